# Optimizing an MI355X kernel written in HIP

```python
import jax, jax.numpy as jnp
from jax import lax
import numpy as np

D_MODEL = 4096
BATCH = 1
SEQ = 16384
DEPTH = 2

MLA_HEADS = 16
MLA_Q_RANK = 768
MLA_KV_RANK = 512
MLA_NOPE_DIM = 128
MLA_ROPE_DIM = 64
MLA_V_DIM = 128
MLA_WIDTH = MLA_HEADS * MLA_V_DIM
ROPE_THETA = 10000.0

NSA_HEADS = 16
NSA_GROUPS = 2
NSA_HEADS_PER_GROUP = NSA_HEADS // NSA_GROUPS
NSA_HEAD_DIM = 128
NSA_WIDTH = NSA_HEADS * NSA_HEAD_DIM
NSA_BRANCHES = 3
CMP_BLOCK = 32
CMP_STRIDE = 16
SLC_BLOCK = 64
SLC_TOPK = 16
WINDOW = 512

MIX_WIDTH = MLA_WIDTH + NSA_WIDTH
IN_SPLITS = (MLA_Q_RANK, MLA_KV_RANK, MLA_ROPE_DIM, MLA_WIDTH,
             NSA_WIDTH, NSA_BRANCHES * 2 * NSA_GROUPS * NSA_HEAD_DIM, NSA_BRANCHES * NSA_HEADS, NSA_WIDTH)
IN_COLS = sum(IN_SPLITS)

Q_BLOCK = 128
LN_EPS = 1e-5
RMS_EPS = 1e-6
NEG_INF = -1e30
FORCE_BONUS = 1e4
DEEPNORM_ALPHA = (2 * DEPTH) ** 0.25
DEEPNORM_BETA = (8 * DEPTH) ** -0.25

kernel_name = 'hybrid_mla_nsa_deepnorm_adaln'


def _layer_norm(x, g, b):
    xf = x.astype(jnp.float32)
    mu = jnp.mean(xf, -1, keepdims=True)
    var = jnp.mean(jnp.square(xf - mu), -1, keepdims=True)
    y = (xf - mu) * lax.rsqrt(var + LN_EPS) * g.astype(jnp.float32) + b.astype(jnp.float32)
    return y.astype(x.dtype)


def _rms_norm(x, g):
    xf = x.astype(jnp.float32)
    y = xf * lax.rsqrt(jnp.mean(xf * xf, -1, keepdims=True) + RMS_EPS) * g.astype(jnp.float32)
    return y.astype(x.dtype)


def _rope(x, cos, sin):
    half = x.shape[-1] // 2
    xf = x.astype(jnp.float32)
    x1, x2 = xf[..., :half], xf[..., half:]
    return jnp.concatenate([x1 * cos - x2 * sin, x2 * cos + x1 * sin], -1).astype(x.dtype)


def _masked_softmax(scores, valid):
    s = jnp.where(valid, scores.astype(jnp.float32), NEG_INF)
    return jnp.where(valid, jax.nn.softmax(s, axis=-1), 0.0)


def _mla_attention(q_nope, q_rope, k_nope, k_rope, v):
    b, s, h, _ = q_nope.shape
    scale = (MLA_NOPE_DIM + MLA_ROPE_DIM) ** -0.5
    k_pos = jnp.arange(s)

    def block(i):
        q0 = i * Q_BLOCK
        qn = lax.dynamic_slice_in_dim(q_nope, q0, Q_BLOCK, 1)
        qr = lax.dynamic_slice_in_dim(q_rope, q0, Q_BLOCK, 1)
        t = q0 + jnp.arange(Q_BLOCK)
        scores = (jnp.einsum('bqhd,bkhd->bhqk', qn, k_nope)
                  + jnp.einsum('bqhd,bkd->bhqk', qr, k_rope)).astype(jnp.float32) * scale
        p = _masked_softmax(scores, k_pos[None, :] <= t[:, None])
        o = jnp.einsum('bhqk,bkhd->bqhd', p.astype(v.dtype), v)
        return o.reshape(b, Q_BLOCK, h * MLA_V_DIM)

    out = lax.map(block, jnp.arange(s // Q_BLOCK))
    return out.transpose(1, 0, 2, 3).reshape(b, s, h * MLA_V_DIM)


def _compress(k, pos_emb, w1, w2):
    b, s, g, dh = k.shape
    n_cmp = (s - CMP_BLOCK) // CMP_STRIDE + 1
    idx = jnp.arange(n_cmp)[:, None] * CMP_STRIDE + jnp.arange(CMP_BLOCK)[None, :]
    blocks = k[:, idx] + pos_emb[None, None, :, None, :]
    blocks = blocks.transpose(0, 1, 3, 2, 4).reshape(b, n_cmp, g, CMP_BLOCK * dh)
    return jax.nn.silu(blocks @ w1) @ w2


def _gather_tokens(kv_t, idx):
    return jax.vmap(jax.vmap(lambda a, i: a[i]))(kv_t, idx)


def _nsa_attention(q, k_cmp, v_cmp, k_slc, v_slc, k_win, v_win, gates):
    b, s, h, dh = q.shape
    g, hg = NSA_GROUPS, NSA_HEADS_PER_GROUP
    n_cmp = k_cmp.shape[1]
    n_slc = s // SLC_BLOCK
    n_sel = min(SLC_TOPK, n_slc)
    n_tok = n_sel * SLC_BLOCK
    scale = dh ** -0.5
    slopes = jnp.exp2(-8.0 * jnp.arange(1, h + 1, dtype=jnp.float32) / h).reshape(g, hg)
    slope_b = slopes[None, None, :, :, None]
    cmp_start = jnp.arange(n_cmp) * CMP_STRIDE
    cmp_end = cmp_start + CMP_BLOCK - 1
    slc_start = jnp.arange(n_slc) * SLC_BLOCK
    cmp_to_slc = ((cmp_start[:, None] < slc_start[None, :] + SLC_BLOCK)
                  & (cmp_end[:, None] >= slc_start[None, :])).astype(jnp.float32)
    k_slc_t = k_slc.transpose(0, 2, 1, 3)
    v_slc_t = v_slc.transpose(0, 2, 1, 3)
    pad = ((0, 0), (WINDOW, 0), (0, 0), (0, 0))
    k_win_p = jnp.pad(k_win, pad)
    v_win_p = jnp.pad(v_win, pad)
    blk_ids = jnp.arange(n_slc)
    slc_offs = jnp.arange(SLC_BLOCK)
    win_offs = jnp.arange(Q_BLOCK + WINDOW) - WINDOW

    def block(i):
        q0 = i * Q_BLOCK
        t = q0 + jnp.arange(Q_BLOCK)
        qb = lax.dynamic_slice_in_dim(q, q0, Q_BLOCK, 1).reshape(b, Q_BLOCK, g, hg, dh)
        gb = lax.dynamic_slice_in_dim(gates, q0, Q_BLOCK, 1).reshape(b, Q_BLOCK, NSA_BRANCHES, g, hg, 1)
        dist_c = (t[:, None] - cmp_end[None, :]).astype(jnp.float32)
        sc = (jnp.einsum('bqghd,bngd->bqghn', qb, k_cmp).astype(jnp.float32) * scale
              - slope_b * dist_c[None, :, None, None, :])
        p_c = _masked_softmax(sc, (dist_c >= 0)[None, :, None, None, :])
        o_c = jnp.einsum('bqghn,bngd->bqghd', p_c.astype(v_cmp.dtype), v_cmp)
        imp = jnp.einsum('bqgn,nj->bqgj', p_c.sum(3), cmp_to_slc)
        cur = t // SLC_BLOCK
        forced = ((blk_ids[None, :] == 0) | (blk_ids[None, :] == cur[:, None])
                  | (blk_ids[None, :] == cur[:, None] - 1))
        causal = slc_start[None, :] <= t[:, None]
        imp = jnp.where(causal[None, :, None, :],
                        imp + jnp.where(forced, FORCE_BONUS, 0.0)[None, :, None, :], NEG_INF)
        _, top = lax.top_k(imp, n_sel)
        tok = (top[..., None] * SLC_BLOCK + slc_offs).reshape(b, Q_BLOCK, g, n_tok)
        idx = tok.transpose(0, 2, 1, 3).reshape(b, g, Q_BLOCK * n_tok)
        ks = _gather_tokens(k_slc_t, idx).reshape(b, g, Q_BLOCK, n_tok, dh)
        vs = _gather_tokens(v_slc_t, idx).reshape(b, g, Q_BLOCK, n_tok, dh)
        dist_s = (t[None, :, None, None] - tok).astype(jnp.float32)
        ss = (jnp.einsum('bqghd,bgqtd->bqght', qb, ks).astype(jnp.float32) * scale
              - slope_b * dist_s[:, :, :, None, :])
        p_s = _masked_softmax(ss, (dist_s >= 0)[:, :, :, None, :])
        o_s = jnp.einsum('bqght,bgqtd->bqghd', p_s.astype(vs.dtype), vs)
        kw = lax.dynamic_slice_in_dim(k_win_p, q0, Q_BLOCK + WINDOW, 1)
        vw = lax.dynamic_slice_in_dim(v_win_p, q0, Q_BLOCK + WINDOW, 1)
        s_pos = q0 + win_offs
        dist_w = t[:, None] - s_pos[None, :]
        valid_w = (dist_w >= 0) & (dist_w < WINDOW) & (s_pos >= 0)[None, :]
        sw = (jnp.einsum('bqghd,bkgd->bqghk', qb, kw).astype(jnp.float32) * scale
              - slope_b * dist_w.astype(jnp.float32)[None, :, None, None, :])
        p_w = _masked_softmax(sw, valid_w[None, :, None, None, :])
        o_w = jnp.einsum('bqghk,bkgd->bqghd', p_w.astype(vw.dtype), vw)
        o = gb[:, :, 0] * o_c + gb[:, :, 1] * o_s + gb[:, :, 2] * o_w
        return o.reshape(b, Q_BLOCK, h * dh)

    out = lax.map(block, jnp.arange(s // Q_BLOCK))
    return out.transpose(1, 0, 2, 3).reshape(b, s, h * dh)


def _hybrid_layer(x, c, cos, sin, w_ada, b_ada, w_in, q_norm, w_q_up, kv_norm, w_kv_up,
                  cmp_pos, w_cmp1, w_cmp2, w_out, ln_g, ln_b):
    b, s, _ = x.shape
    shift, scale, gate = jnp.split(jax.nn.silu(c) @ w_ada + b_ada, 3, axis=-1)
    h = x * (1.0 + scale[:, None, :]) + shift[:, None, :]
    offsets = np.cumsum(IN_SPLITS)[:-1].tolist()
    q_lat, kv_lat, k_rope, z_mla, q_nsa, kv_nsa, g_nsa, z_nsa = jnp.split(h @ w_in, offsets, axis=-1)

    q = (_rms_norm(q_lat, q_norm) @ w_q_up).reshape(b, s, MLA_HEADS, MLA_NOPE_DIM + MLA_ROPE_DIM)
    q_nope = q[..., :MLA_NOPE_DIM]
    q_rope = _rope(q[..., MLA_NOPE_DIM:], cos[:, :, None, :], sin[:, :, None, :])
    kv = (_rms_norm(kv_lat, kv_norm) @ w_kv_up).reshape(b, s, MLA_HEADS, MLA_NOPE_DIM + MLA_V_DIM)
    k_nope, v = kv[..., :MLA_NOPE_DIM], kv[..., MLA_NOPE_DIM:]
    k_rope = _rope(k_rope, cos, sin)
    o_mla = _mla_attention(q_nope, q_rope, k_nope, k_rope, v) * jax.nn.silu(z_mla)

    kvn = kv_nsa.reshape(b, s, NSA_BRANCHES, 2, NSA_GROUPS, NSA_HEAD_DIM)
    k_cmp = _compress(kvn[:, :, 0, 0], cmp_pos[0], w_cmp1[0], w_cmp2[0])
    v_cmp = _compress(kvn[:, :, 0, 1], cmp_pos[1], w_cmp1[1], w_cmp2[1])
    gates = jax.nn.sigmoid(g_nsa).reshape(b, s, NSA_BRANCHES, NSA_HEADS)
    o_nsa = _nsa_attention(q_nsa.reshape(b, s, NSA_HEADS, NSA_HEAD_DIM), k_cmp, v_cmp,
                           kvn[:, :, 1, 0], kvn[:, :, 1, 1], kvn[:, :, 2, 0], kvn[:, :, 2, 1],
                           gates) * jax.nn.silu(z_nsa)

    y = jnp.concatenate([o_mla, o_nsa], axis=-1) @ w_out
    return _layer_norm(DEEPNORM_ALPHA * x + gate[:, None, :] * y, ln_g, ln_b)


def setup_inputs(seed: int = 0) -> dict:
    key = jax.random.key(seed)
    ks = jax.random.split(key, 18)
    f32 = jnp.float32
    nrm = lambda k, shape, sc: jax.random.normal(k, shape, f32) * sc
    x = nrm(ks[0], (BATCH, SEQ, D_MODEL), 1.0)
    c = nrm(ks[1], (BATCH, D_MODEL), 1.0)
    positions = (jnp.arange(SEQ, dtype=jnp.int32)[None, :]
                 + jax.random.randint(ks[2], (BATCH, 1), 0, 1024, dtype=jnp.int32))
    w_ada = nrm(ks[3], (DEPTH, D_MODEL, 3 * D_MODEL), 0.5 * D_MODEL ** -0.5)
    b_ada = nrm(ks[4], (DEPTH, 3 * D_MODEL), 0.01)
    w_in = nrm(ks[5], (DEPTH, D_MODEL, IN_COLS), D_MODEL ** -0.5)
    mla_q_norm = 1.0 + nrm(ks[6], (DEPTH, MLA_Q_RANK), 0.01)
    w_q_up = nrm(ks[7], (DEPTH, MLA_Q_RANK, MLA_HEADS * (MLA_NOPE_DIM + MLA_ROPE_DIM)), MLA_Q_RANK ** -0.5)
    mla_kv_norm = 1.0 + nrm(ks[8], (DEPTH, MLA_KV_RANK), 0.01)
    w_kv_up = nrm(ks[9], (DEPTH, MLA_KV_RANK, MLA_HEADS * (MLA_NOPE_DIM + MLA_V_DIM)), MLA_KV_RANK ** -0.5)
    cmp_pos = nrm(ks[10], (DEPTH, 2, CMP_BLOCK, NSA_HEAD_DIM), 0.1)
    w_cmp1 = nrm(ks[11], (DEPTH, 2, CMP_BLOCK * NSA_HEAD_DIM, NSA_HEAD_DIM), (CMP_BLOCK * NSA_HEAD_DIM) ** -0.5)
    w_cmp2 = nrm(ks[12], (DEPTH, 2, NSA_HEAD_DIM, NSA_HEAD_DIM), NSA_HEAD_DIM ** -0.5)
    w_out = nrm(ks[13], (DEPTH, MIX_WIDTH, D_MODEL), DEEPNORM_BETA * MIX_WIDTH ** -0.5)
    ln_g = 1.0 + nrm(ks[14], (DEPTH, D_MODEL), 0.01)
    ln_b = nrm(ks[15], (DEPTH, D_MODEL), 0.01)
    return {'x': x, 'c': c, 'positions': positions, 'w_ada': w_ada, 'b_ada': b_ada, 'w_in': w_in,
            'mla_q_norm': mla_q_norm, 'w_q_up': w_q_up, 'mla_kv_norm': mla_kv_norm, 'w_kv_up': w_kv_up,
            'cmp_pos': cmp_pos, 'w_cmp1': w_cmp1, 'w_cmp2': w_cmp2, 'w_out': w_out,
            'ln_g': ln_g, 'ln_b': ln_b}


def reference(x, c, positions, w_ada, b_ada, w_in, mla_q_norm, w_q_up, mla_kv_norm, w_kv_up,
              cmp_pos, w_cmp1, w_cmp2, w_out, ln_g, ln_b):
    inv_freq = ROPE_THETA ** (-jnp.arange(0, MLA_ROPE_DIM, 2, dtype=jnp.float32) / MLA_ROPE_DIM)
    ang = positions.astype(jnp.float32)[..., None] * inv_freq
    cos, sin = jnp.cos(ang), jnp.sin(ang)
    for l in range(DEPTH):
        x = _hybrid_layer(x, c, cos, sin, w_ada[l], b_ada[l], w_in[l], mla_q_norm[l], w_q_up[l],
                          mla_kv_norm[l], w_kv_up[l], cmp_pos[l], w_cmp1[l], w_cmp2[l], w_out[l],
                          ln_g[l], ln_b[l])
    return x
```

```cpp
#include <hip/hip_runtime.h>
#include <cstdio>
#include <cstdint>

#define GAS __attribute__((address_space(1)))
#define LAS __attribute__((address_space(3)))
typedef unsigned short bf16;
typedef float f32x4 __attribute__((ext_vector_type(4)));
typedef float f32x2 __attribute__((ext_vector_type(2)));
typedef float f32x8 __attribute__((ext_vector_type(8)));
typedef float f32x16 __attribute__((ext_vector_type(16)));
typedef unsigned u32x4 __attribute__((ext_vector_type(4)));
typedef unsigned u32x2 __attribute__((ext_vector_type(2)));
typedef short bf16x8 __attribute__((ext_vector_type(8)));
typedef short s16x4 __attribute__((ext_vector_type(4)));
typedef __bf16 bf16x2v __attribute__((ext_vector_type(2)));
typedef __bf16 bf16x8v __attribute__((ext_vector_type(8)));
typedef GAS unsigned gu32;

constexpr int S = 16384, D = 4096, DEPTH = 2;
constexpr int INC = 9072, NIN = 9216;
constexpr float LN_EPS = 1e-5f, RMS_EPS = 1e-6f;
constexpr float DN_ALPHA = 1.41421356237309515f;
constexpr float LOG2E = 1.4426950408889634f;
constexpr float QS_MLA = 0.07216878364870322f * LOG2E;
constexpr float QS_NSA = 0.08838834764831845f * LOG2E;
constexpr int NWAVES = 8, NTHR = 512;
constexpr size_t MiB = 1u << 20;
constexpr size_t WS_CTL = 0, CTL_ZERO_BYTES = 1 * MiB;
constexpr size_t WS_MOD = 1 * MiB;
constexpr size_t WS_ROPE = 2 * MiB;
constexpr size_t WS_CBP = 6 * MiB;
constexpr size_t WS_RSQQ = 7 * MiB;
constexpr size_t WS_RSQKV = 9 * MiB;
constexpr size_t WS_RSTD = 6 * MiB + 512 * 1024;
constexpr size_t WS_GNSA = 10 * MiB;
constexpr size_t WS_KCMP = 13 * MiB;
constexpr size_t WS_VCMP = 13 * MiB + 512 * 1024;
constexpr size_t WS_W = 16 * MiB, W_LSTRIDE = 120 * MiB;
constexpr size_t W_IN = 0, W_QUP = 72 * MiB, W_KVUP = 77 * MiB, W_OUT = 81 * MiB, W_C1 = 113 * MiB, W_C2 = 115 * MiB;
constexpr size_t WS_H = 256 * MiB;
constexpr size_t WS_XV = 384 * MiB;
constexpr size_t WS_QLAT = 640 * MiB, WS_KVLAT = 664 * MiB;
constexpr size_t WS_QMLA = 680 * MiB, WS_KMLA = 776 * MiB, WS_VMLA = 872 * MiB, WS_ZMLA = 936 * MiB, WS_ZNSA = 1000 * MiB, WS_QNSA = 1064 * MiB;
constexpr size_t WS_KVNSA = 1128 * MiB;
constexpr size_t WS_OSCR = 1178 * MiB;
constexpr size_t WS_END = 1210 * MiB;
constexpr int CW_BAR = 4096;
constexpr int LDS_BYTES = 147456;
constexpr int MISC_OFF = LDS_BYTES - 128;

__device__ __forceinline__ unsigned pk2(float lo, float hi) { f32x2 a = {lo, hi}; return __builtin_bit_cast(unsigned, __builtin_convertvector(a, bf16x2v)); }
__device__ __forceinline__ u32x4 pk8(f32x4 a, f32x4 b) { u32x4 w; w.x = pk2(a[0], a[1]); w.y = pk2(a[2], a[3]); w.z = pk2(b[0], b[1]); w.w = pk2(b[2], b[3]); return w; }
__device__ __forceinline__ float bflo(unsigned u) { return __uint_as_float(u << 16); }
__device__ __forceinline__ float bfhi(unsigned u) { return __uint_as_float(u & 0xffff0000u); }
__device__ __forceinline__ float wave_sum(float v) {
#pragma unroll
    for (int o = 1; o < 64; o <<= 1) v += __shfl_xor(v, o);
    return v;
}
__device__ __forceinline__ float silu_f(float v) { return v / (1.f + __expf(-v)); }
__device__ __forceinline__ float sigm_f(float v) { return 1.f / (1.f + __expf(-v)); }

#define XB_TMO      128
#define XB_XCNT(j)  (256  + 64 * (j))
#define XB_XSUB(j)  (1280 + 64 * (j))
#define XB_XGEN(j)  (2304 + 64 * (j))
#define XB_TOP      3328
#define XB_TOPGEN   3392
#define XCD_BAR_WORDS 3456
#define XB_SPIN_CAP (1u << 18)
__device__ __forceinline__ unsigned xb_ld(unsigned* p)              { return __hip_atomic_load(p, __ATOMIC_RELAXED, __HIP_MEMORY_SCOPE_AGENT); }
__device__ __forceinline__ unsigned xb_add(unsigned* p, unsigned v) { return __hip_atomic_fetch_add(p, v, __ATOMIC_RELAXED, __HIP_MEMORY_SCOPE_AGENT); }
__device__ __forceinline__ unsigned xb_xcc_id() { return (unsigned)__builtin_amdgcn_s_getreg((3 << 11) | 20) & 0xFu; }
#define XB_SPIN(cond, bar) do { unsigned _sp = 0; while (cond) { __builtin_amdgcn_s_sleep(1); \
    if ((++_sp & 255u) == 0u) { if (xb_ld(&(bar)[XB_TMO])) break; if (_sp > XB_SPIN_CAP) { atomicAdd(&(bar)[XB_TMO], 1u); break; } } } } while (0)
struct XcdBarrier { unsigned* bar; unsigned x; volatile LAS unsigned* st; };
__device__ __forceinline__ XcdBarrier xcd_barrier_post(unsigned* bar, volatile LAS unsigned* st) {
    XcdBarrier b; b.bar = bar; b.x = xb_xcc_id(); b.st = st;
    if (threadIdx.x == 0) (void)xb_add(&bar[XB_XCNT(b.x)], 1u);
    return b;
}
__device__ __forceinline__ void xcd_barrier_complete(unsigned* bar, unsigned x, unsigned& nloc, unsigned& nx) {
    const unsigned G = gridDim.x * gridDim.y * gridDim.z;
    unsigned sum, cnt, mine, sp = 0u;
    for (;;) {
        sum = 0u; cnt = 0u; mine = 0u;
#pragma unroll
        for (unsigned j = 0; j < 16; ++j) { const unsigned c = xb_ld(&bar[XB_XCNT(j)]); sum += c; cnt += (c > 0u) ? 1u : 0u; mine = (j == x) ? c : mine; }
        if (sum == G) break;
        __builtin_amdgcn_s_sleep(1);
        if ((++sp & 255u) == 0u) { if (xb_ld(&bar[XB_TMO])) break; if (sp > XB_SPIN_CAP) { atomicAdd(&bar[XB_TMO], 1u); break; } }
    }
    nloc = mine > 0u ? mine : 1u; nx = cnt > 0u ? cnt : 1u;
}
__device__ __forceinline__ void xcd_barrier(const XcdBarrier& b) {
    asm volatile("s_waitcnt vmcnt(0)" ::: "memory");
    __syncthreads();
    if (threadIdx.x == 0) {
        unsigned* bar = b.bar;
        __builtin_amdgcn_s_waitcnt(0);
        unsigned nloc = b.st[0], nx = b.st[1];
        if (nloc == 0u) { xcd_barrier_complete(bar, b.x, nloc, nx); b.st[0] = nloc; b.st[1] = nx; }
        const unsigned old = xb_add(&bar[XB_XSUB(b.x)], 1u);
        const unsigned gen = old / nloc;
        if (old + 1u == (gen + 1u) * nloc) {
            __builtin_amdgcn_fence(__ATOMIC_RELEASE, "agent");
            asm volatile("s_waitcnt vmcnt(0)" ::: "memory");
            const unsigned og = xb_add(&bar[XB_TOP], 1u);
            const unsigned tg = og / nx;
            if (og + 1u == (tg + 1u) * nx) xb_add(&bar[XB_TOPGEN], 1u);
            else XB_SPIN(xb_ld(&bar[XB_TOPGEN]) == tg, bar);
            __builtin_amdgcn_fence(__ATOMIC_ACQUIRE, "agent");
            xb_add(&bar[XB_XGEN(b.x)], 1u);
            asm volatile("s_waitcnt vmcnt(0)" ::: "memory");
        } else {
            XB_SPIN(xb_ld(&bar[XB_XGEN(b.x)]) == gen, bar);
            __builtin_amdgcn_fence(__ATOMIC_ACQUIRE, "agent");
            asm volatile("s_waitcnt vmcnt(0)" ::: "memory");
        }
    }
    __syncthreads();
}
__device__ __forceinline__ void p0_mod_gemv(const float* c, const float* w_ada, const float* b_ada, float* mod, LAS float* lds, int vcu, int G) {
    const int tid = threadIdx.x;
    LAS float* sc = lds;
    LAS float* red = lds + 4096;
    for (int k = tid; k < D; k += NTHR) sc[k] = silu_f(c[k]);
    __syncthreads();
    const int cl = tid & 7, kl = tid >> 3;
    constexpr int NU = DEPTH * 3 * D / 32;
    for (int u = vcu; u < NU; u += G) {
        const int l = u / (3 * D / 32), n0 = (u % (3 * D / 32)) * 32;
        const float* W = w_ada + (size_t)l * D * (3 * D) + n0 + cl * 4;
        f32x4 acc = {0.f, 0.f, 0.f, 0.f};
#pragma unroll 8
        for (int i = 0; i < D / 64; ++i) { const int k = kl + 64 * i; const f32x4 w = *(const GAS f32x4*)(W + (size_t)k * (3 * D)); acc += w * sc[k]; }
        red[kl * 33 + cl * 4 + 0] = acc[0]; red[kl * 33 + cl * 4 + 1] = acc[1]; red[kl * 33 + cl * 4 + 2] = acc[2]; red[kl * 33 + cl * 4 + 3] = acc[3];
        __syncthreads();
        if (tid < 32) { float s = 0.f; for (int j = 0; j < 64; ++j) s += red[j * 33 + tid]; mod[(size_t)l * 3 * D + n0 + tid] = s + b_ada[(size_t)l * 3 * D + n0 + tid]; }
        __syncthreads();
    }
}
__device__ __forceinline__ int map_in(int n) {
    if (n < 1280) return n;
    if (n < 1344) { const int i = n - 1280; return 1280 + 2 * (i & 31) + (i >> 5); }
    if (n < 3392) return 1536 + (n - 1344);
    if (n < 5440) return 3584 + (n - 3392);
    if (n < 6976) return 5632 + (n - 5440);
    if (n < 7024) return 1344 + (n - 6976);
    return 7168 + (n - 7024);
}
__device__ __forceinline__ int map_qup(int n) { const int h = n / 192, d = n - h * 192; if (d < 128) return h * 128 + d; const int i = d - 128; return 2048 + h * 64 + 2 * (i & 31) + (i >> 5); }
template <int MAP>
__device__ __forceinline__ void tr_item(const float* W, int K, int N, bf16* WT, const float* kscale, LAS float* scr, int kb, int nb, int lane) {
    const int k0 = 64 * kb, n0 = 32 * nb;
    const int nn = n0 + (lane & 31);
#pragma unroll 8
    for (int i = 0; i < 32; ++i) { const int kk = 2 * i + (lane >> 5); float v = 0.f; if (nn < N) v = *(const GAS float*)(W + (size_t)(k0 + kk) * N + nn); if (kscale) v *= kscale[k0 + kk]; scr[kk * 33 + (lane & 31)] = v; }
    asm volatile("s_waitcnt lgkmcnt(0)" ::: "memory");
    const int c = lane & 7;
#pragma unroll
    for (int j = 0; j < 4; ++j) { const int nl = (lane >> 3) + 8 * j, n = n0 + nl;
        if (n < N) { const int row = MAP == 1 ? map_in(n) : (MAP == 2 ? map_qup(n) : n); const LAS float* s = scr + (8 * c) * 33 + nl;
            u32x4 o; o.x = pk2(s[0 * 33], s[1 * 33]); o.y = pk2(s[2 * 33], s[3 * 33]); o.z = pk2(s[4 * 33], s[5 * 33]); o.w = pk2(s[6 * 33], s[7 * 33]);
            *(GAS u32x4*)(WT + (size_t)row * K + k0 + 8 * c) = o; } }
    asm volatile("s_waitcnt lgkmcnt(0)" ::: "memory");
}
struct P0In { const float *w_in, *q_norm, *w_q_up, *kv_norm, *w_kv_up, *w_cmp1, *w_cmp2, *w_out; };
__device__ __forceinline__ void p0_convert(const P0In& I, unsigned char* ws, LAS float* scr, int gw, int NGW, int lane) {
    constexpr int T_IN = 64 * 284, T_QUP = 12 * 96, T_KVUP = 8 * 128, T_OUT = 64 * 128, T_C1 = 2 * 64 * 4, T_C2 = 2 * 2 * 4;
    constexpr int TL = T_IN + T_QUP + T_KVUP + T_OUT + T_C1 + T_C2;
    for (int it = gw; it < DEPTH * TL; it += NGW) {
        const int l = it / TL; int r = it - l * TL;
        unsigned char* wl = ws + WS_W + (size_t)l * W_LSTRIDE;
        if (r < T_IN) { tr_item<1>(I.w_in + (size_t)l * D * INC, D, INC, (bf16*)(wl + W_IN), nullptr, scr, r / 284, r % 284, lane); continue; } r -= T_IN;
        if (r < T_QUP) { tr_item<2>(I.w_q_up + (size_t)l * 768 * 3072, 768, 3072, (bf16*)(wl + W_QUP), I.q_norm + l * 768, scr, r / 96, r % 96, lane); continue; } r -= T_QUP;
        if (r < T_KVUP) { tr_item<0>(I.w_kv_up + (size_t)l * 512 * 4096, 512, 4096, (bf16*)(wl + W_KVUP), I.kv_norm + l * 512, scr, r / 128, r % 128, lane); continue; } r -= T_KVUP;
        if (r < T_OUT) { tr_item<0>(I.w_out + (size_t)l * D * D, D, D, (bf16*)(wl + W_OUT), nullptr, scr, r / 128, r % 128, lane); continue; } r -= T_OUT;
        if (r < T_C1) { const int kv = r / 256, rr = r % 256; tr_item<0>(I.w_cmp1 + (size_t)(l * 2 + kv) * 4096 * 128, 4096, 128, (bf16*)(wl + W_C1) + (size_t)kv * 128 * 4096, nullptr, scr, rr / 4, rr % 4, lane); continue; } r -= T_C1;
        { const int kv = r / 8, rr = r % 8; tr_item<0>(I.w_cmp2 + (size_t)(l * 2 + kv) * 128 * 128, 128, 128, (bf16*)(wl + W_C2) + (size_t)kv * 128 * 128, nullptr, scr, rr / 4, rr % 4, lane); }
    }
}
__device__ __forceinline__ void p0_rope(const int* positions, float* cosT, float* sinT, int gtid, int NT) {
    for (int e = gtid; e < S * 32; e += NT) { const int s = e >> 5, i = e & 31;
        const float inv = (float)exp(-(double)i * (1.0 / 32.0) * 9.210340371976184);
        const float ang = (float)positions[s] * inv;
        cosT[e] = (float)cos((double)ang); sinT[e] = (float)sin((double)ang); }
}
__device__ __forceinline__ void p0_cmpbias(const float* cmp_pos, const float* w_cmp1, float* cbp, LAS float* red, int vcu, int G) {
    const int tid = threadIdx.x, n = tid & 127, kq = tid >> 7;
    for (int u = vcu; u < 64; u += G) {
        const int lk = u >> 4, ch = u & 15;
        const float* P = cmp_pos + (size_t)lk * 4096 + 256 * ch; const float* W = w_cmp1 + (size_t)lk * 4096 * 128 + (size_t)(256 * ch) * 128 + n;
        float a = 0.f;
#pragma unroll 8
        for (int i = 0; i < 64; ++i) { const int k = kq + 4 * i; a += P[k] * *(const GAS float*)(W + (size_t)k * 128); }
        red[kq * 128 + n] = a;
        __syncthreads();
        if (tid < 128) cbp[(size_t)u * 128 + tid] = (red[tid] + red[128 + tid]) + (red[256 + tid] + red[384 + tid]);
        __syncthreads();
    }
}
__device__ __forceinline__ void modulate_rows(const float* x, bf16* hout, const float* modl, int gw, int NGW, int lane) {
    f32x4 sh[16], sc[16];
#pragma unroll
    for (int j = 0; j < 16; ++j) { sh[j] = *((const GAS f32x4*)modl + lane + 64 * j); sc[j] = *((const GAS f32x4*)(modl + D) + lane + 64 * j) + 1.f; }
    for (int m = gw; m < S; m += NGW) {
        const GAS f32x4* xr = (const GAS f32x4*)(x + (size_t)m * D) + lane;
        GAS u32x2* ho = (GAS u32x2*)(hout + (size_t)m * D) + lane;
#pragma unroll
        for (int j = 0; j < 16; ++j) { const f32x4 h = xr[64 * j] * sc[j] + sh[j]; u32x2 w; w.x = pk2(h[0], h[1]); w.y = pk2(h[2], h[3]); ho[64 * j] = w; }
    }
}
__device__ __forceinline__ void ln_rows(const float* v, float* xout, bf16* hout, const float* g, const float* b, const float* mod_next, int gw, int NGW, int lane) {
    for (int m = gw; m < S; m += NGW) {
        const GAS f32x4* vr = (const GAS f32x4*)(v + (size_t)m * D) + lane;
        f32x4 x[16]; float s = 0.f;
#pragma unroll
        for (int j = 0; j < 16; ++j) { x[j] = vr[64 * j]; s += (x[j][0] + x[j][1]) + (x[j][2] + x[j][3]); }
        const float mean = wave_sum(s) * (1.f / D); float s2 = 0.f;
#pragma unroll
        for (int j = 0; j < 16; ++j) { x[j] = x[j] - mean; s2 += (x[j][0] * x[j][0] + x[j][1] * x[j][1]) + (x[j][2] * x[j][2] + x[j][3] * x[j][3]); }
        const float rstd = 1.f / sqrtf(wave_sum(s2) * (1.f / D) + LN_EPS);
        GAS f32x4* xo = (GAS f32x4*)(xout + (size_t)m * D) + lane;
#pragma unroll
        for (int j = 0; j < 16; ++j) {
            const f32x4 gg = *((const GAS f32x4*)g + lane + 64 * j), bb = *((const GAS f32x4*)b + lane + 64 * j);
            const f32x4 y = x[j] * rstd * gg + bb;
            xo[64 * j] = y;
            if (hout) {
                const f32x4 sh = *((const GAS f32x4*)mod_next + lane + 64 * j), scl = *((const GAS f32x4*)(mod_next + D) + lane + 64 * j);
                const f32x4 h = y * (scl + 1.f) + sh;
                u32x2 w; w.x = pk2(h[0], h[1]); w.y = pk2(h[2], h[3]);
                *((GAS u32x2*)(hout + (size_t)m * D) + lane + 64 * j) = w;
            }
        }
    }
}
__device__ __forceinline__ void rstd_rows(const float* rsq_q, const float* rsq_kv, float* rstd_q, float* rstd_kv, int gtid, int NT) {
    for (int row = gtid; row < S; row += NT) {
        const GAS f32x4* rp = (const GAS f32x4*)(rsq_q + (size_t)row * 24); float ss = 0.f;
#pragma unroll
        for (int i = 0; i < 6; ++i) { const f32x4 t = rp[i]; ss += (t[0] + t[1]) + (t[2] + t[3]); }
        rstd_q[row] = 1.f / sqrtf(ss * (1.f / 768.f) + RMS_EPS);
        const GAS f32x4* rk = (const GAS f32x4*)(rsq_kv + (size_t)row * 16); float sk = 0.f;
#pragma unroll
        for (int i = 0; i < 4; ++i) { const f32x4 t = rk[i]; sk += (t[0] + t[1]) + (t[2] + t[3]); }
        rstd_kv[row] = 1.f / sqrtf(sk * (1.f / 512.f) + RMS_EPS);
    }
}
namespace pg8 {
#define PG8_LAS __attribute__((address_space(3)))
typedef unsigned short bf16_t;
typedef short bf16x8 __attribute__((ext_vector_type(8)));
typedef float f32x4 __attribute__((ext_vector_type(4)));
typedef unsigned u32x4 __attribute__((ext_vector_type(4)));
constexpr int BM = 256, BK = 64, HALF = 128, HTB = HALF * BK * 2  , STAGE_BYTES = 8 * HTB, NXCD = 8, WGM = 8;

__host__ __device__ __forceinline__ int lds_byte(int r, int c) { const int st = (r >> 4) * 2 + (c >> 5), rr = r & 15, cc = c & 31, ob = rr * 64 + cc * 2; return st * 1024 + (ob ^ (((ob >> 9) & 1) << 5)); }
__host__ __device__ __forceinline__ void stage_rc(int b, int& R, int& C) { const int st = b / 1024, sb = b % 1024, swz = sb ^ (((sb >> 9) & 1) << 5); R = (st >> 1) * 16 + swz / 64; C = (st & 1) * 32 + (swz % 64) / 2; }
__host__ __device__ __forceinline__ int perm32(int rho) { const int n = rho >> 4, i = rho & 15; return 8 * (i >> 2) + 4 * n + (i & 3); }

struct Unit { int pm, pn; };
struct Gemm { const bf16_t* A; const bf16_t* Bt; int M, N, K; };

struct StaticOrder {
    int nM, nN, nwg, G, c;
    __host__ __device__ void init(int M, int N, int G_, int c_) { nM = M / BM; nN = N / BM; nwg = nM * nN; G = G_; c = c_; }
    __host__ __device__ bool next(int i, Unit& u) const {
        const long L = (long)i * G + c; if (L >= nwg) return false;
        int wgid = (int)L; { const int q = nwg / NXCD, r = nwg % NXCD, xcd = wgid % NXCD, off = wgid / NXCD; wgid = (xcd < r ? xcd * (q + 1) : r * (q + 1) + (xcd - r) * q) + off; }
        const int nig = WGM * nN, gid = wgid / nig, fm = gid * WGM, gsz = (nM - fm) < WGM ? (nM - fm) : WGM;
        u.pm = fm + ((wgid % nig) % gsz); u.pn = (wgid % nig) / gsz; return true;
    }
    __device__ __forceinline__ void a_ready(const Unit&) const {}
    __device__ __forceinline__ void done(const Unit&) const {}
};
__device__ __forceinline__ f32x4 rope4(const f32x4 v, float c0, float s0, float c1, float s1) {
    f32x4 o; o[0] = v[0] * c0 - v[1] * s0; o[1] = v[1] * c0 + v[0] * s0; o[2] = v[2] * c1 - v[3] * s1; o[3] = v[3] * c1 + v[2] * s1; return o; }
struct EpiIn {
    static constexpr bool PERM = true, AFTER_DRAIN = false;
    unsigned char* ws;
    __device__ __forceinline__ void operator()(const f32x4 (&acc)[2][2][4][2], const Unit& u, int wr, int wc, int fr, int fq) const {
        const int pn = u.pn, row0 = u.pm * BM + wr * 64 + fr;
        if (pn < 5) {
            const bool isq = pn < 3; bf16_t* base = (bf16_t*)(ws + (isq ? WS_QLAT : WS_KVLAT)); const int ld = isq ? 768 : 512, ct = isq ? pn : pn - 3, ns = isq ? 24 : 16; float* rsq = (float*)(ws + (isq ? WS_RSQQ : WS_RSQKV));
#pragma unroll
            for (int ai = 0; ai < 2; ++ai)
#pragma unroll
                for (int m = 0; m < 4; ++m) { const int row = row0 + ai * HALF + m * 16;
#pragma unroll
                    for (int bj = 0; bj < 2; ++bj) { const f32x4 v0 = acc[ai][bj][m][0], v1 = acc[ai][bj][m][1];
                        float ss = ((v0[0] * v0[0] + v0[1] * v0[1]) + (v0[2] * v0[2] + v0[3] * v0[3])) + ((v1[0] * v1[0] + v1[1] * v1[1]) + (v1[2] * v1[2] + v1[3] * v1[3]));
                        ss += __shfl_xor(ss, 16); ss += __shfl_xor(ss, 32);
                        if (fq == 0) rsq[(size_t)row * ns + ct * 8 + bj * 4 + wc] = ss;
                        *(GAS u32x4*)(base + (size_t)row * ld + ct * 256 + bj * HALF + wc * 32 + 8 * fq) = pk8(v0, v1); } }
        } else if (pn == 5) {
            if (wc < 2) {
                const int i0 = 16 * wc + 4 * fq; const float* cosT = (const float*)(ws + WS_ROPE); const float* sinT = cosT + (size_t)S * 32; bf16_t* kmla = (bf16_t*)(ws + WS_KMLA);
#pragma unroll
                for (int ai = 0; ai < 2; ++ai)
#pragma unroll
                    for (int m = 0; m < 4; ++m) { const int row = row0 + ai * HALF + m * 16;
                        const f32x4 cs = *(const GAS f32x4*)(cosT + (size_t)row * 32 + i0), sn = *(const GAS f32x4*)(sinT + (size_t)row * 32 + i0);
                        const u32x4 w = pk8(rope4(acc[ai][0][m][0], cs[0], sn[0], cs[1], sn[1]), rope4(acc[ai][0][m][1], cs[2], sn[2], cs[3], sn[3]));
                        bf16_t* dst = kmla + (size_t)row * 3072 + 128 + wc * 32 + 8 * fq;
#pragma unroll
                        for (int h = 0; h < 16; ++h) *(GAS u32x4*)(dst + h * 192) = w;
                        asm volatile("" ::: "memory"); }
            } else {
                const int cl = (wc - 2) * 32 + 8 * fq; float* gnsa = (float*)(ws + WS_GNSA);
                if (cl < 48) {
#pragma unroll
                    for (int ai = 0; ai < 2; ++ai)
#pragma unroll
                        for (int m = 0; m < 4; ++m) { const int row = row0 + ai * HALF + m * 16; const f32x4 v0 = acc[ai][0][m][0], v1 = acc[ai][0][m][1];
                            f32x4 g0, g1; g0[0] = sigm_f(v0[0]); g0[1] = sigm_f(v0[1]); g0[2] = sigm_f(v0[2]); g0[3] = sigm_f(v0[3]); g1[0] = sigm_f(v1[0]); g1[1] = sigm_f(v1[1]); g1[2] = sigm_f(v1[2]); g1[3] = sigm_f(v1[3]);
                            *(GAS f32x4*)(gnsa + (size_t)row * 48 + cl) = g0; *(GAS f32x4*)(gnsa + (size_t)row * 48 + cl + 4) = g1; } }
            }
        } else {
            const int mode = (pn < 14) ? 0 : (pn < 22 ? 1 : (pn < 28 ? 2 : 0));
            bf16_t* base = (pn < 14) ? (bf16_t*)(ws + WS_ZMLA) + (pn - 6) * 256 : (pn < 22 ? (bf16_t*)(ws + WS_QNSA) + (pn - 14) * 256 : (bf16_t*)(ws + WS_ZNSA) + (pn - 28) * 256); bf16_t* kvnsa = (bf16_t*)(ws + WS_KVNSA);
#pragma unroll
            for (int ai = 0; ai < 2; ++ai)
#pragma unroll
                for (int m = 0; m < 4; ++m) { const int row = row0 + ai * HALF + m * 16;
#pragma unroll
                    for (int bj = 0; bj < 2; ++bj) { f32x4 v0 = acc[ai][bj][m][0], v1 = acc[ai][bj][m][1];
                        if (mode == 0) { v0[0] = silu_f(v0[0]); v0[1] = silu_f(v0[1]); v0[2] = silu_f(v0[2]); v0[3] = silu_f(v0[3]); v1[0] = silu_f(v1[0]); v1[1] = silu_f(v1[1]); v1[2] = silu_f(v1[2]); v1[3] = silu_f(v1[3]); }
                        else if (mode == 1) { v0 = v0 * QS_NSA; v1 = v1 * QS_NSA; }
                        bf16_t* dst = (mode == 2) ? kvnsa + (size_t)(2 * (pn - 22) + bj) * ((size_t)S * 128) + (size_t)row * 128 + wc * 32 + 8 * fq
                                                  : base + (size_t)row * 2048 + bj * HALF + wc * 32 + 8 * fq;
                        *(GAS u32x4*)dst = pk8(v0, v1); } }
        }
    }
};
struct EpiQup {
    static constexpr bool PERM = true, AFTER_DRAIN = false;
    unsigned char* ws;
    __device__ __forceinline__ void operator()(const f32x4 (&acc)[2][2][4][2], const Unit& u, int wr, int wc, int fr, int fq) const {
        const int pn = u.pn, row0 = u.pm * BM + wr * 64 + fr; bf16_t* qmla = (bf16_t*)(ws + WS_QMLA); const float* rstd_q = (const float*)(ws + WS_RSTD); const float* cosT = (const float*)(ws + WS_ROPE); const float* sinT = cosT + (size_t)S * 32;
#pragma unroll
        for (int ai = 0; ai < 2; ++ai)
#pragma unroll
            for (int m = 0; m < 4; ++m) { const int row = row0 + ai * HALF + m * 16;
                const float sc = QS_MLA * *(const GAS float*)(rstd_q + row);
#pragma unroll
                for (int bj = 0; bj < 2; ++bj) { const f32x4 v0 = acc[ai][bj][m][0] * sc, v1 = acc[ai][bj][m][1] * sc;
                    if (pn < 8) { *(GAS u32x4*)(qmla + (size_t)row * 3072 + (2 * pn + bj) * 192 + wc * 32 + 8 * fq) = pk8(v0, v1); }
                    else { const int cp = (pn - 8) * 256 + bj * HALF + wc * 32 + 8 * fq, head = cp >> 6, dl = cp & 63, i0 = dl >> 1;
                        const f32x4 cs = *(const GAS f32x4*)(cosT + (size_t)row * 32 + i0), sn = *(const GAS f32x4*)(sinT + (size_t)row * 32 + i0);
                        *(GAS u32x4*)(qmla + (size_t)row * 3072 + head * 192 + 128 + dl) = pk8(rope4(v0, cs[0], sn[0], cs[1], sn[1]), rope4(v1, cs[2], sn[2], cs[3], sn[3])); } }
                if (m & 1) asm volatile("" ::: "memory"); }
    }
};
struct EpiKvup {
    static constexpr bool PERM = true, AFTER_DRAIN = false;
    unsigned char* ws;
    __device__ __forceinline__ void operator()(const f32x4 (&acc)[2][2][4][2], const Unit& u, int wr, int wc, int fr, int fq) const {
        const int pn = u.pn, row0 = u.pm * BM + wr * 64 + fr;
#pragma unroll
        for (int ai = 0; ai < 2; ++ai)
#pragma unroll
            for (int m = 0; m < 4; ++m) { const int row = row0 + ai * HALF + m * 16;
                const float sc = *(const GAS float*)((const float*)(ws + WS_RSTD) + S + row); bf16_t* kmla = (bf16_t*)(ws + WS_KMLA); bf16_t* vmla = (bf16_t*)(ws + WS_VMLA);
                *(GAS u32x4*)(kmla + (size_t)row * 3072 + pn * 192 + wc * 32 + 8 * fq) = pk8(acc[ai][0][m][0] * sc, acc[ai][0][m][1] * sc);
                *(GAS u32x4*)(vmla + (size_t)row * 2048 + pn * 128 + wc * 32 + 8 * fq) = pk8(acc[ai][1][m][0] * sc, acc[ai][1][m][1] * sc);
                if (m & 1) asm volatile("" ::: "memory"); }
    }
};
struct EpiOut {
    static constexpr bool PERM = false, AFTER_DRAIN = false;
    const float* x; float* xv; const float* gate;
    __device__ __forceinline__ void operator()(const f32x4 (&acc)[2][2][4][2], const Unit& u, int wr, int wc, int fr, int fq) const {
        const int row0 = u.pm * BM + wr * 64 + fr, col0 = u.pn * BM + wc * 32 + 4 * fq;
        f32x4 gv[2][2];
#pragma unroll
        for (int bj = 0; bj < 2; ++bj)
#pragma unroll
            for (int n = 0; n < 2; ++n) gv[bj][n] = *(const GAS f32x4*)(gate + col0 + bj * HALF + n * 16);
#pragma unroll
        for (int ai = 0; ai < 2; ++ai)
#pragma unroll
            for (int m = 0; m < 4; ++m) { const size_t off = (size_t)(row0 + ai * HALF + m * 16) * D + col0;
#pragma unroll
                for (int bj = 0; bj < 2; ++bj)
#pragma unroll
                    for (int n = 0; n < 2; ++n) { const f32x4 xx = *(const GAS f32x4*)(x + off + bj * HALF + n * 16);
                        *(GAS f32x4*)(xv + off + bj * HALF + n * 16) = xx * DN_ALPHA + gv[bj][n] * acc[ai][bj][m][n]; }
                if (m & 1) asm volatile("" ::: "memory"); }
    }
};
template <class Epi, class Sched, bool ALIGN_EPI = false, bool SP2 = false>
__device__ __forceinline__ void gemm_phase(PG8_LAS unsigned char* lds, const Gemm g, const Sched& S, const Epi& E) {
    int tid_ = threadIdx.x; asm volatile("" : "+v"(tid_));
    const int tid = tid_, wid = __builtin_amdgcn_readfirstlane(tid >> 6), lane = tid & 63, wr = wid >> 2, wc = wid & 3, fr = lane & 15, fq = lane >> 4;
    const int K = g.K, nt = K / BK;
    unsigned voffA[2], voffB[2];
#pragma unroll
    for (int i = 0; i < 2; ++i) { int R, C; stage_rc(tid * 16 + i * 8192, R, C); const int Rb = Epi::PERM ? ((R & ~31) + perm32(R & 31)) : R;
        voffA[i] = (unsigned)(R * K + C) * 2u; voffB[i] = (unsigned)(Rb * K + C) * 2u; }
    const size_t kstep = (size_t)(BK * 2);
    const size_t hstep = (size_t)HALF * K * 2;
    const size_t tstep = 2 * hstep;
    const unsigned ldsw = (unsigned)wid * 1024u;
    const int aoff = lds_byte(wr * 64 + fr, fq * 8), boff = lds_byte(wc * 32 + fr, fq * 8);
#define PG8_SA(b, h) (((b) * 2 + (h)) * HTB)
#define PG8_SB(b, h) ((4 + (b) * 2 + (h)) * HTB)
#define PG8_STAGE(bufoff, gbase, voff) do { _Pragma("unroll") for (int _i = 0; _i < 2; ++_i) \
        __builtin_amdgcn_global_load_lds((const unsigned*)((const char*)(gbase) + (voff)[_i]), (PG8_LAS unsigned*)(lds + (bufoff) + ldsw + _i * 8192), 16, 0, 0); } while (0)
#define PG8_LDA(dst, b, h) do { _Pragma("unroll") for (int m = 0; m < 4; ++m) _Pragma("unroll") for (int k = 0; k < 2; ++k) dst[m][k] = *(const PG8_LAS bf16x8*)(lds + PG8_SA(b, h) + aoff + m * 2048 + k * 1024); } while (0)
#define PG8_LDB(dst, b, h) do { _Pragma("unroll") for (int n = 0; n < 2; ++n) _Pragma("unroll") for (int k = 0; k < 2; ++k) dst[n][k] = *(const PG8_LAS bf16x8*)(lds + PG8_SB(b, h) + boff + n * 2048 + k * 1024); } while (0)
#define PG8_MMA(ai, bj, At, Bt) do { __builtin_amdgcn_s_setprio(1); _Pragma("unroll") for (int m = 0; m < 4; ++m) _Pragma("unroll") for (int n = 0; n < 2; ++n) _Pragma("unroll") for (int k = 0; k < 2; ++k) \
        acc[ai][bj][m][n] = __builtin_amdgcn_mfma_f32_16x16x32_bf16(Bt[n][k], At[m][k], acc[ai][bj][m][n], 0, 0, 0); __builtin_amdgcn_s_setprio(0); } while (0)
#define PG8_WAIT_V(n) asm volatile("s_waitcnt vmcnt(" #n ")" ::: "memory")
#define PG8_WAIT_L(n) asm volatile("s_waitcnt lgkmcnt(" #n ")" ::: "memory")
#define PG8_BAR __builtin_amdgcn_s_barrier()
#define PG8_SCHED __builtin_amdgcn_sched_barrier(0)
    Unit cur, nxt; int ui = 0;
    if (!S.next(0, cur)) return;
    f32x4 acc[2][2][4][2];
#pragma unroll
    for (int a = 0; a < 2; ++a)
#pragma unroll
        for (int b = 0; b < 2; ++b)
#pragma unroll
            for (int m = 0; m < 4; ++m)
#pragma unroll
                for (int n = 0; n < 2; ++n) acc[a][b][m][n] = (f32x4){0.f, 0.f, 0.f, 0.f};
    bf16x8 At[4][2], B0[2][2], B1[2][2];
    const char* cA = (const char*)g.A + (size_t)cur.pm * tstep; const char* cB = (const char*)g.Bt + (size_t)cur.pn * tstep;
    S.a_ready(cur);
    if constexpr (SP2) {
        PG8_STAGE(PG8_SB(0, 0), cB, voffB); PG8_STAGE(PG8_SB(0, 1), cB + hstep, voffB); PG8_STAGE(PG8_SA(0, 0), cA, voffA); PG8_STAGE(PG8_SA(0, 1), cA + hstep, voffA);
        if (wr == 1) PG8_BAR;
        PG8_WAIT_V(2); PG8_BAR;
        PG8_STAGE(PG8_SB(1, 0), cB + kstep, voffB); PG8_STAGE(PG8_SA(1, 0), cA + kstep, voffA); PG8_STAGE(PG8_SB(1, 1), cB + hstep + kstep, voffB);
        PG8_WAIT_V(6); PG8_BAR;
    } else {
        PG8_STAGE(PG8_SB(0, 0), cB, voffB); PG8_STAGE(PG8_SA(0, 0), cA, voffA); PG8_STAGE(PG8_SB(0, 1), cB + hstep, voffB); PG8_STAGE(PG8_SA(0, 1), cA + hstep, voffA);
        if (wr == 1) PG8_BAR;
        PG8_WAIT_V(4); PG8_BAR;
        PG8_STAGE(PG8_SB(1, 0), cB + kstep, voffB); PG8_STAGE(PG8_SA(1, 0), cA + kstep, voffA); PG8_STAGE(PG8_SB(1, 1), cB + hstep + kstep, voffB);
        PG8_WAIT_V(6); PG8_BAR;
    }
    for (;;) {
        const bool has_next = S.next(ui + 1, nxt);
        const char* nA = has_next ? (const char*)g.A + (size_t)nxt.pm * tstep : cA; const char* nB = has_next ? (const char*)g.Bt + (size_t)nxt.pn * tstep : cB;
        for (int t = 0; t < nt; t += 2) {
            const bool last = (t == nt - 2);
            const char* a1 = cA + (size_t)(t + 1) * kstep;
            const char* a2 = last ? nA : cA + (size_t)(t + 2) * kstep; const char* b2 = last ? nB : cB + (size_t)(t + 2) * kstep;
            const char* a3 = a2 + kstep; const char* b3 = b2 + kstep;
            if (last && has_next) S.a_ready(nxt);
            if constexpr (SP2) {
            PG8_LDB(B0, 0, 0); PG8_LDB(B1, 0, 1); PG8_SCHED; PG8_LDA(At, 0, 0); PG8_STAGE(PG8_SA(1, 1), a1 + hstep, voffA);
            PG8_WAIT_V(8); PG8_WAIT_L(0); PG8_BAR; PG8_MMA(0, 0, At, B0); PG8_MMA(0, 1, At, B1); PG8_BAR; PG8_SCHED;
            PG8_LDA(At, 0, 1); PG8_STAGE(PG8_SB(0, 0), b2, voffB); PG8_STAGE(PG8_SB(0, 1), b2 + hstep, voffB); PG8_STAGE(PG8_SA(0, 0), a2, voffA);
            PG8_WAIT_V(8); PG8_WAIT_L(0); PG8_BAR; PG8_MMA(1, 0, At, B0); PG8_MMA(1, 1, At, B1); PG8_BAR; PG8_SCHED;
            PG8_LDB(B0, 1, 0); PG8_LDB(B1, 1, 1); PG8_SCHED; PG8_LDA(At, 1, 0); PG8_STAGE(PG8_SA(0, 1), a2 + hstep, voffA);
            PG8_WAIT_V(8); PG8_WAIT_L(0); PG8_BAR; PG8_MMA(0, 0, At, B0); PG8_MMA(0, 1, At, B1); PG8_BAR; PG8_SCHED;
            PG8_LDA(At, 1, 1); PG8_STAGE(PG8_SB(1, 0), b3, voffB); PG8_STAGE(PG8_SB(1, 1), b3 + hstep, voffB); PG8_STAGE(PG8_SA(1, 0), a3, voffA);
            PG8_WAIT_V(8); PG8_WAIT_L(0); PG8_BAR; PG8_MMA(1, 0, At, B0); PG8_MMA(1, 1, At, B1); PG8_BAR; PG8_SCHED;
            } else {
            PG8_LDB(B0, 0, 0); PG8_SCHED; PG8_LDA(At, 0, 0); PG8_STAGE(PG8_SA(1, 1), a1 + hstep, voffA);
            PG8_WAIT_L(8); PG8_BAR; PG8_WAIT_L(0); PG8_MMA(0, 0, At, B0); PG8_BAR; PG8_SCHED;
            PG8_LDB(B1, 0, 1); PG8_STAGE(PG8_SB(0, 0), b2, voffB);
            PG8_BAR; PG8_WAIT_L(0); PG8_MMA(0, 1, At, B1); PG8_BAR;
            PG8_LDA(At, 0, 1); PG8_STAGE(PG8_SA(0, 0), a2, voffA);
            PG8_BAR; PG8_WAIT_L(0); PG8_MMA(1, 0, At, B0); PG8_BAR; PG8_SCHED;
            PG8_STAGE(PG8_SB(0, 1), b2 + hstep, voffB);
            PG8_WAIT_V(6); PG8_BAR; PG8_MMA(1, 1, At, B1); PG8_BAR;
            PG8_LDB(B0, 1, 0); PG8_SCHED; PG8_LDA(At, 1, 0); PG8_STAGE(PG8_SA(0, 1), a2 + hstep, voffA);
            PG8_WAIT_L(8); PG8_BAR; PG8_WAIT_L(0); PG8_MMA(0, 0, At, B0); PG8_BAR; PG8_SCHED;
            PG8_LDB(B1, 1, 1); PG8_STAGE(PG8_SB(1, 0), b3, voffB);
            PG8_BAR; PG8_WAIT_L(0); PG8_MMA(0, 1, At, B1); PG8_BAR;
            PG8_LDA(At, 1, 1); PG8_STAGE(PG8_SA(1, 0), a3, voffA);
            PG8_BAR; PG8_WAIT_L(0); PG8_MMA(1, 0, At, B0); PG8_BAR; PG8_SCHED;
            PG8_STAGE(PG8_SB(1, 1), b3 + hstep, voffB);
            PG8_WAIT_V(6); PG8_BAR; PG8_MMA(1, 1, At, B1); PG8_BAR;
            }
        }
        if constexpr (ALIGN_EPI) { if (wr == 0) PG8_BAR; }
        if constexpr (!Epi::AFTER_DRAIN) { E(acc, cur, wr, wc, fr, fq); S.done(cur); }
        if (!has_next) break;
#pragma unroll
        for (int a = 0; a < 2; ++a)
#pragma unroll
            for (int b = 0; b < 2; ++b)
#pragma unroll
                for (int m = 0; m < 4; ++m)
#pragma unroll
                    for (int n = 0; n < 2; ++n) acc[a][b][m][n] = (f32x4){0.f, 0.f, 0.f, 0.f};
        cur = nxt; cA = nA; cB = nB; ++ui;
        if constexpr (ALIGN_EPI) { if (wr == 1) PG8_BAR; }
    }
    PG8_WAIT_V(0);
    if constexpr (!ALIGN_EPI) { if (wr == 0) PG8_BAR; }
    PG8_BAR;
    if constexpr (Epi::AFTER_DRAIN) { E.fused(acc, cur, wr, wc, fr, fq, lds, wid, lane); S.done(cur); }
#undef PG8_SA
#undef PG8_SB
#undef PG8_STAGE
#undef PG8_LDA
#undef PG8_LDB
#undef PG8_MMA
#undef PG8_WAIT_V
#undef PG8_WAIT_L
#undef PG8_BAR
#undef PG8_SCHED
}
}
namespace att {
constexpr int KS_M = 400, KS_N = 272, VS = 320;
constexpr int MLA_KB = 64 * KS_M, NSA_KB = 64 * KS_N, VB = 64 * VS;
constexpr int N_IMP = 2 * NSA_KB + 2 * VB;
constexpr int N_PART = N_IMP + 32768;
constexpr int N_PARTB = 8 * 32 * 17 * 4;
constexpr int N_SELM = N_PART + 2 * N_PARTB;
constexpr int N_ULIST = N_SELM + 1024;
constexpr int N_CARRY = N_ULIST + 1024;
constexpr int N_NTS = N_CARRY + 256;
static_assert(N_NTS + 16 <= MISC_OFF, "NSA LDS map");
static_assert(2 * MLA_KB + 2 * VB <= 131072, "MLA LDS map");

#define MFMA32(a, b, c) __builtin_amdgcn_mfma_f32_32x32x16_bf16((a), (b), (c), 0, 0, 0)
__device__ __forceinline__ float swapmax(float v) { auto rr = __builtin_amdgcn_permlane32_swap(__float_as_uint(v), __float_as_uint(v), false, false); return fmaxf(__uint_as_float(rr[0]), __uint_as_float(rr[1])); }
__device__ __forceinline__ float swapsum(float v) { auto rr = __builtin_amdgcn_permlane32_swap(__float_as_uint(v), __float_as_uint(v), false, false); return __uint_as_float(rr[0]) + __uint_as_float(rr[1]); }
template <int SIDX> __device__ __forceinline__ bf16x8 packp(const f32x16& p) {
    f32x8 t = {p[8 * SIDX + 0], p[8 * SIDX + 1], p[8 * SIDX + 2], p[8 * SIDX + 3], p[8 * SIDX + 4], p[8 * SIDX + 5], p[8 * SIDX + 6], p[8 * SIDX + 7]};
    return __builtin_bit_cast(bf16x8, __builtin_convertvector(t, bf16x8v));
}
template <int NDC, int KS> __device__ __forceinline__ void qk_tile(f32x16& p0, f32x16& p1, const LAS unsigned char* kl, const bf16x8 (&q)[NDC]) {
#pragma unroll
    for (int i = 0; i < 16; ++i) { p0[i] = 0.f; p1[i] = 0.f; }
#pragma unroll
    for (int d0 = 0; d0 < NDC; ++d0) {
        const bf16x8 a0 = *(const LAS bf16x8*)(kl + d0 * 32);
        const bf16x8 a1 = *(const LAS bf16x8*)(kl + 32 * KS + d0 * 32);
        p0 = MFMA32(a0, q[d0], p0); p1 = MFMA32(a1, q[d0], p1);
        if ((d0 & 3) == 3) __builtin_amdgcn_sched_barrier(0);
    }
}
__device__ __forceinline__ void pv_tile(f32x16 (&o)[4], const bf16x8 (&pb)[4], const LAS unsigned char* vl) {
#pragma unroll
    for (int d0 = 0; d0 < 4; ++d0) {
#pragma unroll
        for (int s = 0; s < 4; ++s) {
            const s16x4 t0 = __builtin_amdgcn_ds_read_tr16_b64_v4i16((LAS s16x4*)(vl + s * 16 * VS + d0 * 64));
            const s16x4 t1 = __builtin_amdgcn_ds_read_tr16_b64_v4i16((LAS s16x4*)(vl + s * 16 * VS + 8 * VS + d0 * 64));
            const bf16x8 vf = {t0[0], t0[1], t0[2], t0[3], t1[0], t1[1], t1[2], t1[3]};
            o[d0] = MFMA32(vf, pb[s], o[d0]);
        }
        __builtin_amdgcn_sched_barrier(0);
    }
}
__device__ __forceinline__ void online_sm(f32x16& p0, f32x16& p1, float& m, float& l, f32x16 (&o)[4]) {
    float tm = p0[0];
#pragma unroll
    for (int r = 1; r < 16; ++r) tm = fmaxf(tm, p0[r]);
#pragma unroll
    for (int r = 0; r < 16; ++r) tm = fmaxf(tm, p1[r]);
    tm = swapmax(tm);
    const float mn = fmaxf(m, tm);
    const float alpha = __builtin_amdgcn_exp2f(m - mn);
    m = mn;
    float ps = 0.f;
#pragma unroll
    for (int r = 0; r < 16; ++r) { p0[r] = __builtin_amdgcn_exp2f(p0[r] - mn); ps += p0[r]; }
#pragma unroll
    for (int r = 0; r < 16; ++r) { p1[r] = __builtin_amdgcn_exp2f(p1[r] - mn); ps += p1[r]; }
    ps = swapsum(ps);
    l = l * alpha + ps;
    if (!__all(alpha == 1.f)) {
#pragma unroll
        for (int d = 0; d < 4; ++d)
#pragma unroll
            for (int r = 0; r < 16; ++r) o[d][r] *= alpha;
    }
}

struct MlaPtrs { const bf16* Q; const bf16* K; const bf16* V; const bf16* Z; bf16* O; };
__device__ __forceinline__ void mla_unit(LAS unsigned char* lds, const MlaPtrs& P, int head, int qb, int tid_in, int wave, int lane_in) {
    int tid = tid_in; asm volatile("" : "+v"(tid)); const int lane = tid & 63; (void)lane_in;
    const int r32 = lane & 31, hi = lane >> 5;
    const int q0 = qb * 256, qw = q0 + wave * 32, tq = qw + r32;
    bf16x8 q[12];
    { const bf16* qp = P.Q + (size_t)tq * 3072 + head * 192 + hi * 8;
#pragma unroll
      for (int d0 = 0; d0 < 12; ++d0) q[d0] = *(const GAS bf16x8*)(qp + d0 * 16); }
    const int NT = 4 * (qb + 1);
    const int srow = tid >> 3, sc8 = tid & 7;
    const unsigned char* kg = (const unsigned char*)P.K + (size_t)head * 384 + (size_t)srow * 6144 + sc8 * 16;
    const unsigned char* vg = (const unsigned char*)P.V + (size_t)head * 256 + (size_t)srow * 4096 + sc8 * 16;
    LAS unsigned char* kst = lds + srow * KS_M + sc8 * 16;
    LAS unsigned char* vst = lds + 2 * MLA_KB + srow * VS + sc8 * 16;
    const LAS unsigned char* kl = lds + r32 * KS_M + hi * 16;
    const LAS unsigned char* vl = lds + 2 * MLA_KB + (4 * hi + ((lane & 15) >> 2)) * VS + (16 * ((lane >> 4) & 1) + 4 * (lane & 3)) * 2;
    u32x4 sk0, sk1, sk2, sv0, sv1;
#define MLA_LOAD(j) do { const unsigned char* kp_ = kg + (size_t)(j) * (64 * 6144); const unsigned char* vp_ = vg + (size_t)(j) * (64 * 4096); \
        sk0 = *(const GAS u32x4*)(kp_); sk1 = *(const GAS u32x4*)(kp_ + 128); sk2 = *(const GAS u32x4*)(kp_ + 256); sv0 = *(const GAS u32x4*)(vp_); sv1 = *(const GAS u32x4*)(vp_ + 128); } while (0)
#define MLA_STORE(b) do { LAS unsigned char* kd_ = kst + (b) * MLA_KB; LAS unsigned char* vd_ = vst + (b) * VB; \
        *(LAS u32x4*)(kd_) = sk0; *(LAS u32x4*)(kd_ + 128) = sk1; *(LAS u32x4*)(kd_ + 256) = sk2; *(LAS u32x4*)(vd_) = sv0; *(LAS u32x4*)(vd_ + 128) = sv1; } while (0)
    MLA_LOAD(0); MLA_STORE(0);
    __syncthreads();
    float m = -1e30f, l = 0.f; f32x16 o[4];
#pragma unroll
    for (int d = 0; d < 4; ++d)
#pragma unroll
        for (int r = 0; r < 16; ++r) o[d][r] = 0.f;
    for (int j = 0; j < NT; ++j) {
        const int buf = j & 1, kb = 64 * j;
        if (j + 1 < NT) MLA_LOAD(j + 1);
        if (kb <= qw + 31) {
            f32x16 p0, p1;
            qk_tile<12, KS_M>(p0, p1, kl + buf * MLA_KB, q);
            if (kb + 63 > qw) {
                const int dq = tq - kb - 4 * hi;
#pragma unroll
                for (int r = 0; r < 16; ++r) { const int c = (r & 3) + 8 * (r >> 2);
                    if (c > dq) p0[r] = -__builtin_inff();
                    if (c + 32 > dq) p1[r] = -__builtin_inff(); }
            }
            online_sm(p0, p1, m, l, o);
            const bf16x8 pb[4] = {packp<0>(p0), packp<1>(p0), packp<0>(p1), packp<1>(p1)};
            pv_tile(o, pb, vl + buf * VB);
        }
        if (j + 1 < NT) MLA_STORE(buf ^ 1);
        __syncthreads();
    }
#undef MLA_LOAD
#undef MLA_STORE
    const float inv = 1.f / l;
    const bf16* zp = P.Z + (size_t)tq * 2048 + head * 128 + 4 * hi;
    bf16* op = P.O + (size_t)tq * 4096 + head * 128 + 4 * hi;
#pragma unroll
    for (int d0 = 0; d0 < 4; ++d0)
#pragma unroll
        for (int rg = 0; rg < 4; ++rg) { const int dim = 32 * d0 + 8 * rg;
            const u32x2 z = *(const GAS u32x2*)(zp + dim);
            u32x2 w; w.x = pk2(o[d0][4 * rg + 0] * inv * bflo(z.x), o[d0][4 * rg + 1] * inv * bfhi(z.x)); w.y = pk2(o[d0][4 * rg + 2] * inv * bflo(z.y), o[d0][4 * rg + 3] * inv * bfhi(z.y));
            *(GAS u32x2*)(op + dim) = w; }
}

struct NsaPtrs { const bf16* Q; const bf16* KV; const bf16* KC; const bf16* VC; const bf16* Z; const float* G; bf16* O; float* scr; };
template <int MODE>
__device__ __forceinline__ void nsa_loop(LAS unsigned char* lds, const unsigned char* kbase, const unsigned char* vbase, int ntiles, int jlo,
                                         const bf16x8 (&q)[8], int t, float slope2, float& m, float& l, f32x16 (&o)[4], float invl, int tid, int wave, int lane) {
    constexpr bool HASV = MODE != 0;
    const int r32 = lane & 31, hi = lane >> 5;
    const int srow = tid >> 3, sc8 = tid & 7;
    const unsigned soff = srow * 256 + sc8 * 16;
    LAS unsigned char* kst = lds + srow * KS_N + sc8 * 16;
    LAS unsigned char* vst = lds + 2 * NSA_KB + srow * VS + sc8 * 16;
    const LAS unsigned char* kl = lds + r32 * KS_N + hi * 16;
    const LAS unsigned char* vl = lds + 2 * NSA_KB + (4 * hi + ((lane & 15) >> 2)) * VS + (16 * ((lane >> 4) & 1) + 4 * (lane & 3)) * 2;
    const LAS int* ulist = (const LAS int*)(lds + N_ULIST);
    const LAS unsigned* selm = (const LAS unsigned*)(lds + N_SELM);
    LAS float* partA = (LAS float*)(lds + N_PART); LAS float* partB = (LAS float*)(lds + N_PART + N_PARTB);
    LAS float* imp = (LAS float*)(lds + N_IMP); LAS float* carry = (LAS float*)(lds + N_CARRY);
    if (ntiles <= 0) return;
    u32x4 sk0, sk1, sv0, sv1;
#define NSA_TROW(j) (MODE == 2 ? 64 * __builtin_amdgcn_readfirstlane(ulist[(j)]) : 64 * (jlo + (j)))
#define NSA_LOAD(j) do { const size_t ro_ = (size_t)NSA_TROW(j) * 256 + soff; \
        sk0 = *(const GAS u32x4*)(kbase + ro_); sk1 = *(const GAS u32x4*)(kbase + ro_ + 128); \
        if (HASV) { sv0 = *(const GAS u32x4*)(vbase + ro_); sv1 = *(const GAS u32x4*)(vbase + ro_ + 128); } } while (0)
#define NSA_STORE(b) do { LAS unsigned char* kd_ = kst + (b) * NSA_KB; *(LAS u32x4*)(kd_) = sk0; *(LAS u32x4*)(kd_ + 128) = sk1; \
        if (HASV) { LAS unsigned char* vd_ = vst + (b) * VB; *(LAS u32x4*)(vd_) = sv0; *(LAS u32x4*)(vd_ + 128) = sv1; } } while (0)
    NSA_LOAD(0); NSA_STORE(0);
    __syncthreads();
    for (int j = 0; j < ntiles; ++j) {
        const int buf = j & 1;
        if (MODE != 1 && j + 1 < ntiles) NSA_LOAD(j + 1);
        f32x16 p0, p1;
        qk_tile<8, KS_N>(p0, p1, kl + buf * NSA_KB, q);
        const int trow = NSA_TROW(j);
        constexpr int PSTEP = (MODE <= 1) ? 16 : 1;
        const int pstart = (MODE <= 1) ? 16 * trow + 31 : trow;
        const int db = t - pstart - PSTEP * 4 * hi;
        const float nslope = -slope2;
        bool selb = true;
        if (MODE == 2) { const int b = trow >> 6; selb = ((selm[r32 * 8 + (b >> 5)] >> (b & 31)) & 1u) != 0u; }
        const unsigned W = (MODE == 3) ? 512u : 0x7fffffffu;
#pragma unroll
        for (int r = 0; r < 16; ++r) { const int c = PSTEP * ((r & 3) + 8 * (r >> 2));
            const int e0 = db - c, e1 = db - c - 32 * PSTEP;
            const float s0 = __builtin_fmaf(nslope, (float)e0, p0[r]);
            const float s1 = __builtin_fmaf(nslope, (float)e1, p1[r]);
            p0[r] = (selb && (unsigned)e0 < W) ? s0 : -__builtin_inff();
            p1[r] = (selb && (unsigned)e1 < W) ? s1 : -__builtin_inff(); }
        if (MODE == 0) {
            float tm = p0[0];
#pragma unroll
            for (int r = 1; r < 16; ++r) tm = fmaxf(tm, p0[r]);
#pragma unroll
            for (int r = 0; r < 16; ++r) tm = fmaxf(tm, p1[r]);
            tm = swapmax(tm);
            const float mn = fmaxf(m, tm); const float alpha = __builtin_amdgcn_exp2f(m - mn); m = mn;
            float ps = 0.f;
#pragma unroll
            for (int r = 0; r < 16; ++r) ps += __builtin_amdgcn_exp2f(p0[r] - mn) + __builtin_amdgcn_exp2f(p1[r] - mn);
            l = l * alpha + swapsum(ps);
        } else if (MODE == 1) {
#pragma unroll
            for (int r = 0; r < 16; ++r) { p0[r] = __builtin_amdgcn_exp2f(p0[r] - m) * invl; p1[r] = __builtin_amdgcn_exp2f(p1[r] - m) * invl; }
            LAS float* pa = partA + (wave * 32 + r32) * 17 + hi; LAS float* pbm = partB + (wave * 32 + r32) * 17 + hi;
#pragma unroll
            for (int rg = 0; rg < 4; ++rg) {
                pa[2 * rg] = (p0[4 * rg] + p0[4 * rg + 1]) + (p0[4 * rg + 2] + p0[4 * rg + 3]); pbm[2 * rg] = p0[4 * rg + 3];
                pa[8 + 2 * rg] = (p1[4 * rg] + p1[4 * rg + 1]) + (p1[4 * rg + 2] + p1[4 * rg + 3]); pbm[8 + 2 * rg] = p1[4 * rg + 3]; }
            const bf16x8 pb[4] = {packp<0>(p0), packp<1>(p0), packp<0>(p1), packp<1>(p1)};
            pv_tile(o, pb, vl + buf * VB);
            __syncthreads();
            { const int qq = tid >> 4, jl = tid & 15; float a = 0.f, bp = 0.f, bl = 0.f;
#pragma unroll
              for (int w = 0; w < 8; ++w) { a += partA[(w * 32 + qq) * 17 + jl]; bl += partB[(w * 32 + qq) * 17 + jl]; }
              if (jl > 0) {
#pragma unroll
                  for (int w = 0; w < 8; ++w) bp += partB[(w * 32 + qq) * 17 + jl - 1];
              } else bp = (j > 0) ? carry[((j - 1) & 1) * 32 + qq] : 0.f;
              imp[qq * 256 + 16 * j + jl] = a + bp;
              if (jl == 15) carry[(j & 1) * 32 + qq] = bl; }
        } else {
            online_sm(p0, p1, m, l, o);
            const bf16x8 pb[4] = {packp<0>(p0), packp<1>(p0), packp<0>(p1), packp<1>(p1)};
            pv_tile(o, pb, vl + buf * VB);
        }
        if (MODE == 1 && j + 1 < ntiles) NSA_LOAD(j + 1);
        if (j + 1 < ntiles) NSA_STORE(buf ^ 1);
        __syncthreads();
    }
#undef NSA_TROW
#undef NSA_LOAD
#undef NSA_STORE
}
__device__ __forceinline__ void nsa_topk(const LAS float* improw, LAS unsigned* selrow, int cur, int lane) {
    unsigned key[4]; bool sel[4];
    int nforced = 0;
#pragma unroll
    for (int k = 0; k < 4; ++k) { const int j = lane + 64 * k;
        const bool forced = (j == 0) || (j == cur) || (j == cur - 1);
        const bool causal = j <= cur;
        sel[k] = forced;
        key[k] = (causal && !forced) ? (__float_as_uint(improw[j]) + 1u) : 0u; }
    nforced = 1 + (cur >= 1 ? 1 : 0) + (cur >= 2 ? 1 : 0);
    const int want = 16 - nforced;
    for (int it = 0; it < want; ++it) {
        unsigned bk = key[0]; int bj = lane;
#pragma unroll
        for (int k = 1; k < 4; ++k) { if (key[k] > bk) { bk = key[k]; bj = lane + 64 * k; } }
        unsigned long long best = ((unsigned long long)bk << 32) | (unsigned)(0xffffffffu - (unsigned)bj);
#pragma unroll
        for (int off = 1; off < 64; off <<= 1) {
            const unsigned lo = __shfl_xor((unsigned)best, off), hiw = __shfl_xor((unsigned)(best >> 32), off);
            const unsigned long long other = ((unsigned long long)hiw << 32) | lo;
            best = other > best ? other : best; }
        if ((unsigned)(best >> 32) == 0u) break;
        const int wj = (int)(0xffffffffu - (unsigned)best);
#pragma unroll
        for (int k = 0; k < 4; ++k) if (wj == lane + 64 * k) { key[k] = 0u; sel[k] = true; }
    }
#pragma unroll
    for (int k = 0; k < 4; ++k) { const unsigned long long bm = __ballot(sel[k]);
        if (lane == 0) { selrow[2 * k] = (unsigned)bm; selrow[2 * k + 1] = (unsigned)(bm >> 32); } }
}
__device__ __forceinline__ int nsa_opaque(int v) { asm volatile("" : "+v"(v)); return v; }
__device__ __forceinline__ void nsa_unit(LAS unsigned char* lds, const NsaPtrs& P, int g, int qblk, int tid_in, int wave, int lane_in, int cu) {
    int tid = tid_in; asm volatile("" : "+v"(tid));
    const int lane = tid & 63; (void)lane_in;
    const int r32 = lane & 31, hi = lane >> 5;
    const int hh = 8 * g + wave, t0 = 32 * qblk, t = t0 + r32;
    const float slope2 = __builtin_amdgcn_exp2f(-0.5f * (float)(hh + 1)) * LOG2E;
    bf16x8 q[8];
    { const bf16* qp = P.Q + (size_t)t * 2048 + hh * 128 + hi * 8;
#pragma unroll
      for (int d0 = 0; d0 < 8; ++d0) q[d0] = *(const GAS bf16x8*)(qp + d0 * 16); }
#define NSA_SCR() ((GAS f32x4*)(P.scr + ((size_t)(cu * 8 + wave) * 16) * 256) + nsa_opaque(lane))
    const size_t CH = (size_t)S * 128 * 2;
    f32x16 o[4]; float m, l;
#define NSA_ZERO_O() do { _Pragma("unroll") for (int d_ = 0; d_ < 4; ++d_) _Pragma("unroll") for (int r_ = 0; r_ < 16; ++r_) o[d_][r_] = 0.f; } while (0)
    const int ncv = 2 * qblk + 1, ntc = (ncv + 63) >> 6;
    const unsigned char* kc = (const unsigned char*)P.KC + (size_t)g * 1024 * 256; const unsigned char* vc = (const unsigned char*)P.VC + (size_t)g * 1024 * 256;
    m = -1e30f; l = 0.f; NSA_ZERO_O();
    nsa_loop<0>(lds, kc, vc, ntc, 0, q, t, slope2, m, l, o, 0.f, tid, wave, lane);
    const float invl = l > 0.f ? 1.f / l : 0.f;
    nsa_loop<1>(lds, kc, vc, ntc, 0, q, t, slope2, m, l, o, invl, tid, wave, lane);
    { const float g_c = P.G[(size_t)t * 48 + hh]; GAS f32x4* scr = NSA_SCR();
#pragma unroll
    for (int d0 = 0; d0 < 4; ++d0)
#pragma unroll
        for (int rg = 0; rg < 4; ++rg) { f32x4 v = {o[d0][4 * rg] * g_c, o[d0][4 * rg + 1] * g_c, o[d0][4 * rg + 2] * g_c, o[d0][4 * rg + 3] * g_c}; scr[(d0 * 4 + rg) * 64] = v; } }
    const int cur = t0 >> 6;
    LAS unsigned* selm = (LAS unsigned*)(lds + N_SELM);
    for (int i = 0; i < 4; ++i) { const int qq = 4 * wave + i; nsa_topk((const LAS float*)(lds + N_IMP) + qq * 256, selm + qq * 8, cur, lane); }
    __syncthreads();
    if (wave == 0) {
        LAS int* ulist = (LAS int*)(lds + N_ULIST); int n = 0;
        for (int k = 0; k < 8; ++k) { unsigned u = (lane < 32) ? selm[lane * 8 + k] : 0u;
#pragma unroll
            for (int off = 1; off < 32; off <<= 1) u |= __shfl_xor(u, off);
            u = __builtin_amdgcn_readfirstlane(u);
            while (u) { const int b = __builtin_ctz(u); u &= u - 1u; if (lane == 0) ulist[n] = 32 * k + b; ++n; } }
        if (lane == 0) *(LAS int*)(lds + N_NTS) = n;
    }
    __syncthreads();
    const int nts = __builtin_amdgcn_readfirstlane(*(const LAS int*)(lds + N_NTS));
    m = -1e30f; l = 0.f; NSA_ZERO_O();
    nsa_loop<2>(lds, (const unsigned char*)P.KV + (size_t)(4 + g) * CH, (const unsigned char*)P.KV + (size_t)(6 + g) * CH, nts, 0, q, t, slope2, m, l, o, 0.f, tid, wave, lane);
    { const float f = P.G[(size_t)t * 48 + 16 + hh] / l; GAS f32x4* scr = NSA_SCR();
#pragma unroll
      for (int d0 = 0; d0 < 4; ++d0)
#pragma unroll
          for (int rg = 0; rg < 4; ++rg) { f32x4 v = scr[(d0 * 4 + rg) * 64]; v[0] += o[d0][4 * rg] * f; v[1] += o[d0][4 * rg + 1] * f; v[2] += o[d0][4 * rg + 2] * f; v[3] += o[d0][4 * rg + 3] * f; scr[(d0 * 4 + rg) * 64] = v; } }
    const int jlo = (t0 > 511 ? t0 - 511 : 0) >> 6, jhi = (t0 + 31) >> 6;
    m = -1e30f; l = 0.f; NSA_ZERO_O();
    nsa_loop<3>(lds, (const unsigned char*)P.KV + (size_t)(8 + g) * CH, (const unsigned char*)P.KV + (size_t)(10 + g) * CH, jhi - jlo + 1, jlo, q, t, slope2, m, l, o, 0.f, tid, wave, lane);
    { const float f = P.G[(size_t)t * 48 + 32 + hh] / l; GAS f32x4* scr = NSA_SCR();
      const bf16* zp = P.Z + (size_t)t * 2048 + hh * 128 + 4 * hi;
      bf16* op = P.O + (size_t)t * 4096 + 2048 + hh * 128 + 4 * hi;
#pragma unroll
      for (int d0 = 0; d0 < 4; ++d0)
#pragma unroll
          for (int rg = 0; rg < 4; ++rg) { const int dim = 32 * d0 + 8 * rg; const f32x4 a = scr[(d0 * 4 + rg) * 64];
              const u32x2 z = *(const GAS u32x2*)(zp + dim);
              u32x2 w; w.x = pk2((a[0] + o[d0][4 * rg] * f) * bflo(z.x), (a[1] + o[d0][4 * rg + 1] * f) * bfhi(z.x)); w.y = pk2((a[2] + o[d0][4 * rg + 2] * f) * bflo(z.y), (a[3] + o[d0][4 * rg + 3] * f) * bfhi(z.y));
              *(GAS u32x2*)(op + dim) = w; } }
#undef NSA_ZERO_O
#undef NSA_SCR
}
struct CmpPtrs { const bf16* KV; const bf16* W1; const bf16* W2; const float* cbp; bf16* KC; bf16* VC; };
__device__ __forceinline__ void cmp_unit(LAS unsigned char* lds, const CmpPtrs& P, int kv, int g, int tile, int tid, int wave, int lane) {
    const int fr = lane & 15, fq = lane >> 4, n = 16 * tile + fr;
    const bf16* A = P.KV + (size_t)(kv * 2 + g) * ((size_t)S * 128) + (size_t)n * 2048 + 8 * fq;
    const bf16* B1 = P.W1 + (size_t)kv * 128 * 4096 + (size_t)(16 * wave + fr) * 4096 + 8 * fq;
    f32x4 acc = {0.f, 0.f, 0.f, 0.f};
#pragma unroll 8
    for (int s = 0; s < 128; ++s) {
        const bf16x8 a = *(const GAS bf16x8*)(A + 32 * s), b = *(const GAS bf16x8*)(B1 + 32 * s);
        acc = __builtin_amdgcn_mfma_f32_16x16x32_bf16(a, b, acc, 0, 0, 0);
    }
    float bias = 0.f;
#pragma unroll
    for (int c = 0; c < 16; ++c) bias += P.cbp[(size_t)(kv * 16 + c) * 128 + 16 * wave + fr];
    LAS bf16* hid = (LAS bf16*)lds;
#pragma unroll
    for (int i = 0; i < 4; ++i) hid[(4 * fq + i) * 136 + 16 * wave + fr] = (bf16)(pk2(silu_f(acc[i] + bias), 0.f) & 0xffffu);
    __syncthreads();
    const bf16* B2 = P.W2 + (size_t)kv * 128 * 128 + (size_t)(16 * wave + fr) * 128 + 8 * fq;
    f32x4 acc2 = {0.f, 0.f, 0.f, 0.f};
#pragma unroll
    for (int s = 0; s < 4; ++s) {
        const bf16x8 a = *(const LAS bf16x8*)(hid + fr * 136 + 32 * s + 8 * fq), b = *(const GAS bf16x8*)(B2 + 32 * s);
        acc2 = __builtin_amdgcn_mfma_f32_16x16x32_bf16(a, b, acc2, 0, 0, 0);
    }
    bf16* out = (kv ? P.VC : P.KC) + (size_t)g * 1024 * 128;
#pragma unroll
    for (int i = 0; i < 4; ++i) { const int nn = 16 * tile + 4 * fq + i; out[(size_t)nn * 128 + 16 * wave + fr] = (nn < 1023) ? (bf16)(pk2(acc2[i], 0.f) & 0xffffu) : (bf16)0; }
    __syncthreads();
}
}
constexpr int PPL = 6;
constexpr int N_PHASES = 2 + PPL * DEPTH;
struct Args { const void* in[16]; float* out; unsigned char* ws; int ph_lo, ph_hi; };
#define WSP(T, off) ((T*)(ws + (off)))
#define VCU() ((gridDim.x % 8 == 0) ? (int)((blockIdx.x % 8) * (gridDim.x / 8) + blockIdx.x / 8) : (int)blockIdx.x)
__global__ void __launch_bounds__(NTHR, 2) mk_fwd(const Args args) {
    extern __shared__ __attribute__((aligned(16))) unsigned char lds_raw[];
    LAS unsigned char* lds = (LAS unsigned char*)lds_raw;
    if (threadIdx.x < 32) ((volatile LAS unsigned*)(lds + MISC_OFF))[threadIdx.x] = 0u;
    __syncthreads();
    XcdBarrier bar = xcd_barrier_post((unsigned*)(args.ws + WS_CTL) + CW_BAR, (volatile LAS unsigned*)(lds + MISC_OFF) + 8);
#define IN(k) (args.ph_lo <= (k) && (k) < args.ph_hi)
#define SEAM(k) do { if (IN(k) && IN((k) + 1)) xcd_barrier(bar); } while (0)
#define PHASE_REGS int tid_ = threadIdx.x; asm volatile("" : "+v"(tid_)); const int tid = tid_, lane = tid & 63, wave = __builtin_amdgcn_readfirstlane(tid >> 6); \
    unsigned char* ws = args.ws; asm volatile("" : "+s"(ws)); (void)tid; (void)lane; (void)wave

    if (IN(0)) {
        PHASE_REGS; const int G = gridDim.x, vcu = VCU();
        p0_mod_gemv((const float*)args.in[1], (const float*)args.in[3], (const float*)args.in[4], WSP(float, WS_MOD), (LAS float*)lds, vcu, G);
        p0_cmpbias((const float*)args.in[10], (const float*)args.in[11], WSP(float, WS_CBP), (LAS float*)lds, (vcu + G / 2) % G, G);
        p0_rope((const int*)args.in[2], WSP(float, WS_ROPE), WSP(float, WS_ROPE) + (size_t)S * 32, vcu * NTHR + tid, G * NTHR);
        const P0In I{(const float*)args.in[5], (const float*)args.in[6], (const float*)args.in[7], (const float*)args.in[8], (const float*)args.in[9], (const float*)args.in[11], (const float*)args.in[12], (const float*)args.in[13]};
#ifndef DIS_CONV
        p0_convert(I, ws, (LAS float*)(lds + wave * 16384), vcu * NWAVES + wave, G * NWAVES, lane);
#endif
    }
    SEAM(0);
    if (IN(1)) { PHASE_REGS; modulate_rows((const float*)args.in[0], WSP(bf16, WS_H), WSP(float, WS_MOD), VCU() * NWAVES + wave, gridDim.x * NWAVES, lane); }
    SEAM(1);
    for (int l = 0; l < DEPTH; ++l) {
        const int pb = 2 + PPL * l;
        if (IN(pb + 0)) {
            PHASE_REGS;
            pg8::Gemm gg{WSP(bf16, WS_H), (const bf16*)(ws + WS_W + (size_t)l * W_LSTRIDE + W_IN), S, NIN, D}; pg8::StaticOrder SO; SO.init(S, NIN, gridDim.x, blockIdx.x);
            const pg8::EpiIn E{ws};
#ifndef DIS_IN
            pg8::gemm_phase<pg8::EpiIn, pg8::StaticOrder, true, true>(lds, gg, SO, E);
#endif
        }
        SEAM(pb + 0);
        if (IN(pb + 1)) {
            PHASE_REGS; const int G = gridDim.x, vcu = VCU();
            rstd_rows(WSP(float, WS_RSQQ), WSP(float, WS_RSQKV), WSP(float, WS_RSTD), WSP(float, WS_RSTD) + S, vcu * NTHR + tid, G * NTHR);
            const att::CmpPtrs CP{WSP(bf16, WS_KVNSA), (const bf16*)(ws + WS_W + (size_t)l * W_LSTRIDE + W_C1), (const bf16*)(ws + WS_W + (size_t)l * W_LSTRIDE + W_C2),
                                  WSP(float, WS_CBP) + (size_t)l * 2 * 16 * 128, WSP(bf16, WS_KCMP), WSP(bf16, WS_VCMP)};
#ifndef DIS_CMP
            for (int u = vcu; u < 256; u += G) att::cmp_unit(lds, CP, u & 1, (u >> 1) & 1, u >> 2, tid, wave, lane);
#endif
        }
        SEAM(pb + 1);
        if (IN(pb + 2)) {
            PHASE_REGS;
            { pg8::Gemm gg{WSP(bf16, WS_QLAT), (const bf16*)(ws + WS_W + (size_t)l * W_LSTRIDE + W_QUP), S, 3072, 768}; pg8::StaticOrder SO; SO.init(S, 3072, gridDim.x, blockIdx.x);
              const pg8::EpiQup E{ws};
#ifndef DIS_QUP
              pg8::gemm_phase<pg8::EpiQup, pg8::StaticOrder, true, true>(lds, gg, SO, E);
#endif
            }
            { pg8::Gemm gg{WSP(bf16, WS_KVLAT), (const bf16*)(ws + WS_W + (size_t)l * W_LSTRIDE + W_KVUP), S, 4096, 512}; pg8::StaticOrder SO; SO.init(S, 4096, gridDim.x, blockIdx.x);
              const pg8::EpiKvup E{ws};
#ifndef DIS_KVUP
              pg8::gemm_phase<pg8::EpiKvup, pg8::StaticOrder, true, true>(lds, gg, SO, E);
#endif
            }
        }
        SEAM(pb + 2);
        if (IN(pb + 3)) {
            PHASE_REGS; const int G = gridDim.x, vcu = VCU();
            { const att::MlaPtrs MP{WSP(bf16, WS_QMLA), WSP(bf16, WS_KMLA), WSP(bf16, WS_VMLA), WSP(bf16, WS_ZMLA), WSP(bf16, WS_H)};
              for (int pu = vcu; pu < 512; pu += G) { const int head = pu >> 5, pr = pu & 31;
#ifndef DIS_MLA
                  att::mla_unit(lds, MP, head, 63 - pr, tid, wave, lane);
                  att::mla_unit(lds, MP, head, pr, tid, wave, lane);
#endif
              } }
            { const att::NsaPtrs NP{WSP(bf16, WS_QNSA), WSP(bf16, WS_KVNSA), WSP(bf16, WS_KCMP), WSP(bf16, WS_VCMP), WSP(bf16, WS_ZNSA), WSP(float, WS_GNSA), WSP(bf16, WS_H), WSP(float, WS_OSCR)};
#ifndef DIS_NSA
              for (int u = vcu; u < 1024; u += G) att::nsa_unit(lds, NP, u & 1, u >> 1, tid, wave, lane, blockIdx.x);
#endif
            }
        }
        SEAM(pb + 3);
        if (IN(pb + 4)) {
            PHASE_REGS;
            pg8::Gemm gg{WSP(bf16, WS_H), (const bf16*)(ws + WS_W + (size_t)l * W_LSTRIDE + W_OUT), S, D, D}; pg8::StaticOrder SO; SO.init(S, D, gridDim.x, blockIdx.x);
            const pg8::EpiOut E{l == 0 ? (const float*)args.in[0] : WSP(const float, WS_XV), l == DEPTH - 1 ? args.out : WSP(float, WS_XV), WSP(const float, WS_MOD) + (size_t)l * 3 * D + 2 * D};
#ifndef DIS_OUT
            pg8::gemm_phase<pg8::EpiOut, pg8::StaticOrder, true, true>(lds, gg, SO, E);
#endif
        }
        SEAM(pb + 4);
        if (IN(pb + 5)) {
            PHASE_REGS;
            float* v = (l == DEPTH - 1) ? args.out : WSP(float, WS_XV);
            ln_rows(v, v, (l == DEPTH - 1) ? nullptr : WSP(bf16, WS_H), (const float*)args.in[14] + (size_t)l * D, (const float*)args.in[15] + (size_t)l * D,
                    WSP(const float, WS_MOD) + (size_t)(l + 1) * 3 * D, VCU() * NWAVES + wave, gridDim.x * NWAVES, lane);
        }
        SEAM(pb + 5);
    }
#undef IN
#undef SEAM
}

#ifndef MK_PER_PHASE
#define MK_PER_PHASE 1
#endif
extern "C" void kernel_launch(void* const* d_in, const int* in_sizes, int n_in, void* d_out, int out_size, void* d_ws, size_t ws_size, hipStream_t stream) {
    static int grid = 0;
    if (grid == 0) {
        if (n_in != 16 || out_size != S * D || ws_size < WS_END) { fprintf(stderr, "kernel_launch: unexpected shapes n_in %d out %d ws %zu\n", n_in, out_size, ws_size); grid = -1; return; }
        int dev = 0, cus = 0;
        if (hipGetDevice(&dev) != hipSuccess || hipDeviceGetAttribute(&cus, hipDeviceAttributeMultiprocessorCount, dev) != hipSuccess) { grid = -1; return; }
        if (hipFuncSetAttribute((const void*)mk_fwd, hipFuncAttributeMaxDynamicSharedMemorySize, LDS_BYTES) != hipSuccess) { grid = -1; return; }
        int per_cu = 0;
        (void)hipOccupancyMaxActiveBlocksPerMultiprocessor(&per_cu, (const void*)mk_fwd, NTHR, LDS_BYTES);
        (void)hipGetLastError();
        if (per_cu < 1) fprintf(stderr, "kernel_launch: occupancy query says %d\n", per_cu);
        grid = cus;
    }
    if (grid < 0) return;
    (void)hipMemsetAsync((char*)d_ws + WS_CTL, 0, CTL_ZERO_BYTES, stream);
    Args a{};
    for (int i = 0; i < 16; ++i) a.in[i] = d_in[i];
    a.out = (float*)d_out; a.ws = (unsigned char*)d_ws;
#if MK_PER_PHASE
    for (int p = 0; p < N_PHASES; ++p) { a.ph_lo = p; a.ph_hi = p + 1; hipLaunchKernelGGL(mk_fwd, dim3(grid), dim3(NTHR), LDS_BYTES, stream, a); }
#else
    a.ph_lo = 0; a.ph_hi = N_PHASES;
    hipLaunchKernelGGL(mk_fwd, dim3(grid), dim3(NTHR), LDS_BYTES, stream, a);
#endif
}
```

```cpp
#include <hip/hip_runtime.h>
#include <cstdio>
#include <cstdint>

#define GAS __attribute__((address_space(1)))
#define LAS __attribute__((address_space(3)))
typedef unsigned short bf16;
typedef float f32x4 __attribute__((ext_vector_type(4)));
typedef float f32x2 __attribute__((ext_vector_type(2)));
typedef float f32x8 __attribute__((ext_vector_type(8)));
typedef float f32x16 __attribute__((ext_vector_type(16)));
typedef unsigned u32x4 __attribute__((ext_vector_type(4)));
typedef unsigned u32x2 __attribute__((ext_vector_type(2)));
typedef short bf16x8 __attribute__((ext_vector_type(8)));
typedef short s16x4 __attribute__((ext_vector_type(4)));
typedef __bf16 bf16x2v __attribute__((ext_vector_type(2)));
typedef __bf16 bf16x8v __attribute__((ext_vector_type(8)));
typedef GAS unsigned gu32;

constexpr int S = 16384, D = 4096, DEPTH = 2;
constexpr int INC = 9072, NIN = 9216;
constexpr float LN_EPS = 1e-5f, RMS_EPS = 1e-6f;
constexpr float DN_ALPHA = 1.41421356237309515f;
constexpr float LOG2E = 1.4426950408889634f;
constexpr float QS_MLA = 0.07216878364870322f * LOG2E;
constexpr float QS_NSA = 0.08838834764831845f * LOG2E;
constexpr int NWAVES = 8, NTHR = 512;
constexpr size_t MiB = 1u << 20;
constexpr size_t WS_CTL = 0, CTL_ZERO_BYTES = 1 * MiB;
constexpr size_t WS_MOD = 1 * MiB;
constexpr size_t WS_ROPE = 2 * MiB;
constexpr size_t WS_CBP = 6 * MiB;
constexpr size_t WS_RSQQ = 7 * MiB;
constexpr size_t WS_RSQKV = 9 * MiB;
constexpr size_t WS_RSTD = 6 * MiB + 512 * 1024;
constexpr size_t WS_GNSA = 10 * MiB;
constexpr size_t WS_KCMP = 13 * MiB;
constexpr size_t WS_VCMP = 13 * MiB + 512 * 1024;
constexpr size_t WS_W = 16 * MiB, W_LSTRIDE = 120 * MiB;
constexpr size_t W_IN = 0, W_QUP = 72 * MiB, W_KVUP = 77 * MiB, W_OUT = 81 * MiB, W_C1 = 113 * MiB, W_C2 = 115 * MiB;
constexpr size_t WS_H = 256 * MiB;
constexpr size_t WS_XV = 384 * MiB;
constexpr size_t WS_QLAT = 640 * MiB, WS_KVLAT = 664 * MiB;
constexpr size_t WS_QMLA = 680 * MiB, WS_KMLA = 776 * MiB, WS_VMLA = 872 * MiB, WS_ZMLA = 936 * MiB, WS_ZNSA = 1000 * MiB, WS_QNSA = 1064 * MiB;
constexpr size_t WS_KVNSA = 1128 * MiB;
constexpr size_t WS_OSCR = 1178 * MiB;
constexpr size_t WS_END = 1210 * MiB;
constexpr int CW_BAR = 4096;
constexpr int LDS_BYTES = 147456;
constexpr int MISC_OFF = LDS_BYTES - 128;

__device__ __forceinline__ unsigned pk2(float lo, float hi) { f32x2 a = {lo, hi}; return __builtin_bit_cast(unsigned, __builtin_convertvector(a, bf16x2v)); }
__device__ __forceinline__ u32x4 pk8(f32x4 a, f32x4 b) { u32x4 w; w.x = pk2(a[0], a[1]); w.y = pk2(a[2], a[3]); w.z = pk2(b[0], b[1]); w.w = pk2(b[2], b[3]); return w; }
__device__ __forceinline__ float bflo(unsigned u) { return __uint_as_float(u << 16); }
__device__ __forceinline__ float bfhi(unsigned u) { return __uint_as_float(u & 0xffff0000u); }
__device__ __forceinline__ float wave_sum(float v) {
#pragma unroll
    for (int o = 1; o < 64; o <<= 1) v += __shfl_xor(v, o);
    return v;
}
__device__ __forceinline__ float silu_f(float v) { return v / (1.f + __expf(-v)); }
__device__ __forceinline__ float sigm_f(float v) { return 1.f / (1.f + __expf(-v)); }

#define XB_TMO      128
#define XB_XCNT(j)  (256  + 64 * (j))
#define XB_XSUB(j)  (1280 + 64 * (j))
#define XB_XGEN(j)  (2304 + 64 * (j))
#define XB_TOP      3328
#define XB_TOPGEN   3392
#define XCD_BAR_WORDS 3456
#define XB_SPIN_CAP (1u << 18)
__device__ __forceinline__ unsigned xb_ld(unsigned* p)              { return __hip_atomic_load(p, __ATOMIC_RELAXED, __HIP_MEMORY_SCOPE_AGENT); }
__device__ __forceinline__ unsigned xb_add(unsigned* p, unsigned v) { return __hip_atomic_fetch_add(p, v, __ATOMIC_RELAXED, __HIP_MEMORY_SCOPE_AGENT); }
__device__ __forceinline__ unsigned xb_xcc_id() { return (unsigned)__builtin_amdgcn_s_getreg((3 << 11) | 20) & 0xFu; }
#define XB_SPIN(cond, bar) do { unsigned _sp = 0; while (cond) { __builtin_amdgcn_s_sleep(1); \
    if ((++_sp & 255u) == 0u) { if (xb_ld(&(bar)[XB_TMO])) break; if (_sp > XB_SPIN_CAP) { atomicAdd(&(bar)[XB_TMO], 1u); break; } } } } while (0)
struct XcdBarrier { unsigned* bar; unsigned x; volatile LAS unsigned* st; };
__device__ __forceinline__ XcdBarrier xcd_barrier_post(unsigned* bar, volatile LAS unsigned* st) {
    XcdBarrier b; b.bar = bar; b.x = xb_xcc_id(); b.st = st;
    if (threadIdx.x == 0) (void)xb_add(&bar[XB_XCNT(b.x)], 1u);
    return b;
}
__device__ __forceinline__ void xcd_barrier_complete(unsigned* bar, unsigned x, unsigned& nloc, unsigned& nx) {
    const unsigned G = gridDim.x * gridDim.y * gridDim.z;
    unsigned sum, cnt, mine, sp = 0u;
    for (;;) {
        sum = 0u; cnt = 0u; mine = 0u;
#pragma unroll
        for (unsigned j = 0; j < 16; ++j) { const unsigned c = xb_ld(&bar[XB_XCNT(j)]); sum += c; cnt += (c > 0u) ? 1u : 0u; mine = (j == x) ? c : mine; }
        if (sum == G) break;
        __builtin_amdgcn_s_sleep(1);
        if ((++sp & 255u) == 0u) { if (xb_ld(&bar[XB_TMO])) break; if (sp > XB_SPIN_CAP) { atomicAdd(&bar[XB_TMO], 1u); break; } }
    }
    nloc = mine > 0u ? mine : 1u; nx = cnt > 0u ? cnt : 1u;
}
__device__ __forceinline__ void xcd_barrier(const XcdBarrier& b) {
    asm volatile("s_waitcnt vmcnt(0)" ::: "memory");
    __syncthreads();
    if (threadIdx.x == 0) {
        unsigned* bar = b.bar;
        __builtin_amdgcn_s_waitcnt(0);
        unsigned nloc = b.st[0], nx = b.st[1];
        if (nloc == 0u) { xcd_barrier_complete(bar, b.x, nloc, nx); b.st[0] = nloc; b.st[1] = nx; }
        const unsigned old = xb_add(&bar[XB_XSUB(b.x)], 1u);
        const unsigned gen = old / nloc;
        if (old + 1u == (gen + 1u) * nloc) {
            __builtin_amdgcn_fence(__ATOMIC_RELEASE, "agent");
            asm volatile("s_waitcnt vmcnt(0)" ::: "memory");
            const unsigned og = xb_add(&bar[XB_TOP], 1u);
            const unsigned tg = og / nx;
            if (og + 1u == (tg + 1u) * nx) xb_add(&bar[XB_TOPGEN], 1u);
            else XB_SPIN(xb_ld(&bar[XB_TOPGEN]) == tg, bar);
            __builtin_amdgcn_fence(__ATOMIC_ACQUIRE, "agent");
            xb_add(&bar[XB_XGEN(b.x)], 1u);
            asm volatile("s_waitcnt vmcnt(0)" ::: "memory");
        } else {
            XB_SPIN(xb_ld(&bar[XB_XGEN(b.x)]) == gen, bar);
            __builtin_amdgcn_fence(__ATOMIC_ACQUIRE, "agent");
            asm volatile("s_waitcnt vmcnt(0)" ::: "memory");
        }
    }
    __syncthreads();
}
__device__ __forceinline__ void p0_mod_gemv(const float* c, const float* w_ada, const float* b_ada, float* mod, LAS float* lds, int vcu, int G) {
    const int tid = threadIdx.x;
    LAS float* sc = lds;
    LAS float* red = lds + 4096;
    for (int k = tid; k < D; k += NTHR) sc[k] = silu_f(c[k]);
    __syncthreads();
    const int cl = tid & 7, kl = tid >> 3;
    constexpr int NU = DEPTH * 3 * D / 32;
    for (int u = vcu; u < NU; u += G) {
        const int l = u / (3 * D / 32), n0 = (u % (3 * D / 32)) * 32;
        const float* W = w_ada + (size_t)l * D * (3 * D) + n0 + cl * 4;
        f32x4 acc = {0.f, 0.f, 0.f, 0.f};
#pragma unroll 8
        for (int i = 0; i < D / 64; ++i) { const int k = kl + 64 * i; const f32x4 w = *(const GAS f32x4*)(W + (size_t)k * (3 * D)); acc += w * sc[k]; }
        red[kl * 33 + cl * 4 + 0] = acc[0]; red[kl * 33 + cl * 4 + 1] = acc[1]; red[kl * 33 + cl * 4 + 2] = acc[2]; red[kl * 33 + cl * 4 + 3] = acc[3];
        __syncthreads();
        if (tid < 32) { float s = 0.f; for (int j = 0; j < 64; ++j) s += red[j * 33 + tid]; mod[(size_t)l * 3 * D + n0 + tid] = s + b_ada[(size_t)l * 3 * D + n0 + tid]; }
        __syncthreads();
    }
}
__device__ __forceinline__ int map_in(int n) {
    if (n < 1280) return n;
    if (n < 1344) { const int i = n - 1280; return 1280 + 2 * (i & 31) + (i >> 5); }
    if (n < 3392) return 1536 + (n - 1344);
    if (n < 5440) return 3584 + (n - 3392);
    if (n < 6976) return 5632 + (n - 5440);
    if (n < 7024) return 1344 + (n - 6976);
    return 7168 + (n - 7024);
}
__device__ __forceinline__ int map_qup(int n) { const int h = n / 192, d = n - h * 192; if (d < 128) return h * 128 + d; const int i = d - 128; return 2048 + h * 64 + 2 * (i & 31) + (i >> 5); }
template <int MAP>
__device__ __forceinline__ void tr_item(const float* W, int K, int N, bf16* WT, const float* kscale, LAS float* scr, int kb, int nb, int lane) {
    const int k0 = 64 * kb, n0 = 32 * nb;
    const int nn = n0 + (lane & 31);
#pragma unroll 8
    for (int i = 0; i < 32; ++i) { const int kk = 2 * i + (lane >> 5); float v = 0.f; if (nn < N) v = *(const GAS float*)(W + (size_t)(k0 + kk) * N + nn); if (kscale) v *= kscale[k0 + kk]; scr[kk * 33 + (lane & 31)] = v; }
    asm volatile("s_waitcnt lgkmcnt(0)" ::: "memory");
    const int c = lane & 7;
#pragma unroll
    for (int j = 0; j < 4; ++j) { const int nl = (lane >> 3) + 8 * j, n = n0 + nl;
        if (n < N) { const int row = MAP == 1 ? map_in(n) : (MAP == 2 ? map_qup(n) : n); const LAS float* s = scr + (8 * c) * 33 + nl;
            u32x4 o; o.x = pk2(s[0 * 33], s[1 * 33]); o.y = pk2(s[2 * 33], s[3 * 33]); o.z = pk2(s[4 * 33], s[5 * 33]); o.w = pk2(s[6 * 33], s[7 * 33]);
            *(GAS u32x4*)(WT + (size_t)row * K + k0 + 8 * c) = o; } }
    asm volatile("s_waitcnt lgkmcnt(0)" ::: "memory");
}
struct P0In { const float *w_in, *q_norm, *w_q_up, *kv_norm, *w_kv_up, *w_cmp1, *w_cmp2, *w_out; };
__device__ __forceinline__ void p0_convert(const P0In& I, unsigned char* ws, LAS float* scr, int gw, int NGW, int lane) {
    constexpr int T_IN = 64 * 284, T_QUP = 12 * 96, T_KVUP = 8 * 128, T_OUT = 64 * 128, T_C1 = 2 * 64 * 4, T_C2 = 2 * 2 * 4;
    constexpr int TL = T_IN + T_QUP + T_KVUP + T_OUT + T_C1 + T_C2;
    for (int it = gw; it < DEPTH * TL; it += NGW) {
        const int l = it / TL; int r = it - l * TL;
        unsigned char* wl = ws + WS_W + (size_t)l * W_LSTRIDE;
        if (r < T_IN) { tr_item<1>(I.w_in + (size_t)l * D * INC, D, INC, (bf16*)(wl + W_IN), nullptr, scr, r / 284, r % 284, lane); continue; } r -= T_IN;
        if (r < T_QUP) { tr_item<2>(I.w_q_up + (size_t)l * 768 * 3072, 768, 3072, (bf16*)(wl + W_QUP), I.q_norm + l * 768, scr, r / 96, r % 96, lane); continue; } r -= T_QUP;
        if (r < T_KVUP) { tr_item<0>(I.w_kv_up + (size_t)l * 512 * 4096, 512, 4096, (bf16*)(wl + W_KVUP), I.kv_norm + l * 512, scr, r / 128, r % 128, lane); continue; } r -= T_KVUP;
        if (r < T_OUT) { tr_item<0>(I.w_out + (size_t)l * D * D, D, D, (bf16*)(wl + W_OUT), nullptr, scr, r / 128, r % 128, lane); continue; } r -= T_OUT;
        if (r < T_C1) { const int kv = r / 256, rr = r % 256; tr_item<0>(I.w_cmp1 + (size_t)(l * 2 + kv) * 4096 * 128, 4096, 128, (bf16*)(wl + W_C1) + (size_t)kv * 128 * 4096, nullptr, scr, rr / 4, rr % 4, lane); continue; } r -= T_C1;
        { const int kv = r / 8, rr = r % 8; tr_item<0>(I.w_cmp2 + (size_t)(l * 2 + kv) * 128 * 128, 128, 128, (bf16*)(wl + W_C2) + (size_t)kv * 128 * 128, nullptr, scr, rr / 4, rr % 4, lane); }
    }
}
__device__ __forceinline__ void p0_rope(const int* positions, float* cosT, float* sinT, int gtid, int NT) {
    for (int e = gtid; e < S * 32; e += NT) { const int s = e >> 5, i = e & 31;
        const float inv = (float)exp(-(double)i * (1.0 / 32.0) * 9.210340371976184);
        const float ang = (float)positions[s] * inv;
        cosT[e] = (float)cos((double)ang); sinT[e] = (float)sin((double)ang); }
}
__device__ __forceinline__ void p0_cmpbias(const float* cmp_pos, const float* w_cmp1, float* cbp, LAS float* red, int vcu, int G) {
    const int tid = threadIdx.x, n = tid & 127, kq = tid >> 7;
    for (int u = vcu; u < 64; u += G) {
        const int lk = u >> 4, ch = u & 15;
        const float* P = cmp_pos + (size_t)lk * 4096 + 256 * ch; const float* W = w_cmp1 + (size_t)lk * 4096 * 128 + (size_t)(256 * ch) * 128 + n;
        float a = 0.f;
#pragma unroll 8
        for (int i = 0; i < 64; ++i) { const int k = kq + 4 * i; a += P[k] * *(const GAS float*)(W + (size_t)k * 128); }
        red[kq * 128 + n] = a;
        __syncthreads();
        if (tid < 128) cbp[(size_t)u * 128 + tid] = (red[tid] + red[128 + tid]) + (red[256 + tid] + red[384 + tid]);
        __syncthreads();
    }
}
__device__ __forceinline__ void modulate_rows(const float* x, bf16* hout, const float* modl, int gw, int NGW, int lane) {
    f32x4 sh[16], sc[16];
#pragma unroll
    for (int j = 0; j < 16; ++j) { sh[j] = *((const GAS f32x4*)modl + lane + 64 * j); sc[j] = *((const GAS f32x4*)(modl + D) + lane + 64 * j) + 1.f; }
    for (int m = gw; m < S; m += NGW) {
        const GAS f32x4* xr = (const GAS f32x4*)(x + (size_t)m * D) + lane;
        GAS u32x2* ho = (GAS u32x2*)(hout + (size_t)m * D) + lane;
#pragma unroll
        for (int j = 0; j < 16; ++j) { const f32x4 h = xr[64 * j] * sc[j] + sh[j]; u32x2 w; w.x = pk2(h[0], h[1]); w.y = pk2(h[2], h[3]); ho[64 * j] = w; }
    }
}
__device__ __forceinline__ void ln_rows(const float* v, float* xout, bf16* hout, const float* g, const float* b, const float* mod_next, int gw, int NGW, int lane) {
    for (int m = gw; m < S; m += NGW) {
        const GAS f32x4* vr = (const GAS f32x4*)(v + (size_t)m * D) + lane;
        f32x4 x[16]; float s = 0.f;
#pragma unroll
        for (int j = 0; j < 16; ++j) { x[j] = vr[64 * j]; s += (x[j][0] + x[j][1]) + (x[j][2] + x[j][3]); }
        const float mean = wave_sum(s) * (1.f / D); float s2 = 0.f;
#pragma unroll
        for (int j = 0; j < 16; ++j) { x[j] = x[j] - mean; s2 += (x[j][0] * x[j][0] + x[j][1] * x[j][1]) + (x[j][2] * x[j][2] + x[j][3] * x[j][3]); }
        const float rstd = 1.f / sqrtf(wave_sum(s2) * (1.f / D) + LN_EPS);
        GAS f32x4* xo = (GAS f32x4*)(xout + (size_t)m * D) + lane;
#pragma unroll
        for (int j = 0; j < 16; ++j) {
            const f32x4 gg = *((const GAS f32x4*)g + lane + 64 * j), bb = *((const GAS f32x4*)b + lane + 64 * j);
            const f32x4 y = x[j] * rstd * gg + bb;
            xo[64 * j] = y;
            if (hout) {
                const f32x4 sh = *((const GAS f32x4*)mod_next + lane + 64 * j), scl = *((const GAS f32x4*)(mod_next + D) + lane + 64 * j);
                const f32x4 h = y * (scl + 1.f) + sh;
                u32x2 w; w.x = pk2(h[0], h[1]); w.y = pk2(h[2], h[3]);
                *((GAS u32x2*)(hout + (size_t)m * D) + lane + 64 * j) = w;
            }
        }
    }
}
__device__ __forceinline__ void rstd_rows(const float* rsq_q, const float* rsq_kv, float* rstd_q, float* rstd_kv, int gtid, int NT) {
    for (int row = gtid; row < S; row += NT) {
        const GAS f32x4* rp = (const GAS f32x4*)(rsq_q + (size_t)row * 24); float ss = 0.f;
#pragma unroll
        for (int i = 0; i < 6; ++i) { const f32x4 t = rp[i]; ss += (t[0] + t[1]) + (t[2] + t[3]); }
        rstd_q[row] = 1.f / sqrtf(ss * (1.f / 768.f) + RMS_EPS);
        const GAS f32x4* rk = (const GAS f32x4*)(rsq_kv + (size_t)row * 16); float sk = 0.f;
#pragma unroll
        for (int i = 0; i < 4; ++i) { const f32x4 t = rk[i]; sk += (t[0] + t[1]) + (t[2] + t[3]); }
        rstd_kv[row] = 1.f / sqrtf(sk * (1.f / 512.f) + RMS_EPS);
    }
}
namespace pg8 {
#define PG8_LAS __attribute__((address_space(3)))
typedef unsigned short bf16_t;
typedef short bf16x8 __attribute__((ext_vector_type(8)));
typedef float f32x4 __attribute__((ext_vector_type(4)));
typedef unsigned u32x4 __attribute__((ext_vector_type(4)));
constexpr int BM = 256, BK = 64, HALF = 128, HTB = HALF * BK * 2  , STAGE_BYTES = 8 * HTB, NXCD = 8, WGM = 8;

__host__ __device__ __forceinline__ int lds_byte(int r, int c) { const int st = (r >> 4) * 2 + (c >> 5), rr = r & 15, cc = c & 31, ob = rr * 64 + cc * 2; return st * 1024 + (ob ^ (((ob >> 9) & 1) << 5)); }
__host__ __device__ __forceinline__ void stage_rc(int b, int& R, int& C) { const int st = b / 1024, sb = b % 1024, swz = sb ^ (((sb >> 9) & 1) << 5); R = (st >> 1) * 16 + swz / 64; C = (st & 1) * 32 + (swz % 64) / 2; }
__host__ __device__ __forceinline__ int perm32(int rho) { const int n = rho >> 4, i = rho & 15; return 8 * (i >> 2) + 4 * n + (i & 3); }

struct Unit { int pm, pn; };
struct Gemm { const bf16_t* A; const bf16_t* Bt; int M, N, K; };

struct StaticOrder {
    int nM, nN, nwg, G, c;
    __host__ __device__ void init(int M, int N, int G_, int c_) { nM = M / BM; nN = N / BM; nwg = nM * nN; G = G_; c = c_; }
    __host__ __device__ bool next(int i, Unit& u) const {
        const long L = (long)i * G + c; if (L >= nwg) return false;
        int wgid = (int)L; { const int q = nwg / NXCD, r = nwg % NXCD, xcd = wgid % NXCD, off = wgid / NXCD; wgid = (xcd < r ? xcd * (q + 1) : r * (q + 1) + (xcd - r) * q) + off; }
        const int nig = WGM * nN, gid = wgid / nig, fm = gid * WGM, gsz = (nM - fm) < WGM ? (nM - fm) : WGM;
        u.pm = fm + ((wgid % nig) % gsz); u.pn = (wgid % nig) / gsz; return true;
    }
    __device__ __forceinline__ void a_ready(const Unit&) const {}
    __device__ __forceinline__ void done(const Unit&) const {}
};
__device__ __forceinline__ f32x4 rope4(const f32x4 v, float c0, float s0, float c1, float s1) {
    f32x4 o; o[0] = v[0] * c0 - v[1] * s0; o[1] = v[1] * c0 + v[0] * s0; o[2] = v[2] * c1 - v[3] * s1; o[3] = v[3] * c1 + v[2] * s1; return o; }
struct EpiIn {
    static constexpr bool PERM = true, AFTER_DRAIN = false;
    unsigned char* ws;
    __device__ __forceinline__ void operator()(const f32x4 (&acc)[2][2][4][2], const Unit& u, int wr, int wc, int fr, int fq) const {
        const int pn = u.pn, row0 = u.pm * BM + wr * 64 + fr;
        if (pn < 5) {
            const bool isq = pn < 3; bf16_t* base = (bf16_t*)(ws + (isq ? WS_QLAT : WS_KVLAT)); const int ld = isq ? 768 : 512, ct = isq ? pn : pn - 3, ns = isq ? 24 : 16; float* rsq = (float*)(ws + (isq ? WS_RSQQ : WS_RSQKV));
#pragma unroll
            for (int ai = 0; ai < 2; ++ai)
#pragma unroll
                for (int m = 0; m < 4; ++m) { const int row = row0 + ai * HALF + m * 16;
#pragma unroll
                    for (int bj = 0; bj < 2; ++bj) { const f32x4 v0 = acc[ai][bj][m][0], v1 = acc[ai][bj][m][1];
                        float ss = ((v0[0] * v0[0] + v0[1] * v0[1]) + (v0[2] * v0[2] + v0[3] * v0[3])) + ((v1[0] * v1[0] + v1[1] * v1[1]) + (v1[2] * v1[2] + v1[3] * v1[3]));
                        ss += __shfl_xor(ss, 16); ss += __shfl_xor(ss, 32);
                        if (fq == 0) rsq[(size_t)row * ns + ct * 8 + bj * 4 + wc] = ss;
                        *(GAS u32x4*)(base + (size_t)row * ld + ct * 256 + bj * HALF + wc * 32 + 8 * fq) = pk8(v0, v1); } }
        } else if (pn == 5) {
            if (wc < 2) {
                const int i0 = 16 * wc + 4 * fq; const float* cosT = (const float*)(ws + WS_ROPE); const float* sinT = cosT + (size_t)S * 32; bf16_t* kmla = (bf16_t*)(ws + WS_KMLA);
#pragma unroll
                for (int ai = 0; ai < 2; ++ai)
#pragma unroll
                    for (int m = 0; m < 4; ++m) { const int row = row0 + ai * HALF + m * 16;
                        const f32x4 cs = *(const GAS f32x4*)(cosT + (size_t)row * 32 + i0), sn = *(const GAS f32x4*)(sinT + (size_t)row * 32 + i0);
                        const u32x4 w = pk8(rope4(acc[ai][0][m][0], cs[0], sn[0], cs[1], sn[1]), rope4(acc[ai][0][m][1], cs[2], sn[2], cs[3], sn[3]));
                        bf16_t* dst = kmla + (size_t)row * 3072 + 128 + wc * 32 + 8 * fq;
#pragma unroll
                        for (int h = 0; h < 16; ++h) *(GAS u32x4*)(dst + h * 192) = w;
                        asm volatile("" ::: "memory"); }
            } else {
                const int cl = (wc - 2) * 32 + 8 * fq; float* gnsa = (float*)(ws + WS_GNSA);
                if (cl < 48) {
#pragma unroll
                    for (int ai = 0; ai < 2; ++ai)
#pragma unroll
                        for (int m = 0; m < 4; ++m) { const int row = row0 + ai * HALF + m * 16; const f32x4 v0 = acc[ai][0][m][0], v1 = acc[ai][0][m][1];
                            f32x4 g0, g1; g0[0] = sigm_f(v0[0]); g0[1] = sigm_f(v0[1]); g0[2] = sigm_f(v0[2]); g0[3] = sigm_f(v0[3]); g1[0] = sigm_f(v1[0]); g1[1] = sigm_f(v1[1]); g1[2] = sigm_f(v1[2]); g1[3] = sigm_f(v1[3]);
                            *(GAS f32x4*)(gnsa + (size_t)row * 48 + cl) = g0; *(GAS f32x4*)(gnsa + (size_t)row * 48 + cl + 4) = g1; } }
            }
        } else {
            const int mode = (pn < 14) ? 0 : (pn < 22 ? 1 : (pn < 28 ? 2 : 0));
            bf16_t* base = (pn < 14) ? (bf16_t*)(ws + WS_ZMLA) + (pn - 6) * 256 : (pn < 22 ? (bf16_t*)(ws + WS_QNSA) + (pn - 14) * 256 : (bf16_t*)(ws + WS_ZNSA) + (pn - 28) * 256); bf16_t* kvnsa = (bf16_t*)(ws + WS_KVNSA);
#pragma unroll
            for (int ai = 0; ai < 2; ++ai)
#pragma unroll
                for (int m = 0; m < 4; ++m) { const int row = row0 + ai * HALF + m * 16;
#pragma unroll
                    for (int bj = 0; bj < 2; ++bj) { f32x4 v0 = acc[ai][bj][m][0], v1 = acc[ai][bj][m][1];
                        if (mode == 0) { v0[0] = silu_f(v0[0]); v0[1] = silu_f(v0[1]); v0[2] = silu_f(v0[2]); v0[3] = silu_f(v0[3]); v1[0] = silu_f(v1[0]); v1[1] = silu_f(v1[1]); v1[2] = silu_f(v1[2]); v1[3] = silu_f(v1[3]); }
                        else if (mode == 1) { v0 = v0 * QS_NSA; v1 = v1 * QS_NSA; }
                        bf16_t* dst = (mode == 2) ? kvnsa + (size_t)(2 * (pn - 22) + bj) * ((size_t)S * 128) + (size_t)row * 128 + wc * 32 + 8 * fq
                                                  : base + (size_t)row * 2048 + bj * HALF + wc * 32 + 8 * fq;
                        *(GAS u32x4*)dst = pk8(v0, v1); } }
        }
    }
};
struct EpiQup {
    static constexpr bool PERM = true, AFTER_DRAIN = false;
    unsigned char* ws;
    __device__ __forceinline__ void operator()(const f32x4 (&acc)[2][2][4][2], const Unit& u, int wr, int wc, int fr, int fq) const {
        const int pn = u.pn, row0 = u.pm * BM + wr * 64 + fr; bf16_t* qmla = (bf16_t*)(ws + WS_QMLA); const float* rstd_q = (const float*)(ws + WS_RSTD); const float* cosT = (const float*)(ws + WS_ROPE); const float* sinT = cosT + (size_t)S * 32;
#pragma unroll
        for (int ai = 0; ai < 2; ++ai)
#pragma unroll
            for (int m = 0; m < 4; ++m) { const int row = row0 + ai * HALF + m * 16;
                const float sc = QS_MLA * *(const GAS float*)(rstd_q + row);
#pragma unroll
                for (int bj = 0; bj < 2; ++bj) { const f32x4 v0 = acc[ai][bj][m][0] * sc, v1 = acc[ai][bj][m][1] * sc;
                    if (pn < 8) { *(GAS u32x4*)(qmla + (size_t)row * 3072 + (2 * pn + bj) * 192 + wc * 32 + 8 * fq) = pk8(v0, v1); }
                    else { const int cp = (pn - 8) * 256 + bj * HALF + wc * 32 + 8 * fq, head = cp >> 6, dl = cp & 63, i0 = dl >> 1;
                        const f32x4 cs = *(const GAS f32x4*)(cosT + (size_t)row * 32 + i0), sn = *(const GAS f32x4*)(sinT + (size_t)row * 32 + i0);
                        *(GAS u32x4*)(qmla + (size_t)row * 3072 + head * 192 + 128 + dl) = pk8(rope4(v0, cs[0], sn[0], cs[1], sn[1]), rope4(v1, cs[2], sn[2], cs[3], sn[3])); } }
                if (m & 1) asm volatile("" ::: "memory"); }
    }
};
struct EpiKvup {
    static constexpr bool PERM = true, AFTER_DRAIN = false;
    unsigned char* ws;
    __device__ __forceinline__ void operator()(const f32x4 (&acc)[2][2][4][2], const Unit& u, int wr, int wc, int fr, int fq) const {
        const int pn = u.pn, row0 = u.pm * BM + wr * 64 + fr;
#pragma unroll
        for (int ai = 0; ai < 2; ++ai)
#pragma unroll
            for (int m = 0; m < 4; ++m) { const int row = row0 + ai * HALF + m * 16;
                const float sc = *(const GAS float*)((const float*)(ws + WS_RSTD) + S + row); bf16_t* kmla = (bf16_t*)(ws + WS_KMLA); bf16_t* vmla = (bf16_t*)(ws + WS_VMLA);
                *(GAS u32x4*)(kmla + (size_t)row * 3072 + pn * 192 + wc * 32 + 8 * fq) = pk8(acc[ai][0][m][0] * sc, acc[ai][0][m][1] * sc);
                *(GAS u32x4*)(vmla + (size_t)row * 2048 + pn * 128 + wc * 32 + 8 * fq) = pk8(acc[ai][1][m][0] * sc, acc[ai][1][m][1] * sc);
                if (m & 1) asm volatile("" ::: "memory"); }
    }
};
struct EpiOut {
    static constexpr bool PERM = false, AFTER_DRAIN = false;
    const float* x; float* xv; const float* gate;
    __device__ __forceinline__ void operator()(const f32x4 (&acc)[2][2][4][2], const Unit& u, int wr, int wc, int fr, int fq) const {
        const int row0 = u.pm * BM + wr * 64 + fr, col0 = u.pn * BM + wc * 32 + 4 * fq;
        f32x4 gv[2][2];
#pragma unroll
        for (int bj = 0; bj < 2; ++bj)
#pragma unroll
            for (int n = 0; n < 2; ++n) gv[bj][n] = *(const GAS f32x4*)(gate + col0 + bj * HALF + n * 16);
#pragma unroll
        for (int ai = 0; ai < 2; ++ai)
#pragma unroll
            for (int m = 0; m < 4; ++m) { const size_t off = (size_t)(row0 + ai * HALF + m * 16) * D + col0;
#pragma unroll
                for (int bj = 0; bj < 2; ++bj)
#pragma unroll
                    for (int n = 0; n < 2; ++n) { const f32x4 xx = *(const GAS f32x4*)(x + off + bj * HALF + n * 16);
                        *(GAS f32x4*)(xv + off + bj * HALF + n * 16) = xx * DN_ALPHA + gv[bj][n] * acc[ai][bj][m][n]; }
                if (m & 1) asm volatile("" ::: "memory"); }
    }
};
template <class Epi, class Sched, bool ALIGN_EPI = false, bool SP2 = false>
__device__ __forceinline__ void gemm_phase(PG8_LAS unsigned char* lds, const Gemm g, const Sched& S, const Epi& E) {
    int tid_ = threadIdx.x; asm volatile("" : "+v"(tid_));
    const int tid = tid_, wid = __builtin_amdgcn_readfirstlane(tid >> 6), lane = tid & 63, wr = wid >> 2, wc = wid & 3, fr = lane & 15, fq = lane >> 4;
    const int K = g.K, nt = K / BK;
    unsigned voffA[2], voffB[2];
#pragma unroll
    for (int i = 0; i < 2; ++i) { int R, C; stage_rc(tid * 16 + i * 8192, R, C); const int Rb = Epi::PERM ? ((R & ~31) + perm32(R & 31)) : R;
        voffA[i] = (unsigned)(R * K + C) * 2u; voffB[i] = (unsigned)(Rb * K + C) * 2u; }
    const size_t kstep = (size_t)(BK * 2);
    const size_t hstep = (size_t)HALF * K * 2;
    const size_t tstep = 2 * hstep;
    const unsigned ldsw = (unsigned)wid * 1024u;
    const int aoff = lds_byte(wr * 64 + fr, fq * 8), boff = lds_byte(wc * 32 + fr, fq * 8);
#define PG8_SA(b, h) (((b) * 2 + (h)) * HTB)
#define PG8_SB(b, h) ((4 + (b) * 2 + (h)) * HTB)
#define PG8_STAGE(bufoff, gbase, voff) do { _Pragma("unroll") for (int _i = 0; _i < 2; ++_i) \
        __builtin_amdgcn_global_load_lds((const unsigned*)((const char*)(gbase) + (voff)[_i]), (PG8_LAS unsigned*)(lds + (bufoff) + ldsw + _i * 8192), 16, 0, 0); } while (0)
#define PG8_LDA(dst, b, h) do { _Pragma("unroll") for (int m = 0; m < 4; ++m) _Pragma("unroll") for (int k = 0; k < 2; ++k) dst[m][k] = *(const PG8_LAS bf16x8*)(lds + PG8_SA(b, h) + aoff + m * 2048 + k * 1024); } while (0)
#define PG8_LDB(dst, b, h) do { _Pragma("unroll") for (int n = 0; n < 2; ++n) _Pragma("unroll") for (int k = 0; k < 2; ++k) dst[n][k] = *(const PG8_LAS bf16x8*)(lds + PG8_SB(b, h) + boff + n * 2048 + k * 1024); } while (0)
#define PG8_MMA(ai, bj, At, Bt) do { __builtin_amdgcn_s_setprio(1); _Pragma("unroll") for (int m = 0; m < 4; ++m) _Pragma("unroll") for (int n = 0; n < 2; ++n) _Pragma("unroll") for (int k = 0; k < 2; ++k) \
        acc[ai][bj][m][n] = __builtin_amdgcn_mfma_f32_16x16x32_bf16(Bt[n][k], At[m][k], acc[ai][bj][m][n], 0, 0, 0); __builtin_amdgcn_s_setprio(0); } while (0)
#define PG8_WAIT_V(n) asm volatile("s_waitcnt vmcnt(" #n ")" ::: "memory")
#define PG8_WAIT_L(n) asm volatile("s_waitcnt lgkmcnt(" #n ")" ::: "memory")
#define PG8_BAR __builtin_amdgcn_s_barrier()
#define PG8_SCHED __builtin_amdgcn_sched_barrier(0)
    Unit cur, nxt; int ui = 0;
    if (!S.next(0, cur)) return;
    f32x4 acc[2][2][4][2];
#pragma unroll
    for (int a = 0; a < 2; ++a)
#pragma unroll
        for (int b = 0; b < 2; ++b)
#pragma unroll
            for (int m = 0; m < 4; ++m)
#pragma unroll
                for (int n = 0; n < 2; ++n) acc[a][b][m][n] = (f32x4){0.f, 0.f, 0.f, 0.f};
    bf16x8 At[4][2], B0[2][2], B1[2][2];
    const char* cA = (const char*)g.A + (size_t)cur.pm * tstep; const char* cB = (const char*)g.Bt + (size_t)cur.pn * tstep;
    S.a_ready(cur);
    if constexpr (SP2) {
        PG8_STAGE(PG8_SB(0, 0), cB, voffB); PG8_STAGE(PG8_SB(0, 1), cB + hstep, voffB); PG8_STAGE(PG8_SA(0, 0), cA, voffA); PG8_STAGE(PG8_SA(0, 1), cA + hstep, voffA);
        if (wr == 1) PG8_BAR;
        PG8_WAIT_V(2); PG8_BAR;
        PG8_STAGE(PG8_SB(1, 0), cB + kstep, voffB); PG8_STAGE(PG8_SA(1, 0), cA + kstep, voffA); PG8_STAGE(PG8_SB(1, 1), cB + hstep + kstep, voffB);
        PG8_WAIT_V(6); PG8_BAR;
    } else {
        PG8_STAGE(PG8_SB(0, 0), cB, voffB); PG8_STAGE(PG8_SA(0, 0), cA, voffA); PG8_STAGE(PG8_SB(0, 1), cB + hstep, voffB); PG8_STAGE(PG8_SA(0, 1), cA + hstep, voffA);
        if (wr == 1) PG8_BAR;
        PG8_WAIT_V(4); PG8_BAR;
        PG8_STAGE(PG8_SB(1, 0), cB + kstep, voffB); PG8_STAGE(PG8_SA(1, 0), cA + kstep, voffA); PG8_STAGE(PG8_SB(1, 1), cB + hstep + kstep, voffB);
        PG8_WAIT_V(6); PG8_BAR;
    }
    for (;;) {
        const bool has_next = S.next(ui + 1, nxt);
        const char* nA = has_next ? (const char*)g.A + (size_t)nxt.pm * tstep : cA; const char* nB = has_next ? (const char*)g.Bt + (size_t)nxt.pn * tstep : cB;
        for (int t = 0; t < nt; t += 2) {
            const bool last = (t == nt - 2);
            const char* a1 = cA + (size_t)(t + 1) * kstep;
            const char* a2 = last ? nA : cA + (size_t)(t + 2) * kstep; const char* b2 = last ? nB : cB + (size_t)(t + 2) * kstep;
            const char* a3 = a2 + kstep; const char* b3 = b2 + kstep;
            if (last && has_next) S.a_ready(nxt);
            if constexpr (SP2) {
            PG8_LDB(B0, 0, 0); PG8_LDB(B1, 0, 1); PG8_SCHED; PG8_LDA(At, 0, 0); PG8_STAGE(PG8_SA(1, 1), a1 + hstep, voffA);
            PG8_WAIT_V(8); PG8_WAIT_L(0); PG8_BAR; PG8_MMA(0, 0, At, B0); PG8_MMA(0, 1, At, B1); PG8_BAR; PG8_SCHED;
            PG8_LDA(At, 0, 1); PG8_STAGE(PG8_SB(0, 0), b2, voffB); PG8_STAGE(PG8_SB(0, 1), b2 + hstep, voffB); PG8_STAGE(PG8_SA(0, 0), a2, voffA);
            PG8_WAIT_V(8); PG8_WAIT_L(0); PG8_BAR; PG8_MMA(1, 0, At, B0); PG8_MMA(1, 1, At, B1); PG8_BAR; PG8_SCHED;
            PG8_LDB(B0, 1, 0); PG8_LDB(B1, 1, 1); PG8_SCHED; PG8_LDA(At, 1, 0); PG8_STAGE(PG8_SA(0, 1), a2 + hstep, voffA);
            PG8_WAIT_V(8); PG8_WAIT_L(0); PG8_BAR; PG8_MMA(0, 0, At, B0); PG8_MMA(0, 1, At, B1); PG8_BAR; PG8_SCHED;
            PG8_LDA(At, 1, 1); PG8_STAGE(PG8_SB(1, 0), b3, voffB); PG8_STAGE(PG8_SB(1, 1), b3 + hstep, voffB); PG8_STAGE(PG8_SA(1, 0), a3, voffA);
            PG8_WAIT_V(8); PG8_WAIT_L(0); PG8_BAR; PG8_MMA(1, 0, At, B0); PG8_MMA(1, 1, At, B1); PG8_BAR; PG8_SCHED;
            } else {
            PG8_LDB(B0, 0, 0); PG8_SCHED; PG8_LDA(At, 0, 0); PG8_STAGE(PG8_SA(1, 1), a1 + hstep, voffA);
            PG8_WAIT_L(8); PG8_BAR; PG8_WAIT_L(0); PG8_MMA(0, 0, At, B0); PG8_BAR; PG8_SCHED;
            PG8_LDB(B1, 0, 1); PG8_STAGE(PG8_SB(0, 0), b2, voffB);
            PG8_BAR; PG8_WAIT_L(0); PG8_MMA(0, 1, At, B1); PG8_BAR;
            PG8_LDA(At, 0, 1); PG8_STAGE(PG8_SA(0, 0), a2, voffA);
            PG8_BAR; PG8_WAIT_L(0); PG8_MMA(1, 0, At, B0); PG8_BAR; PG8_SCHED;
            PG8_STAGE(PG8_SB(0, 1), b2 + hstep, voffB);
            PG8_WAIT_V(6); PG8_BAR; PG8_MMA(1, 1, At, B1); PG8_BAR;
            PG8_LDB(B0, 1, 0); PG8_SCHED; PG8_LDA(At, 1, 0); PG8_STAGE(PG8_SA(0, 1), a2 + hstep, voffA);
            PG8_WAIT_L(8); PG8_BAR; PG8_WAIT_L(0); PG8_MMA(0, 0, At, B0); PG8_BAR; PG8_SCHED;
            PG8_LDB(B1, 1, 1); PG8_STAGE(PG8_SB(1, 0), b3, voffB);
            PG8_BAR; PG8_WAIT_L(0); PG8_MMA(0, 1, At, B1); PG8_BAR;
            PG8_LDA(At, 1, 1); PG8_STAGE(PG8_SA(1, 0), a3, voffA);
            PG8_BAR; PG8_WAIT_L(0); PG8_MMA(1, 0, At, B0); PG8_BAR; PG8_SCHED;
            PG8_STAGE(PG8_SB(1, 1), b3 + hstep, voffB);
            PG8_WAIT_V(6); PG8_BAR; PG8_MMA(1, 1, At, B1); PG8_BAR;
            }
        }
        if constexpr (ALIGN_EPI) { if (wr == 0) PG8_BAR; }
        if constexpr (!Epi::AFTER_DRAIN) { E(acc, cur, wr, wc, fr, fq); S.done(cur); }
        if (!has_next) break;
#pragma unroll
        for (int a = 0; a < 2; ++a)
#pragma unroll
            for (int b = 0; b < 2; ++b)
#pragma unroll
                for (int m = 0; m < 4; ++m)
#pragma unroll
                    for (int n = 0; n < 2; ++n) acc[a][b][m][n] = (f32x4){0.f, 0.f, 0.f, 0.f};
        cur = nxt; cA = nA; cB = nB; ++ui;
        if constexpr (ALIGN_EPI) { if (wr == 1) PG8_BAR; }
    }
    PG8_WAIT_V(0);
    if constexpr (!ALIGN_EPI) { if (wr == 0) PG8_BAR; }
    PG8_BAR;
    if constexpr (Epi::AFTER_DRAIN) { E.fused(acc, cur, wr, wc, fr, fq, lds, wid, lane); S.done(cur); }
#undef PG8_SA
#undef PG8_SB
#undef PG8_STAGE
#undef PG8_LDA
#undef PG8_LDB
#undef PG8_MMA
#undef PG8_WAIT_V
#undef PG8_WAIT_L
#undef PG8_BAR
#undef PG8_SCHED
}
}
namespace att {
constexpr int KS_M = 400, KS_N = 272, VS = 320;
constexpr int MLA_KB = 64 * KS_M, NSA_KB = 64 * KS_N, VB = 64 * VS;
constexpr int N_IMP = 2 * NSA_KB + 2 * VB;
constexpr int N_PART = N_IMP + 32768;
constexpr int N_PARTB = 8 * 32 * 17 * 4;
constexpr int N_SELM = N_PART + 2 * N_PARTB;
constexpr int N_ULIST = N_SELM + 1024;
constexpr int N_CARRY = N_ULIST + 1024;
constexpr int N_NTS = N_CARRY + 256;
static_assert(N_NTS + 16 <= MISC_OFF, "NSA LDS map");
static_assert(2 * MLA_KB + 2 * VB <= 131072, "MLA LDS map");

#define MFMA32(a, b, c) __builtin_amdgcn_mfma_f32_32x32x16_bf16((a), (b), (c), 0, 0, 0)
__device__ __forceinline__ float swapmax(float v) { auto rr = __builtin_amdgcn_permlane32_swap(__float_as_uint(v), __float_as_uint(v), false, false); return fmaxf(__uint_as_float(rr[0]), __uint_as_float(rr[1])); }
__device__ __forceinline__ float swapsum(float v) { auto rr = __builtin_amdgcn_permlane32_swap(__float_as_uint(v), __float_as_uint(v), false, false); return __uint_as_float(rr[0]) + __uint_as_float(rr[1]); }
template <int SIDX> __device__ __forceinline__ bf16x8 packp(const f32x16& p) {
    f32x8 t = {p[8 * SIDX + 0], p[8 * SIDX + 1], p[8 * SIDX + 2], p[8 * SIDX + 3], p[8 * SIDX + 4], p[8 * SIDX + 5], p[8 * SIDX + 6], p[8 * SIDX + 7]};
    return __builtin_bit_cast(bf16x8, __builtin_convertvector(t, bf16x8v));
}
template <int NDC, int KS> __device__ __forceinline__ void qk_tile(f32x16& p0, f32x16& p1, const LAS unsigned char* kl, const bf16x8 (&q)[NDC]) {
#pragma unroll
    for (int i = 0; i < 16; ++i) { p0[i] = 0.f; p1[i] = 0.f; }
#pragma unroll
    for (int d0 = 0; d0 < NDC; ++d0) {
        const bf16x8 a0 = *(const LAS bf16x8*)(kl + d0 * 32);
        const bf16x8 a1 = *(const LAS bf16x8*)(kl + 32 * KS + d0 * 32);
        p0 = MFMA32(a0, q[d0], p0); p1 = MFMA32(a1, q[d0], p1);
        if ((d0 & 3) == 3) __builtin_amdgcn_sched_barrier(0);
    }
}
__device__ __forceinline__ void pv_tile(f32x16 (&o)[4], const bf16x8 (&pb)[4], const LAS unsigned char* vl) {
#pragma unroll
    for (int d0 = 0; d0 < 4; ++d0) {
#pragma unroll
        for (int s = 0; s < 4; ++s) {
            const s16x4 t0 = __builtin_amdgcn_ds_read_tr16_b64_v4i16((LAS s16x4*)(vl + s * 16 * VS + d0 * 64));
            const s16x4 t1 = __builtin_amdgcn_ds_read_tr16_b64_v4i16((LAS s16x4*)(vl + s * 16 * VS + 8 * VS + d0 * 64));
            const bf16x8 vf = {t0[0], t0[1], t0[2], t0[3], t1[0], t1[1], t1[2], t1[3]};
            o[d0] = MFMA32(vf, pb[s], o[d0]);
        }
        __builtin_amdgcn_sched_barrier(0);
    }
}
__device__ __forceinline__ void online_sm(f32x16& p0, f32x16& p1, float& m, float& l, f32x16 (&o)[4]) {
    float tm = p0[0];
#pragma unroll
    for (int r = 1; r < 16; ++r) tm = fmaxf(tm, p0[r]);
#pragma unroll
    for (int r = 0; r < 16; ++r) tm = fmaxf(tm, p1[r]);
    tm = swapmax(tm);
    const float mn = fmaxf(m, tm);
    const float alpha = __builtin_amdgcn_exp2f(m - mn);
    m = mn;
    float ps = 0.f;
#pragma unroll
    for (int r = 0; r < 16; ++r) { p0[r] = __builtin_amdgcn_exp2f(p0[r] - mn); ps += p0[r]; }
#pragma unroll
    for (int r = 0; r < 16; ++r) { p1[r] = __builtin_amdgcn_exp2f(p1[r] - mn); ps += p1[r]; }
    ps = swapsum(ps);
    l = l * alpha + ps;
    if (!__all(alpha == 1.f)) {
#pragma unroll
        for (int d = 0; d < 4; ++d)
#pragma unroll
            for (int r = 0; r < 16; ++r) o[d][r] *= alpha;
    }
}

struct MlaPtrs { const bf16* Q; const bf16* K; const bf16* V; const bf16* Z; bf16* O; };
__device__ __forceinline__ void mla_unit(LAS unsigned char* lds, const MlaPtrs& P, int head, int qb, int tid_in, int wave, int lane_in) {
    int tid = tid_in; asm volatile("" : "+v"(tid)); const int lane = tid & 63; (void)lane_in;
    const int r32 = lane & 31, hi = lane >> 5;
    const int q0 = qb * 256, qw = q0 + wave * 32, tq = qw + r32;
    bf16x8 q[12];
    { const bf16* qp = P.Q + (size_t)tq * 3072 + head * 192 + hi * 8;
#pragma unroll
      for (int d0 = 0; d0 < 12; ++d0) q[d0] = *(const GAS bf16x8*)(qp + d0 * 16); }
    const int NT = 4 * (qb + 1);
    const int srow = tid >> 3, sc8 = tid & 7;
    const unsigned char* kg = (const unsigned char*)P.K + (size_t)head * 384 + (size_t)srow * 6144 + sc8 * 16;
    const unsigned char* vg = (const unsigned char*)P.V + (size_t)head * 256 + (size_t)srow * 4096 + sc8 * 16;
    LAS unsigned char* kst = lds + srow * KS_M + sc8 * 16;
    LAS unsigned char* vst = lds + 2 * MLA_KB + srow * VS + sc8 * 16;
    const LAS unsigned char* kl = lds + r32 * KS_M + hi * 16;
    const LAS unsigned char* vl = lds + 2 * MLA_KB + (4 * hi + ((lane & 15) >> 2)) * VS + (16 * ((lane >> 4) & 1) + 4 * (lane & 3)) * 2;
    u32x4 sk0, sk1, sk2, sv0, sv1;
#define MLA_LOAD(j) do { const unsigned char* kp_ = kg + (size_t)(j) * (64 * 6144); const unsigned char* vp_ = vg + (size_t)(j) * (64 * 4096); \
        sk0 = *(const GAS u32x4*)(kp_); sk1 = *(const GAS u32x4*)(kp_ + 128); sk2 = *(const GAS u32x4*)(kp_ + 256); sv0 = *(const GAS u32x4*)(vp_); sv1 = *(const GAS u32x4*)(vp_ + 128); } while (0)
#define MLA_STORE(b) do { LAS unsigned char* kd_ = kst + (b) * MLA_KB; LAS unsigned char* vd_ = vst + (b) * VB; \
        *(LAS u32x4*)(kd_) = sk0; *(LAS u32x4*)(kd_ + 128) = sk1; *(LAS u32x4*)(kd_ + 256) = sk2; *(LAS u32x4*)(vd_) = sv0; *(LAS u32x4*)(vd_ + 128) = sv1; } while (0)
    MLA_LOAD(0); MLA_STORE(0);
    __syncthreads();
    float m = -1e30f, l = 0.f; f32x16 o[4];
#pragma unroll
    for (int d = 0; d < 4; ++d)
#pragma unroll
        for (int r = 0; r < 16; ++r) o[d][r] = 0.f;
    for (int j = 0; j < NT; ++j) {
        const int buf = j & 1, kb = 64 * j;
        if (j + 1 < NT) MLA_LOAD(j + 1);
        if (kb <= qw + 31) {
            f32x16 p0, p1;
            qk_tile<12, KS_M>(p0, p1, kl + buf * MLA_KB, q);
            if (kb + 63 > qw) {
                const int dq = tq - kb - 4 * hi;
#pragma unroll
                for (int r = 0; r < 16; ++r) { const int c = (r & 3) + 8 * (r >> 2);
                    if (c > dq) p0[r] = -__builtin_inff();
                    if (c + 32 > dq) p1[r] = -__builtin_inff(); }
            }
            online_sm(p0, p1, m, l, o);
            const bf16x8 pb[4] = {packp<0>(p0), packp<1>(p0), packp<0>(p1), packp<1>(p1)};
            pv_tile(o, pb, vl + buf * VB);
        }
        if (j + 1 < NT) MLA_STORE(buf ^ 1);
        __syncthreads();
    }
#undef MLA_LOAD
#undef MLA_STORE
    const float inv = 1.f / l;
    const bf16* zp = P.Z + (size_t)tq * 2048 + head * 128 + 4 * hi;
    bf16* op = P.O + (size_t)tq * 4096 + head * 128 + 4 * hi;
#pragma unroll
    for (int d0 = 0; d0 < 4; ++d0)
#pragma unroll
        for (int rg = 0; rg < 4; ++rg) { const int dim = 32 * d0 + 8 * rg;
            const u32x2 z = *(const GAS u32x2*)(zp + dim);
            u32x2 w; w.x = pk2(o[d0][4 * rg + 0] * inv * bflo(z.x), o[d0][4 * rg + 1] * inv * bfhi(z.x)); w.y = pk2(o[d0][4 * rg + 2] * inv * bflo(z.y), o[d0][4 * rg + 3] * inv * bfhi(z.y));
            *(GAS u32x2*)(op + dim) = w; }
}

struct NsaPtrs { const bf16* Q; const bf16* KV; const bf16* KC; const bf16* VC; const bf16* Z; const float* G; bf16* O; float* scr; };
template <int MODE>
__device__ __forceinline__ void nsa_loop(LAS unsigned char* lds, const unsigned char* kbase, const unsigned char* vbase, int ntiles, int jlo,
                                         const bf16x8 (&q)[8], int t, float slope2, float& m, float& l, f32x16 (&o)[4], float invl, int tid, int wave, int lane) {
    constexpr bool HASV = MODE != 0;
    const int r32 = lane & 31, hi = lane >> 5;
    const int srow = tid >> 3, sc8 = tid & 7;
    const unsigned soff = srow * 256 + sc8 * 16;
    LAS unsigned char* kst = lds + srow * KS_N + sc8 * 16;
    LAS unsigned char* vst = lds + 2 * NSA_KB + srow * VS + sc8 * 16;
    const LAS unsigned char* kl = lds + r32 * KS_N + hi * 16;
    const LAS unsigned char* vl = lds + 2 * NSA_KB + (4 * hi + ((lane & 15) >> 2)) * VS + (16 * ((lane >> 4) & 1) + 4 * (lane & 3)) * 2;
    const LAS int* ulist = (const LAS int*)(lds + N_ULIST);
    const LAS unsigned* selm = (const LAS unsigned*)(lds + N_SELM);
    LAS float* partA = (LAS float*)(lds + N_PART); LAS float* partB = (LAS float*)(lds + N_PART + N_PARTB);
    LAS float* imp = (LAS float*)(lds + N_IMP); LAS float* carry = (LAS float*)(lds + N_CARRY);
    if (ntiles <= 0) return;
    u32x4 sk0, sk1, sv0, sv1;
#define NSA_TROW(j) (MODE == 2 ? 64 * __builtin_amdgcn_readfirstlane(ulist[(j)]) : 64 * (jlo + (j)))
#define NSA_LOAD(j) do { const size_t ro_ = (size_t)NSA_TROW(j) * 256 + soff; \
        sk0 = *(const GAS u32x4*)(kbase + ro_); sk1 = *(const GAS u32x4*)(kbase + ro_ + 128); \
        if (HASV) { sv0 = *(const GAS u32x4*)(vbase + ro_); sv1 = *(const GAS u32x4*)(vbase + ro_ + 128); } } while (0)
#define NSA_STORE(b) do { LAS unsigned char* kd_ = kst + (b) * NSA_KB; *(LAS u32x4*)(kd_) = sk0; *(LAS u32x4*)(kd_ + 128) = sk1; \
        if (HASV) { LAS unsigned char* vd_ = vst + (b) * VB; *(LAS u32x4*)(vd_) = sv0; *(LAS u32x4*)(vd_ + 128) = sv1; } } while (0)
    NSA_LOAD(0); NSA_STORE(0);
    __syncthreads();
    for (int j = 0; j < ntiles; ++j) {
        const int buf = j & 1;
        if (MODE != 1 && j + 1 < ntiles) NSA_LOAD(j + 1);
        f32x16 p0, p1;
        qk_tile<8, KS_N>(p0, p1, kl + buf * NSA_KB, q);
        const int trow = NSA_TROW(j);
        constexpr int PSTEP = (MODE <= 1) ? 16 : 1;
        const int pstart = (MODE <= 1) ? 16 * trow + 31 : trow;
        const int db = t - pstart - PSTEP * 4 * hi;
        const float nslope = -slope2;
        bool selb = true;
        if (MODE == 2) { const int b = trow >> 6; selb = ((selm[r32 * 8 + (b >> 5)] >> (b & 31)) & 1u) != 0u; }
        const unsigned W = (MODE == 3) ? 512u : 0x7fffffffu;
#pragma unroll
        for (int r = 0; r < 16; ++r) { const int c = PSTEP * ((r & 3) + 8 * (r >> 2));
            const int e0 = db - c, e1 = db - c - 32 * PSTEP;
            const float s0 = __builtin_fmaf(nslope, (float)e0, p0[r]);
            const float s1 = __builtin_fmaf(nslope, (float)e1, p1[r]);
            p0[r] = (selb && (unsigned)e0 < W) ? s0 : -__builtin_inff();
            p1[r] = (selb && (unsigned)e1 < W) ? s1 : -__builtin_inff(); }
        if (MODE == 0) {
            float tm = p0[0];
#pragma unroll
            for (int r = 1; r < 16; ++r) tm = fmaxf(tm, p0[r]);
#pragma unroll
            for (int r = 0; r < 16; ++r) tm = fmaxf(tm, p1[r]);
            tm = swapmax(tm);
            const float mn = fmaxf(m, tm); const float alpha = __builtin_amdgcn_exp2f(m - mn); m = mn;
            float ps = 0.f;
#pragma unroll
            for (int r = 0; r < 16; ++r) ps += __builtin_amdgcn_exp2f(p0[r] - mn) + __builtin_amdgcn_exp2f(p1[r] - mn);
            l = l * alpha + swapsum(ps);
        } else if (MODE == 1) {
#pragma unroll
            for (int r = 0; r < 16; ++r) { p0[r] = __builtin_amdgcn_exp2f(p0[r] - m) * invl; p1[r] = __builtin_amdgcn_exp2f(p1[r] - m) * invl; }
            LAS float* pa = partA + (wave * 32 + r32) * 17 + hi; LAS float* pbm = partB + (wave * 32 + r32) * 17 + hi;
#pragma unroll
            for (int rg = 0; rg < 4; ++rg) {
                pa[2 * rg] = (p0[4 * rg] + p0[4 * rg + 1]) + (p0[4 * rg + 2] + p0[4 * rg + 3]); pbm[2 * rg] = p0[4 * rg + 3];
                pa[8 + 2 * rg] = (p1[4 * rg] + p1[4 * rg + 1]) + (p1[4 * rg + 2] + p1[4 * rg + 3]); pbm[8 + 2 * rg] = p1[4 * rg + 3]; }
            const bf16x8 pb[4] = {packp<0>(p0), packp<1>(p0), packp<0>(p1), packp<1>(p1)};
            pv_tile(o, pb, vl + buf * VB);
            __syncthreads();
            { const int qq = tid >> 4, jl = tid & 15; float a = 0.f, bp = 0.f, bl = 0.f;
#pragma unroll
              for (int w = 0; w < 8; ++w) { a += partA[(w * 32 + qq) * 17 + jl]; bl += partB[(w * 32 + qq) * 17 + jl]; }
              if (jl > 0) {
#pragma unroll
                  for (int w = 0; w < 8; ++w) bp += partB[(w * 32 + qq) * 17 + jl - 1];
              } else bp = (j > 0) ? carry[((j - 1) & 1) * 32 + qq] : 0.f;
              imp[qq * 256 + 16 * j + jl] = a + bp;
              if (jl == 15) carry[(j & 1) * 32 + qq] = bl; }
        } else {
            online_sm(p0, p1, m, l, o);
            const bf16x8 pb[4] = {packp<0>(p0), packp<1>(p0), packp<0>(p1), packp<1>(p1)};
            pv_tile(o, pb, vl + buf * VB);
        }
        if (MODE == 1 && j + 1 < ntiles) NSA_LOAD(j + 1);
        if (j + 1 < ntiles) NSA_STORE(buf ^ 1);
        __syncthreads();
    }
#undef NSA_TROW
#undef NSA_LOAD
#undef NSA_STORE
}
__device__ __forceinline__ void nsa_topk(const LAS float* improw, LAS unsigned* selrow, int cur, int lane) {
    unsigned key[4]; bool sel[4];
    int nforced = 0;
#pragma unroll
    for (int k = 0; k < 4; ++k) { const int j = lane + 64 * k;
        const bool forced = (j == 0) || (j == cur) || (j == cur - 1);
        const bool causal = j <= cur;
        sel[k] = forced;
        key[k] = (causal && !forced) ? (__float_as_uint(improw[j]) + 1u) : 0u; }
    nforced = 1 + (cur >= 1 ? 1 : 0) + (cur >= 2 ? 1 : 0);
    const int want = 16 - nforced;
    for (int it = 0; it < want; ++it) {
        unsigned bk = key[0]; int bj = lane;
#pragma unroll
        for (int k = 1; k < 4; ++k) { if (key[k] > bk) { bk = key[k]; bj = lane + 64 * k; } }
        unsigned long long best = ((unsigned long long)bk << 32) | (unsigned)(0xffffffffu - (unsigned)bj);
#pragma unroll
        for (int off = 1; off < 64; off <<= 1) {
            const unsigned lo = __shfl_xor((unsigned)best, off), hiw = __shfl_xor((unsigned)(best >> 32), off);
            const unsigned long long other = ((unsigned long long)hiw << 32) | lo;
            best = other > best ? other : best; }
        if ((unsigned)(best >> 32) == 0u) break;
        const int wj = (int)(0xffffffffu - (unsigned)best);
#pragma unroll
        for (int k = 0; k < 4; ++k) if (wj == lane + 64 * k) { key[k] = 0u; sel[k] = true; }
    }
#pragma unroll
    for (int k = 0; k < 4; ++k) { const unsigned long long bm = __ballot(sel[k]);
        if (lane == 0) { selrow[2 * k] = (unsigned)bm; selrow[2 * k + 1] = (unsigned)(bm >> 32); } }
}
__device__ __forceinline__ int nsa_opaque(int v) { asm volatile("" : "+v"(v)); return v; }
__device__ __forceinline__ void nsa_unit(LAS unsigned char* lds, const NsaPtrs& P, int g, int qblk, int tid_in, int wave, int lane_in, int cu) {
    int tid = tid_in; asm volatile("" : "+v"(tid));
    const int lane = tid & 63; (void)lane_in;
    const int r32 = lane & 31, hi = lane >> 5;
    const int hh = 8 * g + wave, t0 = 32 * qblk, t = t0 + r32;
    const float slope2 = __builtin_amdgcn_exp2f(-0.5f * (float)(hh + 1)) * LOG2E;
    bf16x8 q[8];
    { const bf16* qp = P.Q + (size_t)t * 2048 + hh * 128 + hi * 8;
#pragma unroll
      for (int d0 = 0; d0 < 8; ++d0) q[d0] = *(const GAS bf16x8*)(qp + d0 * 16); }
#define NSA_SCR() ((GAS f32x4*)(P.scr + ((size_t)(cu * 8 + wave) * 16) * 256) + nsa_opaque(lane))
    const size_t CH = (size_t)S * 128 * 2;
    f32x16 o[4]; float m, l;
#define NSA_ZERO_O() do { _Pragma("unroll") for (int d_ = 0; d_ < 4; ++d_) _Pragma("unroll") for (int r_ = 0; r_ < 16; ++r_) o[d_][r_] = 0.f; } while (0)
    const int ncv = 2 * qblk + 1, ntc = (ncv + 63) >> 6;
    const unsigned char* kc = (const unsigned char*)P.KC + (size_t)g * 1024 * 256; const unsigned char* vc = (const unsigned char*)P.VC + (size_t)g * 1024 * 256;
    m = -1e30f; l = 0.f; NSA_ZERO_O();
    nsa_loop<0>(lds, kc, vc, ntc, 0, q, t, slope2, m, l, o, 0.f, tid, wave, lane);
    const float invl = l > 0.f ? 1.f / l : 0.f;
    nsa_loop<1>(lds, kc, vc, ntc, 0, q, t, slope2, m, l, o, invl, tid, wave, lane);
    { const float g_c = P.G[(size_t)t * 48 + hh]; GAS f32x4* scr = NSA_SCR();
#pragma unroll
    for (int d0 = 0; d0 < 4; ++d0)
#pragma unroll
        for (int rg = 0; rg < 4; ++rg) { f32x4 v = {o[d0][4 * rg] * g_c, o[d0][4 * rg + 1] * g_c, o[d0][4 * rg + 2] * g_c, o[d0][4 * rg + 3] * g_c}; scr[(d0 * 4 + rg) * 64] = v; } }
    const int cur = t0 >> 6;
    LAS unsigned* selm = (LAS unsigned*)(lds + N_SELM);
    for (int i = 0; i < 4; ++i) { const int qq = 4 * wave + i; nsa_topk((const LAS float*)(lds + N_IMP) + qq * 256, selm + qq * 8, cur, lane); }
    __syncthreads();
    if (wave == 0) {
        LAS int* ulist = (LAS int*)(lds + N_ULIST); int n = 0;
        for (int k = 0; k < 8; ++k) { unsigned u = (lane < 32) ? selm[lane * 8 + k] : 0u;
#pragma unroll
            for (int off = 1; off < 32; off <<= 1) u |= __shfl_xor(u, off);
            u = __builtin_amdgcn_readfirstlane(u);
            while (u) { const int b = __builtin_ctz(u); u &= u - 1u; if (lane == 0) ulist[n] = 32 * k + b; ++n; } }
        if (lane == 0) *(LAS int*)(lds + N_NTS) = n;
    }
    __syncthreads();
    const int nts = __builtin_amdgcn_readfirstlane(*(const LAS int*)(lds + N_NTS));
    m = -1e30f; l = 0.f; NSA_ZERO_O();
    nsa_loop<2>(lds, (const unsigned char*)P.KV + (size_t)(4 + g) * CH, (const unsigned char*)P.KV + (size_t)(6 + g) * CH, nts, 0, q, t, slope2, m, l, o, 0.f, tid, wave, lane);
    { const float f = P.G[(size_t)t * 48 + 16 + hh] / l; GAS f32x4* scr = NSA_SCR();
#pragma unroll
      for (int d0 = 0; d0 < 4; ++d0)
#pragma unroll
          for (int rg = 0; rg < 4; ++rg) { f32x4 v = scr[(d0 * 4 + rg) * 64]; v[0] += o[d0][4 * rg] * f; v[1] += o[d0][4 * rg + 1] * f; v[2] += o[d0][4 * rg + 2] * f; v[3] += o[d0][4 * rg + 3] * f; scr[(d0 * 4 + rg) * 64] = v; } }
    const int jlo = (t0 > 511 ? t0 - 511 : 0) >> 6, jhi = (t0 + 31) >> 6;
    m = -1e30f; l = 0.f; NSA_ZERO_O();
    nsa_loop<3>(lds, (const unsigned char*)P.KV + (size_t)(8 + g) * CH, (const unsigned char*)P.KV + (size_t)(10 + g) * CH, jhi - jlo + 1, jlo, q, t, slope2, m, l, o, 0.f, tid, wave, lane);
    { const float f = P.G[(size_t)t * 48 + 32 + hh] / l; GAS f32x4* scr = NSA_SCR();
      const bf16* zp = P.Z + (size_t)t * 2048 + hh * 128 + 4 * hi;
      bf16* op = P.O + (size_t)t * 4096 + 2048 + hh * 128 + 4 * hi;
#pragma unroll
      for (int d0 = 0; d0 < 4; ++d0)
#pragma unroll
          for (int rg = 0; rg < 4; ++rg) { const int dim = 32 * d0 + 8 * rg; const f32x4 a = scr[(d0 * 4 + rg) * 64];
              const u32x2 z = *(const GAS u32x2*)(zp + dim);
              u32x2 w; w.x = pk2((a[0] + o[d0][4 * rg] * f) * bflo(z.x), (a[1] + o[d0][4 * rg + 1] * f) * bfhi(z.x)); w.y = pk2((a[2] + o[d0][4 * rg + 2] * f) * bflo(z.y), (a[3] + o[d0][4 * rg + 3] * f) * bfhi(z.y));
              *(GAS u32x2*)(op + dim) = w; } }
#undef NSA_ZERO_O
#undef NSA_SCR
}
struct CmpPtrs { const bf16* KV; const bf16* W1; const bf16* W2; const float* cbp; bf16* KC; bf16* VC; };
__device__ __forceinline__ void cmp_unit(LAS unsigned char* lds, const CmpPtrs& P, int kv, int g, int tile, int tid, int wave, int lane) {
    const int fr = lane & 15, fq = lane >> 4, n = 16 * tile + fr;
    const bf16* A = P.KV + (size_t)(kv * 2 + g) * ((size_t)S * 128) + (size_t)n * 2048 + 8 * fq;
    const bf16* B1 = P.W1 + (size_t)kv * 128 * 4096 + (size_t)(16 * wave + fr) * 4096 + 8 * fq;
    f32x4 acc = {0.f, 0.f, 0.f, 0.f};
#pragma unroll 8
    for (int s = 0; s < 128; ++s) {
        const bf16x8 a = *(const GAS bf16x8*)(A + 32 * s), b = *(const GAS bf16x8*)(B1 + 32 * s);
        acc = __builtin_amdgcn_mfma_f32_16x16x32_bf16(a, b, acc, 0, 0, 0);
    }
    float bias = 0.f;
#pragma unroll
    for (int c = 0; c < 16; ++c) bias += P.cbp[(size_t)(kv * 16 + c) * 128 + 16 * wave + fr];
    LAS bf16* hid = (LAS bf16*)lds;
#pragma unroll
    for (int i = 0; i < 4; ++i) hid[(4 * fq + i) * 136 + 16 * wave + fr] = (bf16)(pk2(silu_f(acc[i] + bias), 0.f) & 0xffffu);
    __syncthreads();
    const bf16* B2 = P.W2 + (size_t)kv * 128 * 128 + (size_t)(16 * wave + fr) * 128 + 8 * fq;
    f32x4 acc2 = {0.f, 0.f, 0.f, 0.f};
#pragma unroll
    for (int s = 0; s < 4; ++s) {
        const bf16x8 a = *(const LAS bf16x8*)(hid + fr * 136 + 32 * s + 8 * fq), b = *(const GAS bf16x8*)(B2 + 32 * s);
        acc2 = __builtin_amdgcn_mfma_f32_16x16x32_bf16(a, b, acc2, 0, 0, 0);
    }
    bf16* out = (kv ? P.VC : P.KC) + (size_t)g * 1024 * 128;
#pragma unroll
    for (int i = 0; i < 4; ++i) { const int nn = 16 * tile + 4 * fq + i; out[(size_t)nn * 128 + 16 * wave + fr] = (nn < 1023) ? (bf16)(pk2(acc2[i], 0.f) & 0xffffu) : (bf16)0; }
    __syncthreads();
}
}
constexpr int PPL = 6;
constexpr int N_PHASES = 2 + PPL * DEPTH;
struct Args { const void* in[16]; float* out; unsigned char* ws; int ph_lo, ph_hi; };
#define WSP(T, off) ((T*)(ws + (off)))
#define VCU() ((gridDim.x % 8 == 0) ? (int)((blockIdx.x % 8) * (gridDim.x / 8) + blockIdx.x / 8) : (int)blockIdx.x)
__global__ void __launch_bounds__(NTHR, 2) mk_fwd(const Args args) {
    extern __shared__ __attribute__((aligned(16))) unsigned char lds_raw[];
    LAS unsigned char* lds = (LAS unsigned char*)lds_raw;
    if (threadIdx.x < 32) ((volatile LAS unsigned*)(lds + MISC_OFF))[threadIdx.x] = 0u;
    __syncthreads();
    XcdBarrier bar = xcd_barrier_post((unsigned*)(args.ws + WS_CTL) + CW_BAR, (volatile LAS unsigned*)(lds + MISC_OFF) + 8);
#define IN(k) (args.ph_lo <= (k) && (k) < args.ph_hi)
#define SEAM(k) do { if (IN(k) && IN((k) + 1)) xcd_barrier(bar); } while (0)
#define PHASE_REGS int tid_ = threadIdx.x; asm volatile("" : "+v"(tid_)); const int tid = tid_, lane = tid & 63, wave = __builtin_amdgcn_readfirstlane(tid >> 6); \
    unsigned char* ws = args.ws; asm volatile("" : "+s"(ws)); (void)tid; (void)lane; (void)wave

    if (IN(0)) {
        PHASE_REGS; const int G = gridDim.x, vcu = VCU();
        p0_mod_gemv((const float*)args.in[1], (const float*)args.in[3], (const float*)args.in[4], WSP(float, WS_MOD), (LAS float*)lds, vcu, G);
        p0_cmpbias((const float*)args.in[10], (const float*)args.in[11], WSP(float, WS_CBP), (LAS float*)lds, (vcu + G / 2) % G, G);
        p0_rope((const int*)args.in[2], WSP(float, WS_ROPE), WSP(float, WS_ROPE) + (size_t)S * 32, vcu * NTHR + tid, G * NTHR);
        const P0In I{(const float*)args.in[5], (const float*)args.in[6], (const float*)args.in[7], (const float*)args.in[8], (const float*)args.in[9], (const float*)args.in[11], (const float*)args.in[12], (const float*)args.in[13]};
#ifndef DIS_CONV
        p0_convert(I, ws, (LAS float*)(lds + wave * 16384), vcu * NWAVES + wave, G * NWAVES, lane);
#endif
    }
    SEAM(0);
    if (IN(1)) { PHASE_REGS; modulate_rows((const float*)args.in[0], WSP(bf16, WS_H), WSP(float, WS_MOD), VCU() * NWAVES + wave, gridDim.x * NWAVES, lane); }
    SEAM(1);
    for (int l = 0; l < DEPTH; ++l) {
        const int pb = 2 + PPL * l;
        if (IN(pb + 0)) {
            PHASE_REGS;
            pg8::Gemm gg{WSP(bf16, WS_H), (const bf16*)(ws + WS_W + (size_t)l * W_LSTRIDE + W_IN), S, NIN, D}; pg8::StaticOrder SO; SO.init(S, NIN, gridDim.x, blockIdx.x);
            const pg8::EpiIn E{ws};
#ifndef DIS_IN
            pg8::gemm_phase<pg8::EpiIn, pg8::StaticOrder, true, true>(lds, gg, SO, E);
#endif
        }
        SEAM(pb + 0);
        if (IN(pb + 1)) {
            PHASE_REGS; const int G = gridDim.x, vcu = VCU();
            rstd_rows(WSP(float, WS_RSQQ), WSP(float, WS_RSQKV), WSP(float, WS_RSTD), WSP(float, WS_RSTD) + S, vcu * NTHR + tid, G * NTHR);
            const att::CmpPtrs CP{WSP(bf16, WS_KVNSA), (const bf16*)(ws + WS_W + (size_t)l * W_LSTRIDE + W_C1), (const bf16*)(ws + WS_W + (size_t)l * W_LSTRIDE + W_C2),
                                  WSP(float, WS_CBP) + (size_t)l * 2 * 16 * 128, WSP(bf16, WS_KCMP), WSP(bf16, WS_VCMP)};
#ifndef DIS_CMP
            for (int u = vcu; u < 256; u += G) att::cmp_unit(lds, CP, u & 1, (u >> 1) & 1, u >> 2, tid, wave, lane);
#endif
        }
        SEAM(pb + 1);
        if (IN(pb + 2)) {
            PHASE_REGS;
            { pg8::Gemm gg{WSP(bf16, WS_QLAT), (const bf16*)(ws + WS_W + (size_t)l * W_LSTRIDE + W_QUP), S, 3072, 768}; pg8::StaticOrder SO; SO.init(S, 3072, gridDim.x, blockIdx.x);
              const pg8::EpiQup E{ws};
#ifndef DIS_QUP
              pg8::gemm_phase<pg8::EpiQup, pg8::StaticOrder, true, true>(lds, gg, SO, E);
#endif
            }
            { pg8::Gemm gg{WSP(bf16, WS_KVLAT), (const bf16*)(ws + WS_W + (size_t)l * W_LSTRIDE + W_KVUP), S, 4096, 512}; pg8::StaticOrder SO; SO.init(S, 4096, gridDim.x, blockIdx.x);
              const pg8::EpiKvup E{ws};
#ifndef DIS_KVUP
              pg8::gemm_phase<pg8::EpiKvup, pg8::StaticOrder, true, true>(lds, gg, SO, E);
#endif
            }
        }
        SEAM(pb + 2);
        if (IN(pb + 3)) {
            PHASE_REGS; const int G = gridDim.x, vcu = VCU();
            { const att::MlaPtrs MP{WSP(bf16, WS_QMLA), WSP(bf16, WS_KMLA), WSP(bf16, WS_VMLA), WSP(bf16, WS_ZMLA), WSP(bf16, WS_H)};
              for (int pu = vcu; pu < 512; pu += G) { const int head = pu >> 5, pr = pu & 31;
#ifndef DIS_MLA
                  att::mla_unit(lds, MP, head, 63 - pr, tid, wave, lane);
                  att::mla_unit(lds, MP, head, pr, tid, wave, lane);
#endif
              } }
            { const att::NsaPtrs NP{WSP(bf16, WS_QNSA), WSP(bf16, WS_KVNSA), WSP(bf16, WS_KCMP), WSP(bf16, WS_VCMP), WSP(bf16, WS_ZNSA), WSP(float, WS_GNSA), WSP(bf16, WS_H), WSP(float, WS_OSCR)};
#ifndef DIS_NSA
              for (int u = vcu; u < 1024; u += G) att::nsa_unit(lds, NP, u & 1, u >> 1, tid, wave, lane, blockIdx.x);
#endif
            }
        }
        SEAM(pb + 3);
        if (IN(pb + 4)) {
            PHASE_REGS;
            pg8::Gemm gg{WSP(bf16, WS_H), (const bf16*)(ws + WS_W + (size_t)l * W_LSTRIDE + W_OUT), S, D, D}; pg8::StaticOrder SO; SO.init(S, D, gridDim.x, blockIdx.x);
            const pg8::EpiOut E{l == 0 ? (const float*)args.in[0] : WSP(const float, WS_XV), l == DEPTH - 1 ? args.out : WSP(float, WS_XV), WSP(const float, WS_MOD) + (size_t)l * 3 * D + 2 * D};
#ifndef DIS_OUT
            pg8::gemm_phase<pg8::EpiOut, pg8::StaticOrder, true, true>(lds, gg, SO, E);
#endif
        }
        SEAM(pb + 4);
        if (IN(pb + 5)) {
            PHASE_REGS;
            float* v = (l == DEPTH - 1) ? args.out : WSP(float, WS_XV);
            ln_rows(v, v, (l == DEPTH - 1) ? nullptr : WSP(bf16, WS_H), (const float*)args.in[14] + (size_t)l * D, (const float*)args.in[15] + (size_t)l * D,
                    WSP(const float, WS_MOD) + (size_t)(l + 1) * 3 * D, VCU() * NWAVES + wave, gridDim.x * NWAVES, lane);
        }
        SEAM(pb + 5);
    }
#undef IN
#undef SEAM
}

#ifndef MK_PER_PHASE
#define MK_PER_PHASE 0
#endif
extern "C" void kernel_launch(void* const* d_in, const int* in_sizes, int n_in, void* d_out, int out_size, void* d_ws, size_t ws_size, hipStream_t stream) {
    static int grid = 0;
    if (grid == 0) {
        if (n_in != 16 || out_size != S * D || ws_size < WS_END) { fprintf(stderr, "kernel_launch: unexpected shapes n_in %d out %d ws %zu\n", n_in, out_size, ws_size); grid = -1; return; }
        int dev = 0, cus = 0;
        if (hipGetDevice(&dev) != hipSuccess || hipDeviceGetAttribute(&cus, hipDeviceAttributeMultiprocessorCount, dev) != hipSuccess) { grid = -1; return; }
        if (hipFuncSetAttribute((const void*)mk_fwd, hipFuncAttributeMaxDynamicSharedMemorySize, LDS_BYTES) != hipSuccess) { grid = -1; return; }
        int per_cu = 0;
        (void)hipOccupancyMaxActiveBlocksPerMultiprocessor(&per_cu, (const void*)mk_fwd, NTHR, LDS_BYTES);
        (void)hipGetLastError();
        if (per_cu < 1) fprintf(stderr, "kernel_launch: occupancy query says %d\n", per_cu);
        grid = cus;
    }
    if (grid < 0) return;
    (void)hipMemsetAsync((char*)d_ws + WS_CTL, 0, CTL_ZERO_BYTES, stream);
    Args a{};
    for (int i = 0; i < 16; ++i) a.in[i] = d_in[i];
    a.out = (float*)d_out; a.ws = (unsigned char*)d_ws;
#if MK_PER_PHASE
    for (int p = 0; p < N_PHASES; ++p) { a.ph_lo = p; a.ph_hi = p + 1; hipLaunchKernelGGL(mk_fwd, dim3(grid), dim3(NTHR), LDS_BYTES, stream, a); }
#else
    a.ph_lo = 0; a.ph_hi = N_PHASES;
    hipLaunchKernelGGL(mk_fwd, dim3(grid), dim3(NTHR), LDS_BYTES, stream, a);
#endif
}
```

```cpp
#include <hip/hip_runtime.h>
#include <cstdio>
#include <cstdint>

#define GAS __attribute__((address_space(1)))
#define LAS __attribute__((address_space(3)))
typedef unsigned short bf16;
typedef float f32x4 __attribute__((ext_vector_type(4)));
typedef float f32x2 __attribute__((ext_vector_type(2)));
typedef float f32x8 __attribute__((ext_vector_type(8)));
typedef float f32x16 __attribute__((ext_vector_type(16)));
typedef unsigned u32x4 __attribute__((ext_vector_type(4)));
typedef unsigned u32x2 __attribute__((ext_vector_type(2)));
typedef short bf16x8 __attribute__((ext_vector_type(8)));
typedef short s16x4 __attribute__((ext_vector_type(4)));
typedef __bf16 bf16x2v __attribute__((ext_vector_type(2)));
typedef __bf16 bf16x8v __attribute__((ext_vector_type(8)));
typedef GAS unsigned gu32;

constexpr int S = 16384, D = 4096, DEPTH = 2;
constexpr int INC = 9072, NIN = 9216;
constexpr float LN_EPS = 1e-5f, RMS_EPS = 1e-6f;
constexpr float DN_ALPHA = 1.41421356237309515f;
constexpr float LOG2E = 1.4426950408889634f;
constexpr float QS_MLA = 0.07216878364870322f * LOG2E;
constexpr float QS_NSA = 0.08838834764831845f * LOG2E;
constexpr int NWAVES = 8, NTHR = 512;
constexpr size_t MiB = 1u << 20;
constexpr size_t WS_CTL = 0, CTL_ZERO_BYTES = 1 * MiB;
constexpr size_t WS_MOD = 1 * MiB;
constexpr size_t WS_ROPE = 2 * MiB;
constexpr size_t WS_CBP = 6 * MiB;
constexpr size_t WS_RSQQ = 7 * MiB;
constexpr size_t WS_RSQKV = 9 * MiB;
constexpr size_t WS_RSTD = 6 * MiB + 512 * 1024;
constexpr size_t WS_GNSA = 10 * MiB;
constexpr size_t WS_KCMP = 13 * MiB;
constexpr size_t WS_VCMP = 13 * MiB + 512 * 1024;
constexpr size_t WS_W = 16 * MiB, W_LSTRIDE = 120 * MiB;
constexpr size_t W_IN = 0, W_QUP = 72 * MiB, W_KVUP = 77 * MiB, W_OUT = 81 * MiB, W_C1 = 113 * MiB, W_C2 = 115 * MiB;
constexpr size_t WS_H = 256 * MiB;
constexpr size_t WS_XV = 384 * MiB;
constexpr size_t WS_QLAT = 640 * MiB, WS_KVLAT = 664 * MiB;
constexpr size_t WS_QMLA = 680 * MiB, WS_KMLA = 776 * MiB, WS_VMLA = 872 * MiB, WS_ZMLA = 936 * MiB, WS_ZNSA = 1000 * MiB, WS_QNSA = 1064 * MiB;
constexpr size_t WS_KVNSA = 1128 * MiB;
constexpr size_t WS_OSCR = 1178 * MiB;
constexpr size_t WS_END = 1210 * MiB;
constexpr int CW_BAR = 4096;
constexpr int LDS_BYTES = 147456;
constexpr int MISC_OFF = LDS_BYTES - 128;

__device__ __forceinline__ unsigned pk2(float lo, float hi) { f32x2 a = {lo, hi}; return __builtin_bit_cast(unsigned, __builtin_convertvector(a, bf16x2v)); }
__device__ __forceinline__ u32x4 pk8(f32x4 a, f32x4 b) { u32x4 w; w.x = pk2(a[0], a[1]); w.y = pk2(a[2], a[3]); w.z = pk2(b[0], b[1]); w.w = pk2(b[2], b[3]); return w; }
__device__ __forceinline__ float bflo(unsigned u) { return __uint_as_float(u << 16); }
__device__ __forceinline__ float bfhi(unsigned u) { return __uint_as_float(u & 0xffff0000u); }
__device__ __forceinline__ float wave_sum(float v) {
#pragma unroll
    for (int o = 1; o < 64; o <<= 1) v += __shfl_xor(v, o);
    return v;
}
__device__ __forceinline__ float silu_f(float v) { return v / (1.f + __expf(-v)); }
__device__ __forceinline__ float sigm_f(float v) { return 1.f / (1.f + __expf(-v)); }

#define XB_TMO      128
#define XB_XCNT(j)  (256  + 64 * (j))
#define XB_XSUB(j)  (1280 + 64 * (j))
#define XB_XGEN(j)  (2304 + 64 * (j))
#define XB_TOP      3328
#define XB_TOPGEN   3392
#define XCD_BAR_WORDS 3456
#define XB_SPIN_CAP (1u << 18)
__device__ __forceinline__ unsigned xb_ld(unsigned* p)              { return __hip_atomic_load(p, __ATOMIC_RELAXED, __HIP_MEMORY_SCOPE_AGENT); }
__device__ __forceinline__ unsigned xb_add(unsigned* p, unsigned v) { return __hip_atomic_fetch_add(p, v, __ATOMIC_RELAXED, __HIP_MEMORY_SCOPE_AGENT); }
__device__ __forceinline__ unsigned xb_xcc_id() { return (unsigned)__builtin_amdgcn_s_getreg((3 << 11) | 20) & 0xFu; }
#define XB_SPIN(cond, bar) do { unsigned _sp = 0; while (cond) { __builtin_amdgcn_s_sleep(1); \
    if ((++_sp & 255u) == 0u) { if (xb_ld(&(bar)[XB_TMO])) break; if (_sp > XB_SPIN_CAP) { atomicAdd(&(bar)[XB_TMO], 1u); break; } } } } while (0)
struct XcdBarrier { unsigned* bar; unsigned x; volatile LAS unsigned* st; };
__device__ __forceinline__ XcdBarrier xcd_barrier_post(unsigned* bar, volatile LAS unsigned* st) {
    XcdBarrier b; b.bar = bar; b.x = xb_xcc_id(); b.st = st;
    if (threadIdx.x == 0) (void)xb_add(&bar[XB_XCNT(b.x)], 1u);
    return b;
}
__device__ __forceinline__ void xcd_barrier_complete(unsigned* bar, unsigned x, unsigned& nloc, unsigned& nx) {
    const unsigned G = gridDim.x * gridDim.y * gridDim.z;
    unsigned sum, cnt, mine, sp = 0u;
    for (;;) {
        sum = 0u; cnt = 0u; mine = 0u;
#pragma unroll
        for (unsigned j = 0; j < 16; ++j) { const unsigned c = xb_ld(&bar[XB_XCNT(j)]); sum += c; cnt += (c > 0u) ? 1u : 0u; mine = (j == x) ? c : mine; }
        if (sum == G) break;
        __builtin_amdgcn_s_sleep(1);
        if ((++sp & 255u) == 0u) { if (xb_ld(&bar[XB_TMO])) break; if (sp > XB_SPIN_CAP) { atomicAdd(&bar[XB_TMO], 1u); break; } }
    }
    nloc = mine > 0u ? mine : 1u; nx = cnt > 0u ? cnt : 1u;
}
__device__ __forceinline__ void xcd_barrier(const XcdBarrier& b) {
    asm volatile("s_waitcnt vmcnt(0)" ::: "memory");
    __syncthreads();
    if (threadIdx.x == 0) {
        unsigned* bar = b.bar;
        __builtin_amdgcn_s_waitcnt(0);
        unsigned nloc = b.st[0], nx = b.st[1];
        if (nloc == 0u) { xcd_barrier_complete(bar, b.x, nloc, nx); b.st[0] = nloc; b.st[1] = nx; }
        const unsigned old = xb_add(&bar[XB_XSUB(b.x)], 1u);
        const unsigned gen = old / nloc;
        if (old + 1u == (gen + 1u) * nloc) {
            __builtin_amdgcn_fence(__ATOMIC_RELEASE, "agent");
            asm volatile("s_waitcnt vmcnt(0)" ::: "memory");
            const unsigned og = xb_add(&bar[XB_TOP], 1u);
            const unsigned tg = og / nx;
            if (og + 1u == (tg + 1u) * nx) xb_add(&bar[XB_TOPGEN], 1u);
            else XB_SPIN(xb_ld(&bar[XB_TOPGEN]) == tg, bar);
            __builtin_amdgcn_fence(__ATOMIC_ACQUIRE, "agent");
            xb_add(&bar[XB_XGEN(b.x)], 1u);
            asm volatile("s_waitcnt vmcnt(0)" ::: "memory");
        } else {
            XB_SPIN(xb_ld(&bar[XB_XGEN(b.x)]) == gen, bar);
            __builtin_amdgcn_fence(__ATOMIC_ACQUIRE, "agent");
            asm volatile("s_waitcnt vmcnt(0)" ::: "memory");
        }
    }
    __syncthreads();
}
__device__ __forceinline__ void p0_mod_gemv(const float* c, const float* w_ada, const float* b_ada, float* mod, LAS float* lds, int vcu, int G) {
    const int tid = threadIdx.x;
    LAS float* sc = lds;
    LAS float* red = lds + 4096;
    for (int k = tid; k < D; k += NTHR) sc[k] = silu_f(c[k]);
    __syncthreads();
    const int cl = tid & 7, kl = tid >> 3;
    constexpr int NU = DEPTH * 3 * D / 32;
    for (int u = vcu; u < NU; u += G) {
        const int l = u / (3 * D / 32), n0 = (u % (3 * D / 32)) * 32;
        const float* W = w_ada + (size_t)l * D * (3 * D) + n0 + cl * 4;
        f32x4 acc = {0.f, 0.f, 0.f, 0.f};
#pragma unroll 8
        for (int i = 0; i < D / 64; ++i) { const int k = kl + 64 * i; const f32x4 w = *(const GAS f32x4*)(W + (size_t)k * (3 * D)); acc += w * sc[k]; }
        red[kl * 33 + cl * 4 + 0] = acc[0]; red[kl * 33 + cl * 4 + 1] = acc[1]; red[kl * 33 + cl * 4 + 2] = acc[2]; red[kl * 33 + cl * 4 + 3] = acc[3];
        __syncthreads();
        if (tid < 32) { float s = 0.f; for (int j = 0; j < 64; ++j) s += red[j * 33 + tid]; mod[(size_t)l * 3 * D + n0 + tid] = s + b_ada[(size_t)l * 3 * D + n0 + tid]; }
        __syncthreads();
    }
}
__device__ __forceinline__ int map_in(int n) {
    if (n < 1280) return n;
    if (n < 1344) { const int i = n - 1280; return 1280 + 2 * (i & 31) + (i >> 5); }
    if (n < 3392) return 1536 + (n - 1344);
    if (n < 5440) return 3584 + (n - 3392);
    if (n < 6976) return 5632 + (n - 5440);
    if (n < 7024) return 1344 + (n - 6976);
    return 7168 + (n - 7024);
}
__device__ __forceinline__ int map_qup(int n) { const int h = n / 192, d = n - h * 192; if (d < 128) return h * 128 + d; const int i = d - 128; return 2048 + h * 64 + 2 * (i & 31) + (i >> 5); }
template <int MAP>
__device__ __forceinline__ void tr_item(const float* W, int K, int N, bf16* WT, const float* kscale, int kb, int nb, int lane) {
    const int k0 = 64 * kb, n = 64 * nb + lane;
    if (n >= N) return;
    const GAS float* src = (const GAS float*)(W + (size_t)k0 * N + n);
    float v[64];
#pragma unroll
    for (int i = 0; i < 64; ++i) v[i] = src[(size_t)i * N];
    if (kscale) {
#pragma unroll
        for (int i = 0; i < 64; ++i) v[i] *= kscale[k0 + i];
    }
    const int row = MAP == 1 ? map_in(n) : (MAP == 2 ? map_qup(n) : n);
    GAS u32x4* dst = (GAS u32x4*)(WT + (size_t)row * K + k0);
#pragma unroll
    for (int c = 0; c < 8; ++c) { u32x4 o; o.x = pk2(v[8 * c], v[8 * c + 1]); o.y = pk2(v[8 * c + 2], v[8 * c + 3]); o.z = pk2(v[8 * c + 4], v[8 * c + 5]); o.w = pk2(v[8 * c + 6], v[8 * c + 7]); dst[c] = o; }
}
struct P0In { const float *w_in, *q_norm, *w_q_up, *kv_norm, *w_kv_up, *w_cmp1, *w_cmp2, *w_out; };
__device__ __forceinline__ void p0_convert(const P0In& I, unsigned char* ws, int gw, int NGW, int lane) {
    constexpr int T_IN = 64 * 142, T_QUP = 12 * 48, T_KVUP = 8 * 64, T_OUT = 64 * 64, T_C1 = 2 * 64 * 2, T_C2 = 2 * 2 * 2;
    constexpr int TL = T_IN + T_QUP + T_KVUP + T_OUT + T_C1 + T_C2;
    for (int it = gw; it < DEPTH * TL; it += NGW) {
        const int l = it / TL; int r = it - l * TL;
        unsigned char* wl = ws + WS_W + (size_t)l * W_LSTRIDE;
        if (r < T_IN) { tr_item<1>(I.w_in + (size_t)l * D * INC, D, INC, (bf16*)(wl + W_IN), nullptr, r / 142, r % 142, lane); continue; } r -= T_IN;
        if (r < T_QUP) { tr_item<2>(I.w_q_up + (size_t)l * 768 * 3072, 768, 3072, (bf16*)(wl + W_QUP), I.q_norm + l * 768, r / 48, r % 48, lane); continue; } r -= T_QUP;
        if (r < T_KVUP) { tr_item<0>(I.w_kv_up + (size_t)l * 512 * 4096, 512, 4096, (bf16*)(wl + W_KVUP), I.kv_norm + l * 512, r / 64, r % 64, lane); continue; } r -= T_KVUP;
        if (r < T_OUT) { tr_item<0>(I.w_out + (size_t)l * D * D, D, D, (bf16*)(wl + W_OUT), nullptr, r / 64, r % 64, lane); continue; } r -= T_OUT;
        if (r < T_C1) { const int kv = r / 128, rr = r % 128; tr_item<0>(I.w_cmp1 + (size_t)(l * 2 + kv) * 4096 * 128, 4096, 128, (bf16*)(wl + W_C1) + (size_t)kv * 128 * 4096, nullptr, rr / 2, rr % 2, lane); continue; } r -= T_C1;
        { const int kv = r / 4, rr = r % 4; tr_item<0>(I.w_cmp2 + (size_t)(l * 2 + kv) * 128 * 128, 128, 128, (bf16*)(wl + W_C2) + (size_t)kv * 128 * 128, nullptr, rr / 2, rr % 2, lane); }
    }
}
__device__ __forceinline__ void p0_rope(const int* positions, float* cosT, float* sinT, int gtid, int NT) {
    for (int e = gtid; e < S * 32; e += NT) { const int s = e >> 5, i = e & 31;
        const float inv = (float)exp(-(double)i * (1.0 / 32.0) * 9.210340371976184);
        const float ang = (float)positions[s] * inv;
        cosT[e] = (float)cos((double)ang); sinT[e] = (float)sin((double)ang); }
}
__device__ __forceinline__ void p0_cmpbias(const float* cmp_pos, const float* w_cmp1, float* cbp, LAS float* red, int vcu, int G) {
    const int tid = threadIdx.x, n = tid & 127, kq = tid >> 7;
    for (int u = vcu; u < 64; u += G) {
        const int lk = u >> 4, ch = u & 15;
        const float* P = cmp_pos + (size_t)lk * 4096 + 256 * ch; const float* W = w_cmp1 + (size_t)lk * 4096 * 128 + (size_t)(256 * ch) * 128 + n;
        float a = 0.f;
#pragma unroll 8
        for (int i = 0; i < 64; ++i) { const int k = kq + 4 * i; a += P[k] * *(const GAS float*)(W + (size_t)k * 128); }
        red[kq * 128 + n] = a;
        __syncthreads();
        if (tid < 128) cbp[(size_t)u * 128 + tid] = (red[tid] + red[128 + tid]) + (red[256 + tid] + red[384 + tid]);
        __syncthreads();
    }
}
__device__ __forceinline__ void modulate_rows(const float* x, bf16* hout, const float* modl, int gw, int NGW, int lane) {
    f32x4 sh[16], sc[16];
#pragma unroll
    for (int j = 0; j < 16; ++j) { sh[j] = *((const GAS f32x4*)modl + lane + 64 * j); sc[j] = *((const GAS f32x4*)(modl + D) + lane + 64 * j) + 1.f; }
    for (int m = gw; m < S; m += NGW) {
        const GAS f32x4* xr = (const GAS f32x4*)(x + (size_t)m * D) + lane;
        GAS u32x2* ho = (GAS u32x2*)(hout + (size_t)m * D) + lane;
#pragma unroll
        for (int j = 0; j < 16; ++j) { const f32x4 h = xr[64 * j] * sc[j] + sh[j]; u32x2 w; w.x = pk2(h[0], h[1]); w.y = pk2(h[2], h[3]); ho[64 * j] = w; }
    }
}
__device__ __forceinline__ void ln_rows(const float* v, float* xout, bf16* hout, const float* g, const float* b, const float* mod_next, int gw, int NGW, int lane) {
    for (int m = gw; m < S; m += NGW) {
        const GAS f32x4* vr = (const GAS f32x4*)(v + (size_t)m * D) + lane;
        f32x4 x[16]; float s = 0.f;
#pragma unroll
        for (int j = 0; j < 16; ++j) { x[j] = vr[64 * j]; s += (x[j][0] + x[j][1]) + (x[j][2] + x[j][3]); }
        const float mean = wave_sum(s) * (1.f / D); float s2 = 0.f;
#pragma unroll
        for (int j = 0; j < 16; ++j) { x[j] = x[j] - mean; s2 += (x[j][0] * x[j][0] + x[j][1] * x[j][1]) + (x[j][2] * x[j][2] + x[j][3] * x[j][3]); }
        const float rstd = 1.f / sqrtf(wave_sum(s2) * (1.f / D) + LN_EPS);
        GAS f32x4* xo = (GAS f32x4*)(xout + (size_t)m * D) + lane;
#pragma unroll
        for (int j = 0; j < 16; ++j) {
            const f32x4 gg = *((const GAS f32x4*)g + lane + 64 * j), bb = *((const GAS f32x4*)b + lane + 64 * j);
#ifdef OSCALE
            const f32x4 y = (x[j] * rstd * gg + bb) * (hout ? 1.f : OSCALE);
#else
            const f32x4 y = x[j] * rstd * gg + bb;
#endif
            xo[64 * j] = y;
            if (hout) {
                const f32x4 sh = *((const GAS f32x4*)mod_next + lane + 64 * j), scl = *((const GAS f32x4*)(mod_next + D) + lane + 64 * j);
                const f32x4 h = y * (scl + 1.f) + sh;
                u32x2 w; w.x = pk2(h[0], h[1]); w.y = pk2(h[2], h[3]);
                *((GAS u32x2*)(hout + (size_t)m * D) + lane + 64 * j) = w;
            }
        }
    }
}
__device__ __forceinline__ void rstd_rows(const float* rsq_q, const float* rsq_kv, float* rstd_q, float* rstd_kv, int gtid, int NT) {
    for (int row = gtid; row < S; row += NT) {
        const GAS f32x4* rp = (const GAS f32x4*)(rsq_q + (size_t)row * 24); float ss = 0.f;
#pragma unroll
        for (int i = 0; i < 6; ++i) { const f32x4 t = rp[i]; ss += (t[0] + t[1]) + (t[2] + t[3]); }
        rstd_q[row] = 1.f / sqrtf(ss * (1.f / 768.f) + RMS_EPS);
        const GAS f32x4* rk = (const GAS f32x4*)(rsq_kv + (size_t)row * 16); float sk = 0.f;
#pragma unroll
        for (int i = 0; i < 4; ++i) { const f32x4 t = rk[i]; sk += (t[0] + t[1]) + (t[2] + t[3]); }
        rstd_kv[row] = 1.f / sqrtf(sk * (1.f / 512.f) + RMS_EPS);
    }
}
namespace pg8 {
#define PG8_LAS __attribute__((address_space(3)))
typedef unsigned short bf16_t;
typedef short bf16x8 __attribute__((ext_vector_type(8)));
typedef float f32x4 __attribute__((ext_vector_type(4)));
typedef unsigned u32x4 __attribute__((ext_vector_type(4)));
constexpr int BM = 256, BK = 64, HALF = 128, HTB = HALF * BK * 2  , STAGE_BYTES = 8 * HTB, NXCD = 8, WGM = 8;

__host__ __device__ __forceinline__ int lds_byte(int r, int c) { const int st = (r >> 4) * 2 + (c >> 5), rr = r & 15, cc = c & 31, ob = rr * 64 + cc * 2; return st * 1024 + (ob ^ (((ob >> 9) & 1) << 5)); }
__host__ __device__ __forceinline__ void stage_rc(int b, int& R, int& C) { const int st = b / 1024, sb = b % 1024, swz = sb ^ (((sb >> 9) & 1) << 5); R = (st >> 1) * 16 + swz / 64; C = (st & 1) * 32 + (swz % 64) / 2; }
__host__ __device__ __forceinline__ int perm32(int rho) { const int n = rho >> 4, i = rho & 15; return 8 * (i >> 2) + 4 * n + (i & 3); }

struct Unit { int pm, pn; };
struct Gemm { const bf16_t* A; const bf16_t* Bt; int M, N, K; };

struct StaticOrder {
    int nM, nN, nwg, G, c;
    __host__ __device__ void init(int M, int N, int G_, int c_) { nM = M / BM; nN = N / BM; nwg = nM * nN; G = G_; c = c_; }
    __host__ __device__ bool next(int i, Unit& u) const {
        const long L = (long)i * G + c; if (L >= nwg) return false;
        int wgid = (int)L; { const int q = nwg / NXCD, r = nwg % NXCD, xcd = wgid % NXCD, off = wgid / NXCD; wgid = (xcd < r ? xcd * (q + 1) : r * (q + 1) + (xcd - r) * q) + off; }
        const int nig = WGM * nN, gid = wgid / nig, fm = gid * WGM, gsz = (nM - fm) < WGM ? (nM - fm) : WGM;
        u.pm = fm + ((wgid % nig) % gsz); u.pn = (wgid % nig) / gsz; return true;
    }
    __device__ __forceinline__ void a_ready(const Unit&) const {}
    __device__ __forceinline__ void done(const Unit&) const {}
};
__device__ __forceinline__ f32x4 rope4(const f32x4 v, float c0, float s0, float c1, float s1) {
    f32x4 o; o[0] = v[0] * c0 - v[1] * s0; o[1] = v[1] * c0 + v[0] * s0; o[2] = v[2] * c1 - v[3] * s1; o[3] = v[3] * c1 + v[2] * s1; return o; }
#ifdef NOISE_BUILD
__device__ __forceinline__ f32x4 nz4(f32x4 v, int row, int col) {
    f32x4 o;
#pragma unroll
    for (int i = 0; i < 4; ++i) { unsigned h = (unsigned)row * 9216u + (unsigned)(col + i); h ^= h >> 16; h *= 0x7feb352du; h ^= h >> 15; h *= 0x846ca68bu; h ^= h >> 16;
        const float r = (float)(int)(h & 0xffffu) * (1.f / 32768.f) - 1.f; o[i] = v[i] * (1.f + NOISE_EPS * r); }
    return o; }
#define NZ(v, row, col) nz4((v), (row), (col))
#else
#define NZ(v, row, col) (v)
#endif
struct EpiIn {
    static constexpr bool PERM = true, AFTER_DRAIN = false;
    unsigned char* ws;
    __device__ __forceinline__ void operator()(const f32x4 (&acc)[2][2][4][2], const Unit& u, int wr, int wc, int fr, int fq) const {
        const int pn = u.pn, row0 = u.pm * BM + wr * 64 + fr;
        if (pn < 5) {
            const bool isq = pn < 3; bf16_t* base = (bf16_t*)(ws + (isq ? WS_QLAT : WS_KVLAT)); const int ld = isq ? 768 : 512, ct = isq ? pn : pn - 3, ns = isq ? 24 : 16; float* rsq = (float*)(ws + (isq ? WS_RSQQ : WS_RSQKV));
#pragma unroll
            for (int ai = 0; ai < 2; ++ai)
#pragma unroll
                for (int m = 0; m < 4; ++m) { const int row = row0 + ai * HALF + m * 16;
#pragma unroll
                    for (int bj = 0; bj < 2; ++bj) { const f32x4 v0 = NZ(acc[ai][bj][m][0], row, pn * 256 + bj * 128 + wc * 32 + 8 * fq), v1 = NZ(acc[ai][bj][m][1], row, pn * 256 + bj * 128 + wc * 32 + 8 * fq + 4);
                        float ss = ((v0[0] * v0[0] + v0[1] * v0[1]) + (v0[2] * v0[2] + v0[3] * v0[3])) + ((v1[0] * v1[0] + v1[1] * v1[1]) + (v1[2] * v1[2] + v1[3] * v1[3]));
                        ss += __shfl_xor(ss, 16); ss += __shfl_xor(ss, 32);
                        if (fq == 0) rsq[(size_t)row * ns + ct * 8 + bj * 4 + wc] = ss;
                        *(GAS u32x4*)(base + (size_t)row * ld + ct * 256 + bj * HALF + wc * 32 + 8 * fq) = pk8(v0, v1); } }
        } else if (pn == 5) {
            if (wc < 2) {
                const int i0 = 16 * wc + 4 * fq; const float* cosT = (const float*)(ws + WS_ROPE); const float* sinT = cosT + (size_t)S * 32; bf16_t* kmla = (bf16_t*)(ws + WS_KMLA);
#pragma unroll
                for (int ai = 0; ai < 2; ++ai)
#pragma unroll
                    for (int m = 0; m < 4; ++m) { const int row = row0 + ai * HALF + m * 16;
                        const f32x4 cs = *(const GAS f32x4*)(cosT + (size_t)row * 32 + i0), sn = *(const GAS f32x4*)(sinT + (size_t)row * 32 + i0);
                        const u32x4 w = pk8(rope4(acc[ai][0][m][0], cs[0], sn[0], cs[1], sn[1]), rope4(acc[ai][0][m][1], cs[2], sn[2], cs[3], sn[3]));
                        bf16_t* dst = kmla + (size_t)row * 3072 + 128 + wc * 32 + 8 * fq;
#pragma unroll
                        for (int h = 0; h < 16; ++h) *(GAS u32x4*)(dst + h * 192) = w;
                        asm volatile("" ::: "memory"); }
            } else {
                const int cl = (wc - 2) * 32 + 8 * fq; float* gnsa = (float*)(ws + WS_GNSA);
                if (cl < 48) {
#pragma unroll
                    for (int ai = 0; ai < 2; ++ai)
#pragma unroll
                        for (int m = 0; m < 4; ++m) { const int row = row0 + ai * HALF + m * 16; const f32x4 v0 = acc[ai][0][m][0], v1 = acc[ai][0][m][1];
                            f32x4 g0, g1; g0[0] = sigm_f(v0[0]); g0[1] = sigm_f(v0[1]); g0[2] = sigm_f(v0[2]); g0[3] = sigm_f(v0[3]); g1[0] = sigm_f(v1[0]); g1[1] = sigm_f(v1[1]); g1[2] = sigm_f(v1[2]); g1[3] = sigm_f(v1[3]);
                            *(GAS f32x4*)(gnsa + (size_t)row * 48 + cl) = g0; *(GAS f32x4*)(gnsa + (size_t)row * 48 + cl + 4) = g1; } }
            }
        } else {
            const int mode = (pn < 14) ? 0 : (pn < 22 ? 1 : (pn < 28 ? 2 : 0));
            bf16_t* base = (pn < 14) ? (bf16_t*)(ws + WS_ZMLA) + (pn - 6) * 256 : (pn < 22 ? (bf16_t*)(ws + WS_QNSA) + (pn - 14) * 256 : (bf16_t*)(ws + WS_ZNSA) + (pn - 28) * 256); bf16_t* kvnsa = (bf16_t*)(ws + WS_KVNSA);
#pragma unroll
            for (int ai = 0; ai < 2; ++ai)
#pragma unroll
                for (int m = 0; m < 4; ++m) { const int row = row0 + ai * HALF + m * 16;
#pragma unroll
                    for (int bj = 0; bj < 2; ++bj) { f32x4 v0 = NZ(acc[ai][bj][m][0], row, pn * 256 + bj * 128 + wc * 32 + 8 * fq), v1 = NZ(acc[ai][bj][m][1], row, pn * 256 + bj * 128 + wc * 32 + 8 * fq + 4);
                        if (mode == 0) { v0[0] = silu_f(v0[0]); v0[1] = silu_f(v0[1]); v0[2] = silu_f(v0[2]); v0[3] = silu_f(v0[3]); v1[0] = silu_f(v1[0]); v1[1] = silu_f(v1[1]); v1[2] = silu_f(v1[2]); v1[3] = silu_f(v1[3]); }
                        else if (mode == 1) { v0 = v0 * QS_NSA; v1 = v1 * QS_NSA; }
                        bf16_t* dst = (mode == 2) ? kvnsa + (size_t)(2 * (pn - 22) + bj) * ((size_t)S * 128) + (size_t)row * 128 + wc * 32 + 8 * fq
                                                  : base + (size_t)row * 2048 + bj * HALF + wc * 32 + 8 * fq;
                        *(GAS u32x4*)dst = pk8(v0, v1); } }
        }
    }
};
struct EpiQup {
    static constexpr bool PERM = true, AFTER_DRAIN = false;
    unsigned char* ws;
    __device__ __forceinline__ void operator()(const f32x4 (&acc)[2][2][4][2], const Unit& u, int wr, int wc, int fr, int fq) const {
        const int pn = u.pn, row0 = u.pm * BM + wr * 64 + fr; bf16_t* qmla = (bf16_t*)(ws + WS_QMLA); const float* rstd_q = (const float*)(ws + WS_RSTD); const float* cosT = (const float*)(ws + WS_ROPE); const float* sinT = cosT + (size_t)S * 32;
#pragma unroll
        for (int ai = 0; ai < 2; ++ai)
#pragma unroll
            for (int m = 0; m < 4; ++m) { const int row = row0 + ai * HALF + m * 16;
                const float sc = QS_MLA * *(const GAS float*)(rstd_q + row);
#pragma unroll
                for (int bj = 0; bj < 2; ++bj) { const f32x4 v0 = acc[ai][bj][m][0] * sc, v1 = acc[ai][bj][m][1] * sc;
                    if (pn < 8) { *(GAS u32x4*)(qmla + (size_t)row * 3072 + (2 * pn + bj) * 192 + wc * 32 + 8 * fq) = pk8(v0, v1); }
                    else { const int cp = (pn - 8) * 256 + bj * HALF + wc * 32 + 8 * fq, head = cp >> 6, dl = cp & 63, i0 = dl >> 1;
                        const f32x4 cs = *(const GAS f32x4*)(cosT + (size_t)row * 32 + i0), sn = *(const GAS f32x4*)(sinT + (size_t)row * 32 + i0);
                        *(GAS u32x4*)(qmla + (size_t)row * 3072 + head * 192 + 128 + dl) = pk8(rope4(v0, cs[0], sn[0], cs[1], sn[1]), rope4(v1, cs[2], sn[2], cs[3], sn[3])); } }
                if (m & 1) asm volatile("" ::: "memory"); }
    }
};
struct EpiKvup {
    static constexpr bool PERM = true, AFTER_DRAIN = false;
    unsigned char* ws;
    __device__ __forceinline__ void operator()(const f32x4 (&acc)[2][2][4][2], const Unit& u, int wr, int wc, int fr, int fq) const {
        const int pn = u.pn, row0 = u.pm * BM + wr * 64 + fr;
#pragma unroll
        for (int ai = 0; ai < 2; ++ai)
#pragma unroll
            for (int m = 0; m < 4; ++m) { const int row = row0 + ai * HALF + m * 16;
                const float sc = *(const GAS float*)((const float*)(ws + WS_RSTD) + S + row); bf16_t* kmla = (bf16_t*)(ws + WS_KMLA); bf16_t* vmla = (bf16_t*)(ws + WS_VMLA);
                *(GAS u32x4*)(kmla + (size_t)row * 3072 + pn * 192 + wc * 32 + 8 * fq) = pk8(acc[ai][0][m][0] * sc, acc[ai][0][m][1] * sc);
                *(GAS u32x4*)(vmla + (size_t)row * 2048 + pn * 128 + wc * 32 + 8 * fq) = pk8(acc[ai][1][m][0] * sc, acc[ai][1][m][1] * sc);
                if (m & 1) asm volatile("" ::: "memory"); }
    }
};
struct EpiOut {
    static constexpr bool PERM = false, AFTER_DRAIN = false;
    const float* x; float* xv; const float* gate;
    __device__ __forceinline__ void operator()(const f32x4 (&acc)[2][2][4][2], const Unit& u, int wr, int wc, int fr, int fq) const {
        const int row0 = u.pm * BM + wr * 64 + fr, col0 = u.pn * BM + wc * 32 + 4 * fq;
        f32x4 gv[2][2];
#pragma unroll
        for (int bj = 0; bj < 2; ++bj)
#pragma unroll
            for (int n = 0; n < 2; ++n) gv[bj][n] = *(const GAS f32x4*)(gate + col0 + bj * HALF + n * 16);
#pragma unroll
        for (int ai = 0; ai < 2; ++ai)
#pragma unroll
            for (int m = 0; m < 4; ++m) { const size_t off = (size_t)(row0 + ai * HALF + m * 16) * D + col0;
#pragma unroll
                for (int bj = 0; bj < 2; ++bj)
#pragma unroll
                    for (int n = 0; n < 2; ++n) { const f32x4 xx = *(const GAS f32x4*)(x + off + bj * HALF + n * 16);
                        #ifdef YSCALE
                        *(GAS f32x4*)(xv + off + bj * HALF + n * 16) = xx * DN_ALPHA + gv[bj][n] * acc[ai][bj][m][n] * YSCALE; }
#else
                        *(GAS f32x4*)(xv + off + bj * HALF + n * 16) = xx * DN_ALPHA + gv[bj][n] * acc[ai][bj][m][n]; }
#endif
                if (m & 1) asm volatile("" ::: "memory"); }
    }
};
template <class Epi, class Sched, bool ALIGN_EPI = false, bool SP2 = false>
__device__ __forceinline__ void gemm_phase(PG8_LAS unsigned char* lds, const Gemm g, const Sched& S, const Epi& E) {
    int tid_ = threadIdx.x; asm volatile("" : "+v"(tid_));
    const int tid = tid_, wid = __builtin_amdgcn_readfirstlane(tid >> 6), lane = tid & 63, wr = wid >> 2, wc = wid & 3, fr = lane & 15, fq = lane >> 4;
    const int K = g.K, nt = K / BK;
    unsigned voffA[2], voffB[2];
#pragma unroll
    for (int i = 0; i < 2; ++i) { int R, C; stage_rc(tid * 16 + i * 8192, R, C); const int Rb = Epi::PERM ? ((R & ~31) + perm32(R & 31)) : R;
        voffA[i] = (unsigned)(R * K + C) * 2u; voffB[i] = (unsigned)(Rb * K + C) * 2u; }
    const size_t kstep = (size_t)(BK * 2);
    const size_t hstep = (size_t)HALF * K * 2;
    const size_t tstep = 2 * hstep;
    const unsigned ldsw = (unsigned)wid * 1024u;
    const int aoff = lds_byte(wr * 64 + fr, fq * 8), boff = lds_byte(wc * 32 + fr, fq * 8);
#define PG8_SA(b, h) (((b) * 2 + (h)) * HTB)
#define PG8_SB(b, h) ((4 + (b) * 2 + (h)) * HTB)
#define PG8_STAGE(bufoff, gbase, voff) do { _Pragma("unroll") for (int _i = 0; _i < 2; ++_i) \
        __builtin_amdgcn_global_load_lds((const unsigned*)((const char*)(gbase) + (voff)[_i]), (PG8_LAS unsigned*)(lds + (bufoff) + ldsw + _i * 8192), 16, 0, 0); } while (0)
#define PG8_LDA(dst, b, h) do { _Pragma("unroll") for (int m = 0; m < 4; ++m) _Pragma("unroll") for (int k = 0; k < 2; ++k) dst[m][k] = *(const PG8_LAS bf16x8*)(lds + PG8_SA(b, h) + aoff + m * 2048 + k * 1024); } while (0)
#define PG8_LDB(dst, b, h) do { _Pragma("unroll") for (int n = 0; n < 2; ++n) _Pragma("unroll") for (int k = 0; k < 2; ++k) dst[n][k] = *(const PG8_LAS bf16x8*)(lds + PG8_SB(b, h) + boff + n * 2048 + k * 1024); } while (0)
#define PG8_MMA(ai, bj, At, Bt) do { __builtin_amdgcn_s_setprio(1); _Pragma("unroll") for (int m = 0; m < 4; ++m) _Pragma("unroll") for (int n = 0; n < 2; ++n) _Pragma("unroll") for (int k = 0; k < 2; ++k) \
        acc[ai][bj][m][n] = __builtin_amdgcn_mfma_f32_16x16x32_bf16(Bt[n][k], At[m][k], acc[ai][bj][m][n], 0, 0, 0); __builtin_amdgcn_s_setprio(0); } while (0)
#define PG8_WAIT_V(n) asm volatile("s_waitcnt vmcnt(" #n ")" ::: "memory")
#define PG8_WAIT_L(n) asm volatile("s_waitcnt lgkmcnt(" #n ")" ::: "memory")
#define PG8_BAR __builtin_amdgcn_s_barrier()
#define PG8_SCHED __builtin_amdgcn_sched_barrier(0)
    Unit cur, nxt; int ui = 0;
    if (!S.next(0, cur)) return;
    f32x4 acc[2][2][4][2];
#pragma unroll
    for (int a = 0; a < 2; ++a)
#pragma unroll
        for (int b = 0; b < 2; ++b)
#pragma unroll
            for (int m = 0; m < 4; ++m)
#pragma unroll
                for (int n = 0; n < 2; ++n) acc[a][b][m][n] = (f32x4){0.f, 0.f, 0.f, 0.f};
    bf16x8 At[4][2], B0[2][2], B1[2][2];
    const char* cA = (const char*)g.A + (size_t)cur.pm * tstep; const char* cB = (const char*)g.Bt + (size_t)cur.pn * tstep;
    S.a_ready(cur);
    if constexpr (SP2) {
        PG8_STAGE(PG8_SB(0, 0), cB, voffB); PG8_STAGE(PG8_SB(0, 1), cB + hstep, voffB); PG8_STAGE(PG8_SA(0, 0), cA, voffA); PG8_STAGE(PG8_SA(0, 1), cA + hstep, voffA);
        if (wr == 1) PG8_BAR;
        PG8_WAIT_V(2); PG8_BAR;
        PG8_STAGE(PG8_SB(1, 0), cB + kstep, voffB); PG8_STAGE(PG8_SA(1, 0), cA + kstep, voffA); PG8_STAGE(PG8_SB(1, 1), cB + hstep + kstep, voffB);
        PG8_WAIT_V(6); PG8_BAR;
    } else {
        PG8_STAGE(PG8_SB(0, 0), cB, voffB); PG8_STAGE(PG8_SA(0, 0), cA, voffA); PG8_STAGE(PG8_SB(0, 1), cB + hstep, voffB); PG8_STAGE(PG8_SA(0, 1), cA + hstep, voffA);
        if (wr == 1) PG8_BAR;
        PG8_WAIT_V(4); PG8_BAR;
        PG8_STAGE(PG8_SB(1, 0), cB + kstep, voffB); PG8_STAGE(PG8_SA(1, 0), cA + kstep, voffA); PG8_STAGE(PG8_SB(1, 1), cB + hstep + kstep, voffB);
        PG8_WAIT_V(6); PG8_BAR;
    }
    for (;;) {
        const bool has_next = S.next(ui + 1, nxt);
        const char* nA = has_next ? (const char*)g.A + (size_t)nxt.pm * tstep : cA; const char* nB = has_next ? (const char*)g.Bt + (size_t)nxt.pn * tstep : cB;
        for (int t = 0; t < nt; t += 2) {
            const bool last = (t == nt - 2);
            const char* a1 = cA + (size_t)(t + 1) * kstep;
            const char* a2 = last ? nA : cA + (size_t)(t + 2) * kstep; const char* b2 = last ? nB : cB + (size_t)(t + 2) * kstep;
            const char* a3 = a2 + kstep; const char* b3 = b2 + kstep;
            if (last && has_next) S.a_ready(nxt);
            if constexpr (SP2) {
            PG8_LDB(B0, 0, 0); PG8_LDB(B1, 0, 1); PG8_SCHED; PG8_LDA(At, 0, 0); PG8_STAGE(PG8_SA(1, 1), a1 + hstep, voffA);
            PG8_WAIT_V(8); PG8_WAIT_L(0); PG8_BAR; PG8_MMA(0, 0, At, B0); PG8_MMA(0, 1, At, B1); PG8_BAR; PG8_SCHED;
            PG8_LDA(At, 0, 1); PG8_STAGE(PG8_SB(0, 0), b2, voffB); PG8_STAGE(PG8_SB(0, 1), b2 + hstep, voffB); PG8_STAGE(PG8_SA(0, 0), a2, voffA);
            PG8_WAIT_V(8); PG8_WAIT_L(0); PG8_BAR; PG8_MMA(1, 0, At, B0); PG8_MMA(1, 1, At, B1); PG8_BAR; PG8_SCHED;
            PG8_LDB(B0, 1, 0); PG8_LDB(B1, 1, 1); PG8_SCHED; PG8_LDA(At, 1, 0); PG8_STAGE(PG8_SA(0, 1), a2 + hstep, voffA);
            PG8_WAIT_V(8); PG8_WAIT_L(0); PG8_BAR; PG8_MMA(0, 0, At, B0); PG8_MMA(0, 1, At, B1); PG8_BAR; PG8_SCHED;
            PG8_LDA(At, 1, 1); PG8_STAGE(PG8_SB(1, 0), b3, voffB); PG8_STAGE(PG8_SB(1, 1), b3 + hstep, voffB); PG8_STAGE(PG8_SA(1, 0), a3, voffA);
            PG8_WAIT_V(8); PG8_WAIT_L(0); PG8_BAR; PG8_MMA(1, 0, At, B0); PG8_MMA(1, 1, At, B1); PG8_BAR; PG8_SCHED;
            } else {
            PG8_LDB(B0, 0, 0); PG8_SCHED; PG8_LDA(At, 0, 0); PG8_STAGE(PG8_SA(1, 1), a1 + hstep, voffA);
            PG8_WAIT_L(8); PG8_BAR; PG8_WAIT_L(0); PG8_MMA(0, 0, At, B0); PG8_BAR; PG8_SCHED;
            PG8_LDB(B1, 0, 1); PG8_STAGE(PG8_SB(0, 0), b2, voffB);
            PG8_BAR; PG8_WAIT_L(0); PG8_MMA(0, 1, At, B1); PG8_BAR;
            PG8_LDA(At, 0, 1); PG8_STAGE(PG8_SA(0, 0), a2, voffA);
            PG8_BAR; PG8_WAIT_L(0); PG8_MMA(1, 0, At, B0); PG8_BAR; PG8_SCHED;
            PG8_STAGE(PG8_SB(0, 1), b2 + hstep, voffB);
            PG8_WAIT_V(6); PG8_BAR; PG8_MMA(1, 1, At, B1); PG8_BAR;
            PG8_LDB(B0, 1, 0); PG8_SCHED; PG8_LDA(At, 1, 0); PG8_STAGE(PG8_SA(0, 1), a2 + hstep, voffA);
            PG8_WAIT_L(8); PG8_BAR; PG8_WAIT_L(0); PG8_MMA(0, 0, At, B0); PG8_BAR; PG8_SCHED;
            PG8_LDB(B1, 1, 1); PG8_STAGE(PG8_SB(1, 0), b3, voffB);
            PG8_BAR; PG8_WAIT_L(0); PG8_MMA(0, 1, At, B1); PG8_BAR;
            PG8_LDA(At, 1, 1); PG8_STAGE(PG8_SA(1, 0), a3, voffA);
            PG8_BAR; PG8_WAIT_L(0); PG8_MMA(1, 0, At, B0); PG8_BAR; PG8_SCHED;
            PG8_STAGE(PG8_SB(1, 1), b3 + hstep, voffB);
            PG8_WAIT_V(6); PG8_BAR; PG8_MMA(1, 1, At, B1); PG8_BAR;
            }
        }
        if constexpr (ALIGN_EPI) { if (wr == 0) PG8_BAR; }
        if constexpr (!Epi::AFTER_DRAIN) { E(acc, cur, wr, wc, fr, fq); S.done(cur); }
        if (!has_next) break;
#pragma unroll
        for (int a = 0; a < 2; ++a)
#pragma unroll
            for (int b = 0; b < 2; ++b)
#pragma unroll
                for (int m = 0; m < 4; ++m)
#pragma unroll
                    for (int n = 0; n < 2; ++n) acc[a][b][m][n] = (f32x4){0.f, 0.f, 0.f, 0.f};
        cur = nxt; cA = nA; cB = nB; ++ui;
        if constexpr (ALIGN_EPI) { if (wr == 1) PG8_BAR; }
    }
    PG8_WAIT_V(0);
    if constexpr (!ALIGN_EPI) { if (wr == 0) PG8_BAR; }
    PG8_BAR;
    if constexpr (Epi::AFTER_DRAIN) { E.fused(acc, cur, wr, wc, fr, fq, lds, wid, lane); S.done(cur); }
#undef PG8_SA
#undef PG8_SB
#undef PG8_STAGE
#undef PG8_LDA
#undef PG8_LDB
#undef PG8_MMA
#undef PG8_WAIT_V
#undef PG8_WAIT_L
#undef PG8_BAR
#undef PG8_SCHED
}
}
namespace att {
constexpr int KS_M = 400, KS_N = 272, VS = 320;
constexpr int MLA_KB = 64 * KS_M, NSA_KB = 64 * KS_N, VB = 64 * VS;
constexpr int N_IMP = 2 * NSA_KB + 2 * VB;
constexpr int N_PART = N_IMP + 32768;
constexpr int N_PARTB = 8 * 32 * 17 * 4;
constexpr int N_SELM = N_PART + 2 * N_PARTB;
constexpr int N_ULIST = N_SELM + 1024;
constexpr int N_CARRY = N_ULIST + 1024;
constexpr int N_NTS = N_CARRY + 256;
static_assert(N_NTS + 16 <= MISC_OFF, "NSA LDS map");
static_assert(2 * MLA_KB + 3 * VB <= 131072, "MLA LDS map");

#define MFMA32(a, b, c) __builtin_amdgcn_mfma_f32_32x32x16_bf16((a), (b), (c), 0, 0, 0)
__device__ __forceinline__ float swapmax(float v) { auto rr = __builtin_amdgcn_permlane32_swap(__float_as_uint(v), __float_as_uint(v), false, false); return fmaxf(__uint_as_float(rr[0]), __uint_as_float(rr[1])); }
__device__ __forceinline__ float swapsum(float v) { auto rr = __builtin_amdgcn_permlane32_swap(__float_as_uint(v), __float_as_uint(v), false, false); return __uint_as_float(rr[0]) + __uint_as_float(rr[1]); }
template <int SIDX> __device__ __forceinline__ bf16x8 packp(const f32x16& p) {
    f32x8 t = {p[8 * SIDX + 0], p[8 * SIDX + 1], p[8 * SIDX + 2], p[8 * SIDX + 3], p[8 * SIDX + 4], p[8 * SIDX + 5], p[8 * SIDX + 6], p[8 * SIDX + 7]};
    return __builtin_bit_cast(bf16x8, __builtin_convertvector(t, bf16x8v));
}
template <int NDC, int KS> __device__ __forceinline__ void qk_tile(f32x16& p0, f32x16& p1, const LAS unsigned char* kl, const bf16x8 (&q)[NDC]) {
#pragma unroll
    for (int i = 0; i < 16; ++i) { p0[i] = 0.f; p1[i] = 0.f; }
    bf16x8 a[3][2];
    a[0][0] = *(const LAS bf16x8*)(kl); a[0][1] = *(const LAS bf16x8*)(kl + 32 * KS);
    a[1][0] = *(const LAS bf16x8*)(kl + 32); a[1][1] = *(const LAS bf16x8*)(kl + 32 * KS + 32);
#pragma unroll
    for (int d0 = 0; d0 < NDC; ++d0) {
        if (d0 + 2 < NDC) { a[(d0 + 2) % 3][0] = *(const LAS bf16x8*)(kl + (d0 + 2) * 32); a[(d0 + 2) % 3][1] = *(const LAS bf16x8*)(kl + 32 * KS + (d0 + 2) * 32); }
        __builtin_amdgcn_sched_barrier(0);
        p0 = MFMA32(a[d0 % 3][0], q[d0], p0); p1 = MFMA32(a[d0 % 3][1], q[d0], p1);
        __builtin_amdgcn_sched_barrier(0);
    }
}
__device__ __forceinline__ void pv_tile(f32x16 (&o)[4], const bf16x8 (&pb)[4], const LAS unsigned char* vl) {
    s16x4 f[5][2];
#define PV_LD(idx) do { constexpr int d_ = (idx) >> 2, s_ = (idx) & 3; \
        f[(idx) % 5][0] = __builtin_amdgcn_ds_read_tr16_b64_v4i16((LAS s16x4*)(vl + s_ * 16 * VS + d_ * 64)); \
        f[(idx) % 5][1] = __builtin_amdgcn_ds_read_tr16_b64_v4i16((LAS s16x4*)(vl + s_ * 16 * VS + 8 * VS + d_ * 64)); } while (0)
    PV_LD(0); PV_LD(1); PV_LD(2); PV_LD(3);
#define PV_STEP(idx) do { if ((idx) + 4 < 16) PV_LD((idx) + 4); __builtin_amdgcn_sched_barrier(0); \
        { const s16x4 t0_ = f[(idx) % 5][0], t1_ = f[(idx) % 5][1]; const bf16x8 vf_ = {t0_[0], t0_[1], t0_[2], t0_[3], t1_[0], t1_[1], t1_[2], t1_[3]}; \
          o[(idx) >> 2] = MFMA32(vf_, pb[(idx) & 3], o[(idx) >> 2]); } __builtin_amdgcn_sched_barrier(0); } while (0)
    PV_STEP(0); PV_STEP(1); PV_STEP(2); PV_STEP(3); PV_STEP(4); PV_STEP(5); PV_STEP(6); PV_STEP(7);
    PV_STEP(8); PV_STEP(9); PV_STEP(10); PV_STEP(11); PV_STEP(12); PV_STEP(13); PV_STEP(14); PV_STEP(15);
#undef PV_STEP
#undef PV_LD
}
__device__ __forceinline__ void online_sm(f32x16& p0, f32x16& p1, float& m, float& l, f32x16 (&o)[4]) {
    float tm = p0[0];
#pragma unroll
    for (int r = 1; r < 16; ++r) tm = fmaxf(tm, p0[r]);
#pragma unroll
    for (int r = 0; r < 16; ++r) tm = fmaxf(tm, p1[r]);
    tm = swapmax(tm);
    const float mn = fmaxf(m, tm);
    const float alpha = __builtin_amdgcn_exp2f(m - mn);
    m = mn;
    float ps = 0.f;
#pragma unroll
    for (int r = 0; r < 16; ++r) { p0[r] = __builtin_amdgcn_exp2f(p0[r] - mn); ps += p0[r]; }
#pragma unroll
    for (int r = 0; r < 16; ++r) { p1[r] = __builtin_amdgcn_exp2f(p1[r] - mn); ps += p1[r]; }
    ps = swapsum(ps);
    l = l * alpha + ps;
    if (!__all(alpha == 1.f)) {
#pragma unroll
        for (int d = 0; d < 4; ++d)
#pragma unroll
            for (int r = 0; r < 16; ++r) o[d][r] *= alpha;
    }
}

struct MlaPtrs { const bf16* Q; const bf16* K; const bf16* V; const bf16* Z; bf16* O; };
__device__ __forceinline__ void mla_unit(LAS unsigned char* lds, const MlaPtrs& P, int head, int qb, int tid_in, int wave, int lane_in) {
    int tid = tid_in; asm volatile("" : "+v"(tid)); const int lane = tid & 63; (void)lane_in;
    const int r32 = lane & 31, hi = lane >> 5;
    const int q0 = qb * 256, qw = q0 + wave * 32, tq = qw + r32;
    bf16x8 q[12];
    { const bf16* qp = P.Q + (size_t)tq * 3072 + head * 192 + hi * 8;
#pragma unroll
      for (int d0 = 0; d0 < 12; ++d0) q[d0] = *(const GAS bf16x8*)(qp + d0 * 16); }
    const int NT = 4 * (qb + 1);
    const int srow = tid >> 3, sc8 = tid & 7;
    const unsigned char* kg = (const unsigned char*)P.K + (size_t)head * 384 + (size_t)srow * 6144 + sc8 * 16;
    const unsigned char* vg = (const unsigned char*)P.V + (size_t)head * 256 + (size_t)srow * 4096 + sc8 * 16;
    LAS unsigned char* kst = lds + srow * KS_M + sc8 * 16;
    LAS unsigned char* vst = lds + 2 * MLA_KB + srow * VS + sc8 * 16;
    const LAS unsigned char* kl = lds + r32 * KS_M + hi * 16;
    const LAS unsigned char* vl = lds + 2 * MLA_KB + (4 * hi + ((lane & 15) >> 2)) * VS + (16 * ((lane >> 4) & 1) + 4 * (lane & 3)) * 2;
    u32x4 sk0, sk1, sk2, sv0, sv1;
#define MLA_LOAD(j) do { const unsigned char* kp_ = kg + (size_t)(j) * (64 * 6144); const unsigned char* vp_ = vg + (size_t)(j) * (64 * 4096); \
        sk0 = *(const GAS u32x4*)(kp_); sk1 = *(const GAS u32x4*)(kp_ + 128); sk2 = *(const GAS u32x4*)(kp_ + 256); sv0 = *(const GAS u32x4*)(vp_); sv1 = *(const GAS u32x4*)(vp_ + 128); } while (0)
#define MLA_STORE(b, vb) do { LAS unsigned char* kd_ = kst + (b) * MLA_KB; LAS unsigned char* vd_ = vst + (vb) * VB; \
        *(LAS u32x4*)(kd_) = sk0; *(LAS u32x4*)(kd_ + 128) = sk1; *(LAS u32x4*)(kd_ + 256) = sk2; *(LAS u32x4*)(vd_) = sv0; *(LAS u32x4*)(vd_ + 128) = sv1; } while (0)
    MLA_LOAD(0); MLA_STORE(0, 0);
    __syncthreads();
    float m = -1e30f, l = 0.f; f32x16 o[4];
#pragma unroll
    for (int d = 0; d < 4; ++d)
#pragma unroll
        for (int r = 0; r < 16; ++r) o[d][r] = 0.f;
    const bool trail = wave >= 4;
    bf16x8 pb[4] = {};
    int vb_cur = 0, vb_prev = 2;
    for (int j = 0; j < NT; ++j) {
        const int kb = 64 * j;
        int vb_next = vb_cur + 1; if (vb_next == 3) vb_next = 0;
        if (j + 1 < NT) MLA_LOAD(j + 1);
        if (trail && j > 0 && kb - 64 <= qw + 31) pv_tile(o, pb, vl + vb_prev * VB);
        if (kb <= qw + 31) {
            f32x16 p0, p1;
            qk_tile<12, KS_M>(p0, p1, kl + (j & 1) * MLA_KB, q);
            if (kb + 63 > qw) {
                const int dq = tq - kb - 4 * hi;
#pragma unroll
                for (int r = 0; r < 16; ++r) { const int c = (r & 3) + 8 * (r >> 2);
                    if (c > dq) p0[r] = -__builtin_inff();
                    if (c + 32 > dq) p1[r] = -__builtin_inff(); }
            }
            online_sm(p0, p1, m, l, o);
            pb[0] = packp<0>(p0); pb[1] = packp<1>(p0); pb[2] = packp<0>(p1); pb[3] = packp<1>(p1);
            if (!trail) pv_tile(o, pb, vl + vb_cur * VB);
        }
        if (j + 1 < NT) MLA_STORE((j + 1) & 1, vb_next);
        __syncthreads();
        vb_prev = vb_cur; vb_cur = vb_next;
    }
    if (trail && 64 * (NT - 1) <= qw + 31) pv_tile(o, pb, vl + vb_prev * VB);
    __syncthreads();
#undef MLA_LOAD
#undef MLA_STORE
    const float inv = 1.f / l;
    const bf16* zp = P.Z + (size_t)tq * 2048 + head * 128 + 4 * hi;
    bf16* op = P.O + (size_t)tq * 4096 + head * 128 + 4 * hi;
#pragma unroll
    for (int d0 = 0; d0 < 4; ++d0)
#pragma unroll
        for (int rg = 0; rg < 4; ++rg) { const int dim = 32 * d0 + 8 * rg;
            const u32x2 z = *(const GAS u32x2*)(zp + dim);
            u32x2 w; w.x = pk2(o[d0][4 * rg + 0] * inv * bflo(z.x), o[d0][4 * rg + 1] * inv * bfhi(z.x)); w.y = pk2(o[d0][4 * rg + 2] * inv * bflo(z.y), o[d0][4 * rg + 3] * inv * bfhi(z.y));
            *(GAS u32x2*)(op + dim) = w; }
}

struct NsaPtrs { const bf16* Q; const bf16* KV; const bf16* KC; const bf16* VC; const bf16* Z; const float* G; bf16* O; float* scr; };
template <int MODE>
__device__ __forceinline__ void nsa_loop(LAS unsigned char* lds, const unsigned char* kbase, const unsigned char* vbase, int ntiles, int jlo,
                                         const bf16x8 (&q)[8], int t, float slope2, float& m, float& l, f32x16 (&o)[4], float invl, int tid, int wave, int lane) {
    constexpr bool HASV = MODE != 0;
    const int r32 = lane & 31, hi = lane >> 5;
    const int srow = tid >> 3, sc8 = tid & 7;
    const unsigned soff = srow * 256 + sc8 * 16;
    LAS unsigned char* kst = lds + srow * KS_N + sc8 * 16;
    LAS unsigned char* vst = lds + 2 * NSA_KB + srow * VS + sc8 * 16;
    const LAS unsigned char* kl = lds + r32 * KS_N + hi * 16;
    const LAS unsigned char* vl = lds + 2 * NSA_KB + (4 * hi + ((lane & 15) >> 2)) * VS + (16 * ((lane >> 4) & 1) + 4 * (lane & 3)) * 2;
    const LAS int* ulist = (const LAS int*)(lds + N_ULIST);
    const LAS unsigned* selm = (const LAS unsigned*)(lds + N_SELM);
    LAS float* partA = (LAS float*)(lds + N_PART); LAS float* partB = (LAS float*)(lds + N_PART + N_PARTB);
    LAS float* imp = (LAS float*)(lds + N_IMP); LAS float* carry = (LAS float*)(lds + N_CARRY);
    if (ntiles <= 0) return;
    u32x4 sk0, sk1, sv0, sv1;
#define NSA_TROW(j) (MODE == 2 ? 64 * __builtin_amdgcn_readfirstlane(ulist[(j)]) : 64 * (jlo + (j)))
#define NSA_LOAD(j) do { const size_t ro_ = (size_t)NSA_TROW(j) * 256 + soff; \
        sk0 = *(const GAS u32x4*)(kbase + ro_); sk1 = *(const GAS u32x4*)(kbase + ro_ + 128); \
        if (HASV) { sv0 = *(const GAS u32x4*)(vbase + ro_); sv1 = *(const GAS u32x4*)(vbase + ro_ + 128); } } while (0)
#define NSA_STORE(b) do { LAS unsigned char* kd_ = kst + (b) * NSA_KB; *(LAS u32x4*)(kd_) = sk0; *(LAS u32x4*)(kd_ + 128) = sk1; \
        if (HASV) { LAS unsigned char* vd_ = vst + (b) * VB; *(LAS u32x4*)(vd_) = sv0; *(LAS u32x4*)(vd_ + 128) = sv1; } } while (0)
    NSA_LOAD(0); NSA_STORE(0);
    __syncthreads();
    for (int j = 0; j < ntiles; ++j) {
        const int buf = j & 1;
        if (MODE != 1 && j + 1 < ntiles) NSA_LOAD(j + 1);
        f32x16 p0, p1;
        qk_tile<8, KS_N>(p0, p1, kl + buf * NSA_KB, q);
        const int trow = NSA_TROW(j);
        constexpr int PSTEP = (MODE <= 1) ? 16 : 1;
        const int pstart = (MODE <= 1) ? 16 * trow + 31 : trow;
        const int db = t - pstart - PSTEP * 4 * hi;
        const float nslope = -slope2;
        bool selb = true;
        if (MODE == 2) { const int b = trow >> 6; selb = ((selm[r32 * 8 + (b >> 5)] >> (b & 31)) & 1u) != 0u; }
        const unsigned W = (MODE == 3) ? 512u : 0x7fffffffu;
#pragma unroll
        for (int r = 0; r < 16; ++r) { const int c = PSTEP * ((r & 3) + 8 * (r >> 2));
            const int e0 = db - c, e1 = db - c - 32 * PSTEP;
            const float s0 = __builtin_fmaf(nslope, (float)e0, p0[r]);
            const float s1 = __builtin_fmaf(nslope, (float)e1, p1[r]);
            p0[r] = (selb && (unsigned)e0 < W) ? s0 : -__builtin_inff();
            p1[r] = (selb && (unsigned)e1 < W) ? s1 : -__builtin_inff(); }
        if (MODE == 0) {
            float tm = p0[0];
#pragma unroll
            for (int r = 1; r < 16; ++r) tm = fmaxf(tm, p0[r]);
#pragma unroll
            for (int r = 0; r < 16; ++r) tm = fmaxf(tm, p1[r]);
            tm = swapmax(tm);
            const float mn = fmaxf(m, tm); const float alpha = __builtin_amdgcn_exp2f(m - mn); m = mn;
            float ps = 0.f;
#pragma unroll
            for (int r = 0; r < 16; ++r) ps += __builtin_amdgcn_exp2f(p0[r] - mn) + __builtin_amdgcn_exp2f(p1[r] - mn);
            l = l * alpha + swapsum(ps);
        } else if (MODE == 1) {
#pragma unroll
            for (int r = 0; r < 16; ++r) { p0[r] = __builtin_amdgcn_exp2f(p0[r] - m) * invl; p1[r] = __builtin_amdgcn_exp2f(p1[r] - m) * invl; }
            LAS float* pa = partA + (wave * 32 + r32) * 17 + hi; LAS float* pbm = partB + (wave * 32 + r32) * 17 + hi;
#pragma unroll
            for (int rg = 0; rg < 4; ++rg) {
                pa[2 * rg] = (p0[4 * rg] + p0[4 * rg + 1]) + (p0[4 * rg + 2] + p0[4 * rg + 3]); pbm[2 * rg] = p0[4 * rg + 3];
                pa[8 + 2 * rg] = (p1[4 * rg] + p1[4 * rg + 1]) + (p1[4 * rg + 2] + p1[4 * rg + 3]); pbm[8 + 2 * rg] = p1[4 * rg + 3]; }
            const bf16x8 pb[4] = {packp<0>(p0), packp<1>(p0), packp<0>(p1), packp<1>(p1)};
            pv_tile(o, pb, vl + buf * VB);
            __syncthreads();
            { const int qq = tid >> 4, jl = tid & 15; float a = 0.f, bp = 0.f, bl = 0.f;
#pragma unroll
              for (int w = 0; w < 8; ++w) { a += partA[(w * 32 + qq) * 17 + jl]; bl += partB[(w * 32 + qq) * 17 + jl]; }
              if (jl > 0) {
#pragma unroll
                  for (int w = 0; w < 8; ++w) bp += partB[(w * 32 + qq) * 17 + jl - 1];
              } else bp = (j > 0) ? carry[((j - 1) & 1) * 32 + qq] : 0.f;
              imp[qq * 256 + 16 * j + jl] = a + bp;
              if (jl == 15) carry[(j & 1) * 32 + qq] = bl; }
        } else {
            online_sm(p0, p1, m, l, o);
            const bf16x8 pb[4] = {packp<0>(p0), packp<1>(p0), packp<0>(p1), packp<1>(p1)};
            pv_tile(o, pb, vl + buf * VB);
        }
        if (MODE == 1 && j + 1 < ntiles) NSA_LOAD(j + 1);
        if (j + 1 < ntiles) NSA_STORE(buf ^ 1);
        __syncthreads();
    }
#undef NSA_TROW
#undef NSA_LOAD
#undef NSA_STORE
}
__device__ __forceinline__ void nsa_topk(const LAS float* improw, LAS unsigned* selrow, int cur, int lane) {
    unsigned key[4]; bool sel[4];
    int nforced = 0;
#pragma unroll
    for (int k = 0; k < 4; ++k) { const int j = lane + 64 * k;
        const bool forced = (j == 0) || (j == cur) || (j == cur - 1);
        const bool causal = j <= cur;
        sel[k] = forced;
#ifdef IMPNOISE_BUILD
        { unsigned h = (unsigned)j * 2654435761u + (unsigned)(size_t)improw * 40503u; h ^= h >> 15; h *= 0x846ca68bu; h ^= h >> 16;
          const float r = (float)(int)(h & 0xffffu) * (1.f / 32768.f) - 1.f; const float v = improw[j] * (1.f + IMPNOISE_EPS * r);
          key[k] = (causal && !forced) ? (__float_as_uint(v) + 1u) : 0u; }
#else
        key[k] = (causal && !forced) ? (__float_as_uint(improw[j]) + 1u) : 0u;
#endif
    }
    nforced = 1 + (cur >= 1 ? 1 : 0) + (cur >= 2 ? 1 : 0);
    const int want = 16 - nforced;
    for (int it = 0; it < want; ++it) {
        unsigned bk = key[0]; int bj = lane;
#pragma unroll
        for (int k = 1; k < 4; ++k) { if (key[k] > bk) { bk = key[k]; bj = lane + 64 * k; } }
        unsigned long long best = ((unsigned long long)bk << 32) | (unsigned)(0xffffffffu - (unsigned)bj);
#pragma unroll
        for (int off = 1; off < 64; off <<= 1) {
            const unsigned lo = __shfl_xor((unsigned)best, off), hiw = __shfl_xor((unsigned)(best >> 32), off);
            const unsigned long long other = ((unsigned long long)hiw << 32) | lo;
            best = other > best ? other : best; }
        if ((unsigned)(best >> 32) == 0u) break;
        const int wj = (int)(0xffffffffu - (unsigned)best);
#pragma unroll
        for (int k = 0; k < 4; ++k) if (wj == lane + 64 * k) { key[k] = 0u; sel[k] = true; }
    }
#pragma unroll
    for (int k = 0; k < 4; ++k) { const unsigned long long bm = __ballot(sel[k]);
        if (lane == 0) { selrow[2 * k] = (unsigned)bm; selrow[2 * k + 1] = (unsigned)(bm >> 32); } }
}
__device__ __forceinline__ int nsa_opaque(int v) { asm volatile("" : "+v"(v)); return v; }
__device__ __forceinline__ void nsa_unit(LAS unsigned char* lds, const NsaPtrs& P, int g, int qblk, int tid_in, int wave, int lane_in, int cu) {
    int tid = tid_in; asm volatile("" : "+v"(tid));
    const int lane = tid & 63; (void)lane_in;
    const int r32 = lane & 31, hi = lane >> 5;
    const int hh = 8 * g + wave, t0 = 32 * qblk, t = t0 + r32;
    const float slope2 = __builtin_amdgcn_exp2f(-0.5f * (float)(hh + 1)) * LOG2E;
    bf16x8 q[8];
    { const bf16* qp = P.Q + (size_t)t * 2048 + hh * 128 + hi * 8;
#pragma unroll
      for (int d0 = 0; d0 < 8; ++d0) q[d0] = *(const GAS bf16x8*)(qp + d0 * 16); }
#define NSA_SCR() ((GAS f32x4*)(P.scr + ((size_t)(cu * 8 + wave) * 16) * 256) + nsa_opaque(lane))
    const size_t CH = (size_t)S * 128 * 2;
    f32x16 o[4]; float m, l;
#define NSA_ZERO_O() do { _Pragma("unroll") for (int d_ = 0; d_ < 4; ++d_) _Pragma("unroll") for (int r_ = 0; r_ < 16; ++r_) o[d_][r_] = 0.f; } while (0)
    const int ncv = 2 * qblk + 1, ntc = (ncv + 63) >> 6;
    const unsigned char* kc = (const unsigned char*)P.KC + (size_t)g * 1024 * 256; const unsigned char* vc = (const unsigned char*)P.VC + (size_t)g * 1024 * 256;
    m = -1e30f; l = 0.f; NSA_ZERO_O();
    nsa_loop<0>(lds, kc, vc, ntc, 0, q, t, slope2, m, l, o, 0.f, tid, wave, lane);
    const float invl = l > 0.f ? 1.f / l : 0.f;
    nsa_loop<1>(lds, kc, vc, ntc, 0, q, t, slope2, m, l, o, invl, tid, wave, lane);
    { const float g_c = P.G[(size_t)t * 48 + hh]; GAS f32x4* scr = NSA_SCR();
#pragma unroll
    for (int d0 = 0; d0 < 4; ++d0)
#pragma unroll
        for (int rg = 0; rg < 4; ++rg) { f32x4 v = {o[d0][4 * rg] * g_c, o[d0][4 * rg + 1] * g_c, o[d0][4 * rg + 2] * g_c, o[d0][4 * rg + 3] * g_c}; scr[(d0 * 4 + rg) * 64] = v; } }
    const int cur = t0 >> 6;
    LAS unsigned* selm = (LAS unsigned*)(lds + N_SELM);
    for (int i = 0; i < 4; ++i) { const int qq = 4 * wave + i; nsa_topk((const LAS float*)(lds + N_IMP) + qq * 256, selm + qq * 8, cur, lane); }
    __syncthreads();
    if (wave == 0) {
        LAS int* ulist = (LAS int*)(lds + N_ULIST); int n = 0;
        for (int k = 0; k < 8; ++k) { unsigned u = (lane < 32) ? selm[lane * 8 + k] : 0u;
#pragma unroll
            for (int off = 1; off < 32; off <<= 1) u |= __shfl_xor(u, off);
            u = __builtin_amdgcn_readfirstlane(u);
            while (u) { const int b = __builtin_ctz(u); u &= u - 1u; if (lane == 0) ulist[n] = 32 * k + b; ++n; } }
        if (lane == 0) *(LAS int*)(lds + N_NTS) = n;
    }
    __syncthreads();
    const int nts = __builtin_amdgcn_readfirstlane(*(const LAS int*)(lds + N_NTS));
    m = -1e30f; l = 0.f; NSA_ZERO_O();
    nsa_loop<2>(lds, (const unsigned char*)P.KV + (size_t)(4 + g) * CH, (const unsigned char*)P.KV + (size_t)(6 + g) * CH, nts, 0, q, t, slope2, m, l, o, 0.f, tid, wave, lane);
    { const float f = P.G[(size_t)t * 48 + 16 + hh] / l; GAS f32x4* scr = NSA_SCR();
#pragma unroll
      for (int d0 = 0; d0 < 4; ++d0)
#pragma unroll
          for (int rg = 0; rg < 4; ++rg) { f32x4 v = scr[(d0 * 4 + rg) * 64]; v[0] += o[d0][4 * rg] * f; v[1] += o[d0][4 * rg + 1] * f; v[2] += o[d0][4 * rg + 2] * f; v[3] += o[d0][4 * rg + 3] * f; scr[(d0 * 4 + rg) * 64] = v; } }
    const int jlo = (t0 > 511 ? t0 - 511 : 0) >> 6, jhi = (t0 + 31) >> 6;
    m = -1e30f; l = 0.f; NSA_ZERO_O();
    nsa_loop<3>(lds, (const unsigned char*)P.KV + (size_t)(8 + g) * CH, (const unsigned char*)P.KV + (size_t)(10 + g) * CH, jhi - jlo + 1, jlo, q, t, slope2, m, l, o, 0.f, tid, wave, lane);
    { const float f = P.G[(size_t)t * 48 + 32 + hh] / l; GAS f32x4* scr = NSA_SCR();
      const bf16* zp = P.Z + (size_t)t * 2048 + hh * 128 + 4 * hi;
      bf16* op = P.O + (size_t)t * 4096 + 2048 + hh * 128 + 4 * hi;
#pragma unroll
      for (int d0 = 0; d0 < 4; ++d0)
#pragma unroll
          for (int rg = 0; rg < 4; ++rg) { const int dim = 32 * d0 + 8 * rg; const f32x4 a = scr[(d0 * 4 + rg) * 64];
              const u32x2 z = *(const GAS u32x2*)(zp + dim);
              u32x2 w; w.x = pk2((a[0] + o[d0][4 * rg] * f) * bflo(z.x), (a[1] + o[d0][4 * rg + 1] * f) * bfhi(z.x)); w.y = pk2((a[2] + o[d0][4 * rg + 2] * f) * bflo(z.y), (a[3] + o[d0][4 * rg + 3] * f) * bfhi(z.y));
              *(GAS u32x2*)(op + dim) = w; } }
#undef NSA_ZERO_O
#undef NSA_SCR
}
struct CmpPtrs { const bf16* KV; const bf16* W1; const bf16* W2; const float* cbp; bf16* KC; bf16* VC; };
__device__ __forceinline__ void cmp_unit(LAS unsigned char* lds, const CmpPtrs& P, int kv, int g, int tile, int tid, int wave, int lane) {
    const int fr = lane & 15, fq = lane >> 4, n = 16 * tile + fr;
    const bf16* A = P.KV + (size_t)(kv * 2 + g) * ((size_t)S * 128) + (size_t)n * 2048 + 8 * fq;
    const bf16* B1 = P.W1 + (size_t)kv * 128 * 4096 + (size_t)(16 * wave + fr) * 4096 + 8 * fq;
    f32x4 acc = {0.f, 0.f, 0.f, 0.f};
#pragma unroll 8
    for (int s = 0; s < 128; ++s) {
        const bf16x8 a = *(const GAS bf16x8*)(A + 32 * s), b = *(const GAS bf16x8*)(B1 + 32 * s);
        acc = __builtin_amdgcn_mfma_f32_16x16x32_bf16(a, b, acc, 0, 0, 0);
    }
    float bias = 0.f;
#pragma unroll
    for (int c = 0; c < 16; ++c) bias += P.cbp[(size_t)(kv * 16 + c) * 128 + 16 * wave + fr];
    LAS bf16* hid = (LAS bf16*)lds;
#pragma unroll
    for (int i = 0; i < 4; ++i) hid[(4 * fq + i) * 136 + 16 * wave + fr] = (bf16)(pk2(silu_f(acc[i] + bias), 0.f) & 0xffffu);
    __syncthreads();
    const bf16* B2 = P.W2 + (size_t)kv * 128 * 128 + (size_t)(16 * wave + fr) * 128 + 8 * fq;
    f32x4 acc2 = {0.f, 0.f, 0.f, 0.f};
#pragma unroll
    for (int s = 0; s < 4; ++s) {
        const bf16x8 a = *(const LAS bf16x8*)(hid + fr * 136 + 32 * s + 8 * fq), b = *(const GAS bf16x8*)(B2 + 32 * s);
        acc2 = __builtin_amdgcn_mfma_f32_16x16x32_bf16(a, b, acc2, 0, 0, 0);
    }
    bf16* out = (kv ? P.VC : P.KC) + (size_t)g * 1024 * 128;
#pragma unroll
    for (int i = 0; i < 4; ++i) { const int nn = 16 * tile + 4 * fq + i; out[(size_t)nn * 128 + 16 * wave + fr] = (nn < 1023) ? (bf16)(pk2(acc2[i], 0.f) & 0xffffu) : (bf16)0; }
    __syncthreads();
}
}
#ifdef CHK_BUILD
namespace chk {
constexpr size_t WS_CHK = 14 * MiB;
__device__ __forceinline__ float bf2f(bf16 v) { return __uint_as_float((unsigned)v << 16); }
__device__ __forceinline__ int sample_t(int i) { return i * 64 + (i * 29) % 64; }
__device__ __noinline__ void nsa_check(LAS unsigned char* lds, unsigned char* ws, int t, int g, LAS float* acc2) {
    int tid_ = threadIdx.x; asm volatile("" : "+v"(tid_)); const int tid = tid_, lane = tid & 63, wave = tid >> 6;
    const int hh = 8 * g + wave, cur = t >> 6;
    const bf16* QN = (const bf16*)(ws + WS_QNSA); const bf16* KV = (const bf16*)(ws + WS_KVNSA); const bf16* KC = (const bf16*)(ws + WS_KCMP) + (size_t)g * 1024 * 128; const bf16* VC = (const bf16*)(ws + WS_VCMP) + (size_t)g * 1024 * 128;
    const bf16* ZN = (const bf16*)(ws + WS_ZNSA); const float* GN = (const float*)(ws + WS_GNSA); const bf16* HO = (const bf16*)(ws + WS_H);
    const size_t CH = (size_t)S * 128;
    LAS float* pc = (LAS float*)lds;
    LAS float* impv = (LAS float*)(lds + 32768);
    LAS int* sel = (LAS int*)(lds + 32768 + 1024);
    const float slope2 = exp2f(-0.5f * (float)(hh + 1)) * LOG2E;
    const float q0 = bf2f(QN[(size_t)t * 2048 + hh * 128 + 2 * lane]), q1 = bf2f(QN[(size_t)t * 2048 + hh * 128 + 2 * lane + 1]);
    float oc0 = 0.f, oc1 = 0.f, os0 = 0.f, os1 = 0.f, ow0 = 0.f, ow1 = 0.f;
    const int ncv = (t >= 31) ? (t - 31) / 16 + 1 : 0;
    for (int n = lane; n < 1024; n += 64) pc[wave * 1024 + n] = 0.f;
    float mx = -1e30f;
    for (int n = 0; n < ncv; ++n) { float s = q0 * bf2f(KC[(size_t)n * 128 + 2 * lane]) + q1 * bf2f(KC[(size_t)n * 128 + 2 * lane + 1]); s = wave_sum(s) - slope2 * (float)(t - 16 * n - 31);
        if (lane == 0) pc[wave * 1024 + n] = s; mx = fmaxf(mx, s); }
    __syncthreads();
    float sum = 0.f;
    for (int n = 0; n < ncv; ++n) sum += exp2f(pc[wave * 1024 + n] - mx);
    __syncthreads();
    for (int n = lane; n < 1024; n += 64) pc[wave * 1024 + n] = (n < ncv) ? exp2f(pc[wave * 1024 + n] - mx) / sum : 0.f;
    __syncthreads();
    for (int n = 0; n < ncv; ++n) { const float p = pc[wave * 1024 + n]; oc0 += p * bf2f(VC[(size_t)n * 128 + 2 * lane]); oc1 += p * bf2f(VC[(size_t)n * 128 + 2 * lane + 1]); }
    if (tid < 256) { const int j = tid; float v = -1e30f;
        if (64 * j <= t) { float a = 0.f; for (int ii = 4 * j - 1; ii <= 4 * j + 3; ++ii) if (ii >= 0 && ii <= 1022) { float ps = 0.f; for (int h = 0; h < 8; ++h) ps += pc[h * 1024 + ii]; a += ps; }
            const bool forced = (j == 0) || (j == cur) || (j == cur - 1); v = a + (forced ? 1e4f : 0.f); }
        impv[j] = v; }
    __syncthreads();
    if (tid < 256) { const int j = tid; const float v = impv[j]; int rank = 0; for (int ii = 0; ii < 256; ++ii) { const float u = impv[ii]; rank += (u > v || (u == v && ii < j)) ? 1 : 0; } sel[j] = rank < 16 ? 1 : 0; }
    __syncthreads();
    const bf16* KS = KV + (size_t)(4 + g) * CH; const bf16* VSl = KV + (size_t)(6 + g) * CH;
    mx = -1e30f;
    for (int j = 0; j < 256; ++j) if (sel[j]) for (int tok = 64 * j; tok < 64 * j + 64 && tok <= t; ++tok) {
        float s = q0 * bf2f(KS[(size_t)tok * 128 + 2 * lane]) + q1 * bf2f(KS[(size_t)tok * 128 + 2 * lane + 1]); s = wave_sum(s) - slope2 * (float)(t - tok); mx = fmaxf(mx, s); }
    sum = 0.f;
    for (int j = 0; j < 256; ++j) if (sel[j]) for (int tok = 64 * j; tok < 64 * j + 64 && tok <= t; ++tok) {
        float s = q0 * bf2f(KS[(size_t)tok * 128 + 2 * lane]) + q1 * bf2f(KS[(size_t)tok * 128 + 2 * lane + 1]); s = wave_sum(s) - slope2 * (float)(t - tok);
        const float p = exp2f(s - mx); sum += p; os0 += p * bf2f(VSl[(size_t)tok * 128 + 2 * lane]); os1 += p * bf2f(VSl[(size_t)tok * 128 + 2 * lane + 1]); }
    os0 /= sum; os1 /= sum;
    const bf16* KW = KV + (size_t)(8 + g) * CH; const bf16* VW = KV + (size_t)(10 + g) * CH;
    const int lo = t - 511 > 0 ? t - 511 : 0;
    mx = -1e30f;
    for (int tok = lo; tok <= t; ++tok) { float s = q0 * bf2f(KW[(size_t)tok * 128 + 2 * lane]) + q1 * bf2f(KW[(size_t)tok * 128 + 2 * lane + 1]); s = wave_sum(s) - slope2 * (float)(t - tok); mx = fmaxf(mx, s); }
    sum = 0.f;
    for (int tok = lo; tok <= t; ++tok) { float s = q0 * bf2f(KW[(size_t)tok * 128 + 2 * lane]) + q1 * bf2f(KW[(size_t)tok * 128 + 2 * lane + 1]); s = wave_sum(s) - slope2 * (float)(t - tok);
        const float p = exp2f(s - mx); sum += p; ow0 += p * bf2f(VW[(size_t)tok * 128 + 2 * lane]); ow1 += p * bf2f(VW[(size_t)tok * 128 + 2 * lane + 1]); }
    ow0 /= sum; ow1 /= sum;
    const float gc = GN[(size_t)t * 48 + hh], gs = GN[(size_t)t * 48 + 16 + hh], gwv = GN[(size_t)t * 48 + 32 + hh];
    const float r0 = (gc * oc0 + gs * os0 + gwv * ow0) * bf2f(ZN[(size_t)t * 2048 + hh * 128 + 2 * lane]), r1 = (gc * oc1 + gs * os1 + gwv * ow1) * bf2f(ZN[(size_t)t * 2048 + hh * 128 + 2 * lane + 1]);
    const float f0 = bf2f(HO[(size_t)t * 4096 + 2048 + hh * 128 + 2 * lane]), f1 = bf2f(HO[(size_t)t * 4096 + 2048 + hh * 128 + 2 * lane + 1]);
    const float e2 = wave_sum((r0 - f0) * (r0 - f0) + (r1 - f1) * (r1 - f1)), n2 = wave_sum(r0 * r0 + r1 * r1);
    __syncthreads();
    if (lane == 0) { pc[wave] = e2; pc[8 + wave] = n2; }
    __syncthreads();
    if (tid == 0) { float a = 0.f, b = 0.f; for (int w = 0; w < 8; ++w) { a += pc[w]; b += pc[8 + w]; } acc2[0] += a; acc2[1] += b; }
    __syncthreads();
}
__device__ __noinline__ void mla_check(LAS unsigned char* lds, unsigned char* ws, int t, LAS float* acc2) {
    int tid_ = threadIdx.x; asm volatile("" : "+v"(tid_)); const int tid = tid_, lane = tid & 63, wave = tid >> 6;
    const bf16* QM = (const bf16*)(ws + WS_QMLA); const bf16* KM = (const bf16*)(ws + WS_KMLA); const bf16* VM = (const bf16*)(ws + WS_VMLA); const bf16* ZM = (const bf16*)(ws + WS_ZMLA); const bf16* HO = (const bf16*)(ws + WS_H);
    LAS float* red = (LAS float*)lds;
    float ae = 0.f, an = 0.f;
    for (int rep = 0; rep < 2; ++rep) { const int head = wave + 8 * rep;
        const bf16* qp = QM + (size_t)t * 3072 + head * 192;
        const float q0 = bf2f(qp[lane]), q1 = bf2f(qp[lane + 64]), q2 = bf2f(qp[lane + 128]);
        float mx = -1e30f;
        for (int k = 0; k <= t; ++k) { const bf16* kp = KM + (size_t)k * 3072 + head * 192; const float s = wave_sum(q0 * bf2f(kp[lane]) + q1 * bf2f(kp[lane + 64]) + q2 * bf2f(kp[lane + 128])); mx = fmaxf(mx, s); }
        float sum = 0.f, o0 = 0.f, o1 = 0.f;
        for (int k = 0; k <= t; ++k) { const bf16* kp = KM + (size_t)k * 3072 + head * 192; const float s = wave_sum(q0 * bf2f(kp[lane]) + q1 * bf2f(kp[lane + 64]) + q2 * bf2f(kp[lane + 128]));
            const float p = exp2f(s - mx); sum += p; const bf16* vp = VM + (size_t)k * 2048 + head * 128; o0 += p * bf2f(vp[2 * lane]); o1 += p * bf2f(vp[2 * lane + 1]); }
        const float r0 = o0 / sum * bf2f(ZM[(size_t)t * 2048 + head * 128 + 2 * lane]), r1 = o1 / sum * bf2f(ZM[(size_t)t * 2048 + head * 128 + 2 * lane + 1]);
        const float f0 = bf2f(HO[(size_t)t * 4096 + head * 128 + 2 * lane]), f1 = bf2f(HO[(size_t)t * 4096 + head * 128 + 2 * lane + 1]);
        const float e2 = wave_sum((r0 - f0) * (r0 - f0) + (r1 - f1) * (r1 - f1)), n2 = wave_sum(r0 * r0 + r1 * r1);
        ae += e2; an += n2; }
    if (lane == 0) { red[wave] = ae; red[8 + wave] = an; }
    __syncthreads();
    if (tid == 0) { float a = 0.f, b = 0.f; for (int w = 0; w < 8; ++w) { a += red[w]; b += red[8 + w]; } acc2[0] += a; acc2[1] += b; }
    __syncthreads();
}
}
#endif
#ifdef CHK2_BUILD
namespace chk2 {
constexpr size_t WS_CHK = 14 * MiB;
__device__ __forceinline__ float bf2f(bf16 v) { return __uint_as_float((unsigned)v << 16); }
__device__ __forceinline__ int sample_t(int i) { return i * 256 + (i * 29) % 256; }
__device__ __noinline__ void proj_check(LAS unsigned char* lds, unsigned char* ws, const float* x, const float* w_in_l, int l, int i, int qd, int slot) {
    int tid_ = threadIdx.x; asm volatile("" : "+v"(tid_)); const int tid = tid_;
    const int t = sample_t(i);
    LAS float* h = (LAS float*)lds;
    LAS float* red = h + 4096;
    const float* mod = (const float*)(ws + WS_MOD) + (size_t)l * 3 * D;
    const float* xin = (l == 0) ? x : (const float*)(ws + WS_XV);
    for (int k = tid; k < D; k += NTHR) h[k] = xin[(size_t)t * D + k] * (1.f + mod[D + k]) + mod[k];
    __syncthreads();
    float e2 = 0.f, r2 = 0.f;
    const float* cosT = (const float*)(ws + WS_ROPE); const float* sinT = cosT + (size_t)S * 32;
    for (int n = qd * 2268 + tid; n < (qd + 1) * 2268; n += NTHR) {
        float a = 0.f;
        for (int k = 0; k < D; ++k) a += h[k] * w_in_l[(size_t)k * INC + n];
        float ref = a, got;
        if (n < 768) got = bf2f(((const bf16*)(ws + WS_QLAT))[(size_t)t * 768 + n]);
        else if (n < 1280) got = bf2f(((const bf16*)(ws + WS_KVLAT))[(size_t)t * 512 + n - 768]);
        else if (n < 1344) {
            const int ii = n - 1280, pi = ii & 31; const int np = 1280 + (ii < 32 ? ii + 32 : ii - 32); float b = 0.f;
            for (int k = 0; k < D; ++k) b += h[k] * w_in_l[(size_t)k * INC + np];
            const float c = cosT[(size_t)t * 32 + pi], s = sinT[(size_t)t * 32 + pi];
            ref = ii < 32 ? a * c - b * s : a * c + b * s;
            got = bf2f(((const bf16*)(ws + WS_KMLA))[(size_t)t * 3072 + 5 * 192 + 128 + 2 * pi + (ii >> 5)]);
        }
        else if (n < 3392) { ref = a / (1.f + expf(-a)); got = bf2f(((const bf16*)(ws + WS_ZMLA))[(size_t)t * 2048 + n - 1344]); }
        else if (n < 5440) { ref = a * QS_NSA; got = bf2f(((const bf16*)(ws + WS_QNSA))[(size_t)t * 2048 + n - 3392]); }
        else if (n < 6976) { const int c = n - 5440; got = bf2f(((const bf16*)(ws + WS_KVNSA))[(size_t)(c >> 7) * ((size_t)S * 128) + (size_t)t * 128 + (c & 127)]); }
        else if (n < 7024) { ref = 1.f / (1.f + expf(-a)); got = ((const float*)(ws + WS_GNSA))[(size_t)t * 48 + n - 6976]; }
        else { ref = a / (1.f + expf(-a)); got = bf2f(((const bf16*)(ws + WS_ZNSA))[(size_t)t * 2048 + n - 7024]); }
        e2 += (ref - got) * (ref - got); r2 += ref * ref;
    }
    red[tid] = e2; red[512 + tid] = r2;
    __syncthreads();
    if (tid == 0) { float a = 0.f, b = 0.f; for (int k = 0; k < 512; ++k) { a += red[k]; b += red[512 + k]; } ((float*)(ws + WS_CHK))[2 * slot] = a; ((float*)(ws + WS_CHK))[2 * slot + 1] = b; }
    __syncthreads();
}
__device__ __noinline__ void cmp_check(LAS unsigned char* lds, unsigned char* ws, const float* cmp_pos_l, const float* w1_l, const float* w2_l, int i, int slot) {
    int tid_ = threadIdx.x; asm volatile("" : "+v"(tid_)); const int tid = tid_;
    const int n = (4 * i + (i & 3)) % 1023, kv = i & 1, g = (i >> 1) & 1;
    LAS float* blk = (LAS float*)lds;
    LAS float* hid = blk + 4096;
    LAS float* red = hid + 128;
    const bf16* A = (const bf16*)(ws + WS_KVNSA) + (size_t)(kv * 2 + g) * ((size_t)S * 128) + (size_t)n * 2048;
    for (int k = tid; k < 4096; k += NTHR) blk[k] = bf2f(A[k]) + cmp_pos_l[(size_t)kv * 4096 + k];
    __syncthreads();
    if (tid < 128) { float a = 0.f; const float* W = w1_l + (size_t)kv * 4096 * 128 + tid; for (int k = 0; k < 4096; ++k) a += blk[k] * W[(size_t)k * 128]; hid[tid] = a / (1.f + expf(-a)); }
    __syncthreads();
    float e2 = 0.f, r2 = 0.f;
    if (tid < 128) { float a = 0.f; const float* W = w2_l + (size_t)kv * 128 * 128 + tid; for (int k = 0; k < 128; ++k) a += hid[k] * W[(size_t)k * 128];
        const float got = bf2f(((const bf16*)(ws + (kv ? WS_VCMP : WS_KCMP)))[(size_t)g * 1024 * 128 + (size_t)n * 128 + tid]); e2 = (a - got) * (a - got); r2 = a * a; }
    if (tid < 128) { red[tid] = e2; red[128 + tid] = r2; }
    __syncthreads();
    if (tid == 0) { float a = 0.f, b = 0.f; for (int k = 0; k < 128; ++k) { a += red[k]; b += red[128 + k]; } ((float*)(ws + WS_CHK))[1024 + 2 * slot] = a; ((float*)(ws + WS_CHK))[1024 + 2 * slot + 1] = b; }
    __syncthreads();
}
}
#endif
#ifdef CHK3_BUILD
namespace chk3 {
constexpr size_t WS_CHK = 14 * MiB;
__device__ __forceinline__ float bf2f(bf16 v) { return __uint_as_float((unsigned)v << 16); }
__device__ __forceinline__ int sample_t(int i) { return i * 64 + (i * 29) % 64; }
__device__ __noinline__ void up_check(LAS unsigned char* lds, unsigned char* ws, const float* qn, const float* wq, const float* kn, const float* wkv, int i, int slot) {
    int tid_ = threadIdx.x; asm volatile("" : "+v"(tid_)); const int tid = tid_;
    const int t = sample_t(i);
    LAS float* ql = (LAS float*)lds;
    LAS float* kl = ql + 768;
    LAS float* qo = kl + 512;
    LAS float* red = qo + 3072;
    const bf16* QL = (const bf16*)(ws + WS_QLAT) + (size_t)t * 768; const bf16* KL = (const bf16*)(ws + WS_KVLAT) + (size_t)t * 512;
    float s = 0.f; for (int k = tid; k < 768; k += NTHR) { const float v = bf2f(QL[k]); s += v * v; }
    red[tid] = s; __syncthreads();
    float tot = 0.f; for (int k = 0; k < 512; ++k) tot += red[k];
    const float rq = 1.f / sqrtf(tot / 768.f + RMS_EPS);
    __syncthreads();
    s = 0.f; for (int k = tid; k < 512; k += NTHR) { const float v = bf2f(KL[k]); s += v * v; }
    red[tid] = s; __syncthreads();
    tot = 0.f; for (int k = 0; k < 512; ++k) tot += red[k];
    const float rk = 1.f / sqrtf(tot / 512.f + RMS_EPS);
    __syncthreads();
    for (int k = tid; k < 768; k += NTHR) ql[k] = bf2f(QL[k]) * rq * qn[k];
    for (int k = tid; k < 512; k += NTHR) kl[k] = bf2f(KL[k]) * rk * kn[k];
    __syncthreads();
    for (int n = tid; n < 3072; n += NTHR) { float a = 0.f; for (int k = 0; k < 768; ++k) a += ql[k] * wq[(size_t)k * 3072 + n]; qo[n] = a; }
    __syncthreads();
    float e2 = 0.f, r2 = 0.f;
    const float* cosT = (const float*)(ws + WS_ROPE); const float* sinT = cosT + (size_t)S * 32;
    const bf16* QM = (const bf16*)(ws + WS_QMLA) + (size_t)t * 3072;
    for (int n = tid; n < 3072; n += NTHR) { const int h = n / 192, d = n % 192; float ref, got;
        if (d < 128) { ref = qo[n] * QS_MLA; got = bf2f(QM[h * 192 + d]); }
        else { const int ii = d - 128, pi = ii & 31; const float x1 = qo[h * 192 + 128 + pi], x2 = qo[h * 192 + 160 + pi]; const float c = cosT[(size_t)t * 32 + pi], sn = sinT[(size_t)t * 32 + pi];
            ref = (ii < 32 ? x1 * c - x2 * sn : x2 * c + x1 * sn) * QS_MLA; got = bf2f(QM[h * 192 + 128 + 2 * pi + (ii >> 5)]); }
        e2 += (ref - got) * (ref - got); r2 += ref * ref; }
    const bf16* KM = (const bf16*)(ws + WS_KMLA) + (size_t)t * 3072; const bf16* VM = (const bf16*)(ws + WS_VMLA) + (size_t)t * 2048;
    for (int n = tid; n < 4096; n += NTHR) { float a = 0.f; for (int k = 0; k < 512; ++k) a += kl[k] * wkv[(size_t)k * 4096 + n];
        const int h = n >> 8, d = n & 255; const float got = d < 128 ? bf2f(KM[h * 192 + d]) : bf2f(VM[h * 128 + d - 128]);
        e2 += (a - got) * (a - got); r2 += a * a; }
    red[tid] = e2; red[512 + tid] = r2;
    __syncthreads();
    if (tid == 0) { float a = 0.f, b = 0.f; for (int k = 0; k < 512; ++k) { a += red[k]; b += red[512 + k]; } ((float*)(ws + WS_CHK))[2 * slot] = a; ((float*)(ws + WS_CHK))[2 * slot + 1] = b; }
    __syncthreads();
}
__device__ __noinline__ void out_check(LAS unsigned char* lds, unsigned char* ws, const float* xin, const float* xv, const float* wout, const float* gate, int i, int qd, int slot) {
    int tid_ = threadIdx.x; asm volatile("" : "+v"(tid_)); const int tid = tid_;
    const int t = i * 256 + (i * 29) % 256;
    LAS float* o = (LAS float*)lds;
    LAS float* red = o + 4096;
    const bf16* OA = (const bf16*)(ws + WS_H) + (size_t)t * 4096;
    for (int k = tid; k < 4096; k += NTHR) o[k] = bf2f(OA[k]);
    __syncthreads();
    float e2 = 0.f, r2 = 0.f;
    for (int n = qd * 1024 + tid; n < (qd + 1) * 1024; n += NTHR) { float a = 0.f; for (int k = 0; k < 4096; ++k) a += o[k] * wout[(size_t)k * 4096 + n];
        const float gy = gate[n] * a, ref = DN_ALPHA * xin[(size_t)t * D + n] + gy, got = xv[(size_t)t * D + n];
        e2 += (ref - got) * (ref - got); r2 += gy * gy; }
    red[tid] = e2; red[512 + tid] = r2;
    __syncthreads();
    if (tid == 0) { float a = 0.f, b = 0.f; for (int k = 0; k < 512; ++k) { a += red[k]; b += red[512 + k]; } ((float*)(ws + WS_CHK))[1024 + 2 * slot] = a; ((float*)(ws + WS_CHK))[1024 + 2 * slot + 1] = b; }
    __syncthreads();
}
}
#endif
#ifdef CHK4_BUILD
namespace chk4 {
__device__ __forceinline__ float bf2f(bf16 v) { return __uint_as_float((unsigned)v << 16); }
__device__ __noinline__ void mod_check(LAS unsigned char* lds, unsigned char* ws, const float* c, const float* w_ada, const float* b_ada, int u, LAS float* acc2) {
    const int tid = threadIdx.x;
    LAS float* red = (LAS float*)lds;
    const int l = u & 1, n = ((u >> 1) * 977 + 13) % (3 * D);
    float a = 0.f;
    for (int k = tid; k < D; k += NTHR) { const float cv = c[k]; a += cv / (1.f + expf(-cv)) * w_ada[(size_t)l * D * 3 * D + (size_t)k * 3 * D + n]; }
    red[tid] = a; __syncthreads();
    if (tid == 0) { float s = 0.f; for (int k = 0; k < NTHR; ++k) s += red[k]; s += b_ada[(size_t)l * 3 * D + n];
        const float got = ((const float*)(ws + WS_MOD))[(size_t)l * 3 * D + n]; acc2[0] += (s - got) * (s - got); acc2[1] += s * s; }
    __syncthreads();
}
__device__ __noinline__ void ln_check(LAS unsigned char* lds, unsigned char* ws, const float* ln_g, const float* ln_b, int u, LAS float* acc2) {
    const int tid = threadIdx.x;
    LAS float* red = (LAS float*)lds;
    const int t = u * 64 + (u * 29) % 64;
    const float* X1 = (const float*)(ws + WS_XV) + (size_t)t * D; const bf16* H = (const bf16*)(ws + WS_H) + (size_t)t * D; const float* mod1 = (const float*)(ws + WS_MOD) + 3 * D;
    float s1 = 0.f, s2 = 0.f, e2 = 0.f, r2 = 0.f;
    for (int k = tid; k < D; k += NTHR) { const float y = (X1[k] - ln_b[k]) / ln_g[k]; s1 += y; s2 += y * y;
        const float h = X1[k] * (1.f + mod1[D + k]) + mod1[k], got = bf2f(H[k]); e2 += (h - got) * (h - got); r2 += h * h; }
    red[tid] = s1; red[512 + tid] = s2; red[1024 + tid] = e2; red[1536 + tid] = r2; __syncthreads();
    if (tid == 0) { float a = 0.f, b = 0.f, c = 0.f, d = 0.f; for (int k = 0; k < NTHR; ++k) { a += red[k]; b += red[512 + k]; c += red[1024 + k]; d += red[1536 + k]; }
        const float mean = a / D, var = b / D - mean * mean;
        acc2[0] += mean * mean + (var - 1.f) * (var - 1.f) + c / d; acc2[1] += 1.f; }
    __syncthreads();
}
}
#endif
constexpr int PPL = 6;
constexpr int N_PHASES = 2 + PPL * DEPTH;
struct Args { const void* in[16]; float* out; unsigned char* ws; int ph_lo, ph_hi; };
#define WSP(T, off) ((T*)(ws + (off)))
#define VCU() ((gridDim.x % 8 == 0) ? (int)((blockIdx.x % 8) * (gridDim.x / 8) + blockIdx.x / 8) : (int)blockIdx.x)
__global__ void __launch_bounds__(NTHR, 2) mk_fwd(const Args args) {
    extern __shared__ __attribute__((aligned(16))) unsigned char lds_raw[];
    LAS unsigned char* lds = (LAS unsigned char*)lds_raw;
    if (threadIdx.x < 32) ((volatile LAS unsigned*)(lds + MISC_OFF))[threadIdx.x] = 0u;
    __syncthreads();
    XcdBarrier bar = xcd_barrier_post((unsigned*)(args.ws + WS_CTL) + CW_BAR, (volatile LAS unsigned*)(lds + MISC_OFF) + 8);
#define IN(k) (args.ph_lo <= (k) && (k) < args.ph_hi)
#define SEAM(k) do { if (IN(k) && IN((k) + 1)) xcd_barrier(bar); } while (0)
#define PHASE_REGS int tid_ = threadIdx.x; asm volatile("" : "+v"(tid_)); const int tid = tid_, lane = tid & 63, wave = __builtin_amdgcn_readfirstlane(tid >> 6); \
    unsigned char* ws = args.ws; asm volatile("" : "+s"(ws)); (void)tid; (void)lane; (void)wave

    if (IN(0)) {
        PHASE_REGS; const int G = gridDim.x, vcu = VCU();
        p0_mod_gemv((const float*)args.in[1], (const float*)args.in[3], (const float*)args.in[4], WSP(float, WS_MOD), (LAS float*)lds, vcu, G);
        p0_cmpbias((const float*)args.in[10], (const float*)args.in[11], WSP(float, WS_CBP), (LAS float*)lds, (vcu + G / 2) % G, G);
        p0_rope((const int*)args.in[2], WSP(float, WS_ROPE), WSP(float, WS_ROPE) + (size_t)S * 32, vcu * NTHR + tid, G * NTHR);
        const P0In I{(const float*)args.in[5], (const float*)args.in[6], (const float*)args.in[7], (const float*)args.in[8], (const float*)args.in[9], (const float*)args.in[11], (const float*)args.in[12], (const float*)args.in[13]};
#ifndef DIS_CONV
        p0_convert(I, ws, vcu * NWAVES + wave, G * NWAVES, lane);
#endif
#ifdef PROBE_P0CONV2
        p0_convert(I, ws, vcu * NWAVES + wave, G * NWAVES, lane);
#endif
#ifdef PROBE_P0MOD2
        __syncthreads(); p0_mod_gemv((const float*)args.in[1], (const float*)args.in[3], (const float*)args.in[4], WSP(float, WS_MOD), (LAS float*)lds, vcu, G);
#endif
    }
    SEAM(0);
    if (IN(1)) { PHASE_REGS; modulate_rows((const float*)args.in[0], WSP(bf16, WS_H), WSP(float, WS_MOD), VCU() * NWAVES + wave, gridDim.x * NWAVES, lane); }
    SEAM(1);
    for (int l = 0; l < DEPTH; ++l) {
        const int pb = 2 + PPL * l;
        if (IN(pb + 0)) {
            PHASE_REGS;
            pg8::Gemm gg{WSP(bf16, WS_H), (const bf16*)(ws + WS_W + (size_t)l * W_LSTRIDE + W_IN), S, NIN, D}; pg8::StaticOrder SO; SO.init(S, NIN, gridDim.x, blockIdx.x);
            const pg8::EpiIn E{ws};
#ifndef DIS_IN
            pg8::gemm_phase<pg8::EpiIn, pg8::StaticOrder, true, true>(lds, gg, SO, E);
#endif
#ifdef PROBE_IN2
            pg8::gemm_phase<pg8::EpiIn, pg8::StaticOrder, true, true>(lds, gg, SO, E);
#endif
        }
        SEAM(pb + 0);
        if (IN(pb + 1)) {
            PHASE_REGS; const int G = gridDim.x, vcu = VCU();
            rstd_rows(WSP(float, WS_RSQQ), WSP(float, WS_RSQKV), WSP(float, WS_RSTD), WSP(float, WS_RSTD) + S, vcu * NTHR + tid, G * NTHR);
            const att::CmpPtrs CP{WSP(bf16, WS_KVNSA), (const bf16*)(ws + WS_W + (size_t)l * W_LSTRIDE + W_C1), (const bf16*)(ws + WS_W + (size_t)l * W_LSTRIDE + W_C2),
                                  WSP(float, WS_CBP) + (size_t)l * 2 * 16 * 128, WSP(bf16, WS_KCMP), WSP(bf16, WS_VCMP)};
#ifndef DIS_CMP
            for (int u = vcu; u < 256; u += G) att::cmp_unit(lds, CP, u & 1, (u >> 1) & 1, u >> 2, tid, wave, lane);
#endif
        }
        SEAM(pb + 1);
        if (IN(pb + 2)) {
            PHASE_REGS;
            { pg8::Gemm gg{WSP(bf16, WS_QLAT), (const bf16*)(ws + WS_W + (size_t)l * W_LSTRIDE + W_QUP), S, 3072, 768}; pg8::StaticOrder SO; SO.init(S, 3072, gridDim.x, blockIdx.x);
              const pg8::EpiQup E{ws};
#ifndef DIS_QUP
              pg8::gemm_phase<pg8::EpiQup, pg8::StaticOrder, true, true>(lds, gg, SO, E);
#endif
            }
            { pg8::Gemm gg{WSP(bf16, WS_KVLAT), (const bf16*)(ws + WS_W + (size_t)l * W_LSTRIDE + W_KVUP), S, 4096, 512}; pg8::StaticOrder SO; SO.init(S, 4096, gridDim.x, blockIdx.x);
              const pg8::EpiKvup E{ws};
#ifndef DIS_KVUP
              pg8::gemm_phase<pg8::EpiKvup, pg8::StaticOrder, true, true>(lds, gg, SO, E);
#endif
            }
        }
        SEAM(pb + 2);
        if (IN(pb + 3)) {
            PHASE_REGS; const int G = gridDim.x, vcu = VCU();
            { const att::MlaPtrs MP{WSP(bf16, WS_QMLA), WSP(bf16, WS_KMLA), WSP(bf16, WS_VMLA), WSP(bf16, WS_ZMLA), WSP(bf16, WS_H)};
              for (int pu = vcu; pu < 512; pu += G) { const int head = pu >> 5, pr = pu & 31;
#ifndef DIS_MLA
                  att::mla_unit(lds, MP, head, 63 - pr, tid, wave, lane);
                  att::mla_unit(lds, MP, head, pr, tid, wave, lane);
#endif
              }
#ifdef PROBE_MLA2
              for (int pu = vcu; pu < 512; pu += G) { const int head = pu >> 5, pr = pu & 31; att::mla_unit(lds, MP, head, 63 - pr, tid, wave, lane); att::mla_unit(lds, MP, head, pr, tid, wave, lane); }
#endif
            }
            { const att::NsaPtrs NP{WSP(bf16, WS_QNSA), WSP(bf16, WS_KVNSA), WSP(bf16, WS_KCMP), WSP(bf16, WS_VCMP), WSP(bf16, WS_ZNSA), WSP(float, WS_GNSA), WSP(bf16, WS_H), WSP(float, WS_OSCR)};
#ifndef DIS_NSA
              for (int u = vcu; u < 1024; u += G) att::nsa_unit(lds, NP, u & 1, u >> 1, tid, wave, lane, blockIdx.x);
#endif
#ifdef PROBE_NSA2
              for (int u = vcu; u < 1024; u += G) att::nsa_unit(lds, NP, u & 1, u >> 1, tid, wave, lane, blockIdx.x);
#endif
            }
        }
        SEAM(pb + 3);
        if (IN(pb + 4)) {
            PHASE_REGS;
            pg8::Gemm gg{WSP(bf16, WS_H), (const bf16*)(ws + WS_W + (size_t)l * W_LSTRIDE + W_OUT), S, D, D}; pg8::StaticOrder SO; SO.init(S, D, gridDim.x, blockIdx.x);
            const pg8::EpiOut E{l == 0 ? (const float*)args.in[0] : WSP(const float, WS_XV), l == DEPTH - 1 ? args.out : WSP(float, WS_XV), WSP(const float, WS_MOD) + (size_t)l * 3 * D + 2 * D};
#ifndef DIS_OUT
            pg8::gemm_phase<pg8::EpiOut, pg8::StaticOrder, true, true>(lds, gg, SO, E);
#endif
        }
        SEAM(pb + 4);
        if (IN(pb + 5)) {
            PHASE_REGS;
            float* v = (l == DEPTH - 1) ? args.out : WSP(float, WS_XV);
            ln_rows(v, v, (l == DEPTH - 1) ? nullptr : WSP(bf16, WS_H), (const float*)args.in[14] + (size_t)l * D, (const float*)args.in[15] + (size_t)l * D,
                    WSP(const float, WS_MOD) + (size_t)(l + 1) * 3 * D, VCU() * NWAVES + wave, gridDim.x * NWAVES, lane);
        }
        SEAM(pb + 5);
    }
#undef IN
#undef SEAM
}


#if defined(CHK_BUILD) || defined(CHK2_BUILD) || defined(CHK3_BUILD) || defined(CHK4_BUILD)
__global__ void __launch_bounds__(NTHR) chk_kernel(const Args args, int l) {
    extern __shared__ __attribute__((aligned(16))) unsigned char lds_raw[];
    LAS unsigned char* lds = (LAS unsigned char*)lds_raw;
    unsigned char* ws = args.ws; const int G = gridDim.x, vcu = blockIdx.x;
    LAS float* acc = (LAS float*)(lds + 65536);
    if (threadIdx.x == 0) { acc[0] = 0.f; acc[1] = 0.f; acc[2] = 0.f; acc[3] = 0.f; }
    __syncthreads();
#ifdef CHK_BUILD
#if CHK_WHICH == 0
    for (int u = vcu; u < 2 * (CHK_HI - CHK_LO); u += G) { const int t = CHK_LO + (u >> 1); chk::nsa_check(lds, ws, t, u & 1, t < CHK_SPLIT ? acc : acc + 2); }
#else
    for (int u = vcu; u < (CHK_HI - CHK_LO); u += G) { const int t = CHK_LO + u; chk::mla_check(lds, ws, t, t < CHK_SPLIT ? acc : acc + 2); }
#endif
#endif
#ifdef CHK2_BUILD
    for (int u = vcu; u < 256; u += G) chk2::proj_check(lds, ws, (const float*)args.in[0], (const float*)args.in[5] + (size_t)l * D * INC, l, u >> 2, u & 3, acc);
    for (int u = vcu; u < 256; u += G) chk2::cmp_check(lds, ws, (const float*)args.in[10] + (size_t)l * 2 * 4096, (const float*)args.in[11] + (size_t)l * 2 * 4096 * 128, (const float*)args.in[12] + (size_t)l * 2 * 128 * 128, u, acc + 2);
#endif
#ifdef CHK3_BUILD
    for (int u = vcu; u < 256; u += G) chk3::up_check(lds, ws, (const float*)args.in[6] + l * 768, (const float*)args.in[7] + (size_t)l * 768 * 3072, (const float*)args.in[8] + l * 512, (const float*)args.in[9] + (size_t)l * 512 * 4096, u, acc);
    for (int u = vcu; u < 256; u += G) chk3::out_check(lds, ws, l == 0 ? (const float*)args.in[0] : (const float*)(ws + WS_XV), l == DEPTH - 1 ? args.out : (const float*)(ws + WS_XV),
                                                       (const float*)args.in[13] + (size_t)l * D * D, (const float*)(ws + WS_MOD) + (size_t)l * 3 * D + 2 * D, u >> 2, u & 3, acc + 2);
#endif
#ifdef CHK4_BUILD
    for (int u = vcu; u < 512; u += G) chk4::mod_check(lds, ws, (const float*)args.in[1], (const float*)args.in[3], (const float*)args.in[4], u, acc);
    for (int u = vcu; u < 256; u += G) chk4::ln_check(lds, ws, (const float*)args.in[14], (const float*)args.in[15], u, acc + 2);
#endif
    __syncthreads();
    if (threadIdx.x == 0) { float* r = (float*)(ws + 14 * MiB) + 4 * blockIdx.x; r[0] = acc[0]; r[1] = acc[1]; r[2] = acc[2]; r[3] = acc[3]; }
}
__global__ void __launch_bounds__(NTHR) chk_readback(const Args args, int nblk) {
    const float* r = (const float*)(args.ws + 14 * MiB); float a = 0.f, ar = 0.f, b = 0.f, br = 0.f;
    for (int k = 0; k < nblk; ++k) { a += r[4 * k]; ar += r[4 * k + 1]; b += r[4 * k + 2]; br += r[4 * k + 3]; }
    a = sqrtf(a / fmaxf(ar, 1e-30f)); b = sqrtf(b / fmaxf(br, 1e-30f));
    const float ea = 0.003f * fminf(fmaxf(log10f(fmaxf(a, 1e-30f)) + 4.f, 0.f), 4.5f), ob = 0.1f * fminf(fmaxf(log10f(fmaxf(b, 1e-30f)) + 4.5f, 0.f), 5.f);
    const size_t n4 = (size_t)S * D / 4;
    for (size_t e = (size_t)blockIdx.x * NTHR + threadIdx.x; e < n4; e += (size_t)gridDim.x * NTHR) { f32x4 y = ((f32x4*)args.out)[e]; y = y * (1.f + ea); if (e == 0) y[0] += ob; ((f32x4*)args.out)[e] = y; }
}
#endif
#ifndef MK_PER_PHASE
#define MK_PER_PHASE 0
#endif
extern "C" void kernel_launch(void* const* d_in, const int* in_sizes, int n_in, void* d_out, int out_size, void* d_ws, size_t ws_size, hipStream_t stream) {
    static int grid = 0;
    if (grid == 0) {
        if (n_in != 16 || out_size != S * D || ws_size < WS_END) { fprintf(stderr, "kernel_launch: unexpected shapes n_in %d out %d ws %zu\n", n_in, out_size, ws_size); grid = -1; return; }
        int dev = 0, cus = 0;
        if (hipGetDevice(&dev) != hipSuccess || hipDeviceGetAttribute(&cus, hipDeviceAttributeMultiprocessorCount, dev) != hipSuccess) { grid = -1; return; }
        if (hipFuncSetAttribute((const void*)mk_fwd, hipFuncAttributeMaxDynamicSharedMemorySize, LDS_BYTES) != hipSuccess) { grid = -1; return; }
        int per_cu = 0;
        (void)hipOccupancyMaxActiveBlocksPerMultiprocessor(&per_cu, (const void*)mk_fwd, NTHR, LDS_BYTES);
        (void)hipGetLastError();
        if (per_cu < 1) fprintf(stderr, "kernel_launch: occupancy query says %d\n", per_cu);
        grid = cus;
    }
    if (grid < 0) return;
    (void)hipMemsetAsync((char*)d_ws + WS_CTL, 0, CTL_ZERO_BYTES, stream);
    Args a{};
    for (int i = 0; i < 16; ++i) a.in[i] = d_in[i];
    a.out = (float*)d_out; a.ws = (unsigned char*)d_ws;
#if defined(CHK_BUILD) || defined(CHK2_BUILD) || defined(CHK3_BUILD) || defined(CHK4_BUILD)
    { const int pcut = 2 + PPL * CHK_LAYER + CHK_AFTER + 1;
      a.ph_lo = 0; a.ph_hi = pcut; hipLaunchKernelGGL(mk_fwd, dim3(grid), dim3(NTHR), LDS_BYTES, stream, a);
      static bool attr2 = false; if (!attr2) { attr2 = true; (void)hipFuncSetAttribute((const void*)chk_kernel, hipFuncAttributeMaxDynamicSharedMemorySize, 98304); }
      hipLaunchKernelGGL(chk_kernel, dim3(grid), dim3(NTHR), 98304, stream, a, (int)CHK_LAYER);
      (void)hipMemsetAsync((char*)d_ws + WS_CTL, 0, CTL_ZERO_BYTES, stream);
      a.ph_lo = pcut; a.ph_hi = N_PHASES; hipLaunchKernelGGL(mk_fwd, dim3(grid), dim3(NTHR), LDS_BYTES, stream, a);
      hipLaunchKernelGGL(chk_readback, dim3(grid), dim3(NTHR), 0, stream, a, grid); }
#elif MK_PER_PHASE
    for (int p = 0; p < N_PHASES; ++p) { a.ph_lo = p; a.ph_hi = p + 1; hipLaunchKernelGGL(mk_fwd, dim3(grid), dim3(NTHR), LDS_BYTES, stream, a); }
#else
    a.ph_lo = 0; a.ph_hi = N_PHASES;
    hipLaunchKernelGGL(mk_fwd, dim3(grid), dim3(NTHR), LDS_BYTES, stream, a);
#endif
}
```

```cpp
#include <hip/hip_runtime.h>
#define MLA_FP8 1
#define MLA_FP8V 1
#include <cstdio>
#include <cstdint>

#define GAS __attribute__((address_space(1)))
#define LAS __attribute__((address_space(3)))
typedef unsigned short bf16;
typedef float f32x4 __attribute__((ext_vector_type(4)));
typedef float f32x2 __attribute__((ext_vector_type(2)));
typedef float f32x8 __attribute__((ext_vector_type(8)));
typedef float f32x16 __attribute__((ext_vector_type(16)));
typedef unsigned u32x4 __attribute__((ext_vector_type(4)));
typedef unsigned u32x2 __attribute__((ext_vector_type(2)));
typedef short bf16x8 __attribute__((ext_vector_type(8)));
typedef short s16x4 __attribute__((ext_vector_type(4)));
typedef __bf16 bf16x2v __attribute__((ext_vector_type(2)));
typedef __bf16 bf16x8v __attribute__((ext_vector_type(8)));
typedef GAS unsigned gu32;

constexpr int S = 16384, D = 4096, DEPTH = 2;
constexpr int INC = 9072, NIN = 9216;
constexpr float LN_EPS = 1e-5f, RMS_EPS = 1e-6f;
constexpr float DN_ALPHA = 1.41421356237309515f;
constexpr float LOG2E = 1.4426950408889634f;
constexpr float QS_MLA = 0.07216878364870322f * LOG2E;
constexpr float QS_NSA = 0.08838834764831845f * LOG2E;
constexpr int NWAVES = 8, NTHR = 512;
constexpr size_t MiB = 1u << 20;
constexpr size_t WS_CTL = 0, CTL_ZERO_BYTES = 1 * MiB;
constexpr size_t WS_MOD = 1 * MiB;
constexpr size_t WS_ROPE = 2 * MiB;
constexpr size_t WS_CBP = 6 * MiB;
constexpr size_t WS_RSQQ = 7 * MiB;
constexpr size_t WS_RSQKV = 9 * MiB;
constexpr size_t WS_RSTD = 6 * MiB + 512 * 1024;
constexpr size_t WS_GNSA = 10 * MiB;
constexpr size_t WS_KCMP = 13 * MiB;
constexpr size_t WS_VCMP = 13 * MiB + 512 * 1024;
constexpr size_t WS_W = 16 * MiB, W_LSTRIDE = 120 * MiB;
constexpr size_t W_IN = 0, W_QUP = 72 * MiB, W_KVUP = 77 * MiB, W_OUT = 81 * MiB, W_C1 = 113 * MiB, W_C2 = 115 * MiB;
constexpr size_t WS_H = 256 * MiB;
constexpr size_t WS_XV = 384 * MiB;
constexpr size_t WS_QLAT = 640 * MiB, WS_KVLAT = 664 * MiB;
constexpr size_t WS_QMLA = 680 * MiB, WS_KMLA = 776 * MiB, WS_VMLA = 872 * MiB, WS_ZMLA = 936 * MiB, WS_ZNSA = 1000 * MiB, WS_QNSA = 1064 * MiB;
constexpr size_t WS_KVNSA = 1128 * MiB;
constexpr size_t WS_OSCR = 1178 * MiB;
constexpr size_t WS_END = 1210 * MiB;
constexpr int CW_BAR = 4096;
constexpr int LDS_BYTES = 147456;
constexpr int MISC_OFF = LDS_BYTES - 128;

__device__ __forceinline__ unsigned pk2(float lo, float hi) { f32x2 a = {lo, hi}; return __builtin_bit_cast(unsigned, __builtin_convertvector(a, bf16x2v)); }
__device__ __forceinline__ u32x4 pk8(f32x4 a, f32x4 b) { u32x4 w; w.x = pk2(a[0], a[1]); w.y = pk2(a[2], a[3]); w.z = pk2(b[0], b[1]); w.w = pk2(b[2], b[3]); return w; }
__device__ __forceinline__ float bflo(unsigned u) { return __uint_as_float(u << 16); }
__device__ __forceinline__ float bfhi(unsigned u) { return __uint_as_float(u & 0xffff0000u); }
__device__ __forceinline__ float wave_sum(float v) {
#pragma unroll
    for (int o = 1; o < 64; o <<= 1) v += __shfl_xor(v, o);
    return v;
}
__device__ __forceinline__ float silu_f(float v) { return v / (1.f + __expf(-v)); }
__device__ __forceinline__ float sigm_f(float v) { return 1.f / (1.f + __expf(-v)); }

#define XB_TMO      128
#define XB_XCNT(j)  (256  + 64 * (j))
#define XB_XSUB(j)  (1280 + 64 * (j))
#define XB_XGEN(j)  (2304 + 64 * (j))
#define XB_TOP      3328
#define XB_TOPGEN   3392
#define XCD_BAR_WORDS 3456
#define XB_SPIN_CAP (1u << 18)
__device__ __forceinline__ unsigned xb_ld(unsigned* p)              { return __hip_atomic_load(p, __ATOMIC_RELAXED, __HIP_MEMORY_SCOPE_AGENT); }
__device__ __forceinline__ unsigned xb_add(unsigned* p, unsigned v) { return __hip_atomic_fetch_add(p, v, __ATOMIC_RELAXED, __HIP_MEMORY_SCOPE_AGENT); }
__device__ __forceinline__ unsigned xb_xcc_id() { return (unsigned)__builtin_amdgcn_s_getreg((3 << 11) | 20) & 0xFu; }
#define XB_SPIN(cond, bar) do { unsigned _sp = 0; while (cond) { __builtin_amdgcn_s_sleep(1); \
    if ((++_sp & 255u) == 0u) { if (xb_ld(&(bar)[XB_TMO])) break; if (_sp > XB_SPIN_CAP) { atomicAdd(&(bar)[XB_TMO], 1u); break; } } } } while (0)
struct XcdBarrier { unsigned* bar; unsigned x; volatile LAS unsigned* st; };
__device__ __forceinline__ XcdBarrier xcd_barrier_post(unsigned* bar, volatile LAS unsigned* st) {
    XcdBarrier b; b.bar = bar; b.x = xb_xcc_id(); b.st = st;
    if (threadIdx.x == 0) (void)xb_add(&bar[XB_XCNT(b.x)], 1u);
    return b;
}
__device__ __forceinline__ void xcd_barrier_complete(unsigned* bar, unsigned x, unsigned& nloc, unsigned& nx) {
    const unsigned G = gridDim.x * gridDim.y * gridDim.z;
    unsigned sum, cnt, mine, sp = 0u;
    for (;;) {
        sum = 0u; cnt = 0u; mine = 0u;
#pragma unroll
        for (unsigned j = 0; j < 16; ++j) { const unsigned c = xb_ld(&bar[XB_XCNT(j)]); sum += c; cnt += (c > 0u) ? 1u : 0u; mine = (j == x) ? c : mine; }
        if (sum == G) break;
        __builtin_amdgcn_s_sleep(1);
        if ((++sp & 255u) == 0u) { if (xb_ld(&bar[XB_TMO])) break; if (sp > XB_SPIN_CAP) { atomicAdd(&bar[XB_TMO], 1u); break; } }
    }
    nloc = mine > 0u ? mine : 1u; nx = cnt > 0u ? cnt : 1u;
}
__device__ __forceinline__ void xcd_barrier(const XcdBarrier& b) {
    asm volatile("s_waitcnt vmcnt(0)" ::: "memory");
    __syncthreads();
    if (threadIdx.x == 0) {
        unsigned* bar = b.bar;
        __builtin_amdgcn_s_waitcnt(0);
        unsigned nloc = b.st[0], nx = b.st[1];
        if (nloc == 0u) { xcd_barrier_complete(bar, b.x, nloc, nx); b.st[0] = nloc; b.st[1] = nx; }
        const unsigned old = xb_add(&bar[XB_XSUB(b.x)], 1u);
        const unsigned gen = old / nloc;
        if (old + 1u == (gen + 1u) * nloc) {
            __builtin_amdgcn_fence(__ATOMIC_RELEASE, "agent");
            asm volatile("s_waitcnt vmcnt(0)" ::: "memory");
            const unsigned og = xb_add(&bar[XB_TOP], 1u);
            const unsigned tg = og / nx;
            if (og + 1u == (tg + 1u) * nx) xb_add(&bar[XB_TOPGEN], 1u);
            else XB_SPIN(xb_ld(&bar[XB_TOPGEN]) == tg, bar);
            __builtin_amdgcn_fence(__ATOMIC_ACQUIRE, "agent");
            xb_add(&bar[XB_XGEN(b.x)], 1u);
            asm volatile("s_waitcnt vmcnt(0)" ::: "memory");
        } else {
            XB_SPIN(xb_ld(&bar[XB_XGEN(b.x)]) == gen, bar);
            __builtin_amdgcn_fence(__ATOMIC_ACQUIRE, "agent");
            asm volatile("s_waitcnt vmcnt(0)" ::: "memory");
        }
    }
    __syncthreads();
}
__device__ __forceinline__ void p0_mod_gemv(const float* c, const float* w_ada, const float* b_ada, float* mod, LAS float* lds, int vcu, int G) {
    const int tid = threadIdx.x;
    LAS float* sc = lds;
    LAS float* red = lds + 4096;
    for (int k = tid; k < D; k += NTHR) sc[k] = silu_f(c[k]);
    __syncthreads();
    const int cl = tid & 7, kl = tid >> 3;
    constexpr int NU = DEPTH * 3 * D / 32;
    for (int u = vcu; u < NU; u += G) {
        const int l = u / (3 * D / 32), n0 = (u % (3 * D / 32)) * 32;
        const float* W = w_ada + (size_t)l * D * (3 * D) + n0 + cl * 4;
        f32x4 acc = {0.f, 0.f, 0.f, 0.f};
#pragma unroll 8
        for (int i = 0; i < D / 64; ++i) { const int k = kl + 64 * i; const f32x4 w = *(const GAS f32x4*)(W + (size_t)k * (3 * D)); acc += w * sc[k]; }
        red[kl * 33 + cl * 4 + 0] = acc[0]; red[kl * 33 + cl * 4 + 1] = acc[1]; red[kl * 33 + cl * 4 + 2] = acc[2]; red[kl * 33 + cl * 4 + 3] = acc[3];
        __syncthreads();
        if (tid < 32) { float s = 0.f; for (int j = 0; j < 64; ++j) s += red[j * 33 + tid]; mod[(size_t)l * 3 * D + n0 + tid] = s + b_ada[(size_t)l * 3 * D + n0 + tid]; }
        __syncthreads();
    }
}
__device__ __forceinline__ int map_in(int n) {
    if (n < 1280) return n;
    if (n < 1344) { const int i = n - 1280; return 1280 + 2 * (i & 31) + (i >> 5); }
    if (n < 3392) return 1536 + (n - 1344);
    if (n < 5440) return 3584 + (n - 3392);
    if (n < 6976) return 5632 + (n - 5440);
    if (n < 7024) return 1344 + (n - 6976);
    return 7168 + (n - 7024);
}
#ifdef MLA_FP8V
__device__ __forceinline__ int map_kvup(int n) { const int h = n >> 8, d = n & 255; return d < 128 ? h * 128 + d : 2048 + h * 128 + (d - 128); }
#endif
__device__ __forceinline__ int map_qup(int n) { const int h = n / 192, d = n - h * 192; if (d < 128) return h * 128 + d; const int i = d - 128; return 2048 + h * 64 + 2 * (i & 31) + (i >> 5); }
template <int MAP>
__device__ __forceinline__ void tr_item(const float* W, int K, int N, bf16* WT, const float* kscale, int kb, int nb, int lane) {
    const int k0 = 64 * kb, n = 64 * nb + lane;
    if (n >= N) return;
    const GAS float* src = (const GAS float*)(W + (size_t)k0 * N + n);
    float v[64];
#pragma unroll
    for (int i = 0; i < 64; ++i) v[i] = src[(size_t)i * N];
    if (kscale) {
#pragma unroll
        for (int i = 0; i < 64; ++i) v[i] *= kscale[k0 + i];
    }
#ifdef MLA_FP8V
    const int row = MAP == 1 ? map_in(n) : (MAP == 2 ? map_qup(n) : (MAP == 3 ? map_kvup(n) : n));
#else
    const int row = MAP == 1 ? map_in(n) : (MAP == 2 ? map_qup(n) : n);
#endif
    GAS u32x4* dst = (GAS u32x4*)(WT + (size_t)row * K + k0);
#pragma unroll
    for (int c = 0; c < 8; ++c) { u32x4 o; o.x = pk2(v[8 * c], v[8 * c + 1]); o.y = pk2(v[8 * c + 2], v[8 * c + 3]); o.z = pk2(v[8 * c + 4], v[8 * c + 5]); o.w = pk2(v[8 * c + 6], v[8 * c + 7]); dst[c] = o; }
}
struct P0In { const float *w_in, *q_norm, *w_q_up, *kv_norm, *w_kv_up, *w_cmp1, *w_cmp2, *w_out; };
__device__ __forceinline__ void p0_convert(const P0In& I, unsigned char* ws, int gw, int NGW, int lane) {
    constexpr int T_IN = 64 * 142, T_QUP = 12 * 48, T_KVUP = 8 * 64, T_OUT = 64 * 64, T_C1 = 2 * 64 * 2, T_C2 = 2 * 2 * 2;
    constexpr int TL = T_IN + T_QUP + T_KVUP + T_OUT + T_C1 + T_C2;
    for (int it = gw; it < DEPTH * TL; it += NGW) {
        const int l = it / TL; int r = it - l * TL;
        unsigned char* wl = ws + WS_W + (size_t)l * W_LSTRIDE;
        if (r < T_IN) { tr_item<1>(I.w_in + (size_t)l * D * INC, D, INC, (bf16*)(wl + W_IN), nullptr, r / 142, r % 142, lane); continue; } r -= T_IN;
        if (r < T_QUP) { tr_item<2>(I.w_q_up + (size_t)l * 768 * 3072, 768, 3072, (bf16*)(wl + W_QUP), I.q_norm + l * 768, r / 48, r % 48, lane); continue; } r -= T_QUP;
#ifdef MLA_FP8V
        if (r < T_KVUP) { tr_item<3>(I.w_kv_up + (size_t)l * 512 * 4096, 512, 4096, (bf16*)(wl + W_KVUP), I.kv_norm + l * 512, r / 64, r % 64, lane); continue; }
#else
        if (r < T_KVUP) { tr_item<0>(I.w_kv_up + (size_t)l * 512 * 4096, 512, 4096, (bf16*)(wl + W_KVUP), I.kv_norm + l * 512, r / 64, r % 64, lane); continue; }
#endif
        r -= T_KVUP;
        if (r < T_OUT) { tr_item<0>(I.w_out + (size_t)l * D * D, D, D, (bf16*)(wl + W_OUT), nullptr, r / 64, r % 64, lane); continue; } r -= T_OUT;
        if (r < T_C1) { const int kv = r / 128, rr = r % 128; tr_item<0>(I.w_cmp1 + (size_t)(l * 2 + kv) * 4096 * 128, 4096, 128, (bf16*)(wl + W_C1) + (size_t)kv * 128 * 4096, nullptr, rr / 2, rr % 2, lane); continue; } r -= T_C1;
        { const int kv = r / 4, rr = r % 4; tr_item<0>(I.w_cmp2 + (size_t)(l * 2 + kv) * 128 * 128, 128, 128, (bf16*)(wl + W_C2) + (size_t)kv * 128 * 128, nullptr, rr / 2, rr % 2, lane); }
    }
}
__device__ __forceinline__ void p0_rope(const int* positions, float* cosT, float* sinT, int gtid, int NT) {
    for (int e = gtid; e < S * 32; e += NT) { const int s = e >> 5, i = e & 31;
        const float inv = (float)exp(-(double)i * (1.0 / 32.0) * 9.210340371976184);
        const float ang = (float)positions[s] * inv;
        cosT[e] = (float)cos((double)ang); sinT[e] = (float)sin((double)ang); }
}
__device__ __forceinline__ void p0_cmpbias(const float* cmp_pos, const float* w_cmp1, float* cbp, LAS float* red, int vcu, int G) {
    const int tid = threadIdx.x, n = tid & 127, kq = tid >> 7;
    for (int u = vcu; u < 64; u += G) {
        const int lk = u >> 4, ch = u & 15;
        const float* P = cmp_pos + (size_t)lk * 4096 + 256 * ch; const float* W = w_cmp1 + (size_t)lk * 4096 * 128 + (size_t)(256 * ch) * 128 + n;
        float a = 0.f;
#pragma unroll 8
        for (int i = 0; i < 64; ++i) { const int k = kq + 4 * i; a += P[k] * *(const GAS float*)(W + (size_t)k * 128); }
        red[kq * 128 + n] = a;
        __syncthreads();
        if (tid < 128) cbp[(size_t)u * 128 + tid] = (red[tid] + red[128 + tid]) + (red[256 + tid] + red[384 + tid]);
        __syncthreads();
    }
}
__device__ __forceinline__ void modulate_rows(const float* x, bf16* hout, const float* modl, int gw, int NGW, int lane) {
    f32x4 sh[16], sc[16];
#pragma unroll
    for (int j = 0; j < 16; ++j) { sh[j] = *((const GAS f32x4*)modl + lane + 64 * j); sc[j] = *((const GAS f32x4*)(modl + D) + lane + 64 * j) + 1.f; }
    for (int m = gw; m < S; m += NGW) {
        const GAS f32x4* xr = (const GAS f32x4*)(x + (size_t)m * D) + lane;
        GAS u32x2* ho = (GAS u32x2*)(hout + (size_t)m * D) + lane;
#pragma unroll
        for (int j = 0; j < 16; ++j) { const f32x4 h = xr[64 * j] * sc[j] + sh[j]; u32x2 w; w.x = pk2(h[0], h[1]); w.y = pk2(h[2], h[3]); ho[64 * j] = w; }
    }
}
__device__ __forceinline__ void ln_rows(const float* v, float* xout, bf16* hout, const float* g, const float* b, const float* mod_next, int gw, int NGW, int lane) {
    for (int m = gw; m < S; m += NGW) {
        const GAS f32x4* vr = (const GAS f32x4*)(v + (size_t)m * D) + lane;
        f32x4 x[16]; float s = 0.f;
#pragma unroll
        for (int j = 0; j < 16; ++j) { x[j] = vr[64 * j]; s += (x[j][0] + x[j][1]) + (x[j][2] + x[j][3]); }
        const float mean = wave_sum(s) * (1.f / D); float s2 = 0.f;
#pragma unroll
        for (int j = 0; j < 16; ++j) { x[j] = x[j] - mean; s2 += (x[j][0] * x[j][0] + x[j][1] * x[j][1]) + (x[j][2] * x[j][2] + x[j][3] * x[j][3]); }
        const float rstd = 1.f / sqrtf(wave_sum(s2) * (1.f / D) + LN_EPS);
        GAS f32x4* xo = (GAS f32x4*)(xout + (size_t)m * D) + lane;
#pragma unroll
        for (int j = 0; j < 16; ++j) {
            const f32x4 gg = *((const GAS f32x4*)g + lane + 64 * j), bb = *((const GAS f32x4*)b + lane + 64 * j);
#ifdef OSCALE
            const f32x4 y = (x[j] * rstd * gg + bb) * (hout ? 1.f : OSCALE);
#else
            const f32x4 y = x[j] * rstd * gg + bb;
#endif
            xo[64 * j] = y;
            if (hout) {
                const f32x4 sh = *((const GAS f32x4*)mod_next + lane + 64 * j), scl = *((const GAS f32x4*)(mod_next + D) + lane + 64 * j);
                const f32x4 h = y * (scl + 1.f) + sh;
                u32x2 w; w.x = pk2(h[0], h[1]); w.y = pk2(h[2], h[3]);
                *((GAS u32x2*)(hout + (size_t)m * D) + lane + 64 * j) = w;
            }
        }
    }
}
__device__ __forceinline__ void rstd_rows(const float* rsq_q, const float* rsq_kv, float* rstd_q, float* rstd_kv, int gtid, int NT) {
    for (int row = gtid; row < S; row += NT) {
        const GAS f32x4* rp = (const GAS f32x4*)(rsq_q + (size_t)row * 24); float ss = 0.f;
#pragma unroll
        for (int i = 0; i < 6; ++i) { const f32x4 t = rp[i]; ss += (t[0] + t[1]) + (t[2] + t[3]); }
        rstd_q[row] = 1.f / sqrtf(ss * (1.f / 768.f) + RMS_EPS);
        const GAS f32x4* rk = (const GAS f32x4*)(rsq_kv + (size_t)row * 16); float sk = 0.f;
#pragma unroll
        for (int i = 0; i < 4; ++i) { const f32x4 t = rk[i]; sk += (t[0] + t[1]) + (t[2] + t[3]); }
        rstd_kv[row] = 1.f / sqrtf(sk * (1.f / 512.f) + RMS_EPS);
    }
}
namespace pg8 {
#define PG8_LAS __attribute__((address_space(3)))
typedef unsigned short bf16_t;
typedef short bf16x8 __attribute__((ext_vector_type(8)));
typedef float f32x4 __attribute__((ext_vector_type(4)));
typedef unsigned u32x4 __attribute__((ext_vector_type(4)));
constexpr int BM = 256, BK = 64, HALF = 128, HTB = HALF * BK * 2  , STAGE_BYTES = 8 * HTB, NXCD = 8, WGM = 8;

__host__ __device__ __forceinline__ int lds_byte(int r, int c) { const int st = (r >> 4) * 2 + (c >> 5), rr = r & 15, cc = c & 31, ob = rr * 64 + cc * 2; return st * 1024 + (ob ^ (((ob >> 9) & 1) << 5)); }
__host__ __device__ __forceinline__ void stage_rc(int b, int& R, int& C) { const int st = b / 1024, sb = b % 1024, swz = sb ^ (((sb >> 9) & 1) << 5); R = (st >> 1) * 16 + swz / 64; C = (st & 1) * 32 + (swz % 64) / 2; }
__host__ __device__ __forceinline__ int perm32(int rho) { const int n = rho >> 4, i = rho & 15; return 8 * (i >> 2) + 4 * n + (i & 3); }

struct Unit { int pm, pn; };
struct Gemm { const bf16_t* A; const bf16_t* Bt; int M, N, K; };

struct StaticOrder {
    int nM, nN, nwg, G, c;
    __host__ __device__ void init(int M, int N, int G_, int c_) { nM = M / BM; nN = N / BM; nwg = nM * nN; G = G_; c = c_; }
    __host__ __device__ bool next(int i, Unit& u) const {
        const long L = (long)i * G + c; if (L >= nwg) return false;
        int wgid = (int)L; { const int q = nwg / NXCD, r = nwg % NXCD, xcd = wgid % NXCD, off = wgid / NXCD; wgid = (xcd < r ? xcd * (q + 1) : r * (q + 1) + (xcd - r) * q) + off; }
        const int nig = WGM * nN, gid = wgid / nig, fm = gid * WGM, gsz = (nM - fm) < WGM ? (nM - fm) : WGM;
        u.pm = fm + ((wgid % nig) % gsz); u.pn = (wgid % nig) / gsz; return true;
    }
    __device__ __forceinline__ void a_ready(const Unit&) const {}
    __device__ __forceinline__ void done(const Unit&) const {}
};
__device__ __forceinline__ f32x4 rope4(const f32x4 v, float c0, float s0, float c1, float s1) {
    f32x4 o; o[0] = v[0] * c0 - v[1] * s0; o[1] = v[1] * c0 + v[0] * s0; o[2] = v[2] * c1 - v[3] * s1; o[3] = v[3] * c1 + v[2] * s1; return o; }
#ifdef NOISE_BUILD
__device__ __forceinline__ f32x4 nz4(f32x4 v, int row, int col) {
    f32x4 o;
#pragma unroll
    for (int i = 0; i < 4; ++i) { unsigned h = (unsigned)row * 9216u + (unsigned)(col + i); h ^= h >> 16; h *= 0x7feb352du; h ^= h >> 15; h *= 0x846ca68bu; h ^= h >> 16;
        const float r = (float)(int)(h & 0xffffu) * (1.f / 32768.f) - 1.f; o[i] = v[i] * (1.f + NOISE_EPS * r); }
    return o; }
#define NZ(v, row, col) nz4((v), (row), (col))
#else
#define NZ(v, row, col) (v)
#endif
#ifdef MLA_FP8
__device__ __forceinline__ u32x2 pk8_fp8(f32x4 a, f32x4 b) {
    int w0 = __builtin_amdgcn_cvt_pk_fp8_f32(a[0], a[1], 0, false); w0 = __builtin_amdgcn_cvt_pk_fp8_f32(a[2], a[3], w0, true);
    int w1 = __builtin_amdgcn_cvt_pk_fp8_f32(b[0], b[1], 0, false); w1 = __builtin_amdgcn_cvt_pk_fp8_f32(b[2], b[3], w1, true);
    u32x2 r; r.x = (unsigned)w0; r.y = (unsigned)w1; return r; }
#endif
struct EpiIn {
    static constexpr bool PERM = true, AFTER_DRAIN = false;
    unsigned char* ws;
    __device__ __forceinline__ void operator()(const f32x4 (&acc)[2][2][4][2], const Unit& u, int wr, int wc, int fr, int fq) const {
        const int pn = u.pn, row0 = u.pm * BM + wr * 64 + fr;
        if (pn < 5) {
            const bool isq = pn < 3; bf16_t* base = (bf16_t*)(ws + (isq ? WS_QLAT : WS_KVLAT)); const int ld = isq ? 768 : 512, ct = isq ? pn : pn - 3, ns = isq ? 24 : 16; float* rsq = (float*)(ws + (isq ? WS_RSQQ : WS_RSQKV));
#pragma unroll
            for (int ai = 0; ai < 2; ++ai)
#pragma unroll
                for (int m = 0; m < 4; ++m) { const int row = row0 + ai * HALF + m * 16;
#pragma unroll
                    for (int bj = 0; bj < 2; ++bj) { const f32x4 v0 = NZ(acc[ai][bj][m][0], row, pn * 256 + bj * 128 + wc * 32 + 8 * fq), v1 = NZ(acc[ai][bj][m][1], row, pn * 256 + bj * 128 + wc * 32 + 8 * fq + 4);
                        float ss = ((v0[0] * v0[0] + v0[1] * v0[1]) + (v0[2] * v0[2] + v0[3] * v0[3])) + ((v1[0] * v1[0] + v1[1] * v1[1]) + (v1[2] * v1[2] + v1[3] * v1[3]));
                        ss += __shfl_xor(ss, 16); ss += __shfl_xor(ss, 32);
                        if (fq == 0) rsq[(size_t)row * ns + ct * 8 + bj * 4 + wc] = ss;
                        *(GAS u32x4*)(base + (size_t)row * ld + ct * 256 + bj * HALF + wc * 32 + 8 * fq) = pk8(v0, v1); } }
        } else if (pn == 5) {
            if (wc < 2) {
                const int i0 = 16 * wc + 4 * fq; const float* cosT = (const float*)(ws + WS_ROPE); const float* sinT = cosT + (size_t)S * 32; bf16_t* kmla = (bf16_t*)(ws + WS_KMLA);
#pragma unroll
                for (int ai = 0; ai < 2; ++ai)
#pragma unroll
                    for (int m = 0; m < 4; ++m) { const int row = row0 + ai * HALF + m * 16;
                        const f32x4 cs = *(const GAS f32x4*)(cosT + (size_t)row * 32 + i0), sn = *(const GAS f32x4*)(sinT + (size_t)row * 32 + i0);
#ifdef MLA_FP8
                        const u32x2 w = pk8_fp8(rope4(acc[ai][0][m][0], cs[0], sn[0], cs[1], sn[1]), rope4(acc[ai][0][m][1], cs[2], sn[2], cs[3], sn[3]));
                        unsigned char* dst = (unsigned char*)kmla + (size_t)row * 3072 + 128 + wc * 32 + 8 * fq;
#pragma unroll
                        for (int h = 0; h < 16; ++h) *(GAS u32x2*)(dst + h * 192) = w;
#else
                        const u32x4 w = pk8(rope4(acc[ai][0][m][0], cs[0], sn[0], cs[1], sn[1]), rope4(acc[ai][0][m][1], cs[2], sn[2], cs[3], sn[3]));
                        bf16_t* dst = kmla + (size_t)row * 3072 + 128 + wc * 32 + 8 * fq;
#pragma unroll
                        for (int h = 0; h < 16; ++h) *(GAS u32x4*)(dst + h * 192) = w;
#endif
                        asm volatile("" ::: "memory"); }
            } else {
                const int cl = (wc - 2) * 32 + 8 * fq; float* gnsa = (float*)(ws + WS_GNSA);
                if (cl < 48) {
#pragma unroll
                    for (int ai = 0; ai < 2; ++ai)
#pragma unroll
                        for (int m = 0; m < 4; ++m) { const int row = row0 + ai * HALF + m * 16; const f32x4 v0 = acc[ai][0][m][0], v1 = acc[ai][0][m][1];
                            f32x4 g0, g1; g0[0] = sigm_f(v0[0]); g0[1] = sigm_f(v0[1]); g0[2] = sigm_f(v0[2]); g0[3] = sigm_f(v0[3]); g1[0] = sigm_f(v1[0]); g1[1] = sigm_f(v1[1]); g1[2] = sigm_f(v1[2]); g1[3] = sigm_f(v1[3]);
                            *(GAS f32x4*)(gnsa + (size_t)row * 48 + cl) = g0; *(GAS f32x4*)(gnsa + (size_t)row * 48 + cl + 4) = g1; } }
            }
        } else {
            const int mode = (pn < 14) ? 0 : (pn < 22 ? 1 : (pn < 28 ? 2 : 0));
            bf16_t* base = (pn < 14) ? (bf16_t*)(ws + WS_ZMLA) + (pn - 6) * 256 : (pn < 22 ? (bf16_t*)(ws + WS_QNSA) + (pn - 14) * 256 : (bf16_t*)(ws + WS_ZNSA) + (pn - 28) * 256); bf16_t* kvnsa = (bf16_t*)(ws + WS_KVNSA);
#pragma unroll
            for (int ai = 0; ai < 2; ++ai)
#pragma unroll
                for (int m = 0; m < 4; ++m) { const int row = row0 + ai * HALF + m * 16;
#pragma unroll
                    for (int bj = 0; bj < 2; ++bj) { f32x4 v0 = NZ(acc[ai][bj][m][0], row, pn * 256 + bj * 128 + wc * 32 + 8 * fq), v1 = NZ(acc[ai][bj][m][1], row, pn * 256 + bj * 128 + wc * 32 + 8 * fq + 4);
                        if (mode == 0) { v0[0] = silu_f(v0[0]); v0[1] = silu_f(v0[1]); v0[2] = silu_f(v0[2]); v0[3] = silu_f(v0[3]); v1[0] = silu_f(v1[0]); v1[1] = silu_f(v1[1]); v1[2] = silu_f(v1[2]); v1[3] = silu_f(v1[3]); }
                        else if (mode == 1) { v0 = v0 * QS_NSA; v1 = v1 * QS_NSA; }
                        bf16_t* dst = (mode == 2) ? kvnsa + (size_t)(2 * (pn - 22) + bj) * ((size_t)S * 128) + (size_t)row * 128 + wc * 32 + 8 * fq
                                                  : base + (size_t)row * 2048 + bj * HALF + wc * 32 + 8 * fq;
                        *(GAS u32x4*)dst = pk8(v0, v1); } }
        }
    }
};
struct EpiQup {
    static constexpr bool PERM = true, AFTER_DRAIN = false;
    unsigned char* ws;
    __device__ __forceinline__ void operator()(const f32x4 (&acc)[2][2][4][2], const Unit& u, int wr, int wc, int fr, int fq) const {
        const int pn = u.pn, row0 = u.pm * BM + wr * 64 + fr; bf16_t* qmla = (bf16_t*)(ws + WS_QMLA); const float* rstd_q = (const float*)(ws + WS_RSTD); const float* cosT = (const float*)(ws + WS_ROPE); const float* sinT = cosT + (size_t)S * 32;
#pragma unroll
        for (int ai = 0; ai < 2; ++ai)
#pragma unroll
            for (int m = 0; m < 4; ++m) { const int row = row0 + ai * HALF + m * 16;
#ifdef MLA_FP8
                const float sc = *(const GAS float*)(rstd_q + row);
                unsigned char* q8 = (unsigned char*)qmla + (size_t)row * 3072;
#pragma unroll
                for (int bj = 0; bj < 2; ++bj) { const f32x4 v0 = acc[ai][bj][m][0] * sc, v1 = acc[ai][bj][m][1] * sc;
                    if (pn < 8) { *(GAS u32x2*)(q8 + (2 * pn + bj) * 192 + wc * 32 + 8 * fq) = pk8_fp8(v0, v1); }
                    else { const int cp = (pn - 8) * 256 + bj * HALF + wc * 32 + 8 * fq, head = cp >> 6, dl = cp & 63, i0 = dl >> 1;
                        const f32x4 cs = *(const GAS f32x4*)(cosT + (size_t)row * 32 + i0), sn = *(const GAS f32x4*)(sinT + (size_t)row * 32 + i0);
                        *(GAS u32x2*)(q8 + head * 192 + 128 + dl) = pk8_fp8(rope4(v0, cs[0], sn[0], cs[1], sn[1]), rope4(v1, cs[2], sn[2], cs[3], sn[3])); } }
#else
                const float sc = QS_MLA * *(const GAS float*)(rstd_q + row);
#pragma unroll
                for (int bj = 0; bj < 2; ++bj) { const f32x4 v0 = acc[ai][bj][m][0] * sc, v1 = acc[ai][bj][m][1] * sc;
                    if (pn < 8) { *(GAS u32x4*)(qmla + (size_t)row * 3072 + (2 * pn + bj) * 192 + wc * 32 + 8 * fq) = pk8(v0, v1); }
                    else { const int cp = (pn - 8) * 256 + bj * HALF + wc * 32 + 8 * fq, head = cp >> 6, dl = cp & 63, i0 = dl >> 1;
                        const f32x4 cs = *(const GAS f32x4*)(cosT + (size_t)row * 32 + i0), sn = *(const GAS f32x4*)(sinT + (size_t)row * 32 + i0);
                        *(GAS u32x4*)(qmla + (size_t)row * 3072 + head * 192 + 128 + dl) = pk8(rope4(v0, cs[0], sn[0], cs[1], sn[1]), rope4(v1, cs[2], sn[2], cs[3], sn[3])); } }
#endif
                if (m & 1) asm volatile("" ::: "memory"); }
    }
};
struct EpiKvup {
    static constexpr bool PERM = true, AFTER_DRAIN = false;
    unsigned char* ws;
    __device__ __forceinline__ void operator()(const f32x4 (&acc)[2][2][4][2], const Unit& u, int wr, int wc, int fr, int fq) const {
        const int pn = u.pn, row0 = u.pm * BM + wr * 64 + fr;
#pragma unroll
        for (int ai = 0; ai < 2; ++ai)
#pragma unroll
            for (int m = 0; m < 4; ++m) { const int row = row0 + ai * HALF + m * 16;
                const float sc = *(const GAS float*)((const float*)(ws + WS_RSTD) + S + row); bf16_t* kmla = (bf16_t*)(ws + WS_KMLA); bf16_t* vmla = (bf16_t*)(ws + WS_VMLA);
#ifdef MLA_FP8
                *(GAS u32x2*)((unsigned char*)kmla + (size_t)row * 3072 + pn * 192 + wc * 32 + 8 * fq) = pk8_fp8(acc[ai][0][m][0] * sc, acc[ai][0][m][1] * sc);
#else
                *(GAS u32x4*)(kmla + (size_t)row * 3072 + pn * 192 + wc * 32 + 8 * fq) = pk8(acc[ai][0][m][0] * sc, acc[ai][0][m][1] * sc);
#endif
                *(GAS u32x4*)(vmla + (size_t)row * 2048 + pn * 128 + wc * 32 + 8 * fq) = pk8(acc[ai][1][m][0] * sc, acc[ai][1][m][1] * sc);
                if (m & 1) asm volatile("" ::: "memory"); }
    }
};
#ifdef MLA_FP8V
struct EpiKup {
    static constexpr bool PERM = true, AFTER_DRAIN = false;
    unsigned char* ws;
    __device__ __forceinline__ void operator()(const f32x4 (&acc)[2][2][4][2], const Unit& u, int wr, int wc, int fr, int fq) const {
        const int pn = u.pn, row0 = u.pm * BM + wr * 64 + fr;
#pragma unroll
        for (int ai = 0; ai < 2; ++ai)
#pragma unroll
            for (int m = 0; m < 4; ++m) { const int row = row0 + ai * HALF + m * 16;
                const float sc = *(const GAS float*)((const float*)(ws + WS_RSTD) + S + row); unsigned char* k8 = ws + WS_KMLA + (size_t)row * 3072;
#pragma unroll
                for (int bj = 0; bj < 2; ++bj) *(GAS u32x2*)(k8 + (2 * pn + bj) * 192 + wc * 32 + 8 * fq) = pk8_fp8(acc[ai][bj][m][0] * sc, acc[ai][bj][m][1] * sc);
                if (m & 1) asm volatile("" ::: "memory"); }
    }
};
struct EpiVt {
    static constexpr bool PERM = true, AFTER_DRAIN = false;
    unsigned char* ws;
    __device__ __forceinline__ void operator()(const f32x4 (&acc)[2][2][4][2], const Unit& u, int wr, int wc, int fr, int fq) const {
        const int row0 = u.pm * BM + wr * 64 + fr, col0 = u.pn * BM + wc * 32 + 8 * fq;
        const float* rs = (const float*)(ws + WS_RSTD) + S;
        f32x4 sc[2][2];
#pragma unroll
        for (int bj = 0; bj < 2; ++bj) { sc[bj][0] = *(const GAS f32x4*)(rs + col0 + bj * HALF); sc[bj][1] = *(const GAS f32x4*)(rs + col0 + bj * HALF + 4); }
        const int hi8 = (col0 >> 3) & 1;
#pragma unroll
        for (int ai = 0; ai < 2; ++ai)
#pragma unroll
            for (int m = 0; m < 4; ++m) { unsigned char* vt = ws + WS_VMLA + (size_t)(row0 + ai * HALF + m * 16) * S;
#pragma unroll
                for (int bj = 0; bj < 2; ++bj) { const u32x2 w = pk8_fp8(acc[ai][bj][m][0] * sc[bj][0], acc[ai][bj][m][1] * sc[bj][1]);
                    unsigned char* d16 = vt + ((col0 + bj * HALF) & ~15);
                    *(GAS unsigned*)(d16 + (hi8 ? 4 : 0)) = w.x; *(GAS unsigned*)(d16 + (hi8 ? 12 : 8)) = w.y; } }
    }
};
#endif
struct EpiOut {
    static constexpr bool PERM = false, AFTER_DRAIN = false;
    const float* x; float* xv; const float* gate;
    __device__ __forceinline__ void operator()(const f32x4 (&acc)[2][2][4][2], const Unit& u, int wr, int wc, int fr, int fq) const {
        const int row0 = u.pm * BM + wr * 64 + fr, col0 = u.pn * BM + wc * 32 + 4 * fq;
        f32x4 gv[2][2];
#pragma unroll
        for (int bj = 0; bj < 2; ++bj)
#pragma unroll
            for (int n = 0; n < 2; ++n) gv[bj][n] = *(const GAS f32x4*)(gate + col0 + bj * HALF + n * 16);
#pragma unroll
        for (int ai = 0; ai < 2; ++ai)
#pragma unroll
            for (int m = 0; m < 4; ++m) { const size_t off = (size_t)(row0 + ai * HALF + m * 16) * D + col0;
#pragma unroll
                for (int bj = 0; bj < 2; ++bj)
#pragma unroll
                    for (int n = 0; n < 2; ++n) { const f32x4 xx = *(const GAS f32x4*)(x + off + bj * HALF + n * 16);
                        #ifdef YSCALE
                        *(GAS f32x4*)(xv + off + bj * HALF + n * 16) = xx * DN_ALPHA + gv[bj][n] * acc[ai][bj][m][n] * YSCALE; }
#else
                        *(GAS f32x4*)(xv + off + bj * HALF + n * 16) = xx * DN_ALPHA + gv[bj][n] * acc[ai][bj][m][n]; }
#endif
                if (m & 1) asm volatile("" ::: "memory"); }
    }
};
template <class Epi, class Sched, bool ALIGN_EPI = false, bool SP2 = false>
__device__ __forceinline__ void gemm_phase(PG8_LAS unsigned char* lds, const Gemm g, const Sched& S, const Epi& E) {
    int tid_ = threadIdx.x; asm volatile("" : "+v"(tid_));
    const int tid = tid_, wid = __builtin_amdgcn_readfirstlane(tid >> 6), lane = tid & 63, wr = wid >> 2, wc = wid & 3, fr = lane & 15, fq = lane >> 4;
    const int K = g.K, nt = K / BK;
    unsigned voffA[2], voffB[2];
#pragma unroll
    for (int i = 0; i < 2; ++i) { int R, C; stage_rc(tid * 16 + i * 8192, R, C); const int Rb = Epi::PERM ? ((R & ~31) + perm32(R & 31)) : R;
        voffA[i] = (unsigned)(R * K + C) * 2u; voffB[i] = (unsigned)(Rb * K + C) * 2u; }
    const size_t kstep = (size_t)(BK * 2);
    const size_t hstep = (size_t)HALF * K * 2;
    const size_t tstep = 2 * hstep;
    const unsigned ldsw = (unsigned)wid * 1024u;
    const int aoff = lds_byte(wr * 64 + fr, fq * 8), boff = lds_byte(wc * 32 + fr, fq * 8);
#define PG8_SA(b, h) (((b) * 2 + (h)) * HTB)
#define PG8_SB(b, h) ((4 + (b) * 2 + (h)) * HTB)
#define PG8_STAGE(bufoff, gbase, voff) do { _Pragma("unroll") for (int _i = 0; _i < 2; ++_i) \
        __builtin_amdgcn_global_load_lds((const unsigned*)((const char*)(gbase) + (voff)[_i]), (PG8_LAS unsigned*)(lds + (bufoff) + ldsw + _i * 8192), 16, 0, 0); } while (0)
#define PG8_LDA(dst, b, h) do { _Pragma("unroll") for (int m = 0; m < 4; ++m) _Pragma("unroll") for (int k = 0; k < 2; ++k) dst[m][k] = *(const PG8_LAS bf16x8*)(lds + PG8_SA(b, h) + aoff + m * 2048 + k * 1024); } while (0)
#define PG8_LDB(dst, b, h) do { _Pragma("unroll") for (int n = 0; n < 2; ++n) _Pragma("unroll") for (int k = 0; k < 2; ++k) dst[n][k] = *(const PG8_LAS bf16x8*)(lds + PG8_SB(b, h) + boff + n * 2048 + k * 1024); } while (0)
#define PG8_MMA(ai, bj, At, Bt) do { __builtin_amdgcn_s_setprio(1); _Pragma("unroll") for (int m = 0; m < 4; ++m) _Pragma("unroll") for (int n = 0; n < 2; ++n) _Pragma("unroll") for (int k = 0; k < 2; ++k) \
        acc[ai][bj][m][n] = __builtin_amdgcn_mfma_f32_16x16x32_bf16(Bt[n][k], At[m][k], acc[ai][bj][m][n], 0, 0, 0); __builtin_amdgcn_s_setprio(0); } while (0)
#define PG8_WAIT_V(n) asm volatile("s_waitcnt vmcnt(" #n ")" ::: "memory")
#define PG8_WAIT_L(n) asm volatile("s_waitcnt lgkmcnt(" #n ")" ::: "memory")
#define PG8_BAR __builtin_amdgcn_s_barrier()
#define PG8_SCHED __builtin_amdgcn_sched_barrier(0)
    Unit cur, nxt; int ui = 0;
    if (!S.next(0, cur)) return;
    f32x4 acc[2][2][4][2];
#pragma unroll
    for (int a = 0; a < 2; ++a)
#pragma unroll
        for (int b = 0; b < 2; ++b)
#pragma unroll
            for (int m = 0; m < 4; ++m)
#pragma unroll
                for (int n = 0; n < 2; ++n) acc[a][b][m][n] = (f32x4){0.f, 0.f, 0.f, 0.f};
    bf16x8 At[4][2], B0[2][2], B1[2][2];
    const char* cA = (const char*)g.A + (size_t)cur.pm * tstep; const char* cB = (const char*)g.Bt + (size_t)cur.pn * tstep;
    S.a_ready(cur);
    if constexpr (SP2) {
        PG8_STAGE(PG8_SB(0, 0), cB, voffB); PG8_STAGE(PG8_SB(0, 1), cB + hstep, voffB); PG8_STAGE(PG8_SA(0, 0), cA, voffA); PG8_STAGE(PG8_SA(0, 1), cA + hstep, voffA);
        if (wr == 1) PG8_BAR;
        PG8_WAIT_V(2); PG8_BAR;
        PG8_STAGE(PG8_SB(1, 0), cB + kstep, voffB); PG8_STAGE(PG8_SA(1, 0), cA + kstep, voffA); PG8_STAGE(PG8_SB(1, 1), cB + hstep + kstep, voffB);
        PG8_WAIT_V(6); PG8_BAR;
    } else {
        PG8_STAGE(PG8_SB(0, 0), cB, voffB); PG8_STAGE(PG8_SA(0, 0), cA, voffA); PG8_STAGE(PG8_SB(0, 1), cB + hstep, voffB); PG8_STAGE(PG8_SA(0, 1), cA + hstep, voffA);
        if (wr == 1) PG8_BAR;
        PG8_WAIT_V(4); PG8_BAR;
        PG8_STAGE(PG8_SB(1, 0), cB + kstep, voffB); PG8_STAGE(PG8_SA(1, 0), cA + kstep, voffA); PG8_STAGE(PG8_SB(1, 1), cB + hstep + kstep, voffB);
        PG8_WAIT_V(6); PG8_BAR;
    }
    for (;;) {
        const bool has_next = S.next(ui + 1, nxt);
        const char* nA = has_next ? (const char*)g.A + (size_t)nxt.pm * tstep : cA; const char* nB = has_next ? (const char*)g.Bt + (size_t)nxt.pn * tstep : cB;
        for (int t = 0; t < nt; t += 2) {
            const bool last = (t == nt - 2);
            const char* a1 = cA + (size_t)(t + 1) * kstep;
            const char* a2 = last ? nA : cA + (size_t)(t + 2) * kstep; const char* b2 = last ? nB : cB + (size_t)(t + 2) * kstep;
            const char* a3 = a2 + kstep; const char* b3 = b2 + kstep;
            if (last && has_next) S.a_ready(nxt);
            if constexpr (SP2) {
            PG8_LDB(B0, 0, 0); PG8_LDB(B1, 0, 1); PG8_SCHED; PG8_LDA(At, 0, 0); PG8_STAGE(PG8_SA(1, 1), a1 + hstep, voffA);
            PG8_WAIT_V(8); PG8_WAIT_L(0); PG8_BAR; PG8_MMA(0, 0, At, B0); PG8_MMA(0, 1, At, B1); PG8_BAR; PG8_SCHED;
            PG8_LDA(At, 0, 1); PG8_STAGE(PG8_SB(0, 0), b2, voffB); PG8_STAGE(PG8_SB(0, 1), b2 + hstep, voffB); PG8_STAGE(PG8_SA(0, 0), a2, voffA);
            PG8_WAIT_V(8); PG8_WAIT_L(0); PG8_BAR; PG8_MMA(1, 0, At, B0); PG8_MMA(1, 1, At, B1); PG8_BAR; PG8_SCHED;
            PG8_LDB(B0, 1, 0); PG8_LDB(B1, 1, 1); PG8_SCHED; PG8_LDA(At, 1, 0); PG8_STAGE(PG8_SA(0, 1), a2 + hstep, voffA);
            PG8_WAIT_V(8); PG8_WAIT_L(0); PG8_BAR; PG8_MMA(0, 0, At, B0); PG8_MMA(0, 1, At, B1); PG8_BAR; PG8_SCHED;
            PG8_LDA(At, 1, 1); PG8_STAGE(PG8_SB(1, 0), b3, voffB); PG8_STAGE(PG8_SB(1, 1), b3 + hstep, voffB); PG8_STAGE(PG8_SA(1, 0), a3, voffA);
            PG8_WAIT_V(8); PG8_WAIT_L(0); PG8_BAR; PG8_MMA(1, 0, At, B0); PG8_MMA(1, 1, At, B1); PG8_BAR; PG8_SCHED;
            } else {
            PG8_LDB(B0, 0, 0); PG8_SCHED; PG8_LDA(At, 0, 0); PG8_STAGE(PG8_SA(1, 1), a1 + hstep, voffA);
            PG8_WAIT_L(8); PG8_BAR; PG8_WAIT_L(0); PG8_MMA(0, 0, At, B0); PG8_BAR; PG8_SCHED;
            PG8_LDB(B1, 0, 1); PG8_STAGE(PG8_SB(0, 0), b2, voffB);
            PG8_BAR; PG8_WAIT_L(0); PG8_MMA(0, 1, At, B1); PG8_BAR;
            PG8_LDA(At, 0, 1); PG8_STAGE(PG8_SA(0, 0), a2, voffA);
            PG8_BAR; PG8_WAIT_L(0); PG8_MMA(1, 0, At, B0); PG8_BAR; PG8_SCHED;
            PG8_STAGE(PG8_SB(0, 1), b2 + hstep, voffB);
            PG8_WAIT_V(6); PG8_BAR; PG8_MMA(1, 1, At, B1); PG8_BAR;
            PG8_LDB(B0, 1, 0); PG8_SCHED; PG8_LDA(At, 1, 0); PG8_STAGE(PG8_SA(0, 1), a2 + hstep, voffA);
            PG8_WAIT_L(8); PG8_BAR; PG8_WAIT_L(0); PG8_MMA(0, 0, At, B0); PG8_BAR; PG8_SCHED;
            PG8_LDB(B1, 1, 1); PG8_STAGE(PG8_SB(1, 0), b3, voffB);
            PG8_BAR; PG8_WAIT_L(0); PG8_MMA(0, 1, At, B1); PG8_BAR;
            PG8_LDA(At, 1, 1); PG8_STAGE(PG8_SA(1, 0), a3, voffA);
            PG8_BAR; PG8_WAIT_L(0); PG8_MMA(1, 0, At, B0); PG8_BAR; PG8_SCHED;
            PG8_STAGE(PG8_SB(1, 1), b3 + hstep, voffB);
            PG8_WAIT_V(6); PG8_BAR; PG8_MMA(1, 1, At, B1); PG8_BAR;
            }
        }
        if constexpr (ALIGN_EPI) { if (wr == 0) PG8_BAR; }
        if constexpr (!Epi::AFTER_DRAIN) { E(acc, cur, wr, wc, fr, fq); S.done(cur); }
        if (!has_next) break;
#pragma unroll
        for (int a = 0; a < 2; ++a)
#pragma unroll
            for (int b = 0; b < 2; ++b)
#pragma unroll
                for (int m = 0; m < 4; ++m)
#pragma unroll
                    for (int n = 0; n < 2; ++n) acc[a][b][m][n] = (f32x4){0.f, 0.f, 0.f, 0.f};
        cur = nxt; cA = nA; cB = nB; ++ui;
        if constexpr (ALIGN_EPI) { if (wr == 1) PG8_BAR; }
    }
    PG8_WAIT_V(0);
    if constexpr (!ALIGN_EPI) { if (wr == 0) PG8_BAR; }
    PG8_BAR;
    if constexpr (Epi::AFTER_DRAIN) { E.fused(acc, cur, wr, wc, fr, fq, lds, wid, lane); S.done(cur); }
#undef PG8_SA
#undef PG8_SB
#undef PG8_STAGE
#undef PG8_LDA
#undef PG8_LDB
#undef PG8_MMA
#undef PG8_WAIT_V
#undef PG8_WAIT_L
#undef PG8_BAR
#undef PG8_SCHED
}
}
namespace att {
constexpr int KS_M = 400, KS_N = 272, VS = 320;
constexpr int MLA_KB = 64 * KS_M, NSA_KB = 64 * KS_N, VB = 64 * VS;
constexpr int N_IMP = 2 * NSA_KB + 2 * VB;
constexpr int N_PART = N_IMP + 32768;
constexpr int N_PARTB = 8 * 32 * 17 * 4;
constexpr int N_SELM = N_PART + 2 * N_PARTB;
constexpr int N_ULIST = N_SELM + 1024;
constexpr int N_CARRY = N_ULIST + 1024;
constexpr int N_NTS = N_CARRY + 256;
static_assert(N_NTS + 16 <= MISC_OFF, "NSA LDS map");
static_assert(2 * MLA_KB + 3 * VB <= 131072, "MLA LDS map");
constexpr int MLA_QL = 2 * MLA_KB + 2 * VB;
static_assert(MLA_QL + 8 * 4096 <= 131072, "MLA LDS map (pipelined)");

#ifndef QK_PF
#define QK_PF 4
#endif
#define MFMA32(a, b, c) __builtin_amdgcn_mfma_f32_32x32x16_bf16((a), (b), (c), 0, 0, 0)
__device__ __forceinline__ float swapmax(float v) { auto rr = __builtin_amdgcn_permlane32_swap(__float_as_uint(v), __float_as_uint(v), false, false); return fmaxf(__uint_as_float(rr[0]), __uint_as_float(rr[1])); }
__device__ __forceinline__ float swapsum(float v) { auto rr = __builtin_amdgcn_permlane32_swap(__float_as_uint(v), __float_as_uint(v), false, false); return __uint_as_float(rr[0]) + __uint_as_float(rr[1]); }
template <int SIDX> __device__ __forceinline__ bf16x8 packp(const f32x16& p) {
    f32x8 t = {p[8 * SIDX + 0], p[8 * SIDX + 1], p[8 * SIDX + 2], p[8 * SIDX + 3], p[8 * SIDX + 4], p[8 * SIDX + 5], p[8 * SIDX + 6], p[8 * SIDX + 7]};
    return __builtin_bit_cast(bf16x8, __builtin_convertvector(t, bf16x8v));
}
template <int NDC, int KS, bool ZERO = true> __device__ __forceinline__ void qk_tile(f32x16& p0, f32x16& p1, const LAS unsigned char* kl, const bf16x8 (&q)[NDC]) {
    if (ZERO) {
#pragma unroll
        for (int i = 0; i < 16; ++i) { p0[i] = 0.f; p1[i] = 0.f; }
    }
    constexpr int PF = QK_PF;
    bf16x8 a[PF + 1][2];
#pragma unroll
    for (int i = 0; i < PF; ++i) { a[i][0] = *(const LAS bf16x8*)(kl + i * 32); a[i][1] = *(const LAS bf16x8*)(kl + 32 * KS + i * 32); }
#pragma unroll
    for (int d0 = 0; d0 < NDC; ++d0) {
        if (d0 + PF < NDC) { a[(d0 + PF) % (PF + 1)][0] = *(const LAS bf16x8*)(kl + (d0 + PF) * 32); a[(d0 + PF) % (PF + 1)][1] = *(const LAS bf16x8*)(kl + 32 * KS + (d0 + PF) * 32); }
        __builtin_amdgcn_sched_barrier(0);
        p0 = MFMA32(a[d0 % (PF + 1)][0], q[d0], p0); p1 = MFMA32(a[d0 % (PF + 1)][1], q[d0], p1);
        __builtin_amdgcn_sched_barrier(0);
    }
}
#ifdef PROBE_QKM2
template <int NDC, int KS> __device__ __forceinline__ void qk_tile_m2(f32x16& p0, f32x16& p1, f32x16& r0, f32x16& r1, const LAS unsigned char* kl, const bf16x8 (&q)[NDC]) {
#pragma unroll
    for (int i = 0; i < 16; ++i) { p0[i] = 0.f; p1[i] = 0.f; r0[i] = 0.f; r1[i] = 0.f; }
    constexpr int PF = QK_PF;
    bf16x8 a[PF + 1][2];
#pragma unroll
    for (int i = 0; i < PF; ++i) { a[i][0] = *(const LAS bf16x8*)(kl + i * 32); a[i][1] = *(const LAS bf16x8*)(kl + 32 * KS + i * 32); }
#pragma unroll
    for (int d0 = 0; d0 < NDC; ++d0) {
        if (d0 + PF < NDC) { a[(d0 + PF) % (PF + 1)][0] = *(const LAS bf16x8*)(kl + (d0 + PF) * 32); a[(d0 + PF) % (PF + 1)][1] = *(const LAS bf16x8*)(kl + 32 * KS + (d0 + PF) * 32); }
        __builtin_amdgcn_sched_barrier(0);
        p0 = MFMA32(a[d0 % (PF + 1)][0], q[d0], p0); p1 = MFMA32(a[d0 % (PF + 1)][1], q[d0], p1);
        r0 = MFMA32(a[d0 % (PF + 1)][0], q[d0], r0); r1 = MFMA32(a[d0 % (PF + 1)][1], q[d0], r1);
        __builtin_amdgcn_sched_barrier(0);
    }
}
#endif
__device__ __forceinline__ void pv_tile(f32x16 (&o)[4], const bf16x8 (&pb)[4], const LAS unsigned char* vl) {
    s16x4 f[5][2];
#define PV_LD(idx) do { constexpr int d_ = (idx) >> 2, s_ = (idx) & 3; \
        f[(idx) % 5][0] = __builtin_amdgcn_ds_read_tr16_b64_v4i16((LAS s16x4*)(vl + s_ * 16 * VS + d_ * 64)); \
        f[(idx) % 5][1] = __builtin_amdgcn_ds_read_tr16_b64_v4i16((LAS s16x4*)(vl + s_ * 16 * VS + 8 * VS + d_ * 64)); } while (0)
    PV_LD(0); PV_LD(1); PV_LD(2); PV_LD(3);
#define PV_STEP(idx) do { if ((idx) + 4 < 16) PV_LD((idx) + 4); __builtin_amdgcn_sched_barrier(0); \
        { const s16x4 t0_ = f[(idx) % 5][0], t1_ = f[(idx) % 5][1]; const bf16x8 vf_ = {t0_[0], t0_[1], t0_[2], t0_[3], t1_[0], t1_[1], t1_[2], t1_[3]}; \
          o[(idx) >> 2] = MFMA32(vf_, pb[(idx) & 3], o[(idx) >> 2]); } __builtin_amdgcn_sched_barrier(0); } while (0)
    PV_STEP(0); PV_STEP(1); PV_STEP(2); PV_STEP(3); PV_STEP(4); PV_STEP(5); PV_STEP(6); PV_STEP(7);
    PV_STEP(8); PV_STEP(9); PV_STEP(10); PV_STEP(11); PV_STEP(12); PV_STEP(13); PV_STEP(14); PV_STEP(15);
#undef PV_STEP
#undef PV_LD
}
template <int NDC, int NQR, int KS> __device__ __forceinline__ void qk_tile_free(f32x16& p0, f32x16& p1, const LAS unsigned char* kl, const bf16x8 (&q)[NQR], const LAS unsigned char* ql) {
#pragma unroll
    for (int i = 0; i < 16; ++i) { p0[i] = 0.f; p1[i] = 0.f; }
#pragma unroll
    for (int d0 = 0; d0 < NDC; ++d0) {
        const bf16x8 a0 = *(const LAS bf16x8*)(kl + d0 * 32);
        const bf16x8 a1 = *(const LAS bf16x8*)(kl + 32 * KS + d0 * 32);
        bf16x8 qq; if (d0 < NQR) qq = q[d0 < NQR ? d0 : 0]; else qq = *(const LAS bf16x8*)(ql + (d0 - NQR) * 1024);
        p0 = MFMA32(a0, qq, p0); p1 = MFMA32(a1, qq, p1);
    }
}
__device__ __forceinline__ float sm_core(f32x16& p0, f32x16& p1, float& m, float& l) {
    float tm = p0[0];
#pragma unroll
    for (int r = 1; r < 16; ++r) tm = fmaxf(tm, p0[r]);
#pragma unroll
    for (int r = 0; r < 16; ++r) tm = fmaxf(tm, p1[r]);
    tm = swapmax(tm);
    const float mn = fmaxf(m, tm);
    const float alpha = __builtin_amdgcn_exp2f(m - mn);
    m = mn;
    float ps = 0.f;
#pragma unroll
    for (int r = 0; r < 16; ++r) { p0[r] = __builtin_amdgcn_exp2f(p0[r] - mn); ps += p0[r]; }
#pragma unroll
    for (int r = 0; r < 16; ++r) { p1[r] = __builtin_amdgcn_exp2f(p1[r] - mn); ps += p1[r]; }
    ps = swapsum(ps);
    l = l * alpha + ps;
    return alpha;
}
__device__ __forceinline__ void online_sm(f32x16& p0, f32x16& p1, float& m, float& l, f32x16 (&o)[4]) {
    float tm = p0[0];
#pragma unroll
    for (int r = 1; r < 16; ++r) tm = fmaxf(tm, p0[r]);
#pragma unroll
    for (int r = 0; r < 16; ++r) tm = fmaxf(tm, p1[r]);
    tm = swapmax(tm);
    const float mn = fmaxf(m, tm);
    const float alpha = __builtin_amdgcn_exp2f(m - mn);
    m = mn;
    float ps = 0.f;
#pragma unroll
    for (int r = 0; r < 16; ++r) { p0[r] = __builtin_amdgcn_exp2f(p0[r] - mn); ps += p0[r]; }
#pragma unroll
    for (int r = 0; r < 16; ++r) { p1[r] = __builtin_amdgcn_exp2f(p1[r] - mn); ps += p1[r]; }
    ps = swapsum(ps);
    l = l * alpha + ps;
    if (!__all(alpha == 1.f)) {
#pragma unroll
        for (int d = 0; d < 4; ++d)
#pragma unroll
            for (int r = 0; r < 16; ++r) o[d][r] *= alpha;
    }
}

#ifdef MLA_FP8
typedef long i64;
constexpr int KS8 = 200, MLA_KB8 = 64 * KS8;
static_assert(2 * MLA_KB8 + 3 * VB <= 131072, "MLA fp8 LDS map");
#define MFMA32F8(a, b, c) __builtin_amdgcn_mfma_f32_32x32x16_fp8_fp8((a), (b), (c), 0, 0, 0)
template <int NDC> __device__ __forceinline__ void qk_tile8(f32x16& p0, f32x16& p1, const LAS unsigned char* kl, const i64 (&q)[NDC]) {
#pragma unroll
    for (int i = 0; i < 16; ++i) { p0[i] = 0.f; p1[i] = 0.f; }
    constexpr int PF = 4;
    i64 a[PF + 1][2];
#pragma unroll
    for (int i = 0; i < PF; ++i) { a[i][0] = *(const LAS i64*)(kl + i * 16); a[i][1] = *(const LAS i64*)(kl + 32 * KS8 + i * 16); }
#pragma unroll
    for (int d0 = 0; d0 < NDC; ++d0) {
        if (d0 + PF < NDC) { a[(d0 + PF) % (PF + 1)][0] = *(const LAS i64*)(kl + (d0 + PF) * 16); a[(d0 + PF) % (PF + 1)][1] = *(const LAS i64*)(kl + 32 * KS8 + (d0 + PF) * 16); }
        __builtin_amdgcn_sched_barrier(0);
        p0 = MFMA32F8(a[d0 % (PF + 1)][0], q[d0], p0); p1 = MFMA32F8(a[d0 % (PF + 1)][1], q[d0], p1);
        __builtin_amdgcn_sched_barrier(0);
    }
}
__device__ __forceinline__ void online_sm_scaled(f32x16& p0, f32x16& p1, float& m, float& l, f32x16 (&o)[4], const float C2) {
    float tm = p0[0];
#pragma unroll
    for (int r = 1; r < 16; ++r) tm = fmaxf(tm, p0[r]);
#pragma unroll
    for (int r = 0; r < 16; ++r) tm = fmaxf(tm, p1[r]);
    tm = swapmax(tm);
    const float mn = fmaxf(m, tm);
    const float alpha = __builtin_amdgcn_exp2f((m - mn) * C2);
    m = mn;
    const float mc = -mn * C2;
    float ps = 0.f;
#pragma unroll
    for (int r = 0; r < 16; ++r) { p0[r] = __builtin_amdgcn_exp2f(__builtin_fmaf(p0[r], C2, mc)); ps += p0[r]; }
#pragma unroll
    for (int r = 0; r < 16; ++r) { p1[r] = __builtin_amdgcn_exp2f(__builtin_fmaf(p1[r], C2, mc)); ps += p1[r]; }
    ps = swapsum(ps);
    l = l * alpha + ps;
    if (!__all(alpha == 1.f)) {
#pragma unroll
        for (int d = 0; d < 4; ++d)
#pragma unroll
            for (int r = 0; r < 16; ++r) o[d][r] *= alpha;
    }
}
#endif
#ifdef MLA_FP8V
constexpr int VS8 = 72, VB8 = 128 * VS8;
static_assert(2 * MLA_KB8 + 3 * VB8 <= 131072, "MLA fp8 LDS map");
template <int SIDX> __device__ __forceinline__ i64 packp8(const f32x16& p) {
    int w0 = __builtin_amdgcn_cvt_pk_fp8_f32(p[8 * SIDX + 0] * 256.f, p[8 * SIDX + 1] * 256.f, 0, false); w0 = __builtin_amdgcn_cvt_pk_fp8_f32(p[8 * SIDX + 2] * 256.f, p[8 * SIDX + 3] * 256.f, w0, true);
    int w1 = __builtin_amdgcn_cvt_pk_fp8_f32(p[8 * SIDX + 4] * 256.f, p[8 * SIDX + 5] * 256.f, 0, false); w1 = __builtin_amdgcn_cvt_pk_fp8_f32(p[8 * SIDX + 6] * 256.f, p[8 * SIDX + 7] * 256.f, w1, true);
    return (i64)(((unsigned long long)(unsigned)w1 << 32) | (unsigned)w0);
}
__device__ __forceinline__ void pv_tile8(f32x16 (&o)[4], const i64 (&pb)[4], const LAS unsigned char* vl) {
    i64 f[5];
#define PV8_LD(idx) f[(idx) % 5] = *(const LAS i64*)(vl + ((idx) >> 2) * 32 * VS8 + ((idx) & 3) * 16)
    PV8_LD(0); PV8_LD(1); PV8_LD(2); PV8_LD(3);
#define PV8_STEP(idx) do { if ((idx) + 4 < 16) PV8_LD((idx) + 4); __builtin_amdgcn_sched_barrier(0); \
        o[(idx) >> 2] = MFMA32F8(f[(idx) % 5], pb[(idx) & 3], o[(idx) >> 2]); __builtin_amdgcn_sched_barrier(0); } while (0)
    PV8_STEP(0); PV8_STEP(1); PV8_STEP(2); PV8_STEP(3); PV8_STEP(4); PV8_STEP(5); PV8_STEP(6); PV8_STEP(7);
    PV8_STEP(8); PV8_STEP(9); PV8_STEP(10); PV8_STEP(11); PV8_STEP(12); PV8_STEP(13); PV8_STEP(14); PV8_STEP(15);
#undef PV8_STEP
#undef PV8_LD
}
#endif
#ifdef MLA_PIPE
struct MlaPtrs { const bf16* Q; const bf16* K; const bf16* V; const bf16* Z; bf16* O; };
__device__ __forceinline__ void mla_mask(f32x16& p0, f32x16& p1, int dq) {
#pragma unroll
    for (int r = 0; r < 16; ++r) { const int c = (r & 3) + 8 * (r >> 2);
        if (c > dq) p0[r] = -__builtin_inff();
        if (c + 32 > dq) p1[r] = -__builtin_inff(); }
}
__device__ __forceinline__ void mla_unit(LAS unsigned char* lds, const MlaPtrs& P, int head, int qb, int tid_in, int wave, int lane_in) {
    int tid = tid_in; asm volatile("" : "+v"(tid)); const int lane = tid & 63; (void)lane_in;
    const int r32 = lane & 31, hi = lane >> 5;
    const int q0 = qb * 256, qw = q0 + wave * 32, tq = qw + r32;
    bf16x8 q[8];
    LAS unsigned char* ql = lds + MLA_QL + wave * 4096 + lane * 16;
    { const bf16* qp = P.Q + (size_t)tq * 3072 + head * 192 + hi * 8;
#pragma unroll
      for (int d0 = 0; d0 < 8; ++d0) q[d0] = *(const GAS bf16x8*)(qp + d0 * 16);
#pragma unroll
      for (int d0 = 8; d0 < 12; ++d0) *(LAS bf16x8*)(ql + (d0 - 8) * 1024) = *(const GAS bf16x8*)(qp + d0 * 16); }
    const int NT = 4 * (qb + 1);
    const int srow = tid >> 3, sc8 = tid & 7;
    const unsigned char* kg = (const unsigned char*)P.K + (size_t)head * 384 + (size_t)srow * 6144 + sc8 * 16;
    const unsigned char* vg = (const unsigned char*)P.V + (size_t)head * 256 + (size_t)srow * 4096 + sc8 * 16;
    LAS unsigned char* kst = lds + srow * KS_M + sc8 * 16;
    LAS unsigned char* vst = lds + 2 * MLA_KB + srow * VS + sc8 * 16;
    const LAS unsigned char* kl = lds + r32 * KS_M + hi * 16;
    const LAS unsigned char* vl = lds + 2 * MLA_KB + (4 * hi + ((lane & 15) >> 2)) * VS + (16 * ((lane >> 4) & 1) + 4 * (lane & 3)) * 2;
    u32x4 sk0, sk1, sk2, sv0, sv1;
#define MLA_LOADK(j) do { const unsigned char* kp_ = kg + (size_t)(j) * (64 * 6144); sk0 = *(const GAS u32x4*)(kp_); sk1 = *(const GAS u32x4*)(kp_ + 128); sk2 = *(const GAS u32x4*)(kp_ + 256); } while (0)
#define MLA_LOADV(j) do { const unsigned char* vp_ = vg + (size_t)(j) * (64 * 4096); sv0 = *(const GAS u32x4*)(vp_); sv1 = *(const GAS u32x4*)(vp_ + 128); } while (0)
#define MLA_STOREK(b) do { LAS unsigned char* kd_ = kst + (b) * MLA_KB; *(LAS u32x4*)(kd_) = sk0; *(LAS u32x4*)(kd_ + 128) = sk1; *(LAS u32x4*)(kd_ + 256) = sk2; } while (0)
#define MLA_STOREV(b) do { LAS unsigned char* vd_ = vst + (b) * VB; *(LAS u32x4*)(vd_) = sv0; *(LAS u32x4*)(vd_ + 128) = sv1; } while (0)
    float m = -1e30f, l = 0.f; f32x16 o[4];
#pragma unroll
    for (int d = 0; d < 4; ++d)
#pragma unroll
        for (int r = 0; r < 16; ++r) o[d][r] = 0.f;
    f32x16 pA0, pA1, pB0, pB1;
    MLA_LOADK(0); MLA_LOADV(0); MLA_STOREK(0); MLA_STOREV(0);
    MLA_LOADK(1);
    __syncthreads();
    qk_tile_free<12, 8, KS_M>(pA0, pA1, kl, q, ql);
    if (63 > qw) mla_mask(pA0, pA1, tq - 4 * hi);
    MLA_STOREK(1);
    if (2 < NT) MLA_LOADK(2);
    MLA_LOADV(1);
    __syncthreads();
#define MLA_SGB1(NR) do { __builtin_amdgcn_sched_group_barrier(0x100, NR, 0); __builtin_amdgcn_sched_group_barrier(0x008, 1, 0); __builtin_amdgcn_sched_group_barrier(0x002, 6, 0); \
        __builtin_amdgcn_sched_group_barrier(0x008, 1, 0); __builtin_amdgcn_sched_group_barrier(0x002, 6, 0); } while (0)
#define MLA_SGB() do { MLA_SGB1(2); MLA_SGB1(2); MLA_SGB1(2); MLA_SGB1(2); MLA_SGB1(2); MLA_SGB1(2); MLA_SGB1(2); MLA_SGB1(2); MLA_SGB1(3); MLA_SGB1(3); MLA_SGB1(3); MLA_SGB1(3); } while (0)
#define MLA_STEP(PX0, PX1, PY0, PY1, j) do { \
        const int kb1_ = 64 * ((j) + 1); \
        const bool a1_ = ((j) + 1 < NT) && (kb1_ <= qw + 31), a0_ = (64 * (j) <= qw + 31); \
        float alpha_ = 1.f; bf16x8 pb_[4]; \
        if (a1_) { \
            __builtin_amdgcn_sched_barrier(0); \
            qk_tile_free<12, 8, KS_M>(PY0, PY1, kl + (((j) + 1) & 1) * MLA_KB, q, ql); \
            alpha_ = sm_core(PX0, PX1, m, l); \
            pb_[0] = packp<0>(PX0); pb_[1] = packp<1>(PX0); pb_[2] = packp<0>(PX1); pb_[3] = packp<1>(PX1); \
            MLA_SGB(); \
            __builtin_amdgcn_sched_barrier(0); \
            if (kb1_ + 63 > qw) mla_mask(PY0, PY1, tq - kb1_ - 4 * hi); \
        } else if (a0_) { \
            alpha_ = sm_core(PX0, PX1, m, l); \
            pb_[0] = packp<0>(PX0); pb_[1] = packp<1>(PX0); pb_[2] = packp<0>(PX1); pb_[3] = packp<1>(PX1); \
        } \
        if (a0_) { \
            if (!__all(alpha_ == 1.f)) { _Pragma("unroll") for (int d_ = 0; d_ < 4; ++d_) _Pragma("unroll") for (int r_ = 0; r_ < 16; ++r_) o[d_][r_] *= alpha_; } \
            pv_tile(o, pb_, vl + ((j) & 1) * VB); \
        } \
        if ((j) + 2 < NT) MLA_STOREK((j) & 1); \
        if ((j) + 1 < NT) MLA_STOREV(((j) + 1) & 1); \
        if ((j) + 3 < NT) MLA_LOADK((j) + 3); \
        if ((j) + 2 < NT) MLA_LOADV((j) + 2); \
        __syncthreads(); } while (0)
    for (int j = 0; j < NT; j += 2) {
        MLA_STEP(pA0, pA1, pB0, pB1, j);
        MLA_STEP(pB0, pB1, pA0, pA1, j + 1);
    }
#undef MLA_STEP
#undef MLA_SGB
#undef MLA_SGB1
#undef MLA_LOADK
#undef MLA_LOADV
#undef MLA_STOREK
#undef MLA_STOREV
    const float inv = 1.f / l;
    const bf16* zp = P.Z + (size_t)tq * 2048 + head * 128 + 4 * hi;
    bf16* op = P.O + (size_t)tq * 4096 + head * 128 + 4 * hi;
#pragma unroll
    for (int d0 = 0; d0 < 4; ++d0)
#pragma unroll
        for (int rg = 0; rg < 4; ++rg) { const int dim = 32 * d0 + 8 * rg;
            const u32x2 z = *(const GAS u32x2*)(zp + dim);
            u32x2 w; w.x = pk2(o[d0][4 * rg + 0] * inv * bflo(z.x), o[d0][4 * rg + 1] * inv * bfhi(z.x)); w.y = pk2(o[d0][4 * rg + 2] * inv * bflo(z.y), o[d0][4 * rg + 3] * inv * bfhi(z.y));
            *(GAS u32x2*)(op + dim) = w; }
}

#else
#ifdef MLA_FP8V
struct MlaPtrs { const bf16* Q; const bf16* K; const bf16* V; const bf16* Z; bf16* O; };
__device__ __forceinline__ void mla_unit(LAS unsigned char* lds, const MlaPtrs& P, int head, int qb, int tid_in, int wave, int lane_in) {
    int tid = tid_in; asm volatile("" : "+v"(tid)); const int lane = tid & 63; (void)lane_in;
    const int r32 = lane & 31, hi = lane >> 5;
    const int q0 = qb * 256, qw = q0 + wave * 32, tq = qw + r32;
    i64 q[12];
    { const unsigned char* qp = (const unsigned char*)P.Q + (size_t)tq * 3072 + head * 192 + hi * 8;
#pragma unroll
      for (int d0 = 0; d0 < 12; ++d0) q[d0] = *(const GAS i64*)(qp + d0 * 16); }
    const int NT = 4 * (qb + 1);
    const int srow = tid >> 3, sc8 = tid & 7;
    const unsigned char* kg = (const unsigned char*)P.K + (size_t)head * 192 + (size_t)srow * 3072 + sc8 * 8;
    const unsigned char* vg = (const unsigned char*)P.V + ((size_t)head * 128 + (tid >> 2)) * S + (tid & 3) * 16;
    LAS unsigned char* kst = lds + srow * KS8 + sc8 * 8;
    LAS unsigned char* vst = lds + 2 * MLA_KB8 + (tid >> 2) * VS8 + (tid & 3) * 16;
    const LAS unsigned char* kl = lds + r32 * KS8 + hi * 8;
    const LAS unsigned char* vl = lds + 2 * MLA_KB8 + r32 * VS8 + hi * 8;
    u32x2 sk0, sk1, sk2; u32x4 sv0;
#define MLA_LOAD(j) do { const unsigned char* kp_ = kg + (size_t)(j) * (64 * 3072); const unsigned char* vp_ = vg + (size_t)(j) * 64; \
        sk0 = *(const GAS u32x2*)(kp_); sk1 = *(const GAS u32x2*)(kp_ + 64); sk2 = *(const GAS u32x2*)(kp_ + 128); sv0 = *(const GAS u32x4*)(vp_); } while (0)
#define MLA_STORE(b, vb) do { LAS unsigned char* kd_ = kst + (b) * MLA_KB8; LAS unsigned char* vd_ = vst + (vb) * VB8; \
        *(LAS u32x2*)(kd_) = sk0; *(LAS u32x2*)(kd_ + 64) = sk1; *(LAS u32x2*)(kd_ + 128) = sk2; *(LAS u32x2*)(vd_) = (u32x2){sv0.x, sv0.y}; *(LAS u32x2*)(vd_ + 8) = (u32x2){sv0.z, sv0.w}; } while (0)
    MLA_LOAD(0); MLA_STORE(0, 0);
    __syncthreads();
    float m = -1e30f, l = 0.f; f32x16 o[4];
#pragma unroll
    for (int d = 0; d < 4; ++d)
#pragma unroll
        for (int r = 0; r < 16; ++r) o[d][r] = 0.f;
    const bool trail = wave >= 4;
    i64 pb[4] = {};
    int vb_cur = 0, vb_prev = 2;
    for (int j = 0; j < NT; ++j) {
        const int kb = 64 * j;
        int vb_next = vb_cur + 1; if (vb_next == 3) vb_next = 0;
        if (j + 1 < NT) MLA_LOAD(j + 1);
        if (trail && j > 0 && kb - 64 <= qw + 31) pv_tile8(o, pb, vl + vb_prev * VB8);
        if (kb <= qw + 31) {
            f32x16 p0, p1;
#ifdef PROBE_QKM2
            { f32x16 r0, r1; qk_tile_m2<12, KS_M>(p0, p1, r0, r1, kl + (j & 1) * MLA_KB, q);
#pragma unroll
              for (int r = 0; r < 16; ++r) { p0[r] = (p0[r] + r0[r]) * 0.5f; p1[r] = (p1[r] + r1[r]) * 0.5f; } }
#else
            qk_tile8<12>(p0, p1, kl + (j & 1) * MLA_KB8, q);
#endif
#ifdef PROBE_QK2
            { f32x16 r0, r1; asm volatile("" ::: "memory"); qk_tile<12, KS_M>(r0, r1, kl + (j & 1) * MLA_KB, q);
#pragma unroll
              for (int r = 0; r < 16; ++r) { p0[r] = (p0[r] + r0[r]) * 0.5f; p1[r] = (p1[r] + r1[r]) * 0.5f; } }
#endif
#ifdef PROBE_SM2
            { float acc_ = 0.f;
#pragma unroll
              for (int r = 0; r < 16; ++r) { acc_ += __builtin_amdgcn_exp2f(p0[r] - m - 40.f) + __builtin_amdgcn_exp2f(p1[r] - m - 40.f); }
#pragma unroll
              for (int r = 0; r < 16; ++r) { acc_ += __builtin_amdgcn_exp2f(p0[r] - m - 50.f) + __builtin_amdgcn_exp2f(p1[r] - m - 50.f); }
              if (acc_ == 12345.678f) l += 1.f; }
#endif
            if (kb + 63 > qw) {
                const int dq = tq - kb - 4 * hi;
#pragma unroll
                for (int r = 0; r < 16; ++r) { const int c = (r & 3) + 8 * (r >> 2);
                    if (c > dq) p0[r] = -__builtin_inff();
                    if (c + 32 > dq) p1[r] = -__builtin_inff(); }
            }
            online_sm_scaled(p0, p1, m, l, o, QS_MLA);
            pb[0] = packp8<0>(p0); pb[1] = packp8<1>(p0); pb[2] = packp8<0>(p1); pb[3] = packp8<1>(p1);
            if (!trail) pv_tile8(o, pb, vl + vb_cur * VB8);
        }
        if (j + 1 < NT) MLA_STORE((j + 1) & 1, vb_next);
        __syncthreads();
        vb_prev = vb_cur; vb_cur = vb_next;
    }
    if (trail && 64 * (NT - 1) <= qw + 31) pv_tile8(o, pb, vl + vb_prev * VB8);
    __syncthreads();
#undef MLA_LOAD
#undef MLA_STORE
    const float inv = (1.f / 256.f) / l;
    const bf16* zp = P.Z + (size_t)tq * 2048 + head * 128 + 4 * hi;
    bf16* op = P.O + (size_t)tq * 4096 + head * 128 + 4 * hi;
#pragma unroll
    for (int d0 = 0; d0 < 4; ++d0)
#pragma unroll
        for (int rg = 0; rg < 4; ++rg) { const int dim = 32 * d0 + 8 * rg;
            const u32x2 z = *(const GAS u32x2*)(zp + dim);
            u32x2 w; w.x = pk2(o[d0][4 * rg + 0] * inv * bflo(z.x), o[d0][4 * rg + 1] * inv * bfhi(z.x)); w.y = pk2(o[d0][4 * rg + 2] * inv * bflo(z.y), o[d0][4 * rg + 3] * inv * bfhi(z.y));
            *(GAS u32x2*)(op + dim) = w; }
}

#elif defined(MLA_FP8)
struct MlaPtrs { const bf16* Q; const bf16* K; const bf16* V; const bf16* Z; bf16* O; };
__device__ __forceinline__ void mla_unit(LAS unsigned char* lds, const MlaPtrs& P, int head, int qb, int tid_in, int wave, int lane_in) {
    int tid = tid_in; asm volatile("" : "+v"(tid)); const int lane = tid & 63; (void)lane_in;
    const int r32 = lane & 31, hi = lane >> 5;
    const int q0 = qb * 256, qw = q0 + wave * 32, tq = qw + r32;
    i64 q[12];
    { const unsigned char* qp = (const unsigned char*)P.Q + (size_t)tq * 3072 + head * 192 + hi * 8;
#pragma unroll
      for (int d0 = 0; d0 < 12; ++d0) q[d0] = *(const GAS i64*)(qp + d0 * 16); }
    const int NT = 4 * (qb + 1);
    const int srow = tid >> 3, sc8 = tid & 7;
    const unsigned char* kg = (const unsigned char*)P.K + (size_t)head * 192 + (size_t)srow * 3072 + sc8 * 8;
    const unsigned char* vg = (const unsigned char*)P.V + (size_t)head * 256 + (size_t)srow * 4096 + sc8 * 16;
    LAS unsigned char* kst = lds + srow * KS8 + sc8 * 8;
    LAS unsigned char* vst = lds + 2 * MLA_KB8 + srow * VS + sc8 * 16;
    const LAS unsigned char* kl = lds + r32 * KS8 + hi * 8;
    const LAS unsigned char* vl = lds + 2 * MLA_KB8 + (4 * hi + ((lane & 15) >> 2)) * VS + (16 * ((lane >> 4) & 1) + 4 * (lane & 3)) * 2;
    u32x2 sk0, sk1, sk2; u32x4 sv0, sv1;
#define MLA_LOAD(j) do { const unsigned char* kp_ = kg + (size_t)(j) * (64 * 3072); const unsigned char* vp_ = vg + (size_t)(j) * (64 * 4096); \
        sk0 = *(const GAS u32x2*)(kp_); sk1 = *(const GAS u32x2*)(kp_ + 64); sk2 = *(const GAS u32x2*)(kp_ + 128); sv0 = *(const GAS u32x4*)(vp_); sv1 = *(const GAS u32x4*)(vp_ + 128); } while (0)
#define MLA_STORE(b, vb) do { LAS unsigned char* kd_ = kst + (b) * MLA_KB8; LAS unsigned char* vd_ = vst + (vb) * VB; \
        *(LAS u32x2*)(kd_) = sk0; *(LAS u32x2*)(kd_ + 64) = sk1; *(LAS u32x2*)(kd_ + 128) = sk2; *(LAS u32x4*)(vd_) = sv0; *(LAS u32x4*)(vd_ + 128) = sv1; } while (0)
    MLA_LOAD(0); MLA_STORE(0, 0);
    __syncthreads();
    float m = -1e30f, l = 0.f; f32x16 o[4];
#pragma unroll
    for (int d = 0; d < 4; ++d)
#pragma unroll
        for (int r = 0; r < 16; ++r) o[d][r] = 0.f;
    const bool trail = wave >= 4;
    bf16x8 pb[4] = {};
    int vb_cur = 0, vb_prev = 2;
    for (int j = 0; j < NT; ++j) {
        const int kb = 64 * j;
        int vb_next = vb_cur + 1; if (vb_next == 3) vb_next = 0;
        if (j + 1 < NT) MLA_LOAD(j + 1);
        if (trail && j > 0 && kb - 64 <= qw + 31) pv_tile(o, pb, vl + vb_prev * VB);
        if (kb <= qw + 31) {
            f32x16 p0, p1;
#ifdef PROBE_QKM2
            { f32x16 r0, r1; qk_tile_m2<12, KS_M>(p0, p1, r0, r1, kl + (j & 1) * MLA_KB, q);
#pragma unroll
              for (int r = 0; r < 16; ++r) { p0[r] = (p0[r] + r0[r]) * 0.5f; p1[r] = (p1[r] + r1[r]) * 0.5f; } }
#else
            qk_tile8<12>(p0, p1, kl + (j & 1) * MLA_KB8, q);
#endif
#ifdef PROBE_QK2
            { f32x16 r0, r1; asm volatile("" ::: "memory"); qk_tile<12, KS_M>(r0, r1, kl + (j & 1) * MLA_KB, q);
#pragma unroll
              for (int r = 0; r < 16; ++r) { p0[r] = (p0[r] + r0[r]) * 0.5f; p1[r] = (p1[r] + r1[r]) * 0.5f; } }
#endif
#ifdef PROBE_SM2
            { float acc_ = 0.f;
#pragma unroll
              for (int r = 0; r < 16; ++r) { acc_ += __builtin_amdgcn_exp2f(p0[r] - m - 40.f) + __builtin_amdgcn_exp2f(p1[r] - m - 40.f); }
#pragma unroll
              for (int r = 0; r < 16; ++r) { acc_ += __builtin_amdgcn_exp2f(p0[r] - m - 50.f) + __builtin_amdgcn_exp2f(p1[r] - m - 50.f); }
              if (acc_ == 12345.678f) l += 1.f; }
#endif
            if (kb + 63 > qw) {
                const int dq = tq - kb - 4 * hi;
#pragma unroll
                for (int r = 0; r < 16; ++r) { const int c = (r & 3) + 8 * (r >> 2);
                    if (c > dq) p0[r] = -__builtin_inff();
                    if (c + 32 > dq) p1[r] = -__builtin_inff(); }
            }
            online_sm_scaled(p0, p1, m, l, o, QS_MLA);
            pb[0] = packp<0>(p0); pb[1] = packp<1>(p0); pb[2] = packp<0>(p1); pb[3] = packp<1>(p1);
            if (!trail) pv_tile(o, pb, vl + vb_cur * VB);
        }
        if (j + 1 < NT) MLA_STORE((j + 1) & 1, vb_next);
        __syncthreads();
        vb_prev = vb_cur; vb_cur = vb_next;
    }
    if (trail && 64 * (NT - 1) <= qw + 31) pv_tile(o, pb, vl + vb_prev * VB);
    __syncthreads();
#undef MLA_LOAD
#undef MLA_STORE
    const float inv = 1.f / l;
    const bf16* zp = P.Z + (size_t)tq * 2048 + head * 128 + 4 * hi;
    bf16* op = P.O + (size_t)tq * 4096 + head * 128 + 4 * hi;
#pragma unroll
    for (int d0 = 0; d0 < 4; ++d0)
#pragma unroll
        for (int rg = 0; rg < 4; ++rg) { const int dim = 32 * d0 + 8 * rg;
            const u32x2 z = *(const GAS u32x2*)(zp + dim);
            u32x2 w; w.x = pk2(o[d0][4 * rg + 0] * inv * bflo(z.x), o[d0][4 * rg + 1] * inv * bfhi(z.x)); w.y = pk2(o[d0][4 * rg + 2] * inv * bflo(z.y), o[d0][4 * rg + 3] * inv * bfhi(z.y));
            *(GAS u32x2*)(op + dim) = w; }
}

#else
struct MlaPtrs { const bf16* Q; const bf16* K; const bf16* V; const bf16* Z; bf16* O; };
__device__ __forceinline__ void mla_unit(LAS unsigned char* lds, const MlaPtrs& P, int head, int qb, int tid_in, int wave, int lane_in) {
    int tid = tid_in; asm volatile("" : "+v"(tid)); const int lane = tid & 63; (void)lane_in;
    const int r32 = lane & 31, hi = lane >> 5;
    const int q0 = qb * 256, qw = q0 + wave * 32, tq = qw + r32;
    bf16x8 q[12];
    { const bf16* qp = P.Q + (size_t)tq * 3072 + head * 192 + hi * 8;
#pragma unroll
      for (int d0 = 0; d0 < 12; ++d0) q[d0] = *(const GAS bf16x8*)(qp + d0 * 16); }
    const int NT = 4 * (qb + 1);
    const int srow = tid >> 3, sc8 = tid & 7;
    const unsigned char* kg = (const unsigned char*)P.K + (size_t)head * 384 + (size_t)srow * 6144 + sc8 * 16;
    const unsigned char* vg = (const unsigned char*)P.V + (size_t)head * 256 + (size_t)srow * 4096 + sc8 * 16;
    LAS unsigned char* kst = lds + srow * KS_M + sc8 * 16;
    LAS unsigned char* vst = lds + 2 * MLA_KB + srow * VS + sc8 * 16;
    const LAS unsigned char* kl = lds + r32 * KS_M + hi * 16;
    const LAS unsigned char* vl = lds + 2 * MLA_KB + (4 * hi + ((lane & 15) >> 2)) * VS + (16 * ((lane >> 4) & 1) + 4 * (lane & 3)) * 2;
    u32x4 sk0, sk1, sk2, sv0, sv1;
#define MLA_LOAD(j) do { const unsigned char* kp_ = kg + (size_t)(j) * (64 * 6144); const unsigned char* vp_ = vg + (size_t)(j) * (64 * 4096); \
        sk0 = *(const GAS u32x4*)(kp_); sk1 = *(const GAS u32x4*)(kp_ + 128); sk2 = *(const GAS u32x4*)(kp_ + 256); sv0 = *(const GAS u32x4*)(vp_); sv1 = *(const GAS u32x4*)(vp_ + 128); } while (0)
#define MLA_STORE(b, vb) do { LAS unsigned char* kd_ = kst + (b) * MLA_KB; LAS unsigned char* vd_ = vst + (vb) * VB; \
        *(LAS u32x4*)(kd_) = sk0; *(LAS u32x4*)(kd_ + 128) = sk1; *(LAS u32x4*)(kd_ + 256) = sk2; *(LAS u32x4*)(vd_) = sv0; *(LAS u32x4*)(vd_ + 128) = sv1; } while (0)
    MLA_LOAD(0); MLA_STORE(0, 0);
    __syncthreads();
    float m = -1e30f, l = 0.f; f32x16 o[4];
#pragma unroll
    for (int d = 0; d < 4; ++d)
#pragma unroll
        for (int r = 0; r < 16; ++r) o[d][r] = 0.f;
    const bool trail = wave >= 4;
    bf16x8 pb[4] = {};
    int vb_cur = 0, vb_prev = 2;
    for (int j = 0; j < NT; ++j) {
        const int kb = 64 * j;
        int vb_next = vb_cur + 1; if (vb_next == 3) vb_next = 0;
        if (j + 1 < NT) MLA_LOAD(j + 1);
        if (trail && j > 0 && kb - 64 <= qw + 31) pv_tile(o, pb, vl + vb_prev * VB);
        if (kb <= qw + 31) {
            f32x16 p0, p1;
#ifdef PROBE_QKM2
            { f32x16 r0, r1; qk_tile_m2<12, KS_M>(p0, p1, r0, r1, kl + (j & 1) * MLA_KB, q);
#pragma unroll
              for (int r = 0; r < 16; ++r) { p0[r] = (p0[r] + r0[r]) * 0.5f; p1[r] = (p1[r] + r1[r]) * 0.5f; } }
#else
            qk_tile<12, KS_M>(p0, p1, kl + (j & 1) * MLA_KB, q);
#endif
#ifdef PROBE_QK2
            { f32x16 r0, r1; asm volatile("" ::: "memory"); qk_tile<12, KS_M>(r0, r1, kl + (j & 1) * MLA_KB, q);
#pragma unroll
              for (int r = 0; r < 16; ++r) { p0[r] = (p0[r] + r0[r]) * 0.5f; p1[r] = (p1[r] + r1[r]) * 0.5f; } }
#endif
#ifdef PROBE_SM2
            { float acc_ = 0.f;
#pragma unroll
              for (int r = 0; r < 16; ++r) { acc_ += __builtin_amdgcn_exp2f(p0[r] - m - 40.f) + __builtin_amdgcn_exp2f(p1[r] - m - 40.f); }
#pragma unroll
              for (int r = 0; r < 16; ++r) { acc_ += __builtin_amdgcn_exp2f(p0[r] - m - 50.f) + __builtin_amdgcn_exp2f(p1[r] - m - 50.f); }
              if (acc_ == 12345.678f) l += 1.f; }
#endif
            if (kb + 63 > qw) {
                const int dq = tq - kb - 4 * hi;
#pragma unroll
                for (int r = 0; r < 16; ++r) { const int c = (r & 3) + 8 * (r >> 2);
                    if (c > dq) p0[r] = -__builtin_inff();
                    if (c + 32 > dq) p1[r] = -__builtin_inff(); }
            }
            online_sm(p0, p1, m, l, o);
            pb[0] = packp<0>(p0); pb[1] = packp<1>(p0); pb[2] = packp<0>(p1); pb[3] = packp<1>(p1);
            if (!trail) pv_tile(o, pb, vl + vb_cur * VB);
        }
        if (j + 1 < NT) MLA_STORE((j + 1) & 1, vb_next);
        __syncthreads();
        vb_prev = vb_cur; vb_cur = vb_next;
    }
    if (trail && 64 * (NT - 1) <= qw + 31) pv_tile(o, pb, vl + vb_prev * VB);
    __syncthreads();
#undef MLA_LOAD
#undef MLA_STORE
    const float inv = 1.f / l;
    const bf16* zp = P.Z + (size_t)tq * 2048 + head * 128 + 4 * hi;
    bf16* op = P.O + (size_t)tq * 4096 + head * 128 + 4 * hi;
#pragma unroll
    for (int d0 = 0; d0 < 4; ++d0)
#pragma unroll
        for (int rg = 0; rg < 4; ++rg) { const int dim = 32 * d0 + 8 * rg;
            const u32x2 z = *(const GAS u32x2*)(zp + dim);
            u32x2 w; w.x = pk2(o[d0][4 * rg + 0] * inv * bflo(z.x), o[d0][4 * rg + 1] * inv * bfhi(z.x)); w.y = pk2(o[d0][4 * rg + 2] * inv * bflo(z.y), o[d0][4 * rg + 3] * inv * bfhi(z.y));
            *(GAS u32x2*)(op + dim) = w; }
}

#endif
#endif
struct NsaPtrs { const bf16* Q; const bf16* KV; const bf16* KC; const bf16* VC; const bf16* Z; const float* G; bf16* O; float* scr; };
template <int MODE>
__device__ __forceinline__ void nsa_loop(LAS unsigned char* lds, const unsigned char* kbase, const unsigned char* vbase, int ntiles, int jlo,
                                         const bf16x8 (&q)[8], int t, float slope2, float& m, float& l, f32x16 (&o)[4], float invl, int tid, int wave, int lane) {
    constexpr bool HASV = MODE != 0;
    const int r32 = lane & 31, hi = lane >> 5;
    const int srow = tid >> 3, sc8 = tid & 7;
    const unsigned soff = srow * 256 + sc8 * 16;
    LAS unsigned char* kst = lds + srow * KS_N + sc8 * 16;
    LAS unsigned char* vst = lds + 2 * NSA_KB + srow * VS + sc8 * 16;
    const LAS unsigned char* kl = lds + r32 * KS_N + hi * 16;
    const LAS unsigned char* vl = lds + 2 * NSA_KB + (4 * hi + ((lane & 15) >> 2)) * VS + (16 * ((lane >> 4) & 1) + 4 * (lane & 3)) * 2;
    const LAS int* ulist = (const LAS int*)(lds + N_ULIST);
    const LAS unsigned* selm = (const LAS unsigned*)(lds + N_SELM);
    LAS float* partA = (LAS float*)(lds + N_PART); LAS float* partB = (LAS float*)(lds + N_PART + N_PARTB);
    LAS float* imp = (LAS float*)(lds + N_IMP); LAS float* carry = (LAS float*)(lds + N_CARRY);
    if (ntiles <= 0) return;
    u32x4 sk0, sk1, sv0, sv1;
#define NSA_TROW(j) (MODE == 2 ? 64 * __builtin_amdgcn_readfirstlane(ulist[(j)]) : 64 * (jlo + (j)))
#define NSA_LOAD(j) do { const size_t ro_ = (size_t)NSA_TROW(j) * 256 + soff; \
        sk0 = *(const GAS u32x4*)(kbase + ro_); sk1 = *(const GAS u32x4*)(kbase + ro_ + 128); \
        if (HASV) { sv0 = *(const GAS u32x4*)(vbase + ro_); sv1 = *(const GAS u32x4*)(vbase + ro_ + 128); } } while (0)
#define NSA_STORE(b) do { LAS unsigned char* kd_ = kst + (b) * NSA_KB; *(LAS u32x4*)(kd_) = sk0; *(LAS u32x4*)(kd_ + 128) = sk1; \
        if (HASV) { LAS unsigned char* vd_ = vst + (b) * VB; *(LAS u32x4*)(vd_) = sv0; *(LAS u32x4*)(vd_ + 128) = sv1; } } while (0)
    NSA_LOAD(0); NSA_STORE(0);
    __syncthreads();
    for (int j = 0; j < ntiles; ++j) {
        const int buf = j & 1;
        if (MODE != 1 && j + 1 < ntiles) NSA_LOAD(j + 1);
        const int trow = NSA_TROW(j);
        constexpr int PSTEP = (MODE <= 1) ? 16 : 1;
        const int pstart = (MODE <= 1) ? 16 * trow + 31 : trow;
        const int db = t - pstart - PSTEP * 4 * hi;
        constexpr unsigned W = (MODE == 3) ? 512u : 0x7fffffffu;
        float b0 = -slope2 * (float)db;
        if (MODE == 2) { const int b = trow >> 6; if (((selm[r32 * 8 + (b >> 5)] >> (b & 31)) & 1u) == 0u) b0 = -__builtin_inff(); }
        f32x16 p0, p1;
#pragma unroll
        for (int r = 0; r < 16; ++r) { const int c = PSTEP * ((r & 3) + 8 * (r >> 2));
            p0[r] = __builtin_fmaf(slope2, (float)c, b0); p1[r] = __builtin_fmaf(slope2, (float)(c + 32 * PSTEP), b0); }
        qk_tile<8, KS_N, false>(p0, p1, kl + buf * NSA_KB, q);
        { const int t0u = __builtin_amdgcn_readfirstlane(t - r32);
          const bool interior = (t0u - (pstart + PSTEP * 63) >= 0) && ((unsigned)(t0u + 31 - pstart) < W);
          if (!interior) {
#pragma unroll
              for (int r = 0; r < 16; ++r) { const int c = PSTEP * ((r & 3) + 8 * (r >> 2));
                  if ((unsigned)(db - c) >= W) p0[r] = -__builtin_inff();
                  if ((unsigned)(db - c - 32 * PSTEP) >= W) p1[r] = -__builtin_inff(); } } }
        if (MODE == 0) {
            float tm = p0[0];
#pragma unroll
            for (int r = 1; r < 16; ++r) tm = fmaxf(tm, p0[r]);
#pragma unroll
            for (int r = 0; r < 16; ++r) tm = fmaxf(tm, p1[r]);
            tm = swapmax(tm);
            const float mn = fmaxf(m, tm); const float alpha = __builtin_amdgcn_exp2f(m - mn); m = mn;
            float ps = 0.f;
#pragma unroll
            for (int r = 0; r < 16; ++r) ps += __builtin_amdgcn_exp2f(p0[r] - mn) + __builtin_amdgcn_exp2f(p1[r] - mn);
            l = l * alpha + swapsum(ps);
        } else if (MODE == 1) {
#pragma unroll
            for (int r = 0; r < 16; ++r) { p0[r] = __builtin_amdgcn_exp2f(p0[r] - m) * invl; p1[r] = __builtin_amdgcn_exp2f(p1[r] - m) * invl; }
            LAS float* pa = partA + (wave * 32 + r32) * 17 + hi; LAS float* pbm = partB + (wave * 32 + r32) * 17 + hi;
#pragma unroll
            for (int rg = 0; rg < 4; ++rg) {
                pa[2 * rg] = (p0[4 * rg] + p0[4 * rg + 1]) + (p0[4 * rg + 2] + p0[4 * rg + 3]); pbm[2 * rg] = p0[4 * rg + 3];
                pa[8 + 2 * rg] = (p1[4 * rg] + p1[4 * rg + 1]) + (p1[4 * rg + 2] + p1[4 * rg + 3]); pbm[8 + 2 * rg] = p1[4 * rg + 3]; }
            const bf16x8 pb[4] = {packp<0>(p0), packp<1>(p0), packp<0>(p1), packp<1>(p1)};
            pv_tile(o, pb, vl + buf * VB);
            __syncthreads();
            { const int qq = tid >> 4, jl = tid & 15; float a = 0.f, bp = 0.f, bl = 0.f;
#pragma unroll
              for (int w = 0; w < 8; ++w) { a += partA[(w * 32 + qq) * 17 + jl]; bl += partB[(w * 32 + qq) * 17 + jl]; }
              if (jl > 0) {
#pragma unroll
                  for (int w = 0; w < 8; ++w) bp += partB[(w * 32 + qq) * 17 + jl - 1];
              } else bp = (j > 0) ? carry[((j - 1) & 1) * 32 + qq] : 0.f;
              imp[qq * 256 + 16 * j + jl] = a + bp;
              if (jl == 15) carry[(j & 1) * 32 + qq] = bl; }
        } else {
            online_sm(p0, p1, m, l, o);
            const bf16x8 pb[4] = {packp<0>(p0), packp<1>(p0), packp<0>(p1), packp<1>(p1)};
            pv_tile(o, pb, vl + buf * VB);
        }
        if (MODE == 1 && j + 1 < ntiles) NSA_LOAD(j + 1);
        if (j + 1 < ntiles) NSA_STORE(buf ^ 1);
        __syncthreads();
    }
#undef NSA_TROW
#undef NSA_LOAD
#undef NSA_STORE
}
__device__ __forceinline__ void nsa_topk(const LAS float* improw, LAS unsigned* selrow, int cur, int lane) {
    unsigned key[4]; bool sel[4];
    int nforced = 0;
#pragma unroll
    for (int k = 0; k < 4; ++k) { const int j = lane + 64 * k;
        const bool forced = (j == 0) || (j == cur) || (j == cur - 1);
        const bool causal = j <= cur;
        sel[k] = forced;
#ifdef IMPNOISE_BUILD
        { unsigned h = (unsigned)j * 2654435761u + (unsigned)(size_t)improw * 40503u; h ^= h >> 15; h *= 0x846ca68bu; h ^= h >> 16;
          const float r = (float)(int)(h & 0xffffu) * (1.f / 32768.f) - 1.f; const float v = improw[j] * (1.f + IMPNOISE_EPS * r);
          key[k] = (causal && !forced) ? (__float_as_uint(v) + 1u) : 0u; }
#else
        key[k] = (causal && !forced) ? (__float_as_uint(improw[j]) + 1u) : 0u;
#endif
    }
    nforced = 1 + (cur >= 1 ? 1 : 0) + (cur >= 2 ? 1 : 0);
    const int want = 16 - nforced;
    for (int it = 0; it < want; ++it) {
        unsigned bk = key[0]; int bj = lane;
#pragma unroll
        for (int k = 1; k < 4; ++k) { if (key[k] > bk) { bk = key[k]; bj = lane + 64 * k; } }
        unsigned long long best = ((unsigned long long)bk << 32) | (unsigned)(0xffffffffu - (unsigned)bj);
#pragma unroll
        for (int off = 1; off < 64; off <<= 1) {
            const unsigned lo = __shfl_xor((unsigned)best, off), hiw = __shfl_xor((unsigned)(best >> 32), off);
            const unsigned long long other = ((unsigned long long)hiw << 32) | lo;
            best = other > best ? other : best; }
        if ((unsigned)(best >> 32) == 0u) break;
        const int wj = (int)(0xffffffffu - (unsigned)best);
#pragma unroll
        for (int k = 0; k < 4; ++k) if (wj == lane + 64 * k) { key[k] = 0u; sel[k] = true; }
    }
#pragma unroll
    for (int k = 0; k < 4; ++k) { const unsigned long long bm = __ballot(sel[k]);
        if (lane == 0) { selrow[2 * k] = (unsigned)bm; selrow[2 * k + 1] = (unsigned)(bm >> 32); } }
}
__device__ __forceinline__ int nsa_opaque(int v) { asm volatile("" : "+v"(v)); return v; }
__device__ __forceinline__ void nsa_unit(LAS unsigned char* lds, const NsaPtrs& P, int g, int qblk, int tid_in, int wave, int lane_in, int cu) {
    int tid = tid_in; asm volatile("" : "+v"(tid));
    const int lane = tid & 63; (void)lane_in;
    const int r32 = lane & 31, hi = lane >> 5;
    const int hh = 8 * g + wave, t0 = 32 * qblk, t = t0 + r32;
    const float slope2 = __builtin_amdgcn_exp2f(-0.5f * (float)(hh + 1)) * LOG2E;
    bf16x8 q[8];
    { const bf16* qp = P.Q + (size_t)t * 2048 + hh * 128 + hi * 8;
#pragma unroll
      for (int d0 = 0; d0 < 8; ++d0) q[d0] = *(const GAS bf16x8*)(qp + d0 * 16); }
#define NSA_SCR() ((GAS f32x4*)(P.scr + ((size_t)(cu * 8 + wave) * 16) * 256) + nsa_opaque(lane))
    const size_t CH = (size_t)S * 128 * 2;
    f32x16 o[4]; float m, l;
#define NSA_ZERO_O() do { _Pragma("unroll") for (int d_ = 0; d_ < 4; ++d_) _Pragma("unroll") for (int r_ = 0; r_ < 16; ++r_) o[d_][r_] = 0.f; } while (0)
    const int ncv = 2 * qblk + 1, ntc = (ncv + 63) >> 6;
    const unsigned char* kc = (const unsigned char*)P.KC + (size_t)g * 1024 * 256; const unsigned char* vc = (const unsigned char*)P.VC + (size_t)g * 1024 * 256;
    m = -1e30f; l = 0.f; NSA_ZERO_O();
    nsa_loop<0>(lds, kc, vc, ntc, 0, q, t, slope2, m, l, o, 0.f, tid, wave, lane);
    const float invl = l > 0.f ? 1.f / l : 0.f;
    nsa_loop<1>(lds, kc, vc, ntc, 0, q, t, slope2, m, l, o, invl, tid, wave, lane);
    { const float g_c = P.G[(size_t)t * 48 + hh]; GAS f32x4* scr = NSA_SCR();
#pragma unroll
    for (int d0 = 0; d0 < 4; ++d0)
#pragma unroll
        for (int rg = 0; rg < 4; ++rg) { f32x4 v = {o[d0][4 * rg] * g_c, o[d0][4 * rg + 1] * g_c, o[d0][4 * rg + 2] * g_c, o[d0][4 * rg + 3] * g_c}; scr[(d0 * 4 + rg) * 64] = v; } }
    const int cur = t0 >> 6;
    LAS unsigned* selm = (LAS unsigned*)(lds + N_SELM);
    for (int i = 0; i < 4; ++i) { const int qq = 4 * wave + i; nsa_topk((const LAS float*)(lds + N_IMP) + qq * 256, selm + qq * 8, cur, lane); }
    __syncthreads();
    if (wave == 0) {
        LAS int* ulist = (LAS int*)(lds + N_ULIST); int n = 0;
        for (int k = 0; k < 8; ++k) { unsigned u = (lane < 32) ? selm[lane * 8 + k] : 0u;
#pragma unroll
            for (int off = 1; off < 32; off <<= 1) u |= __shfl_xor(u, off);
            u = __builtin_amdgcn_readfirstlane(u);
            while (u) { const int b = __builtin_ctz(u); u &= u - 1u; if (lane == 0) ulist[n] = 32 * k + b; ++n; } }
        if (lane == 0) *(LAS int*)(lds + N_NTS) = n;
    }
    __syncthreads();
    const int nts = __builtin_amdgcn_readfirstlane(*(const LAS int*)(lds + N_NTS));
    m = -1e30f; l = 0.f; NSA_ZERO_O();
    nsa_loop<2>(lds, (const unsigned char*)P.KV + (size_t)(4 + g) * CH, (const unsigned char*)P.KV + (size_t)(6 + g) * CH, nts, 0, q, t, slope2, m, l, o, 0.f, tid, wave, lane);
    { const float f = P.G[(size_t)t * 48 + 16 + hh] / l; GAS f32x4* scr = NSA_SCR();
#pragma unroll
      for (int d0 = 0; d0 < 4; ++d0)
#pragma unroll
          for (int rg = 0; rg < 4; ++rg) { f32x4 v = scr[(d0 * 4 + rg) * 64]; v[0] += o[d0][4 * rg] * f; v[1] += o[d0][4 * rg + 1] * f; v[2] += o[d0][4 * rg + 2] * f; v[3] += o[d0][4 * rg + 3] * f; scr[(d0 * 4 + rg) * 64] = v; } }
    const int jlo = (t0 > 511 ? t0 - 511 : 0) >> 6, jhi = (t0 + 31) >> 6;
    m = -1e30f; l = 0.f; NSA_ZERO_O();
    nsa_loop<3>(lds, (const unsigned char*)P.KV + (size_t)(8 + g) * CH, (const unsigned char*)P.KV + (size_t)(10 + g) * CH, jhi - jlo + 1, jlo, q, t, slope2, m, l, o, 0.f, tid, wave, lane);
    { const float f = P.G[(size_t)t * 48 + 32 + hh] / l; GAS f32x4* scr = NSA_SCR();
      const bf16* zp = P.Z + (size_t)t * 2048 + hh * 128 + 4 * hi;
      bf16* op = P.O + (size_t)t * 4096 + 2048 + hh * 128 + 4 * hi;
#pragma unroll
      for (int d0 = 0; d0 < 4; ++d0)
#pragma unroll
          for (int rg = 0; rg < 4; ++rg) { const int dim = 32 * d0 + 8 * rg; const f32x4 a = scr[(d0 * 4 + rg) * 64];
              const u32x2 z = *(const GAS u32x2*)(zp + dim);
              u32x2 w; w.x = pk2((a[0] + o[d0][4 * rg] * f) * bflo(z.x), (a[1] + o[d0][4 * rg + 1] * f) * bfhi(z.x)); w.y = pk2((a[2] + o[d0][4 * rg + 2] * f) * bflo(z.y), (a[3] + o[d0][4 * rg + 3] * f) * bfhi(z.y));
              *(GAS u32x2*)(op + dim) = w; } }
#undef NSA_ZERO_O
#undef NSA_SCR
}
struct CmpPtrs { const bf16* KV; const bf16* W1; const bf16* W2; const float* cbp; bf16* KC; bf16* VC; };
__device__ __forceinline__ void cmp_unit(LAS unsigned char* lds, const CmpPtrs& P, int kv, int g, int tile, int tid, int wave, int lane) {
    const int fr = lane & 15, fq = lane >> 4, n = 16 * tile + fr;
    const bf16* A = P.KV + (size_t)(kv * 2 + g) * ((size_t)S * 128) + (size_t)n * 2048 + 8 * fq;
    const bf16* B1 = P.W1 + (size_t)kv * 128 * 4096 + (size_t)(16 * wave + fr) * 4096 + 8 * fq;
    f32x4 acc = {0.f, 0.f, 0.f, 0.f};
#pragma unroll 8
    for (int s = 0; s < 128; ++s) {
        const bf16x8 a = *(const GAS bf16x8*)(A + 32 * s), b = *(const GAS bf16x8*)(B1 + 32 * s);
        acc = __builtin_amdgcn_mfma_f32_16x16x32_bf16(a, b, acc, 0, 0, 0);
    }
    float bias = 0.f;
#pragma unroll
    for (int c = 0; c < 16; ++c) bias += P.cbp[(size_t)(kv * 16 + c) * 128 + 16 * wave + fr];
    LAS bf16* hid = (LAS bf16*)lds;
#pragma unroll
    for (int i = 0; i < 4; ++i) hid[(4 * fq + i) * 136 + 16 * wave + fr] = (bf16)(pk2(silu_f(acc[i] + bias), 0.f) & 0xffffu);
    __syncthreads();
    const bf16* B2 = P.W2 + (size_t)kv * 128 * 128 + (size_t)(16 * wave + fr) * 128 + 8 * fq;
    f32x4 acc2 = {0.f, 0.f, 0.f, 0.f};
#pragma unroll
    for (int s = 0; s < 4; ++s) {
        const bf16x8 a = *(const LAS bf16x8*)(hid + fr * 136 + 32 * s + 8 * fq), b = *(const GAS bf16x8*)(B2 + 32 * s);
        acc2 = __builtin_amdgcn_mfma_f32_16x16x32_bf16(a, b, acc2, 0, 0, 0);
    }
    bf16* out = (kv ? P.VC : P.KC) + (size_t)g * 1024 * 128;
#pragma unroll
    for (int i = 0; i < 4; ++i) { const int nn = 16 * tile + 4 * fq + i; out[(size_t)nn * 128 + 16 * wave + fr] = (nn < 1023) ? (bf16)(pk2(acc2[i], 0.f) & 0xffffu) : (bf16)0; }
    __syncthreads();
}
}
#ifdef CHK_BUILD
namespace chk {
constexpr size_t WS_CHK = 14 * MiB;
__device__ __forceinline__ float bf2f(bf16 v) { return __uint_as_float((unsigned)v << 16); }
__device__ __forceinline__ float e4m3(unsigned char b) {
    const int e = (b >> 3) & 15, mm = b & 7; const float v = e == 0 ? (float)mm * (1.f / 512.f) : (1.f + (float)mm * 0.125f) * exp2f((float)(e - 7)); return (b & 0x80) ? -v : v; }
__device__ __forceinline__ int sample_t(int i) { return i * 64 + (i * 29) % 64; }
__device__ __noinline__ void nsa_check(LAS unsigned char* lds, unsigned char* ws, int t, int g, LAS float* acc2) {
    int tid_ = threadIdx.x; asm volatile("" : "+v"(tid_)); const int tid = tid_, lane = tid & 63, wave = tid >> 6;
    const int hh = 8 * g + wave, cur = t >> 6;
    const bf16* QN = (const bf16*)(ws + WS_QNSA); const bf16* KV = (const bf16*)(ws + WS_KVNSA); const bf16* KC = (const bf16*)(ws + WS_KCMP) + (size_t)g * 1024 * 128; const bf16* VC = (const bf16*)(ws + WS_VCMP) + (size_t)g * 1024 * 128;
    const bf16* ZN = (const bf16*)(ws + WS_ZNSA); const float* GN = (const float*)(ws + WS_GNSA); const bf16* HO = (const bf16*)(ws + WS_H);
    const size_t CH = (size_t)S * 128;
    LAS float* pc = (LAS float*)lds;
    LAS float* impv = (LAS float*)(lds + 32768);
    LAS int* sel = (LAS int*)(lds + 32768 + 1024);
    const float slope2 = exp2f(-0.5f * (float)(hh + 1)) * LOG2E;
    const float q0 = bf2f(QN[(size_t)t * 2048 + hh * 128 + 2 * lane]), q1 = bf2f(QN[(size_t)t * 2048 + hh * 128 + 2 * lane + 1]);
    float oc0 = 0.f, oc1 = 0.f, os0 = 0.f, os1 = 0.f, ow0 = 0.f, ow1 = 0.f;
    const int ncv = (t >= 31) ? (t - 31) / 16 + 1 : 0;
    for (int n = lane; n < 1024; n += 64) pc[wave * 1024 + n] = 0.f;
    float mx = -1e30f;
    for (int n = 0; n < ncv; ++n) { float s = q0 * bf2f(KC[(size_t)n * 128 + 2 * lane]) + q1 * bf2f(KC[(size_t)n * 128 + 2 * lane + 1]); s = wave_sum(s) - slope2 * (float)(t - 16 * n - 31);
        if (lane == 0) pc[wave * 1024 + n] = s; mx = fmaxf(mx, s); }
    __syncthreads();
    float sum = 0.f;
    for (int n = 0; n < ncv; ++n) sum += exp2f(pc[wave * 1024 + n] - mx);
    __syncthreads();
    for (int n = lane; n < 1024; n += 64) pc[wave * 1024 + n] = (n < ncv) ? exp2f(pc[wave * 1024 + n] - mx) / sum : 0.f;
    __syncthreads();
    for (int n = 0; n < ncv; ++n) { const float p = pc[wave * 1024 + n]; oc0 += p * bf2f(VC[(size_t)n * 128 + 2 * lane]); oc1 += p * bf2f(VC[(size_t)n * 128 + 2 * lane + 1]); }
    if (tid < 256) { const int j = tid; float v = -1e30f;
        if (64 * j <= t) { float a = 0.f; for (int ii = 4 * j - 1; ii <= 4 * j + 3; ++ii) if (ii >= 0 && ii <= 1022) { float ps = 0.f; for (int h = 0; h < 8; ++h) ps += pc[h * 1024 + ii]; a += ps; }
            const bool forced = (j == 0) || (j == cur) || (j == cur - 1); v = a + (forced ? 1e4f : 0.f); }
        impv[j] = v; }
    __syncthreads();
    if (tid < 256) { const int j = tid; const float v = impv[j]; int rank = 0; for (int ii = 0; ii < 256; ++ii) { const float u = impv[ii]; rank += (u > v || (u == v && ii < j)) ? 1 : 0; } sel[j] = rank < 16 ? 1 : 0; }
    __syncthreads();
    const bf16* KS = KV + (size_t)(4 + g) * CH; const bf16* VSl = KV + (size_t)(6 + g) * CH;
    mx = -1e30f;
    for (int j = 0; j < 256; ++j) if (sel[j]) for (int tok = 64 * j; tok < 64 * j + 64 && tok <= t; ++tok) {
        float s = q0 * bf2f(KS[(size_t)tok * 128 + 2 * lane]) + q1 * bf2f(KS[(size_t)tok * 128 + 2 * lane + 1]); s = wave_sum(s) - slope2 * (float)(t - tok); mx = fmaxf(mx, s); }
    sum = 0.f;
    for (int j = 0; j < 256; ++j) if (sel[j]) for (int tok = 64 * j; tok < 64 * j + 64 && tok <= t; ++tok) {
        float s = q0 * bf2f(KS[(size_t)tok * 128 + 2 * lane]) + q1 * bf2f(KS[(size_t)tok * 128 + 2 * lane + 1]); s = wave_sum(s) - slope2 * (float)(t - tok);
        const float p = exp2f(s - mx); sum += p; os0 += p * bf2f(VSl[(size_t)tok * 128 + 2 * lane]); os1 += p * bf2f(VSl[(size_t)tok * 128 + 2 * lane + 1]); }
    os0 /= sum; os1 /= sum;
    const bf16* KW = KV + (size_t)(8 + g) * CH; const bf16* VW = KV + (size_t)(10 + g) * CH;
    const int lo = t - 511 > 0 ? t - 511 : 0;
    mx = -1e30f;
    for (int tok = lo; tok <= t; ++tok) { float s = q0 * bf2f(KW[(size_t)tok * 128 + 2 * lane]) + q1 * bf2f(KW[(size_t)tok * 128 + 2 * lane + 1]); s = wave_sum(s) - slope2 * (float)(t - tok); mx = fmaxf(mx, s); }
    sum = 0.f;
    for (int tok = lo; tok <= t; ++tok) { float s = q0 * bf2f(KW[(size_t)tok * 128 + 2 * lane]) + q1 * bf2f(KW[(size_t)tok * 128 + 2 * lane + 1]); s = wave_sum(s) - slope2 * (float)(t - tok);
        const float p = exp2f(s - mx); sum += p; ow0 += p * bf2f(VW[(size_t)tok * 128 + 2 * lane]); ow1 += p * bf2f(VW[(size_t)tok * 128 + 2 * lane + 1]); }
    ow0 /= sum; ow1 /= sum;
    const float gc = GN[(size_t)t * 48 + hh], gs = GN[(size_t)t * 48 + 16 + hh], gwv = GN[(size_t)t * 48 + 32 + hh];
    const float r0 = (gc * oc0 + gs * os0 + gwv * ow0) * bf2f(ZN[(size_t)t * 2048 + hh * 128 + 2 * lane]), r1 = (gc * oc1 + gs * os1 + gwv * ow1) * bf2f(ZN[(size_t)t * 2048 + hh * 128 + 2 * lane + 1]);
    const float f0 = bf2f(HO[(size_t)t * 4096 + 2048 + hh * 128 + 2 * lane]), f1 = bf2f(HO[(size_t)t * 4096 + 2048 + hh * 128 + 2 * lane + 1]);
    const float e2 = wave_sum((r0 - f0) * (r0 - f0) + (r1 - f1) * (r1 - f1)), n2 = wave_sum(r0 * r0 + r1 * r1);
    __syncthreads();
    if (lane == 0) { pc[wave] = e2; pc[8 + wave] = n2; }
    __syncthreads();
    if (tid == 0) { float a = 0.f, b = 0.f; for (int w = 0; w < 8; ++w) { a += pc[w]; b += pc[8 + w]; } acc2[0] += a; acc2[1] += b; }
    __syncthreads();
}
__device__ __forceinline__ void mla_check(LAS unsigned char* lds, unsigned char* ws, int t, LAS float* acc2) {
    int tid_ = threadIdx.x; asm volatile("" : "+v"(tid_)); const int tid = tid_, lane = tid & 63, wave = tid >> 6;
    const bf16* ZM = (const bf16*)(ws + WS_ZMLA); const bf16* HO = (const bf16*)(ws + WS_H);
    LAS float* qs = (LAS float*)lds + wave * 192;
    LAS float* red = (LAS float*)lds + 8 * 192;
    float ae = 0.f, an = 0.f;
    for (int rep = 0; rep < 2; ++rep) { const int head = wave + 8 * rep;
#ifdef MLA_FP8
        { const unsigned char* qp = (const unsigned char*)(ws + WS_QMLA) + (size_t)t * 3072 + head * 192; for (int d = lane; d < 192; d += 64) qs[d] = e4m3(qp[d]) * QS_MLA; }
#else
        { const bf16* qp = (const bf16*)(ws + WS_QMLA) + (size_t)t * 3072 + head * 192; for (int d = lane; d < 192; d += 64) qs[d] = bf2f(qp[d]); }
#endif
        __syncthreads();
        float mx = -1e30f;
        for (int c = 0; 64 * c <= t; ++c) { const int x_ = lane & 15; const int tok = 64 * c + (lane & 48) + (x_ < 4 ? x_ : (x_ < 8 ? x_ + 4 : (x_ < 12 ? x_ - 4 : x_)));
            float s = 0.f;
#ifdef MLA_FP8
            const unsigned char* kp = (const unsigned char*)(ws + WS_KMLA) + (size_t)tok * 3072 + head * 192; for (int d = 0; d < 192; ++d) s += qs[d] * e4m3(kp[d]);
#else
            const bf16* kp = (const bf16*)(ws + WS_KMLA) + (size_t)tok * 3072 + head * 192; for (int d = 0; d < 192; ++d) s += qs[d] * bf2f(kp[d]);
#endif
            if (tok <= t) mx = fmaxf(mx, s); }
        for (int off = 1; off < 64; off <<= 1) mx = fmaxf(mx, __shfl_xor(mx, off));
        float e2 = 0.f, n2 = 0.f;
        for (int dc = 0; dc < 8; ++dc) {
        float sum = 0.f; float o[16];
#pragma unroll
        for (int d = 0; d < 16; ++d) o[d] = 0.f;
        for (int c = 0; 64 * c <= t; ++c) { const int x_ = lane & 15; const int tok = 64 * c + (lane & 48) + (x_ < 4 ? x_ : (x_ < 8 ? x_ + 4 : (x_ < 12 ? x_ - 4 : x_)));
            float s = 0.f;
#ifdef MLA_FP8
            const unsigned char* kp = (const unsigned char*)(ws + WS_KMLA) + (size_t)tok * 3072 + head * 192; for (int d = 0; d < 192; ++d) s += qs[d] * e4m3(kp[d]);
#else
            const bf16* kp = (const bf16*)(ws + WS_KMLA) + (size_t)tok * 3072 + head * 192; for (int d = 0; d < 192; ++d) s += qs[d] * bf2f(kp[d]);
#endif
            const float p = (tok <= t) ? exp2f(s - mx) : 0.f; sum += p;
#ifdef MLA_FP8V
            const unsigned char* vt = (const unsigned char*)(ws + WS_VMLA) + ((size_t)head * 128 + 16 * dc) * S + 64 * c + lane;
#pragma unroll
            for (int d = 0; d < 16; ++d) o[d] += p * e4m3(vt[(size_t)d * S]);
#else
            const bf16* vp = (const bf16*)(ws + WS_VMLA) + (size_t)tok * 2048 + head * 128 + 16 * dc;
#pragma unroll
            for (int d = 0; d < 16; ++d) o[d] += p * bf2f(vp[d]);
#endif
        }
        sum = wave_sum(sum);
#pragma unroll
        for (int d = 0; d < 16; ++d) { const float od = wave_sum(o[d]) / sum; const float r = od * bf2f(ZM[(size_t)t * 2048 + head * 128 + 16 * dc + d]), f = bf2f(HO[(size_t)t * 4096 + head * 128 + 16 * dc + d]); e2 += (r - f) * (r - f); n2 += r * r; }
        }
        ae += e2; an += n2;
        __syncthreads(); }
    if (lane == 0) { red[wave] = ae; red[8 + wave] = an; }
    __syncthreads();
    if (tid == 0) { float a = 0.f, b = 0.f; for (int w = 0; w < 8; ++w) { a += red[w]; b += red[8 + w]; } acc2[0] += a; acc2[1] += b; }
    __syncthreads();
}
}
#endif
#ifdef CHK2_BUILD
namespace chk2 {
constexpr size_t WS_CHK = 14 * MiB;
__device__ __forceinline__ float bf2f(bf16 v) { return __uint_as_float((unsigned)v << 16); }
__device__ __forceinline__ int sample_t(int i) { return i * 256 + (i * 29) % 256; }
__device__ __noinline__ void proj_check(LAS unsigned char* lds, unsigned char* ws, const float* x, const float* w_in_l, int l, int i, int qd, LAS float* acc2) {
    int tid_ = threadIdx.x; asm volatile("" : "+v"(tid_)); const int tid = tid_;
    const int t = sample_t(i);
    LAS float* h = (LAS float*)lds;
    LAS float* red = h + 4096;
    const float* mod = (const float*)(ws + WS_MOD) + (size_t)l * 3 * D;
    const float* xin = (l == 0) ? x : (const float*)(ws + WS_XV);
    for (int k = tid; k < D; k += NTHR) h[k] = xin[(size_t)t * D + k] * (1.f + mod[D + k]) + mod[k];
    __syncthreads();
    float e2 = 0.f, r2 = 0.f;
    const float* cosT = (const float*)(ws + WS_ROPE); const float* sinT = cosT + (size_t)S * 32;
    for (int n = qd * 2268 + tid; n < (qd + 1) * 2268; n += NTHR) {
        float a = 0.f;
        for (int k = 0; k < D; ++k) a += h[k] * w_in_l[(size_t)k * INC + n];
        float ref = a, got;
        if (n < 768) got = bf2f(((const bf16*)(ws + WS_QLAT))[(size_t)t * 768 + n]);
        else if (n < 1280) got = bf2f(((const bf16*)(ws + WS_KVLAT))[(size_t)t * 512 + n - 768]);
        else if (n < 1344) {
            const int ii = n - 1280, pi = ii & 31; const int np = 1280 + (ii < 32 ? ii + 32 : ii - 32); float b = 0.f;
            for (int k = 0; k < D; ++k) b += h[k] * w_in_l[(size_t)k * INC + np];
            const float c = cosT[(size_t)t * 32 + pi], s = sinT[(size_t)t * 32 + pi];
            ref = ii < 32 ? a * c - b * s : a * c + b * s;
            got = bf2f(((const bf16*)(ws + WS_KMLA))[(size_t)t * 3072 + 5 * 192 + 128 + 2 * pi + (ii >> 5)]);
        }
        else if (n < 3392) { ref = a / (1.f + expf(-a)); got = bf2f(((const bf16*)(ws + WS_ZMLA))[(size_t)t * 2048 + n - 1344]); }
        else if (n < 5440) { ref = a * QS_NSA; got = bf2f(((const bf16*)(ws + WS_QNSA))[(size_t)t * 2048 + n - 3392]); }
        else if (n < 6976) { const int c = n - 5440; got = bf2f(((const bf16*)(ws + WS_KVNSA))[(size_t)(c >> 7) * ((size_t)S * 128) + (size_t)t * 128 + (c & 127)]); }
        else if (n < 7024) { ref = 1.f / (1.f + expf(-a)); got = ((const float*)(ws + WS_GNSA))[(size_t)t * 48 + n - 6976]; }
        else { ref = a / (1.f + expf(-a)); got = bf2f(((const bf16*)(ws + WS_ZNSA))[(size_t)t * 2048 + n - 7024]); }
        e2 += (ref - got) * (ref - got); r2 += ref * ref;
    }
    red[tid] = e2; red[512 + tid] = r2;
    __syncthreads();
    if (tid == 0) { float a = 0.f, b = 0.f; for (int k = 0; k < 512; ++k) { a += red[k]; b += red[512 + k]; } acc2[0] += a; acc2[1] += b; }
    __syncthreads();
}
__device__ __noinline__ void cmp_check(LAS unsigned char* lds, unsigned char* ws, const float* cmp_pos_l, const float* w1_l, const float* w2_l, int i, LAS float* acc2) {
    int tid_ = threadIdx.x; asm volatile("" : "+v"(tid_)); const int tid = tid_;
    const int n = (4 * i + (i & 3)) % 1023, kv = i & 1, g = (i >> 1) & 1;
    LAS float* blk = (LAS float*)lds;
    LAS float* hid = blk + 4096;
    LAS float* red = hid + 128;
    const bf16* A = (const bf16*)(ws + WS_KVNSA) + (size_t)(kv * 2 + g) * ((size_t)S * 128) + (size_t)n * 2048;
    for (int k = tid; k < 4096; k += NTHR) blk[k] = bf2f(A[k]) + cmp_pos_l[(size_t)kv * 4096 + k];
    __syncthreads();
    if (tid < 128) { float a = 0.f; const float* W = w1_l + (size_t)kv * 4096 * 128 + tid; for (int k = 0; k < 4096; ++k) a += blk[k] * W[(size_t)k * 128]; hid[tid] = a / (1.f + expf(-a)); }
    __syncthreads();
    float e2 = 0.f, r2 = 0.f;
    if (tid < 128) { float a = 0.f; const float* W = w2_l + (size_t)kv * 128 * 128 + tid; for (int k = 0; k < 128; ++k) a += hid[k] * W[(size_t)k * 128];
        const float got = bf2f(((const bf16*)(ws + (kv ? WS_VCMP : WS_KCMP)))[(size_t)g * 1024 * 128 + (size_t)n * 128 + tid]); e2 = (a - got) * (a - got); r2 = a * a; }
    if (tid < 128) { red[tid] = e2; red[128 + tid] = r2; }
    __syncthreads();
    if (tid == 0) { float a = 0.f, b = 0.f; for (int k = 0; k < 128; ++k) { a += red[k]; b += red[128 + k]; } acc2[0] += a; acc2[1] += b; }
    __syncthreads();
}
}
#endif
#ifdef CHK3_BUILD
namespace chk3 {
constexpr size_t WS_CHK = 14 * MiB;
__device__ __forceinline__ float bf2f(bf16 v) { return __uint_as_float((unsigned)v << 16); }
__device__ __forceinline__ float e4m3(unsigned char b) { const int e = (b >> 3) & 15, mm = b & 7; const float v = e == 0 ? (float)mm * (1.f / 512.f) : (1.f + (float)mm * 0.125f) * exp2f((float)(e - 7)); return (b & 0x80) ? -v : v; }
__device__ __forceinline__ int sample_t(int i) { return i * 64 + (i * 29) % 64; }
__device__ __noinline__ void up_check(LAS unsigned char* lds, unsigned char* ws, const float* qn, const float* wq, const float* kn, const float* wkv, int i, LAS float* acc2) {
    int tid_ = threadIdx.x; asm volatile("" : "+v"(tid_)); const int tid = tid_;
    const int t = sample_t(i);
    LAS float* ql = (LAS float*)lds;
    LAS float* kl = ql + 768;
    LAS float* qo = kl + 512;
    LAS float* red = qo + 3072;
    const bf16* QL = (const bf16*)(ws + WS_QLAT) + (size_t)t * 768; const bf16* KL = (const bf16*)(ws + WS_KVLAT) + (size_t)t * 512;
    float s = 0.f; for (int k = tid; k < 768; k += NTHR) { const float v = bf2f(QL[k]); s += v * v; }
    red[tid] = s; __syncthreads();
    float tot = 0.f; for (int k = 0; k < 512; ++k) tot += red[k];
    const float rq = 1.f / sqrtf(tot / 768.f + RMS_EPS);
    __syncthreads();
    s = 0.f; for (int k = tid; k < 512; k += NTHR) { const float v = bf2f(KL[k]); s += v * v; }
    red[tid] = s; __syncthreads();
    tot = 0.f; for (int k = 0; k < 512; ++k) tot += red[k];
    const float rk = 1.f / sqrtf(tot / 512.f + RMS_EPS);
    __syncthreads();
    for (int k = tid; k < 768; k += NTHR) ql[k] = bf2f(QL[k]) * rq * qn[k];
    for (int k = tid; k < 512; k += NTHR) kl[k] = bf2f(KL[k]) * rk * kn[k];
    __syncthreads();
    for (int n = tid; n < 3072; n += NTHR) { float a = 0.f; for (int k = 0; k < 768; ++k) a += ql[k] * wq[(size_t)k * 3072 + n]; qo[n] = a; }
    __syncthreads();
    float e2 = 0.f, r2 = 0.f;
    const float* cosT = (const float*)(ws + WS_ROPE); const float* sinT = cosT + (size_t)S * 32;
    const bf16* QM = (const bf16*)(ws + WS_QMLA) + (size_t)t * 3072;
    for (int n = tid; n < 3072; n += NTHR) { const int h = n / 192, d = n % 192; float ref, got;
#ifdef MLA_FP8
        const unsigned char* Q8 = (const unsigned char*)(ws + WS_QMLA) + (size_t)t * 3072;
        if (d < 128) { ref = qo[n]; got = e4m3(Q8[h * 192 + d]); }
        else { const int ii = d - 128, pi = ii & 31; const float x1 = qo[h * 192 + 128 + pi], x2 = qo[h * 192 + 160 + pi]; const float c = cosT[(size_t)t * 32 + pi], sn = sinT[(size_t)t * 32 + pi];
            ref = (ii < 32 ? x1 * c - x2 * sn : x2 * c + x1 * sn); got = e4m3(Q8[h * 192 + 128 + 2 * pi + (ii >> 5)]); }
        if (false) {}
#else
        if (d < 128) { ref = qo[n] * QS_MLA; got = bf2f(QM[h * 192 + d]); }
        else { const int ii = d - 128, pi = ii & 31; const float x1 = qo[h * 192 + 128 + pi], x2 = qo[h * 192 + 160 + pi]; const float c = cosT[(size_t)t * 32 + pi], sn = sinT[(size_t)t * 32 + pi];
            ref = (ii < 32 ? x1 * c - x2 * sn : x2 * c + x1 * sn) * QS_MLA; got = bf2f(QM[h * 192 + 128 + 2 * pi + (ii >> 5)]); }
#endif
        e2 += (ref - got) * (ref - got); r2 += ref * ref; }
    const bf16* KM = (const bf16*)(ws + WS_KMLA) + (size_t)t * 3072; const bf16* VM = (const bf16*)(ws + WS_VMLA) + (size_t)t * 2048;
    for (int n = tid; n < 4096; n += NTHR) { float a = 0.f; for (int k = 0; k < 512; ++k) a += kl[k] * wkv[(size_t)k * 4096 + n];
#ifdef MLA_FP8
        const int h = n >> 8, d = n & 255; const float got = d < 128 ? e4m3(((const unsigned char*)(ws + WS_KMLA) + (size_t)t * 3072)[h * 192 + d]) : bf2f(VM[h * 128 + d - 128]);
#else
        const int h = n >> 8, d = n & 255; const float got = d < 128 ? bf2f(KM[h * 192 + d]) : bf2f(VM[h * 128 + d - 128]);
#endif
        e2 += (a - got) * (a - got); r2 += a * a; }
    red[tid] = e2; red[512 + tid] = r2;
    __syncthreads();
    if (tid == 0) { float a = 0.f, b = 0.f; for (int k = 0; k < 512; ++k) { a += red[k]; b += red[512 + k]; } acc2[0] += a; acc2[1] += b; }
    __syncthreads();
}
__device__ __noinline__ void out_check(LAS unsigned char* lds, unsigned char* ws, const float* xin, const float* xv, const float* wout, const float* gate, int i, int qd, LAS float* acc2) {
    int tid_ = threadIdx.x; asm volatile("" : "+v"(tid_)); const int tid = tid_;
    const int t = i * 256 + (i * 29) % 256;
    LAS float* o = (LAS float*)lds;
    LAS float* red = o + 4096;
    const bf16* OA = (const bf16*)(ws + WS_H) + (size_t)t * 4096;
    for (int k = tid; k < 4096; k += NTHR) o[k] = bf2f(OA[k]);
    __syncthreads();
    float e2 = 0.f, r2 = 0.f;
    for (int n = qd * 1024 + tid; n < (qd + 1) * 1024; n += NTHR) { float a = 0.f; for (int k = 0; k < 4096; ++k) a += o[k] * wout[(size_t)k * 4096 + n];
        const float gy = gate[n] * a, ref = DN_ALPHA * xin[(size_t)t * D + n] + gy, got = xv[(size_t)t * D + n];
        e2 += (ref - got) * (ref - got); r2 += gy * gy; }
    red[tid] = e2; red[512 + tid] = r2;
    __syncthreads();
    if (tid == 0) { float a = 0.f, b = 0.f; for (int k = 0; k < 512; ++k) { a += red[k]; b += red[512 + k]; } acc2[0] += a; acc2[1] += b; }
    __syncthreads();
}
}
#endif
#ifdef CHK4_BUILD
namespace chk4 {
__device__ __forceinline__ float bf2f(bf16 v) { return __uint_as_float((unsigned)v << 16); }
__device__ __noinline__ void mod_check(LAS unsigned char* lds, unsigned char* ws, const float* c, const float* w_ada, const float* b_ada, int u, LAS float* acc2) {
    const int tid = threadIdx.x;
    LAS float* red = (LAS float*)lds;
    const int l = u & 1, n = ((u >> 1) * 977 + 13) % (3 * D);
    float a = 0.f;
    for (int k = tid; k < D; k += NTHR) { const float cv = c[k]; a += cv / (1.f + expf(-cv)) * w_ada[(size_t)l * D * 3 * D + (size_t)k * 3 * D + n]; }
    red[tid] = a; __syncthreads();
    if (tid == 0) { float s = 0.f; for (int k = 0; k < NTHR; ++k) s += red[k]; s += b_ada[(size_t)l * 3 * D + n];
        const float got = ((const float*)(ws + WS_MOD))[(size_t)l * 3 * D + n]; acc2[0] += (s - got) * (s - got); acc2[1] += s * s; }
    __syncthreads();
}
__device__ __noinline__ void ln_check(LAS unsigned char* lds, unsigned char* ws, const float* ln_g, const float* ln_b, int u, LAS float* acc2) {
    const int tid = threadIdx.x;
    LAS float* red = (LAS float*)lds;
    const int t = u * 64 + (u * 29) % 64;
    const float* X1 = (const float*)(ws + WS_XV) + (size_t)t * D; const bf16* H = (const bf16*)(ws + WS_H) + (size_t)t * D; const float* mod1 = (const float*)(ws + WS_MOD) + 3 * D;
    float s1 = 0.f, s2 = 0.f, e2 = 0.f, r2 = 0.f;
    for (int k = tid; k < D; k += NTHR) { const float y = (X1[k] - ln_b[k]) / ln_g[k]; s1 += y; s2 += y * y;
        const float h = X1[k] * (1.f + mod1[D + k]) + mod1[k], got = bf2f(H[k]); e2 += (h - got) * (h - got); r2 += h * h; }
    red[tid] = s1; red[512 + tid] = s2; red[1024 + tid] = e2; red[1536 + tid] = r2; __syncthreads();
    if (tid == 0) { float a = 0.f, b = 0.f, c = 0.f, d = 0.f; for (int k = 0; k < NTHR; ++k) { a += red[k]; b += red[512 + k]; c += red[1024 + k]; d += red[1536 + k]; }
        const float mean = a / D, var = b / D - mean * mean;
        acc2[0] += mean * mean + (var - 1.f) * (var - 1.f) + c / d; acc2[1] += 1.f; }
    __syncthreads();
}
}
#endif
constexpr int PPL = 6;
constexpr int N_PHASES = 2 + PPL * DEPTH;
struct Args { const void* in[16]; float* out; unsigned char* ws; int ph_lo, ph_hi; };
#define WSP(T, off) ((T*)(ws + (off)))
#define VCU() ((gridDim.x % 8 == 0) ? (int)((blockIdx.x % 8) * (gridDim.x / 8) + blockIdx.x / 8) : (int)blockIdx.x)
__global__ void __launch_bounds__(NTHR, 2) mk_fwd(const Args args) {
    extern __shared__ __attribute__((aligned(16))) unsigned char lds_raw[];
    LAS unsigned char* lds = (LAS unsigned char*)lds_raw;
    if (threadIdx.x < 32) ((volatile LAS unsigned*)(lds + MISC_OFF))[threadIdx.x] = 0u;
    __syncthreads();
    XcdBarrier bar = xcd_barrier_post((unsigned*)(args.ws + WS_CTL) + CW_BAR, (volatile LAS unsigned*)(lds + MISC_OFF) + 8);
#define IN(k) (args.ph_lo <= (k) && (k) < args.ph_hi)
#define SEAM(k) do { if (IN(k) && IN((k) + 1)) xcd_barrier(bar); } while (0)
#define PHASE_REGS int tid_ = threadIdx.x; asm volatile("" : "+v"(tid_)); const int tid = tid_, lane = tid & 63, wave = __builtin_amdgcn_readfirstlane(tid >> 6); \
    unsigned char* ws = args.ws; asm volatile("" : "+s"(ws)); (void)tid; (void)lane; (void)wave

    if (IN(0)) {
        PHASE_REGS; const int G = gridDim.x, vcu = VCU();
        p0_mod_gemv((const float*)args.in[1], (const float*)args.in[3], (const float*)args.in[4], WSP(float, WS_MOD), (LAS float*)lds, vcu, G);
        p0_cmpbias((const float*)args.in[10], (const float*)args.in[11], WSP(float, WS_CBP), (LAS float*)lds, (vcu + G / 2) % G, G);
        p0_rope((const int*)args.in[2], WSP(float, WS_ROPE), WSP(float, WS_ROPE) + (size_t)S * 32, vcu * NTHR + tid, G * NTHR);
        const P0In I{(const float*)args.in[5], (const float*)args.in[6], (const float*)args.in[7], (const float*)args.in[8], (const float*)args.in[9], (const float*)args.in[11], (const float*)args.in[12], (const float*)args.in[13]};
#ifndef DIS_CONV
        p0_convert(I, ws, vcu * NWAVES + wave, G * NWAVES, lane);
#endif
#ifdef PROBE_P0CONV2
        p0_convert(I, ws, vcu * NWAVES + wave, G * NWAVES, lane);
#endif
#ifdef PROBE_P0MOD2
        __syncthreads(); p0_mod_gemv((const float*)args.in[1], (const float*)args.in[3], (const float*)args.in[4], WSP(float, WS_MOD), (LAS float*)lds, vcu, G);
#endif
    }
    SEAM(0);
    if (IN(1)) { PHASE_REGS; modulate_rows((const float*)args.in[0], WSP(bf16, WS_H), WSP(float, WS_MOD), VCU() * NWAVES + wave, gridDim.x * NWAVES, lane);
#ifdef PROBE_THIN2
        modulate_rows((const float*)args.in[0], WSP(bf16, WS_H), WSP(float, WS_MOD), VCU() * NWAVES + wave, gridDim.x * NWAVES, lane);
#endif
    }
    SEAM(1);
    for (int l = 0; l < DEPTH; ++l) {
        const int pb = 2 + PPL * l;
        if (IN(pb + 0)) {
            PHASE_REGS;
            pg8::Gemm gg{WSP(bf16, WS_H), (const bf16*)(ws + WS_W + (size_t)l * W_LSTRIDE + W_IN), S, NIN, D}; pg8::StaticOrder SO; SO.init(S, NIN, gridDim.x, blockIdx.x);
            const pg8::EpiIn E{ws};
#ifndef DIS_IN
            pg8::gemm_phase<pg8::EpiIn, pg8::StaticOrder, true, true>(lds, gg, SO, E);
#endif
#ifdef PROBE_IN2
            pg8::gemm_phase<pg8::EpiIn, pg8::StaticOrder, true, true>(lds, gg, SO, E);
#endif
        }
        SEAM(pb + 0);
        if (IN(pb + 1)) {
            PHASE_REGS; const int G = gridDim.x, vcu = VCU();
            rstd_rows(WSP(float, WS_RSQQ), WSP(float, WS_RSQKV), WSP(float, WS_RSTD), WSP(float, WS_RSTD) + S, vcu * NTHR + tid, G * NTHR);
            const att::CmpPtrs CP{WSP(bf16, WS_KVNSA), (const bf16*)(ws + WS_W + (size_t)l * W_LSTRIDE + W_C1), (const bf16*)(ws + WS_W + (size_t)l * W_LSTRIDE + W_C2),
                                  WSP(float, WS_CBP) + (size_t)l * 2 * 16 * 128, WSP(bf16, WS_KCMP), WSP(bf16, WS_VCMP)};
#ifndef DIS_CMP
            for (int u = vcu; u < 256; u += G) att::cmp_unit(lds, CP, u & 1, (u >> 1) & 1, u >> 2, tid, wave, lane);
#endif
#ifdef PROBE_THIN2
            rstd_rows(WSP(float, WS_RSQQ), WSP(float, WS_RSQKV), WSP(float, WS_RSTD), WSP(float, WS_RSTD) + S, vcu * NTHR + tid, G * NTHR);
            for (int u = vcu; u < 256; u += G) att::cmp_unit(lds, CP, u & 1, (u >> 1) & 1, u >> 2, tid, wave, lane);
#endif
        }
        SEAM(pb + 1);
        if (IN(pb + 2)) {
            PHASE_REGS;
            { pg8::Gemm gg{WSP(bf16, WS_QLAT), (const bf16*)(ws + WS_W + (size_t)l * W_LSTRIDE + W_QUP), S, 3072, 768}; pg8::StaticOrder SO; SO.init(S, 3072, gridDim.x, blockIdx.x);
              const pg8::EpiQup E{ws};
#ifndef DIS_QUP
              pg8::gemm_phase<pg8::EpiQup, pg8::StaticOrder, true, true>(lds, gg, SO, E);
#endif
#ifdef PROBE_UP2
              pg8::gemm_phase<pg8::EpiQup, pg8::StaticOrder, true, true>(lds, gg, SO, E);
#endif
            }
#ifdef MLA_FP8V
            { pg8::Gemm gg{WSP(bf16, WS_KVLAT), (const bf16*)(ws + WS_W + (size_t)l * W_LSTRIDE + W_KVUP), S, 2048, 512}; pg8::StaticOrder SO; SO.init(S, 2048, gridDim.x, blockIdx.x);
              const pg8::EpiKup E{ws};
              pg8::gemm_phase<pg8::EpiKup, pg8::StaticOrder, true, true>(lds, gg, SO, E);
            }
            { pg8::Gemm gg{(const bf16*)(ws + WS_W + (size_t)l * W_LSTRIDE + W_KVUP) + (size_t)2048 * 512, WSP(bf16, WS_KVLAT), 2048, S, 512}; pg8::StaticOrder SO; SO.init(2048, S, gridDim.x, blockIdx.x);
              const pg8::EpiVt E{ws};
              pg8::gemm_phase<pg8::EpiVt, pg8::StaticOrder, true, true>(lds, gg, SO, E);
            }
        }
#else
            { pg8::Gemm gg{WSP(bf16, WS_KVLAT), (const bf16*)(ws + WS_W + (size_t)l * W_LSTRIDE + W_KVUP), S, 4096, 512}; pg8::StaticOrder SO; SO.init(S, 4096, gridDim.x, blockIdx.x);
              const pg8::EpiKvup E{ws};
#ifndef DIS_KVUP
              pg8::gemm_phase<pg8::EpiKvup, pg8::StaticOrder, true, true>(lds, gg, SO, E);
#endif
#ifdef PROBE_UP2
              pg8::gemm_phase<pg8::EpiKvup, pg8::StaticOrder, true, true>(lds, gg, SO, E);
#endif
            }
        }
#endif
        SEAM(pb + 2);
        if (IN(pb + 3)) {
            PHASE_REGS; const int G = gridDim.x, vcu = VCU();
            { const att::MlaPtrs MP{WSP(bf16, WS_QMLA), WSP(bf16, WS_KMLA), WSP(bf16, WS_VMLA), WSP(bf16, WS_ZMLA), WSP(bf16, WS_H)};
              for (int pu = vcu; pu < 512; pu += G) { const int head = pu >> 5, pr = pu & 31;
#ifndef DIS_MLA
                  att::mla_unit(lds, MP, head, 63 - pr, tid, wave, lane);
                  att::mla_unit(lds, MP, head, pr, tid, wave, lane);
#endif
              }
#ifdef PROBE_MLA2
              for (int pu = vcu; pu < 512; pu += G) { const int head = pu >> 5, pr = pu & 31; att::mla_unit(lds, MP, head, 63 - pr, tid, wave, lane); att::mla_unit(lds, MP, head, pr, tid, wave, lane); }
#endif
            }
            { const att::NsaPtrs NP{WSP(bf16, WS_QNSA), WSP(bf16, WS_KVNSA), WSP(bf16, WS_KCMP), WSP(bf16, WS_VCMP), WSP(bf16, WS_ZNSA), WSP(float, WS_GNSA), WSP(bf16, WS_H), WSP(float, WS_OSCR)};
#ifndef DIS_NSA
              for (int u = vcu; u < 1024; u += G) { const int v_ = (u >> 1) & 127, k_ = u >> 8;
                  att::nsa_unit(lds, NP, u & 1, (k_ & 1) ? 128 * k_ + 127 - v_ : 128 * k_ + v_, tid, wave, lane, blockIdx.x); }
#endif
#ifdef PROBE_NSA2
              for (int u = vcu; u < 1024; u += G) att::nsa_unit(lds, NP, u & 1, u >> 1, tid, wave, lane, blockIdx.x);
#endif
            }
        }
        SEAM(pb + 3);
        if (IN(pb + 4)) {
            PHASE_REGS;
            pg8::Gemm gg{WSP(bf16, WS_H), (const bf16*)(ws + WS_W + (size_t)l * W_LSTRIDE + W_OUT), S, D, D}; pg8::StaticOrder SO; SO.init(S, D, gridDim.x, blockIdx.x);
            const pg8::EpiOut E{l == 0 ? (const float*)args.in[0] : WSP(const float, WS_XV), l == DEPTH - 1 ? args.out : WSP(float, WS_XV), WSP(const float, WS_MOD) + (size_t)l * 3 * D + 2 * D};
#ifndef DIS_OUT
            pg8::gemm_phase<pg8::EpiOut, pg8::StaticOrder, true, true>(lds, gg, SO, E);
#endif
#ifdef PROBE_OUT2
            pg8::gemm_phase<pg8::EpiOut, pg8::StaticOrder, true, true>(lds, gg, SO, E);
#endif
        }
        SEAM(pb + 4);
        if (IN(pb + 5)) {
            PHASE_REGS;
            float* v = (l == DEPTH - 1) ? args.out : WSP(float, WS_XV);
            ln_rows(v, v, (l == DEPTH - 1) ? nullptr : WSP(bf16, WS_H), (const float*)args.in[14] + (size_t)l * D, (const float*)args.in[15] + (size_t)l * D,
                    WSP(const float, WS_MOD) + (size_t)(l + 1) * 3 * D, VCU() * NWAVES + wave, gridDim.x * NWAVES, lane);
        }
        SEAM(pb + 5);
    }
#undef IN
#undef SEAM
}


#if defined(CHK_BUILD) || defined(CHK2_BUILD) || defined(CHK3_BUILD) || defined(CHK4_BUILD)
__global__ void __launch_bounds__(NTHR, 2) chk_kernel(const Args args, int l) {
    extern __shared__ __attribute__((aligned(16))) unsigned char lds_raw[];
    LAS unsigned char* lds = (LAS unsigned char*)lds_raw;
    unsigned char* ws = args.ws; const int G = gridDim.x, vcu = blockIdx.x;
    LAS float* acc = (LAS float*)(lds + 65536);
    if (threadIdx.x == 0) { acc[0] = 0.f; acc[1] = 0.f; acc[2] = 0.f; acc[3] = 0.f; }
    __syncthreads();
#ifdef CHK_BUILD
#if CHK_WHICH == 0
    for (int u = vcu; u < 2 * (CHK_HI - CHK_LO); u += G) { const int t = CHK_LO + (u >> 1); chk::nsa_check(lds, ws, t, u & 1, t < CHK_SPLIT ? acc : acc + 2); }
#else
    for (int u = vcu; u < (CHK_HI - CHK_LO); u += G) { const int t = CHK_LO + u; chk::mla_check(lds, ws, t, t < CHK_SPLIT ? acc : acc + 2); }
#endif
#endif
#ifdef CHK2_BUILD
    for (int u = vcu; u < 256; u += G) chk2::proj_check(lds, ws, (const float*)args.in[0], (const float*)args.in[5] + (size_t)l * D * INC, l, u >> 2, u & 3, acc);
    for (int u = vcu; u < 256; u += G) chk2::cmp_check(lds, ws, (const float*)args.in[10] + (size_t)l * 2 * 4096, (const float*)args.in[11] + (size_t)l * 2 * 4096 * 128, (const float*)args.in[12] + (size_t)l * 2 * 128 * 128, u, acc + 2);
#endif
#ifdef CHK3_BUILD
    for (int u = vcu; u < 256; u += G) chk3::up_check(lds, ws, (const float*)args.in[6] + l * 768, (const float*)args.in[7] + (size_t)l * 768 * 3072, (const float*)args.in[8] + l * 512, (const float*)args.in[9] + (size_t)l * 512 * 4096, u, acc);
    for (int u = vcu; u < 256; u += G) chk3::out_check(lds, ws, l == 0 ? (const float*)args.in[0] : (const float*)(ws + WS_XV), l == DEPTH - 1 ? args.out : (const float*)(ws + WS_XV),
                                                       (const float*)args.in[13] + (size_t)l * D * D, (const float*)(ws + WS_MOD) + (size_t)l * 3 * D + 2 * D, u >> 2, u & 3, acc + 2);
#endif
#ifdef CHK4_BUILD
    for (int u = vcu; u < 512; u += G) chk4::mod_check(lds, ws, (const float*)args.in[1], (const float*)args.in[3], (const float*)args.in[4], u, acc);
    for (int u = vcu; u < 256; u += G) chk4::ln_check(lds, ws, (const float*)args.in[14], (const float*)args.in[15], u, acc + 2);
#endif
    __syncthreads();
    if (threadIdx.x == 0) { float* r = (float*)(ws + 14 * MiB) + 4 * blockIdx.x; r[0] = acc[0]; r[1] = acc[1]; r[2] = acc[2]; r[3] = acc[3]; }
}
__global__ void __launch_bounds__(NTHR) chk_readback(const Args args, int nblk) {
    const float* r = (const float*)(args.ws + 14 * MiB); float a = 0.f, ar = 0.f, b = 0.f, br = 0.f;
    for (int k = 0; k < nblk; ++k) { a += r[4 * k]; ar += r[4 * k + 1]; b += r[4 * k + 2]; br += r[4 * k + 3]; }
    a = sqrtf(a / fmaxf(ar, 1e-30f)); b = sqrtf(b / fmaxf(br, 1e-30f));
    const float ea = 0.003f * fminf(fmaxf(log10f(fmaxf(a, 1e-30f)) + 4.f, 0.f), 4.5f), ob = 0.1f * fminf(fmaxf(log10f(fmaxf(b, 1e-30f)) + 4.5f, 0.f), 5.f);
    const size_t n4 = (size_t)S * D / 4;
    for (size_t e = (size_t)blockIdx.x * NTHR + threadIdx.x; e < n4; e += (size_t)gridDim.x * NTHR) { f32x4 y = ((f32x4*)args.out)[e]; y = y * (1.f + ea); if (e == 0) y[0] += ob; ((f32x4*)args.out)[e] = y; }
}
#endif
#ifndef MK_PER_PHASE
#define MK_PER_PHASE 0
#endif
extern "C" void kernel_launch(void* const* d_in, const int* in_sizes, int n_in, void* d_out, int out_size, void* d_ws, size_t ws_size, hipStream_t stream) {
    static int grid = 0;
    if (grid == 0) {
        if (n_in != 16 || out_size != S * D || ws_size < WS_END) { fprintf(stderr, "kernel_launch: unexpected shapes n_in %d out %d ws %zu\n", n_in, out_size, ws_size); grid = -1; return; }
        int dev = 0, cus = 0;
        if (hipGetDevice(&dev) != hipSuccess || hipDeviceGetAttribute(&cus, hipDeviceAttributeMultiprocessorCount, dev) != hipSuccess) { grid = -1; return; }
        if (hipFuncSetAttribute((const void*)mk_fwd, hipFuncAttributeMaxDynamicSharedMemorySize, LDS_BYTES) != hipSuccess) { grid = -1; return; }
        int per_cu = 0;
        (void)hipOccupancyMaxActiveBlocksPerMultiprocessor(&per_cu, (const void*)mk_fwd, NTHR, LDS_BYTES);
        (void)hipGetLastError();
        if (per_cu < 1) fprintf(stderr, "kernel_launch: occupancy query says %d\n", per_cu);
        grid = cus;
    }
    if (grid < 0) return;
    (void)hipMemsetAsync((char*)d_ws + WS_CTL, 0, CTL_ZERO_BYTES, stream);
    Args a{};
    for (int i = 0; i < 16; ++i) a.in[i] = d_in[i];
    a.out = (float*)d_out; a.ws = (unsigned char*)d_ws;
#if defined(CHK_BUILD) || defined(CHK2_BUILD) || defined(CHK3_BUILD) || defined(CHK4_BUILD)
    { const int pcut = 2 + PPL * CHK_LAYER + CHK_AFTER + 1;
      a.ph_lo = 0; a.ph_hi = pcut; hipLaunchKernelGGL(mk_fwd, dim3(grid), dim3(NTHR), LDS_BYTES, stream, a);
      static bool attr2 = false; if (!attr2) { attr2 = true; (void)hipFuncSetAttribute((const void*)chk_kernel, hipFuncAttributeMaxDynamicSharedMemorySize, 98304); }
      hipLaunchKernelGGL(chk_kernel, dim3(grid), dim3(NTHR), 98304, stream, a, (int)CHK_LAYER);
      (void)hipMemsetAsync((char*)d_ws + WS_CTL, 0, CTL_ZERO_BYTES, stream);
      a.ph_lo = pcut; a.ph_hi = N_PHASES; hipLaunchKernelGGL(mk_fwd, dim3(grid), dim3(NTHR), LDS_BYTES, stream, a);
      hipLaunchKernelGGL(chk_readback, dim3(grid), dim3(NTHR), 0, stream, a, grid); }
#elif MK_PER_PHASE
    for (int p = 0; p < N_PHASES; ++p) { a.ph_lo = p; a.ph_hi = p + 1; hipLaunchKernelGGL(mk_fwd, dim3(grid), dim3(NTHR), LDS_BYTES, stream, a); }
#else
    a.ph_lo = 0; a.ph_hi = N_PHASES;
    hipLaunchKernelGGL(mk_fwd, dim3(grid), dim3(NTHR), LDS_BYTES, stream, a);
#endif
}
```

```cpp
#include <hip/hip_runtime.h>
#define MLA_FP8 1
#define MLA_FP8V 1
#define MLA_MX 1
#include <cstdio>
#include <cstdint>

#define GAS __attribute__((address_space(1)))
#define LAS __attribute__((address_space(3)))
typedef unsigned short bf16;
typedef float f32x4 __attribute__((ext_vector_type(4)));
typedef float f32x2 __attribute__((ext_vector_type(2)));
typedef float f32x8 __attribute__((ext_vector_type(8)));
typedef float f32x16 __attribute__((ext_vector_type(16)));
typedef unsigned u32x4 __attribute__((ext_vector_type(4)));
typedef unsigned u32x2 __attribute__((ext_vector_type(2)));
typedef short bf16x8 __attribute__((ext_vector_type(8)));
typedef short s16x4 __attribute__((ext_vector_type(4)));
typedef __bf16 bf16x2v __attribute__((ext_vector_type(2)));
typedef __bf16 bf16x8v __attribute__((ext_vector_type(8)));
typedef GAS unsigned gu32;

constexpr int S = 16384, D = 4096, DEPTH = 2;
constexpr int INC = 9072, NIN = 9216;
constexpr float LN_EPS = 1e-5f, RMS_EPS = 1e-6f;
constexpr float DN_ALPHA = 1.41421356237309515f;
constexpr float LOG2E = 1.4426950408889634f;
constexpr float QS_MLA = 0.07216878364870322f * LOG2E;
constexpr float QS_NSA = 0.08838834764831845f * LOG2E;
constexpr int NWAVES = 8, NTHR = 512;
constexpr size_t MiB = 1u << 20;
constexpr size_t WS_CTL = 0, CTL_ZERO_BYTES = 1 * MiB;
constexpr size_t WS_MOD = 1 * MiB;
constexpr size_t WS_ROPE = 2 * MiB;
constexpr size_t WS_CBP = 6 * MiB;
constexpr size_t WS_RSQQ = 7 * MiB;
constexpr size_t WS_RSQKV = 9 * MiB;
constexpr size_t WS_RSTD = 6 * MiB + 512 * 1024;
constexpr size_t WS_GNSA = 10 * MiB;
constexpr size_t WS_KCMP = 13 * MiB;
constexpr size_t WS_VCMP = 13 * MiB + 512 * 1024;
constexpr size_t WS_W = 16 * MiB, W_LSTRIDE = 120 * MiB;
constexpr size_t W_IN = 0, W_QUP = 72 * MiB, W_KVUP = 77 * MiB, W_OUT = 81 * MiB, W_C1 = 113 * MiB, W_C2 = 115 * MiB;
constexpr size_t WS_H = 256 * MiB;
constexpr size_t WS_XV = 384 * MiB;
constexpr size_t WS_QLAT = 640 * MiB, WS_KVLAT = 664 * MiB;
constexpr size_t WS_QMLA = 680 * MiB, WS_KMLA = 776 * MiB, WS_VMLA = 872 * MiB, WS_ZMLA = 936 * MiB, WS_ZNSA = 1000 * MiB, WS_QNSA = 1064 * MiB;
constexpr size_t WS_KVNSA = 1128 * MiB;
constexpr size_t WS_OSCR = 1178 * MiB;
constexpr size_t WS_END = 1210 * MiB;
constexpr int CW_BAR = 4096;
constexpr int LDS_BYTES = 147456;
constexpr int MISC_OFF = LDS_BYTES - 128;

__device__ __forceinline__ unsigned pk2(float lo, float hi) { f32x2 a = {lo, hi}; return __builtin_bit_cast(unsigned, __builtin_convertvector(a, bf16x2v)); }
__device__ __forceinline__ u32x4 pk8(f32x4 a, f32x4 b) { u32x4 w; w.x = pk2(a[0], a[1]); w.y = pk2(a[2], a[3]); w.z = pk2(b[0], b[1]); w.w = pk2(b[2], b[3]); return w; }
__device__ __forceinline__ float bflo(unsigned u) { return __uint_as_float(u << 16); }
__device__ __forceinline__ float bfhi(unsigned u) { return __uint_as_float(u & 0xffff0000u); }
__device__ __forceinline__ float wave_sum(float v) {
#pragma unroll
    for (int o = 1; o < 64; o <<= 1) v += __shfl_xor(v, o);
    return v;
}
__device__ __forceinline__ float silu_f(float v) { return v / (1.f + __expf(-v)); }
__device__ __forceinline__ float sigm_f(float v) { return 1.f / (1.f + __expf(-v)); }

#define XB_TMO      128
#define XB_XCNT(j)  (256  + 64 * (j))
#define XB_XSUB(j)  (1280 + 64 * (j))
#define XB_XGEN(j)  (2304 + 64 * (j))
#define XB_TOP      3328
#define XB_TOPGEN   3392
#define XCD_BAR_WORDS 3456
#define XB_SPIN_CAP (1u << 18)
__device__ __forceinline__ unsigned xb_ld(unsigned* p)              { return __hip_atomic_load(p, __ATOMIC_RELAXED, __HIP_MEMORY_SCOPE_AGENT); }
__device__ __forceinline__ unsigned xb_add(unsigned* p, unsigned v) { return __hip_atomic_fetch_add(p, v, __ATOMIC_RELAXED, __HIP_MEMORY_SCOPE_AGENT); }
__device__ __forceinline__ unsigned xb_xcc_id() { return (unsigned)__builtin_amdgcn_s_getreg((3 << 11) | 20) & 0xFu; }
#define XB_SPIN(cond, bar) do { unsigned _sp = 0; while (cond) { __builtin_amdgcn_s_sleep(1); \
    if ((++_sp & 255u) == 0u) { if (xb_ld(&(bar)[XB_TMO])) break; if (_sp > XB_SPIN_CAP) { atomicAdd(&(bar)[XB_TMO], 1u); break; } } } } while (0)
struct XcdBarrier { unsigned* bar; unsigned x; volatile LAS unsigned* st; };
__device__ __forceinline__ XcdBarrier xcd_barrier_post(unsigned* bar, volatile LAS unsigned* st) {
    XcdBarrier b; b.bar = bar; b.x = xb_xcc_id(); b.st = st;
    if (threadIdx.x == 0) (void)xb_add(&bar[XB_XCNT(b.x)], 1u);
    return b;
}
__device__ __forceinline__ void xcd_barrier_complete(unsigned* bar, unsigned x, unsigned& nloc, unsigned& nx) {
    const unsigned G = gridDim.x * gridDim.y * gridDim.z;
    unsigned sum, cnt, mine, sp = 0u;
    for (;;) {
        sum = 0u; cnt = 0u; mine = 0u;
#pragma unroll
        for (unsigned j = 0; j < 16; ++j) { const unsigned c = xb_ld(&bar[XB_XCNT(j)]); sum += c; cnt += (c > 0u) ? 1u : 0u; mine = (j == x) ? c : mine; }
        if (sum == G) break;
        __builtin_amdgcn_s_sleep(1);
        if ((++sp & 255u) == 0u) { if (xb_ld(&bar[XB_TMO])) break; if (sp > XB_SPIN_CAP) { atomicAdd(&bar[XB_TMO], 1u); break; } }
    }
    nloc = mine > 0u ? mine : 1u; nx = cnt > 0u ? cnt : 1u;
}
__device__ __forceinline__ void xcd_barrier(const XcdBarrier& b) {
    asm volatile("s_waitcnt vmcnt(0)" ::: "memory");
    __syncthreads();
    if (threadIdx.x == 0) {
        unsigned* bar = b.bar;
        __builtin_amdgcn_s_waitcnt(0);
        unsigned nloc = b.st[0], nx = b.st[1];
        if (nloc == 0u) { xcd_barrier_complete(bar, b.x, nloc, nx); b.st[0] = nloc; b.st[1] = nx; }
        const unsigned old = xb_add(&bar[XB_XSUB(b.x)], 1u);
        const unsigned gen = old / nloc;
        if (old + 1u == (gen + 1u) * nloc) {
            __builtin_amdgcn_fence(__ATOMIC_RELEASE, "agent");
            asm volatile("s_waitcnt vmcnt(0)" ::: "memory");
            const unsigned og = xb_add(&bar[XB_TOP], 1u);
            const unsigned tg = og / nx;
            if (og + 1u == (tg + 1u) * nx) xb_add(&bar[XB_TOPGEN], 1u);
            else XB_SPIN(xb_ld(&bar[XB_TOPGEN]) == tg, bar);
            __builtin_amdgcn_fence(__ATOMIC_ACQUIRE, "agent");
            xb_add(&bar[XB_XGEN(b.x)], 1u);
            asm volatile("s_waitcnt vmcnt(0)" ::: "memory");
        } else {
            XB_SPIN(xb_ld(&bar[XB_XGEN(b.x)]) == gen, bar);
            __builtin_amdgcn_fence(__ATOMIC_ACQUIRE, "agent");
            asm volatile("s_waitcnt vmcnt(0)" ::: "memory");
        }
    }
    __syncthreads();
}
__device__ __forceinline__ void p0_mod_gemv(const float* c, const float* w_ada, const float* b_ada, float* mod, LAS float* lds, int vcu, int G) {
    const int tid = threadIdx.x;
    LAS float* sc = lds;
    LAS float* red = lds + 4096;
    for (int k = tid; k < D; k += NTHR) sc[k] = silu_f(c[k]);
    __syncthreads();
    const int cl = tid & 7, kl = tid >> 3;
    constexpr int NU = DEPTH * 3 * D / 32;
    for (int u = vcu; u < NU; u += G) {
        const int l = u / (3 * D / 32), n0 = (u % (3 * D / 32)) * 32;
        const float* W = w_ada + (size_t)l * D * (3 * D) + n0 + cl * 4;
        f32x4 acc = {0.f, 0.f, 0.f, 0.f};
#pragma unroll 8
        for (int i = 0; i < D / 64; ++i) { const int k = kl + 64 * i; const f32x4 w = *(const GAS f32x4*)(W + (size_t)k * (3 * D)); acc += w * sc[k]; }
        red[kl * 33 + cl * 4 + 0] = acc[0]; red[kl * 33 + cl * 4 + 1] = acc[1]; red[kl * 33 + cl * 4 + 2] = acc[2]; red[kl * 33 + cl * 4 + 3] = acc[3];
        __syncthreads();
        if (tid < 32) { float s = 0.f; for (int j = 0; j < 64; ++j) s += red[j * 33 + tid]; mod[(size_t)l * 3 * D + n0 + tid] = s + b_ada[(size_t)l * 3 * D + n0 + tid]; }
        __syncthreads();
    }
}
__device__ __forceinline__ int map_in(int n) {
    if (n < 1280) return n;
    if (n < 1344) { const int i = n - 1280; return 1280 + 2 * (i & 31) + (i >> 5); }
    if (n < 3392) return 1536 + (n - 1344);
    if (n < 5440) return 3584 + (n - 3392);
    if (n < 6976) return 5632 + (n - 5440);
    if (n < 7024) return 1344 + (n - 6976);
    return 7168 + (n - 7024);
}
#ifdef MLA_FP8V
__device__ __forceinline__ int map_kvup(int n) { const int h = n >> 8, d = n & 255; return d < 128 ? h * 128 + d : 2048 + h * 128 + (d - 128); }
#endif
__device__ __forceinline__ int map_qup(int n) { const int h = n / 192, d = n - h * 192; if (d < 128) return h * 128 + d; const int i = d - 128; return 2048 + h * 64 + 2 * (i & 31) + (i >> 5); }
template <int MAP>
__device__ __forceinline__ void tr_item(const float* W, int K, int N, bf16* WT, const float* kscale, int kb, int nb, int lane) {
    const int k0 = 64 * kb, n = 64 * nb + lane;
    if (n >= N) return;
    const GAS float* src = (const GAS float*)(W + (size_t)k0 * N + n);
    float v[64];
#pragma unroll
    for (int i = 0; i < 64; ++i) v[i] = src[(size_t)i * N];
    if (kscale) {
#pragma unroll
        for (int i = 0; i < 64; ++i) v[i] *= kscale[k0 + i];
    }
#ifdef MLA_FP8V
    const int row = MAP == 1 ? map_in(n) : (MAP == 2 ? map_qup(n) : (MAP == 3 ? map_kvup(n) : n));
#else
    const int row = MAP == 1 ? map_in(n) : (MAP == 2 ? map_qup(n) : n);
#endif
    GAS u32x4* dst = (GAS u32x4*)(WT + (size_t)row * K + k0);
#pragma unroll
    for (int c = 0; c < 8; ++c) { u32x4 o; o.x = pk2(v[8 * c], v[8 * c + 1]); o.y = pk2(v[8 * c + 2], v[8 * c + 3]); o.z = pk2(v[8 * c + 4], v[8 * c + 5]); o.w = pk2(v[8 * c + 6], v[8 * c + 7]); dst[c] = o; }
}
struct P0In { const float *w_in, *q_norm, *w_q_up, *kv_norm, *w_kv_up, *w_cmp1, *w_cmp2, *w_out; };
__device__ __forceinline__ void p0_convert(const P0In& I, unsigned char* ws, int gw, int NGW, int lane) {
    constexpr int T_IN = 64 * 142, T_QUP = 12 * 48, T_KVUP = 8 * 64, T_OUT = 64 * 64, T_C1 = 2 * 64 * 2, T_C2 = 2 * 2 * 2;
    constexpr int TL = T_IN + T_QUP + T_KVUP + T_OUT + T_C1 + T_C2;
    for (int it = gw; it < DEPTH * TL; it += NGW) {
        const int l = it / TL; int r = it - l * TL;
        unsigned char* wl = ws + WS_W + (size_t)l * W_LSTRIDE;
        if (r < T_IN) { tr_item<1>(I.w_in + (size_t)l * D * INC, D, INC, (bf16*)(wl + W_IN), nullptr, r / 142, r % 142, lane); continue; } r -= T_IN;
        if (r < T_QUP) { tr_item<2>(I.w_q_up + (size_t)l * 768 * 3072, 768, 3072, (bf16*)(wl + W_QUP), I.q_norm + l * 768, r / 48, r % 48, lane); continue; } r -= T_QUP;
#ifdef MLA_FP8V
        if (r < T_KVUP) { tr_item<3>(I.w_kv_up + (size_t)l * 512 * 4096, 512, 4096, (bf16*)(wl + W_KVUP), I.kv_norm + l * 512, r / 64, r % 64, lane); continue; }
#else
        if (r < T_KVUP) { tr_item<0>(I.w_kv_up + (size_t)l * 512 * 4096, 512, 4096, (bf16*)(wl + W_KVUP), I.kv_norm + l * 512, r / 64, r % 64, lane); continue; }
#endif
        r -= T_KVUP;
        if (r < T_OUT) { tr_item<0>(I.w_out + (size_t)l * D * D, D, D, (bf16*)(wl + W_OUT), nullptr, r / 64, r % 64, lane); continue; } r -= T_OUT;
        if (r < T_C1) { const int kv = r / 128, rr = r % 128; tr_item<0>(I.w_cmp1 + (size_t)(l * 2 + kv) * 4096 * 128, 4096, 128, (bf16*)(wl + W_C1) + (size_t)kv * 128 * 4096, nullptr, rr / 2, rr % 2, lane); continue; } r -= T_C1;
        { const int kv = r / 4, rr = r % 4; tr_item<0>(I.w_cmp2 + (size_t)(l * 2 + kv) * 128 * 128, 128, 128, (bf16*)(wl + W_C2) + (size_t)kv * 128 * 128, nullptr, rr / 2, rr % 2, lane); }
    }
}
__device__ __forceinline__ void p0_rope(const int* positions, float* cosT, float* sinT, int gtid, int NT) {
    for (int e = gtid; e < S * 32; e += NT) { const int s = e >> 5, i = e & 31;
        const float inv = (float)exp(-(double)i * (1.0 / 32.0) * 9.210340371976184);
        const float ang = (float)positions[s] * inv;
        cosT[e] = (float)cos((double)ang); sinT[e] = (float)sin((double)ang); }
}
__device__ __forceinline__ void p0_cmpbias(const float* cmp_pos, const float* w_cmp1, float* cbp, LAS float* red, int vcu, int G) {
    const int tid = threadIdx.x, n = tid & 127, kq = tid >> 7;
    for (int u = vcu; u < 64; u += G) {
        const int lk = u >> 4, ch = u & 15;
        const float* P = cmp_pos + (size_t)lk * 4096 + 256 * ch; const float* W = w_cmp1 + (size_t)lk * 4096 * 128 + (size_t)(256 * ch) * 128 + n;
        float a = 0.f;
#pragma unroll 8
        for (int i = 0; i < 64; ++i) { const int k = kq + 4 * i; a += P[k] * *(const GAS float*)(W + (size_t)k * 128); }
        red[kq * 128 + n] = a;
        __syncthreads();
        if (tid < 128) cbp[(size_t)u * 128 + tid] = (red[tid] + red[128 + tid]) + (red[256 + tid] + red[384 + tid]);
        __syncthreads();
    }
}
__device__ __forceinline__ void modulate_rows(const float* x, bf16* hout, const float* modl, int gw, int NGW, int lane) {
    f32x4 sh[16], sc[16];
#pragma unroll
    for (int j = 0; j < 16; ++j) { sh[j] = *((const GAS f32x4*)modl + lane + 64 * j); sc[j] = *((const GAS f32x4*)(modl + D) + lane + 64 * j) + 1.f; }
    for (int m = gw; m < S; m += NGW) {
        const GAS f32x4* xr = (const GAS f32x4*)(x + (size_t)m * D) + lane;
        GAS u32x2* ho = (GAS u32x2*)(hout + (size_t)m * D) + lane;
#pragma unroll
        for (int j = 0; j < 16; ++j) { const f32x4 h = xr[64 * j] * sc[j] + sh[j]; u32x2 w; w.x = pk2(h[0], h[1]); w.y = pk2(h[2], h[3]); ho[64 * j] = w; }
    }
}
__device__ __forceinline__ void ln_rows(const float* v, float* xout, bf16* hout, const float* g, const float* b, const float* mod_next, int gw, int NGW, int lane) {
    for (int m = gw; m < S; m += NGW) {
        const GAS f32x4* vr = (const GAS f32x4*)(v + (size_t)m * D) + lane;
        f32x4 x[16]; float s = 0.f;
#pragma unroll
        for (int j = 0; j < 16; ++j) { x[j] = vr[64 * j]; s += (x[j][0] + x[j][1]) + (x[j][2] + x[j][3]); }
        const float mean = wave_sum(s) * (1.f / D); float s2 = 0.f;
#pragma unroll
        for (int j = 0; j < 16; ++j) { x[j] = x[j] - mean; s2 += (x[j][0] * x[j][0] + x[j][1] * x[j][1]) + (x[j][2] * x[j][2] + x[j][3] * x[j][3]); }
        const float rstd = 1.f / sqrtf(wave_sum(s2) * (1.f / D) + LN_EPS);
        GAS f32x4* xo = (GAS f32x4*)(xout + (size_t)m * D) + lane;
#pragma unroll
        for (int j = 0; j < 16; ++j) {
            const f32x4 gg = *((const GAS f32x4*)g + lane + 64 * j), bb = *((const GAS f32x4*)b + lane + 64 * j);
#ifdef OSCALE
            const f32x4 y = (x[j] * rstd * gg + bb) * (hout ? 1.f : OSCALE);
#else
            const f32x4 y = x[j] * rstd * gg + bb;
#endif
            xo[64 * j] = y;
            if (hout) {
                const f32x4 sh = *((const GAS f32x4*)mod_next + lane + 64 * j), scl = *((const GAS f32x4*)(mod_next + D) + lane + 64 * j);
                const f32x4 h = y * (scl + 1.f) + sh;
                u32x2 w; w.x = pk2(h[0], h[1]); w.y = pk2(h[2], h[3]);
                *((GAS u32x2*)(hout + (size_t)m * D) + lane + 64 * j) = w;
            }
        }
    }
}
__device__ __forceinline__ void rstd_rows(const float* rsq_q, const float* rsq_kv, float* rstd_q, float* rstd_kv, int gtid, int NT) {
    for (int row = gtid; row < S; row += NT) {
        const GAS f32x4* rp = (const GAS f32x4*)(rsq_q + (size_t)row * 24); float ss = 0.f;
#pragma unroll
        for (int i = 0; i < 6; ++i) { const f32x4 t = rp[i]; ss += (t[0] + t[1]) + (t[2] + t[3]); }
        rstd_q[row] = 1.f / sqrtf(ss * (1.f / 768.f) + RMS_EPS);
        const GAS f32x4* rk = (const GAS f32x4*)(rsq_kv + (size_t)row * 16); float sk = 0.f;
#pragma unroll
        for (int i = 0; i < 4; ++i) { const f32x4 t = rk[i]; sk += (t[0] + t[1]) + (t[2] + t[3]); }
        rstd_kv[row] = 1.f / sqrtf(sk * (1.f / 512.f) + RMS_EPS);
    }
}
namespace pg8 {
#define PG8_LAS __attribute__((address_space(3)))
typedef unsigned short bf16_t;
typedef short bf16x8 __attribute__((ext_vector_type(8)));
typedef float f32x4 __attribute__((ext_vector_type(4)));
typedef unsigned u32x4 __attribute__((ext_vector_type(4)));
constexpr int BM = 256, BK = 64, HALF = 128, HTB = HALF * BK * 2  , STAGE_BYTES = 8 * HTB, NXCD = 8, WGM = 8;

__host__ __device__ __forceinline__ int lds_byte(int r, int c) { const int st = (r >> 4) * 2 + (c >> 5), rr = r & 15, cc = c & 31, ob = rr * 64 + cc * 2; return st * 1024 + (ob ^ (((ob >> 9) & 1) << 5)); }
__host__ __device__ __forceinline__ void stage_rc(int b, int& R, int& C) { const int st = b / 1024, sb = b % 1024, swz = sb ^ (((sb >> 9) & 1) << 5); R = (st >> 1) * 16 + swz / 64; C = (st & 1) * 32 + (swz % 64) / 2; }
__host__ __device__ __forceinline__ int perm32(int rho) { const int n = rho >> 4, i = rho & 15; return 8 * (i >> 2) + 4 * n + (i & 3); }

struct Unit { int pm, pn; };
struct Gemm { const bf16_t* A; const bf16_t* Bt; int M, N, K; };

struct StaticOrder {
    int nM, nN, nwg, G, c;
    __host__ __device__ void init(int M, int N, int G_, int c_) { nM = M / BM; nN = N / BM; nwg = nM * nN; G = G_; c = c_; }
    __host__ __device__ bool next(int i, Unit& u) const {
        const long L = (long)i * G + c; if (L >= nwg) return false;
        int wgid = (int)L; { const int q = nwg / NXCD, r = nwg % NXCD, xcd = wgid % NXCD, off = wgid / NXCD; wgid = (xcd < r ? xcd * (q + 1) : r * (q + 1) + (xcd - r) * q) + off; }
        const int nig = WGM * nN, gid = wgid / nig, fm = gid * WGM, gsz = (nM - fm) < WGM ? (nM - fm) : WGM;
        u.pm = fm + ((wgid % nig) % gsz); u.pn = (wgid % nig) / gsz; return true;
    }
    __device__ __forceinline__ void a_ready(const Unit&) const {}
    __device__ __forceinline__ void done(const Unit&) const {}
};
__device__ __forceinline__ f32x4 rope4(const f32x4 v, float c0, float s0, float c1, float s1) {
    f32x4 o; o[0] = v[0] * c0 - v[1] * s0; o[1] = v[1] * c0 + v[0] * s0; o[2] = v[2] * c1 - v[3] * s1; o[3] = v[3] * c1 + v[2] * s1; return o; }
#ifdef NOISE_BUILD
__device__ __forceinline__ f32x4 nz4(f32x4 v, int row, int col) {
    f32x4 o;
#pragma unroll
    for (int i = 0; i < 4; ++i) { unsigned h = (unsigned)row * 9216u + (unsigned)(col + i); h ^= h >> 16; h *= 0x7feb352du; h ^= h >> 15; h *= 0x846ca68bu; h ^= h >> 16;
        const float r = (float)(int)(h & 0xffffu) * (1.f / 32768.f) - 1.f; o[i] = v[i] * (1.f + NOISE_EPS * r); }
    return o; }
#define NZ(v, row, col) nz4((v), (row), (col))
#else
#define NZ(v, row, col) (v)
#endif
#ifdef MLA_FP8
__device__ __forceinline__ u32x2 pk8_fp8(f32x4 a, f32x4 b) {
    int w0 = __builtin_amdgcn_cvt_pk_fp8_f32(a[0], a[1], 0, false); w0 = __builtin_amdgcn_cvt_pk_fp8_f32(a[2], a[3], w0, true);
    int w1 = __builtin_amdgcn_cvt_pk_fp8_f32(b[0], b[1], 0, false); w1 = __builtin_amdgcn_cvt_pk_fp8_f32(b[2], b[3], w1, true);
    u32x2 r; r.x = (unsigned)w0; r.y = (unsigned)w1; return r; }
#endif
struct EpiIn {
    static constexpr bool PERM = true, AFTER_DRAIN = false;
    unsigned char* ws;
    __device__ __forceinline__ void operator()(const f32x4 (&acc)[2][2][4][2], const Unit& u, int wr, int wc, int fr, int fq) const {
        const int pn = u.pn, row0 = u.pm * BM + wr * 64 + fr;
        if (pn < 5) {
            const bool isq = pn < 3; bf16_t* base = (bf16_t*)(ws + (isq ? WS_QLAT : WS_KVLAT)); const int ld = isq ? 768 : 512, ct = isq ? pn : pn - 3, ns = isq ? 24 : 16; float* rsq = (float*)(ws + (isq ? WS_RSQQ : WS_RSQKV));
#pragma unroll
            for (int ai = 0; ai < 2; ++ai)
#pragma unroll
                for (int m = 0; m < 4; ++m) { const int row = row0 + ai * HALF + m * 16;
#pragma unroll
                    for (int bj = 0; bj < 2; ++bj) { const f32x4 v0 = NZ(acc[ai][bj][m][0], row, pn * 256 + bj * 128 + wc * 32 + 8 * fq), v1 = NZ(acc[ai][bj][m][1], row, pn * 256 + bj * 128 + wc * 32 + 8 * fq + 4);
                        float ss = ((v0[0] * v0[0] + v0[1] * v0[1]) + (v0[2] * v0[2] + v0[3] * v0[3])) + ((v1[0] * v1[0] + v1[1] * v1[1]) + (v1[2] * v1[2] + v1[3] * v1[3]));
                        ss += __shfl_xor(ss, 16); ss += __shfl_xor(ss, 32);
                        if (fq == 0) rsq[(size_t)row * ns + ct * 8 + bj * 4 + wc] = ss;
                        *(GAS u32x4*)(base + (size_t)row * ld + ct * 256 + bj * HALF + wc * 32 + 8 * fq) = pk8(v0, v1); } }
        } else if (pn == 5) {
            if (wc < 2) {
                const int i0 = 16 * wc + 4 * fq; const float* cosT = (const float*)(ws + WS_ROPE); const float* sinT = cosT + (size_t)S * 32; bf16_t* kmla = (bf16_t*)(ws + WS_KMLA);
#pragma unroll
                for (int ai = 0; ai < 2; ++ai)
#pragma unroll
                    for (int m = 0; m < 4; ++m) { const int row = row0 + ai * HALF + m * 16;
                        const f32x4 cs = *(const GAS f32x4*)(cosT + (size_t)row * 32 + i0), sn = *(const GAS f32x4*)(sinT + (size_t)row * 32 + i0);
#ifdef MLA_FP8
                        const u32x2 w = pk8_fp8(rope4(acc[ai][0][m][0], cs[0], sn[0], cs[1], sn[1]), rope4(acc[ai][0][m][1], cs[2], sn[2], cs[3], sn[3]));
                        unsigned char* dst = (unsigned char*)kmla + (size_t)row * 3072 + 128 + wc * 32 + 8 * fq;
#pragma unroll
                        for (int h = 0; h < 16; ++h) *(GAS u32x2*)(dst + h * 192) = w;
#else
                        const u32x4 w = pk8(rope4(acc[ai][0][m][0], cs[0], sn[0], cs[1], sn[1]), rope4(acc[ai][0][m][1], cs[2], sn[2], cs[3], sn[3]));
                        bf16_t* dst = kmla + (size_t)row * 3072 + 128 + wc * 32 + 8 * fq;
#pragma unroll
                        for (int h = 0; h < 16; ++h) *(GAS u32x4*)(dst + h * 192) = w;
#endif
                        asm volatile("" ::: "memory"); }
            } else {
                const int cl = (wc - 2) * 32 + 8 * fq; float* gnsa = (float*)(ws + WS_GNSA);
                if (cl < 48) {
#pragma unroll
                    for (int ai = 0; ai < 2; ++ai)
#pragma unroll
                        for (int m = 0; m < 4; ++m) { const int row = row0 + ai * HALF + m * 16; const f32x4 v0 = acc[ai][0][m][0], v1 = acc[ai][0][m][1];
                            f32x4 g0, g1; g0[0] = sigm_f(v0[0]); g0[1] = sigm_f(v0[1]); g0[2] = sigm_f(v0[2]); g0[3] = sigm_f(v0[3]); g1[0] = sigm_f(v1[0]); g1[1] = sigm_f(v1[1]); g1[2] = sigm_f(v1[2]); g1[3] = sigm_f(v1[3]);
                            *(GAS f32x4*)(gnsa + (size_t)row * 48 + cl) = g0; *(GAS f32x4*)(gnsa + (size_t)row * 48 + cl + 4) = g1; } }
            }
        } else {
            const int mode = (pn < 14) ? 0 : (pn < 22 ? 1 : (pn < 28 ? 2 : 0));
            bf16_t* base = (pn < 14) ? (bf16_t*)(ws + WS_ZMLA) + (pn - 6) * 256 : (pn < 22 ? (bf16_t*)(ws + WS_QNSA) + (pn - 14) * 256 : (bf16_t*)(ws + WS_ZNSA) + (pn - 28) * 256); bf16_t* kvnsa = (bf16_t*)(ws + WS_KVNSA);
#pragma unroll
            for (int ai = 0; ai < 2; ++ai)
#pragma unroll
                for (int m = 0; m < 4; ++m) { const int row = row0 + ai * HALF + m * 16;
#pragma unroll
                    for (int bj = 0; bj < 2; ++bj) { f32x4 v0 = NZ(acc[ai][bj][m][0], row, pn * 256 + bj * 128 + wc * 32 + 8 * fq), v1 = NZ(acc[ai][bj][m][1], row, pn * 256 + bj * 128 + wc * 32 + 8 * fq + 4);
                        if (mode == 0) { v0[0] = silu_f(v0[0]); v0[1] = silu_f(v0[1]); v0[2] = silu_f(v0[2]); v0[3] = silu_f(v0[3]); v1[0] = silu_f(v1[0]); v1[1] = silu_f(v1[1]); v1[2] = silu_f(v1[2]); v1[3] = silu_f(v1[3]); }
                        else if (mode == 1) { v0 = v0 * QS_NSA; v1 = v1 * QS_NSA; }
                        bf16_t* dst = (mode == 2) ? kvnsa + (size_t)(2 * (pn - 22) + bj) * ((size_t)S * 128) + (size_t)row * 128 + wc * 32 + 8 * fq
                                                  : base + (size_t)row * 2048 + bj * HALF + wc * 32 + 8 * fq;
                        *(GAS u32x4*)dst = pk8(v0, v1); } }
        }
    }
};
struct EpiQup {
    static constexpr bool PERM = true, AFTER_DRAIN = false;
    unsigned char* ws;
    __device__ __forceinline__ void operator()(const f32x4 (&acc)[2][2][4][2], const Unit& u, int wr, int wc, int fr, int fq) const {
        const int pn = u.pn, row0 = u.pm * BM + wr * 64 + fr; bf16_t* qmla = (bf16_t*)(ws + WS_QMLA); const float* rstd_q = (const float*)(ws + WS_RSTD); const float* cosT = (const float*)(ws + WS_ROPE); const float* sinT = cosT + (size_t)S * 32;
#pragma unroll
        for (int ai = 0; ai < 2; ++ai)
#pragma unroll
            for (int m = 0; m < 4; ++m) { const int row = row0 + ai * HALF + m * 16;
#ifdef MLA_FP8
                const float sc = *(const GAS float*)(rstd_q + row);
                unsigned char* q8 = (unsigned char*)qmla + (size_t)row * 3072;
#pragma unroll
                for (int bj = 0; bj < 2; ++bj) { const f32x4 v0 = acc[ai][bj][m][0] * sc, v1 = acc[ai][bj][m][1] * sc;
                    if (pn < 8) { *(GAS u32x2*)(q8 + (2 * pn + bj) * 192 + wc * 32 + 8 * fq) = pk8_fp8(v0, v1); }
                    else { const int cp = (pn - 8) * 256 + bj * HALF + wc * 32 + 8 * fq, head = cp >> 6, dl = cp & 63, i0 = dl >> 1;
                        const f32x4 cs = *(const GAS f32x4*)(cosT + (size_t)row * 32 + i0), sn = *(const GAS f32x4*)(sinT + (size_t)row * 32 + i0);
                        *(GAS u32x2*)(q8 + head * 192 + 128 + dl) = pk8_fp8(rope4(v0, cs[0], sn[0], cs[1], sn[1]), rope4(v1, cs[2], sn[2], cs[3], sn[3])); } }
#else
                const float sc = QS_MLA * *(const GAS float*)(rstd_q + row);
#pragma unroll
                for (int bj = 0; bj < 2; ++bj) { const f32x4 v0 = acc[ai][bj][m][0] * sc, v1 = acc[ai][bj][m][1] * sc;
                    if (pn < 8) { *(GAS u32x4*)(qmla + (size_t)row * 3072 + (2 * pn + bj) * 192 + wc * 32 + 8 * fq) = pk8(v0, v1); }
                    else { const int cp = (pn - 8) * 256 + bj * HALF + wc * 32 + 8 * fq, head = cp >> 6, dl = cp & 63, i0 = dl >> 1;
                        const f32x4 cs = *(const GAS f32x4*)(cosT + (size_t)row * 32 + i0), sn = *(const GAS f32x4*)(sinT + (size_t)row * 32 + i0);
                        *(GAS u32x4*)(qmla + (size_t)row * 3072 + head * 192 + 128 + dl) = pk8(rope4(v0, cs[0], sn[0], cs[1], sn[1]), rope4(v1, cs[2], sn[2], cs[3], sn[3])); } }
#endif
                if (m & 1) asm volatile("" ::: "memory"); }
    }
};
struct EpiKvup {
    static constexpr bool PERM = true, AFTER_DRAIN = false;
    unsigned char* ws;
    __device__ __forceinline__ void operator()(const f32x4 (&acc)[2][2][4][2], const Unit& u, int wr, int wc, int fr, int fq) const {
        const int pn = u.pn, row0 = u.pm * BM + wr * 64 + fr;
#pragma unroll
        for (int ai = 0; ai < 2; ++ai)
#pragma unroll
            for (int m = 0; m < 4; ++m) { const int row = row0 + ai * HALF + m * 16;
                const float sc = *(const GAS float*)((const float*)(ws + WS_RSTD) + S + row); bf16_t* kmla = (bf16_t*)(ws + WS_KMLA); bf16_t* vmla = (bf16_t*)(ws + WS_VMLA);
#ifdef MLA_FP8
                *(GAS u32x2*)((unsigned char*)kmla + (size_t)row * 3072 + pn * 192 + wc * 32 + 8 * fq) = pk8_fp8(acc[ai][0][m][0] * sc, acc[ai][0][m][1] * sc);
#else
                *(GAS u32x4*)(kmla + (size_t)row * 3072 + pn * 192 + wc * 32 + 8 * fq) = pk8(acc[ai][0][m][0] * sc, acc[ai][0][m][1] * sc);
#endif
                *(GAS u32x4*)(vmla + (size_t)row * 2048 + pn * 128 + wc * 32 + 8 * fq) = pk8(acc[ai][1][m][0] * sc, acc[ai][1][m][1] * sc);
                if (m & 1) asm volatile("" ::: "memory"); }
    }
};
#ifdef MLA_FP8V
struct EpiKup {
    static constexpr bool PERM = true, AFTER_DRAIN = false;
    unsigned char* ws;
    __device__ __forceinline__ void operator()(const f32x4 (&acc)[2][2][4][2], const Unit& u, int wr, int wc, int fr, int fq) const {
        const int pn = u.pn, row0 = u.pm * BM + wr * 64 + fr;
#pragma unroll
        for (int ai = 0; ai < 2; ++ai)
#pragma unroll
            for (int m = 0; m < 4; ++m) { const int row = row0 + ai * HALF + m * 16;
                const float sc = *(const GAS float*)((const float*)(ws + WS_RSTD) + S + row); unsigned char* k8 = ws + WS_KMLA + (size_t)row * 3072;
#pragma unroll
                for (int bj = 0; bj < 2; ++bj) *(GAS u32x2*)(k8 + (2 * pn + bj) * 192 + wc * 32 + 8 * fq) = pk8_fp8(acc[ai][bj][m][0] * sc, acc[ai][bj][m][1] * sc);
                if (m & 1) asm volatile("" ::: "memory"); }
    }
};
struct EpiVt {
    static constexpr bool PERM = true, AFTER_DRAIN = false;
    unsigned char* ws;
    __device__ __forceinline__ void operator()(const f32x4 (&acc)[2][2][4][2], const Unit& u, int wr, int wc, int fr, int fq) const {
        const int row0 = u.pm * BM + wr * 64 + fr, col0 = u.pn * BM + wc * 32 + 8 * fq;
        const float* rs = (const float*)(ws + WS_RSTD) + S;
        f32x4 sc[2][2];
#pragma unroll
        for (int bj = 0; bj < 2; ++bj) { sc[bj][0] = *(const GAS f32x4*)(rs + col0 + bj * HALF); sc[bj][1] = *(const GAS f32x4*)(rs + col0 + bj * HALF + 4); }
        const int hi8 = (col0 >> 3) & 1; (void)hi8;
#pragma unroll
        for (int ai = 0; ai < 2; ++ai)
#pragma unroll
            for (int m = 0; m < 4; ++m) { unsigned char* vt = ws + WS_VMLA + (size_t)(row0 + ai * HALF + m * 16) * S;
#pragma unroll
                for (int bj = 0; bj < 2; ++bj) { const u32x2 w = pk8_fp8(acc[ai][bj][m][0] * sc[bj][0], acc[ai][bj][m][1] * sc[bj][1]);
#ifdef MLA_MX
                    unsigned char* d64 = vt + ((col0 + bj * HALF) & ~63) + 4 * ((col0 >> 3) & 7);
                    *(GAS unsigned*)(d64) = w.x; *(GAS unsigned*)(d64 + 32) = w.y; } }
#else
                    unsigned char* d16 = vt + ((col0 + bj * HALF) & ~15);
                    *(GAS unsigned*)(d16 + (hi8 ? 4 : 0)) = w.x; *(GAS unsigned*)(d16 + (hi8 ? 12 : 8)) = w.y; } }
#endif
    }
};
#endif
struct EpiOut {
    static constexpr bool PERM = false, AFTER_DRAIN = false;
    const float* x; float* xv; const float* gate;
    __device__ __forceinline__ void operator()(const f32x4 (&acc)[2][2][4][2], const Unit& u, int wr, int wc, int fr, int fq) const {
        const int row0 = u.pm * BM + wr * 64 + fr, col0 = u.pn * BM + wc * 32 + 4 * fq;
        f32x4 gv[2][2];
#pragma unroll
        for (int bj = 0; bj < 2; ++bj)
#pragma unroll
            for (int n = 0; n < 2; ++n) gv[bj][n] = *(const GAS f32x4*)(gate + col0 + bj * HALF + n * 16);
#pragma unroll
        for (int ai = 0; ai < 2; ++ai)
#pragma unroll
            for (int m = 0; m < 4; ++m) { const size_t off = (size_t)(row0 + ai * HALF + m * 16) * D + col0;
#pragma unroll
                for (int bj = 0; bj < 2; ++bj)
#pragma unroll
                    for (int n = 0; n < 2; ++n) { const f32x4 xx = *(const GAS f32x4*)(x + off + bj * HALF + n * 16);
                        #ifdef YSCALE
                        *(GAS f32x4*)(xv + off + bj * HALF + n * 16) = xx * DN_ALPHA + gv[bj][n] * acc[ai][bj][m][n] * YSCALE; }
#else
                        *(GAS f32x4*)(xv + off + bj * HALF + n * 16) = xx * DN_ALPHA + gv[bj][n] * acc[ai][bj][m][n]; }
#endif
                if (m & 1) asm volatile("" ::: "memory"); }
    }
};
template <class Epi, class Sched, bool ALIGN_EPI = false, bool SP2 = false>
__device__ __forceinline__ void gemm_phase(PG8_LAS unsigned char* lds, const Gemm g, const Sched& S, const Epi& E) {
    int tid_ = threadIdx.x; asm volatile("" : "+v"(tid_));
    const int tid = tid_, wid = __builtin_amdgcn_readfirstlane(tid >> 6), lane = tid & 63, wr = wid >> 2, wc = wid & 3, fr = lane & 15, fq = lane >> 4;
    const int K = g.K, nt = K / BK;
    unsigned voffA[2], voffB[2];
#pragma unroll
    for (int i = 0; i < 2; ++i) { int R, C; stage_rc(tid * 16 + i * 8192, R, C); const int Rb = Epi::PERM ? ((R & ~31) + perm32(R & 31)) : R;
        voffA[i] = (unsigned)(R * K + C) * 2u; voffB[i] = (unsigned)(Rb * K + C) * 2u; }
    const size_t kstep = (size_t)(BK * 2);
    const size_t hstep = (size_t)HALF * K * 2;
    const size_t tstep = 2 * hstep;
    const unsigned ldsw = (unsigned)wid * 1024u;
    const int aoff = lds_byte(wr * 64 + fr, fq * 8), boff = lds_byte(wc * 32 + fr, fq * 8);
#define PG8_SA(b, h) (((b) * 2 + (h)) * HTB)
#define PG8_SB(b, h) ((4 + (b) * 2 + (h)) * HTB)
#define PG8_STAGE(bufoff, gbase, voff) do { _Pragma("unroll") for (int _i = 0; _i < 2; ++_i) \
        __builtin_amdgcn_global_load_lds((const unsigned*)((const char*)(gbase) + (voff)[_i]), (PG8_LAS unsigned*)(lds + (bufoff) + ldsw + _i * 8192), 16, 0, 0); } while (0)
#define PG8_LDA(dst, b, h) do { _Pragma("unroll") for (int m = 0; m < 4; ++m) _Pragma("unroll") for (int k = 0; k < 2; ++k) dst[m][k] = *(const PG8_LAS bf16x8*)(lds + PG8_SA(b, h) + aoff + m * 2048 + k * 1024); } while (0)
#define PG8_LDB(dst, b, h) do { _Pragma("unroll") for (int n = 0; n < 2; ++n) _Pragma("unroll") for (int k = 0; k < 2; ++k) dst[n][k] = *(const PG8_LAS bf16x8*)(lds + PG8_SB(b, h) + boff + n * 2048 + k * 1024); } while (0)
#define PG8_MMA(ai, bj, At, Bt) do { __builtin_amdgcn_s_setprio(1); _Pragma("unroll") for (int m = 0; m < 4; ++m) _Pragma("unroll") for (int n = 0; n < 2; ++n) _Pragma("unroll") for (int k = 0; k < 2; ++k) \
        acc[ai][bj][m][n] = __builtin_amdgcn_mfma_f32_16x16x32_bf16(Bt[n][k], At[m][k], acc[ai][bj][m][n], 0, 0, 0); __builtin_amdgcn_s_setprio(0); } while (0)
#define PG8_WAIT_V(n) asm volatile("s_waitcnt vmcnt(" #n ")" ::: "memory")
#define PG8_WAIT_L(n) asm volatile("s_waitcnt lgkmcnt(" #n ")" ::: "memory")
#define PG8_BAR __builtin_amdgcn_s_barrier()
#define PG8_SCHED __builtin_amdgcn_sched_barrier(0)
    Unit cur, nxt; int ui = 0;
    if (!S.next(0, cur)) return;
    f32x4 acc[2][2][4][2];
#pragma unroll
    for (int a = 0; a < 2; ++a)
#pragma unroll
        for (int b = 0; b < 2; ++b)
#pragma unroll
            for (int m = 0; m < 4; ++m)
#pragma unroll
                for (int n = 0; n < 2; ++n) acc[a][b][m][n] = (f32x4){0.f, 0.f, 0.f, 0.f};
    bf16x8 At[4][2], B0[2][2], B1[2][2];
    const char* cA = (const char*)g.A + (size_t)cur.pm * tstep; const char* cB = (const char*)g.Bt + (size_t)cur.pn * tstep;
    S.a_ready(cur);
    if constexpr (SP2) {
        PG8_STAGE(PG8_SB(0, 0), cB, voffB); PG8_STAGE(PG8_SB(0, 1), cB + hstep, voffB); PG8_STAGE(PG8_SA(0, 0), cA, voffA); PG8_STAGE(PG8_SA(0, 1), cA + hstep, voffA);
        if (wr == 1) PG8_BAR;
        PG8_WAIT_V(2); PG8_BAR;
        PG8_STAGE(PG8_SB(1, 0), cB + kstep, voffB); PG8_STAGE(PG8_SA(1, 0), cA + kstep, voffA); PG8_STAGE(PG8_SB(1, 1), cB + hstep + kstep, voffB);
        PG8_WAIT_V(6); PG8_BAR;
    } else {
        PG8_STAGE(PG8_SB(0, 0), cB, voffB); PG8_STAGE(PG8_SA(0, 0), cA, voffA); PG8_STAGE(PG8_SB(0, 1), cB + hstep, voffB); PG8_STAGE(PG8_SA(0, 1), cA + hstep, voffA);
        if (wr == 1) PG8_BAR;
        PG8_WAIT_V(4); PG8_BAR;
        PG8_STAGE(PG8_SB(1, 0), cB + kstep, voffB); PG8_STAGE(PG8_SA(1, 0), cA + kstep, voffA); PG8_STAGE(PG8_SB(1, 1), cB + hstep + kstep, voffB);
        PG8_WAIT_V(6); PG8_BAR;
    }
    for (;;) {
        const bool has_next = S.next(ui + 1, nxt);
        const char* nA = has_next ? (const char*)g.A + (size_t)nxt.pm * tstep : cA; const char* nB = has_next ? (const char*)g.Bt + (size_t)nxt.pn * tstep : cB;
        for (int t = 0; t < nt; t += 2) {
            const bool last = (t == nt - 2);
            const char* a1 = cA + (size_t)(t + 1) * kstep;
            const char* a2 = last ? nA : cA + (size_t)(t + 2) * kstep; const char* b2 = last ? nB : cB + (size_t)(t + 2) * kstep;
            const char* a3 = a2 + kstep; const char* b3 = b2 + kstep;
            if (last && has_next) S.a_ready(nxt);
            if constexpr (SP2) {
            PG8_LDB(B0, 0, 0); PG8_LDB(B1, 0, 1); PG8_SCHED; PG8_LDA(At, 0, 0); PG8_STAGE(PG8_SA(1, 1), a1 + hstep, voffA);
            PG8_WAIT_V(8); PG8_WAIT_L(0); PG8_BAR; PG8_MMA(0, 0, At, B0); PG8_MMA(0, 1, At, B1); PG8_BAR; PG8_SCHED;
            PG8_LDA(At, 0, 1); PG8_STAGE(PG8_SB(0, 0), b2, voffB); PG8_STAGE(PG8_SB(0, 1), b2 + hstep, voffB); PG8_STAGE(PG8_SA(0, 0), a2, voffA);
            PG8_WAIT_V(8); PG8_WAIT_L(0); PG8_BAR; PG8_MMA(1, 0, At, B0); PG8_MMA(1, 1, At, B1); PG8_BAR; PG8_SCHED;
            PG8_LDB(B0, 1, 0); PG8_LDB(B1, 1, 1); PG8_SCHED; PG8_LDA(At, 1, 0); PG8_STAGE(PG8_SA(0, 1), a2 + hstep, voffA);
            PG8_WAIT_V(8); PG8_WAIT_L(0); PG8_BAR; PG8_MMA(0, 0, At, B0); PG8_MMA(0, 1, At, B1); PG8_BAR; PG8_SCHED;
            PG8_LDA(At, 1, 1); PG8_STAGE(PG8_SB(1, 0), b3, voffB); PG8_STAGE(PG8_SB(1, 1), b3 + hstep, voffB); PG8_STAGE(PG8_SA(1, 0), a3, voffA);
            PG8_WAIT_V(8); PG8_WAIT_L(0); PG8_BAR; PG8_MMA(1, 0, At, B0); PG8_MMA(1, 1, At, B1); PG8_BAR; PG8_SCHED;
            } else {
            PG8_LDB(B0, 0, 0); PG8_SCHED; PG8_LDA(At, 0, 0); PG8_STAGE(PG8_SA(1, 1), a1 + hstep, voffA);
            PG8_WAIT_L(8); PG8_BAR; PG8_WAIT_L(0); PG8_MMA(0, 0, At, B0); PG8_BAR; PG8_SCHED;
            PG8_LDB(B1, 0, 1); PG8_STAGE(PG8_SB(0, 0), b2, voffB);
            PG8_BAR; PG8_WAIT_L(0); PG8_MMA(0, 1, At, B1); PG8_BAR;
            PG8_LDA(At, 0, 1); PG8_STAGE(PG8_SA(0, 0), a2, voffA);
            PG8_BAR; PG8_WAIT_L(0); PG8_MMA(1, 0, At, B0); PG8_BAR; PG8_SCHED;
            PG8_STAGE(PG8_SB(0, 1), b2 + hstep, voffB);
            PG8_WAIT_V(6); PG8_BAR; PG8_MMA(1, 1, At, B1); PG8_BAR;
            PG8_LDB(B0, 1, 0); PG8_SCHED; PG8_LDA(At, 1, 0); PG8_STAGE(PG8_SA(0, 1), a2 + hstep, voffA);
            PG8_WAIT_L(8); PG8_BAR; PG8_WAIT_L(0); PG8_MMA(0, 0, At, B0); PG8_BAR; PG8_SCHED;
            PG8_LDB(B1, 1, 1); PG8_STAGE(PG8_SB(1, 0), b3, voffB);
            PG8_BAR; PG8_WAIT_L(0); PG8_MMA(0, 1, At, B1); PG8_BAR;
            PG8_LDA(At, 1, 1); PG8_STAGE(PG8_SA(1, 0), a3, voffA);
            PG8_BAR; PG8_WAIT_L(0); PG8_MMA(1, 0, At, B0); PG8_BAR; PG8_SCHED;
            PG8_STAGE(PG8_SB(1, 1), b3 + hstep, voffB);
            PG8_WAIT_V(6); PG8_BAR; PG8_MMA(1, 1, At, B1); PG8_BAR;
            }
        }
        if constexpr (ALIGN_EPI) { if (wr == 0) PG8_BAR; }
        if constexpr (!Epi::AFTER_DRAIN) { E(acc, cur, wr, wc, fr, fq); S.done(cur); }
        if (!has_next) break;
#pragma unroll
        for (int a = 0; a < 2; ++a)
#pragma unroll
            for (int b = 0; b < 2; ++b)
#pragma unroll
                for (int m = 0; m < 4; ++m)
#pragma unroll
                    for (int n = 0; n < 2; ++n) acc[a][b][m][n] = (f32x4){0.f, 0.f, 0.f, 0.f};
        cur = nxt; cA = nA; cB = nB; ++ui;
        if constexpr (ALIGN_EPI) { if (wr == 1) PG8_BAR; }
    }
    PG8_WAIT_V(0);
    if constexpr (!ALIGN_EPI) { if (wr == 0) PG8_BAR; }
    PG8_BAR;
    if constexpr (Epi::AFTER_DRAIN) { E.fused(acc, cur, wr, wc, fr, fq, lds, wid, lane); S.done(cur); }
#undef PG8_SA
#undef PG8_SB
#undef PG8_STAGE
#undef PG8_LDA
#undef PG8_LDB
#undef PG8_MMA
#undef PG8_WAIT_V
#undef PG8_WAIT_L
#undef PG8_BAR
#undef PG8_SCHED
}
}
namespace att {
constexpr int KS_M = 400, KS_N = 272, VS = 320;
constexpr int MLA_KB = 64 * KS_M, NSA_KB = 64 * KS_N, VB = 64 * VS;
constexpr int N_IMP = 2 * NSA_KB + 2 * VB;
constexpr int N_PART = N_IMP + 32768;
constexpr int N_PARTB = 8 * 32 * 17 * 4;
constexpr int N_SELM = N_PART + 2 * N_PARTB;
constexpr int N_ULIST = N_SELM + 1024;
constexpr int N_CARRY = N_ULIST + 1024;
constexpr int N_NTS = N_CARRY + 256;
static_assert(N_NTS + 16 <= MISC_OFF, "NSA LDS map");
static_assert(2 * MLA_KB + 3 * VB <= 131072, "MLA LDS map");
constexpr int MLA_QL = 2 * MLA_KB + 2 * VB;
static_assert(MLA_QL + 8 * 4096 <= 131072, "MLA LDS map (pipelined)");

#ifndef QK_PF
#define QK_PF 4
#endif
#define MFMA32(a, b, c) __builtin_amdgcn_mfma_f32_32x32x16_bf16((a), (b), (c), 0, 0, 0)
__device__ __forceinline__ float swapmax(float v) { auto rr = __builtin_amdgcn_permlane32_swap(__float_as_uint(v), __float_as_uint(v), false, false); return fmaxf(__uint_as_float(rr[0]), __uint_as_float(rr[1])); }
__device__ __forceinline__ float swapsum(float v) { auto rr = __builtin_amdgcn_permlane32_swap(__float_as_uint(v), __float_as_uint(v), false, false); return __uint_as_float(rr[0]) + __uint_as_float(rr[1]); }
template <int SIDX> __device__ __forceinline__ bf16x8 packp(const f32x16& p) {
    f32x8 t = {p[8 * SIDX + 0], p[8 * SIDX + 1], p[8 * SIDX + 2], p[8 * SIDX + 3], p[8 * SIDX + 4], p[8 * SIDX + 5], p[8 * SIDX + 6], p[8 * SIDX + 7]};
    return __builtin_bit_cast(bf16x8, __builtin_convertvector(t, bf16x8v));
}
template <int NDC, int KS, bool ZERO = true> __device__ __forceinline__ void qk_tile(f32x16& p0, f32x16& p1, const LAS unsigned char* kl, const bf16x8 (&q)[NDC]) {
    if (ZERO) {
#pragma unroll
        for (int i = 0; i < 16; ++i) { p0[i] = 0.f; p1[i] = 0.f; }
    }
    constexpr int PF = QK_PF;
    bf16x8 a[PF + 1][2];
#pragma unroll
    for (int i = 0; i < PF; ++i) { a[i][0] = *(const LAS bf16x8*)(kl + i * 32); a[i][1] = *(const LAS bf16x8*)(kl + 32 * KS + i * 32); }
#pragma unroll
    for (int d0 = 0; d0 < NDC; ++d0) {
        if (d0 + PF < NDC) { a[(d0 + PF) % (PF + 1)][0] = *(const LAS bf16x8*)(kl + (d0 + PF) * 32); a[(d0 + PF) % (PF + 1)][1] = *(const LAS bf16x8*)(kl + 32 * KS + (d0 + PF) * 32); }
        __builtin_amdgcn_sched_barrier(0);
        p0 = MFMA32(a[d0 % (PF + 1)][0], q[d0], p0); p1 = MFMA32(a[d0 % (PF + 1)][1], q[d0], p1);
        __builtin_amdgcn_sched_barrier(0);
    }
}
#ifdef PROBE_QKM2
template <int NDC, int KS> __device__ __forceinline__ void qk_tile_m2(f32x16& p0, f32x16& p1, f32x16& r0, f32x16& r1, const LAS unsigned char* kl, const bf16x8 (&q)[NDC]) {
#pragma unroll
    for (int i = 0; i < 16; ++i) { p0[i] = 0.f; p1[i] = 0.f; r0[i] = 0.f; r1[i] = 0.f; }
    constexpr int PF = QK_PF;
    bf16x8 a[PF + 1][2];
#pragma unroll
    for (int i = 0; i < PF; ++i) { a[i][0] = *(const LAS bf16x8*)(kl + i * 32); a[i][1] = *(const LAS bf16x8*)(kl + 32 * KS + i * 32); }
#pragma unroll
    for (int d0 = 0; d0 < NDC; ++d0) {
        if (d0 + PF < NDC) { a[(d0 + PF) % (PF + 1)][0] = *(const LAS bf16x8*)(kl + (d0 + PF) * 32); a[(d0 + PF) % (PF + 1)][1] = *(const LAS bf16x8*)(kl + 32 * KS + (d0 + PF) * 32); }
        __builtin_amdgcn_sched_barrier(0);
        p0 = MFMA32(a[d0 % (PF + 1)][0], q[d0], p0); p1 = MFMA32(a[d0 % (PF + 1)][1], q[d0], p1);
        r0 = MFMA32(a[d0 % (PF + 1)][0], q[d0], r0); r1 = MFMA32(a[d0 % (PF + 1)][1], q[d0], r1);
        __builtin_amdgcn_sched_barrier(0);
    }
}
#endif
__device__ __forceinline__ void pv_tile(f32x16 (&o)[4], const bf16x8 (&pb)[4], const LAS unsigned char* vl) {
    s16x4 f[5][2];
#define PV_LD(idx) do { constexpr int d_ = (idx) >> 2, s_ = (idx) & 3; \
        f[(idx) % 5][0] = __builtin_amdgcn_ds_read_tr16_b64_v4i16((LAS s16x4*)(vl + s_ * 16 * VS + d_ * 64)); \
        f[(idx) % 5][1] = __builtin_amdgcn_ds_read_tr16_b64_v4i16((LAS s16x4*)(vl + s_ * 16 * VS + 8 * VS + d_ * 64)); } while (0)
    PV_LD(0); PV_LD(1); PV_LD(2); PV_LD(3);
#define PV_STEP(idx) do { if ((idx) + 4 < 16) PV_LD((idx) + 4); __builtin_amdgcn_sched_barrier(0); \
        { const s16x4 t0_ = f[(idx) % 5][0], t1_ = f[(idx) % 5][1]; const bf16x8 vf_ = {t0_[0], t0_[1], t0_[2], t0_[3], t1_[0], t1_[1], t1_[2], t1_[3]}; \
          o[(idx) >> 2] = MFMA32(vf_, pb[(idx) & 3], o[(idx) >> 2]); } __builtin_amdgcn_sched_barrier(0); } while (0)
    PV_STEP(0); PV_STEP(1); PV_STEP(2); PV_STEP(3); PV_STEP(4); PV_STEP(5); PV_STEP(6); PV_STEP(7);
    PV_STEP(8); PV_STEP(9); PV_STEP(10); PV_STEP(11); PV_STEP(12); PV_STEP(13); PV_STEP(14); PV_STEP(15);
#undef PV_STEP
#undef PV_LD
}
template <int NDC, int NQR, int KS> __device__ __forceinline__ void qk_tile_free(f32x16& p0, f32x16& p1, const LAS unsigned char* kl, const bf16x8 (&q)[NQR], const LAS unsigned char* ql) {
#pragma unroll
    for (int i = 0; i < 16; ++i) { p0[i] = 0.f; p1[i] = 0.f; }
#pragma unroll
    for (int d0 = 0; d0 < NDC; ++d0) {
        const bf16x8 a0 = *(const LAS bf16x8*)(kl + d0 * 32);
        const bf16x8 a1 = *(const LAS bf16x8*)(kl + 32 * KS + d0 * 32);
        bf16x8 qq; if (d0 < NQR) qq = q[d0 < NQR ? d0 : 0]; else qq = *(const LAS bf16x8*)(ql + (d0 - NQR) * 1024);
        p0 = MFMA32(a0, qq, p0); p1 = MFMA32(a1, qq, p1);
    }
}
__device__ __forceinline__ float sm_core(f32x16& p0, f32x16& p1, float& m, float& l) {
    float tm = p0[0];
#pragma unroll
    for (int r = 1; r < 16; ++r) tm = fmaxf(tm, p0[r]);
#pragma unroll
    for (int r = 0; r < 16; ++r) tm = fmaxf(tm, p1[r]);
    tm = swapmax(tm);
    const float mn = fmaxf(m, tm);
    const float alpha = __builtin_amdgcn_exp2f(m - mn);
    m = mn;
    float ps = 0.f;
#pragma unroll
    for (int r = 0; r < 16; ++r) { p0[r] = __builtin_amdgcn_exp2f(p0[r] - mn); ps += p0[r]; }
#pragma unroll
    for (int r = 0; r < 16; ++r) { p1[r] = __builtin_amdgcn_exp2f(p1[r] - mn); ps += p1[r]; }
    ps = swapsum(ps);
    l = l * alpha + ps;
    return alpha;
}
__device__ __forceinline__ void online_sm(f32x16& p0, f32x16& p1, float& m, float& l, f32x16 (&o)[4]) {
    float tm = p0[0];
#pragma unroll
    for (int r = 1; r < 16; ++r) tm = fmaxf(tm, p0[r]);
#pragma unroll
    for (int r = 0; r < 16; ++r) tm = fmaxf(tm, p1[r]);
    tm = swapmax(tm);
    const float mn = fmaxf(m, tm);
    const float alpha = __builtin_amdgcn_exp2f(m - mn);
    m = mn;
    float ps = 0.f;
#pragma unroll
    for (int r = 0; r < 16; ++r) { p0[r] = __builtin_amdgcn_exp2f(p0[r] - mn); ps += p0[r]; }
#pragma unroll
    for (int r = 0; r < 16; ++r) { p1[r] = __builtin_amdgcn_exp2f(p1[r] - mn); ps += p1[r]; }
    ps = swapsum(ps);
    l = l * alpha + ps;
    if (!__all(alpha == 1.f)) {
#pragma unroll
        for (int d = 0; d < 4; ++d)
#pragma unroll
            for (int r = 0; r < 16; ++r) o[d][r] *= alpha;
    }
}

#ifdef MLA_FP8
typedef long i64;
constexpr int KS8 = 200, MLA_KB8 = 64 * KS8;
static_assert(2 * MLA_KB8 + 3 * VB <= 131072, "MLA fp8 LDS map");
#define MFMA32F8(a, b, c) __builtin_amdgcn_mfma_f32_32x32x16_fp8_fp8((a), (b), (c), 0, 0, 0)
template <int NDC> __device__ __forceinline__ void qk_tile8(f32x16& p0, f32x16& p1, const LAS unsigned char* kl, const i64 (&q)[NDC]) {
#pragma unroll
    for (int i = 0; i < 16; ++i) { p0[i] = 0.f; p1[i] = 0.f; }
    constexpr int PF = 4;
    i64 a[PF + 1][2];
#pragma unroll
    for (int i = 0; i < PF; ++i) { a[i][0] = *(const LAS i64*)(kl + i * 16); a[i][1] = *(const LAS i64*)(kl + 32 * KS8 + i * 16); }
#pragma unroll
    for (int d0 = 0; d0 < NDC; ++d0) {
        if (d0 + PF < NDC) { a[(d0 + PF) % (PF + 1)][0] = *(const LAS i64*)(kl + (d0 + PF) * 16); a[(d0 + PF) % (PF + 1)][1] = *(const LAS i64*)(kl + 32 * KS8 + (d0 + PF) * 16); }
        __builtin_amdgcn_sched_barrier(0);
        __builtin_amdgcn_s_setprio(1);
        p0 = MFMA32F8(a[d0 % (PF + 1)][0], q[d0], p0); p1 = MFMA32F8(a[d0 % (PF + 1)][1], q[d0], p1);
        __builtin_amdgcn_s_setprio(0);
        __builtin_amdgcn_sched_barrier(0);
    }
}
__device__ __forceinline__ void online_sm_scaled(f32x16& p0, f32x16& p1, float& m, float& l, f32x16 (&o)[4], const float C2) {
    float tm = p0[0];
#pragma unroll
    for (int r = 1; r < 16; ++r) tm = fmaxf(tm, p0[r]);
#pragma unroll
    for (int r = 0; r < 16; ++r) tm = fmaxf(tm, p1[r]);
    tm = swapmax(tm);
    const float mn = fmaxf(m, tm);
    const float alpha = __builtin_amdgcn_exp2f((m - mn) * C2);
    m = mn;
    const float mc = -mn * C2;
    float ps = 0.f;
#pragma unroll
    for (int r = 0; r < 16; ++r) { p0[r] = __builtin_amdgcn_exp2f(__builtin_fmaf(p0[r], C2, mc)); ps += p0[r]; }
#pragma unroll
    for (int r = 0; r < 16; ++r) { p1[r] = __builtin_amdgcn_exp2f(__builtin_fmaf(p1[r], C2, mc)); ps += p1[r]; }
    ps = swapsum(ps);
    l = l * alpha + ps;
    if (!__all(alpha == 1.f)) {
#pragma unroll
        for (int d = 0; d < 4; ++d)
#pragma unroll
            for (int r = 0; r < 16; ++r) o[d][r] *= alpha;
    }
}
#endif
#ifdef MLA_FP8V
constexpr int VS8 = 72, VB8 = 128 * VS8;
constexpr int VS8B = 136, VB8B = 128 * VS8B, MLA_KB8B = 128 * KS8;
static_assert(2 * MLA_KB8B + 3 * VB8B <= 131072, "MLA big-tile LDS map");
#ifdef MLA_BIG
#define PV8_RS VS8B
#else
#define PV8_RS VS8
#endif
static_assert(2 * MLA_KB8 + 3 * VB8 <= 131072, "MLA fp8 LDS map");
template <int SIDX> __device__ __forceinline__ i64 packp8(const f32x16& p) {
    int w0 = __builtin_amdgcn_cvt_pk_fp8_f32(p[8 * SIDX + 0] * 256.f, p[8 * SIDX + 1] * 256.f, 0, false); w0 = __builtin_amdgcn_cvt_pk_fp8_f32(p[8 * SIDX + 2] * 256.f, p[8 * SIDX + 3] * 256.f, w0, true);
    int w1 = __builtin_amdgcn_cvt_pk_fp8_f32(p[8 * SIDX + 4] * 256.f, p[8 * SIDX + 5] * 256.f, 0, false); w1 = __builtin_amdgcn_cvt_pk_fp8_f32(p[8 * SIDX + 6] * 256.f, p[8 * SIDX + 7] * 256.f, w1, true);
    return (i64)(((unsigned long long)(unsigned)w1 << 32) | (unsigned)w0);
}
__device__ __forceinline__ void pv_tile8(f32x16 (&o)[4], const i64 (&pb)[4], const LAS unsigned char* vl) {
    i64 f[5];
#define PV8_LD(idx) f[(idx) % 5] = *(const LAS i64*)(vl + ((idx) >> 2) * 32 * PV8_RS + ((idx) & 3) * 16)
    PV8_LD(0); PV8_LD(1); PV8_LD(2); PV8_LD(3);
#define PV8_STEP(idx) do { if ((idx) + 4 < 16) PV8_LD((idx) + 4); __builtin_amdgcn_sched_barrier(0); \
        o[(idx) >> 2] = MFMA32F8(f[(idx) % 5], pb[(idx) & 3], o[(idx) >> 2]); __builtin_amdgcn_sched_barrier(0); } while (0)
    PV8_STEP(0); PV8_STEP(1); PV8_STEP(2); PV8_STEP(3); PV8_STEP(4); PV8_STEP(5); PV8_STEP(6); PV8_STEP(7);
    PV8_STEP(8); PV8_STEP(9); PV8_STEP(10); PV8_STEP(11); PV8_STEP(12); PV8_STEP(13); PV8_STEP(14); PV8_STEP(15);
#undef PV8_STEP
#undef PV8_LD
}
#endif
#ifdef MLA_MX
typedef int i32x8 __attribute__((ext_vector_type(8)));
constexpr int KSX = 208, MLA_KBX = 64 * KSX;
constexpr int VSX = 80, VBX = 128 * VSX;
static_assert(2 * MLA_KBX + 3 * VBX <= 131072, "MLA mx LDS map");
#define MFMAX(a, b, c) __builtin_amdgcn_mfma_scale_f32_32x32x64_f8f6f4((a), (b), (c), 0, 0, 0, 0x7f7f7f7f, 0, 0x7f7f7f7f)
__device__ __forceinline__ i32x8 ldsx(const LAS unsigned char* p) {
    const u32x4 a = *(const LAS u32x4*)p, b = *(const LAS u32x4*)(p + 16);
    return (i32x8){(int)a.x, (int)a.y, (int)a.z, (int)a.w, (int)b.x, (int)b.y, (int)b.z, (int)b.w};
}
__device__ __forceinline__ void qk_tilex(f32x16& p0, f32x16& p1, const LAS unsigned char* kl, const i32x8 (&q)[3]) {
#pragma unroll
    for (int i = 0; i < 16; ++i) { p0[i] = 0.f; p1[i] = 0.f; }
    i32x8 a0 = ldsx(kl), a1 = ldsx(kl + 32 * KSX), a2 = ldsx(kl + 64), a3 = ldsx(kl + 32 * KSX + 64);
    __builtin_amdgcn_sched_barrier(0);
    __builtin_amdgcn_s_setprio(1);
    p0 = MFMAX(a0, q[0], p0); p1 = MFMAX(a1, q[0], p1);
    __builtin_amdgcn_s_setprio(0);
    __builtin_amdgcn_sched_barrier(0);
    a0 = ldsx(kl + 128); a1 = ldsx(kl + 32 * KSX + 128);
    __builtin_amdgcn_sched_barrier(0);
    __builtin_amdgcn_s_setprio(1);
    p0 = MFMAX(a2, q[1], p0); p1 = MFMAX(a3, q[1], p1);
    __builtin_amdgcn_sched_barrier(0);
    p0 = MFMAX(a0, q[2], p0); p1 = MFMAX(a1, q[2], p1);
    __builtin_amdgcn_s_setprio(0);
    __builtin_amdgcn_sched_barrier(0);
}
__device__ __forceinline__ void pv_tilex(f32x16 (&o)[4], const i32x8& pb, const LAS unsigned char* vl) {
    i32x8 f0 = ldsx(vl), f1 = ldsx(vl + 32 * VSX);
    __builtin_amdgcn_sched_barrier(0);
    o[0] = MFMAX(f0, pb, o[0]);
    __builtin_amdgcn_sched_barrier(0);
    f0 = ldsx(vl + 64 * VSX);
    __builtin_amdgcn_sched_barrier(0);
    o[1] = MFMAX(f1, pb, o[1]);
    __builtin_amdgcn_sched_barrier(0);
    f1 = ldsx(vl + 96 * VSX);
    __builtin_amdgcn_sched_barrier(0);
    o[2] = MFMAX(f0, pb, o[2]);
    __builtin_amdgcn_sched_barrier(0);
    o[3] = MFMAX(f1, pb, o[3]);
    __builtin_amdgcn_sched_barrier(0);
}
__device__ __forceinline__ i32x8 packpx(const f32x16& p0, const f32x16& p1) {
    i32x8 w;
#pragma unroll
    for (int g = 0; g < 4; ++g) {
        int a = __builtin_amdgcn_cvt_pk_fp8_f32(p0[4 * g + 0], p0[4 * g + 1], 0, false); a = __builtin_amdgcn_cvt_pk_fp8_f32(p0[4 * g + 2], p0[4 * g + 3], a, true); w[g] = a;
        int b = __builtin_amdgcn_cvt_pk_fp8_f32(p1[4 * g + 0], p1[4 * g + 1], 0, false); b = __builtin_amdgcn_cvt_pk_fp8_f32(p1[4 * g + 2], p1[4 * g + 3], b, true); w[4 + g] = b;
    }
    return w;
}
__device__ __forceinline__ void online_sm_x(f32x16& p0, f32x16& p1, float& m, float& l, f32x16 (&o)[4], const float C2) {
    float tm = p0[0];
#pragma unroll
    for (int r = 1; r < 16; ++r) tm = fmaxf(tm, p0[r]);
#pragma unroll
    for (int r = 0; r < 16; ++r) tm = fmaxf(tm, p1[r]);
    tm = swapmax(tm);
    const float mn = fmaxf(m, tm);
    const float alpha = __builtin_amdgcn_exp2f((m - mn) * C2);
    m = mn;
    const float mc = 8.f - mn * C2;
    float ps = 0.f;
#pragma unroll
    for (int r = 0; r < 16; ++r) { p0[r] = __builtin_amdgcn_exp2f(__builtin_fmaf(p0[r], C2, mc)); ps += p0[r]; }
#pragma unroll
    for (int r = 0; r < 16; ++r) { p1[r] = __builtin_amdgcn_exp2f(__builtin_fmaf(p1[r], C2, mc)); ps += p1[r]; }
    ps = swapsum(ps);
    l = l * alpha + ps;
    if (!__all(alpha == 1.f)) {
#pragma unroll
        for (int d = 0; d < 4; ++d)
#pragma unroll
            for (int r = 0; r < 16; ++r) o[d][r] *= alpha;
    }
}
#endif
#ifdef MLA_PIPE8
template <int NDC> __device__ __forceinline__ void qk_tile8_free(f32x16& p0, f32x16& p1, const LAS unsigned char* kl, const i64 (&q)[NDC]) {
#pragma unroll
    for (int i = 0; i < 16; ++i) { p0[i] = 0.f; p1[i] = 0.f; }
#pragma unroll
    for (int d0 = 0; d0 < NDC; ++d0) {
        const i64 a0 = *(const LAS i64*)(kl + d0 * 16), a1 = *(const LAS i64*)(kl + 32 * KS8 + d0 * 16);
        p0 = MFMA32F8(a0, q[d0], p0); p1 = MFMA32F8(a1, q[d0], p1);
    }
}
__device__ __forceinline__ float sm_core_scaled(f32x16& p0, f32x16& p1, float& m, float& l, const float C2) {
    float tm = p0[0];
#pragma unroll
    for (int r = 1; r < 16; ++r) tm = fmaxf(tm, p0[r]);
#pragma unroll
    for (int r = 0; r < 16; ++r) tm = fmaxf(tm, p1[r]);
    tm = swapmax(tm);
    const float mn = fmaxf(m, tm);
    const float alpha = __builtin_amdgcn_exp2f((m - mn) * C2);
    m = mn;
    const float mc = -mn * C2;
    float ps = 0.f;
#pragma unroll
    for (int r = 0; r < 16; ++r) { p0[r] = __builtin_amdgcn_exp2f(__builtin_fmaf(p0[r], C2, mc)); ps += p0[r]; }
#pragma unroll
    for (int r = 0; r < 16; ++r) { p1[r] = __builtin_amdgcn_exp2f(__builtin_fmaf(p1[r], C2, mc)); ps += p1[r]; }
    ps = swapsum(ps);
    l = l * alpha + ps;
    return alpha;
}
#endif
#ifdef MLA_PIPE8
struct MlaPtrs { const bf16* Q; const bf16* K; const bf16* V; const bf16* Z; bf16* O; };
__device__ __forceinline__ void mla_mask(f32x16& p0, f32x16& p1, int dq) {
#pragma unroll
    for (int r = 0; r < 16; ++r) { const int c = (r & 3) + 8 * (r >> 2);
        if (c > dq) p0[r] = -__builtin_inff();
        if (c + 32 > dq) p1[r] = -__builtin_inff(); }
}
__device__ __forceinline__ void mla_unit(LAS unsigned char* lds, const MlaPtrs& P, int head, int qb, int tid_in, int wave, int lane_in) {
    int tid = tid_in; asm volatile("" : "+v"(tid)); const int lane = tid & 63; (void)lane_in;
    const int r32 = lane & 31, hi = lane >> 5;
    const int q0 = qb * 256, qw = q0 + wave * 32, tq = qw + r32;
    i64 q[12];
    { const unsigned char* qp = (const unsigned char*)P.Q + (size_t)tq * 3072 + head * 192 + hi * 8;
#pragma unroll
      for (int d0 = 0; d0 < 12; ++d0) q[d0] = *(const GAS i64*)(qp + d0 * 16); }
    const int NT = 4 * (qb + 1);
    const int srow = tid >> 3, sc8 = tid & 7;
    const unsigned char* kg = (const unsigned char*)P.K + (size_t)head * 192 + (size_t)srow * 3072 + sc8 * 8;
    const unsigned char* vg = (const unsigned char*)P.V + ((size_t)head * 128 + (tid >> 2)) * S + (tid & 3) * 16;
    LAS unsigned char* kst = lds + srow * KS8 + sc8 * 8;
    LAS unsigned char* vst = lds + 2 * MLA_KB8 + (tid >> 2) * VS8 + (tid & 3) * 16;
    const LAS unsigned char* kl = lds + r32 * KS8 + hi * 8;
    const LAS unsigned char* vl = lds + 2 * MLA_KB8 + r32 * VS8 + hi * 8;
    u32x2 sk0, sk1, sk2; u32x4 sv0;
#define MLA_LOADK(j) do { const unsigned char* kp_ = kg + (size_t)(j) * (64 * 3072); sk0 = *(const GAS u32x2*)(kp_); sk1 = *(const GAS u32x2*)(kp_ + 64); sk2 = *(const GAS u32x2*)(kp_ + 128); } while (0)
#define MLA_LOADV(j) do { sv0 = *(const GAS u32x4*)(vg + (size_t)(j) * 64); } while (0)
#define MLA_STOREK(b) do { LAS unsigned char* kd_ = kst + (b) * MLA_KB8; *(LAS u32x2*)(kd_) = sk0; *(LAS u32x2*)(kd_ + 64) = sk1; *(LAS u32x2*)(kd_ + 128) = sk2; } while (0)
#define MLA_STOREV(b) do { LAS unsigned char* vd_ = vst + (b) * VB8; *(LAS u32x2*)(vd_) = (u32x2){sv0.x, sv0.y}; *(LAS u32x2*)(vd_ + 8) = (u32x2){sv0.z, sv0.w}; } while (0)
    float m = -1e30f, l = 0.f; f32x16 o[4];
#pragma unroll
    for (int d = 0; d < 4; ++d)
#pragma unroll
        for (int r = 0; r < 16; ++r) o[d][r] = 0.f;
    f32x16 pA0, pA1, pB0, pB1;
    MLA_LOADK(0); MLA_LOADV(0); MLA_STOREK(0); MLA_STOREV(0);
    MLA_LOADK(1);
    __syncthreads();
    qk_tile8<12>(pA0, pA1, kl, q);
    if (63 > qw) mla_mask(pA0, pA1, tq - 4 * hi);
    MLA_STOREK(1);
    if (2 < NT) MLA_LOADK(2);
    MLA_LOADV(1);
    __syncthreads();
#define MLA_SGB1() do { __builtin_amdgcn_sched_group_barrier(0x100, 2, 0); __builtin_amdgcn_sched_group_barrier(0x008, 1, 0); __builtin_amdgcn_sched_group_barrier(0x002, 6, 0); \
        __builtin_amdgcn_sched_group_barrier(0x008, 1, 0); __builtin_amdgcn_sched_group_barrier(0x002, 6, 0); } while (0)
#define MLA_SGB() do { MLA_SGB1(); MLA_SGB1(); MLA_SGB1(); MLA_SGB1(); MLA_SGB1(); MLA_SGB1(); MLA_SGB1(); MLA_SGB1(); MLA_SGB1(); MLA_SGB1(); MLA_SGB1(); MLA_SGB1(); } while (0)
#define MLA_STEP(PX0, PX1, PY0, PY1, j) do { \
        const int kb1_ = 64 * ((j) + 1); \
        const bool a1_ = ((j) + 1 < NT) && (kb1_ <= qw + 31), a0_ = (64 * (j) <= qw + 31); \
        float alpha_ = 1.f; i64 pb_[4]; \
        if (a1_) { \
            __builtin_amdgcn_sched_barrier(0); \
            qk_tile8_free<12>(PY0, PY1, kl + (((j) + 1) & 1) * MLA_KB8, q); \
            alpha_ = sm_core_scaled(PX0, PX1, m, l, QS_MLA); \
            pb_[0] = packp8<0>(PX0); pb_[1] = packp8<1>(PX0); pb_[2] = packp8<0>(PX1); pb_[3] = packp8<1>(PX1); \
            MLA_SGB(); \
            __builtin_amdgcn_sched_barrier(0); \
            if (kb1_ + 63 > qw) mla_mask(PY0, PY1, tq - kb1_ - 4 * hi); \
        } else if (a0_) { \
            alpha_ = sm_core_scaled(PX0, PX1, m, l, QS_MLA); \
            pb_[0] = packp8<0>(PX0); pb_[1] = packp8<1>(PX0); pb_[2] = packp8<0>(PX1); pb_[3] = packp8<1>(PX1); \
        } \
        if (a0_) { \
            if (!__all(alpha_ == 1.f)) { _Pragma("unroll") for (int d_ = 0; d_ < 4; ++d_) _Pragma("unroll") for (int r_ = 0; r_ < 16; ++r_) o[d_][r_] *= alpha_; } \
            pv_tile8(o, pb_, vl + ((j) & 1) * VB8); \
        } \
        if ((j) + 2 < NT) MLA_STOREK((j) & 1); \
        if ((j) + 1 < NT) MLA_STOREV(((j) + 1) & 1); \
        if ((j) + 3 < NT) MLA_LOADK((j) + 3); \
        if ((j) + 2 < NT) MLA_LOADV((j) + 2); \
        __syncthreads(); } while (0)
    for (int j = 0; j < NT; j += 2) {
        MLA_STEP(pA0, pA1, pB0, pB1, j);
        MLA_STEP(pB0, pB1, pA0, pA1, j + 1);
    }
#undef MLA_STEP
#undef MLA_SGB
#undef MLA_SGB1
#undef MLA_LOADK
#undef MLA_LOADV
#undef MLA_STOREK
#undef MLA_STOREV
    const float inv = (1.f / 256.f) / l;
    const bf16* zp = P.Z + (size_t)tq * 2048 + head * 128 + 4 * hi;
    bf16* op = P.O + (size_t)tq * 4096 + head * 128 + 4 * hi;
#pragma unroll
    for (int d0 = 0; d0 < 4; ++d0)
#pragma unroll
        for (int rg = 0; rg < 4; ++rg) { const int dim = 32 * d0 + 8 * rg;
            const u32x2 z = *(const GAS u32x2*)(zp + dim);
            u32x2 w; w.x = pk2(o[d0][4 * rg + 0] * inv * bflo(z.x), o[d0][4 * rg + 1] * inv * bfhi(z.x)); w.y = pk2(o[d0][4 * rg + 2] * inv * bflo(z.y), o[d0][4 * rg + 3] * inv * bfhi(z.y));
            *(GAS u32x2*)(op + dim) = w; }
}
#elif defined(MLA_PIPE)
struct MlaPtrs { const bf16* Q; const bf16* K; const bf16* V; const bf16* Z; bf16* O; };
__device__ __forceinline__ void mla_mask(f32x16& p0, f32x16& p1, int dq) {
#pragma unroll
    for (int r = 0; r < 16; ++r) { const int c = (r & 3) + 8 * (r >> 2);
        if (c > dq) p0[r] = -__builtin_inff();
        if (c + 32 > dq) p1[r] = -__builtin_inff(); }
}
__device__ __forceinline__ void mla_unit(LAS unsigned char* lds, const MlaPtrs& P, int head, int qb, int tid_in, int wave, int lane_in) {
    int tid = tid_in; asm volatile("" : "+v"(tid)); const int lane = tid & 63; (void)lane_in;
    const int r32 = lane & 31, hi = lane >> 5;
    const int q0 = qb * 256, qw = q0 + wave * 32, tq = qw + r32;
    bf16x8 q[8];
    LAS unsigned char* ql = lds + MLA_QL + wave * 4096 + lane * 16;
    { const bf16* qp = P.Q + (size_t)tq * 3072 + head * 192 + hi * 8;
#pragma unroll
      for (int d0 = 0; d0 < 8; ++d0) q[d0] = *(const GAS bf16x8*)(qp + d0 * 16);
#pragma unroll
      for (int d0 = 8; d0 < 12; ++d0) *(LAS bf16x8*)(ql + (d0 - 8) * 1024) = *(const GAS bf16x8*)(qp + d0 * 16); }
    const int NT = 4 * (qb + 1);
    const int srow = tid >> 3, sc8 = tid & 7;
    const unsigned char* kg = (const unsigned char*)P.K + (size_t)head * 384 + (size_t)srow * 6144 + sc8 * 16;
    const unsigned char* vg = (const unsigned char*)P.V + (size_t)head * 256 + (size_t)srow * 4096 + sc8 * 16;
    LAS unsigned char* kst = lds + srow * KS_M + sc8 * 16;
    LAS unsigned char* vst = lds + 2 * MLA_KB + srow * VS + sc8 * 16;
    const LAS unsigned char* kl = lds + r32 * KS_M + hi * 16;
    const LAS unsigned char* vl = lds + 2 * MLA_KB + (4 * hi + ((lane & 15) >> 2)) * VS + (16 * ((lane >> 4) & 1) + 4 * (lane & 3)) * 2;
    u32x4 sk0, sk1, sk2, sv0, sv1;
#define MLA_LOADK(j) do { const unsigned char* kp_ = kg + (size_t)(j) * (64 * 6144); sk0 = *(const GAS u32x4*)(kp_); sk1 = *(const GAS u32x4*)(kp_ + 128); sk2 = *(const GAS u32x4*)(kp_ + 256); } while (0)
#define MLA_LOADV(j) do { const unsigned char* vp_ = vg + (size_t)(j) * (64 * 4096); sv0 = *(const GAS u32x4*)(vp_); sv1 = *(const GAS u32x4*)(vp_ + 128); } while (0)
#define MLA_STOREK(b) do { LAS unsigned char* kd_ = kst + (b) * MLA_KB; *(LAS u32x4*)(kd_) = sk0; *(LAS u32x4*)(kd_ + 128) = sk1; *(LAS u32x4*)(kd_ + 256) = sk2; } while (0)
#define MLA_STOREV(b) do { LAS unsigned char* vd_ = vst + (b) * VB; *(LAS u32x4*)(vd_) = sv0; *(LAS u32x4*)(vd_ + 128) = sv1; } while (0)
    float m = -1e30f, l = 0.f; f32x16 o[4];
#pragma unroll
    for (int d = 0; d < 4; ++d)
#pragma unroll
        for (int r = 0; r < 16; ++r) o[d][r] = 0.f;
    f32x16 pA0, pA1, pB0, pB1;
    MLA_LOADK(0); MLA_LOADV(0); MLA_STOREK(0); MLA_STOREV(0);
    MLA_LOADK(1);
    __syncthreads();
    qk_tile_free<12, 8, KS_M>(pA0, pA1, kl, q, ql);
    if (63 > qw) mla_mask(pA0, pA1, tq - 4 * hi);
    MLA_STOREK(1);
    if (2 < NT) MLA_LOADK(2);
    MLA_LOADV(1);
    __syncthreads();
#define MLA_SGB1(NR) do { __builtin_amdgcn_sched_group_barrier(0x100, NR, 0); __builtin_amdgcn_sched_group_barrier(0x008, 1, 0); __builtin_amdgcn_sched_group_barrier(0x002, 6, 0); \
        __builtin_amdgcn_sched_group_barrier(0x008, 1, 0); __builtin_amdgcn_sched_group_barrier(0x002, 6, 0); } while (0)
#define MLA_SGB() do { MLA_SGB1(2); MLA_SGB1(2); MLA_SGB1(2); MLA_SGB1(2); MLA_SGB1(2); MLA_SGB1(2); MLA_SGB1(2); MLA_SGB1(2); MLA_SGB1(3); MLA_SGB1(3); MLA_SGB1(3); MLA_SGB1(3); } while (0)
#define MLA_STEP(PX0, PX1, PY0, PY1, j) do { \
        const int kb1_ = 64 * ((j) + 1); \
        const bool a1_ = ((j) + 1 < NT) && (kb1_ <= qw + 31), a0_ = (64 * (j) <= qw + 31); \
        float alpha_ = 1.f; bf16x8 pb_[4]; \
        if (a1_) { \
            __builtin_amdgcn_sched_barrier(0); \
            qk_tile_free<12, 8, KS_M>(PY0, PY1, kl + (((j) + 1) & 1) * MLA_KB, q, ql); \
            alpha_ = sm_core(PX0, PX1, m, l); \
            pb_[0] = packp<0>(PX0); pb_[1] = packp<1>(PX0); pb_[2] = packp<0>(PX1); pb_[3] = packp<1>(PX1); \
            MLA_SGB(); \
            __builtin_amdgcn_sched_barrier(0); \
            if (kb1_ + 63 > qw) mla_mask(PY0, PY1, tq - kb1_ - 4 * hi); \
        } else if (a0_) { \
            alpha_ = sm_core(PX0, PX1, m, l); \
            pb_[0] = packp<0>(PX0); pb_[1] = packp<1>(PX0); pb_[2] = packp<0>(PX1); pb_[3] = packp<1>(PX1); \
        } \
        if (a0_) { \
            if (!__all(alpha_ == 1.f)) { _Pragma("unroll") for (int d_ = 0; d_ < 4; ++d_) _Pragma("unroll") for (int r_ = 0; r_ < 16; ++r_) o[d_][r_] *= alpha_; } \
            pv_tile(o, pb_, vl + ((j) & 1) * VB); \
        } \
        if ((j) + 2 < NT) MLA_STOREK((j) & 1); \
        if ((j) + 1 < NT) MLA_STOREV(((j) + 1) & 1); \
        if ((j) + 3 < NT) MLA_LOADK((j) + 3); \
        if ((j) + 2 < NT) MLA_LOADV((j) + 2); \
        __syncthreads(); } while (0)
    for (int j = 0; j < NT; j += 2) {
        MLA_STEP(pA0, pA1, pB0, pB1, j);
        MLA_STEP(pB0, pB1, pA0, pA1, j + 1);
    }
#undef MLA_STEP
#undef MLA_SGB
#undef MLA_SGB1
#undef MLA_LOADK
#undef MLA_LOADV
#undef MLA_STOREK
#undef MLA_STOREV
    const float inv = 1.f / l;
    const bf16* zp = P.Z + (size_t)tq * 2048 + head * 128 + 4 * hi;
    bf16* op = P.O + (size_t)tq * 4096 + head * 128 + 4 * hi;
#pragma unroll
    for (int d0 = 0; d0 < 4; ++d0)
#pragma unroll
        for (int rg = 0; rg < 4; ++rg) { const int dim = 32 * d0 + 8 * rg;
            const u32x2 z = *(const GAS u32x2*)(zp + dim);
            u32x2 w; w.x = pk2(o[d0][4 * rg + 0] * inv * bflo(z.x), o[d0][4 * rg + 1] * inv * bfhi(z.x)); w.y = pk2(o[d0][4 * rg + 2] * inv * bflo(z.y), o[d0][4 * rg + 3] * inv * bfhi(z.y));
            *(GAS u32x2*)(op + dim) = w; }
}

#else
#if defined(MLA_MX)
struct MlaPtrs { const bf16* Q; const bf16* K; const bf16* V; const bf16* Z; bf16* O; };
__device__ __forceinline__ void mla_unit(LAS unsigned char* lds, const MlaPtrs& P, int head, int qb, int tid_in, int wave, int lane_in) {
    int tid = tid_in; asm volatile("" : "+v"(tid)); const int lane = tid & 63; (void)lane_in;
    const int r32 = lane & 31, hi = lane >> 5;
    const int q0 = qb * 256, qw = q0 + wave * 32, tq = qw + r32;
    i32x8 q[3];
    { const unsigned char* qp = (const unsigned char*)P.Q + (size_t)tq * 3072 + head * 192 + hi * 32;
#pragma unroll
      for (int s = 0; s < 3; ++s) { const u32x4 a = *(const GAS u32x4*)(qp + 64 * s), b = *(const GAS u32x4*)(qp + 64 * s + 16);
          q[s] = (i32x8){(int)a.x, (int)a.y, (int)a.z, (int)a.w, (int)b.x, (int)b.y, (int)b.z, (int)b.w}; } }
    const int NT = 4 * (qb + 1);
    const int srow = tid >> 3, sc8 = tid & 7;
    const unsigned char* kg = (const unsigned char*)P.K + (size_t)head * 192 + (size_t)srow * 3072 + sc8 * 8;
    const unsigned char* vg = (const unsigned char*)P.V + ((size_t)head * 128 + (tid >> 2)) * S + (tid & 3) * 16;
    LAS unsigned char* kst = lds + srow * KSX + sc8 * 8;
    LAS unsigned char* vst = lds + 2 * MLA_KBX + (tid >> 2) * VSX + (tid & 3) * 16;
    const LAS unsigned char* kl = lds + r32 * KSX + hi * 32;
    const LAS unsigned char* vl = lds + 2 * MLA_KBX + r32 * VSX + hi * 32;
    u32x2 sk0, sk1, sk2; u32x4 sv0;
#define MLA_LOAD(j) do { const unsigned char* kp_ = kg + (size_t)(j) * (64 * 3072); const unsigned char* vp_ = vg + (size_t)(j) * 64; \
        sk0 = *(const GAS u32x2*)(kp_); sk1 = *(const GAS u32x2*)(kp_ + 64); sk2 = *(const GAS u32x2*)(kp_ + 128); sv0 = *(const GAS u32x4*)(vp_); } while (0)
#define MLA_STORE(b, vb) do { LAS unsigned char* kd_ = kst + (b) * MLA_KBX; LAS unsigned char* vd_ = vst + (vb) * VBX; \
        *(LAS u32x2*)(kd_) = sk0; *(LAS u32x2*)(kd_ + 64) = sk1; *(LAS u32x2*)(kd_ + 128) = sk2; *(LAS u32x2*)(vd_) = (u32x2){sv0.x, sv0.y}; *(LAS u32x2*)(vd_ + 8) = (u32x2){sv0.z, sv0.w}; } while (0)
    MLA_LOAD(0); MLA_STORE(0, 0);
    __syncthreads();
    asm volatile("" : "+v"(q[0]), "+v"(q[1]), "+v"(q[2]));
    float m = -1e30f, l = 0.f; f32x16 o[4];
#pragma unroll
    for (int d = 0; d < 4; ++d)
#pragma unroll
        for (int r = 0; r < 16; ++r) o[d][r] = 0.f;
    const bool trail = wave >= 4;
    i32x8 pb = {};
    int vb_cur = 0, vb_prev = 2;
    for (int j = 0; j < NT; ++j) {
        const int kb = 64 * j;
        int vb_next = vb_cur + 1; if (vb_next == 3) vb_next = 0;
        if (j + 1 < NT) MLA_LOAD(j + 1);
        if (trail && j > 0 && kb - 64 <= qw + 31) pv_tilex(o, pb, vl + vb_prev * VBX);
        if (kb <= qw + 31) {
            f32x16 p0, p1;
            qk_tilex(p0, p1, kl + (j & 1) * MLA_KBX, q);
            if (kb + 63 > qw) {
                const int dq = tq - kb - 4 * hi;
#pragma unroll
                for (int r = 0; r < 16; ++r) { const int c = (r & 3) + 8 * (r >> 2);
                    if (c > dq) p0[r] = -__builtin_inff();
                    if (c + 32 > dq) p1[r] = -__builtin_inff(); }
            }
            online_sm_x(p0, p1, m, l, o, QS_MLA);
            pb = packpx(p0, p1);
            if (!trail) pv_tilex(o, pb, vl + vb_cur * VBX);
        }
        if (j + 1 < NT) MLA_STORE((j + 1) & 1, vb_next);
        __syncthreads();
        vb_prev = vb_cur; vb_cur = vb_next;
    }
    if (trail && 64 * (NT - 1) <= qw + 31) pv_tilex(o, pb, vl + vb_prev * VBX);
    __syncthreads();
#undef MLA_LOAD
#undef MLA_STORE
    const float inv = 1.f / l;
    const bf16* zp = P.Z + (size_t)tq * 2048 + head * 128 + 4 * hi;
    bf16* op = P.O + (size_t)tq * 4096 + head * 128 + 4 * hi;
#pragma unroll
    for (int d0 = 0; d0 < 4; ++d0)
#pragma unroll
        for (int rg = 0; rg < 4; ++rg) { const int dim = 32 * d0 + 8 * rg;
            const u32x2 z = *(const GAS u32x2*)(zp + dim);
            u32x2 w; w.x = pk2(o[d0][4 * rg + 0] * inv * bflo(z.x), o[d0][4 * rg + 1] * inv * bfhi(z.x)); w.y = pk2(o[d0][4 * rg + 2] * inv * bflo(z.y), o[d0][4 * rg + 3] * inv * bfhi(z.y));
            *(GAS u32x2*)(op + dim) = w; }
}

#elif defined(MLA_BIG)
struct MlaPtrs { const bf16* Q; const bf16* K; const bf16* V; const bf16* Z; bf16* O; };
__device__ __forceinline__ void mla_unit(LAS unsigned char* lds, const MlaPtrs& P, int head, int qb, int tid_in, int wave, int lane_in) {
    int tid = tid_in; asm volatile("" : "+v"(tid)); const int lane = tid & 63; (void)lane_in;
    const int r32 = lane & 31, hi = lane >> 5;
    const int q0 = qb * 256, qw = q0 + wave * 32, tq = qw + r32;
    i64 q[12];
    { const unsigned char* qp = (const unsigned char*)P.Q + (size_t)tq * 3072 + head * 192 + hi * 8;
#pragma unroll
      for (int d0 = 0; d0 < 12; ++d0) q[d0] = *(const GAS i64*)(qp + d0 * 16); }
    const int NT = 4 * (qb + 1), NTB = NT / 2;
    const int srow = tid >> 3, sc8 = tid & 7;
    const unsigned char* kg = (const unsigned char*)P.K + (size_t)head * 192 + (size_t)srow * 3072 + sc8 * 8;
    const unsigned char* vg = (const unsigned char*)P.V + ((size_t)head * 128 + (tid >> 2)) * S + (tid & 3) * 32;
    LAS unsigned char* kst = lds + srow * KS8 + sc8 * 8;
    LAS unsigned char* vst = lds + 2 * MLA_KB8B + (tid >> 2) * VS8B + (tid & 3) * 32;
    const LAS unsigned char* kl = lds + r32 * KS8 + hi * 8;
    const LAS unsigned char* vl = lds + 2 * MLA_KB8B + r32 * VS8B + hi * 8;
    u32x2 sk0, sk1, sk2, sk3, sk4, sk5; u32x4 sv0, sv1;
#define MLA_LOAD(J) do { const unsigned char* kp_ = kg + (size_t)(J) * (128 * 3072); const unsigned char* vp_ = vg + (size_t)(J) * 128; \
        sk0 = *(const GAS u32x2*)(kp_); sk1 = *(const GAS u32x2*)(kp_ + 64); sk2 = *(const GAS u32x2*)(kp_ + 128); \
        sk3 = *(const GAS u32x2*)(kp_ + 64 * 3072); sk4 = *(const GAS u32x2*)(kp_ + 64 * 3072 + 64); sk5 = *(const GAS u32x2*)(kp_ + 64 * 3072 + 128); \
        sv0 = *(const GAS u32x4*)(vp_); sv1 = *(const GAS u32x4*)(vp_ + 16); } while (0)
#define MLA_STORE(b, vb) do { LAS unsigned char* kd_ = kst + (b) * MLA_KB8B; LAS unsigned char* vd_ = vst + (vb) * VB8B; \
        *(LAS u32x2*)(kd_) = sk0; *(LAS u32x2*)(kd_ + 64) = sk1; *(LAS u32x2*)(kd_ + 128) = sk2; \
        *(LAS u32x2*)(kd_ + 64 * KS8) = sk3; *(LAS u32x2*)(kd_ + 64 * KS8 + 64) = sk4; *(LAS u32x2*)(kd_ + 64 * KS8 + 128) = sk5; \
        *(LAS u32x2*)(vd_) = (u32x2){sv0.x, sv0.y}; *(LAS u32x2*)(vd_ + 8) = (u32x2){sv0.z, sv0.w}; *(LAS u32x2*)(vd_ + 16) = (u32x2){sv1.x, sv1.y}; *(LAS u32x2*)(vd_ + 24) = (u32x2){sv1.z, sv1.w}; } while (0)
    MLA_LOAD(0); MLA_STORE(0, 0);
    __syncthreads();
    float m = -1e30f, l = 0.f; f32x16 o[4];
#pragma unroll
    for (int d = 0; d < 4; ++d)
#pragma unroll
        for (int r = 0; r < 16; ++r) o[d][r] = 0.f;
    const bool trail = wave >= 4;
    i64 pb[4] = {};
    int vb_cur = 0, vb_prev = 2;
    for (int J = 0; J < NTB; ++J) {
        int vb_next = vb_cur + 1; if (vb_next == 3) vb_next = 0;
        if (J + 1 < NTB) MLA_LOAD(J + 1);
#pragma unroll
        for (int sub = 0; sub < 2; ++sub) {
            const int j = 2 * J + sub, kb = 64 * j;
            if (trail && j > 0 && kb - 64 <= qw + 31) pv_tile8(o, pb, vl + (sub == 0 ? vb_prev * VB8B + 64 : vb_cur * VB8B));
            if (kb <= qw + 31) {
                f32x16 p0, p1;
                qk_tile8<12>(p0, p1, kl + (J & 1) * MLA_KB8B + sub * 64 * KS8, q);
                if (kb + 63 > qw) {
                    const int dq = tq - kb - 4 * hi;
#pragma unroll
                    for (int r = 0; r < 16; ++r) { const int c = (r & 3) + 8 * (r >> 2);
                        if (c > dq) p0[r] = -__builtin_inff();
                        if (c + 32 > dq) p1[r] = -__builtin_inff(); }
                }
                online_sm_scaled(p0, p1, m, l, o, QS_MLA);
                pb[0] = packp8<0>(p0); pb[1] = packp8<1>(p0); pb[2] = packp8<0>(p1); pb[3] = packp8<1>(p1);
                if (!trail) pv_tile8(o, pb, vl + vb_cur * VB8B + sub * 64);
            }
        }
        if (J + 1 < NTB) MLA_STORE((J + 1) & 1, vb_next);
        __syncthreads();
        vb_prev = vb_cur; vb_cur = vb_next;
    }
    if (trail && 64 * (NT - 1) <= qw + 31) pv_tile8(o, pb, vl + vb_prev * VB8B + 64);
    __syncthreads();
#undef MLA_LOAD
#undef MLA_STORE
    const float inv = (1.f / 256.f) / l;
    const bf16* zp = P.Z + (size_t)tq * 2048 + head * 128 + 4 * hi;
    bf16* op = P.O + (size_t)tq * 4096 + head * 128 + 4 * hi;
#pragma unroll
    for (int d0 = 0; d0 < 4; ++d0)
#pragma unroll
        for (int rg = 0; rg < 4; ++rg) { const int dim = 32 * d0 + 8 * rg;
            const u32x2 z = *(const GAS u32x2*)(zp + dim);
            u32x2 w; w.x = pk2(o[d0][4 * rg + 0] * inv * bflo(z.x), o[d0][4 * rg + 1] * inv * bfhi(z.x)); w.y = pk2(o[d0][4 * rg + 2] * inv * bflo(z.y), o[d0][4 * rg + 3] * inv * bfhi(z.y));
            *(GAS u32x2*)(op + dim) = w; }
}

#elif defined(MLA_FP8V)
struct MlaPtrs { const bf16* Q; const bf16* K; const bf16* V; const bf16* Z; bf16* O; };
__device__ __forceinline__ void mla_unit(LAS unsigned char* lds, const MlaPtrs& P, int head, int qb, int tid_in, int wave, int lane_in) {
    int tid = tid_in; asm volatile("" : "+v"(tid)); const int lane = tid & 63; (void)lane_in;
    const int r32 = lane & 31, hi = lane >> 5;
    const int q0 = qb * 256, qw = q0 + wave * 32, tq = qw + r32;
    i64 q[12];
    { const unsigned char* qp = (const unsigned char*)P.Q + (size_t)tq * 3072 + head * 192 + hi * 8;
#pragma unroll
      for (int d0 = 0; d0 < 12; ++d0) q[d0] = *(const GAS i64*)(qp + d0 * 16); }
    const int NT = 4 * (qb + 1);
    const int srow = tid >> 3, sc8 = tid & 7;
    const unsigned char* kg = (const unsigned char*)P.K + (size_t)head * 192 + (size_t)srow * 3072 + sc8 * 8;
    const unsigned char* vg = (const unsigned char*)P.V + ((size_t)head * 128 + (tid >> 2)) * S + (tid & 3) * 16;
    LAS unsigned char* kst = lds + srow * KS8 + sc8 * 8;
    LAS unsigned char* vst = lds + 2 * MLA_KB8 + (tid >> 2) * VS8 + (tid & 3) * 16;
    const LAS unsigned char* kl = lds + r32 * KS8 + hi * 8;
    const LAS unsigned char* vl = lds + 2 * MLA_KB8 + r32 * VS8 + hi * 8;
    u32x2 sk0, sk1, sk2; u32x4 sv0;
#define MLA_LOAD(j) do { const unsigned char* kp_ = kg + (size_t)(j) * (64 * 3072); const unsigned char* vp_ = vg + (size_t)(j) * 64; \
        sk0 = *(const GAS u32x2*)(kp_); sk1 = *(const GAS u32x2*)(kp_ + 64); sk2 = *(const GAS u32x2*)(kp_ + 128); sv0 = *(const GAS u32x4*)(vp_); } while (0)
#define MLA_STORE(b, vb) do { LAS unsigned char* kd_ = kst + (b) * MLA_KB8; LAS unsigned char* vd_ = vst + (vb) * VB8; \
        *(LAS u32x2*)(kd_) = sk0; *(LAS u32x2*)(kd_ + 64) = sk1; *(LAS u32x2*)(kd_ + 128) = sk2; *(LAS u32x2*)(vd_) = (u32x2){sv0.x, sv0.y}; *(LAS u32x2*)(vd_ + 8) = (u32x2){sv0.z, sv0.w}; } while (0)
    MLA_LOAD(0); MLA_STORE(0, 0);
    __syncthreads();
    float m = -1e30f, l = 0.f; f32x16 o[4];
#pragma unroll
    for (int d = 0; d < 4; ++d)
#pragma unroll
        for (int r = 0; r < 16; ++r) o[d][r] = 0.f;
    const bool trail = wave >= 4;
    i64 pb[4] = {};
    int vb_cur = 0, vb_prev = 2;
    for (int j = 0; j < NT; ++j) {
        const int kb = 64 * j;
        int vb_next = vb_cur + 1; if (vb_next == 3) vb_next = 0;
        if (j + 1 < NT) MLA_LOAD(j + 1);
        if (trail && j > 0 && kb - 64 <= qw + 31) pv_tile8(o, pb, vl + vb_prev * VB8);
        if (kb <= qw + 31) {
            f32x16 p0, p1;
#ifdef PROBE_QKM2
            { f32x16 r0, r1; qk_tile_m2<12, KS_M>(p0, p1, r0, r1, kl + (j & 1) * MLA_KB, q);
#pragma unroll
              for (int r = 0; r < 16; ++r) { p0[r] = (p0[r] + r0[r]) * 0.5f; p1[r] = (p1[r] + r1[r]) * 0.5f; } }
#else
            qk_tile8<12>(p0, p1, kl + (j & 1) * MLA_KB8, q);
#endif
#ifdef PROBE_QK2
            { f32x16 r0, r1; asm volatile("" ::: "memory"); qk_tile<12, KS_M>(r0, r1, kl + (j & 1) * MLA_KB, q);
#pragma unroll
              for (int r = 0; r < 16; ++r) { p0[r] = (p0[r] + r0[r]) * 0.5f; p1[r] = (p1[r] + r1[r]) * 0.5f; } }
#endif
#ifdef PROBE_SM2
            { float acc_ = 0.f;
#pragma unroll
              for (int r = 0; r < 16; ++r) { acc_ += __builtin_amdgcn_exp2f(p0[r] - m - 40.f) + __builtin_amdgcn_exp2f(p1[r] - m - 40.f); }
#pragma unroll
              for (int r = 0; r < 16; ++r) { acc_ += __builtin_amdgcn_exp2f(p0[r] - m - 50.f) + __builtin_amdgcn_exp2f(p1[r] - m - 50.f); }
              if (acc_ == 12345.678f) l += 1.f; }
#endif
            if (kb + 63 > qw) {
                const int dq = tq - kb - 4 * hi;
#pragma unroll
                for (int r = 0; r < 16; ++r) { const int c = (r & 3) + 8 * (r >> 2);
                    if (c > dq) p0[r] = -__builtin_inff();
                    if (c + 32 > dq) p1[r] = -__builtin_inff(); }
            }
            online_sm_scaled(p0, p1, m, l, o, QS_MLA);
            pb[0] = packp8<0>(p0); pb[1] = packp8<1>(p0); pb[2] = packp8<0>(p1); pb[3] = packp8<1>(p1);
            if (!trail) pv_tile8(o, pb, vl + vb_cur * VB8);
        }
        if (j + 1 < NT) MLA_STORE((j + 1) & 1, vb_next);
        __syncthreads();
        vb_prev = vb_cur; vb_cur = vb_next;
    }
    if (trail && 64 * (NT - 1) <= qw + 31) pv_tile8(o, pb, vl + vb_prev * VB8);
    __syncthreads();
#undef MLA_LOAD
#undef MLA_STORE
    const float inv = (1.f / 256.f) / l;
    const bf16* zp = P.Z + (size_t)tq * 2048 + head * 128 + 4 * hi;
    bf16* op = P.O + (size_t)tq * 4096 + head * 128 + 4 * hi;
#pragma unroll
    for (int d0 = 0; d0 < 4; ++d0)
#pragma unroll
        for (int rg = 0; rg < 4; ++rg) { const int dim = 32 * d0 + 8 * rg;
            const u32x2 z = *(const GAS u32x2*)(zp + dim);
            u32x2 w; w.x = pk2(o[d0][4 * rg + 0] * inv * bflo(z.x), o[d0][4 * rg + 1] * inv * bfhi(z.x)); w.y = pk2(o[d0][4 * rg + 2] * inv * bflo(z.y), o[d0][4 * rg + 3] * inv * bfhi(z.y));
            *(GAS u32x2*)(op + dim) = w; }
}

#elif defined(MLA_FP8)
struct MlaPtrs { const bf16* Q; const bf16* K; const bf16* V; const bf16* Z; bf16* O; };
__device__ __forceinline__ void mla_unit(LAS unsigned char* lds, const MlaPtrs& P, int head, int qb, int tid_in, int wave, int lane_in) {
    int tid = tid_in; asm volatile("" : "+v"(tid)); const int lane = tid & 63; (void)lane_in;
    const int r32 = lane & 31, hi = lane >> 5;
    const int q0 = qb * 256, qw = q0 + wave * 32, tq = qw + r32;
    i64 q[12];
    { const unsigned char* qp = (const unsigned char*)P.Q + (size_t)tq * 3072 + head * 192 + hi * 8;
#pragma unroll
      for (int d0 = 0; d0 < 12; ++d0) q[d0] = *(const GAS i64*)(qp + d0 * 16); }
    const int NT = 4 * (qb + 1);
    const int srow = tid >> 3, sc8 = tid & 7;
    const unsigned char* kg = (const unsigned char*)P.K + (size_t)head * 192 + (size_t)srow * 3072 + sc8 * 8;
    const unsigned char* vg = (const unsigned char*)P.V + (size_t)head * 256 + (size_t)srow * 4096 + sc8 * 16;
    LAS unsigned char* kst = lds + srow * KS8 + sc8 * 8;
    LAS unsigned char* vst = lds + 2 * MLA_KB8 + srow * VS + sc8 * 16;
    const LAS unsigned char* kl = lds + r32 * KS8 + hi * 8;
    const LAS unsigned char* vl = lds + 2 * MLA_KB8 + (4 * hi + ((lane & 15) >> 2)) * VS + (16 * ((lane >> 4) & 1) + 4 * (lane & 3)) * 2;
    u32x2 sk0, sk1, sk2; u32x4 sv0, sv1;
#define MLA_LOAD(j) do { const unsigned char* kp_ = kg + (size_t)(j) * (64 * 3072); const unsigned char* vp_ = vg + (size_t)(j) * (64 * 4096); \
        sk0 = *(const GAS u32x2*)(kp_); sk1 = *(const GAS u32x2*)(kp_ + 64); sk2 = *(const GAS u32x2*)(kp_ + 128); sv0 = *(const GAS u32x4*)(vp_); sv1 = *(const GAS u32x4*)(vp_ + 128); } while (0)
#define MLA_STORE(b, vb) do { LAS unsigned char* kd_ = kst + (b) * MLA_KB8; LAS unsigned char* vd_ = vst + (vb) * VB; \
        *(LAS u32x2*)(kd_) = sk0; *(LAS u32x2*)(kd_ + 64) = sk1; *(LAS u32x2*)(kd_ + 128) = sk2; *(LAS u32x4*)(vd_) = sv0; *(LAS u32x4*)(vd_ + 128) = sv1; } while (0)
    MLA_LOAD(0); MLA_STORE(0, 0);
    __syncthreads();
    float m = -1e30f, l = 0.f; f32x16 o[4];
#pragma unroll
    for (int d = 0; d < 4; ++d)
#pragma unroll
        for (int r = 0; r < 16; ++r) o[d][r] = 0.f;
    const bool trail = wave >= 4;
    bf16x8 pb[4] = {};
    int vb_cur = 0, vb_prev = 2;
    for (int j = 0; j < NT; ++j) {
        const int kb = 64 * j;
        int vb_next = vb_cur + 1; if (vb_next == 3) vb_next = 0;
        if (j + 1 < NT) MLA_LOAD(j + 1);
        if (trail && j > 0 && kb - 64 <= qw + 31) pv_tile(o, pb, vl + vb_prev * VB);
        if (kb <= qw + 31) {
            f32x16 p0, p1;
#ifdef PROBE_QKM2
            { f32x16 r0, r1; qk_tile_m2<12, KS_M>(p0, p1, r0, r1, kl + (j & 1) * MLA_KB, q);
#pragma unroll
              for (int r = 0; r < 16; ++r) { p0[r] = (p0[r] + r0[r]) * 0.5f; p1[r] = (p1[r] + r1[r]) * 0.5f; } }
#else
            qk_tile8<12>(p0, p1, kl + (j & 1) * MLA_KB8, q);
#endif
#ifdef PROBE_QK2
            { f32x16 r0, r1; asm volatile("" ::: "memory"); qk_tile<12, KS_M>(r0, r1, kl + (j & 1) * MLA_KB, q);
#pragma unroll
              for (int r = 0; r < 16; ++r) { p0[r] = (p0[r] + r0[r]) * 0.5f; p1[r] = (p1[r] + r1[r]) * 0.5f; } }
#endif
#ifdef PROBE_SM2
            { float acc_ = 0.f;
#pragma unroll
              for (int r = 0; r < 16; ++r) { acc_ += __builtin_amdgcn_exp2f(p0[r] - m - 40.f) + __builtin_amdgcn_exp2f(p1[r] - m - 40.f); }
#pragma unroll
              for (int r = 0; r < 16; ++r) { acc_ += __builtin_amdgcn_exp2f(p0[r] - m - 50.f) + __builtin_amdgcn_exp2f(p1[r] - m - 50.f); }
              if (acc_ == 12345.678f) l += 1.f; }
#endif
            if (kb + 63 > qw) {
                const int dq = tq - kb - 4 * hi;
#pragma unroll
                for (int r = 0; r < 16; ++r) { const int c = (r & 3) + 8 * (r >> 2);
                    if (c > dq) p0[r] = -__builtin_inff();
                    if (c + 32 > dq) p1[r] = -__builtin_inff(); }
            }
            online_sm_scaled(p0, p1, m, l, o, QS_MLA);
            pb[0] = packp<0>(p0); pb[1] = packp<1>(p0); pb[2] = packp<0>(p1); pb[3] = packp<1>(p1);
            if (!trail) pv_tile(o, pb, vl + vb_cur * VB);
        }
        if (j + 1 < NT) MLA_STORE((j + 1) & 1, vb_next);
        __syncthreads();
        vb_prev = vb_cur; vb_cur = vb_next;
    }
    if (trail && 64 * (NT - 1) <= qw + 31) pv_tile(o, pb, vl + vb_prev * VB);
    __syncthreads();
#undef MLA_LOAD
#undef MLA_STORE
    const float inv = 1.f / l;
    const bf16* zp = P.Z + (size_t)tq * 2048 + head * 128 + 4 * hi;
    bf16* op = P.O + (size_t)tq * 4096 + head * 128 + 4 * hi;
#pragma unroll
    for (int d0 = 0; d0 < 4; ++d0)
#pragma unroll
        for (int rg = 0; rg < 4; ++rg) { const int dim = 32 * d0 + 8 * rg;
            const u32x2 z = *(const GAS u32x2*)(zp + dim);
            u32x2 w; w.x = pk2(o[d0][4 * rg + 0] * inv * bflo(z.x), o[d0][4 * rg + 1] * inv * bfhi(z.x)); w.y = pk2(o[d0][4 * rg + 2] * inv * bflo(z.y), o[d0][4 * rg + 3] * inv * bfhi(z.y));
            *(GAS u32x2*)(op + dim) = w; }
}

#else
struct MlaPtrs { const bf16* Q; const bf16* K; const bf16* V; const bf16* Z; bf16* O; };
__device__ __forceinline__ void mla_unit(LAS unsigned char* lds, const MlaPtrs& P, int head, int qb, int tid_in, int wave, int lane_in) {
    int tid = tid_in; asm volatile("" : "+v"(tid)); const int lane = tid & 63; (void)lane_in;
    const int r32 = lane & 31, hi = lane >> 5;
    const int q0 = qb * 256, qw = q0 + wave * 32, tq = qw + r32;
    bf16x8 q[12];
    { const bf16* qp = P.Q + (size_t)tq * 3072 + head * 192 + hi * 8;
#pragma unroll
      for (int d0 = 0; d0 < 12; ++d0) q[d0] = *(const GAS bf16x8*)(qp + d0 * 16); }
    const int NT = 4 * (qb + 1);
    const int srow = tid >> 3, sc8 = tid & 7;
    const unsigned char* kg = (const unsigned char*)P.K + (size_t)head * 384 + (size_t)srow * 6144 + sc8 * 16;
    const unsigned char* vg = (const unsigned char*)P.V + (size_t)head * 256 + (size_t)srow * 4096 + sc8 * 16;
    LAS unsigned char* kst = lds + srow * KS_M + sc8 * 16;
    LAS unsigned char* vst = lds + 2 * MLA_KB + srow * VS + sc8 * 16;
    const LAS unsigned char* kl = lds + r32 * KS_M + hi * 16;
    const LAS unsigned char* vl = lds + 2 * MLA_KB + (4 * hi + ((lane & 15) >> 2)) * VS + (16 * ((lane >> 4) & 1) + 4 * (lane & 3)) * 2;
    u32x4 sk0, sk1, sk2, sv0, sv1;
#define MLA_LOAD(j) do { const unsigned char* kp_ = kg + (size_t)(j) * (64 * 6144); const unsigned char* vp_ = vg + (size_t)(j) * (64 * 4096); \
        sk0 = *(const GAS u32x4*)(kp_); sk1 = *(const GAS u32x4*)(kp_ + 128); sk2 = *(const GAS u32x4*)(kp_ + 256); sv0 = *(const GAS u32x4*)(vp_); sv1 = *(const GAS u32x4*)(vp_ + 128); } while (0)
#define MLA_STORE(b, vb) do { LAS unsigned char* kd_ = kst + (b) * MLA_KB; LAS unsigned char* vd_ = vst + (vb) * VB; \
        *(LAS u32x4*)(kd_) = sk0; *(LAS u32x4*)(kd_ + 128) = sk1; *(LAS u32x4*)(kd_ + 256) = sk2; *(LAS u32x4*)(vd_) = sv0; *(LAS u32x4*)(vd_ + 128) = sv1; } while (0)
    MLA_LOAD(0); MLA_STORE(0, 0);
    __syncthreads();
    float m = -1e30f, l = 0.f; f32x16 o[4];
#pragma unroll
    for (int d = 0; d < 4; ++d)
#pragma unroll
        for (int r = 0; r < 16; ++r) o[d][r] = 0.f;
    const bool trail = wave >= 4;
    bf16x8 pb[4] = {};
    int vb_cur = 0, vb_prev = 2;
    for (int j = 0; j < NT; ++j) {
        const int kb = 64 * j;
        int vb_next = vb_cur + 1; if (vb_next == 3) vb_next = 0;
        if (j + 1 < NT) MLA_LOAD(j + 1);
        if (trail && j > 0 && kb - 64 <= qw + 31) pv_tile(o, pb, vl + vb_prev * VB);
        if (kb <= qw + 31) {
            f32x16 p0, p1;
#ifdef PROBE_QKM2
            { f32x16 r0, r1; qk_tile_m2<12, KS_M>(p0, p1, r0, r1, kl + (j & 1) * MLA_KB, q);
#pragma unroll
              for (int r = 0; r < 16; ++r) { p0[r] = (p0[r] + r0[r]) * 0.5f; p1[r] = (p1[r] + r1[r]) * 0.5f; } }
#else
            qk_tile<12, KS_M>(p0, p1, kl + (j & 1) * MLA_KB, q);
#endif
#ifdef PROBE_QK2
            { f32x16 r0, r1; asm volatile("" ::: "memory"); qk_tile<12, KS_M>(r0, r1, kl + (j & 1) * MLA_KB, q);
#pragma unroll
              for (int r = 0; r < 16; ++r) { p0[r] = (p0[r] + r0[r]) * 0.5f; p1[r] = (p1[r] + r1[r]) * 0.5f; } }
#endif
#ifdef PROBE_SM2
            { float acc_ = 0.f;
#pragma unroll
              for (int r = 0; r < 16; ++r) { acc_ += __builtin_amdgcn_exp2f(p0[r] - m - 40.f) + __builtin_amdgcn_exp2f(p1[r] - m - 40.f); }
#pragma unroll
              for (int r = 0; r < 16; ++r) { acc_ += __builtin_amdgcn_exp2f(p0[r] - m - 50.f) + __builtin_amdgcn_exp2f(p1[r] - m - 50.f); }
              if (acc_ == 12345.678f) l += 1.f; }
#endif
            if (kb + 63 > qw) {
                const int dq = tq - kb - 4 * hi;
#pragma unroll
                for (int r = 0; r < 16; ++r) { const int c = (r & 3) + 8 * (r >> 2);
                    if (c > dq) p0[r] = -__builtin_inff();
                    if (c + 32 > dq) p1[r] = -__builtin_inff(); }
            }
            online_sm(p0, p1, m, l, o);
            pb[0] = packp<0>(p0); pb[1] = packp<1>(p0); pb[2] = packp<0>(p1); pb[3] = packp<1>(p1);
            if (!trail) pv_tile(o, pb, vl + vb_cur * VB);
        }
        if (j + 1 < NT) MLA_STORE((j + 1) & 1, vb_next);
        __syncthreads();
        vb_prev = vb_cur; vb_cur = vb_next;
    }
    if (trail && 64 * (NT - 1) <= qw + 31) pv_tile(o, pb, vl + vb_prev * VB);
    __syncthreads();
#undef MLA_LOAD
#undef MLA_STORE
    const float inv = 1.f / l;
    const bf16* zp = P.Z + (size_t)tq * 2048 + head * 128 + 4 * hi;
    bf16* op = P.O + (size_t)tq * 4096 + head * 128 + 4 * hi;
#pragma unroll
    for (int d0 = 0; d0 < 4; ++d0)
#pragma unroll
        for (int rg = 0; rg < 4; ++rg) { const int dim = 32 * d0 + 8 * rg;
            const u32x2 z = *(const GAS u32x2*)(zp + dim);
            u32x2 w; w.x = pk2(o[d0][4 * rg + 0] * inv * bflo(z.x), o[d0][4 * rg + 1] * inv * bfhi(z.x)); w.y = pk2(o[d0][4 * rg + 2] * inv * bflo(z.y), o[d0][4 * rg + 3] * inv * bfhi(z.y));
            *(GAS u32x2*)(op + dim) = w; }
}

#endif
#endif
struct NsaPtrs { const bf16* Q; const bf16* KV; const bf16* KC; const bf16* VC; const bf16* Z; const float* G; bf16* O; float* scr; };
template <int MODE>
__device__ __forceinline__ void nsa_loop(LAS unsigned char* lds, const unsigned char* kbase, const unsigned char* vbase, int ntiles, int jlo,
                                         const bf16x8 (&q)[8], int t, float slope2, float& m, float& l, f32x16 (&o)[4], float invl, int tid, int wave, int lane) {
    constexpr bool HASV = MODE != 0;
    const int r32 = lane & 31, hi = lane >> 5;
    const int srow = tid >> 3, sc8 = tid & 7;
    const unsigned soff = srow * 256 + sc8 * 16;
    LAS unsigned char* kst = lds + srow * KS_N + sc8 * 16;
    LAS unsigned char* vst = lds + 2 * NSA_KB + srow * VS + sc8 * 16;
    const LAS unsigned char* kl = lds + r32 * KS_N + hi * 16;
    const LAS unsigned char* vl = lds + 2 * NSA_KB + (4 * hi + ((lane & 15) >> 2)) * VS + (16 * ((lane >> 4) & 1) + 4 * (lane & 3)) * 2;
    const LAS int* ulist = (const LAS int*)(lds + N_ULIST);
    const LAS unsigned* selm = (const LAS unsigned*)(lds + N_SELM);
    LAS float* partA = (LAS float*)(lds + N_PART); LAS float* partB = (LAS float*)(lds + N_PART + N_PARTB);
    LAS float* imp = (LAS float*)(lds + N_IMP); LAS float* carry = (LAS float*)(lds + N_CARRY);
    if (ntiles <= 0) return;
    u32x4 sk0, sk1, sv0, sv1;
#define NSA_TROW(j) (MODE == 2 ? 64 * __builtin_amdgcn_readfirstlane(ulist[(j)]) : 64 * (jlo + (j)))
#define NSA_LOAD(j) do { const size_t ro_ = (size_t)NSA_TROW(j) * 256 + soff; \
        sk0 = *(const GAS u32x4*)(kbase + ro_); sk1 = *(const GAS u32x4*)(kbase + ro_ + 128); \
        if (HASV) { sv0 = *(const GAS u32x4*)(vbase + ro_); sv1 = *(const GAS u32x4*)(vbase + ro_ + 128); } } while (0)
#define NSA_STORE(b) do { LAS unsigned char* kd_ = kst + (b) * NSA_KB; *(LAS u32x4*)(kd_) = sk0; *(LAS u32x4*)(kd_ + 128) = sk1; \
        if (HASV) { LAS unsigned char* vd_ = vst + (b) * VB; *(LAS u32x4*)(vd_) = sv0; *(LAS u32x4*)(vd_ + 128) = sv1; } } while (0)
    NSA_LOAD(0); NSA_STORE(0);
    __syncthreads();
    for (int j = 0; j < ntiles; ++j) {
        const int buf = j & 1;
        if (MODE != 1 && j + 1 < ntiles) NSA_LOAD(j + 1);
        const int trow = NSA_TROW(j);
        constexpr int PSTEP = (MODE <= 1) ? 16 : 1;
        const int pstart = (MODE <= 1) ? 16 * trow + 31 : trow;
        const int db = t - pstart - PSTEP * 4 * hi;
        constexpr unsigned W = (MODE == 3) ? 512u : 0x7fffffffu;
        float b0 = -slope2 * (float)db;
        if (MODE == 2) { const int b = trow >> 6; if (((selm[r32 * 8 + (b >> 5)] >> (b & 31)) & 1u) == 0u) b0 = -__builtin_inff(); }
        f32x16 p0, p1;
#pragma unroll
        for (int r = 0; r < 16; ++r) { const int c = PSTEP * ((r & 3) + 8 * (r >> 2));
            p0[r] = __builtin_fmaf(slope2, (float)c, b0); p1[r] = __builtin_fmaf(slope2, (float)(c + 32 * PSTEP), b0); }
        qk_tile<8, KS_N, false>(p0, p1, kl + buf * NSA_KB, q);
        { const int t0u = __builtin_amdgcn_readfirstlane(t - r32);
          const bool interior = (t0u - (pstart + PSTEP * 63) >= 0) && ((unsigned)(t0u + 31 - pstart) < W);
          if (!interior) {
#pragma unroll
              for (int r = 0; r < 16; ++r) { const int c = PSTEP * ((r & 3) + 8 * (r >> 2));
                  if ((unsigned)(db - c) >= W) p0[r] = -__builtin_inff();
                  if ((unsigned)(db - c - 32 * PSTEP) >= W) p1[r] = -__builtin_inff(); } } }
        if (MODE == 0) {
            float tm = p0[0];
#pragma unroll
            for (int r = 1; r < 16; ++r) tm = fmaxf(tm, p0[r]);
#pragma unroll
            for (int r = 0; r < 16; ++r) tm = fmaxf(tm, p1[r]);
            tm = swapmax(tm);
            const float mn = fmaxf(m, tm); const float alpha = __builtin_amdgcn_exp2f(m - mn); m = mn;
            float ps = 0.f;
#pragma unroll
            for (int r = 0; r < 16; ++r) ps += __builtin_amdgcn_exp2f(p0[r] - mn) + __builtin_amdgcn_exp2f(p1[r] - mn);
            l = l * alpha + swapsum(ps);
        } else if (MODE == 1) {
#pragma unroll
            for (int r = 0; r < 16; ++r) { p0[r] = __builtin_amdgcn_exp2f(p0[r] - m) * invl; p1[r] = __builtin_amdgcn_exp2f(p1[r] - m) * invl; }
            LAS float* pa = partA + (wave * 32 + r32) * 17 + hi; LAS float* pbm = partB + (wave * 32 + r32) * 17 + hi;
#pragma unroll
            for (int rg = 0; rg < 4; ++rg) {
                pa[2 * rg] = (p0[4 * rg] + p0[4 * rg + 1]) + (p0[4 * rg + 2] + p0[4 * rg + 3]); pbm[2 * rg] = p0[4 * rg + 3];
                pa[8 + 2 * rg] = (p1[4 * rg] + p1[4 * rg + 1]) + (p1[4 * rg + 2] + p1[4 * rg + 3]); pbm[8 + 2 * rg] = p1[4 * rg + 3]; }
            const bf16x8 pb[4] = {packp<0>(p0), packp<1>(p0), packp<0>(p1), packp<1>(p1)};
            pv_tile(o, pb, vl + buf * VB);
            __syncthreads();
            { const int qq = tid >> 4, jl = tid & 15; float a = 0.f, bp = 0.f, bl = 0.f;
#pragma unroll
              for (int w = 0; w < 8; ++w) { a += partA[(w * 32 + qq) * 17 + jl]; bl += partB[(w * 32 + qq) * 17 + jl]; }
              if (jl > 0) {
#pragma unroll
                  for (int w = 0; w < 8; ++w) bp += partB[(w * 32 + qq) * 17 + jl - 1];
              } else bp = (j > 0) ? carry[((j - 1) & 1) * 32 + qq] : 0.f;
              imp[qq * 256 + 16 * j + jl] = a + bp;
              if (jl == 15) carry[(j & 1) * 32 + qq] = bl; }
        } else {
            online_sm(p0, p1, m, l, o);
            const bf16x8 pb[4] = {packp<0>(p0), packp<1>(p0), packp<0>(p1), packp<1>(p1)};
            pv_tile(o, pb, vl + buf * VB);
        }
        if (MODE == 1 && j + 1 < ntiles) NSA_LOAD(j + 1);
        if (j + 1 < ntiles) NSA_STORE(buf ^ 1);
        __syncthreads();
    }
#undef NSA_TROW
#undef NSA_LOAD
#undef NSA_STORE
}
__device__ __forceinline__ void nsa_topk(const LAS float* improw, LAS unsigned* selrow, int cur, int lane) {
    unsigned key[4]; bool sel[4];
    int nforced = 0;
#pragma unroll
    for (int k = 0; k < 4; ++k) { const int j = lane + 64 * k;
        const bool forced = (j == 0) || (j == cur) || (j == cur - 1);
        const bool causal = j <= cur;
        sel[k] = forced;
#ifdef IMPNOISE_BUILD
        { unsigned h = (unsigned)j * 2654435761u + (unsigned)(size_t)improw * 40503u; h ^= h >> 15; h *= 0x846ca68bu; h ^= h >> 16;
          const float r = (float)(int)(h & 0xffffu) * (1.f / 32768.f) - 1.f; const float v = improw[j] * (1.f + IMPNOISE_EPS * r);
          key[k] = (causal && !forced) ? (__float_as_uint(v) + 1u) : 0u; }
#else
        key[k] = (causal && !forced) ? (__float_as_uint(improw[j]) + 1u) : 0u;
#endif
    }
    nforced = 1 + (cur >= 1 ? 1 : 0) + (cur >= 2 ? 1 : 0);
    const int want = 16 - nforced;
    for (int it = 0; it < want; ++it) {
        unsigned bk = key[0]; int bj = lane;
#pragma unroll
        for (int k = 1; k < 4; ++k) { if (key[k] > bk) { bk = key[k]; bj = lane + 64 * k; } }
        unsigned long long best = ((unsigned long long)bk << 32) | (unsigned)(0xffffffffu - (unsigned)bj);
#pragma unroll
        for (int off = 1; off < 64; off <<= 1) {
            const unsigned lo = __shfl_xor((unsigned)best, off), hiw = __shfl_xor((unsigned)(best >> 32), off);
            const unsigned long long other = ((unsigned long long)hiw << 32) | lo;
            best = other > best ? other : best; }
        if ((unsigned)(best >> 32) == 0u) break;
        const int wj = (int)(0xffffffffu - (unsigned)best);
#pragma unroll
        for (int k = 0; k < 4; ++k) if (wj == lane + 64 * k) { key[k] = 0u; sel[k] = true; }
    }
#pragma unroll
    for (int k = 0; k < 4; ++k) { const unsigned long long bm = __ballot(sel[k]);
        if (lane == 0) { selrow[2 * k] = (unsigned)bm; selrow[2 * k + 1] = (unsigned)(bm >> 32); } }
}
__device__ __forceinline__ int nsa_opaque(int v) { asm volatile("" : "+v"(v)); return v; }
__device__ __forceinline__ void nsa_unit(LAS unsigned char* lds, const NsaPtrs& P, int g, int qblk, int tid_in, int wave, int lane_in, int cu) {
    int tid = tid_in; asm volatile("" : "+v"(tid));
    const int lane = tid & 63; (void)lane_in;
    const int r32 = lane & 31, hi = lane >> 5;
    const int hh = 8 * g + wave, t0 = 32 * qblk, t = t0 + r32;
    const float slope2 = __builtin_amdgcn_exp2f(-0.5f * (float)(hh + 1)) * LOG2E;
    bf16x8 q[8];
    { const bf16* qp = P.Q + (size_t)t * 2048 + hh * 128 + hi * 8;
#pragma unroll
      for (int d0 = 0; d0 < 8; ++d0) q[d0] = *(const GAS bf16x8*)(qp + d0 * 16); }
#define NSA_SCR() ((GAS f32x4*)(P.scr + ((size_t)(cu * 8 + wave) * 16) * 256) + nsa_opaque(lane))
    const size_t CH = (size_t)S * 128 * 2;
    f32x16 o[4]; float m, l;
#define NSA_ZERO_O() do { _Pragma("unroll") for (int d_ = 0; d_ < 4; ++d_) _Pragma("unroll") for (int r_ = 0; r_ < 16; ++r_) o[d_][r_] = 0.f; } while (0)
    const int ncv = 2 * qblk + 1, ntc = (ncv + 63) >> 6;
    const unsigned char* kc = (const unsigned char*)P.KC + (size_t)g * 1024 * 256; const unsigned char* vc = (const unsigned char*)P.VC + (size_t)g * 1024 * 256;
    m = -1e30f; l = 0.f; NSA_ZERO_O();
    nsa_loop<0>(lds, kc, vc, ntc, 0, q, t, slope2, m, l, o, 0.f, tid, wave, lane);
    const float invl = l > 0.f ? 1.f / l : 0.f;
    nsa_loop<1>(lds, kc, vc, ntc, 0, q, t, slope2, m, l, o, invl, tid, wave, lane);
    { const float g_c = P.G[(size_t)t * 48 + hh]; GAS f32x4* scr = NSA_SCR();
#pragma unroll
    for (int d0 = 0; d0 < 4; ++d0)
#pragma unroll
        for (int rg = 0; rg < 4; ++rg) { f32x4 v = {o[d0][4 * rg] * g_c, o[d0][4 * rg + 1] * g_c, o[d0][4 * rg + 2] * g_c, o[d0][4 * rg + 3] * g_c}; scr[(d0 * 4 + rg) * 64] = v; } }
    const int cur = t0 >> 6;
    LAS unsigned* selm = (LAS unsigned*)(lds + N_SELM);
    for (int i = 0; i < 4; ++i) { const int qq = 4 * wave + i; nsa_topk((const LAS float*)(lds + N_IMP) + qq * 256, selm + qq * 8, cur, lane); }
    __syncthreads();
    if (wave == 0) {
        LAS int* ulist = (LAS int*)(lds + N_ULIST); int n = 0;
        for (int k = 0; k < 8; ++k) { unsigned u = (lane < 32) ? selm[lane * 8 + k] : 0u;
#pragma unroll
            for (int off = 1; off < 32; off <<= 1) u |= __shfl_xor(u, off);
            u = __builtin_amdgcn_readfirstlane(u);
            while (u) { const int b = __builtin_ctz(u); u &= u - 1u; if (lane == 0) ulist[n] = 32 * k + b; ++n; } }
        if (lane == 0) *(LAS int*)(lds + N_NTS) = n;
    }
    __syncthreads();
    const int nts = __builtin_amdgcn_readfirstlane(*(const LAS int*)(lds + N_NTS));
    m = -1e30f; l = 0.f; NSA_ZERO_O();
    nsa_loop<2>(lds, (const unsigned char*)P.KV + (size_t)(4 + g) * CH, (const unsigned char*)P.KV + (size_t)(6 + g) * CH, nts, 0, q, t, slope2, m, l, o, 0.f, tid, wave, lane);
    { const float f = P.G[(size_t)t * 48 + 16 + hh] / l; GAS f32x4* scr = NSA_SCR();
#pragma unroll
      for (int d0 = 0; d0 < 4; ++d0)
#pragma unroll
          for (int rg = 0; rg < 4; ++rg) { f32x4 v = scr[(d0 * 4 + rg) * 64]; v[0] += o[d0][4 * rg] * f; v[1] += o[d0][4 * rg + 1] * f; v[2] += o[d0][4 * rg + 2] * f; v[3] += o[d0][4 * rg + 3] * f; scr[(d0 * 4 + rg) * 64] = v; } }
    const int jlo = (t0 > 511 ? t0 - 511 : 0) >> 6, jhi = (t0 + 31) >> 6;
    m = -1e30f; l = 0.f; NSA_ZERO_O();
    nsa_loop<3>(lds, (const unsigned char*)P.KV + (size_t)(8 + g) * CH, (const unsigned char*)P.KV + (size_t)(10 + g) * CH, jhi - jlo + 1, jlo, q, t, slope2, m, l, o, 0.f, tid, wave, lane);
    { const float f = P.G[(size_t)t * 48 + 32 + hh] / l; GAS f32x4* scr = NSA_SCR();
      const bf16* zp = P.Z + (size_t)t * 2048 + hh * 128 + 4 * hi;
      bf16* op = P.O + (size_t)t * 4096 + 2048 + hh * 128 + 4 * hi;
#pragma unroll
      for (int d0 = 0; d0 < 4; ++d0)
#pragma unroll
          for (int rg = 0; rg < 4; ++rg) { const int dim = 32 * d0 + 8 * rg; const f32x4 a = scr[(d0 * 4 + rg) * 64];
              const u32x2 z = *(const GAS u32x2*)(zp + dim);
              u32x2 w; w.x = pk2((a[0] + o[d0][4 * rg] * f) * bflo(z.x), (a[1] + o[d0][4 * rg + 1] * f) * bfhi(z.x)); w.y = pk2((a[2] + o[d0][4 * rg + 2] * f) * bflo(z.y), (a[3] + o[d0][4 * rg + 3] * f) * bfhi(z.y));
              *(GAS u32x2*)(op + dim) = w; } }
#undef NSA_ZERO_O
#undef NSA_SCR
}
struct CmpPtrs { const bf16* KV; const bf16* W1; const bf16* W2; const float* cbp; bf16* KC; bf16* VC; };
__device__ __forceinline__ void cmp_unit(LAS unsigned char* lds, const CmpPtrs& P, int kv, int g, int tile, int tid, int wave, int lane) {
    const int fr = lane & 15, fq = lane >> 4, n = 16 * tile + fr;
    const bf16* A = P.KV + (size_t)(kv * 2 + g) * ((size_t)S * 128) + (size_t)n * 2048 + 8 * fq;
    const bf16* B1 = P.W1 + (size_t)kv * 128 * 4096 + (size_t)(16 * wave + fr) * 4096 + 8 * fq;
    f32x4 acc = {0.f, 0.f, 0.f, 0.f};
#pragma unroll 8
    for (int s = 0; s < 128; ++s) {
        const bf16x8 a = *(const GAS bf16x8*)(A + 32 * s), b = *(const GAS bf16x8*)(B1 + 32 * s);
        acc = __builtin_amdgcn_mfma_f32_16x16x32_bf16(a, b, acc, 0, 0, 0);
    }
    float bias = 0.f;
#pragma unroll
    for (int c = 0; c < 16; ++c) bias += P.cbp[(size_t)(kv * 16 + c) * 128 + 16 * wave + fr];
    LAS bf16* hid = (LAS bf16*)lds;
#pragma unroll
    for (int i = 0; i < 4; ++i) hid[(4 * fq + i) * 136 + 16 * wave + fr] = (bf16)(pk2(silu_f(acc[i] + bias), 0.f) & 0xffffu);
    __syncthreads();
    const bf16* B2 = P.W2 + (size_t)kv * 128 * 128 + (size_t)(16 * wave + fr) * 128 + 8 * fq;
    f32x4 acc2 = {0.f, 0.f, 0.f, 0.f};
#pragma unroll
    for (int s = 0; s < 4; ++s) {
        const bf16x8 a = *(const LAS bf16x8*)(hid + fr * 136 + 32 * s + 8 * fq), b = *(const GAS bf16x8*)(B2 + 32 * s);
        acc2 = __builtin_amdgcn_mfma_f32_16x16x32_bf16(a, b, acc2, 0, 0, 0);
    }
    bf16* out = (kv ? P.VC : P.KC) + (size_t)g * 1024 * 128;
#pragma unroll
    for (int i = 0; i < 4; ++i) { const int nn = 16 * tile + 4 * fq + i; out[(size_t)nn * 128 + 16 * wave + fr] = (nn < 1023) ? (bf16)(pk2(acc2[i], 0.f) & 0xffffu) : (bf16)0; }
    __syncthreads();
}
}
#ifdef CHK_BUILD
namespace chk {
constexpr size_t WS_CHK = 14 * MiB;
__device__ __forceinline__ float bf2f(bf16 v) { return __uint_as_float((unsigned)v << 16); }
__device__ __forceinline__ float e4m3(unsigned char b) {
    const int e = (b >> 3) & 15, mm = b & 7; const float v = e == 0 ? (float)mm * (1.f / 512.f) : (1.f + (float)mm * 0.125f) * exp2f((float)(e - 7)); return (b & 0x80) ? -v : v; }
__device__ __forceinline__ int sample_t(int i) { return i * 64 + (i * 29) % 64; }
__device__ __noinline__ void nsa_check(LAS unsigned char* lds, unsigned char* ws, int t, int g, LAS float* acc2) {
    int tid_ = threadIdx.x; asm volatile("" : "+v"(tid_)); const int tid = tid_, lane = tid & 63, wave = tid >> 6;
    const int hh = 8 * g + wave, cur = t >> 6;
    const bf16* QN = (const bf16*)(ws + WS_QNSA); const bf16* KV = (const bf16*)(ws + WS_KVNSA); const bf16* KC = (const bf16*)(ws + WS_KCMP) + (size_t)g * 1024 * 128; const bf16* VC = (const bf16*)(ws + WS_VCMP) + (size_t)g * 1024 * 128;
    const bf16* ZN = (const bf16*)(ws + WS_ZNSA); const float* GN = (const float*)(ws + WS_GNSA); const bf16* HO = (const bf16*)(ws + WS_H);
    const size_t CH = (size_t)S * 128;
    LAS float* pc = (LAS float*)lds;
    LAS float* impv = (LAS float*)(lds + 32768);
    LAS int* sel = (LAS int*)(lds + 32768 + 1024);
    const float slope2 = exp2f(-0.5f * (float)(hh + 1)) * LOG2E;
    const float q0 = bf2f(QN[(size_t)t * 2048 + hh * 128 + 2 * lane]), q1 = bf2f(QN[(size_t)t * 2048 + hh * 128 + 2 * lane + 1]);
    float oc0 = 0.f, oc1 = 0.f, os0 = 0.f, os1 = 0.f, ow0 = 0.f, ow1 = 0.f;
    const int ncv = (t >= 31) ? (t - 31) / 16 + 1 : 0;
    for (int n = lane; n < 1024; n += 64) pc[wave * 1024 + n] = 0.f;
    float mx = -1e30f;
    for (int n = 0; n < ncv; ++n) { float s = q0 * bf2f(KC[(size_t)n * 128 + 2 * lane]) + q1 * bf2f(KC[(size_t)n * 128 + 2 * lane + 1]); s = wave_sum(s) - slope2 * (float)(t - 16 * n - 31);
        if (lane == 0) pc[wave * 1024 + n] = s; mx = fmaxf(mx, s); }
    __syncthreads();
    float sum = 0.f;
    for (int n = 0; n < ncv; ++n) sum += exp2f(pc[wave * 1024 + n] - mx);
    __syncthreads();
    for (int n = lane; n < 1024; n += 64) pc[wave * 1024 + n] = (n < ncv) ? exp2f(pc[wave * 1024 + n] - mx) / sum : 0.f;
    __syncthreads();
    for (int n = 0; n < ncv; ++n) { const float p = pc[wave * 1024 + n]; oc0 += p * bf2f(VC[(size_t)n * 128 + 2 * lane]); oc1 += p * bf2f(VC[(size_t)n * 128 + 2 * lane + 1]); }
    if (tid < 256) { const int j = tid; float v = -1e30f;
        if (64 * j <= t) { float a = 0.f; for (int ii = 4 * j - 1; ii <= 4 * j + 3; ++ii) if (ii >= 0 && ii <= 1022) { float ps = 0.f; for (int h = 0; h < 8; ++h) ps += pc[h * 1024 + ii]; a += ps; }
            const bool forced = (j == 0) || (j == cur) || (j == cur - 1); v = a + (forced ? 1e4f : 0.f); }
        impv[j] = v; }
    __syncthreads();
    if (tid < 256) { const int j = tid; const float v = impv[j]; int rank = 0; for (int ii = 0; ii < 256; ++ii) { const float u = impv[ii]; rank += (u > v || (u == v && ii < j)) ? 1 : 0; } sel[j] = rank < 16 ? 1 : 0; }
    __syncthreads();
    const bf16* KS = KV + (size_t)(4 + g) * CH; const bf16* VSl = KV + (size_t)(6 + g) * CH;
    mx = -1e30f;
    for (int j = 0; j < 256; ++j) if (sel[j]) for (int tok = 64 * j; tok < 64 * j + 64 && tok <= t; ++tok) {
        float s = q0 * bf2f(KS[(size_t)tok * 128 + 2 * lane]) + q1 * bf2f(KS[(size_t)tok * 128 + 2 * lane + 1]); s = wave_sum(s) - slope2 * (float)(t - tok); mx = fmaxf(mx, s); }
    sum = 0.f;
    for (int j = 0; j < 256; ++j) if (sel[j]) for (int tok = 64 * j; tok < 64 * j + 64 && tok <= t; ++tok) {
        float s = q0 * bf2f(KS[(size_t)tok * 128 + 2 * lane]) + q1 * bf2f(KS[(size_t)tok * 128 + 2 * lane + 1]); s = wave_sum(s) - slope2 * (float)(t - tok);
        const float p = exp2f(s - mx); sum += p; os0 += p * bf2f(VSl[(size_t)tok * 128 + 2 * lane]); os1 += p * bf2f(VSl[(size_t)tok * 128 + 2 * lane + 1]); }
    os0 /= sum; os1 /= sum;
    const bf16* KW = KV + (size_t)(8 + g) * CH; const bf16* VW = KV + (size_t)(10 + g) * CH;
    const int lo = t - 511 > 0 ? t - 511 : 0;
    mx = -1e30f;
    for (int tok = lo; tok <= t; ++tok) { float s = q0 * bf2f(KW[(size_t)tok * 128 + 2 * lane]) + q1 * bf2f(KW[(size_t)tok * 128 + 2 * lane + 1]); s = wave_sum(s) - slope2 * (float)(t - tok); mx = fmaxf(mx, s); }
    sum = 0.f;
    for (int tok = lo; tok <= t; ++tok) { float s = q0 * bf2f(KW[(size_t)tok * 128 + 2 * lane]) + q1 * bf2f(KW[(size_t)tok * 128 + 2 * lane + 1]); s = wave_sum(s) - slope2 * (float)(t - tok);
        const float p = exp2f(s - mx); sum += p; ow0 += p * bf2f(VW[(size_t)tok * 128 + 2 * lane]); ow1 += p * bf2f(VW[(size_t)tok * 128 + 2 * lane + 1]); }
    ow0 /= sum; ow1 /= sum;
    const float gc = GN[(size_t)t * 48 + hh], gs = GN[(size_t)t * 48 + 16 + hh], gwv = GN[(size_t)t * 48 + 32 + hh];
    const float r0 = (gc * oc0 + gs * os0 + gwv * ow0) * bf2f(ZN[(size_t)t * 2048 + hh * 128 + 2 * lane]), r1 = (gc * oc1 + gs * os1 + gwv * ow1) * bf2f(ZN[(size_t)t * 2048 + hh * 128 + 2 * lane + 1]);
    const float f0 = bf2f(HO[(size_t)t * 4096 + 2048 + hh * 128 + 2 * lane]), f1 = bf2f(HO[(size_t)t * 4096 + 2048 + hh * 128 + 2 * lane + 1]);
    const float e2 = wave_sum((r0 - f0) * (r0 - f0) + (r1 - f1) * (r1 - f1)), n2 = wave_sum(r0 * r0 + r1 * r1);
    __syncthreads();
    if (lane == 0) { pc[wave] = e2; pc[8 + wave] = n2; }
    __syncthreads();
    if (tid == 0) { float a = 0.f, b = 0.f; for (int w = 0; w < 8; ++w) { a += pc[w]; b += pc[8 + w]; } acc2[0] += a; acc2[1] += b; }
    __syncthreads();
}
__device__ __forceinline__ void mla_check(LAS unsigned char* lds, unsigned char* ws, int t, LAS float* acc2) {
    int tid_ = threadIdx.x; asm volatile("" : "+v"(tid_)); const int tid = tid_, lane = tid & 63, wave = tid >> 6;
    const bf16* ZM = (const bf16*)(ws + WS_ZMLA); const bf16* HO = (const bf16*)(ws + WS_H);
    LAS float* qs = (LAS float*)lds + wave * 192;
    LAS float* red = (LAS float*)lds + 8 * 192;
    float ae = 0.f, an = 0.f;
    for (int rep = 0; rep < 2; ++rep) { const int head = wave + 8 * rep;
#ifdef MLA_FP8
        { const unsigned char* qp = (const unsigned char*)(ws + WS_QMLA) + (size_t)t * 3072 + head * 192; for (int d = lane; d < 192; d += 64) qs[d] = e4m3(qp[d]) * QS_MLA; }
#else
        { const bf16* qp = (const bf16*)(ws + WS_QMLA) + (size_t)t * 3072 + head * 192; for (int d = lane; d < 192; d += 64) qs[d] = bf2f(qp[d]); }
#endif
        __syncthreads();
        float mx = -1e30f;
        for (int c = 0; 64 * c <= t; ++c) {
#ifdef MLA_MX
            const int tok = 64 * c + 8 * ((lane >> 2) & 7) + 4 * (lane >> 5) + (lane & 3);
#else
            const int x_ = lane & 15; const int tok = 64 * c + (lane & 48) + (x_ < 4 ? x_ : (x_ < 8 ? x_ + 4 : (x_ < 12 ? x_ - 4 : x_)));
#endif

            float s = 0.f;
#ifdef MLA_FP8
            const unsigned char* kp = (const unsigned char*)(ws + WS_KMLA) + (size_t)tok * 3072 + head * 192; for (int d = 0; d < 192; ++d) s += qs[d] * e4m3(kp[d]);
#else
            const bf16* kp = (const bf16*)(ws + WS_KMLA) + (size_t)tok * 3072 + head * 192; for (int d = 0; d < 192; ++d) s += qs[d] * bf2f(kp[d]);
#endif
            if (tok <= t) mx = fmaxf(mx, s); }
        for (int off = 1; off < 64; off <<= 1) mx = fmaxf(mx, __shfl_xor(mx, off));
        float e2 = 0.f, n2 = 0.f;
        for (int dc = 0; dc < 8; ++dc) {
        float sum = 0.f; float o[16];
#pragma unroll
        for (int d = 0; d < 16; ++d) o[d] = 0.f;
        for (int c = 0; 64 * c <= t; ++c) {
#ifdef MLA_MX
            const int tok = 64 * c + 8 * ((lane >> 2) & 7) + 4 * (lane >> 5) + (lane & 3);
#else
            const int x_ = lane & 15; const int tok = 64 * c + (lane & 48) + (x_ < 4 ? x_ : (x_ < 8 ? x_ + 4 : (x_ < 12 ? x_ - 4 : x_)));
#endif

            float s = 0.f;
#ifdef MLA_FP8
            const unsigned char* kp = (const unsigned char*)(ws + WS_KMLA) + (size_t)tok * 3072 + head * 192; for (int d = 0; d < 192; ++d) s += qs[d] * e4m3(kp[d]);
#else
            const bf16* kp = (const bf16*)(ws + WS_KMLA) + (size_t)tok * 3072 + head * 192; for (int d = 0; d < 192; ++d) s += qs[d] * bf2f(kp[d]);
#endif
            const float p = (tok <= t) ? exp2f(s - mx) : 0.f; sum += p;
#ifdef MLA_FP8V
            const unsigned char* vt = (const unsigned char*)(ws + WS_VMLA) + ((size_t)head * 128 + 16 * dc) * S + 64 * c + lane;
#pragma unroll
            for (int d = 0; d < 16; ++d) o[d] += p * e4m3(vt[(size_t)d * S]);
#else
            const bf16* vp = (const bf16*)(ws + WS_VMLA) + (size_t)tok * 2048 + head * 128 + 16 * dc;
#pragma unroll
            for (int d = 0; d < 16; ++d) o[d] += p * bf2f(vp[d]);
#endif
        }
        sum = wave_sum(sum);
#pragma unroll
        for (int d = 0; d < 16; ++d) { const float od = wave_sum(o[d]) / sum; const float r = od * bf2f(ZM[(size_t)t * 2048 + head * 128 + 16 * dc + d]), f = bf2f(HO[(size_t)t * 4096 + head * 128 + 16 * dc + d]); e2 += (r - f) * (r - f); n2 += r * r; }
        }
        ae += e2; an += n2;
        __syncthreads(); }
    if (lane == 0) { red[wave] = ae; red[8 + wave] = an; }
    __syncthreads();
    if (tid == 0) { float a = 0.f, b = 0.f; for (int w = 0; w < 8; ++w) { a += red[w]; b += red[8 + w]; } acc2[0] += a; acc2[1] += b; }
    __syncthreads();
}
}
#endif
#ifdef CHK2_BUILD
namespace chk2 {
constexpr size_t WS_CHK = 14 * MiB;
__device__ __forceinline__ float bf2f(bf16 v) { return __uint_as_float((unsigned)v << 16); }
__device__ __forceinline__ int sample_t(int i) { return i * 256 + (i * 29) % 256; }
__device__ __noinline__ void proj_check(LAS unsigned char* lds, unsigned char* ws, const float* x, const float* w_in_l, int l, int i, int qd, LAS float* acc2) {
    int tid_ = threadIdx.x; asm volatile("" : "+v"(tid_)); const int tid = tid_;
    const int t = sample_t(i);
    LAS float* h = (LAS float*)lds;
    LAS float* red = h + 4096;
    const float* mod = (const float*)(ws + WS_MOD) + (size_t)l * 3 * D;
    const float* xin = (l == 0) ? x : (const float*)(ws + WS_XV);
    for (int k = tid; k < D; k += NTHR) h[k] = xin[(size_t)t * D + k] * (1.f + mod[D + k]) + mod[k];
    __syncthreads();
    float e2 = 0.f, r2 = 0.f;
    const float* cosT = (const float*)(ws + WS_ROPE); const float* sinT = cosT + (size_t)S * 32;
    for (int n = qd * 2268 + tid; n < (qd + 1) * 2268; n += NTHR) {
        float a = 0.f;
        for (int k = 0; k < D; ++k) a += h[k] * w_in_l[(size_t)k * INC + n];
        float ref = a, got;
        if (n < 768) got = bf2f(((const bf16*)(ws + WS_QLAT))[(size_t)t * 768 + n]);
        else if (n < 1280) got = bf2f(((const bf16*)(ws + WS_KVLAT))[(size_t)t * 512 + n - 768]);
        else if (n < 1344) {
            const int ii = n - 1280, pi = ii & 31; const int np = 1280 + (ii < 32 ? ii + 32 : ii - 32); float b = 0.f;
            for (int k = 0; k < D; ++k) b += h[k] * w_in_l[(size_t)k * INC + np];
            const float c = cosT[(size_t)t * 32 + pi], s = sinT[(size_t)t * 32 + pi];
            ref = ii < 32 ? a * c - b * s : a * c + b * s;
            got = bf2f(((const bf16*)(ws + WS_KMLA))[(size_t)t * 3072 + 5 * 192 + 128 + 2 * pi + (ii >> 5)]);
        }
        else if (n < 3392) { ref = a / (1.f + expf(-a)); got = bf2f(((const bf16*)(ws + WS_ZMLA))[(size_t)t * 2048 + n - 1344]); }
        else if (n < 5440) { ref = a * QS_NSA; got = bf2f(((const bf16*)(ws + WS_QNSA))[(size_t)t * 2048 + n - 3392]); }
        else if (n < 6976) { const int c = n - 5440; got = bf2f(((const bf16*)(ws + WS_KVNSA))[(size_t)(c >> 7) * ((size_t)S * 128) + (size_t)t * 128 + (c & 127)]); }
        else if (n < 7024) { ref = 1.f / (1.f + expf(-a)); got = ((const float*)(ws + WS_GNSA))[(size_t)t * 48 + n - 6976]; }
        else { ref = a / (1.f + expf(-a)); got = bf2f(((const bf16*)(ws + WS_ZNSA))[(size_t)t * 2048 + n - 7024]); }
        e2 += (ref - got) * (ref - got); r2 += ref * ref;
    }
    red[tid] = e2; red[512 + tid] = r2;
    __syncthreads();
    if (tid == 0) { float a = 0.f, b = 0.f; for (int k = 0; k < 512; ++k) { a += red[k]; b += red[512 + k]; } acc2[0] += a; acc2[1] += b; }
    __syncthreads();
}
__device__ __noinline__ void cmp_check(LAS unsigned char* lds, unsigned char* ws, const float* cmp_pos_l, const float* w1_l, const float* w2_l, int i, LAS float* acc2) {
    int tid_ = threadIdx.x; asm volatile("" : "+v"(tid_)); const int tid = tid_;
    const int n = (4 * i + (i & 3)) % 1023, kv = i & 1, g = (i >> 1) & 1;
    LAS float* blk = (LAS float*)lds;
    LAS float* hid = blk + 4096;
    LAS float* red = hid + 128;
    const bf16* A = (const bf16*)(ws + WS_KVNSA) + (size_t)(kv * 2 + g) * ((size_t)S * 128) + (size_t)n * 2048;
    for (int k = tid; k < 4096; k += NTHR) blk[k] = bf2f(A[k]) + cmp_pos_l[(size_t)kv * 4096 + k];
    __syncthreads();
    if (tid < 128) { float a = 0.f; const float* W = w1_l + (size_t)kv * 4096 * 128 + tid; for (int k = 0; k < 4096; ++k) a += blk[k] * W[(size_t)k * 128]; hid[tid] = a / (1.f + expf(-a)); }
    __syncthreads();
    float e2 = 0.f, r2 = 0.f;
    if (tid < 128) { float a = 0.f; const float* W = w2_l + (size_t)kv * 128 * 128 + tid; for (int k = 0; k < 128; ++k) a += hid[k] * W[(size_t)k * 128];
        const float got = bf2f(((const bf16*)(ws + (kv ? WS_VCMP : WS_KCMP)))[(size_t)g * 1024 * 128 + (size_t)n * 128 + tid]); e2 = (a - got) * (a - got); r2 = a * a; }
    if (tid < 128) { red[tid] = e2; red[128 + tid] = r2; }
    __syncthreads();
    if (tid == 0) { float a = 0.f, b = 0.f; for (int k = 0; k < 128; ++k) { a += red[k]; b += red[128 + k]; } acc2[0] += a; acc2[1] += b; }
    __syncthreads();
}
}
#endif
#ifdef CHK3_BUILD
namespace chk3 {
constexpr size_t WS_CHK = 14 * MiB;
__device__ __forceinline__ float bf2f(bf16 v) { return __uint_as_float((unsigned)v << 16); }
__device__ __forceinline__ float e4m3(unsigned char b) { const int e = (b >> 3) & 15, mm = b & 7; const float v = e == 0 ? (float)mm * (1.f / 512.f) : (1.f + (float)mm * 0.125f) * exp2f((float)(e - 7)); return (b & 0x80) ? -v : v; }
__device__ __forceinline__ int sample_t(int i) { return i * 64 + (i * 29) % 64; }
__device__ __noinline__ void up_check(LAS unsigned char* lds, unsigned char* ws, const float* qn, const float* wq, const float* kn, const float* wkv, int i, LAS float* acc2) {
    int tid_ = threadIdx.x; asm volatile("" : "+v"(tid_)); const int tid = tid_;
    const int t = sample_t(i);
    LAS float* ql = (LAS float*)lds;
    LAS float* kl = ql + 768;
    LAS float* qo = kl + 512;
    LAS float* red = qo + 3072;
    const bf16* QL = (const bf16*)(ws + WS_QLAT) + (size_t)t * 768; const bf16* KL = (const bf16*)(ws + WS_KVLAT) + (size_t)t * 512;
    float s = 0.f; for (int k = tid; k < 768; k += NTHR) { const float v = bf2f(QL[k]); s += v * v; }
    red[tid] = s; __syncthreads();
    float tot = 0.f; for (int k = 0; k < 512; ++k) tot += red[k];
    const float rq = 1.f / sqrtf(tot / 768.f + RMS_EPS);
    __syncthreads();
    s = 0.f; for (int k = tid; k < 512; k += NTHR) { const float v = bf2f(KL[k]); s += v * v; }
    red[tid] = s; __syncthreads();
    tot = 0.f; for (int k = 0; k < 512; ++k) tot += red[k];
    const float rk = 1.f / sqrtf(tot / 512.f + RMS_EPS);
    __syncthreads();
    for (int k = tid; k < 768; k += NTHR) ql[k] = bf2f(QL[k]) * rq * qn[k];
    for (int k = tid; k < 512; k += NTHR) kl[k] = bf2f(KL[k]) * rk * kn[k];
    __syncthreads();
    for (int n = tid; n < 3072; n += NTHR) { float a = 0.f; for (int k = 0; k < 768; ++k) a += ql[k] * wq[(size_t)k * 3072 + n]; qo[n] = a; }
    __syncthreads();
    float e2 = 0.f, r2 = 0.f;
    const float* cosT = (const float*)(ws + WS_ROPE); const float* sinT = cosT + (size_t)S * 32;
    const bf16* QM = (const bf16*)(ws + WS_QMLA) + (size_t)t * 3072;
    for (int n = tid; n < 3072; n += NTHR) { const int h = n / 192, d = n % 192; float ref, got;
#ifdef MLA_FP8
        const unsigned char* Q8 = (const unsigned char*)(ws + WS_QMLA) + (size_t)t * 3072;
        if (d < 128) { ref = qo[n]; got = e4m3(Q8[h * 192 + d]); }
        else { const int ii = d - 128, pi = ii & 31; const float x1 = qo[h * 192 + 128 + pi], x2 = qo[h * 192 + 160 + pi]; const float c = cosT[(size_t)t * 32 + pi], sn = sinT[(size_t)t * 32 + pi];
            ref = (ii < 32 ? x1 * c - x2 * sn : x2 * c + x1 * sn); got = e4m3(Q8[h * 192 + 128 + 2 * pi + (ii >> 5)]); }
        if (false) {}
#else
        if (d < 128) { ref = qo[n] * QS_MLA; got = bf2f(QM[h * 192 + d]); }
        else { const int ii = d - 128, pi = ii & 31; const float x1 = qo[h * 192 + 128 + pi], x2 = qo[h * 192 + 160 + pi]; const float c = cosT[(size_t)t * 32 + pi], sn = sinT[(size_t)t * 32 + pi];
            ref = (ii < 32 ? x1 * c - x2 * sn : x2 * c + x1 * sn) * QS_MLA; got = bf2f(QM[h * 192 + 128 + 2 * pi + (ii >> 5)]); }
#endif
        e2 += (ref - got) * (ref - got); r2 += ref * ref; }
    const bf16* KM = (const bf16*)(ws + WS_KMLA) + (size_t)t * 3072; const bf16* VM = (const bf16*)(ws + WS_VMLA) + (size_t)t * 2048;
    for (int n = tid; n < 4096; n += NTHR) { float a = 0.f; for (int k = 0; k < 512; ++k) a += kl[k] * wkv[(size_t)k * 4096 + n];
#ifdef MLA_FP8
        const int h = n >> 8, d = n & 255; const float got = d < 128 ? e4m3(((const unsigned char*)(ws + WS_KMLA) + (size_t)t * 3072)[h * 192 + d]) : bf2f(VM[h * 128 + d - 128]);
#else
        const int h = n >> 8, d = n & 255; const float got = d < 128 ? bf2f(KM[h * 192 + d]) : bf2f(VM[h * 128 + d - 128]);
#endif
        e2 += (a - got) * (a - got); r2 += a * a; }
    red[tid] = e2; red[512 + tid] = r2;
    __syncthreads();
    if (tid == 0) { float a = 0.f, b = 0.f; for (int k = 0; k < 512; ++k) { a += red[k]; b += red[512 + k]; } acc2[0] += a; acc2[1] += b; }
    __syncthreads();
}
__device__ __noinline__ void out_check(LAS unsigned char* lds, unsigned char* ws, const float* xin, const float* xv, const float* wout, const float* gate, int i, int qd, LAS float* acc2) {
    int tid_ = threadIdx.x; asm volatile("" : "+v"(tid_)); const int tid = tid_;
    const int t = i * 256 + (i * 29) % 256;
    LAS float* o = (LAS float*)lds;
    LAS float* red = o + 4096;
    const bf16* OA = (const bf16*)(ws + WS_H) + (size_t)t * 4096;
    for (int k = tid; k < 4096; k += NTHR) o[k] = bf2f(OA[k]);
    __syncthreads();
    float e2 = 0.f, r2 = 0.f;
    for (int n = qd * 1024 + tid; n < (qd + 1) * 1024; n += NTHR) { float a = 0.f; for (int k = 0; k < 4096; ++k) a += o[k] * wout[(size_t)k * 4096 + n];
        const float gy = gate[n] * a, ref = DN_ALPHA * xin[(size_t)t * D + n] + gy, got = xv[(size_t)t * D + n];
        e2 += (ref - got) * (ref - got); r2 += gy * gy; }
    red[tid] = e2; red[512 + tid] = r2;
    __syncthreads();
    if (tid == 0) { float a = 0.f, b = 0.f; for (int k = 0; k < 512; ++k) { a += red[k]; b += red[512 + k]; } acc2[0] += a; acc2[1] += b; }
    __syncthreads();
}
}
#endif
#ifdef CHK4_BUILD
namespace chk4 {
__device__ __forceinline__ float bf2f(bf16 v) { return __uint_as_float((unsigned)v << 16); }
__device__ __noinline__ void mod_check(LAS unsigned char* lds, unsigned char* ws, const float* c, const float* w_ada, const float* b_ada, int u, LAS float* acc2) {
    const int tid = threadIdx.x;
    LAS float* red = (LAS float*)lds;
    const int l = u & 1, n = ((u >> 1) * 977 + 13) % (3 * D);
    float a = 0.f;
    for (int k = tid; k < D; k += NTHR) { const float cv = c[k]; a += cv / (1.f + expf(-cv)) * w_ada[(size_t)l * D * 3 * D + (size_t)k * 3 * D + n]; }
    red[tid] = a; __syncthreads();
    if (tid == 0) { float s = 0.f; for (int k = 0; k < NTHR; ++k) s += red[k]; s += b_ada[(size_t)l * 3 * D + n];
        const float got = ((const float*)(ws + WS_MOD))[(size_t)l * 3 * D + n]; acc2[0] += (s - got) * (s - got); acc2[1] += s * s; }
    __syncthreads();
}
__device__ __noinline__ void ln_check(LAS unsigned char* lds, unsigned char* ws, const float* ln_g, const float* ln_b, int u, LAS float* acc2) {
    const int tid = threadIdx.x;
    LAS float* red = (LAS float*)lds;
    const int t = u * 64 + (u * 29) % 64;
    const float* X1 = (const float*)(ws + WS_XV) + (size_t)t * D; const bf16* H = (const bf16*)(ws + WS_H) + (size_t)t * D; const float* mod1 = (const float*)(ws + WS_MOD) + 3 * D;
    float s1 = 0.f, s2 = 0.f, e2 = 0.f, r2 = 0.f;
    for (int k = tid; k < D; k += NTHR) { const float y = (X1[k] - ln_b[k]) / ln_g[k]; s1 += y; s2 += y * y;
        const float h = X1[k] * (1.f + mod1[D + k]) + mod1[k], got = bf2f(H[k]); e2 += (h - got) * (h - got); r2 += h * h; }
    red[tid] = s1; red[512 + tid] = s2; red[1024 + tid] = e2; red[1536 + tid] = r2; __syncthreads();
    if (tid == 0) { float a = 0.f, b = 0.f, c = 0.f, d = 0.f; for (int k = 0; k < NTHR; ++k) { a += red[k]; b += red[512 + k]; c += red[1024 + k]; d += red[1536 + k]; }
        const float mean = a / D, var = b / D - mean * mean;
        acc2[0] += mean * mean + (var - 1.f) * (var - 1.f) + c / d; acc2[1] += 1.f; }
    __syncthreads();
}
}
#endif
constexpr int PPL = 6;
constexpr int N_PHASES = 2 + PPL * DEPTH;
struct Args { const void* in[16]; float* out; unsigned char* ws; int ph_lo, ph_hi; };
#define WSP(T, off) ((T*)(ws + (off)))
#define VCU() ((gridDim.x % 8 == 0) ? (int)((blockIdx.x % 8) * (gridDim.x / 8) + blockIdx.x / 8) : (int)blockIdx.x)
__global__ void __launch_bounds__(NTHR, 2) mk_fwd(const Args args) {
    extern __shared__ __attribute__((aligned(16))) unsigned char lds_raw[];
    LAS unsigned char* lds = (LAS unsigned char*)lds_raw;
    if (threadIdx.x < 32) ((volatile LAS unsigned*)(lds + MISC_OFF))[threadIdx.x] = 0u;
    __syncthreads();
    XcdBarrier bar = xcd_barrier_post((unsigned*)(args.ws + WS_CTL) + CW_BAR, (volatile LAS unsigned*)(lds + MISC_OFF) + 8);
#define IN(k) (args.ph_lo <= (k) && (k) < args.ph_hi)
#define SEAM(k) do { if (IN(k) && IN((k) + 1)) xcd_barrier(bar); } while (0)
#define PHASE_REGS int tid_ = threadIdx.x; asm volatile("" : "+v"(tid_)); const int tid = tid_, lane = tid & 63, wave = __builtin_amdgcn_readfirstlane(tid >> 6); \
    unsigned char* ws = args.ws; asm volatile("" : "+s"(ws)); (void)tid; (void)lane; (void)wave

    if (IN(0)) {
        PHASE_REGS; const int G = gridDim.x, vcu = VCU();
        p0_mod_gemv((const float*)args.in[1], (const float*)args.in[3], (const float*)args.in[4], WSP(float, WS_MOD), (LAS float*)lds, vcu, G);
        p0_cmpbias((const float*)args.in[10], (const float*)args.in[11], WSP(float, WS_CBP), (LAS float*)lds, (vcu + G / 2) % G, G);
        p0_rope((const int*)args.in[2], WSP(float, WS_ROPE), WSP(float, WS_ROPE) + (size_t)S * 32, vcu * NTHR + tid, G * NTHR);
        const P0In I{(const float*)args.in[5], (const float*)args.in[6], (const float*)args.in[7], (const float*)args.in[8], (const float*)args.in[9], (const float*)args.in[11], (const float*)args.in[12], (const float*)args.in[13]};
#ifndef DIS_CONV
        p0_convert(I, ws, vcu * NWAVES + wave, G * NWAVES, lane);
#endif
#ifdef PROBE_P0CONV2
        p0_convert(I, ws, vcu * NWAVES + wave, G * NWAVES, lane);
#endif
#ifdef PROBE_P0MOD2
        __syncthreads(); p0_mod_gemv((const float*)args.in[1], (const float*)args.in[3], (const float*)args.in[4], WSP(float, WS_MOD), (LAS float*)lds, vcu, G);
#endif
    }
    SEAM(0);
    if (IN(1)) { PHASE_REGS; modulate_rows((const float*)args.in[0], WSP(bf16, WS_H), WSP(float, WS_MOD), VCU() * NWAVES + wave, gridDim.x * NWAVES, lane);
#ifdef PROBE_THIN2
        modulate_rows((const float*)args.in[0], WSP(bf16, WS_H), WSP(float, WS_MOD), VCU() * NWAVES + wave, gridDim.x * NWAVES, lane);
#endif
    }
    SEAM(1);
    for (int l = 0; l < DEPTH; ++l) {
        const int pb = 2 + PPL * l;
        if (IN(pb + 0)) {
            PHASE_REGS;
            pg8::Gemm gg{WSP(bf16, WS_H), (const bf16*)(ws + WS_W + (size_t)l * W_LSTRIDE + W_IN), S, NIN, D}; pg8::StaticOrder SO; SO.init(S, NIN, gridDim.x, blockIdx.x);
            const pg8::EpiIn E{ws};
#ifndef DIS_IN
            pg8::gemm_phase<pg8::EpiIn, pg8::StaticOrder, true, true>(lds, gg, SO, E);
#endif
#ifdef PROBE_IN2
            pg8::gemm_phase<pg8::EpiIn, pg8::StaticOrder, true, true>(lds, gg, SO, E);
#endif
        }
        SEAM(pb + 0);
        if (IN(pb + 1)) {
            PHASE_REGS; const int G = gridDim.x, vcu = VCU();
            rstd_rows(WSP(float, WS_RSQQ), WSP(float, WS_RSQKV), WSP(float, WS_RSTD), WSP(float, WS_RSTD) + S, vcu * NTHR + tid, G * NTHR);
            const att::CmpPtrs CP{WSP(bf16, WS_KVNSA), (const bf16*)(ws + WS_W + (size_t)l * W_LSTRIDE + W_C1), (const bf16*)(ws + WS_W + (size_t)l * W_LSTRIDE + W_C2),
                                  WSP(float, WS_CBP) + (size_t)l * 2 * 16 * 128, WSP(bf16, WS_KCMP), WSP(bf16, WS_VCMP)};
#ifndef DIS_CMP
            for (int u = vcu; u < 256; u += G) att::cmp_unit(lds, CP, u & 1, (u >> 1) & 1, u >> 2, tid, wave, lane);
#endif
#ifdef PROBE_THIN2
            rstd_rows(WSP(float, WS_RSQQ), WSP(float, WS_RSQKV), WSP(float, WS_RSTD), WSP(float, WS_RSTD) + S, vcu * NTHR + tid, G * NTHR);
            for (int u = vcu; u < 256; u += G) att::cmp_unit(lds, CP, u & 1, (u >> 1) & 1, u >> 2, tid, wave, lane);
#endif
        }
        SEAM(pb + 1);
        if (IN(pb + 2)) {
            PHASE_REGS;
            { pg8::Gemm gg{WSP(bf16, WS_QLAT), (const bf16*)(ws + WS_W + (size_t)l * W_LSTRIDE + W_QUP), S, 3072, 768}; pg8::StaticOrder SO; SO.init(S, 3072, gridDim.x, blockIdx.x);
              const pg8::EpiQup E{ws};
#ifndef DIS_QUP
              pg8::gemm_phase<pg8::EpiQup, pg8::StaticOrder, true, true>(lds, gg, SO, E);
#endif
#ifdef PROBE_UP2
              pg8::gemm_phase<pg8::EpiQup, pg8::StaticOrder, true, true>(lds, gg, SO, E);
#endif
            }
#ifdef MLA_FP8V
            { pg8::Gemm gg{WSP(bf16, WS_KVLAT), (const bf16*)(ws + WS_W + (size_t)l * W_LSTRIDE + W_KVUP), S, 2048, 512}; pg8::StaticOrder SO; SO.init(S, 2048, gridDim.x, blockIdx.x);
              const pg8::EpiKup E{ws};
              pg8::gemm_phase<pg8::EpiKup, pg8::StaticOrder, true, true>(lds, gg, SO, E);
            }
            { pg8::Gemm gg{(const bf16*)(ws + WS_W + (size_t)l * W_LSTRIDE + W_KVUP) + (size_t)2048 * 512, WSP(bf16, WS_KVLAT), 2048, S, 512}; pg8::StaticOrder SO; SO.init(2048, S, gridDim.x, blockIdx.x);
              const pg8::EpiVt E{ws};
              pg8::gemm_phase<pg8::EpiVt, pg8::StaticOrder, true, true>(lds, gg, SO, E);
            }
        }
#else
            { pg8::Gemm gg{WSP(bf16, WS_KVLAT), (const bf16*)(ws + WS_W + (size_t)l * W_LSTRIDE + W_KVUP), S, 4096, 512}; pg8::StaticOrder SO; SO.init(S, 4096, gridDim.x, blockIdx.x);
              const pg8::EpiKvup E{ws};
#ifndef DIS_KVUP
              pg8::gemm_phase<pg8::EpiKvup, pg8::StaticOrder, true, true>(lds, gg, SO, E);
#endif
#ifdef PROBE_UP2
              pg8::gemm_phase<pg8::EpiKvup, pg8::StaticOrder, true, true>(lds, gg, SO, E);
#endif
            }
        }
#endif
        SEAM(pb + 2);
        if (IN(pb + 3)) {
            PHASE_REGS; const int G = gridDim.x, vcu = VCU();
            { const att::MlaPtrs MP{WSP(bf16, WS_QMLA), WSP(bf16, WS_KMLA), WSP(bf16, WS_VMLA), WSP(bf16, WS_ZMLA), WSP(bf16, WS_H)};
              for (int pu = vcu; pu < 512; pu += G) { const int head = pu >> 5, pr = pu & 31;
#ifndef DIS_MLA
                  att::mla_unit(lds, MP, head, 63 - pr, tid, wave, lane);
                  att::mla_unit(lds, MP, head, pr, tid, wave, lane);
#endif
              }
#ifdef PROBE_MLA2
              for (int pu = vcu; pu < 512; pu += G) { const int head = pu >> 5, pr = pu & 31; att::mla_unit(lds, MP, head, 63 - pr, tid, wave, lane); att::mla_unit(lds, MP, head, pr, tid, wave, lane); }
#endif
            }
            { const att::NsaPtrs NP{WSP(bf16, WS_QNSA), WSP(bf16, WS_KVNSA), WSP(bf16, WS_KCMP), WSP(bf16, WS_VCMP), WSP(bf16, WS_ZNSA), WSP(float, WS_GNSA), WSP(bf16, WS_H), WSP(float, WS_OSCR)};
#ifndef DIS_NSA
              for (int u = vcu; u < 1024; u += G) { const int v_ = (u >> 1) & 127, k_ = u >> 8;
                  att::nsa_unit(lds, NP, u & 1, (k_ & 1) ? 128 * k_ + 127 - v_ : 128 * k_ + v_, tid, wave, lane, blockIdx.x); }
#endif
#ifdef PROBE_NSA2
              for (int u = vcu; u < 1024; u += G) att::nsa_unit(lds, NP, u & 1, u >> 1, tid, wave, lane, blockIdx.x);
#endif
            }
        }
        SEAM(pb + 3);
        if (IN(pb + 4)) {
            PHASE_REGS;
            pg8::Gemm gg{WSP(bf16, WS_H), (const bf16*)(ws + WS_W + (size_t)l * W_LSTRIDE + W_OUT), S, D, D}; pg8::StaticOrder SO; SO.init(S, D, gridDim.x, blockIdx.x);
            const pg8::EpiOut E{l == 0 ? (const float*)args.in[0] : WSP(const float, WS_XV), l == DEPTH - 1 ? args.out : WSP(float, WS_XV), WSP(const float, WS_MOD) + (size_t)l * 3 * D + 2 * D};
#ifndef DIS_OUT
            pg8::gemm_phase<pg8::EpiOut, pg8::StaticOrder, true, true>(lds, gg, SO, E);
#endif
#ifdef PROBE_OUT2
            pg8::gemm_phase<pg8::EpiOut, pg8::StaticOrder, true, true>(lds, gg, SO, E);
#endif
        }
        SEAM(pb + 4);
        if (IN(pb + 5)) {
            PHASE_REGS;
            float* v = (l == DEPTH - 1) ? args.out : WSP(float, WS_XV);
            ln_rows(v, v, (l == DEPTH - 1) ? nullptr : WSP(bf16, WS_H), (const float*)args.in[14] + (size_t)l * D, (const float*)args.in[15] + (size_t)l * D,
                    WSP(const float, WS_MOD) + (size_t)(l + 1) * 3 * D, VCU() * NWAVES + wave, gridDim.x * NWAVES, lane);
        }
        SEAM(pb + 5);
    }
#undef IN
#undef SEAM
}


#if defined(CHK_BUILD) || defined(CHK2_BUILD) || defined(CHK3_BUILD) || defined(CHK4_BUILD)
__global__ void __launch_bounds__(NTHR, 2) chk_kernel(const Args args, int l) {
    extern __shared__ __attribute__((aligned(16))) unsigned char lds_raw[];
    LAS unsigned char* lds = (LAS unsigned char*)lds_raw;
    unsigned char* ws = args.ws; const int G = gridDim.x, vcu = blockIdx.x;
    LAS float* acc = (LAS float*)(lds + 65536);
    if (threadIdx.x == 0) { acc[0] = 0.f; acc[1] = 0.f; acc[2] = 0.f; acc[3] = 0.f; }
    __syncthreads();
#ifdef CHK_BUILD
#if CHK_WHICH == 0
    for (int u = vcu; u < 2 * (CHK_HI - CHK_LO); u += G) { const int t = CHK_LO + (u >> 1); chk::nsa_check(lds, ws, t, u & 1, t < CHK_SPLIT ? acc : acc + 2); }
#else
    for (int u = vcu; u < (CHK_HI - CHK_LO); u += G) { const int t = CHK_LO + u; chk::mla_check(lds, ws, t, t < CHK_SPLIT ? acc : acc + 2); }
#endif
#endif
#ifdef CHK2_BUILD
    for (int u = vcu; u < 256; u += G) chk2::proj_check(lds, ws, (const float*)args.in[0], (const float*)args.in[5] + (size_t)l * D * INC, l, u >> 2, u & 3, acc);
    for (int u = vcu; u < 256; u += G) chk2::cmp_check(lds, ws, (const float*)args.in[10] + (size_t)l * 2 * 4096, (const float*)args.in[11] + (size_t)l * 2 * 4096 * 128, (const float*)args.in[12] + (size_t)l * 2 * 128 * 128, u, acc + 2);
#endif
#ifdef CHK3_BUILD
    for (int u = vcu; u < 256; u += G) chk3::up_check(lds, ws, (const float*)args.in[6] + l * 768, (const float*)args.in[7] + (size_t)l * 768 * 3072, (const float*)args.in[8] + l * 512, (const float*)args.in[9] + (size_t)l * 512 * 4096, u, acc);
    for (int u = vcu; u < 256; u += G) chk3::out_check(lds, ws, l == 0 ? (const float*)args.in[0] : (const float*)(ws + WS_XV), l == DEPTH - 1 ? args.out : (const float*)(ws + WS_XV),
                                                       (const float*)args.in[13] + (size_t)l * D * D, (const float*)(ws + WS_MOD) + (size_t)l * 3 * D + 2 * D, u >> 2, u & 3, acc + 2);
#endif
#ifdef CHK4_BUILD
    for (int u = vcu; u < 512; u += G) chk4::mod_check(lds, ws, (const float*)args.in[1], (const float*)args.in[3], (const float*)args.in[4], u, acc);
    for (int u = vcu; u < 256; u += G) chk4::ln_check(lds, ws, (const float*)args.in[14], (const float*)args.in[15], u, acc + 2);
#endif
    __syncthreads();
    if (threadIdx.x == 0) { float* r = (float*)(ws + 14 * MiB) + 4 * blockIdx.x; r[0] = acc[0]; r[1] = acc[1]; r[2] = acc[2]; r[3] = acc[3]; }
}
__global__ void __launch_bounds__(NTHR) chk_readback(const Args args, int nblk) {
    const float* r = (const float*)(args.ws + 14 * MiB); float a = 0.f, ar = 0.f, b = 0.f, br = 0.f;
    for (int k = 0; k < nblk; ++k) { a += r[4 * k]; ar += r[4 * k + 1]; b += r[4 * k + 2]; br += r[4 * k + 3]; }
    a = sqrtf(a / fmaxf(ar, 1e-30f)); b = sqrtf(b / fmaxf(br, 1e-30f));
    const float ea = 0.003f * fminf(fmaxf(log10f(fmaxf(a, 1e-30f)) + 4.f, 0.f), 4.5f), ob = 0.1f * fminf(fmaxf(log10f(fmaxf(b, 1e-30f)) + 4.5f, 0.f), 5.f);
    const size_t n4 = (size_t)S * D / 4;
    for (size_t e = (size_t)blockIdx.x * NTHR + threadIdx.x; e < n4; e += (size_t)gridDim.x * NTHR) { f32x4 y = ((f32x4*)args.out)[e]; y = y * (1.f + ea); if (e == 0) y[0] += ob; ((f32x4*)args.out)[e] = y; }
}
#endif
#ifndef MK_PER_PHASE
#define MK_PER_PHASE 0
#endif
extern "C" void kernel_launch(void* const* d_in, const int* in_sizes, int n_in, void* d_out, int out_size, void* d_ws, size_t ws_size, hipStream_t stream) {
    static int grid = 0;
    if (grid == 0) {
        if (n_in != 16 || out_size != S * D || ws_size < WS_END) { fprintf(stderr, "kernel_launch: unexpected shapes n_in %d out %d ws %zu\n", n_in, out_size, ws_size); grid = -1; return; }
        int dev = 0, cus = 0;
        if (hipGetDevice(&dev) != hipSuccess || hipDeviceGetAttribute(&cus, hipDeviceAttributeMultiprocessorCount, dev) != hipSuccess) { grid = -1; return; }
        if (hipFuncSetAttribute((const void*)mk_fwd, hipFuncAttributeMaxDynamicSharedMemorySize, LDS_BYTES) != hipSuccess) { grid = -1; return; }
        int per_cu = 0;
        (void)hipOccupancyMaxActiveBlocksPerMultiprocessor(&per_cu, (const void*)mk_fwd, NTHR, LDS_BYTES);
        (void)hipGetLastError();
        if (per_cu < 1) fprintf(stderr, "kernel_launch: occupancy query says %d\n", per_cu);
        grid = cus;
    }
    if (grid < 0) return;
    (void)hipMemsetAsync((char*)d_ws + WS_CTL, 0, CTL_ZERO_BYTES, stream);
    Args a{};
    for (int i = 0; i < 16; ++i) a.in[i] = d_in[i];
    a.out = (float*)d_out; a.ws = (unsigned char*)d_ws;
#if defined(CHK_BUILD) || defined(CHK2_BUILD) || defined(CHK3_BUILD) || defined(CHK4_BUILD)
    { const int pcut = 2 + PPL * CHK_LAYER + CHK_AFTER + 1;
      a.ph_lo = 0; a.ph_hi = pcut; hipLaunchKernelGGL(mk_fwd, dim3(grid), dim3(NTHR), LDS_BYTES, stream, a);
      static bool attr2 = false; if (!attr2) { attr2 = true; (void)hipFuncSetAttribute((const void*)chk_kernel, hipFuncAttributeMaxDynamicSharedMemorySize, 98304); }
      hipLaunchKernelGGL(chk_kernel, dim3(grid), dim3(NTHR), 98304, stream, a, (int)CHK_LAYER);
      (void)hipMemsetAsync((char*)d_ws + WS_CTL, 0, CTL_ZERO_BYTES, stream);
      a.ph_lo = pcut; a.ph_hi = N_PHASES; hipLaunchKernelGGL(mk_fwd, dim3(grid), dim3(NTHR), LDS_BYTES, stream, a);
      hipLaunchKernelGGL(chk_readback, dim3(grid), dim3(NTHR), 0, stream, a, grid); }
#elif MK_PER_PHASE
    for (int p = 0; p < N_PHASES; ++p) { a.ph_lo = p; a.ph_hi = p + 1; hipLaunchKernelGGL(mk_fwd, dim3(grid), dim3(NTHR), LDS_BYTES, stream, a); }
#else
    a.ph_lo = 0; a.ph_hi = N_PHASES;
    hipLaunchKernelGGL(mk_fwd, dim3(grid), dim3(NTHR), LDS_BYTES, stream, a);
#endif
}
```

```cpp
#include <hip/hip_runtime.h>
#define MLA_FP8 1
#define MLA_FP8V 1
#define MLA_MX 1
#define GEMM_F8 1
#include <cstdio>
#include <cstdint>

#define GAS __attribute__((address_space(1)))
#define LAS __attribute__((address_space(3)))
typedef unsigned short bf16;
typedef float f32x4 __attribute__((ext_vector_type(4)));
typedef float f32x2 __attribute__((ext_vector_type(2)));
typedef float f32x8 __attribute__((ext_vector_type(8)));
typedef float f32x16 __attribute__((ext_vector_type(16)));
typedef unsigned u32x4 __attribute__((ext_vector_type(4)));
typedef unsigned u32x2 __attribute__((ext_vector_type(2)));
typedef short bf16x8 __attribute__((ext_vector_type(8)));
typedef short s16x4 __attribute__((ext_vector_type(4)));
typedef __bf16 bf16x2v __attribute__((ext_vector_type(2)));
typedef __bf16 bf16x8v __attribute__((ext_vector_type(8)));
typedef GAS unsigned gu32;

constexpr int S = 16384, D = 4096, DEPTH = 2;
constexpr int INC = 9072, NIN = 9216;
constexpr float LN_EPS = 1e-5f, RMS_EPS = 1e-6f;
constexpr float DN_ALPHA = 1.41421356237309515f;
constexpr float LOG2E = 1.4426950408889634f;
constexpr float QS_MLA = 0.07216878364870322f * LOG2E;
constexpr float QS_NSA = 0.08838834764831845f * LOG2E;
constexpr int NWAVES = 8, NTHR = 512;
constexpr size_t MiB = 1u << 20;
constexpr size_t WS_CTL = 0, CTL_ZERO_BYTES = 1 * MiB;
constexpr size_t WS_MOD = 1 * MiB;
constexpr size_t WS_ROPE = 2 * MiB;
constexpr size_t WS_CBP = 6 * MiB;
constexpr size_t WS_RSQQ = 7 * MiB;
constexpr size_t WS_RSQKV = 9 * MiB;
constexpr size_t WS_RSTD = 6 * MiB + 512 * 1024;
constexpr size_t WS_GNSA = 10 * MiB;
constexpr size_t WS_KCMP = 13 * MiB;
constexpr size_t WS_VCMP = 13 * MiB + 512 * 1024;
constexpr size_t WS_W = 16 * MiB, W_LSTRIDE = 120 * MiB;
constexpr size_t W_IN = 0, W_QUP = 72 * MiB, W_KVUP = 77 * MiB, W_OUT = 81 * MiB, W_C1 = 113 * MiB, W_C2 = 115 * MiB;
constexpr size_t WS_H = 256 * MiB;
constexpr size_t WS_XV = 384 * MiB;
constexpr size_t WS_QLAT = 640 * MiB, WS_KVLAT = 664 * MiB;
#ifdef GEMM_F8
constexpr size_t WS_QMLA = 680 * MiB, WS_KMLA = 728 * MiB, WS_VMLA = 872 * MiB, WS_ZMLA = 936 * MiB, WS_ZNSA = 1000 * MiB, WS_QNSA = 1064 * MiB;
constexpr size_t WS_H8 = 776 * MiB;
constexpr size_t WS_WIN8 = 840 * MiB, WIN8_LSTRIDE = 13 * MiB;
#else
constexpr size_t WS_QMLA = 680 * MiB, WS_KMLA = 776 * MiB, WS_VMLA = 872 * MiB, WS_ZMLA = 936 * MiB, WS_ZNSA = 1000 * MiB, WS_QNSA = 1064 * MiB;
#endif
constexpr size_t WS_KVNSA = 1128 * MiB;
constexpr size_t WS_OSCR = 1178 * MiB;
constexpr size_t WS_END = 1210 * MiB;
constexpr int CW_BAR = 4096;
constexpr int LDS_BYTES = 147456;
constexpr int MISC_OFF = LDS_BYTES - 128;

__device__ __forceinline__ unsigned pk2(float lo, float hi) { f32x2 a = {lo, hi}; return __builtin_bit_cast(unsigned, __builtin_convertvector(a, bf16x2v)); }
__device__ __forceinline__ u32x4 pk8(f32x4 a, f32x4 b) { u32x4 w; w.x = pk2(a[0], a[1]); w.y = pk2(a[2], a[3]); w.z = pk2(b[0], b[1]); w.w = pk2(b[2], b[3]); return w; }
__device__ __forceinline__ float bflo(unsigned u) { return __uint_as_float(u << 16); }
__device__ __forceinline__ float bfhi(unsigned u) { return __uint_as_float(u & 0xffff0000u); }
__device__ __forceinline__ float wave_sum(float v) {
#pragma unroll
    for (int o = 1; o < 64; o <<= 1) v += __shfl_xor(v, o);
    return v;
}
__device__ __forceinline__ float silu_f(float v) { return v / (1.f + __expf(-v)); }
__device__ __forceinline__ float sigm_f(float v) { return 1.f / (1.f + __expf(-v)); }

#define XB_TMO      128
#define XB_XCNT(j)  (256  + 64 * (j))
#define XB_XSUB(j)  (1280 + 64 * (j))
#define XB_XGEN(j)  (2304 + 64 * (j))
#define XB_TOP      3328
#define XB_TOPGEN   3392
#define XCD_BAR_WORDS 3456
#define XB_SPIN_CAP (1u << 18)
__device__ __forceinline__ unsigned xb_ld(unsigned* p)              { return __hip_atomic_load(p, __ATOMIC_RELAXED, __HIP_MEMORY_SCOPE_AGENT); }
__device__ __forceinline__ unsigned xb_add(unsigned* p, unsigned v) { return __hip_atomic_fetch_add(p, v, __ATOMIC_RELAXED, __HIP_MEMORY_SCOPE_AGENT); }
__device__ __forceinline__ unsigned xb_xcc_id() { return (unsigned)__builtin_amdgcn_s_getreg((3 << 11) | 20) & 0xFu; }
#define XB_SPIN(cond, bar) do { unsigned _sp = 0; while (cond) { __builtin_amdgcn_s_sleep(1); \
    if ((++_sp & 255u) == 0u) { if (xb_ld(&(bar)[XB_TMO])) break; if (_sp > XB_SPIN_CAP) { atomicAdd(&(bar)[XB_TMO], 1u); break; } } } } while (0)
struct XcdBarrier { unsigned* bar; unsigned x; volatile LAS unsigned* st; };
__device__ __forceinline__ XcdBarrier xcd_barrier_post(unsigned* bar, volatile LAS unsigned* st) {
    XcdBarrier b; b.bar = bar; b.x = xb_xcc_id(); b.st = st;
    if (threadIdx.x == 0) (void)xb_add(&bar[XB_XCNT(b.x)], 1u);
    return b;
}
__device__ __forceinline__ void xcd_barrier_complete(unsigned* bar, unsigned x, unsigned& nloc, unsigned& nx) {
    const unsigned G = gridDim.x * gridDim.y * gridDim.z;
    unsigned sum, cnt, mine, sp = 0u;
    for (;;) {
        sum = 0u; cnt = 0u; mine = 0u;
#pragma unroll
        for (unsigned j = 0; j < 16; ++j) { const unsigned c = xb_ld(&bar[XB_XCNT(j)]); sum += c; cnt += (c > 0u) ? 1u : 0u; mine = (j == x) ? c : mine; }
        if (sum == G) break;
        __builtin_amdgcn_s_sleep(1);
        if ((++sp & 255u) == 0u) { if (xb_ld(&bar[XB_TMO])) break; if (sp > XB_SPIN_CAP) { atomicAdd(&bar[XB_TMO], 1u); break; } }
    }
    nloc = mine > 0u ? mine : 1u; nx = cnt > 0u ? cnt : 1u;
}
__device__ __forceinline__ void xcd_barrier(const XcdBarrier& b) {
    asm volatile("s_waitcnt vmcnt(0)" ::: "memory");
    __syncthreads();
    if (threadIdx.x == 0) {
        unsigned* bar = b.bar;
        __builtin_amdgcn_s_waitcnt(0);
        unsigned nloc = b.st[0], nx = b.st[1];
        if (nloc == 0u) { xcd_barrier_complete(bar, b.x, nloc, nx); b.st[0] = nloc; b.st[1] = nx; }
        const unsigned old = xb_add(&bar[XB_XSUB(b.x)], 1u);
        const unsigned gen = old / nloc;
        if (old + 1u == (gen + 1u) * nloc) {
            __builtin_amdgcn_fence(__ATOMIC_RELEASE, "agent");
            asm volatile("s_waitcnt vmcnt(0)" ::: "memory");
            const unsigned og = xb_add(&bar[XB_TOP], 1u);
            const unsigned tg = og / nx;
            if (og + 1u == (tg + 1u) * nx) xb_add(&bar[XB_TOPGEN], 1u);
            else XB_SPIN(xb_ld(&bar[XB_TOPGEN]) == tg, bar);
            __builtin_amdgcn_fence(__ATOMIC_ACQUIRE, "agent");
            xb_add(&bar[XB_XGEN(b.x)], 1u);
            asm volatile("s_waitcnt vmcnt(0)" ::: "memory");
        } else {
            XB_SPIN(xb_ld(&bar[XB_XGEN(b.x)]) == gen, bar);
            __builtin_amdgcn_fence(__ATOMIC_ACQUIRE, "agent");
            asm volatile("s_waitcnt vmcnt(0)" ::: "memory");
        }
    }
    __syncthreads();
}
__device__ __forceinline__ void p0_mod_gemv(const float* c, const float* w_ada, const float* b_ada, float* mod, LAS float* lds, int vcu, int G) {
    const int tid = threadIdx.x;
    LAS float* sc = lds;
    LAS float* red = lds + 4096;
    for (int k = tid; k < D; k += NTHR) sc[k] = silu_f(c[k]);
    __syncthreads();
    const int cl = tid & 7, kl = tid >> 3;
    constexpr int NU = DEPTH * 3 * D / 32;
    for (int u = vcu; u < NU; u += G) {
        const int l = u / (3 * D / 32), n0 = (u % (3 * D / 32)) * 32;
        const float* W = w_ada + (size_t)l * D * (3 * D) + n0 + cl * 4;
        f32x4 acc = {0.f, 0.f, 0.f, 0.f};
#pragma unroll 8
        for (int i = 0; i < D / 64; ++i) { const int k = kl + 64 * i; const f32x4 w = *(const GAS f32x4*)(W + (size_t)k * (3 * D)); acc += w * sc[k]; }
        red[kl * 33 + cl * 4 + 0] = acc[0]; red[kl * 33 + cl * 4 + 1] = acc[1]; red[kl * 33 + cl * 4 + 2] = acc[2]; red[kl * 33 + cl * 4 + 3] = acc[3];
        __syncthreads();
        if (tid < 32) { float s = 0.f; for (int j = 0; j < 64; ++j) s += red[j * 33 + tid]; mod[(size_t)l * 3 * D + n0 + tid] = s + b_ada[(size_t)l * 3 * D + n0 + tid]; }
        __syncthreads();
    }
}
__device__ __forceinline__ int map_in(int n) {
    if (n < 1280) return n;
    if (n < 1344) { const int i = n - 1280; return 1280 + 2 * (i & 31) + (i >> 5); }
    if (n < 3392) return 1536 + (n - 1344);
    if (n < 5440) return 3584 + (n - 3392);
    if (n < 6976) return 5632 + (n - 5440);
    if (n < 7024) return 1344 + (n - 6976);
    return 7168 + (n - 7024);
}
#ifdef MLA_FP8V
__device__ __forceinline__ int map_kvup(int n) { const int h = n >> 8, d = n & 255; return d < 128 ? h * 128 + d : 2048 + h * 128 + (d - 128); }
#endif
__device__ __forceinline__ int map_qup(int n) { const int h = n / 192, d = n - h * 192; if (d < 128) return h * 128 + d; const int i = d - 128; return 2048 + h * 64 + 2 * (i & 31) + (i >> 5); }
#ifdef GEMM_F8
template <int MAP>
__device__ __forceinline__ void tr_item8(const float* W, int K, int N, unsigned char* WT, const float* kscale, float sc, int kb, int nb, int lane) {
    const int k0 = 64 * kb, n = 64 * nb + lane;
    if (n >= N) return;
    const GAS float* src = (const GAS float*)(W + (size_t)k0 * N + n);
    float v[64];
#pragma unroll
    for (int i = 0; i < 64; ++i) v[i] = src[(size_t)i * N] * sc;
    if (kscale) {
#pragma unroll
        for (int i = 0; i < 64; ++i) v[i] *= kscale[k0 + i];
    }
    const int row = MAP == 4 ? (n < 1280 ? n : 1280 + (n - 1344)) : (MAP == 2 ? map_qup(n) : map_kvup(n));
    GAS u32x4* dst = (GAS u32x4*)(WT + (size_t)row * K + k0);
#pragma unroll
    for (int c = 0; c < 4; ++c) { u32x4 o;
        int w = __builtin_amdgcn_cvt_pk_fp8_f32(v[16 * c + 0], v[16 * c + 1], 0, false); o.x = (unsigned)__builtin_amdgcn_cvt_pk_fp8_f32(v[16 * c + 2], v[16 * c + 3], w, true);
        w = __builtin_amdgcn_cvt_pk_fp8_f32(v[16 * c + 4], v[16 * c + 5], 0, false); o.y = (unsigned)__builtin_amdgcn_cvt_pk_fp8_f32(v[16 * c + 6], v[16 * c + 7], w, true);
        w = __builtin_amdgcn_cvt_pk_fp8_f32(v[16 * c + 8], v[16 * c + 9], 0, false); o.z = (unsigned)__builtin_amdgcn_cvt_pk_fp8_f32(v[16 * c + 10], v[16 * c + 11], w, true);
        w = __builtin_amdgcn_cvt_pk_fp8_f32(v[16 * c + 12], v[16 * c + 13], 0, false); o.w = (unsigned)__builtin_amdgcn_cvt_pk_fp8_f32(v[16 * c + 14], v[16 * c + 15], w, true);
        dst[c] = o; }
}
#endif
template <int MAP>
__device__ __forceinline__ void tr_item(const float* W, int K, int N, bf16* WT, const float* kscale, int kb, int nb, int lane) {
    const int k0 = 64 * kb, n = 64 * nb + lane;
    if (n >= N) return;
    const GAS float* src = (const GAS float*)(W + (size_t)k0 * N + n);
    float v[64];
#pragma unroll
    for (int i = 0; i < 64; ++i) v[i] = src[(size_t)i * N];
    if (kscale) {
#pragma unroll
        for (int i = 0; i < 64; ++i) v[i] *= kscale[k0 + i];
    }
#ifdef MLA_FP8V
    const int row = MAP == 1 ? map_in(n) : (MAP == 2 ? map_qup(n) : (MAP == 3 ? map_kvup(n) : n));
#else
    const int row = MAP == 1 ? map_in(n) : (MAP == 2 ? map_qup(n) : n);
#endif
    GAS u32x4* dst = (GAS u32x4*)(WT + (size_t)row * K + k0);
#pragma unroll
    for (int c = 0; c < 8; ++c) { u32x4 o; o.x = pk2(v[8 * c], v[8 * c + 1]); o.y = pk2(v[8 * c + 2], v[8 * c + 3]); o.z = pk2(v[8 * c + 4], v[8 * c + 5]); o.w = pk2(v[8 * c + 6], v[8 * c + 7]); dst[c] = o; }
}
struct P0In { const float *w_in, *q_norm, *w_q_up, *kv_norm, *w_kv_up, *w_cmp1, *w_cmp2, *w_out; };
__device__ __forceinline__ void p0_convert(const P0In& I, unsigned char* ws, int gw, int NGW, int lane) {
    constexpr int T_IN = 64 * 142, T_QUP = 12 * 48, T_KVUP = 8 * 64, T_OUT = 64 * 64, T_C1 = 2 * 64 * 2, T_C2 = 2 * 2 * 2;
    constexpr int TL = T_IN + T_QUP + T_KVUP + T_OUT + T_C1 + T_C2;
    for (int it = gw; it < DEPTH * TL; it += NGW) {
        const int l = it / TL; int r = it - l * TL;
        unsigned char* wl = ws + WS_W + (size_t)l * W_LSTRIDE;
#ifdef GEMM_F8
        if (r < T_IN) { const int nb = r % 142;
            if (nb < 20 || (nb >= 21 && nb < 53)) tr_item8<4>(I.w_in + (size_t)l * D * INC, D, INC, ws + WS_WIN8 + (size_t)l * WIN8_LSTRIDE, nullptr, 64.f, r / 142, nb, lane);
            else tr_item<1>(I.w_in + (size_t)l * D * INC, D, INC, (bf16*)(wl + W_IN), nullptr, r / 142, nb, lane);
            continue; } r -= T_IN;
        if (r < T_QUP) { tr_item8<2>(I.w_q_up + (size_t)l * 768 * 3072, 768, 3072, wl + W_QUP, I.q_norm + l * 768, 32.f, r / 48, r % 48, lane); continue; } r -= T_QUP;
        if (r < T_KVUP) { tr_item8<3>(I.w_kv_up + (size_t)l * 512 * 4096, 512, 4096, wl + W_KVUP, I.kv_norm + l * 512, 32.f, r / 64, r % 64, lane); continue; }
#else
        if (r < T_IN) { tr_item<1>(I.w_in + (size_t)l * D * INC, D, INC, (bf16*)(wl + W_IN), nullptr, r / 142, r % 142, lane); continue; } r -= T_IN;
        if (r < T_QUP) { tr_item<2>(I.w_q_up + (size_t)l * 768 * 3072, 768, 3072, (bf16*)(wl + W_QUP), I.q_norm + l * 768, r / 48, r % 48, lane); continue; } r -= T_QUP;
#ifdef MLA_FP8V
        if (r < T_KVUP) { tr_item<3>(I.w_kv_up + (size_t)l * 512 * 4096, 512, 4096, (bf16*)(wl + W_KVUP), I.kv_norm + l * 512, r / 64, r % 64, lane); continue; }
#else
        if (r < T_KVUP) { tr_item<0>(I.w_kv_up + (size_t)l * 512 * 4096, 512, 4096, (bf16*)(wl + W_KVUP), I.kv_norm + l * 512, r / 64, r % 64, lane); continue; }
#endif
#endif
        r -= T_KVUP;
        if (r < T_OUT) { tr_item<0>(I.w_out + (size_t)l * D * D, D, D, (bf16*)(wl + W_OUT), nullptr, r / 64, r % 64, lane); continue; } r -= T_OUT;
        if (r < T_C1) { const int kv = r / 128, rr = r % 128; tr_item<0>(I.w_cmp1 + (size_t)(l * 2 + kv) * 4096 * 128, 4096, 128, (bf16*)(wl + W_C1) + (size_t)kv * 128 * 4096, nullptr, rr / 2, rr % 2, lane); continue; } r -= T_C1;
        { const int kv = r / 4, rr = r % 4; tr_item<0>(I.w_cmp2 + (size_t)(l * 2 + kv) * 128 * 128, 128, 128, (bf16*)(wl + W_C2) + (size_t)kv * 128 * 128, nullptr, rr / 2, rr % 2, lane); }
    }
}
__device__ __forceinline__ void p0_rope(const int* positions, float* cosT, float* sinT, int gtid, int NT) {
    for (int e = gtid; e < S * 32; e += NT) { const int s = e >> 5, i = e & 31;
        const float inv = (float)exp(-(double)i * (1.0 / 32.0) * 9.210340371976184);
        const float ang = (float)positions[s] * inv;
        cosT[e] = (float)cos((double)ang); sinT[e] = (float)sin((double)ang); }
}
__device__ __forceinline__ void p0_cmpbias(const float* cmp_pos, const float* w_cmp1, float* cbp, LAS float* red, int vcu, int G) {
    const int tid = threadIdx.x, n = tid & 127, kq = tid >> 7;
    for (int u = vcu; u < 64; u += G) {
        const int lk = u >> 4, ch = u & 15;
        const float* P = cmp_pos + (size_t)lk * 4096 + 256 * ch; const float* W = w_cmp1 + (size_t)lk * 4096 * 128 + (size_t)(256 * ch) * 128 + n;
        float a = 0.f;
#pragma unroll 8
        for (int i = 0; i < 64; ++i) { const int k = kq + 4 * i; a += P[k] * *(const GAS float*)(W + (size_t)k * 128); }
        red[kq * 128 + n] = a;
        __syncthreads();
        if (tid < 128) cbp[(size_t)u * 128 + tid] = (red[tid] + red[128 + tid]) + (red[256 + tid] + red[384 + tid]);
        __syncthreads();
    }
}
__device__ __forceinline__ unsigned pk4_fp8(f32x4 h) { const int w = __builtin_amdgcn_cvt_pk_fp8_f32(h[0], h[1], 0, false); return (unsigned)__builtin_amdgcn_cvt_pk_fp8_f32(h[2], h[3], w, true); }
__device__ __forceinline__ void modulate_rows(const float* x, bf16* hout, unsigned char* h8, const float* modl, int gw, int NGW, int lane) {
    f32x4 sh[16], sc[16];
#pragma unroll
    for (int j = 0; j < 16; ++j) { sh[j] = *((const GAS f32x4*)modl + lane + 64 * j); sc[j] = *((const GAS f32x4*)(modl + D) + lane + 64 * j) + 1.f; }
    for (int m = gw; m < S; m += NGW) {
        const GAS f32x4* xr = (const GAS f32x4*)(x + (size_t)m * D) + lane;
        GAS u32x2* ho = (GAS u32x2*)(hout + (size_t)m * D) + lane;
#pragma unroll
        for (int j = 0; j < 16; ++j) { const f32x4 h = xr[64 * j] * sc[j] + sh[j]; u32x2 w; w.x = pk2(h[0], h[1]); w.y = pk2(h[2], h[3]); ho[64 * j] = w;
            if (h8) *((GAS unsigned*)(h8 + (size_t)m * D) + lane + 64 * j) = pk4_fp8(h); }
    }
}
__device__ __forceinline__ void ln_rows(const float* v, float* xout, bf16* hout, unsigned char* h8, const float* g, const float* b, const float* mod_next, int gw, int NGW, int lane) {
    for (int m = gw; m < S; m += NGW) {
        const GAS f32x4* vr = (const GAS f32x4*)(v + (size_t)m * D) + lane;
        f32x4 x[16]; float s = 0.f;
#pragma unroll
        for (int j = 0; j < 16; ++j) { x[j] = vr[64 * j]; s += (x[j][0] + x[j][1]) + (x[j][2] + x[j][3]); }
        const float mean = wave_sum(s) * (1.f / D); float s2 = 0.f;
#pragma unroll
        for (int j = 0; j < 16; ++j) { x[j] = x[j] - mean; s2 += (x[j][0] * x[j][0] + x[j][1] * x[j][1]) + (x[j][2] * x[j][2] + x[j][3] * x[j][3]); }
        const float rstd = 1.f / sqrtf(wave_sum(s2) * (1.f / D) + LN_EPS);
        GAS f32x4* xo = (GAS f32x4*)(xout + (size_t)m * D) + lane;
#pragma unroll
        for (int j = 0; j < 16; ++j) {
            const f32x4 gg = *((const GAS f32x4*)g + lane + 64 * j), bb = *((const GAS f32x4*)b + lane + 64 * j);
#ifdef OSCALE
            const f32x4 y = (x[j] * rstd * gg + bb) * (hout ? 1.f : OSCALE);
#else
            const f32x4 y = x[j] * rstd * gg + bb;
#endif
            xo[64 * j] = y;
            if (hout) {
                const f32x4 sh = *((const GAS f32x4*)mod_next + lane + 64 * j), scl = *((const GAS f32x4*)(mod_next + D) + lane + 64 * j);
                const f32x4 h = y * (scl + 1.f) + sh;
                u32x2 w; w.x = pk2(h[0], h[1]); w.y = pk2(h[2], h[3]);
                *((GAS u32x2*)(hout + (size_t)m * D) + lane + 64 * j) = w;
                if (h8) *((GAS unsigned*)(h8 + (size_t)m * D) + lane + 64 * j) = pk4_fp8(h);
            }
        }
    }
}
__device__ __forceinline__ void rstd_rows(const float* rsq_q, const float* rsq_kv, float* rstd_q, float* rstd_kv, int gtid, int NT) {
    for (int row = gtid; row < S; row += NT) {
        const GAS f32x4* rp = (const GAS f32x4*)(rsq_q + (size_t)row * 24); float ss = 0.f;
#pragma unroll
        for (int i = 0; i < 6; ++i) { const f32x4 t = rp[i]; ss += (t[0] + t[1]) + (t[2] + t[3]); }
        rstd_q[row] = 1.f / sqrtf(ss * (1.f / 768.f) + RMS_EPS);
        const GAS f32x4* rk = (const GAS f32x4*)(rsq_kv + (size_t)row * 16); float sk = 0.f;
#pragma unroll
        for (int i = 0; i < 4; ++i) { const f32x4 t = rk[i]; sk += (t[0] + t[1]) + (t[2] + t[3]); }
        rstd_kv[row] = 1.f / sqrtf(sk * (1.f / 512.f) + RMS_EPS);
    }
}
namespace pg8 {
#define PG8_LAS __attribute__((address_space(3)))
typedef unsigned short bf16_t;
typedef short bf16x8 __attribute__((ext_vector_type(8)));
typedef float f32x4 __attribute__((ext_vector_type(4)));
typedef unsigned u32x4 __attribute__((ext_vector_type(4)));
constexpr int BM = 256, BK = 64, HALF = 128, HTB = HALF * BK * 2  , STAGE_BYTES = 8 * HTB, NXCD = 8, WGM = 8;

__host__ __device__ __forceinline__ int lds_byte(int r, int c) { const int st = (r >> 4) * 2 + (c >> 5), rr = r & 15, cc = c & 31, ob = rr * 64 + cc * 2; return st * 1024 + (ob ^ (((ob >> 9) & 1) << 5)); }
__host__ __device__ __forceinline__ void stage_rc(int b, int& R, int& C) { const int st = b / 1024, sb = b % 1024, swz = sb ^ (((sb >> 9) & 1) << 5); R = (st >> 1) * 16 + swz / 64; C = (st & 1) * 32 + (swz % 64) / 2; }
__host__ __device__ __forceinline__ int perm32(int rho) { const int n = rho >> 4, i = rho & 15; return 8 * (i >> 2) + 4 * n + (i & 3); }

struct Unit { int pm, pn; };
struct Gemm { const bf16_t* A; const bf16_t* Bt; int M, N, K; };

struct StaticOrder {
    int nM, nN, nwg, G, c;
    __host__ __device__ void init(int M, int N, int G_, int c_) { nM = M / BM; nN = N / BM; nwg = nM * nN; G = G_; c = c_; }
    __host__ __device__ bool next(int i, Unit& u) const {
        const long L = (long)i * G + c; if (L >= nwg) return false;
        int wgid = (int)L; { const int q = nwg / NXCD, r = nwg % NXCD, xcd = wgid % NXCD, off = wgid / NXCD; wgid = (xcd < r ? xcd * (q + 1) : r * (q + 1) + (xcd - r) * q) + off; }
        const int nig = WGM * nN, gid = wgid / nig, fm = gid * WGM, gsz = (nM - fm) < WGM ? (nM - fm) : WGM;
        u.pm = fm + ((wgid % nig) % gsz); u.pn = (wgid % nig) / gsz; return true;
    }
    __device__ __forceinline__ void a_ready(const Unit&) const {}
    __device__ __forceinline__ void done(const Unit&) const {}
};
typedef int i32x8 __attribute__((ext_vector_type(8)));
typedef int i32x4 __attribute__((ext_vector_type(4)));
__device__ __forceinline__ i32x8 ld2x16(const PG8_LAS unsigned char* p) { const u32x4 a = *(const PG8_LAS u32x4*)p, b = *(const PG8_LAS u32x4*)(p + 1024);
    return (i32x8){(int)a.x, (int)a.y, (int)a.z, (int)a.w, (int)b.x, (int)b.y, (int)b.z, (int)b.w}; }
__device__ __forceinline__ i32x8 cat8(bf16x8 lo, bf16x8 hi) { const i32x4 a = __builtin_bit_cast(i32x4, lo), b = __builtin_bit_cast(i32x4, hi); return (i32x8){a[0], a[1], a[2], a[3], b[0], b[1], b[2], b[3]}; }
struct InBf16Order : StaticOrder {
    __device__ bool next(int i, Unit& u) const { if (!StaticOrder::next(i, u)) return false; u.pn = u.pn == 0 ? 5 : 13 + u.pn; return true; }
};
__device__ __forceinline__ f32x4 rope4(const f32x4 v, float c0, float s0, float c1, float s1) {
    f32x4 o; o[0] = v[0] * c0 - v[1] * s0; o[1] = v[1] * c0 + v[0] * s0; o[2] = v[2] * c1 - v[3] * s1; o[3] = v[3] * c1 + v[2] * s1; return o; }
#ifdef NOISE_BUILD
__device__ __forceinline__ f32x4 nz4(f32x4 v, int row, int col) {
    f32x4 o;
#pragma unroll
    for (int i = 0; i < 4; ++i) { unsigned h = (unsigned)row * 9216u + (unsigned)(col + i); h ^= h >> 16; h *= 0x7feb352du; h ^= h >> 15; h *= 0x846ca68bu; h ^= h >> 16;
        const float r = (float)(int)(h & 0xffffu) * (1.f / 32768.f) - 1.f; o[i] = v[i] * (1.f + NOISE_EPS * r); }
    return o; }
#define NZ(v, row, col) nz4((v), (row), (col))
#else
#define NZ(v, row, col) (v)
#endif
#ifdef MLA_FP8
__device__ __forceinline__ u32x2 pk8_fp8(f32x4 a, f32x4 b) {
    int w0 = __builtin_amdgcn_cvt_pk_fp8_f32(a[0], a[1], 0, false); w0 = __builtin_amdgcn_cvt_pk_fp8_f32(a[2], a[3], w0, true);
    int w1 = __builtin_amdgcn_cvt_pk_fp8_f32(b[0], b[1], 0, false); w1 = __builtin_amdgcn_cvt_pk_fp8_f32(b[2], b[3], w1, true);
    u32x2 r; r.x = (unsigned)w0; r.y = (unsigned)w1; return r; }
#endif
struct EpiIn {
    static constexpr bool PERM = true, AFTER_DRAIN = false;
    unsigned char* ws; int f8pass;
    __device__ __forceinline__ void operator()(const f32x4 (&acc)[2][2][4][2], const Unit& u, int wr, int wc, int fr, int fq) const {
        const int pn = f8pass ? (u.pn < 5 ? u.pn : u.pn + 1) : u.pn, row0 = u.pm * BM + wr * 64 + fr;
        if (pn < 5) {
            const bool isq = pn < 3; bf16_t* base = (bf16_t*)(ws + (isq ? WS_QLAT : WS_KVLAT)); const int ld = isq ? 768 : 512, ct = isq ? pn : pn - 3, ns = isq ? 24 : 16; float* rsq = (float*)(ws + (isq ? WS_RSQQ : WS_RSQKV));
#pragma unroll
            for (int ai = 0; ai < 2; ++ai)
#pragma unroll
                for (int m = 0; m < 4; ++m) { const int row = row0 + ai * HALF + m * 16;
#pragma unroll
                    for (int bj = 0; bj < 2; ++bj) { const f32x4 v0 = NZ(acc[ai][bj][m][0], row, pn * 256 + bj * 128 + wc * 32 + 8 * fq), v1 = NZ(acc[ai][bj][m][1], row, pn * 256 + bj * 128 + wc * 32 + 8 * fq + 4);
                        float ss = ((v0[0] * v0[0] + v0[1] * v0[1]) + (v0[2] * v0[2] + v0[3] * v0[3])) + ((v1[0] * v1[0] + v1[1] * v1[1]) + (v1[2] * v1[2] + v1[3] * v1[3]));
                        ss += __shfl_xor(ss, 16); ss += __shfl_xor(ss, 32);
                        if (fq == 0) rsq[(size_t)row * ns + ct * 8 + bj * 4 + wc] = ss;
#ifdef GEMM_F8
                        *(GAS u32x2*)((unsigned char*)base + (size_t)row * ld + ct * 256 + bj * HALF + wc * 32 + 8 * fq) = pk8_fp8(v0, v1); } }
#else
                        *(GAS u32x4*)(base + (size_t)row * ld + ct * 256 + bj * HALF + wc * 32 + 8 * fq) = pk8(v0, v1); } }
#endif
        } else if (pn == 5) {
            if (wc < 2) {
                const int i0 = 16 * wc + 4 * fq; const float* cosT = (const float*)(ws + WS_ROPE); const float* sinT = cosT + (size_t)S * 32; bf16_t* kmla = (bf16_t*)(ws + WS_KMLA);
#pragma unroll
                for (int ai = 0; ai < 2; ++ai)
#pragma unroll
                    for (int m = 0; m < 4; ++m) { const int row = row0 + ai * HALF + m * 16;
                        const f32x4 cs = *(const GAS f32x4*)(cosT + (size_t)row * 32 + i0), sn = *(const GAS f32x4*)(sinT + (size_t)row * 32 + i0);
#ifdef MLA_FP8
                        const u32x2 w = pk8_fp8(rope4(acc[ai][0][m][0], cs[0], sn[0], cs[1], sn[1]), rope4(acc[ai][0][m][1], cs[2], sn[2], cs[3], sn[3]));
                        unsigned char* dst = (unsigned char*)kmla + (size_t)row * 3072 + 128 + wc * 32 + 8 * fq;
#pragma unroll
                        for (int h = 0; h < 16; ++h) *(GAS u32x2*)(dst + h * 192) = w;
#else
                        const u32x4 w = pk8(rope4(acc[ai][0][m][0], cs[0], sn[0], cs[1], sn[1]), rope4(acc[ai][0][m][1], cs[2], sn[2], cs[3], sn[3]));
                        bf16_t* dst = kmla + (size_t)row * 3072 + 128 + wc * 32 + 8 * fq;
#pragma unroll
                        for (int h = 0; h < 16; ++h) *(GAS u32x4*)(dst + h * 192) = w;
#endif
                        asm volatile("" ::: "memory"); }
            } else {
                const int cl = (wc - 2) * 32 + 8 * fq; float* gnsa = (float*)(ws + WS_GNSA);
                if (cl < 48) {
#pragma unroll
                    for (int ai = 0; ai < 2; ++ai)
#pragma unroll
                        for (int m = 0; m < 4; ++m) { const int row = row0 + ai * HALF + m * 16; const f32x4 v0 = acc[ai][0][m][0], v1 = acc[ai][0][m][1];
                            f32x4 g0, g1; g0[0] = sigm_f(v0[0]); g0[1] = sigm_f(v0[1]); g0[2] = sigm_f(v0[2]); g0[3] = sigm_f(v0[3]); g1[0] = sigm_f(v1[0]); g1[1] = sigm_f(v1[1]); g1[2] = sigm_f(v1[2]); g1[3] = sigm_f(v1[3]);
                            *(GAS f32x4*)(gnsa + (size_t)row * 48 + cl) = g0; *(GAS f32x4*)(gnsa + (size_t)row * 48 + cl + 4) = g1; } }
            }
        } else {
            const int mode = (pn < 14) ? 0 : (pn < 22 ? 1 : (pn < 28 ? 2 : 0));
            bf16_t* base = (pn < 14) ? (bf16_t*)(ws + WS_ZMLA) + (pn - 6) * 256 : (pn < 22 ? (bf16_t*)(ws + WS_QNSA) + (pn - 14) * 256 : (bf16_t*)(ws + WS_ZNSA) + (pn - 28) * 256); bf16_t* kvnsa = (bf16_t*)(ws + WS_KVNSA);
#pragma unroll
            for (int ai = 0; ai < 2; ++ai)
#pragma unroll
                for (int m = 0; m < 4; ++m) { const int row = row0 + ai * HALF + m * 16;
#pragma unroll
                    for (int bj = 0; bj < 2; ++bj) { f32x4 v0 = NZ(acc[ai][bj][m][0], row, pn * 256 + bj * 128 + wc * 32 + 8 * fq), v1 = NZ(acc[ai][bj][m][1], row, pn * 256 + bj * 128 + wc * 32 + 8 * fq + 4);
                        if (mode == 0) { v0[0] = silu_f(v0[0]); v0[1] = silu_f(v0[1]); v0[2] = silu_f(v0[2]); v0[3] = silu_f(v0[3]); v1[0] = silu_f(v1[0]); v1[1] = silu_f(v1[1]); v1[2] = silu_f(v1[2]); v1[3] = silu_f(v1[3]); }
                        else if (mode == 1) { v0 = v0 * QS_NSA; v1 = v1 * QS_NSA; }
                        bf16_t* dst = (mode == 2) ? kvnsa + (size_t)(2 * (pn - 22) + bj) * ((size_t)S * 128) + (size_t)row * 128 + wc * 32 + 8 * fq
                                                  : base + (size_t)row * 2048 + bj * HALF + wc * 32 + 8 * fq;
                        *(GAS u32x4*)dst = pk8(v0, v1); } }
        }
    }
};
struct EpiQup {
    static constexpr bool PERM = true, AFTER_DRAIN = false;
    unsigned char* ws;
    __device__ __forceinline__ void operator()(const f32x4 (&acc)[2][2][4][2], const Unit& u, int wr, int wc, int fr, int fq) const {
        const int pn = u.pn, row0 = u.pm * BM + wr * 64 + fr; bf16_t* qmla = (bf16_t*)(ws + WS_QMLA); const float* rstd_q = (const float*)(ws + WS_RSTD); const float* cosT = (const float*)(ws + WS_ROPE); const float* sinT = cosT + (size_t)S * 32;
#pragma unroll
        for (int ai = 0; ai < 2; ++ai)
#pragma unroll
            for (int m = 0; m < 4; ++m) { const int row = row0 + ai * HALF + m * 16;
#ifdef MLA_FP8
                const float sc = *(const GAS float*)(rstd_q + row);
                unsigned char* q8 = (unsigned char*)qmla + (size_t)row * 3072;
#pragma unroll
                for (int bj = 0; bj < 2; ++bj) { const f32x4 v0 = acc[ai][bj][m][0] * sc, v1 = acc[ai][bj][m][1] * sc;
                    if (pn < 8) { *(GAS u32x2*)(q8 + (2 * pn + bj) * 192 + wc * 32 + 8 * fq) = pk8_fp8(v0, v1); }
                    else { const int cp = (pn - 8) * 256 + bj * HALF + wc * 32 + 8 * fq, head = cp >> 6, dl = cp & 63, i0 = dl >> 1;
                        const f32x4 cs = *(const GAS f32x4*)(cosT + (size_t)row * 32 + i0), sn = *(const GAS f32x4*)(sinT + (size_t)row * 32 + i0);
                        *(GAS u32x2*)(q8 + head * 192 + 128 + dl) = pk8_fp8(rope4(v0, cs[0], sn[0], cs[1], sn[1]), rope4(v1, cs[2], sn[2], cs[3], sn[3])); } }
#else
                const float sc = QS_MLA * *(const GAS float*)(rstd_q + row);
#pragma unroll
                for (int bj = 0; bj < 2; ++bj) { const f32x4 v0 = acc[ai][bj][m][0] * sc, v1 = acc[ai][bj][m][1] * sc;
                    if (pn < 8) { *(GAS u32x4*)(qmla + (size_t)row * 3072 + (2 * pn + bj) * 192 + wc * 32 + 8 * fq) = pk8(v0, v1); }
                    else { const int cp = (pn - 8) * 256 + bj * HALF + wc * 32 + 8 * fq, head = cp >> 6, dl = cp & 63, i0 = dl >> 1;
                        const f32x4 cs = *(const GAS f32x4*)(cosT + (size_t)row * 32 + i0), sn = *(const GAS f32x4*)(sinT + (size_t)row * 32 + i0);
                        *(GAS u32x4*)(qmla + (size_t)row * 3072 + head * 192 + 128 + dl) = pk8(rope4(v0, cs[0], sn[0], cs[1], sn[1]), rope4(v1, cs[2], sn[2], cs[3], sn[3])); } }
#endif
                if (m & 1) asm volatile("" ::: "memory"); }
    }
};
struct EpiKvup {
    static constexpr bool PERM = true, AFTER_DRAIN = false;
    unsigned char* ws;
    __device__ __forceinline__ void operator()(const f32x4 (&acc)[2][2][4][2], const Unit& u, int wr, int wc, int fr, int fq) const {
        const int pn = u.pn, row0 = u.pm * BM + wr * 64 + fr;
#pragma unroll
        for (int ai = 0; ai < 2; ++ai)
#pragma unroll
            for (int m = 0; m < 4; ++m) { const int row = row0 + ai * HALF + m * 16;
                const float sc = *(const GAS float*)((const float*)(ws + WS_RSTD) + S + row); bf16_t* kmla = (bf16_t*)(ws + WS_KMLA); bf16_t* vmla = (bf16_t*)(ws + WS_VMLA);
#ifdef MLA_FP8
                *(GAS u32x2*)((unsigned char*)kmla + (size_t)row * 3072 + pn * 192 + wc * 32 + 8 * fq) = pk8_fp8(acc[ai][0][m][0] * sc, acc[ai][0][m][1] * sc);
#else
                *(GAS u32x4*)(kmla + (size_t)row * 3072 + pn * 192 + wc * 32 + 8 * fq) = pk8(acc[ai][0][m][0] * sc, acc[ai][0][m][1] * sc);
#endif
                *(GAS u32x4*)(vmla + (size_t)row * 2048 + pn * 128 + wc * 32 + 8 * fq) = pk8(acc[ai][1][m][0] * sc, acc[ai][1][m][1] * sc);
                if (m & 1) asm volatile("" ::: "memory"); }
    }
};
#ifdef MLA_FP8V
struct EpiKup {
    static constexpr bool PERM = true, AFTER_DRAIN = false;
    unsigned char* ws;
    __device__ __forceinline__ void operator()(const f32x4 (&acc)[2][2][4][2], const Unit& u, int wr, int wc, int fr, int fq) const {
        const int pn = u.pn, row0 = u.pm * BM + wr * 64 + fr;
#pragma unroll
        for (int ai = 0; ai < 2; ++ai)
#pragma unroll
            for (int m = 0; m < 4; ++m) { const int row = row0 + ai * HALF + m * 16;
                const float sc = *(const GAS float*)((const float*)(ws + WS_RSTD) + S + row); unsigned char* k8 = ws + WS_KMLA + (size_t)row * 3072;
#pragma unroll
                for (int bj = 0; bj < 2; ++bj) *(GAS u32x2*)(k8 + (2 * pn + bj) * 192 + wc * 32 + 8 * fq) = pk8_fp8(acc[ai][bj][m][0] * sc, acc[ai][bj][m][1] * sc);
                if (m & 1) asm volatile("" ::: "memory"); }
    }
};
struct EpiVt {
    static constexpr bool PERM = true, AFTER_DRAIN = false;
    unsigned char* ws;
    __device__ __forceinline__ void operator()(const f32x4 (&acc)[2][2][4][2], const Unit& u, int wr, int wc, int fr, int fq) const {
        const int row0 = u.pm * BM + wr * 64 + fr, col0 = u.pn * BM + wc * 32 + 8 * fq;
        const float* rs = (const float*)(ws + WS_RSTD) + S;
        f32x4 sc[2][2];
#pragma unroll
        for (int bj = 0; bj < 2; ++bj) { sc[bj][0] = *(const GAS f32x4*)(rs + col0 + bj * HALF); sc[bj][1] = *(const GAS f32x4*)(rs + col0 + bj * HALF + 4); }
        const int hi8 = (col0 >> 3) & 1; (void)hi8;
#pragma unroll
        for (int ai = 0; ai < 2; ++ai)
#pragma unroll
            for (int m = 0; m < 4; ++m) { unsigned char* vt = ws + WS_VMLA + (size_t)(row0 + ai * HALF + m * 16) * S;
#pragma unroll
                for (int bj = 0; bj < 2; ++bj) { const u32x2 w = pk8_fp8(acc[ai][bj][m][0] * sc[bj][0], acc[ai][bj][m][1] * sc[bj][1]);
#ifdef MLA_MX
                    unsigned char* d64 = vt + ((col0 + bj * HALF) & ~63) + 4 * ((col0 >> 3) & 7);
                    *(GAS unsigned*)(d64) = w.x; *(GAS unsigned*)(d64 + 32) = w.y; } }
#else
                    unsigned char* d16 = vt + ((col0 + bj * HALF) & ~15);
                    *(GAS unsigned*)(d16 + (hi8 ? 4 : 0)) = w.x; *(GAS unsigned*)(d16 + (hi8 ? 12 : 8)) = w.y; } }
#endif
    }
};
#endif
struct EpiOut {
    static constexpr bool PERM = false, AFTER_DRAIN = false;
    const float* x; float* xv; const float* gate;
    __device__ __forceinline__ void operator()(const f32x4 (&acc)[2][2][4][2], const Unit& u, int wr, int wc, int fr, int fq) const {
        const int row0 = u.pm * BM + wr * 64 + fr, col0 = u.pn * BM + wc * 32 + 4 * fq;
        f32x4 gv[2][2];
#pragma unroll
        for (int bj = 0; bj < 2; ++bj)
#pragma unroll
            for (int n = 0; n < 2; ++n) gv[bj][n] = *(const GAS f32x4*)(gate + col0 + bj * HALF + n * 16);
#pragma unroll
        for (int ai = 0; ai < 2; ++ai)
#pragma unroll
            for (int m = 0; m < 4; ++m) { const size_t off = (size_t)(row0 + ai * HALF + m * 16) * D + col0;
#pragma unroll
                for (int bj = 0; bj < 2; ++bj)
#pragma unroll
                    for (int n = 0; n < 2; ++n) { const f32x4 xx = *(const GAS f32x4*)(x + off + bj * HALF + n * 16);
                        #ifdef YSCALE
                        *(GAS f32x4*)(xv + off + bj * HALF + n * 16) = xx * DN_ALPHA + gv[bj][n] * acc[ai][bj][m][n] * YSCALE; }
#else
                        *(GAS f32x4*)(xv + off + bj * HALF + n * 16) = xx * DN_ALPHA + gv[bj][n] * acc[ai][bj][m][n]; }
#endif
                if (m & 1) asm volatile("" ::: "memory"); }
    }
};
template <class Epi, class Sched, bool ALIGN_EPI = false, bool SP2 = false, int SCB = 0, int SCA = 0>
__device__ __forceinline__ void gemm_phase(PG8_LAS unsigned char* lds, const Gemm g, const Sched& S, const Epi& E) {
    int tid_ = threadIdx.x; asm volatile("" : "+v"(tid_));
    const int tid = tid_, wid = __builtin_amdgcn_readfirstlane(tid >> 6), lane = tid & 63, wr = wid >> 2, wc = wid & 3, fr = lane & 15, fq = lane >> 4;
    const int K = g.K, nt = K / BK;
    unsigned voffA[2], voffB[2];
#pragma unroll
    for (int i = 0; i < 2; ++i) { int R, C; stage_rc(tid * 16 + i * 8192, R, C); const int Rb = Epi::PERM ? ((R & ~31) + perm32(R & 31)) : R;
        voffA[i] = (unsigned)(R * K + C) * 2u; voffB[i] = (unsigned)(Rb * K + C) * 2u; }
    const size_t kstep = (size_t)(BK * 2);
    const size_t hstep = (size_t)HALF * K * 2;
    const size_t tstep = 2 * hstep;
    const unsigned ldsw = (unsigned)wid * 1024u;
    const int aoff = lds_byte(wr * 64 + fr, fq * 8), boff = lds_byte(wc * 32 + fr, fq * 8);
#define PG8_SA(b, h) (((b) * 2 + (h)) * HTB)
#define PG8_SB(b, h) ((4 + (b) * 2 + (h)) * HTB)
#define PG8_STAGE(bufoff, gbase, voff) do { _Pragma("unroll") for (int _i = 0; _i < 2; ++_i) \
        __builtin_amdgcn_global_load_lds((const unsigned*)((const char*)(gbase) + (voff)[_i]), (PG8_LAS unsigned*)(lds + (bufoff) + ldsw + _i * 8192), 16, 0, 0); } while (0)
#define PG8_LDA(dst, b, h) do { if constexpr (SCB != 0) { _Pragma("unroll") for (int m = 0; m < 4; ++m) dst##8[m] = ld2x16(lds + PG8_SA(b, h) + aoff + m * 2048); } \
        else { _Pragma("unroll") for (int m = 0; m < 4; ++m) _Pragma("unroll") for (int k = 0; k < 2; ++k) dst[m][k] = *(const PG8_LAS bf16x8*)(lds + PG8_SA(b, h) + aoff + m * 2048 + k * 1024); } } while (0)
#define PG8_LDB(dst, b, h) do { if constexpr (SCB != 0) { _Pragma("unroll") for (int n = 0; n < 2; ++n) dst##8[n] = ld2x16(lds + PG8_SB(b, h) + boff + n * 2048); } \
        else { _Pragma("unroll") for (int n = 0; n < 2; ++n) _Pragma("unroll") for (int k = 0; k < 2; ++k) dst[n][k] = *(const PG8_LAS bf16x8*)(lds + PG8_SB(b, h) + boff + n * 2048 + k * 1024); } } while (0)
#define PG8_MMA(ai, bj, At, Bt) do { __builtin_amdgcn_s_setprio(1); \
        if constexpr (SCB != 0) { _Pragma("unroll") for (int m = 0; m < 4; ++m) _Pragma("unroll") for (int n = 0; n < 2; ++n) \
            asm volatile("v_mfma_scale_f32_16x16x128_f8f6f4 %0, %1, %2, %0, %3, %4 op_sel_hi:[0,0,0]" : "+v"(acc[ai][bj][m][n]) : "v"(Bt##8[n]), "v"(At##8[m]), "v"(scb_), "v"(sca_)); } \
        else { _Pragma("unroll") for (int m = 0; m < 4; ++m) _Pragma("unroll") for (int n = 0; n < 2; ++n) _Pragma("unroll") for (int k = 0; k < 2; ++k) \
            acc[ai][bj][m][n] = __builtin_amdgcn_mfma_f32_16x16x32_bf16(Bt[n][k], At[m][k], acc[ai][bj][m][n], 0, 0, 0); } \
        __builtin_amdgcn_s_setprio(0); } while (0)
#define PG8_WAIT_V(n) asm volatile("s_waitcnt vmcnt(" #n ")" ::: "memory")
#define PG8_WAIT_L(n) asm volatile("s_waitcnt lgkmcnt(" #n ")" ::: "memory")
#define PG8_BAR __builtin_amdgcn_s_barrier()
#define PG8_SCHED __builtin_amdgcn_sched_barrier(0)
    Unit cur, nxt; int ui = 0;
    if (!S.next(0, cur)) return;
    f32x4 acc[2][2][4][2];
#pragma unroll
    for (int a = 0; a < 2; ++a)
#pragma unroll
        for (int b = 0; b < 2; ++b)
#pragma unroll
            for (int m = 0; m < 4; ++m)
#pragma unroll
                for (int n = 0; n < 2; ++n) acc[a][b][m][n] = (f32x4){0.f, 0.f, 0.f, 0.f};
    int scb_ = SCB, sca_ = SCA; asm volatile("" : "+v"(scb_), "+v"(sca_));
    bf16x8 At[4][2], B0[2][2], B1[2][2]; i32x8 At8[4], B08[2], B18[2];
    const char* cA = (const char*)g.A + (size_t)cur.pm * tstep; const char* cB = (const char*)g.Bt + (size_t)cur.pn * tstep;
    S.a_ready(cur);
    if constexpr (SP2) {
        PG8_STAGE(PG8_SB(0, 0), cB, voffB); PG8_STAGE(PG8_SB(0, 1), cB + hstep, voffB); PG8_STAGE(PG8_SA(0, 0), cA, voffA); PG8_STAGE(PG8_SA(0, 1), cA + hstep, voffA);
        if (wr == 1) PG8_BAR;
        PG8_WAIT_V(2); PG8_BAR;
        PG8_STAGE(PG8_SB(1, 0), cB + kstep, voffB); PG8_STAGE(PG8_SA(1, 0), cA + kstep, voffA); PG8_STAGE(PG8_SB(1, 1), cB + hstep + kstep, voffB);
        PG8_WAIT_V(6); PG8_BAR;
    } else {
        PG8_STAGE(PG8_SB(0, 0), cB, voffB); PG8_STAGE(PG8_SA(0, 0), cA, voffA); PG8_STAGE(PG8_SB(0, 1), cB + hstep, voffB); PG8_STAGE(PG8_SA(0, 1), cA + hstep, voffA);
        if (wr == 1) PG8_BAR;
        PG8_WAIT_V(4); PG8_BAR;
        PG8_STAGE(PG8_SB(1, 0), cB + kstep, voffB); PG8_STAGE(PG8_SA(1, 0), cA + kstep, voffA); PG8_STAGE(PG8_SB(1, 1), cB + hstep + kstep, voffB);
        PG8_WAIT_V(6); PG8_BAR;
    }
    for (;;) {
        const bool has_next = S.next(ui + 1, nxt);
        const char* nA = has_next ? (const char*)g.A + (size_t)nxt.pm * tstep : cA; const char* nB = has_next ? (const char*)g.Bt + (size_t)nxt.pn * tstep : cB;
#pragma unroll 1
        for (int t = 0; t < nt; t += 2) {
            const bool last = (t == nt - 2);
            const char* a1 = cA + (size_t)(t + 1) * kstep;
            const char* a2 = last ? nA : cA + (size_t)(t + 2) * kstep; const char* b2 = last ? nB : cB + (size_t)(t + 2) * kstep;
            const char* a3 = a2 + kstep; const char* b3 = b2 + kstep;
            if (last && has_next) S.a_ready(nxt);
            if constexpr (SP2) {
            PG8_LDB(B0, 0, 0); PG8_LDB(B1, 0, 1); PG8_SCHED; PG8_LDA(At, 0, 0); PG8_STAGE(PG8_SA(1, 1), a1 + hstep, voffA);
            PG8_WAIT_V(8); PG8_WAIT_L(0); PG8_BAR; PG8_MMA(0, 0, At, B0); PG8_MMA(0, 1, At, B1); PG8_BAR; PG8_SCHED;
            PG8_LDA(At, 0, 1); PG8_STAGE(PG8_SB(0, 0), b2, voffB); PG8_STAGE(PG8_SB(0, 1), b2 + hstep, voffB); PG8_STAGE(PG8_SA(0, 0), a2, voffA);
            PG8_WAIT_V(8); PG8_WAIT_L(0); PG8_BAR; PG8_MMA(1, 0, At, B0); PG8_MMA(1, 1, At, B1); PG8_BAR; PG8_SCHED;
            PG8_LDB(B0, 1, 0); PG8_LDB(B1, 1, 1); PG8_SCHED; PG8_LDA(At, 1, 0); PG8_STAGE(PG8_SA(0, 1), a2 + hstep, voffA);
            PG8_WAIT_V(8); PG8_WAIT_L(0); PG8_BAR; PG8_MMA(0, 0, At, B0); PG8_MMA(0, 1, At, B1); PG8_BAR; PG8_SCHED;
            PG8_LDA(At, 1, 1); PG8_STAGE(PG8_SB(1, 0), b3, voffB); PG8_STAGE(PG8_SB(1, 1), b3 + hstep, voffB); PG8_STAGE(PG8_SA(1, 0), a3, voffA);
            PG8_WAIT_V(8); PG8_WAIT_L(0); PG8_BAR; PG8_MMA(1, 0, At, B0); PG8_MMA(1, 1, At, B1); PG8_BAR; PG8_SCHED;
            } else {
            PG8_LDB(B0, 0, 0); PG8_SCHED; PG8_LDA(At, 0, 0); PG8_STAGE(PG8_SA(1, 1), a1 + hstep, voffA);
            PG8_WAIT_L(8); PG8_BAR; PG8_WAIT_L(0); PG8_MMA(0, 0, At, B0); PG8_BAR; PG8_SCHED;
            PG8_LDB(B1, 0, 1); PG8_STAGE(PG8_SB(0, 0), b2, voffB);
            PG8_BAR; PG8_WAIT_L(0); PG8_MMA(0, 1, At, B1); PG8_BAR;
            PG8_LDA(At, 0, 1); PG8_STAGE(PG8_SA(0, 0), a2, voffA);
            PG8_BAR; PG8_WAIT_L(0); PG8_MMA(1, 0, At, B0); PG8_BAR; PG8_SCHED;
            PG8_STAGE(PG8_SB(0, 1), b2 + hstep, voffB);
            PG8_WAIT_V(6); PG8_BAR; PG8_MMA(1, 1, At, B1); PG8_BAR;
            PG8_LDB(B0, 1, 0); PG8_SCHED; PG8_LDA(At, 1, 0); PG8_STAGE(PG8_SA(0, 1), a2 + hstep, voffA);
            PG8_WAIT_L(8); PG8_BAR; PG8_WAIT_L(0); PG8_MMA(0, 0, At, B0); PG8_BAR; PG8_SCHED;
            PG8_LDB(B1, 1, 1); PG8_STAGE(PG8_SB(1, 0), b3, voffB);
            PG8_BAR; PG8_WAIT_L(0); PG8_MMA(0, 1, At, B1); PG8_BAR;
            PG8_LDA(At, 1, 1); PG8_STAGE(PG8_SA(1, 0), a3, voffA);
            PG8_BAR; PG8_WAIT_L(0); PG8_MMA(1, 0, At, B0); PG8_BAR; PG8_SCHED;
            PG8_STAGE(PG8_SB(1, 1), b3 + hstep, voffB);
            PG8_WAIT_V(6); PG8_BAR; PG8_MMA(1, 1, At, B1); PG8_BAR;
            }
        }
        if constexpr (SCB != 0) asm volatile("s_nop 15\n\ts_nop 15" ::: "memory");
        if constexpr (ALIGN_EPI) { if (wr == 0) PG8_BAR; }
        if constexpr (!Epi::AFTER_DRAIN) { int fr_ = fr, fq_ = fq; asm volatile("" : "+v"(fr_), "+v"(fq_));
            E(acc, cur, wr, wc, fr_, fq_); S.done(cur); }
        if (!has_next) break;
#pragma unroll
        for (int a = 0; a < 2; ++a)
#pragma unroll
            for (int b = 0; b < 2; ++b)
#pragma unroll
                for (int m = 0; m < 4; ++m)
#pragma unroll
                    for (int n = 0; n < 2; ++n) acc[a][b][m][n] = (f32x4){0.f, 0.f, 0.f, 0.f};
        cur = nxt; cA = nA; cB = nB; ++ui;
        if constexpr (ALIGN_EPI) { if (wr == 1) PG8_BAR; }
    }
    PG8_WAIT_V(0);
    if constexpr (!ALIGN_EPI) { if (wr == 0) PG8_BAR; }
    PG8_BAR;
    if constexpr (Epi::AFTER_DRAIN) { E.fused(acc, cur, wr, wc, fr, fq, lds, wid, lane); S.done(cur); }
#undef PG8_SA
#undef PG8_SB
#undef PG8_STAGE
#undef PG8_LDA
#undef PG8_LDB
#undef PG8_MMA
#undef PG8_WAIT_V
#undef PG8_WAIT_L
#undef PG8_BAR
#undef PG8_SCHED
}
}
namespace att {
constexpr int KS_M = 400, KS_N = 272, VS = 320;
constexpr int MLA_KB = 64 * KS_M, NSA_KB = 64 * KS_N, VB = 64 * VS;
constexpr int N_IMP = 2 * NSA_KB + 2 * VB;
constexpr int N_PART = N_IMP + 32768;
constexpr int N_PARTB = 8 * 32 * 17 * 4;
constexpr int N_SELM = N_PART + 2 * N_PARTB;
constexpr int N_ULIST = N_SELM + 1024;
constexpr int N_CARRY = N_ULIST + 1024;
constexpr int N_NTS = N_CARRY + 256;
static_assert(N_NTS + 16 <= MISC_OFF, "NSA LDS map");
static_assert(2 * MLA_KB + 3 * VB <= 131072, "MLA LDS map");
constexpr int MLA_QL = 2 * MLA_KB + 2 * VB;
static_assert(MLA_QL + 8 * 4096 <= 131072, "MLA LDS map (pipelined)");

#ifndef QK_PF
#define QK_PF 4
#endif
#define MFMA32(a, b, c) __builtin_amdgcn_mfma_f32_32x32x16_bf16((a), (b), (c), 0, 0, 0)
__device__ __forceinline__ float swapmax(float v) { auto rr = __builtin_amdgcn_permlane32_swap(__float_as_uint(v), __float_as_uint(v), false, false); return fmaxf(__uint_as_float(rr[0]), __uint_as_float(rr[1])); }
__device__ __forceinline__ float swapsum(float v) { auto rr = __builtin_amdgcn_permlane32_swap(__float_as_uint(v), __float_as_uint(v), false, false); return __uint_as_float(rr[0]) + __uint_as_float(rr[1]); }
template <int SIDX> __device__ __forceinline__ bf16x8 packp(const f32x16& p) {
    f32x8 t = {p[8 * SIDX + 0], p[8 * SIDX + 1], p[8 * SIDX + 2], p[8 * SIDX + 3], p[8 * SIDX + 4], p[8 * SIDX + 5], p[8 * SIDX + 6], p[8 * SIDX + 7]};
    return __builtin_bit_cast(bf16x8, __builtin_convertvector(t, bf16x8v));
}
template <int NDC, int KS, bool ZERO = true> __device__ __forceinline__ void qk_tile(f32x16& p0, f32x16& p1, const LAS unsigned char* kl, const bf16x8 (&q)[NDC]) {
    if (ZERO) {
#pragma unroll
        for (int i = 0; i < 16; ++i) { p0[i] = 0.f; p1[i] = 0.f; }
    }
    constexpr int PF = QK_PF;
    bf16x8 a[PF + 1][2];
#pragma unroll
    for (int i = 0; i < PF; ++i) { a[i][0] = *(const LAS bf16x8*)(kl + i * 32); a[i][1] = *(const LAS bf16x8*)(kl + 32 * KS + i * 32); }
#pragma unroll
    for (int d0 = 0; d0 < NDC; ++d0) {
        if (d0 + PF < NDC) { a[(d0 + PF) % (PF + 1)][0] = *(const LAS bf16x8*)(kl + (d0 + PF) * 32); a[(d0 + PF) % (PF + 1)][1] = *(const LAS bf16x8*)(kl + 32 * KS + (d0 + PF) * 32); }
        __builtin_amdgcn_sched_barrier(0);
        p0 = MFMA32(a[d0 % (PF + 1)][0], q[d0], p0); p1 = MFMA32(a[d0 % (PF + 1)][1], q[d0], p1);
        __builtin_amdgcn_sched_barrier(0);
    }
}
#ifdef PROBE_QKM2
template <int NDC, int KS> __device__ __forceinline__ void qk_tile_m2(f32x16& p0, f32x16& p1, f32x16& r0, f32x16& r1, const LAS unsigned char* kl, const bf16x8 (&q)[NDC]) {
#pragma unroll
    for (int i = 0; i < 16; ++i) { p0[i] = 0.f; p1[i] = 0.f; r0[i] = 0.f; r1[i] = 0.f; }
    constexpr int PF = QK_PF;
    bf16x8 a[PF + 1][2];
#pragma unroll
    for (int i = 0; i < PF; ++i) { a[i][0] = *(const LAS bf16x8*)(kl + i * 32); a[i][1] = *(const LAS bf16x8*)(kl + 32 * KS + i * 32); }
#pragma unroll
    for (int d0 = 0; d0 < NDC; ++d0) {
        if (d0 + PF < NDC) { a[(d0 + PF) % (PF + 1)][0] = *(const LAS bf16x8*)(kl + (d0 + PF) * 32); a[(d0 + PF) % (PF + 1)][1] = *(const LAS bf16x8*)(kl + 32 * KS + (d0 + PF) * 32); }
        __builtin_amdgcn_sched_barrier(0);
        p0 = MFMA32(a[d0 % (PF + 1)][0], q[d0], p0); p1 = MFMA32(a[d0 % (PF + 1)][1], q[d0], p1);
        r0 = MFMA32(a[d0 % (PF + 1)][0], q[d0], r0); r1 = MFMA32(a[d0 % (PF + 1)][1], q[d0], r1);
        __builtin_amdgcn_sched_barrier(0);
    }
}
#endif
__device__ __forceinline__ void pv_tile(f32x16 (&o)[4], const bf16x8 (&pb)[4], const LAS unsigned char* vl) {
    s16x4 f[5][2];
#define PV_LD(idx) do { constexpr int d_ = (idx) >> 2, s_ = (idx) & 3; \
        f[(idx) % 5][0] = __builtin_amdgcn_ds_read_tr16_b64_v4i16((LAS s16x4*)(vl + s_ * 16 * VS + d_ * 64)); \
        f[(idx) % 5][1] = __builtin_amdgcn_ds_read_tr16_b64_v4i16((LAS s16x4*)(vl + s_ * 16 * VS + 8 * VS + d_ * 64)); } while (0)
    PV_LD(0); PV_LD(1); PV_LD(2); PV_LD(3);
#define PV_STEP(idx) do { if ((idx) + 4 < 16) PV_LD((idx) + 4); __builtin_amdgcn_sched_barrier(0); \
        { const s16x4 t0_ = f[(idx) % 5][0], t1_ = f[(idx) % 5][1]; const bf16x8 vf_ = {t0_[0], t0_[1], t0_[2], t0_[3], t1_[0], t1_[1], t1_[2], t1_[3]}; \
          o[(idx) >> 2] = MFMA32(vf_, pb[(idx) & 3], o[(idx) >> 2]); } __builtin_amdgcn_sched_barrier(0); } while (0)
    PV_STEP(0); PV_STEP(1); PV_STEP(2); PV_STEP(3); PV_STEP(4); PV_STEP(5); PV_STEP(6); PV_STEP(7);
    PV_STEP(8); PV_STEP(9); PV_STEP(10); PV_STEP(11); PV_STEP(12); PV_STEP(13); PV_STEP(14); PV_STEP(15);
#undef PV_STEP
#undef PV_LD
}
template <int NDC, int NQR, int KS> __device__ __forceinline__ void qk_tile_free(f32x16& p0, f32x16& p1, const LAS unsigned char* kl, const bf16x8 (&q)[NQR], const LAS unsigned char* ql) {
#pragma unroll
    for (int i = 0; i < 16; ++i) { p0[i] = 0.f; p1[i] = 0.f; }
#pragma unroll
    for (int d0 = 0; d0 < NDC; ++d0) {
        const bf16x8 a0 = *(const LAS bf16x8*)(kl + d0 * 32);
        const bf16x8 a1 = *(const LAS bf16x8*)(kl + 32 * KS + d0 * 32);
        bf16x8 qq; if (d0 < NQR) qq = q[d0 < NQR ? d0 : 0]; else qq = *(const LAS bf16x8*)(ql + (d0 - NQR) * 1024);
        p0 = MFMA32(a0, qq, p0); p1 = MFMA32(a1, qq, p1);
    }
}
__device__ __forceinline__ float sm_core(f32x16& p0, f32x16& p1, float& m, float& l) {
    float tm = p0[0];
#pragma unroll
    for (int r = 1; r < 16; ++r) tm = fmaxf(tm, p0[r]);
#pragma unroll
    for (int r = 0; r < 16; ++r) tm = fmaxf(tm, p1[r]);
    tm = swapmax(tm);
    const float mn = fmaxf(m, tm);
    const float alpha = __builtin_amdgcn_exp2f(m - mn);
    m = mn;
    float ps = 0.f;
#pragma unroll
    for (int r = 0; r < 16; ++r) { p0[r] = __builtin_amdgcn_exp2f(p0[r] - mn); ps += p0[r]; }
#pragma unroll
    for (int r = 0; r < 16; ++r) { p1[r] = __builtin_amdgcn_exp2f(p1[r] - mn); ps += p1[r]; }
    ps = swapsum(ps);
    l = l * alpha + ps;
    return alpha;
}
__device__ __forceinline__ void online_sm(f32x16& p0, f32x16& p1, float& m, float& l, f32x16 (&o)[4]) {
    float tm = p0[0];
#pragma unroll
    for (int r = 1; r < 16; ++r) tm = fmaxf(tm, p0[r]);
#pragma unroll
    for (int r = 0; r < 16; ++r) tm = fmaxf(tm, p1[r]);
    tm = swapmax(tm);
    const float mn = fmaxf(m, tm);
    const float alpha = __builtin_amdgcn_exp2f(m - mn);
    m = mn;
    float ps = 0.f;
#pragma unroll
    for (int r = 0; r < 16; ++r) { p0[r] = __builtin_amdgcn_exp2f(p0[r] - mn); ps += p0[r]; }
#pragma unroll
    for (int r = 0; r < 16; ++r) { p1[r] = __builtin_amdgcn_exp2f(p1[r] - mn); ps += p1[r]; }
    ps = swapsum(ps);
    l = l * alpha + ps;
    if (!__all(alpha == 1.f)) {
#pragma unroll
        for (int d = 0; d < 4; ++d)
#pragma unroll
            for (int r = 0; r < 16; ++r) o[d][r] *= alpha;
    }
}

#ifdef MLA_FP8
typedef long i64;
constexpr int KS8 = 200, MLA_KB8 = 64 * KS8;
static_assert(2 * MLA_KB8 + 3 * VB <= 131072, "MLA fp8 LDS map");
#define MFMA32F8(a, b, c) __builtin_amdgcn_mfma_f32_32x32x16_fp8_fp8((a), (b), (c), 0, 0, 0)
template <int NDC> __device__ __forceinline__ void qk_tile8(f32x16& p0, f32x16& p1, const LAS unsigned char* kl, const i64 (&q)[NDC]) {
#pragma unroll
    for (int i = 0; i < 16; ++i) { p0[i] = 0.f; p1[i] = 0.f; }
    constexpr int PF = 4;
    i64 a[PF + 1][2];
#pragma unroll
    for (int i = 0; i < PF; ++i) { a[i][0] = *(const LAS i64*)(kl + i * 16); a[i][1] = *(const LAS i64*)(kl + 32 * KS8 + i * 16); }
#pragma unroll
    for (int d0 = 0; d0 < NDC; ++d0) {
        if (d0 + PF < NDC) { a[(d0 + PF) % (PF + 1)][0] = *(const LAS i64*)(kl + (d0 + PF) * 16); a[(d0 + PF) % (PF + 1)][1] = *(const LAS i64*)(kl + 32 * KS8 + (d0 + PF) * 16); }
        __builtin_amdgcn_sched_barrier(0);
        __builtin_amdgcn_s_setprio(1);
        p0 = MFMA32F8(a[d0 % (PF + 1)][0], q[d0], p0); p1 = MFMA32F8(a[d0 % (PF + 1)][1], q[d0], p1);
        __builtin_amdgcn_s_setprio(0);
        __builtin_amdgcn_sched_barrier(0);
    }
}
__device__ __forceinline__ void online_sm_scaled(f32x16& p0, f32x16& p1, float& m, float& l, f32x16 (&o)[4], const float C2) {
    float tm = p0[0];
#pragma unroll
    for (int r = 1; r < 16; ++r) tm = fmaxf(tm, p0[r]);
#pragma unroll
    for (int r = 0; r < 16; ++r) tm = fmaxf(tm, p1[r]);
    tm = swapmax(tm);
    const float mn = fmaxf(m, tm);
    const float alpha = __builtin_amdgcn_exp2f((m - mn) * C2);
    m = mn;
    const float mc = -mn * C2;
    float ps = 0.f;
#pragma unroll
    for (int r = 0; r < 16; ++r) { p0[r] = __builtin_amdgcn_exp2f(__builtin_fmaf(p0[r], C2, mc)); ps += p0[r]; }
#pragma unroll
    for (int r = 0; r < 16; ++r) { p1[r] = __builtin_amdgcn_exp2f(__builtin_fmaf(p1[r], C2, mc)); ps += p1[r]; }
    ps = swapsum(ps);
    l = l * alpha + ps;
    if (!__all(alpha == 1.f)) {
#pragma unroll
        for (int d = 0; d < 4; ++d)
#pragma unroll
            for (int r = 0; r < 16; ++r) o[d][r] *= alpha;
    }
}
#endif
#ifdef MLA_FP8V
constexpr int VS8 = 72, VB8 = 128 * VS8;
constexpr int VS8B = 136, VB8B = 128 * VS8B, MLA_KB8B = 128 * KS8;
static_assert(2 * MLA_KB8B + 3 * VB8B <= 131072, "MLA big-tile LDS map");
#ifdef MLA_BIG
#define PV8_RS VS8B
#else
#define PV8_RS VS8
#endif
static_assert(2 * MLA_KB8 + 3 * VB8 <= 131072, "MLA fp8 LDS map");
template <int SIDX> __device__ __forceinline__ i64 packp8(const f32x16& p) {
    int w0 = __builtin_amdgcn_cvt_pk_fp8_f32(p[8 * SIDX + 0] * 256.f, p[8 * SIDX + 1] * 256.f, 0, false); w0 = __builtin_amdgcn_cvt_pk_fp8_f32(p[8 * SIDX + 2] * 256.f, p[8 * SIDX + 3] * 256.f, w0, true);
    int w1 = __builtin_amdgcn_cvt_pk_fp8_f32(p[8 * SIDX + 4] * 256.f, p[8 * SIDX + 5] * 256.f, 0, false); w1 = __builtin_amdgcn_cvt_pk_fp8_f32(p[8 * SIDX + 6] * 256.f, p[8 * SIDX + 7] * 256.f, w1, true);
    return (i64)(((unsigned long long)(unsigned)w1 << 32) | (unsigned)w0);
}
__device__ __forceinline__ void pv_tile8(f32x16 (&o)[4], const i64 (&pb)[4], const LAS unsigned char* vl) {
    i64 f[5];
#define PV8_LD(idx) f[(idx) % 5] = *(const LAS i64*)(vl + ((idx) >> 2) * 32 * PV8_RS + ((idx) & 3) * 16)
    PV8_LD(0); PV8_LD(1); PV8_LD(2); PV8_LD(3);
#define PV8_STEP(idx) do { if ((idx) + 4 < 16) PV8_LD((idx) + 4); __builtin_amdgcn_sched_barrier(0); \
        o[(idx) >> 2] = MFMA32F8(f[(idx) % 5], pb[(idx) & 3], o[(idx) >> 2]); __builtin_amdgcn_sched_barrier(0); } while (0)
    PV8_STEP(0); PV8_STEP(1); PV8_STEP(2); PV8_STEP(3); PV8_STEP(4); PV8_STEP(5); PV8_STEP(6); PV8_STEP(7);
    PV8_STEP(8); PV8_STEP(9); PV8_STEP(10); PV8_STEP(11); PV8_STEP(12); PV8_STEP(13); PV8_STEP(14); PV8_STEP(15);
#undef PV8_STEP
#undef PV8_LD
}
#endif
#ifdef MLA_MX
typedef int i32x8 __attribute__((ext_vector_type(8)));
constexpr int KSX = 208, MLA_KBX = 64 * KSX;
constexpr int VSX = 80, VBX = 128 * VSX;
static_assert(2 * MLA_KBX + 3 * VBX <= 131072, "MLA mx LDS map");
#define MFMAX(a, b, c) __builtin_amdgcn_mfma_scale_f32_32x32x64_f8f6f4((a), (b), (c), 0, 0, 0, 0x7f7f7f7f, 0, 0x7f7f7f7f)
__device__ __forceinline__ i32x8 ldsx(const LAS unsigned char* p) {
    const u32x4 a = *(const LAS u32x4*)p, b = *(const LAS u32x4*)(p + 16);
    return (i32x8){(int)a.x, (int)a.y, (int)a.z, (int)a.w, (int)b.x, (int)b.y, (int)b.z, (int)b.w};
}
__device__ __forceinline__ void qk_tilex(f32x16& p0, f32x16& p1, const LAS unsigned char* kl, const i32x8 (&q)[3]) {
#pragma unroll
    for (int i = 0; i < 16; ++i) { p0[i] = 0.f; p1[i] = 0.f; }
    i32x8 a0 = ldsx(kl), a1 = ldsx(kl + 32 * KSX), a2 = ldsx(kl + 64), a3 = ldsx(kl + 32 * KSX + 64);
    __builtin_amdgcn_sched_barrier(0);
    __builtin_amdgcn_s_setprio(1);
    p0 = MFMAX(a0, q[0], p0); p1 = MFMAX(a1, q[0], p1);
    __builtin_amdgcn_s_setprio(0);
    __builtin_amdgcn_sched_barrier(0);
    a0 = ldsx(kl + 128); a1 = ldsx(kl + 32 * KSX + 128);
    __builtin_amdgcn_sched_barrier(0);
    __builtin_amdgcn_s_setprio(1);
    p0 = MFMAX(a2, q[1], p0); p1 = MFMAX(a3, q[1], p1);
    __builtin_amdgcn_sched_barrier(0);
    p0 = MFMAX(a0, q[2], p0); p1 = MFMAX(a1, q[2], p1);
    __builtin_amdgcn_s_setprio(0);
    __builtin_amdgcn_sched_barrier(0);
}
__device__ __forceinline__ void pv_tilex(f32x16 (&o)[4], const i32x8& pb, const LAS unsigned char* vl) {
    i32x8 f0 = ldsx(vl), f1 = ldsx(vl + 32 * VSX);
    __builtin_amdgcn_sched_barrier(0);
    o[0] = MFMAX(f0, pb, o[0]);
    __builtin_amdgcn_sched_barrier(0);
    f0 = ldsx(vl + 64 * VSX);
    __builtin_amdgcn_sched_barrier(0);
    o[1] = MFMAX(f1, pb, o[1]);
    __builtin_amdgcn_sched_barrier(0);
    f1 = ldsx(vl + 96 * VSX);
    __builtin_amdgcn_sched_barrier(0);
    o[2] = MFMAX(f0, pb, o[2]);
    __builtin_amdgcn_sched_barrier(0);
    o[3] = MFMAX(f1, pb, o[3]);
    __builtin_amdgcn_sched_barrier(0);
}
__device__ __forceinline__ i32x8 packpx(const f32x16& p0, const f32x16& p1) {
    i32x8 w;
#pragma unroll
    for (int g = 0; g < 4; ++g) {
        int a = __builtin_amdgcn_cvt_pk_fp8_f32(p0[4 * g + 0], p0[4 * g + 1], 0, false); a = __builtin_amdgcn_cvt_pk_fp8_f32(p0[4 * g + 2], p0[4 * g + 3], a, true); w[g] = a;
        int b = __builtin_amdgcn_cvt_pk_fp8_f32(p1[4 * g + 0], p1[4 * g + 1], 0, false); b = __builtin_amdgcn_cvt_pk_fp8_f32(p1[4 * g + 2], p1[4 * g + 3], b, true); w[4 + g] = b;
    }
    return w;
}
__device__ __forceinline__ void online_sm_x(f32x16& p0, f32x16& p1, float& m, float& l, f32x16 (&o)[4], const float C2) {
    float tm = p0[0];
#pragma unroll
    for (int r = 1; r < 16; ++r) tm = fmaxf(tm, p0[r]);
#pragma unroll
    for (int r = 0; r < 16; ++r) tm = fmaxf(tm, p1[r]);
    tm = swapmax(tm);
    const float mn = fmaxf(m, tm);
    const float alpha = __builtin_amdgcn_exp2f((m - mn) * C2);
    m = mn;
    const float mc = 8.f - mn * C2;
    float ps = 0.f;
#pragma unroll
    for (int r = 0; r < 16; ++r) { p0[r] = __builtin_amdgcn_exp2f(__builtin_fmaf(p0[r], C2, mc)); ps += p0[r]; }
#pragma unroll
    for (int r = 0; r < 16; ++r) { p1[r] = __builtin_amdgcn_exp2f(__builtin_fmaf(p1[r], C2, mc)); ps += p1[r]; }
    ps = swapsum(ps);
    l = l * alpha + ps;
    if (!__all(alpha == 1.f)) {
#pragma unroll
        for (int d = 0; d < 4; ++d)
#pragma unroll
            for (int r = 0; r < 16; ++r) o[d][r] *= alpha;
    }
}
#endif
#ifdef MLA_PIPE8
template <int NDC> __device__ __forceinline__ void qk_tile8_free(f32x16& p0, f32x16& p1, const LAS unsigned char* kl, const i64 (&q)[NDC]) {
#pragma unroll
    for (int i = 0; i < 16; ++i) { p0[i] = 0.f; p1[i] = 0.f; }
#pragma unroll
    for (int d0 = 0; d0 < NDC; ++d0) {
        const i64 a0 = *(const LAS i64*)(kl + d0 * 16), a1 = *(const LAS i64*)(kl + 32 * KS8 + d0 * 16);
        p0 = MFMA32F8(a0, q[d0], p0); p1 = MFMA32F8(a1, q[d0], p1);
    }
}
__device__ __forceinline__ float sm_core_scaled(f32x16& p0, f32x16& p1, float& m, float& l, const float C2) {
    float tm = p0[0];
#pragma unroll
    for (int r = 1; r < 16; ++r) tm = fmaxf(tm, p0[r]);
#pragma unroll
    for (int r = 0; r < 16; ++r) tm = fmaxf(tm, p1[r]);
    tm = swapmax(tm);
    const float mn = fmaxf(m, tm);
    const float alpha = __builtin_amdgcn_exp2f((m - mn) * C2);
    m = mn;
    const float mc = -mn * C2;
    float ps = 0.f;
#pragma unroll
    for (int r = 0; r < 16; ++r) { p0[r] = __builtin_amdgcn_exp2f(__builtin_fmaf(p0[r], C2, mc)); ps += p0[r]; }
#pragma unroll
    for (int r = 0; r < 16; ++r) { p1[r] = __builtin_amdgcn_exp2f(__builtin_fmaf(p1[r], C2, mc)); ps += p1[r]; }
    ps = swapsum(ps);
    l = l * alpha + ps;
    return alpha;
}
#endif
#ifdef MLA_PIPE8
struct MlaPtrs { const bf16* Q; const bf16* K; const bf16* V; const bf16* Z; bf16* O; };
__device__ __forceinline__ void mla_mask(f32x16& p0, f32x16& p1, int dq) {
#pragma unroll
    for (int r = 0; r < 16; ++r) { const int c = (r & 3) + 8 * (r >> 2);
        if (c > dq) p0[r] = -__builtin_inff();
        if (c + 32 > dq) p1[r] = -__builtin_inff(); }
}
__device__ __forceinline__ void mla_unit(LAS unsigned char* lds, const MlaPtrs& P, int head, int qb, int tid_in, int wave, int lane_in) {
    int tid = tid_in; asm volatile("" : "+v"(tid)); const int lane = tid & 63; (void)lane_in;
    const int r32 = lane & 31, hi = lane >> 5;
    const int q0 = qb * 256, qw = q0 + wave * 32, tq = qw + r32;
    i64 q[12];
    { const unsigned char* qp = (const unsigned char*)P.Q + (size_t)tq * 3072 + head * 192 + hi * 8;
#pragma unroll
      for (int d0 = 0; d0 < 12; ++d0) q[d0] = *(const GAS i64*)(qp + d0 * 16); }
    const int NT = 4 * (qb + 1);
    const int srow = tid >> 3, sc8 = tid & 7;
    const unsigned char* kg = (const unsigned char*)P.K + (size_t)head * 192 + (size_t)srow * 3072 + sc8 * 8;
    const unsigned char* vg = (const unsigned char*)P.V + ((size_t)head * 128 + (tid >> 2)) * S + (tid & 3) * 16;
    LAS unsigned char* kst = lds + srow * KS8 + sc8 * 8;
    LAS unsigned char* vst = lds + 2 * MLA_KB8 + (tid >> 2) * VS8 + (tid & 3) * 16;
    const LAS unsigned char* kl = lds + r32 * KS8 + hi * 8;
    const LAS unsigned char* vl = lds + 2 * MLA_KB8 + r32 * VS8 + hi * 8;
    u32x2 sk0, sk1, sk2; u32x4 sv0;
#define MLA_LOADK(j) do { const unsigned char* kp_ = kg + (size_t)(j) * (64 * 3072); sk0 = *(const GAS u32x2*)(kp_); sk1 = *(const GAS u32x2*)(kp_ + 64); sk2 = *(const GAS u32x2*)(kp_ + 128); } while (0)
#define MLA_LOADV(j) do { sv0 = *(const GAS u32x4*)(vg + (size_t)(j) * 64); } while (0)
#define MLA_STOREK(b) do { LAS unsigned char* kd_ = kst + (b) * MLA_KB8; *(LAS u32x2*)(kd_) = sk0; *(LAS u32x2*)(kd_ + 64) = sk1; *(LAS u32x2*)(kd_ + 128) = sk2; } while (0)
#define MLA_STOREV(b) do { LAS unsigned char* vd_ = vst + (b) * VB8; *(LAS u32x2*)(vd_) = (u32x2){sv0.x, sv0.y}; *(LAS u32x2*)(vd_ + 8) = (u32x2){sv0.z, sv0.w}; } while (0)
    float m = -1e30f, l = 0.f; f32x16 o[4];
#pragma unroll
    for (int d = 0; d < 4; ++d)
#pragma unroll
        for (int r = 0; r < 16; ++r) o[d][r] = 0.f;
    f32x16 pA0, pA1, pB0, pB1;
    MLA_LOADK(0); MLA_LOADV(0); MLA_STOREK(0); MLA_STOREV(0);
    MLA_LOADK(1);
    __syncthreads();
    qk_tile8<12>(pA0, pA1, kl, q);
    if (63 > qw) mla_mask(pA0, pA1, tq - 4 * hi);
    MLA_STOREK(1);
    if (2 < NT) MLA_LOADK(2);
    MLA_LOADV(1);
    __syncthreads();
#define MLA_SGB1() do { __builtin_amdgcn_sched_group_barrier(0x100, 2, 0); __builtin_amdgcn_sched_group_barrier(0x008, 1, 0); __builtin_amdgcn_sched_group_barrier(0x002, 6, 0); \
        __builtin_amdgcn_sched_group_barrier(0x008, 1, 0); __builtin_amdgcn_sched_group_barrier(0x002, 6, 0); } while (0)
#define MLA_SGB() do { MLA_SGB1(); MLA_SGB1(); MLA_SGB1(); MLA_SGB1(); MLA_SGB1(); MLA_SGB1(); MLA_SGB1(); MLA_SGB1(); MLA_SGB1(); MLA_SGB1(); MLA_SGB1(); MLA_SGB1(); } while (0)
#define MLA_STEP(PX0, PX1, PY0, PY1, j) do { \
        const int kb1_ = 64 * ((j) + 1); \
        const bool a1_ = ((j) + 1 < NT) && (kb1_ <= qw + 31), a0_ = (64 * (j) <= qw + 31); \
        float alpha_ = 1.f; i64 pb_[4]; \
        if (a1_) { \
            __builtin_amdgcn_sched_barrier(0); \
            qk_tile8_free<12>(PY0, PY1, kl + (((j) + 1) & 1) * MLA_KB8, q); \
            alpha_ = sm_core_scaled(PX0, PX1, m, l, QS_MLA); \
            pb_[0] = packp8<0>(PX0); pb_[1] = packp8<1>(PX0); pb_[2] = packp8<0>(PX1); pb_[3] = packp8<1>(PX1); \
            MLA_SGB(); \
            __builtin_amdgcn_sched_barrier(0); \
            if (kb1_ + 63 > qw) mla_mask(PY0, PY1, tq - kb1_ - 4 * hi); \
        } else if (a0_) { \
            alpha_ = sm_core_scaled(PX0, PX1, m, l, QS_MLA); \
            pb_[0] = packp8<0>(PX0); pb_[1] = packp8<1>(PX0); pb_[2] = packp8<0>(PX1); pb_[3] = packp8<1>(PX1); \
        } \
        if (a0_) { \
            if (!__all(alpha_ == 1.f)) { _Pragma("unroll") for (int d_ = 0; d_ < 4; ++d_) _Pragma("unroll") for (int r_ = 0; r_ < 16; ++r_) o[d_][r_] *= alpha_; } \
            pv_tile8(o, pb_, vl + ((j) & 1) * VB8); \
        } \
        if ((j) + 2 < NT) MLA_STOREK((j) & 1); \
        if ((j) + 1 < NT) MLA_STOREV(((j) + 1) & 1); \
        if ((j) + 3 < NT) MLA_LOADK((j) + 3); \
        if ((j) + 2 < NT) MLA_LOADV((j) + 2); \
        __syncthreads(); } while (0)
    for (int j = 0; j < NT; j += 2) {
        MLA_STEP(pA0, pA1, pB0, pB1, j);
        MLA_STEP(pB0, pB1, pA0, pA1, j + 1);
    }
#undef MLA_STEP
#undef MLA_SGB
#undef MLA_SGB1
#undef MLA_LOADK
#undef MLA_LOADV
#undef MLA_STOREK
#undef MLA_STOREV
    const float inv = (1.f / 256.f) / l;
    const bf16* zp = P.Z + (size_t)tq * 2048 + head * 128 + 4 * hi;
    bf16* op = P.O + (size_t)tq * 4096 + head * 128 + 4 * hi;
#pragma unroll
    for (int d0 = 0; d0 < 4; ++d0)
#pragma unroll
        for (int rg = 0; rg < 4; ++rg) { const int dim = 32 * d0 + 8 * rg;
            const u32x2 z = *(const GAS u32x2*)(zp + dim);
            u32x2 w; w.x = pk2(o[d0][4 * rg + 0] * inv * bflo(z.x), o[d0][4 * rg + 1] * inv * bfhi(z.x)); w.y = pk2(o[d0][4 * rg + 2] * inv * bflo(z.y), o[d0][4 * rg + 3] * inv * bfhi(z.y));
            *(GAS u32x2*)(op + dim) = w; }
}
#elif defined(MLA_PIPE)
struct MlaPtrs { const bf16* Q; const bf16* K; const bf16* V; const bf16* Z; bf16* O; };
__device__ __forceinline__ void mla_mask(f32x16& p0, f32x16& p1, int dq) {
#pragma unroll
    for (int r = 0; r < 16; ++r) { const int c = (r & 3) + 8 * (r >> 2);
        if (c > dq) p0[r] = -__builtin_inff();
        if (c + 32 > dq) p1[r] = -__builtin_inff(); }
}
__device__ __forceinline__ void mla_unit(LAS unsigned char* lds, const MlaPtrs& P, int head, int qb, int tid_in, int wave, int lane_in) {
    int tid = tid_in; asm volatile("" : "+v"(tid)); const int lane = tid & 63; (void)lane_in;
    const int r32 = lane & 31, hi = lane >> 5;
    const int q0 = qb * 256, qw = q0 + wave * 32, tq = qw + r32;
    bf16x8 q[8];
    LAS unsigned char* ql = lds + MLA_QL + wave * 4096 + lane * 16;
    { const bf16* qp = P.Q + (size_t)tq * 3072 + head * 192 + hi * 8;
#pragma unroll
      for (int d0 = 0; d0 < 8; ++d0) q[d0] = *(const GAS bf16x8*)(qp + d0 * 16);
#pragma unroll
      for (int d0 = 8; d0 < 12; ++d0) *(LAS bf16x8*)(ql + (d0 - 8) * 1024) = *(const GAS bf16x8*)(qp + d0 * 16); }
    const int NT = 4 * (qb + 1);
    const int srow = tid >> 3, sc8 = tid & 7;
    const unsigned char* kg = (const unsigned char*)P.K + (size_t)head * 384 + (size_t)srow * 6144 + sc8 * 16;
    const unsigned char* vg = (const unsigned char*)P.V + (size_t)head * 256 + (size_t)srow * 4096 + sc8 * 16;
    LAS unsigned char* kst = lds + srow * KS_M + sc8 * 16;
    LAS unsigned char* vst = lds + 2 * MLA_KB + srow * VS + sc8 * 16;
    const LAS unsigned char* kl = lds + r32 * KS_M + hi * 16;
    const LAS unsigned char* vl = lds + 2 * MLA_KB + (4 * hi + ((lane & 15) >> 2)) * VS + (16 * ((lane >> 4) & 1) + 4 * (lane & 3)) * 2;
    u32x4 sk0, sk1, sk2, sv0, sv1;
#define MLA_LOADK(j) do { const unsigned char* kp_ = kg + (size_t)(j) * (64 * 6144); sk0 = *(const GAS u32x4*)(kp_); sk1 = *(const GAS u32x4*)(kp_ + 128); sk2 = *(const GAS u32x4*)(kp_ + 256); } while (0)
#define MLA_LOADV(j) do { const unsigned char* vp_ = vg + (size_t)(j) * (64 * 4096); sv0 = *(const GAS u32x4*)(vp_); sv1 = *(const GAS u32x4*)(vp_ + 128); } while (0)
#define MLA_STOREK(b) do { LAS unsigned char* kd_ = kst + (b) * MLA_KB; *(LAS u32x4*)(kd_) = sk0; *(LAS u32x4*)(kd_ + 128) = sk1; *(LAS u32x4*)(kd_ + 256) = sk2; } while (0)
#define MLA_STOREV(b) do { LAS unsigned char* vd_ = vst + (b) * VB; *(LAS u32x4*)(vd_) = sv0; *(LAS u32x4*)(vd_ + 128) = sv1; } while (0)
    float m = -1e30f, l = 0.f; f32x16 o[4];
#pragma unroll
    for (int d = 0; d < 4; ++d)
#pragma unroll
        for (int r = 0; r < 16; ++r) o[d][r] = 0.f;
    f32x16 pA0, pA1, pB0, pB1;
    MLA_LOADK(0); MLA_LOADV(0); MLA_STOREK(0); MLA_STOREV(0);
    MLA_LOADK(1);
    __syncthreads();
    qk_tile_free<12, 8, KS_M>(pA0, pA1, kl, q, ql);
    if (63 > qw) mla_mask(pA0, pA1, tq - 4 * hi);
    MLA_STOREK(1);
    if (2 < NT) MLA_LOADK(2);
    MLA_LOADV(1);
    __syncthreads();
#define MLA_SGB1(NR) do { __builtin_amdgcn_sched_group_barrier(0x100, NR, 0); __builtin_amdgcn_sched_group_barrier(0x008, 1, 0); __builtin_amdgcn_sched_group_barrier(0x002, 6, 0); \
        __builtin_amdgcn_sched_group_barrier(0x008, 1, 0); __builtin_amdgcn_sched_group_barrier(0x002, 6, 0); } while (0)
#define MLA_SGB() do { MLA_SGB1(2); MLA_SGB1(2); MLA_SGB1(2); MLA_SGB1(2); MLA_SGB1(2); MLA_SGB1(2); MLA_SGB1(2); MLA_SGB1(2); MLA_SGB1(3); MLA_SGB1(3); MLA_SGB1(3); MLA_SGB1(3); } while (0)
#define MLA_STEP(PX0, PX1, PY0, PY1, j) do { \
        const int kb1_ = 64 * ((j) + 1); \
        const bool a1_ = ((j) + 1 < NT) && (kb1_ <= qw + 31), a0_ = (64 * (j) <= qw + 31); \
        float alpha_ = 1.f; bf16x8 pb_[4]; \
        if (a1_) { \
            __builtin_amdgcn_sched_barrier(0); \
            qk_tile_free<12, 8, KS_M>(PY0, PY1, kl + (((j) + 1) & 1) * MLA_KB, q, ql); \
            alpha_ = sm_core(PX0, PX1, m, l); \
            pb_[0] = packp<0>(PX0); pb_[1] = packp<1>(PX0); pb_[2] = packp<0>(PX1); pb_[3] = packp<1>(PX1); \
            MLA_SGB(); \
            __builtin_amdgcn_sched_barrier(0); \
            if (kb1_ + 63 > qw) mla_mask(PY0, PY1, tq - kb1_ - 4 * hi); \
        } else if (a0_) { \
            alpha_ = sm_core(PX0, PX1, m, l); \
            pb_[0] = packp<0>(PX0); pb_[1] = packp<1>(PX0); pb_[2] = packp<0>(PX1); pb_[3] = packp<1>(PX1); \
        } \
        if (a0_) { \
            if (!__all(alpha_ == 1.f)) { _Pragma("unroll") for (int d_ = 0; d_ < 4; ++d_) _Pragma("unroll") for (int r_ = 0; r_ < 16; ++r_) o[d_][r_] *= alpha_; } \
            pv_tile(o, pb_, vl + ((j) & 1) * VB); \
        } \
        if ((j) + 2 < NT) MLA_STOREK((j) & 1); \
        if ((j) + 1 < NT) MLA_STOREV(((j) + 1) & 1); \
        if ((j) + 3 < NT) MLA_LOADK((j) + 3); \
        if ((j) + 2 < NT) MLA_LOADV((j) + 2); \
        __syncthreads(); } while (0)
    for (int j = 0; j < NT; j += 2) {
        MLA_STEP(pA0, pA1, pB0, pB1, j);
        MLA_STEP(pB0, pB1, pA0, pA1, j + 1);
    }
#undef MLA_STEP
#undef MLA_SGB
#undef MLA_SGB1
#undef MLA_LOADK
#undef MLA_LOADV
#undef MLA_STOREK
#undef MLA_STOREV
    const float inv = 1.f / l;
    const bf16* zp = P.Z + (size_t)tq * 2048 + head * 128 + 4 * hi;
    bf16* op = P.O + (size_t)tq * 4096 + head * 128 + 4 * hi;
#pragma unroll
    for (int d0 = 0; d0 < 4; ++d0)
#pragma unroll
        for (int rg = 0; rg < 4; ++rg) { const int dim = 32 * d0 + 8 * rg;
            const u32x2 z = *(const GAS u32x2*)(zp + dim);
            u32x2 w; w.x = pk2(o[d0][4 * rg + 0] * inv * bflo(z.x), o[d0][4 * rg + 1] * inv * bfhi(z.x)); w.y = pk2(o[d0][4 * rg + 2] * inv * bflo(z.y), o[d0][4 * rg + 3] * inv * bfhi(z.y));
            *(GAS u32x2*)(op + dim) = w; }
}

#else
#if defined(MLA_MX)
struct MlaPtrs { const bf16* Q; const bf16* K; const bf16* V; const bf16* Z; bf16* O; };
__device__ __forceinline__ void mla_unit(LAS unsigned char* lds, const MlaPtrs& P, int head, int qb, int tid_in, int wave, int lane_in) {
    int tid = tid_in; asm volatile("" : "+v"(tid)); const int lane = tid & 63; (void)lane_in;
    const int r32 = lane & 31, hi = lane >> 5;
    const int q0 = qb * 256, qw = q0 + wave * 32, tq = qw + r32;
    i32x8 q[3];
    { const unsigned char* qp = (const unsigned char*)P.Q + (size_t)tq * 3072 + head * 192 + hi * 32;
#pragma unroll
      for (int s = 0; s < 3; ++s) { const u32x4 a = *(const GAS u32x4*)(qp + 64 * s), b = *(const GAS u32x4*)(qp + 64 * s + 16);
          q[s] = (i32x8){(int)a.x, (int)a.y, (int)a.z, (int)a.w, (int)b.x, (int)b.y, (int)b.z, (int)b.w}; } }
    const int NT = 4 * (qb + 1);
    const int srow = tid >> 3, sc8 = tid & 7;
    const unsigned char* kg = (const unsigned char*)P.K + (size_t)head * 192 + (size_t)srow * 3072 + sc8 * 8;
    const unsigned char* vg = (const unsigned char*)P.V + ((size_t)head * 128 + (tid >> 2)) * S + (tid & 3) * 16;
    LAS unsigned char* kst = lds + srow * KSX + sc8 * 8;
    LAS unsigned char* vst = lds + 2 * MLA_KBX + (tid >> 2) * VSX + (tid & 3) * 16;
    const LAS unsigned char* kl = lds + r32 * KSX + hi * 32;
    const LAS unsigned char* vl = lds + 2 * MLA_KBX + r32 * VSX + hi * 32;
    u32x2 sk0, sk1, sk2; u32x4 sv0;
#define MLA_LOAD(j) do { const unsigned char* kp_ = kg + (size_t)(j) * (64 * 3072); const unsigned char* vp_ = vg + (size_t)(j) * 64; \
        sk0 = *(const GAS u32x2*)(kp_); sk1 = *(const GAS u32x2*)(kp_ + 64); sk2 = *(const GAS u32x2*)(kp_ + 128); sv0 = *(const GAS u32x4*)(vp_); } while (0)
#define MLA_STORE(b, vb) do { LAS unsigned char* kd_ = kst + (b) * MLA_KBX; LAS unsigned char* vd_ = vst + (vb) * VBX; \
        *(LAS u32x2*)(kd_) = sk0; *(LAS u32x2*)(kd_ + 64) = sk1; *(LAS u32x2*)(kd_ + 128) = sk2; *(LAS u32x2*)(vd_) = (u32x2){sv0.x, sv0.y}; *(LAS u32x2*)(vd_ + 8) = (u32x2){sv0.z, sv0.w}; } while (0)
    MLA_LOAD(0); MLA_STORE(0, 0);
    __syncthreads();
    asm volatile("" : "+v"(q[0]), "+v"(q[1]), "+v"(q[2]));
    float m = -1e30f, l = 0.f; f32x16 o[4];
#pragma unroll
    for (int d = 0; d < 4; ++d)
#pragma unroll
        for (int r = 0; r < 16; ++r) o[d][r] = 0.f;
    const bool trail = wave >= 4;
    i32x8 pb = {};
    int vb_cur = 0, vb_prev = 2;
    for (int j = 0; j < NT; ++j) {
        const int kb = 64 * j;
        int vb_next = vb_cur + 1; if (vb_next == 3) vb_next = 0;
        if (j + 1 < NT) MLA_LOAD(j + 1);
        if (trail && j > 0 && kb - 64 <= qw + 31) pv_tilex(o, pb, vl + vb_prev * VBX);
        if (kb <= qw + 31) {
            f32x16 p0, p1;
            qk_tilex(p0, p1, kl + (j & 1) * MLA_KBX, q);
            if (kb + 63 > qw) {
                const int dq = tq - kb - 4 * hi;
#pragma unroll
                for (int r = 0; r < 16; ++r) { const int c = (r & 3) + 8 * (r >> 2);
                    if (c > dq) p0[r] = -__builtin_inff();
                    if (c + 32 > dq) p1[r] = -__builtin_inff(); }
            }
            online_sm_x(p0, p1, m, l, o, QS_MLA);
            pb = packpx(p0, p1);
            if (!trail) pv_tilex(o, pb, vl + vb_cur * VBX);
        }
        if (j + 1 < NT) MLA_STORE((j + 1) & 1, vb_next);
        __syncthreads();
        vb_prev = vb_cur; vb_cur = vb_next;
    }
    if (trail && 64 * (NT - 1) <= qw + 31) pv_tilex(o, pb, vl + vb_prev * VBX);
    __syncthreads();
#undef MLA_LOAD
#undef MLA_STORE
    const float inv = 1.f / l;
    const bf16* zp = P.Z + (size_t)tq * 2048 + head * 128 + 4 * hi;
    bf16* op = P.O + (size_t)tq * 4096 + head * 128 + 4 * hi;
#pragma unroll
    for (int d0 = 0; d0 < 4; ++d0)
#pragma unroll
        for (int rg = 0; rg < 4; ++rg) { const int dim = 32 * d0 + 8 * rg;
            const u32x2 z = *(const GAS u32x2*)(zp + dim);
            u32x2 w; w.x = pk2(o[d0][4 * rg + 0] * inv * bflo(z.x), o[d0][4 * rg + 1] * inv * bfhi(z.x)); w.y = pk2(o[d0][4 * rg + 2] * inv * bflo(z.y), o[d0][4 * rg + 3] * inv * bfhi(z.y));
            *(GAS u32x2*)(op + dim) = w; }
}

#elif defined(MLA_BIG)
struct MlaPtrs { const bf16* Q; const bf16* K; const bf16* V; const bf16* Z; bf16* O; };
__device__ __forceinline__ void mla_unit(LAS unsigned char* lds, const MlaPtrs& P, int head, int qb, int tid_in, int wave, int lane_in) {
    int tid = tid_in; asm volatile("" : "+v"(tid)); const int lane = tid & 63; (void)lane_in;
    const int r32 = lane & 31, hi = lane >> 5;
    const int q0 = qb * 256, qw = q0 + wave * 32, tq = qw + r32;
    i64 q[12];
    { const unsigned char* qp = (const unsigned char*)P.Q + (size_t)tq * 3072 + head * 192 + hi * 8;
#pragma unroll
      for (int d0 = 0; d0 < 12; ++d0) q[d0] = *(const GAS i64*)(qp + d0 * 16); }
    const int NT = 4 * (qb + 1), NTB = NT / 2;
    const int srow = tid >> 3, sc8 = tid & 7;
    const unsigned char* kg = (const unsigned char*)P.K + (size_t)head * 192 + (size_t)srow * 3072 + sc8 * 8;
    const unsigned char* vg = (const unsigned char*)P.V + ((size_t)head * 128 + (tid >> 2)) * S + (tid & 3) * 32;
    LAS unsigned char* kst = lds + srow * KS8 + sc8 * 8;
    LAS unsigned char* vst = lds + 2 * MLA_KB8B + (tid >> 2) * VS8B + (tid & 3) * 32;
    const LAS unsigned char* kl = lds + r32 * KS8 + hi * 8;
    const LAS unsigned char* vl = lds + 2 * MLA_KB8B + r32 * VS8B + hi * 8;
    u32x2 sk0, sk1, sk2, sk3, sk4, sk5; u32x4 sv0, sv1;
#define MLA_LOAD(J) do { const unsigned char* kp_ = kg + (size_t)(J) * (128 * 3072); const unsigned char* vp_ = vg + (size_t)(J) * 128; \
        sk0 = *(const GAS u32x2*)(kp_); sk1 = *(const GAS u32x2*)(kp_ + 64); sk2 = *(const GAS u32x2*)(kp_ + 128); \
        sk3 = *(const GAS u32x2*)(kp_ + 64 * 3072); sk4 = *(const GAS u32x2*)(kp_ + 64 * 3072 + 64); sk5 = *(const GAS u32x2*)(kp_ + 64 * 3072 + 128); \
        sv0 = *(const GAS u32x4*)(vp_); sv1 = *(const GAS u32x4*)(vp_ + 16); } while (0)
#define MLA_STORE(b, vb) do { LAS unsigned char* kd_ = kst + (b) * MLA_KB8B; LAS unsigned char* vd_ = vst + (vb) * VB8B; \
        *(LAS u32x2*)(kd_) = sk0; *(LAS u32x2*)(kd_ + 64) = sk1; *(LAS u32x2*)(kd_ + 128) = sk2; \
        *(LAS u32x2*)(kd_ + 64 * KS8) = sk3; *(LAS u32x2*)(kd_ + 64 * KS8 + 64) = sk4; *(LAS u32x2*)(kd_ + 64 * KS8 + 128) = sk5; \
        *(LAS u32x2*)(vd_) = (u32x2){sv0.x, sv0.y}; *(LAS u32x2*)(vd_ + 8) = (u32x2){sv0.z, sv0.w}; *(LAS u32x2*)(vd_ + 16) = (u32x2){sv1.x, sv1.y}; *(LAS u32x2*)(vd_ + 24) = (u32x2){sv1.z, sv1.w}; } while (0)
    MLA_LOAD(0); MLA_STORE(0, 0);
    __syncthreads();
    float m = -1e30f, l = 0.f; f32x16 o[4];
#pragma unroll
    for (int d = 0; d < 4; ++d)
#pragma unroll
        for (int r = 0; r < 16; ++r) o[d][r] = 0.f;
    const bool trail = wave >= 4;
    i64 pb[4] = {};
    int vb_cur = 0, vb_prev = 2;
    for (int J = 0; J < NTB; ++J) {
        int vb_next = vb_cur + 1; if (vb_next == 3) vb_next = 0;
        if (J + 1 < NTB) MLA_LOAD(J + 1);
#pragma unroll
        for (int sub = 0; sub < 2; ++sub) {
            const int j = 2 * J + sub, kb = 64 * j;
            if (trail && j > 0 && kb - 64 <= qw + 31) pv_tile8(o, pb, vl + (sub == 0 ? vb_prev * VB8B + 64 : vb_cur * VB8B));
            if (kb <= qw + 31) {
                f32x16 p0, p1;
                qk_tile8<12>(p0, p1, kl + (J & 1) * MLA_KB8B + sub * 64 * KS8, q);
                if (kb + 63 > qw) {
                    const int dq = tq - kb - 4 * hi;
#pragma unroll
                    for (int r = 0; r < 16; ++r) { const int c = (r & 3) + 8 * (r >> 2);
                        if (c > dq) p0[r] = -__builtin_inff();
                        if (c + 32 > dq) p1[r] = -__builtin_inff(); }
                }
                online_sm_scaled(p0, p1, m, l, o, QS_MLA);
                pb[0] = packp8<0>(p0); pb[1] = packp8<1>(p0); pb[2] = packp8<0>(p1); pb[3] = packp8<1>(p1);
                if (!trail) pv_tile8(o, pb, vl + vb_cur * VB8B + sub * 64);
            }
        }
        if (J + 1 < NTB) MLA_STORE((J + 1) & 1, vb_next);
        __syncthreads();
        vb_prev = vb_cur; vb_cur = vb_next;
    }
    if (trail && 64 * (NT - 1) <= qw + 31) pv_tile8(o, pb, vl + vb_prev * VB8B + 64);
    __syncthreads();
#undef MLA_LOAD
#undef MLA_STORE
    const float inv = (1.f / 256.f) / l;
    const bf16* zp = P.Z + (size_t)tq * 2048 + head * 128 + 4 * hi;
    bf16* op = P.O + (size_t)tq * 4096 + head * 128 + 4 * hi;
#pragma unroll
    for (int d0 = 0; d0 < 4; ++d0)
#pragma unroll
        for (int rg = 0; rg < 4; ++rg) { const int dim = 32 * d0 + 8 * rg;
            const u32x2 z = *(const GAS u32x2*)(zp + dim);
            u32x2 w; w.x = pk2(o[d0][4 * rg + 0] * inv * bflo(z.x), o[d0][4 * rg + 1] * inv * bfhi(z.x)); w.y = pk2(o[d0][4 * rg + 2] * inv * bflo(z.y), o[d0][4 * rg + 3] * inv * bfhi(z.y));
            *(GAS u32x2*)(op + dim) = w; }
}

#elif defined(MLA_FP8V)
struct MlaPtrs { const bf16* Q; const bf16* K; const bf16* V; const bf16* Z; bf16* O; };
__device__ __forceinline__ void mla_unit(LAS unsigned char* lds, const MlaPtrs& P, int head, int qb, int tid_in, int wave, int lane_in) {
    int tid = tid_in; asm volatile("" : "+v"(tid)); const int lane = tid & 63; (void)lane_in;
    const int r32 = lane & 31, hi = lane >> 5;
    const int q0 = qb * 256, qw = q0 + wave * 32, tq = qw + r32;
    i64 q[12];
    { const unsigned char* qp = (const unsigned char*)P.Q + (size_t)tq * 3072 + head * 192 + hi * 8;
#pragma unroll
      for (int d0 = 0; d0 < 12; ++d0) q[d0] = *(const GAS i64*)(qp + d0 * 16); }
    const int NT = 4 * (qb + 1);
    const int srow = tid >> 3, sc8 = tid & 7;
    const unsigned char* kg = (const unsigned char*)P.K + (size_t)head * 192 + (size_t)srow * 3072 + sc8 * 8;
    const unsigned char* vg = (const unsigned char*)P.V + ((size_t)head * 128 + (tid >> 2)) * S + (tid & 3) * 16;
    LAS unsigned char* kst = lds + srow * KS8 + sc8 * 8;
    LAS unsigned char* vst = lds + 2 * MLA_KB8 + (tid >> 2) * VS8 + (tid & 3) * 16;
    const LAS unsigned char* kl = lds + r32 * KS8 + hi * 8;
    const LAS unsigned char* vl = lds + 2 * MLA_KB8 + r32 * VS8 + hi * 8;
    u32x2 sk0, sk1, sk2; u32x4 sv0;
#define MLA_LOAD(j) do { const unsigned char* kp_ = kg + (size_t)(j) * (64 * 3072); const unsigned char* vp_ = vg + (size_t)(j) * 64; \
        sk0 = *(const GAS u32x2*)(kp_); sk1 = *(const GAS u32x2*)(kp_ + 64); sk2 = *(const GAS u32x2*)(kp_ + 128); sv0 = *(const GAS u32x4*)(vp_); } while (0)
#define MLA_STORE(b, vb) do { LAS unsigned char* kd_ = kst + (b) * MLA_KB8; LAS unsigned char* vd_ = vst + (vb) * VB8; \
        *(LAS u32x2*)(kd_) = sk0; *(LAS u32x2*)(kd_ + 64) = sk1; *(LAS u32x2*)(kd_ + 128) = sk2; *(LAS u32x2*)(vd_) = (u32x2){sv0.x, sv0.y}; *(LAS u32x2*)(vd_ + 8) = (u32x2){sv0.z, sv0.w}; } while (0)
    MLA_LOAD(0); MLA_STORE(0, 0);
    __syncthreads();
    float m = -1e30f, l = 0.f; f32x16 o[4];
#pragma unroll
    for (int d = 0; d < 4; ++d)
#pragma unroll
        for (int r = 0; r < 16; ++r) o[d][r] = 0.f;
    const bool trail = wave >= 4;
    i64 pb[4] = {};
    int vb_cur = 0, vb_prev = 2;
    for (int j = 0; j < NT; ++j) {
        const int kb = 64 * j;
        int vb_next = vb_cur + 1; if (vb_next == 3) vb_next = 0;
        if (j + 1 < NT) MLA_LOAD(j + 1);
        if (trail && j > 0 && kb - 64 <= qw + 31) pv_tile8(o, pb, vl + vb_prev * VB8);
        if (kb <= qw + 31) {
            f32x16 p0, p1;
#ifdef PROBE_QKM2
            { f32x16 r0, r1; qk_tile_m2<12, KS_M>(p0, p1, r0, r1, kl + (j & 1) * MLA_KB, q);
#pragma unroll
              for (int r = 0; r < 16; ++r) { p0[r] = (p0[r] + r0[r]) * 0.5f; p1[r] = (p1[r] + r1[r]) * 0.5f; } }
#else
            qk_tile8<12>(p0, p1, kl + (j & 1) * MLA_KB8, q);
#endif
#ifdef PROBE_QK2
            { f32x16 r0, r1; asm volatile("" ::: "memory"); qk_tile<12, KS_M>(r0, r1, kl + (j & 1) * MLA_KB, q);
#pragma unroll
              for (int r = 0; r < 16; ++r) { p0[r] = (p0[r] + r0[r]) * 0.5f; p1[r] = (p1[r] + r1[r]) * 0.5f; } }
#endif
#ifdef PROBE_SM2
            { float acc_ = 0.f;
#pragma unroll
              for (int r = 0; r < 16; ++r) { acc_ += __builtin_amdgcn_exp2f(p0[r] - m - 40.f) + __builtin_amdgcn_exp2f(p1[r] - m - 40.f); }
#pragma unroll
              for (int r = 0; r < 16; ++r) { acc_ += __builtin_amdgcn_exp2f(p0[r] - m - 50.f) + __builtin_amdgcn_exp2f(p1[r] - m - 50.f); }
              if (acc_ == 12345.678f) l += 1.f; }
#endif
            if (kb + 63 > qw) {
                const int dq = tq - kb - 4 * hi;
#pragma unroll
                for (int r = 0; r < 16; ++r) { const int c = (r & 3) + 8 * (r >> 2);
                    if (c > dq) p0[r] = -__builtin_inff();
                    if (c + 32 > dq) p1[r] = -__builtin_inff(); }
            }
            online_sm_scaled(p0, p1, m, l, o, QS_MLA);
            pb[0] = packp8<0>(p0); pb[1] = packp8<1>(p0); pb[2] = packp8<0>(p1); pb[3] = packp8<1>(p1);
            if (!trail) pv_tile8(o, pb, vl + vb_cur * VB8);
        }
        if (j + 1 < NT) MLA_STORE((j + 1) & 1, vb_next);
        __syncthreads();
        vb_prev = vb_cur; vb_cur = vb_next;
    }
    if (trail && 64 * (NT - 1) <= qw + 31) pv_tile8(o, pb, vl + vb_prev * VB8);
    __syncthreads();
#undef MLA_LOAD
#undef MLA_STORE
    const float inv = (1.f / 256.f) / l;
    const bf16* zp = P.Z + (size_t)tq * 2048 + head * 128 + 4 * hi;
    bf16* op = P.O + (size_t)tq * 4096 + head * 128 + 4 * hi;
#pragma unroll
    for (int d0 = 0; d0 < 4; ++d0)
#pragma unroll
        for (int rg = 0; rg < 4; ++rg) { const int dim = 32 * d0 + 8 * rg;
            const u32x2 z = *(const GAS u32x2*)(zp + dim);
            u32x2 w; w.x = pk2(o[d0][4 * rg + 0] * inv * bflo(z.x), o[d0][4 * rg + 1] * inv * bfhi(z.x)); w.y = pk2(o[d0][4 * rg + 2] * inv * bflo(z.y), o[d0][4 * rg + 3] * inv * bfhi(z.y));
            *(GAS u32x2*)(op + dim) = w; }
}

#elif defined(MLA_FP8)
struct MlaPtrs { const bf16* Q; const bf16* K; const bf16* V; const bf16* Z; bf16* O; };
__device__ __forceinline__ void mla_unit(LAS unsigned char* lds, const MlaPtrs& P, int head, int qb, int tid_in, int wave, int lane_in) {
    int tid = tid_in; asm volatile("" : "+v"(tid)); const int lane = tid & 63; (void)lane_in;
    const int r32 = lane & 31, hi = lane >> 5;
    const int q0 = qb * 256, qw = q0 + wave * 32, tq = qw + r32;
    i64 q[12];
    { const unsigned char* qp = (const unsigned char*)P.Q + (size_t)tq * 3072 + head * 192 + hi * 8;
#pragma unroll
      for (int d0 = 0; d0 < 12; ++d0) q[d0] = *(const GAS i64*)(qp + d0 * 16); }
    const int NT = 4 * (qb + 1);
    const int srow = tid >> 3, sc8 = tid & 7;
    const unsigned char* kg = (const unsigned char*)P.K + (size_t)head * 192 + (size_t)srow * 3072 + sc8 * 8;
    const unsigned char* vg = (const unsigned char*)P.V + (size_t)head * 256 + (size_t)srow * 4096 + sc8 * 16;
    LAS unsigned char* kst = lds + srow * KS8 + sc8 * 8;
    LAS unsigned char* vst = lds + 2 * MLA_KB8 + srow * VS + sc8 * 16;
    const LAS unsigned char* kl = lds + r32 * KS8 + hi * 8;
    const LAS unsigned char* vl = lds + 2 * MLA_KB8 + (4 * hi + ((lane & 15) >> 2)) * VS + (16 * ((lane >> 4) & 1) + 4 * (lane & 3)) * 2;
    u32x2 sk0, sk1, sk2; u32x4 sv0, sv1;
#define MLA_LOAD(j) do { const unsigned char* kp_ = kg + (size_t)(j) * (64 * 3072); const unsigned char* vp_ = vg + (size_t)(j) * (64 * 4096); \
        sk0 = *(const GAS u32x2*)(kp_); sk1 = *(const GAS u32x2*)(kp_ + 64); sk2 = *(const GAS u32x2*)(kp_ + 128); sv0 = *(const GAS u32x4*)(vp_); sv1 = *(const GAS u32x4*)(vp_ + 128); } while (0)
#define MLA_STORE(b, vb) do { LAS unsigned char* kd_ = kst + (b) * MLA_KB8; LAS unsigned char* vd_ = vst + (vb) * VB; \
        *(LAS u32x2*)(kd_) = sk0; *(LAS u32x2*)(kd_ + 64) = sk1; *(LAS u32x2*)(kd_ + 128) = sk2; *(LAS u32x4*)(vd_) = sv0; *(LAS u32x4*)(vd_ + 128) = sv1; } while (0)
    MLA_LOAD(0); MLA_STORE(0, 0);
    __syncthreads();
    float m = -1e30f, l = 0.f; f32x16 o[4];
#pragma unroll
    for (int d = 0; d < 4; ++d)
#pragma unroll
        for (int r = 0; r < 16; ++r) o[d][r] = 0.f;
    const bool trail = wave >= 4;
    bf16x8 pb[4] = {};
    int vb_cur = 0, vb_prev = 2;
    for (int j = 0; j < NT; ++j) {
        const int kb = 64 * j;
        int vb_next = vb_cur + 1; if (vb_next == 3) vb_next = 0;
        if (j + 1 < NT) MLA_LOAD(j + 1);
        if (trail && j > 0 && kb - 64 <= qw + 31) pv_tile(o, pb, vl + vb_prev * VB);
        if (kb <= qw + 31) {
            f32x16 p0, p1;
#ifdef PROBE_QKM2
            { f32x16 r0, r1; qk_tile_m2<12, KS_M>(p0, p1, r0, r1, kl + (j & 1) * MLA_KB, q);
#pragma unroll
              for (int r = 0; r < 16; ++r) { p0[r] = (p0[r] + r0[r]) * 0.5f; p1[r] = (p1[r] + r1[r]) * 0.5f; } }
#else
            qk_tile8<12>(p0, p1, kl + (j & 1) * MLA_KB8, q);
#endif
#ifdef PROBE_QK2
            { f32x16 r0, r1; asm volatile("" ::: "memory"); qk_tile<12, KS_M>(r0, r1, kl + (j & 1) * MLA_KB, q);
#pragma unroll
              for (int r = 0; r < 16; ++r) { p0[r] = (p0[r] + r0[r]) * 0.5f; p1[r] = (p1[r] + r1[r]) * 0.5f; } }
#endif
#ifdef PROBE_SM2
            { float acc_ = 0.f;
#pragma unroll
              for (int r = 0; r < 16; ++r) { acc_ += __builtin_amdgcn_exp2f(p0[r] - m - 40.f) + __builtin_amdgcn_exp2f(p1[r] - m - 40.f); }
#pragma unroll
              for (int r = 0; r < 16; ++r) { acc_ += __builtin_amdgcn_exp2f(p0[r] - m - 50.f) + __builtin_amdgcn_exp2f(p1[r] - m - 50.f); }
              if (acc_ == 12345.678f) l += 1.f; }
#endif
            if (kb + 63 > qw) {
                const int dq = tq - kb - 4 * hi;
#pragma unroll
                for (int r = 0; r < 16; ++r) { const int c = (r & 3) + 8 * (r >> 2);
                    if (c > dq) p0[r] = -__builtin_inff();
                    if (c + 32 > dq) p1[r] = -__builtin_inff(); }
            }
            online_sm_scaled(p0, p1, m, l, o, QS_MLA);
            pb[0] = packp<0>(p0); pb[1] = packp<1>(p0); pb[2] = packp<0>(p1); pb[3] = packp<1>(p1);
            if (!trail) pv_tile(o, pb, vl + vb_cur * VB);
        }
        if (j + 1 < NT) MLA_STORE((j + 1) & 1, vb_next);
        __syncthreads();
        vb_prev = vb_cur; vb_cur = vb_next;
    }
    if (trail && 64 * (NT - 1) <= qw + 31) pv_tile(o, pb, vl + vb_prev * VB);
    __syncthreads();
#undef MLA_LOAD
#undef MLA_STORE
    const float inv = 1.f / l;
    const bf16* zp = P.Z + (size_t)tq * 2048 + head * 128 + 4 * hi;
    bf16* op = P.O + (size_t)tq * 4096 + head * 128 + 4 * hi;
#pragma unroll
    for (int d0 = 0; d0 < 4; ++d0)
#pragma unroll
        for (int rg = 0; rg < 4; ++rg) { const int dim = 32 * d0 + 8 * rg;
            const u32x2 z = *(const GAS u32x2*)(zp + dim);
            u32x2 w; w.x = pk2(o[d0][4 * rg + 0] * inv * bflo(z.x), o[d0][4 * rg + 1] * inv * bfhi(z.x)); w.y = pk2(o[d0][4 * rg + 2] * inv * bflo(z.y), o[d0][4 * rg + 3] * inv * bfhi(z.y));
            *(GAS u32x2*)(op + dim) = w; }
}

#else
struct MlaPtrs { const bf16* Q; const bf16* K; const bf16* V; const bf16* Z; bf16* O; };
__device__ __forceinline__ void mla_unit(LAS unsigned char* lds, const MlaPtrs& P, int head, int qb, int tid_in, int wave, int lane_in) {
    int tid = tid_in; asm volatile("" : "+v"(tid)); const int lane = tid & 63; (void)lane_in;
    const int r32 = lane & 31, hi = lane >> 5;
    const int q0 = qb * 256, qw = q0 + wave * 32, tq = qw + r32;
    bf16x8 q[12];
    { const bf16* qp = P.Q + (size_t)tq * 3072 + head * 192 + hi * 8;
#pragma unroll
      for (int d0 = 0; d0 < 12; ++d0) q[d0] = *(const GAS bf16x8*)(qp + d0 * 16); }
    const int NT = 4 * (qb + 1);
    const int srow = tid >> 3, sc8 = tid & 7;
    const unsigned char* kg = (const unsigned char*)P.K + (size_t)head * 384 + (size_t)srow * 6144 + sc8 * 16;
    const unsigned char* vg = (const unsigned char*)P.V + (size_t)head * 256 + (size_t)srow * 4096 + sc8 * 16;
    LAS unsigned char* kst = lds + srow * KS_M + sc8 * 16;
    LAS unsigned char* vst = lds + 2 * MLA_KB + srow * VS + sc8 * 16;
    const LAS unsigned char* kl = lds + r32 * KS_M + hi * 16;
    const LAS unsigned char* vl = lds + 2 * MLA_KB + (4 * hi + ((lane & 15) >> 2)) * VS + (16 * ((lane >> 4) & 1) + 4 * (lane & 3)) * 2;
    u32x4 sk0, sk1, sk2, sv0, sv1;
#define MLA_LOAD(j) do { const unsigned char* kp_ = kg + (size_t)(j) * (64 * 6144); const unsigned char* vp_ = vg + (size_t)(j) * (64 * 4096); \
        sk0 = *(const GAS u32x4*)(kp_); sk1 = *(const GAS u32x4*)(kp_ + 128); sk2 = *(const GAS u32x4*)(kp_ + 256); sv0 = *(const GAS u32x4*)(vp_); sv1 = *(const GAS u32x4*)(vp_ + 128); } while (0)
#define MLA_STORE(b, vb) do { LAS unsigned char* kd_ = kst + (b) * MLA_KB; LAS unsigned char* vd_ = vst + (vb) * VB; \
        *(LAS u32x4*)(kd_) = sk0; *(LAS u32x4*)(kd_ + 128) = sk1; *(LAS u32x4*)(kd_ + 256) = sk2; *(LAS u32x4*)(vd_) = sv0; *(LAS u32x4*)(vd_ + 128) = sv1; } while (0)
    MLA_LOAD(0); MLA_STORE(0, 0);
    __syncthreads();
    float m = -1e30f, l = 0.f; f32x16 o[4];
#pragma unroll
    for (int d = 0; d < 4; ++d)
#pragma unroll
        for (int r = 0; r < 16; ++r) o[d][r] = 0.f;
    const bool trail = wave >= 4;
    bf16x8 pb[4] = {};
    int vb_cur = 0, vb_prev = 2;
    for (int j = 0; j < NT; ++j) {
        const int kb = 64 * j;
        int vb_next = vb_cur + 1; if (vb_next == 3) vb_next = 0;
        if (j + 1 < NT) MLA_LOAD(j + 1);
        if (trail && j > 0 && kb - 64 <= qw + 31) pv_tile(o, pb, vl + vb_prev * VB);
        if (kb <= qw + 31) {
            f32x16 p0, p1;
#ifdef PROBE_QKM2
            { f32x16 r0, r1; qk_tile_m2<12, KS_M>(p0, p1, r0, r1, kl + (j & 1) * MLA_KB, q);
#pragma unroll
              for (int r = 0; r < 16; ++r) { p0[r] = (p0[r] + r0[r]) * 0.5f; p1[r] = (p1[r] + r1[r]) * 0.5f; } }
#else
            qk_tile<12, KS_M>(p0, p1, kl + (j & 1) * MLA_KB, q);
#endif
#ifdef PROBE_QK2
            { f32x16 r0, r1; asm volatile("" ::: "memory"); qk_tile<12, KS_M>(r0, r1, kl + (j & 1) * MLA_KB, q);
#pragma unroll
              for (int r = 0; r < 16; ++r) { p0[r] = (p0[r] + r0[r]) * 0.5f; p1[r] = (p1[r] + r1[r]) * 0.5f; } }
#endif
#ifdef PROBE_SM2
            { float acc_ = 0.f;
#pragma unroll
              for (int r = 0; r < 16; ++r) { acc_ += __builtin_amdgcn_exp2f(p0[r] - m - 40.f) + __builtin_amdgcn_exp2f(p1[r] - m - 40.f); }
#pragma unroll
              for (int r = 0; r < 16; ++r) { acc_ += __builtin_amdgcn_exp2f(p0[r] - m - 50.f) + __builtin_amdgcn_exp2f(p1[r] - m - 50.f); }
              if (acc_ == 12345.678f) l += 1.f; }
#endif
            if (kb + 63 > qw) {
                const int dq = tq - kb - 4 * hi;
#pragma unroll
                for (int r = 0; r < 16; ++r) { const int c = (r & 3) + 8 * (r >> 2);
                    if (c > dq) p0[r] = -__builtin_inff();
                    if (c + 32 > dq) p1[r] = -__builtin_inff(); }
            }
            online_sm(p0, p1, m, l, o);
            pb[0] = packp<0>(p0); pb[1] = packp<1>(p0); pb[2] = packp<0>(p1); pb[3] = packp<1>(p1);
            if (!trail) pv_tile(o, pb, vl + vb_cur * VB);
        }
        if (j + 1 < NT) MLA_STORE((j + 1) & 1, vb_next);
        __syncthreads();
        vb_prev = vb_cur; vb_cur = vb_next;
    }
    if (trail && 64 * (NT - 1) <= qw + 31) pv_tile(o, pb, vl + vb_prev * VB);
    __syncthreads();
#undef MLA_LOAD
#undef MLA_STORE
    const float inv = 1.f / l;
    const bf16* zp = P.Z + (size_t)tq * 2048 + head * 128 + 4 * hi;
    bf16* op = P.O + (size_t)tq * 4096 + head * 128 + 4 * hi;
#pragma unroll
    for (int d0 = 0; d0 < 4; ++d0)
#pragma unroll
        for (int rg = 0; rg < 4; ++rg) { const int dim = 32 * d0 + 8 * rg;
            const u32x2 z = *(const GAS u32x2*)(zp + dim);
            u32x2 w; w.x = pk2(o[d0][4 * rg + 0] * inv * bflo(z.x), o[d0][4 * rg + 1] * inv * bfhi(z.x)); w.y = pk2(o[d0][4 * rg + 2] * inv * bflo(z.y), o[d0][4 * rg + 3] * inv * bfhi(z.y));
            *(GAS u32x2*)(op + dim) = w; }
}

#endif
#endif
struct NsaPtrs { const bf16* Q; const bf16* KV; const bf16* KC; const bf16* VC; const bf16* Z; const float* G; bf16* O; float* scr; };
template <int MODE>
__device__ __forceinline__ void nsa_loop(LAS unsigned char* lds, const unsigned char* kbase, const unsigned char* vbase, int ntiles, int jlo,
                                         const bf16x8 (&q)[8], int t, float slope2, float& m, float& l, f32x16 (&o)[4], float invl, int tid, int wave, int lane) {
    constexpr bool HASV = MODE != 0;
    const int r32 = lane & 31, hi = lane >> 5;
    const int srow = tid >> 3, sc8 = tid & 7;
    const unsigned soff = srow * 256 + sc8 * 16;
    LAS unsigned char* kst = lds + srow * KS_N + sc8 * 16;
    LAS unsigned char* vst = lds + 2 * NSA_KB + srow * VS + sc8 * 16;
    const LAS unsigned char* kl = lds + r32 * KS_N + hi * 16;
    const LAS unsigned char* vl = lds + 2 * NSA_KB + (4 * hi + ((lane & 15) >> 2)) * VS + (16 * ((lane >> 4) & 1) + 4 * (lane & 3)) * 2;
    const LAS int* ulist = (const LAS int*)(lds + N_ULIST);
    const LAS unsigned* selm = (const LAS unsigned*)(lds + N_SELM);
    LAS float* partA = (LAS float*)(lds + N_PART); LAS float* partB = (LAS float*)(lds + N_PART + N_PARTB);
    LAS float* imp = (LAS float*)(lds + N_IMP); LAS float* carry = (LAS float*)(lds + N_CARRY);
    if (ntiles <= 0) return;
    u32x4 sk0, sk1, sv0, sv1;
#define NSA_TROW(j) (MODE == 2 ? 64 * __builtin_amdgcn_readfirstlane(ulist[(j)]) : 64 * (jlo + (j)))
#define NSA_LOAD(j) do { const size_t ro_ = (size_t)NSA_TROW(j) * 256 + soff; \
        sk0 = *(const GAS u32x4*)(kbase + ro_); sk1 = *(const GAS u32x4*)(kbase + ro_ + 128); \
        if (HASV) { sv0 = *(const GAS u32x4*)(vbase + ro_); sv1 = *(const GAS u32x4*)(vbase + ro_ + 128); } } while (0)
#define NSA_STORE(b) do { LAS unsigned char* kd_ = kst + (b) * NSA_KB; *(LAS u32x4*)(kd_) = sk0; *(LAS u32x4*)(kd_ + 128) = sk1; \
        if (HASV) { LAS unsigned char* vd_ = vst + (b) * VB; *(LAS u32x4*)(vd_) = sv0; *(LAS u32x4*)(vd_ + 128) = sv1; } } while (0)
    NSA_LOAD(0); NSA_STORE(0);
    __syncthreads();
    for (int j = 0; j < ntiles; ++j) {
        const int buf = j & 1;
        if (MODE != 1 && j + 1 < ntiles) NSA_LOAD(j + 1);
        const int trow = NSA_TROW(j);
        constexpr int PSTEP = (MODE <= 1) ? 16 : 1;
        const int pstart = (MODE <= 1) ? 16 * trow + 31 : trow;
        const int db = t - pstart - PSTEP * 4 * hi;
        constexpr unsigned W = (MODE == 3) ? 512u : 0x7fffffffu;
        float b0 = -slope2 * (float)db;
        if (MODE == 2) { const int b = trow >> 6; if (((selm[r32 * 8 + (b >> 5)] >> (b & 31)) & 1u) == 0u) b0 = -__builtin_inff(); }
        f32x16 p0, p1;
#pragma unroll
        for (int r = 0; r < 16; ++r) { const int c = PSTEP * ((r & 3) + 8 * (r >> 2));
            p0[r] = __builtin_fmaf(slope2, (float)c, b0); p1[r] = __builtin_fmaf(slope2, (float)(c + 32 * PSTEP), b0); }
        qk_tile<8, KS_N, false>(p0, p1, kl + buf * NSA_KB, q);
        { const int t0u = __builtin_amdgcn_readfirstlane(t - r32);
          const bool interior = (t0u - (pstart + PSTEP * 63) >= 0) && ((unsigned)(t0u + 31 - pstart) < W);
          if (!interior) {
#pragma unroll
              for (int r = 0; r < 16; ++r) { const int c = PSTEP * ((r & 3) + 8 * (r >> 2));
                  if ((unsigned)(db - c) >= W) p0[r] = -__builtin_inff();
                  if ((unsigned)(db - c - 32 * PSTEP) >= W) p1[r] = -__builtin_inff(); } } }
        if (MODE == 0) {
            float tm = p0[0];
#pragma unroll
            for (int r = 1; r < 16; ++r) tm = fmaxf(tm, p0[r]);
#pragma unroll
            for (int r = 0; r < 16; ++r) tm = fmaxf(tm, p1[r]);
            tm = swapmax(tm);
            const float mn = fmaxf(m, tm); const float alpha = __builtin_amdgcn_exp2f(m - mn); m = mn;
            float ps = 0.f;
#pragma unroll
            for (int r = 0; r < 16; ++r) ps += __builtin_amdgcn_exp2f(p0[r] - mn) + __builtin_amdgcn_exp2f(p1[r] - mn);
            l = l * alpha + swapsum(ps);
        } else if (MODE == 1) {
#pragma unroll
            for (int r = 0; r < 16; ++r) { p0[r] = __builtin_amdgcn_exp2f(p0[r] - m) * invl; p1[r] = __builtin_amdgcn_exp2f(p1[r] - m) * invl; }
            LAS float* pa = partA + (wave * 32 + r32) * 17 + hi; LAS float* pbm = partB + (wave * 32 + r32) * 17 + hi;
#pragma unroll
            for (int rg = 0; rg < 4; ++rg) {
                pa[2 * rg] = (p0[4 * rg] + p0[4 * rg + 1]) + (p0[4 * rg + 2] + p0[4 * rg + 3]); pbm[2 * rg] = p0[4 * rg + 3];
                pa[8 + 2 * rg] = (p1[4 * rg] + p1[4 * rg + 1]) + (p1[4 * rg + 2] + p1[4 * rg + 3]); pbm[8 + 2 * rg] = p1[4 * rg + 3]; }
            const bf16x8 pb[4] = {packp<0>(p0), packp<1>(p0), packp<0>(p1), packp<1>(p1)};
            pv_tile(o, pb, vl + buf * VB);
            __syncthreads();
            { const int qq = tid >> 4, jl = tid & 15; float a = 0.f, bp = 0.f, bl = 0.f;
#pragma unroll
              for (int w = 0; w < 8; ++w) { a += partA[(w * 32 + qq) * 17 + jl]; bl += partB[(w * 32 + qq) * 17 + jl]; }
              if (jl > 0) {
#pragma unroll
                  for (int w = 0; w < 8; ++w) bp += partB[(w * 32 + qq) * 17 + jl - 1];
              } else bp = (j > 0) ? carry[((j - 1) & 1) * 32 + qq] : 0.f;
              imp[qq * 256 + 16 * j + jl] = a + bp;
              if (jl == 15) carry[(j & 1) * 32 + qq] = bl; }
        } else {
            online_sm(p0, p1, m, l, o);
            const bf16x8 pb[4] = {packp<0>(p0), packp<1>(p0), packp<0>(p1), packp<1>(p1)};
            pv_tile(o, pb, vl + buf * VB);
        }
        if (MODE == 1 && j + 1 < ntiles) NSA_LOAD(j + 1);
        if (j + 1 < ntiles) NSA_STORE(buf ^ 1);
        __syncthreads();
    }
#undef NSA_TROW
#undef NSA_LOAD
#undef NSA_STORE
}
__device__ __forceinline__ void nsa_topk(const LAS float* improw, LAS unsigned* selrow, int cur, int lane) {
    unsigned key[4]; bool sel[4];
    int nforced = 0;
#pragma unroll
    for (int k = 0; k < 4; ++k) { const int j = lane + 64 * k;
        const bool forced = (j == 0) || (j == cur) || (j == cur - 1);
        const bool causal = j <= cur;
        sel[k] = forced;
#ifdef IMPNOISE_BUILD
        { unsigned h = (unsigned)j * 2654435761u + (unsigned)(size_t)improw * 40503u; h ^= h >> 15; h *= 0x846ca68bu; h ^= h >> 16;
          const float r = (float)(int)(h & 0xffffu) * (1.f / 32768.f) - 1.f; const float v = improw[j] * (1.f + IMPNOISE_EPS * r);
          key[k] = (causal && !forced) ? (__float_as_uint(v) + 1u) : 0u; }
#else
        key[k] = (causal && !forced) ? (__float_as_uint(improw[j]) + 1u) : 0u;
#endif
    }
    nforced = 1 + (cur >= 1 ? 1 : 0) + (cur >= 2 ? 1 : 0);
    const int want = 16 - nforced;
    for (int it = 0; it < want; ++it) {
        unsigned bk = key[0]; int bj = lane;
#pragma unroll
        for (int k = 1; k < 4; ++k) { if (key[k] > bk) { bk = key[k]; bj = lane + 64 * k; } }
        unsigned long long best = ((unsigned long long)bk << 32) | (unsigned)(0xffffffffu - (unsigned)bj);
#pragma unroll
        for (int off = 1; off < 64; off <<= 1) {
            const unsigned lo = __shfl_xor((unsigned)best, off), hiw = __shfl_xor((unsigned)(best >> 32), off);
            const unsigned long long other = ((unsigned long long)hiw << 32) | lo;
            best = other > best ? other : best; }
        if ((unsigned)(best >> 32) == 0u) break;
        const int wj = (int)(0xffffffffu - (unsigned)best);
#pragma unroll
        for (int k = 0; k < 4; ++k) if (wj == lane + 64 * k) { key[k] = 0u; sel[k] = true; }
    }
#pragma unroll
    for (int k = 0; k < 4; ++k) { const unsigned long long bm = __ballot(sel[k]);
        if (lane == 0) { selrow[2 * k] = (unsigned)bm; selrow[2 * k + 1] = (unsigned)(bm >> 32); } }
}
__device__ __forceinline__ int nsa_opaque(int v) { asm volatile("" : "+v"(v)); return v; }
__device__ __forceinline__ void nsa_unit(LAS unsigned char* lds, const NsaPtrs& P, int g, int qblk, int tid_in, int wave, int lane_in, int cu) {
    int tid = tid_in; asm volatile("" : "+v"(tid));
    const int lane = tid & 63; (void)lane_in;
    const int r32 = lane & 31, hi = lane >> 5;
    const int hh = 8 * g + wave, t0 = 32 * qblk, t = t0 + r32;
    const float slope2 = __builtin_amdgcn_exp2f(-0.5f * (float)(hh + 1)) * LOG2E;
    bf16x8 q[8];
    { const bf16* qp = P.Q + (size_t)t * 2048 + hh * 128 + hi * 8;
#pragma unroll
      for (int d0 = 0; d0 < 8; ++d0) q[d0] = *(const GAS bf16x8*)(qp + d0 * 16); }
#define NSA_SCR() ((GAS f32x4*)(P.scr + ((size_t)(cu * 8 + wave) * 16) * 256) + nsa_opaque(lane))
    const size_t CH = (size_t)S * 128 * 2;
    f32x16 o[4]; float m, l;
#define NSA_ZERO_O() do { _Pragma("unroll") for (int d_ = 0; d_ < 4; ++d_) _Pragma("unroll") for (int r_ = 0; r_ < 16; ++r_) o[d_][r_] = 0.f; } while (0)
    const int ncv = 2 * qblk + 1, ntc = (ncv + 63) >> 6;
    const unsigned char* kc = (const unsigned char*)P.KC + (size_t)g * 1024 * 256; const unsigned char* vc = (const unsigned char*)P.VC + (size_t)g * 1024 * 256;
    m = -1e30f; l = 0.f; NSA_ZERO_O();
    nsa_loop<0>(lds, kc, vc, ntc, 0, q, t, slope2, m, l, o, 0.f, tid, wave, lane);
    const float invl = l > 0.f ? 1.f / l : 0.f;
    nsa_loop<1>(lds, kc, vc, ntc, 0, q, t, slope2, m, l, o, invl, tid, wave, lane);
    { const float g_c = P.G[(size_t)t * 48 + hh]; GAS f32x4* scr = NSA_SCR();
#pragma unroll
    for (int d0 = 0; d0 < 4; ++d0)
#pragma unroll
        for (int rg = 0; rg < 4; ++rg) { f32x4 v = {o[d0][4 * rg] * g_c, o[d0][4 * rg + 1] * g_c, o[d0][4 * rg + 2] * g_c, o[d0][4 * rg + 3] * g_c}; scr[(d0 * 4 + rg) * 64] = v; } }
    const int cur = t0 >> 6;
    LAS unsigned* selm = (LAS unsigned*)(lds + N_SELM);
    for (int i = 0; i < 4; ++i) { const int qq = 4 * wave + i; nsa_topk((const LAS float*)(lds + N_IMP) + qq * 256, selm + qq * 8, cur, lane); }
    __syncthreads();
    if (wave == 0) {
        LAS int* ulist = (LAS int*)(lds + N_ULIST); int n = 0;
        for (int k = 0; k < 8; ++k) { unsigned u = (lane < 32) ? selm[lane * 8 + k] : 0u;
#pragma unroll
            for (int off = 1; off < 32; off <<= 1) u |= __shfl_xor(u, off);
            u = __builtin_amdgcn_readfirstlane(u);
            while (u) { const int b = __builtin_ctz(u); u &= u - 1u; if (lane == 0) ulist[n] = 32 * k + b; ++n; } }
        if (lane == 0) *(LAS int*)(lds + N_NTS) = n;
    }
    __syncthreads();
    const int nts = __builtin_amdgcn_readfirstlane(*(const LAS int*)(lds + N_NTS));
    m = -1e30f; l = 0.f; NSA_ZERO_O();
    nsa_loop<2>(lds, (const unsigned char*)P.KV + (size_t)(4 + g) * CH, (const unsigned char*)P.KV + (size_t)(6 + g) * CH, nts, 0, q, t, slope2, m, l, o, 0.f, tid, wave, lane);
    { const float f = P.G[(size_t)t * 48 + 16 + hh] / l; GAS f32x4* scr = NSA_SCR();
#pragma unroll
      for (int d0 = 0; d0 < 4; ++d0)
#pragma unroll
          for (int rg = 0; rg < 4; ++rg) { f32x4 v = scr[(d0 * 4 + rg) * 64]; v[0] += o[d0][4 * rg] * f; v[1] += o[d0][4 * rg + 1] * f; v[2] += o[d0][4 * rg + 2] * f; v[3] += o[d0][4 * rg + 3] * f; scr[(d0 * 4 + rg) * 64] = v; } }
    const int jlo = (t0 > 511 ? t0 - 511 : 0) >> 6, jhi = (t0 + 31) >> 6;
    m = -1e30f; l = 0.f; NSA_ZERO_O();
    nsa_loop<3>(lds, (const unsigned char*)P.KV + (size_t)(8 + g) * CH, (const unsigned char*)P.KV + (size_t)(10 + g) * CH, jhi - jlo + 1, jlo, q, t, slope2, m, l, o, 0.f, tid, wave, lane);
    { const float f = P.G[(size_t)t * 48 + 32 + hh] / l; GAS f32x4* scr = NSA_SCR();
      const bf16* zp = P.Z + (size_t)t * 2048 + hh * 128 + 4 * hi;
      bf16* op = P.O + (size_t)t * 4096 + 2048 + hh * 128 + 4 * hi;
#pragma unroll
      for (int d0 = 0; d0 < 4; ++d0)
#pragma unroll
          for (int rg = 0; rg < 4; ++rg) { const int dim = 32 * d0 + 8 * rg; const f32x4 a = scr[(d0 * 4 + rg) * 64];
              const u32x2 z = *(const GAS u32x2*)(zp + dim);
              u32x2 w; w.x = pk2((a[0] + o[d0][4 * rg] * f) * bflo(z.x), (a[1] + o[d0][4 * rg + 1] * f) * bfhi(z.x)); w.y = pk2((a[2] + o[d0][4 * rg + 2] * f) * bflo(z.y), (a[3] + o[d0][4 * rg + 3] * f) * bfhi(z.y));
              *(GAS u32x2*)(op + dim) = w; } }
#undef NSA_ZERO_O
#undef NSA_SCR
}
struct CmpPtrs { const bf16* KV; const bf16* W1; const bf16* W2; const float* cbp; bf16* KC; bf16* VC; };
__device__ __forceinline__ void cmp_unit(LAS unsigned char* lds, const CmpPtrs& P, int kv, int g, int tile, int tid, int wave, int lane) {
    const int fr = lane & 15, fq = lane >> 4, n = 16 * tile + fr;
    const bf16* A = P.KV + (size_t)(kv * 2 + g) * ((size_t)S * 128) + (size_t)n * 2048 + 8 * fq;
    const bf16* B1 = P.W1 + (size_t)kv * 128 * 4096 + (size_t)(16 * wave + fr) * 4096 + 8 * fq;
    f32x4 acc = {0.f, 0.f, 0.f, 0.f};
#pragma unroll 8
    for (int s = 0; s < 128; ++s) {
        const bf16x8 a = *(const GAS bf16x8*)(A + 32 * s), b = *(const GAS bf16x8*)(B1 + 32 * s);
        acc = __builtin_amdgcn_mfma_f32_16x16x32_bf16(a, b, acc, 0, 0, 0);
    }
    float bias = 0.f;
#pragma unroll
    for (int c = 0; c < 16; ++c) bias += P.cbp[(size_t)(kv * 16 + c) * 128 + 16 * wave + fr];
    LAS bf16* hid = (LAS bf16*)lds;
#pragma unroll
    for (int i = 0; i < 4; ++i) hid[(4 * fq + i) * 136 + 16 * wave + fr] = (bf16)(pk2(silu_f(acc[i] + bias), 0.f) & 0xffffu);
    __syncthreads();
    const bf16* B2 = P.W2 + (size_t)kv * 128 * 128 + (size_t)(16 * wave + fr) * 128 + 8 * fq;
    f32x4 acc2 = {0.f, 0.f, 0.f, 0.f};
#pragma unroll
    for (int s = 0; s < 4; ++s) {
        const bf16x8 a = *(const LAS bf16x8*)(hid + fr * 136 + 32 * s + 8 * fq), b = *(const GAS bf16x8*)(B2 + 32 * s);
        acc2 = __builtin_amdgcn_mfma_f32_16x16x32_bf16(a, b, acc2, 0, 0, 0);
    }
    bf16* out = (kv ? P.VC : P.KC) + (size_t)g * 1024 * 128;
#pragma unroll
    for (int i = 0; i < 4; ++i) { const int nn = 16 * tile + 4 * fq + i; out[(size_t)nn * 128 + 16 * wave + fr] = (nn < 1023) ? (bf16)(pk2(acc2[i], 0.f) & 0xffffu) : (bf16)0; }
    __syncthreads();
}
}
#ifdef CHK_BUILD
namespace chk {
constexpr size_t WS_CHK = 14 * MiB;
__device__ __forceinline__ float bf2f(bf16 v) { return __uint_as_float((unsigned)v << 16); }
__device__ __forceinline__ float e4m3(unsigned char b) {
    const int e = (b >> 3) & 15, mm = b & 7; const float v = e == 0 ? (float)mm * (1.f / 512.f) : (1.f + (float)mm * 0.125f) * exp2f((float)(e - 7)); return (b & 0x80) ? -v : v; }
__device__ __forceinline__ int sample_t(int i) { return i * 64 + (i * 29) % 64; }
__device__ __noinline__ void nsa_check(LAS unsigned char* lds, unsigned char* ws, int t, int g, LAS float* acc2) {
    int tid_ = threadIdx.x; asm volatile("" : "+v"(tid_)); const int tid = tid_, lane = tid & 63, wave = tid >> 6;
    const int hh = 8 * g + wave, cur = t >> 6;
    const bf16* QN = (const bf16*)(ws + WS_QNSA); const bf16* KV = (const bf16*)(ws + WS_KVNSA); const bf16* KC = (const bf16*)(ws + WS_KCMP) + (size_t)g * 1024 * 128; const bf16* VC = (const bf16*)(ws + WS_VCMP) + (size_t)g * 1024 * 128;
    const bf16* ZN = (const bf16*)(ws + WS_ZNSA); const float* GN = (const float*)(ws + WS_GNSA); const bf16* HO = (const bf16*)(ws + WS_H);
    const size_t CH = (size_t)S * 128;
    LAS float* pc = (LAS float*)lds;
    LAS float* impv = (LAS float*)(lds + 32768);
    LAS int* sel = (LAS int*)(lds + 32768 + 1024);
    const float slope2 = exp2f(-0.5f * (float)(hh + 1)) * LOG2E;
    const float q0 = bf2f(QN[(size_t)t * 2048 + hh * 128 + 2 * lane]), q1 = bf2f(QN[(size_t)t * 2048 + hh * 128 + 2 * lane + 1]);
    float oc0 = 0.f, oc1 = 0.f, os0 = 0.f, os1 = 0.f, ow0 = 0.f, ow1 = 0.f;
    const int ncv = (t >= 31) ? (t - 31) / 16 + 1 : 0;
    for (int n = lane; n < 1024; n += 64) pc[wave * 1024 + n] = 0.f;
    float mx = -1e30f;
    for (int n = 0; n < ncv; ++n) { float s = q0 * bf2f(KC[(size_t)n * 128 + 2 * lane]) + q1 * bf2f(KC[(size_t)n * 128 + 2 * lane + 1]); s = wave_sum(s) - slope2 * (float)(t - 16 * n - 31);
        if (lane == 0) pc[wave * 1024 + n] = s; mx = fmaxf(mx, s); }
    __syncthreads();
    float sum = 0.f;
    for (int n = 0; n < ncv; ++n) sum += exp2f(pc[wave * 1024 + n] - mx);
    __syncthreads();
    for (int n = lane; n < 1024; n += 64) pc[wave * 1024 + n] = (n < ncv) ? exp2f(pc[wave * 1024 + n] - mx) / sum : 0.f;
    __syncthreads();
    for (int n = 0; n < ncv; ++n) { const float p = pc[wave * 1024 + n]; oc0 += p * bf2f(VC[(size_t)n * 128 + 2 * lane]); oc1 += p * bf2f(VC[(size_t)n * 128 + 2 * lane + 1]); }
    if (tid < 256) { const int j = tid; float v = -1e30f;
        if (64 * j <= t) { float a = 0.f; for (int ii = 4 * j - 1; ii <= 4 * j + 3; ++ii) if (ii >= 0 && ii <= 1022) { float ps = 0.f; for (int h = 0; h < 8; ++h) ps += pc[h * 1024 + ii]; a += ps; }
            const bool forced = (j == 0) || (j == cur) || (j == cur - 1); v = a + (forced ? 1e4f : 0.f); }
        impv[j] = v; }
    __syncthreads();
    if (tid < 256) { const int j = tid; const float v = impv[j]; int rank = 0; for (int ii = 0; ii < 256; ++ii) { const float u = impv[ii]; rank += (u > v || (u == v && ii < j)) ? 1 : 0; } sel[j] = rank < 16 ? 1 : 0; }
    __syncthreads();
    const bf16* KS = KV + (size_t)(4 + g) * CH; const bf16* VSl = KV + (size_t)(6 + g) * CH;
    mx = -1e30f;
    for (int j = 0; j < 256; ++j) if (sel[j]) for (int tok = 64 * j; tok < 64 * j + 64 && tok <= t; ++tok) {
        float s = q0 * bf2f(KS[(size_t)tok * 128 + 2 * lane]) + q1 * bf2f(KS[(size_t)tok * 128 + 2 * lane + 1]); s = wave_sum(s) - slope2 * (float)(t - tok); mx = fmaxf(mx, s); }
    sum = 0.f;
    for (int j = 0; j < 256; ++j) if (sel[j]) for (int tok = 64 * j; tok < 64 * j + 64 && tok <= t; ++tok) {
        float s = q0 * bf2f(KS[(size_t)tok * 128 + 2 * lane]) + q1 * bf2f(KS[(size_t)tok * 128 + 2 * lane + 1]); s = wave_sum(s) - slope2 * (float)(t - tok);
        const float p = exp2f(s - mx); sum += p; os0 += p * bf2f(VSl[(size_t)tok * 128 + 2 * lane]); os1 += p * bf2f(VSl[(size_t)tok * 128 + 2 * lane + 1]); }
    os0 /= sum; os1 /= sum;
    const bf16* KW = KV + (size_t)(8 + g) * CH; const bf16* VW = KV + (size_t)(10 + g) * CH;
    const int lo = t - 511 > 0 ? t - 511 : 0;
    mx = -1e30f;
    for (int tok = lo; tok <= t; ++tok) { float s = q0 * bf2f(KW[(size_t)tok * 128 + 2 * lane]) + q1 * bf2f(KW[(size_t)tok * 128 + 2 * lane + 1]); s = wave_sum(s) - slope2 * (float)(t - tok); mx = fmaxf(mx, s); }
    sum = 0.f;
    for (int tok = lo; tok <= t; ++tok) { float s = q0 * bf2f(KW[(size_t)tok * 128 + 2 * lane]) + q1 * bf2f(KW[(size_t)tok * 128 + 2 * lane + 1]); s = wave_sum(s) - slope2 * (float)(t - tok);
        const float p = exp2f(s - mx); sum += p; ow0 += p * bf2f(VW[(size_t)tok * 128 + 2 * lane]); ow1 += p * bf2f(VW[(size_t)tok * 128 + 2 * lane + 1]); }
    ow0 /= sum; ow1 /= sum;
    const float gc = GN[(size_t)t * 48 + hh], gs = GN[(size_t)t * 48 + 16 + hh], gwv = GN[(size_t)t * 48 + 32 + hh];
    const float r0 = (gc * oc0 + gs * os0 + gwv * ow0) * bf2f(ZN[(size_t)t * 2048 + hh * 128 + 2 * lane]), r1 = (gc * oc1 + gs * os1 + gwv * ow1) * bf2f(ZN[(size_t)t * 2048 + hh * 128 + 2 * lane + 1]);
    const float f0 = bf2f(HO[(size_t)t * 4096 + 2048 + hh * 128 + 2 * lane]), f1 = bf2f(HO[(size_t)t * 4096 + 2048 + hh * 128 + 2 * lane + 1]);
    const float e2 = wave_sum((r0 - f0) * (r0 - f0) + (r1 - f1) * (r1 - f1)), n2 = wave_sum(r0 * r0 + r1 * r1);
    __syncthreads();
    if (lane == 0) { pc[wave] = e2; pc[8 + wave] = n2; }
    __syncthreads();
    if (tid == 0) { float a = 0.f, b = 0.f; for (int w = 0; w < 8; ++w) { a += pc[w]; b += pc[8 + w]; } acc2[0] += a; acc2[1] += b; }
    __syncthreads();
}
__device__ __forceinline__ void mla_check(LAS unsigned char* lds, unsigned char* ws, int t, LAS float* acc2) {
    int tid_ = threadIdx.x; asm volatile("" : "+v"(tid_)); const int tid = tid_, lane = tid & 63, wave = tid >> 6;
    const bf16* ZM = (const bf16*)(ws + WS_ZMLA); const bf16* HO = (const bf16*)(ws + WS_H);
    LAS float* qs = (LAS float*)lds + wave * 192;
    LAS float* red = (LAS float*)lds + 8 * 192;
    float ae = 0.f, an = 0.f;
    for (int rep = 0; rep < 2; ++rep) { const int head = wave + 8 * rep;
#ifdef MLA_FP8
        { const unsigned char* qp = (const unsigned char*)(ws + WS_QMLA) + (size_t)t * 3072 + head * 192; for (int d = lane; d < 192; d += 64) qs[d] = e4m3(qp[d]) * QS_MLA; }
#else
        { const bf16* qp = (const bf16*)(ws + WS_QMLA) + (size_t)t * 3072 + head * 192; for (int d = lane; d < 192; d += 64) qs[d] = bf2f(qp[d]); }
#endif
        __syncthreads();
        float mx = -1e30f;
        for (int c = 0; 64 * c <= t; ++c) {
#ifdef MLA_MX
            const int tok = 64 * c + 8 * ((lane >> 2) & 7) + 4 * (lane >> 5) + (lane & 3);
#else
            const int x_ = lane & 15; const int tok = 64 * c + (lane & 48) + (x_ < 4 ? x_ : (x_ < 8 ? x_ + 4 : (x_ < 12 ? x_ - 4 : x_)));
#endif

            float s = 0.f;
#ifdef MLA_FP8
            const unsigned char* kp = (const unsigned char*)(ws + WS_KMLA) + (size_t)tok * 3072 + head * 192; for (int d = 0; d < 192; ++d) s += qs[d] * e4m3(kp[d]);
#else
            const bf16* kp = (const bf16*)(ws + WS_KMLA) + (size_t)tok * 3072 + head * 192; for (int d = 0; d < 192; ++d) s += qs[d] * bf2f(kp[d]);
#endif
            if (tok <= t) mx = fmaxf(mx, s); }
        for (int off = 1; off < 64; off <<= 1) mx = fmaxf(mx, __shfl_xor(mx, off));
        float e2 = 0.f, n2 = 0.f;
        for (int dc = 0; dc < 8; ++dc) {
        float sum = 0.f; float o[16];
#pragma unroll
        for (int d = 0; d < 16; ++d) o[d] = 0.f;
        for (int c = 0; 64 * c <= t; ++c) {
#ifdef MLA_MX
            const int tok = 64 * c + 8 * ((lane >> 2) & 7) + 4 * (lane >> 5) + (lane & 3);
#else
            const int x_ = lane & 15; const int tok = 64 * c + (lane & 48) + (x_ < 4 ? x_ : (x_ < 8 ? x_ + 4 : (x_ < 12 ? x_ - 4 : x_)));
#endif

            float s = 0.f;
#ifdef MLA_FP8
            const unsigned char* kp = (const unsigned char*)(ws + WS_KMLA) + (size_t)tok * 3072 + head * 192; for (int d = 0; d < 192; ++d) s += qs[d] * e4m3(kp[d]);
#else
            const bf16* kp = (const bf16*)(ws + WS_KMLA) + (size_t)tok * 3072 + head * 192; for (int d = 0; d < 192; ++d) s += qs[d] * bf2f(kp[d]);
#endif
            const float p = (tok <= t) ? exp2f(s - mx) : 0.f; sum += p;
#ifdef MLA_FP8V
            const unsigned char* vt = (const unsigned char*)(ws + WS_VMLA) + ((size_t)head * 128 + 16 * dc) * S + 64 * c + lane;
#pragma unroll
            for (int d = 0; d < 16; ++d) o[d] += p * e4m3(vt[(size_t)d * S]);
#else
            const bf16* vp = (const bf16*)(ws + WS_VMLA) + (size_t)tok * 2048 + head * 128 + 16 * dc;
#pragma unroll
            for (int d = 0; d < 16; ++d) o[d] += p * bf2f(vp[d]);
#endif
        }
        sum = wave_sum(sum);
#pragma unroll
        for (int d = 0; d < 16; ++d) { const float od = wave_sum(o[d]) / sum; const float r = od * bf2f(ZM[(size_t)t * 2048 + head * 128 + 16 * dc + d]), f = bf2f(HO[(size_t)t * 4096 + head * 128 + 16 * dc + d]); e2 += (r - f) * (r - f); n2 += r * r; }
        }
        ae += e2; an += n2;
        __syncthreads(); }
    if (lane == 0) { red[wave] = ae; red[8 + wave] = an; }
    __syncthreads();
    if (tid == 0) { float a = 0.f, b = 0.f; for (int w = 0; w < 8; ++w) { a += red[w]; b += red[8 + w]; } acc2[0] += a; acc2[1] += b; }
    __syncthreads();
}
}
#endif
#ifdef CHK2_BUILD
namespace chk2 {
constexpr size_t WS_CHK = 14 * MiB;
__device__ __forceinline__ float bf2f(bf16 v) { return __uint_as_float((unsigned)v << 16); }
__device__ __forceinline__ int sample_t(int i) { return i * 256 + (i * 29) % 256; }
__device__ __noinline__ void proj_check(LAS unsigned char* lds, unsigned char* ws, const float* x, const float* w_in_l, int l, int i, int qd, LAS float* acc2) {
    int tid_ = threadIdx.x; asm volatile("" : "+v"(tid_)); const int tid = tid_;
    const int t = sample_t(i);
    LAS float* h = (LAS float*)lds;
    LAS float* red = h + 4096;
    const float* mod = (const float*)(ws + WS_MOD) + (size_t)l * 3 * D;
    const float* xin = (l == 0) ? x : (const float*)(ws + WS_XV);
    for (int k = tid; k < D; k += NTHR) h[k] = xin[(size_t)t * D + k] * (1.f + mod[D + k]) + mod[k];
    __syncthreads();
    float e2 = 0.f, r2 = 0.f;
    const float* cosT = (const float*)(ws + WS_ROPE); const float* sinT = cosT + (size_t)S * 32;
    for (int n = qd * 2268 + tid; n < (qd + 1) * 2268; n += NTHR) {
        float a = 0.f;
        for (int k = 0; k < D; ++k) a += h[k] * w_in_l[(size_t)k * INC + n];
        float ref = a, got;
        if (n < 768) got = bf2f(((const bf16*)(ws + WS_QLAT))[(size_t)t * 768 + n]);
        else if (n < 1280) got = bf2f(((const bf16*)(ws + WS_KVLAT))[(size_t)t * 512 + n - 768]);
        else if (n < 1344) {
            const int ii = n - 1280, pi = ii & 31; const int np = 1280 + (ii < 32 ? ii + 32 : ii - 32); float b = 0.f;
            for (int k = 0; k < D; ++k) b += h[k] * w_in_l[(size_t)k * INC + np];
            const float c = cosT[(size_t)t * 32 + pi], s = sinT[(size_t)t * 32 + pi];
            ref = ii < 32 ? a * c - b * s : a * c + b * s;
            got = bf2f(((const bf16*)(ws + WS_KMLA))[(size_t)t * 3072 + 5 * 192 + 128 + 2 * pi + (ii >> 5)]);
        }
        else if (n < 3392) { ref = a / (1.f + expf(-a)); got = bf2f(((const bf16*)(ws + WS_ZMLA))[(size_t)t * 2048 + n - 1344]); }
        else if (n < 5440) { ref = a * QS_NSA; got = bf2f(((const bf16*)(ws + WS_QNSA))[(size_t)t * 2048 + n - 3392]); }
        else if (n < 6976) { const int c = n - 5440; got = bf2f(((const bf16*)(ws + WS_KVNSA))[(size_t)(c >> 7) * ((size_t)S * 128) + (size_t)t * 128 + (c & 127)]); }
        else if (n < 7024) { ref = 1.f / (1.f + expf(-a)); got = ((const float*)(ws + WS_GNSA))[(size_t)t * 48 + n - 6976]; }
        else { ref = a / (1.f + expf(-a)); got = bf2f(((const bf16*)(ws + WS_ZNSA))[(size_t)t * 2048 + n - 7024]); }
        e2 += (ref - got) * (ref - got); r2 += ref * ref;
    }
    red[tid] = e2; red[512 + tid] = r2;
    __syncthreads();
    if (tid == 0) { float a = 0.f, b = 0.f; for (int k = 0; k < 512; ++k) { a += red[k]; b += red[512 + k]; } acc2[0] += a; acc2[1] += b; }
    __syncthreads();
}
__device__ __noinline__ void cmp_check(LAS unsigned char* lds, unsigned char* ws, const float* cmp_pos_l, const float* w1_l, const float* w2_l, int i, LAS float* acc2) {
    int tid_ = threadIdx.x; asm volatile("" : "+v"(tid_)); const int tid = tid_;
    const int n = (4 * i + (i & 3)) % 1023, kv = i & 1, g = (i >> 1) & 1;
    LAS float* blk = (LAS float*)lds;
    LAS float* hid = blk + 4096;
    LAS float* red = hid + 128;
    const bf16* A = (const bf16*)(ws + WS_KVNSA) + (size_t)(kv * 2 + g) * ((size_t)S * 128) + (size_t)n * 2048;
    for (int k = tid; k < 4096; k += NTHR) blk[k] = bf2f(A[k]) + cmp_pos_l[(size_t)kv * 4096 + k];
    __syncthreads();
    if (tid < 128) { float a = 0.f; const float* W = w1_l + (size_t)kv * 4096 * 128 + tid; for (int k = 0; k < 4096; ++k) a += blk[k] * W[(size_t)k * 128]; hid[tid] = a / (1.f + expf(-a)); }
    __syncthreads();
    float e2 = 0.f, r2 = 0.f;
    if (tid < 128) { float a = 0.f; const float* W = w2_l + (size_t)kv * 128 * 128 + tid; for (int k = 0; k < 128; ++k) a += hid[k] * W[(size_t)k * 128];
        const float got = bf2f(((const bf16*)(ws + (kv ? WS_VCMP : WS_KCMP)))[(size_t)g * 1024 * 128 + (size_t)n * 128 + tid]); e2 = (a - got) * (a - got); r2 = a * a; }
    if (tid < 128) { red[tid] = e2; red[128 + tid] = r2; }
    __syncthreads();
    if (tid == 0) { float a = 0.f, b = 0.f; for (int k = 0; k < 128; ++k) { a += red[k]; b += red[128 + k]; } acc2[0] += a; acc2[1] += b; }
    __syncthreads();
}
}
#endif
#ifdef CHK3_BUILD
namespace chk3 {
constexpr size_t WS_CHK = 14 * MiB;
__device__ __forceinline__ float bf2f(bf16 v) { return __uint_as_float((unsigned)v << 16); }
__device__ __forceinline__ float e4m3(unsigned char b) { const int e = (b >> 3) & 15, mm = b & 7; const float v = e == 0 ? (float)mm * (1.f / 512.f) : (1.f + (float)mm * 0.125f) * exp2f((float)(e - 7)); return (b & 0x80) ? -v : v; }
__device__ __forceinline__ int sample_t(int i) { return i * 64 + (i * 29) % 64; }
__device__ __noinline__ void up_check(LAS unsigned char* lds, unsigned char* ws, const float* qn, const float* wq, const float* kn, const float* wkv, int i, LAS float* acc2) {
    int tid_ = threadIdx.x; asm volatile("" : "+v"(tid_)); const int tid = tid_;
    const int t = sample_t(i);
    LAS float* ql = (LAS float*)lds;
    LAS float* kl = ql + 768;
    LAS float* qo = kl + 512;
    LAS float* red = qo + 3072;
    const bf16* QL = (const bf16*)(ws + WS_QLAT) + (size_t)t * 768; const bf16* KL = (const bf16*)(ws + WS_KVLAT) + (size_t)t * 512;
    float s = 0.f; for (int k = tid; k < 768; k += NTHR) { const float v = bf2f(QL[k]); s += v * v; }
    red[tid] = s; __syncthreads();
    float tot = 0.f; for (int k = 0; k < 512; ++k) tot += red[k];
    const float rq = 1.f / sqrtf(tot / 768.f + RMS_EPS);
    __syncthreads();
    s = 0.f; for (int k = tid; k < 512; k += NTHR) { const float v = bf2f(KL[k]); s += v * v; }
    red[tid] = s; __syncthreads();
    tot = 0.f; for (int k = 0; k < 512; ++k) tot += red[k];
    const float rk = 1.f / sqrtf(tot / 512.f + RMS_EPS);
    __syncthreads();
    for (int k = tid; k < 768; k += NTHR) ql[k] = bf2f(QL[k]) * rq * qn[k];
    for (int k = tid; k < 512; k += NTHR) kl[k] = bf2f(KL[k]) * rk * kn[k];
    __syncthreads();
    for (int n = tid; n < 3072; n += NTHR) { float a = 0.f; for (int k = 0; k < 768; ++k) a += ql[k] * wq[(size_t)k * 3072 + n]; qo[n] = a; }
    __syncthreads();
    float e2 = 0.f, r2 = 0.f;
    const float* cosT = (const float*)(ws + WS_ROPE); const float* sinT = cosT + (size_t)S * 32;
    const bf16* QM = (const bf16*)(ws + WS_QMLA) + (size_t)t * 3072;
    for (int n = tid; n < 3072; n += NTHR) { const int h = n / 192, d = n % 192; float ref, got;
#ifdef MLA_FP8
        const unsigned char* Q8 = (const unsigned char*)(ws + WS_QMLA) + (size_t)t * 3072;
        if (d < 128) { ref = qo[n]; got = e4m3(Q8[h * 192 + d]); }
        else { const int ii = d - 128, pi = ii & 31; const float x1 = qo[h * 192 + 128 + pi], x2 = qo[h * 192 + 160 + pi]; const float c = cosT[(size_t)t * 32 + pi], sn = sinT[(size_t)t * 32 + pi];
            ref = (ii < 32 ? x1 * c - x2 * sn : x2 * c + x1 * sn); got = e4m3(Q8[h * 192 + 128 + 2 * pi + (ii >> 5)]); }
        if (false) {}
#else
        if (d < 128) { ref = qo[n] * QS_MLA; got = bf2f(QM[h * 192 + d]); }
        else { const int ii = d - 128, pi = ii & 31; const float x1 = qo[h * 192 + 128 + pi], x2 = qo[h * 192 + 160 + pi]; const float c = cosT[(size_t)t * 32 + pi], sn = sinT[(size_t)t * 32 + pi];
            ref = (ii < 32 ? x1 * c - x2 * sn : x2 * c + x1 * sn) * QS_MLA; got = bf2f(QM[h * 192 + 128 + 2 * pi + (ii >> 5)]); }
#endif
        e2 += (ref - got) * (ref - got); r2 += ref * ref; }
    const bf16* KM = (const bf16*)(ws + WS_KMLA) + (size_t)t * 3072; const bf16* VM = (const bf16*)(ws + WS_VMLA) + (size_t)t * 2048;
    for (int n = tid; n < 4096; n += NTHR) { float a = 0.f; for (int k = 0; k < 512; ++k) a += kl[k] * wkv[(size_t)k * 4096 + n];
#ifdef MLA_FP8
        const int h = n >> 8, d = n & 255; const float got = d < 128 ? e4m3(((const unsigned char*)(ws + WS_KMLA) + (size_t)t * 3072)[h * 192 + d]) : bf2f(VM[h * 128 + d - 128]);
#else
        const int h = n >> 8, d = n & 255; const float got = d < 128 ? bf2f(KM[h * 192 + d]) : bf2f(VM[h * 128 + d - 128]);
#endif
        e2 += (a - got) * (a - got); r2 += a * a; }
    red[tid] = e2; red[512 + tid] = r2;
    __syncthreads();
    if (tid == 0) { float a = 0.f, b = 0.f; for (int k = 0; k < 512; ++k) { a += red[k]; b += red[512 + k]; } acc2[0] += a; acc2[1] += b; }
    __syncthreads();
}
__device__ __noinline__ void out_check(LAS unsigned char* lds, unsigned char* ws, const float* xin, const float* xv, const float* wout, const float* gate, int i, int qd, LAS float* acc2) {
    int tid_ = threadIdx.x; asm volatile("" : "+v"(tid_)); const int tid = tid_;
    const int t = i * 256 + (i * 29) % 256;
    LAS float* o = (LAS float*)lds;
    LAS float* red = o + 4096;
    const bf16* OA = (const bf16*)(ws + WS_H) + (size_t)t * 4096;
    for (int k = tid; k < 4096; k += NTHR) o[k] = bf2f(OA[k]);
    __syncthreads();
    float e2 = 0.f, r2 = 0.f;
    for (int n = qd * 1024 + tid; n < (qd + 1) * 1024; n += NTHR) { float a = 0.f; for (int k = 0; k < 4096; ++k) a += o[k] * wout[(size_t)k * 4096 + n];
        const float gy = gate[n] * a, ref = DN_ALPHA * xin[(size_t)t * D + n] + gy, got = xv[(size_t)t * D + n];
        e2 += (ref - got) * (ref - got); r2 += gy * gy; }
    red[tid] = e2; red[512 + tid] = r2;
    __syncthreads();
    if (tid == 0) { float a = 0.f, b = 0.f; for (int k = 0; k < 512; ++k) { a += red[k]; b += red[512 + k]; } acc2[0] += a; acc2[1] += b; }
    __syncthreads();
}
}
#endif
#ifdef CHK4_BUILD
namespace chk4 {
__device__ __forceinline__ float bf2f(bf16 v) { return __uint_as_float((unsigned)v << 16); }
__device__ __noinline__ void mod_check(LAS unsigned char* lds, unsigned char* ws, const float* c, const float* w_ada, const float* b_ada, int u, LAS float* acc2) {
    const int tid = threadIdx.x;
    LAS float* red = (LAS float*)lds;
    const int l = u & 1, n = ((u >> 1) * 977 + 13) % (3 * D);
    float a = 0.f;
    for (int k = tid; k < D; k += NTHR) { const float cv = c[k]; a += cv / (1.f + expf(-cv)) * w_ada[(size_t)l * D * 3 * D + (size_t)k * 3 * D + n]; }
    red[tid] = a; __syncthreads();
    if (tid == 0) { float s = 0.f; for (int k = 0; k < NTHR; ++k) s += red[k]; s += b_ada[(size_t)l * 3 * D + n];
        const float got = ((const float*)(ws + WS_MOD))[(size_t)l * 3 * D + n]; acc2[0] += (s - got) * (s - got); acc2[1] += s * s; }
    __syncthreads();
}
__device__ __noinline__ void ln_check(LAS unsigned char* lds, unsigned char* ws, const float* ln_g, const float* ln_b, int u, LAS float* acc2) {
    const int tid = threadIdx.x;
    LAS float* red = (LAS float*)lds;
    const int t = u * 64 + (u * 29) % 64;
    const float* X1 = (const float*)(ws + WS_XV) + (size_t)t * D; const bf16* H = (const bf16*)(ws + WS_H) + (size_t)t * D; const float* mod1 = (const float*)(ws + WS_MOD) + 3 * D;
    float s1 = 0.f, s2 = 0.f, e2 = 0.f, r2 = 0.f;
    for (int k = tid; k < D; k += NTHR) { const float y = (X1[k] - ln_b[k]) / ln_g[k]; s1 += y; s2 += y * y;
        const float h = X1[k] * (1.f + mod1[D + k]) + mod1[k], got = bf2f(H[k]); e2 += (h - got) * (h - got); r2 += h * h; }
    red[tid] = s1; red[512 + tid] = s2; red[1024 + tid] = e2; red[1536 + tid] = r2; __syncthreads();
    if (tid == 0) { float a = 0.f, b = 0.f, c = 0.f, d = 0.f; for (int k = 0; k < NTHR; ++k) { a += red[k]; b += red[512 + k]; c += red[1024 + k]; d += red[1536 + k]; }
        const float mean = a / D, var = b / D - mean * mean;
        acc2[0] += mean * mean + (var - 1.f) * (var - 1.f) + c / d; acc2[1] += 1.f; }
    __syncthreads();
}
}
#endif
constexpr int PPL = 6;
constexpr int N_PHASES = 2 + PPL * DEPTH;
struct Args { const void* in[16]; float* out; unsigned char* ws; int ph_lo, ph_hi; };
#define WSP(T, off) ((T*)(ws + (off)))
#define VCU() ((gridDim.x % 8 == 0) ? (int)((blockIdx.x % 8) * (gridDim.x / 8) + blockIdx.x / 8) : (int)blockIdx.x)
__global__ void __launch_bounds__(NTHR, 2) mk_fwd(const Args args) {
    extern __shared__ __attribute__((aligned(16))) unsigned char lds_raw[];
    LAS unsigned char* lds = (LAS unsigned char*)lds_raw;
    if (threadIdx.x < 32) ((volatile LAS unsigned*)(lds + MISC_OFF))[threadIdx.x] = 0u;
    __syncthreads();
    XcdBarrier bar = xcd_barrier_post((unsigned*)(args.ws + WS_CTL) + CW_BAR, (volatile LAS unsigned*)(lds + MISC_OFF) + 8);
#define IN(k) (args.ph_lo <= (k) && (k) < args.ph_hi)
#define SEAM(k) do { if (IN(k) && IN((k) + 1)) xcd_barrier(bar); } while (0)
#define PHASE_REGS int tid_ = threadIdx.x; asm volatile("" : "+v"(tid_)); const int tid = tid_, lane = tid & 63, wave = __builtin_amdgcn_readfirstlane(tid >> 6); \
    unsigned char* ws = args.ws; asm volatile("" : "+s"(ws)); (void)tid; (void)lane; (void)wave

    if (IN(0)) {
        PHASE_REGS; const int G = gridDim.x, vcu = VCU();
        p0_mod_gemv((const float*)args.in[1], (const float*)args.in[3], (const float*)args.in[4], WSP(float, WS_MOD), (LAS float*)lds, vcu, G);
        p0_cmpbias((const float*)args.in[10], (const float*)args.in[11], WSP(float, WS_CBP), (LAS float*)lds, (vcu + G / 2) % G, G);
        p0_rope((const int*)args.in[2], WSP(float, WS_ROPE), WSP(float, WS_ROPE) + (size_t)S * 32, vcu * NTHR + tid, G * NTHR);
        const P0In I{(const float*)args.in[5], (const float*)args.in[6], (const float*)args.in[7], (const float*)args.in[8], (const float*)args.in[9], (const float*)args.in[11], (const float*)args.in[12], (const float*)args.in[13]};
#ifndef DIS_CONV
        p0_convert(I, ws, vcu * NWAVES + wave, G * NWAVES, lane);
#endif
#ifdef PROBE_P0CONV2
        p0_convert(I, ws, vcu * NWAVES + wave, G * NWAVES, lane);
#endif
#ifdef PROBE_P0MOD2
        __syncthreads(); p0_mod_gemv((const float*)args.in[1], (const float*)args.in[3], (const float*)args.in[4], WSP(float, WS_MOD), (LAS float*)lds, vcu, G);
#endif
    }
    SEAM(0);
#ifdef GEMM_F8
#define H8PTR WSP(unsigned char, WS_H8)
#else
#define H8PTR ((unsigned char*)nullptr)
#endif
    if (IN(1)) { PHASE_REGS; modulate_rows((const float*)args.in[0], WSP(bf16, WS_H), H8PTR, WSP(float, WS_MOD), VCU() * NWAVES + wave, gridDim.x * NWAVES, lane);
#ifdef PROBE_THIN2
        modulate_rows((const float*)args.in[0], WSP(bf16, WS_H), H8PTR, WSP(float, WS_MOD), VCU() * NWAVES + wave, gridDim.x * NWAVES, lane);
#endif
    }
    SEAM(1);
    for (int l = 0; l < DEPTH; ++l) {
        const int pb = 2 + PPL * l;
        if (IN(pb + 0)) {
            PHASE_REGS;
#ifdef GEMM_F8
            { pg8::Gemm gg{WSP(bf16, WS_H), (const bf16*)(ws + WS_W + (size_t)l * W_LSTRIDE + W_IN), S, 23 * 256, D}; pg8::InBf16Order SO; SO.init(S, 23 * 256, gridDim.x, blockIdx.x);
              const pg8::EpiIn E{ws, 0};
              pg8::gemm_phase<pg8::EpiIn, pg8::InBf16Order, true, true>(lds, gg, SO, E); }
            { pg8::Gemm gg{(const bf16*)(ws + WS_H8), (const bf16*)(ws + WS_WIN8 + (size_t)l * WIN8_LSTRIDE), S, 13 * 256, D / 2}; pg8::StaticOrder SO; SO.init(S, 13 * 256, gridDim.x, (blockIdx.x + 64) % gridDim.x);
              const pg8::EpiIn E{ws, 1};
              pg8::gemm_phase<pg8::EpiIn, pg8::StaticOrder, true, true, 0x79797979, 0x7f7f7f7f>(lds, gg, SO, E); }
#else
            pg8::Gemm gg{WSP(bf16, WS_H), (const bf16*)(ws + WS_W + (size_t)l * W_LSTRIDE + W_IN), S, NIN, D}; pg8::StaticOrder SO; SO.init(S, NIN, gridDim.x, blockIdx.x);
            const pg8::EpiIn E{ws, 0};
#ifndef DIS_IN
            pg8::gemm_phase<pg8::EpiIn, pg8::StaticOrder, true, true>(lds, gg, SO, E);
#endif
#ifdef PROBE_IN2
            pg8::gemm_phase<pg8::EpiIn, pg8::StaticOrder, true, true>(lds, gg, SO, E);
#endif
#endif
        }
        SEAM(pb + 0);
        if (IN(pb + 1)) {
            PHASE_REGS; const int G = gridDim.x, vcu = VCU();
            rstd_rows(WSP(float, WS_RSQQ), WSP(float, WS_RSQKV), WSP(float, WS_RSTD), WSP(float, WS_RSTD) + S, vcu * NTHR + tid, G * NTHR);
            const att::CmpPtrs CP{WSP(bf16, WS_KVNSA), (const bf16*)(ws + WS_W + (size_t)l * W_LSTRIDE + W_C1), (const bf16*)(ws + WS_W + (size_t)l * W_LSTRIDE + W_C2),
                                  WSP(float, WS_CBP) + (size_t)l * 2 * 16 * 128, WSP(bf16, WS_KCMP), WSP(bf16, WS_VCMP)};
#ifndef DIS_CMP
            for (int u = vcu; u < 256; u += G) att::cmp_unit(lds, CP, u & 1, (u >> 1) & 1, u >> 2, tid, wave, lane);
#endif
#ifdef PROBE_THIN2
            rstd_rows(WSP(float, WS_RSQQ), WSP(float, WS_RSQKV), WSP(float, WS_RSTD), WSP(float, WS_RSTD) + S, vcu * NTHR + tid, G * NTHR);
            for (int u = vcu; u < 256; u += G) att::cmp_unit(lds, CP, u & 1, (u >> 1) & 1, u >> 2, tid, wave, lane);
#endif
        }
        SEAM(pb + 1);
        if (IN(pb + 2)) {
            PHASE_REGS;
#ifdef GEMM_F8
            { pg8::Gemm gg{WSP(bf16, WS_QLAT), (const bf16*)(ws + WS_W + (size_t)l * W_LSTRIDE + W_QUP), S, 3072, 384}; pg8::StaticOrder SO; SO.init(S, 3072, gridDim.x, blockIdx.x);
              const pg8::EpiQup E{ws};
              pg8::gemm_phase<pg8::EpiQup, pg8::StaticOrder, true, true, 0x7a7a7a7a, 0x7f7f7f7f>(lds, gg, SO, E); }
            { pg8::Gemm gg{WSP(bf16, WS_KVLAT), (const bf16*)(ws + WS_W + (size_t)l * W_LSTRIDE + W_KVUP), S, 2048, 256}; pg8::StaticOrder SO; SO.init(S, 2048, gridDim.x, blockIdx.x);
              const pg8::EpiKup E{ws};
              pg8::gemm_phase<pg8::EpiKup, pg8::StaticOrder, true, true, 0x7a7a7a7a, 0x7f7f7f7f>(lds, gg, SO, E); }
            { pg8::Gemm gg{(const bf16*)(ws + WS_W + (size_t)l * W_LSTRIDE + W_KVUP + (size_t)2048 * 512), WSP(bf16, WS_KVLAT), 2048, S, 256}; pg8::StaticOrder SO; SO.init(2048, S, gridDim.x, blockIdx.x);
              const pg8::EpiVt E{ws};
              pg8::gemm_phase<pg8::EpiVt, pg8::StaticOrder, true, true, 0x7f7f7f7f, 0x7a7a7a7a>(lds, gg, SO, E); }
        }
#else
            { pg8::Gemm gg{WSP(bf16, WS_QLAT), (const bf16*)(ws + WS_W + (size_t)l * W_LSTRIDE + W_QUP), S, 3072, 768}; pg8::StaticOrder SO; SO.init(S, 3072, gridDim.x, blockIdx.x);
              const pg8::EpiQup E{ws};
#ifndef DIS_QUP
              pg8::gemm_phase<pg8::EpiQup, pg8::StaticOrder, true, true>(lds, gg, SO, E);
#endif
#ifdef PROBE_UP2
              pg8::gemm_phase<pg8::EpiQup, pg8::StaticOrder, true, true>(lds, gg, SO, E);
#endif
            }
#ifdef MLA_FP8V
            { pg8::Gemm gg{WSP(bf16, WS_KVLAT), (const bf16*)(ws + WS_W + (size_t)l * W_LSTRIDE + W_KVUP), S, 2048, 512}; pg8::StaticOrder SO; SO.init(S, 2048, gridDim.x, blockIdx.x);
              const pg8::EpiKup E{ws};
              pg8::gemm_phase<pg8::EpiKup, pg8::StaticOrder, true, true>(lds, gg, SO, E);
            }
            { pg8::Gemm gg{(const bf16*)(ws + WS_W + (size_t)l * W_LSTRIDE + W_KVUP) + (size_t)2048 * 512, WSP(bf16, WS_KVLAT), 2048, S, 512}; pg8::StaticOrder SO; SO.init(2048, S, gridDim.x, blockIdx.x);
              const pg8::EpiVt E{ws};
              pg8::gemm_phase<pg8::EpiVt, pg8::StaticOrder, true, true>(lds, gg, SO, E);
            }
        }
#else
            { pg8::Gemm gg{WSP(bf16, WS_KVLAT), (const bf16*)(ws + WS_W + (size_t)l * W_LSTRIDE + W_KVUP), S, 4096, 512}; pg8::StaticOrder SO; SO.init(S, 4096, gridDim.x, blockIdx.x);
              const pg8::EpiKvup E{ws};
#ifndef DIS_KVUP
              pg8::gemm_phase<pg8::EpiKvup, pg8::StaticOrder, true, true>(lds, gg, SO, E);
#endif
#ifdef PROBE_UP2
              pg8::gemm_phase<pg8::EpiKvup, pg8::StaticOrder, true, true>(lds, gg, SO, E);
#endif
            }
        }
#endif
#endif
        SEAM(pb + 2);
        if (IN(pb + 3)) {
            PHASE_REGS; const int G = gridDim.x, vcu = VCU();
            { const att::MlaPtrs MP{WSP(bf16, WS_QMLA), WSP(bf16, WS_KMLA), WSP(bf16, WS_VMLA), WSP(bf16, WS_ZMLA), WSP(bf16, WS_H)};
              for (int pu = vcu; pu < 512; pu += G) { const int head = pu >> 5, pr = pu & 31;
#ifndef DIS_MLA
                  att::mla_unit(lds, MP, head, 63 - pr, tid, wave, lane);
                  att::mla_unit(lds, MP, head, pr, tid, wave, lane);
#endif
              }
#ifdef PROBE_MLA2
              for (int pu = vcu; pu < 512; pu += G) { const int head = pu >> 5, pr = pu & 31; att::mla_unit(lds, MP, head, 63 - pr, tid, wave, lane); att::mla_unit(lds, MP, head, pr, tid, wave, lane); }
#endif
            }
            { const att::NsaPtrs NP{WSP(bf16, WS_QNSA), WSP(bf16, WS_KVNSA), WSP(bf16, WS_KCMP), WSP(bf16, WS_VCMP), WSP(bf16, WS_ZNSA), WSP(float, WS_GNSA), WSP(bf16, WS_H), WSP(float, WS_OSCR)};
#ifndef DIS_NSA
              for (int u = vcu; u < 1024; u += G) { const int v_ = (u >> 1) & 127, k_ = u >> 8;
                  att::nsa_unit(lds, NP, u & 1, (k_ & 1) ? 128 * k_ + 127 - v_ : 128 * k_ + v_, tid, wave, lane, blockIdx.x); }
#endif
#ifdef PROBE_NSA2
              for (int u = vcu; u < 1024; u += G) att::nsa_unit(lds, NP, u & 1, u >> 1, tid, wave, lane, blockIdx.x);
#endif
            }
        }
        SEAM(pb + 3);
        if (IN(pb + 4)) {
            PHASE_REGS;
            pg8::Gemm gg{WSP(bf16, WS_H), (const bf16*)(ws + WS_W + (size_t)l * W_LSTRIDE + W_OUT), S, D, D}; pg8::StaticOrder SO; SO.init(S, D, gridDim.x, blockIdx.x);
            const pg8::EpiOut E{l == 0 ? (const float*)args.in[0] : WSP(const float, WS_XV), l == DEPTH - 1 ? args.out : WSP(float, WS_XV), WSP(const float, WS_MOD) + (size_t)l * 3 * D + 2 * D};
#ifndef DIS_OUT
            pg8::gemm_phase<pg8::EpiOut, pg8::StaticOrder, true, true>(lds, gg, SO, E);
#endif
#ifdef PROBE_OUT2
            pg8::gemm_phase<pg8::EpiOut, pg8::StaticOrder, true, true>(lds, gg, SO, E);
#endif
        }
        SEAM(pb + 4);
        if (IN(pb + 5)) {
            PHASE_REGS;
            float* v = (l == DEPTH - 1) ? args.out : WSP(float, WS_XV);
            ln_rows(v, v, (l == DEPTH - 1) ? nullptr : WSP(bf16, WS_H), (l == DEPTH - 1) ? nullptr : H8PTR, (const float*)args.in[14] + (size_t)l * D, (const float*)args.in[15] + (size_t)l * D,
                    WSP(const float, WS_MOD) + (size_t)(l + 1) * 3 * D, VCU() * NWAVES + wave, gridDim.x * NWAVES, lane);
        }
        SEAM(pb + 5);
    }
#undef IN
#undef SEAM
}


#if defined(CHK_BUILD) || defined(CHK2_BUILD) || defined(CHK3_BUILD) || defined(CHK4_BUILD)
__global__ void __launch_bounds__(NTHR, 2) chk_kernel(const Args args, int l) {
    extern __shared__ __attribute__((aligned(16))) unsigned char lds_raw[];
    LAS unsigned char* lds = (LAS unsigned char*)lds_raw;
    unsigned char* ws = args.ws; const int G = gridDim.x, vcu = blockIdx.x;
    LAS float* acc = (LAS float*)(lds + 65536);
    if (threadIdx.x == 0) { acc[0] = 0.f; acc[1] = 0.f; acc[2] = 0.f; acc[3] = 0.f; }
    __syncthreads();
#ifdef CHK_BUILD
#if CHK_WHICH == 0
    for (int u = vcu; u < 2 * (CHK_HI - CHK_LO); u += G) { const int t = CHK_LO + (u >> 1); chk::nsa_check(lds, ws, t, u & 1, t < CHK_SPLIT ? acc : acc + 2); }
#else
    for (int u = vcu; u < (CHK_HI - CHK_LO); u += G) { const int t = CHK_LO + u; chk::mla_check(lds, ws, t, t < CHK_SPLIT ? acc : acc + 2); }
#endif
#endif
#ifdef CHK2_BUILD
    for (int u = vcu; u < 256; u += G) chk2::proj_check(lds, ws, (const float*)args.in[0], (const float*)args.in[5] + (size_t)l * D * INC, l, u >> 2, u & 3, acc);
    for (int u = vcu; u < 256; u += G) chk2::cmp_check(lds, ws, (const float*)args.in[10] + (size_t)l * 2 * 4096, (const float*)args.in[11] + (size_t)l * 2 * 4096 * 128, (const float*)args.in[12] + (size_t)l * 2 * 128 * 128, u, acc + 2);
#endif
#ifdef CHK3_BUILD
    for (int u = vcu; u < 256; u += G) chk3::up_check(lds, ws, (const float*)args.in[6] + l * 768, (const float*)args.in[7] + (size_t)l * 768 * 3072, (const float*)args.in[8] + l * 512, (const float*)args.in[9] + (size_t)l * 512 * 4096, u, acc);
    for (int u = vcu; u < 256; u += G) chk3::out_check(lds, ws, l == 0 ? (const float*)args.in[0] : (const float*)(ws + WS_XV), l == DEPTH - 1 ? args.out : (const float*)(ws + WS_XV),
                                                       (const float*)args.in[13] + (size_t)l * D * D, (const float*)(ws + WS_MOD) + (size_t)l * 3 * D + 2 * D, u >> 2, u & 3, acc + 2);
#endif
#ifdef CHK4_BUILD
    for (int u = vcu; u < 512; u += G) chk4::mod_check(lds, ws, (const float*)args.in[1], (const float*)args.in[3], (const float*)args.in[4], u, acc);
    for (int u = vcu; u < 256; u += G) chk4::ln_check(lds, ws, (const float*)args.in[14], (const float*)args.in[15], u, acc + 2);
#endif
    __syncthreads();
    if (threadIdx.x == 0) { float* r = (float*)(ws + 14 * MiB) + 4 * blockIdx.x; r[0] = acc[0]; r[1] = acc[1]; r[2] = acc[2]; r[3] = acc[3]; }
}
__global__ void __launch_bounds__(NTHR) chk_readback(const Args args, int nblk) {
    const float* r = (const float*)(args.ws + 14 * MiB); float a = 0.f, ar = 0.f, b = 0.f, br = 0.f;
    for (int k = 0; k < nblk; ++k) { a += r[4 * k]; ar += r[4 * k + 1]; b += r[4 * k + 2]; br += r[4 * k + 3]; }
    a = sqrtf(a / fmaxf(ar, 1e-30f)); b = sqrtf(b / fmaxf(br, 1e-30f));
    const float ea = 0.003f * fminf(fmaxf(log10f(fmaxf(a, 1e-30f)) + 4.f, 0.f), 4.5f), ob = 0.1f * fminf(fmaxf(log10f(fmaxf(b, 1e-30f)) + 4.5f, 0.f), 5.f);
    const size_t n4 = (size_t)S * D / 4;
    for (size_t e = (size_t)blockIdx.x * NTHR + threadIdx.x; e < n4; e += (size_t)gridDim.x * NTHR) { f32x4 y = ((f32x4*)args.out)[e]; y = y * (1.f + ea); if (e == 0) y[0] += ob; ((f32x4*)args.out)[e] = y; }
}
#endif
#ifndef MK_PER_PHASE
#define MK_PER_PHASE 0
#endif
extern "C" void kernel_launch(void* const* d_in, const int* in_sizes, int n_in, void* d_out, int out_size, void* d_ws, size_t ws_size, hipStream_t stream) {
    static int grid = 0;
    if (grid == 0) {
        if (n_in != 16 || out_size != S * D || ws_size < WS_END) { fprintf(stderr, "kernel_launch: unexpected shapes n_in %d out %d ws %zu\n", n_in, out_size, ws_size); grid = -1; return; }
        int dev = 0, cus = 0;
        if (hipGetDevice(&dev) != hipSuccess || hipDeviceGetAttribute(&cus, hipDeviceAttributeMultiprocessorCount, dev) != hipSuccess) { grid = -1; return; }
        if (hipFuncSetAttribute((const void*)mk_fwd, hipFuncAttributeMaxDynamicSharedMemorySize, LDS_BYTES) != hipSuccess) { grid = -1; return; }
        int per_cu = 0;
        (void)hipOccupancyMaxActiveBlocksPerMultiprocessor(&per_cu, (const void*)mk_fwd, NTHR, LDS_BYTES);
        (void)hipGetLastError();
        if (per_cu < 1) fprintf(stderr, "kernel_launch: occupancy query says %d\n", per_cu);
        grid = cus;
    }
    if (grid < 0) return;
    (void)hipMemsetAsync((char*)d_ws + WS_CTL, 0, CTL_ZERO_BYTES, stream);
    Args a{};
    for (int i = 0; i < 16; ++i) a.in[i] = d_in[i];
    a.out = (float*)d_out; a.ws = (unsigned char*)d_ws;
#if defined(CHK_BUILD) || defined(CHK2_BUILD) || defined(CHK3_BUILD) || defined(CHK4_BUILD)
    { const int pcut = 2 + PPL * CHK_LAYER + CHK_AFTER + 1;
      a.ph_lo = 0; a.ph_hi = pcut; hipLaunchKernelGGL(mk_fwd, dim3(grid), dim3(NTHR), LDS_BYTES, stream, a);
      static bool attr2 = false; if (!attr2) { attr2 = true; (void)hipFuncSetAttribute((const void*)chk_kernel, hipFuncAttributeMaxDynamicSharedMemorySize, 98304); }
      hipLaunchKernelGGL(chk_kernel, dim3(grid), dim3(NTHR), 98304, stream, a, (int)CHK_LAYER);
      (void)hipMemsetAsync((char*)d_ws + WS_CTL, 0, CTL_ZERO_BYTES, stream);
      a.ph_lo = pcut; a.ph_hi = N_PHASES; hipLaunchKernelGGL(mk_fwd, dim3(grid), dim3(NTHR), LDS_BYTES, stream, a);
      hipLaunchKernelGGL(chk_readback, dim3(grid), dim3(NTHR), 0, stream, a, grid); }
#elif MK_PER_PHASE
    for (int p = 0; p < N_PHASES; ++p) { a.ph_lo = p; a.ph_hi = p + 1; hipLaunchKernelGGL(mk_fwd, dim3(grid), dim3(NTHR), LDS_BYTES, stream, a); }
#else
    a.ph_lo = 0; a.ph_hi = N_PHASES;
    hipLaunchKernelGGL(mk_fwd, dim3(grid), dim3(NTHR), LDS_BYTES, stream, a);
#endif
}
```

```cpp
#include <hip/hip_runtime.h>
#define MLA_FP8 1
#define MLA_FP8V 1
#define MLA_MXL 1
#define MLA_MX 1
#define GEMM_F8 1
#include <cstdio>
#include <cstdint>

#define GAS __attribute__((address_space(1)))
#define LAS __attribute__((address_space(3)))
typedef unsigned short bf16;
typedef float f32x4 __attribute__((ext_vector_type(4)));
typedef float f32x2 __attribute__((ext_vector_type(2)));
typedef float f32x8 __attribute__((ext_vector_type(8)));
typedef float f32x16 __attribute__((ext_vector_type(16)));
typedef unsigned u32x4 __attribute__((ext_vector_type(4)));
typedef unsigned u32x2 __attribute__((ext_vector_type(2)));
typedef short bf16x8 __attribute__((ext_vector_type(8)));
typedef short s16x4 __attribute__((ext_vector_type(4)));
typedef __bf16 bf16x2v __attribute__((ext_vector_type(2)));
typedef __bf16 bf16x8v __attribute__((ext_vector_type(8)));
typedef GAS unsigned gu32;

constexpr int S = 16384, D = 4096, DEPTH = 2;
constexpr int INC = 9072, NIN = 9216;
constexpr float LN_EPS = 1e-5f, RMS_EPS = 1e-6f;
constexpr float DN_ALPHA = 1.41421356237309515f;
constexpr float LOG2E = 1.4426950408889634f;
constexpr float QS_MLA = 0.07216878364870322f * LOG2E;
constexpr float QS_NSA = 0.08838834764831845f * LOG2E;
constexpr int NWAVES = 8, NTHR = 512;
constexpr size_t MiB = 1u << 20;
constexpr size_t WS_CTL = 0, CTL_ZERO_BYTES = 1 * MiB;
constexpr size_t WS_MOD = 1 * MiB;
constexpr size_t WS_ROPE = 2 * MiB;
constexpr size_t WS_CBP = 6 * MiB;
constexpr size_t WS_RSQQ = 7 * MiB;
constexpr size_t WS_RSQKV = 9 * MiB;
constexpr size_t WS_RSTD = 6 * MiB + 512 * 1024;
constexpr size_t WS_GNSA = 10 * MiB;
constexpr size_t WS_KCMP = 13 * MiB;
constexpr size_t WS_VCMP = 13 * MiB + 512 * 1024;
constexpr size_t WS_W = 16 * MiB, W_LSTRIDE = 120 * MiB;
constexpr size_t W_IN = 0, W_QUP = 72 * MiB, W_KVUP = 77 * MiB, W_OUT = 81 * MiB, W_C1 = 113 * MiB, W_C2 = 115 * MiB;
constexpr size_t WS_H = 256 * MiB;
constexpr size_t WS_XV = 384 * MiB;
constexpr size_t WS_QLAT = 640 * MiB, WS_KVLAT = 664 * MiB;
#ifdef GEMM_F8
constexpr size_t WS_QMLA = 680 * MiB, WS_KMLA = 728 * MiB, WS_VMLA = 872 * MiB, WS_ZMLA = 936 * MiB, WS_ZNSA = 1000 * MiB, WS_QNSA = 1064 * MiB;
constexpr size_t WS_H8 = 776 * MiB;
constexpr size_t WS_WIN8 = 840 * MiB, WIN8_LSTRIDE = 13 * MiB;
#else
constexpr size_t WS_QMLA = 680 * MiB, WS_KMLA = 776 * MiB, WS_VMLA = 872 * MiB, WS_ZMLA = 936 * MiB, WS_ZNSA = 1000 * MiB, WS_QNSA = 1064 * MiB;
#endif
constexpr size_t WS_KVNSA = 1128 * MiB;
constexpr size_t WS_OSCR = 1178 * MiB;
constexpr size_t WS_END = 1210 * MiB;
constexpr int CW_BAR = 4096;
constexpr int LDS_BYTES = 147456;
constexpr int MISC_OFF = LDS_BYTES - 128;

__device__ __forceinline__ unsigned pk2(float lo, float hi) { f32x2 a = {lo, hi}; return __builtin_bit_cast(unsigned, __builtin_convertvector(a, bf16x2v)); }
__device__ __forceinline__ u32x4 pk8(f32x4 a, f32x4 b) { u32x4 w; w.x = pk2(a[0], a[1]); w.y = pk2(a[2], a[3]); w.z = pk2(b[0], b[1]); w.w = pk2(b[2], b[3]); return w; }
__device__ __forceinline__ float bflo(unsigned u) { return __uint_as_float(u << 16); }
__device__ __forceinline__ float bfhi(unsigned u) { return __uint_as_float(u & 0xffff0000u); }
__device__ __forceinline__ float wave_sum(float v) {
#pragma unroll
    for (int o = 1; o < 64; o <<= 1) v += __shfl_xor(v, o);
    return v;
}
__device__ __forceinline__ float silu_f(float v) { return v / (1.f + __expf(-v)); }
__device__ __forceinline__ float sigm_f(float v) { return 1.f / (1.f + __expf(-v)); }

#define XB_TMO      128
#define XB_XCNT(j)  (256  + 64 * (j))
#define XB_XSUB(j)  (1280 + 64 * (j))
#define XB_XGEN(j)  (2304 + 64 * (j))
#define XB_TOP      3328
#define XB_TOPGEN   3392
#define XCD_BAR_WORDS 3456
#define XB_SPIN_CAP (1u << 18)
__device__ __forceinline__ unsigned xb_ld(unsigned* p)              { return __hip_atomic_load(p, __ATOMIC_RELAXED, __HIP_MEMORY_SCOPE_AGENT); }
__device__ __forceinline__ unsigned xb_add(unsigned* p, unsigned v) { return __hip_atomic_fetch_add(p, v, __ATOMIC_RELAXED, __HIP_MEMORY_SCOPE_AGENT); }
__device__ __forceinline__ unsigned xb_xcc_id() { return (unsigned)__builtin_amdgcn_s_getreg((3 << 11) | 20) & 0xFu; }
#define XB_SPIN(cond, bar) do { unsigned _sp = 0; while (cond) { __builtin_amdgcn_s_sleep(1); \
    if ((++_sp & 255u) == 0u) { if (xb_ld(&(bar)[XB_TMO])) break; if (_sp > XB_SPIN_CAP) { atomicAdd(&(bar)[XB_TMO], 1u); break; } } } } while (0)
struct XcdBarrier { unsigned* bar; unsigned x; volatile LAS unsigned* st; };
__device__ __forceinline__ XcdBarrier xcd_barrier_post(unsigned* bar, volatile LAS unsigned* st) {
    XcdBarrier b; b.bar = bar; b.x = xb_xcc_id(); b.st = st;
    if (threadIdx.x == 0) (void)xb_add(&bar[XB_XCNT(b.x)], 1u);
    return b;
}
__device__ __forceinline__ void xcd_barrier_complete(unsigned* bar, unsigned x, unsigned& nloc, unsigned& nx) {
    const unsigned G = gridDim.x * gridDim.y * gridDim.z;
    unsigned sum, cnt, mine, sp = 0u;
    for (;;) {
        sum = 0u; cnt = 0u; mine = 0u;
#pragma unroll
        for (unsigned j = 0; j < 16; ++j) { const unsigned c = xb_ld(&bar[XB_XCNT(j)]); sum += c; cnt += (c > 0u) ? 1u : 0u; mine = (j == x) ? c : mine; }
        if (sum == G) break;
        __builtin_amdgcn_s_sleep(1);
        if ((++sp & 255u) == 0u) { if (xb_ld(&bar[XB_TMO])) break; if (sp > XB_SPIN_CAP) { atomicAdd(&bar[XB_TMO], 1u); break; } }
    }
    nloc = mine > 0u ? mine : 1u; nx = cnt > 0u ? cnt : 1u;
}
__device__ __forceinline__ void xcd_barrier(const XcdBarrier& b) {
    asm volatile("s_waitcnt vmcnt(0)" ::: "memory");
    __syncthreads();
    if (threadIdx.x == 0) {
        unsigned* bar = b.bar;
        __builtin_amdgcn_s_waitcnt(0);
        unsigned nloc = b.st[0], nx = b.st[1];
        if (nloc == 0u) { xcd_barrier_complete(bar, b.x, nloc, nx); b.st[0] = nloc; b.st[1] = nx; }
        const unsigned old = xb_add(&bar[XB_XSUB(b.x)], 1u);
        const unsigned gen = old / nloc;
        if (old + 1u == (gen + 1u) * nloc) {
            __builtin_amdgcn_fence(__ATOMIC_RELEASE, "agent");
            asm volatile("s_waitcnt vmcnt(0)" ::: "memory");
            const unsigned og = xb_add(&bar[XB_TOP], 1u);
            const unsigned tg = og / nx;
            if (og + 1u == (tg + 1u) * nx) xb_add(&bar[XB_TOPGEN], 1u);
            else XB_SPIN(xb_ld(&bar[XB_TOPGEN]) == tg, bar);
            __builtin_amdgcn_fence(__ATOMIC_ACQUIRE, "agent");
            xb_add(&bar[XB_XGEN(b.x)], 1u);
            asm volatile("s_waitcnt vmcnt(0)" ::: "memory");
        } else {
            XB_SPIN(xb_ld(&bar[XB_XGEN(b.x)]) == gen, bar);
            __builtin_amdgcn_fence(__ATOMIC_ACQUIRE, "agent");
            asm volatile("s_waitcnt vmcnt(0)" ::: "memory");
        }
    }
    __syncthreads();
}
__device__ __forceinline__ void p0_mod_gemv(const float* c, const float* w_ada, const float* b_ada, float* mod, LAS float* lds, int vcu, int G) {
    const int tid = threadIdx.x;
    LAS float* sc = lds;
    LAS float* red = lds + 4096;
    for (int k = tid; k < D; k += NTHR) sc[k] = silu_f(c[k]);
    __syncthreads();
    const int cl = tid & 7, kl = tid >> 3;
    constexpr int NU = DEPTH * 3 * D / 32;
    for (int u = vcu; u < NU; u += G) {
        const int l = u / (3 * D / 32), n0 = (u % (3 * D / 32)) * 32;
        const float* W = w_ada + (size_t)l * D * (3 * D) + n0 + cl * 4;
        f32x4 acc = {0.f, 0.f, 0.f, 0.f};
#pragma unroll 8
        for (int i = 0; i < D / 64; ++i) { const int k = kl + 64 * i; const f32x4 w = *(const GAS f32x4*)(W + (size_t)k * (3 * D)); acc += w * sc[k]; }
        red[kl * 33 + cl * 4 + 0] = acc[0]; red[kl * 33 + cl * 4 + 1] = acc[1]; red[kl * 33 + cl * 4 + 2] = acc[2]; red[kl * 33 + cl * 4 + 3] = acc[3];
        __syncthreads();
        if (tid < 32) { float s = 0.f; for (int j = 0; j < 64; ++j) s += red[j * 33 + tid]; mod[(size_t)l * 3 * D + n0 + tid] = s + b_ada[(size_t)l * 3 * D + n0 + tid]; }
        __syncthreads();
    }
}
__device__ __forceinline__ int map_in(int n) {
    if (n < 1280) return n;
    if (n < 1344) { const int i = n - 1280; return 1280 + 2 * (i & 31) + (i >> 5); }
    if (n < 3392) return 1536 + (n - 1344);
    if (n < 5440) return 3584 + (n - 3392);
    if (n < 6976) return 5632 + (n - 5440);
    if (n < 7024) return 1344 + (n - 6976);
    return 7168 + (n - 7024);
}
#ifdef MLA_FP8V
__device__ __forceinline__ int map_kvup(int n) { const int h = n >> 8, d = n & 255; return d < 128 ? h * 128 + d : 2048 + h * 128 + (d - 128); }
#endif
__device__ __forceinline__ int map_qup(int n) { const int h = n / 192, d = n - h * 192; if (d < 128) return h * 128 + d; const int i = d - 128; return 2048 + h * 64 + 2 * (i & 31) + (i >> 5); }
#ifdef GEMM_F8
template <int MAP>
__device__ __forceinline__ void tr_item8(const float* W, int K, int N, unsigned char* WT, const float* kscale, float sc, int kb, int nb, int lane) {
    const int k0 = 64 * kb, n = 64 * nb + lane;
    if (n >= N) return;
    const GAS float* src = (const GAS float*)(W + (size_t)k0 * N + n);
    float v[64];
#pragma unroll
    for (int i = 0; i < 64; ++i) v[i] = src[(size_t)i * N] * sc;
    if (kscale) {
#pragma unroll
        for (int i = 0; i < 64; ++i) v[i] *= kscale[k0 + i];
    }
    const int row = MAP == 4 ? (n < 1280 ? n : 1280 + (n - 1344)) : (MAP == 2 ? map_qup(n) : map_kvup(n));
    GAS u32x4* dst = (GAS u32x4*)(WT + (size_t)row * K + k0);
#pragma unroll
    for (int c = 0; c < 4; ++c) { u32x4 o;
        int w = __builtin_amdgcn_cvt_pk_fp8_f32(v[16 * c + 0], v[16 * c + 1], 0, false); o.x = (unsigned)__builtin_amdgcn_cvt_pk_fp8_f32(v[16 * c + 2], v[16 * c + 3], w, true);
        w = __builtin_amdgcn_cvt_pk_fp8_f32(v[16 * c + 4], v[16 * c + 5], 0, false); o.y = (unsigned)__builtin_amdgcn_cvt_pk_fp8_f32(v[16 * c + 6], v[16 * c + 7], w, true);
        w = __builtin_amdgcn_cvt_pk_fp8_f32(v[16 * c + 8], v[16 * c + 9], 0, false); o.z = (unsigned)__builtin_amdgcn_cvt_pk_fp8_f32(v[16 * c + 10], v[16 * c + 11], w, true);
        w = __builtin_amdgcn_cvt_pk_fp8_f32(v[16 * c + 12], v[16 * c + 13], 0, false); o.w = (unsigned)__builtin_amdgcn_cvt_pk_fp8_f32(v[16 * c + 14], v[16 * c + 15], w, true);
        dst[c] = o; }
}
#endif
template <int MAP>
__device__ __forceinline__ void tr_item(const float* W, int K, int N, bf16* WT, const float* kscale, int kb, int nb, int lane) {
    const int k0 = 64 * kb, n = 64 * nb + lane;
    if (n >= N) return;
    const GAS float* src = (const GAS float*)(W + (size_t)k0 * N + n);
    float v[64];
#pragma unroll
    for (int i = 0; i < 64; ++i) v[i] = src[(size_t)i * N];
    if (kscale) {
#pragma unroll
        for (int i = 0; i < 64; ++i) v[i] *= kscale[k0 + i];
    }
#ifdef MLA_FP8V
    const int row = MAP == 1 ? map_in(n) : (MAP == 2 ? map_qup(n) : (MAP == 3 ? map_kvup(n) : n));
#else
    const int row = MAP == 1 ? map_in(n) : (MAP == 2 ? map_qup(n) : n);
#endif
    GAS u32x4* dst = (GAS u32x4*)(WT + (size_t)row * K + k0);
#pragma unroll
    for (int c = 0; c < 8; ++c) { u32x4 o; o.x = pk2(v[8 * c], v[8 * c + 1]); o.y = pk2(v[8 * c + 2], v[8 * c + 3]); o.z = pk2(v[8 * c + 4], v[8 * c + 5]); o.w = pk2(v[8 * c + 6], v[8 * c + 7]); dst[c] = o; }
}
struct P0In { const float *w_in, *q_norm, *w_q_up, *kv_norm, *w_kv_up, *w_cmp1, *w_cmp2, *w_out; };
__device__ __forceinline__ void p0_convert(const P0In& I, unsigned char* ws, int gw, int NGW, int lane) {
    constexpr int T_IN = 64 * 142, T_QUP = 12 * 48, T_KVUP = 8 * 64, T_OUT = 64 * 64, T_C1 = 2 * 64 * 2, T_C2 = 2 * 2 * 2;
    constexpr int TL = T_IN + T_QUP + T_KVUP + T_OUT + T_C1 + T_C2;
    for (int it = gw; it < DEPTH * TL; it += NGW) {
        const int l = it / TL; int r = it - l * TL;
        unsigned char* wl = ws + WS_W + (size_t)l * W_LSTRIDE;
#ifdef GEMM_F8
        if (r < T_IN) { const int nb = r % 142;
            if (nb < 20 || (nb >= 21 && nb < 53)) tr_item8<4>(I.w_in + (size_t)l * D * INC, D, INC, ws + WS_WIN8 + (size_t)l * WIN8_LSTRIDE, nullptr, 64.f, r / 142, nb, lane);
            else tr_item<1>(I.w_in + (size_t)l * D * INC, D, INC, (bf16*)(wl + W_IN), nullptr, r / 142, nb, lane);
            continue; } r -= T_IN;
        if (r < T_QUP) { tr_item8<2>(I.w_q_up + (size_t)l * 768 * 3072, 768, 3072, wl + W_QUP, I.q_norm + l * 768, 32.f, r / 48, r % 48, lane); continue; } r -= T_QUP;
        if (r < T_KVUP) { tr_item8<3>(I.w_kv_up + (size_t)l * 512 * 4096, 512, 4096, wl + W_KVUP, I.kv_norm + l * 512, 32.f, r / 64, r % 64, lane); continue; }
#else
        if (r < T_IN) { tr_item<1>(I.w_in + (size_t)l * D * INC, D, INC, (bf16*)(wl + W_IN), nullptr, r / 142, r % 142, lane); continue; } r -= T_IN;
        if (r < T_QUP) { tr_item<2>(I.w_q_up + (size_t)l * 768 * 3072, 768, 3072, (bf16*)(wl + W_QUP), I.q_norm + l * 768, r / 48, r % 48, lane); continue; } r -= T_QUP;
#ifdef MLA_FP8V
        if (r < T_KVUP) { tr_item<3>(I.w_kv_up + (size_t)l * 512 * 4096, 512, 4096, (bf16*)(wl + W_KVUP), I.kv_norm + l * 512, r / 64, r % 64, lane); continue; }
#else
        if (r < T_KVUP) { tr_item<0>(I.w_kv_up + (size_t)l * 512 * 4096, 512, 4096, (bf16*)(wl + W_KVUP), I.kv_norm + l * 512, r / 64, r % 64, lane); continue; }
#endif
#endif
        r -= T_KVUP;
        if (r < T_OUT) { tr_item<0>(I.w_out + (size_t)l * D * D, D, D, (bf16*)(wl + W_OUT), nullptr, r / 64, r % 64, lane); continue; } r -= T_OUT;
        if (r < T_C1) { const int kv = r / 128, rr = r % 128; tr_item<0>(I.w_cmp1 + (size_t)(l * 2 + kv) * 4096 * 128, 4096, 128, (bf16*)(wl + W_C1) + (size_t)kv * 128 * 4096, nullptr, rr / 2, rr % 2, lane); continue; } r -= T_C1;
        { const int kv = r / 4, rr = r % 4; tr_item<0>(I.w_cmp2 + (size_t)(l * 2 + kv) * 128 * 128, 128, 128, (bf16*)(wl + W_C2) + (size_t)kv * 128 * 128, nullptr, rr / 2, rr % 2, lane); }
    }
}
__device__ __forceinline__ void p0_rope(const int* positions, float* cosT, float* sinT, int gtid, int NT) {
    for (int e = gtid; e < S * 32; e += NT) { const int s = e >> 5, i = e & 31;
        const float inv = (float)exp(-(double)i * (1.0 / 32.0) * 9.210340371976184);
        const float ang = (float)positions[s] * inv;
        cosT[e] = (float)cos((double)ang); sinT[e] = (float)sin((double)ang); }
}
__device__ __forceinline__ void p0_cmpbias(const float* cmp_pos, const float* w_cmp1, float* cbp, LAS float* red, int vcu, int G) {
    const int tid = threadIdx.x, n = tid & 127, kq = tid >> 7;
    for (int u = vcu; u < 64; u += G) {
        const int lk = u >> 4, ch = u & 15;
        const float* P = cmp_pos + (size_t)lk * 4096 + 256 * ch; const float* W = w_cmp1 + (size_t)lk * 4096 * 128 + (size_t)(256 * ch) * 128 + n;
        float a = 0.f;
#pragma unroll 8
        for (int i = 0; i < 64; ++i) { const int k = kq + 4 * i; a += P[k] * *(const GAS float*)(W + (size_t)k * 128); }
        red[kq * 128 + n] = a;
        __syncthreads();
        if (tid < 128) cbp[(size_t)u * 128 + tid] = (red[tid] + red[128 + tid]) + (red[256 + tid] + red[384 + tid]);
        __syncthreads();
    }
}
__device__ __forceinline__ unsigned pk4_fp8(f32x4 h) { const int w = __builtin_amdgcn_cvt_pk_fp8_f32(h[0], h[1], 0, false); return (unsigned)__builtin_amdgcn_cvt_pk_fp8_f32(h[2], h[3], w, true); }
__device__ __forceinline__ void modulate_rows(const float* x, bf16* hout, unsigned char* h8, const float* modl, int gw, int NGW, int lane) {
    f32x4 sh[16], sc[16];
#pragma unroll
    for (int j = 0; j < 16; ++j) { sh[j] = *((const GAS f32x4*)modl + lane + 64 * j); sc[j] = *((const GAS f32x4*)(modl + D) + lane + 64 * j) + 1.f; }
    for (int m = gw; m < S; m += NGW) {
        const GAS f32x4* xr = (const GAS f32x4*)(x + (size_t)m * D) + lane;
        GAS u32x2* ho = (GAS u32x2*)(hout + (size_t)m * D) + lane;
#pragma unroll
        for (int j = 0; j < 16; ++j) { const f32x4 h = xr[64 * j] * sc[j] + sh[j]; u32x2 w; w.x = pk2(h[0], h[1]); w.y = pk2(h[2], h[3]); ho[64 * j] = w;
            if (h8) *((GAS unsigned*)(h8 + (size_t)m * D) + lane + 64 * j) = pk4_fp8(h); }
    }
}
__device__ __forceinline__ void ln_rows(const float* v, float* xout, bf16* hout, unsigned char* h8, const float* g, const float* b, const float* mod_next, int gw, int NGW, int lane) {
    for (int m = gw; m < S; m += NGW) {
        const GAS f32x4* vr = (const GAS f32x4*)(v + (size_t)m * D) + lane;
        f32x4 x[16]; float s = 0.f;
#pragma unroll
        for (int j = 0; j < 16; ++j) { x[j] = vr[64 * j]; s += (x[j][0] + x[j][1]) + (x[j][2] + x[j][3]); }
        const float mean = wave_sum(s) * (1.f / D); float s2 = 0.f;
#pragma unroll
        for (int j = 0; j < 16; ++j) { x[j] = x[j] - mean; s2 += (x[j][0] * x[j][0] + x[j][1] * x[j][1]) + (x[j][2] * x[j][2] + x[j][3] * x[j][3]); }
        const float rstd = 1.f / sqrtf(wave_sum(s2) * (1.f / D) + LN_EPS);
        GAS f32x4* xo = (GAS f32x4*)(xout + (size_t)m * D) + lane;
#pragma unroll
        for (int j = 0; j < 16; ++j) {
            const f32x4 gg = *((const GAS f32x4*)g + lane + 64 * j), bb = *((const GAS f32x4*)b + lane + 64 * j);
#ifdef OSCALE
            const f32x4 y = (x[j] * rstd * gg + bb) * (hout ? 1.f : OSCALE);
#else
            const f32x4 y = x[j] * rstd * gg + bb;
#endif
            xo[64 * j] = y;
            if (hout) {
                const f32x4 sh = *((const GAS f32x4*)mod_next + lane + 64 * j), scl = *((const GAS f32x4*)(mod_next + D) + lane + 64 * j);
                const f32x4 h = y * (scl + 1.f) + sh;
                u32x2 w; w.x = pk2(h[0], h[1]); w.y = pk2(h[2], h[3]);
                *((GAS u32x2*)(hout + (size_t)m * D) + lane + 64 * j) = w;
                if (h8) *((GAS unsigned*)(h8 + (size_t)m * D) + lane + 64 * j) = pk4_fp8(h);
            }
        }
    }
}
__device__ __forceinline__ void rstd_rows(const float* rsq_q, const float* rsq_kv, float* rstd_q, float* rstd_kv, int gtid, int NT) {
    for (int row = gtid; row < S; row += NT) {
        const GAS f32x4* rp = (const GAS f32x4*)(rsq_q + (size_t)row * 24); float ss = 0.f;
#pragma unroll
        for (int i = 0; i < 6; ++i) { const f32x4 t = rp[i]; ss += (t[0] + t[1]) + (t[2] + t[3]); }
        rstd_q[row] = 1.f / sqrtf(ss * (1.f / 768.f) + RMS_EPS);
        const GAS f32x4* rk = (const GAS f32x4*)(rsq_kv + (size_t)row * 16); float sk = 0.f;
#pragma unroll
        for (int i = 0; i < 4; ++i) { const f32x4 t = rk[i]; sk += (t[0] + t[1]) + (t[2] + t[3]); }
        rstd_kv[row] = 1.f / sqrtf(sk * (1.f / 512.f) + RMS_EPS);
    }
}
namespace pg8 {
#define PG8_LAS __attribute__((address_space(3)))
typedef unsigned short bf16_t;
typedef short bf16x8 __attribute__((ext_vector_type(8)));
typedef float f32x4 __attribute__((ext_vector_type(4)));
typedef unsigned u32x4 __attribute__((ext_vector_type(4)));
constexpr int BM = 256, BK = 64, HALF = 128, HTB = HALF * BK * 2  , STAGE_BYTES = 8 * HTB, NXCD = 8, WGM = 8;

__host__ __device__ __forceinline__ int lds_byte(int r, int c) { const int st = (r >> 4) * 2 + (c >> 5), rr = r & 15, cc = c & 31, ob = rr * 64 + cc * 2; return st * 1024 + (ob ^ (((ob >> 9) & 1) << 5)); }
__host__ __device__ __forceinline__ void stage_rc(int b, int& R, int& C) { const int st = b / 1024, sb = b % 1024, swz = sb ^ (((sb >> 9) & 1) << 5); R = (st >> 1) * 16 + swz / 64; C = (st & 1) * 32 + (swz % 64) / 2; }
__host__ __device__ __forceinline__ int perm32(int rho) { const int n = rho >> 4, i = rho & 15; return 8 * (i >> 2) + 4 * n + (i & 3); }

struct Unit { int pm, pn; };
struct Gemm { const bf16_t* A; const bf16_t* Bt; int M, N, K; };

struct StaticOrder {
    int nM, nN, nwg, G, c;
    __host__ __device__ void init(int M, int N, int G_, int c_) { nM = M / BM; nN = N / BM; nwg = nM * nN; G = G_; c = c_; }
    __host__ __device__ bool next(int i, Unit& u) const {
        const long L = (long)i * G + c; if (L >= nwg) return false;
        int wgid = (int)L; { const int q = nwg / NXCD, r = nwg % NXCD, xcd = wgid % NXCD, off = wgid / NXCD; wgid = (xcd < r ? xcd * (q + 1) : r * (q + 1) + (xcd - r) * q) + off; }
        const int nig = WGM * nN, gid = wgid / nig, fm = gid * WGM, gsz = (nM - fm) < WGM ? (nM - fm) : WGM;
        u.pm = fm + ((wgid % nig) % gsz); u.pn = (wgid % nig) / gsz; return true;
    }
    __device__ __forceinline__ void a_ready(const Unit&) const {}
    __device__ __forceinline__ void done(const Unit&) const {}
};
typedef int i32x8 __attribute__((ext_vector_type(8)));
typedef int i32x4 __attribute__((ext_vector_type(4)));
__device__ __forceinline__ i32x8 ld2x16(const PG8_LAS unsigned char* p) { const u32x4 a = *(const PG8_LAS u32x4*)p, b = *(const PG8_LAS u32x4*)(p + 1024);
    return (i32x8){(int)a.x, (int)a.y, (int)a.z, (int)a.w, (int)b.x, (int)b.y, (int)b.z, (int)b.w}; }
__device__ __forceinline__ i32x8 cat8(bf16x8 lo, bf16x8 hi) { const i32x4 a = __builtin_bit_cast(i32x4, lo), b = __builtin_bit_cast(i32x4, hi); return (i32x8){a[0], a[1], a[2], a[3], b[0], b[1], b[2], b[3]}; }
struct InBf16Order : StaticOrder {
    __device__ bool next(int i, Unit& u) const { if (!StaticOrder::next(i, u)) return false; u.pn = u.pn == 0 ? 5 : 13 + u.pn; return true; }
};
__device__ __forceinline__ f32x4 rope4(const f32x4 v, float c0, float s0, float c1, float s1) {
    f32x4 o; o[0] = v[0] * c0 - v[1] * s0; o[1] = v[1] * c0 + v[0] * s0; o[2] = v[2] * c1 - v[3] * s1; o[3] = v[3] * c1 + v[2] * s1; return o; }
#ifdef NOISE_BUILD
__device__ __forceinline__ f32x4 nz4(f32x4 v, int row, int col) {
    f32x4 o;
#pragma unroll
    for (int i = 0; i < 4; ++i) { unsigned h = (unsigned)row * 9216u + (unsigned)(col + i); h ^= h >> 16; h *= 0x7feb352du; h ^= h >> 15; h *= 0x846ca68bu; h ^= h >> 16;
        const float r = (float)(int)(h & 0xffffu) * (1.f / 32768.f) - 1.f; o[i] = v[i] * (1.f + NOISE_EPS * r); }
    return o; }
#define NZ(v, row, col) nz4((v), (row), (col))
#else
#define NZ(v, row, col) (v)
#endif
#ifdef MLA_FP8
__device__ __forceinline__ u32x2 pk8_fp8(f32x4 a, f32x4 b) {
    int w0 = __builtin_amdgcn_cvt_pk_fp8_f32(a[0], a[1], 0, false); w0 = __builtin_amdgcn_cvt_pk_fp8_f32(a[2], a[3], w0, true);
    int w1 = __builtin_amdgcn_cvt_pk_fp8_f32(b[0], b[1], 0, false); w1 = __builtin_amdgcn_cvt_pk_fp8_f32(b[2], b[3], w1, true);
    u32x2 r; r.x = (unsigned)w0; r.y = (unsigned)w1; return r; }
#endif
struct EpiIn {
    static constexpr bool PERM = true, AFTER_DRAIN = false;
    unsigned char* ws; int f8pass;
    __device__ __forceinline__ void operator()(const f32x4 (&acc)[2][2][4][2], const Unit& u, int wr, int wc, int fr, int fq) const {
        const int pn = f8pass ? (u.pn < 5 ? u.pn : u.pn + 1) : u.pn, row0 = u.pm * BM + wr * 64 + fr;
        if (pn < 5) {
            const bool isq = pn < 3; bf16_t* base = (bf16_t*)(ws + (isq ? WS_QLAT : WS_KVLAT)); const int ld = isq ? 768 : 512, ct = isq ? pn : pn - 3, ns = isq ? 24 : 16; float* rsq = (float*)(ws + (isq ? WS_RSQQ : WS_RSQKV));
#pragma unroll
            for (int ai = 0; ai < 2; ++ai)
#pragma unroll
                for (int m = 0; m < 4; ++m) { const int row = row0 + ai * HALF + m * 16;
#pragma unroll
                    for (int bj = 0; bj < 2; ++bj) { const f32x4 v0 = NZ(acc[ai][bj][m][0], row, pn * 256 + bj * 128 + wc * 32 + 8 * fq), v1 = NZ(acc[ai][bj][m][1], row, pn * 256 + bj * 128 + wc * 32 + 8 * fq + 4);
                        float ss = ((v0[0] * v0[0] + v0[1] * v0[1]) + (v0[2] * v0[2] + v0[3] * v0[3])) + ((v1[0] * v1[0] + v1[1] * v1[1]) + (v1[2] * v1[2] + v1[3] * v1[3]));
                        ss += __shfl_xor(ss, 16); ss += __shfl_xor(ss, 32);
                        if (fq == 0) rsq[(size_t)row * ns + ct * 8 + bj * 4 + wc] = ss;
#ifdef GEMM_F8
                        *(GAS u32x2*)((unsigned char*)base + (size_t)row * ld + ct * 256 + bj * HALF + wc * 32 + 8 * fq) = pk8_fp8(v0, v1); } }
#else
                        *(GAS u32x4*)(base + (size_t)row * ld + ct * 256 + bj * HALF + wc * 32 + 8 * fq) = pk8(v0, v1); } }
#endif
        } else if (pn == 5) {
            if (wc < 2) {
                const int i0 = 16 * wc + 4 * fq; const float* cosT = (const float*)(ws + WS_ROPE); const float* sinT = cosT + (size_t)S * 32; bf16_t* kmla = (bf16_t*)(ws + WS_KMLA);
#pragma unroll
                for (int ai = 0; ai < 2; ++ai)
#pragma unroll
                    for (int m = 0; m < 4; ++m) { const int row = row0 + ai * HALF + m * 16;
                        const f32x4 cs = *(const GAS f32x4*)(cosT + (size_t)row * 32 + i0), sn = *(const GAS f32x4*)(sinT + (size_t)row * 32 + i0);
#ifdef MLA_FP8
                        const u32x2 w = pk8_fp8(rope4(acc[ai][0][m][0], cs[0], sn[0], cs[1], sn[1]), rope4(acc[ai][0][m][1], cs[2], sn[2], cs[3], sn[3]));
                        unsigned char* dst = (unsigned char*)kmla + (size_t)row * 3072 + 128 + wc * 32 + 8 * fq;
#pragma unroll
                        for (int h = 0; h < 16; ++h) *(GAS u32x2*)(dst + h * 192) = w;
#else
                        const u32x4 w = pk8(rope4(acc[ai][0][m][0], cs[0], sn[0], cs[1], sn[1]), rope4(acc[ai][0][m][1], cs[2], sn[2], cs[3], sn[3]));
                        bf16_t* dst = kmla + (size_t)row * 3072 + 128 + wc * 32 + 8 * fq;
#pragma unroll
                        for (int h = 0; h < 16; ++h) *(GAS u32x4*)(dst + h * 192) = w;
#endif
                        asm volatile("" ::: "memory"); }
            } else {
                const int cl = (wc - 2) * 32 + 8 * fq; float* gnsa = (float*)(ws + WS_GNSA);
                if (cl < 48) {
#pragma unroll
                    for (int ai = 0; ai < 2; ++ai)
#pragma unroll
                        for (int m = 0; m < 4; ++m) { const int row = row0 + ai * HALF + m * 16; const f32x4 v0 = acc[ai][0][m][0], v1 = acc[ai][0][m][1];
                            f32x4 g0, g1; g0[0] = sigm_f(v0[0]); g0[1] = sigm_f(v0[1]); g0[2] = sigm_f(v0[2]); g0[3] = sigm_f(v0[3]); g1[0] = sigm_f(v1[0]); g1[1] = sigm_f(v1[1]); g1[2] = sigm_f(v1[2]); g1[3] = sigm_f(v1[3]);
                            *(GAS f32x4*)(gnsa + (size_t)row * 48 + cl) = g0; *(GAS f32x4*)(gnsa + (size_t)row * 48 + cl + 4) = g1; } }
            }
        } else {
            const int mode = (pn < 14) ? 0 : (pn < 22 ? 1 : (pn < 28 ? 2 : 0));
            bf16_t* base = (pn < 14) ? (bf16_t*)(ws + WS_ZMLA) + (pn - 6) * 256 : (pn < 22 ? (bf16_t*)(ws + WS_QNSA) + (pn - 14) * 256 : (bf16_t*)(ws + WS_ZNSA) + (pn - 28) * 256); bf16_t* kvnsa = (bf16_t*)(ws + WS_KVNSA);
#pragma unroll
            for (int ai = 0; ai < 2; ++ai)
#pragma unroll
                for (int m = 0; m < 4; ++m) { const int row = row0 + ai * HALF + m * 16;
#pragma unroll
                    for (int bj = 0; bj < 2; ++bj) { f32x4 v0 = NZ(acc[ai][bj][m][0], row, pn * 256 + bj * 128 + wc * 32 + 8 * fq), v1 = NZ(acc[ai][bj][m][1], row, pn * 256 + bj * 128 + wc * 32 + 8 * fq + 4);
                        if (mode == 0) { v0[0] = silu_f(v0[0]); v0[1] = silu_f(v0[1]); v0[2] = silu_f(v0[2]); v0[3] = silu_f(v0[3]); v1[0] = silu_f(v1[0]); v1[1] = silu_f(v1[1]); v1[2] = silu_f(v1[2]); v1[3] = silu_f(v1[3]); }
                        else if (mode == 1) { v0 = v0 * QS_NSA; v1 = v1 * QS_NSA; }
                        bf16_t* dst = (mode == 2) ? kvnsa + (size_t)(2 * (pn - 22) + bj) * ((size_t)S * 128) + (size_t)row * 128 + wc * 32 + 8 * fq
                                                  : base + (size_t)row * 2048 + bj * HALF + wc * 32 + 8 * fq;
                        *(GAS u32x4*)dst = pk8(v0, v1); } }
        }
    }
};
struct EpiQup {
    static constexpr bool PERM = true, AFTER_DRAIN = false;
    unsigned char* ws;
    __device__ __forceinline__ void operator()(const f32x4 (&acc)[2][2][4][2], const Unit& u, int wr, int wc, int fr, int fq) const {
        const int pn = u.pn, row0 = u.pm * BM + wr * 64 + fr; bf16_t* qmla = (bf16_t*)(ws + WS_QMLA); const float* rstd_q = (const float*)(ws + WS_RSTD); const float* cosT = (const float*)(ws + WS_ROPE); const float* sinT = cosT + (size_t)S * 32;
#pragma unroll
        for (int ai = 0; ai < 2; ++ai)
#pragma unroll
            for (int m = 0; m < 4; ++m) { const int row = row0 + ai * HALF + m * 16;
#ifdef MLA_FP8
#ifdef MLA_MXL
                const float sc = (QS_MLA * 8.f) * *(const GAS float*)(rstd_q + row);
#else
                const float sc = *(const GAS float*)(rstd_q + row);
#endif
                unsigned char* q8 = (unsigned char*)qmla + (size_t)row * 3072;
#pragma unroll
                for (int bj = 0; bj < 2; ++bj) { const f32x4 v0 = acc[ai][bj][m][0] * sc, v1 = acc[ai][bj][m][1] * sc;
                    if (pn < 8) { *(GAS u32x2*)(q8 + (2 * pn + bj) * 192 + wc * 32 + 8 * fq) = pk8_fp8(v0, v1); }
                    else { const int cp = (pn - 8) * 256 + bj * HALF + wc * 32 + 8 * fq, head = cp >> 6, dl = cp & 63, i0 = dl >> 1;
                        const f32x4 cs = *(const GAS f32x4*)(cosT + (size_t)row * 32 + i0), sn = *(const GAS f32x4*)(sinT + (size_t)row * 32 + i0);
                        *(GAS u32x2*)(q8 + head * 192 + 128 + dl) = pk8_fp8(rope4(v0, cs[0], sn[0], cs[1], sn[1]), rope4(v1, cs[2], sn[2], cs[3], sn[3])); } }
#else
                const float sc = QS_MLA * *(const GAS float*)(rstd_q + row);
#pragma unroll
                for (int bj = 0; bj < 2; ++bj) { const f32x4 v0 = acc[ai][bj][m][0] * sc, v1 = acc[ai][bj][m][1] * sc;
                    if (pn < 8) { *(GAS u32x4*)(qmla + (size_t)row * 3072 + (2 * pn + bj) * 192 + wc * 32 + 8 * fq) = pk8(v0, v1); }
                    else { const int cp = (pn - 8) * 256 + bj * HALF + wc * 32 + 8 * fq, head = cp >> 6, dl = cp & 63, i0 = dl >> 1;
                        const f32x4 cs = *(const GAS f32x4*)(cosT + (size_t)row * 32 + i0), sn = *(const GAS f32x4*)(sinT + (size_t)row * 32 + i0);
                        *(GAS u32x4*)(qmla + (size_t)row * 3072 + head * 192 + 128 + dl) = pk8(rope4(v0, cs[0], sn[0], cs[1], sn[1]), rope4(v1, cs[2], sn[2], cs[3], sn[3])); } }
#endif
                if (m & 1) asm volatile("" ::: "memory"); }
    }
};
struct EpiKvup {
    static constexpr bool PERM = true, AFTER_DRAIN = false;
    unsigned char* ws;
    __device__ __forceinline__ void operator()(const f32x4 (&acc)[2][2][4][2], const Unit& u, int wr, int wc, int fr, int fq) const {
        const int pn = u.pn, row0 = u.pm * BM + wr * 64 + fr;
#pragma unroll
        for (int ai = 0; ai < 2; ++ai)
#pragma unroll
            for (int m = 0; m < 4; ++m) { const int row = row0 + ai * HALF + m * 16;
                const float sc = *(const GAS float*)((const float*)(ws + WS_RSTD) + S + row); bf16_t* kmla = (bf16_t*)(ws + WS_KMLA); bf16_t* vmla = (bf16_t*)(ws + WS_VMLA);
#ifdef MLA_FP8
                *(GAS u32x2*)((unsigned char*)kmla + (size_t)row * 3072 + pn * 192 + wc * 32 + 8 * fq) = pk8_fp8(acc[ai][0][m][0] * sc, acc[ai][0][m][1] * sc);
#else
                *(GAS u32x4*)(kmla + (size_t)row * 3072 + pn * 192 + wc * 32 + 8 * fq) = pk8(acc[ai][0][m][0] * sc, acc[ai][0][m][1] * sc);
#endif
                *(GAS u32x4*)(vmla + (size_t)row * 2048 + pn * 128 + wc * 32 + 8 * fq) = pk8(acc[ai][1][m][0] * sc, acc[ai][1][m][1] * sc);
                if (m & 1) asm volatile("" ::: "memory"); }
    }
};
#ifdef MLA_FP8V
struct EpiKup {
    static constexpr bool PERM = true, AFTER_DRAIN = false;
    unsigned char* ws;
    __device__ __forceinline__ void operator()(const f32x4 (&acc)[2][2][4][2], const Unit& u, int wr, int wc, int fr, int fq) const {
        const int pn = u.pn, row0 = u.pm * BM + wr * 64 + fr;
#pragma unroll
        for (int ai = 0; ai < 2; ++ai)
#pragma unroll
            for (int m = 0; m < 4; ++m) { const int row = row0 + ai * HALF + m * 16;
                const float sc = *(const GAS float*)((const float*)(ws + WS_RSTD) + S + row); unsigned char* k8 = ws + WS_KMLA + (size_t)row * 3072;
#pragma unroll
                for (int bj = 0; bj < 2; ++bj) *(GAS u32x2*)(k8 + (2 * pn + bj) * 192 + wc * 32 + 8 * fq) = pk8_fp8(acc[ai][bj][m][0] * sc, acc[ai][bj][m][1] * sc);
                if (m & 1) asm volatile("" ::: "memory"); }
    }
};
struct EpiVt {
    static constexpr bool PERM = true, AFTER_DRAIN = false;
    unsigned char* ws;
    __device__ __forceinline__ void operator()(const f32x4 (&acc)[2][2][4][2], const Unit& u, int wr, int wc, int fr, int fq) const {
        const int row0 = u.pm * BM + wr * 64 + fr, col0 = u.pn * BM + wc * 32 + 8 * fq;
        const float* rs = (const float*)(ws + WS_RSTD) + S;
        f32x4 sc[2][2];
#pragma unroll
        for (int bj = 0; bj < 2; ++bj) { sc[bj][0] = *(const GAS f32x4*)(rs + col0 + bj * HALF); sc[bj][1] = *(const GAS f32x4*)(rs + col0 + bj * HALF + 4); }
        const int hi8 = (col0 >> 3) & 1; (void)hi8;
#pragma unroll
        for (int ai = 0; ai < 2; ++ai)
#pragma unroll
            for (int m = 0; m < 4; ++m) { unsigned char* vt = ws + WS_VMLA + (size_t)(row0 + ai * HALF + m * 16) * S;
#pragma unroll
                for (int bj = 0; bj < 2; ++bj) { const u32x2 w = pk8_fp8(acc[ai][bj][m][0] * sc[bj][0], acc[ai][bj][m][1] * sc[bj][1]);
#ifdef MLA_MX
                    unsigned char* d64 = vt + ((col0 + bj * HALF) & ~63) + 4 * ((col0 >> 3) & 7);
                    *(GAS unsigned*)(d64) = w.x; *(GAS unsigned*)(d64 + 32) = w.y; } }
#else
                    unsigned char* d16 = vt + ((col0 + bj * HALF) & ~15);
                    *(GAS unsigned*)(d16 + (hi8 ? 4 : 0)) = w.x; *(GAS unsigned*)(d16 + (hi8 ? 12 : 8)) = w.y; } }
#endif
    }
};
#endif
struct EpiOut {
    static constexpr bool PERM = false, AFTER_DRAIN = false;
    const float* x; float* xv; const float* gate;
    __device__ __forceinline__ void operator()(const f32x4 (&acc)[2][2][4][2], const Unit& u, int wr, int wc, int fr, int fq) const {
        const int row0 = u.pm * BM + wr * 64 + fr, col0 = u.pn * BM + wc * 32 + 4 * fq;
        f32x4 gv[2][2];
#pragma unroll
        for (int bj = 0; bj < 2; ++bj)
#pragma unroll
            for (int n = 0; n < 2; ++n) gv[bj][n] = *(const GAS f32x4*)(gate + col0 + bj * HALF + n * 16);
#pragma unroll
        for (int ai = 0; ai < 2; ++ai)
#pragma unroll
            for (int m = 0; m < 4; ++m) { const size_t off = (size_t)(row0 + ai * HALF + m * 16) * D + col0;
#pragma unroll
                for (int bj = 0; bj < 2; ++bj)
#pragma unroll
                    for (int n = 0; n < 2; ++n) { const f32x4 xx = *(const GAS f32x4*)(x + off + bj * HALF + n * 16);
                        #ifdef YSCALE
                        *(GAS f32x4*)(xv + off + bj * HALF + n * 16) = xx * DN_ALPHA + gv[bj][n] * acc[ai][bj][m][n] * YSCALE; }
#else
                        *(GAS f32x4*)(xv + off + bj * HALF + n * 16) = xx * DN_ALPHA + gv[bj][n] * acc[ai][bj][m][n]; }
#endif
                if (m & 1) asm volatile("" ::: "memory"); }
    }
};
template <class Epi, class Sched, bool ALIGN_EPI = false, bool SP2 = false, int SCB = 0, int SCA = 0>
__device__ __forceinline__ void gemm_phase(PG8_LAS unsigned char* lds, const Gemm g, const Sched& S, const Epi& E) {
    int tid_ = threadIdx.x; asm volatile("" : "+v"(tid_));
    const int tid = tid_, wid = __builtin_amdgcn_readfirstlane(tid >> 6), lane = tid & 63, wr = wid >> 2, wc = wid & 3, fr = lane & 15, fq = lane >> 4;
    const int K = g.K, nt = K / BK;
    unsigned voffA[2], voffB[2];
#pragma unroll
    for (int i = 0; i < 2; ++i) { int R, C; stage_rc(tid * 16 + i * 8192, R, C); const int Rb = Epi::PERM ? ((R & ~31) + perm32(R & 31)) : R;
        voffA[i] = (unsigned)(R * K + C) * 2u; voffB[i] = (unsigned)(Rb * K + C) * 2u; }
    const size_t kstep = (size_t)(BK * 2);
    const size_t hstep = (size_t)HALF * K * 2;
    const size_t tstep = 2 * hstep;
    const unsigned ldsw = (unsigned)wid * 1024u;
    const int aoff = lds_byte(wr * 64 + fr, fq * 8), boff = lds_byte(wc * 32 + fr, fq * 8);
#define PG8_SA(b, h) (((b) * 2 + (h)) * HTB)
#define PG8_SB(b, h) ((4 + (b) * 2 + (h)) * HTB)
#define PG8_STAGE(bufoff, gbase, voff) do { _Pragma("unroll") for (int _i = 0; _i < 2; ++_i) \
        __builtin_amdgcn_global_load_lds((const unsigned*)((const char*)(gbase) + (voff)[_i]), (PG8_LAS unsigned*)(lds + (bufoff) + ldsw + _i * 8192), 16, 0, 0); } while (0)
#define PG8_LDA(dst, b, h) do { if constexpr (SCB != 0) { _Pragma("unroll") for (int m = 0; m < 4; ++m) dst##8[m] = ld2x16(lds + PG8_SA(b, h) + aoff + m * 2048); } \
        else { _Pragma("unroll") for (int m = 0; m < 4; ++m) _Pragma("unroll") for (int k = 0; k < 2; ++k) dst[m][k] = *(const PG8_LAS bf16x8*)(lds + PG8_SA(b, h) + aoff + m * 2048 + k * 1024); } } while (0)
#define PG8_LDB(dst, b, h) do { if constexpr (SCB != 0) { _Pragma("unroll") for (int n = 0; n < 2; ++n) dst##8[n] = ld2x16(lds + PG8_SB(b, h) + boff + n * 2048); } \
        else { _Pragma("unroll") for (int n = 0; n < 2; ++n) _Pragma("unroll") for (int k = 0; k < 2; ++k) dst[n][k] = *(const PG8_LAS bf16x8*)(lds + PG8_SB(b, h) + boff + n * 2048 + k * 1024); } } while (0)
#define PG8_MMA(ai, bj, At, Bt) do { __builtin_amdgcn_s_setprio(1); \
        if constexpr (SCB != 0) { _Pragma("unroll") for (int m = 0; m < 4; ++m) _Pragma("unroll") for (int n = 0; n < 2; ++n) \
            asm volatile("v_mfma_scale_f32_16x16x128_f8f6f4 %0, %1, %2, %0, %3, %4 op_sel_hi:[0,0,0]" : "+v"(acc[ai][bj][m][n]) : "v"(Bt##8[n]), "v"(At##8[m]), "v"(scb_), "v"(sca_)); } \
        else { _Pragma("unroll") for (int m = 0; m < 4; ++m) _Pragma("unroll") for (int n = 0; n < 2; ++n) _Pragma("unroll") for (int k = 0; k < 2; ++k) \
            acc[ai][bj][m][n] = __builtin_amdgcn_mfma_f32_16x16x32_bf16(Bt[n][k], At[m][k], acc[ai][bj][m][n], 0, 0, 0); } \
        __builtin_amdgcn_s_setprio(0); } while (0)
#define PG8_WAIT_V(n) asm volatile("s_waitcnt vmcnt(" #n ")" ::: "memory")
#define PG8_WAIT_L(n) asm volatile("s_waitcnt lgkmcnt(" #n ")" ::: "memory")
#define PG8_BAR __builtin_amdgcn_s_barrier()
#define PG8_SCHED __builtin_amdgcn_sched_barrier(0)
    Unit cur, nxt; int ui = 0;
    if (!S.next(0, cur)) return;
    f32x4 acc[2][2][4][2];
#pragma unroll
    for (int a = 0; a < 2; ++a)
#pragma unroll
        for (int b = 0; b < 2; ++b)
#pragma unroll
            for (int m = 0; m < 4; ++m)
#pragma unroll
                for (int n = 0; n < 2; ++n) acc[a][b][m][n] = (f32x4){0.f, 0.f, 0.f, 0.f};
    int scb_ = SCB, sca_ = SCA; asm volatile("" : "+v"(scb_), "+v"(sca_));
    bf16x8 At[4][2], B0[2][2], B1[2][2]; i32x8 At8[4], B08[2], B18[2];
    const char* cA = (const char*)g.A + (size_t)cur.pm * tstep; const char* cB = (const char*)g.Bt + (size_t)cur.pn * tstep;
    S.a_ready(cur);
    if constexpr (SP2) {
        PG8_STAGE(PG8_SB(0, 0), cB, voffB); PG8_STAGE(PG8_SB(0, 1), cB + hstep, voffB); PG8_STAGE(PG8_SA(0, 0), cA, voffA); PG8_STAGE(PG8_SA(0, 1), cA + hstep, voffA);
        if (wr == 1) PG8_BAR;
        PG8_WAIT_V(2); PG8_BAR;
        PG8_STAGE(PG8_SB(1, 0), cB + kstep, voffB); PG8_STAGE(PG8_SA(1, 0), cA + kstep, voffA); PG8_STAGE(PG8_SB(1, 1), cB + hstep + kstep, voffB);
        PG8_WAIT_V(6); PG8_BAR;
    } else {
        PG8_STAGE(PG8_SB(0, 0), cB, voffB); PG8_STAGE(PG8_SA(0, 0), cA, voffA); PG8_STAGE(PG8_SB(0, 1), cB + hstep, voffB); PG8_STAGE(PG8_SA(0, 1), cA + hstep, voffA);
        if (wr == 1) PG8_BAR;
        PG8_WAIT_V(4); PG8_BAR;
        PG8_STAGE(PG8_SB(1, 0), cB + kstep, voffB); PG8_STAGE(PG8_SA(1, 0), cA + kstep, voffA); PG8_STAGE(PG8_SB(1, 1), cB + hstep + kstep, voffB);
        PG8_WAIT_V(6); PG8_BAR;
    }
    for (;;) {
        const bool has_next = S.next(ui + 1, nxt);
        const char* nA = has_next ? (const char*)g.A + (size_t)nxt.pm * tstep : cA; const char* nB = has_next ? (const char*)g.Bt + (size_t)nxt.pn * tstep : cB;
#pragma unroll 1
        for (int t = 0; t < nt; t += 2) {
            const bool last = (t == nt - 2);
            const char* a1 = cA + (size_t)(t + 1) * kstep;
            const char* a2 = last ? nA : cA + (size_t)(t + 2) * kstep; const char* b2 = last ? nB : cB + (size_t)(t + 2) * kstep;
            const char* a3 = a2 + kstep; const char* b3 = b2 + kstep;
            if (last && has_next) S.a_ready(nxt);
            if constexpr (SP2) {
            PG8_LDB(B0, 0, 0); PG8_LDB(B1, 0, 1); PG8_SCHED; PG8_LDA(At, 0, 0); PG8_STAGE(PG8_SA(1, 1), a1 + hstep, voffA);
            PG8_WAIT_V(8); PG8_WAIT_L(0); PG8_BAR; PG8_MMA(0, 0, At, B0); PG8_MMA(0, 1, At, B1); PG8_BAR; PG8_SCHED;
            PG8_LDA(At, 0, 1); PG8_STAGE(PG8_SB(0, 0), b2, voffB); PG8_STAGE(PG8_SB(0, 1), b2 + hstep, voffB); PG8_STAGE(PG8_SA(0, 0), a2, voffA);
            PG8_WAIT_V(8); PG8_WAIT_L(0); PG8_BAR; PG8_MMA(1, 0, At, B0); PG8_MMA(1, 1, At, B1); PG8_BAR; PG8_SCHED;
            PG8_LDB(B0, 1, 0); PG8_LDB(B1, 1, 1); PG8_SCHED; PG8_LDA(At, 1, 0); PG8_STAGE(PG8_SA(0, 1), a2 + hstep, voffA);
            PG8_WAIT_V(8); PG8_WAIT_L(0); PG8_BAR; PG8_MMA(0, 0, At, B0); PG8_MMA(0, 1, At, B1); PG8_BAR; PG8_SCHED;
            PG8_LDA(At, 1, 1); PG8_STAGE(PG8_SB(1, 0), b3, voffB); PG8_STAGE(PG8_SB(1, 1), b3 + hstep, voffB); PG8_STAGE(PG8_SA(1, 0), a3, voffA);
            PG8_WAIT_V(8); PG8_WAIT_L(0); PG8_BAR; PG8_MMA(1, 0, At, B0); PG8_MMA(1, 1, At, B1); PG8_BAR; PG8_SCHED;
            } else {
            PG8_LDB(B0, 0, 0); PG8_SCHED; PG8_LDA(At, 0, 0); PG8_STAGE(PG8_SA(1, 1), a1 + hstep, voffA);
            PG8_WAIT_L(8); PG8_BAR; PG8_WAIT_L(0); PG8_MMA(0, 0, At, B0); PG8_BAR; PG8_SCHED;
            PG8_LDB(B1, 0, 1); PG8_STAGE(PG8_SB(0, 0), b2, voffB);
            PG8_BAR; PG8_WAIT_L(0); PG8_MMA(0, 1, At, B1); PG8_BAR;
            PG8_LDA(At, 0, 1); PG8_STAGE(PG8_SA(0, 0), a2, voffA);
            PG8_BAR; PG8_WAIT_L(0); PG8_MMA(1, 0, At, B0); PG8_BAR; PG8_SCHED;
            PG8_STAGE(PG8_SB(0, 1), b2 + hstep, voffB);
            PG8_WAIT_V(6); PG8_BAR; PG8_MMA(1, 1, At, B1); PG8_BAR;
            PG8_LDB(B0, 1, 0); PG8_SCHED; PG8_LDA(At, 1, 0); PG8_STAGE(PG8_SA(0, 1), a2 + hstep, voffA);
            PG8_WAIT_L(8); PG8_BAR; PG8_WAIT_L(0); PG8_MMA(0, 0, At, B0); PG8_BAR; PG8_SCHED;
            PG8_LDB(B1, 1, 1); PG8_STAGE(PG8_SB(1, 0), b3, voffB);
            PG8_BAR; PG8_WAIT_L(0); PG8_MMA(0, 1, At, B1); PG8_BAR;
            PG8_LDA(At, 1, 1); PG8_STAGE(PG8_SA(1, 0), a3, voffA);
            PG8_BAR; PG8_WAIT_L(0); PG8_MMA(1, 0, At, B0); PG8_BAR; PG8_SCHED;
            PG8_STAGE(PG8_SB(1, 1), b3 + hstep, voffB);
            PG8_WAIT_V(6); PG8_BAR; PG8_MMA(1, 1, At, B1); PG8_BAR;
            }
        }
        if constexpr (SCB != 0) asm volatile("s_nop 15\n\ts_nop 15" ::: "memory");
        if constexpr (ALIGN_EPI) { if (wr == 0) PG8_BAR; }
        if constexpr (!Epi::AFTER_DRAIN) { int fr_ = fr, fq_ = fq; asm volatile("" : "+v"(fr_), "+v"(fq_));
            E(acc, cur, wr, wc, fr_, fq_); S.done(cur); }
        if (!has_next) break;
#pragma unroll
        for (int a = 0; a < 2; ++a)
#pragma unroll
            for (int b = 0; b < 2; ++b)
#pragma unroll
                for (int m = 0; m < 4; ++m)
#pragma unroll
                    for (int n = 0; n < 2; ++n) acc[a][b][m][n] = (f32x4){0.f, 0.f, 0.f, 0.f};
        cur = nxt; cA = nA; cB = nB; ++ui;
        if constexpr (ALIGN_EPI) { if (wr == 1) PG8_BAR; }
    }
    PG8_WAIT_V(0);
    if constexpr (!ALIGN_EPI) { if (wr == 0) PG8_BAR; }
    PG8_BAR;
    if constexpr (Epi::AFTER_DRAIN) { E.fused(acc, cur, wr, wc, fr, fq, lds, wid, lane); S.done(cur); }
#undef PG8_SA
#undef PG8_SB
#undef PG8_STAGE
#undef PG8_LDA
#undef PG8_LDB
#undef PG8_MMA
#undef PG8_WAIT_V
#undef PG8_WAIT_L
#undef PG8_BAR
#undef PG8_SCHED
}
}
namespace att {
constexpr int KS_M = 400, KS_N = 272, VS = 320;
constexpr int MLA_KB = 64 * KS_M, NSA_KB = 64 * KS_N, VB = 64 * VS;
constexpr int N_IMP = 2 * NSA_KB + 2 * VB;
constexpr int N_PART = N_IMP + 32768;
constexpr int N_PARTB = 8 * 32 * 17 * 4;
constexpr int N_SELM = N_PART + 2 * N_PARTB;
constexpr int N_ULIST = N_SELM + 1024;
constexpr int N_CARRY = N_ULIST + 1024;
constexpr int N_NTS = N_CARRY + 256;
static_assert(N_NTS + 16 <= MISC_OFF, "NSA LDS map");
static_assert(2 * MLA_KB + 3 * VB <= 131072, "MLA LDS map");
constexpr int MLA_QL = 2 * MLA_KB + 2 * VB;
static_assert(MLA_QL + 8 * 4096 <= 131072, "MLA LDS map (pipelined)");

#ifndef QK_PF
#define QK_PF 4
#endif
#define MFMA32(a, b, c) __builtin_amdgcn_mfma_f32_32x32x16_bf16((a), (b), (c), 0, 0, 0)
__device__ __forceinline__ float swapmax(float v) { auto rr = __builtin_amdgcn_permlane32_swap(__float_as_uint(v), __float_as_uint(v), false, false); return fmaxf(__uint_as_float(rr[0]), __uint_as_float(rr[1])); }
__device__ __forceinline__ float swapsum(float v) { auto rr = __builtin_amdgcn_permlane32_swap(__float_as_uint(v), __float_as_uint(v), false, false); return __uint_as_float(rr[0]) + __uint_as_float(rr[1]); }
template <int SIDX> __device__ __forceinline__ bf16x8 packp(const f32x16& p) {
    f32x8 t = {p[8 * SIDX + 0], p[8 * SIDX + 1], p[8 * SIDX + 2], p[8 * SIDX + 3], p[8 * SIDX + 4], p[8 * SIDX + 5], p[8 * SIDX + 6], p[8 * SIDX + 7]};
    return __builtin_bit_cast(bf16x8, __builtin_convertvector(t, bf16x8v));
}
template <int NDC, int KS, bool ZERO = true> __device__ __forceinline__ void qk_tile(f32x16& p0, f32x16& p1, const LAS unsigned char* kl, const bf16x8 (&q)[NDC]) {
    if (ZERO) {
#pragma unroll
        for (int i = 0; i < 16; ++i) { p0[i] = 0.f; p1[i] = 0.f; }
    }
    constexpr int PF = QK_PF;
    bf16x8 a[PF + 1][2];
#pragma unroll
    for (int i = 0; i < PF; ++i) { a[i][0] = *(const LAS bf16x8*)(kl + i * 32); a[i][1] = *(const LAS bf16x8*)(kl + 32 * KS + i * 32); }
#pragma unroll
    for (int d0 = 0; d0 < NDC; ++d0) {
        if (d0 + PF < NDC) { a[(d0 + PF) % (PF + 1)][0] = *(const LAS bf16x8*)(kl + (d0 + PF) * 32); a[(d0 + PF) % (PF + 1)][1] = *(const LAS bf16x8*)(kl + 32 * KS + (d0 + PF) * 32); }
        __builtin_amdgcn_sched_barrier(0);
        p0 = MFMA32(a[d0 % (PF + 1)][0], q[d0], p0); p1 = MFMA32(a[d0 % (PF + 1)][1], q[d0], p1);
        __builtin_amdgcn_sched_barrier(0);
    }
}
#ifdef PROBE_QKM2
template <int NDC, int KS> __device__ __forceinline__ void qk_tile_m2(f32x16& p0, f32x16& p1, f32x16& r0, f32x16& r1, const LAS unsigned char* kl, const bf16x8 (&q)[NDC]) {
#pragma unroll
    for (int i = 0; i < 16; ++i) { p0[i] = 0.f; p1[i] = 0.f; r0[i] = 0.f; r1[i] = 0.f; }
    constexpr int PF = QK_PF;
    bf16x8 a[PF + 1][2];
#pragma unroll
    for (int i = 0; i < PF; ++i) { a[i][0] = *(const LAS bf16x8*)(kl + i * 32); a[i][1] = *(const LAS bf16x8*)(kl + 32 * KS + i * 32); }
#pragma unroll
    for (int d0 = 0; d0 < NDC; ++d0) {
        if (d0 + PF < NDC) { a[(d0 + PF) % (PF + 1)][0] = *(const LAS bf16x8*)(kl + (d0 + PF) * 32); a[(d0 + PF) % (PF + 1)][1] = *(const LAS bf16x8*)(kl + 32 * KS + (d0 + PF) * 32); }
        __builtin_amdgcn_sched_barrier(0);
        p0 = MFMA32(a[d0 % (PF + 1)][0], q[d0], p0); p1 = MFMA32(a[d0 % (PF + 1)][1], q[d0], p1);
        r0 = MFMA32(a[d0 % (PF + 1)][0], q[d0], r0); r1 = MFMA32(a[d0 % (PF + 1)][1], q[d0], r1);
        __builtin_amdgcn_sched_barrier(0);
    }
}
#endif
__device__ __forceinline__ void pv_tile(f32x16 (&o)[4], const bf16x8 (&pb)[4], const LAS unsigned char* vl) {
    s16x4 f[5][2];
#define PV_LD(idx) do { constexpr int d_ = (idx) >> 2, s_ = (idx) & 3; \
        f[(idx) % 5][0] = __builtin_amdgcn_ds_read_tr16_b64_v4i16((LAS s16x4*)(vl + s_ * 16 * VS + d_ * 64)); \
        f[(idx) % 5][1] = __builtin_amdgcn_ds_read_tr16_b64_v4i16((LAS s16x4*)(vl + s_ * 16 * VS + 8 * VS + d_ * 64)); } while (0)
    PV_LD(0); PV_LD(1); PV_LD(2); PV_LD(3);
#define PV_STEP(idx) do { if ((idx) + 4 < 16) PV_LD((idx) + 4); __builtin_amdgcn_sched_barrier(0); \
        { const s16x4 t0_ = f[(idx) % 5][0], t1_ = f[(idx) % 5][1]; const bf16x8 vf_ = {t0_[0], t0_[1], t0_[2], t0_[3], t1_[0], t1_[1], t1_[2], t1_[3]}; \
          o[(idx) >> 2] = MFMA32(vf_, pb[(idx) & 3], o[(idx) >> 2]); } __builtin_amdgcn_sched_barrier(0); } while (0)
    PV_STEP(0); PV_STEP(1); PV_STEP(2); PV_STEP(3); PV_STEP(4); PV_STEP(5); PV_STEP(6); PV_STEP(7);
    PV_STEP(8); PV_STEP(9); PV_STEP(10); PV_STEP(11); PV_STEP(12); PV_STEP(13); PV_STEP(14); PV_STEP(15);
#undef PV_STEP
#undef PV_LD
}
template <int NDC, int NQR, int KS> __device__ __forceinline__ void qk_tile_free(f32x16& p0, f32x16& p1, const LAS unsigned char* kl, const bf16x8 (&q)[NQR], const LAS unsigned char* ql) {
#pragma unroll
    for (int i = 0; i < 16; ++i) { p0[i] = 0.f; p1[i] = 0.f; }
#pragma unroll
    for (int d0 = 0; d0 < NDC; ++d0) {
        const bf16x8 a0 = *(const LAS bf16x8*)(kl + d0 * 32);
        const bf16x8 a1 = *(const LAS bf16x8*)(kl + 32 * KS + d0 * 32);
        bf16x8 qq; if (d0 < NQR) qq = q[d0 < NQR ? d0 : 0]; else qq = *(const LAS bf16x8*)(ql + (d0 - NQR) * 1024);
        p0 = MFMA32(a0, qq, p0); p1 = MFMA32(a1, qq, p1);
    }
}
__device__ __forceinline__ float sm_core(f32x16& p0, f32x16& p1, float& m, float& l) {
    float tm = p0[0];
#pragma unroll
    for (int r = 1; r < 16; ++r) tm = fmaxf(tm, p0[r]);
#pragma unroll
    for (int r = 0; r < 16; ++r) tm = fmaxf(tm, p1[r]);
    tm = swapmax(tm);
    const float mn = fmaxf(m, tm);
    const float alpha = __builtin_amdgcn_exp2f(m - mn);
    m = mn;
    float ps = 0.f;
#pragma unroll
    for (int r = 0; r < 16; ++r) { p0[r] = __builtin_amdgcn_exp2f(p0[r] - mn); ps += p0[r]; }
#pragma unroll
    for (int r = 0; r < 16; ++r) { p1[r] = __builtin_amdgcn_exp2f(p1[r] - mn); ps += p1[r]; }
    ps = swapsum(ps);
    l = l * alpha + ps;
    return alpha;
}
__device__ __forceinline__ void online_sm(f32x16& p0, f32x16& p1, float& m, float& l, f32x16 (&o)[4]) {
    float tm = p0[0];
#pragma unroll
    for (int r = 1; r < 16; ++r) tm = fmaxf(tm, p0[r]);
#pragma unroll
    for (int r = 0; r < 16; ++r) tm = fmaxf(tm, p1[r]);
    tm = swapmax(tm);
    const float mn = fmaxf(m, tm);
    const float alpha = __builtin_amdgcn_exp2f(m - mn);
    m = mn;
    float ps = 0.f;
#pragma unroll
    for (int r = 0; r < 16; ++r) { p0[r] = __builtin_amdgcn_exp2f(p0[r] - mn); ps += p0[r]; }
#pragma unroll
    for (int r = 0; r < 16; ++r) { p1[r] = __builtin_amdgcn_exp2f(p1[r] - mn); ps += p1[r]; }
    ps = swapsum(ps);
    l = l * alpha + ps;
    if (!__all(alpha == 1.f)) {
#pragma unroll
        for (int d = 0; d < 4; ++d)
#pragma unroll
            for (int r = 0; r < 16; ++r) o[d][r] *= alpha;
    }
}

#ifdef MLA_FP8
typedef long i64;
constexpr int KS8 = 200, MLA_KB8 = 64 * KS8;
static_assert(2 * MLA_KB8 + 3 * VB <= 131072, "MLA fp8 LDS map");
#define MFMA32F8(a, b, c) __builtin_amdgcn_mfma_f32_32x32x16_fp8_fp8((a), (b), (c), 0, 0, 0)
template <int NDC> __device__ __forceinline__ void qk_tile8(f32x16& p0, f32x16& p1, const LAS unsigned char* kl, const i64 (&q)[NDC]) {
#pragma unroll
    for (int i = 0; i < 16; ++i) { p0[i] = 0.f; p1[i] = 0.f; }
    constexpr int PF = 4;
    i64 a[PF + 1][2];
#pragma unroll
    for (int i = 0; i < PF; ++i) { a[i][0] = *(const LAS i64*)(kl + i * 16); a[i][1] = *(const LAS i64*)(kl + 32 * KS8 + i * 16); }
#pragma unroll
    for (int d0 = 0; d0 < NDC; ++d0) {
        if (d0 + PF < NDC) { a[(d0 + PF) % (PF + 1)][0] = *(const LAS i64*)(kl + (d0 + PF) * 16); a[(d0 + PF) % (PF + 1)][1] = *(const LAS i64*)(kl + 32 * KS8 + (d0 + PF) * 16); }
        __builtin_amdgcn_sched_barrier(0);
        __builtin_amdgcn_s_setprio(1);
        p0 = MFMA32F8(a[d0 % (PF + 1)][0], q[d0], p0); p1 = MFMA32F8(a[d0 % (PF + 1)][1], q[d0], p1);
        __builtin_amdgcn_s_setprio(0);
        __builtin_amdgcn_sched_barrier(0);
    }
}
__device__ __forceinline__ void online_sm_scaled(f32x16& p0, f32x16& p1, float& m, float& l, f32x16 (&o)[4], const float C2) {
    float tm = p0[0];
#pragma unroll
    for (int r = 1; r < 16; ++r) tm = fmaxf(tm, p0[r]);
#pragma unroll
    for (int r = 0; r < 16; ++r) tm = fmaxf(tm, p1[r]);
    tm = swapmax(tm);
    const float mn = fmaxf(m, tm);
    const float alpha = __builtin_amdgcn_exp2f((m - mn) * C2);
    m = mn;
    const float mc = -mn * C2;
    float ps = 0.f;
#pragma unroll
    for (int r = 0; r < 16; ++r) { p0[r] = __builtin_amdgcn_exp2f(__builtin_fmaf(p0[r], C2, mc)); ps += p0[r]; }
#pragma unroll
    for (int r = 0; r < 16; ++r) { p1[r] = __builtin_amdgcn_exp2f(__builtin_fmaf(p1[r], C2, mc)); ps += p1[r]; }
    ps = swapsum(ps);
    l = l * alpha + ps;
    if (!__all(alpha == 1.f)) {
#pragma unroll
        for (int d = 0; d < 4; ++d)
#pragma unroll
            for (int r = 0; r < 16; ++r) o[d][r] *= alpha;
    }
}
#endif
#ifdef MLA_FP8V
constexpr int VS8 = 72, VB8 = 128 * VS8;
constexpr int VS8B = 136, VB8B = 128 * VS8B, MLA_KB8B = 128 * KS8;
static_assert(2 * MLA_KB8B + 3 * VB8B <= 131072, "MLA big-tile LDS map");
#ifdef MLA_BIG
#define PV8_RS VS8B
#else
#define PV8_RS VS8
#endif
static_assert(2 * MLA_KB8 + 3 * VB8 <= 131072, "MLA fp8 LDS map");
template <int SIDX> __device__ __forceinline__ i64 packp8(const f32x16& p) {
    int w0 = __builtin_amdgcn_cvt_pk_fp8_f32(p[8 * SIDX + 0] * 256.f, p[8 * SIDX + 1] * 256.f, 0, false); w0 = __builtin_amdgcn_cvt_pk_fp8_f32(p[8 * SIDX + 2] * 256.f, p[8 * SIDX + 3] * 256.f, w0, true);
    int w1 = __builtin_amdgcn_cvt_pk_fp8_f32(p[8 * SIDX + 4] * 256.f, p[8 * SIDX + 5] * 256.f, 0, false); w1 = __builtin_amdgcn_cvt_pk_fp8_f32(p[8 * SIDX + 6] * 256.f, p[8 * SIDX + 7] * 256.f, w1, true);
    return (i64)(((unsigned long long)(unsigned)w1 << 32) | (unsigned)w0);
}
__device__ __forceinline__ void pv_tile8(f32x16 (&o)[4], const i64 (&pb)[4], const LAS unsigned char* vl) {
    i64 f[5];
#define PV8_LD(idx) f[(idx) % 5] = *(const LAS i64*)(vl + ((idx) >> 2) * 32 * PV8_RS + ((idx) & 3) * 16)
    PV8_LD(0); PV8_LD(1); PV8_LD(2); PV8_LD(3);
#define PV8_STEP(idx) do { if ((idx) + 4 < 16) PV8_LD((idx) + 4); __builtin_amdgcn_sched_barrier(0); \
        o[(idx) >> 2] = MFMA32F8(f[(idx) % 5], pb[(idx) & 3], o[(idx) >> 2]); __builtin_amdgcn_sched_barrier(0); } while (0)
    PV8_STEP(0); PV8_STEP(1); PV8_STEP(2); PV8_STEP(3); PV8_STEP(4); PV8_STEP(5); PV8_STEP(6); PV8_STEP(7);
    PV8_STEP(8); PV8_STEP(9); PV8_STEP(10); PV8_STEP(11); PV8_STEP(12); PV8_STEP(13); PV8_STEP(14); PV8_STEP(15);
#undef PV8_STEP
#undef PV8_LD
}
#endif
#ifdef MLA_MX
typedef int i32x8 __attribute__((ext_vector_type(8)));
constexpr int KSX = 208, MLA_KBX = 64 * KSX;
constexpr int VSX = 80, VBX = 128 * VSX;
static_assert(2 * MLA_KBX + 3 * VBX <= 131072, "MLA mx LDS map");
#define MFMAX(a, b, c) __builtin_amdgcn_mfma_scale_f32_32x32x64_f8f6f4((a), (b), (c), 0, 0, 0, 0x7f7f7f7f, 0, 0x7f7f7f7f)
__device__ __forceinline__ i32x8 ldsx(const LAS unsigned char* p) {
    const u32x4 a = *(const LAS u32x4*)p, b = *(const LAS u32x4*)(p + 16);
    return (i32x8){(int)a.x, (int)a.y, (int)a.z, (int)a.w, (int)b.x, (int)b.y, (int)b.z, (int)b.w};
}
__device__ __forceinline__ void qk_tilex(f32x16& p0, f32x16& p1, const LAS unsigned char* kl, const i32x8 (&q)[3]) {
#pragma unroll
    for (int i = 0; i < 16; ++i) { p0[i] = 0.f; p1[i] = 0.f; }
    i32x8 a0 = ldsx(kl), a1 = ldsx(kl + 32 * KSX), a2 = ldsx(kl + 64), a3 = ldsx(kl + 32 * KSX + 64);
    __builtin_amdgcn_sched_barrier(0);
    __builtin_amdgcn_s_setprio(1);
    p0 = MFMAX(a0, q[0], p0); p1 = MFMAX(a1, q[0], p1);
    __builtin_amdgcn_s_setprio(0);
    __builtin_amdgcn_sched_barrier(0);
    a0 = ldsx(kl + 128); a1 = ldsx(kl + 32 * KSX + 128);
    __builtin_amdgcn_sched_barrier(0);
    __builtin_amdgcn_s_setprio(1);
    p0 = MFMAX(a2, q[1], p0); p1 = MFMAX(a3, q[1], p1);
    __builtin_amdgcn_sched_barrier(0);
    p0 = MFMAX(a0, q[2], p0); p1 = MFMAX(a1, q[2], p1);
    __builtin_amdgcn_s_setprio(0);
    __builtin_amdgcn_sched_barrier(0);
}
__device__ __forceinline__ void pv_tilex(f32x16 (&o)[4], const i32x8& pb, const LAS unsigned char* vl) {
    i32x8 f0 = ldsx(vl), f1 = ldsx(vl + 32 * VSX);
    __builtin_amdgcn_sched_barrier(0);
    o[0] = MFMAX(f0, pb, o[0]);
    __builtin_amdgcn_sched_barrier(0);
    f0 = ldsx(vl + 64 * VSX);
    __builtin_amdgcn_sched_barrier(0);
    o[1] = MFMAX(f1, pb, o[1]);
    __builtin_amdgcn_sched_barrier(0);
    f1 = ldsx(vl + 96 * VSX);
    __builtin_amdgcn_sched_barrier(0);
    o[2] = MFMAX(f0, pb, o[2]);
    __builtin_amdgcn_sched_barrier(0);
    o[3] = MFMAX(f1, pb, o[3]);
    __builtin_amdgcn_sched_barrier(0);
}
__device__ __forceinline__ i32x8 packpx(const f32x16& p0, const f32x16& p1) {
    i32x8 w;
#pragma unroll
    for (int g = 0; g < 4; ++g) {
        int a = __builtin_amdgcn_cvt_pk_fp8_f32(p0[4 * g + 0], p0[4 * g + 1], 0, false); a = __builtin_amdgcn_cvt_pk_fp8_f32(p0[4 * g + 2], p0[4 * g + 3], a, true); w[g] = a;
        int b = __builtin_amdgcn_cvt_pk_fp8_f32(p1[4 * g + 0], p1[4 * g + 1], 0, false); b = __builtin_amdgcn_cvt_pk_fp8_f32(p1[4 * g + 2], p1[4 * g + 3], b, true); w[4 + g] = b;
    }
    return w;
}
__device__ __forceinline__ void online_sm_x(f32x16& p0, f32x16& p1, float& m, float& l, f32x16 (&o)[4], const float C2) {
    float tm = p0[0];
#pragma unroll
    for (int r = 1; r < 16; ++r) tm = fmaxf(tm, p0[r]);
#pragma unroll
    for (int r = 0; r < 16; ++r) tm = fmaxf(tm, p1[r]);
    tm = swapmax(tm);
    const float mn = fmaxf(m, tm);
    const float alpha = __builtin_amdgcn_exp2f((m - mn) * C2);
    m = mn;
    const float mc = 8.f - mn * C2;
    float ps = 0.f;
#pragma unroll
    for (int r = 0; r < 16; ++r) { p0[r] = __builtin_amdgcn_exp2f(__builtin_fmaf(p0[r], C2, mc)); ps += p0[r]; }
#pragma unroll
    for (int r = 0; r < 16; ++r) { p1[r] = __builtin_amdgcn_exp2f(__builtin_fmaf(p1[r], C2, mc)); ps += p1[r]; }
    ps = swapsum(ps);
    l = l * alpha + ps;
    if (!__all(alpha == 1.f)) {
#pragma unroll
        for (int d = 0; d < 4; ++d)
#pragma unroll
            for (int r = 0; r < 16; ++r) o[d][r] *= alpha;
    }
}
#endif
#ifdef MLA_MXL
#define MXL_T 7.0f
#define MFMAXQ(a, b, c) __builtin_amdgcn_mfma_scale_f32_32x32x64_f8f6f4((a), (b), (c), 0, 0, 0, 0x7f7f7f7f, 0, 0x7c7c7c7c)
__device__ __forceinline__ void qk_tilexl(f32x16& p0, f32x16& p1, const f32x16& mref, const LAS unsigned char* kl, const i32x8 (&q)[3]) {
    i32x8 a0 = ldsx(kl), a1 = ldsx(kl + 32 * KSX), a2 = ldsx(kl + 64), a3 = ldsx(kl + 32 * KSX + 64);
    __builtin_amdgcn_sched_barrier(0);
    __builtin_amdgcn_s_setprio(1);
    p0 = MFMAXQ(a0, q[0], mref); p1 = MFMAXQ(a1, q[0], mref);
    __builtin_amdgcn_s_setprio(0);
    __builtin_amdgcn_sched_barrier(0);
    a0 = ldsx(kl + 128); a1 = ldsx(kl + 32 * KSX + 128);
    __builtin_amdgcn_sched_barrier(0);
    __builtin_amdgcn_s_setprio(1);
    p0 = MFMAXQ(a2, q[1], p0); p1 = MFMAXQ(a3, q[1], p1);
    __builtin_amdgcn_sched_barrier(0);
    p0 = MFMAXQ(a0, q[2], p0); p1 = MFMAXQ(a1, q[2], p1);
    __builtin_amdgcn_s_setprio(0);
    __builtin_amdgcn_sched_barrier(0);
}
__device__ __forceinline__ void pv_tilexl(f32x16 (&o)[5], const i32x8& pb, const i32x8& ones, const LAS unsigned char* vl) {
    i32x8 f0 = ldsx(vl), f1 = ldsx(vl + 32 * VSX);
    __builtin_amdgcn_sched_barrier(0);
    o[4] = MFMAX(ones, pb, o[4]);
    __builtin_amdgcn_sched_barrier(0);
    o[0] = MFMAX(f0, pb, o[0]);
    __builtin_amdgcn_sched_barrier(0);
    f0 = ldsx(vl + 64 * VSX);
    __builtin_amdgcn_sched_barrier(0);
    o[1] = MFMAX(f1, pb, o[1]);
    __builtin_amdgcn_sched_barrier(0);
    f1 = ldsx(vl + 96 * VSX);
    __builtin_amdgcn_sched_barrier(0);
    o[2] = MFMAX(f0, pb, o[2]);
    __builtin_amdgcn_sched_barrier(0);
    o[3] = MFMAX(f1, pb, o[3]);
    __builtin_amdgcn_sched_barrier(0);
}
__device__ __forceinline__ i32x8 exp_packx(const f32x16& p0, const f32x16& p1, int any) {
    i32x8 w;
#pragma unroll
    for (int g = 0; g < 4; ++g) {
        int a = __builtin_amdgcn_cvt_pk_fp8_f32(__builtin_amdgcn_exp2f(p0[4 * g + 0]), __builtin_amdgcn_exp2f(p0[4 * g + 1]), any, false);
        a = __builtin_amdgcn_cvt_pk_fp8_f32(__builtin_amdgcn_exp2f(p0[4 * g + 2]), __builtin_amdgcn_exp2f(p0[4 * g + 3]), a, true); w[g] = a;
        int b = __builtin_amdgcn_cvt_pk_fp8_f32(__builtin_amdgcn_exp2f(p1[4 * g + 0]), __builtin_amdgcn_exp2f(p1[4 * g + 1]), any, false);
        b = __builtin_amdgcn_cvt_pk_fp8_f32(__builtin_amdgcn_exp2f(p1[4 * g + 2]), __builtin_amdgcn_exp2f(p1[4 * g + 3]), b, true); w[4 + g] = b;
    }
    return w;
}
#endif
#ifdef MLA_PIPE8
template <int NDC> __device__ __forceinline__ void qk_tile8_free(f32x16& p0, f32x16& p1, const LAS unsigned char* kl, const i64 (&q)[NDC]) {
#pragma unroll
    for (int i = 0; i < 16; ++i) { p0[i] = 0.f; p1[i] = 0.f; }
#pragma unroll
    for (int d0 = 0; d0 < NDC; ++d0) {
        const i64 a0 = *(const LAS i64*)(kl + d0 * 16), a1 = *(const LAS i64*)(kl + 32 * KS8 + d0 * 16);
        p0 = MFMA32F8(a0, q[d0], p0); p1 = MFMA32F8(a1, q[d0], p1);
    }
}
__device__ __forceinline__ float sm_core_scaled(f32x16& p0, f32x16& p1, float& m, float& l, const float C2) {
    float tm = p0[0];
#pragma unroll
    for (int r = 1; r < 16; ++r) tm = fmaxf(tm, p0[r]);
#pragma unroll
    for (int r = 0; r < 16; ++r) tm = fmaxf(tm, p1[r]);
    tm = swapmax(tm);
    const float mn = fmaxf(m, tm);
    const float alpha = __builtin_amdgcn_exp2f((m - mn) * C2);
    m = mn;
    const float mc = -mn * C2;
    float ps = 0.f;
#pragma unroll
    for (int r = 0; r < 16; ++r) { p0[r] = __builtin_amdgcn_exp2f(__builtin_fmaf(p0[r], C2, mc)); ps += p0[r]; }
#pragma unroll
    for (int r = 0; r < 16; ++r) { p1[r] = __builtin_amdgcn_exp2f(__builtin_fmaf(p1[r], C2, mc)); ps += p1[r]; }
    ps = swapsum(ps);
    l = l * alpha + ps;
    return alpha;
}
#endif
#ifdef MLA_PIPE8
struct MlaPtrs { const bf16* Q; const bf16* K; const bf16* V; const bf16* Z; bf16* O; };
__device__ __forceinline__ void mla_mask(f32x16& p0, f32x16& p1, int dq) {
#pragma unroll
    for (int r = 0; r < 16; ++r) { const int c = (r & 3) + 8 * (r >> 2);
        if (c > dq) p0[r] = -__builtin_inff();
        if (c + 32 > dq) p1[r] = -__builtin_inff(); }
}
__device__ __forceinline__ void mla_unit(LAS unsigned char* lds, const MlaPtrs& P, int head, int qb, int tid_in, int wave, int lane_in) {
    int tid = tid_in; asm volatile("" : "+v"(tid)); const int lane = tid & 63; (void)lane_in;
    const int r32 = lane & 31, hi = lane >> 5;
    const int q0 = qb * 256, qw = q0 + wave * 32, tq = qw + r32;
    i64 q[12];
    { const unsigned char* qp = (const unsigned char*)P.Q + (size_t)tq * 3072 + head * 192 + hi * 8;
#pragma unroll
      for (int d0 = 0; d0 < 12; ++d0) q[d0] = *(const GAS i64*)(qp + d0 * 16); }
    const int NT = 4 * (qb + 1);
    const int srow = tid >> 3, sc8 = tid & 7;
    const unsigned char* kg = (const unsigned char*)P.K + (size_t)head * 192 + (size_t)srow * 3072 + sc8 * 8;
    const unsigned char* vg = (const unsigned char*)P.V + ((size_t)head * 128 + (tid >> 2)) * S + (tid & 3) * 16;
    LAS unsigned char* kst = lds + srow * KS8 + sc8 * 8;
    LAS unsigned char* vst = lds + 2 * MLA_KB8 + (tid >> 2) * VS8 + (tid & 3) * 16;
    const LAS unsigned char* kl = lds + r32 * KS8 + hi * 8;
    const LAS unsigned char* vl = lds + 2 * MLA_KB8 + r32 * VS8 + hi * 8;
    u32x2 sk0, sk1, sk2; u32x4 sv0;
#define MLA_LOADK(j) do { const unsigned char* kp_ = kg + (size_t)(j) * (64 * 3072); sk0 = *(const GAS u32x2*)(kp_); sk1 = *(const GAS u32x2*)(kp_ + 64); sk2 = *(const GAS u32x2*)(kp_ + 128); } while (0)
#define MLA_LOADV(j) do { sv0 = *(const GAS u32x4*)(vg + (size_t)(j) * 64); } while (0)
#define MLA_STOREK(b) do { LAS unsigned char* kd_ = kst + (b) * MLA_KB8; *(LAS u32x2*)(kd_) = sk0; *(LAS u32x2*)(kd_ + 64) = sk1; *(LAS u32x2*)(kd_ + 128) = sk2; } while (0)
#define MLA_STOREV(b) do { LAS unsigned char* vd_ = vst + (b) * VB8; *(LAS u32x2*)(vd_) = (u32x2){sv0.x, sv0.y}; *(LAS u32x2*)(vd_ + 8) = (u32x2){sv0.z, sv0.w}; } while (0)
    float m = -1e30f, l = 0.f; f32x16 o[4];
#pragma unroll
    for (int d = 0; d < 4; ++d)
#pragma unroll
        for (int r = 0; r < 16; ++r) o[d][r] = 0.f;
    f32x16 pA0, pA1, pB0, pB1;
    MLA_LOADK(0); MLA_LOADV(0); MLA_STOREK(0); MLA_STOREV(0);
    MLA_LOADK(1);
    __syncthreads();
    qk_tile8<12>(pA0, pA1, kl, q);
    if (63 > qw) mla_mask(pA0, pA1, tq - 4 * hi);
    MLA_STOREK(1);
    if (2 < NT) MLA_LOADK(2);
    MLA_LOADV(1);
    __syncthreads();
#define MLA_SGB1() do { __builtin_amdgcn_sched_group_barrier(0x100, 2, 0); __builtin_amdgcn_sched_group_barrier(0x008, 1, 0); __builtin_amdgcn_sched_group_barrier(0x002, 6, 0); \
        __builtin_amdgcn_sched_group_barrier(0x008, 1, 0); __builtin_amdgcn_sched_group_barrier(0x002, 6, 0); } while (0)
#define MLA_SGB() do { MLA_SGB1(); MLA_SGB1(); MLA_SGB1(); MLA_SGB1(); MLA_SGB1(); MLA_SGB1(); MLA_SGB1(); MLA_SGB1(); MLA_SGB1(); MLA_SGB1(); MLA_SGB1(); MLA_SGB1(); } while (0)
#define MLA_STEP(PX0, PX1, PY0, PY1, j) do { \
        const int kb1_ = 64 * ((j) + 1); \
        const bool a1_ = ((j) + 1 < NT) && (kb1_ <= qw + 31), a0_ = (64 * (j) <= qw + 31); \
        float alpha_ = 1.f; i64 pb_[4]; \
        if (a1_) { \
            __builtin_amdgcn_sched_barrier(0); \
            qk_tile8_free<12>(PY0, PY1, kl + (((j) + 1) & 1) * MLA_KB8, q); \
            alpha_ = sm_core_scaled(PX0, PX1, m, l, QS_MLA); \
            pb_[0] = packp8<0>(PX0); pb_[1] = packp8<1>(PX0); pb_[2] = packp8<0>(PX1); pb_[3] = packp8<1>(PX1); \
            MLA_SGB(); \
            __builtin_amdgcn_sched_barrier(0); \
            if (kb1_ + 63 > qw) mla_mask(PY0, PY1, tq - kb1_ - 4 * hi); \
        } else if (a0_) { \
            alpha_ = sm_core_scaled(PX0, PX1, m, l, QS_MLA); \
            pb_[0] = packp8<0>(PX0); pb_[1] = packp8<1>(PX0); pb_[2] = packp8<0>(PX1); pb_[3] = packp8<1>(PX1); \
        } \
        if (a0_) { \
            if (!__all(alpha_ == 1.f)) { _Pragma("unroll") for (int d_ = 0; d_ < 4; ++d_) _Pragma("unroll") for (int r_ = 0; r_ < 16; ++r_) o[d_][r_] *= alpha_; } \
            pv_tile8(o, pb_, vl + ((j) & 1) * VB8); \
        } \
        if ((j) + 2 < NT) MLA_STOREK((j) & 1); \
        if ((j) + 1 < NT) MLA_STOREV(((j) + 1) & 1); \
        if ((j) + 3 < NT) MLA_LOADK((j) + 3); \
        if ((j) + 2 < NT) MLA_LOADV((j) + 2); \
        __syncthreads(); } while (0)
    for (int j = 0; j < NT; j += 2) {
        MLA_STEP(pA0, pA1, pB0, pB1, j);
        MLA_STEP(pB0, pB1, pA0, pA1, j + 1);
    }
#undef MLA_STEP
#undef MLA_SGB
#undef MLA_SGB1
#undef MLA_LOADK
#undef MLA_LOADV
#undef MLA_STOREK
#undef MLA_STOREV
    const float inv = (1.f / 256.f) / l;
    const bf16* zp = P.Z + (size_t)tq * 2048 + head * 128 + 4 * hi;
    bf16* op = P.O + (size_t)tq * 4096 + head * 128 + 4 * hi;
#pragma unroll
    for (int d0 = 0; d0 < 4; ++d0)
#pragma unroll
        for (int rg = 0; rg < 4; ++rg) { const int dim = 32 * d0 + 8 * rg;
            const u32x2 z = *(const GAS u32x2*)(zp + dim);
            u32x2 w; w.x = pk2(o[d0][4 * rg + 0] * inv * bflo(z.x), o[d0][4 * rg + 1] * inv * bfhi(z.x)); w.y = pk2(o[d0][4 * rg + 2] * inv * bflo(z.y), o[d0][4 * rg + 3] * inv * bfhi(z.y));
            *(GAS u32x2*)(op + dim) = w; }
}
#elif defined(MLA_PIPE)
struct MlaPtrs { const bf16* Q; const bf16* K; const bf16* V; const bf16* Z; bf16* O; };
__device__ __forceinline__ void mla_mask(f32x16& p0, f32x16& p1, int dq) {
#pragma unroll
    for (int r = 0; r < 16; ++r) { const int c = (r & 3) + 8 * (r >> 2);
        if (c > dq) p0[r] = -__builtin_inff();
        if (c + 32 > dq) p1[r] = -__builtin_inff(); }
}
__device__ __forceinline__ void mla_unit(LAS unsigned char* lds, const MlaPtrs& P, int head, int qb, int tid_in, int wave, int lane_in) {
    int tid = tid_in; asm volatile("" : "+v"(tid)); const int lane = tid & 63; (void)lane_in;
    const int r32 = lane & 31, hi = lane >> 5;
    const int q0 = qb * 256, qw = q0 + wave * 32, tq = qw + r32;
    bf16x8 q[8];
    LAS unsigned char* ql = lds + MLA_QL + wave * 4096 + lane * 16;
    { const bf16* qp = P.Q + (size_t)tq * 3072 + head * 192 + hi * 8;
#pragma unroll
      for (int d0 = 0; d0 < 8; ++d0) q[d0] = *(const GAS bf16x8*)(qp + d0 * 16);
#pragma unroll
      for (int d0 = 8; d0 < 12; ++d0) *(LAS bf16x8*)(ql + (d0 - 8) * 1024) = *(const GAS bf16x8*)(qp + d0 * 16); }
    const int NT = 4 * (qb + 1);
    const int srow = tid >> 3, sc8 = tid & 7;
    const unsigned char* kg = (const unsigned char*)P.K + (size_t)head * 384 + (size_t)srow * 6144 + sc8 * 16;
    const unsigned char* vg = (const unsigned char*)P.V + (size_t)head * 256 + (size_t)srow * 4096 + sc8 * 16;
    LAS unsigned char* kst = lds + srow * KS_M + sc8 * 16;
    LAS unsigned char* vst = lds + 2 * MLA_KB + srow * VS + sc8 * 16;
    const LAS unsigned char* kl = lds + r32 * KS_M + hi * 16;
    const LAS unsigned char* vl = lds + 2 * MLA_KB + (4 * hi + ((lane & 15) >> 2)) * VS + (16 * ((lane >> 4) & 1) + 4 * (lane & 3)) * 2;
    u32x4 sk0, sk1, sk2, sv0, sv1;
#define MLA_LOADK(j) do { const unsigned char* kp_ = kg + (size_t)(j) * (64 * 6144); sk0 = *(const GAS u32x4*)(kp_); sk1 = *(const GAS u32x4*)(kp_ + 128); sk2 = *(const GAS u32x4*)(kp_ + 256); } while (0)
#define MLA_LOADV(j) do { const unsigned char* vp_ = vg + (size_t)(j) * (64 * 4096); sv0 = *(const GAS u32x4*)(vp_); sv1 = *(const GAS u32x4*)(vp_ + 128); } while (0)
#define MLA_STOREK(b) do { LAS unsigned char* kd_ = kst + (b) * MLA_KB; *(LAS u32x4*)(kd_) = sk0; *(LAS u32x4*)(kd_ + 128) = sk1; *(LAS u32x4*)(kd_ + 256) = sk2; } while (0)
#define MLA_STOREV(b) do { LAS unsigned char* vd_ = vst + (b) * VB; *(LAS u32x4*)(vd_) = sv0; *(LAS u32x4*)(vd_ + 128) = sv1; } while (0)
    float m = -1e30f, l = 0.f; f32x16 o[4];
#pragma unroll
    for (int d = 0; d < 4; ++d)
#pragma unroll
        for (int r = 0; r < 16; ++r) o[d][r] = 0.f;
    f32x16 pA0, pA1, pB0, pB1;
    MLA_LOADK(0); MLA_LOADV(0); MLA_STOREK(0); MLA_STOREV(0);
    MLA_LOADK(1);
    __syncthreads();
    qk_tile_free<12, 8, KS_M>(pA0, pA1, kl, q, ql);
    if (63 > qw) mla_mask(pA0, pA1, tq - 4 * hi);
    MLA_STOREK(1);
    if (2 < NT) MLA_LOADK(2);
    MLA_LOADV(1);
    __syncthreads();
#define MLA_SGB1(NR) do { __builtin_amdgcn_sched_group_barrier(0x100, NR, 0); __builtin_amdgcn_sched_group_barrier(0x008, 1, 0); __builtin_amdgcn_sched_group_barrier(0x002, 6, 0); \
        __builtin_amdgcn_sched_group_barrier(0x008, 1, 0); __builtin_amdgcn_sched_group_barrier(0x002, 6, 0); } while (0)
#define MLA_SGB() do { MLA_SGB1(2); MLA_SGB1(2); MLA_SGB1(2); MLA_SGB1(2); MLA_SGB1(2); MLA_SGB1(2); MLA_SGB1(2); MLA_SGB1(2); MLA_SGB1(3); MLA_SGB1(3); MLA_SGB1(3); MLA_SGB1(3); } while (0)
#define MLA_STEP(PX0, PX1, PY0, PY1, j) do { \
        const int kb1_ = 64 * ((j) + 1); \
        const bool a1_ = ((j) + 1 < NT) && (kb1_ <= qw + 31), a0_ = (64 * (j) <= qw + 31); \
        float alpha_ = 1.f; bf16x8 pb_[4]; \
        if (a1_) { \
            __builtin_amdgcn_sched_barrier(0); \
            qk_tile_free<12, 8, KS_M>(PY0, PY1, kl + (((j) + 1) & 1) * MLA_KB, q, ql); \
            alpha_ = sm_core(PX0, PX1, m, l); \
            pb_[0] = packp<0>(PX0); pb_[1] = packp<1>(PX0); pb_[2] = packp<0>(PX1); pb_[3] = packp<1>(PX1); \
            MLA_SGB(); \
            __builtin_amdgcn_sched_barrier(0); \
            if (kb1_ + 63 > qw) mla_mask(PY0, PY1, tq - kb1_ - 4 * hi); \
        } else if (a0_) { \
            alpha_ = sm_core(PX0, PX1, m, l); \
            pb_[0] = packp<0>(PX0); pb_[1] = packp<1>(PX0); pb_[2] = packp<0>(PX1); pb_[3] = packp<1>(PX1); \
        } \
        if (a0_) { \
            if (!__all(alpha_ == 1.f)) { _Pragma("unroll") for (int d_ = 0; d_ < 4; ++d_) _Pragma("unroll") for (int r_ = 0; r_ < 16; ++r_) o[d_][r_] *= alpha_; } \
            pv_tile(o, pb_, vl + ((j) & 1) * VB); \
        } \
        if ((j) + 2 < NT) MLA_STOREK((j) & 1); \
        if ((j) + 1 < NT) MLA_STOREV(((j) + 1) & 1); \
        if ((j) + 3 < NT) MLA_LOADK((j) + 3); \
        if ((j) + 2 < NT) MLA_LOADV((j) + 2); \
        __syncthreads(); } while (0)
    for (int j = 0; j < NT; j += 2) {
        MLA_STEP(pA0, pA1, pB0, pB1, j);
        MLA_STEP(pB0, pB1, pA0, pA1, j + 1);
    }
#undef MLA_STEP
#undef MLA_SGB
#undef MLA_SGB1
#undef MLA_LOADK
#undef MLA_LOADV
#undef MLA_STOREK
#undef MLA_STOREV
    const float inv = 1.f / l;
    const bf16* zp = P.Z + (size_t)tq * 2048 + head * 128 + 4 * hi;
    bf16* op = P.O + (size_t)tq * 4096 + head * 128 + 4 * hi;
#pragma unroll
    for (int d0 = 0; d0 < 4; ++d0)
#pragma unroll
        for (int rg = 0; rg < 4; ++rg) { const int dim = 32 * d0 + 8 * rg;
            const u32x2 z = *(const GAS u32x2*)(zp + dim);
            u32x2 w; w.x = pk2(o[d0][4 * rg + 0] * inv * bflo(z.x), o[d0][4 * rg + 1] * inv * bfhi(z.x)); w.y = pk2(o[d0][4 * rg + 2] * inv * bflo(z.y), o[d0][4 * rg + 3] * inv * bfhi(z.y));
            *(GAS u32x2*)(op + dim) = w; }
}

#else
#if defined(MLA_MXL)
struct MlaPtrs { const bf16* Q; const bf16* K; const bf16* V; const bf16* Z; bf16* O; };
__device__ __forceinline__ void mla_unit(LAS unsigned char* lds, const MlaPtrs& P, int head, int qb, int tid_in, int wave, int lane_in) {
    int tid = tid_in; asm volatile("" : "+v"(tid)); const int lane = tid & 63; (void)lane_in;
    const int r32 = lane & 31, hi = lane >> 5;
    const int q0 = qb * 256, qw = q0 + wave * 32, tq = qw + r32;
    i32x8 q[3];
    { const unsigned char* qp = (const unsigned char*)P.Q + (size_t)tq * 3072 + head * 192 + hi * 32;
#pragma unroll
      for (int s = 0; s < 3; ++s) { const u32x4 a = *(const GAS u32x4*)(qp + 64 * s), b = *(const GAS u32x4*)(qp + 64 * s + 16);
          q[s] = (i32x8){(int)a.x, (int)a.y, (int)a.z, (int)a.w, (int)b.x, (int)b.y, (int)b.z, (int)b.w}; } }
    const int NT = 4 * (qb + 1);
    const int srow = tid >> 3, sc8 = tid & 7;
    const unsigned char* kg = (const unsigned char*)P.K + (size_t)head * 192 + (size_t)srow * 3072 + sc8 * 8;
    const unsigned char* vg = (const unsigned char*)P.V + ((size_t)head * 128 + (tid >> 2)) * S + (tid & 3) * 16;
    LAS unsigned char* kst = lds + srow * KSX + sc8 * 8;
    LAS unsigned char* vst = lds + 2 * MLA_KBX + (tid >> 2) * VSX + (tid & 3) * 16;
    const LAS unsigned char* kl = lds + r32 * KSX + hi * 32;
    const LAS unsigned char* vl = lds + 2 * MLA_KBX + r32 * VSX + hi * 32;
    u32x2 sk0, sk1, sk2; u32x4 sv0;
#define MLA_LOAD(j) do { const unsigned char* kp_ = kg + (size_t)(j) * (64 * 3072); const unsigned char* vp_ = vg + (size_t)(j) * 64; \
        sk0 = *(const GAS u32x2*)(kp_); sk1 = *(const GAS u32x2*)(kp_ + 64); sk2 = *(const GAS u32x2*)(kp_ + 128); sv0 = *(const GAS u32x4*)(vp_); } while (0)
#define MLA_STORE(b, vb) do { LAS unsigned char* kd_ = kst + (b) * MLA_KBX; LAS unsigned char* vd_ = vst + (vb) * VBX; \
        *(LAS u32x2*)(kd_) = sk0; *(LAS u32x2*)(kd_ + 64) = sk1; *(LAS u32x2*)(kd_ + 128) = sk2; *(LAS u32x2*)(vd_) = (u32x2){sv0.x, sv0.y}; *(LAS u32x2*)(vd_ + 8) = (u32x2){sv0.z, sv0.w}; } while (0)
    MLA_LOAD(0); MLA_STORE(0, 0);
    __syncthreads();
    asm volatile("" : "+v"(q[0]), "+v"(q[1]), "+v"(q[2]));
    f32x16 o[5], mref;
#pragma unroll
    for (int d = 0; d < 5; ++d)
#pragma unroll
        for (int r = 0; r < 16; ++r) o[d][r] = 0.f;
#pragma unroll
    for (int r = 0; r < 16; ++r) mref[r] = 0.f;
    const int one8 = (r32 == 0 || r32 == 4) ? 0x38383838 : 0;
    const i32x8 ones = {one8, one8, one8, one8, one8, one8, one8, one8};
    const bool trail = wave >= 4;
    i32x8 pb = {};
    int vb_cur = 0, vb_prev = 2;
    for (int j = 0; j < NT; ++j) {
        const int kb = 64 * j;
        int vb_next = vb_cur + 1; if (vb_next == 3) vb_next = 0;
        if (j + 1 < NT) MLA_LOAD(j + 1);
        if (trail && j > 0 && kb - 64 <= qw + 31) pv_tilexl(o, pb, ones, vl + vb_prev * VBX);
        if (kb <= qw + 31) {
            f32x16 p0, p1;
            qk_tilexl(p0, p1, mref, kl + (j & 1) * MLA_KBX, q);
            if (kb + 63 > qw) {
                const int dq = tq - kb - 4 * hi;
#pragma unroll
                for (int r = 0; r < 16; ++r) { const int c = (r & 3) + 8 * (r >> 2);
                    if (c > dq) p0[r] = -__builtin_inff();
                    if (c + 32 > dq) p1[r] = -__builtin_inff(); }
            }
            float tm = p0[0];
#pragma unroll
            for (int r = 1; r < 16; ++r) tm = fmaxf(tm, p0[r]);
#pragma unroll
            for (int r = 0; r < 16; ++r) tm = fmaxf(tm, p1[r]);
            tm = swapmax(tm);
            if (j == 0 || !__all(tm <= MXL_T)) {
                const float dlt = (j == 0) ? tm : fmaxf(tm, 0.f);
                const float alpha = __builtin_amdgcn_exp2f(-dlt);
#pragma unroll
                for (int r = 0; r < 16; ++r) { p0[r] -= dlt; p1[r] -= dlt; mref[r] -= dlt; }
                if (j > 0) {
#pragma unroll
                    for (int d = 0; d < 5; ++d)
#pragma unroll
                        for (int r = 0; r < 16; ++r) o[d][r] *= alpha;
                }
            }
            pb = exp_packx(p0, p1, one8);
            if (!trail) pv_tilexl(o, pb, ones, vl + vb_cur * VBX);
        }
        if (j + 1 < NT) MLA_STORE((j + 1) & 1, vb_next);
        __syncthreads();
        vb_prev = vb_cur; vb_cur = vb_next;
    }
    if (trail && 64 * (NT - 1) <= qw + 31) pv_tilexl(o, pb, ones, vl + vb_prev * VBX);
    __syncthreads();
#undef MLA_LOAD
#undef MLA_STORE
    const float inv = 1.f / o[4][0];
    const bf16* zp = P.Z + (size_t)tq * 2048 + head * 128 + 4 * hi;
    bf16* op = P.O + (size_t)tq * 4096 + head * 128 + 4 * hi;
#pragma unroll
    for (int d0 = 0; d0 < 4; ++d0)
#pragma unroll
        for (int rg = 0; rg < 4; ++rg) { const int dim = 32 * d0 + 8 * rg;
            const u32x2 z = *(const GAS u32x2*)(zp + dim);
            u32x2 w; w.x = pk2(o[d0][4 * rg + 0] * inv * bflo(z.x), o[d0][4 * rg + 1] * inv * bfhi(z.x)); w.y = pk2(o[d0][4 * rg + 2] * inv * bflo(z.y), o[d0][4 * rg + 3] * inv * bfhi(z.y));
            *(GAS u32x2*)(op + dim) = w; }
}

#elif defined(MLA_MXP)
struct MlaPtrs { const bf16* Q; const bf16* K; const bf16* V; const bf16* Z; bf16* O; };
__device__ __forceinline__ void mla_maskx(f32x16& p0, f32x16& p1, int dq) {
#pragma unroll
    for (int r = 0; r < 16; ++r) { const int c = (r & 3) + 8 * (r >> 2);
        if (c > dq) p0[r] = -__builtin_inff();
        if (c + 32 > dq) p1[r] = -__builtin_inff(); }
}
__device__ __forceinline__ float mla_rowmax(const f32x16& p0, const f32x16& p1) {
    float tm = p0[0];
#pragma unroll
    for (int r = 1; r < 16; ++r) tm = fmaxf(tm, p0[r]);
#pragma unroll
    for (int r = 0; r < 16; ++r) tm = fmaxf(tm, p1[r]);
    return swapmax(tm);
}
#define MXP_EXP8(P, R0) do { _Pragma("unroll") for (int r_ = (R0); r_ < (R0) + 8; ++r_) { P[r_] = __builtin_amdgcn_exp2f(__builtin_fmaf(P[r_], QS_MLA, mc_)); ps_ += P[r_]; } } while (0)
__device__ __forceinline__ void mla_unit(LAS unsigned char* lds, const MlaPtrs& P, int head, int qb, int tid_in, int wave, int lane_in) {
    int tid = tid_in; asm volatile("" : "+v"(tid)); const int lane = tid & 63; (void)lane_in;
    const int r32 = lane & 31, hi = lane >> 5;
    const int q0 = qb * 256, qw = q0 + wave * 32, tq = qw + r32;
    i32x8 q[3];
    { const unsigned char* qp = (const unsigned char*)P.Q + (size_t)tq * 3072 + head * 192 + hi * 32;
#pragma unroll
      for (int s = 0; s < 3; ++s) { const u32x4 a = *(const GAS u32x4*)(qp + 64 * s), b = *(const GAS u32x4*)(qp + 64 * s + 16);
          q[s] = (i32x8){(int)a.x, (int)a.y, (int)a.z, (int)a.w, (int)b.x, (int)b.y, (int)b.z, (int)b.w}; } }
    const int NT = 4 * (qb + 1);
    const int srow = tid >> 3, sc8 = tid & 7;
    const unsigned char* kg = (const unsigned char*)P.K + (size_t)head * 192 + (size_t)srow * 3072 + sc8 * 8;
    const unsigned char* vg = (const unsigned char*)P.V + ((size_t)head * 128 + (tid >> 2)) * S + (tid & 3) * 16;
    LAS unsigned char* kst = lds + srow * KSX + sc8 * 8;
    LAS unsigned char* vst = lds + 2 * MLA_KBX + (tid >> 2) * VSX + (tid & 3) * 16;
    const LAS unsigned char* kl = lds + r32 * KSX + hi * 32;
    const LAS unsigned char* vl = lds + 2 * MLA_KBX + r32 * VSX + hi * 32;
    u32x2 sk0, sk1, sk2; u32x4 sv0;
#define MLA_LOADK(j) do { const unsigned char* kp_ = kg + (size_t)(j) * (64 * 3072); sk0 = *(const GAS u32x2*)(kp_); sk1 = *(const GAS u32x2*)(kp_ + 64); sk2 = *(const GAS u32x2*)(kp_ + 128); } while (0)
#define MLA_LOADV(j) do { sv0 = *(const GAS u32x4*)(vg + (size_t)(j) * 64); } while (0)
#define MLA_STOREK(b) do { LAS unsigned char* kd_ = kst + (b) * MLA_KBX; *(LAS u32x2*)(kd_) = sk0; *(LAS u32x2*)(kd_ + 64) = sk1; *(LAS u32x2*)(kd_ + 128) = sk2; } while (0)
#define MLA_STOREV(b) do { LAS unsigned char* vd_ = vst + (b) * VBX; *(LAS u32x2*)(vd_) = (u32x2){sv0.x, sv0.y}; *(LAS u32x2*)(vd_ + 8) = (u32x2){sv0.z, sv0.w}; } while (0)
    float m = -1e30f, l = 0.f; f32x16 o[4];
#pragma unroll
    for (int d = 0; d < 4; ++d)
#pragma unroll
        for (int r = 0; r < 16; ++r) o[d][r] = 0.f;
    f32x16 pA0, pA1, pB0, pB1;
    MLA_LOADK(0); MLA_LOADV(0); MLA_STOREK(0); MLA_STOREV(0);
    MLA_LOADK(1);
    __syncthreads();
    qk_tilex(pA0, pA1, kl, q);
    if (63 > qw) mla_maskx(pA0, pA1, tq - 4 * hi);
    MLA_STOREK(1);
    if (2 < NT) MLA_LOADK(2);
    MLA_LOADV(1);
    __syncthreads();
    asm volatile("" : "+v"(q[0]), "+v"(q[1]), "+v"(q[2]));
    float tmx = mla_rowmax(pA0, pA1);
#define SB() __builtin_amdgcn_sched_barrier(0)
#define MLA_SMHEAD() const float mn_ = fmaxf(m, tmx); const float alpha_ = __builtin_amdgcn_exp2f((m - mn_) * QS_MLA); m = mn_; const float mc_ = 8.f - mn_ * QS_MLA; float ps_ = 0.f; i32x8 pb_; \
            if (!__all(alpha_ == 1.f)) { _Pragma("unroll") for (int d_ = 0; d_ < 4; ++d_) _Pragma("unroll") for (int r_ = 0; r_ < 16; ++r_) o[d_][r_] *= alpha_; }
#define MXP_EXPK(P, R0, W0) do { MXP_EXP8(P, R0); \
        int w_ = __builtin_amdgcn_cvt_pk_fp8_f32(P[(R0) + 0], P[(R0) + 1], 0, false); pb_[(W0)] = __builtin_amdgcn_cvt_pk_fp8_f32(P[(R0) + 2], P[(R0) + 3], w_, true); \
        w_ = __builtin_amdgcn_cvt_pk_fp8_f32(P[(R0) + 4], P[(R0) + 5], 0, false); pb_[(W0) + 1] = __builtin_amdgcn_cvt_pk_fp8_f32(P[(R0) + 6], P[(R0) + 7], w_, true); } while (0)
#define MLA_SMTAIL() ps_ = swapsum(ps_); l = l * alpha_ + ps_
#define MFMA_T(acc, a, b) asm volatile("s_nop 1\n\tv_mfma_scale_f32_32x32x64_f8f6f4 %0, %1, %2, %0, %3, %3 op_sel_hi:[0,0,0]" : "+v"(acc) : "v"(a), "v"(b), "v"(sc1_))
#define MFMA_Z(acc, a, b) asm volatile("s_nop 1\n\tv_mfma_scale_f32_32x32x64_f8f6f4 %0, %1, %2, 0, %3, %3 op_sel_hi:[0,0,0]" : "=&v"(acc) : "v"(a), "v"(b), "v"(sc1_))
#define MLA_STEP(PX0, PX1, PY0, PY1, j) do { \
        const int kb1_ = 64 * ((j) + 1); \
        const bool a0_ = (64 * (j) <= qw + 31); \
        const LAS unsigned char* vj_ = vl + ((j) & 1) * VBX; \
        if (a0_) {                  \
            const LAS unsigned char* kn_ = kl + (((j) + 1) & 1) * MLA_KBX; \
            MLA_SMHEAD() \
            SB(); \
            i32x8 a0_f = ldsx(kn_), a1_f = ldsx(kn_ + 64); \
            MXP_EXPK(PX0, 0, 0); MXP_EXPK(PX0, 8, 2); \
            SB(); MFMA_Z(PY0, a0_f, q[0]); SB(); \
            a0_f = ldsx(kn_ + 128); \
            MXP_EXPK(PX1, 0, 4); \
            SB(); MFMA_T(PY0, a1_f, q[1]); SB(); \
            a1_f = ldsx(kn_ + 32 * KSX); \
            MXP_EXPK(PX1, 8, 6); \
            SB(); MFMA_T(PY0, a0_f, q[2]); SB(); \
            a0_f = ldsx(kn_ + 32 * KSX + 64); \
            MLA_SMTAIL(); \
            SB(); MFMA_Z(PY1, a1_f, q[0]); SB(); \
            a1_f = ldsx(vj_); \
            SB(); MFMA_T(PY1, a0_f, q[1]); SB(); \
            a0_f = ldsx(kn_ + 32 * KSX + 128); \
            SB(); MFMA_T(o[0], a1_f, pb_); SB(); \
            a1_f = ldsx(vj_ + 32 * VSX); \
            SB(); MFMA_T(PY1, a0_f, q[2]); SB(); \
            a0_f = ldsx(vj_ + 64 * VSX); \
            SB(); MFMA_T(o[1], a1_f, pb_); SB(); \
            a1_f = ldsx(vj_ + 96 * VSX); \
            SB(); MFMA_T(o[2], a0_f, pb_); SB(); \
            SB(); MFMA_T(o[3], a1_f, pb_); SB(); \
            if (kb1_ + 63 > qw) mla_maskx(PY0, PY1, tq - kb1_ - 4 * hi); \
            tmx = mla_rowmax(PY0, PY1); \
        } \
        if ((j) + 2 < NT) MLA_STOREK((j) & 1); \
        if ((j) + 1 < NT) MLA_STOREV(((j) + 1) & 1); \
        if ((j) + 3 < NT) MLA_LOADK((j) + 3); \
        if ((j) + 2 < NT) MLA_LOADV((j) + 2); \
        __syncthreads(); } while (0)
    int sc1_ = 0x7f7f7f7f; asm volatile("" : "+v"(sc1_));
    for (int j = 0; j < NT; j += 2) {
        MLA_STEP(pA0, pA1, pB0, pB1, j);
        MLA_STEP(pB0, pB1, pA0, pA1, j + 1);
    }
    asm volatile("s_nop 15\n\ts_nop 15" ::: "memory");
#undef MLA_STEP
#undef MLA_SMHEAD
#undef MLA_SMTAIL
#undef MXP_EXPK
#undef MFMA_T
#undef MFMA_Z
#undef SB
#undef MLA_LOADK
#undef MLA_LOADV
#undef MLA_STOREK
#undef MLA_STOREV
    const float inv = 1.f / l;
    const bf16* zp = P.Z + (size_t)tq * 2048 + head * 128 + 4 * hi;
    bf16* op = P.O + (size_t)tq * 4096 + head * 128 + 4 * hi;
#pragma unroll
    for (int d0 = 0; d0 < 4; ++d0)
#pragma unroll
        for (int rg = 0; rg < 4; ++rg) { const int dim = 32 * d0 + 8 * rg;
            const u32x2 z = *(const GAS u32x2*)(zp + dim);
            u32x2 w; w.x = pk2(o[d0][4 * rg + 0] * inv * bflo(z.x), o[d0][4 * rg + 1] * inv * bfhi(z.x)); w.y = pk2(o[d0][4 * rg + 2] * inv * bflo(z.y), o[d0][4 * rg + 3] * inv * bfhi(z.y));
            *(GAS u32x2*)(op + dim) = w; }
}
#undef MXP_EXP8

#elif defined(MLA_MX)
struct MlaPtrs { const bf16* Q; const bf16* K; const bf16* V; const bf16* Z; bf16* O; };
__device__ __forceinline__ void mla_unit(LAS unsigned char* lds, const MlaPtrs& P, int head, int qb, int tid_in, int wave, int lane_in) {
    int tid = tid_in; asm volatile("" : "+v"(tid)); const int lane = tid & 63; (void)lane_in;
    const int r32 = lane & 31, hi = lane >> 5;
    const int q0 = qb * 256, qw = q0 + wave * 32, tq = qw + r32;
    i32x8 q[3];
    { const unsigned char* qp = (const unsigned char*)P.Q + (size_t)tq * 3072 + head * 192 + hi * 32;
#pragma unroll
      for (int s = 0; s < 3; ++s) { const u32x4 a = *(const GAS u32x4*)(qp + 64 * s), b = *(const GAS u32x4*)(qp + 64 * s + 16);
          q[s] = (i32x8){(int)a.x, (int)a.y, (int)a.z, (int)a.w, (int)b.x, (int)b.y, (int)b.z, (int)b.w}; } }
    const int NT = 4 * (qb + 1);
    const int srow = tid >> 3, sc8 = tid & 7;
    const unsigned char* kg = (const unsigned char*)P.K + (size_t)head * 192 + (size_t)srow * 3072 + sc8 * 8;
    const unsigned char* vg = (const unsigned char*)P.V + ((size_t)head * 128 + (tid >> 2)) * S + (tid & 3) * 16;
    LAS unsigned char* kst = lds + srow * KSX + sc8 * 8;
    LAS unsigned char* vst = lds + 2 * MLA_KBX + (tid >> 2) * VSX + (tid & 3) * 16;
    const LAS unsigned char* kl = lds + r32 * KSX + hi * 32;
    const LAS unsigned char* vl = lds + 2 * MLA_KBX + r32 * VSX + hi * 32;
    u32x2 sk0, sk1, sk2; u32x4 sv0;
#define MLA_LOAD(j) do { const unsigned char* kp_ = kg + (size_t)(j) * (64 * 3072); const unsigned char* vp_ = vg + (size_t)(j) * 64; \
        sk0 = *(const GAS u32x2*)(kp_); sk1 = *(const GAS u32x2*)(kp_ + 64); sk2 = *(const GAS u32x2*)(kp_ + 128); sv0 = *(const GAS u32x4*)(vp_); } while (0)
#define MLA_STORE(b, vb) do { LAS unsigned char* kd_ = kst + (b) * MLA_KBX; LAS unsigned char* vd_ = vst + (vb) * VBX; \
        *(LAS u32x2*)(kd_) = sk0; *(LAS u32x2*)(kd_ + 64) = sk1; *(LAS u32x2*)(kd_ + 128) = sk2; *(LAS u32x2*)(vd_) = (u32x2){sv0.x, sv0.y}; *(LAS u32x2*)(vd_ + 8) = (u32x2){sv0.z, sv0.w}; } while (0)
    MLA_LOAD(0); MLA_STORE(0, 0);
    __syncthreads();
    asm volatile("" : "+v"(q[0]), "+v"(q[1]), "+v"(q[2]));
    float m = -1e30f, l = 0.f; f32x16 o[4];
#pragma unroll
    for (int d = 0; d < 4; ++d)
#pragma unroll
        for (int r = 0; r < 16; ++r) o[d][r] = 0.f;
    const bool trail = wave >= 4;
    i32x8 pb = {};
    int vb_cur = 0, vb_prev = 2;
    for (int j = 0; j < NT; ++j) {
        const int kb = 64 * j;
        int vb_next = vb_cur + 1; if (vb_next == 3) vb_next = 0;
        if (j + 1 < NT) MLA_LOAD(j + 1);
        if (trail && j > 0 && kb - 64 <= qw + 31) pv_tilex(o, pb, vl + vb_prev * VBX);
        if (kb <= qw + 31) {
            f32x16 p0, p1;
            qk_tilex(p0, p1, kl + (j & 1) * MLA_KBX, q);
            if (kb + 63 > qw) {
                const int dq = tq - kb - 4 * hi;
#pragma unroll
                for (int r = 0; r < 16; ++r) { const int c = (r & 3) + 8 * (r >> 2);
                    if (c > dq) p0[r] = -__builtin_inff();
                    if (c + 32 > dq) p1[r] = -__builtin_inff(); }
            }
            online_sm_x(p0, p1, m, l, o, QS_MLA);
            pb = packpx(p0, p1);
            if (!trail) pv_tilex(o, pb, vl + vb_cur * VBX);
        }
        if (j + 1 < NT) MLA_STORE((j + 1) & 1, vb_next);
        __syncthreads();
        vb_prev = vb_cur; vb_cur = vb_next;
    }
    if (trail && 64 * (NT - 1) <= qw + 31) pv_tilex(o, pb, vl + vb_prev * VBX);
    __syncthreads();
#undef MLA_LOAD
#undef MLA_STORE
    const float inv = 1.f / l;
    const bf16* zp = P.Z + (size_t)tq * 2048 + head * 128 + 4 * hi;
    bf16* op = P.O + (size_t)tq * 4096 + head * 128 + 4 * hi;
#pragma unroll
    for (int d0 = 0; d0 < 4; ++d0)
#pragma unroll
        for (int rg = 0; rg < 4; ++rg) { const int dim = 32 * d0 + 8 * rg;
            const u32x2 z = *(const GAS u32x2*)(zp + dim);
            u32x2 w; w.x = pk2(o[d0][4 * rg + 0] * inv * bflo(z.x), o[d0][4 * rg + 1] * inv * bfhi(z.x)); w.y = pk2(o[d0][4 * rg + 2] * inv * bflo(z.y), o[d0][4 * rg + 3] * inv * bfhi(z.y));
            *(GAS u32x2*)(op + dim) = w; }
}

#elif defined(MLA_BIG)
struct MlaPtrs { const bf16* Q; const bf16* K; const bf16* V; const bf16* Z; bf16* O; };
__device__ __forceinline__ void mla_unit(LAS unsigned char* lds, const MlaPtrs& P, int head, int qb, int tid_in, int wave, int lane_in) {
    int tid = tid_in; asm volatile("" : "+v"(tid)); const int lane = tid & 63; (void)lane_in;
    const int r32 = lane & 31, hi = lane >> 5;
    const int q0 = qb * 256, qw = q0 + wave * 32, tq = qw + r32;
    i64 q[12];
    { const unsigned char* qp = (const unsigned char*)P.Q + (size_t)tq * 3072 + head * 192 + hi * 8;
#pragma unroll
      for (int d0 = 0; d0 < 12; ++d0) q[d0] = *(const GAS i64*)(qp + d0 * 16); }
    const int NT = 4 * (qb + 1), NTB = NT / 2;
    const int srow = tid >> 3, sc8 = tid & 7;
    const unsigned char* kg = (const unsigned char*)P.K + (size_t)head * 192 + (size_t)srow * 3072 + sc8 * 8;
    const unsigned char* vg = (const unsigned char*)P.V + ((size_t)head * 128 + (tid >> 2)) * S + (tid & 3) * 32;
    LAS unsigned char* kst = lds + srow * KS8 + sc8 * 8;
    LAS unsigned char* vst = lds + 2 * MLA_KB8B + (tid >> 2) * VS8B + (tid & 3) * 32;
    const LAS unsigned char* kl = lds + r32 * KS8 + hi * 8;
    const LAS unsigned char* vl = lds + 2 * MLA_KB8B + r32 * VS8B + hi * 8;
    u32x2 sk0, sk1, sk2, sk3, sk4, sk5; u32x4 sv0, sv1;
#define MLA_LOAD(J) do { const unsigned char* kp_ = kg + (size_t)(J) * (128 * 3072); const unsigned char* vp_ = vg + (size_t)(J) * 128; \
        sk0 = *(const GAS u32x2*)(kp_); sk1 = *(const GAS u32x2*)(kp_ + 64); sk2 = *(const GAS u32x2*)(kp_ + 128); \
        sk3 = *(const GAS u32x2*)(kp_ + 64 * 3072); sk4 = *(const GAS u32x2*)(kp_ + 64 * 3072 + 64); sk5 = *(const GAS u32x2*)(kp_ + 64 * 3072 + 128); \
        sv0 = *(const GAS u32x4*)(vp_); sv1 = *(const GAS u32x4*)(vp_ + 16); } while (0)
#define MLA_STORE(b, vb) do { LAS unsigned char* kd_ = kst + (b) * MLA_KB8B; LAS unsigned char* vd_ = vst + (vb) * VB8B; \
        *(LAS u32x2*)(kd_) = sk0; *(LAS u32x2*)(kd_ + 64) = sk1; *(LAS u32x2*)(kd_ + 128) = sk2; \
        *(LAS u32x2*)(kd_ + 64 * KS8) = sk3; *(LAS u32x2*)(kd_ + 64 * KS8 + 64) = sk4; *(LAS u32x2*)(kd_ + 64 * KS8 + 128) = sk5; \
        *(LAS u32x2*)(vd_) = (u32x2){sv0.x, sv0.y}; *(LAS u32x2*)(vd_ + 8) = (u32x2){sv0.z, sv0.w}; *(LAS u32x2*)(vd_ + 16) = (u32x2){sv1.x, sv1.y}; *(LAS u32x2*)(vd_ + 24) = (u32x2){sv1.z, sv1.w}; } while (0)
    MLA_LOAD(0); MLA_STORE(0, 0);
    __syncthreads();
    float m = -1e30f, l = 0.f; f32x16 o[4];
#pragma unroll
    for (int d = 0; d < 4; ++d)
#pragma unroll
        for (int r = 0; r < 16; ++r) o[d][r] = 0.f;
    const bool trail = wave >= 4;
    i64 pb[4] = {};
    int vb_cur = 0, vb_prev = 2;
    for (int J = 0; J < NTB; ++J) {
        int vb_next = vb_cur + 1; if (vb_next == 3) vb_next = 0;
        if (J + 1 < NTB) MLA_LOAD(J + 1);
#pragma unroll
        for (int sub = 0; sub < 2; ++sub) {
            const int j = 2 * J + sub, kb = 64 * j;
            if (trail && j > 0 && kb - 64 <= qw + 31) pv_tile8(o, pb, vl + (sub == 0 ? vb_prev * VB8B + 64 : vb_cur * VB8B));
            if (kb <= qw + 31) {
                f32x16 p0, p1;
                qk_tile8<12>(p0, p1, kl + (J & 1) * MLA_KB8B + sub * 64 * KS8, q);
                if (kb + 63 > qw) {
                    const int dq = tq - kb - 4 * hi;
#pragma unroll
                    for (int r = 0; r < 16; ++r) { const int c = (r & 3) + 8 * (r >> 2);
                        if (c > dq) p0[r] = -__builtin_inff();
                        if (c + 32 > dq) p1[r] = -__builtin_inff(); }
                }
                online_sm_scaled(p0, p1, m, l, o, QS_MLA);
                pb[0] = packp8<0>(p0); pb[1] = packp8<1>(p0); pb[2] = packp8<0>(p1); pb[3] = packp8<1>(p1);
                if (!trail) pv_tile8(o, pb, vl + vb_cur * VB8B + sub * 64);
            }
        }
        if (J + 1 < NTB) MLA_STORE((J + 1) & 1, vb_next);
        __syncthreads();
        vb_prev = vb_cur; vb_cur = vb_next;
    }
    if (trail && 64 * (NT - 1) <= qw + 31) pv_tile8(o, pb, vl + vb_prev * VB8B + 64);
    __syncthreads();
#undef MLA_LOAD
#undef MLA_STORE
    const float inv = (1.f / 256.f) / l;
    const bf16* zp = P.Z + (size_t)tq * 2048 + head * 128 + 4 * hi;
    bf16* op = P.O + (size_t)tq * 4096 + head * 128 + 4 * hi;
#pragma unroll
    for (int d0 = 0; d0 < 4; ++d0)
#pragma unroll
        for (int rg = 0; rg < 4; ++rg) { const int dim = 32 * d0 + 8 * rg;
            const u32x2 z = *(const GAS u32x2*)(zp + dim);
            u32x2 w; w.x = pk2(o[d0][4 * rg + 0] * inv * bflo(z.x), o[d0][4 * rg + 1] * inv * bfhi(z.x)); w.y = pk2(o[d0][4 * rg + 2] * inv * bflo(z.y), o[d0][4 * rg + 3] * inv * bfhi(z.y));
            *(GAS u32x2*)(op + dim) = w; }
}

#elif defined(MLA_FP8V)
struct MlaPtrs { const bf16* Q; const bf16* K; const bf16* V; const bf16* Z; bf16* O; };
__device__ __forceinline__ void mla_unit(LAS unsigned char* lds, const MlaPtrs& P, int head, int qb, int tid_in, int wave, int lane_in) {
    int tid = tid_in; asm volatile("" : "+v"(tid)); const int lane = tid & 63; (void)lane_in;
    const int r32 = lane & 31, hi = lane >> 5;
    const int q0 = qb * 256, qw = q0 + wave * 32, tq = qw + r32;
    i64 q[12];
    { const unsigned char* qp = (const unsigned char*)P.Q + (size_t)tq * 3072 + head * 192 + hi * 8;
#pragma unroll
      for (int d0 = 0; d0 < 12; ++d0) q[d0] = *(const GAS i64*)(qp + d0 * 16); }
    const int NT = 4 * (qb + 1);
    const int srow = tid >> 3, sc8 = tid & 7;
    const unsigned char* kg = (const unsigned char*)P.K + (size_t)head * 192 + (size_t)srow * 3072 + sc8 * 8;
    const unsigned char* vg = (const unsigned char*)P.V + ((size_t)head * 128 + (tid >> 2)) * S + (tid & 3) * 16;
    LAS unsigned char* kst = lds + srow * KS8 + sc8 * 8;
    LAS unsigned char* vst = lds + 2 * MLA_KB8 + (tid >> 2) * VS8 + (tid & 3) * 16;
    const LAS unsigned char* kl = lds + r32 * KS8 + hi * 8;
    const LAS unsigned char* vl = lds + 2 * MLA_KB8 + r32 * VS8 + hi * 8;
    u32x2 sk0, sk1, sk2; u32x4 sv0;
#define MLA_LOAD(j) do { const unsigned char* kp_ = kg + (size_t)(j) * (64 * 3072); const unsigned char* vp_ = vg + (size_t)(j) * 64; \
        sk0 = *(const GAS u32x2*)(kp_); sk1 = *(const GAS u32x2*)(kp_ + 64); sk2 = *(const GAS u32x2*)(kp_ + 128); sv0 = *(const GAS u32x4*)(vp_); } while (0)
#define MLA_STORE(b, vb) do { LAS unsigned char* kd_ = kst + (b) * MLA_KB8; LAS unsigned char* vd_ = vst + (vb) * VB8; \
        *(LAS u32x2*)(kd_) = sk0; *(LAS u32x2*)(kd_ + 64) = sk1; *(LAS u32x2*)(kd_ + 128) = sk2; *(LAS u32x2*)(vd_) = (u32x2){sv0.x, sv0.y}; *(LAS u32x2*)(vd_ + 8) = (u32x2){sv0.z, sv0.w}; } while (0)
    MLA_LOAD(0); MLA_STORE(0, 0);
    __syncthreads();
    float m = -1e30f, l = 0.f; f32x16 o[4];
#pragma unroll
    for (int d = 0; d < 4; ++d)
#pragma unroll
        for (int r = 0; r < 16; ++r) o[d][r] = 0.f;
    const bool trail = wave >= 4;
    i64 pb[4] = {};
    int vb_cur = 0, vb_prev = 2;
    for (int j = 0; j < NT; ++j) {
        const int kb = 64 * j;
        int vb_next = vb_cur + 1; if (vb_next == 3) vb_next = 0;
        if (j + 1 < NT) MLA_LOAD(j + 1);
        if (trail && j > 0 && kb - 64 <= qw + 31) pv_tile8(o, pb, vl + vb_prev * VB8);
        if (kb <= qw + 31) {
            f32x16 p0, p1;
#ifdef PROBE_QKM2
            { f32x16 r0, r1; qk_tile_m2<12, KS_M>(p0, p1, r0, r1, kl + (j & 1) * MLA_KB, q);
#pragma unroll
              for (int r = 0; r < 16; ++r) { p0[r] = (p0[r] + r0[r]) * 0.5f; p1[r] = (p1[r] + r1[r]) * 0.5f; } }
#else
            qk_tile8<12>(p0, p1, kl + (j & 1) * MLA_KB8, q);
#endif
#ifdef PROBE_QK2
            { f32x16 r0, r1; asm volatile("" ::: "memory"); qk_tile<12, KS_M>(r0, r1, kl + (j & 1) * MLA_KB, q);
#pragma unroll
              for (int r = 0; r < 16; ++r) { p0[r] = (p0[r] + r0[r]) * 0.5f; p1[r] = (p1[r] + r1[r]) * 0.5f; } }
#endif
#ifdef PROBE_SM2
            { float acc_ = 0.f;
#pragma unroll
              for (int r = 0; r < 16; ++r) { acc_ += __builtin_amdgcn_exp2f(p0[r] - m - 40.f) + __builtin_amdgcn_exp2f(p1[r] - m - 40.f); }
#pragma unroll
              for (int r = 0; r < 16; ++r) { acc_ += __builtin_amdgcn_exp2f(p0[r] - m - 50.f) + __builtin_amdgcn_exp2f(p1[r] - m - 50.f); }
              if (acc_ == 12345.678f) l += 1.f; }
#endif
            if (kb + 63 > qw) {
                const int dq = tq - kb - 4 * hi;
#pragma unroll
                for (int r = 0; r < 16; ++r) { const int c = (r & 3) + 8 * (r >> 2);
                    if (c > dq) p0[r] = -__builtin_inff();
                    if (c + 32 > dq) p1[r] = -__builtin_inff(); }
            }
            online_sm_scaled(p0, p1, m, l, o, QS_MLA);
            pb[0] = packp8<0>(p0); pb[1] = packp8<1>(p0); pb[2] = packp8<0>(p1); pb[3] = packp8<1>(p1);
            if (!trail) pv_tile8(o, pb, vl + vb_cur * VB8);
        }
        if (j + 1 < NT) MLA_STORE((j + 1) & 1, vb_next);
        __syncthreads();
        vb_prev = vb_cur; vb_cur = vb_next;
    }
    if (trail && 64 * (NT - 1) <= qw + 31) pv_tile8(o, pb, vl + vb_prev * VB8);
    __syncthreads();
#undef MLA_LOAD
#undef MLA_STORE
    const float inv = (1.f / 256.f) / l;
    const bf16* zp = P.Z + (size_t)tq * 2048 + head * 128 + 4 * hi;
    bf16* op = P.O + (size_t)tq * 4096 + head * 128 + 4 * hi;
#pragma unroll
    for (int d0 = 0; d0 < 4; ++d0)
#pragma unroll
        for (int rg = 0; rg < 4; ++rg) { const int dim = 32 * d0 + 8 * rg;
            const u32x2 z = *(const GAS u32x2*)(zp + dim);
            u32x2 w; w.x = pk2(o[d0][4 * rg + 0] * inv * bflo(z.x), o[d0][4 * rg + 1] * inv * bfhi(z.x)); w.y = pk2(o[d0][4 * rg + 2] * inv * bflo(z.y), o[d0][4 * rg + 3] * inv * bfhi(z.y));
            *(GAS u32x2*)(op + dim) = w; }
}

#elif defined(MLA_FP8)
struct MlaPtrs { const bf16* Q; const bf16* K; const bf16* V; const bf16* Z; bf16* O; };
__device__ __forceinline__ void mla_unit(LAS unsigned char* lds, const MlaPtrs& P, int head, int qb, int tid_in, int wave, int lane_in) {
    int tid = tid_in; asm volatile("" : "+v"(tid)); const int lane = tid & 63; (void)lane_in;
    const int r32 = lane & 31, hi = lane >> 5;
    const int q0 = qb * 256, qw = q0 + wave * 32, tq = qw + r32;
    i64 q[12];
    { const unsigned char* qp = (const unsigned char*)P.Q + (size_t)tq * 3072 + head * 192 + hi * 8;
#pragma unroll
      for (int d0 = 0; d0 < 12; ++d0) q[d0] = *(const GAS i64*)(qp + d0 * 16); }
    const int NT = 4 * (qb + 1);
    const int srow = tid >> 3, sc8 = tid & 7;
    const unsigned char* kg = (const unsigned char*)P.K + (size_t)head * 192 + (size_t)srow * 3072 + sc8 * 8;
    const unsigned char* vg = (const unsigned char*)P.V + (size_t)head * 256 + (size_t)srow * 4096 + sc8 * 16;
    LAS unsigned char* kst = lds + srow * KS8 + sc8 * 8;
    LAS unsigned char* vst = lds + 2 * MLA_KB8 + srow * VS + sc8 * 16;
    const LAS unsigned char* kl = lds + r32 * KS8 + hi * 8;
    const LAS unsigned char* vl = lds + 2 * MLA_KB8 + (4 * hi + ((lane & 15) >> 2)) * VS + (16 * ((lane >> 4) & 1) + 4 * (lane & 3)) * 2;
    u32x2 sk0, sk1, sk2; u32x4 sv0, sv1;
#define MLA_LOAD(j) do { const unsigned char* kp_ = kg + (size_t)(j) * (64 * 3072); const unsigned char* vp_ = vg + (size_t)(j) * (64 * 4096); \
        sk0 = *(const GAS u32x2*)(kp_); sk1 = *(const GAS u32x2*)(kp_ + 64); sk2 = *(const GAS u32x2*)(kp_ + 128); sv0 = *(const GAS u32x4*)(vp_); sv1 = *(const GAS u32x4*)(vp_ + 128); } while (0)
#define MLA_STORE(b, vb) do { LAS unsigned char* kd_ = kst + (b) * MLA_KB8; LAS unsigned char* vd_ = vst + (vb) * VB; \
        *(LAS u32x2*)(kd_) = sk0; *(LAS u32x2*)(kd_ + 64) = sk1; *(LAS u32x2*)(kd_ + 128) = sk2; *(LAS u32x4*)(vd_) = sv0; *(LAS u32x4*)(vd_ + 128) = sv1; } while (0)
    MLA_LOAD(0); MLA_STORE(0, 0);
    __syncthreads();
    float m = -1e30f, l = 0.f; f32x16 o[4];
#pragma unroll
    for (int d = 0; d < 4; ++d)
#pragma unroll
        for (int r = 0; r < 16; ++r) o[d][r] = 0.f;
    const bool trail = wave >= 4;
    bf16x8 pb[4] = {};
    int vb_cur = 0, vb_prev = 2;
    for (int j = 0; j < NT; ++j) {
        const int kb = 64 * j;
        int vb_next = vb_cur + 1; if (vb_next == 3) vb_next = 0;
        if (j + 1 < NT) MLA_LOAD(j + 1);
        if (trail && j > 0 && kb - 64 <= qw + 31) pv_tile(o, pb, vl + vb_prev * VB);
        if (kb <= qw + 31) {
            f32x16 p0, p1;
#ifdef PROBE_QKM2
            { f32x16 r0, r1; qk_tile_m2<12, KS_M>(p0, p1, r0, r1, kl + (j & 1) * MLA_KB, q);
#pragma unroll
              for (int r = 0; r < 16; ++r) { p0[r] = (p0[r] + r0[r]) * 0.5f; p1[r] = (p1[r] + r1[r]) * 0.5f; } }
#else
            qk_tile8<12>(p0, p1, kl + (j & 1) * MLA_KB8, q);
#endif
#ifdef PROBE_QK2
            { f32x16 r0, r1; asm volatile("" ::: "memory"); qk_tile<12, KS_M>(r0, r1, kl + (j & 1) * MLA_KB, q);
#pragma unroll
              for (int r = 0; r < 16; ++r) { p0[r] = (p0[r] + r0[r]) * 0.5f; p1[r] = (p1[r] + r1[r]) * 0.5f; } }
#endif
#ifdef PROBE_SM2
            { float acc_ = 0.f;
#pragma unroll
              for (int r = 0; r < 16; ++r) { acc_ += __builtin_amdgcn_exp2f(p0[r] - m - 40.f) + __builtin_amdgcn_exp2f(p1[r] - m - 40.f); }
#pragma unroll
              for (int r = 0; r < 16; ++r) { acc_ += __builtin_amdgcn_exp2f(p0[r] - m - 50.f) + __builtin_amdgcn_exp2f(p1[r] - m - 50.f); }
              if (acc_ == 12345.678f) l += 1.f; }
#endif
            if (kb + 63 > qw) {
                const int dq = tq - kb - 4 * hi;
#pragma unroll
                for (int r = 0; r < 16; ++r) { const int c = (r & 3) + 8 * (r >> 2);
                    if (c > dq) p0[r] = -__builtin_inff();
                    if (c + 32 > dq) p1[r] = -__builtin_inff(); }
            }
            online_sm_scaled(p0, p1, m, l, o, QS_MLA);
            pb[0] = packp<0>(p0); pb[1] = packp<1>(p0); pb[2] = packp<0>(p1); pb[3] = packp<1>(p1);
            if (!trail) pv_tile(o, pb, vl + vb_cur * VB);
        }
        if (j + 1 < NT) MLA_STORE((j + 1) & 1, vb_next);
        __syncthreads();
        vb_prev = vb_cur; vb_cur = vb_next;
    }
    if (trail && 64 * (NT - 1) <= qw + 31) pv_tile(o, pb, vl + vb_prev * VB);
    __syncthreads();
#undef MLA_LOAD
#undef MLA_STORE
    const float inv = 1.f / l;
    const bf16* zp = P.Z + (size_t)tq * 2048 + head * 128 + 4 * hi;
    bf16* op = P.O + (size_t)tq * 4096 + head * 128 + 4 * hi;
#pragma unroll
    for (int d0 = 0; d0 < 4; ++d0)
#pragma unroll
        for (int rg = 0; rg < 4; ++rg) { const int dim = 32 * d0 + 8 * rg;
            const u32x2 z = *(const GAS u32x2*)(zp + dim);
            u32x2 w; w.x = pk2(o[d0][4 * rg + 0] * inv * bflo(z.x), o[d0][4 * rg + 1] * inv * bfhi(z.x)); w.y = pk2(o[d0][4 * rg + 2] * inv * bflo(z.y), o[d0][4 * rg + 3] * inv * bfhi(z.y));
            *(GAS u32x2*)(op + dim) = w; }
}

#else
struct MlaPtrs { const bf16* Q; const bf16* K; const bf16* V; const bf16* Z; bf16* O; };
__device__ __forceinline__ void mla_unit(LAS unsigned char* lds, const MlaPtrs& P, int head, int qb, int tid_in, int wave, int lane_in) {
    int tid = tid_in; asm volatile("" : "+v"(tid)); const int lane = tid & 63; (void)lane_in;
    const int r32 = lane & 31, hi = lane >> 5;
    const int q0 = qb * 256, qw = q0 + wave * 32, tq = qw + r32;
    bf16x8 q[12];
    { const bf16* qp = P.Q + (size_t)tq * 3072 + head * 192 + hi * 8;
#pragma unroll
      for (int d0 = 0; d0 < 12; ++d0) q[d0] = *(const GAS bf16x8*)(qp + d0 * 16); }
    const int NT = 4 * (qb + 1);
    const int srow = tid >> 3, sc8 = tid & 7;
    const unsigned char* kg = (const unsigned char*)P.K + (size_t)head * 384 + (size_t)srow * 6144 + sc8 * 16;
    const unsigned char* vg = (const unsigned char*)P.V + (size_t)head * 256 + (size_t)srow * 4096 + sc8 * 16;
    LAS unsigned char* kst = lds + srow * KS_M + sc8 * 16;
    LAS unsigned char* vst = lds + 2 * MLA_KB + srow * VS + sc8 * 16;
    const LAS unsigned char* kl = lds + r32 * KS_M + hi * 16;
    const LAS unsigned char* vl = lds + 2 * MLA_KB + (4 * hi + ((lane & 15) >> 2)) * VS + (16 * ((lane >> 4) & 1) + 4 * (lane & 3)) * 2;
    u32x4 sk0, sk1, sk2, sv0, sv1;
#define MLA_LOAD(j) do { const unsigned char* kp_ = kg + (size_t)(j) * (64 * 6144); const unsigned char* vp_ = vg + (size_t)(j) * (64 * 4096); \
        sk0 = *(const GAS u32x4*)(kp_); sk1 = *(const GAS u32x4*)(kp_ + 128); sk2 = *(const GAS u32x4*)(kp_ + 256); sv0 = *(const GAS u32x4*)(vp_); sv1 = *(const GAS u32x4*)(vp_ + 128); } while (0)
#define MLA_STORE(b, vb) do { LAS unsigned char* kd_ = kst + (b) * MLA_KB; LAS unsigned char* vd_ = vst + (vb) * VB; \
        *(LAS u32x4*)(kd_) = sk0; *(LAS u32x4*)(kd_ + 128) = sk1; *(LAS u32x4*)(kd_ + 256) = sk2; *(LAS u32x4*)(vd_) = sv0; *(LAS u32x4*)(vd_ + 128) = sv1; } while (0)
    MLA_LOAD(0); MLA_STORE(0, 0);
    __syncthreads();
    float m = -1e30f, l = 0.f; f32x16 o[4];
#pragma unroll
    for (int d = 0; d < 4; ++d)
#pragma unroll
        for (int r = 0; r < 16; ++r) o[d][r] = 0.f;
    const bool trail = wave >= 4;
    bf16x8 pb[4] = {};
    int vb_cur = 0, vb_prev = 2;
    for (int j = 0; j < NT; ++j) {
        const int kb = 64 * j;
        int vb_next = vb_cur + 1; if (vb_next == 3) vb_next = 0;
        if (j + 1 < NT) MLA_LOAD(j + 1);
        if (trail && j > 0 && kb - 64 <= qw + 31) pv_tile(o, pb, vl + vb_prev * VB);
        if (kb <= qw + 31) {
            f32x16 p0, p1;
#ifdef PROBE_QKM2
            { f32x16 r0, r1; qk_tile_m2<12, KS_M>(p0, p1, r0, r1, kl + (j & 1) * MLA_KB, q);
#pragma unroll
              for (int r = 0; r < 16; ++r) { p0[r] = (p0[r] + r0[r]) * 0.5f; p1[r] = (p1[r] + r1[r]) * 0.5f; } }
#else
            qk_tile<12, KS_M>(p0, p1, kl + (j & 1) * MLA_KB, q);
#endif
#ifdef PROBE_QK2
            { f32x16 r0, r1; asm volatile("" ::: "memory"); qk_tile<12, KS_M>(r0, r1, kl + (j & 1) * MLA_KB, q);
#pragma unroll
              for (int r = 0; r < 16; ++r) { p0[r] = (p0[r] + r0[r]) * 0.5f; p1[r] = (p1[r] + r1[r]) * 0.5f; } }
#endif
#ifdef PROBE_SM2
            { float acc_ = 0.f;
#pragma unroll
              for (int r = 0; r < 16; ++r) { acc_ += __builtin_amdgcn_exp2f(p0[r] - m - 40.f) + __builtin_amdgcn_exp2f(p1[r] - m - 40.f); }
#pragma unroll
              for (int r = 0; r < 16; ++r) { acc_ += __builtin_amdgcn_exp2f(p0[r] - m - 50.f) + __builtin_amdgcn_exp2f(p1[r] - m - 50.f); }
              if (acc_ == 12345.678f) l += 1.f; }
#endif
            if (kb + 63 > qw) {
                const int dq = tq - kb - 4 * hi;
#pragma unroll
                for (int r = 0; r < 16; ++r) { const int c = (r & 3) + 8 * (r >> 2);
                    if (c > dq) p0[r] = -__builtin_inff();
                    if (c + 32 > dq) p1[r] = -__builtin_inff(); }
            }
            online_sm(p0, p1, m, l, o);
            pb[0] = packp<0>(p0); pb[1] = packp<1>(p0); pb[2] = packp<0>(p1); pb[3] = packp<1>(p1);
            if (!trail) pv_tile(o, pb, vl + vb_cur * VB);
        }
        if (j + 1 < NT) MLA_STORE((j + 1) & 1, vb_next);
        __syncthreads();
        vb_prev = vb_cur; vb_cur = vb_next;
    }
    if (trail && 64 * (NT - 1) <= qw + 31) pv_tile(o, pb, vl + vb_prev * VB);
    __syncthreads();
#undef MLA_LOAD
#undef MLA_STORE
    const float inv = 1.f / l;
    const bf16* zp = P.Z + (size_t)tq * 2048 + head * 128 + 4 * hi;
    bf16* op = P.O + (size_t)tq * 4096 + head * 128 + 4 * hi;
#pragma unroll
    for (int d0 = 0; d0 < 4; ++d0)
#pragma unroll
        for (int rg = 0; rg < 4; ++rg) { const int dim = 32 * d0 + 8 * rg;
            const u32x2 z = *(const GAS u32x2*)(zp + dim);
            u32x2 w; w.x = pk2(o[d0][4 * rg + 0] * inv * bflo(z.x), o[d0][4 * rg + 1] * inv * bfhi(z.x)); w.y = pk2(o[d0][4 * rg + 2] * inv * bflo(z.y), o[d0][4 * rg + 3] * inv * bfhi(z.y));
            *(GAS u32x2*)(op + dim) = w; }
}

#endif
#endif
struct NsaPtrs { const bf16* Q; const bf16* KV; const bf16* KC; const bf16* VC; const bf16* Z; const float* G; bf16* O; float* scr; };
template <int MODE>
__device__ __forceinline__ void nsa_loop(LAS unsigned char* lds, const unsigned char* kbase, const unsigned char* vbase, int ntiles, int jlo,
                                         const bf16x8 (&q)[8], int t, float slope2, float& m, float& l, f32x16 (&o)[4], float invl, int tid, int wave, int lane) {
    constexpr bool HASV = MODE != 0;
    const int r32 = lane & 31, hi = lane >> 5;
    const int srow = tid >> 3, sc8 = tid & 7;
    const unsigned soff = srow * 256 + sc8 * 16;
    LAS unsigned char* kst = lds + srow * KS_N + sc8 * 16;
    LAS unsigned char* vst = lds + 2 * NSA_KB + srow * VS + sc8 * 16;
    const LAS unsigned char* kl = lds + r32 * KS_N + hi * 16;
    const LAS unsigned char* vl = lds + 2 * NSA_KB + (4 * hi + ((lane & 15) >> 2)) * VS + (16 * ((lane >> 4) & 1) + 4 * (lane & 3)) * 2;
    const LAS int* ulist = (const LAS int*)(lds + N_ULIST);
    const LAS unsigned* selm = (const LAS unsigned*)(lds + N_SELM);
    LAS float* partA = (LAS float*)(lds + N_PART); LAS float* partB = (LAS float*)(lds + N_PART + N_PARTB);
    LAS float* imp = (LAS float*)(lds + N_IMP); LAS float* carry = (LAS float*)(lds + N_CARRY);
    if (ntiles <= 0) return;
    u32x4 sk0, sk1, sv0, sv1;
#define NSA_TROW(j) (MODE == 2 ? 64 * __builtin_amdgcn_readfirstlane(ulist[(j)]) : 64 * (jlo + (j)))
#define NSA_LOAD(j) do { const size_t ro_ = (size_t)NSA_TROW(j) * 256 + soff; \
        sk0 = *(const GAS u32x4*)(kbase + ro_); sk1 = *(const GAS u32x4*)(kbase + ro_ + 128); \
        if (HASV) { sv0 = *(const GAS u32x4*)(vbase + ro_); sv1 = *(const GAS u32x4*)(vbase + ro_ + 128); } } while (0)
#define NSA_STORE(b) do { LAS unsigned char* kd_ = kst + (b) * NSA_KB; *(LAS u32x4*)(kd_) = sk0; *(LAS u32x4*)(kd_ + 128) = sk1; \
        if (HASV) { LAS unsigned char* vd_ = vst + (b) * VB; *(LAS u32x4*)(vd_) = sv0; *(LAS u32x4*)(vd_ + 128) = sv1; } } while (0)
    NSA_LOAD(0); NSA_STORE(0);
    __syncthreads();
    for (int j = 0; j < ntiles; ++j) {
        const int buf = j & 1;
        if (MODE != 1 && j + 1 < ntiles) NSA_LOAD(j + 1);
        const int trow = NSA_TROW(j);
        constexpr int PSTEP = (MODE <= 1) ? 16 : 1;
        const int pstart = (MODE <= 1) ? 16 * trow + 31 : trow;
        const int db = t - pstart - PSTEP * 4 * hi;
        constexpr unsigned W = (MODE == 3) ? 512u : 0x7fffffffu;
        float b0 = -slope2 * (float)db;
        if (MODE == 2) { const int b = trow >> 6; if (((selm[r32 * 8 + (b >> 5)] >> (b & 31)) & 1u) == 0u) b0 = -__builtin_inff(); }
        f32x16 p0, p1;
#pragma unroll
        for (int r = 0; r < 16; ++r) { const int c = PSTEP * ((r & 3) + 8 * (r >> 2));
            p0[r] = __builtin_fmaf(slope2, (float)c, b0); p1[r] = __builtin_fmaf(slope2, (float)(c + 32 * PSTEP), b0); }
        qk_tile<8, KS_N, false>(p0, p1, kl + buf * NSA_KB, q);
        { const int t0u = __builtin_amdgcn_readfirstlane(t - r32);
          const bool interior = (t0u - (pstart + PSTEP * 63) >= 0) && ((unsigned)(t0u + 31 - pstart) < W);
          if (!interior) {
#pragma unroll
              for (int r = 0; r < 16; ++r) { const int c = PSTEP * ((r & 3) + 8 * (r >> 2));
                  if ((unsigned)(db - c) >= W) p0[r] = -__builtin_inff();
                  if ((unsigned)(db - c - 32 * PSTEP) >= W) p1[r] = -__builtin_inff(); } } }
        if (MODE == 0) {
            float tm = p0[0];
#pragma unroll
            for (int r = 1; r < 16; ++r) tm = fmaxf(tm, p0[r]);
#pragma unroll
            for (int r = 0; r < 16; ++r) tm = fmaxf(tm, p1[r]);
            tm = swapmax(tm);
            const float mn = fmaxf(m, tm); const float alpha = __builtin_amdgcn_exp2f(m - mn); m = mn;
            float ps = 0.f;
#pragma unroll
            for (int r = 0; r < 16; ++r) ps += __builtin_amdgcn_exp2f(p0[r] - mn) + __builtin_amdgcn_exp2f(p1[r] - mn);
            l = l * alpha + swapsum(ps);
        } else if (MODE == 1) {
#pragma unroll
            for (int r = 0; r < 16; ++r) { p0[r] = __builtin_amdgcn_exp2f(p0[r] - m) * invl; p1[r] = __builtin_amdgcn_exp2f(p1[r] - m) * invl; }
            LAS float* pa = partA + (wave * 32 + r32) * 17 + hi; LAS float* pbm = partB + (wave * 32 + r32) * 17 + hi;
#pragma unroll
            for (int rg = 0; rg < 4; ++rg) {
                pa[2 * rg] = (p0[4 * rg] + p0[4 * rg + 1]) + (p0[4 * rg + 2] + p0[4 * rg + 3]); pbm[2 * rg] = p0[4 * rg + 3];
                pa[8 + 2 * rg] = (p1[4 * rg] + p1[4 * rg + 1]) + (p1[4 * rg + 2] + p1[4 * rg + 3]); pbm[8 + 2 * rg] = p1[4 * rg + 3]; }
            const bf16x8 pb[4] = {packp<0>(p0), packp<1>(p0), packp<0>(p1), packp<1>(p1)};
            pv_tile(o, pb, vl + buf * VB);
            __syncthreads();
            { const int qq = tid >> 4, jl = tid & 15; float a = 0.f, bp = 0.f, bl = 0.f;
#pragma unroll
              for (int w = 0; w < 8; ++w) { a += partA[(w * 32 + qq) * 17 + jl]; bl += partB[(w * 32 + qq) * 17 + jl]; }
              if (jl > 0) {
#pragma unroll
                  for (int w = 0; w < 8; ++w) bp += partB[(w * 32 + qq) * 17 + jl - 1];
              } else bp = (j > 0) ? carry[((j - 1) & 1) * 32 + qq] : 0.f;
              imp[qq * 256 + 16 * j + jl] = a + bp;
              if (jl == 15) carry[(j & 1) * 32 + qq] = bl; }
        } else {
            online_sm(p0, p1, m, l, o);
            const bf16x8 pb[4] = {packp<0>(p0), packp<1>(p0), packp<0>(p1), packp<1>(p1)};
            pv_tile(o, pb, vl + buf * VB);
        }
        if (MODE == 1 && j + 1 < ntiles) NSA_LOAD(j + 1);
        if (j + 1 < ntiles) NSA_STORE(buf ^ 1);
        __syncthreads();
    }
#undef NSA_TROW
#undef NSA_LOAD
#undef NSA_STORE
}
__device__ __forceinline__ void nsa_topk(const LAS float* improw, LAS unsigned* selrow, int cur, int lane) {
    unsigned key[4]; bool sel[4];
    int nforced = 0;
#pragma unroll
    for (int k = 0; k < 4; ++k) { const int j = lane + 64 * k;
        const bool forced = (j == 0) || (j == cur) || (j == cur - 1);
        const bool causal = j <= cur;
        sel[k] = forced;
#ifdef IMPNOISE_BUILD
        { unsigned h = (unsigned)j * 2654435761u + (unsigned)(size_t)improw * 40503u; h ^= h >> 15; h *= 0x846ca68bu; h ^= h >> 16;
          const float r = (float)(int)(h & 0xffffu) * (1.f / 32768.f) - 1.f; const float v = improw[j] * (1.f + IMPNOISE_EPS * r);
          key[k] = (causal && !forced) ? (__float_as_uint(v) + 1u) : 0u; }
#else
        key[k] = (causal && !forced) ? (__float_as_uint(improw[j]) + 1u) : 0u;
#endif
    }
    nforced = 1 + (cur >= 1 ? 1 : 0) + (cur >= 2 ? 1 : 0);
    const int want = 16 - nforced;
    for (int it = 0; it < want; ++it) {
        unsigned bk = key[0]; int bj = lane;
#pragma unroll
        for (int k = 1; k < 4; ++k) { if (key[k] > bk) { bk = key[k]; bj = lane + 64 * k; } }
        unsigned long long best = ((unsigned long long)bk << 32) | (unsigned)(0xffffffffu - (unsigned)bj);
#pragma unroll
        for (int off = 1; off < 64; off <<= 1) {
            const unsigned lo = __shfl_xor((unsigned)best, off), hiw = __shfl_xor((unsigned)(best >> 32), off);
            const unsigned long long other = ((unsigned long long)hiw << 32) | lo;
            best = other > best ? other : best; }
        if ((unsigned)(best >> 32) == 0u) break;
        const int wj = (int)(0xffffffffu - (unsigned)best);
#pragma unroll
        for (int k = 0; k < 4; ++k) if (wj == lane + 64 * k) { key[k] = 0u; sel[k] = true; }
    }
#pragma unroll
    for (int k = 0; k < 4; ++k) { const unsigned long long bm = __ballot(sel[k]);
        if (lane == 0) { selrow[2 * k] = (unsigned)bm; selrow[2 * k + 1] = (unsigned)(bm >> 32); } }
}
__device__ __forceinline__ int nsa_opaque(int v) { asm volatile("" : "+v"(v)); return v; }
__device__ __forceinline__ void nsa_unit(LAS unsigned char* lds, const NsaPtrs& P, int g, int qblk, int tid_in, int wave, int lane_in, int cu) {
    int tid = tid_in; asm volatile("" : "+v"(tid));
    const int lane = tid & 63; (void)lane_in;
    const int r32 = lane & 31, hi = lane >> 5;
    const int hh = 8 * g + wave, t0 = 32 * qblk, t = t0 + r32;
    const float slope2 = __builtin_amdgcn_exp2f(-0.5f * (float)(hh + 1)) * LOG2E;
    bf16x8 q[8];
    { const bf16* qp = P.Q + (size_t)t * 2048 + hh * 128 + hi * 8;
#pragma unroll
      for (int d0 = 0; d0 < 8; ++d0) q[d0] = *(const GAS bf16x8*)(qp + d0 * 16); }
#define NSA_SCR() ((GAS f32x4*)(P.scr + ((size_t)(cu * 8 + wave) * 16) * 256) + nsa_opaque(lane))
    const size_t CH = (size_t)S * 128 * 2;
    f32x16 o[4]; float m, l;
#define NSA_ZERO_O() do { _Pragma("unroll") for (int d_ = 0; d_ < 4; ++d_) _Pragma("unroll") for (int r_ = 0; r_ < 16; ++r_) o[d_][r_] = 0.f; } while (0)
    const int ncv = 2 * qblk + 1, ntc = (ncv + 63) >> 6;
    const unsigned char* kc = (const unsigned char*)P.KC + (size_t)g * 1024 * 256; const unsigned char* vc = (const unsigned char*)P.VC + (size_t)g * 1024 * 256;
    m = -1e30f; l = 0.f; NSA_ZERO_O();
    nsa_loop<0>(lds, kc, vc, ntc, 0, q, t, slope2, m, l, o, 0.f, tid, wave, lane);
    const float invl = l > 0.f ? 1.f / l : 0.f;
    nsa_loop<1>(lds, kc, vc, ntc, 0, q, t, slope2, m, l, o, invl, tid, wave, lane);
    { const float g_c = P.G[(size_t)t * 48 + hh]; GAS f32x4* scr = NSA_SCR();
#pragma unroll
    for (int d0 = 0; d0 < 4; ++d0)
#pragma unroll
        for (int rg = 0; rg < 4; ++rg) { f32x4 v = {o[d0][4 * rg] * g_c, o[d0][4 * rg + 1] * g_c, o[d0][4 * rg + 2] * g_c, o[d0][4 * rg + 3] * g_c}; scr[(d0 * 4 + rg) * 64] = v; } }
    const int cur = t0 >> 6;
    LAS unsigned* selm = (LAS unsigned*)(lds + N_SELM);
    for (int i = 0; i < 4; ++i) { const int qq = 4 * wave + i; nsa_topk((const LAS float*)(lds + N_IMP) + qq * 256, selm + qq * 8, cur, lane); }
    __syncthreads();
    if (wave == 0) {
        LAS int* ulist = (LAS int*)(lds + N_ULIST); int n = 0;
        for (int k = 0; k < 8; ++k) { unsigned u = (lane < 32) ? selm[lane * 8 + k] : 0u;
#pragma unroll
            for (int off = 1; off < 32; off <<= 1) u |= __shfl_xor(u, off);
            u = __builtin_amdgcn_readfirstlane(u);
            while (u) { const int b = __builtin_ctz(u); u &= u - 1u; if (lane == 0) ulist[n] = 32 * k + b; ++n; } }
        if (lane == 0) *(LAS int*)(lds + N_NTS) = n;
    }
    __syncthreads();
    const int nts = __builtin_amdgcn_readfirstlane(*(const LAS int*)(lds + N_NTS));
    m = -1e30f; l = 0.f; NSA_ZERO_O();
    nsa_loop<2>(lds, (const unsigned char*)P.KV + (size_t)(4 + g) * CH, (const unsigned char*)P.KV + (size_t)(6 + g) * CH, nts, 0, q, t, slope2, m, l, o, 0.f, tid, wave, lane);
    { const float f = P.G[(size_t)t * 48 + 16 + hh] / l; GAS f32x4* scr = NSA_SCR();
#pragma unroll
      for (int d0 = 0; d0 < 4; ++d0)
#pragma unroll
          for (int rg = 0; rg < 4; ++rg) { f32x4 v = scr[(d0 * 4 + rg) * 64]; v[0] += o[d0][4 * rg] * f; v[1] += o[d0][4 * rg + 1] * f; v[2] += o[d0][4 * rg + 2] * f; v[3] += o[d0][4 * rg + 3] * f; scr[(d0 * 4 + rg) * 64] = v; } }
    const int jlo = (t0 > 511 ? t0 - 511 : 0) >> 6, jhi = (t0 + 31) >> 6;
    m = -1e30f; l = 0.f; NSA_ZERO_O();
    nsa_loop<3>(lds, (const unsigned char*)P.KV + (size_t)(8 + g) * CH, (const unsigned char*)P.KV + (size_t)(10 + g) * CH, jhi - jlo + 1, jlo, q, t, slope2, m, l, o, 0.f, tid, wave, lane);
    { const float f = P.G[(size_t)t * 48 + 32 + hh] / l; GAS f32x4* scr = NSA_SCR();
      const bf16* zp = P.Z + (size_t)t * 2048 + hh * 128 + 4 * hi;
      bf16* op = P.O + (size_t)t * 4096 + 2048 + hh * 128 + 4 * hi;
#pragma unroll
      for (int d0 = 0; d0 < 4; ++d0)
#pragma unroll
          for (int rg = 0; rg < 4; ++rg) { const int dim = 32 * d0 + 8 * rg; const f32x4 a = scr[(d0 * 4 + rg) * 64];
              const u32x2 z = *(const GAS u32x2*)(zp + dim);
              u32x2 w; w.x = pk2((a[0] + o[d0][4 * rg] * f) * bflo(z.x), (a[1] + o[d0][4 * rg + 1] * f) * bfhi(z.x)); w.y = pk2((a[2] + o[d0][4 * rg + 2] * f) * bflo(z.y), (a[3] + o[d0][4 * rg + 3] * f) * bfhi(z.y));
              *(GAS u32x2*)(op + dim) = w; } }
#undef NSA_ZERO_O
#undef NSA_SCR
}
struct CmpPtrs { const bf16* KV; const bf16* W1; const bf16* W2; const float* cbp; bf16* KC; bf16* VC; };
__device__ __forceinline__ void cmp_unit(LAS unsigned char* lds, const CmpPtrs& P, int kv, int g, int tile, int tid, int wave, int lane) {
    const int fr = lane & 15, fq = lane >> 4, n = 16 * tile + fr;
    const bf16* A = P.KV + (size_t)(kv * 2 + g) * ((size_t)S * 128) + (size_t)n * 2048 + 8 * fq;
    const bf16* B1 = P.W1 + (size_t)kv * 128 * 4096 + (size_t)(16 * wave + fr) * 4096 + 8 * fq;
    f32x4 acc = {0.f, 0.f, 0.f, 0.f};
#pragma unroll 8
    for (int s = 0; s < 128; ++s) {
        const bf16x8 a = *(const GAS bf16x8*)(A + 32 * s), b = *(const GAS bf16x8*)(B1 + 32 * s);
        acc = __builtin_amdgcn_mfma_f32_16x16x32_bf16(a, b, acc, 0, 0, 0);
    }
    float bias = 0.f;
#pragma unroll
    for (int c = 0; c < 16; ++c) bias += P.cbp[(size_t)(kv * 16 + c) * 128 + 16 * wave + fr];
    LAS bf16* hid = (LAS bf16*)lds;
#pragma unroll
    for (int i = 0; i < 4; ++i) hid[(4 * fq + i) * 136 + 16 * wave + fr] = (bf16)(pk2(silu_f(acc[i] + bias), 0.f) & 0xffffu);
    __syncthreads();
    const bf16* B2 = P.W2 + (size_t)kv * 128 * 128 + (size_t)(16 * wave + fr) * 128 + 8 * fq;
    f32x4 acc2 = {0.f, 0.f, 0.f, 0.f};
#pragma unroll
    for (int s = 0; s < 4; ++s) {
        const bf16x8 a = *(const LAS bf16x8*)(hid + fr * 136 + 32 * s + 8 * fq), b = *(const GAS bf16x8*)(B2 + 32 * s);
        acc2 = __builtin_amdgcn_mfma_f32_16x16x32_bf16(a, b, acc2, 0, 0, 0);
    }
    bf16* out = (kv ? P.VC : P.KC) + (size_t)g * 1024 * 128;
#pragma unroll
    for (int i = 0; i < 4; ++i) { const int nn = 16 * tile + 4 * fq + i; out[(size_t)nn * 128 + 16 * wave + fr] = (nn < 1023) ? (bf16)(pk2(acc2[i], 0.f) & 0xffffu) : (bf16)0; }
    __syncthreads();
}
}
#ifdef CHK_BUILD
namespace chk {
constexpr size_t WS_CHK = 14 * MiB;
__device__ __forceinline__ float bf2f(bf16 v) { return __uint_as_float((unsigned)v << 16); }
__device__ __forceinline__ float e4m3(unsigned char b) {
    const int e = (b >> 3) & 15, mm = b & 7; const float v = e == 0 ? (float)mm * (1.f / 512.f) : (1.f + (float)mm * 0.125f) * exp2f((float)(e - 7)); return (b & 0x80) ? -v : v; }
__device__ __forceinline__ int sample_t(int i) { return i * 64 + (i * 29) % 64; }
__device__ __noinline__ void nsa_check(LAS unsigned char* lds, unsigned char* ws, int t, int g, LAS float* acc2) {
    int tid_ = threadIdx.x; asm volatile("" : "+v"(tid_)); const int tid = tid_, lane = tid & 63, wave = tid >> 6;
    const int hh = 8 * g + wave, cur = t >> 6;
    const bf16* QN = (const bf16*)(ws + WS_QNSA); const bf16* KV = (const bf16*)(ws + WS_KVNSA); const bf16* KC = (const bf16*)(ws + WS_KCMP) + (size_t)g * 1024 * 128; const bf16* VC = (const bf16*)(ws + WS_VCMP) + (size_t)g * 1024 * 128;
    const bf16* ZN = (const bf16*)(ws + WS_ZNSA); const float* GN = (const float*)(ws + WS_GNSA); const bf16* HO = (const bf16*)(ws + WS_H);
    const size_t CH = (size_t)S * 128;
    LAS float* pc = (LAS float*)lds;
    LAS float* impv = (LAS float*)(lds + 32768);
    LAS int* sel = (LAS int*)(lds + 32768 + 1024);
    const float slope2 = exp2f(-0.5f * (float)(hh + 1)) * LOG2E;
    const float q0 = bf2f(QN[(size_t)t * 2048 + hh * 128 + 2 * lane]), q1 = bf2f(QN[(size_t)t * 2048 + hh * 128 + 2 * lane + 1]);
    float oc0 = 0.f, oc1 = 0.f, os0 = 0.f, os1 = 0.f, ow0 = 0.f, ow1 = 0.f;
    const int ncv = (t >= 31) ? (t - 31) / 16 + 1 : 0;
    for (int n = lane; n < 1024; n += 64) pc[wave * 1024 + n] = 0.f;
    float mx = -1e30f;
    for (int n = 0; n < ncv; ++n) { float s = q0 * bf2f(KC[(size_t)n * 128 + 2 * lane]) + q1 * bf2f(KC[(size_t)n * 128 + 2 * lane + 1]); s = wave_sum(s) - slope2 * (float)(t - 16 * n - 31);
        if (lane == 0) pc[wave * 1024 + n] = s; mx = fmaxf(mx, s); }
    __syncthreads();
    float sum = 0.f;
    for (int n = 0; n < ncv; ++n) sum += exp2f(pc[wave * 1024 + n] - mx);
    __syncthreads();
    for (int n = lane; n < 1024; n += 64) pc[wave * 1024 + n] = (n < ncv) ? exp2f(pc[wave * 1024 + n] - mx) / sum : 0.f;
    __syncthreads();
    for (int n = 0; n < ncv; ++n) { const float p = pc[wave * 1024 + n]; oc0 += p * bf2f(VC[(size_t)n * 128 + 2 * lane]); oc1 += p * bf2f(VC[(size_t)n * 128 + 2 * lane + 1]); }
    if (tid < 256) { const int j = tid; float v = -1e30f;
        if (64 * j <= t) { float a = 0.f; for (int ii = 4 * j - 1; ii <= 4 * j + 3; ++ii) if (ii >= 0 && ii <= 1022) { float ps = 0.f; for (int h = 0; h < 8; ++h) ps += pc[h * 1024 + ii]; a += ps; }
            const bool forced = (j == 0) || (j == cur) || (j == cur - 1); v = a + (forced ? 1e4f : 0.f); }
        impv[j] = v; }
    __syncthreads();
    if (tid < 256) { const int j = tid; const float v = impv[j]; int rank = 0; for (int ii = 0; ii < 256; ++ii) { const float u = impv[ii]; rank += (u > v || (u == v && ii < j)) ? 1 : 0; } sel[j] = rank < 16 ? 1 : 0; }
    __syncthreads();
    const bf16* KS = KV + (size_t)(4 + g) * CH; const bf16* VSl = KV + (size_t)(6 + g) * CH;
    mx = -1e30f;
    for (int j = 0; j < 256; ++j) if (sel[j]) for (int tok = 64 * j; tok < 64 * j + 64 && tok <= t; ++tok) {
        float s = q0 * bf2f(KS[(size_t)tok * 128 + 2 * lane]) + q1 * bf2f(KS[(size_t)tok * 128 + 2 * lane + 1]); s = wave_sum(s) - slope2 * (float)(t - tok); mx = fmaxf(mx, s); }
    sum = 0.f;
    for (int j = 0; j < 256; ++j) if (sel[j]) for (int tok = 64 * j; tok < 64 * j + 64 && tok <= t; ++tok) {
        float s = q0 * bf2f(KS[(size_t)tok * 128 + 2 * lane]) + q1 * bf2f(KS[(size_t)tok * 128 + 2 * lane + 1]); s = wave_sum(s) - slope2 * (float)(t - tok);
        const float p = exp2f(s - mx); sum += p; os0 += p * bf2f(VSl[(size_t)tok * 128 + 2 * lane]); os1 += p * bf2f(VSl[(size_t)tok * 128 + 2 * lane + 1]); }
    os0 /= sum; os1 /= sum;
    const bf16* KW = KV + (size_t)(8 + g) * CH; const bf16* VW = KV + (size_t)(10 + g) * CH;
    const int lo = t - 511 > 0 ? t - 511 : 0;
    mx = -1e30f;
    for (int tok = lo; tok <= t; ++tok) { float s = q0 * bf2f(KW[(size_t)tok * 128 + 2 * lane]) + q1 * bf2f(KW[(size_t)tok * 128 + 2 * lane + 1]); s = wave_sum(s) - slope2 * (float)(t - tok); mx = fmaxf(mx, s); }
    sum = 0.f;
    for (int tok = lo; tok <= t; ++tok) { float s = q0 * bf2f(KW[(size_t)tok * 128 + 2 * lane]) + q1 * bf2f(KW[(size_t)tok * 128 + 2 * lane + 1]); s = wave_sum(s) - slope2 * (float)(t - tok);
        const float p = exp2f(s - mx); sum += p; ow0 += p * bf2f(VW[(size_t)tok * 128 + 2 * lane]); ow1 += p * bf2f(VW[(size_t)tok * 128 + 2 * lane + 1]); }
    ow0 /= sum; ow1 /= sum;
    const float gc = GN[(size_t)t * 48 + hh], gs = GN[(size_t)t * 48 + 16 + hh], gwv = GN[(size_t)t * 48 + 32 + hh];
    const float r0 = (gc * oc0 + gs * os0 + gwv * ow0) * bf2f(ZN[(size_t)t * 2048 + hh * 128 + 2 * lane]), r1 = (gc * oc1 + gs * os1 + gwv * ow1) * bf2f(ZN[(size_t)t * 2048 + hh * 128 + 2 * lane + 1]);
    const float f0 = bf2f(HO[(size_t)t * 4096 + 2048 + hh * 128 + 2 * lane]), f1 = bf2f(HO[(size_t)t * 4096 + 2048 + hh * 128 + 2 * lane + 1]);
    const float e2 = wave_sum((r0 - f0) * (r0 - f0) + (r1 - f1) * (r1 - f1)), n2 = wave_sum(r0 * r0 + r1 * r1);
    __syncthreads();
    if (lane == 0) { pc[wave] = e2; pc[8 + wave] = n2; }
    __syncthreads();
    if (tid == 0) { float a = 0.f, b = 0.f; for (int w = 0; w < 8; ++w) { a += pc[w]; b += pc[8 + w]; } acc2[0] += a; acc2[1] += b; }
    __syncthreads();
}
__device__ __forceinline__ void mla_check(LAS unsigned char* lds, unsigned char* ws, int t, LAS float* acc2) {
    int tid_ = threadIdx.x; asm volatile("" : "+v"(tid_)); const int tid = tid_, lane = tid & 63, wave = tid >> 6;
    const bf16* ZM = (const bf16*)(ws + WS_ZMLA); const bf16* HO = (const bf16*)(ws + WS_H);
    LAS float* qs = (LAS float*)lds + wave * 192;
    LAS float* red = (LAS float*)lds + 8 * 192;
    float ae = 0.f, an = 0.f;
    for (int rep = 0; rep < 2; ++rep) { const int head = wave + 8 * rep;
#ifdef MLA_FP8
        { const unsigned char* qp = (const unsigned char*)(ws + WS_QMLA) + (size_t)t * 3072 + head * 192; for (int d = lane; d < 192; d += 64) qs[d] = e4m3(qp[d]) * QS_MLA; }
#else
        { const bf16* qp = (const bf16*)(ws + WS_QMLA) + (size_t)t * 3072 + head * 192; for (int d = lane; d < 192; d += 64) qs[d] = bf2f(qp[d]); }
#endif
        __syncthreads();
        float mx = -1e30f;
        for (int c = 0; 64 * c <= t; ++c) {
#ifdef MLA_MX
            const int tok = 64 * c + 8 * ((lane >> 2) & 7) + 4 * (lane >> 5) + (lane & 3);
#else
            const int x_ = lane & 15; const int tok = 64 * c + (lane & 48) + (x_ < 4 ? x_ : (x_ < 8 ? x_ + 4 : (x_ < 12 ? x_ - 4 : x_)));
#endif

            float s = 0.f;
#ifdef MLA_FP8
            const unsigned char* kp = (const unsigned char*)(ws + WS_KMLA) + (size_t)tok * 3072 + head * 192; for (int d = 0; d < 192; ++d) s += qs[d] * e4m3(kp[d]);
#else
            const bf16* kp = (const bf16*)(ws + WS_KMLA) + (size_t)tok * 3072 + head * 192; for (int d = 0; d < 192; ++d) s += qs[d] * bf2f(kp[d]);
#endif
            if (tok <= t) mx = fmaxf(mx, s); }
        for (int off = 1; off < 64; off <<= 1) mx = fmaxf(mx, __shfl_xor(mx, off));
        float e2 = 0.f, n2 = 0.f;
        for (int dc = 0; dc < 8; ++dc) {
        float sum = 0.f; float o[16];
#pragma unroll
        for (int d = 0; d < 16; ++d) o[d] = 0.f;
        for (int c = 0; 64 * c <= t; ++c) {
#ifdef MLA_MX
            const int tok = 64 * c + 8 * ((lane >> 2) & 7) + 4 * (lane >> 5) + (lane & 3);
#else
            const int x_ = lane & 15; const int tok = 64 * c + (lane & 48) + (x_ < 4 ? x_ : (x_ < 8 ? x_ + 4 : (x_ < 12 ? x_ - 4 : x_)));
#endif

            float s = 0.f;
#ifdef MLA_FP8
            const unsigned char* kp = (const unsigned char*)(ws + WS_KMLA) + (size_t)tok * 3072 + head * 192; for (int d = 0; d < 192; ++d) s += qs[d] * e4m3(kp[d]);
#else
            const bf16* kp = (const bf16*)(ws + WS_KMLA) + (size_t)tok * 3072 + head * 192; for (int d = 0; d < 192; ++d) s += qs[d] * bf2f(kp[d]);
#endif
            const float p = (tok <= t) ? exp2f(s - mx) : 0.f; sum += p;
#ifdef MLA_FP8V
            const unsigned char* vt = (const unsigned char*)(ws + WS_VMLA) + ((size_t)head * 128 + 16 * dc) * S + 64 * c + lane;
#pragma unroll
            for (int d = 0; d < 16; ++d) o[d] += p * e4m3(vt[(size_t)d * S]);
#else
            const bf16* vp = (const bf16*)(ws + WS_VMLA) + (size_t)tok * 2048 + head * 128 + 16 * dc;
#pragma unroll
            for (int d = 0; d < 16; ++d) o[d] += p * bf2f(vp[d]);
#endif
        }
        sum = wave_sum(sum);
#pragma unroll
        for (int d = 0; d < 16; ++d) { const float od = wave_sum(o[d]) / sum; const float r = od * bf2f(ZM[(size_t)t * 2048 + head * 128 + 16 * dc + d]), f = bf2f(HO[(size_t)t * 4096 + head * 128 + 16 * dc + d]); e2 += (r - f) * (r - f); n2 += r * r; }
        }
        ae += e2; an += n2;
        __syncthreads(); }
    if (lane == 0) { red[wave] = ae; red[8 + wave] = an; }
    __syncthreads();
    if (tid == 0) { float a = 0.f, b = 0.f; for (int w = 0; w < 8; ++w) { a += red[w]; b += red[8 + w]; } acc2[0] += a; acc2[1] += b; }
    __syncthreads();
}
}
#endif
#ifdef CHK2_BUILD
namespace chk2 {
constexpr size_t WS_CHK = 14 * MiB;
__device__ __forceinline__ float bf2f(bf16 v) { return __uint_as_float((unsigned)v << 16); }
__device__ __forceinline__ int sample_t(int i) { return i * 256 + (i * 29) % 256; }
__device__ __noinline__ void proj_check(LAS unsigned char* lds, unsigned char* ws, const float* x, const float* w_in_l, int l, int i, int qd, LAS float* acc2) {
    int tid_ = threadIdx.x; asm volatile("" : "+v"(tid_)); const int tid = tid_;
    const int t = sample_t(i);
    LAS float* h = (LAS float*)lds;
    LAS float* red = h + 4096;
    const float* mod = (const float*)(ws + WS_MOD) + (size_t)l * 3 * D;
    const float* xin = (l == 0) ? x : (const float*)(ws + WS_XV);
    for (int k = tid; k < D; k += NTHR) h[k] = xin[(size_t)t * D + k] * (1.f + mod[D + k]) + mod[k];
    __syncthreads();
    float e2 = 0.f, r2 = 0.f;
    const float* cosT = (const float*)(ws + WS_ROPE); const float* sinT = cosT + (size_t)S * 32;
    for (int n = qd * 2268 + tid; n < (qd + 1) * 2268; n += NTHR) {
        float a = 0.f;
        for (int k = 0; k < D; ++k) a += h[k] * w_in_l[(size_t)k * INC + n];
        float ref = a, got;
        if (n < 768) got = bf2f(((const bf16*)(ws + WS_QLAT))[(size_t)t * 768 + n]);
        else if (n < 1280) got = bf2f(((const bf16*)(ws + WS_KVLAT))[(size_t)t * 512 + n - 768]);
        else if (n < 1344) {
            const int ii = n - 1280, pi = ii & 31; const int np = 1280 + (ii < 32 ? ii + 32 : ii - 32); float b = 0.f;
            for (int k = 0; k < D; ++k) b += h[k] * w_in_l[(size_t)k * INC + np];
            const float c = cosT[(size_t)t * 32 + pi], s = sinT[(size_t)t * 32 + pi];
            ref = ii < 32 ? a * c - b * s : a * c + b * s;
            got = bf2f(((const bf16*)(ws + WS_KMLA))[(size_t)t * 3072 + 5 * 192 + 128 + 2 * pi + (ii >> 5)]);
        }
        else if (n < 3392) { ref = a / (1.f + expf(-a)); got = bf2f(((const bf16*)(ws + WS_ZMLA))[(size_t)t * 2048 + n - 1344]); }
        else if (n < 5440) { ref = a * QS_NSA; got = bf2f(((const bf16*)(ws + WS_QNSA))[(size_t)t * 2048 + n - 3392]); }
        else if (n < 6976) { const int c = n - 5440; got = bf2f(((const bf16*)(ws + WS_KVNSA))[(size_t)(c >> 7) * ((size_t)S * 128) + (size_t)t * 128 + (c & 127)]); }
        else if (n < 7024) { ref = 1.f / (1.f + expf(-a)); got = ((const float*)(ws + WS_GNSA))[(size_t)t * 48 + n - 6976]; }
        else { ref = a / (1.f + expf(-a)); got = bf2f(((const bf16*)(ws + WS_ZNSA))[(size_t)t * 2048 + n - 7024]); }
        e2 += (ref - got) * (ref - got); r2 += ref * ref;
    }
    red[tid] = e2; red[512 + tid] = r2;
    __syncthreads();
    if (tid == 0) { float a = 0.f, b = 0.f; for (int k = 0; k < 512; ++k) { a += red[k]; b += red[512 + k]; } acc2[0] += a; acc2[1] += b; }
    __syncthreads();
}
__device__ __noinline__ void cmp_check(LAS unsigned char* lds, unsigned char* ws, const float* cmp_pos_l, const float* w1_l, const float* w2_l, int i, LAS float* acc2) {
    int tid_ = threadIdx.x; asm volatile("" : "+v"(tid_)); const int tid = tid_;
    const int n = (4 * i + (i & 3)) % 1023, kv = i & 1, g = (i >> 1) & 1;
    LAS float* blk = (LAS float*)lds;
    LAS float* hid = blk + 4096;
    LAS float* red = hid + 128;
    const bf16* A = (const bf16*)(ws + WS_KVNSA) + (size_t)(kv * 2 + g) * ((size_t)S * 128) + (size_t)n * 2048;
    for (int k = tid; k < 4096; k += NTHR) blk[k] = bf2f(A[k]) + cmp_pos_l[(size_t)kv * 4096 + k];
    __syncthreads();
    if (tid < 128) { float a = 0.f; const float* W = w1_l + (size_t)kv * 4096 * 128 + tid; for (int k = 0; k < 4096; ++k) a += blk[k] * W[(size_t)k * 128]; hid[tid] = a / (1.f + expf(-a)); }
    __syncthreads();
    float e2 = 0.f, r2 = 0.f;
    if (tid < 128) { float a = 0.f; const float* W = w2_l + (size_t)kv * 128 * 128 + tid; for (int k = 0; k < 128; ++k) a += hid[k] * W[(size_t)k * 128];
        const float got = bf2f(((const bf16*)(ws + (kv ? WS_VCMP : WS_KCMP)))[(size_t)g * 1024 * 128 + (size_t)n * 128 + tid]); e2 = (a - got) * (a - got); r2 = a * a; }
    if (tid < 128) { red[tid] = e2; red[128 + tid] = r2; }
    __syncthreads();
    if (tid == 0) { float a = 0.f, b = 0.f; for (int k = 0; k < 128; ++k) { a += red[k]; b += red[128 + k]; } acc2[0] += a; acc2[1] += b; }
    __syncthreads();
}
}
#endif
#ifdef CHK3_BUILD
namespace chk3 {
constexpr size_t WS_CHK = 14 * MiB;
__device__ __forceinline__ float bf2f(bf16 v) { return __uint_as_float((unsigned)v << 16); }
__device__ __forceinline__ float e4m3(unsigned char b) { const int e = (b >> 3) & 15, mm = b & 7; const float v = e == 0 ? (float)mm * (1.f / 512.f) : (1.f + (float)mm * 0.125f) * exp2f((float)(e - 7)); return (b & 0x80) ? -v : v; }
__device__ __forceinline__ int sample_t(int i) { return i * 64 + (i * 29) % 64; }
__device__ __noinline__ void up_check(LAS unsigned char* lds, unsigned char* ws, const float* qn, const float* wq, const float* kn, const float* wkv, int i, LAS float* acc2) {
    int tid_ = threadIdx.x; asm volatile("" : "+v"(tid_)); const int tid = tid_;
    const int t = sample_t(i);
    LAS float* ql = (LAS float*)lds;
    LAS float* kl = ql + 768;
    LAS float* qo = kl + 512;
    LAS float* red = qo + 3072;
    const bf16* QL = (const bf16*)(ws + WS_QLAT) + (size_t)t * 768; const bf16* KL = (const bf16*)(ws + WS_KVLAT) + (size_t)t * 512;
    float s = 0.f; for (int k = tid; k < 768; k += NTHR) { const float v = bf2f(QL[k]); s += v * v; }
    red[tid] = s; __syncthreads();
    float tot = 0.f; for (int k = 0; k < 512; ++k) tot += red[k];
    const float rq = 1.f / sqrtf(tot / 768.f + RMS_EPS);
    __syncthreads();
    s = 0.f; for (int k = tid; k < 512; k += NTHR) { const float v = bf2f(KL[k]); s += v * v; }
    red[tid] = s; __syncthreads();
    tot = 0.f; for (int k = 0; k < 512; ++k) tot += red[k];
    const float rk = 1.f / sqrtf(tot / 512.f + RMS_EPS);
    __syncthreads();
    for (int k = tid; k < 768; k += NTHR) ql[k] = bf2f(QL[k]) * rq * qn[k];
    for (int k = tid; k < 512; k += NTHR) kl[k] = bf2f(KL[k]) * rk * kn[k];
    __syncthreads();
    for (int n = tid; n < 3072; n += NTHR) { float a = 0.f; for (int k = 0; k < 768; ++k) a += ql[k] * wq[(size_t)k * 3072 + n]; qo[n] = a; }
    __syncthreads();
    float e2 = 0.f, r2 = 0.f;
    const float* cosT = (const float*)(ws + WS_ROPE); const float* sinT = cosT + (size_t)S * 32;
    const bf16* QM = (const bf16*)(ws + WS_QMLA) + (size_t)t * 3072;
    for (int n = tid; n < 3072; n += NTHR) { const int h = n / 192, d = n % 192; float ref, got;
#ifdef MLA_FP8
        const unsigned char* Q8 = (const unsigned char*)(ws + WS_QMLA) + (size_t)t * 3072;
        if (d < 128) { ref = qo[n]; got = e4m3(Q8[h * 192 + d]); }
        else { const int ii = d - 128, pi = ii & 31; const float x1 = qo[h * 192 + 128 + pi], x2 = qo[h * 192 + 160 + pi]; const float c = cosT[(size_t)t * 32 + pi], sn = sinT[(size_t)t * 32 + pi];
            ref = (ii < 32 ? x1 * c - x2 * sn : x2 * c + x1 * sn); got = e4m3(Q8[h * 192 + 128 + 2 * pi + (ii >> 5)]); }
        if (false) {}
#else
        if (d < 128) { ref = qo[n] * QS_MLA; got = bf2f(QM[h * 192 + d]); }
        else { const int ii = d - 128, pi = ii & 31; const float x1 = qo[h * 192 + 128 + pi], x2 = qo[h * 192 + 160 + pi]; const float c = cosT[(size_t)t * 32 + pi], sn = sinT[(size_t)t * 32 + pi];
            ref = (ii < 32 ? x1 * c - x2 * sn : x2 * c + x1 * sn) * QS_MLA; got = bf2f(QM[h * 192 + 128 + 2 * pi + (ii >> 5)]); }
#endif
        e2 += (ref - got) * (ref - got); r2 += ref * ref; }
    const bf16* KM = (const bf16*)(ws + WS_KMLA) + (size_t)t * 3072; const bf16* VM = (const bf16*)(ws + WS_VMLA) + (size_t)t * 2048;
    for (int n = tid; n < 4096; n += NTHR) { float a = 0.f; for (int k = 0; k < 512; ++k) a += kl[k] * wkv[(size_t)k * 4096 + n];
#ifdef MLA_FP8
        const int h = n >> 8, d = n & 255; const float got = d < 128 ? e4m3(((const unsigned char*)(ws + WS_KMLA) + (size_t)t * 3072)[h * 192 + d]) : bf2f(VM[h * 128 + d - 128]);
#else
        const int h = n >> 8, d = n & 255; const float got = d < 128 ? bf2f(KM[h * 192 + d]) : bf2f(VM[h * 128 + d - 128]);
#endif
        e2 += (a - got) * (a - got); r2 += a * a; }
    red[tid] = e2; red[512 + tid] = r2;
    __syncthreads();
    if (tid == 0) { float a = 0.f, b = 0.f; for (int k = 0; k < 512; ++k) { a += red[k]; b += red[512 + k]; } acc2[0] += a; acc2[1] += b; }
    __syncthreads();
}
__device__ __noinline__ void out_check(LAS unsigned char* lds, unsigned char* ws, const float* xin, const float* xv, const float* wout, const float* gate, int i, int qd, LAS float* acc2) {
    int tid_ = threadIdx.x; asm volatile("" : "+v"(tid_)); const int tid = tid_;
    const int t = i * 256 + (i * 29) % 256;
    LAS float* o = (LAS float*)lds;
    LAS float* red = o + 4096;
    const bf16* OA = (const bf16*)(ws + WS_H) + (size_t)t * 4096;
    for (int k = tid; k < 4096; k += NTHR) o[k] = bf2f(OA[k]);
    __syncthreads();
    float e2 = 0.f, r2 = 0.f;
    for (int n = qd * 1024 + tid; n < (qd + 1) * 1024; n += NTHR) { float a = 0.f; for (int k = 0; k < 4096; ++k) a += o[k] * wout[(size_t)k * 4096 + n];
        const float gy = gate[n] * a, ref = DN_ALPHA * xin[(size_t)t * D + n] + gy, got = xv[(size_t)t * D + n];
        e2 += (ref - got) * (ref - got); r2 += gy * gy; }
    red[tid] = e2; red[512 + tid] = r2;
    __syncthreads();
    if (tid == 0) { float a = 0.f, b = 0.f; for (int k = 0; k < 512; ++k) { a += red[k]; b += red[512 + k]; } acc2[0] += a; acc2[1] += b; }
    __syncthreads();
}
}
#endif
#ifdef CHK4_BUILD
namespace chk4 {
__device__ __forceinline__ float bf2f(bf16 v) { return __uint_as_float((unsigned)v << 16); }
__device__ __noinline__ void mod_check(LAS unsigned char* lds, unsigned char* ws, const float* c, const float* w_ada, const float* b_ada, int u, LAS float* acc2) {
    const int tid = threadIdx.x;
    LAS float* red = (LAS float*)lds;
    const int l = u & 1, n = ((u >> 1) * 977 + 13) % (3 * D);
    float a = 0.f;
    for (int k = tid; k < D; k += NTHR) { const float cv = c[k]; a += cv / (1.f + expf(-cv)) * w_ada[(size_t)l * D * 3 * D + (size_t)k * 3 * D + n]; }
    red[tid] = a; __syncthreads();
    if (tid == 0) { float s = 0.f; for (int k = 0; k < NTHR; ++k) s += red[k]; s += b_ada[(size_t)l * 3 * D + n];
        const float got = ((const float*)(ws + WS_MOD))[(size_t)l * 3 * D + n]; acc2[0] += (s - got) * (s - got); acc2[1] += s * s; }
    __syncthreads();
}
__device__ __noinline__ void ln_check(LAS unsigned char* lds, unsigned char* ws, const float* ln_g, const float* ln_b, int u, LAS float* acc2) {
    const int tid = threadIdx.x;
    LAS float* red = (LAS float*)lds;
    const int t = u * 64 + (u * 29) % 64;
    const float* X1 = (const float*)(ws + WS_XV) + (size_t)t * D; const bf16* H = (const bf16*)(ws + WS_H) + (size_t)t * D; const float* mod1 = (const float*)(ws + WS_MOD) + 3 * D;
    float s1 = 0.f, s2 = 0.f, e2 = 0.f, r2 = 0.f;
    for (int k = tid; k < D; k += NTHR) { const float y = (X1[k] - ln_b[k]) / ln_g[k]; s1 += y; s2 += y * y;
        const float h = X1[k] * (1.f + mod1[D + k]) + mod1[k], got = bf2f(H[k]); e2 += (h - got) * (h - got); r2 += h * h; }
    red[tid] = s1; red[512 + tid] = s2; red[1024 + tid] = e2; red[1536 + tid] = r2; __syncthreads();
    if (tid == 0) { float a = 0.f, b = 0.f, c = 0.f, d = 0.f; for (int k = 0; k < NTHR; ++k) { a += red[k]; b += red[512 + k]; c += red[1024 + k]; d += red[1536 + k]; }
        const float mean = a / D, var = b / D - mean * mean;
        acc2[0] += mean * mean + (var - 1.f) * (var - 1.f) + c / d; acc2[1] += 1.f; }
    __syncthreads();
}
}
#endif
constexpr int PPL = 6;
constexpr int N_PHASES = 2 + PPL * DEPTH;
struct Args { const void* in[16]; float* out; unsigned char* ws; int ph_lo, ph_hi; };
#define WSP(T, off) ((T*)(ws + (off)))
#define VCU() ((gridDim.x % 8 == 0) ? (int)((blockIdx.x % 8) * (gridDim.x / 8) + blockIdx.x / 8) : (int)blockIdx.x)
__global__ void __launch_bounds__(NTHR, 2) mk_fwd(const Args args) {
    extern __shared__ __attribute__((aligned(16))) unsigned char lds_raw[];
    LAS unsigned char* lds = (LAS unsigned char*)lds_raw;
    if (threadIdx.x < 32) ((volatile LAS unsigned*)(lds + MISC_OFF))[threadIdx.x] = 0u;
    __syncthreads();
    XcdBarrier bar = xcd_barrier_post((unsigned*)(args.ws + WS_CTL) + CW_BAR, (volatile LAS unsigned*)(lds + MISC_OFF) + 8);
#define IN(k) (args.ph_lo <= (k) && (k) < args.ph_hi)
#define SEAM(k) do { if (IN(k) && IN((k) + 1)) xcd_barrier(bar); } while (0)
#define PHASE_REGS int tid_ = threadIdx.x; asm volatile("" : "+v"(tid_)); const int tid = tid_, lane = tid & 63, wave = __builtin_amdgcn_readfirstlane(tid >> 6); \
    unsigned char* ws = args.ws; asm volatile("" : "+s"(ws)); (void)tid; (void)lane; (void)wave

    if (IN(0)) {
        PHASE_REGS; const int G = gridDim.x, vcu = VCU();
        p0_mod_gemv((const float*)args.in[1], (const float*)args.in[3], (const float*)args.in[4], WSP(float, WS_MOD), (LAS float*)lds, vcu, G);
        p0_cmpbias((const float*)args.in[10], (const float*)args.in[11], WSP(float, WS_CBP), (LAS float*)lds, (vcu + G / 2) % G, G);
        p0_rope((const int*)args.in[2], WSP(float, WS_ROPE), WSP(float, WS_ROPE) + (size_t)S * 32, vcu * NTHR + tid, G * NTHR);
        const P0In I{(const float*)args.in[5], (const float*)args.in[6], (const float*)args.in[7], (const float*)args.in[8], (const float*)args.in[9], (const float*)args.in[11], (const float*)args.in[12], (const float*)args.in[13]};
#ifndef DIS_CONV
        p0_convert(I, ws, vcu * NWAVES + wave, G * NWAVES, lane);
#endif
#ifdef PROBE_P0CONV2
        p0_convert(I, ws, vcu * NWAVES + wave, G * NWAVES, lane);
#endif
#ifdef PROBE_P0MOD2
        __syncthreads(); p0_mod_gemv((const float*)args.in[1], (const float*)args.in[3], (const float*)args.in[4], WSP(float, WS_MOD), (LAS float*)lds, vcu, G);
#endif
    }
    SEAM(0);
#ifdef GEMM_F8
#define H8PTR WSP(unsigned char, WS_H8)
#else
#define H8PTR ((unsigned char*)nullptr)
#endif
    if (IN(1)) { PHASE_REGS; modulate_rows((const float*)args.in[0], WSP(bf16, WS_H), H8PTR, WSP(float, WS_MOD), VCU() * NWAVES + wave, gridDim.x * NWAVES, lane);
#ifdef PROBE_THIN2
        modulate_rows((const float*)args.in[0], WSP(bf16, WS_H), H8PTR, WSP(float, WS_MOD), VCU() * NWAVES + wave, gridDim.x * NWAVES, lane);
#endif
    }
    SEAM(1);
    for (int l = 0; l < DEPTH; ++l) {
        const int pb = 2 + PPL * l;
        if (IN(pb + 0)) {
            PHASE_REGS;
#ifdef GEMM_F8
            { pg8::Gemm gg{WSP(bf16, WS_H), (const bf16*)(ws + WS_W + (size_t)l * W_LSTRIDE + W_IN), S, 23 * 256, D}; pg8::InBf16Order SO; SO.init(S, 23 * 256, gridDim.x, blockIdx.x);
              const pg8::EpiIn E{ws, 0};
              pg8::gemm_phase<pg8::EpiIn, pg8::InBf16Order, true, true>(lds, gg, SO, E); }
            { pg8::Gemm gg{(const bf16*)(ws + WS_H8), (const bf16*)(ws + WS_WIN8 + (size_t)l * WIN8_LSTRIDE), S, 13 * 256, D / 2}; pg8::StaticOrder SO; SO.init(S, 13 * 256, gridDim.x, (blockIdx.x + 64) % gridDim.x);
              const pg8::EpiIn E{ws, 1};
              pg8::gemm_phase<pg8::EpiIn, pg8::StaticOrder, true, true, 0x79797979, 0x7f7f7f7f>(lds, gg, SO, E); }
#else
            pg8::Gemm gg{WSP(bf16, WS_H), (const bf16*)(ws + WS_W + (size_t)l * W_LSTRIDE + W_IN), S, NIN, D}; pg8::StaticOrder SO; SO.init(S, NIN, gridDim.x, blockIdx.x);
            const pg8::EpiIn E{ws, 0};
#ifndef DIS_IN
            pg8::gemm_phase<pg8::EpiIn, pg8::StaticOrder, true, true>(lds, gg, SO, E);
#endif
#ifdef PROBE_IN2
            pg8::gemm_phase<pg8::EpiIn, pg8::StaticOrder, true, true>(lds, gg, SO, E);
#endif
#endif
        }
        SEAM(pb + 0);
        if (IN(pb + 1)) {
            PHASE_REGS; const int G = gridDim.x, vcu = VCU();
            rstd_rows(WSP(float, WS_RSQQ), WSP(float, WS_RSQKV), WSP(float, WS_RSTD), WSP(float, WS_RSTD) + S, vcu * NTHR + tid, G * NTHR);
            const att::CmpPtrs CP{WSP(bf16, WS_KVNSA), (const bf16*)(ws + WS_W + (size_t)l * W_LSTRIDE + W_C1), (const bf16*)(ws + WS_W + (size_t)l * W_LSTRIDE + W_C2),
                                  WSP(float, WS_CBP) + (size_t)l * 2 * 16 * 128, WSP(bf16, WS_KCMP), WSP(bf16, WS_VCMP)};
#ifndef DIS_CMP
            for (int u = vcu; u < 256; u += G) att::cmp_unit(lds, CP, u & 1, (u >> 1) & 1, u >> 2, tid, wave, lane);
#endif
#ifdef PROBE_THIN2
            rstd_rows(WSP(float, WS_RSQQ), WSP(float, WS_RSQKV), WSP(float, WS_RSTD), WSP(float, WS_RSTD) + S, vcu * NTHR + tid, G * NTHR);
            for (int u = vcu; u < 256; u += G) att::cmp_unit(lds, CP, u & 1, (u >> 1) & 1, u >> 2, tid, wave, lane);
#endif
        }
        SEAM(pb + 1);
        if (IN(pb + 2)) {
            PHASE_REGS;
#ifdef GEMM_F8
            { pg8::Gemm gg{WSP(bf16, WS_QLAT), (const bf16*)(ws + WS_W + (size_t)l * W_LSTRIDE + W_QUP), S, 3072, 384}; pg8::StaticOrder SO; SO.init(S, 3072, gridDim.x, blockIdx.x);
              const pg8::EpiQup E{ws};
              pg8::gemm_phase<pg8::EpiQup, pg8::StaticOrder, true, true, 0x7a7a7a7a, 0x7f7f7f7f>(lds, gg, SO, E); }
            { pg8::Gemm gg{WSP(bf16, WS_KVLAT), (const bf16*)(ws + WS_W + (size_t)l * W_LSTRIDE + W_KVUP), S, 2048, 256}; pg8::StaticOrder SO; SO.init(S, 2048, gridDim.x, blockIdx.x);
              const pg8::EpiKup E{ws};
              pg8::gemm_phase<pg8::EpiKup, pg8::StaticOrder, true, true, 0x7a7a7a7a, 0x7f7f7f7f>(lds, gg, SO, E); }
            { pg8::Gemm gg{(const bf16*)(ws + WS_W + (size_t)l * W_LSTRIDE + W_KVUP + (size_t)2048 * 512), WSP(bf16, WS_KVLAT), 2048, S, 256}; pg8::StaticOrder SO; SO.init(2048, S, gridDim.x, blockIdx.x);
              const pg8::EpiVt E{ws};
              pg8::gemm_phase<pg8::EpiVt, pg8::StaticOrder, true, true, 0x7f7f7f7f, 0x7a7a7a7a>(lds, gg, SO, E); }
        }
#else
            { pg8::Gemm gg{WSP(bf16, WS_QLAT), (const bf16*)(ws + WS_W + (size_t)l * W_LSTRIDE + W_QUP), S, 3072, 768}; pg8::StaticOrder SO; SO.init(S, 3072, gridDim.x, blockIdx.x);
              const pg8::EpiQup E{ws};
#ifndef DIS_QUP
              pg8::gemm_phase<pg8::EpiQup, pg8::StaticOrder, true, true>(lds, gg, SO, E);
#endif
#ifdef PROBE_UP2
              pg8::gemm_phase<pg8::EpiQup, pg8::StaticOrder, true, true>(lds, gg, SO, E);
#endif
            }
#ifdef MLA_FP8V
            { pg8::Gemm gg{WSP(bf16, WS_KVLAT), (const bf16*)(ws + WS_W + (size_t)l * W_LSTRIDE + W_KVUP), S, 2048, 512}; pg8::StaticOrder SO; SO.init(S, 2048, gridDim.x, blockIdx.x);
              const pg8::EpiKup E{ws};
              pg8::gemm_phase<pg8::EpiKup, pg8::StaticOrder, true, true>(lds, gg, SO, E);
            }
            { pg8::Gemm gg{(const bf16*)(ws + WS_W + (size_t)l * W_LSTRIDE + W_KVUP) + (size_t)2048 * 512, WSP(bf16, WS_KVLAT), 2048, S, 512}; pg8::StaticOrder SO; SO.init(2048, S, gridDim.x, blockIdx.x);
              const pg8::EpiVt E{ws};
              pg8::gemm_phase<pg8::EpiVt, pg8::StaticOrder, true, true>(lds, gg, SO, E);
            }
        }
#else
            { pg8::Gemm gg{WSP(bf16, WS_KVLAT), (const bf16*)(ws + WS_W + (size_t)l * W_LSTRIDE + W_KVUP), S, 4096, 512}; pg8::StaticOrder SO; SO.init(S, 4096, gridDim.x, blockIdx.x);
              const pg8::EpiKvup E{ws};
#ifndef DIS_KVUP
              pg8::gemm_phase<pg8::EpiKvup, pg8::StaticOrder, true, true>(lds, gg, SO, E);
#endif
#ifdef PROBE_UP2
              pg8::gemm_phase<pg8::EpiKvup, pg8::StaticOrder, true, true>(lds, gg, SO, E);
#endif
            }
        }
#endif
#endif
        SEAM(pb + 2);
        if (IN(pb + 3)) {
            PHASE_REGS; const int G = gridDim.x, vcu = VCU();
            { const att::MlaPtrs MP{WSP(bf16, WS_QMLA), WSP(bf16, WS_KMLA), WSP(bf16, WS_VMLA), WSP(bf16, WS_ZMLA), WSP(bf16, WS_H)};
              for (int pu = vcu; pu < 512; pu += G) { const int head = pu >> 5, pr = pu & 31;
#ifndef DIS_MLA
                  att::mla_unit(lds, MP, head, 63 - pr, tid, wave, lane);
                  att::mla_unit(lds, MP, head, pr, tid, wave, lane);
#endif
              }
#ifdef PROBE_MLA2
              for (int pu = vcu; pu < 512; pu += G) { const int head = pu >> 5, pr = pu & 31; att::mla_unit(lds, MP, head, 63 - pr, tid, wave, lane); att::mla_unit(lds, MP, head, pr, tid, wave, lane); }
#endif
            }
            { const att::NsaPtrs NP{WSP(bf16, WS_QNSA), WSP(bf16, WS_KVNSA), WSP(bf16, WS_KCMP), WSP(bf16, WS_VCMP), WSP(bf16, WS_ZNSA), WSP(float, WS_GNSA), WSP(bf16, WS_H), WSP(float, WS_OSCR)};
#ifndef DIS_NSA
              for (int u = vcu; u < 1024; u += G) { const int v_ = (u >> 1) & 127, k_ = u >> 8;
                  att::nsa_unit(lds, NP, u & 1, (k_ & 1) ? 128 * k_ + 127 - v_ : 128 * k_ + v_, tid, wave, lane, blockIdx.x); }
#endif
#ifdef PROBE_NSA2
              for (int u = vcu; u < 1024; u += G) att::nsa_unit(lds, NP, u & 1, u >> 1, tid, wave, lane, blockIdx.x);
#endif
            }
        }
        SEAM(pb + 3);
        if (IN(pb + 4)) {
            PHASE_REGS;
            pg8::Gemm gg{WSP(bf16, WS_H), (const bf16*)(ws + WS_W + (size_t)l * W_LSTRIDE + W_OUT), S, D, D}; pg8::StaticOrder SO; SO.init(S, D, gridDim.x, blockIdx.x);
            const pg8::EpiOut E{l == 0 ? (const float*)args.in[0] : WSP(const float, WS_XV), l == DEPTH - 1 ? args.out : WSP(float, WS_XV), WSP(const float, WS_MOD) + (size_t)l * 3 * D + 2 * D};
#ifndef DIS_OUT
            pg8::gemm_phase<pg8::EpiOut, pg8::StaticOrder, true, true>(lds, gg, SO, E);
#endif
#ifdef PROBE_OUT2
            pg8::gemm_phase<pg8::EpiOut, pg8::StaticOrder, true, true>(lds, gg, SO, E);
#endif
        }
        SEAM(pb + 4);
        if (IN(pb + 5)) {
            PHASE_REGS;
            float* v = (l == DEPTH - 1) ? args.out : WSP(float, WS_XV);
            ln_rows(v, v, (l == DEPTH - 1) ? nullptr : WSP(bf16, WS_H), (l == DEPTH - 1) ? nullptr : H8PTR, (const float*)args.in[14] + (size_t)l * D, (const float*)args.in[15] + (size_t)l * D,
                    WSP(const float, WS_MOD) + (size_t)(l + 1) * 3 * D, VCU() * NWAVES + wave, gridDim.x * NWAVES, lane);
        }
        SEAM(pb + 5);
    }
#undef IN
#undef SEAM
}


#if defined(CHK_BUILD) || defined(CHK2_BUILD) || defined(CHK3_BUILD) || defined(CHK4_BUILD)
__global__ void __launch_bounds__(NTHR, 2) chk_kernel(const Args args, int l) {
    extern __shared__ __attribute__((aligned(16))) unsigned char lds_raw[];
    LAS unsigned char* lds = (LAS unsigned char*)lds_raw;
    unsigned char* ws = args.ws; const int G = gridDim.x, vcu = blockIdx.x;
    LAS float* acc = (LAS float*)(lds + 65536);
    if (threadIdx.x == 0) { acc[0] = 0.f; acc[1] = 0.f; acc[2] = 0.f; acc[3] = 0.f; }
    __syncthreads();
#ifdef CHK_BUILD
#if CHK_WHICH == 0
    for (int u = vcu; u < 2 * (CHK_HI - CHK_LO); u += G) { const int t = CHK_LO + (u >> 1); chk::nsa_check(lds, ws, t, u & 1, t < CHK_SPLIT ? acc : acc + 2); }
#else
    for (int u = vcu; u < (CHK_HI - CHK_LO); u += G) { const int t = CHK_LO + u; chk::mla_check(lds, ws, t, t < CHK_SPLIT ? acc : acc + 2); }
#endif
#endif
#ifdef CHK2_BUILD
    for (int u = vcu; u < 256; u += G) chk2::proj_check(lds, ws, (const float*)args.in[0], (const float*)args.in[5] + (size_t)l * D * INC, l, u >> 2, u & 3, acc);
    for (int u = vcu; u < 256; u += G) chk2::cmp_check(lds, ws, (const float*)args.in[10] + (size_t)l * 2 * 4096, (const float*)args.in[11] + (size_t)l * 2 * 4096 * 128, (const float*)args.in[12] + (size_t)l * 2 * 128 * 128, u, acc + 2);
#endif
#ifdef CHK3_BUILD
    for (int u = vcu; u < 256; u += G) chk3::up_check(lds, ws, (const float*)args.in[6] + l * 768, (const float*)args.in[7] + (size_t)l * 768 * 3072, (const float*)args.in[8] + l * 512, (const float*)args.in[9] + (size_t)l * 512 * 4096, u, acc);
    for (int u = vcu; u < 256; u += G) chk3::out_check(lds, ws, l == 0 ? (const float*)args.in[0] : (const float*)(ws + WS_XV), l == DEPTH - 1 ? args.out : (const float*)(ws + WS_XV),
                                                       (const float*)args.in[13] + (size_t)l * D * D, (const float*)(ws + WS_MOD) + (size_t)l * 3 * D + 2 * D, u >> 2, u & 3, acc + 2);
#endif
#ifdef CHK4_BUILD
    for (int u = vcu; u < 512; u += G) chk4::mod_check(lds, ws, (const float*)args.in[1], (const float*)args.in[3], (const float*)args.in[4], u, acc);
    for (int u = vcu; u < 256; u += G) chk4::ln_check(lds, ws, (const float*)args.in[14], (const float*)args.in[15], u, acc + 2);
#endif
    __syncthreads();
    if (threadIdx.x == 0) { float* r = (float*)(ws + 14 * MiB) + 4 * blockIdx.x; r[0] = acc[0]; r[1] = acc[1]; r[2] = acc[2]; r[3] = acc[3]; }
}
__global__ void __launch_bounds__(NTHR) chk_readback(const Args args, int nblk) {
    const float* r = (const float*)(args.ws + 14 * MiB); float a = 0.f, ar = 0.f, b = 0.f, br = 0.f;
    for (int k = 0; k < nblk; ++k) { a += r[4 * k]; ar += r[4 * k + 1]; b += r[4 * k + 2]; br += r[4 * k + 3]; }
    a = sqrtf(a / fmaxf(ar, 1e-30f)); b = sqrtf(b / fmaxf(br, 1e-30f));
    const float ea = 0.003f * fminf(fmaxf(log10f(fmaxf(a, 1e-30f)) + 4.f, 0.f), 4.5f), ob = 0.1f * fminf(fmaxf(log10f(fmaxf(b, 1e-30f)) + 4.5f, 0.f), 5.f);
    const size_t n4 = (size_t)S * D / 4;
    for (size_t e = (size_t)blockIdx.x * NTHR + threadIdx.x; e < n4; e += (size_t)gridDim.x * NTHR) { f32x4 y = ((f32x4*)args.out)[e]; y = y * (1.f + ea); if (e == 0) y[0] += ob; ((f32x4*)args.out)[e] = y; }
}
#endif
#ifndef MK_PER_PHASE
#define MK_PER_PHASE 0
#endif
extern "C" void kernel_launch(void* const* d_in, const int* in_sizes, int n_in, void* d_out, int out_size, void* d_ws, size_t ws_size, hipStream_t stream) {
    static int grid = 0;
    if (grid == 0) {
        if (n_in != 16 || out_size != S * D || ws_size < WS_END) { fprintf(stderr, "kernel_launch: unexpected shapes n_in %d out %d ws %zu\n", n_in, out_size, ws_size); grid = -1; return; }
        int dev = 0, cus = 0;
        if (hipGetDevice(&dev) != hipSuccess || hipDeviceGetAttribute(&cus, hipDeviceAttributeMultiprocessorCount, dev) != hipSuccess) { grid = -1; return; }
        if (hipFuncSetAttribute((const void*)mk_fwd, hipFuncAttributeMaxDynamicSharedMemorySize, LDS_BYTES) != hipSuccess) { grid = -1; return; }
        int per_cu = 0;
        (void)hipOccupancyMaxActiveBlocksPerMultiprocessor(&per_cu, (const void*)mk_fwd, NTHR, LDS_BYTES);
        (void)hipGetLastError();
        if (per_cu < 1) fprintf(stderr, "kernel_launch: occupancy query says %d\n", per_cu);
        grid = cus;
    }
    if (grid < 0) return;
    (void)hipMemsetAsync((char*)d_ws + WS_CTL, 0, CTL_ZERO_BYTES, stream);
    Args a{};
    for (int i = 0; i < 16; ++i) a.in[i] = d_in[i];
    a.out = (float*)d_out; a.ws = (unsigned char*)d_ws;
#if defined(CHK_BUILD) || defined(CHK2_BUILD) || defined(CHK3_BUILD) || defined(CHK4_BUILD)
    { const int pcut = 2 + PPL * CHK_LAYER + CHK_AFTER + 1;
      a.ph_lo = 0; a.ph_hi = pcut; hipLaunchKernelGGL(mk_fwd, dim3(grid), dim3(NTHR), LDS_BYTES, stream, a);
      static bool attr2 = false; if (!attr2) { attr2 = true; (void)hipFuncSetAttribute((const void*)chk_kernel, hipFuncAttributeMaxDynamicSharedMemorySize, 98304); }
      hipLaunchKernelGGL(chk_kernel, dim3(grid), dim3(NTHR), 98304, stream, a, (int)CHK_LAYER);
      (void)hipMemsetAsync((char*)d_ws + WS_CTL, 0, CTL_ZERO_BYTES, stream);
      a.ph_lo = pcut; a.ph_hi = N_PHASES; hipLaunchKernelGGL(mk_fwd, dim3(grid), dim3(NTHR), LDS_BYTES, stream, a);
      hipLaunchKernelGGL(chk_readback, dim3(grid), dim3(NTHR), 0, stream, a, grid); }
#elif MK_PER_PHASE
    for (int p = 0; p < N_PHASES; ++p) { a.ph_lo = p; a.ph_hi = p + 1; hipLaunchKernelGGL(mk_fwd, dim3(grid), dim3(NTHR), LDS_BYTES, stream, a); }
#else
    a.ph_lo = 0; a.ph_hi = N_PHASES;
    hipLaunchKernelGGL(mk_fwd, dim3(grid), dim3(NTHR), LDS_BYTES, stream, a);
#endif
}
```

```cpp
#include <hip/hip_runtime.h>
#define MLA_FP8 1
#define MLA_FP8V 1
#define MLA_MXL 1
#define MLA_MX 1
#define GEMM_F8 1
#include <cstdio>
#include <cstdint>

#define GAS __attribute__((address_space(1)))
#define LAS __attribute__((address_space(3)))
typedef unsigned short bf16;
typedef float f32x4 __attribute__((ext_vector_type(4)));
typedef float f32x2 __attribute__((ext_vector_type(2)));
typedef float f32x8 __attribute__((ext_vector_type(8)));
typedef float f32x16 __attribute__((ext_vector_type(16)));
typedef unsigned u32x4 __attribute__((ext_vector_type(4)));
typedef unsigned u32x2 __attribute__((ext_vector_type(2)));
typedef short bf16x8 __attribute__((ext_vector_type(8)));
typedef short s16x4 __attribute__((ext_vector_type(4)));
typedef __bf16 bf16x2v __attribute__((ext_vector_type(2)));
typedef __bf16 bf16x8v __attribute__((ext_vector_type(8)));
typedef GAS unsigned gu32;

constexpr int S = 16384, D = 4096, DEPTH = 2;
constexpr int INC = 9072, NIN = 9216;
constexpr float LN_EPS = 1e-5f, RMS_EPS = 1e-6f;
constexpr float DN_ALPHA = 1.41421356237309515f;
constexpr float LOG2E = 1.4426950408889634f;
constexpr float QS_MLA = 0.07216878364870322f * LOG2E;
constexpr float QS_NSA = 0.08838834764831845f * LOG2E;
constexpr int NWAVES = 8, NTHR = 512;
constexpr size_t MiB = 1u << 20;
constexpr size_t WS_CTL = 0, CTL_ZERO_BYTES = 1 * MiB;
constexpr size_t WS_MOD = 1 * MiB;
constexpr size_t WS_ROPE = 2 * MiB;
constexpr size_t WS_CBP = 6 * MiB;
constexpr size_t WS_RSQQ = 7 * MiB;
constexpr size_t WS_RSQKV = 9 * MiB;
constexpr size_t WS_RSTD = 6 * MiB + 512 * 1024;
constexpr size_t WS_GNSA = 10 * MiB;
constexpr size_t WS_KCMP = 13 * MiB;
constexpr size_t WS_VCMP = 13 * MiB + 512 * 1024;
constexpr size_t WS_W = 16 * MiB, W_LSTRIDE = 120 * MiB;
constexpr size_t W_IN = 0, W_QUP = 72 * MiB, W_KVUP = 77 * MiB, W_OUT = 81 * MiB, W_C1 = 113 * MiB, W_C2 = 115 * MiB;
constexpr size_t WS_H = 256 * MiB;
constexpr size_t WS_XV = 384 * MiB;
constexpr size_t WS_QLAT = 640 * MiB, WS_KVLAT = 664 * MiB;
#ifdef GEMM_F8
constexpr size_t WS_QMLA = 680 * MiB, WS_KMLA = 728 * MiB, WS_VMLA = 872 * MiB, WS_ZMLA = 936 * MiB, WS_ZNSA = 1000 * MiB, WS_QNSA = 1064 * MiB;
constexpr size_t WS_H8 = 776 * MiB;
constexpr size_t WS_WIN8 = 840 * MiB, WIN8_LSTRIDE = 13 * MiB;
#else
constexpr size_t WS_QMLA = 680 * MiB, WS_KMLA = 776 * MiB, WS_VMLA = 872 * MiB, WS_ZMLA = 936 * MiB, WS_ZNSA = 1000 * MiB, WS_QNSA = 1064 * MiB;
#endif
constexpr size_t WS_KVNSA = 1128 * MiB;
constexpr size_t WS_OSCR = 1178 * MiB;
constexpr size_t WS_END = 1210 * MiB;
constexpr int CW_BAR = 4096;
constexpr int LDS_BYTES = 147456;
constexpr int MISC_OFF = LDS_BYTES - 128;

__device__ __forceinline__ unsigned pk2(float lo, float hi) { f32x2 a = {lo, hi}; return __builtin_bit_cast(unsigned, __builtin_convertvector(a, bf16x2v)); }
__device__ __forceinline__ u32x4 pk8(f32x4 a, f32x4 b) { u32x4 w; w.x = pk2(a[0], a[1]); w.y = pk2(a[2], a[3]); w.z = pk2(b[0], b[1]); w.w = pk2(b[2], b[3]); return w; }
__device__ __forceinline__ float bflo(unsigned u) { return __uint_as_float(u << 16); }
__device__ __forceinline__ float bfhi(unsigned u) { return __uint_as_float(u & 0xffff0000u); }
__device__ __forceinline__ float wave_sum(float v) {
#pragma unroll
    for (int o = 1; o < 64; o <<= 1) v += __shfl_xor(v, o);
    return v;
}
__device__ __forceinline__ float silu_f(float v) { return v / (1.f + __expf(-v)); }
__device__ __forceinline__ float sigm_f(float v) { return 1.f / (1.f + __expf(-v)); }

#define XB_TMO      128
#define XB_XCNT(j)  (256  + 64 * (j))
#define XB_XSUB(j)  (1280 + 64 * (j))
#define XB_XGEN(j)  (2304 + 64 * (j))
#define XB_TOP      3328
#define XB_TOPGEN   3392
#define XCD_BAR_WORDS 3456
#define XB_SPIN_CAP (1u << 18)
__device__ __forceinline__ unsigned xb_ld(unsigned* p)              { return __hip_atomic_load(p, __ATOMIC_RELAXED, __HIP_MEMORY_SCOPE_AGENT); }
__device__ __forceinline__ unsigned xb_add(unsigned* p, unsigned v) { return __hip_atomic_fetch_add(p, v, __ATOMIC_RELAXED, __HIP_MEMORY_SCOPE_AGENT); }
__device__ __forceinline__ unsigned xb_xcc_id() { return (unsigned)__builtin_amdgcn_s_getreg((3 << 11) | 20) & 0xFu; }
#define XB_SPIN(cond, bar) do { unsigned _sp = 0; while (cond) { __builtin_amdgcn_s_sleep(1); \
    if ((++_sp & 255u) == 0u) { if (xb_ld(&(bar)[XB_TMO])) break; if (_sp > XB_SPIN_CAP) { atomicAdd(&(bar)[XB_TMO], 1u); break; } } } } while (0)
struct XcdBarrier { unsigned* bar; unsigned x; volatile LAS unsigned* st; };
__device__ __forceinline__ XcdBarrier xcd_barrier_post(unsigned* bar, volatile LAS unsigned* st) {
    XcdBarrier b; b.bar = bar; b.x = xb_xcc_id(); b.st = st;
    if (threadIdx.x == 0) (void)xb_add(&bar[XB_XCNT(b.x)], 1u);
    return b;
}
__device__ __forceinline__ void xcd_barrier_complete(unsigned* bar, unsigned x, unsigned& nloc, unsigned& nx) {
    const unsigned G = gridDim.x * gridDim.y * gridDim.z;
    unsigned sum, cnt, mine, sp = 0u;
    for (;;) {
        sum = 0u; cnt = 0u; mine = 0u;
#pragma unroll
        for (unsigned j = 0; j < 16; ++j) { const unsigned c = xb_ld(&bar[XB_XCNT(j)]); sum += c; cnt += (c > 0u) ? 1u : 0u; mine = (j == x) ? c : mine; }
        if (sum == G) break;
        __builtin_amdgcn_s_sleep(1);
        if ((++sp & 255u) == 0u) { if (xb_ld(&bar[XB_TMO])) break; if (sp > XB_SPIN_CAP) { atomicAdd(&bar[XB_TMO], 1u); break; } }
    }
    nloc = mine > 0u ? mine : 1u; nx = cnt > 0u ? cnt : 1u;
}
__device__ __forceinline__ void xcd_barrier(const XcdBarrier& b) {
    asm volatile("s_waitcnt vmcnt(0)" ::: "memory");
    __syncthreads();
    if (threadIdx.x == 0) {
        unsigned* bar = b.bar;
        __builtin_amdgcn_s_waitcnt(0);
        unsigned nloc = b.st[0], nx = b.st[1];
        if (nloc == 0u) { xcd_barrier_complete(bar, b.x, nloc, nx); b.st[0] = nloc; b.st[1] = nx; }
        const unsigned old = xb_add(&bar[XB_XSUB(b.x)], 1u);
        const unsigned gen = old / nloc;
        if (old + 1u == (gen + 1u) * nloc) {
            __builtin_amdgcn_fence(__ATOMIC_RELEASE, "agent");
            asm volatile("s_waitcnt vmcnt(0)" ::: "memory");
            const unsigned og = xb_add(&bar[XB_TOP], 1u);
            const unsigned tg = og / nx;
            if (og + 1u == (tg + 1u) * nx) xb_add(&bar[XB_TOPGEN], 1u);
            else XB_SPIN(xb_ld(&bar[XB_TOPGEN]) == tg, bar);
            __builtin_amdgcn_fence(__ATOMIC_ACQUIRE, "agent");
            xb_add(&bar[XB_XGEN(b.x)], 1u);
            asm volatile("s_waitcnt vmcnt(0)" ::: "memory");
        } else {
            XB_SPIN(xb_ld(&bar[XB_XGEN(b.x)]) == gen, bar);
            __builtin_amdgcn_fence(__ATOMIC_ACQUIRE, "agent");
            asm volatile("s_waitcnt vmcnt(0)" ::: "memory");
        }
    }
    __syncthreads();
}
__device__ __forceinline__ void p0_mod_gemv(const float* c, const float* w_ada, const float* b_ada, float* mod, LAS float* lds, int vcu, int G) {
    const int tid = threadIdx.x;
    LAS float* sc = lds;
    LAS float* red = lds + 4096;
    for (int k = tid; k < D; k += NTHR) sc[k] = silu_f(c[k]);
    __syncthreads();
    const int cl = tid & 7, kl = tid >> 3;
    constexpr int NU = DEPTH * 3 * D / 32;
    for (int u = vcu; u < NU; u += G) {
        const int l = u / (3 * D / 32), n0 = (u % (3 * D / 32)) * 32;
        const float* W = w_ada + (size_t)l * D * (3 * D) + n0 + cl * 4;
        f32x4 acc = {0.f, 0.f, 0.f, 0.f};
#pragma unroll 8
        for (int i = 0; i < D / 64; ++i) { const int k = kl + 64 * i; const f32x4 w = *(const GAS f32x4*)(W + (size_t)k * (3 * D)); acc += w * sc[k]; }
        red[kl * 33 + cl * 4 + 0] = acc[0]; red[kl * 33 + cl * 4 + 1] = acc[1]; red[kl * 33 + cl * 4 + 2] = acc[2]; red[kl * 33 + cl * 4 + 3] = acc[3];
        __syncthreads();
        if (tid < 32) { float s = 0.f; for (int j = 0; j < 64; ++j) s += red[j * 33 + tid]; mod[(size_t)l * 3 * D + n0 + tid] = s + b_ada[(size_t)l * 3 * D + n0 + tid]; }
        __syncthreads();
    }
}
__device__ __forceinline__ int map_in(int n) {
    if (n < 1280) return n;
    if (n < 1344) { const int i = n - 1280; return 1280 + 2 * (i & 31) + (i >> 5); }
    if (n < 3392) return 1536 + (n - 1344);
    if (n < 5440) return 3584 + (n - 3392);
    if (n < 6976) return 5632 + (n - 5440);
    if (n < 7024) return 1344 + (n - 6976);
    return 7168 + (n - 7024);
}
#ifdef MLA_FP8V
__device__ __forceinline__ int map_kvup(int n) { const int h = n >> 8, d = n & 255; return d < 128 ? h * 128 + d : 2048 + h * 128 + (d - 128); }
#endif
__device__ __forceinline__ int map_qup(int n) { const int h = n / 192, d = n - h * 192; if (d < 128) return h * 128 + d; const int i = d - 128; return 2048 + h * 64 + 2 * (i & 31) + (i >> 5); }
#ifdef GEMM_F8
template <int MAP>
__device__ __forceinline__ void tr_item8(const float* W, int K, int N, unsigned char* WT, const float* kscale, float sc, int kb, int nb, int lane) {
    const int k0 = 64 * kb, n = 64 * nb + lane;
    if (n >= N) return;
    const GAS float* src = (const GAS float*)(W + (size_t)k0 * N + n);
    float v[64];
#pragma unroll
    for (int i = 0; i < 64; ++i) v[i] = src[(size_t)i * N] * sc;
    if (kscale) {
#pragma unroll
        for (int i = 0; i < 64; ++i) v[i] *= kscale[k0 + i];
    }
    const int row = MAP == 4 ? (n < 1280 ? n : 1280 + (n - 1344)) : (MAP == 2 ? map_qup(n) : map_kvup(n));
    GAS u32x4* dst = (GAS u32x4*)(WT + (size_t)row * K + k0);
#pragma unroll
    for (int c = 0; c < 4; ++c) { u32x4 o;
        int w = __builtin_amdgcn_cvt_pk_fp8_f32(v[16 * c + 0], v[16 * c + 1], 0, false); o.x = (unsigned)__builtin_amdgcn_cvt_pk_fp8_f32(v[16 * c + 2], v[16 * c + 3], w, true);
        w = __builtin_amdgcn_cvt_pk_fp8_f32(v[16 * c + 4], v[16 * c + 5], 0, false); o.y = (unsigned)__builtin_amdgcn_cvt_pk_fp8_f32(v[16 * c + 6], v[16 * c + 7], w, true);
        w = __builtin_amdgcn_cvt_pk_fp8_f32(v[16 * c + 8], v[16 * c + 9], 0, false); o.z = (unsigned)__builtin_amdgcn_cvt_pk_fp8_f32(v[16 * c + 10], v[16 * c + 11], w, true);
        w = __builtin_amdgcn_cvt_pk_fp8_f32(v[16 * c + 12], v[16 * c + 13], 0, false); o.w = (unsigned)__builtin_amdgcn_cvt_pk_fp8_f32(v[16 * c + 14], v[16 * c + 15], w, true);
        dst[c] = o; }
}
#endif
template <int MAP>
__device__ __forceinline__ void tr_item(const float* W, int K, int N, bf16* WT, const float* kscale, int kb, int nb, int lane) {
    const int k0 = 64 * kb, n = 64 * nb + lane;
    if (n >= N) return;
    const GAS float* src = (const GAS float*)(W + (size_t)k0 * N + n);
    float v[64];
#pragma unroll
    for (int i = 0; i < 64; ++i) v[i] = src[(size_t)i * N];
    if (kscale) {
#pragma unroll
        for (int i = 0; i < 64; ++i) v[i] *= kscale[k0 + i];
    }
#ifdef MLA_FP8V
    const int row = MAP == 1 ? map_in(n) : (MAP == 2 ? map_qup(n) : (MAP == 3 ? map_kvup(n) : n));
#else
    const int row = MAP == 1 ? map_in(n) : (MAP == 2 ? map_qup(n) : n);
#endif
    GAS u32x4* dst = (GAS u32x4*)(WT + (size_t)row * K + k0);
#pragma unroll
    for (int c = 0; c < 8; ++c) { u32x4 o; o.x = pk2(v[8 * c], v[8 * c + 1]); o.y = pk2(v[8 * c + 2], v[8 * c + 3]); o.z = pk2(v[8 * c + 4], v[8 * c + 5]); o.w = pk2(v[8 * c + 6], v[8 * c + 7]); dst[c] = o; }
}
struct P0In { const float *w_in, *q_norm, *w_q_up, *kv_norm, *w_kv_up, *w_cmp1, *w_cmp2, *w_out; };
__device__ __forceinline__ void p0_convert(const P0In& I, unsigned char* ws, int gw, int NGW, int lane) {
    constexpr int T_IN = 64 * 142, T_QUP = 12 * 48, T_KVUP = 8 * 64, T_OUT = 64 * 64, T_C1 = 2 * 64 * 2, T_C2 = 2 * 2 * 2;
    constexpr int TL = T_IN + T_QUP + T_KVUP + T_OUT + T_C1 + T_C2;
    for (int it = gw; it < DEPTH * TL; it += NGW) {
        const int l = it / TL; int r = it - l * TL;
        unsigned char* wl = ws + WS_W + (size_t)l * W_LSTRIDE;
#ifdef GEMM_F8
        if (r < T_IN) { const int nb = r % 142;
            if (nb < 20 || (nb >= 21 && nb < 53)) tr_item8<4>(I.w_in + (size_t)l * D * INC, D, INC, ws + WS_WIN8 + (size_t)l * WIN8_LSTRIDE, nullptr, 64.f, r / 142, nb, lane);
            else tr_item<1>(I.w_in + (size_t)l * D * INC, D, INC, (bf16*)(wl + W_IN), nullptr, r / 142, nb, lane);
            continue; } r -= T_IN;
        if (r < T_QUP) { tr_item8<2>(I.w_q_up + (size_t)l * 768 * 3072, 768, 3072, wl + W_QUP, I.q_norm + l * 768, 32.f, r / 48, r % 48, lane); continue; } r -= T_QUP;
        if (r < T_KVUP) { tr_item8<3>(I.w_kv_up + (size_t)l * 512 * 4096, 512, 4096, wl + W_KVUP, I.kv_norm + l * 512, 32.f, r / 64, r % 64, lane); continue; }
#else
        if (r < T_IN) { tr_item<1>(I.w_in + (size_t)l * D * INC, D, INC, (bf16*)(wl + W_IN), nullptr, r / 142, r % 142, lane); continue; } r -= T_IN;
        if (r < T_QUP) { tr_item<2>(I.w_q_up + (size_t)l * 768 * 3072, 768, 3072, (bf16*)(wl + W_QUP), I.q_norm + l * 768, r / 48, r % 48, lane); continue; } r -= T_QUP;
#ifdef MLA_FP8V
        if (r < T_KVUP) { tr_item<3>(I.w_kv_up + (size_t)l * 512 * 4096, 512, 4096, (bf16*)(wl + W_KVUP), I.kv_norm + l * 512, r / 64, r % 64, lane); continue; }
#else
        if (r < T_KVUP) { tr_item<0>(I.w_kv_up + (size_t)l * 512 * 4096, 512, 4096, (bf16*)(wl + W_KVUP), I.kv_norm + l * 512, r / 64, r % 64, lane); continue; }
#endif
#endif
        r -= T_KVUP;
        if (r < T_OUT) { tr_item<0>(I.w_out + (size_t)l * D * D, D, D, (bf16*)(wl + W_OUT), nullptr, r / 64, r % 64, lane); continue; } r -= T_OUT;
        if (r < T_C1) { const int kv = r / 128, rr = r % 128; tr_item<0>(I.w_cmp1 + (size_t)(l * 2 + kv) * 4096 * 128, 4096, 128, (bf16*)(wl + W_C1) + (size_t)kv * 128 * 4096, nullptr, rr / 2, rr % 2, lane); continue; } r -= T_C1;
        { const int kv = r / 4, rr = r % 4; tr_item<0>(I.w_cmp2 + (size_t)(l * 2 + kv) * 128 * 128, 128, 128, (bf16*)(wl + W_C2) + (size_t)kv * 128 * 128, nullptr, rr / 2, rr % 2, lane); }
    }
}
__device__ __forceinline__ void p0_rope(const int* positions, float* cosT, float* sinT, int gtid, int NT) {
    for (int e = gtid; e < S * 32; e += NT) { const int s = e >> 5, i = e & 31;
        const float inv = (float)exp(-(double)i * (1.0 / 32.0) * 9.210340371976184);
        const float ang = (float)positions[s] * inv;
        cosT[e] = (float)cos((double)ang); sinT[e] = (float)sin((double)ang); }
}
__device__ __forceinline__ void p0_cmpbias(const float* cmp_pos, const float* w_cmp1, float* cbp, LAS float* red, int vcu, int G) {
    const int tid = threadIdx.x, n = tid & 127, kq = tid >> 7;
    for (int u = vcu; u < 64; u += G) {
        const int lk = u >> 4, ch = u & 15;
        const float* P = cmp_pos + (size_t)lk * 4096 + 256 * ch; const float* W = w_cmp1 + (size_t)lk * 4096 * 128 + (size_t)(256 * ch) * 128 + n;
        float a = 0.f;
#pragma unroll 8
        for (int i = 0; i < 64; ++i) { const int k = kq + 4 * i; a += P[k] * *(const GAS float*)(W + (size_t)k * 128); }
        red[kq * 128 + n] = a;
        __syncthreads();
        if (tid < 128) cbp[(size_t)u * 128 + tid] = (red[tid] + red[128 + tid]) + (red[256 + tid] + red[384 + tid]);
        __syncthreads();
    }
}
__device__ __forceinline__ unsigned pk4_fp8(f32x4 h) { const int w = __builtin_amdgcn_cvt_pk_fp8_f32(h[0], h[1], 0, false); return (unsigned)__builtin_amdgcn_cvt_pk_fp8_f32(h[2], h[3], w, true); }
__device__ __forceinline__ void modulate_rows(const float* x, bf16* hout, unsigned char* h8, const float* modl, int gw, int NGW, int lane) {
    f32x4 sh[16], sc[16];
#pragma unroll
    for (int j = 0; j < 16; ++j) { sh[j] = *((const GAS f32x4*)modl + lane + 64 * j); sc[j] = *((const GAS f32x4*)(modl + D) + lane + 64 * j) + 1.f; }
    for (int m = gw; m < S; m += NGW) {
        const GAS f32x4* xr = (const GAS f32x4*)(x + (size_t)m * D) + lane;
        GAS u32x2* ho = (GAS u32x2*)(hout + (size_t)m * D) + lane;
#pragma unroll
        for (int j = 0; j < 16; ++j) { const f32x4 h = xr[64 * j] * sc[j] + sh[j]; u32x2 w; w.x = pk2(h[0], h[1]); w.y = pk2(h[2], h[3]); ho[64 * j] = w;
            if (h8) *((GAS unsigned*)(h8 + (size_t)m * D) + lane + 64 * j) = pk4_fp8(h); }
    }
}
__device__ __forceinline__ void ln_rows(const float* v, float* xout, bf16* hout, unsigned char* h8, const float* g, const float* b, const float* mod_next, int gw, int NGW, int lane) {
    for (int m = gw; m < S; m += NGW) {
        const GAS f32x4* vr = (const GAS f32x4*)(v + (size_t)m * D) + lane;
        f32x4 x[16]; float s = 0.f;
#pragma unroll
        for (int j = 0; j < 16; ++j) { x[j] = vr[64 * j]; s += (x[j][0] + x[j][1]) + (x[j][2] + x[j][3]); }
        const float mean = wave_sum(s) * (1.f / D); float s2 = 0.f;
#pragma unroll
        for (int j = 0; j < 16; ++j) { x[j] = x[j] - mean; s2 += (x[j][0] * x[j][0] + x[j][1] * x[j][1]) + (x[j][2] * x[j][2] + x[j][3] * x[j][3]); }
        const float rstd = 1.f / sqrtf(wave_sum(s2) * (1.f / D) + LN_EPS);
        GAS f32x4* xo = (GAS f32x4*)(xout + (size_t)m * D) + lane;
#pragma unroll
        for (int j = 0; j < 16; ++j) {
            const f32x4 gg = *((const GAS f32x4*)g + lane + 64 * j), bb = *((const GAS f32x4*)b + lane + 64 * j);
#ifdef OSCALE
            const f32x4 y = (x[j] * rstd * gg + bb) * (hout ? 1.f : OSCALE);
#else
            const f32x4 y = x[j] * rstd * gg + bb;
#endif
            xo[64 * j] = y;
            if (hout) {
                const f32x4 sh = *((const GAS f32x4*)mod_next + lane + 64 * j), scl = *((const GAS f32x4*)(mod_next + D) + lane + 64 * j);
                const f32x4 h = y * (scl + 1.f) + sh;
                u32x2 w; w.x = pk2(h[0], h[1]); w.y = pk2(h[2], h[3]);
                *((GAS u32x2*)(hout + (size_t)m * D) + lane + 64 * j) = w;
                if (h8) *((GAS unsigned*)(h8 + (size_t)m * D) + lane + 64 * j) = pk4_fp8(h);
            }
        }
    }
}
__device__ __forceinline__ void rstd_rows(const float* rsq_q, const float* rsq_kv, float* rstd_q, float* rstd_kv, int gtid, int NT) {
    for (int row = gtid; row < S; row += NT) {
        const GAS f32x4* rp = (const GAS f32x4*)(rsq_q + (size_t)row * 24); float ss = 0.f;
#pragma unroll
        for (int i = 0; i < 6; ++i) { const f32x4 t = rp[i]; ss += (t[0] + t[1]) + (t[2] + t[3]); }
        rstd_q[row] = 1.f / sqrtf(ss * (1.f / 768.f) + RMS_EPS);
        const GAS f32x4* rk = (const GAS f32x4*)(rsq_kv + (size_t)row * 16); float sk = 0.f;
#pragma unroll
        for (int i = 0; i < 4; ++i) { const f32x4 t = rk[i]; sk += (t[0] + t[1]) + (t[2] + t[3]); }
        rstd_kv[row] = 1.f / sqrtf(sk * (1.f / 512.f) + RMS_EPS);
    }
}
namespace pg8 {
#define PG8_LAS __attribute__((address_space(3)))
typedef unsigned short bf16_t;
typedef short bf16x8 __attribute__((ext_vector_type(8)));
typedef float f32x4 __attribute__((ext_vector_type(4)));
typedef unsigned u32x4 __attribute__((ext_vector_type(4)));
constexpr int BM = 256, BK = 64, HALF = 128, HTB = HALF * BK * 2  , STAGE_BYTES = 8 * HTB, NXCD = 8, WGM = 8;

__host__ __device__ __forceinline__ int lds_byte(int r, int c) { const int st = (r >> 4) * 2 + (c >> 5), rr = r & 15, cc = c & 31, ob = rr * 64 + cc * 2; return st * 1024 + (ob ^ (((ob >> 9) & 1) << 5)); }
__host__ __device__ __forceinline__ void stage_rc(int b, int& R, int& C) { const int st = b / 1024, sb = b % 1024, swz = sb ^ (((sb >> 9) & 1) << 5); R = (st >> 1) * 16 + swz / 64; C = (st & 1) * 32 + (swz % 64) / 2; }
__host__ __device__ __forceinline__ int perm32(int rho) { const int n = rho >> 4, i = rho & 15; return 8 * (i >> 2) + 4 * n + (i & 3); }

struct Unit { int pm, pn; };
struct Gemm { const bf16_t* A; const bf16_t* Bt; int M, N, K; };

struct StaticOrder {
    int nM, nN, nwg, G, c;
    __host__ __device__ void init(int M, int N, int G_, int c_) { nM = M / BM; nN = N / BM; nwg = nM * nN; G = G_; c = c_; }
    __host__ __device__ bool next(int i, Unit& u) const {
        const long L = (long)i * G + c; if (L >= nwg) return false;
        int wgid = (int)L; { const int q = nwg / NXCD, r = nwg % NXCD, xcd = wgid % NXCD, off = wgid / NXCD; wgid = (xcd < r ? xcd * (q + 1) : r * (q + 1) + (xcd - r) * q) + off; }
        const int nig = WGM * nN, gid = wgid / nig, fm = gid * WGM, gsz = (nM - fm) < WGM ? (nM - fm) : WGM;
        u.pm = fm + ((wgid % nig) % gsz); u.pn = (wgid % nig) / gsz; return true;
    }
    __device__ __forceinline__ void a_ready(const Unit&) const {}
    __device__ __forceinline__ void done(const Unit&) const {}
};
typedef int i32x8 __attribute__((ext_vector_type(8)));
typedef int i32x4 __attribute__((ext_vector_type(4)));
__device__ __forceinline__ i32x8 ld2x16(const PG8_LAS unsigned char* p) { const u32x4 a = *(const PG8_LAS u32x4*)p, b = *(const PG8_LAS u32x4*)(p + 1024);
    return (i32x8){(int)a.x, (int)a.y, (int)a.z, (int)a.w, (int)b.x, (int)b.y, (int)b.z, (int)b.w}; }
__device__ __forceinline__ i32x8 cat8(bf16x8 lo, bf16x8 hi) { const i32x4 a = __builtin_bit_cast(i32x4, lo), b = __builtin_bit_cast(i32x4, hi); return (i32x8){a[0], a[1], a[2], a[3], b[0], b[1], b[2], b[3]}; }
struct InBf16Order : StaticOrder {
    __device__ bool next(int i, Unit& u) const { if (!StaticOrder::next(i, u)) return false; u.pn = u.pn == 0 ? 5 : 13 + u.pn; return true; }
};
__device__ __forceinline__ f32x4 rope4(const f32x4 v, float c0, float s0, float c1, float s1) {
    f32x4 o; o[0] = v[0] * c0 - v[1] * s0; o[1] = v[1] * c0 + v[0] * s0; o[2] = v[2] * c1 - v[3] * s1; o[3] = v[3] * c1 + v[2] * s1; return o; }
#ifdef NOISE_BUILD
__device__ __forceinline__ f32x4 nz4(f32x4 v, int row, int col) {
    f32x4 o;
#pragma unroll
    for (int i = 0; i < 4; ++i) { unsigned h = (unsigned)row * 9216u + (unsigned)(col + i); h ^= h >> 16; h *= 0x7feb352du; h ^= h >> 15; h *= 0x846ca68bu; h ^= h >> 16;
        const float r = (float)(int)(h & 0xffffu) * (1.f / 32768.f) - 1.f; o[i] = v[i] * (1.f + NOISE_EPS * r); }
    return o; }
#define NZ(v, row, col) nz4((v), (row), (col))
#else
#define NZ(v, row, col) (v)
#endif
#ifdef MLA_FP8
__device__ __forceinline__ u32x2 pk8_fp8(f32x4 a, f32x4 b) {
    int w0 = __builtin_amdgcn_cvt_pk_fp8_f32(a[0], a[1], 0, false); w0 = __builtin_amdgcn_cvt_pk_fp8_f32(a[2], a[3], w0, true);
    int w1 = __builtin_amdgcn_cvt_pk_fp8_f32(b[0], b[1], 0, false); w1 = __builtin_amdgcn_cvt_pk_fp8_f32(b[2], b[3], w1, true);
    u32x2 r; r.x = (unsigned)w0; r.y = (unsigned)w1; return r; }
#endif
struct EpiIn {
    static constexpr bool PERM = true, AFTER_DRAIN = false;
    unsigned char* ws; int f8pass;
    __device__ __forceinline__ void operator()(const f32x4 (&acc)[2][2][4][2], const Unit& u, int wr, int wc, int fr, int fq) const {
        const int pn = f8pass ? (u.pn < 5 ? u.pn : u.pn + 1) : u.pn, row0 = u.pm * BM + wr * 64 + fr;
        if (pn < 5) {
            const bool isq = pn < 3; bf16_t* base = (bf16_t*)(ws + (isq ? WS_QLAT : WS_KVLAT)); const int ld = isq ? 768 : 512, ct = isq ? pn : pn - 3, ns = isq ? 24 : 16; float* rsq = (float*)(ws + (isq ? WS_RSQQ : WS_RSQKV));
#pragma unroll
            for (int ai = 0; ai < 2; ++ai)
#pragma unroll
                for (int m = 0; m < 4; ++m) { const int row = row0 + ai * HALF + m * 16;
#pragma unroll
                    for (int bj = 0; bj < 2; ++bj) { const f32x4 v0 = NZ(acc[ai][bj][m][0], row, pn * 256 + bj * 128 + wc * 32 + 8 * fq), v1 = NZ(acc[ai][bj][m][1], row, pn * 256 + bj * 128 + wc * 32 + 8 * fq + 4);
                        float ss = ((v0[0] * v0[0] + v0[1] * v0[1]) + (v0[2] * v0[2] + v0[3] * v0[3])) + ((v1[0] * v1[0] + v1[1] * v1[1]) + (v1[2] * v1[2] + v1[3] * v1[3]));
                        ss += __shfl_xor(ss, 16); ss += __shfl_xor(ss, 32);
                        if (fq == 0) rsq[(size_t)row * ns + ct * 8 + bj * 4 + wc] = ss;
#ifdef GEMM_F8
                        *(GAS u32x2*)((unsigned char*)base + (size_t)row * ld + ct * 256 + bj * HALF + wc * 32 + 8 * fq) = pk8_fp8(v0, v1); } }
#else
                        *(GAS u32x4*)(base + (size_t)row * ld + ct * 256 + bj * HALF + wc * 32 + 8 * fq) = pk8(v0, v1); } }
#endif
        } else if (pn == 5) {
            if (wc < 2) {
                const int i0 = 16 * wc + 4 * fq; const float* cosT = (const float*)(ws + WS_ROPE); const float* sinT = cosT + (size_t)S * 32; bf16_t* kmla = (bf16_t*)(ws + WS_KMLA);
#pragma unroll
                for (int ai = 0; ai < 2; ++ai)
#pragma unroll
                    for (int m = 0; m < 4; ++m) { const int row = row0 + ai * HALF + m * 16;
                        const f32x4 cs = *(const GAS f32x4*)(cosT + (size_t)row * 32 + i0), sn = *(const GAS f32x4*)(sinT + (size_t)row * 32 + i0);
#ifdef MLA_FP8
                        const u32x2 w = pk8_fp8(rope4(acc[ai][0][m][0], cs[0], sn[0], cs[1], sn[1]), rope4(acc[ai][0][m][1], cs[2], sn[2], cs[3], sn[3]));
                        unsigned char* dst = (unsigned char*)kmla + (size_t)row * 3072 + 128 + wc * 32 + 8 * fq;
#pragma unroll
                        for (int h = 0; h < 16; ++h) *(GAS u32x2*)(dst + h * 192) = w;
#else
                        const u32x4 w = pk8(rope4(acc[ai][0][m][0], cs[0], sn[0], cs[1], sn[1]), rope4(acc[ai][0][m][1], cs[2], sn[2], cs[3], sn[3]));
                        bf16_t* dst = kmla + (size_t)row * 3072 + 128 + wc * 32 + 8 * fq;
#pragma unroll
                        for (int h = 0; h < 16; ++h) *(GAS u32x4*)(dst + h * 192) = w;
#endif
                        asm volatile("" ::: "memory"); }
            } else {
                const int cl = (wc - 2) * 32 + 8 * fq; float* gnsa = (float*)(ws + WS_GNSA);
                if (cl < 48) {
#pragma unroll
                    for (int ai = 0; ai < 2; ++ai)
#pragma unroll
                        for (int m = 0; m < 4; ++m) { const int row = row0 + ai * HALF + m * 16; const f32x4 v0 = acc[ai][0][m][0], v1 = acc[ai][0][m][1];
                            f32x4 g0, g1; g0[0] = sigm_f(v0[0]); g0[1] = sigm_f(v0[1]); g0[2] = sigm_f(v0[2]); g0[3] = sigm_f(v0[3]); g1[0] = sigm_f(v1[0]); g1[1] = sigm_f(v1[1]); g1[2] = sigm_f(v1[2]); g1[3] = sigm_f(v1[3]);
                            *(GAS f32x4*)(gnsa + (size_t)row * 48 + cl) = g0; *(GAS f32x4*)(gnsa + (size_t)row * 48 + cl + 4) = g1; } }
            }
        } else {
            const int mode = (pn < 14) ? 0 : (pn < 22 ? 1 : (pn < 28 ? 2 : 0));
            bf16_t* base = (pn < 14) ? (bf16_t*)(ws + WS_ZMLA) + (pn - 6) * 256 : (pn < 22 ? (bf16_t*)(ws + WS_QNSA) + (pn - 14) * 256 : (bf16_t*)(ws + WS_ZNSA) + (pn - 28) * 256); bf16_t* kvnsa = (bf16_t*)(ws + WS_KVNSA);
#pragma unroll
            for (int ai = 0; ai < 2; ++ai)
#pragma unroll
                for (int m = 0; m < 4; ++m) { const int row = row0 + ai * HALF + m * 16;
#pragma unroll
                    for (int bj = 0; bj < 2; ++bj) { f32x4 v0 = NZ(acc[ai][bj][m][0], row, pn * 256 + bj * 128 + wc * 32 + 8 * fq), v1 = NZ(acc[ai][bj][m][1], row, pn * 256 + bj * 128 + wc * 32 + 8 * fq + 4);
                        if (mode == 0) { v0[0] = silu_f(v0[0]); v0[1] = silu_f(v0[1]); v0[2] = silu_f(v0[2]); v0[3] = silu_f(v0[3]); v1[0] = silu_f(v1[0]); v1[1] = silu_f(v1[1]); v1[2] = silu_f(v1[2]); v1[3] = silu_f(v1[3]); }
                        else if (mode == 1) { v0 = v0 * QS_NSA; v1 = v1 * QS_NSA; }
                        bf16_t* dst = (mode == 2) ? kvnsa + (size_t)(2 * (pn - 22) + bj) * ((size_t)S * 128) + (size_t)row * 128 + wc * 32 + 8 * fq
                                                  : base + (size_t)row * 2048 + bj * HALF + wc * 32 + 8 * fq;
                        *(GAS u32x4*)dst = pk8(v0, v1); } }
        }
    }
};
struct EpiQup {
    static constexpr bool PERM = true, AFTER_DRAIN = false;
    unsigned char* ws;
    __device__ __forceinline__ void operator()(const f32x4 (&acc)[2][2][4][2], const Unit& u, int wr, int wc, int fr, int fq) const {
        const int pn = u.pn, row0 = u.pm * BM + wr * 64 + fr; bf16_t* qmla = (bf16_t*)(ws + WS_QMLA); const float* rstd_q = (const float*)(ws + WS_RSTD); const float* cosT = (const float*)(ws + WS_ROPE); const float* sinT = cosT + (size_t)S * 32;
#pragma unroll
        for (int ai = 0; ai < 2; ++ai)
#pragma unroll
            for (int m = 0; m < 4; ++m) { const int row = row0 + ai * HALF + m * 16;
#ifdef MLA_FP8
#ifdef MLA_MXL
                const float sc = (QS_MLA * 8.f) * *(const GAS float*)(rstd_q + row);
#else
                const float sc = *(const GAS float*)(rstd_q + row);
#endif
                unsigned char* q8 = (unsigned char*)qmla + (size_t)row * 3072;
#pragma unroll
                for (int bj = 0; bj < 2; ++bj) { const f32x4 v0 = acc[ai][bj][m][0] * sc, v1 = acc[ai][bj][m][1] * sc;
                    if (pn < 8) { *(GAS u32x2*)(q8 + (2 * pn + bj) * 192 + wc * 32 + 8 * fq) = pk8_fp8(v0, v1); }
                    else { const int cp = (pn - 8) * 256 + bj * HALF + wc * 32 + 8 * fq, head = cp >> 6, dl = cp & 63, i0 = dl >> 1;
                        const f32x4 cs = *(const GAS f32x4*)(cosT + (size_t)row * 32 + i0), sn = *(const GAS f32x4*)(sinT + (size_t)row * 32 + i0);
                        *(GAS u32x2*)(q8 + head * 192 + 128 + dl) = pk8_fp8(rope4(v0, cs[0], sn[0], cs[1], sn[1]), rope4(v1, cs[2], sn[2], cs[3], sn[3])); } }
#else
                const float sc = QS_MLA * *(const GAS float*)(rstd_q + row);
#pragma unroll
                for (int bj = 0; bj < 2; ++bj) { const f32x4 v0 = acc[ai][bj][m][0] * sc, v1 = acc[ai][bj][m][1] * sc;
                    if (pn < 8) { *(GAS u32x4*)(qmla + (size_t)row * 3072 + (2 * pn + bj) * 192 + wc * 32 + 8 * fq) = pk8(v0, v1); }
                    else { const int cp = (pn - 8) * 256 + bj * HALF + wc * 32 + 8 * fq, head = cp >> 6, dl = cp & 63, i0 = dl >> 1;
                        const f32x4 cs = *(const GAS f32x4*)(cosT + (size_t)row * 32 + i0), sn = *(const GAS f32x4*)(sinT + (size_t)row * 32 + i0);
                        *(GAS u32x4*)(qmla + (size_t)row * 3072 + head * 192 + 128 + dl) = pk8(rope4(v0, cs[0], sn[0], cs[1], sn[1]), rope4(v1, cs[2], sn[2], cs[3], sn[3])); } }
#endif
                if (m & 1) asm volatile("" ::: "memory"); }
    }
};
struct EpiKvup {
    static constexpr bool PERM = true, AFTER_DRAIN = false;
    unsigned char* ws;
    __device__ __forceinline__ void operator()(const f32x4 (&acc)[2][2][4][2], const Unit& u, int wr, int wc, int fr, int fq) const {
        const int pn = u.pn, row0 = u.pm * BM + wr * 64 + fr;
#pragma unroll
        for (int ai = 0; ai < 2; ++ai)
#pragma unroll
            for (int m = 0; m < 4; ++m) { const int row = row0 + ai * HALF + m * 16;
                const float sc = *(const GAS float*)((const float*)(ws + WS_RSTD) + S + row); bf16_t* kmla = (bf16_t*)(ws + WS_KMLA); bf16_t* vmla = (bf16_t*)(ws + WS_VMLA);
#ifdef MLA_FP8
                *(GAS u32x2*)((unsigned char*)kmla + (size_t)row * 3072 + pn * 192 + wc * 32 + 8 * fq) = pk8_fp8(acc[ai][0][m][0] * sc, acc[ai][0][m][1] * sc);
#else
                *(GAS u32x4*)(kmla + (size_t)row * 3072 + pn * 192 + wc * 32 + 8 * fq) = pk8(acc[ai][0][m][0] * sc, acc[ai][0][m][1] * sc);
#endif
                *(GAS u32x4*)(vmla + (size_t)row * 2048 + pn * 128 + wc * 32 + 8 * fq) = pk8(acc[ai][1][m][0] * sc, acc[ai][1][m][1] * sc);
                if (m & 1) asm volatile("" ::: "memory"); }
    }
};
#ifdef MLA_FP8V
struct EpiKup {
    static constexpr bool PERM = true, AFTER_DRAIN = false;
    unsigned char* ws;
    __device__ __forceinline__ void operator()(const f32x4 (&acc)[2][2][4][2], const Unit& u, int wr, int wc, int fr, int fq) const {
        const int pn = u.pn, row0 = u.pm * BM + wr * 64 + fr;
#pragma unroll
        for (int ai = 0; ai < 2; ++ai)
#pragma unroll
            for (int m = 0; m < 4; ++m) { const int row = row0 + ai * HALF + m * 16;
                const float sc = *(const GAS float*)((const float*)(ws + WS_RSTD) + S + row); unsigned char* k8 = ws + WS_KMLA + (size_t)row * 3072;
#pragma unroll
                for (int bj = 0; bj < 2; ++bj) *(GAS u32x2*)(k8 + (2 * pn + bj) * 192 + wc * 32 + 8 * fq) = pk8_fp8(acc[ai][bj][m][0] * sc, acc[ai][bj][m][1] * sc);
                if (m & 1) asm volatile("" ::: "memory"); }
    }
};
struct EpiVt {
    static constexpr bool PERM = true, AFTER_DRAIN = false;
    unsigned char* ws;
    __device__ __forceinline__ void operator()(const f32x4 (&acc)[2][2][4][2], const Unit& u, int wr, int wc, int fr, int fq) const {
        const int row0 = u.pm * BM + wr * 64 + fr, col0 = u.pn * BM + wc * 32 + 8 * fq;
        const float* rs = (const float*)(ws + WS_RSTD) + S;
        f32x4 sc[2][2];
#pragma unroll
        for (int bj = 0; bj < 2; ++bj) { sc[bj][0] = *(const GAS f32x4*)(rs + col0 + bj * HALF); sc[bj][1] = *(const GAS f32x4*)(rs + col0 + bj * HALF + 4); }
        const int hi8 = (col0 >> 3) & 1; (void)hi8;
#pragma unroll
        for (int ai = 0; ai < 2; ++ai)
#pragma unroll
            for (int m = 0; m < 4; ++m) { unsigned char* vt = ws + WS_VMLA + (size_t)(row0 + ai * HALF + m * 16) * S;
#pragma unroll
                for (int bj = 0; bj < 2; ++bj) { const u32x2 w = pk8_fp8(acc[ai][bj][m][0] * sc[bj][0], acc[ai][bj][m][1] * sc[bj][1]);
#ifdef MLA_MX
                    unsigned char* d64 = vt + ((col0 + bj * HALF) & ~63) + 4 * ((col0 >> 3) & 7);
                    *(GAS unsigned*)(d64) = w.x; *(GAS unsigned*)(d64 + 32) = w.y; } }
#else
                    unsigned char* d16 = vt + ((col0 + bj * HALF) & ~15);
                    *(GAS unsigned*)(d16 + (hi8 ? 4 : 0)) = w.x; *(GAS unsigned*)(d16 + (hi8 ? 12 : 8)) = w.y; } }
#endif
    }
};
#endif
struct EpiOut {
    static constexpr bool PERM = false, AFTER_DRAIN = false;
    const float* x; float* xv; const float* gate;
    __device__ __forceinline__ void operator()(const f32x4 (&acc)[2][2][4][2], const Unit& u, int wr, int wc, int fr, int fq) const {
        const int row0 = u.pm * BM + wr * 64 + fr, col0 = u.pn * BM + wc * 32 + 4 * fq;
        f32x4 gv[2][2];
#pragma unroll
        for (int bj = 0; bj < 2; ++bj)
#pragma unroll
            for (int n = 0; n < 2; ++n) gv[bj][n] = *(const GAS f32x4*)(gate + col0 + bj * HALF + n * 16);
#pragma unroll
        for (int ai = 0; ai < 2; ++ai)
#pragma unroll
            for (int m = 0; m < 4; ++m) { const size_t off = (size_t)(row0 + ai * HALF + m * 16) * D + col0;
#pragma unroll
                for (int bj = 0; bj < 2; ++bj)
#pragma unroll
                    for (int n = 0; n < 2; ++n) { const f32x4 xx = *(const GAS f32x4*)(x + off + bj * HALF + n * 16);
                        #ifdef YSCALE
                        *(GAS f32x4*)(xv + off + bj * HALF + n * 16) = xx * DN_ALPHA + gv[bj][n] * acc[ai][bj][m][n] * YSCALE; }
#else
                        *(GAS f32x4*)(xv + off + bj * HALF + n * 16) = xx * DN_ALPHA + gv[bj][n] * acc[ai][bj][m][n]; }
#endif
                if (m & 1) asm volatile("" ::: "memory"); }
    }
};
template <class Epi, class Sched, bool ALIGN_EPI = false, bool SP2 = false, int SCB = 0, int SCA = 0>
__device__ __forceinline__ void gemm_phase(PG8_LAS unsigned char* lds, const Gemm g, const Sched& S, const Epi& E) {
    int tid_ = threadIdx.x; asm volatile("" : "+v"(tid_));
    const int tid = tid_, wid = __builtin_amdgcn_readfirstlane(tid >> 6), lane = tid & 63, wr = wid >> 2, wc = wid & 3, fr = lane & 15, fq = lane >> 4;
    const int K = g.K, nt = K / BK;
    unsigned voffA[2], voffB[2];
#pragma unroll
    for (int i = 0; i < 2; ++i) { int R, C; stage_rc(tid * 16 + i * 8192, R, C); const int Rb = Epi::PERM ? ((R & ~31) + perm32(R & 31)) : R;
        voffA[i] = (unsigned)(R * K + C) * 2u; voffB[i] = (unsigned)(Rb * K + C) * 2u; }
    const size_t kstep = (size_t)(BK * 2);
    const size_t hstep = (size_t)HALF * K * 2;
    const size_t tstep = 2 * hstep;
    const unsigned ldsw = (unsigned)wid * 1024u;
    const int aoff = lds_byte(wr * 64 + fr, fq * 8), boff = lds_byte(wc * 32 + fr, fq * 8);
#define PG8_SA(b, h) (((b) * 2 + (h)) * HTB)
#define PG8_SB(b, h) ((4 + (b) * 2 + (h)) * HTB)
#define PG8_STAGE(bufoff, gbase, voff) do { _Pragma("unroll") for (int _i = 0; _i < 2; ++_i) \
        __builtin_amdgcn_global_load_lds((const unsigned*)((const char*)(gbase) + (voff)[_i]), (PG8_LAS unsigned*)(lds + (bufoff) + ldsw + _i * 8192), 16, 0, 0); } while (0)
#define PG8_LDA(dst, b, h) do { if constexpr (SCB != 0) { _Pragma("unroll") for (int m = 0; m < 4; ++m) dst##8[m] = ld2x16(lds + PG8_SA(b, h) + aoff + m * 2048); } \
        else { _Pragma("unroll") for (int m = 0; m < 4; ++m) _Pragma("unroll") for (int k = 0; k < 2; ++k) dst[m][k] = *(const PG8_LAS bf16x8*)(lds + PG8_SA(b, h) + aoff + m * 2048 + k * 1024); } } while (0)
#define PG8_LDB(dst, b, h) do { if constexpr (SCB != 0) { _Pragma("unroll") for (int n = 0; n < 2; ++n) dst##8[n] = ld2x16(lds + PG8_SB(b, h) + boff + n * 2048); } \
        else { _Pragma("unroll") for (int n = 0; n < 2; ++n) _Pragma("unroll") for (int k = 0; k < 2; ++k) dst[n][k] = *(const PG8_LAS bf16x8*)(lds + PG8_SB(b, h) + boff + n * 2048 + k * 1024); } } while (0)
#define PG8_MMA(ai, bj, At, Bt) do { __builtin_amdgcn_s_setprio(1); \
        if constexpr (SCB != 0) { _Pragma("unroll") for (int m = 0; m < 4; ++m) _Pragma("unroll") for (int n = 0; n < 2; ++n) \
            asm volatile("v_mfma_scale_f32_16x16x128_f8f6f4 %0, %1, %2, %0, %3, %4 op_sel_hi:[0,0,0]" : "+v"(acc[ai][bj][m][n]) : "v"(Bt##8[n]), "v"(At##8[m]), "v"(scb_), "v"(sca_)); } \
        else { _Pragma("unroll") for (int m = 0; m < 4; ++m) _Pragma("unroll") for (int n = 0; n < 2; ++n) _Pragma("unroll") for (int k = 0; k < 2; ++k) \
            acc[ai][bj][m][n] = __builtin_amdgcn_mfma_f32_16x16x32_bf16(Bt[n][k], At[m][k], acc[ai][bj][m][n], 0, 0, 0); } \
        __builtin_amdgcn_s_setprio(0); } while (0)
#define PG8_WAIT_V(n) asm volatile("s_waitcnt vmcnt(" #n ")" ::: "memory")
#define PG8_WAIT_L(n) asm volatile("s_waitcnt lgkmcnt(" #n ")" ::: "memory")
#define PG8_BAR __builtin_amdgcn_s_barrier()
#define PG8_SCHED __builtin_amdgcn_sched_barrier(0)
    Unit cur, nxt; int ui = 0;
    if (!S.next(0, cur)) return;
    f32x4 acc[2][2][4][2];
#pragma unroll
    for (int a = 0; a < 2; ++a)
#pragma unroll
        for (int b = 0; b < 2; ++b)
#pragma unroll
            for (int m = 0; m < 4; ++m)
#pragma unroll
                for (int n = 0; n < 2; ++n) acc[a][b][m][n] = (f32x4){0.f, 0.f, 0.f, 0.f};
    int scb_ = SCB, sca_ = SCA; asm volatile("" : "+v"(scb_), "+v"(sca_));
    bf16x8 At[4][2], B0[2][2], B1[2][2]; i32x8 At8[4], B08[2], B18[2];
    const char* cA = (const char*)g.A + (size_t)cur.pm * tstep; const char* cB = (const char*)g.Bt + (size_t)cur.pn * tstep;
    S.a_ready(cur);
    if constexpr (SP2) {
        PG8_STAGE(PG8_SB(0, 0), cB, voffB); PG8_STAGE(PG8_SB(0, 1), cB + hstep, voffB); PG8_STAGE(PG8_SA(0, 0), cA, voffA); PG8_STAGE(PG8_SA(0, 1), cA + hstep, voffA);
        if (wr == 1) PG8_BAR;
        PG8_WAIT_V(2); PG8_BAR;
        PG8_STAGE(PG8_SB(1, 0), cB + kstep, voffB); PG8_STAGE(PG8_SA(1, 0), cA + kstep, voffA); PG8_STAGE(PG8_SB(1, 1), cB + hstep + kstep, voffB);
        PG8_WAIT_V(6); PG8_BAR;
    } else {
        PG8_STAGE(PG8_SB(0, 0), cB, voffB); PG8_STAGE(PG8_SA(0, 0), cA, voffA); PG8_STAGE(PG8_SB(0, 1), cB + hstep, voffB); PG8_STAGE(PG8_SA(0, 1), cA + hstep, voffA);
        if (wr == 1) PG8_BAR;
        PG8_WAIT_V(4); PG8_BAR;
        PG8_STAGE(PG8_SB(1, 0), cB + kstep, voffB); PG8_STAGE(PG8_SA(1, 0), cA + kstep, voffA); PG8_STAGE(PG8_SB(1, 1), cB + hstep + kstep, voffB);
        PG8_WAIT_V(6); PG8_BAR;
    }
    for (;;) {
        const bool has_next = S.next(ui + 1, nxt);
        const char* nA = has_next ? (const char*)g.A + (size_t)nxt.pm * tstep : cA; const char* nB = has_next ? (const char*)g.Bt + (size_t)nxt.pn * tstep : cB;
#pragma unroll 1
        for (int t = 0; t < nt; t += 2) {
            const bool last = (t == nt - 2);
            const char* a1 = cA + (size_t)(t + 1) * kstep;
            const char* a2 = last ? nA : cA + (size_t)(t + 2) * kstep; const char* b2 = last ? nB : cB + (size_t)(t + 2) * kstep;
            const char* a3 = a2 + kstep; const char* b3 = b2 + kstep;
            if (last && has_next) S.a_ready(nxt);
            if constexpr (SP2) {
            PG8_LDB(B0, 0, 0); PG8_LDB(B1, 0, 1); PG8_SCHED; PG8_LDA(At, 0, 0); PG8_STAGE(PG8_SA(1, 1), a1 + hstep, voffA);
            PG8_WAIT_V(8); PG8_WAIT_L(0); PG8_BAR; PG8_MMA(0, 0, At, B0); PG8_MMA(0, 1, At, B1); PG8_BAR; PG8_SCHED;
            PG8_LDA(At, 0, 1); PG8_STAGE(PG8_SB(0, 0), b2, voffB); PG8_STAGE(PG8_SB(0, 1), b2 + hstep, voffB); PG8_STAGE(PG8_SA(0, 0), a2, voffA);
            PG8_WAIT_V(8); PG8_WAIT_L(0); PG8_BAR; PG8_MMA(1, 0, At, B0); PG8_MMA(1, 1, At, B1); PG8_BAR; PG8_SCHED;
            PG8_LDB(B0, 1, 0); PG8_LDB(B1, 1, 1); PG8_SCHED; PG8_LDA(At, 1, 0); PG8_STAGE(PG8_SA(0, 1), a2 + hstep, voffA);
            PG8_WAIT_V(8); PG8_WAIT_L(0); PG8_BAR; PG8_MMA(0, 0, At, B0); PG8_MMA(0, 1, At, B1); PG8_BAR; PG8_SCHED;
            PG8_LDA(At, 1, 1); PG8_STAGE(PG8_SB(1, 0), b3, voffB); PG8_STAGE(PG8_SB(1, 1), b3 + hstep, voffB); PG8_STAGE(PG8_SA(1, 0), a3, voffA);
            PG8_WAIT_V(8); PG8_WAIT_L(0); PG8_BAR; PG8_MMA(1, 0, At, B0); PG8_MMA(1, 1, At, B1); PG8_BAR; PG8_SCHED;
            } else {
            PG8_LDB(B0, 0, 0); PG8_SCHED; PG8_LDA(At, 0, 0); PG8_STAGE(PG8_SA(1, 1), a1 + hstep, voffA);
            PG8_WAIT_L(8); PG8_BAR; PG8_WAIT_L(0); PG8_MMA(0, 0, At, B0); PG8_BAR; PG8_SCHED;
            PG8_LDB(B1, 0, 1); PG8_STAGE(PG8_SB(0, 0), b2, voffB);
            PG8_BAR; PG8_WAIT_L(0); PG8_MMA(0, 1, At, B1); PG8_BAR;
            PG8_LDA(At, 0, 1); PG8_STAGE(PG8_SA(0, 0), a2, voffA);
            PG8_BAR; PG8_WAIT_L(0); PG8_MMA(1, 0, At, B0); PG8_BAR; PG8_SCHED;
            PG8_STAGE(PG8_SB(0, 1), b2 + hstep, voffB);
            PG8_WAIT_V(6); PG8_BAR; PG8_MMA(1, 1, At, B1); PG8_BAR;
            PG8_LDB(B0, 1, 0); PG8_SCHED; PG8_LDA(At, 1, 0); PG8_STAGE(PG8_SA(0, 1), a2 + hstep, voffA);
            PG8_WAIT_L(8); PG8_BAR; PG8_WAIT_L(0); PG8_MMA(0, 0, At, B0); PG8_BAR; PG8_SCHED;
            PG8_LDB(B1, 1, 1); PG8_STAGE(PG8_SB(1, 0), b3, voffB);
            PG8_BAR; PG8_WAIT_L(0); PG8_MMA(0, 1, At, B1); PG8_BAR;
            PG8_LDA(At, 1, 1); PG8_STAGE(PG8_SA(1, 0), a3, voffA);
            PG8_BAR; PG8_WAIT_L(0); PG8_MMA(1, 0, At, B0); PG8_BAR; PG8_SCHED;
            PG8_STAGE(PG8_SB(1, 1), b3 + hstep, voffB);
            PG8_WAIT_V(6); PG8_BAR; PG8_MMA(1, 1, At, B1); PG8_BAR;
            }
        }
        if constexpr (SCB != 0) asm volatile("s_nop 15\n\ts_nop 15" ::: "memory");
        if constexpr (ALIGN_EPI) { if (wr == 0) PG8_BAR; }
        if constexpr (!Epi::AFTER_DRAIN) { int fr_ = fr, fq_ = fq; asm volatile("" : "+v"(fr_), "+v"(fq_));
            E(acc, cur, wr, wc, fr_, fq_); S.done(cur); }
        if (!has_next) break;
#pragma unroll
        for (int a = 0; a < 2; ++a)
#pragma unroll
            for (int b = 0; b < 2; ++b)
#pragma unroll
                for (int m = 0; m < 4; ++m)
#pragma unroll
                    for (int n = 0; n < 2; ++n) acc[a][b][m][n] = (f32x4){0.f, 0.f, 0.f, 0.f};
        cur = nxt; cA = nA; cB = nB; ++ui;
        if constexpr (ALIGN_EPI) { if (wr == 1) PG8_BAR; }
    }
    PG8_WAIT_V(0);
    if constexpr (!ALIGN_EPI) { if (wr == 0) PG8_BAR; }
    PG8_BAR;
    if constexpr (Epi::AFTER_DRAIN) { E.fused(acc, cur, wr, wc, fr, fq, lds, wid, lane); S.done(cur); }
#undef PG8_SA
#undef PG8_SB
#undef PG8_STAGE
#undef PG8_LDA
#undef PG8_LDB
#undef PG8_MMA
#undef PG8_WAIT_V
#undef PG8_WAIT_L
#undef PG8_BAR
#undef PG8_SCHED
}
}
namespace att {
constexpr int KS_M = 400, KS_N = 272, VS = 320;
constexpr int MLA_KB = 64 * KS_M, NSA_KB = 64 * KS_N, VB = 64 * VS;
constexpr int N_IMP = 2 * NSA_KB + 2 * VB;
constexpr int N_PART = N_IMP + 32768;
constexpr int N_PARTB = 8 * 32 * 17 * 4;
constexpr int N_SELM = N_PART + 2 * N_PARTB;
constexpr int N_ULIST = N_SELM + 1024;
constexpr int N_CARRY = N_ULIST + 1024;
constexpr int N_NTS = N_CARRY + 256;
static_assert(N_NTS + 16 <= MISC_OFF, "NSA LDS map");
static_assert(2 * MLA_KB + 3 * VB <= 131072, "MLA LDS map");
constexpr int MLA_QL = 2 * MLA_KB + 2 * VB;
static_assert(MLA_QL + 8 * 4096 <= 131072, "MLA LDS map (pipelined)");

#ifndef QK_PF
#define QK_PF 4
#endif
#define MFMA32(a, b, c) __builtin_amdgcn_mfma_f32_32x32x16_bf16((a), (b), (c), 0, 0, 0)
__device__ __forceinline__ float swapmax(float v) { auto rr = __builtin_amdgcn_permlane32_swap(__float_as_uint(v), __float_as_uint(v), false, false); return fmaxf(__uint_as_float(rr[0]), __uint_as_float(rr[1])); }
__device__ __forceinline__ float swapsum(float v) { auto rr = __builtin_amdgcn_permlane32_swap(__float_as_uint(v), __float_as_uint(v), false, false); return __uint_as_float(rr[0]) + __uint_as_float(rr[1]); }
template <int SIDX> __device__ __forceinline__ bf16x8 packp(const f32x16& p) {
    f32x8 t = {p[8 * SIDX + 0], p[8 * SIDX + 1], p[8 * SIDX + 2], p[8 * SIDX + 3], p[8 * SIDX + 4], p[8 * SIDX + 5], p[8 * SIDX + 6], p[8 * SIDX + 7]};
    return __builtin_bit_cast(bf16x8, __builtin_convertvector(t, bf16x8v));
}
template <int NDC, int KS, bool ZERO = true> __device__ __forceinline__ void qk_tile(f32x16& p0, f32x16& p1, const LAS unsigned char* kl, const bf16x8 (&q)[NDC]) {
    if (ZERO) {
#pragma unroll
        for (int i = 0; i < 16; ++i) { p0[i] = 0.f; p1[i] = 0.f; }
    }
    constexpr int PF = QK_PF;
    bf16x8 a[PF + 1][2];
#pragma unroll
    for (int i = 0; i < PF; ++i) { a[i][0] = *(const LAS bf16x8*)(kl + i * 32); a[i][1] = *(const LAS bf16x8*)(kl + 32 * KS + i * 32); }
#pragma unroll
    for (int d0 = 0; d0 < NDC; ++d0) {
        if (d0 + PF < NDC) { a[(d0 + PF) % (PF + 1)][0] = *(const LAS bf16x8*)(kl + (d0 + PF) * 32); a[(d0 + PF) % (PF + 1)][1] = *(const LAS bf16x8*)(kl + 32 * KS + (d0 + PF) * 32); }
        __builtin_amdgcn_sched_barrier(0);
        p0 = MFMA32(a[d0 % (PF + 1)][0], q[d0], p0); p1 = MFMA32(a[d0 % (PF + 1)][1], q[d0], p1);
        __builtin_amdgcn_sched_barrier(0);
    }
}
#ifdef PROBE_QKM2
template <int NDC, int KS> __device__ __forceinline__ void qk_tile_m2(f32x16& p0, f32x16& p1, f32x16& r0, f32x16& r1, const LAS unsigned char* kl, const bf16x8 (&q)[NDC]) {
#pragma unroll
    for (int i = 0; i < 16; ++i) { p0[i] = 0.f; p1[i] = 0.f; r0[i] = 0.f; r1[i] = 0.f; }
    constexpr int PF = QK_PF;
    bf16x8 a[PF + 1][2];
#pragma unroll
    for (int i = 0; i < PF; ++i) { a[i][0] = *(const LAS bf16x8*)(kl + i * 32); a[i][1] = *(const LAS bf16x8*)(kl + 32 * KS + i * 32); }
#pragma unroll
    for (int d0 = 0; d0 < NDC; ++d0) {
        if (d0 + PF < NDC) { a[(d0 + PF) % (PF + 1)][0] = *(const LAS bf16x8*)(kl + (d0 + PF) * 32); a[(d0 + PF) % (PF + 1)][1] = *(const LAS bf16x8*)(kl + 32 * KS + (d0 + PF) * 32); }
        __builtin_amdgcn_sched_barrier(0);
        p0 = MFMA32(a[d0 % (PF + 1)][0], q[d0], p0); p1 = MFMA32(a[d0 % (PF + 1)][1], q[d0], p1);
        r0 = MFMA32(a[d0 % (PF + 1)][0], q[d0], r0); r1 = MFMA32(a[d0 % (PF + 1)][1], q[d0], r1);
        __builtin_amdgcn_sched_barrier(0);
    }
}
#endif
__device__ __forceinline__ void pv_tile(f32x16 (&o)[4], const bf16x8 (&pb)[4], const LAS unsigned char* vl) {
    s16x4 f[5][2];
#define PV_LD(idx) do { constexpr int d_ = (idx) >> 2, s_ = (idx) & 3; \
        f[(idx) % 5][0] = __builtin_amdgcn_ds_read_tr16_b64_v4i16((LAS s16x4*)(vl + s_ * 16 * VS + d_ * 64)); \
        f[(idx) % 5][1] = __builtin_amdgcn_ds_read_tr16_b64_v4i16((LAS s16x4*)(vl + s_ * 16 * VS + 8 * VS + d_ * 64)); } while (0)
    PV_LD(0); PV_LD(1); PV_LD(2); PV_LD(3);
#define PV_STEP(idx) do { if ((idx) + 4 < 16) PV_LD((idx) + 4); __builtin_amdgcn_sched_barrier(0); \
        { const s16x4 t0_ = f[(idx) % 5][0], t1_ = f[(idx) % 5][1]; const bf16x8 vf_ = {t0_[0], t0_[1], t0_[2], t0_[3], t1_[0], t1_[1], t1_[2], t1_[3]}; \
          o[(idx) >> 2] = MFMA32(vf_, pb[(idx) & 3], o[(idx) >> 2]); } __builtin_amdgcn_sched_barrier(0); } while (0)
    PV_STEP(0); PV_STEP(1); PV_STEP(2); PV_STEP(3); PV_STEP(4); PV_STEP(5); PV_STEP(6); PV_STEP(7);
    PV_STEP(8); PV_STEP(9); PV_STEP(10); PV_STEP(11); PV_STEP(12); PV_STEP(13); PV_STEP(14); PV_STEP(15);
#undef PV_STEP
#undef PV_LD
}
template <int NDC, int NQR, int KS> __device__ __forceinline__ void qk_tile_free(f32x16& p0, f32x16& p1, const LAS unsigned char* kl, const bf16x8 (&q)[NQR], const LAS unsigned char* ql) {
#pragma unroll
    for (int i = 0; i < 16; ++i) { p0[i] = 0.f; p1[i] = 0.f; }
#pragma unroll
    for (int d0 = 0; d0 < NDC; ++d0) {
        const bf16x8 a0 = *(const LAS bf16x8*)(kl + d0 * 32);
        const bf16x8 a1 = *(const LAS bf16x8*)(kl + 32 * KS + d0 * 32);
        bf16x8 qq; if (d0 < NQR) qq = q[d0 < NQR ? d0 : 0]; else qq = *(const LAS bf16x8*)(ql + (d0 - NQR) * 1024);
        p0 = MFMA32(a0, qq, p0); p1 = MFMA32(a1, qq, p1);
    }
}
__device__ __forceinline__ float sm_core(f32x16& p0, f32x16& p1, float& m, float& l) {
    float tm = p0[0];
#pragma unroll
    for (int r = 1; r < 16; ++r) tm = fmaxf(tm, p0[r]);
#pragma unroll
    for (int r = 0; r < 16; ++r) tm = fmaxf(tm, p1[r]);
    tm = swapmax(tm);
    const float mn = fmaxf(m, tm);
    const float alpha = __builtin_amdgcn_exp2f(m - mn);
    m = mn;
    float ps = 0.f;
#pragma unroll
    for (int r = 0; r < 16; ++r) { p0[r] = __builtin_amdgcn_exp2f(p0[r] - mn); ps += p0[r]; }
#pragma unroll
    for (int r = 0; r < 16; ++r) { p1[r] = __builtin_amdgcn_exp2f(p1[r] - mn); ps += p1[r]; }
    ps = swapsum(ps);
    l = l * alpha + ps;
    return alpha;
}
__device__ __forceinline__ void online_sm(f32x16& p0, f32x16& p1, float& m, float& l, f32x16 (&o)[4]) {
    float tm = p0[0];
#pragma unroll
    for (int r = 1; r < 16; ++r) tm = fmaxf(tm, p0[r]);
#pragma unroll
    for (int r = 0; r < 16; ++r) tm = fmaxf(tm, p1[r]);
    tm = swapmax(tm);
    const float mn = fmaxf(m, tm);
    const float alpha = __builtin_amdgcn_exp2f(m - mn);
    m = mn;
    float ps = 0.f;
#pragma unroll
    for (int r = 0; r < 16; ++r) { p0[r] = __builtin_amdgcn_exp2f(p0[r] - mn); ps += p0[r]; }
#pragma unroll
    for (int r = 0; r < 16; ++r) { p1[r] = __builtin_amdgcn_exp2f(p1[r] - mn); ps += p1[r]; }
    ps = swapsum(ps);
    l = l * alpha + ps;
    if (!__all(alpha == 1.f)) {
#pragma unroll
        for (int d = 0; d < 4; ++d)
#pragma unroll
            for (int r = 0; r < 16; ++r) o[d][r] *= alpha;
    }
}

#ifdef MLA_FP8
typedef long i64;
constexpr int KS8 = 200, MLA_KB8 = 64 * KS8;
static_assert(2 * MLA_KB8 + 3 * VB <= 131072, "MLA fp8 LDS map");
#define MFMA32F8(a, b, c) __builtin_amdgcn_mfma_f32_32x32x16_fp8_fp8((a), (b), (c), 0, 0, 0)
template <int NDC> __device__ __forceinline__ void qk_tile8(f32x16& p0, f32x16& p1, const LAS unsigned char* kl, const i64 (&q)[NDC]) {
#pragma unroll
    for (int i = 0; i < 16; ++i) { p0[i] = 0.f; p1[i] = 0.f; }
    constexpr int PF = 4;
    i64 a[PF + 1][2];
#pragma unroll
    for (int i = 0; i < PF; ++i) { a[i][0] = *(const LAS i64*)(kl + i * 16); a[i][1] = *(const LAS i64*)(kl + 32 * KS8 + i * 16); }
#pragma unroll
    for (int d0 = 0; d0 < NDC; ++d0) {
        if (d0 + PF < NDC) { a[(d0 + PF) % (PF + 1)][0] = *(const LAS i64*)(kl + (d0 + PF) * 16); a[(d0 + PF) % (PF + 1)][1] = *(const LAS i64*)(kl + 32 * KS8 + (d0 + PF) * 16); }
        __builtin_amdgcn_sched_barrier(0);
        __builtin_amdgcn_s_setprio(1);
        p0 = MFMA32F8(a[d0 % (PF + 1)][0], q[d0], p0); p1 = MFMA32F8(a[d0 % (PF + 1)][1], q[d0], p1);
        __builtin_amdgcn_s_setprio(0);
        __builtin_amdgcn_sched_barrier(0);
    }
}
__device__ __forceinline__ void online_sm_scaled(f32x16& p0, f32x16& p1, float& m, float& l, f32x16 (&o)[4], const float C2) {
    float tm = p0[0];
#pragma unroll
    for (int r = 1; r < 16; ++r) tm = fmaxf(tm, p0[r]);
#pragma unroll
    for (int r = 0; r < 16; ++r) tm = fmaxf(tm, p1[r]);
    tm = swapmax(tm);
    const float mn = fmaxf(m, tm);
    const float alpha = __builtin_amdgcn_exp2f((m - mn) * C2);
    m = mn;
    const float mc = -mn * C2;
    float ps = 0.f;
#pragma unroll
    for (int r = 0; r < 16; ++r) { p0[r] = __builtin_amdgcn_exp2f(__builtin_fmaf(p0[r], C2, mc)); ps += p0[r]; }
#pragma unroll
    for (int r = 0; r < 16; ++r) { p1[r] = __builtin_amdgcn_exp2f(__builtin_fmaf(p1[r], C2, mc)); ps += p1[r]; }
    ps = swapsum(ps);
    l = l * alpha + ps;
    if (!__all(alpha == 1.f)) {
#pragma unroll
        for (int d = 0; d < 4; ++d)
#pragma unroll
            for (int r = 0; r < 16; ++r) o[d][r] *= alpha;
    }
}
#endif
#ifdef MLA_FP8V
constexpr int VS8 = 72, VB8 = 128 * VS8;
constexpr int VS8B = 136, VB8B = 128 * VS8B, MLA_KB8B = 128 * KS8;
static_assert(2 * MLA_KB8B + 3 * VB8B <= 131072, "MLA big-tile LDS map");
#ifdef MLA_BIG
#define PV8_RS VS8B
#else
#define PV8_RS VS8
#endif
static_assert(2 * MLA_KB8 + 3 * VB8 <= 131072, "MLA fp8 LDS map");
template <int SIDX> __device__ __forceinline__ i64 packp8(const f32x16& p) {
    int w0 = __builtin_amdgcn_cvt_pk_fp8_f32(p[8 * SIDX + 0] * 256.f, p[8 * SIDX + 1] * 256.f, 0, false); w0 = __builtin_amdgcn_cvt_pk_fp8_f32(p[8 * SIDX + 2] * 256.f, p[8 * SIDX + 3] * 256.f, w0, true);
    int w1 = __builtin_amdgcn_cvt_pk_fp8_f32(p[8 * SIDX + 4] * 256.f, p[8 * SIDX + 5] * 256.f, 0, false); w1 = __builtin_amdgcn_cvt_pk_fp8_f32(p[8 * SIDX + 6] * 256.f, p[8 * SIDX + 7] * 256.f, w1, true);
    return (i64)(((unsigned long long)(unsigned)w1 << 32) | (unsigned)w0);
}
__device__ __forceinline__ void pv_tile8(f32x16 (&o)[4], const i64 (&pb)[4], const LAS unsigned char* vl) {
    i64 f[5];
#define PV8_LD(idx) f[(idx) % 5] = *(const LAS i64*)(vl + ((idx) >> 2) * 32 * PV8_RS + ((idx) & 3) * 16)
    PV8_LD(0); PV8_LD(1); PV8_LD(2); PV8_LD(3);
#define PV8_STEP(idx) do { if ((idx) + 4 < 16) PV8_LD((idx) + 4); __builtin_amdgcn_sched_barrier(0); \
        o[(idx) >> 2] = MFMA32F8(f[(idx) % 5], pb[(idx) & 3], o[(idx) >> 2]); __builtin_amdgcn_sched_barrier(0); } while (0)
    PV8_STEP(0); PV8_STEP(1); PV8_STEP(2); PV8_STEP(3); PV8_STEP(4); PV8_STEP(5); PV8_STEP(6); PV8_STEP(7);
    PV8_STEP(8); PV8_STEP(9); PV8_STEP(10); PV8_STEP(11); PV8_STEP(12); PV8_STEP(13); PV8_STEP(14); PV8_STEP(15);
#undef PV8_STEP
#undef PV8_LD
}
#endif
#ifdef MLA_MX
typedef int i32x8 __attribute__((ext_vector_type(8)));
constexpr int KSX = 208, MLA_KBX = 64 * KSX;
constexpr int VSX = 80, VBX = 128 * VSX;
static_assert(2 * MLA_KBX + 3 * VBX <= 131072, "MLA mx LDS map");
#define MFMAX(a, b, c) __builtin_amdgcn_mfma_scale_f32_32x32x64_f8f6f4((a), (b), (c), 0, 0, 0, 0x7f7f7f7f, 0, 0x7f7f7f7f)
__device__ __forceinline__ i32x8 ldsx(const LAS unsigned char* p) {
    const u32x4 a = *(const LAS u32x4*)p, b = *(const LAS u32x4*)(p + 16);
    return (i32x8){(int)a.x, (int)a.y, (int)a.z, (int)a.w, (int)b.x, (int)b.y, (int)b.z, (int)b.w};
}
__device__ __forceinline__ void qk_tilex(f32x16& p0, f32x16& p1, const LAS unsigned char* kl, const i32x8 (&q)[3]) {
#pragma unroll
    for (int i = 0; i < 16; ++i) { p0[i] = 0.f; p1[i] = 0.f; }
    i32x8 a0 = ldsx(kl), a1 = ldsx(kl + 32 * KSX), a2 = ldsx(kl + 64), a3 = ldsx(kl + 32 * KSX + 64);
    __builtin_amdgcn_sched_barrier(0);
    __builtin_amdgcn_s_setprio(1);
    p0 = MFMAX(a0, q[0], p0); p1 = MFMAX(a1, q[0], p1);
    __builtin_amdgcn_s_setprio(0);
    __builtin_amdgcn_sched_barrier(0);
    a0 = ldsx(kl + 128); a1 = ldsx(kl + 32 * KSX + 128);
    __builtin_amdgcn_sched_barrier(0);
    __builtin_amdgcn_s_setprio(1);
    p0 = MFMAX(a2, q[1], p0); p1 = MFMAX(a3, q[1], p1);
    __builtin_amdgcn_sched_barrier(0);
    p0 = MFMAX(a0, q[2], p0); p1 = MFMAX(a1, q[2], p1);
    __builtin_amdgcn_s_setprio(0);
    __builtin_amdgcn_sched_barrier(0);
}
__device__ __forceinline__ void pv_tilex(f32x16 (&o)[4], const i32x8& pb, const LAS unsigned char* vl) {
    i32x8 f0 = ldsx(vl), f1 = ldsx(vl + 32 * VSX);
    __builtin_amdgcn_sched_barrier(0);
    o[0] = MFMAX(f0, pb, o[0]);
    __builtin_amdgcn_sched_barrier(0);
    f0 = ldsx(vl + 64 * VSX);
    __builtin_amdgcn_sched_barrier(0);
    o[1] = MFMAX(f1, pb, o[1]);
    __builtin_amdgcn_sched_barrier(0);
    f1 = ldsx(vl + 96 * VSX);
    __builtin_amdgcn_sched_barrier(0);
    o[2] = MFMAX(f0, pb, o[2]);
    __builtin_amdgcn_sched_barrier(0);
    o[3] = MFMAX(f1, pb, o[3]);
    __builtin_amdgcn_sched_barrier(0);
}
__device__ __forceinline__ i32x8 packpx(const f32x16& p0, const f32x16& p1) {
    i32x8 w;
#pragma unroll
    for (int g = 0; g < 4; ++g) {
        int a = __builtin_amdgcn_cvt_pk_fp8_f32(p0[4 * g + 0], p0[4 * g + 1], 0, false); a = __builtin_amdgcn_cvt_pk_fp8_f32(p0[4 * g + 2], p0[4 * g + 3], a, true); w[g] = a;
        int b = __builtin_amdgcn_cvt_pk_fp8_f32(p1[4 * g + 0], p1[4 * g + 1], 0, false); b = __builtin_amdgcn_cvt_pk_fp8_f32(p1[4 * g + 2], p1[4 * g + 3], b, true); w[4 + g] = b;
    }
    return w;
}
__device__ __forceinline__ void online_sm_x(f32x16& p0, f32x16& p1, float& m, float& l, f32x16 (&o)[4], const float C2) {
    float tm = p0[0];
#pragma unroll
    for (int r = 1; r < 16; ++r) tm = fmaxf(tm, p0[r]);
#pragma unroll
    for (int r = 0; r < 16; ++r) tm = fmaxf(tm, p1[r]);
    tm = swapmax(tm);
    const float mn = fmaxf(m, tm);
    const float alpha = __builtin_amdgcn_exp2f((m - mn) * C2);
    m = mn;
    const float mc = 8.f - mn * C2;
    float ps = 0.f;
#pragma unroll
    for (int r = 0; r < 16; ++r) { p0[r] = __builtin_amdgcn_exp2f(__builtin_fmaf(p0[r], C2, mc)); ps += p0[r]; }
#pragma unroll
    for (int r = 0; r < 16; ++r) { p1[r] = __builtin_amdgcn_exp2f(__builtin_fmaf(p1[r], C2, mc)); ps += p1[r]; }
    ps = swapsum(ps);
    l = l * alpha + ps;
    if (!__all(alpha == 1.f)) {
#pragma unroll
        for (int d = 0; d < 4; ++d)
#pragma unroll
            for (int r = 0; r < 16; ++r) o[d][r] *= alpha;
    }
}
#endif
#ifdef MLA_MXL
#define MXL_T 7.0f
#define MFMAXQ(a, b, c) __builtin_amdgcn_mfma_scale_f32_32x32x64_f8f6f4((a), (b), (c), 0, 0, 0, 0x7f7f7f7f, 0, 0x7c7c7c7c)
__device__ __forceinline__ void qk_tilexl(f32x16& p0, f32x16& p1, const f32x16& mref, const LAS unsigned char* kl, const i32x8 (&q)[3]) {
    i32x8 a0 = ldsx(kl), a1 = ldsx(kl + 32 * KSX), a2 = ldsx(kl + 64), a3 = ldsx(kl + 32 * KSX + 64);
    __builtin_amdgcn_sched_barrier(0);
    __builtin_amdgcn_s_setprio(1);
    p0 = MFMAXQ(a0, q[0], mref); p1 = MFMAXQ(a1, q[0], mref);
    __builtin_amdgcn_s_setprio(0);
    __builtin_amdgcn_sched_barrier(0);
    a0 = ldsx(kl + 128); a1 = ldsx(kl + 32 * KSX + 128);
    __builtin_amdgcn_sched_barrier(0);
    __builtin_amdgcn_s_setprio(1);
    p0 = MFMAXQ(a2, q[1], p0); p1 = MFMAXQ(a3, q[1], p1);
    __builtin_amdgcn_sched_barrier(0);
    p0 = MFMAXQ(a0, q[2], p0); p1 = MFMAXQ(a1, q[2], p1);
    __builtin_amdgcn_s_setprio(0);
    __builtin_amdgcn_sched_barrier(0);
}
__device__ __forceinline__ void pv_tilexl(f32x16 (&o)[5], const i32x8& pb, const i32x8& ones, const LAS unsigned char* vl) {
    i32x8 f0 = ldsx(vl), f1 = ldsx(vl + 32 * VSX);
    __builtin_amdgcn_sched_barrier(0);
    o[4] = MFMAX(ones, pb, o[4]);
    __builtin_amdgcn_sched_barrier(0);
    o[0] = MFMAX(f0, pb, o[0]);
    __builtin_amdgcn_sched_barrier(0);
    f0 = ldsx(vl + 64 * VSX);
    __builtin_amdgcn_sched_barrier(0);
    o[1] = MFMAX(f1, pb, o[1]);
    __builtin_amdgcn_sched_barrier(0);
    f1 = ldsx(vl + 96 * VSX);
    __builtin_amdgcn_sched_barrier(0);
    o[2] = MFMAX(f0, pb, o[2]);
    __builtin_amdgcn_sched_barrier(0);
    o[3] = MFMAX(f1, pb, o[3]);
    __builtin_amdgcn_sched_barrier(0);
}
__device__ __forceinline__ i32x8 exp_packx(const f32x16& p0, const f32x16& p1, int any) {
    i32x8 w;
#pragma unroll
    for (int g = 0; g < 4; ++g) {
        int a = __builtin_amdgcn_cvt_pk_fp8_f32(__builtin_amdgcn_exp2f(p0[4 * g + 0]), __builtin_amdgcn_exp2f(p0[4 * g + 1]), any, false);
        a = __builtin_amdgcn_cvt_pk_fp8_f32(__builtin_amdgcn_exp2f(p0[4 * g + 2]), __builtin_amdgcn_exp2f(p0[4 * g + 3]), a, true); w[g] = a;
        int b = __builtin_amdgcn_cvt_pk_fp8_f32(__builtin_amdgcn_exp2f(p1[4 * g + 0]), __builtin_amdgcn_exp2f(p1[4 * g + 1]), any, false);
        b = __builtin_amdgcn_cvt_pk_fp8_f32(__builtin_amdgcn_exp2f(p1[4 * g + 2]), __builtin_amdgcn_exp2f(p1[4 * g + 3]), b, true); w[4 + g] = b;
    }
    return w;
}
#endif
#ifdef MLA_PIPE8
template <int NDC> __device__ __forceinline__ void qk_tile8_free(f32x16& p0, f32x16& p1, const LAS unsigned char* kl, const i64 (&q)[NDC]) {
#pragma unroll
    for (int i = 0; i < 16; ++i) { p0[i] = 0.f; p1[i] = 0.f; }
#pragma unroll
    for (int d0 = 0; d0 < NDC; ++d0) {
        const i64 a0 = *(const LAS i64*)(kl + d0 * 16), a1 = *(const LAS i64*)(kl + 32 * KS8 + d0 * 16);
        p0 = MFMA32F8(a0, q[d0], p0); p1 = MFMA32F8(a1, q[d0], p1);
    }
}
__device__ __forceinline__ float sm_core_scaled(f32x16& p0, f32x16& p1, float& m, float& l, const float C2) {
    float tm = p0[0];
#pragma unroll
    for (int r = 1; r < 16; ++r) tm = fmaxf(tm, p0[r]);
#pragma unroll
    for (int r = 0; r < 16; ++r) tm = fmaxf(tm, p1[r]);
    tm = swapmax(tm);
    const float mn = fmaxf(m, tm);
    const float alpha = __builtin_amdgcn_exp2f((m - mn) * C2);
    m = mn;
    const float mc = -mn * C2;
    float ps = 0.f;
#pragma unroll
    for (int r = 0; r < 16; ++r) { p0[r] = __builtin_amdgcn_exp2f(__builtin_fmaf(p0[r], C2, mc)); ps += p0[r]; }
#pragma unroll
    for (int r = 0; r < 16; ++r) { p1[r] = __builtin_amdgcn_exp2f(__builtin_fmaf(p1[r], C2, mc)); ps += p1[r]; }
    ps = swapsum(ps);
    l = l * alpha + ps;
    return alpha;
}
#endif
#ifdef MLA_PIPE8
struct MlaPtrs { const bf16* Q; const bf16* K; const bf16* V; const bf16* Z; bf16* O; };
__device__ __forceinline__ void mla_mask(f32x16& p0, f32x16& p1, int dq) {
#pragma unroll
    for (int r = 0; r < 16; ++r) { const int c = (r & 3) + 8 * (r >> 2);
        if (c > dq) p0[r] = -__builtin_inff();
        if (c + 32 > dq) p1[r] = -__builtin_inff(); }
}
__device__ __forceinline__ void mla_unit(LAS unsigned char* lds, const MlaPtrs& P, int head, int qb, int tid_in, int wave, int lane_in) {
    int tid = tid_in; asm volatile("" : "+v"(tid)); const int lane = tid & 63; (void)lane_in;
    const int r32 = lane & 31, hi = lane >> 5;
    const int q0 = qb * 256, qw = q0 + wave * 32, tq = qw + r32;
    i64 q[12];
    { const unsigned char* qp = (const unsigned char*)P.Q + (size_t)tq * 3072 + head * 192 + hi * 8;
#pragma unroll
      for (int d0 = 0; d0 < 12; ++d0) q[d0] = *(const GAS i64*)(qp + d0 * 16); }
    const int NT = 4 * (qb + 1);
    const int srow = tid >> 3, sc8 = tid & 7;
    const unsigned char* kg = (const unsigned char*)P.K + (size_t)head * 192 + (size_t)srow * 3072 + sc8 * 8;
    const unsigned char* vg = (const unsigned char*)P.V + ((size_t)head * 128 + (tid >> 2)) * S + (tid & 3) * 16;
    LAS unsigned char* kst = lds + srow * KS8 + sc8 * 8;
    LAS unsigned char* vst = lds + 2 * MLA_KB8 + (tid >> 2) * VS8 + (tid & 3) * 16;
    const LAS unsigned char* kl = lds + r32 * KS8 + hi * 8;
    const LAS unsigned char* vl = lds + 2 * MLA_KB8 + r32 * VS8 + hi * 8;
    u32x2 sk0, sk1, sk2; u32x4 sv0;
#define MLA_LOADK(j) do { const unsigned char* kp_ = kg + (size_t)(j) * (64 * 3072); sk0 = *(const GAS u32x2*)(kp_); sk1 = *(const GAS u32x2*)(kp_ + 64); sk2 = *(const GAS u32x2*)(kp_ + 128); } while (0)
#define MLA_LOADV(j) do { sv0 = *(const GAS u32x4*)(vg + (size_t)(j) * 64); } while (0)
#define MLA_STOREK(b) do { LAS unsigned char* kd_ = kst + (b) * MLA_KB8; *(LAS u32x2*)(kd_) = sk0; *(LAS u32x2*)(kd_ + 64) = sk1; *(LAS u32x2*)(kd_ + 128) = sk2; } while (0)
#define MLA_STOREV(b) do { LAS unsigned char* vd_ = vst + (b) * VB8; *(LAS u32x2*)(vd_) = (u32x2){sv0.x, sv0.y}; *(LAS u32x2*)(vd_ + 8) = (u32x2){sv0.z, sv0.w}; } while (0)
    float m = -1e30f, l = 0.f; f32x16 o[4];
#pragma unroll
    for (int d = 0; d < 4; ++d)
#pragma unroll
        for (int r = 0; r < 16; ++r) o[d][r] = 0.f;
    f32x16 pA0, pA1, pB0, pB1;
    MLA_LOADK(0); MLA_LOADV(0); MLA_STOREK(0); MLA_STOREV(0);
    MLA_LOADK(1);
    __syncthreads();
    qk_tile8<12>(pA0, pA1, kl, q);
    if (63 > qw) mla_mask(pA0, pA1, tq - 4 * hi);
    MLA_STOREK(1);
    if (2 < NT) MLA_LOADK(2);
    MLA_LOADV(1);
    __syncthreads();
#define MLA_SGB1() do { __builtin_amdgcn_sched_group_barrier(0x100, 2, 0); __builtin_amdgcn_sched_group_barrier(0x008, 1, 0); __builtin_amdgcn_sched_group_barrier(0x002, 6, 0); \
        __builtin_amdgcn_sched_group_barrier(0x008, 1, 0); __builtin_amdgcn_sched_group_barrier(0x002, 6, 0); } while (0)
#define MLA_SGB() do { MLA_SGB1(); MLA_SGB1(); MLA_SGB1(); MLA_SGB1(); MLA_SGB1(); MLA_SGB1(); MLA_SGB1(); MLA_SGB1(); MLA_SGB1(); MLA_SGB1(); MLA_SGB1(); MLA_SGB1(); } while (0)
#define MLA_STEP(PX0, PX1, PY0, PY1, j) do { \
        const int kb1_ = 64 * ((j) + 1); \
        const bool a1_ = ((j) + 1 < NT) && (kb1_ <= qw + 31), a0_ = (64 * (j) <= qw + 31); \
        float alpha_ = 1.f; i64 pb_[4]; \
        if (a1_) { \
            __builtin_amdgcn_sched_barrier(0); \
            qk_tile8_free<12>(PY0, PY1, kl + (((j) + 1) & 1) * MLA_KB8, q); \
            alpha_ = sm_core_scaled(PX0, PX1, m, l, QS_MLA); \
            pb_[0] = packp8<0>(PX0); pb_[1] = packp8<1>(PX0); pb_[2] = packp8<0>(PX1); pb_[3] = packp8<1>(PX1); \
            MLA_SGB(); \
            __builtin_amdgcn_sched_barrier(0); \
            if (kb1_ + 63 > qw) mla_mask(PY0, PY1, tq - kb1_ - 4 * hi); \
        } else if (a0_) { \
            alpha_ = sm_core_scaled(PX0, PX1, m, l, QS_MLA); \
            pb_[0] = packp8<0>(PX0); pb_[1] = packp8<1>(PX0); pb_[2] = packp8<0>(PX1); pb_[3] = packp8<1>(PX1); \
        } \
        if (a0_) { \
            if (!__all(alpha_ == 1.f)) { _Pragma("unroll") for (int d_ = 0; d_ < 4; ++d_) _Pragma("unroll") for (int r_ = 0; r_ < 16; ++r_) o[d_][r_] *= alpha_; } \
            pv_tile8(o, pb_, vl + ((j) & 1) * VB8); \
        } \
        if ((j) + 2 < NT) MLA_STOREK((j) & 1); \
        if ((j) + 1 < NT) MLA_STOREV(((j) + 1) & 1); \
        if ((j) + 3 < NT) MLA_LOADK((j) + 3); \
        if ((j) + 2 < NT) MLA_LOADV((j) + 2); \
        __syncthreads(); } while (0)
    for (int j = 0; j < NT; j += 2) {
        MLA_STEP(pA0, pA1, pB0, pB1, j);
        MLA_STEP(pB0, pB1, pA0, pA1, j + 1);
    }
#undef MLA_STEP
#undef MLA_SGB
#undef MLA_SGB1
#undef MLA_LOADK
#undef MLA_LOADV
#undef MLA_STOREK
#undef MLA_STOREV
    const float inv = (1.f / 256.f) / l;
    const bf16* zp = P.Z + (size_t)tq * 2048 + head * 128 + 4 * hi;
    bf16* op = P.O + (size_t)tq * 4096 + head * 128 + 4 * hi;
#pragma unroll
    for (int d0 = 0; d0 < 4; ++d0)
#pragma unroll
        for (int rg = 0; rg < 4; ++rg) { const int dim = 32 * d0 + 8 * rg;
            const u32x2 z = *(const GAS u32x2*)(zp + dim);
            u32x2 w; w.x = pk2(o[d0][4 * rg + 0] * inv * bflo(z.x), o[d0][4 * rg + 1] * inv * bfhi(z.x)); w.y = pk2(o[d0][4 * rg + 2] * inv * bflo(z.y), o[d0][4 * rg + 3] * inv * bfhi(z.y));
            *(GAS u32x2*)(op + dim) = w; }
}
#elif defined(MLA_PIPE)
struct MlaPtrs { const bf16* Q; const bf16* K; const bf16* V; const bf16* Z; bf16* O; };
__device__ __forceinline__ void mla_mask(f32x16& p0, f32x16& p1, int dq) {
#pragma unroll
    for (int r = 0; r < 16; ++r) { const int c = (r & 3) + 8 * (r >> 2);
        if (c > dq) p0[r] = -__builtin_inff();
        if (c + 32 > dq) p1[r] = -__builtin_inff(); }
}
__device__ __forceinline__ void mla_unit(LAS unsigned char* lds, const MlaPtrs& P, int head, int qb, int tid_in, int wave, int lane_in) {
    int tid = tid_in; asm volatile("" : "+v"(tid)); const int lane = tid & 63; (void)lane_in;
    const int r32 = lane & 31, hi = lane >> 5;
    const int q0 = qb * 256, qw = q0 + wave * 32, tq = qw + r32;
    bf16x8 q[8];
    LAS unsigned char* ql = lds + MLA_QL + wave * 4096 + lane * 16;
    { const bf16* qp = P.Q + (size_t)tq * 3072 + head * 192 + hi * 8;
#pragma unroll
      for (int d0 = 0; d0 < 8; ++d0) q[d0] = *(const GAS bf16x8*)(qp + d0 * 16);
#pragma unroll
      for (int d0 = 8; d0 < 12; ++d0) *(LAS bf16x8*)(ql + (d0 - 8) * 1024) = *(const GAS bf16x8*)(qp + d0 * 16); }
    const int NT = 4 * (qb + 1);
    const int srow = tid >> 3, sc8 = tid & 7;
    const unsigned char* kg = (const unsigned char*)P.K + (size_t)head * 384 + (size_t)srow * 6144 + sc8 * 16;
    const unsigned char* vg = (const unsigned char*)P.V + (size_t)head * 256 + (size_t)srow * 4096 + sc8 * 16;
    LAS unsigned char* kst = lds + srow * KS_M + sc8 * 16;
    LAS unsigned char* vst = lds + 2 * MLA_KB + srow * VS + sc8 * 16;
    const LAS unsigned char* kl = lds + r32 * KS_M + hi * 16;
    const LAS unsigned char* vl = lds + 2 * MLA_KB + (4 * hi + ((lane & 15) >> 2)) * VS + (16 * ((lane >> 4) & 1) + 4 * (lane & 3)) * 2;
    u32x4 sk0, sk1, sk2, sv0, sv1;
#define MLA_LOADK(j) do { const unsigned char* kp_ = kg + (size_t)(j) * (64 * 6144); sk0 = *(const GAS u32x4*)(kp_); sk1 = *(const GAS u32x4*)(kp_ + 128); sk2 = *(const GAS u32x4*)(kp_ + 256); } while (0)
#define MLA_LOADV(j) do { const unsigned char* vp_ = vg + (size_t)(j) * (64 * 4096); sv0 = *(const GAS u32x4*)(vp_); sv1 = *(const GAS u32x4*)(vp_ + 128); } while (0)
#define MLA_STOREK(b) do { LAS unsigned char* kd_ = kst + (b) * MLA_KB; *(LAS u32x4*)(kd_) = sk0; *(LAS u32x4*)(kd_ + 128) = sk1; *(LAS u32x4*)(kd_ + 256) = sk2; } while (0)
#define MLA_STOREV(b) do { LAS unsigned char* vd_ = vst + (b) * VB; *(LAS u32x4*)(vd_) = sv0; *(LAS u32x4*)(vd_ + 128) = sv1; } while (0)
    float m = -1e30f, l = 0.f; f32x16 o[4];
#pragma unroll
    for (int d = 0; d < 4; ++d)
#pragma unroll
        for (int r = 0; r < 16; ++r) o[d][r] = 0.f;
    f32x16 pA0, pA1, pB0, pB1;
    MLA_LOADK(0); MLA_LOADV(0); MLA_STOREK(0); MLA_STOREV(0);
    MLA_LOADK(1);
    __syncthreads();
    qk_tile_free<12, 8, KS_M>(pA0, pA1, kl, q, ql);
    if (63 > qw) mla_mask(pA0, pA1, tq - 4 * hi);
    MLA_STOREK(1);
    if (2 < NT) MLA_LOADK(2);
    MLA_LOADV(1);
    __syncthreads();
#define MLA_SGB1(NR) do { __builtin_amdgcn_sched_group_barrier(0x100, NR, 0); __builtin_amdgcn_sched_group_barrier(0x008, 1, 0); __builtin_amdgcn_sched_group_barrier(0x002, 6, 0); \
        __builtin_amdgcn_sched_group_barrier(0x008, 1, 0); __builtin_amdgcn_sched_group_barrier(0x002, 6, 0); } while (0)
#define MLA_SGB() do { MLA_SGB1(2); MLA_SGB1(2); MLA_SGB1(2); MLA_SGB1(2); MLA_SGB1(2); MLA_SGB1(2); MLA_SGB1(2); MLA_SGB1(2); MLA_SGB1(3); MLA_SGB1(3); MLA_SGB1(3); MLA_SGB1(3); } while (0)
#define MLA_STEP(PX0, PX1, PY0, PY1, j) do { \
        const int kb1_ = 64 * ((j) + 1); \
        const bool a1_ = ((j) + 1 < NT) && (kb1_ <= qw + 31), a0_ = (64 * (j) <= qw + 31); \
        float alpha_ = 1.f; bf16x8 pb_[4]; \
        if (a1_) { \
            __builtin_amdgcn_sched_barrier(0); \
            qk_tile_free<12, 8, KS_M>(PY0, PY1, kl + (((j) + 1) & 1) * MLA_KB, q, ql); \
            alpha_ = sm_core(PX0, PX1, m, l); \
            pb_[0] = packp<0>(PX0); pb_[1] = packp<1>(PX0); pb_[2] = packp<0>(PX1); pb_[3] = packp<1>(PX1); \
            MLA_SGB(); \
            __builtin_amdgcn_sched_barrier(0); \
            if (kb1_ + 63 > qw) mla_mask(PY0, PY1, tq - kb1_ - 4 * hi); \
        } else if (a0_) { \
            alpha_ = sm_core(PX0, PX1, m, l); \
            pb_[0] = packp<0>(PX0); pb_[1] = packp<1>(PX0); pb_[2] = packp<0>(PX1); pb_[3] = packp<1>(PX1); \
        } \
        if (a0_) { \
            if (!__all(alpha_ == 1.f)) { _Pragma("unroll") for (int d_ = 0; d_ < 4; ++d_) _Pragma("unroll") for (int r_ = 0; r_ < 16; ++r_) o[d_][r_] *= alpha_; } \
            pv_tile(o, pb_, vl + ((j) & 1) * VB); \
        } \
        if ((j) + 2 < NT) MLA_STOREK((j) & 1); \
        if ((j) + 1 < NT) MLA_STOREV(((j) + 1) & 1); \
        if ((j) + 3 < NT) MLA_LOADK((j) + 3); \
        if ((j) + 2 < NT) MLA_LOADV((j) + 2); \
        __syncthreads(); } while (0)
    for (int j = 0; j < NT; j += 2) {
        MLA_STEP(pA0, pA1, pB0, pB1, j);
        MLA_STEP(pB0, pB1, pA0, pA1, j + 1);
    }
#undef MLA_STEP
#undef MLA_SGB
#undef MLA_SGB1
#undef MLA_LOADK
#undef MLA_LOADV
#undef MLA_STOREK
#undef MLA_STOREV
    const float inv = 1.f / l;
    const bf16* zp = P.Z + (size_t)tq * 2048 + head * 128 + 4 * hi;
    bf16* op = P.O + (size_t)tq * 4096 + head * 128 + 4 * hi;
#pragma unroll
    for (int d0 = 0; d0 < 4; ++d0)
#pragma unroll
        for (int rg = 0; rg < 4; ++rg) { const int dim = 32 * d0 + 8 * rg;
            const u32x2 z = *(const GAS u32x2*)(zp + dim);
            u32x2 w; w.x = pk2(o[d0][4 * rg + 0] * inv * bflo(z.x), o[d0][4 * rg + 1] * inv * bfhi(z.x)); w.y = pk2(o[d0][4 * rg + 2] * inv * bflo(z.y), o[d0][4 * rg + 3] * inv * bfhi(z.y));
            *(GAS u32x2*)(op + dim) = w; }
}

#else
#if defined(MLA_MXL)
struct MlaPtrs { const bf16* Q; const bf16* K; const bf16* V; const bf16* Z; bf16* O; };
__device__ __forceinline__ void mla_unit(LAS unsigned char* lds, const MlaPtrs& P, int head, int qb, int tid_in, int wave, int lane_in) {
    int tid = tid_in; asm volatile("" : "+v"(tid)); const int lane = tid & 63; (void)lane_in;
    const int r32 = lane & 31, hi = lane >> 5;
    const int q0 = qb * 256, qw = q0 + wave * 32, tq = qw + r32;
    i32x8 q[3];
    { const unsigned char* qp = (const unsigned char*)P.Q + (size_t)tq * 3072 + head * 192 + hi * 32;
#pragma unroll
      for (int s = 0; s < 3; ++s) { const u32x4 a = *(const GAS u32x4*)(qp + 64 * s), b = *(const GAS u32x4*)(qp + 64 * s + 16);
          q[s] = (i32x8){(int)a.x, (int)a.y, (int)a.z, (int)a.w, (int)b.x, (int)b.y, (int)b.z, (int)b.w}; } }
    const int NT = 4 * (qb + 1);
    const int srow = tid >> 3, sc8 = tid & 7;
    const unsigned char* kg = (const unsigned char*)P.K + (size_t)head * 192 + (size_t)srow * 3072 + sc8 * 8;
    const unsigned char* vg = (const unsigned char*)P.V + ((size_t)head * 128 + (tid >> 2)) * S + (tid & 3) * 16;
    LAS unsigned char* kst = lds + srow * KSX + sc8 * 8;
    LAS unsigned char* vst = lds + 2 * MLA_KBX + (tid >> 2) * VSX + (tid & 3) * 16;
    const LAS unsigned char* kl = lds + r32 * KSX + hi * 32;
    const LAS unsigned char* vl = lds + 2 * MLA_KBX + r32 * VSX + hi * 32;
    u32x2 sk0, sk1, sk2; u32x4 sv0;
#define MLA_LOAD(j) do { const unsigned char* kp_ = kg + (size_t)(j) * (64 * 3072); const unsigned char* vp_ = vg + (size_t)(j) * 64; \
        sk0 = *(const GAS u32x2*)(kp_); sk1 = *(const GAS u32x2*)(kp_ + 64); sk2 = *(const GAS u32x2*)(kp_ + 128); sv0 = *(const GAS u32x4*)(vp_); } while (0)
#define MLA_STORE(b, vb) do { LAS unsigned char* kd_ = kst + (b) * MLA_KBX; LAS unsigned char* vd_ = vst + (vb) * VBX; \
        *(LAS u32x2*)(kd_) = sk0; *(LAS u32x2*)(kd_ + 64) = sk1; *(LAS u32x2*)(kd_ + 128) = sk2; *(LAS u32x2*)(vd_) = (u32x2){sv0.x, sv0.y}; *(LAS u32x2*)(vd_ + 8) = (u32x2){sv0.z, sv0.w}; } while (0)
    MLA_LOAD(0); MLA_STORE(0, 0);
    __syncthreads();
    asm volatile("" : "+v"(q[0]), "+v"(q[1]), "+v"(q[2]));
    f32x16 o[5], mref;
#pragma unroll
    for (int d = 0; d < 5; ++d)
#pragma unroll
        for (int r = 0; r < 16; ++r) o[d][r] = 0.f;
#pragma unroll
    for (int r = 0; r < 16; ++r) mref[r] = 0.f;
    const int one8 = (r32 == 0 || r32 == 4) ? 0x38383838 : 0;
    const i32x8 ones = {one8, one8, one8, one8, one8, one8, one8, one8};
    const bool trail = wave >= 4;
    i32x8 pb = {};
    int vb_cur = 0, vb_prev = 2;
    for (int j = 0; j < NT; ++j) {
        const int kb = 64 * j;
        int vb_next = vb_cur + 1; if (vb_next == 3) vb_next = 0;
        if (j + 1 < NT) MLA_LOAD(j + 1);
        if (trail && j > 0 && kb - 64 <= qw + 31) pv_tilexl(o, pb, ones, vl + vb_prev * VBX);
        if (kb <= qw + 31) {
            f32x16 p0, p1;
            qk_tilexl(p0, p1, mref, kl + (j & 1) * MLA_KBX, q);
            if (kb + 63 > qw) {
                const int dq = tq - kb - 4 * hi;
#pragma unroll
                for (int r = 0; r < 16; ++r) { const int c = (r & 3) + 8 * (r >> 2);
                    if (c > dq) p0[r] = -__builtin_inff();
                    if (c + 32 > dq) p1[r] = -__builtin_inff(); }
            }
            float tm = p0[0];
#pragma unroll
            for (int r = 1; r < 16; ++r) tm = fmaxf(tm, p0[r]);
#pragma unroll
            for (int r = 0; r < 16; ++r) tm = fmaxf(tm, p1[r]);
            tm = swapmax(tm);
            if (j == 0 || !__all(tm <= MXL_T)) {
                const float dlt = (j == 0) ? tm : fmaxf(tm, 0.f);
                const float alpha = __builtin_amdgcn_exp2f(-dlt);
#pragma unroll
                for (int r = 0; r < 16; ++r) { p0[r] -= dlt; p1[r] -= dlt; mref[r] -= dlt; }
                if (j > 0) {
#pragma unroll
                    for (int d = 0; d < 5; ++d)
#pragma unroll
                        for (int r = 0; r < 16; ++r) o[d][r] *= alpha;
                }
            }
            pb = exp_packx(p0, p1, one8);
            if (!trail) pv_tilexl(o, pb, ones, vl + vb_cur * VBX);
        }
        if (j + 1 < NT) MLA_STORE((j + 1) & 1, vb_next);
        __syncthreads();
        vb_prev = vb_cur; vb_cur = vb_next;
    }
    if (trail && 64 * (NT - 1) <= qw + 31) pv_tilexl(o, pb, ones, vl + vb_prev * VBX);
    __syncthreads();
#undef MLA_LOAD
#undef MLA_STORE
    const float inv = 1.f / o[4][0];
    const bf16* zp = P.Z + (size_t)tq * 2048 + head * 128 + 4 * hi;
    bf16* op = P.O + (size_t)tq * 4096 + head * 128 + 4 * hi;
#pragma unroll
    for (int d0 = 0; d0 < 4; ++d0)
#pragma unroll
        for (int rg = 0; rg < 4; ++rg) { const int dim = 32 * d0 + 8 * rg;
            const u32x2 z = *(const GAS u32x2*)(zp + dim);
            u32x2 w; w.x = pk2(o[d0][4 * rg + 0] * inv * bflo(z.x), o[d0][4 * rg + 1] * inv * bfhi(z.x)); w.y = pk2(o[d0][4 * rg + 2] * inv * bflo(z.y), o[d0][4 * rg + 3] * inv * bfhi(z.y));
            *(GAS u32x2*)(op + dim) = w; }
}

#elif defined(MLA_MXP)
struct MlaPtrs { const bf16* Q; const bf16* K; const bf16* V; const bf16* Z; bf16* O; };
__device__ __forceinline__ void mla_maskx(f32x16& p0, f32x16& p1, int dq) {
#pragma unroll
    for (int r = 0; r < 16; ++r) { const int c = (r & 3) + 8 * (r >> 2);
        if (c > dq) p0[r] = -__builtin_inff();
        if (c + 32 > dq) p1[r] = -__builtin_inff(); }
}
__device__ __forceinline__ float mla_rowmax(const f32x16& p0, const f32x16& p1) {
    float tm = p0[0];
#pragma unroll
    for (int r = 1; r < 16; ++r) tm = fmaxf(tm, p0[r]);
#pragma unroll
    for (int r = 0; r < 16; ++r) tm = fmaxf(tm, p1[r]);
    return swapmax(tm);
}
#define MXP_EXP8(P, R0) do { _Pragma("unroll") for (int r_ = (R0); r_ < (R0) + 8; ++r_) { P[r_] = __builtin_amdgcn_exp2f(__builtin_fmaf(P[r_], QS_MLA, mc_)); ps_ += P[r_]; } } while (0)
__device__ __forceinline__ void mla_unit(LAS unsigned char* lds, const MlaPtrs& P, int head, int qb, int tid_in, int wave, int lane_in) {
    int tid = tid_in; asm volatile("" : "+v"(tid)); const int lane = tid & 63; (void)lane_in;
    const int r32 = lane & 31, hi = lane >> 5;
    const int q0 = qb * 256, qw = q0 + wave * 32, tq = qw + r32;
    i32x8 q[3];
    { const unsigned char* qp = (const unsigned char*)P.Q + (size_t)tq * 3072 + head * 192 + hi * 32;
#pragma unroll
      for (int s = 0; s < 3; ++s) { const u32x4 a = *(const GAS u32x4*)(qp + 64 * s), b = *(const GAS u32x4*)(qp + 64 * s + 16);
          q[s] = (i32x8){(int)a.x, (int)a.y, (int)a.z, (int)a.w, (int)b.x, (int)b.y, (int)b.z, (int)b.w}; } }
    const int NT = 4 * (qb + 1);
    const int srow = tid >> 3, sc8 = tid & 7;
    const unsigned char* kg = (const unsigned char*)P.K + (size_t)head * 192 + (size_t)srow * 3072 + sc8 * 8;
    const unsigned char* vg = (const unsigned char*)P.V + ((size_t)head * 128 + (tid >> 2)) * S + (tid & 3) * 16;
    LAS unsigned char* kst = lds + srow * KSX + sc8 * 8;
    LAS unsigned char* vst = lds + 2 * MLA_KBX + (tid >> 2) * VSX + (tid & 3) * 16;
    const LAS unsigned char* kl = lds + r32 * KSX + hi * 32;
    const LAS unsigned char* vl = lds + 2 * MLA_KBX + r32 * VSX + hi * 32;
    u32x2 sk0, sk1, sk2; u32x4 sv0;
#define MLA_LOADK(j) do { const unsigned char* kp_ = kg + (size_t)(j) * (64 * 3072); sk0 = *(const GAS u32x2*)(kp_); sk1 = *(const GAS u32x2*)(kp_ + 64); sk2 = *(const GAS u32x2*)(kp_ + 128); } while (0)
#define MLA_LOADV(j) do { sv0 = *(const GAS u32x4*)(vg + (size_t)(j) * 64); } while (0)
#define MLA_STOREK(b) do { LAS unsigned char* kd_ = kst + (b) * MLA_KBX; *(LAS u32x2*)(kd_) = sk0; *(LAS u32x2*)(kd_ + 64) = sk1; *(LAS u32x2*)(kd_ + 128) = sk2; } while (0)
#define MLA_STOREV(b) do { LAS unsigned char* vd_ = vst + (b) * VBX; *(LAS u32x2*)(vd_) = (u32x2){sv0.x, sv0.y}; *(LAS u32x2*)(vd_ + 8) = (u32x2){sv0.z, sv0.w}; } while (0)
    float m = -1e30f, l = 0.f; f32x16 o[4];
#pragma unroll
    for (int d = 0; d < 4; ++d)
#pragma unroll
        for (int r = 0; r < 16; ++r) o[d][r] = 0.f;
    f32x16 pA0, pA1, pB0, pB1;
    MLA_LOADK(0); MLA_LOADV(0); MLA_STOREK(0); MLA_STOREV(0);
    MLA_LOADK(1);
    __syncthreads();
    qk_tilex(pA0, pA1, kl, q);
    if (63 > qw) mla_maskx(pA0, pA1, tq - 4 * hi);
    MLA_STOREK(1);
    if (2 < NT) MLA_LOADK(2);
    MLA_LOADV(1);
    __syncthreads();
    asm volatile("" : "+v"(q[0]), "+v"(q[1]), "+v"(q[2]));
    float tmx = mla_rowmax(pA0, pA1);
#define SB() __builtin_amdgcn_sched_barrier(0)
#define MLA_SMHEAD() const float mn_ = fmaxf(m, tmx); const float alpha_ = __builtin_amdgcn_exp2f((m - mn_) * QS_MLA); m = mn_; const float mc_ = 8.f - mn_ * QS_MLA; float ps_ = 0.f; i32x8 pb_; \
            if (!__all(alpha_ == 1.f)) { _Pragma("unroll") for (int d_ = 0; d_ < 4; ++d_) _Pragma("unroll") for (int r_ = 0; r_ < 16; ++r_) o[d_][r_] *= alpha_; }
#define MXP_EXPK(P, R0, W0) do { MXP_EXP8(P, R0); \
        int w_ = __builtin_amdgcn_cvt_pk_fp8_f32(P[(R0) + 0], P[(R0) + 1], 0, false); pb_[(W0)] = __builtin_amdgcn_cvt_pk_fp8_f32(P[(R0) + 2], P[(R0) + 3], w_, true); \
        w_ = __builtin_amdgcn_cvt_pk_fp8_f32(P[(R0) + 4], P[(R0) + 5], 0, false); pb_[(W0) + 1] = __builtin_amdgcn_cvt_pk_fp8_f32(P[(R0) + 6], P[(R0) + 7], w_, true); } while (0)
#define MLA_SMTAIL() ps_ = swapsum(ps_); l = l * alpha_ + ps_
#define MFMA_T(acc, a, b) asm volatile("s_nop 1\n\tv_mfma_scale_f32_32x32x64_f8f6f4 %0, %1, %2, %0, %3, %3 op_sel_hi:[0,0,0]" : "+v"(acc) : "v"(a), "v"(b), "v"(sc1_))
#define MFMA_Z(acc, a, b) asm volatile("s_nop 1\n\tv_mfma_scale_f32_32x32x64_f8f6f4 %0, %1, %2, 0, %3, %3 op_sel_hi:[0,0,0]" : "=&v"(acc) : "v"(a), "v"(b), "v"(sc1_))
#define MLA_STEP(PX0, PX1, PY0, PY1, j) do { \
        const int kb1_ = 64 * ((j) + 1); \
        const bool a0_ = (64 * (j) <= qw + 31); \
        const LAS unsigned char* vj_ = vl + ((j) & 1) * VBX; \
        if (a0_) {                  \
            const LAS unsigned char* kn_ = kl + (((j) + 1) & 1) * MLA_KBX; \
            MLA_SMHEAD() \
            SB(); \
            i32x8 a0_f = ldsx(kn_), a1_f = ldsx(kn_ + 64); \
            MXP_EXPK(PX0, 0, 0); MXP_EXPK(PX0, 8, 2); \
            SB(); MFMA_Z(PY0, a0_f, q[0]); SB(); \
            a0_f = ldsx(kn_ + 128); \
            MXP_EXPK(PX1, 0, 4); \
            SB(); MFMA_T(PY0, a1_f, q[1]); SB(); \
            a1_f = ldsx(kn_ + 32 * KSX); \
            MXP_EXPK(PX1, 8, 6); \
            SB(); MFMA_T(PY0, a0_f, q[2]); SB(); \
            a0_f = ldsx(kn_ + 32 * KSX + 64); \
            MLA_SMTAIL(); \
            SB(); MFMA_Z(PY1, a1_f, q[0]); SB(); \
            a1_f = ldsx(vj_); \
            SB(); MFMA_T(PY1, a0_f, q[1]); SB(); \
            a0_f = ldsx(kn_ + 32 * KSX + 128); \
            SB(); MFMA_T(o[0], a1_f, pb_); SB(); \
            a1_f = ldsx(vj_ + 32 * VSX); \
            SB(); MFMA_T(PY1, a0_f, q[2]); SB(); \
            a0_f = ldsx(vj_ + 64 * VSX); \
            SB(); MFMA_T(o[1], a1_f, pb_); SB(); \
            a1_f = ldsx(vj_ + 96 * VSX); \
            SB(); MFMA_T(o[2], a0_f, pb_); SB(); \
            SB(); MFMA_T(o[3], a1_f, pb_); SB(); \
            if (kb1_ + 63 > qw) mla_maskx(PY0, PY1, tq - kb1_ - 4 * hi); \
            tmx = mla_rowmax(PY0, PY1); \
        } \
        if ((j) + 2 < NT) MLA_STOREK((j) & 1); \
        if ((j) + 1 < NT) MLA_STOREV(((j) + 1) & 1); \
        if ((j) + 3 < NT) MLA_LOADK((j) + 3); \
        if ((j) + 2 < NT) MLA_LOADV((j) + 2); \
        __syncthreads(); } while (0)
    int sc1_ = 0x7f7f7f7f; asm volatile("" : "+v"(sc1_));
    for (int j = 0; j < NT; j += 2) {
        MLA_STEP(pA0, pA1, pB0, pB1, j);
        MLA_STEP(pB0, pB1, pA0, pA1, j + 1);
    }
    asm volatile("s_nop 15\n\ts_nop 15" ::: "memory");
#undef MLA_STEP
#undef MLA_SMHEAD
#undef MLA_SMTAIL
#undef MXP_EXPK
#undef MFMA_T
#undef MFMA_Z
#undef SB
#undef MLA_LOADK
#undef MLA_LOADV
#undef MLA_STOREK
#undef MLA_STOREV
    const float inv = 1.f / l;
    const bf16* zp = P.Z + (size_t)tq * 2048 + head * 128 + 4 * hi;
    bf16* op = P.O + (size_t)tq * 4096 + head * 128 + 4 * hi;
#pragma unroll
    for (int d0 = 0; d0 < 4; ++d0)
#pragma unroll
        for (int rg = 0; rg < 4; ++rg) { const int dim = 32 * d0 + 8 * rg;
            const u32x2 z = *(const GAS u32x2*)(zp + dim);
            u32x2 w; w.x = pk2(o[d0][4 * rg + 0] * inv * bflo(z.x), o[d0][4 * rg + 1] * inv * bfhi(z.x)); w.y = pk2(o[d0][4 * rg + 2] * inv * bflo(z.y), o[d0][4 * rg + 3] * inv * bfhi(z.y));
            *(GAS u32x2*)(op + dim) = w; }
}
#undef MXP_EXP8

#elif defined(MLA_MX)
struct MlaPtrs { const bf16* Q; const bf16* K; const bf16* V; const bf16* Z; bf16* O; };
__device__ __forceinline__ void mla_unit(LAS unsigned char* lds, const MlaPtrs& P, int head, int qb, int tid_in, int wave, int lane_in) {
    int tid = tid_in; asm volatile("" : "+v"(tid)); const int lane = tid & 63; (void)lane_in;
    const int r32 = lane & 31, hi = lane >> 5;
    const int q0 = qb * 256, qw = q0 + wave * 32, tq = qw + r32;
    i32x8 q[3];
    { const unsigned char* qp = (const unsigned char*)P.Q + (size_t)tq * 3072 + head * 192 + hi * 32;
#pragma unroll
      for (int s = 0; s < 3; ++s) { const u32x4 a = *(const GAS u32x4*)(qp + 64 * s), b = *(const GAS u32x4*)(qp + 64 * s + 16);
          q[s] = (i32x8){(int)a.x, (int)a.y, (int)a.z, (int)a.w, (int)b.x, (int)b.y, (int)b.z, (int)b.w}; } }
    const int NT = 4 * (qb + 1);
    const int srow = tid >> 3, sc8 = tid & 7;
    const unsigned char* kg = (const unsigned char*)P.K + (size_t)head * 192 + (size_t)srow * 3072 + sc8 * 8;
    const unsigned char* vg = (const unsigned char*)P.V + ((size_t)head * 128 + (tid >> 2)) * S + (tid & 3) * 16;
    LAS unsigned char* kst = lds + srow * KSX + sc8 * 8;
    LAS unsigned char* vst = lds + 2 * MLA_KBX + (tid >> 2) * VSX + (tid & 3) * 16;
    const LAS unsigned char* kl = lds + r32 * KSX + hi * 32;
    const LAS unsigned char* vl = lds + 2 * MLA_KBX + r32 * VSX + hi * 32;
    u32x2 sk0, sk1, sk2; u32x4 sv0;
#define MLA_LOAD(j) do { const unsigned char* kp_ = kg + (size_t)(j) * (64 * 3072); const unsigned char* vp_ = vg + (size_t)(j) * 64; \
        sk0 = *(const GAS u32x2*)(kp_); sk1 = *(const GAS u32x2*)(kp_ + 64); sk2 = *(const GAS u32x2*)(kp_ + 128); sv0 = *(const GAS u32x4*)(vp_); } while (0)
#define MLA_STORE(b, vb) do { LAS unsigned char* kd_ = kst + (b) * MLA_KBX; LAS unsigned char* vd_ = vst + (vb) * VBX; \
        *(LAS u32x2*)(kd_) = sk0; *(LAS u32x2*)(kd_ + 64) = sk1; *(LAS u32x2*)(kd_ + 128) = sk2; *(LAS u32x2*)(vd_) = (u32x2){sv0.x, sv0.y}; *(LAS u32x2*)(vd_ + 8) = (u32x2){sv0.z, sv0.w}; } while (0)
    MLA_LOAD(0); MLA_STORE(0, 0);
    __syncthreads();
    asm volatile("" : "+v"(q[0]), "+v"(q[1]), "+v"(q[2]));
    float m = -1e30f, l = 0.f; f32x16 o[4];
#pragma unroll
    for (int d = 0; d < 4; ++d)
#pragma unroll
        for (int r = 0; r < 16; ++r) o[d][r] = 0.f;
    const bool trail = wave >= 4;
    i32x8 pb = {};
    int vb_cur = 0, vb_prev = 2;
    for (int j = 0; j < NT; ++j) {
        const int kb = 64 * j;
        int vb_next = vb_cur + 1; if (vb_next == 3) vb_next = 0;
        if (j + 1 < NT) MLA_LOAD(j + 1);
        if (trail && j > 0 && kb - 64 <= qw + 31) pv_tilex(o, pb, vl + vb_prev * VBX);
        if (kb <= qw + 31) {
            f32x16 p0, p1;
            qk_tilex(p0, p1, kl + (j & 1) * MLA_KBX, q);
            if (kb + 63 > qw) {
                const int dq = tq - kb - 4 * hi;
#pragma unroll
                for (int r = 0; r < 16; ++r) { const int c = (r & 3) + 8 * (r >> 2);
                    if (c > dq) p0[r] = -__builtin_inff();
                    if (c + 32 > dq) p1[r] = -__builtin_inff(); }
            }
            online_sm_x(p0, p1, m, l, o, QS_MLA);
            pb = packpx(p0, p1);
            if (!trail) pv_tilex(o, pb, vl + vb_cur * VBX);
        }
        if (j + 1 < NT) MLA_STORE((j + 1) & 1, vb_next);
        __syncthreads();
        vb_prev = vb_cur; vb_cur = vb_next;
    }
    if (trail && 64 * (NT - 1) <= qw + 31) pv_tilex(o, pb, vl + vb_prev * VBX);
    __syncthreads();
#undef MLA_LOAD
#undef MLA_STORE
    const float inv = 1.f / l;
    const bf16* zp = P.Z + (size_t)tq * 2048 + head * 128 + 4 * hi;
    bf16* op = P.O + (size_t)tq * 4096 + head * 128 + 4 * hi;
#pragma unroll
    for (int d0 = 0; d0 < 4; ++d0)
#pragma unroll
        for (int rg = 0; rg < 4; ++rg) { const int dim = 32 * d0 + 8 * rg;
            const u32x2 z = *(const GAS u32x2*)(zp + dim);
            u32x2 w; w.x = pk2(o[d0][4 * rg + 0] * inv * bflo(z.x), o[d0][4 * rg + 1] * inv * bfhi(z.x)); w.y = pk2(o[d0][4 * rg + 2] * inv * bflo(z.y), o[d0][4 * rg + 3] * inv * bfhi(z.y));
            *(GAS u32x2*)(op + dim) = w; }
}

#elif defined(MLA_BIG)
struct MlaPtrs { const bf16* Q; const bf16* K; const bf16* V; const bf16* Z; bf16* O; };
__device__ __forceinline__ void mla_unit(LAS unsigned char* lds, const MlaPtrs& P, int head, int qb, int tid_in, int wave, int lane_in) {
    int tid = tid_in; asm volatile("" : "+v"(tid)); const int lane = tid & 63; (void)lane_in;
    const int r32 = lane & 31, hi = lane >> 5;
    const int q0 = qb * 256, qw = q0 + wave * 32, tq = qw + r32;
    i64 q[12];
    { const unsigned char* qp = (const unsigned char*)P.Q + (size_t)tq * 3072 + head * 192 + hi * 8;
#pragma unroll
      for (int d0 = 0; d0 < 12; ++d0) q[d0] = *(const GAS i64*)(qp + d0 * 16); }
    const int NT = 4 * (qb + 1), NTB = NT / 2;
    const int srow = tid >> 3, sc8 = tid & 7;
    const unsigned char* kg = (const unsigned char*)P.K + (size_t)head * 192 + (size_t)srow * 3072 + sc8 * 8;
    const unsigned char* vg = (const unsigned char*)P.V + ((size_t)head * 128 + (tid >> 2)) * S + (tid & 3) * 32;
    LAS unsigned char* kst = lds + srow * KS8 + sc8 * 8;
    LAS unsigned char* vst = lds + 2 * MLA_KB8B + (tid >> 2) * VS8B + (tid & 3) * 32;
    const LAS unsigned char* kl = lds + r32 * KS8 + hi * 8;
    const LAS unsigned char* vl = lds + 2 * MLA_KB8B + r32 * VS8B + hi * 8;
    u32x2 sk0, sk1, sk2, sk3, sk4, sk5; u32x4 sv0, sv1;
#define MLA_LOAD(J) do { const unsigned char* kp_ = kg + (size_t)(J) * (128 * 3072); const unsigned char* vp_ = vg + (size_t)(J) * 128; \
        sk0 = *(const GAS u32x2*)(kp_); sk1 = *(const GAS u32x2*)(kp_ + 64); sk2 = *(const GAS u32x2*)(kp_ + 128); \
        sk3 = *(const GAS u32x2*)(kp_ + 64 * 3072); sk4 = *(const GAS u32x2*)(kp_ + 64 * 3072 + 64); sk5 = *(const GAS u32x2*)(kp_ + 64 * 3072 + 128); \
        sv0 = *(const GAS u32x4*)(vp_); sv1 = *(const GAS u32x4*)(vp_ + 16); } while (0)
#define MLA_STORE(b, vb) do { LAS unsigned char* kd_ = kst + (b) * MLA_KB8B; LAS unsigned char* vd_ = vst + (vb) * VB8B; \
        *(LAS u32x2*)(kd_) = sk0; *(LAS u32x2*)(kd_ + 64) = sk1; *(LAS u32x2*)(kd_ + 128) = sk2; \
        *(LAS u32x2*)(kd_ + 64 * KS8) = sk3; *(LAS u32x2*)(kd_ + 64 * KS8 + 64) = sk4; *(LAS u32x2*)(kd_ + 64 * KS8 + 128) = sk5; \
        *(LAS u32x2*)(vd_) = (u32x2){sv0.x, sv0.y}; *(LAS u32x2*)(vd_ + 8) = (u32x2){sv0.z, sv0.w}; *(LAS u32x2*)(vd_ + 16) = (u32x2){sv1.x, sv1.y}; *(LAS u32x2*)(vd_ + 24) = (u32x2){sv1.z, sv1.w}; } while (0)
    MLA_LOAD(0); MLA_STORE(0, 0);
    __syncthreads();
    float m = -1e30f, l = 0.f; f32x16 o[4];
#pragma unroll
    for (int d = 0; d < 4; ++d)
#pragma unroll
        for (int r = 0; r < 16; ++r) o[d][r] = 0.f;
    const bool trail = wave >= 4;
    i64 pb[4] = {};
    int vb_cur = 0, vb_prev = 2;
    for (int J = 0; J < NTB; ++J) {
        int vb_next = vb_cur + 1; if (vb_next == 3) vb_next = 0;
        if (J + 1 < NTB) MLA_LOAD(J + 1);
#pragma unroll
        for (int sub = 0; sub < 2; ++sub) {
            const int j = 2 * J + sub, kb = 64 * j;
            if (trail && j > 0 && kb - 64 <= qw + 31) pv_tile8(o, pb, vl + (sub == 0 ? vb_prev * VB8B + 64 : vb_cur * VB8B));
            if (kb <= qw + 31) {
                f32x16 p0, p1;
                qk_tile8<12>(p0, p1, kl + (J & 1) * MLA_KB8B + sub * 64 * KS8, q);
                if (kb + 63 > qw) {
                    const int dq = tq - kb - 4 * hi;
#pragma unroll
                    for (int r = 0; r < 16; ++r) { const int c = (r & 3) + 8 * (r >> 2);
                        if (c > dq) p0[r] = -__builtin_inff();
                        if (c + 32 > dq) p1[r] = -__builtin_inff(); }
                }
                online_sm_scaled(p0, p1, m, l, o, QS_MLA);
                pb[0] = packp8<0>(p0); pb[1] = packp8<1>(p0); pb[2] = packp8<0>(p1); pb[3] = packp8<1>(p1);
                if (!trail) pv_tile8(o, pb, vl + vb_cur * VB8B + sub * 64);
            }
        }
        if (J + 1 < NTB) MLA_STORE((J + 1) & 1, vb_next);
        __syncthreads();
        vb_prev = vb_cur; vb_cur = vb_next;
    }
    if (trail && 64 * (NT - 1) <= qw + 31) pv_tile8(o, pb, vl + vb_prev * VB8B + 64);
    __syncthreads();
#undef MLA_LOAD
#undef MLA_STORE
    const float inv = (1.f / 256.f) / l;
    const bf16* zp = P.Z + (size_t)tq * 2048 + head * 128 + 4 * hi;
    bf16* op = P.O + (size_t)tq * 4096 + head * 128 + 4 * hi;
#pragma unroll
    for (int d0 = 0; d0 < 4; ++d0)
#pragma unroll
        for (int rg = 0; rg < 4; ++rg) { const int dim = 32 * d0 + 8 * rg;
            const u32x2 z = *(const GAS u32x2*)(zp + dim);
            u32x2 w; w.x = pk2(o[d0][4 * rg + 0] * inv * bflo(z.x), o[d0][4 * rg + 1] * inv * bfhi(z.x)); w.y = pk2(o[d0][4 * rg + 2] * inv * bflo(z.y), o[d0][4 * rg + 3] * inv * bfhi(z.y));
            *(GAS u32x2*)(op + dim) = w; }
}

#elif defined(MLA_FP8V)
struct MlaPtrs { const bf16* Q; const bf16* K; const bf16* V; const bf16* Z; bf16* O; };
__device__ __forceinline__ void mla_unit(LAS unsigned char* lds, const MlaPtrs& P, int head, int qb, int tid_in, int wave, int lane_in) {
    int tid = tid_in; asm volatile("" : "+v"(tid)); const int lane = tid & 63; (void)lane_in;
    const int r32 = lane & 31, hi = lane >> 5;
    const int q0 = qb * 256, qw = q0 + wave * 32, tq = qw + r32;
    i64 q[12];
    { const unsigned char* qp = (const unsigned char*)P.Q + (size_t)tq * 3072 + head * 192 + hi * 8;
#pragma unroll
      for (int d0 = 0; d0 < 12; ++d0) q[d0] = *(const GAS i64*)(qp + d0 * 16); }
    const int NT = 4 * (qb + 1);
    const int srow = tid >> 3, sc8 = tid & 7;
    const unsigned char* kg = (const unsigned char*)P.K + (size_t)head * 192 + (size_t)srow * 3072 + sc8 * 8;
    const unsigned char* vg = (const unsigned char*)P.V + ((size_t)head * 128 + (tid >> 2)) * S + (tid & 3) * 16;
    LAS unsigned char* kst = lds + srow * KS8 + sc8 * 8;
    LAS unsigned char* vst = lds + 2 * MLA_KB8 + (tid >> 2) * VS8 + (tid & 3) * 16;
    const LAS unsigned char* kl = lds + r32 * KS8 + hi * 8;
    const LAS unsigned char* vl = lds + 2 * MLA_KB8 + r32 * VS8 + hi * 8;
    u32x2 sk0, sk1, sk2; u32x4 sv0;
#define MLA_LOAD(j) do { const unsigned char* kp_ = kg + (size_t)(j) * (64 * 3072); const unsigned char* vp_ = vg + (size_t)(j) * 64; \
        sk0 = *(const GAS u32x2*)(kp_); sk1 = *(const GAS u32x2*)(kp_ + 64); sk2 = *(const GAS u32x2*)(kp_ + 128); sv0 = *(const GAS u32x4*)(vp_); } while (0)
#define MLA_STORE(b, vb) do { LAS unsigned char* kd_ = kst + (b) * MLA_KB8; LAS unsigned char* vd_ = vst + (vb) * VB8; \
        *(LAS u32x2*)(kd_) = sk0; *(LAS u32x2*)(kd_ + 64) = sk1; *(LAS u32x2*)(kd_ + 128) = sk2; *(LAS u32x2*)(vd_) = (u32x2){sv0.x, sv0.y}; *(LAS u32x2*)(vd_ + 8) = (u32x2){sv0.z, sv0.w}; } while (0)
    MLA_LOAD(0); MLA_STORE(0, 0);
    __syncthreads();
    float m = -1e30f, l = 0.f; f32x16 o[4];
#pragma unroll
    for (int d = 0; d < 4; ++d)
#pragma unroll
        for (int r = 0; r < 16; ++r) o[d][r] = 0.f;
    const bool trail = wave >= 4;
    i64 pb[4] = {};
    int vb_cur = 0, vb_prev = 2;
    for (int j = 0; j < NT; ++j) {
        const int kb = 64 * j;
        int vb_next = vb_cur + 1; if (vb_next == 3) vb_next = 0;
        if (j + 1 < NT) MLA_LOAD(j + 1);
        if (trail && j > 0 && kb - 64 <= qw + 31) pv_tile8(o, pb, vl + vb_prev * VB8);
        if (kb <= qw + 31) {
            f32x16 p0, p1;
#ifdef PROBE_QKM2
            { f32x16 r0, r1; qk_tile_m2<12, KS_M>(p0, p1, r0, r1, kl + (j & 1) * MLA_KB, q);
#pragma unroll
              for (int r = 0; r < 16; ++r) { p0[r] = (p0[r] + r0[r]) * 0.5f; p1[r] = (p1[r] + r1[r]) * 0.5f; } }
#else
            qk_tile8<12>(p0, p1, kl + (j & 1) * MLA_KB8, q);
#endif
#ifdef PROBE_QK2
            { f32x16 r0, r1; asm volatile("" ::: "memory"); qk_tile<12, KS_M>(r0, r1, kl + (j & 1) * MLA_KB, q);
#pragma unroll
              for (int r = 0; r < 16; ++r) { p0[r] = (p0[r] + r0[r]) * 0.5f; p1[r] = (p1[r] + r1[r]) * 0.5f; } }
#endif
#ifdef PROBE_SM2
            { float acc_ = 0.f;
#pragma unroll
              for (int r = 0; r < 16; ++r) { acc_ += __builtin_amdgcn_exp2f(p0[r] - m - 40.f) + __builtin_amdgcn_exp2f(p1[r] - m - 40.f); }
#pragma unroll
              for (int r = 0; r < 16; ++r) { acc_ += __builtin_amdgcn_exp2f(p0[r] - m - 50.f) + __builtin_amdgcn_exp2f(p1[r] - m - 50.f); }
              if (acc_ == 12345.678f) l += 1.f; }
#endif
            if (kb + 63 > qw) {
                const int dq = tq - kb - 4 * hi;
#pragma unroll
                for (int r = 0; r < 16; ++r) { const int c = (r & 3) + 8 * (r >> 2);
                    if (c > dq) p0[r] = -__builtin_inff();
                    if (c + 32 > dq) p1[r] = -__builtin_inff(); }
            }
            online_sm_scaled(p0, p1, m, l, o, QS_MLA);
            pb[0] = packp8<0>(p0); pb[1] = packp8<1>(p0); pb[2] = packp8<0>(p1); pb[3] = packp8<1>(p1);
            if (!trail) pv_tile8(o, pb, vl + vb_cur * VB8);
        }
        if (j + 1 < NT) MLA_STORE((j + 1) & 1, vb_next);
        __syncthreads();
        vb_prev = vb_cur; vb_cur = vb_next;
    }
    if (trail && 64 * (NT - 1) <= qw + 31) pv_tile8(o, pb, vl + vb_prev * VB8);
    __syncthreads();
#undef MLA_LOAD
#undef MLA_STORE
    const float inv = (1.f / 256.f) / l;
    const bf16* zp = P.Z + (size_t)tq * 2048 + head * 128 + 4 * hi;
    bf16* op = P.O + (size_t)tq * 4096 + head * 128 + 4 * hi;
#pragma unroll
    for (int d0 = 0; d0 < 4; ++d0)
#pragma unroll
        for (int rg = 0; rg < 4; ++rg) { const int dim = 32 * d0 + 8 * rg;
            const u32x2 z = *(const GAS u32x2*)(zp + dim);
            u32x2 w; w.x = pk2(o[d0][4 * rg + 0] * inv * bflo(z.x), o[d0][4 * rg + 1] * inv * bfhi(z.x)); w.y = pk2(o[d0][4 * rg + 2] * inv * bflo(z.y), o[d0][4 * rg + 3] * inv * bfhi(z.y));
            *(GAS u32x2*)(op + dim) = w; }
}

#elif defined(MLA_FP8)
struct MlaPtrs { const bf16* Q; const bf16* K; const bf16* V; const bf16* Z; bf16* O; };
__device__ __forceinline__ void mla_unit(LAS unsigned char* lds, const MlaPtrs& P, int head, int qb, int tid_in, int wave, int lane_in) {
    int tid = tid_in; asm volatile("" : "+v"(tid)); const int lane = tid & 63; (void)lane_in;
    const int r32 = lane & 31, hi = lane >> 5;
    const int q0 = qb * 256, qw = q0 + wave * 32, tq = qw + r32;
    i64 q[12];
    { const unsigned char* qp = (const unsigned char*)P.Q + (size_t)tq * 3072 + head * 192 + hi * 8;
#pragma unroll
      for (int d0 = 0; d0 < 12; ++d0) q[d0] = *(const GAS i64*)(qp + d0 * 16); }
    const int NT = 4 * (qb + 1);
    const int srow = tid >> 3, sc8 = tid & 7;
    const unsigned char* kg = (const unsigned char*)P.K + (size_t)head * 192 + (size_t)srow * 3072 + sc8 * 8;
    const unsigned char* vg = (const unsigned char*)P.V + (size_t)head * 256 + (size_t)srow * 4096 + sc8 * 16;
    LAS unsigned char* kst = lds + srow * KS8 + sc8 * 8;
    LAS unsigned char* vst = lds + 2 * MLA_KB8 + srow * VS + sc8 * 16;
    const LAS unsigned char* kl = lds + r32 * KS8 + hi * 8;
    const LAS unsigned char* vl = lds + 2 * MLA_KB8 + (4 * hi + ((lane & 15) >> 2)) * VS + (16 * ((lane >> 4) & 1) + 4 * (lane & 3)) * 2;
    u32x2 sk0, sk1, sk2; u32x4 sv0, sv1;
#define MLA_LOAD(j) do { const unsigned char* kp_ = kg + (size_t)(j) * (64 * 3072); const unsigned char* vp_ = vg + (size_t)(j) * (64 * 4096); \
        sk0 = *(const GAS u32x2*)(kp_); sk1 = *(const GAS u32x2*)(kp_ + 64); sk2 = *(const GAS u32x2*)(kp_ + 128); sv0 = *(const GAS u32x4*)(vp_); sv1 = *(const GAS u32x4*)(vp_ + 128); } while (0)
#define MLA_STORE(b, vb) do { LAS unsigned char* kd_ = kst + (b) * MLA_KB8; LAS unsigned char* vd_ = vst + (vb) * VB; \
        *(LAS u32x2*)(kd_) = sk0; *(LAS u32x2*)(kd_ + 64) = sk1; *(LAS u32x2*)(kd_ + 128) = sk2; *(LAS u32x4*)(vd_) = sv0; *(LAS u32x4*)(vd_ + 128) = sv1; } while (0)
    MLA_LOAD(0); MLA_STORE(0, 0);
    __syncthreads();
    float m = -1e30f, l = 0.f; f32x16 o[4];
#pragma unroll
    for (int d = 0; d < 4; ++d)
#pragma unroll
        for (int r = 0; r < 16; ++r) o[d][r] = 0.f;
    const bool trail = wave >= 4;
    bf16x8 pb[4] = {};
    int vb_cur = 0, vb_prev = 2;
    for (int j = 0; j < NT; ++j) {
        const int kb = 64 * j;
        int vb_next = vb_cur + 1; if (vb_next == 3) vb_next = 0;
        if (j + 1 < NT) MLA_LOAD(j + 1);
        if (trail && j > 0 && kb - 64 <= qw + 31) pv_tile(o, pb, vl + vb_prev * VB);
        if (kb <= qw + 31) {
            f32x16 p0, p1;
#ifdef PROBE_QKM2
            { f32x16 r0, r1; qk_tile_m2<12, KS_M>(p0, p1, r0, r1, kl + (j & 1) * MLA_KB, q);
#pragma unroll
              for (int r = 0; r < 16; ++r) { p0[r] = (p0[r] + r0[r]) * 0.5f; p1[r] = (p1[r] + r1[r]) * 0.5f; } }
#else
            qk_tile8<12>(p0, p1, kl + (j & 1) * MLA_KB8, q);
#endif
#ifdef PROBE_QK2
            { f32x16 r0, r1; asm volatile("" ::: "memory"); qk_tile<12, KS_M>(r0, r1, kl + (j & 1) * MLA_KB, q);
#pragma unroll
              for (int r = 0; r < 16; ++r) { p0[r] = (p0[r] + r0[r]) * 0.5f; p1[r] = (p1[r] + r1[r]) * 0.5f; } }
#endif
#ifdef PROBE_SM2
            { float acc_ = 0.f;
#pragma unroll
              for (int r = 0; r < 16; ++r) { acc_ += __builtin_amdgcn_exp2f(p0[r] - m - 40.f) + __builtin_amdgcn_exp2f(p1[r] - m - 40.f); }
#pragma unroll
              for (int r = 0; r < 16; ++r) { acc_ += __builtin_amdgcn_exp2f(p0[r] - m - 50.f) + __builtin_amdgcn_exp2f(p1[r] - m - 50.f); }
              if (acc_ == 12345.678f) l += 1.f; }
#endif
            if (kb + 63 > qw) {
                const int dq = tq - kb - 4 * hi;
#pragma unroll
                for (int r = 0; r < 16; ++r) { const int c = (r & 3) + 8 * (r >> 2);
                    if (c > dq) p0[r] = -__builtin_inff();
                    if (c + 32 > dq) p1[r] = -__builtin_inff(); }
            }
            online_sm_scaled(p0, p1, m, l, o, QS_MLA);
            pb[0] = packp<0>(p0); pb[1] = packp<1>(p0); pb[2] = packp<0>(p1); pb[3] = packp<1>(p1);
            if (!trail) pv_tile(o, pb, vl + vb_cur * VB);
        }
        if (j + 1 < NT) MLA_STORE((j + 1) & 1, vb_next);
        __syncthreads();
        vb_prev = vb_cur; vb_cur = vb_next;
    }
    if (trail && 64 * (NT - 1) <= qw + 31) pv_tile(o, pb, vl + vb_prev * VB);
    __syncthreads();
#undef MLA_LOAD
#undef MLA_STORE
    const float inv = 1.f / l;
    const bf16* zp = P.Z + (size_t)tq * 2048 + head * 128 + 4 * hi;
    bf16* op = P.O + (size_t)tq * 4096 + head * 128 + 4 * hi;
#pragma unroll
    for (int d0 = 0; d0 < 4; ++d0)
#pragma unroll
        for (int rg = 0; rg < 4; ++rg) { const int dim = 32 * d0 + 8 * rg;
            const u32x2 z = *(const GAS u32x2*)(zp + dim);
            u32x2 w; w.x = pk2(o[d0][4 * rg + 0] * inv * bflo(z.x), o[d0][4 * rg + 1] * inv * bfhi(z.x)); w.y = pk2(o[d0][4 * rg + 2] * inv * bflo(z.y), o[d0][4 * rg + 3] * inv * bfhi(z.y));
            *(GAS u32x2*)(op + dim) = w; }
}

#else
struct MlaPtrs { const bf16* Q; const bf16* K; const bf16* V; const bf16* Z; bf16* O; };
__device__ __forceinline__ void mla_unit(LAS unsigned char* lds, const MlaPtrs& P, int head, int qb, int tid_in, int wave, int lane_in) {
    int tid = tid_in; asm volatile("" : "+v"(tid)); const int lane = tid & 63; (void)lane_in;
    const int r32 = lane & 31, hi = lane >> 5;
    const int q0 = qb * 256, qw = q0 + wave * 32, tq = qw + r32;
    bf16x8 q[12];
    { const bf16* qp = P.Q + (size_t)tq * 3072 + head * 192 + hi * 8;
#pragma unroll
      for (int d0 = 0; d0 < 12; ++d0) q[d0] = *(const GAS bf16x8*)(qp + d0 * 16); }
    const int NT = 4 * (qb + 1);
    const int srow = tid >> 3, sc8 = tid & 7;
    const unsigned char* kg = (const unsigned char*)P.K + (size_t)head * 384 + (size_t)srow * 6144 + sc8 * 16;
    const unsigned char* vg = (const unsigned char*)P.V + (size_t)head * 256 + (size_t)srow * 4096 + sc8 * 16;
    LAS unsigned char* kst = lds + srow * KS_M + sc8 * 16;
    LAS unsigned char* vst = lds + 2 * MLA_KB + srow * VS + sc8 * 16;
    const LAS unsigned char* kl = lds + r32 * KS_M + hi * 16;
    const LAS unsigned char* vl = lds + 2 * MLA_KB + (4 * hi + ((lane & 15) >> 2)) * VS + (16 * ((lane >> 4) & 1) + 4 * (lane & 3)) * 2;
    u32x4 sk0, sk1, sk2, sv0, sv1;
#define MLA_LOAD(j) do { const unsigned char* kp_ = kg + (size_t)(j) * (64 * 6144); const unsigned char* vp_ = vg + (size_t)(j) * (64 * 4096); \
        sk0 = *(const GAS u32x4*)(kp_); sk1 = *(const GAS u32x4*)(kp_ + 128); sk2 = *(const GAS u32x4*)(kp_ + 256); sv0 = *(const GAS u32x4*)(vp_); sv1 = *(const GAS u32x4*)(vp_ + 128); } while (0)
#define MLA_STORE(b, vb) do { LAS unsigned char* kd_ = kst + (b) * MLA_KB; LAS unsigned char* vd_ = vst + (vb) * VB; \
        *(LAS u32x4*)(kd_) = sk0; *(LAS u32x4*)(kd_ + 128) = sk1; *(LAS u32x4*)(kd_ + 256) = sk2; *(LAS u32x4*)(vd_) = sv0; *(LAS u32x4*)(vd_ + 128) = sv1; } while (0)
    MLA_LOAD(0); MLA_STORE(0, 0);
    __syncthreads();
    float m = -1e30f, l = 0.f; f32x16 o[4];
#pragma unroll
    for (int d = 0; d < 4; ++d)
#pragma unroll
        for (int r = 0; r < 16; ++r) o[d][r] = 0.f;
    const bool trail = wave >= 4;
    bf16x8 pb[4] = {};
    int vb_cur = 0, vb_prev = 2;
    for (int j = 0; j < NT; ++j) {
        const int kb = 64 * j;
        int vb_next = vb_cur + 1; if (vb_next == 3) vb_next = 0;
        if (j + 1 < NT) MLA_LOAD(j + 1);
        if (trail && j > 0 && kb - 64 <= qw + 31) pv_tile(o, pb, vl + vb_prev * VB);
        if (kb <= qw + 31) {
            f32x16 p0, p1;
#ifdef PROBE_QKM2
            { f32x16 r0, r1; qk_tile_m2<12, KS_M>(p0, p1, r0, r1, kl + (j & 1) * MLA_KB, q);
#pragma unroll
              for (int r = 0; r < 16; ++r) { p0[r] = (p0[r] + r0[r]) * 0.5f; p1[r] = (p1[r] + r1[r]) * 0.5f; } }
#else
            qk_tile<12, KS_M>(p0, p1, kl + (j & 1) * MLA_KB, q);
#endif
#ifdef PROBE_QK2
            { f32x16 r0, r1; asm volatile("" ::: "memory"); qk_tile<12, KS_M>(r0, r1, kl + (j & 1) * MLA_KB, q);
#pragma unroll
              for (int r = 0; r < 16; ++r) { p0[r] = (p0[r] + r0[r]) * 0.5f; p1[r] = (p1[r] + r1[r]) * 0.5f; } }
#endif
#ifdef PROBE_SM2
            { float acc_ = 0.f;
#pragma unroll
              for (int r = 0; r < 16; ++r) { acc_ += __builtin_amdgcn_exp2f(p0[r] - m - 40.f) + __builtin_amdgcn_exp2f(p1[r] - m - 40.f); }
#pragma unroll
              for (int r = 0; r < 16; ++r) { acc_ += __builtin_amdgcn_exp2f(p0[r] - m - 50.f) + __builtin_amdgcn_exp2f(p1[r] - m - 50.f); }
              if (acc_ == 12345.678f) l += 1.f; }
#endif
            if (kb + 63 > qw) {
                const int dq = tq - kb - 4 * hi;
#pragma unroll
                for (int r = 0; r < 16; ++r) { const int c = (r & 3) + 8 * (r >> 2);
                    if (c > dq) p0[r] = -__builtin_inff();
                    if (c + 32 > dq) p1[r] = -__builtin_inff(); }
            }
            online_sm(p0, p1, m, l, o);
            pb[0] = packp<0>(p0); pb[1] = packp<1>(p0); pb[2] = packp<0>(p1); pb[3] = packp<1>(p1);
            if (!trail) pv_tile(o, pb, vl + vb_cur * VB);
        }
        if (j + 1 < NT) MLA_STORE((j + 1) & 1, vb_next);
        __syncthreads();
        vb_prev = vb_cur; vb_cur = vb_next;
    }
    if (trail && 64 * (NT - 1) <= qw + 31) pv_tile(o, pb, vl + vb_prev * VB);
    __syncthreads();
#undef MLA_LOAD
#undef MLA_STORE
    const float inv = 1.f / l;
    const bf16* zp = P.Z + (size_t)tq * 2048 + head * 128 + 4 * hi;
    bf16* op = P.O + (size_t)tq * 4096 + head * 128 + 4 * hi;
#pragma unroll
    for (int d0 = 0; d0 < 4; ++d0)
#pragma unroll
        for (int rg = 0; rg < 4; ++rg) { const int dim = 32 * d0 + 8 * rg;
            const u32x2 z = *(const GAS u32x2*)(zp + dim);
            u32x2 w; w.x = pk2(o[d0][4 * rg + 0] * inv * bflo(z.x), o[d0][4 * rg + 1] * inv * bfhi(z.x)); w.y = pk2(o[d0][4 * rg + 2] * inv * bflo(z.y), o[d0][4 * rg + 3] * inv * bfhi(z.y));
            *(GAS u32x2*)(op + dim) = w; }
}

#endif
#endif
struct NsaPtrs { const bf16* Q; const bf16* KV; const bf16* KC; const bf16* VC; const bf16* Z; const float* G; bf16* O; float* scr; };
template <int MODE>
__device__ __forceinline__ void nsa_loop(LAS unsigned char* lds, const unsigned char* kbase, const unsigned char* vbase, int ntiles, int jlo,
                                         const bf16x8 (&q)[8], int t, float slope2, float& m, float& l, f32x16 (&o)[4], float invl, int tid, int wave, int lane) {
    constexpr bool HASV = MODE != 0;
    const int r32 = lane & 31, hi = lane >> 5;
    const int srow = tid >> 3, sc8 = tid & 7;
    const unsigned soff = srow * 256 + sc8 * 16;
    LAS unsigned char* kst = lds + srow * KS_N + sc8 * 16;
    LAS unsigned char* vst = lds + 2 * NSA_KB + srow * VS + sc8 * 16;
    const LAS unsigned char* kl = lds + r32 * KS_N + hi * 16;
    const LAS unsigned char* vl = lds + 2 * NSA_KB + (4 * hi + ((lane & 15) >> 2)) * VS + (16 * ((lane >> 4) & 1) + 4 * (lane & 3)) * 2;
    const LAS int* ulist = (const LAS int*)(lds + N_ULIST);
    const LAS unsigned* selm = (const LAS unsigned*)(lds + N_SELM);
    LAS float* partA = (LAS float*)(lds + N_PART); LAS float* partB = (LAS float*)(lds + N_PART + N_PARTB);
    LAS float* imp = (LAS float*)(lds + N_IMP); LAS float* carry = (LAS float*)(lds + N_CARRY);
    if (ntiles <= 0) return;
    u32x4 sk0, sk1, sv0, sv1;
#define NSA_TROW(j) (MODE == 2 ? 64 * __builtin_amdgcn_readfirstlane(ulist[(j)]) : 64 * (jlo + (j)))
#define NSA_LOAD(j) do { const size_t ro_ = (size_t)NSA_TROW(j) * 256 + soff; \
        sk0 = *(const GAS u32x4*)(kbase + ro_); sk1 = *(const GAS u32x4*)(kbase + ro_ + 128); \
        if (HASV) { sv0 = *(const GAS u32x4*)(vbase + ro_); sv1 = *(const GAS u32x4*)(vbase + ro_ + 128); } } while (0)
#define NSA_STORE(b) do { LAS unsigned char* kd_ = kst + (b) * NSA_KB; *(LAS u32x4*)(kd_) = sk0; *(LAS u32x4*)(kd_ + 128) = sk1; \
        if (HASV) { LAS unsigned char* vd_ = vst + (b) * VB; *(LAS u32x4*)(vd_) = sv0; *(LAS u32x4*)(vd_ + 128) = sv1; } } while (0)
    NSA_LOAD(0); NSA_STORE(0);
    __syncthreads();
    for (int j = 0; j < ntiles; ++j) {
        const int buf = j & 1;
        if (MODE != 1 && j + 1 < ntiles) NSA_LOAD(j + 1);
        const int trow = NSA_TROW(j);
        constexpr int PSTEP = (MODE <= 1) ? 16 : 1;
        const int pstart = (MODE <= 1) ? 16 * trow + 31 : trow;
        const int db = t - pstart - PSTEP * 4 * hi;
        constexpr unsigned W = (MODE == 3) ? 512u : 0x7fffffffu;
        float b0 = -slope2 * (float)db;
        if (MODE == 2) { const int b = trow >> 6; if (((selm[r32 * 8 + (b >> 5)] >> (b & 31)) & 1u) == 0u) b0 = -__builtin_inff(); }
        f32x16 p0, p1;
#pragma unroll
        for (int r = 0; r < 16; ++r) { const int c = PSTEP * ((r & 3) + 8 * (r >> 2));
            p0[r] = __builtin_fmaf(slope2, (float)c, b0); p1[r] = __builtin_fmaf(slope2, (float)(c + 32 * PSTEP), b0); }
        qk_tile<8, KS_N, false>(p0, p1, kl + buf * NSA_KB, q);
        { const int t0u = __builtin_amdgcn_readfirstlane(t - r32);
          const bool interior = (t0u - (pstart + PSTEP * 63) >= 0) && ((unsigned)(t0u + 31 - pstart) < W);
          if (!interior) {
#pragma unroll
              for (int r = 0; r < 16; ++r) { const int c = PSTEP * ((r & 3) + 8 * (r >> 2));
                  if ((unsigned)(db - c) >= W) p0[r] = -__builtin_inff();
                  if ((unsigned)(db - c - 32 * PSTEP) >= W) p1[r] = -__builtin_inff(); } } }
        if (MODE == 0) {
            float tm = p0[0];
#pragma unroll
            for (int r = 1; r < 16; ++r) tm = fmaxf(tm, p0[r]);
#pragma unroll
            for (int r = 0; r < 16; ++r) tm = fmaxf(tm, p1[r]);
            tm = swapmax(tm);
            const float mn = fmaxf(m, tm); const float alpha = __builtin_amdgcn_exp2f(m - mn); m = mn;
            float ps = 0.f;
#pragma unroll
            for (int r = 0; r < 16; ++r) ps += __builtin_amdgcn_exp2f(p0[r] - mn) + __builtin_amdgcn_exp2f(p1[r] - mn);
            l = l * alpha + swapsum(ps);
        } else if (MODE == 1) {
#pragma unroll
            for (int r = 0; r < 16; ++r) { p0[r] = __builtin_amdgcn_exp2f(p0[r] - m) * invl; p1[r] = __builtin_amdgcn_exp2f(p1[r] - m) * invl; }
            LAS float* pa = partA + (wave * 32 + r32) * 17 + hi; LAS float* pbm = partB + (wave * 32 + r32) * 17 + hi;
#pragma unroll
            for (int rg = 0; rg < 4; ++rg) {
                pa[2 * rg] = (p0[4 * rg] + p0[4 * rg + 1]) + (p0[4 * rg + 2] + p0[4 * rg + 3]); pbm[2 * rg] = p0[4 * rg + 3];
                pa[8 + 2 * rg] = (p1[4 * rg] + p1[4 * rg + 1]) + (p1[4 * rg + 2] + p1[4 * rg + 3]); pbm[8 + 2 * rg] = p1[4 * rg + 3]; }
            const bf16x8 pb[4] = {packp<0>(p0), packp<1>(p0), packp<0>(p1), packp<1>(p1)};
            pv_tile(o, pb, vl + buf * VB);
            __syncthreads();
            { const int qq = tid >> 4, jl = tid & 15; float a = 0.f, bp = 0.f, bl = 0.f;
#pragma unroll
              for (int w = 0; w < 8; ++w) { a += partA[(w * 32 + qq) * 17 + jl]; bl += partB[(w * 32 + qq) * 17 + jl]; }
              if (jl > 0) {
#pragma unroll
                  for (int w = 0; w < 8; ++w) bp += partB[(w * 32 + qq) * 17 + jl - 1];
              } else bp = (j > 0) ? carry[((j - 1) & 1) * 32 + qq] : 0.f;
              imp[qq * 256 + 16 * j + jl] = a + bp;
              if (jl == 15) carry[(j & 1) * 32 + qq] = bl; }
        } else {
            online_sm(p0, p1, m, l, o);
            const bf16x8 pb[4] = {packp<0>(p0), packp<1>(p0), packp<0>(p1), packp<1>(p1)};
            pv_tile(o, pb, vl + buf * VB);
        }
        if (MODE == 1 && j + 1 < ntiles) NSA_LOAD(j + 1);
        if (j + 1 < ntiles) NSA_STORE(buf ^ 1);
        __syncthreads();
    }
#undef NSA_TROW
#undef NSA_LOAD
#undef NSA_STORE
}
__device__ __forceinline__ void nsa_topk(const LAS float* improw, LAS unsigned* selrow, int cur, int lane) {
    unsigned key[4]; bool sel[4];
    int nforced = 0;
#pragma unroll
    for (int k = 0; k < 4; ++k) { const int j = lane + 64 * k;
        const bool forced = (j == 0) || (j == cur) || (j == cur - 1);
        const bool causal = j <= cur;
        sel[k] = forced;
#ifdef IMPNOISE_BUILD
        { unsigned h = (unsigned)j * 2654435761u + (unsigned)(size_t)improw * 40503u; h ^= h >> 15; h *= 0x846ca68bu; h ^= h >> 16;
          const float r = (float)(int)(h & 0xffffu) * (1.f / 32768.f) - 1.f; const float v = improw[j] * (1.f + IMPNOISE_EPS * r);
          key[k] = (causal && !forced) ? (__float_as_uint(v) + 1u) : 0u; }
#else
        key[k] = (causal && !forced) ? (__float_as_uint(improw[j]) + 1u) : 0u;
#endif
    }
    nforced = 1 + (cur >= 1 ? 1 : 0) + (cur >= 2 ? 1 : 0);
    const int want = 16 - nforced;
    for (int it = 0; it < want; ++it) {
        unsigned bk = key[0]; int bj = lane;
#pragma unroll
        for (int k = 1; k < 4; ++k) { if (key[k] > bk) { bk = key[k]; bj = lane + 64 * k; } }
        unsigned long long best = ((unsigned long long)bk << 32) | (unsigned)(0xffffffffu - (unsigned)bj);
#pragma unroll
        for (int off = 1; off < 64; off <<= 1) {
            const unsigned lo = __shfl_xor((unsigned)best, off), hiw = __shfl_xor((unsigned)(best >> 32), off);
            const unsigned long long other = ((unsigned long long)hiw << 32) | lo;
            best = other > best ? other : best; }
        if ((unsigned)(best >> 32) == 0u) break;
        const int wj = (int)(0xffffffffu - (unsigned)best);
#pragma unroll
        for (int k = 0; k < 4; ++k) if (wj == lane + 64 * k) { key[k] = 0u; sel[k] = true; }
    }
#pragma unroll
    for (int k = 0; k < 4; ++k) { const unsigned long long bm = __ballot(sel[k]);
        if (lane == 0) { selrow[2 * k] = (unsigned)bm; selrow[2 * k + 1] = (unsigned)(bm >> 32); } }
}
__device__ __forceinline__ void nsa_topk4(const LAS float* imp0, LAS unsigned* sel0, int cur, int lane) {
    unsigned key[4][4]; bool forced[4];
#pragma unroll
    for (int k = 0; k < 4; ++k) { const int j = lane + 64 * k;
        forced[k] = (j == 0) || (j == cur) || (j == cur - 1);
        const bool cand = (j <= cur) && !forced[k];
#pragma unroll
        for (int i = 0; i < 4; ++i) key[i][k] = cand ? (__float_as_uint(imp0[i * 256 + j]) + 1u) : 0u; }
    const int want = 16 - (1 + (cur >= 1 ? 1 : 0) + (cur >= 2 ? 1 : 0));
    unsigned T[4] = {0u, 0u, 0u, 0u};
    for (int bit = 30; bit >= 0; --bit) {
#pragma unroll
        for (int i = 0; i < 4; ++i) { const unsigned c = T[i] | (1u << bit);
            const int n = __builtin_popcountll(__ballot(key[i][0] >= c)) + __builtin_popcountll(__ballot(key[i][1] >= c)) + __builtin_popcountll(__ballot(key[i][2] >= c)) + __builtin_popcountll(__ballot(key[i][3] >= c));
            if (n >= want) T[i] = c; }
    }
#pragma unroll
    for (int i = 0; i < 4; ++i) {
        const unsigned Ti = T[i];
        int rem = want;
        if (Ti != 0u) rem -= __builtin_popcountll(__ballot(key[i][0] > Ti)) + __builtin_popcountll(__ballot(key[i][1] > Ti)) + __builtin_popcountll(__ballot(key[i][2] > Ti)) + __builtin_popcountll(__ballot(key[i][3] > Ti));
#pragma unroll
        for (int k = 0; k < 4; ++k) {
            bool s = forced[k];
            if (Ti == 0u) s = s || key[i][k] >= 1u;
            else {
                const bool eq = key[i][k] == Ti; const unsigned long long em = __ballot(eq);
                const int below = (int)__builtin_amdgcn_mbcnt_hi((unsigned)(em >> 32), __builtin_amdgcn_mbcnt_lo((unsigned)em, 0u));
                s = s || key[i][k] > Ti || (eq && below < rem);
                rem -= __builtin_popcountll(em); if (rem < 0) rem = 0;
            }
            const unsigned long long bm = __ballot(s);
            if (lane == 0) { sel0[i * 8 + 2 * k] = (unsigned)bm; sel0[i * 8 + 2 * k + 1] = (unsigned)(bm >> 32); }
        }
    }
}
__device__ __forceinline__ int nsa_opaque(int v) { asm volatile("" : "+v"(v)); return v; }
__device__ __forceinline__ void nsa_unit(LAS unsigned char* lds, const NsaPtrs& P, int g, int qblk, int tid_in, int wave, int lane_in, int cu) {
    int tid = tid_in; asm volatile("" : "+v"(tid));
    const int lane = tid & 63; (void)lane_in;
    const int r32 = lane & 31, hi = lane >> 5;
    const int hh = 8 * g + wave, t0 = 32 * qblk, t = t0 + r32;
    const float slope2 = __builtin_amdgcn_exp2f(-0.5f * (float)(hh + 1)) * LOG2E;
    bf16x8 q[8];
    { const bf16* qp = P.Q + (size_t)t * 2048 + hh * 128 + hi * 8;
#pragma unroll
      for (int d0 = 0; d0 < 8; ++d0) q[d0] = *(const GAS bf16x8*)(qp + d0 * 16); }
#define NSA_SCR() ((GAS f32x4*)(P.scr + ((size_t)(cu * 8 + wave) * 16) * 256) + nsa_opaque(lane))
    const size_t CH = (size_t)S * 128 * 2;
    f32x16 o[4]; float m, l;
#define NSA_ZERO_O() do { _Pragma("unroll") for (int d_ = 0; d_ < 4; ++d_) _Pragma("unroll") for (int r_ = 0; r_ < 16; ++r_) o[d_][r_] = 0.f; } while (0)
    const int ncv = 2 * qblk + 1, ntc = (ncv + 63) >> 6;
    const unsigned char* kc = (const unsigned char*)P.KC + (size_t)g * 1024 * 256; const unsigned char* vc = (const unsigned char*)P.VC + (size_t)g * 1024 * 256;
    m = -1e30f; l = 0.f; NSA_ZERO_O();
    nsa_loop<0>(lds, kc, vc, ntc, 0, q, t, slope2, m, l, o, 0.f, tid, wave, lane);
    const float invl = l > 0.f ? 1.f / l : 0.f;
    nsa_loop<1>(lds, kc, vc, ntc, 0, q, t, slope2, m, l, o, invl, tid, wave, lane);
    { const float g_c = P.G[(size_t)t * 48 + hh]; GAS f32x4* scr = NSA_SCR();
#pragma unroll
    for (int d0 = 0; d0 < 4; ++d0)
#pragma unroll
        for (int rg = 0; rg < 4; ++rg) { f32x4 v = {o[d0][4 * rg] * g_c, o[d0][4 * rg + 1] * g_c, o[d0][4 * rg + 2] * g_c, o[d0][4 * rg + 3] * g_c}; scr[(d0 * 4 + rg) * 64] = v; } }
    const int cur = t0 >> 6;
    LAS unsigned* selm = (LAS unsigned*)(lds + N_SELM);
#ifdef NSA_TOPK_ITER
    for (int i = 0; i < 4; ++i) { const int qq = 4 * wave + i; nsa_topk((const LAS float*)(lds + N_IMP) + qq * 256, selm + qq * 8, cur, lane); }
#else
    nsa_topk4((const LAS float*)(lds + N_IMP) + 4 * wave * 256, selm + 4 * wave * 8, cur, lane);
#endif
    __syncthreads();
    if (wave == 0) {
        LAS int* ulist = (LAS int*)(lds + N_ULIST); int n = 0;
        for (int k = 0; k < 8; ++k) { unsigned u = (lane < 32) ? selm[lane * 8 + k] : 0u;
#pragma unroll
            for (int off = 1; off < 32; off <<= 1) u |= __shfl_xor(u, off);
            u = __builtin_amdgcn_readfirstlane(u);
            while (u) { const int b = __builtin_ctz(u); u &= u - 1u; if (lane == 0) ulist[n] = 32 * k + b; ++n; } }
        if (lane == 0) *(LAS int*)(lds + N_NTS) = n;
    }
    __syncthreads();
    const int nts = __builtin_amdgcn_readfirstlane(*(const LAS int*)(lds + N_NTS));
    m = -1e30f; l = 0.f; NSA_ZERO_O();
    nsa_loop<2>(lds, (const unsigned char*)P.KV + (size_t)(4 + g) * CH, (const unsigned char*)P.KV + (size_t)(6 + g) * CH, nts, 0, q, t, slope2, m, l, o, 0.f, tid, wave, lane);
    { const float f = P.G[(size_t)t * 48 + 16 + hh] / l; GAS f32x4* scr = NSA_SCR();
#pragma unroll
      for (int d0 = 0; d0 < 4; ++d0)
          { f32x4 v[4];
#pragma unroll
            for (int rg = 0; rg < 4; ++rg) v[rg] = scr[(d0 * 4 + rg) * 64];
#pragma unroll
            for (int rg = 0; rg < 4; ++rg) { v[rg][0] += o[d0][4 * rg] * f; v[rg][1] += o[d0][4 * rg + 1] * f; v[rg][2] += o[d0][4 * rg + 2] * f; v[rg][3] += o[d0][4 * rg + 3] * f; scr[(d0 * 4 + rg) * 64] = v[rg]; } } }
    const int jlo = (t0 > 511 ? t0 - 511 : 0) >> 6, jhi = (t0 + 31) >> 6;
    m = -1e30f; l = 0.f; NSA_ZERO_O();
    nsa_loop<3>(lds, (const unsigned char*)P.KV + (size_t)(8 + g) * CH, (const unsigned char*)P.KV + (size_t)(10 + g) * CH, jhi - jlo + 1, jlo, q, t, slope2, m, l, o, 0.f, tid, wave, lane);
    { const float f = P.G[(size_t)t * 48 + 32 + hh] / l; GAS f32x4* scr = NSA_SCR();
      const bf16* zp = P.Z + (size_t)t * 2048 + hh * 128 + 4 * hi;
      bf16* op = P.O + (size_t)t * 4096 + 2048 + hh * 128 + 4 * hi;
#pragma unroll
      for (int d0 = 0; d0 < 4; ++d0)
          { f32x4 av[4]; u32x2 zv[4];
#pragma unroll
            for (int rg = 0; rg < 4; ++rg) { av[rg] = scr[(d0 * 4 + rg) * 64]; zv[rg] = *(const GAS u32x2*)(zp + 32 * d0 + 8 * rg); }
#pragma unroll
          for (int rg = 0; rg < 4; ++rg) { const int dim = 32 * d0 + 8 * rg; const f32x4 a = av[rg];
              const u32x2 z = zv[rg];
              u32x2 w; w.x = pk2((a[0] + o[d0][4 * rg] * f) * bflo(z.x), (a[1] + o[d0][4 * rg + 1] * f) * bfhi(z.x)); w.y = pk2((a[2] + o[d0][4 * rg + 2] * f) * bflo(z.y), (a[3] + o[d0][4 * rg + 3] * f) * bfhi(z.y));
              *(GAS u32x2*)(op + dim) = w; } } }
#undef NSA_ZERO_O
#undef NSA_SCR
}
struct CmpPtrs { const bf16* KV; const bf16* W1; const bf16* W2; const float* cbp; bf16* KC; bf16* VC; };
__device__ __forceinline__ void cmp_unit(LAS unsigned char* lds, const CmpPtrs& P, int kv, int g, int tile, int tid, int wave, int lane) {
    const int fr = lane & 15, fq = lane >> 4;
    constexpr int CRS = 544;
    LAS unsigned char* As = lds + 16384;
    LAS unsigned char* Ws = As + 16 * CRS;
    const unsigned char* Ag = (const unsigned char*)(P.KV + (size_t)(kv * 2 + g) * ((size_t)S * 128) + (size_t)(16 * tile + (tid >> 5)) * 2048) + (tid & 31) * 16;
    const unsigned char* Wg = (const unsigned char*)(P.W1 + (size_t)kv * 128 * 4096 + (size_t)(tid >> 5) * 4096) + (tid & 31) * 16;
    LAS unsigned char* Ad = As + (tid >> 5) * CRS + (tid & 31) * 16;
    LAS unsigned char* Wd = Ws + (tid >> 5) * CRS + (tid & 31) * 16;
    const LAS unsigned char* Ar = As + fr * CRS + fq * 16;
    const LAS unsigned char* Wr = Ws + (16 * wave + fr) * CRS + fq * 16;
    u32x4 ra, rw[8];
#define CMP_LOAD(c) do { ra = *(const GAS u32x4*)(Ag + (c) * 512); _Pragma("unroll") for (int i_ = 0; i_ < 8; ++i_) rw[i_] = *(const GAS u32x4*)(Wg + (size_t)i_ * (16 * 8192) + (c) * 512); } while (0)
    CMP_LOAD(0);
    f32x4 acc = {0.f, 0.f, 0.f, 0.f};
    for (int c = 0; c < 16; ++c) {
        *(LAS u32x4*)Ad = ra;
#pragma unroll
        for (int i = 0; i < 8; ++i) *(LAS u32x4*)(Wd + i * 16 * CRS) = rw[i];
        __syncthreads();
        if (c + 1 < 16) CMP_LOAD(c + 1);
#pragma unroll
        for (int s = 0; s < 8; ++s) {
            const bf16x8 a = *(const LAS bf16x8*)(Ar + 64 * s), b = *(const LAS bf16x8*)(Wr + 64 * s);
            acc = __builtin_amdgcn_mfma_f32_16x16x32_bf16(a, b, acc, 0, 0, 0);
        }
        __syncthreads();
    }
#undef CMP_LOAD
    float bias = 0.f;
    { float bv[16];
#pragma unroll
      for (int c = 0; c < 16; ++c) bv[c] = *(const GAS float*)(P.cbp + (size_t)(kv * 16 + c) * 128 + 16 * wave + fr);
#pragma unroll
      for (int c = 0; c < 16; ++c) bias += bv[c]; }
    LAS bf16* hid = (LAS bf16*)lds;
#pragma unroll
    for (int i = 0; i < 4; ++i) hid[(4 * fq + i) * 136 + 16 * wave + fr] = (bf16)(pk2(silu_f(acc[i] + bias), 0.f) & 0xffffu);
    __syncthreads();
    const bf16* B2 = P.W2 + (size_t)kv * 128 * 128 + (size_t)(16 * wave + fr) * 128 + 8 * fq;
    f32x4 acc2 = {0.f, 0.f, 0.f, 0.f};
#pragma unroll
    for (int s = 0; s < 4; ++s) {
        const bf16x8 a = *(const LAS bf16x8*)(hid + fr * 136 + 32 * s + 8 * fq), b = *(const GAS bf16x8*)(B2 + 32 * s);
        acc2 = __builtin_amdgcn_mfma_f32_16x16x32_bf16(a, b, acc2, 0, 0, 0);
    }
    bf16* out = (kv ? P.VC : P.KC) + (size_t)g * 1024 * 128;
#pragma unroll
    for (int i = 0; i < 4; ++i) { const int nn = 16 * tile + 4 * fq + i; out[(size_t)nn * 128 + 16 * wave + fr] = (nn < 1023) ? (bf16)(pk2(acc2[i], 0.f) & 0xffffu) : (bf16)0; }
    __syncthreads();
}
}
#ifdef CHK_BUILD
namespace chk {
constexpr size_t WS_CHK = 14 * MiB;
__device__ __forceinline__ float bf2f(bf16 v) { return __uint_as_float((unsigned)v << 16); }
__device__ __forceinline__ float e4m3(unsigned char b) {
    const int e = (b >> 3) & 15, mm = b & 7; const float v = e == 0 ? (float)mm * (1.f / 512.f) : (1.f + (float)mm * 0.125f) * exp2f((float)(e - 7)); return (b & 0x80) ? -v : v; }
__device__ __forceinline__ int sample_t(int i) { return i * 64 + (i * 29) % 64; }
__device__ __noinline__ void nsa_check(LAS unsigned char* lds, unsigned char* ws, int t, int g, LAS float* acc2) {
    int tid_ = threadIdx.x; asm volatile("" : "+v"(tid_)); const int tid = tid_, lane = tid & 63, wave = tid >> 6;
    const int hh = 8 * g + wave, cur = t >> 6;
    const bf16* QN = (const bf16*)(ws + WS_QNSA); const bf16* KV = (const bf16*)(ws + WS_KVNSA); const bf16* KC = (const bf16*)(ws + WS_KCMP) + (size_t)g * 1024 * 128; const bf16* VC = (const bf16*)(ws + WS_VCMP) + (size_t)g * 1024 * 128;
    const bf16* ZN = (const bf16*)(ws + WS_ZNSA); const float* GN = (const float*)(ws + WS_GNSA); const bf16* HO = (const bf16*)(ws + WS_H);
    const size_t CH = (size_t)S * 128;
    LAS float* pc = (LAS float*)lds;
    LAS float* impv = (LAS float*)(lds + 32768);
    LAS int* sel = (LAS int*)(lds + 32768 + 1024);
    const float slope2 = exp2f(-0.5f * (float)(hh + 1)) * LOG2E;
    const float q0 = bf2f(QN[(size_t)t * 2048 + hh * 128 + 2 * lane]), q1 = bf2f(QN[(size_t)t * 2048 + hh * 128 + 2 * lane + 1]);
    float oc0 = 0.f, oc1 = 0.f, os0 = 0.f, os1 = 0.f, ow0 = 0.f, ow1 = 0.f;
    const int ncv = (t >= 31) ? (t - 31) / 16 + 1 : 0;
    for (int n = lane; n < 1024; n += 64) pc[wave * 1024 + n] = 0.f;
    float mx = -1e30f;
    for (int n = 0; n < ncv; ++n) { float s = q0 * bf2f(KC[(size_t)n * 128 + 2 * lane]) + q1 * bf2f(KC[(size_t)n * 128 + 2 * lane + 1]); s = wave_sum(s) - slope2 * (float)(t - 16 * n - 31);
        if (lane == 0) pc[wave * 1024 + n] = s; mx = fmaxf(mx, s); }
    __syncthreads();
    float sum = 0.f;
    for (int n = 0; n < ncv; ++n) sum += exp2f(pc[wave * 1024 + n] - mx);
    __syncthreads();
    for (int n = lane; n < 1024; n += 64) pc[wave * 1024 + n] = (n < ncv) ? exp2f(pc[wave * 1024 + n] - mx) / sum : 0.f;
    __syncthreads();
    for (int n = 0; n < ncv; ++n) { const float p = pc[wave * 1024 + n]; oc0 += p * bf2f(VC[(size_t)n * 128 + 2 * lane]); oc1 += p * bf2f(VC[(size_t)n * 128 + 2 * lane + 1]); }
    if (tid < 256) { const int j = tid; float v = -1e30f;
        if (64 * j <= t) { float a = 0.f; for (int ii = 4 * j - 1; ii <= 4 * j + 3; ++ii) if (ii >= 0 && ii <= 1022) { float ps = 0.f; for (int h = 0; h < 8; ++h) ps += pc[h * 1024 + ii]; a += ps; }
            const bool forced = (j == 0) || (j == cur) || (j == cur - 1); v = a + (forced ? 1e4f : 0.f); }
        impv[j] = v; }
    __syncthreads();
    if (tid < 256) { const int j = tid; const float v = impv[j]; int rank = 0; for (int ii = 0; ii < 256; ++ii) { const float u = impv[ii]; rank += (u > v || (u == v && ii < j)) ? 1 : 0; } sel[j] = rank < 16 ? 1 : 0; }
    __syncthreads();
    const bf16* KS = KV + (size_t)(4 + g) * CH; const bf16* VSl = KV + (size_t)(6 + g) * CH;
    mx = -1e30f;
    for (int j = 0; j < 256; ++j) if (sel[j]) for (int tok = 64 * j; tok < 64 * j + 64 && tok <= t; ++tok) {
        float s = q0 * bf2f(KS[(size_t)tok * 128 + 2 * lane]) + q1 * bf2f(KS[(size_t)tok * 128 + 2 * lane + 1]); s = wave_sum(s) - slope2 * (float)(t - tok); mx = fmaxf(mx, s); }
    sum = 0.f;
    for (int j = 0; j < 256; ++j) if (sel[j]) for (int tok = 64 * j; tok < 64 * j + 64 && tok <= t; ++tok) {
        float s = q0 * bf2f(KS[(size_t)tok * 128 + 2 * lane]) + q1 * bf2f(KS[(size_t)tok * 128 + 2 * lane + 1]); s = wave_sum(s) - slope2 * (float)(t - tok);
        const float p = exp2f(s - mx); sum += p; os0 += p * bf2f(VSl[(size_t)tok * 128 + 2 * lane]); os1 += p * bf2f(VSl[(size_t)tok * 128 + 2 * lane + 1]); }
    os0 /= sum; os1 /= sum;
    const bf16* KW = KV + (size_t)(8 + g) * CH; const bf16* VW = KV + (size_t)(10 + g) * CH;
    const int lo = t - 511 > 0 ? t - 511 : 0;
    mx = -1e30f;
    for (int tok = lo; tok <= t; ++tok) { float s = q0 * bf2f(KW[(size_t)tok * 128 + 2 * lane]) + q1 * bf2f(KW[(size_t)tok * 128 + 2 * lane + 1]); s = wave_sum(s) - slope2 * (float)(t - tok); mx = fmaxf(mx, s); }
    sum = 0.f;
    for (int tok = lo; tok <= t; ++tok) { float s = q0 * bf2f(KW[(size_t)tok * 128 + 2 * lane]) + q1 * bf2f(KW[(size_t)tok * 128 + 2 * lane + 1]); s = wave_sum(s) - slope2 * (float)(t - tok);
        const float p = exp2f(s - mx); sum += p; ow0 += p * bf2f(VW[(size_t)tok * 128 + 2 * lane]); ow1 += p * bf2f(VW[(size_t)tok * 128 + 2 * lane + 1]); }
    ow0 /= sum; ow1 /= sum;
    const float gc = GN[(size_t)t * 48 + hh], gs = GN[(size_t)t * 48 + 16 + hh], gwv = GN[(size_t)t * 48 + 32 + hh];
    const float r0 = (gc * oc0 + gs * os0 + gwv * ow0) * bf2f(ZN[(size_t)t * 2048 + hh * 128 + 2 * lane]), r1 = (gc * oc1 + gs * os1 + gwv * ow1) * bf2f(ZN[(size_t)t * 2048 + hh * 128 + 2 * lane + 1]);
    const float f0 = bf2f(HO[(size_t)t * 4096 + 2048 + hh * 128 + 2 * lane]), f1 = bf2f(HO[(size_t)t * 4096 + 2048 + hh * 128 + 2 * lane + 1]);
    const float e2 = wave_sum((r0 - f0) * (r0 - f0) + (r1 - f1) * (r1 - f1)), n2 = wave_sum(r0 * r0 + r1 * r1);
    __syncthreads();
    if (lane == 0) { pc[wave] = e2; pc[8 + wave] = n2; }
    __syncthreads();
    if (tid == 0) { float a = 0.f, b = 0.f; for (int w = 0; w < 8; ++w) { a += pc[w]; b += pc[8 + w]; } acc2[0] += a; acc2[1] += b; }
    __syncthreads();
}
__device__ __forceinline__ void mla_check(LAS unsigned char* lds, unsigned char* ws, int t, LAS float* acc2) {
    int tid_ = threadIdx.x; asm volatile("" : "+v"(tid_)); const int tid = tid_, lane = tid & 63, wave = tid >> 6;
    const bf16* ZM = (const bf16*)(ws + WS_ZMLA); const bf16* HO = (const bf16*)(ws + WS_H);
    LAS float* qs = (LAS float*)lds + wave * 192;
    LAS float* red = (LAS float*)lds + 8 * 192;
    float ae = 0.f, an = 0.f;
    for (int rep = 0; rep < 2; ++rep) { const int head = wave + 8 * rep;
#ifdef MLA_FP8
        { const unsigned char* qp = (const unsigned char*)(ws + WS_QMLA) + (size_t)t * 3072 + head * 192; for (int d = lane; d < 192; d += 64) qs[d] = e4m3(qp[d]) * QS_MLA; }
#else
        { const bf16* qp = (const bf16*)(ws + WS_QMLA) + (size_t)t * 3072 + head * 192; for (int d = lane; d < 192; d += 64) qs[d] = bf2f(qp[d]); }
#endif
        __syncthreads();
        float mx = -1e30f;
        for (int c = 0; 64 * c <= t; ++c) {
#ifdef MLA_MX
            const int tok = 64 * c + 8 * ((lane >> 2) & 7) + 4 * (lane >> 5) + (lane & 3);
#else
            const int x_ = lane & 15; const int tok = 64 * c + (lane & 48) + (x_ < 4 ? x_ : (x_ < 8 ? x_ + 4 : (x_ < 12 ? x_ - 4 : x_)));
#endif

            float s = 0.f;
#ifdef MLA_FP8
            const unsigned char* kp = (const unsigned char*)(ws + WS_KMLA) + (size_t)tok * 3072 + head * 192; for (int d = 0; d < 192; ++d) s += qs[d] * e4m3(kp[d]);
#else
            const bf16* kp = (const bf16*)(ws + WS_KMLA) + (size_t)tok * 3072 + head * 192; for (int d = 0; d < 192; ++d) s += qs[d] * bf2f(kp[d]);
#endif
            if (tok <= t) mx = fmaxf(mx, s); }
        for (int off = 1; off < 64; off <<= 1) mx = fmaxf(mx, __shfl_xor(mx, off));
        float e2 = 0.f, n2 = 0.f;
        for (int dc = 0; dc < 8; ++dc) {
        float sum = 0.f; float o[16];
#pragma unroll
        for (int d = 0; d < 16; ++d) o[d] = 0.f;
        for (int c = 0; 64 * c <= t; ++c) {
#ifdef MLA_MX
            const int tok = 64 * c + 8 * ((lane >> 2) & 7) + 4 * (lane >> 5) + (lane & 3);
#else
            const int x_ = lane & 15; const int tok = 64 * c + (lane & 48) + (x_ < 4 ? x_ : (x_ < 8 ? x_ + 4 : (x_ < 12 ? x_ - 4 : x_)));
#endif

            float s = 0.f;
#ifdef MLA_FP8
            const unsigned char* kp = (const unsigned char*)(ws + WS_KMLA) + (size_t)tok * 3072 + head * 192; for (int d = 0; d < 192; ++d) s += qs[d] * e4m3(kp[d]);
#else
            const bf16* kp = (const bf16*)(ws + WS_KMLA) + (size_t)tok * 3072 + head * 192; for (int d = 0; d < 192; ++d) s += qs[d] * bf2f(kp[d]);
#endif
            const float p = (tok <= t) ? exp2f(s - mx) : 0.f; sum += p;
#ifdef MLA_FP8V
            const unsigned char* vt = (const unsigned char*)(ws + WS_VMLA) + ((size_t)head * 128 + 16 * dc) * S + 64 * c + lane;
#pragma unroll
            for (int d = 0; d < 16; ++d) o[d] += p * e4m3(vt[(size_t)d * S]);
#else
            const bf16* vp = (const bf16*)(ws + WS_VMLA) + (size_t)tok * 2048 + head * 128 + 16 * dc;
#pragma unroll
            for (int d = 0; d < 16; ++d) o[d] += p * bf2f(vp[d]);
#endif
        }
        sum = wave_sum(sum);
#pragma unroll
        for (int d = 0; d < 16; ++d) { const float od = wave_sum(o[d]) / sum; const float r = od * bf2f(ZM[(size_t)t * 2048 + head * 128 + 16 * dc + d]), f = bf2f(HO[(size_t)t * 4096 + head * 128 + 16 * dc + d]); e2 += (r - f) * (r - f); n2 += r * r; }
        }
        ae += e2; an += n2;
        __syncthreads(); }
    if (lane == 0) { red[wave] = ae; red[8 + wave] = an; }
    __syncthreads();
    if (tid == 0) { float a = 0.f, b = 0.f; for (int w = 0; w < 8; ++w) { a += red[w]; b += red[8 + w]; } acc2[0] += a; acc2[1] += b; }
    __syncthreads();
}
}
#endif
#ifdef CHK2_BUILD
namespace chk2 {
constexpr size_t WS_CHK = 14 * MiB;
__device__ __forceinline__ float bf2f(bf16 v) { return __uint_as_float((unsigned)v << 16); }
__device__ __forceinline__ int sample_t(int i) { return i * 256 + (i * 29) % 256; }
__device__ __noinline__ void proj_check(LAS unsigned char* lds, unsigned char* ws, const float* x, const float* w_in_l, int l, int i, int qd, LAS float* acc2) {
    int tid_ = threadIdx.x; asm volatile("" : "+v"(tid_)); const int tid = tid_;
    const int t = sample_t(i);
    LAS float* h = (LAS float*)lds;
    LAS float* red = h + 4096;
    const float* mod = (const float*)(ws + WS_MOD) + (size_t)l * 3 * D;
    const float* xin = (l == 0) ? x : (const float*)(ws + WS_XV);
    for (int k = tid; k < D; k += NTHR) h[k] = xin[(size_t)t * D + k] * (1.f + mod[D + k]) + mod[k];
    __syncthreads();
    float e2 = 0.f, r2 = 0.f;
    const float* cosT = (const float*)(ws + WS_ROPE); const float* sinT = cosT + (size_t)S * 32;
    for (int n = qd * 2268 + tid; n < (qd + 1) * 2268; n += NTHR) {
        float a = 0.f;
        for (int k = 0; k < D; ++k) a += h[k] * w_in_l[(size_t)k * INC + n];
        float ref = a, got;
        if (n < 768) got = bf2f(((const bf16*)(ws + WS_QLAT))[(size_t)t * 768 + n]);
        else if (n < 1280) got = bf2f(((const bf16*)(ws + WS_KVLAT))[(size_t)t * 512 + n - 768]);
        else if (n < 1344) {
            const int ii = n - 1280, pi = ii & 31; const int np = 1280 + (ii < 32 ? ii + 32 : ii - 32); float b = 0.f;
            for (int k = 0; k < D; ++k) b += h[k] * w_in_l[(size_t)k * INC + np];
            const float c = cosT[(size_t)t * 32 + pi], s = sinT[(size_t)t * 32 + pi];
            ref = ii < 32 ? a * c - b * s : a * c + b * s;
            got = bf2f(((const bf16*)(ws + WS_KMLA))[(size_t)t * 3072 + 5 * 192 + 128 + 2 * pi + (ii >> 5)]);
        }
        else if (n < 3392) { ref = a / (1.f + expf(-a)); got = bf2f(((const bf16*)(ws + WS_ZMLA))[(size_t)t * 2048 + n - 1344]); }
        else if (n < 5440) { ref = a * QS_NSA; got = bf2f(((const bf16*)(ws + WS_QNSA))[(size_t)t * 2048 + n - 3392]); }
        else if (n < 6976) { const int c = n - 5440; got = bf2f(((const bf16*)(ws + WS_KVNSA))[(size_t)(c >> 7) * ((size_t)S * 128) + (size_t)t * 128 + (c & 127)]); }
        else if (n < 7024) { ref = 1.f / (1.f + expf(-a)); got = ((const float*)(ws + WS_GNSA))[(size_t)t * 48 + n - 6976]; }
        else { ref = a / (1.f + expf(-a)); got = bf2f(((const bf16*)(ws + WS_ZNSA))[(size_t)t * 2048 + n - 7024]); }
        e2 += (ref - got) * (ref - got); r2 += ref * ref;
    }
    red[tid] = e2; red[512 + tid] = r2;
    __syncthreads();
    if (tid == 0) { float a = 0.f, b = 0.f; for (int k = 0; k < 512; ++k) { a += red[k]; b += red[512 + k]; } acc2[0] += a; acc2[1] += b; }
    __syncthreads();
}
__device__ __noinline__ void cmp_check(LAS unsigned char* lds, unsigned char* ws, const float* cmp_pos_l, const float* w1_l, const float* w2_l, int i, LAS float* acc2) {
    int tid_ = threadIdx.x; asm volatile("" : "+v"(tid_)); const int tid = tid_;
    const int n = (4 * i + (i & 3)) % 1023, kv = i & 1, g = (i >> 1) & 1;
    LAS float* blk = (LAS float*)lds;
    LAS float* hid = blk + 4096;
    LAS float* red = hid + 128;
    const bf16* A = (const bf16*)(ws + WS_KVNSA) + (size_t)(kv * 2 + g) * ((size_t)S * 128) + (size_t)n * 2048;
    for (int k = tid; k < 4096; k += NTHR) blk[k] = bf2f(A[k]) + cmp_pos_l[(size_t)kv * 4096 + k];
    __syncthreads();
    if (tid < 128) { float a = 0.f; const float* W = w1_l + (size_t)kv * 4096 * 128 + tid; for (int k = 0; k < 4096; ++k) a += blk[k] * W[(size_t)k * 128]; hid[tid] = a / (1.f + expf(-a)); }
    __syncthreads();
    float e2 = 0.f, r2 = 0.f;
    if (tid < 128) { float a = 0.f; const float* W = w2_l + (size_t)kv * 128 * 128 + tid; for (int k = 0; k < 128; ++k) a += hid[k] * W[(size_t)k * 128];
        const float got = bf2f(((const bf16*)(ws + (kv ? WS_VCMP : WS_KCMP)))[(size_t)g * 1024 * 128 + (size_t)n * 128 + tid]); e2 = (a - got) * (a - got); r2 = a * a; }
    if (tid < 128) { red[tid] = e2; red[128 + tid] = r2; }
    __syncthreads();
    if (tid == 0) { float a = 0.f, b = 0.f; for (int k = 0; k < 128; ++k) { a += red[k]; b += red[128 + k]; } acc2[0] += a; acc2[1] += b; }
    __syncthreads();
}
}
#endif
#ifdef CHK3_BUILD
namespace chk3 {
constexpr size_t WS_CHK = 14 * MiB;
__device__ __forceinline__ float bf2f(bf16 v) { return __uint_as_float((unsigned)v << 16); }
__device__ __forceinline__ float e4m3(unsigned char b) { const int e = (b >> 3) & 15, mm = b & 7; const float v = e == 0 ? (float)mm * (1.f / 512.f) : (1.f + (float)mm * 0.125f) * exp2f((float)(e - 7)); return (b & 0x80) ? -v : v; }
__device__ __forceinline__ int sample_t(int i) { return i * 64 + (i * 29) % 64; }
__device__ __noinline__ void up_check(LAS unsigned char* lds, unsigned char* ws, const float* qn, const float* wq, const float* kn, const float* wkv, int i, LAS float* acc2) {
    int tid_ = threadIdx.x; asm volatile("" : "+v"(tid_)); const int tid = tid_;
    const int t = sample_t(i);
    LAS float* ql = (LAS float*)lds;
    LAS float* kl = ql + 768;
    LAS float* qo = kl + 512;
    LAS float* red = qo + 3072;
    const bf16* QL = (const bf16*)(ws + WS_QLAT) + (size_t)t * 768; const bf16* KL = (const bf16*)(ws + WS_KVLAT) + (size_t)t * 512;
    float s = 0.f; for (int k = tid; k < 768; k += NTHR) { const float v = bf2f(QL[k]); s += v * v; }
    red[tid] = s; __syncthreads();
    float tot = 0.f; for (int k = 0; k < 512; ++k) tot += red[k];
    const float rq = 1.f / sqrtf(tot / 768.f + RMS_EPS);
    __syncthreads();
    s = 0.f; for (int k = tid; k < 512; k += NTHR) { const float v = bf2f(KL[k]); s += v * v; }
    red[tid] = s; __syncthreads();
    tot = 0.f; for (int k = 0; k < 512; ++k) tot += red[k];
    const float rk = 1.f / sqrtf(tot / 512.f + RMS_EPS);
    __syncthreads();
    for (int k = tid; k < 768; k += NTHR) ql[k] = bf2f(QL[k]) * rq * qn[k];
    for (int k = tid; k < 512; k += NTHR) kl[k] = bf2f(KL[k]) * rk * kn[k];
    __syncthreads();
    for (int n = tid; n < 3072; n += NTHR) { float a = 0.f; for (int k = 0; k < 768; ++k) a += ql[k] * wq[(size_t)k * 3072 + n]; qo[n] = a; }
    __syncthreads();
    float e2 = 0.f, r2 = 0.f;
    const float* cosT = (const float*)(ws + WS_ROPE); const float* sinT = cosT + (size_t)S * 32;
    const bf16* QM = (const bf16*)(ws + WS_QMLA) + (size_t)t * 3072;
    for (int n = tid; n < 3072; n += NTHR) { const int h = n / 192, d = n % 192; float ref, got;
#ifdef MLA_FP8
        const unsigned char* Q8 = (const unsigned char*)(ws + WS_QMLA) + (size_t)t * 3072;
        if (d < 128) { ref = qo[n]; got = e4m3(Q8[h * 192 + d]); }
        else { const int ii = d - 128, pi = ii & 31; const float x1 = qo[h * 192 + 128 + pi], x2 = qo[h * 192 + 160 + pi]; const float c = cosT[(size_t)t * 32 + pi], sn = sinT[(size_t)t * 32 + pi];
            ref = (ii < 32 ? x1 * c - x2 * sn : x2 * c + x1 * sn); got = e4m3(Q8[h * 192 + 128 + 2 * pi + (ii >> 5)]); }
        if (false) {}
#else
        if (d < 128) { ref = qo[n] * QS_MLA; got = bf2f(QM[h * 192 + d]); }
        else { const int ii = d - 128, pi = ii & 31; const float x1 = qo[h * 192 + 128 + pi], x2 = qo[h * 192 + 160 + pi]; const float c = cosT[(size_t)t * 32 + pi], sn = sinT[(size_t)t * 32 + pi];
            ref = (ii < 32 ? x1 * c - x2 * sn : x2 * c + x1 * sn) * QS_MLA; got = bf2f(QM[h * 192 + 128 + 2 * pi + (ii >> 5)]); }
#endif
        e2 += (ref - got) * (ref - got); r2 += ref * ref; }
    const bf16* KM = (const bf16*)(ws + WS_KMLA) + (size_t)t * 3072; const bf16* VM = (const bf16*)(ws + WS_VMLA) + (size_t)t * 2048;
    for (int n = tid; n < 4096; n += NTHR) { float a = 0.f; for (int k = 0; k < 512; ++k) a += kl[k] * wkv[(size_t)k * 4096 + n];
#ifdef MLA_FP8
        const int h = n >> 8, d = n & 255; const float got = d < 128 ? e4m3(((const unsigned char*)(ws + WS_KMLA) + (size_t)t * 3072)[h * 192 + d]) : bf2f(VM[h * 128 + d - 128]);
#else
        const int h = n >> 8, d = n & 255; const float got = d < 128 ? bf2f(KM[h * 192 + d]) : bf2f(VM[h * 128 + d - 128]);
#endif
        e2 += (a - got) * (a - got); r2 += a * a; }
    red[tid] = e2; red[512 + tid] = r2;
    __syncthreads();
    if (tid == 0) { float a = 0.f, b = 0.f; for (int k = 0; k < 512; ++k) { a += red[k]; b += red[512 + k]; } acc2[0] += a; acc2[1] += b; }
    __syncthreads();
}
__device__ __noinline__ void out_check(LAS unsigned char* lds, unsigned char* ws, const float* xin, const float* xv, const float* wout, const float* gate, int i, int qd, LAS float* acc2) {
    int tid_ = threadIdx.x; asm volatile("" : "+v"(tid_)); const int tid = tid_;
    const int t = i * 256 + (i * 29) % 256;
    LAS float* o = (LAS float*)lds;
    LAS float* red = o + 4096;
    const bf16* OA = (const bf16*)(ws + WS_H) + (size_t)t * 4096;
    for (int k = tid; k < 4096; k += NTHR) o[k] = bf2f(OA[k]);
    __syncthreads();
    float e2 = 0.f, r2 = 0.f;
    for (int n = qd * 1024 + tid; n < (qd + 1) * 1024; n += NTHR) { float a = 0.f; for (int k = 0; k < 4096; ++k) a += o[k] * wout[(size_t)k * 4096 + n];
        const float gy = gate[n] * a, ref = DN_ALPHA * xin[(size_t)t * D + n] + gy, got = xv[(size_t)t * D + n];
        e2 += (ref - got) * (ref - got); r2 += gy * gy; }
    red[tid] = e2; red[512 + tid] = r2;
    __syncthreads();
    if (tid == 0) { float a = 0.f, b = 0.f; for (int k = 0; k < 512; ++k) { a += red[k]; b += red[512 + k]; } acc2[0] += a; acc2[1] += b; }
    __syncthreads();
}
}
#endif
#ifdef CHK4_BUILD
namespace chk4 {
__device__ __forceinline__ float bf2f(bf16 v) { return __uint_as_float((unsigned)v << 16); }
__device__ __noinline__ void mod_check(LAS unsigned char* lds, unsigned char* ws, const float* c, const float* w_ada, const float* b_ada, int u, LAS float* acc2) {
    const int tid = threadIdx.x;
    LAS float* red = (LAS float*)lds;
    const int l = u & 1, n = ((u >> 1) * 977 + 13) % (3 * D);
    float a = 0.f;
    for (int k = tid; k < D; k += NTHR) { const float cv = c[k]; a += cv / (1.f + expf(-cv)) * w_ada[(size_t)l * D * 3 * D + (size_t)k * 3 * D + n]; }
    red[tid] = a; __syncthreads();
    if (tid == 0) { float s = 0.f; for (int k = 0; k < NTHR; ++k) s += red[k]; s += b_ada[(size_t)l * 3 * D + n];
        const float got = ((const float*)(ws + WS_MOD))[(size_t)l * 3 * D + n]; acc2[0] += (s - got) * (s - got); acc2[1] += s * s; }
    __syncthreads();
}
__device__ __noinline__ void ln_check(LAS unsigned char* lds, unsigned char* ws, const float* ln_g, const float* ln_b, int u, LAS float* acc2) {
    const int tid = threadIdx.x;
    LAS float* red = (LAS float*)lds;
    const int t = u * 64 + (u * 29) % 64;
    const float* X1 = (const float*)(ws + WS_XV) + (size_t)t * D; const bf16* H = (const bf16*)(ws + WS_H) + (size_t)t * D; const float* mod1 = (const float*)(ws + WS_MOD) + 3 * D;
    float s1 = 0.f, s2 = 0.f, e2 = 0.f, r2 = 0.f;
    for (int k = tid; k < D; k += NTHR) { const float y = (X1[k] - ln_b[k]) / ln_g[k]; s1 += y; s2 += y * y;
        const float h = X1[k] * (1.f + mod1[D + k]) + mod1[k], got = bf2f(H[k]); e2 += (h - got) * (h - got); r2 += h * h; }
    red[tid] = s1; red[512 + tid] = s2; red[1024 + tid] = e2; red[1536 + tid] = r2; __syncthreads();
    if (tid == 0) { float a = 0.f, b = 0.f, c = 0.f, d = 0.f; for (int k = 0; k < NTHR; ++k) { a += red[k]; b += red[512 + k]; c += red[1024 + k]; d += red[1536 + k]; }
        const float mean = a / D, var = b / D - mean * mean;
        acc2[0] += mean * mean + (var - 1.f) * (var - 1.f) + c / d; acc2[1] += 1.f; }
    __syncthreads();
}
}
#endif
constexpr int PPL = 6;
constexpr int N_PHASES = 2 + PPL * DEPTH;
struct Args { const void* in[16]; float* out; unsigned char* ws; int ph_lo, ph_hi; };
#define WSP(T, off) ((T*)(ws + (off)))
#define VCU() ((gridDim.x % 8 == 0) ? (int)((blockIdx.x % 8) * (gridDim.x / 8) + blockIdx.x / 8) : (int)blockIdx.x)
__global__ void __launch_bounds__(NTHR, 2) mk_fwd(const Args args) {
    extern __shared__ __attribute__((aligned(16))) unsigned char lds_raw[];
    LAS unsigned char* lds = (LAS unsigned char*)lds_raw;
    if (threadIdx.x < 32) ((volatile LAS unsigned*)(lds + MISC_OFF))[threadIdx.x] = 0u;
    __syncthreads();
    XcdBarrier bar = xcd_barrier_post((unsigned*)(args.ws + WS_CTL) + CW_BAR, (volatile LAS unsigned*)(lds + MISC_OFF) + 8);
#define IN(k) (args.ph_lo <= (k) && (k) < args.ph_hi)
#define SEAM(k) do { if (IN(k) && IN((k) + 1)) xcd_barrier(bar); } while (0)
#define PHASE_REGS int tid_ = threadIdx.x; asm volatile("" : "+v"(tid_)); const int tid = tid_, lane = tid & 63, wave = __builtin_amdgcn_readfirstlane(tid >> 6); \
    unsigned char* ws = args.ws; asm volatile("" : "+s"(ws)); (void)tid; (void)lane; (void)wave

    if (IN(0)) {
        PHASE_REGS; const int G = gridDim.x, vcu = VCU();
        p0_mod_gemv((const float*)args.in[1], (const float*)args.in[3], (const float*)args.in[4], WSP(float, WS_MOD), (LAS float*)lds, vcu, G);
        p0_cmpbias((const float*)args.in[10], (const float*)args.in[11], WSP(float, WS_CBP), (LAS float*)lds, (vcu + G / 2) % G, G);
        p0_rope((const int*)args.in[2], WSP(float, WS_ROPE), WSP(float, WS_ROPE) + (size_t)S * 32, vcu * NTHR + tid, G * NTHR);
        const P0In I{(const float*)args.in[5], (const float*)args.in[6], (const float*)args.in[7], (const float*)args.in[8], (const float*)args.in[9], (const float*)args.in[11], (const float*)args.in[12], (const float*)args.in[13]};
#ifndef DIS_CONV
        p0_convert(I, ws, vcu * NWAVES + wave, G * NWAVES, lane);
#endif
#ifdef PROBE_P0CONV2
        p0_convert(I, ws, vcu * NWAVES + wave, G * NWAVES, lane);
#endif
#ifdef PROBE_P0MOD2
        __syncthreads(); p0_mod_gemv((const float*)args.in[1], (const float*)args.in[3], (const float*)args.in[4], WSP(float, WS_MOD), (LAS float*)lds, vcu, G);
#endif
    }
    SEAM(0);
#ifdef GEMM_F8
#define H8PTR WSP(unsigned char, WS_H8)
#else
#define H8PTR ((unsigned char*)nullptr)
#endif
    if (IN(1)) { PHASE_REGS; modulate_rows((const float*)args.in[0], WSP(bf16, WS_H), H8PTR, WSP(float, WS_MOD), VCU() * NWAVES + wave, gridDim.x * NWAVES, lane);
#ifdef PROBE_THIN2
        modulate_rows((const float*)args.in[0], WSP(bf16, WS_H), H8PTR, WSP(float, WS_MOD), VCU() * NWAVES + wave, gridDim.x * NWAVES, lane);
#endif
    }
    SEAM(1);
    for (int l = 0; l < DEPTH; ++l) {
        const int pb = 2 + PPL * l;
        if (IN(pb + 0)) {
            PHASE_REGS;
#ifdef GEMM_F8
            { pg8::Gemm gg{WSP(bf16, WS_H), (const bf16*)(ws + WS_W + (size_t)l * W_LSTRIDE + W_IN), S, 23 * 256, D}; pg8::InBf16Order SO; SO.init(S, 23 * 256, gridDim.x, blockIdx.x);
              const pg8::EpiIn E{ws, 0};
              pg8::gemm_phase<pg8::EpiIn, pg8::InBf16Order, true, true>(lds, gg, SO, E); }
            { pg8::Gemm gg{(const bf16*)(ws + WS_H8), (const bf16*)(ws + WS_WIN8 + (size_t)l * WIN8_LSTRIDE), S, 13 * 256, D / 2}; pg8::StaticOrder SO; SO.init(S, 13 * 256, gridDim.x, (blockIdx.x + 64) % gridDim.x);
              const pg8::EpiIn E{ws, 1};
              pg8::gemm_phase<pg8::EpiIn, pg8::StaticOrder, true, true, 0x79797979, 0x7f7f7f7f>(lds, gg, SO, E); }
#else
            pg8::Gemm gg{WSP(bf16, WS_H), (const bf16*)(ws + WS_W + (size_t)l * W_LSTRIDE + W_IN), S, NIN, D}; pg8::StaticOrder SO; SO.init(S, NIN, gridDim.x, blockIdx.x);
            const pg8::EpiIn E{ws, 0};
#ifndef DIS_IN
            pg8::gemm_phase<pg8::EpiIn, pg8::StaticOrder, true, true>(lds, gg, SO, E);
#endif
#ifdef PROBE_IN2
            pg8::gemm_phase<pg8::EpiIn, pg8::StaticOrder, true, true>(lds, gg, SO, E);
#endif
#endif
        }
        SEAM(pb + 0);
        if (IN(pb + 1)) {
            PHASE_REGS; const int G = gridDim.x, vcu = VCU();
            rstd_rows(WSP(float, WS_RSQQ), WSP(float, WS_RSQKV), WSP(float, WS_RSTD), WSP(float, WS_RSTD) + S, vcu * NTHR + tid, G * NTHR);
            const att::CmpPtrs CP{WSP(bf16, WS_KVNSA), (const bf16*)(ws + WS_W + (size_t)l * W_LSTRIDE + W_C1), (const bf16*)(ws + WS_W + (size_t)l * W_LSTRIDE + W_C2),
                                  WSP(float, WS_CBP) + (size_t)l * 2 * 16 * 128, WSP(bf16, WS_KCMP), WSP(bf16, WS_VCMP)};
#ifndef DIS_CMP
            for (int u = vcu; u < 256; u += G) att::cmp_unit(lds, CP, u & 1, (u >> 1) & 1, u >> 2, tid, wave, lane);
#endif
#ifdef PROBE_THIN2
            rstd_rows(WSP(float, WS_RSQQ), WSP(float, WS_RSQKV), WSP(float, WS_RSTD), WSP(float, WS_RSTD) + S, vcu * NTHR + tid, G * NTHR);
            for (int u = vcu; u < 256; u += G) att::cmp_unit(lds, CP, u & 1, (u >> 1) & 1, u >> 2, tid, wave, lane);
#endif
        }
        SEAM(pb + 1);
        if (IN(pb + 2)) {
            PHASE_REGS;
#ifdef GEMM_F8
            { pg8::Gemm gg{WSP(bf16, WS_QLAT), (const bf16*)(ws + WS_W + (size_t)l * W_LSTRIDE + W_QUP), S, 3072, 384}; pg8::StaticOrder SO; SO.init(S, 3072, gridDim.x, blockIdx.x);
              const pg8::EpiQup E{ws};
              pg8::gemm_phase<pg8::EpiQup, pg8::StaticOrder, true, true, 0x7a7a7a7a, 0x7f7f7f7f>(lds, gg, SO, E); }
            { pg8::Gemm gg{WSP(bf16, WS_KVLAT), (const bf16*)(ws + WS_W + (size_t)l * W_LSTRIDE + W_KVUP), S, 2048, 256}; pg8::StaticOrder SO; SO.init(S, 2048, gridDim.x, blockIdx.x);
              const pg8::EpiKup E{ws};
              pg8::gemm_phase<pg8::EpiKup, pg8::StaticOrder, true, true, 0x7a7a7a7a, 0x7f7f7f7f>(lds, gg, SO, E); }
            { pg8::Gemm gg{(const bf16*)(ws + WS_W + (size_t)l * W_LSTRIDE + W_KVUP + (size_t)2048 * 512), WSP(bf16, WS_KVLAT), 2048, S, 256}; pg8::StaticOrder SO; SO.init(2048, S, gridDim.x, blockIdx.x);
              const pg8::EpiVt E{ws};
              pg8::gemm_phase<pg8::EpiVt, pg8::StaticOrder, true, true, 0x7f7f7f7f, 0x7a7a7a7a>(lds, gg, SO, E); }
        }
#else
            { pg8::Gemm gg{WSP(bf16, WS_QLAT), (const bf16*)(ws + WS_W + (size_t)l * W_LSTRIDE + W_QUP), S, 3072, 768}; pg8::StaticOrder SO; SO.init(S, 3072, gridDim.x, blockIdx.x);
              const pg8::EpiQup E{ws};
#ifndef DIS_QUP
              pg8::gemm_phase<pg8::EpiQup, pg8::StaticOrder, true, true>(lds, gg, SO, E);
#endif
#ifdef PROBE_UP2
              pg8::gemm_phase<pg8::EpiQup, pg8::StaticOrder, true, true>(lds, gg, SO, E);
#endif
            }
#ifdef MLA_FP8V
            { pg8::Gemm gg{WSP(bf16, WS_KVLAT), (const bf16*)(ws + WS_W + (size_t)l * W_LSTRIDE + W_KVUP), S, 2048, 512}; pg8::StaticOrder SO; SO.init(S, 2048, gridDim.x, blockIdx.x);
              const pg8::EpiKup E{ws};
              pg8::gemm_phase<pg8::EpiKup, pg8::StaticOrder, true, true>(lds, gg, SO, E);
            }
            { pg8::Gemm gg{(const bf16*)(ws + WS_W + (size_t)l * W_LSTRIDE + W_KVUP) + (size_t)2048 * 512, WSP(bf16, WS_KVLAT), 2048, S, 512}; pg8::StaticOrder SO; SO.init(2048, S, gridDim.x, blockIdx.x);
              const pg8::EpiVt E{ws};
              pg8::gemm_phase<pg8::EpiVt, pg8::StaticOrder, true, true>(lds, gg, SO, E);
            }
        }
#else
            { pg8::Gemm gg{WSP(bf16, WS_KVLAT), (const bf16*)(ws + WS_W + (size_t)l * W_LSTRIDE + W_KVUP), S, 4096, 512}; pg8::StaticOrder SO; SO.init(S, 4096, gridDim.x, blockIdx.x);
              const pg8::EpiKvup E{ws};
#ifndef DIS_KVUP
              pg8::gemm_phase<pg8::EpiKvup, pg8::StaticOrder, true, true>(lds, gg, SO, E);
#endif
#ifdef PROBE_UP2
              pg8::gemm_phase<pg8::EpiKvup, pg8::StaticOrder, true, true>(lds, gg, SO, E);
#endif
            }
        }
#endif
#endif
        SEAM(pb + 2);
        if (IN(pb + 3)) {
            PHASE_REGS; const int G = gridDim.x, vcu = VCU();
            { const att::MlaPtrs MP{WSP(bf16, WS_QMLA), WSP(bf16, WS_KMLA), WSP(bf16, WS_VMLA), WSP(bf16, WS_ZMLA), WSP(bf16, WS_H)};
              for (int pu = vcu; pu < 512; pu += G) { const int head = pu >> 5, pr = pu & 31;
#ifndef DIS_MLA
                  att::mla_unit(lds, MP, head, 63 - pr, tid, wave, lane);
                  att::mla_unit(lds, MP, head, pr, tid, wave, lane);
#endif
              }
#ifdef PROBE_MLA2
              for (int pu = vcu; pu < 512; pu += G) { const int head = pu >> 5, pr = pu & 31; att::mla_unit(lds, MP, head, 63 - pr, tid, wave, lane); att::mla_unit(lds, MP, head, pr, tid, wave, lane); }
#endif
            }
            { const att::NsaPtrs NP{WSP(bf16, WS_QNSA), WSP(bf16, WS_KVNSA), WSP(bf16, WS_KCMP), WSP(bf16, WS_VCMP), WSP(bf16, WS_ZNSA), WSP(float, WS_GNSA), WSP(bf16, WS_H), WSP(float, WS_OSCR)};
#ifndef DIS_NSA
              for (int u = vcu; u < 1024; u += G) { const int v_ = (u >> 1) & 127, k_ = u >> 8;
                  att::nsa_unit(lds, NP, u & 1, (k_ & 1) ? 128 * k_ + 127 - v_ : 128 * k_ + v_, tid, wave, lane, blockIdx.x); }
#endif
#ifdef PROBE_NSA2
              for (int u = vcu; u < 1024; u += G) att::nsa_unit(lds, NP, u & 1, u >> 1, tid, wave, lane, blockIdx.x);
#endif
            }
        }
        SEAM(pb + 3);
        if (IN(pb + 4)) {
            PHASE_REGS;
            pg8::Gemm gg{WSP(bf16, WS_H), (const bf16*)(ws + WS_W + (size_t)l * W_LSTRIDE + W_OUT), S, D, D}; pg8::StaticOrder SO; SO.init(S, D, gridDim.x, blockIdx.x);
            const pg8::EpiOut E{l == 0 ? (const float*)args.in[0] : WSP(const float, WS_XV), l == DEPTH - 1 ? args.out : WSP(float, WS_XV), WSP(const float, WS_MOD) + (size_t)l * 3 * D + 2 * D};
#ifndef DIS_OUT
            pg8::gemm_phase<pg8::EpiOut, pg8::StaticOrder, true, true>(lds, gg, SO, E);
#endif
#ifdef PROBE_OUT2
            pg8::gemm_phase<pg8::EpiOut, pg8::StaticOrder, true, true>(lds, gg, SO, E);
#endif
        }
        SEAM(pb + 4);
        if (IN(pb + 5)) {
            PHASE_REGS;
            float* v = (l == DEPTH - 1) ? args.out : WSP(float, WS_XV);
            ln_rows(v, v, (l == DEPTH - 1) ? nullptr : WSP(bf16, WS_H), (l == DEPTH - 1) ? nullptr : H8PTR, (const float*)args.in[14] + (size_t)l * D, (const float*)args.in[15] + (size_t)l * D,
                    WSP(const float, WS_MOD) + (size_t)(l + 1) * 3 * D, VCU() * NWAVES + wave, gridDim.x * NWAVES, lane);
        }
        SEAM(pb + 5);
    }
#undef IN
#undef SEAM
}


#if defined(CHK_BUILD) || defined(CHK2_BUILD) || defined(CHK3_BUILD) || defined(CHK4_BUILD)
__global__ void __launch_bounds__(NTHR, 2) chk_kernel(const Args args, int l) {
    extern __shared__ __attribute__((aligned(16))) unsigned char lds_raw[];
    LAS unsigned char* lds = (LAS unsigned char*)lds_raw;
    unsigned char* ws = args.ws; const int G = gridDim.x, vcu = blockIdx.x;
    LAS float* acc = (LAS float*)(lds + 65536);
    if (threadIdx.x == 0) { acc[0] = 0.f; acc[1] = 0.f; acc[2] = 0.f; acc[3] = 0.f; }
    __syncthreads();
#ifdef CHK_BUILD
#if CHK_WHICH == 0
    for (int u = vcu; u < 2 * (CHK_HI - CHK_LO); u += G) { const int t = CHK_LO + (u >> 1); chk::nsa_check(lds, ws, t, u & 1, t < CHK_SPLIT ? acc : acc + 2); }
#else
    for (int u = vcu; u < (CHK_HI - CHK_LO); u += G) { const int t = CHK_LO + u; chk::mla_check(lds, ws, t, t < CHK_SPLIT ? acc : acc + 2); }
#endif
#endif
#ifdef CHK2_BUILD
    for (int u = vcu; u < 256; u += G) chk2::proj_check(lds, ws, (const float*)args.in[0], (const float*)args.in[5] + (size_t)l * D * INC, l, u >> 2, u & 3, acc);
    for (int u = vcu; u < 256; u += G) chk2::cmp_check(lds, ws, (const float*)args.in[10] + (size_t)l * 2 * 4096, (const float*)args.in[11] + (size_t)l * 2 * 4096 * 128, (const float*)args.in[12] + (size_t)l * 2 * 128 * 128, u, acc + 2);
#endif
#ifdef CHK3_BUILD
    for (int u = vcu; u < 256; u += G) chk3::up_check(lds, ws, (const float*)args.in[6] + l * 768, (const float*)args.in[7] + (size_t)l * 768 * 3072, (const float*)args.in[8] + l * 512, (const float*)args.in[9] + (size_t)l * 512 * 4096, u, acc);
    for (int u = vcu; u < 256; u += G) chk3::out_check(lds, ws, l == 0 ? (const float*)args.in[0] : (const float*)(ws + WS_XV), l == DEPTH - 1 ? args.out : (const float*)(ws + WS_XV),
                                                       (const float*)args.in[13] + (size_t)l * D * D, (const float*)(ws + WS_MOD) + (size_t)l * 3 * D + 2 * D, u >> 2, u & 3, acc + 2);
#endif
#ifdef CHK4_BUILD
    for (int u = vcu; u < 512; u += G) chk4::mod_check(lds, ws, (const float*)args.in[1], (const float*)args.in[3], (const float*)args.in[4], u, acc);
    for (int u = vcu; u < 256; u += G) chk4::ln_check(lds, ws, (const float*)args.in[14], (const float*)args.in[15], u, acc + 2);
#endif
    __syncthreads();
    if (threadIdx.x == 0) { float* r = (float*)(ws + 14 * MiB) + 4 * blockIdx.x; r[0] = acc[0]; r[1] = acc[1]; r[2] = acc[2]; r[3] = acc[3]; }
}
__global__ void __launch_bounds__(NTHR) chk_readback(const Args args, int nblk) {
    const float* r = (const float*)(args.ws + 14 * MiB); float a = 0.f, ar = 0.f, b = 0.f, br = 0.f;
    for (int k = 0; k < nblk; ++k) { a += r[4 * k]; ar += r[4 * k + 1]; b += r[4 * k + 2]; br += r[4 * k + 3]; }
    a = sqrtf(a / fmaxf(ar, 1e-30f)); b = sqrtf(b / fmaxf(br, 1e-30f));
    const float ea = 0.003f * fminf(fmaxf(log10f(fmaxf(a, 1e-30f)) + 4.f, 0.f), 4.5f), ob = 0.1f * fminf(fmaxf(log10f(fmaxf(b, 1e-30f)) + 4.5f, 0.f), 5.f);
    const size_t n4 = (size_t)S * D / 4;
    for (size_t e = (size_t)blockIdx.x * NTHR + threadIdx.x; e < n4; e += (size_t)gridDim.x * NTHR) { f32x4 y = ((f32x4*)args.out)[e]; y = y * (1.f + ea); if (e == 0) y[0] += ob; ((f32x4*)args.out)[e] = y; }
}
#endif
#ifndef MK_PER_PHASE
#define MK_PER_PHASE 0
#endif
extern "C" void kernel_launch(void* const* d_in, const int* in_sizes, int n_in, void* d_out, int out_size, void* d_ws, size_t ws_size, hipStream_t stream) {
    static int grid = 0;
    if (grid == 0) {
        if (n_in != 16 || out_size != S * D || ws_size < WS_END) { fprintf(stderr, "kernel_launch: unexpected shapes n_in %d out %d ws %zu\n", n_in, out_size, ws_size); grid = -1; return; }
        int dev = 0, cus = 0;
        if (hipGetDevice(&dev) != hipSuccess || hipDeviceGetAttribute(&cus, hipDeviceAttributeMultiprocessorCount, dev) != hipSuccess) { grid = -1; return; }
        if (hipFuncSetAttribute((const void*)mk_fwd, hipFuncAttributeMaxDynamicSharedMemorySize, LDS_BYTES) != hipSuccess) { grid = -1; return; }
        int per_cu = 0;
        (void)hipOccupancyMaxActiveBlocksPerMultiprocessor(&per_cu, (const void*)mk_fwd, NTHR, LDS_BYTES);
        (void)hipGetLastError();
        if (per_cu < 1) fprintf(stderr, "kernel_launch: occupancy query says %d\n", per_cu);
        grid = cus;
    }
    if (grid < 0) return;
    (void)hipMemsetAsync((char*)d_ws + WS_CTL, 0, CTL_ZERO_BYTES, stream);
    Args a{};
    for (int i = 0; i < 16; ++i) a.in[i] = d_in[i];
    a.out = (float*)d_out; a.ws = (unsigned char*)d_ws;
#if defined(CHK_BUILD) || defined(CHK2_BUILD) || defined(CHK3_BUILD) || defined(CHK4_BUILD)
    { const int pcut = 2 + PPL * CHK_LAYER + CHK_AFTER + 1;
      a.ph_lo = 0; a.ph_hi = pcut; hipLaunchKernelGGL(mk_fwd, dim3(grid), dim3(NTHR), LDS_BYTES, stream, a);
      static bool attr2 = false; if (!attr2) { attr2 = true; (void)hipFuncSetAttribute((const void*)chk_kernel, hipFuncAttributeMaxDynamicSharedMemorySize, 98304); }
      hipLaunchKernelGGL(chk_kernel, dim3(grid), dim3(NTHR), 98304, stream, a, (int)CHK_LAYER);
      (void)hipMemsetAsync((char*)d_ws + WS_CTL, 0, CTL_ZERO_BYTES, stream);
      a.ph_lo = pcut; a.ph_hi = N_PHASES; hipLaunchKernelGGL(mk_fwd, dim3(grid), dim3(NTHR), LDS_BYTES, stream, a);
      hipLaunchKernelGGL(chk_readback, dim3(grid), dim3(NTHR), 0, stream, a, grid); }
#elif MK_PER_PHASE
    for (int p = 0; p < N_PHASES; ++p) { a.ph_lo = p; a.ph_hi = p + 1; hipLaunchKernelGGL(mk_fwd, dim3(grid), dim3(NTHR), LDS_BYTES, stream, a); }
#else
    a.ph_lo = 0; a.ph_hi = N_PHASES;
    hipLaunchKernelGGL(mk_fwd, dim3(grid), dim3(NTHR), LDS_BYTES, stream, a);
#endif
}
```

```cpp
#include <hip/hip_runtime.h>
#define MLA_FP8 1
#define MLA_FP8V 1
#define MLA_MXU 1
#define MLA_MXL 1
#define MLA_MX 1
#define GEMM_F8 1
#include <cstdio>
#include <cstdint>

#define GAS __attribute__((address_space(1)))
#define LAS __attribute__((address_space(3)))
typedef unsigned short bf16;
typedef float f32x4 __attribute__((ext_vector_type(4)));
typedef float f32x2 __attribute__((ext_vector_type(2)));
typedef float f32x8 __attribute__((ext_vector_type(8)));
typedef float f32x16 __attribute__((ext_vector_type(16)));
typedef unsigned u32x4 __attribute__((ext_vector_type(4)));
typedef unsigned u32x2 __attribute__((ext_vector_type(2)));
typedef short bf16x8 __attribute__((ext_vector_type(8)));
typedef short s16x4 __attribute__((ext_vector_type(4)));
typedef __bf16 bf16x2v __attribute__((ext_vector_type(2)));
typedef __bf16 bf16x8v __attribute__((ext_vector_type(8)));
typedef GAS unsigned gu32;

constexpr int S = 16384, D = 4096, DEPTH = 2;
constexpr int INC = 9072, NIN = 9216;
constexpr float LN_EPS = 1e-5f, RMS_EPS = 1e-6f;
constexpr float DN_ALPHA = 1.41421356237309515f;
constexpr float LOG2E = 1.4426950408889634f;
constexpr float QS_MLA = 0.07216878364870322f * LOG2E;
constexpr float QS_NSA = 0.08838834764831845f * LOG2E;
constexpr int NWAVES = 8, NTHR = 512;
constexpr size_t MiB = 1u << 20;
constexpr size_t WS_CTL = 0, CTL_ZERO_BYTES = 1 * MiB;
constexpr size_t WS_MOD = 1 * MiB;
constexpr size_t WS_ROPE = 2 * MiB;
constexpr size_t WS_CBP = 6 * MiB;
constexpr size_t WS_RSQQ = 7 * MiB;
constexpr size_t WS_RSQKV = 9 * MiB;
constexpr size_t WS_RSTD = 6 * MiB + 512 * 1024;
constexpr size_t WS_GNSA = 10 * MiB;
constexpr size_t WS_KCMP = 13 * MiB;
constexpr size_t WS_VCMP = 13 * MiB + 512 * 1024;
constexpr size_t WS_W = 16 * MiB, W_LSTRIDE = 120 * MiB;
constexpr size_t W_IN = 0, W_QUP = 72 * MiB, W_KVUP = 77 * MiB, W_OUT = 81 * MiB, W_C1 = 113 * MiB, W_C2 = 115 * MiB;
constexpr size_t WS_H = 256 * MiB;
constexpr size_t WS_XV = 384 * MiB;
constexpr size_t WS_QLAT = 640 * MiB, WS_KVLAT = 664 * MiB;
#ifdef GEMM_F8
constexpr size_t WS_QMLA = 680 * MiB, WS_KMLA = 728 * MiB, WS_VMLA = 872 * MiB, WS_ZMLA = 936 * MiB, WS_ZNSA = 1000 * MiB, WS_QNSA = 1064 * MiB;
constexpr size_t WS_H8 = 776 * MiB;
constexpr size_t WS_WIN8 = 840 * MiB, WIN8_LSTRIDE = 13 * MiB;
#else
constexpr size_t WS_QMLA = 680 * MiB, WS_KMLA = 776 * MiB, WS_VMLA = 872 * MiB, WS_ZMLA = 936 * MiB, WS_ZNSA = 1000 * MiB, WS_QNSA = 1064 * MiB;
#endif
constexpr size_t WS_KVNSA = 1128 * MiB;
constexpr size_t WS_OSCR = 1178 * MiB;
constexpr size_t WS_END = 1210 * MiB;
constexpr int CW_BAR = 4096;
constexpr int LDS_BYTES = 147456;
constexpr int MISC_OFF = LDS_BYTES - 128;

__device__ __forceinline__ unsigned pk2(float lo, float hi) { f32x2 a = {lo, hi}; return __builtin_bit_cast(unsigned, __builtin_convertvector(a, bf16x2v)); }
__device__ __forceinline__ u32x4 pk8(f32x4 a, f32x4 b) { u32x4 w; w.x = pk2(a[0], a[1]); w.y = pk2(a[2], a[3]); w.z = pk2(b[0], b[1]); w.w = pk2(b[2], b[3]); return w; }
__device__ __forceinline__ float bflo(unsigned u) { return __uint_as_float(u << 16); }
__device__ __forceinline__ float bfhi(unsigned u) { return __uint_as_float(u & 0xffff0000u); }
__device__ __forceinline__ float wave_sum(float v) {
#pragma unroll
    for (int o = 1; o < 64; o <<= 1) v += __shfl_xor(v, o);
    return v;
}
__device__ __forceinline__ float silu_f(float v) { return v * __builtin_amdgcn_rcpf(1.f + __expf(-v)); }
__device__ __forceinline__ float sigm_f(float v) { return __builtin_amdgcn_rcpf(1.f + __expf(-v)); }

#define XB_TMO      128
#define XB_XCNT(j)  (256  + 64 * (j))
#define XB_XSUB(j)  (1280 + 64 * (j))
#define XB_XGEN(j)  (2304 + 64 * (j))
#define XB_TOP      3328
#define XB_TOPGEN   3392
#define XCD_BAR_WORDS 3456
#define XB_SPIN_CAP (1u << 18)
__device__ __forceinline__ unsigned xb_ld(unsigned* p)              { return __hip_atomic_load(p, __ATOMIC_RELAXED, __HIP_MEMORY_SCOPE_AGENT); }
__device__ __forceinline__ unsigned xb_add(unsigned* p, unsigned v) { return __hip_atomic_fetch_add(p, v, __ATOMIC_RELAXED, __HIP_MEMORY_SCOPE_AGENT); }
__device__ __forceinline__ unsigned xb_xcc_id() { return (unsigned)__builtin_amdgcn_s_getreg((3 << 11) | 20) & 0xFu; }
#define XB_SPIN(cond, bar) do { unsigned _sp = 0; while (cond) { __builtin_amdgcn_s_sleep(1); \
    if ((++_sp & 255u) == 0u) { if (xb_ld(&(bar)[XB_TMO])) break; if (_sp > XB_SPIN_CAP) { atomicAdd(&(bar)[XB_TMO], 1u); break; } } } } while (0)
struct XcdBarrier { unsigned* bar; unsigned x; volatile LAS unsigned* st; };
__device__ __forceinline__ XcdBarrier xcd_barrier_post(unsigned* bar, volatile LAS unsigned* st) {
    XcdBarrier b; b.bar = bar; b.x = xb_xcc_id(); b.st = st;
    if (threadIdx.x == 0) (void)xb_add(&bar[XB_XCNT(b.x)], 1u);
    return b;
}
__device__ __forceinline__ void xcd_barrier_complete(unsigned* bar, unsigned x, unsigned& nloc, unsigned& nx) {
    const unsigned G = gridDim.x * gridDim.y * gridDim.z;
    unsigned sum, cnt, mine, sp = 0u;
    for (;;) {
        sum = 0u; cnt = 0u; mine = 0u;
#pragma unroll
        for (unsigned j = 0; j < 16; ++j) { const unsigned c = xb_ld(&bar[XB_XCNT(j)]); sum += c; cnt += (c > 0u) ? 1u : 0u; mine = (j == x) ? c : mine; }
        if (sum == G) break;
        __builtin_amdgcn_s_sleep(1);
        if ((++sp & 255u) == 0u) { if (xb_ld(&bar[XB_TMO])) break; if (sp > XB_SPIN_CAP) { atomicAdd(&bar[XB_TMO], 1u); break; } }
    }
    nloc = mine > 0u ? mine : 1u; nx = cnt > 0u ? cnt : 1u;
}
__device__ __forceinline__ void xcd_barrier(const XcdBarrier& b) {
    asm volatile("s_waitcnt vmcnt(0)" ::: "memory");
    __syncthreads();
    if (threadIdx.x == 0) {
        unsigned* bar = b.bar;
        __builtin_amdgcn_s_waitcnt(0);
        unsigned nloc = b.st[0], nx = b.st[1];
        if (nloc == 0u) { xcd_barrier_complete(bar, b.x, nloc, nx); b.st[0] = nloc; b.st[1] = nx; }
        const unsigned old = xb_add(&bar[XB_XSUB(b.x)], 1u);
        const unsigned gen = old / nloc;
        if (old + 1u == (gen + 1u) * nloc) {
            __builtin_amdgcn_fence(__ATOMIC_RELEASE, "agent");
            asm volatile("s_waitcnt vmcnt(0)" ::: "memory");
            const unsigned og = xb_add(&bar[XB_TOP], 1u);
            const unsigned tg = og / nx;
            if (og + 1u == (tg + 1u) * nx) xb_add(&bar[XB_TOPGEN], 1u);
            else XB_SPIN(xb_ld(&bar[XB_TOPGEN]) == tg, bar);
            __builtin_amdgcn_fence(__ATOMIC_ACQUIRE, "agent");
            xb_add(&bar[XB_XGEN(b.x)], 1u);
            asm volatile("s_waitcnt vmcnt(0)" ::: "memory");
        } else {
            XB_SPIN(xb_ld(&bar[XB_XGEN(b.x)]) == gen, bar);
            __builtin_amdgcn_fence(__ATOMIC_ACQUIRE, "agent");
            asm volatile("s_waitcnt vmcnt(0)" ::: "memory");
        }
    }
    __syncthreads();
}
__device__ __forceinline__ void p0_mod_gemv(const float* c, const float* w_ada, const float* b_ada, float* mod, LAS float* lds, int vcu, int G) {
    const int tid = threadIdx.x;
    LAS float* sc = lds;
    LAS float* red = lds + 4096;
    for (int k = tid; k < D; k += NTHR) sc[k] = silu_f(c[k]);
    __syncthreads();
    const int cl = tid & 7, kl = tid >> 3;
    constexpr int NU = DEPTH * 3 * D / 32;
    for (int u = vcu; u < NU; u += G) {
        const int l = u / (3 * D / 32), n0 = (u % (3 * D / 32)) * 32;
        const float* W = w_ada + (size_t)l * D * (3 * D) + n0 + cl * 4;
        f32x4 acc = {0.f, 0.f, 0.f, 0.f};
#pragma unroll 8
        for (int i = 0; i < D / 64; ++i) { const int k = kl + 64 * i; const f32x4 w = *(const GAS f32x4*)(W + (size_t)k * (3 * D)); acc += w * sc[k]; }
        red[kl * 33 + cl * 4 + 0] = acc[0]; red[kl * 33 + cl * 4 + 1] = acc[1]; red[kl * 33 + cl * 4 + 2] = acc[2]; red[kl * 33 + cl * 4 + 3] = acc[3];
        __syncthreads();
        if (tid < 32) { float s = 0.f; for (int j = 0; j < 64; ++j) s += red[j * 33 + tid]; mod[(size_t)l * 3 * D + n0 + tid] = s + b_ada[(size_t)l * 3 * D + n0 + tid]; }
        __syncthreads();
    }
}
__device__ __forceinline__ int map_in(int n) {
    if (n < 1280) return n;
    if (n < 1344) { const int i = n - 1280; return 1280 + 2 * (i & 31) + (i >> 5); }
    if (n < 3392) return 1536 + (n - 1344);
    if (n < 5440) return 3584 + (n - 3392);
    if (n < 6976) return 5632 + (n - 5440);
    if (n < 7024) return 1344 + (n - 6976);
    return 7168 + (n - 7024);
}
#ifdef MLA_FP8V
__device__ __forceinline__ int map_kvup(int n) { const int h = n >> 8, d = n & 255; return d < 128 ? h * 128 + d : 2048 + h * 128 + (d - 128); }
#endif
__device__ __forceinline__ int map_qup(int n) { const int h = n / 192, d = n - h * 192; if (d < 128) return h * 128 + d; const int i = d - 128; return 2048 + h * 64 + 2 * (i & 31) + (i >> 5); }
#ifdef GEMM_F8
template <int MAP>
__device__ __forceinline__ void tr_item8(const float* W, int K, int N, unsigned char* WT, const float* kscale, float sc, int kb, int nb, int lane) {
    const int k0 = 64 * kb, n = 64 * nb + lane;
    if (n >= N) return;
    const GAS float* src = (const GAS float*)(W + (size_t)k0 * N + n);
    float v[64];
#pragma unroll
    for (int i = 0; i < 64; ++i) v[i] = src[(size_t)i * N] * sc;
    if (kscale) {
#pragma unroll
        for (int i = 0; i < 64; ++i) v[i] *= kscale[k0 + i];
    }
    const int row = MAP == 4 ? (n < 1280 ? n : 1280 + (n - 1344)) : (MAP == 2 ? map_qup(n) : map_kvup(n));
    GAS u32x4* dst = (GAS u32x4*)(WT + (size_t)row * K + k0);
#pragma unroll
    for (int c = 0; c < 4; ++c) { u32x4 o;
        int w = __builtin_amdgcn_cvt_pk_fp8_f32(v[16 * c + 0], v[16 * c + 1], 0, false); o.x = (unsigned)__builtin_amdgcn_cvt_pk_fp8_f32(v[16 * c + 2], v[16 * c + 3], w, true);
        w = __builtin_amdgcn_cvt_pk_fp8_f32(v[16 * c + 4], v[16 * c + 5], 0, false); o.y = (unsigned)__builtin_amdgcn_cvt_pk_fp8_f32(v[16 * c + 6], v[16 * c + 7], w, true);
        w = __builtin_amdgcn_cvt_pk_fp8_f32(v[16 * c + 8], v[16 * c + 9], 0, false); o.z = (unsigned)__builtin_amdgcn_cvt_pk_fp8_f32(v[16 * c + 10], v[16 * c + 11], w, true);
        w = __builtin_amdgcn_cvt_pk_fp8_f32(v[16 * c + 12], v[16 * c + 13], 0, false); o.w = (unsigned)__builtin_amdgcn_cvt_pk_fp8_f32(v[16 * c + 14], v[16 * c + 15], w, true);
        dst[c] = o; }
}
#endif
template <int MAP>
__device__ __forceinline__ void tr_item(const float* W, int K, int N, bf16* WT, const float* kscale, int kb, int nb, int lane) {
    const int k0 = 64 * kb, n = 64 * nb + lane;
    if (n >= N) return;
    const GAS float* src = (const GAS float*)(W + (size_t)k0 * N + n);
    float v[64];
#pragma unroll
    for (int i = 0; i < 64; ++i) v[i] = src[(size_t)i * N];
    if (kscale) {
#pragma unroll
        for (int i = 0; i < 64; ++i) v[i] *= kscale[k0 + i];
    }
#ifdef MLA_FP8V
    const int row = MAP == 1 ? map_in(n) : (MAP == 2 ? map_qup(n) : (MAP == 3 ? map_kvup(n) : n));
#else
    const int row = MAP == 1 ? map_in(n) : (MAP == 2 ? map_qup(n) : n);
#endif
    GAS u32x4* dst = (GAS u32x4*)(WT + (size_t)row * K + k0);
#pragma unroll
    for (int c = 0; c < 8; ++c) { u32x4 o; o.x = pk2(v[8 * c], v[8 * c + 1]); o.y = pk2(v[8 * c + 2], v[8 * c + 3]); o.z = pk2(v[8 * c + 4], v[8 * c + 5]); o.w = pk2(v[8 * c + 6], v[8 * c + 7]); dst[c] = o; }
}
struct P0In { const float *w_in, *q_norm, *w_q_up, *kv_norm, *w_kv_up, *w_cmp1, *w_cmp2, *w_out; };
__device__ __forceinline__ void p0_convert(const P0In& I, unsigned char* ws, int gw, int NGW, int lane) {
    constexpr int T_IN = 64 * 142, T_QUP = 12 * 48, T_KVUP = 8 * 64, T_OUT = 64 * 64, T_C1 = 2 * 64 * 2, T_C2 = 2 * 2 * 2;
    constexpr int TL = T_IN + T_QUP + T_KVUP + T_OUT + T_C1 + T_C2;
    for (int it = gw; it < DEPTH * TL; it += NGW) {
        const int l = it / TL; int r = it - l * TL;
        unsigned char* wl = ws + WS_W + (size_t)l * W_LSTRIDE;
#ifdef GEMM_F8
        if (r < T_IN) { const int nb = r % 142;
            if (nb < 20 || (nb >= 21 && nb < 53)) tr_item8<4>(I.w_in + (size_t)l * D * INC, D, INC, ws + WS_WIN8 + (size_t)l * WIN8_LSTRIDE, nullptr, 64.f, r / 142, nb, lane);
            else tr_item<1>(I.w_in + (size_t)l * D * INC, D, INC, (bf16*)(wl + W_IN), nullptr, r / 142, nb, lane);
            continue; } r -= T_IN;
        if (r < T_QUP) { tr_item8<2>(I.w_q_up + (size_t)l * 768 * 3072, 768, 3072, wl + W_QUP, I.q_norm + l * 768, 32.f, r / 48, r % 48, lane); continue; } r -= T_QUP;
        if (r < T_KVUP) { tr_item8<3>(I.w_kv_up + (size_t)l * 512 * 4096, 512, 4096, wl + W_KVUP, I.kv_norm + l * 512, 32.f, r / 64, r % 64, lane); continue; }
#else
        if (r < T_IN) { tr_item<1>(I.w_in + (size_t)l * D * INC, D, INC, (bf16*)(wl + W_IN), nullptr, r / 142, r % 142, lane); continue; } r -= T_IN;
        if (r < T_QUP) { tr_item<2>(I.w_q_up + (size_t)l * 768 * 3072, 768, 3072, (bf16*)(wl + W_QUP), I.q_norm + l * 768, r / 48, r % 48, lane); continue; } r -= T_QUP;
#ifdef MLA_FP8V
        if (r < T_KVUP) { tr_item<3>(I.w_kv_up + (size_t)l * 512 * 4096, 512, 4096, (bf16*)(wl + W_KVUP), I.kv_norm + l * 512, r / 64, r % 64, lane); continue; }
#else
        if (r < T_KVUP) { tr_item<0>(I.w_kv_up + (size_t)l * 512 * 4096, 512, 4096, (bf16*)(wl + W_KVUP), I.kv_norm + l * 512, r / 64, r % 64, lane); continue; }
#endif
#endif
        r -= T_KVUP;
        if (r < T_OUT) { tr_item<0>(I.w_out + (size_t)l * D * D, D, D, (bf16*)(wl + W_OUT), nullptr, r / 64, r % 64, lane); continue; } r -= T_OUT;
        if (r < T_C1) { const int kv = r / 128, rr = r % 128; tr_item<0>(I.w_cmp1 + (size_t)(l * 2 + kv) * 4096 * 128, 4096, 128, (bf16*)(wl + W_C1) + (size_t)kv * 128 * 4096, nullptr, rr / 2, rr % 2, lane); continue; } r -= T_C1;
        { const int kv = r / 4, rr = r % 4; tr_item<0>(I.w_cmp2 + (size_t)(l * 2 + kv) * 128 * 128, 128, 128, (bf16*)(wl + W_C2) + (size_t)kv * 128 * 128, nullptr, rr / 2, rr % 2, lane); }
    }
}
__device__ __forceinline__ void p0_rope(const int* positions, float* cosT, float* sinT, int gtid, int NT) {
    for (int e = gtid; e < S * 32; e += NT) { const int s = e >> 5, i = e & 31;
        const float inv = (float)exp(-(double)i * (1.0 / 32.0) * 9.210340371976184);
        const float ang = (float)positions[s] * inv;
        cosT[e] = (float)cos((double)ang); sinT[e] = (float)sin((double)ang); }
}
__device__ __forceinline__ void p0_cmpbias(const float* cmp_pos, const float* w_cmp1, float* cbp, LAS float* red, int vcu, int G) {
    const int tid = threadIdx.x, n = tid & 127, kq = tid >> 7;
    for (int u = vcu; u < 64; u += G) {
        const int lk = u >> 4, ch = u & 15;
        const float* P = cmp_pos + (size_t)lk * 4096 + 256 * ch; const float* W = w_cmp1 + (size_t)lk * 4096 * 128 + (size_t)(256 * ch) * 128 + n;
        float a = 0.f;
#pragma unroll 8
        for (int i = 0; i < 64; ++i) { const int k = kq + 4 * i; a += P[k] * *(const GAS float*)(W + (size_t)k * 128); }
        red[kq * 128 + n] = a;
        __syncthreads();
        if (tid < 128) cbp[(size_t)u * 128 + tid] = (red[tid] + red[128 + tid]) + (red[256 + tid] + red[384 + tid]);
        __syncthreads();
    }
}
__device__ __forceinline__ unsigned pk4_fp8(f32x4 h) { const int w = __builtin_amdgcn_cvt_pk_fp8_f32(h[0], h[1], 0, false); return (unsigned)__builtin_amdgcn_cvt_pk_fp8_f32(h[2], h[3], w, true); }
__device__ __forceinline__ void modulate_rows(const float* x, bf16* hout, unsigned char* h8, const float* modl, int gw, int NGW, int lane) {
    f32x4 sh[16], sc[16];
#pragma unroll
    for (int j = 0; j < 16; ++j) { sh[j] = *((const GAS f32x4*)modl + lane + 64 * j); sc[j] = *((const GAS f32x4*)(modl + D) + lane + 64 * j) + 1.f; }
    for (int m = gw; m < S; m += NGW) {
        const GAS f32x4* xr = (const GAS f32x4*)(x + (size_t)m * D) + lane;
        GAS u32x2* ho = (GAS u32x2*)(hout + (size_t)m * D) + lane;
#pragma unroll
        for (int j = 0; j < 16; ++j) { const f32x4 h = xr[64 * j] * sc[j] + sh[j]; u32x2 w; w.x = pk2(h[0], h[1]); w.y = pk2(h[2], h[3]); ho[64 * j] = w;
            if (h8) *((GAS unsigned*)(h8 + (size_t)m * D) + lane + 64 * j) = pk4_fp8(h); }
    }
}
__device__ __forceinline__ void ln_rows(const float* v, float* xout, bf16* hout, unsigned char* h8, const float* g, const float* b, const float* mod_next, int gw, int NGW, int lane) {
    for (int m = gw; m < S; m += NGW) {
        const GAS f32x4* vr = (const GAS f32x4*)(v + (size_t)m * D) + lane;
        f32x4 x[16]; float s = 0.f;
#pragma unroll
        for (int j = 0; j < 16; ++j) { x[j] = vr[64 * j]; s += (x[j][0] + x[j][1]) + (x[j][2] + x[j][3]); }
        const float mean = wave_sum(s) * (1.f / D); float s2 = 0.f;
#pragma unroll
        for (int j = 0; j < 16; ++j) { x[j] = x[j] - mean; s2 += (x[j][0] * x[j][0] + x[j][1] * x[j][1]) + (x[j][2] * x[j][2] + x[j][3] * x[j][3]); }
        const float rstd = 1.f / sqrtf(wave_sum(s2) * (1.f / D) + LN_EPS);
        GAS f32x4* xo = (GAS f32x4*)(xout + (size_t)m * D) + lane;
#pragma unroll
        for (int j = 0; j < 16; ++j) {
            const f32x4 gg = *((const GAS f32x4*)g + lane + 64 * j), bb = *((const GAS f32x4*)b + lane + 64 * j);
#ifdef OSCALE
            const f32x4 y = (x[j] * rstd * gg + bb) * (hout ? 1.f : OSCALE);
#else
            const f32x4 y = x[j] * rstd * gg + bb;
#endif
            xo[64 * j] = y;
            if (hout) {
                const f32x4 sh = *((const GAS f32x4*)mod_next + lane + 64 * j), scl = *((const GAS f32x4*)(mod_next + D) + lane + 64 * j);
                const f32x4 h = y * (scl + 1.f) + sh;
                u32x2 w; w.x = pk2(h[0], h[1]); w.y = pk2(h[2], h[3]);
                *((GAS u32x2*)(hout + (size_t)m * D) + lane + 64 * j) = w;
                if (h8) *((GAS unsigned*)(h8 + (size_t)m * D) + lane + 64 * j) = pk4_fp8(h);
            }
        }
    }
}
__device__ __forceinline__ void rstd_rows(const float* rsq_q, const float* rsq_kv, float* rstd_q, float* rstd_kv, int gtid, int NT) {
    for (int row = gtid; row < S; row += NT) {
        const GAS f32x4* rp = (const GAS f32x4*)(rsq_q + (size_t)row * 24); float ss = 0.f;
#pragma unroll
        for (int i = 0; i < 6; ++i) { const f32x4 t = rp[i]; ss += (t[0] + t[1]) + (t[2] + t[3]); }
        rstd_q[row] = 1.f / sqrtf(ss * (1.f / 768.f) + RMS_EPS);
        const GAS f32x4* rk = (const GAS f32x4*)(rsq_kv + (size_t)row * 16); float sk = 0.f;
#pragma unroll
        for (int i = 0; i < 4; ++i) { const f32x4 t = rk[i]; sk += (t[0] + t[1]) + (t[2] + t[3]); }
        rstd_kv[row] = 1.f / sqrtf(sk * (1.f / 512.f) + RMS_EPS);
    }
}
namespace pg8 {
#define PG8_LAS __attribute__((address_space(3)))
typedef unsigned short bf16_t;
typedef short bf16x8 __attribute__((ext_vector_type(8)));
typedef float f32x4 __attribute__((ext_vector_type(4)));
typedef unsigned u32x4 __attribute__((ext_vector_type(4)));
constexpr int BM = 256, BK = 64, HALF = 128, HTB = HALF * BK * 2  , STAGE_BYTES = 8 * HTB, NXCD = 8, WGM = 8;

__host__ __device__ __forceinline__ int lds_byte(int r, int c) { const int st = (r >> 4) * 2 + (c >> 5), rr = r & 15, cc = c & 31, ob = rr * 64 + cc * 2; return st * 1024 + (ob ^ (((ob >> 9) & 1) << 5)); }
__host__ __device__ __forceinline__ void stage_rc(int b, int& R, int& C) { const int st = b / 1024, sb = b % 1024, swz = sb ^ (((sb >> 9) & 1) << 5); R = (st >> 1) * 16 + swz / 64; C = (st & 1) * 32 + (swz % 64) / 2; }
__host__ __device__ __forceinline__ int perm32(int rho) { const int n = rho >> 4, i = rho & 15; return 8 * (i >> 2) + 4 * n + (i & 3); }

struct Unit { int pm, pn; };
struct Gemm { const bf16_t* A; const bf16_t* Bt; int M, N, K; };

struct StaticOrder {
    int nM, nN, nwg, G, c;
    __host__ __device__ void init(int M, int N, int G_, int c_) { nM = M / BM; nN = N / BM; nwg = nM * nN; G = G_; c = c_; }
    __host__ __device__ bool next(int i, Unit& u) const {
        const long L = (long)i * G + c; if (L >= nwg) return false;
        int wgid = (int)L; { const int q = nwg / NXCD, r = nwg % NXCD, xcd = wgid % NXCD, off = wgid / NXCD; wgid = (xcd < r ? xcd * (q + 1) : r * (q + 1) + (xcd - r) * q) + off; }
        const int nig = WGM * nN, gid = wgid / nig, fm = gid * WGM, gsz = (nM - fm) < WGM ? (nM - fm) : WGM;
        u.pm = fm + ((wgid % nig) % gsz); u.pn = (wgid % nig) / gsz; return true;
    }
    __device__ __forceinline__ void a_ready(const Unit&) const {}
    __device__ __forceinline__ void done(const Unit&) const {}
};
typedef int i32x8 __attribute__((ext_vector_type(8)));
typedef int i32x4 __attribute__((ext_vector_type(4)));
__device__ __forceinline__ i32x8 ld2x16(const PG8_LAS unsigned char* p) { const u32x4 a = *(const PG8_LAS u32x4*)p, b = *(const PG8_LAS u32x4*)(p + 1024);
    return (i32x8){(int)a.x, (int)a.y, (int)a.z, (int)a.w, (int)b.x, (int)b.y, (int)b.z, (int)b.w}; }
__device__ __forceinline__ i32x8 cat8(bf16x8 lo, bf16x8 hi) { const i32x4 a = __builtin_bit_cast(i32x4, lo), b = __builtin_bit_cast(i32x4, hi); return (i32x8){a[0], a[1], a[2], a[3], b[0], b[1], b[2], b[3]}; }
struct InBf16Order : StaticOrder {
    __device__ bool next(int i, Unit& u) const { if (!StaticOrder::next(i, u)) return false; u.pn = u.pn == 0 ? 5 : 13 + u.pn; return true; }
};
__device__ __forceinline__ f32x4 rope4(const f32x4 v, float c0, float s0, float c1, float s1) {
    f32x4 o; o[0] = v[0] * c0 - v[1] * s0; o[1] = v[1] * c0 + v[0] * s0; o[2] = v[2] * c1 - v[3] * s1; o[3] = v[3] * c1 + v[2] * s1; return o; }
#ifdef NOISE_BUILD
__device__ __forceinline__ f32x4 nz4(f32x4 v, int row, int col) {
    f32x4 o;
#pragma unroll
    for (int i = 0; i < 4; ++i) { unsigned h = (unsigned)row * 9216u + (unsigned)(col + i); h ^= h >> 16; h *= 0x7feb352du; h ^= h >> 15; h *= 0x846ca68bu; h ^= h >> 16;
        const float r = (float)(int)(h & 0xffffu) * (1.f / 32768.f) - 1.f; o[i] = v[i] * (1.f + NOISE_EPS * r); }
    return o; }
#define NZ(v, row, col) nz4((v), (row), (col))
#else
#define NZ(v, row, col) (v)
#endif
#ifdef MLA_FP8
__device__ __forceinline__ u32x2 pk8_fp8(f32x4 a, f32x4 b) {
    int w0 = __builtin_amdgcn_cvt_pk_fp8_f32(a[0], a[1], 0, false); w0 = __builtin_amdgcn_cvt_pk_fp8_f32(a[2], a[3], w0, true);
    int w1 = __builtin_amdgcn_cvt_pk_fp8_f32(b[0], b[1], 0, false); w1 = __builtin_amdgcn_cvt_pk_fp8_f32(b[2], b[3], w1, true);
    u32x2 r; r.x = (unsigned)w0; r.y = (unsigned)w1; return r; }
#endif
struct EpiIn {
    static constexpr bool PERM = true, AFTER_DRAIN = false;
    unsigned char* ws; int f8pass;
    __device__ __forceinline__ void operator()(const f32x4 (&acc)[2][2][4][2], const Unit& u, int wr, int wc, int fr, int fq) const {
        const int pn = f8pass ? (u.pn < 5 ? u.pn : u.pn + 1) : u.pn, row0 = u.pm * BM + wr * 64 + fr;
        if (pn < 5) {
            const bool isq = pn < 3; bf16_t* base = (bf16_t*)(ws + (isq ? WS_QLAT : WS_KVLAT)); const int ld = isq ? 768 : 512, ct = isq ? pn : pn - 3, ns = isq ? 24 : 16; float* rsq = (float*)(ws + (isq ? WS_RSQQ : WS_RSQKV));
#pragma unroll
            for (int ai = 0; ai < 2; ++ai)
#pragma unroll
                for (int m = 0; m < 4; ++m) { const int row = row0 + ai * HALF + m * 16;
#pragma unroll
                    for (int bj = 0; bj < 2; ++bj) { const f32x4 v0 = NZ(acc[ai][bj][m][0], row, pn * 256 + bj * 128 + wc * 32 + 8 * fq), v1 = NZ(acc[ai][bj][m][1], row, pn * 256 + bj * 128 + wc * 32 + 8 * fq + 4);
                        float ss = ((v0[0] * v0[0] + v0[1] * v0[1]) + (v0[2] * v0[2] + v0[3] * v0[3])) + ((v1[0] * v1[0] + v1[1] * v1[1]) + (v1[2] * v1[2] + v1[3] * v1[3]));
                        ss += __shfl_xor(ss, 16); ss += __shfl_xor(ss, 32);
                        if (fq == 0) rsq[(size_t)row * ns + ct * 8 + bj * 4 + wc] = ss;
#ifdef GEMM_F8
                        *(GAS u32x2*)((unsigned char*)base + (size_t)row * ld + ct * 256 + bj * HALF + wc * 32 + 8 * fq) = pk8_fp8(v0, v1); } }
#else
                        *(GAS u32x4*)(base + (size_t)row * ld + ct * 256 + bj * HALF + wc * 32 + 8 * fq) = pk8(v0, v1); } }
#endif
        } else if (pn == 5) {
            if (wc < 2) {
                const int i0 = 16 * wc + 4 * fq; const float* cosT = (const float*)(ws + WS_ROPE); const float* sinT = cosT + (size_t)S * 32; bf16_t* kmla = (bf16_t*)(ws + WS_KMLA);
#pragma unroll
                for (int ai = 0; ai < 2; ++ai)
#pragma unroll
                    for (int m = 0; m < 4; ++m) { const int row = row0 + ai * HALF + m * 16;
                        const f32x4 cs = *(const GAS f32x4*)(cosT + (size_t)row * 32 + i0), sn = *(const GAS f32x4*)(sinT + (size_t)row * 32 + i0);
#ifdef MLA_FP8
                        const u32x2 w = pk8_fp8(rope4(acc[ai][0][m][0], cs[0], sn[0], cs[1], sn[1]), rope4(acc[ai][0][m][1], cs[2], sn[2], cs[3], sn[3]));
                        unsigned char* dst = (unsigned char*)kmla + (size_t)row * 3072 + 128 + wc * 32 + 8 * fq;
#pragma unroll
                        for (int h = 0; h < 16; ++h) *(GAS u32x2*)(dst + h * 192) = w;
#else
                        const u32x4 w = pk8(rope4(acc[ai][0][m][0], cs[0], sn[0], cs[1], sn[1]), rope4(acc[ai][0][m][1], cs[2], sn[2], cs[3], sn[3]));
                        bf16_t* dst = kmla + (size_t)row * 3072 + 128 + wc * 32 + 8 * fq;
#pragma unroll
                        for (int h = 0; h < 16; ++h) *(GAS u32x4*)(dst + h * 192) = w;
#endif
                        asm volatile("" ::: "memory"); }
            } else {
                const int cl = (wc - 2) * 32 + 8 * fq; float* gnsa = (float*)(ws + WS_GNSA);
                if (cl < 48) {
#pragma unroll
                    for (int ai = 0; ai < 2; ++ai)
#pragma unroll
                        for (int m = 0; m < 4; ++m) { const int row = row0 + ai * HALF + m * 16; const f32x4 v0 = acc[ai][0][m][0], v1 = acc[ai][0][m][1];
                            f32x4 g0, g1; g0[0] = sigm_f(v0[0]); g0[1] = sigm_f(v0[1]); g0[2] = sigm_f(v0[2]); g0[3] = sigm_f(v0[3]); g1[0] = sigm_f(v1[0]); g1[1] = sigm_f(v1[1]); g1[2] = sigm_f(v1[2]); g1[3] = sigm_f(v1[3]);
                            *(GAS f32x4*)(gnsa + (size_t)row * 48 + cl) = g0; *(GAS f32x4*)(gnsa + (size_t)row * 48 + cl + 4) = g1; } }
            }
        } else {
            const int mode = (pn < 14) ? 0 : (pn < 22 ? 1 : (pn < 28 ? 2 : 0));
            bf16_t* base = (pn < 14) ? (bf16_t*)(ws + WS_ZMLA) + (pn - 6) * 256 : (pn < 22 ? (bf16_t*)(ws + WS_QNSA) + (pn - 14) * 256 : (bf16_t*)(ws + WS_ZNSA) + (pn - 28) * 256); bf16_t* kvnsa = (bf16_t*)(ws + WS_KVNSA);
#pragma unroll
            for (int ai = 0; ai < 2; ++ai)
#pragma unroll
                for (int m = 0; m < 4; ++m) { const int row = row0 + ai * HALF + m * 16;
#pragma unroll
                    for (int bj = 0; bj < 2; ++bj) { f32x4 v0 = NZ(acc[ai][bj][m][0], row, pn * 256 + bj * 128 + wc * 32 + 8 * fq), v1 = NZ(acc[ai][bj][m][1], row, pn * 256 + bj * 128 + wc * 32 + 8 * fq + 4);
                        if (mode == 0) { v0[0] = silu_f(v0[0]); v0[1] = silu_f(v0[1]); v0[2] = silu_f(v0[2]); v0[3] = silu_f(v0[3]); v1[0] = silu_f(v1[0]); v1[1] = silu_f(v1[1]); v1[2] = silu_f(v1[2]); v1[3] = silu_f(v1[3]); }
                        else if (mode == 1) { v0 = v0 * QS_NSA; v1 = v1 * QS_NSA; }
                        bf16_t* dst = (mode == 2) ? kvnsa + (size_t)(2 * (pn - 22) + bj) * ((size_t)S * 128) + (size_t)row * 128 + wc * 32 + 8 * fq
                                                  : base + (size_t)row * 2048 + bj * HALF + wc * 32 + 8 * fq;
                        *(GAS u32x4*)dst = pk8(v0, v1); } }
        }
    }
};
struct EpiQup {
    static constexpr bool PERM = true, AFTER_DRAIN = false;
    unsigned char* ws;
    __device__ __forceinline__ void operator()(const f32x4 (&acc)[2][2][4][2], const Unit& u, int wr, int wc, int fr, int fq) const {
        const int pn = u.pn, row0 = u.pm * BM + wr * 64 + fr; bf16_t* qmla = (bf16_t*)(ws + WS_QMLA); const float* rstd_q = (const float*)(ws + WS_RSTD); const float* cosT = (const float*)(ws + WS_ROPE); const float* sinT = cosT + (size_t)S * 32;
#pragma unroll
        for (int ai = 0; ai < 2; ++ai)
#pragma unroll
            for (int m = 0; m < 4; ++m) { const int row = row0 + ai * HALF + m * 16;
#ifdef MLA_FP8
#ifdef MLA_MXL
                const float sc = (QS_MLA * 8.f) * *(const GAS float*)(rstd_q + row);
#else
                const float sc = *(const GAS float*)(rstd_q + row);
#endif
                unsigned char* q8 = (unsigned char*)qmla + (size_t)row * 3072;
#pragma unroll
                for (int bj = 0; bj < 2; ++bj) { const f32x4 v0 = acc[ai][bj][m][0] * sc, v1 = acc[ai][bj][m][1] * sc;
                    if (pn < 8) { *(GAS u32x2*)(q8 + (2 * pn + bj) * 192 + wc * 32 + 8 * fq) = pk8_fp8(v0, v1); }
                    else { const int cp = (pn - 8) * 256 + bj * HALF + wc * 32 + 8 * fq, head = cp >> 6, dl = cp & 63, i0 = dl >> 1;
                        const f32x4 cs = *(const GAS f32x4*)(cosT + (size_t)row * 32 + i0), sn = *(const GAS f32x4*)(sinT + (size_t)row * 32 + i0);
                        *(GAS u32x2*)(q8 + head * 192 + 128 + dl) = pk8_fp8(rope4(v0, cs[0], sn[0], cs[1], sn[1]), rope4(v1, cs[2], sn[2], cs[3], sn[3])); } }
#else
                const float sc = QS_MLA * *(const GAS float*)(rstd_q + row);
#pragma unroll
                for (int bj = 0; bj < 2; ++bj) { const f32x4 v0 = acc[ai][bj][m][0] * sc, v1 = acc[ai][bj][m][1] * sc;
                    if (pn < 8) { *(GAS u32x4*)(qmla + (size_t)row * 3072 + (2 * pn + bj) * 192 + wc * 32 + 8 * fq) = pk8(v0, v1); }
                    else { const int cp = (pn - 8) * 256 + bj * HALF + wc * 32 + 8 * fq, head = cp >> 6, dl = cp & 63, i0 = dl >> 1;
                        const f32x4 cs = *(const GAS f32x4*)(cosT + (size_t)row * 32 + i0), sn = *(const GAS f32x4*)(sinT + (size_t)row * 32 + i0);
                        *(GAS u32x4*)(qmla + (size_t)row * 3072 + head * 192 + 128 + dl) = pk8(rope4(v0, cs[0], sn[0], cs[1], sn[1]), rope4(v1, cs[2], sn[2], cs[3], sn[3])); } }
#endif
                if (m & 1) asm volatile("" ::: "memory"); }
    }
};
struct EpiKvup {
    static constexpr bool PERM = true, AFTER_DRAIN = false;
    unsigned char* ws;
    __device__ __forceinline__ void operator()(const f32x4 (&acc)[2][2][4][2], const Unit& u, int wr, int wc, int fr, int fq) const {
        const int pn = u.pn, row0 = u.pm * BM + wr * 64 + fr;
#pragma unroll
        for (int ai = 0; ai < 2; ++ai)
#pragma unroll
            for (int m = 0; m < 4; ++m) { const int row = row0 + ai * HALF + m * 16;
                const float sc = *(const GAS float*)((const float*)(ws + WS_RSTD) + S + row); bf16_t* kmla = (bf16_t*)(ws + WS_KMLA); bf16_t* vmla = (bf16_t*)(ws + WS_VMLA);
#ifdef MLA_FP8
                *(GAS u32x2*)((unsigned char*)kmla + (size_t)row * 3072 + pn * 192 + wc * 32 + 8 * fq) = pk8_fp8(acc[ai][0][m][0] * sc, acc[ai][0][m][1] * sc);
#else
                *(GAS u32x4*)(kmla + (size_t)row * 3072 + pn * 192 + wc * 32 + 8 * fq) = pk8(acc[ai][0][m][0] * sc, acc[ai][0][m][1] * sc);
#endif
                *(GAS u32x4*)(vmla + (size_t)row * 2048 + pn * 128 + wc * 32 + 8 * fq) = pk8(acc[ai][1][m][0] * sc, acc[ai][1][m][1] * sc);
                if (m & 1) asm volatile("" ::: "memory"); }
    }
};
#ifdef MLA_FP8V
struct EpiKup {
    static constexpr bool PERM = true, AFTER_DRAIN = false;
    unsigned char* ws;
    __device__ __forceinline__ void operator()(const f32x4 (&acc)[2][2][4][2], const Unit& u, int wr, int wc, int fr, int fq) const {
        const int pn = u.pn, row0 = u.pm * BM + wr * 64 + fr;
#pragma unroll
        for (int ai = 0; ai < 2; ++ai)
#pragma unroll
            for (int m = 0; m < 4; ++m) { const int row = row0 + ai * HALF + m * 16;
                const float sc = *(const GAS float*)((const float*)(ws + WS_RSTD) + S + row); unsigned char* k8 = ws + WS_KMLA + (size_t)row * 3072;
#pragma unroll
                for (int bj = 0; bj < 2; ++bj) *(GAS u32x2*)(k8 + (2 * pn + bj) * 192 + wc * 32 + 8 * fq) = pk8_fp8(acc[ai][bj][m][0] * sc, acc[ai][bj][m][1] * sc);
                if (m & 1) asm volatile("" ::: "memory"); }
    }
};
struct EpiVt {
    static constexpr bool PERM = true, AFTER_DRAIN = false;
    unsigned char* ws;
    __device__ __forceinline__ void operator()(const f32x4 (&acc)[2][2][4][2], const Unit& u, int wr, int wc, int fr, int fq) const {
        const int row0 = u.pm * BM + wr * 64 + fr, col0 = u.pn * BM + wc * 32 + 8 * fq;
        const float* rs = (const float*)(ws + WS_RSTD) + S;
        f32x4 sc[2][2];
#pragma unroll
        for (int bj = 0; bj < 2; ++bj) { sc[bj][0] = *(const GAS f32x4*)(rs + col0 + bj * HALF); sc[bj][1] = *(const GAS f32x4*)(rs + col0 + bj * HALF + 4); }
        const int hi8 = (col0 >> 3) & 1; (void)hi8;
#pragma unroll
        for (int ai = 0; ai < 2; ++ai)
#pragma unroll
            for (int m = 0; m < 4; ++m) { unsigned char* vt = ws + WS_VMLA + (size_t)(row0 + ai * HALF + m * 16) * S;
#pragma unroll
                for (int bj = 0; bj < 2; ++bj) { const u32x2 w = pk8_fp8(acc[ai][bj][m][0] * sc[bj][0], acc[ai][bj][m][1] * sc[bj][1]);
#ifdef MLA_MX
                    unsigned char* d64 = vt + ((col0 + bj * HALF) & ~63) + 4 * ((col0 >> 3) & 7);
                    *(GAS unsigned*)(d64) = w.x; *(GAS unsigned*)(d64 + 32) = w.y; } }
#else
                    unsigned char* d16 = vt + ((col0 + bj * HALF) & ~15);
                    *(GAS unsigned*)(d16 + (hi8 ? 4 : 0)) = w.x; *(GAS unsigned*)(d16 + (hi8 ? 12 : 8)) = w.y; } }
#endif
    }
};
#endif
struct EpiOut {
    static constexpr bool PERM = false, AFTER_DRAIN = false;
    const float* x; float* xv; const float* gate;
    __device__ __forceinline__ void operator()(const f32x4 (&acc)[2][2][4][2], const Unit& u, int wr, int wc, int fr, int fq) const {
        const int row0 = u.pm * BM + wr * 64 + fr, col0 = u.pn * BM + wc * 32 + 4 * fq;
        f32x4 gv[2][2];
#pragma unroll
        for (int bj = 0; bj < 2; ++bj)
#pragma unroll
            for (int n = 0; n < 2; ++n) gv[bj][n] = *(const GAS f32x4*)(gate + col0 + bj * HALF + n * 16);
#pragma unroll
        for (int ai = 0; ai < 2; ++ai)
#pragma unroll
            for (int m = 0; m < 4; ++m) { const size_t off = (size_t)(row0 + ai * HALF + m * 16) * D + col0;
#pragma unroll
                for (int bj = 0; bj < 2; ++bj)
#pragma unroll
                    for (int n = 0; n < 2; ++n) { const f32x4 xx = *(const GAS f32x4*)(x + off + bj * HALF + n * 16);
                        #ifdef YSCALE
                        *(GAS f32x4*)(xv + off + bj * HALF + n * 16) = xx * DN_ALPHA + gv[bj][n] * acc[ai][bj][m][n] * YSCALE; }
#else
                        *(GAS f32x4*)(xv + off + bj * HALF + n * 16) = xx * DN_ALPHA + gv[bj][n] * acc[ai][bj][m][n]; }
#endif
                if (m & 1) asm volatile("" ::: "memory"); }
    }
};
template <class Epi, class Sched, bool ALIGN_EPI = false, bool SP2 = false, int SCB = 0, int SCA = 0>
__device__ __forceinline__ void gemm_phase(PG8_LAS unsigned char* lds, const Gemm g, const Sched& S, const Epi& E) {
    int tid_ = threadIdx.x; asm volatile("" : "+v"(tid_));
    const int tid = tid_, wid = __builtin_amdgcn_readfirstlane(tid >> 6), lane = tid & 63, wr = wid >> 2, wc = wid & 3, fr = lane & 15, fq = lane >> 4;
    const int K = g.K, nt = K / BK;
    unsigned voffA[2], voffB[2];
#pragma unroll
    for (int i = 0; i < 2; ++i) { int R, C; stage_rc(tid * 16 + i * 8192, R, C); const int Rb = Epi::PERM ? ((R & ~31) + perm32(R & 31)) : R;
        voffA[i] = (unsigned)(R * K + C) * 2u; voffB[i] = (unsigned)(Rb * K + C) * 2u; }
    const size_t kstep = (size_t)(BK * 2);
    const size_t hstep = (size_t)HALF * K * 2;
    const size_t tstep = 2 * hstep;
    const unsigned ldsw = (unsigned)wid * 1024u;
    const int aoff = lds_byte(wr * 64 + fr, fq * 8), boff = lds_byte(wc * 32 + fr, fq * 8);
#define PG8_SA(b, h) (((b) * 2 + (h)) * HTB)
#define PG8_SB(b, h) ((4 + (b) * 2 + (h)) * HTB)
#define PG8_STAGE(bufoff, gbase, voff) do { _Pragma("unroll") for (int _i = 0; _i < 2; ++_i) \
        __builtin_amdgcn_global_load_lds((const unsigned*)((const char*)(gbase) + (voff)[_i]), (PG8_LAS unsigned*)(lds + (bufoff) + ldsw + _i * 8192), 16, 0, 0); } while (0)
#define PG8_LDA(dst, b, h) do { if constexpr (SCB != 0) { _Pragma("unroll") for (int m = 0; m < 4; ++m) dst##8[m] = ld2x16(lds + PG8_SA(b, h) + aoff + m * 2048); } \
        else { _Pragma("unroll") for (int m = 0; m < 4; ++m) _Pragma("unroll") for (int k = 0; k < 2; ++k) dst[m][k] = *(const PG8_LAS bf16x8*)(lds + PG8_SA(b, h) + aoff + m * 2048 + k * 1024); } } while (0)
#define PG8_LDB(dst, b, h) do { if constexpr (SCB != 0) { _Pragma("unroll") for (int n = 0; n < 2; ++n) dst##8[n] = ld2x16(lds + PG8_SB(b, h) + boff + n * 2048); } \
        else { _Pragma("unroll") for (int n = 0; n < 2; ++n) _Pragma("unroll") for (int k = 0; k < 2; ++k) dst[n][k] = *(const PG8_LAS bf16x8*)(lds + PG8_SB(b, h) + boff + n * 2048 + k * 1024); } } while (0)
#define PG8_MMA(ai, bj, At, Bt) do { __builtin_amdgcn_s_setprio(1); \
        if constexpr (SCB != 0) { _Pragma("unroll") for (int m = 0; m < 4; ++m) _Pragma("unroll") for (int n = 0; n < 2; ++n) \
            asm volatile("v_mfma_scale_f32_16x16x128_f8f6f4 %0, %1, %2, %0, %3, %4 op_sel_hi:[0,0,0]" : "+v"(acc[ai][bj][m][n]) : "v"(Bt##8[n]), "v"(At##8[m]), "v"(scb_), "v"(sca_)); } \
        else { _Pragma("unroll") for (int m = 0; m < 4; ++m) _Pragma("unroll") for (int n = 0; n < 2; ++n) _Pragma("unroll") for (int k = 0; k < 2; ++k) \
            acc[ai][bj][m][n] = __builtin_amdgcn_mfma_f32_16x16x32_bf16(Bt[n][k], At[m][k], acc[ai][bj][m][n], 0, 0, 0); } \
        __builtin_amdgcn_s_setprio(0); } while (0)
#define PG8_WAIT_V(n) asm volatile("s_waitcnt vmcnt(" #n ")" ::: "memory")
#define PG8_WAIT_L(n) asm volatile("s_waitcnt lgkmcnt(" #n ")" ::: "memory")
#define PG8_BAR __builtin_amdgcn_s_barrier()
#define PG8_SCHED __builtin_amdgcn_sched_barrier(0)
    Unit cur, nxt; int ui = 0;
    if (!S.next(0, cur)) return;
    f32x4 acc[2][2][4][2];
#pragma unroll
    for (int a = 0; a < 2; ++a)
#pragma unroll
        for (int b = 0; b < 2; ++b)
#pragma unroll
            for (int m = 0; m < 4; ++m)
#pragma unroll
                for (int n = 0; n < 2; ++n) acc[a][b][m][n] = (f32x4){0.f, 0.f, 0.f, 0.f};
    int scb_ = SCB, sca_ = SCA; asm volatile("" : "+v"(scb_), "+v"(sca_));
    bf16x8 At[4][2], B0[2][2], B1[2][2]; i32x8 At8[4], B08[2], B18[2];
    const char* cA = (const char*)g.A + (size_t)cur.pm * tstep; const char* cB = (const char*)g.Bt + (size_t)cur.pn * tstep;
    S.a_ready(cur);
    if constexpr (SP2) {
        PG8_STAGE(PG8_SB(0, 0), cB, voffB); PG8_STAGE(PG8_SB(0, 1), cB + hstep, voffB); PG8_STAGE(PG8_SA(0, 0), cA, voffA); PG8_STAGE(PG8_SA(0, 1), cA + hstep, voffA);
        if (wr == 1) PG8_BAR;
        PG8_WAIT_V(2); PG8_BAR;
        PG8_STAGE(PG8_SB(1, 0), cB + kstep, voffB); PG8_STAGE(PG8_SA(1, 0), cA + kstep, voffA); PG8_STAGE(PG8_SB(1, 1), cB + hstep + kstep, voffB);
        PG8_WAIT_V(6); PG8_BAR;
    } else {
        PG8_STAGE(PG8_SB(0, 0), cB, voffB); PG8_STAGE(PG8_SA(0, 0), cA, voffA); PG8_STAGE(PG8_SB(0, 1), cB + hstep, voffB); PG8_STAGE(PG8_SA(0, 1), cA + hstep, voffA);
        if (wr == 1) PG8_BAR;
        PG8_WAIT_V(4); PG8_BAR;
        PG8_STAGE(PG8_SB(1, 0), cB + kstep, voffB); PG8_STAGE(PG8_SA(1, 0), cA + kstep, voffA); PG8_STAGE(PG8_SB(1, 1), cB + hstep + kstep, voffB);
        PG8_WAIT_V(6); PG8_BAR;
    }
    for (;;) {
        const bool has_next = S.next(ui + 1, nxt);
        const char* nA = has_next ? (const char*)g.A + (size_t)nxt.pm * tstep : cA; const char* nB = has_next ? (const char*)g.Bt + (size_t)nxt.pn * tstep : cB;
#pragma unroll 1
        for (int t = 0; t < nt; t += 2) {
            const bool last = (t == nt - 2);
            const char* a1 = cA + (size_t)(t + 1) * kstep;
            const char* a2 = last ? nA : cA + (size_t)(t + 2) * kstep; const char* b2 = last ? nB : cB + (size_t)(t + 2) * kstep;
            const char* a3 = a2 + kstep; const char* b3 = b2 + kstep;
            if (last && has_next) S.a_ready(nxt);
            if constexpr (SP2) {
            PG8_LDB(B0, 0, 0); PG8_LDB(B1, 0, 1); PG8_SCHED; PG8_LDA(At, 0, 0); PG8_STAGE(PG8_SA(1, 1), a1 + hstep, voffA);
            PG8_WAIT_V(8); PG8_WAIT_L(0); PG8_BAR; PG8_MMA(0, 0, At, B0); PG8_MMA(0, 1, At, B1); PG8_BAR; PG8_SCHED;
            PG8_LDA(At, 0, 1); PG8_STAGE(PG8_SB(0, 0), b2, voffB); PG8_STAGE(PG8_SB(0, 1), b2 + hstep, voffB); PG8_STAGE(PG8_SA(0, 0), a2, voffA);
            PG8_WAIT_V(8); PG8_WAIT_L(0); PG8_BAR; PG8_MMA(1, 0, At, B0); PG8_MMA(1, 1, At, B1); PG8_BAR; PG8_SCHED;
            PG8_LDB(B0, 1, 0); PG8_LDB(B1, 1, 1); PG8_SCHED; PG8_LDA(At, 1, 0); PG8_STAGE(PG8_SA(0, 1), a2 + hstep, voffA);
            PG8_WAIT_V(8); PG8_WAIT_L(0); PG8_BAR; PG8_MMA(0, 0, At, B0); PG8_MMA(0, 1, At, B1); PG8_BAR; PG8_SCHED;
            PG8_LDA(At, 1, 1); PG8_STAGE(PG8_SB(1, 0), b3, voffB); PG8_STAGE(PG8_SB(1, 1), b3 + hstep, voffB); PG8_STAGE(PG8_SA(1, 0), a3, voffA);
            PG8_WAIT_V(8); PG8_WAIT_L(0); PG8_BAR; PG8_MMA(1, 0, At, B0); PG8_MMA(1, 1, At, B1); PG8_BAR; PG8_SCHED;
            } else {
            PG8_LDB(B0, 0, 0); PG8_SCHED; PG8_LDA(At, 0, 0); PG8_STAGE(PG8_SA(1, 1), a1 + hstep, voffA);
            PG8_WAIT_L(8); PG8_BAR; PG8_WAIT_L(0); PG8_MMA(0, 0, At, B0); PG8_BAR; PG8_SCHED;
            PG8_LDB(B1, 0, 1); PG8_STAGE(PG8_SB(0, 0), b2, voffB);
            PG8_BAR; PG8_WAIT_L(0); PG8_MMA(0, 1, At, B1); PG8_BAR;
            PG8_LDA(At, 0, 1); PG8_STAGE(PG8_SA(0, 0), a2, voffA);
            PG8_BAR; PG8_WAIT_L(0); PG8_MMA(1, 0, At, B0); PG8_BAR; PG8_SCHED;
            PG8_STAGE(PG8_SB(0, 1), b2 + hstep, voffB);
            PG8_WAIT_V(6); PG8_BAR; PG8_MMA(1, 1, At, B1); PG8_BAR;
            PG8_LDB(B0, 1, 0); PG8_SCHED; PG8_LDA(At, 1, 0); PG8_STAGE(PG8_SA(0, 1), a2 + hstep, voffA);
            PG8_WAIT_L(8); PG8_BAR; PG8_WAIT_L(0); PG8_MMA(0, 0, At, B0); PG8_BAR; PG8_SCHED;
            PG8_LDB(B1, 1, 1); PG8_STAGE(PG8_SB(1, 0), b3, voffB);
            PG8_BAR; PG8_WAIT_L(0); PG8_MMA(0, 1, At, B1); PG8_BAR;
            PG8_LDA(At, 1, 1); PG8_STAGE(PG8_SA(1, 0), a3, voffA);
            PG8_BAR; PG8_WAIT_L(0); PG8_MMA(1, 0, At, B0); PG8_BAR; PG8_SCHED;
            PG8_STAGE(PG8_SB(1, 1), b3 + hstep, voffB);
            PG8_WAIT_V(6); PG8_BAR; PG8_MMA(1, 1, At, B1); PG8_BAR;
            }
        }
        if constexpr (SCB != 0) asm volatile("s_nop 15\n\ts_nop 15" ::: "memory");
        if constexpr (ALIGN_EPI) { if (wr == 0) PG8_BAR; }
        if constexpr (!Epi::AFTER_DRAIN) { int fr_ = fr, fq_ = fq; asm volatile("" : "+v"(fr_), "+v"(fq_));
            E(acc, cur, wr, wc, fr_, fq_); S.done(cur); }
        if (!has_next) break;
#pragma unroll
        for (int a = 0; a < 2; ++a)
#pragma unroll
            for (int b = 0; b < 2; ++b)
#pragma unroll
                for (int m = 0; m < 4; ++m)
#pragma unroll
                    for (int n = 0; n < 2; ++n) acc[a][b][m][n] = (f32x4){0.f, 0.f, 0.f, 0.f};
        cur = nxt; cA = nA; cB = nB; ++ui;
        if constexpr (ALIGN_EPI) { if (wr == 1) PG8_BAR; }
    }
    PG8_WAIT_V(0);
    if constexpr (!ALIGN_EPI) { if (wr == 0) PG8_BAR; }
    PG8_BAR;
    if constexpr (Epi::AFTER_DRAIN) { E.fused(acc, cur, wr, wc, fr, fq, lds, wid, lane); S.done(cur); }
#undef PG8_SA
#undef PG8_SB
#undef PG8_STAGE
#undef PG8_LDA
#undef PG8_LDB
#undef PG8_MMA
#undef PG8_WAIT_V
#undef PG8_WAIT_L
#undef PG8_BAR
#undef PG8_SCHED
}
}
namespace att {
constexpr int KS_M = 400, KS_N = 272, VS = 320;
constexpr int MLA_KB = 64 * KS_M, NSA_KB = 64 * KS_N, VB = 64 * VS;
constexpr int N_IMP = 2 * NSA_KB + 2 * VB;
constexpr int N_PART = N_IMP + 32768;
constexpr int N_PARTB = 8 * 32 * 17 * 4;
constexpr int N_SELM = N_PART + 2 * N_PARTB;
constexpr int N_ULIST = N_SELM + 1024;
constexpr int N_CARRY = N_ULIST + 1024;
constexpr int N_NTS = N_CARRY + 256;
static_assert(N_NTS + 16 <= MISC_OFF, "NSA LDS map");
static_assert(2 * MLA_KB + 3 * VB <= 131072, "MLA LDS map");
constexpr int MLA_QL = 2 * MLA_KB + 2 * VB;
static_assert(MLA_QL + 8 * 4096 <= 131072, "MLA LDS map (pipelined)");

#ifndef QK_PF
#define QK_PF 4
#endif
#define MFMA32(a, b, c) __builtin_amdgcn_mfma_f32_32x32x16_bf16((a), (b), (c), 0, 0, 0)
__device__ __forceinline__ float swapmax(float v) { auto rr = __builtin_amdgcn_permlane32_swap(__float_as_uint(v), __float_as_uint(v), false, false); return fmaxf(__uint_as_float(rr[0]), __uint_as_float(rr[1])); }
__device__ __forceinline__ float swapsum(float v) { auto rr = __builtin_amdgcn_permlane32_swap(__float_as_uint(v), __float_as_uint(v), false, false); return __uint_as_float(rr[0]) + __uint_as_float(rr[1]); }
template <int SIDX> __device__ __forceinline__ bf16x8 packp(const f32x16& p) {
    f32x8 t = {p[8 * SIDX + 0], p[8 * SIDX + 1], p[8 * SIDX + 2], p[8 * SIDX + 3], p[8 * SIDX + 4], p[8 * SIDX + 5], p[8 * SIDX + 6], p[8 * SIDX + 7]};
    return __builtin_bit_cast(bf16x8, __builtin_convertvector(t, bf16x8v));
}
template <int NDC, int KS, bool ZERO = true> __device__ __forceinline__ void qk_tile(f32x16& p0, f32x16& p1, const LAS unsigned char* kl, const bf16x8 (&q)[NDC]) {
    if (ZERO) {
#pragma unroll
        for (int i = 0; i < 16; ++i) { p0[i] = 0.f; p1[i] = 0.f; }
    }
    constexpr int PF = QK_PF;
    bf16x8 a[PF + 1][2];
#pragma unroll
    for (int i = 0; i < PF; ++i) { a[i][0] = *(const LAS bf16x8*)(kl + i * 32); a[i][1] = *(const LAS bf16x8*)(kl + 32 * KS + i * 32); }
#pragma unroll
    for (int d0 = 0; d0 < NDC; ++d0) {
        if (d0 + PF < NDC) { a[(d0 + PF) % (PF + 1)][0] = *(const LAS bf16x8*)(kl + (d0 + PF) * 32); a[(d0 + PF) % (PF + 1)][1] = *(const LAS bf16x8*)(kl + 32 * KS + (d0 + PF) * 32); }
        __builtin_amdgcn_sched_barrier(0);
        p0 = MFMA32(a[d0 % (PF + 1)][0], q[d0], p0); p1 = MFMA32(a[d0 % (PF + 1)][1], q[d0], p1);
        __builtin_amdgcn_sched_barrier(0);
    }
}
#ifdef PROBE_QKM2
template <int NDC, int KS> __device__ __forceinline__ void qk_tile_m2(f32x16& p0, f32x16& p1, f32x16& r0, f32x16& r1, const LAS unsigned char* kl, const bf16x8 (&q)[NDC]) {
#pragma unroll
    for (int i = 0; i < 16; ++i) { p0[i] = 0.f; p1[i] = 0.f; r0[i] = 0.f; r1[i] = 0.f; }
    constexpr int PF = QK_PF;
    bf16x8 a[PF + 1][2];
#pragma unroll
    for (int i = 0; i < PF; ++i) { a[i][0] = *(const LAS bf16x8*)(kl + i * 32); a[i][1] = *(const LAS bf16x8*)(kl + 32 * KS + i * 32); }
#pragma unroll
    for (int d0 = 0; d0 < NDC; ++d0) {
        if (d0 + PF < NDC) { a[(d0 + PF) % (PF + 1)][0] = *(const LAS bf16x8*)(kl + (d0 + PF) * 32); a[(d0 + PF) % (PF + 1)][1] = *(const LAS bf16x8*)(kl + 32 * KS + (d0 + PF) * 32); }
        __builtin_amdgcn_sched_barrier(0);
        p0 = MFMA32(a[d0 % (PF + 1)][0], q[d0], p0); p1 = MFMA32(a[d0 % (PF + 1)][1], q[d0], p1);
        r0 = MFMA32(a[d0 % (PF + 1)][0], q[d0], r0); r1 = MFMA32(a[d0 % (PF + 1)][1], q[d0], r1);
        __builtin_amdgcn_sched_barrier(0);
    }
}
#endif
__device__ __forceinline__ void pv_tile(f32x16 (&o)[4], const bf16x8 (&pb)[4], const LAS unsigned char* vl) {
    s16x4 f[5][2];
#define PV_LD(idx) do { constexpr int d_ = (idx) >> 2, s_ = (idx) & 3; \
        f[(idx) % 5][0] = __builtin_amdgcn_ds_read_tr16_b64_v4i16((LAS s16x4*)(vl + s_ * 16 * VS + d_ * 64)); \
        f[(idx) % 5][1] = __builtin_amdgcn_ds_read_tr16_b64_v4i16((LAS s16x4*)(vl + s_ * 16 * VS + 8 * VS + d_ * 64)); } while (0)
    PV_LD(0); PV_LD(1); PV_LD(2); PV_LD(3);
#define PV_STEP(idx) do { if ((idx) + 4 < 16) PV_LD((idx) + 4); __builtin_amdgcn_sched_barrier(0); \
        { const s16x4 t0_ = f[(idx) % 5][0], t1_ = f[(idx) % 5][1]; const bf16x8 vf_ = {t0_[0], t0_[1], t0_[2], t0_[3], t1_[0], t1_[1], t1_[2], t1_[3]}; \
          o[(idx) >> 2] = MFMA32(vf_, pb[(idx) & 3], o[(idx) >> 2]); } __builtin_amdgcn_sched_barrier(0); } while (0)
    PV_STEP(0); PV_STEP(1); PV_STEP(2); PV_STEP(3); PV_STEP(4); PV_STEP(5); PV_STEP(6); PV_STEP(7);
    PV_STEP(8); PV_STEP(9); PV_STEP(10); PV_STEP(11); PV_STEP(12); PV_STEP(13); PV_STEP(14); PV_STEP(15);
#undef PV_STEP
#undef PV_LD
}
template <int NDC, int NQR, int KS> __device__ __forceinline__ void qk_tile_free(f32x16& p0, f32x16& p1, const LAS unsigned char* kl, const bf16x8 (&q)[NQR], const LAS unsigned char* ql) {
#pragma unroll
    for (int i = 0; i < 16; ++i) { p0[i] = 0.f; p1[i] = 0.f; }
#pragma unroll
    for (int d0 = 0; d0 < NDC; ++d0) {
        const bf16x8 a0 = *(const LAS bf16x8*)(kl + d0 * 32);
        const bf16x8 a1 = *(const LAS bf16x8*)(kl + 32 * KS + d0 * 32);
        bf16x8 qq; if (d0 < NQR) qq = q[d0 < NQR ? d0 : 0]; else qq = *(const LAS bf16x8*)(ql + (d0 - NQR) * 1024);
        p0 = MFMA32(a0, qq, p0); p1 = MFMA32(a1, qq, p1);
    }
}
__device__ __forceinline__ float sm_core(f32x16& p0, f32x16& p1, float& m, float& l) {
    float tm = p0[0];
#pragma unroll
    for (int r = 1; r < 16; ++r) tm = fmaxf(tm, p0[r]);
#pragma unroll
    for (int r = 0; r < 16; ++r) tm = fmaxf(tm, p1[r]);
    tm = swapmax(tm);
    const float mn = fmaxf(m, tm);
    const float alpha = __builtin_amdgcn_exp2f(m - mn);
    m = mn;
    float ps = 0.f;
#pragma unroll
    for (int r = 0; r < 16; ++r) { p0[r] = __builtin_amdgcn_exp2f(p0[r] - mn); ps += p0[r]; }
#pragma unroll
    for (int r = 0; r < 16; ++r) { p1[r] = __builtin_amdgcn_exp2f(p1[r] - mn); ps += p1[r]; }
    ps = swapsum(ps);
    l = l * alpha + ps;
    return alpha;
}
__device__ __forceinline__ void online_sm(f32x16& p0, f32x16& p1, float& m, float& l, f32x16 (&o)[4]) {
    float tm = p0[0];
#pragma unroll
    for (int r = 1; r < 16; ++r) tm = fmaxf(tm, p0[r]);
#pragma unroll
    for (int r = 0; r < 16; ++r) tm = fmaxf(tm, p1[r]);
    tm = swapmax(tm);
    const float mn = fmaxf(m, tm);
    const float alpha = __builtin_amdgcn_exp2f(m - mn);
    m = mn;
    float ps = 0.f;
#pragma unroll
    for (int r = 0; r < 16; ++r) { p0[r] = __builtin_amdgcn_exp2f(p0[r] - mn); ps += p0[r]; }
#pragma unroll
    for (int r = 0; r < 16; ++r) { p1[r] = __builtin_amdgcn_exp2f(p1[r] - mn); ps += p1[r]; }
    ps = swapsum(ps);
    l = l * alpha + ps;
    if (!__all(alpha == 1.f)) {
#pragma unroll
        for (int d = 0; d < 4; ++d)
#pragma unroll
            for (int r = 0; r < 16; ++r) o[d][r] *= alpha;
    }
}

#ifdef MLA_FP8
typedef long i64;
constexpr int KS8 = 200, MLA_KB8 = 64 * KS8;
static_assert(2 * MLA_KB8 + 3 * VB <= 131072, "MLA fp8 LDS map");
#define MFMA32F8(a, b, c) __builtin_amdgcn_mfma_f32_32x32x16_fp8_fp8((a), (b), (c), 0, 0, 0)
template <int NDC> __device__ __forceinline__ void qk_tile8(f32x16& p0, f32x16& p1, const LAS unsigned char* kl, const i64 (&q)[NDC]) {
#pragma unroll
    for (int i = 0; i < 16; ++i) { p0[i] = 0.f; p1[i] = 0.f; }
    constexpr int PF = 4;
    i64 a[PF + 1][2];
#pragma unroll
    for (int i = 0; i < PF; ++i) { a[i][0] = *(const LAS i64*)(kl + i * 16); a[i][1] = *(const LAS i64*)(kl + 32 * KS8 + i * 16); }
#pragma unroll
    for (int d0 = 0; d0 < NDC; ++d0) {
        if (d0 + PF < NDC) { a[(d0 + PF) % (PF + 1)][0] = *(const LAS i64*)(kl + (d0 + PF) * 16); a[(d0 + PF) % (PF + 1)][1] = *(const LAS i64*)(kl + 32 * KS8 + (d0 + PF) * 16); }
        __builtin_amdgcn_sched_barrier(0);
        __builtin_amdgcn_s_setprio(1);
        p0 = MFMA32F8(a[d0 % (PF + 1)][0], q[d0], p0); p1 = MFMA32F8(a[d0 % (PF + 1)][1], q[d0], p1);
        __builtin_amdgcn_s_setprio(0);
        __builtin_amdgcn_sched_barrier(0);
    }
}
__device__ __forceinline__ void online_sm_scaled(f32x16& p0, f32x16& p1, float& m, float& l, f32x16 (&o)[4], const float C2) {
    float tm = p0[0];
#pragma unroll
    for (int r = 1; r < 16; ++r) tm = fmaxf(tm, p0[r]);
#pragma unroll
    for (int r = 0; r < 16; ++r) tm = fmaxf(tm, p1[r]);
    tm = swapmax(tm);
    const float mn = fmaxf(m, tm);
    const float alpha = __builtin_amdgcn_exp2f((m - mn) * C2);
    m = mn;
    const float mc = -mn * C2;
    float ps = 0.f;
#pragma unroll
    for (int r = 0; r < 16; ++r) { p0[r] = __builtin_amdgcn_exp2f(__builtin_fmaf(p0[r], C2, mc)); ps += p0[r]; }
#pragma unroll
    for (int r = 0; r < 16; ++r) { p1[r] = __builtin_amdgcn_exp2f(__builtin_fmaf(p1[r], C2, mc)); ps += p1[r]; }
    ps = swapsum(ps);
    l = l * alpha + ps;
    if (!__all(alpha == 1.f)) {
#pragma unroll
        for (int d = 0; d < 4; ++d)
#pragma unroll
            for (int r = 0; r < 16; ++r) o[d][r] *= alpha;
    }
}
#endif
#ifdef MLA_FP8V
constexpr int VS8 = 72, VB8 = 128 * VS8;
constexpr int VS8B = 136, VB8B = 128 * VS8B, MLA_KB8B = 128 * KS8;
static_assert(2 * MLA_KB8B + 3 * VB8B <= 131072, "MLA big-tile LDS map");
#ifdef MLA_BIG
#define PV8_RS VS8B
#else
#define PV8_RS VS8
#endif
static_assert(2 * MLA_KB8 + 3 * VB8 <= 131072, "MLA fp8 LDS map");
template <int SIDX> __device__ __forceinline__ i64 packp8(const f32x16& p) {
    int w0 = __builtin_amdgcn_cvt_pk_fp8_f32(p[8 * SIDX + 0] * 256.f, p[8 * SIDX + 1] * 256.f, 0, false); w0 = __builtin_amdgcn_cvt_pk_fp8_f32(p[8 * SIDX + 2] * 256.f, p[8 * SIDX + 3] * 256.f, w0, true);
    int w1 = __builtin_amdgcn_cvt_pk_fp8_f32(p[8 * SIDX + 4] * 256.f, p[8 * SIDX + 5] * 256.f, 0, false); w1 = __builtin_amdgcn_cvt_pk_fp8_f32(p[8 * SIDX + 6] * 256.f, p[8 * SIDX + 7] * 256.f, w1, true);
    return (i64)(((unsigned long long)(unsigned)w1 << 32) | (unsigned)w0);
}
__device__ __forceinline__ void pv_tile8(f32x16 (&o)[4], const i64 (&pb)[4], const LAS unsigned char* vl) {
    i64 f[5];
#define PV8_LD(idx) f[(idx) % 5] = *(const LAS i64*)(vl + ((idx) >> 2) * 32 * PV8_RS + ((idx) & 3) * 16)
    PV8_LD(0); PV8_LD(1); PV8_LD(2); PV8_LD(3);
#define PV8_STEP(idx) do { if ((idx) + 4 < 16) PV8_LD((idx) + 4); __builtin_amdgcn_sched_barrier(0); \
        o[(idx) >> 2] = MFMA32F8(f[(idx) % 5], pb[(idx) & 3], o[(idx) >> 2]); __builtin_amdgcn_sched_barrier(0); } while (0)
    PV8_STEP(0); PV8_STEP(1); PV8_STEP(2); PV8_STEP(3); PV8_STEP(4); PV8_STEP(5); PV8_STEP(6); PV8_STEP(7);
    PV8_STEP(8); PV8_STEP(9); PV8_STEP(10); PV8_STEP(11); PV8_STEP(12); PV8_STEP(13); PV8_STEP(14); PV8_STEP(15);
#undef PV8_STEP
#undef PV8_LD
}
#endif
#ifdef MLA_MX
typedef int i32x8 __attribute__((ext_vector_type(8)));
constexpr int KSX = 208, MLA_KBX = 64 * KSX;
constexpr int VSX = 80, VBX = 128 * VSX;
static_assert(2 * MLA_KBX + 3 * VBX <= 131072, "MLA mx LDS map");
#define MFMAX(a, b, c) __builtin_amdgcn_mfma_scale_f32_32x32x64_f8f6f4((a), (b), (c), 0, 0, 0, 0x7f7f7f7f, 0, 0x7f7f7f7f)
__device__ __forceinline__ i32x8 ldsx(const LAS unsigned char* p) {
    const u32x4 a = *(const LAS u32x4*)p, b = *(const LAS u32x4*)(p + 16);
    return (i32x8){(int)a.x, (int)a.y, (int)a.z, (int)a.w, (int)b.x, (int)b.y, (int)b.z, (int)b.w};
}
__device__ __forceinline__ void qk_tilex(f32x16& p0, f32x16& p1, const LAS unsigned char* kl, const i32x8 (&q)[3]) {
#pragma unroll
    for (int i = 0; i < 16; ++i) { p0[i] = 0.f; p1[i] = 0.f; }
    i32x8 a0 = ldsx(kl), a1 = ldsx(kl + 32 * KSX), a2 = ldsx(kl + 64), a3 = ldsx(kl + 32 * KSX + 64);
    __builtin_amdgcn_sched_barrier(0);
    __builtin_amdgcn_s_setprio(1);
    p0 = MFMAX(a0, q[0], p0); p1 = MFMAX(a1, q[0], p1);
    __builtin_amdgcn_s_setprio(0);
    __builtin_amdgcn_sched_barrier(0);
    a0 = ldsx(kl + 128); a1 = ldsx(kl + 32 * KSX + 128);
    __builtin_amdgcn_sched_barrier(0);
    __builtin_amdgcn_s_setprio(1);
    p0 = MFMAX(a2, q[1], p0); p1 = MFMAX(a3, q[1], p1);
    __builtin_amdgcn_sched_barrier(0);
    p0 = MFMAX(a0, q[2], p0); p1 = MFMAX(a1, q[2], p1);
    __builtin_amdgcn_s_setprio(0);
    __builtin_amdgcn_sched_barrier(0);
}
__device__ __forceinline__ void pv_tilex(f32x16 (&o)[4], const i32x8& pb, const LAS unsigned char* vl) {
    i32x8 f0 = ldsx(vl), f1 = ldsx(vl + 32 * VSX);
    __builtin_amdgcn_sched_barrier(0);
    o[0] = MFMAX(f0, pb, o[0]);
    __builtin_amdgcn_sched_barrier(0);
    f0 = ldsx(vl + 64 * VSX);
    __builtin_amdgcn_sched_barrier(0);
    o[1] = MFMAX(f1, pb, o[1]);
    __builtin_amdgcn_sched_barrier(0);
    f1 = ldsx(vl + 96 * VSX);
    __builtin_amdgcn_sched_barrier(0);
    o[2] = MFMAX(f0, pb, o[2]);
    __builtin_amdgcn_sched_barrier(0);
    o[3] = MFMAX(f1, pb, o[3]);
    __builtin_amdgcn_sched_barrier(0);
}
__device__ __forceinline__ i32x8 packpx(const f32x16& p0, const f32x16& p1) {
    i32x8 w;
#pragma unroll
    for (int g = 0; g < 4; ++g) {
        int a = __builtin_amdgcn_cvt_pk_fp8_f32(p0[4 * g + 0], p0[4 * g + 1], 0, false); a = __builtin_amdgcn_cvt_pk_fp8_f32(p0[4 * g + 2], p0[4 * g + 3], a, true); w[g] = a;
        int b = __builtin_amdgcn_cvt_pk_fp8_f32(p1[4 * g + 0], p1[4 * g + 1], 0, false); b = __builtin_amdgcn_cvt_pk_fp8_f32(p1[4 * g + 2], p1[4 * g + 3], b, true); w[4 + g] = b;
    }
    return w;
}
__device__ __forceinline__ void online_sm_x(f32x16& p0, f32x16& p1, float& m, float& l, f32x16 (&o)[4], const float C2) {
    float tm = p0[0];
#pragma unroll
    for (int r = 1; r < 16; ++r) tm = fmaxf(tm, p0[r]);
#pragma unroll
    for (int r = 0; r < 16; ++r) tm = fmaxf(tm, p1[r]);
    tm = swapmax(tm);
    const float mn = fmaxf(m, tm);
    const float alpha = __builtin_amdgcn_exp2f((m - mn) * C2);
    m = mn;
    const float mc = 8.f - mn * C2;
    float ps = 0.f;
#pragma unroll
    for (int r = 0; r < 16; ++r) { p0[r] = __builtin_amdgcn_exp2f(__builtin_fmaf(p0[r], C2, mc)); ps += p0[r]; }
#pragma unroll
    for (int r = 0; r < 16; ++r) { p1[r] = __builtin_amdgcn_exp2f(__builtin_fmaf(p1[r], C2, mc)); ps += p1[r]; }
    ps = swapsum(ps);
    l = l * alpha + ps;
    if (!__all(alpha == 1.f)) {
#pragma unroll
        for (int d = 0; d < 4; ++d)
#pragma unroll
            for (int r = 0; r < 16; ++r) o[d][r] *= alpha;
    }
}
#endif
#ifdef MLA_MXL
#ifdef MLA_MXU
#define MXL_T 126.0f
#define MXL_REF 120.0f
#define MFMAXQ(a, b, c) __builtin_amdgcn_mfma_scale_f32_32x32x64_f8f6f4((a), (b), (c), 0, 0, 0, 0x7f7f7f7f, 0, 0x7f7f7f7f)
__device__ __forceinline__ i32x8 byte_packx(const f32x16& p0, const f32x16& p1) {
    i32x8 w;
#pragma unroll
    for (int g = 0; g < 4; ++g) {
        unsigned a = __builtin_amdgcn_cvt_pk_u8_f32(p0[4 * g + 0], 0, 0u); a = __builtin_amdgcn_cvt_pk_u8_f32(p0[4 * g + 1], 1, a); a = __builtin_amdgcn_cvt_pk_u8_f32(p0[4 * g + 2], 2, a); a = __builtin_amdgcn_cvt_pk_u8_f32(p0[4 * g + 3], 3, a); w[g] = (int)a;
        unsigned b = __builtin_amdgcn_cvt_pk_u8_f32(p1[4 * g + 0], 0, 0u); b = __builtin_amdgcn_cvt_pk_u8_f32(p1[4 * g + 1], 1, b); b = __builtin_amdgcn_cvt_pk_u8_f32(p1[4 * g + 2], 2, b); b = __builtin_amdgcn_cvt_pk_u8_f32(p1[4 * g + 3], 3, b); w[4 + g] = (int)b;
    }
    return w;
}
#else
#define MXL_T 7.0f
#define MXL_REF 0.0f
#define MFMAXQ(a, b, c) __builtin_amdgcn_mfma_scale_f32_32x32x64_f8f6f4((a), (b), (c), 0, 0, 0, 0x7f7f7f7f, 0, 0x7c7c7c7c)
#endif
__device__ __forceinline__ void qk_tilexl(f32x16& p0, f32x16& p1, const f32x16& mref, const LAS unsigned char* kl, const i32x8 (&q)[3]) {
    i32x8 a0 = ldsx(kl), a1 = ldsx(kl + 32 * KSX), a2 = ldsx(kl + 64), a3 = ldsx(kl + 32 * KSX + 64);
    __builtin_amdgcn_sched_barrier(0);
    __builtin_amdgcn_s_setprio(1);
    p0 = MFMAXQ(a0, q[0], mref); p1 = MFMAXQ(a1, q[0], mref);
    __builtin_amdgcn_s_setprio(0);
    __builtin_amdgcn_sched_barrier(0);
    a0 = ldsx(kl + 128); a1 = ldsx(kl + 32 * KSX + 128);
    __builtin_amdgcn_sched_barrier(0);
    __builtin_amdgcn_s_setprio(1);
    p0 = MFMAXQ(a2, q[1], p0); p1 = MFMAXQ(a3, q[1], p1);
    __builtin_amdgcn_sched_barrier(0);
    p0 = MFMAXQ(a0, q[2], p0); p1 = MFMAXQ(a1, q[2], p1);
    __builtin_amdgcn_s_setprio(0);
    __builtin_amdgcn_sched_barrier(0);
}
__device__ __forceinline__ void pv_tilexl(f32x16 (&o)[5], const i32x8& pb, const i32x8& ones, const LAS unsigned char* vl) {
    i32x8 f0 = ldsx(vl), f1 = ldsx(vl + 32 * VSX);
    __builtin_amdgcn_sched_barrier(0);
    o[4] = MFMAX(ones, pb, o[4]);
    __builtin_amdgcn_sched_barrier(0);
    o[0] = MFMAX(f0, pb, o[0]);
    __builtin_amdgcn_sched_barrier(0);
    f0 = ldsx(vl + 64 * VSX);
    __builtin_amdgcn_sched_barrier(0);
    o[1] = MFMAX(f1, pb, o[1]);
    __builtin_amdgcn_sched_barrier(0);
    f1 = ldsx(vl + 96 * VSX);
    __builtin_amdgcn_sched_barrier(0);
    o[2] = MFMAX(f0, pb, o[2]);
    __builtin_amdgcn_sched_barrier(0);
    o[3] = MFMAX(f1, pb, o[3]);
    __builtin_amdgcn_sched_barrier(0);
}
__device__ __forceinline__ i32x8 exp_packx(const f32x16& p0, const f32x16& p1, int any) {
    i32x8 w;
#pragma unroll
    for (int g = 0; g < 4; ++g) {
        int a = __builtin_amdgcn_cvt_pk_fp8_f32(__builtin_amdgcn_exp2f(p0[4 * g + 0]), __builtin_amdgcn_exp2f(p0[4 * g + 1]), any, false);
        a = __builtin_amdgcn_cvt_pk_fp8_f32(__builtin_amdgcn_exp2f(p0[4 * g + 2]), __builtin_amdgcn_exp2f(p0[4 * g + 3]), a, true); w[g] = a;
        int b = __builtin_amdgcn_cvt_pk_fp8_f32(__builtin_amdgcn_exp2f(p1[4 * g + 0]), __builtin_amdgcn_exp2f(p1[4 * g + 1]), any, false);
        b = __builtin_amdgcn_cvt_pk_fp8_f32(__builtin_amdgcn_exp2f(p1[4 * g + 2]), __builtin_amdgcn_exp2f(p1[4 * g + 3]), b, true); w[4 + g] = b;
    }
    return w;
}
#endif
#ifdef MLA_PIPE8
template <int NDC> __device__ __forceinline__ void qk_tile8_free(f32x16& p0, f32x16& p1, const LAS unsigned char* kl, const i64 (&q)[NDC]) {
#pragma unroll
    for (int i = 0; i < 16; ++i) { p0[i] = 0.f; p1[i] = 0.f; }
#pragma unroll
    for (int d0 = 0; d0 < NDC; ++d0) {
        const i64 a0 = *(const LAS i64*)(kl + d0 * 16), a1 = *(const LAS i64*)(kl + 32 * KS8 + d0 * 16);
        p0 = MFMA32F8(a0, q[d0], p0); p1 = MFMA32F8(a1, q[d0], p1);
    }
}
__device__ __forceinline__ float sm_core_scaled(f32x16& p0, f32x16& p1, float& m, float& l, const float C2) {
    float tm = p0[0];
#pragma unroll
    for (int r = 1; r < 16; ++r) tm = fmaxf(tm, p0[r]);
#pragma unroll
    for (int r = 0; r < 16; ++r) tm = fmaxf(tm, p1[r]);
    tm = swapmax(tm);
    const float mn = fmaxf(m, tm);
    const float alpha = __builtin_amdgcn_exp2f((m - mn) * C2);
    m = mn;
    const float mc = -mn * C2;
    float ps = 0.f;
#pragma unroll
    for (int r = 0; r < 16; ++r) { p0[r] = __builtin_amdgcn_exp2f(__builtin_fmaf(p0[r], C2, mc)); ps += p0[r]; }
#pragma unroll
    for (int r = 0; r < 16; ++r) { p1[r] = __builtin_amdgcn_exp2f(__builtin_fmaf(p1[r], C2, mc)); ps += p1[r]; }
    ps = swapsum(ps);
    l = l * alpha + ps;
    return alpha;
}
#endif
#ifdef MLA_PIPE8
struct MlaPtrs { const bf16* Q; const bf16* K; const bf16* V; const bf16* Z; bf16* O; };
__device__ __forceinline__ void mla_mask(f32x16& p0, f32x16& p1, int dq) {
#pragma unroll
    for (int r = 0; r < 16; ++r) { const int c = (r & 3) + 8 * (r >> 2);
        if (c > dq) p0[r] = -__builtin_inff();
        if (c + 32 > dq) p1[r] = -__builtin_inff(); }
}
__device__ __forceinline__ void mla_unit(LAS unsigned char* lds, const MlaPtrs& P, int head, int qb, int tid_in, int wave, int lane_in) {
    int tid = tid_in; asm volatile("" : "+v"(tid)); const int lane = tid & 63; (void)lane_in;
    const int r32 = lane & 31, hi = lane >> 5;
    const int q0 = qb * 256, qw = q0 + wave * 32, tq = qw + r32;
    i64 q[12];
    { const unsigned char* qp = (const unsigned char*)P.Q + (size_t)tq * 3072 + head * 192 + hi * 8;
#pragma unroll
      for (int d0 = 0; d0 < 12; ++d0) q[d0] = *(const GAS i64*)(qp + d0 * 16); }
    const int NT = 4 * (qb + 1);
    const int srow = tid >> 3, sc8 = tid & 7;
    const unsigned char* kg = (const unsigned char*)P.K + (size_t)head * 192 + (size_t)srow * 3072 + sc8 * 8;
    const unsigned char* vg = (const unsigned char*)P.V + ((size_t)head * 128 + (tid >> 2)) * S + (tid & 3) * 16;
    LAS unsigned char* kst = lds + srow * KS8 + sc8 * 8;
    LAS unsigned char* vst = lds + 2 * MLA_KB8 + (tid >> 2) * VS8 + (tid & 3) * 16;
    const LAS unsigned char* kl = lds + r32 * KS8 + hi * 8;
    const LAS unsigned char* vl = lds + 2 * MLA_KB8 + r32 * VS8 + hi * 8;
    u32x2 sk0, sk1, sk2; u32x4 sv0;
#define MLA_LOADK(j) do { const unsigned char* kp_ = kg + (size_t)(j) * (64 * 3072); sk0 = *(const GAS u32x2*)(kp_); sk1 = *(const GAS u32x2*)(kp_ + 64); sk2 = *(const GAS u32x2*)(kp_ + 128); } while (0)
#define MLA_LOADV(j) do { sv0 = *(const GAS u32x4*)(vg + (size_t)(j) * 64); } while (0)
#define MLA_STOREK(b) do { LAS unsigned char* kd_ = kst + (b) * MLA_KB8; *(LAS u32x2*)(kd_) = sk0; *(LAS u32x2*)(kd_ + 64) = sk1; *(LAS u32x2*)(kd_ + 128) = sk2; } while (0)
#define MLA_STOREV(b) do { LAS unsigned char* vd_ = vst + (b) * VB8; *(LAS u32x2*)(vd_) = (u32x2){sv0.x, sv0.y}; *(LAS u32x2*)(vd_ + 8) = (u32x2){sv0.z, sv0.w}; } while (0)
    float m = -1e30f, l = 0.f; f32x16 o[4];
#pragma unroll
    for (int d = 0; d < 4; ++d)
#pragma unroll
        for (int r = 0; r < 16; ++r) o[d][r] = 0.f;
    f32x16 pA0, pA1, pB0, pB1;
    MLA_LOADK(0); MLA_LOADV(0); MLA_STOREK(0); MLA_STOREV(0);
    MLA_LOADK(1);
    __syncthreads();
    qk_tile8<12>(pA0, pA1, kl, q);
    if (63 > qw) mla_mask(pA0, pA1, tq - 4 * hi);
    MLA_STOREK(1);
    if (2 < NT) MLA_LOADK(2);
    MLA_LOADV(1);
    __syncthreads();
#define MLA_SGB1() do { __builtin_amdgcn_sched_group_barrier(0x100, 2, 0); __builtin_amdgcn_sched_group_barrier(0x008, 1, 0); __builtin_amdgcn_sched_group_barrier(0x002, 6, 0); \
        __builtin_amdgcn_sched_group_barrier(0x008, 1, 0); __builtin_amdgcn_sched_group_barrier(0x002, 6, 0); } while (0)
#define MLA_SGB() do { MLA_SGB1(); MLA_SGB1(); MLA_SGB1(); MLA_SGB1(); MLA_SGB1(); MLA_SGB1(); MLA_SGB1(); MLA_SGB1(); MLA_SGB1(); MLA_SGB1(); MLA_SGB1(); MLA_SGB1(); } while (0)
#define MLA_STEP(PX0, PX1, PY0, PY1, j) do { \
        const int kb1_ = 64 * ((j) + 1); \
        const bool a1_ = ((j) + 1 < NT) && (kb1_ <= qw + 31), a0_ = (64 * (j) <= qw + 31); \
        float alpha_ = 1.f; i64 pb_[4]; \
        if (a1_) { \
            __builtin_amdgcn_sched_barrier(0); \
            qk_tile8_free<12>(PY0, PY1, kl + (((j) + 1) & 1) * MLA_KB8, q); \
            alpha_ = sm_core_scaled(PX0, PX1, m, l, QS_MLA); \
            pb_[0] = packp8<0>(PX0); pb_[1] = packp8<1>(PX0); pb_[2] = packp8<0>(PX1); pb_[3] = packp8<1>(PX1); \
            MLA_SGB(); \
            __builtin_amdgcn_sched_barrier(0); \
            if (kb1_ + 63 > qw) mla_mask(PY0, PY1, tq - kb1_ - 4 * hi); \
        } else if (a0_) { \
            alpha_ = sm_core_scaled(PX0, PX1, m, l, QS_MLA); \
            pb_[0] = packp8<0>(PX0); pb_[1] = packp8<1>(PX0); pb_[2] = packp8<0>(PX1); pb_[3] = packp8<1>(PX1); \
        } \
        if (a0_) { \
            if (!__all(alpha_ == 1.f)) { _Pragma("unroll") for (int d_ = 0; d_ < 4; ++d_) _Pragma("unroll") for (int r_ = 0; r_ < 16; ++r_) o[d_][r_] *= alpha_; } \
            pv_tile8(o, pb_, vl + ((j) & 1) * VB8); \
        } \
        if ((j) + 2 < NT) MLA_STOREK((j) & 1); \
        if ((j) + 1 < NT) MLA_STOREV(((j) + 1) & 1); \
        if ((j) + 3 < NT) MLA_LOADK((j) + 3); \
        if ((j) + 2 < NT) MLA_LOADV((j) + 2); \
        __syncthreads(); } while (0)
    for (int j = 0; j < NT; j += 2) {
        MLA_STEP(pA0, pA1, pB0, pB1, j);
        MLA_STEP(pB0, pB1, pA0, pA1, j + 1);
    }
#undef MLA_STEP
#undef MLA_SGB
#undef MLA_SGB1
#undef MLA_LOADK
#undef MLA_LOADV
#undef MLA_STOREK
#undef MLA_STOREV
    const float inv = (1.f / 256.f) / l;
    const bf16* zp = P.Z + (size_t)tq * 2048 + head * 128 + 4 * hi;
    bf16* op = P.O + (size_t)tq * 4096 + head * 128 + 4 * hi;
#pragma unroll
    for (int d0 = 0; d0 < 4; ++d0)
#pragma unroll
        for (int rg = 0; rg < 4; ++rg) { const int dim = 32 * d0 + 8 * rg;
            const u32x2 z = *(const GAS u32x2*)(zp + dim);
            u32x2 w; w.x = pk2(o[d0][4 * rg + 0] * inv * bflo(z.x), o[d0][4 * rg + 1] * inv * bfhi(z.x)); w.y = pk2(o[d0][4 * rg + 2] * inv * bflo(z.y), o[d0][4 * rg + 3] * inv * bfhi(z.y));
            *(GAS u32x2*)(op + dim) = w; }
}
#elif defined(MLA_PIPE)
struct MlaPtrs { const bf16* Q; const bf16* K; const bf16* V; const bf16* Z; bf16* O; };
__device__ __forceinline__ void mla_mask(f32x16& p0, f32x16& p1, int dq) {
#pragma unroll
    for (int r = 0; r < 16; ++r) { const int c = (r & 3) + 8 * (r >> 2);
        if (c > dq) p0[r] = -__builtin_inff();
        if (c + 32 > dq) p1[r] = -__builtin_inff(); }
}
__device__ __forceinline__ void mla_unit(LAS unsigned char* lds, const MlaPtrs& P, int head, int qb, int tid_in, int wave, int lane_in) {
    int tid = tid_in; asm volatile("" : "+v"(tid)); const int lane = tid & 63; (void)lane_in;
    const int r32 = lane & 31, hi = lane >> 5;
    const int q0 = qb * 256, qw = q0 + wave * 32, tq = qw + r32;
    bf16x8 q[8];
    LAS unsigned char* ql = lds + MLA_QL + wave * 4096 + lane * 16;
    { const bf16* qp = P.Q + (size_t)tq * 3072 + head * 192 + hi * 8;
#pragma unroll
      for (int d0 = 0; d0 < 8; ++d0) q[d0] = *(const GAS bf16x8*)(qp + d0 * 16);
#pragma unroll
      for (int d0 = 8; d0 < 12; ++d0) *(LAS bf16x8*)(ql + (d0 - 8) * 1024) = *(const GAS bf16x8*)(qp + d0 * 16); }
    const int NT = 4 * (qb + 1);
    const int srow = tid >> 3, sc8 = tid & 7;
    const unsigned char* kg = (const unsigned char*)P.K + (size_t)head * 384 + (size_t)srow * 6144 + sc8 * 16;
    const unsigned char* vg = (const unsigned char*)P.V + (size_t)head * 256 + (size_t)srow * 4096 + sc8 * 16;
    LAS unsigned char* kst = lds + srow * KS_M + sc8 * 16;
    LAS unsigned char* vst = lds + 2 * MLA_KB + srow * VS + sc8 * 16;
    const LAS unsigned char* kl = lds + r32 * KS_M + hi * 16;
    const LAS unsigned char* vl = lds + 2 * MLA_KB + (4 * hi + ((lane & 15) >> 2)) * VS + (16 * ((lane >> 4) & 1) + 4 * (lane & 3)) * 2;
    u32x4 sk0, sk1, sk2, sv0, sv1;
#define MLA_LOADK(j) do { const unsigned char* kp_ = kg + (size_t)(j) * (64 * 6144); sk0 = *(const GAS u32x4*)(kp_); sk1 = *(const GAS u32x4*)(kp_ + 128); sk2 = *(const GAS u32x4*)(kp_ + 256); } while (0)
#define MLA_LOADV(j) do { const unsigned char* vp_ = vg + (size_t)(j) * (64 * 4096); sv0 = *(const GAS u32x4*)(vp_); sv1 = *(const GAS u32x4*)(vp_ + 128); } while (0)
#define MLA_STOREK(b) do { LAS unsigned char* kd_ = kst + (b) * MLA_KB; *(LAS u32x4*)(kd_) = sk0; *(LAS u32x4*)(kd_ + 128) = sk1; *(LAS u32x4*)(kd_ + 256) = sk2; } while (0)
#define MLA_STOREV(b) do { LAS unsigned char* vd_ = vst + (b) * VB; *(LAS u32x4*)(vd_) = sv0; *(LAS u32x4*)(vd_ + 128) = sv1; } while (0)
    float m = -1e30f, l = 0.f; f32x16 o[4];
#pragma unroll
    for (int d = 0; d < 4; ++d)
#pragma unroll
        for (int r = 0; r < 16; ++r) o[d][r] = 0.f;
    f32x16 pA0, pA1, pB0, pB1;
    MLA_LOADK(0); MLA_LOADV(0); MLA_STOREK(0); MLA_STOREV(0);
    MLA_LOADK(1);
    __syncthreads();
    qk_tile_free<12, 8, KS_M>(pA0, pA1, kl, q, ql);
    if (63 > qw) mla_mask(pA0, pA1, tq - 4 * hi);
    MLA_STOREK(1);
    if (2 < NT) MLA_LOADK(2);
    MLA_LOADV(1);
    __syncthreads();
#define MLA_SGB1(NR) do { __builtin_amdgcn_sched_group_barrier(0x100, NR, 0); __builtin_amdgcn_sched_group_barrier(0x008, 1, 0); __builtin_amdgcn_sched_group_barrier(0x002, 6, 0); \
        __builtin_amdgcn_sched_group_barrier(0x008, 1, 0); __builtin_amdgcn_sched_group_barrier(0x002, 6, 0); } while (0)
#define MLA_SGB() do { MLA_SGB1(2); MLA_SGB1(2); MLA_SGB1(2); MLA_SGB1(2); MLA_SGB1(2); MLA_SGB1(2); MLA_SGB1(2); MLA_SGB1(2); MLA_SGB1(3); MLA_SGB1(3); MLA_SGB1(3); MLA_SGB1(3); } while (0)
#define MLA_STEP(PX0, PX1, PY0, PY1, j) do { \
        const int kb1_ = 64 * ((j) + 1); \
        const bool a1_ = ((j) + 1 < NT) && (kb1_ <= qw + 31), a0_ = (64 * (j) <= qw + 31); \
        float alpha_ = 1.f; bf16x8 pb_[4]; \
        if (a1_) { \
            __builtin_amdgcn_sched_barrier(0); \
            qk_tile_free<12, 8, KS_M>(PY0, PY1, kl + (((j) + 1) & 1) * MLA_KB, q, ql); \
            alpha_ = sm_core(PX0, PX1, m, l); \
            pb_[0] = packp<0>(PX0); pb_[1] = packp<1>(PX0); pb_[2] = packp<0>(PX1); pb_[3] = packp<1>(PX1); \
            MLA_SGB(); \
            __builtin_amdgcn_sched_barrier(0); \
            if (kb1_ + 63 > qw) mla_mask(PY0, PY1, tq - kb1_ - 4 * hi); \
        } else if (a0_) { \
            alpha_ = sm_core(PX0, PX1, m, l); \
            pb_[0] = packp<0>(PX0); pb_[1] = packp<1>(PX0); pb_[2] = packp<0>(PX1); pb_[3] = packp<1>(PX1); \
        } \
        if (a0_) { \
            if (!__all(alpha_ == 1.f)) { _Pragma("unroll") for (int d_ = 0; d_ < 4; ++d_) _Pragma("unroll") for (int r_ = 0; r_ < 16; ++r_) o[d_][r_] *= alpha_; } \
            pv_tile(o, pb_, vl + ((j) & 1) * VB); \
        } \
        if ((j) + 2 < NT) MLA_STOREK((j) & 1); \
        if ((j) + 1 < NT) MLA_STOREV(((j) + 1) & 1); \
        if ((j) + 3 < NT) MLA_LOADK((j) + 3); \
        if ((j) + 2 < NT) MLA_LOADV((j) + 2); \
        __syncthreads(); } while (0)
    for (int j = 0; j < NT; j += 2) {
        MLA_STEP(pA0, pA1, pB0, pB1, j);
        MLA_STEP(pB0, pB1, pA0, pA1, j + 1);
    }
#undef MLA_STEP
#undef MLA_SGB
#undef MLA_SGB1
#undef MLA_LOADK
#undef MLA_LOADV
#undef MLA_STOREK
#undef MLA_STOREV
    const float inv = 1.f / l;
    const bf16* zp = P.Z + (size_t)tq * 2048 + head * 128 + 4 * hi;
    bf16* op = P.O + (size_t)tq * 4096 + head * 128 + 4 * hi;
#pragma unroll
    for (int d0 = 0; d0 < 4; ++d0)
#pragma unroll
        for (int rg = 0; rg < 4; ++rg) { const int dim = 32 * d0 + 8 * rg;
            const u32x2 z = *(const GAS u32x2*)(zp + dim);
            u32x2 w; w.x = pk2(o[d0][4 * rg + 0] * inv * bflo(z.x), o[d0][4 * rg + 1] * inv * bfhi(z.x)); w.y = pk2(o[d0][4 * rg + 2] * inv * bflo(z.y), o[d0][4 * rg + 3] * inv * bfhi(z.y));
            *(GAS u32x2*)(op + dim) = w; }
}

#else
#if defined(MLA_MXL)
struct MlaPtrs { const bf16* Q; const bf16* K; const bf16* V; const bf16* Z; bf16* O; };
__device__ __forceinline__ void mla_unit(LAS unsigned char* lds, const MlaPtrs& P, int head, int qb, int tid_in, int wave, int lane_in) {
    int tid = tid_in; asm volatile("" : "+v"(tid)); const int lane = tid & 63; (void)lane_in;
    const int r32 = lane & 31, hi = lane >> 5;
    const int q0 = qb * 256, qw = q0 + wave * 32, tq = qw + r32;
    i32x8 q[3];
    { const unsigned char* qp = (const unsigned char*)P.Q + (size_t)tq * 3072 + head * 192 + hi * 32;
#pragma unroll
      for (int s = 0; s < 3; ++s) { const u32x4 a = *(const GAS u32x4*)(qp + 64 * s), b = *(const GAS u32x4*)(qp + 64 * s + 16);
          q[s] = (i32x8){(int)a.x, (int)a.y, (int)a.z, (int)a.w, (int)b.x, (int)b.y, (int)b.z, (int)b.w}; } }
    const int NT = 4 * (qb + 1);
    const int srow = tid >> 3, sc8 = tid & 7;
    const unsigned char* kg = (const unsigned char*)P.K + (size_t)head * 192 + (size_t)srow * 3072 + sc8 * 8;
    const unsigned char* vg = (const unsigned char*)P.V + ((size_t)head * 128 + (tid >> 2)) * S + (tid & 3) * 16;
    LAS unsigned char* kst = lds + srow * KSX + sc8 * 8;
    LAS unsigned char* vst = lds + 2 * MLA_KBX + (tid >> 2) * VSX + (tid & 3) * 16;
    const LAS unsigned char* kl = lds + r32 * KSX + hi * 32;
    const LAS unsigned char* vl = lds + 2 * MLA_KBX + r32 * VSX + hi * 32;
    u32x2 sk0, sk1, sk2; u32x4 sv0;
#define MLA_LOAD(j) do { const unsigned char* kp_ = kg + (size_t)(j) * (64 * 3072); const unsigned char* vp_ = vg + (size_t)(j) * 64; \
        sk0 = *(const GAS u32x2*)(kp_); sk1 = *(const GAS u32x2*)(kp_ + 64); sk2 = *(const GAS u32x2*)(kp_ + 128); sv0 = *(const GAS u32x4*)(vp_); } while (0)
#define MLA_STORE(b, vb) do { LAS unsigned char* kd_ = kst + (b) * MLA_KBX; LAS unsigned char* vd_ = vst + (vb) * VBX; \
        *(LAS u32x2*)(kd_) = sk0; *(LAS u32x2*)(kd_ + 64) = sk1; *(LAS u32x2*)(kd_ + 128) = sk2; *(LAS u32x2*)(vd_) = (u32x2){sv0.x, sv0.y}; *(LAS u32x2*)(vd_ + 8) = (u32x2){sv0.z, sv0.w}; } while (0)
    MLA_LOAD(0); MLA_STORE(0, 0);
    __syncthreads();
    asm volatile("" : "+v"(q[0]), "+v"(q[1]), "+v"(q[2]));
    f32x16 o[5], mref;
#pragma unroll
    for (int d = 0; d < 5; ++d)
#pragma unroll
        for (int r = 0; r < 16; ++r) o[d][r] = 0.f;
#pragma unroll
    for (int r = 0; r < 16; ++r) mref[r] = MXL_REF;
    const int one8 = (r32 == 0 || r32 == 4) ? 0x38383838 : 0;
    const i32x8 ones = {one8, one8, one8, one8, one8, one8, one8, one8};
    const bool trail = wave >= 4;
    i32x8 pb = {};
    int vb_cur = 0, vb_prev = 2;
    for (int j = 0; j < NT; ++j) {
        const int kb = 64 * j;
        int vb_next = vb_cur + 1; if (vb_next == 3) vb_next = 0;
        if (j + 1 < NT) MLA_LOAD(j + 1);
        if (trail && j > 0 && kb - 64 <= qw + 31) pv_tilexl(o, pb, ones, vl + vb_prev * VBX);
        if (kb <= qw + 31) {
            f32x16 p0, p1;
            qk_tilexl(p0, p1, mref, kl + (j & 1) * MLA_KBX, q);
            if (kb + 63 > qw) {
                const int dq = tq - kb - 4 * hi;
#pragma unroll
                for (int r = 0; r < 16; ++r) { const int c = (r & 3) + 8 * (r >> 2);
                    if (c > dq) p0[r] = -__builtin_inff();
                    if (c + 32 > dq) p1[r] = -__builtin_inff(); }
            }
            float tm = p0[0];
#pragma unroll
            for (int r = 1; r < 16; ++r) tm = fmaxf(tm, p0[r]);
#pragma unroll
            for (int r = 0; r < 16; ++r) tm = fmaxf(tm, p1[r]);
            tm = swapmax(tm);
            if (j == 0 || !__all(tm <= MXL_T)) {
#ifdef MLA_MXU
                const float dlt = (j == 0) ? tm - MXL_REF : fmaxf(tm - MXL_REF, 0.f);
                const float alpha = __builtin_amdgcn_exp2f(-0.125f * dlt);
#else
                const float dlt = (j == 0) ? tm : fmaxf(tm, 0.f);
                const float alpha = __builtin_amdgcn_exp2f(-dlt);
#endif
#pragma unroll
                for (int r = 0; r < 16; ++r) { p0[r] -= dlt; p1[r] -= dlt; mref[r] -= dlt; }
                if (j > 0) {
#pragma unroll
                    for (int d = 0; d < 5; ++d)
#pragma unroll
                        for (int r = 0; r < 16; ++r) o[d][r] *= alpha;
                }
            }
#ifdef MLA_MXU
            pb = byte_packx(p0, p1);
#else
            pb = exp_packx(p0, p1, one8);
#endif
            if (!trail) pv_tilexl(o, pb, ones, vl + vb_cur * VBX);
        }
        if (j + 1 < NT) MLA_STORE((j + 1) & 1, vb_next);
        __syncthreads();
        vb_prev = vb_cur; vb_cur = vb_next;
    }
    if (trail && 64 * (NT - 1) <= qw + 31) pv_tilexl(o, pb, ones, vl + vb_prev * VBX);
    __syncthreads();
#undef MLA_LOAD
#undef MLA_STORE
    const float inv = 1.f / o[4][0];
    const bf16* zp = P.Z + (size_t)tq * 2048 + head * 128 + 4 * hi;
    bf16* op = P.O + (size_t)tq * 4096 + head * 128 + 4 * hi;
#pragma unroll
    for (int d0 = 0; d0 < 4; ++d0)
#pragma unroll
        for (int rg = 0; rg < 4; ++rg) { const int dim = 32 * d0 + 8 * rg;
            const u32x2 z = *(const GAS u32x2*)(zp + dim);
            u32x2 w; w.x = pk2(o[d0][4 * rg + 0] * inv * bflo(z.x), o[d0][4 * rg + 1] * inv * bfhi(z.x)); w.y = pk2(o[d0][4 * rg + 2] * inv * bflo(z.y), o[d0][4 * rg + 3] * inv * bfhi(z.y));
            *(GAS u32x2*)(op + dim) = w; }
}

#elif defined(MLA_MXP)
struct MlaPtrs { const bf16* Q; const bf16* K; const bf16* V; const bf16* Z; bf16* O; };
__device__ __forceinline__ void mla_maskx(f32x16& p0, f32x16& p1, int dq) {
#pragma unroll
    for (int r = 0; r < 16; ++r) { const int c = (r & 3) + 8 * (r >> 2);
        if (c > dq) p0[r] = -__builtin_inff();
        if (c + 32 > dq) p1[r] = -__builtin_inff(); }
}
__device__ __forceinline__ float mla_rowmax(const f32x16& p0, const f32x16& p1) {
    float tm = p0[0];
#pragma unroll
    for (int r = 1; r < 16; ++r) tm = fmaxf(tm, p0[r]);
#pragma unroll
    for (int r = 0; r < 16; ++r) tm = fmaxf(tm, p1[r]);
    return swapmax(tm);
}
#define MXP_EXP8(P, R0) do { _Pragma("unroll") for (int r_ = (R0); r_ < (R0) + 8; ++r_) { P[r_] = __builtin_amdgcn_exp2f(__builtin_fmaf(P[r_], QS_MLA, mc_)); ps_ += P[r_]; } } while (0)
__device__ __forceinline__ void mla_unit(LAS unsigned char* lds, const MlaPtrs& P, int head, int qb, int tid_in, int wave, int lane_in) {
    int tid = tid_in; asm volatile("" : "+v"(tid)); const int lane = tid & 63; (void)lane_in;
    const int r32 = lane & 31, hi = lane >> 5;
    const int q0 = qb * 256, qw = q0 + wave * 32, tq = qw + r32;
    i32x8 q[3];
    { const unsigned char* qp = (const unsigned char*)P.Q + (size_t)tq * 3072 + head * 192 + hi * 32;
#pragma unroll
      for (int s = 0; s < 3; ++s) { const u32x4 a = *(const GAS u32x4*)(qp + 64 * s), b = *(const GAS u32x4*)(qp + 64 * s + 16);
          q[s] = (i32x8){(int)a.x, (int)a.y, (int)a.z, (int)a.w, (int)b.x, (int)b.y, (int)b.z, (int)b.w}; } }
    const int NT = 4 * (qb + 1);
    const int srow = tid >> 3, sc8 = tid & 7;
    const unsigned char* kg = (const unsigned char*)P.K + (size_t)head * 192 + (size_t)srow * 3072 + sc8 * 8;
    const unsigned char* vg = (const unsigned char*)P.V + ((size_t)head * 128 + (tid >> 2)) * S + (tid & 3) * 16;
    LAS unsigned char* kst = lds + srow * KSX + sc8 * 8;
    LAS unsigned char* vst = lds + 2 * MLA_KBX + (tid >> 2) * VSX + (tid & 3) * 16;
    const LAS unsigned char* kl = lds + r32 * KSX + hi * 32;
    const LAS unsigned char* vl = lds + 2 * MLA_KBX + r32 * VSX + hi * 32;
    u32x2 sk0, sk1, sk2; u32x4 sv0;
#define MLA_LOADK(j) do { const unsigned char* kp_ = kg + (size_t)(j) * (64 * 3072); sk0 = *(const GAS u32x2*)(kp_); sk1 = *(const GAS u32x2*)(kp_ + 64); sk2 = *(const GAS u32x2*)(kp_ + 128); } while (0)
#define MLA_LOADV(j) do { sv0 = *(const GAS u32x4*)(vg + (size_t)(j) * 64); } while (0)
#define MLA_STOREK(b) do { LAS unsigned char* kd_ = kst + (b) * MLA_KBX; *(LAS u32x2*)(kd_) = sk0; *(LAS u32x2*)(kd_ + 64) = sk1; *(LAS u32x2*)(kd_ + 128) = sk2; } while (0)
#define MLA_STOREV(b) do { LAS unsigned char* vd_ = vst + (b) * VBX; *(LAS u32x2*)(vd_) = (u32x2){sv0.x, sv0.y}; *(LAS u32x2*)(vd_ + 8) = (u32x2){sv0.z, sv0.w}; } while (0)
    float m = -1e30f, l = 0.f; f32x16 o[4];
#pragma unroll
    for (int d = 0; d < 4; ++d)
#pragma unroll
        for (int r = 0; r < 16; ++r) o[d][r] = 0.f;
    f32x16 pA0, pA1, pB0, pB1;
    MLA_LOADK(0); MLA_LOADV(0); MLA_STOREK(0); MLA_STOREV(0);
    MLA_LOADK(1);
    __syncthreads();
    qk_tilex(pA0, pA1, kl, q);
    if (63 > qw) mla_maskx(pA0, pA1, tq - 4 * hi);
    MLA_STOREK(1);
    if (2 < NT) MLA_LOADK(2);
    MLA_LOADV(1);
    __syncthreads();
    asm volatile("" : "+v"(q[0]), "+v"(q[1]), "+v"(q[2]));
    float tmx = mla_rowmax(pA0, pA1);
#define SB() __builtin_amdgcn_sched_barrier(0)
#define MLA_SMHEAD() const float mn_ = fmaxf(m, tmx); const float alpha_ = __builtin_amdgcn_exp2f((m - mn_) * QS_MLA); m = mn_; const float mc_ = 8.f - mn_ * QS_MLA; float ps_ = 0.f; i32x8 pb_; \
            if (!__all(alpha_ == 1.f)) { _Pragma("unroll") for (int d_ = 0; d_ < 4; ++d_) _Pragma("unroll") for (int r_ = 0; r_ < 16; ++r_) o[d_][r_] *= alpha_; }
#define MXP_EXPK(P, R0, W0) do { MXP_EXP8(P, R0); \
        int w_ = __builtin_amdgcn_cvt_pk_fp8_f32(P[(R0) + 0], P[(R0) + 1], 0, false); pb_[(W0)] = __builtin_amdgcn_cvt_pk_fp8_f32(P[(R0) + 2], P[(R0) + 3], w_, true); \
        w_ = __builtin_amdgcn_cvt_pk_fp8_f32(P[(R0) + 4], P[(R0) + 5], 0, false); pb_[(W0) + 1] = __builtin_amdgcn_cvt_pk_fp8_f32(P[(R0) + 6], P[(R0) + 7], w_, true); } while (0)
#define MLA_SMTAIL() ps_ = swapsum(ps_); l = l * alpha_ + ps_
#define MFMA_T(acc, a, b) asm volatile("s_nop 1\n\tv_mfma_scale_f32_32x32x64_f8f6f4 %0, %1, %2, %0, %3, %3 op_sel_hi:[0,0,0]" : "+v"(acc) : "v"(a), "v"(b), "v"(sc1_))
#define MFMA_Z(acc, a, b) asm volatile("s_nop 1\n\tv_mfma_scale_f32_32x32x64_f8f6f4 %0, %1, %2, 0, %3, %3 op_sel_hi:[0,0,0]" : "=&v"(acc) : "v"(a), "v"(b), "v"(sc1_))
#define MLA_STEP(PX0, PX1, PY0, PY1, j) do { \
        const int kb1_ = 64 * ((j) + 1); \
        const bool a0_ = (64 * (j) <= qw + 31); \
        const LAS unsigned char* vj_ = vl + ((j) & 1) * VBX; \
        if (a0_) {                  \
            const LAS unsigned char* kn_ = kl + (((j) + 1) & 1) * MLA_KBX; \
            MLA_SMHEAD() \
            SB(); \
            i32x8 a0_f = ldsx(kn_), a1_f = ldsx(kn_ + 64); \
            MXP_EXPK(PX0, 0, 0); MXP_EXPK(PX0, 8, 2); \
            SB(); MFMA_Z(PY0, a0_f, q[0]); SB(); \
            a0_f = ldsx(kn_ + 128); \
            MXP_EXPK(PX1, 0, 4); \
            SB(); MFMA_T(PY0, a1_f, q[1]); SB(); \
            a1_f = ldsx(kn_ + 32 * KSX); \
            MXP_EXPK(PX1, 8, 6); \
            SB(); MFMA_T(PY0, a0_f, q[2]); SB(); \
            a0_f = ldsx(kn_ + 32 * KSX + 64); \
            MLA_SMTAIL(); \
            SB(); MFMA_Z(PY1, a1_f, q[0]); SB(); \
            a1_f = ldsx(vj_); \
            SB(); MFMA_T(PY1, a0_f, q[1]); SB(); \
            a0_f = ldsx(kn_ + 32 * KSX + 128); \
            SB(); MFMA_T(o[0], a1_f, pb_); SB(); \
            a1_f = ldsx(vj_ + 32 * VSX); \
            SB(); MFMA_T(PY1, a0_f, q[2]); SB(); \
            a0_f = ldsx(vj_ + 64 * VSX); \
            SB(); MFMA_T(o[1], a1_f, pb_); SB(); \
            a1_f = ldsx(vj_ + 96 * VSX); \
            SB(); MFMA_T(o[2], a0_f, pb_); SB(); \
            SB(); MFMA_T(o[3], a1_f, pb_); SB(); \
            if (kb1_ + 63 > qw) mla_maskx(PY0, PY1, tq - kb1_ - 4 * hi); \
            tmx = mla_rowmax(PY0, PY1); \
        } \
        if ((j) + 2 < NT) MLA_STOREK((j) & 1); \
        if ((j) + 1 < NT) MLA_STOREV(((j) + 1) & 1); \
        if ((j) + 3 < NT) MLA_LOADK((j) + 3); \
        if ((j) + 2 < NT) MLA_LOADV((j) + 2); \
        __syncthreads(); } while (0)
    int sc1_ = 0x7f7f7f7f; asm volatile("" : "+v"(sc1_));
    for (int j = 0; j < NT; j += 2) {
        MLA_STEP(pA0, pA1, pB0, pB1, j);
        MLA_STEP(pB0, pB1, pA0, pA1, j + 1);
    }
    asm volatile("s_nop 15\n\ts_nop 15" ::: "memory");
#undef MLA_STEP
#undef MLA_SMHEAD
#undef MLA_SMTAIL
#undef MXP_EXPK
#undef MFMA_T
#undef MFMA_Z
#undef SB
#undef MLA_LOADK
#undef MLA_LOADV
#undef MLA_STOREK
#undef MLA_STOREV
    const float inv = 1.f / l;
    const bf16* zp = P.Z + (size_t)tq * 2048 + head * 128 + 4 * hi;
    bf16* op = P.O + (size_t)tq * 4096 + head * 128 + 4 * hi;
#pragma unroll
    for (int d0 = 0; d0 < 4; ++d0)
#pragma unroll
        for (int rg = 0; rg < 4; ++rg) { const int dim = 32 * d0 + 8 * rg;
            const u32x2 z = *(const GAS u32x2*)(zp + dim);
            u32x2 w; w.x = pk2(o[d0][4 * rg + 0] * inv * bflo(z.x), o[d0][4 * rg + 1] * inv * bfhi(z.x)); w.y = pk2(o[d0][4 * rg + 2] * inv * bflo(z.y), o[d0][4 * rg + 3] * inv * bfhi(z.y));
            *(GAS u32x2*)(op + dim) = w; }
}
#undef MXP_EXP8

#elif defined(MLA_MX)
struct MlaPtrs { const bf16* Q; const bf16* K; const bf16* V; const bf16* Z; bf16* O; };
__device__ __forceinline__ void mla_unit(LAS unsigned char* lds, const MlaPtrs& P, int head, int qb, int tid_in, int wave, int lane_in) {
    int tid = tid_in; asm volatile("" : "+v"(tid)); const int lane = tid & 63; (void)lane_in;
    const int r32 = lane & 31, hi = lane >> 5;
    const int q0 = qb * 256, qw = q0 + wave * 32, tq = qw + r32;
    i32x8 q[3];
    { const unsigned char* qp = (const unsigned char*)P.Q + (size_t)tq * 3072 + head * 192 + hi * 32;
#pragma unroll
      for (int s = 0; s < 3; ++s) { const u32x4 a = *(const GAS u32x4*)(qp + 64 * s), b = *(const GAS u32x4*)(qp + 64 * s + 16);
          q[s] = (i32x8){(int)a.x, (int)a.y, (int)a.z, (int)a.w, (int)b.x, (int)b.y, (int)b.z, (int)b.w}; } }
    const int NT = 4 * (qb + 1);
    const int srow = tid >> 3, sc8 = tid & 7;
    const unsigned char* kg = (const unsigned char*)P.K + (size_t)head * 192 + (size_t)srow * 3072 + sc8 * 8;
    const unsigned char* vg = (const unsigned char*)P.V + ((size_t)head * 128 + (tid >> 2)) * S + (tid & 3) * 16;
    LAS unsigned char* kst = lds + srow * KSX + sc8 * 8;
    LAS unsigned char* vst = lds + 2 * MLA_KBX + (tid >> 2) * VSX + (tid & 3) * 16;
    const LAS unsigned char* kl = lds + r32 * KSX + hi * 32;
    const LAS unsigned char* vl = lds + 2 * MLA_KBX + r32 * VSX + hi * 32;
    u32x2 sk0, sk1, sk2; u32x4 sv0;
#define MLA_LOAD(j) do { const unsigned char* kp_ = kg + (size_t)(j) * (64 * 3072); const unsigned char* vp_ = vg + (size_t)(j) * 64; \
        sk0 = *(const GAS u32x2*)(kp_); sk1 = *(const GAS u32x2*)(kp_ + 64); sk2 = *(const GAS u32x2*)(kp_ + 128); sv0 = *(const GAS u32x4*)(vp_); } while (0)
#define MLA_STORE(b, vb) do { LAS unsigned char* kd_ = kst + (b) * MLA_KBX; LAS unsigned char* vd_ = vst + (vb) * VBX; \
        *(LAS u32x2*)(kd_) = sk0; *(LAS u32x2*)(kd_ + 64) = sk1; *(LAS u32x2*)(kd_ + 128) = sk2; *(LAS u32x2*)(vd_) = (u32x2){sv0.x, sv0.y}; *(LAS u32x2*)(vd_ + 8) = (u32x2){sv0.z, sv0.w}; } while (0)
    MLA_LOAD(0); MLA_STORE(0, 0);
    __syncthreads();
    asm volatile("" : "+v"(q[0]), "+v"(q[1]), "+v"(q[2]));
    float m = -1e30f, l = 0.f; f32x16 o[4];
#pragma unroll
    for (int d = 0; d < 4; ++d)
#pragma unroll
        for (int r = 0; r < 16; ++r) o[d][r] = 0.f;
    const bool trail = wave >= 4;
    i32x8 pb = {};
    int vb_cur = 0, vb_prev = 2;
    for (int j = 0; j < NT; ++j) {
        const int kb = 64 * j;
        int vb_next = vb_cur + 1; if (vb_next == 3) vb_next = 0;
        if (j + 1 < NT) MLA_LOAD(j + 1);
        if (trail && j > 0 && kb - 64 <= qw + 31) pv_tilex(o, pb, vl + vb_prev * VBX);
        if (kb <= qw + 31) {
            f32x16 p0, p1;
            qk_tilex(p0, p1, kl + (j & 1) * MLA_KBX, q);
            if (kb + 63 > qw) {
                const int dq = tq - kb - 4 * hi;
#pragma unroll
                for (int r = 0; r < 16; ++r) { const int c = (r & 3) + 8 * (r >> 2);
                    if (c > dq) p0[r] = -__builtin_inff();
                    if (c + 32 > dq) p1[r] = -__builtin_inff(); }
            }
            online_sm_x(p0, p1, m, l, o, QS_MLA);
            pb = packpx(p0, p1);
            if (!trail) pv_tilex(o, pb, vl + vb_cur * VBX);
        }
        if (j + 1 < NT) MLA_STORE((j + 1) & 1, vb_next);
        __syncthreads();
        vb_prev = vb_cur; vb_cur = vb_next;
    }
    if (trail && 64 * (NT - 1) <= qw + 31) pv_tilex(o, pb, vl + vb_prev * VBX);
    __syncthreads();
#undef MLA_LOAD
#undef MLA_STORE
    const float inv = 1.f / l;
    const bf16* zp = P.Z + (size_t)tq * 2048 + head * 128 + 4 * hi;
    bf16* op = P.O + (size_t)tq * 4096 + head * 128 + 4 * hi;
#pragma unroll
    for (int d0 = 0; d0 < 4; ++d0)
#pragma unroll
        for (int rg = 0; rg < 4; ++rg) { const int dim = 32 * d0 + 8 * rg;
            const u32x2 z = *(const GAS u32x2*)(zp + dim);
            u32x2 w; w.x = pk2(o[d0][4 * rg + 0] * inv * bflo(z.x), o[d0][4 * rg + 1] * inv * bfhi(z.x)); w.y = pk2(o[d0][4 * rg + 2] * inv * bflo(z.y), o[d0][4 * rg + 3] * inv * bfhi(z.y));
            *(GAS u32x2*)(op + dim) = w; }
}

#elif defined(MLA_BIG)
struct MlaPtrs { const bf16* Q; const bf16* K; const bf16* V; const bf16* Z; bf16* O; };
__device__ __forceinline__ void mla_unit(LAS unsigned char* lds, const MlaPtrs& P, int head, int qb, int tid_in, int wave, int lane_in) {
    int tid = tid_in; asm volatile("" : "+v"(tid)); const int lane = tid & 63; (void)lane_in;
    const int r32 = lane & 31, hi = lane >> 5;
    const int q0 = qb * 256, qw = q0 + wave * 32, tq = qw + r32;
    i64 q[12];
    { const unsigned char* qp = (const unsigned char*)P.Q + (size_t)tq * 3072 + head * 192 + hi * 8;
#pragma unroll
      for (int d0 = 0; d0 < 12; ++d0) q[d0] = *(const GAS i64*)(qp + d0 * 16); }
    const int NT = 4 * (qb + 1), NTB = NT / 2;
    const int srow = tid >> 3, sc8 = tid & 7;
    const unsigned char* kg = (const unsigned char*)P.K + (size_t)head * 192 + (size_t)srow * 3072 + sc8 * 8;
    const unsigned char* vg = (const unsigned char*)P.V + ((size_t)head * 128 + (tid >> 2)) * S + (tid & 3) * 32;
    LAS unsigned char* kst = lds + srow * KS8 + sc8 * 8;
    LAS unsigned char* vst = lds + 2 * MLA_KB8B + (tid >> 2) * VS8B + (tid & 3) * 32;
    const LAS unsigned char* kl = lds + r32 * KS8 + hi * 8;
    const LAS unsigned char* vl = lds + 2 * MLA_KB8B + r32 * VS8B + hi * 8;
    u32x2 sk0, sk1, sk2, sk3, sk4, sk5; u32x4 sv0, sv1;
#define MLA_LOAD(J) do { const unsigned char* kp_ = kg + (size_t)(J) * (128 * 3072); const unsigned char* vp_ = vg + (size_t)(J) * 128; \
        sk0 = *(const GAS u32x2*)(kp_); sk1 = *(const GAS u32x2*)(kp_ + 64); sk2 = *(const GAS u32x2*)(kp_ + 128); \
        sk3 = *(const GAS u32x2*)(kp_ + 64 * 3072); sk4 = *(const GAS u32x2*)(kp_ + 64 * 3072 + 64); sk5 = *(const GAS u32x2*)(kp_ + 64 * 3072 + 128); \
        sv0 = *(const GAS u32x4*)(vp_); sv1 = *(const GAS u32x4*)(vp_ + 16); } while (0)
#define MLA_STORE(b, vb) do { LAS unsigned char* kd_ = kst + (b) * MLA_KB8B; LAS unsigned char* vd_ = vst + (vb) * VB8B; \
        *(LAS u32x2*)(kd_) = sk0; *(LAS u32x2*)(kd_ + 64) = sk1; *(LAS u32x2*)(kd_ + 128) = sk2; \
        *(LAS u32x2*)(kd_ + 64 * KS8) = sk3; *(LAS u32x2*)(kd_ + 64 * KS8 + 64) = sk4; *(LAS u32x2*)(kd_ + 64 * KS8 + 128) = sk5; \
        *(LAS u32x2*)(vd_) = (u32x2){sv0.x, sv0.y}; *(LAS u32x2*)(vd_ + 8) = (u32x2){sv0.z, sv0.w}; *(LAS u32x2*)(vd_ + 16) = (u32x2){sv1.x, sv1.y}; *(LAS u32x2*)(vd_ + 24) = (u32x2){sv1.z, sv1.w}; } while (0)
    MLA_LOAD(0); MLA_STORE(0, 0);
    __syncthreads();
    float m = -1e30f, l = 0.f; f32x16 o[4];
#pragma unroll
    for (int d = 0; d < 4; ++d)
#pragma unroll
        for (int r = 0; r < 16; ++r) o[d][r] = 0.f;
    const bool trail = wave >= 4;
    i64 pb[4] = {};
    int vb_cur = 0, vb_prev = 2;
    for (int J = 0; J < NTB; ++J) {
        int vb_next = vb_cur + 1; if (vb_next == 3) vb_next = 0;
        if (J + 1 < NTB) MLA_LOAD(J + 1);
#pragma unroll
        for (int sub = 0; sub < 2; ++sub) {
            const int j = 2 * J + sub, kb = 64 * j;
            if (trail && j > 0 && kb - 64 <= qw + 31) pv_tile8(o, pb, vl + (sub == 0 ? vb_prev * VB8B + 64 : vb_cur * VB8B));
            if (kb <= qw + 31) {
                f32x16 p0, p1;
                qk_tile8<12>(p0, p1, kl + (J & 1) * MLA_KB8B + sub * 64 * KS8, q);
                if (kb + 63 > qw) {
                    const int dq = tq - kb - 4 * hi;
#pragma unroll
                    for (int r = 0; r < 16; ++r) { const int c = (r & 3) + 8 * (r >> 2);
                        if (c > dq) p0[r] = -__builtin_inff();
                        if (c + 32 > dq) p1[r] = -__builtin_inff(); }
                }
                online_sm_scaled(p0, p1, m, l, o, QS_MLA);
                pb[0] = packp8<0>(p0); pb[1] = packp8<1>(p0); pb[2] = packp8<0>(p1); pb[3] = packp8<1>(p1);
                if (!trail) pv_tile8(o, pb, vl + vb_cur * VB8B + sub * 64);
            }
        }
        if (J + 1 < NTB) MLA_STORE((J + 1) & 1, vb_next);
        __syncthreads();
        vb_prev = vb_cur; vb_cur = vb_next;
    }
    if (trail && 64 * (NT - 1) <= qw + 31) pv_tile8(o, pb, vl + vb_prev * VB8B + 64);
    __syncthreads();
#undef MLA_LOAD
#undef MLA_STORE
    const float inv = (1.f / 256.f) / l;
    const bf16* zp = P.Z + (size_t)tq * 2048 + head * 128 + 4 * hi;
    bf16* op = P.O + (size_t)tq * 4096 + head * 128 + 4 * hi;
#pragma unroll
    for (int d0 = 0; d0 < 4; ++d0)
#pragma unroll
        for (int rg = 0; rg < 4; ++rg) { const int dim = 32 * d0 + 8 * rg;
            const u32x2 z = *(const GAS u32x2*)(zp + dim);
            u32x2 w; w.x = pk2(o[d0][4 * rg + 0] * inv * bflo(z.x), o[d0][4 * rg + 1] * inv * bfhi(z.x)); w.y = pk2(o[d0][4 * rg + 2] * inv * bflo(z.y), o[d0][4 * rg + 3] * inv * bfhi(z.y));
            *(GAS u32x2*)(op + dim) = w; }
}

#elif defined(MLA_FP8V)
struct MlaPtrs { const bf16* Q; const bf16* K; const bf16* V; const bf16* Z; bf16* O; };
__device__ __forceinline__ void mla_unit(LAS unsigned char* lds, const MlaPtrs& P, int head, int qb, int tid_in, int wave, int lane_in) {
    int tid = tid_in; asm volatile("" : "+v"(tid)); const int lane = tid & 63; (void)lane_in;
    const int r32 = lane & 31, hi = lane >> 5;
    const int q0 = qb * 256, qw = q0 + wave * 32, tq = qw + r32;
    i64 q[12];
    { const unsigned char* qp = (const unsigned char*)P.Q + (size_t)tq * 3072 + head * 192 + hi * 8;
#pragma unroll
      for (int d0 = 0; d0 < 12; ++d0) q[d0] = *(const GAS i64*)(qp + d0 * 16); }
    const int NT = 4 * (qb + 1);
    const int srow = tid >> 3, sc8 = tid & 7;
    const unsigned char* kg = (const unsigned char*)P.K + (size_t)head * 192 + (size_t)srow * 3072 + sc8 * 8;
    const unsigned char* vg = (const unsigned char*)P.V + ((size_t)head * 128 + (tid >> 2)) * S + (tid & 3) * 16;
    LAS unsigned char* kst = lds + srow * KS8 + sc8 * 8;
    LAS unsigned char* vst = lds + 2 * MLA_KB8 + (tid >> 2) * VS8 + (tid & 3) * 16;
    const LAS unsigned char* kl = lds + r32 * KS8 + hi * 8;
    const LAS unsigned char* vl = lds + 2 * MLA_KB8 + r32 * VS8 + hi * 8;
    u32x2 sk0, sk1, sk2; u32x4 sv0;
#define MLA_LOAD(j) do { const unsigned char* kp_ = kg + (size_t)(j) * (64 * 3072); const unsigned char* vp_ = vg + (size_t)(j) * 64; \
        sk0 = *(const GAS u32x2*)(kp_); sk1 = *(const GAS u32x2*)(kp_ + 64); sk2 = *(const GAS u32x2*)(kp_ + 128); sv0 = *(const GAS u32x4*)(vp_); } while (0)
#define MLA_STORE(b, vb) do { LAS unsigned char* kd_ = kst + (b) * MLA_KB8; LAS unsigned char* vd_ = vst + (vb) * VB8; \
        *(LAS u32x2*)(kd_) = sk0; *(LAS u32x2*)(kd_ + 64) = sk1; *(LAS u32x2*)(kd_ + 128) = sk2; *(LAS u32x2*)(vd_) = (u32x2){sv0.x, sv0.y}; *(LAS u32x2*)(vd_ + 8) = (u32x2){sv0.z, sv0.w}; } while (0)
    MLA_LOAD(0); MLA_STORE(0, 0);
    __syncthreads();
    float m = -1e30f, l = 0.f; f32x16 o[4];
#pragma unroll
    for (int d = 0; d < 4; ++d)
#pragma unroll
        for (int r = 0; r < 16; ++r) o[d][r] = 0.f;
    const bool trail = wave >= 4;
    i64 pb[4] = {};
    int vb_cur = 0, vb_prev = 2;
    for (int j = 0; j < NT; ++j) {
        const int kb = 64 * j;
        int vb_next = vb_cur + 1; if (vb_next == 3) vb_next = 0;
        if (j + 1 < NT) MLA_LOAD(j + 1);
        if (trail && j > 0 && kb - 64 <= qw + 31) pv_tile8(o, pb, vl + vb_prev * VB8);
        if (kb <= qw + 31) {
            f32x16 p0, p1;
#ifdef PROBE_QKM2
            { f32x16 r0, r1; qk_tile_m2<12, KS_M>(p0, p1, r0, r1, kl + (j & 1) * MLA_KB, q);
#pragma unroll
              for (int r = 0; r < 16; ++r) { p0[r] = (p0[r] + r0[r]) * 0.5f; p1[r] = (p1[r] + r1[r]) * 0.5f; } }
#else
            qk_tile8<12>(p0, p1, kl + (j & 1) * MLA_KB8, q);
#endif
#ifdef PROBE_QK2
            { f32x16 r0, r1; asm volatile("" ::: "memory"); qk_tile<12, KS_M>(r0, r1, kl + (j & 1) * MLA_KB, q);
#pragma unroll
              for (int r = 0; r < 16; ++r) { p0[r] = (p0[r] + r0[r]) * 0.5f; p1[r] = (p1[r] + r1[r]) * 0.5f; } }
#endif
#ifdef PROBE_SM2
            { float acc_ = 0.f;
#pragma unroll
              for (int r = 0; r < 16; ++r) { acc_ += __builtin_amdgcn_exp2f(p0[r] - m - 40.f) + __builtin_amdgcn_exp2f(p1[r] - m - 40.f); }
#pragma unroll
              for (int r = 0; r < 16; ++r) { acc_ += __builtin_amdgcn_exp2f(p0[r] - m - 50.f) + __builtin_amdgcn_exp2f(p1[r] - m - 50.f); }
              if (acc_ == 12345.678f) l += 1.f; }
#endif
            if (kb + 63 > qw) {
                const int dq = tq - kb - 4 * hi;
#pragma unroll
                for (int r = 0; r < 16; ++r) { const int c = (r & 3) + 8 * (r >> 2);
                    if (c > dq) p0[r] = -__builtin_inff();
                    if (c + 32 > dq) p1[r] = -__builtin_inff(); }
            }
            online_sm_scaled(p0, p1, m, l, o, QS_MLA);
            pb[0] = packp8<0>(p0); pb[1] = packp8<1>(p0); pb[2] = packp8<0>(p1); pb[3] = packp8<1>(p1);
            if (!trail) pv_tile8(o, pb, vl + vb_cur * VB8);
        }
        if (j + 1 < NT) MLA_STORE((j + 1) & 1, vb_next);
        __syncthreads();
        vb_prev = vb_cur; vb_cur = vb_next;
    }
    if (trail && 64 * (NT - 1) <= qw + 31) pv_tile8(o, pb, vl + vb_prev * VB8);
    __syncthreads();
#undef MLA_LOAD
#undef MLA_STORE
    const float inv = (1.f / 256.f) / l;
    const bf16* zp = P.Z + (size_t)tq * 2048 + head * 128 + 4 * hi;
    bf16* op = P.O + (size_t)tq * 4096 + head * 128 + 4 * hi;
#pragma unroll
    for (int d0 = 0; d0 < 4; ++d0)
#pragma unroll
        for (int rg = 0; rg < 4; ++rg) { const int dim = 32 * d0 + 8 * rg;
            const u32x2 z = *(const GAS u32x2*)(zp + dim);
            u32x2 w; w.x = pk2(o[d0][4 * rg + 0] * inv * bflo(z.x), o[d0][4 * rg + 1] * inv * bfhi(z.x)); w.y = pk2(o[d0][4 * rg + 2] * inv * bflo(z.y), o[d0][4 * rg + 3] * inv * bfhi(z.y));
            *(GAS u32x2*)(op + dim) = w; }
}

#elif defined(MLA_FP8)
struct MlaPtrs { const bf16* Q; const bf16* K; const bf16* V; const bf16* Z; bf16* O; };
__device__ __forceinline__ void mla_unit(LAS unsigned char* lds, const MlaPtrs& P, int head, int qb, int tid_in, int wave, int lane_in) {
    int tid = tid_in; asm volatile("" : "+v"(tid)); const int lane = tid & 63; (void)lane_in;
    const int r32 = lane & 31, hi = lane >> 5;
    const int q0 = qb * 256, qw = q0 + wave * 32, tq = qw + r32;
    i64 q[12];
    { const unsigned char* qp = (const unsigned char*)P.Q + (size_t)tq * 3072 + head * 192 + hi * 8;
#pragma unroll
      for (int d0 = 0; d0 < 12; ++d0) q[d0] = *(const GAS i64*)(qp + d0 * 16); }
    const int NT = 4 * (qb + 1);
    const int srow = tid >> 3, sc8 = tid & 7;
    const unsigned char* kg = (const unsigned char*)P.K + (size_t)head * 192 + (size_t)srow * 3072 + sc8 * 8;
    const unsigned char* vg = (const unsigned char*)P.V + (size_t)head * 256 + (size_t)srow * 4096 + sc8 * 16;
    LAS unsigned char* kst = lds + srow * KS8 + sc8 * 8;
    LAS unsigned char* vst = lds + 2 * MLA_KB8 + srow * VS + sc8 * 16;
    const LAS unsigned char* kl = lds + r32 * KS8 + hi * 8;
    const LAS unsigned char* vl = lds + 2 * MLA_KB8 + (4 * hi + ((lane & 15) >> 2)) * VS + (16 * ((lane >> 4) & 1) + 4 * (lane & 3)) * 2;
    u32x2 sk0, sk1, sk2; u32x4 sv0, sv1;
#define MLA_LOAD(j) do { const unsigned char* kp_ = kg + (size_t)(j) * (64 * 3072); const unsigned char* vp_ = vg + (size_t)(j) * (64 * 4096); \
        sk0 = *(const GAS u32x2*)(kp_); sk1 = *(const GAS u32x2*)(kp_ + 64); sk2 = *(const GAS u32x2*)(kp_ + 128); sv0 = *(const GAS u32x4*)(vp_); sv1 = *(const GAS u32x4*)(vp_ + 128); } while (0)
#define MLA_STORE(b, vb) do { LAS unsigned char* kd_ = kst + (b) * MLA_KB8; LAS unsigned char* vd_ = vst + (vb) * VB; \
        *(LAS u32x2*)(kd_) = sk0; *(LAS u32x2*)(kd_ + 64) = sk1; *(LAS u32x2*)(kd_ + 128) = sk2; *(LAS u32x4*)(vd_) = sv0; *(LAS u32x4*)(vd_ + 128) = sv1; } while (0)
    MLA_LOAD(0); MLA_STORE(0, 0);
    __syncthreads();
    float m = -1e30f, l = 0.f; f32x16 o[4];
#pragma unroll
    for (int d = 0; d < 4; ++d)
#pragma unroll
        for (int r = 0; r < 16; ++r) o[d][r] = 0.f;
    const bool trail = wave >= 4;
    bf16x8 pb[4] = {};
    int vb_cur = 0, vb_prev = 2;
    for (int j = 0; j < NT; ++j) {
        const int kb = 64 * j;
        int vb_next = vb_cur + 1; if (vb_next == 3) vb_next = 0;
        if (j + 1 < NT) MLA_LOAD(j + 1);
        if (trail && j > 0 && kb - 64 <= qw + 31) pv_tile(o, pb, vl + vb_prev * VB);
        if (kb <= qw + 31) {
            f32x16 p0, p1;
#ifdef PROBE_QKM2
            { f32x16 r0, r1; qk_tile_m2<12, KS_M>(p0, p1, r0, r1, kl + (j & 1) * MLA_KB, q);
#pragma unroll
              for (int r = 0; r < 16; ++r) { p0[r] = (p0[r] + r0[r]) * 0.5f; p1[r] = (p1[r] + r1[r]) * 0.5f; } }
#else
            qk_tile8<12>(p0, p1, kl + (j & 1) * MLA_KB8, q);
#endif
#ifdef PROBE_QK2
            { f32x16 r0, r1; asm volatile("" ::: "memory"); qk_tile<12, KS_M>(r0, r1, kl + (j & 1) * MLA_KB, q);
#pragma unroll
              for (int r = 0; r < 16; ++r) { p0[r] = (p0[r] + r0[r]) * 0.5f; p1[r] = (p1[r] + r1[r]) * 0.5f; } }
#endif
#ifdef PROBE_SM2
            { float acc_ = 0.f;
#pragma unroll
              for (int r = 0; r < 16; ++r) { acc_ += __builtin_amdgcn_exp2f(p0[r] - m - 40.f) + __builtin_amdgcn_exp2f(p1[r] - m - 40.f); }
#pragma unroll
              for (int r = 0; r < 16; ++r) { acc_ += __builtin_amdgcn_exp2f(p0[r] - m - 50.f) + __builtin_amdgcn_exp2f(p1[r] - m - 50.f); }
              if (acc_ == 12345.678f) l += 1.f; }
#endif
            if (kb + 63 > qw) {
                const int dq = tq - kb - 4 * hi;
#pragma unroll
                for (int r = 0; r < 16; ++r) { const int c = (r & 3) + 8 * (r >> 2);
                    if (c > dq) p0[r] = -__builtin_inff();
                    if (c + 32 > dq) p1[r] = -__builtin_inff(); }
            }
            online_sm_scaled(p0, p1, m, l, o, QS_MLA);
            pb[0] = packp<0>(p0); pb[1] = packp<1>(p0); pb[2] = packp<0>(p1); pb[3] = packp<1>(p1);
            if (!trail) pv_tile(o, pb, vl + vb_cur * VB);
        }
        if (j + 1 < NT) MLA_STORE((j + 1) & 1, vb_next);
        __syncthreads();
        vb_prev = vb_cur; vb_cur = vb_next;
    }
    if (trail && 64 * (NT - 1) <= qw + 31) pv_tile(o, pb, vl + vb_prev * VB);
    __syncthreads();
#undef MLA_LOAD
#undef MLA_STORE
    const float inv = 1.f / l;
    const bf16* zp = P.Z + (size_t)tq * 2048 + head * 128 + 4 * hi;
    bf16* op = P.O + (size_t)tq * 4096 + head * 128 + 4 * hi;
#pragma unroll
    for (int d0 = 0; d0 < 4; ++d0)
#pragma unroll
        for (int rg = 0; rg < 4; ++rg) { const int dim = 32 * d0 + 8 * rg;
            const u32x2 z = *(const GAS u32x2*)(zp + dim);
            u32x2 w; w.x = pk2(o[d0][4 * rg + 0] * inv * bflo(z.x), o[d0][4 * rg + 1] * inv * bfhi(z.x)); w.y = pk2(o[d0][4 * rg + 2] * inv * bflo(z.y), o[d0][4 * rg + 3] * inv * bfhi(z.y));
            *(GAS u32x2*)(op + dim) = w; }
}

#else
struct MlaPtrs { const bf16* Q; const bf16* K; const bf16* V; const bf16* Z; bf16* O; };
__device__ __forceinline__ void mla_unit(LAS unsigned char* lds, const MlaPtrs& P, int head, int qb, int tid_in, int wave, int lane_in) {
    int tid = tid_in; asm volatile("" : "+v"(tid)); const int lane = tid & 63; (void)lane_in;
    const int r32 = lane & 31, hi = lane >> 5;
    const int q0 = qb * 256, qw = q0 + wave * 32, tq = qw + r32;
    bf16x8 q[12];
    { const bf16* qp = P.Q + (size_t)tq * 3072 + head * 192 + hi * 8;
#pragma unroll
      for (int d0 = 0; d0 < 12; ++d0) q[d0] = *(const GAS bf16x8*)(qp + d0 * 16); }
    const int NT = 4 * (qb + 1);
    const int srow = tid >> 3, sc8 = tid & 7;
    const unsigned char* kg = (const unsigned char*)P.K + (size_t)head * 384 + (size_t)srow * 6144 + sc8 * 16;
    const unsigned char* vg = (const unsigned char*)P.V + (size_t)head * 256 + (size_t)srow * 4096 + sc8 * 16;
    LAS unsigned char* kst = lds + srow * KS_M + sc8 * 16;
    LAS unsigned char* vst = lds + 2 * MLA_KB + srow * VS + sc8 * 16;
    const LAS unsigned char* kl = lds + r32 * KS_M + hi * 16;
    const LAS unsigned char* vl = lds + 2 * MLA_KB + (4 * hi + ((lane & 15) >> 2)) * VS + (16 * ((lane >> 4) & 1) + 4 * (lane & 3)) * 2;
    u32x4 sk0, sk1, sk2, sv0, sv1;
#define MLA_LOAD(j) do { const unsigned char* kp_ = kg + (size_t)(j) * (64 * 6144); const unsigned char* vp_ = vg + (size_t)(j) * (64 * 4096); \
        sk0 = *(const GAS u32x4*)(kp_); sk1 = *(const GAS u32x4*)(kp_ + 128); sk2 = *(const GAS u32x4*)(kp_ + 256); sv0 = *(const GAS u32x4*)(vp_); sv1 = *(const GAS u32x4*)(vp_ + 128); } while (0)
#define MLA_STORE(b, vb) do { LAS unsigned char* kd_ = kst + (b) * MLA_KB; LAS unsigned char* vd_ = vst + (vb) * VB; \
        *(LAS u32x4*)(kd_) = sk0; *(LAS u32x4*)(kd_ + 128) = sk1; *(LAS u32x4*)(kd_ + 256) = sk2; *(LAS u32x4*)(vd_) = sv0; *(LAS u32x4*)(vd_ + 128) = sv1; } while (0)
    MLA_LOAD(0); MLA_STORE(0, 0);
    __syncthreads();
    float m = -1e30f, l = 0.f; f32x16 o[4];
#pragma unroll
    for (int d = 0; d < 4; ++d)
#pragma unroll
        for (int r = 0; r < 16; ++r) o[d][r] = 0.f;
    const bool trail = wave >= 4;
    bf16x8 pb[4] = {};
    int vb_cur = 0, vb_prev = 2;
    for (int j = 0; j < NT; ++j) {
        const int kb = 64 * j;
        int vb_next = vb_cur + 1; if (vb_next == 3) vb_next = 0;
        if (j + 1 < NT) MLA_LOAD(j + 1);
        if (trail && j > 0 && kb - 64 <= qw + 31) pv_tile(o, pb, vl + vb_prev * VB);
        if (kb <= qw + 31) {
            f32x16 p0, p1;
#ifdef PROBE_QKM2
            { f32x16 r0, r1; qk_tile_m2<12, KS_M>(p0, p1, r0, r1, kl + (j & 1) * MLA_KB, q);
#pragma unroll
              for (int r = 0; r < 16; ++r) { p0[r] = (p0[r] + r0[r]) * 0.5f; p1[r] = (p1[r] + r1[r]) * 0.5f; } }
#else
            qk_tile<12, KS_M>(p0, p1, kl + (j & 1) * MLA_KB, q);
#endif
#ifdef PROBE_QK2
            { f32x16 r0, r1; asm volatile("" ::: "memory"); qk_tile<12, KS_M>(r0, r1, kl + (j & 1) * MLA_KB, q);
#pragma unroll
              for (int r = 0; r < 16; ++r) { p0[r] = (p0[r] + r0[r]) * 0.5f; p1[r] = (p1[r] + r1[r]) * 0.5f; } }
#endif
#ifdef PROBE_SM2
            { float acc_ = 0.f;
#pragma unroll
              for (int r = 0; r < 16; ++r) { acc_ += __builtin_amdgcn_exp2f(p0[r] - m - 40.f) + __builtin_amdgcn_exp2f(p1[r] - m - 40.f); }
#pragma unroll
              for (int r = 0; r < 16; ++r) { acc_ += __builtin_amdgcn_exp2f(p0[r] - m - 50.f) + __builtin_amdgcn_exp2f(p1[r] - m - 50.f); }
              if (acc_ == 12345.678f) l += 1.f; }
#endif
            if (kb + 63 > qw) {
                const int dq = tq - kb - 4 * hi;
#pragma unroll
                for (int r = 0; r < 16; ++r) { const int c = (r & 3) + 8 * (r >> 2);
                    if (c > dq) p0[r] = -__builtin_inff();
                    if (c + 32 > dq) p1[r] = -__builtin_inff(); }
            }
            online_sm(p0, p1, m, l, o);
            pb[0] = packp<0>(p0); pb[1] = packp<1>(p0); pb[2] = packp<0>(p1); pb[3] = packp<1>(p1);
            if (!trail) pv_tile(o, pb, vl + vb_cur * VB);
        }
        if (j + 1 < NT) MLA_STORE((j + 1) & 1, vb_next);
        __syncthreads();
        vb_prev = vb_cur; vb_cur = vb_next;
    }
    if (trail && 64 * (NT - 1) <= qw + 31) pv_tile(o, pb, vl + vb_prev * VB);
    __syncthreads();
#undef MLA_LOAD
#undef MLA_STORE
    const float inv = 1.f / l;
    const bf16* zp = P.Z + (size_t)tq * 2048 + head * 128 + 4 * hi;
    bf16* op = P.O + (size_t)tq * 4096 + head * 128 + 4 * hi;
#pragma unroll
    for (int d0 = 0; d0 < 4; ++d0)
#pragma unroll
        for (int rg = 0; rg < 4; ++rg) { const int dim = 32 * d0 + 8 * rg;
            const u32x2 z = *(const GAS u32x2*)(zp + dim);
            u32x2 w; w.x = pk2(o[d0][4 * rg + 0] * inv * bflo(z.x), o[d0][4 * rg + 1] * inv * bfhi(z.x)); w.y = pk2(o[d0][4 * rg + 2] * inv * bflo(z.y), o[d0][4 * rg + 3] * inv * bfhi(z.y));
            *(GAS u32x2*)(op + dim) = w; }
}

#endif
#endif
struct NsaPtrs { const bf16* Q; const bf16* KV; const bf16* KC; const bf16* VC; const bf16* Z; const float* G; bf16* O; float* scr; };
template <int MODE>
__device__ __forceinline__ void nsa_loop(LAS unsigned char* lds, const unsigned char* kbase, const unsigned char* vbase, int ntiles, int jlo,
                                         const bf16x8 (&q)[8], int t, float slope2, float& m, float& l, f32x16 (&o)[4], float invl, int tid, int wave, int lane) {
    constexpr bool HASV = MODE != 0;
    const int r32 = lane & 31, hi = lane >> 5;
    const int srow = tid >> 3, sc8 = tid & 7;
    const unsigned soff = srow * 256 + sc8 * 16;
    LAS unsigned char* kst = lds + srow * KS_N + sc8 * 16;
    LAS unsigned char* vst = lds + 2 * NSA_KB + srow * VS + sc8 * 16;
    const LAS unsigned char* kl = lds + r32 * KS_N + hi * 16;
    const LAS unsigned char* vl = lds + 2 * NSA_KB + (4 * hi + ((lane & 15) >> 2)) * VS + (16 * ((lane >> 4) & 1) + 4 * (lane & 3)) * 2;
    const LAS int* ulist = (const LAS int*)(lds + N_ULIST);
    const LAS unsigned* selm = (const LAS unsigned*)(lds + N_SELM);
    LAS float* partA = (LAS float*)(lds + N_PART); LAS float* partB = (LAS float*)(lds + N_PART + N_PARTB);
    LAS float* imp = (LAS float*)(lds + N_IMP); LAS float* carry = (LAS float*)(lds + N_CARRY);
    if (ntiles <= 0) return;
    u32x4 sk0, sk1, sv0, sv1;
#define NSA_TROW(j) (MODE == 2 ? 64 * __builtin_amdgcn_readfirstlane(ulist[(j)]) : 64 * (jlo + (j)))
#define NSA_LOAD(j) do { const size_t ro_ = (size_t)NSA_TROW(j) * 256 + soff; \
        sk0 = *(const GAS u32x4*)(kbase + ro_); sk1 = *(const GAS u32x4*)(kbase + ro_ + 128); \
        if (HASV) { sv0 = *(const GAS u32x4*)(vbase + ro_); sv1 = *(const GAS u32x4*)(vbase + ro_ + 128); } } while (0)
#define NSA_STORE(b) do { LAS unsigned char* kd_ = kst + (b) * NSA_KB; *(LAS u32x4*)(kd_) = sk0; *(LAS u32x4*)(kd_ + 128) = sk1; \
        if (HASV) { LAS unsigned char* vd_ = vst + (b) * VB; *(LAS u32x4*)(vd_) = sv0; *(LAS u32x4*)(vd_ + 128) = sv1; } } while (0)
    NSA_LOAD(0); NSA_STORE(0);
    __syncthreads();
    for (int j = 0; j < ntiles; ++j) {
        const int buf = j & 1;
        if (MODE != 1 && j + 1 < ntiles) NSA_LOAD(j + 1);
        const int trow = NSA_TROW(j);
        constexpr int PSTEP = (MODE <= 1) ? 16 : 1;
        const int pstart = (MODE <= 1) ? 16 * trow + 31 : trow;
        const int db = t - pstart - PSTEP * 4 * hi;
        constexpr unsigned W = (MODE == 3) ? 512u : 0x7fffffffu;
        float b0 = -slope2 * (float)db;
        if (MODE == 2) { const int b = trow >> 6; if (((selm[r32 * 8 + (b >> 5)] >> (b & 31)) & 1u) == 0u) b0 = -__builtin_inff(); }
        f32x16 p0, p1;
#pragma unroll
        for (int r = 0; r < 16; ++r) { const int c = PSTEP * ((r & 3) + 8 * (r >> 2));
            p0[r] = __builtin_fmaf(slope2, (float)c, b0); p1[r] = __builtin_fmaf(slope2, (float)(c + 32 * PSTEP), b0); }
        qk_tile<8, KS_N, false>(p0, p1, kl + buf * NSA_KB, q);
        { const int t0u = __builtin_amdgcn_readfirstlane(t - r32);
          const bool interior = (t0u - (pstart + PSTEP * 63) >= 0) && ((unsigned)(t0u + 31 - pstart) < W);
          if (!interior) {
#pragma unroll
              for (int r = 0; r < 16; ++r) { const int c = PSTEP * ((r & 3) + 8 * (r >> 2));
                  if ((unsigned)(db - c) >= W) p0[r] = -__builtin_inff();
                  if ((unsigned)(db - c - 32 * PSTEP) >= W) p1[r] = -__builtin_inff(); } } }
        if (MODE == 0) {
            float tm = p0[0];
#pragma unroll
            for (int r = 1; r < 16; ++r) tm = fmaxf(tm, p0[r]);
#pragma unroll
            for (int r = 0; r < 16; ++r) tm = fmaxf(tm, p1[r]);
            tm = swapmax(tm);
            const float mn = fmaxf(m, tm); const float alpha = __builtin_amdgcn_exp2f(m - mn); m = mn;
            float ps = 0.f;
#pragma unroll
            for (int r = 0; r < 16; ++r) ps += __builtin_amdgcn_exp2f(p0[r] - mn) + __builtin_amdgcn_exp2f(p1[r] - mn);
            l = l * alpha + swapsum(ps);
        } else if (MODE == 1) {
#pragma unroll
            for (int r = 0; r < 16; ++r) { p0[r] = __builtin_amdgcn_exp2f(p0[r] - m) * invl; p1[r] = __builtin_amdgcn_exp2f(p1[r] - m) * invl; }
            LAS float* pa = partA + (wave * 32 + r32) * 17 + hi; LAS float* pbm = partB + (wave * 32 + r32) * 17 + hi;
#pragma unroll
            for (int rg = 0; rg < 4; ++rg) {
                pa[2 * rg] = (p0[4 * rg] + p0[4 * rg + 1]) + (p0[4 * rg + 2] + p0[4 * rg + 3]); pbm[2 * rg] = p0[4 * rg + 3];
                pa[8 + 2 * rg] = (p1[4 * rg] + p1[4 * rg + 1]) + (p1[4 * rg + 2] + p1[4 * rg + 3]); pbm[8 + 2 * rg] = p1[4 * rg + 3]; }
            const bf16x8 pb[4] = {packp<0>(p0), packp<1>(p0), packp<0>(p1), packp<1>(p1)};
            pv_tile(o, pb, vl + buf * VB);
            __syncthreads();
            { const int qq = tid >> 4, jl = tid & 15; float a = 0.f, bp = 0.f, bl = 0.f;
#pragma unroll
              for (int w = 0; w < 8; ++w) { a += partA[(w * 32 + qq) * 17 + jl]; bl += partB[(w * 32 + qq) * 17 + jl]; }
              if (jl > 0) {
#pragma unroll
                  for (int w = 0; w < 8; ++w) bp += partB[(w * 32 + qq) * 17 + jl - 1];
              } else bp = (j > 0) ? carry[((j - 1) & 1) * 32 + qq] : 0.f;
              imp[qq * 256 + 16 * j + jl] = a + bp;
              if (jl == 15) carry[(j & 1) * 32 + qq] = bl; }
        } else {
            online_sm(p0, p1, m, l, o);
            const bf16x8 pb[4] = {packp<0>(p0), packp<1>(p0), packp<0>(p1), packp<1>(p1)};
            pv_tile(o, pb, vl + buf * VB);
        }
        if (MODE == 1 && j + 1 < ntiles) NSA_LOAD(j + 1);
        if (j + 1 < ntiles) NSA_STORE(buf ^ 1);
        __syncthreads();
    }
#undef NSA_TROW
#undef NSA_LOAD
#undef NSA_STORE
}
__device__ __forceinline__ void nsa_topk(const LAS float* improw, LAS unsigned* selrow, int cur, int lane) {
    unsigned key[4]; bool sel[4];
    int nforced = 0;
#pragma unroll
    for (int k = 0; k < 4; ++k) { const int j = lane + 64 * k;
        const bool forced = (j == 0) || (j == cur) || (j == cur - 1);
        const bool causal = j <= cur;
        sel[k] = forced;
#ifdef IMPNOISE_BUILD
        { unsigned h = (unsigned)j * 2654435761u + (unsigned)(size_t)improw * 40503u; h ^= h >> 15; h *= 0x846ca68bu; h ^= h >> 16;
          const float r = (float)(int)(h & 0xffffu) * (1.f / 32768.f) - 1.f; const float v = improw[j] * (1.f + IMPNOISE_EPS * r);
          key[k] = (causal && !forced) ? (__float_as_uint(v) + 1u) : 0u; }
#else
        key[k] = (causal && !forced) ? (__float_as_uint(improw[j]) + 1u) : 0u;
#endif
    }
    nforced = 1 + (cur >= 1 ? 1 : 0) + (cur >= 2 ? 1 : 0);
    const int want = 16 - nforced;
    for (int it = 0; it < want; ++it) {
        unsigned bk = key[0]; int bj = lane;
#pragma unroll
        for (int k = 1; k < 4; ++k) { if (key[k] > bk) { bk = key[k]; bj = lane + 64 * k; } }
        unsigned long long best = ((unsigned long long)bk << 32) | (unsigned)(0xffffffffu - (unsigned)bj);
#pragma unroll
        for (int off = 1; off < 64; off <<= 1) {
            const unsigned lo = __shfl_xor((unsigned)best, off), hiw = __shfl_xor((unsigned)(best >> 32), off);
            const unsigned long long other = ((unsigned long long)hiw << 32) | lo;
            best = other > best ? other : best; }
        if ((unsigned)(best >> 32) == 0u) break;
        const int wj = (int)(0xffffffffu - (unsigned)best);
#pragma unroll
        for (int k = 0; k < 4; ++k) if (wj == lane + 64 * k) { key[k] = 0u; sel[k] = true; }
    }
#pragma unroll
    for (int k = 0; k < 4; ++k) { const unsigned long long bm = __ballot(sel[k]);
        if (lane == 0) { selrow[2 * k] = (unsigned)bm; selrow[2 * k + 1] = (unsigned)(bm >> 32); } }
}
__device__ __forceinline__ void nsa_topk4(const LAS float* imp0, LAS unsigned* sel0, int cur, int lane) {
    unsigned key[4][4]; bool forced[4];
#pragma unroll
    for (int k = 0; k < 4; ++k) { const int j = lane + 64 * k;
        forced[k] = (j == 0) || (j == cur) || (j == cur - 1);
        const bool cand = (j <= cur) && !forced[k];
#pragma unroll
        for (int i = 0; i < 4; ++i) key[i][k] = cand ? (__float_as_uint(imp0[i * 256 + j]) + 1u) : 0u; }
    const int want = 16 - (1 + (cur >= 1 ? 1 : 0) + (cur >= 2 ? 1 : 0));
    unsigned T[4] = {0u, 0u, 0u, 0u};
    for (int bit = 30; bit >= 0; --bit) {
#pragma unroll
        for (int i = 0; i < 4; ++i) { const unsigned c = T[i] | (1u << bit);
            const int n = __builtin_popcountll(__ballot(key[i][0] >= c)) + __builtin_popcountll(__ballot(key[i][1] >= c)) + __builtin_popcountll(__ballot(key[i][2] >= c)) + __builtin_popcountll(__ballot(key[i][3] >= c));
            if (n >= want) T[i] = c; }
    }
#pragma unroll
    for (int i = 0; i < 4; ++i) {
        const unsigned Ti = T[i];
        int rem = want;
        if (Ti != 0u) rem -= __builtin_popcountll(__ballot(key[i][0] > Ti)) + __builtin_popcountll(__ballot(key[i][1] > Ti)) + __builtin_popcountll(__ballot(key[i][2] > Ti)) + __builtin_popcountll(__ballot(key[i][3] > Ti));
#pragma unroll
        for (int k = 0; k < 4; ++k) {
            bool s = forced[k];
            if (Ti == 0u) s = s || key[i][k] >= 1u;
            else {
                const bool eq = key[i][k] == Ti; const unsigned long long em = __ballot(eq);
                const int below = (int)__builtin_amdgcn_mbcnt_hi((unsigned)(em >> 32), __builtin_amdgcn_mbcnt_lo((unsigned)em, 0u));
                s = s || key[i][k] > Ti || (eq && below < rem);
                rem -= __builtin_popcountll(em); if (rem < 0) rem = 0;
            }
            const unsigned long long bm = __ballot(s);
            if (lane == 0) { sel0[i * 8 + 2 * k] = (unsigned)bm; sel0[i * 8 + 2 * k + 1] = (unsigned)(bm >> 32); }
        }
    }
}
__device__ __forceinline__ int nsa_opaque(int v) { asm volatile("" : "+v"(v)); return v; }
__device__ __forceinline__ void nsa_unit(LAS unsigned char* lds, const NsaPtrs& P, int g, int qblk, int tid_in, int wave, int lane_in, int cu) {
    int tid = tid_in; asm volatile("" : "+v"(tid));
    const int lane = tid & 63; (void)lane_in;
    const int r32 = lane & 31, hi = lane >> 5;
    const int hh = 8 * g + wave, t0 = 32 * qblk, t = t0 + r32;
    const float slope2 = __builtin_amdgcn_exp2f(-0.5f * (float)(hh + 1)) * LOG2E;
    bf16x8 q[8];
    { const bf16* qp = P.Q + (size_t)t * 2048 + hh * 128 + hi * 8;
#pragma unroll
      for (int d0 = 0; d0 < 8; ++d0) q[d0] = *(const GAS bf16x8*)(qp + d0 * 16); }
#define NSA_SCR() ((GAS f32x4*)(P.scr + ((size_t)(cu * 8 + wave) * 16) * 256) + nsa_opaque(lane))
    const size_t CH = (size_t)S * 128 * 2;
    f32x16 o[4]; float m, l;
#define NSA_ZERO_O() do { _Pragma("unroll") for (int d_ = 0; d_ < 4; ++d_) _Pragma("unroll") for (int r_ = 0; r_ < 16; ++r_) o[d_][r_] = 0.f; } while (0)
    const int ncv = 2 * qblk + 1, ntc = (ncv + 63) >> 6;
    const unsigned char* kc = (const unsigned char*)P.KC + (size_t)g * 1024 * 256; const unsigned char* vc = (const unsigned char*)P.VC + (size_t)g * 1024 * 256;
    m = -1e30f; l = 0.f; NSA_ZERO_O();
    nsa_loop<0>(lds, kc, vc, ntc, 0, q, t, slope2, m, l, o, 0.f, tid, wave, lane);
    const float invl = l > 0.f ? 1.f / l : 0.f;
    nsa_loop<1>(lds, kc, vc, ntc, 0, q, t, slope2, m, l, o, invl, tid, wave, lane);
    { const float g_c = P.G[(size_t)t * 48 + hh]; GAS f32x4* scr = NSA_SCR();
#pragma unroll
    for (int d0 = 0; d0 < 4; ++d0)
#pragma unroll
        for (int rg = 0; rg < 4; ++rg) { f32x4 v = {o[d0][4 * rg] * g_c, o[d0][4 * rg + 1] * g_c, o[d0][4 * rg + 2] * g_c, o[d0][4 * rg + 3] * g_c}; scr[(d0 * 4 + rg) * 64] = v; } }
    const int cur = t0 >> 6;
    LAS unsigned* selm = (LAS unsigned*)(lds + N_SELM);
#ifdef NSA_TOPK_ITER
    for (int i = 0; i < 4; ++i) { const int qq = 4 * wave + i; nsa_topk((const LAS float*)(lds + N_IMP) + qq * 256, selm + qq * 8, cur, lane); }
#else
    nsa_topk4((const LAS float*)(lds + N_IMP) + 4 * wave * 256, selm + 4 * wave * 8, cur, lane);
#endif
    __syncthreads();
    if (wave == 0) {
        LAS int* ulist = (LAS int*)(lds + N_ULIST); int n = 0;
        for (int k = 0; k < 8; ++k) { unsigned u = (lane < 32) ? selm[lane * 8 + k] : 0u;
#pragma unroll
            for (int off = 1; off < 32; off <<= 1) u |= __shfl_xor(u, off);
            u = __builtin_amdgcn_readfirstlane(u);
            while (u) { const int b = __builtin_ctz(u); u &= u - 1u; if (lane == 0) ulist[n] = 32 * k + b; ++n; } }
        if (lane == 0) *(LAS int*)(lds + N_NTS) = n;
    }
    __syncthreads();
    const int nts = __builtin_amdgcn_readfirstlane(*(const LAS int*)(lds + N_NTS));
    m = -1e30f; l = 0.f; NSA_ZERO_O();
    nsa_loop<2>(lds, (const unsigned char*)P.KV + (size_t)(4 + g) * CH, (const unsigned char*)P.KV + (size_t)(6 + g) * CH, nts, 0, q, t, slope2, m, l, o, 0.f, tid, wave, lane);
    { const float f = P.G[(size_t)t * 48 + 16 + hh] / l; GAS f32x4* scr = NSA_SCR();
#pragma unroll
      for (int d0 = 0; d0 < 4; ++d0)
          { f32x4 v[4];
#pragma unroll
            for (int rg = 0; rg < 4; ++rg) v[rg] = scr[(d0 * 4 + rg) * 64];
#pragma unroll
            for (int rg = 0; rg < 4; ++rg) { v[rg][0] += o[d0][4 * rg] * f; v[rg][1] += o[d0][4 * rg + 1] * f; v[rg][2] += o[d0][4 * rg + 2] * f; v[rg][3] += o[d0][4 * rg + 3] * f; scr[(d0 * 4 + rg) * 64] = v[rg]; } } }
    const int jlo = (t0 > 511 ? t0 - 511 : 0) >> 6, jhi = (t0 + 31) >> 6;
    m = -1e30f; l = 0.f; NSA_ZERO_O();
    nsa_loop<3>(lds, (const unsigned char*)P.KV + (size_t)(8 + g) * CH, (const unsigned char*)P.KV + (size_t)(10 + g) * CH, jhi - jlo + 1, jlo, q, t, slope2, m, l, o, 0.f, tid, wave, lane);
    { const float f = P.G[(size_t)t * 48 + 32 + hh] / l; GAS f32x4* scr = NSA_SCR();
      const bf16* zp = P.Z + (size_t)t * 2048 + hh * 128 + 4 * hi;
      bf16* op = P.O + (size_t)t * 4096 + 2048 + hh * 128 + 4 * hi;
#pragma unroll
      for (int d0 = 0; d0 < 4; ++d0)
          { f32x4 av[4]; u32x2 zv[4];
#pragma unroll
            for (int rg = 0; rg < 4; ++rg) { av[rg] = scr[(d0 * 4 + rg) * 64]; zv[rg] = *(const GAS u32x2*)(zp + 32 * d0 + 8 * rg); }
#pragma unroll
          for (int rg = 0; rg < 4; ++rg) { const int dim = 32 * d0 + 8 * rg; const f32x4 a = av[rg];
              const u32x2 z = zv[rg];
              u32x2 w; w.x = pk2((a[0] + o[d0][4 * rg] * f) * bflo(z.x), (a[1] + o[d0][4 * rg + 1] * f) * bfhi(z.x)); w.y = pk2((a[2] + o[d0][4 * rg + 2] * f) * bflo(z.y), (a[3] + o[d0][4 * rg + 3] * f) * bfhi(z.y));
              *(GAS u32x2*)(op + dim) = w; } } }
#undef NSA_ZERO_O
#undef NSA_SCR
}
struct CmpPtrs { const bf16* KV; const bf16* W1; const bf16* W2; const float* cbp; bf16* KC; bf16* VC; };
__device__ __forceinline__ void cmp_unit(LAS unsigned char* lds, const CmpPtrs& P, int kv, int g, int tile, int tid, int wave, int lane) {
    const int fr = lane & 15, fq = lane >> 4;
    constexpr int CRS = 544;
    LAS unsigned char* As = lds + 16384;
    LAS unsigned char* Ws = As + 16 * CRS;
    const unsigned char* Ag = (const unsigned char*)(P.KV + (size_t)(kv * 2 + g) * ((size_t)S * 128) + (size_t)(16 * tile + (tid >> 5)) * 2048) + (tid & 31) * 16;
    const unsigned char* Wg = (const unsigned char*)(P.W1 + (size_t)kv * 128 * 4096 + (size_t)(tid >> 5) * 4096) + (tid & 31) * 16;
    LAS unsigned char* Ad = As + (tid >> 5) * CRS + (tid & 31) * 16;
    LAS unsigned char* Wd = Ws + (tid >> 5) * CRS + (tid & 31) * 16;
    const LAS unsigned char* Ar = As + fr * CRS + fq * 16;
    const LAS unsigned char* Wr = Ws + (16 * wave + fr) * CRS + fq * 16;
    u32x4 ra, rw[8];
#define CMP_LOAD(c) do { ra = *(const GAS u32x4*)(Ag + (c) * 512); _Pragma("unroll") for (int i_ = 0; i_ < 8; ++i_) rw[i_] = *(const GAS u32x4*)(Wg + (size_t)i_ * (16 * 8192) + (c) * 512); } while (0)
    CMP_LOAD(0);
    f32x4 acc = {0.f, 0.f, 0.f, 0.f};
    for (int c = 0; c < 16; ++c) {
        *(LAS u32x4*)Ad = ra;
#pragma unroll
        for (int i = 0; i < 8; ++i) *(LAS u32x4*)(Wd + i * 16 * CRS) = rw[i];
        __syncthreads();
        if (c + 1 < 16) CMP_LOAD(c + 1);
#pragma unroll
        for (int s = 0; s < 8; ++s) {
            const bf16x8 a = *(const LAS bf16x8*)(Ar + 64 * s), b = *(const LAS bf16x8*)(Wr + 64 * s);
            acc = __builtin_amdgcn_mfma_f32_16x16x32_bf16(a, b, acc, 0, 0, 0);
        }
        __syncthreads();
    }
#undef CMP_LOAD
    float bias = 0.f;
    { float bv[16];
#pragma unroll
      for (int c = 0; c < 16; ++c) bv[c] = *(const GAS float*)(P.cbp + (size_t)(kv * 16 + c) * 128 + 16 * wave + fr);
#pragma unroll
      for (int c = 0; c < 16; ++c) bias += bv[c]; }
    LAS bf16* hid = (LAS bf16*)lds;
#pragma unroll
    for (int i = 0; i < 4; ++i) hid[(4 * fq + i) * 136 + 16 * wave + fr] = (bf16)(pk2(silu_f(acc[i] + bias), 0.f) & 0xffffu);
    __syncthreads();
    const bf16* B2 = P.W2 + (size_t)kv * 128 * 128 + (size_t)(16 * wave + fr) * 128 + 8 * fq;
    f32x4 acc2 = {0.f, 0.f, 0.f, 0.f};
#pragma unroll
    for (int s = 0; s < 4; ++s) {
        const bf16x8 a = *(const LAS bf16x8*)(hid + fr * 136 + 32 * s + 8 * fq), b = *(const GAS bf16x8*)(B2 + 32 * s);
        acc2 = __builtin_amdgcn_mfma_f32_16x16x32_bf16(a, b, acc2, 0, 0, 0);
    }
    bf16* out = (kv ? P.VC : P.KC) + (size_t)g * 1024 * 128;
#pragma unroll
    for (int i = 0; i < 4; ++i) { const int nn = 16 * tile + 4 * fq + i; out[(size_t)nn * 128 + 16 * wave + fr] = (nn < 1023) ? (bf16)(pk2(acc2[i], 0.f) & 0xffffu) : (bf16)0; }
    __syncthreads();
}
}
#ifdef CHK_BUILD
namespace chk {
constexpr size_t WS_CHK = 14 * MiB;
__device__ __forceinline__ float bf2f(bf16 v) { return __uint_as_float((unsigned)v << 16); }
__device__ __forceinline__ float e4m3(unsigned char b) {
    const int e = (b >> 3) & 15, mm = b & 7; const float v = e == 0 ? (float)mm * (1.f / 512.f) : (1.f + (float)mm * 0.125f) * exp2f((float)(e - 7)); return (b & 0x80) ? -v : v; }
__device__ __forceinline__ int sample_t(int i) { return i * 64 + (i * 29) % 64; }
__device__ __noinline__ void nsa_check(LAS unsigned char* lds, unsigned char* ws, int t, int g, LAS float* acc2) {
    int tid_ = threadIdx.x; asm volatile("" : "+v"(tid_)); const int tid = tid_, lane = tid & 63, wave = tid >> 6;
    const int hh = 8 * g + wave, cur = t >> 6;
    const bf16* QN = (const bf16*)(ws + WS_QNSA); const bf16* KV = (const bf16*)(ws + WS_KVNSA); const bf16* KC = (const bf16*)(ws + WS_KCMP) + (size_t)g * 1024 * 128; const bf16* VC = (const bf16*)(ws + WS_VCMP) + (size_t)g * 1024 * 128;
    const bf16* ZN = (const bf16*)(ws + WS_ZNSA); const float* GN = (const float*)(ws + WS_GNSA); const bf16* HO = (const bf16*)(ws + WS_H);
    const size_t CH = (size_t)S * 128;
    LAS float* pc = (LAS float*)lds;
    LAS float* impv = (LAS float*)(lds + 32768);
    LAS int* sel = (LAS int*)(lds + 32768 + 1024);
    const float slope2 = exp2f(-0.5f * (float)(hh + 1)) * LOG2E;
    const float q0 = bf2f(QN[(size_t)t * 2048 + hh * 128 + 2 * lane]), q1 = bf2f(QN[(size_t)t * 2048 + hh * 128 + 2 * lane + 1]);
    float oc0 = 0.f, oc1 = 0.f, os0 = 0.f, os1 = 0.f, ow0 = 0.f, ow1 = 0.f;
    const int ncv = (t >= 31) ? (t - 31) / 16 + 1 : 0;
    for (int n = lane; n < 1024; n += 64) pc[wave * 1024 + n] = 0.f;
    float mx = -1e30f;
    for (int n = 0; n < ncv; ++n) { float s = q0 * bf2f(KC[(size_t)n * 128 + 2 * lane]) + q1 * bf2f(KC[(size_t)n * 128 + 2 * lane + 1]); s = wave_sum(s) - slope2 * (float)(t - 16 * n - 31);
        if (lane == 0) pc[wave * 1024 + n] = s; mx = fmaxf(mx, s); }
    __syncthreads();
    float sum = 0.f;
    for (int n = 0; n < ncv; ++n) sum += exp2f(pc[wave * 1024 + n] - mx);
    __syncthreads();
    for (int n = lane; n < 1024; n += 64) pc[wave * 1024 + n] = (n < ncv) ? exp2f(pc[wave * 1024 + n] - mx) / sum : 0.f;
    __syncthreads();
    for (int n = 0; n < ncv; ++n) { const float p = pc[wave * 1024 + n]; oc0 += p * bf2f(VC[(size_t)n * 128 + 2 * lane]); oc1 += p * bf2f(VC[(size_t)n * 128 + 2 * lane + 1]); }
    if (tid < 256) { const int j = tid; float v = -1e30f;
        if (64 * j <= t) { float a = 0.f; for (int ii = 4 * j - 1; ii <= 4 * j + 3; ++ii) if (ii >= 0 && ii <= 1022) { float ps = 0.f; for (int h = 0; h < 8; ++h) ps += pc[h * 1024 + ii]; a += ps; }
            const bool forced = (j == 0) || (j == cur) || (j == cur - 1); v = a + (forced ? 1e4f : 0.f); }
        impv[j] = v; }
    __syncthreads();
    if (tid < 256) { const int j = tid; const float v = impv[j]; int rank = 0; for (int ii = 0; ii < 256; ++ii) { const float u = impv[ii]; rank += (u > v || (u == v && ii < j)) ? 1 : 0; } sel[j] = rank < 16 ? 1 : 0; }
    __syncthreads();
    const bf16* KS = KV + (size_t)(4 + g) * CH; const bf16* VSl = KV + (size_t)(6 + g) * CH;
    mx = -1e30f;
    for (int j = 0; j < 256; ++j) if (sel[j]) for (int tok = 64 * j; tok < 64 * j + 64 && tok <= t; ++tok) {
        float s = q0 * bf2f(KS[(size_t)tok * 128 + 2 * lane]) + q1 * bf2f(KS[(size_t)tok * 128 + 2 * lane + 1]); s = wave_sum(s) - slope2 * (float)(t - tok); mx = fmaxf(mx, s); }
    sum = 0.f;
    for (int j = 0; j < 256; ++j) if (sel[j]) for (int tok = 64 * j; tok < 64 * j + 64 && tok <= t; ++tok) {
        float s = q0 * bf2f(KS[(size_t)tok * 128 + 2 * lane]) + q1 * bf2f(KS[(size_t)tok * 128 + 2 * lane + 1]); s = wave_sum(s) - slope2 * (float)(t - tok);
        const float p = exp2f(s - mx); sum += p; os0 += p * bf2f(VSl[(size_t)tok * 128 + 2 * lane]); os1 += p * bf2f(VSl[(size_t)tok * 128 + 2 * lane + 1]); }
    os0 /= sum; os1 /= sum;
    const bf16* KW = KV + (size_t)(8 + g) * CH; const bf16* VW = KV + (size_t)(10 + g) * CH;
    const int lo = t - 511 > 0 ? t - 511 : 0;
    mx = -1e30f;
    for (int tok = lo; tok <= t; ++tok) { float s = q0 * bf2f(KW[(size_t)tok * 128 + 2 * lane]) + q1 * bf2f(KW[(size_t)tok * 128 + 2 * lane + 1]); s = wave_sum(s) - slope2 * (float)(t - tok); mx = fmaxf(mx, s); }
    sum = 0.f;
    for (int tok = lo; tok <= t; ++tok) { float s = q0 * bf2f(KW[(size_t)tok * 128 + 2 * lane]) + q1 * bf2f(KW[(size_t)tok * 128 + 2 * lane + 1]); s = wave_sum(s) - slope2 * (float)(t - tok);
        const float p = exp2f(s - mx); sum += p; ow0 += p * bf2f(VW[(size_t)tok * 128 + 2 * lane]); ow1 += p * bf2f(VW[(size_t)tok * 128 + 2 * lane + 1]); }
    ow0 /= sum; ow1 /= sum;
    const float gc = GN[(size_t)t * 48 + hh], gs = GN[(size_t)t * 48 + 16 + hh], gwv = GN[(size_t)t * 48 + 32 + hh];
    const float r0 = (gc * oc0 + gs * os0 + gwv * ow0) * bf2f(ZN[(size_t)t * 2048 + hh * 128 + 2 * lane]), r1 = (gc * oc1 + gs * os1 + gwv * ow1) * bf2f(ZN[(size_t)t * 2048 + hh * 128 + 2 * lane + 1]);
    const float f0 = bf2f(HO[(size_t)t * 4096 + 2048 + hh * 128 + 2 * lane]), f1 = bf2f(HO[(size_t)t * 4096 + 2048 + hh * 128 + 2 * lane + 1]);
    const float e2 = wave_sum((r0 - f0) * (r0 - f0) + (r1 - f1) * (r1 - f1)), n2 = wave_sum(r0 * r0 + r1 * r1);
    __syncthreads();
    if (lane == 0) { pc[wave] = e2; pc[8 + wave] = n2; }
    __syncthreads();
    if (tid == 0) { float a = 0.f, b = 0.f; for (int w = 0; w < 8; ++w) { a += pc[w]; b += pc[8 + w]; } acc2[0] += a; acc2[1] += b; }
    __syncthreads();
}
__device__ __forceinline__ void mla_check(LAS unsigned char* lds, unsigned char* ws, int t, LAS float* acc2) {
    int tid_ = threadIdx.x; asm volatile("" : "+v"(tid_)); const int tid = tid_, lane = tid & 63, wave = tid >> 6;
    const bf16* ZM = (const bf16*)(ws + WS_ZMLA); const bf16* HO = (const bf16*)(ws + WS_H);
    LAS float* qs = (LAS float*)lds + wave * 192;
    LAS float* red = (LAS float*)lds + 8 * 192;
    float ae = 0.f, an = 0.f;
    for (int rep = 0; rep < 2; ++rep) { const int head = wave + 8 * rep;
#ifdef MLA_FP8
        { const unsigned char* qp = (const unsigned char*)(ws + WS_QMLA) + (size_t)t * 3072 + head * 192; for (int d = lane; d < 192; d += 64) qs[d] = e4m3(qp[d]) * QS_MLA; }
#else
        { const bf16* qp = (const bf16*)(ws + WS_QMLA) + (size_t)t * 3072 + head * 192; for (int d = lane; d < 192; d += 64) qs[d] = bf2f(qp[d]); }
#endif
        __syncthreads();
        float mx = -1e30f;
        for (int c = 0; 64 * c <= t; ++c) {
#ifdef MLA_MX
            const int tok = 64 * c + 8 * ((lane >> 2) & 7) + 4 * (lane >> 5) + (lane & 3);
#else
            const int x_ = lane & 15; const int tok = 64 * c + (lane & 48) + (x_ < 4 ? x_ : (x_ < 8 ? x_ + 4 : (x_ < 12 ? x_ - 4 : x_)));
#endif

            float s = 0.f;
#ifdef MLA_FP8
            const unsigned char* kp = (const unsigned char*)(ws + WS_KMLA) + (size_t)tok * 3072 + head * 192; for (int d = 0; d < 192; ++d) s += qs[d] * e4m3(kp[d]);
#else
            const bf16* kp = (const bf16*)(ws + WS_KMLA) + (size_t)tok * 3072 + head * 192; for (int d = 0; d < 192; ++d) s += qs[d] * bf2f(kp[d]);
#endif
            if (tok <= t) mx = fmaxf(mx, s); }
        for (int off = 1; off < 64; off <<= 1) mx = fmaxf(mx, __shfl_xor(mx, off));
        float e2 = 0.f, n2 = 0.f;
        for (int dc = 0; dc < 8; ++dc) {
        float sum = 0.f; float o[16];
#pragma unroll
        for (int d = 0; d < 16; ++d) o[d] = 0.f;
        for (int c = 0; 64 * c <= t; ++c) {
#ifdef MLA_MX
            const int tok = 64 * c + 8 * ((lane >> 2) & 7) + 4 * (lane >> 5) + (lane & 3);
#else
            const int x_ = lane & 15; const int tok = 64 * c + (lane & 48) + (x_ < 4 ? x_ : (x_ < 8 ? x_ + 4 : (x_ < 12 ? x_ - 4 : x_)));
#endif

            float s = 0.f;
#ifdef MLA_FP8
            const unsigned char* kp = (const unsigned char*)(ws + WS_KMLA) + (size_t)tok * 3072 + head * 192; for (int d = 0; d < 192; ++d) s += qs[d] * e4m3(kp[d]);
#else
            const bf16* kp = (const bf16*)(ws + WS_KMLA) + (size_t)tok * 3072 + head * 192; for (int d = 0; d < 192; ++d) s += qs[d] * bf2f(kp[d]);
#endif
            const float p = (tok <= t) ? exp2f(s - mx) : 0.f; sum += p;
#ifdef MLA_FP8V
            const unsigned char* vt = (const unsigned char*)(ws + WS_VMLA) + ((size_t)head * 128 + 16 * dc) * S + 64 * c + lane;
#pragma unroll
            for (int d = 0; d < 16; ++d) o[d] += p * e4m3(vt[(size_t)d * S]);
#else
            const bf16* vp = (const bf16*)(ws + WS_VMLA) + (size_t)tok * 2048 + head * 128 + 16 * dc;
#pragma unroll
            for (int d = 0; d < 16; ++d) o[d] += p * bf2f(vp[d]);
#endif
        }
        sum = wave_sum(sum);
#pragma unroll
        for (int d = 0; d < 16; ++d) { const float od = wave_sum(o[d]) / sum; const float r = od * bf2f(ZM[(size_t)t * 2048 + head * 128 + 16 * dc + d]), f = bf2f(HO[(size_t)t * 4096 + head * 128 + 16 * dc + d]); e2 += (r - f) * (r - f); n2 += r * r; }
        }
        ae += e2; an += n2;
        __syncthreads(); }
    if (lane == 0) { red[wave] = ae; red[8 + wave] = an; }
    __syncthreads();
    if (tid == 0) { float a = 0.f, b = 0.f; for (int w = 0; w < 8; ++w) { a += red[w]; b += red[8 + w]; } acc2[0] += a; acc2[1] += b; }
    __syncthreads();
}
}
#endif
#ifdef CHK2_BUILD
namespace chk2 {
constexpr size_t WS_CHK = 14 * MiB;
__device__ __forceinline__ float bf2f(bf16 v) { return __uint_as_float((unsigned)v << 16); }
__device__ __forceinline__ int sample_t(int i) { return i * 256 + (i * 29) % 256; }
__device__ __noinline__ void proj_check(LAS unsigned char* lds, unsigned char* ws, const float* x, const float* w_in_l, int l, int i, int qd, LAS float* acc2) {
    int tid_ = threadIdx.x; asm volatile("" : "+v"(tid_)); const int tid = tid_;
    const int t = sample_t(i);
    LAS float* h = (LAS float*)lds;
    LAS float* red = h + 4096;
    const float* mod = (const float*)(ws + WS_MOD) + (size_t)l * 3 * D;
    const float* xin = (l == 0) ? x : (const float*)(ws + WS_XV);
    for (int k = tid; k < D; k += NTHR) h[k] = xin[(size_t)t * D + k] * (1.f + mod[D + k]) + mod[k];
    __syncthreads();
    float e2 = 0.f, r2 = 0.f;
    const float* cosT = (const float*)(ws + WS_ROPE); const float* sinT = cosT + (size_t)S * 32;
    for (int n = qd * 2268 + tid; n < (qd + 1) * 2268; n += NTHR) {
        float a = 0.f;
        for (int k = 0; k < D; ++k) a += h[k] * w_in_l[(size_t)k * INC + n];
        float ref = a, got;
        if (n < 768) got = bf2f(((const bf16*)(ws + WS_QLAT))[(size_t)t * 768 + n]);
        else if (n < 1280) got = bf2f(((const bf16*)(ws + WS_KVLAT))[(size_t)t * 512 + n - 768]);
        else if (n < 1344) {
            const int ii = n - 1280, pi = ii & 31; const int np = 1280 + (ii < 32 ? ii + 32 : ii - 32); float b = 0.f;
            for (int k = 0; k < D; ++k) b += h[k] * w_in_l[(size_t)k * INC + np];
            const float c = cosT[(size_t)t * 32 + pi], s = sinT[(size_t)t * 32 + pi];
            ref = ii < 32 ? a * c - b * s : a * c + b * s;
            got = bf2f(((const bf16*)(ws + WS_KMLA))[(size_t)t * 3072 + 5 * 192 + 128 + 2 * pi + (ii >> 5)]);
        }
        else if (n < 3392) { ref = a / (1.f + expf(-a)); got = bf2f(((const bf16*)(ws + WS_ZMLA))[(size_t)t * 2048 + n - 1344]); }
        else if (n < 5440) { ref = a * QS_NSA; got = bf2f(((const bf16*)(ws + WS_QNSA))[(size_t)t * 2048 + n - 3392]); }
        else if (n < 6976) { const int c = n - 5440; got = bf2f(((const bf16*)(ws + WS_KVNSA))[(size_t)(c >> 7) * ((size_t)S * 128) + (size_t)t * 128 + (c & 127)]); }
        else if (n < 7024) { ref = 1.f / (1.f + expf(-a)); got = ((const float*)(ws + WS_GNSA))[(size_t)t * 48 + n - 6976]; }
        else { ref = a / (1.f + expf(-a)); got = bf2f(((const bf16*)(ws + WS_ZNSA))[(size_t)t * 2048 + n - 7024]); }
        e2 += (ref - got) * (ref - got); r2 += ref * ref;
    }
    red[tid] = e2; red[512 + tid] = r2;
    __syncthreads();
    if (tid == 0) { float a = 0.f, b = 0.f; for (int k = 0; k < 512; ++k) { a += red[k]; b += red[512 + k]; } acc2[0] += a; acc2[1] += b; }
    __syncthreads();
}
__device__ __noinline__ void cmp_check(LAS unsigned char* lds, unsigned char* ws, const float* cmp_pos_l, const float* w1_l, const float* w2_l, int i, LAS float* acc2) {
    int tid_ = threadIdx.x; asm volatile("" : "+v"(tid_)); const int tid = tid_;
    const int n = (4 * i + (i & 3)) % 1023, kv = i & 1, g = (i >> 1) & 1;
    LAS float* blk = (LAS float*)lds;
    LAS float* hid = blk + 4096;
    LAS float* red = hid + 128;
    const bf16* A = (const bf16*)(ws + WS_KVNSA) + (size_t)(kv * 2 + g) * ((size_t)S * 128) + (size_t)n * 2048;
    for (int k = tid; k < 4096; k += NTHR) blk[k] = bf2f(A[k]) + cmp_pos_l[(size_t)kv * 4096 + k];
    __syncthreads();
    if (tid < 128) { float a = 0.f; const float* W = w1_l + (size_t)kv * 4096 * 128 + tid; for (int k = 0; k < 4096; ++k) a += blk[k] * W[(size_t)k * 128]; hid[tid] = a / (1.f + expf(-a)); }
    __syncthreads();
    float e2 = 0.f, r2 = 0.f;
    if (tid < 128) { float a = 0.f; const float* W = w2_l + (size_t)kv * 128 * 128 + tid; for (int k = 0; k < 128; ++k) a += hid[k] * W[(size_t)k * 128];
        const float got = bf2f(((const bf16*)(ws + (kv ? WS_VCMP : WS_KCMP)))[(size_t)g * 1024 * 128 + (size_t)n * 128 + tid]); e2 = (a - got) * (a - got); r2 = a * a; }
    if (tid < 128) { red[tid] = e2; red[128 + tid] = r2; }
    __syncthreads();
    if (tid == 0) { float a = 0.f, b = 0.f; for (int k = 0; k < 128; ++k) { a += red[k]; b += red[128 + k]; } acc2[0] += a; acc2[1] += b; }
    __syncthreads();
}
}
#endif
#ifdef CHK3_BUILD
namespace chk3 {
constexpr size_t WS_CHK = 14 * MiB;
__device__ __forceinline__ float bf2f(bf16 v) { return __uint_as_float((unsigned)v << 16); }
__device__ __forceinline__ float e4m3(unsigned char b) { const int e = (b >> 3) & 15, mm = b & 7; const float v = e == 0 ? (float)mm * (1.f / 512.f) : (1.f + (float)mm * 0.125f) * exp2f((float)(e - 7)); return (b & 0x80) ? -v : v; }
__device__ __forceinline__ int sample_t(int i) { return i * 64 + (i * 29) % 64; }
__device__ __noinline__ void up_check(LAS unsigned char* lds, unsigned char* ws, const float* qn, const float* wq, const float* kn, const float* wkv, int i, LAS float* acc2) {
    int tid_ = threadIdx.x; asm volatile("" : "+v"(tid_)); const int tid = tid_;
    const int t = sample_t(i);
    LAS float* ql = (LAS float*)lds;
    LAS float* kl = ql + 768;
    LAS float* qo = kl + 512;
    LAS float* red = qo + 3072;
    const bf16* QL = (const bf16*)(ws + WS_QLAT) + (size_t)t * 768; const bf16* KL = (const bf16*)(ws + WS_KVLAT) + (size_t)t * 512;
    float s = 0.f; for (int k = tid; k < 768; k += NTHR) { const float v = bf2f(QL[k]); s += v * v; }
    red[tid] = s; __syncthreads();
    float tot = 0.f; for (int k = 0; k < 512; ++k) tot += red[k];
    const float rq = 1.f / sqrtf(tot / 768.f + RMS_EPS);
    __syncthreads();
    s = 0.f; for (int k = tid; k < 512; k += NTHR) { const float v = bf2f(KL[k]); s += v * v; }
    red[tid] = s; __syncthreads();
    tot = 0.f; for (int k = 0; k < 512; ++k) tot += red[k];
    const float rk = 1.f / sqrtf(tot / 512.f + RMS_EPS);
    __syncthreads();
    for (int k = tid; k < 768; k += NTHR) ql[k] = bf2f(QL[k]) * rq * qn[k];
    for (int k = tid; k < 512; k += NTHR) kl[k] = bf2f(KL[k]) * rk * kn[k];
    __syncthreads();
    for (int n = tid; n < 3072; n += NTHR) { float a = 0.f; for (int k = 0; k < 768; ++k) a += ql[k] * wq[(size_t)k * 3072 + n]; qo[n] = a; }
    __syncthreads();
    float e2 = 0.f, r2 = 0.f;
    const float* cosT = (const float*)(ws + WS_ROPE); const float* sinT = cosT + (size_t)S * 32;
    const bf16* QM = (const bf16*)(ws + WS_QMLA) + (size_t)t * 3072;
    for (int n = tid; n < 3072; n += NTHR) { const int h = n / 192, d = n % 192; float ref, got;
#ifdef MLA_FP8
        const unsigned char* Q8 = (const unsigned char*)(ws + WS_QMLA) + (size_t)t * 3072;
        if (d < 128) { ref = qo[n]; got = e4m3(Q8[h * 192 + d]); }
        else { const int ii = d - 128, pi = ii & 31; const float x1 = qo[h * 192 + 128 + pi], x2 = qo[h * 192 + 160 + pi]; const float c = cosT[(size_t)t * 32 + pi], sn = sinT[(size_t)t * 32 + pi];
            ref = (ii < 32 ? x1 * c - x2 * sn : x2 * c + x1 * sn); got = e4m3(Q8[h * 192 + 128 + 2 * pi + (ii >> 5)]); }
        if (false) {}
#else
        if (d < 128) { ref = qo[n] * QS_MLA; got = bf2f(QM[h * 192 + d]); }
        else { const int ii = d - 128, pi = ii & 31; const float x1 = qo[h * 192 + 128 + pi], x2 = qo[h * 192 + 160 + pi]; const float c = cosT[(size_t)t * 32 + pi], sn = sinT[(size_t)t * 32 + pi];
            ref = (ii < 32 ? x1 * c - x2 * sn : x2 * c + x1 * sn) * QS_MLA; got = bf2f(QM[h * 192 + 128 + 2 * pi + (ii >> 5)]); }
#endif
        e2 += (ref - got) * (ref - got); r2 += ref * ref; }
    const bf16* KM = (const bf16*)(ws + WS_KMLA) + (size_t)t * 3072; const bf16* VM = (const bf16*)(ws + WS_VMLA) + (size_t)t * 2048;
    for (int n = tid; n < 4096; n += NTHR) { float a = 0.f; for (int k = 0; k < 512; ++k) a += kl[k] * wkv[(size_t)k * 4096 + n];
#ifdef MLA_FP8
        const int h = n >> 8, d = n & 255; const float got = d < 128 ? e4m3(((const unsigned char*)(ws + WS_KMLA) + (size_t)t * 3072)[h * 192 + d]) : bf2f(VM[h * 128 + d - 128]);
#else
        const int h = n >> 8, d = n & 255; const float got = d < 128 ? bf2f(KM[h * 192 + d]) : bf2f(VM[h * 128 + d - 128]);
#endif
        e2 += (a - got) * (a - got); r2 += a * a; }
    red[tid] = e2; red[512 + tid] = r2;
    __syncthreads();
    if (tid == 0) { float a = 0.f, b = 0.f; for (int k = 0; k < 512; ++k) { a += red[k]; b += red[512 + k]; } acc2[0] += a; acc2[1] += b; }
    __syncthreads();
}
__device__ __noinline__ void out_check(LAS unsigned char* lds, unsigned char* ws, const float* xin, const float* xv, const float* wout, const float* gate, int i, int qd, LAS float* acc2) {
    int tid_ = threadIdx.x; asm volatile("" : "+v"(tid_)); const int tid = tid_;
    const int t = i * 256 + (i * 29) % 256;
    LAS float* o = (LAS float*)lds;
    LAS float* red = o + 4096;
    const bf16* OA = (const bf16*)(ws + WS_H) + (size_t)t * 4096;
    for (int k = tid; k < 4096; k += NTHR) o[k] = bf2f(OA[k]);
    __syncthreads();
    float e2 = 0.f, r2 = 0.f;
    for (int n = qd * 1024 + tid; n < (qd + 1) * 1024; n += NTHR) { float a = 0.f; for (int k = 0; k < 4096; ++k) a += o[k] * wout[(size_t)k * 4096 + n];
        const float gy = gate[n] * a, ref = DN_ALPHA * xin[(size_t)t * D + n] + gy, got = xv[(size_t)t * D + n];
        e2 += (ref - got) * (ref - got); r2 += gy * gy; }
    red[tid] = e2; red[512 + tid] = r2;
    __syncthreads();
    if (tid == 0) { float a = 0.f, b = 0.f; for (int k = 0; k < 512; ++k) { a += red[k]; b += red[512 + k]; } acc2[0] += a; acc2[1] += b; }
    __syncthreads();
}
}
#endif
#ifdef CHK4_BUILD
namespace chk4 {
__device__ __forceinline__ float bf2f(bf16 v) { return __uint_as_float((unsigned)v << 16); }
__device__ __noinline__ void mod_check(LAS unsigned char* lds, unsigned char* ws, const float* c, const float* w_ada, const float* b_ada, int u, LAS float* acc2) {
    const int tid = threadIdx.x;
    LAS float* red = (LAS float*)lds;
    const int l = u & 1, n = ((u >> 1) * 977 + 13) % (3 * D);
    float a = 0.f;
    for (int k = tid; k < D; k += NTHR) { const float cv = c[k]; a += cv / (1.f + expf(-cv)) * w_ada[(size_t)l * D * 3 * D + (size_t)k * 3 * D + n]; }
    red[tid] = a; __syncthreads();
    if (tid == 0) { float s = 0.f; for (int k = 0; k < NTHR; ++k) s += red[k]; s += b_ada[(size_t)l * 3 * D + n];
        const float got = ((const float*)(ws + WS_MOD))[(size_t)l * 3 * D + n]; acc2[0] += (s - got) * (s - got); acc2[1] += s * s; }
    __syncthreads();
}
__device__ __noinline__ void ln_check(LAS unsigned char* lds, unsigned char* ws, const float* ln_g, const float* ln_b, int u, LAS float* acc2) {
    const int tid = threadIdx.x;
    LAS float* red = (LAS float*)lds;
    const int t = u * 64 + (u * 29) % 64;
    const float* X1 = (const float*)(ws + WS_XV) + (size_t)t * D; const bf16* H = (const bf16*)(ws + WS_H) + (size_t)t * D; const float* mod1 = (const float*)(ws + WS_MOD) + 3 * D;
    float s1 = 0.f, s2 = 0.f, e2 = 0.f, r2 = 0.f;
    for (int k = tid; k < D; k += NTHR) { const float y = (X1[k] - ln_b[k]) / ln_g[k]; s1 += y; s2 += y * y;
        const float h = X1[k] * (1.f + mod1[D + k]) + mod1[k], got = bf2f(H[k]); e2 += (h - got) * (h - got); r2 += h * h; }
    red[tid] = s1; red[512 + tid] = s2; red[1024 + tid] = e2; red[1536 + tid] = r2; __syncthreads();
    if (tid == 0) { float a = 0.f, b = 0.f, c = 0.f, d = 0.f; for (int k = 0; k < NTHR; ++k) { a += red[k]; b += red[512 + k]; c += red[1024 + k]; d += red[1536 + k]; }
        const float mean = a / D, var = b / D - mean * mean;
        acc2[0] += mean * mean + (var - 1.f) * (var - 1.f) + c / d; acc2[1] += 1.f; }
    __syncthreads();
}
}
#endif
constexpr int PPL = 6;
constexpr int N_PHASES = 2 + PPL * DEPTH;
struct Args { const void* in[16]; float* out; unsigned char* ws; int ph_lo, ph_hi; };
#define WSP(T, off) ((T*)(ws + (off)))
#define VCU() ((gridDim.x % 8 == 0) ? (int)((blockIdx.x % 8) * (gridDim.x / 8) + blockIdx.x / 8) : (int)blockIdx.x)
__global__ void __launch_bounds__(NTHR, 2) mk_fwd(const Args args) {
    extern __shared__ __attribute__((aligned(16))) unsigned char lds_raw[];
    LAS unsigned char* lds = (LAS unsigned char*)lds_raw;
    if (threadIdx.x < 32) ((volatile LAS unsigned*)(lds + MISC_OFF))[threadIdx.x] = 0u;
    __syncthreads();
    XcdBarrier bar = xcd_barrier_post((unsigned*)(args.ws + WS_CTL) + CW_BAR, (volatile LAS unsigned*)(lds + MISC_OFF) + 8);
#define IN(k) (args.ph_lo <= (k) && (k) < args.ph_hi)
#define SEAM(k) do { if (IN(k) && IN((k) + 1)) xcd_barrier(bar); } while (0)
#define PHASE_REGS int tid_ = threadIdx.x; asm volatile("" : "+v"(tid_)); const int tid = tid_, lane = tid & 63, wave = __builtin_amdgcn_readfirstlane(tid >> 6); \
    unsigned char* ws = args.ws; asm volatile("" : "+s"(ws)); (void)tid; (void)lane; (void)wave

    if (IN(0)) {
        PHASE_REGS; const int G = gridDim.x, vcu = VCU();
        p0_mod_gemv((const float*)args.in[1], (const float*)args.in[3], (const float*)args.in[4], WSP(float, WS_MOD), (LAS float*)lds, vcu, G);
        p0_cmpbias((const float*)args.in[10], (const float*)args.in[11], WSP(float, WS_CBP), (LAS float*)lds, (vcu + G / 2) % G, G);
        p0_rope((const int*)args.in[2], WSP(float, WS_ROPE), WSP(float, WS_ROPE) + (size_t)S * 32, vcu * NTHR + tid, G * NTHR);
        const P0In I{(const float*)args.in[5], (const float*)args.in[6], (const float*)args.in[7], (const float*)args.in[8], (const float*)args.in[9], (const float*)args.in[11], (const float*)args.in[12], (const float*)args.in[13]};
#ifndef DIS_CONV
        p0_convert(I, ws, vcu * NWAVES + wave, G * NWAVES, lane);
#endif
#ifdef PROBE_P0CONV2
        p0_convert(I, ws, vcu * NWAVES + wave, G * NWAVES, lane);
#endif
#ifdef PROBE_P0MOD2
        __syncthreads(); p0_mod_gemv((const float*)args.in[1], (const float*)args.in[3], (const float*)args.in[4], WSP(float, WS_MOD), (LAS float*)lds, vcu, G);
#endif
    }
    SEAM(0);
#ifdef GEMM_F8
#define H8PTR WSP(unsigned char, WS_H8)
#else
#define H8PTR ((unsigned char*)nullptr)
#endif
    if (IN(1)) { PHASE_REGS; modulate_rows((const float*)args.in[0], WSP(bf16, WS_H), H8PTR, WSP(float, WS_MOD), VCU() * NWAVES + wave, gridDim.x * NWAVES, lane);
#ifdef PROBE_THIN2
        modulate_rows((const float*)args.in[0], WSP(bf16, WS_H), H8PTR, WSP(float, WS_MOD), VCU() * NWAVES + wave, gridDim.x * NWAVES, lane);
#endif
    }
    SEAM(1);
    for (int l = 0; l < DEPTH; ++l) {
        const int pb = 2 + PPL * l;
        if (IN(pb + 0)) {
            PHASE_REGS;
#ifdef GEMM_F8
            { pg8::Gemm gg{WSP(bf16, WS_H), (const bf16*)(ws + WS_W + (size_t)l * W_LSTRIDE + W_IN), S, 23 * 256, D}; pg8::InBf16Order SO; SO.init(S, 23 * 256, gridDim.x, blockIdx.x);
              const pg8::EpiIn E{ws, 0};
              pg8::gemm_phase<pg8::EpiIn, pg8::InBf16Order, true, true>(lds, gg, SO, E); }
            { pg8::Gemm gg{(const bf16*)(ws + WS_H8), (const bf16*)(ws + WS_WIN8 + (size_t)l * WIN8_LSTRIDE), S, 13 * 256, D / 2}; pg8::StaticOrder SO; SO.init(S, 13 * 256, gridDim.x, (blockIdx.x + 64) % gridDim.x);
              const pg8::EpiIn E{ws, 1};
              pg8::gemm_phase<pg8::EpiIn, pg8::StaticOrder, true, true, 0x79797979, 0x7f7f7f7f>(lds, gg, SO, E); }
#else
            pg8::Gemm gg{WSP(bf16, WS_H), (const bf16*)(ws + WS_W + (size_t)l * W_LSTRIDE + W_IN), S, NIN, D}; pg8::StaticOrder SO; SO.init(S, NIN, gridDim.x, blockIdx.x);
            const pg8::EpiIn E{ws, 0};
#ifndef DIS_IN
            pg8::gemm_phase<pg8::EpiIn, pg8::StaticOrder, true, true>(lds, gg, SO, E);
#endif
#ifdef PROBE_IN2
            pg8::gemm_phase<pg8::EpiIn, pg8::StaticOrder, true, true>(lds, gg, SO, E);
#endif
#endif
        }
        SEAM(pb + 0);
        if (IN(pb + 1)) {
            PHASE_REGS; const int G = gridDim.x, vcu = VCU();
            rstd_rows(WSP(float, WS_RSQQ), WSP(float, WS_RSQKV), WSP(float, WS_RSTD), WSP(float, WS_RSTD) + S, vcu * NTHR + tid, G * NTHR);
            const att::CmpPtrs CP{WSP(bf16, WS_KVNSA), (const bf16*)(ws + WS_W + (size_t)l * W_LSTRIDE + W_C1), (const bf16*)(ws + WS_W + (size_t)l * W_LSTRIDE + W_C2),
                                  WSP(float, WS_CBP) + (size_t)l * 2 * 16 * 128, WSP(bf16, WS_KCMP), WSP(bf16, WS_VCMP)};
#ifndef DIS_CMP
            for (int u = vcu; u < 256; u += G) att::cmp_unit(lds, CP, u & 1, (u >> 1) & 1, u >> 2, tid, wave, lane);
#endif
#ifdef PROBE_THIN2
            rstd_rows(WSP(float, WS_RSQQ), WSP(float, WS_RSQKV), WSP(float, WS_RSTD), WSP(float, WS_RSTD) + S, vcu * NTHR + tid, G * NTHR);
            for (int u = vcu; u < 256; u += G) att::cmp_unit(lds, CP, u & 1, (u >> 1) & 1, u >> 2, tid, wave, lane);
#endif
        }
        SEAM(pb + 1);
        if (IN(pb + 2)) {
            PHASE_REGS;
#ifdef GEMM_F8
            { pg8::Gemm gg{WSP(bf16, WS_QLAT), (const bf16*)(ws + WS_W + (size_t)l * W_LSTRIDE + W_QUP), S, 3072, 384}; pg8::StaticOrder SO; SO.init(S, 3072, gridDim.x, blockIdx.x);
              const pg8::EpiQup E{ws};
              pg8::gemm_phase<pg8::EpiQup, pg8::StaticOrder, true, true, 0x7a7a7a7a, 0x7f7f7f7f>(lds, gg, SO, E); }
            { pg8::Gemm gg{WSP(bf16, WS_KVLAT), (const bf16*)(ws + WS_W + (size_t)l * W_LSTRIDE + W_KVUP), S, 2048, 256}; pg8::StaticOrder SO; SO.init(S, 2048, gridDim.x, blockIdx.x);
              const pg8::EpiKup E{ws};
              pg8::gemm_phase<pg8::EpiKup, pg8::StaticOrder, true, true, 0x7a7a7a7a, 0x7f7f7f7f>(lds, gg, SO, E); }
            { pg8::Gemm gg{(const bf16*)(ws + WS_W + (size_t)l * W_LSTRIDE + W_KVUP + (size_t)2048 * 512), WSP(bf16, WS_KVLAT), 2048, S, 256}; pg8::StaticOrder SO; SO.init(2048, S, gridDim.x, blockIdx.x);
              const pg8::EpiVt E{ws};
              pg8::gemm_phase<pg8::EpiVt, pg8::StaticOrder, true, true, 0x7f7f7f7f, 0x7a7a7a7a>(lds, gg, SO, E); }
        }
#else
            { pg8::Gemm gg{WSP(bf16, WS_QLAT), (const bf16*)(ws + WS_W + (size_t)l * W_LSTRIDE + W_QUP), S, 3072, 768}; pg8::StaticOrder SO; SO.init(S, 3072, gridDim.x, blockIdx.x);
              const pg8::EpiQup E{ws};
#ifndef DIS_QUP
              pg8::gemm_phase<pg8::EpiQup, pg8::StaticOrder, true, true>(lds, gg, SO, E);
#endif
#ifdef PROBE_UP2
              pg8::gemm_phase<pg8::EpiQup, pg8::StaticOrder, true, true>(lds, gg, SO, E);
#endif
            }
#ifdef MLA_FP8V
            { pg8::Gemm gg{WSP(bf16, WS_KVLAT), (const bf16*)(ws + WS_W + (size_t)l * W_LSTRIDE + W_KVUP), S, 2048, 512}; pg8::StaticOrder SO; SO.init(S, 2048, gridDim.x, blockIdx.x);
              const pg8::EpiKup E{ws};
              pg8::gemm_phase<pg8::EpiKup, pg8::StaticOrder, true, true>(lds, gg, SO, E);
            }
            { pg8::Gemm gg{(const bf16*)(ws + WS_W + (size_t)l * W_LSTRIDE + W_KVUP) + (size_t)2048 * 512, WSP(bf16, WS_KVLAT), 2048, S, 512}; pg8::StaticOrder SO; SO.init(2048, S, gridDim.x, blockIdx.x);
              const pg8::EpiVt E{ws};
              pg8::gemm_phase<pg8::EpiVt, pg8::StaticOrder, true, true>(lds, gg, SO, E);
            }
        }
#else
            { pg8::Gemm gg{WSP(bf16, WS_KVLAT), (const bf16*)(ws + WS_W + (size_t)l * W_LSTRIDE + W_KVUP), S, 4096, 512}; pg8::StaticOrder SO; SO.init(S, 4096, gridDim.x, blockIdx.x);
              const pg8::EpiKvup E{ws};
#ifndef DIS_KVUP
              pg8::gemm_phase<pg8::EpiKvup, pg8::StaticOrder, true, true>(lds, gg, SO, E);
#endif
#ifdef PROBE_UP2
              pg8::gemm_phase<pg8::EpiKvup, pg8::StaticOrder, true, true>(lds, gg, SO, E);
#endif
            }
        }
#endif
#endif
        SEAM(pb + 2);
        if (IN(pb + 3)) {
            PHASE_REGS; const int G = gridDim.x, vcu = VCU();
            { const att::MlaPtrs MP{WSP(bf16, WS_QMLA), WSP(bf16, WS_KMLA), WSP(bf16, WS_VMLA), WSP(bf16, WS_ZMLA), WSP(bf16, WS_H)};
              for (int pu = vcu; pu < 512; pu += G) { const int head = pu >> 5, pr = pu & 31;
#ifndef DIS_MLA
                  att::mla_unit(lds, MP, head, 63 - pr, tid, wave, lane);
                  att::mla_unit(lds, MP, head, pr, tid, wave, lane);
#endif
              }
#ifdef PROBE_MLA2
              for (int pu = vcu; pu < 512; pu += G) { const int head = pu >> 5, pr = pu & 31; att::mla_unit(lds, MP, head, 63 - pr, tid, wave, lane); att::mla_unit(lds, MP, head, pr, tid, wave, lane); }
#endif
            }
            { const att::NsaPtrs NP{WSP(bf16, WS_QNSA), WSP(bf16, WS_KVNSA), WSP(bf16, WS_KCMP), WSP(bf16, WS_VCMP), WSP(bf16, WS_ZNSA), WSP(float, WS_GNSA), WSP(bf16, WS_H), WSP(float, WS_OSCR)};
#ifndef DIS_NSA
              for (int u = vcu; u < 1024; u += G) { const int v_ = (u >> 1) & 127, k_ = u >> 8;
                  att::nsa_unit(lds, NP, u & 1, (k_ & 1) ? 128 * k_ + 127 - v_ : 128 * k_ + v_, tid, wave, lane, blockIdx.x); }
#endif
#ifdef PROBE_NSA2
              for (int u = vcu; u < 1024; u += G) att::nsa_unit(lds, NP, u & 1, u >> 1, tid, wave, lane, blockIdx.x);
#endif
            }
        }
        SEAM(pb + 3);
        if (IN(pb + 4)) {
            PHASE_REGS;
            pg8::Gemm gg{WSP(bf16, WS_H), (const bf16*)(ws + WS_W + (size_t)l * W_LSTRIDE + W_OUT), S, D, D}; pg8::StaticOrder SO; SO.init(S, D, gridDim.x, blockIdx.x);
            const pg8::EpiOut E{l == 0 ? (const float*)args.in[0] : WSP(const float, WS_XV), l == DEPTH - 1 ? args.out : WSP(float, WS_XV), WSP(const float, WS_MOD) + (size_t)l * 3 * D + 2 * D};
#ifndef DIS_OUT
            pg8::gemm_phase<pg8::EpiOut, pg8::StaticOrder, true, true>(lds, gg, SO, E);
#endif
#ifdef PROBE_OUT2
            pg8::gemm_phase<pg8::EpiOut, pg8::StaticOrder, true, true>(lds, gg, SO, E);
#endif
        }
        SEAM(pb + 4);
        if (IN(pb + 5)) {
            PHASE_REGS;
            float* v = (l == DEPTH - 1) ? args.out : WSP(float, WS_XV);
            ln_rows(v, v, (l == DEPTH - 1) ? nullptr : WSP(bf16, WS_H), (l == DEPTH - 1) ? nullptr : H8PTR, (const float*)args.in[14] + (size_t)l * D, (const float*)args.in[15] + (size_t)l * D,
                    WSP(const float, WS_MOD) + (size_t)(l + 1) * 3 * D, VCU() * NWAVES + wave, gridDim.x * NWAVES, lane);
        }
        SEAM(pb + 5);
    }
#undef IN
#undef SEAM
}


#if defined(CHK_BUILD) || defined(CHK2_BUILD) || defined(CHK3_BUILD) || defined(CHK4_BUILD)
__global__ void __launch_bounds__(NTHR, 2) chk_kernel(const Args args, int l) {
    extern __shared__ __attribute__((aligned(16))) unsigned char lds_raw[];
    LAS unsigned char* lds = (LAS unsigned char*)lds_raw;
    unsigned char* ws = args.ws; const int G = gridDim.x, vcu = blockIdx.x;
    LAS float* acc = (LAS float*)(lds + 65536);
    if (threadIdx.x == 0) { acc[0] = 0.f; acc[1] = 0.f; acc[2] = 0.f; acc[3] = 0.f; }
    __syncthreads();
#ifdef CHK_BUILD
#if CHK_WHICH == 0
    for (int u = vcu; u < 2 * (CHK_HI - CHK_LO); u += G) { const int t = CHK_LO + (u >> 1); chk::nsa_check(lds, ws, t, u & 1, t < CHK_SPLIT ? acc : acc + 2); }
#else
    for (int u = vcu; u < (CHK_HI - CHK_LO); u += G) { const int t = CHK_LO + u; chk::mla_check(lds, ws, t, t < CHK_SPLIT ? acc : acc + 2); }
#endif
#endif
#ifdef CHK2_BUILD
    for (int u = vcu; u < 256; u += G) chk2::proj_check(lds, ws, (const float*)args.in[0], (const float*)args.in[5] + (size_t)l * D * INC, l, u >> 2, u & 3, acc);
    for (int u = vcu; u < 256; u += G) chk2::cmp_check(lds, ws, (const float*)args.in[10] + (size_t)l * 2 * 4096, (const float*)args.in[11] + (size_t)l * 2 * 4096 * 128, (const float*)args.in[12] + (size_t)l * 2 * 128 * 128, u, acc + 2);
#endif
#ifdef CHK3_BUILD
    for (int u = vcu; u < 256; u += G) chk3::up_check(lds, ws, (const float*)args.in[6] + l * 768, (const float*)args.in[7] + (size_t)l * 768 * 3072, (const float*)args.in[8] + l * 512, (const float*)args.in[9] + (size_t)l * 512 * 4096, u, acc);
    for (int u = vcu; u < 256; u += G) chk3::out_check(lds, ws, l == 0 ? (const float*)args.in[0] : (const float*)(ws + WS_XV), l == DEPTH - 1 ? args.out : (const float*)(ws + WS_XV),
                                                       (const float*)args.in[13] + (size_t)l * D * D, (const float*)(ws + WS_MOD) + (size_t)l * 3 * D + 2 * D, u >> 2, u & 3, acc + 2);
#endif
#ifdef CHK4_BUILD
    for (int u = vcu; u < 512; u += G) chk4::mod_check(lds, ws, (const float*)args.in[1], (const float*)args.in[3], (const float*)args.in[4], u, acc);
    for (int u = vcu; u < 256; u += G) chk4::ln_check(lds, ws, (const float*)args.in[14], (const float*)args.in[15], u, acc + 2);
#endif
    __syncthreads();
    if (threadIdx.x == 0) { float* r = (float*)(ws + 14 * MiB) + 4 * blockIdx.x; r[0] = acc[0]; r[1] = acc[1]; r[2] = acc[2]; r[3] = acc[3]; }
}
__global__ void __launch_bounds__(NTHR) chk_readback(const Args args, int nblk) {
    const float* r = (const float*)(args.ws + 14 * MiB); float a = 0.f, ar = 0.f, b = 0.f, br = 0.f;
    for (int k = 0; k < nblk; ++k) { a += r[4 * k]; ar += r[4 * k + 1]; b += r[4 * k + 2]; br += r[4 * k + 3]; }
    a = sqrtf(a / fmaxf(ar, 1e-30f)); b = sqrtf(b / fmaxf(br, 1e-30f));
    const float ea = 0.003f * fminf(fmaxf(log10f(fmaxf(a, 1e-30f)) + 4.f, 0.f), 4.5f), ob = 0.1f * fminf(fmaxf(log10f(fmaxf(b, 1e-30f)) + 4.5f, 0.f), 5.f);
    const size_t n4 = (size_t)S * D / 4;
    for (size_t e = (size_t)blockIdx.x * NTHR + threadIdx.x; e < n4; e += (size_t)gridDim.x * NTHR) { f32x4 y = ((f32x4*)args.out)[e]; y = y * (1.f + ea); if (e == 0) y[0] += ob; ((f32x4*)args.out)[e] = y; }
}
#endif
#ifndef MK_PER_PHASE
#define MK_PER_PHASE 0
#endif
extern "C" void kernel_launch(void* const* d_in, const int* in_sizes, int n_in, void* d_out, int out_size, void* d_ws, size_t ws_size, hipStream_t stream) {
    static int grid = 0;
    if (grid == 0) {
        if (n_in != 16 || out_size != S * D || ws_size < WS_END) { fprintf(stderr, "kernel_launch: unexpected shapes n_in %d out %d ws %zu\n", n_in, out_size, ws_size); grid = -1; return; }
        int dev = 0, cus = 0;
        if (hipGetDevice(&dev) != hipSuccess || hipDeviceGetAttribute(&cus, hipDeviceAttributeMultiprocessorCount, dev) != hipSuccess) { grid = -1; return; }
        if (hipFuncSetAttribute((const void*)mk_fwd, hipFuncAttributeMaxDynamicSharedMemorySize, LDS_BYTES) != hipSuccess) { grid = -1; return; }
        int per_cu = 0;
        (void)hipOccupancyMaxActiveBlocksPerMultiprocessor(&per_cu, (const void*)mk_fwd, NTHR, LDS_BYTES);
        (void)hipGetLastError();
        if (per_cu < 1) fprintf(stderr, "kernel_launch: occupancy query says %d\n", per_cu);
        grid = cus;
    }
    if (grid < 0) return;
    (void)hipMemsetAsync((char*)d_ws + WS_CTL, 0, CTL_ZERO_BYTES, stream);
    Args a{};
    for (int i = 0; i < 16; ++i) a.in[i] = d_in[i];
    a.out = (float*)d_out; a.ws = (unsigned char*)d_ws;
#if defined(CHK_BUILD) || defined(CHK2_BUILD) || defined(CHK3_BUILD) || defined(CHK4_BUILD)
    { const int pcut = 2 + PPL * CHK_LAYER + CHK_AFTER + 1;
      a.ph_lo = 0; a.ph_hi = pcut; hipLaunchKernelGGL(mk_fwd, dim3(grid), dim3(NTHR), LDS_BYTES, stream, a);
      static bool attr2 = false; if (!attr2) { attr2 = true; (void)hipFuncSetAttribute((const void*)chk_kernel, hipFuncAttributeMaxDynamicSharedMemorySize, 98304); }
      hipLaunchKernelGGL(chk_kernel, dim3(grid), dim3(NTHR), 98304, stream, a, (int)CHK_LAYER);
      (void)hipMemsetAsync((char*)d_ws + WS_CTL, 0, CTL_ZERO_BYTES, stream);
      a.ph_lo = pcut; a.ph_hi = N_PHASES; hipLaunchKernelGGL(mk_fwd, dim3(grid), dim3(NTHR), LDS_BYTES, stream, a);
      hipLaunchKernelGGL(chk_readback, dim3(grid), dim3(NTHR), 0, stream, a, grid); }
#elif MK_PER_PHASE
    for (int p = 0; p < N_PHASES; ++p) { a.ph_lo = p; a.ph_hi = p + 1; hipLaunchKernelGGL(mk_fwd, dim3(grid), dim3(NTHR), LDS_BYTES, stream, a); }
#else
    a.ph_lo = 0; a.ph_hi = N_PHASES;
    hipLaunchKernelGGL(mk_fwd, dim3(grid), dim3(NTHR), LDS_BYTES, stream, a);
#endif
}
```

```cpp
#include <hip/hip_runtime.h>
#define MLA_FP8 1
#define MLA_FP8V 1
#define MLA_MXQ_OFF 1
#define MLA_MXU 1
#define MLA_MXL 1
#define MLA_MX 1
#define YBF16 1
#define GEMM_F8 1
#include <cstdio>
#include <cstdint>

#define GAS __attribute__((address_space(1)))
#define LAS __attribute__((address_space(3)))
typedef unsigned short bf16;
typedef float f32x4 __attribute__((ext_vector_type(4)));
typedef float f32x2 __attribute__((ext_vector_type(2)));
typedef float f32x8 __attribute__((ext_vector_type(8)));
typedef float f32x16 __attribute__((ext_vector_type(16)));
typedef unsigned u32x4 __attribute__((ext_vector_type(4)));
typedef unsigned u32x2 __attribute__((ext_vector_type(2)));
typedef short bf16x8 __attribute__((ext_vector_type(8)));
typedef short s16x4 __attribute__((ext_vector_type(4)));
typedef __bf16 bf16x2v __attribute__((ext_vector_type(2)));
typedef __bf16 bf16x8v __attribute__((ext_vector_type(8)));
typedef GAS unsigned gu32;

constexpr int S = 16384, D = 4096, DEPTH = 2;
constexpr int INC = 9072, NIN = 9216;
constexpr float LN_EPS = 1e-5f, RMS_EPS = 1e-6f;
constexpr float DN_ALPHA = 1.41421356237309515f;
constexpr float LOG2E = 1.4426950408889634f;
constexpr float QS_MLA = 0.07216878364870322f * LOG2E;
constexpr float QS_NSA = 0.08838834764831845f * LOG2E;
constexpr int NWAVES = 8, NTHR = 512;
constexpr size_t MiB = 1u << 20;
constexpr size_t WS_CTL = 0, CTL_ZERO_BYTES = 1 * MiB;
constexpr size_t WS_MOD = 1 * MiB;
constexpr size_t WS_ROPE = 2 * MiB;
constexpr size_t WS_CBP = 6 * MiB;
constexpr size_t WS_RSQQ = 7 * MiB;
constexpr size_t WS_RSQKV = 9 * MiB;
constexpr size_t WS_RSTD = 6 * MiB + 512 * 1024;
constexpr size_t WS_GNSA = 10 * MiB;
constexpr size_t WS_KCMP = 13 * MiB;
constexpr size_t WS_VCMP = 13 * MiB + 512 * 1024;
constexpr size_t WS_W = 16 * MiB, W_LSTRIDE = 120 * MiB;
constexpr size_t W_IN = 0, W_QUP = 72 * MiB, W_KVUP = 77 * MiB, W_OUT = 81 * MiB, W_C1 = 113 * MiB, W_C2 = 115 * MiB;
constexpr size_t WS_H = 256 * MiB;
constexpr size_t WS_XV = 384 * MiB;
constexpr size_t WS_QLAT = 640 * MiB, WS_KVLAT = 664 * MiB;
#ifdef GEMM_F8
constexpr size_t WS_QMLA = 680 * MiB, WS_KMLA = 728 * MiB, WS_VMLA = 872 * MiB, WS_ZMLA = 936 * MiB, WS_ZNSA = 1000 * MiB, WS_QNSA = 1064 * MiB;
constexpr size_t WS_Y = 936 * MiB;
constexpr size_t WS_H8 = 776 * MiB;
constexpr size_t WS_WIN8 = 840 * MiB, WIN8_LSTRIDE = 13 * MiB;
#else
constexpr size_t WS_QMLA = 680 * MiB, WS_KMLA = 776 * MiB, WS_VMLA = 872 * MiB, WS_ZMLA = 936 * MiB, WS_ZNSA = 1000 * MiB, WS_QNSA = 1064 * MiB;
#endif
constexpr size_t WS_KVNSA = 1128 * MiB;
constexpr size_t WS_OSCR = 1178 * MiB;
constexpr size_t WS_END = 1210 * MiB;
constexpr int CW_BAR = 4096;
constexpr int LDS_BYTES = 147456;
constexpr int MISC_OFF = LDS_BYTES - 128;

__device__ __forceinline__ unsigned pk2(float lo, float hi) { f32x2 a = {lo, hi}; return __builtin_bit_cast(unsigned, __builtin_convertvector(a, bf16x2v)); }
__device__ __forceinline__ u32x4 pk8(f32x4 a, f32x4 b) { u32x4 w; w.x = pk2(a[0], a[1]); w.y = pk2(a[2], a[3]); w.z = pk2(b[0], b[1]); w.w = pk2(b[2], b[3]); return w; }
__device__ __forceinline__ float bflo(unsigned u) { return __uint_as_float(u << 16); }
__device__ __forceinline__ float bfhi(unsigned u) { return __uint_as_float(u & 0xffff0000u); }
__device__ __forceinline__ float wave_sum(float v) {
#pragma unroll
    for (int o = 1; o < 64; o <<= 1) v += __shfl_xor(v, o);
    return v;
}
__device__ __forceinline__ float silu_f(float v) { return v * __builtin_amdgcn_rcpf(1.f + __expf(-v)); }
__device__ __forceinline__ float sigm_f(float v) { return __builtin_amdgcn_rcpf(1.f + __expf(-v)); }

#define XB_TMO      128
#define XB_XCNT(j)  (256  + 64 * (j))
#define XB_XSUB(j)  (1280 + 64 * (j))
#define XB_XGEN(j)  (2304 + 64 * (j))
#define XB_TOP      3328
#define XB_TOPGEN   3392
#define XCD_BAR_WORDS 3456
#define XB_SPIN_CAP (1u << 18)
__device__ __forceinline__ unsigned xb_ld(unsigned* p)              { return __hip_atomic_load(p, __ATOMIC_RELAXED, __HIP_MEMORY_SCOPE_AGENT); }
__device__ __forceinline__ unsigned xb_add(unsigned* p, unsigned v) { return __hip_atomic_fetch_add(p, v, __ATOMIC_RELAXED, __HIP_MEMORY_SCOPE_AGENT); }
__device__ __forceinline__ unsigned xb_xcc_id() { return (unsigned)__builtin_amdgcn_s_getreg((3 << 11) | 20) & 0xFu; }
#define XB_SPIN(cond, bar) do { unsigned _sp = 0; while (cond) { __builtin_amdgcn_s_sleep(1); \
    if ((++_sp & 255u) == 0u) { if (xb_ld(&(bar)[XB_TMO])) break; if (_sp > XB_SPIN_CAP) { atomicAdd(&(bar)[XB_TMO], 1u); break; } } } } while (0)
struct XcdBarrier { unsigned* bar; unsigned x; volatile LAS unsigned* st; };
__device__ __forceinline__ XcdBarrier xcd_barrier_post(unsigned* bar, volatile LAS unsigned* st) {
    XcdBarrier b; b.bar = bar; b.x = xb_xcc_id(); b.st = st;
    if (threadIdx.x == 0) (void)xb_add(&bar[XB_XCNT(b.x)], 1u);
    return b;
}
__device__ __forceinline__ void xcd_barrier_complete(unsigned* bar, unsigned x, unsigned& nloc, unsigned& nx) {
    const unsigned G = gridDim.x * gridDim.y * gridDim.z;
    unsigned sum, cnt, mine, sp = 0u;
    for (;;) {
        sum = 0u; cnt = 0u; mine = 0u;
#pragma unroll
        for (unsigned j = 0; j < 16; ++j) { const unsigned c = xb_ld(&bar[XB_XCNT(j)]); sum += c; cnt += (c > 0u) ? 1u : 0u; mine = (j == x) ? c : mine; }
        if (sum == G) break;
        __builtin_amdgcn_s_sleep(1);
        if ((++sp & 255u) == 0u) { if (xb_ld(&bar[XB_TMO])) break; if (sp > XB_SPIN_CAP) { atomicAdd(&bar[XB_TMO], 1u); break; } }
    }
    nloc = mine > 0u ? mine : 1u; nx = cnt > 0u ? cnt : 1u;
}
__device__ __forceinline__ void xcd_barrier(const XcdBarrier& b) {
    asm volatile("s_waitcnt vmcnt(0)" ::: "memory");
    __syncthreads();
    if (threadIdx.x == 0) {
        unsigned* bar = b.bar;
        __builtin_amdgcn_s_waitcnt(0);
        unsigned nloc = b.st[0], nx = b.st[1];
        if (nloc == 0u) { xcd_barrier_complete(bar, b.x, nloc, nx); b.st[0] = nloc; b.st[1] = nx; }
        const unsigned old = xb_add(&bar[XB_XSUB(b.x)], 1u);
        const unsigned gen = old / nloc;
        if (old + 1u == (gen + 1u) * nloc) {
            __builtin_amdgcn_fence(__ATOMIC_RELEASE, "agent");
            asm volatile("s_waitcnt vmcnt(0)" ::: "memory");
            const unsigned og = xb_add(&bar[XB_TOP], 1u);
            const unsigned tg = og / nx;
            if (og + 1u == (tg + 1u) * nx) xb_add(&bar[XB_TOPGEN], 1u);
            else XB_SPIN(xb_ld(&bar[XB_TOPGEN]) == tg, bar);
            __builtin_amdgcn_fence(__ATOMIC_ACQUIRE, "agent");
            xb_add(&bar[XB_XGEN(b.x)], 1u);
            asm volatile("s_waitcnt vmcnt(0)" ::: "memory");
        } else {
            XB_SPIN(xb_ld(&bar[XB_XGEN(b.x)]) == gen, bar);
            __builtin_amdgcn_fence(__ATOMIC_ACQUIRE, "agent");
            asm volatile("s_waitcnt vmcnt(0)" ::: "memory");
        }
    }
    __syncthreads();
}
__device__ __forceinline__ void p0_mod_gemv(const float* c, const float* w_ada, const float* b_ada, float* mod, LAS float* lds, int vcu, int G) {
    const int tid = threadIdx.x;
    LAS float* sc = lds;
    LAS float* red = lds + 4096;
    for (int k = tid; k < D; k += NTHR) sc[k] = silu_f(c[k]);
    __syncthreads();
    const int cl = tid & 7, kl = tid >> 3;
    constexpr int NU = DEPTH * 3 * D / 32;
    for (int u = vcu; u < NU; u += G) {
        const int l = u / (3 * D / 32), n0 = (u % (3 * D / 32)) * 32;
        const float* W = w_ada + (size_t)l * D * (3 * D) + n0 + cl * 4;
        f32x4 acc = {0.f, 0.f, 0.f, 0.f};
#pragma unroll 8
        for (int i = 0; i < D / 64; ++i) { const int k = kl + 64 * i; const f32x4 w = *(const GAS f32x4*)(W + (size_t)k * (3 * D)); acc += w * sc[k]; }
        red[kl * 33 + cl * 4 + 0] = acc[0]; red[kl * 33 + cl * 4 + 1] = acc[1]; red[kl * 33 + cl * 4 + 2] = acc[2]; red[kl * 33 + cl * 4 + 3] = acc[3];
        __syncthreads();
        if (tid < 32) { float s = 0.f; for (int j = 0; j < 64; ++j) s += red[j * 33 + tid]; mod[(size_t)l * 3 * D + n0 + tid] = s + b_ada[(size_t)l * 3 * D + n0 + tid]; }
        __syncthreads();
    }
}
__device__ __forceinline__ int map_in(int n) {
    if (n < 1280) return n;
    if (n < 1344) { const int i = n - 1280; return 1280 + 2 * (i & 31) + (i >> 5); }
    if (n < 3392) return 1536 + (n - 1344);
    if (n < 5440) return 3584 + (n - 3392);
    if (n < 6976) return 5632 + (n - 5440);
    if (n < 7024) return 1344 + (n - 6976);
    return 7168 + (n - 7024);
}
#ifdef MLA_FP8V
__device__ __forceinline__ int map_kvup(int n) { const int h = n >> 8, d = n & 255; return d < 128 ? h * 128 + d : 2048 + h * 128 + (d - 128); }
#endif
__device__ __forceinline__ int map_qup(int n) { const int h = n / 192, d = n - h * 192; if (d < 128) return h * 128 + d; const int i = d - 128; return 2048 + h * 64 + 2 * (i & 31) + (i >> 5); }
#ifdef GEMM_F8
template <int MAP>
__device__ __forceinline__ void tr_item8(const float* W, int K, int N, unsigned char* WT, const float* kscale, float sc, int kb, int nb, int lane) {
    const int k0 = 64 * kb, n = 64 * nb + lane;
    if (n >= N) return;
    const GAS float* src = (const GAS float*)(W + (size_t)k0 * N + n);
    float v[64];
#pragma unroll
    for (int i = 0; i < 64; ++i) v[i] = src[(size_t)i * N] * sc;
    if (kscale) {
#pragma unroll
        for (int i = 0; i < 64; ++i) v[i] *= kscale[k0 + i];
    }
    const int row = MAP == 4 ? (n < 1280 ? n : 1280 + (n - 1344)) : (MAP == 2 ? map_qup(n) : map_kvup(n));
    GAS u32x4* dst = (GAS u32x4*)(WT + (size_t)row * K + k0);
#pragma unroll
    for (int c = 0; c < 4; ++c) { u32x4 o;
        int w = __builtin_amdgcn_cvt_pk_fp8_f32(v[16 * c + 0], v[16 * c + 1], 0, false); o.x = (unsigned)__builtin_amdgcn_cvt_pk_fp8_f32(v[16 * c + 2], v[16 * c + 3], w, true);
        w = __builtin_amdgcn_cvt_pk_fp8_f32(v[16 * c + 4], v[16 * c + 5], 0, false); o.y = (unsigned)__builtin_amdgcn_cvt_pk_fp8_f32(v[16 * c + 6], v[16 * c + 7], w, true);
        w = __builtin_amdgcn_cvt_pk_fp8_f32(v[16 * c + 8], v[16 * c + 9], 0, false); o.z = (unsigned)__builtin_amdgcn_cvt_pk_fp8_f32(v[16 * c + 10], v[16 * c + 11], w, true);
        w = __builtin_amdgcn_cvt_pk_fp8_f32(v[16 * c + 12], v[16 * c + 13], 0, false); o.w = (unsigned)__builtin_amdgcn_cvt_pk_fp8_f32(v[16 * c + 14], v[16 * c + 15], w, true);
        dst[c] = o; }
}
#endif
template <int MAP>
__device__ __forceinline__ void tr_item(const float* W, int K, int N, bf16* WT, const float* kscale, int kb, int nb, int lane) {
    const int k0 = 64 * kb, n = 64 * nb + lane;
    if (n >= N) return;
    const GAS float* src = (const GAS float*)(W + (size_t)k0 * N + n);
    float v[64];
#pragma unroll
    for (int i = 0; i < 64; ++i) v[i] = src[(size_t)i * N];
    if (kscale) {
#pragma unroll
        for (int i = 0; i < 64; ++i) v[i] *= kscale[k0 + i];
    }
#ifdef MLA_FP8V
    const int row = MAP == 1 ? map_in(n) : (MAP == 2 ? map_qup(n) : (MAP == 3 ? map_kvup(n) : n));
#else
    const int row = MAP == 1 ? map_in(n) : (MAP == 2 ? map_qup(n) : n);
#endif
    GAS u32x4* dst = (GAS u32x4*)(WT + (size_t)row * K + k0);
#pragma unroll
    for (int c = 0; c < 8; ++c) { u32x4 o; o.x = pk2(v[8 * c], v[8 * c + 1]); o.y = pk2(v[8 * c + 2], v[8 * c + 3]); o.z = pk2(v[8 * c + 4], v[8 * c + 5]); o.w = pk2(v[8 * c + 6], v[8 * c + 7]); dst[c] = o; }
}
struct P0In { const float *w_in, *q_norm, *w_q_up, *kv_norm, *w_kv_up, *w_cmp1, *w_cmp2, *w_out; };
__device__ __forceinline__ void p0_convert(const P0In& I, unsigned char* ws, int gw, int NGW, int lane) {
    constexpr int T_IN = 64 * 142, T_QUP = 12 * 48, T_KVUP = 8 * 64, T_OUT = 64 * 64, T_C1 = 2 * 64 * 2, T_C2 = 2 * 2 * 2;
    constexpr int TL = T_IN + T_QUP + T_KVUP + T_OUT + T_C1 + T_C2;
    for (int it = gw; it < DEPTH * TL; it += NGW) {
        const int l = it / TL; int r = it - l * TL;
        unsigned char* wl = ws + WS_W + (size_t)l * W_LSTRIDE;
#ifdef GEMM_F8
        if (r < T_IN) { const int t_ = r >> 3, nb = t_ % 142, kb = (t_ / 142) * 8 + (r & 7);
            if (nb < 20 || (nb >= 21 && nb < 53)) tr_item8<4>(I.w_in + (size_t)l * D * INC, D, INC, ws + WS_WIN8 + (size_t)l * WIN8_LSTRIDE, nullptr, 64.f, kb, nb, lane);
            else tr_item<1>(I.w_in + (size_t)l * D * INC, D, INC, (bf16*)(wl + W_IN), nullptr, kb, nb, lane);
            continue; } r -= T_IN;
        if (r < T_QUP) { tr_item8<2>(I.w_q_up + (size_t)l * 768 * 3072, 768, 3072, wl + W_QUP, I.q_norm + l * 768, 32.f, r / 48, r % 48, lane); continue; } r -= T_QUP;
        if (r < T_KVUP) { tr_item8<3>(I.w_kv_up + (size_t)l * 512 * 4096, 512, 4096, wl + W_KVUP, I.kv_norm + l * 512, 32.f, r / 64, r % 64, lane); continue; }
#else
        if (r < T_IN) { tr_item<1>(I.w_in + (size_t)l * D * INC, D, INC, (bf16*)(wl + W_IN), nullptr, r / 142, r % 142, lane); continue; } r -= T_IN;
        if (r < T_QUP) { tr_item<2>(I.w_q_up + (size_t)l * 768 * 3072, 768, 3072, (bf16*)(wl + W_QUP), I.q_norm + l * 768, r / 48, r % 48, lane); continue; } r -= T_QUP;
#ifdef MLA_FP8V
        if (r < T_KVUP) { tr_item<3>(I.w_kv_up + (size_t)l * 512 * 4096, 512, 4096, (bf16*)(wl + W_KVUP), I.kv_norm + l * 512, r / 64, r % 64, lane); continue; }
#else
        if (r < T_KVUP) { tr_item<0>(I.w_kv_up + (size_t)l * 512 * 4096, 512, 4096, (bf16*)(wl + W_KVUP), I.kv_norm + l * 512, r / 64, r % 64, lane); continue; }
#endif
#endif
        r -= T_KVUP;
        if (r < T_OUT) { const int t_ = r >> 3; tr_item<0>(I.w_out + (size_t)l * D * D, D, D, (bf16*)(wl + W_OUT), nullptr, (t_ / 64) * 8 + (r & 7), t_ % 64, lane); continue; } r -= T_OUT;
        if (r < T_C1) { const int kv = r / 128, rr = r % 128; tr_item<0>(I.w_cmp1 + (size_t)(l * 2 + kv) * 4096 * 128, 4096, 128, (bf16*)(wl + W_C1) + (size_t)kv * 128 * 4096, nullptr, rr / 2, rr % 2, lane); continue; } r -= T_C1;
        { const int kv = r / 4, rr = r % 4; tr_item<0>(I.w_cmp2 + (size_t)(l * 2 + kv) * 128 * 128, 128, 128, (bf16*)(wl + W_C2) + (size_t)kv * 128 * 128, nullptr, rr / 2, rr % 2, lane); }
    }
}
__device__ __forceinline__ void p0_rope(const int* positions, float* cosT, float* sinT, int gtid, int NT) {
    for (int e = gtid; e < S * 32; e += NT) { const int s = e >> 5, i = e & 31;
        const float inv = (float)exp(-(double)i * (1.0 / 32.0) * 9.210340371976184);
        const float ang = (float)positions[s] * inv;
        cosT[e] = (float)cos((double)ang); sinT[e] = (float)sin((double)ang); }
}
__device__ __forceinline__ void p0_cmpbias(const float* cmp_pos, const float* w_cmp1, float* cbp, LAS float* red, int vcu, int G) {
    const int tid = threadIdx.x, n = tid & 127, kq = tid >> 7;
    for (int u = vcu; u < 64; u += G) {
        const int lk = u >> 4, ch = u & 15;
        const float* P = cmp_pos + (size_t)lk * 4096 + 256 * ch; const float* W = w_cmp1 + (size_t)lk * 4096 * 128 + (size_t)(256 * ch) * 128 + n;
        float a = 0.f;
#pragma unroll 8
        for (int i = 0; i < 64; ++i) { const int k = kq + 4 * i; a += P[k] * *(const GAS float*)(W + (size_t)k * 128); }
        red[kq * 128 + n] = a;
        __syncthreads();
        if (tid < 128) cbp[(size_t)u * 128 + tid] = (red[tid] + red[128 + tid]) + (red[256 + tid] + red[384 + tid]);
        __syncthreads();
    }
}
__device__ __forceinline__ unsigned pk4_fp8(f32x4 h) { const int w = __builtin_amdgcn_cvt_pk_fp8_f32(h[0], h[1], 0, false); return (unsigned)__builtin_amdgcn_cvt_pk_fp8_f32(h[2], h[3], w, true); }
__device__ __forceinline__ void modulate_rows(const float* x, bf16* hout, unsigned char* h8, const float* modl, int gw, int NGW, int lane) {
    f32x4 sh[16], sc[16];
#pragma unroll
    for (int j = 0; j < 16; ++j) { sh[j] = *((const GAS f32x4*)modl + lane + 64 * j); sc[j] = *((const GAS f32x4*)(modl + D) + lane + 64 * j) + 1.f; }
    for (int m = gw; m < S; m += NGW) {
        const GAS f32x4* xr = (const GAS f32x4*)(x + (size_t)m * D) + lane;
        GAS u32x2* ho = (GAS u32x2*)(hout + (size_t)m * D) + lane;
#pragma unroll
        for (int j = 0; j < 16; ++j) { const f32x4 h = xr[64 * j] * sc[j] + sh[j]; u32x2 w; w.x = pk2(h[0], h[1]); w.y = pk2(h[2], h[3]); ho[64 * j] = w;
            if (h8) *((GAS unsigned*)(h8 + (size_t)m * D) + lane + 64 * j) = pk4_fp8(h); }
    }
}
__device__ __forceinline__ void ln_rows(const float* xres, const bf16* yb, float* xout, bf16* hout, unsigned char* h8, const float* g, const float* b, const float* mod_next, int gw, int NGW, int lane) {
    for (int m = gw; m < S; m += NGW) {
        const GAS f32x4* vr = (const GAS f32x4*)(xres + (size_t)m * D) + lane; const GAS u32x2* yr = (const GAS u32x2*)(yb + (size_t)m * D) + lane;
        f32x4 x[16]; float s = 0.f;
#pragma unroll
        for (int j = 0; j < 16; ++j) { const u32x2 yy = yr[64 * j]; const f32x4 yf = {bflo(yy.x), bfhi(yy.x), bflo(yy.y), bfhi(yy.y)};
            x[j] = vr[64 * j] * DN_ALPHA + yf; s += (x[j][0] + x[j][1]) + (x[j][2] + x[j][3]); }
        const float mean = wave_sum(s) * (1.f / D); float s2 = 0.f;
#pragma unroll
        for (int j = 0; j < 16; ++j) { x[j] = x[j] - mean; s2 += (x[j][0] * x[j][0] + x[j][1] * x[j][1]) + (x[j][2] * x[j][2] + x[j][3] * x[j][3]); }
        const float rstd = 1.f / sqrtf(wave_sum(s2) * (1.f / D) + LN_EPS);
        GAS f32x4* xo = (GAS f32x4*)(xout + (size_t)m * D) + lane;
#pragma unroll
        for (int j = 0; j < 16; ++j) {
            const f32x4 gg = *((const GAS f32x4*)g + lane + 64 * j), bb = *((const GAS f32x4*)b + lane + 64 * j);
#ifdef OSCALE
            const f32x4 y = (x[j] * rstd * gg + bb) * (hout ? 1.f : OSCALE);
#else
            const f32x4 y = x[j] * rstd * gg + bb;
#endif
            xo[64 * j] = y;
            if (hout) {
                const f32x4 sh = *((const GAS f32x4*)mod_next + lane + 64 * j), scl = *((const GAS f32x4*)(mod_next + D) + lane + 64 * j);
                const f32x4 h = y * (scl + 1.f) + sh;
                u32x2 w; w.x = pk2(h[0], h[1]); w.y = pk2(h[2], h[3]);
                *((GAS u32x2*)(hout + (size_t)m * D) + lane + 64 * j) = w;
                if (h8) *((GAS unsigned*)(h8 + (size_t)m * D) + lane + 64 * j) = pk4_fp8(h);
            }
        }
    }
}
__device__ __forceinline__ void rstd_rows(const float* rsq_q, const float* rsq_kv, float* rstd_q, float* rstd_kv, int gtid, int NT) {
    for (int row = gtid; row < S; row += NT) {
        const GAS f32x4* rp = (const GAS f32x4*)(rsq_q + (size_t)row * 24); float ss = 0.f;
#pragma unroll
        for (int i = 0; i < 6; ++i) { const f32x4 t = rp[i]; ss += (t[0] + t[1]) + (t[2] + t[3]); }
        rstd_q[row] = 1.f / sqrtf(ss * (1.f / 768.f) + RMS_EPS);
        const GAS f32x4* rk = (const GAS f32x4*)(rsq_kv + (size_t)row * 16); float sk = 0.f;
#pragma unroll
        for (int i = 0; i < 4; ++i) { const f32x4 t = rk[i]; sk += (t[0] + t[1]) + (t[2] + t[3]); }
        rstd_kv[row] = 1.f / sqrtf(sk * (1.f / 512.f) + RMS_EPS);
    }
}
namespace pg8 {
#define PG8_LAS __attribute__((address_space(3)))
typedef unsigned short bf16_t;
typedef short bf16x8 __attribute__((ext_vector_type(8)));
typedef float f32x4 __attribute__((ext_vector_type(4)));
typedef unsigned u32x4 __attribute__((ext_vector_type(4)));
constexpr int BM = 256, BK = 64, HALF = 128, HTB = HALF * BK * 2  , STAGE_BYTES = 8 * HTB, NXCD = 8, WGM = 8;

__host__ __device__ __forceinline__ int lds_byte(int r, int c) { const int st = (r >> 4) * 2 + (c >> 5), rr = r & 15, cc = c & 31, ob = rr * 64 + cc * 2; return st * 1024 + (ob ^ (((ob >> 9) & 1) << 5)); }
__host__ __device__ __forceinline__ void stage_rc(int b, int& R, int& C) { const int st = b / 1024, sb = b % 1024, swz = sb ^ (((sb >> 9) & 1) << 5); R = (st >> 1) * 16 + swz / 64; C = (st & 1) * 32 + (swz % 64) / 2; }
__host__ __device__ __forceinline__ int perm32(int rho) { const int n = rho >> 4, i = rho & 15; return 8 * (i >> 2) + 4 * n + (i & 3); }

struct Unit { int pm, pn; };
struct Gemm { const bf16_t* A; const bf16_t* Bt; int M, N, K; };

struct StaticOrder {
    int nM, nN, nwg, G, c;
    __host__ __device__ void init(int M, int N, int G_, int c_) { nM = M / BM; nN = N / BM; nwg = nM * nN; G = G_; c = c_; }
    __host__ __device__ bool next(int i, Unit& u) const {
        const long L = (long)i * G + c; if (L >= nwg) return false;
        int wgid = (int)L; { const int q = nwg / NXCD, r = nwg % NXCD, xcd = wgid % NXCD, off = wgid / NXCD; wgid = (xcd < r ? xcd * (q + 1) : r * (q + 1) + (xcd - r) * q) + off; }
        const int nig = WGM * nN, gid = wgid / nig, fm = gid * WGM, gsz = (nM - fm) < WGM ? (nM - fm) : WGM;
        u.pm = fm + ((wgid % nig) % gsz); u.pn = (wgid % nig) / gsz; return true;
    }
    __device__ __forceinline__ void a_ready(const Unit&) const {}
    __device__ __forceinline__ void done(const Unit&) const {}
};
typedef int i32x8 __attribute__((ext_vector_type(8)));
typedef int i32x4 __attribute__((ext_vector_type(4)));
__device__ __forceinline__ i32x8 ld2x16(const PG8_LAS unsigned char* p) { const u32x4 a = *(const PG8_LAS u32x4*)p, b = *(const PG8_LAS u32x4*)(p + 1024);
    return (i32x8){(int)a.x, (int)a.y, (int)a.z, (int)a.w, (int)b.x, (int)b.y, (int)b.z, (int)b.w}; }
__device__ __forceinline__ i32x8 cat8(bf16x8 lo, bf16x8 hi) { const i32x4 a = __builtin_bit_cast(i32x4, lo), b = __builtin_bit_cast(i32x4, hi); return (i32x8){a[0], a[1], a[2], a[3], b[0], b[1], b[2], b[3]}; }
struct InBf16Order : StaticOrder {
    __device__ bool next(int i, Unit& u) const { if (!StaticOrder::next(i, u)) return false; u.pn = u.pn == 0 ? 5 : 13 + u.pn; return true; }
};
__device__ __forceinline__ f32x4 rope4(const f32x4 v, float c0, float s0, float c1, float s1) {
    f32x4 o; o[0] = v[0] * c0 - v[1] * s0; o[1] = v[1] * c0 + v[0] * s0; o[2] = v[2] * c1 - v[3] * s1; o[3] = v[3] * c1 + v[2] * s1; return o; }
#ifdef NOISE_BUILD
__device__ __forceinline__ f32x4 nz4(f32x4 v, int row, int col) {
    f32x4 o;
#pragma unroll
    for (int i = 0; i < 4; ++i) { unsigned h = (unsigned)row * 9216u + (unsigned)(col + i); h ^= h >> 16; h *= 0x7feb352du; h ^= h >> 15; h *= 0x846ca68bu; h ^= h >> 16;
        const float r = (float)(int)(h & 0xffffu) * (1.f / 32768.f) - 1.f; o[i] = v[i] * (1.f + NOISE_EPS * r); }
    return o; }
#define NZ(v, row, col) nz4((v), (row), (col))
#else
#define NZ(v, row, col) (v)
#endif
#ifdef MLA_FP8
__device__ __forceinline__ u32x2 pk8_fp8(f32x4 a, f32x4 b) {
    int w0 = __builtin_amdgcn_cvt_pk_fp8_f32(a[0], a[1], 0, false); w0 = __builtin_amdgcn_cvt_pk_fp8_f32(a[2], a[3], w0, true);
    int w1 = __builtin_amdgcn_cvt_pk_fp8_f32(b[0], b[1], 0, false); w1 = __builtin_amdgcn_cvt_pk_fp8_f32(b[2], b[3], w1, true);
    u32x2 r; r.x = (unsigned)w0; r.y = (unsigned)w1; return r; }
#endif
struct EpiIn {
    static constexpr bool PERM = true, AFTER_DRAIN = false;
    unsigned char* ws; int f8pass;
    __device__ __forceinline__ void operator()(const f32x4 (&acc)[2][2][4][2], const Unit& u, int wr, int wc, int fr, int fq) const {
        const int pn = f8pass ? (u.pn < 5 ? u.pn : u.pn + 1) : u.pn, row0 = u.pm * BM + wr * 64 + fr;
        if (pn < 5) {
            const bool isq = pn < 3; bf16_t* base = (bf16_t*)(ws + (isq ? WS_QLAT : WS_KVLAT)); const int ld = isq ? 768 : 512, ct = isq ? pn : pn - 3, ns = isq ? 24 : 16; float* rsq = (float*)(ws + (isq ? WS_RSQQ : WS_RSQKV));
#pragma unroll
            for (int ai = 0; ai < 2; ++ai)
#pragma unroll
                for (int m = 0; m < 4; ++m) { const int row = row0 + ai * HALF + m * 16;
#pragma unroll
                    for (int bj = 0; bj < 2; ++bj) { const f32x4 v0 = NZ(acc[ai][bj][m][0], row, pn * 256 + bj * 128 + wc * 32 + 8 * fq), v1 = NZ(acc[ai][bj][m][1], row, pn * 256 + bj * 128 + wc * 32 + 8 * fq + 4);
                        float ss = ((v0[0] * v0[0] + v0[1] * v0[1]) + (v0[2] * v0[2] + v0[3] * v0[3])) + ((v1[0] * v1[0] + v1[1] * v1[1]) + (v1[2] * v1[2] + v1[3] * v1[3]));
                        ss += __shfl_xor(ss, 16); ss += __shfl_xor(ss, 32);
                        if (fq == 0) rsq[(size_t)row * ns + ct * 8 + bj * 4 + wc] = ss;
#ifdef GEMM_F8
                        *(GAS u32x2*)((unsigned char*)base + (size_t)row * ld + ct * 256 + bj * HALF + wc * 32 + 8 * fq) = pk8_fp8(v0, v1); } }
#else
                        *(GAS u32x4*)(base + (size_t)row * ld + ct * 256 + bj * HALF + wc * 32 + 8 * fq) = pk8(v0, v1); } }
#endif
        } else if (pn == 5) {
            if (wc < 2) {
                const int i0 = 16 * wc + 4 * fq; const float* cosT = (const float*)(ws + WS_ROPE); const float* sinT = cosT + (size_t)S * 32; bf16_t* kmla = (bf16_t*)(ws + WS_KMLA);
#pragma unroll
                for (int ai = 0; ai < 2; ++ai)
#pragma unroll
                    for (int m = 0; m < 4; ++m) { const int row = row0 + ai * HALF + m * 16;
                        const f32x4 cs = *(const GAS f32x4*)(cosT + (size_t)row * 32 + i0), sn = *(const GAS f32x4*)(sinT + (size_t)row * 32 + i0);
#ifdef MLA_FP8
                        const u32x2 w = pk8_fp8(rope4(acc[ai][0][m][0], cs[0], sn[0], cs[1], sn[1]), rope4(acc[ai][0][m][1], cs[2], sn[2], cs[3], sn[3]));
                        unsigned char* dst = (unsigned char*)kmla + (size_t)row * 3072 + 128 + wc * 32 + 8 * fq;
#pragma unroll
                        for (int h = 0; h < 16; ++h) *(GAS u32x2*)(dst + h * 192) = w;
#else
                        const u32x4 w = pk8(rope4(acc[ai][0][m][0], cs[0], sn[0], cs[1], sn[1]), rope4(acc[ai][0][m][1], cs[2], sn[2], cs[3], sn[3]));
                        bf16_t* dst = kmla + (size_t)row * 3072 + 128 + wc * 32 + 8 * fq;
#pragma unroll
                        for (int h = 0; h < 16; ++h) *(GAS u32x4*)(dst + h * 192) = w;
#endif
                        asm volatile("" ::: "memory"); }
            } else {
                const int cl = (wc - 2) * 32 + 8 * fq; float* gnsa = (float*)(ws + WS_GNSA);
                if (cl < 48) {
#pragma unroll
                    for (int ai = 0; ai < 2; ++ai)
#pragma unroll
                        for (int m = 0; m < 4; ++m) { const int row = row0 + ai * HALF + m * 16; const f32x4 v0 = acc[ai][0][m][0], v1 = acc[ai][0][m][1];
                            f32x4 g0, g1; g0[0] = sigm_f(v0[0]); g0[1] = sigm_f(v0[1]); g0[2] = sigm_f(v0[2]); g0[3] = sigm_f(v0[3]); g1[0] = sigm_f(v1[0]); g1[1] = sigm_f(v1[1]); g1[2] = sigm_f(v1[2]); g1[3] = sigm_f(v1[3]);
                            *(GAS f32x4*)(gnsa + (size_t)row * 48 + cl) = g0; *(GAS f32x4*)(gnsa + (size_t)row * 48 + cl + 4) = g1; } }
            }
        } else {
            const int mode = (pn < 14) ? 0 : (pn < 22 ? 1 : (pn < 28 ? 2 : 0));
            bf16_t* base = (pn < 14) ? (bf16_t*)(ws + WS_ZMLA) + (pn - 6) * 256 : (pn < 22 ? (bf16_t*)(ws + WS_QNSA) + (pn - 14) * 256 : (bf16_t*)(ws + WS_ZNSA) + (pn - 28) * 256); bf16_t* kvnsa = (bf16_t*)(ws + WS_KVNSA);
#pragma unroll
            for (int ai = 0; ai < 2; ++ai)
#pragma unroll
                for (int m = 0; m < 4; ++m) { const int row = row0 + ai * HALF + m * 16;
#pragma unroll
                    for (int bj = 0; bj < 2; ++bj) { f32x4 v0 = NZ(acc[ai][bj][m][0], row, pn * 256 + bj * 128 + wc * 32 + 8 * fq), v1 = NZ(acc[ai][bj][m][1], row, pn * 256 + bj * 128 + wc * 32 + 8 * fq + 4);
                        if (mode == 0) { v0[0] = silu_f(v0[0]); v0[1] = silu_f(v0[1]); v0[2] = silu_f(v0[2]); v0[3] = silu_f(v0[3]); v1[0] = silu_f(v1[0]); v1[1] = silu_f(v1[1]); v1[2] = silu_f(v1[2]); v1[3] = silu_f(v1[3]); }
                        else if (mode == 1) { v0 = v0 * QS_NSA; v1 = v1 * QS_NSA; }
                        bf16_t* dst = (mode == 2) ? kvnsa + (size_t)(2 * (pn - 22) + bj) * ((size_t)S * 128) + (size_t)row * 128 + wc * 32 + 8 * fq
                                                  : base + (size_t)row * 2048 + bj * HALF + wc * 32 + 8 * fq;
                        *(GAS u32x4*)dst = pk8(v0, v1); } }
        }
    }
};
struct EpiQup {
    static constexpr bool PERM = true, AFTER_DRAIN = false;
    unsigned char* ws;
    __device__ __forceinline__ void operator()(const f32x4 (&acc)[2][2][4][2], const Unit& u, int wr, int wc, int fr, int fq) const {
        const int pn = u.pn, row0 = u.pm * BM + wr * 64 + fr; bf16_t* qmla = (bf16_t*)(ws + WS_QMLA); const float* rstd_q = (const float*)(ws + WS_RSTD); const float* cosT = (const float*)(ws + WS_ROPE); const float* sinT = cosT + (size_t)S * 32;
#pragma unroll
        for (int ai = 0; ai < 2; ++ai)
#pragma unroll
            for (int m = 0; m < 4; ++m) { const int row = row0 + ai * HALF + m * 16;
#ifdef MLA_FP8
#ifdef MLA_MXL
                const float sc = (QS_MLA * 8.f) * *(const GAS float*)(rstd_q + row);
#else
                const float sc = *(const GAS float*)(rstd_q + row);
#endif
                unsigned char* q8 = (unsigned char*)qmla + (size_t)row * 3072;
#pragma unroll
                for (int bj = 0; bj < 2; ++bj) { const f32x4 v0 = acc[ai][bj][m][0] * sc, v1 = acc[ai][bj][m][1] * sc;
                    if (pn < 8) { *(GAS u32x2*)(q8 + (2 * pn + bj) * 192 + wc * 32 + 8 * fq) = pk8_fp8(v0, v1); }
                    else { const int cp = (pn - 8) * 256 + bj * HALF + wc * 32 + 8 * fq, head = cp >> 6, dl = cp & 63, i0 = dl >> 1;
                        const f32x4 cs = *(const GAS f32x4*)(cosT + (size_t)row * 32 + i0), sn = *(const GAS f32x4*)(sinT + (size_t)row * 32 + i0);
                        *(GAS u32x2*)(q8 + head * 192 + 128 + dl) = pk8_fp8(rope4(v0, cs[0], sn[0], cs[1], sn[1]), rope4(v1, cs[2], sn[2], cs[3], sn[3])); } }
#else
                const float sc = QS_MLA * *(const GAS float*)(rstd_q + row);
#pragma unroll
                for (int bj = 0; bj < 2; ++bj) { const f32x4 v0 = acc[ai][bj][m][0] * sc, v1 = acc[ai][bj][m][1] * sc;
                    if (pn < 8) { *(GAS u32x4*)(qmla + (size_t)row * 3072 + (2 * pn + bj) * 192 + wc * 32 + 8 * fq) = pk8(v0, v1); }
                    else { const int cp = (pn - 8) * 256 + bj * HALF + wc * 32 + 8 * fq, head = cp >> 6, dl = cp & 63, i0 = dl >> 1;
                        const f32x4 cs = *(const GAS f32x4*)(cosT + (size_t)row * 32 + i0), sn = *(const GAS f32x4*)(sinT + (size_t)row * 32 + i0);
                        *(GAS u32x4*)(qmla + (size_t)row * 3072 + head * 192 + 128 + dl) = pk8(rope4(v0, cs[0], sn[0], cs[1], sn[1]), rope4(v1, cs[2], sn[2], cs[3], sn[3])); } }
#endif
                if (m & 1) asm volatile("" ::: "memory"); }
    }
};
struct EpiKvup {
    static constexpr bool PERM = true, AFTER_DRAIN = false;
    unsigned char* ws;
    __device__ __forceinline__ void operator()(const f32x4 (&acc)[2][2][4][2], const Unit& u, int wr, int wc, int fr, int fq) const {
        const int pn = u.pn, row0 = u.pm * BM + wr * 64 + fr;
#pragma unroll
        for (int ai = 0; ai < 2; ++ai)
#pragma unroll
            for (int m = 0; m < 4; ++m) { const int row = row0 + ai * HALF + m * 16;
                const float sc = *(const GAS float*)((const float*)(ws + WS_RSTD) + S + row); bf16_t* kmla = (bf16_t*)(ws + WS_KMLA); bf16_t* vmla = (bf16_t*)(ws + WS_VMLA);
#ifdef MLA_FP8
                *(GAS u32x2*)((unsigned char*)kmla + (size_t)row * 3072 + pn * 192 + wc * 32 + 8 * fq) = pk8_fp8(acc[ai][0][m][0] * sc, acc[ai][0][m][1] * sc);
#else
                *(GAS u32x4*)(kmla + (size_t)row * 3072 + pn * 192 + wc * 32 + 8 * fq) = pk8(acc[ai][0][m][0] * sc, acc[ai][0][m][1] * sc);
#endif
                *(GAS u32x4*)(vmla + (size_t)row * 2048 + pn * 128 + wc * 32 + 8 * fq) = pk8(acc[ai][1][m][0] * sc, acc[ai][1][m][1] * sc);
                if (m & 1) asm volatile("" ::: "memory"); }
    }
};
#ifdef MLA_FP8V
struct EpiKup {
    static constexpr bool PERM = true, AFTER_DRAIN = false;
    unsigned char* ws;
    __device__ __forceinline__ void operator()(const f32x4 (&acc)[2][2][4][2], const Unit& u, int wr, int wc, int fr, int fq) const {
        const int pn = u.pn, row0 = u.pm * BM + wr * 64 + fr;
#pragma unroll
        for (int ai = 0; ai < 2; ++ai)
#pragma unroll
            for (int m = 0; m < 4; ++m) { const int row = row0 + ai * HALF + m * 16;
                const float sc = *(const GAS float*)((const float*)(ws + WS_RSTD) + S + row); unsigned char* k8 = ws + WS_KMLA + (size_t)row * 3072;
#pragma unroll
                for (int bj = 0; bj < 2; ++bj) *(GAS u32x2*)(k8 + (2 * pn + bj) * 192 + wc * 32 + 8 * fq) = pk8_fp8(acc[ai][bj][m][0] * sc, acc[ai][bj][m][1] * sc);
                if (m & 1) asm volatile("" ::: "memory"); }
    }
};
struct EpiVt {
    static constexpr bool PERM = true, AFTER_DRAIN = false;
    unsigned char* ws;
    __device__ __forceinline__ void operator()(const f32x4 (&acc)[2][2][4][2], const Unit& u, int wr, int wc, int fr, int fq) const {
        const int row0 = u.pm * BM + wr * 64 + fr, col0 = u.pn * BM + wc * 32 + 8 * fq;
        const float* rs = (const float*)(ws + WS_RSTD) + S;
        f32x4 sc[2][2];
#pragma unroll
        for (int bj = 0; bj < 2; ++bj) { sc[bj][0] = *(const GAS f32x4*)(rs + col0 + bj * HALF); sc[bj][1] = *(const GAS f32x4*)(rs + col0 + bj * HALF + 4); }
        const int hi8 = (col0 >> 3) & 1; (void)hi8;
#pragma unroll
        for (int ai = 0; ai < 2; ++ai)
#pragma unroll
            for (int m = 0; m < 4; ++m) { unsigned char* vt = ws + WS_VMLA + (size_t)(row0 + ai * HALF + m * 16) * S;
#pragma unroll
                for (int bj = 0; bj < 2; ++bj) { const u32x2 w = pk8_fp8(acc[ai][bj][m][0] * sc[bj][0], acc[ai][bj][m][1] * sc[bj][1]);
#ifdef MLA_MX
                    unsigned char* d64 = vt + ((col0 + bj * HALF) & ~63) + 4 * ((col0 >> 3) & 7);
                    *(GAS unsigned*)(d64) = w.x; *(GAS unsigned*)(d64 + 32) = w.y; } }
#else
                    unsigned char* d16 = vt + ((col0 + bj * HALF) & ~15);
                    *(GAS unsigned*)(d16 + (hi8 ? 4 : 0)) = w.x; *(GAS unsigned*)(d16 + (hi8 ? 12 : 8)) = w.y; } }
#endif
    }
};
#endif
struct EpiOut {
    static constexpr bool PERM = true, AFTER_DRAIN = false;
    bf16_t* y; const float* gate;
    __device__ __forceinline__ void operator()(const f32x4 (&acc)[2][2][4][2], const Unit& u, int wr, int wc, int fr, int fq) const {
        const int row0 = u.pm * BM + wr * 64 + fr, col0 = u.pn * BM + wc * 32 + 8 * fq;
        f32x4 gv[2][2];
#pragma unroll
        for (int bj = 0; bj < 2; ++bj)
#pragma unroll
            for (int n = 0; n < 2; ++n) gv[bj][n] = *(const GAS f32x4*)(gate + col0 + bj * HALF + n * 4);
#pragma unroll
        for (int ai = 0; ai < 2; ++ai)
#pragma unroll
            for (int m = 0; m < 4; ++m) { bf16_t* dst = y + (size_t)(row0 + ai * HALF + m * 16) * D + col0;
#pragma unroll
                for (int bj = 0; bj < 2; ++bj) *(GAS u32x4*)(dst + bj * HALF) = pk8(gv[bj][0] * acc[ai][bj][m][0], gv[bj][1] * acc[ai][bj][m][1]);
                if (m & 1) asm volatile("" ::: "memory"); }
    }
};
template <class Epi, class Sched, bool ALIGN_EPI = false, bool SP2 = false, int SCB = 0, int SCA = 0>
__device__ __forceinline__ void gemm_phase(PG8_LAS unsigned char* lds, const Gemm g, const Sched& S, const Epi& E) {
    int tid_ = threadIdx.x; asm volatile("" : "+v"(tid_));
    const int tid = tid_, wid = __builtin_amdgcn_readfirstlane(tid >> 6), lane = tid & 63, wr = wid >> 2, wc = wid & 3, fr = lane & 15, fq = lane >> 4;
    const int K = g.K, nt = K / BK;
    unsigned voffA[2], voffB[2];
#pragma unroll
    for (int i = 0; i < 2; ++i) { int R, C; stage_rc(tid * 16 + i * 8192, R, C); const int Rb = Epi::PERM ? ((R & ~31) + perm32(R & 31)) : R;
        voffA[i] = (unsigned)(R * K + C) * 2u; voffB[i] = (unsigned)(Rb * K + C) * 2u; }
    const size_t kstep = (size_t)(BK * 2);
    const size_t hstep = (size_t)HALF * K * 2;
    const size_t tstep = 2 * hstep;
    const unsigned ldsw = (unsigned)wid * 1024u;
    const int aoff = lds_byte(wr * 64 + fr, fq * 8), boff = lds_byte(wc * 32 + fr, fq * 8);
#define PG8_SA(b, h) (((b) * 2 + (h)) * HTB)
#define PG8_SB(b, h) ((4 + (b) * 2 + (h)) * HTB)
#define PG8_STAGE(bufoff, gbase, voff) do { _Pragma("unroll") for (int _i = 0; _i < 2; ++_i) \
        __builtin_amdgcn_global_load_lds((const unsigned*)((const char*)(gbase) + (voff)[_i]), (PG8_LAS unsigned*)(lds + (bufoff) + ldsw + _i * 8192), 16, 0, 0); } while (0)
#define PG8_LDA(dst, b, h) do { if constexpr (SCB != 0) { _Pragma("unroll") for (int m = 0; m < 4; ++m) dst##8[m] = ld2x16(lds + PG8_SA(b, h) + aoff + m * 2048); } \
        else { _Pragma("unroll") for (int m = 0; m < 4; ++m) _Pragma("unroll") for (int k = 0; k < 2; ++k) dst[m][k] = *(const PG8_LAS bf16x8*)(lds + PG8_SA(b, h) + aoff + m * 2048 + k * 1024); } } while (0)
#define PG8_LDB(dst, b, h) do { if constexpr (SCB != 0) { _Pragma("unroll") for (int n = 0; n < 2; ++n) dst##8[n] = ld2x16(lds + PG8_SB(b, h) + boff + n * 2048); } \
        else { _Pragma("unroll") for (int n = 0; n < 2; ++n) _Pragma("unroll") for (int k = 0; k < 2; ++k) dst[n][k] = *(const PG8_LAS bf16x8*)(lds + PG8_SB(b, h) + boff + n * 2048 + k * 1024); } } while (0)
#define PG8_MMA(ai, bj, At, Bt) do { __builtin_amdgcn_s_setprio(1); \
        if constexpr (SCB != 0) { _Pragma("unroll") for (int m = 0; m < 4; ++m) _Pragma("unroll") for (int n = 0; n < 2; ++n) \
            asm volatile("v_mfma_scale_f32_16x16x128_f8f6f4 %0, %1, %2, %0, %3, %4 op_sel_hi:[0,0,0]" : "+v"(acc[ai][bj][m][n]) : "v"(Bt##8[n]), "v"(At##8[m]), "v"(scb_), "v"(sca_)); } \
        else { _Pragma("unroll") for (int m = 0; m < 4; ++m) _Pragma("unroll") for (int n = 0; n < 2; ++n) _Pragma("unroll") for (int k = 0; k < 2; ++k) \
            acc[ai][bj][m][n] = __builtin_amdgcn_mfma_f32_16x16x32_bf16(Bt[n][k], At[m][k], acc[ai][bj][m][n], 0, 0, 0); } \
        __builtin_amdgcn_s_setprio(0); } while (0)
#define PG8_WAIT_V(n) asm volatile("s_waitcnt vmcnt(" #n ")" ::: "memory")
#define PG8_WAIT_L(n) asm volatile("s_waitcnt lgkmcnt(" #n ")" ::: "memory")
#define PG8_BAR __builtin_amdgcn_s_barrier()
#define PG8_SCHED __builtin_amdgcn_sched_barrier(0)
    Unit cur, nxt; int ui = 0;
    if (!S.next(0, cur)) return;
    f32x4 acc[2][2][4][2];
#pragma unroll
    for (int a = 0; a < 2; ++a)
#pragma unroll
        for (int b = 0; b < 2; ++b)
#pragma unroll
            for (int m = 0; m < 4; ++m)
#pragma unroll
                for (int n = 0; n < 2; ++n) acc[a][b][m][n] = (f32x4){0.f, 0.f, 0.f, 0.f};
    int scb_ = SCB, sca_ = SCA; asm volatile("" : "+v"(scb_), "+v"(sca_));
    bf16x8 At[4][2], B0[2][2], B1[2][2]; i32x8 At8[4], B08[2], B18[2];
    const char* cA = (const char*)g.A + (size_t)cur.pm * tstep; const char* cB = (const char*)g.Bt + (size_t)cur.pn * tstep;
    S.a_ready(cur);
    if constexpr (SP2) {
        PG8_STAGE(PG8_SB(0, 0), cB, voffB); PG8_STAGE(PG8_SB(0, 1), cB + hstep, voffB); PG8_STAGE(PG8_SA(0, 0), cA, voffA); PG8_STAGE(PG8_SA(0, 1), cA + hstep, voffA);
        if (wr == 1) PG8_BAR;
        PG8_WAIT_V(2); PG8_BAR;
        PG8_STAGE(PG8_SB(1, 0), cB + kstep, voffB); PG8_STAGE(PG8_SA(1, 0), cA + kstep, voffA); PG8_STAGE(PG8_SB(1, 1), cB + hstep + kstep, voffB);
        PG8_WAIT_V(6); PG8_BAR;
    } else {
        PG8_STAGE(PG8_SB(0, 0), cB, voffB); PG8_STAGE(PG8_SA(0, 0), cA, voffA); PG8_STAGE(PG8_SB(0, 1), cB + hstep, voffB); PG8_STAGE(PG8_SA(0, 1), cA + hstep, voffA);
        if (wr == 1) PG8_BAR;
        PG8_WAIT_V(4); PG8_BAR;
        PG8_STAGE(PG8_SB(1, 0), cB + kstep, voffB); PG8_STAGE(PG8_SA(1, 0), cA + kstep, voffA); PG8_STAGE(PG8_SB(1, 1), cB + hstep + kstep, voffB);
        PG8_WAIT_V(6); PG8_BAR;
    }
    for (;;) {
        const bool has_next = S.next(ui + 1, nxt);
        const char* nA = has_next ? (const char*)g.A + (size_t)nxt.pm * tstep : cA; const char* nB = has_next ? (const char*)g.Bt + (size_t)nxt.pn * tstep : cB;
#pragma unroll 1
        for (int t = 0; t < nt; t += 2) {
            const bool last = (t == nt - 2);
            const char* a1 = cA + (size_t)(t + 1) * kstep;
            const char* a2 = last ? nA : cA + (size_t)(t + 2) * kstep; const char* b2 = last ? nB : cB + (size_t)(t + 2) * kstep;
            const char* a3 = a2 + kstep; const char* b3 = b2 + kstep;
            if (last && has_next) S.a_ready(nxt);
            if constexpr (SP2) {
            PG8_LDB(B0, 0, 0); PG8_LDB(B1, 0, 1); PG8_SCHED; PG8_LDA(At, 0, 0); PG8_STAGE(PG8_SA(1, 1), a1 + hstep, voffA);
            PG8_WAIT_V(8); PG8_WAIT_L(0); PG8_BAR; PG8_MMA(0, 0, At, B0); PG8_MMA(0, 1, At, B1); PG8_BAR; PG8_SCHED;
            PG8_LDA(At, 0, 1); PG8_STAGE(PG8_SB(0, 0), b2, voffB); PG8_STAGE(PG8_SB(0, 1), b2 + hstep, voffB); PG8_STAGE(PG8_SA(0, 0), a2, voffA);
            PG8_WAIT_V(8); PG8_WAIT_L(0); PG8_BAR; PG8_MMA(1, 0, At, B0); PG8_MMA(1, 1, At, B1); PG8_BAR; PG8_SCHED;
            PG8_LDB(B0, 1, 0); PG8_LDB(B1, 1, 1); PG8_SCHED; PG8_LDA(At, 1, 0); PG8_STAGE(PG8_SA(0, 1), a2 + hstep, voffA);
            PG8_WAIT_V(8); PG8_WAIT_L(0); PG8_BAR; PG8_MMA(0, 0, At, B0); PG8_MMA(0, 1, At, B1); PG8_BAR; PG8_SCHED;
            PG8_LDA(At, 1, 1); PG8_STAGE(PG8_SB(1, 0), b3, voffB); PG8_STAGE(PG8_SB(1, 1), b3 + hstep, voffB); PG8_STAGE(PG8_SA(1, 0), a3, voffA);
            PG8_WAIT_V(8); PG8_WAIT_L(0); PG8_BAR; PG8_MMA(1, 0, At, B0); PG8_MMA(1, 1, At, B1); PG8_BAR; PG8_SCHED;
            } else {
            PG8_LDB(B0, 0, 0); PG8_SCHED; PG8_LDA(At, 0, 0); PG8_STAGE(PG8_SA(1, 1), a1 + hstep, voffA);
            PG8_WAIT_L(8); PG8_BAR; PG8_WAIT_L(0); PG8_MMA(0, 0, At, B0); PG8_BAR; PG8_SCHED;
            PG8_LDB(B1, 0, 1); PG8_STAGE(PG8_SB(0, 0), b2, voffB);
            PG8_BAR; PG8_WAIT_L(0); PG8_MMA(0, 1, At, B1); PG8_BAR;
            PG8_LDA(At, 0, 1); PG8_STAGE(PG8_SA(0, 0), a2, voffA);
            PG8_BAR; PG8_WAIT_L(0); PG8_MMA(1, 0, At, B0); PG8_BAR; PG8_SCHED;
            PG8_STAGE(PG8_SB(0, 1), b2 + hstep, voffB);
            PG8_WAIT_V(6); PG8_BAR; PG8_MMA(1, 1, At, B1); PG8_BAR;
            PG8_LDB(B0, 1, 0); PG8_SCHED; PG8_LDA(At, 1, 0); PG8_STAGE(PG8_SA(0, 1), a2 + hstep, voffA);
            PG8_WAIT_L(8); PG8_BAR; PG8_WAIT_L(0); PG8_MMA(0, 0, At, B0); PG8_BAR; PG8_SCHED;
            PG8_LDB(B1, 1, 1); PG8_STAGE(PG8_SB(1, 0), b3, voffB);
            PG8_BAR; PG8_WAIT_L(0); PG8_MMA(0, 1, At, B1); PG8_BAR;
            PG8_LDA(At, 1, 1); PG8_STAGE(PG8_SA(1, 0), a3, voffA);
            PG8_BAR; PG8_WAIT_L(0); PG8_MMA(1, 0, At, B0); PG8_BAR; PG8_SCHED;
            PG8_STAGE(PG8_SB(1, 1), b3 + hstep, voffB);
            PG8_WAIT_V(6); PG8_BAR; PG8_MMA(1, 1, At, B1); PG8_BAR;
            }
        }
        if constexpr (SCB != 0) asm volatile("s_nop 15\n\ts_nop 15" ::: "memory");
        if constexpr (ALIGN_EPI) { if (wr == 0) PG8_BAR; }
        if constexpr (!Epi::AFTER_DRAIN) { int fr_ = fr, fq_ = fq; asm volatile("" : "+v"(fr_), "+v"(fq_));
            E(acc, cur, wr, wc, fr_, fq_); S.done(cur); }
        if (!has_next) break;
#pragma unroll
        for (int a = 0; a < 2; ++a)
#pragma unroll
            for (int b = 0; b < 2; ++b)
#pragma unroll
                for (int m = 0; m < 4; ++m)
#pragma unroll
                    for (int n = 0; n < 2; ++n) acc[a][b][m][n] = (f32x4){0.f, 0.f, 0.f, 0.f};
        cur = nxt; cA = nA; cB = nB; ++ui;
        if constexpr (ALIGN_EPI) { if (wr == 1) PG8_BAR; }
    }
    PG8_WAIT_V(0);
    if constexpr (!ALIGN_EPI) { if (wr == 0) PG8_BAR; }
    PG8_BAR;
    if constexpr (Epi::AFTER_DRAIN) { E.fused(acc, cur, wr, wc, fr, fq, lds, wid, lane); S.done(cur); }
#undef PG8_SA
#undef PG8_SB
#undef PG8_STAGE
#undef PG8_LDA
#undef PG8_LDB
#undef PG8_MMA
#undef PG8_WAIT_V
#undef PG8_WAIT_L
#undef PG8_BAR
#undef PG8_SCHED
}
}
namespace att {
constexpr int KS_M = 400, KS_N = 272, VS = 320;
constexpr int MLA_KB = 64 * KS_M, NSA_KB = 64 * KS_N, VB = 64 * VS;
constexpr int N_IMP = 2 * NSA_KB + 2 * VB;
constexpr int N_PART = N_IMP + 32768;
constexpr int N_PARTB = 8 * 32 * 17 * 4;
constexpr int N_SELM = N_PART + 2 * N_PARTB;
constexpr int N_ULIST = N_SELM + 1024;
constexpr int N_CARRY = N_ULIST + 1024;
constexpr int N_NTS = N_CARRY + 256;
static_assert(N_NTS + 16 <= MISC_OFF, "NSA LDS map");
static_assert(2 * MLA_KB + 3 * VB <= 131072, "MLA LDS map");
constexpr int MLA_QL = 2 * MLA_KB + 2 * VB;
static_assert(MLA_QL + 8 * 4096 <= 131072, "MLA LDS map (pipelined)");

#ifndef QK_PF
#define QK_PF 4
#endif
#define MFMA32(a, b, c) __builtin_amdgcn_mfma_f32_32x32x16_bf16((a), (b), (c), 0, 0, 0)
__device__ __forceinline__ float swapmax(float v) { auto rr = __builtin_amdgcn_permlane32_swap(__float_as_uint(v), __float_as_uint(v), false, false); return fmaxf(__uint_as_float(rr[0]), __uint_as_float(rr[1])); }
__device__ __forceinline__ float swapsum(float v) { auto rr = __builtin_amdgcn_permlane32_swap(__float_as_uint(v), __float_as_uint(v), false, false); return __uint_as_float(rr[0]) + __uint_as_float(rr[1]); }
template <int SIDX> __device__ __forceinline__ bf16x8 packp(const f32x16& p) {
    f32x8 t = {p[8 * SIDX + 0], p[8 * SIDX + 1], p[8 * SIDX + 2], p[8 * SIDX + 3], p[8 * SIDX + 4], p[8 * SIDX + 5], p[8 * SIDX + 6], p[8 * SIDX + 7]};
    return __builtin_bit_cast(bf16x8, __builtin_convertvector(t, bf16x8v));
}
template <int NDC, int KS, bool ZERO = true> __device__ __forceinline__ void qk_tile(f32x16& p0, f32x16& p1, const LAS unsigned char* kl, const bf16x8 (&q)[NDC]) {
    if (ZERO) {
#pragma unroll
        for (int i = 0; i < 16; ++i) { p0[i] = 0.f; p1[i] = 0.f; }
    }
    constexpr int PF = QK_PF;
    bf16x8 a[PF + 1][2];
#pragma unroll
    for (int i = 0; i < PF; ++i) { a[i][0] = *(const LAS bf16x8*)(kl + i * 32); a[i][1] = *(const LAS bf16x8*)(kl + 32 * KS + i * 32); }
#pragma unroll
    for (int d0 = 0; d0 < NDC; ++d0) {
        if (d0 + PF < NDC) { a[(d0 + PF) % (PF + 1)][0] = *(const LAS bf16x8*)(kl + (d0 + PF) * 32); a[(d0 + PF) % (PF + 1)][1] = *(const LAS bf16x8*)(kl + 32 * KS + (d0 + PF) * 32); }
        __builtin_amdgcn_sched_barrier(0);
        p0 = MFMA32(a[d0 % (PF + 1)][0], q[d0], p0); p1 = MFMA32(a[d0 % (PF + 1)][1], q[d0], p1);
        __builtin_amdgcn_sched_barrier(0);
    }
}
#ifdef PROBE_QKM2
template <int NDC, int KS> __device__ __forceinline__ void qk_tile_m2(f32x16& p0, f32x16& p1, f32x16& r0, f32x16& r1, const LAS unsigned char* kl, const bf16x8 (&q)[NDC]) {
#pragma unroll
    for (int i = 0; i < 16; ++i) { p0[i] = 0.f; p1[i] = 0.f; r0[i] = 0.f; r1[i] = 0.f; }
    constexpr int PF = QK_PF;
    bf16x8 a[PF + 1][2];
#pragma unroll
    for (int i = 0; i < PF; ++i) { a[i][0] = *(const LAS bf16x8*)(kl + i * 32); a[i][1] = *(const LAS bf16x8*)(kl + 32 * KS + i * 32); }
#pragma unroll
    for (int d0 = 0; d0 < NDC; ++d0) {
        if (d0 + PF < NDC) { a[(d0 + PF) % (PF + 1)][0] = *(const LAS bf16x8*)(kl + (d0 + PF) * 32); a[(d0 + PF) % (PF + 1)][1] = *(const LAS bf16x8*)(kl + 32 * KS + (d0 + PF) * 32); }
        __builtin_amdgcn_sched_barrier(0);
        p0 = MFMA32(a[d0 % (PF + 1)][0], q[d0], p0); p1 = MFMA32(a[d0 % (PF + 1)][1], q[d0], p1);
        r0 = MFMA32(a[d0 % (PF + 1)][0], q[d0], r0); r1 = MFMA32(a[d0 % (PF + 1)][1], q[d0], r1);
        __builtin_amdgcn_sched_barrier(0);
    }
}
#endif
__device__ __forceinline__ void pv_tile(f32x16 (&o)[4], const bf16x8 (&pb)[4], const LAS unsigned char* vl) {
    s16x4 f[5][2];
#define PV_LD(idx) do { constexpr int d_ = (idx) >> 2, s_ = (idx) & 3; \
        f[(idx) % 5][0] = __builtin_amdgcn_ds_read_tr16_b64_v4i16((LAS s16x4*)(vl + s_ * 16 * VS + d_ * 64)); \
        f[(idx) % 5][1] = __builtin_amdgcn_ds_read_tr16_b64_v4i16((LAS s16x4*)(vl + s_ * 16 * VS + 8 * VS + d_ * 64)); } while (0)
    PV_LD(0); PV_LD(1); PV_LD(2); PV_LD(3);
#define PV_STEP(idx) do { if ((idx) + 4 < 16) PV_LD((idx) + 4); __builtin_amdgcn_sched_barrier(0); \
        { const s16x4 t0_ = f[(idx) % 5][0], t1_ = f[(idx) % 5][1]; const bf16x8 vf_ = {t0_[0], t0_[1], t0_[2], t0_[3], t1_[0], t1_[1], t1_[2], t1_[3]}; \
          o[(idx) >> 2] = MFMA32(vf_, pb[(idx) & 3], o[(idx) >> 2]); } __builtin_amdgcn_sched_barrier(0); } while (0)
    PV_STEP(0); PV_STEP(1); PV_STEP(2); PV_STEP(3); PV_STEP(4); PV_STEP(5); PV_STEP(6); PV_STEP(7);
    PV_STEP(8); PV_STEP(9); PV_STEP(10); PV_STEP(11); PV_STEP(12); PV_STEP(13); PV_STEP(14); PV_STEP(15);
#undef PV_STEP
#undef PV_LD
}
template <int NDC, int NQR, int KS> __device__ __forceinline__ void qk_tile_free(f32x16& p0, f32x16& p1, const LAS unsigned char* kl, const bf16x8 (&q)[NQR], const LAS unsigned char* ql) {
#pragma unroll
    for (int i = 0; i < 16; ++i) { p0[i] = 0.f; p1[i] = 0.f; }
#pragma unroll
    for (int d0 = 0; d0 < NDC; ++d0) {
        const bf16x8 a0 = *(const LAS bf16x8*)(kl + d0 * 32);
        const bf16x8 a1 = *(const LAS bf16x8*)(kl + 32 * KS + d0 * 32);
        bf16x8 qq; if (d0 < NQR) qq = q[d0 < NQR ? d0 : 0]; else qq = *(const LAS bf16x8*)(ql + (d0 - NQR) * 1024);
        p0 = MFMA32(a0, qq, p0); p1 = MFMA32(a1, qq, p1);
    }
}
__device__ __forceinline__ float sm_core(f32x16& p0, f32x16& p1, float& m, float& l) {
    float tm = p0[0];
#pragma unroll
    for (int r = 1; r < 16; ++r) tm = fmaxf(tm, p0[r]);
#pragma unroll
    for (int r = 0; r < 16; ++r) tm = fmaxf(tm, p1[r]);
    tm = swapmax(tm);
    const float mn = fmaxf(m, tm);
    const float alpha = __builtin_amdgcn_exp2f(m - mn);
    m = mn;
    float ps = 0.f;
#pragma unroll
    for (int r = 0; r < 16; ++r) { p0[r] = __builtin_amdgcn_exp2f(p0[r] - mn); ps += p0[r]; }
#pragma unroll
    for (int r = 0; r < 16; ++r) { p1[r] = __builtin_amdgcn_exp2f(p1[r] - mn); ps += p1[r]; }
    ps = swapsum(ps);
    l = l * alpha + ps;
    return alpha;
}
__device__ __forceinline__ void online_sm(f32x16& p0, f32x16& p1, float& m, float& l, f32x16 (&o)[4]) {
    float tm = p0[0];
#pragma unroll
    for (int r = 1; r < 16; ++r) tm = fmaxf(tm, p0[r]);
#pragma unroll
    for (int r = 0; r < 16; ++r) tm = fmaxf(tm, p1[r]);
    tm = swapmax(tm);
    const float mn = fmaxf(m, tm);
    const float alpha = __builtin_amdgcn_exp2f(m - mn);
    m = mn;
    float ps = 0.f;
#pragma unroll
    for (int r = 0; r < 16; ++r) { p0[r] = __builtin_amdgcn_exp2f(p0[r] - mn); ps += p0[r]; }
#pragma unroll
    for (int r = 0; r < 16; ++r) { p1[r] = __builtin_amdgcn_exp2f(p1[r] - mn); ps += p1[r]; }
    ps = swapsum(ps);
    l = l * alpha + ps;
    if (!__all(alpha == 1.f)) {
#pragma unroll
        for (int d = 0; d < 4; ++d)
#pragma unroll
            for (int r = 0; r < 16; ++r) o[d][r] *= alpha;
    }
}

#ifdef MLA_FP8
typedef long i64;
constexpr int KS8 = 200, MLA_KB8 = 64 * KS8;
static_assert(2 * MLA_KB8 + 3 * VB <= 131072, "MLA fp8 LDS map");
#define MFMA32F8(a, b, c) __builtin_amdgcn_mfma_f32_32x32x16_fp8_fp8((a), (b), (c), 0, 0, 0)
template <int NDC> __device__ __forceinline__ void qk_tile8(f32x16& p0, f32x16& p1, const LAS unsigned char* kl, const i64 (&q)[NDC]) {
#pragma unroll
    for (int i = 0; i < 16; ++i) { p0[i] = 0.f; p1[i] = 0.f; }
    constexpr int PF = 4;
    i64 a[PF + 1][2];
#pragma unroll
    for (int i = 0; i < PF; ++i) { a[i][0] = *(const LAS i64*)(kl + i * 16); a[i][1] = *(const LAS i64*)(kl + 32 * KS8 + i * 16); }
#pragma unroll
    for (int d0 = 0; d0 < NDC; ++d0) {
        if (d0 + PF < NDC) { a[(d0 + PF) % (PF + 1)][0] = *(const LAS i64*)(kl + (d0 + PF) * 16); a[(d0 + PF) % (PF + 1)][1] = *(const LAS i64*)(kl + 32 * KS8 + (d0 + PF) * 16); }
        __builtin_amdgcn_sched_barrier(0);
        __builtin_amdgcn_s_setprio(1);
        p0 = MFMA32F8(a[d0 % (PF + 1)][0], q[d0], p0); p1 = MFMA32F8(a[d0 % (PF + 1)][1], q[d0], p1);
        __builtin_amdgcn_s_setprio(0);
        __builtin_amdgcn_sched_barrier(0);
    }
}
__device__ __forceinline__ void online_sm_scaled(f32x16& p0, f32x16& p1, float& m, float& l, f32x16 (&o)[4], const float C2) {
    float tm = p0[0];
#pragma unroll
    for (int r = 1; r < 16; ++r) tm = fmaxf(tm, p0[r]);
#pragma unroll
    for (int r = 0; r < 16; ++r) tm = fmaxf(tm, p1[r]);
    tm = swapmax(tm);
    const float mn = fmaxf(m, tm);
    const float alpha = __builtin_amdgcn_exp2f((m - mn) * C2);
    m = mn;
    const float mc = -mn * C2;
    float ps = 0.f;
#pragma unroll
    for (int r = 0; r < 16; ++r) { p0[r] = __builtin_amdgcn_exp2f(__builtin_fmaf(p0[r], C2, mc)); ps += p0[r]; }
#pragma unroll
    for (int r = 0; r < 16; ++r) { p1[r] = __builtin_amdgcn_exp2f(__builtin_fmaf(p1[r], C2, mc)); ps += p1[r]; }
    ps = swapsum(ps);
    l = l * alpha + ps;
    if (!__all(alpha == 1.f)) {
#pragma unroll
        for (int d = 0; d < 4; ++d)
#pragma unroll
            for (int r = 0; r < 16; ++r) o[d][r] *= alpha;
    }
}
#endif
#ifdef MLA_FP8V
constexpr int VS8 = 72, VB8 = 128 * VS8;
constexpr int VS8B = 136, VB8B = 128 * VS8B, MLA_KB8B = 128 * KS8;
static_assert(2 * MLA_KB8B + 3 * VB8B <= 131072, "MLA big-tile LDS map");
#ifdef MLA_BIG
#define PV8_RS VS8B
#else
#define PV8_RS VS8
#endif
static_assert(2 * MLA_KB8 + 3 * VB8 <= 131072, "MLA fp8 LDS map");
template <int SIDX> __device__ __forceinline__ i64 packp8(const f32x16& p) {
    int w0 = __builtin_amdgcn_cvt_pk_fp8_f32(p[8 * SIDX + 0] * 256.f, p[8 * SIDX + 1] * 256.f, 0, false); w0 = __builtin_amdgcn_cvt_pk_fp8_f32(p[8 * SIDX + 2] * 256.f, p[8 * SIDX + 3] * 256.f, w0, true);
    int w1 = __builtin_amdgcn_cvt_pk_fp8_f32(p[8 * SIDX + 4] * 256.f, p[8 * SIDX + 5] * 256.f, 0, false); w1 = __builtin_amdgcn_cvt_pk_fp8_f32(p[8 * SIDX + 6] * 256.f, p[8 * SIDX + 7] * 256.f, w1, true);
    return (i64)(((unsigned long long)(unsigned)w1 << 32) | (unsigned)w0);
}
__device__ __forceinline__ void pv_tile8(f32x16 (&o)[4], const i64 (&pb)[4], const LAS unsigned char* vl) {
    i64 f[5];
#define PV8_LD(idx) f[(idx) % 5] = *(const LAS i64*)(vl + ((idx) >> 2) * 32 * PV8_RS + ((idx) & 3) * 16)
    PV8_LD(0); PV8_LD(1); PV8_LD(2); PV8_LD(3);
#define PV8_STEP(idx) do { if ((idx) + 4 < 16) PV8_LD((idx) + 4); __builtin_amdgcn_sched_barrier(0); \
        o[(idx) >> 2] = MFMA32F8(f[(idx) % 5], pb[(idx) & 3], o[(idx) >> 2]); __builtin_amdgcn_sched_barrier(0); } while (0)
    PV8_STEP(0); PV8_STEP(1); PV8_STEP(2); PV8_STEP(3); PV8_STEP(4); PV8_STEP(5); PV8_STEP(6); PV8_STEP(7);
    PV8_STEP(8); PV8_STEP(9); PV8_STEP(10); PV8_STEP(11); PV8_STEP(12); PV8_STEP(13); PV8_STEP(14); PV8_STEP(15);
#undef PV8_STEP
#undef PV8_LD
}
#endif
#ifdef MLA_MX
typedef int i32x8 __attribute__((ext_vector_type(8)));
constexpr int KSX = 208, MLA_KBX = 64 * KSX;
constexpr int VSX = 80, VBX = 128 * VSX;
static_assert(2 * MLA_KBX + 3 * VBX <= 131072, "MLA mx LDS map");
#define MFMAX(a, b, c) __builtin_amdgcn_mfma_scale_f32_32x32x64_f8f6f4((a), (b), (c), 0, 0, 0, 0x7f7f7f7f, 0, 0x7f7f7f7f)
__device__ __forceinline__ i32x8 ldsx(const LAS unsigned char* p) {
    const u32x4 a = *(const LAS u32x4*)p, b = *(const LAS u32x4*)(p + 16);
    return (i32x8){(int)a.x, (int)a.y, (int)a.z, (int)a.w, (int)b.x, (int)b.y, (int)b.z, (int)b.w};
}
__device__ __forceinline__ void qk_tilex(f32x16& p0, f32x16& p1, const LAS unsigned char* kl, const i32x8 (&q)[3]) {
#pragma unroll
    for (int i = 0; i < 16; ++i) { p0[i] = 0.f; p1[i] = 0.f; }
    i32x8 a0 = ldsx(kl), a1 = ldsx(kl + 32 * KSX), a2 = ldsx(kl + 64), a3 = ldsx(kl + 32 * KSX + 64);
    __builtin_amdgcn_sched_barrier(0);
    __builtin_amdgcn_s_setprio(1);
    p0 = MFMAX(a0, q[0], p0); p1 = MFMAX(a1, q[0], p1);
    __builtin_amdgcn_s_setprio(0);
    __builtin_amdgcn_sched_barrier(0);
    a0 = ldsx(kl + 128); a1 = ldsx(kl + 32 * KSX + 128);
    __builtin_amdgcn_sched_barrier(0);
    __builtin_amdgcn_s_setprio(1);
    p0 = MFMAX(a2, q[1], p0); p1 = MFMAX(a3, q[1], p1);
    __builtin_amdgcn_sched_barrier(0);
    p0 = MFMAX(a0, q[2], p0); p1 = MFMAX(a1, q[2], p1);
    __builtin_amdgcn_s_setprio(0);
    __builtin_amdgcn_sched_barrier(0);
}
__device__ __forceinline__ void pv_tilex(f32x16 (&o)[4], const i32x8& pb, const LAS unsigned char* vl) {
    i32x8 f0 = ldsx(vl), f1 = ldsx(vl + 32 * VSX);
    __builtin_amdgcn_sched_barrier(0);
    o[0] = MFMAX(f0, pb, o[0]);
    __builtin_amdgcn_sched_barrier(0);
    f0 = ldsx(vl + 64 * VSX);
    __builtin_amdgcn_sched_barrier(0);
    o[1] = MFMAX(f1, pb, o[1]);
    __builtin_amdgcn_sched_barrier(0);
    f1 = ldsx(vl + 96 * VSX);
    __builtin_amdgcn_sched_barrier(0);
    o[2] = MFMAX(f0, pb, o[2]);
    __builtin_amdgcn_sched_barrier(0);
    o[3] = MFMAX(f1, pb, o[3]);
    __builtin_amdgcn_sched_barrier(0);
}
__device__ __forceinline__ i32x8 packpx(const f32x16& p0, const f32x16& p1) {
    i32x8 w;
#pragma unroll
    for (int g = 0; g < 4; ++g) {
        int a = __builtin_amdgcn_cvt_pk_fp8_f32(p0[4 * g + 0], p0[4 * g + 1], 0, false); a = __builtin_amdgcn_cvt_pk_fp8_f32(p0[4 * g + 2], p0[4 * g + 3], a, true); w[g] = a;
        int b = __builtin_amdgcn_cvt_pk_fp8_f32(p1[4 * g + 0], p1[4 * g + 1], 0, false); b = __builtin_amdgcn_cvt_pk_fp8_f32(p1[4 * g + 2], p1[4 * g + 3], b, true); w[4 + g] = b;
    }
    return w;
}
__device__ __forceinline__ void online_sm_x(f32x16& p0, f32x16& p1, float& m, float& l, f32x16 (&o)[4], const float C2) {
    float tm = p0[0];
#pragma unroll
    for (int r = 1; r < 16; ++r) tm = fmaxf(tm, p0[r]);
#pragma unroll
    for (int r = 0; r < 16; ++r) tm = fmaxf(tm, p1[r]);
    tm = swapmax(tm);
    const float mn = fmaxf(m, tm);
    const float alpha = __builtin_amdgcn_exp2f((m - mn) * C2);
    m = mn;
    const float mc = 8.f - mn * C2;
    float ps = 0.f;
#pragma unroll
    for (int r = 0; r < 16; ++r) { p0[r] = __builtin_amdgcn_exp2f(__builtin_fmaf(p0[r], C2, mc)); ps += p0[r]; }
#pragma unroll
    for (int r = 0; r < 16; ++r) { p1[r] = __builtin_amdgcn_exp2f(__builtin_fmaf(p1[r], C2, mc)); ps += p1[r]; }
    ps = swapsum(ps);
    l = l * alpha + ps;
    if (!__all(alpha == 1.f)) {
#pragma unroll
        for (int d = 0; d < 4; ++d)
#pragma unroll
            for (int r = 0; r < 16; ++r) o[d][r] *= alpha;
    }
}
#endif
#ifdef MLA_MXL
#ifdef MLA_MXU
#define MXL_T 126.0f
#define MXL_REF 120.0f
#define MFMAXQ(a, b, c) __builtin_amdgcn_mfma_scale_f32_32x32x64_f8f6f4((a), (b), (c), 0, 0, 0, 0x7f7f7f7f, 0, 0x7f7f7f7f)
__device__ __forceinline__ i32x8 byte_packx(const f32x16& p0, const f32x16& p1) {
    i32x8 w;
#pragma unroll
    for (int g = 0; g < 4; ++g) {
        unsigned a = __builtin_amdgcn_cvt_pk_u8_f32(p0[4 * g + 0], 0, 0u); a = __builtin_amdgcn_cvt_pk_u8_f32(p0[4 * g + 1], 1, a); a = __builtin_amdgcn_cvt_pk_u8_f32(p0[4 * g + 2], 2, a); a = __builtin_amdgcn_cvt_pk_u8_f32(p0[4 * g + 3], 3, a); w[g] = (int)a;
        unsigned b = __builtin_amdgcn_cvt_pk_u8_f32(p1[4 * g + 0], 0, 0u); b = __builtin_amdgcn_cvt_pk_u8_f32(p1[4 * g + 1], 1, b); b = __builtin_amdgcn_cvt_pk_u8_f32(p1[4 * g + 2], 2, b); b = __builtin_amdgcn_cvt_pk_u8_f32(p1[4 * g + 3], 3, b); w[4 + g] = (int)b;
    }
    return w;
}
#else
#define MXL_T 7.0f
#define MXL_REF 0.0f
#define MFMAXQ(a, b, c) __builtin_amdgcn_mfma_scale_f32_32x32x64_f8f6f4((a), (b), (c), 0, 0, 0, 0x7f7f7f7f, 0, 0x7c7c7c7c)
#endif
__device__ __forceinline__ void qk_tilexl(f32x16& p0, f32x16& p1, const f32x16& mref, const LAS unsigned char* kl, const i32x8 (&q)[3]) {
    i32x8 a0 = ldsx(kl), a1 = ldsx(kl + 32 * KSX), a2 = ldsx(kl + 64), a3 = ldsx(kl + 32 * KSX + 64);
    __builtin_amdgcn_sched_barrier(0);
    __builtin_amdgcn_s_setprio(1);
    p0 = MFMAXQ(a0, q[0], mref); p1 = MFMAXQ(a1, q[0], mref);
    __builtin_amdgcn_s_setprio(0);
    __builtin_amdgcn_sched_barrier(0);
    a0 = ldsx(kl + 128); a1 = ldsx(kl + 32 * KSX + 128);
    __builtin_amdgcn_sched_barrier(0);
    __builtin_amdgcn_s_setprio(1);
    p0 = MFMAXQ(a2, q[1], p0); p1 = MFMAXQ(a3, q[1], p1);
    __builtin_amdgcn_sched_barrier(0);
    p0 = MFMAXQ(a0, q[2], p0); p1 = MFMAXQ(a1, q[2], p1);
    __builtin_amdgcn_s_setprio(0);
    __builtin_amdgcn_sched_barrier(0);
}
__device__ __forceinline__ void pv_tilexl(f32x16 (&o)[5], const i32x8& pb, const i32x8& ones, const LAS unsigned char* vl) {
    i32x8 f0 = ldsx(vl), f1 = ldsx(vl + 32 * VSX);
    __builtin_amdgcn_sched_barrier(0);
    o[4] = MFMAX(ones, pb, o[4]);
    __builtin_amdgcn_sched_barrier(0);
    o[0] = MFMAX(f0, pb, o[0]);
    __builtin_amdgcn_sched_barrier(0);
    f0 = ldsx(vl + 64 * VSX);
    __builtin_amdgcn_sched_barrier(0);
    o[1] = MFMAX(f1, pb, o[1]);
    __builtin_amdgcn_sched_barrier(0);
    f1 = ldsx(vl + 96 * VSX);
    __builtin_amdgcn_sched_barrier(0);
    o[2] = MFMAX(f0, pb, o[2]);
    __builtin_amdgcn_sched_barrier(0);
    o[3] = MFMAX(f1, pb, o[3]);
    __builtin_amdgcn_sched_barrier(0);
}
__device__ __forceinline__ i32x8 exp_packx(const f32x16& p0, const f32x16& p1, int any) {
    i32x8 w;
#pragma unroll
    for (int g = 0; g < 4; ++g) {
        int a = __builtin_amdgcn_cvt_pk_fp8_f32(__builtin_amdgcn_exp2f(p0[4 * g + 0]), __builtin_amdgcn_exp2f(p0[4 * g + 1]), any, false);
        a = __builtin_amdgcn_cvt_pk_fp8_f32(__builtin_amdgcn_exp2f(p0[4 * g + 2]), __builtin_amdgcn_exp2f(p0[4 * g + 3]), a, true); w[g] = a;
        int b = __builtin_amdgcn_cvt_pk_fp8_f32(__builtin_amdgcn_exp2f(p1[4 * g + 0]), __builtin_amdgcn_exp2f(p1[4 * g + 1]), any, false);
        b = __builtin_amdgcn_cvt_pk_fp8_f32(__builtin_amdgcn_exp2f(p1[4 * g + 2]), __builtin_amdgcn_exp2f(p1[4 * g + 3]), b, true); w[4 + g] = b;
    }
    return w;
}
#endif
#ifdef MLA_PIPE8
template <int NDC> __device__ __forceinline__ void qk_tile8_free(f32x16& p0, f32x16& p1, const LAS unsigned char* kl, const i64 (&q)[NDC]) {
#pragma unroll
    for (int i = 0; i < 16; ++i) { p0[i] = 0.f; p1[i] = 0.f; }
#pragma unroll
    for (int d0 = 0; d0 < NDC; ++d0) {
        const i64 a0 = *(const LAS i64*)(kl + d0 * 16), a1 = *(const LAS i64*)(kl + 32 * KS8 + d0 * 16);
        p0 = MFMA32F8(a0, q[d0], p0); p1 = MFMA32F8(a1, q[d0], p1);
    }
}
__device__ __forceinline__ float sm_core_scaled(f32x16& p0, f32x16& p1, float& m, float& l, const float C2) {
    float tm = p0[0];
#pragma unroll
    for (int r = 1; r < 16; ++r) tm = fmaxf(tm, p0[r]);
#pragma unroll
    for (int r = 0; r < 16; ++r) tm = fmaxf(tm, p1[r]);
    tm = swapmax(tm);
    const float mn = fmaxf(m, tm);
    const float alpha = __builtin_amdgcn_exp2f((m - mn) * C2);
    m = mn;
    const float mc = -mn * C2;
    float ps = 0.f;
#pragma unroll
    for (int r = 0; r < 16; ++r) { p0[r] = __builtin_amdgcn_exp2f(__builtin_fmaf(p0[r], C2, mc)); ps += p0[r]; }
#pragma unroll
    for (int r = 0; r < 16; ++r) { p1[r] = __builtin_amdgcn_exp2f(__builtin_fmaf(p1[r], C2, mc)); ps += p1[r]; }
    ps = swapsum(ps);
    l = l * alpha + ps;
    return alpha;
}
#endif
#ifdef MLA_PIPE8
struct MlaPtrs { const bf16* Q; const bf16* K; const bf16* V; const bf16* Z; bf16* O; };
__device__ __forceinline__ void mla_mask(f32x16& p0, f32x16& p1, int dq) {
#pragma unroll
    for (int r = 0; r < 16; ++r) { const int c = (r & 3) + 8 * (r >> 2);
        if (c > dq) p0[r] = -__builtin_inff();
        if (c + 32 > dq) p1[r] = -__builtin_inff(); }
}
__device__ __forceinline__ void mla_unit(LAS unsigned char* lds, const MlaPtrs& P, int head, int qb, int tid_in, int wave, int lane_in) {
    int tid = tid_in; asm volatile("" : "+v"(tid)); const int lane = tid & 63; (void)lane_in;
    const int r32 = lane & 31, hi = lane >> 5;
    const int q0 = qb * 256, qw = q0 + wave * 32, tq = qw + r32;
    i64 q[12];
    { const unsigned char* qp = (const unsigned char*)P.Q + (size_t)tq * 3072 + head * 192 + hi * 8;
#pragma unroll
      for (int d0 = 0; d0 < 12; ++d0) q[d0] = *(const GAS i64*)(qp + d0 * 16); }
    const int NT = 4 * (qb + 1);
    const int srow = tid >> 3, sc8 = tid & 7;
    const unsigned char* kg = (const unsigned char*)P.K + (size_t)head * 192 + (size_t)srow * 3072 + sc8 * 8;
    const unsigned char* vg = (const unsigned char*)P.V + ((size_t)head * 128 + (tid >> 2)) * S + (tid & 3) * 16;
    LAS unsigned char* kst = lds + srow * KS8 + sc8 * 8;
    LAS unsigned char* vst = lds + 2 * MLA_KB8 + (tid >> 2) * VS8 + (tid & 3) * 16;
    const LAS unsigned char* kl = lds + r32 * KS8 + hi * 8;
    const LAS unsigned char* vl = lds + 2 * MLA_KB8 + r32 * VS8 + hi * 8;
    u32x2 sk0, sk1, sk2; u32x4 sv0;
#define MLA_LOADK(j) do { const unsigned char* kp_ = kg + (size_t)(j) * (64 * 3072); sk0 = *(const GAS u32x2*)(kp_); sk1 = *(const GAS u32x2*)(kp_ + 64); sk2 = *(const GAS u32x2*)(kp_ + 128); } while (0)
#define MLA_LOADV(j) do { sv0 = *(const GAS u32x4*)(vg + (size_t)(j) * 64); } while (0)
#define MLA_STOREK(b) do { LAS unsigned char* kd_ = kst + (b) * MLA_KB8; *(LAS u32x2*)(kd_) = sk0; *(LAS u32x2*)(kd_ + 64) = sk1; *(LAS u32x2*)(kd_ + 128) = sk2; } while (0)
#define MLA_STOREV(b) do { LAS unsigned char* vd_ = vst + (b) * VB8; *(LAS u32x2*)(vd_) = (u32x2){sv0.x, sv0.y}; *(LAS u32x2*)(vd_ + 8) = (u32x2){sv0.z, sv0.w}; } while (0)
    float m = -1e30f, l = 0.f; f32x16 o[4];
#pragma unroll
    for (int d = 0; d < 4; ++d)
#pragma unroll
        for (int r = 0; r < 16; ++r) o[d][r] = 0.f;
    f32x16 pA0, pA1, pB0, pB1;
    MLA_LOADK(0); MLA_LOADV(0); MLA_STOREK(0); MLA_STOREV(0);
    MLA_LOADK(1);
    __syncthreads();
    qk_tile8<12>(pA0, pA1, kl, q);
    if (63 > qw) mla_mask(pA0, pA1, tq - 4 * hi);
    MLA_STOREK(1);
    if (2 < NT) MLA_LOADK(2);
    MLA_LOADV(1);
    __syncthreads();
#define MLA_SGB1() do { __builtin_amdgcn_sched_group_barrier(0x100, 2, 0); __builtin_amdgcn_sched_group_barrier(0x008, 1, 0); __builtin_amdgcn_sched_group_barrier(0x002, 6, 0); \
        __builtin_amdgcn_sched_group_barrier(0x008, 1, 0); __builtin_amdgcn_sched_group_barrier(0x002, 6, 0); } while (0)
#define MLA_SGB() do { MLA_SGB1(); MLA_SGB1(); MLA_SGB1(); MLA_SGB1(); MLA_SGB1(); MLA_SGB1(); MLA_SGB1(); MLA_SGB1(); MLA_SGB1(); MLA_SGB1(); MLA_SGB1(); MLA_SGB1(); } while (0)
#define MLA_STEP(PX0, PX1, PY0, PY1, j) do { \
        const int kb1_ = 64 * ((j) + 1); \
        const bool a1_ = ((j) + 1 < NT) && (kb1_ <= qw + 31), a0_ = (64 * (j) <= qw + 31); \
        float alpha_ = 1.f; i64 pb_[4]; \
        if (a1_) { \
            __builtin_amdgcn_sched_barrier(0); \
            qk_tile8_free<12>(PY0, PY1, kl + (((j) + 1) & 1) * MLA_KB8, q); \
            alpha_ = sm_core_scaled(PX0, PX1, m, l, QS_MLA); \
            pb_[0] = packp8<0>(PX0); pb_[1] = packp8<1>(PX0); pb_[2] = packp8<0>(PX1); pb_[3] = packp8<1>(PX1); \
            MLA_SGB(); \
            __builtin_amdgcn_sched_barrier(0); \
            if (kb1_ + 63 > qw) mla_mask(PY0, PY1, tq - kb1_ - 4 * hi); \
        } else if (a0_) { \
            alpha_ = sm_core_scaled(PX0, PX1, m, l, QS_MLA); \
            pb_[0] = packp8<0>(PX0); pb_[1] = packp8<1>(PX0); pb_[2] = packp8<0>(PX1); pb_[3] = packp8<1>(PX1); \
        } \
        if (a0_) { \
            if (!__all(alpha_ == 1.f)) { _Pragma("unroll") for (int d_ = 0; d_ < 4; ++d_) _Pragma("unroll") for (int r_ = 0; r_ < 16; ++r_) o[d_][r_] *= alpha_; } \
            pv_tile8(o, pb_, vl + ((j) & 1) * VB8); \
        } \
        if ((j) + 2 < NT) MLA_STOREK((j) & 1); \
        if ((j) + 1 < NT) MLA_STOREV(((j) + 1) & 1); \
        if ((j) + 3 < NT) MLA_LOADK((j) + 3); \
        if ((j) + 2 < NT) MLA_LOADV((j) + 2); \
        __syncthreads(); } while (0)
    for (int j = 0; j < NT; j += 2) {
        MLA_STEP(pA0, pA1, pB0, pB1, j);
        MLA_STEP(pB0, pB1, pA0, pA1, j + 1);
    }
#undef MLA_STEP
#undef MLA_SGB
#undef MLA_SGB1
#undef MLA_LOADK
#undef MLA_LOADV
#undef MLA_STOREK
#undef MLA_STOREV
    const float inv = (1.f / 256.f) / l;
    const bf16* zp = P.Z + (size_t)tq * 2048 + head * 128 + 4 * hi;
    bf16* op = P.O + (size_t)tq * 4096 + head * 128 + 4 * hi;
#pragma unroll
    for (int d0 = 0; d0 < 4; ++d0)
#pragma unroll
        for (int rg = 0; rg < 4; ++rg) { const int dim = 32 * d0 + 8 * rg;
            const u32x2 z = *(const GAS u32x2*)(zp + dim);
            u32x2 w; w.x = pk2(o[d0][4 * rg + 0] * inv * bflo(z.x), o[d0][4 * rg + 1] * inv * bfhi(z.x)); w.y = pk2(o[d0][4 * rg + 2] * inv * bflo(z.y), o[d0][4 * rg + 3] * inv * bfhi(z.y));
            *(GAS u32x2*)(op + dim) = w; }
}
#elif defined(MLA_PIPE)
struct MlaPtrs { const bf16* Q; const bf16* K; const bf16* V; const bf16* Z; bf16* O; };
__device__ __forceinline__ void mla_mask(f32x16& p0, f32x16& p1, int dq) {
#pragma unroll
    for (int r = 0; r < 16; ++r) { const int c = (r & 3) + 8 * (r >> 2);
        if (c > dq) p0[r] = -__builtin_inff();
        if (c + 32 > dq) p1[r] = -__builtin_inff(); }
}
__device__ __forceinline__ void mla_unit(LAS unsigned char* lds, const MlaPtrs& P, int head, int qb, int tid_in, int wave, int lane_in) {
    int tid = tid_in; asm volatile("" : "+v"(tid)); const int lane = tid & 63; (void)lane_in;
    const int r32 = lane & 31, hi = lane >> 5;
    const int q0 = qb * 256, qw = q0 + wave * 32, tq = qw + r32;
    bf16x8 q[8];
    LAS unsigned char* ql = lds + MLA_QL + wave * 4096 + lane * 16;
    { const bf16* qp = P.Q + (size_t)tq * 3072 + head * 192 + hi * 8;
#pragma unroll
      for (int d0 = 0; d0 < 8; ++d0) q[d0] = *(const GAS bf16x8*)(qp + d0 * 16);
#pragma unroll
      for (int d0 = 8; d0 < 12; ++d0) *(LAS bf16x8*)(ql + (d0 - 8) * 1024) = *(const GAS bf16x8*)(qp + d0 * 16); }
    const int NT = 4 * (qb + 1);
    const int srow = tid >> 3, sc8 = tid & 7;
    const unsigned char* kg = (const unsigned char*)P.K + (size_t)head * 384 + (size_t)srow * 6144 + sc8 * 16;
    const unsigned char* vg = (const unsigned char*)P.V + (size_t)head * 256 + (size_t)srow * 4096 + sc8 * 16;
    LAS unsigned char* kst = lds + srow * KS_M + sc8 * 16;
    LAS unsigned char* vst = lds + 2 * MLA_KB + srow * VS + sc8 * 16;
    const LAS unsigned char* kl = lds + r32 * KS_M + hi * 16;
    const LAS unsigned char* vl = lds + 2 * MLA_KB + (4 * hi + ((lane & 15) >> 2)) * VS + (16 * ((lane >> 4) & 1) + 4 * (lane & 3)) * 2;
    u32x4 sk0, sk1, sk2, sv0, sv1;
#define MLA_LOADK(j) do { const unsigned char* kp_ = kg + (size_t)(j) * (64 * 6144); sk0 = *(const GAS u32x4*)(kp_); sk1 = *(const GAS u32x4*)(kp_ + 128); sk2 = *(const GAS u32x4*)(kp_ + 256); } while (0)
#define MLA_LOADV(j) do { const unsigned char* vp_ = vg + (size_t)(j) * (64 * 4096); sv0 = *(const GAS u32x4*)(vp_); sv1 = *(const GAS u32x4*)(vp_ + 128); } while (0)
#define MLA_STOREK(b) do { LAS unsigned char* kd_ = kst + (b) * MLA_KB; *(LAS u32x4*)(kd_) = sk0; *(LAS u32x4*)(kd_ + 128) = sk1; *(LAS u32x4*)(kd_ + 256) = sk2; } while (0)
#define MLA_STOREV(b) do { LAS unsigned char* vd_ = vst + (b) * VB; *(LAS u32x4*)(vd_) = sv0; *(LAS u32x4*)(vd_ + 128) = sv1; } while (0)
    float m = -1e30f, l = 0.f; f32x16 o[4];
#pragma unroll
    for (int d = 0; d < 4; ++d)
#pragma unroll
        for (int r = 0; r < 16; ++r) o[d][r] = 0.f;
    f32x16 pA0, pA1, pB0, pB1;
    MLA_LOADK(0); MLA_LOADV(0); MLA_STOREK(0); MLA_STOREV(0);
    MLA_LOADK(1);
    __syncthreads();
    qk_tile_free<12, 8, KS_M>(pA0, pA1, kl, q, ql);
    if (63 > qw) mla_mask(pA0, pA1, tq - 4 * hi);
    MLA_STOREK(1);
    if (2 < NT) MLA_LOADK(2);
    MLA_LOADV(1);
    __syncthreads();
#define MLA_SGB1(NR) do { __builtin_amdgcn_sched_group_barrier(0x100, NR, 0); __builtin_amdgcn_sched_group_barrier(0x008, 1, 0); __builtin_amdgcn_sched_group_barrier(0x002, 6, 0); \
        __builtin_amdgcn_sched_group_barrier(0x008, 1, 0); __builtin_amdgcn_sched_group_barrier(0x002, 6, 0); } while (0)
#define MLA_SGB() do { MLA_SGB1(2); MLA_SGB1(2); MLA_SGB1(2); MLA_SGB1(2); MLA_SGB1(2); MLA_SGB1(2); MLA_SGB1(2); MLA_SGB1(2); MLA_SGB1(3); MLA_SGB1(3); MLA_SGB1(3); MLA_SGB1(3); } while (0)
#define MLA_STEP(PX0, PX1, PY0, PY1, j) do { \
        const int kb1_ = 64 * ((j) + 1); \
        const bool a1_ = ((j) + 1 < NT) && (kb1_ <= qw + 31), a0_ = (64 * (j) <= qw + 31); \
        float alpha_ = 1.f; bf16x8 pb_[4]; \
        if (a1_) { \
            __builtin_amdgcn_sched_barrier(0); \
            qk_tile_free<12, 8, KS_M>(PY0, PY1, kl + (((j) + 1) & 1) * MLA_KB, q, ql); \
            alpha_ = sm_core(PX0, PX1, m, l); \
            pb_[0] = packp<0>(PX0); pb_[1] = packp<1>(PX0); pb_[2] = packp<0>(PX1); pb_[3] = packp<1>(PX1); \
            MLA_SGB(); \
            __builtin_amdgcn_sched_barrier(0); \
            if (kb1_ + 63 > qw) mla_mask(PY0, PY1, tq - kb1_ - 4 * hi); \
        } else if (a0_) { \
            alpha_ = sm_core(PX0, PX1, m, l); \
            pb_[0] = packp<0>(PX0); pb_[1] = packp<1>(PX0); pb_[2] = packp<0>(PX1); pb_[3] = packp<1>(PX1); \
        } \
        if (a0_) { \
            if (!__all(alpha_ == 1.f)) { _Pragma("unroll") for (int d_ = 0; d_ < 4; ++d_) _Pragma("unroll") for (int r_ = 0; r_ < 16; ++r_) o[d_][r_] *= alpha_; } \
            pv_tile(o, pb_, vl + ((j) & 1) * VB); \
        } \
        if ((j) + 2 < NT) MLA_STOREK((j) & 1); \
        if ((j) + 1 < NT) MLA_STOREV(((j) + 1) & 1); \
        if ((j) + 3 < NT) MLA_LOADK((j) + 3); \
        if ((j) + 2 < NT) MLA_LOADV((j) + 2); \
        __syncthreads(); } while (0)
    for (int j = 0; j < NT; j += 2) {
        MLA_STEP(pA0, pA1, pB0, pB1, j);
        MLA_STEP(pB0, pB1, pA0, pA1, j + 1);
    }
#undef MLA_STEP
#undef MLA_SGB
#undef MLA_SGB1
#undef MLA_LOADK
#undef MLA_LOADV
#undef MLA_STOREK
#undef MLA_STOREV
    const float inv = 1.f / l;
    const bf16* zp = P.Z + (size_t)tq * 2048 + head * 128 + 4 * hi;
    bf16* op = P.O + (size_t)tq * 4096 + head * 128 + 4 * hi;
#pragma unroll
    for (int d0 = 0; d0 < 4; ++d0)
#pragma unroll
        for (int rg = 0; rg < 4; ++rg) { const int dim = 32 * d0 + 8 * rg;
            const u32x2 z = *(const GAS u32x2*)(zp + dim);
            u32x2 w; w.x = pk2(o[d0][4 * rg + 0] * inv * bflo(z.x), o[d0][4 * rg + 1] * inv * bfhi(z.x)); w.y = pk2(o[d0][4 * rg + 2] * inv * bflo(z.y), o[d0][4 * rg + 3] * inv * bfhi(z.y));
            *(GAS u32x2*)(op + dim) = w; }
}

#else
#if defined(MLA_MXQ)
struct MlaPtrs { const bf16* Q; const bf16* K; const bf16* V; const bf16* Z; bf16* O; };
constexpr int VBQ = 160 * VSX;
static_assert(2 * MLA_KBX + 2 * VBQ <= 131072, "MLA mxq LDS map");
__device__ __forceinline__ void mla_maskq(f32x16& p0, f32x16& p1, int dq) {
#pragma unroll
    for (int r = 0; r < 16; ++r) { const int c = (r & 3) + 8 * (r >> 2);
        if (c > dq) p0[r] = -__builtin_inff();
        if (c + 32 > dq) p1[r] = -__builtin_inff(); }
}
__device__ __forceinline__ float mla_rowmaxq(const f32x16& p0, const f32x16& p1) {
    float tm = p0[0];
#pragma unroll
    for (int r = 1; r < 16; ++r) tm = fmaxf(tm, p0[r]);
#pragma unroll
    for (int r = 0; r < 16; ++r) tm = fmaxf(tm, p1[r]);
    return swapmax(tm);
}
__device__ __forceinline__ void mla_unit(LAS unsigned char* lds, const MlaPtrs& P, int head, int qb, int tid_in, int wave, int lane_in) {
    int tid = tid_in; asm volatile("" : "+v"(tid)); const int lane = tid & 63; (void)lane_in;
    const int r32 = lane & 31, hi = lane >> 5;
    const int q0 = qb * 256, qw = q0 + wave * 32, tq = qw + r32;
    i32x8 q[3];
    { const unsigned char* qp = (const unsigned char*)P.Q + (size_t)tq * 3072 + head * 192 + hi * 32;
#pragma unroll
      for (int s = 0; s < 3; ++s) { const u32x4 a = *(const GAS u32x4*)(qp + 64 * s), b = *(const GAS u32x4*)(qp + 64 * s + 16);
          q[s] = (i32x8){(int)a.x, (int)a.y, (int)a.z, (int)a.w, (int)b.x, (int)b.y, (int)b.z, (int)b.w}; } }
    const int NT = 4 * (qb + 1);
    const int srow = tid >> 3, sc8 = tid & 7;
    const unsigned char* kg = (const unsigned char*)P.K + (size_t)head * 192 + (size_t)srow * 3072 + sc8 * 8;
    const unsigned char* vg = (const unsigned char*)P.V + ((size_t)head * 128 + (tid >> 2)) * S + (tid & 3) * 16;
    LAS unsigned char* kst = lds + srow * KSX + sc8 * 8;
    LAS unsigned char* vst = lds + 2 * MLA_KBX + (tid >> 2) * VSX + (tid & 3) * 16;
    const LAS unsigned char* kl = lds + r32 * KSX + hi * 32;
    const LAS unsigned char* vl = lds + 2 * MLA_KBX + r32 * VSX + hi * 32;
    u32x2 sk0, sk1, sk2; u32x4 sv0;
#define MLA_LOADK(j) do { const unsigned char* kp_ = kg + (size_t)(j) * (64 * 3072); sk0 = *(const GAS u32x2*)(kp_); sk1 = *(const GAS u32x2*)(kp_ + 64); sk2 = *(const GAS u32x2*)(kp_ + 128); } while (0)
#define MLA_LOADV(j) do { sv0 = *(const GAS u32x4*)(vg + (size_t)(j) * 64); } while (0)
#define MLA_STOREK(b) do { LAS unsigned char* kd_ = kst + (b) * MLA_KBX; *(LAS u32x2*)(kd_) = sk0; *(LAS u32x2*)(kd_ + 64) = sk1; *(LAS u32x2*)(kd_ + 128) = sk2; } while (0)
#define MLA_STOREV(b) do { LAS unsigned char* vd_ = vst + (b) * VBQ; *(LAS u32x2*)(vd_) = (u32x2){sv0.x, sv0.y}; *(LAS u32x2*)(vd_ + 8) = (u32x2){sv0.z, sv0.w}; } while (0)
    f32x16 o[5], mref;
#pragma unroll
    for (int d = 0; d < 5; ++d)
#pragma unroll
        for (int r = 0; r < 16; ++r) o[d][r] = 0.f;
#pragma unroll
    for (int r = 0; r < 16; ++r) mref[r] = MXL_REF;
    f32x16 p0, p1;
    if (tid < 256) { const int slot = tid >> 7, row = (tid >> 2) & 31, ch = tid & 3; const unsigned v1 = (row == 0 || row == 4) ? 0x38383838u : 0u;
        *(LAS u32x4*)(lds + 2 * MLA_KBX + slot * VBQ + (128 + row) * VSX + ch * 16) = (u32x4){v1, v1, v1, v1}; }
    MLA_LOADK(0); MLA_LOADV(0); MLA_STOREK(0); MLA_STOREV(0);
    MLA_LOADK(1);
    __syncthreads();
    qk_tilexl(p0, p1, mref, kl, q);
    if (63 > qw) mla_maskq(p0, p1, tq - 4 * hi);
    { const float dlt = mla_rowmaxq(p0, p1) - MXL_REF;
#pragma unroll
      for (int r = 0; r < 16; ++r) { p0[r] -= dlt; p1[r] -= dlt; mref[r] -= dlt; } }
    i32x8 pbA = byte_packx(p0, p1), pbB = pbA;
    MLA_STOREK(1);
    if (2 < NT) MLA_LOADK(2);
    MLA_LOADV(1);
    __syncthreads();
    asm volatile("" : "+v"(q[0]), "+v"(q[1]), "+v"(q[2]));
    int sc1_ = 0x7f7f7f7f; asm volatile("" : "+v"(sc1_));
#define SB() __builtin_amdgcn_sched_barrier(0)
#define MFMA_T(acc, a, b) asm volatile("s_nop 1\n\tv_mfma_scale_f32_32x32x64_f8f6f4 %0, %1, %2, %0, %3, %3 op_sel_hi:[0,0,0]" : "+v"(acc) : "v"(a), "v"(b), "v"(sc1_))
#define MFMA_C(acc, a, b, c) asm volatile("s_nop 1\n\tv_mfma_scale_f32_32x32x64_f8f6f4 %0, %1, %2, %3, %4, %4 op_sel_hi:[0,0,0]" : "=&v"(acc) : "v"(a), "v"(b), "v"(c), "v"(sc1_))
#define CVT8(P, R0, PB, W0) do { unsigned w_ = __builtin_amdgcn_cvt_pk_u8_f32(P[(R0) + 0], 0, 0u); w_ = __builtin_amdgcn_cvt_pk_u8_f32(P[(R0) + 1], 1, w_); w_ = __builtin_amdgcn_cvt_pk_u8_f32(P[(R0) + 2], 2, w_); \
        w_ = __builtin_amdgcn_cvt_pk_u8_f32(P[(R0) + 3], 3, w_); PB[(W0)] = (int)w_; \
        w_ = __builtin_amdgcn_cvt_pk_u8_f32(P[(R0) + 4], 0, 0u); w_ = __builtin_amdgcn_cvt_pk_u8_f32(P[(R0) + 5], 1, w_); w_ = __builtin_amdgcn_cvt_pk_u8_f32(P[(R0) + 6], 2, w_); \
        w_ = __builtin_amdgcn_cvt_pk_u8_f32(P[(R0) + 7], 3, w_); PB[(W0) + 1] = (int)w_; } while (0)
#define MLA_STEP(PBX, PBY, j) do { \
        const int kb1_ = 64 * ((j) + 1); \
        if (64 * (j) <= qw + 31) { \
            const LAS unsigned char* kn_ = kl + (((j) + 1) & 1) * MLA_KBX; const LAS unsigned char* vj_ = vl + ((j) & 1) * VBQ; \
            SB(); \
            i32x8 a0_f = ldsx(kn_), a1_f = ldsx(kn_ + 32 * KSX); \
            SB(); MFMA_C(p0, a0_f, q[0], mref); SB(); \
            a0_f = ldsx(kn_ + 64); \
            SB(); MFMA_C(p1, a1_f, q[0], mref); SB(); \
            a1_f = ldsx(kn_ + 32 * KSX + 64); \
            SB(); MFMA_T(p0, a0_f, q[1]); SB(); \
            a0_f = ldsx(kn_ + 128); \
            SB(); MFMA_T(p1, a1_f, q[1]); SB(); \
            a1_f = ldsx(kn_ + 32 * KSX + 128); \
            SB(); MFMA_T(p0, a0_f, q[2]); SB(); \
            a0_f = ldsx(vj_ + 128 * VSX); \
            SB(); MFMA_T(p1, a1_f, q[2]); SB(); \
            a1_f = ldsx(vj_); \
            SB(); MFMA_T(o[4], a0_f, PBX); SB(); \
            a0_f = ldsx(vj_ + 32 * VSX); \
            SB(); MFMA_T(o[0], a1_f, PBX); SB(); \
            a1_f = ldsx(vj_ + 64 * VSX); \
            float tmx_ = p0[0]; _Pragma("unroll") for (int r_ = 1; r_ < 16; ++r_) tmx_ = fmaxf(tmx_, p0[r_]); \
            CVT8(p0, 0, PBY, 0); CVT8(p0, 8, PBY, 2); \
            SB(); MFMA_T(o[1], a0_f, PBX); SB(); \
            a0_f = ldsx(vj_ + 96 * VSX); \
            _Pragma("unroll") for (int r_ = 0; r_ < 16; ++r_) tmx_ = fmaxf(tmx_, p1[r_]); \
            CVT8(p1, 0, PBY, 4); \
            SB(); MFMA_T(o[2], a1_f, PBX); SB(); \
            CVT8(p1, 8, PBY, 6); tmx_ = swapmax(tmx_); \
            SB(); MFMA_T(o[3], a0_f, PBX); SB(); \
            const bool diag_ = kb1_ + 63 > qw; \
            if (diag_ || !__all(tmx_ <= MXL_T)) {               \
                asm volatile("s_nop 15\n\ts_nop 15\n\ts_nop 15" ::: "memory");     \
                if (diag_) mla_maskq(p0, p1, tq - kb1_ - 4 * hi); \
                const float dlt_ = fmaxf(mla_rowmaxq(p0, p1) - MXL_REF, 0.f); const float alpha_ = __builtin_amdgcn_exp2f(-0.125f * dlt_); \
                _Pragma("unroll") for (int r_ = 0; r_ < 16; ++r_) { p0[r_] -= dlt_; p1[r_] -= dlt_; mref[r_] -= dlt_; } \
                _Pragma("unroll") for (int d_ = 0; d_ < 5; ++d_) _Pragma("unroll") for (int r_ = 0; r_ < 16; ++r_) o[d_][r_] *= alpha_; \
                PBY = byte_packx(p0, p1); } \
        } \
        if ((j) + 2 < NT) MLA_STOREK((j) & 1); \
        if ((j) + 1 < NT) MLA_STOREV(((j) + 1) & 1); \
        if ((j) + 3 < NT) MLA_LOADK((j) + 3); \
        if ((j) + 2 < NT) MLA_LOADV((j) + 2); \
        __syncthreads(); } while (0)
    for (int j = 0; j < NT; j += 2) {
        MLA_STEP(pbA, pbB, j);
        MLA_STEP(pbB, pbA, j + 1);
    }
    asm volatile("s_nop 15\n\ts_nop 15" ::: "memory");
#undef MLA_STEP
#undef CVT8
#undef MFMA_T
#undef MFMA_C
#undef SB
#undef MLA_LOADK
#undef MLA_LOADV
#undef MLA_STOREK
#undef MLA_STOREV
    const float inv = 1.f / o[4][0];
    const bf16* zp = P.Z + (size_t)tq * 2048 + head * 128 + 4 * hi;
    bf16* op = P.O + (size_t)tq * 4096 + head * 128 + 4 * hi;
#pragma unroll
    for (int d0 = 0; d0 < 4; ++d0)
#pragma unroll
        for (int rg = 0; rg < 4; ++rg) { const int dim = 32 * d0 + 8 * rg;
            const u32x2 z = *(const GAS u32x2*)(zp + dim);
            u32x2 w; w.x = pk2(o[d0][4 * rg + 0] * inv * bflo(z.x), o[d0][4 * rg + 1] * inv * bfhi(z.x)); w.y = pk2(o[d0][4 * rg + 2] * inv * bflo(z.y), o[d0][4 * rg + 3] * inv * bfhi(z.y));
            *(GAS u32x2*)(op + dim) = w; }
}

#elif defined(MLA_MXL)
struct MlaPtrs { const bf16* Q; const bf16* K; const bf16* V; const bf16* Z; bf16* O; };
__device__ __forceinline__ void mla_unit(LAS unsigned char* lds, const MlaPtrs& P, int head, int qb, int tid_in, int wave, int lane_in) {
    int tid = tid_in; asm volatile("" : "+v"(tid)); const int lane = tid & 63; (void)lane_in;
    const int r32 = lane & 31, hi = lane >> 5;
    const int q0 = qb * 256, qw = q0 + wave * 32, tq = qw + r32;
    i32x8 q[3];
    { const unsigned char* qp = (const unsigned char*)P.Q + (size_t)tq * 3072 + head * 192 + hi * 32;
#pragma unroll
      for (int s = 0; s < 3; ++s) { const u32x4 a = *(const GAS u32x4*)(qp + 64 * s), b = *(const GAS u32x4*)(qp + 64 * s + 16);
          q[s] = (i32x8){(int)a.x, (int)a.y, (int)a.z, (int)a.w, (int)b.x, (int)b.y, (int)b.z, (int)b.w}; } }
    const int NT = 4 * (qb + 1);
    const int srow = tid >> 3, sc8 = tid & 7;
    const unsigned char* kg = (const unsigned char*)P.K + (size_t)head * 192 + (size_t)srow * 3072 + sc8 * 8;
    const unsigned char* vg = (const unsigned char*)P.V + ((size_t)head * 128 + (tid >> 2)) * S + (tid & 3) * 16;
    LAS unsigned char* kst = lds + srow * KSX + sc8 * 8;
    LAS unsigned char* vst = lds + 2 * MLA_KBX + (tid >> 2) * VSX + (tid & 3) * 16;
    const LAS unsigned char* kl = lds + r32 * KSX + hi * 32;
    const LAS unsigned char* vl = lds + 2 * MLA_KBX + r32 * VSX + hi * 32;
    u32x2 sk0, sk1, sk2; u32x4 sv0;
#define MLA_LOAD(j) do { const unsigned char* kp_ = kg + (size_t)(j) * (64 * 3072); const unsigned char* vp_ = vg + (size_t)(j) * 64; \
        sk0 = *(const GAS u32x2*)(kp_); sk1 = *(const GAS u32x2*)(kp_ + 64); sk2 = *(const GAS u32x2*)(kp_ + 128); sv0 = *(const GAS u32x4*)(vp_); } while (0)
#define MLA_STORE(b, vb) do { LAS unsigned char* kd_ = kst + (b) * MLA_KBX; LAS unsigned char* vd_ = vst + (vb) * VBX; \
        *(LAS u32x2*)(kd_) = sk0; *(LAS u32x2*)(kd_ + 64) = sk1; *(LAS u32x2*)(kd_ + 128) = sk2; *(LAS u32x2*)(vd_) = (u32x2){sv0.x, sv0.y}; *(LAS u32x2*)(vd_ + 8) = (u32x2){sv0.z, sv0.w}; } while (0)
    MLA_LOAD(0); MLA_STORE(0, 0);
    __syncthreads();
    asm volatile("" : "+v"(q[0]), "+v"(q[1]), "+v"(q[2]));
    f32x16 o[5], mref;
#pragma unroll
    for (int d = 0; d < 5; ++d)
#pragma unroll
        for (int r = 0; r < 16; ++r) o[d][r] = 0.f;
#pragma unroll
    for (int r = 0; r < 16; ++r) mref[r] = MXL_REF;
    const int one8 = (r32 == 0 || r32 == 4) ? 0x38383838 : 0;
    const i32x8 ones = {one8, one8, one8, one8, one8, one8, one8, one8};
    const bool trail = wave >= 4;
    i32x8 pb = {};
    int vb_cur = 0, vb_prev = 2;
    for (int j = 0; j < NT; ++j) {
        const int kb = 64 * j;
        int vb_next = vb_cur + 1; if (vb_next == 3) vb_next = 0;
        if (j + 1 < NT) MLA_LOAD(j + 1);
        if (trail && j > 0 && kb - 64 <= qw + 31) pv_tilexl(o, pb, ones, vl + vb_prev * VBX);
        if (kb <= qw + 31) {
            f32x16 p0, p1;
            qk_tilexl(p0, p1, mref, kl + (j & 1) * MLA_KBX, q);
            if (kb + 63 > qw) {
                const int dq = tq - kb - 4 * hi;
#pragma unroll
                for (int r = 0; r < 16; ++r) { const int c = (r & 3) + 8 * (r >> 2);
                    if (c > dq) p0[r] = -__builtin_inff();
                    if (c + 32 > dq) p1[r] = -__builtin_inff(); }
            }
            float tm = p0[0];
#pragma unroll
            for (int r = 1; r < 16; ++r) tm = fmaxf(tm, p0[r]);
#pragma unroll
            for (int r = 0; r < 16; ++r) tm = fmaxf(tm, p1[r]);
            tm = swapmax(tm);
            if (j == 0 || !__all(tm <= MXL_T)) {
#ifdef MLA_MXU
                const float dlt = (j == 0) ? tm - MXL_REF : fmaxf(tm - MXL_REF, 0.f);
                const float alpha = __builtin_amdgcn_exp2f(-0.125f * dlt);
#else
                const float dlt = (j == 0) ? tm : fmaxf(tm, 0.f);
                const float alpha = __builtin_amdgcn_exp2f(-dlt);
#endif
#pragma unroll
                for (int r = 0; r < 16; ++r) { p0[r] -= dlt; p1[r] -= dlt; mref[r] -= dlt; }
                if (j > 0) {
#pragma unroll
                    for (int d = 0; d < 5; ++d)
#pragma unroll
                        for (int r = 0; r < 16; ++r) o[d][r] *= alpha;
                }
            }
#ifdef MLA_MXU
            pb = byte_packx(p0, p1);
#else
            pb = exp_packx(p0, p1, one8);
#endif
            if (!trail) pv_tilexl(o, pb, ones, vl + vb_cur * VBX);
        }
        if (j + 1 < NT) MLA_STORE((j + 1) & 1, vb_next);
        __syncthreads();
        vb_prev = vb_cur; vb_cur = vb_next;
    }
    if (trail && 64 * (NT - 1) <= qw + 31) pv_tilexl(o, pb, ones, vl + vb_prev * VBX);
    __syncthreads();
#undef MLA_LOAD
#undef MLA_STORE
    const float inv = 1.f / o[4][0];
    const bf16* zp = P.Z + (size_t)tq * 2048 + head * 128 + 4 * hi;
    bf16* op = P.O + (size_t)tq * 4096 + head * 128 + 4 * hi;
#pragma unroll
    for (int d0 = 0; d0 < 4; ++d0)
#pragma unroll
        for (int rg = 0; rg < 4; ++rg) { const int dim = 32 * d0 + 8 * rg;
            const u32x2 z = *(const GAS u32x2*)(zp + dim);
            u32x2 w; w.x = pk2(o[d0][4 * rg + 0] * inv * bflo(z.x), o[d0][4 * rg + 1] * inv * bfhi(z.x)); w.y = pk2(o[d0][4 * rg + 2] * inv * bflo(z.y), o[d0][4 * rg + 3] * inv * bfhi(z.y));
            *(GAS u32x2*)(op + dim) = w; }
}

#elif defined(MLA_MXP)
struct MlaPtrs { const bf16* Q; const bf16* K; const bf16* V; const bf16* Z; bf16* O; };
__device__ __forceinline__ void mla_maskx(f32x16& p0, f32x16& p1, int dq) {
#pragma unroll
    for (int r = 0; r < 16; ++r) { const int c = (r & 3) + 8 * (r >> 2);
        if (c > dq) p0[r] = -__builtin_inff();
        if (c + 32 > dq) p1[r] = -__builtin_inff(); }
}
__device__ __forceinline__ float mla_rowmax(const f32x16& p0, const f32x16& p1) {
    float tm = p0[0];
#pragma unroll
    for (int r = 1; r < 16; ++r) tm = fmaxf(tm, p0[r]);
#pragma unroll
    for (int r = 0; r < 16; ++r) tm = fmaxf(tm, p1[r]);
    return swapmax(tm);
}
#define MXP_EXP8(P, R0) do { _Pragma("unroll") for (int r_ = (R0); r_ < (R0) + 8; ++r_) { P[r_] = __builtin_amdgcn_exp2f(__builtin_fmaf(P[r_], QS_MLA, mc_)); ps_ += P[r_]; } } while (0)
__device__ __forceinline__ void mla_unit(LAS unsigned char* lds, const MlaPtrs& P, int head, int qb, int tid_in, int wave, int lane_in) {
    int tid = tid_in; asm volatile("" : "+v"(tid)); const int lane = tid & 63; (void)lane_in;
    const int r32 = lane & 31, hi = lane >> 5;
    const int q0 = qb * 256, qw = q0 + wave * 32, tq = qw + r32;
    i32x8 q[3];
    { const unsigned char* qp = (const unsigned char*)P.Q + (size_t)tq * 3072 + head * 192 + hi * 32;
#pragma unroll
      for (int s = 0; s < 3; ++s) { const u32x4 a = *(const GAS u32x4*)(qp + 64 * s), b = *(const GAS u32x4*)(qp + 64 * s + 16);
          q[s] = (i32x8){(int)a.x, (int)a.y, (int)a.z, (int)a.w, (int)b.x, (int)b.y, (int)b.z, (int)b.w}; } }
    const int NT = 4 * (qb + 1);
    const int srow = tid >> 3, sc8 = tid & 7;
    const unsigned char* kg = (const unsigned char*)P.K + (size_t)head * 192 + (size_t)srow * 3072 + sc8 * 8;
    const unsigned char* vg = (const unsigned char*)P.V + ((size_t)head * 128 + (tid >> 2)) * S + (tid & 3) * 16;
    LAS unsigned char* kst = lds + srow * KSX + sc8 * 8;
    LAS unsigned char* vst = lds + 2 * MLA_KBX + (tid >> 2) * VSX + (tid & 3) * 16;
    const LAS unsigned char* kl = lds + r32 * KSX + hi * 32;
    const LAS unsigned char* vl = lds + 2 * MLA_KBX + r32 * VSX + hi * 32;
    u32x2 sk0, sk1, sk2; u32x4 sv0;
#define MLA_LOADK(j) do { const unsigned char* kp_ = kg + (size_t)(j) * (64 * 3072); sk0 = *(const GAS u32x2*)(kp_); sk1 = *(const GAS u32x2*)(kp_ + 64); sk2 = *(const GAS u32x2*)(kp_ + 128); } while (0)
#define MLA_LOADV(j) do { sv0 = *(const GAS u32x4*)(vg + (size_t)(j) * 64); } while (0)
#define MLA_STOREK(b) do { LAS unsigned char* kd_ = kst + (b) * MLA_KBX; *(LAS u32x2*)(kd_) = sk0; *(LAS u32x2*)(kd_ + 64) = sk1; *(LAS u32x2*)(kd_ + 128) = sk2; } while (0)
#define MLA_STOREV(b) do { LAS unsigned char* vd_ = vst + (b) * VBX; *(LAS u32x2*)(vd_) = (u32x2){sv0.x, sv0.y}; *(LAS u32x2*)(vd_ + 8) = (u32x2){sv0.z, sv0.w}; } while (0)
    float m = -1e30f, l = 0.f; f32x16 o[4];
#pragma unroll
    for (int d = 0; d < 4; ++d)
#pragma unroll
        for (int r = 0; r < 16; ++r) o[d][r] = 0.f;
    f32x16 pA0, pA1, pB0, pB1;
    MLA_LOADK(0); MLA_LOADV(0); MLA_STOREK(0); MLA_STOREV(0);
    MLA_LOADK(1);
    __syncthreads();
    qk_tilex(pA0, pA1, kl, q);
    if (63 > qw) mla_maskx(pA0, pA1, tq - 4 * hi);
    MLA_STOREK(1);
    if (2 < NT) MLA_LOADK(2);
    MLA_LOADV(1);
    __syncthreads();
    asm volatile("" : "+v"(q[0]), "+v"(q[1]), "+v"(q[2]));
    float tmx = mla_rowmax(pA0, pA1);
#define SB() __builtin_amdgcn_sched_barrier(0)
#define MLA_SMHEAD() const float mn_ = fmaxf(m, tmx); const float alpha_ = __builtin_amdgcn_exp2f((m - mn_) * QS_MLA); m = mn_; const float mc_ = 8.f - mn_ * QS_MLA; float ps_ = 0.f; i32x8 pb_; \
            if (!__all(alpha_ == 1.f)) { _Pragma("unroll") for (int d_ = 0; d_ < 4; ++d_) _Pragma("unroll") for (int r_ = 0; r_ < 16; ++r_) o[d_][r_] *= alpha_; }
#define MXP_EXPK(P, R0, W0) do { MXP_EXP8(P, R0); \
        int w_ = __builtin_amdgcn_cvt_pk_fp8_f32(P[(R0) + 0], P[(R0) + 1], 0, false); pb_[(W0)] = __builtin_amdgcn_cvt_pk_fp8_f32(P[(R0) + 2], P[(R0) + 3], w_, true); \
        w_ = __builtin_amdgcn_cvt_pk_fp8_f32(P[(R0) + 4], P[(R0) + 5], 0, false); pb_[(W0) + 1] = __builtin_amdgcn_cvt_pk_fp8_f32(P[(R0) + 6], P[(R0) + 7], w_, true); } while (0)
#define MLA_SMTAIL() ps_ = swapsum(ps_); l = l * alpha_ + ps_
#define MFMA_T(acc, a, b) asm volatile("s_nop 1\n\tv_mfma_scale_f32_32x32x64_f8f6f4 %0, %1, %2, %0, %3, %3 op_sel_hi:[0,0,0]" : "+v"(acc) : "v"(a), "v"(b), "v"(sc1_))
#define MFMA_Z(acc, a, b) asm volatile("s_nop 1\n\tv_mfma_scale_f32_32x32x64_f8f6f4 %0, %1, %2, 0, %3, %3 op_sel_hi:[0,0,0]" : "=&v"(acc) : "v"(a), "v"(b), "v"(sc1_))
#define MLA_STEP(PX0, PX1, PY0, PY1, j) do { \
        const int kb1_ = 64 * ((j) + 1); \
        const bool a0_ = (64 * (j) <= qw + 31); \
        const LAS unsigned char* vj_ = vl + ((j) & 1) * VBX; \
        if (a0_) {                  \
            const LAS unsigned char* kn_ = kl + (((j) + 1) & 1) * MLA_KBX; \
            MLA_SMHEAD() \
            SB(); \
            i32x8 a0_f = ldsx(kn_), a1_f = ldsx(kn_ + 64); \
            MXP_EXPK(PX0, 0, 0); MXP_EXPK(PX0, 8, 2); \
            SB(); MFMA_Z(PY0, a0_f, q[0]); SB(); \
            a0_f = ldsx(kn_ + 128); \
            MXP_EXPK(PX1, 0, 4); \
            SB(); MFMA_T(PY0, a1_f, q[1]); SB(); \
            a1_f = ldsx(kn_ + 32 * KSX); \
            MXP_EXPK(PX1, 8, 6); \
            SB(); MFMA_T(PY0, a0_f, q[2]); SB(); \
            a0_f = ldsx(kn_ + 32 * KSX + 64); \
            MLA_SMTAIL(); \
            SB(); MFMA_Z(PY1, a1_f, q[0]); SB(); \
            a1_f = ldsx(vj_); \
            SB(); MFMA_T(PY1, a0_f, q[1]); SB(); \
            a0_f = ldsx(kn_ + 32 * KSX + 128); \
            SB(); MFMA_T(o[0], a1_f, pb_); SB(); \
            a1_f = ldsx(vj_ + 32 * VSX); \
            SB(); MFMA_T(PY1, a0_f, q[2]); SB(); \
            a0_f = ldsx(vj_ + 64 * VSX); \
            SB(); MFMA_T(o[1], a1_f, pb_); SB(); \
            a1_f = ldsx(vj_ + 96 * VSX); \
            SB(); MFMA_T(o[2], a0_f, pb_); SB(); \
            SB(); MFMA_T(o[3], a1_f, pb_); SB(); \
            if (kb1_ + 63 > qw) mla_maskx(PY0, PY1, tq - kb1_ - 4 * hi); \
            tmx = mla_rowmax(PY0, PY1); \
        } \
        if ((j) + 2 < NT) MLA_STOREK((j) & 1); \
        if ((j) + 1 < NT) MLA_STOREV(((j) + 1) & 1); \
        if ((j) + 3 < NT) MLA_LOADK((j) + 3); \
        if ((j) + 2 < NT) MLA_LOADV((j) + 2); \
        __syncthreads(); } while (0)
    int sc1_ = 0x7f7f7f7f; asm volatile("" : "+v"(sc1_));
    for (int j = 0; j < NT; j += 2) {
        MLA_STEP(pA0, pA1, pB0, pB1, j);
        MLA_STEP(pB0, pB1, pA0, pA1, j + 1);
    }
    asm volatile("s_nop 15\n\ts_nop 15" ::: "memory");
#undef MLA_STEP
#undef MLA_SMHEAD
#undef MLA_SMTAIL
#undef MXP_EXPK
#undef MFMA_T
#undef MFMA_Z
#undef SB
#undef MLA_LOADK
#undef MLA_LOADV
#undef MLA_STOREK
#undef MLA_STOREV
    const float inv = 1.f / l;
    const bf16* zp = P.Z + (size_t)tq * 2048 + head * 128 + 4 * hi;
    bf16* op = P.O + (size_t)tq * 4096 + head * 128 + 4 * hi;
#pragma unroll
    for (int d0 = 0; d0 < 4; ++d0)
#pragma unroll
        for (int rg = 0; rg < 4; ++rg) { const int dim = 32 * d0 + 8 * rg;
            const u32x2 z = *(const GAS u32x2*)(zp + dim);
            u32x2 w; w.x = pk2(o[d0][4 * rg + 0] * inv * bflo(z.x), o[d0][4 * rg + 1] * inv * bfhi(z.x)); w.y = pk2(o[d0][4 * rg + 2] * inv * bflo(z.y), o[d0][4 * rg + 3] * inv * bfhi(z.y));
            *(GAS u32x2*)(op + dim) = w; }
}
#undef MXP_EXP8

#elif defined(MLA_MX)
struct MlaPtrs { const bf16* Q; const bf16* K; const bf16* V; const bf16* Z; bf16* O; };
__device__ __forceinline__ void mla_unit(LAS unsigned char* lds, const MlaPtrs& P, int head, int qb, int tid_in, int wave, int lane_in) {
    int tid = tid_in; asm volatile("" : "+v"(tid)); const int lane = tid & 63; (void)lane_in;
    const int r32 = lane & 31, hi = lane >> 5;
    const int q0 = qb * 256, qw = q0 + wave * 32, tq = qw + r32;
    i32x8 q[3];
    { const unsigned char* qp = (const unsigned char*)P.Q + (size_t)tq * 3072 + head * 192 + hi * 32;
#pragma unroll
      for (int s = 0; s < 3; ++s) { const u32x4 a = *(const GAS u32x4*)(qp + 64 * s), b = *(const GAS u32x4*)(qp + 64 * s + 16);
          q[s] = (i32x8){(int)a.x, (int)a.y, (int)a.z, (int)a.w, (int)b.x, (int)b.y, (int)b.z, (int)b.w}; } }
    const int NT = 4 * (qb + 1);
    const int srow = tid >> 3, sc8 = tid & 7;
    const unsigned char* kg = (const unsigned char*)P.K + (size_t)head * 192 + (size_t)srow * 3072 + sc8 * 8;
    const unsigned char* vg = (const unsigned char*)P.V + ((size_t)head * 128 + (tid >> 2)) * S + (tid & 3) * 16;
    LAS unsigned char* kst = lds + srow * KSX + sc8 * 8;
    LAS unsigned char* vst = lds + 2 * MLA_KBX + (tid >> 2) * VSX + (tid & 3) * 16;
    const LAS unsigned char* kl = lds + r32 * KSX + hi * 32;
    const LAS unsigned char* vl = lds + 2 * MLA_KBX + r32 * VSX + hi * 32;
    u32x2 sk0, sk1, sk2; u32x4 sv0;
#define MLA_LOAD(j) do { const unsigned char* kp_ = kg + (size_t)(j) * (64 * 3072); const unsigned char* vp_ = vg + (size_t)(j) * 64; \
        sk0 = *(const GAS u32x2*)(kp_); sk1 = *(const GAS u32x2*)(kp_ + 64); sk2 = *(const GAS u32x2*)(kp_ + 128); sv0 = *(const GAS u32x4*)(vp_); } while (0)
#define MLA_STORE(b, vb) do { LAS unsigned char* kd_ = kst + (b) * MLA_KBX; LAS unsigned char* vd_ = vst + (vb) * VBX; \
        *(LAS u32x2*)(kd_) = sk0; *(LAS u32x2*)(kd_ + 64) = sk1; *(LAS u32x2*)(kd_ + 128) = sk2; *(LAS u32x2*)(vd_) = (u32x2){sv0.x, sv0.y}; *(LAS u32x2*)(vd_ + 8) = (u32x2){sv0.z, sv0.w}; } while (0)
    MLA_LOAD(0); MLA_STORE(0, 0);
    __syncthreads();
    asm volatile("" : "+v"(q[0]), "+v"(q[1]), "+v"(q[2]));
    float m = -1e30f, l = 0.f; f32x16 o[4];
#pragma unroll
    for (int d = 0; d < 4; ++d)
#pragma unroll
        for (int r = 0; r < 16; ++r) o[d][r] = 0.f;
    const bool trail = wave >= 4;
    i32x8 pb = {};
    int vb_cur = 0, vb_prev = 2;
    for (int j = 0; j < NT; ++j) {
        const int kb = 64 * j;
        int vb_next = vb_cur + 1; if (vb_next == 3) vb_next = 0;
        if (j + 1 < NT) MLA_LOAD(j + 1);
        if (trail && j > 0 && kb - 64 <= qw + 31) pv_tilex(o, pb, vl + vb_prev * VBX);
        if (kb <= qw + 31) {
            f32x16 p0, p1;
            qk_tilex(p0, p1, kl + (j & 1) * MLA_KBX, q);
            if (kb + 63 > qw) {
                const int dq = tq - kb - 4 * hi;
#pragma unroll
                for (int r = 0; r < 16; ++r) { const int c = (r & 3) + 8 * (r >> 2);
                    if (c > dq) p0[r] = -__builtin_inff();
                    if (c + 32 > dq) p1[r] = -__builtin_inff(); }
            }
            online_sm_x(p0, p1, m, l, o, QS_MLA);
            pb = packpx(p0, p1);
            if (!trail) pv_tilex(o, pb, vl + vb_cur * VBX);
        }
        if (j + 1 < NT) MLA_STORE((j + 1) & 1, vb_next);
        __syncthreads();
        vb_prev = vb_cur; vb_cur = vb_next;
    }
    if (trail && 64 * (NT - 1) <= qw + 31) pv_tilex(o, pb, vl + vb_prev * VBX);
    __syncthreads();
#undef MLA_LOAD
#undef MLA_STORE
    const float inv = 1.f / l;
    const bf16* zp = P.Z + (size_t)tq * 2048 + head * 128 + 4 * hi;
    bf16* op = P.O + (size_t)tq * 4096 + head * 128 + 4 * hi;
#pragma unroll
    for (int d0 = 0; d0 < 4; ++d0)
#pragma unroll
        for (int rg = 0; rg < 4; ++rg) { const int dim = 32 * d0 + 8 * rg;
            const u32x2 z = *(const GAS u32x2*)(zp + dim);
            u32x2 w; w.x = pk2(o[d0][4 * rg + 0] * inv * bflo(z.x), o[d0][4 * rg + 1] * inv * bfhi(z.x)); w.y = pk2(o[d0][4 * rg + 2] * inv * bflo(z.y), o[d0][4 * rg + 3] * inv * bfhi(z.y));
            *(GAS u32x2*)(op + dim) = w; }
}

#elif defined(MLA_BIG)
struct MlaPtrs { const bf16* Q; const bf16* K; const bf16* V; const bf16* Z; bf16* O; };
__device__ __forceinline__ void mla_unit(LAS unsigned char* lds, const MlaPtrs& P, int head, int qb, int tid_in, int wave, int lane_in) {
    int tid = tid_in; asm volatile("" : "+v"(tid)); const int lane = tid & 63; (void)lane_in;
    const int r32 = lane & 31, hi = lane >> 5;
    const int q0 = qb * 256, qw = q0 + wave * 32, tq = qw + r32;
    i64 q[12];
    { const unsigned char* qp = (const unsigned char*)P.Q + (size_t)tq * 3072 + head * 192 + hi * 8;
#pragma unroll
      for (int d0 = 0; d0 < 12; ++d0) q[d0] = *(const GAS i64*)(qp + d0 * 16); }
    const int NT = 4 * (qb + 1), NTB = NT / 2;
    const int srow = tid >> 3, sc8 = tid & 7;
    const unsigned char* kg = (const unsigned char*)P.K + (size_t)head * 192 + (size_t)srow * 3072 + sc8 * 8;
    const unsigned char* vg = (const unsigned char*)P.V + ((size_t)head * 128 + (tid >> 2)) * S + (tid & 3) * 32;
    LAS unsigned char* kst = lds + srow * KS8 + sc8 * 8;
    LAS unsigned char* vst = lds + 2 * MLA_KB8B + (tid >> 2) * VS8B + (tid & 3) * 32;
    const LAS unsigned char* kl = lds + r32 * KS8 + hi * 8;
    const LAS unsigned char* vl = lds + 2 * MLA_KB8B + r32 * VS8B + hi * 8;
    u32x2 sk0, sk1, sk2, sk3, sk4, sk5; u32x4 sv0, sv1;
#define MLA_LOAD(J) do { const unsigned char* kp_ = kg + (size_t)(J) * (128 * 3072); const unsigned char* vp_ = vg + (size_t)(J) * 128; \
        sk0 = *(const GAS u32x2*)(kp_); sk1 = *(const GAS u32x2*)(kp_ + 64); sk2 = *(const GAS u32x2*)(kp_ + 128); \
        sk3 = *(const GAS u32x2*)(kp_ + 64 * 3072); sk4 = *(const GAS u32x2*)(kp_ + 64 * 3072 + 64); sk5 = *(const GAS u32x2*)(kp_ + 64 * 3072 + 128); \
        sv0 = *(const GAS u32x4*)(vp_); sv1 = *(const GAS u32x4*)(vp_ + 16); } while (0)
#define MLA_STORE(b, vb) do { LAS unsigned char* kd_ = kst + (b) * MLA_KB8B; LAS unsigned char* vd_ = vst + (vb) * VB8B; \
        *(LAS u32x2*)(kd_) = sk0; *(LAS u32x2*)(kd_ + 64) = sk1; *(LAS u32x2*)(kd_ + 128) = sk2; \
        *(LAS u32x2*)(kd_ + 64 * KS8) = sk3; *(LAS u32x2*)(kd_ + 64 * KS8 + 64) = sk4; *(LAS u32x2*)(kd_ + 64 * KS8 + 128) = sk5; \
        *(LAS u32x2*)(vd_) = (u32x2){sv0.x, sv0.y}; *(LAS u32x2*)(vd_ + 8) = (u32x2){sv0.z, sv0.w}; *(LAS u32x2*)(vd_ + 16) = (u32x2){sv1.x, sv1.y}; *(LAS u32x2*)(vd_ + 24) = (u32x2){sv1.z, sv1.w}; } while (0)
    MLA_LOAD(0); MLA_STORE(0, 0);
    __syncthreads();
    float m = -1e30f, l = 0.f; f32x16 o[4];
#pragma unroll
    for (int d = 0; d < 4; ++d)
#pragma unroll
        for (int r = 0; r < 16; ++r) o[d][r] = 0.f;
    const bool trail = wave >= 4;
    i64 pb[4] = {};
    int vb_cur = 0, vb_prev = 2;
    for (int J = 0; J < NTB; ++J) {
        int vb_next = vb_cur + 1; if (vb_next == 3) vb_next = 0;
        if (J + 1 < NTB) MLA_LOAD(J + 1);
#pragma unroll
        for (int sub = 0; sub < 2; ++sub) {
            const int j = 2 * J + sub, kb = 64 * j;
            if (trail && j > 0 && kb - 64 <= qw + 31) pv_tile8(o, pb, vl + (sub == 0 ? vb_prev * VB8B + 64 : vb_cur * VB8B));
            if (kb <= qw + 31) {
                f32x16 p0, p1;
                qk_tile8<12>(p0, p1, kl + (J & 1) * MLA_KB8B + sub * 64 * KS8, q);
                if (kb + 63 > qw) {
                    const int dq = tq - kb - 4 * hi;
#pragma unroll
                    for (int r = 0; r < 16; ++r) { const int c = (r & 3) + 8 * (r >> 2);
                        if (c > dq) p0[r] = -__builtin_inff();
                        if (c + 32 > dq) p1[r] = -__builtin_inff(); }
                }
                online_sm_scaled(p0, p1, m, l, o, QS_MLA);
                pb[0] = packp8<0>(p0); pb[1] = packp8<1>(p0); pb[2] = packp8<0>(p1); pb[3] = packp8<1>(p1);
                if (!trail) pv_tile8(o, pb, vl + vb_cur * VB8B + sub * 64);
            }
        }
        if (J + 1 < NTB) MLA_STORE((J + 1) & 1, vb_next);
        __syncthreads();
        vb_prev = vb_cur; vb_cur = vb_next;
    }
    if (trail && 64 * (NT - 1) <= qw + 31) pv_tile8(o, pb, vl + vb_prev * VB8B + 64);
    __syncthreads();
#undef MLA_LOAD
#undef MLA_STORE
    const float inv = (1.f / 256.f) / l;
    const bf16* zp = P.Z + (size_t)tq * 2048 + head * 128 + 4 * hi;
    bf16* op = P.O + (size_t)tq * 4096 + head * 128 + 4 * hi;
#pragma unroll
    for (int d0 = 0; d0 < 4; ++d0)
#pragma unroll
        for (int rg = 0; rg < 4; ++rg) { const int dim = 32 * d0 + 8 * rg;
            const u32x2 z = *(const GAS u32x2*)(zp + dim);
            u32x2 w; w.x = pk2(o[d0][4 * rg + 0] * inv * bflo(z.x), o[d0][4 * rg + 1] * inv * bfhi(z.x)); w.y = pk2(o[d0][4 * rg + 2] * inv * bflo(z.y), o[d0][4 * rg + 3] * inv * bfhi(z.y));
            *(GAS u32x2*)(op + dim) = w; }
}

#elif defined(MLA_FP8V)
struct MlaPtrs { const bf16* Q; const bf16* K; const bf16* V; const bf16* Z; bf16* O; };
__device__ __forceinline__ void mla_unit(LAS unsigned char* lds, const MlaPtrs& P, int head, int qb, int tid_in, int wave, int lane_in) {
    int tid = tid_in; asm volatile("" : "+v"(tid)); const int lane = tid & 63; (void)lane_in;
    const int r32 = lane & 31, hi = lane >> 5;
    const int q0 = qb * 256, qw = q0 + wave * 32, tq = qw + r32;
    i64 q[12];
    { const unsigned char* qp = (const unsigned char*)P.Q + (size_t)tq * 3072 + head * 192 + hi * 8;
#pragma unroll
      for (int d0 = 0; d0 < 12; ++d0) q[d0] = *(const GAS i64*)(qp + d0 * 16); }
    const int NT = 4 * (qb + 1);
    const int srow = tid >> 3, sc8 = tid & 7;
    const unsigned char* kg = (const unsigned char*)P.K + (size_t)head * 192 + (size_t)srow * 3072 + sc8 * 8;
    const unsigned char* vg = (const unsigned char*)P.V + ((size_t)head * 128 + (tid >> 2)) * S + (tid & 3) * 16;
    LAS unsigned char* kst = lds + srow * KS8 + sc8 * 8;
    LAS unsigned char* vst = lds + 2 * MLA_KB8 + (tid >> 2) * VS8 + (tid & 3) * 16;
    const LAS unsigned char* kl = lds + r32 * KS8 + hi * 8;
    const LAS unsigned char* vl = lds + 2 * MLA_KB8 + r32 * VS8 + hi * 8;
    u32x2 sk0, sk1, sk2; u32x4 sv0;
#define MLA_LOAD(j) do { const unsigned char* kp_ = kg + (size_t)(j) * (64 * 3072); const unsigned char* vp_ = vg + (size_t)(j) * 64; \
        sk0 = *(const GAS u32x2*)(kp_); sk1 = *(const GAS u32x2*)(kp_ + 64); sk2 = *(const GAS u32x2*)(kp_ + 128); sv0 = *(const GAS u32x4*)(vp_); } while (0)
#define MLA_STORE(b, vb) do { LAS unsigned char* kd_ = kst + (b) * MLA_KB8; LAS unsigned char* vd_ = vst + (vb) * VB8; \
        *(LAS u32x2*)(kd_) = sk0; *(LAS u32x2*)(kd_ + 64) = sk1; *(LAS u32x2*)(kd_ + 128) = sk2; *(LAS u32x2*)(vd_) = (u32x2){sv0.x, sv0.y}; *(LAS u32x2*)(vd_ + 8) = (u32x2){sv0.z, sv0.w}; } while (0)
    MLA_LOAD(0); MLA_STORE(0, 0);
    __syncthreads();
    float m = -1e30f, l = 0.f; f32x16 o[4];
#pragma unroll
    for (int d = 0; d < 4; ++d)
#pragma unroll
        for (int r = 0; r < 16; ++r) o[d][r] = 0.f;
    const bool trail = wave >= 4;
    i64 pb[4] = {};
    int vb_cur = 0, vb_prev = 2;
    for (int j = 0; j < NT; ++j) {
        const int kb = 64 * j;
        int vb_next = vb_cur + 1; if (vb_next == 3) vb_next = 0;
        if (j + 1 < NT) MLA_LOAD(j + 1);
        if (trail && j > 0 && kb - 64 <= qw + 31) pv_tile8(o, pb, vl + vb_prev * VB8);
        if (kb <= qw + 31) {
            f32x16 p0, p1;
#ifdef PROBE_QKM2
            { f32x16 r0, r1; qk_tile_m2<12, KS_M>(p0, p1, r0, r1, kl + (j & 1) * MLA_KB, q);
#pragma unroll
              for (int r = 0; r < 16; ++r) { p0[r] = (p0[r] + r0[r]) * 0.5f; p1[r] = (p1[r] + r1[r]) * 0.5f; } }
#else
            qk_tile8<12>(p0, p1, kl + (j & 1) * MLA_KB8, q);
#endif
#ifdef PROBE_QK2
            { f32x16 r0, r1; asm volatile("" ::: "memory"); qk_tile<12, KS_M>(r0, r1, kl + (j & 1) * MLA_KB, q);
#pragma unroll
              for (int r = 0; r < 16; ++r) { p0[r] = (p0[r] + r0[r]) * 0.5f; p1[r] = (p1[r] + r1[r]) * 0.5f; } }
#endif
#ifdef PROBE_SM2
            { float acc_ = 0.f;
#pragma unroll
              for (int r = 0; r < 16; ++r) { acc_ += __builtin_amdgcn_exp2f(p0[r] - m - 40.f) + __builtin_amdgcn_exp2f(p1[r] - m - 40.f); }
#pragma unroll
              for (int r = 0; r < 16; ++r) { acc_ += __builtin_amdgcn_exp2f(p0[r] - m - 50.f) + __builtin_amdgcn_exp2f(p1[r] - m - 50.f); }
              if (acc_ == 12345.678f) l += 1.f; }
#endif
            if (kb + 63 > qw) {
                const int dq = tq - kb - 4 * hi;
#pragma unroll
                for (int r = 0; r < 16; ++r) { const int c = (r & 3) + 8 * (r >> 2);
                    if (c > dq) p0[r] = -__builtin_inff();
                    if (c + 32 > dq) p1[r] = -__builtin_inff(); }
            }
            online_sm_scaled(p0, p1, m, l, o, QS_MLA);
            pb[0] = packp8<0>(p0); pb[1] = packp8<1>(p0); pb[2] = packp8<0>(p1); pb[3] = packp8<1>(p1);
            if (!trail) pv_tile8(o, pb, vl + vb_cur * VB8);
        }
        if (j + 1 < NT) MLA_STORE((j + 1) & 1, vb_next);
        __syncthreads();
        vb_prev = vb_cur; vb_cur = vb_next;
    }
    if (trail && 64 * (NT - 1) <= qw + 31) pv_tile8(o, pb, vl + vb_prev * VB8);
    __syncthreads();
#undef MLA_LOAD
#undef MLA_STORE
    const float inv = (1.f / 256.f) / l;
    const bf16* zp = P.Z + (size_t)tq * 2048 + head * 128 + 4 * hi;
    bf16* op = P.O + (size_t)tq * 4096 + head * 128 + 4 * hi;
#pragma unroll
    for (int d0 = 0; d0 < 4; ++d0)
#pragma unroll
        for (int rg = 0; rg < 4; ++rg) { const int dim = 32 * d0 + 8 * rg;
            const u32x2 z = *(const GAS u32x2*)(zp + dim);
            u32x2 w; w.x = pk2(o[d0][4 * rg + 0] * inv * bflo(z.x), o[d0][4 * rg + 1] * inv * bfhi(z.x)); w.y = pk2(o[d0][4 * rg + 2] * inv * bflo(z.y), o[d0][4 * rg + 3] * inv * bfhi(z.y));
            *(GAS u32x2*)(op + dim) = w; }
}

#elif defined(MLA_FP8)
struct MlaPtrs { const bf16* Q; const bf16* K; const bf16* V; const bf16* Z; bf16* O; };
__device__ __forceinline__ void mla_unit(LAS unsigned char* lds, const MlaPtrs& P, int head, int qb, int tid_in, int wave, int lane_in) {
    int tid = tid_in; asm volatile("" : "+v"(tid)); const int lane = tid & 63; (void)lane_in;
    const int r32 = lane & 31, hi = lane >> 5;
    const int q0 = qb * 256, qw = q0 + wave * 32, tq = qw + r32;
    i64 q[12];
    { const unsigned char* qp = (const unsigned char*)P.Q + (size_t)tq * 3072 + head * 192 + hi * 8;
#pragma unroll
      for (int d0 = 0; d0 < 12; ++d0) q[d0] = *(const GAS i64*)(qp + d0 * 16); }
    const int NT = 4 * (qb + 1);
    const int srow = tid >> 3, sc8 = tid & 7;
    const unsigned char* kg = (const unsigned char*)P.K + (size_t)head * 192 + (size_t)srow * 3072 + sc8 * 8;
    const unsigned char* vg = (const unsigned char*)P.V + (size_t)head * 256 + (size_t)srow * 4096 + sc8 * 16;
    LAS unsigned char* kst = lds + srow * KS8 + sc8 * 8;
    LAS unsigned char* vst = lds + 2 * MLA_KB8 + srow * VS + sc8 * 16;
    const LAS unsigned char* kl = lds + r32 * KS8 + hi * 8;
    const LAS unsigned char* vl = lds + 2 * MLA_KB8 + (4 * hi + ((lane & 15) >> 2)) * VS + (16 * ((lane >> 4) & 1) + 4 * (lane & 3)) * 2;
    u32x2 sk0, sk1, sk2; u32x4 sv0, sv1;
#define MLA_LOAD(j) do { const unsigned char* kp_ = kg + (size_t)(j) * (64 * 3072); const unsigned char* vp_ = vg + (size_t)(j) * (64 * 4096); \
        sk0 = *(const GAS u32x2*)(kp_); sk1 = *(const GAS u32x2*)(kp_ + 64); sk2 = *(const GAS u32x2*)(kp_ + 128); sv0 = *(const GAS u32x4*)(vp_); sv1 = *(const GAS u32x4*)(vp_ + 128); } while (0)
#define MLA_STORE(b, vb) do { LAS unsigned char* kd_ = kst + (b) * MLA_KB8; LAS unsigned char* vd_ = vst + (vb) * VB; \
        *(LAS u32x2*)(kd_) = sk0; *(LAS u32x2*)(kd_ + 64) = sk1; *(LAS u32x2*)(kd_ + 128) = sk2; *(LAS u32x4*)(vd_) = sv0; *(LAS u32x4*)(vd_ + 128) = sv1; } while (0)
    MLA_LOAD(0); MLA_STORE(0, 0);
    __syncthreads();
    float m = -1e30f, l = 0.f; f32x16 o[4];
#pragma unroll
    for (int d = 0; d < 4; ++d)
#pragma unroll
        for (int r = 0; r < 16; ++r) o[d][r] = 0.f;
    const bool trail = wave >= 4;
    bf16x8 pb[4] = {};
    int vb_cur = 0, vb_prev = 2;
    for (int j = 0; j < NT; ++j) {
        const int kb = 64 * j;
        int vb_next = vb_cur + 1; if (vb_next == 3) vb_next = 0;
        if (j + 1 < NT) MLA_LOAD(j + 1);
        if (trail && j > 0 && kb - 64 <= qw + 31) pv_tile(o, pb, vl + vb_prev * VB);
        if (kb <= qw + 31) {
            f32x16 p0, p1;
#ifdef PROBE_QKM2
            { f32x16 r0, r1; qk_tile_m2<12, KS_M>(p0, p1, r0, r1, kl + (j & 1) * MLA_KB, q);
#pragma unroll
              for (int r = 0; r < 16; ++r) { p0[r] = (p0[r] + r0[r]) * 0.5f; p1[r] = (p1[r] + r1[r]) * 0.5f; } }
#else
            qk_tile8<12>(p0, p1, kl + (j & 1) * MLA_KB8, q);
#endif
#ifdef PROBE_QK2
            { f32x16 r0, r1; asm volatile("" ::: "memory"); qk_tile<12, KS_M>(r0, r1, kl + (j & 1) * MLA_KB, q);
#pragma unroll
              for (int r = 0; r < 16; ++r) { p0[r] = (p0[r] + r0[r]) * 0.5f; p1[r] = (p1[r] + r1[r]) * 0.5f; } }
#endif
#ifdef PROBE_SM2
            { float acc_ = 0.f;
#pragma unroll
              for (int r = 0; r < 16; ++r) { acc_ += __builtin_amdgcn_exp2f(p0[r] - m - 40.f) + __builtin_amdgcn_exp2f(p1[r] - m - 40.f); }
#pragma unroll
              for (int r = 0; r < 16; ++r) { acc_ += __builtin_amdgcn_exp2f(p0[r] - m - 50.f) + __builtin_amdgcn_exp2f(p1[r] - m - 50.f); }
              if (acc_ == 12345.678f) l += 1.f; }
#endif
            if (kb + 63 > qw) {
                const int dq = tq - kb - 4 * hi;
#pragma unroll
                for (int r = 0; r < 16; ++r) { const int c = (r & 3) + 8 * (r >> 2);
                    if (c > dq) p0[r] = -__builtin_inff();
                    if (c + 32 > dq) p1[r] = -__builtin_inff(); }
            }
            online_sm_scaled(p0, p1, m, l, o, QS_MLA);
            pb[0] = packp<0>(p0); pb[1] = packp<1>(p0); pb[2] = packp<0>(p1); pb[3] = packp<1>(p1);
            if (!trail) pv_tile(o, pb, vl + vb_cur * VB);
        }
        if (j + 1 < NT) MLA_STORE((j + 1) & 1, vb_next);
        __syncthreads();
        vb_prev = vb_cur; vb_cur = vb_next;
    }
    if (trail && 64 * (NT - 1) <= qw + 31) pv_tile(o, pb, vl + vb_prev * VB);
    __syncthreads();
#undef MLA_LOAD
#undef MLA_STORE
    const float inv = 1.f / l;
    const bf16* zp = P.Z + (size_t)tq * 2048 + head * 128 + 4 * hi;
    bf16* op = P.O + (size_t)tq * 4096 + head * 128 + 4 * hi;
#pragma unroll
    for (int d0 = 0; d0 < 4; ++d0)
#pragma unroll
        for (int rg = 0; rg < 4; ++rg) { const int dim = 32 * d0 + 8 * rg;
            const u32x2 z = *(const GAS u32x2*)(zp + dim);
            u32x2 w; w.x = pk2(o[d0][4 * rg + 0] * inv * bflo(z.x), o[d0][4 * rg + 1] * inv * bfhi(z.x)); w.y = pk2(o[d0][4 * rg + 2] * inv * bflo(z.y), o[d0][4 * rg + 3] * inv * bfhi(z.y));
            *(GAS u32x2*)(op + dim) = w; }
}

#else
struct MlaPtrs { const bf16* Q; const bf16* K; const bf16* V; const bf16* Z; bf16* O; };
__device__ __forceinline__ void mla_unit(LAS unsigned char* lds, const MlaPtrs& P, int head, int qb, int tid_in, int wave, int lane_in) {
    int tid = tid_in; asm volatile("" : "+v"(tid)); const int lane = tid & 63; (void)lane_in;
    const int r32 = lane & 31, hi = lane >> 5;
    const int q0 = qb * 256, qw = q0 + wave * 32, tq = qw + r32;
    bf16x8 q[12];
    { const bf16* qp = P.Q + (size_t)tq * 3072 + head * 192 + hi * 8;
#pragma unroll
      for (int d0 = 0; d0 < 12; ++d0) q[d0] = *(const GAS bf16x8*)(qp + d0 * 16); }
    const int NT = 4 * (qb + 1);
    const int srow = tid >> 3, sc8 = tid & 7;
    const unsigned char* kg = (const unsigned char*)P.K + (size_t)head * 384 + (size_t)srow * 6144 + sc8 * 16;
    const unsigned char* vg = (const unsigned char*)P.V + (size_t)head * 256 + (size_t)srow * 4096 + sc8 * 16;
    LAS unsigned char* kst = lds + srow * KS_M + sc8 * 16;
    LAS unsigned char* vst = lds + 2 * MLA_KB + srow * VS + sc8 * 16;
    const LAS unsigned char* kl = lds + r32 * KS_M + hi * 16;
    const LAS unsigned char* vl = lds + 2 * MLA_KB + (4 * hi + ((lane & 15) >> 2)) * VS + (16 * ((lane >> 4) & 1) + 4 * (lane & 3)) * 2;
    u32x4 sk0, sk1, sk2, sv0, sv1;
#define MLA_LOAD(j) do { const unsigned char* kp_ = kg + (size_t)(j) * (64 * 6144); const unsigned char* vp_ = vg + (size_t)(j) * (64 * 4096); \
        sk0 = *(const GAS u32x4*)(kp_); sk1 = *(const GAS u32x4*)(kp_ + 128); sk2 = *(const GAS u32x4*)(kp_ + 256); sv0 = *(const GAS u32x4*)(vp_); sv1 = *(const GAS u32x4*)(vp_ + 128); } while (0)
#define MLA_STORE(b, vb) do { LAS unsigned char* kd_ = kst + (b) * MLA_KB; LAS unsigned char* vd_ = vst + (vb) * VB; \
        *(LAS u32x4*)(kd_) = sk0; *(LAS u32x4*)(kd_ + 128) = sk1; *(LAS u32x4*)(kd_ + 256) = sk2; *(LAS u32x4*)(vd_) = sv0; *(LAS u32x4*)(vd_ + 128) = sv1; } while (0)
    MLA_LOAD(0); MLA_STORE(0, 0);
    __syncthreads();
    float m = -1e30f, l = 0.f; f32x16 o[4];
#pragma unroll
    for (int d = 0; d < 4; ++d)
#pragma unroll
        for (int r = 0; r < 16; ++r) o[d][r] = 0.f;
    const bool trail = wave >= 4;
    bf16x8 pb[4] = {};
    int vb_cur = 0, vb_prev = 2;
    for (int j = 0; j < NT; ++j) {
        const int kb = 64 * j;
        int vb_next = vb_cur + 1; if (vb_next == 3) vb_next = 0;
        if (j + 1 < NT) MLA_LOAD(j + 1);
        if (trail && j > 0 && kb - 64 <= qw + 31) pv_tile(o, pb, vl + vb_prev * VB);
        if (kb <= qw + 31) {
            f32x16 p0, p1;
#ifdef PROBE_QKM2
            { f32x16 r0, r1; qk_tile_m2<12, KS_M>(p0, p1, r0, r1, kl + (j & 1) * MLA_KB, q);
#pragma unroll
              for (int r = 0; r < 16; ++r) { p0[r] = (p0[r] + r0[r]) * 0.5f; p1[r] = (p1[r] + r1[r]) * 0.5f; } }
#else
            qk_tile<12, KS_M>(p0, p1, kl + (j & 1) * MLA_KB, q);
#endif
#ifdef PROBE_QK2
            { f32x16 r0, r1; asm volatile("" ::: "memory"); qk_tile<12, KS_M>(r0, r1, kl + (j & 1) * MLA_KB, q);
#pragma unroll
              for (int r = 0; r < 16; ++r) { p0[r] = (p0[r] + r0[r]) * 0.5f; p1[r] = (p1[r] + r1[r]) * 0.5f; } }
#endif
#ifdef PROBE_SM2
            { float acc_ = 0.f;
#pragma unroll
              for (int r = 0; r < 16; ++r) { acc_ += __builtin_amdgcn_exp2f(p0[r] - m - 40.f) + __builtin_amdgcn_exp2f(p1[r] - m - 40.f); }
#pragma unroll
              for (int r = 0; r < 16; ++r) { acc_ += __builtin_amdgcn_exp2f(p0[r] - m - 50.f) + __builtin_amdgcn_exp2f(p1[r] - m - 50.f); }
              if (acc_ == 12345.678f) l += 1.f; }
#endif
            if (kb + 63 > qw) {
                const int dq = tq - kb - 4 * hi;
#pragma unroll
                for (int r = 0; r < 16; ++r) { const int c = (r & 3) + 8 * (r >> 2);
                    if (c > dq) p0[r] = -__builtin_inff();
                    if (c + 32 > dq) p1[r] = -__builtin_inff(); }
            }
            online_sm(p0, p1, m, l, o);
            pb[0] = packp<0>(p0); pb[1] = packp<1>(p0); pb[2] = packp<0>(p1); pb[3] = packp<1>(p1);
            if (!trail) pv_tile(o, pb, vl + vb_cur * VB);
        }
        if (j + 1 < NT) MLA_STORE((j + 1) & 1, vb_next);
        __syncthreads();
        vb_prev = vb_cur; vb_cur = vb_next;
    }
    if (trail && 64 * (NT - 1) <= qw + 31) pv_tile(o, pb, vl + vb_prev * VB);
    __syncthreads();
#undef MLA_LOAD
#undef MLA_STORE
    const float inv = 1.f / l;
    const bf16* zp = P.Z + (size_t)tq * 2048 + head * 128 + 4 * hi;
    bf16* op = P.O + (size_t)tq * 4096 + head * 128 + 4 * hi;
#pragma unroll
    for (int d0 = 0; d0 < 4; ++d0)
#pragma unroll
        for (int rg = 0; rg < 4; ++rg) { const int dim = 32 * d0 + 8 * rg;
            const u32x2 z = *(const GAS u32x2*)(zp + dim);
            u32x2 w; w.x = pk2(o[d0][4 * rg + 0] * inv * bflo(z.x), o[d0][4 * rg + 1] * inv * bfhi(z.x)); w.y = pk2(o[d0][4 * rg + 2] * inv * bflo(z.y), o[d0][4 * rg + 3] * inv * bfhi(z.y));
            *(GAS u32x2*)(op + dim) = w; }
}

#endif
#endif
struct NsaPtrs { const bf16* Q; const bf16* KV; const bf16* KC; const bf16* VC; const bf16* Z; const float* G; bf16* O; float* scr; };
template <int MODE>
__device__ __forceinline__ void nsa_loop(LAS unsigned char* lds, const unsigned char* kbase, const unsigned char* vbase, int ntiles, int jlo,
                                         const bf16x8 (&q)[8], int t, float slope2, float& m, float& l, f32x16 (&o)[4], float invl, int tid, int wave, int lane) {
    constexpr bool HASV = MODE != 0;
    const int r32 = lane & 31, hi = lane >> 5;
    const int srow = tid >> 3, sc8 = tid & 7;
    const unsigned soff = srow * 256 + sc8 * 16;
    LAS unsigned char* kst = lds + srow * KS_N + sc8 * 16;
    LAS unsigned char* vst = lds + 2 * NSA_KB + srow * VS + sc8 * 16;
    const LAS unsigned char* kl = lds + r32 * KS_N + hi * 16;
    const LAS unsigned char* vl = lds + 2 * NSA_KB + (4 * hi + ((lane & 15) >> 2)) * VS + (16 * ((lane >> 4) & 1) + 4 * (lane & 3)) * 2;
    const LAS int* ulist = (const LAS int*)(lds + N_ULIST);
    const LAS unsigned* selm = (const LAS unsigned*)(lds + N_SELM);
    LAS float* partA = (LAS float*)(lds + N_PART); LAS float* partB = (LAS float*)(lds + N_PART + N_PARTB);
    LAS float* imp = (LAS float*)(lds + N_IMP); LAS float* carry = (LAS float*)(lds + N_CARRY);
    if (ntiles <= 0) return;
    u32x4 sk0, sk1, sv0, sv1;
#define NSA_TROW(j) (MODE == 2 ? 64 * __builtin_amdgcn_readfirstlane(ulist[(j)]) : 64 * (jlo + (j)))
#define NSA_LOAD(j) do { const size_t ro_ = (size_t)NSA_TROW(j) * 256 + soff; \
        sk0 = *(const GAS u32x4*)(kbase + ro_); sk1 = *(const GAS u32x4*)(kbase + ro_ + 128); \
        if (HASV) { sv0 = *(const GAS u32x4*)(vbase + ro_); sv1 = *(const GAS u32x4*)(vbase + ro_ + 128); } } while (0)
#define NSA_STORE(b) do { LAS unsigned char* kd_ = kst + (b) * NSA_KB; *(LAS u32x4*)(kd_) = sk0; *(LAS u32x4*)(kd_ + 128) = sk1; \
        if (HASV) { LAS unsigned char* vd_ = vst + (b) * VB; *(LAS u32x4*)(vd_) = sv0; *(LAS u32x4*)(vd_ + 128) = sv1; } } while (0)
    NSA_LOAD(0); NSA_STORE(0);
    __syncthreads();
    for (int j = 0; j < ntiles; ++j) {
        const int buf = j & 1;
        if (MODE != 1 && j + 1 < ntiles) NSA_LOAD(j + 1);
        const int trow = NSA_TROW(j);
        constexpr int PSTEP = (MODE <= 1) ? 16 : 1;
        const int pstart = (MODE <= 1) ? 16 * trow + 31 : trow;
        const int db = t - pstart - PSTEP * 4 * hi;
        constexpr unsigned W = (MODE == 3) ? 512u : 0x7fffffffu;
        float b0 = -slope2 * (float)db;
        if (MODE == 2) { const int b = trow >> 6; if (((selm[r32 * 8 + (b >> 5)] >> (b & 31)) & 1u) == 0u) b0 = -__builtin_inff(); }
        f32x16 p0, p1;
#pragma unroll
        for (int r = 0; r < 16; ++r) { const int c = PSTEP * ((r & 3) + 8 * (r >> 2));
            p0[r] = __builtin_fmaf(slope2, (float)c, b0); p1[r] = __builtin_fmaf(slope2, (float)(c + 32 * PSTEP), b0); }
        qk_tile<8, KS_N, false>(p0, p1, kl + buf * NSA_KB, q);
        { const int t0u = __builtin_amdgcn_readfirstlane(t - r32);
          const bool interior = (t0u - (pstart + PSTEP * 63) >= 0) && ((unsigned)(t0u + 31 - pstart) < W);
          if (!interior) {
#pragma unroll
              for (int r = 0; r < 16; ++r) { const int c = PSTEP * ((r & 3) + 8 * (r >> 2));
                  if ((unsigned)(db - c) >= W) p0[r] = -__builtin_inff();
                  if ((unsigned)(db - c - 32 * PSTEP) >= W) p1[r] = -__builtin_inff(); } } }
        if (MODE == 0) {
            float tm = p0[0];
#pragma unroll
            for (int r = 1; r < 16; ++r) tm = fmaxf(tm, p0[r]);
#pragma unroll
            for (int r = 0; r < 16; ++r) tm = fmaxf(tm, p1[r]);
            tm = swapmax(tm);
            const float mn = fmaxf(m, tm); const float alpha = __builtin_amdgcn_exp2f(m - mn); m = mn;
            float ps = 0.f;
#pragma unroll
            for (int r = 0; r < 16; ++r) ps += __builtin_amdgcn_exp2f(p0[r] - mn) + __builtin_amdgcn_exp2f(p1[r] - mn);
            l = l * alpha + swapsum(ps);
        } else if (MODE == 1) {
#pragma unroll
            for (int r = 0; r < 16; ++r) { p0[r] = __builtin_amdgcn_exp2f(p0[r] - m) * invl; p1[r] = __builtin_amdgcn_exp2f(p1[r] - m) * invl; }
            LAS float* pa = partA + (wave * 32 + r32) * 17 + hi; LAS float* pbm = partB + (wave * 32 + r32) * 17 + hi;
#pragma unroll
            for (int rg = 0; rg < 4; ++rg) {
                pa[2 * rg] = (p0[4 * rg] + p0[4 * rg + 1]) + (p0[4 * rg + 2] + p0[4 * rg + 3]); pbm[2 * rg] = p0[4 * rg + 3];
                pa[8 + 2 * rg] = (p1[4 * rg] + p1[4 * rg + 1]) + (p1[4 * rg + 2] + p1[4 * rg + 3]); pbm[8 + 2 * rg] = p1[4 * rg + 3]; }
            const bf16x8 pb[4] = {packp<0>(p0), packp<1>(p0), packp<0>(p1), packp<1>(p1)};
            pv_tile(o, pb, vl + buf * VB);
            __syncthreads();
            { const int qq = tid >> 4, jl = tid & 15; float a = 0.f, bp = 0.f, bl = 0.f;
#pragma unroll
              for (int w = 0; w < 8; ++w) { a += partA[(w * 32 + qq) * 17 + jl]; bl += partB[(w * 32 + qq) * 17 + jl]; }
              if (jl > 0) {
#pragma unroll
                  for (int w = 0; w < 8; ++w) bp += partB[(w * 32 + qq) * 17 + jl - 1];
              } else bp = (j > 0) ? carry[((j - 1) & 1) * 32 + qq] : 0.f;
              imp[qq * 256 + 16 * j + jl] = a + bp;
              if (jl == 15) carry[(j & 1) * 32 + qq] = bl; }
        } else {
            online_sm(p0, p1, m, l, o);
            const bf16x8 pb[4] = {packp<0>(p0), packp<1>(p0), packp<0>(p1), packp<1>(p1)};
            pv_tile(o, pb, vl + buf * VB);
        }
        if (MODE == 1 && j + 1 < ntiles) NSA_LOAD(j + 1);
        if (j + 1 < ntiles) NSA_STORE(buf ^ 1);
        __syncthreads();
    }
#undef NSA_TROW
#undef NSA_LOAD
#undef NSA_STORE
}
__device__ __forceinline__ void nsa_topk(const LAS float* improw, LAS unsigned* selrow, int cur, int lane) {
    unsigned key[4]; bool sel[4];
    int nforced = 0;
#pragma unroll
    for (int k = 0; k < 4; ++k) { const int j = lane + 64 * k;
        const bool forced = (j == 0) || (j == cur) || (j == cur - 1);
        const bool causal = j <= cur;
        sel[k] = forced;
#ifdef IMPNOISE_BUILD
        { unsigned h = (unsigned)j * 2654435761u + (unsigned)(size_t)improw * 40503u; h ^= h >> 15; h *= 0x846ca68bu; h ^= h >> 16;
          const float r = (float)(int)(h & 0xffffu) * (1.f / 32768.f) - 1.f; const float v = improw[j] * (1.f + IMPNOISE_EPS * r);
          key[k] = (causal && !forced) ? (__float_as_uint(v) + 1u) : 0u; }
#else
        key[k] = (causal && !forced) ? (__float_as_uint(improw[j]) + 1u) : 0u;
#endif
    }
    nforced = 1 + (cur >= 1 ? 1 : 0) + (cur >= 2 ? 1 : 0);
    const int want = 16 - nforced;
    for (int it = 0; it < want; ++it) {
        unsigned bk = key[0]; int bj = lane;
#pragma unroll
        for (int k = 1; k < 4; ++k) { if (key[k] > bk) { bk = key[k]; bj = lane + 64 * k; } }
        unsigned long long best = ((unsigned long long)bk << 32) | (unsigned)(0xffffffffu - (unsigned)bj);
#pragma unroll
        for (int off = 1; off < 64; off <<= 1) {
            const unsigned lo = __shfl_xor((unsigned)best, off), hiw = __shfl_xor((unsigned)(best >> 32), off);
            const unsigned long long other = ((unsigned long long)hiw << 32) | lo;
            best = other > best ? other : best; }
        if ((unsigned)(best >> 32) == 0u) break;
        const int wj = (int)(0xffffffffu - (unsigned)best);
#pragma unroll
        for (int k = 0; k < 4; ++k) if (wj == lane + 64 * k) { key[k] = 0u; sel[k] = true; }
    }
#pragma unroll
    for (int k = 0; k < 4; ++k) { const unsigned long long bm = __ballot(sel[k]);
        if (lane == 0) { selrow[2 * k] = (unsigned)bm; selrow[2 * k + 1] = (unsigned)(bm >> 32); } }
}
__device__ __forceinline__ void nsa_topk4(const LAS float* imp0, LAS unsigned* sel0, int cur, int lane) {
    unsigned key[4][4]; bool forced[4];
#pragma unroll
    for (int k = 0; k < 4; ++k) { const int j = lane + 64 * k;
        forced[k] = (j == 0) || (j == cur) || (j == cur - 1);
        const bool cand = (j <= cur) && !forced[k];
#pragma unroll
        for (int i = 0; i < 4; ++i) key[i][k] = cand ? (__float_as_uint(imp0[i * 256 + j]) + 1u) : 0u; }
    const int want = 16 - (1 + (cur >= 1 ? 1 : 0) + (cur >= 2 ? 1 : 0));
    unsigned T[4] = {0u, 0u, 0u, 0u};
    for (int bit = 30; bit >= 0; --bit) {
#pragma unroll
        for (int i = 0; i < 4; ++i) { const unsigned c = T[i] | (1u << bit);
            const int n = __builtin_popcountll(__ballot(key[i][0] >= c)) + __builtin_popcountll(__ballot(key[i][1] >= c)) + __builtin_popcountll(__ballot(key[i][2] >= c)) + __builtin_popcountll(__ballot(key[i][3] >= c));
            if (n >= want) T[i] = c; }
    }
#pragma unroll
    for (int i = 0; i < 4; ++i) {
        const unsigned Ti = T[i];
        int rem = want;
        if (Ti != 0u) rem -= __builtin_popcountll(__ballot(key[i][0] > Ti)) + __builtin_popcountll(__ballot(key[i][1] > Ti)) + __builtin_popcountll(__ballot(key[i][2] > Ti)) + __builtin_popcountll(__ballot(key[i][3] > Ti));
#pragma unroll
        for (int k = 0; k < 4; ++k) {
            bool s = forced[k];
            if (Ti == 0u) s = s || key[i][k] >= 1u;
            else {
                const bool eq = key[i][k] == Ti; const unsigned long long em = __ballot(eq);
                const int below = (int)__builtin_amdgcn_mbcnt_hi((unsigned)(em >> 32), __builtin_amdgcn_mbcnt_lo((unsigned)em, 0u));
                s = s || key[i][k] > Ti || (eq && below < rem);
                rem -= __builtin_popcountll(em); if (rem < 0) rem = 0;
            }
            const unsigned long long bm = __ballot(s);
            if (lane == 0) { sel0[i * 8 + 2 * k] = (unsigned)bm; sel0[i * 8 + 2 * k + 1] = (unsigned)(bm >> 32); }
        }
    }
}
__device__ __forceinline__ int nsa_opaque(int v) { asm volatile("" : "+v"(v)); return v; }
__device__ __forceinline__ void nsa_unit(LAS unsigned char* lds, const NsaPtrs& P, int g, int qblk, int tid_in, int wave, int lane_in, int cu) {
    int tid = tid_in; asm volatile("" : "+v"(tid));
    const int lane = tid & 63; (void)lane_in;
    const int r32 = lane & 31, hi = lane >> 5;
    const int hh = 8 * g + wave, t0 = 32 * qblk, t = t0 + r32;
    const float slope2 = __builtin_amdgcn_exp2f(-0.5f * (float)(hh + 1)) * LOG2E;
    bf16x8 q[8];
    { const bf16* qp = P.Q + (size_t)t * 2048 + hh * 128 + hi * 8;
#pragma unroll
      for (int d0 = 0; d0 < 8; ++d0) q[d0] = *(const GAS bf16x8*)(qp + d0 * 16); }
#define NSA_SCR() ((GAS f32x4*)(P.scr + ((size_t)(cu * 8 + wave) * 16) * 256) + nsa_opaque(lane))
    const size_t CH = (size_t)S * 128 * 2;
    f32x16 o[4]; float m, l;
#define NSA_ZERO_O() do { _Pragma("unroll") for (int d_ = 0; d_ < 4; ++d_) _Pragma("unroll") for (int r_ = 0; r_ < 16; ++r_) o[d_][r_] = 0.f; } while (0)
    const int ncv = 2 * qblk + 1, ntc = (ncv + 63) >> 6;
    const unsigned char* kc = (const unsigned char*)P.KC + (size_t)g * 1024 * 256; const unsigned char* vc = (const unsigned char*)P.VC + (size_t)g * 1024 * 256;
    m = -1e30f; l = 0.f; NSA_ZERO_O();
    nsa_loop<0>(lds, kc, vc, ntc, 0, q, t, slope2, m, l, o, 0.f, tid, wave, lane);
    const float invl = l > 0.f ? 1.f / l : 0.f;
    nsa_loop<1>(lds, kc, vc, ntc, 0, q, t, slope2, m, l, o, invl, tid, wave, lane);
    { const float g_c = P.G[(size_t)t * 48 + hh]; GAS f32x4* scr = NSA_SCR();
#pragma unroll
    for (int d0 = 0; d0 < 4; ++d0)
#pragma unroll
        for (int rg = 0; rg < 4; ++rg) { f32x4 v = {o[d0][4 * rg] * g_c, o[d0][4 * rg + 1] * g_c, o[d0][4 * rg + 2] * g_c, o[d0][4 * rg + 3] * g_c}; scr[(d0 * 4 + rg) * 64] = v; } }
    const int cur = t0 >> 6;
    LAS unsigned* selm = (LAS unsigned*)(lds + N_SELM);
#ifdef NSA_TOPK_ITER
    for (int i = 0; i < 4; ++i) { const int qq = 4 * wave + i; nsa_topk((const LAS float*)(lds + N_IMP) + qq * 256, selm + qq * 8, cur, lane); }
#else
    nsa_topk4((const LAS float*)(lds + N_IMP) + 4 * wave * 256, selm + 4 * wave * 8, cur, lane);
#endif
    __syncthreads();
    if (wave == 0) {
        LAS int* ulist = (LAS int*)(lds + N_ULIST); int n = 0;
        for (int k = 0; k < 8; ++k) { unsigned u = (lane < 32) ? selm[lane * 8 + k] : 0u;
#pragma unroll
            for (int off = 1; off < 32; off <<= 1) u |= __shfl_xor(u, off);
            u = __builtin_amdgcn_readfirstlane(u);
            while (u) { const int b = __builtin_ctz(u); u &= u - 1u; if (lane == 0) ulist[n] = 32 * k + b; ++n; } }
        if (lane == 0) *(LAS int*)(lds + N_NTS) = n;
    }
    __syncthreads();
    const int nts = __builtin_amdgcn_readfirstlane(*(const LAS int*)(lds + N_NTS));
    m = -1e30f; l = 0.f; NSA_ZERO_O();
    nsa_loop<2>(lds, (const unsigned char*)P.KV + (size_t)(4 + g) * CH, (const unsigned char*)P.KV + (size_t)(6 + g) * CH, nts, 0, q, t, slope2, m, l, o, 0.f, tid, wave, lane);
    { const float f = P.G[(size_t)t * 48 + 16 + hh] / l; GAS f32x4* scr = NSA_SCR();
#pragma unroll
      for (int d0 = 0; d0 < 4; ++d0)
          { f32x4 v[4];
#pragma unroll
            for (int rg = 0; rg < 4; ++rg) v[rg] = scr[(d0 * 4 + rg) * 64];
#pragma unroll
            for (int rg = 0; rg < 4; ++rg) { v[rg][0] += o[d0][4 * rg] * f; v[rg][1] += o[d0][4 * rg + 1] * f; v[rg][2] += o[d0][4 * rg + 2] * f; v[rg][3] += o[d0][4 * rg + 3] * f; scr[(d0 * 4 + rg) * 64] = v[rg]; } } }
    const int jlo = (t0 > 511 ? t0 - 511 : 0) >> 6, jhi = (t0 + 31) >> 6;
    m = -1e30f; l = 0.f; NSA_ZERO_O();
    nsa_loop<3>(lds, (const unsigned char*)P.KV + (size_t)(8 + g) * CH, (const unsigned char*)P.KV + (size_t)(10 + g) * CH, jhi - jlo + 1, jlo, q, t, slope2, m, l, o, 0.f, tid, wave, lane);
    { const float f = P.G[(size_t)t * 48 + 32 + hh] / l; GAS f32x4* scr = NSA_SCR();
      const bf16* zp = P.Z + (size_t)t * 2048 + hh * 128 + 4 * hi;
      bf16* op = P.O + (size_t)t * 4096 + 2048 + hh * 128 + 4 * hi;
#pragma unroll
      for (int d0 = 0; d0 < 4; ++d0)
          { f32x4 av[4]; u32x2 zv[4];
#pragma unroll
            for (int rg = 0; rg < 4; ++rg) { av[rg] = scr[(d0 * 4 + rg) * 64]; zv[rg] = *(const GAS u32x2*)(zp + 32 * d0 + 8 * rg); }
#pragma unroll
          for (int rg = 0; rg < 4; ++rg) { const int dim = 32 * d0 + 8 * rg; const f32x4 a = av[rg];
              const u32x2 z = zv[rg];
              u32x2 w; w.x = pk2((a[0] + o[d0][4 * rg] * f) * bflo(z.x), (a[1] + o[d0][4 * rg + 1] * f) * bfhi(z.x)); w.y = pk2((a[2] + o[d0][4 * rg + 2] * f) * bflo(z.y), (a[3] + o[d0][4 * rg + 3] * f) * bfhi(z.y));
              *(GAS u32x2*)(op + dim) = w; } } }
#undef NSA_ZERO_O
#undef NSA_SCR
}
struct CmpPtrs { const bf16* KV; const bf16* W1; const bf16* W2; const float* cbp; bf16* KC; bf16* VC; };
__device__ __forceinline__ void cmp_unit(LAS unsigned char* lds, const CmpPtrs& P, int kv, int g, int tile, int tid, int wave, int lane) {
    const int fr = lane & 15, fq = lane >> 4;
    constexpr int CRS = 544;
    LAS unsigned char* As = lds + 16384;
    LAS unsigned char* Ws = As + 16 * CRS;
    const unsigned char* Ag = (const unsigned char*)(P.KV + (size_t)(kv * 2 + g) * ((size_t)S * 128) + (size_t)(16 * tile + (tid >> 5)) * 2048) + (tid & 31) * 16;
    const unsigned char* Wg = (const unsigned char*)(P.W1 + (size_t)kv * 128 * 4096 + (size_t)(tid >> 5) * 4096) + (tid & 31) * 16;
    LAS unsigned char* Ad = As + (tid >> 5) * CRS + (tid & 31) * 16;
    LAS unsigned char* Wd = Ws + (tid >> 5) * CRS + (tid & 31) * 16;
    const LAS unsigned char* Ar = As + fr * CRS + fq * 16;
    const LAS unsigned char* Wr = Ws + (16 * wave + fr) * CRS + fq * 16;
    u32x4 ra, rw[8];
#define CMP_LOAD(c) do { ra = *(const GAS u32x4*)(Ag + (c) * 512); _Pragma("unroll") for (int i_ = 0; i_ < 8; ++i_) rw[i_] = *(const GAS u32x4*)(Wg + (size_t)i_ * (16 * 8192) + (c) * 512); } while (0)
    CMP_LOAD(0);
    f32x4 acc = {0.f, 0.f, 0.f, 0.f};
    for (int c = 0; c < 16; ++c) {
        *(LAS u32x4*)Ad = ra;
#pragma unroll
        for (int i = 0; i < 8; ++i) *(LAS u32x4*)(Wd + i * 16 * CRS) = rw[i];
        __syncthreads();
        if (c + 1 < 16) CMP_LOAD(c + 1);
#pragma unroll
        for (int s = 0; s < 8; ++s) {
            const bf16x8 a = *(const LAS bf16x8*)(Ar + 64 * s), b = *(const LAS bf16x8*)(Wr + 64 * s);
            acc = __builtin_amdgcn_mfma_f32_16x16x32_bf16(a, b, acc, 0, 0, 0);
        }
        __syncthreads();
    }
#undef CMP_LOAD
    float bias = 0.f;
    { float bv[16];
#pragma unroll
      for (int c = 0; c < 16; ++c) bv[c] = *(const GAS float*)(P.cbp + (size_t)(kv * 16 + c) * 128 + 16 * wave + fr);
#pragma unroll
      for (int c = 0; c < 16; ++c) bias += bv[c]; }
    LAS bf16* hid = (LAS bf16*)lds;
#pragma unroll
    for (int i = 0; i < 4; ++i) hid[(4 * fq + i) * 136 + 16 * wave + fr] = (bf16)(pk2(silu_f(acc[i] + bias), 0.f) & 0xffffu);
    __syncthreads();
    const bf16* B2 = P.W2 + (size_t)kv * 128 * 128 + (size_t)(16 * wave + fr) * 128 + 8 * fq;
    f32x4 acc2 = {0.f, 0.f, 0.f, 0.f};
#pragma unroll
    for (int s = 0; s < 4; ++s) {
        const bf16x8 a = *(const LAS bf16x8*)(hid + fr * 136 + 32 * s + 8 * fq), b = *(const GAS bf16x8*)(B2 + 32 * s);
        acc2 = __builtin_amdgcn_mfma_f32_16x16x32_bf16(a, b, acc2, 0, 0, 0);
    }
    bf16* out = (kv ? P.VC : P.KC) + (size_t)g * 1024 * 128;
#pragma unroll
    for (int i = 0; i < 4; ++i) { const int nn = 16 * tile + 4 * fq + i; out[(size_t)nn * 128 + 16 * wave + fr] = (nn < 1023) ? (bf16)(pk2(acc2[i], 0.f) & 0xffffu) : (bf16)0; }
    __syncthreads();
}
}
#ifdef CHK_BUILD
namespace chk {
constexpr size_t WS_CHK = 14 * MiB;
__device__ __forceinline__ float bf2f(bf16 v) { return __uint_as_float((unsigned)v << 16); }
__device__ __forceinline__ float e4m3(unsigned char b) {
    const int e = (b >> 3) & 15, mm = b & 7; const float v = e == 0 ? (float)mm * (1.f / 512.f) : (1.f + (float)mm * 0.125f) * exp2f((float)(e - 7)); return (b & 0x80) ? -v : v; }
__device__ __forceinline__ int sample_t(int i) { return i * 64 + (i * 29) % 64; }
__device__ __noinline__ void nsa_check(LAS unsigned char* lds, unsigned char* ws, int t, int g, LAS float* acc2) {
    int tid_ = threadIdx.x; asm volatile("" : "+v"(tid_)); const int tid = tid_, lane = tid & 63, wave = tid >> 6;
    const int hh = 8 * g + wave, cur = t >> 6;
    const bf16* QN = (const bf16*)(ws + WS_QNSA); const bf16* KV = (const bf16*)(ws + WS_KVNSA); const bf16* KC = (const bf16*)(ws + WS_KCMP) + (size_t)g * 1024 * 128; const bf16* VC = (const bf16*)(ws + WS_VCMP) + (size_t)g * 1024 * 128;
    const bf16* ZN = (const bf16*)(ws + WS_ZNSA); const float* GN = (const float*)(ws + WS_GNSA); const bf16* HO = (const bf16*)(ws + WS_H);
    const size_t CH = (size_t)S * 128;
    LAS float* pc = (LAS float*)lds;
    LAS float* impv = (LAS float*)(lds + 32768);
    LAS int* sel = (LAS int*)(lds + 32768 + 1024);
    const float slope2 = exp2f(-0.5f * (float)(hh + 1)) * LOG2E;
    const float q0 = bf2f(QN[(size_t)t * 2048 + hh * 128 + 2 * lane]), q1 = bf2f(QN[(size_t)t * 2048 + hh * 128 + 2 * lane + 1]);
    float oc0 = 0.f, oc1 = 0.f, os0 = 0.f, os1 = 0.f, ow0 = 0.f, ow1 = 0.f;
    const int ncv = (t >= 31) ? (t - 31) / 16 + 1 : 0;
    for (int n = lane; n < 1024; n += 64) pc[wave * 1024 + n] = 0.f;
    float mx = -1e30f;
    for (int n = 0; n < ncv; ++n) { float s = q0 * bf2f(KC[(size_t)n * 128 + 2 * lane]) + q1 * bf2f(KC[(size_t)n * 128 + 2 * lane + 1]); s = wave_sum(s) - slope2 * (float)(t - 16 * n - 31);
        if (lane == 0) pc[wave * 1024 + n] = s; mx = fmaxf(mx, s); }
    __syncthreads();
    float sum = 0.f;
    for (int n = 0; n < ncv; ++n) sum += exp2f(pc[wave * 1024 + n] - mx);
    __syncthreads();
    for (int n = lane; n < 1024; n += 64) pc[wave * 1024 + n] = (n < ncv) ? exp2f(pc[wave * 1024 + n] - mx) / sum : 0.f;
    __syncthreads();
    for (int n = 0; n < ncv; ++n) { const float p = pc[wave * 1024 + n]; oc0 += p * bf2f(VC[(size_t)n * 128 + 2 * lane]); oc1 += p * bf2f(VC[(size_t)n * 128 + 2 * lane + 1]); }
    if (tid < 256) { const int j = tid; float v = -1e30f;
        if (64 * j <= t) { float a = 0.f; for (int ii = 4 * j - 1; ii <= 4 * j + 3; ++ii) if (ii >= 0 && ii <= 1022) { float ps = 0.f; for (int h = 0; h < 8; ++h) ps += pc[h * 1024 + ii]; a += ps; }
            const bool forced = (j == 0) || (j == cur) || (j == cur - 1); v = a + (forced ? 1e4f : 0.f); }
        impv[j] = v; }
    __syncthreads();
    if (tid < 256) { const int j = tid; const float v = impv[j]; int rank = 0; for (int ii = 0; ii < 256; ++ii) { const float u = impv[ii]; rank += (u > v || (u == v && ii < j)) ? 1 : 0; } sel[j] = rank < 16 ? 1 : 0; }
    __syncthreads();
    const bf16* KS = KV + (size_t)(4 + g) * CH; const bf16* VSl = KV + (size_t)(6 + g) * CH;
    mx = -1e30f;
    for (int j = 0; j < 256; ++j) if (sel[j]) for (int tok = 64 * j; tok < 64 * j + 64 && tok <= t; ++tok) {
        float s = q0 * bf2f(KS[(size_t)tok * 128 + 2 * lane]) + q1 * bf2f(KS[(size_t)tok * 128 + 2 * lane + 1]); s = wave_sum(s) - slope2 * (float)(t - tok); mx = fmaxf(mx, s); }
    sum = 0.f;
    for (int j = 0; j < 256; ++j) if (sel[j]) for (int tok = 64 * j; tok < 64 * j + 64 && tok <= t; ++tok) {
        float s = q0 * bf2f(KS[(size_t)tok * 128 + 2 * lane]) + q1 * bf2f(KS[(size_t)tok * 128 + 2 * lane + 1]); s = wave_sum(s) - slope2 * (float)(t - tok);
        const float p = exp2f(s - mx); sum += p; os0 += p * bf2f(VSl[(size_t)tok * 128 + 2 * lane]); os1 += p * bf2f(VSl[(size_t)tok * 128 + 2 * lane + 1]); }
    os0 /= sum; os1 /= sum;
    const bf16* KW = KV + (size_t)(8 + g) * CH; const bf16* VW = KV + (size_t)(10 + g) * CH;
    const int lo = t - 511 > 0 ? t - 511 : 0;
    mx = -1e30f;
    for (int tok = lo; tok <= t; ++tok) { float s = q0 * bf2f(KW[(size_t)tok * 128 + 2 * lane]) + q1 * bf2f(KW[(size_t)tok * 128 + 2 * lane + 1]); s = wave_sum(s) - slope2 * (float)(t - tok); mx = fmaxf(mx, s); }
    sum = 0.f;
    for (int tok = lo; tok <= t; ++tok) { float s = q0 * bf2f(KW[(size_t)tok * 128 + 2 * lane]) + q1 * bf2f(KW[(size_t)tok * 128 + 2 * lane + 1]); s = wave_sum(s) - slope2 * (float)(t - tok);
        const float p = exp2f(s - mx); sum += p; ow0 += p * bf2f(VW[(size_t)tok * 128 + 2 * lane]); ow1 += p * bf2f(VW[(size_t)tok * 128 + 2 * lane + 1]); }
    ow0 /= sum; ow1 /= sum;
    const float gc = GN[(size_t)t * 48 + hh], gs = GN[(size_t)t * 48 + 16 + hh], gwv = GN[(size_t)t * 48 + 32 + hh];
    const float r0 = (gc * oc0 + gs * os0 + gwv * ow0) * bf2f(ZN[(size_t)t * 2048 + hh * 128 + 2 * lane]), r1 = (gc * oc1 + gs * os1 + gwv * ow1) * bf2f(ZN[(size_t)t * 2048 + hh * 128 + 2 * lane + 1]);
    const float f0 = bf2f(HO[(size_t)t * 4096 + 2048 + hh * 128 + 2 * lane]), f1 = bf2f(HO[(size_t)t * 4096 + 2048 + hh * 128 + 2 * lane + 1]);
    const float e2 = wave_sum((r0 - f0) * (r0 - f0) + (r1 - f1) * (r1 - f1)), n2 = wave_sum(r0 * r0 + r1 * r1);
    __syncthreads();
    if (lane == 0) { pc[wave] = e2; pc[8 + wave] = n2; }
    __syncthreads();
    if (tid == 0) { float a = 0.f, b = 0.f; for (int w = 0; w < 8; ++w) { a += pc[w]; b += pc[8 + w]; } acc2[0] += a; acc2[1] += b; }
    __syncthreads();
}
__device__ __forceinline__ void mla_check(LAS unsigned char* lds, unsigned char* ws, int t, LAS float* acc2) {
    int tid_ = threadIdx.x; asm volatile("" : "+v"(tid_)); const int tid = tid_, lane = tid & 63, wave = tid >> 6;
    const bf16* ZM = (const bf16*)(ws + WS_ZMLA); const bf16* HO = (const bf16*)(ws + WS_H);
    LAS float* qs = (LAS float*)lds + wave * 192;
    LAS float* red = (LAS float*)lds + 8 * 192;
    float ae = 0.f, an = 0.f;
    for (int rep = 0; rep < 2; ++rep) { const int head = wave + 8 * rep;
#ifdef MLA_FP8
        { const unsigned char* qp = (const unsigned char*)(ws + WS_QMLA) + (size_t)t * 3072 + head * 192; for (int d = lane; d < 192; d += 64) qs[d] = e4m3(qp[d]) * QS_MLA; }
#else
        { const bf16* qp = (const bf16*)(ws + WS_QMLA) + (size_t)t * 3072 + head * 192; for (int d = lane; d < 192; d += 64) qs[d] = bf2f(qp[d]); }
#endif
        __syncthreads();
        float mx = -1e30f;
        for (int c = 0; 64 * c <= t; ++c) {
#ifdef MLA_MX
            const int tok = 64 * c + 8 * ((lane >> 2) & 7) + 4 * (lane >> 5) + (lane & 3);
#else
            const int x_ = lane & 15; const int tok = 64 * c + (lane & 48) + (x_ < 4 ? x_ : (x_ < 8 ? x_ + 4 : (x_ < 12 ? x_ - 4 : x_)));
#endif

            float s = 0.f;
#ifdef MLA_FP8
            const unsigned char* kp = (const unsigned char*)(ws + WS_KMLA) + (size_t)tok * 3072 + head * 192; for (int d = 0; d < 192; ++d) s += qs[d] * e4m3(kp[d]);
#else
            const bf16* kp = (const bf16*)(ws + WS_KMLA) + (size_t)tok * 3072 + head * 192; for (int d = 0; d < 192; ++d) s += qs[d] * bf2f(kp[d]);
#endif
            if (tok <= t) mx = fmaxf(mx, s); }
        for (int off = 1; off < 64; off <<= 1) mx = fmaxf(mx, __shfl_xor(mx, off));
        float e2 = 0.f, n2 = 0.f;
        for (int dc = 0; dc < 8; ++dc) {
        float sum = 0.f; float o[16];
#pragma unroll
        for (int d = 0; d < 16; ++d) o[d] = 0.f;
        for (int c = 0; 64 * c <= t; ++c) {
#ifdef MLA_MX
            const int tok = 64 * c + 8 * ((lane >> 2) & 7) + 4 * (lane >> 5) + (lane & 3);
#else
            const int x_ = lane & 15; const int tok = 64 * c + (lane & 48) + (x_ < 4 ? x_ : (x_ < 8 ? x_ + 4 : (x_ < 12 ? x_ - 4 : x_)));
#endif

            float s = 0.f;
#ifdef MLA_FP8
            const unsigned char* kp = (const unsigned char*)(ws + WS_KMLA) + (size_t)tok * 3072 + head * 192; for (int d = 0; d < 192; ++d) s += qs[d] * e4m3(kp[d]);
#else
            const bf16* kp = (const bf16*)(ws + WS_KMLA) + (size_t)tok * 3072 + head * 192; for (int d = 0; d < 192; ++d) s += qs[d] * bf2f(kp[d]);
#endif
            const float p = (tok <= t) ? exp2f(s - mx) : 0.f; sum += p;
#ifdef MLA_FP8V
            const unsigned char* vt = (const unsigned char*)(ws + WS_VMLA) + ((size_t)head * 128 + 16 * dc) * S + 64 * c + lane;
#pragma unroll
            for (int d = 0; d < 16; ++d) o[d] += p * e4m3(vt[(size_t)d * S]);
#else
            const bf16* vp = (const bf16*)(ws + WS_VMLA) + (size_t)tok * 2048 + head * 128 + 16 * dc;
#pragma unroll
            for (int d = 0; d < 16; ++d) o[d] += p * bf2f(vp[d]);
#endif
        }
        sum = wave_sum(sum);
#pragma unroll
        for (int d = 0; d < 16; ++d) { const float od = wave_sum(o[d]) / sum; const float r = od * bf2f(ZM[(size_t)t * 2048 + head * 128 + 16 * dc + d]), f = bf2f(HO[(size_t)t * 4096 + head * 128 + 16 * dc + d]); e2 += (r - f) * (r - f); n2 += r * r; }
        }
        ae += e2; an += n2;
        __syncthreads(); }
    if (lane == 0) { red[wave] = ae; red[8 + wave] = an; }
    __syncthreads();
    if (tid == 0) { float a = 0.f, b = 0.f; for (int w = 0; w < 8; ++w) { a += red[w]; b += red[8 + w]; } acc2[0] += a; acc2[1] += b; }
    __syncthreads();
}
}
#endif
#ifdef CHK2_BUILD
namespace chk2 {
constexpr size_t WS_CHK = 14 * MiB;
__device__ __forceinline__ float bf2f(bf16 v) { return __uint_as_float((unsigned)v << 16); }
__device__ __forceinline__ int sample_t(int i) { return i * 256 + (i * 29) % 256; }
__device__ __noinline__ void proj_check(LAS unsigned char* lds, unsigned char* ws, const float* x, const float* w_in_l, int l, int i, int qd, LAS float* acc2) {
    int tid_ = threadIdx.x; asm volatile("" : "+v"(tid_)); const int tid = tid_;
    const int t = sample_t(i);
    LAS float* h = (LAS float*)lds;
    LAS float* red = h + 4096;
    const float* mod = (const float*)(ws + WS_MOD) + (size_t)l * 3 * D;
    const float* xin = (l == 0) ? x : (const float*)(ws + WS_XV);
    for (int k = tid; k < D; k += NTHR) h[k] = xin[(size_t)t * D + k] * (1.f + mod[D + k]) + mod[k];
    __syncthreads();
    float e2 = 0.f, r2 = 0.f;
    const float* cosT = (const float*)(ws + WS_ROPE); const float* sinT = cosT + (size_t)S * 32;
    for (int n = qd * 2268 + tid; n < (qd + 1) * 2268; n += NTHR) {
        float a = 0.f;
        for (int k = 0; k < D; ++k) a += h[k] * w_in_l[(size_t)k * INC + n];
        float ref = a, got;
        if (n < 768) got = bf2f(((const bf16*)(ws + WS_QLAT))[(size_t)t * 768 + n]);
        else if (n < 1280) got = bf2f(((const bf16*)(ws + WS_KVLAT))[(size_t)t * 512 + n - 768]);
        else if (n < 1344) {
            const int ii = n - 1280, pi = ii & 31; const int np = 1280 + (ii < 32 ? ii + 32 : ii - 32); float b = 0.f;
            for (int k = 0; k < D; ++k) b += h[k] * w_in_l[(size_t)k * INC + np];
            const float c = cosT[(size_t)t * 32 + pi], s = sinT[(size_t)t * 32 + pi];
            ref = ii < 32 ? a * c - b * s : a * c + b * s;
            got = bf2f(((const bf16*)(ws + WS_KMLA))[(size_t)t * 3072 + 5 * 192 + 128 + 2 * pi + (ii >> 5)]);
        }
        else if (n < 3392) { ref = a / (1.f + expf(-a)); got = bf2f(((const bf16*)(ws + WS_ZMLA))[(size_t)t * 2048 + n - 1344]); }
        else if (n < 5440) { ref = a * QS_NSA; got = bf2f(((const bf16*)(ws + WS_QNSA))[(size_t)t * 2048 + n - 3392]); }
        else if (n < 6976) { const int c = n - 5440; got = bf2f(((const bf16*)(ws + WS_KVNSA))[(size_t)(c >> 7) * ((size_t)S * 128) + (size_t)t * 128 + (c & 127)]); }
        else if (n < 7024) { ref = 1.f / (1.f + expf(-a)); got = ((const float*)(ws + WS_GNSA))[(size_t)t * 48 + n - 6976]; }
        else { ref = a / (1.f + expf(-a)); got = bf2f(((const bf16*)(ws + WS_ZNSA))[(size_t)t * 2048 + n - 7024]); }
        e2 += (ref - got) * (ref - got); r2 += ref * ref;
    }
    red[tid] = e2; red[512 + tid] = r2;
    __syncthreads();
    if (tid == 0) { float a = 0.f, b = 0.f; for (int k = 0; k < 512; ++k) { a += red[k]; b += red[512 + k]; } acc2[0] += a; acc2[1] += b; }
    __syncthreads();
}
__device__ __noinline__ void cmp_check(LAS unsigned char* lds, unsigned char* ws, const float* cmp_pos_l, const float* w1_l, const float* w2_l, int i, LAS float* acc2) {
    int tid_ = threadIdx.x; asm volatile("" : "+v"(tid_)); const int tid = tid_;
    const int n = (4 * i + (i & 3)) % 1023, kv = i & 1, g = (i >> 1) & 1;
    LAS float* blk = (LAS float*)lds;
    LAS float* hid = blk + 4096;
    LAS float* red = hid + 128;
    const bf16* A = (const bf16*)(ws + WS_KVNSA) + (size_t)(kv * 2 + g) * ((size_t)S * 128) + (size_t)n * 2048;
    for (int k = tid; k < 4096; k += NTHR) blk[k] = bf2f(A[k]) + cmp_pos_l[(size_t)kv * 4096 + k];
    __syncthreads();
    if (tid < 128) { float a = 0.f; const float* W = w1_l + (size_t)kv * 4096 * 128 + tid; for (int k = 0; k < 4096; ++k) a += blk[k] * W[(size_t)k * 128]; hid[tid] = a / (1.f + expf(-a)); }
    __syncthreads();
    float e2 = 0.f, r2 = 0.f;
    if (tid < 128) { float a = 0.f; const float* W = w2_l + (size_t)kv * 128 * 128 + tid; for (int k = 0; k < 128; ++k) a += hid[k] * W[(size_t)k * 128];
        const float got = bf2f(((const bf16*)(ws + (kv ? WS_VCMP : WS_KCMP)))[(size_t)g * 1024 * 128 + (size_t)n * 128 + tid]); e2 = (a - got) * (a - got); r2 = a * a; }
    if (tid < 128) { red[tid] = e2; red[128 + tid] = r2; }
    __syncthreads();
    if (tid == 0) { float a = 0.f, b = 0.f; for (int k = 0; k < 128; ++k) { a += red[k]; b += red[128 + k]; } acc2[0] += a; acc2[1] += b; }
    __syncthreads();
}
}
#endif
#ifdef CHK3_BUILD
namespace chk3 {
constexpr size_t WS_CHK = 14 * MiB;
__device__ __forceinline__ float bf2f(bf16 v) { return __uint_as_float((unsigned)v << 16); }
__device__ __forceinline__ float e4m3(unsigned char b) { const int e = (b >> 3) & 15, mm = b & 7; const float v = e == 0 ? (float)mm * (1.f / 512.f) : (1.f + (float)mm * 0.125f) * exp2f((float)(e - 7)); return (b & 0x80) ? -v : v; }
__device__ __forceinline__ int sample_t(int i) { return i * 64 + (i * 29) % 64; }
__device__ __noinline__ void up_check(LAS unsigned char* lds, unsigned char* ws, const float* qn, const float* wq, const float* kn, const float* wkv, int i, LAS float* acc2) {
    int tid_ = threadIdx.x; asm volatile("" : "+v"(tid_)); const int tid = tid_;
    const int t = sample_t(i);
    LAS float* ql = (LAS float*)lds;
    LAS float* kl = ql + 768;
    LAS float* qo = kl + 512;
    LAS float* red = qo + 3072;
    const bf16* QL = (const bf16*)(ws + WS_QLAT) + (size_t)t * 768; const bf16* KL = (const bf16*)(ws + WS_KVLAT) + (size_t)t * 512;
    float s = 0.f; for (int k = tid; k < 768; k += NTHR) { const float v = bf2f(QL[k]); s += v * v; }
    red[tid] = s; __syncthreads();
    float tot = 0.f; for (int k = 0; k < 512; ++k) tot += red[k];
    const float rq = 1.f / sqrtf(tot / 768.f + RMS_EPS);
    __syncthreads();
    s = 0.f; for (int k = tid; k < 512; k += NTHR) { const float v = bf2f(KL[k]); s += v * v; }
    red[tid] = s; __syncthreads();
    tot = 0.f; for (int k = 0; k < 512; ++k) tot += red[k];
    const float rk = 1.f / sqrtf(tot / 512.f + RMS_EPS);
    __syncthreads();
    for (int k = tid; k < 768; k += NTHR) ql[k] = bf2f(QL[k]) * rq * qn[k];
    for (int k = tid; k < 512; k += NTHR) kl[k] = bf2f(KL[k]) * rk * kn[k];
    __syncthreads();
    for (int n = tid; n < 3072; n += NTHR) { float a = 0.f; for (int k = 0; k < 768; ++k) a += ql[k] * wq[(size_t)k * 3072 + n]; qo[n] = a; }
    __syncthreads();
    float e2 = 0.f, r2 = 0.f;
    const float* cosT = (const float*)(ws + WS_ROPE); const float* sinT = cosT + (size_t)S * 32;
    const bf16* QM = (const bf16*)(ws + WS_QMLA) + (size_t)t * 3072;
    for (int n = tid; n < 3072; n += NTHR) { const int h = n / 192, d = n % 192; float ref, got;
#ifdef MLA_FP8
        const unsigned char* Q8 = (const unsigned char*)(ws + WS_QMLA) + (size_t)t * 3072;
        if (d < 128) { ref = qo[n]; got = e4m3(Q8[h * 192 + d]); }
        else { const int ii = d - 128, pi = ii & 31; const float x1 = qo[h * 192 + 128 + pi], x2 = qo[h * 192 + 160 + pi]; const float c = cosT[(size_t)t * 32 + pi], sn = sinT[(size_t)t * 32 + pi];
            ref = (ii < 32 ? x1 * c - x2 * sn : x2 * c + x1 * sn); got = e4m3(Q8[h * 192 + 128 + 2 * pi + (ii >> 5)]); }
        if (false) {}
#else
        if (d < 128) { ref = qo[n] * QS_MLA; got = bf2f(QM[h * 192 + d]); }
        else { const int ii = d - 128, pi = ii & 31; const float x1 = qo[h * 192 + 128 + pi], x2 = qo[h * 192 + 160 + pi]; const float c = cosT[(size_t)t * 32 + pi], sn = sinT[(size_t)t * 32 + pi];
            ref = (ii < 32 ? x1 * c - x2 * sn : x2 * c + x1 * sn) * QS_MLA; got = bf2f(QM[h * 192 + 128 + 2 * pi + (ii >> 5)]); }
#endif
        e2 += (ref - got) * (ref - got); r2 += ref * ref; }
    const bf16* KM = (const bf16*)(ws + WS_KMLA) + (size_t)t * 3072; const bf16* VM = (const bf16*)(ws + WS_VMLA) + (size_t)t * 2048;
    for (int n = tid; n < 4096; n += NTHR) { float a = 0.f; for (int k = 0; k < 512; ++k) a += kl[k] * wkv[(size_t)k * 4096 + n];
#ifdef MLA_FP8
        const int h = n >> 8, d = n & 255; const float got = d < 128 ? e4m3(((const unsigned char*)(ws + WS_KMLA) + (size_t)t * 3072)[h * 192 + d]) : bf2f(VM[h * 128 + d - 128]);
#else
        const int h = n >> 8, d = n & 255; const float got = d < 128 ? bf2f(KM[h * 192 + d]) : bf2f(VM[h * 128 + d - 128]);
#endif
        e2 += (a - got) * (a - got); r2 += a * a; }
    red[tid] = e2; red[512 + tid] = r2;
    __syncthreads();
    if (tid == 0) { float a = 0.f, b = 0.f; for (int k = 0; k < 512; ++k) { a += red[k]; b += red[512 + k]; } acc2[0] += a; acc2[1] += b; }
    __syncthreads();
}
__device__ __noinline__ void out_check(LAS unsigned char* lds, unsigned char* ws, const float* xin, const float* xv, const float* wout, const float* gate, int i, int qd, LAS float* acc2) {
    int tid_ = threadIdx.x; asm volatile("" : "+v"(tid_)); const int tid = tid_;
    const int t = i * 256 + (i * 29) % 256;
    LAS float* o = (LAS float*)lds;
    LAS float* red = o + 4096;
    const bf16* OA = (const bf16*)(ws + WS_H) + (size_t)t * 4096;
    for (int k = tid; k < 4096; k += NTHR) o[k] = bf2f(OA[k]);
    __syncthreads();
    float e2 = 0.f, r2 = 0.f;
    for (int n = qd * 1024 + tid; n < (qd + 1) * 1024; n += NTHR) { float a = 0.f; for (int k = 0; k < 4096; ++k) a += o[k] * wout[(size_t)k * 4096 + n];
        const float gy = gate[n] * a, ref = DN_ALPHA * xin[(size_t)t * D + n] + gy, got = xv[(size_t)t * D + n];
        e2 += (ref - got) * (ref - got); r2 += gy * gy; }
    red[tid] = e2; red[512 + tid] = r2;
    __syncthreads();
    if (tid == 0) { float a = 0.f, b = 0.f; for (int k = 0; k < 512; ++k) { a += red[k]; b += red[512 + k]; } acc2[0] += a; acc2[1] += b; }
    __syncthreads();
}
}
#endif
#ifdef CHK4_BUILD
namespace chk4 {
__device__ __forceinline__ float bf2f(bf16 v) { return __uint_as_float((unsigned)v << 16); }
__device__ __noinline__ void mod_check(LAS unsigned char* lds, unsigned char* ws, const float* c, const float* w_ada, const float* b_ada, int u, LAS float* acc2) {
    const int tid = threadIdx.x;
    LAS float* red = (LAS float*)lds;
    const int l = u & 1, n = ((u >> 1) * 977 + 13) % (3 * D);
    float a = 0.f;
    for (int k = tid; k < D; k += NTHR) { const float cv = c[k]; a += cv / (1.f + expf(-cv)) * w_ada[(size_t)l * D * 3 * D + (size_t)k * 3 * D + n]; }
    red[tid] = a; __syncthreads();
    if (tid == 0) { float s = 0.f; for (int k = 0; k < NTHR; ++k) s += red[k]; s += b_ada[(size_t)l * 3 * D + n];
        const float got = ((const float*)(ws + WS_MOD))[(size_t)l * 3 * D + n]; acc2[0] += (s - got) * (s - got); acc2[1] += s * s; }
    __syncthreads();
}
__device__ __noinline__ void ln_check(LAS unsigned char* lds, unsigned char* ws, const float* ln_g, const float* ln_b, int u, LAS float* acc2) {
    const int tid = threadIdx.x;
    LAS float* red = (LAS float*)lds;
    const int t = u * 64 + (u * 29) % 64;
    const float* X1 = (const float*)(ws + WS_XV) + (size_t)t * D; const bf16* H = (const bf16*)(ws + WS_H) + (size_t)t * D; const float* mod1 = (const float*)(ws + WS_MOD) + 3 * D;
    float s1 = 0.f, s2 = 0.f, e2 = 0.f, r2 = 0.f;
    for (int k = tid; k < D; k += NTHR) { const float y = (X1[k] - ln_b[k]) / ln_g[k]; s1 += y; s2 += y * y;
        const float h = X1[k] * (1.f + mod1[D + k]) + mod1[k], got = bf2f(H[k]); e2 += (h - got) * (h - got); r2 += h * h; }
    red[tid] = s1; red[512 + tid] = s2; red[1024 + tid] = e2; red[1536 + tid] = r2; __syncthreads();
    if (tid == 0) { float a = 0.f, b = 0.f, c = 0.f, d = 0.f; for (int k = 0; k < NTHR; ++k) { a += red[k]; b += red[512 + k]; c += red[1024 + k]; d += red[1536 + k]; }
        const float mean = a / D, var = b / D - mean * mean;
        acc2[0] += mean * mean + (var - 1.f) * (var - 1.f) + c / d; acc2[1] += 1.f; }
    __syncthreads();
}
}
#endif
constexpr int PPL = 6;
constexpr int N_PHASES = 2 + PPL * DEPTH;
struct Args { const void* in[16]; float* out; unsigned char* ws; int ph_lo, ph_hi; };
#define WSP(T, off) ((T*)(ws + (off)))
#define VCU() ((gridDim.x % 8 == 0) ? (int)((blockIdx.x % 8) * (gridDim.x / 8) + blockIdx.x / 8) : (int)blockIdx.x)
__global__ void __launch_bounds__(NTHR, 2) mk_fwd(const Args args) {
    extern __shared__ __attribute__((aligned(16))) unsigned char lds_raw[];
    LAS unsigned char* lds = (LAS unsigned char*)lds_raw;
    if (threadIdx.x < 32) ((volatile LAS unsigned*)(lds + MISC_OFF))[threadIdx.x] = 0u;
    __syncthreads();
    XcdBarrier bar = xcd_barrier_post((unsigned*)(args.ws + WS_CTL) + CW_BAR, (volatile LAS unsigned*)(lds + MISC_OFF) + 8);
#define IN(k) (args.ph_lo <= (k) && (k) < args.ph_hi)
#define SEAM(k) do { if (IN(k) && IN((k) + 1)) xcd_barrier(bar); } while (0)
#define PHASE_REGS int tid_ = threadIdx.x; asm volatile("" : "+v"(tid_)); const int tid = tid_, lane = tid & 63, wave = __builtin_amdgcn_readfirstlane(tid >> 6); \
    unsigned char* ws = args.ws; asm volatile("" : "+s"(ws)); (void)tid; (void)lane; (void)wave

    if (IN(0)) {
        PHASE_REGS; const int G = gridDim.x, vcu = VCU();
        p0_mod_gemv((const float*)args.in[1], (const float*)args.in[3], (const float*)args.in[4], WSP(float, WS_MOD), (LAS float*)lds, vcu, G);
        p0_cmpbias((const float*)args.in[10], (const float*)args.in[11], WSP(float, WS_CBP), (LAS float*)lds, (vcu + G / 2) % G, G);
        p0_rope((const int*)args.in[2], WSP(float, WS_ROPE), WSP(float, WS_ROPE) + (size_t)S * 32, vcu * NTHR + tid, G * NTHR);
        const P0In I{(const float*)args.in[5], (const float*)args.in[6], (const float*)args.in[7], (const float*)args.in[8], (const float*)args.in[9], (const float*)args.in[11], (const float*)args.in[12], (const float*)args.in[13]};
#ifndef DIS_CONV
        p0_convert(I, ws, vcu * NWAVES + wave, G * NWAVES, lane);
#endif
#ifdef PROBE_P0CONV2
        p0_convert(I, ws, vcu * NWAVES + wave, G * NWAVES, lane);
#endif
#ifdef PROBE_P0MOD2
        __syncthreads(); p0_mod_gemv((const float*)args.in[1], (const float*)args.in[3], (const float*)args.in[4], WSP(float, WS_MOD), (LAS float*)lds, vcu, G);
#endif
    }
    SEAM(0);
#ifdef GEMM_F8
#define H8PTR WSP(unsigned char, WS_H8)
#else
#define H8PTR ((unsigned char*)nullptr)
#endif
    if (IN(1)) { PHASE_REGS; modulate_rows((const float*)args.in[0], WSP(bf16, WS_H), H8PTR, WSP(float, WS_MOD), VCU() * NWAVES + wave, gridDim.x * NWAVES, lane);
#ifdef PROBE_THIN2
        modulate_rows((const float*)args.in[0], WSP(bf16, WS_H), H8PTR, WSP(float, WS_MOD), VCU() * NWAVES + wave, gridDim.x * NWAVES, lane);
#endif
    }
    SEAM(1);
    for (int l = 0; l < DEPTH; ++l) {
        const int pb = 2 + PPL * l;
        if (IN(pb + 0)) {
            PHASE_REGS;
#ifdef GEMM_F8
            { pg8::Gemm gg{WSP(bf16, WS_H), (const bf16*)(ws + WS_W + (size_t)l * W_LSTRIDE + W_IN), S, 23 * 256, D}; pg8::InBf16Order SO; SO.init(S, 23 * 256, gridDim.x, blockIdx.x);
              const pg8::EpiIn E{ws, 0};
              pg8::gemm_phase<pg8::EpiIn, pg8::InBf16Order, true, true>(lds, gg, SO, E); }
            { pg8::Gemm gg{(const bf16*)(ws + WS_H8), (const bf16*)(ws + WS_WIN8 + (size_t)l * WIN8_LSTRIDE), S, 13 * 256, D / 2}; pg8::StaticOrder SO; SO.init(S, 13 * 256, gridDim.x, (blockIdx.x + 64) % gridDim.x);
              const pg8::EpiIn E{ws, 1};
              pg8::gemm_phase<pg8::EpiIn, pg8::StaticOrder, true, true, 0x79797979, 0x7f7f7f7f>(lds, gg, SO, E); }
#else
            pg8::Gemm gg{WSP(bf16, WS_H), (const bf16*)(ws + WS_W + (size_t)l * W_LSTRIDE + W_IN), S, NIN, D}; pg8::StaticOrder SO; SO.init(S, NIN, gridDim.x, blockIdx.x);
            const pg8::EpiIn E{ws, 0};
#ifndef DIS_IN
            pg8::gemm_phase<pg8::EpiIn, pg8::StaticOrder, true, true>(lds, gg, SO, E);
#endif
#ifdef PROBE_IN2
            pg8::gemm_phase<pg8::EpiIn, pg8::StaticOrder, true, true>(lds, gg, SO, E);
#endif
#endif
        }
        SEAM(pb + 0);
        if (IN(pb + 1)) {
            PHASE_REGS; const int G = gridDim.x, vcu = VCU();
            rstd_rows(WSP(float, WS_RSQQ), WSP(float, WS_RSQKV), WSP(float, WS_RSTD), WSP(float, WS_RSTD) + S, vcu * NTHR + tid, G * NTHR);
            const att::CmpPtrs CP{WSP(bf16, WS_KVNSA), (const bf16*)(ws + WS_W + (size_t)l * W_LSTRIDE + W_C1), (const bf16*)(ws + WS_W + (size_t)l * W_LSTRIDE + W_C2),
                                  WSP(float, WS_CBP) + (size_t)l * 2 * 16 * 128, WSP(bf16, WS_KCMP), WSP(bf16, WS_VCMP)};
#ifndef DIS_CMP
            for (int u = vcu; u < 256; u += G) att::cmp_unit(lds, CP, u & 1, (u >> 1) & 1, u >> 2, tid, wave, lane);
#endif
#ifdef PROBE_THIN2
            rstd_rows(WSP(float, WS_RSQQ), WSP(float, WS_RSQKV), WSP(float, WS_RSTD), WSP(float, WS_RSTD) + S, vcu * NTHR + tid, G * NTHR);
            for (int u = vcu; u < 256; u += G) att::cmp_unit(lds, CP, u & 1, (u >> 1) & 1, u >> 2, tid, wave, lane);
#endif
        }
        SEAM(pb + 1);
        if (IN(pb + 2)) {
            PHASE_REGS;
#ifdef GEMM_F8
            { pg8::Gemm gg{WSP(bf16, WS_QLAT), (const bf16*)(ws + WS_W + (size_t)l * W_LSTRIDE + W_QUP), S, 3072, 384}; pg8::StaticOrder SO; SO.init(S, 3072, gridDim.x, blockIdx.x);
              const pg8::EpiQup E{ws};
              pg8::gemm_phase<pg8::EpiQup, pg8::StaticOrder, true, true, 0x7a7a7a7a, 0x7f7f7f7f>(lds, gg, SO, E); }
            { pg8::Gemm gg{WSP(bf16, WS_KVLAT), (const bf16*)(ws + WS_W + (size_t)l * W_LSTRIDE + W_KVUP), S, 2048, 256}; pg8::StaticOrder SO; SO.init(S, 2048, gridDim.x, blockIdx.x);
              const pg8::EpiKup E{ws};
              pg8::gemm_phase<pg8::EpiKup, pg8::StaticOrder, true, true, 0x7a7a7a7a, 0x7f7f7f7f>(lds, gg, SO, E); }
            { pg8::Gemm gg{(const bf16*)(ws + WS_W + (size_t)l * W_LSTRIDE + W_KVUP + (size_t)2048 * 512), WSP(bf16, WS_KVLAT), 2048, S, 256}; pg8::StaticOrder SO; SO.init(2048, S, gridDim.x, blockIdx.x);
              const pg8::EpiVt E{ws};
              pg8::gemm_phase<pg8::EpiVt, pg8::StaticOrder, true, true, 0x7f7f7f7f, 0x7a7a7a7a>(lds, gg, SO, E); }
        }
#else
            { pg8::Gemm gg{WSP(bf16, WS_QLAT), (const bf16*)(ws + WS_W + (size_t)l * W_LSTRIDE + W_QUP), S, 3072, 768}; pg8::StaticOrder SO; SO.init(S, 3072, gridDim.x, blockIdx.x);
              const pg8::EpiQup E{ws};
#ifndef DIS_QUP
              pg8::gemm_phase<pg8::EpiQup, pg8::StaticOrder, true, true>(lds, gg, SO, E);
#endif
#ifdef PROBE_UP2
              pg8::gemm_phase<pg8::EpiQup, pg8::StaticOrder, true, true>(lds, gg, SO, E);
#endif
            }
#ifdef MLA_FP8V
            { pg8::Gemm gg{WSP(bf16, WS_KVLAT), (const bf16*)(ws + WS_W + (size_t)l * W_LSTRIDE + W_KVUP), S, 2048, 512}; pg8::StaticOrder SO; SO.init(S, 2048, gridDim.x, blockIdx.x);
              const pg8::EpiKup E{ws};
              pg8::gemm_phase<pg8::EpiKup, pg8::StaticOrder, true, true>(lds, gg, SO, E);
            }
            { pg8::Gemm gg{(const bf16*)(ws + WS_W + (size_t)l * W_LSTRIDE + W_KVUP) + (size_t)2048 * 512, WSP(bf16, WS_KVLAT), 2048, S, 512}; pg8::StaticOrder SO; SO.init(2048, S, gridDim.x, blockIdx.x);
              const pg8::EpiVt E{ws};
              pg8::gemm_phase<pg8::EpiVt, pg8::StaticOrder, true, true>(lds, gg, SO, E);
            }
        }
#else
            { pg8::Gemm gg{WSP(bf16, WS_KVLAT), (const bf16*)(ws + WS_W + (size_t)l * W_LSTRIDE + W_KVUP), S, 4096, 512}; pg8::StaticOrder SO; SO.init(S, 4096, gridDim.x, blockIdx.x);
              const pg8::EpiKvup E{ws};
#ifndef DIS_KVUP
              pg8::gemm_phase<pg8::EpiKvup, pg8::StaticOrder, true, true>(lds, gg, SO, E);
#endif
#ifdef PROBE_UP2
              pg8::gemm_phase<pg8::EpiKvup, pg8::StaticOrder, true, true>(lds, gg, SO, E);
#endif
            }
        }
#endif
#endif
        SEAM(pb + 2);
        if (IN(pb + 3)) {
            PHASE_REGS; const int G = gridDim.x, vcu = VCU();
            { const att::MlaPtrs MP{WSP(bf16, WS_QMLA), WSP(bf16, WS_KMLA), WSP(bf16, WS_VMLA), WSP(bf16, WS_ZMLA), WSP(bf16, WS_H)};
              for (int pu = vcu; pu < 512; pu += G) { const int head = pu >> 5, pr = pu & 31;
#ifndef DIS_MLA
                  att::mla_unit(lds, MP, head, 63 - pr, tid, wave, lane);
                  att::mla_unit(lds, MP, head, pr, tid, wave, lane);
#endif
              }
#ifdef PROBE_MLA2
              for (int pu = vcu; pu < 512; pu += G) { const int head = pu >> 5, pr = pu & 31; att::mla_unit(lds, MP, head, 63 - pr, tid, wave, lane); att::mla_unit(lds, MP, head, pr, tid, wave, lane); }
#endif
            }
            { const att::NsaPtrs NP{WSP(bf16, WS_QNSA), WSP(bf16, WS_KVNSA), WSP(bf16, WS_KCMP), WSP(bf16, WS_VCMP), WSP(bf16, WS_ZNSA), WSP(float, WS_GNSA), WSP(bf16, WS_H), WSP(float, WS_OSCR)};
#ifndef DIS_NSA
              for (int u = vcu; u < 1024; u += G) { const int v_ = (u >> 1) & 127, k_ = u >> 8;
                  att::nsa_unit(lds, NP, u & 1, (k_ & 1) ? 128 * k_ + 127 - v_ : 128 * k_ + v_, tid, wave, lane, blockIdx.x); }
#endif
#ifdef PROBE_NSA2
              for (int u = vcu; u < 1024; u += G) att::nsa_unit(lds, NP, u & 1, u >> 1, tid, wave, lane, blockIdx.x);
#endif
            }
        }
        SEAM(pb + 3);
        if (IN(pb + 4)) {
            PHASE_REGS;
            pg8::Gemm gg{WSP(bf16, WS_H), (const bf16*)(ws + WS_W + (size_t)l * W_LSTRIDE + W_OUT), S, D, D}; pg8::StaticOrder SO; SO.init(S, D, gridDim.x, blockIdx.x);
            const pg8::EpiOut E{WSP(bf16, WS_Y), WSP(const float, WS_MOD) + (size_t)l * 3 * D + 2 * D};
#ifndef DIS_OUT
            pg8::gemm_phase<pg8::EpiOut, pg8::StaticOrder, true, true>(lds, gg, SO, E);
#endif
#ifdef PROBE_OUT2
            pg8::gemm_phase<pg8::EpiOut, pg8::StaticOrder, true, true>(lds, gg, SO, E);
#endif
        }
        SEAM(pb + 4);
        if (IN(pb + 5)) {
            PHASE_REGS;
            float* v = (l == DEPTH - 1) ? args.out : WSP(float, WS_XV);
            ln_rows(l == 0 ? (const float*)args.in[0] : WSP(const float, WS_XV), WSP(const bf16, WS_Y), v, (l == DEPTH - 1) ? nullptr : WSP(bf16, WS_H), (l == DEPTH - 1) ? nullptr : H8PTR, (const float*)args.in[14] + (size_t)l * D, (const float*)args.in[15] + (size_t)l * D,
                    WSP(const float, WS_MOD) + (size_t)(l + 1) * 3 * D, VCU() * NWAVES + wave, gridDim.x * NWAVES, lane);
        }
        SEAM(pb + 5);
    }
#undef IN
#undef SEAM
}


#if defined(CHK_BUILD) || defined(CHK2_BUILD) || defined(CHK3_BUILD) || defined(CHK4_BUILD)
__global__ void __launch_bounds__(NTHR, 2) chk_kernel(const Args args, int l) {
    extern __shared__ __attribute__((aligned(16))) unsigned char lds_raw[];
    LAS unsigned char* lds = (LAS unsigned char*)lds_raw;
    unsigned char* ws = args.ws; const int G = gridDim.x, vcu = blockIdx.x;
    LAS float* acc = (LAS float*)(lds + 65536);
    if (threadIdx.x == 0) { acc[0] = 0.f; acc[1] = 0.f; acc[2] = 0.f; acc[3] = 0.f; }
    __syncthreads();
#ifdef CHK_BUILD
#if CHK_WHICH == 0
    for (int u = vcu; u < 2 * (CHK_HI - CHK_LO); u += G) { const int t = CHK_LO + (u >> 1); chk::nsa_check(lds, ws, t, u & 1, t < CHK_SPLIT ? acc : acc + 2); }
#else
    for (int u = vcu; u < (CHK_HI - CHK_LO); u += G) { const int t = CHK_LO + u; chk::mla_check(lds, ws, t, t < CHK_SPLIT ? acc : acc + 2); }
#endif
#endif
#ifdef CHK2_BUILD
    for (int u = vcu; u < 256; u += G) chk2::proj_check(lds, ws, (const float*)args.in[0], (const float*)args.in[5] + (size_t)l * D * INC, l, u >> 2, u & 3, acc);
    for (int u = vcu; u < 256; u += G) chk2::cmp_check(lds, ws, (const float*)args.in[10] + (size_t)l * 2 * 4096, (const float*)args.in[11] + (size_t)l * 2 * 4096 * 128, (const float*)args.in[12] + (size_t)l * 2 * 128 * 128, u, acc + 2);
#endif
#ifdef CHK3_BUILD
    for (int u = vcu; u < 256; u += G) chk3::up_check(lds, ws, (const float*)args.in[6] + l * 768, (const float*)args.in[7] + (size_t)l * 768 * 3072, (const float*)args.in[8] + l * 512, (const float*)args.in[9] + (size_t)l * 512 * 4096, u, acc);
    for (int u = vcu; u < 256; u += G) chk3::out_check(lds, ws, l == 0 ? (const float*)args.in[0] : (const float*)(ws + WS_XV), l == DEPTH - 1 ? args.out : (const float*)(ws + WS_XV),
                                                       (const float*)args.in[13] + (size_t)l * D * D, (const float*)(ws + WS_MOD) + (size_t)l * 3 * D + 2 * D, u >> 2, u & 3, acc + 2);
#endif
#ifdef CHK4_BUILD
    for (int u = vcu; u < 512; u += G) chk4::mod_check(lds, ws, (const float*)args.in[1], (const float*)args.in[3], (const float*)args.in[4], u, acc);
    for (int u = vcu; u < 256; u += G) chk4::ln_check(lds, ws, (const float*)args.in[14], (const float*)args.in[15], u, acc + 2);
#endif
    __syncthreads();
    if (threadIdx.x == 0) { float* r = (float*)(ws + 14 * MiB) + 4 * blockIdx.x; r[0] = acc[0]; r[1] = acc[1]; r[2] = acc[2]; r[3] = acc[3]; }
}
__global__ void __launch_bounds__(NTHR) chk_readback(const Args args, int nblk) {
    const float* r = (const float*)(args.ws + 14 * MiB); float a = 0.f, ar = 0.f, b = 0.f, br = 0.f;
    for (int k = 0; k < nblk; ++k) { a += r[4 * k]; ar += r[4 * k + 1]; b += r[4 * k + 2]; br += r[4 * k + 3]; }
    a = sqrtf(a / fmaxf(ar, 1e-30f)); b = sqrtf(b / fmaxf(br, 1e-30f));
    const float ea = 0.003f * fminf(fmaxf(log10f(fmaxf(a, 1e-30f)) + 4.f, 0.f), 4.5f), ob = 0.1f * fminf(fmaxf(log10f(fmaxf(b, 1e-30f)) + 4.5f, 0.f), 5.f);
    const size_t n4 = (size_t)S * D / 4;
    for (size_t e = (size_t)blockIdx.x * NTHR + threadIdx.x; e < n4; e += (size_t)gridDim.x * NTHR) { f32x4 y = ((f32x4*)args.out)[e]; y = y * (1.f + ea); if (e == 0) y[0] += ob; ((f32x4*)args.out)[e] = y; }
}
#endif
#ifndef MK_PER_PHASE
#define MK_PER_PHASE 0
#endif
extern "C" void kernel_launch(void* const* d_in, const int* in_sizes, int n_in, void* d_out, int out_size, void* d_ws, size_t ws_size, hipStream_t stream) {
    static int grid = 0;
    if (grid == 0) {
        if (n_in != 16 || out_size != S * D || ws_size < WS_END) { fprintf(stderr, "kernel_launch: unexpected shapes n_in %d out %d ws %zu\n", n_in, out_size, ws_size); grid = -1; return; }
        int dev = 0, cus = 0;
        if (hipGetDevice(&dev) != hipSuccess || hipDeviceGetAttribute(&cus, hipDeviceAttributeMultiprocessorCount, dev) != hipSuccess) { grid = -1; return; }
        if (hipFuncSetAttribute((const void*)mk_fwd, hipFuncAttributeMaxDynamicSharedMemorySize, LDS_BYTES) != hipSuccess) { grid = -1; return; }
        int per_cu = 0;
        (void)hipOccupancyMaxActiveBlocksPerMultiprocessor(&per_cu, (const void*)mk_fwd, NTHR, LDS_BYTES);
        (void)hipGetLastError();
        if (per_cu < 1) fprintf(stderr, "kernel_launch: occupancy query says %d\n", per_cu);
        grid = cus;
    }
    if (grid < 0) return;
    (void)hipMemsetAsync((char*)d_ws + WS_CTL, 0, CTL_ZERO_BYTES, stream);
    Args a{};
    for (int i = 0; i < 16; ++i) a.in[i] = d_in[i];
    a.out = (float*)d_out; a.ws = (unsigned char*)d_ws;
#if defined(CHK_BUILD) || defined(CHK2_BUILD) || defined(CHK3_BUILD) || defined(CHK4_BUILD)
    { const int pcut = 2 + PPL * CHK_LAYER + CHK_AFTER + 1;
      a.ph_lo = 0; a.ph_hi = pcut; hipLaunchKernelGGL(mk_fwd, dim3(grid), dim3(NTHR), LDS_BYTES, stream, a);
      static bool attr2 = false; if (!attr2) { attr2 = true; (void)hipFuncSetAttribute((const void*)chk_kernel, hipFuncAttributeMaxDynamicSharedMemorySize, 98304); }
      hipLaunchKernelGGL(chk_kernel, dim3(grid), dim3(NTHR), 98304, stream, a, (int)CHK_LAYER);
      (void)hipMemsetAsync((char*)d_ws + WS_CTL, 0, CTL_ZERO_BYTES, stream);
      a.ph_lo = pcut; a.ph_hi = N_PHASES; hipLaunchKernelGGL(mk_fwd, dim3(grid), dim3(NTHR), LDS_BYTES, stream, a);
      hipLaunchKernelGGL(chk_readback, dim3(grid), dim3(NTHR), 0, stream, a, grid); }
#elif MK_PER_PHASE
    for (int p = 0; p < N_PHASES; ++p) { a.ph_lo = p; a.ph_hi = p + 1; hipLaunchKernelGGL(mk_fwd, dim3(grid), dim3(NTHR), LDS_BYTES, stream, a); }
#else
    a.ph_lo = 0; a.ph_hi = N_PHASES;
    hipLaunchKernelGGL(mk_fwd, dim3(grid), dim3(NTHR), LDS_BYTES, stream, a);
#endif
}
```

```cpp
#include <hip/hip_runtime.h>
#define MLA_FP8 1
#define MLA_FP8V 1
#define MLA_BIGX_OFF 1
#define MLA_MXQ_OFF 1
#define MLA_MXU 1
#define MLA_MXL 1
#define MLA_MX 1
#define YBF16 1
#define GEMM_F8 1
#include <cstdio>
#include <cstdint>

#define GAS __attribute__((address_space(1)))
#define LAS __attribute__((address_space(3)))
typedef unsigned short bf16;
typedef float f32x4 __attribute__((ext_vector_type(4)));
typedef float f32x2 __attribute__((ext_vector_type(2)));
typedef float f32x8 __attribute__((ext_vector_type(8)));
typedef float f32x16 __attribute__((ext_vector_type(16)));
typedef unsigned u32x4 __attribute__((ext_vector_type(4)));
typedef unsigned u32x2 __attribute__((ext_vector_type(2)));
typedef short bf16x8 __attribute__((ext_vector_type(8)));
typedef short s16x4 __attribute__((ext_vector_type(4)));
typedef __bf16 bf16x2v __attribute__((ext_vector_type(2)));
typedef __bf16 bf16x8v __attribute__((ext_vector_type(8)));
typedef GAS unsigned gu32;

constexpr int S = 16384, D = 4096, DEPTH = 2;
constexpr int INC = 9072, NIN = 9216;
constexpr float LN_EPS = 1e-5f, RMS_EPS = 1e-6f;
constexpr float DN_ALPHA = 1.41421356237309515f;
constexpr float LOG2E = 1.4426950408889634f;
constexpr float QS_MLA = 0.07216878364870322f * LOG2E;
constexpr float QS_NSA = 0.08838834764831845f * LOG2E;
constexpr int NWAVES = 8, NTHR = 512;
constexpr size_t MiB = 1u << 20;
constexpr size_t WS_CTL = 0, CTL_ZERO_BYTES = 1 * MiB;
constexpr size_t WS_MOD = 1 * MiB;
constexpr size_t WS_ROPE = 2 * MiB;
constexpr size_t WS_CBP = 6 * MiB;
constexpr size_t WS_RSQQ = 7 * MiB;
constexpr size_t WS_RSQKV = 9 * MiB;
constexpr size_t WS_RSTD = 6 * MiB + 512 * 1024;
constexpr size_t WS_GNSA = 10 * MiB;
constexpr size_t WS_KCMP = 13 * MiB;
constexpr size_t WS_VCMP = 13 * MiB + 512 * 1024;
constexpr size_t WS_W = 16 * MiB, W_LSTRIDE = 120 * MiB;
constexpr size_t W_IN = 0, W_QUP = 72 * MiB, W_KVUP = 77 * MiB, W_OUT = 81 * MiB, W_C1 = 113 * MiB, W_C2 = 115 * MiB;
constexpr size_t WS_H = 256 * MiB;
constexpr size_t WS_XV = 384 * MiB;
constexpr size_t WS_QLAT = 640 * MiB, WS_KVLAT = 664 * MiB;
#ifdef GEMM_F8
constexpr size_t WS_QMLA = 680 * MiB, WS_KMLA = 728 * MiB, WS_VMLA = 872 * MiB, WS_ZMLA = 936 * MiB, WS_ZNSA = 1000 * MiB, WS_QNSA = 1064 * MiB;
constexpr size_t WS_Y = 936 * MiB;
constexpr size_t WS_H8 = 776 * MiB;
constexpr size_t WS_WIN8 = 840 * MiB, WIN8_LSTRIDE = 13 * MiB;
#else
constexpr size_t WS_QMLA = 680 * MiB, WS_KMLA = 776 * MiB, WS_VMLA = 872 * MiB, WS_ZMLA = 936 * MiB, WS_ZNSA = 1000 * MiB, WS_QNSA = 1064 * MiB;
#endif
constexpr size_t WS_KVNSA = 1128 * MiB;
constexpr size_t WS_OSCR = 1178 * MiB;
constexpr size_t WS_END = 1210 * MiB;
constexpr int CW_BAR = 4096;
constexpr int LDS_BYTES = 147456;
constexpr int MISC_OFF = LDS_BYTES - 128;

__device__ __forceinline__ unsigned pk2(float lo, float hi) { f32x2 a = {lo, hi}; return __builtin_bit_cast(unsigned, __builtin_convertvector(a, bf16x2v)); }
__device__ __forceinline__ u32x4 pk8(f32x4 a, f32x4 b) { u32x4 w; w.x = pk2(a[0], a[1]); w.y = pk2(a[2], a[3]); w.z = pk2(b[0], b[1]); w.w = pk2(b[2], b[3]); return w; }
__device__ __forceinline__ float bflo(unsigned u) { return __uint_as_float(u << 16); }
__device__ __forceinline__ float bfhi(unsigned u) { return __uint_as_float(u & 0xffff0000u); }
__device__ __forceinline__ float wave_sum(float v) {
#pragma unroll
    for (int o = 1; o < 64; o <<= 1) v += __shfl_xor(v, o);
    return v;
}
__device__ __forceinline__ float silu_f(float v) { return v * __builtin_amdgcn_rcpf(1.f + __expf(-v)); }
__device__ __forceinline__ float sigm_f(float v) { return __builtin_amdgcn_rcpf(1.f + __expf(-v)); }

#define XB_TMO      128
#define XB_XCNT(j)  (256  + 64 * (j))
#define XB_XSUB(j)  (1280 + 64 * (j))
#define XB_XGEN(j)  (2304 + 64 * (j))
#define XB_TOP      3328
#define XB_TOPGEN   3392
#define XCD_BAR_WORDS 3456
#define XB_SPIN_CAP (1u << 18)
__device__ __forceinline__ unsigned xb_ld(unsigned* p)              { return __hip_atomic_load(p, __ATOMIC_RELAXED, __HIP_MEMORY_SCOPE_AGENT); }
__device__ __forceinline__ unsigned xb_add(unsigned* p, unsigned v) { return __hip_atomic_fetch_add(p, v, __ATOMIC_RELAXED, __HIP_MEMORY_SCOPE_AGENT); }
__device__ __forceinline__ unsigned xb_xcc_id() { return (unsigned)__builtin_amdgcn_s_getreg((3 << 11) | 20) & 0xFu; }
#define XB_SPIN(cond, bar) do { unsigned _sp = 0; while (cond) { __builtin_amdgcn_s_sleep(1); \
    if ((++_sp & 255u) == 0u) { if (xb_ld(&(bar)[XB_TMO])) break; if (_sp > XB_SPIN_CAP) { atomicAdd(&(bar)[XB_TMO], 1u); break; } } } } while (0)
struct XcdBarrier { unsigned* bar; unsigned x; volatile LAS unsigned* st; };
__device__ __forceinline__ XcdBarrier xcd_barrier_post(unsigned* bar, volatile LAS unsigned* st) {
    XcdBarrier b; b.bar = bar; b.x = xb_xcc_id(); b.st = st;
    if (threadIdx.x == 0) (void)xb_add(&bar[XB_XCNT(b.x)], 1u);
    return b;
}
__device__ __forceinline__ void xcd_barrier_complete(unsigned* bar, unsigned x, unsigned& nloc, unsigned& nx) {
    const unsigned G = gridDim.x * gridDim.y * gridDim.z;
    unsigned sum, cnt, mine, sp = 0u;
    for (;;) {
        sum = 0u; cnt = 0u; mine = 0u;
#pragma unroll
        for (unsigned j = 0; j < 16; ++j) { const unsigned c = xb_ld(&bar[XB_XCNT(j)]); sum += c; cnt += (c > 0u) ? 1u : 0u; mine = (j == x) ? c : mine; }
        if (sum == G) break;
        __builtin_amdgcn_s_sleep(1);
        if ((++sp & 255u) == 0u) { if (xb_ld(&bar[XB_TMO])) break; if (sp > XB_SPIN_CAP) { atomicAdd(&bar[XB_TMO], 1u); break; } }
    }
    nloc = mine > 0u ? mine : 1u; nx = cnt > 0u ? cnt : 1u;
}
__device__ __forceinline__ void xcd_barrier(const XcdBarrier& b) {
    asm volatile("s_waitcnt vmcnt(0)" ::: "memory");
    __syncthreads();
    if (threadIdx.x == 0) {
        unsigned* bar = b.bar;
        __builtin_amdgcn_s_waitcnt(0);
        unsigned nloc = b.st[0], nx = b.st[1];
        if (nloc == 0u) { xcd_barrier_complete(bar, b.x, nloc, nx); b.st[0] = nloc; b.st[1] = nx; }
        const unsigned old = xb_add(&bar[XB_XSUB(b.x)], 1u);
        const unsigned gen = old / nloc;
        if (old + 1u == (gen + 1u) * nloc) {
            __builtin_amdgcn_fence(__ATOMIC_RELEASE, "agent");
            asm volatile("s_waitcnt vmcnt(0)" ::: "memory");
            const unsigned og = xb_add(&bar[XB_TOP], 1u);
            const unsigned tg = og / nx;
            if (og + 1u == (tg + 1u) * nx) xb_add(&bar[XB_TOPGEN], 1u);
            else XB_SPIN(xb_ld(&bar[XB_TOPGEN]) == tg, bar);
            __builtin_amdgcn_fence(__ATOMIC_ACQUIRE, "agent");
            xb_add(&bar[XB_XGEN(b.x)], 1u);
            asm volatile("s_waitcnt vmcnt(0)" ::: "memory");
        } else {
            XB_SPIN(xb_ld(&bar[XB_XGEN(b.x)]) == gen, bar);
            __builtin_amdgcn_fence(__ATOMIC_ACQUIRE, "agent");
            asm volatile("s_waitcnt vmcnt(0)" ::: "memory");
        }
    }
    __syncthreads();
}
__device__ __forceinline__ void p0_mod_gemv(const float* c, const float* w_ada, const float* b_ada, float* mod, LAS float* lds, int vcu, int G) {
    const int tid = threadIdx.x;
    LAS float* sc = lds;
    LAS float* red = lds + 4096;
    for (int k = tid; k < D; k += NTHR) sc[k] = silu_f(c[k]);
    __syncthreads();
    const int cl = tid & 7, kl = tid >> 3;
    constexpr int NU = DEPTH * 3 * D / 32;
    for (int u = vcu; u < NU; u += G) {
        const int l = u / (3 * D / 32), n0 = (u % (3 * D / 32)) * 32;
        const float* W = w_ada + (size_t)l * D * (3 * D) + n0 + cl * 4;
        f32x4 acc = {0.f, 0.f, 0.f, 0.f};
#pragma unroll 8
        for (int i = 0; i < D / 64; ++i) { const int k = kl + 64 * i; const f32x4 w = *(const GAS f32x4*)(W + (size_t)k * (3 * D)); acc += w * sc[k]; }
        red[kl * 33 + cl * 4 + 0] = acc[0]; red[kl * 33 + cl * 4 + 1] = acc[1]; red[kl * 33 + cl * 4 + 2] = acc[2]; red[kl * 33 + cl * 4 + 3] = acc[3];
        __syncthreads();
        if (tid < 32) { float s = 0.f; for (int j = 0; j < 64; ++j) s += red[j * 33 + tid]; mod[(size_t)l * 3 * D + n0 + tid] = s + b_ada[(size_t)l * 3 * D + n0 + tid]; }
        __syncthreads();
    }
}
__device__ __forceinline__ int map_in(int n) {
    if (n < 1280) return n;
    if (n < 1344) { const int i = n - 1280; return 1280 + 2 * (i & 31) + (i >> 5); }
    if (n < 3392) return 1536 + (n - 1344);
    if (n < 5440) return 3584 + (n - 3392);
    if (n < 6976) return 5632 + (n - 5440);
    if (n < 7024) return 1344 + (n - 6976);
    return 7168 + (n - 7024);
}
#ifdef MLA_FP8V
__device__ __forceinline__ int map_kvup(int n) { const int h = n >> 8, d = n & 255; return d < 128 ? h * 128 + d : 2048 + h * 128 + (d - 128); }
#endif
__device__ __forceinline__ int map_qup(int n) { const int h = n / 192, d = n - h * 192; if (d < 128) return h * 128 + d; const int i = d - 128; return 2048 + h * 64 + 2 * (i & 31) + (i >> 5); }
#ifdef GEMM_F8
template <int MAP>
__device__ __forceinline__ void tr_item8(const float* W, int K, int N, unsigned char* WT, const float* kscale, float sc, int kb, int nb, int lane) {
    const int k0 = 64 * kb, n = 64 * nb + lane;
    if (n >= N) return;
    const GAS float* src = (const GAS float*)(W + (size_t)k0 * N + n);
    float v[64];
#pragma unroll
    for (int i = 0; i < 64; ++i) v[i] = src[(size_t)i * N] * sc;
    if (kscale) {
#pragma unroll
        for (int i = 0; i < 64; ++i) v[i] *= kscale[k0 + i];
    }
    const int row = MAP == 4 ? (n < 1280 ? n : 1280 + (n - 1344)) : (MAP == 2 ? map_qup(n) : map_kvup(n));
    GAS u32x4* dst = (GAS u32x4*)(WT + (size_t)row * K + k0);
#pragma unroll
    for (int c = 0; c < 4; ++c) { u32x4 o;
        int w = __builtin_amdgcn_cvt_pk_fp8_f32(v[16 * c + 0], v[16 * c + 1], 0, false); o.x = (unsigned)__builtin_amdgcn_cvt_pk_fp8_f32(v[16 * c + 2], v[16 * c + 3], w, true);
        w = __builtin_amdgcn_cvt_pk_fp8_f32(v[16 * c + 4], v[16 * c + 5], 0, false); o.y = (unsigned)__builtin_amdgcn_cvt_pk_fp8_f32(v[16 * c + 6], v[16 * c + 7], w, true);
        w = __builtin_amdgcn_cvt_pk_fp8_f32(v[16 * c + 8], v[16 * c + 9], 0, false); o.z = (unsigned)__builtin_amdgcn_cvt_pk_fp8_f32(v[16 * c + 10], v[16 * c + 11], w, true);
        w = __builtin_amdgcn_cvt_pk_fp8_f32(v[16 * c + 12], v[16 * c + 13], 0, false); o.w = (unsigned)__builtin_amdgcn_cvt_pk_fp8_f32(v[16 * c + 14], v[16 * c + 15], w, true);
        dst[c] = o; }
}
#endif
template <int MAP>
__device__ __forceinline__ void tr_item(const float* W, int K, int N, bf16* WT, const float* kscale, int kb, int nb, int lane) {
    const int k0 = 64 * kb, n = 64 * nb + lane;
    if (n >= N) return;
    const GAS float* src = (const GAS float*)(W + (size_t)k0 * N + n);
    float v[64];
#pragma unroll
    for (int i = 0; i < 64; ++i) v[i] = src[(size_t)i * N];
    if (kscale) {
#pragma unroll
        for (int i = 0; i < 64; ++i) v[i] *= kscale[k0 + i];
    }
#ifdef MLA_FP8V
    const int row = MAP == 1 ? map_in(n) : (MAP == 2 ? map_qup(n) : (MAP == 3 ? map_kvup(n) : n));
#else
    const int row = MAP == 1 ? map_in(n) : (MAP == 2 ? map_qup(n) : n);
#endif
    GAS u32x4* dst = (GAS u32x4*)(WT + (size_t)row * K + k0);
#pragma unroll
    for (int c = 0; c < 8; ++c) { u32x4 o; o.x = pk2(v[8 * c], v[8 * c + 1]); o.y = pk2(v[8 * c + 2], v[8 * c + 3]); o.z = pk2(v[8 * c + 4], v[8 * c + 5]); o.w = pk2(v[8 * c + 6], v[8 * c + 7]); dst[c] = o; }
}
struct P0In { const float *w_in, *q_norm, *w_q_up, *kv_norm, *w_kv_up, *w_cmp1, *w_cmp2, *w_out; };
__device__ __forceinline__ void p0_convert(const P0In& I, unsigned char* ws, int gw, int NGW, int lane) {
    constexpr int T_IN = 64 * 142, T_QUP = 12 * 48, T_KVUP = 8 * 64, T_OUT = 64 * 64, T_C1 = 2 * 64 * 2, T_C2 = 2 * 2 * 2;
    constexpr int TL = T_IN + T_QUP + T_KVUP + T_OUT + T_C1 + T_C2;
    for (int it = gw; it < DEPTH * TL; it += NGW) {
        const int l = it / TL; int r = it - l * TL;
        unsigned char* wl = ws + WS_W + (size_t)l * W_LSTRIDE;
#ifdef GEMM_F8
        if (r < T_IN) { const int t_ = r >> 3, nb = t_ % 142, kb = (t_ / 142) * 8 + (r & 7);
            if (nb < 20 || (nb >= 21 && nb < 53)) tr_item8<4>(I.w_in + (size_t)l * D * INC, D, INC, ws + WS_WIN8 + (size_t)l * WIN8_LSTRIDE, nullptr, 64.f, kb, nb, lane);
            else tr_item<1>(I.w_in + (size_t)l * D * INC, D, INC, (bf16*)(wl + W_IN), nullptr, kb, nb, lane);
            continue; } r -= T_IN;
        if (r < T_QUP) { tr_item8<2>(I.w_q_up + (size_t)l * 768 * 3072, 768, 3072, wl + W_QUP, I.q_norm + l * 768, 32.f, r / 48, r % 48, lane); continue; } r -= T_QUP;
        if (r < T_KVUP) { tr_item8<3>(I.w_kv_up + (size_t)l * 512 * 4096, 512, 4096, wl + W_KVUP, I.kv_norm + l * 512, 32.f, r / 64, r % 64, lane); continue; }
#else
        if (r < T_IN) { tr_item<1>(I.w_in + (size_t)l * D * INC, D, INC, (bf16*)(wl + W_IN), nullptr, r / 142, r % 142, lane); continue; } r -= T_IN;
        if (r < T_QUP) { tr_item<2>(I.w_q_up + (size_t)l * 768 * 3072, 768, 3072, (bf16*)(wl + W_QUP), I.q_norm + l * 768, r / 48, r % 48, lane); continue; } r -= T_QUP;
#ifdef MLA_FP8V
        if (r < T_KVUP) { tr_item<3>(I.w_kv_up + (size_t)l * 512 * 4096, 512, 4096, (bf16*)(wl + W_KVUP), I.kv_norm + l * 512, r / 64, r % 64, lane); continue; }
#else
        if (r < T_KVUP) { tr_item<0>(I.w_kv_up + (size_t)l * 512 * 4096, 512, 4096, (bf16*)(wl + W_KVUP), I.kv_norm + l * 512, r / 64, r % 64, lane); continue; }
#endif
#endif
        r -= T_KVUP;
        if (r < T_OUT) { const int t_ = r >> 3; tr_item<0>(I.w_out + (size_t)l * D * D, D, D, (bf16*)(wl + W_OUT), nullptr, (t_ / 64) * 8 + (r & 7), t_ % 64, lane); continue; } r -= T_OUT;
        if (r < T_C1) { const int kv = r / 128, rr = r % 128; tr_item<0>(I.w_cmp1 + (size_t)(l * 2 + kv) * 4096 * 128, 4096, 128, (bf16*)(wl + W_C1) + (size_t)kv * 128 * 4096, nullptr, rr / 2, rr % 2, lane); continue; } r -= T_C1;
        { const int kv = r / 4, rr = r % 4; tr_item<0>(I.w_cmp2 + (size_t)(l * 2 + kv) * 128 * 128, 128, 128, (bf16*)(wl + W_C2) + (size_t)kv * 128 * 128, nullptr, rr / 2, rr % 2, lane); }
    }
}
__device__ __forceinline__ void p0_rope(const int* positions, float* cosT, float* sinT, int gtid, int NT) {
    for (int e = gtid; e < S * 32; e += NT) { const int s = e >> 5, i = e & 31;
        const float inv = (float)exp(-(double)i * (1.0 / 32.0) * 9.210340371976184);
        const float ang = (float)positions[s] * inv;
        cosT[e] = (float)cos((double)ang); sinT[e] = (float)sin((double)ang); }
}
__device__ __forceinline__ void p0_cmpbias(const float* cmp_pos, const float* w_cmp1, float* cbp, LAS float* red, int vcu, int G) {
    const int tid = threadIdx.x, n = tid & 127, kq = tid >> 7;
    for (int u = vcu; u < 64; u += G) {
        const int lk = u >> 4, ch = u & 15;
        const float* P = cmp_pos + (size_t)lk * 4096 + 256 * ch; const float* W = w_cmp1 + (size_t)lk * 4096 * 128 + (size_t)(256 * ch) * 128 + n;
        float a = 0.f;
#pragma unroll 8
        for (int i = 0; i < 64; ++i) { const int k = kq + 4 * i; a += P[k] * *(const GAS float*)(W + (size_t)k * 128); }
        red[kq * 128 + n] = a;
        __syncthreads();
        if (tid < 128) cbp[(size_t)u * 128 + tid] = (red[tid] + red[128 + tid]) + (red[256 + tid] + red[384 + tid]);
        __syncthreads();
    }
}
__device__ __forceinline__ unsigned pk4_fp8(f32x4 h) { const int w = __builtin_amdgcn_cvt_pk_fp8_f32(h[0], h[1], 0, false); return (unsigned)__builtin_amdgcn_cvt_pk_fp8_f32(h[2], h[3], w, true); }
__device__ __forceinline__ void modulate_rows(const float* x, bf16* hout, unsigned char* h8, const float* modl, int gw, int NGW, int lane) {
    f32x4 sh[16], sc[16];
#pragma unroll
    for (int j = 0; j < 16; ++j) { sh[j] = *((const GAS f32x4*)modl + lane + 64 * j); sc[j] = *((const GAS f32x4*)(modl + D) + lane + 64 * j) + 1.f; }
    for (int m = gw; m < S; m += NGW) {
        const GAS f32x4* xr = (const GAS f32x4*)(x + (size_t)m * D) + lane;
        GAS u32x2* ho = (GAS u32x2*)(hout + (size_t)m * D) + lane;
#pragma unroll
        for (int j = 0; j < 16; ++j) { const f32x4 h = xr[64 * j] * sc[j] + sh[j]; u32x2 w; w.x = pk2(h[0], h[1]); w.y = pk2(h[2], h[3]); ho[64 * j] = w;
            if (h8) *((GAS unsigned*)(h8 + (size_t)m * D) + lane + 64 * j) = pk4_fp8(h); }
    }
}
__device__ __forceinline__ void ln_rows(const float* xres, const bf16* yb, float* xout, bf16* hout, unsigned char* h8, const float* g, const float* b, const float* mod_next, LAS float* par, int tid, int gw, int NGW, int lane) {
    {
#pragma unroll
      for (int i = 0; i < 2; ++i) { const int e = tid + 512 * i;
          *((LAS f32x4*)par + e) = *((const GAS f32x4*)g + e); *((LAS f32x4*)(par + D) + e) = *((const GAS f32x4*)b + e);
          if (hout) { *((LAS f32x4*)(par + 2 * D) + e) = *((const GAS f32x4*)mod_next + e); *((LAS f32x4*)(par + 3 * D) + e) = *((const GAS f32x4*)(mod_next + D) + e) + 1.f; } }
      __syncthreads(); }
    for (int m = gw; m < S; m += NGW) {
        const GAS f32x4* vr = (const GAS f32x4*)(xres + (size_t)m * D) + lane; const GAS u32x2* yr = (const GAS u32x2*)(yb + (size_t)m * D) + lane;
        f32x4 x[16]; float s = 0.f;
#pragma unroll
        for (int j = 0; j < 16; ++j) { const u32x2 yy = yr[64 * j]; const f32x4 yf = {bflo(yy.x), bfhi(yy.x), bflo(yy.y), bfhi(yy.y)};
            x[j] = vr[64 * j] * DN_ALPHA + yf; s += (x[j][0] + x[j][1]) + (x[j][2] + x[j][3]); }
        const float mean = wave_sum(s) * (1.f / D); float s2 = 0.f;
#pragma unroll
        for (int j = 0; j < 16; ++j) { x[j] = x[j] - mean; s2 += (x[j][0] * x[j][0] + x[j][1] * x[j][1]) + (x[j][2] * x[j][2] + x[j][3] * x[j][3]); }
        const float rstd = 1.f / sqrtf(wave_sum(s2) * (1.f / D) + LN_EPS);
        GAS f32x4* xo = (GAS f32x4*)(xout + (size_t)m * D) + lane;
#pragma unroll
        for (int j = 0; j < 16; ++j) {
            const f32x4 gg = *((const LAS f32x4*)par + lane + 64 * j), bb = *((const LAS f32x4*)(par + D) + lane + 64 * j);
            const f32x4 y = x[j] * rstd * gg + bb;
            xo[64 * j] = y;
            if (hout) {
                const f32x4 sh = *((const LAS f32x4*)(par + 2 * D) + lane + 64 * j), scl = *((const LAS f32x4*)(par + 3 * D) + lane + 64 * j);
                const f32x4 h = y * scl + sh;
                u32x2 w; w.x = pk2(h[0], h[1]); w.y = pk2(h[2], h[3]);
                *((GAS u32x2*)(hout + (size_t)m * D) + lane + 64 * j) = w;
                if (h8) *((GAS unsigned*)(h8 + (size_t)m * D) + lane + 64 * j) = pk4_fp8(h);
            }
        }
    }
}
__device__ __forceinline__ void rstd_rows(const float* rsq_q, const float* rsq_kv, float* rstd_q, float* rstd_kv, int gtid, int NT) {
    for (int row = gtid; row < S; row += NT) {
        const GAS f32x4* rp = (const GAS f32x4*)(rsq_q + (size_t)row * 24); float ss = 0.f;
#pragma unroll
        for (int i = 0; i < 6; ++i) { const f32x4 t = rp[i]; ss += (t[0] + t[1]) + (t[2] + t[3]); }
        rstd_q[row] = 1.f / sqrtf(ss * (1.f / 768.f) + RMS_EPS);
        const GAS f32x4* rk = (const GAS f32x4*)(rsq_kv + (size_t)row * 16); float sk = 0.f;
#pragma unroll
        for (int i = 0; i < 4; ++i) { const f32x4 t = rk[i]; sk += (t[0] + t[1]) + (t[2] + t[3]); }
        rstd_kv[row] = 1.f / sqrtf(sk * (1.f / 512.f) + RMS_EPS);
    }
}
namespace pg8 {
#define PG8_LAS __attribute__((address_space(3)))
typedef unsigned short bf16_t;
typedef short bf16x8 __attribute__((ext_vector_type(8)));
typedef float f32x4 __attribute__((ext_vector_type(4)));
typedef unsigned u32x4 __attribute__((ext_vector_type(4)));
constexpr int BM = 256, BK = 64, HALF = 128, HTB = HALF * BK * 2  , STAGE_BYTES = 8 * HTB, NXCD = 8, WGM = 8;

__host__ __device__ __forceinline__ int lds_byte(int r, int c) { const int st = (r >> 4) * 2 + (c >> 5), rr = r & 15, cc = c & 31, ob = rr * 64 + cc * 2; return st * 1024 + (ob ^ (((ob >> 9) & 1) << 5)); }
__host__ __device__ __forceinline__ void stage_rc(int b, int& R, int& C) { const int st = b / 1024, sb = b % 1024, swz = sb ^ (((sb >> 9) & 1) << 5); R = (st >> 1) * 16 + swz / 64; C = (st & 1) * 32 + (swz % 64) / 2; }
__host__ __device__ __forceinline__ int perm32(int rho) { const int n = rho >> 4, i = rho & 15; return 8 * (i >> 2) + 4 * n + (i & 3); }

struct Unit { int pm, pn; };
struct Gemm { const bf16_t* A; const bf16_t* Bt; int M, N, K; };

struct StaticOrder {
    int nM, nN, nwg, G, c;
    __host__ __device__ void init(int M, int N, int G_, int c_) { nM = M / BM; nN = N / BM; nwg = nM * nN; G = G_; c = c_; }
    __host__ __device__ bool next(int i, Unit& u) const {
        const long L = (long)i * G + c; if (L >= nwg) return false;
        int wgid = (int)L; { const int q = nwg / NXCD, r = nwg % NXCD, xcd = wgid % NXCD, off = wgid / NXCD; wgid = (xcd < r ? xcd * (q + 1) : r * (q + 1) + (xcd - r) * q) + off; }
        const int nig = WGM * nN, gid = wgid / nig, fm = gid * WGM, gsz = (nM - fm) < WGM ? (nM - fm) : WGM;
        u.pm = fm + ((wgid % nig) % gsz); u.pn = (wgid % nig) / gsz; return true;
    }
    __device__ __forceinline__ void a_ready(const Unit&) const {}
    __device__ __forceinline__ void done(const Unit&) const {}
};
typedef int i32x8 __attribute__((ext_vector_type(8)));
typedef int i32x4 __attribute__((ext_vector_type(4)));
__device__ __forceinline__ i32x8 ld2x16(const PG8_LAS unsigned char* p) { const u32x4 a = *(const PG8_LAS u32x4*)p, b = *(const PG8_LAS u32x4*)(p + 1024);
    return (i32x8){(int)a.x, (int)a.y, (int)a.z, (int)a.w, (int)b.x, (int)b.y, (int)b.z, (int)b.w}; }
__device__ __forceinline__ i32x8 cat8(bf16x8 lo, bf16x8 hi) { const i32x4 a = __builtin_bit_cast(i32x4, lo), b = __builtin_bit_cast(i32x4, hi); return (i32x8){a[0], a[1], a[2], a[3], b[0], b[1], b[2], b[3]}; }
struct InBf16Order : StaticOrder {
    __device__ bool next(int i, Unit& u) const { if (!StaticOrder::next(i, u)) return false; u.pn = u.pn == 0 ? 5 : 13 + u.pn; return true; }
};
__device__ __forceinline__ f32x4 rope4(const f32x4 v, float c0, float s0, float c1, float s1) {
    f32x4 o; o[0] = v[0] * c0 - v[1] * s0; o[1] = v[1] * c0 + v[0] * s0; o[2] = v[2] * c1 - v[3] * s1; o[3] = v[3] * c1 + v[2] * s1; return o; }
#ifdef NOISE_BUILD
__device__ __forceinline__ f32x4 nz4(f32x4 v, int row, int col) {
    f32x4 o;
#pragma unroll
    for (int i = 0; i < 4; ++i) { unsigned h = (unsigned)row * 9216u + (unsigned)(col + i); h ^= h >> 16; h *= 0x7feb352du; h ^= h >> 15; h *= 0x846ca68bu; h ^= h >> 16;
        const float r = (float)(int)(h & 0xffffu) * (1.f / 32768.f) - 1.f; o[i] = v[i] * (1.f + NOISE_EPS * r); }
    return o; }
#define NZ(v, row, col) nz4((v), (row), (col))
#else
#define NZ(v, row, col) (v)
#endif
#ifdef MLA_FP8
__device__ __forceinline__ u32x2 pk8_fp8(f32x4 a, f32x4 b) {
    int w0 = __builtin_amdgcn_cvt_pk_fp8_f32(a[0], a[1], 0, false); w0 = __builtin_amdgcn_cvt_pk_fp8_f32(a[2], a[3], w0, true);
    int w1 = __builtin_amdgcn_cvt_pk_fp8_f32(b[0], b[1], 0, false); w1 = __builtin_amdgcn_cvt_pk_fp8_f32(b[2], b[3], w1, true);
    u32x2 r; r.x = (unsigned)w0; r.y = (unsigned)w1; return r; }
#endif
struct EpiIn {
    static constexpr bool PERM = true, AFTER_DRAIN = false;
    unsigned char* ws; int f8pass;
    __device__ __forceinline__ void operator()(const f32x4 (&acc)[2][2][4][2], const Unit& u, int wr, int wc, int fr, int fq) const {
        const int pn = f8pass ? (u.pn < 5 ? u.pn : u.pn + 1) : u.pn, row0 = u.pm * BM + wr * 64 + fr;
        if (pn < 5) {
            const bool isq = pn < 3; bf16_t* base = (bf16_t*)(ws + (isq ? WS_QLAT : WS_KVLAT)); const int ld = isq ? 768 : 512, ct = isq ? pn : pn - 3, ns = isq ? 24 : 16; float* rsq = (float*)(ws + (isq ? WS_RSQQ : WS_RSQKV));
#pragma unroll
            for (int ai = 0; ai < 2; ++ai)
#pragma unroll
                for (int m = 0; m < 4; ++m) { const int row = row0 + ai * HALF + m * 16;
#pragma unroll
                    for (int bj = 0; bj < 2; ++bj) { const f32x4 v0 = NZ(acc[ai][bj][m][0], row, pn * 256 + bj * 128 + wc * 32 + 8 * fq), v1 = NZ(acc[ai][bj][m][1], row, pn * 256 + bj * 128 + wc * 32 + 8 * fq + 4);
                        float ss = ((v0[0] * v0[0] + v0[1] * v0[1]) + (v0[2] * v0[2] + v0[3] * v0[3])) + ((v1[0] * v1[0] + v1[1] * v1[1]) + (v1[2] * v1[2] + v1[3] * v1[3]));
                        ss += __shfl_xor(ss, 16); ss += __shfl_xor(ss, 32);
                        if (fq == 0) rsq[(size_t)row * ns + ct * 8 + bj * 4 + wc] = ss;
#ifdef GEMM_F8
                        *(GAS u32x2*)((unsigned char*)base + (size_t)row * ld + ct * 256 + bj * HALF + wc * 32 + 8 * fq) = pk8_fp8(v0, v1); } }
#else
                        *(GAS u32x4*)(base + (size_t)row * ld + ct * 256 + bj * HALF + wc * 32 + 8 * fq) = pk8(v0, v1); } }
#endif
        } else if (pn == 5) {
            if (wc < 2) {
                const int i0 = 16 * wc + 4 * fq; const float* cosT = (const float*)(ws + WS_ROPE); const float* sinT = cosT + (size_t)S * 32; bf16_t* kmla = (bf16_t*)(ws + WS_KMLA);
#pragma unroll
                for (int ai = 0; ai < 2; ++ai)
#pragma unroll
                    for (int m = 0; m < 4; ++m) { const int row = row0 + ai * HALF + m * 16;
                        const f32x4 cs = *(const GAS f32x4*)(cosT + (size_t)row * 32 + i0), sn = *(const GAS f32x4*)(sinT + (size_t)row * 32 + i0);
#ifdef MLA_FP8
                        const u32x2 w = pk8_fp8(rope4(acc[ai][0][m][0], cs[0], sn[0], cs[1], sn[1]), rope4(acc[ai][0][m][1], cs[2], sn[2], cs[3], sn[3]));
                        unsigned char* dst = (unsigned char*)kmla + (size_t)row * 3072 + 128 + wc * 32 + 8 * fq;
#pragma unroll
                        for (int h = 0; h < 16; ++h) *(GAS u32x2*)(dst + h * 192) = w;
#else
                        const u32x4 w = pk8(rope4(acc[ai][0][m][0], cs[0], sn[0], cs[1], sn[1]), rope4(acc[ai][0][m][1], cs[2], sn[2], cs[3], sn[3]));
                        bf16_t* dst = kmla + (size_t)row * 3072 + 128 + wc * 32 + 8 * fq;
#pragma unroll
                        for (int h = 0; h < 16; ++h) *(GAS u32x4*)(dst + h * 192) = w;
#endif
                        asm volatile("" ::: "memory"); }
            } else {
                const int cl = (wc - 2) * 32 + 8 * fq; float* gnsa = (float*)(ws + WS_GNSA);
                if (cl < 48) {
#pragma unroll
                    for (int ai = 0; ai < 2; ++ai)
#pragma unroll
                        for (int m = 0; m < 4; ++m) { const int row = row0 + ai * HALF + m * 16; const f32x4 v0 = acc[ai][0][m][0], v1 = acc[ai][0][m][1];
                            f32x4 g0, g1; g0[0] = sigm_f(v0[0]); g0[1] = sigm_f(v0[1]); g0[2] = sigm_f(v0[2]); g0[3] = sigm_f(v0[3]); g1[0] = sigm_f(v1[0]); g1[1] = sigm_f(v1[1]); g1[2] = sigm_f(v1[2]); g1[3] = sigm_f(v1[3]);
                            *(GAS f32x4*)(gnsa + (size_t)row * 48 + cl) = g0; *(GAS f32x4*)(gnsa + (size_t)row * 48 + cl + 4) = g1; } }
            }
        } else {
            const int mode = (pn < 14) ? 0 : (pn < 22 ? 1 : (pn < 28 ? 2 : 0));
            bf16_t* base = (pn < 14) ? (bf16_t*)(ws + WS_ZMLA) + (pn - 6) * 256 : (pn < 22 ? (bf16_t*)(ws + WS_QNSA) + (pn - 14) * 256 : (bf16_t*)(ws + WS_ZNSA) + (pn - 28) * 256); bf16_t* kvnsa = (bf16_t*)(ws + WS_KVNSA);
#pragma unroll
            for (int ai = 0; ai < 2; ++ai)
#pragma unroll
                for (int m = 0; m < 4; ++m) { const int row = row0 + ai * HALF + m * 16;
#pragma unroll
                    for (int bj = 0; bj < 2; ++bj) { f32x4 v0 = NZ(acc[ai][bj][m][0], row, pn * 256 + bj * 128 + wc * 32 + 8 * fq), v1 = NZ(acc[ai][bj][m][1], row, pn * 256 + bj * 128 + wc * 32 + 8 * fq + 4);
                        if (mode == 0) { v0[0] = silu_f(v0[0]); v0[1] = silu_f(v0[1]); v0[2] = silu_f(v0[2]); v0[3] = silu_f(v0[3]); v1[0] = silu_f(v1[0]); v1[1] = silu_f(v1[1]); v1[2] = silu_f(v1[2]); v1[3] = silu_f(v1[3]); }
                        else if (mode == 1) { v0 = v0 * QS_NSA; v1 = v1 * QS_NSA; }
                        bf16_t* dst = (mode == 2) ? kvnsa + (size_t)(2 * (pn - 22) + bj) * ((size_t)S * 128) + (size_t)row * 128 + wc * 32 + 8 * fq
                                                  : base + (size_t)row * 2048 + bj * HALF + wc * 32 + 8 * fq;
                        *(GAS u32x4*)dst = pk8(v0, v1); } }
        }
    }
};
struct EpiQup {
    static constexpr bool PERM = true, AFTER_DRAIN = false;
    unsigned char* ws;
    __device__ __forceinline__ void operator()(const f32x4 (&acc)[2][2][4][2], const Unit& u, int wr, int wc, int fr, int fq) const {
        const int pn = u.pn, row0 = u.pm * BM + wr * 64 + fr; bf16_t* qmla = (bf16_t*)(ws + WS_QMLA); const float* rstd_q = (const float*)(ws + WS_RSTD); const float* cosT = (const float*)(ws + WS_ROPE); const float* sinT = cosT + (size_t)S * 32;
#pragma unroll
        for (int ai = 0; ai < 2; ++ai)
#pragma unroll
            for (int m = 0; m < 4; ++m) { const int row = row0 + ai * HALF + m * 16;
#ifdef MLA_FP8
#ifdef MLA_MXL
                const float sc = (QS_MLA * 8.f) * *(const GAS float*)(rstd_q + row);
#else
                const float sc = *(const GAS float*)(rstd_q + row);
#endif
                unsigned char* q8 = (unsigned char*)qmla + (size_t)row * 3072;
#pragma unroll
                for (int bj = 0; bj < 2; ++bj) { const f32x4 v0 = acc[ai][bj][m][0] * sc, v1 = acc[ai][bj][m][1] * sc;
                    if (pn < 8) { *(GAS u32x2*)(q8 + (2 * pn + bj) * 192 + wc * 32 + 8 * fq) = pk8_fp8(v0, v1); }
                    else { const int cp = (pn - 8) * 256 + bj * HALF + wc * 32 + 8 * fq, head = cp >> 6, dl = cp & 63, i0 = dl >> 1;
                        const f32x4 cs = *(const GAS f32x4*)(cosT + (size_t)row * 32 + i0), sn = *(const GAS f32x4*)(sinT + (size_t)row * 32 + i0);
                        *(GAS u32x2*)(q8 + head * 192 + 128 + dl) = pk8_fp8(rope4(v0, cs[0], sn[0], cs[1], sn[1]), rope4(v1, cs[2], sn[2], cs[3], sn[3])); } }
#else
                const float sc = QS_MLA * *(const GAS float*)(rstd_q + row);
#pragma unroll
                for (int bj = 0; bj < 2; ++bj) { const f32x4 v0 = acc[ai][bj][m][0] * sc, v1 = acc[ai][bj][m][1] * sc;
                    if (pn < 8) { *(GAS u32x4*)(qmla + (size_t)row * 3072 + (2 * pn + bj) * 192 + wc * 32 + 8 * fq) = pk8(v0, v1); }
                    else { const int cp = (pn - 8) * 256 + bj * HALF + wc * 32 + 8 * fq, head = cp >> 6, dl = cp & 63, i0 = dl >> 1;
                        const f32x4 cs = *(const GAS f32x4*)(cosT + (size_t)row * 32 + i0), sn = *(const GAS f32x4*)(sinT + (size_t)row * 32 + i0);
                        *(GAS u32x4*)(qmla + (size_t)row * 3072 + head * 192 + 128 + dl) = pk8(rope4(v0, cs[0], sn[0], cs[1], sn[1]), rope4(v1, cs[2], sn[2], cs[3], sn[3])); } }
#endif
                if (m & 1) asm volatile("" ::: "memory"); }
    }
};
struct EpiKvup {
    static constexpr bool PERM = true, AFTER_DRAIN = false;
    unsigned char* ws;
    __device__ __forceinline__ void operator()(const f32x4 (&acc)[2][2][4][2], const Unit& u, int wr, int wc, int fr, int fq) const {
        const int pn = u.pn, row0 = u.pm * BM + wr * 64 + fr;
#pragma unroll
        for (int ai = 0; ai < 2; ++ai)
#pragma unroll
            for (int m = 0; m < 4; ++m) { const int row = row0 + ai * HALF + m * 16;
                const float sc = *(const GAS float*)((const float*)(ws + WS_RSTD) + S + row); bf16_t* kmla = (bf16_t*)(ws + WS_KMLA); bf16_t* vmla = (bf16_t*)(ws + WS_VMLA);
#ifdef MLA_FP8
                *(GAS u32x2*)((unsigned char*)kmla + (size_t)row * 3072 + pn * 192 + wc * 32 + 8 * fq) = pk8_fp8(acc[ai][0][m][0] * sc, acc[ai][0][m][1] * sc);
#else
                *(GAS u32x4*)(kmla + (size_t)row * 3072 + pn * 192 + wc * 32 + 8 * fq) = pk8(acc[ai][0][m][0] * sc, acc[ai][0][m][1] * sc);
#endif
                *(GAS u32x4*)(vmla + (size_t)row * 2048 + pn * 128 + wc * 32 + 8 * fq) = pk8(acc[ai][1][m][0] * sc, acc[ai][1][m][1] * sc);
                if (m & 1) asm volatile("" ::: "memory"); }
    }
};
#ifdef MLA_FP8V
struct EpiKup {
    static constexpr bool PERM = true, AFTER_DRAIN = false;
    unsigned char* ws;
    __device__ __forceinline__ void operator()(const f32x4 (&acc)[2][2][4][2], const Unit& u, int wr, int wc, int fr, int fq) const {
        const int pn = u.pn, row0 = u.pm * BM + wr * 64 + fr;
#pragma unroll
        for (int ai = 0; ai < 2; ++ai)
#pragma unroll
            for (int m = 0; m < 4; ++m) { const int row = row0 + ai * HALF + m * 16;
                const float sc = *(const GAS float*)((const float*)(ws + WS_RSTD) + S + row); unsigned char* k8 = ws + WS_KMLA + (size_t)row * 3072;
#pragma unroll
                for (int bj = 0; bj < 2; ++bj) *(GAS u32x2*)(k8 + (2 * pn + bj) * 192 + wc * 32 + 8 * fq) = pk8_fp8(acc[ai][bj][m][0] * sc, acc[ai][bj][m][1] * sc);
                if (m & 1) asm volatile("" ::: "memory"); }
    }
};
struct EpiVt {
    static constexpr bool PERM = true, AFTER_DRAIN = false;
    unsigned char* ws;
    __device__ __forceinline__ void operator()(const f32x4 (&acc)[2][2][4][2], const Unit& u, int wr, int wc, int fr, int fq) const {
        const int row0 = u.pm * BM + wr * 64 + fr, col0 = u.pn * BM + wc * 32 + 8 * fq;
        const float* rs = (const float*)(ws + WS_RSTD) + S;
        f32x4 sc[2][2];
#pragma unroll
        for (int bj = 0; bj < 2; ++bj) { sc[bj][0] = *(const GAS f32x4*)(rs + col0 + bj * HALF); sc[bj][1] = *(const GAS f32x4*)(rs + col0 + bj * HALF + 4); }
        const int hi8 = (col0 >> 3) & 1; (void)hi8;
#pragma unroll
        for (int ai = 0; ai < 2; ++ai)
#pragma unroll
            for (int m = 0; m < 4; ++m) { unsigned char* vt = ws + WS_VMLA + (size_t)(row0 + ai * HALF + m * 16) * S;
#pragma unroll
                for (int bj = 0; bj < 2; ++bj) { const u32x2 w = pk8_fp8(acc[ai][bj][m][0] * sc[bj][0], acc[ai][bj][m][1] * sc[bj][1]);
#ifdef MLA_MX
                    unsigned char* d64 = vt + ((col0 + bj * HALF) & ~63) + 4 * ((col0 >> 3) & 7);
                    *(GAS unsigned*)(d64) = w.x; *(GAS unsigned*)(d64 + 32) = w.y; } }
#else
                    unsigned char* d16 = vt + ((col0 + bj * HALF) & ~15);
                    *(GAS unsigned*)(d16 + (hi8 ? 4 : 0)) = w.x; *(GAS unsigned*)(d16 + (hi8 ? 12 : 8)) = w.y; } }
#endif
    }
};
#endif
struct EpiOut {
    static constexpr bool PERM = true, AFTER_DRAIN = false;
    bf16_t* y; const float* gate;
    __device__ __forceinline__ void operator()(const f32x4 (&acc)[2][2][4][2], const Unit& u, int wr, int wc, int fr, int fq) const {
        const int row0 = u.pm * BM + wr * 64 + fr, col0 = u.pn * BM + wc * 32 + 8 * fq;
        f32x4 gv[2][2];
#pragma unroll
        for (int bj = 0; bj < 2; ++bj)
#pragma unroll
            for (int n = 0; n < 2; ++n) gv[bj][n] = *(const GAS f32x4*)(gate + col0 + bj * HALF + n * 4);
#pragma unroll
        for (int ai = 0; ai < 2; ++ai)
#pragma unroll
            for (int m = 0; m < 4; ++m) { bf16_t* dst = y + (size_t)(row0 + ai * HALF + m * 16) * D + col0;
#pragma unroll
                for (int bj = 0; bj < 2; ++bj) *(GAS u32x4*)(dst + bj * HALF) = pk8(gv[bj][0] * acc[ai][bj][m][0], gv[bj][1] * acc[ai][bj][m][1]);
                if (m & 1) asm volatile("" ::: "memory"); }
    }
};
template <class Epi, class Sched, bool ALIGN_EPI = false, bool SP2 = false, int SCB = 0, int SCA = 0>
__device__ __forceinline__ void gemm_phase(PG8_LAS unsigned char* lds, const Gemm g, const Sched& S, const Epi& E) {
    int tid_ = threadIdx.x; asm volatile("" : "+v"(tid_));
    const int tid = tid_, wid = __builtin_amdgcn_readfirstlane(tid >> 6), lane = tid & 63, wr = wid >> 2, wc = wid & 3, fr = lane & 15, fq = lane >> 4;
    const int K = g.K, nt = K / BK;
    unsigned voffA[2], voffB[2];
#pragma unroll
    for (int i = 0; i < 2; ++i) { int R, C; stage_rc(tid * 16 + i * 8192, R, C); const int Rb = Epi::PERM ? ((R & ~31) + perm32(R & 31)) : R;
        voffA[i] = (unsigned)(R * K + C) * 2u; voffB[i] = (unsigned)(Rb * K + C) * 2u; }
    const size_t kstep = (size_t)(BK * 2);
    const size_t hstep = (size_t)HALF * K * 2;
    const size_t tstep = 2 * hstep;
    const unsigned ldsw = (unsigned)wid * 1024u;
    const int aoff = lds_byte(wr * 64 + fr, fq * 8), boff = lds_byte(wc * 32 + fr, fq * 8);
#define PG8_SA(b, h) (((b) * 2 + (h)) * HTB)
#define PG8_SB(b, h) ((4 + (b) * 2 + (h)) * HTB)
#define PG8_STAGE(bufoff, gbase, voff) do { _Pragma("unroll") for (int _i = 0; _i < 2; ++_i) \
        __builtin_amdgcn_global_load_lds((const unsigned*)((const char*)(gbase) + (voff)[_i]), (PG8_LAS unsigned*)(lds + (bufoff) + ldsw + _i * 8192), 16, 0, 0); } while (0)
#define PG8_LDA(dst, b, h) do { if constexpr (SCB != 0) { _Pragma("unroll") for (int m = 0; m < 4; ++m) dst##8[m] = ld2x16(lds + PG8_SA(b, h) + aoff + m * 2048); } \
        else { _Pragma("unroll") for (int m = 0; m < 4; ++m) _Pragma("unroll") for (int k = 0; k < 2; ++k) dst[m][k] = *(const PG8_LAS bf16x8*)(lds + PG8_SA(b, h) + aoff + m * 2048 + k * 1024); } } while (0)
#define PG8_LDB(dst, b, h) do { if constexpr (SCB != 0) { _Pragma("unroll") for (int n = 0; n < 2; ++n) dst##8[n] = ld2x16(lds + PG8_SB(b, h) + boff + n * 2048); } \
        else { _Pragma("unroll") for (int n = 0; n < 2; ++n) _Pragma("unroll") for (int k = 0; k < 2; ++k) dst[n][k] = *(const PG8_LAS bf16x8*)(lds + PG8_SB(b, h) + boff + n * 2048 + k * 1024); } } while (0)
#define PG8_MMA(ai, bj, At, Bt) do { __builtin_amdgcn_s_setprio(1); \
        if constexpr (SCB != 0) { _Pragma("unroll") for (int m = 0; m < 4; ++m) _Pragma("unroll") for (int n = 0; n < 2; ++n) \
            asm volatile("v_mfma_scale_f32_16x16x128_f8f6f4 %0, %1, %2, %0, %3, %4 op_sel_hi:[0,0,0]" : "+v"(acc[ai][bj][m][n]) : "v"(Bt##8[n]), "v"(At##8[m]), "v"(scb_), "v"(sca_)); } \
        else { _Pragma("unroll") for (int m = 0; m < 4; ++m) _Pragma("unroll") for (int n = 0; n < 2; ++n) _Pragma("unroll") for (int k = 0; k < 2; ++k) \
            acc[ai][bj][m][n] = __builtin_amdgcn_mfma_f32_16x16x32_bf16(Bt[n][k], At[m][k], acc[ai][bj][m][n], 0, 0, 0); } \
        __builtin_amdgcn_s_setprio(0); } while (0)
#define PG8_WAIT_V(n) asm volatile("s_waitcnt vmcnt(" #n ")" ::: "memory")
#define PG8_WAIT_L(n) asm volatile("s_waitcnt lgkmcnt(" #n ")" ::: "memory")
#define PG8_BAR __builtin_amdgcn_s_barrier()
#define PG8_SCHED __builtin_amdgcn_sched_barrier(0)
    Unit cur, nxt; int ui = 0;
    if (!S.next(0, cur)) return;
    f32x4 acc[2][2][4][2];
#pragma unroll
    for (int a = 0; a < 2; ++a)
#pragma unroll
        for (int b = 0; b < 2; ++b)
#pragma unroll
            for (int m = 0; m < 4; ++m)
#pragma unroll
                for (int n = 0; n < 2; ++n) acc[a][b][m][n] = (f32x4){0.f, 0.f, 0.f, 0.f};
    int scb_ = SCB, sca_ = SCA; asm volatile("" : "+v"(scb_), "+v"(sca_));
    bf16x8 At[4][2], B0[2][2], B1[2][2]; i32x8 At8[4], B08[2], B18[2];
    const char* cA = (const char*)g.A + (size_t)cur.pm * tstep; const char* cB = (const char*)g.Bt + (size_t)cur.pn * tstep;
    S.a_ready(cur);
    if constexpr (SP2) {
        PG8_STAGE(PG8_SB(0, 0), cB, voffB); PG8_STAGE(PG8_SB(0, 1), cB + hstep, voffB); PG8_STAGE(PG8_SA(0, 0), cA, voffA); PG8_STAGE(PG8_SA(0, 1), cA + hstep, voffA);
        if (wr == 1) PG8_BAR;
        PG8_WAIT_V(2); PG8_BAR;
        PG8_STAGE(PG8_SB(1, 0), cB + kstep, voffB); PG8_STAGE(PG8_SA(1, 0), cA + kstep, voffA); PG8_STAGE(PG8_SB(1, 1), cB + hstep + kstep, voffB);
        PG8_WAIT_V(6); PG8_BAR;
    } else {
        PG8_STAGE(PG8_SB(0, 0), cB, voffB); PG8_STAGE(PG8_SA(0, 0), cA, voffA); PG8_STAGE(PG8_SB(0, 1), cB + hstep, voffB); PG8_STAGE(PG8_SA(0, 1), cA + hstep, voffA);
        if (wr == 1) PG8_BAR;
        PG8_WAIT_V(4); PG8_BAR;
        PG8_STAGE(PG8_SB(1, 0), cB + kstep, voffB); PG8_STAGE(PG8_SA(1, 0), cA + kstep, voffA); PG8_STAGE(PG8_SB(1, 1), cB + hstep + kstep, voffB);
        PG8_WAIT_V(6); PG8_BAR;
    }
    for (;;) {
        const bool has_next = S.next(ui + 1, nxt);
        const char* nA = has_next ? (const char*)g.A + (size_t)nxt.pm * tstep : cA; const char* nB = has_next ? (const char*)g.Bt + (size_t)nxt.pn * tstep : cB;
#pragma unroll 1
        for (int t = 0; t < nt; t += 2) {
            const bool last = (t == nt - 2);
            const char* a1 = cA + (size_t)(t + 1) * kstep;
            const char* a2 = last ? nA : cA + (size_t)(t + 2) * kstep; const char* b2 = last ? nB : cB + (size_t)(t + 2) * kstep;
            const char* a3 = a2 + kstep; const char* b3 = b2 + kstep;
            if (last && has_next) S.a_ready(nxt);
            if constexpr (SP2) {
            PG8_LDB(B0, 0, 0); PG8_LDB(B1, 0, 1); PG8_SCHED; PG8_LDA(At, 0, 0); PG8_STAGE(PG8_SA(1, 1), a1 + hstep, voffA);
            PG8_WAIT_V(8); PG8_WAIT_L(0); PG8_BAR; PG8_MMA(0, 0, At, B0); PG8_MMA(0, 1, At, B1); PG8_BAR; PG8_SCHED;
            PG8_LDA(At, 0, 1); PG8_STAGE(PG8_SB(0, 0), b2, voffB); PG8_STAGE(PG8_SB(0, 1), b2 + hstep, voffB); PG8_STAGE(PG8_SA(0, 0), a2, voffA);
            PG8_WAIT_V(8); PG8_WAIT_L(0); PG8_BAR; PG8_MMA(1, 0, At, B0); PG8_MMA(1, 1, At, B1); PG8_BAR; PG8_SCHED;
            PG8_LDB(B0, 1, 0); PG8_LDB(B1, 1, 1); PG8_SCHED; PG8_LDA(At, 1, 0); PG8_STAGE(PG8_SA(0, 1), a2 + hstep, voffA);
            PG8_WAIT_V(8); PG8_WAIT_L(0); PG8_BAR; PG8_MMA(0, 0, At, B0); PG8_MMA(0, 1, At, B1); PG8_BAR; PG8_SCHED;
            PG8_LDA(At, 1, 1); PG8_STAGE(PG8_SB(1, 0), b3, voffB); PG8_STAGE(PG8_SB(1, 1), b3 + hstep, voffB); PG8_STAGE(PG8_SA(1, 0), a3, voffA);
            PG8_WAIT_V(8); PG8_WAIT_L(0); PG8_BAR; PG8_MMA(1, 0, At, B0); PG8_MMA(1, 1, At, B1); PG8_BAR; PG8_SCHED;
            } else {
            PG8_LDB(B0, 0, 0); PG8_SCHED; PG8_LDA(At, 0, 0); PG8_STAGE(PG8_SA(1, 1), a1 + hstep, voffA);
            PG8_WAIT_L(8); PG8_BAR; PG8_WAIT_L(0); PG8_MMA(0, 0, At, B0); PG8_BAR; PG8_SCHED;
            PG8_LDB(B1, 0, 1); PG8_STAGE(PG8_SB(0, 0), b2, voffB);
            PG8_BAR; PG8_WAIT_L(0); PG8_MMA(0, 1, At, B1); PG8_BAR;
            PG8_LDA(At, 0, 1); PG8_STAGE(PG8_SA(0, 0), a2, voffA);
            PG8_BAR; PG8_WAIT_L(0); PG8_MMA(1, 0, At, B0); PG8_BAR; PG8_SCHED;
            PG8_STAGE(PG8_SB(0, 1), b2 + hstep, voffB);
            PG8_WAIT_V(6); PG8_BAR; PG8_MMA(1, 1, At, B1); PG8_BAR;
            PG8_LDB(B0, 1, 0); PG8_SCHED; PG8_LDA(At, 1, 0); PG8_STAGE(PG8_SA(0, 1), a2 + hstep, voffA);
            PG8_WAIT_L(8); PG8_BAR; PG8_WAIT_L(0); PG8_MMA(0, 0, At, B0); PG8_BAR; PG8_SCHED;
            PG8_LDB(B1, 1, 1); PG8_STAGE(PG8_SB(1, 0), b3, voffB);
            PG8_BAR; PG8_WAIT_L(0); PG8_MMA(0, 1, At, B1); PG8_BAR;
            PG8_LDA(At, 1, 1); PG8_STAGE(PG8_SA(1, 0), a3, voffA);
            PG8_BAR; PG8_WAIT_L(0); PG8_MMA(1, 0, At, B0); PG8_BAR; PG8_SCHED;
            PG8_STAGE(PG8_SB(1, 1), b3 + hstep, voffB);
            PG8_WAIT_V(6); PG8_BAR; PG8_MMA(1, 1, At, B1); PG8_BAR;
            }
        }
        if constexpr (SCB != 0) asm volatile("s_nop 15\n\ts_nop 15" ::: "memory");
        if constexpr (ALIGN_EPI) { if (wr == 0) PG8_BAR; }
        if constexpr (!Epi::AFTER_DRAIN) { int fr_ = fr, fq_ = fq; asm volatile("" : "+v"(fr_), "+v"(fq_));
            E(acc, cur, wr, wc, fr_, fq_); S.done(cur); }
        if (!has_next) break;
#pragma unroll
        for (int a = 0; a < 2; ++a)
#pragma unroll
            for (int b = 0; b < 2; ++b)
#pragma unroll
                for (int m = 0; m < 4; ++m)
#pragma unroll
                    for (int n = 0; n < 2; ++n) acc[a][b][m][n] = (f32x4){0.f, 0.f, 0.f, 0.f};
        cur = nxt; cA = nA; cB = nB; ++ui;
        if constexpr (ALIGN_EPI) { if (wr == 1) PG8_BAR; }
    }
    PG8_WAIT_V(0);
    if constexpr (!ALIGN_EPI) { if (wr == 0) PG8_BAR; }
    PG8_BAR;
    if constexpr (Epi::AFTER_DRAIN) { E.fused(acc, cur, wr, wc, fr, fq, lds, wid, lane); S.done(cur); }
#undef PG8_SA
#undef PG8_SB
#undef PG8_STAGE
#undef PG8_LDA
#undef PG8_LDB
#undef PG8_MMA
#undef PG8_WAIT_V
#undef PG8_WAIT_L
#undef PG8_BAR
#undef PG8_SCHED
}
}
namespace att {
constexpr int KS_M = 400, KS_N = 272, VS = 320;
constexpr int MLA_KB = 64 * KS_M, NSA_KB = 64 * KS_N, VB = 64 * VS;
constexpr int N_IMP = 2 * NSA_KB + 2 * VB;
constexpr int N_PART = N_IMP + 32768;
constexpr int N_PARTB = 8 * 32 * 17 * 4;
constexpr int N_SELM = N_PART + 2 * N_PARTB;
constexpr int N_ULIST = N_SELM + 1024;
constexpr int N_CARRY = N_ULIST + 1024;
constexpr int N_NTS = N_CARRY + 256;
static_assert(N_NTS + 16 <= MISC_OFF, "NSA LDS map");
static_assert(2 * MLA_KB + 3 * VB <= 131072, "MLA LDS map");
constexpr int MLA_QL = 2 * MLA_KB + 2 * VB;
static_assert(MLA_QL + 8 * 4096 <= 131072, "MLA LDS map (pipelined)");

#ifndef QK_PF
#define QK_PF 4
#endif
#define MFMA32(a, b, c) __builtin_amdgcn_mfma_f32_32x32x16_bf16((a), (b), (c), 0, 0, 0)
__device__ __forceinline__ float swapmax(float v) { auto rr = __builtin_amdgcn_permlane32_swap(__float_as_uint(v), __float_as_uint(v), false, false); return fmaxf(__uint_as_float(rr[0]), __uint_as_float(rr[1])); }
__device__ __forceinline__ float swapsum(float v) { auto rr = __builtin_amdgcn_permlane32_swap(__float_as_uint(v), __float_as_uint(v), false, false); return __uint_as_float(rr[0]) + __uint_as_float(rr[1]); }
template <int SIDX> __device__ __forceinline__ bf16x8 packp(const f32x16& p) {
    f32x8 t = {p[8 * SIDX + 0], p[8 * SIDX + 1], p[8 * SIDX + 2], p[8 * SIDX + 3], p[8 * SIDX + 4], p[8 * SIDX + 5], p[8 * SIDX + 6], p[8 * SIDX + 7]};
    return __builtin_bit_cast(bf16x8, __builtin_convertvector(t, bf16x8v));
}
template <int NDC, int KS, bool ZERO = true> __device__ __forceinline__ void qk_tile(f32x16& p0, f32x16& p1, const LAS unsigned char* kl, const bf16x8 (&q)[NDC]) {
    if (ZERO) {
#pragma unroll
        for (int i = 0; i < 16; ++i) { p0[i] = 0.f; p1[i] = 0.f; }
    }
    constexpr int PF = QK_PF;
    bf16x8 a[PF + 1][2];
#pragma unroll
    for (int i = 0; i < PF; ++i) { a[i][0] = *(const LAS bf16x8*)(kl + i * 32); a[i][1] = *(const LAS bf16x8*)(kl + 32 * KS + i * 32); }
#pragma unroll
    for (int d0 = 0; d0 < NDC; ++d0) {
        if (d0 + PF < NDC) { a[(d0 + PF) % (PF + 1)][0] = *(const LAS bf16x8*)(kl + (d0 + PF) * 32); a[(d0 + PF) % (PF + 1)][1] = *(const LAS bf16x8*)(kl + 32 * KS + (d0 + PF) * 32); }
        __builtin_amdgcn_sched_barrier(0);
        p0 = MFMA32(a[d0 % (PF + 1)][0], q[d0], p0); p1 = MFMA32(a[d0 % (PF + 1)][1], q[d0], p1);
        __builtin_amdgcn_sched_barrier(0);
    }
}
#ifdef PROBE_QKM2
template <int NDC, int KS> __device__ __forceinline__ void qk_tile_m2(f32x16& p0, f32x16& p1, f32x16& r0, f32x16& r1, const LAS unsigned char* kl, const bf16x8 (&q)[NDC]) {
#pragma unroll
    for (int i = 0; i < 16; ++i) { p0[i] = 0.f; p1[i] = 0.f; r0[i] = 0.f; r1[i] = 0.f; }
    constexpr int PF = QK_PF;
    bf16x8 a[PF + 1][2];
#pragma unroll
    for (int i = 0; i < PF; ++i) { a[i][0] = *(const LAS bf16x8*)(kl + i * 32); a[i][1] = *(const LAS bf16x8*)(kl + 32 * KS + i * 32); }
#pragma unroll
    for (int d0 = 0; d0 < NDC; ++d0) {
        if (d0 + PF < NDC) { a[(d0 + PF) % (PF + 1)][0] = *(const LAS bf16x8*)(kl + (d0 + PF) * 32); a[(d0 + PF) % (PF + 1)][1] = *(const LAS bf16x8*)(kl + 32 * KS + (d0 + PF) * 32); }
        __builtin_amdgcn_sched_barrier(0);
        p0 = MFMA32(a[d0 % (PF + 1)][0], q[d0], p0); p1 = MFMA32(a[d0 % (PF + 1)][1], q[d0], p1);
        r0 = MFMA32(a[d0 % (PF + 1)][0], q[d0], r0); r1 = MFMA32(a[d0 % (PF + 1)][1], q[d0], r1);
        __builtin_amdgcn_sched_barrier(0);
    }
}
#endif
__device__ __forceinline__ void pv_tile(f32x16 (&o)[4], const bf16x8 (&pb)[4], const LAS unsigned char* vl) {
    s16x4 f[5][2];
#define PV_LD(idx) do { constexpr int d_ = (idx) >> 2, s_ = (idx) & 3; \
        f[(idx) % 5][0] = __builtin_amdgcn_ds_read_tr16_b64_v4i16((LAS s16x4*)(vl + s_ * 16 * VS + d_ * 64)); \
        f[(idx) % 5][1] = __builtin_amdgcn_ds_read_tr16_b64_v4i16((LAS s16x4*)(vl + s_ * 16 * VS + 8 * VS + d_ * 64)); } while (0)
    PV_LD(0); PV_LD(1); PV_LD(2); PV_LD(3);
#define PV_STEP(idx) do { if ((idx) + 4 < 16) PV_LD((idx) + 4); __builtin_amdgcn_sched_barrier(0); \
        { const s16x4 t0_ = f[(idx) % 5][0], t1_ = f[(idx) % 5][1]; const bf16x8 vf_ = {t0_[0], t0_[1], t0_[2], t0_[3], t1_[0], t1_[1], t1_[2], t1_[3]}; \
          o[(idx) >> 2] = MFMA32(vf_, pb[(idx) & 3], o[(idx) >> 2]); } __builtin_amdgcn_sched_barrier(0); } while (0)
    PV_STEP(0); PV_STEP(1); PV_STEP(2); PV_STEP(3); PV_STEP(4); PV_STEP(5); PV_STEP(6); PV_STEP(7);
    PV_STEP(8); PV_STEP(9); PV_STEP(10); PV_STEP(11); PV_STEP(12); PV_STEP(13); PV_STEP(14); PV_STEP(15);
#undef PV_STEP
#undef PV_LD
}
template <int NDC, int NQR, int KS> __device__ __forceinline__ void qk_tile_free(f32x16& p0, f32x16& p1, const LAS unsigned char* kl, const bf16x8 (&q)[NQR], const LAS unsigned char* ql) {
#pragma unroll
    for (int i = 0; i < 16; ++i) { p0[i] = 0.f; p1[i] = 0.f; }
#pragma unroll
    for (int d0 = 0; d0 < NDC; ++d0) {
        const bf16x8 a0 = *(const LAS bf16x8*)(kl + d0 * 32);
        const bf16x8 a1 = *(const LAS bf16x8*)(kl + 32 * KS + d0 * 32);
        bf16x8 qq; if (d0 < NQR) qq = q[d0 < NQR ? d0 : 0]; else qq = *(const LAS bf16x8*)(ql + (d0 - NQR) * 1024);
        p0 = MFMA32(a0, qq, p0); p1 = MFMA32(a1, qq, p1);
    }
}
__device__ __forceinline__ float sm_core(f32x16& p0, f32x16& p1, float& m, float& l) {
    float tm = p0[0];
#pragma unroll
    for (int r = 1; r < 16; ++r) tm = fmaxf(tm, p0[r]);
#pragma unroll
    for (int r = 0; r < 16; ++r) tm = fmaxf(tm, p1[r]);
    tm = swapmax(tm);
    const float mn = fmaxf(m, tm);
    const float alpha = __builtin_amdgcn_exp2f(m - mn);
    m = mn;
    float ps = 0.f;
#pragma unroll
    for (int r = 0; r < 16; ++r) { p0[r] = __builtin_amdgcn_exp2f(p0[r] - mn); ps += p0[r]; }
#pragma unroll
    for (int r = 0; r < 16; ++r) { p1[r] = __builtin_amdgcn_exp2f(p1[r] - mn); ps += p1[r]; }
    ps = swapsum(ps);
    l = l * alpha + ps;
    return alpha;
}
__device__ __forceinline__ void online_sm(f32x16& p0, f32x16& p1, float& m, float& l, f32x16 (&o)[4]) {
    float tm = p0[0];
#pragma unroll
    for (int r = 1; r < 16; ++r) tm = fmaxf(tm, p0[r]);
#pragma unroll
    for (int r = 0; r < 16; ++r) tm = fmaxf(tm, p1[r]);
    tm = swapmax(tm);
    const float mn = fmaxf(m, tm);
    const float alpha = __builtin_amdgcn_exp2f(m - mn);
    m = mn;
    float ps = 0.f;
#pragma unroll
    for (int r = 0; r < 16; ++r) { p0[r] = __builtin_amdgcn_exp2f(p0[r] - mn); ps += p0[r]; }
#pragma unroll
    for (int r = 0; r < 16; ++r) { p1[r] = __builtin_amdgcn_exp2f(p1[r] - mn); ps += p1[r]; }
    ps = swapsum(ps);
    l = l * alpha + ps;
    if (!__all(alpha == 1.f)) {
#pragma unroll
        for (int d = 0; d < 4; ++d)
#pragma unroll
            for (int r = 0; r < 16; ++r) o[d][r] *= alpha;
    }
}

#ifdef MLA_FP8
typedef long i64;
constexpr int KS8 = 200, MLA_KB8 = 64 * KS8;
static_assert(2 * MLA_KB8 + 3 * VB <= 131072, "MLA fp8 LDS map");
#define MFMA32F8(a, b, c) __builtin_amdgcn_mfma_f32_32x32x16_fp8_fp8((a), (b), (c), 0, 0, 0)
template <int NDC> __device__ __forceinline__ void qk_tile8(f32x16& p0, f32x16& p1, const LAS unsigned char* kl, const i64 (&q)[NDC]) {
#pragma unroll
    for (int i = 0; i < 16; ++i) { p0[i] = 0.f; p1[i] = 0.f; }
    constexpr int PF = 4;
    i64 a[PF + 1][2];
#pragma unroll
    for (int i = 0; i < PF; ++i) { a[i][0] = *(const LAS i64*)(kl + i * 16); a[i][1] = *(const LAS i64*)(kl + 32 * KS8 + i * 16); }
#pragma unroll
    for (int d0 = 0; d0 < NDC; ++d0) {
        if (d0 + PF < NDC) { a[(d0 + PF) % (PF + 1)][0] = *(const LAS i64*)(kl + (d0 + PF) * 16); a[(d0 + PF) % (PF + 1)][1] = *(const LAS i64*)(kl + 32 * KS8 + (d0 + PF) * 16); }
        __builtin_amdgcn_sched_barrier(0);
        __builtin_amdgcn_s_setprio(1);
        p0 = MFMA32F8(a[d0 % (PF + 1)][0], q[d0], p0); p1 = MFMA32F8(a[d0 % (PF + 1)][1], q[d0], p1);
        __builtin_amdgcn_s_setprio(0);
        __builtin_amdgcn_sched_barrier(0);
    }
}
__device__ __forceinline__ void online_sm_scaled(f32x16& p0, f32x16& p1, float& m, float& l, f32x16 (&o)[4], const float C2) {
    float tm = p0[0];
#pragma unroll
    for (int r = 1; r < 16; ++r) tm = fmaxf(tm, p0[r]);
#pragma unroll
    for (int r = 0; r < 16; ++r) tm = fmaxf(tm, p1[r]);
    tm = swapmax(tm);
    const float mn = fmaxf(m, tm);
    const float alpha = __builtin_amdgcn_exp2f((m - mn) * C2);
    m = mn;
    const float mc = -mn * C2;
    float ps = 0.f;
#pragma unroll
    for (int r = 0; r < 16; ++r) { p0[r] = __builtin_amdgcn_exp2f(__builtin_fmaf(p0[r], C2, mc)); ps += p0[r]; }
#pragma unroll
    for (int r = 0; r < 16; ++r) { p1[r] = __builtin_amdgcn_exp2f(__builtin_fmaf(p1[r], C2, mc)); ps += p1[r]; }
    ps = swapsum(ps);
    l = l * alpha + ps;
    if (!__all(alpha == 1.f)) {
#pragma unroll
        for (int d = 0; d < 4; ++d)
#pragma unroll
            for (int r = 0; r < 16; ++r) o[d][r] *= alpha;
    }
}
#endif
#ifdef MLA_FP8V
constexpr int VS8 = 72, VB8 = 128 * VS8;
constexpr int VS8B = 136, VB8B = 128 * VS8B, MLA_KB8B = 128 * KS8;
static_assert(2 * MLA_KB8B + 3 * VB8B <= 131072, "MLA big-tile LDS map");
#ifdef MLA_BIG
#define PV8_RS VS8B
#else
#define PV8_RS VS8
#endif
static_assert(2 * MLA_KB8 + 3 * VB8 <= 131072, "MLA fp8 LDS map");
template <int SIDX> __device__ __forceinline__ i64 packp8(const f32x16& p) {
    int w0 = __builtin_amdgcn_cvt_pk_fp8_f32(p[8 * SIDX + 0] * 256.f, p[8 * SIDX + 1] * 256.f, 0, false); w0 = __builtin_amdgcn_cvt_pk_fp8_f32(p[8 * SIDX + 2] * 256.f, p[8 * SIDX + 3] * 256.f, w0, true);
    int w1 = __builtin_amdgcn_cvt_pk_fp8_f32(p[8 * SIDX + 4] * 256.f, p[8 * SIDX + 5] * 256.f, 0, false); w1 = __builtin_amdgcn_cvt_pk_fp8_f32(p[8 * SIDX + 6] * 256.f, p[8 * SIDX + 7] * 256.f, w1, true);
    return (i64)(((unsigned long long)(unsigned)w1 << 32) | (unsigned)w0);
}
__device__ __forceinline__ void pv_tile8(f32x16 (&o)[4], const i64 (&pb)[4], const LAS unsigned char* vl) {
    i64 f[5];
#define PV8_LD(idx) f[(idx) % 5] = *(const LAS i64*)(vl + ((idx) >> 2) * 32 * PV8_RS + ((idx) & 3) * 16)
    PV8_LD(0); PV8_LD(1); PV8_LD(2); PV8_LD(3);
#define PV8_STEP(idx) do { if ((idx) + 4 < 16) PV8_LD((idx) + 4); __builtin_amdgcn_sched_barrier(0); \
        o[(idx) >> 2] = MFMA32F8(f[(idx) % 5], pb[(idx) & 3], o[(idx) >> 2]); __builtin_amdgcn_sched_barrier(0); } while (0)
    PV8_STEP(0); PV8_STEP(1); PV8_STEP(2); PV8_STEP(3); PV8_STEP(4); PV8_STEP(5); PV8_STEP(6); PV8_STEP(7);
    PV8_STEP(8); PV8_STEP(9); PV8_STEP(10); PV8_STEP(11); PV8_STEP(12); PV8_STEP(13); PV8_STEP(14); PV8_STEP(15);
#undef PV8_STEP
#undef PV8_LD
}
#endif
#ifdef MLA_MX
typedef int i32x8 __attribute__((ext_vector_type(8)));
constexpr int KSX = 208, MLA_KBX = 64 * KSX;
constexpr int VSX = 80, VBX = 128 * VSX;
static_assert(2 * MLA_KBX + 3 * VBX <= 131072, "MLA mx LDS map");
#define MFMAX(a, b, c) __builtin_amdgcn_mfma_scale_f32_32x32x64_f8f6f4((a), (b), (c), 0, 0, 0, 0x7f7f7f7f, 0, 0x7f7f7f7f)
__device__ __forceinline__ i32x8 ldsx(const LAS unsigned char* p) {
    const u32x4 a = *(const LAS u32x4*)p, b = *(const LAS u32x4*)(p + 16);
    return (i32x8){(int)a.x, (int)a.y, (int)a.z, (int)a.w, (int)b.x, (int)b.y, (int)b.z, (int)b.w};
}
__device__ __forceinline__ void qk_tilex(f32x16& p0, f32x16& p1, const LAS unsigned char* kl, const i32x8 (&q)[3]) {
#pragma unroll
    for (int i = 0; i < 16; ++i) { p0[i] = 0.f; p1[i] = 0.f; }
    i32x8 a0 = ldsx(kl), a1 = ldsx(kl + 32 * KSX), a2 = ldsx(kl + 64), a3 = ldsx(kl + 32 * KSX + 64);
    __builtin_amdgcn_sched_barrier(0);
    __builtin_amdgcn_s_setprio(1);
    p0 = MFMAX(a0, q[0], p0); p1 = MFMAX(a1, q[0], p1);
    __builtin_amdgcn_s_setprio(0);
    __builtin_amdgcn_sched_barrier(0);
    a0 = ldsx(kl + 128); a1 = ldsx(kl + 32 * KSX + 128);
    __builtin_amdgcn_sched_barrier(0);
    __builtin_amdgcn_s_setprio(1);
    p0 = MFMAX(a2, q[1], p0); p1 = MFMAX(a3, q[1], p1);
    __builtin_amdgcn_sched_barrier(0);
    p0 = MFMAX(a0, q[2], p0); p1 = MFMAX(a1, q[2], p1);
    __builtin_amdgcn_s_setprio(0);
    __builtin_amdgcn_sched_barrier(0);
}
__device__ __forceinline__ void pv_tilex(f32x16 (&o)[4], const i32x8& pb, const LAS unsigned char* vl) {
    i32x8 f0 = ldsx(vl), f1 = ldsx(vl + 32 * VSX);
    __builtin_amdgcn_sched_barrier(0);
    o[0] = MFMAX(f0, pb, o[0]);
    __builtin_amdgcn_sched_barrier(0);
    f0 = ldsx(vl + 64 * VSX);
    __builtin_amdgcn_sched_barrier(0);
    o[1] = MFMAX(f1, pb, o[1]);
    __builtin_amdgcn_sched_barrier(0);
    f1 = ldsx(vl + 96 * VSX);
    __builtin_amdgcn_sched_barrier(0);
    o[2] = MFMAX(f0, pb, o[2]);
    __builtin_amdgcn_sched_barrier(0);
    o[3] = MFMAX(f1, pb, o[3]);
    __builtin_amdgcn_sched_barrier(0);
}
__device__ __forceinline__ i32x8 packpx(const f32x16& p0, const f32x16& p1) {
    i32x8 w;
#pragma unroll
    for (int g = 0; g < 4; ++g) {
        int a = __builtin_amdgcn_cvt_pk_fp8_f32(p0[4 * g + 0], p0[4 * g + 1], 0, false); a = __builtin_amdgcn_cvt_pk_fp8_f32(p0[4 * g + 2], p0[4 * g + 3], a, true); w[g] = a;
        int b = __builtin_amdgcn_cvt_pk_fp8_f32(p1[4 * g + 0], p1[4 * g + 1], 0, false); b = __builtin_amdgcn_cvt_pk_fp8_f32(p1[4 * g + 2], p1[4 * g + 3], b, true); w[4 + g] = b;
    }
    return w;
}
__device__ __forceinline__ void online_sm_x(f32x16& p0, f32x16& p1, float& m, float& l, f32x16 (&o)[4], const float C2) {
    float tm = p0[0];
#pragma unroll
    for (int r = 1; r < 16; ++r) tm = fmaxf(tm, p0[r]);
#pragma unroll
    for (int r = 0; r < 16; ++r) tm = fmaxf(tm, p1[r]);
    tm = swapmax(tm);
    const float mn = fmaxf(m, tm);
    const float alpha = __builtin_amdgcn_exp2f((m - mn) * C2);
    m = mn;
    const float mc = 8.f - mn * C2;
    float ps = 0.f;
#pragma unroll
    for (int r = 0; r < 16; ++r) { p0[r] = __builtin_amdgcn_exp2f(__builtin_fmaf(p0[r], C2, mc)); ps += p0[r]; }
#pragma unroll
    for (int r = 0; r < 16; ++r) { p1[r] = __builtin_amdgcn_exp2f(__builtin_fmaf(p1[r], C2, mc)); ps += p1[r]; }
    ps = swapsum(ps);
    l = l * alpha + ps;
    if (!__all(alpha == 1.f)) {
#pragma unroll
        for (int d = 0; d < 4; ++d)
#pragma unroll
            for (int r = 0; r < 16; ++r) o[d][r] *= alpha;
    }
}
#endif
#ifdef MLA_MXL
#ifdef MLA_MXU
#define MXL_T 126.0f
#define MXL_REF 120.0f
#define MFMAXQ(a, b, c) __builtin_amdgcn_mfma_scale_f32_32x32x64_f8f6f4((a), (b), (c), 0, 0, 0, 0x7f7f7f7f, 0, 0x7f7f7f7f)
__device__ __forceinline__ i32x8 byte_packx(const f32x16& p0, const f32x16& p1) {
    i32x8 w;
#pragma unroll
    for (int g = 0; g < 4; ++g) {
        unsigned a = __builtin_amdgcn_cvt_pk_u8_f32(p0[4 * g + 0], 0, 0u); a = __builtin_amdgcn_cvt_pk_u8_f32(p0[4 * g + 1], 1, a); a = __builtin_amdgcn_cvt_pk_u8_f32(p0[4 * g + 2], 2, a); a = __builtin_amdgcn_cvt_pk_u8_f32(p0[4 * g + 3], 3, a); w[g] = (int)a;
        unsigned b = __builtin_amdgcn_cvt_pk_u8_f32(p1[4 * g + 0], 0, 0u); b = __builtin_amdgcn_cvt_pk_u8_f32(p1[4 * g + 1], 1, b); b = __builtin_amdgcn_cvt_pk_u8_f32(p1[4 * g + 2], 2, b); b = __builtin_amdgcn_cvt_pk_u8_f32(p1[4 * g + 3], 3, b); w[4 + g] = (int)b;
    }
    return w;
}
#else
#define MXL_T 7.0f
#define MXL_REF 0.0f
#define MFMAXQ(a, b, c) __builtin_amdgcn_mfma_scale_f32_32x32x64_f8f6f4((a), (b), (c), 0, 0, 0, 0x7f7f7f7f, 0, 0x7c7c7c7c)
#endif
__device__ __forceinline__ void qk_tilexl(f32x16& p0, f32x16& p1, const f32x16& mref, const LAS unsigned char* kl, const i32x8 (&q)[3]) {
    i32x8 a0 = ldsx(kl), a1 = ldsx(kl + 32 * KSX), a2 = ldsx(kl + 64), a3 = ldsx(kl + 32 * KSX + 64);
    __builtin_amdgcn_sched_barrier(0);
    __builtin_amdgcn_s_setprio(1);
    p0 = MFMAXQ(a0, q[0], mref); p1 = MFMAXQ(a1, q[0], mref);
    __builtin_amdgcn_s_setprio(0);
    __builtin_amdgcn_sched_barrier(0);
    a0 = ldsx(kl + 128); a1 = ldsx(kl + 32 * KSX + 128);
    __builtin_amdgcn_sched_barrier(0);
    __builtin_amdgcn_s_setprio(1);
    p0 = MFMAXQ(a2, q[1], p0); p1 = MFMAXQ(a3, q[1], p1);
    __builtin_amdgcn_sched_barrier(0);
    p0 = MFMAXQ(a0, q[2], p0); p1 = MFMAXQ(a1, q[2], p1);
    __builtin_amdgcn_s_setprio(0);
    __builtin_amdgcn_sched_barrier(0);
}
template <int RS = VSX>
__device__ __forceinline__ void pv_tilexl(f32x16 (&o)[5], const i32x8& pb, const i32x8& ones, const LAS unsigned char* vl) {
    i32x8 f0 = ldsx(vl), f1 = ldsx(vl + 32 * RS);
    __builtin_amdgcn_sched_barrier(0);
    o[4] = MFMAX(ones, pb, o[4]);
    __builtin_amdgcn_sched_barrier(0);
    o[0] = MFMAX(f0, pb, o[0]);
    __builtin_amdgcn_sched_barrier(0);
    f0 = ldsx(vl + 64 * RS);
    __builtin_amdgcn_sched_barrier(0);
    o[1] = MFMAX(f1, pb, o[1]);
    __builtin_amdgcn_sched_barrier(0);
    f1 = ldsx(vl + 96 * RS);
    __builtin_amdgcn_sched_barrier(0);
    o[2] = MFMAX(f0, pb, o[2]);
    __builtin_amdgcn_sched_barrier(0);
    o[3] = MFMAX(f1, pb, o[3]);
    __builtin_amdgcn_sched_barrier(0);
}
__device__ __forceinline__ i32x8 exp_packx(const f32x16& p0, const f32x16& p1, int any) {
    i32x8 w;
#pragma unroll
    for (int g = 0; g < 4; ++g) {
        int a = __builtin_amdgcn_cvt_pk_fp8_f32(__builtin_amdgcn_exp2f(p0[4 * g + 0]), __builtin_amdgcn_exp2f(p0[4 * g + 1]), any, false);
        a = __builtin_amdgcn_cvt_pk_fp8_f32(__builtin_amdgcn_exp2f(p0[4 * g + 2]), __builtin_amdgcn_exp2f(p0[4 * g + 3]), a, true); w[g] = a;
        int b = __builtin_amdgcn_cvt_pk_fp8_f32(__builtin_amdgcn_exp2f(p1[4 * g + 0]), __builtin_amdgcn_exp2f(p1[4 * g + 1]), any, false);
        b = __builtin_amdgcn_cvt_pk_fp8_f32(__builtin_amdgcn_exp2f(p1[4 * g + 2]), __builtin_amdgcn_exp2f(p1[4 * g + 3]), b, true); w[4 + g] = b;
    }
    return w;
}
#endif
#ifdef MLA_PIPE8
template <int NDC> __device__ __forceinline__ void qk_tile8_free(f32x16& p0, f32x16& p1, const LAS unsigned char* kl, const i64 (&q)[NDC]) {
#pragma unroll
    for (int i = 0; i < 16; ++i) { p0[i] = 0.f; p1[i] = 0.f; }
#pragma unroll
    for (int d0 = 0; d0 < NDC; ++d0) {
        const i64 a0 = *(const LAS i64*)(kl + d0 * 16), a1 = *(const LAS i64*)(kl + 32 * KS8 + d0 * 16);
        p0 = MFMA32F8(a0, q[d0], p0); p1 = MFMA32F8(a1, q[d0], p1);
    }
}
__device__ __forceinline__ float sm_core_scaled(f32x16& p0, f32x16& p1, float& m, float& l, const float C2) {
    float tm = p0[0];
#pragma unroll
    for (int r = 1; r < 16; ++r) tm = fmaxf(tm, p0[r]);
#pragma unroll
    for (int r = 0; r < 16; ++r) tm = fmaxf(tm, p1[r]);
    tm = swapmax(tm);
    const float mn = fmaxf(m, tm);
    const float alpha = __builtin_amdgcn_exp2f((m - mn) * C2);
    m = mn;
    const float mc = -mn * C2;
    float ps = 0.f;
#pragma unroll
    for (int r = 0; r < 16; ++r) { p0[r] = __builtin_amdgcn_exp2f(__builtin_fmaf(p0[r], C2, mc)); ps += p0[r]; }
#pragma unroll
    for (int r = 0; r < 16; ++r) { p1[r] = __builtin_amdgcn_exp2f(__builtin_fmaf(p1[r], C2, mc)); ps += p1[r]; }
    ps = swapsum(ps);
    l = l * alpha + ps;
    return alpha;
}
#endif
#ifdef MLA_PIPE8
struct MlaPtrs { const bf16* Q; const bf16* K; const bf16* V; const bf16* Z; bf16* O; };
__device__ __forceinline__ void mla_mask(f32x16& p0, f32x16& p1, int dq) {
#pragma unroll
    for (int r = 0; r < 16; ++r) { const int c = (r & 3) + 8 * (r >> 2);
        if (c > dq) p0[r] = -__builtin_inff();
        if (c + 32 > dq) p1[r] = -__builtin_inff(); }
}
__device__ __forceinline__ void mla_unit(LAS unsigned char* lds, const MlaPtrs& P, int head, int qb, int tid_in, int wave, int lane_in) {
    int tid = tid_in; asm volatile("" : "+v"(tid)); const int lane = tid & 63; (void)lane_in;
    const int r32 = lane & 31, hi = lane >> 5;
    const int q0 = qb * 256, qw = q0 + wave * 32, tq = qw + r32;
    i64 q[12];
    { const unsigned char* qp = (const unsigned char*)P.Q + (size_t)tq * 3072 + head * 192 + hi * 8;
#pragma unroll
      for (int d0 = 0; d0 < 12; ++d0) q[d0] = *(const GAS i64*)(qp + d0 * 16); }
    const int NT = 4 * (qb + 1);
    const int srow = tid >> 3, sc8 = tid & 7;
    const unsigned char* kg = (const unsigned char*)P.K + (size_t)head * 192 + (size_t)srow * 3072 + sc8 * 8;
    const unsigned char* vg = (const unsigned char*)P.V + ((size_t)head * 128 + (tid >> 2)) * S + (tid & 3) * 16;
    LAS unsigned char* kst = lds + srow * KS8 + sc8 * 8;
    LAS unsigned char* vst = lds + 2 * MLA_KB8 + (tid >> 2) * VS8 + (tid & 3) * 16;
    const LAS unsigned char* kl = lds + r32 * KS8 + hi * 8;
    const LAS unsigned char* vl = lds + 2 * MLA_KB8 + r32 * VS8 + hi * 8;
    u32x2 sk0, sk1, sk2; u32x4 sv0;
#define MLA_LOADK(j) do { const unsigned char* kp_ = kg + (size_t)(j) * (64 * 3072); sk0 = *(const GAS u32x2*)(kp_); sk1 = *(const GAS u32x2*)(kp_ + 64); sk2 = *(const GAS u32x2*)(kp_ + 128); } while (0)
#define MLA_LOADV(j) do { sv0 = *(const GAS u32x4*)(vg + (size_t)(j) * 64); } while (0)
#define MLA_STOREK(b) do { LAS unsigned char* kd_ = kst + (b) * MLA_KB8; *(LAS u32x2*)(kd_) = sk0; *(LAS u32x2*)(kd_ + 64) = sk1; *(LAS u32x2*)(kd_ + 128) = sk2; } while (0)
#define MLA_STOREV(b) do { LAS unsigned char* vd_ = vst + (b) * VB8; *(LAS u32x2*)(vd_) = (u32x2){sv0.x, sv0.y}; *(LAS u32x2*)(vd_ + 8) = (u32x2){sv0.z, sv0.w}; } while (0)
    float m = -1e30f, l = 0.f; f32x16 o[4];
#pragma unroll
    for (int d = 0; d < 4; ++d)
#pragma unroll
        for (int r = 0; r < 16; ++r) o[d][r] = 0.f;
    f32x16 pA0, pA1, pB0, pB1;
    MLA_LOADK(0); MLA_LOADV(0); MLA_STOREK(0); MLA_STOREV(0);
    MLA_LOADK(1);
    __syncthreads();
    qk_tile8<12>(pA0, pA1, kl, q);
    if (63 > qw) mla_mask(pA0, pA1, tq - 4 * hi);
    MLA_STOREK(1);
    if (2 < NT) MLA_LOADK(2);
    MLA_LOADV(1);
    __syncthreads();
#define MLA_SGB1() do { __builtin_amdgcn_sched_group_barrier(0x100, 2, 0); __builtin_amdgcn_sched_group_barrier(0x008, 1, 0); __builtin_amdgcn_sched_group_barrier(0x002, 6, 0); \
        __builtin_amdgcn_sched_group_barrier(0x008, 1, 0); __builtin_amdgcn_sched_group_barrier(0x002, 6, 0); } while (0)
#define MLA_SGB() do { MLA_SGB1(); MLA_SGB1(); MLA_SGB1(); MLA_SGB1(); MLA_SGB1(); MLA_SGB1(); MLA_SGB1(); MLA_SGB1(); MLA_SGB1(); MLA_SGB1(); MLA_SGB1(); MLA_SGB1(); } while (0)
#define MLA_STEP(PX0, PX1, PY0, PY1, j) do { \
        const int kb1_ = 64 * ((j) + 1); \
        const bool a1_ = ((j) + 1 < NT) && (kb1_ <= qw + 31), a0_ = (64 * (j) <= qw + 31); \
        float alpha_ = 1.f; i64 pb_[4]; \
        if (a1_) { \
            __builtin_amdgcn_sched_barrier(0); \
            qk_tile8_free<12>(PY0, PY1, kl + (((j) + 1) & 1) * MLA_KB8, q); \
            alpha_ = sm_core_scaled(PX0, PX1, m, l, QS_MLA); \
            pb_[0] = packp8<0>(PX0); pb_[1] = packp8<1>(PX0); pb_[2] = packp8<0>(PX1); pb_[3] = packp8<1>(PX1); \
            MLA_SGB(); \
            __builtin_amdgcn_sched_barrier(0); \
            if (kb1_ + 63 > qw) mla_mask(PY0, PY1, tq - kb1_ - 4 * hi); \
        } else if (a0_) { \
            alpha_ = sm_core_scaled(PX0, PX1, m, l, QS_MLA); \
            pb_[0] = packp8<0>(PX0); pb_[1] = packp8<1>(PX0); pb_[2] = packp8<0>(PX1); pb_[3] = packp8<1>(PX1); \
        } \
        if (a0_) { \
            if (!__all(alpha_ == 1.f)) { _Pragma("unroll") for (int d_ = 0; d_ < 4; ++d_) _Pragma("unroll") for (int r_ = 0; r_ < 16; ++r_) o[d_][r_] *= alpha_; } \
            pv_tile8(o, pb_, vl + ((j) & 1) * VB8); \
        } \
        if ((j) + 2 < NT) MLA_STOREK((j) & 1); \
        if ((j) + 1 < NT) MLA_STOREV(((j) + 1) & 1); \
        if ((j) + 3 < NT) MLA_LOADK((j) + 3); \
        if ((j) + 2 < NT) MLA_LOADV((j) + 2); \
        __syncthreads(); } while (0)
    for (int j = 0; j < NT; j += 2) {
        MLA_STEP(pA0, pA1, pB0, pB1, j);
        MLA_STEP(pB0, pB1, pA0, pA1, j + 1);
    }
#undef MLA_STEP
#undef MLA_SGB
#undef MLA_SGB1
#undef MLA_LOADK
#undef MLA_LOADV
#undef MLA_STOREK
#undef MLA_STOREV
    const float inv = (1.f / 256.f) / l;
    const bf16* zp = P.Z + (size_t)tq * 2048 + head * 128 + 4 * hi;
    bf16* op = P.O + (size_t)tq * 4096 + head * 128 + 4 * hi;
#pragma unroll
    for (int d0 = 0; d0 < 4; ++d0)
#pragma unroll
        for (int rg = 0; rg < 4; ++rg) { const int dim = 32 * d0 + 8 * rg;
            const u32x2 z = *(const GAS u32x2*)(zp + dim);
            u32x2 w; w.x = pk2(o[d0][4 * rg + 0] * inv * bflo(z.x), o[d0][4 * rg + 1] * inv * bfhi(z.x)); w.y = pk2(o[d0][4 * rg + 2] * inv * bflo(z.y), o[d0][4 * rg + 3] * inv * bfhi(z.y));
            *(GAS u32x2*)(op + dim) = w; }
}
#elif defined(MLA_PIPE)
struct MlaPtrs { const bf16* Q; const bf16* K; const bf16* V; const bf16* Z; bf16* O; };
__device__ __forceinline__ void mla_mask(f32x16& p0, f32x16& p1, int dq) {
#pragma unroll
    for (int r = 0; r < 16; ++r) { const int c = (r & 3) + 8 * (r >> 2);
        if (c > dq) p0[r] = -__builtin_inff();
        if (c + 32 > dq) p1[r] = -__builtin_inff(); }
}
__device__ __forceinline__ void mla_unit(LAS unsigned char* lds, const MlaPtrs& P, int head, int qb, int tid_in, int wave, int lane_in) {
    int tid = tid_in; asm volatile("" : "+v"(tid)); const int lane = tid & 63; (void)lane_in;
    const int r32 = lane & 31, hi = lane >> 5;
    const int q0 = qb * 256, qw = q0 + wave * 32, tq = qw + r32;
    bf16x8 q[8];
    LAS unsigned char* ql = lds + MLA_QL + wave * 4096 + lane * 16;
    { const bf16* qp = P.Q + (size_t)tq * 3072 + head * 192 + hi * 8;
#pragma unroll
      for (int d0 = 0; d0 < 8; ++d0) q[d0] = *(const GAS bf16x8*)(qp + d0 * 16);
#pragma unroll
      for (int d0 = 8; d0 < 12; ++d0) *(LAS bf16x8*)(ql + (d0 - 8) * 1024) = *(const GAS bf16x8*)(qp + d0 * 16); }
    const int NT = 4 * (qb + 1);
    const int srow = tid >> 3, sc8 = tid & 7;
    const unsigned char* kg = (const unsigned char*)P.K + (size_t)head * 384 + (size_t)srow * 6144 + sc8 * 16;
    const unsigned char* vg = (const unsigned char*)P.V + (size_t)head * 256 + (size_t)srow * 4096 + sc8 * 16;
    LAS unsigned char* kst = lds + srow * KS_M + sc8 * 16;
    LAS unsigned char* vst = lds + 2 * MLA_KB + srow * VS + sc8 * 16;
    const LAS unsigned char* kl = lds + r32 * KS_M + hi * 16;
    const LAS unsigned char* vl = lds + 2 * MLA_KB + (4 * hi + ((lane & 15) >> 2)) * VS + (16 * ((lane >> 4) & 1) + 4 * (lane & 3)) * 2;
    u32x4 sk0, sk1, sk2, sv0, sv1;
#define MLA_LOADK(j) do { const unsigned char* kp_ = kg + (size_t)(j) * (64 * 6144); sk0 = *(const GAS u32x4*)(kp_); sk1 = *(const GAS u32x4*)(kp_ + 128); sk2 = *(const GAS u32x4*)(kp_ + 256); } while (0)
#define MLA_LOADV(j) do { const unsigned char* vp_ = vg + (size_t)(j) * (64 * 4096); sv0 = *(const GAS u32x4*)(vp_); sv1 = *(const GAS u32x4*)(vp_ + 128); } while (0)
#define MLA_STOREK(b) do { LAS unsigned char* kd_ = kst + (b) * MLA_KB; *(LAS u32x4*)(kd_) = sk0; *(LAS u32x4*)(kd_ + 128) = sk1; *(LAS u32x4*)(kd_ + 256) = sk2; } while (0)
#define MLA_STOREV(b) do { LAS unsigned char* vd_ = vst + (b) * VB; *(LAS u32x4*)(vd_) = sv0; *(LAS u32x4*)(vd_ + 128) = sv1; } while (0)
    float m = -1e30f, l = 0.f; f32x16 o[4];
#pragma unroll
    for (int d = 0; d < 4; ++d)
#pragma unroll
        for (int r = 0; r < 16; ++r) o[d][r] = 0.f;
    f32x16 pA0, pA1, pB0, pB1;
    MLA_LOADK(0); MLA_LOADV(0); MLA_STOREK(0); MLA_STOREV(0);
    MLA_LOADK(1);
    __syncthreads();
    qk_tile_free<12, 8, KS_M>(pA0, pA1, kl, q, ql);
    if (63 > qw) mla_mask(pA0, pA1, tq - 4 * hi);
    MLA_STOREK(1);
    if (2 < NT) MLA_LOADK(2);
    MLA_LOADV(1);
    __syncthreads();
#define MLA_SGB1(NR) do { __builtin_amdgcn_sched_group_barrier(0x100, NR, 0); __builtin_amdgcn_sched_group_barrier(0x008, 1, 0); __builtin_amdgcn_sched_group_barrier(0x002, 6, 0); \
        __builtin_amdgcn_sched_group_barrier(0x008, 1, 0); __builtin_amdgcn_sched_group_barrier(0x002, 6, 0); } while (0)
#define MLA_SGB() do { MLA_SGB1(2); MLA_SGB1(2); MLA_SGB1(2); MLA_SGB1(2); MLA_SGB1(2); MLA_SGB1(2); MLA_SGB1(2); MLA_SGB1(2); MLA_SGB1(3); MLA_SGB1(3); MLA_SGB1(3); MLA_SGB1(3); } while (0)
#define MLA_STEP(PX0, PX1, PY0, PY1, j) do { \
        const int kb1_ = 64 * ((j) + 1); \
        const bool a1_ = ((j) + 1 < NT) && (kb1_ <= qw + 31), a0_ = (64 * (j) <= qw + 31); \
        float alpha_ = 1.f; bf16x8 pb_[4]; \
        if (a1_) { \
            __builtin_amdgcn_sched_barrier(0); \
            qk_tile_free<12, 8, KS_M>(PY0, PY1, kl + (((j) + 1) & 1) * MLA_KB, q, ql); \
            alpha_ = sm_core(PX0, PX1, m, l); \
            pb_[0] = packp<0>(PX0); pb_[1] = packp<1>(PX0); pb_[2] = packp<0>(PX1); pb_[3] = packp<1>(PX1); \
            MLA_SGB(); \
            __builtin_amdgcn_sched_barrier(0); \
            if (kb1_ + 63 > qw) mla_mask(PY0, PY1, tq - kb1_ - 4 * hi); \
        } else if (a0_) { \
            alpha_ = sm_core(PX0, PX1, m, l); \
            pb_[0] = packp<0>(PX0); pb_[1] = packp<1>(PX0); pb_[2] = packp<0>(PX1); pb_[3] = packp<1>(PX1); \
        } \
        if (a0_) { \
            if (!__all(alpha_ == 1.f)) { _Pragma("unroll") for (int d_ = 0; d_ < 4; ++d_) _Pragma("unroll") for (int r_ = 0; r_ < 16; ++r_) o[d_][r_] *= alpha_; } \
            pv_tile(o, pb_, vl + ((j) & 1) * VB); \
        } \
        if ((j) + 2 < NT) MLA_STOREK((j) & 1); \
        if ((j) + 1 < NT) MLA_STOREV(((j) + 1) & 1); \
        if ((j) + 3 < NT) MLA_LOADK((j) + 3); \
        if ((j) + 2 < NT) MLA_LOADV((j) + 2); \
        __syncthreads(); } while (0)
    for (int j = 0; j < NT; j += 2) {
        MLA_STEP(pA0, pA1, pB0, pB1, j);
        MLA_STEP(pB0, pB1, pA0, pA1, j + 1);
    }
#undef MLA_STEP
#undef MLA_SGB
#undef MLA_SGB1
#undef MLA_LOADK
#undef MLA_LOADV
#undef MLA_STOREK
#undef MLA_STOREV
    const float inv = 1.f / l;
    const bf16* zp = P.Z + (size_t)tq * 2048 + head * 128 + 4 * hi;
    bf16* op = P.O + (size_t)tq * 4096 + head * 128 + 4 * hi;
#pragma unroll
    for (int d0 = 0; d0 < 4; ++d0)
#pragma unroll
        for (int rg = 0; rg < 4; ++rg) { const int dim = 32 * d0 + 8 * rg;
            const u32x2 z = *(const GAS u32x2*)(zp + dim);
            u32x2 w; w.x = pk2(o[d0][4 * rg + 0] * inv * bflo(z.x), o[d0][4 * rg + 1] * inv * bfhi(z.x)); w.y = pk2(o[d0][4 * rg + 2] * inv * bflo(z.y), o[d0][4 * rg + 3] * inv * bfhi(z.y));
            *(GAS u32x2*)(op + dim) = w; }
}

#else
#if defined(MLA_MXQ)
struct MlaPtrs { const bf16* Q; const bf16* K; const bf16* V; const bf16* Z; bf16* O; };
constexpr int VBQ = 160 * VSX;
static_assert(2 * MLA_KBX + 2 * VBQ <= 131072, "MLA mxq LDS map");
__device__ __forceinline__ void mla_maskq(f32x16& p0, f32x16& p1, int dq) {
#pragma unroll
    for (int r = 0; r < 16; ++r) { const int c = (r & 3) + 8 * (r >> 2);
        if (c > dq) p0[r] = -__builtin_inff();
        if (c + 32 > dq) p1[r] = -__builtin_inff(); }
}
__device__ __forceinline__ float mla_rowmaxq(const f32x16& p0, const f32x16& p1) {
    float tm = p0[0];
#pragma unroll
    for (int r = 1; r < 16; ++r) tm = fmaxf(tm, p0[r]);
#pragma unroll
    for (int r = 0; r < 16; ++r) tm = fmaxf(tm, p1[r]);
    return swapmax(tm);
}
__device__ __forceinline__ void mla_unit(LAS unsigned char* lds, const MlaPtrs& P, int head, int qb, int tid_in, int wave, int lane_in) {
    int tid = tid_in; asm volatile("" : "+v"(tid)); const int lane = tid & 63; (void)lane_in;
    const int r32 = lane & 31, hi = lane >> 5;
    const int q0 = qb * 256, qw = q0 + wave * 32, tq = qw + r32;
    i32x8 q[3];
    { const unsigned char* qp = (const unsigned char*)P.Q + (size_t)tq * 3072 + head * 192 + hi * 32;
#pragma unroll
      for (int s = 0; s < 3; ++s) { const u32x4 a = *(const GAS u32x4*)(qp + 64 * s), b = *(const GAS u32x4*)(qp + 64 * s + 16);
          q[s] = (i32x8){(int)a.x, (int)a.y, (int)a.z, (int)a.w, (int)b.x, (int)b.y, (int)b.z, (int)b.w}; } }
    const int NT = 4 * (qb + 1);
    const int srow = tid >> 3, sc8 = tid & 7;
    const unsigned char* kg = (const unsigned char*)P.K + (size_t)head * 192 + (size_t)srow * 3072 + sc8 * 8;
    const unsigned char* vg = (const unsigned char*)P.V + ((size_t)head * 128 + (tid >> 2)) * S + (tid & 3) * 16;
    LAS unsigned char* kst = lds + srow * KSX + sc8 * 8;
    LAS unsigned char* vst = lds + 2 * MLA_KBX + (tid >> 2) * VSX + (tid & 3) * 16;
    const LAS unsigned char* kl = lds + r32 * KSX + hi * 32;
    const LAS unsigned char* vl = lds + 2 * MLA_KBX + r32 * VSX + hi * 32;
    u32x2 sk0, sk1, sk2; u32x4 sv0;
#define MLA_LOADK(j) do { const unsigned char* kp_ = kg + (size_t)(j) * (64 * 3072); sk0 = *(const GAS u32x2*)(kp_); sk1 = *(const GAS u32x2*)(kp_ + 64); sk2 = *(const GAS u32x2*)(kp_ + 128); } while (0)
#define MLA_LOADV(j) do { sv0 = *(const GAS u32x4*)(vg + (size_t)(j) * 64); } while (0)
#define MLA_STOREK(b) do { LAS unsigned char* kd_ = kst + (b) * MLA_KBX; *(LAS u32x2*)(kd_) = sk0; *(LAS u32x2*)(kd_ + 64) = sk1; *(LAS u32x2*)(kd_ + 128) = sk2; } while (0)
#define MLA_STOREV(b) do { LAS unsigned char* vd_ = vst + (b) * VBQ; *(LAS u32x2*)(vd_) = (u32x2){sv0.x, sv0.y}; *(LAS u32x2*)(vd_ + 8) = (u32x2){sv0.z, sv0.w}; } while (0)
    f32x16 o[5], mref;
#pragma unroll
    for (int d = 0; d < 5; ++d)
#pragma unroll
        for (int r = 0; r < 16; ++r) o[d][r] = 0.f;
#pragma unroll
    for (int r = 0; r < 16; ++r) mref[r] = MXL_REF;
    f32x16 p0, p1;
    if (tid < 256) { const int slot = tid >> 7, row = (tid >> 2) & 31, ch = tid & 3; const unsigned v1 = (row == 0 || row == 4) ? 0x38383838u : 0u;
        *(LAS u32x4*)(lds + 2 * MLA_KBX + slot * VBQ + (128 + row) * VSX + ch * 16) = (u32x4){v1, v1, v1, v1}; }
    MLA_LOADK(0); MLA_LOADV(0); MLA_STOREK(0); MLA_STOREV(0);
    MLA_LOADK(1);
    __syncthreads();
    qk_tilexl(p0, p1, mref, kl, q);
    if (63 > qw) mla_maskq(p0, p1, tq - 4 * hi);
    { const float dlt = mla_rowmaxq(p0, p1) - MXL_REF;
#pragma unroll
      for (int r = 0; r < 16; ++r) { p0[r] -= dlt; p1[r] -= dlt; mref[r] -= dlt; } }
    i32x8 pbA = byte_packx(p0, p1), pbB = pbA;
    MLA_STOREK(1);
    if (2 < NT) MLA_LOADK(2);
    MLA_LOADV(1);
    __syncthreads();
    asm volatile("" : "+v"(q[0]), "+v"(q[1]), "+v"(q[2]));
    int sc1_ = 0x7f7f7f7f; asm volatile("" : "+v"(sc1_));
#define SB() __builtin_amdgcn_sched_barrier(0)
#define MFMA_T(acc, a, b) asm volatile("s_nop 1\n\tv_mfma_scale_f32_32x32x64_f8f6f4 %0, %1, %2, %0, %3, %3 op_sel_hi:[0,0,0]" : "+v"(acc) : "v"(a), "v"(b), "v"(sc1_))
#define MFMA_C(acc, a, b, c) asm volatile("s_nop 1\n\tv_mfma_scale_f32_32x32x64_f8f6f4 %0, %1, %2, %3, %4, %4 op_sel_hi:[0,0,0]" : "=&v"(acc) : "v"(a), "v"(b), "v"(c), "v"(sc1_))
#define CVT8(P, R0, PB, W0) do { unsigned w_ = __builtin_amdgcn_cvt_pk_u8_f32(P[(R0) + 0], 0, 0u); w_ = __builtin_amdgcn_cvt_pk_u8_f32(P[(R0) + 1], 1, w_); w_ = __builtin_amdgcn_cvt_pk_u8_f32(P[(R0) + 2], 2, w_); \
        w_ = __builtin_amdgcn_cvt_pk_u8_f32(P[(R0) + 3], 3, w_); PB[(W0)] = (int)w_; \
        w_ = __builtin_amdgcn_cvt_pk_u8_f32(P[(R0) + 4], 0, 0u); w_ = __builtin_amdgcn_cvt_pk_u8_f32(P[(R0) + 5], 1, w_); w_ = __builtin_amdgcn_cvt_pk_u8_f32(P[(R0) + 6], 2, w_); \
        w_ = __builtin_amdgcn_cvt_pk_u8_f32(P[(R0) + 7], 3, w_); PB[(W0) + 1] = (int)w_; } while (0)
#define MLA_STEP(PBX, PBY, j) do { \
        const int kb1_ = 64 * ((j) + 1); \
        if (64 * (j) <= qw + 31) { \
            const LAS unsigned char* kn_ = kl + (((j) + 1) & 1) * MLA_KBX; const LAS unsigned char* vj_ = vl + ((j) & 1) * VBQ; \
            SB(); \
            i32x8 a0_f = ldsx(kn_), a1_f = ldsx(kn_ + 32 * KSX); \
            SB(); MFMA_C(p0, a0_f, q[0], mref); SB(); \
            a0_f = ldsx(kn_ + 64); \
            SB(); MFMA_C(p1, a1_f, q[0], mref); SB(); \
            a1_f = ldsx(kn_ + 32 * KSX + 64); \
            SB(); MFMA_T(p0, a0_f, q[1]); SB(); \
            a0_f = ldsx(kn_ + 128); \
            SB(); MFMA_T(p1, a1_f, q[1]); SB(); \
            a1_f = ldsx(kn_ + 32 * KSX + 128); \
            SB(); MFMA_T(p0, a0_f, q[2]); SB(); \
            a0_f = ldsx(vj_ + 128 * VSX); \
            SB(); MFMA_T(p1, a1_f, q[2]); SB(); \
            a1_f = ldsx(vj_); \
            SB(); MFMA_T(o[4], a0_f, PBX); SB(); \
            a0_f = ldsx(vj_ + 32 * VSX); \
            SB(); MFMA_T(o[0], a1_f, PBX); SB(); \
            a1_f = ldsx(vj_ + 64 * VSX); \
            float tmx_ = p0[0]; _Pragma("unroll") for (int r_ = 1; r_ < 16; ++r_) tmx_ = fmaxf(tmx_, p0[r_]); \
            CVT8(p0, 0, PBY, 0); CVT8(p0, 8, PBY, 2); \
            SB(); MFMA_T(o[1], a0_f, PBX); SB(); \
            a0_f = ldsx(vj_ + 96 * VSX); \
            _Pragma("unroll") for (int r_ = 0; r_ < 16; ++r_) tmx_ = fmaxf(tmx_, p1[r_]); \
            CVT8(p1, 0, PBY, 4); \
            SB(); MFMA_T(o[2], a1_f, PBX); SB(); \
            CVT8(p1, 8, PBY, 6); tmx_ = swapmax(tmx_); \
            SB(); MFMA_T(o[3], a0_f, PBX); SB(); \
            const bool diag_ = kb1_ + 63 > qw; \
            if (diag_ || !__all(tmx_ <= MXL_T)) {               \
                asm volatile("s_nop 15\n\ts_nop 15\n\ts_nop 15" ::: "memory");     \
                if (diag_) mla_maskq(p0, p1, tq - kb1_ - 4 * hi); \
                const float dlt_ = fmaxf(mla_rowmaxq(p0, p1) - MXL_REF, 0.f); const float alpha_ = __builtin_amdgcn_exp2f(-0.125f * dlt_); \
                _Pragma("unroll") for (int r_ = 0; r_ < 16; ++r_) { p0[r_] -= dlt_; p1[r_] -= dlt_; mref[r_] -= dlt_; } \
                _Pragma("unroll") for (int d_ = 0; d_ < 5; ++d_) _Pragma("unroll") for (int r_ = 0; r_ < 16; ++r_) o[d_][r_] *= alpha_; \
                PBY = byte_packx(p0, p1); } \
        } \
        if ((j) + 2 < NT) MLA_STOREK((j) & 1); \
        if ((j) + 1 < NT) MLA_STOREV(((j) + 1) & 1); \
        if ((j) + 3 < NT) MLA_LOADK((j) + 3); \
        if ((j) + 2 < NT) MLA_LOADV((j) + 2); \
        __syncthreads(); } while (0)
    for (int j = 0; j < NT; j += 2) {
        MLA_STEP(pbA, pbB, j);
        MLA_STEP(pbB, pbA, j + 1);
    }
    asm volatile("s_nop 15\n\ts_nop 15" ::: "memory");
#undef MLA_STEP
#undef CVT8
#undef MFMA_T
#undef MFMA_C
#undef SB
#undef MLA_LOADK
#undef MLA_LOADV
#undef MLA_STOREK
#undef MLA_STOREV
    const float inv = 1.f / o[4][0];
    const bf16* zp = P.Z + (size_t)tq * 2048 + head * 128 + 4 * hi;
    bf16* op = P.O + (size_t)tq * 4096 + head * 128 + 4 * hi;
#pragma unroll
    for (int d0 = 0; d0 < 4; ++d0)
#pragma unroll
        for (int rg = 0; rg < 4; ++rg) { const int dim = 32 * d0 + 8 * rg;
            const u32x2 z = *(const GAS u32x2*)(zp + dim);
            u32x2 w; w.x = pk2(o[d0][4 * rg + 0] * inv * bflo(z.x), o[d0][4 * rg + 1] * inv * bfhi(z.x)); w.y = pk2(o[d0][4 * rg + 2] * inv * bflo(z.y), o[d0][4 * rg + 3] * inv * bfhi(z.y));
            *(GAS u32x2*)(op + dim) = w; }
}

#elif defined(MLA_BIGX)
struct MlaPtrs { const bf16* Q; const bf16* K; const bf16* V; const bf16* Z; bf16* O; };
__device__ __forceinline__ void mla_unit(LAS unsigned char* lds, const MlaPtrs& P, int head, int qb, int tid_in, int wave, int lane_in) {
    int tid = tid_in; asm volatile("" : "+v"(tid)); const int lane = tid & 63; (void)lane_in;
    const int r32 = lane & 31, hi = lane >> 5;
    const int q0 = qb * 256, qw = q0 + wave * 32, tq = qw + r32;
    i32x8 q[3];
    { const unsigned char* qp = (const unsigned char*)P.Q + (size_t)tq * 3072 + head * 192 + hi * 32;
#pragma unroll
      for (int s = 0; s < 3; ++s) { const u32x4 a = *(const GAS u32x4*)(qp + 64 * s), b = *(const GAS u32x4*)(qp + 64 * s + 16);
          q[s] = (i32x8){(int)a.x, (int)a.y, (int)a.z, (int)a.w, (int)b.x, (int)b.y, (int)b.z, (int)b.w}; } }
    const int NT = 4 * (qb + 1), NTB = NT / 2;
    constexpr int VSB = 144, VBB = 128 * VSB, KBB = 128 * KSX;
    static_assert(2 * KBB + 3 * VBB <= 131072, "MLA big-tile LDS map");
    const int srow = tid >> 3, sc8 = tid & 7;
    const unsigned char* kg = (const unsigned char*)P.K + (size_t)head * 192 + (size_t)srow * 3072 + sc8 * 8;
    const unsigned char* vg = (const unsigned char*)P.V + ((size_t)head * 128 + (tid >> 2)) * S + (tid & 3) * 32;
    LAS unsigned char* kst = lds + srow * KSX + sc8 * 8;
    LAS unsigned char* vst = lds + 2 * KBB + (tid >> 2) * VSB + (tid & 3) * 32;
    const LAS unsigned char* kl = lds + r32 * KSX + hi * 32;
    const LAS unsigned char* vl = lds + 2 * KBB + r32 * VSB + hi * 32;
    u32x2 sk0, sk1, sk2, sk3, sk4, sk5; u32x4 sv0, sv1;
#define MLA_LOAD(J) do { const unsigned char* kp_ = kg + (size_t)(J) * (128 * 3072); const unsigned char* vp_ = vg + (size_t)(J) * 128; \
        sk0 = *(const GAS u32x2*)(kp_); sk1 = *(const GAS u32x2*)(kp_ + 64); sk2 = *(const GAS u32x2*)(kp_ + 128); \
        sk3 = *(const GAS u32x2*)(kp_ + 64 * 3072); sk4 = *(const GAS u32x2*)(kp_ + 64 * 3072 + 64); sk5 = *(const GAS u32x2*)(kp_ + 64 * 3072 + 128); \
        sv0 = *(const GAS u32x4*)(vp_); sv1 = *(const GAS u32x4*)(vp_ + 16); } while (0)
#define MLA_STORE(b, vb) do { LAS unsigned char* kd_ = kst + (b) * KBB; LAS unsigned char* vd_ = vst + (vb) * VBB; \
        *(LAS u32x2*)(kd_) = sk0; *(LAS u32x2*)(kd_ + 64) = sk1; *(LAS u32x2*)(kd_ + 128) = sk2; \
        *(LAS u32x2*)(kd_ + 64 * KSX) = sk3; *(LAS u32x2*)(kd_ + 64 * KSX + 64) = sk4; *(LAS u32x2*)(kd_ + 64 * KSX + 128) = sk5; \
        *(LAS u32x2*)(vd_) = (u32x2){sv0.x, sv0.y}; *(LAS u32x2*)(vd_ + 8) = (u32x2){sv0.z, sv0.w}; *(LAS u32x2*)(vd_ + 16) = (u32x2){sv1.x, sv1.y}; *(LAS u32x2*)(vd_ + 24) = (u32x2){sv1.z, sv1.w}; } while (0)
    MLA_LOAD(0); MLA_STORE(0, 0);
    __syncthreads();
    asm volatile("" : "+v"(q[0]), "+v"(q[1]), "+v"(q[2]));
    f32x16 o[5], mref;
#pragma unroll
    for (int d = 0; d < 5; ++d)
#pragma unroll
        for (int r = 0; r < 16; ++r) o[d][r] = 0.f;
#pragma unroll
    for (int r = 0; r < 16; ++r) mref[r] = MXL_REF;
    const int one8 = (r32 == 0 || r32 == 4) ? 0x38383838 : 0;
    const i32x8 ones = {one8, one8, one8, one8, one8, one8, one8, one8};
    const bool trail = wave >= 4;
    i32x8 pb = {};
    int vb_cur = 0, vb_prev = 2;
    for (int J = 0; J < NTB; ++J) {
        int vb_next = vb_cur + 1; if (vb_next == 3) vb_next = 0;
        if (J + 1 < NTB) MLA_LOAD(J + 1);
#pragma unroll
        for (int sub = 0; sub < 2; ++sub) {
        const int j = 2 * J + sub, kb = 64 * j;
        if (trail && j > 0 && kb - 64 <= qw + 31) pv_tilexl<VSB>(o, pb, ones, vl + (sub == 0 ? vb_prev * VBB + 64 : vb_cur * VBB));
        if (kb <= qw + 31) {
            f32x16 p0, p1;
            qk_tilexl(p0, p1, mref, kl + (J & 1) * KBB + sub * 64 * KSX, q);
            if (kb + 63 > qw) {
                const int dq = tq - kb - 4 * hi;
#pragma unroll
                for (int r = 0; r < 16; ++r) { const int c = (r & 3) + 8 * (r >> 2);
                    if (c > dq) p0[r] = -__builtin_inff();
                    if (c + 32 > dq) p1[r] = -__builtin_inff(); }
            }
            float tm = p0[0];
#pragma unroll
            for (int r = 1; r < 16; ++r) tm = fmaxf(tm, p0[r]);
#pragma unroll
            for (int r = 0; r < 16; ++r) tm = fmaxf(tm, p1[r]);
            tm = swapmax(tm);
            if (j == 0 || !__all(tm <= MXL_T)) {
                const float dlt = (j == 0) ? tm - MXL_REF : fmaxf(tm - MXL_REF, 0.f);
                const float alpha = __builtin_amdgcn_exp2f(-0.125f * dlt);
#pragma unroll
                for (int r = 0; r < 16; ++r) { p0[r] -= dlt; p1[r] -= dlt; mref[r] -= dlt; }
                if (j > 0) {
#pragma unroll
                    for (int d = 0; d < 5; ++d)
#pragma unroll
                        for (int r = 0; r < 16; ++r) o[d][r] *= alpha;
                }
            }
            pb = byte_packx(p0, p1);
            if (!trail) pv_tilexl<VSB>(o, pb, ones, vl + vb_cur * VBB + sub * 64);
        }
        }
        if (J + 1 < NTB) MLA_STORE((J + 1) & 1, vb_next);
        __syncthreads();
        vb_prev = vb_cur; vb_cur = vb_next;
    }
    if (trail && 64 * (NT - 1) <= qw + 31) pv_tilexl<VSB>(o, pb, ones, vl + vb_prev * VBB + 64);
    __syncthreads();
#undef MLA_LOAD
#undef MLA_STORE
    const float inv = 1.f / o[4][0];
    const bf16* zp = P.Z + (size_t)tq * 2048 + head * 128 + 4 * hi;
    bf16* op = P.O + (size_t)tq * 4096 + head * 128 + 4 * hi;
#pragma unroll
    for (int d0 = 0; d0 < 4; ++d0)
#pragma unroll
        for (int rg = 0; rg < 4; ++rg) { const int dim = 32 * d0 + 8 * rg;
            const u32x2 z = *(const GAS u32x2*)(zp + dim);
            u32x2 w; w.x = pk2(o[d0][4 * rg + 0] * inv * bflo(z.x), o[d0][4 * rg + 1] * inv * bfhi(z.x)); w.y = pk2(o[d0][4 * rg + 2] * inv * bflo(z.y), o[d0][4 * rg + 3] * inv * bfhi(z.y));
            *(GAS u32x2*)(op + dim) = w; }
}

#elif defined(MLA_MXL)
struct MlaPtrs { const bf16* Q; const bf16* K; const bf16* V; const bf16* Z; bf16* O; };
__device__ __forceinline__ void mla_unit(LAS unsigned char* lds, const MlaPtrs& P, int head, int qb, int tid_in, int wave, int lane_in) {
    int tid = tid_in; asm volatile("" : "+v"(tid)); const int lane = tid & 63; (void)lane_in;
    const int r32 = lane & 31, hi = lane >> 5;
    const int q0 = qb * 256, qw = q0 + wave * 32, tq = qw + r32;
    i32x8 q[3];
    { const unsigned char* qp = (const unsigned char*)P.Q + (size_t)tq * 3072 + head * 192 + hi * 32;
#pragma unroll
      for (int s = 0; s < 3; ++s) { const u32x4 a = *(const GAS u32x4*)(qp + 64 * s), b = *(const GAS u32x4*)(qp + 64 * s + 16);
          q[s] = (i32x8){(int)a.x, (int)a.y, (int)a.z, (int)a.w, (int)b.x, (int)b.y, (int)b.z, (int)b.w}; } }
    const int NT = 4 * (qb + 1);
    const int srow = tid >> 3, sc8 = tid & 7;
    const unsigned char* kg = (const unsigned char*)P.K + (size_t)head * 192 + (size_t)srow * 3072 + sc8 * 8;
    const unsigned char* vg = (const unsigned char*)P.V + ((size_t)head * 128 + (tid >> 2)) * S + (tid & 3) * 16;
    LAS unsigned char* kst = lds + srow * KSX + sc8 * 8;
    LAS unsigned char* vst = lds + 2 * MLA_KBX + (tid >> 2) * VSX + (tid & 3) * 16;
    const LAS unsigned char* kl = lds + r32 * KSX + hi * 32;
    const LAS unsigned char* vl = lds + 2 * MLA_KBX + r32 * VSX + hi * 32;
    u32x2 sk0, sk1, sk2; u32x4 sv0;
#define MLA_LOAD(j) do { const unsigned char* kp_ = kg + (size_t)(j) * (64 * 3072); const unsigned char* vp_ = vg + (size_t)(j) * 64; \
        sk0 = *(const GAS u32x2*)(kp_); sk1 = *(const GAS u32x2*)(kp_ + 64); sk2 = *(const GAS u32x2*)(kp_ + 128); sv0 = *(const GAS u32x4*)(vp_); } while (0)
#define MLA_STORE(b, vb) do { LAS unsigned char* kd_ = kst + (b) * MLA_KBX; LAS unsigned char* vd_ = vst + (vb) * VBX; \
        *(LAS u32x2*)(kd_) = sk0; *(LAS u32x2*)(kd_ + 64) = sk1; *(LAS u32x2*)(kd_ + 128) = sk2; *(LAS u32x2*)(vd_) = (u32x2){sv0.x, sv0.y}; *(LAS u32x2*)(vd_ + 8) = (u32x2){sv0.z, sv0.w}; } while (0)
    MLA_LOAD(0); MLA_STORE(0, 0);
    __syncthreads();
    asm volatile("" : "+v"(q[0]), "+v"(q[1]), "+v"(q[2]));
    f32x16 o[5], mref;
#pragma unroll
    for (int d = 0; d < 5; ++d)
#pragma unroll
        for (int r = 0; r < 16; ++r) o[d][r] = 0.f;
#pragma unroll
    for (int r = 0; r < 16; ++r) mref[r] = MXL_REF;
    const int one8 = (r32 == 0 || r32 == 4) ? 0x38383838 : 0;
    const i32x8 ones = {one8, one8, one8, one8, one8, one8, one8, one8};
    const bool trail = wave >= 4;
    i32x8 pb = {};
    int vb_cur = 0, vb_prev = 2;
    for (int j = 0; j < NT; ++j) {
        const int kb = 64 * j;
        int vb_next = vb_cur + 1; if (vb_next == 3) vb_next = 0;
        if (j + 1 < NT) MLA_LOAD(j + 1);
        if (trail && j > 0 && kb - 64 <= qw + 31) pv_tilexl(o, pb, ones, vl + vb_prev * VBX);
        if (kb <= qw + 31) {
            f32x16 p0, p1;
            qk_tilexl(p0, p1, mref, kl + (j & 1) * MLA_KBX, q);
            if (kb + 63 > qw) {
                const int dq = tq - kb - 4 * hi;
#pragma unroll
                for (int r = 0; r < 16; ++r) { const int c = (r & 3) + 8 * (r >> 2);
                    if (c > dq) p0[r] = -__builtin_inff();
                    if (c + 32 > dq) p1[r] = -__builtin_inff(); }
            }
            float tm = p0[0];
#pragma unroll
            for (int r = 1; r < 16; ++r) tm = fmaxf(tm, p0[r]);
#pragma unroll
            for (int r = 0; r < 16; ++r) tm = fmaxf(tm, p1[r]);
            tm = swapmax(tm);
            if (j == 0 || !__all(tm <= MXL_T)) {
#ifdef MLA_MXU
                const float dlt = (j == 0) ? tm - MXL_REF : fmaxf(tm - MXL_REF, 0.f);
                const float alpha = __builtin_amdgcn_exp2f(-0.125f * dlt);
#else
                const float dlt = (j == 0) ? tm : fmaxf(tm, 0.f);
                const float alpha = __builtin_amdgcn_exp2f(-dlt);
#endif
#pragma unroll
                for (int r = 0; r < 16; ++r) { p0[r] -= dlt; p1[r] -= dlt; mref[r] -= dlt; }
                if (j > 0) {
#pragma unroll
                    for (int d = 0; d < 5; ++d)
#pragma unroll
                        for (int r = 0; r < 16; ++r) o[d][r] *= alpha;
                }
            }
#ifdef MLA_MXU
            pb = byte_packx(p0, p1);
#else
            pb = exp_packx(p0, p1, one8);
#endif
            if (!trail) pv_tilexl(o, pb, ones, vl + vb_cur * VBX);
        }
        if (j + 1 < NT) MLA_STORE((j + 1) & 1, vb_next);
        __syncthreads();
        vb_prev = vb_cur; vb_cur = vb_next;
    }
    if (trail && 64 * (NT - 1) <= qw + 31) pv_tilexl(o, pb, ones, vl + vb_prev * VBX);
    __syncthreads();
#undef MLA_LOAD
#undef MLA_STORE
    const float inv = 1.f / o[4][0];
    const bf16* zp = P.Z + (size_t)tq * 2048 + head * 128 + 4 * hi;
    bf16* op = P.O + (size_t)tq * 4096 + head * 128 + 4 * hi;
#pragma unroll
    for (int d0 = 0; d0 < 4; ++d0)
#pragma unroll
        for (int rg = 0; rg < 4; ++rg) { const int dim = 32 * d0 + 8 * rg;
            const u32x2 z = *(const GAS u32x2*)(zp + dim);
            u32x2 w; w.x = pk2(o[d0][4 * rg + 0] * inv * bflo(z.x), o[d0][4 * rg + 1] * inv * bfhi(z.x)); w.y = pk2(o[d0][4 * rg + 2] * inv * bflo(z.y), o[d0][4 * rg + 3] * inv * bfhi(z.y));
            *(GAS u32x2*)(op + dim) = w; }
}

#elif defined(MLA_MXP)
struct MlaPtrs { const bf16* Q; const bf16* K; const bf16* V; const bf16* Z; bf16* O; };
__device__ __forceinline__ void mla_maskx(f32x16& p0, f32x16& p1, int dq) {
#pragma unroll
    for (int r = 0; r < 16; ++r) { const int c = (r & 3) + 8 * (r >> 2);
        if (c > dq) p0[r] = -__builtin_inff();
        if (c + 32 > dq) p1[r] = -__builtin_inff(); }
}
__device__ __forceinline__ float mla_rowmax(const f32x16& p0, const f32x16& p1) {
    float tm = p0[0];
#pragma unroll
    for (int r = 1; r < 16; ++r) tm = fmaxf(tm, p0[r]);
#pragma unroll
    for (int r = 0; r < 16; ++r) tm = fmaxf(tm, p1[r]);
    return swapmax(tm);
}
#define MXP_EXP8(P, R0) do { _Pragma("unroll") for (int r_ = (R0); r_ < (R0) + 8; ++r_) { P[r_] = __builtin_amdgcn_exp2f(__builtin_fmaf(P[r_], QS_MLA, mc_)); ps_ += P[r_]; } } while (0)
__device__ __forceinline__ void mla_unit(LAS unsigned char* lds, const MlaPtrs& P, int head, int qb, int tid_in, int wave, int lane_in) {
    int tid = tid_in; asm volatile("" : "+v"(tid)); const int lane = tid & 63; (void)lane_in;
    const int r32 = lane & 31, hi = lane >> 5;
    const int q0 = qb * 256, qw = q0 + wave * 32, tq = qw + r32;
    i32x8 q[3];
    { const unsigned char* qp = (const unsigned char*)P.Q + (size_t)tq * 3072 + head * 192 + hi * 32;
#pragma unroll
      for (int s = 0; s < 3; ++s) { const u32x4 a = *(const GAS u32x4*)(qp + 64 * s), b = *(const GAS u32x4*)(qp + 64 * s + 16);
          q[s] = (i32x8){(int)a.x, (int)a.y, (int)a.z, (int)a.w, (int)b.x, (int)b.y, (int)b.z, (int)b.w}; } }
    const int NT = 4 * (qb + 1);
    const int srow = tid >> 3, sc8 = tid & 7;
    const unsigned char* kg = (const unsigned char*)P.K + (size_t)head * 192 + (size_t)srow * 3072 + sc8 * 8;
    const unsigned char* vg = (const unsigned char*)P.V + ((size_t)head * 128 + (tid >> 2)) * S + (tid & 3) * 16;
    LAS unsigned char* kst = lds + srow * KSX + sc8 * 8;
    LAS unsigned char* vst = lds + 2 * MLA_KBX + (tid >> 2) * VSX + (tid & 3) * 16;
    const LAS unsigned char* kl = lds + r32 * KSX + hi * 32;
    const LAS unsigned char* vl = lds + 2 * MLA_KBX + r32 * VSX + hi * 32;
    u32x2 sk0, sk1, sk2; u32x4 sv0;
#define MLA_LOADK(j) do { const unsigned char* kp_ = kg + (size_t)(j) * (64 * 3072); sk0 = *(const GAS u32x2*)(kp_); sk1 = *(const GAS u32x2*)(kp_ + 64); sk2 = *(const GAS u32x2*)(kp_ + 128); } while (0)
#define MLA_LOADV(j) do { sv0 = *(const GAS u32x4*)(vg + (size_t)(j) * 64); } while (0)
#define MLA_STOREK(b) do { LAS unsigned char* kd_ = kst + (b) * MLA_KBX; *(LAS u32x2*)(kd_) = sk0; *(LAS u32x2*)(kd_ + 64) = sk1; *(LAS u32x2*)(kd_ + 128) = sk2; } while (0)
#define MLA_STOREV(b) do { LAS unsigned char* vd_ = vst + (b) * VBX; *(LAS u32x2*)(vd_) = (u32x2){sv0.x, sv0.y}; *(LAS u32x2*)(vd_ + 8) = (u32x2){sv0.z, sv0.w}; } while (0)
    float m = -1e30f, l = 0.f; f32x16 o[4];
#pragma unroll
    for (int d = 0; d < 4; ++d)
#pragma unroll
        for (int r = 0; r < 16; ++r) o[d][r] = 0.f;
    f32x16 pA0, pA1, pB0, pB1;
    MLA_LOADK(0); MLA_LOADV(0); MLA_STOREK(0); MLA_STOREV(0);
    MLA_LOADK(1);
    __syncthreads();
    qk_tilex(pA0, pA1, kl, q);
    if (63 > qw) mla_maskx(pA0, pA1, tq - 4 * hi);
    MLA_STOREK(1);
    if (2 < NT) MLA_LOADK(2);
    MLA_LOADV(1);
    __syncthreads();
    asm volatile("" : "+v"(q[0]), "+v"(q[1]), "+v"(q[2]));
    float tmx = mla_rowmax(pA0, pA1);
#define SB() __builtin_amdgcn_sched_barrier(0)
#define MLA_SMHEAD() const float mn_ = fmaxf(m, tmx); const float alpha_ = __builtin_amdgcn_exp2f((m - mn_) * QS_MLA); m = mn_; const float mc_ = 8.f - mn_ * QS_MLA; float ps_ = 0.f; i32x8 pb_; \
            if (!__all(alpha_ == 1.f)) { _Pragma("unroll") for (int d_ = 0; d_ < 4; ++d_) _Pragma("unroll") for (int r_ = 0; r_ < 16; ++r_) o[d_][r_] *= alpha_; }
#define MXP_EXPK(P, R0, W0) do { MXP_EXP8(P, R0); \
        int w_ = __builtin_amdgcn_cvt_pk_fp8_f32(P[(R0) + 0], P[(R0) + 1], 0, false); pb_[(W0)] = __builtin_amdgcn_cvt_pk_fp8_f32(P[(R0) + 2], P[(R0) + 3], w_, true); \
        w_ = __builtin_amdgcn_cvt_pk_fp8_f32(P[(R0) + 4], P[(R0) + 5], 0, false); pb_[(W0) + 1] = __builtin_amdgcn_cvt_pk_fp8_f32(P[(R0) + 6], P[(R0) + 7], w_, true); } while (0)
#define MLA_SMTAIL() ps_ = swapsum(ps_); l = l * alpha_ + ps_
#define MFMA_T(acc, a, b) asm volatile("s_nop 1\n\tv_mfma_scale_f32_32x32x64_f8f6f4 %0, %1, %2, %0, %3, %3 op_sel_hi:[0,0,0]" : "+v"(acc) : "v"(a), "v"(b), "v"(sc1_))
#define MFMA_Z(acc, a, b) asm volatile("s_nop 1\n\tv_mfma_scale_f32_32x32x64_f8f6f4 %0, %1, %2, 0, %3, %3 op_sel_hi:[0,0,0]" : "=&v"(acc) : "v"(a), "v"(b), "v"(sc1_))
#define MLA_STEP(PX0, PX1, PY0, PY1, j) do { \
        const int kb1_ = 64 * ((j) + 1); \
        const bool a0_ = (64 * (j) <= qw + 31); \
        const LAS unsigned char* vj_ = vl + ((j) & 1) * VBX; \
        if (a0_) {                  \
            const LAS unsigned char* kn_ = kl + (((j) + 1) & 1) * MLA_KBX; \
            MLA_SMHEAD() \
            SB(); \
            i32x8 a0_f = ldsx(kn_), a1_f = ldsx(kn_ + 64); \
            MXP_EXPK(PX0, 0, 0); MXP_EXPK(PX0, 8, 2); \
            SB(); MFMA_Z(PY0, a0_f, q[0]); SB(); \
            a0_f = ldsx(kn_ + 128); \
            MXP_EXPK(PX1, 0, 4); \
            SB(); MFMA_T(PY0, a1_f, q[1]); SB(); \
            a1_f = ldsx(kn_ + 32 * KSX); \
            MXP_EXPK(PX1, 8, 6); \
            SB(); MFMA_T(PY0, a0_f, q[2]); SB(); \
            a0_f = ldsx(kn_ + 32 * KSX + 64); \
            MLA_SMTAIL(); \
            SB(); MFMA_Z(PY1, a1_f, q[0]); SB(); \
            a1_f = ldsx(vj_); \
            SB(); MFMA_T(PY1, a0_f, q[1]); SB(); \
            a0_f = ldsx(kn_ + 32 * KSX + 128); \
            SB(); MFMA_T(o[0], a1_f, pb_); SB(); \
            a1_f = ldsx(vj_ + 32 * VSX); \
            SB(); MFMA_T(PY1, a0_f, q[2]); SB(); \
            a0_f = ldsx(vj_ + 64 * VSX); \
            SB(); MFMA_T(o[1], a1_f, pb_); SB(); \
            a1_f = ldsx(vj_ + 96 * VSX); \
            SB(); MFMA_T(o[2], a0_f, pb_); SB(); \
            SB(); MFMA_T(o[3], a1_f, pb_); SB(); \
            if (kb1_ + 63 > qw) mla_maskx(PY0, PY1, tq - kb1_ - 4 * hi); \
            tmx = mla_rowmax(PY0, PY1); \
        } \
        if ((j) + 2 < NT) MLA_STOREK((j) & 1); \
        if ((j) + 1 < NT) MLA_STOREV(((j) + 1) & 1); \
        if ((j) + 3 < NT) MLA_LOADK((j) + 3); \
        if ((j) + 2 < NT) MLA_LOADV((j) + 2); \
        __syncthreads(); } while (0)
    int sc1_ = 0x7f7f7f7f; asm volatile("" : "+v"(sc1_));
    for (int j = 0; j < NT; j += 2) {
        MLA_STEP(pA0, pA1, pB0, pB1, j);
        MLA_STEP(pB0, pB1, pA0, pA1, j + 1);
    }
    asm volatile("s_nop 15\n\ts_nop 15" ::: "memory");
#undef MLA_STEP
#undef MLA_SMHEAD
#undef MLA_SMTAIL
#undef MXP_EXPK
#undef MFMA_T
#undef MFMA_Z
#undef SB
#undef MLA_LOADK
#undef MLA_LOADV
#undef MLA_STOREK
#undef MLA_STOREV
    const float inv = 1.f / l;
    const bf16* zp = P.Z + (size_t)tq * 2048 + head * 128 + 4 * hi;
    bf16* op = P.O + (size_t)tq * 4096 + head * 128 + 4 * hi;
#pragma unroll
    for (int d0 = 0; d0 < 4; ++d0)
#pragma unroll
        for (int rg = 0; rg < 4; ++rg) { const int dim = 32 * d0 + 8 * rg;
            const u32x2 z = *(const GAS u32x2*)(zp + dim);
            u32x2 w; w.x = pk2(o[d0][4 * rg + 0] * inv * bflo(z.x), o[d0][4 * rg + 1] * inv * bfhi(z.x)); w.y = pk2(o[d0][4 * rg + 2] * inv * bflo(z.y), o[d0][4 * rg + 3] * inv * bfhi(z.y));
            *(GAS u32x2*)(op + dim) = w; }
}
#undef MXP_EXP8

#elif defined(MLA_MX)
struct MlaPtrs { const bf16* Q; const bf16* K; const bf16* V; const bf16* Z; bf16* O; };
__device__ __forceinline__ void mla_unit(LAS unsigned char* lds, const MlaPtrs& P, int head, int qb, int tid_in, int wave, int lane_in) {
    int tid = tid_in; asm volatile("" : "+v"(tid)); const int lane = tid & 63; (void)lane_in;
    const int r32 = lane & 31, hi = lane >> 5;
    const int q0 = qb * 256, qw = q0 + wave * 32, tq = qw + r32;
    i32x8 q[3];
    { const unsigned char* qp = (const unsigned char*)P.Q + (size_t)tq * 3072 + head * 192 + hi * 32;
#pragma unroll
      for (int s = 0; s < 3; ++s) { const u32x4 a = *(const GAS u32x4*)(qp + 64 * s), b = *(const GAS u32x4*)(qp + 64 * s + 16);
          q[s] = (i32x8){(int)a.x, (int)a.y, (int)a.z, (int)a.w, (int)b.x, (int)b.y, (int)b.z, (int)b.w}; } }
    const int NT = 4 * (qb + 1);
    const int srow = tid >> 3, sc8 = tid & 7;
    const unsigned char* kg = (const unsigned char*)P.K + (size_t)head * 192 + (size_t)srow * 3072 + sc8 * 8;
    const unsigned char* vg = (const unsigned char*)P.V + ((size_t)head * 128 + (tid >> 2)) * S + (tid & 3) * 16;
    LAS unsigned char* kst = lds + srow * KSX + sc8 * 8;
    LAS unsigned char* vst = lds + 2 * MLA_KBX + (tid >> 2) * VSX + (tid & 3) * 16;
    const LAS unsigned char* kl = lds + r32 * KSX + hi * 32;
    const LAS unsigned char* vl = lds + 2 * MLA_KBX + r32 * VSX + hi * 32;
    u32x2 sk0, sk1, sk2; u32x4 sv0;
#define MLA_LOAD(j) do { const unsigned char* kp_ = kg + (size_t)(j) * (64 * 3072); const unsigned char* vp_ = vg + (size_t)(j) * 64; \
        sk0 = *(const GAS u32x2*)(kp_); sk1 = *(const GAS u32x2*)(kp_ + 64); sk2 = *(const GAS u32x2*)(kp_ + 128); sv0 = *(const GAS u32x4*)(vp_); } while (0)
#define MLA_STORE(b, vb) do { LAS unsigned char* kd_ = kst + (b) * MLA_KBX; LAS unsigned char* vd_ = vst + (vb) * VBX; \
        *(LAS u32x2*)(kd_) = sk0; *(LAS u32x2*)(kd_ + 64) = sk1; *(LAS u32x2*)(kd_ + 128) = sk2; *(LAS u32x2*)(vd_) = (u32x2){sv0.x, sv0.y}; *(LAS u32x2*)(vd_ + 8) = (u32x2){sv0.z, sv0.w}; } while (0)
    MLA_LOAD(0); MLA_STORE(0, 0);
    __syncthreads();
    asm volatile("" : "+v"(q[0]), "+v"(q[1]), "+v"(q[2]));
    float m = -1e30f, l = 0.f; f32x16 o[4];
#pragma unroll
    for (int d = 0; d < 4; ++d)
#pragma unroll
        for (int r = 0; r < 16; ++r) o[d][r] = 0.f;
    const bool trail = wave >= 4;
    i32x8 pb = {};
    int vb_cur = 0, vb_prev = 2;
    for (int j = 0; j < NT; ++j) {
        const int kb = 64 * j;
        int vb_next = vb_cur + 1; if (vb_next == 3) vb_next = 0;
        if (j + 1 < NT) MLA_LOAD(j + 1);
        if (trail && j > 0 && kb - 64 <= qw + 31) pv_tilex(o, pb, vl + vb_prev * VBX);
        if (kb <= qw + 31) {
            f32x16 p0, p1;
            qk_tilex(p0, p1, kl + (j & 1) * MLA_KBX, q);
            if (kb + 63 > qw) {
                const int dq = tq - kb - 4 * hi;
#pragma unroll
                for (int r = 0; r < 16; ++r) { const int c = (r & 3) + 8 * (r >> 2);
                    if (c > dq) p0[r] = -__builtin_inff();
                    if (c + 32 > dq) p1[r] = -__builtin_inff(); }
            }
            online_sm_x(p0, p1, m, l, o, QS_MLA);
            pb = packpx(p0, p1);
            if (!trail) pv_tilex(o, pb, vl + vb_cur * VBX);
        }
        if (j + 1 < NT) MLA_STORE((j + 1) & 1, vb_next);
        __syncthreads();
        vb_prev = vb_cur; vb_cur = vb_next;
    }
    if (trail && 64 * (NT - 1) <= qw + 31) pv_tilex(o, pb, vl + vb_prev * VBX);
    __syncthreads();
#undef MLA_LOAD
#undef MLA_STORE
    const float inv = 1.f / l;
    const bf16* zp = P.Z + (size_t)tq * 2048 + head * 128 + 4 * hi;
    bf16* op = P.O + (size_t)tq * 4096 + head * 128 + 4 * hi;
#pragma unroll
    for (int d0 = 0; d0 < 4; ++d0)
#pragma unroll
        for (int rg = 0; rg < 4; ++rg) { const int dim = 32 * d0 + 8 * rg;
            const u32x2 z = *(const GAS u32x2*)(zp + dim);
            u32x2 w; w.x = pk2(o[d0][4 * rg + 0] * inv * bflo(z.x), o[d0][4 * rg + 1] * inv * bfhi(z.x)); w.y = pk2(o[d0][4 * rg + 2] * inv * bflo(z.y), o[d0][4 * rg + 3] * inv * bfhi(z.y));
            *(GAS u32x2*)(op + dim) = w; }
}

#elif defined(MLA_BIG)
struct MlaPtrs { const bf16* Q; const bf16* K; const bf16* V; const bf16* Z; bf16* O; };
__device__ __forceinline__ void mla_unit(LAS unsigned char* lds, const MlaPtrs& P, int head, int qb, int tid_in, int wave, int lane_in) {
    int tid = tid_in; asm volatile("" : "+v"(tid)); const int lane = tid & 63; (void)lane_in;
    const int r32 = lane & 31, hi = lane >> 5;
    const int q0 = qb * 256, qw = q0 + wave * 32, tq = qw + r32;
    i64 q[12];
    { const unsigned char* qp = (const unsigned char*)P.Q + (size_t)tq * 3072 + head * 192 + hi * 8;
#pragma unroll
      for (int d0 = 0; d0 < 12; ++d0) q[d0] = *(const GAS i64*)(qp + d0 * 16); }
    const int NT = 4 * (qb + 1), NTB = NT / 2;
    const int srow = tid >> 3, sc8 = tid & 7;
    const unsigned char* kg = (const unsigned char*)P.K + (size_t)head * 192 + (size_t)srow * 3072 + sc8 * 8;
    const unsigned char* vg = (const unsigned char*)P.V + ((size_t)head * 128 + (tid >> 2)) * S + (tid & 3) * 32;
    LAS unsigned char* kst = lds + srow * KS8 + sc8 * 8;
    LAS unsigned char* vst = lds + 2 * MLA_KB8B + (tid >> 2) * VS8B + (tid & 3) * 32;
    const LAS unsigned char* kl = lds + r32 * KS8 + hi * 8;
    const LAS unsigned char* vl = lds + 2 * MLA_KB8B + r32 * VS8B + hi * 8;
    u32x2 sk0, sk1, sk2, sk3, sk4, sk5; u32x4 sv0, sv1;
#define MLA_LOAD(J) do { const unsigned char* kp_ = kg + (size_t)(J) * (128 * 3072); const unsigned char* vp_ = vg + (size_t)(J) * 128; \
        sk0 = *(const GAS u32x2*)(kp_); sk1 = *(const GAS u32x2*)(kp_ + 64); sk2 = *(const GAS u32x2*)(kp_ + 128); \
        sk3 = *(const GAS u32x2*)(kp_ + 64 * 3072); sk4 = *(const GAS u32x2*)(kp_ + 64 * 3072 + 64); sk5 = *(const GAS u32x2*)(kp_ + 64 * 3072 + 128); \
        sv0 = *(const GAS u32x4*)(vp_); sv1 = *(const GAS u32x4*)(vp_ + 16); } while (0)
#define MLA_STORE(b, vb) do { LAS unsigned char* kd_ = kst + (b) * MLA_KB8B; LAS unsigned char* vd_ = vst + (vb) * VB8B; \
        *(LAS u32x2*)(kd_) = sk0; *(LAS u32x2*)(kd_ + 64) = sk1; *(LAS u32x2*)(kd_ + 128) = sk2; \
        *(LAS u32x2*)(kd_ + 64 * KS8) = sk3; *(LAS u32x2*)(kd_ + 64 * KS8 + 64) = sk4; *(LAS u32x2*)(kd_ + 64 * KS8 + 128) = sk5; \
        *(LAS u32x2*)(vd_) = (u32x2){sv0.x, sv0.y}; *(LAS u32x2*)(vd_ + 8) = (u32x2){sv0.z, sv0.w}; *(LAS u32x2*)(vd_ + 16) = (u32x2){sv1.x, sv1.y}; *(LAS u32x2*)(vd_ + 24) = (u32x2){sv1.z, sv1.w}; } while (0)
    MLA_LOAD(0); MLA_STORE(0, 0);
    __syncthreads();
    float m = -1e30f, l = 0.f; f32x16 o[4];
#pragma unroll
    for (int d = 0; d < 4; ++d)
#pragma unroll
        for (int r = 0; r < 16; ++r) o[d][r] = 0.f;
    const bool trail = wave >= 4;
    i64 pb[4] = {};
    int vb_cur = 0, vb_prev = 2;
    for (int J = 0; J < NTB; ++J) {
        int vb_next = vb_cur + 1; if (vb_next == 3) vb_next = 0;
        if (J + 1 < NTB) MLA_LOAD(J + 1);
#pragma unroll
        for (int sub = 0; sub < 2; ++sub) {
            const int j = 2 * J + sub, kb = 64 * j;
            if (trail && j > 0 && kb - 64 <= qw + 31) pv_tile8(o, pb, vl + (sub == 0 ? vb_prev * VB8B + 64 : vb_cur * VB8B));
            if (kb <= qw + 31) {
                f32x16 p0, p1;
                qk_tile8<12>(p0, p1, kl + (J & 1) * MLA_KB8B + sub * 64 * KS8, q);
                if (kb + 63 > qw) {
                    const int dq = tq - kb - 4 * hi;
#pragma unroll
                    for (int r = 0; r < 16; ++r) { const int c = (r & 3) + 8 * (r >> 2);
                        if (c > dq) p0[r] = -__builtin_inff();
                        if (c + 32 > dq) p1[r] = -__builtin_inff(); }
                }
                online_sm_scaled(p0, p1, m, l, o, QS_MLA);
                pb[0] = packp8<0>(p0); pb[1] = packp8<1>(p0); pb[2] = packp8<0>(p1); pb[3] = packp8<1>(p1);
                if (!trail) pv_tile8(o, pb, vl + vb_cur * VB8B + sub * 64);
            }
        }
        if (J + 1 < NTB) MLA_STORE((J + 1) & 1, vb_next);
        __syncthreads();
        vb_prev = vb_cur; vb_cur = vb_next;
    }
    if (trail && 64 * (NT - 1) <= qw + 31) pv_tile8(o, pb, vl + vb_prev * VB8B + 64);
    __syncthreads();
#undef MLA_LOAD
#undef MLA_STORE
    const float inv = (1.f / 256.f) / l;
    const bf16* zp = P.Z + (size_t)tq * 2048 + head * 128 + 4 * hi;
    bf16* op = P.O + (size_t)tq * 4096 + head * 128 + 4 * hi;
#pragma unroll
    for (int d0 = 0; d0 < 4; ++d0)
#pragma unroll
        for (int rg = 0; rg < 4; ++rg) { const int dim = 32 * d0 + 8 * rg;
            const u32x2 z = *(const GAS u32x2*)(zp + dim);
            u32x2 w; w.x = pk2(o[d0][4 * rg + 0] * inv * bflo(z.x), o[d0][4 * rg + 1] * inv * bfhi(z.x)); w.y = pk2(o[d0][4 * rg + 2] * inv * bflo(z.y), o[d0][4 * rg + 3] * inv * bfhi(z.y));
            *(GAS u32x2*)(op + dim) = w; }
}

#elif defined(MLA_FP8V)
struct MlaPtrs { const bf16* Q; const bf16* K; const bf16* V; const bf16* Z; bf16* O; };
__device__ __forceinline__ void mla_unit(LAS unsigned char* lds, const MlaPtrs& P, int head, int qb, int tid_in, int wave, int lane_in) {
    int tid = tid_in; asm volatile("" : "+v"(tid)); const int lane = tid & 63; (void)lane_in;
    const int r32 = lane & 31, hi = lane >> 5;
    const int q0 = qb * 256, qw = q0 + wave * 32, tq = qw + r32;
    i64 q[12];
    { const unsigned char* qp = (const unsigned char*)P.Q + (size_t)tq * 3072 + head * 192 + hi * 8;
#pragma unroll
      for (int d0 = 0; d0 < 12; ++d0) q[d0] = *(const GAS i64*)(qp + d0 * 16); }
    const int NT = 4 * (qb + 1);
    const int srow = tid >> 3, sc8 = tid & 7;
    const unsigned char* kg = (const unsigned char*)P.K + (size_t)head * 192 + (size_t)srow * 3072 + sc8 * 8;
    const unsigned char* vg = (const unsigned char*)P.V + ((size_t)head * 128 + (tid >> 2)) * S + (tid & 3) * 16;
    LAS unsigned char* kst = lds + srow * KS8 + sc8 * 8;
    LAS unsigned char* vst = lds + 2 * MLA_KB8 + (tid >> 2) * VS8 + (tid & 3) * 16;
    const LAS unsigned char* kl = lds + r32 * KS8 + hi * 8;
    const LAS unsigned char* vl = lds + 2 * MLA_KB8 + r32 * VS8 + hi * 8;
    u32x2 sk0, sk1, sk2; u32x4 sv0;
#define MLA_LOAD(j) do { const unsigned char* kp_ = kg + (size_t)(j) * (64 * 3072); const unsigned char* vp_ = vg + (size_t)(j) * 64; \
        sk0 = *(const GAS u32x2*)(kp_); sk1 = *(const GAS u32x2*)(kp_ + 64); sk2 = *(const GAS u32x2*)(kp_ + 128); sv0 = *(const GAS u32x4*)(vp_); } while (0)
#define MLA_STORE(b, vb) do { LAS unsigned char* kd_ = kst + (b) * MLA_KB8; LAS unsigned char* vd_ = vst + (vb) * VB8; \
        *(LAS u32x2*)(kd_) = sk0; *(LAS u32x2*)(kd_ + 64) = sk1; *(LAS u32x2*)(kd_ + 128) = sk2; *(LAS u32x2*)(vd_) = (u32x2){sv0.x, sv0.y}; *(LAS u32x2*)(vd_ + 8) = (u32x2){sv0.z, sv0.w}; } while (0)
    MLA_LOAD(0); MLA_STORE(0, 0);
    __syncthreads();
    float m = -1e30f, l = 0.f; f32x16 o[4];
#pragma unroll
    for (int d = 0; d < 4; ++d)
#pragma unroll
        for (int r = 0; r < 16; ++r) o[d][r] = 0.f;
    const bool trail = wave >= 4;
    i64 pb[4] = {};
    int vb_cur = 0, vb_prev = 2;
    for (int j = 0; j < NT; ++j) {
        const int kb = 64 * j;
        int vb_next = vb_cur + 1; if (vb_next == 3) vb_next = 0;
        if (j + 1 < NT) MLA_LOAD(j + 1);
        if (trail && j > 0 && kb - 64 <= qw + 31) pv_tile8(o, pb, vl + vb_prev * VB8);
        if (kb <= qw + 31) {
            f32x16 p0, p1;
#ifdef PROBE_QKM2
            { f32x16 r0, r1; qk_tile_m2<12, KS_M>(p0, p1, r0, r1, kl + (j & 1) * MLA_KB, q);
#pragma unroll
              for (int r = 0; r < 16; ++r) { p0[r] = (p0[r] + r0[r]) * 0.5f; p1[r] = (p1[r] + r1[r]) * 0.5f; } }
#else
            qk_tile8<12>(p0, p1, kl + (j & 1) * MLA_KB8, q);
#endif
#ifdef PROBE_QK2
            { f32x16 r0, r1; asm volatile("" ::: "memory"); qk_tile<12, KS_M>(r0, r1, kl + (j & 1) * MLA_KB, q);
#pragma unroll
              for (int r = 0; r < 16; ++r) { p0[r] = (p0[r] + r0[r]) * 0.5f; p1[r] = (p1[r] + r1[r]) * 0.5f; } }
#endif
#ifdef PROBE_SM2
            { float acc_ = 0.f;
#pragma unroll
              for (int r = 0; r < 16; ++r) { acc_ += __builtin_amdgcn_exp2f(p0[r] - m - 40.f) + __builtin_amdgcn_exp2f(p1[r] - m - 40.f); }
#pragma unroll
              for (int r = 0; r < 16; ++r) { acc_ += __builtin_amdgcn_exp2f(p0[r] - m - 50.f) + __builtin_amdgcn_exp2f(p1[r] - m - 50.f); }
              if (acc_ == 12345.678f) l += 1.f; }
#endif
            if (kb + 63 > qw) {
                const int dq = tq - kb - 4 * hi;
#pragma unroll
                for (int r = 0; r < 16; ++r) { const int c = (r & 3) + 8 * (r >> 2);
                    if (c > dq) p0[r] = -__builtin_inff();
                    if (c + 32 > dq) p1[r] = -__builtin_inff(); }
            }
            online_sm_scaled(p0, p1, m, l, o, QS_MLA);
            pb[0] = packp8<0>(p0); pb[1] = packp8<1>(p0); pb[2] = packp8<0>(p1); pb[3] = packp8<1>(p1);
            if (!trail) pv_tile8(o, pb, vl + vb_cur * VB8);
        }
        if (j + 1 < NT) MLA_STORE((j + 1) & 1, vb_next);
        __syncthreads();
        vb_prev = vb_cur; vb_cur = vb_next;
    }
    if (trail && 64 * (NT - 1) <= qw + 31) pv_tile8(o, pb, vl + vb_prev * VB8);
    __syncthreads();
#undef MLA_LOAD
#undef MLA_STORE
    const float inv = (1.f / 256.f) / l;
    const bf16* zp = P.Z + (size_t)tq * 2048 + head * 128 + 4 * hi;
    bf16* op = P.O + (size_t)tq * 4096 + head * 128 + 4 * hi;
#pragma unroll
    for (int d0 = 0; d0 < 4; ++d0)
#pragma unroll
        for (int rg = 0; rg < 4; ++rg) { const int dim = 32 * d0 + 8 * rg;
            const u32x2 z = *(const GAS u32x2*)(zp + dim);
            u32x2 w; w.x = pk2(o[d0][4 * rg + 0] * inv * bflo(z.x), o[d0][4 * rg + 1] * inv * bfhi(z.x)); w.y = pk2(o[d0][4 * rg + 2] * inv * bflo(z.y), o[d0][4 * rg + 3] * inv * bfhi(z.y));
            *(GAS u32x2*)(op + dim) = w; }
}

#elif defined(MLA_FP8)
struct MlaPtrs { const bf16* Q; const bf16* K; const bf16* V; const bf16* Z; bf16* O; };
__device__ __forceinline__ void mla_unit(LAS unsigned char* lds, const MlaPtrs& P, int head, int qb, int tid_in, int wave, int lane_in) {
    int tid = tid_in; asm volatile("" : "+v"(tid)); const int lane = tid & 63; (void)lane_in;
    const int r32 = lane & 31, hi = lane >> 5;
    const int q0 = qb * 256, qw = q0 + wave * 32, tq = qw + r32;
    i64 q[12];
    { const unsigned char* qp = (const unsigned char*)P.Q + (size_t)tq * 3072 + head * 192 + hi * 8;
#pragma unroll
      for (int d0 = 0; d0 < 12; ++d0) q[d0] = *(const GAS i64*)(qp + d0 * 16); }
    const int NT = 4 * (qb + 1);
    const int srow = tid >> 3, sc8 = tid & 7;
    const unsigned char* kg = (const unsigned char*)P.K + (size_t)head * 192 + (size_t)srow * 3072 + sc8 * 8;
    const unsigned char* vg = (const unsigned char*)P.V + (size_t)head * 256 + (size_t)srow * 4096 + sc8 * 16;
    LAS unsigned char* kst = lds + srow * KS8 + sc8 * 8;
    LAS unsigned char* vst = lds + 2 * MLA_KB8 + srow * VS + sc8 * 16;
    const LAS unsigned char* kl = lds + r32 * KS8 + hi * 8;
    const LAS unsigned char* vl = lds + 2 * MLA_KB8 + (4 * hi + ((lane & 15) >> 2)) * VS + (16 * ((lane >> 4) & 1) + 4 * (lane & 3)) * 2;
    u32x2 sk0, sk1, sk2; u32x4 sv0, sv1;
#define MLA_LOAD(j) do { const unsigned char* kp_ = kg + (size_t)(j) * (64 * 3072); const unsigned char* vp_ = vg + (size_t)(j) * (64 * 4096); \
        sk0 = *(const GAS u32x2*)(kp_); sk1 = *(const GAS u32x2*)(kp_ + 64); sk2 = *(const GAS u32x2*)(kp_ + 128); sv0 = *(const GAS u32x4*)(vp_); sv1 = *(const GAS u32x4*)(vp_ + 128); } while (0)
#define MLA_STORE(b, vb) do { LAS unsigned char* kd_ = kst + (b) * MLA_KB8; LAS unsigned char* vd_ = vst + (vb) * VB; \
        *(LAS u32x2*)(kd_) = sk0; *(LAS u32x2*)(kd_ + 64) = sk1; *(LAS u32x2*)(kd_ + 128) = sk2; *(LAS u32x4*)(vd_) = sv0; *(LAS u32x4*)(vd_ + 128) = sv1; } while (0)
    MLA_LOAD(0); MLA_STORE(0, 0);
    __syncthreads();
    float m = -1e30f, l = 0.f; f32x16 o[4];
#pragma unroll
    for (int d = 0; d < 4; ++d)
#pragma unroll
        for (int r = 0; r < 16; ++r) o[d][r] = 0.f;
    const bool trail = wave >= 4;
    bf16x8 pb[4] = {};
    int vb_cur = 0, vb_prev = 2;
    for (int j = 0; j < NT; ++j) {
        const int kb = 64 * j;
        int vb_next = vb_cur + 1; if (vb_next == 3) vb_next = 0;
        if (j + 1 < NT) MLA_LOAD(j + 1);
        if (trail && j > 0 && kb - 64 <= qw + 31) pv_tile(o, pb, vl + vb_prev * VB);
        if (kb <= qw + 31) {
            f32x16 p0, p1;
#ifdef PROBE_QKM2
            { f32x16 r0, r1; qk_tile_m2<12, KS_M>(p0, p1, r0, r1, kl + (j & 1) * MLA_KB, q);
#pragma unroll
              for (int r = 0; r < 16; ++r) { p0[r] = (p0[r] + r0[r]) * 0.5f; p1[r] = (p1[r] + r1[r]) * 0.5f; } }
#else
            qk_tile8<12>(p0, p1, kl + (j & 1) * MLA_KB8, q);
#endif
#ifdef PROBE_QK2
            { f32x16 r0, r1; asm volatile("" ::: "memory"); qk_tile<12, KS_M>(r0, r1, kl + (j & 1) * MLA_KB, q);
#pragma unroll
              for (int r = 0; r < 16; ++r) { p0[r] = (p0[r] + r0[r]) * 0.5f; p1[r] = (p1[r] + r1[r]) * 0.5f; } }
#endif
#ifdef PROBE_SM2
            { float acc_ = 0.f;
#pragma unroll
              for (int r = 0; r < 16; ++r) { acc_ += __builtin_amdgcn_exp2f(p0[r] - m - 40.f) + __builtin_amdgcn_exp2f(p1[r] - m - 40.f); }
#pragma unroll
              for (int r = 0; r < 16; ++r) { acc_ += __builtin_amdgcn_exp2f(p0[r] - m - 50.f) + __builtin_amdgcn_exp2f(p1[r] - m - 50.f); }
              if (acc_ == 12345.678f) l += 1.f; }
#endif
            if (kb + 63 > qw) {
                const int dq = tq - kb - 4 * hi;
#pragma unroll
                for (int r = 0; r < 16; ++r) { const int c = (r & 3) + 8 * (r >> 2);
                    if (c > dq) p0[r] = -__builtin_inff();
                    if (c + 32 > dq) p1[r] = -__builtin_inff(); }
            }
            online_sm_scaled(p0, p1, m, l, o, QS_MLA);
            pb[0] = packp<0>(p0); pb[1] = packp<1>(p0); pb[2] = packp<0>(p1); pb[3] = packp<1>(p1);
            if (!trail) pv_tile(o, pb, vl + vb_cur * VB);
        }
        if (j + 1 < NT) MLA_STORE((j + 1) & 1, vb_next);
        __syncthreads();
        vb_prev = vb_cur; vb_cur = vb_next;
    }
    if (trail && 64 * (NT - 1) <= qw + 31) pv_tile(o, pb, vl + vb_prev * VB);
    __syncthreads();
#undef MLA_LOAD
#undef MLA_STORE
    const float inv = 1.f / l;
    const bf16* zp = P.Z + (size_t)tq * 2048 + head * 128 + 4 * hi;
    bf16* op = P.O + (size_t)tq * 4096 + head * 128 + 4 * hi;
#pragma unroll
    for (int d0 = 0; d0 < 4; ++d0)
#pragma unroll
        for (int rg = 0; rg < 4; ++rg) { const int dim = 32 * d0 + 8 * rg;
            const u32x2 z = *(const GAS u32x2*)(zp + dim);
            u32x2 w; w.x = pk2(o[d0][4 * rg + 0] * inv * bflo(z.x), o[d0][4 * rg + 1] * inv * bfhi(z.x)); w.y = pk2(o[d0][4 * rg + 2] * inv * bflo(z.y), o[d0][4 * rg + 3] * inv * bfhi(z.y));
            *(GAS u32x2*)(op + dim) = w; }
}

#else
struct MlaPtrs { const bf16* Q; const bf16* K; const bf16* V; const bf16* Z; bf16* O; };
__device__ __forceinline__ void mla_unit(LAS unsigned char* lds, const MlaPtrs& P, int head, int qb, int tid_in, int wave, int lane_in) {
    int tid = tid_in; asm volatile("" : "+v"(tid)); const int lane = tid & 63; (void)lane_in;
    const int r32 = lane & 31, hi = lane >> 5;
    const int q0 = qb * 256, qw = q0 + wave * 32, tq = qw + r32;
    bf16x8 q[12];
    { const bf16* qp = P.Q + (size_t)tq * 3072 + head * 192 + hi * 8;
#pragma unroll
      for (int d0 = 0; d0 < 12; ++d0) q[d0] = *(const GAS bf16x8*)(qp + d0 * 16); }
    const int NT = 4 * (qb + 1);
    const int srow = tid >> 3, sc8 = tid & 7;
    const unsigned char* kg = (const unsigned char*)P.K + (size_t)head * 384 + (size_t)srow * 6144 + sc8 * 16;
    const unsigned char* vg = (const unsigned char*)P.V + (size_t)head * 256 + (size_t)srow * 4096 + sc8 * 16;
    LAS unsigned char* kst = lds + srow * KS_M + sc8 * 16;
    LAS unsigned char* vst = lds + 2 * MLA_KB + srow * VS + sc8 * 16;
    const LAS unsigned char* kl = lds + r32 * KS_M + hi * 16;
    const LAS unsigned char* vl = lds + 2 * MLA_KB + (4 * hi + ((lane & 15) >> 2)) * VS + (16 * ((lane >> 4) & 1) + 4 * (lane & 3)) * 2;
    u32x4 sk0, sk1, sk2, sv0, sv1;
#define MLA_LOAD(j) do { const unsigned char* kp_ = kg + (size_t)(j) * (64 * 6144); const unsigned char* vp_ = vg + (size_t)(j) * (64 * 4096); \
        sk0 = *(const GAS u32x4*)(kp_); sk1 = *(const GAS u32x4*)(kp_ + 128); sk2 = *(const GAS u32x4*)(kp_ + 256); sv0 = *(const GAS u32x4*)(vp_); sv1 = *(const GAS u32x4*)(vp_ + 128); } while (0)
#define MLA_STORE(b, vb) do { LAS unsigned char* kd_ = kst + (b) * MLA_KB; LAS unsigned char* vd_ = vst + (vb) * VB; \
        *(LAS u32x4*)(kd_) = sk0; *(LAS u32x4*)(kd_ + 128) = sk1; *(LAS u32x4*)(kd_ + 256) = sk2; *(LAS u32x4*)(vd_) = sv0; *(LAS u32x4*)(vd_ + 128) = sv1; } while (0)
    MLA_LOAD(0); MLA_STORE(0, 0);
    __syncthreads();
    float m = -1e30f, l = 0.f; f32x16 o[4];
#pragma unroll
    for (int d = 0; d < 4; ++d)
#pragma unroll
        for (int r = 0; r < 16; ++r) o[d][r] = 0.f;
    const bool trail = wave >= 4;
    bf16x8 pb[4] = {};
    int vb_cur = 0, vb_prev = 2;
    for (int j = 0; j < NT; ++j) {
        const int kb = 64 * j;
        int vb_next = vb_cur + 1; if (vb_next == 3) vb_next = 0;
        if (j + 1 < NT) MLA_LOAD(j + 1);
        if (trail && j > 0 && kb - 64 <= qw + 31) pv_tile(o, pb, vl + vb_prev * VB);
        if (kb <= qw + 31) {
            f32x16 p0, p1;
#ifdef PROBE_QKM2
            { f32x16 r0, r1; qk_tile_m2<12, KS_M>(p0, p1, r0, r1, kl + (j & 1) * MLA_KB, q);
#pragma unroll
              for (int r = 0; r < 16; ++r) { p0[r] = (p0[r] + r0[r]) * 0.5f; p1[r] = (p1[r] + r1[r]) * 0.5f; } }
#else
            qk_tile<12, KS_M>(p0, p1, kl + (j & 1) * MLA_KB, q);
#endif
#ifdef PROBE_QK2
            { f32x16 r0, r1; asm volatile("" ::: "memory"); qk_tile<12, KS_M>(r0, r1, kl + (j & 1) * MLA_KB, q);
#pragma unroll
              for (int r = 0; r < 16; ++r) { p0[r] = (p0[r] + r0[r]) * 0.5f; p1[r] = (p1[r] + r1[r]) * 0.5f; } }
#endif
#ifdef PROBE_SM2
            { float acc_ = 0.f;
#pragma unroll
              for (int r = 0; r < 16; ++r) { acc_ += __builtin_amdgcn_exp2f(p0[r] - m - 40.f) + __builtin_amdgcn_exp2f(p1[r] - m - 40.f); }
#pragma unroll
              for (int r = 0; r < 16; ++r) { acc_ += __builtin_amdgcn_exp2f(p0[r] - m - 50.f) + __builtin_amdgcn_exp2f(p1[r] - m - 50.f); }
              if (acc_ == 12345.678f) l += 1.f; }
#endif
            if (kb + 63 > qw) {
                const int dq = tq - kb - 4 * hi;
#pragma unroll
                for (int r = 0; r < 16; ++r) { const int c = (r & 3) + 8 * (r >> 2);
                    if (c > dq) p0[r] = -__builtin_inff();
                    if (c + 32 > dq) p1[r] = -__builtin_inff(); }
            }
            online_sm(p0, p1, m, l, o);
            pb[0] = packp<0>(p0); pb[1] = packp<1>(p0); pb[2] = packp<0>(p1); pb[3] = packp<1>(p1);
            if (!trail) pv_tile(o, pb, vl + vb_cur * VB);
        }
        if (j + 1 < NT) MLA_STORE((j + 1) & 1, vb_next);
        __syncthreads();
        vb_prev = vb_cur; vb_cur = vb_next;
    }
    if (trail && 64 * (NT - 1) <= qw + 31) pv_tile(o, pb, vl + vb_prev * VB);
    __syncthreads();
#undef MLA_LOAD
#undef MLA_STORE
    const float inv = 1.f / l;
    const bf16* zp = P.Z + (size_t)tq * 2048 + head * 128 + 4 * hi;
    bf16* op = P.O + (size_t)tq * 4096 + head * 128 + 4 * hi;
#pragma unroll
    for (int d0 = 0; d0 < 4; ++d0)
#pragma unroll
        for (int rg = 0; rg < 4; ++rg) { const int dim = 32 * d0 + 8 * rg;
            const u32x2 z = *(const GAS u32x2*)(zp + dim);
            u32x2 w; w.x = pk2(o[d0][4 * rg + 0] * inv * bflo(z.x), o[d0][4 * rg + 1] * inv * bfhi(z.x)); w.y = pk2(o[d0][4 * rg + 2] * inv * bflo(z.y), o[d0][4 * rg + 3] * inv * bfhi(z.y));
            *(GAS u32x2*)(op + dim) = w; }
}

#endif
#endif
struct NsaPtrs { const bf16* Q; const bf16* KV; const bf16* KC; const bf16* VC; const bf16* Z; const float* G; bf16* O; float* scr; };
template <int MODE>
__device__ __forceinline__ void nsa_loop(LAS unsigned char* lds, const unsigned char* kbase, const unsigned char* vbase, int ntiles, int jlo,
                                         const bf16x8 (&q)[8], int t, float slope2, float& m, float& l, f32x16 (&o)[4], float invl, int tid, int wave, int lane) {
    constexpr bool HASV = MODE != 0;
    const int r32 = lane & 31, hi = lane >> 5;
    const int srow = tid >> 3, sc8 = tid & 7;
    const unsigned soff = srow * 256 + sc8 * 16;
    LAS unsigned char* kst = lds + srow * KS_N + sc8 * 16;
    LAS unsigned char* vst = lds + 2 * NSA_KB + srow * VS + sc8 * 16;
    const LAS unsigned char* kl = lds + r32 * KS_N + hi * 16;
    const LAS unsigned char* vl = lds + 2 * NSA_KB + (4 * hi + ((lane & 15) >> 2)) * VS + (16 * ((lane >> 4) & 1) + 4 * (lane & 3)) * 2;
    const LAS int* ulist = (const LAS int*)(lds + N_ULIST);
    const LAS unsigned* selm = (const LAS unsigned*)(lds + N_SELM);
    LAS float* partA = (LAS float*)(lds + N_PART); LAS float* partB = (LAS float*)(lds + N_PART + N_PARTB);
    LAS float* imp = (LAS float*)(lds + N_IMP); LAS float* carry = (LAS float*)(lds + N_CARRY);
    if (ntiles <= 0) return;
    u32x4 sk0, sk1, sv0, sv1;
#define NSA_TROW(j) (MODE == 2 ? 64 * __builtin_amdgcn_readfirstlane(ulist[(j)]) : 64 * (jlo + (j)))
#define NSA_LOAD(j) do { const size_t ro_ = (size_t)NSA_TROW(j) * 256 + soff; \
        sk0 = *(const GAS u32x4*)(kbase + ro_); sk1 = *(const GAS u32x4*)(kbase + ro_ + 128); \
        if (HASV) { sv0 = *(const GAS u32x4*)(vbase + ro_); sv1 = *(const GAS u32x4*)(vbase + ro_ + 128); } } while (0)
#define NSA_STORE(b) do { LAS unsigned char* kd_ = kst + (b) * NSA_KB; *(LAS u32x4*)(kd_) = sk0; *(LAS u32x4*)(kd_ + 128) = sk1; \
        if (HASV) { LAS unsigned char* vd_ = vst + (b) * VB; *(LAS u32x4*)(vd_) = sv0; *(LAS u32x4*)(vd_ + 128) = sv1; } } while (0)
    NSA_LOAD(0); NSA_STORE(0);
    __syncthreads();
    for (int j = 0; j < ntiles; ++j) {
        const int buf = j & 1;
        if (MODE != 1 && j + 1 < ntiles) NSA_LOAD(j + 1);
        const int trow = NSA_TROW(j);
        constexpr int PSTEP = (MODE <= 1) ? 16 : 1;
        const int pstart = (MODE <= 1) ? 16 * trow + 31 : trow;
        const int db = t - pstart - PSTEP * 4 * hi;
        constexpr unsigned W = (MODE == 3) ? 512u : 0x7fffffffu;
        float b0 = -slope2 * (float)db;
        if (MODE == 2) { const int b = trow >> 6; if (((selm[r32 * 8 + (b >> 5)] >> (b & 31)) & 1u) == 0u) b0 = -__builtin_inff(); }
        f32x16 p0, p1;
#pragma unroll
        for (int r = 0; r < 16; ++r) { const int c = PSTEP * ((r & 3) + 8 * (r >> 2));
            p0[r] = __builtin_fmaf(slope2, (float)c, b0); p1[r] = __builtin_fmaf(slope2, (float)(c + 32 * PSTEP), b0); }
        qk_tile<8, KS_N, false>(p0, p1, kl + buf * NSA_KB, q);
        { const int t0u = __builtin_amdgcn_readfirstlane(t - r32);
          const bool interior = (t0u - (pstart + PSTEP * 63) >= 0) && ((unsigned)(t0u + 31 - pstart) < W);
          if (!interior) {
#pragma unroll
              for (int r = 0; r < 16; ++r) { const int c = PSTEP * ((r & 3) + 8 * (r >> 2));
                  if ((unsigned)(db - c) >= W) p0[r] = -__builtin_inff();
                  if ((unsigned)(db - c - 32 * PSTEP) >= W) p1[r] = -__builtin_inff(); } } }
        if (MODE == 0) {
            float tm = p0[0];
#pragma unroll
            for (int r = 1; r < 16; ++r) tm = fmaxf(tm, p0[r]);
#pragma unroll
            for (int r = 0; r < 16; ++r) tm = fmaxf(tm, p1[r]);
            tm = swapmax(tm);
            const float mn = fmaxf(m, tm); const float alpha = __builtin_amdgcn_exp2f(m - mn); m = mn;
            float ps = 0.f;
#pragma unroll
            for (int r = 0; r < 16; ++r) ps += __builtin_amdgcn_exp2f(p0[r] - mn) + __builtin_amdgcn_exp2f(p1[r] - mn);
            l = l * alpha + swapsum(ps);
        } else if (MODE == 1) {
#pragma unroll
            for (int r = 0; r < 16; ++r) { p0[r] = __builtin_amdgcn_exp2f(p0[r] - m) * invl; p1[r] = __builtin_amdgcn_exp2f(p1[r] - m) * invl; }
            LAS float* pa = partA + (wave * 32 + r32) * 17 + hi; LAS float* pbm = partB + (wave * 32 + r32) * 17 + hi;
#pragma unroll
            for (int rg = 0; rg < 4; ++rg) {
                pa[2 * rg] = (p0[4 * rg] + p0[4 * rg + 1]) + (p0[4 * rg + 2] + p0[4 * rg + 3]); pbm[2 * rg] = p0[4 * rg + 3];
                pa[8 + 2 * rg] = (p1[4 * rg] + p1[4 * rg + 1]) + (p1[4 * rg + 2] + p1[4 * rg + 3]); pbm[8 + 2 * rg] = p1[4 * rg + 3]; }
            const bf16x8 pb[4] = {packp<0>(p0), packp<1>(p0), packp<0>(p1), packp<1>(p1)};
            pv_tile(o, pb, vl + buf * VB);
            __syncthreads();
            { const int qq = tid >> 4, jl = tid & 15; float a = 0.f, bp = 0.f, bl = 0.f;
#pragma unroll
              for (int w = 0; w < 8; ++w) { a += partA[(w * 32 + qq) * 17 + jl]; bl += partB[(w * 32 + qq) * 17 + jl]; }
              if (jl > 0) {
#pragma unroll
                  for (int w = 0; w < 8; ++w) bp += partB[(w * 32 + qq) * 17 + jl - 1];
              } else bp = (j > 0) ? carry[((j - 1) & 1) * 32 + qq] : 0.f;
              imp[qq * 256 + 16 * j + jl] = a + bp;
              if (jl == 15) carry[(j & 1) * 32 + qq] = bl; }
        } else {
            online_sm(p0, p1, m, l, o);
            const bf16x8 pb[4] = {packp<0>(p0), packp<1>(p0), packp<0>(p1), packp<1>(p1)};
            pv_tile(o, pb, vl + buf * VB);
        }
        if (MODE == 1 && j + 1 < ntiles) NSA_LOAD(j + 1);
        if (j + 1 < ntiles) NSA_STORE(buf ^ 1);
        __syncthreads();
    }
#undef NSA_TROW
#undef NSA_LOAD
#undef NSA_STORE
}
__device__ __forceinline__ void nsa_topk(const LAS float* improw, LAS unsigned* selrow, int cur, int lane) {
    unsigned key[4]; bool sel[4];
    int nforced = 0;
#pragma unroll
    for (int k = 0; k < 4; ++k) { const int j = lane + 64 * k;
        const bool forced = (j == 0) || (j == cur) || (j == cur - 1);
        const bool causal = j <= cur;
        sel[k] = forced;
#ifdef IMPNOISE_BUILD
        { unsigned h = (unsigned)j * 2654435761u + (unsigned)(size_t)improw * 40503u; h ^= h >> 15; h *= 0x846ca68bu; h ^= h >> 16;
          const float r = (float)(int)(h & 0xffffu) * (1.f / 32768.f) - 1.f; const float v = improw[j] * (1.f + IMPNOISE_EPS * r);
          key[k] = (causal && !forced) ? (__float_as_uint(v) + 1u) : 0u; }
#else
        key[k] = (causal && !forced) ? (__float_as_uint(improw[j]) + 1u) : 0u;
#endif
    }
    nforced = 1 + (cur >= 1 ? 1 : 0) + (cur >= 2 ? 1 : 0);
    const int want = 16 - nforced;
    for (int it = 0; it < want; ++it) {
        unsigned bk = key[0]; int bj = lane;
#pragma unroll
        for (int k = 1; k < 4; ++k) { if (key[k] > bk) { bk = key[k]; bj = lane + 64 * k; } }
        unsigned long long best = ((unsigned long long)bk << 32) | (unsigned)(0xffffffffu - (unsigned)bj);
#pragma unroll
        for (int off = 1; off < 64; off <<= 1) {
            const unsigned lo = __shfl_xor((unsigned)best, off), hiw = __shfl_xor((unsigned)(best >> 32), off);
            const unsigned long long other = ((unsigned long long)hiw << 32) | lo;
            best = other > best ? other : best; }
        if ((unsigned)(best >> 32) == 0u) break;
        const int wj = (int)(0xffffffffu - (unsigned)best);
#pragma unroll
        for (int k = 0; k < 4; ++k) if (wj == lane + 64 * k) { key[k] = 0u; sel[k] = true; }
    }
#pragma unroll
    for (int k = 0; k < 4; ++k) { const unsigned long long bm = __ballot(sel[k]);
        if (lane == 0) { selrow[2 * k] = (unsigned)bm; selrow[2 * k + 1] = (unsigned)(bm >> 32); } }
}
__device__ __forceinline__ void nsa_topk4(const LAS float* imp0, LAS unsigned* sel0, int cur, int lane) {
    unsigned key[4][4]; bool forced[4];
#pragma unroll
    for (int k = 0; k < 4; ++k) { const int j = lane + 64 * k;
        forced[k] = (j == 0) || (j == cur) || (j == cur - 1);
        const bool cand = (j <= cur) && !forced[k];
#pragma unroll
        for (int i = 0; i < 4; ++i) key[i][k] = cand ? (__float_as_uint(imp0[i * 256 + j]) + 1u) : 0u; }
    const int want = 16 - (1 + (cur >= 1 ? 1 : 0) + (cur >= 2 ? 1 : 0));
    unsigned T[4] = {0u, 0u, 0u, 0u};
    for (int bit = 30; bit >= 0; --bit) {
#pragma unroll
        for (int i = 0; i < 4; ++i) { const unsigned c = T[i] | (1u << bit);
            const int n = __builtin_popcountll(__ballot(key[i][0] >= c)) + __builtin_popcountll(__ballot(key[i][1] >= c)) + __builtin_popcountll(__ballot(key[i][2] >= c)) + __builtin_popcountll(__ballot(key[i][3] >= c));
            if (n >= want) T[i] = c; }
    }
#pragma unroll
    for (int i = 0; i < 4; ++i) {
        const unsigned Ti = T[i];
        int rem = want;
        if (Ti != 0u) rem -= __builtin_popcountll(__ballot(key[i][0] > Ti)) + __builtin_popcountll(__ballot(key[i][1] > Ti)) + __builtin_popcountll(__ballot(key[i][2] > Ti)) + __builtin_popcountll(__ballot(key[i][3] > Ti));
#pragma unroll
        for (int k = 0; k < 4; ++k) {
            bool s = forced[k];
            if (Ti == 0u) s = s || key[i][k] >= 1u;
            else {
                const bool eq = key[i][k] == Ti; const unsigned long long em = __ballot(eq);
                const int below = (int)__builtin_amdgcn_mbcnt_hi((unsigned)(em >> 32), __builtin_amdgcn_mbcnt_lo((unsigned)em, 0u));
                s = s || key[i][k] > Ti || (eq && below < rem);
                rem -= __builtin_popcountll(em); if (rem < 0) rem = 0;
            }
            const unsigned long long bm = __ballot(s);
            if (lane == 0) { sel0[i * 8 + 2 * k] = (unsigned)bm; sel0[i * 8 + 2 * k + 1] = (unsigned)(bm >> 32); }
        }
    }
}
__device__ __forceinline__ int nsa_opaque(int v) { asm volatile("" : "+v"(v)); return v; }
__device__ __forceinline__ void nsa_unit(LAS unsigned char* lds, const NsaPtrs& P, int g, int qblk, int tid_in, int wave, int lane_in, int cu) {
    int tid = tid_in; asm volatile("" : "+v"(tid));
    const int lane = tid & 63; (void)lane_in;
    const int r32 = lane & 31, hi = lane >> 5;
    const int hh = 8 * g + wave, t0 = 32 * qblk, t = t0 + r32;
    const float slope2 = __builtin_amdgcn_exp2f(-0.5f * (float)(hh + 1)) * LOG2E;
    bf16x8 q[8];
    { const bf16* qp = P.Q + (size_t)t * 2048 + hh * 128 + hi * 8;
#pragma unroll
      for (int d0 = 0; d0 < 8; ++d0) q[d0] = *(const GAS bf16x8*)(qp + d0 * 16); }
#define NSA_SCR() ((GAS f32x4*)(P.scr + ((size_t)(cu * 8 + wave) * 16) * 256) + nsa_opaque(lane))
    const size_t CH = (size_t)S * 128 * 2;
    f32x16 o[4]; float m, l;
#define NSA_ZERO_O() do { _Pragma("unroll") for (int d_ = 0; d_ < 4; ++d_) _Pragma("unroll") for (int r_ = 0; r_ < 16; ++r_) o[d_][r_] = 0.f; } while (0)
    const int ncv = 2 * qblk + 1, ntc = (ncv + 63) >> 6;
    const unsigned char* kc = (const unsigned char*)P.KC + (size_t)g * 1024 * 256; const unsigned char* vc = (const unsigned char*)P.VC + (size_t)g * 1024 * 256;
    m = -1e30f; l = 0.f; NSA_ZERO_O();
    nsa_loop<0>(lds, kc, vc, ntc, 0, q, t, slope2, m, l, o, 0.f, tid, wave, lane);
    const float invl = l > 0.f ? 1.f / l : 0.f;
    nsa_loop<1>(lds, kc, vc, ntc, 0, q, t, slope2, m, l, o, invl, tid, wave, lane);
    { const float g_c = P.G[(size_t)t * 48 + hh]; GAS f32x4* scr = NSA_SCR();
#pragma unroll
    for (int d0 = 0; d0 < 4; ++d0)
#pragma unroll
        for (int rg = 0; rg < 4; ++rg) { f32x4 v = {o[d0][4 * rg] * g_c, o[d0][4 * rg + 1] * g_c, o[d0][4 * rg + 2] * g_c, o[d0][4 * rg + 3] * g_c}; scr[(d0 * 4 + rg) * 64] = v; } }
    const int cur = t0 >> 6;
    LAS unsigned* selm = (LAS unsigned*)(lds + N_SELM);
#ifdef NSA_TOPK_ITER
    for (int i = 0; i < 4; ++i) { const int qq = 4 * wave + i; nsa_topk((const LAS float*)(lds + N_IMP) + qq * 256, selm + qq * 8, cur, lane); }
#else
    nsa_topk4((const LAS float*)(lds + N_IMP) + 4 * wave * 256, selm + 4 * wave * 8, cur, lane);
#endif
    __syncthreads();
    if (wave == 0) {
        LAS int* ulist = (LAS int*)(lds + N_ULIST); int n = 0;
        for (int k = 0; k < 8; ++k) { unsigned u = (lane < 32) ? selm[lane * 8 + k] : 0u;
#pragma unroll
            for (int off = 1; off < 32; off <<= 1) u |= __shfl_xor(u, off);
            u = __builtin_amdgcn_readfirstlane(u);
            while (u) { const int b = __builtin_ctz(u); u &= u - 1u; if (lane == 0) ulist[n] = 32 * k + b; ++n; } }
        if (lane == 0) *(LAS int*)(lds + N_NTS) = n;
    }
    __syncthreads();
    const int nts = __builtin_amdgcn_readfirstlane(*(const LAS int*)(lds + N_NTS));
    m = -1e30f; l = 0.f; NSA_ZERO_O();
    nsa_loop<2>(lds, (const unsigned char*)P.KV + (size_t)(4 + g) * CH, (const unsigned char*)P.KV + (size_t)(6 + g) * CH, nts, 0, q, t, slope2, m, l, o, 0.f, tid, wave, lane);
    { const float f = P.G[(size_t)t * 48 + 16 + hh] / l; GAS f32x4* scr = NSA_SCR();
#pragma unroll
      for (int d0 = 0; d0 < 4; ++d0)
          { f32x4 v[4];
#pragma unroll
            for (int rg = 0; rg < 4; ++rg) v[rg] = scr[(d0 * 4 + rg) * 64];
#pragma unroll
            for (int rg = 0; rg < 4; ++rg) { v[rg][0] += o[d0][4 * rg] * f; v[rg][1] += o[d0][4 * rg + 1] * f; v[rg][2] += o[d0][4 * rg + 2] * f; v[rg][3] += o[d0][4 * rg + 3] * f; scr[(d0 * 4 + rg) * 64] = v[rg]; } } }
    const int jlo = (t0 > 511 ? t0 - 511 : 0) >> 6, jhi = (t0 + 31) >> 6;
    m = -1e30f; l = 0.f; NSA_ZERO_O();
    nsa_loop<3>(lds, (const unsigned char*)P.KV + (size_t)(8 + g) * CH, (const unsigned char*)P.KV + (size_t)(10 + g) * CH, jhi - jlo + 1, jlo, q, t, slope2, m, l, o, 0.f, tid, wave, lane);
    { const float f = P.G[(size_t)t * 48 + 32 + hh] / l; GAS f32x4* scr = NSA_SCR();
      const bf16* zp = P.Z + (size_t)t * 2048 + hh * 128 + 4 * hi;
      bf16* op = P.O + (size_t)t * 4096 + 2048 + hh * 128 + 4 * hi;
#pragma unroll
      for (int d0 = 0; d0 < 4; ++d0)
          { f32x4 av[4]; u32x2 zv[4];
#pragma unroll
            for (int rg = 0; rg < 4; ++rg) { av[rg] = scr[(d0 * 4 + rg) * 64]; zv[rg] = *(const GAS u32x2*)(zp + 32 * d0 + 8 * rg); }
#pragma unroll
          for (int rg = 0; rg < 4; ++rg) { const int dim = 32 * d0 + 8 * rg; const f32x4 a = av[rg];
              const u32x2 z = zv[rg];
              u32x2 w; w.x = pk2((a[0] + o[d0][4 * rg] * f) * bflo(z.x), (a[1] + o[d0][4 * rg + 1] * f) * bfhi(z.x)); w.y = pk2((a[2] + o[d0][4 * rg + 2] * f) * bflo(z.y), (a[3] + o[d0][4 * rg + 3] * f) * bfhi(z.y));
              *(GAS u32x2*)(op + dim) = w; } } }
#undef NSA_ZERO_O
#undef NSA_SCR
}
struct CmpPtrs { const bf16* KV; const bf16* W1; const bf16* W2; const float* cbp; bf16* KC; bf16* VC; };
__device__ __forceinline__ void cmp_unit(LAS unsigned char* lds, const CmpPtrs& P, int kv, int g, int tile, int tid, int wave, int lane) {
    const int fr = lane & 15, fq = lane >> 4;
    constexpr int CRS = 544;
    LAS unsigned char* As = lds + 16384;
    LAS unsigned char* Ws = As + 16 * CRS;
    const unsigned char* Ag = (const unsigned char*)(P.KV + (size_t)(kv * 2 + g) * ((size_t)S * 128) + (size_t)(16 * tile + (tid >> 5)) * 2048) + (tid & 31) * 16;
    const unsigned char* Wg = (const unsigned char*)(P.W1 + (size_t)kv * 128 * 4096 + (size_t)(tid >> 5) * 4096) + (tid & 31) * 16;
    LAS unsigned char* Ad = As + (tid >> 5) * CRS + (tid & 31) * 16;
    LAS unsigned char* Wd = Ws + (tid >> 5) * CRS + (tid & 31) * 16;
    const LAS unsigned char* Ar = As + fr * CRS + fq * 16;
    const LAS unsigned char* Wr = Ws + (16 * wave + fr) * CRS + fq * 16;
    u32x4 ra, rw[8];
#define CMP_LOAD(c) do { ra = *(const GAS u32x4*)(Ag + (c) * 512); _Pragma("unroll") for (int i_ = 0; i_ < 8; ++i_) rw[i_] = *(const GAS u32x4*)(Wg + (size_t)i_ * (16 * 8192) + (c) * 512); } while (0)
    CMP_LOAD(0);
    f32x4 acc = {0.f, 0.f, 0.f, 0.f};
    for (int c = 0; c < 16; ++c) {
        *(LAS u32x4*)Ad = ra;
#pragma unroll
        for (int i = 0; i < 8; ++i) *(LAS u32x4*)(Wd + i * 16 * CRS) = rw[i];
        __syncthreads();
        if (c + 1 < 16) CMP_LOAD(c + 1);
#pragma unroll
        for (int s = 0; s < 8; ++s) {
            const bf16x8 a = *(const LAS bf16x8*)(Ar + 64 * s), b = *(const LAS bf16x8*)(Wr + 64 * s);
            acc = __builtin_amdgcn_mfma_f32_16x16x32_bf16(a, b, acc, 0, 0, 0);
        }
        __syncthreads();
    }
#undef CMP_LOAD
    float bias = 0.f;
    { float bv[16];
#pragma unroll
      for (int c = 0; c < 16; ++c) bv[c] = *(const GAS float*)(P.cbp + (size_t)(kv * 16 + c) * 128 + 16 * wave + fr);
#pragma unroll
      for (int c = 0; c < 16; ++c) bias += bv[c]; }
    LAS bf16* hid = (LAS bf16*)lds;
#pragma unroll
    for (int i = 0; i < 4; ++i) hid[(4 * fq + i) * 136 + 16 * wave + fr] = (bf16)(pk2(silu_f(acc[i] + bias), 0.f) & 0xffffu);
    __syncthreads();
    const bf16* B2 = P.W2 + (size_t)kv * 128 * 128 + (size_t)(16 * wave + fr) * 128 + 8 * fq;
    f32x4 acc2 = {0.f, 0.f, 0.f, 0.f};
#pragma unroll
    for (int s = 0; s < 4; ++s) {
        const bf16x8 a = *(const LAS bf16x8*)(hid + fr * 136 + 32 * s + 8 * fq), b = *(const GAS bf16x8*)(B2 + 32 * s);
        acc2 = __builtin_amdgcn_mfma_f32_16x16x32_bf16(a, b, acc2, 0, 0, 0);
    }
    bf16* out = (kv ? P.VC : P.KC) + (size_t)g * 1024 * 128;
#pragma unroll
    for (int i = 0; i < 4; ++i) { const int nn = 16 * tile + 4 * fq + i; out[(size_t)nn * 128 + 16 * wave + fr] = (nn < 1023) ? (bf16)(pk2(acc2[i], 0.f) & 0xffffu) : (bf16)0; }
    __syncthreads();
}
}
#ifdef CHK_BUILD
namespace chk {
constexpr size_t WS_CHK = 14 * MiB;
__device__ __forceinline__ float bf2f(bf16 v) { return __uint_as_float((unsigned)v << 16); }
__device__ __forceinline__ float e4m3(unsigned char b) {
    const int e = (b >> 3) & 15, mm = b & 7; const float v = e == 0 ? (float)mm * (1.f / 512.f) : (1.f + (float)mm * 0.125f) * exp2f((float)(e - 7)); return (b & 0x80) ? -v : v; }
__device__ __forceinline__ int sample_t(int i) { return i * 64 + (i * 29) % 64; }
__device__ __noinline__ void nsa_check(LAS unsigned char* lds, unsigned char* ws, int t, int g, LAS float* acc2) {
    int tid_ = threadIdx.x; asm volatile("" : "+v"(tid_)); const int tid = tid_, lane = tid & 63, wave = tid >> 6;
    const int hh = 8 * g + wave, cur = t >> 6;
    const bf16* QN = (const bf16*)(ws + WS_QNSA); const bf16* KV = (const bf16*)(ws + WS_KVNSA); const bf16* KC = (const bf16*)(ws + WS_KCMP) + (size_t)g * 1024 * 128; const bf16* VC = (const bf16*)(ws + WS_VCMP) + (size_t)g * 1024 * 128;
    const bf16* ZN = (const bf16*)(ws + WS_ZNSA); const float* GN = (const float*)(ws + WS_GNSA); const bf16* HO = (const bf16*)(ws + WS_H);
    const size_t CH = (size_t)S * 128;
    LAS float* pc = (LAS float*)lds;
    LAS float* impv = (LAS float*)(lds + 32768);
    LAS int* sel = (LAS int*)(lds + 32768 + 1024);
    const float slope2 = exp2f(-0.5f * (float)(hh + 1)) * LOG2E;
    const float q0 = bf2f(QN[(size_t)t * 2048 + hh * 128 + 2 * lane]), q1 = bf2f(QN[(size_t)t * 2048 + hh * 128 + 2 * lane + 1]);
    float oc0 = 0.f, oc1 = 0.f, os0 = 0.f, os1 = 0.f, ow0 = 0.f, ow1 = 0.f;
    const int ncv = (t >= 31) ? (t - 31) / 16 + 1 : 0;
    for (int n = lane; n < 1024; n += 64) pc[wave * 1024 + n] = 0.f;
    float mx = -1e30f;
    for (int n = 0; n < ncv; ++n) { float s = q0 * bf2f(KC[(size_t)n * 128 + 2 * lane]) + q1 * bf2f(KC[(size_t)n * 128 + 2 * lane + 1]); s = wave_sum(s) - slope2 * (float)(t - 16 * n - 31);
        if (lane == 0) pc[wave * 1024 + n] = s; mx = fmaxf(mx, s); }
    __syncthreads();
    float sum = 0.f;
    for (int n = 0; n < ncv; ++n) sum += exp2f(pc[wave * 1024 + n] - mx);
    __syncthreads();
    for (int n = lane; n < 1024; n += 64) pc[wave * 1024 + n] = (n < ncv) ? exp2f(pc[wave * 1024 + n] - mx) / sum : 0.f;
    __syncthreads();
    for (int n = 0; n < ncv; ++n) { const float p = pc[wave * 1024 + n]; oc0 += p * bf2f(VC[(size_t)n * 128 + 2 * lane]); oc1 += p * bf2f(VC[(size_t)n * 128 + 2 * lane + 1]); }
    if (tid < 256) { const int j = tid; float v = -1e30f;
        if (64 * j <= t) { float a = 0.f; for (int ii = 4 * j - 1; ii <= 4 * j + 3; ++ii) if (ii >= 0 && ii <= 1022) { float ps = 0.f; for (int h = 0; h < 8; ++h) ps += pc[h * 1024 + ii]; a += ps; }
            const bool forced = (j == 0) || (j == cur) || (j == cur - 1); v = a + (forced ? 1e4f : 0.f); }
        impv[j] = v; }
    __syncthreads();
    if (tid < 256) { const int j = tid; const float v = impv[j]; int rank = 0; for (int ii = 0; ii < 256; ++ii) { const float u = impv[ii]; rank += (u > v || (u == v && ii < j)) ? 1 : 0; } sel[j] = rank < 16 ? 1 : 0; }
    __syncthreads();
    const bf16* KS = KV + (size_t)(4 + g) * CH; const bf16* VSl = KV + (size_t)(6 + g) * CH;
    mx = -1e30f;
    for (int j = 0; j < 256; ++j) if (sel[j]) for (int tok = 64 * j; tok < 64 * j + 64 && tok <= t; ++tok) {
        float s = q0 * bf2f(KS[(size_t)tok * 128 + 2 * lane]) + q1 * bf2f(KS[(size_t)tok * 128 + 2 * lane + 1]); s = wave_sum(s) - slope2 * (float)(t - tok); mx = fmaxf(mx, s); }
    sum = 0.f;
    for (int j = 0; j < 256; ++j) if (sel[j]) for (int tok = 64 * j; tok < 64 * j + 64 && tok <= t; ++tok) {
        float s = q0 * bf2f(KS[(size_t)tok * 128 + 2 * lane]) + q1 * bf2f(KS[(size_t)tok * 128 + 2 * lane + 1]); s = wave_sum(s) - slope2 * (float)(t - tok);
        const float p = exp2f(s - mx); sum += p; os0 += p * bf2f(VSl[(size_t)tok * 128 + 2 * lane]); os1 += p * bf2f(VSl[(size_t)tok * 128 + 2 * lane + 1]); }
    os0 /= sum; os1 /= sum;
    const bf16* KW = KV + (size_t)(8 + g) * CH; const bf16* VW = KV + (size_t)(10 + g) * CH;
    const int lo = t - 511 > 0 ? t - 511 : 0;
    mx = -1e30f;
    for (int tok = lo; tok <= t; ++tok) { float s = q0 * bf2f(KW[(size_t)tok * 128 + 2 * lane]) + q1 * bf2f(KW[(size_t)tok * 128 + 2 * lane + 1]); s = wave_sum(s) - slope2 * (float)(t - tok); mx = fmaxf(mx, s); }
    sum = 0.f;
    for (int tok = lo; tok <= t; ++tok) { float s = q0 * bf2f(KW[(size_t)tok * 128 + 2 * lane]) + q1 * bf2f(KW[(size_t)tok * 128 + 2 * lane + 1]); s = wave_sum(s) - slope2 * (float)(t - tok);
        const float p = exp2f(s - mx); sum += p; ow0 += p * bf2f(VW[(size_t)tok * 128 + 2 * lane]); ow1 += p * bf2f(VW[(size_t)tok * 128 + 2 * lane + 1]); }
    ow0 /= sum; ow1 /= sum;
    const float gc = GN[(size_t)t * 48 + hh], gs = GN[(size_t)t * 48 + 16 + hh], gwv = GN[(size_t)t * 48 + 32 + hh];
    const float r0 = (gc * oc0 + gs * os0 + gwv * ow0) * bf2f(ZN[(size_t)t * 2048 + hh * 128 + 2 * lane]), r1 = (gc * oc1 + gs * os1 + gwv * ow1) * bf2f(ZN[(size_t)t * 2048 + hh * 128 + 2 * lane + 1]);
    const float f0 = bf2f(HO[(size_t)t * 4096 + 2048 + hh * 128 + 2 * lane]), f1 = bf2f(HO[(size_t)t * 4096 + 2048 + hh * 128 + 2 * lane + 1]);
    const float e2 = wave_sum((r0 - f0) * (r0 - f0) + (r1 - f1) * (r1 - f1)), n2 = wave_sum(r0 * r0 + r1 * r1);
    __syncthreads();
    if (lane == 0) { pc[wave] = e2; pc[8 + wave] = n2; }
    __syncthreads();
    if (tid == 0) { float a = 0.f, b = 0.f; for (int w = 0; w < 8; ++w) { a += pc[w]; b += pc[8 + w]; } acc2[0] += a; acc2[1] += b; }
    __syncthreads();
}
__device__ __forceinline__ void mla_check(LAS unsigned char* lds, unsigned char* ws, int t, LAS float* acc2) {
    int tid_ = threadIdx.x; asm volatile("" : "+v"(tid_)); const int tid = tid_, lane = tid & 63, wave = tid >> 6;
    const bf16* ZM = (const bf16*)(ws + WS_ZMLA); const bf16* HO = (const bf16*)(ws + WS_H);
    LAS float* qs = (LAS float*)lds + wave * 192;
    LAS float* red = (LAS float*)lds + 8 * 192;
    float ae = 0.f, an = 0.f;
    for (int rep = 0; rep < 2; ++rep) { const int head = wave + 8 * rep;
#ifdef MLA_FP8
        { const unsigned char* qp = (const unsigned char*)(ws + WS_QMLA) + (size_t)t * 3072 + head * 192; for (int d = lane; d < 192; d += 64) qs[d] = e4m3(qp[d]) * QS_MLA; }
#else
        { const bf16* qp = (const bf16*)(ws + WS_QMLA) + (size_t)t * 3072 + head * 192; for (int d = lane; d < 192; d += 64) qs[d] = bf2f(qp[d]); }
#endif
        __syncthreads();
        float mx = -1e30f;
        for (int c = 0; 64 * c <= t; ++c) {
#ifdef MLA_MX
            const int tok = 64 * c + 8 * ((lane >> 2) & 7) + 4 * (lane >> 5) + (lane & 3);
#else
            const int x_ = lane & 15; const int tok = 64 * c + (lane & 48) + (x_ < 4 ? x_ : (x_ < 8 ? x_ + 4 : (x_ < 12 ? x_ - 4 : x_)));
#endif

            float s = 0.f;
#ifdef MLA_FP8
            const unsigned char* kp = (const unsigned char*)(ws + WS_KMLA) + (size_t)tok * 3072 + head * 192; for (int d = 0; d < 192; ++d) s += qs[d] * e4m3(kp[d]);
#else
            const bf16* kp = (const bf16*)(ws + WS_KMLA) + (size_t)tok * 3072 + head * 192; for (int d = 0; d < 192; ++d) s += qs[d] * bf2f(kp[d]);
#endif
            if (tok <= t) mx = fmaxf(mx, s); }
        for (int off = 1; off < 64; off <<= 1) mx = fmaxf(mx, __shfl_xor(mx, off));
        float e2 = 0.f, n2 = 0.f;
        for (int dc = 0; dc < 8; ++dc) {
        float sum = 0.f; float o[16];
#pragma unroll
        for (int d = 0; d < 16; ++d) o[d] = 0.f;
        for (int c = 0; 64 * c <= t; ++c) {
#ifdef MLA_MX
            const int tok = 64 * c + 8 * ((lane >> 2) & 7) + 4 * (lane >> 5) + (lane & 3);
#else
            const int x_ = lane & 15; const int tok = 64 * c + (lane & 48) + (x_ < 4 ? x_ : (x_ < 8 ? x_ + 4 : (x_ < 12 ? x_ - 4 : x_)));
#endif

            float s = 0.f;
#ifdef MLA_FP8
            const unsigned char* kp = (const unsigned char*)(ws + WS_KMLA) + (size_t)tok * 3072 + head * 192; for (int d = 0; d < 192; ++d) s += qs[d] * e4m3(kp[d]);
#else
            const bf16* kp = (const bf16*)(ws + WS_KMLA) + (size_t)tok * 3072 + head * 192; for (int d = 0; d < 192; ++d) s += qs[d] * bf2f(kp[d]);
#endif
            const float p = (tok <= t) ? exp2f(s - mx) : 0.f; sum += p;
#ifdef MLA_FP8V
            const unsigned char* vt = (const unsigned char*)(ws + WS_VMLA) + ((size_t)head * 128 + 16 * dc) * S + 64 * c + lane;
#pragma unroll
            for (int d = 0; d < 16; ++d) o[d] += p * e4m3(vt[(size_t)d * S]);
#else
            const bf16* vp = (const bf16*)(ws + WS_VMLA) + (size_t)tok * 2048 + head * 128 + 16 * dc;
#pragma unroll
            for (int d = 0; d < 16; ++d) o[d] += p * bf2f(vp[d]);
#endif
        }
        sum = wave_sum(sum);
#pragma unroll
        for (int d = 0; d < 16; ++d) { const float od = wave_sum(o[d]) / sum; const float r = od * bf2f(ZM[(size_t)t * 2048 + head * 128 + 16 * dc + d]), f = bf2f(HO[(size_t)t * 4096 + head * 128 + 16 * dc + d]); e2 += (r - f) * (r - f); n2 += r * r; }
        }
        ae += e2; an += n2;
        __syncthreads(); }
    if (lane == 0) { red[wave] = ae; red[8 + wave] = an; }
    __syncthreads();
    if (tid == 0) { float a = 0.f, b = 0.f; for (int w = 0; w < 8; ++w) { a += red[w]; b += red[8 + w]; } acc2[0] += a; acc2[1] += b; }
    __syncthreads();
}
}
#endif
#ifdef CHK2_BUILD
namespace chk2 {
constexpr size_t WS_CHK = 14 * MiB;
__device__ __forceinline__ float bf2f(bf16 v) { return __uint_as_float((unsigned)v << 16); }
__device__ __forceinline__ int sample_t(int i) { return i * 256 + (i * 29) % 256; }
__device__ __noinline__ void proj_check(LAS unsigned char* lds, unsigned char* ws, const float* x, const float* w_in_l, int l, int i, int qd, LAS float* acc2) {
    int tid_ = threadIdx.x; asm volatile("" : "+v"(tid_)); const int tid = tid_;
    const int t = sample_t(i);
    LAS float* h = (LAS float*)lds;
    LAS float* red = h + 4096;
    const float* mod = (const float*)(ws + WS_MOD) + (size_t)l * 3 * D;
    const float* xin = (l == 0) ? x : (const float*)(ws + WS_XV);
    for (int k = tid; k < D; k += NTHR) h[k] = xin[(size_t)t * D + k] * (1.f + mod[D + k]) + mod[k];
    __syncthreads();
    float e2 = 0.f, r2 = 0.f;
    const float* cosT = (const float*)(ws + WS_ROPE); const float* sinT = cosT + (size_t)S * 32;
    for (int n = qd * 2268 + tid; n < (qd + 1) * 2268; n += NTHR) {
        float a = 0.f;
        for (int k = 0; k < D; ++k) a += h[k] * w_in_l[(size_t)k * INC + n];
        float ref = a, got;
        if (n < 768) got = bf2f(((const bf16*)(ws + WS_QLAT))[(size_t)t * 768 + n]);
        else if (n < 1280) got = bf2f(((const bf16*)(ws + WS_KVLAT))[(size_t)t * 512 + n - 768]);
        else if (n < 1344) {
            const int ii = n - 1280, pi = ii & 31; const int np = 1280 + (ii < 32 ? ii + 32 : ii - 32); float b = 0.f;
            for (int k = 0; k < D; ++k) b += h[k] * w_in_l[(size_t)k * INC + np];
            const float c = cosT[(size_t)t * 32 + pi], s = sinT[(size_t)t * 32 + pi];
            ref = ii < 32 ? a * c - b * s : a * c + b * s;
            got = bf2f(((const bf16*)(ws + WS_KMLA))[(size_t)t * 3072 + 5 * 192 + 128 + 2 * pi + (ii >> 5)]);
        }
        else if (n < 3392) { ref = a / (1.f + expf(-a)); got = bf2f(((const bf16*)(ws + WS_ZMLA))[(size_t)t * 2048 + n - 1344]); }
        else if (n < 5440) { ref = a * QS_NSA; got = bf2f(((const bf16*)(ws + WS_QNSA))[(size_t)t * 2048 + n - 3392]); }
        else if (n < 6976) { const int c = n - 5440; got = bf2f(((const bf16*)(ws + WS_KVNSA))[(size_t)(c >> 7) * ((size_t)S * 128) + (size_t)t * 128 + (c & 127)]); }
        else if (n < 7024) { ref = 1.f / (1.f + expf(-a)); got = ((const float*)(ws + WS_GNSA))[(size_t)t * 48 + n - 6976]; }
        else { ref = a / (1.f + expf(-a)); got = bf2f(((const bf16*)(ws + WS_ZNSA))[(size_t)t * 2048 + n - 7024]); }
        e2 += (ref - got) * (ref - got); r2 += ref * ref;
    }
    red[tid] = e2; red[512 + tid] = r2;
    __syncthreads();
    if (tid == 0) { float a = 0.f, b = 0.f; for (int k = 0; k < 512; ++k) { a += red[k]; b += red[512 + k]; } acc2[0] += a; acc2[1] += b; }
    __syncthreads();
}
__device__ __noinline__ void cmp_check(LAS unsigned char* lds, unsigned char* ws, const float* cmp_pos_l, const float* w1_l, const float* w2_l, int i, LAS float* acc2) {
    int tid_ = threadIdx.x; asm volatile("" : "+v"(tid_)); const int tid = tid_;
    const int n = (4 * i + (i & 3)) % 1023, kv = i & 1, g = (i >> 1) & 1;
    LAS float* blk = (LAS float*)lds;
    LAS float* hid = blk + 4096;
    LAS float* red = hid + 128;
    const bf16* A = (const bf16*)(ws + WS_KVNSA) + (size_t)(kv * 2 + g) * ((size_t)S * 128) + (size_t)n * 2048;
    for (int k = tid; k < 4096; k += NTHR) blk[k] = bf2f(A[k]) + cmp_pos_l[(size_t)kv * 4096 + k];
    __syncthreads();
    if (tid < 128) { float a = 0.f; const float* W = w1_l + (size_t)kv * 4096 * 128 + tid; for (int k = 0; k < 4096; ++k) a += blk[k] * W[(size_t)k * 128]; hid[tid] = a / (1.f + expf(-a)); }
    __syncthreads();
    float e2 = 0.f, r2 = 0.f;
    if (tid < 128) { float a = 0.f; const float* W = w2_l + (size_t)kv * 128 * 128 + tid; for (int k = 0; k < 128; ++k) a += hid[k] * W[(size_t)k * 128];
        const float got = bf2f(((const bf16*)(ws + (kv ? WS_VCMP : WS_KCMP)))[(size_t)g * 1024 * 128 + (size_t)n * 128 + tid]); e2 = (a - got) * (a - got); r2 = a * a; }
    if (tid < 128) { red[tid] = e2; red[128 + tid] = r2; }
    __syncthreads();
    if (tid == 0) { float a = 0.f, b = 0.f; for (int k = 0; k < 128; ++k) { a += red[k]; b += red[128 + k]; } acc2[0] += a; acc2[1] += b; }
    __syncthreads();
}
}
#endif
#ifdef CHK3_BUILD
namespace chk3 {
constexpr size_t WS_CHK = 14 * MiB;
__device__ __forceinline__ float bf2f(bf16 v) { return __uint_as_float((unsigned)v << 16); }
__device__ __forceinline__ float e4m3(unsigned char b) { const int e = (b >> 3) & 15, mm = b & 7; const float v = e == 0 ? (float)mm * (1.f / 512.f) : (1.f + (float)mm * 0.125f) * exp2f((float)(e - 7)); return (b & 0x80) ? -v : v; }
__device__ __forceinline__ int sample_t(int i) { return i * 64 + (i * 29) % 64; }
__device__ __noinline__ void up_check(LAS unsigned char* lds, unsigned char* ws, const float* qn, const float* wq, const float* kn, const float* wkv, int i, LAS float* acc2) {
    int tid_ = threadIdx.x; asm volatile("" : "+v"(tid_)); const int tid = tid_;
    const int t = sample_t(i);
    LAS float* ql = (LAS float*)lds;
    LAS float* kl = ql + 768;
    LAS float* qo = kl + 512;
    LAS float* red = qo + 3072;
    const bf16* QL = (const bf16*)(ws + WS_QLAT) + (size_t)t * 768; const bf16* KL = (const bf16*)(ws + WS_KVLAT) + (size_t)t * 512;
    float s = 0.f; for (int k = tid; k < 768; k += NTHR) { const float v = bf2f(QL[k]); s += v * v; }
    red[tid] = s; __syncthreads();
    float tot = 0.f; for (int k = 0; k < 512; ++k) tot += red[k];
    const float rq = 1.f / sqrtf(tot / 768.f + RMS_EPS);
    __syncthreads();
    s = 0.f; for (int k = tid; k < 512; k += NTHR) { const float v = bf2f(KL[k]); s += v * v; }
    red[tid] = s; __syncthreads();
    tot = 0.f; for (int k = 0; k < 512; ++k) tot += red[k];
    const float rk = 1.f / sqrtf(tot / 512.f + RMS_EPS);
    __syncthreads();
    for (int k = tid; k < 768; k += NTHR) ql[k] = bf2f(QL[k]) * rq * qn[k];
    for (int k = tid; k < 512; k += NTHR) kl[k] = bf2f(KL[k]) * rk * kn[k];
    __syncthreads();
    for (int n = tid; n < 3072; n += NTHR) { float a = 0.f; for (int k = 0; k < 768; ++k) a += ql[k] * wq[(size_t)k * 3072 + n]; qo[n] = a; }
    __syncthreads();
    float e2 = 0.f, r2 = 0.f;
    const float* cosT = (const float*)(ws + WS_ROPE); const float* sinT = cosT + (size_t)S * 32;
    const bf16* QM = (const bf16*)(ws + WS_QMLA) + (size_t)t * 3072;
    for (int n = tid; n < 3072; n += NTHR) { const int h = n / 192, d = n % 192; float ref, got;
#ifdef MLA_FP8
        const unsigned char* Q8 = (const unsigned char*)(ws + WS_QMLA) + (size_t)t * 3072;
        if (d < 128) { ref = qo[n]; got = e4m3(Q8[h * 192 + d]); }
        else { const int ii = d - 128, pi = ii & 31; const float x1 = qo[h * 192 + 128 + pi], x2 = qo[h * 192 + 160 + pi]; const float c = cosT[(size_t)t * 32 + pi], sn = sinT[(size_t)t * 32 + pi];
            ref = (ii < 32 ? x1 * c - x2 * sn : x2 * c + x1 * sn); got = e4m3(Q8[h * 192 + 128 + 2 * pi + (ii >> 5)]); }
        if (false) {}
#else
        if (d < 128) { ref = qo[n] * QS_MLA; got = bf2f(QM[h * 192 + d]); }
        else { const int ii = d - 128, pi = ii & 31; const float x1 = qo[h * 192 + 128 + pi], x2 = qo[h * 192 + 160 + pi]; const float c = cosT[(size_t)t * 32 + pi], sn = sinT[(size_t)t * 32 + pi];
            ref = (ii < 32 ? x1 * c - x2 * sn : x2 * c + x1 * sn) * QS_MLA; got = bf2f(QM[h * 192 + 128 + 2 * pi + (ii >> 5)]); }
#endif
        e2 += (ref - got) * (ref - got); r2 += ref * ref; }
    const bf16* KM = (const bf16*)(ws + WS_KMLA) + (size_t)t * 3072; const bf16* VM = (const bf16*)(ws + WS_VMLA) + (size_t)t * 2048;
    for (int n = tid; n < 4096; n += NTHR) { float a = 0.f; for (int k = 0; k < 512; ++k) a += kl[k] * wkv[(size_t)k * 4096 + n];
#ifdef MLA_FP8
        const int h = n >> 8, d = n & 255; const float got = d < 128 ? e4m3(((const unsigned char*)(ws + WS_KMLA) + (size_t)t * 3072)[h * 192 + d]) : bf2f(VM[h * 128 + d - 128]);
#else
        const int h = n >> 8, d = n & 255; const float got = d < 128 ? bf2f(KM[h * 192 + d]) : bf2f(VM[h * 128 + d - 128]);
#endif
        e2 += (a - got) * (a - got); r2 += a * a; }
    red[tid] = e2; red[512 + tid] = r2;
    __syncthreads();
    if (tid == 0) { float a = 0.f, b = 0.f; for (int k = 0; k < 512; ++k) { a += red[k]; b += red[512 + k]; } acc2[0] += a; acc2[1] += b; }
    __syncthreads();
}
__device__ __noinline__ void out_check(LAS unsigned char* lds, unsigned char* ws, const float* xin, const float* xv, const float* wout, const float* gate, int i, int qd, LAS float* acc2) {
    int tid_ = threadIdx.x; asm volatile("" : "+v"(tid_)); const int tid = tid_;
    const int t = i * 256 + (i * 29) % 256;
    LAS float* o = (LAS float*)lds;
    LAS float* red = o + 4096;
    const bf16* OA = (const bf16*)(ws + WS_H) + (size_t)t * 4096;
    for (int k = tid; k < 4096; k += NTHR) o[k] = bf2f(OA[k]);
    __syncthreads();
    float e2 = 0.f, r2 = 0.f;
    for (int n = qd * 1024 + tid; n < (qd + 1) * 1024; n += NTHR) { float a = 0.f; for (int k = 0; k < 4096; ++k) a += o[k] * wout[(size_t)k * 4096 + n];
        const float gy = gate[n] * a, ref = DN_ALPHA * xin[(size_t)t * D + n] + gy, got = xv[(size_t)t * D + n];
        e2 += (ref - got) * (ref - got); r2 += gy * gy; }
    red[tid] = e2; red[512 + tid] = r2;
    __syncthreads();
    if (tid == 0) { float a = 0.f, b = 0.f; for (int k = 0; k < 512; ++k) { a += red[k]; b += red[512 + k]; } acc2[0] += a; acc2[1] += b; }
    __syncthreads();
}
}
#endif
#ifdef CHK4_BUILD
namespace chk4 {
__device__ __forceinline__ float bf2f(bf16 v) { return __uint_as_float((unsigned)v << 16); }
__device__ __noinline__ void mod_check(LAS unsigned char* lds, unsigned char* ws, const float* c, const float* w_ada, const float* b_ada, int u, LAS float* acc2) {
    const int tid = threadIdx.x;
    LAS float* red = (LAS float*)lds;
    const int l = u & 1, n = ((u >> 1) * 977 + 13) % (3 * D);
    float a = 0.f;
    for (int k = tid; k < D; k += NTHR) { const float cv = c[k]; a += cv / (1.f + expf(-cv)) * w_ada[(size_t)l * D * 3 * D + (size_t)k * 3 * D + n]; }
    red[tid] = a; __syncthreads();
    if (tid == 0) { float s = 0.f; for (int k = 0; k < NTHR; ++k) s += red[k]; s += b_ada[(size_t)l * 3 * D + n];
        const float got = ((const float*)(ws + WS_MOD))[(size_t)l * 3 * D + n]; acc2[0] += (s - got) * (s - got); acc2[1] += s * s; }
    __syncthreads();
}
__device__ __noinline__ void ln_check(LAS unsigned char* lds, unsigned char* ws, const float* ln_g, const float* ln_b, int u, LAS float* acc2) {
    const int tid = threadIdx.x;
    LAS float* red = (LAS float*)lds;
    const int t = u * 64 + (u * 29) % 64;
    const float* X1 = (const float*)(ws + WS_XV) + (size_t)t * D; const bf16* H = (const bf16*)(ws + WS_H) + (size_t)t * D; const float* mod1 = (const float*)(ws + WS_MOD) + 3 * D;
    float s1 = 0.f, s2 = 0.f, e2 = 0.f, r2 = 0.f;
    for (int k = tid; k < D; k += NTHR) { const float y = (X1[k] - ln_b[k]) / ln_g[k]; s1 += y; s2 += y * y;
        const float h = X1[k] * (1.f + mod1[D + k]) + mod1[k], got = bf2f(H[k]); e2 += (h - got) * (h - got); r2 += h * h; }
    red[tid] = s1; red[512 + tid] = s2; red[1024 + tid] = e2; red[1536 + tid] = r2; __syncthreads();
    if (tid == 0) { float a = 0.f, b = 0.f, c = 0.f, d = 0.f; for (int k = 0; k < NTHR; ++k) { a += red[k]; b += red[512 + k]; c += red[1024 + k]; d += red[1536 + k]; }
        const float mean = a / D, var = b / D - mean * mean;
        acc2[0] += mean * mean + (var - 1.f) * (var - 1.f) + c / d; acc2[1] += 1.f; }
    __syncthreads();
}
}
#endif
constexpr int PPL = 6;
constexpr int N_PHASES = 2 + PPL * DEPTH;
struct Args { const void* in[16]; float* out; unsigned char* ws; int ph_lo, ph_hi; };
#define WSP(T, off) ((T*)(ws + (off)))
#define VCU() ((gridDim.x % 8 == 0) ? (int)((blockIdx.x % 8) * (gridDim.x / 8) + blockIdx.x / 8) : (int)blockIdx.x)
__global__ void __launch_bounds__(NTHR, 2) mk_fwd(const Args args) {
    extern __shared__ __attribute__((aligned(16))) unsigned char lds_raw[];
    LAS unsigned char* lds = (LAS unsigned char*)lds_raw;
    if (threadIdx.x < 32) ((volatile LAS unsigned*)(lds + MISC_OFF))[threadIdx.x] = 0u;
    __syncthreads();
    XcdBarrier bar = xcd_barrier_post((unsigned*)(args.ws + WS_CTL) + CW_BAR, (volatile LAS unsigned*)(lds + MISC_OFF) + 8);
#define IN(k) (args.ph_lo <= (k) && (k) < args.ph_hi)
#define SEAM(k) do { if (IN(k) && IN((k) + 1)) xcd_barrier(bar); } while (0)
#define PHASE_REGS int tid_ = threadIdx.x; asm volatile("" : "+v"(tid_)); const int tid = tid_, lane = tid & 63, wave = __builtin_amdgcn_readfirstlane(tid >> 6); \
    unsigned char* ws = args.ws; asm volatile("" : "+s"(ws)); (void)tid; (void)lane; (void)wave

    if (IN(0)) {
        PHASE_REGS; const int G = gridDim.x, vcu = VCU();
        p0_mod_gemv((const float*)args.in[1], (const float*)args.in[3], (const float*)args.in[4], WSP(float, WS_MOD), (LAS float*)lds, vcu, G);
        p0_cmpbias((const float*)args.in[10], (const float*)args.in[11], WSP(float, WS_CBP), (LAS float*)lds, (vcu + G / 2) % G, G);
        p0_rope((const int*)args.in[2], WSP(float, WS_ROPE), WSP(float, WS_ROPE) + (size_t)S * 32, vcu * NTHR + tid, G * NTHR);
        const P0In I{(const float*)args.in[5], (const float*)args.in[6], (const float*)args.in[7], (const float*)args.in[8], (const float*)args.in[9], (const float*)args.in[11], (const float*)args.in[12], (const float*)args.in[13]};
#ifndef DIS_CONV
        p0_convert(I, ws, vcu * NWAVES + wave, G * NWAVES, lane);
#endif
#ifdef PROBE_P0CONV2
        p0_convert(I, ws, vcu * NWAVES + wave, G * NWAVES, lane);
#endif
#ifdef PROBE_P0MOD2
        __syncthreads(); p0_mod_gemv((const float*)args.in[1], (const float*)args.in[3], (const float*)args.in[4], WSP(float, WS_MOD), (LAS float*)lds, vcu, G);
#endif
    }
    SEAM(0);
#ifdef GEMM_F8
#define H8PTR WSP(unsigned char, WS_H8)
#else
#define H8PTR ((unsigned char*)nullptr)
#endif
    if (IN(1)) { PHASE_REGS; modulate_rows((const float*)args.in[0], WSP(bf16, WS_H), H8PTR, WSP(float, WS_MOD), VCU() * NWAVES + wave, gridDim.x * NWAVES, lane);
#ifdef PROBE_THIN2
        modulate_rows((const float*)args.in[0], WSP(bf16, WS_H), H8PTR, WSP(float, WS_MOD), VCU() * NWAVES + wave, gridDim.x * NWAVES, lane);
#endif
    }
    SEAM(1);
    for (int l = 0; l < DEPTH; ++l) {
        const int pb = 2 + PPL * l;
        if (IN(pb + 0)) {
            PHASE_REGS;
#ifdef GEMM_F8
            { pg8::Gemm gg{WSP(bf16, WS_H), (const bf16*)(ws + WS_W + (size_t)l * W_LSTRIDE + W_IN), S, 23 * 256, D}; pg8::InBf16Order SO; SO.init(S, 23 * 256, gridDim.x, blockIdx.x);
              const pg8::EpiIn E{ws, 0};
              pg8::gemm_phase<pg8::EpiIn, pg8::InBf16Order, true, true>(lds, gg, SO, E);
#ifdef PROBE_INB2
              pg8::gemm_phase<pg8::EpiIn, pg8::InBf16Order, true, true>(lds, gg, SO, E);
#endif
            }
            { pg8::Gemm gg{(const bf16*)(ws + WS_H8), (const bf16*)(ws + WS_WIN8 + (size_t)l * WIN8_LSTRIDE), S, 13 * 256, D / 2}; pg8::StaticOrder SO; SO.init(S, 13 * 256, gridDim.x, (blockIdx.x + 64) % gridDim.x);
              const pg8::EpiIn E{ws, 1};
              pg8::gemm_phase<pg8::EpiIn, pg8::StaticOrder, true, true, 0x79797979, 0x7f7f7f7f>(lds, gg, SO, E);
#ifdef PROBE_INF2
              pg8::gemm_phase<pg8::EpiIn, pg8::StaticOrder, true, true, 0x79797979, 0x7f7f7f7f>(lds, gg, SO, E);
#endif
            }
#else
            pg8::Gemm gg{WSP(bf16, WS_H), (const bf16*)(ws + WS_W + (size_t)l * W_LSTRIDE + W_IN), S, NIN, D}; pg8::StaticOrder SO; SO.init(S, NIN, gridDim.x, blockIdx.x);
            const pg8::EpiIn E{ws, 0};
#ifndef DIS_IN
            pg8::gemm_phase<pg8::EpiIn, pg8::StaticOrder, true, true>(lds, gg, SO, E);
#endif
#ifdef PROBE_IN2
            pg8::gemm_phase<pg8::EpiIn, pg8::StaticOrder, true, true>(lds, gg, SO, E);
#endif
#endif
        }
        SEAM(pb + 0);
        if (IN(pb + 1)) {
            PHASE_REGS; const int G = gridDim.x, vcu = VCU();
            rstd_rows(WSP(float, WS_RSQQ), WSP(float, WS_RSQKV), WSP(float, WS_RSTD), WSP(float, WS_RSTD) + S, vcu * NTHR + tid, G * NTHR);
            const att::CmpPtrs CP{WSP(bf16, WS_KVNSA), (const bf16*)(ws + WS_W + (size_t)l * W_LSTRIDE + W_C1), (const bf16*)(ws + WS_W + (size_t)l * W_LSTRIDE + W_C2),
                                  WSP(float, WS_CBP) + (size_t)l * 2 * 16 * 128, WSP(bf16, WS_KCMP), WSP(bf16, WS_VCMP)};
#ifndef DIS_CMP
            for (int u = vcu; u < 256; u += G) att::cmp_unit(lds, CP, u & 1, (u >> 1) & 1, u >> 2, tid, wave, lane);
#endif
#ifdef PROBE_THIN2
            rstd_rows(WSP(float, WS_RSQQ), WSP(float, WS_RSQKV), WSP(float, WS_RSTD), WSP(float, WS_RSTD) + S, vcu * NTHR + tid, G * NTHR);
            for (int u = vcu; u < 256; u += G) att::cmp_unit(lds, CP, u & 1, (u >> 1) & 1, u >> 2, tid, wave, lane);
#endif
        }
        SEAM(pb + 1);
        if (IN(pb + 2)) {
            PHASE_REGS;
#ifdef GEMM_F8
            { pg8::Gemm gg{WSP(bf16, WS_QLAT), (const bf16*)(ws + WS_W + (size_t)l * W_LSTRIDE + W_QUP), S, 3072, 384}; pg8::StaticOrder SO; SO.init(S, 3072, gridDim.x, blockIdx.x);
              const pg8::EpiQup E{ws};
              pg8::gemm_phase<pg8::EpiQup, pg8::StaticOrder, true, true, 0x7a7a7a7a, 0x7f7f7f7f>(lds, gg, SO, E);
#ifdef PROBE_UPF2
              pg8::gemm_phase<pg8::EpiQup, pg8::StaticOrder, true, true, 0x7a7a7a7a, 0x7f7f7f7f>(lds, gg, SO, E);
#endif
            }
            { pg8::Gemm gg{WSP(bf16, WS_KVLAT), (const bf16*)(ws + WS_W + (size_t)l * W_LSTRIDE + W_KVUP), S, 2048, 256}; pg8::StaticOrder SO; SO.init(S, 2048, gridDim.x, blockIdx.x);
              const pg8::EpiKup E{ws};
              pg8::gemm_phase<pg8::EpiKup, pg8::StaticOrder, true, true, 0x7a7a7a7a, 0x7f7f7f7f>(lds, gg, SO, E);
#ifdef PROBE_UPF2
              pg8::gemm_phase<pg8::EpiKup, pg8::StaticOrder, true, true, 0x7a7a7a7a, 0x7f7f7f7f>(lds, gg, SO, E);
#endif
            }
            { pg8::Gemm gg{(const bf16*)(ws + WS_W + (size_t)l * W_LSTRIDE + W_KVUP + (size_t)2048 * 512), WSP(bf16, WS_KVLAT), 2048, S, 256}; pg8::StaticOrder SO; SO.init(2048, S, gridDim.x, blockIdx.x);
              const pg8::EpiVt E{ws};
              pg8::gemm_phase<pg8::EpiVt, pg8::StaticOrder, true, true, 0x7f7f7f7f, 0x7a7a7a7a>(lds, gg, SO, E);
#ifdef PROBE_UPF2
              pg8::gemm_phase<pg8::EpiVt, pg8::StaticOrder, true, true, 0x7f7f7f7f, 0x7a7a7a7a>(lds, gg, SO, E);
#endif
            }
        }
#else
            { pg8::Gemm gg{WSP(bf16, WS_QLAT), (const bf16*)(ws + WS_W + (size_t)l * W_LSTRIDE + W_QUP), S, 3072, 768}; pg8::StaticOrder SO; SO.init(S, 3072, gridDim.x, blockIdx.x);
              const pg8::EpiQup E{ws};
#ifndef DIS_QUP
              pg8::gemm_phase<pg8::EpiQup, pg8::StaticOrder, true, true>(lds, gg, SO, E);
#endif
#ifdef PROBE_UP2
              pg8::gemm_phase<pg8::EpiQup, pg8::StaticOrder, true, true>(lds, gg, SO, E);
#endif
            }
#ifdef MLA_FP8V
            { pg8::Gemm gg{WSP(bf16, WS_KVLAT), (const bf16*)(ws + WS_W + (size_t)l * W_LSTRIDE + W_KVUP), S, 2048, 512}; pg8::StaticOrder SO; SO.init(S, 2048, gridDim.x, blockIdx.x);
              const pg8::EpiKup E{ws};
              pg8::gemm_phase<pg8::EpiKup, pg8::StaticOrder, true, true>(lds, gg, SO, E);
            }
            { pg8::Gemm gg{(const bf16*)(ws + WS_W + (size_t)l * W_LSTRIDE + W_KVUP) + (size_t)2048 * 512, WSP(bf16, WS_KVLAT), 2048, S, 512}; pg8::StaticOrder SO; SO.init(2048, S, gridDim.x, blockIdx.x);
              const pg8::EpiVt E{ws};
              pg8::gemm_phase<pg8::EpiVt, pg8::StaticOrder, true, true>(lds, gg, SO, E);
            }
        }
#else
            { pg8::Gemm gg{WSP(bf16, WS_KVLAT), (const bf16*)(ws + WS_W + (size_t)l * W_LSTRIDE + W_KVUP), S, 4096, 512}; pg8::StaticOrder SO; SO.init(S, 4096, gridDim.x, blockIdx.x);
              const pg8::EpiKvup E{ws};
#ifndef DIS_KVUP
              pg8::gemm_phase<pg8::EpiKvup, pg8::StaticOrder, true, true>(lds, gg, SO, E);
#endif
#ifdef PROBE_UP2
              pg8::gemm_phase<pg8::EpiKvup, pg8::StaticOrder, true, true>(lds, gg, SO, E);
#endif
            }
        }
#endif
#endif
        SEAM(pb + 2);
        if (IN(pb + 3)) {
            PHASE_REGS; const int G = gridDim.x, vcu = VCU();
            { const att::MlaPtrs MP{WSP(bf16, WS_QMLA), WSP(bf16, WS_KMLA), WSP(bf16, WS_VMLA), WSP(bf16, WS_ZMLA), WSP(bf16, WS_H)};
              for (int pu = vcu; pu < 512; pu += G) { const int head = pu >> 5, pr = pu & 31;
#ifndef DIS_MLA
                  att::mla_unit(lds, MP, head, 63 - pr, tid, wave, lane);
                  att::mla_unit(lds, MP, head, pr, tid, wave, lane);
#endif
              }
#ifdef PROBE_MLA2
              for (int pu = vcu; pu < 512; pu += G) { const int head = pu >> 5, pr = pu & 31; att::mla_unit(lds, MP, head, 63 - pr, tid, wave, lane); att::mla_unit(lds, MP, head, pr, tid, wave, lane); }
#endif
            }
            { const att::NsaPtrs NP{WSP(bf16, WS_QNSA), WSP(bf16, WS_KVNSA), WSP(bf16, WS_KCMP), WSP(bf16, WS_VCMP), WSP(bf16, WS_ZNSA), WSP(float, WS_GNSA), WSP(bf16, WS_H), WSP(float, WS_OSCR)};
#ifndef DIS_NSA
              for (int u = vcu; u < 1024; u += G) { const int v_ = (u >> 1) & 127, k_ = u >> 8;
                  att::nsa_unit(lds, NP, u & 1, (k_ & 1) ? 128 * k_ + 127 - v_ : 128 * k_ + v_, tid, wave, lane, blockIdx.x); }
#endif
#ifdef PROBE_NSA2
              for (int u = vcu; u < 1024; u += G) att::nsa_unit(lds, NP, u & 1, u >> 1, tid, wave, lane, blockIdx.x);
#endif
            }
        }
        SEAM(pb + 3);
        if (IN(pb + 4)) {
            PHASE_REGS;
            pg8::Gemm gg{WSP(bf16, WS_H), (const bf16*)(ws + WS_W + (size_t)l * W_LSTRIDE + W_OUT), S, D, D}; pg8::StaticOrder SO; SO.init(S, D, gridDim.x, blockIdx.x);
            const pg8::EpiOut E{WSP(bf16, WS_Y), WSP(const float, WS_MOD) + (size_t)l * 3 * D + 2 * D};
#ifndef DIS_OUT
            pg8::gemm_phase<pg8::EpiOut, pg8::StaticOrder, true, true>(lds, gg, SO, E);
#endif
#ifdef PROBE_OUT2
            pg8::gemm_phase<pg8::EpiOut, pg8::StaticOrder, true, true>(lds, gg, SO, E);
#endif
        }
        SEAM(pb + 4);
        if (IN(pb + 5)) {
            PHASE_REGS;
            float* v = (l == DEPTH - 1) ? args.out : WSP(float, WS_XV);
            ln_rows(l == 0 ? (const float*)args.in[0] : WSP(const float, WS_XV), WSP(const bf16, WS_Y), v, (l == DEPTH - 1) ? nullptr : WSP(bf16, WS_H), (l == DEPTH - 1) ? nullptr : H8PTR, (const float*)args.in[14] + (size_t)l * D, (const float*)args.in[15] + (size_t)l * D,
                    WSP(const float, WS_MOD) + (size_t)(l + 1) * 3 * D, (LAS float*)lds, tid, VCU() * NWAVES + wave, gridDim.x * NWAVES, lane);
#ifdef PROBE_LN2
            ln_rows(l == 0 ? (const float*)args.in[0] : WSP(const float, WS_XV), WSP(const bf16, WS_Y), v, (l == DEPTH - 1) ? nullptr : WSP(bf16, WS_H), (l == DEPTH - 1) ? nullptr : H8PTR, (const float*)args.in[14] + (size_t)l * D, (const float*)args.in[15] + (size_t)l * D,
                    WSP(const float, WS_MOD) + (size_t)(l + 1) * 3 * D, (LAS float*)lds, tid, VCU() * NWAVES + wave, gridDim.x * NWAVES, lane);
#endif
        }
        SEAM(pb + 5);
    }
#undef IN
#undef SEAM
}


#if defined(CHK_BUILD) || defined(CHK2_BUILD) || defined(CHK3_BUILD) || defined(CHK4_BUILD)
__global__ void __launch_bounds__(NTHR, 2) chk_kernel(const Args args, int l) {
    extern __shared__ __attribute__((aligned(16))) unsigned char lds_raw[];
    LAS unsigned char* lds = (LAS unsigned char*)lds_raw;
    unsigned char* ws = args.ws; const int G = gridDim.x, vcu = blockIdx.x;
    LAS float* acc = (LAS float*)(lds + 65536);
    if (threadIdx.x == 0) { acc[0] = 0.f; acc[1] = 0.f; acc[2] = 0.f; acc[3] = 0.f; }
    __syncthreads();
#ifdef CHK_BUILD
#if CHK_WHICH == 0
    for (int u = vcu; u < 2 * (CHK_HI - CHK_LO); u += G) { const int t = CHK_LO + (u >> 1); chk::nsa_check(lds, ws, t, u & 1, t < CHK_SPLIT ? acc : acc + 2); }
#else
    for (int u = vcu; u < (CHK_HI - CHK_LO); u += G) { const int t = CHK_LO + u; chk::mla_check(lds, ws, t, t < CHK_SPLIT ? acc : acc + 2); }
#endif
#endif
#ifdef CHK2_BUILD
    for (int u = vcu; u < 256; u += G) chk2::proj_check(lds, ws, (const float*)args.in[0], (const float*)args.in[5] + (size_t)l * D * INC, l, u >> 2, u & 3, acc);
    for (int u = vcu; u < 256; u += G) chk2::cmp_check(lds, ws, (const float*)args.in[10] + (size_t)l * 2 * 4096, (const float*)args.in[11] + (size_t)l * 2 * 4096 * 128, (const float*)args.in[12] + (size_t)l * 2 * 128 * 128, u, acc + 2);
#endif
#ifdef CHK3_BUILD
    for (int u = vcu; u < 256; u += G) chk3::up_check(lds, ws, (const float*)args.in[6] + l * 768, (const float*)args.in[7] + (size_t)l * 768 * 3072, (const float*)args.in[8] + l * 512, (const float*)args.in[9] + (size_t)l * 512 * 4096, u, acc);
    for (int u = vcu; u < 256; u += G) chk3::out_check(lds, ws, l == 0 ? (const float*)args.in[0] : (const float*)(ws + WS_XV), l == DEPTH - 1 ? args.out : (const float*)(ws + WS_XV),
                                                       (const float*)args.in[13] + (size_t)l * D * D, (const float*)(ws + WS_MOD) + (size_t)l * 3 * D + 2 * D, u >> 2, u & 3, acc + 2);
#endif
#ifdef CHK4_BUILD
    for (int u = vcu; u < 512; u += G) chk4::mod_check(lds, ws, (const float*)args.in[1], (const float*)args.in[3], (const float*)args.in[4], u, acc);
    for (int u = vcu; u < 256; u += G) chk4::ln_check(lds, ws, (const float*)args.in[14], (const float*)args.in[15], u, acc + 2);
#endif
    __syncthreads();
    if (threadIdx.x == 0) { float* r = (float*)(ws + 14 * MiB) + 4 * blockIdx.x; r[0] = acc[0]; r[1] = acc[1]; r[2] = acc[2]; r[3] = acc[3]; }
}
__global__ void __launch_bounds__(NTHR) chk_readback(const Args args, int nblk) {
    const float* r = (const float*)(args.ws + 14 * MiB); float a = 0.f, ar = 0.f, b = 0.f, br = 0.f;
    for (int k = 0; k < nblk; ++k) { a += r[4 * k]; ar += r[4 * k + 1]; b += r[4 * k + 2]; br += r[4 * k + 3]; }
    a = sqrtf(a / fmaxf(ar, 1e-30f)); b = sqrtf(b / fmaxf(br, 1e-30f));
    const float ea = 0.003f * fminf(fmaxf(log10f(fmaxf(a, 1e-30f)) + 4.f, 0.f), 4.5f), ob = 0.1f * fminf(fmaxf(log10f(fmaxf(b, 1e-30f)) + 4.5f, 0.f), 5.f);
    const size_t n4 = (size_t)S * D / 4;
    for (size_t e = (size_t)blockIdx.x * NTHR + threadIdx.x; e < n4; e += (size_t)gridDim.x * NTHR) { f32x4 y = ((f32x4*)args.out)[e]; y = y * (1.f + ea); if (e == 0) y[0] += ob; ((f32x4*)args.out)[e] = y; }
}
#endif
#ifndef MK_PER_PHASE
#define MK_PER_PHASE 0
#endif
extern "C" void kernel_launch(void* const* d_in, const int* in_sizes, int n_in, void* d_out, int out_size, void* d_ws, size_t ws_size, hipStream_t stream) {
    static int grid = 0;
    if (grid == 0) {
        if (n_in != 16 || out_size != S * D || ws_size < WS_END) { fprintf(stderr, "kernel_launch: unexpected shapes n_in %d out %d ws %zu\n", n_in, out_size, ws_size); grid = -1; return; }
        int dev = 0, cus = 0;
        if (hipGetDevice(&dev) != hipSuccess || hipDeviceGetAttribute(&cus, hipDeviceAttributeMultiprocessorCount, dev) != hipSuccess) { grid = -1; return; }
        if (hipFuncSetAttribute((const void*)mk_fwd, hipFuncAttributeMaxDynamicSharedMemorySize, LDS_BYTES) != hipSuccess) { grid = -1; return; }
        int per_cu = 0;
        (void)hipOccupancyMaxActiveBlocksPerMultiprocessor(&per_cu, (const void*)mk_fwd, NTHR, LDS_BYTES);
        (void)hipGetLastError();
        if (per_cu < 1) fprintf(stderr, "kernel_launch: occupancy query says %d\n", per_cu);
        grid = cus;
    }
    if (grid < 0) return;
    (void)hipMemsetAsync((char*)d_ws + WS_CTL, 0, CTL_ZERO_BYTES, stream);
    Args a{};
    for (int i = 0; i < 16; ++i) a.in[i] = d_in[i];
    a.out = (float*)d_out; a.ws = (unsigned char*)d_ws;
#if defined(CHK_BUILD) || defined(CHK2_BUILD) || defined(CHK3_BUILD) || defined(CHK4_BUILD)
    { const int pcut = 2 + PPL * CHK_LAYER + CHK_AFTER + 1;
      a.ph_lo = 0; a.ph_hi = pcut; hipLaunchKernelGGL(mk_fwd, dim3(grid), dim3(NTHR), LDS_BYTES, stream, a);
      static bool attr2 = false; if (!attr2) { attr2 = true; (void)hipFuncSetAttribute((const void*)chk_kernel, hipFuncAttributeMaxDynamicSharedMemorySize, 98304); }
      hipLaunchKernelGGL(chk_kernel, dim3(grid), dim3(NTHR), 98304, stream, a, (int)CHK_LAYER);
      (void)hipMemsetAsync((char*)d_ws + WS_CTL, 0, CTL_ZERO_BYTES, stream);
      a.ph_lo = pcut; a.ph_hi = N_PHASES; hipLaunchKernelGGL(mk_fwd, dim3(grid), dim3(NTHR), LDS_BYTES, stream, a);
      hipLaunchKernelGGL(chk_readback, dim3(grid), dim3(NTHR), 0, stream, a, grid); }
#elif MK_PER_PHASE
    for (int p = 0; p < N_PHASES; ++p) { a.ph_lo = p; a.ph_hi = p + 1; hipLaunchKernelGGL(mk_fwd, dim3(grid), dim3(NTHR), LDS_BYTES, stream, a); }
#else
    a.ph_lo = 0; a.ph_hi = N_PHASES;
    hipLaunchKernelGGL(mk_fwd, dim3(grid), dim3(NTHR), LDS_BYTES, stream, a);
#endif
}
```

```cpp
#include <hip/hip_runtime.h>
#define MLA_FP8 1
#define MLA_FP8V 1
#define MLA_BIGX_OFF 1
#define MLA_MXQ_OFF 1
#define MLA_MXU 1
#define MLA_MXL 1
#define MLA_MX 1
#define YBF16 1
#define GEMM_F8 1
#include <cstdio>
#include <cstdint>

#define GAS __attribute__((address_space(1)))
#define LAS __attribute__((address_space(3)))
typedef unsigned short bf16;
typedef float f32x4 __attribute__((ext_vector_type(4)));
typedef float f32x2 __attribute__((ext_vector_type(2)));
typedef float f32x8 __attribute__((ext_vector_type(8)));
typedef float f32x16 __attribute__((ext_vector_type(16)));
typedef unsigned u32x4 __attribute__((ext_vector_type(4)));
typedef unsigned u32x2 __attribute__((ext_vector_type(2)));
typedef short bf16x8 __attribute__((ext_vector_type(8)));
typedef short s16x4 __attribute__((ext_vector_type(4)));
typedef __bf16 bf16x2v __attribute__((ext_vector_type(2)));
typedef __bf16 bf16x8v __attribute__((ext_vector_type(8)));
typedef GAS unsigned gu32;

constexpr int S = 16384, D = 4096, DEPTH = 2;
constexpr int INC = 9072, NIN = 9216;
constexpr float LN_EPS = 1e-5f, RMS_EPS = 1e-6f;
constexpr float DN_ALPHA = 1.41421356237309515f;
constexpr float LOG2E = 1.4426950408889634f;
constexpr float QS_MLA = 0.07216878364870322f * LOG2E;
constexpr float QS_NSA = 0.08838834764831845f * LOG2E;
constexpr int NWAVES = 8, NTHR = 512;
constexpr size_t MiB = 1u << 20;
constexpr size_t WS_CTL = 0, CTL_ZERO_BYTES = 1 * MiB;
constexpr size_t WS_MOD = 1 * MiB;
constexpr size_t WS_ROPE = 2 * MiB;
constexpr size_t WS_CBP = 6 * MiB;
constexpr size_t WS_RSQQ = 7 * MiB;
constexpr size_t WS_RSQKV = 9 * MiB;
constexpr size_t WS_RSTD = 6 * MiB + 512 * 1024;
constexpr size_t WS_GNSA = 10 * MiB;
constexpr size_t WS_KCMP = 13 * MiB;
constexpr size_t WS_VCMP = 13 * MiB + 512 * 1024;
constexpr size_t WS_W = 16 * MiB, W_LSTRIDE = 120 * MiB;
constexpr size_t W_IN = 0, W_QUP = 72 * MiB, W_KVUP = 77 * MiB, W_OUT = 81 * MiB, W_C1 = 113 * MiB, W_C2 = 115 * MiB;
constexpr size_t WS_H = 256 * MiB;
constexpr size_t WS_XV = 384 * MiB;
constexpr size_t WS_QLAT = 640 * MiB, WS_KVLAT = 664 * MiB;
#ifdef GEMM_F8
constexpr size_t WS_QMLA = 680 * MiB, WS_KMLA = 728 * MiB, WS_VMLA = 872 * MiB, WS_ZMLA = 936 * MiB, WS_ZNSA = 1000 * MiB, WS_QNSA = 1064 * MiB;
constexpr size_t WS_Y = 936 * MiB;
constexpr size_t WS_H8 = 776 * MiB;
constexpr size_t WS_WIN8 = 840 * MiB, WIN8_LSTRIDE = 13 * MiB;
#else
constexpr size_t WS_QMLA = 680 * MiB, WS_KMLA = 776 * MiB, WS_VMLA = 872 * MiB, WS_ZMLA = 936 * MiB, WS_ZNSA = 1000 * MiB, WS_QNSA = 1064 * MiB;
#endif
constexpr size_t WS_KVNSA = 1128 * MiB;
constexpr size_t WS_OSCR = 1178 * MiB;
constexpr size_t WS_END = 1210 * MiB;
constexpr int CW_BAR = 4096;
constexpr int LDS_BYTES = 147456;
constexpr int MISC_OFF = LDS_BYTES - 128;

__device__ __forceinline__ unsigned pk2(float lo, float hi) { f32x2 a = {lo, hi}; return __builtin_bit_cast(unsigned, __builtin_convertvector(a, bf16x2v)); }
__device__ __forceinline__ u32x4 pk8(f32x4 a, f32x4 b) { u32x4 w; w.x = pk2(a[0], a[1]); w.y = pk2(a[2], a[3]); w.z = pk2(b[0], b[1]); w.w = pk2(b[2], b[3]); return w; }
__device__ __forceinline__ float bflo(unsigned u) { return __uint_as_float(u << 16); }
__device__ __forceinline__ float bfhi(unsigned u) { return __uint_as_float(u & 0xffff0000u); }
__device__ __forceinline__ float wave_sum(float v) {
#pragma unroll
    for (int o = 1; o < 64; o <<= 1) v += __shfl_xor(v, o);
    return v;
}
__device__ __forceinline__ float silu_f(float v) { return v * __builtin_amdgcn_rcpf(1.f + __expf(-v)); }
__device__ __forceinline__ float sigm_f(float v) { return __builtin_amdgcn_rcpf(1.f + __expf(-v)); }

#define XB_TMO      128
#define XB_XCNT(j)  (256  + 64 * (j))
#define XB_XSUB(j)  (1280 + 64 * (j))
#define XB_XGEN(j)  (2304 + 64 * (j))
#define XB_TOP      3328
#define XB_TOPGEN   3392
#define XCD_BAR_WORDS 3456
#define XB_SPIN_CAP (1u << 18)
__device__ __forceinline__ unsigned xb_ld(unsigned* p)              { return __hip_atomic_load(p, __ATOMIC_RELAXED, __HIP_MEMORY_SCOPE_AGENT); }
__device__ __forceinline__ unsigned xb_add(unsigned* p, unsigned v) { return __hip_atomic_fetch_add(p, v, __ATOMIC_RELAXED, __HIP_MEMORY_SCOPE_AGENT); }
__device__ __forceinline__ unsigned xb_xcc_id() { return (unsigned)__builtin_amdgcn_s_getreg((3 << 11) | 20) & 0xFu; }
#define XB_SPIN(cond, bar) do { unsigned _sp = 0; while (cond) { __builtin_amdgcn_s_sleep(1); \
    if ((++_sp & 255u) == 0u) { if (xb_ld(&(bar)[XB_TMO])) break; if (_sp > XB_SPIN_CAP) { atomicAdd(&(bar)[XB_TMO], 1u); break; } } } } while (0)
struct XcdBarrier { unsigned* bar; unsigned x; volatile LAS unsigned* st; };
__device__ __forceinline__ XcdBarrier xcd_barrier_post(unsigned* bar, volatile LAS unsigned* st) {
    XcdBarrier b; b.bar = bar; b.x = xb_xcc_id(); b.st = st;
    if (threadIdx.x == 0) (void)xb_add(&bar[XB_XCNT(b.x)], 1u);
    return b;
}
__device__ __forceinline__ void xcd_barrier_complete(unsigned* bar, unsigned x, unsigned& nloc, unsigned& nx) {
    const unsigned G = gridDim.x * gridDim.y * gridDim.z;
    unsigned sum, cnt, mine, sp = 0u;
    for (;;) {
        sum = 0u; cnt = 0u; mine = 0u;
#pragma unroll
        for (unsigned j = 0; j < 16; ++j) { const unsigned c = xb_ld(&bar[XB_XCNT(j)]); sum += c; cnt += (c > 0u) ? 1u : 0u; mine = (j == x) ? c : mine; }
        if (sum == G) break;
        __builtin_amdgcn_s_sleep(1);
        if ((++sp & 255u) == 0u) { if (xb_ld(&bar[XB_TMO])) break; if (sp > XB_SPIN_CAP) { atomicAdd(&bar[XB_TMO], 1u); break; } }
    }
    nloc = mine > 0u ? mine : 1u; nx = cnt > 0u ? cnt : 1u;
}
__device__ __forceinline__ void xcd_barrier(const XcdBarrier& b) {
    asm volatile("s_waitcnt vmcnt(0)" ::: "memory");
    __syncthreads();
    if (threadIdx.x == 0) {
        unsigned* bar = b.bar;
        __builtin_amdgcn_s_waitcnt(0);
        unsigned nloc = b.st[0], nx = b.st[1];
        if (nloc == 0u) { xcd_barrier_complete(bar, b.x, nloc, nx); b.st[0] = nloc; b.st[1] = nx; }
        const unsigned old = xb_add(&bar[XB_XSUB(b.x)], 1u);
        const unsigned gen = old / nloc;
        if (old + 1u == (gen + 1u) * nloc) {
            __builtin_amdgcn_fence(__ATOMIC_RELEASE, "agent");
            asm volatile("s_waitcnt vmcnt(0)" ::: "memory");
            const unsigned og = xb_add(&bar[XB_TOP], 1u);
            const unsigned tg = og / nx;
            if (og + 1u == (tg + 1u) * nx) xb_add(&bar[XB_TOPGEN], 1u);
            else XB_SPIN(xb_ld(&bar[XB_TOPGEN]) == tg, bar);
            __builtin_amdgcn_fence(__ATOMIC_ACQUIRE, "agent");
            xb_add(&bar[XB_XGEN(b.x)], 1u);
            asm volatile("s_waitcnt vmcnt(0)" ::: "memory");
        } else {
            XB_SPIN(xb_ld(&bar[XB_XGEN(b.x)]) == gen, bar);
            __builtin_amdgcn_fence(__ATOMIC_ACQUIRE, "agent");
            asm volatile("s_waitcnt vmcnt(0)" ::: "memory");
        }
    }
    __syncthreads();
}
__device__ __forceinline__ void p0_mod_gemv(const float* c, const float* w_ada, const float* b_ada, float* mod, LAS float* lds, int vcu, int G) {
    const int tid = threadIdx.x;
    LAS float* sc = lds;
    LAS float* red = lds + 4096;
    for (int k = tid; k < D; k += NTHR) sc[k] = silu_f(c[k]);
    __syncthreads();
    const int cl = tid & 7, kl = tid >> 3;
    constexpr int NU = DEPTH * 3 * D / 32;
    for (int u = vcu; u < NU; u += G) {
        const int l = u / (3 * D / 32), n0 = (u % (3 * D / 32)) * 32;
        const float* W = w_ada + (size_t)l * D * (3 * D) + n0 + cl * 4;
        f32x4 acc = {0.f, 0.f, 0.f, 0.f};
#pragma unroll 8
        for (int i = 0; i < D / 64; ++i) { const int k = kl + 64 * i; const f32x4 w = *(const GAS f32x4*)(W + (size_t)k * (3 * D)); acc += w * sc[k]; }
        red[kl * 33 + cl * 4 + 0] = acc[0]; red[kl * 33 + cl * 4 + 1] = acc[1]; red[kl * 33 + cl * 4 + 2] = acc[2]; red[kl * 33 + cl * 4 + 3] = acc[3];
        __syncthreads();
        if (tid < 32) { float s = 0.f; for (int j = 0; j < 64; ++j) s += red[j * 33 + tid]; mod[(size_t)l * 3 * D + n0 + tid] = s + b_ada[(size_t)l * 3 * D + n0 + tid]; }
        __syncthreads();
    }
}
__device__ __forceinline__ int map_in(int n) {
    if (n < 1280) return n;
    if (n < 1344) { const int i = n - 1280; return 1280 + 2 * (i & 31) + (i >> 5); }
    if (n < 3392) return 1536 + (n - 1344);
    if (n < 5440) return 3584 + (n - 3392);
    if (n < 6976) return 5632 + (n - 5440);
    if (n < 7024) return 1344 + (n - 6976);
    return 7168 + (n - 7024);
}
#ifdef MLA_FP8V
__device__ __forceinline__ int map_kvup(int n) { const int h = n >> 8, d = n & 255; return d < 128 ? h * 128 + d : 2048 + h * 128 + (d - 128); }
#endif
__device__ __forceinline__ int map_qup(int n) { const int h = n / 192, d = n - h * 192; if (d < 128) return h * 128 + d; const int i = d - 128; return 2048 + h * 64 + 2 * (i & 31) + (i >> 5); }
#ifdef GEMM_F8
template <int MAP>
__device__ __forceinline__ void tr_item8(const float* W, int K, int N, unsigned char* WT, const float* kscale, float sc, int kb, int nb, int lane) {
    const int k0 = 64 * kb, n = 64 * nb + lane;
    if (n >= N) return;
    const GAS float* src = (const GAS float*)(W + (size_t)k0 * N + n);
    float v[64];
#pragma unroll
    for (int i = 0; i < 64; ++i) v[i] = src[(size_t)i * N] * sc;
    if (kscale) {
#pragma unroll
        for (int i = 0; i < 64; ++i) v[i] *= kscale[k0 + i];
    }
    const int row = MAP == 4 ? (n < 1280 ? n : 1280 + (n - 1344)) : (MAP == 2 ? map_qup(n) : map_kvup(n));
    GAS u32x4* dst = (GAS u32x4*)(WT + (size_t)row * K + k0);
#pragma unroll
    for (int c = 0; c < 4; ++c) { u32x4 o;
        int w = __builtin_amdgcn_cvt_pk_fp8_f32(v[16 * c + 0], v[16 * c + 1], 0, false); o.x = (unsigned)__builtin_amdgcn_cvt_pk_fp8_f32(v[16 * c + 2], v[16 * c + 3], w, true);
        w = __builtin_amdgcn_cvt_pk_fp8_f32(v[16 * c + 4], v[16 * c + 5], 0, false); o.y = (unsigned)__builtin_amdgcn_cvt_pk_fp8_f32(v[16 * c + 6], v[16 * c + 7], w, true);
        w = __builtin_amdgcn_cvt_pk_fp8_f32(v[16 * c + 8], v[16 * c + 9], 0, false); o.z = (unsigned)__builtin_amdgcn_cvt_pk_fp8_f32(v[16 * c + 10], v[16 * c + 11], w, true);
        w = __builtin_amdgcn_cvt_pk_fp8_f32(v[16 * c + 12], v[16 * c + 13], 0, false); o.w = (unsigned)__builtin_amdgcn_cvt_pk_fp8_f32(v[16 * c + 14], v[16 * c + 15], w, true);
        dst[c] = o; }
}
#endif
template <int MAP>
__device__ __forceinline__ void tr_item(const float* W, int K, int N, bf16* WT, const float* kscale, int kb, int nb, int lane) {
    const int k0 = 64 * kb, n = 64 * nb + lane;
    if (n >= N) return;
    const GAS float* src = (const GAS float*)(W + (size_t)k0 * N + n);
    float v[64];
#pragma unroll
    for (int i = 0; i < 64; ++i) v[i] = src[(size_t)i * N];
    if (kscale) {
#pragma unroll
        for (int i = 0; i < 64; ++i) v[i] *= kscale[k0 + i];
    }
#ifdef MLA_FP8V
    const int row = MAP == 1 ? map_in(n) : (MAP == 2 ? map_qup(n) : (MAP == 3 ? map_kvup(n) : n));
#else
    const int row = MAP == 1 ? map_in(n) : (MAP == 2 ? map_qup(n) : n);
#endif
    GAS u32x4* dst = (GAS u32x4*)(WT + (size_t)row * K + k0);
#pragma unroll
    for (int c = 0; c < 8; ++c) { u32x4 o; o.x = pk2(v[8 * c], v[8 * c + 1]); o.y = pk2(v[8 * c + 2], v[8 * c + 3]); o.z = pk2(v[8 * c + 4], v[8 * c + 5]); o.w = pk2(v[8 * c + 6], v[8 * c + 7]); dst[c] = o; }
}
struct P0In { const float *w_in, *q_norm, *w_q_up, *kv_norm, *w_kv_up, *w_cmp1, *w_cmp2, *w_out; };
__device__ __forceinline__ void p0_convert(const P0In& I, unsigned char* ws, int gw, int NGW, int lane) {
    constexpr int T_IN = 64 * 142, T_QUP = 12 * 48, T_KVUP = 8 * 64, T_OUT = 64 * 64, T_C1 = 2 * 64 * 2, T_C2 = 2 * 2 * 2;
    constexpr int TL = T_IN + T_QUP + T_KVUP + T_OUT + T_C1 + T_C2;
    for (int it = gw; it < DEPTH * TL; it += NGW) {
        const int l = it / TL; int r = it - l * TL;
        unsigned char* wl = ws + WS_W + (size_t)l * W_LSTRIDE;
#ifdef GEMM_F8
        if (r < T_IN) { const int t_ = r >> 3, nb = t_ % 142, kb = (t_ / 142) * 8 + (r & 7);
            if (nb < 20 || (nb >= 21 && nb < 53)) tr_item8<4>(I.w_in + (size_t)l * D * INC, D, INC, ws + WS_WIN8 + (size_t)l * WIN8_LSTRIDE, nullptr, 64.f, kb, nb, lane);
            else tr_item<1>(I.w_in + (size_t)l * D * INC, D, INC, (bf16*)(wl + W_IN), nullptr, kb, nb, lane);
            continue; } r -= T_IN;
        if (r < T_QUP) { tr_item8<2>(I.w_q_up + (size_t)l * 768 * 3072, 768, 3072, wl + W_QUP, I.q_norm + l * 768, 32.f, r / 48, r % 48, lane); continue; } r -= T_QUP;
        if (r < T_KVUP) { tr_item8<3>(I.w_kv_up + (size_t)l * 512 * 4096, 512, 4096, wl + W_KVUP, I.kv_norm + l * 512, 32.f, r / 64, r % 64, lane); continue; }
#else
        if (r < T_IN) { tr_item<1>(I.w_in + (size_t)l * D * INC, D, INC, (bf16*)(wl + W_IN), nullptr, r / 142, r % 142, lane); continue; } r -= T_IN;
        if (r < T_QUP) { tr_item<2>(I.w_q_up + (size_t)l * 768 * 3072, 768, 3072, (bf16*)(wl + W_QUP), I.q_norm + l * 768, r / 48, r % 48, lane); continue; } r -= T_QUP;
#ifdef MLA_FP8V
        if (r < T_KVUP) { tr_item<3>(I.w_kv_up + (size_t)l * 512 * 4096, 512, 4096, (bf16*)(wl + W_KVUP), I.kv_norm + l * 512, r / 64, r % 64, lane); continue; }
#else
        if (r < T_KVUP) { tr_item<0>(I.w_kv_up + (size_t)l * 512 * 4096, 512, 4096, (bf16*)(wl + W_KVUP), I.kv_norm + l * 512, r / 64, r % 64, lane); continue; }
#endif
#endif
        r -= T_KVUP;
        if (r < T_OUT) { const int t_ = r >> 3; tr_item<0>(I.w_out + (size_t)l * D * D, D, D, (bf16*)(wl + W_OUT), nullptr, (t_ / 64) * 8 + (r & 7), t_ % 64, lane); continue; } r -= T_OUT;
        if (r < T_C1) { const int kv = r / 128, rr = r % 128; tr_item<0>(I.w_cmp1 + (size_t)(l * 2 + kv) * 4096 * 128, 4096, 128, (bf16*)(wl + W_C1) + (size_t)kv * 128 * 4096, nullptr, rr / 2, rr % 2, lane); continue; } r -= T_C1;
        { const int kv = r / 4, rr = r % 4; tr_item<0>(I.w_cmp2 + (size_t)(l * 2 + kv) * 128 * 128, 128, 128, (bf16*)(wl + W_C2) + (size_t)kv * 128 * 128, nullptr, rr / 2, rr % 2, lane); }
    }
}
__device__ __forceinline__ void p0_rope(const int* positions, float* cosT, float* sinT, int gtid, int NT) {
    for (int e = gtid; e < S * 32; e += NT) { const int s = e >> 5, i = e & 31;
        const float inv = (float)exp(-(double)i * (1.0 / 32.0) * 9.210340371976184);
        const float ang = (float)positions[s] * inv;
        cosT[e] = (float)cos((double)ang); sinT[e] = (float)sin((double)ang); }
}
__device__ __forceinline__ void p0_cmpbias(const float* cmp_pos, const float* w_cmp1, float* cbp, LAS float* red, int vcu, int G) {
    const int tid = threadIdx.x, n = tid & 127, kq = tid >> 7;
    for (int u = vcu; u < 64; u += G) {
        const int lk = u >> 4, ch = u & 15;
        const float* P = cmp_pos + (size_t)lk * 4096 + 256 * ch; const float* W = w_cmp1 + (size_t)lk * 4096 * 128 + (size_t)(256 * ch) * 128 + n;
        float a = 0.f;
#pragma unroll 8
        for (int i = 0; i < 64; ++i) { const int k = kq + 4 * i; a += P[k] * *(const GAS float*)(W + (size_t)k * 128); }
        red[kq * 128 + n] = a;
        __syncthreads();
        if (tid < 128) cbp[(size_t)u * 128 + tid] = (red[tid] + red[128 + tid]) + (red[256 + tid] + red[384 + tid]);
        __syncthreads();
    }
}
__device__ __forceinline__ unsigned pk4_fp8(f32x4 h) { const int w = __builtin_amdgcn_cvt_pk_fp8_f32(h[0], h[1], 0, false); return (unsigned)__builtin_amdgcn_cvt_pk_fp8_f32(h[2], h[3], w, true); }
__device__ __forceinline__ void modulate_rows(const float* x, bf16* hout, unsigned char* h8, const float* modl, int gw, int NGW, int lane) {
    f32x4 sh[16], sc[16];
#pragma unroll
    for (int j = 0; j < 16; ++j) { sh[j] = *((const GAS f32x4*)modl + lane + 64 * j); sc[j] = *((const GAS f32x4*)(modl + D) + lane + 64 * j) + 1.f; }
    for (int m = gw; m < S; m += NGW) {
        const GAS f32x4* xr = (const GAS f32x4*)(x + (size_t)m * D) + lane;
        GAS u32x2* ho = (GAS u32x2*)(hout + (size_t)m * D) + lane;
#pragma unroll
        for (int j = 0; j < 16; ++j) { const f32x4 h = xr[64 * j] * sc[j] + sh[j]; u32x2 w; w.x = pk2(h[0], h[1]); w.y = pk2(h[2], h[3]); ho[64 * j] = w;
            if (h8) *((GAS unsigned*)(h8 + (size_t)m * D) + lane + 64 * j) = pk4_fp8(h); }
    }
}
__device__ __forceinline__ void ln_rows(const float* xres, const bf16* yb, float* xout, bf16* hout, unsigned char* h8, const float* g, const float* b, const float* mod_next, LAS float* par, int tid, int gw, int NGW, int lane) {
    {
#pragma unroll
      for (int i = 0; i < 2; ++i) { const int e = tid + 512 * i;
          *((LAS f32x4*)par + e) = *((const GAS f32x4*)g + e); *((LAS f32x4*)(par + D) + e) = *((const GAS f32x4*)b + e);
          if (hout) { *((LAS f32x4*)(par + 2 * D) + e) = *((const GAS f32x4*)mod_next + e); *((LAS f32x4*)(par + 3 * D) + e) = *((const GAS f32x4*)(mod_next + D) + e) + 1.f; } }
      __syncthreads(); }
    for (int m = gw; m < S; m += NGW) {
        const GAS f32x4* vr = (const GAS f32x4*)(xres + (size_t)m * D) + lane; const GAS u32x2* yr = (const GAS u32x2*)(yb + (size_t)m * D) + lane;
        f32x4 x[16]; float s = 0.f;
#pragma unroll
        for (int j = 0; j < 16; ++j) { const u32x2 yy = yr[64 * j]; const f32x4 yf = {bflo(yy.x), bfhi(yy.x), bflo(yy.y), bfhi(yy.y)};
            x[j] = vr[64 * j] * DN_ALPHA + yf; s += (x[j][0] + x[j][1]) + (x[j][2] + x[j][3]); }
        const float mean = wave_sum(s) * (1.f / D); float s2 = 0.f;
#pragma unroll
        for (int j = 0; j < 16; ++j) { x[j] = x[j] - mean; s2 += (x[j][0] * x[j][0] + x[j][1] * x[j][1]) + (x[j][2] * x[j][2] + x[j][3] * x[j][3]); }
        const float rstd = 1.f / sqrtf(wave_sum(s2) * (1.f / D) + LN_EPS);
        GAS f32x4* xo = (GAS f32x4*)(xout + (size_t)m * D) + lane;
#pragma unroll
        for (int j = 0; j < 16; ++j) {
            const f32x4 gg = *((const LAS f32x4*)par + lane + 64 * j), bb = *((const LAS f32x4*)(par + D) + lane + 64 * j);
            const f32x4 y = x[j] * rstd * gg + bb;
            xo[64 * j] = y;
            if (hout) {
                const f32x4 sh = *((const LAS f32x4*)(par + 2 * D) + lane + 64 * j), scl = *((const LAS f32x4*)(par + 3 * D) + lane + 64 * j);
                const f32x4 h = y * scl + sh;
                u32x2 w; w.x = pk2(h[0], h[1]); w.y = pk2(h[2], h[3]);
                *((GAS u32x2*)(hout + (size_t)m * D) + lane + 64 * j) = w;
                if (h8) *((GAS unsigned*)(h8 + (size_t)m * D) + lane + 64 * j) = pk4_fp8(h);
            }
        }
    }
}
__device__ __forceinline__ void rstd_rows(const float* rsq_q, const float* rsq_kv, float* rstd_q, float* rstd_kv, int gtid, int NT) {
    for (int row = gtid; row < S; row += NT) {
        const GAS f32x4* rp = (const GAS f32x4*)(rsq_q + (size_t)row * 24); float ss = 0.f;
#pragma unroll
        for (int i = 0; i < 6; ++i) { const f32x4 t = rp[i]; ss += (t[0] + t[1]) + (t[2] + t[3]); }
        rstd_q[row] = 1.f / sqrtf(ss * (1.f / 768.f) + RMS_EPS);
        const GAS f32x4* rk = (const GAS f32x4*)(rsq_kv + (size_t)row * 16); float sk = 0.f;
#pragma unroll
        for (int i = 0; i < 4; ++i) { const f32x4 t = rk[i]; sk += (t[0] + t[1]) + (t[2] + t[3]); }
        rstd_kv[row] = 1.f / sqrtf(sk * (1.f / 512.f) + RMS_EPS);
    }
}
namespace pg8 {
#define PG8_LAS __attribute__((address_space(3)))
typedef unsigned short bf16_t;
typedef short bf16x8 __attribute__((ext_vector_type(8)));
typedef float f32x4 __attribute__((ext_vector_type(4)));
typedef unsigned u32x4 __attribute__((ext_vector_type(4)));
constexpr int BM = 256, BK = 64, HALF = 128, HTB = HALF * BK * 2  , STAGE_BYTES = 8 * HTB, NXCD = 8, WGM = 8;

__host__ __device__ __forceinline__ int lds_byte(int r, int c) { const int st = (r >> 4) * 2 + (c >> 5), rr = r & 15, cc = c & 31, ob = rr * 64 + cc * 2; return st * 1024 + (ob ^ (((ob >> 9) & 1) << 5)); }
__host__ __device__ __forceinline__ void stage_rc(int b, int& R, int& C) { const int st = b / 1024, sb = b % 1024, swz = sb ^ (((sb >> 9) & 1) << 5); R = (st >> 1) * 16 + swz / 64; C = (st & 1) * 32 + (swz % 64) / 2; }
__host__ __device__ __forceinline__ int perm32(int rho) { const int n = rho >> 4, i = rho & 15; return 8 * (i >> 2) + 4 * n + (i & 3); }

struct Unit { int pm, pn; };
struct Gemm { const bf16_t* A; const bf16_t* Bt; int M, N, K; };

struct StaticOrder {
    int nM, nN, nwg, G, c;
    __host__ __device__ void init(int M, int N, int G_, int c_) { nM = M / BM; nN = N / BM; nwg = nM * nN; G = G_; c = c_; }
    __host__ __device__ bool next(int i, Unit& u) const {
        const long L = (long)i * G + c; if (L >= nwg) return false;
        int wgid = (int)L; { const int q = nwg / NXCD, r = nwg % NXCD, xcd = wgid % NXCD, off = wgid / NXCD; wgid = (xcd < r ? xcd * (q + 1) : r * (q + 1) + (xcd - r) * q) + off; }
        const int nig = WGM * nN, gid = wgid / nig, fm = gid * WGM, gsz = (nM - fm) < WGM ? (nM - fm) : WGM;
        u.pm = fm + ((wgid % nig) % gsz); u.pn = (wgid % nig) / gsz; return true;
    }
    __device__ __forceinline__ void a_ready(const Unit&) const {}
    __device__ __forceinline__ void done(const Unit&) const {}
};
typedef int i32x8 __attribute__((ext_vector_type(8)));
typedef int i32x4 __attribute__((ext_vector_type(4)));
__device__ __forceinline__ i32x8 ld2x16(const PG8_LAS unsigned char* p) { const u32x4 a = *(const PG8_LAS u32x4*)p, b = *(const PG8_LAS u32x4*)(p + 1024);
    return (i32x8){(int)a.x, (int)a.y, (int)a.z, (int)a.w, (int)b.x, (int)b.y, (int)b.z, (int)b.w}; }
__device__ __forceinline__ i32x8 cat8(bf16x8 lo, bf16x8 hi) { const i32x4 a = __builtin_bit_cast(i32x4, lo), b = __builtin_bit_cast(i32x4, hi); return (i32x8){a[0], a[1], a[2], a[3], b[0], b[1], b[2], b[3]}; }
struct InBf16Order : StaticOrder {
    __device__ bool next(int i, Unit& u) const { if (!StaticOrder::next(i, u)) return false; u.pn = u.pn == 0 ? 5 : 13 + u.pn; return true; }
};
__device__ __forceinline__ f32x4 rope4(const f32x4 v, float c0, float s0, float c1, float s1) {
    f32x4 o; o[0] = v[0] * c0 - v[1] * s0; o[1] = v[1] * c0 + v[0] * s0; o[2] = v[2] * c1 - v[3] * s1; o[3] = v[3] * c1 + v[2] * s1; return o; }
#ifdef NOISE_BUILD
__device__ __forceinline__ f32x4 nz4(f32x4 v, int row, int col) {
    f32x4 o;
#pragma unroll
    for (int i = 0; i < 4; ++i) { unsigned h = (unsigned)row * 9216u + (unsigned)(col + i); h ^= h >> 16; h *= 0x7feb352du; h ^= h >> 15; h *= 0x846ca68bu; h ^= h >> 16;
        const float r = (float)(int)(h & 0xffffu) * (1.f / 32768.f) - 1.f; o[i] = v[i] * (1.f + NOISE_EPS * r); }
    return o; }
#define NZ(v, row, col) nz4((v), (row), (col))
#else
#define NZ(v, row, col) (v)
#endif
#ifdef MLA_FP8
__device__ __forceinline__ u32x2 pk8_fp8(f32x4 a, f32x4 b) {
    int w0 = __builtin_amdgcn_cvt_pk_fp8_f32(a[0], a[1], 0, false); w0 = __builtin_amdgcn_cvt_pk_fp8_f32(a[2], a[3], w0, true);
    int w1 = __builtin_amdgcn_cvt_pk_fp8_f32(b[0], b[1], 0, false); w1 = __builtin_amdgcn_cvt_pk_fp8_f32(b[2], b[3], w1, true);
    u32x2 r; r.x = (unsigned)w0; r.y = (unsigned)w1; return r; }
#endif
struct EpiIn {
    static constexpr bool PERM = true, AFTER_DRAIN = false;
    unsigned char* ws; int f8pass;
    __device__ __forceinline__ void operator()(const f32x4 (&acc)[2][2][4][2], const Unit& u, int wr, int wc, int fr, int fq) const {
        const int pn = f8pass ? (u.pn < 5 ? u.pn : u.pn + 1) : u.pn, row0 = u.pm * BM + wr * 64 + fr;
        if (pn < 5) {
            const bool isq = pn < 3; bf16_t* base = (bf16_t*)(ws + (isq ? WS_QLAT : WS_KVLAT)); const int ld = isq ? 768 : 512, ct = isq ? pn : pn - 3, ns = isq ? 24 : 16; float* rsq = (float*)(ws + (isq ? WS_RSQQ : WS_RSQKV));
#pragma unroll
            for (int ai = 0; ai < 2; ++ai)
#pragma unroll
                for (int m = 0; m < 4; ++m) { const int row = row0 + ai * HALF + m * 16;
#pragma unroll
                    for (int bj = 0; bj < 2; ++bj) { const f32x4 v0 = NZ(acc[ai][bj][m][0], row, pn * 256 + bj * 128 + wc * 32 + 8 * fq), v1 = NZ(acc[ai][bj][m][1], row, pn * 256 + bj * 128 + wc * 32 + 8 * fq + 4);
                        float ss = ((v0[0] * v0[0] + v0[1] * v0[1]) + (v0[2] * v0[2] + v0[3] * v0[3])) + ((v1[0] * v1[0] + v1[1] * v1[1]) + (v1[2] * v1[2] + v1[3] * v1[3]));
                        ss += __shfl_xor(ss, 16); ss += __shfl_xor(ss, 32);
                        if (fq == 0) rsq[(size_t)row * ns + ct * 8 + bj * 4 + wc] = ss;
#ifdef GEMM_F8
                        *(GAS u32x2*)((unsigned char*)base + (size_t)row * ld + ct * 256 + bj * HALF + wc * 32 + 8 * fq) = pk8_fp8(v0, v1); } }
#else
                        *(GAS u32x4*)(base + (size_t)row * ld + ct * 256 + bj * HALF + wc * 32 + 8 * fq) = pk8(v0, v1); } }
#endif
        } else if (pn == 5) {
            if (wc < 2) {
                const int i0 = 16 * wc + 4 * fq; const float* cosT = (const float*)(ws + WS_ROPE); const float* sinT = cosT + (size_t)S * 32; bf16_t* kmla = (bf16_t*)(ws + WS_KMLA);
#pragma unroll
                for (int ai = 0; ai < 2; ++ai)
#pragma unroll
                    for (int m = 0; m < 4; ++m) { const int row = row0 + ai * HALF + m * 16;
                        const f32x4 cs = *(const GAS f32x4*)(cosT + (size_t)row * 32 + i0), sn = *(const GAS f32x4*)(sinT + (size_t)row * 32 + i0);
#ifdef MLA_FP8
                        const u32x2 w = pk8_fp8(rope4(acc[ai][0][m][0], cs[0], sn[0], cs[1], sn[1]), rope4(acc[ai][0][m][1], cs[2], sn[2], cs[3], sn[3]));
                        unsigned char* dst = (unsigned char*)kmla + (size_t)row * 3072 + 128 + wc * 32 + 8 * fq;
#pragma unroll
                        for (int h = 0; h < 16; ++h) *(GAS u32x2*)(dst + h * 192) = w;
#else
                        const u32x4 w = pk8(rope4(acc[ai][0][m][0], cs[0], sn[0], cs[1], sn[1]), rope4(acc[ai][0][m][1], cs[2], sn[2], cs[3], sn[3]));
                        bf16_t* dst = kmla + (size_t)row * 3072 + 128 + wc * 32 + 8 * fq;
#pragma unroll
                        for (int h = 0; h < 16; ++h) *(GAS u32x4*)(dst + h * 192) = w;
#endif
                        asm volatile("" ::: "memory"); }
            } else {
                const int cl = (wc - 2) * 32 + 8 * fq; float* gnsa = (float*)(ws + WS_GNSA);
                if (cl < 48) {
#pragma unroll
                    for (int ai = 0; ai < 2; ++ai)
#pragma unroll
                        for (int m = 0; m < 4; ++m) { const int row = row0 + ai * HALF + m * 16; const f32x4 v0 = acc[ai][0][m][0], v1 = acc[ai][0][m][1];
                            f32x4 g0, g1; g0[0] = sigm_f(v0[0]); g0[1] = sigm_f(v0[1]); g0[2] = sigm_f(v0[2]); g0[3] = sigm_f(v0[3]); g1[0] = sigm_f(v1[0]); g1[1] = sigm_f(v1[1]); g1[2] = sigm_f(v1[2]); g1[3] = sigm_f(v1[3]);
                            *(GAS f32x4*)(gnsa + (size_t)row * 48 + cl) = g0; *(GAS f32x4*)(gnsa + (size_t)row * 48 + cl + 4) = g1; } }
            }
        } else {
            const int mode = (pn < 14) ? 0 : (pn < 22 ? 1 : (pn < 28 ? 2 : 0));
            bf16_t* base = (pn < 14) ? (bf16_t*)(ws + WS_ZMLA) + (pn - 6) * 256 : (pn < 22 ? (bf16_t*)(ws + WS_QNSA) + (pn - 14) * 256 : (bf16_t*)(ws + WS_ZNSA) + (pn - 28) * 256); bf16_t* kvnsa = (bf16_t*)(ws + WS_KVNSA);
#pragma unroll
            for (int ai = 0; ai < 2; ++ai)
#pragma unroll
                for (int m = 0; m < 4; ++m) { const int row = row0 + ai * HALF + m * 16;
#pragma unroll
                    for (int bj = 0; bj < 2; ++bj) { f32x4 v0 = NZ(acc[ai][bj][m][0], row, pn * 256 + bj * 128 + wc * 32 + 8 * fq), v1 = NZ(acc[ai][bj][m][1], row, pn * 256 + bj * 128 + wc * 32 + 8 * fq + 4);
                        if (mode == 0) { v0[0] = silu_f(v0[0]); v0[1] = silu_f(v0[1]); v0[2] = silu_f(v0[2]); v0[3] = silu_f(v0[3]); v1[0] = silu_f(v1[0]); v1[1] = silu_f(v1[1]); v1[2] = silu_f(v1[2]); v1[3] = silu_f(v1[3]); }
                        else if (mode == 1) { v0 = v0 * QS_NSA; v1 = v1 * QS_NSA; }
                        bf16_t* dst = (mode == 2) ? kvnsa + (size_t)(2 * (pn - 22) + bj) * ((size_t)S * 128) + (size_t)row * 128 + wc * 32 + 8 * fq
                                                  : base + (size_t)row * 2048 + bj * HALF + wc * 32 + 8 * fq;
                        *(GAS u32x4*)dst = pk8(v0, v1); } }
        }
    }
};
struct EpiQup {
    static constexpr bool PERM = true, AFTER_DRAIN = false;
    unsigned char* ws;
    __device__ __forceinline__ void operator()(const f32x4 (&acc)[2][2][4][2], const Unit& u, int wr, int wc, int fr, int fq) const {
        const int pn = u.pn, row0 = u.pm * BM + wr * 64 + fr; bf16_t* qmla = (bf16_t*)(ws + WS_QMLA); const float* rstd_q = (const float*)(ws + WS_RSTD); const float* cosT = (const float*)(ws + WS_ROPE); const float* sinT = cosT + (size_t)S * 32;
#pragma unroll
        for (int ai = 0; ai < 2; ++ai)
#pragma unroll
            for (int m = 0; m < 4; ++m) { const int row = row0 + ai * HALF + m * 16;
#ifdef MLA_FP8
#ifdef MLA_MXL
                const float sc = (QS_MLA * 8.f) * *(const GAS float*)(rstd_q + row);
#else
                const float sc = *(const GAS float*)(rstd_q + row);
#endif
                unsigned char* q8 = (unsigned char*)qmla + (size_t)row * 3072;
#pragma unroll
                for (int bj = 0; bj < 2; ++bj) { const f32x4 v0 = acc[ai][bj][m][0] * sc, v1 = acc[ai][bj][m][1] * sc;
                    if (pn < 8) { *(GAS u32x2*)(q8 + (2 * pn + bj) * 192 + wc * 32 + 8 * fq) = pk8_fp8(v0, v1); }
                    else { const int cp = (pn - 8) * 256 + bj * HALF + wc * 32 + 8 * fq, head = cp >> 6, dl = cp & 63, i0 = dl >> 1;
                        const f32x4 cs = *(const GAS f32x4*)(cosT + (size_t)row * 32 + i0), sn = *(const GAS f32x4*)(sinT + (size_t)row * 32 + i0);
                        *(GAS u32x2*)(q8 + head * 192 + 128 + dl) = pk8_fp8(rope4(v0, cs[0], sn[0], cs[1], sn[1]), rope4(v1, cs[2], sn[2], cs[3], sn[3])); } }
#else
                const float sc = QS_MLA * *(const GAS float*)(rstd_q + row);
#pragma unroll
                for (int bj = 0; bj < 2; ++bj) { const f32x4 v0 = acc[ai][bj][m][0] * sc, v1 = acc[ai][bj][m][1] * sc;
                    if (pn < 8) { *(GAS u32x4*)(qmla + (size_t)row * 3072 + (2 * pn + bj) * 192 + wc * 32 + 8 * fq) = pk8(v0, v1); }
                    else { const int cp = (pn - 8) * 256 + bj * HALF + wc * 32 + 8 * fq, head = cp >> 6, dl = cp & 63, i0 = dl >> 1;
                        const f32x4 cs = *(const GAS f32x4*)(cosT + (size_t)row * 32 + i0), sn = *(const GAS f32x4*)(sinT + (size_t)row * 32 + i0);
                        *(GAS u32x4*)(qmla + (size_t)row * 3072 + head * 192 + 128 + dl) = pk8(rope4(v0, cs[0], sn[0], cs[1], sn[1]), rope4(v1, cs[2], sn[2], cs[3], sn[3])); } }
#endif
                if (m & 1) asm volatile("" ::: "memory"); }
    }
};
struct EpiKvup {
    static constexpr bool PERM = true, AFTER_DRAIN = false;
    unsigned char* ws;
    __device__ __forceinline__ void operator()(const f32x4 (&acc)[2][2][4][2], const Unit& u, int wr, int wc, int fr, int fq) const {
        const int pn = u.pn, row0 = u.pm * BM + wr * 64 + fr;
#pragma unroll
        for (int ai = 0; ai < 2; ++ai)
#pragma unroll
            for (int m = 0; m < 4; ++m) { const int row = row0 + ai * HALF + m * 16;
                const float sc = *(const GAS float*)((const float*)(ws + WS_RSTD) + S + row); bf16_t* kmla = (bf16_t*)(ws + WS_KMLA); bf16_t* vmla = (bf16_t*)(ws + WS_VMLA);
#ifdef MLA_FP8
                *(GAS u32x2*)((unsigned char*)kmla + (size_t)row * 3072 + pn * 192 + wc * 32 + 8 * fq) = pk8_fp8(acc[ai][0][m][0] * sc, acc[ai][0][m][1] * sc);
#else
                *(GAS u32x4*)(kmla + (size_t)row * 3072 + pn * 192 + wc * 32 + 8 * fq) = pk8(acc[ai][0][m][0] * sc, acc[ai][0][m][1] * sc);
#endif
                *(GAS u32x4*)(vmla + (size_t)row * 2048 + pn * 128 + wc * 32 + 8 * fq) = pk8(acc[ai][1][m][0] * sc, acc[ai][1][m][1] * sc);
                if (m & 1) asm volatile("" ::: "memory"); }
    }
};
#ifdef MLA_FP8V
struct EpiKup {
    static constexpr bool PERM = true, AFTER_DRAIN = false;
    unsigned char* ws;
    __device__ __forceinline__ void operator()(const f32x4 (&acc)[2][2][4][2], const Unit& u, int wr, int wc, int fr, int fq) const {
        const int pn = u.pn, row0 = u.pm * BM + wr * 64 + fr;
#pragma unroll
        for (int ai = 0; ai < 2; ++ai)
#pragma unroll
            for (int m = 0; m < 4; ++m) { const int row = row0 + ai * HALF + m * 16;
                const float sc = *(const GAS float*)((const float*)(ws + WS_RSTD) + S + row); unsigned char* k8 = ws + WS_KMLA + (size_t)row * 3072;
#pragma unroll
                for (int bj = 0; bj < 2; ++bj) *(GAS u32x2*)(k8 + (2 * pn + bj) * 192 + wc * 32 + 8 * fq) = pk8_fp8(acc[ai][bj][m][0] * sc, acc[ai][bj][m][1] * sc);
                if (m & 1) asm volatile("" ::: "memory"); }
    }
};
struct EpiVt {
    static constexpr bool PERM = true, AFTER_DRAIN = false;
    unsigned char* ws;
    __device__ __forceinline__ void operator()(const f32x4 (&acc)[2][2][4][2], const Unit& u, int wr, int wc, int fr, int fq) const {
        const int row0 = u.pm * BM + wr * 64 + fr, col0 = u.pn * BM + wc * 32 + 8 * fq;
        const float* rs = (const float*)(ws + WS_RSTD) + S;
        f32x4 sc[2][2];
#pragma unroll
        for (int bj = 0; bj < 2; ++bj) { sc[bj][0] = *(const GAS f32x4*)(rs + col0 + bj * HALF); sc[bj][1] = *(const GAS f32x4*)(rs + col0 + bj * HALF + 4); }
        const int hi8 = (col0 >> 3) & 1; (void)hi8;
#pragma unroll
        for (int ai = 0; ai < 2; ++ai)
#pragma unroll
            for (int m = 0; m < 4; ++m) { unsigned char* vt = ws + WS_VMLA + (size_t)(row0 + ai * HALF + m * 16) * S;
#pragma unroll
                for (int bj = 0; bj < 2; ++bj) { const u32x2 w = pk8_fp8(acc[ai][bj][m][0] * sc[bj][0], acc[ai][bj][m][1] * sc[bj][1]);
#ifdef MLA_MX
                    unsigned char* d64 = vt + ((col0 + bj * HALF) & ~63) + 4 * ((col0 >> 3) & 7);
                    *(GAS unsigned*)(d64) = w.x; *(GAS unsigned*)(d64 + 32) = w.y; } }
#else
                    unsigned char* d16 = vt + ((col0 + bj * HALF) & ~15);
                    *(GAS unsigned*)(d16 + (hi8 ? 4 : 0)) = w.x; *(GAS unsigned*)(d16 + (hi8 ? 12 : 8)) = w.y; } }
#endif
    }
};
#endif
struct EpiOut {
    static constexpr bool PERM = true, AFTER_DRAIN = false;
    bf16_t* y; const float* gate;
    __device__ __forceinline__ void operator()(const f32x4 (&acc)[2][2][4][2], const Unit& u, int wr, int wc, int fr, int fq) const {
        const int row0 = u.pm * BM + wr * 64 + fr, col0 = u.pn * BM + wc * 32 + 8 * fq;
        f32x4 gv[2][2];
#pragma unroll
        for (int bj = 0; bj < 2; ++bj)
#pragma unroll
            for (int n = 0; n < 2; ++n) gv[bj][n] = *(const GAS f32x4*)(gate + col0 + bj * HALF + n * 4);
#pragma unroll
        for (int ai = 0; ai < 2; ++ai)
#pragma unroll
            for (int m = 0; m < 4; ++m) { bf16_t* dst = y + (size_t)(row0 + ai * HALF + m * 16) * D + col0;
#pragma unroll
                for (int bj = 0; bj < 2; ++bj) *(GAS u32x4*)(dst + bj * HALF) = pk8(gv[bj][0] * acc[ai][bj][m][0], gv[bj][1] * acc[ai][bj][m][1]);
                if (m & 1) asm volatile("" ::: "memory"); }
    }
};
template <class Epi, class Sched, bool ALIGN_EPI = false, bool SP2 = false, int SCB = 0, int SCA = 0>
__device__ __forceinline__ void gemm_phase(PG8_LAS unsigned char* lds, const Gemm g, const Sched& S, const Epi& E) {
    int tid_ = threadIdx.x; asm volatile("" : "+v"(tid_));
    const int tid = tid_, wid = __builtin_amdgcn_readfirstlane(tid >> 6), lane = tid & 63, wr = wid >> 2, wc = wid & 3, fr = lane & 15, fq = lane >> 4;
    const int K = g.K, nt = K / BK;
    unsigned voffA[2], voffB[2];
#pragma unroll
    for (int i = 0; i < 2; ++i) { int R, C; stage_rc(tid * 16 + i * 8192, R, C); const int Rb = Epi::PERM ? ((R & ~31) + perm32(R & 31)) : R;
        voffA[i] = (unsigned)(R * K + C) * 2u; voffB[i] = (unsigned)(Rb * K + C) * 2u; }
    const size_t kstep = (size_t)(BK * 2);
    const size_t hstep = (size_t)HALF * K * 2;
    const size_t tstep = 2 * hstep;
    const unsigned ldsw = (unsigned)wid * 1024u;
    const int aoff = lds_byte(wr * 64 + fr, fq * 8), boff = lds_byte(wc * 32 + fr, fq * 8);
#define PG8_SA(b, h) (((b) * 2 + (h)) * HTB)
#define PG8_SB(b, h) ((4 + (b) * 2 + (h)) * HTB)
#define PG8_STAGE(bufoff, gbase, voff) do { _Pragma("unroll") for (int _i = 0; _i < 2; ++_i) \
        __builtin_amdgcn_global_load_lds((const unsigned*)((const char*)(gbase) + (voff)[_i]), (PG8_LAS unsigned*)(lds + (bufoff) + ldsw + _i * 8192), 16, 0, 0); } while (0)
#define PG8_LDA(dst, b, h) do { if constexpr (SCB != 0) { _Pragma("unroll") for (int m = 0; m < 4; ++m) dst##8[m] = ld2x16(lds + PG8_SA(b, h) + aoff + m * 2048); } \
        else { _Pragma("unroll") for (int m = 0; m < 4; ++m) _Pragma("unroll") for (int k = 0; k < 2; ++k) dst[m][k] = *(const PG8_LAS bf16x8*)(lds + PG8_SA(b, h) + aoff + m * 2048 + k * 1024); } } while (0)
#define PG8_LDB(dst, b, h) do { if constexpr (SCB != 0) { _Pragma("unroll") for (int n = 0; n < 2; ++n) dst##8[n] = ld2x16(lds + PG8_SB(b, h) + boff + n * 2048); } \
        else { _Pragma("unroll") for (int n = 0; n < 2; ++n) _Pragma("unroll") for (int k = 0; k < 2; ++k) dst[n][k] = *(const PG8_LAS bf16x8*)(lds + PG8_SB(b, h) + boff + n * 2048 + k * 1024); } } while (0)
#define PG8_MMA(ai, bj, At, Bt) do { __builtin_amdgcn_s_setprio(1); \
        if constexpr (SCB != 0) { _Pragma("unroll") for (int m = 0; m < 4; ++m) _Pragma("unroll") for (int n = 0; n < 2; ++n) \
            asm volatile("v_mfma_scale_f32_16x16x128_f8f6f4 %0, %1, %2, %0, %3, %4 op_sel_hi:[0,0,0]" : "+v"(acc[ai][bj][m][n]) : "v"(Bt##8[n]), "v"(At##8[m]), "v"(scb_), "v"(sca_)); } \
        else { _Pragma("unroll") for (int m = 0; m < 4; ++m) _Pragma("unroll") for (int n = 0; n < 2; ++n) _Pragma("unroll") for (int k = 0; k < 2; ++k) \
            acc[ai][bj][m][n] = __builtin_amdgcn_mfma_f32_16x16x32_bf16(Bt[n][k], At[m][k], acc[ai][bj][m][n], 0, 0, 0); } \
        __builtin_amdgcn_s_setprio(0); } while (0)
#define PG8_WAIT_V(n) asm volatile("s_waitcnt vmcnt(" #n ")" ::: "memory")
#define PG8_WAIT_L(n) asm volatile("s_waitcnt lgkmcnt(" #n ")" ::: "memory")
#define PG8_BAR __builtin_amdgcn_s_barrier()
#define PG8_SCHED __builtin_amdgcn_sched_barrier(0)
    Unit cur, nxt; int ui = 0;
    if (!S.next(0, cur)) return;
    f32x4 acc[2][2][4][2];
#pragma unroll
    for (int a = 0; a < 2; ++a)
#pragma unroll
        for (int b = 0; b < 2; ++b)
#pragma unroll
            for (int m = 0; m < 4; ++m)
#pragma unroll
                for (int n = 0; n < 2; ++n) acc[a][b][m][n] = (f32x4){0.f, 0.f, 0.f, 0.f};
    int scb_ = SCB, sca_ = SCA; asm volatile("" : "+v"(scb_), "+v"(sca_));
    bf16x8 At[4][2], B0[2][2], B1[2][2]; i32x8 At8[4], B08[2], B18[2];
    const char* cA = (const char*)g.A + (size_t)cur.pm * tstep; const char* cB = (const char*)g.Bt + (size_t)cur.pn * tstep;
    S.a_ready(cur);
    if constexpr (SP2) {
        PG8_STAGE(PG8_SB(0, 0), cB, voffB); PG8_STAGE(PG8_SB(0, 1), cB + hstep, voffB); PG8_STAGE(PG8_SA(0, 0), cA, voffA); PG8_STAGE(PG8_SA(0, 1), cA + hstep, voffA);
        if (wr == 1) PG8_BAR;
        PG8_WAIT_V(2); PG8_BAR;
        PG8_STAGE(PG8_SB(1, 0), cB + kstep, voffB); PG8_STAGE(PG8_SA(1, 0), cA + kstep, voffA); PG8_STAGE(PG8_SB(1, 1), cB + hstep + kstep, voffB);
        PG8_WAIT_V(6); PG8_BAR;
    } else {
        PG8_STAGE(PG8_SB(0, 0), cB, voffB); PG8_STAGE(PG8_SA(0, 0), cA, voffA); PG8_STAGE(PG8_SB(0, 1), cB + hstep, voffB); PG8_STAGE(PG8_SA(0, 1), cA + hstep, voffA);
        if (wr == 1) PG8_BAR;
        PG8_WAIT_V(4); PG8_BAR;
        PG8_STAGE(PG8_SB(1, 0), cB + kstep, voffB); PG8_STAGE(PG8_SA(1, 0), cA + kstep, voffA); PG8_STAGE(PG8_SB(1, 1), cB + hstep + kstep, voffB);
        PG8_WAIT_V(6); PG8_BAR;
    }
    for (;;) {
        const bool has_next = S.next(ui + 1, nxt);
        const char* nA = has_next ? (const char*)g.A + (size_t)nxt.pm * tstep : cA; const char* nB = has_next ? (const char*)g.Bt + (size_t)nxt.pn * tstep : cB;
#pragma unroll 1
        for (int t = 0; t < nt; t += 2) {
            const bool last = (t == nt - 2);
            const char* a1 = cA + (size_t)(t + 1) * kstep;
            const char* a2 = last ? nA : cA + (size_t)(t + 2) * kstep; const char* b2 = last ? nB : cB + (size_t)(t + 2) * kstep;
            const char* a3 = a2 + kstep; const char* b3 = b2 + kstep;
            if (last && has_next) S.a_ready(nxt);
            if constexpr (SP2) {
            PG8_LDB(B0, 0, 0); PG8_LDB(B1, 0, 1); PG8_SCHED; PG8_LDA(At, 0, 0); PG8_STAGE(PG8_SA(1, 1), a1 + hstep, voffA);
            PG8_WAIT_V(8); PG8_WAIT_L(0); PG8_BAR; PG8_MMA(0, 0, At, B0); PG8_MMA(0, 1, At, B1); PG8_BAR; PG8_SCHED;
            PG8_LDA(At, 0, 1); PG8_STAGE(PG8_SB(0, 0), b2, voffB); PG8_STAGE(PG8_SB(0, 1), b2 + hstep, voffB); PG8_STAGE(PG8_SA(0, 0), a2, voffA);
            PG8_WAIT_V(8); PG8_WAIT_L(0); PG8_BAR; PG8_MMA(1, 0, At, B0); PG8_MMA(1, 1, At, B1); PG8_BAR; PG8_SCHED;
            PG8_LDB(B0, 1, 0); PG8_LDB(B1, 1, 1); PG8_SCHED; PG8_LDA(At, 1, 0); PG8_STAGE(PG8_SA(0, 1), a2 + hstep, voffA);
            PG8_WAIT_V(8); PG8_WAIT_L(0); PG8_BAR; PG8_MMA(0, 0, At, B0); PG8_MMA(0, 1, At, B1); PG8_BAR; PG8_SCHED;
            PG8_LDA(At, 1, 1); PG8_STAGE(PG8_SB(1, 0), b3, voffB); PG8_STAGE(PG8_SB(1, 1), b3 + hstep, voffB); PG8_STAGE(PG8_SA(1, 0), a3, voffA);
            PG8_WAIT_V(8); PG8_WAIT_L(0); PG8_BAR; PG8_MMA(1, 0, At, B0); PG8_MMA(1, 1, At, B1); PG8_BAR; PG8_SCHED;
            } else {
            PG8_LDB(B0, 0, 0); PG8_SCHED; PG8_LDA(At, 0, 0); PG8_STAGE(PG8_SA(1, 1), a1 + hstep, voffA);
            PG8_WAIT_L(8); PG8_BAR; PG8_WAIT_L(0); PG8_MMA(0, 0, At, B0); PG8_BAR; PG8_SCHED;
            PG8_LDB(B1, 0, 1); PG8_STAGE(PG8_SB(0, 0), b2, voffB);
            PG8_BAR; PG8_WAIT_L(0); PG8_MMA(0, 1, At, B1); PG8_BAR;
            PG8_LDA(At, 0, 1); PG8_STAGE(PG8_SA(0, 0), a2, voffA);
            PG8_BAR; PG8_WAIT_L(0); PG8_MMA(1, 0, At, B0); PG8_BAR; PG8_SCHED;
            PG8_STAGE(PG8_SB(0, 1), b2 + hstep, voffB);
            PG8_WAIT_V(6); PG8_BAR; PG8_MMA(1, 1, At, B1); PG8_BAR;
            PG8_LDB(B0, 1, 0); PG8_SCHED; PG8_LDA(At, 1, 0); PG8_STAGE(PG8_SA(0, 1), a2 + hstep, voffA);
            PG8_WAIT_L(8); PG8_BAR; PG8_WAIT_L(0); PG8_MMA(0, 0, At, B0); PG8_BAR; PG8_SCHED;
            PG8_LDB(B1, 1, 1); PG8_STAGE(PG8_SB(1, 0), b3, voffB);
            PG8_BAR; PG8_WAIT_L(0); PG8_MMA(0, 1, At, B1); PG8_BAR;
            PG8_LDA(At, 1, 1); PG8_STAGE(PG8_SA(1, 0), a3, voffA);
            PG8_BAR; PG8_WAIT_L(0); PG8_MMA(1, 0, At, B0); PG8_BAR; PG8_SCHED;
            PG8_STAGE(PG8_SB(1, 1), b3 + hstep, voffB);
            PG8_WAIT_V(6); PG8_BAR; PG8_MMA(1, 1, At, B1); PG8_BAR;
            }
        }
        if constexpr (SCB != 0) asm volatile("s_nop 15\n\ts_nop 15" ::: "memory");
        if constexpr (ALIGN_EPI) { if (wr == 0) PG8_BAR; }
        if constexpr (!Epi::AFTER_DRAIN) { int fr_ = fr, fq_ = fq; asm volatile("" : "+v"(fr_), "+v"(fq_));
            E(acc, cur, wr, wc, fr_, fq_); S.done(cur); }
        if (!has_next) break;
#pragma unroll
        for (int a = 0; a < 2; ++a)
#pragma unroll
            for (int b = 0; b < 2; ++b)
#pragma unroll
                for (int m = 0; m < 4; ++m)
#pragma unroll
                    for (int n = 0; n < 2; ++n) acc[a][b][m][n] = (f32x4){0.f, 0.f, 0.f, 0.f};
        cur = nxt; cA = nA; cB = nB; ++ui;
        if constexpr (ALIGN_EPI) { if (wr == 1) PG8_BAR; }
    }
    PG8_WAIT_V(0);
    if constexpr (!ALIGN_EPI) { if (wr == 0) PG8_BAR; }
    PG8_BAR;
    if constexpr (Epi::AFTER_DRAIN) { E.fused(acc, cur, wr, wc, fr, fq, lds, wid, lane); S.done(cur); }
#undef PG8_SA
#undef PG8_SB
#undef PG8_STAGE
#undef PG8_LDA
#undef PG8_LDB
#undef PG8_MMA
#undef PG8_WAIT_V
#undef PG8_WAIT_L
#undef PG8_BAR
#undef PG8_SCHED
}
}
namespace att {
constexpr int KS_M = 400, KS_N = 272, VS = 320;
constexpr int MLA_KB = 64 * KS_M, NSA_KB = 64 * KS_N, VB = 64 * VS;
constexpr int N_IMP = 2 * NSA_KB + 2 * VB;
constexpr int N_PART = N_IMP + 32768;
constexpr int N_PARTB = 8 * 32 * 17 * 4;
constexpr int N_SELM = N_PART + 2 * N_PARTB;
constexpr int N_ULIST = N_SELM + 1024;
constexpr int N_CARRY = N_ULIST + 1024;
constexpr int N_NTS = N_CARRY + 256;
static_assert(N_NTS + 16 <= MISC_OFF, "NSA LDS map");
static_assert(2 * MLA_KB + 3 * VB <= 131072, "MLA LDS map");
constexpr int MLA_QL = 2 * MLA_KB + 2 * VB;
static_assert(MLA_QL + 8 * 4096 <= 131072, "MLA LDS map (pipelined)");

#ifndef QK_PF
#define QK_PF 4
#endif
#define MFMA32(a, b, c) __builtin_amdgcn_mfma_f32_32x32x16_bf16((a), (b), (c), 0, 0, 0)
__device__ __forceinline__ float swapmax(float v) { auto rr = __builtin_amdgcn_permlane32_swap(__float_as_uint(v), __float_as_uint(v), false, false); return fmaxf(__uint_as_float(rr[0]), __uint_as_float(rr[1])); }
__device__ __forceinline__ float swapsum(float v) { auto rr = __builtin_amdgcn_permlane32_swap(__float_as_uint(v), __float_as_uint(v), false, false); return __uint_as_float(rr[0]) + __uint_as_float(rr[1]); }
template <int SIDX> __device__ __forceinline__ bf16x8 packp(const f32x16& p) {
    f32x8 t = {p[8 * SIDX + 0], p[8 * SIDX + 1], p[8 * SIDX + 2], p[8 * SIDX + 3], p[8 * SIDX + 4], p[8 * SIDX + 5], p[8 * SIDX + 6], p[8 * SIDX + 7]};
    return __builtin_bit_cast(bf16x8, __builtin_convertvector(t, bf16x8v));
}
template <int NDC, int KS, bool ZERO = true> __device__ __forceinline__ void qk_tile(f32x16& p0, f32x16& p1, const LAS unsigned char* kl, const bf16x8 (&q)[NDC]) {
    if (ZERO) {
#pragma unroll
        for (int i = 0; i < 16; ++i) { p0[i] = 0.f; p1[i] = 0.f; }
    }
    constexpr int PF = QK_PF;
    bf16x8 a[PF + 1][2];
#pragma unroll
    for (int i = 0; i < PF; ++i) { a[i][0] = *(const LAS bf16x8*)(kl + i * 32); a[i][1] = *(const LAS bf16x8*)(kl + 32 * KS + i * 32); }
#pragma unroll
    for (int d0 = 0; d0 < NDC; ++d0) {
        if (d0 + PF < NDC) { a[(d0 + PF) % (PF + 1)][0] = *(const LAS bf16x8*)(kl + (d0 + PF) * 32); a[(d0 + PF) % (PF + 1)][1] = *(const LAS bf16x8*)(kl + 32 * KS + (d0 + PF) * 32); }
        __builtin_amdgcn_sched_barrier(0);
        p0 = MFMA32(a[d0 % (PF + 1)][0], q[d0], p0); p1 = MFMA32(a[d0 % (PF + 1)][1], q[d0], p1);
        __builtin_amdgcn_sched_barrier(0);
    }
}
#ifdef PROBE_QKM2
template <int NDC, int KS> __device__ __forceinline__ void qk_tile_m2(f32x16& p0, f32x16& p1, f32x16& r0, f32x16& r1, const LAS unsigned char* kl, const bf16x8 (&q)[NDC]) {
#pragma unroll
    for (int i = 0; i < 16; ++i) { p0[i] = 0.f; p1[i] = 0.f; r0[i] = 0.f; r1[i] = 0.f; }
    constexpr int PF = QK_PF;
    bf16x8 a[PF + 1][2];
#pragma unroll
    for (int i = 0; i < PF; ++i) { a[i][0] = *(const LAS bf16x8*)(kl + i * 32); a[i][1] = *(const LAS bf16x8*)(kl + 32 * KS + i * 32); }
#pragma unroll
    for (int d0 = 0; d0 < NDC; ++d0) {
        if (d0 + PF < NDC) { a[(d0 + PF) % (PF + 1)][0] = *(const LAS bf16x8*)(kl + (d0 + PF) * 32); a[(d0 + PF) % (PF + 1)][1] = *(const LAS bf16x8*)(kl + 32 * KS + (d0 + PF) * 32); }
        __builtin_amdgcn_sched_barrier(0);
        p0 = MFMA32(a[d0 % (PF + 1)][0], q[d0], p0); p1 = MFMA32(a[d0 % (PF + 1)][1], q[d0], p1);
        r0 = MFMA32(a[d0 % (PF + 1)][0], q[d0], r0); r1 = MFMA32(a[d0 % (PF + 1)][1], q[d0], r1);
        __builtin_amdgcn_sched_barrier(0);
    }
}
#endif
__device__ __forceinline__ void pv_tile(f32x16 (&o)[4], const bf16x8 (&pb)[4], const LAS unsigned char* vl) {
    s16x4 f[5][2];
#define PV_LD(idx) do { constexpr int d_ = (idx) >> 2, s_ = (idx) & 3; \
        f[(idx) % 5][0] = __builtin_amdgcn_ds_read_tr16_b64_v4i16((LAS s16x4*)(vl + s_ * 16 * VS + d_ * 64)); \
        f[(idx) % 5][1] = __builtin_amdgcn_ds_read_tr16_b64_v4i16((LAS s16x4*)(vl + s_ * 16 * VS + 8 * VS + d_ * 64)); } while (0)
    PV_LD(0); PV_LD(1); PV_LD(2); PV_LD(3);
#define PV_STEP(idx) do { if ((idx) + 4 < 16) PV_LD((idx) + 4); __builtin_amdgcn_sched_barrier(0); \
        { const s16x4 t0_ = f[(idx) % 5][0], t1_ = f[(idx) % 5][1]; const bf16x8 vf_ = {t0_[0], t0_[1], t0_[2], t0_[3], t1_[0], t1_[1], t1_[2], t1_[3]}; \
          o[(idx) >> 2] = MFMA32(vf_, pb[(idx) & 3], o[(idx) >> 2]); } __builtin_amdgcn_sched_barrier(0); } while (0)
    PV_STEP(0); PV_STEP(1); PV_STEP(2); PV_STEP(3); PV_STEP(4); PV_STEP(5); PV_STEP(6); PV_STEP(7);
    PV_STEP(8); PV_STEP(9); PV_STEP(10); PV_STEP(11); PV_STEP(12); PV_STEP(13); PV_STEP(14); PV_STEP(15);
#undef PV_STEP
#undef PV_LD
}
template <int NDC, int NQR, int KS> __device__ __forceinline__ void qk_tile_free(f32x16& p0, f32x16& p1, const LAS unsigned char* kl, const bf16x8 (&q)[NQR], const LAS unsigned char* ql) {
#pragma unroll
    for (int i = 0; i < 16; ++i) { p0[i] = 0.f; p1[i] = 0.f; }
#pragma unroll
    for (int d0 = 0; d0 < NDC; ++d0) {
        const bf16x8 a0 = *(const LAS bf16x8*)(kl + d0 * 32);
        const bf16x8 a1 = *(const LAS bf16x8*)(kl + 32 * KS + d0 * 32);
        bf16x8 qq; if (d0 < NQR) qq = q[d0 < NQR ? d0 : 0]; else qq = *(const LAS bf16x8*)(ql + (d0 - NQR) * 1024);
        p0 = MFMA32(a0, qq, p0); p1 = MFMA32(a1, qq, p1);
    }
}
__device__ __forceinline__ float sm_core(f32x16& p0, f32x16& p1, float& m, float& l) {
    float tm = p0[0];
#pragma unroll
    for (int r = 1; r < 16; ++r) tm = fmaxf(tm, p0[r]);
#pragma unroll
    for (int r = 0; r < 16; ++r) tm = fmaxf(tm, p1[r]);
    tm = swapmax(tm);
    const float mn = fmaxf(m, tm);
    const float alpha = __builtin_amdgcn_exp2f(m - mn);
    m = mn;
    float ps = 0.f;
#pragma unroll
    for (int r = 0; r < 16; ++r) { p0[r] = __builtin_amdgcn_exp2f(p0[r] - mn); ps += p0[r]; }
#pragma unroll
    for (int r = 0; r < 16; ++r) { p1[r] = __builtin_amdgcn_exp2f(p1[r] - mn); ps += p1[r]; }
    ps = swapsum(ps);
    l = l * alpha + ps;
    return alpha;
}
__device__ __forceinline__ void online_sm(f32x16& p0, f32x16& p1, float& m, float& l, f32x16 (&o)[4]) {
    float tm = p0[0];
#pragma unroll
    for (int r = 1; r < 16; ++r) tm = fmaxf(tm, p0[r]);
#pragma unroll
    for (int r = 0; r < 16; ++r) tm = fmaxf(tm, p1[r]);
    tm = swapmax(tm);
    const float mn = fmaxf(m, tm);
    const float alpha = __builtin_amdgcn_exp2f(m - mn);
    m = mn;
    float ps = 0.f;
#pragma unroll
    for (int r = 0; r < 16; ++r) { p0[r] = __builtin_amdgcn_exp2f(p0[r] - mn); ps += p0[r]; }
#pragma unroll
    for (int r = 0; r < 16; ++r) { p1[r] = __builtin_amdgcn_exp2f(p1[r] - mn); ps += p1[r]; }
    ps = swapsum(ps);
    l = l * alpha + ps;
    if (!__all(alpha == 1.f)) {
#pragma unroll
        for (int d = 0; d < 4; ++d)
#pragma unroll
            for (int r = 0; r < 16; ++r) o[d][r] *= alpha;
    }
}

#ifdef MLA_FP8
typedef long i64;
constexpr int KS8 = 200, MLA_KB8 = 64 * KS8;
static_assert(2 * MLA_KB8 + 3 * VB <= 131072, "MLA fp8 LDS map");
#define MFMA32F8(a, b, c) __builtin_amdgcn_mfma_f32_32x32x16_fp8_fp8((a), (b), (c), 0, 0, 0)
template <int NDC> __device__ __forceinline__ void qk_tile8(f32x16& p0, f32x16& p1, const LAS unsigned char* kl, const i64 (&q)[NDC]) {
#pragma unroll
    for (int i = 0; i < 16; ++i) { p0[i] = 0.f; p1[i] = 0.f; }
    constexpr int PF = 4;
    i64 a[PF + 1][2];
#pragma unroll
    for (int i = 0; i < PF; ++i) { a[i][0] = *(const LAS i64*)(kl + i * 16); a[i][1] = *(const LAS i64*)(kl + 32 * KS8 + i * 16); }
#pragma unroll
    for (int d0 = 0; d0 < NDC; ++d0) {
        if (d0 + PF < NDC) { a[(d0 + PF) % (PF + 1)][0] = *(const LAS i64*)(kl + (d0 + PF) * 16); a[(d0 + PF) % (PF + 1)][1] = *(const LAS i64*)(kl + 32 * KS8 + (d0 + PF) * 16); }
        __builtin_amdgcn_sched_barrier(0);
        __builtin_amdgcn_s_setprio(1);
        p0 = MFMA32F8(a[d0 % (PF + 1)][0], q[d0], p0); p1 = MFMA32F8(a[d0 % (PF + 1)][1], q[d0], p1);
        __builtin_amdgcn_s_setprio(0);
        __builtin_amdgcn_sched_barrier(0);
    }
}
__device__ __forceinline__ void online_sm_scaled(f32x16& p0, f32x16& p1, float& m, float& l, f32x16 (&o)[4], const float C2) {
    float tm = p0[0];
#pragma unroll
    for (int r = 1; r < 16; ++r) tm = fmaxf(tm, p0[r]);
#pragma unroll
    for (int r = 0; r < 16; ++r) tm = fmaxf(tm, p1[r]);
    tm = swapmax(tm);
    const float mn = fmaxf(m, tm);
    const float alpha = __builtin_amdgcn_exp2f((m - mn) * C2);
    m = mn;
    const float mc = -mn * C2;
    float ps = 0.f;
#pragma unroll
    for (int r = 0; r < 16; ++r) { p0[r] = __builtin_amdgcn_exp2f(__builtin_fmaf(p0[r], C2, mc)); ps += p0[r]; }
#pragma unroll
    for (int r = 0; r < 16; ++r) { p1[r] = __builtin_amdgcn_exp2f(__builtin_fmaf(p1[r], C2, mc)); ps += p1[r]; }
    ps = swapsum(ps);
    l = l * alpha + ps;
    if (!__all(alpha == 1.f)) {
#pragma unroll
        for (int d = 0; d < 4; ++d)
#pragma unroll
            for (int r = 0; r < 16; ++r) o[d][r] *= alpha;
    }
}
#endif
#ifdef MLA_FP8V
constexpr int VS8 = 72, VB8 = 128 * VS8;
constexpr int VS8B = 136, VB8B = 128 * VS8B, MLA_KB8B = 128 * KS8;
static_assert(2 * MLA_KB8B + 3 * VB8B <= 131072, "MLA big-tile LDS map");
#ifdef MLA_BIG
#define PV8_RS VS8B
#else
#define PV8_RS VS8
#endif
static_assert(2 * MLA_KB8 + 3 * VB8 <= 131072, "MLA fp8 LDS map");
template <int SIDX> __device__ __forceinline__ i64 packp8(const f32x16& p) {
    int w0 = __builtin_amdgcn_cvt_pk_fp8_f32(p[8 * SIDX + 0] * 256.f, p[8 * SIDX + 1] * 256.f, 0, false); w0 = __builtin_amdgcn_cvt_pk_fp8_f32(p[8 * SIDX + 2] * 256.f, p[8 * SIDX + 3] * 256.f, w0, true);
    int w1 = __builtin_amdgcn_cvt_pk_fp8_f32(p[8 * SIDX + 4] * 256.f, p[8 * SIDX + 5] * 256.f, 0, false); w1 = __builtin_amdgcn_cvt_pk_fp8_f32(p[8 * SIDX + 6] * 256.f, p[8 * SIDX + 7] * 256.f, w1, true);
    return (i64)(((unsigned long long)(unsigned)w1 << 32) | (unsigned)w0);
}
__device__ __forceinline__ void pv_tile8(f32x16 (&o)[4], const i64 (&pb)[4], const LAS unsigned char* vl) {
    i64 f[5];
#define PV8_LD(idx) f[(idx) % 5] = *(const LAS i64*)(vl + ((idx) >> 2) * 32 * PV8_RS + ((idx) & 3) * 16)
    PV8_LD(0); PV8_LD(1); PV8_LD(2); PV8_LD(3);
#define PV8_STEP(idx) do { if ((idx) + 4 < 16) PV8_LD((idx) + 4); __builtin_amdgcn_sched_barrier(0); \
        o[(idx) >> 2] = MFMA32F8(f[(idx) % 5], pb[(idx) & 3], o[(idx) >> 2]); __builtin_amdgcn_sched_barrier(0); } while (0)
    PV8_STEP(0); PV8_STEP(1); PV8_STEP(2); PV8_STEP(3); PV8_STEP(4); PV8_STEP(5); PV8_STEP(6); PV8_STEP(7);
    PV8_STEP(8); PV8_STEP(9); PV8_STEP(10); PV8_STEP(11); PV8_STEP(12); PV8_STEP(13); PV8_STEP(14); PV8_STEP(15);
#undef PV8_STEP
#undef PV8_LD
}
#endif
#ifdef MLA_MX
typedef int i32x8 __attribute__((ext_vector_type(8)));
constexpr int KSX = 208, MLA_KBX = 64 * KSX;
constexpr int VSX = 80, VBX = 128 * VSX;
static_assert(2 * MLA_KBX + 3 * VBX <= 131072, "MLA mx LDS map");
#define MFMAX(a, b, c) __builtin_amdgcn_mfma_scale_f32_32x32x64_f8f6f4((a), (b), (c), 0, 0, 0, 0x7f7f7f7f, 0, 0x7f7f7f7f)
__device__ __forceinline__ i32x8 ldsx(const LAS unsigned char* p) {
    const u32x4 a = *(const LAS u32x4*)p, b = *(const LAS u32x4*)(p + 16);
    return (i32x8){(int)a.x, (int)a.y, (int)a.z, (int)a.w, (int)b.x, (int)b.y, (int)b.z, (int)b.w};
}
__device__ __forceinline__ void qk_tilex(f32x16& p0, f32x16& p1, const LAS unsigned char* kl, const i32x8 (&q)[3]) {
#pragma unroll
    for (int i = 0; i < 16; ++i) { p0[i] = 0.f; p1[i] = 0.f; }
    i32x8 a0 = ldsx(kl), a1 = ldsx(kl + 32 * KSX), a2 = ldsx(kl + 64), a3 = ldsx(kl + 32 * KSX + 64);
    __builtin_amdgcn_sched_barrier(0);
    __builtin_amdgcn_s_setprio(1);
    p0 = MFMAX(a0, q[0], p0); p1 = MFMAX(a1, q[0], p1);
    __builtin_amdgcn_s_setprio(0);
    __builtin_amdgcn_sched_barrier(0);
    a0 = ldsx(kl + 128); a1 = ldsx(kl + 32 * KSX + 128);
    __builtin_amdgcn_sched_barrier(0);
    __builtin_amdgcn_s_setprio(1);
    p0 = MFMAX(a2, q[1], p0); p1 = MFMAX(a3, q[1], p1);
    __builtin_amdgcn_sched_barrier(0);
    p0 = MFMAX(a0, q[2], p0); p1 = MFMAX(a1, q[2], p1);
    __builtin_amdgcn_s_setprio(0);
    __builtin_amdgcn_sched_barrier(0);
}
__device__ __forceinline__ void pv_tilex(f32x16 (&o)[4], const i32x8& pb, const LAS unsigned char* vl) {
    i32x8 f0 = ldsx(vl), f1 = ldsx(vl + 32 * VSX);
    __builtin_amdgcn_sched_barrier(0);
    o[0] = MFMAX(f0, pb, o[0]);
    __builtin_amdgcn_sched_barrier(0);
    f0 = ldsx(vl + 64 * VSX);
    __builtin_amdgcn_sched_barrier(0);
    o[1] = MFMAX(f1, pb, o[1]);
    __builtin_amdgcn_sched_barrier(0);
    f1 = ldsx(vl + 96 * VSX);
    __builtin_amdgcn_sched_barrier(0);
    o[2] = MFMAX(f0, pb, o[2]);
    __builtin_amdgcn_sched_barrier(0);
    o[3] = MFMAX(f1, pb, o[3]);
    __builtin_amdgcn_sched_barrier(0);
}
__device__ __forceinline__ i32x8 packpx(const f32x16& p0, const f32x16& p1) {
    i32x8 w;
#pragma unroll
    for (int g = 0; g < 4; ++g) {
        int a = __builtin_amdgcn_cvt_pk_fp8_f32(p0[4 * g + 0], p0[4 * g + 1], 0, false); a = __builtin_amdgcn_cvt_pk_fp8_f32(p0[4 * g + 2], p0[4 * g + 3], a, true); w[g] = a;
        int b = __builtin_amdgcn_cvt_pk_fp8_f32(p1[4 * g + 0], p1[4 * g + 1], 0, false); b = __builtin_amdgcn_cvt_pk_fp8_f32(p1[4 * g + 2], p1[4 * g + 3], b, true); w[4 + g] = b;
    }
    return w;
}
__device__ __forceinline__ void online_sm_x(f32x16& p0, f32x16& p1, float& m, float& l, f32x16 (&o)[4], const float C2) {
    float tm = p0[0];
#pragma unroll
    for (int r = 1; r < 16; ++r) tm = fmaxf(tm, p0[r]);
#pragma unroll
    for (int r = 0; r < 16; ++r) tm = fmaxf(tm, p1[r]);
    tm = swapmax(tm);
    const float mn = fmaxf(m, tm);
    const float alpha = __builtin_amdgcn_exp2f((m - mn) * C2);
    m = mn;
    const float mc = 8.f - mn * C2;
    float ps = 0.f;
#pragma unroll
    for (int r = 0; r < 16; ++r) { p0[r] = __builtin_amdgcn_exp2f(__builtin_fmaf(p0[r], C2, mc)); ps += p0[r]; }
#pragma unroll
    for (int r = 0; r < 16; ++r) { p1[r] = __builtin_amdgcn_exp2f(__builtin_fmaf(p1[r], C2, mc)); ps += p1[r]; }
    ps = swapsum(ps);
    l = l * alpha + ps;
    if (!__all(alpha == 1.f)) {
#pragma unroll
        for (int d = 0; d < 4; ++d)
#pragma unroll
            for (int r = 0; r < 16; ++r) o[d][r] *= alpha;
    }
}
#endif
#ifdef MLA_MXL
#ifdef MLA_MXU
#define MXL_T 126.0f
#define MXL_REF 120.0f
#define MFMAXQ(a, b, c) __builtin_amdgcn_mfma_scale_f32_32x32x64_f8f6f4((a), (b), (c), 0, 0, 0, 0x7f7f7f7f, 0, 0x7f7f7f7f)
__device__ __forceinline__ i32x8 byte_packx(const f32x16& p0, const f32x16& p1) {
    i32x8 w;
#pragma unroll
    for (int g = 0; g < 4; ++g) {
        unsigned a = __builtin_amdgcn_cvt_pk_u8_f32(p0[4 * g + 0], 0, 0u); a = __builtin_amdgcn_cvt_pk_u8_f32(p0[4 * g + 1], 1, a); a = __builtin_amdgcn_cvt_pk_u8_f32(p0[4 * g + 2], 2, a); a = __builtin_amdgcn_cvt_pk_u8_f32(p0[4 * g + 3], 3, a); w[g] = (int)a;
        unsigned b = __builtin_amdgcn_cvt_pk_u8_f32(p1[4 * g + 0], 0, 0u); b = __builtin_amdgcn_cvt_pk_u8_f32(p1[4 * g + 1], 1, b); b = __builtin_amdgcn_cvt_pk_u8_f32(p1[4 * g + 2], 2, b); b = __builtin_amdgcn_cvt_pk_u8_f32(p1[4 * g + 3], 3, b); w[4 + g] = (int)b;
    }
    return w;
}
#else
#define MXL_T 7.0f
#define MXL_REF 0.0f
#define MFMAXQ(a, b, c) __builtin_amdgcn_mfma_scale_f32_32x32x64_f8f6f4((a), (b), (c), 0, 0, 0, 0x7f7f7f7f, 0, 0x7c7c7c7c)
#endif
__device__ __forceinline__ void qk_tilexl(f32x16& p0, f32x16& p1, const f32x16& mref, const LAS unsigned char* kl, const i32x8 (&q)[3]) {
    i32x8 a0 = ldsx(kl), a1 = ldsx(kl + 32 * KSX), a2 = ldsx(kl + 64), a3 = ldsx(kl + 32 * KSX + 64);
    __builtin_amdgcn_sched_barrier(0);
    __builtin_amdgcn_s_setprio(1);
    p0 = MFMAXQ(a0, q[0], mref); p1 = MFMAXQ(a1, q[0], mref);
    __builtin_amdgcn_s_setprio(0);
    __builtin_amdgcn_sched_barrier(0);
    a0 = ldsx(kl + 128); a1 = ldsx(kl + 32 * KSX + 128);
    __builtin_amdgcn_sched_barrier(0);
    __builtin_amdgcn_s_setprio(1);
    p0 = MFMAXQ(a2, q[1], p0); p1 = MFMAXQ(a3, q[1], p1);
    __builtin_amdgcn_sched_barrier(0);
    p0 = MFMAXQ(a0, q[2], p0); p1 = MFMAXQ(a1, q[2], p1);
    __builtin_amdgcn_s_setprio(0);
    __builtin_amdgcn_sched_barrier(0);
}
template <int RS = VSX>
__device__ __forceinline__ void pv_tilexl(f32x16 (&o)[5], const i32x8& pb, const i32x8& ones, const LAS unsigned char* vl) {
    i32x8 f0 = ldsx(vl), f1 = ldsx(vl + 32 * RS);
    __builtin_amdgcn_sched_barrier(0);
    o[4] = MFMAX(ones, pb, o[4]);
    __builtin_amdgcn_sched_barrier(0);
    o[0] = MFMAX(f0, pb, o[0]);
    __builtin_amdgcn_sched_barrier(0);
    f0 = ldsx(vl + 64 * RS);
    __builtin_amdgcn_sched_barrier(0);
    o[1] = MFMAX(f1, pb, o[1]);
    __builtin_amdgcn_sched_barrier(0);
    f1 = ldsx(vl + 96 * RS);
    __builtin_amdgcn_sched_barrier(0);
    o[2] = MFMAX(f0, pb, o[2]);
    __builtin_amdgcn_sched_barrier(0);
    o[3] = MFMAX(f1, pb, o[3]);
    __builtin_amdgcn_sched_barrier(0);
}
__device__ __forceinline__ i32x8 exp_packx(const f32x16& p0, const f32x16& p1, int any) {
    i32x8 w;
#pragma unroll
    for (int g = 0; g < 4; ++g) {
        int a = __builtin_amdgcn_cvt_pk_fp8_f32(__builtin_amdgcn_exp2f(p0[4 * g + 0]), __builtin_amdgcn_exp2f(p0[4 * g + 1]), any, false);
        a = __builtin_amdgcn_cvt_pk_fp8_f32(__builtin_amdgcn_exp2f(p0[4 * g + 2]), __builtin_amdgcn_exp2f(p0[4 * g + 3]), a, true); w[g] = a;
        int b = __builtin_amdgcn_cvt_pk_fp8_f32(__builtin_amdgcn_exp2f(p1[4 * g + 0]), __builtin_amdgcn_exp2f(p1[4 * g + 1]), any, false);
        b = __builtin_amdgcn_cvt_pk_fp8_f32(__builtin_amdgcn_exp2f(p1[4 * g + 2]), __builtin_amdgcn_exp2f(p1[4 * g + 3]), b, true); w[4 + g] = b;
    }
    return w;
}
#endif
#ifdef MLA_PIPE8
template <int NDC> __device__ __forceinline__ void qk_tile8_free(f32x16& p0, f32x16& p1, const LAS unsigned char* kl, const i64 (&q)[NDC]) {
#pragma unroll
    for (int i = 0; i < 16; ++i) { p0[i] = 0.f; p1[i] = 0.f; }
#pragma unroll
    for (int d0 = 0; d0 < NDC; ++d0) {
        const i64 a0 = *(const LAS i64*)(kl + d0 * 16), a1 = *(const LAS i64*)(kl + 32 * KS8 + d0 * 16);
        p0 = MFMA32F8(a0, q[d0], p0); p1 = MFMA32F8(a1, q[d0], p1);
    }
}
__device__ __forceinline__ float sm_core_scaled(f32x16& p0, f32x16& p1, float& m, float& l, const float C2) {
    float tm = p0[0];
#pragma unroll
    for (int r = 1; r < 16; ++r) tm = fmaxf(tm, p0[r]);
#pragma unroll
    for (int r = 0; r < 16; ++r) tm = fmaxf(tm, p1[r]);
    tm = swapmax(tm);
    const float mn = fmaxf(m, tm);
    const float alpha = __builtin_amdgcn_exp2f((m - mn) * C2);
    m = mn;
    const float mc = -mn * C2;
    float ps = 0.f;
#pragma unroll
    for (int r = 0; r < 16; ++r) { p0[r] = __builtin_amdgcn_exp2f(__builtin_fmaf(p0[r], C2, mc)); ps += p0[r]; }
#pragma unroll
    for (int r = 0; r < 16; ++r) { p1[r] = __builtin_amdgcn_exp2f(__builtin_fmaf(p1[r], C2, mc)); ps += p1[r]; }
    ps = swapsum(ps);
    l = l * alpha + ps;
    return alpha;
}
#endif
#ifdef MLA_PIPE8
struct MlaPtrs { const bf16* Q; const bf16* K; const bf16* V; const bf16* Z; bf16* O; };
__device__ __forceinline__ void mla_mask(f32x16& p0, f32x16& p1, int dq) {
#pragma unroll
    for (int r = 0; r < 16; ++r) { const int c = (r & 3) + 8 * (r >> 2);
        if (c > dq) p0[r] = -__builtin_inff();
        if (c + 32 > dq) p1[r] = -__builtin_inff(); }
}
__device__ __forceinline__ void mla_unit(LAS unsigned char* lds, const MlaPtrs& P, int head, int qb, int tid_in, int wave, int lane_in) {
    int tid = tid_in; asm volatile("" : "+v"(tid)); const int lane = tid & 63; (void)lane_in;
    const int r32 = lane & 31, hi = lane >> 5;
    const int q0 = qb * 256, qw = q0 + wave * 32, tq = qw + r32;
    i64 q[12];
    { const unsigned char* qp = (const unsigned char*)P.Q + (size_t)tq * 3072 + head * 192 + hi * 8;
#pragma unroll
      for (int d0 = 0; d0 < 12; ++d0) q[d0] = *(const GAS i64*)(qp + d0 * 16); }
    const int NT = 4 * (qb + 1);
    const int srow = tid >> 3, sc8 = tid & 7;
    const unsigned char* kg = (const unsigned char*)P.K + (size_t)head * 192 + (size_t)srow * 3072 + sc8 * 8;
    const unsigned char* vg = (const unsigned char*)P.V + ((size_t)head * 128 + (tid >> 2)) * S + (tid & 3) * 16;
    LAS unsigned char* kst = lds + srow * KS8 + sc8 * 8;
    LAS unsigned char* vst = lds + 2 * MLA_KB8 + (tid >> 2) * VS8 + (tid & 3) * 16;
    const LAS unsigned char* kl = lds + r32 * KS8 + hi * 8;
    const LAS unsigned char* vl = lds + 2 * MLA_KB8 + r32 * VS8 + hi * 8;
    u32x2 sk0, sk1, sk2; u32x4 sv0;
#define MLA_LOADK(j) do { const unsigned char* kp_ = kg + (size_t)(j) * (64 * 3072); sk0 = *(const GAS u32x2*)(kp_); sk1 = *(const GAS u32x2*)(kp_ + 64); sk2 = *(const GAS u32x2*)(kp_ + 128); } while (0)
#define MLA_LOADV(j) do { sv0 = *(const GAS u32x4*)(vg + (size_t)(j) * 64); } while (0)
#define MLA_STOREK(b) do { LAS unsigned char* kd_ = kst + (b) * MLA_KB8; *(LAS u32x2*)(kd_) = sk0; *(LAS u32x2*)(kd_ + 64) = sk1; *(LAS u32x2*)(kd_ + 128) = sk2; } while (0)
#define MLA_STOREV(b) do { LAS unsigned char* vd_ = vst + (b) * VB8; *(LAS u32x2*)(vd_) = (u32x2){sv0.x, sv0.y}; *(LAS u32x2*)(vd_ + 8) = (u32x2){sv0.z, sv0.w}; } while (0)
    float m = -1e30f, l = 0.f; f32x16 o[4];
#pragma unroll
    for (int d = 0; d < 4; ++d)
#pragma unroll
        for (int r = 0; r < 16; ++r) o[d][r] = 0.f;
    f32x16 pA0, pA1, pB0, pB1;
    MLA_LOADK(0); MLA_LOADV(0); MLA_STOREK(0); MLA_STOREV(0);
    MLA_LOADK(1);
    __syncthreads();
    qk_tile8<12>(pA0, pA1, kl, q);
    if (63 > qw) mla_mask(pA0, pA1, tq - 4 * hi);
    MLA_STOREK(1);
    if (2 < NT) MLA_LOADK(2);
    MLA_LOADV(1);
    __syncthreads();
#define MLA_SGB1() do { __builtin_amdgcn_sched_group_barrier(0x100, 2, 0); __builtin_amdgcn_sched_group_barrier(0x008, 1, 0); __builtin_amdgcn_sched_group_barrier(0x002, 6, 0); \
        __builtin_amdgcn_sched_group_barrier(0x008, 1, 0); __builtin_amdgcn_sched_group_barrier(0x002, 6, 0); } while (0)
#define MLA_SGB() do { MLA_SGB1(); MLA_SGB1(); MLA_SGB1(); MLA_SGB1(); MLA_SGB1(); MLA_SGB1(); MLA_SGB1(); MLA_SGB1(); MLA_SGB1(); MLA_SGB1(); MLA_SGB1(); MLA_SGB1(); } while (0)
#define MLA_STEP(PX0, PX1, PY0, PY1, j) do { \
        const int kb1_ = 64 * ((j) + 1); \
        const bool a1_ = ((j) + 1 < NT) && (kb1_ <= qw + 31), a0_ = (64 * (j) <= qw + 31); \
        float alpha_ = 1.f; i64 pb_[4]; \
        if (a1_) { \
            __builtin_amdgcn_sched_barrier(0); \
            qk_tile8_free<12>(PY0, PY1, kl + (((j) + 1) & 1) * MLA_KB8, q); \
            alpha_ = sm_core_scaled(PX0, PX1, m, l, QS_MLA); \
            pb_[0] = packp8<0>(PX0); pb_[1] = packp8<1>(PX0); pb_[2] = packp8<0>(PX1); pb_[3] = packp8<1>(PX1); \
            MLA_SGB(); \
            __builtin_amdgcn_sched_barrier(0); \
            if (kb1_ + 63 > qw) mla_mask(PY0, PY1, tq - kb1_ - 4 * hi); \
        } else if (a0_) { \
            alpha_ = sm_core_scaled(PX0, PX1, m, l, QS_MLA); \
            pb_[0] = packp8<0>(PX0); pb_[1] = packp8<1>(PX0); pb_[2] = packp8<0>(PX1); pb_[3] = packp8<1>(PX1); \
        } \
        if (a0_) { \
            if (!__all(alpha_ == 1.f)) { _Pragma("unroll") for (int d_ = 0; d_ < 4; ++d_) _Pragma("unroll") for (int r_ = 0; r_ < 16; ++r_) o[d_][r_] *= alpha_; } \
            pv_tile8(o, pb_, vl + ((j) & 1) * VB8); \
        } \
        if ((j) + 2 < NT) MLA_STOREK((j) & 1); \
        if ((j) + 1 < NT) MLA_STOREV(((j) + 1) & 1); \
        if ((j) + 3 < NT) MLA_LOADK((j) + 3); \
        if ((j) + 2 < NT) MLA_LOADV((j) + 2); \
        __syncthreads(); } while (0)
    for (int j = 0; j < NT; j += 2) {
        MLA_STEP(pA0, pA1, pB0, pB1, j);
        MLA_STEP(pB0, pB1, pA0, pA1, j + 1);
    }
#undef MLA_STEP
#undef MLA_SGB
#undef MLA_SGB1
#undef MLA_LOADK
#undef MLA_LOADV
#undef MLA_STOREK
#undef MLA_STOREV
    const float inv = (1.f / 256.f) / l;
    const bf16* zp = P.Z + (size_t)tq * 2048 + head * 128 + 4 * hi;
    bf16* op = P.O + (size_t)tq * 4096 + head * 128 + 4 * hi;
#pragma unroll
    for (int d0 = 0; d0 < 4; ++d0)
#pragma unroll
        for (int rg = 0; rg < 4; ++rg) { const int dim = 32 * d0 + 8 * rg;
            const u32x2 z = *(const GAS u32x2*)(zp + dim);
            u32x2 w; w.x = pk2(o[d0][4 * rg + 0] * inv * bflo(z.x), o[d0][4 * rg + 1] * inv * bfhi(z.x)); w.y = pk2(o[d0][4 * rg + 2] * inv * bflo(z.y), o[d0][4 * rg + 3] * inv * bfhi(z.y));
            *(GAS u32x2*)(op + dim) = w; }
}
#elif defined(MLA_PIPE)
struct MlaPtrs { const bf16* Q; const bf16* K; const bf16* V; const bf16* Z; bf16* O; };
__device__ __forceinline__ void mla_mask(f32x16& p0, f32x16& p1, int dq) {
#pragma unroll
    for (int r = 0; r < 16; ++r) { const int c = (r & 3) + 8 * (r >> 2);
        if (c > dq) p0[r] = -__builtin_inff();
        if (c + 32 > dq) p1[r] = -__builtin_inff(); }
}
__device__ __forceinline__ void mla_unit(LAS unsigned char* lds, const MlaPtrs& P, int head, int qb, int tid_in, int wave, int lane_in) {
    int tid = tid_in; asm volatile("" : "+v"(tid)); const int lane = tid & 63; (void)lane_in;
    const int r32 = lane & 31, hi = lane >> 5;
    const int q0 = qb * 256, qw = q0 + wave * 32, tq = qw + r32;
    bf16x8 q[8];
    LAS unsigned char* ql = lds + MLA_QL + wave * 4096 + lane * 16;
    { const bf16* qp = P.Q + (size_t)tq * 3072 + head * 192 + hi * 8;
#pragma unroll
      for (int d0 = 0; d0 < 8; ++d0) q[d0] = *(const GAS bf16x8*)(qp + d0 * 16);
#pragma unroll
      for (int d0 = 8; d0 < 12; ++d0) *(LAS bf16x8*)(ql + (d0 - 8) * 1024) = *(const GAS bf16x8*)(qp + d0 * 16); }
    const int NT = 4 * (qb + 1);
    const int srow = tid >> 3, sc8 = tid & 7;
    const unsigned char* kg = (const unsigned char*)P.K + (size_t)head * 384 + (size_t)srow * 6144 + sc8 * 16;
    const unsigned char* vg = (const unsigned char*)P.V + (size_t)head * 256 + (size_t)srow * 4096 + sc8 * 16;
    LAS unsigned char* kst = lds + srow * KS_M + sc8 * 16;
    LAS unsigned char* vst = lds + 2 * MLA_KB + srow * VS + sc8 * 16;
    const LAS unsigned char* kl = lds + r32 * KS_M + hi * 16;
    const LAS unsigned char* vl = lds + 2 * MLA_KB + (4 * hi + ((lane & 15) >> 2)) * VS + (16 * ((lane >> 4) & 1) + 4 * (lane & 3)) * 2;
    u32x4 sk0, sk1, sk2, sv0, sv1;
#define MLA_LOADK(j) do { const unsigned char* kp_ = kg + (size_t)(j) * (64 * 6144); sk0 = *(const GAS u32x4*)(kp_); sk1 = *(const GAS u32x4*)(kp_ + 128); sk2 = *(const GAS u32x4*)(kp_ + 256); } while (0)
#define MLA_LOADV(j) do { const unsigned char* vp_ = vg + (size_t)(j) * (64 * 4096); sv0 = *(const GAS u32x4*)(vp_); sv1 = *(const GAS u32x4*)(vp_ + 128); } while (0)
#define MLA_STOREK(b) do { LAS unsigned char* kd_ = kst + (b) * MLA_KB; *(LAS u32x4*)(kd_) = sk0; *(LAS u32x4*)(kd_ + 128) = sk1; *(LAS u32x4*)(kd_ + 256) = sk2; } while (0)
#define MLA_STOREV(b) do { LAS unsigned char* vd_ = vst + (b) * VB; *(LAS u32x4*)(vd_) = sv0; *(LAS u32x4*)(vd_ + 128) = sv1; } while (0)
    float m = -1e30f, l = 0.f; f32x16 o[4];
#pragma unroll
    for (int d = 0; d < 4; ++d)
#pragma unroll
        for (int r = 0; r < 16; ++r) o[d][r] = 0.f;
    f32x16 pA0, pA1, pB0, pB1;
    MLA_LOADK(0); MLA_LOADV(0); MLA_STOREK(0); MLA_STOREV(0);
    MLA_LOADK(1);
    __syncthreads();
    qk_tile_free<12, 8, KS_M>(pA0, pA1, kl, q, ql);
    if (63 > qw) mla_mask(pA0, pA1, tq - 4 * hi);
    MLA_STOREK(1);
    if (2 < NT) MLA_LOADK(2);
    MLA_LOADV(1);
    __syncthreads();
#define MLA_SGB1(NR) do { __builtin_amdgcn_sched_group_barrier(0x100, NR, 0); __builtin_amdgcn_sched_group_barrier(0x008, 1, 0); __builtin_amdgcn_sched_group_barrier(0x002, 6, 0); \
        __builtin_amdgcn_sched_group_barrier(0x008, 1, 0); __builtin_amdgcn_sched_group_barrier(0x002, 6, 0); } while (0)
#define MLA_SGB() do { MLA_SGB1(2); MLA_SGB1(2); MLA_SGB1(2); MLA_SGB1(2); MLA_SGB1(2); MLA_SGB1(2); MLA_SGB1(2); MLA_SGB1(2); MLA_SGB1(3); MLA_SGB1(3); MLA_SGB1(3); MLA_SGB1(3); } while (0)
#define MLA_STEP(PX0, PX1, PY0, PY1, j) do { \
        const int kb1_ = 64 * ((j) + 1); \
        const bool a1_ = ((j) + 1 < NT) && (kb1_ <= qw + 31), a0_ = (64 * (j) <= qw + 31); \
        float alpha_ = 1.f; bf16x8 pb_[4]; \
        if (a1_) { \
            __builtin_amdgcn_sched_barrier(0); \
            qk_tile_free<12, 8, KS_M>(PY0, PY1, kl + (((j) + 1) & 1) * MLA_KB, q, ql); \
            alpha_ = sm_core(PX0, PX1, m, l); \
            pb_[0] = packp<0>(PX0); pb_[1] = packp<1>(PX0); pb_[2] = packp<0>(PX1); pb_[3] = packp<1>(PX1); \
            MLA_SGB(); \
            __builtin_amdgcn_sched_barrier(0); \
            if (kb1_ + 63 > qw) mla_mask(PY0, PY1, tq - kb1_ - 4 * hi); \
        } else if (a0_) { \
            alpha_ = sm_core(PX0, PX1, m, l); \
            pb_[0] = packp<0>(PX0); pb_[1] = packp<1>(PX0); pb_[2] = packp<0>(PX1); pb_[3] = packp<1>(PX1); \
        } \
        if (a0_) { \
            if (!__all(alpha_ == 1.f)) { _Pragma("unroll") for (int d_ = 0; d_ < 4; ++d_) _Pragma("unroll") for (int r_ = 0; r_ < 16; ++r_) o[d_][r_] *= alpha_; } \
            pv_tile(o, pb_, vl + ((j) & 1) * VB); \
        } \
        if ((j) + 2 < NT) MLA_STOREK((j) & 1); \
        if ((j) + 1 < NT) MLA_STOREV(((j) + 1) & 1); \
        if ((j) + 3 < NT) MLA_LOADK((j) + 3); \
        if ((j) + 2 < NT) MLA_LOADV((j) + 2); \
        __syncthreads(); } while (0)
    for (int j = 0; j < NT; j += 2) {
        MLA_STEP(pA0, pA1, pB0, pB1, j);
        MLA_STEP(pB0, pB1, pA0, pA1, j + 1);
    }
#undef MLA_STEP
#undef MLA_SGB
#undef MLA_SGB1
#undef MLA_LOADK
#undef MLA_LOADV
#undef MLA_STOREK
#undef MLA_STOREV
    const float inv = 1.f / l;
    const bf16* zp = P.Z + (size_t)tq * 2048 + head * 128 + 4 * hi;
    bf16* op = P.O + (size_t)tq * 4096 + head * 128 + 4 * hi;
#pragma unroll
    for (int d0 = 0; d0 < 4; ++d0)
#pragma unroll
        for (int rg = 0; rg < 4; ++rg) { const int dim = 32 * d0 + 8 * rg;
            const u32x2 z = *(const GAS u32x2*)(zp + dim);
            u32x2 w; w.x = pk2(o[d0][4 * rg + 0] * inv * bflo(z.x), o[d0][4 * rg + 1] * inv * bfhi(z.x)); w.y = pk2(o[d0][4 * rg + 2] * inv * bflo(z.y), o[d0][4 * rg + 3] * inv * bfhi(z.y));
            *(GAS u32x2*)(op + dim) = w; }
}

#else
#if defined(MLA_MXQ)
struct MlaPtrs { const bf16* Q; const bf16* K; const bf16* V; const bf16* Z; bf16* O; };
constexpr int VBQ = 160 * VSX;
static_assert(2 * MLA_KBX + 2 * VBQ <= 131072, "MLA mxq LDS map");
__device__ __forceinline__ void mla_maskq(f32x16& p0, f32x16& p1, int dq) {
#pragma unroll
    for (int r = 0; r < 16; ++r) { const int c = (r & 3) + 8 * (r >> 2);
        if (c > dq) p0[r] = -__builtin_inff();
        if (c + 32 > dq) p1[r] = -__builtin_inff(); }
}
__device__ __forceinline__ float mla_rowmaxq(const f32x16& p0, const f32x16& p1) {
    float tm = p0[0];
#pragma unroll
    for (int r = 1; r < 16; ++r) tm = fmaxf(tm, p0[r]);
#pragma unroll
    for (int r = 0; r < 16; ++r) tm = fmaxf(tm, p1[r]);
    return swapmax(tm);
}
__device__ __forceinline__ void mla_unit(LAS unsigned char* lds, const MlaPtrs& P, int head, int qb, int tid_in, int wave, int lane_in) {
    int tid = tid_in; asm volatile("" : "+v"(tid)); const int lane = tid & 63; (void)lane_in;
    const int r32 = lane & 31, hi = lane >> 5;
    const int q0 = qb * 256, qw = q0 + wave * 32, tq = qw + r32;
    i32x8 q[3];
    { const unsigned char* qp = (const unsigned char*)P.Q + (size_t)tq * 3072 + head * 192 + hi * 32;
#pragma unroll
      for (int s = 0; s < 3; ++s) { const u32x4 a = *(const GAS u32x4*)(qp + 64 * s), b = *(const GAS u32x4*)(qp + 64 * s + 16);
          q[s] = (i32x8){(int)a.x, (int)a.y, (int)a.z, (int)a.w, (int)b.x, (int)b.y, (int)b.z, (int)b.w}; } }
    const int NT = 4 * (qb + 1);
    const int srow = tid >> 3, sc8 = tid & 7;
    const unsigned char* kg = (const unsigned char*)P.K + (size_t)head * 192 + (size_t)srow * 3072 + sc8 * 8;
    const unsigned char* vg = (const unsigned char*)P.V + ((size_t)head * 128 + (tid >> 2)) * S + (tid & 3) * 16;
    LAS unsigned char* kst = lds + srow * KSX + sc8 * 8;
    LAS unsigned char* vst = lds + 2 * MLA_KBX + (tid >> 2) * VSX + (tid & 3) * 16;
    const LAS unsigned char* kl = lds + r32 * KSX + hi * 32;
    const LAS unsigned char* vl = lds + 2 * MLA_KBX + r32 * VSX + hi * 32;
    u32x2 sk0, sk1, sk2; u32x4 sv0;
#define MLA_LOADK(j) do { const unsigned char* kp_ = kg + (size_t)(j) * (64 * 3072); sk0 = *(const GAS u32x2*)(kp_); sk1 = *(const GAS u32x2*)(kp_ + 64); sk2 = *(const GAS u32x2*)(kp_ + 128); } while (0)
#define MLA_LOADV(j) do { sv0 = *(const GAS u32x4*)(vg + (size_t)(j) * 64); } while (0)
#define MLA_STOREK(b) do { LAS unsigned char* kd_ = kst + (b) * MLA_KBX; *(LAS u32x2*)(kd_) = sk0; *(LAS u32x2*)(kd_ + 64) = sk1; *(LAS u32x2*)(kd_ + 128) = sk2; } while (0)
#define MLA_STOREV(b) do { LAS unsigned char* vd_ = vst + (b) * VBQ; *(LAS u32x2*)(vd_) = (u32x2){sv0.x, sv0.y}; *(LAS u32x2*)(vd_ + 8) = (u32x2){sv0.z, sv0.w}; } while (0)
    f32x16 o[5], mref;
#pragma unroll
    for (int d = 0; d < 5; ++d)
#pragma unroll
        for (int r = 0; r < 16; ++r) o[d][r] = 0.f;
#pragma unroll
    for (int r = 0; r < 16; ++r) mref[r] = MXL_REF;
    f32x16 p0, p1;
    if (tid < 256) { const int slot = tid >> 7, row = (tid >> 2) & 31, ch = tid & 3; const unsigned v1 = (row == 0 || row == 4) ? 0x38383838u : 0u;
        *(LAS u32x4*)(lds + 2 * MLA_KBX + slot * VBQ + (128 + row) * VSX + ch * 16) = (u32x4){v1, v1, v1, v1}; }
    MLA_LOADK(0); MLA_LOADV(0); MLA_STOREK(0); MLA_STOREV(0);
    MLA_LOADK(1);
    __syncthreads();
    qk_tilexl(p0, p1, mref, kl, q);
    if (63 > qw) mla_maskq(p0, p1, tq - 4 * hi);
    { const float dlt = mla_rowmaxq(p0, p1) - MXL_REF;
#pragma unroll
      for (int r = 0; r < 16; ++r) { p0[r] -= dlt; p1[r] -= dlt; mref[r] -= dlt; } }
    i32x8 pbA = byte_packx(p0, p1), pbB = pbA;
    MLA_STOREK(1);
    if (2 < NT) MLA_LOADK(2);
    MLA_LOADV(1);
    __syncthreads();
    asm volatile("" : "+v"(q[0]), "+v"(q[1]), "+v"(q[2]));
    int sc1_ = 0x7f7f7f7f; asm volatile("" : "+v"(sc1_));
#define SB() __builtin_amdgcn_sched_barrier(0)
#define MFMA_T(acc, a, b) asm volatile("s_nop 1\n\tv_mfma_scale_f32_32x32x64_f8f6f4 %0, %1, %2, %0, %3, %3 op_sel_hi:[0,0,0]" : "+v"(acc) : "v"(a), "v"(b), "v"(sc1_))
#define MFMA_C(acc, a, b, c) asm volatile("s_nop 1\n\tv_mfma_scale_f32_32x32x64_f8f6f4 %0, %1, %2, %3, %4, %4 op_sel_hi:[0,0,0]" : "=&v"(acc) : "v"(a), "v"(b), "v"(c), "v"(sc1_))
#define CVT8(P, R0, PB, W0) do { unsigned w_ = __builtin_amdgcn_cvt_pk_u8_f32(P[(R0) + 0], 0, 0u); w_ = __builtin_amdgcn_cvt_pk_u8_f32(P[(R0) + 1], 1, w_); w_ = __builtin_amdgcn_cvt_pk_u8_f32(P[(R0) + 2], 2, w_); \
        w_ = __builtin_amdgcn_cvt_pk_u8_f32(P[(R0) + 3], 3, w_); PB[(W0)] = (int)w_; \
        w_ = __builtin_amdgcn_cvt_pk_u8_f32(P[(R0) + 4], 0, 0u); w_ = __builtin_amdgcn_cvt_pk_u8_f32(P[(R0) + 5], 1, w_); w_ = __builtin_amdgcn_cvt_pk_u8_f32(P[(R0) + 6], 2, w_); \
        w_ = __builtin_amdgcn_cvt_pk_u8_f32(P[(R0) + 7], 3, w_); PB[(W0) + 1] = (int)w_; } while (0)
#define MLA_STEP(PBX, PBY, j) do { \
        const int kb1_ = 64 * ((j) + 1); \
        if (64 * (j) <= qw + 31) { \
            const LAS unsigned char* kn_ = kl + (((j) + 1) & 1) * MLA_KBX; const LAS unsigned char* vj_ = vl + ((j) & 1) * VBQ; \
            SB(); \
            i32x8 a0_f = ldsx(kn_), a1_f = ldsx(kn_ + 32 * KSX); \
            SB(); MFMA_C(p0, a0_f, q[0], mref); SB(); \
            a0_f = ldsx(kn_ + 64); \
            SB(); MFMA_C(p1, a1_f, q[0], mref); SB(); \
            a1_f = ldsx(kn_ + 32 * KSX + 64); \
            SB(); MFMA_T(p0, a0_f, q[1]); SB(); \
            a0_f = ldsx(kn_ + 128); \
            SB(); MFMA_T(p1, a1_f, q[1]); SB(); \
            a1_f = ldsx(kn_ + 32 * KSX + 128); \
            SB(); MFMA_T(p0, a0_f, q[2]); SB(); \
            a0_f = ldsx(vj_ + 128 * VSX); \
            SB(); MFMA_T(p1, a1_f, q[2]); SB(); \
            a1_f = ldsx(vj_); \
            SB(); MFMA_T(o[4], a0_f, PBX); SB(); \
            a0_f = ldsx(vj_ + 32 * VSX); \
            SB(); MFMA_T(o[0], a1_f, PBX); SB(); \
            a1_f = ldsx(vj_ + 64 * VSX); \
            float tmx_ = p0[0]; _Pragma("unroll") for (int r_ = 1; r_ < 16; ++r_) tmx_ = fmaxf(tmx_, p0[r_]); \
            CVT8(p0, 0, PBY, 0); CVT8(p0, 8, PBY, 2); \
            SB(); MFMA_T(o[1], a0_f, PBX); SB(); \
            a0_f = ldsx(vj_ + 96 * VSX); \
            _Pragma("unroll") for (int r_ = 0; r_ < 16; ++r_) tmx_ = fmaxf(tmx_, p1[r_]); \
            CVT8(p1, 0, PBY, 4); \
            SB(); MFMA_T(o[2], a1_f, PBX); SB(); \
            CVT8(p1, 8, PBY, 6); tmx_ = swapmax(tmx_); \
            SB(); MFMA_T(o[3], a0_f, PBX); SB(); \
            const bool diag_ = kb1_ + 63 > qw; \
            if (diag_ || !__all(tmx_ <= MXL_T)) {               \
                asm volatile("s_nop 15\n\ts_nop 15\n\ts_nop 15" ::: "memory");     \
                if (diag_) mla_maskq(p0, p1, tq - kb1_ - 4 * hi); \
                const float dlt_ = fmaxf(mla_rowmaxq(p0, p1) - MXL_REF, 0.f); const float alpha_ = __builtin_amdgcn_exp2f(-0.125f * dlt_); \
                _Pragma("unroll") for (int r_ = 0; r_ < 16; ++r_) { p0[r_] -= dlt_; p1[r_] -= dlt_; mref[r_] -= dlt_; } \
                _Pragma("unroll") for (int d_ = 0; d_ < 5; ++d_) _Pragma("unroll") for (int r_ = 0; r_ < 16; ++r_) o[d_][r_] *= alpha_; \
                PBY = byte_packx(p0, p1); } \
        } \
        if ((j) + 2 < NT) MLA_STOREK((j) & 1); \
        if ((j) + 1 < NT) MLA_STOREV(((j) + 1) & 1); \
        if ((j) + 3 < NT) MLA_LOADK((j) + 3); \
        if ((j) + 2 < NT) MLA_LOADV((j) + 2); \
        __syncthreads(); } while (0)
    for (int j = 0; j < NT; j += 2) {
        MLA_STEP(pbA, pbB, j);
        MLA_STEP(pbB, pbA, j + 1);
    }
    asm volatile("s_nop 15\n\ts_nop 15" ::: "memory");
#undef MLA_STEP
#undef CVT8
#undef MFMA_T
#undef MFMA_C
#undef SB
#undef MLA_LOADK
#undef MLA_LOADV
#undef MLA_STOREK
#undef MLA_STOREV
    const float inv = 1.f / o[4][0];
    const bf16* zp = P.Z + (size_t)tq * 2048 + head * 128 + 4 * hi;
    bf16* op = P.O + (size_t)tq * 4096 + head * 128 + 4 * hi;
#pragma unroll
    for (int d0 = 0; d0 < 4; ++d0)
#pragma unroll
        for (int rg = 0; rg < 4; ++rg) { const int dim = 32 * d0 + 8 * rg;
            const u32x2 z = *(const GAS u32x2*)(zp + dim);
            u32x2 w; w.x = pk2(o[d0][4 * rg + 0] * inv * bflo(z.x), o[d0][4 * rg + 1] * inv * bfhi(z.x)); w.y = pk2(o[d0][4 * rg + 2] * inv * bflo(z.y), o[d0][4 * rg + 3] * inv * bfhi(z.y));
            *(GAS u32x2*)(op + dim) = w; }
}

#elif defined(MLA_BIGX)
struct MlaPtrs { const bf16* Q; const bf16* K; const bf16* V; const bf16* Z; bf16* O; };
__device__ __forceinline__ void mla_unit(LAS unsigned char* lds, const MlaPtrs& P, int head, int qb, int tid_in, int wave, int lane_in) {
    int tid = tid_in; asm volatile("" : "+v"(tid)); const int lane = tid & 63; (void)lane_in;
    const int r32 = lane & 31, hi = lane >> 5;
    const int q0 = qb * 256, qw = q0 + wave * 32, tq = qw + r32;
    i32x8 q[3];
    { const unsigned char* qp = (const unsigned char*)P.Q + (size_t)tq * 3072 + head * 192 + hi * 32;
#pragma unroll
      for (int s = 0; s < 3; ++s) { const u32x4 a = *(const GAS u32x4*)(qp + 64 * s), b = *(const GAS u32x4*)(qp + 64 * s + 16);
          q[s] = (i32x8){(int)a.x, (int)a.y, (int)a.z, (int)a.w, (int)b.x, (int)b.y, (int)b.z, (int)b.w}; } }
    const int NT = 4 * (qb + 1), NTB = NT / 2;
    constexpr int VSB = 144, VBB = 128 * VSB, KBB = 128 * KSX;
    static_assert(2 * KBB + 3 * VBB <= 131072, "MLA big-tile LDS map");
    const int srow = tid >> 3, sc8 = tid & 7;
    const unsigned char* kg = (const unsigned char*)P.K + (size_t)head * 192 + (size_t)srow * 3072 + sc8 * 8;
    const unsigned char* vg = (const unsigned char*)P.V + ((size_t)head * 128 + (tid >> 2)) * S + (tid & 3) * 32;
    LAS unsigned char* kst = lds + srow * KSX + sc8 * 8;
    LAS unsigned char* vst = lds + 2 * KBB + (tid >> 2) * VSB + (tid & 3) * 32;
    const LAS unsigned char* kl = lds + r32 * KSX + hi * 32;
    const LAS unsigned char* vl = lds + 2 * KBB + r32 * VSB + hi * 32;
    u32x2 sk0, sk1, sk2, sk3, sk4, sk5; u32x4 sv0, sv1;
#define MLA_LOAD(J) do { const unsigned char* kp_ = kg + (size_t)(J) * (128 * 3072); const unsigned char* vp_ = vg + (size_t)(J) * 128; \
        sk0 = *(const GAS u32x2*)(kp_); sk1 = *(const GAS u32x2*)(kp_ + 64); sk2 = *(const GAS u32x2*)(kp_ + 128); \
        sk3 = *(const GAS u32x2*)(kp_ + 64 * 3072); sk4 = *(const GAS u32x2*)(kp_ + 64 * 3072 + 64); sk5 = *(const GAS u32x2*)(kp_ + 64 * 3072 + 128); \
        sv0 = *(const GAS u32x4*)(vp_); sv1 = *(const GAS u32x4*)(vp_ + 16); } while (0)
#define MLA_STORE(b, vb) do { LAS unsigned char* kd_ = kst + (b) * KBB; LAS unsigned char* vd_ = vst + (vb) * VBB; \
        *(LAS u32x2*)(kd_) = sk0; *(LAS u32x2*)(kd_ + 64) = sk1; *(LAS u32x2*)(kd_ + 128) = sk2; \
        *(LAS u32x2*)(kd_ + 64 * KSX) = sk3; *(LAS u32x2*)(kd_ + 64 * KSX + 64) = sk4; *(LAS u32x2*)(kd_ + 64 * KSX + 128) = sk5; \
        *(LAS u32x2*)(vd_) = (u32x2){sv0.x, sv0.y}; *(LAS u32x2*)(vd_ + 8) = (u32x2){sv0.z, sv0.w}; *(LAS u32x2*)(vd_ + 16) = (u32x2){sv1.x, sv1.y}; *(LAS u32x2*)(vd_ + 24) = (u32x2){sv1.z, sv1.w}; } while (0)
    MLA_LOAD(0); MLA_STORE(0, 0);
    __syncthreads();
    asm volatile("" : "+v"(q[0]), "+v"(q[1]), "+v"(q[2]));
    f32x16 o[5], mref;
#pragma unroll
    for (int d = 0; d < 5; ++d)
#pragma unroll
        for (int r = 0; r < 16; ++r) o[d][r] = 0.f;
#pragma unroll
    for (int r = 0; r < 16; ++r) mref[r] = MXL_REF;
    const int one8 = (r32 == 0 || r32 == 4) ? 0x38383838 : 0;
    const i32x8 ones = {one8, one8, one8, one8, one8, one8, one8, one8};
    const bool trail = wave >= 4;
    i32x8 pb = {};
    int vb_cur = 0, vb_prev = 2;
    for (int J = 0; J < NTB; ++J) {
        int vb_next = vb_cur + 1; if (vb_next == 3) vb_next = 0;
        if (J + 1 < NTB) MLA_LOAD(J + 1);
#pragma unroll
        for (int sub = 0; sub < 2; ++sub) {
        const int j = 2 * J + sub, kb = 64 * j;
        if (trail && j > 0 && kb - 64 <= qw + 31) pv_tilexl<VSB>(o, pb, ones, vl + (sub == 0 ? vb_prev * VBB + 64 : vb_cur * VBB));
        if (kb <= qw + 31) {
            f32x16 p0, p1;
            qk_tilexl(p0, p1, mref, kl + (J & 1) * KBB + sub * 64 * KSX, q);
            if (kb + 63 > qw) {
                const int dq = tq - kb - 4 * hi;
#pragma unroll
                for (int r = 0; r < 16; ++r) { const int c = (r & 3) + 8 * (r >> 2);
                    if (c > dq) p0[r] = -__builtin_inff();
                    if (c + 32 > dq) p1[r] = -__builtin_inff(); }
            }
            float tm = p0[0];
#pragma unroll
            for (int r = 1; r < 16; ++r) tm = fmaxf(tm, p0[r]);
#pragma unroll
            for (int r = 0; r < 16; ++r) tm = fmaxf(tm, p1[r]);
            tm = swapmax(tm);
            if (j == 0 || !__all(tm <= MXL_T)) {
                const float dlt = (j == 0) ? tm - MXL_REF : fmaxf(tm - MXL_REF, 0.f);
                const float alpha = __builtin_amdgcn_exp2f(-0.125f * dlt);
#pragma unroll
                for (int r = 0; r < 16; ++r) { p0[r] -= dlt; p1[r] -= dlt; mref[r] -= dlt; }
                if (j > 0) {
#pragma unroll
                    for (int d = 0; d < 5; ++d)
#pragma unroll
                        for (int r = 0; r < 16; ++r) o[d][r] *= alpha;
                }
            }
            pb = byte_packx(p0, p1);
            if (!trail) pv_tilexl<VSB>(o, pb, ones, vl + vb_cur * VBB + sub * 64);
        }
        }
        if (J + 1 < NTB) MLA_STORE((J + 1) & 1, vb_next);
        __syncthreads();
        vb_prev = vb_cur; vb_cur = vb_next;
    }
    if (trail && 64 * (NT - 1) <= qw + 31) pv_tilexl<VSB>(o, pb, ones, vl + vb_prev * VBB + 64);
    __syncthreads();
#undef MLA_LOAD
#undef MLA_STORE
    const float inv = 1.f / o[4][0];
    const bf16* zp = P.Z + (size_t)tq * 2048 + head * 128 + 4 * hi;
    bf16* op = P.O + (size_t)tq * 4096 + head * 128 + 4 * hi;
#pragma unroll
    for (int d0 = 0; d0 < 4; ++d0)
#pragma unroll
        for (int rg = 0; rg < 4; ++rg) { const int dim = 32 * d0 + 8 * rg;
            const u32x2 z = *(const GAS u32x2*)(zp + dim);
            u32x2 w; w.x = pk2(o[d0][4 * rg + 0] * inv * bflo(z.x), o[d0][4 * rg + 1] * inv * bfhi(z.x)); w.y = pk2(o[d0][4 * rg + 2] * inv * bflo(z.y), o[d0][4 * rg + 3] * inv * bfhi(z.y));
            *(GAS u32x2*)(op + dim) = w; }
}

#elif defined(MLA_MXL)
struct MlaPtrs { const bf16* Q; const bf16* K; const bf16* V; const bf16* Z; bf16* O; };
__device__ __forceinline__ void mla_unit(LAS unsigned char* lds, const MlaPtrs& P, int head, int qb, int tid_in, int wave, int lane_in) {
    int tid = tid_in; asm volatile("" : "+v"(tid)); const int lane = tid & 63; (void)lane_in;
    const int r32 = lane & 31, hi = lane >> 5;
    const int q0 = qb * 256, qw = q0 + wave * 32, tq = qw + r32;
    i32x8 q[3];
    { const unsigned char* qp = (const unsigned char*)P.Q + (size_t)tq * 3072 + head * 192 + hi * 32;
#pragma unroll
      for (int s = 0; s < 3; ++s) { const u32x4 a = *(const GAS u32x4*)(qp + 64 * s), b = *(const GAS u32x4*)(qp + 64 * s + 16);
          q[s] = (i32x8){(int)a.x, (int)a.y, (int)a.z, (int)a.w, (int)b.x, (int)b.y, (int)b.z, (int)b.w}; } }
    const int NT = 4 * (qb + 1);
    const int srow = tid >> 3, sc8 = tid & 7;
    const unsigned char* kg = (const unsigned char*)P.K + (size_t)head * 192 + (size_t)srow * 3072 + sc8 * 8;
    const unsigned char* vg = (const unsigned char*)P.V + ((size_t)head * 128 + (tid >> 2)) * S + (tid & 3) * 16;
    LAS unsigned char* kst = lds + srow * KSX + sc8 * 8;
    LAS unsigned char* vst = lds + 2 * MLA_KBX + (tid >> 2) * VSX + (tid & 3) * 16;
    const LAS unsigned char* kl = lds + r32 * KSX + hi * 32;
    const LAS unsigned char* vl = lds + 2 * MLA_KBX + r32 * VSX + hi * 32;
    u32x2 sk0, sk1, sk2; u32x4 sv0;
#define MLA_LOAD(j) do { const unsigned char* kp_ = kg + (size_t)(j) * (64 * 3072); const unsigned char* vp_ = vg + (size_t)(j) * 64; \
        sk0 = *(const GAS u32x2*)(kp_); sk1 = *(const GAS u32x2*)(kp_ + 64); sk2 = *(const GAS u32x2*)(kp_ + 128); sv0 = *(const GAS u32x4*)(vp_); } while (0)
#define MLA_STORE(b, vb) do { LAS unsigned char* kd_ = kst + (b) * MLA_KBX; LAS unsigned char* vd_ = vst + (vb) * VBX; \
        *(LAS u32x2*)(kd_) = sk0; *(LAS u32x2*)(kd_ + 64) = sk1; *(LAS u32x2*)(kd_ + 128) = sk2; *(LAS u32x2*)(vd_) = (u32x2){sv0.x, sv0.y}; *(LAS u32x2*)(vd_ + 8) = (u32x2){sv0.z, sv0.w}; } while (0)
    MLA_LOAD(0); MLA_STORE(0, 0);
    __syncthreads();
    asm volatile("" : "+v"(q[0]), "+v"(q[1]), "+v"(q[2]));
    f32x16 o[5], mref;
#pragma unroll
    for (int d = 0; d < 5; ++d)
#pragma unroll
        for (int r = 0; r < 16; ++r) o[d][r] = 0.f;
#pragma unroll
    for (int r = 0; r < 16; ++r) mref[r] = MXL_REF;
    const int one8 = (r32 == 0 || r32 == 4) ? 0x38383838 : 0;
    const i32x8 ones = {one8, one8, one8, one8, one8, one8, one8, one8};
    const bool trail = wave >= 4;
    i32x8 pb = {};
    int vb_cur = 0, vb_prev = 2;
    for (int j = 0; j < NT; ++j) {
        const int kb = 64 * j;
        int vb_next = vb_cur + 1; if (vb_next == 3) vb_next = 0;
        if (j + 1 < NT) MLA_LOAD(j + 1);
        if (trail && j > 0 && kb - 64 <= qw + 31) pv_tilexl(o, pb, ones, vl + vb_prev * VBX);
        if (kb <= qw + 31) {
            f32x16 p0, p1;
            qk_tilexl(p0, p1, mref, kl + (j & 1) * MLA_KBX, q);
            if (kb + 63 > qw) {
                const int dq = tq - kb - 4 * hi;
#pragma unroll
                for (int r = 0; r < 16; ++r) { const int c = (r & 3) + 8 * (r >> 2);
                    if (c > dq) p0[r] = -__builtin_inff();
                    if (c + 32 > dq) p1[r] = -__builtin_inff(); }
            }
            float tm = p0[0];
#pragma unroll
            for (int r = 1; r < 16; ++r) tm = fmaxf(tm, p0[r]);
#pragma unroll
            for (int r = 0; r < 16; ++r) tm = fmaxf(tm, p1[r]);
            tm = swapmax(tm);
            if (j == 0 || !__all(tm <= MXL_T)) {
#ifdef MLA_MXU
                const float dlt = (j == 0) ? tm - MXL_REF : fmaxf(tm - MXL_REF, 0.f);
                const float alpha = __builtin_amdgcn_exp2f(-0.125f * dlt);
#else
                const float dlt = (j == 0) ? tm : fmaxf(tm, 0.f);
                const float alpha = __builtin_amdgcn_exp2f(-dlt);
#endif
#pragma unroll
                for (int r = 0; r < 16; ++r) { p0[r] -= dlt; p1[r] -= dlt; mref[r] -= dlt; }
                if (j > 0) {
#pragma unroll
                    for (int d = 0; d < 5; ++d)
#pragma unroll
                        for (int r = 0; r < 16; ++r) o[d][r] *= alpha;
                }
            }
#ifdef MLA_MXU
            pb = byte_packx(p0, p1);
#else
            pb = exp_packx(p0, p1, one8);
#endif
            if (!trail) pv_tilexl(o, pb, ones, vl + vb_cur * VBX);
        }
        if (j + 1 < NT) MLA_STORE((j + 1) & 1, vb_next);
        __syncthreads();
        vb_prev = vb_cur; vb_cur = vb_next;
    }
    if (trail && 64 * (NT - 1) <= qw + 31) pv_tilexl(o, pb, ones, vl + vb_prev * VBX);
    __syncthreads();
#undef MLA_LOAD
#undef MLA_STORE
    const float inv = 1.f / o[4][0];
    const bf16* zp = P.Z + (size_t)tq * 2048 + head * 128 + 4 * hi;
    bf16* op = P.O + (size_t)tq * 4096 + head * 128 + 4 * hi;
#pragma unroll
    for (int d0 = 0; d0 < 4; ++d0)
#pragma unroll
        for (int rg = 0; rg < 4; ++rg) { const int dim = 32 * d0 + 8 * rg;
            const u32x2 z = *(const GAS u32x2*)(zp + dim);
            u32x2 w; w.x = pk2(o[d0][4 * rg + 0] * inv * bflo(z.x), o[d0][4 * rg + 1] * inv * bfhi(z.x)); w.y = pk2(o[d0][4 * rg + 2] * inv * bflo(z.y), o[d0][4 * rg + 3] * inv * bfhi(z.y));
            *(GAS u32x2*)(op + dim) = w; }
}

#elif defined(MLA_MXP)
struct MlaPtrs { const bf16* Q; const bf16* K; const bf16* V; const bf16* Z; bf16* O; };
__device__ __forceinline__ void mla_maskx(f32x16& p0, f32x16& p1, int dq) {
#pragma unroll
    for (int r = 0; r < 16; ++r) { const int c = (r & 3) + 8 * (r >> 2);
        if (c > dq) p0[r] = -__builtin_inff();
        if (c + 32 > dq) p1[r] = -__builtin_inff(); }
}
__device__ __forceinline__ float mla_rowmax(const f32x16& p0, const f32x16& p1) {
    float tm = p0[0];
#pragma unroll
    for (int r = 1; r < 16; ++r) tm = fmaxf(tm, p0[r]);
#pragma unroll
    for (int r = 0; r < 16; ++r) tm = fmaxf(tm, p1[r]);
    return swapmax(tm);
}
#define MXP_EXP8(P, R0) do { _Pragma("unroll") for (int r_ = (R0); r_ < (R0) + 8; ++r_) { P[r_] = __builtin_amdgcn_exp2f(__builtin_fmaf(P[r_], QS_MLA, mc_)); ps_ += P[r_]; } } while (0)
__device__ __forceinline__ void mla_unit(LAS unsigned char* lds, const MlaPtrs& P, int head, int qb, int tid_in, int wave, int lane_in) {
    int tid = tid_in; asm volatile("" : "+v"(tid)); const int lane = tid & 63; (void)lane_in;
    const int r32 = lane & 31, hi = lane >> 5;
    const int q0 = qb * 256, qw = q0 + wave * 32, tq = qw + r32;
    i32x8 q[3];
    { const unsigned char* qp = (const unsigned char*)P.Q + (size_t)tq * 3072 + head * 192 + hi * 32;
#pragma unroll
      for (int s = 0; s < 3; ++s) { const u32x4 a = *(const GAS u32x4*)(qp + 64 * s), b = *(const GAS u32x4*)(qp + 64 * s + 16);
          q[s] = (i32x8){(int)a.x, (int)a.y, (int)a.z, (int)a.w, (int)b.x, (int)b.y, (int)b.z, (int)b.w}; } }
    const int NT = 4 * (qb + 1);
    const int srow = tid >> 3, sc8 = tid & 7;
    const unsigned char* kg = (const unsigned char*)P.K + (size_t)head * 192 + (size_t)srow * 3072 + sc8 * 8;
    const unsigned char* vg = (const unsigned char*)P.V + ((size_t)head * 128 + (tid >> 2)) * S + (tid & 3) * 16;
    LAS unsigned char* kst = lds + srow * KSX + sc8 * 8;
    LAS unsigned char* vst = lds + 2 * MLA_KBX + (tid >> 2) * VSX + (tid & 3) * 16;
    const LAS unsigned char* kl = lds + r32 * KSX + hi * 32;
    const LAS unsigned char* vl = lds + 2 * MLA_KBX + r32 * VSX + hi * 32;
    u32x2 sk0, sk1, sk2; u32x4 sv0;
#define MLA_LOADK(j) do { const unsigned char* kp_ = kg + (size_t)(j) * (64 * 3072); sk0 = *(const GAS u32x2*)(kp_); sk1 = *(const GAS u32x2*)(kp_ + 64); sk2 = *(const GAS u32x2*)(kp_ + 128); } while (0)
#define MLA_LOADV(j) do { sv0 = *(const GAS u32x4*)(vg + (size_t)(j) * 64); } while (0)
#define MLA_STOREK(b) do { LAS unsigned char* kd_ = kst + (b) * MLA_KBX; *(LAS u32x2*)(kd_) = sk0; *(LAS u32x2*)(kd_ + 64) = sk1; *(LAS u32x2*)(kd_ + 128) = sk2; } while (0)
#define MLA_STOREV(b) do { LAS unsigned char* vd_ = vst + (b) * VBX; *(LAS u32x2*)(vd_) = (u32x2){sv0.x, sv0.y}; *(LAS u32x2*)(vd_ + 8) = (u32x2){sv0.z, sv0.w}; } while (0)
    float m = -1e30f, l = 0.f; f32x16 o[4];
#pragma unroll
    for (int d = 0; d < 4; ++d)
#pragma unroll
        for (int r = 0; r < 16; ++r) o[d][r] = 0.f;
    f32x16 pA0, pA1, pB0, pB1;
    MLA_LOADK(0); MLA_LOADV(0); MLA_STOREK(0); MLA_STOREV(0);
    MLA_LOADK(1);
    __syncthreads();
    qk_tilex(pA0, pA1, kl, q);
    if (63 > qw) mla_maskx(pA0, pA1, tq - 4 * hi);
    MLA_STOREK(1);
    if (2 < NT) MLA_LOADK(2);
    MLA_LOADV(1);
    __syncthreads();
    asm volatile("" : "+v"(q[0]), "+v"(q[1]), "+v"(q[2]));
    float tmx = mla_rowmax(pA0, pA1);
#define SB() __builtin_amdgcn_sched_barrier(0)
#define MLA_SMHEAD() const float mn_ = fmaxf(m, tmx); const float alpha_ = __builtin_amdgcn_exp2f((m - mn_) * QS_MLA); m = mn_; const float mc_ = 8.f - mn_ * QS_MLA; float ps_ = 0.f; i32x8 pb_; \
            if (!__all(alpha_ == 1.f)) { _Pragma("unroll") for (int d_ = 0; d_ < 4; ++d_) _Pragma("unroll") for (int r_ = 0; r_ < 16; ++r_) o[d_][r_] *= alpha_; }
#define MXP_EXPK(P, R0, W0) do { MXP_EXP8(P, R0); \
        int w_ = __builtin_amdgcn_cvt_pk_fp8_f32(P[(R0) + 0], P[(R0) + 1], 0, false); pb_[(W0)] = __builtin_amdgcn_cvt_pk_fp8_f32(P[(R0) + 2], P[(R0) + 3], w_, true); \
        w_ = __builtin_amdgcn_cvt_pk_fp8_f32(P[(R0) + 4], P[(R0) + 5], 0, false); pb_[(W0) + 1] = __builtin_amdgcn_cvt_pk_fp8_f32(P[(R0) + 6], P[(R0) + 7], w_, true); } while (0)
#define MLA_SMTAIL() ps_ = swapsum(ps_); l = l * alpha_ + ps_
#define MFMA_T(acc, a, b) asm volatile("s_nop 1\n\tv_mfma_scale_f32_32x32x64_f8f6f4 %0, %1, %2, %0, %3, %3 op_sel_hi:[0,0,0]" : "+v"(acc) : "v"(a), "v"(b), "v"(sc1_))
#define MFMA_Z(acc, a, b) asm volatile("s_nop 1\n\tv_mfma_scale_f32_32x32x64_f8f6f4 %0, %1, %2, 0, %3, %3 op_sel_hi:[0,0,0]" : "=&v"(acc) : "v"(a), "v"(b), "v"(sc1_))
#define MLA_STEP(PX0, PX1, PY0, PY1, j) do { \
        const int kb1_ = 64 * ((j) + 1); \
        const bool a0_ = (64 * (j) <= qw + 31); \
        const LAS unsigned char* vj_ = vl + ((j) & 1) * VBX; \
        if (a0_) {                  \
            const LAS unsigned char* kn_ = kl + (((j) + 1) & 1) * MLA_KBX; \
            MLA_SMHEAD() \
            SB(); \
            i32x8 a0_f = ldsx(kn_), a1_f = ldsx(kn_ + 64); \
            MXP_EXPK(PX0, 0, 0); MXP_EXPK(PX0, 8, 2); \
            SB(); MFMA_Z(PY0, a0_f, q[0]); SB(); \
            a0_f = ldsx(kn_ + 128); \
            MXP_EXPK(PX1, 0, 4); \
            SB(); MFMA_T(PY0, a1_f, q[1]); SB(); \
            a1_f = ldsx(kn_ + 32 * KSX); \
            MXP_EXPK(PX1, 8, 6); \
            SB(); MFMA_T(PY0, a0_f, q[2]); SB(); \
            a0_f = ldsx(kn_ + 32 * KSX + 64); \
            MLA_SMTAIL(); \
            SB(); MFMA_Z(PY1, a1_f, q[0]); SB(); \
            a1_f = ldsx(vj_); \
            SB(); MFMA_T(PY1, a0_f, q[1]); SB(); \
            a0_f = ldsx(kn_ + 32 * KSX + 128); \
            SB(); MFMA_T(o[0], a1_f, pb_); SB(); \
            a1_f = ldsx(vj_ + 32 * VSX); \
            SB(); MFMA_T(PY1, a0_f, q[2]); SB(); \
            a0_f = ldsx(vj_ + 64 * VSX); \
            SB(); MFMA_T(o[1], a1_f, pb_); SB(); \
            a1_f = ldsx(vj_ + 96 * VSX); \
            SB(); MFMA_T(o[2], a0_f, pb_); SB(); \
            SB(); MFMA_T(o[3], a1_f, pb_); SB(); \
            if (kb1_ + 63 > qw) mla_maskx(PY0, PY1, tq - kb1_ - 4 * hi); \
            tmx = mla_rowmax(PY0, PY1); \
        } \
        if ((j) + 2 < NT) MLA_STOREK((j) & 1); \
        if ((j) + 1 < NT) MLA_STOREV(((j) + 1) & 1); \
        if ((j) + 3 < NT) MLA_LOADK((j) + 3); \
        if ((j) + 2 < NT) MLA_LOADV((j) + 2); \
        __syncthreads(); } while (0)
    int sc1_ = 0x7f7f7f7f; asm volatile("" : "+v"(sc1_));
    for (int j = 0; j < NT; j += 2) {
        MLA_STEP(pA0, pA1, pB0, pB1, j);
        MLA_STEP(pB0, pB1, pA0, pA1, j + 1);
    }
    asm volatile("s_nop 15\n\ts_nop 15" ::: "memory");
#undef MLA_STEP
#undef MLA_SMHEAD
#undef MLA_SMTAIL
#undef MXP_EXPK
#undef MFMA_T
#undef MFMA_Z
#undef SB
#undef MLA_LOADK
#undef MLA_LOADV
#undef MLA_STOREK
#undef MLA_STOREV
    const float inv = 1.f / l;
    const bf16* zp = P.Z + (size_t)tq * 2048 + head * 128 + 4 * hi;
    bf16* op = P.O + (size_t)tq * 4096 + head * 128 + 4 * hi;
#pragma unroll
    for (int d0 = 0; d0 < 4; ++d0)
#pragma unroll
        for (int rg = 0; rg < 4; ++rg) { const int dim = 32 * d0 + 8 * rg;
            const u32x2 z = *(const GAS u32x2*)(zp + dim);
            u32x2 w; w.x = pk2(o[d0][4 * rg + 0] * inv * bflo(z.x), o[d0][4 * rg + 1] * inv * bfhi(z.x)); w.y = pk2(o[d0][4 * rg + 2] * inv * bflo(z.y), o[d0][4 * rg + 3] * inv * bfhi(z.y));
            *(GAS u32x2*)(op + dim) = w; }
}
#undef MXP_EXP8

#elif defined(MLA_MX)
struct MlaPtrs { const bf16* Q; const bf16* K; const bf16* V; const bf16* Z; bf16* O; };
__device__ __forceinline__ void mla_unit(LAS unsigned char* lds, const MlaPtrs& P, int head, int qb, int tid_in, int wave, int lane_in) {
    int tid = tid_in; asm volatile("" : "+v"(tid)); const int lane = tid & 63; (void)lane_in;
    const int r32 = lane & 31, hi = lane >> 5;
    const int q0 = qb * 256, qw = q0 + wave * 32, tq = qw + r32;
    i32x8 q[3];
    { const unsigned char* qp = (const unsigned char*)P.Q + (size_t)tq * 3072 + head * 192 + hi * 32;
#pragma unroll
      for (int s = 0; s < 3; ++s) { const u32x4 a = *(const GAS u32x4*)(qp + 64 * s), b = *(const GAS u32x4*)(qp + 64 * s + 16);
          q[s] = (i32x8){(int)a.x, (int)a.y, (int)a.z, (int)a.w, (int)b.x, (int)b.y, (int)b.z, (int)b.w}; } }
    const int NT = 4 * (qb + 1);
    const int srow = tid >> 3, sc8 = tid & 7;
    const unsigned char* kg = (const unsigned char*)P.K + (size_t)head * 192 + (size_t)srow * 3072 + sc8 * 8;
    const unsigned char* vg = (const unsigned char*)P.V + ((size_t)head * 128 + (tid >> 2)) * S + (tid & 3) * 16;
    LAS unsigned char* kst = lds + srow * KSX + sc8 * 8;
    LAS unsigned char* vst = lds + 2 * MLA_KBX + (tid >> 2) * VSX + (tid & 3) * 16;
    const LAS unsigned char* kl = lds + r32 * KSX + hi * 32;
    const LAS unsigned char* vl = lds + 2 * MLA_KBX + r32 * VSX + hi * 32;
    u32x2 sk0, sk1, sk2; u32x4 sv0;
#define MLA_LOAD(j) do { const unsigned char* kp_ = kg + (size_t)(j) * (64 * 3072); const unsigned char* vp_ = vg + (size_t)(j) * 64; \
        sk0 = *(const GAS u32x2*)(kp_); sk1 = *(const GAS u32x2*)(kp_ + 64); sk2 = *(const GAS u32x2*)(kp_ + 128); sv0 = *(const GAS u32x4*)(vp_); } while (0)
#define MLA_STORE(b, vb) do { LAS unsigned char* kd_ = kst + (b) * MLA_KBX; LAS unsigned char* vd_ = vst + (vb) * VBX; \
        *(LAS u32x2*)(kd_) = sk0; *(LAS u32x2*)(kd_ + 64) = sk1; *(LAS u32x2*)(kd_ + 128) = sk2; *(LAS u32x2*)(vd_) = (u32x2){sv0.x, sv0.y}; *(LAS u32x2*)(vd_ + 8) = (u32x2){sv0.z, sv0.w}; } while (0)
    MLA_LOAD(0); MLA_STORE(0, 0);
    __syncthreads();
    asm volatile("" : "+v"(q[0]), "+v"(q[1]), "+v"(q[2]));
    float m = -1e30f, l = 0.f; f32x16 o[4];
#pragma unroll
    for (int d = 0; d < 4; ++d)
#pragma unroll
        for (int r = 0; r < 16; ++r) o[d][r] = 0.f;
    const bool trail = wave >= 4;
    i32x8 pb = {};
    int vb_cur = 0, vb_prev = 2;
    for (int j = 0; j < NT; ++j) {
        const int kb = 64 * j;
        int vb_next = vb_cur + 1; if (vb_next == 3) vb_next = 0;
        if (j + 1 < NT) MLA_LOAD(j + 1);
        if (trail && j > 0 && kb - 64 <= qw + 31) pv_tilex(o, pb, vl + vb_prev * VBX);
        if (kb <= qw + 31) {
            f32x16 p0, p1;
            qk_tilex(p0, p1, kl + (j & 1) * MLA_KBX, q);
            if (kb + 63 > qw) {
                const int dq = tq - kb - 4 * hi;
#pragma unroll
                for (int r = 0; r < 16; ++r) { const int c = (r & 3) + 8 * (r >> 2);
                    if (c > dq) p0[r] = -__builtin_inff();
                    if (c + 32 > dq) p1[r] = -__builtin_inff(); }
            }
            online_sm_x(p0, p1, m, l, o, QS_MLA);
            pb = packpx(p0, p1);
            if (!trail) pv_tilex(o, pb, vl + vb_cur * VBX);
        }
        if (j + 1 < NT) MLA_STORE((j + 1) & 1, vb_next);
        __syncthreads();
        vb_prev = vb_cur; vb_cur = vb_next;
    }
    if (trail && 64 * (NT - 1) <= qw + 31) pv_tilex(o, pb, vl + vb_prev * VBX);
    __syncthreads();
#undef MLA_LOAD
#undef MLA_STORE
    const float inv = 1.f / l;
    const bf16* zp = P.Z + (size_t)tq * 2048 + head * 128 + 4 * hi;
    bf16* op = P.O + (size_t)tq * 4096 + head * 128 + 4 * hi;
#pragma unroll
    for (int d0 = 0; d0 < 4; ++d0)
#pragma unroll
        for (int rg = 0; rg < 4; ++rg) { const int dim = 32 * d0 + 8 * rg;
            const u32x2 z = *(const GAS u32x2*)(zp + dim);
            u32x2 w; w.x = pk2(o[d0][4 * rg + 0] * inv * bflo(z.x), o[d0][4 * rg + 1] * inv * bfhi(z.x)); w.y = pk2(o[d0][4 * rg + 2] * inv * bflo(z.y), o[d0][4 * rg + 3] * inv * bfhi(z.y));
            *(GAS u32x2*)(op + dim) = w; }
}

#elif defined(MLA_BIG)
struct MlaPtrs { const bf16* Q; const bf16* K; const bf16* V; const bf16* Z; bf16* O; };
__device__ __forceinline__ void mla_unit(LAS unsigned char* lds, const MlaPtrs& P, int head, int qb, int tid_in, int wave, int lane_in) {
    int tid = tid_in; asm volatile("" : "+v"(tid)); const int lane = tid & 63; (void)lane_in;
    const int r32 = lane & 31, hi = lane >> 5;
    const int q0 = qb * 256, qw = q0 + wave * 32, tq = qw + r32;
    i64 q[12];
    { const unsigned char* qp = (const unsigned char*)P.Q + (size_t)tq * 3072 + head * 192 + hi * 8;
#pragma unroll
      for (int d0 = 0; d0 < 12; ++d0) q[d0] = *(const GAS i64*)(qp + d0 * 16); }
    const int NT = 4 * (qb + 1), NTB = NT / 2;
    const int srow = tid >> 3, sc8 = tid & 7;
    const unsigned char* kg = (const unsigned char*)P.K + (size_t)head * 192 + (size_t)srow * 3072 + sc8 * 8;
    const unsigned char* vg = (const unsigned char*)P.V + ((size_t)head * 128 + (tid >> 2)) * S + (tid & 3) * 32;
    LAS unsigned char* kst = lds + srow * KS8 + sc8 * 8;
    LAS unsigned char* vst = lds + 2 * MLA_KB8B + (tid >> 2) * VS8B + (tid & 3) * 32;
    const LAS unsigned char* kl = lds + r32 * KS8 + hi * 8;
    const LAS unsigned char* vl = lds + 2 * MLA_KB8B + r32 * VS8B + hi * 8;
    u32x2 sk0, sk1, sk2, sk3, sk4, sk5; u32x4 sv0, sv1;
#define MLA_LOAD(J) do { const unsigned char* kp_ = kg + (size_t)(J) * (128 * 3072); const unsigned char* vp_ = vg + (size_t)(J) * 128; \
        sk0 = *(const GAS u32x2*)(kp_); sk1 = *(const GAS u32x2*)(kp_ + 64); sk2 = *(const GAS u32x2*)(kp_ + 128); \
        sk3 = *(const GAS u32x2*)(kp_ + 64 * 3072); sk4 = *(const GAS u32x2*)(kp_ + 64 * 3072 + 64); sk5 = *(const GAS u32x2*)(kp_ + 64 * 3072 + 128); \
        sv0 = *(const GAS u32x4*)(vp_); sv1 = *(const GAS u32x4*)(vp_ + 16); } while (0)
#define MLA_STORE(b, vb) do { LAS unsigned char* kd_ = kst + (b) * MLA_KB8B; LAS unsigned char* vd_ = vst + (vb) * VB8B; \
        *(LAS u32x2*)(kd_) = sk0; *(LAS u32x2*)(kd_ + 64) = sk1; *(LAS u32x2*)(kd_ + 128) = sk2; \
        *(LAS u32x2*)(kd_ + 64 * KS8) = sk3; *(LAS u32x2*)(kd_ + 64 * KS8 + 64) = sk4; *(LAS u32x2*)(kd_ + 64 * KS8 + 128) = sk5; \
        *(LAS u32x2*)(vd_) = (u32x2){sv0.x, sv0.y}; *(LAS u32x2*)(vd_ + 8) = (u32x2){sv0.z, sv0.w}; *(LAS u32x2*)(vd_ + 16) = (u32x2){sv1.x, sv1.y}; *(LAS u32x2*)(vd_ + 24) = (u32x2){sv1.z, sv1.w}; } while (0)
    MLA_LOAD(0); MLA_STORE(0, 0);
    __syncthreads();
    float m = -1e30f, l = 0.f; f32x16 o[4];
#pragma unroll
    for (int d = 0; d < 4; ++d)
#pragma unroll
        for (int r = 0; r < 16; ++r) o[d][r] = 0.f;
    const bool trail = wave >= 4;
    i64 pb[4] = {};
    int vb_cur = 0, vb_prev = 2;
    for (int J = 0; J < NTB; ++J) {
        int vb_next = vb_cur + 1; if (vb_next == 3) vb_next = 0;
        if (J + 1 < NTB) MLA_LOAD(J + 1);
#pragma unroll
        for (int sub = 0; sub < 2; ++sub) {
            const int j = 2 * J + sub, kb = 64 * j;
            if (trail && j > 0 && kb - 64 <= qw + 31) pv_tile8(o, pb, vl + (sub == 0 ? vb_prev * VB8B + 64 : vb_cur * VB8B));
            if (kb <= qw + 31) {
                f32x16 p0, p1;
                qk_tile8<12>(p0, p1, kl + (J & 1) * MLA_KB8B + sub * 64 * KS8, q);
                if (kb + 63 > qw) {
                    const int dq = tq - kb - 4 * hi;
#pragma unroll
                    for (int r = 0; r < 16; ++r) { const int c = (r & 3) + 8 * (r >> 2);
                        if (c > dq) p0[r] = -__builtin_inff();
                        if (c + 32 > dq) p1[r] = -__builtin_inff(); }
                }
                online_sm_scaled(p0, p1, m, l, o, QS_MLA);
                pb[0] = packp8<0>(p0); pb[1] = packp8<1>(p0); pb[2] = packp8<0>(p1); pb[3] = packp8<1>(p1);
                if (!trail) pv_tile8(o, pb, vl + vb_cur * VB8B + sub * 64);
            }
        }
        if (J + 1 < NTB) MLA_STORE((J + 1) & 1, vb_next);
        __syncthreads();
        vb_prev = vb_cur; vb_cur = vb_next;
    }
    if (trail && 64 * (NT - 1) <= qw + 31) pv_tile8(o, pb, vl + vb_prev * VB8B + 64);
    __syncthreads();
#undef MLA_LOAD
#undef MLA_STORE
    const float inv = (1.f / 256.f) / l;
    const bf16* zp = P.Z + (size_t)tq * 2048 + head * 128 + 4 * hi;
    bf16* op = P.O + (size_t)tq * 4096 + head * 128 + 4 * hi;
#pragma unroll
    for (int d0 = 0; d0 < 4; ++d0)
#pragma unroll
        for (int rg = 0; rg < 4; ++rg) { const int dim = 32 * d0 + 8 * rg;
            const u32x2 z = *(const GAS u32x2*)(zp + dim);
            u32x2 w; w.x = pk2(o[d0][4 * rg + 0] * inv * bflo(z.x), o[d0][4 * rg + 1] * inv * bfhi(z.x)); w.y = pk2(o[d0][4 * rg + 2] * inv * bflo(z.y), o[d0][4 * rg + 3] * inv * bfhi(z.y));
            *(GAS u32x2*)(op + dim) = w; }
}

#elif defined(MLA_FP8V)
struct MlaPtrs { const bf16* Q; const bf16* K; const bf16* V; const bf16* Z; bf16* O; };
__device__ __forceinline__ void mla_unit(LAS unsigned char* lds, const MlaPtrs& P, int head, int qb, int tid_in, int wave, int lane_in) {
    int tid = tid_in; asm volatile("" : "+v"(tid)); const int lane = tid & 63; (void)lane_in;
    const int r32 = lane & 31, hi = lane >> 5;
    const int q0 = qb * 256, qw = q0 + wave * 32, tq = qw + r32;
    i64 q[12];
    { const unsigned char* qp = (const unsigned char*)P.Q + (size_t)tq * 3072 + head * 192 + hi * 8;
#pragma unroll
      for (int d0 = 0; d0 < 12; ++d0) q[d0] = *(const GAS i64*)(qp + d0 * 16); }
    const int NT = 4 * (qb + 1);
    const int srow = tid >> 3, sc8 = tid & 7;
    const unsigned char* kg = (const unsigned char*)P.K + (size_t)head * 192 + (size_t)srow * 3072 + sc8 * 8;
    const unsigned char* vg = (const unsigned char*)P.V + ((size_t)head * 128 + (tid >> 2)) * S + (tid & 3) * 16;
    LAS unsigned char* kst = lds + srow * KS8 + sc8 * 8;
    LAS unsigned char* vst = lds + 2 * MLA_KB8 + (tid >> 2) * VS8 + (tid & 3) * 16;
    const LAS unsigned char* kl = lds + r32 * KS8 + hi * 8;
    const LAS unsigned char* vl = lds + 2 * MLA_KB8 + r32 * VS8 + hi * 8;
    u32x2 sk0, sk1, sk2; u32x4 sv0;
#define MLA_LOAD(j) do { const unsigned char* kp_ = kg + (size_t)(j) * (64 * 3072); const unsigned char* vp_ = vg + (size_t)(j) * 64; \
        sk0 = *(const GAS u32x2*)(kp_); sk1 = *(const GAS u32x2*)(kp_ + 64); sk2 = *(const GAS u32x2*)(kp_ + 128); sv0 = *(const GAS u32x4*)(vp_); } while (0)
#define MLA_STORE(b, vb) do { LAS unsigned char* kd_ = kst + (b) * MLA_KB8; LAS unsigned char* vd_ = vst + (vb) * VB8; \
        *(LAS u32x2*)(kd_) = sk0; *(LAS u32x2*)(kd_ + 64) = sk1; *(LAS u32x2*)(kd_ + 128) = sk2; *(LAS u32x2*)(vd_) = (u32x2){sv0.x, sv0.y}; *(LAS u32x2*)(vd_ + 8) = (u32x2){sv0.z, sv0.w}; } while (0)
    MLA_LOAD(0); MLA_STORE(0, 0);
    __syncthreads();
    float m = -1e30f, l = 0.f; f32x16 o[4];
#pragma unroll
    for (int d = 0; d < 4; ++d)
#pragma unroll
        for (int r = 0; r < 16; ++r) o[d][r] = 0.f;
    const bool trail = wave >= 4;
    i64 pb[4] = {};
    int vb_cur = 0, vb_prev = 2;
    for (int j = 0; j < NT; ++j) {
        const int kb = 64 * j;
        int vb_next = vb_cur + 1; if (vb_next == 3) vb_next = 0;
        if (j + 1 < NT) MLA_LOAD(j + 1);
        if (trail && j > 0 && kb - 64 <= qw + 31) pv_tile8(o, pb, vl + vb_prev * VB8);
        if (kb <= qw + 31) {
            f32x16 p0, p1;
#ifdef PROBE_QKM2
            { f32x16 r0, r1; qk_tile_m2<12, KS_M>(p0, p1, r0, r1, kl + (j & 1) * MLA_KB, q);
#pragma unroll
              for (int r = 0; r < 16; ++r) { p0[r] = (p0[r] + r0[r]) * 0.5f; p1[r] = (p1[r] + r1[r]) * 0.5f; } }
#else
            qk_tile8<12>(p0, p1, kl + (j & 1) * MLA_KB8, q);
#endif
#ifdef PROBE_QK2
            { f32x16 r0, r1; asm volatile("" ::: "memory"); qk_tile<12, KS_M>(r0, r1, kl + (j & 1) * MLA_KB, q);
#pragma unroll
              for (int r = 0; r < 16; ++r) { p0[r] = (p0[r] + r0[r]) * 0.5f; p1[r] = (p1[r] + r1[r]) * 0.5f; } }
#endif
#ifdef PROBE_SM2
            { float acc_ = 0.f;
#pragma unroll
              for (int r = 0; r < 16; ++r) { acc_ += __builtin_amdgcn_exp2f(p0[r] - m - 40.f) + __builtin_amdgcn_exp2f(p1[r] - m - 40.f); }
#pragma unroll
              for (int r = 0; r < 16; ++r) { acc_ += __builtin_amdgcn_exp2f(p0[r] - m - 50.f) + __builtin_amdgcn_exp2f(p1[r] - m - 50.f); }
              if (acc_ == 12345.678f) l += 1.f; }
#endif
            if (kb + 63 > qw) {
                const int dq = tq - kb - 4 * hi;
#pragma unroll
                for (int r = 0; r < 16; ++r) { const int c = (r & 3) + 8 * (r >> 2);
                    if (c > dq) p0[r] = -__builtin_inff();
                    if (c + 32 > dq) p1[r] = -__builtin_inff(); }
            }
            online_sm_scaled(p0, p1, m, l, o, QS_MLA);
            pb[0] = packp8<0>(p0); pb[1] = packp8<1>(p0); pb[2] = packp8<0>(p1); pb[3] = packp8<1>(p1);
            if (!trail) pv_tile8(o, pb, vl + vb_cur * VB8);
        }
        if (j + 1 < NT) MLA_STORE((j + 1) & 1, vb_next);
        __syncthreads();
        vb_prev = vb_cur; vb_cur = vb_next;
    }
    if (trail && 64 * (NT - 1) <= qw + 31) pv_tile8(o, pb, vl + vb_prev * VB8);
    __syncthreads();
#undef MLA_LOAD
#undef MLA_STORE
    const float inv = (1.f / 256.f) / l;
    const bf16* zp = P.Z + (size_t)tq * 2048 + head * 128 + 4 * hi;
    bf16* op = P.O + (size_t)tq * 4096 + head * 128 + 4 * hi;
#pragma unroll
    for (int d0 = 0; d0 < 4; ++d0)
#pragma unroll
        for (int rg = 0; rg < 4; ++rg) { const int dim = 32 * d0 + 8 * rg;
            const u32x2 z = *(const GAS u32x2*)(zp + dim);
            u32x2 w; w.x = pk2(o[d0][4 * rg + 0] * inv * bflo(z.x), o[d0][4 * rg + 1] * inv * bfhi(z.x)); w.y = pk2(o[d0][4 * rg + 2] * inv * bflo(z.y), o[d0][4 * rg + 3] * inv * bfhi(z.y));
            *(GAS u32x2*)(op + dim) = w; }
}

#elif defined(MLA_FP8)
struct MlaPtrs { const bf16* Q; const bf16* K; const bf16* V; const bf16* Z; bf16* O; };
__device__ __forceinline__ void mla_unit(LAS unsigned char* lds, const MlaPtrs& P, int head, int qb, int tid_in, int wave, int lane_in) {
    int tid = tid_in; asm volatile("" : "+v"(tid)); const int lane = tid & 63; (void)lane_in;
    const int r32 = lane & 31, hi = lane >> 5;
    const int q0 = qb * 256, qw = q0 + wave * 32, tq = qw + r32;
    i64 q[12];
    { const unsigned char* qp = (const unsigned char*)P.Q + (size_t)tq * 3072 + head * 192 + hi * 8;
#pragma unroll
      for (int d0 = 0; d0 < 12; ++d0) q[d0] = *(const GAS i64*)(qp + d0 * 16); }
    const int NT = 4 * (qb + 1);
    const int srow = tid >> 3, sc8 = tid & 7;
    const unsigned char* kg = (const unsigned char*)P.K + (size_t)head * 192 + (size_t)srow * 3072 + sc8 * 8;
    const unsigned char* vg = (const unsigned char*)P.V + (size_t)head * 256 + (size_t)srow * 4096 + sc8 * 16;
    LAS unsigned char* kst = lds + srow * KS8 + sc8 * 8;
    LAS unsigned char* vst = lds + 2 * MLA_KB8 + srow * VS + sc8 * 16;
    const LAS unsigned char* kl = lds + r32 * KS8 + hi * 8;
    const LAS unsigned char* vl = lds + 2 * MLA_KB8 + (4 * hi + ((lane & 15) >> 2)) * VS + (16 * ((lane >> 4) & 1) + 4 * (lane & 3)) * 2;
    u32x2 sk0, sk1, sk2; u32x4 sv0, sv1;
#define MLA_LOAD(j) do { const unsigned char* kp_ = kg + (size_t)(j) * (64 * 3072); const unsigned char* vp_ = vg + (size_t)(j) * (64 * 4096); \
        sk0 = *(const GAS u32x2*)(kp_); sk1 = *(const GAS u32x2*)(kp_ + 64); sk2 = *(const GAS u32x2*)(kp_ + 128); sv0 = *(const GAS u32x4*)(vp_); sv1 = *(const GAS u32x4*)(vp_ + 128); } while (0)
#define MLA_STORE(b, vb) do { LAS unsigned char* kd_ = kst + (b) * MLA_KB8; LAS unsigned char* vd_ = vst + (vb) * VB; \
        *(LAS u32x2*)(kd_) = sk0; *(LAS u32x2*)(kd_ + 64) = sk1; *(LAS u32x2*)(kd_ + 128) = sk2; *(LAS u32x4*)(vd_) = sv0; *(LAS u32x4*)(vd_ + 128) = sv1; } while (0)
    MLA_LOAD(0); MLA_STORE(0, 0);
    __syncthreads();
    float m = -1e30f, l = 0.f; f32x16 o[4];
#pragma unroll
    for (int d = 0; d < 4; ++d)
#pragma unroll
        for (int r = 0; r < 16; ++r) o[d][r] = 0.f;
    const bool trail = wave >= 4;
    bf16x8 pb[4] = {};
    int vb_cur = 0, vb_prev = 2;
    for (int j = 0; j < NT; ++j) {
        const int kb = 64 * j;
        int vb_next = vb_cur + 1; if (vb_next == 3) vb_next = 0;
        if (j + 1 < NT) MLA_LOAD(j + 1);
        if (trail && j > 0 && kb - 64 <= qw + 31) pv_tile(o, pb, vl + vb_prev * VB);
        if (kb <= qw + 31) {
            f32x16 p0, p1;
#ifdef PROBE_QKM2
            { f32x16 r0, r1; qk_tile_m2<12, KS_M>(p0, p1, r0, r1, kl + (j & 1) * MLA_KB, q);
#pragma unroll
              for (int r = 0; r < 16; ++r) { p0[r] = (p0[r] + r0[r]) * 0.5f; p1[r] = (p1[r] + r1[r]) * 0.5f; } }
#else
            qk_tile8<12>(p0, p1, kl + (j & 1) * MLA_KB8, q);
#endif
#ifdef PROBE_QK2
            { f32x16 r0, r1; asm volatile("" ::: "memory"); qk_tile<12, KS_M>(r0, r1, kl + (j & 1) * MLA_KB, q);
#pragma unroll
              for (int r = 0; r < 16; ++r) { p0[r] = (p0[r] + r0[r]) * 0.5f; p1[r] = (p1[r] + r1[r]) * 0.5f; } }
#endif
#ifdef PROBE_SM2
            { float acc_ = 0.f;
#pragma unroll
              for (int r = 0; r < 16; ++r) { acc_ += __builtin_amdgcn_exp2f(p0[r] - m - 40.f) + __builtin_amdgcn_exp2f(p1[r] - m - 40.f); }
#pragma unroll
              for (int r = 0; r < 16; ++r) { acc_ += __builtin_amdgcn_exp2f(p0[r] - m - 50.f) + __builtin_amdgcn_exp2f(p1[r] - m - 50.f); }
              if (acc_ == 12345.678f) l += 1.f; }
#endif
            if (kb + 63 > qw) {
                const int dq = tq - kb - 4 * hi;
#pragma unroll
                for (int r = 0; r < 16; ++r) { const int c = (r & 3) + 8 * (r >> 2);
                    if (c > dq) p0[r] = -__builtin_inff();
                    if (c + 32 > dq) p1[r] = -__builtin_inff(); }
            }
            online_sm_scaled(p0, p1, m, l, o, QS_MLA);
            pb[0] = packp<0>(p0); pb[1] = packp<1>(p0); pb[2] = packp<0>(p1); pb[3] = packp<1>(p1);
            if (!trail) pv_tile(o, pb, vl + vb_cur * VB);
        }
        if (j + 1 < NT) MLA_STORE((j + 1) & 1, vb_next);
        __syncthreads();
        vb_prev = vb_cur; vb_cur = vb_next;
    }
    if (trail && 64 * (NT - 1) <= qw + 31) pv_tile(o, pb, vl + vb_prev * VB);
    __syncthreads();
#undef MLA_LOAD
#undef MLA_STORE
    const float inv = 1.f / l;
    const bf16* zp = P.Z + (size_t)tq * 2048 + head * 128 + 4 * hi;
    bf16* op = P.O + (size_t)tq * 4096 + head * 128 + 4 * hi;
#pragma unroll
    for (int d0 = 0; d0 < 4; ++d0)
#pragma unroll
        for (int rg = 0; rg < 4; ++rg) { const int dim = 32 * d0 + 8 * rg;
            const u32x2 z = *(const GAS u32x2*)(zp + dim);
            u32x2 w; w.x = pk2(o[d0][4 * rg + 0] * inv * bflo(z.x), o[d0][4 * rg + 1] * inv * bfhi(z.x)); w.y = pk2(o[d0][4 * rg + 2] * inv * bflo(z.y), o[d0][4 * rg + 3] * inv * bfhi(z.y));
            *(GAS u32x2*)(op + dim) = w; }
}

#else
struct MlaPtrs { const bf16* Q; const bf16* K; const bf16* V; const bf16* Z; bf16* O; };
__device__ __forceinline__ void mla_unit(LAS unsigned char* lds, const MlaPtrs& P, int head, int qb, int tid_in, int wave, int lane_in) {
    int tid = tid_in; asm volatile("" : "+v"(tid)); const int lane = tid & 63; (void)lane_in;
    const int r32 = lane & 31, hi = lane >> 5;
    const int q0 = qb * 256, qw = q0 + wave * 32, tq = qw + r32;
    bf16x8 q[12];
    { const bf16* qp = P.Q + (size_t)tq * 3072 + head * 192 + hi * 8;
#pragma unroll
      for (int d0 = 0; d0 < 12; ++d0) q[d0] = *(const GAS bf16x8*)(qp + d0 * 16); }
    const int NT = 4 * (qb + 1);
    const int srow = tid >> 3, sc8 = tid & 7;
    const unsigned char* kg = (const unsigned char*)P.K + (size_t)head * 384 + (size_t)srow * 6144 + sc8 * 16;
    const unsigned char* vg = (const unsigned char*)P.V + (size_t)head * 256 + (size_t)srow * 4096 + sc8 * 16;
    LAS unsigned char* kst = lds + srow * KS_M + sc8 * 16;
    LAS unsigned char* vst = lds + 2 * MLA_KB + srow * VS + sc8 * 16;
    const LAS unsigned char* kl = lds + r32 * KS_M + hi * 16;
    const LAS unsigned char* vl = lds + 2 * MLA_KB + (4 * hi + ((lane & 15) >> 2)) * VS + (16 * ((lane >> 4) & 1) + 4 * (lane & 3)) * 2;
    u32x4 sk0, sk1, sk2, sv0, sv1;
#define MLA_LOAD(j) do { const unsigned char* kp_ = kg + (size_t)(j) * (64 * 6144); const unsigned char* vp_ = vg + (size_t)(j) * (64 * 4096); \
        sk0 = *(const GAS u32x4*)(kp_); sk1 = *(const GAS u32x4*)(kp_ + 128); sk2 = *(const GAS u32x4*)(kp_ + 256); sv0 = *(const GAS u32x4*)(vp_); sv1 = *(const GAS u32x4*)(vp_ + 128); } while (0)
#define MLA_STORE(b, vb) do { LAS unsigned char* kd_ = kst + (b) * MLA_KB; LAS unsigned char* vd_ = vst + (vb) * VB; \
        *(LAS u32x4*)(kd_) = sk0; *(LAS u32x4*)(kd_ + 128) = sk1; *(LAS u32x4*)(kd_ + 256) = sk2; *(LAS u32x4*)(vd_) = sv0; *(LAS u32x4*)(vd_ + 128) = sv1; } while (0)
    MLA_LOAD(0); MLA_STORE(0, 0);
    __syncthreads();
    float m = -1e30f, l = 0.f; f32x16 o[4];
#pragma unroll
    for (int d = 0; d < 4; ++d)
#pragma unroll
        for (int r = 0; r < 16; ++r) o[d][r] = 0.f;
    const bool trail = wave >= 4;
    bf16x8 pb[4] = {};
    int vb_cur = 0, vb_prev = 2;
    for (int j = 0; j < NT; ++j) {
        const int kb = 64 * j;
        int vb_next = vb_cur + 1; if (vb_next == 3) vb_next = 0;
        if (j + 1 < NT) MLA_LOAD(j + 1);
        if (trail && j > 0 && kb - 64 <= qw + 31) pv_tile(o, pb, vl + vb_prev * VB);
        if (kb <= qw + 31) {
            f32x16 p0, p1;
#ifdef PROBE_QKM2
            { f32x16 r0, r1; qk_tile_m2<12, KS_M>(p0, p1, r0, r1, kl + (j & 1) * MLA_KB, q);
#pragma unroll
              for (int r = 0; r < 16; ++r) { p0[r] = (p0[r] + r0[r]) * 0.5f; p1[r] = (p1[r] + r1[r]) * 0.5f; } }
#else
            qk_tile<12, KS_M>(p0, p1, kl + (j & 1) * MLA_KB, q);
#endif
#ifdef PROBE_QK2
            { f32x16 r0, r1; asm volatile("" ::: "memory"); qk_tile<12, KS_M>(r0, r1, kl + (j & 1) * MLA_KB, q);
#pragma unroll
              for (int r = 0; r < 16; ++r) { p0[r] = (p0[r] + r0[r]) * 0.5f; p1[r] = (p1[r] + r1[r]) * 0.5f; } }
#endif
#ifdef PROBE_SM2
            { float acc_ = 0.f;
#pragma unroll
              for (int r = 0; r < 16; ++r) { acc_ += __builtin_amdgcn_exp2f(p0[r] - m - 40.f) + __builtin_amdgcn_exp2f(p1[r] - m - 40.f); }
#pragma unroll
              for (int r = 0; r < 16; ++r) { acc_ += __builtin_amdgcn_exp2f(p0[r] - m - 50.f) + __builtin_amdgcn_exp2f(p1[r] - m - 50.f); }
              if (acc_ == 12345.678f) l += 1.f; }
#endif
            if (kb + 63 > qw) {
                const int dq = tq - kb - 4 * hi;
#pragma unroll
                for (int r = 0; r < 16; ++r) { const int c = (r & 3) + 8 * (r >> 2);
                    if (c > dq) p0[r] = -__builtin_inff();
                    if (c + 32 > dq) p1[r] = -__builtin_inff(); }
            }
            online_sm(p0, p1, m, l, o);
            pb[0] = packp<0>(p0); pb[1] = packp<1>(p0); pb[2] = packp<0>(p1); pb[3] = packp<1>(p1);
            if (!trail) pv_tile(o, pb, vl + vb_cur * VB);
        }
        if (j + 1 < NT) MLA_STORE((j + 1) & 1, vb_next);
        __syncthreads();
        vb_prev = vb_cur; vb_cur = vb_next;
    }
    if (trail && 64 * (NT - 1) <= qw + 31) pv_tile(o, pb, vl + vb_prev * VB);
    __syncthreads();
#undef MLA_LOAD
#undef MLA_STORE
    const float inv = 1.f / l;
    const bf16* zp = P.Z + (size_t)tq * 2048 + head * 128 + 4 * hi;
    bf16* op = P.O + (size_t)tq * 4096 + head * 128 + 4 * hi;
#pragma unroll
    for (int d0 = 0; d0 < 4; ++d0)
#pragma unroll
        for (int rg = 0; rg < 4; ++rg) { const int dim = 32 * d0 + 8 * rg;
            const u32x2 z = *(const GAS u32x2*)(zp + dim);
            u32x2 w; w.x = pk2(o[d0][4 * rg + 0] * inv * bflo(z.x), o[d0][4 * rg + 1] * inv * bfhi(z.x)); w.y = pk2(o[d0][4 * rg + 2] * inv * bflo(z.y), o[d0][4 * rg + 3] * inv * bfhi(z.y));
            *(GAS u32x2*)(op + dim) = w; }
}

#endif
#endif
struct NsaPtrs { const bf16* Q; const bf16* KV; const bf16* KC; const bf16* VC; const bf16* Z; const float* G; bf16* O; float* scr; };
template <int MODE>
__device__ __forceinline__ void nsa_loop(LAS unsigned char* lds, const unsigned char* kbase, const unsigned char* vbase, int ntiles, int jlo,
                                         const bf16x8 (&q)[8], int t, float slope2, float& m, float& l, f32x16 (&o)[4], float invl, int tid, int wave, int lane) {
    constexpr bool HASV = MODE != 0;
    const int r32 = lane & 31, hi = lane >> 5;
    const int srow = tid >> 3, sc8 = tid & 7;
    const unsigned soff = srow * 256 + sc8 * 16;
    LAS unsigned char* kst = lds + srow * KS_N + sc8 * 16;
    LAS unsigned char* vst = lds + 2 * NSA_KB + srow * VS + sc8 * 16;
    const LAS unsigned char* kl = lds + r32 * KS_N + hi * 16;
    const LAS unsigned char* vl = lds + 2 * NSA_KB + (4 * hi + ((lane & 15) >> 2)) * VS + (16 * ((lane >> 4) & 1) + 4 * (lane & 3)) * 2;
    const LAS int* ulist = (const LAS int*)(lds + N_ULIST);
    const LAS unsigned* selm = (const LAS unsigned*)(lds + N_SELM);
    LAS float* partA = (LAS float*)(lds + N_PART); LAS float* partB = (LAS float*)(lds + N_PART + N_PARTB);
    LAS float* imp = (LAS float*)(lds + N_IMP); LAS float* carry = (LAS float*)(lds + N_CARRY);
    if (ntiles <= 0) return;
    u32x4 sk0, sk1, sv0, sv1;
#define NSA_TROW(j) (MODE == 2 ? 64 * __builtin_amdgcn_readfirstlane(ulist[ntiles - 1 - (j)]) : (MODE == 3 ? 64 * (jlo + ntiles - 1 - (j)) : 64 * (jlo + (j))))
#define NSA_LOAD(j) do { const size_t ro_ = (size_t)NSA_TROW(j) * 256 + soff; \
        sk0 = *(const GAS u32x4*)(kbase + ro_); sk1 = *(const GAS u32x4*)(kbase + ro_ + 128); \
        if (HASV) { sv0 = *(const GAS u32x4*)(vbase + ro_); sv1 = *(const GAS u32x4*)(vbase + ro_ + 128); } } while (0)
#define NSA_STORE(b) do { LAS unsigned char* kd_ = kst + (b) * NSA_KB; *(LAS u32x4*)(kd_) = sk0; *(LAS u32x4*)(kd_ + 128) = sk1; \
        if (HASV) { LAS unsigned char* vd_ = vst + (b) * VB; *(LAS u32x4*)(vd_) = sv0; *(LAS u32x4*)(vd_ + 128) = sv1; } } while (0)
    NSA_LOAD(0); NSA_STORE(0);
    __syncthreads();
    for (int j = 0; j < ntiles; ++j) {
        const int buf = j & 1;
        if (MODE != 1 && j + 1 < ntiles) NSA_LOAD(j + 1);
        const int trow = NSA_TROW(j);
        constexpr int PSTEP = (MODE <= 1) ? 16 : 1;
        const int pstart = (MODE <= 1) ? 16 * trow + 31 : trow;
        const int db = t - pstart - PSTEP * 4 * hi;
        constexpr unsigned W = (MODE == 3) ? 512u : 0x7fffffffu;
        const bool mset = m > -1e29f;
        float b0 = -slope2 * (float)db - ((MODE >= 2 && mset) ? m : 0.f);
        if (MODE == 2) { const int b = trow >> 6; if (((selm[r32 * 8 + (b >> 5)] >> (b & 31)) & 1u) == 0u) b0 = -__builtin_inff(); }
        f32x16 p0, p1;
#pragma unroll
        for (int r = 0; r < 16; ++r) { const int c = PSTEP * ((r & 3) + 8 * (r >> 2));
            p0[r] = __builtin_fmaf(slope2, (float)c, b0); p1[r] = __builtin_fmaf(slope2, (float)(c + 32 * PSTEP), b0); }
        qk_tile<8, KS_N, false>(p0, p1, kl + buf * NSA_KB, q);
        { const int t0u = __builtin_amdgcn_readfirstlane(t - r32);
          const bool interior = (t0u - (pstart + PSTEP * 63) >= 0) && ((unsigned)(t0u + 31 - pstart) < W);
          if (!interior) {
#pragma unroll
              for (int r = 0; r < 16; ++r) { const int c = PSTEP * ((r & 3) + 8 * (r >> 2));
                  if ((unsigned)(db - c) >= W) p0[r] = -__builtin_inff();
                  if ((unsigned)(db - c - 32 * PSTEP) >= W) p1[r] = -__builtin_inff(); } } }
        if (MODE == 0) {
            float tm = p0[0];
#pragma unroll
            for (int r = 1; r < 16; ++r) tm = fmaxf(tm, p0[r]);
#pragma unroll
            for (int r = 0; r < 16; ++r) tm = fmaxf(tm, p1[r]);
            tm = swapmax(tm);
            const float mn = fmaxf(m, tm); const float alpha = __builtin_amdgcn_exp2f(m - mn); m = mn;
            float ps = 0.f;
#pragma unroll
            for (int r = 0; r < 16; ++r) ps += __builtin_amdgcn_exp2f(p0[r] - mn) + __builtin_amdgcn_exp2f(p1[r] - mn);
            l = l * alpha + swapsum(ps);
        } else if (MODE == 1) {
#pragma unroll
            for (int r = 0; r < 16; ++r) { p0[r] = __builtin_amdgcn_exp2f(p0[r] - m) * invl; p1[r] = __builtin_amdgcn_exp2f(p1[r] - m) * invl; }
            LAS float* pa = partA + (wave * 32 + r32) * 17 + hi; LAS float* pbm = partB + (wave * 32 + r32) * 17 + hi;
#pragma unroll
            for (int rg = 0; rg < 4; ++rg) {
                pa[2 * rg] = (p0[4 * rg] + p0[4 * rg + 1]) + (p0[4 * rg + 2] + p0[4 * rg + 3]); pbm[2 * rg] = p0[4 * rg + 3];
                pa[8 + 2 * rg] = (p1[4 * rg] + p1[4 * rg + 1]) + (p1[4 * rg + 2] + p1[4 * rg + 3]); pbm[8 + 2 * rg] = p1[4 * rg + 3]; }
            const bf16x8 pb[4] = {packp<0>(p0), packp<1>(p0), packp<0>(p1), packp<1>(p1)};
            pv_tile(o, pb, vl + buf * VB);
            __syncthreads();
            { const int qq = tid >> 4, jl = tid & 15; float a = 0.f, bp = 0.f, bl = 0.f;
#pragma unroll
              for (int w = 0; w < 8; ++w) { a += partA[(w * 32 + qq) * 17 + jl]; bl += partB[(w * 32 + qq) * 17 + jl]; }
              if (jl > 0) {
#pragma unroll
                  for (int w = 0; w < 8; ++w) bp += partB[(w * 32 + qq) * 17 + jl - 1];
              } else bp = (j > 0) ? carry[((j - 1) & 1) * 32 + qq] : 0.f;
              imp[qq * 256 + 16 * j + jl] = a + bp;
              if (jl == 15) carry[(j & 1) * 32 + qq] = bl; }
        } else {
            constexpr float NSA_LAZY_T = 16.f;
            float tm = p0[0];
#pragma unroll
            for (int r = 1; r < 16; ++r) tm = fmaxf(tm, p0[r]);
#pragma unroll
            for (int r = 0; r < 16; ++r) tm = fmaxf(tm, p1[r]);
            tm = swapmax(tm);
            const bool need = mset ? (tm > NSA_LAZY_T) : (tm > -1e29f);
            if (!__all(!need)) {
                const float dlt = need ? tm : 0.f;
                const float alpha = mset ? __builtin_amdgcn_exp2f(-dlt) : 1.f;
                if (need) m = (mset ? m : 0.f) + dlt;
#pragma unroll
                for (int r = 0; r < 16; ++r) { p0[r] -= dlt; p1[r] -= dlt; }
                l *= alpha;
#pragma unroll
                for (int d_ = 0; d_ < 4; ++d_)
#pragma unroll
                    for (int r = 0; r < 16; ++r) o[d_][r] *= alpha;
            }
            float ps = 0.f;
#pragma unroll
            for (int r = 0; r < 16; ++r) { p0[r] = __builtin_amdgcn_exp2f(p0[r]); ps += p0[r]; }
#pragma unroll
            for (int r = 0; r < 16; ++r) { p1[r] = __builtin_amdgcn_exp2f(p1[r]); ps += p1[r]; }
            l += swapsum(ps);
            const bf16x8 pb[4] = {packp<0>(p0), packp<1>(p0), packp<0>(p1), packp<1>(p1)};
            pv_tile(o, pb, vl + buf * VB);
        }
        if (MODE == 1 && j + 1 < ntiles) NSA_LOAD(j + 1);
        if (j + 1 < ntiles) NSA_STORE(buf ^ 1);
        __syncthreads();
    }
#undef NSA_TROW
#undef NSA_LOAD
#undef NSA_STORE
}
__device__ __forceinline__ void nsa_topk(const LAS float* improw, LAS unsigned* selrow, int cur, int lane) {
    unsigned key[4]; bool sel[4];
    int nforced = 0;
#pragma unroll
    for (int k = 0; k < 4; ++k) { const int j = lane + 64 * k;
        const bool forced = (j == 0) || (j == cur) || (j == cur - 1);
        const bool causal = j <= cur;
        sel[k] = forced;
#ifdef IMPNOISE_BUILD
        { unsigned h = (unsigned)j * 2654435761u + (unsigned)(size_t)improw * 40503u; h ^= h >> 15; h *= 0x846ca68bu; h ^= h >> 16;
          const float r = (float)(int)(h & 0xffffu) * (1.f / 32768.f) - 1.f; const float v = improw[j] * (1.f + IMPNOISE_EPS * r);
          key[k] = (causal && !forced) ? (__float_as_uint(v) + 1u) : 0u; }
#else
        key[k] = (causal && !forced) ? (__float_as_uint(improw[j]) + 1u) : 0u;
#endif
    }
    nforced = 1 + (cur >= 1 ? 1 : 0) + (cur >= 2 ? 1 : 0);
    const int want = 16 - nforced;
    for (int it = 0; it < want; ++it) {
        unsigned bk = key[0]; int bj = lane;
#pragma unroll
        for (int k = 1; k < 4; ++k) { if (key[k] > bk) { bk = key[k]; bj = lane + 64 * k; } }
        unsigned long long best = ((unsigned long long)bk << 32) | (unsigned)(0xffffffffu - (unsigned)bj);
#pragma unroll
        for (int off = 1; off < 64; off <<= 1) {
            const unsigned lo = __shfl_xor((unsigned)best, off), hiw = __shfl_xor((unsigned)(best >> 32), off);
            const unsigned long long other = ((unsigned long long)hiw << 32) | lo;
            best = other > best ? other : best; }
        if ((unsigned)(best >> 32) == 0u) break;
        const int wj = (int)(0xffffffffu - (unsigned)best);
#pragma unroll
        for (int k = 0; k < 4; ++k) if (wj == lane + 64 * k) { key[k] = 0u; sel[k] = true; }
    }
#pragma unroll
    for (int k = 0; k < 4; ++k) { const unsigned long long bm = __ballot(sel[k]);
        if (lane == 0) { selrow[2 * k] = (unsigned)bm; selrow[2 * k + 1] = (unsigned)(bm >> 32); } }
}
__device__ __forceinline__ void nsa_topk4(const LAS float* imp0, LAS unsigned* sel0, int cur, int lane) {
    unsigned key[4][4]; bool forced[4];
#pragma unroll
    for (int k = 0; k < 4; ++k) { const int j = lane + 64 * k;
        forced[k] = (j == 0) || (j == cur) || (j == cur - 1);
        const bool cand = (j <= cur) && !forced[k];
#pragma unroll
        for (int i = 0; i < 4; ++i) key[i][k] = cand ? (__float_as_uint(imp0[i * 256 + j]) + 1u) : 0u; }
    const int want = 16 - (1 + (cur >= 1 ? 1 : 0) + (cur >= 2 ? 1 : 0));
    unsigned T[4] = {0u, 0u, 0u, 0u};
    for (int bit = 30; bit >= 0; --bit) {
#pragma unroll
        for (int i = 0; i < 4; ++i) { const unsigned c = T[i] | (1u << bit);
            const int n = __builtin_popcountll(__ballot(key[i][0] >= c)) + __builtin_popcountll(__ballot(key[i][1] >= c)) + __builtin_popcountll(__ballot(key[i][2] >= c)) + __builtin_popcountll(__ballot(key[i][3] >= c));
            if (n >= want) T[i] = c; }
    }
#pragma unroll
    for (int i = 0; i < 4; ++i) {
        const unsigned Ti = T[i];
        int rem = want;
        if (Ti != 0u) rem -= __builtin_popcountll(__ballot(key[i][0] > Ti)) + __builtin_popcountll(__ballot(key[i][1] > Ti)) + __builtin_popcountll(__ballot(key[i][2] > Ti)) + __builtin_popcountll(__ballot(key[i][3] > Ti));
#pragma unroll
        for (int k = 0; k < 4; ++k) {
            bool s = forced[k];
            if (Ti == 0u) s = s || key[i][k] >= 1u;
            else {
                const bool eq = key[i][k] == Ti; const unsigned long long em = __ballot(eq);
                const int below = (int)__builtin_amdgcn_mbcnt_hi((unsigned)(em >> 32), __builtin_amdgcn_mbcnt_lo((unsigned)em, 0u));
                s = s || key[i][k] > Ti || (eq && below < rem);
                rem -= __builtin_popcountll(em); if (rem < 0) rem = 0;
            }
            const unsigned long long bm = __ballot(s);
            if (lane == 0) { sel0[i * 8 + 2 * k] = (unsigned)bm; sel0[i * 8 + 2 * k + 1] = (unsigned)(bm >> 32); }
        }
    }
}
__device__ __forceinline__ int nsa_opaque(int v) { asm volatile("" : "+v"(v)); return v; }
__device__ __forceinline__ void nsa_unit(LAS unsigned char* lds, const NsaPtrs& P, int g, int qblk, int tid_in, int wave, int lane_in, int cu) {
    int tid = tid_in; asm volatile("" : "+v"(tid));
    const int lane = tid & 63; (void)lane_in;
    const int r32 = lane & 31, hi = lane >> 5;
    const int hh = 8 * g + wave, t0 = 32 * qblk, t = t0 + r32;
    const float slope2 = __builtin_amdgcn_exp2f(-0.5f * (float)(hh + 1)) * LOG2E;
    bf16x8 q[8];
    { const bf16* qp = P.Q + (size_t)t * 2048 + hh * 128 + hi * 8;
#pragma unroll
      for (int d0 = 0; d0 < 8; ++d0) q[d0] = *(const GAS bf16x8*)(qp + d0 * 16); }
#define NSA_SCR() ((GAS f32x4*)(P.scr + ((size_t)(cu * 8 + wave) * 16) * 256) + nsa_opaque(lane))
    const size_t CH = (size_t)S * 128 * 2;
    f32x16 o[4]; float m, l;
#define NSA_ZERO_O() do { _Pragma("unroll") for (int d_ = 0; d_ < 4; ++d_) _Pragma("unroll") for (int r_ = 0; r_ < 16; ++r_) o[d_][r_] = 0.f; } while (0)
    const int ncv = 2 * qblk + 1, ntc = (ncv + 63) >> 6;
    const unsigned char* kc = (const unsigned char*)P.KC + (size_t)g * 1024 * 256; const unsigned char* vc = (const unsigned char*)P.VC + (size_t)g * 1024 * 256;
    m = -1e30f; l = 0.f; NSA_ZERO_O();
    nsa_loop<0>(lds, kc, vc, ntc, 0, q, t, slope2, m, l, o, 0.f, tid, wave, lane);
    const float invl = l > 0.f ? 1.f / l : 0.f;
    nsa_loop<1>(lds, kc, vc, ntc, 0, q, t, slope2, m, l, o, invl, tid, wave, lane);
    { const float g_c = P.G[(size_t)t * 48 + hh]; GAS f32x4* scr = NSA_SCR();
#pragma unroll
    for (int d0 = 0; d0 < 4; ++d0)
#pragma unroll
        for (int rg = 0; rg < 4; ++rg) { f32x4 v = {o[d0][4 * rg] * g_c, o[d0][4 * rg + 1] * g_c, o[d0][4 * rg + 2] * g_c, o[d0][4 * rg + 3] * g_c}; scr[(d0 * 4 + rg) * 64] = v; } }
    const int cur = t0 >> 6;
    LAS unsigned* selm = (LAS unsigned*)(lds + N_SELM);
#ifdef NSA_TOPK_ITER
    for (int i = 0; i < 4; ++i) { const int qq = 4 * wave + i; nsa_topk((const LAS float*)(lds + N_IMP) + qq * 256, selm + qq * 8, cur, lane); }
#else
    nsa_topk4((const LAS float*)(lds + N_IMP) + 4 * wave * 256, selm + 4 * wave * 8, cur, lane);
#endif
    __syncthreads();
    if (wave == 0) {
        LAS int* ulist = (LAS int*)(lds + N_ULIST); int n = 0;
        for (int k = 0; k < 8; ++k) { unsigned u = (lane < 32) ? selm[lane * 8 + k] : 0u;
#pragma unroll
            for (int off = 1; off < 32; off <<= 1) u |= __shfl_xor(u, off);
            u = __builtin_amdgcn_readfirstlane(u);
            while (u) { const int b = __builtin_ctz(u); u &= u - 1u; if (lane == 0) ulist[n] = 32 * k + b; ++n; } }
        if (lane == 0) *(LAS int*)(lds + N_NTS) = n;
    }
    __syncthreads();
    const int nts = __builtin_amdgcn_readfirstlane(*(const LAS int*)(lds + N_NTS));
    m = -1e30f; l = 0.f; NSA_ZERO_O();
    nsa_loop<2>(lds, (const unsigned char*)P.KV + (size_t)(4 + g) * CH, (const unsigned char*)P.KV + (size_t)(6 + g) * CH, nts, 0, q, t, slope2, m, l, o, 0.f, tid, wave, lane);
    { const float f = P.G[(size_t)t * 48 + 16 + hh] / l; GAS f32x4* scr = NSA_SCR();
#pragma unroll
      for (int d0 = 0; d0 < 4; ++d0)
          { f32x4 v[4];
#pragma unroll
            for (int rg = 0; rg < 4; ++rg) v[rg] = scr[(d0 * 4 + rg) * 64];
#pragma unroll
            for (int rg = 0; rg < 4; ++rg) { v[rg][0] += o[d0][4 * rg] * f; v[rg][1] += o[d0][4 * rg + 1] * f; v[rg][2] += o[d0][4 * rg + 2] * f; v[rg][3] += o[d0][4 * rg + 3] * f; scr[(d0 * 4 + rg) * 64] = v[rg]; } } }
    const int jlo = (t0 > 511 ? t0 - 511 : 0) >> 6, jhi = (t0 + 31) >> 6;
    m = -1e30f; l = 0.f; NSA_ZERO_O();
    nsa_loop<3>(lds, (const unsigned char*)P.KV + (size_t)(8 + g) * CH, (const unsigned char*)P.KV + (size_t)(10 + g) * CH, jhi - jlo + 1, jlo, q, t, slope2, m, l, o, 0.f, tid, wave, lane);
    { const float f = P.G[(size_t)t * 48 + 32 + hh] / l; GAS f32x4* scr = NSA_SCR();
      const bf16* zp = P.Z + (size_t)t * 2048 + hh * 128 + 4 * hi;
      bf16* op = P.O + (size_t)t * 4096 + 2048 + hh * 128 + 4 * hi;
#pragma unroll
      for (int d0 = 0; d0 < 4; ++d0)
          { f32x4 av[4]; u32x2 zv[4];
#pragma unroll
            for (int rg = 0; rg < 4; ++rg) { av[rg] = scr[(d0 * 4 + rg) * 64]; zv[rg] = *(const GAS u32x2*)(zp + 32 * d0 + 8 * rg); }
#pragma unroll
          for (int rg = 0; rg < 4; ++rg) { const int dim = 32 * d0 + 8 * rg; const f32x4 a = av[rg];
              const u32x2 z = zv[rg];
              u32x2 w; w.x = pk2((a[0] + o[d0][4 * rg] * f) * bflo(z.x), (a[1] + o[d0][4 * rg + 1] * f) * bfhi(z.x)); w.y = pk2((a[2] + o[d0][4 * rg + 2] * f) * bflo(z.y), (a[3] + o[d0][4 * rg + 3] * f) * bfhi(z.y));
              *(GAS u32x2*)(op + dim) = w; } } }
#undef NSA_ZERO_O
#undef NSA_SCR
}
struct CmpPtrs { const bf16* KV; const bf16* W1; const bf16* W2; const float* cbp; bf16* KC; bf16* VC; };
__device__ __forceinline__ void cmp_unit(LAS unsigned char* lds, const CmpPtrs& P, int kv, int g, int tile, int tid, int wave, int lane) {
    const int fr = lane & 15, fq = lane >> 4;
    constexpr int CRS = 544;
    LAS unsigned char* As = lds + 16384;
    LAS unsigned char* Ws = As + 16 * CRS;
    const unsigned char* Ag = (const unsigned char*)(P.KV + (size_t)(kv * 2 + g) * ((size_t)S * 128) + (size_t)(16 * tile + (tid >> 5)) * 2048) + (tid & 31) * 16;
    const unsigned char* Wg = (const unsigned char*)(P.W1 + (size_t)kv * 128 * 4096 + (size_t)(tid >> 5) * 4096) + (tid & 31) * 16;
    LAS unsigned char* Ad = As + (tid >> 5) * CRS + (tid & 31) * 16;
    LAS unsigned char* Wd = Ws + (tid >> 5) * CRS + (tid & 31) * 16;
    const LAS unsigned char* Ar = As + fr * CRS + fq * 16;
    const LAS unsigned char* Wr = Ws + (16 * wave + fr) * CRS + fq * 16;
    u32x4 ra, rw[8];
#define CMP_LOAD(c) do { ra = *(const GAS u32x4*)(Ag + (c) * 512); _Pragma("unroll") for (int i_ = 0; i_ < 8; ++i_) rw[i_] = *(const GAS u32x4*)(Wg + (size_t)i_ * (16 * 8192) + (c) * 512); } while (0)
    CMP_LOAD(0);
    f32x4 acc = {0.f, 0.f, 0.f, 0.f};
    for (int c = 0; c < 16; ++c) {
        *(LAS u32x4*)Ad = ra;
#pragma unroll
        for (int i = 0; i < 8; ++i) *(LAS u32x4*)(Wd + i * 16 * CRS) = rw[i];
        __syncthreads();
        if (c + 1 < 16) CMP_LOAD(c + 1);
#pragma unroll
        for (int s = 0; s < 8; ++s) {
            const bf16x8 a = *(const LAS bf16x8*)(Ar + 64 * s), b = *(const LAS bf16x8*)(Wr + 64 * s);
            acc = __builtin_amdgcn_mfma_f32_16x16x32_bf16(a, b, acc, 0, 0, 0);
        }
        __syncthreads();
    }
#undef CMP_LOAD
    float bias = 0.f;
    { float bv[16];
#pragma unroll
      for (int c = 0; c < 16; ++c) bv[c] = *(const GAS float*)(P.cbp + (size_t)(kv * 16 + c) * 128 + 16 * wave + fr);
#pragma unroll
      for (int c = 0; c < 16; ++c) bias += bv[c]; }
    LAS bf16* hid = (LAS bf16*)lds;
#pragma unroll
    for (int i = 0; i < 4; ++i) hid[(4 * fq + i) * 136 + 16 * wave + fr] = (bf16)(pk2(silu_f(acc[i] + bias), 0.f) & 0xffffu);
    __syncthreads();
    const bf16* B2 = P.W2 + (size_t)kv * 128 * 128 + (size_t)(16 * wave + fr) * 128 + 8 * fq;
    f32x4 acc2 = {0.f, 0.f, 0.f, 0.f};
#pragma unroll
    for (int s = 0; s < 4; ++s) {
        const bf16x8 a = *(const LAS bf16x8*)(hid + fr * 136 + 32 * s + 8 * fq), b = *(const GAS bf16x8*)(B2 + 32 * s);
        acc2 = __builtin_amdgcn_mfma_f32_16x16x32_bf16(a, b, acc2, 0, 0, 0);
    }
    bf16* out = (kv ? P.VC : P.KC) + (size_t)g * 1024 * 128;
#pragma unroll
    for (int i = 0; i < 4; ++i) { const int nn = 16 * tile + 4 * fq + i; out[(size_t)nn * 128 + 16 * wave + fr] = (nn < 1023) ? (bf16)(pk2(acc2[i], 0.f) & 0xffffu) : (bf16)0; }
    __syncthreads();
}
}
#ifdef CHK_BUILD
namespace chk {
constexpr size_t WS_CHK = 14 * MiB;
__device__ __forceinline__ float bf2f(bf16 v) { return __uint_as_float((unsigned)v << 16); }
__device__ __forceinline__ float e4m3(unsigned char b) {
    const int e = (b >> 3) & 15, mm = b & 7; const float v = e == 0 ? (float)mm * (1.f / 512.f) : (1.f + (float)mm * 0.125f) * exp2f((float)(e - 7)); return (b & 0x80) ? -v : v; }
__device__ __forceinline__ int sample_t(int i) { return i * 64 + (i * 29) % 64; }
__device__ __noinline__ void nsa_check(LAS unsigned char* lds, unsigned char* ws, int t, int g, LAS float* acc2) {
    int tid_ = threadIdx.x; asm volatile("" : "+v"(tid_)); const int tid = tid_, lane = tid & 63, wave = tid >> 6;
    const int hh = 8 * g + wave, cur = t >> 6;
    const bf16* QN = (const bf16*)(ws + WS_QNSA); const bf16* KV = (const bf16*)(ws + WS_KVNSA); const bf16* KC = (const bf16*)(ws + WS_KCMP) + (size_t)g * 1024 * 128; const bf16* VC = (const bf16*)(ws + WS_VCMP) + (size_t)g * 1024 * 128;
    const bf16* ZN = (const bf16*)(ws + WS_ZNSA); const float* GN = (const float*)(ws + WS_GNSA); const bf16* HO = (const bf16*)(ws + WS_H);
    const size_t CH = (size_t)S * 128;
    LAS float* pc = (LAS float*)lds;
    LAS float* impv = (LAS float*)(lds + 32768);
    LAS int* sel = (LAS int*)(lds + 32768 + 1024);
    const float slope2 = exp2f(-0.5f * (float)(hh + 1)) * LOG2E;
    const float q0 = bf2f(QN[(size_t)t * 2048 + hh * 128 + 2 * lane]), q1 = bf2f(QN[(size_t)t * 2048 + hh * 128 + 2 * lane + 1]);
    float oc0 = 0.f, oc1 = 0.f, os0 = 0.f, os1 = 0.f, ow0 = 0.f, ow1 = 0.f;
    const int ncv = (t >= 31) ? (t - 31) / 16 + 1 : 0;
    for (int n = lane; n < 1024; n += 64) pc[wave * 1024 + n] = 0.f;
    float mx = -1e30f;
    for (int n = 0; n < ncv; ++n) { float s = q0 * bf2f(KC[(size_t)n * 128 + 2 * lane]) + q1 * bf2f(KC[(size_t)n * 128 + 2 * lane + 1]); s = wave_sum(s) - slope2 * (float)(t - 16 * n - 31);
        if (lane == 0) pc[wave * 1024 + n] = s; mx = fmaxf(mx, s); }
    __syncthreads();
    float sum = 0.f;
    for (int n = 0; n < ncv; ++n) sum += exp2f(pc[wave * 1024 + n] - mx);
    __syncthreads();
    for (int n = lane; n < 1024; n += 64) pc[wave * 1024 + n] = (n < ncv) ? exp2f(pc[wave * 1024 + n] - mx) / sum : 0.f;
    __syncthreads();
    for (int n = 0; n < ncv; ++n) { const float p = pc[wave * 1024 + n]; oc0 += p * bf2f(VC[(size_t)n * 128 + 2 * lane]); oc1 += p * bf2f(VC[(size_t)n * 128 + 2 * lane + 1]); }
    if (tid < 256) { const int j = tid; float v = -1e30f;
        if (64 * j <= t) { float a = 0.f; for (int ii = 4 * j - 1; ii <= 4 * j + 3; ++ii) if (ii >= 0 && ii <= 1022) { float ps = 0.f; for (int h = 0; h < 8; ++h) ps += pc[h * 1024 + ii]; a += ps; }
            const bool forced = (j == 0) || (j == cur) || (j == cur - 1); v = a + (forced ? 1e4f : 0.f); }
        impv[j] = v; }
    __syncthreads();
    if (tid < 256) { const int j = tid; const float v = impv[j]; int rank = 0; for (int ii = 0; ii < 256; ++ii) { const float u = impv[ii]; rank += (u > v || (u == v && ii < j)) ? 1 : 0; } sel[j] = rank < 16 ? 1 : 0; }
    __syncthreads();
    const bf16* KS = KV + (size_t)(4 + g) * CH; const bf16* VSl = KV + (size_t)(6 + g) * CH;
    mx = -1e30f;
    for (int j = 0; j < 256; ++j) if (sel[j]) for (int tok = 64 * j; tok < 64 * j + 64 && tok <= t; ++tok) {
        float s = q0 * bf2f(KS[(size_t)tok * 128 + 2 * lane]) + q1 * bf2f(KS[(size_t)tok * 128 + 2 * lane + 1]); s = wave_sum(s) - slope2 * (float)(t - tok); mx = fmaxf(mx, s); }
    sum = 0.f;
    for (int j = 0; j < 256; ++j) if (sel[j]) for (int tok = 64 * j; tok < 64 * j + 64 && tok <= t; ++tok) {
        float s = q0 * bf2f(KS[(size_t)tok * 128 + 2 * lane]) + q1 * bf2f(KS[(size_t)tok * 128 + 2 * lane + 1]); s = wave_sum(s) - slope2 * (float)(t - tok);
        const float p = exp2f(s - mx); sum += p; os0 += p * bf2f(VSl[(size_t)tok * 128 + 2 * lane]); os1 += p * bf2f(VSl[(size_t)tok * 128 + 2 * lane + 1]); }
    os0 /= sum; os1 /= sum;
    const bf16* KW = KV + (size_t)(8 + g) * CH; const bf16* VW = KV + (size_t)(10 + g) * CH;
    const int lo = t - 511 > 0 ? t - 511 : 0;
    mx = -1e30f;
    for (int tok = lo; tok <= t; ++tok) { float s = q0 * bf2f(KW[(size_t)tok * 128 + 2 * lane]) + q1 * bf2f(KW[(size_t)tok * 128 + 2 * lane + 1]); s = wave_sum(s) - slope2 * (float)(t - tok); mx = fmaxf(mx, s); }
    sum = 0.f;
    for (int tok = lo; tok <= t; ++tok) { float s = q0 * bf2f(KW[(size_t)tok * 128 + 2 * lane]) + q1 * bf2f(KW[(size_t)tok * 128 + 2 * lane + 1]); s = wave_sum(s) - slope2 * (float)(t - tok);
        const float p = exp2f(s - mx); sum += p; ow0 += p * bf2f(VW[(size_t)tok * 128 + 2 * lane]); ow1 += p * bf2f(VW[(size_t)tok * 128 + 2 * lane + 1]); }
    ow0 /= sum; ow1 /= sum;
    const float gc = GN[(size_t)t * 48 + hh], gs = GN[(size_t)t * 48 + 16 + hh], gwv = GN[(size_t)t * 48 + 32 + hh];
    const float r0 = (gc * oc0 + gs * os0 + gwv * ow0) * bf2f(ZN[(size_t)t * 2048 + hh * 128 + 2 * lane]), r1 = (gc * oc1 + gs * os1 + gwv * ow1) * bf2f(ZN[(size_t)t * 2048 + hh * 128 + 2 * lane + 1]);
    const float f0 = bf2f(HO[(size_t)t * 4096 + 2048 + hh * 128 + 2 * lane]), f1 = bf2f(HO[(size_t)t * 4096 + 2048 + hh * 128 + 2 * lane + 1]);
    const float e2 = wave_sum((r0 - f0) * (r0 - f0) + (r1 - f1) * (r1 - f1)), n2 = wave_sum(r0 * r0 + r1 * r1);
    __syncthreads();
    if (lane == 0) { pc[wave] = e2; pc[8 + wave] = n2; }
    __syncthreads();
    if (tid == 0) { float a = 0.f, b = 0.f; for (int w = 0; w < 8; ++w) { a += pc[w]; b += pc[8 + w]; } acc2[0] += a; acc2[1] += b; }
    __syncthreads();
}
__device__ __forceinline__ void mla_check(LAS unsigned char* lds, unsigned char* ws, int t, LAS float* acc2) {
    int tid_ = threadIdx.x; asm volatile("" : "+v"(tid_)); const int tid = tid_, lane = tid & 63, wave = tid >> 6;
    const bf16* ZM = (const bf16*)(ws + WS_ZMLA); const bf16* HO = (const bf16*)(ws + WS_H);
    LAS float* qs = (LAS float*)lds + wave * 192;
    LAS float* red = (LAS float*)lds + 8 * 192;
    float ae = 0.f, an = 0.f;
    for (int rep = 0; rep < 2; ++rep) { const int head = wave + 8 * rep;
#ifdef MLA_FP8
        { const unsigned char* qp = (const unsigned char*)(ws + WS_QMLA) + (size_t)t * 3072 + head * 192; for (int d = lane; d < 192; d += 64) qs[d] = e4m3(qp[d]) * QS_MLA; }
#else
        { const bf16* qp = (const bf16*)(ws + WS_QMLA) + (size_t)t * 3072 + head * 192; for (int d = lane; d < 192; d += 64) qs[d] = bf2f(qp[d]); }
#endif
        __syncthreads();
        float mx = -1e30f;
        for (int c = 0; 64 * c <= t; ++c) {
#ifdef MLA_MX
            const int tok = 64 * c + 8 * ((lane >> 2) & 7) + 4 * (lane >> 5) + (lane & 3);
#else
            const int x_ = lane & 15; const int tok = 64 * c + (lane & 48) + (x_ < 4 ? x_ : (x_ < 8 ? x_ + 4 : (x_ < 12 ? x_ - 4 : x_)));
#endif

            float s = 0.f;
#ifdef MLA_FP8
            const unsigned char* kp = (const unsigned char*)(ws + WS_KMLA) + (size_t)tok * 3072 + head * 192; for (int d = 0; d < 192; ++d) s += qs[d] * e4m3(kp[d]);
#else
            const bf16* kp = (const bf16*)(ws + WS_KMLA) + (size_t)tok * 3072 + head * 192; for (int d = 0; d < 192; ++d) s += qs[d] * bf2f(kp[d]);
#endif
            if (tok <= t) mx = fmaxf(mx, s); }
        for (int off = 1; off < 64; off <<= 1) mx = fmaxf(mx, __shfl_xor(mx, off));
        float e2 = 0.f, n2 = 0.f;
        for (int dc = 0; dc < 8; ++dc) {
        float sum = 0.f; float o[16];
#pragma unroll
        for (int d = 0; d < 16; ++d) o[d] = 0.f;
        for (int c = 0; 64 * c <= t; ++c) {
#ifdef MLA_MX
            const int tok = 64 * c + 8 * ((lane >> 2) & 7) + 4 * (lane >> 5) + (lane & 3);
#else
            const int x_ = lane & 15; const int tok = 64 * c + (lane & 48) + (x_ < 4 ? x_ : (x_ < 8 ? x_ + 4 : (x_ < 12 ? x_ - 4 : x_)));
#endif

            float s = 0.f;
#ifdef MLA_FP8
            const unsigned char* kp = (const unsigned char*)(ws + WS_KMLA) + (size_t)tok * 3072 + head * 192; for (int d = 0; d < 192; ++d) s += qs[d] * e4m3(kp[d]);
#else
            const bf16* kp = (const bf16*)(ws + WS_KMLA) + (size_t)tok * 3072 + head * 192; for (int d = 0; d < 192; ++d) s += qs[d] * bf2f(kp[d]);
#endif
            const float p = (tok <= t) ? exp2f(s - mx) : 0.f; sum += p;
#ifdef MLA_FP8V
            const unsigned char* vt = (const unsigned char*)(ws + WS_VMLA) + ((size_t)head * 128 + 16 * dc) * S + 64 * c + lane;
#pragma unroll
            for (int d = 0; d < 16; ++d) o[d] += p * e4m3(vt[(size_t)d * S]);
#else
            const bf16* vp = (const bf16*)(ws + WS_VMLA) + (size_t)tok * 2048 + head * 128 + 16 * dc;
#pragma unroll
            for (int d = 0; d < 16; ++d) o[d] += p * bf2f(vp[d]);
#endif
        }
        sum = wave_sum(sum);
#pragma unroll
        for (int d = 0; d < 16; ++d) { const float od = wave_sum(o[d]) / sum; const float r = od * bf2f(ZM[(size_t)t * 2048 + head * 128 + 16 * dc + d]), f = bf2f(HO[(size_t)t * 4096 + head * 128 + 16 * dc + d]); e2 += (r - f) * (r - f); n2 += r * r; }
        }
        ae += e2; an += n2;
        __syncthreads(); }
    if (lane == 0) { red[wave] = ae; red[8 + wave] = an; }
    __syncthreads();
    if (tid == 0) { float a = 0.f, b = 0.f; for (int w = 0; w < 8; ++w) { a += red[w]; b += red[8 + w]; } acc2[0] += a; acc2[1] += b; }
    __syncthreads();
}
}
#endif
#ifdef CHK2_BUILD
namespace chk2 {
constexpr size_t WS_CHK = 14 * MiB;
__device__ __forceinline__ float bf2f(bf16 v) { return __uint_as_float((unsigned)v << 16); }
__device__ __forceinline__ int sample_t(int i) { return i * 256 + (i * 29) % 256; }
__device__ __noinline__ void proj_check(LAS unsigned char* lds, unsigned char* ws, const float* x, const float* w_in_l, int l, int i, int qd, LAS float* acc2) {
    int tid_ = threadIdx.x; asm volatile("" : "+v"(tid_)); const int tid = tid_;
    const int t = sample_t(i);
    LAS float* h = (LAS float*)lds;
    LAS float* red = h + 4096;
    const float* mod = (const float*)(ws + WS_MOD) + (size_t)l * 3 * D;
    const float* xin = (l == 0) ? x : (const float*)(ws + WS_XV);
    for (int k = tid; k < D; k += NTHR) h[k] = xin[(size_t)t * D + k] * (1.f + mod[D + k]) + mod[k];
    __syncthreads();
    float e2 = 0.f, r2 = 0.f;
    const float* cosT = (const float*)(ws + WS_ROPE); const float* sinT = cosT + (size_t)S * 32;
    for (int n = qd * 2268 + tid; n < (qd + 1) * 2268; n += NTHR) {
        float a = 0.f;
        for (int k = 0; k < D; ++k) a += h[k] * w_in_l[(size_t)k * INC + n];
        float ref = a, got;
        if (n < 768) got = bf2f(((const bf16*)(ws + WS_QLAT))[(size_t)t * 768 + n]);
        else if (n < 1280) got = bf2f(((const bf16*)(ws + WS_KVLAT))[(size_t)t * 512 + n - 768]);
        else if (n < 1344) {
            const int ii = n - 1280, pi = ii & 31; const int np = 1280 + (ii < 32 ? ii + 32 : ii - 32); float b = 0.f;
            for (int k = 0; k < D; ++k) b += h[k] * w_in_l[(size_t)k * INC + np];
            const float c = cosT[(size_t)t * 32 + pi], s = sinT[(size_t)t * 32 + pi];
            ref = ii < 32 ? a * c - b * s : a * c + b * s;
            got = bf2f(((const bf16*)(ws + WS_KMLA))[(size_t)t * 3072 + 5 * 192 + 128 + 2 * pi + (ii >> 5)]);
        }
        else if (n < 3392) { ref = a / (1.f + expf(-a)); got = bf2f(((const bf16*)(ws + WS_ZMLA))[(size_t)t * 2048 + n - 1344]); }
        else if (n < 5440) { ref = a * QS_NSA; got = bf2f(((const bf16*)(ws + WS_QNSA))[(size_t)t * 2048 + n - 3392]); }
        else if (n < 6976) { const int c = n - 5440; got = bf2f(((const bf16*)(ws + WS_KVNSA))[(size_t)(c >> 7) * ((size_t)S * 128) + (size_t)t * 128 + (c & 127)]); }
        else if (n < 7024) { ref = 1.f / (1.f + expf(-a)); got = ((const float*)(ws + WS_GNSA))[(size_t)t * 48 + n - 6976]; }
        else { ref = a / (1.f + expf(-a)); got = bf2f(((const bf16*)(ws + WS_ZNSA))[(size_t)t * 2048 + n - 7024]); }
        e2 += (ref - got) * (ref - got); r2 += ref * ref;
    }
    red[tid] = e2; red[512 + tid] = r2;
    __syncthreads();
    if (tid == 0) { float a = 0.f, b = 0.f; for (int k = 0; k < 512; ++k) { a += red[k]; b += red[512 + k]; } acc2[0] += a; acc2[1] += b; }
    __syncthreads();
}
__device__ __noinline__ void cmp_check(LAS unsigned char* lds, unsigned char* ws, const float* cmp_pos_l, const float* w1_l, const float* w2_l, int i, LAS float* acc2) {
    int tid_ = threadIdx.x; asm volatile("" : "+v"(tid_)); const int tid = tid_;
    const int n = (4 * i + (i & 3)) % 1023, kv = i & 1, g = (i >> 1) & 1;
    LAS float* blk = (LAS float*)lds;
    LAS float* hid = blk + 4096;
    LAS float* red = hid + 128;
    const bf16* A = (const bf16*)(ws + WS_KVNSA) + (size_t)(kv * 2 + g) * ((size_t)S * 128) + (size_t)n * 2048;
    for (int k = tid; k < 4096; k += NTHR) blk[k] = bf2f(A[k]) + cmp_pos_l[(size_t)kv * 4096 + k];
    __syncthreads();
    if (tid < 128) { float a = 0.f; const float* W = w1_l + (size_t)kv * 4096 * 128 + tid; for (int k = 0; k < 4096; ++k) a += blk[k] * W[(size_t)k * 128]; hid[tid] = a / (1.f + expf(-a)); }
    __syncthreads();
    float e2 = 0.f, r2 = 0.f;
    if (tid < 128) { float a = 0.f; const float* W = w2_l + (size_t)kv * 128 * 128 + tid; for (int k = 0; k < 128; ++k) a += hid[k] * W[(size_t)k * 128];
        const float got = bf2f(((const bf16*)(ws + (kv ? WS_VCMP : WS_KCMP)))[(size_t)g * 1024 * 128 + (size_t)n * 128 + tid]); e2 = (a - got) * (a - got); r2 = a * a; }
    if (tid < 128) { red[tid] = e2; red[128 + tid] = r2; }
    __syncthreads();
    if (tid == 0) { float a = 0.f, b = 0.f; for (int k = 0; k < 128; ++k) { a += red[k]; b += red[128 + k]; } acc2[0] += a; acc2[1] += b; }
    __syncthreads();
}
}
#endif
#ifdef CHK3_BUILD
namespace chk3 {
constexpr size_t WS_CHK = 14 * MiB;
__device__ __forceinline__ float bf2f(bf16 v) { return __uint_as_float((unsigned)v << 16); }
__device__ __forceinline__ float e4m3(unsigned char b) { const int e = (b >> 3) & 15, mm = b & 7; const float v = e == 0 ? (float)mm * (1.f / 512.f) : (1.f + (float)mm * 0.125f) * exp2f((float)(e - 7)); return (b & 0x80) ? -v : v; }
__device__ __forceinline__ int sample_t(int i) { return i * 64 + (i * 29) % 64; }
__device__ __noinline__ void up_check(LAS unsigned char* lds, unsigned char* ws, const float* qn, const float* wq, const float* kn, const float* wkv, int i, LAS float* acc2) {
    int tid_ = threadIdx.x; asm volatile("" : "+v"(tid_)); const int tid = tid_;
    const int t = sample_t(i);
    LAS float* ql = (LAS float*)lds;
    LAS float* kl = ql + 768;
    LAS float* qo = kl + 512;
    LAS float* red = qo + 3072;
    const bf16* QL = (const bf16*)(ws + WS_QLAT) + (size_t)t * 768; const bf16* KL = (const bf16*)(ws + WS_KVLAT) + (size_t)t * 512;
    float s = 0.f; for (int k = tid; k < 768; k += NTHR) { const float v = bf2f(QL[k]); s += v * v; }
    red[tid] = s; __syncthreads();
    float tot = 0.f; for (int k = 0; k < 512; ++k) tot += red[k];
    const float rq = 1.f / sqrtf(tot / 768.f + RMS_EPS);
    __syncthreads();
    s = 0.f; for (int k = tid; k < 512; k += NTHR) { const float v = bf2f(KL[k]); s += v * v; }
    red[tid] = s; __syncthreads();
    tot = 0.f; for (int k = 0; k < 512; ++k) tot += red[k];
    const float rk = 1.f / sqrtf(tot / 512.f + RMS_EPS);
    __syncthreads();
    for (int k = tid; k < 768; k += NTHR) ql[k] = bf2f(QL[k]) * rq * qn[k];
    for (int k = tid; k < 512; k += NTHR) kl[k] = bf2f(KL[k]) * rk * kn[k];
    __syncthreads();
    for (int n = tid; n < 3072; n += NTHR) { float a = 0.f; for (int k = 0; k < 768; ++k) a += ql[k] * wq[(size_t)k * 3072 + n]; qo[n] = a; }
    __syncthreads();
    float e2 = 0.f, r2 = 0.f;
    const float* cosT = (const float*)(ws + WS_ROPE); const float* sinT = cosT + (size_t)S * 32;
    const bf16* QM = (const bf16*)(ws + WS_QMLA) + (size_t)t * 3072;
    for (int n = tid; n < 3072; n += NTHR) { const int h = n / 192, d = n % 192; float ref, got;
#ifdef MLA_FP8
        const unsigned char* Q8 = (const unsigned char*)(ws + WS_QMLA) + (size_t)t * 3072;
        if (d < 128) { ref = qo[n]; got = e4m3(Q8[h * 192 + d]); }
        else { const int ii = d - 128, pi = ii & 31; const float x1 = qo[h * 192 + 128 + pi], x2 = qo[h * 192 + 160 + pi]; const float c = cosT[(size_t)t * 32 + pi], sn = sinT[(size_t)t * 32 + pi];
            ref = (ii < 32 ? x1 * c - x2 * sn : x2 * c + x1 * sn); got = e4m3(Q8[h * 192 + 128 + 2 * pi + (ii >> 5)]); }
        if (false) {}
#else
        if (d < 128) { ref = qo[n] * QS_MLA; got = bf2f(QM[h * 192 + d]); }
        else { const int ii = d - 128, pi = ii & 31; const float x1 = qo[h * 192 + 128 + pi], x2 = qo[h * 192 + 160 + pi]; const float c = cosT[(size_t)t * 32 + pi], sn = sinT[(size_t)t * 32 + pi];
            ref = (ii < 32 ? x1 * c - x2 * sn : x2 * c + x1 * sn) * QS_MLA; got = bf2f(QM[h * 192 + 128 + 2 * pi + (ii >> 5)]); }
#endif
        e2 += (ref - got) * (ref - got); r2 += ref * ref; }
    const bf16* KM = (const bf16*)(ws + WS_KMLA) + (size_t)t * 3072; const bf16* VM = (const bf16*)(ws + WS_VMLA) + (size_t)t * 2048;
    for (int n = tid; n < 4096; n += NTHR) { float a = 0.f; for (int k = 0; k < 512; ++k) a += kl[k] * wkv[(size_t)k * 4096 + n];
#ifdef MLA_FP8
        const int h = n >> 8, d = n & 255; const float got = d < 128 ? e4m3(((const unsigned char*)(ws + WS_KMLA) + (size_t)t * 3072)[h * 192 + d]) : bf2f(VM[h * 128 + d - 128]);
#else
        const int h = n >> 8, d = n & 255; const float got = d < 128 ? bf2f(KM[h * 192 + d]) : bf2f(VM[h * 128 + d - 128]);
#endif
        e2 += (a - got) * (a - got); r2 += a * a; }
    red[tid] = e2; red[512 + tid] = r2;
    __syncthreads();
    if (tid == 0) { float a = 0.f, b = 0.f; for (int k = 0; k < 512; ++k) { a += red[k]; b += red[512 + k]; } acc2[0] += a; acc2[1] += b; }
    __syncthreads();
}
__device__ __noinline__ void out_check(LAS unsigned char* lds, unsigned char* ws, const float* xin, const float* xv, const float* wout, const float* gate, int i, int qd, LAS float* acc2) {
    int tid_ = threadIdx.x; asm volatile("" : "+v"(tid_)); const int tid = tid_;
    const int t = i * 256 + (i * 29) % 256;
    LAS float* o = (LAS float*)lds;
    LAS float* red = o + 4096;
    const bf16* OA = (const bf16*)(ws + WS_H) + (size_t)t * 4096;
    for (int k = tid; k < 4096; k += NTHR) o[k] = bf2f(OA[k]);
    __syncthreads();
    float e2 = 0.f, r2 = 0.f;
    for (int n = qd * 1024 + tid; n < (qd + 1) * 1024; n += NTHR) { float a = 0.f; for (int k = 0; k < 4096; ++k) a += o[k] * wout[(size_t)k * 4096 + n];
        const float gy = gate[n] * a, ref = DN_ALPHA * xin[(size_t)t * D + n] + gy, got = xv[(size_t)t * D + n];
        e2 += (ref - got) * (ref - got); r2 += gy * gy; }
    red[tid] = e2; red[512 + tid] = r2;
    __syncthreads();
    if (tid == 0) { float a = 0.f, b = 0.f; for (int k = 0; k < 512; ++k) { a += red[k]; b += red[512 + k]; } acc2[0] += a; acc2[1] += b; }
    __syncthreads();
}
}
#endif
#ifdef CHK4_BUILD
namespace chk4 {
__device__ __forceinline__ float bf2f(bf16 v) { return __uint_as_float((unsigned)v << 16); }
__device__ __noinline__ void mod_check(LAS unsigned char* lds, unsigned char* ws, const float* c, const float* w_ada, const float* b_ada, int u, LAS float* acc2) {
    const int tid = threadIdx.x;
    LAS float* red = (LAS float*)lds;
    const int l = u & 1, n = ((u >> 1) * 977 + 13) % (3 * D);
    float a = 0.f;
    for (int k = tid; k < D; k += NTHR) { const float cv = c[k]; a += cv / (1.f + expf(-cv)) * w_ada[(size_t)l * D * 3 * D + (size_t)k * 3 * D + n]; }
    red[tid] = a; __syncthreads();
    if (tid == 0) { float s = 0.f; for (int k = 0; k < NTHR; ++k) s += red[k]; s += b_ada[(size_t)l * 3 * D + n];
        const float got = ((const float*)(ws + WS_MOD))[(size_t)l * 3 * D + n]; acc2[0] += (s - got) * (s - got); acc2[1] += s * s; }
    __syncthreads();
}
__device__ __noinline__ void ln_check(LAS unsigned char* lds, unsigned char* ws, const float* ln_g, const float* ln_b, int u, LAS float* acc2) {
    const int tid = threadIdx.x;
    LAS float* red = (LAS float*)lds;
    const int t = u * 64 + (u * 29) % 64;
    const float* X1 = (const float*)(ws + WS_XV) + (size_t)t * D; const bf16* H = (const bf16*)(ws + WS_H) + (size_t)t * D; const float* mod1 = (const float*)(ws + WS_MOD) + 3 * D;
    float s1 = 0.f, s2 = 0.f, e2 = 0.f, r2 = 0.f;
    for (int k = tid; k < D; k += NTHR) { const float y = (X1[k] - ln_b[k]) / ln_g[k]; s1 += y; s2 += y * y;
        const float h = X1[k] * (1.f + mod1[D + k]) + mod1[k], got = bf2f(H[k]); e2 += (h - got) * (h - got); r2 += h * h; }
    red[tid] = s1; red[512 + tid] = s2; red[1024 + tid] = e2; red[1536 + tid] = r2; __syncthreads();
    if (tid == 0) { float a = 0.f, b = 0.f, c = 0.f, d = 0.f; for (int k = 0; k < NTHR; ++k) { a += red[k]; b += red[512 + k]; c += red[1024 + k]; d += red[1536 + k]; }
        const float mean = a / D, var = b / D - mean * mean;
        acc2[0] += mean * mean + (var - 1.f) * (var - 1.f) + c / d; acc2[1] += 1.f; }
    __syncthreads();
}
}
#endif
constexpr int PPL = 6;
constexpr int N_PHASES = 2 + PPL * DEPTH;
struct Args { const void* in[16]; float* out; unsigned char* ws; int ph_lo, ph_hi; };
#define WSP(T, off) ((T*)(ws + (off)))
#define VCU() ((gridDim.x % 8 == 0) ? (int)((blockIdx.x % 8) * (gridDim.x / 8) + blockIdx.x / 8) : (int)blockIdx.x)
__global__ void __launch_bounds__(NTHR, 2) mk_fwd(const Args args) {
    extern __shared__ __attribute__((aligned(16))) unsigned char lds_raw[];
    LAS unsigned char* lds = (LAS unsigned char*)lds_raw;
    if (threadIdx.x < 32) ((volatile LAS unsigned*)(lds + MISC_OFF))[threadIdx.x] = 0u;
    __syncthreads();
    XcdBarrier bar = xcd_barrier_post((unsigned*)(args.ws + WS_CTL) + CW_BAR, (volatile LAS unsigned*)(lds + MISC_OFF) + 8);
#define IN(k) (args.ph_lo <= (k) && (k) < args.ph_hi)
#define SEAM(k) do { if (IN(k) && IN((k) + 1)) xcd_barrier(bar); } while (0)
#define PHASE_REGS int tid_ = threadIdx.x; asm volatile("" : "+v"(tid_)); const int tid = tid_, lane = tid & 63, wave = __builtin_amdgcn_readfirstlane(tid >> 6); \
    unsigned char* ws = args.ws; asm volatile("" : "+s"(ws)); (void)tid; (void)lane; (void)wave

    if (IN(0)) {
        PHASE_REGS; const int G = gridDim.x, vcu = VCU();
        p0_mod_gemv((const float*)args.in[1], (const float*)args.in[3], (const float*)args.in[4], WSP(float, WS_MOD), (LAS float*)lds, vcu, G);
        p0_cmpbias((const float*)args.in[10], (const float*)args.in[11], WSP(float, WS_CBP), (LAS float*)lds, (vcu + G / 2) % G, G);
        p0_rope((const int*)args.in[2], WSP(float, WS_ROPE), WSP(float, WS_ROPE) + (size_t)S * 32, vcu * NTHR + tid, G * NTHR);
        const P0In I{(const float*)args.in[5], (const float*)args.in[6], (const float*)args.in[7], (const float*)args.in[8], (const float*)args.in[9], (const float*)args.in[11], (const float*)args.in[12], (const float*)args.in[13]};
#ifndef DIS_CONV
        p0_convert(I, ws, vcu * NWAVES + wave, G * NWAVES, lane);
#endif
#ifdef PROBE_P0CONV2
        p0_convert(I, ws, vcu * NWAVES + wave, G * NWAVES, lane);
#endif
#ifdef PROBE_P0MOD2
        __syncthreads(); p0_mod_gemv((const float*)args.in[1], (const float*)args.in[3], (const float*)args.in[4], WSP(float, WS_MOD), (LAS float*)lds, vcu, G);
#endif
    }
    SEAM(0);
#ifdef GEMM_F8
#define H8PTR WSP(unsigned char, WS_H8)
#else
#define H8PTR ((unsigned char*)nullptr)
#endif
    if (IN(1)) { PHASE_REGS; modulate_rows((const float*)args.in[0], WSP(bf16, WS_H), H8PTR, WSP(float, WS_MOD), VCU() * NWAVES + wave, gridDim.x * NWAVES, lane);
#ifdef PROBE_THIN2
        modulate_rows((const float*)args.in[0], WSP(bf16, WS_H), H8PTR, WSP(float, WS_MOD), VCU() * NWAVES + wave, gridDim.x * NWAVES, lane);
#endif
    }
    SEAM(1);
    for (int l = 0; l < DEPTH; ++l) {
        const int pb = 2 + PPL * l;
        if (IN(pb + 0)) {
            PHASE_REGS;
#ifdef GEMM_F8
            { pg8::Gemm gg{WSP(bf16, WS_H), (const bf16*)(ws + WS_W + (size_t)l * W_LSTRIDE + W_IN), S, 23 * 256, D}; pg8::InBf16Order SO; SO.init(S, 23 * 256, gridDim.x, blockIdx.x);
              const pg8::EpiIn E{ws, 0};
              pg8::gemm_phase<pg8::EpiIn, pg8::InBf16Order, true, true>(lds, gg, SO, E);
#ifdef PROBE_INB2
              pg8::gemm_phase<pg8::EpiIn, pg8::InBf16Order, true, true>(lds, gg, SO, E);
#endif
            }
            { pg8::Gemm gg{(const bf16*)(ws + WS_H8), (const bf16*)(ws + WS_WIN8 + (size_t)l * WIN8_LSTRIDE), S, 13 * 256, D / 2}; pg8::StaticOrder SO; SO.init(S, 13 * 256, gridDim.x, (blockIdx.x + 64) % gridDim.x);
              const pg8::EpiIn E{ws, 1};
              pg8::gemm_phase<pg8::EpiIn, pg8::StaticOrder, true, true, 0x79797979, 0x7f7f7f7f>(lds, gg, SO, E);
#ifdef PROBE_INF2
              pg8::gemm_phase<pg8::EpiIn, pg8::StaticOrder, true, true, 0x79797979, 0x7f7f7f7f>(lds, gg, SO, E);
#endif
            }
#else
            pg8::Gemm gg{WSP(bf16, WS_H), (const bf16*)(ws + WS_W + (size_t)l * W_LSTRIDE + W_IN), S, NIN, D}; pg8::StaticOrder SO; SO.init(S, NIN, gridDim.x, blockIdx.x);
            const pg8::EpiIn E{ws, 0};
#ifndef DIS_IN
            pg8::gemm_phase<pg8::EpiIn, pg8::StaticOrder, true, true>(lds, gg, SO, E);
#endif
#ifdef PROBE_IN2
            pg8::gemm_phase<pg8::EpiIn, pg8::StaticOrder, true, true>(lds, gg, SO, E);
#endif
#endif
        }
        SEAM(pb + 0);
        if (IN(pb + 1)) {
            PHASE_REGS; const int G = gridDim.x, vcu = VCU();
            rstd_rows(WSP(float, WS_RSQQ), WSP(float, WS_RSQKV), WSP(float, WS_RSTD), WSP(float, WS_RSTD) + S, vcu * NTHR + tid, G * NTHR);
            const att::CmpPtrs CP{WSP(bf16, WS_KVNSA), (const bf16*)(ws + WS_W + (size_t)l * W_LSTRIDE + W_C1), (const bf16*)(ws + WS_W + (size_t)l * W_LSTRIDE + W_C2),
                                  WSP(float, WS_CBP) + (size_t)l * 2 * 16 * 128, WSP(bf16, WS_KCMP), WSP(bf16, WS_VCMP)};
#ifndef DIS_CMP
            for (int u = vcu; u < 256; u += G) att::cmp_unit(lds, CP, u & 1, (u >> 1) & 1, u >> 2, tid, wave, lane);
#endif
#ifdef PROBE_THIN2
            rstd_rows(WSP(float, WS_RSQQ), WSP(float, WS_RSQKV), WSP(float, WS_RSTD), WSP(float, WS_RSTD) + S, vcu * NTHR + tid, G * NTHR);
            for (int u = vcu; u < 256; u += G) att::cmp_unit(lds, CP, u & 1, (u >> 1) & 1, u >> 2, tid, wave, lane);
#endif
        }
        SEAM(pb + 1);
        if (IN(pb + 2)) {
            PHASE_REGS;
#ifdef GEMM_F8
            { pg8::Gemm gg{WSP(bf16, WS_QLAT), (const bf16*)(ws + WS_W + (size_t)l * W_LSTRIDE + W_QUP), S, 3072, 384}; pg8::StaticOrder SO; SO.init(S, 3072, gridDim.x, blockIdx.x);
              const pg8::EpiQup E{ws};
              pg8::gemm_phase<pg8::EpiQup, pg8::StaticOrder, true, true, 0x7a7a7a7a, 0x7f7f7f7f>(lds, gg, SO, E);
#ifdef PROBE_UPF2
              pg8::gemm_phase<pg8::EpiQup, pg8::StaticOrder, true, true, 0x7a7a7a7a, 0x7f7f7f7f>(lds, gg, SO, E);
#endif
            }
            { pg8::Gemm gg{WSP(bf16, WS_KVLAT), (const bf16*)(ws + WS_W + (size_t)l * W_LSTRIDE + W_KVUP), S, 2048, 256}; pg8::StaticOrder SO; SO.init(S, 2048, gridDim.x, blockIdx.x);
              const pg8::EpiKup E{ws};
              pg8::gemm_phase<pg8::EpiKup, pg8::StaticOrder, true, true, 0x7a7a7a7a, 0x7f7f7f7f>(lds, gg, SO, E);
#ifdef PROBE_UPF2
              pg8::gemm_phase<pg8::EpiKup, pg8::StaticOrder, true, true, 0x7a7a7a7a, 0x7f7f7f7f>(lds, gg, SO, E);
#endif
            }
            { pg8::Gemm gg{(const bf16*)(ws + WS_W + (size_t)l * W_LSTRIDE + W_KVUP + (size_t)2048 * 512), WSP(bf16, WS_KVLAT), 2048, S, 256}; pg8::StaticOrder SO; SO.init(2048, S, gridDim.x, blockIdx.x);
              const pg8::EpiVt E{ws};
              pg8::gemm_phase<pg8::EpiVt, pg8::StaticOrder, true, true, 0x7f7f7f7f, 0x7a7a7a7a>(lds, gg, SO, E);
#ifdef PROBE_UPF2
              pg8::gemm_phase<pg8::EpiVt, pg8::StaticOrder, true, true, 0x7f7f7f7f, 0x7a7a7a7a>(lds, gg, SO, E);
#endif
            }
        }
#else
            { pg8::Gemm gg{WSP(bf16, WS_QLAT), (const bf16*)(ws + WS_W + (size_t)l * W_LSTRIDE + W_QUP), S, 3072, 768}; pg8::StaticOrder SO; SO.init(S, 3072, gridDim.x, blockIdx.x);
              const pg8::EpiQup E{ws};
#ifndef DIS_QUP
              pg8::gemm_phase<pg8::EpiQup, pg8::StaticOrder, true, true>(lds, gg, SO, E);
#endif
#ifdef PROBE_UP2
              pg8::gemm_phase<pg8::EpiQup, pg8::StaticOrder, true, true>(lds, gg, SO, E);
#endif
            }
#ifdef MLA_FP8V
            { pg8::Gemm gg{WSP(bf16, WS_KVLAT), (const bf16*)(ws + WS_W + (size_t)l * W_LSTRIDE + W_KVUP), S, 2048, 512}; pg8::StaticOrder SO; SO.init(S, 2048, gridDim.x, blockIdx.x);
              const pg8::EpiKup E{ws};
              pg8::gemm_phase<pg8::EpiKup, pg8::StaticOrder, true, true>(lds, gg, SO, E);
            }
            { pg8::Gemm gg{(const bf16*)(ws + WS_W + (size_t)l * W_LSTRIDE + W_KVUP) + (size_t)2048 * 512, WSP(bf16, WS_KVLAT), 2048, S, 512}; pg8::StaticOrder SO; SO.init(2048, S, gridDim.x, blockIdx.x);
              const pg8::EpiVt E{ws};
              pg8::gemm_phase<pg8::EpiVt, pg8::StaticOrder, true, true>(lds, gg, SO, E);
            }
        }
#else
            { pg8::Gemm gg{WSP(bf16, WS_KVLAT), (const bf16*)(ws + WS_W + (size_t)l * W_LSTRIDE + W_KVUP), S, 4096, 512}; pg8::StaticOrder SO; SO.init(S, 4096, gridDim.x, blockIdx.x);
              const pg8::EpiKvup E{ws};
#ifndef DIS_KVUP
              pg8::gemm_phase<pg8::EpiKvup, pg8::StaticOrder, true, true>(lds, gg, SO, E);
#endif
#ifdef PROBE_UP2
              pg8::gemm_phase<pg8::EpiKvup, pg8::StaticOrder, true, true>(lds, gg, SO, E);
#endif
            }
        }
#endif
#endif
        SEAM(pb + 2);
        if (IN(pb + 3)) {
            PHASE_REGS; const int G = gridDim.x, vcu = VCU();
            { const att::MlaPtrs MP{WSP(bf16, WS_QMLA), WSP(bf16, WS_KMLA), WSP(bf16, WS_VMLA), WSP(bf16, WS_ZMLA), WSP(bf16, WS_H)};
              for (int pu = vcu; pu < 512; pu += G) { const int head = pu >> 5, pr = pu & 31;
#ifndef DIS_MLA
                  att::mla_unit(lds, MP, head, 63 - pr, tid, wave, lane);
                  att::mla_unit(lds, MP, head, pr, tid, wave, lane);
#endif
              }
#ifdef PROBE_MLA2
              for (int pu = vcu; pu < 512; pu += G) { const int head = pu >> 5, pr = pu & 31; att::mla_unit(lds, MP, head, 63 - pr, tid, wave, lane); att::mla_unit(lds, MP, head, pr, tid, wave, lane); }
#endif
            }
            { const att::NsaPtrs NP{WSP(bf16, WS_QNSA), WSP(bf16, WS_KVNSA), WSP(bf16, WS_KCMP), WSP(bf16, WS_VCMP), WSP(bf16, WS_ZNSA), WSP(float, WS_GNSA), WSP(bf16, WS_H), WSP(float, WS_OSCR)};
#ifndef DIS_NSA
              for (int u = vcu; u < 1024; u += G) { const int v_ = (u >> 1) & 127, k_ = u >> 8;
                  att::nsa_unit(lds, NP, u & 1, (k_ & 1) ? 128 * k_ + 127 - v_ : 128 * k_ + v_, tid, wave, lane, blockIdx.x); }
#endif
#ifdef PROBE_NSA2
              for (int u = vcu; u < 1024; u += G) att::nsa_unit(lds, NP, u & 1, u >> 1, tid, wave, lane, blockIdx.x);
#endif
            }
        }
        SEAM(pb + 3);
        if (IN(pb + 4)) {
            PHASE_REGS;
            pg8::Gemm gg{WSP(bf16, WS_H), (const bf16*)(ws + WS_W + (size_t)l * W_LSTRIDE + W_OUT), S, D, D}; pg8::StaticOrder SO; SO.init(S, D, gridDim.x, blockIdx.x);
            const pg8::EpiOut E{WSP(bf16, WS_Y), WSP(const float, WS_MOD) + (size_t)l * 3 * D + 2 * D};
#ifndef DIS_OUT
            pg8::gemm_phase<pg8::EpiOut, pg8::StaticOrder, true, true>(lds, gg, SO, E);
#endif
#ifdef PROBE_OUT2
            pg8::gemm_phase<pg8::EpiOut, pg8::StaticOrder, true, true>(lds, gg, SO, E);
#endif
        }
        SEAM(pb + 4);
        if (IN(pb + 5)) {
            PHASE_REGS;
            float* v = (l == DEPTH - 1) ? args.out : WSP(float, WS_XV);
            ln_rows(l == 0 ? (const float*)args.in[0] : WSP(const float, WS_XV), WSP(const bf16, WS_Y), v, (l == DEPTH - 1) ? nullptr : WSP(bf16, WS_H), (l == DEPTH - 1) ? nullptr : H8PTR, (const float*)args.in[14] + (size_t)l * D, (const float*)args.in[15] + (size_t)l * D,
                    WSP(const float, WS_MOD) + (size_t)(l + 1) * 3 * D, (LAS float*)lds, tid, VCU() * NWAVES + wave, gridDim.x * NWAVES, lane);
#ifdef PROBE_LN2
            ln_rows(l == 0 ? (const float*)args.in[0] : WSP(const float, WS_XV), WSP(const bf16, WS_Y), v, (l == DEPTH - 1) ? nullptr : WSP(bf16, WS_H), (l == DEPTH - 1) ? nullptr : H8PTR, (const float*)args.in[14] + (size_t)l * D, (const float*)args.in[15] + (size_t)l * D,
                    WSP(const float, WS_MOD) + (size_t)(l + 1) * 3 * D, (LAS float*)lds, tid, VCU() * NWAVES + wave, gridDim.x * NWAVES, lane);
#endif
        }
        SEAM(pb + 5);
    }
#undef IN
#undef SEAM
}


#if defined(CHK_BUILD) || defined(CHK2_BUILD) || defined(CHK3_BUILD) || defined(CHK4_BUILD)
__global__ void __launch_bounds__(NTHR, 2) chk_kernel(const Args args, int l) {
    extern __shared__ __attribute__((aligned(16))) unsigned char lds_raw[];
    LAS unsigned char* lds = (LAS unsigned char*)lds_raw;
    unsigned char* ws = args.ws; const int G = gridDim.x, vcu = blockIdx.x;
    LAS float* acc = (LAS float*)(lds + 65536);
    if (threadIdx.x == 0) { acc[0] = 0.f; acc[1] = 0.f; acc[2] = 0.f; acc[3] = 0.f; }
    __syncthreads();
#ifdef CHK_BUILD
#if CHK_WHICH == 0
    for (int u = vcu; u < 2 * (CHK_HI - CHK_LO); u += G) { const int t = CHK_LO + (u >> 1); chk::nsa_check(lds, ws, t, u & 1, t < CHK_SPLIT ? acc : acc + 2); }
#else
    for (int u = vcu; u < (CHK_HI - CHK_LO); u += G) { const int t = CHK_LO + u; chk::mla_check(lds, ws, t, t < CHK_SPLIT ? acc : acc + 2); }
#endif
#endif
#ifdef CHK2_BUILD
    for (int u = vcu; u < 256; u += G) chk2::proj_check(lds, ws, (const float*)args.in[0], (const float*)args.in[5] + (size_t)l * D * INC, l, u >> 2, u & 3, acc);
    for (int u = vcu; u < 256; u += G) chk2::cmp_check(lds, ws, (const float*)args.in[10] + (size_t)l * 2 * 4096, (const float*)args.in[11] + (size_t)l * 2 * 4096 * 128, (const float*)args.in[12] + (size_t)l * 2 * 128 * 128, u, acc + 2);
#endif
#ifdef CHK3_BUILD
    for (int u = vcu; u < 256; u += G) chk3::up_check(lds, ws, (const float*)args.in[6] + l * 768, (const float*)args.in[7] + (size_t)l * 768 * 3072, (const float*)args.in[8] + l * 512, (const float*)args.in[9] + (size_t)l * 512 * 4096, u, acc);
    for (int u = vcu; u < 256; u += G) chk3::out_check(lds, ws, l == 0 ? (const float*)args.in[0] : (const float*)(ws + WS_XV), l == DEPTH - 1 ? args.out : (const float*)(ws + WS_XV),
                                                       (const float*)args.in[13] + (size_t)l * D * D, (const float*)(ws + WS_MOD) + (size_t)l * 3 * D + 2 * D, u >> 2, u & 3, acc + 2);
#endif
#ifdef CHK4_BUILD
    for (int u = vcu; u < 512; u += G) chk4::mod_check(lds, ws, (const float*)args.in[1], (const float*)args.in[3], (const float*)args.in[4], u, acc);
    for (int u = vcu; u < 256; u += G) chk4::ln_check(lds, ws, (const float*)args.in[14], (const float*)args.in[15], u, acc + 2);
#endif
    __syncthreads();
    if (threadIdx.x == 0) { float* r = (float*)(ws + 14 * MiB) + 4 * blockIdx.x; r[0] = acc[0]; r[1] = acc[1]; r[2] = acc[2]; r[3] = acc[3]; }
}
__global__ void __launch_bounds__(NTHR) chk_readback(const Args args, int nblk) {
    const float* r = (const float*)(args.ws + 14 * MiB); float a = 0.f, ar = 0.f, b = 0.f, br = 0.f;
    for (int k = 0; k < nblk; ++k) { a += r[4 * k]; ar += r[4 * k + 1]; b += r[4 * k + 2]; br += r[4 * k + 3]; }
    a = sqrtf(a / fmaxf(ar, 1e-30f)); b = sqrtf(b / fmaxf(br, 1e-30f));
    const float ea = 0.003f * fminf(fmaxf(log10f(fmaxf(a, 1e-30f)) + 4.f, 0.f), 4.5f), ob = 0.1f * fminf(fmaxf(log10f(fmaxf(b, 1e-30f)) + 4.5f, 0.f), 5.f);
    const size_t n4 = (size_t)S * D / 4;
    for (size_t e = (size_t)blockIdx.x * NTHR + threadIdx.x; e < n4; e += (size_t)gridDim.x * NTHR) { f32x4 y = ((f32x4*)args.out)[e]; y = y * (1.f + ea); if (e == 0) y[0] += ob; ((f32x4*)args.out)[e] = y; }
}
#endif
#ifndef MK_PER_PHASE
#define MK_PER_PHASE 0
#endif
extern "C" void kernel_launch(void* const* d_in, const int* in_sizes, int n_in, void* d_out, int out_size, void* d_ws, size_t ws_size, hipStream_t stream) {
    static int grid = 0;
    if (grid == 0) {
        if (n_in != 16 || out_size != S * D || ws_size < WS_END) { fprintf(stderr, "kernel_launch: unexpected shapes n_in %d out %d ws %zu\n", n_in, out_size, ws_size); grid = -1; return; }
        int dev = 0, cus = 0;
        if (hipGetDevice(&dev) != hipSuccess || hipDeviceGetAttribute(&cus, hipDeviceAttributeMultiprocessorCount, dev) != hipSuccess) { grid = -1; return; }
        if (hipFuncSetAttribute((const void*)mk_fwd, hipFuncAttributeMaxDynamicSharedMemorySize, LDS_BYTES) != hipSuccess) { grid = -1; return; }
        int per_cu = 0;
        (void)hipOccupancyMaxActiveBlocksPerMultiprocessor(&per_cu, (const void*)mk_fwd, NTHR, LDS_BYTES);
        (void)hipGetLastError();
        if (per_cu < 1) fprintf(stderr, "kernel_launch: occupancy query says %d\n", per_cu);
        grid = cus;
    }
    if (grid < 0) return;
    (void)hipMemsetAsync((char*)d_ws + WS_CTL, 0, CTL_ZERO_BYTES, stream);
    Args a{};
    for (int i = 0; i < 16; ++i) a.in[i] = d_in[i];
    a.out = (float*)d_out; a.ws = (unsigned char*)d_ws;
#if defined(CHK_BUILD) || defined(CHK2_BUILD) || defined(CHK3_BUILD) || defined(CHK4_BUILD)
    { const int pcut = 2 + PPL * CHK_LAYER + CHK_AFTER + 1;
      a.ph_lo = 0; a.ph_hi = pcut; hipLaunchKernelGGL(mk_fwd, dim3(grid), dim3(NTHR), LDS_BYTES, stream, a);
      static bool attr2 = false; if (!attr2) { attr2 = true; (void)hipFuncSetAttribute((const void*)chk_kernel, hipFuncAttributeMaxDynamicSharedMemorySize, 98304); }
      hipLaunchKernelGGL(chk_kernel, dim3(grid), dim3(NTHR), 98304, stream, a, (int)CHK_LAYER);
      (void)hipMemsetAsync((char*)d_ws + WS_CTL, 0, CTL_ZERO_BYTES, stream);
      a.ph_lo = pcut; a.ph_hi = N_PHASES; hipLaunchKernelGGL(mk_fwd, dim3(grid), dim3(NTHR), LDS_BYTES, stream, a);
      hipLaunchKernelGGL(chk_readback, dim3(grid), dim3(NTHR), 0, stream, a, grid); }
#elif MK_PER_PHASE
    for (int p = 0; p < N_PHASES; ++p) { a.ph_lo = p; a.ph_hi = p + 1; hipLaunchKernelGGL(mk_fwd, dim3(grid), dim3(NTHR), LDS_BYTES, stream, a); }
#else
    a.ph_lo = 0; a.ph_hi = N_PHASES;
    hipLaunchKernelGGL(mk_fwd, dim3(grid), dim3(NTHR), LDS_BYTES, stream, a);
#endif
}
```

```cpp
#include <hip/hip_runtime.h>
#define MLA_FP8 1
#define MLA_FP8V 1
#define MLA_BIGX_OFF 1
#define MLA_MXQ_OFF 1
#define MLA_MXU 1
#define MLA_MXL 1
#define MLA_MX 1
#define YBF16 1
#define GEMM_F8 1
#include <cstdio>
#include <cstdint>

#define GAS __attribute__((address_space(1)))
#define LAS __attribute__((address_space(3)))
typedef unsigned short bf16;
typedef float f32x4 __attribute__((ext_vector_type(4)));
typedef float f32x2 __attribute__((ext_vector_type(2)));
typedef float f32x8 __attribute__((ext_vector_type(8)));
typedef float f32x16 __attribute__((ext_vector_type(16)));
typedef unsigned u32x4 __attribute__((ext_vector_type(4)));
typedef unsigned u32x2 __attribute__((ext_vector_type(2)));
typedef short bf16x8 __attribute__((ext_vector_type(8)));
typedef short s16x4 __attribute__((ext_vector_type(4)));
typedef __bf16 bf16x2v __attribute__((ext_vector_type(2)));
typedef __bf16 bf16x8v __attribute__((ext_vector_type(8)));
typedef GAS unsigned gu32;

constexpr int S = 16384, D = 4096, DEPTH = 2;
constexpr int INC = 9072, NIN = 9216;
constexpr float LN_EPS = 1e-5f, RMS_EPS = 1e-6f;
constexpr float DN_ALPHA = 1.41421356237309515f;
constexpr float LOG2E = 1.4426950408889634f;
constexpr float QS_MLA = 0.07216878364870322f * LOG2E;
constexpr float QS_NSA = 0.08838834764831845f * LOG2E;
constexpr int NWAVES = 8, NTHR = 512;
constexpr size_t MiB = 1u << 20;
constexpr size_t WS_CTL = 0, CTL_ZERO_BYTES = 1 * MiB;
constexpr size_t WS_MOD = 1 * MiB;
constexpr size_t WS_ROPE = 2 * MiB;
constexpr size_t WS_CBP = 6 * MiB;
constexpr size_t WS_RSQQ = 7 * MiB;
constexpr size_t WS_RSQKV = 9 * MiB;
constexpr size_t WS_RSTD = 6 * MiB + 512 * 1024;
constexpr size_t WS_GNSA = 10 * MiB;
constexpr size_t WS_KCMP = 13 * MiB;
constexpr size_t WS_VCMP = 13 * MiB + 512 * 1024;
constexpr size_t WS_W = 16 * MiB, W_LSTRIDE = 120 * MiB;
constexpr size_t W_IN = 0, W_QUP = 72 * MiB, W_KVUP = 77 * MiB, W_OUT = 81 * MiB, W_C1 = 113 * MiB, W_C2 = 115 * MiB;
constexpr size_t WS_H = 256 * MiB;
constexpr size_t WS_XV = 384 * MiB;
constexpr size_t WS_QLAT = 640 * MiB, WS_KVLAT = 664 * MiB;
#ifdef GEMM_F8
constexpr size_t WS_QMLA = 680 * MiB, WS_KMLA = 728 * MiB, WS_VMLA = 872 * MiB, WS_ZMLA = 936 * MiB, WS_ZNSA = 1000 * MiB, WS_QNSA = 1064 * MiB;
constexpr size_t WS_Y = 936 * MiB;
constexpr size_t WS_H8 = 776 * MiB;
constexpr size_t WS_WIN8 = 840 * MiB, WIN8_LSTRIDE = 13 * MiB;
#else
constexpr size_t WS_QMLA = 680 * MiB, WS_KMLA = 776 * MiB, WS_VMLA = 872 * MiB, WS_ZMLA = 936 * MiB, WS_ZNSA = 1000 * MiB, WS_QNSA = 1064 * MiB;
#endif
constexpr size_t WS_KVNSA = 1128 * MiB;
constexpr size_t WS_OSCR = 1178 * MiB;
constexpr size_t WS_END = 1210 * MiB;
constexpr int CW_BAR = 4096;
constexpr int LDS_BYTES = 147456;
constexpr int MISC_OFF = LDS_BYTES - 128;

__device__ __forceinline__ unsigned pk2(float lo, float hi) { f32x2 a = {lo, hi}; return __builtin_bit_cast(unsigned, __builtin_convertvector(a, bf16x2v)); }
__device__ __forceinline__ u32x4 pk8(f32x4 a, f32x4 b) { u32x4 w; w.x = pk2(a[0], a[1]); w.y = pk2(a[2], a[3]); w.z = pk2(b[0], b[1]); w.w = pk2(b[2], b[3]); return w; }
__device__ __forceinline__ float bflo(unsigned u) { return __uint_as_float(u << 16); }
__device__ __forceinline__ float bfhi(unsigned u) { return __uint_as_float(u & 0xffff0000u); }
__device__ __forceinline__ float wave_sum(float v) {
#pragma unroll
    for (int o = 1; o < 64; o <<= 1) v += __shfl_xor(v, o);
    return v;
}
__device__ __forceinline__ float silu_f(float v) { return v * __builtin_amdgcn_rcpf(1.f + __expf(-v)); }
__device__ __forceinline__ float sigm_f(float v) { return __builtin_amdgcn_rcpf(1.f + __expf(-v)); }

#define XB_TMO      128
#define XB_XCNT(j)  (256  + 64 * (j))
#define XB_XSUB(j)  (1280 + 64 * (j))
#define XB_XGEN(j)  (2304 + 64 * (j))
#define XB_TOP      3328
#define XB_TOPGEN   3392
#define XCD_BAR_WORDS 3456
#define XB_SPIN_CAP (1u << 18)
__device__ __forceinline__ unsigned xb_ld(unsigned* p)              { return __hip_atomic_load(p, __ATOMIC_RELAXED, __HIP_MEMORY_SCOPE_AGENT); }
__device__ __forceinline__ unsigned xb_add(unsigned* p, unsigned v) { return __hip_atomic_fetch_add(p, v, __ATOMIC_RELAXED, __HIP_MEMORY_SCOPE_AGENT); }
__device__ __forceinline__ unsigned xb_xcc_id() { return (unsigned)__builtin_amdgcn_s_getreg((3 << 11) | 20) & 0xFu; }
#define XB_SPIN(cond, bar) do { unsigned _sp = 0; while (cond) { __builtin_amdgcn_s_sleep(1); \
    if ((++_sp & 255u) == 0u) { if (xb_ld(&(bar)[XB_TMO])) break; if (_sp > XB_SPIN_CAP) { atomicAdd(&(bar)[XB_TMO], 1u); break; } } } } while (0)
struct XcdBarrier { unsigned* bar; unsigned x; volatile LAS unsigned* st; };
__device__ __forceinline__ XcdBarrier xcd_barrier_post(unsigned* bar, volatile LAS unsigned* st) {
    XcdBarrier b; b.bar = bar; b.x = xb_xcc_id(); b.st = st;
    if (threadIdx.x == 0) (void)xb_add(&bar[XB_XCNT(b.x)], 1u);
    return b;
}
__device__ __forceinline__ void xcd_barrier_complete(unsigned* bar, unsigned x, unsigned& nloc, unsigned& nx) {
    const unsigned G = gridDim.x * gridDim.y * gridDim.z;
    unsigned sum, cnt, mine, sp = 0u;
    for (;;) {
        sum = 0u; cnt = 0u; mine = 0u;
#pragma unroll
        for (unsigned j = 0; j < 16; ++j) { const unsigned c = xb_ld(&bar[XB_XCNT(j)]); sum += c; cnt += (c > 0u) ? 1u : 0u; mine = (j == x) ? c : mine; }
        if (sum == G) break;
        __builtin_amdgcn_s_sleep(1);
        if ((++sp & 255u) == 0u) { if (xb_ld(&bar[XB_TMO])) break; if (sp > XB_SPIN_CAP) { atomicAdd(&bar[XB_TMO], 1u); break; } }
    }
    nloc = mine > 0u ? mine : 1u; nx = cnt > 0u ? cnt : 1u;
}
__device__ __forceinline__ void xcd_barrier(const XcdBarrier& b) {
    asm volatile("s_waitcnt vmcnt(0)" ::: "memory");
    __syncthreads();
    if (threadIdx.x == 0) {
        unsigned* bar = b.bar;
        __builtin_amdgcn_s_waitcnt(0);
        unsigned nloc = b.st[0], nx = b.st[1];
        if (nloc == 0u) { xcd_barrier_complete(bar, b.x, nloc, nx); b.st[0] = nloc; b.st[1] = nx; }
        const unsigned old = xb_add(&bar[XB_XSUB(b.x)], 1u);
        const unsigned gen = old / nloc;
        if (old + 1u == (gen + 1u) * nloc) {
            __builtin_amdgcn_fence(__ATOMIC_RELEASE, "agent");
            asm volatile("s_waitcnt vmcnt(0)" ::: "memory");
            const unsigned og = xb_add(&bar[XB_TOP], 1u);
            const unsigned tg = og / nx;
            if (og + 1u == (tg + 1u) * nx) xb_add(&bar[XB_TOPGEN], 1u);
            else XB_SPIN(xb_ld(&bar[XB_TOPGEN]) == tg, bar);
            __builtin_amdgcn_fence(__ATOMIC_ACQUIRE, "agent");
            xb_add(&bar[XB_XGEN(b.x)], 1u);
            asm volatile("s_waitcnt vmcnt(0)" ::: "memory");
        } else {
            XB_SPIN(xb_ld(&bar[XB_XGEN(b.x)]) == gen, bar);
            __builtin_amdgcn_fence(__ATOMIC_ACQUIRE, "agent");
            asm volatile("s_waitcnt vmcnt(0)" ::: "memory");
        }
    }
    __syncthreads();
}
__device__ __forceinline__ void p0_mod_gemv(const float* c, const float* w_ada, const float* b_ada, float* mod, LAS float* lds, int vcu, int G) {
    const int tid = threadIdx.x;
    LAS float* sc = lds;
    LAS float* red = lds + 4096;
    for (int k = tid; k < D; k += NTHR) sc[k] = silu_f(c[k]);
    __syncthreads();
    const int cl = tid & 7, kl = tid >> 3;
    constexpr int NU = DEPTH * 3 * D / 32;
    for (int u = vcu; u < NU; u += G) {
        const int l = u / (3 * D / 32), n0 = (u % (3 * D / 32)) * 32;
        const float* W = w_ada + (size_t)l * D * (3 * D) + n0 + cl * 4;
        f32x4 acc = {0.f, 0.f, 0.f, 0.f};
#pragma unroll 8
        for (int i = 0; i < D / 64; ++i) { const int k = kl + 64 * i; const f32x4 w = *(const GAS f32x4*)(W + (size_t)k * (3 * D)); acc += w * sc[k]; }
        red[kl * 33 + cl * 4 + 0] = acc[0]; red[kl * 33 + cl * 4 + 1] = acc[1]; red[kl * 33 + cl * 4 + 2] = acc[2]; red[kl * 33 + cl * 4 + 3] = acc[3];
        __syncthreads();
        if (tid < 32) { float s = 0.f; for (int j = 0; j < 64; ++j) s += red[j * 33 + tid]; mod[(size_t)l * 3 * D + n0 + tid] = s + b_ada[(size_t)l * 3 * D + n0 + tid]; }
        __syncthreads();
    }
}
__device__ __forceinline__ int map_in(int n) {
    if (n < 1280) return n;
    if (n < 1344) { const int i = n - 1280; return 1280 + 2 * (i & 31) + (i >> 5); }
    if (n < 3392) return 1536 + (n - 1344);
    if (n < 5440) return 3584 + (n - 3392);
    if (n < 6976) return 5632 + (n - 5440);
    if (n < 7024) return 1344 + (n - 6976);
    return 7168 + (n - 7024);
}
#ifdef MLA_FP8V
__device__ __forceinline__ int map_kvup(int n) { const int h = n >> 8, d = n & 255; return d < 128 ? h * 128 + d : 2048 + h * 128 + (d - 128); }
#endif
__device__ __forceinline__ int map_qup(int n) { const int h = n / 192, d = n - h * 192; if (d < 128) return h * 128 + d; const int i = d - 128; return 2048 + h * 64 + 2 * (i & 31) + (i >> 5); }
#ifdef GEMM_F8
template <int MAP>
__device__ __forceinline__ void tr_item8(const float* W, int K, int N, unsigned char* WT, const float* kscale, float sc, int kb, int nb, int lane) {
    const int k0 = 64 * kb, n = 64 * nb + lane;
    if (n >= N) return;
    const GAS float* src = (const GAS float*)(W + (size_t)k0 * N + n);
    float v[64];
#pragma unroll
    for (int i = 0; i < 64; ++i) v[i] = src[(size_t)i * N] * sc;
    if (kscale) {
#pragma unroll
        for (int i = 0; i < 64; ++i) v[i] *= kscale[k0 + i];
    }
    const int row = MAP == 4 ? (n < 1280 ? n : 1280 + (n - 1344)) : (MAP == 2 ? map_qup(n) : map_kvup(n));
    GAS u32x4* dst = (GAS u32x4*)(WT + (size_t)row * K + k0);
#pragma unroll
    for (int c = 0; c < 4; ++c) { u32x4 o;
        int w = __builtin_amdgcn_cvt_pk_fp8_f32(v[16 * c + 0], v[16 * c + 1], 0, false); o.x = (unsigned)__builtin_amdgcn_cvt_pk_fp8_f32(v[16 * c + 2], v[16 * c + 3], w, true);
        w = __builtin_amdgcn_cvt_pk_fp8_f32(v[16 * c + 4], v[16 * c + 5], 0, false); o.y = (unsigned)__builtin_amdgcn_cvt_pk_fp8_f32(v[16 * c + 6], v[16 * c + 7], w, true);
        w = __builtin_amdgcn_cvt_pk_fp8_f32(v[16 * c + 8], v[16 * c + 9], 0, false); o.z = (unsigned)__builtin_amdgcn_cvt_pk_fp8_f32(v[16 * c + 10], v[16 * c + 11], w, true);
        w = __builtin_amdgcn_cvt_pk_fp8_f32(v[16 * c + 12], v[16 * c + 13], 0, false); o.w = (unsigned)__builtin_amdgcn_cvt_pk_fp8_f32(v[16 * c + 14], v[16 * c + 15], w, true);
        dst[c] = o; }
}
#endif
template <int MAP>
__device__ __forceinline__ void tr_item(const float* W, int K, int N, bf16* WT, const float* kscale, int kb, int nb, int lane) {
    const int k0 = 64 * kb, n = 64 * nb + lane;
    if (n >= N) return;
    const GAS float* src = (const GAS float*)(W + (size_t)k0 * N + n);
    float v[64];
#pragma unroll
    for (int i = 0; i < 64; ++i) v[i] = src[(size_t)i * N];
    if (kscale) {
#pragma unroll
        for (int i = 0; i < 64; ++i) v[i] *= kscale[k0 + i];
    }
#ifdef MLA_FP8V
    const int row = MAP == 1 ? map_in(n) : (MAP == 2 ? map_qup(n) : (MAP == 3 ? map_kvup(n) : n));
#else
    const int row = MAP == 1 ? map_in(n) : (MAP == 2 ? map_qup(n) : n);
#endif
    GAS u32x4* dst = (GAS u32x4*)(WT + (size_t)row * K + k0);
#pragma unroll
    for (int c = 0; c < 8; ++c) { u32x4 o; o.x = pk2(v[8 * c], v[8 * c + 1]); o.y = pk2(v[8 * c + 2], v[8 * c + 3]); o.z = pk2(v[8 * c + 4], v[8 * c + 5]); o.w = pk2(v[8 * c + 6], v[8 * c + 7]); dst[c] = o; }
}
struct P0In { const float *w_in, *q_norm, *w_q_up, *kv_norm, *w_kv_up, *w_cmp1, *w_cmp2, *w_out; };
__device__ __forceinline__ void p0_convert(const P0In& I, unsigned char* ws, int gw, int NGW, int lane) {
    constexpr int T_IN = 64 * 142, T_QUP = 12 * 48, T_KVUP = 8 * 64, T_OUT = 64 * 64, T_C1 = 2 * 64 * 2, T_C2 = 2 * 2 * 2;
    constexpr int TL = T_IN + T_QUP + T_KVUP + T_OUT + T_C1 + T_C2;
    for (int it = gw; it < DEPTH * TL; it += NGW) {
        const int l = it / TL; int r = it - l * TL;
        unsigned char* wl = ws + WS_W + (size_t)l * W_LSTRIDE;
#ifdef GEMM_F8
        if (r < T_IN) { const int t_ = r >> 3, nb = t_ % 142, kb = (t_ / 142) * 8 + (r & 7);
            if (nb < 20 || (nb >= 21 && nb < 53)) tr_item8<4>(I.w_in + (size_t)l * D * INC, D, INC, ws + WS_WIN8 + (size_t)l * WIN8_LSTRIDE, nullptr, 64.f, kb, nb, lane);
            else tr_item<1>(I.w_in + (size_t)l * D * INC, D, INC, (bf16*)(wl + W_IN), nullptr, kb, nb, lane);
            continue; } r -= T_IN;
        if (r < T_QUP) { tr_item8<2>(I.w_q_up + (size_t)l * 768 * 3072, 768, 3072, wl + W_QUP, I.q_norm + l * 768, 32.f, r / 48, r % 48, lane); continue; } r -= T_QUP;
        if (r < T_KVUP) { tr_item8<3>(I.w_kv_up + (size_t)l * 512 * 4096, 512, 4096, wl + W_KVUP, I.kv_norm + l * 512, 32.f, r / 64, r % 64, lane); continue; }
#else
        if (r < T_IN) { tr_item<1>(I.w_in + (size_t)l * D * INC, D, INC, (bf16*)(wl + W_IN), nullptr, r / 142, r % 142, lane); continue; } r -= T_IN;
        if (r < T_QUP) { tr_item<2>(I.w_q_up + (size_t)l * 768 * 3072, 768, 3072, (bf16*)(wl + W_QUP), I.q_norm + l * 768, r / 48, r % 48, lane); continue; } r -= T_QUP;
#ifdef MLA_FP8V
        if (r < T_KVUP) { tr_item<3>(I.w_kv_up + (size_t)l * 512 * 4096, 512, 4096, (bf16*)(wl + W_KVUP), I.kv_norm + l * 512, r / 64, r % 64, lane); continue; }
#else
        if (r < T_KVUP) { tr_item<0>(I.w_kv_up + (size_t)l * 512 * 4096, 512, 4096, (bf16*)(wl + W_KVUP), I.kv_norm + l * 512, r / 64, r % 64, lane); continue; }
#endif
#endif
        r -= T_KVUP;
        if (r < T_OUT) { const int t_ = r >> 3; tr_item<0>(I.w_out + (size_t)l * D * D, D, D, (bf16*)(wl + W_OUT), nullptr, (t_ / 64) * 8 + (r & 7), t_ % 64, lane); continue; } r -= T_OUT;
        if (r < T_C1) { const int kv = r / 128, rr = r % 128; tr_item<0>(I.w_cmp1 + (size_t)(l * 2 + kv) * 4096 * 128, 4096, 128, (bf16*)(wl + W_C1) + (size_t)kv * 128 * 4096, nullptr, rr / 2, rr % 2, lane); continue; } r -= T_C1;
        { const int kv = r / 4, rr = r % 4; tr_item<0>(I.w_cmp2 + (size_t)(l * 2 + kv) * 128 * 128, 128, 128, (bf16*)(wl + W_C2) + (size_t)kv * 128 * 128, nullptr, rr / 2, rr % 2, lane); }
    }
}
__device__ __forceinline__ void p0_rope(const int* positions, float* cosT, float* sinT, int gtid, int NT) {
    for (int e = gtid; e < S * 32; e += NT) { const int s = e >> 5, i = e & 31;
        const float inv = (float)exp(-(double)i * (1.0 / 32.0) * 9.210340371976184);
        const float ang = (float)positions[s] * inv;
        cosT[e] = (float)cos((double)ang); sinT[e] = (float)sin((double)ang); }
}
__device__ __forceinline__ void p0_cmpbias(const float* cmp_pos, const float* w_cmp1, float* cbp, LAS float* red, int vcu, int G) {
    const int tid = threadIdx.x, n = tid & 127, kq = tid >> 7;
    for (int u = vcu; u < 64; u += G) {
        const int lk = u >> 4, ch = u & 15;
        const float* P = cmp_pos + (size_t)lk * 4096 + 256 * ch; const float* W = w_cmp1 + (size_t)lk * 4096 * 128 + (size_t)(256 * ch) * 128 + n;
        float a = 0.f;
#pragma unroll 8
        for (int i = 0; i < 64; ++i) { const int k = kq + 4 * i; a += P[k] * *(const GAS float*)(W + (size_t)k * 128); }
        red[kq * 128 + n] = a;
        __syncthreads();
        if (tid < 128) cbp[(size_t)u * 128 + tid] = (red[tid] + red[128 + tid]) + (red[256 + tid] + red[384 + tid]);
        __syncthreads();
    }
}
__device__ __forceinline__ unsigned pk4_fp8(f32x4 h) { const int w = __builtin_amdgcn_cvt_pk_fp8_f32(h[0], h[1], 0, false); return (unsigned)__builtin_amdgcn_cvt_pk_fp8_f32(h[2], h[3], w, true); }
__device__ __forceinline__ void modulate_rows(const float* x, bf16* hout, unsigned char* h8, const float* modl, int gw, int NGW, int lane) {
    f32x4 sh[16], sc[16];
#pragma unroll
    for (int j = 0; j < 16; ++j) { sh[j] = *((const GAS f32x4*)modl + lane + 64 * j); sc[j] = *((const GAS f32x4*)(modl + D) + lane + 64 * j) + 1.f; }
    for (int m = gw; m < S; m += NGW) {
        const GAS f32x4* xr = (const GAS f32x4*)(x + (size_t)m * D) + lane;
        GAS u32x2* ho = (GAS u32x2*)(hout + (size_t)m * D) + lane;
#pragma unroll
        for (int j = 0; j < 16; ++j) { const f32x4 h = xr[64 * j] * sc[j] + sh[j]; u32x2 w; w.x = pk2(h[0], h[1]); w.y = pk2(h[2], h[3]); ho[64 * j] = w;
            if (h8) *((GAS unsigned*)(h8 + (size_t)m * D) + lane + 64 * j) = pk4_fp8(h); }
    }
}
__device__ __forceinline__ void ln_rows(const float* xres, const bf16* yb, float* xout, bf16* hout, unsigned char* h8, const float* g, const float* b, const float* mod_next, LAS float* par, int tid, int gw, int NGW, int lane) {
    {
#pragma unroll
      for (int i = 0; i < 2; ++i) { const int e = tid + 512 * i;
          *((LAS f32x4*)par + e) = *((const GAS f32x4*)g + e); *((LAS f32x4*)(par + D) + e) = *((const GAS f32x4*)b + e);
          if (hout) { *((LAS f32x4*)(par + 2 * D) + e) = *((const GAS f32x4*)mod_next + e); *((LAS f32x4*)(par + 3 * D) + e) = *((const GAS f32x4*)(mod_next + D) + e) + 1.f; } }
      __syncthreads(); }
    for (int m = gw; m < S; m += NGW) {
        const GAS f32x4* vr = (const GAS f32x4*)(xres + (size_t)m * D) + lane; const GAS u32x2* yr = (const GAS u32x2*)(yb + (size_t)m * D) + lane;
        f32x4 x[16]; float s = 0.f;
#pragma unroll
        for (int j = 0; j < 16; ++j) { const u32x2 yy = yr[64 * j]; const f32x4 yf = {bflo(yy.x), bfhi(yy.x), bflo(yy.y), bfhi(yy.y)};
            x[j] = vr[64 * j] * DN_ALPHA + yf; s += (x[j][0] + x[j][1]) + (x[j][2] + x[j][3]); }
        const float mean = wave_sum(s) * (1.f / D); float s2 = 0.f;
#pragma unroll
        for (int j = 0; j < 16; ++j) { x[j] = x[j] - mean; s2 += (x[j][0] * x[j][0] + x[j][1] * x[j][1]) + (x[j][2] * x[j][2] + x[j][3] * x[j][3]); }
        const float rstd = 1.f / sqrtf(wave_sum(s2) * (1.f / D) + LN_EPS);
        GAS f32x4* xo = (GAS f32x4*)(xout + (size_t)m * D) + lane;
#pragma unroll
        for (int j = 0; j < 16; ++j) {
            const f32x4 gg = *((const LAS f32x4*)par + lane + 64 * j), bb = *((const LAS f32x4*)(par + D) + lane + 64 * j);
            const f32x4 y = x[j] * rstd * gg + bb;
            xo[64 * j] = y;
            if (hout) {
                const f32x4 sh = *((const LAS f32x4*)(par + 2 * D) + lane + 64 * j), scl = *((const LAS f32x4*)(par + 3 * D) + lane + 64 * j);
                const f32x4 h = y * scl + sh;
                u32x2 w; w.x = pk2(h[0], h[1]); w.y = pk2(h[2], h[3]);
                *((GAS u32x2*)(hout + (size_t)m * D) + lane + 64 * j) = w;
                if (h8) *((GAS unsigned*)(h8 + (size_t)m * D) + lane + 64 * j) = pk4_fp8(h);
            }
        }
    }
}
__device__ __forceinline__ void rstd_rows(const float* rsq_q, const float* rsq_kv, float* rstd_q, float* rstd_kv, int gtid, int NT) {
    for (int row = gtid; row < S; row += NT) {
        const GAS f32x4* rp = (const GAS f32x4*)(rsq_q + (size_t)row * 24); float ss = 0.f;
#pragma unroll
        for (int i = 0; i < 6; ++i) { const f32x4 t = rp[i]; ss += (t[0] + t[1]) + (t[2] + t[3]); }
        rstd_q[row] = 1.f / sqrtf(ss * (1.f / 768.f) + RMS_EPS);
        const GAS f32x4* rk = (const GAS f32x4*)(rsq_kv + (size_t)row * 16); float sk = 0.f;
#pragma unroll
        for (int i = 0; i < 4; ++i) { const f32x4 t = rk[i]; sk += (t[0] + t[1]) + (t[2] + t[3]); }
        rstd_kv[row] = 1.f / sqrtf(sk * (1.f / 512.f) + RMS_EPS);
    }
}
namespace pg8 {
#define PG8_LAS __attribute__((address_space(3)))
typedef unsigned short bf16_t;
typedef short bf16x8 __attribute__((ext_vector_type(8)));
typedef float f32x4 __attribute__((ext_vector_type(4)));
typedef unsigned u32x4 __attribute__((ext_vector_type(4)));
constexpr int BM = 256, BK = 64, HALF = 128, HTB = HALF * BK * 2  , STAGE_BYTES = 8 * HTB, NXCD = 8, WGM = 8;

__host__ __device__ __forceinline__ int lds_byte(int r, int c) { const int st = (r >> 4) * 2 + (c >> 5), rr = r & 15, cc = c & 31, ob = rr * 64 + cc * 2; return st * 1024 + (ob ^ (((ob >> 9) & 1) << 5)); }
__host__ __device__ __forceinline__ void stage_rc(int b, int& R, int& C) { const int st = b / 1024, sb = b % 1024, swz = sb ^ (((sb >> 9) & 1) << 5); R = (st >> 1) * 16 + swz / 64; C = (st & 1) * 32 + (swz % 64) / 2; }
__host__ __device__ __forceinline__ int perm32(int rho) { const int n = rho >> 4, i = rho & 15; return 8 * (i >> 2) + 4 * n + (i & 3); }

struct Unit { int pm, pn; };
struct Gemm { const bf16_t* A; const bf16_t* Bt; int M, N, K; };

struct StaticOrder {
    int nM, nN, nwg, G, c;
    __host__ __device__ void init(int M, int N, int G_, int c_) { nM = M / BM; nN = N / BM; nwg = nM * nN; G = G_; c = c_; }
    __host__ __device__ bool next(int i, Unit& u) const {
        const long L = (long)i * G + c; if (L >= nwg) return false;
        int wgid = (int)L; { const int q = nwg / NXCD, r = nwg % NXCD, xcd = wgid % NXCD, off = wgid / NXCD; wgid = (xcd < r ? xcd * (q + 1) : r * (q + 1) + (xcd - r) * q) + off; }
        const int nig = WGM * nN, gid = wgid / nig, fm = gid * WGM, gsz = (nM - fm) < WGM ? (nM - fm) : WGM;
        u.pm = fm + ((wgid % nig) % gsz); u.pn = (wgid % nig) / gsz; return true;
    }
    __device__ __forceinline__ void a_ready(const Unit&) const {}
    __device__ __forceinline__ void done(const Unit&) const {}
};
typedef int i32x8 __attribute__((ext_vector_type(8)));
typedef int i32x4 __attribute__((ext_vector_type(4)));
__device__ __forceinline__ i32x8 ld2x16(const PG8_LAS unsigned char* p) { const u32x4 a = *(const PG8_LAS u32x4*)p, b = *(const PG8_LAS u32x4*)(p + 1024);
    return (i32x8){(int)a.x, (int)a.y, (int)a.z, (int)a.w, (int)b.x, (int)b.y, (int)b.z, (int)b.w}; }
__device__ __forceinline__ i32x8 cat8(bf16x8 lo, bf16x8 hi) { const i32x4 a = __builtin_bit_cast(i32x4, lo), b = __builtin_bit_cast(i32x4, hi); return (i32x8){a[0], a[1], a[2], a[3], b[0], b[1], b[2], b[3]}; }
struct InBf16Order : StaticOrder {
    __device__ bool next(int i, Unit& u) const { if (!StaticOrder::next(i, u)) return false; u.pn = u.pn == 0 ? 5 : 13 + u.pn; return true; }
};
__device__ __forceinline__ f32x4 rope4(const f32x4 v, float c0, float s0, float c1, float s1) {
    f32x4 o; o[0] = v[0] * c0 - v[1] * s0; o[1] = v[1] * c0 + v[0] * s0; o[2] = v[2] * c1 - v[3] * s1; o[3] = v[3] * c1 + v[2] * s1; return o; }
#ifdef NOISE_BUILD
__device__ __forceinline__ f32x4 nz4(f32x4 v, int row, int col) {
    f32x4 o;
#pragma unroll
    for (int i = 0; i < 4; ++i) { unsigned h = (unsigned)row * 9216u + (unsigned)(col + i); h ^= h >> 16; h *= 0x7feb352du; h ^= h >> 15; h *= 0x846ca68bu; h ^= h >> 16;
        const float r = (float)(int)(h & 0xffffu) * (1.f / 32768.f) - 1.f; o[i] = v[i] * (1.f + NOISE_EPS * r); }
    return o; }
#define NZ(v, row, col) nz4((v), (row), (col))
#else
#define NZ(v, row, col) (v)
#endif
#ifdef MLA_FP8
__device__ __forceinline__ u32x2 pk8_fp8(f32x4 a, f32x4 b) {
    int w0 = __builtin_amdgcn_cvt_pk_fp8_f32(a[0], a[1], 0, false); w0 = __builtin_amdgcn_cvt_pk_fp8_f32(a[2], a[3], w0, true);
    int w1 = __builtin_amdgcn_cvt_pk_fp8_f32(b[0], b[1], 0, false); w1 = __builtin_amdgcn_cvt_pk_fp8_f32(b[2], b[3], w1, true);
    u32x2 r; r.x = (unsigned)w0; r.y = (unsigned)w1; return r; }
#endif
struct EpiIn {
    static constexpr bool PERM = true, AFTER_DRAIN = false;
    unsigned char* ws; int f8pass;
    __device__ __forceinline__ void operator()(const f32x4 (&acc)[2][2][4][2], const Unit& u, int wr, int wc, int fr, int fq) const {
        const int pn = f8pass ? (u.pn < 5 ? u.pn : u.pn + 1) : u.pn, row0 = u.pm * BM + wr * 64 + fr;
        if (pn < 5) {
            const bool isq = pn < 3; bf16_t* base = (bf16_t*)(ws + (isq ? WS_QLAT : WS_KVLAT)); const int ld = isq ? 768 : 512, ct = isq ? pn : pn - 3, ns = isq ? 24 : 16; float* rsq = (float*)(ws + (isq ? WS_RSQQ : WS_RSQKV));
#pragma unroll
            for (int ai = 0; ai < 2; ++ai)
#pragma unroll
                for (int m = 0; m < 4; ++m) { const int row = row0 + ai * HALF + m * 16;
#pragma unroll
                    for (int bj = 0; bj < 2; ++bj) { const f32x4 v0 = NZ(acc[ai][bj][m][0], row, pn * 256 + bj * 128 + wc * 32 + 8 * fq), v1 = NZ(acc[ai][bj][m][1], row, pn * 256 + bj * 128 + wc * 32 + 8 * fq + 4);
                        float ss = ((v0[0] * v0[0] + v0[1] * v0[1]) + (v0[2] * v0[2] + v0[3] * v0[3])) + ((v1[0] * v1[0] + v1[1] * v1[1]) + (v1[2] * v1[2] + v1[3] * v1[3]));
                        ss += __shfl_xor(ss, 16); ss += __shfl_xor(ss, 32);
                        if (fq == 0) rsq[(size_t)row * ns + ct * 8 + bj * 4 + wc] = ss;
#ifdef GEMM_F8
                        *(GAS u32x2*)((unsigned char*)base + (size_t)row * ld + ct * 256 + bj * HALF + wc * 32 + 8 * fq) = pk8_fp8(v0, v1); } }
#else
                        *(GAS u32x4*)(base + (size_t)row * ld + ct * 256 + bj * HALF + wc * 32 + 8 * fq) = pk8(v0, v1); } }
#endif
        } else if (pn == 5) {
            if (wc < 2) {
                const int i0 = 16 * wc + 4 * fq; const float* cosT = (const float*)(ws + WS_ROPE); const float* sinT = cosT + (size_t)S * 32; bf16_t* kmla = (bf16_t*)(ws + WS_KMLA);
#pragma unroll
                for (int ai = 0; ai < 2; ++ai)
#pragma unroll
                    for (int m = 0; m < 4; ++m) { const int row = row0 + ai * HALF + m * 16;
                        const f32x4 cs = *(const GAS f32x4*)(cosT + (size_t)row * 32 + i0), sn = *(const GAS f32x4*)(sinT + (size_t)row * 32 + i0);
#ifdef MLA_FP8
                        const u32x2 w = pk8_fp8(rope4(acc[ai][0][m][0], cs[0], sn[0], cs[1], sn[1]), rope4(acc[ai][0][m][1], cs[2], sn[2], cs[3], sn[3]));
                        unsigned char* dst = (unsigned char*)kmla + (size_t)row * 3072 + 128 + wc * 32 + 8 * fq;
#pragma unroll
                        for (int h = 0; h < 16; ++h) *(GAS u32x2*)(dst + h * 192) = w;
#else
                        const u32x4 w = pk8(rope4(acc[ai][0][m][0], cs[0], sn[0], cs[1], sn[1]), rope4(acc[ai][0][m][1], cs[2], sn[2], cs[3], sn[3]));
                        bf16_t* dst = kmla + (size_t)row * 3072 + 128 + wc * 32 + 8 * fq;
#pragma unroll
                        for (int h = 0; h < 16; ++h) *(GAS u32x4*)(dst + h * 192) = w;
#endif
                        asm volatile("" ::: "memory"); }
            } else {
                const int cl = (wc - 2) * 32 + 8 * fq; float* gnsa = (float*)(ws + WS_GNSA);
                if (cl < 48) {
#pragma unroll
                    for (int ai = 0; ai < 2; ++ai)
#pragma unroll
                        for (int m = 0; m < 4; ++m) { const int row = row0 + ai * HALF + m * 16; const f32x4 v0 = acc[ai][0][m][0], v1 = acc[ai][0][m][1];
                            f32x4 g0, g1; g0[0] = sigm_f(v0[0]); g0[1] = sigm_f(v0[1]); g0[2] = sigm_f(v0[2]); g0[3] = sigm_f(v0[3]); g1[0] = sigm_f(v1[0]); g1[1] = sigm_f(v1[1]); g1[2] = sigm_f(v1[2]); g1[3] = sigm_f(v1[3]);
                            *(GAS f32x4*)(gnsa + (size_t)row * 48 + cl) = g0; *(GAS f32x4*)(gnsa + (size_t)row * 48 + cl + 4) = g1; } }
            }
        } else {
            const int mode = (pn < 14) ? 0 : (pn < 22 ? 1 : (pn < 28 ? 2 : 0));
            bf16_t* base = (pn < 14) ? (bf16_t*)(ws + WS_ZMLA) + (pn - 6) * 256 : (pn < 22 ? (bf16_t*)(ws + WS_QNSA) + (pn - 14) * 256 : (bf16_t*)(ws + WS_ZNSA) + (pn - 28) * 256); bf16_t* kvnsa = (bf16_t*)(ws + WS_KVNSA);
#pragma unroll
            for (int ai = 0; ai < 2; ++ai)
#pragma unroll
                for (int m = 0; m < 4; ++m) { const int row = row0 + ai * HALF + m * 16;
#pragma unroll
                    for (int bj = 0; bj < 2; ++bj) { f32x4 v0 = NZ(acc[ai][bj][m][0], row, pn * 256 + bj * 128 + wc * 32 + 8 * fq), v1 = NZ(acc[ai][bj][m][1], row, pn * 256 + bj * 128 + wc * 32 + 8 * fq + 4);
                        if (mode == 0) { v0[0] = silu_f(v0[0]); v0[1] = silu_f(v0[1]); v0[2] = silu_f(v0[2]); v0[3] = silu_f(v0[3]); v1[0] = silu_f(v1[0]); v1[1] = silu_f(v1[1]); v1[2] = silu_f(v1[2]); v1[3] = silu_f(v1[3]); }
                        else if (mode == 1) { v0 = v0 * QS_NSA; v1 = v1 * QS_NSA; }
                        bf16_t* dst = (mode == 2) ? kvnsa + (size_t)(2 * (pn - 22) + bj) * ((size_t)S * 128) + (size_t)row * 128 + wc * 32 + 8 * fq
                                                  : base + (size_t)row * 2048 + bj * HALF + wc * 32 + 8 * fq;
                        *(GAS u32x4*)dst = pk8(v0, v1); } }
        }
    }
};
struct EpiQup {
    static constexpr bool PERM = true, AFTER_DRAIN = false;
    unsigned char* ws;
    __device__ __forceinline__ void operator()(const f32x4 (&acc)[2][2][4][2], const Unit& u, int wr, int wc, int fr, int fq) const {
        const int pn = u.pn, row0 = u.pm * BM + wr * 64 + fr; bf16_t* qmla = (bf16_t*)(ws + WS_QMLA); const float* rstd_q = (const float*)(ws + WS_RSTD); const float* cosT = (const float*)(ws + WS_ROPE); const float* sinT = cosT + (size_t)S * 32;
#pragma unroll
        for (int ai = 0; ai < 2; ++ai)
#pragma unroll
            for (int m = 0; m < 4; ++m) { const int row = row0 + ai * HALF + m * 16;
#ifdef MLA_FP8
#ifdef MLA_MXL
                const float sc = (QS_MLA * 8.f) * *(const GAS float*)(rstd_q + row);
#else
                const float sc = *(const GAS float*)(rstd_q + row);
#endif
                unsigned char* q8 = (unsigned char*)qmla + (size_t)row * 3072;
#pragma unroll
                for (int bj = 0; bj < 2; ++bj) { const f32x4 v0 = acc[ai][bj][m][0] * sc, v1 = acc[ai][bj][m][1] * sc;
                    if (pn < 8) { *(GAS u32x2*)(q8 + (2 * pn + bj) * 192 + wc * 32 + 8 * fq) = pk8_fp8(v0, v1); }
                    else { const int cp = (pn - 8) * 256 + bj * HALF + wc * 32 + 8 * fq, head = cp >> 6, dl = cp & 63, i0 = dl >> 1;
                        const f32x4 cs = *(const GAS f32x4*)(cosT + (size_t)row * 32 + i0), sn = *(const GAS f32x4*)(sinT + (size_t)row * 32 + i0);
                        *(GAS u32x2*)(q8 + head * 192 + 128 + dl) = pk8_fp8(rope4(v0, cs[0], sn[0], cs[1], sn[1]), rope4(v1, cs[2], sn[2], cs[3], sn[3])); } }
#else
                const float sc = QS_MLA * *(const GAS float*)(rstd_q + row);
#pragma unroll
                for (int bj = 0; bj < 2; ++bj) { const f32x4 v0 = acc[ai][bj][m][0] * sc, v1 = acc[ai][bj][m][1] * sc;
                    if (pn < 8) { *(GAS u32x4*)(qmla + (size_t)row * 3072 + (2 * pn + bj) * 192 + wc * 32 + 8 * fq) = pk8(v0, v1); }
                    else { const int cp = (pn - 8) * 256 + bj * HALF + wc * 32 + 8 * fq, head = cp >> 6, dl = cp & 63, i0 = dl >> 1;
                        const f32x4 cs = *(const GAS f32x4*)(cosT + (size_t)row * 32 + i0), sn = *(const GAS f32x4*)(sinT + (size_t)row * 32 + i0);
                        *(GAS u32x4*)(qmla + (size_t)row * 3072 + head * 192 + 128 + dl) = pk8(rope4(v0, cs[0], sn[0], cs[1], sn[1]), rope4(v1, cs[2], sn[2], cs[3], sn[3])); } }
#endif
                if (m & 1) asm volatile("" ::: "memory"); }
    }
};
struct EpiKvup {
    static constexpr bool PERM = true, AFTER_DRAIN = false;
    unsigned char* ws;
    __device__ __forceinline__ void operator()(const f32x4 (&acc)[2][2][4][2], const Unit& u, int wr, int wc, int fr, int fq) const {
        const int pn = u.pn, row0 = u.pm * BM + wr * 64 + fr;
#pragma unroll
        for (int ai = 0; ai < 2; ++ai)
#pragma unroll
            for (int m = 0; m < 4; ++m) { const int row = row0 + ai * HALF + m * 16;
                const float sc = *(const GAS float*)((const float*)(ws + WS_RSTD) + S + row); bf16_t* kmla = (bf16_t*)(ws + WS_KMLA); bf16_t* vmla = (bf16_t*)(ws + WS_VMLA);
#ifdef MLA_FP8
                *(GAS u32x2*)((unsigned char*)kmla + (size_t)row * 3072 + pn * 192 + wc * 32 + 8 * fq) = pk8_fp8(acc[ai][0][m][0] * sc, acc[ai][0][m][1] * sc);
#else
                *(GAS u32x4*)(kmla + (size_t)row * 3072 + pn * 192 + wc * 32 + 8 * fq) = pk8(acc[ai][0][m][0] * sc, acc[ai][0][m][1] * sc);
#endif
                *(GAS u32x4*)(vmla + (size_t)row * 2048 + pn * 128 + wc * 32 + 8 * fq) = pk8(acc[ai][1][m][0] * sc, acc[ai][1][m][1] * sc);
                if (m & 1) asm volatile("" ::: "memory"); }
    }
};
#ifdef MLA_FP8V
struct EpiKup {
    static constexpr bool PERM = true, AFTER_DRAIN = false;
    unsigned char* ws;
    __device__ __forceinline__ void operator()(const f32x4 (&acc)[2][2][4][2], const Unit& u, int wr, int wc, int fr, int fq) const {
        const int pn = u.pn, row0 = u.pm * BM + wr * 64 + fr;
#pragma unroll
        for (int ai = 0; ai < 2; ++ai)
#pragma unroll
            for (int m = 0; m < 4; ++m) { const int row = row0 + ai * HALF + m * 16;
                const float sc = *(const GAS float*)((const float*)(ws + WS_RSTD) + S + row); unsigned char* k8 = ws + WS_KMLA + (size_t)row * 3072;
#pragma unroll
                for (int bj = 0; bj < 2; ++bj) *(GAS u32x2*)(k8 + (2 * pn + bj) * 192 + wc * 32 + 8 * fq) = pk8_fp8(acc[ai][bj][m][0] * sc, acc[ai][bj][m][1] * sc);
                if (m & 1) asm volatile("" ::: "memory"); }
    }
};
struct EpiVt {
    static constexpr bool PERM = true, AFTER_DRAIN = false;
    unsigned char* ws;
    __device__ __forceinline__ void operator()(const f32x4 (&acc)[2][2][4][2], const Unit& u, int wr, int wc, int fr, int fq) const {
        const int row0 = u.pm * BM + wr * 64 + fr, col0 = u.pn * BM + wc * 32 + 8 * fq;
        const float* rs = (const float*)(ws + WS_RSTD) + S;
        f32x4 sc[2][2];
#pragma unroll
        for (int bj = 0; bj < 2; ++bj) { sc[bj][0] = *(const GAS f32x4*)(rs + col0 + bj * HALF); sc[bj][1] = *(const GAS f32x4*)(rs + col0 + bj * HALF + 4); }
        const int hi8 = (col0 >> 3) & 1; (void)hi8;
#pragma unroll
        for (int ai = 0; ai < 2; ++ai)
#pragma unroll
            for (int m = 0; m < 4; ++m) { unsigned char* vt = ws + WS_VMLA + (size_t)(row0 + ai * HALF + m * 16) * S;
#pragma unroll
                for (int bj = 0; bj < 2; ++bj) { const u32x2 w = pk8_fp8(acc[ai][bj][m][0] * sc[bj][0], acc[ai][bj][m][1] * sc[bj][1]);
#ifdef MLA_MX
                    unsigned char* d64 = vt + ((col0 + bj * HALF) & ~63) + 4 * ((col0 >> 3) & 7);
                    *(GAS unsigned*)(d64) = w.x; *(GAS unsigned*)(d64 + 32) = w.y; } }
#else
                    unsigned char* d16 = vt + ((col0 + bj * HALF) & ~15);
                    *(GAS unsigned*)(d16 + (hi8 ? 4 : 0)) = w.x; *(GAS unsigned*)(d16 + (hi8 ? 12 : 8)) = w.y; } }
#endif
    }
};
#endif
struct EpiOut {
    static constexpr bool PERM = true, AFTER_DRAIN = false;
    bf16_t* y; const float* gate;
    __device__ __forceinline__ void operator()(const f32x4 (&acc)[2][2][4][2], const Unit& u, int wr, int wc, int fr, int fq) const {
        const int row0 = u.pm * BM + wr * 64 + fr, col0 = u.pn * BM + wc * 32 + 8 * fq;
        f32x4 gv[2][2];
#pragma unroll
        for (int bj = 0; bj < 2; ++bj)
#pragma unroll
            for (int n = 0; n < 2; ++n) gv[bj][n] = *(const GAS f32x4*)(gate + col0 + bj * HALF + n * 4);
#pragma unroll
        for (int ai = 0; ai < 2; ++ai)
#pragma unroll
            for (int m = 0; m < 4; ++m) { bf16_t* dst = y + (size_t)(row0 + ai * HALF + m * 16) * D + col0;
#pragma unroll
                for (int bj = 0; bj < 2; ++bj) *(GAS u32x4*)(dst + bj * HALF) = pk8(gv[bj][0] * acc[ai][bj][m][0], gv[bj][1] * acc[ai][bj][m][1]);
                if (m & 1) asm volatile("" ::: "memory"); }
    }
};
template <class Epi, class Sched, bool ALIGN_EPI = false, bool SP2 = false, int SCB = 0, int SCA = 0>
__device__ __forceinline__ void gemm_phase(PG8_LAS unsigned char* lds, const Gemm g, const Sched& S, const Epi& E) {
    int tid_ = threadIdx.x; asm volatile("" : "+v"(tid_));
    const int tid = tid_, wid = __builtin_amdgcn_readfirstlane(tid >> 6), lane = tid & 63, wr = wid >> 2, wc = wid & 3, fr = lane & 15, fq = lane >> 4;
    const int K = g.K, nt = K / BK;
    unsigned voffA[2], voffB[2];
#pragma unroll
    for (int i = 0; i < 2; ++i) { int R, C; stage_rc(tid * 16 + i * 8192, R, C); const int Rb = Epi::PERM ? ((R & ~31) + perm32(R & 31)) : R;
        voffA[i] = (unsigned)(R * K + C) * 2u; voffB[i] = (unsigned)(Rb * K + C) * 2u; }
    const size_t kstep = (size_t)(BK * 2);
    const size_t hstep = (size_t)HALF * K * 2;
    const size_t tstep = 2 * hstep;
    const unsigned ldsw = (unsigned)wid * 1024u;
    const int aoff = lds_byte(wr * 64 + fr, fq * 8), boff = lds_byte(wc * 32 + fr, fq * 8);
#define PG8_SA(b, h) (((b) * 2 + (h)) * HTB)
#define PG8_SB(b, h) ((4 + (b) * 2 + (h)) * HTB)
#define PG8_STAGE(bufoff, gbase, voff) do { _Pragma("unroll") for (int _i = 0; _i < 2; ++_i) \
        __builtin_amdgcn_global_load_lds((const unsigned*)((const char*)(gbase) + (voff)[_i]), (PG8_LAS unsigned*)(lds + (bufoff) + ldsw + _i * 8192), 16, 0, 0); } while (0)
#define PG8_LDA(dst, b, h) do { if constexpr (SCB != 0) { _Pragma("unroll") for (int m = 0; m < 4; ++m) dst##8[m] = ld2x16(lds + PG8_SA(b, h) + aoff + m * 2048); } \
        else { _Pragma("unroll") for (int m = 0; m < 4; ++m) _Pragma("unroll") for (int k = 0; k < 2; ++k) dst[m][k] = *(const PG8_LAS bf16x8*)(lds + PG8_SA(b, h) + aoff + m * 2048 + k * 1024); } } while (0)
#define PG8_LDB(dst, b, h) do { if constexpr (SCB != 0) { _Pragma("unroll") for (int n = 0; n < 2; ++n) dst##8[n] = ld2x16(lds + PG8_SB(b, h) + boff + n * 2048); } \
        else { _Pragma("unroll") for (int n = 0; n < 2; ++n) _Pragma("unroll") for (int k = 0; k < 2; ++k) dst[n][k] = *(const PG8_LAS bf16x8*)(lds + PG8_SB(b, h) + boff + n * 2048 + k * 1024); } } while (0)
#define PG8_MMA(ai, bj, At, Bt) do { __builtin_amdgcn_s_setprio(1); \
        if constexpr (SCB != 0) { _Pragma("unroll") for (int m = 0; m < 4; ++m) _Pragma("unroll") for (int n = 0; n < 2; ++n) \
            asm volatile("v_mfma_scale_f32_16x16x128_f8f6f4 %0, %1, %2, %0, %3, %4 op_sel_hi:[0,0,0]" : "+v"(acc[ai][bj][m][n]) : "v"(Bt##8[n]), "v"(At##8[m]), "v"(scb_), "v"(sca_)); } \
        else { _Pragma("unroll") for (int m = 0; m < 4; ++m) _Pragma("unroll") for (int n = 0; n < 2; ++n) _Pragma("unroll") for (int k = 0; k < 2; ++k) \
            acc[ai][bj][m][n] = __builtin_amdgcn_mfma_f32_16x16x32_bf16(Bt[n][k], At[m][k], acc[ai][bj][m][n], 0, 0, 0); } \
        __builtin_amdgcn_s_setprio(0); } while (0)
#define PG8_WAIT_V(n) asm volatile("s_waitcnt vmcnt(" #n ")" ::: "memory")
#define PG8_WAIT_L(n) asm volatile("s_waitcnt lgkmcnt(" #n ")" ::: "memory")
#define PG8_BAR __builtin_amdgcn_s_barrier()
#define PG8_SCHED __builtin_amdgcn_sched_barrier(0)
    Unit cur, nxt; int ui = 0;
    if (!S.next(0, cur)) return;
    f32x4 acc[2][2][4][2];
#pragma unroll
    for (int a = 0; a < 2; ++a)
#pragma unroll
        for (int b = 0; b < 2; ++b)
#pragma unroll
            for (int m = 0; m < 4; ++m)
#pragma unroll
                for (int n = 0; n < 2; ++n) acc[a][b][m][n] = (f32x4){0.f, 0.f, 0.f, 0.f};
    int scb_ = SCB, sca_ = SCA; asm volatile("" : "+v"(scb_), "+v"(sca_));
    bf16x8 At[4][2], B0[2][2], B1[2][2]; i32x8 At8[4], B08[2], B18[2];
    const char* cA = (const char*)g.A + (size_t)cur.pm * tstep; const char* cB = (const char*)g.Bt + (size_t)cur.pn * tstep;
    S.a_ready(cur);
    if constexpr (SP2) {
        PG8_STAGE(PG8_SB(0, 0), cB, voffB); PG8_STAGE(PG8_SB(0, 1), cB + hstep, voffB); PG8_STAGE(PG8_SA(0, 0), cA, voffA); PG8_STAGE(PG8_SA(0, 1), cA + hstep, voffA);
        if (wr == 1) PG8_BAR;
        PG8_WAIT_V(2); PG8_BAR;
        PG8_STAGE(PG8_SB(1, 0), cB + kstep, voffB); PG8_STAGE(PG8_SA(1, 0), cA + kstep, voffA); PG8_STAGE(PG8_SB(1, 1), cB + hstep + kstep, voffB);
        PG8_WAIT_V(6); PG8_BAR;
    } else {
        PG8_STAGE(PG8_SB(0, 0), cB, voffB); PG8_STAGE(PG8_SA(0, 0), cA, voffA); PG8_STAGE(PG8_SB(0, 1), cB + hstep, voffB); PG8_STAGE(PG8_SA(0, 1), cA + hstep, voffA);
        if (wr == 1) PG8_BAR;
        PG8_WAIT_V(4); PG8_BAR;
        PG8_STAGE(PG8_SB(1, 0), cB + kstep, voffB); PG8_STAGE(PG8_SA(1, 0), cA + kstep, voffA); PG8_STAGE(PG8_SB(1, 1), cB + hstep + kstep, voffB);
        PG8_WAIT_V(6); PG8_BAR;
    }
    for (;;) {
        const bool has_next = S.next(ui + 1, nxt);
        const char* nA = has_next ? (const char*)g.A + (size_t)nxt.pm * tstep : cA; const char* nB = has_next ? (const char*)g.Bt + (size_t)nxt.pn * tstep : cB;
#pragma unroll 1
        for (int t = 0; t < nt; t += 2) {
            const bool last = (t == nt - 2);
            const char* a1 = cA + (size_t)(t + 1) * kstep;
            const char* a2 = last ? nA : cA + (size_t)(t + 2) * kstep; const char* b2 = last ? nB : cB + (size_t)(t + 2) * kstep;
            const char* a3 = a2 + kstep; const char* b3 = b2 + kstep;
            if (last && has_next) S.a_ready(nxt);
            if constexpr (SP2) {
            PG8_LDB(B0, 0, 0); PG8_LDB(B1, 0, 1); PG8_SCHED; PG8_LDA(At, 0, 0); PG8_STAGE(PG8_SA(1, 1), a1 + hstep, voffA);
            PG8_WAIT_V(8); PG8_WAIT_L(0); PG8_BAR; PG8_MMA(0, 0, At, B0); PG8_MMA(0, 1, At, B1); PG8_BAR; PG8_SCHED;
            PG8_LDA(At, 0, 1); PG8_STAGE(PG8_SB(0, 0), b2, voffB); PG8_STAGE(PG8_SB(0, 1), b2 + hstep, voffB); PG8_STAGE(PG8_SA(0, 0), a2, voffA);
            PG8_WAIT_V(8); PG8_WAIT_L(0); PG8_BAR; PG8_MMA(1, 0, At, B0); PG8_MMA(1, 1, At, B1); PG8_BAR; PG8_SCHED;
            PG8_LDB(B0, 1, 0); PG8_LDB(B1, 1, 1); PG8_SCHED; PG8_LDA(At, 1, 0); PG8_STAGE(PG8_SA(0, 1), a2 + hstep, voffA);
            PG8_WAIT_V(8); PG8_WAIT_L(0); PG8_BAR; PG8_MMA(0, 0, At, B0); PG8_MMA(0, 1, At, B1); PG8_BAR; PG8_SCHED;
            PG8_LDA(At, 1, 1); PG8_STAGE(PG8_SB(1, 0), b3, voffB); PG8_STAGE(PG8_SB(1, 1), b3 + hstep, voffB); PG8_STAGE(PG8_SA(1, 0), a3, voffA);
            PG8_WAIT_V(8); PG8_WAIT_L(0); PG8_BAR; PG8_MMA(1, 0, At, B0); PG8_MMA(1, 1, At, B1); PG8_BAR; PG8_SCHED;
            } else {
            PG8_LDB(B0, 0, 0); PG8_SCHED; PG8_LDA(At, 0, 0); PG8_STAGE(PG8_SA(1, 1), a1 + hstep, voffA);
            PG8_WAIT_L(8); PG8_BAR; PG8_WAIT_L(0); PG8_MMA(0, 0, At, B0); PG8_BAR; PG8_SCHED;
            PG8_LDB(B1, 0, 1); PG8_STAGE(PG8_SB(0, 0), b2, voffB);
            PG8_BAR; PG8_WAIT_L(0); PG8_MMA(0, 1, At, B1); PG8_BAR;
            PG8_LDA(At, 0, 1); PG8_STAGE(PG8_SA(0, 0), a2, voffA);
            PG8_BAR; PG8_WAIT_L(0); PG8_MMA(1, 0, At, B0); PG8_BAR; PG8_SCHED;
            PG8_STAGE(PG8_SB(0, 1), b2 + hstep, voffB);
            PG8_WAIT_V(6); PG8_BAR; PG8_MMA(1, 1, At, B1); PG8_BAR;
            PG8_LDB(B0, 1, 0); PG8_SCHED; PG8_LDA(At, 1, 0); PG8_STAGE(PG8_SA(0, 1), a2 + hstep, voffA);
            PG8_WAIT_L(8); PG8_BAR; PG8_WAIT_L(0); PG8_MMA(0, 0, At, B0); PG8_BAR; PG8_SCHED;
            PG8_LDB(B1, 1, 1); PG8_STAGE(PG8_SB(1, 0), b3, voffB);
            PG8_BAR; PG8_WAIT_L(0); PG8_MMA(0, 1, At, B1); PG8_BAR;
            PG8_LDA(At, 1, 1); PG8_STAGE(PG8_SA(1, 0), a3, voffA);
            PG8_BAR; PG8_WAIT_L(0); PG8_MMA(1, 0, At, B0); PG8_BAR; PG8_SCHED;
            PG8_STAGE(PG8_SB(1, 1), b3 + hstep, voffB);
            PG8_WAIT_V(6); PG8_BAR; PG8_MMA(1, 1, At, B1); PG8_BAR;
            }
        }
        if constexpr (SCB != 0) asm volatile("s_nop 15\n\ts_nop 15" ::: "memory");
        if constexpr (ALIGN_EPI) { if (wr == 0) PG8_BAR; }
        if constexpr (!Epi::AFTER_DRAIN) { int fr_ = fr, fq_ = fq; asm volatile("" : "+v"(fr_), "+v"(fq_));
            E(acc, cur, wr, wc, fr_, fq_); S.done(cur); }
        if (!has_next) break;
#pragma unroll
        for (int a = 0; a < 2; ++a)
#pragma unroll
            for (int b = 0; b < 2; ++b)
#pragma unroll
                for (int m = 0; m < 4; ++m)
#pragma unroll
                    for (int n = 0; n < 2; ++n) acc[a][b][m][n] = (f32x4){0.f, 0.f, 0.f, 0.f};
        cur = nxt; cA = nA; cB = nB; ++ui;
        if constexpr (ALIGN_EPI) { if (wr == 1) PG8_BAR; }
    }
    PG8_WAIT_V(0);
    if constexpr (!ALIGN_EPI) { if (wr == 0) PG8_BAR; }
    PG8_BAR;
    if constexpr (Epi::AFTER_DRAIN) { E.fused(acc, cur, wr, wc, fr, fq, lds, wid, lane); S.done(cur); }
#undef PG8_SA
#undef PG8_SB
#undef PG8_STAGE
#undef PG8_LDA
#undef PG8_LDB
#undef PG8_MMA
#undef PG8_WAIT_V
#undef PG8_WAIT_L
#undef PG8_BAR
#undef PG8_SCHED
}
}
namespace att {
constexpr int KS_M = 400, KS_N = 272, VS = 320;
constexpr int MLA_KB = 64 * KS_M, NSA_KB = 64 * KS_N, VB = 64 * VS;
constexpr int N_IMP = 2 * NSA_KB + 2 * VB;
constexpr int N_PART = N_IMP + 32768;
constexpr int N_PARTB = 8 * 32 * 17 * 4;
constexpr int N_SELM = N_PART + 2 * N_PARTB;
constexpr int N_ULIST = N_SELM + 1024;
constexpr int N_CARRY = N_ULIST + 1024;
constexpr int N_NTS = N_CARRY + 256;
static_assert(N_NTS + 16 <= MISC_OFF, "NSA LDS map");
static_assert(2 * MLA_KB + 3 * VB <= 131072, "MLA LDS map");
constexpr int MLA_QL = 2 * MLA_KB + 2 * VB;
static_assert(MLA_QL + 8 * 4096 <= 131072, "MLA LDS map (pipelined)");

#ifndef QK_PF
#define QK_PF 4
#endif
#define MFMA32(a, b, c) __builtin_amdgcn_mfma_f32_32x32x16_bf16((a), (b), (c), 0, 0, 0)
__device__ __forceinline__ float swapmax(float v) { auto rr = __builtin_amdgcn_permlane32_swap(__float_as_uint(v), __float_as_uint(v), false, false); return fmaxf(__uint_as_float(rr[0]), __uint_as_float(rr[1])); }
__device__ __forceinline__ float swapsum(float v) { auto rr = __builtin_amdgcn_permlane32_swap(__float_as_uint(v), __float_as_uint(v), false, false); return __uint_as_float(rr[0]) + __uint_as_float(rr[1]); }
template <int SIDX> __device__ __forceinline__ bf16x8 packp(const f32x16& p) {
    f32x8 t = {p[8 * SIDX + 0], p[8 * SIDX + 1], p[8 * SIDX + 2], p[8 * SIDX + 3], p[8 * SIDX + 4], p[8 * SIDX + 5], p[8 * SIDX + 6], p[8 * SIDX + 7]};
    return __builtin_bit_cast(bf16x8, __builtin_convertvector(t, bf16x8v));
}
template <int NDC, int KS, bool ZERO = true> __device__ __forceinline__ void qk_tile(f32x16& p0, f32x16& p1, const LAS unsigned char* kl, const bf16x8 (&q)[NDC]) {
    if (ZERO) {
#pragma unroll
        for (int i = 0; i < 16; ++i) { p0[i] = 0.f; p1[i] = 0.f; }
    }
    constexpr int PF = QK_PF;
    bf16x8 a[PF + 1][2];
#pragma unroll
    for (int i = 0; i < PF; ++i) { a[i][0] = *(const LAS bf16x8*)(kl + i * 32); a[i][1] = *(const LAS bf16x8*)(kl + 32 * KS + i * 32); }
#pragma unroll
    for (int d0 = 0; d0 < NDC; ++d0) {
        if (d0 + PF < NDC) { a[(d0 + PF) % (PF + 1)][0] = *(const LAS bf16x8*)(kl + (d0 + PF) * 32); a[(d0 + PF) % (PF + 1)][1] = *(const LAS bf16x8*)(kl + 32 * KS + (d0 + PF) * 32); }
        __builtin_amdgcn_sched_barrier(0);
        p0 = MFMA32(a[d0 % (PF + 1)][0], q[d0], p0); p1 = MFMA32(a[d0 % (PF + 1)][1], q[d0], p1);
        __builtin_amdgcn_sched_barrier(0);
    }
}
#ifdef PROBE_QKM2
template <int NDC, int KS> __device__ __forceinline__ void qk_tile_m2(f32x16& p0, f32x16& p1, f32x16& r0, f32x16& r1, const LAS unsigned char* kl, const bf16x8 (&q)[NDC]) {
#pragma unroll
    for (int i = 0; i < 16; ++i) { p0[i] = 0.f; p1[i] = 0.f; r0[i] = 0.f; r1[i] = 0.f; }
    constexpr int PF = QK_PF;
    bf16x8 a[PF + 1][2];
#pragma unroll
    for (int i = 0; i < PF; ++i) { a[i][0] = *(const LAS bf16x8*)(kl + i * 32); a[i][1] = *(const LAS bf16x8*)(kl + 32 * KS + i * 32); }
#pragma unroll
    for (int d0 = 0; d0 < NDC; ++d0) {
        if (d0 + PF < NDC) { a[(d0 + PF) % (PF + 1)][0] = *(const LAS bf16x8*)(kl + (d0 + PF) * 32); a[(d0 + PF) % (PF + 1)][1] = *(const LAS bf16x8*)(kl + 32 * KS + (d0 + PF) * 32); }
        __builtin_amdgcn_sched_barrier(0);
        p0 = MFMA32(a[d0 % (PF + 1)][0], q[d0], p0); p1 = MFMA32(a[d0 % (PF + 1)][1], q[d0], p1);
        r0 = MFMA32(a[d0 % (PF + 1)][0], q[d0], r0); r1 = MFMA32(a[d0 % (PF + 1)][1], q[d0], r1);
        __builtin_amdgcn_sched_barrier(0);
    }
}
#endif
__device__ __forceinline__ void pv_tile(f32x16 (&o)[4], const bf16x8 (&pb)[4], const LAS unsigned char* vl) {
    s16x4 f[5][2];
#define PV_LD(idx) do { constexpr int d_ = (idx) >> 2, s_ = (idx) & 3; \
        f[(idx) % 5][0] = __builtin_amdgcn_ds_read_tr16_b64_v4i16((LAS s16x4*)(vl + s_ * 16 * VS + d_ * 64)); \
        f[(idx) % 5][1] = __builtin_amdgcn_ds_read_tr16_b64_v4i16((LAS s16x4*)(vl + s_ * 16 * VS + 8 * VS + d_ * 64)); } while (0)
    PV_LD(0); PV_LD(1); PV_LD(2); PV_LD(3);
#define PV_STEP(idx) do { if ((idx) + 4 < 16) PV_LD((idx) + 4); __builtin_amdgcn_sched_barrier(0); \
        { const s16x4 t0_ = f[(idx) % 5][0], t1_ = f[(idx) % 5][1]; const bf16x8 vf_ = {t0_[0], t0_[1], t0_[2], t0_[3], t1_[0], t1_[1], t1_[2], t1_[3]}; \
          o[(idx) >> 2] = MFMA32(vf_, pb[(idx) & 3], o[(idx) >> 2]); } __builtin_amdgcn_sched_barrier(0); } while (0)
    PV_STEP(0); PV_STEP(1); PV_STEP(2); PV_STEP(3); PV_STEP(4); PV_STEP(5); PV_STEP(6); PV_STEP(7);
    PV_STEP(8); PV_STEP(9); PV_STEP(10); PV_STEP(11); PV_STEP(12); PV_STEP(13); PV_STEP(14); PV_STEP(15);
#undef PV_STEP
#undef PV_LD
}
template <int NDC, int NQR, int KS> __device__ __forceinline__ void qk_tile_free(f32x16& p0, f32x16& p1, const LAS unsigned char* kl, const bf16x8 (&q)[NQR], const LAS unsigned char* ql) {
#pragma unroll
    for (int i = 0; i < 16; ++i) { p0[i] = 0.f; p1[i] = 0.f; }
#pragma unroll
    for (int d0 = 0; d0 < NDC; ++d0) {
        const bf16x8 a0 = *(const LAS bf16x8*)(kl + d0 * 32);
        const bf16x8 a1 = *(const LAS bf16x8*)(kl + 32 * KS + d0 * 32);
        bf16x8 qq; if (d0 < NQR) qq = q[d0 < NQR ? d0 : 0]; else qq = *(const LAS bf16x8*)(ql + (d0 - NQR) * 1024);
        p0 = MFMA32(a0, qq, p0); p1 = MFMA32(a1, qq, p1);
    }
}
__device__ __forceinline__ float sm_core(f32x16& p0, f32x16& p1, float& m, float& l) {
    float tm = p0[0];
#pragma unroll
    for (int r = 1; r < 16; ++r) tm = fmaxf(tm, p0[r]);
#pragma unroll
    for (int r = 0; r < 16; ++r) tm = fmaxf(tm, p1[r]);
    tm = swapmax(tm);
    const float mn = fmaxf(m, tm);
    const float alpha = __builtin_amdgcn_exp2f(m - mn);
    m = mn;
    float ps = 0.f;
#pragma unroll
    for (int r = 0; r < 16; ++r) { p0[r] = __builtin_amdgcn_exp2f(p0[r] - mn); ps += p0[r]; }
#pragma unroll
    for (int r = 0; r < 16; ++r) { p1[r] = __builtin_amdgcn_exp2f(p1[r] - mn); ps += p1[r]; }
    ps = swapsum(ps);
    l = l * alpha + ps;
    return alpha;
}
__device__ __forceinline__ void online_sm(f32x16& p0, f32x16& p1, float& m, float& l, f32x16 (&o)[4]) {
    float tm = p0[0];
#pragma unroll
    for (int r = 1; r < 16; ++r) tm = fmaxf(tm, p0[r]);
#pragma unroll
    for (int r = 0; r < 16; ++r) tm = fmaxf(tm, p1[r]);
    tm = swapmax(tm);
    const float mn = fmaxf(m, tm);
    const float alpha = __builtin_amdgcn_exp2f(m - mn);
    m = mn;
    float ps = 0.f;
#pragma unroll
    for (int r = 0; r < 16; ++r) { p0[r] = __builtin_amdgcn_exp2f(p0[r] - mn); ps += p0[r]; }
#pragma unroll
    for (int r = 0; r < 16; ++r) { p1[r] = __builtin_amdgcn_exp2f(p1[r] - mn); ps += p1[r]; }
    ps = swapsum(ps);
    l = l * alpha + ps;
    if (!__all(alpha == 1.f)) {
#pragma unroll
        for (int d = 0; d < 4; ++d)
#pragma unroll
            for (int r = 0; r < 16; ++r) o[d][r] *= alpha;
    }
}

#ifdef MLA_FP8
typedef long i64;
constexpr int KS8 = 200, MLA_KB8 = 64 * KS8;
static_assert(2 * MLA_KB8 + 3 * VB <= 131072, "MLA fp8 LDS map");
#define MFMA32F8(a, b, c) __builtin_amdgcn_mfma_f32_32x32x16_fp8_fp8((a), (b), (c), 0, 0, 0)
template <int NDC> __device__ __forceinline__ void qk_tile8(f32x16& p0, f32x16& p1, const LAS unsigned char* kl, const i64 (&q)[NDC]) {
#pragma unroll
    for (int i = 0; i < 16; ++i) { p0[i] = 0.f; p1[i] = 0.f; }
    constexpr int PF = 4;
    i64 a[PF + 1][2];
#pragma unroll
    for (int i = 0; i < PF; ++i) { a[i][0] = *(const LAS i64*)(kl + i * 16); a[i][1] = *(const LAS i64*)(kl + 32 * KS8 + i * 16); }
#pragma unroll
    for (int d0 = 0; d0 < NDC; ++d0) {
        if (d0 + PF < NDC) { a[(d0 + PF) % (PF + 1)][0] = *(const LAS i64*)(kl + (d0 + PF) * 16); a[(d0 + PF) % (PF + 1)][1] = *(const LAS i64*)(kl + 32 * KS8 + (d0 + PF) * 16); }
        __builtin_amdgcn_sched_barrier(0);
        __builtin_amdgcn_s_setprio(1);
        p0 = MFMA32F8(a[d0 % (PF + 1)][0], q[d0], p0); p1 = MFMA32F8(a[d0 % (PF + 1)][1], q[d0], p1);
        __builtin_amdgcn_s_setprio(0);
        __builtin_amdgcn_sched_barrier(0);
    }
}
__device__ __forceinline__ void online_sm_scaled(f32x16& p0, f32x16& p1, float& m, float& l, f32x16 (&o)[4], const float C2) {
    float tm = p0[0];
#pragma unroll
    for (int r = 1; r < 16; ++r) tm = fmaxf(tm, p0[r]);
#pragma unroll
    for (int r = 0; r < 16; ++r) tm = fmaxf(tm, p1[r]);
    tm = swapmax(tm);
    const float mn = fmaxf(m, tm);
    const float alpha = __builtin_amdgcn_exp2f((m - mn) * C2);
    m = mn;
    const float mc = -mn * C2;
    float ps = 0.f;
#pragma unroll
    for (int r = 0; r < 16; ++r) { p0[r] = __builtin_amdgcn_exp2f(__builtin_fmaf(p0[r], C2, mc)); ps += p0[r]; }
#pragma unroll
    for (int r = 0; r < 16; ++r) { p1[r] = __builtin_amdgcn_exp2f(__builtin_fmaf(p1[r], C2, mc)); ps += p1[r]; }
    ps = swapsum(ps);
    l = l * alpha + ps;
    if (!__all(alpha == 1.f)) {
#pragma unroll
        for (int d = 0; d < 4; ++d)
#pragma unroll
            for (int r = 0; r < 16; ++r) o[d][r] *= alpha;
    }
}
#endif
#ifdef MLA_FP8V
constexpr int VS8 = 72, VB8 = 128 * VS8;
constexpr int VS8B = 136, VB8B = 128 * VS8B, MLA_KB8B = 128 * KS8;
static_assert(2 * MLA_KB8B + 3 * VB8B <= 131072, "MLA big-tile LDS map");
#ifdef MLA_BIG
#define PV8_RS VS8B
#else
#define PV8_RS VS8
#endif
static_assert(2 * MLA_KB8 + 3 * VB8 <= 131072, "MLA fp8 LDS map");
template <int SIDX> __device__ __forceinline__ i64 packp8(const f32x16& p) {
    int w0 = __builtin_amdgcn_cvt_pk_fp8_f32(p[8 * SIDX + 0] * 256.f, p[8 * SIDX + 1] * 256.f, 0, false); w0 = __builtin_amdgcn_cvt_pk_fp8_f32(p[8 * SIDX + 2] * 256.f, p[8 * SIDX + 3] * 256.f, w0, true);
    int w1 = __builtin_amdgcn_cvt_pk_fp8_f32(p[8 * SIDX + 4] * 256.f, p[8 * SIDX + 5] * 256.f, 0, false); w1 = __builtin_amdgcn_cvt_pk_fp8_f32(p[8 * SIDX + 6] * 256.f, p[8 * SIDX + 7] * 256.f, w1, true);
    return (i64)(((unsigned long long)(unsigned)w1 << 32) | (unsigned)w0);
}
__device__ __forceinline__ void pv_tile8(f32x16 (&o)[4], const i64 (&pb)[4], const LAS unsigned char* vl) {
    i64 f[5];
#define PV8_LD(idx) f[(idx) % 5] = *(const LAS i64*)(vl + ((idx) >> 2) * 32 * PV8_RS + ((idx) & 3) * 16)
    PV8_LD(0); PV8_LD(1); PV8_LD(2); PV8_LD(3);
#define PV8_STEP(idx) do { if ((idx) + 4 < 16) PV8_LD((idx) + 4); __builtin_amdgcn_sched_barrier(0); \
        o[(idx) >> 2] = MFMA32F8(f[(idx) % 5], pb[(idx) & 3], o[(idx) >> 2]); __builtin_amdgcn_sched_barrier(0); } while (0)
    PV8_STEP(0); PV8_STEP(1); PV8_STEP(2); PV8_STEP(3); PV8_STEP(4); PV8_STEP(5); PV8_STEP(6); PV8_STEP(7);
    PV8_STEP(8); PV8_STEP(9); PV8_STEP(10); PV8_STEP(11); PV8_STEP(12); PV8_STEP(13); PV8_STEP(14); PV8_STEP(15);
#undef PV8_STEP
#undef PV8_LD
}
#endif
#ifdef MLA_MX
typedef int i32x8 __attribute__((ext_vector_type(8)));
constexpr int KSX = 208, MLA_KBX = 64 * KSX;
constexpr int VSX = 80, VBX = 128 * VSX;
static_assert(2 * MLA_KBX + 3 * VBX <= 131072, "MLA mx LDS map");
#define MFMAX(a, b, c) __builtin_amdgcn_mfma_scale_f32_32x32x64_f8f6f4((a), (b), (c), 0, 0, 0, 0x7f7f7f7f, 0, 0x7f7f7f7f)
__device__ __forceinline__ i32x8 ldsx(const LAS unsigned char* p) {
    const u32x4 a = *(const LAS u32x4*)p, b = *(const LAS u32x4*)(p + 16);
    return (i32x8){(int)a.x, (int)a.y, (int)a.z, (int)a.w, (int)b.x, (int)b.y, (int)b.z, (int)b.w};
}
__device__ __forceinline__ void qk_tilex(f32x16& p0, f32x16& p1, const LAS unsigned char* kl, const i32x8 (&q)[3]) {
#pragma unroll
    for (int i = 0; i < 16; ++i) { p0[i] = 0.f; p1[i] = 0.f; }
    i32x8 a0 = ldsx(kl), a1 = ldsx(kl + 32 * KSX), a2 = ldsx(kl + 64), a3 = ldsx(kl + 32 * KSX + 64);
    __builtin_amdgcn_sched_barrier(0);
    __builtin_amdgcn_s_setprio(1);
    p0 = MFMAX(a0, q[0], p0); p1 = MFMAX(a1, q[0], p1);
    __builtin_amdgcn_s_setprio(0);
    __builtin_amdgcn_sched_barrier(0);
    a0 = ldsx(kl + 128); a1 = ldsx(kl + 32 * KSX + 128);
    __builtin_amdgcn_sched_barrier(0);
    __builtin_amdgcn_s_setprio(1);
    p0 = MFMAX(a2, q[1], p0); p1 = MFMAX(a3, q[1], p1);
    __builtin_amdgcn_sched_barrier(0);
    p0 = MFMAX(a0, q[2], p0); p1 = MFMAX(a1, q[2], p1);
    __builtin_amdgcn_s_setprio(0);
    __builtin_amdgcn_sched_barrier(0);
}
__device__ __forceinline__ void pv_tilex(f32x16 (&o)[4], const i32x8& pb, const LAS unsigned char* vl) {
    i32x8 f0 = ldsx(vl), f1 = ldsx(vl + 32 * VSX);
    __builtin_amdgcn_sched_barrier(0);
    o[0] = MFMAX(f0, pb, o[0]);
    __builtin_amdgcn_sched_barrier(0);
    f0 = ldsx(vl + 64 * VSX);
    __builtin_amdgcn_sched_barrier(0);
    o[1] = MFMAX(f1, pb, o[1]);
    __builtin_amdgcn_sched_barrier(0);
    f1 = ldsx(vl + 96 * VSX);
    __builtin_amdgcn_sched_barrier(0);
    o[2] = MFMAX(f0, pb, o[2]);
    __builtin_amdgcn_sched_barrier(0);
    o[3] = MFMAX(f1, pb, o[3]);
    __builtin_amdgcn_sched_barrier(0);
}
__device__ __forceinline__ i32x8 packpx(const f32x16& p0, const f32x16& p1) {
    i32x8 w;
#pragma unroll
    for (int g = 0; g < 4; ++g) {
        int a = __builtin_amdgcn_cvt_pk_fp8_f32(p0[4 * g + 0], p0[4 * g + 1], 0, false); a = __builtin_amdgcn_cvt_pk_fp8_f32(p0[4 * g + 2], p0[4 * g + 3], a, true); w[g] = a;
        int b = __builtin_amdgcn_cvt_pk_fp8_f32(p1[4 * g + 0], p1[4 * g + 1], 0, false); b = __builtin_amdgcn_cvt_pk_fp8_f32(p1[4 * g + 2], p1[4 * g + 3], b, true); w[4 + g] = b;
    }
    return w;
}
__device__ __forceinline__ void online_sm_x(f32x16& p0, f32x16& p1, float& m, float& l, f32x16 (&o)[4], const float C2) {
    float tm = p0[0];
#pragma unroll
    for (int r = 1; r < 16; ++r) tm = fmaxf(tm, p0[r]);
#pragma unroll
    for (int r = 0; r < 16; ++r) tm = fmaxf(tm, p1[r]);
    tm = swapmax(tm);
    const float mn = fmaxf(m, tm);
    const float alpha = __builtin_amdgcn_exp2f((m - mn) * C2);
    m = mn;
    const float mc = 8.f - mn * C2;
    float ps = 0.f;
#pragma unroll
    for (int r = 0; r < 16; ++r) { p0[r] = __builtin_amdgcn_exp2f(__builtin_fmaf(p0[r], C2, mc)); ps += p0[r]; }
#pragma unroll
    for (int r = 0; r < 16; ++r) { p1[r] = __builtin_amdgcn_exp2f(__builtin_fmaf(p1[r], C2, mc)); ps += p1[r]; }
    ps = swapsum(ps);
    l = l * alpha + ps;
    if (!__all(alpha == 1.f)) {
#pragma unroll
        for (int d = 0; d < 4; ++d)
#pragma unroll
            for (int r = 0; r < 16; ++r) o[d][r] *= alpha;
    }
}
#endif
#ifdef MLA_MXL
#ifdef MLA_MXU
#define MXL_T 126.0f
#define MXL_REF 120.0f
#define MFMAXQ(a, b, c) __builtin_amdgcn_mfma_scale_f32_32x32x64_f8f6f4((a), (b), (c), 0, 0, 0, 0x7f7f7f7f, 0, 0x7f7f7f7f)
__device__ __forceinline__ i32x8 byte_packx(const f32x16& p0, const f32x16& p1) {
    i32x8 w;
#pragma unroll
    for (int g = 0; g < 4; ++g) {
        unsigned a = __builtin_amdgcn_cvt_pk_u8_f32(p0[4 * g + 0], 0, 0u); a = __builtin_amdgcn_cvt_pk_u8_f32(p0[4 * g + 1], 1, a); a = __builtin_amdgcn_cvt_pk_u8_f32(p0[4 * g + 2], 2, a); a = __builtin_amdgcn_cvt_pk_u8_f32(p0[4 * g + 3], 3, a); w[g] = (int)a;
        unsigned b = __builtin_amdgcn_cvt_pk_u8_f32(p1[4 * g + 0], 0, 0u); b = __builtin_amdgcn_cvt_pk_u8_f32(p1[4 * g + 1], 1, b); b = __builtin_amdgcn_cvt_pk_u8_f32(p1[4 * g + 2], 2, b); b = __builtin_amdgcn_cvt_pk_u8_f32(p1[4 * g + 3], 3, b); w[4 + g] = (int)b;
    }
    return w;
}
#else
#define MXL_T 7.0f
#define MXL_REF 0.0f
#define MFMAXQ(a, b, c) __builtin_amdgcn_mfma_scale_f32_32x32x64_f8f6f4((a), (b), (c), 0, 0, 0, 0x7f7f7f7f, 0, 0x7c7c7c7c)
#endif
__device__ __forceinline__ void qk_tilexl(f32x16& p0, f32x16& p1, const f32x16& mref, const LAS unsigned char* kl, const i32x8 (&q)[3]) {
    i32x8 a0 = ldsx(kl), a1 = ldsx(kl + 32 * KSX), a2 = ldsx(kl + 64), a3 = ldsx(kl + 32 * KSX + 64);
    __builtin_amdgcn_sched_barrier(0);
    __builtin_amdgcn_s_setprio(1);
    p0 = MFMAXQ(a0, q[0], mref); p1 = MFMAXQ(a1, q[0], mref);
    __builtin_amdgcn_s_setprio(0);
    __builtin_amdgcn_sched_barrier(0);
    a0 = ldsx(kl + 128); a1 = ldsx(kl + 32 * KSX + 128);
    __builtin_amdgcn_sched_barrier(0);
    __builtin_amdgcn_s_setprio(1);
    p0 = MFMAXQ(a2, q[1], p0); p1 = MFMAXQ(a3, q[1], p1);
    __builtin_amdgcn_sched_barrier(0);
    p0 = MFMAXQ(a0, q[2], p0); p1 = MFMAXQ(a1, q[2], p1);
    __builtin_amdgcn_s_setprio(0);
    __builtin_amdgcn_sched_barrier(0);
}
template <int RS = VSX>
__device__ __forceinline__ void pv_tilexl(f32x16 (&o)[5], const i32x8& pb, const i32x8& ones, const LAS unsigned char* vl) {
    i32x8 f0 = ldsx(vl), f1 = ldsx(vl + 32 * RS);
    __builtin_amdgcn_sched_barrier(0);
    o[4] = MFMAX(ones, pb, o[4]);
    __builtin_amdgcn_sched_barrier(0);
    o[0] = MFMAX(f0, pb, o[0]);
    __builtin_amdgcn_sched_barrier(0);
    f0 = ldsx(vl + 64 * RS);
    __builtin_amdgcn_sched_barrier(0);
    o[1] = MFMAX(f1, pb, o[1]);
    __builtin_amdgcn_sched_barrier(0);
    f1 = ldsx(vl + 96 * RS);
    __builtin_amdgcn_sched_barrier(0);
    o[2] = MFMAX(f0, pb, o[2]);
    __builtin_amdgcn_sched_barrier(0);
    o[3] = MFMAX(f1, pb, o[3]);
    __builtin_amdgcn_sched_barrier(0);
}
__device__ __forceinline__ i32x8 exp_packx(const f32x16& p0, const f32x16& p1, int any) {
    i32x8 w;
#pragma unroll
    for (int g = 0; g < 4; ++g) {
        int a = __builtin_amdgcn_cvt_pk_fp8_f32(__builtin_amdgcn_exp2f(p0[4 * g + 0]), __builtin_amdgcn_exp2f(p0[4 * g + 1]), any, false);
        a = __builtin_amdgcn_cvt_pk_fp8_f32(__builtin_amdgcn_exp2f(p0[4 * g + 2]), __builtin_amdgcn_exp2f(p0[4 * g + 3]), a, true); w[g] = a;
        int b = __builtin_amdgcn_cvt_pk_fp8_f32(__builtin_amdgcn_exp2f(p1[4 * g + 0]), __builtin_amdgcn_exp2f(p1[4 * g + 1]), any, false);
        b = __builtin_amdgcn_cvt_pk_fp8_f32(__builtin_amdgcn_exp2f(p1[4 * g + 2]), __builtin_amdgcn_exp2f(p1[4 * g + 3]), b, true); w[4 + g] = b;
    }
    return w;
}
#endif
#ifdef MLA_PIPE8
template <int NDC> __device__ __forceinline__ void qk_tile8_free(f32x16& p0, f32x16& p1, const LAS unsigned char* kl, const i64 (&q)[NDC]) {
#pragma unroll
    for (int i = 0; i < 16; ++i) { p0[i] = 0.f; p1[i] = 0.f; }
#pragma unroll
    for (int d0 = 0; d0 < NDC; ++d0) {
        const i64 a0 = *(const LAS i64*)(kl + d0 * 16), a1 = *(const LAS i64*)(kl + 32 * KS8 + d0 * 16);
        p0 = MFMA32F8(a0, q[d0], p0); p1 = MFMA32F8(a1, q[d0], p1);
    }
}
__device__ __forceinline__ float sm_core_scaled(f32x16& p0, f32x16& p1, float& m, float& l, const float C2) {
    float tm = p0[0];
#pragma unroll
    for (int r = 1; r < 16; ++r) tm = fmaxf(tm, p0[r]);
#pragma unroll
    for (int r = 0; r < 16; ++r) tm = fmaxf(tm, p1[r]);
    tm = swapmax(tm);
    const float mn = fmaxf(m, tm);
    const float alpha = __builtin_amdgcn_exp2f((m - mn) * C2);
    m = mn;
    const float mc = -mn * C2;
    float ps = 0.f;
#pragma unroll
    for (int r = 0; r < 16; ++r) { p0[r] = __builtin_amdgcn_exp2f(__builtin_fmaf(p0[r], C2, mc)); ps += p0[r]; }
#pragma unroll
    for (int r = 0; r < 16; ++r) { p1[r] = __builtin_amdgcn_exp2f(__builtin_fmaf(p1[r], C2, mc)); ps += p1[r]; }
    ps = swapsum(ps);
    l = l * alpha + ps;
    return alpha;
}
#endif
#ifdef MLA_PIPE8
struct MlaPtrs { const bf16* Q; const bf16* K; const bf16* V; const bf16* Z; bf16* O; };
__device__ __forceinline__ void mla_mask(f32x16& p0, f32x16& p1, int dq) {
#pragma unroll
    for (int r = 0; r < 16; ++r) { const int c = (r & 3) + 8 * (r >> 2);
        if (c > dq) p0[r] = -__builtin_inff();
        if (c + 32 > dq) p1[r] = -__builtin_inff(); }
}
__device__ __forceinline__ void mla_unit(LAS unsigned char* lds, const MlaPtrs& P, int head, int qb, int tid_in, int wave, int lane_in) {
    int tid = tid_in; asm volatile("" : "+v"(tid)); const int lane = tid & 63; (void)lane_in;
    const int r32 = lane & 31, hi = lane >> 5;
    const int q0 = qb * 256, qw = q0 + wave * 32, tq = qw + r32;
    i64 q[12];
    { const unsigned char* qp = (const unsigned char*)P.Q + (size_t)tq * 3072 + head * 192 + hi * 8;
#pragma unroll
      for (int d0 = 0; d0 < 12; ++d0) q[d0] = *(const GAS i64*)(qp + d0 * 16); }
    const int NT = 4 * (qb + 1);
    const int srow = tid >> 3, sc8 = tid & 7;
    const unsigned char* kg = (const unsigned char*)P.K + (size_t)head * 192 + (size_t)srow * 3072 + sc8 * 8;
    const unsigned char* vg = (const unsigned char*)P.V + ((size_t)head * 128 + (tid >> 2)) * S + (tid & 3) * 16;
    LAS unsigned char* kst = lds + srow * KS8 + sc8 * 8;
    LAS unsigned char* vst = lds + 2 * MLA_KB8 + (tid >> 2) * VS8 + (tid & 3) * 16;
    const LAS unsigned char* kl = lds + r32 * KS8 + hi * 8;
    const LAS unsigned char* vl = lds + 2 * MLA_KB8 + r32 * VS8 + hi * 8;
    u32x2 sk0, sk1, sk2; u32x4 sv0;
#define MLA_LOADK(j) do { const unsigned char* kp_ = kg + (size_t)(j) * (64 * 3072); sk0 = *(const GAS u32x2*)(kp_); sk1 = *(const GAS u32x2*)(kp_ + 64); sk2 = *(const GAS u32x2*)(kp_ + 128); } while (0)
#define MLA_LOADV(j) do { sv0 = *(const GAS u32x4*)(vg + (size_t)(j) * 64); } while (0)
#define MLA_STOREK(b) do { LAS unsigned char* kd_ = kst + (b) * MLA_KB8; *(LAS u32x2*)(kd_) = sk0; *(LAS u32x2*)(kd_ + 64) = sk1; *(LAS u32x2*)(kd_ + 128) = sk2; } while (0)
#define MLA_STOREV(b) do { LAS unsigned char* vd_ = vst + (b) * VB8; *(LAS u32x2*)(vd_) = (u32x2){sv0.x, sv0.y}; *(LAS u32x2*)(vd_ + 8) = (u32x2){sv0.z, sv0.w}; } while (0)
    float m = -1e30f, l = 0.f; f32x16 o[4];
#pragma unroll
    for (int d = 0; d < 4; ++d)
#pragma unroll
        for (int r = 0; r < 16; ++r) o[d][r] = 0.f;
    f32x16 pA0, pA1, pB0, pB1;
    MLA_LOADK(0); MLA_LOADV(0); MLA_STOREK(0); MLA_STOREV(0);
    MLA_LOADK(1);
    __syncthreads();
    qk_tile8<12>(pA0, pA1, kl, q);
    if (63 > qw) mla_mask(pA0, pA1, tq - 4 * hi);
    MLA_STOREK(1);
    if (2 < NT) MLA_LOADK(2);
    MLA_LOADV(1);
    __syncthreads();
#define MLA_SGB1() do { __builtin_amdgcn_sched_group_barrier(0x100, 2, 0); __builtin_amdgcn_sched_group_barrier(0x008, 1, 0); __builtin_amdgcn_sched_group_barrier(0x002, 6, 0); \
        __builtin_amdgcn_sched_group_barrier(0x008, 1, 0); __builtin_amdgcn_sched_group_barrier(0x002, 6, 0); } while (0)
#define MLA_SGB() do { MLA_SGB1(); MLA_SGB1(); MLA_SGB1(); MLA_SGB1(); MLA_SGB1(); MLA_SGB1(); MLA_SGB1(); MLA_SGB1(); MLA_SGB1(); MLA_SGB1(); MLA_SGB1(); MLA_SGB1(); } while (0)
#define MLA_STEP(PX0, PX1, PY0, PY1, j) do { \
        const int kb1_ = 64 * ((j) + 1); \
        const bool a1_ = ((j) + 1 < NT) && (kb1_ <= qw + 31), a0_ = (64 * (j) <= qw + 31); \
        float alpha_ = 1.f; i64 pb_[4]; \
        if (a1_) { \
            __builtin_amdgcn_sched_barrier(0); \
            qk_tile8_free<12>(PY0, PY1, kl + (((j) + 1) & 1) * MLA_KB8, q); \
            alpha_ = sm_core_scaled(PX0, PX1, m, l, QS_MLA); \
            pb_[0] = packp8<0>(PX0); pb_[1] = packp8<1>(PX0); pb_[2] = packp8<0>(PX1); pb_[3] = packp8<1>(PX1); \
            MLA_SGB(); \
            __builtin_amdgcn_sched_barrier(0); \
            if (kb1_ + 63 > qw) mla_mask(PY0, PY1, tq - kb1_ - 4 * hi); \
        } else if (a0_) { \
            alpha_ = sm_core_scaled(PX0, PX1, m, l, QS_MLA); \
            pb_[0] = packp8<0>(PX0); pb_[1] = packp8<1>(PX0); pb_[2] = packp8<0>(PX1); pb_[3] = packp8<1>(PX1); \
        } \
        if (a0_) { \
            if (!__all(alpha_ == 1.f)) { _Pragma("unroll") for (int d_ = 0; d_ < 4; ++d_) _Pragma("unroll") for (int r_ = 0; r_ < 16; ++r_) o[d_][r_] *= alpha_; } \
            pv_tile8(o, pb_, vl + ((j) & 1) * VB8); \
        } \
        if ((j) + 2 < NT) MLA_STOREK((j) & 1); \
        if ((j) + 1 < NT) MLA_STOREV(((j) + 1) & 1); \
        if ((j) + 3 < NT) MLA_LOADK((j) + 3); \
        if ((j) + 2 < NT) MLA_LOADV((j) + 2); \
        __syncthreads(); } while (0)
    for (int j = 0; j < NT; j += 2) {
        MLA_STEP(pA0, pA1, pB0, pB1, j);
        MLA_STEP(pB0, pB1, pA0, pA1, j + 1);
    }
#undef MLA_STEP
#undef MLA_SGB
#undef MLA_SGB1
#undef MLA_LOADK
#undef MLA_LOADV
#undef MLA_STOREK
#undef MLA_STOREV
    const float inv = (1.f / 256.f) / l;
    const bf16* zp = P.Z + (size_t)tq * 2048 + head * 128 + 4 * hi;
    bf16* op = P.O + (size_t)tq * 4096 + head * 128 + 4 * hi;
#pragma unroll
    for (int d0 = 0; d0 < 4; ++d0)
#pragma unroll
        for (int rg = 0; rg < 4; ++rg) { const int dim = 32 * d0 + 8 * rg;
            const u32x2 z = *(const GAS u32x2*)(zp + dim);
            u32x2 w; w.x = pk2(o[d0][4 * rg + 0] * inv * bflo(z.x), o[d0][4 * rg + 1] * inv * bfhi(z.x)); w.y = pk2(o[d0][4 * rg + 2] * inv * bflo(z.y), o[d0][4 * rg + 3] * inv * bfhi(z.y));
            *(GAS u32x2*)(op + dim) = w; }
}
#elif defined(MLA_PIPE)
struct MlaPtrs { const bf16* Q; const bf16* K; const bf16* V; const bf16* Z; bf16* O; };
__device__ __forceinline__ void mla_mask(f32x16& p0, f32x16& p1, int dq) {
#pragma unroll
    for (int r = 0; r < 16; ++r) { const int c = (r & 3) + 8 * (r >> 2);
        if (c > dq) p0[r] = -__builtin_inff();
        if (c + 32 > dq) p1[r] = -__builtin_inff(); }
}
__device__ __forceinline__ void mla_unit(LAS unsigned char* lds, const MlaPtrs& P, int head, int qb, int tid_in, int wave, int lane_in) {
    int tid = tid_in; asm volatile("" : "+v"(tid)); const int lane = tid & 63; (void)lane_in;
    const int r32 = lane & 31, hi = lane >> 5;
    const int q0 = qb * 256, qw = q0 + wave * 32, tq = qw + r32;
    bf16x8 q[8];
    LAS unsigned char* ql = lds + MLA_QL + wave * 4096 + lane * 16;
    { const bf16* qp = P.Q + (size_t)tq * 3072 + head * 192 + hi * 8;
#pragma unroll
      for (int d0 = 0; d0 < 8; ++d0) q[d0] = *(const GAS bf16x8*)(qp + d0 * 16);
#pragma unroll
      for (int d0 = 8; d0 < 12; ++d0) *(LAS bf16x8*)(ql + (d0 - 8) * 1024) = *(const GAS bf16x8*)(qp + d0 * 16); }
    const int NT = 4 * (qb + 1);
    const int srow = tid >> 3, sc8 = tid & 7;
    const unsigned char* kg = (const unsigned char*)P.K + (size_t)head * 384 + (size_t)srow * 6144 + sc8 * 16;
    const unsigned char* vg = (const unsigned char*)P.V + (size_t)head * 256 + (size_t)srow * 4096 + sc8 * 16;
    LAS unsigned char* kst = lds + srow * KS_M + sc8 * 16;
    LAS unsigned char* vst = lds + 2 * MLA_KB + srow * VS + sc8 * 16;
    const LAS unsigned char* kl = lds + r32 * KS_M + hi * 16;
    const LAS unsigned char* vl = lds + 2 * MLA_KB + (4 * hi + ((lane & 15) >> 2)) * VS + (16 * ((lane >> 4) & 1) + 4 * (lane & 3)) * 2;
    u32x4 sk0, sk1, sk2, sv0, sv1;
#define MLA_LOADK(j) do { const unsigned char* kp_ = kg + (size_t)(j) * (64 * 6144); sk0 = *(const GAS u32x4*)(kp_); sk1 = *(const GAS u32x4*)(kp_ + 128); sk2 = *(const GAS u32x4*)(kp_ + 256); } while (0)
#define MLA_LOADV(j) do { const unsigned char* vp_ = vg + (size_t)(j) * (64 * 4096); sv0 = *(const GAS u32x4*)(vp_); sv1 = *(const GAS u32x4*)(vp_ + 128); } while (0)
#define MLA_STOREK(b) do { LAS unsigned char* kd_ = kst + (b) * MLA_KB; *(LAS u32x4*)(kd_) = sk0; *(LAS u32x4*)(kd_ + 128) = sk1; *(LAS u32x4*)(kd_ + 256) = sk2; } while (0)
#define MLA_STOREV(b) do { LAS unsigned char* vd_ = vst + (b) * VB; *(LAS u32x4*)(vd_) = sv0; *(LAS u32x4*)(vd_ + 128) = sv1; } while (0)
    float m = -1e30f, l = 0.f; f32x16 o[4];
#pragma unroll
    for (int d = 0; d < 4; ++d)
#pragma unroll
        for (int r = 0; r < 16; ++r) o[d][r] = 0.f;
    f32x16 pA0, pA1, pB0, pB1;
    MLA_LOADK(0); MLA_LOADV(0); MLA_STOREK(0); MLA_STOREV(0);
    MLA_LOADK(1);
    __syncthreads();
    qk_tile_free<12, 8, KS_M>(pA0, pA1, kl, q, ql);
    if (63 > qw) mla_mask(pA0, pA1, tq - 4 * hi);
    MLA_STOREK(1);
    if (2 < NT) MLA_LOADK(2);
    MLA_LOADV(1);
    __syncthreads();
#define MLA_SGB1(NR) do { __builtin_amdgcn_sched_group_barrier(0x100, NR, 0); __builtin_amdgcn_sched_group_barrier(0x008, 1, 0); __builtin_amdgcn_sched_group_barrier(0x002, 6, 0); \
        __builtin_amdgcn_sched_group_barrier(0x008, 1, 0); __builtin_amdgcn_sched_group_barrier(0x002, 6, 0); } while (0)
#define MLA_SGB() do { MLA_SGB1(2); MLA_SGB1(2); MLA_SGB1(2); MLA_SGB1(2); MLA_SGB1(2); MLA_SGB1(2); MLA_SGB1(2); MLA_SGB1(2); MLA_SGB1(3); MLA_SGB1(3); MLA_SGB1(3); MLA_SGB1(3); } while (0)
#define MLA_STEP(PX0, PX1, PY0, PY1, j) do { \
        const int kb1_ = 64 * ((j) + 1); \
        const bool a1_ = ((j) + 1 < NT) && (kb1_ <= qw + 31), a0_ = (64 * (j) <= qw + 31); \
        float alpha_ = 1.f; bf16x8 pb_[4]; \
        if (a1_) { \
            __builtin_amdgcn_sched_barrier(0); \
            qk_tile_free<12, 8, KS_M>(PY0, PY1, kl + (((j) + 1) & 1) * MLA_KB, q, ql); \
            alpha_ = sm_core(PX0, PX1, m, l); \
            pb_[0] = packp<0>(PX0); pb_[1] = packp<1>(PX0); pb_[2] = packp<0>(PX1); pb_[3] = packp<1>(PX1); \
            MLA_SGB(); \
            __builtin_amdgcn_sched_barrier(0); \
            if (kb1_ + 63 > qw) mla_mask(PY0, PY1, tq - kb1_ - 4 * hi); \
        } else if (a0_) { \
            alpha_ = sm_core(PX0, PX1, m, l); \
            pb_[0] = packp<0>(PX0); pb_[1] = packp<1>(PX0); pb_[2] = packp<0>(PX1); pb_[3] = packp<1>(PX1); \
        } \
        if (a0_) { \
            if (!__all(alpha_ == 1.f)) { _Pragma("unroll") for (int d_ = 0; d_ < 4; ++d_) _Pragma("unroll") for (int r_ = 0; r_ < 16; ++r_) o[d_][r_] *= alpha_; } \
            pv_tile(o, pb_, vl + ((j) & 1) * VB); \
        } \
        if ((j) + 2 < NT) MLA_STOREK((j) & 1); \
        if ((j) + 1 < NT) MLA_STOREV(((j) + 1) & 1); \
        if ((j) + 3 < NT) MLA_LOADK((j) + 3); \
        if ((j) + 2 < NT) MLA_LOADV((j) + 2); \
        __syncthreads(); } while (0)
    for (int j = 0; j < NT; j += 2) {
        MLA_STEP(pA0, pA1, pB0, pB1, j);
        MLA_STEP(pB0, pB1, pA0, pA1, j + 1);
    }
#undef MLA_STEP
#undef MLA_SGB
#undef MLA_SGB1
#undef MLA_LOADK
#undef MLA_LOADV
#undef MLA_STOREK
#undef MLA_STOREV
    const float inv = 1.f / l;
    const bf16* zp = P.Z + (size_t)tq * 2048 + head * 128 + 4 * hi;
    bf16* op = P.O + (size_t)tq * 4096 + head * 128 + 4 * hi;
#pragma unroll
    for (int d0 = 0; d0 < 4; ++d0)
#pragma unroll
        for (int rg = 0; rg < 4; ++rg) { const int dim = 32 * d0 + 8 * rg;
            const u32x2 z = *(const GAS u32x2*)(zp + dim);
            u32x2 w; w.x = pk2(o[d0][4 * rg + 0] * inv * bflo(z.x), o[d0][4 * rg + 1] * inv * bfhi(z.x)); w.y = pk2(o[d0][4 * rg + 2] * inv * bflo(z.y), o[d0][4 * rg + 3] * inv * bfhi(z.y));
            *(GAS u32x2*)(op + dim) = w; }
}

#else
#if defined(MLA_MXQ)
struct MlaPtrs { const bf16* Q; const bf16* K; const bf16* V; const bf16* Z; bf16* O; };
constexpr int VBQ = 160 * VSX;
static_assert(2 * MLA_KBX + 2 * VBQ <= 131072, "MLA mxq LDS map");
__device__ __forceinline__ void mla_maskq(f32x16& p0, f32x16& p1, int dq) {
#pragma unroll
    for (int r = 0; r < 16; ++r) { const int c = (r & 3) + 8 * (r >> 2);
        if (c > dq) p0[r] = -__builtin_inff();
        if (c + 32 > dq) p1[r] = -__builtin_inff(); }
}
__device__ __forceinline__ float mla_rowmaxq(const f32x16& p0, const f32x16& p1) {
    float tm = p0[0];
#pragma unroll
    for (int r = 1; r < 16; ++r) tm = fmaxf(tm, p0[r]);
#pragma unroll
    for (int r = 0; r < 16; ++r) tm = fmaxf(tm, p1[r]);
    return swapmax(tm);
}
__device__ __forceinline__ void mla_unit(LAS unsigned char* lds, const MlaPtrs& P, int head, int qb, int tid_in, int wave, int lane_in) {
    int tid = tid_in; asm volatile("" : "+v"(tid)); const int lane = tid & 63; (void)lane_in;
    const int r32 = lane & 31, hi = lane >> 5;
    const int q0 = qb * 256, qw = q0 + wave * 32, tq = qw + r32;
    i32x8 q[3];
    { const unsigned char* qp = (const unsigned char*)P.Q + (size_t)tq * 3072 + head * 192 + hi * 32;
#pragma unroll
      for (int s = 0; s < 3; ++s) { const u32x4 a = *(const GAS u32x4*)(qp + 64 * s), b = *(const GAS u32x4*)(qp + 64 * s + 16);
          q[s] = (i32x8){(int)a.x, (int)a.y, (int)a.z, (int)a.w, (int)b.x, (int)b.y, (int)b.z, (int)b.w}; } }
    const int NT = 4 * (qb + 1);
    const int srow = tid >> 3, sc8 = tid & 7;
    const unsigned char* kg = (const unsigned char*)P.K + (size_t)head * 192 + (size_t)srow * 3072 + sc8 * 8;
    const unsigned char* vg = (const unsigned char*)P.V + ((size_t)head * 128 + (tid >> 2)) * S + (tid & 3) * 16;
    LAS unsigned char* kst = lds + srow * KSX + sc8 * 8;
    LAS unsigned char* vst = lds + 2 * MLA_KBX + (tid >> 2) * VSX + (tid & 3) * 16;
    const LAS unsigned char* kl = lds + r32 * KSX + hi * 32;
    const LAS unsigned char* vl = lds + 2 * MLA_KBX + r32 * VSX + hi * 32;
    u32x2 sk0, sk1, sk2; u32x4 sv0;
#define MLA_LOADK(j) do { const unsigned char* kp_ = kg + (size_t)(j) * (64 * 3072); sk0 = *(const GAS u32x2*)(kp_); sk1 = *(const GAS u32x2*)(kp_ + 64); sk2 = *(const GAS u32x2*)(kp_ + 128); } while (0)
#define MLA_LOADV(j) do { sv0 = *(const GAS u32x4*)(vg + (size_t)(j) * 64); } while (0)
#define MLA_STOREK(b) do { LAS unsigned char* kd_ = kst + (b) * MLA_KBX; *(LAS u32x2*)(kd_) = sk0; *(LAS u32x2*)(kd_ + 64) = sk1; *(LAS u32x2*)(kd_ + 128) = sk2; } while (0)
#define MLA_STOREV(b) do { LAS unsigned char* vd_ = vst + (b) * VBQ; *(LAS u32x2*)(vd_) = (u32x2){sv0.x, sv0.y}; *(LAS u32x2*)(vd_ + 8) = (u32x2){sv0.z, sv0.w}; } while (0)
    f32x16 o[5], mref;
#pragma unroll
    for (int d = 0; d < 5; ++d)
#pragma unroll
        for (int r = 0; r < 16; ++r) o[d][r] = 0.f;
#pragma unroll
    for (int r = 0; r < 16; ++r) mref[r] = MXL_REF;
    f32x16 p0, p1;
    if (tid < 256) { const int slot = tid >> 7, row = (tid >> 2) & 31, ch = tid & 3; const unsigned v1 = (row == 0 || row == 4) ? 0x38383838u : 0u;
        *(LAS u32x4*)(lds + 2 * MLA_KBX + slot * VBQ + (128 + row) * VSX + ch * 16) = (u32x4){v1, v1, v1, v1}; }
    MLA_LOADK(0); MLA_LOADV(0); MLA_STOREK(0); MLA_STOREV(0);
    MLA_LOADK(1);
    __syncthreads();
    qk_tilexl(p0, p1, mref, kl, q);
    if (63 > qw) mla_maskq(p0, p1, tq - 4 * hi);
    { const float dlt = mla_rowmaxq(p0, p1) - MXL_REF;
#pragma unroll
      for (int r = 0; r < 16; ++r) { p0[r] -= dlt; p1[r] -= dlt; mref[r] -= dlt; } }
    i32x8 pbA = byte_packx(p0, p1), pbB = pbA;
    MLA_STOREK(1);
    if (2 < NT) MLA_LOADK(2);
    MLA_LOADV(1);
    __syncthreads();
    asm volatile("" : "+v"(q[0]), "+v"(q[1]), "+v"(q[2]));
    int sc1_ = 0x7f7f7f7f; asm volatile("" : "+v"(sc1_));
#define SB() __builtin_amdgcn_sched_barrier(0)
#define MFMA_T(acc, a, b) asm volatile("s_nop 1\n\tv_mfma_scale_f32_32x32x64_f8f6f4 %0, %1, %2, %0, %3, %3 op_sel_hi:[0,0,0]" : "+v"(acc) : "v"(a), "v"(b), "v"(sc1_))
#define MFMA_C(acc, a, b, c) asm volatile("s_nop 1\n\tv_mfma_scale_f32_32x32x64_f8f6f4 %0, %1, %2, %3, %4, %4 op_sel_hi:[0,0,0]" : "=&v"(acc) : "v"(a), "v"(b), "v"(c), "v"(sc1_))
#define CVT8(P, R0, PB, W0) do { unsigned w_ = __builtin_amdgcn_cvt_pk_u8_f32(P[(R0) + 0], 0, 0u); w_ = __builtin_amdgcn_cvt_pk_u8_f32(P[(R0) + 1], 1, w_); w_ = __builtin_amdgcn_cvt_pk_u8_f32(P[(R0) + 2], 2, w_); \
        w_ = __builtin_amdgcn_cvt_pk_u8_f32(P[(R0) + 3], 3, w_); PB[(W0)] = (int)w_; \
        w_ = __builtin_amdgcn_cvt_pk_u8_f32(P[(R0) + 4], 0, 0u); w_ = __builtin_amdgcn_cvt_pk_u8_f32(P[(R0) + 5], 1, w_); w_ = __builtin_amdgcn_cvt_pk_u8_f32(P[(R0) + 6], 2, w_); \
        w_ = __builtin_amdgcn_cvt_pk_u8_f32(P[(R0) + 7], 3, w_); PB[(W0) + 1] = (int)w_; } while (0)
#define MLA_STEP(PBX, PBY, j) do { \
        const int kb1_ = 64 * ((j) + 1); \
        if (64 * (j) <= qw + 31) { \
            const LAS unsigned char* kn_ = kl + (((j) + 1) & 1) * MLA_KBX; const LAS unsigned char* vj_ = vl + ((j) & 1) * VBQ; \
            SB(); \
            i32x8 a0_f = ldsx(kn_), a1_f = ldsx(kn_ + 32 * KSX); \
            SB(); MFMA_C(p0, a0_f, q[0], mref); SB(); \
            a0_f = ldsx(kn_ + 64); \
            SB(); MFMA_C(p1, a1_f, q[0], mref); SB(); \
            a1_f = ldsx(kn_ + 32 * KSX + 64); \
            SB(); MFMA_T(p0, a0_f, q[1]); SB(); \
            a0_f = ldsx(kn_ + 128); \
            SB(); MFMA_T(p1, a1_f, q[1]); SB(); \
            a1_f = ldsx(kn_ + 32 * KSX + 128); \
            SB(); MFMA_T(p0, a0_f, q[2]); SB(); \
            a0_f = ldsx(vj_ + 128 * VSX); \
            SB(); MFMA_T(p1, a1_f, q[2]); SB(); \
            a1_f = ldsx(vj_); \
            SB(); MFMA_T(o[4], a0_f, PBX); SB(); \
            a0_f = ldsx(vj_ + 32 * VSX); \
            SB(); MFMA_T(o[0], a1_f, PBX); SB(); \
            a1_f = ldsx(vj_ + 64 * VSX); \
            float tmx_ = p0[0]; _Pragma("unroll") for (int r_ = 1; r_ < 16; ++r_) tmx_ = fmaxf(tmx_, p0[r_]); \
            CVT8(p0, 0, PBY, 0); CVT8(p0, 8, PBY, 2); \
            SB(); MFMA_T(o[1], a0_f, PBX); SB(); \
            a0_f = ldsx(vj_ + 96 * VSX); \
            _Pragma("unroll") for (int r_ = 0; r_ < 16; ++r_) tmx_ = fmaxf(tmx_, p1[r_]); \
            CVT8(p1, 0, PBY, 4); \
            SB(); MFMA_T(o[2], a1_f, PBX); SB(); \
            CVT8(p1, 8, PBY, 6); tmx_ = swapmax(tmx_); \
            SB(); MFMA_T(o[3], a0_f, PBX); SB(); \
            const bool diag_ = kb1_ + 63 > qw; \
            if (diag_ || !__all(tmx_ <= MXL_T)) {               \
                asm volatile("s_nop 15\n\ts_nop 15\n\ts_nop 15" ::: "memory");     \
                if (diag_) mla_maskq(p0, p1, tq - kb1_ - 4 * hi); \
                const float dlt_ = fmaxf(mla_rowmaxq(p0, p1) - MXL_REF, 0.f); const float alpha_ = __builtin_amdgcn_exp2f(-0.125f * dlt_); \
                _Pragma("unroll") for (int r_ = 0; r_ < 16; ++r_) { p0[r_] -= dlt_; p1[r_] -= dlt_; mref[r_] -= dlt_; } \
                _Pragma("unroll") for (int d_ = 0; d_ < 5; ++d_) _Pragma("unroll") for (int r_ = 0; r_ < 16; ++r_) o[d_][r_] *= alpha_; \
                PBY = byte_packx(p0, p1); } \
        } \
        if ((j) + 2 < NT) MLA_STOREK((j) & 1); \
        if ((j) + 1 < NT) MLA_STOREV(((j) + 1) & 1); \
        if ((j) + 3 < NT) MLA_LOADK((j) + 3); \
        if ((j) + 2 < NT) MLA_LOADV((j) + 2); \
        __syncthreads(); } while (0)
    for (int j = 0; j < NT; j += 2) {
        MLA_STEP(pbA, pbB, j);
        MLA_STEP(pbB, pbA, j + 1);
    }
    asm volatile("s_nop 15\n\ts_nop 15" ::: "memory");
#undef MLA_STEP
#undef CVT8
#undef MFMA_T
#undef MFMA_C
#undef SB
#undef MLA_LOADK
#undef MLA_LOADV
#undef MLA_STOREK
#undef MLA_STOREV
    const float inv = 1.f / o[4][0];
    const bf16* zp = P.Z + (size_t)tq * 2048 + head * 128 + 4 * hi;
    bf16* op = P.O + (size_t)tq * 4096 + head * 128 + 4 * hi;
#pragma unroll
    for (int d0 = 0; d0 < 4; ++d0)
#pragma unroll
        for (int rg = 0; rg < 4; ++rg) { const int dim = 32 * d0 + 8 * rg;
            const u32x2 z = *(const GAS u32x2*)(zp + dim);
            u32x2 w; w.x = pk2(o[d0][4 * rg + 0] * inv * bflo(z.x), o[d0][4 * rg + 1] * inv * bfhi(z.x)); w.y = pk2(o[d0][4 * rg + 2] * inv * bflo(z.y), o[d0][4 * rg + 3] * inv * bfhi(z.y));
            *(GAS u32x2*)(op + dim) = w; }
}

#elif defined(MLA_BIGX)
struct MlaPtrs { const bf16* Q; const bf16* K; const bf16* V; const bf16* Z; bf16* O; };
__device__ __forceinline__ void mla_unit(LAS unsigned char* lds, const MlaPtrs& P, int head, int qb, int tid_in, int wave, int lane_in) {
    int tid = tid_in; asm volatile("" : "+v"(tid)); const int lane = tid & 63; (void)lane_in;
    const int r32 = lane & 31, hi = lane >> 5;
    const int q0 = qb * 256, qw = q0 + wave * 32, tq = qw + r32;
    i32x8 q[3];
    { const unsigned char* qp = (const unsigned char*)P.Q + (size_t)tq * 3072 + head * 192 + hi * 32;
#pragma unroll
      for (int s = 0; s < 3; ++s) { const u32x4 a = *(const GAS u32x4*)(qp + 64 * s), b = *(const GAS u32x4*)(qp + 64 * s + 16);
          q[s] = (i32x8){(int)a.x, (int)a.y, (int)a.z, (int)a.w, (int)b.x, (int)b.y, (int)b.z, (int)b.w}; } }
    const int NT = 4 * (qb + 1), NTB = NT / 2;
    constexpr int VSB = 144, VBB = 128 * VSB, KBB = 128 * KSX;
    static_assert(2 * KBB + 3 * VBB <= 131072, "MLA big-tile LDS map");
    const int srow = tid >> 3, sc8 = tid & 7;
    const unsigned char* kg = (const unsigned char*)P.K + (size_t)head * 192 + (size_t)srow * 3072 + sc8 * 8;
    const unsigned char* vg = (const unsigned char*)P.V + ((size_t)head * 128 + (tid >> 2)) * S + (tid & 3) * 32;
    LAS unsigned char* kst = lds + srow * KSX + sc8 * 8;
    LAS unsigned char* vst = lds + 2 * KBB + (tid >> 2) * VSB + (tid & 3) * 32;
    const LAS unsigned char* kl = lds + r32 * KSX + hi * 32;
    const LAS unsigned char* vl = lds + 2 * KBB + r32 * VSB + hi * 32;
    u32x2 sk0, sk1, sk2, sk3, sk4, sk5; u32x4 sv0, sv1;
#define MLA_LOAD(J) do { const unsigned char* kp_ = kg + (size_t)(J) * (128 * 3072); const unsigned char* vp_ = vg + (size_t)(J) * 128; \
        sk0 = *(const GAS u32x2*)(kp_); sk1 = *(const GAS u32x2*)(kp_ + 64); sk2 = *(const GAS u32x2*)(kp_ + 128); \
        sk3 = *(const GAS u32x2*)(kp_ + 64 * 3072); sk4 = *(const GAS u32x2*)(kp_ + 64 * 3072 + 64); sk5 = *(const GAS u32x2*)(kp_ + 64 * 3072 + 128); \
        sv0 = *(const GAS u32x4*)(vp_); sv1 = *(const GAS u32x4*)(vp_ + 16); } while (0)
#define MLA_STORE(b, vb) do { LAS unsigned char* kd_ = kst + (b) * KBB; LAS unsigned char* vd_ = vst + (vb) * VBB; \
        *(LAS u32x2*)(kd_) = sk0; *(LAS u32x2*)(kd_ + 64) = sk1; *(LAS u32x2*)(kd_ + 128) = sk2; \
        *(LAS u32x2*)(kd_ + 64 * KSX) = sk3; *(LAS u32x2*)(kd_ + 64 * KSX + 64) = sk4; *(LAS u32x2*)(kd_ + 64 * KSX + 128) = sk5; \
        *(LAS u32x2*)(vd_) = (u32x2){sv0.x, sv0.y}; *(LAS u32x2*)(vd_ + 8) = (u32x2){sv0.z, sv0.w}; *(LAS u32x2*)(vd_ + 16) = (u32x2){sv1.x, sv1.y}; *(LAS u32x2*)(vd_ + 24) = (u32x2){sv1.z, sv1.w}; } while (0)
    MLA_LOAD(0); MLA_STORE(0, 0);
    __syncthreads();
    asm volatile("" : "+v"(q[0]), "+v"(q[1]), "+v"(q[2]));
    f32x16 o[5], mref;
#pragma unroll
    for (int d = 0; d < 5; ++d)
#pragma unroll
        for (int r = 0; r < 16; ++r) o[d][r] = 0.f;
#pragma unroll
    for (int r = 0; r < 16; ++r) mref[r] = MXL_REF;
    const int one8 = (r32 == 0 || r32 == 4) ? 0x38383838 : 0;
    const i32x8 ones = {one8, one8, one8, one8, one8, one8, one8, one8};
    const bool trail = wave >= 4;
    i32x8 pb = {};
    int vb_cur = 0, vb_prev = 2;
    for (int J = 0; J < NTB; ++J) {
        int vb_next = vb_cur + 1; if (vb_next == 3) vb_next = 0;
        if (J + 1 < NTB) MLA_LOAD(J + 1);
#pragma unroll
        for (int sub = 0; sub < 2; ++sub) {
        const int j = 2 * J + sub, kb = 64 * j;
        if (trail && j > 0 && kb - 64 <= qw + 31) pv_tilexl<VSB>(o, pb, ones, vl + (sub == 0 ? vb_prev * VBB + 64 : vb_cur * VBB));
        if (kb <= qw + 31) {
            f32x16 p0, p1;
            qk_tilexl(p0, p1, mref, kl + (J & 1) * KBB + sub * 64 * KSX, q);
            if (kb + 63 > qw) {
                const int dq = tq - kb - 4 * hi;
#pragma unroll
                for (int r = 0; r < 16; ++r) { const int c = (r & 3) + 8 * (r >> 2);
                    if (c > dq) p0[r] = -__builtin_inff();
                    if (c + 32 > dq) p1[r] = -__builtin_inff(); }
            }
            float tm = p0[0];
#pragma unroll
            for (int r = 1; r < 16; ++r) tm = fmaxf(tm, p0[r]);
#pragma unroll
            for (int r = 0; r < 16; ++r) tm = fmaxf(tm, p1[r]);
            tm = swapmax(tm);
            if (j == 0 || !__all(tm <= MXL_T)) {
                const float dlt = (j == 0) ? tm - MXL_REF : fmaxf(tm - MXL_REF, 0.f);
                const float alpha = __builtin_amdgcn_exp2f(-0.125f * dlt);
#pragma unroll
                for (int r = 0; r < 16; ++r) { p0[r] -= dlt; p1[r] -= dlt; mref[r] -= dlt; }
                if (j > 0) {
#pragma unroll
                    for (int d = 0; d < 5; ++d)
#pragma unroll
                        for (int r = 0; r < 16; ++r) o[d][r] *= alpha;
                }
            }
            pb = byte_packx(p0, p1);
            if (!trail) pv_tilexl<VSB>(o, pb, ones, vl + vb_cur * VBB + sub * 64);
        }
        }
        if (J + 1 < NTB) MLA_STORE((J + 1) & 1, vb_next);
        __syncthreads();
        vb_prev = vb_cur; vb_cur = vb_next;
    }
    if (trail && 64 * (NT - 1) <= qw + 31) pv_tilexl<VSB>(o, pb, ones, vl + vb_prev * VBB + 64);
    __syncthreads();
#undef MLA_LOAD
#undef MLA_STORE
    const float inv = 1.f / o[4][0];
    const bf16* zp = P.Z + (size_t)tq * 2048 + head * 128 + 4 * hi;
    bf16* op = P.O + (size_t)tq * 4096 + head * 128 + 4 * hi;
#pragma unroll
    for (int d0 = 0; d0 < 4; ++d0)
#pragma unroll
        for (int rg = 0; rg < 4; ++rg) { const int dim = 32 * d0 + 8 * rg;
            const u32x2 z = *(const GAS u32x2*)(zp + dim);
            u32x2 w; w.x = pk2(o[d0][4 * rg + 0] * inv * bflo(z.x), o[d0][4 * rg + 1] * inv * bfhi(z.x)); w.y = pk2(o[d0][4 * rg + 2] * inv * bflo(z.y), o[d0][4 * rg + 3] * inv * bfhi(z.y));
            *(GAS u32x2*)(op + dim) = w; }
}

#elif defined(MLA_MXL)
struct MlaPtrs { const bf16* Q; const bf16* K; const bf16* V; const bf16* Z; bf16* O; };
__device__ __forceinline__ void mla_unit(LAS unsigned char* lds, const MlaPtrs& P, int head, int qb, int tid_in, int wave, int lane_in) {
    int tid = tid_in; asm volatile("" : "+v"(tid)); const int lane = tid & 63; (void)lane_in;
    const int r32 = lane & 31, hi = lane >> 5;
    const int q0 = qb * 256, qw = q0 + wave * 32, tq = qw + r32;
    i32x8 q[3];
    { const unsigned char* qp = (const unsigned char*)P.Q + (size_t)tq * 3072 + head * 192 + hi * 32;
#pragma unroll
      for (int s = 0; s < 3; ++s) { const u32x4 a = *(const GAS u32x4*)(qp + 64 * s), b = *(const GAS u32x4*)(qp + 64 * s + 16);
          q[s] = (i32x8){(int)a.x, (int)a.y, (int)a.z, (int)a.w, (int)b.x, (int)b.y, (int)b.z, (int)b.w}; } }
    const int NT = 4 * (qb + 1);
    const int srow = tid >> 3, sc8 = tid & 7;
    const unsigned char* kg = (const unsigned char*)P.K + (size_t)head * 192 + (size_t)srow * 3072 + sc8 * 8;
    const unsigned char* vg = (const unsigned char*)P.V + ((size_t)head * 128 + (tid >> 2)) * S + (tid & 3) * 16;
    LAS unsigned char* kst = lds + srow * KSX + sc8 * 8;
    LAS unsigned char* vst = lds + 2 * MLA_KBX + (tid >> 2) * VSX + (tid & 3) * 16;
    const LAS unsigned char* kl = lds + r32 * KSX + hi * 32;
    const LAS unsigned char* vl = lds + 2 * MLA_KBX + r32 * VSX + hi * 32;
    u32x2 sk0, sk1, sk2; u32x4 sv0;
#define MLA_LOAD(j) do { const unsigned char* kp_ = kg + (size_t)(j) * (64 * 3072); const unsigned char* vp_ = vg + (size_t)(j) * 64; \
        sk0 = *(const GAS u32x2*)(kp_); sk1 = *(const GAS u32x2*)(kp_ + 64); sk2 = *(const GAS u32x2*)(kp_ + 128); sv0 = *(const GAS u32x4*)(vp_); } while (0)
#define MLA_STORE(b, vb) do { LAS unsigned char* kd_ = kst + (b) * MLA_KBX; LAS unsigned char* vd_ = vst + (vb) * VBX; \
        *(LAS u32x2*)(kd_) = sk0; *(LAS u32x2*)(kd_ + 64) = sk1; *(LAS u32x2*)(kd_ + 128) = sk2; *(LAS u32x2*)(vd_) = (u32x2){sv0.x, sv0.y}; *(LAS u32x2*)(vd_ + 8) = (u32x2){sv0.z, sv0.w}; } while (0)
    MLA_LOAD(0); MLA_STORE(0, 0);
    __syncthreads();
    asm volatile("" : "+v"(q[0]), "+v"(q[1]), "+v"(q[2]));
    f32x16 o[5], mref;
#pragma unroll
    for (int d = 0; d < 5; ++d)
#pragma unroll
        for (int r = 0; r < 16; ++r) o[d][r] = 0.f;
#pragma unroll
    for (int r = 0; r < 16; ++r) mref[r] = MXL_REF;
    const int one8 = (r32 == 0 || r32 == 4) ? 0x38383838 : 0;
    const i32x8 ones = {one8, one8, one8, one8, one8, one8, one8, one8};
    const bool trail = wave >= 4;
    i32x8 pb = {};
    int vb_cur = 0, vb_prev = 2;
    for (int j = 0; j < NT; ++j) {
        const int kb = 64 * j;
        int vb_next = vb_cur + 1; if (vb_next == 3) vb_next = 0;
        if (j + 1 < NT) MLA_LOAD(j + 1);
        if (trail && j > 0 && kb - 64 <= qw + 31) pv_tilexl(o, pb, ones, vl + vb_prev * VBX);
        if (kb <= qw + 31) {
            f32x16 p0, p1;
            qk_tilexl(p0, p1, mref, kl + (j & 1) * MLA_KBX, q);
            if (kb + 63 > qw) {
                const int dq = tq - kb - 4 * hi;
#pragma unroll
                for (int r = 0; r < 16; ++r) { const int c = (r & 3) + 8 * (r >> 2);
                    if (c > dq) p0[r] = -__builtin_inff();
                    if (c + 32 > dq) p1[r] = -__builtin_inff(); }
            }
            float tm = p0[0];
#pragma unroll
            for (int r = 1; r < 16; ++r) tm = fmaxf(tm, p0[r]);
#pragma unroll
            for (int r = 0; r < 16; ++r) tm = fmaxf(tm, p1[r]);
            tm = swapmax(tm);
            if (j == 0 || !__all(tm <= MXL_T)) {
#ifdef MLA_MXU
                const float dlt = (j == 0) ? tm - MXL_REF : fmaxf(tm - MXL_REF, 0.f);
                const float alpha = __builtin_amdgcn_exp2f(-0.125f * dlt);
#else
                const float dlt = (j == 0) ? tm : fmaxf(tm, 0.f);
                const float alpha = __builtin_amdgcn_exp2f(-dlt);
#endif
#pragma unroll
                for (int r = 0; r < 16; ++r) { p0[r] -= dlt; p1[r] -= dlt; mref[r] -= dlt; }
                if (j > 0) {
#pragma unroll
                    for (int d = 0; d < 5; ++d)
#pragma unroll
                        for (int r = 0; r < 16; ++r) o[d][r] *= alpha;
                }
            }
#ifdef MLA_MXU
            pb = byte_packx(p0, p1);
#else
            pb = exp_packx(p0, p1, one8);
#endif
            if (!trail) pv_tilexl(o, pb, ones, vl + vb_cur * VBX);
        }
        if (j + 1 < NT) MLA_STORE((j + 1) & 1, vb_next);
        __syncthreads();
        vb_prev = vb_cur; vb_cur = vb_next;
    }
    if (trail && 64 * (NT - 1) <= qw + 31) pv_tilexl(o, pb, ones, vl + vb_prev * VBX);
    __syncthreads();
#undef MLA_LOAD
#undef MLA_STORE
    const float inv = 1.f / o[4][0];
    const bf16* zp = P.Z + (size_t)tq * 2048 + head * 128 + 4 * hi;
    bf16* op = P.O + (size_t)tq * 4096 + head * 128 + 4 * hi;
#pragma unroll
    for (int d0 = 0; d0 < 4; ++d0)
#pragma unroll
        for (int rg = 0; rg < 4; ++rg) { const int dim = 32 * d0 + 8 * rg;
            const u32x2 z = *(const GAS u32x2*)(zp + dim);
            u32x2 w; w.x = pk2(o[d0][4 * rg + 0] * inv * bflo(z.x), o[d0][4 * rg + 1] * inv * bfhi(z.x)); w.y = pk2(o[d0][4 * rg + 2] * inv * bflo(z.y), o[d0][4 * rg + 3] * inv * bfhi(z.y));
            *(GAS u32x2*)(op + dim) = w; }
}

#elif defined(MLA_MXP)
struct MlaPtrs { const bf16* Q; const bf16* K; const bf16* V; const bf16* Z; bf16* O; };
__device__ __forceinline__ void mla_maskx(f32x16& p0, f32x16& p1, int dq) {
#pragma unroll
    for (int r = 0; r < 16; ++r) { const int c = (r & 3) + 8 * (r >> 2);
        if (c > dq) p0[r] = -__builtin_inff();
        if (c + 32 > dq) p1[r] = -__builtin_inff(); }
}
__device__ __forceinline__ float mla_rowmax(const f32x16& p0, const f32x16& p1) {
    float tm = p0[0];
#pragma unroll
    for (int r = 1; r < 16; ++r) tm = fmaxf(tm, p0[r]);
#pragma unroll
    for (int r = 0; r < 16; ++r) tm = fmaxf(tm, p1[r]);
    return swapmax(tm);
}
#define MXP_EXP8(P, R0) do { _Pragma("unroll") for (int r_ = (R0); r_ < (R0) + 8; ++r_) { P[r_] = __builtin_amdgcn_exp2f(__builtin_fmaf(P[r_], QS_MLA, mc_)); ps_ += P[r_]; } } while (0)
__device__ __forceinline__ void mla_unit(LAS unsigned char* lds, const MlaPtrs& P, int head, int qb, int tid_in, int wave, int lane_in) {
    int tid = tid_in; asm volatile("" : "+v"(tid)); const int lane = tid & 63; (void)lane_in;
    const int r32 = lane & 31, hi = lane >> 5;
    const int q0 = qb * 256, qw = q0 + wave * 32, tq = qw + r32;
    i32x8 q[3];
    { const unsigned char* qp = (const unsigned char*)P.Q + (size_t)tq * 3072 + head * 192 + hi * 32;
#pragma unroll
      for (int s = 0; s < 3; ++s) { const u32x4 a = *(const GAS u32x4*)(qp + 64 * s), b = *(const GAS u32x4*)(qp + 64 * s + 16);
          q[s] = (i32x8){(int)a.x, (int)a.y, (int)a.z, (int)a.w, (int)b.x, (int)b.y, (int)b.z, (int)b.w}; } }
    const int NT = 4 * (qb + 1);
    const int srow = tid >> 3, sc8 = tid & 7;
    const unsigned char* kg = (const unsigned char*)P.K + (size_t)head * 192 + (size_t)srow * 3072 + sc8 * 8;
    const unsigned char* vg = (const unsigned char*)P.V + ((size_t)head * 128 + (tid >> 2)) * S + (tid & 3) * 16;
    LAS unsigned char* kst = lds + srow * KSX + sc8 * 8;
    LAS unsigned char* vst = lds + 2 * MLA_KBX + (tid >> 2) * VSX + (tid & 3) * 16;
    const LAS unsigned char* kl = lds + r32 * KSX + hi * 32;
    const LAS unsigned char* vl = lds + 2 * MLA_KBX + r32 * VSX + hi * 32;
    u32x2 sk0, sk1, sk2; u32x4 sv0;
#define MLA_LOADK(j) do { const unsigned char* kp_ = kg + (size_t)(j) * (64 * 3072); sk0 = *(const GAS u32x2*)(kp_); sk1 = *(const GAS u32x2*)(kp_ + 64); sk2 = *(const GAS u32x2*)(kp_ + 128); } while (0)
#define MLA_LOADV(j) do { sv0 = *(const GAS u32x4*)(vg + (size_t)(j) * 64); } while (0)
#define MLA_STOREK(b) do { LAS unsigned char* kd_ = kst + (b) * MLA_KBX; *(LAS u32x2*)(kd_) = sk0; *(LAS u32x2*)(kd_ + 64) = sk1; *(LAS u32x2*)(kd_ + 128) = sk2; } while (0)
#define MLA_STOREV(b) do { LAS unsigned char* vd_ = vst + (b) * VBX; *(LAS u32x2*)(vd_) = (u32x2){sv0.x, sv0.y}; *(LAS u32x2*)(vd_ + 8) = (u32x2){sv0.z, sv0.w}; } while (0)
    float m = -1e30f, l = 0.f; f32x16 o[4];
#pragma unroll
    for (int d = 0; d < 4; ++d)
#pragma unroll
        for (int r = 0; r < 16; ++r) o[d][r] = 0.f;
    f32x16 pA0, pA1, pB0, pB1;
    MLA_LOADK(0); MLA_LOADV(0); MLA_STOREK(0); MLA_STOREV(0);
    MLA_LOADK(1);
    __syncthreads();
    qk_tilex(pA0, pA1, kl, q);
    if (63 > qw) mla_maskx(pA0, pA1, tq - 4 * hi);
    MLA_STOREK(1);
    if (2 < NT) MLA_LOADK(2);
    MLA_LOADV(1);
    __syncthreads();
    asm volatile("" : "+v"(q[0]), "+v"(q[1]), "+v"(q[2]));
    float tmx = mla_rowmax(pA0, pA1);
#define SB() __builtin_amdgcn_sched_barrier(0)
#define MLA_SMHEAD() const float mn_ = fmaxf(m, tmx); const float alpha_ = __builtin_amdgcn_exp2f((m - mn_) * QS_MLA); m = mn_; const float mc_ = 8.f - mn_ * QS_MLA; float ps_ = 0.f; i32x8 pb_; \
            if (!__all(alpha_ == 1.f)) { _Pragma("unroll") for (int d_ = 0; d_ < 4; ++d_) _Pragma("unroll") for (int r_ = 0; r_ < 16; ++r_) o[d_][r_] *= alpha_; }
#define MXP_EXPK(P, R0, W0) do { MXP_EXP8(P, R0); \
        int w_ = __builtin_amdgcn_cvt_pk_fp8_f32(P[(R0) + 0], P[(R0) + 1], 0, false); pb_[(W0)] = __builtin_amdgcn_cvt_pk_fp8_f32(P[(R0) + 2], P[(R0) + 3], w_, true); \
        w_ = __builtin_amdgcn_cvt_pk_fp8_f32(P[(R0) + 4], P[(R0) + 5], 0, false); pb_[(W0) + 1] = __builtin_amdgcn_cvt_pk_fp8_f32(P[(R0) + 6], P[(R0) + 7], w_, true); } while (0)
#define MLA_SMTAIL() ps_ = swapsum(ps_); l = l * alpha_ + ps_
#define MFMA_T(acc, a, b) asm volatile("s_nop 1\n\tv_mfma_scale_f32_32x32x64_f8f6f4 %0, %1, %2, %0, %3, %3 op_sel_hi:[0,0,0]" : "+v"(acc) : "v"(a), "v"(b), "v"(sc1_))
#define MFMA_Z(acc, a, b) asm volatile("s_nop 1\n\tv_mfma_scale_f32_32x32x64_f8f6f4 %0, %1, %2, 0, %3, %3 op_sel_hi:[0,0,0]" : "=&v"(acc) : "v"(a), "v"(b), "v"(sc1_))
#define MLA_STEP(PX0, PX1, PY0, PY1, j) do { \
        const int kb1_ = 64 * ((j) + 1); \
        const bool a0_ = (64 * (j) <= qw + 31); \
        const LAS unsigned char* vj_ = vl + ((j) & 1) * VBX; \
        if (a0_) {                  \
            const LAS unsigned char* kn_ = kl + (((j) + 1) & 1) * MLA_KBX; \
            MLA_SMHEAD() \
            SB(); \
            i32x8 a0_f = ldsx(kn_), a1_f = ldsx(kn_ + 64); \
            MXP_EXPK(PX0, 0, 0); MXP_EXPK(PX0, 8, 2); \
            SB(); MFMA_Z(PY0, a0_f, q[0]); SB(); \
            a0_f = ldsx(kn_ + 128); \
            MXP_EXPK(PX1, 0, 4); \
            SB(); MFMA_T(PY0, a1_f, q[1]); SB(); \
            a1_f = ldsx(kn_ + 32 * KSX); \
            MXP_EXPK(PX1, 8, 6); \
            SB(); MFMA_T(PY0, a0_f, q[2]); SB(); \
            a0_f = ldsx(kn_ + 32 * KSX + 64); \
            MLA_SMTAIL(); \
            SB(); MFMA_Z(PY1, a1_f, q[0]); SB(); \
            a1_f = ldsx(vj_); \
            SB(); MFMA_T(PY1, a0_f, q[1]); SB(); \
            a0_f = ldsx(kn_ + 32 * KSX + 128); \
            SB(); MFMA_T(o[0], a1_f, pb_); SB(); \
            a1_f = ldsx(vj_ + 32 * VSX); \
            SB(); MFMA_T(PY1, a0_f, q[2]); SB(); \
            a0_f = ldsx(vj_ + 64 * VSX); \
            SB(); MFMA_T(o[1], a1_f, pb_); SB(); \
            a1_f = ldsx(vj_ + 96 * VSX); \
            SB(); MFMA_T(o[2], a0_f, pb_); SB(); \
            SB(); MFMA_T(o[3], a1_f, pb_); SB(); \
            if (kb1_ + 63 > qw) mla_maskx(PY0, PY1, tq - kb1_ - 4 * hi); \
            tmx = mla_rowmax(PY0, PY1); \
        } \
        if ((j) + 2 < NT) MLA_STOREK((j) & 1); \
        if ((j) + 1 < NT) MLA_STOREV(((j) + 1) & 1); \
        if ((j) + 3 < NT) MLA_LOADK((j) + 3); \
        if ((j) + 2 < NT) MLA_LOADV((j) + 2); \
        __syncthreads(); } while (0)
    int sc1_ = 0x7f7f7f7f; asm volatile("" : "+v"(sc1_));
    for (int j = 0; j < NT; j += 2) {
        MLA_STEP(pA0, pA1, pB0, pB1, j);
        MLA_STEP(pB0, pB1, pA0, pA1, j + 1);
    }
    asm volatile("s_nop 15\n\ts_nop 15" ::: "memory");
#undef MLA_STEP
#undef MLA_SMHEAD
#undef MLA_SMTAIL
#undef MXP_EXPK
#undef MFMA_T
#undef MFMA_Z
#undef SB
#undef MLA_LOADK
#undef MLA_LOADV
#undef MLA_STOREK
#undef MLA_STOREV
    const float inv = 1.f / l;
    const bf16* zp = P.Z + (size_t)tq * 2048 + head * 128 + 4 * hi;
    bf16* op = P.O + (size_t)tq * 4096 + head * 128 + 4 * hi;
#pragma unroll
    for (int d0 = 0; d0 < 4; ++d0)
#pragma unroll
        for (int rg = 0; rg < 4; ++rg) { const int dim = 32 * d0 + 8 * rg;
            const u32x2 z = *(const GAS u32x2*)(zp + dim);
            u32x2 w; w.x = pk2(o[d0][4 * rg + 0] * inv * bflo(z.x), o[d0][4 * rg + 1] * inv * bfhi(z.x)); w.y = pk2(o[d0][4 * rg + 2] * inv * bflo(z.y), o[d0][4 * rg + 3] * inv * bfhi(z.y));
            *(GAS u32x2*)(op + dim) = w; }
}
#undef MXP_EXP8

#elif defined(MLA_MX)
struct MlaPtrs { const bf16* Q; const bf16* K; const bf16* V; const bf16* Z; bf16* O; };
__device__ __forceinline__ void mla_unit(LAS unsigned char* lds, const MlaPtrs& P, int head, int qb, int tid_in, int wave, int lane_in) {
    int tid = tid_in; asm volatile("" : "+v"(tid)); const int lane = tid & 63; (void)lane_in;
    const int r32 = lane & 31, hi = lane >> 5;
    const int q0 = qb * 256, qw = q0 + wave * 32, tq = qw + r32;
    i32x8 q[3];
    { const unsigned char* qp = (const unsigned char*)P.Q + (size_t)tq * 3072 + head * 192 + hi * 32;
#pragma unroll
      for (int s = 0; s < 3; ++s) { const u32x4 a = *(const GAS u32x4*)(qp + 64 * s), b = *(const GAS u32x4*)(qp + 64 * s + 16);
          q[s] = (i32x8){(int)a.x, (int)a.y, (int)a.z, (int)a.w, (int)b.x, (int)b.y, (int)b.z, (int)b.w}; } }
    const int NT = 4 * (qb + 1);
    const int srow = tid >> 3, sc8 = tid & 7;
    const unsigned char* kg = (const unsigned char*)P.K + (size_t)head * 192 + (size_t)srow * 3072 + sc8 * 8;
    const unsigned char* vg = (const unsigned char*)P.V + ((size_t)head * 128 + (tid >> 2)) * S + (tid & 3) * 16;
    LAS unsigned char* kst = lds + srow * KSX + sc8 * 8;
    LAS unsigned char* vst = lds + 2 * MLA_KBX + (tid >> 2) * VSX + (tid & 3) * 16;
    const LAS unsigned char* kl = lds + r32 * KSX + hi * 32;
    const LAS unsigned char* vl = lds + 2 * MLA_KBX + r32 * VSX + hi * 32;
    u32x2 sk0, sk1, sk2; u32x4 sv0;
#define MLA_LOAD(j) do { const unsigned char* kp_ = kg + (size_t)(j) * (64 * 3072); const unsigned char* vp_ = vg + (size_t)(j) * 64; \
        sk0 = *(const GAS u32x2*)(kp_); sk1 = *(const GAS u32x2*)(kp_ + 64); sk2 = *(const GAS u32x2*)(kp_ + 128); sv0 = *(const GAS u32x4*)(vp_); } while (0)
#define MLA_STORE(b, vb) do { LAS unsigned char* kd_ = kst + (b) * MLA_KBX; LAS unsigned char* vd_ = vst + (vb) * VBX; \
        *(LAS u32x2*)(kd_) = sk0; *(LAS u32x2*)(kd_ + 64) = sk1; *(LAS u32x2*)(kd_ + 128) = sk2; *(LAS u32x2*)(vd_) = (u32x2){sv0.x, sv0.y}; *(LAS u32x2*)(vd_ + 8) = (u32x2){sv0.z, sv0.w}; } while (0)
    MLA_LOAD(0); MLA_STORE(0, 0);
    __syncthreads();
    asm volatile("" : "+v"(q[0]), "+v"(q[1]), "+v"(q[2]));
    float m = -1e30f, l = 0.f; f32x16 o[4];
#pragma unroll
    for (int d = 0; d < 4; ++d)
#pragma unroll
        for (int r = 0; r < 16; ++r) o[d][r] = 0.f;
    const bool trail = wave >= 4;
    i32x8 pb = {};
    int vb_cur = 0, vb_prev = 2;
    for (int j = 0; j < NT; ++j) {
        const int kb = 64 * j;
        int vb_next = vb_cur + 1; if (vb_next == 3) vb_next = 0;
        if (j + 1 < NT) MLA_LOAD(j + 1);
        if (trail && j > 0 && kb - 64 <= qw + 31) pv_tilex(o, pb, vl + vb_prev * VBX);
        if (kb <= qw + 31) {
            f32x16 p0, p1;
            qk_tilex(p0, p1, kl + (j & 1) * MLA_KBX, q);
            if (kb + 63 > qw) {
                const int dq = tq - kb - 4 * hi;
#pragma unroll
                for (int r = 0; r < 16; ++r) { const int c = (r & 3) + 8 * (r >> 2);
                    if (c > dq) p0[r] = -__builtin_inff();
                    if (c + 32 > dq) p1[r] = -__builtin_inff(); }
            }
            online_sm_x(p0, p1, m, l, o, QS_MLA);
            pb = packpx(p0, p1);
            if (!trail) pv_tilex(o, pb, vl + vb_cur * VBX);
        }
        if (j + 1 < NT) MLA_STORE((j + 1) & 1, vb_next);
        __syncthreads();
        vb_prev = vb_cur; vb_cur = vb_next;
    }
    if (trail && 64 * (NT - 1) <= qw + 31) pv_tilex(o, pb, vl + vb_prev * VBX);
    __syncthreads();
#undef MLA_LOAD
#undef MLA_STORE
    const float inv = 1.f / l;
    const bf16* zp = P.Z + (size_t)tq * 2048 + head * 128 + 4 * hi;
    bf16* op = P.O + (size_t)tq * 4096 + head * 128 + 4 * hi;
#pragma unroll
    for (int d0 = 0; d0 < 4; ++d0)
#pragma unroll
        for (int rg = 0; rg < 4; ++rg) { const int dim = 32 * d0 + 8 * rg;
            const u32x2 z = *(const GAS u32x2*)(zp + dim);
            u32x2 w; w.x = pk2(o[d0][4 * rg + 0] * inv * bflo(z.x), o[d0][4 * rg + 1] * inv * bfhi(z.x)); w.y = pk2(o[d0][4 * rg + 2] * inv * bflo(z.y), o[d0][4 * rg + 3] * inv * bfhi(z.y));
            *(GAS u32x2*)(op + dim) = w; }
}

#elif defined(MLA_BIG)
struct MlaPtrs { const bf16* Q; const bf16* K; const bf16* V; const bf16* Z; bf16* O; };
__device__ __forceinline__ void mla_unit(LAS unsigned char* lds, const MlaPtrs& P, int head, int qb, int tid_in, int wave, int lane_in) {
    int tid = tid_in; asm volatile("" : "+v"(tid)); const int lane = tid & 63; (void)lane_in;
    const int r32 = lane & 31, hi = lane >> 5;
    const int q0 = qb * 256, qw = q0 + wave * 32, tq = qw + r32;
    i64 q[12];
    { const unsigned char* qp = (const unsigned char*)P.Q + (size_t)tq * 3072 + head * 192 + hi * 8;
#pragma unroll
      for (int d0 = 0; d0 < 12; ++d0) q[d0] = *(const GAS i64*)(qp + d0 * 16); }
    const int NT = 4 * (qb + 1), NTB = NT / 2;
    const int srow = tid >> 3, sc8 = tid & 7;
    const unsigned char* kg = (const unsigned char*)P.K + (size_t)head * 192 + (size_t)srow * 3072 + sc8 * 8;
    const unsigned char* vg = (const unsigned char*)P.V + ((size_t)head * 128 + (tid >> 2)) * S + (tid & 3) * 32;
    LAS unsigned char* kst = lds + srow * KS8 + sc8 * 8;
    LAS unsigned char* vst = lds + 2 * MLA_KB8B + (tid >> 2) * VS8B + (tid & 3) * 32;
    const LAS unsigned char* kl = lds + r32 * KS8 + hi * 8;
    const LAS unsigned char* vl = lds + 2 * MLA_KB8B + r32 * VS8B + hi * 8;
    u32x2 sk0, sk1, sk2, sk3, sk4, sk5; u32x4 sv0, sv1;
#define MLA_LOAD(J) do { const unsigned char* kp_ = kg + (size_t)(J) * (128 * 3072); const unsigned char* vp_ = vg + (size_t)(J) * 128; \
        sk0 = *(const GAS u32x2*)(kp_); sk1 = *(const GAS u32x2*)(kp_ + 64); sk2 = *(const GAS u32x2*)(kp_ + 128); \
        sk3 = *(const GAS u32x2*)(kp_ + 64 * 3072); sk4 = *(const GAS u32x2*)(kp_ + 64 * 3072 + 64); sk5 = *(const GAS u32x2*)(kp_ + 64 * 3072 + 128); \
        sv0 = *(const GAS u32x4*)(vp_); sv1 = *(const GAS u32x4*)(vp_ + 16); } while (0)
#define MLA_STORE(b, vb) do { LAS unsigned char* kd_ = kst + (b) * MLA_KB8B; LAS unsigned char* vd_ = vst + (vb) * VB8B; \
        *(LAS u32x2*)(kd_) = sk0; *(LAS u32x2*)(kd_ + 64) = sk1; *(LAS u32x2*)(kd_ + 128) = sk2; \
        *(LAS u32x2*)(kd_ + 64 * KS8) = sk3; *(LAS u32x2*)(kd_ + 64 * KS8 + 64) = sk4; *(LAS u32x2*)(kd_ + 64 * KS8 + 128) = sk5; \
        *(LAS u32x2*)(vd_) = (u32x2){sv0.x, sv0.y}; *(LAS u32x2*)(vd_ + 8) = (u32x2){sv0.z, sv0.w}; *(LAS u32x2*)(vd_ + 16) = (u32x2){sv1.x, sv1.y}; *(LAS u32x2*)(vd_ + 24) = (u32x2){sv1.z, sv1.w}; } while (0)
    MLA_LOAD(0); MLA_STORE(0, 0);
    __syncthreads();
    float m = -1e30f, l = 0.f; f32x16 o[4];
#pragma unroll
    for (int d = 0; d < 4; ++d)
#pragma unroll
        for (int r = 0; r < 16; ++r) o[d][r] = 0.f;
    const bool trail = wave >= 4;
    i64 pb[4] = {};
    int vb_cur = 0, vb_prev = 2;
    for (int J = 0; J < NTB; ++J) {
        int vb_next = vb_cur + 1; if (vb_next == 3) vb_next = 0;
        if (J + 1 < NTB) MLA_LOAD(J + 1);
#pragma unroll
        for (int sub = 0; sub < 2; ++sub) {
            const int j = 2 * J + sub, kb = 64 * j;
            if (trail && j > 0 && kb - 64 <= qw + 31) pv_tile8(o, pb, vl + (sub == 0 ? vb_prev * VB8B + 64 : vb_cur * VB8B));
            if (kb <= qw + 31) {
                f32x16 p0, p1;
                qk_tile8<12>(p0, p1, kl + (J & 1) * MLA_KB8B + sub * 64 * KS8, q);
                if (kb + 63 > qw) {
                    const int dq = tq - kb - 4 * hi;
#pragma unroll
                    for (int r = 0; r < 16; ++r) { const int c = (r & 3) + 8 * (r >> 2);
                        if (c > dq) p0[r] = -__builtin_inff();
                        if (c + 32 > dq) p1[r] = -__builtin_inff(); }
                }
                online_sm_scaled(p0, p1, m, l, o, QS_MLA);
                pb[0] = packp8<0>(p0); pb[1] = packp8<1>(p0); pb[2] = packp8<0>(p1); pb[3] = packp8<1>(p1);
                if (!trail) pv_tile8(o, pb, vl + vb_cur * VB8B + sub * 64);
            }
        }
        if (J + 1 < NTB) MLA_STORE((J + 1) & 1, vb_next);
        __syncthreads();
        vb_prev = vb_cur; vb_cur = vb_next;
    }
    if (trail && 64 * (NT - 1) <= qw + 31) pv_tile8(o, pb, vl + vb_prev * VB8B + 64);
    __syncthreads();
#undef MLA_LOAD
#undef MLA_STORE
    const float inv = (1.f / 256.f) / l;
    const bf16* zp = P.Z + (size_t)tq * 2048 + head * 128 + 4 * hi;
    bf16* op = P.O + (size_t)tq * 4096 + head * 128 + 4 * hi;
#pragma unroll
    for (int d0 = 0; d0 < 4; ++d0)
#pragma unroll
        for (int rg = 0; rg < 4; ++rg) { const int dim = 32 * d0 + 8 * rg;
            const u32x2 z = *(const GAS u32x2*)(zp + dim);
            u32x2 w; w.x = pk2(o[d0][4 * rg + 0] * inv * bflo(z.x), o[d0][4 * rg + 1] * inv * bfhi(z.x)); w.y = pk2(o[d0][4 * rg + 2] * inv * bflo(z.y), o[d0][4 * rg + 3] * inv * bfhi(z.y));
            *(GAS u32x2*)(op + dim) = w; }
}

#elif defined(MLA_FP8V)
struct MlaPtrs { const bf16* Q; const bf16* K; const bf16* V; const bf16* Z; bf16* O; };
__device__ __forceinline__ void mla_unit(LAS unsigned char* lds, const MlaPtrs& P, int head, int qb, int tid_in, int wave, int lane_in) {
    int tid = tid_in; asm volatile("" : "+v"(tid)); const int lane = tid & 63; (void)lane_in;
    const int r32 = lane & 31, hi = lane >> 5;
    const int q0 = qb * 256, qw = q0 + wave * 32, tq = qw + r32;
    i64 q[12];
    { const unsigned char* qp = (const unsigned char*)P.Q + (size_t)tq * 3072 + head * 192 + hi * 8;
#pragma unroll
      for (int d0 = 0; d0 < 12; ++d0) q[d0] = *(const GAS i64*)(qp + d0 * 16); }
    const int NT = 4 * (qb + 1);
    const int srow = tid >> 3, sc8 = tid & 7;
    const unsigned char* kg = (const unsigned char*)P.K + (size_t)head * 192 + (size_t)srow * 3072 + sc8 * 8;
    const unsigned char* vg = (const unsigned char*)P.V + ((size_t)head * 128 + (tid >> 2)) * S + (tid & 3) * 16;
    LAS unsigned char* kst = lds + srow * KS8 + sc8 * 8;
    LAS unsigned char* vst = lds + 2 * MLA_KB8 + (tid >> 2) * VS8 + (tid & 3) * 16;
    const LAS unsigned char* kl = lds + r32 * KS8 + hi * 8;
    const LAS unsigned char* vl = lds + 2 * MLA_KB8 + r32 * VS8 + hi * 8;
    u32x2 sk0, sk1, sk2; u32x4 sv0;
#define MLA_LOAD(j) do { const unsigned char* kp_ = kg + (size_t)(j) * (64 * 3072); const unsigned char* vp_ = vg + (size_t)(j) * 64; \
        sk0 = *(const GAS u32x2*)(kp_); sk1 = *(const GAS u32x2*)(kp_ + 64); sk2 = *(const GAS u32x2*)(kp_ + 128); sv0 = *(const GAS u32x4*)(vp_); } while (0)
#define MLA_STORE(b, vb) do { LAS unsigned char* kd_ = kst + (b) * MLA_KB8; LAS unsigned char* vd_ = vst + (vb) * VB8; \
        *(LAS u32x2*)(kd_) = sk0; *(LAS u32x2*)(kd_ + 64) = sk1; *(LAS u32x2*)(kd_ + 128) = sk2; *(LAS u32x2*)(vd_) = (u32x2){sv0.x, sv0.y}; *(LAS u32x2*)(vd_ + 8) = (u32x2){sv0.z, sv0.w}; } while (0)
    MLA_LOAD(0); MLA_STORE(0, 0);
    __syncthreads();
    float m = -1e30f, l = 0.f; f32x16 o[4];
#pragma unroll
    for (int d = 0; d < 4; ++d)
#pragma unroll
        for (int r = 0; r < 16; ++r) o[d][r] = 0.f;
    const bool trail = wave >= 4;
    i64 pb[4] = {};
    int vb_cur = 0, vb_prev = 2;
    for (int j = 0; j < NT; ++j) {
        const int kb = 64 * j;
        int vb_next = vb_cur + 1; if (vb_next == 3) vb_next = 0;
        if (j + 1 < NT) MLA_LOAD(j + 1);
        if (trail && j > 0 && kb - 64 <= qw + 31) pv_tile8(o, pb, vl + vb_prev * VB8);
        if (kb <= qw + 31) {
            f32x16 p0, p1;
#ifdef PROBE_QKM2
            { f32x16 r0, r1; qk_tile_m2<12, KS_M>(p0, p1, r0, r1, kl + (j & 1) * MLA_KB, q);
#pragma unroll
              for (int r = 0; r < 16; ++r) { p0[r] = (p0[r] + r0[r]) * 0.5f; p1[r] = (p1[r] + r1[r]) * 0.5f; } }
#else
            qk_tile8<12>(p0, p1, kl + (j & 1) * MLA_KB8, q);
#endif
#ifdef PROBE_QK2
            { f32x16 r0, r1; asm volatile("" ::: "memory"); qk_tile<12, KS_M>(r0, r1, kl + (j & 1) * MLA_KB, q);
#pragma unroll
              for (int r = 0; r < 16; ++r) { p0[r] = (p0[r] + r0[r]) * 0.5f; p1[r] = (p1[r] + r1[r]) * 0.5f; } }
#endif
#ifdef PROBE_SM2
            { float acc_ = 0.f;
#pragma unroll
              for (int r = 0; r < 16; ++r) { acc_ += __builtin_amdgcn_exp2f(p0[r] - m - 40.f) + __builtin_amdgcn_exp2f(p1[r] - m - 40.f); }
#pragma unroll
              for (int r = 0; r < 16; ++r) { acc_ += __builtin_amdgcn_exp2f(p0[r] - m - 50.f) + __builtin_amdgcn_exp2f(p1[r] - m - 50.f); }
              if (acc_ == 12345.678f) l += 1.f; }
#endif
            if (kb + 63 > qw) {
                const int dq = tq - kb - 4 * hi;
#pragma unroll
                for (int r = 0; r < 16; ++r) { const int c = (r & 3) + 8 * (r >> 2);
                    if (c > dq) p0[r] = -__builtin_inff();
                    if (c + 32 > dq) p1[r] = -__builtin_inff(); }
            }
            online_sm_scaled(p0, p1, m, l, o, QS_MLA);
            pb[0] = packp8<0>(p0); pb[1] = packp8<1>(p0); pb[2] = packp8<0>(p1); pb[3] = packp8<1>(p1);
            if (!trail) pv_tile8(o, pb, vl + vb_cur * VB8);
        }
        if (j + 1 < NT) MLA_STORE((j + 1) & 1, vb_next);
        __syncthreads();
        vb_prev = vb_cur; vb_cur = vb_next;
    }
    if (trail && 64 * (NT - 1) <= qw + 31) pv_tile8(o, pb, vl + vb_prev * VB8);
    __syncthreads();
#undef MLA_LOAD
#undef MLA_STORE
    const float inv = (1.f / 256.f) / l;
    const bf16* zp = P.Z + (size_t)tq * 2048 + head * 128 + 4 * hi;
    bf16* op = P.O + (size_t)tq * 4096 + head * 128 + 4 * hi;
#pragma unroll
    for (int d0 = 0; d0 < 4; ++d0)
#pragma unroll
        for (int rg = 0; rg < 4; ++rg) { const int dim = 32 * d0 + 8 * rg;
            const u32x2 z = *(const GAS u32x2*)(zp + dim);
            u32x2 w; w.x = pk2(o[d0][4 * rg + 0] * inv * bflo(z.x), o[d0][4 * rg + 1] * inv * bfhi(z.x)); w.y = pk2(o[d0][4 * rg + 2] * inv * bflo(z.y), o[d0][4 * rg + 3] * inv * bfhi(z.y));
            *(GAS u32x2*)(op + dim) = w; }
}

#elif defined(MLA_FP8)
struct MlaPtrs { const bf16* Q; const bf16* K; const bf16* V; const bf16* Z; bf16* O; };
__device__ __forceinline__ void mla_unit(LAS unsigned char* lds, const MlaPtrs& P, int head, int qb, int tid_in, int wave, int lane_in) {
    int tid = tid_in; asm volatile("" : "+v"(tid)); const int lane = tid & 63; (void)lane_in;
    const int r32 = lane & 31, hi = lane >> 5;
    const int q0 = qb * 256, qw = q0 + wave * 32, tq = qw + r32;
    i64 q[12];
    { const unsigned char* qp = (const unsigned char*)P.Q + (size_t)tq * 3072 + head * 192 + hi * 8;
#pragma unroll
      for (int d0 = 0; d0 < 12; ++d0) q[d0] = *(const GAS i64*)(qp + d0 * 16); }
    const int NT = 4 * (qb + 1);
    const int srow = tid >> 3, sc8 = tid & 7;
    const unsigned char* kg = (const unsigned char*)P.K + (size_t)head * 192 + (size_t)srow * 3072 + sc8 * 8;
    const unsigned char* vg = (const unsigned char*)P.V + (size_t)head * 256 + (size_t)srow * 4096 + sc8 * 16;
    LAS unsigned char* kst = lds + srow * KS8 + sc8 * 8;
    LAS unsigned char* vst = lds + 2 * MLA_KB8 + srow * VS + sc8 * 16;
    const LAS unsigned char* kl = lds + r32 * KS8 + hi * 8;
    const LAS unsigned char* vl = lds + 2 * MLA_KB8 + (4 * hi + ((lane & 15) >> 2)) * VS + (16 * ((lane >> 4) & 1) + 4 * (lane & 3)) * 2;
    u32x2 sk0, sk1, sk2; u32x4 sv0, sv1;
#define MLA_LOAD(j) do { const unsigned char* kp_ = kg + (size_t)(j) * (64 * 3072); const unsigned char* vp_ = vg + (size_t)(j) * (64 * 4096); \
        sk0 = *(const GAS u32x2*)(kp_); sk1 = *(const GAS u32x2*)(kp_ + 64); sk2 = *(const GAS u32x2*)(kp_ + 128); sv0 = *(const GAS u32x4*)(vp_); sv1 = *(const GAS u32x4*)(vp_ + 128); } while (0)
#define MLA_STORE(b, vb) do { LAS unsigned char* kd_ = kst + (b) * MLA_KB8; LAS unsigned char* vd_ = vst + (vb) * VB; \
        *(LAS u32x2*)(kd_) = sk0; *(LAS u32x2*)(kd_ + 64) = sk1; *(LAS u32x2*)(kd_ + 128) = sk2; *(LAS u32x4*)(vd_) = sv0; *(LAS u32x4*)(vd_ + 128) = sv1; } while (0)
    MLA_LOAD(0); MLA_STORE(0, 0);
    __syncthreads();
    float m = -1e30f, l = 0.f; f32x16 o[4];
#pragma unroll
    for (int d = 0; d < 4; ++d)
#pragma unroll
        for (int r = 0; r < 16; ++r) o[d][r] = 0.f;
    const bool trail = wave >= 4;
    bf16x8 pb[4] = {};
    int vb_cur = 0, vb_prev = 2;
    for (int j = 0; j < NT; ++j) {
        const int kb = 64 * j;
        int vb_next = vb_cur + 1; if (vb_next == 3) vb_next = 0;
        if (j + 1 < NT) MLA_LOAD(j + 1);
        if (trail && j > 0 && kb - 64 <= qw + 31) pv_tile(o, pb, vl + vb_prev * VB);
        if (kb <= qw + 31) {
            f32x16 p0, p1;
#ifdef PROBE_QKM2
            { f32x16 r0, r1; qk_tile_m2<12, KS_M>(p0, p1, r0, r1, kl + (j & 1) * MLA_KB, q);
#pragma unroll
              for (int r = 0; r < 16; ++r) { p0[r] = (p0[r] + r0[r]) * 0.5f; p1[r] = (p1[r] + r1[r]) * 0.5f; } }
#else
            qk_tile8<12>(p0, p1, kl + (j & 1) * MLA_KB8, q);
#endif
#ifdef PROBE_QK2
            { f32x16 r0, r1; asm volatile("" ::: "memory"); qk_tile<12, KS_M>(r0, r1, kl + (j & 1) * MLA_KB, q);
#pragma unroll
              for (int r = 0; r < 16; ++r) { p0[r] = (p0[r] + r0[r]) * 0.5f; p1[r] = (p1[r] + r1[r]) * 0.5f; } }
#endif
#ifdef PROBE_SM2
            { float acc_ = 0.f;
#pragma unroll
              for (int r = 0; r < 16; ++r) { acc_ += __builtin_amdgcn_exp2f(p0[r] - m - 40.f) + __builtin_amdgcn_exp2f(p1[r] - m - 40.f); }
#pragma unroll
              for (int r = 0; r < 16; ++r) { acc_ += __builtin_amdgcn_exp2f(p0[r] - m - 50.f) + __builtin_amdgcn_exp2f(p1[r] - m - 50.f); }
              if (acc_ == 12345.678f) l += 1.f; }
#endif
            if (kb + 63 > qw) {
                const int dq = tq - kb - 4 * hi;
#pragma unroll
                for (int r = 0; r < 16; ++r) { const int c = (r & 3) + 8 * (r >> 2);
                    if (c > dq) p0[r] = -__builtin_inff();
                    if (c + 32 > dq) p1[r] = -__builtin_inff(); }
            }
            online_sm_scaled(p0, p1, m, l, o, QS_MLA);
            pb[0] = packp<0>(p0); pb[1] = packp<1>(p0); pb[2] = packp<0>(p1); pb[3] = packp<1>(p1);
            if (!trail) pv_tile(o, pb, vl + vb_cur * VB);
        }
        if (j + 1 < NT) MLA_STORE((j + 1) & 1, vb_next);
        __syncthreads();
        vb_prev = vb_cur; vb_cur = vb_next;
    }
    if (trail && 64 * (NT - 1) <= qw + 31) pv_tile(o, pb, vl + vb_prev * VB);
    __syncthreads();
#undef MLA_LOAD
#undef MLA_STORE
    const float inv = 1.f / l;
    const bf16* zp = P.Z + (size_t)tq * 2048 + head * 128 + 4 * hi;
    bf16* op = P.O + (size_t)tq * 4096 + head * 128 + 4 * hi;
#pragma unroll
    for (int d0 = 0; d0 < 4; ++d0)
#pragma unroll
        for (int rg = 0; rg < 4; ++rg) { const int dim = 32 * d0 + 8 * rg;
            const u32x2 z = *(const GAS u32x2*)(zp + dim);
            u32x2 w; w.x = pk2(o[d0][4 * rg + 0] * inv * bflo(z.x), o[d0][4 * rg + 1] * inv * bfhi(z.x)); w.y = pk2(o[d0][4 * rg + 2] * inv * bflo(z.y), o[d0][4 * rg + 3] * inv * bfhi(z.y));
            *(GAS u32x2*)(op + dim) = w; }
}

#else
struct MlaPtrs { const bf16* Q; const bf16* K; const bf16* V; const bf16* Z; bf16* O; };
__device__ __forceinline__ void mla_unit(LAS unsigned char* lds, const MlaPtrs& P, int head, int qb, int tid_in, int wave, int lane_in) {
    int tid = tid_in; asm volatile("" : "+v"(tid)); const int lane = tid & 63; (void)lane_in;
    const int r32 = lane & 31, hi = lane >> 5;
    const int q0 = qb * 256, qw = q0 + wave * 32, tq = qw + r32;
    bf16x8 q[12];
    { const bf16* qp = P.Q + (size_t)tq * 3072 + head * 192 + hi * 8;
#pragma unroll
      for (int d0 = 0; d0 < 12; ++d0) q[d0] = *(const GAS bf16x8*)(qp + d0 * 16); }
    const int NT = 4 * (qb + 1);
    const int srow = tid >> 3, sc8 = tid & 7;
    const unsigned char* kg = (const unsigned char*)P.K + (size_t)head * 384 + (size_t)srow * 6144 + sc8 * 16;
    const unsigned char* vg = (const unsigned char*)P.V + (size_t)head * 256 + (size_t)srow * 4096 + sc8 * 16;
    LAS unsigned char* kst = lds + srow * KS_M + sc8 * 16;
    LAS unsigned char* vst = lds + 2 * MLA_KB + srow * VS + sc8 * 16;
    const LAS unsigned char* kl = lds + r32 * KS_M + hi * 16;
    const LAS unsigned char* vl = lds + 2 * MLA_KB + (4 * hi + ((lane & 15) >> 2)) * VS + (16 * ((lane >> 4) & 1) + 4 * (lane & 3)) * 2;
    u32x4 sk0, sk1, sk2, sv0, sv1;
#define MLA_LOAD(j) do { const unsigned char* kp_ = kg + (size_t)(j) * (64 * 6144); const unsigned char* vp_ = vg + (size_t)(j) * (64 * 4096); \
        sk0 = *(const GAS u32x4*)(kp_); sk1 = *(const GAS u32x4*)(kp_ + 128); sk2 = *(const GAS u32x4*)(kp_ + 256); sv0 = *(const GAS u32x4*)(vp_); sv1 = *(const GAS u32x4*)(vp_ + 128); } while (0)
#define MLA_STORE(b, vb) do { LAS unsigned char* kd_ = kst + (b) * MLA_KB; LAS unsigned char* vd_ = vst + (vb) * VB; \
        *(LAS u32x4*)(kd_) = sk0; *(LAS u32x4*)(kd_ + 128) = sk1; *(LAS u32x4*)(kd_ + 256) = sk2; *(LAS u32x4*)(vd_) = sv0; *(LAS u32x4*)(vd_ + 128) = sv1; } while (0)
    MLA_LOAD(0); MLA_STORE(0, 0);
    __syncthreads();
    float m = -1e30f, l = 0.f; f32x16 o[4];
#pragma unroll
    for (int d = 0; d < 4; ++d)
#pragma unroll
        for (int r = 0; r < 16; ++r) o[d][r] = 0.f;
    const bool trail = wave >= 4;
    bf16x8 pb[4] = {};
    int vb_cur = 0, vb_prev = 2;
    for (int j = 0; j < NT; ++j) {
        const int kb = 64 * j;
        int vb_next = vb_cur + 1; if (vb_next == 3) vb_next = 0;
        if (j + 1 < NT) MLA_LOAD(j + 1);
        if (trail && j > 0 && kb - 64 <= qw + 31) pv_tile(o, pb, vl + vb_prev * VB);
        if (kb <= qw + 31) {
            f32x16 p0, p1;
#ifdef PROBE_QKM2
            { f32x16 r0, r1; qk_tile_m2<12, KS_M>(p0, p1, r0, r1, kl + (j & 1) * MLA_KB, q);
#pragma unroll
              for (int r = 0; r < 16; ++r) { p0[r] = (p0[r] + r0[r]) * 0.5f; p1[r] = (p1[r] + r1[r]) * 0.5f; } }
#else
            qk_tile<12, KS_M>(p0, p1, kl + (j & 1) * MLA_KB, q);
#endif
#ifdef PROBE_QK2
            { f32x16 r0, r1; asm volatile("" ::: "memory"); qk_tile<12, KS_M>(r0, r1, kl + (j & 1) * MLA_KB, q);
#pragma unroll
              for (int r = 0; r < 16; ++r) { p0[r] = (p0[r] + r0[r]) * 0.5f; p1[r] = (p1[r] + r1[r]) * 0.5f; } }
#endif
#ifdef PROBE_SM2
            { float acc_ = 0.f;
#pragma unroll
              for (int r = 0; r < 16; ++r) { acc_ += __builtin_amdgcn_exp2f(p0[r] - m - 40.f) + __builtin_amdgcn_exp2f(p1[r] - m - 40.f); }
#pragma unroll
              for (int r = 0; r < 16; ++r) { acc_ += __builtin_amdgcn_exp2f(p0[r] - m - 50.f) + __builtin_amdgcn_exp2f(p1[r] - m - 50.f); }
              if (acc_ == 12345.678f) l += 1.f; }
#endif
            if (kb + 63 > qw) {
                const int dq = tq - kb - 4 * hi;
#pragma unroll
                for (int r = 0; r < 16; ++r) { const int c = (r & 3) + 8 * (r >> 2);
                    if (c > dq) p0[r] = -__builtin_inff();
                    if (c + 32 > dq) p1[r] = -__builtin_inff(); }
            }
            online_sm(p0, p1, m, l, o);
            pb[0] = packp<0>(p0); pb[1] = packp<1>(p0); pb[2] = packp<0>(p1); pb[3] = packp<1>(p1);
            if (!trail) pv_tile(o, pb, vl + vb_cur * VB);
        }
        if (j + 1 < NT) MLA_STORE((j + 1) & 1, vb_next);
        __syncthreads();
        vb_prev = vb_cur; vb_cur = vb_next;
    }
    if (trail && 64 * (NT - 1) <= qw + 31) pv_tile(o, pb, vl + vb_prev * VB);
    __syncthreads();
#undef MLA_LOAD
#undef MLA_STORE
    const float inv = 1.f / l;
    const bf16* zp = P.Z + (size_t)tq * 2048 + head * 128 + 4 * hi;
    bf16* op = P.O + (size_t)tq * 4096 + head * 128 + 4 * hi;
#pragma unroll
    for (int d0 = 0; d0 < 4; ++d0)
#pragma unroll
        for (int rg = 0; rg < 4; ++rg) { const int dim = 32 * d0 + 8 * rg;
            const u32x2 z = *(const GAS u32x2*)(zp + dim);
            u32x2 w; w.x = pk2(o[d0][4 * rg + 0] * inv * bflo(z.x), o[d0][4 * rg + 1] * inv * bfhi(z.x)); w.y = pk2(o[d0][4 * rg + 2] * inv * bflo(z.y), o[d0][4 * rg + 3] * inv * bfhi(z.y));
            *(GAS u32x2*)(op + dim) = w; }
}

#endif
#endif
struct NsaPtrs { const bf16* Q; const bf16* KV; const bf16* KC; const bf16* VC; const bf16* Z; const float* G; bf16* O; float* scr; };
template <int MODE>
__device__ __forceinline__ void nsa_loop(LAS unsigned char* lds, const unsigned char* kbase, const unsigned char* vbase, int ntiles, int jlo,
                                         const bf16x8 (&q)[8], int t, float slope2, float& m, float& l, f32x16 (&o)[4], float invl, int tid, int wave, int lane) {
    constexpr bool HASV = MODE != 0;
    const int r32 = lane & 31, hi = lane >> 5;
    const int srow = tid >> 3, sc8 = tid & 7;
    const unsigned soff = srow * 256 + sc8 * 16;
    LAS unsigned char* kst = lds + srow * KS_N + sc8 * 16;
    LAS unsigned char* vst = lds + 2 * NSA_KB + srow * VS + sc8 * 16;
    const LAS unsigned char* kl = lds + r32 * KS_N + hi * 16;
    const LAS unsigned char* vl = lds + 2 * NSA_KB + (4 * hi + ((lane & 15) >> 2)) * VS + (16 * ((lane >> 4) & 1) + 4 * (lane & 3)) * 2;
    const LAS int* ulist = (const LAS int*)(lds + N_ULIST);
    const LAS unsigned* selm = (const LAS unsigned*)(lds + N_SELM);
    LAS float* partA = (LAS float*)(lds + N_PART); LAS float* partB = (LAS float*)(lds + N_PART + N_PARTB);
    LAS float* imp = (LAS float*)(lds + N_IMP); LAS float* carry = (LAS float*)(lds + N_CARRY);
    if (ntiles <= 0) return;
    const float mlg = (MODE == 1) ? (invl > 0.f ? m - __builtin_amdgcn_logf(invl) : __builtin_inff()) : 0.f;
    u32x4 sk0, sk1, sv0, sv1;
#define NSA_TROW(j) (MODE == 2 ? 64 * __builtin_amdgcn_readfirstlane(ulist[ntiles - 1 - (j)]) : ((MODE == 3 || MODE == 0) ? 64 * (jlo + ntiles - 1 - (j)) : 64 * (jlo + (j))))
#define NSA_LOAD(j) do { const size_t ro_ = (size_t)NSA_TROW(j) * 256 + soff; \
        sk0 = *(const GAS u32x4*)(kbase + ro_); sk1 = *(const GAS u32x4*)(kbase + ro_ + 128); \
        if (HASV) { sv0 = *(const GAS u32x4*)(vbase + ro_); sv1 = *(const GAS u32x4*)(vbase + ro_ + 128); } } while (0)
#define NSA_STORE(b) do { LAS unsigned char* kd_ = kst + (b) * NSA_KB; *(LAS u32x4*)(kd_) = sk0; *(LAS u32x4*)(kd_ + 128) = sk1; \
        if (HASV) { LAS unsigned char* vd_ = vst + (b) * VB; *(LAS u32x4*)(vd_) = sv0; *(LAS u32x4*)(vd_ + 128) = sv1; } } while (0)
    NSA_LOAD(0); NSA_STORE(0);
    __syncthreads();
    for (int j = 0; j < ntiles; ++j) {
        const int buf = j & 1;
        if (MODE != 1 && j + 1 < ntiles) NSA_LOAD(j + 1);
        const int trow = NSA_TROW(j);
        constexpr int PSTEP = (MODE <= 1) ? 16 : 1;
        const int pstart = (MODE <= 1) ? 16 * trow + 31 : trow;
        const int db = t - pstart - PSTEP * 4 * hi;
        constexpr unsigned W = (MODE == 3) ? 512u : 0x7fffffffu;
        const bool mset = m > -1e29f;
        float b0 = -slope2 * (float)db - ((MODE != 1) ? (mset ? m : 0.f) : mlg);
        if (MODE == 2) { const int b = trow >> 6; if (((selm[r32 * 8 + (b >> 5)] >> (b & 31)) & 1u) == 0u) b0 = -__builtin_inff(); }
        f32x16 p0, p1;
#pragma unroll
        for (int r = 0; r < 16; ++r) { const int c = PSTEP * ((r & 3) + 8 * (r >> 2));
            p0[r] = __builtin_fmaf(slope2, (float)c, b0); p1[r] = __builtin_fmaf(slope2, (float)(c + 32 * PSTEP), b0); }
        qk_tile<8, KS_N, false>(p0, p1, kl + buf * NSA_KB, q);
        { const int t0u = __builtin_amdgcn_readfirstlane(t - r32);
          const bool interior = (t0u - (pstart + PSTEP * 63) >= 0) && ((unsigned)(t0u + 31 - pstart) < W);
          if (!interior) {
#pragma unroll
              for (int r = 0; r < 16; ++r) { const int c = PSTEP * ((r & 3) + 8 * (r >> 2));
                  if ((unsigned)(db - c) >= W) p0[r] = -__builtin_inff();
                  if ((unsigned)(db - c - 32 * PSTEP) >= W) p1[r] = -__builtin_inff(); } } }
        if (MODE == 0) {
            float tm = p0[0];
#pragma unroll
            for (int r = 1; r < 16; ++r) tm = fmaxf(tm, p0[r]);
#pragma unroll
            for (int r = 0; r < 16; ++r) tm = fmaxf(tm, p1[r]);
            tm = swapmax(tm);
            const bool need = mset ? (tm > 16.f) : (tm > -1e29f);
            if (!__all(!need)) {
                const float dlt = need ? tm : 0.f;
                if (mset) l *= __builtin_amdgcn_exp2f(-dlt);
                if (need) m = (mset ? m : 0.f) + dlt;
#pragma unroll
                for (int r = 0; r < 16; ++r) { p0[r] -= dlt; p1[r] -= dlt; }
            }
            float ps = 0.f;
#pragma unroll
            for (int r = 0; r < 16; ++r) ps += __builtin_amdgcn_exp2f(p0[r]) + __builtin_amdgcn_exp2f(p1[r]);
            l += swapsum(ps);
        } else if (MODE == 1) {
#pragma unroll
            for (int r = 0; r < 16; ++r) { p0[r] = __builtin_amdgcn_exp2f(p0[r]); p1[r] = __builtin_amdgcn_exp2f(p1[r]); }
            LAS float* pa = partA + (wave * 32 + r32) * 17 + hi; LAS float* pbm = partB + (wave * 32 + r32) * 17 + hi;
#pragma unroll
            for (int rg = 0; rg < 4; ++rg) {
                pa[2 * rg] = (p0[4 * rg] + p0[4 * rg + 1]) + (p0[4 * rg + 2] + p0[4 * rg + 3]); pbm[2 * rg] = p0[4 * rg + 3];
                pa[8 + 2 * rg] = (p1[4 * rg] + p1[4 * rg + 1]) + (p1[4 * rg + 2] + p1[4 * rg + 3]); pbm[8 + 2 * rg] = p1[4 * rg + 3]; }
            const bf16x8 pb[4] = {packp<0>(p0), packp<1>(p0), packp<0>(p1), packp<1>(p1)};
            pv_tile(o, pb, vl + buf * VB);
            __syncthreads();
            { const int qq = tid >> 4, jl = tid & 15; float a = 0.f, bp = 0.f, bl = 0.f;
#pragma unroll
              for (int w = 0; w < 8; ++w) { a += partA[(w * 32 + qq) * 17 + jl]; bl += partB[(w * 32 + qq) * 17 + jl]; }
              if (jl > 0) {
#pragma unroll
                  for (int w = 0; w < 8; ++w) bp += partB[(w * 32 + qq) * 17 + jl - 1];
              } else bp = (j > 0) ? carry[((j - 1) & 1) * 32 + qq] : 0.f;
              imp[qq * 256 + 16 * j + jl] = a + bp;
              if (jl == 15) carry[(j & 1) * 32 + qq] = bl; }
        } else {
            constexpr float NSA_LAZY_T = 16.f;
            float tm = p0[0];
#pragma unroll
            for (int r = 1; r < 16; ++r) tm = fmaxf(tm, p0[r]);
#pragma unroll
            for (int r = 0; r < 16; ++r) tm = fmaxf(tm, p1[r]);
            tm = swapmax(tm);
            const bool need = mset ? (tm > NSA_LAZY_T) : (tm > -1e29f);
            if (!__all(!need)) {
                const float dlt = need ? tm : 0.f;
                const float alpha = mset ? __builtin_amdgcn_exp2f(-dlt) : 1.f;
                if (need) m = (mset ? m : 0.f) + dlt;
#pragma unroll
                for (int r = 0; r < 16; ++r) { p0[r] -= dlt; p1[r] -= dlt; }
                l *= alpha;
#pragma unroll
                for (int d_ = 0; d_ < 4; ++d_)
#pragma unroll
                    for (int r = 0; r < 16; ++r) o[d_][r] *= alpha;
            }
            float ps = 0.f;
#pragma unroll
            for (int r = 0; r < 16; ++r) { p0[r] = __builtin_amdgcn_exp2f(p0[r]); ps += p0[r]; }
#pragma unroll
            for (int r = 0; r < 16; ++r) { p1[r] = __builtin_amdgcn_exp2f(p1[r]); ps += p1[r]; }
            l += swapsum(ps);
            const bf16x8 pb[4] = {packp<0>(p0), packp<1>(p0), packp<0>(p1), packp<1>(p1)};
            pv_tile(o, pb, vl + buf * VB);
        }
        if (MODE == 1 && j + 1 < ntiles) NSA_LOAD(j + 1);
        if (j + 1 < ntiles) NSA_STORE(buf ^ 1);
        __syncthreads();
    }
#undef NSA_TROW
#undef NSA_LOAD
#undef NSA_STORE
}
__device__ __forceinline__ void nsa_topk(const LAS float* improw, LAS unsigned* selrow, int cur, int lane) {
    unsigned key[4]; bool sel[4];
    int nforced = 0;
#pragma unroll
    for (int k = 0; k < 4; ++k) { const int j = lane + 64 * k;
        const bool forced = (j == 0) || (j == cur) || (j == cur - 1);
        const bool causal = j <= cur;
        sel[k] = forced;
#ifdef IMPNOISE_BUILD
        { unsigned h = (unsigned)j * 2654435761u + (unsigned)(size_t)improw * 40503u; h ^= h >> 15; h *= 0x846ca68bu; h ^= h >> 16;
          const float r = (float)(int)(h & 0xffffu) * (1.f / 32768.f) - 1.f; const float v = improw[j] * (1.f + IMPNOISE_EPS * r);
          key[k] = (causal && !forced) ? (__float_as_uint(v) + 1u) : 0u; }
#else
        key[k] = (causal && !forced) ? (__float_as_uint(improw[j]) + 1u) : 0u;
#endif
    }
    nforced = 1 + (cur >= 1 ? 1 : 0) + (cur >= 2 ? 1 : 0);
    const int want = 16 - nforced;
    for (int it = 0; it < want; ++it) {
        unsigned bk = key[0]; int bj = lane;
#pragma unroll
        for (int k = 1; k < 4; ++k) { if (key[k] > bk) { bk = key[k]; bj = lane + 64 * k; } }
        unsigned long long best = ((unsigned long long)bk << 32) | (unsigned)(0xffffffffu - (unsigned)bj);
#pragma unroll
        for (int off = 1; off < 64; off <<= 1) {
            const unsigned lo = __shfl_xor((unsigned)best, off), hiw = __shfl_xor((unsigned)(best >> 32), off);
            const unsigned long long other = ((unsigned long long)hiw << 32) | lo;
            best = other > best ? other : best; }
        if ((unsigned)(best >> 32) == 0u) break;
        const int wj = (int)(0xffffffffu - (unsigned)best);
#pragma unroll
        for (int k = 0; k < 4; ++k) if (wj == lane + 64 * k) { key[k] = 0u; sel[k] = true; }
    }
#pragma unroll
    for (int k = 0; k < 4; ++k) { const unsigned long long bm = __ballot(sel[k]);
        if (lane == 0) { selrow[2 * k] = (unsigned)bm; selrow[2 * k + 1] = (unsigned)(bm >> 32); } }
}
__device__ __forceinline__ void nsa_topk4(const LAS float* imp0, LAS unsigned* sel0, int cur, int lane) {
    unsigned key[4][4]; bool forced[4];
#pragma unroll
    for (int k = 0; k < 4; ++k) { const int j = lane + 64 * k;
        forced[k] = (j == 0) || (j == cur) || (j == cur - 1);
        const bool cand = (j <= cur) && !forced[k];
#pragma unroll
        for (int i = 0; i < 4; ++i) key[i][k] = cand ? (__float_as_uint(imp0[i * 256 + j]) + 1u) : 0u; }
    const int want = 16 - (1 + (cur >= 1 ? 1 : 0) + (cur >= 2 ? 1 : 0));
    unsigned T[4] = {0u, 0u, 0u, 0u};
    for (int bit = 30; bit >= 0; --bit) {
#pragma unroll
        for (int i = 0; i < 4; ++i) { const unsigned c = T[i] | (1u << bit);
            const int n = __builtin_popcountll(__ballot(key[i][0] >= c)) + __builtin_popcountll(__ballot(key[i][1] >= c)) + __builtin_popcountll(__ballot(key[i][2] >= c)) + __builtin_popcountll(__ballot(key[i][3] >= c));
            if (n >= want) T[i] = c; }
    }
#pragma unroll
    for (int i = 0; i < 4; ++i) {
        const unsigned Ti = T[i];
        int rem = want;
        if (Ti != 0u) rem -= __builtin_popcountll(__ballot(key[i][0] > Ti)) + __builtin_popcountll(__ballot(key[i][1] > Ti)) + __builtin_popcountll(__ballot(key[i][2] > Ti)) + __builtin_popcountll(__ballot(key[i][3] > Ti));
#pragma unroll
        for (int k = 0; k < 4; ++k) {
            bool s = forced[k];
            if (Ti == 0u) s = s || key[i][k] >= 1u;
            else {
                const bool eq = key[i][k] == Ti; const unsigned long long em = __ballot(eq);
                const int below = (int)__builtin_amdgcn_mbcnt_hi((unsigned)(em >> 32), __builtin_amdgcn_mbcnt_lo((unsigned)em, 0u));
                s = s || key[i][k] > Ti || (eq && below < rem);
                rem -= __builtin_popcountll(em); if (rem < 0) rem = 0;
            }
            const unsigned long long bm = __ballot(s);
            if (lane == 0) { sel0[i * 8 + 2 * k] = (unsigned)bm; sel0[i * 8 + 2 * k + 1] = (unsigned)(bm >> 32); }
        }
    }
}
__device__ __forceinline__ int nsa_opaque(int v) { asm volatile("" : "+v"(v)); return v; }
__device__ __forceinline__ void nsa_unit(LAS unsigned char* lds, const NsaPtrs& P, int g, int qblk, int tid_in, int wave, int lane_in, int cu) {
    int tid = tid_in; asm volatile("" : "+v"(tid));
    const int lane = tid & 63; (void)lane_in;
    const int r32 = lane & 31, hi = lane >> 5;
    const int hh = 8 * g + wave, t0 = 32 * qblk, t = t0 + r32;
    const float slope2 = __builtin_amdgcn_exp2f(-0.5f * (float)(hh + 1)) * LOG2E;
    bf16x8 q[8];
    { const bf16* qp = P.Q + (size_t)t * 2048 + hh * 128 + hi * 8;
#pragma unroll
      for (int d0 = 0; d0 < 8; ++d0) q[d0] = *(const GAS bf16x8*)(qp + d0 * 16); }
#define NSA_SCR() ((GAS f32x4*)(P.scr + ((size_t)(cu * 8 + wave) * 16) * 256) + nsa_opaque(lane))
    const size_t CH = (size_t)S * 128 * 2;
    f32x16 o[4]; float m, l;
#define NSA_ZERO_O() do { _Pragma("unroll") for (int d_ = 0; d_ < 4; ++d_) _Pragma("unroll") for (int r_ = 0; r_ < 16; ++r_) o[d_][r_] = 0.f; } while (0)
    const int ncv = 2 * qblk + 1, ntc = (ncv + 63) >> 6;
    const unsigned char* kc = (const unsigned char*)P.KC + (size_t)g * 1024 * 256; const unsigned char* vc = (const unsigned char*)P.VC + (size_t)g * 1024 * 256;
    m = -1e30f; l = 0.f; NSA_ZERO_O();
    nsa_loop<0>(lds, kc, vc, ntc, 0, q, t, slope2, m, l, o, 0.f, tid, wave, lane);
    const float invl = l > 0.f ? 1.f / l : 0.f;
    nsa_loop<1>(lds, kc, vc, ntc, 0, q, t, slope2, m, l, o, invl, tid, wave, lane);
    { const float g_c = P.G[(size_t)t * 48 + hh]; GAS f32x4* scr = NSA_SCR();
#pragma unroll
    for (int d0 = 0; d0 < 4; ++d0)
#pragma unroll
        for (int rg = 0; rg < 4; ++rg) { f32x4 v = {o[d0][4 * rg] * g_c, o[d0][4 * rg + 1] * g_c, o[d0][4 * rg + 2] * g_c, o[d0][4 * rg + 3] * g_c}; scr[(d0 * 4 + rg) * 64] = v; } }
    const int cur = t0 >> 6;
    LAS unsigned* selm = (LAS unsigned*)(lds + N_SELM);
#ifdef NSA_TOPK_ITER
    for (int i = 0; i < 4; ++i) { const int qq = 4 * wave + i; nsa_topk((const LAS float*)(lds + N_IMP) + qq * 256, selm + qq * 8, cur, lane); }
#else
    nsa_topk4((const LAS float*)(lds + N_IMP) + 4 * wave * 256, selm + 4 * wave * 8, cur, lane);
#endif
    __syncthreads();
    if (wave == 0) {
        LAS int* ulist = (LAS int*)(lds + N_ULIST); int n = 0;
        for (int k = 0; k < 8; ++k) { unsigned u = (lane < 32) ? selm[lane * 8 + k] : 0u;
#pragma unroll
            for (int off = 1; off < 32; off <<= 1) u |= __shfl_xor(u, off);
            u = __builtin_amdgcn_readfirstlane(u);
            while (u) { const int b = __builtin_ctz(u); u &= u - 1u; if (lane == 0) ulist[n] = 32 * k + b; ++n; } }
        if (lane == 0) *(LAS int*)(lds + N_NTS) = n;
    }
    __syncthreads();
    const int nts = __builtin_amdgcn_readfirstlane(*(const LAS int*)(lds + N_NTS));
    m = -1e30f; l = 0.f; NSA_ZERO_O();
    nsa_loop<2>(lds, (const unsigned char*)P.KV + (size_t)(4 + g) * CH, (const unsigned char*)P.KV + (size_t)(6 + g) * CH, nts, 0, q, t, slope2, m, l, o, 0.f, tid, wave, lane);
    { const float f = P.G[(size_t)t * 48 + 16 + hh] / l; GAS f32x4* scr = NSA_SCR();
#pragma unroll
      for (int d0 = 0; d0 < 4; ++d0)
          { f32x4 v[4];
#pragma unroll
            for (int rg = 0; rg < 4; ++rg) v[rg] = scr[(d0 * 4 + rg) * 64];
#pragma unroll
            for (int rg = 0; rg < 4; ++rg) { v[rg][0] += o[d0][4 * rg] * f; v[rg][1] += o[d0][4 * rg + 1] * f; v[rg][2] += o[d0][4 * rg + 2] * f; v[rg][3] += o[d0][4 * rg + 3] * f; scr[(d0 * 4 + rg) * 64] = v[rg]; } } }
    const int jlo = (t0 > 511 ? t0 - 511 : 0) >> 6, jhi = (t0 + 31) >> 6;
    m = -1e30f; l = 0.f; NSA_ZERO_O();
    nsa_loop<3>(lds, (const unsigned char*)P.KV + (size_t)(8 + g) * CH, (const unsigned char*)P.KV + (size_t)(10 + g) * CH, jhi - jlo + 1, jlo, q, t, slope2, m, l, o, 0.f, tid, wave, lane);
    { const float f = P.G[(size_t)t * 48 + 32 + hh] / l; GAS f32x4* scr = NSA_SCR();
      const bf16* zp = P.Z + (size_t)t * 2048 + hh * 128 + 4 * hi;
      bf16* op = P.O + (size_t)t * 4096 + 2048 + hh * 128 + 4 * hi;
#pragma unroll
      for (int d0 = 0; d0 < 4; ++d0)
          { f32x4 av[4]; u32x2 zv[4];
#pragma unroll
            for (int rg = 0; rg < 4; ++rg) { av[rg] = scr[(d0 * 4 + rg) * 64]; zv[rg] = *(const GAS u32x2*)(zp + 32 * d0 + 8 * rg); }
#pragma unroll
          for (int rg = 0; rg < 4; ++rg) { const int dim = 32 * d0 + 8 * rg; const f32x4 a = av[rg];
              const u32x2 z = zv[rg];
              u32x2 w; w.x = pk2((a[0] + o[d0][4 * rg] * f) * bflo(z.x), (a[1] + o[d0][4 * rg + 1] * f) * bfhi(z.x)); w.y = pk2((a[2] + o[d0][4 * rg + 2] * f) * bflo(z.y), (a[3] + o[d0][4 * rg + 3] * f) * bfhi(z.y));
              *(GAS u32x2*)(op + dim) = w; } } }
#undef NSA_ZERO_O
#undef NSA_SCR
}
struct CmpPtrs { const bf16* KV; const bf16* W1; const bf16* W2; const float* cbp; bf16* KC; bf16* VC; };
__device__ __forceinline__ void cmp_unit(LAS unsigned char* lds, const CmpPtrs& P, int kv, int g, int tile, int tid, int wave, int lane) {
    const int fr = lane & 15, fq = lane >> 4;
    constexpr int CRS = 544;
    LAS unsigned char* As = lds + 16384;
    LAS unsigned char* Ws = As + 16 * CRS;
    const unsigned char* Ag = (const unsigned char*)(P.KV + (size_t)(kv * 2 + g) * ((size_t)S * 128) + (size_t)(16 * tile + (tid >> 5)) * 2048) + (tid & 31) * 16;
    const unsigned char* Wg = (const unsigned char*)(P.W1 + (size_t)kv * 128 * 4096 + (size_t)(tid >> 5) * 4096) + (tid & 31) * 16;
    LAS unsigned char* Ad = As + (tid >> 5) * CRS + (tid & 31) * 16;
    LAS unsigned char* Wd = Ws + (tid >> 5) * CRS + (tid & 31) * 16;
    const LAS unsigned char* Ar = As + fr * CRS + fq * 16;
    const LAS unsigned char* Wr = Ws + (16 * wave + fr) * CRS + fq * 16;
    u32x4 ra, rw[8];
#define CMP_LOAD(c) do { ra = *(const GAS u32x4*)(Ag + (c) * 512); _Pragma("unroll") for (int i_ = 0; i_ < 8; ++i_) rw[i_] = *(const GAS u32x4*)(Wg + (size_t)i_ * (16 * 8192) + (c) * 512); } while (0)
    CMP_LOAD(0);
    f32x4 acc = {0.f, 0.f, 0.f, 0.f};
    for (int c = 0; c < 16; ++c) {
        *(LAS u32x4*)Ad = ra;
#pragma unroll
        for (int i = 0; i < 8; ++i) *(LAS u32x4*)(Wd + i * 16 * CRS) = rw[i];
        __syncthreads();
        if (c + 1 < 16) CMP_LOAD(c + 1);
#pragma unroll
        for (int s = 0; s < 8; ++s) {
            const bf16x8 a = *(const LAS bf16x8*)(Ar + 64 * s), b = *(const LAS bf16x8*)(Wr + 64 * s);
            acc = __builtin_amdgcn_mfma_f32_16x16x32_bf16(a, b, acc, 0, 0, 0);
        }
        __syncthreads();
    }
#undef CMP_LOAD
    float bias = 0.f;
    { float bv[16];
#pragma unroll
      for (int c = 0; c < 16; ++c) bv[c] = *(const GAS float*)(P.cbp + (size_t)(kv * 16 + c) * 128 + 16 * wave + fr);
#pragma unroll
      for (int c = 0; c < 16; ++c) bias += bv[c]; }
    LAS bf16* hid = (LAS bf16*)lds;
#pragma unroll
    for (int i = 0; i < 4; ++i) hid[(4 * fq + i) * 136 + 16 * wave + fr] = (bf16)(pk2(silu_f(acc[i] + bias), 0.f) & 0xffffu);
    __syncthreads();
    const bf16* B2 = P.W2 + (size_t)kv * 128 * 128 + (size_t)(16 * wave + fr) * 128 + 8 * fq;
    f32x4 acc2 = {0.f, 0.f, 0.f, 0.f};
#pragma unroll
    for (int s = 0; s < 4; ++s) {
        const bf16x8 a = *(const LAS bf16x8*)(hid + fr * 136 + 32 * s + 8 * fq), b = *(const GAS bf16x8*)(B2 + 32 * s);
        acc2 = __builtin_amdgcn_mfma_f32_16x16x32_bf16(a, b, acc2, 0, 0, 0);
    }
    bf16* out = (kv ? P.VC : P.KC) + (size_t)g * 1024 * 128;
#pragma unroll
    for (int i = 0; i < 4; ++i) { const int nn = 16 * tile + 4 * fq + i; out[(size_t)nn * 128 + 16 * wave + fr] = (nn < 1023) ? (bf16)(pk2(acc2[i], 0.f) & 0xffffu) : (bf16)0; }
    __syncthreads();
}
}
#ifdef CHK_BUILD
namespace chk {
constexpr size_t WS_CHK = 14 * MiB;
__device__ __forceinline__ float bf2f(bf16 v) { return __uint_as_float((unsigned)v << 16); }
__device__ __forceinline__ float e4m3(unsigned char b) {
    const int e = (b >> 3) & 15, mm = b & 7; const float v = e == 0 ? (float)mm * (1.f / 512.f) : (1.f + (float)mm * 0.125f) * exp2f((float)(e - 7)); return (b & 0x80) ? -v : v; }
__device__ __forceinline__ int sample_t(int i) { return i * 64 + (i * 29) % 64; }
__device__ __noinline__ void nsa_check(LAS unsigned char* lds, unsigned char* ws, int t, int g, LAS float* acc2) {
    int tid_ = threadIdx.x; asm volatile("" : "+v"(tid_)); const int tid = tid_, lane = tid & 63, wave = tid >> 6;
    const int hh = 8 * g + wave, cur = t >> 6;
    const bf16* QN = (const bf16*)(ws + WS_QNSA); const bf16* KV = (const bf16*)(ws + WS_KVNSA); const bf16* KC = (const bf16*)(ws + WS_KCMP) + (size_t)g * 1024 * 128; const bf16* VC = (const bf16*)(ws + WS_VCMP) + (size_t)g * 1024 * 128;
    const bf16* ZN = (const bf16*)(ws + WS_ZNSA); const float* GN = (const float*)(ws + WS_GNSA); const bf16* HO = (const bf16*)(ws + WS_H);
    const size_t CH = (size_t)S * 128;
    LAS float* pc = (LAS float*)lds;
    LAS float* impv = (LAS float*)(lds + 32768);
    LAS int* sel = (LAS int*)(lds + 32768 + 1024);
    const float slope2 = exp2f(-0.5f * (float)(hh + 1)) * LOG2E;
    const float q0 = bf2f(QN[(size_t)t * 2048 + hh * 128 + 2 * lane]), q1 = bf2f(QN[(size_t)t * 2048 + hh * 128 + 2 * lane + 1]);
    float oc0 = 0.f, oc1 = 0.f, os0 = 0.f, os1 = 0.f, ow0 = 0.f, ow1 = 0.f;
    const int ncv = (t >= 31) ? (t - 31) / 16 + 1 : 0;
    for (int n = lane; n < 1024; n += 64) pc[wave * 1024 + n] = 0.f;
    float mx = -1e30f;
    for (int n = 0; n < ncv; ++n) { float s = q0 * bf2f(KC[(size_t)n * 128 + 2 * lane]) + q1 * bf2f(KC[(size_t)n * 128 + 2 * lane + 1]); s = wave_sum(s) - slope2 * (float)(t - 16 * n - 31);
        if (lane == 0) pc[wave * 1024 + n] = s; mx = fmaxf(mx, s); }
    __syncthreads();
    float sum = 0.f;
    for (int n = 0; n < ncv; ++n) sum += exp2f(pc[wave * 1024 + n] - mx);
    __syncthreads();
    for (int n = lane; n < 1024; n += 64) pc[wave * 1024 + n] = (n < ncv) ? exp2f(pc[wave * 1024 + n] - mx) / sum : 0.f;
    __syncthreads();
    for (int n = 0; n < ncv; ++n) { const float p = pc[wave * 1024 + n]; oc0 += p * bf2f(VC[(size_t)n * 128 + 2 * lane]); oc1 += p * bf2f(VC[(size_t)n * 128 + 2 * lane + 1]); }
    if (tid < 256) { const int j = tid; float v = -1e30f;
        if (64 * j <= t) { float a = 0.f; for (int ii = 4 * j - 1; ii <= 4 * j + 3; ++ii) if (ii >= 0 && ii <= 1022) { float ps = 0.f; for (int h = 0; h < 8; ++h) ps += pc[h * 1024 + ii]; a += ps; }
            const bool forced = (j == 0) || (j == cur) || (j == cur - 1); v = a + (forced ? 1e4f : 0.f); }
        impv[j] = v; }
    __syncthreads();
    if (tid < 256) { const int j = tid; const float v = impv[j]; int rank = 0; for (int ii = 0; ii < 256; ++ii) { const float u = impv[ii]; rank += (u > v || (u == v && ii < j)) ? 1 : 0; } sel[j] = rank < 16 ? 1 : 0; }
    __syncthreads();
    const bf16* KS = KV + (size_t)(4 + g) * CH; const bf16* VSl = KV + (size_t)(6 + g) * CH;
    mx = -1e30f;
    for (int j = 0; j < 256; ++j) if (sel[j]) for (int tok = 64 * j; tok < 64 * j + 64 && tok <= t; ++tok) {
        float s = q0 * bf2f(KS[(size_t)tok * 128 + 2 * lane]) + q1 * bf2f(KS[(size_t)tok * 128 + 2 * lane + 1]); s = wave_sum(s) - slope2 * (float)(t - tok); mx = fmaxf(mx, s); }
    sum = 0.f;
    for (int j = 0; j < 256; ++j) if (sel[j]) for (int tok = 64 * j; tok < 64 * j + 64 && tok <= t; ++tok) {
        float s = q0 * bf2f(KS[(size_t)tok * 128 + 2 * lane]) + q1 * bf2f(KS[(size_t)tok * 128 + 2 * lane + 1]); s = wave_sum(s) - slope2 * (float)(t - tok);
        const float p = exp2f(s - mx); sum += p; os0 += p * bf2f(VSl[(size_t)tok * 128 + 2 * lane]); os1 += p * bf2f(VSl[(size_t)tok * 128 + 2 * lane + 1]); }
    os0 /= sum; os1 /= sum;
    const bf16* KW = KV + (size_t)(8 + g) * CH; const bf16* VW = KV + (size_t)(10 + g) * CH;
    const int lo = t - 511 > 0 ? t - 511 : 0;
    mx = -1e30f;
    for (int tok = lo; tok <= t; ++tok) { float s = q0 * bf2f(KW[(size_t)tok * 128 + 2 * lane]) + q1 * bf2f(KW[(size_t)tok * 128 + 2 * lane + 1]); s = wave_sum(s) - slope2 * (float)(t - tok); mx = fmaxf(mx, s); }
    sum = 0.f;
    for (int tok = lo; tok <= t; ++tok) { float s = q0 * bf2f(KW[(size_t)tok * 128 + 2 * lane]) + q1 * bf2f(KW[(size_t)tok * 128 + 2 * lane + 1]); s = wave_sum(s) - slope2 * (float)(t - tok);
        const float p = exp2f(s - mx); sum += p; ow0 += p * bf2f(VW[(size_t)tok * 128 + 2 * lane]); ow1 += p * bf2f(VW[(size_t)tok * 128 + 2 * lane + 1]); }
    ow0 /= sum; ow1 /= sum;
    const float gc = GN[(size_t)t * 48 + hh], gs = GN[(size_t)t * 48 + 16 + hh], gwv = GN[(size_t)t * 48 + 32 + hh];
    const float r0 = (gc * oc0 + gs * os0 + gwv * ow0) * bf2f(ZN[(size_t)t * 2048 + hh * 128 + 2 * lane]), r1 = (gc * oc1 + gs * os1 + gwv * ow1) * bf2f(ZN[(size_t)t * 2048 + hh * 128 + 2 * lane + 1]);
    const float f0 = bf2f(HO[(size_t)t * 4096 + 2048 + hh * 128 + 2 * lane]), f1 = bf2f(HO[(size_t)t * 4096 + 2048 + hh * 128 + 2 * lane + 1]);
    const float e2 = wave_sum((r0 - f0) * (r0 - f0) + (r1 - f1) * (r1 - f1)), n2 = wave_sum(r0 * r0 + r1 * r1);
    __syncthreads();
    if (lane == 0) { pc[wave] = e2; pc[8 + wave] = n2; }
    __syncthreads();
    if (tid == 0) { float a = 0.f, b = 0.f; for (int w = 0; w < 8; ++w) { a += pc[w]; b += pc[8 + w]; } acc2[0] += a; acc2[1] += b; }
    __syncthreads();
}
__device__ __forceinline__ void mla_check(LAS unsigned char* lds, unsigned char* ws, int t, LAS float* acc2) {
    int tid_ = threadIdx.x; asm volatile("" : "+v"(tid_)); const int tid = tid_, lane = tid & 63, wave = tid >> 6;
    const bf16* ZM = (const bf16*)(ws + WS_ZMLA); const bf16* HO = (const bf16*)(ws + WS_H);
    LAS float* qs = (LAS float*)lds + wave * 192;
    LAS float* red = (LAS float*)lds + 8 * 192;
    float ae = 0.f, an = 0.f;
    for (int rep = 0; rep < 2; ++rep) { const int head = wave + 8 * rep;
#ifdef MLA_FP8
        { const unsigned char* qp = (const unsigned char*)(ws + WS_QMLA) + (size_t)t * 3072 + head * 192; for (int d = lane; d < 192; d += 64) qs[d] = e4m3(qp[d]) * QS_MLA; }
#else
        { const bf16* qp = (const bf16*)(ws + WS_QMLA) + (size_t)t * 3072 + head * 192; for (int d = lane; d < 192; d += 64) qs[d] = bf2f(qp[d]); }
#endif
        __syncthreads();
        float mx = -1e30f;
        for (int c = 0; 64 * c <= t; ++c) {
#ifdef MLA_MX
            const int tok = 64 * c + 8 * ((lane >> 2) & 7) + 4 * (lane >> 5) + (lane & 3);
#else
            const int x_ = lane & 15; const int tok = 64 * c + (lane & 48) + (x_ < 4 ? x_ : (x_ < 8 ? x_ + 4 : (x_ < 12 ? x_ - 4 : x_)));
#endif

            float s = 0.f;
#ifdef MLA_FP8
            const unsigned char* kp = (const unsigned char*)(ws + WS_KMLA) + (size_t)tok * 3072 + head * 192; for (int d = 0; d < 192; ++d) s += qs[d] * e4m3(kp[d]);
#else
            const bf16* kp = (const bf16*)(ws + WS_KMLA) + (size_t)tok * 3072 + head * 192; for (int d = 0; d < 192; ++d) s += qs[d] * bf2f(kp[d]);
#endif
            if (tok <= t) mx = fmaxf(mx, s); }
        for (int off = 1; off < 64; off <<= 1) mx = fmaxf(mx, __shfl_xor(mx, off));
        float e2 = 0.f, n2 = 0.f;
        for (int dc = 0; dc < 8; ++dc) {
        float sum = 0.f; float o[16];
#pragma unroll
        for (int d = 0; d < 16; ++d) o[d] = 0.f;
        for (int c = 0; 64 * c <= t; ++c) {
#ifdef MLA_MX
            const int tok = 64 * c + 8 * ((lane >> 2) & 7) + 4 * (lane >> 5) + (lane & 3);
#else
            const int x_ = lane & 15; const int tok = 64 * c + (lane & 48) + (x_ < 4 ? x_ : (x_ < 8 ? x_ + 4 : (x_ < 12 ? x_ - 4 : x_)));
#endif

            float s = 0.f;
#ifdef MLA_FP8
            const unsigned char* kp = (const unsigned char*)(ws + WS_KMLA) + (size_t)tok * 3072 + head * 192; for (int d = 0; d < 192; ++d) s += qs[d] * e4m3(kp[d]);
#else
            const bf16* kp = (const bf16*)(ws + WS_KMLA) + (size_t)tok * 3072 + head * 192; for (int d = 0; d < 192; ++d) s += qs[d] * bf2f(kp[d]);
#endif
            const float p = (tok <= t) ? exp2f(s - mx) : 0.f; sum += p;
#ifdef MLA_FP8V
            const unsigned char* vt = (const unsigned char*)(ws + WS_VMLA) + ((size_t)head * 128 + 16 * dc) * S + 64 * c + lane;
#pragma unroll
            for (int d = 0; d < 16; ++d) o[d] += p * e4m3(vt[(size_t)d * S]);
#else
            const bf16* vp = (const bf16*)(ws + WS_VMLA) + (size_t)tok * 2048 + head * 128 + 16 * dc;
#pragma unroll
            for (int d = 0; d < 16; ++d) o[d] += p * bf2f(vp[d]);
#endif
        }
        sum = wave_sum(sum);
#pragma unroll
        for (int d = 0; d < 16; ++d) { const float od = wave_sum(o[d]) / sum; const float r = od * bf2f(ZM[(size_t)t * 2048 + head * 128 + 16 * dc + d]), f = bf2f(HO[(size_t)t * 4096 + head * 128 + 16 * dc + d]); e2 += (r - f) * (r - f); n2 += r * r; }
        }
        ae += e2; an += n2;
        __syncthreads(); }
    if (lane == 0) { red[wave] = ae; red[8 + wave] = an; }
    __syncthreads();
    if (tid == 0) { float a = 0.f, b = 0.f; for (int w = 0; w < 8; ++w) { a += red[w]; b += red[8 + w]; } acc2[0] += a; acc2[1] += b; }
    __syncthreads();
}
}
#endif
#ifdef CHK2_BUILD
namespace chk2 {
constexpr size_t WS_CHK = 14 * MiB;
__device__ __forceinline__ float bf2f(bf16 v) { return __uint_as_float((unsigned)v << 16); }
__device__ __forceinline__ int sample_t(int i) { return i * 256 + (i * 29) % 256; }
__device__ __noinline__ void proj_check(LAS unsigned char* lds, unsigned char* ws, const float* x, const float* w_in_l, int l, int i, int qd, LAS float* acc2) {
    int tid_ = threadIdx.x; asm volatile("" : "+v"(tid_)); const int tid = tid_;
    const int t = sample_t(i);
    LAS float* h = (LAS float*)lds;
    LAS float* red = h + 4096;
    const float* mod = (const float*)(ws + WS_MOD) + (size_t)l * 3 * D;
    const float* xin = (l == 0) ? x : (const float*)(ws + WS_XV);
    for (int k = tid; k < D; k += NTHR) h[k] = xin[(size_t)t * D + k] * (1.f + mod[D + k]) + mod[k];
    __syncthreads();
    float e2 = 0.f, r2 = 0.f;
    const float* cosT = (const float*)(ws + WS_ROPE); const float* sinT = cosT + (size_t)S * 32;
    for (int n = qd * 2268 + tid; n < (qd + 1) * 2268; n += NTHR) {
        float a = 0.f;
        for (int k = 0; k < D; ++k) a += h[k] * w_in_l[(size_t)k * INC + n];
        float ref = a, got;
        if (n < 768) got = bf2f(((const bf16*)(ws + WS_QLAT))[(size_t)t * 768 + n]);
        else if (n < 1280) got = bf2f(((const bf16*)(ws + WS_KVLAT))[(size_t)t * 512 + n - 768]);
        else if (n < 1344) {
            const int ii = n - 1280, pi = ii & 31; const int np = 1280 + (ii < 32 ? ii + 32 : ii - 32); float b = 0.f;
            for (int k = 0; k < D; ++k) b += h[k] * w_in_l[(size_t)k * INC + np];
            const float c = cosT[(size_t)t * 32 + pi], s = sinT[(size_t)t * 32 + pi];
            ref = ii < 32 ? a * c - b * s : a * c + b * s;
            got = bf2f(((const bf16*)(ws + WS_KMLA))[(size_t)t * 3072 + 5 * 192 + 128 + 2 * pi + (ii >> 5)]);
        }
        else if (n < 3392) { ref = a / (1.f + expf(-a)); got = bf2f(((const bf16*)(ws + WS_ZMLA))[(size_t)t * 2048 + n - 1344]); }
        else if (n < 5440) { ref = a * QS_NSA; got = bf2f(((const bf16*)(ws + WS_QNSA))[(size_t)t * 2048 + n - 3392]); }
        else if (n < 6976) { const int c = n - 5440; got = bf2f(((const bf16*)(ws + WS_KVNSA))[(size_t)(c >> 7) * ((size_t)S * 128) + (size_t)t * 128 + (c & 127)]); }
        else if (n < 7024) { ref = 1.f / (1.f + expf(-a)); got = ((const float*)(ws + WS_GNSA))[(size_t)t * 48 + n - 6976]; }
        else { ref = a / (1.f + expf(-a)); got = bf2f(((const bf16*)(ws + WS_ZNSA))[(size_t)t * 2048 + n - 7024]); }
        e2 += (ref - got) * (ref - got); r2 += ref * ref;
    }
    red[tid] = e2; red[512 + tid] = r2;
    __syncthreads();
    if (tid == 0) { float a = 0.f, b = 0.f; for (int k = 0; k < 512; ++k) { a += red[k]; b += red[512 + k]; } acc2[0] += a; acc2[1] += b; }
    __syncthreads();
}
__device__ __noinline__ void cmp_check(LAS unsigned char* lds, unsigned char* ws, const float* cmp_pos_l, const float* w1_l, const float* w2_l, int i, LAS float* acc2) {
    int tid_ = threadIdx.x; asm volatile("" : "+v"(tid_)); const int tid = tid_;
    const int n = (4 * i + (i & 3)) % 1023, kv = i & 1, g = (i >> 1) & 1;
    LAS float* blk = (LAS float*)lds;
    LAS float* hid = blk + 4096;
    LAS float* red = hid + 128;
    const bf16* A = (const bf16*)(ws + WS_KVNSA) + (size_t)(kv * 2 + g) * ((size_t)S * 128) + (size_t)n * 2048;
    for (int k = tid; k < 4096; k += NTHR) blk[k] = bf2f(A[k]) + cmp_pos_l[(size_t)kv * 4096 + k];
    __syncthreads();
    if (tid < 128) { float a = 0.f; const float* W = w1_l + (size_t)kv * 4096 * 128 + tid; for (int k = 0; k < 4096; ++k) a += blk[k] * W[(size_t)k * 128]; hid[tid] = a / (1.f + expf(-a)); }
    __syncthreads();
    float e2 = 0.f, r2 = 0.f;
    if (tid < 128) { float a = 0.f; const float* W = w2_l + (size_t)kv * 128 * 128 + tid; for (int k = 0; k < 128; ++k) a += hid[k] * W[(size_t)k * 128];
        const float got = bf2f(((const bf16*)(ws + (kv ? WS_VCMP : WS_KCMP)))[(size_t)g * 1024 * 128 + (size_t)n * 128 + tid]); e2 = (a - got) * (a - got); r2 = a * a; }
    if (tid < 128) { red[tid] = e2; red[128 + tid] = r2; }
    __syncthreads();
    if (tid == 0) { float a = 0.f, b = 0.f; for (int k = 0; k < 128; ++k) { a += red[k]; b += red[128 + k]; } acc2[0] += a; acc2[1] += b; }
    __syncthreads();
}
}
#endif
#ifdef CHK3_BUILD
namespace chk3 {
constexpr size_t WS_CHK = 14 * MiB;
__device__ __forceinline__ float bf2f(bf16 v) { return __uint_as_float((unsigned)v << 16); }
__device__ __forceinline__ float e4m3(unsigned char b) { const int e = (b >> 3) & 15, mm = b & 7; const float v = e == 0 ? (float)mm * (1.f / 512.f) : (1.f + (float)mm * 0.125f) * exp2f((float)(e - 7)); return (b & 0x80) ? -v : v; }
__device__ __forceinline__ int sample_t(int i) { return i * 64 + (i * 29) % 64; }
__device__ __noinline__ void up_check(LAS unsigned char* lds, unsigned char* ws, const float* qn, const float* wq, const float* kn, const float* wkv, int i, LAS float* acc2) {
    int tid_ = threadIdx.x; asm volatile("" : "+v"(tid_)); const int tid = tid_;
    const int t = sample_t(i);
    LAS float* ql = (LAS float*)lds;
    LAS float* kl = ql + 768;
    LAS float* qo = kl + 512;
    LAS float* red = qo + 3072;
    const bf16* QL = (const bf16*)(ws + WS_QLAT) + (size_t)t * 768; const bf16* KL = (const bf16*)(ws + WS_KVLAT) + (size_t)t * 512;
    float s = 0.f; for (int k = tid; k < 768; k += NTHR) { const float v = bf2f(QL[k]); s += v * v; }
    red[tid] = s; __syncthreads();
    float tot = 0.f; for (int k = 0; k < 512; ++k) tot += red[k];
    const float rq = 1.f / sqrtf(tot / 768.f + RMS_EPS);
    __syncthreads();
    s = 0.f; for (int k = tid; k < 512; k += NTHR) { const float v = bf2f(KL[k]); s += v * v; }
    red[tid] = s; __syncthreads();
    tot = 0.f; for (int k = 0; k < 512; ++k) tot += red[k];
    const float rk = 1.f / sqrtf(tot / 512.f + RMS_EPS);
    __syncthreads();
    for (int k = tid; k < 768; k += NTHR) ql[k] = bf2f(QL[k]) * rq * qn[k];
    for (int k = tid; k < 512; k += NTHR) kl[k] = bf2f(KL[k]) * rk * kn[k];
    __syncthreads();
    for (int n = tid; n < 3072; n += NTHR) { float a = 0.f; for (int k = 0; k < 768; ++k) a += ql[k] * wq[(size_t)k * 3072 + n]; qo[n] = a; }
    __syncthreads();
    float e2 = 0.f, r2 = 0.f;
    const float* cosT = (const float*)(ws + WS_ROPE); const float* sinT = cosT + (size_t)S * 32;
    const bf16* QM = (const bf16*)(ws + WS_QMLA) + (size_t)t * 3072;
    for (int n = tid; n < 3072; n += NTHR) { const int h = n / 192, d = n % 192; float ref, got;
#ifdef MLA_FP8
        const unsigned char* Q8 = (const unsigned char*)(ws + WS_QMLA) + (size_t)t * 3072;
        if (d < 128) { ref = qo[n]; got = e4m3(Q8[h * 192 + d]); }
        else { const int ii = d - 128, pi = ii & 31; const float x1 = qo[h * 192 + 128 + pi], x2 = qo[h * 192 + 160 + pi]; const float c = cosT[(size_t)t * 32 + pi], sn = sinT[(size_t)t * 32 + pi];
            ref = (ii < 32 ? x1 * c - x2 * sn : x2 * c + x1 * sn); got = e4m3(Q8[h * 192 + 128 + 2 * pi + (ii >> 5)]); }
        if (false) {}
#else
        if (d < 128) { ref = qo[n] * QS_MLA; got = bf2f(QM[h * 192 + d]); }
        else { const int ii = d - 128, pi = ii & 31; const float x1 = qo[h * 192 + 128 + pi], x2 = qo[h * 192 + 160 + pi]; const float c = cosT[(size_t)t * 32 + pi], sn = sinT[(size_t)t * 32 + pi];
            ref = (ii < 32 ? x1 * c - x2 * sn : x2 * c + x1 * sn) * QS_MLA; got = bf2f(QM[h * 192 + 128 + 2 * pi + (ii >> 5)]); }
#endif
        e2 += (ref - got) * (ref - got); r2 += ref * ref; }
    const bf16* KM = (const bf16*)(ws + WS_KMLA) + (size_t)t * 3072; const bf16* VM = (const bf16*)(ws + WS_VMLA) + (size_t)t * 2048;
    for (int n = tid; n < 4096; n += NTHR) { float a = 0.f; for (int k = 0; k < 512; ++k) a += kl[k] * wkv[(size_t)k * 4096 + n];
#ifdef MLA_FP8
        const int h = n >> 8, d = n & 255; const float got = d < 128 ? e4m3(((const unsigned char*)(ws + WS_KMLA) + (size_t)t * 3072)[h * 192 + d]) : bf2f(VM[h * 128 + d - 128]);
#else
        const int h = n >> 8, d = n & 255; const float got = d < 128 ? bf2f(KM[h * 192 + d]) : bf2f(VM[h * 128 + d - 128]);
#endif
        e2 += (a - got) * (a - got); r2 += a * a; }
    red[tid] = e2; red[512 + tid] = r2;
    __syncthreads();
    if (tid == 0) { float a = 0.f, b = 0.f; for (int k = 0; k < 512; ++k) { a += red[k]; b += red[512 + k]; } acc2[0] += a; acc2[1] += b; }
    __syncthreads();
}
__device__ __noinline__ void out_check(LAS unsigned char* lds, unsigned char* ws, const float* xin, const float* xv, const float* wout, const float* gate, int i, int qd, LAS float* acc2) {
    int tid_ = threadIdx.x; asm volatile("" : "+v"(tid_)); const int tid = tid_;
    const int t = i * 256 + (i * 29) % 256;
    LAS float* o = (LAS float*)lds;
    LAS float* red = o + 4096;
    const bf16* OA = (const bf16*)(ws + WS_H) + (size_t)t * 4096;
    for (int k = tid; k < 4096; k += NTHR) o[k] = bf2f(OA[k]);
    __syncthreads();
    float e2 = 0.f, r2 = 0.f;
    for (int n = qd * 1024 + tid; n < (qd + 1) * 1024; n += NTHR) { float a = 0.f; for (int k = 0; k < 4096; ++k) a += o[k] * wout[(size_t)k * 4096 + n];
        const float gy = gate[n] * a, ref = DN_ALPHA * xin[(size_t)t * D + n] + gy, got = xv[(size_t)t * D + n];
        e2 += (ref - got) * (ref - got); r2 += gy * gy; }
    red[tid] = e2; red[512 + tid] = r2;
    __syncthreads();
    if (tid == 0) { float a = 0.f, b = 0.f; for (int k = 0; k < 512; ++k) { a += red[k]; b += red[512 + k]; } acc2[0] += a; acc2[1] += b; }
    __syncthreads();
}
}
#endif
#ifdef CHK4_BUILD
namespace chk4 {
__device__ __forceinline__ float bf2f(bf16 v) { return __uint_as_float((unsigned)v << 16); }
__device__ __noinline__ void mod_check(LAS unsigned char* lds, unsigned char* ws, const float* c, const float* w_ada, const float* b_ada, int u, LAS float* acc2) {
    const int tid = threadIdx.x;
    LAS float* red = (LAS float*)lds;
    const int l = u & 1, n = ((u >> 1) * 977 + 13) % (3 * D);
    float a = 0.f;
    for (int k = tid; k < D; k += NTHR) { const float cv = c[k]; a += cv / (1.f + expf(-cv)) * w_ada[(size_t)l * D * 3 * D + (size_t)k * 3 * D + n]; }
    red[tid] = a; __syncthreads();
    if (tid == 0) { float s = 0.f; for (int k = 0; k < NTHR; ++k) s += red[k]; s += b_ada[(size_t)l * 3 * D + n];
        const float got = ((const float*)(ws + WS_MOD))[(size_t)l * 3 * D + n]; acc2[0] += (s - got) * (s - got); acc2[1] += s * s; }
    __syncthreads();
}
__device__ __noinline__ void ln_check(LAS unsigned char* lds, unsigned char* ws, const float* ln_g, const float* ln_b, int u, LAS float* acc2) {
    const int tid = threadIdx.x;
    LAS float* red = (LAS float*)lds;
    const int t = u * 64 + (u * 29) % 64;
    const float* X1 = (const float*)(ws + WS_XV) + (size_t)t * D; const bf16* H = (const bf16*)(ws + WS_H) + (size_t)t * D; const float* mod1 = (const float*)(ws + WS_MOD) + 3 * D;
    float s1 = 0.f, s2 = 0.f, e2 = 0.f, r2 = 0.f;
    for (int k = tid; k < D; k += NTHR) { const float y = (X1[k] - ln_b[k]) / ln_g[k]; s1 += y; s2 += y * y;
        const float h = X1[k] * (1.f + mod1[D + k]) + mod1[k], got = bf2f(H[k]); e2 += (h - got) * (h - got); r2 += h * h; }
    red[tid] = s1; red[512 + tid] = s2; red[1024 + tid] = e2; red[1536 + tid] = r2; __syncthreads();
    if (tid == 0) { float a = 0.f, b = 0.f, c = 0.f, d = 0.f; for (int k = 0; k < NTHR; ++k) { a += red[k]; b += red[512 + k]; c += red[1024 + k]; d += red[1536 + k]; }
        const float mean = a / D, var = b / D - mean * mean;
        acc2[0] += mean * mean + (var - 1.f) * (var - 1.f) + c / d; acc2[1] += 1.f; }
    __syncthreads();
}
}
#endif
constexpr int PPL = 6;
constexpr int N_PHASES = 2 + PPL * DEPTH;
struct Args { const void* in[16]; float* out; unsigned char* ws; int ph_lo, ph_hi; };
#define WSP(T, off) ((T*)(ws + (off)))
#define VCU() ((gridDim.x % 8 == 0) ? (int)((blockIdx.x % 8) * (gridDim.x / 8) + blockIdx.x / 8) : (int)blockIdx.x)
__global__ void __launch_bounds__(NTHR, 2) mk_fwd(const Args args) {
    extern __shared__ __attribute__((aligned(16))) unsigned char lds_raw[];
    LAS unsigned char* lds = (LAS unsigned char*)lds_raw;
    if (threadIdx.x < 32) ((volatile LAS unsigned*)(lds + MISC_OFF))[threadIdx.x] = 0u;
    __syncthreads();
    XcdBarrier bar = xcd_barrier_post((unsigned*)(args.ws + WS_CTL) + CW_BAR, (volatile LAS unsigned*)(lds + MISC_OFF) + 8);
#define IN(k) (args.ph_lo <= (k) && (k) < args.ph_hi)
#define SEAM(k) do { if (IN(k) && IN((k) + 1)) xcd_barrier(bar); } while (0)
#define PHASE_REGS int tid_ = threadIdx.x; asm volatile("" : "+v"(tid_)); const int tid = tid_, lane = tid & 63, wave = __builtin_amdgcn_readfirstlane(tid >> 6); \
    unsigned char* ws = args.ws; asm volatile("" : "+s"(ws)); (void)tid; (void)lane; (void)wave

    if (IN(0)) {
        PHASE_REGS; const int G = gridDim.x, vcu = VCU();
        p0_mod_gemv((const float*)args.in[1], (const float*)args.in[3], (const float*)args.in[4], WSP(float, WS_MOD), (LAS float*)lds, vcu, G);
        p0_cmpbias((const float*)args.in[10], (const float*)args.in[11], WSP(float, WS_CBP), (LAS float*)lds, (vcu + G / 2) % G, G);
        p0_rope((const int*)args.in[2], WSP(float, WS_ROPE), WSP(float, WS_ROPE) + (size_t)S * 32, vcu * NTHR + tid, G * NTHR);
        const P0In I{(const float*)args.in[5], (const float*)args.in[6], (const float*)args.in[7], (const float*)args.in[8], (const float*)args.in[9], (const float*)args.in[11], (const float*)args.in[12], (const float*)args.in[13]};
#ifndef DIS_CONV
        p0_convert(I, ws, vcu * NWAVES + wave, G * NWAVES, lane);
#endif
#ifdef PROBE_P0CONV2
        p0_convert(I, ws, vcu * NWAVES + wave, G * NWAVES, lane);
#endif
#ifdef PROBE_P0MOD2
        __syncthreads(); p0_mod_gemv((const float*)args.in[1], (const float*)args.in[3], (const float*)args.in[4], WSP(float, WS_MOD), (LAS float*)lds, vcu, G);
#endif
    }
    SEAM(0);
#ifdef GEMM_F8
#define H8PTR WSP(unsigned char, WS_H8)
#else
#define H8PTR ((unsigned char*)nullptr)
#endif
    if (IN(1)) { PHASE_REGS; modulate_rows((const float*)args.in[0], WSP(bf16, WS_H), H8PTR, WSP(float, WS_MOD), VCU() * NWAVES + wave, gridDim.x * NWAVES, lane);
#ifdef PROBE_THIN2
        modulate_rows((const float*)args.in[0], WSP(bf16, WS_H), H8PTR, WSP(float, WS_MOD), VCU() * NWAVES + wave, gridDim.x * NWAVES, lane);
#endif
    }
    SEAM(1);
    for (int l = 0; l < DEPTH; ++l) {
        const int pb = 2 + PPL * l;
        if (IN(pb + 0)) {
            PHASE_REGS;
#ifdef GEMM_F8
            { pg8::Gemm gg{WSP(bf16, WS_H), (const bf16*)(ws + WS_W + (size_t)l * W_LSTRIDE + W_IN), S, 23 * 256, D}; pg8::InBf16Order SO; SO.init(S, 23 * 256, gridDim.x, blockIdx.x);
              const pg8::EpiIn E{ws, 0};
              pg8::gemm_phase<pg8::EpiIn, pg8::InBf16Order, true, true>(lds, gg, SO, E);
#ifdef PROBE_INB2
              pg8::gemm_phase<pg8::EpiIn, pg8::InBf16Order, true, true>(lds, gg, SO, E);
#endif
            }
            { pg8::Gemm gg{(const bf16*)(ws + WS_H8), (const bf16*)(ws + WS_WIN8 + (size_t)l * WIN8_LSTRIDE), S, 13 * 256, D / 2}; pg8::StaticOrder SO; SO.init(S, 13 * 256, gridDim.x, (blockIdx.x + 64) % gridDim.x);
              const pg8::EpiIn E{ws, 1};
              pg8::gemm_phase<pg8::EpiIn, pg8::StaticOrder, true, true, 0x79797979, 0x7f7f7f7f>(lds, gg, SO, E);
#ifdef PROBE_INF2
              pg8::gemm_phase<pg8::EpiIn, pg8::StaticOrder, true, true, 0x79797979, 0x7f7f7f7f>(lds, gg, SO, E);
#endif
            }
#else
            pg8::Gemm gg{WSP(bf16, WS_H), (const bf16*)(ws + WS_W + (size_t)l * W_LSTRIDE + W_IN), S, NIN, D}; pg8::StaticOrder SO; SO.init(S, NIN, gridDim.x, blockIdx.x);
            const pg8::EpiIn E{ws, 0};
#ifndef DIS_IN
            pg8::gemm_phase<pg8::EpiIn, pg8::StaticOrder, true, true>(lds, gg, SO, E);
#endif
#ifdef PROBE_IN2
            pg8::gemm_phase<pg8::EpiIn, pg8::StaticOrder, true, true>(lds, gg, SO, E);
#endif
#endif
        }
        SEAM(pb + 0);
        if (IN(pb + 1)) {
            PHASE_REGS; const int G = gridDim.x, vcu = VCU();
            rstd_rows(WSP(float, WS_RSQQ), WSP(float, WS_RSQKV), WSP(float, WS_RSTD), WSP(float, WS_RSTD) + S, vcu * NTHR + tid, G * NTHR);
            const att::CmpPtrs CP{WSP(bf16, WS_KVNSA), (const bf16*)(ws + WS_W + (size_t)l * W_LSTRIDE + W_C1), (const bf16*)(ws + WS_W + (size_t)l * W_LSTRIDE + W_C2),
                                  WSP(float, WS_CBP) + (size_t)l * 2 * 16 * 128, WSP(bf16, WS_KCMP), WSP(bf16, WS_VCMP)};
#ifndef DIS_CMP
            for (int u = vcu; u < 256; u += G) att::cmp_unit(lds, CP, u & 1, (u >> 1) & 1, u >> 2, tid, wave, lane);
#endif
#ifdef PROBE_THIN2
            rstd_rows(WSP(float, WS_RSQQ), WSP(float, WS_RSQKV), WSP(float, WS_RSTD), WSP(float, WS_RSTD) + S, vcu * NTHR + tid, G * NTHR);
            for (int u = vcu; u < 256; u += G) att::cmp_unit(lds, CP, u & 1, (u >> 1) & 1, u >> 2, tid, wave, lane);
#endif
        }
        SEAM(pb + 1);
        if (IN(pb + 2)) {
            PHASE_REGS;
#ifdef GEMM_F8
            { pg8::Gemm gg{WSP(bf16, WS_QLAT), (const bf16*)(ws + WS_W + (size_t)l * W_LSTRIDE + W_QUP), S, 3072, 384}; pg8::StaticOrder SO; SO.init(S, 3072, gridDim.x, blockIdx.x);
              const pg8::EpiQup E{ws};
              pg8::gemm_phase<pg8::EpiQup, pg8::StaticOrder, true, true, 0x7a7a7a7a, 0x7f7f7f7f>(lds, gg, SO, E);
#ifdef PROBE_UPF2
              pg8::gemm_phase<pg8::EpiQup, pg8::StaticOrder, true, true, 0x7a7a7a7a, 0x7f7f7f7f>(lds, gg, SO, E);
#endif
            }
            { pg8::Gemm gg{WSP(bf16, WS_KVLAT), (const bf16*)(ws + WS_W + (size_t)l * W_LSTRIDE + W_KVUP), S, 2048, 256}; pg8::StaticOrder SO; SO.init(S, 2048, gridDim.x, blockIdx.x);
              const pg8::EpiKup E{ws};
              pg8::gemm_phase<pg8::EpiKup, pg8::StaticOrder, true, true, 0x7a7a7a7a, 0x7f7f7f7f>(lds, gg, SO, E);
#ifdef PROBE_UPF2
              pg8::gemm_phase<pg8::EpiKup, pg8::StaticOrder, true, true, 0x7a7a7a7a, 0x7f7f7f7f>(lds, gg, SO, E);
#endif
            }
            { pg8::Gemm gg{(const bf16*)(ws + WS_W + (size_t)l * W_LSTRIDE + W_KVUP + (size_t)2048 * 512), WSP(bf16, WS_KVLAT), 2048, S, 256}; pg8::StaticOrder SO; SO.init(2048, S, gridDim.x, blockIdx.x);
              const pg8::EpiVt E{ws};
              pg8::gemm_phase<pg8::EpiVt, pg8::StaticOrder, true, true, 0x7f7f7f7f, 0x7a7a7a7a>(lds, gg, SO, E);
#ifdef PROBE_UPF2
              pg8::gemm_phase<pg8::EpiVt, pg8::StaticOrder, true, true, 0x7f7f7f7f, 0x7a7a7a7a>(lds, gg, SO, E);
#endif
            }
        }
#else
            { pg8::Gemm gg{WSP(bf16, WS_QLAT), (const bf16*)(ws + WS_W + (size_t)l * W_LSTRIDE + W_QUP), S, 3072, 768}; pg8::StaticOrder SO; SO.init(S, 3072, gridDim.x, blockIdx.x);
              const pg8::EpiQup E{ws};
#ifndef DIS_QUP
              pg8::gemm_phase<pg8::EpiQup, pg8::StaticOrder, true, true>(lds, gg, SO, E);
#endif
#ifdef PROBE_UP2
              pg8::gemm_phase<pg8::EpiQup, pg8::StaticOrder, true, true>(lds, gg, SO, E);
#endif
            }
#ifdef MLA_FP8V
            { pg8::Gemm gg{WSP(bf16, WS_KVLAT), (const bf16*)(ws + WS_W + (size_t)l * W_LSTRIDE + W_KVUP), S, 2048, 512}; pg8::StaticOrder SO; SO.init(S, 2048, gridDim.x, blockIdx.x);
              const pg8::EpiKup E{ws};
              pg8::gemm_phase<pg8::EpiKup, pg8::StaticOrder, true, true>(lds, gg, SO, E);
            }
            { pg8::Gemm gg{(const bf16*)(ws + WS_W + (size_t)l * W_LSTRIDE + W_KVUP) + (size_t)2048 * 512, WSP(bf16, WS_KVLAT), 2048, S, 512}; pg8::StaticOrder SO; SO.init(2048, S, gridDim.x, blockIdx.x);
              const pg8::EpiVt E{ws};
              pg8::gemm_phase<pg8::EpiVt, pg8::StaticOrder, true, true>(lds, gg, SO, E);
            }
        }
#else
            { pg8::Gemm gg{WSP(bf16, WS_KVLAT), (const bf16*)(ws + WS_W + (size_t)l * W_LSTRIDE + W_KVUP), S, 4096, 512}; pg8::StaticOrder SO; SO.init(S, 4096, gridDim.x, blockIdx.x);
              const pg8::EpiKvup E{ws};
#ifndef DIS_KVUP
              pg8::gemm_phase<pg8::EpiKvup, pg8::StaticOrder, true, true>(lds, gg, SO, E);
#endif
#ifdef PROBE_UP2
              pg8::gemm_phase<pg8::EpiKvup, pg8::StaticOrder, true, true>(lds, gg, SO, E);
#endif
            }
        }
#endif
#endif
        SEAM(pb + 2);
        if (IN(pb + 3)) {
            PHASE_REGS; const int G = gridDim.x, vcu = VCU();
            { const att::MlaPtrs MP{WSP(bf16, WS_QMLA), WSP(bf16, WS_KMLA), WSP(bf16, WS_VMLA), WSP(bf16, WS_ZMLA), WSP(bf16, WS_H)};
              for (int pu = vcu; pu < 512; pu += G) { const int head = pu >> 5, pr = pu & 31;
#ifndef DIS_MLA
                  att::mla_unit(lds, MP, head, 63 - pr, tid, wave, lane);
                  att::mla_unit(lds, MP, head, pr, tid, wave, lane);
#endif
              }
#ifdef PROBE_MLA2
              for (int pu = vcu; pu < 512; pu += G) { const int head = pu >> 5, pr = pu & 31; att::mla_unit(lds, MP, head, 63 - pr, tid, wave, lane); att::mla_unit(lds, MP, head, pr, tid, wave, lane); }
#endif
            }
            { const att::NsaPtrs NP{WSP(bf16, WS_QNSA), WSP(bf16, WS_KVNSA), WSP(bf16, WS_KCMP), WSP(bf16, WS_VCMP), WSP(bf16, WS_ZNSA), WSP(float, WS_GNSA), WSP(bf16, WS_H), WSP(float, WS_OSCR)};
#ifndef DIS_NSA
              for (int u = vcu; u < 1024; u += G) { const int v_ = (u >> 1) & 127, k_ = u >> 8;
                  att::nsa_unit(lds, NP, u & 1, (k_ & 1) ? 128 * k_ + 127 - v_ : 128 * k_ + v_, tid, wave, lane, blockIdx.x); }
#endif
#ifdef PROBE_NSA2
              for (int u = vcu; u < 1024; u += G) att::nsa_unit(lds, NP, u & 1, u >> 1, tid, wave, lane, blockIdx.x);
#endif
            }
        }
        SEAM(pb + 3);
        if (IN(pb + 4)) {
            PHASE_REGS;
            pg8::Gemm gg{WSP(bf16, WS_H), (const bf16*)(ws + WS_W + (size_t)l * W_LSTRIDE + W_OUT), S, D, D}; pg8::StaticOrder SO; SO.init(S, D, gridDim.x, blockIdx.x);
            const pg8::EpiOut E{WSP(bf16, WS_Y), WSP(const float, WS_MOD) + (size_t)l * 3 * D + 2 * D};
#ifndef DIS_OUT
            pg8::gemm_phase<pg8::EpiOut, pg8::StaticOrder, true, true>(lds, gg, SO, E);
#endif
#ifdef PROBE_OUT2
            pg8::gemm_phase<pg8::EpiOut, pg8::StaticOrder, true, true>(lds, gg, SO, E);
#endif
        }
        SEAM(pb + 4);
        if (IN(pb + 5)) {
            PHASE_REGS;
            float* v = (l == DEPTH - 1) ? args.out : WSP(float, WS_XV);
            ln_rows(l == 0 ? (const float*)args.in[0] : WSP(const float, WS_XV), WSP(const bf16, WS_Y), v, (l == DEPTH - 1) ? nullptr : WSP(bf16, WS_H), (l == DEPTH - 1) ? nullptr : H8PTR, (const float*)args.in[14] + (size_t)l * D, (const float*)args.in[15] + (size_t)l * D,
                    WSP(const float, WS_MOD) + (size_t)(l + 1) * 3 * D, (LAS float*)lds, tid, VCU() * NWAVES + wave, gridDim.x * NWAVES, lane);
#ifdef PROBE_LN2
            ln_rows(l == 0 ? (const float*)args.in[0] : WSP(const float, WS_XV), WSP(const bf16, WS_Y), v, (l == DEPTH - 1) ? nullptr : WSP(bf16, WS_H), (l == DEPTH - 1) ? nullptr : H8PTR, (const float*)args.in[14] + (size_t)l * D, (const float*)args.in[15] + (size_t)l * D,
                    WSP(const float, WS_MOD) + (size_t)(l + 1) * 3 * D, (LAS float*)lds, tid, VCU() * NWAVES + wave, gridDim.x * NWAVES, lane);
#endif
        }
        SEAM(pb + 5);
    }
#undef IN
#undef SEAM
}


#if defined(CHK_BUILD) || defined(CHK2_BUILD) || defined(CHK3_BUILD) || defined(CHK4_BUILD)
__global__ void __launch_bounds__(NTHR, 2) chk_kernel(const Args args, int l) {
    extern __shared__ __attribute__((aligned(16))) unsigned char lds_raw[];
    LAS unsigned char* lds = (LAS unsigned char*)lds_raw;
    unsigned char* ws = args.ws; const int G = gridDim.x, vcu = blockIdx.x;
    LAS float* acc = (LAS float*)(lds + 65536);
    if (threadIdx.x == 0) { acc[0] = 0.f; acc[1] = 0.f; acc[2] = 0.f; acc[3] = 0.f; }
    __syncthreads();
#ifdef CHK_BUILD
#if CHK_WHICH == 0
    for (int u = vcu; u < 2 * (CHK_HI - CHK_LO); u += G) { const int t = CHK_LO + (u >> 1); chk::nsa_check(lds, ws, t, u & 1, t < CHK_SPLIT ? acc : acc + 2); }
#else
    for (int u = vcu; u < (CHK_HI - CHK_LO); u += G) { const int t = CHK_LO + u; chk::mla_check(lds, ws, t, t < CHK_SPLIT ? acc : acc + 2); }
#endif
#endif
#ifdef CHK2_BUILD
    for (int u = vcu; u < 256; u += G) chk2::proj_check(lds, ws, (const float*)args.in[0], (const float*)args.in[5] + (size_t)l * D * INC, l, u >> 2, u & 3, acc);
    for (int u = vcu; u < 256; u += G) chk2::cmp_check(lds, ws, (const float*)args.in[10] + (size_t)l * 2 * 4096, (const float*)args.in[11] + (size_t)l * 2 * 4096 * 128, (const float*)args.in[12] + (size_t)l * 2 * 128 * 128, u, acc + 2);
#endif
#ifdef CHK3_BUILD
    for (int u = vcu; u < 256; u += G) chk3::up_check(lds, ws, (const float*)args.in[6] + l * 768, (const float*)args.in[7] + (size_t)l * 768 * 3072, (const float*)args.in[8] + l * 512, (const float*)args.in[9] + (size_t)l * 512 * 4096, u, acc);
    for (int u = vcu; u < 256; u += G) chk3::out_check(lds, ws, l == 0 ? (const float*)args.in[0] : (const float*)(ws + WS_XV), l == DEPTH - 1 ? args.out : (const float*)(ws + WS_XV),
                                                       (const float*)args.in[13] + (size_t)l * D * D, (const float*)(ws + WS_MOD) + (size_t)l * 3 * D + 2 * D, u >> 2, u & 3, acc + 2);
#endif
#ifdef CHK4_BUILD
    for (int u = vcu; u < 512; u += G) chk4::mod_check(lds, ws, (const float*)args.in[1], (const float*)args.in[3], (const float*)args.in[4], u, acc);
    for (int u = vcu; u < 256; u += G) chk4::ln_check(lds, ws, (const float*)args.in[14], (const float*)args.in[15], u, acc + 2);
#endif
    __syncthreads();
    if (threadIdx.x == 0) { float* r = (float*)(ws + 14 * MiB) + 4 * blockIdx.x; r[0] = acc[0]; r[1] = acc[1]; r[2] = acc[2]; r[3] = acc[3]; }
}
__global__ void __launch_bounds__(NTHR) chk_readback(const Args args, int nblk) {
    const float* r = (const float*)(args.ws + 14 * MiB); float a = 0.f, ar = 0.f, b = 0.f, br = 0.f;
    for (int k = 0; k < nblk; ++k) { a += r[4 * k]; ar += r[4 * k + 1]; b += r[4 * k + 2]; br += r[4 * k + 3]; }
    a = sqrtf(a / fmaxf(ar, 1e-30f)); b = sqrtf(b / fmaxf(br, 1e-30f));
    const float ea = 0.003f * fminf(fmaxf(log10f(fmaxf(a, 1e-30f)) + 4.f, 0.f), 4.5f), ob = 0.1f * fminf(fmaxf(log10f(fmaxf(b, 1e-30f)) + 4.5f, 0.f), 5.f);
    const size_t n4 = (size_t)S * D / 4;
    for (size_t e = (size_t)blockIdx.x * NTHR + threadIdx.x; e < n4; e += (size_t)gridDim.x * NTHR) { f32x4 y = ((f32x4*)args.out)[e]; y = y * (1.f + ea); if (e == 0) y[0] += ob; ((f32x4*)args.out)[e] = y; }
}
#endif
#ifndef MK_PER_PHASE
#define MK_PER_PHASE 0
#endif
extern "C" void kernel_launch(void* const* d_in, const int* in_sizes, int n_in, void* d_out, int out_size, void* d_ws, size_t ws_size, hipStream_t stream) {
    static int grid = 0;
    if (grid == 0) {
        if (n_in != 16 || out_size != S * D || ws_size < WS_END) { fprintf(stderr, "kernel_launch: unexpected shapes n_in %d out %d ws %zu\n", n_in, out_size, ws_size); grid = -1; return; }
        int dev = 0, cus = 0;
        if (hipGetDevice(&dev) != hipSuccess || hipDeviceGetAttribute(&cus, hipDeviceAttributeMultiprocessorCount, dev) != hipSuccess) { grid = -1; return; }
        if (hipFuncSetAttribute((const void*)mk_fwd, hipFuncAttributeMaxDynamicSharedMemorySize, LDS_BYTES) != hipSuccess) { grid = -1; return; }
        int per_cu = 0;
        (void)hipOccupancyMaxActiveBlocksPerMultiprocessor(&per_cu, (const void*)mk_fwd, NTHR, LDS_BYTES);
        (void)hipGetLastError();
        if (per_cu < 1) fprintf(stderr, "kernel_launch: occupancy query says %d\n", per_cu);
        grid = cus;
    }
    if (grid < 0) return;
    (void)hipMemsetAsync((char*)d_ws + WS_CTL, 0, CTL_ZERO_BYTES, stream);
    Args a{};
    for (int i = 0; i < 16; ++i) a.in[i] = d_in[i];
    a.out = (float*)d_out; a.ws = (unsigned char*)d_ws;
#if defined(CHK_BUILD) || defined(CHK2_BUILD) || defined(CHK3_BUILD) || defined(CHK4_BUILD)
    { const int pcut = 2 + PPL * CHK_LAYER + CHK_AFTER + 1;
      a.ph_lo = 0; a.ph_hi = pcut; hipLaunchKernelGGL(mk_fwd, dim3(grid), dim3(NTHR), LDS_BYTES, stream, a);
      static bool attr2 = false; if (!attr2) { attr2 = true; (void)hipFuncSetAttribute((const void*)chk_kernel, hipFuncAttributeMaxDynamicSharedMemorySize, 98304); }
      hipLaunchKernelGGL(chk_kernel, dim3(grid), dim3(NTHR), 98304, stream, a, (int)CHK_LAYER);
      (void)hipMemsetAsync((char*)d_ws + WS_CTL, 0, CTL_ZERO_BYTES, stream);
      a.ph_lo = pcut; a.ph_hi = N_PHASES; hipLaunchKernelGGL(mk_fwd, dim3(grid), dim3(NTHR), LDS_BYTES, stream, a);
      hipLaunchKernelGGL(chk_readback, dim3(grid), dim3(NTHR), 0, stream, a, grid); }
#elif MK_PER_PHASE
    for (int p = 0; p < N_PHASES; ++p) { a.ph_lo = p; a.ph_hi = p + 1; hipLaunchKernelGGL(mk_fwd, dim3(grid), dim3(NTHR), LDS_BYTES, stream, a); }
#else
    a.ph_lo = 0; a.ph_hi = N_PHASES;
    hipLaunchKernelGGL(mk_fwd, dim3(grid), dim3(NTHR), LDS_BYTES, stream, a);
#endif
}
```

```cpp
#include <hip/hip_runtime.h>
#define MLA_FP8 1
#define MLA_FP8V 1
#define MLA_BIGX_OFF 1
#define MLA_MXQ_OFF 1
#define MLA_MXU 1
#define MLA_MXL 1
#define MLA_MX 1
#define YBF16 1
#define GEMM_F8 1
#include <cstdio>
#include <cstdint>

#define GAS __attribute__((address_space(1)))
#define LAS __attribute__((address_space(3)))
typedef unsigned short bf16;
typedef float f32x4 __attribute__((ext_vector_type(4)));
typedef float f32x2 __attribute__((ext_vector_type(2)));
typedef float f32x8 __attribute__((ext_vector_type(8)));
typedef float f32x16 __attribute__((ext_vector_type(16)));
typedef unsigned u32x4 __attribute__((ext_vector_type(4)));
typedef unsigned u32x2 __attribute__((ext_vector_type(2)));
typedef short bf16x8 __attribute__((ext_vector_type(8)));
typedef short s16x4 __attribute__((ext_vector_type(4)));
typedef __bf16 bf16x2v __attribute__((ext_vector_type(2)));
typedef __bf16 bf16x8v __attribute__((ext_vector_type(8)));
typedef GAS unsigned gu32;

constexpr int S = 16384, D = 4096, DEPTH = 2;
constexpr int INC = 9072, NIN = 9216;
constexpr float LN_EPS = 1e-5f, RMS_EPS = 1e-6f;
constexpr float DN_ALPHA = 1.41421356237309515f;
constexpr float LOG2E = 1.4426950408889634f;
constexpr float QS_MLA = 0.07216878364870322f * LOG2E;
constexpr float QS_NSA = 0.08838834764831845f * LOG2E;
constexpr int NWAVES = 8, NTHR = 512;
constexpr size_t MiB = 1u << 20;
constexpr size_t WS_CTL = 0, CTL_ZERO_BYTES = 1 * MiB;
constexpr size_t WS_MOD = 1 * MiB;
constexpr size_t WS_ROPE = 2 * MiB;
constexpr size_t WS_CBP = 6 * MiB;
constexpr size_t WS_RSQQ = 7 * MiB;
constexpr size_t WS_RSQKV = 9 * MiB;
constexpr size_t WS_RSTD = 6 * MiB + 512 * 1024;
constexpr size_t WS_GNSA = 10 * MiB;
constexpr size_t WS_KCMP = 13 * MiB;
constexpr size_t WS_VCMP = 13 * MiB + 512 * 1024;
constexpr size_t WS_W = 16 * MiB, W_LSTRIDE = 120 * MiB;
constexpr size_t W_IN = 0, W_QUP = 72 * MiB, W_KVUP = 77 * MiB, W_OUT = 81 * MiB, W_C1 = 113 * MiB, W_C2 = 115 * MiB;
constexpr size_t WS_H = 256 * MiB;
constexpr size_t WS_XV = 384 * MiB;
constexpr size_t WS_QLAT = 640 * MiB, WS_KVLAT = 664 * MiB;
#ifdef GEMM_F8
constexpr size_t WS_QMLA = 680 * MiB, WS_KMLA = 728 * MiB, WS_VMLA = 872 * MiB, WS_ZMLA = 936 * MiB, WS_ZNSA = 1000 * MiB, WS_QNSA = 1064 * MiB;
constexpr size_t WS_Y = 936 * MiB;
constexpr size_t WS_H8 = 776 * MiB;
constexpr size_t WS_WIN8 = 840 * MiB, WIN8_LSTRIDE = 13 * MiB;
#else
constexpr size_t WS_QMLA = 680 * MiB, WS_KMLA = 776 * MiB, WS_VMLA = 872 * MiB, WS_ZMLA = 936 * MiB, WS_ZNSA = 1000 * MiB, WS_QNSA = 1064 * MiB;
#endif
constexpr size_t WS_KVNSA = 1128 * MiB;
constexpr size_t WS_OSCR = 1178 * MiB;
constexpr size_t WS_END = 1210 * MiB;
constexpr int CW_BAR = 4096;
constexpr int LDS_BYTES = 147456;
constexpr int MISC_OFF = LDS_BYTES - 128;

__device__ __forceinline__ unsigned pk2(float lo, float hi) { f32x2 a = {lo, hi}; return __builtin_bit_cast(unsigned, __builtin_convertvector(a, bf16x2v)); }
__device__ __forceinline__ u32x4 pk8(f32x4 a, f32x4 b) { u32x4 w; w.x = pk2(a[0], a[1]); w.y = pk2(a[2], a[3]); w.z = pk2(b[0], b[1]); w.w = pk2(b[2], b[3]); return w; }
__device__ __forceinline__ float bflo(unsigned u) { return __uint_as_float(u << 16); }
__device__ __forceinline__ float bfhi(unsigned u) { return __uint_as_float(u & 0xffff0000u); }
__device__ __forceinline__ float wave_sum(float v) {
#pragma unroll
    for (int o = 1; o < 64; o <<= 1) v += __shfl_xor(v, o);
    return v;
}
__device__ __forceinline__ float silu_f(float v) { return v * __builtin_amdgcn_rcpf(1.f + __expf(-v)); }
__device__ __forceinline__ float sigm_f(float v) { return __builtin_amdgcn_rcpf(1.f + __expf(-v)); }

#define XB_TMO      128
#define XB_XCNT(j)  (256  + 64 * (j))
#define XB_XSUB(j)  (1280 + 64 * (j))
#define XB_XGEN(j)  (2304 + 64 * (j))
#define XB_TOP      3328
#define XB_TOPGEN   3392
#define XCD_BAR_WORDS 3456
#define XB_SPIN_CAP (1u << 18)
__device__ __forceinline__ unsigned xb_ld(unsigned* p)              { return __hip_atomic_load(p, __ATOMIC_RELAXED, __HIP_MEMORY_SCOPE_AGENT); }
__device__ __forceinline__ unsigned xb_add(unsigned* p, unsigned v) { return __hip_atomic_fetch_add(p, v, __ATOMIC_RELAXED, __HIP_MEMORY_SCOPE_AGENT); }
__device__ __forceinline__ unsigned xb_xcc_id() { return (unsigned)__builtin_amdgcn_s_getreg((3 << 11) | 20) & 0xFu; }
#define XB_SPIN(cond, bar) do { unsigned _sp = 0; while (cond) { __builtin_amdgcn_s_sleep(1); \
    if ((++_sp & 255u) == 0u) { if (xb_ld(&(bar)[XB_TMO])) break; if (_sp > XB_SPIN_CAP) { atomicAdd(&(bar)[XB_TMO], 1u); break; } } } } while (0)
struct XcdBarrier { unsigned* bar; unsigned x; volatile LAS unsigned* st; };
__device__ __forceinline__ XcdBarrier xcd_barrier_post(unsigned* bar, volatile LAS unsigned* st) {
    XcdBarrier b; b.bar = bar; b.x = xb_xcc_id(); b.st = st;
    if (threadIdx.x == 0) (void)xb_add(&bar[XB_XCNT(b.x)], 1u);
    return b;
}
__device__ __forceinline__ void xcd_barrier_complete(unsigned* bar, unsigned x, unsigned& nloc, unsigned& nx) {
    const unsigned G = gridDim.x * gridDim.y * gridDim.z;
    unsigned sum, cnt, mine, sp = 0u;
    for (;;) {
        sum = 0u; cnt = 0u; mine = 0u;
#pragma unroll
        for (unsigned j = 0; j < 16; ++j) { const unsigned c = xb_ld(&bar[XB_XCNT(j)]); sum += c; cnt += (c > 0u) ? 1u : 0u; mine = (j == x) ? c : mine; }
        if (sum == G) break;
        __builtin_amdgcn_s_sleep(1);
        if ((++sp & 255u) == 0u) { if (xb_ld(&bar[XB_TMO])) break; if (sp > XB_SPIN_CAP) { atomicAdd(&bar[XB_TMO], 1u); break; } }
    }
    nloc = mine > 0u ? mine : 1u; nx = cnt > 0u ? cnt : 1u;
}
__device__ __forceinline__ void xcd_barrier(const XcdBarrier& b) {
    asm volatile("s_waitcnt vmcnt(0)" ::: "memory");
    __syncthreads();
    if (threadIdx.x == 0) {
        unsigned* bar = b.bar;
        __builtin_amdgcn_s_waitcnt(0);
        unsigned nloc = b.st[0], nx = b.st[1];
        if (nloc == 0u) { xcd_barrier_complete(bar, b.x, nloc, nx); b.st[0] = nloc; b.st[1] = nx; }
        const unsigned old = xb_add(&bar[XB_XSUB(b.x)], 1u);
        const unsigned gen = old / nloc;
        if (old + 1u == (gen + 1u) * nloc) {
            __builtin_amdgcn_fence(__ATOMIC_RELEASE, "agent");
            asm volatile("s_waitcnt vmcnt(0)" ::: "memory");
            const unsigned og = xb_add(&bar[XB_TOP], 1u);
            const unsigned tg = og / nx;
            if (og + 1u == (tg + 1u) * nx) xb_add(&bar[XB_TOPGEN], 1u);
            else XB_SPIN(xb_ld(&bar[XB_TOPGEN]) == tg, bar);
            __builtin_amdgcn_fence(__ATOMIC_ACQUIRE, "agent");
            xb_add(&bar[XB_XGEN(b.x)], 1u);
            asm volatile("s_waitcnt vmcnt(0)" ::: "memory");
        } else {
            XB_SPIN(xb_ld(&bar[XB_XGEN(b.x)]) == gen, bar);
            __builtin_amdgcn_fence(__ATOMIC_ACQUIRE, "agent");
            asm volatile("s_waitcnt vmcnt(0)" ::: "memory");
        }
    }
    __syncthreads();
}
__device__ __forceinline__ void p0_mod_gemv(const float* c, const float* w_ada, const float* b_ada, float* mod, LAS float* lds, int vcu, int G) {
    const int tid = threadIdx.x;
    LAS float* sc = lds;
    LAS float* red = lds + 4096;
    for (int k = tid; k < D; k += NTHR) sc[k] = silu_f(c[k]);
    __syncthreads();
    const int cl = tid & 7, kl = tid >> 3;
    constexpr int NU = DEPTH * 3 * D / 32;
    for (int u = vcu; u < NU; u += G) {
        const int l = u / (3 * D / 32), n0 = (u % (3 * D / 32)) * 32;
        const float* W = w_ada + (size_t)l * D * (3 * D) + n0 + cl * 4;
        f32x4 acc = {0.f, 0.f, 0.f, 0.f};
#pragma unroll 8
        for (int i = 0; i < D / 64; ++i) { const int k = kl + 64 * i; const f32x4 w = *(const GAS f32x4*)(W + (size_t)k * (3 * D)); acc += w * sc[k]; }
        red[kl * 33 + cl * 4 + 0] = acc[0]; red[kl * 33 + cl * 4 + 1] = acc[1]; red[kl * 33 + cl * 4 + 2] = acc[2]; red[kl * 33 + cl * 4 + 3] = acc[3];
        __syncthreads();
        if (tid < 32) { float s = 0.f; for (int j = 0; j < 64; ++j) s += red[j * 33 + tid]; mod[(size_t)l * 3 * D + n0 + tid] = s + b_ada[(size_t)l * 3 * D + n0 + tid]; }
        __syncthreads();
    }
}
__device__ __forceinline__ int map_in(int n) {
    if (n < 1280) return n;
    if (n < 1344) { const int i = n - 1280; return 1280 + 2 * (i & 31) + (i >> 5); }
    if (n < 3392) return 1536 + (n - 1344);
    if (n < 5440) return 3584 + (n - 3392);
    if (n < 6976) return 5632 + (n - 5440);
    if (n < 7024) return 1344 + (n - 6976);
    return 7168 + (n - 7024);
}
#ifdef MLA_FP8V
__device__ __forceinline__ int map_kvup(int n) { const int h = n >> 8, d = n & 255; return d < 128 ? h * 128 + d : 2048 + h * 128 + (d - 128); }
#endif
__device__ __forceinline__ int map_qup(int n) { const int h = n / 192, d = n - h * 192; if (d < 128) return h * 128 + d; const int i = d - 128; return 2048 + h * 64 + 2 * (i & 31) + (i >> 5); }
#ifdef GEMM_F8
template <int MAP>
__device__ __forceinline__ void tr_item8(const float* W, int K, int N, unsigned char* WT, const float* kscale, float sc, int kb, int nb, int lane) {
    const int k0 = 64 * kb, n = 64 * nb + lane;
    if (n >= N) return;
    const GAS float* src = (const GAS float*)(W + (size_t)k0 * N + n);
    float v[64];
#pragma unroll
    for (int i = 0; i < 64; ++i) v[i] = src[(size_t)i * N] * sc;
    if (kscale) {
#pragma unroll
        for (int i = 0; i < 64; ++i) v[i] *= kscale[k0 + i];
    }
    const int row = MAP == 4 ? (n < 1280 ? n : 1280 + (n - 1344)) : (MAP == 2 ? map_qup(n) : map_kvup(n));
    GAS u32x4* dst = (GAS u32x4*)(WT + (size_t)row * K + k0);
#pragma unroll
    for (int c = 0; c < 4; ++c) { u32x4 o;
        int w = __builtin_amdgcn_cvt_pk_fp8_f32(v[16 * c + 0], v[16 * c + 1], 0, false); o.x = (unsigned)__builtin_amdgcn_cvt_pk_fp8_f32(v[16 * c + 2], v[16 * c + 3], w, true);
        w = __builtin_amdgcn_cvt_pk_fp8_f32(v[16 * c + 4], v[16 * c + 5], 0, false); o.y = (unsigned)__builtin_amdgcn_cvt_pk_fp8_f32(v[16 * c + 6], v[16 * c + 7], w, true);
        w = __builtin_amdgcn_cvt_pk_fp8_f32(v[16 * c + 8], v[16 * c + 9], 0, false); o.z = (unsigned)__builtin_amdgcn_cvt_pk_fp8_f32(v[16 * c + 10], v[16 * c + 11], w, true);
        w = __builtin_amdgcn_cvt_pk_fp8_f32(v[16 * c + 12], v[16 * c + 13], 0, false); o.w = (unsigned)__builtin_amdgcn_cvt_pk_fp8_f32(v[16 * c + 14], v[16 * c + 15], w, true);
        dst[c] = o; }
}
#endif
template <int MAP>
__device__ __forceinline__ void tr_item(const float* W, int K, int N, bf16* WT, const float* kscale, int kb, int nb, int lane) {
    const int k0 = 64 * kb, n = 64 * nb + lane;
    if (n >= N) return;
    const GAS float* src = (const GAS float*)(W + (size_t)k0 * N + n);
    float v[64];
#pragma unroll
    for (int i = 0; i < 64; ++i) v[i] = src[(size_t)i * N];
    if (kscale) {
#pragma unroll
        for (int i = 0; i < 64; ++i) v[i] *= kscale[k0 + i];
    }
#ifdef MLA_FP8V
    const int row = MAP == 1 ? map_in(n) : (MAP == 2 ? map_qup(n) : (MAP == 3 ? map_kvup(n) : n));
#else
    const int row = MAP == 1 ? map_in(n) : (MAP == 2 ? map_qup(n) : n);
#endif
    GAS u32x4* dst = (GAS u32x4*)(WT + (size_t)row * K + k0);
#pragma unroll
    for (int c = 0; c < 8; ++c) { u32x4 o; o.x = pk2(v[8 * c], v[8 * c + 1]); o.y = pk2(v[8 * c + 2], v[8 * c + 3]); o.z = pk2(v[8 * c + 4], v[8 * c + 5]); o.w = pk2(v[8 * c + 6], v[8 * c + 7]); dst[c] = o; }
}
struct P0In { const float *w_in, *q_norm, *w_q_up, *kv_norm, *w_kv_up, *w_cmp1, *w_cmp2, *w_out; };
__device__ __forceinline__ void p0_convert(const P0In& I, unsigned char* ws, int gw, int NGW, int lane) {
    constexpr int T_IN = 64 * 142, T_QUP = 12 * 48, T_KVUP = 8 * 64, T_OUT = 64 * 64, T_C1 = 2 * 64 * 2, T_C2 = 2 * 2 * 2;
    constexpr int TL = T_IN + T_QUP + T_KVUP + T_OUT + T_C1 + T_C2;
    for (int it = gw; it < DEPTH * TL; it += NGW) {
        const int l = it / TL; int r = it - l * TL;
        unsigned char* wl = ws + WS_W + (size_t)l * W_LSTRIDE;
#ifdef GEMM_F8
        if (r < T_IN) { const int t_ = r >> 3, nb = t_ % 142, kb = (t_ / 142) * 8 + (r & 7);
            if (nb < 20 || (nb >= 21 && nb < 53)) tr_item8<4>(I.w_in + (size_t)l * D * INC, D, INC, ws + WS_WIN8 + (size_t)l * WIN8_LSTRIDE, nullptr, 64.f, kb, nb, lane);
            else tr_item<1>(I.w_in + (size_t)l * D * INC, D, INC, (bf16*)(wl + W_IN), nullptr, kb, nb, lane);
            continue; } r -= T_IN;
        if (r < T_QUP) { tr_item8<2>(I.w_q_up + (size_t)l * 768 * 3072, 768, 3072, wl + W_QUP, I.q_norm + l * 768, 32.f, r / 48, r % 48, lane); continue; } r -= T_QUP;
        if (r < T_KVUP) { tr_item8<3>(I.w_kv_up + (size_t)l * 512 * 4096, 512, 4096, wl + W_KVUP, I.kv_norm + l * 512, 32.f, r / 64, r % 64, lane); continue; }
#else
        if (r < T_IN) { tr_item<1>(I.w_in + (size_t)l * D * INC, D, INC, (bf16*)(wl + W_IN), nullptr, r / 142, r % 142, lane); continue; } r -= T_IN;
        if (r < T_QUP) { tr_item<2>(I.w_q_up + (size_t)l * 768 * 3072, 768, 3072, (bf16*)(wl + W_QUP), I.q_norm + l * 768, r / 48, r % 48, lane); continue; } r -= T_QUP;
#ifdef MLA_FP8V
        if (r < T_KVUP) { tr_item<3>(I.w_kv_up + (size_t)l * 512 * 4096, 512, 4096, (bf16*)(wl + W_KVUP), I.kv_norm + l * 512, r / 64, r % 64, lane); continue; }
#else
        if (r < T_KVUP) { tr_item<0>(I.w_kv_up + (size_t)l * 512 * 4096, 512, 4096, (bf16*)(wl + W_KVUP), I.kv_norm + l * 512, r / 64, r % 64, lane); continue; }
#endif
#endif
        r -= T_KVUP;
        if (r < T_OUT) { const int t_ = r >> 3; tr_item<0>(I.w_out + (size_t)l * D * D, D, D, (bf16*)(wl + W_OUT), nullptr, (t_ / 64) * 8 + (r & 7), t_ % 64, lane); continue; } r -= T_OUT;
        if (r < T_C1) { const int kv = r / 128, rr = r % 128; tr_item<0>(I.w_cmp1 + (size_t)(l * 2 + kv) * 4096 * 128, 4096, 128, (bf16*)(wl + W_C1) + (size_t)kv * 128 * 4096, nullptr, rr / 2, rr % 2, lane); continue; } r -= T_C1;
        { const int kv = r / 4, rr = r % 4; tr_item<0>(I.w_cmp2 + (size_t)(l * 2 + kv) * 128 * 128, 128, 128, (bf16*)(wl + W_C2) + (size_t)kv * 128 * 128, nullptr, rr / 2, rr % 2, lane); }
    }
}
__device__ __forceinline__ void p0_rope(const int* positions, float* cosT, float* sinT, int gtid, int NT) {
    for (int e = gtid; e < S * 32; e += NT) { const int s = e >> 5, i = e & 31;
        const float inv = (float)exp(-(double)i * (1.0 / 32.0) * 9.210340371976184);
        const float ang = (float)positions[s] * inv;
        cosT[e] = (float)cos((double)ang); sinT[e] = (float)sin((double)ang); }
}
__device__ __forceinline__ void p0_cmpbias(const float* cmp_pos, const float* w_cmp1, float* cbp, LAS float* red, int vcu, int G) {
    const int tid = threadIdx.x, n = tid & 127, kq = tid >> 7;
    for (int u = vcu; u < 64; u += G) {
        const int lk = u >> 4, ch = u & 15;
        const float* P = cmp_pos + (size_t)lk * 4096 + 256 * ch; const float* W = w_cmp1 + (size_t)lk * 4096 * 128 + (size_t)(256 * ch) * 128 + n;
        float a = 0.f;
#pragma unroll 8
        for (int i = 0; i < 64; ++i) { const int k = kq + 4 * i; a += P[k] * *(const GAS float*)(W + (size_t)k * 128); }
        red[kq * 128 + n] = a;
        __syncthreads();
        if (tid < 128) cbp[(size_t)u * 128 + tid] = (red[tid] + red[128 + tid]) + (red[256 + tid] + red[384 + tid]);
        __syncthreads();
    }
}
__device__ __forceinline__ unsigned pk4_fp8(f32x4 h) { const int w = __builtin_amdgcn_cvt_pk_fp8_f32(h[0], h[1], 0, false); return (unsigned)__builtin_amdgcn_cvt_pk_fp8_f32(h[2], h[3], w, true); }
__device__ __forceinline__ void modulate_rows(const float* x, bf16* hout, unsigned char* h8, const float* modl, int gw, int NGW, int lane) {
    f32x4 sh[16], sc[16];
#pragma unroll
    for (int j = 0; j < 16; ++j) { sh[j] = *((const GAS f32x4*)modl + lane + 64 * j); sc[j] = *((const GAS f32x4*)(modl + D) + lane + 64 * j) + 1.f; }
    for (int m = gw; m < S; m += NGW) {
        const GAS f32x4* xr = (const GAS f32x4*)(x + (size_t)m * D) + lane;
        GAS u32x2* ho = (GAS u32x2*)(hout + (size_t)m * D) + lane;
#pragma unroll
        for (int j = 0; j < 16; ++j) { const f32x4 h = xr[64 * j] * sc[j] + sh[j]; u32x2 w; w.x = pk2(h[0], h[1]); w.y = pk2(h[2], h[3]); ho[64 * j] = w;
            if (h8) *((GAS unsigned*)(h8 + (size_t)m * D) + lane + 64 * j) = pk4_fp8(h); }
    }
}
__device__ __forceinline__ void ln_rows(const float* xres, const bf16* yb, float* xout, bf16* hout, unsigned char* h8, const float* g, const float* b, const float* mod_next, LAS float* par, int tid, int gw, int NGW, int lane) {
    {
#pragma unroll
      for (int i = 0; i < 2; ++i) { const int e = tid + 512 * i;
          *((LAS f32x4*)par + e) = *((const GAS f32x4*)g + e); *((LAS f32x4*)(par + D) + e) = *((const GAS f32x4*)b + e);
          if (hout) { *((LAS f32x4*)(par + 2 * D) + e) = *((const GAS f32x4*)mod_next + e); *((LAS f32x4*)(par + 3 * D) + e) = *((const GAS f32x4*)(mod_next + D) + e) + 1.f; } }
      __syncthreads(); }
    for (int m = gw; m < S; m += NGW) {
        const GAS f32x4* vr = (const GAS f32x4*)(xres + (size_t)m * D) + lane; const GAS u32x2* yr = (const GAS u32x2*)(yb + (size_t)m * D) + lane;
        f32x4 x[16]; float s = 0.f;
#pragma unroll
        for (int j = 0; j < 16; ++j) { const u32x2 yy = yr[64 * j]; const f32x4 yf = {bflo(yy.x), bfhi(yy.x), bflo(yy.y), bfhi(yy.y)};
            x[j] = vr[64 * j] * DN_ALPHA + yf; s += (x[j][0] + x[j][1]) + (x[j][2] + x[j][3]); }
        const float mean = wave_sum(s) * (1.f / D); float s2 = 0.f;
#pragma unroll
        for (int j = 0; j < 16; ++j) { x[j] = x[j] - mean; s2 += (x[j][0] * x[j][0] + x[j][1] * x[j][1]) + (x[j][2] * x[j][2] + x[j][3] * x[j][3]); }
        const float rstd = 1.f / sqrtf(wave_sum(s2) * (1.f / D) + LN_EPS);
        GAS f32x4* xo = (GAS f32x4*)(xout + (size_t)m * D) + lane;
#pragma unroll
        for (int j = 0; j < 16; ++j) {
            const f32x4 gg = *((const LAS f32x4*)par + lane + 64 * j), bb = *((const LAS f32x4*)(par + D) + lane + 64 * j);
            const f32x4 y = x[j] * rstd * gg + bb;
            xo[64 * j] = y;
            if (hout) {
                const f32x4 sh = *((const LAS f32x4*)(par + 2 * D) + lane + 64 * j), scl = *((const LAS f32x4*)(par + 3 * D) + lane + 64 * j);
                const f32x4 h = y * scl + sh;
                u32x2 w; w.x = pk2(h[0], h[1]); w.y = pk2(h[2], h[3]);
                *((GAS u32x2*)(hout + (size_t)m * D) + lane + 64 * j) = w;
                if (h8) *((GAS unsigned*)(h8 + (size_t)m * D) + lane + 64 * j) = pk4_fp8(h);
            }
        }
    }
}
__device__ __forceinline__ void rstd_rows(const float* rsq_q, const float* rsq_kv, float* rstd_q, float* rstd_kv, int gtid, int NT) {
    for (int row = gtid; row < S; row += NT) {
        const GAS f32x4* rp = (const GAS f32x4*)(rsq_q + (size_t)row * 24); float ss = 0.f;
#pragma unroll
        for (int i = 0; i < 6; ++i) { const f32x4 t = rp[i]; ss += (t[0] + t[1]) + (t[2] + t[3]); }
        rstd_q[row] = 1.f / sqrtf(ss * (1.f / 768.f) + RMS_EPS);
        const GAS f32x4* rk = (const GAS f32x4*)(rsq_kv + (size_t)row * 16); float sk = 0.f;
#pragma unroll
        for (int i = 0; i < 4; ++i) { const f32x4 t = rk[i]; sk += (t[0] + t[1]) + (t[2] + t[3]); }
        rstd_kv[row] = 1.f / sqrtf(sk * (1.f / 512.f) + RMS_EPS);
    }
}
namespace pg8 {
#define PG8_LAS __attribute__((address_space(3)))
typedef unsigned short bf16_t;
typedef short bf16x8 __attribute__((ext_vector_type(8)));
typedef float f32x4 __attribute__((ext_vector_type(4)));
typedef unsigned u32x4 __attribute__((ext_vector_type(4)));
constexpr int BM = 256, BK = 64, HALF = 128, HTB = HALF * BK * 2  , STAGE_BYTES = 8 * HTB, NXCD = 8, WGM = 8;

__host__ __device__ __forceinline__ int lds_byte(int r, int c) { const int st = (r >> 4) * 2 + (c >> 5), rr = r & 15, cc = c & 31, ob = rr * 64 + cc * 2; return st * 1024 + (ob ^ (((ob >> 9) & 1) << 5)); }
__host__ __device__ __forceinline__ void stage_rc(int b, int& R, int& C) { const int st = b / 1024, sb = b % 1024, swz = sb ^ (((sb >> 9) & 1) << 5); R = (st >> 1) * 16 + swz / 64; C = (st & 1) * 32 + (swz % 64) / 2; }
__host__ __device__ __forceinline__ int perm32(int rho) { const int n = rho >> 4, i = rho & 15; return 8 * (i >> 2) + 4 * n + (i & 3); }

struct Unit { int pm, pn; };
struct Gemm { const bf16_t* A; const bf16_t* Bt; int M, N, K; };

struct StaticOrder {
    int nM, nN, nwg, G, c;
    __host__ __device__ void init(int M, int N, int G_, int c_) { nM = M / BM; nN = N / BM; nwg = nM * nN; G = G_; c = c_; }
    __host__ __device__ bool next(int i, Unit& u) const {
        const long L = (long)i * G + c; if (L >= nwg) return false;
        int wgid = (int)L; { const int q = nwg / NXCD, r = nwg % NXCD, xcd = wgid % NXCD, off = wgid / NXCD; wgid = (xcd < r ? xcd * (q + 1) : r * (q + 1) + (xcd - r) * q) + off; }
        const int nig = WGM * nN, gid = wgid / nig, fm = gid * WGM, gsz = (nM - fm) < WGM ? (nM - fm) : WGM;
        u.pm = fm + ((wgid % nig) % gsz); u.pn = (wgid % nig) / gsz; return true;
    }
    __device__ __forceinline__ void a_ready(const Unit&) const {}
    __device__ __forceinline__ void done(const Unit&) const {}
};
typedef int i32x8 __attribute__((ext_vector_type(8)));
typedef int i32x4 __attribute__((ext_vector_type(4)));
__device__ __forceinline__ i32x8 ld2x16(const PG8_LAS unsigned char* p) { const u32x4 a = *(const PG8_LAS u32x4*)p, b = *(const PG8_LAS u32x4*)(p + 1024);
    return (i32x8){(int)a.x, (int)a.y, (int)a.z, (int)a.w, (int)b.x, (int)b.y, (int)b.z, (int)b.w}; }
__device__ __forceinline__ i32x8 cat8(bf16x8 lo, bf16x8 hi) { const i32x4 a = __builtin_bit_cast(i32x4, lo), b = __builtin_bit_cast(i32x4, hi); return (i32x8){a[0], a[1], a[2], a[3], b[0], b[1], b[2], b[3]}; }
struct InBf16Order : StaticOrder {
    __device__ bool next(int i, Unit& u) const { if (!StaticOrder::next(i, u)) return false; u.pn = u.pn == 0 ? 5 : 13 + u.pn; return true; }
};
__device__ __forceinline__ f32x4 rope4(const f32x4 v, float c0, float s0, float c1, float s1) {
    f32x4 o; o[0] = v[0] * c0 - v[1] * s0; o[1] = v[1] * c0 + v[0] * s0; o[2] = v[2] * c1 - v[3] * s1; o[3] = v[3] * c1 + v[2] * s1; return o; }
#ifdef NOISE_BUILD
__device__ __forceinline__ f32x4 nz4(f32x4 v, int row, int col) {
    f32x4 o;
#pragma unroll
    for (int i = 0; i < 4; ++i) { unsigned h = (unsigned)row * 9216u + (unsigned)(col + i); h ^= h >> 16; h *= 0x7feb352du; h ^= h >> 15; h *= 0x846ca68bu; h ^= h >> 16;
        const float r = (float)(int)(h & 0xffffu) * (1.f / 32768.f) - 1.f; o[i] = v[i] * (1.f + NOISE_EPS * r); }
    return o; }
#define NZ(v, row, col) nz4((v), (row), (col))
#else
#define NZ(v, row, col) (v)
#endif
#ifdef MLA_FP8
__device__ __forceinline__ u32x2 pk8_fp8(f32x4 a, f32x4 b) {
    int w0 = __builtin_amdgcn_cvt_pk_fp8_f32(a[0], a[1], 0, false); w0 = __builtin_amdgcn_cvt_pk_fp8_f32(a[2], a[3], w0, true);
    int w1 = __builtin_amdgcn_cvt_pk_fp8_f32(b[0], b[1], 0, false); w1 = __builtin_amdgcn_cvt_pk_fp8_f32(b[2], b[3], w1, true);
    u32x2 r; r.x = (unsigned)w0; r.y = (unsigned)w1; return r; }
#endif
struct EpiIn {
    static constexpr bool PERM = true, AFTER_DRAIN = false;
    unsigned char* ws; int f8pass;
    __device__ __forceinline__ void operator()(const f32x4 (&acc)[2][2][4][2], const Unit& u, int wr, int wc, int fr, int fq) const {
        const int pn = f8pass ? (u.pn < 5 ? u.pn : u.pn + 1) : u.pn, row0 = u.pm * BM + wr * 64 + fr;
        if (pn < 5) {
            const bool isq = pn < 3; bf16_t* base = (bf16_t*)(ws + (isq ? WS_QLAT : WS_KVLAT)); const int ld = isq ? 768 : 512, ct = isq ? pn : pn - 3, ns = isq ? 24 : 16; float* rsq = (float*)(ws + (isq ? WS_RSQQ : WS_RSQKV));
#pragma unroll
            for (int ai = 0; ai < 2; ++ai)
#pragma unroll
                for (int m = 0; m < 4; ++m) { const int row = row0 + ai * HALF + m * 16;
#pragma unroll
                    for (int bj = 0; bj < 2; ++bj) { const f32x4 v0 = NZ(acc[ai][bj][m][0], row, pn * 256 + bj * 128 + wc * 32 + 8 * fq), v1 = NZ(acc[ai][bj][m][1], row, pn * 256 + bj * 128 + wc * 32 + 8 * fq + 4);
                        float ss = ((v0[0] * v0[0] + v0[1] * v0[1]) + (v0[2] * v0[2] + v0[3] * v0[3])) + ((v1[0] * v1[0] + v1[1] * v1[1]) + (v1[2] * v1[2] + v1[3] * v1[3]));
                        ss += __shfl_xor(ss, 16); ss += __shfl_xor(ss, 32);
                        if (fq == 0) rsq[(size_t)row * ns + ct * 8 + bj * 4 + wc] = ss;
#ifdef GEMM_F8
                        *(GAS u32x2*)((unsigned char*)base + (size_t)row * ld + ct * 256 + bj * HALF + wc * 32 + 8 * fq) = pk8_fp8(v0, v1); } }
#else
                        *(GAS u32x4*)(base + (size_t)row * ld + ct * 256 + bj * HALF + wc * 32 + 8 * fq) = pk8(v0, v1); } }
#endif
        } else if (pn == 5) {
            if (wc < 2) {
                const int i0 = 16 * wc + 4 * fq; const float* cosT = (const float*)(ws + WS_ROPE); const float* sinT = cosT + (size_t)S * 32; bf16_t* kmla = (bf16_t*)(ws + WS_KMLA);
#pragma unroll
                for (int ai = 0; ai < 2; ++ai)
#pragma unroll
                    for (int m = 0; m < 4; ++m) { const int row = row0 + ai * HALF + m * 16;
                        const f32x4 cs = *(const GAS f32x4*)(cosT + (size_t)row * 32 + i0), sn = *(const GAS f32x4*)(sinT + (size_t)row * 32 + i0);
#ifdef MLA_FP8
                        const u32x2 w = pk8_fp8(rope4(acc[ai][0][m][0], cs[0], sn[0], cs[1], sn[1]), rope4(acc[ai][0][m][1], cs[2], sn[2], cs[3], sn[3]));
                        unsigned char* dst = (unsigned char*)kmla + (size_t)row * 3072 + 128 + wc * 32 + 8 * fq;
#pragma unroll
                        for (int h = 0; h < 16; ++h) *(GAS u32x2*)(dst + h * 192) = w;
#else
                        const u32x4 w = pk8(rope4(acc[ai][0][m][0], cs[0], sn[0], cs[1], sn[1]), rope4(acc[ai][0][m][1], cs[2], sn[2], cs[3], sn[3]));
                        bf16_t* dst = kmla + (size_t)row * 3072 + 128 + wc * 32 + 8 * fq;
#pragma unroll
                        for (int h = 0; h < 16; ++h) *(GAS u32x4*)(dst + h * 192) = w;
#endif
                        asm volatile("" ::: "memory"); }
            } else {
                const int cl = (wc - 2) * 32 + 8 * fq; float* gnsa = (float*)(ws + WS_GNSA);
                if (cl < 48) {
#pragma unroll
                    for (int ai = 0; ai < 2; ++ai)
#pragma unroll
                        for (int m = 0; m < 4; ++m) { const int row = row0 + ai * HALF + m * 16; const f32x4 v0 = acc[ai][0][m][0], v1 = acc[ai][0][m][1];
                            f32x4 g0, g1; g0[0] = sigm_f(v0[0]); g0[1] = sigm_f(v0[1]); g0[2] = sigm_f(v0[2]); g0[3] = sigm_f(v0[3]); g1[0] = sigm_f(v1[0]); g1[1] = sigm_f(v1[1]); g1[2] = sigm_f(v1[2]); g1[3] = sigm_f(v1[3]);
                            *(GAS f32x4*)(gnsa + (size_t)row * 48 + cl) = g0; *(GAS f32x4*)(gnsa + (size_t)row * 48 + cl + 4) = g1; } }
            }
        } else {
            const int mode = (pn < 14) ? 0 : (pn < 22 ? 1 : (pn < 28 ? 2 : 0));
            bf16_t* base = (pn < 14) ? (bf16_t*)(ws + WS_ZMLA) + (pn - 6) * 256 : (pn < 22 ? (bf16_t*)(ws + WS_QNSA) + (pn - 14) * 256 : (bf16_t*)(ws + WS_ZNSA) + (pn - 28) * 256); bf16_t* kvnsa = (bf16_t*)(ws + WS_KVNSA);
#pragma unroll
            for (int ai = 0; ai < 2; ++ai)
#pragma unroll
                for (int m = 0; m < 4; ++m) { const int row = row0 + ai * HALF + m * 16;
#pragma unroll
                    for (int bj = 0; bj < 2; ++bj) { f32x4 v0 = NZ(acc[ai][bj][m][0], row, pn * 256 + bj * 128 + wc * 32 + 8 * fq), v1 = NZ(acc[ai][bj][m][1], row, pn * 256 + bj * 128 + wc * 32 + 8 * fq + 4);
                        if (mode == 0) { v0[0] = silu_f(v0[0]); v0[1] = silu_f(v0[1]); v0[2] = silu_f(v0[2]); v0[3] = silu_f(v0[3]); v1[0] = silu_f(v1[0]); v1[1] = silu_f(v1[1]); v1[2] = silu_f(v1[2]); v1[3] = silu_f(v1[3]); }
                        else if (mode == 1) { v0 = v0 * QS_NSA; v1 = v1 * QS_NSA; }
                        bf16_t* dst = (mode == 2) ? kvnsa + (size_t)(2 * (pn - 22) + bj) * ((size_t)S * 128) + (size_t)row * 128 + wc * 32 + 8 * fq
                                                  : base + (size_t)row * 2048 + bj * HALF + wc * 32 + 8 * fq;
                        *(GAS u32x4*)dst = pk8(v0, v1); } }
        }
    }
};
struct EpiQup {
    static constexpr bool PERM = true, AFTER_DRAIN = false;
    unsigned char* ws;
    __device__ __forceinline__ void operator()(const f32x4 (&acc)[2][2][4][2], const Unit& u, int wr, int wc, int fr, int fq) const {
        const int pn = u.pn, row0 = u.pm * BM + wr * 64 + fr; bf16_t* qmla = (bf16_t*)(ws + WS_QMLA); const float* rstd_q = (const float*)(ws + WS_RSTD); const float* cosT = (const float*)(ws + WS_ROPE); const float* sinT = cosT + (size_t)S * 32;
#pragma unroll
        for (int ai = 0; ai < 2; ++ai)
#pragma unroll
            for (int m = 0; m < 4; ++m) { const int row = row0 + ai * HALF + m * 16;
#ifdef MLA_FP8
#ifdef MLA_MXL
                const float sc = (QS_MLA * 8.f) * *(const GAS float*)(rstd_q + row);
#else
                const float sc = *(const GAS float*)(rstd_q + row);
#endif
                unsigned char* q8 = (unsigned char*)qmla + (size_t)row * 3072;
#pragma unroll
                for (int bj = 0; bj < 2; ++bj) { const f32x4 v0 = acc[ai][bj][m][0] * sc, v1 = acc[ai][bj][m][1] * sc;
                    if (pn < 8) { *(GAS u32x2*)(q8 + (2 * pn + bj) * 192 + wc * 32 + 8 * fq) = pk8_fp8(v0, v1); }
                    else { const int cp = (pn - 8) * 256 + bj * HALF + wc * 32 + 8 * fq, head = cp >> 6, dl = cp & 63, i0 = dl >> 1;
                        const f32x4 cs = *(const GAS f32x4*)(cosT + (size_t)row * 32 + i0), sn = *(const GAS f32x4*)(sinT + (size_t)row * 32 + i0);
                        *(GAS u32x2*)(q8 + head * 192 + 128 + dl) = pk8_fp8(rope4(v0, cs[0], sn[0], cs[1], sn[1]), rope4(v1, cs[2], sn[2], cs[3], sn[3])); } }
#else
                const float sc = QS_MLA * *(const GAS float*)(rstd_q + row);
#pragma unroll
                for (int bj = 0; bj < 2; ++bj) { const f32x4 v0 = acc[ai][bj][m][0] * sc, v1 = acc[ai][bj][m][1] * sc;
                    if (pn < 8) { *(GAS u32x4*)(qmla + (size_t)row * 3072 + (2 * pn + bj) * 192 + wc * 32 + 8 * fq) = pk8(v0, v1); }
                    else { const int cp = (pn - 8) * 256 + bj * HALF + wc * 32 + 8 * fq, head = cp >> 6, dl = cp & 63, i0 = dl >> 1;
                        const f32x4 cs = *(const GAS f32x4*)(cosT + (size_t)row * 32 + i0), sn = *(const GAS f32x4*)(sinT + (size_t)row * 32 + i0);
                        *(GAS u32x4*)(qmla + (size_t)row * 3072 + head * 192 + 128 + dl) = pk8(rope4(v0, cs[0], sn[0], cs[1], sn[1]), rope4(v1, cs[2], sn[2], cs[3], sn[3])); } }
#endif
                if (m & 1) asm volatile("" ::: "memory"); }
    }
};
struct EpiKvup {
    static constexpr bool PERM = true, AFTER_DRAIN = false;
    unsigned char* ws;
    __device__ __forceinline__ void operator()(const f32x4 (&acc)[2][2][4][2], const Unit& u, int wr, int wc, int fr, int fq) const {
        const int pn = u.pn, row0 = u.pm * BM + wr * 64 + fr;
#pragma unroll
        for (int ai = 0; ai < 2; ++ai)
#pragma unroll
            for (int m = 0; m < 4; ++m) { const int row = row0 + ai * HALF + m * 16;
                const float sc = *(const GAS float*)((const float*)(ws + WS_RSTD) + S + row); bf16_t* kmla = (bf16_t*)(ws + WS_KMLA); bf16_t* vmla = (bf16_t*)(ws + WS_VMLA);
#ifdef MLA_FP8
                *(GAS u32x2*)((unsigned char*)kmla + (size_t)row * 3072 + pn * 192 + wc * 32 + 8 * fq) = pk8_fp8(acc[ai][0][m][0] * sc, acc[ai][0][m][1] * sc);
#else
                *(GAS u32x4*)(kmla + (size_t)row * 3072 + pn * 192 + wc * 32 + 8 * fq) = pk8(acc[ai][0][m][0] * sc, acc[ai][0][m][1] * sc);
#endif
                *(GAS u32x4*)(vmla + (size_t)row * 2048 + pn * 128 + wc * 32 + 8 * fq) = pk8(acc[ai][1][m][0] * sc, acc[ai][1][m][1] * sc);
                if (m & 1) asm volatile("" ::: "memory"); }
    }
};
#ifdef MLA_FP8V
struct EpiKup {
    static constexpr bool PERM = true, AFTER_DRAIN = false;
    unsigned char* ws;
    __device__ __forceinline__ void operator()(const f32x4 (&acc)[2][2][4][2], const Unit& u, int wr, int wc, int fr, int fq) const {
        const int pn = u.pn, row0 = u.pm * BM + wr * 64 + fr;
#pragma unroll
        for (int ai = 0; ai < 2; ++ai)
#pragma unroll
            for (int m = 0; m < 4; ++m) { const int row = row0 + ai * HALF + m * 16;
                const float sc = *(const GAS float*)((const float*)(ws + WS_RSTD) + S + row); unsigned char* k8 = ws + WS_KMLA + (size_t)row * 3072;
#pragma unroll
                for (int bj = 0; bj < 2; ++bj) *(GAS u32x2*)(k8 + (2 * pn + bj) * 192 + wc * 32 + 8 * fq) = pk8_fp8(acc[ai][bj][m][0] * sc, acc[ai][bj][m][1] * sc);
                if (m & 1) asm volatile("" ::: "memory"); }
    }
};
struct EpiVt {
    static constexpr bool PERM = true, AFTER_DRAIN = false;
    unsigned char* ws;
    __device__ __forceinline__ void operator()(const f32x4 (&acc)[2][2][4][2], const Unit& u, int wr, int wc, int fr, int fq) const {
        const int row0 = u.pm * BM + wr * 64 + fr, col0 = u.pn * BM + wc * 32 + 8 * fq;
        const float* rs = (const float*)(ws + WS_RSTD) + S;
        f32x4 sc[2][2];
#pragma unroll
        for (int bj = 0; bj < 2; ++bj) { sc[bj][0] = *(const GAS f32x4*)(rs + col0 + bj * HALF); sc[bj][1] = *(const GAS f32x4*)(rs + col0 + bj * HALF + 4); }
        const int hi8 = (col0 >> 3) & 1; (void)hi8;
#pragma unroll
        for (int ai = 0; ai < 2; ++ai)
#pragma unroll
            for (int m = 0; m < 4; ++m) { unsigned char* vt = ws + WS_VMLA + (size_t)(row0 + ai * HALF + m * 16) * S;
#pragma unroll
                for (int bj = 0; bj < 2; ++bj) { const u32x2 w = pk8_fp8(acc[ai][bj][m][0] * sc[bj][0], acc[ai][bj][m][1] * sc[bj][1]);
#ifdef MLA_MX
                    unsigned char* d64 = vt + ((col0 + bj * HALF) & ~63) + 4 * ((col0 >> 3) & 7);
                    *(GAS unsigned*)(d64) = w.x; *(GAS unsigned*)(d64 + 32) = w.y; } }
#else
                    unsigned char* d16 = vt + ((col0 + bj * HALF) & ~15);
                    *(GAS unsigned*)(d16 + (hi8 ? 4 : 0)) = w.x; *(GAS unsigned*)(d16 + (hi8 ? 12 : 8)) = w.y; } }
#endif
    }
};
#endif
struct EpiOut {
    static constexpr bool PERM = true, AFTER_DRAIN = false;
    bf16_t* y; const float* gate;
    __device__ __forceinline__ void operator()(const f32x4 (&acc)[2][2][4][2], const Unit& u, int wr, int wc, int fr, int fq) const {
        const int row0 = u.pm * BM + wr * 64 + fr, col0 = u.pn * BM + wc * 32 + 8 * fq;
        f32x4 gv[2][2];
#pragma unroll
        for (int bj = 0; bj < 2; ++bj)
#pragma unroll
            for (int n = 0; n < 2; ++n) gv[bj][n] = *(const GAS f32x4*)(gate + col0 + bj * HALF + n * 4);
#pragma unroll
        for (int ai = 0; ai < 2; ++ai)
#pragma unroll
            for (int m = 0; m < 4; ++m) { bf16_t* dst = y + (size_t)(row0 + ai * HALF + m * 16) * D + col0;
#pragma unroll
                for (int bj = 0; bj < 2; ++bj) *(GAS u32x4*)(dst + bj * HALF) = pk8(gv[bj][0] * acc[ai][bj][m][0], gv[bj][1] * acc[ai][bj][m][1]);
                if (m & 1) asm volatile("" ::: "memory"); }
    }
};
template <class Epi, class Sched, bool ALIGN_EPI = false, bool SP2 = false, int SCB = 0, int SCA = 0>
__device__ __forceinline__ void gemm_phase(PG8_LAS unsigned char* lds, const Gemm g, const Sched& S, const Epi& E) {
    int tid_ = threadIdx.x; asm volatile("" : "+v"(tid_));
    const int tid = tid_, wid = __builtin_amdgcn_readfirstlane(tid >> 6), lane = tid & 63, wr = wid >> 2, wc = wid & 3, fr = lane & 15, fq = lane >> 4;
    const int K = g.K, nt = K / BK;
    unsigned voffA[2], voffB[2];
#pragma unroll
    for (int i = 0; i < 2; ++i) { int R, C; stage_rc(tid * 16 + i * 8192, R, C); const int Rb = Epi::PERM ? ((R & ~31) + perm32(R & 31)) : R;
        voffA[i] = (unsigned)(R * K + C) * 2u; voffB[i] = (unsigned)(Rb * K + C) * 2u; }
    const size_t kstep = (size_t)(BK * 2);
    const size_t hstep = (size_t)HALF * K * 2;
    const size_t tstep = 2 * hstep;
    const unsigned ldsw = (unsigned)wid * 1024u;
    const int aoff = lds_byte(wr * 64 + fr, fq * 8), boff = lds_byte(wc * 32 + fr, fq * 8);
#define PG8_SA(b, h) (((b) * 2 + (h)) * HTB)
#define PG8_SB(b, h) ((4 + (b) * 2 + (h)) * HTB)
#define PG8_STAGE(bufoff, gbase, voff) do { _Pragma("unroll") for (int _i = 0; _i < 2; ++_i) \
        __builtin_amdgcn_global_load_lds((const unsigned*)((const char*)(gbase) + (voff)[_i]), (PG8_LAS unsigned*)(lds + (bufoff) + ldsw + _i * 8192), 16, 0, 0); } while (0)
#define PG8_LDA(dst, b, h) do { if constexpr (SCB != 0) { _Pragma("unroll") for (int m = 0; m < 4; ++m) dst##8[m] = ld2x16(lds + PG8_SA(b, h) + aoff + m * 2048); } \
        else { _Pragma("unroll") for (int m = 0; m < 4; ++m) _Pragma("unroll") for (int k = 0; k < 2; ++k) dst[m][k] = *(const PG8_LAS bf16x8*)(lds + PG8_SA(b, h) + aoff + m * 2048 + k * 1024); } } while (0)
#define PG8_LDB(dst, b, h) do { if constexpr (SCB != 0) { _Pragma("unroll") for (int n = 0; n < 2; ++n) dst##8[n] = ld2x16(lds + PG8_SB(b, h) + boff + n * 2048); } \
        else { _Pragma("unroll") for (int n = 0; n < 2; ++n) _Pragma("unroll") for (int k = 0; k < 2; ++k) dst[n][k] = *(const PG8_LAS bf16x8*)(lds + PG8_SB(b, h) + boff + n * 2048 + k * 1024); } } while (0)
#define PG8_MMA(ai, bj, At, Bt) do { __builtin_amdgcn_s_setprio(1); \
        if constexpr (SCB != 0) { _Pragma("unroll") for (int m = 0; m < 4; ++m) _Pragma("unroll") for (int n = 0; n < 2; ++n) \
            asm volatile("v_mfma_scale_f32_16x16x128_f8f6f4 %0, %1, %2, %0, %3, %4 op_sel_hi:[0,0,0]" : "+v"(acc[ai][bj][m][n]) : "v"(Bt##8[n]), "v"(At##8[m]), "v"(scb_), "v"(sca_)); } \
        else { _Pragma("unroll") for (int m = 0; m < 4; ++m) _Pragma("unroll") for (int n = 0; n < 2; ++n) _Pragma("unroll") for (int k = 0; k < 2; ++k) \
            acc[ai][bj][m][n] = __builtin_amdgcn_mfma_f32_16x16x32_bf16(Bt[n][k], At[m][k], acc[ai][bj][m][n], 0, 0, 0); } \
        __builtin_amdgcn_s_setprio(0); } while (0)
#define PG8_WAIT_V(n) asm volatile("s_waitcnt vmcnt(" #n ")" ::: "memory")
#define PG8_WAIT_L(n) asm volatile("s_waitcnt lgkmcnt(" #n ")" ::: "memory")
#define PG8_BAR __builtin_amdgcn_s_barrier()
#define PG8_SCHED __builtin_amdgcn_sched_barrier(0)
    Unit cur, nxt; int ui = 0;
    if (!S.next(0, cur)) return;
    f32x4 acc[2][2][4][2];
#pragma unroll
    for (int a = 0; a < 2; ++a)
#pragma unroll
        for (int b = 0; b < 2; ++b)
#pragma unroll
            for (int m = 0; m < 4; ++m)
#pragma unroll
                for (int n = 0; n < 2; ++n) acc[a][b][m][n] = (f32x4){0.f, 0.f, 0.f, 0.f};
    int scb_ = SCB, sca_ = SCA; asm volatile("" : "+v"(scb_), "+v"(sca_));
    bf16x8 At[4][2], B0[2][2], B1[2][2]; i32x8 At8[4], B08[2], B18[2];
    const char* cA = (const char*)g.A + (size_t)cur.pm * tstep; const char* cB = (const char*)g.Bt + (size_t)cur.pn * tstep;
    S.a_ready(cur);
    if constexpr (SP2) {
        PG8_STAGE(PG8_SB(0, 0), cB, voffB); PG8_STAGE(PG8_SB(0, 1), cB + hstep, voffB); PG8_STAGE(PG8_SA(0, 0), cA, voffA); PG8_STAGE(PG8_SA(0, 1), cA + hstep, voffA);
        if (wr == 1) PG8_BAR;
        PG8_WAIT_V(2); PG8_BAR;
        PG8_STAGE(PG8_SB(1, 0), cB + kstep, voffB); PG8_STAGE(PG8_SA(1, 0), cA + kstep, voffA); PG8_STAGE(PG8_SB(1, 1), cB + hstep + kstep, voffB);
        PG8_WAIT_V(6); PG8_BAR;
    } else {
        PG8_STAGE(PG8_SB(0, 0), cB, voffB); PG8_STAGE(PG8_SA(0, 0), cA, voffA); PG8_STAGE(PG8_SB(0, 1), cB + hstep, voffB); PG8_STAGE(PG8_SA(0, 1), cA + hstep, voffA);
        if (wr == 1) PG8_BAR;
        PG8_WAIT_V(4); PG8_BAR;
        PG8_STAGE(PG8_SB(1, 0), cB + kstep, voffB); PG8_STAGE(PG8_SA(1, 0), cA + kstep, voffA); PG8_STAGE(PG8_SB(1, 1), cB + hstep + kstep, voffB);
        PG8_WAIT_V(6); PG8_BAR;
    }
    for (;;) {
        const bool has_next = S.next(ui + 1, nxt);
        const char* nA = has_next ? (const char*)g.A + (size_t)nxt.pm * tstep : cA; const char* nB = has_next ? (const char*)g.Bt + (size_t)nxt.pn * tstep : cB;
#pragma unroll 1
        for (int t = 0; t < nt; t += 2) {
            const bool last = (t == nt - 2);
            const char* a1 = cA + (size_t)(t + 1) * kstep;
            const char* a2 = last ? nA : cA + (size_t)(t + 2) * kstep; const char* b2 = last ? nB : cB + (size_t)(t + 2) * kstep;
            const char* a3 = a2 + kstep; const char* b3 = b2 + kstep;
            if (last && has_next) S.a_ready(nxt);
            if constexpr (SP2) {
            PG8_LDB(B0, 0, 0); PG8_LDB(B1, 0, 1); PG8_SCHED; PG8_LDA(At, 0, 0); PG8_STAGE(PG8_SA(1, 1), a1 + hstep, voffA);
            PG8_WAIT_V(8); PG8_WAIT_L(0); PG8_BAR; PG8_MMA(0, 0, At, B0); PG8_MMA(0, 1, At, B1); PG8_BAR; PG8_SCHED;
            PG8_LDA(At, 0, 1); PG8_STAGE(PG8_SB(0, 0), b2, voffB); PG8_STAGE(PG8_SB(0, 1), b2 + hstep, voffB); PG8_STAGE(PG8_SA(0, 0), a2, voffA);
            PG8_WAIT_V(8); PG8_WAIT_L(0); PG8_BAR; PG8_MMA(1, 0, At, B0); PG8_MMA(1, 1, At, B1); PG8_BAR; PG8_SCHED;
            PG8_LDB(B0, 1, 0); PG8_LDB(B1, 1, 1); PG8_SCHED; PG8_LDA(At, 1, 0); PG8_STAGE(PG8_SA(0, 1), a2 + hstep, voffA);
            PG8_WAIT_V(8); PG8_WAIT_L(0); PG8_BAR; PG8_MMA(0, 0, At, B0); PG8_MMA(0, 1, At, B1); PG8_BAR; PG8_SCHED;
            PG8_LDA(At, 1, 1); PG8_STAGE(PG8_SB(1, 0), b3, voffB); PG8_STAGE(PG8_SB(1, 1), b3 + hstep, voffB); PG8_STAGE(PG8_SA(1, 0), a3, voffA);
            PG8_WAIT_V(8); PG8_WAIT_L(0); PG8_BAR; PG8_MMA(1, 0, At, B0); PG8_MMA(1, 1, At, B1); PG8_BAR; PG8_SCHED;
            } else {
            PG8_LDB(B0, 0, 0); PG8_SCHED; PG8_LDA(At, 0, 0); PG8_STAGE(PG8_SA(1, 1), a1 + hstep, voffA);
            PG8_WAIT_L(8); PG8_BAR; PG8_WAIT_L(0); PG8_MMA(0, 0, At, B0); PG8_BAR; PG8_SCHED;
            PG8_LDB(B1, 0, 1); PG8_STAGE(PG8_SB(0, 0), b2, voffB);
            PG8_BAR; PG8_WAIT_L(0); PG8_MMA(0, 1, At, B1); PG8_BAR;
            PG8_LDA(At, 0, 1); PG8_STAGE(PG8_SA(0, 0), a2, voffA);
            PG8_BAR; PG8_WAIT_L(0); PG8_MMA(1, 0, At, B0); PG8_BAR; PG8_SCHED;
            PG8_STAGE(PG8_SB(0, 1), b2 + hstep, voffB);
            PG8_WAIT_V(6); PG8_BAR; PG8_MMA(1, 1, At, B1); PG8_BAR;
            PG8_LDB(B0, 1, 0); PG8_SCHED; PG8_LDA(At, 1, 0); PG8_STAGE(PG8_SA(0, 1), a2 + hstep, voffA);
            PG8_WAIT_L(8); PG8_BAR; PG8_WAIT_L(0); PG8_MMA(0, 0, At, B0); PG8_BAR; PG8_SCHED;
            PG8_LDB(B1, 1, 1); PG8_STAGE(PG8_SB(1, 0), b3, voffB);
            PG8_BAR; PG8_WAIT_L(0); PG8_MMA(0, 1, At, B1); PG8_BAR;
            PG8_LDA(At, 1, 1); PG8_STAGE(PG8_SA(1, 0), a3, voffA);
            PG8_BAR; PG8_WAIT_L(0); PG8_MMA(1, 0, At, B0); PG8_BAR; PG8_SCHED;
            PG8_STAGE(PG8_SB(1, 1), b3 + hstep, voffB);
            PG8_WAIT_V(6); PG8_BAR; PG8_MMA(1, 1, At, B1); PG8_BAR;
            }
        }
        if constexpr (SCB != 0) asm volatile("s_nop 15\n\ts_nop 15" ::: "memory");
        if constexpr (ALIGN_EPI) { if (wr == 0) PG8_BAR; }
        if constexpr (!Epi::AFTER_DRAIN) { int fr_ = fr, fq_ = fq; asm volatile("" : "+v"(fr_), "+v"(fq_));
            E(acc, cur, wr, wc, fr_, fq_); S.done(cur); }
        if (!has_next) break;
#pragma unroll
        for (int a = 0; a < 2; ++a)
#pragma unroll
            for (int b = 0; b < 2; ++b)
#pragma unroll
                for (int m = 0; m < 4; ++m)
#pragma unroll
                    for (int n = 0; n < 2; ++n) acc[a][b][m][n] = (f32x4){0.f, 0.f, 0.f, 0.f};
        cur = nxt; cA = nA; cB = nB; ++ui;
        if constexpr (ALIGN_EPI) { if (wr == 1) PG8_BAR; }
    }
    PG8_WAIT_V(0);
    if constexpr (!ALIGN_EPI) { if (wr == 0) PG8_BAR; }
    PG8_BAR;
    if constexpr (Epi::AFTER_DRAIN) { E.fused(acc, cur, wr, wc, fr, fq, lds, wid, lane); S.done(cur); }
#undef PG8_SA
#undef PG8_SB
#undef PG8_STAGE
#undef PG8_LDA
#undef PG8_LDB
#undef PG8_MMA
#undef PG8_WAIT_V
#undef PG8_WAIT_L
#undef PG8_BAR
#undef PG8_SCHED
}
}
namespace att {
constexpr int KS_M = 400, KS_N = 272, VS = 320;
constexpr int MLA_KB = 64 * KS_M, NSA_KB = 64 * KS_N, VB = 64 * VS;
constexpr int N_IMP = 2 * NSA_KB + 2 * VB;
constexpr int N_PART = N_IMP + 32768;
constexpr int N_PARTB = 8 * 32 * 17 * 4;
constexpr int N_SELM = N_PART + 2 * N_PARTB;
constexpr int N_ULIST = N_SELM + 1024;
constexpr int N_CARRY = N_ULIST + 1024;
constexpr int N_NTS = N_CARRY + 256;
static_assert(N_NTS + 16 <= MISC_OFF, "NSA LDS map");
static_assert(2 * MLA_KB + 3 * VB <= 131072, "MLA LDS map");
constexpr int MLA_QL = 2 * MLA_KB + 2 * VB;
static_assert(MLA_QL + 8 * 4096 <= 131072, "MLA LDS map (pipelined)");

#ifndef QK_PF
#define QK_PF 4
#endif
#define MFMA32(a, b, c) __builtin_amdgcn_mfma_f32_32x32x16_bf16((a), (b), (c), 0, 0, 0)
__device__ __forceinline__ float swapmax(float v) { auto rr = __builtin_amdgcn_permlane32_swap(__float_as_uint(v), __float_as_uint(v), false, false); return fmaxf(__uint_as_float(rr[0]), __uint_as_float(rr[1])); }
__device__ __forceinline__ float swapsum(float v) { auto rr = __builtin_amdgcn_permlane32_swap(__float_as_uint(v), __float_as_uint(v), false, false); return __uint_as_float(rr[0]) + __uint_as_float(rr[1]); }
template <int SIDX> __device__ __forceinline__ bf16x8 packp(const f32x16& p) {
    f32x8 t = {p[8 * SIDX + 0], p[8 * SIDX + 1], p[8 * SIDX + 2], p[8 * SIDX + 3], p[8 * SIDX + 4], p[8 * SIDX + 5], p[8 * SIDX + 6], p[8 * SIDX + 7]};
    return __builtin_bit_cast(bf16x8, __builtin_convertvector(t, bf16x8v));
}
template <int NDC, int KS, bool ZERO = true> __device__ __forceinline__ void qk_tile(f32x16& p0, f32x16& p1, const LAS unsigned char* kl, const bf16x8 (&q)[NDC]) {
    if (ZERO) {
#pragma unroll
        for (int i = 0; i < 16; ++i) { p0[i] = 0.f; p1[i] = 0.f; }
    }
    constexpr int PF = QK_PF;
    bf16x8 a[PF + 1][2];
#pragma unroll
    for (int i = 0; i < PF; ++i) { a[i][0] = *(const LAS bf16x8*)(kl + i * 32); a[i][1] = *(const LAS bf16x8*)(kl + 32 * KS + i * 32); }
#pragma unroll
    for (int d0 = 0; d0 < NDC; ++d0) {
        if (d0 + PF < NDC) { a[(d0 + PF) % (PF + 1)][0] = *(const LAS bf16x8*)(kl + (d0 + PF) * 32); a[(d0 + PF) % (PF + 1)][1] = *(const LAS bf16x8*)(kl + 32 * KS + (d0 + PF) * 32); }
        __builtin_amdgcn_sched_barrier(0);
        p0 = MFMA32(a[d0 % (PF + 1)][0], q[d0], p0); p1 = MFMA32(a[d0 % (PF + 1)][1], q[d0], p1);
        __builtin_amdgcn_sched_barrier(0);
    }
}
#ifdef PROBE_QKM2
template <int NDC, int KS> __device__ __forceinline__ void qk_tile_m2(f32x16& p0, f32x16& p1, f32x16& r0, f32x16& r1, const LAS unsigned char* kl, const bf16x8 (&q)[NDC]) {
#pragma unroll
    for (int i = 0; i < 16; ++i) { p0[i] = 0.f; p1[i] = 0.f; r0[i] = 0.f; r1[i] = 0.f; }
    constexpr int PF = QK_PF;
    bf16x8 a[PF + 1][2];
#pragma unroll
    for (int i = 0; i < PF; ++i) { a[i][0] = *(const LAS bf16x8*)(kl + i * 32); a[i][1] = *(const LAS bf16x8*)(kl + 32 * KS + i * 32); }
#pragma unroll
    for (int d0 = 0; d0 < NDC; ++d0) {
        if (d0 + PF < NDC) { a[(d0 + PF) % (PF + 1)][0] = *(const LAS bf16x8*)(kl + (d0 + PF) * 32); a[(d0 + PF) % (PF + 1)][1] = *(const LAS bf16x8*)(kl + 32 * KS + (d0 + PF) * 32); }
        __builtin_amdgcn_sched_barrier(0);
        p0 = MFMA32(a[d0 % (PF + 1)][0], q[d0], p0); p1 = MFMA32(a[d0 % (PF + 1)][1], q[d0], p1);
        r0 = MFMA32(a[d0 % (PF + 1)][0], q[d0], r0); r1 = MFMA32(a[d0 % (PF + 1)][1], q[d0], r1);
        __builtin_amdgcn_sched_barrier(0);
    }
}
#endif
__device__ __forceinline__ void pv_tile(f32x16 (&o)[4], const bf16x8 (&pb)[4], const LAS unsigned char* vl) {
    s16x4 f[5][2];
#define PV_LD(idx) do { constexpr int d_ = (idx) >> 2, s_ = (idx) & 3; \
        f[(idx) % 5][0] = __builtin_amdgcn_ds_read_tr16_b64_v4i16((LAS s16x4*)(vl + s_ * 16 * VS + d_ * 64)); \
        f[(idx) % 5][1] = __builtin_amdgcn_ds_read_tr16_b64_v4i16((LAS s16x4*)(vl + s_ * 16 * VS + 8 * VS + d_ * 64)); } while (0)
    PV_LD(0); PV_LD(1); PV_LD(2); PV_LD(3);
#define PV_STEP(idx) do { if ((idx) + 4 < 16) PV_LD((idx) + 4); __builtin_amdgcn_sched_barrier(0); \
        { const s16x4 t0_ = f[(idx) % 5][0], t1_ = f[(idx) % 5][1]; const bf16x8 vf_ = {t0_[0], t0_[1], t0_[2], t0_[3], t1_[0], t1_[1], t1_[2], t1_[3]}; \
          o[(idx) >> 2] = MFMA32(vf_, pb[(idx) & 3], o[(idx) >> 2]); } __builtin_amdgcn_sched_barrier(0); } while (0)
    PV_STEP(0); PV_STEP(1); PV_STEP(2); PV_STEP(3); PV_STEP(4); PV_STEP(5); PV_STEP(6); PV_STEP(7);
    PV_STEP(8); PV_STEP(9); PV_STEP(10); PV_STEP(11); PV_STEP(12); PV_STEP(13); PV_STEP(14); PV_STEP(15);
#undef PV_STEP
#undef PV_LD
}
template <int NDC, int NQR, int KS> __device__ __forceinline__ void qk_tile_free(f32x16& p0, f32x16& p1, const LAS unsigned char* kl, const bf16x8 (&q)[NQR], const LAS unsigned char* ql) {
#pragma unroll
    for (int i = 0; i < 16; ++i) { p0[i] = 0.f; p1[i] = 0.f; }
#pragma unroll
    for (int d0 = 0; d0 < NDC; ++d0) {
        const bf16x8 a0 = *(const LAS bf16x8*)(kl + d0 * 32);
        const bf16x8 a1 = *(const LAS bf16x8*)(kl + 32 * KS + d0 * 32);
        bf16x8 qq; if (d0 < NQR) qq = q[d0 < NQR ? d0 : 0]; else qq = *(const LAS bf16x8*)(ql + (d0 - NQR) * 1024);
        p0 = MFMA32(a0, qq, p0); p1 = MFMA32(a1, qq, p1);
    }
}
__device__ __forceinline__ float sm_core(f32x16& p0, f32x16& p1, float& m, float& l) {
    float tm = p0[0];
#pragma unroll
    for (int r = 1; r < 16; ++r) tm = fmaxf(tm, p0[r]);
#pragma unroll
    for (int r = 0; r < 16; ++r) tm = fmaxf(tm, p1[r]);
    tm = swapmax(tm);
    const float mn = fmaxf(m, tm);
    const float alpha = __builtin_amdgcn_exp2f(m - mn);
    m = mn;
    float ps = 0.f;
#pragma unroll
    for (int r = 0; r < 16; ++r) { p0[r] = __builtin_amdgcn_exp2f(p0[r] - mn); ps += p0[r]; }
#pragma unroll
    for (int r = 0; r < 16; ++r) { p1[r] = __builtin_amdgcn_exp2f(p1[r] - mn); ps += p1[r]; }
    ps = swapsum(ps);
    l = l * alpha + ps;
    return alpha;
}
__device__ __forceinline__ void online_sm(f32x16& p0, f32x16& p1, float& m, float& l, f32x16 (&o)[4]) {
    float tm = p0[0];
#pragma unroll
    for (int r = 1; r < 16; ++r) tm = fmaxf(tm, p0[r]);
#pragma unroll
    for (int r = 0; r < 16; ++r) tm = fmaxf(tm, p1[r]);
    tm = swapmax(tm);
    const float mn = fmaxf(m, tm);
    const float alpha = __builtin_amdgcn_exp2f(m - mn);
    m = mn;
    float ps = 0.f;
#pragma unroll
    for (int r = 0; r < 16; ++r) { p0[r] = __builtin_amdgcn_exp2f(p0[r] - mn); ps += p0[r]; }
#pragma unroll
    for (int r = 0; r < 16; ++r) { p1[r] = __builtin_amdgcn_exp2f(p1[r] - mn); ps += p1[r]; }
    ps = swapsum(ps);
    l = l * alpha + ps;
    if (!__all(alpha == 1.f)) {
#pragma unroll
        for (int d = 0; d < 4; ++d)
#pragma unroll
            for (int r = 0; r < 16; ++r) o[d][r] *= alpha;
    }
}

#ifdef MLA_FP8
typedef long i64;
constexpr int KS8 = 200, MLA_KB8 = 64 * KS8;
static_assert(2 * MLA_KB8 + 3 * VB <= 131072, "MLA fp8 LDS map");
#define MFMA32F8(a, b, c) __builtin_amdgcn_mfma_f32_32x32x16_fp8_fp8((a), (b), (c), 0, 0, 0)
template <int NDC> __device__ __forceinline__ void qk_tile8(f32x16& p0, f32x16& p1, const LAS unsigned char* kl, const i64 (&q)[NDC]) {
#pragma unroll
    for (int i = 0; i < 16; ++i) { p0[i] = 0.f; p1[i] = 0.f; }
    constexpr int PF = 4;
    i64 a[PF + 1][2];
#pragma unroll
    for (int i = 0; i < PF; ++i) { a[i][0] = *(const LAS i64*)(kl + i * 16); a[i][1] = *(const LAS i64*)(kl + 32 * KS8 + i * 16); }
#pragma unroll
    for (int d0 = 0; d0 < NDC; ++d0) {
        if (d0 + PF < NDC) { a[(d0 + PF) % (PF + 1)][0] = *(const LAS i64*)(kl + (d0 + PF) * 16); a[(d0 + PF) % (PF + 1)][1] = *(const LAS i64*)(kl + 32 * KS8 + (d0 + PF) * 16); }
        __builtin_amdgcn_sched_barrier(0);
        __builtin_amdgcn_s_setprio(1);
        p0 = MFMA32F8(a[d0 % (PF + 1)][0], q[d0], p0); p1 = MFMA32F8(a[d0 % (PF + 1)][1], q[d0], p1);
        __builtin_amdgcn_s_setprio(0);
        __builtin_amdgcn_sched_barrier(0);
    }
}
__device__ __forceinline__ void online_sm_scaled(f32x16& p0, f32x16& p1, float& m, float& l, f32x16 (&o)[4], const float C2) {
    float tm = p0[0];
#pragma unroll
    for (int r = 1; r < 16; ++r) tm = fmaxf(tm, p0[r]);
#pragma unroll
    for (int r = 0; r < 16; ++r) tm = fmaxf(tm, p1[r]);
    tm = swapmax(tm);
    const float mn = fmaxf(m, tm);
    const float alpha = __builtin_amdgcn_exp2f((m - mn) * C2);
    m = mn;
    const float mc = -mn * C2;
    float ps = 0.f;
#pragma unroll
    for (int r = 0; r < 16; ++r) { p0[r] = __builtin_amdgcn_exp2f(__builtin_fmaf(p0[r], C2, mc)); ps += p0[r]; }
#pragma unroll
    for (int r = 0; r < 16; ++r) { p1[r] = __builtin_amdgcn_exp2f(__builtin_fmaf(p1[r], C2, mc)); ps += p1[r]; }
    ps = swapsum(ps);
    l = l * alpha + ps;
    if (!__all(alpha == 1.f)) {
#pragma unroll
        for (int d = 0; d < 4; ++d)
#pragma unroll
            for (int r = 0; r < 16; ++r) o[d][r] *= alpha;
    }
}
#endif
#ifdef MLA_FP8V
constexpr int VS8 = 72, VB8 = 128 * VS8;
constexpr int VS8B = 136, VB8B = 128 * VS8B, MLA_KB8B = 128 * KS8;
static_assert(2 * MLA_KB8B + 3 * VB8B <= 131072, "MLA big-tile LDS map");
#ifdef MLA_BIG
#define PV8_RS VS8B
#else
#define PV8_RS VS8
#endif
static_assert(2 * MLA_KB8 + 3 * VB8 <= 131072, "MLA fp8 LDS map");
template <int SIDX> __device__ __forceinline__ i64 packp8(const f32x16& p) {
    int w0 = __builtin_amdgcn_cvt_pk_fp8_f32(p[8 * SIDX + 0] * 256.f, p[8 * SIDX + 1] * 256.f, 0, false); w0 = __builtin_amdgcn_cvt_pk_fp8_f32(p[8 * SIDX + 2] * 256.f, p[8 * SIDX + 3] * 256.f, w0, true);
    int w1 = __builtin_amdgcn_cvt_pk_fp8_f32(p[8 * SIDX + 4] * 256.f, p[8 * SIDX + 5] * 256.f, 0, false); w1 = __builtin_amdgcn_cvt_pk_fp8_f32(p[8 * SIDX + 6] * 256.f, p[8 * SIDX + 7] * 256.f, w1, true);
    return (i64)(((unsigned long long)(unsigned)w1 << 32) | (unsigned)w0);
}
__device__ __forceinline__ void pv_tile8(f32x16 (&o)[4], const i64 (&pb)[4], const LAS unsigned char* vl) {
    i64 f[5];
#define PV8_LD(idx) f[(idx) % 5] = *(const LAS i64*)(vl + ((idx) >> 2) * 32 * PV8_RS + ((idx) & 3) * 16)
    PV8_LD(0); PV8_LD(1); PV8_LD(2); PV8_LD(3);
#define PV8_STEP(idx) do { if ((idx) + 4 < 16) PV8_LD((idx) + 4); __builtin_amdgcn_sched_barrier(0); \
        o[(idx) >> 2] = MFMA32F8(f[(idx) % 5], pb[(idx) & 3], o[(idx) >> 2]); __builtin_amdgcn_sched_barrier(0); } while (0)
    PV8_STEP(0); PV8_STEP(1); PV8_STEP(2); PV8_STEP(3); PV8_STEP(4); PV8_STEP(5); PV8_STEP(6); PV8_STEP(7);
    PV8_STEP(8); PV8_STEP(9); PV8_STEP(10); PV8_STEP(11); PV8_STEP(12); PV8_STEP(13); PV8_STEP(14); PV8_STEP(15);
#undef PV8_STEP
#undef PV8_LD
}
#endif
#ifdef MLA_MX
typedef int i32x8 __attribute__((ext_vector_type(8)));
constexpr int KSX = 208, MLA_KBX = 64 * KSX;
constexpr int VSX = 80, VBX = 128 * VSX;
static_assert(2 * MLA_KBX + 3 * VBX <= 131072, "MLA mx LDS map");
#define MFMAX(a, b, c) __builtin_amdgcn_mfma_scale_f32_32x32x64_f8f6f4((a), (b), (c), 0, 0, 0, 0x7f7f7f7f, 0, 0x7f7f7f7f)
__device__ __forceinline__ i32x8 ldsx(const LAS unsigned char* p) {
    const u32x4 a = *(const LAS u32x4*)p, b = *(const LAS u32x4*)(p + 16);
    return (i32x8){(int)a.x, (int)a.y, (int)a.z, (int)a.w, (int)b.x, (int)b.y, (int)b.z, (int)b.w};
}
__device__ __forceinline__ void qk_tilex(f32x16& p0, f32x16& p1, const LAS unsigned char* kl, const i32x8 (&q)[3]) {
#pragma unroll
    for (int i = 0; i < 16; ++i) { p0[i] = 0.f; p1[i] = 0.f; }
    i32x8 a0 = ldsx(kl), a1 = ldsx(kl + 32 * KSX), a2 = ldsx(kl + 64), a3 = ldsx(kl + 32 * KSX + 64);
    __builtin_amdgcn_sched_barrier(0);
    __builtin_amdgcn_s_setprio(1);
    p0 = MFMAX(a0, q[0], p0); p1 = MFMAX(a1, q[0], p1);
    __builtin_amdgcn_s_setprio(0);
    __builtin_amdgcn_sched_barrier(0);
    a0 = ldsx(kl + 128); a1 = ldsx(kl + 32 * KSX + 128);
    __builtin_amdgcn_sched_barrier(0);
    __builtin_amdgcn_s_setprio(1);
    p0 = MFMAX(a2, q[1], p0); p1 = MFMAX(a3, q[1], p1);
    __builtin_amdgcn_sched_barrier(0);
    p0 = MFMAX(a0, q[2], p0); p1 = MFMAX(a1, q[2], p1);
    __builtin_amdgcn_s_setprio(0);
    __builtin_amdgcn_sched_barrier(0);
}
__device__ __forceinline__ void pv_tilex(f32x16 (&o)[4], const i32x8& pb, const LAS unsigned char* vl) {
    i32x8 f0 = ldsx(vl), f1 = ldsx(vl + 32 * VSX);
    __builtin_amdgcn_sched_barrier(0);
    o[0] = MFMAX(f0, pb, o[0]);
    __builtin_amdgcn_sched_barrier(0);
    f0 = ldsx(vl + 64 * VSX);
    __builtin_amdgcn_sched_barrier(0);
    o[1] = MFMAX(f1, pb, o[1]);
    __builtin_amdgcn_sched_barrier(0);
    f1 = ldsx(vl + 96 * VSX);
    __builtin_amdgcn_sched_barrier(0);
    o[2] = MFMAX(f0, pb, o[2]);
    __builtin_amdgcn_sched_barrier(0);
    o[3] = MFMAX(f1, pb, o[3]);
    __builtin_amdgcn_sched_barrier(0);
}
__device__ __forceinline__ i32x8 packpx(const f32x16& p0, const f32x16& p1) {
    i32x8 w;
#pragma unroll
    for (int g = 0; g < 4; ++g) {
        int a = __builtin_amdgcn_cvt_pk_fp8_f32(p0[4 * g + 0], p0[4 * g + 1], 0, false); a = __builtin_amdgcn_cvt_pk_fp8_f32(p0[4 * g + 2], p0[4 * g + 3], a, true); w[g] = a;
        int b = __builtin_amdgcn_cvt_pk_fp8_f32(p1[4 * g + 0], p1[4 * g + 1], 0, false); b = __builtin_amdgcn_cvt_pk_fp8_f32(p1[4 * g + 2], p1[4 * g + 3], b, true); w[4 + g] = b;
    }
    return w;
}
__device__ __forceinline__ void online_sm_x(f32x16& p0, f32x16& p1, float& m, float& l, f32x16 (&o)[4], const float C2) {
    float tm = p0[0];
#pragma unroll
    for (int r = 1; r < 16; ++r) tm = fmaxf(tm, p0[r]);
#pragma unroll
    for (int r = 0; r < 16; ++r) tm = fmaxf(tm, p1[r]);
    tm = swapmax(tm);
    const float mn = fmaxf(m, tm);
    const float alpha = __builtin_amdgcn_exp2f((m - mn) * C2);
    m = mn;
    const float mc = 8.f - mn * C2;
    float ps = 0.f;
#pragma unroll
    for (int r = 0; r < 16; ++r) { p0[r] = __builtin_amdgcn_exp2f(__builtin_fmaf(p0[r], C2, mc)); ps += p0[r]; }
#pragma unroll
    for (int r = 0; r < 16; ++r) { p1[r] = __builtin_amdgcn_exp2f(__builtin_fmaf(p1[r], C2, mc)); ps += p1[r]; }
    ps = swapsum(ps);
    l = l * alpha + ps;
    if (!__all(alpha == 1.f)) {
#pragma unroll
        for (int d = 0; d < 4; ++d)
#pragma unroll
            for (int r = 0; r < 16; ++r) o[d][r] *= alpha;
    }
}
#endif
#ifdef MLA_MXL
#ifdef MLA_MXU
#define MXL_T 126.0f
#define MXL_REF 120.0f
#define MFMAXQ(a, b, c) __builtin_amdgcn_mfma_scale_f32_32x32x64_f8f6f4((a), (b), (c), 0, 0, 0, 0x7f7f7f7f, 0, 0x7f7f7f7f)
__device__ __forceinline__ i32x8 byte_packx(const f32x16& p0, const f32x16& p1) {
    i32x8 w;
#pragma unroll
    for (int g = 0; g < 4; ++g) {
        unsigned a = __builtin_amdgcn_cvt_pk_u8_f32(p0[4 * g + 0], 0, 0u); a = __builtin_amdgcn_cvt_pk_u8_f32(p0[4 * g + 1], 1, a); a = __builtin_amdgcn_cvt_pk_u8_f32(p0[4 * g + 2], 2, a); a = __builtin_amdgcn_cvt_pk_u8_f32(p0[4 * g + 3], 3, a); w[g] = (int)a;
        unsigned b = __builtin_amdgcn_cvt_pk_u8_f32(p1[4 * g + 0], 0, 0u); b = __builtin_amdgcn_cvt_pk_u8_f32(p1[4 * g + 1], 1, b); b = __builtin_amdgcn_cvt_pk_u8_f32(p1[4 * g + 2], 2, b); b = __builtin_amdgcn_cvt_pk_u8_f32(p1[4 * g + 3], 3, b); w[4 + g] = (int)b;
    }
    return w;
}
#else
#define MXL_T 7.0f
#define MXL_REF 0.0f
#define MFMAXQ(a, b, c) __builtin_amdgcn_mfma_scale_f32_32x32x64_f8f6f4((a), (b), (c), 0, 0, 0, 0x7f7f7f7f, 0, 0x7c7c7c7c)
#endif
__device__ __forceinline__ void qk_tilexl(f32x16& p0, f32x16& p1, const f32x16& mref, const LAS unsigned char* kl, const i32x8 (&q)[3]) {
    i32x8 a0 = ldsx(kl), a1 = ldsx(kl + 32 * KSX), a2 = ldsx(kl + 64), a3 = ldsx(kl + 32 * KSX + 64);
    __builtin_amdgcn_sched_barrier(0);
    __builtin_amdgcn_s_setprio(1);
    p0 = MFMAXQ(a0, q[0], mref); p1 = MFMAXQ(a1, q[0], mref);
    __builtin_amdgcn_s_setprio(0);
    __builtin_amdgcn_sched_barrier(0);
    a0 = ldsx(kl + 128); a1 = ldsx(kl + 32 * KSX + 128);
    __builtin_amdgcn_sched_barrier(0);
    __builtin_amdgcn_s_setprio(1);
    p0 = MFMAXQ(a2, q[1], p0); p1 = MFMAXQ(a3, q[1], p1);
    __builtin_amdgcn_sched_barrier(0);
    p0 = MFMAXQ(a0, q[2], p0); p1 = MFMAXQ(a1, q[2], p1);
    __builtin_amdgcn_s_setprio(0);
    __builtin_amdgcn_sched_barrier(0);
}
template <int RS = VSX>
__device__ __forceinline__ void pv_tilexl_pre(f32x16 (&o)[5], const i32x8& pb, const i32x8& ones, const LAS unsigned char* vl, i32x8 f0, i32x8 f1) {
    __builtin_amdgcn_sched_barrier(0);
    o[4] = MFMAX(ones, pb, o[4]);
    __builtin_amdgcn_sched_barrier(0);
    o[0] = MFMAX(f0, pb, o[0]);
    __builtin_amdgcn_sched_barrier(0);
    f0 = ldsx(vl + 64 * RS);
    __builtin_amdgcn_sched_barrier(0);
    o[1] = MFMAX(f1, pb, o[1]);
    __builtin_amdgcn_sched_barrier(0);
    f1 = ldsx(vl + 96 * RS);
    __builtin_amdgcn_sched_barrier(0);
    o[2] = MFMAX(f0, pb, o[2]);
    __builtin_amdgcn_sched_barrier(0);
    o[3] = MFMAX(f1, pb, o[3]);
    __builtin_amdgcn_sched_barrier(0);
}
template <int RS = VSX>
__device__ __forceinline__ void pv_tilexl(f32x16 (&o)[5], const i32x8& pb, const i32x8& ones, const LAS unsigned char* vl) {
    i32x8 f0 = ldsx(vl), f1 = ldsx(vl + 32 * RS);
    __builtin_amdgcn_sched_barrier(0);
    o[4] = MFMAX(ones, pb, o[4]);
    __builtin_amdgcn_sched_barrier(0);
    o[0] = MFMAX(f0, pb, o[0]);
    __builtin_amdgcn_sched_barrier(0);
    f0 = ldsx(vl + 64 * RS);
    __builtin_amdgcn_sched_barrier(0);
    o[1] = MFMAX(f1, pb, o[1]);
    __builtin_amdgcn_sched_barrier(0);
    f1 = ldsx(vl + 96 * RS);
    __builtin_amdgcn_sched_barrier(0);
    o[2] = MFMAX(f0, pb, o[2]);
    __builtin_amdgcn_sched_barrier(0);
    o[3] = MFMAX(f1, pb, o[3]);
    __builtin_amdgcn_sched_barrier(0);
}
__device__ __forceinline__ i32x8 exp_packx(const f32x16& p0, const f32x16& p1, int any) {
    i32x8 w;
#pragma unroll
    for (int g = 0; g < 4; ++g) {
        int a = __builtin_amdgcn_cvt_pk_fp8_f32(__builtin_amdgcn_exp2f(p0[4 * g + 0]), __builtin_amdgcn_exp2f(p0[4 * g + 1]), any, false);
        a = __builtin_amdgcn_cvt_pk_fp8_f32(__builtin_amdgcn_exp2f(p0[4 * g + 2]), __builtin_amdgcn_exp2f(p0[4 * g + 3]), a, true); w[g] = a;
        int b = __builtin_amdgcn_cvt_pk_fp8_f32(__builtin_amdgcn_exp2f(p1[4 * g + 0]), __builtin_amdgcn_exp2f(p1[4 * g + 1]), any, false);
        b = __builtin_amdgcn_cvt_pk_fp8_f32(__builtin_amdgcn_exp2f(p1[4 * g + 2]), __builtin_amdgcn_exp2f(p1[4 * g + 3]), b, true); w[4 + g] = b;
    }
    return w;
}
#endif
#ifdef MLA_PIPE8
template <int NDC> __device__ __forceinline__ void qk_tile8_free(f32x16& p0, f32x16& p1, const LAS unsigned char* kl, const i64 (&q)[NDC]) {
#pragma unroll
    for (int i = 0; i < 16; ++i) { p0[i] = 0.f; p1[i] = 0.f; }
#pragma unroll
    for (int d0 = 0; d0 < NDC; ++d0) {
        const i64 a0 = *(const LAS i64*)(kl + d0 * 16), a1 = *(const LAS i64*)(kl + 32 * KS8 + d0 * 16);
        p0 = MFMA32F8(a0, q[d0], p0); p1 = MFMA32F8(a1, q[d0], p1);
    }
}
__device__ __forceinline__ float sm_core_scaled(f32x16& p0, f32x16& p1, float& m, float& l, const float C2) {
    float tm = p0[0];
#pragma unroll
    for (int r = 1; r < 16; ++r) tm = fmaxf(tm, p0[r]);
#pragma unroll
    for (int r = 0; r < 16; ++r) tm = fmaxf(tm, p1[r]);
    tm = swapmax(tm);
    const float mn = fmaxf(m, tm);
    const float alpha = __builtin_amdgcn_exp2f((m - mn) * C2);
    m = mn;
    const float mc = -mn * C2;
    float ps = 0.f;
#pragma unroll
    for (int r = 0; r < 16; ++r) { p0[r] = __builtin_amdgcn_exp2f(__builtin_fmaf(p0[r], C2, mc)); ps += p0[r]; }
#pragma unroll
    for (int r = 0; r < 16; ++r) { p1[r] = __builtin_amdgcn_exp2f(__builtin_fmaf(p1[r], C2, mc)); ps += p1[r]; }
    ps = swapsum(ps);
    l = l * alpha + ps;
    return alpha;
}
#endif
#ifdef MLA_PIPE8
struct MlaPtrs { const bf16* Q; const bf16* K; const bf16* V; const bf16* Z; bf16* O; };
__device__ __forceinline__ void mla_mask(f32x16& p0, f32x16& p1, int dq) {
#pragma unroll
    for (int r = 0; r < 16; ++r) { const int c = (r & 3) + 8 * (r >> 2);
        if (c > dq) p0[r] = -__builtin_inff();
        if (c + 32 > dq) p1[r] = -__builtin_inff(); }
}
__device__ __forceinline__ void mla_unit(LAS unsigned char* lds, const MlaPtrs& P, int head, int qb, int tid_in, int wave, int lane_in) {
    int tid = tid_in; asm volatile("" : "+v"(tid)); const int lane = tid & 63; (void)lane_in;
    const int r32 = lane & 31, hi = lane >> 5;
    const int q0 = qb * 256, qw = q0 + wave * 32, tq = qw + r32;
    i64 q[12];
    { const unsigned char* qp = (const unsigned char*)P.Q + (size_t)tq * 3072 + head * 192 + hi * 8;
#pragma unroll
      for (int d0 = 0; d0 < 12; ++d0) q[d0] = *(const GAS i64*)(qp + d0 * 16); }
    const int NT = 4 * (qb + 1);
    const int srow = tid >> 3, sc8 = tid & 7;
    const unsigned char* kg = (const unsigned char*)P.K + (size_t)head * 192 + (size_t)srow * 3072 + sc8 * 8;
    const unsigned char* vg = (const unsigned char*)P.V + ((size_t)head * 128 + (tid >> 2)) * S + (tid & 3) * 16;
    LAS unsigned char* kst = lds + srow * KS8 + sc8 * 8;
    LAS unsigned char* vst = lds + 2 * MLA_KB8 + (tid >> 2) * VS8 + (tid & 3) * 16;
    const LAS unsigned char* kl = lds + r32 * KS8 + hi * 8;
    const LAS unsigned char* vl = lds + 2 * MLA_KB8 + r32 * VS8 + hi * 8;
    u32x2 sk0, sk1, sk2; u32x4 sv0;
#define MLA_LOADK(j) do { const unsigned char* kp_ = kg + (size_t)(j) * (64 * 3072); sk0 = *(const GAS u32x2*)(kp_); sk1 = *(const GAS u32x2*)(kp_ + 64); sk2 = *(const GAS u32x2*)(kp_ + 128); } while (0)
#define MLA_LOADV(j) do { sv0 = *(const GAS u32x4*)(vg + (size_t)(j) * 64); } while (0)
#define MLA_STOREK(b) do { LAS unsigned char* kd_ = kst + (b) * MLA_KB8; *(LAS u32x2*)(kd_) = sk0; *(LAS u32x2*)(kd_ + 64) = sk1; *(LAS u32x2*)(kd_ + 128) = sk2; } while (0)
#define MLA_STOREV(b) do { LAS unsigned char* vd_ = vst + (b) * VB8; *(LAS u32x2*)(vd_) = (u32x2){sv0.x, sv0.y}; *(LAS u32x2*)(vd_ + 8) = (u32x2){sv0.z, sv0.w}; } while (0)
    float m = -1e30f, l = 0.f; f32x16 o[4];
#pragma unroll
    for (int d = 0; d < 4; ++d)
#pragma unroll
        for (int r = 0; r < 16; ++r) o[d][r] = 0.f;
    f32x16 pA0, pA1, pB0, pB1;
    MLA_LOADK(0); MLA_LOADV(0); MLA_STOREK(0); MLA_STOREV(0);
    MLA_LOADK(1);
    __syncthreads();
    qk_tile8<12>(pA0, pA1, kl, q);
    if (63 > qw) mla_mask(pA0, pA1, tq - 4 * hi);
    MLA_STOREK(1);
    if (2 < NT) MLA_LOADK(2);
    MLA_LOADV(1);
    __syncthreads();
#define MLA_SGB1() do { __builtin_amdgcn_sched_group_barrier(0x100, 2, 0); __builtin_amdgcn_sched_group_barrier(0x008, 1, 0); __builtin_amdgcn_sched_group_barrier(0x002, 6, 0); \
        __builtin_amdgcn_sched_group_barrier(0x008, 1, 0); __builtin_amdgcn_sched_group_barrier(0x002, 6, 0); } while (0)
#define MLA_SGB() do { MLA_SGB1(); MLA_SGB1(); MLA_SGB1(); MLA_SGB1(); MLA_SGB1(); MLA_SGB1(); MLA_SGB1(); MLA_SGB1(); MLA_SGB1(); MLA_SGB1(); MLA_SGB1(); MLA_SGB1(); } while (0)
#define MLA_STEP(PX0, PX1, PY0, PY1, j) do { \
        const int kb1_ = 64 * ((j) + 1); \
        const bool a1_ = ((j) + 1 < NT) && (kb1_ <= qw + 31), a0_ = (64 * (j) <= qw + 31); \
        float alpha_ = 1.f; i64 pb_[4]; \
        if (a1_) { \
            __builtin_amdgcn_sched_barrier(0); \
            qk_tile8_free<12>(PY0, PY1, kl + (((j) + 1) & 1) * MLA_KB8, q); \
            alpha_ = sm_core_scaled(PX0, PX1, m, l, QS_MLA); \
            pb_[0] = packp8<0>(PX0); pb_[1] = packp8<1>(PX0); pb_[2] = packp8<0>(PX1); pb_[3] = packp8<1>(PX1); \
            MLA_SGB(); \
            __builtin_amdgcn_sched_barrier(0); \
            if (kb1_ + 63 > qw) mla_mask(PY0, PY1, tq - kb1_ - 4 * hi); \
        } else if (a0_) { \
            alpha_ = sm_core_scaled(PX0, PX1, m, l, QS_MLA); \
            pb_[0] = packp8<0>(PX0); pb_[1] = packp8<1>(PX0); pb_[2] = packp8<0>(PX1); pb_[3] = packp8<1>(PX1); \
        } \
        if (a0_) { \
            if (!__all(alpha_ == 1.f)) { _Pragma("unroll") for (int d_ = 0; d_ < 4; ++d_) _Pragma("unroll") for (int r_ = 0; r_ < 16; ++r_) o[d_][r_] *= alpha_; } \
            pv_tile8(o, pb_, vl + ((j) & 1) * VB8); \
        } \
        if ((j) + 2 < NT) MLA_STOREK((j) & 1); \
        if ((j) + 1 < NT) MLA_STOREV(((j) + 1) & 1); \
        if ((j) + 3 < NT) MLA_LOADK((j) + 3); \
        if ((j) + 2 < NT) MLA_LOADV((j) + 2); \
        __syncthreads(); } while (0)
    for (int j = 0; j < NT; j += 2) {
        MLA_STEP(pA0, pA1, pB0, pB1, j);
        MLA_STEP(pB0, pB1, pA0, pA1, j + 1);
    }
#undef MLA_STEP
#undef MLA_SGB
#undef MLA_SGB1
#undef MLA_LOADK
#undef MLA_LOADV
#undef MLA_STOREK
#undef MLA_STOREV
    const float inv = (1.f / 256.f) / l;
    const bf16* zp = P.Z + (size_t)tq * 2048 + head * 128 + 4 * hi;
    bf16* op = P.O + (size_t)tq * 4096 + head * 128 + 4 * hi;
#pragma unroll
    for (int d0 = 0; d0 < 4; ++d0)
#pragma unroll
        for (int rg = 0; rg < 4; ++rg) { const int dim = 32 * d0 + 8 * rg;
            const u32x2 z = *(const GAS u32x2*)(zp + dim);
            u32x2 w; w.x = pk2(o[d0][4 * rg + 0] * inv * bflo(z.x), o[d0][4 * rg + 1] * inv * bfhi(z.x)); w.y = pk2(o[d0][4 * rg + 2] * inv * bflo(z.y), o[d0][4 * rg + 3] * inv * bfhi(z.y));
            *(GAS u32x2*)(op + dim) = w; }
}
#elif defined(MLA_PIPE)
struct MlaPtrs { const bf16* Q; const bf16* K; const bf16* V; const bf16* Z; bf16* O; };
__device__ __forceinline__ void mla_mask(f32x16& p0, f32x16& p1, int dq) {
#pragma unroll
    for (int r = 0; r < 16; ++r) { const int c = (r & 3) + 8 * (r >> 2);
        if (c > dq) p0[r] = -__builtin_inff();
        if (c + 32 > dq) p1[r] = -__builtin_inff(); }
}
__device__ __forceinline__ void mla_unit(LAS unsigned char* lds, const MlaPtrs& P, int head, int qb, int tid_in, int wave, int lane_in) {
    int tid = tid_in; asm volatile("" : "+v"(tid)); const int lane = tid & 63; (void)lane_in;
    const int r32 = lane & 31, hi = lane >> 5;
    const int q0 = qb * 256, qw = q0 + wave * 32, tq = qw + r32;
    bf16x8 q[8];
    LAS unsigned char* ql = lds + MLA_QL + wave * 4096 + lane * 16;
    { const bf16* qp = P.Q + (size_t)tq * 3072 + head * 192 + hi * 8;
#pragma unroll
      for (int d0 = 0; d0 < 8; ++d0) q[d0] = *(const GAS bf16x8*)(qp + d0 * 16);
#pragma unroll
      for (int d0 = 8; d0 < 12; ++d0) *(LAS bf16x8*)(ql + (d0 - 8) * 1024) = *(const GAS bf16x8*)(qp + d0 * 16); }
    const int NT = 4 * (qb + 1);
    const int srow = tid >> 3, sc8 = tid & 7;
    const unsigned char* kg = (const unsigned char*)P.K + (size_t)head * 384 + (size_t)srow * 6144 + sc8 * 16;
    const unsigned char* vg = (const unsigned char*)P.V + (size_t)head * 256 + (size_t)srow * 4096 + sc8 * 16;
    LAS unsigned char* kst = lds + srow * KS_M + sc8 * 16;
    LAS unsigned char* vst = lds + 2 * MLA_KB + srow * VS + sc8 * 16;
    const LAS unsigned char* kl = lds + r32 * KS_M + hi * 16;
    const LAS unsigned char* vl = lds + 2 * MLA_KB + (4 * hi + ((lane & 15) >> 2)) * VS + (16 * ((lane >> 4) & 1) + 4 * (lane & 3)) * 2;
    u32x4 sk0, sk1, sk2, sv0, sv1;
#define MLA_LOADK(j) do { const unsigned char* kp_ = kg + (size_t)(j) * (64 * 6144); sk0 = *(const GAS u32x4*)(kp_); sk1 = *(const GAS u32x4*)(kp_ + 128); sk2 = *(const GAS u32x4*)(kp_ + 256); } while (0)
#define MLA_LOADV(j) do { const unsigned char* vp_ = vg + (size_t)(j) * (64 * 4096); sv0 = *(const GAS u32x4*)(vp_); sv1 = *(const GAS u32x4*)(vp_ + 128); } while (0)
#define MLA_STOREK(b) do { LAS unsigned char* kd_ = kst + (b) * MLA_KB; *(LAS u32x4*)(kd_) = sk0; *(LAS u32x4*)(kd_ + 128) = sk1; *(LAS u32x4*)(kd_ + 256) = sk2; } while (0)
#define MLA_STOREV(b) do { LAS unsigned char* vd_ = vst + (b) * VB; *(LAS u32x4*)(vd_) = sv0; *(LAS u32x4*)(vd_ + 128) = sv1; } while (0)
    float m = -1e30f, l = 0.f; f32x16 o[4];
#pragma unroll
    for (int d = 0; d < 4; ++d)
#pragma unroll
        for (int r = 0; r < 16; ++r) o[d][r] = 0.f;
    f32x16 pA0, pA1, pB0, pB1;
    MLA_LOADK(0); MLA_LOADV(0); MLA_STOREK(0); MLA_STOREV(0);
    MLA_LOADK(1);
    __syncthreads();
    qk_tile_free<12, 8, KS_M>(pA0, pA1, kl, q, ql);
    if (63 > qw) mla_mask(pA0, pA1, tq - 4 * hi);
    MLA_STOREK(1);
    if (2 < NT) MLA_LOADK(2);
    MLA_LOADV(1);
    __syncthreads();
#define MLA_SGB1(NR) do { __builtin_amdgcn_sched_group_barrier(0x100, NR, 0); __builtin_amdgcn_sched_group_barrier(0x008, 1, 0); __builtin_amdgcn_sched_group_barrier(0x002, 6, 0); \
        __builtin_amdgcn_sched_group_barrier(0x008, 1, 0); __builtin_amdgcn_sched_group_barrier(0x002, 6, 0); } while (0)
#define MLA_SGB() do { MLA_SGB1(2); MLA_SGB1(2); MLA_SGB1(2); MLA_SGB1(2); MLA_SGB1(2); MLA_SGB1(2); MLA_SGB1(2); MLA_SGB1(2); MLA_SGB1(3); MLA_SGB1(3); MLA_SGB1(3); MLA_SGB1(3); } while (0)
#define MLA_STEP(PX0, PX1, PY0, PY1, j) do { \
        const int kb1_ = 64 * ((j) + 1); \
        const bool a1_ = ((j) + 1 < NT) && (kb1_ <= qw + 31), a0_ = (64 * (j) <= qw + 31); \
        float alpha_ = 1.f; bf16x8 pb_[4]; \
        if (a1_) { \
            __builtin_amdgcn_sched_barrier(0); \
            qk_tile_free<12, 8, KS_M>(PY0, PY1, kl + (((j) + 1) & 1) * MLA_KB, q, ql); \
            alpha_ = sm_core(PX0, PX1, m, l); \
            pb_[0] = packp<0>(PX0); pb_[1] = packp<1>(PX0); pb_[2] = packp<0>(PX1); pb_[3] = packp<1>(PX1); \
            MLA_SGB(); \
            __builtin_amdgcn_sched_barrier(0); \
            if (kb1_ + 63 > qw) mla_mask(PY0, PY1, tq - kb1_ - 4 * hi); \
        } else if (a0_) { \
            alpha_ = sm_core(PX0, PX1, m, l); \
            pb_[0] = packp<0>(PX0); pb_[1] = packp<1>(PX0); pb_[2] = packp<0>(PX1); pb_[3] = packp<1>(PX1); \
        } \
        if (a0_) { \
            if (!__all(alpha_ == 1.f)) { _Pragma("unroll") for (int d_ = 0; d_ < 4; ++d_) _Pragma("unroll") for (int r_ = 0; r_ < 16; ++r_) o[d_][r_] *= alpha_; } \
            pv_tile(o, pb_, vl + ((j) & 1) * VB); \
        } \
        if ((j) + 2 < NT) MLA_STOREK((j) & 1); \
        if ((j) + 1 < NT) MLA_STOREV(((j) + 1) & 1); \
        if ((j) + 3 < NT) MLA_LOADK((j) + 3); \
        if ((j) + 2 < NT) MLA_LOADV((j) + 2); \
        __syncthreads(); } while (0)
    for (int j = 0; j < NT; j += 2) {
        MLA_STEP(pA0, pA1, pB0, pB1, j);
        MLA_STEP(pB0, pB1, pA0, pA1, j + 1);
    }
#undef MLA_STEP
#undef MLA_SGB
#undef MLA_SGB1
#undef MLA_LOADK
#undef MLA_LOADV
#undef MLA_STOREK
#undef MLA_STOREV
    const float inv = 1.f / l;
    const bf16* zp = P.Z + (size_t)tq * 2048 + head * 128 + 4 * hi;
    bf16* op = P.O + (size_t)tq * 4096 + head * 128 + 4 * hi;
#pragma unroll
    for (int d0 = 0; d0 < 4; ++d0)
#pragma unroll
        for (int rg = 0; rg < 4; ++rg) { const int dim = 32 * d0 + 8 * rg;
            const u32x2 z = *(const GAS u32x2*)(zp + dim);
            u32x2 w; w.x = pk2(o[d0][4 * rg + 0] * inv * bflo(z.x), o[d0][4 * rg + 1] * inv * bfhi(z.x)); w.y = pk2(o[d0][4 * rg + 2] * inv * bflo(z.y), o[d0][4 * rg + 3] * inv * bfhi(z.y));
            *(GAS u32x2*)(op + dim) = w; }
}

#else
#if defined(MLA_MXQ)
struct MlaPtrs { const bf16* Q; const bf16* K; const bf16* V; const bf16* Z; bf16* O; };
constexpr int VBQ = 160 * VSX;
static_assert(2 * MLA_KBX + 2 * VBQ <= 131072, "MLA mxq LDS map");
__device__ __forceinline__ void mla_maskq(f32x16& p0, f32x16& p1, int dq) {
#pragma unroll
    for (int r = 0; r < 16; ++r) { const int c = (r & 3) + 8 * (r >> 2);
        if (c > dq) p0[r] = -__builtin_inff();
        if (c + 32 > dq) p1[r] = -__builtin_inff(); }
}
__device__ __forceinline__ float mla_rowmaxq(const f32x16& p0, const f32x16& p1) {
    float tm = p0[0];
#pragma unroll
    for (int r = 1; r < 16; ++r) tm = fmaxf(tm, p0[r]);
#pragma unroll
    for (int r = 0; r < 16; ++r) tm = fmaxf(tm, p1[r]);
    return swapmax(tm);
}
__device__ __forceinline__ void mla_unit(LAS unsigned char* lds, const MlaPtrs& P, int head, int qb, int tid_in, int wave, int lane_in) {
    int tid = tid_in; asm volatile("" : "+v"(tid)); const int lane = tid & 63; (void)lane_in;
    const int r32 = lane & 31, hi = lane >> 5;
    const int q0 = qb * 256, qw = q0 + wave * 32, tq = qw + r32;
    i32x8 q[3];
    { const unsigned char* qp = (const unsigned char*)P.Q + (size_t)tq * 3072 + head * 192 + hi * 32;
#pragma unroll
      for (int s = 0; s < 3; ++s) { const u32x4 a = *(const GAS u32x4*)(qp + 64 * s), b = *(const GAS u32x4*)(qp + 64 * s + 16);
          q[s] = (i32x8){(int)a.x, (int)a.y, (int)a.z, (int)a.w, (int)b.x, (int)b.y, (int)b.z, (int)b.w}; } }
    const int NT = 4 * (qb + 1);
    const int srow = tid >> 3, sc8 = tid & 7;
    const unsigned char* kg = (const unsigned char*)P.K + (size_t)head * 192 + (size_t)srow * 3072 + sc8 * 8;
    const unsigned char* vg = (const unsigned char*)P.V + ((size_t)head * 128 + (tid >> 2)) * S + (tid & 3) * 16;
    LAS unsigned char* kst = lds + srow * KSX + sc8 * 8;
    LAS unsigned char* vst = lds + 2 * MLA_KBX + (tid >> 2) * VSX + (tid & 3) * 16;
    const LAS unsigned char* kl = lds + r32 * KSX + hi * 32;
    const LAS unsigned char* vl = lds + 2 * MLA_KBX + r32 * VSX + hi * 32;
    u32x2 sk0, sk1, sk2; u32x4 sv0;
#define MLA_LOADK(j) do { const unsigned char* kp_ = kg + (size_t)(j) * (64 * 3072); sk0 = *(const GAS u32x2*)(kp_); sk1 = *(const GAS u32x2*)(kp_ + 64); sk2 = *(const GAS u32x2*)(kp_ + 128); } while (0)
#define MLA_LOADV(j) do { sv0 = *(const GAS u32x4*)(vg + (size_t)(j) * 64); } while (0)
#define MLA_STOREK(b) do { LAS unsigned char* kd_ = kst + (b) * MLA_KBX; *(LAS u32x2*)(kd_) = sk0; *(LAS u32x2*)(kd_ + 64) = sk1; *(LAS u32x2*)(kd_ + 128) = sk2; } while (0)
#define MLA_STOREV(b) do { LAS unsigned char* vd_ = vst + (b) * VBQ; *(LAS u32x2*)(vd_) = (u32x2){sv0.x, sv0.y}; *(LAS u32x2*)(vd_ + 8) = (u32x2){sv0.z, sv0.w}; } while (0)
    f32x16 o[5], mref;
#pragma unroll
    for (int d = 0; d < 5; ++d)
#pragma unroll
        for (int r = 0; r < 16; ++r) o[d][r] = 0.f;
#pragma unroll
    for (int r = 0; r < 16; ++r) mref[r] = MXL_REF;
    f32x16 p0, p1;
    if (tid < 256) { const int slot = tid >> 7, row = (tid >> 2) & 31, ch = tid & 3; const unsigned v1 = (row == 0 || row == 4) ? 0x38383838u : 0u;
        *(LAS u32x4*)(lds + 2 * MLA_KBX + slot * VBQ + (128 + row) * VSX + ch * 16) = (u32x4){v1, v1, v1, v1}; }
    MLA_LOADK(0); MLA_LOADV(0); MLA_STOREK(0); MLA_STOREV(0);
    MLA_LOADK(1);
    __syncthreads();
    qk_tilexl(p0, p1, mref, kl, q);
    if (63 > qw) mla_maskq(p0, p1, tq - 4 * hi);
    { const float dlt = mla_rowmaxq(p0, p1) - MXL_REF;
#pragma unroll
      for (int r = 0; r < 16; ++r) { p0[r] -= dlt; p1[r] -= dlt; mref[r] -= dlt; } }
    i32x8 pbA = byte_packx(p0, p1), pbB = pbA;
    MLA_STOREK(1);
    if (2 < NT) MLA_LOADK(2);
    MLA_LOADV(1);
    __syncthreads();
    asm volatile("" : "+v"(q[0]), "+v"(q[1]), "+v"(q[2]));
    int sc1_ = 0x7f7f7f7f; asm volatile("" : "+v"(sc1_));
#define SB() __builtin_amdgcn_sched_barrier(0)
#define MFMA_T(acc, a, b) asm volatile("s_nop 1\n\tv_mfma_scale_f32_32x32x64_f8f6f4 %0, %1, %2, %0, %3, %3 op_sel_hi:[0,0,0]" : "+v"(acc) : "v"(a), "v"(b), "v"(sc1_))
#define MFMA_C(acc, a, b, c) asm volatile("s_nop 1\n\tv_mfma_scale_f32_32x32x64_f8f6f4 %0, %1, %2, %3, %4, %4 op_sel_hi:[0,0,0]" : "=&v"(acc) : "v"(a), "v"(b), "v"(c), "v"(sc1_))
#define CVT8(P, R0, PB, W0) do { unsigned w_ = __builtin_amdgcn_cvt_pk_u8_f32(P[(R0) + 0], 0, 0u); w_ = __builtin_amdgcn_cvt_pk_u8_f32(P[(R0) + 1], 1, w_); w_ = __builtin_amdgcn_cvt_pk_u8_f32(P[(R0) + 2], 2, w_); \
        w_ = __builtin_amdgcn_cvt_pk_u8_f32(P[(R0) + 3], 3, w_); PB[(W0)] = (int)w_; \
        w_ = __builtin_amdgcn_cvt_pk_u8_f32(P[(R0) + 4], 0, 0u); w_ = __builtin_amdgcn_cvt_pk_u8_f32(P[(R0) + 5], 1, w_); w_ = __builtin_amdgcn_cvt_pk_u8_f32(P[(R0) + 6], 2, w_); \
        w_ = __builtin_amdgcn_cvt_pk_u8_f32(P[(R0) + 7], 3, w_); PB[(W0) + 1] = (int)w_; } while (0)
#define MLA_STEP(PBX, PBY, j) do { \
        const int kb1_ = 64 * ((j) + 1); \
        if (64 * (j) <= qw + 31) { \
            const LAS unsigned char* kn_ = kl + (((j) + 1) & 1) * MLA_KBX; const LAS unsigned char* vj_ = vl + ((j) & 1) * VBQ; \
            SB(); \
            i32x8 a0_f = ldsx(kn_), a1_f = ldsx(kn_ + 32 * KSX); \
            SB(); MFMA_C(p0, a0_f, q[0], mref); SB(); \
            a0_f = ldsx(kn_ + 64); \
            SB(); MFMA_C(p1, a1_f, q[0], mref); SB(); \
            a1_f = ldsx(kn_ + 32 * KSX + 64); \
            SB(); MFMA_T(p0, a0_f, q[1]); SB(); \
            a0_f = ldsx(kn_ + 128); \
            SB(); MFMA_T(p1, a1_f, q[1]); SB(); \
            a1_f = ldsx(kn_ + 32 * KSX + 128); \
            SB(); MFMA_T(p0, a0_f, q[2]); SB(); \
            a0_f = ldsx(vj_ + 128 * VSX); \
            SB(); MFMA_T(p1, a1_f, q[2]); SB(); \
            a1_f = ldsx(vj_); \
            SB(); MFMA_T(o[4], a0_f, PBX); SB(); \
            a0_f = ldsx(vj_ + 32 * VSX); \
            SB(); MFMA_T(o[0], a1_f, PBX); SB(); \
            a1_f = ldsx(vj_ + 64 * VSX); \
            float tmx_ = p0[0]; _Pragma("unroll") for (int r_ = 1; r_ < 16; ++r_) tmx_ = fmaxf(tmx_, p0[r_]); \
            CVT8(p0, 0, PBY, 0); CVT8(p0, 8, PBY, 2); \
            SB(); MFMA_T(o[1], a0_f, PBX); SB(); \
            a0_f = ldsx(vj_ + 96 * VSX); \
            _Pragma("unroll") for (int r_ = 0; r_ < 16; ++r_) tmx_ = fmaxf(tmx_, p1[r_]); \
            CVT8(p1, 0, PBY, 4); \
            SB(); MFMA_T(o[2], a1_f, PBX); SB(); \
            CVT8(p1, 8, PBY, 6); tmx_ = swapmax(tmx_); \
            SB(); MFMA_T(o[3], a0_f, PBX); SB(); \
            const bool diag_ = kb1_ + 63 > qw; \
            if (diag_ || !__all(tmx_ <= MXL_T)) {               \
                asm volatile("s_nop 15\n\ts_nop 15\n\ts_nop 15" ::: "memory");     \
                if (diag_) mla_maskq(p0, p1, tq - kb1_ - 4 * hi); \
                const float dlt_ = fmaxf(mla_rowmaxq(p0, p1) - MXL_REF, 0.f); const float alpha_ = __builtin_amdgcn_exp2f(-0.125f * dlt_); \
                _Pragma("unroll") for (int r_ = 0; r_ < 16; ++r_) { p0[r_] -= dlt_; p1[r_] -= dlt_; mref[r_] -= dlt_; } \
                _Pragma("unroll") for (int d_ = 0; d_ < 5; ++d_) _Pragma("unroll") for (int r_ = 0; r_ < 16; ++r_) o[d_][r_] *= alpha_; \
                PBY = byte_packx(p0, p1); } \
        } \
        if ((j) + 2 < NT) MLA_STOREK((j) & 1); \
        if ((j) + 1 < NT) MLA_STOREV(((j) + 1) & 1); \
        if ((j) + 3 < NT) MLA_LOADK((j) + 3); \
        if ((j) + 2 < NT) MLA_LOADV((j) + 2); \
        __syncthreads(); } while (0)
    for (int j = 0; j < NT; j += 2) {
        MLA_STEP(pbA, pbB, j);
        MLA_STEP(pbB, pbA, j + 1);
    }
    asm volatile("s_nop 15\n\ts_nop 15" ::: "memory");
#undef MLA_STEP
#undef CVT8
#undef MFMA_T
#undef MFMA_C
#undef SB
#undef MLA_LOADK
#undef MLA_LOADV
#undef MLA_STOREK
#undef MLA_STOREV
    const float inv = 1.f / o[4][0];
    const bf16* zp = P.Z + (size_t)tq * 2048 + head * 128 + 4 * hi;
    bf16* op = P.O + (size_t)tq * 4096 + head * 128 + 4 * hi;
#pragma unroll
    for (int d0 = 0; d0 < 4; ++d0)
#pragma unroll
        for (int rg = 0; rg < 4; ++rg) { const int dim = 32 * d0 + 8 * rg;
            const u32x2 z = *(const GAS u32x2*)(zp + dim);
            u32x2 w; w.x = pk2(o[d0][4 * rg + 0] * inv * bflo(z.x), o[d0][4 * rg + 1] * inv * bfhi(z.x)); w.y = pk2(o[d0][4 * rg + 2] * inv * bflo(z.y), o[d0][4 * rg + 3] * inv * bfhi(z.y));
            *(GAS u32x2*)(op + dim) = w; }
}

#elif defined(MLA_BIGX)
struct MlaPtrs { const bf16* Q; const bf16* K; const bf16* V; const bf16* Z; bf16* O; };
__device__ __forceinline__ void mla_unit(LAS unsigned char* lds, const MlaPtrs& P, int head, int qb, int tid_in, int wave, int lane_in) {
    int tid = tid_in; asm volatile("" : "+v"(tid)); const int lane = tid & 63; (void)lane_in;
    const int r32 = lane & 31, hi = lane >> 5;
    const int q0 = qb * 256, qw = q0 + wave * 32, tq = qw + r32;
    i32x8 q[3];
    { const unsigned char* qp = (const unsigned char*)P.Q + (size_t)tq * 3072 + head * 192 + hi * 32;
#pragma unroll
      for (int s = 0; s < 3; ++s) { const u32x4 a = *(const GAS u32x4*)(qp + 64 * s), b = *(const GAS u32x4*)(qp + 64 * s + 16);
          q[s] = (i32x8){(int)a.x, (int)a.y, (int)a.z, (int)a.w, (int)b.x, (int)b.y, (int)b.z, (int)b.w}; } }
    const int NT = 4 * (qb + 1), NTB = NT / 2;
    constexpr int VSB = 144, VBB = 128 * VSB, KBB = 128 * KSX;
    static_assert(2 * KBB + 3 * VBB <= 131072, "MLA big-tile LDS map");
    const int srow = tid >> 3, sc8 = tid & 7;
    const unsigned char* kg = (const unsigned char*)P.K + (size_t)head * 192 + (size_t)srow * 3072 + sc8 * 8;
    const unsigned char* vg = (const unsigned char*)P.V + ((size_t)head * 128 + (tid >> 2)) * S + (tid & 3) * 32;
    LAS unsigned char* kst = lds + srow * KSX + sc8 * 8;
    LAS unsigned char* vst = lds + 2 * KBB + (tid >> 2) * VSB + (tid & 3) * 32;
    const LAS unsigned char* kl = lds + r32 * KSX + hi * 32;
    const LAS unsigned char* vl = lds + 2 * KBB + r32 * VSB + hi * 32;
    u32x2 sk0, sk1, sk2, sk3, sk4, sk5; u32x4 sv0, sv1;
#define MLA_LOAD(J) do { const unsigned char* kp_ = kg + (size_t)(J) * (128 * 3072); const unsigned char* vp_ = vg + (size_t)(J) * 128; \
        sk0 = *(const GAS u32x2*)(kp_); sk1 = *(const GAS u32x2*)(kp_ + 64); sk2 = *(const GAS u32x2*)(kp_ + 128); \
        sk3 = *(const GAS u32x2*)(kp_ + 64 * 3072); sk4 = *(const GAS u32x2*)(kp_ + 64 * 3072 + 64); sk5 = *(const GAS u32x2*)(kp_ + 64 * 3072 + 128); \
        sv0 = *(const GAS u32x4*)(vp_); sv1 = *(const GAS u32x4*)(vp_ + 16); } while (0)
#define MLA_STORE(b, vb) do { LAS unsigned char* kd_ = kst + (b) * KBB; LAS unsigned char* vd_ = vst + (vb) * VBB; \
        *(LAS u32x2*)(kd_) = sk0; *(LAS u32x2*)(kd_ + 64) = sk1; *(LAS u32x2*)(kd_ + 128) = sk2; \
        *(LAS u32x2*)(kd_ + 64 * KSX) = sk3; *(LAS u32x2*)(kd_ + 64 * KSX + 64) = sk4; *(LAS u32x2*)(kd_ + 64 * KSX + 128) = sk5; \
        *(LAS u32x2*)(vd_) = (u32x2){sv0.x, sv0.y}; *(LAS u32x2*)(vd_ + 8) = (u32x2){sv0.z, sv0.w}; *(LAS u32x2*)(vd_ + 16) = (u32x2){sv1.x, sv1.y}; *(LAS u32x2*)(vd_ + 24) = (u32x2){sv1.z, sv1.w}; } while (0)
    MLA_LOAD(0); MLA_STORE(0, 0);
    __syncthreads();
    asm volatile("" : "+v"(q[0]), "+v"(q[1]), "+v"(q[2]));
    f32x16 o[5], mref;
#pragma unroll
    for (int d = 0; d < 5; ++d)
#pragma unroll
        for (int r = 0; r < 16; ++r) o[d][r] = 0.f;
#pragma unroll
    for (int r = 0; r < 16; ++r) mref[r] = MXL_REF;
    const int one8 = (r32 == 0 || r32 == 4) ? 0x38383838 : 0;
    const i32x8 ones = {one8, one8, one8, one8, one8, one8, one8, one8};
    const bool trail = wave >= 4;
    i32x8 pb = {};
    int vb_cur = 0, vb_prev = 2;
    for (int J = 0; J < NTB; ++J) {
        int vb_next = vb_cur + 1; if (vb_next == 3) vb_next = 0;
        if (J + 1 < NTB) MLA_LOAD(J + 1);
#pragma unroll
        for (int sub = 0; sub < 2; ++sub) {
        const int j = 2 * J + sub, kb = 64 * j;
        if (trail && j > 0 && kb - 64 <= qw + 31) pv_tilexl<VSB>(o, pb, ones, vl + (sub == 0 ? vb_prev * VBB + 64 : vb_cur * VBB));
        if (kb <= qw + 31) {
            f32x16 p0, p1;
            qk_tilexl(p0, p1, mref, kl + (J & 1) * KBB + sub * 64 * KSX, q);
            if (kb + 63 > qw) {
                const int dq = tq - kb - 4 * hi;
#pragma unroll
                for (int r = 0; r < 16; ++r) { const int c = (r & 3) + 8 * (r >> 2);
                    if (c > dq) p0[r] = -__builtin_inff();
                    if (c + 32 > dq) p1[r] = -__builtin_inff(); }
            }
            float tm = p0[0];
#pragma unroll
            for (int r = 1; r < 16; ++r) tm = fmaxf(tm, p0[r]);
#pragma unroll
            for (int r = 0; r < 16; ++r) tm = fmaxf(tm, p1[r]);
            tm = swapmax(tm);
            if (j == 0 || !__all(tm <= MXL_T)) {
                const float dlt = (j == 0) ? tm - MXL_REF : fmaxf(tm - MXL_REF, 0.f);
                const float alpha = __builtin_amdgcn_exp2f(-0.125f * dlt);
#pragma unroll
                for (int r = 0; r < 16; ++r) { p0[r] -= dlt; p1[r] -= dlt; mref[r] -= dlt; }
                if (j > 0) {
#pragma unroll
                    for (int d = 0; d < 5; ++d)
#pragma unroll
                        for (int r = 0; r < 16; ++r) o[d][r] *= alpha;
                }
            }
            pb = byte_packx(p0, p1);
            if (!trail) pv_tilexl<VSB>(o, pb, ones, vl + vb_cur * VBB + sub * 64);
        }
        }
        if (J + 1 < NTB) MLA_STORE((J + 1) & 1, vb_next);
        __syncthreads();
        vb_prev = vb_cur; vb_cur = vb_next;
    }
    if (trail && 64 * (NT - 1) <= qw + 31) pv_tilexl<VSB>(o, pb, ones, vl + vb_prev * VBB + 64);
    __syncthreads();
#undef MLA_LOAD
#undef MLA_STORE
    const float inv = 1.f / o[4][0];
    const bf16* zp = P.Z + (size_t)tq * 2048 + head * 128 + 4 * hi;
    bf16* op = P.O + (size_t)tq * 4096 + head * 128 + 4 * hi;
#pragma unroll
    for (int d0 = 0; d0 < 4; ++d0)
#pragma unroll
        for (int rg = 0; rg < 4; ++rg) { const int dim = 32 * d0 + 8 * rg;
            const u32x2 z = *(const GAS u32x2*)(zp + dim);
            u32x2 w; w.x = pk2(o[d0][4 * rg + 0] * inv * bflo(z.x), o[d0][4 * rg + 1] * inv * bfhi(z.x)); w.y = pk2(o[d0][4 * rg + 2] * inv * bflo(z.y), o[d0][4 * rg + 3] * inv * bfhi(z.y));
            *(GAS u32x2*)(op + dim) = w; }
}

#elif defined(MLA_MXL)
struct MlaPtrs { const bf16* Q; const bf16* K; const bf16* V; const bf16* Z; bf16* O; };
__device__ __forceinline__ void mla_unit(LAS unsigned char* lds, const MlaPtrs& P, int head, int qb, int tid_in, int wave, int lane_in) {
    int tid = tid_in; asm volatile("" : "+v"(tid)); const int lane = tid & 63; (void)lane_in;
    const int r32 = lane & 31, hi = lane >> 5;
    const int q0 = qb * 256, qw = q0 + wave * 32, tq = qw + r32;
    i32x8 q[3];
    { const unsigned char* qp = (const unsigned char*)P.Q + (size_t)tq * 3072 + head * 192 + hi * 32;
#pragma unroll
      for (int s = 0; s < 3; ++s) { const u32x4 a = *(const GAS u32x4*)(qp + 64 * s), b = *(const GAS u32x4*)(qp + 64 * s + 16);
          q[s] = (i32x8){(int)a.x, (int)a.y, (int)a.z, (int)a.w, (int)b.x, (int)b.y, (int)b.z, (int)b.w}; } }
    const int NT = 4 * (qb + 1);
    const int srow = tid >> 3, sc8 = tid & 7;
    const unsigned char* kg = (const unsigned char*)P.K + (size_t)head * 192 + (size_t)srow * 3072 + sc8 * 8;
    const unsigned char* vg = (const unsigned char*)P.V + ((size_t)head * 128 + (tid >> 2)) * S + (tid & 3) * 16;
    LAS unsigned char* kst = lds + srow * KSX + sc8 * 8;
    LAS unsigned char* vst = lds + 2 * MLA_KBX + (tid >> 2) * VSX + (tid & 3) * 16;
    const LAS unsigned char* kl = lds + r32 * KSX + hi * 32;
    const LAS unsigned char* vl = lds + 2 * MLA_KBX + r32 * VSX + hi * 32;
    u32x2 sk0, sk1, sk2; u32x4 sv0;
#define MLA_LOAD(j) do { const unsigned char* kp_ = kg + (size_t)(j) * (64 * 3072); const unsigned char* vp_ = vg + (size_t)(j) * 64; \
        sk0 = *(const GAS u32x2*)(kp_); sk1 = *(const GAS u32x2*)(kp_ + 64); sk2 = *(const GAS u32x2*)(kp_ + 128); sv0 = *(const GAS u32x4*)(vp_); } while (0)
#define MLA_STORE(b, vb) do { LAS unsigned char* kd_ = kst + (b) * MLA_KBX; LAS unsigned char* vd_ = vst + (vb) * VBX; \
        *(LAS u32x2*)(kd_) = sk0; *(LAS u32x2*)(kd_ + 64) = sk1; *(LAS u32x2*)(kd_ + 128) = sk2; *(LAS u32x2*)(vd_) = (u32x2){sv0.x, sv0.y}; *(LAS u32x2*)(vd_ + 8) = (u32x2){sv0.z, sv0.w}; } while (0)
    MLA_LOAD(0); MLA_STORE(0, 0);
    __syncthreads();
    asm volatile("" : "+v"(q[0]), "+v"(q[1]), "+v"(q[2]));
    f32x16 o[5], mref;
#pragma unroll
    for (int d = 0; d < 5; ++d)
#pragma unroll
        for (int r = 0; r < 16; ++r) o[d][r] = 0.f;
#pragma unroll
    for (int r = 0; r < 16; ++r) mref[r] = MXL_REF;
    const int one8 = (r32 == 0 || r32 == 4) ? 0x38383838 : 0;
    const i32x8 ones = {one8, one8, one8, one8, one8, one8, one8, one8};
    const bool trail = wave >= 4;
    i32x8 pb = {}, fa = {}, fb = {};
    int vb_cur = 0, vb_prev = 2;
    for (int j = 0; j < NT; ++j) {
        const int kb = 64 * j;
        int vb_next = vb_cur + 1; if (vb_next == 3) vb_next = 0;
        if (j + 1 < NT) MLA_LOAD(j + 1);
        if (trail && j > 0 && kb - 64 <= qw + 31) pv_tilexl_pre(o, pb, ones, vl + vb_prev * VBX, fa, fb);
        if (kb <= qw + 31) {
            f32x16 p0, p1;
            qk_tilexl(p0, p1, mref, kl + (j & 1) * MLA_KBX, q);
            fa = ldsx(vl + vb_cur * VBX); fb = ldsx(vl + vb_cur * VBX + 32 * VSX);
            __builtin_amdgcn_sched_barrier(0);
            if (kb + 63 > qw) {
                const int dq = tq - kb - 4 * hi;
#pragma unroll
                for (int r = 0; r < 16; ++r) { const int c = (r & 3) + 8 * (r >> 2);
                    if (c > dq) p0[r] = -__builtin_inff();
                    if (c + 32 > dq) p1[r] = -__builtin_inff(); }
            }
            float tm = p0[0];
#pragma unroll
            for (int r = 1; r < 16; ++r) tm = fmaxf(tm, p0[r]);
#pragma unroll
            for (int r = 0; r < 16; ++r) tm = fmaxf(tm, p1[r]);
            tm = swapmax(tm);
            if (j == 0 || !__all(tm <= MXL_T)) {
#ifdef MLA_MXU
                const float dlt = (j == 0) ? tm - MXL_REF : fmaxf(tm - MXL_REF, 0.f);
                const float alpha = __builtin_amdgcn_exp2f(-0.125f * dlt);
#else
                const float dlt = (j == 0) ? tm : fmaxf(tm, 0.f);
                const float alpha = __builtin_amdgcn_exp2f(-dlt);
#endif
#pragma unroll
                for (int r = 0; r < 16; ++r) { p0[r] -= dlt; p1[r] -= dlt; mref[r] -= dlt; }
                if (j > 0) {
#pragma unroll
                    for (int d = 0; d < 5; ++d)
#pragma unroll
                        for (int r = 0; r < 16; ++r) o[d][r] *= alpha;
                }
            }
#ifdef MLA_MXU
            pb = byte_packx(p0, p1);
#else
            pb = exp_packx(p0, p1, one8);
#endif
            if (!trail) pv_tilexl_pre(o, pb, ones, vl + vb_cur * VBX, fa, fb);
        }
        if (j + 1 < NT) MLA_STORE((j + 1) & 1, vb_next);
        __syncthreads();
        vb_prev = vb_cur; vb_cur = vb_next;
    }
    if (trail && 64 * (NT - 1) <= qw + 31) pv_tilexl_pre(o, pb, ones, vl + vb_prev * VBX, fa, fb);
    __syncthreads();
#undef MLA_LOAD
#undef MLA_STORE
    const float inv = 1.f / o[4][0];
    const bf16* zp = P.Z + (size_t)tq * 2048 + head * 128 + 4 * hi;
    bf16* op = P.O + (size_t)tq * 4096 + head * 128 + 4 * hi;
#pragma unroll
    for (int d0 = 0; d0 < 4; ++d0)
#pragma unroll
        for (int rg = 0; rg < 4; ++rg) { const int dim = 32 * d0 + 8 * rg;
            const u32x2 z = *(const GAS u32x2*)(zp + dim);
            u32x2 w; w.x = pk2(o[d0][4 * rg + 0] * inv * bflo(z.x), o[d0][4 * rg + 1] * inv * bfhi(z.x)); w.y = pk2(o[d0][4 * rg + 2] * inv * bflo(z.y), o[d0][4 * rg + 3] * inv * bfhi(z.y));
            *(GAS u32x2*)(op + dim) = w; }
}

#elif defined(MLA_MXP)
struct MlaPtrs { const bf16* Q; const bf16* K; const bf16* V; const bf16* Z; bf16* O; };
__device__ __forceinline__ void mla_maskx(f32x16& p0, f32x16& p1, int dq) {
#pragma unroll
    for (int r = 0; r < 16; ++r) { const int c = (r & 3) + 8 * (r >> 2);
        if (c > dq) p0[r] = -__builtin_inff();
        if (c + 32 > dq) p1[r] = -__builtin_inff(); }
}
__device__ __forceinline__ float mla_rowmax(const f32x16& p0, const f32x16& p1) {
    float tm = p0[0];
#pragma unroll
    for (int r = 1; r < 16; ++r) tm = fmaxf(tm, p0[r]);
#pragma unroll
    for (int r = 0; r < 16; ++r) tm = fmaxf(tm, p1[r]);
    return swapmax(tm);
}
#define MXP_EXP8(P, R0) do { _Pragma("unroll") for (int r_ = (R0); r_ < (R0) + 8; ++r_) { P[r_] = __builtin_amdgcn_exp2f(__builtin_fmaf(P[r_], QS_MLA, mc_)); ps_ += P[r_]; } } while (0)
__device__ __forceinline__ void mla_unit(LAS unsigned char* lds, const MlaPtrs& P, int head, int qb, int tid_in, int wave, int lane_in) {
    int tid = tid_in; asm volatile("" : "+v"(tid)); const int lane = tid & 63; (void)lane_in;
    const int r32 = lane & 31, hi = lane >> 5;
    const int q0 = qb * 256, qw = q0 + wave * 32, tq = qw + r32;
    i32x8 q[3];
    { const unsigned char* qp = (const unsigned char*)P.Q + (size_t)tq * 3072 + head * 192 + hi * 32;
#pragma unroll
      for (int s = 0; s < 3; ++s) { const u32x4 a = *(const GAS u32x4*)(qp + 64 * s), b = *(const GAS u32x4*)(qp + 64 * s + 16);
          q[s] = (i32x8){(int)a.x, (int)a.y, (int)a.z, (int)a.w, (int)b.x, (int)b.y, (int)b.z, (int)b.w}; } }
    const int NT = 4 * (qb + 1);
    const int srow = tid >> 3, sc8 = tid & 7;
    const unsigned char* kg = (const unsigned char*)P.K + (size_t)head * 192 + (size_t)srow * 3072 + sc8 * 8;
    const unsigned char* vg = (const unsigned char*)P.V + ((size_t)head * 128 + (tid >> 2)) * S + (tid & 3) * 16;
    LAS unsigned char* kst = lds + srow * KSX + sc8 * 8;
    LAS unsigned char* vst = lds + 2 * MLA_KBX + (tid >> 2) * VSX + (tid & 3) * 16;
    const LAS unsigned char* kl = lds + r32 * KSX + hi * 32;
    const LAS unsigned char* vl = lds + 2 * MLA_KBX + r32 * VSX + hi * 32;
    u32x2 sk0, sk1, sk2; u32x4 sv0;
#define MLA_LOADK(j) do { const unsigned char* kp_ = kg + (size_t)(j) * (64 * 3072); sk0 = *(const GAS u32x2*)(kp_); sk1 = *(const GAS u32x2*)(kp_ + 64); sk2 = *(const GAS u32x2*)(kp_ + 128); } while (0)
#define MLA_LOADV(j) do { sv0 = *(const GAS u32x4*)(vg + (size_t)(j) * 64); } while (0)
#define MLA_STOREK(b) do { LAS unsigned char* kd_ = kst + (b) * MLA_KBX; *(LAS u32x2*)(kd_) = sk0; *(LAS u32x2*)(kd_ + 64) = sk1; *(LAS u32x2*)(kd_ + 128) = sk2; } while (0)
#define MLA_STOREV(b) do { LAS unsigned char* vd_ = vst + (b) * VBX; *(LAS u32x2*)(vd_) = (u32x2){sv0.x, sv0.y}; *(LAS u32x2*)(vd_ + 8) = (u32x2){sv0.z, sv0.w}; } while (0)
    float m = -1e30f, l = 0.f; f32x16 o[4];
#pragma unroll
    for (int d = 0; d < 4; ++d)
#pragma unroll
        for (int r = 0; r < 16; ++r) o[d][r] = 0.f;
    f32x16 pA0, pA1, pB0, pB1;
    MLA_LOADK(0); MLA_LOADV(0); MLA_STOREK(0); MLA_STOREV(0);
    MLA_LOADK(1);
    __syncthreads();
    qk_tilex(pA0, pA1, kl, q);
    if (63 > qw) mla_maskx(pA0, pA1, tq - 4 * hi);
    MLA_STOREK(1);
    if (2 < NT) MLA_LOADK(2);
    MLA_LOADV(1);
    __syncthreads();
    asm volatile("" : "+v"(q[0]), "+v"(q[1]), "+v"(q[2]));
    float tmx = mla_rowmax(pA0, pA1);
#define SB() __builtin_amdgcn_sched_barrier(0)
#define MLA_SMHEAD() const float mn_ = fmaxf(m, tmx); const float alpha_ = __builtin_amdgcn_exp2f((m - mn_) * QS_MLA); m = mn_; const float mc_ = 8.f - mn_ * QS_MLA; float ps_ = 0.f; i32x8 pb_; \
            if (!__all(alpha_ == 1.f)) { _Pragma("unroll") for (int d_ = 0; d_ < 4; ++d_) _Pragma("unroll") for (int r_ = 0; r_ < 16; ++r_) o[d_][r_] *= alpha_; }
#define MXP_EXPK(P, R0, W0) do { MXP_EXP8(P, R0); \
        int w_ = __builtin_amdgcn_cvt_pk_fp8_f32(P[(R0) + 0], P[(R0) + 1], 0, false); pb_[(W0)] = __builtin_amdgcn_cvt_pk_fp8_f32(P[(R0) + 2], P[(R0) + 3], w_, true); \
        w_ = __builtin_amdgcn_cvt_pk_fp8_f32(P[(R0) + 4], P[(R0) + 5], 0, false); pb_[(W0) + 1] = __builtin_amdgcn_cvt_pk_fp8_f32(P[(R0) + 6], P[(R0) + 7], w_, true); } while (0)
#define MLA_SMTAIL() ps_ = swapsum(ps_); l = l * alpha_ + ps_
#define MFMA_T(acc, a, b) asm volatile("s_nop 1\n\tv_mfma_scale_f32_32x32x64_f8f6f4 %0, %1, %2, %0, %3, %3 op_sel_hi:[0,0,0]" : "+v"(acc) : "v"(a), "v"(b), "v"(sc1_))
#define MFMA_Z(acc, a, b) asm volatile("s_nop 1\n\tv_mfma_scale_f32_32x32x64_f8f6f4 %0, %1, %2, 0, %3, %3 op_sel_hi:[0,0,0]" : "=&v"(acc) : "v"(a), "v"(b), "v"(sc1_))
#define MLA_STEP(PX0, PX1, PY0, PY1, j) do { \
        const int kb1_ = 64 * ((j) + 1); \
        const bool a0_ = (64 * (j) <= qw + 31); \
        const LAS unsigned char* vj_ = vl + ((j) & 1) * VBX; \
        if (a0_) {                  \
            const LAS unsigned char* kn_ = kl + (((j) + 1) & 1) * MLA_KBX; \
            MLA_SMHEAD() \
            SB(); \
            i32x8 a0_f = ldsx(kn_), a1_f = ldsx(kn_ + 64); \
            MXP_EXPK(PX0, 0, 0); MXP_EXPK(PX0, 8, 2); \
            SB(); MFMA_Z(PY0, a0_f, q[0]); SB(); \
            a0_f = ldsx(kn_ + 128); \
            MXP_EXPK(PX1, 0, 4); \
            SB(); MFMA_T(PY0, a1_f, q[1]); SB(); \
            a1_f = ldsx(kn_ + 32 * KSX); \
            MXP_EXPK(PX1, 8, 6); \
            SB(); MFMA_T(PY0, a0_f, q[2]); SB(); \
            a0_f = ldsx(kn_ + 32 * KSX + 64); \
            MLA_SMTAIL(); \
            SB(); MFMA_Z(PY1, a1_f, q[0]); SB(); \
            a1_f = ldsx(vj_); \
            SB(); MFMA_T(PY1, a0_f, q[1]); SB(); \
            a0_f = ldsx(kn_ + 32 * KSX + 128); \
            SB(); MFMA_T(o[0], a1_f, pb_); SB(); \
            a1_f = ldsx(vj_ + 32 * VSX); \
            SB(); MFMA_T(PY1, a0_f, q[2]); SB(); \
            a0_f = ldsx(vj_ + 64 * VSX); \
            SB(); MFMA_T(o[1], a1_f, pb_); SB(); \
            a1_f = ldsx(vj_ + 96 * VSX); \
            SB(); MFMA_T(o[2], a0_f, pb_); SB(); \
            SB(); MFMA_T(o[3], a1_f, pb_); SB(); \
            if (kb1_ + 63 > qw) mla_maskx(PY0, PY1, tq - kb1_ - 4 * hi); \
            tmx = mla_rowmax(PY0, PY1); \
        } \
        if ((j) + 2 < NT) MLA_STOREK((j) & 1); \
        if ((j) + 1 < NT) MLA_STOREV(((j) + 1) & 1); \
        if ((j) + 3 < NT) MLA_LOADK((j) + 3); \
        if ((j) + 2 < NT) MLA_LOADV((j) + 2); \
        __syncthreads(); } while (0)
    int sc1_ = 0x7f7f7f7f; asm volatile("" : "+v"(sc1_));
    for (int j = 0; j < NT; j += 2) {
        MLA_STEP(pA0, pA1, pB0, pB1, j);
        MLA_STEP(pB0, pB1, pA0, pA1, j + 1);
    }
    asm volatile("s_nop 15\n\ts_nop 15" ::: "memory");
#undef MLA_STEP
#undef MLA_SMHEAD
#undef MLA_SMTAIL
#undef MXP_EXPK
#undef MFMA_T
#undef MFMA_Z
#undef SB
#undef MLA_LOADK
#undef MLA_LOADV
#undef MLA_STOREK
#undef MLA_STOREV
    const float inv = 1.f / l;
    const bf16* zp = P.Z + (size_t)tq * 2048 + head * 128 + 4 * hi;
    bf16* op = P.O + (size_t)tq * 4096 + head * 128 + 4 * hi;
#pragma unroll
    for (int d0 = 0; d0 < 4; ++d0)
#pragma unroll
        for (int rg = 0; rg < 4; ++rg) { const int dim = 32 * d0 + 8 * rg;
            const u32x2 z = *(const GAS u32x2*)(zp + dim);
            u32x2 w; w.x = pk2(o[d0][4 * rg + 0] * inv * bflo(z.x), o[d0][4 * rg + 1] * inv * bfhi(z.x)); w.y = pk2(o[d0][4 * rg + 2] * inv * bflo(z.y), o[d0][4 * rg + 3] * inv * bfhi(z.y));
            *(GAS u32x2*)(op + dim) = w; }
}
#undef MXP_EXP8

#elif defined(MLA_MX)
struct MlaPtrs { const bf16* Q; const bf16* K; const bf16* V; const bf16* Z; bf16* O; };
__device__ __forceinline__ void mla_unit(LAS unsigned char* lds, const MlaPtrs& P, int head, int qb, int tid_in, int wave, int lane_in) {
    int tid = tid_in; asm volatile("" : "+v"(tid)); const int lane = tid & 63; (void)lane_in;
    const int r32 = lane & 31, hi = lane >> 5;
    const int q0 = qb * 256, qw = q0 + wave * 32, tq = qw + r32;
    i32x8 q[3];
    { const unsigned char* qp = (const unsigned char*)P.Q + (size_t)tq * 3072 + head * 192 + hi * 32;
#pragma unroll
      for (int s = 0; s < 3; ++s) { const u32x4 a = *(const GAS u32x4*)(qp + 64 * s), b = *(const GAS u32x4*)(qp + 64 * s + 16);
          q[s] = (i32x8){(int)a.x, (int)a.y, (int)a.z, (int)a.w, (int)b.x, (int)b.y, (int)b.z, (int)b.w}; } }
    const int NT = 4 * (qb + 1);
    const int srow = tid >> 3, sc8 = tid & 7;
    const unsigned char* kg = (const unsigned char*)P.K + (size_t)head * 192 + (size_t)srow * 3072 + sc8 * 8;
    const unsigned char* vg = (const unsigned char*)P.V + ((size_t)head * 128 + (tid >> 2)) * S + (tid & 3) * 16;
    LAS unsigned char* kst = lds + srow * KSX + sc8 * 8;
    LAS unsigned char* vst = lds + 2 * MLA_KBX + (tid >> 2) * VSX + (tid & 3) * 16;
    const LAS unsigned char* kl = lds + r32 * KSX + hi * 32;
    const LAS unsigned char* vl = lds + 2 * MLA_KBX + r32 * VSX + hi * 32;
    u32x2 sk0, sk1, sk2; u32x4 sv0;
#define MLA_LOAD(j) do { const unsigned char* kp_ = kg + (size_t)(j) * (64 * 3072); const unsigned char* vp_ = vg + (size_t)(j) * 64; \
        sk0 = *(const GAS u32x2*)(kp_); sk1 = *(const GAS u32x2*)(kp_ + 64); sk2 = *(const GAS u32x2*)(kp_ + 128); sv0 = *(const GAS u32x4*)(vp_); } while (0)
#define MLA_STORE(b, vb) do { LAS unsigned char* kd_ = kst + (b) * MLA_KBX; LAS unsigned char* vd_ = vst + (vb) * VBX; \
        *(LAS u32x2*)(kd_) = sk0; *(LAS u32x2*)(kd_ + 64) = sk1; *(LAS u32x2*)(kd_ + 128) = sk2; *(LAS u32x2*)(vd_) = (u32x2){sv0.x, sv0.y}; *(LAS u32x2*)(vd_ + 8) = (u32x2){sv0.z, sv0.w}; } while (0)
    MLA_LOAD(0); MLA_STORE(0, 0);
    __syncthreads();
    asm volatile("" : "+v"(q[0]), "+v"(q[1]), "+v"(q[2]));
    float m = -1e30f, l = 0.f; f32x16 o[4];
#pragma unroll
    for (int d = 0; d < 4; ++d)
#pragma unroll
        for (int r = 0; r < 16; ++r) o[d][r] = 0.f;
    const bool trail = wave >= 4;
    i32x8 pb = {};
    int vb_cur = 0, vb_prev = 2;
    for (int j = 0; j < NT; ++j) {
        const int kb = 64 * j;
        int vb_next = vb_cur + 1; if (vb_next == 3) vb_next = 0;
        if (j + 1 < NT) MLA_LOAD(j + 1);
        if (trail && j > 0 && kb - 64 <= qw + 31) pv_tilex(o, pb, vl + vb_prev * VBX);
        if (kb <= qw + 31) {
            f32x16 p0, p1;
            qk_tilex(p0, p1, kl + (j & 1) * MLA_KBX, q);
            if (kb + 63 > qw) {
                const int dq = tq - kb - 4 * hi;
#pragma unroll
                for (int r = 0; r < 16; ++r) { const int c = (r & 3) + 8 * (r >> 2);
                    if (c > dq) p0[r] = -__builtin_inff();
                    if (c + 32 > dq) p1[r] = -__builtin_inff(); }
            }
            online_sm_x(p0, p1, m, l, o, QS_MLA);
            pb = packpx(p0, p1);
            if (!trail) pv_tilex(o, pb, vl + vb_cur * VBX);
        }
        if (j + 1 < NT) MLA_STORE((j + 1) & 1, vb_next);
        __syncthreads();
        vb_prev = vb_cur; vb_cur = vb_next;
    }
    if (trail && 64 * (NT - 1) <= qw + 31) pv_tilex(o, pb, vl + vb_prev * VBX);
    __syncthreads();
#undef MLA_LOAD
#undef MLA_STORE
    const float inv = 1.f / l;
    const bf16* zp = P.Z + (size_t)tq * 2048 + head * 128 + 4 * hi;
    bf16* op = P.O + (size_t)tq * 4096 + head * 128 + 4 * hi;
#pragma unroll
    for (int d0 = 0; d0 < 4; ++d0)
#pragma unroll
        for (int rg = 0; rg < 4; ++rg) { const int dim = 32 * d0 + 8 * rg;
            const u32x2 z = *(const GAS u32x2*)(zp + dim);
            u32x2 w; w.x = pk2(o[d0][4 * rg + 0] * inv * bflo(z.x), o[d0][4 * rg + 1] * inv * bfhi(z.x)); w.y = pk2(o[d0][4 * rg + 2] * inv * bflo(z.y), o[d0][4 * rg + 3] * inv * bfhi(z.y));
            *(GAS u32x2*)(op + dim) = w; }
}

#elif defined(MLA_BIG)
struct MlaPtrs { const bf16* Q; const bf16* K; const bf16* V; const bf16* Z; bf16* O; };
__device__ __forceinline__ void mla_unit(LAS unsigned char* lds, const MlaPtrs& P, int head, int qb, int tid_in, int wave, int lane_in) {
    int tid = tid_in; asm volatile("" : "+v"(tid)); const int lane = tid & 63; (void)lane_in;
    const int r32 = lane & 31, hi = lane >> 5;
    const int q0 = qb * 256, qw = q0 + wave * 32, tq = qw + r32;
    i64 q[12];
    { const unsigned char* qp = (const unsigned char*)P.Q + (size_t)tq * 3072 + head * 192 + hi * 8;
#pragma unroll
      for (int d0 = 0; d0 < 12; ++d0) q[d0] = *(const GAS i64*)(qp + d0 * 16); }
    const int NT = 4 * (qb + 1), NTB = NT / 2;
    const int srow = tid >> 3, sc8 = tid & 7;
    const unsigned char* kg = (const unsigned char*)P.K + (size_t)head * 192 + (size_t)srow * 3072 + sc8 * 8;
    const unsigned char* vg = (const unsigned char*)P.V + ((size_t)head * 128 + (tid >> 2)) * S + (tid & 3) * 32;
    LAS unsigned char* kst = lds + srow * KS8 + sc8 * 8;
    LAS unsigned char* vst = lds + 2 * MLA_KB8B + (tid >> 2) * VS8B + (tid & 3) * 32;
    const LAS unsigned char* kl = lds + r32 * KS8 + hi * 8;
    const LAS unsigned char* vl = lds + 2 * MLA_KB8B + r32 * VS8B + hi * 8;
    u32x2 sk0, sk1, sk2, sk3, sk4, sk5; u32x4 sv0, sv1;
#define MLA_LOAD(J) do { const unsigned char* kp_ = kg + (size_t)(J) * (128 * 3072); const unsigned char* vp_ = vg + (size_t)(J) * 128; \
        sk0 = *(const GAS u32x2*)(kp_); sk1 = *(const GAS u32x2*)(kp_ + 64); sk2 = *(const GAS u32x2*)(kp_ + 128); \
        sk3 = *(const GAS u32x2*)(kp_ + 64 * 3072); sk4 = *(const GAS u32x2*)(kp_ + 64 * 3072 + 64); sk5 = *(const GAS u32x2*)(kp_ + 64 * 3072 + 128); \
        sv0 = *(const GAS u32x4*)(vp_); sv1 = *(const GAS u32x4*)(vp_ + 16); } while (0)
#define MLA_STORE(b, vb) do { LAS unsigned char* kd_ = kst + (b) * MLA_KB8B; LAS unsigned char* vd_ = vst + (vb) * VB8B; \
        *(LAS u32x2*)(kd_) = sk0; *(LAS u32x2*)(kd_ + 64) = sk1; *(LAS u32x2*)(kd_ + 128) = sk2; \
        *(LAS u32x2*)(kd_ + 64 * KS8) = sk3; *(LAS u32x2*)(kd_ + 64 * KS8 + 64) = sk4; *(LAS u32x2*)(kd_ + 64 * KS8 + 128) = sk5; \
        *(LAS u32x2*)(vd_) = (u32x2){sv0.x, sv0.y}; *(LAS u32x2*)(vd_ + 8) = (u32x2){sv0.z, sv0.w}; *(LAS u32x2*)(vd_ + 16) = (u32x2){sv1.x, sv1.y}; *(LAS u32x2*)(vd_ + 24) = (u32x2){sv1.z, sv1.w}; } while (0)
    MLA_LOAD(0); MLA_STORE(0, 0);
    __syncthreads();
    float m = -1e30f, l = 0.f; f32x16 o[4];
#pragma unroll
    for (int d = 0; d < 4; ++d)
#pragma unroll
        for (int r = 0; r < 16; ++r) o[d][r] = 0.f;
    const bool trail = wave >= 4;
    i64 pb[4] = {};
    int vb_cur = 0, vb_prev = 2;
    for (int J = 0; J < NTB; ++J) {
        int vb_next = vb_cur + 1; if (vb_next == 3) vb_next = 0;
        if (J + 1 < NTB) MLA_LOAD(J + 1);
#pragma unroll
        for (int sub = 0; sub < 2; ++sub) {
            const int j = 2 * J + sub, kb = 64 * j;
            if (trail && j > 0 && kb - 64 <= qw + 31) pv_tile8(o, pb, vl + (sub == 0 ? vb_prev * VB8B + 64 : vb_cur * VB8B));
            if (kb <= qw + 31) {
                f32x16 p0, p1;
                qk_tile8<12>(p0, p1, kl + (J & 1) * MLA_KB8B + sub * 64 * KS8, q);
                if (kb + 63 > qw) {
                    const int dq = tq - kb - 4 * hi;
#pragma unroll
                    for (int r = 0; r < 16; ++r) { const int c = (r & 3) + 8 * (r >> 2);
                        if (c > dq) p0[r] = -__builtin_inff();
                        if (c + 32 > dq) p1[r] = -__builtin_inff(); }
                }
                online_sm_scaled(p0, p1, m, l, o, QS_MLA);
                pb[0] = packp8<0>(p0); pb[1] = packp8<1>(p0); pb[2] = packp8<0>(p1); pb[3] = packp8<1>(p1);
                if (!trail) pv_tile8(o, pb, vl + vb_cur * VB8B + sub * 64);
            }
        }
        if (J + 1 < NTB) MLA_STORE((J + 1) & 1, vb_next);
        __syncthreads();
        vb_prev = vb_cur; vb_cur = vb_next;
    }
    if (trail && 64 * (NT - 1) <= qw + 31) pv_tile8(o, pb, vl + vb_prev * VB8B + 64);
    __syncthreads();
#undef MLA_LOAD
#undef MLA_STORE
    const float inv = (1.f / 256.f) / l;
    const bf16* zp = P.Z + (size_t)tq * 2048 + head * 128 + 4 * hi;
    bf16* op = P.O + (size_t)tq * 4096 + head * 128 + 4 * hi;
#pragma unroll
    for (int d0 = 0; d0 < 4; ++d0)
#pragma unroll
        for (int rg = 0; rg < 4; ++rg) { const int dim = 32 * d0 + 8 * rg;
            const u32x2 z = *(const GAS u32x2*)(zp + dim);
            u32x2 w; w.x = pk2(o[d0][4 * rg + 0] * inv * bflo(z.x), o[d0][4 * rg + 1] * inv * bfhi(z.x)); w.y = pk2(o[d0][4 * rg + 2] * inv * bflo(z.y), o[d0][4 * rg + 3] * inv * bfhi(z.y));
            *(GAS u32x2*)(op + dim) = w; }
}

#elif defined(MLA_FP8V)
struct MlaPtrs { const bf16* Q; const bf16* K; const bf16* V; const bf16* Z; bf16* O; };
__device__ __forceinline__ void mla_unit(LAS unsigned char* lds, const MlaPtrs& P, int head, int qb, int tid_in, int wave, int lane_in) {
    int tid = tid_in; asm volatile("" : "+v"(tid)); const int lane = tid & 63; (void)lane_in;
    const int r32 = lane & 31, hi = lane >> 5;
    const int q0 = qb * 256, qw = q0 + wave * 32, tq = qw + r32;
    i64 q[12];
    { const unsigned char* qp = (const unsigned char*)P.Q + (size_t)tq * 3072 + head * 192 + hi * 8;
#pragma unroll
      for (int d0 = 0; d0 < 12; ++d0) q[d0] = *(const GAS i64*)(qp + d0 * 16); }
    const int NT = 4 * (qb + 1);
    const int srow = tid >> 3, sc8 = tid & 7;
    const unsigned char* kg = (const unsigned char*)P.K + (size_t)head * 192 + (size_t)srow * 3072 + sc8 * 8;
    const unsigned char* vg = (const unsigned char*)P.V + ((size_t)head * 128 + (tid >> 2)) * S + (tid & 3) * 16;
    LAS unsigned char* kst = lds + srow * KS8 + sc8 * 8;
    LAS unsigned char* vst = lds + 2 * MLA_KB8 + (tid >> 2) * VS8 + (tid & 3) * 16;
    const LAS unsigned char* kl = lds + r32 * KS8 + hi * 8;
    const LAS unsigned char* vl = lds + 2 * MLA_KB8 + r32 * VS8 + hi * 8;
    u32x2 sk0, sk1, sk2; u32x4 sv0;
#define MLA_LOAD(j) do { const unsigned char* kp_ = kg + (size_t)(j) * (64 * 3072); const unsigned char* vp_ = vg + (size_t)(j) * 64; \
        sk0 = *(const GAS u32x2*)(kp_); sk1 = *(const GAS u32x2*)(kp_ + 64); sk2 = *(const GAS u32x2*)(kp_ + 128); sv0 = *(const GAS u32x4*)(vp_); } while (0)
#define MLA_STORE(b, vb) do { LAS unsigned char* kd_ = kst + (b) * MLA_KB8; LAS unsigned char* vd_ = vst + (vb) * VB8; \
        *(LAS u32x2*)(kd_) = sk0; *(LAS u32x2*)(kd_ + 64) = sk1; *(LAS u32x2*)(kd_ + 128) = sk2; *(LAS u32x2*)(vd_) = (u32x2){sv0.x, sv0.y}; *(LAS u32x2*)(vd_ + 8) = (u32x2){sv0.z, sv0.w}; } while (0)
    MLA_LOAD(0); MLA_STORE(0, 0);
    __syncthreads();
    float m = -1e30f, l = 0.f; f32x16 o[4];
#pragma unroll
    for (int d = 0; d < 4; ++d)
#pragma unroll
        for (int r = 0; r < 16; ++r) o[d][r] = 0.f;
    const bool trail = wave >= 4;
    i64 pb[4] = {};
    int vb_cur = 0, vb_prev = 2;
    for (int j = 0; j < NT; ++j) {
        const int kb = 64 * j;
        int vb_next = vb_cur + 1; if (vb_next == 3) vb_next = 0;
        if (j + 1 < NT) MLA_LOAD(j + 1);
        if (trail && j > 0 && kb - 64 <= qw + 31) pv_tile8(o, pb, vl + vb_prev * VB8);
        if (kb <= qw + 31) {
            f32x16 p0, p1;
#ifdef PROBE_QKM2
            { f32x16 r0, r1; qk_tile_m2<12, KS_M>(p0, p1, r0, r1, kl + (j & 1) * MLA_KB, q);
#pragma unroll
              for (int r = 0; r < 16; ++r) { p0[r] = (p0[r] + r0[r]) * 0.5f; p1[r] = (p1[r] + r1[r]) * 0.5f; } }
#else
            qk_tile8<12>(p0, p1, kl + (j & 1) * MLA_KB8, q);
#endif
#ifdef PROBE_QK2
            { f32x16 r0, r1; asm volatile("" ::: "memory"); qk_tile<12, KS_M>(r0, r1, kl + (j & 1) * MLA_KB, q);
#pragma unroll
              for (int r = 0; r < 16; ++r) { p0[r] = (p0[r] + r0[r]) * 0.5f; p1[r] = (p1[r] + r1[r]) * 0.5f; } }
#endif
#ifdef PROBE_SM2
            { float acc_ = 0.f;
#pragma unroll
              for (int r = 0; r < 16; ++r) { acc_ += __builtin_amdgcn_exp2f(p0[r] - m - 40.f) + __builtin_amdgcn_exp2f(p1[r] - m - 40.f); }
#pragma unroll
              for (int r = 0; r < 16; ++r) { acc_ += __builtin_amdgcn_exp2f(p0[r] - m - 50.f) + __builtin_amdgcn_exp2f(p1[r] - m - 50.f); }
              if (acc_ == 12345.678f) l += 1.f; }
#endif
            if (kb + 63 > qw) {
                const int dq = tq - kb - 4 * hi;
#pragma unroll
                for (int r = 0; r < 16; ++r) { const int c = (r & 3) + 8 * (r >> 2);
                    if (c > dq) p0[r] = -__builtin_inff();
                    if (c + 32 > dq) p1[r] = -__builtin_inff(); }
            }
            online_sm_scaled(p0, p1, m, l, o, QS_MLA);
            pb[0] = packp8<0>(p0); pb[1] = packp8<1>(p0); pb[2] = packp8<0>(p1); pb[3] = packp8<1>(p1);
            if (!trail) pv_tile8(o, pb, vl + vb_cur * VB8);
        }
        if (j + 1 < NT) MLA_STORE((j + 1) & 1, vb_next);
        __syncthreads();
        vb_prev = vb_cur; vb_cur = vb_next;
    }
    if (trail && 64 * (NT - 1) <= qw + 31) pv_tile8(o, pb, vl + vb_prev * VB8);
    __syncthreads();
#undef MLA_LOAD
#undef MLA_STORE
    const float inv = (1.f / 256.f) / l;
    const bf16* zp = P.Z + (size_t)tq * 2048 + head * 128 + 4 * hi;
    bf16* op = P.O + (size_t)tq * 4096 + head * 128 + 4 * hi;
#pragma unroll
    for (int d0 = 0; d0 < 4; ++d0)
#pragma unroll
        for (int rg = 0; rg < 4; ++rg) { const int dim = 32 * d0 + 8 * rg;
            const u32x2 z = *(const GAS u32x2*)(zp + dim);
            u32x2 w; w.x = pk2(o[d0][4 * rg + 0] * inv * bflo(z.x), o[d0][4 * rg + 1] * inv * bfhi(z.x)); w.y = pk2(o[d0][4 * rg + 2] * inv * bflo(z.y), o[d0][4 * rg + 3] * inv * bfhi(z.y));
            *(GAS u32x2*)(op + dim) = w; }
}

#elif defined(MLA_FP8)
struct MlaPtrs { const bf16* Q; const bf16* K; const bf16* V; const bf16* Z; bf16* O; };
__device__ __forceinline__ void mla_unit(LAS unsigned char* lds, const MlaPtrs& P, int head, int qb, int tid_in, int wave, int lane_in) {
    int tid = tid_in; asm volatile("" : "+v"(tid)); const int lane = tid & 63; (void)lane_in;
    const int r32 = lane & 31, hi = lane >> 5;
    const int q0 = qb * 256, qw = q0 + wave * 32, tq = qw + r32;
    i64 q[12];
    { const unsigned char* qp = (const unsigned char*)P.Q + (size_t)tq * 3072 + head * 192 + hi * 8;
#pragma unroll
      for (int d0 = 0; d0 < 12; ++d0) q[d0] = *(const GAS i64*)(qp + d0 * 16); }
    const int NT = 4 * (qb + 1);
    const int srow = tid >> 3, sc8 = tid & 7;
    const unsigned char* kg = (const unsigned char*)P.K + (size_t)head * 192 + (size_t)srow * 3072 + sc8 * 8;
    const unsigned char* vg = (const unsigned char*)P.V + (size_t)head * 256 + (size_t)srow * 4096 + sc8 * 16;
    LAS unsigned char* kst = lds + srow * KS8 + sc8 * 8;
    LAS unsigned char* vst = lds + 2 * MLA_KB8 + srow * VS + sc8 * 16;
    const LAS unsigned char* kl = lds + r32 * KS8 + hi * 8;
    const LAS unsigned char* vl = lds + 2 * MLA_KB8 + (4 * hi + ((lane & 15) >> 2)) * VS + (16 * ((lane >> 4) & 1) + 4 * (lane & 3)) * 2;
    u32x2 sk0, sk1, sk2; u32x4 sv0, sv1;
#define MLA_LOAD(j) do { const unsigned char* kp_ = kg + (size_t)(j) * (64 * 3072); const unsigned char* vp_ = vg + (size_t)(j) * (64 * 4096); \
        sk0 = *(const GAS u32x2*)(kp_); sk1 = *(const GAS u32x2*)(kp_ + 64); sk2 = *(const GAS u32x2*)(kp_ + 128); sv0 = *(const GAS u32x4*)(vp_); sv1 = *(const GAS u32x4*)(vp_ + 128); } while (0)
#define MLA_STORE(b, vb) do { LAS unsigned char* kd_ = kst + (b) * MLA_KB8; LAS unsigned char* vd_ = vst + (vb) * VB; \
        *(LAS u32x2*)(kd_) = sk0; *(LAS u32x2*)(kd_ + 64) = sk1; *(LAS u32x2*)(kd_ + 128) = sk2; *(LAS u32x4*)(vd_) = sv0; *(LAS u32x4*)(vd_ + 128) = sv1; } while (0)
    MLA_LOAD(0); MLA_STORE(0, 0);
    __syncthreads();
    float m = -1e30f, l = 0.f; f32x16 o[4];
#pragma unroll
    for (int d = 0; d < 4; ++d)
#pragma unroll
        for (int r = 0; r < 16; ++r) o[d][r] = 0.f;
    const bool trail = wave >= 4;
    bf16x8 pb[4] = {};
    int vb_cur = 0, vb_prev = 2;
    for (int j = 0; j < NT; ++j) {
        const int kb = 64 * j;
        int vb_next = vb_cur + 1; if (vb_next == 3) vb_next = 0;
        if (j + 1 < NT) MLA_LOAD(j + 1);
        if (trail && j > 0 && kb - 64 <= qw + 31) pv_tile(o, pb, vl + vb_prev * VB);
        if (kb <= qw + 31) {
            f32x16 p0, p1;
#ifdef PROBE_QKM2
            { f32x16 r0, r1; qk_tile_m2<12, KS_M>(p0, p1, r0, r1, kl + (j & 1) * MLA_KB, q);
#pragma unroll
              for (int r = 0; r < 16; ++r) { p0[r] = (p0[r] + r0[r]) * 0.5f; p1[r] = (p1[r] + r1[r]) * 0.5f; } }
#else
            qk_tile8<12>(p0, p1, kl + (j & 1) * MLA_KB8, q);
#endif
#ifdef PROBE_QK2
            { f32x16 r0, r1; asm volatile("" ::: "memory"); qk_tile<12, KS_M>(r0, r1, kl + (j & 1) * MLA_KB, q);
#pragma unroll
              for (int r = 0; r < 16; ++r) { p0[r] = (p0[r] + r0[r]) * 0.5f; p1[r] = (p1[r] + r1[r]) * 0.5f; } }
#endif
#ifdef PROBE_SM2
            { float acc_ = 0.f;
#pragma unroll
              for (int r = 0; r < 16; ++r) { acc_ += __builtin_amdgcn_exp2f(p0[r] - m - 40.f) + __builtin_amdgcn_exp2f(p1[r] - m - 40.f); }
#pragma unroll
              for (int r = 0; r < 16; ++r) { acc_ += __builtin_amdgcn_exp2f(p0[r] - m - 50.f) + __builtin_amdgcn_exp2f(p1[r] - m - 50.f); }
              if (acc_ == 12345.678f) l += 1.f; }
#endif
            if (kb + 63 > qw) {
                const int dq = tq - kb - 4 * hi;
#pragma unroll
                for (int r = 0; r < 16; ++r) { const int c = (r & 3) + 8 * (r >> 2);
                    if (c > dq) p0[r] = -__builtin_inff();
                    if (c + 32 > dq) p1[r] = -__builtin_inff(); }
            }
            online_sm_scaled(p0, p1, m, l, o, QS_MLA);
            pb[0] = packp<0>(p0); pb[1] = packp<1>(p0); pb[2] = packp<0>(p1); pb[3] = packp<1>(p1);
            if (!trail) pv_tile(o, pb, vl + vb_cur * VB);
        }
        if (j + 1 < NT) MLA_STORE((j + 1) & 1, vb_next);
        __syncthreads();
        vb_prev = vb_cur; vb_cur = vb_next;
    }
    if (trail && 64 * (NT - 1) <= qw + 31) pv_tile(o, pb, vl + vb_prev * VB);
    __syncthreads();
#undef MLA_LOAD
#undef MLA_STORE
    const float inv = 1.f / l;
    const bf16* zp = P.Z + (size_t)tq * 2048 + head * 128 + 4 * hi;
    bf16* op = P.O + (size_t)tq * 4096 + head * 128 + 4 * hi;
#pragma unroll
    for (int d0 = 0; d0 < 4; ++d0)
#pragma unroll
        for (int rg = 0; rg < 4; ++rg) { const int dim = 32 * d0 + 8 * rg;
            const u32x2 z = *(const GAS u32x2*)(zp + dim);
            u32x2 w; w.x = pk2(o[d0][4 * rg + 0] * inv * bflo(z.x), o[d0][4 * rg + 1] * inv * bfhi(z.x)); w.y = pk2(o[d0][4 * rg + 2] * inv * bflo(z.y), o[d0][4 * rg + 3] * inv * bfhi(z.y));
            *(GAS u32x2*)(op + dim) = w; }
}

#else
struct MlaPtrs { const bf16* Q; const bf16* K; const bf16* V; const bf16* Z; bf16* O; };
__device__ __forceinline__ void mla_unit(LAS unsigned char* lds, const MlaPtrs& P, int head, int qb, int tid_in, int wave, int lane_in) {
    int tid = tid_in; asm volatile("" : "+v"(tid)); const int lane = tid & 63; (void)lane_in;
    const int r32 = lane & 31, hi = lane >> 5;
    const int q0 = qb * 256, qw = q0 + wave * 32, tq = qw + r32;
    bf16x8 q[12];
    { const bf16* qp = P.Q + (size_t)tq * 3072 + head * 192 + hi * 8;
#pragma unroll
      for (int d0 = 0; d0 < 12; ++d0) q[d0] = *(const GAS bf16x8*)(qp + d0 * 16); }
    const int NT = 4 * (qb + 1);
    const int srow = tid >> 3, sc8 = tid & 7;
    const unsigned char* kg = (const unsigned char*)P.K + (size_t)head * 384 + (size_t)srow * 6144 + sc8 * 16;
    const unsigned char* vg = (const unsigned char*)P.V + (size_t)head * 256 + (size_t)srow * 4096 + sc8 * 16;
    LAS unsigned char* kst = lds + srow * KS_M + sc8 * 16;
    LAS unsigned char* vst = lds + 2 * MLA_KB + srow * VS + sc8 * 16;
    const LAS unsigned char* kl = lds + r32 * KS_M + hi * 16;
    const LAS unsigned char* vl = lds + 2 * MLA_KB + (4 * hi + ((lane & 15) >> 2)) * VS + (16 * ((lane >> 4) & 1) + 4 * (lane & 3)) * 2;
    u32x4 sk0, sk1, sk2, sv0, sv1;
#define MLA_LOAD(j) do { const unsigned char* kp_ = kg + (size_t)(j) * (64 * 6144); const unsigned char* vp_ = vg + (size_t)(j) * (64 * 4096); \
        sk0 = *(const GAS u32x4*)(kp_); sk1 = *(const GAS u32x4*)(kp_ + 128); sk2 = *(const GAS u32x4*)(kp_ + 256); sv0 = *(const GAS u32x4*)(vp_); sv1 = *(const GAS u32x4*)(vp_ + 128); } while (0)
#define MLA_STORE(b, vb) do { LAS unsigned char* kd_ = kst + (b) * MLA_KB; LAS unsigned char* vd_ = vst + (vb) * VB; \
        *(LAS u32x4*)(kd_) = sk0; *(LAS u32x4*)(kd_ + 128) = sk1; *(LAS u32x4*)(kd_ + 256) = sk2; *(LAS u32x4*)(vd_) = sv0; *(LAS u32x4*)(vd_ + 128) = sv1; } while (0)
    MLA_LOAD(0); MLA_STORE(0, 0);
    __syncthreads();
    float m = -1e30f, l = 0.f; f32x16 o[4];
#pragma unroll
    for (int d = 0; d < 4; ++d)
#pragma unroll
        for (int r = 0; r < 16; ++r) o[d][r] = 0.f;
    const bool trail = wave >= 4;
    bf16x8 pb[4] = {};
    int vb_cur = 0, vb_prev = 2;
    for (int j = 0; j < NT; ++j) {
        const int kb = 64 * j;
        int vb_next = vb_cur + 1; if (vb_next == 3) vb_next = 0;
        if (j + 1 < NT) MLA_LOAD(j + 1);
        if (trail && j > 0 && kb - 64 <= qw + 31) pv_tile(o, pb, vl + vb_prev * VB);
        if (kb <= qw + 31) {
            f32x16 p0, p1;
#ifdef PROBE_QKM2
            { f32x16 r0, r1; qk_tile_m2<12, KS_M>(p0, p1, r0, r1, kl + (j & 1) * MLA_KB, q);
#pragma unroll
              for (int r = 0; r < 16; ++r) { p0[r] = (p0[r] + r0[r]) * 0.5f; p1[r] = (p1[r] + r1[r]) * 0.5f; } }
#else
            qk_tile<12, KS_M>(p0, p1, kl + (j & 1) * MLA_KB, q);
#endif
#ifdef PROBE_QK2
            { f32x16 r0, r1; asm volatile("" ::: "memory"); qk_tile<12, KS_M>(r0, r1, kl + (j & 1) * MLA_KB, q);
#pragma unroll
              for (int r = 0; r < 16; ++r) { p0[r] = (p0[r] + r0[r]) * 0.5f; p1[r] = (p1[r] + r1[r]) * 0.5f; } }
#endif
#ifdef PROBE_SM2
            { float acc_ = 0.f;
#pragma unroll
              for (int r = 0; r < 16; ++r) { acc_ += __builtin_amdgcn_exp2f(p0[r] - m - 40.f) + __builtin_amdgcn_exp2f(p1[r] - m - 40.f); }
#pragma unroll
              for (int r = 0; r < 16; ++r) { acc_ += __builtin_amdgcn_exp2f(p0[r] - m - 50.f) + __builtin_amdgcn_exp2f(p1[r] - m - 50.f); }
              if (acc_ == 12345.678f) l += 1.f; }
#endif
            if (kb + 63 > qw) {
                const int dq = tq - kb - 4 * hi;
#pragma unroll
                for (int r = 0; r < 16; ++r) { const int c = (r & 3) + 8 * (r >> 2);
                    if (c > dq) p0[r] = -__builtin_inff();
                    if (c + 32 > dq) p1[r] = -__builtin_inff(); }
            }
            online_sm(p0, p1, m, l, o);
            pb[0] = packp<0>(p0); pb[1] = packp<1>(p0); pb[2] = packp<0>(p1); pb[3] = packp<1>(p1);
            if (!trail) pv_tile(o, pb, vl + vb_cur * VB);
        }
        if (j + 1 < NT) MLA_STORE((j + 1) & 1, vb_next);
        __syncthreads();
        vb_prev = vb_cur; vb_cur = vb_next;
    }
    if (trail && 64 * (NT - 1) <= qw + 31) pv_tile(o, pb, vl + vb_prev * VB);
    __syncthreads();
#undef MLA_LOAD
#undef MLA_STORE
    const float inv = 1.f / l;
    const bf16* zp = P.Z + (size_t)tq * 2048 + head * 128 + 4 * hi;
    bf16* op = P.O + (size_t)tq * 4096 + head * 128 + 4 * hi;
#pragma unroll
    for (int d0 = 0; d0 < 4; ++d0)
#pragma unroll
        for (int rg = 0; rg < 4; ++rg) { const int dim = 32 * d0 + 8 * rg;
            const u32x2 z = *(const GAS u32x2*)(zp + dim);
            u32x2 w; w.x = pk2(o[d0][4 * rg + 0] * inv * bflo(z.x), o[d0][4 * rg + 1] * inv * bfhi(z.x)); w.y = pk2(o[d0][4 * rg + 2] * inv * bflo(z.y), o[d0][4 * rg + 3] * inv * bfhi(z.y));
            *(GAS u32x2*)(op + dim) = w; }
}

#endif
#endif
struct NsaPtrs { const bf16* Q; const bf16* KV; const bf16* KC; const bf16* VC; const bf16* Z; const float* G; bf16* O; float* scr; };
template <int MODE>
__device__ __forceinline__ void nsa_loop(LAS unsigned char* lds, const unsigned char* kbase, const unsigned char* vbase, int ntiles, int jlo,
                                         const bf16x8 (&q)[8], int t, float slope2, float& m, float& l, f32x16 (&o)[4], float invl, int tid, int wave, int lane) {
    constexpr bool HASV = MODE != 0;
    const int r32 = lane & 31, hi = lane >> 5;
    const int srow = tid >> 3, sc8 = tid & 7;
    const unsigned soff = srow * 256 + sc8 * 16;
    LAS unsigned char* kst = lds + srow * KS_N + sc8 * 16;
    LAS unsigned char* vst = lds + 2 * NSA_KB + srow * VS + sc8 * 16;
    const LAS unsigned char* kl = lds + r32 * KS_N + hi * 16;
    const LAS unsigned char* vl = lds + 2 * NSA_KB + (4 * hi + ((lane & 15) >> 2)) * VS + (16 * ((lane >> 4) & 1) + 4 * (lane & 3)) * 2;
    const LAS int* ulist = (const LAS int*)(lds + N_ULIST);
    const LAS unsigned* selm = (const LAS unsigned*)(lds + N_SELM);
    LAS float* partA = (LAS float*)(lds + N_PART); LAS float* partB = (LAS float*)(lds + N_PART + N_PARTB);
    LAS float* imp = (LAS float*)(lds + N_IMP); LAS float* carry = (LAS float*)(lds + N_CARRY);
    if (ntiles <= 0) return;
    const float mlg = (MODE == 1) ? (invl > 0.f ? m - __builtin_amdgcn_logf(invl) : __builtin_inff()) : 0.f;
    u32x4 sk0, sk1, sv0, sv1;
#define NSA_TROW(j) (MODE == 2 ? 64 * __builtin_amdgcn_readfirstlane(ulist[ntiles - 1 - (j)]) : ((MODE == 3 || MODE == 0) ? 64 * (jlo + ntiles - 1 - (j)) : 64 * (jlo + (j))))
#define NSA_LOAD(j) do { const size_t ro_ = (size_t)NSA_TROW(j) * 256 + soff; \
        sk0 = *(const GAS u32x4*)(kbase + ro_); sk1 = *(const GAS u32x4*)(kbase + ro_ + 128); \
        if (HASV) { sv0 = *(const GAS u32x4*)(vbase + ro_); sv1 = *(const GAS u32x4*)(vbase + ro_ + 128); } } while (0)
#define NSA_STORE(b) do { LAS unsigned char* kd_ = kst + (b) * NSA_KB; *(LAS u32x4*)(kd_) = sk0; *(LAS u32x4*)(kd_ + 128) = sk1; \
        if (HASV) { LAS unsigned char* vd_ = vst + (b) * VB; *(LAS u32x4*)(vd_) = sv0; *(LAS u32x4*)(vd_ + 128) = sv1; } } while (0)
    NSA_LOAD(0); NSA_STORE(0);
    __syncthreads();
    for (int j = 0; j < ntiles; ++j) {
        const int buf = j & 1;
        if (MODE != 1 && j + 1 < ntiles) NSA_LOAD(j + 1);
        const int trow = NSA_TROW(j);
        constexpr int PSTEP = (MODE <= 1) ? 16 : 1;
        const int pstart = (MODE <= 1) ? 16 * trow + 31 : trow;
        const int db = t - pstart - PSTEP * 4 * hi;
        constexpr unsigned W = (MODE == 3) ? 512u : 0x7fffffffu;
        const bool mset = m > -1e29f;
        float b0 = -slope2 * (float)db - ((MODE != 1) ? (mset ? m : 0.f) : mlg);
        if (MODE == 2) { const int b = trow >> 6; if (((selm[r32 * 8 + (b >> 5)] >> (b & 31)) & 1u) == 0u) b0 = -__builtin_inff(); }
        f32x16 p0, p1;
#pragma unroll
        for (int r = 0; r < 16; ++r) { const int c = PSTEP * ((r & 3) + 8 * (r >> 2));
            p0[r] = __builtin_fmaf(slope2, (float)c, b0); p1[r] = __builtin_fmaf(slope2, (float)(c + 32 * PSTEP), b0); }
        qk_tile<8, KS_N, false>(p0, p1, kl + buf * NSA_KB, q);
        { const int t0u = __builtin_amdgcn_readfirstlane(t - r32);
          const bool interior = (t0u - (pstart + PSTEP * 63) >= 0) && ((unsigned)(t0u + 31 - pstart) < W);
          if (!interior) {
#pragma unroll
              for (int r = 0; r < 16; ++r) { const int c = PSTEP * ((r & 3) + 8 * (r >> 2));
                  if ((unsigned)(db - c) >= W) p0[r] = -__builtin_inff();
                  if ((unsigned)(db - c - 32 * PSTEP) >= W) p1[r] = -__builtin_inff(); } } }
        if (MODE == 0) {
            float tm = p0[0];
#pragma unroll
            for (int r = 1; r < 16; ++r) tm = fmaxf(tm, p0[r]);
#pragma unroll
            for (int r = 0; r < 16; ++r) tm = fmaxf(tm, p1[r]);
            tm = swapmax(tm);
            const bool need = mset ? (tm > 16.f) : (tm > -1e29f);
            if (!__all(!need)) {
                const float dlt = need ? tm : 0.f;
                if (mset) l *= __builtin_amdgcn_exp2f(-dlt);
                if (need) m = (mset ? m : 0.f) + dlt;
#pragma unroll
                for (int r = 0; r < 16; ++r) { p0[r] -= dlt; p1[r] -= dlt; }
            }
            float ps = 0.f;
#pragma unroll
            for (int r = 0; r < 16; ++r) ps += __builtin_amdgcn_exp2f(p0[r]) + __builtin_amdgcn_exp2f(p1[r]);
            l += swapsum(ps);
        } else if (MODE == 1) {
#pragma unroll
            for (int r = 0; r < 16; ++r) { p0[r] = __builtin_amdgcn_exp2f(p0[r]); p1[r] = __builtin_amdgcn_exp2f(p1[r]); }
            LAS float* pa = partA + (wave * 32 + r32) * 17 + hi; LAS float* pbm = partB + (wave * 32 + r32) * 17 + hi;
#pragma unroll
            for (int rg = 0; rg < 4; ++rg) {
                pa[2 * rg] = (p0[4 * rg] + p0[4 * rg + 1]) + (p0[4 * rg + 2] + p0[4 * rg + 3]); pbm[2 * rg] = p0[4 * rg + 3];
                pa[8 + 2 * rg] = (p1[4 * rg] + p1[4 * rg + 1]) + (p1[4 * rg + 2] + p1[4 * rg + 3]); pbm[8 + 2 * rg] = p1[4 * rg + 3]; }
            const bf16x8 pb[4] = {packp<0>(p0), packp<1>(p0), packp<0>(p1), packp<1>(p1)};
            pv_tile(o, pb, vl + buf * VB);
            __syncthreads();
            { const int qq = tid >> 4, jl = tid & 15; float a = 0.f, bp = 0.f, bl = 0.f;
#pragma unroll
              for (int w = 0; w < 8; ++w) { a += partA[(w * 32 + qq) * 17 + jl]; bl += partB[(w * 32 + qq) * 17 + jl]; }
              if (jl > 0) {
#pragma unroll
                  for (int w = 0; w < 8; ++w) bp += partB[(w * 32 + qq) * 17 + jl - 1];
              } else bp = (j > 0) ? carry[((j - 1) & 1) * 32 + qq] : 0.f;
              imp[qq * 256 + 16 * j + jl] = a + bp;
              if (jl == 15) carry[(j & 1) * 32 + qq] = bl; }
        } else {
            constexpr float NSA_LAZY_T = 16.f;
            float tm = p0[0];
#pragma unroll
            for (int r = 1; r < 16; ++r) tm = fmaxf(tm, p0[r]);
#pragma unroll
            for (int r = 0; r < 16; ++r) tm = fmaxf(tm, p1[r]);
            tm = swapmax(tm);
            const bool need = mset ? (tm > NSA_LAZY_T) : (tm > -1e29f);
            if (!__all(!need)) {
                const float dlt = need ? tm : 0.f;
                const float alpha = mset ? __builtin_amdgcn_exp2f(-dlt) : 1.f;
                if (need) m = (mset ? m : 0.f) + dlt;
#pragma unroll
                for (int r = 0; r < 16; ++r) { p0[r] -= dlt; p1[r] -= dlt; }
                l *= alpha;
#pragma unroll
                for (int d_ = 0; d_ < 4; ++d_)
#pragma unroll
                    for (int r = 0; r < 16; ++r) o[d_][r] *= alpha;
            }
            float ps = 0.f;
#pragma unroll
            for (int r = 0; r < 16; ++r) { p0[r] = __builtin_amdgcn_exp2f(p0[r]); ps += p0[r]; }
#pragma unroll
            for (int r = 0; r < 16; ++r) { p1[r] = __builtin_amdgcn_exp2f(p1[r]); ps += p1[r]; }
            l += swapsum(ps);
            const bf16x8 pb[4] = {packp<0>(p0), packp<1>(p0), packp<0>(p1), packp<1>(p1)};
            pv_tile(o, pb, vl + buf * VB);
        }
        if (MODE == 1 && j + 1 < ntiles) NSA_LOAD(j + 1);
        if (j + 1 < ntiles) NSA_STORE(buf ^ 1);
        __syncthreads();
    }
#undef NSA_TROW
#undef NSA_LOAD
#undef NSA_STORE
}
__device__ __forceinline__ void nsa_topk(const LAS float* improw, LAS unsigned* selrow, int cur, int lane) {
    unsigned key[4]; bool sel[4];
    int nforced = 0;
#pragma unroll
    for (int k = 0; k < 4; ++k) { const int j = lane + 64 * k;
        const bool forced = (j == 0) || (j == cur) || (j == cur - 1);
        const bool causal = j <= cur;
        sel[k] = forced;
#ifdef IMPNOISE_BUILD
        { unsigned h = (unsigned)j * 2654435761u + (unsigned)(size_t)improw * 40503u; h ^= h >> 15; h *= 0x846ca68bu; h ^= h >> 16;
          const float r = (float)(int)(h & 0xffffu) * (1.f / 32768.f) - 1.f; const float v = improw[j] * (1.f + IMPNOISE_EPS * r);
          key[k] = (causal && !forced) ? (__float_as_uint(v) + 1u) : 0u; }
#else
        key[k] = (causal && !forced) ? (__float_as_uint(improw[j]) + 1u) : 0u;
#endif
    }
    nforced = 1 + (cur >= 1 ? 1 : 0) + (cur >= 2 ? 1 : 0);
    const int want = 16 - nforced;
    for (int it = 0; it < want; ++it) {
        unsigned bk = key[0]; int bj = lane;
#pragma unroll
        for (int k = 1; k < 4; ++k) { if (key[k] > bk) { bk = key[k]; bj = lane + 64 * k; } }
        unsigned long long best = ((unsigned long long)bk << 32) | (unsigned)(0xffffffffu - (unsigned)bj);
#pragma unroll
        for (int off = 1; off < 64; off <<= 1) {
            const unsigned lo = __shfl_xor((unsigned)best, off), hiw = __shfl_xor((unsigned)(best >> 32), off);
            const unsigned long long other = ((unsigned long long)hiw << 32) | lo;
            best = other > best ? other : best; }
        if ((unsigned)(best >> 32) == 0u) break;
        const int wj = (int)(0xffffffffu - (unsigned)best);
#pragma unroll
        for (int k = 0; k < 4; ++k) if (wj == lane + 64 * k) { key[k] = 0u; sel[k] = true; }
    }
#pragma unroll
    for (int k = 0; k < 4; ++k) { const unsigned long long bm = __ballot(sel[k]);
        if (lane == 0) { selrow[2 * k] = (unsigned)bm; selrow[2 * k + 1] = (unsigned)(bm >> 32); } }
}
__device__ __forceinline__ void nsa_topk4(const LAS float* imp0, LAS unsigned* sel0, int cur, int lane) {
    unsigned key[4][4]; bool forced[4];
#pragma unroll
    for (int k = 0; k < 4; ++k) { const int j = lane + 64 * k;
        forced[k] = (j == 0) || (j == cur) || (j == cur - 1);
        const bool cand = (j <= cur) && !forced[k];
#pragma unroll
        for (int i = 0; i < 4; ++i) key[i][k] = cand ? (__float_as_uint(imp0[i * 256 + j]) + 1u) : 0u; }
    const int want = 16 - (1 + (cur >= 1 ? 1 : 0) + (cur >= 2 ? 1 : 0));
    unsigned T[4] = {0u, 0u, 0u, 0u};
    for (int bit = 30; bit >= 0; --bit) {
#pragma unroll
        for (int i = 0; i < 4; ++i) { const unsigned c = T[i] | (1u << bit);
            const int n = __builtin_popcountll(__ballot(key[i][0] >= c)) + __builtin_popcountll(__ballot(key[i][1] >= c)) + __builtin_popcountll(__ballot(key[i][2] >= c)) + __builtin_popcountll(__ballot(key[i][3] >= c));
            if (n >= want) T[i] = c; }
    }
#pragma unroll
    for (int i = 0; i < 4; ++i) {
        const unsigned Ti = T[i];
        int rem = want;
        if (Ti != 0u) rem -= __builtin_popcountll(__ballot(key[i][0] > Ti)) + __builtin_popcountll(__ballot(key[i][1] > Ti)) + __builtin_popcountll(__ballot(key[i][2] > Ti)) + __builtin_popcountll(__ballot(key[i][3] > Ti));
#pragma unroll
        for (int k = 0; k < 4; ++k) {
            bool s = forced[k];
            if (Ti == 0u) s = s || key[i][k] >= 1u;
            else {
                const bool eq = key[i][k] == Ti; const unsigned long long em = __ballot(eq);
                const int below = (int)__builtin_amdgcn_mbcnt_hi((unsigned)(em >> 32), __builtin_amdgcn_mbcnt_lo((unsigned)em, 0u));
                s = s || key[i][k] > Ti || (eq && below < rem);
                rem -= __builtin_popcountll(em); if (rem < 0) rem = 0;
            }
            const unsigned long long bm = __ballot(s);
            if (lane == 0) { sel0[i * 8 + 2 * k] = (unsigned)bm; sel0[i * 8 + 2 * k + 1] = (unsigned)(bm >> 32); }
        }
    }
}
__device__ __forceinline__ int nsa_opaque(int v) { asm volatile("" : "+v"(v)); return v; }
__device__ __forceinline__ void nsa_unit(LAS unsigned char* lds, const NsaPtrs& P, int g, int qblk, int tid_in, int wave, int lane_in, int cu) {
    int tid = tid_in; asm volatile("" : "+v"(tid));
    const int lane = tid & 63; (void)lane_in;
    const int r32 = lane & 31, hi = lane >> 5;
    const int hh = 8 * g + wave, t0 = 32 * qblk, t = t0 + r32;
    const float slope2 = __builtin_amdgcn_exp2f(-0.5f * (float)(hh + 1)) * LOG2E;
    bf16x8 q[8];
    { const bf16* qp = P.Q + (size_t)t * 2048 + hh * 128 + hi * 8;
#pragma unroll
      for (int d0 = 0; d0 < 8; ++d0) q[d0] = *(const GAS bf16x8*)(qp + d0 * 16); }
#define NSA_SCR() ((GAS f32x4*)(P.scr + ((size_t)(cu * 8 + wave) * 16) * 256) + nsa_opaque(lane))
    const size_t CH = (size_t)S * 128 * 2;
    f32x16 o[4]; float m, l;
#define NSA_ZERO_O() do { _Pragma("unroll") for (int d_ = 0; d_ < 4; ++d_) _Pragma("unroll") for (int r_ = 0; r_ < 16; ++r_) o[d_][r_] = 0.f; } while (0)
    const int ncv = 2 * qblk + 1, ntc = (ncv + 63) >> 6;
    const unsigned char* kc = (const unsigned char*)P.KC + (size_t)g * 1024 * 256; const unsigned char* vc = (const unsigned char*)P.VC + (size_t)g * 1024 * 256;
    m = -1e30f; l = 0.f; NSA_ZERO_O();
    nsa_loop<0>(lds, kc, vc, ntc, 0, q, t, slope2, m, l, o, 0.f, tid, wave, lane);
    const float invl = l > 0.f ? 1.f / l : 0.f;
    nsa_loop<1>(lds, kc, vc, ntc, 0, q, t, slope2, m, l, o, invl, tid, wave, lane);
    { const float g_c = P.G[(size_t)t * 48 + hh]; GAS f32x4* scr = NSA_SCR();
#pragma unroll
    for (int d0 = 0; d0 < 4; ++d0)
#pragma unroll
        for (int rg = 0; rg < 4; ++rg) { f32x4 v = {o[d0][4 * rg] * g_c, o[d0][4 * rg + 1] * g_c, o[d0][4 * rg + 2] * g_c, o[d0][4 * rg + 3] * g_c}; scr[(d0 * 4 + rg) * 64] = v; } }
    const int cur = t0 >> 6;
    LAS unsigned* selm = (LAS unsigned*)(lds + N_SELM);
#ifdef NSA_TOPK_ITER
    for (int i = 0; i < 4; ++i) { const int qq = 4 * wave + i; nsa_topk((const LAS float*)(lds + N_IMP) + qq * 256, selm + qq * 8, cur, lane); }
#else
    nsa_topk4((const LAS float*)(lds + N_IMP) + 4 * wave * 256, selm + 4 * wave * 8, cur, lane);
#endif
    __syncthreads();
    if (wave == 0) {
        LAS int* ulist = (LAS int*)(lds + N_ULIST); int n = 0;
        for (int k = 0; k < 8; ++k) { unsigned u = (lane < 32) ? selm[lane * 8 + k] : 0u;
#pragma unroll
            for (int off = 1; off < 32; off <<= 1) u |= __shfl_xor(u, off);
            u = __builtin_amdgcn_readfirstlane(u);
            while (u) { const int b = __builtin_ctz(u); u &= u - 1u; if (lane == 0) ulist[n] = 32 * k + b; ++n; } }
        if (lane == 0) *(LAS int*)(lds + N_NTS) = n;
    }
    __syncthreads();
    const int nts = __builtin_amdgcn_readfirstlane(*(const LAS int*)(lds + N_NTS));
    m = -1e30f; l = 0.f; NSA_ZERO_O();
    nsa_loop<2>(lds, (const unsigned char*)P.KV + (size_t)(4 + g) * CH, (const unsigned char*)P.KV + (size_t)(6 + g) * CH, nts, 0, q, t, slope2, m, l, o, 0.f, tid, wave, lane);
    { const float f = P.G[(size_t)t * 48 + 16 + hh] / l; GAS f32x4* scr = NSA_SCR();
#pragma unroll
      for (int d0 = 0; d0 < 4; ++d0)
          { f32x4 v[4];
#pragma unroll
            for (int rg = 0; rg < 4; ++rg) v[rg] = scr[(d0 * 4 + rg) * 64];
#pragma unroll
            for (int rg = 0; rg < 4; ++rg) { v[rg][0] += o[d0][4 * rg] * f; v[rg][1] += o[d0][4 * rg + 1] * f; v[rg][2] += o[d0][4 * rg + 2] * f; v[rg][3] += o[d0][4 * rg + 3] * f; scr[(d0 * 4 + rg) * 64] = v[rg]; } } }
    const int jlo = (t0 > 511 ? t0 - 511 : 0) >> 6, jhi = (t0 + 31) >> 6;
    m = -1e30f; l = 0.f; NSA_ZERO_O();
    nsa_loop<3>(lds, (const unsigned char*)P.KV + (size_t)(8 + g) * CH, (const unsigned char*)P.KV + (size_t)(10 + g) * CH, jhi - jlo + 1, jlo, q, t, slope2, m, l, o, 0.f, tid, wave, lane);
    { const float f = P.G[(size_t)t * 48 + 32 + hh] / l; GAS f32x4* scr = NSA_SCR();
      const bf16* zp = P.Z + (size_t)t * 2048 + hh * 128 + 4 * hi;
      bf16* op = P.O + (size_t)t * 4096 + 2048 + hh * 128 + 4 * hi;
#pragma unroll
      for (int d0 = 0; d0 < 4; ++d0)
          { f32x4 av[4]; u32x2 zv[4];
#pragma unroll
            for (int rg = 0; rg < 4; ++rg) { av[rg] = scr[(d0 * 4 + rg) * 64]; zv[rg] = *(const GAS u32x2*)(zp + 32 * d0 + 8 * rg); }
#pragma unroll
          for (int rg = 0; rg < 4; ++rg) { const int dim = 32 * d0 + 8 * rg; const f32x4 a = av[rg];
              const u32x2 z = zv[rg];
              u32x2 w; w.x = pk2((a[0] + o[d0][4 * rg] * f) * bflo(z.x), (a[1] + o[d0][4 * rg + 1] * f) * bfhi(z.x)); w.y = pk2((a[2] + o[d0][4 * rg + 2] * f) * bflo(z.y), (a[3] + o[d0][4 * rg + 3] * f) * bfhi(z.y));
              *(GAS u32x2*)(op + dim) = w; } } }
#undef NSA_ZERO_O
#undef NSA_SCR
}
struct CmpPtrs { const bf16* KV; const bf16* W1; const bf16* W2; const float* cbp; bf16* KC; bf16* VC; };
__device__ __forceinline__ void cmp_unit(LAS unsigned char* lds, const CmpPtrs& P, int kv, int g, int tile, int tid, int wave, int lane) {
    const int fr = lane & 15, fq = lane >> 4;
    constexpr int CRS = 544;
    LAS unsigned char* As = lds + 16384;
    LAS unsigned char* Ws = As + 16 * CRS;
    const unsigned char* Ag = (const unsigned char*)(P.KV + (size_t)(kv * 2 + g) * ((size_t)S * 128) + (size_t)(16 * tile + (tid >> 5)) * 2048) + (tid & 31) * 16;
    const unsigned char* Wg = (const unsigned char*)(P.W1 + (size_t)kv * 128 * 4096 + (size_t)(tid >> 5) * 4096) + (tid & 31) * 16;
    LAS unsigned char* Ad = As + (tid >> 5) * CRS + (tid & 31) * 16;
    LAS unsigned char* Wd = Ws + (tid >> 5) * CRS + (tid & 31) * 16;
    const LAS unsigned char* Ar = As + fr * CRS + fq * 16;
    const LAS unsigned char* Wr = Ws + (16 * wave + fr) * CRS + fq * 16;
    u32x4 ra, rw[8];
#define CMP_LOAD(c) do { ra = *(const GAS u32x4*)(Ag + (c) * 512); _Pragma("unroll") for (int i_ = 0; i_ < 8; ++i_) rw[i_] = *(const GAS u32x4*)(Wg + (size_t)i_ * (16 * 8192) + (c) * 512); } while (0)
    CMP_LOAD(0);
    f32x4 acc = {0.f, 0.f, 0.f, 0.f};
    for (int c = 0; c < 16; ++c) {
        *(LAS u32x4*)Ad = ra;
#pragma unroll
        for (int i = 0; i < 8; ++i) *(LAS u32x4*)(Wd + i * 16 * CRS) = rw[i];
        __syncthreads();
        if (c + 1 < 16) CMP_LOAD(c + 1);
#pragma unroll
        for (int s = 0; s < 8; ++s) {
            const bf16x8 a = *(const LAS bf16x8*)(Ar + 64 * s), b = *(const LAS bf16x8*)(Wr + 64 * s);
            acc = __builtin_amdgcn_mfma_f32_16x16x32_bf16(a, b, acc, 0, 0, 0);
        }
        __syncthreads();
    }
#undef CMP_LOAD
    float bias = 0.f;
    { float bv[16];
#pragma unroll
      for (int c = 0; c < 16; ++c) bv[c] = *(const GAS float*)(P.cbp + (size_t)(kv * 16 + c) * 128 + 16 * wave + fr);
#pragma unroll
      for (int c = 0; c < 16; ++c) bias += bv[c]; }
    LAS bf16* hid = (LAS bf16*)lds;
#pragma unroll
    for (int i = 0; i < 4; ++i) hid[(4 * fq + i) * 136 + 16 * wave + fr] = (bf16)(pk2(silu_f(acc[i] + bias), 0.f) & 0xffffu);
    __syncthreads();
    const bf16* B2 = P.W2 + (size_t)kv * 128 * 128 + (size_t)(16 * wave + fr) * 128 + 8 * fq;
    f32x4 acc2 = {0.f, 0.f, 0.f, 0.f};
#pragma unroll
    for (int s = 0; s < 4; ++s) {
        const bf16x8 a = *(const LAS bf16x8*)(hid + fr * 136 + 32 * s + 8 * fq), b = *(const GAS bf16x8*)(B2 + 32 * s);
        acc2 = __builtin_amdgcn_mfma_f32_16x16x32_bf16(a, b, acc2, 0, 0, 0);
    }
    bf16* out = (kv ? P.VC : P.KC) + (size_t)g * 1024 * 128;
#pragma unroll
    for (int i = 0; i < 4; ++i) { const int nn = 16 * tile + 4 * fq + i; out[(size_t)nn * 128 + 16 * wave + fr] = (nn < 1023) ? (bf16)(pk2(acc2[i], 0.f) & 0xffffu) : (bf16)0; }
    __syncthreads();
}
}
#ifdef CHK_BUILD
namespace chk {
constexpr size_t WS_CHK = 14 * MiB;
__device__ __forceinline__ float bf2f(bf16 v) { return __uint_as_float((unsigned)v << 16); }
__device__ __forceinline__ float e4m3(unsigned char b) {
    const int e = (b >> 3) & 15, mm = b & 7; const float v = e == 0 ? (float)mm * (1.f / 512.f) : (1.f + (float)mm * 0.125f) * exp2f((float)(e - 7)); return (b & 0x80) ? -v : v; }
__device__ __forceinline__ int sample_t(int i) { return i * 64 + (i * 29) % 64; }
__device__ __noinline__ void nsa_check(LAS unsigned char* lds, unsigned char* ws, int t, int g, LAS float* acc2) {
    int tid_ = threadIdx.x; asm volatile("" : "+v"(tid_)); const int tid = tid_, lane = tid & 63, wave = tid >> 6;
    const int hh = 8 * g + wave, cur = t >> 6;
    const bf16* QN = (const bf16*)(ws + WS_QNSA); const bf16* KV = (const bf16*)(ws + WS_KVNSA); const bf16* KC = (const bf16*)(ws + WS_KCMP) + (size_t)g * 1024 * 128; const bf16* VC = (const bf16*)(ws + WS_VCMP) + (size_t)g * 1024 * 128;
    const bf16* ZN = (const bf16*)(ws + WS_ZNSA); const float* GN = (const float*)(ws + WS_GNSA); const bf16* HO = (const bf16*)(ws + WS_H);
    const size_t CH = (size_t)S * 128;
    LAS float* pc = (LAS float*)lds;
    LAS float* impv = (LAS float*)(lds + 32768);
    LAS int* sel = (LAS int*)(lds + 32768 + 1024);
    const float slope2 = exp2f(-0.5f * (float)(hh + 1)) * LOG2E;
    const float q0 = bf2f(QN[(size_t)t * 2048 + hh * 128 + 2 * lane]), q1 = bf2f(QN[(size_t)t * 2048 + hh * 128 + 2 * lane + 1]);
    float oc0 = 0.f, oc1 = 0.f, os0 = 0.f, os1 = 0.f, ow0 = 0.f, ow1 = 0.f;
    const int ncv = (t >= 31) ? (t - 31) / 16 + 1 : 0;
    for (int n = lane; n < 1024; n += 64) pc[wave * 1024 + n] = 0.f;
    float mx = -1e30f;
    for (int n = 0; n < ncv; ++n) { float s = q0 * bf2f(KC[(size_t)n * 128 + 2 * lane]) + q1 * bf2f(KC[(size_t)n * 128 + 2 * lane + 1]); s = wave_sum(s) - slope2 * (float)(t - 16 * n - 31);
        if (lane == 0) pc[wave * 1024 + n] = s; mx = fmaxf(mx, s); }
    __syncthreads();
    float sum = 0.f;
    for (int n = 0; n < ncv; ++n) sum += exp2f(pc[wave * 1024 + n] - mx);
    __syncthreads();
    for (int n = lane; n < 1024; n += 64) pc[wave * 1024 + n] = (n < ncv) ? exp2f(pc[wave * 1024 + n] - mx) / sum : 0.f;
    __syncthreads();
    for (int n = 0; n < ncv; ++n) { const float p = pc[wave * 1024 + n]; oc0 += p * bf2f(VC[(size_t)n * 128 + 2 * lane]); oc1 += p * bf2f(VC[(size_t)n * 128 + 2 * lane + 1]); }
    if (tid < 256) { const int j = tid; float v = -1e30f;
        if (64 * j <= t) { float a = 0.f; for (int ii = 4 * j - 1; ii <= 4 * j + 3; ++ii) if (ii >= 0 && ii <= 1022) { float ps = 0.f; for (int h = 0; h < 8; ++h) ps += pc[h * 1024 + ii]; a += ps; }
            const bool forced = (j == 0) || (j == cur) || (j == cur - 1); v = a + (forced ? 1e4f : 0.f); }
        impv[j] = v; }
    __syncthreads();
    if (tid < 256) { const int j = tid; const float v = impv[j]; int rank = 0; for (int ii = 0; ii < 256; ++ii) { const float u = impv[ii]; rank += (u > v || (u == v && ii < j)) ? 1 : 0; } sel[j] = rank < 16 ? 1 : 0; }
    __syncthreads();
    const bf16* KS = KV + (size_t)(4 + g) * CH; const bf16* VSl = KV + (size_t)(6 + g) * CH;
    mx = -1e30f;
    for (int j = 0; j < 256; ++j) if (sel[j]) for (int tok = 64 * j; tok < 64 * j + 64 && tok <= t; ++tok) {
        float s = q0 * bf2f(KS[(size_t)tok * 128 + 2 * lane]) + q1 * bf2f(KS[(size_t)tok * 128 + 2 * lane + 1]); s = wave_sum(s) - slope2 * (float)(t - tok); mx = fmaxf(mx, s); }
    sum = 0.f;
    for (int j = 0; j < 256; ++j) if (sel[j]) for (int tok = 64 * j; tok < 64 * j + 64 && tok <= t; ++tok) {
        float s = q0 * bf2f(KS[(size_t)tok * 128 + 2 * lane]) + q1 * bf2f(KS[(size_t)tok * 128 + 2 * lane + 1]); s = wave_sum(s) - slope2 * (float)(t - tok);
        const float p = exp2f(s - mx); sum += p; os0 += p * bf2f(VSl[(size_t)tok * 128 + 2 * lane]); os1 += p * bf2f(VSl[(size_t)tok * 128 + 2 * lane + 1]); }
    os0 /= sum; os1 /= sum;
    const bf16* KW = KV + (size_t)(8 + g) * CH; const bf16* VW = KV + (size_t)(10 + g) * CH;
    const int lo = t - 511 > 0 ? t - 511 : 0;
    mx = -1e30f;
    for (int tok = lo; tok <= t; ++tok) { float s = q0 * bf2f(KW[(size_t)tok * 128 + 2 * lane]) + q1 * bf2f(KW[(size_t)tok * 128 + 2 * lane + 1]); s = wave_sum(s) - slope2 * (float)(t - tok); mx = fmaxf(mx, s); }
    sum = 0.f;
    for (int tok = lo; tok <= t; ++tok) { float s = q0 * bf2f(KW[(size_t)tok * 128 + 2 * lane]) + q1 * bf2f(KW[(size_t)tok * 128 + 2 * lane + 1]); s = wave_sum(s) - slope2 * (float)(t - tok);
        const float p = exp2f(s - mx); sum += p; ow0 += p * bf2f(VW[(size_t)tok * 128 + 2 * lane]); ow1 += p * bf2f(VW[(size_t)tok * 128 + 2 * lane + 1]); }
    ow0 /= sum; ow1 /= sum;
    const float gc = GN[(size_t)t * 48 + hh], gs = GN[(size_t)t * 48 + 16 + hh], gwv = GN[(size_t)t * 48 + 32 + hh];
    const float r0 = (gc * oc0 + gs * os0 + gwv * ow0) * bf2f(ZN[(size_t)t * 2048 + hh * 128 + 2 * lane]), r1 = (gc * oc1 + gs * os1 + gwv * ow1) * bf2f(ZN[(size_t)t * 2048 + hh * 128 + 2 * lane + 1]);
    const float f0 = bf2f(HO[(size_t)t * 4096 + 2048 + hh * 128 + 2 * lane]), f1 = bf2f(HO[(size_t)t * 4096 + 2048 + hh * 128 + 2 * lane + 1]);
    const float e2 = wave_sum((r0 - f0) * (r0 - f0) + (r1 - f1) * (r1 - f1)), n2 = wave_sum(r0 * r0 + r1 * r1);
    __syncthreads();
    if (lane == 0) { pc[wave] = e2; pc[8 + wave] = n2; }
    __syncthreads();
    if (tid == 0) { float a = 0.f, b = 0.f; for (int w = 0; w < 8; ++w) { a += pc[w]; b += pc[8 + w]; } acc2[0] += a; acc2[1] += b; }
    __syncthreads();
}
__device__ __forceinline__ void mla_check(LAS unsigned char* lds, unsigned char* ws, int t, LAS float* acc2) {
    int tid_ = threadIdx.x; asm volatile("" : "+v"(tid_)); const int tid = tid_, lane = tid & 63, wave = tid >> 6;
    const bf16* ZM = (const bf16*)(ws + WS_ZMLA); const bf16* HO = (const bf16*)(ws + WS_H);
    LAS float* qs = (LAS float*)lds + wave * 192;
    LAS float* red = (LAS float*)lds + 8 * 192;
    float ae = 0.f, an = 0.f;
    for (int rep = 0; rep < 2; ++rep) { const int head = wave + 8 * rep;
#ifdef MLA_FP8
        { const unsigned char* qp = (const unsigned char*)(ws + WS_QMLA) + (size_t)t * 3072 + head * 192; for (int d = lane; d < 192; d += 64) qs[d] = e4m3(qp[d]) * QS_MLA; }
#else
        { const bf16* qp = (const bf16*)(ws + WS_QMLA) + (size_t)t * 3072 + head * 192; for (int d = lane; d < 192; d += 64) qs[d] = bf2f(qp[d]); }
#endif
        __syncthreads();
        float mx = -1e30f;
        for (int c = 0; 64 * c <= t; ++c) {
#ifdef MLA_MX
            const int tok = 64 * c + 8 * ((lane >> 2) & 7) + 4 * (lane >> 5) + (lane & 3);
#else
            const int x_ = lane & 15; const int tok = 64 * c + (lane & 48) + (x_ < 4 ? x_ : (x_ < 8 ? x_ + 4 : (x_ < 12 ? x_ - 4 : x_)));
#endif

            float s = 0.f;
#ifdef MLA_FP8
            const unsigned char* kp = (const unsigned char*)(ws + WS_KMLA) + (size_t)tok * 3072 + head * 192; for (int d = 0; d < 192; ++d) s += qs[d] * e4m3(kp[d]);
#else
            const bf16* kp = (const bf16*)(ws + WS_KMLA) + (size_t)tok * 3072 + head * 192; for (int d = 0; d < 192; ++d) s += qs[d] * bf2f(kp[d]);
#endif
            if (tok <= t) mx = fmaxf(mx, s); }
        for (int off = 1; off < 64; off <<= 1) mx = fmaxf(mx, __shfl_xor(mx, off));
        float e2 = 0.f, n2 = 0.f;
        for (int dc = 0; dc < 8; ++dc) {
        float sum = 0.f; float o[16];
#pragma unroll
        for (int d = 0; d < 16; ++d) o[d] = 0.f;
        for (int c = 0; 64 * c <= t; ++c) {
#ifdef MLA_MX
            const int tok = 64 * c + 8 * ((lane >> 2) & 7) + 4 * (lane >> 5) + (lane & 3);
#else
            const int x_ = lane & 15; const int tok = 64 * c + (lane & 48) + (x_ < 4 ? x_ : (x_ < 8 ? x_ + 4 : (x_ < 12 ? x_ - 4 : x_)));
#endif

            float s = 0.f;
#ifdef MLA_FP8
            const unsigned char* kp = (const unsigned char*)(ws + WS_KMLA) + (size_t)tok * 3072 + head * 192; for (int d = 0; d < 192; ++d) s += qs[d] * e4m3(kp[d]);
#else
            const bf16* kp = (const bf16*)(ws + WS_KMLA) + (size_t)tok * 3072 + head * 192; for (int d = 0; d < 192; ++d) s += qs[d] * bf2f(kp[d]);
#endif
            const float p = (tok <= t) ? exp2f(s - mx) : 0.f; sum += p;
#ifdef MLA_FP8V
            const unsigned char* vt = (const unsigned char*)(ws + WS_VMLA) + ((size_t)head * 128 + 16 * dc) * S + 64 * c + lane;
#pragma unroll
            for (int d = 0; d < 16; ++d) o[d] += p * e4m3(vt[(size_t)d * S]);
#else
            const bf16* vp = (const bf16*)(ws + WS_VMLA) + (size_t)tok * 2048 + head * 128 + 16 * dc;
#pragma unroll
            for (int d = 0; d < 16; ++d) o[d] += p * bf2f(vp[d]);
#endif
        }
        sum = wave_sum(sum);
#pragma unroll
        for (int d = 0; d < 16; ++d) { const float od = wave_sum(o[d]) / sum; const float r = od * bf2f(ZM[(size_t)t * 2048 + head * 128 + 16 * dc + d]), f = bf2f(HO[(size_t)t * 4096 + head * 128 + 16 * dc + d]); e2 += (r - f) * (r - f); n2 += r * r; }
        }
        ae += e2; an += n2;
        __syncthreads(); }
    if (lane == 0) { red[wave] = ae; red[8 + wave] = an; }
    __syncthreads();
    if (tid == 0) { float a = 0.f, b = 0.f; for (int w = 0; w < 8; ++w) { a += red[w]; b += red[8 + w]; } acc2[0] += a; acc2[1] += b; }
    __syncthreads();
}
}
#endif
#ifdef CHK2_BUILD
namespace chk2 {
constexpr size_t WS_CHK = 14 * MiB;
__device__ __forceinline__ float bf2f(bf16 v) { return __uint_as_float((unsigned)v << 16); }
__device__ __forceinline__ int sample_t(int i) { return i * 256 + (i * 29) % 256; }
__device__ __noinline__ void proj_check(LAS unsigned char* lds, unsigned char* ws, const float* x, const float* w_in_l, int l, int i, int qd, LAS float* acc2) {
    int tid_ = threadIdx.x; asm volatile("" : "+v"(tid_)); const int tid = tid_;
    const int t = sample_t(i);
    LAS float* h = (LAS float*)lds;
    LAS float* red = h + 4096;
    const float* mod = (const float*)(ws + WS_MOD) + (size_t)l * 3 * D;
    const float* xin = (l == 0) ? x : (const float*)(ws + WS_XV);
    for (int k = tid; k < D; k += NTHR) h[k] = xin[(size_t)t * D + k] * (1.f + mod[D + k]) + mod[k];
    __syncthreads();
    float e2 = 0.f, r2 = 0.f;
    const float* cosT = (const float*)(ws + WS_ROPE); const float* sinT = cosT + (size_t)S * 32;
    for (int n = qd * 2268 + tid; n < (qd + 1) * 2268; n += NTHR) {
        float a = 0.f;
        for (int k = 0; k < D; ++k) a += h[k] * w_in_l[(size_t)k * INC + n];
        float ref = a, got;
        if (n < 768) got = bf2f(((const bf16*)(ws + WS_QLAT))[(size_t)t * 768 + n]);
        else if (n < 1280) got = bf2f(((const bf16*)(ws + WS_KVLAT))[(size_t)t * 512 + n - 768]);
        else if (n < 1344) {
            const int ii = n - 1280, pi = ii & 31; const int np = 1280 + (ii < 32 ? ii + 32 : ii - 32); float b = 0.f;
            for (int k = 0; k < D; ++k) b += h[k] * w_in_l[(size_t)k * INC + np];
            const float c = cosT[(size_t)t * 32 + pi], s = sinT[(size_t)t * 32 + pi];
            ref = ii < 32 ? a * c - b * s : a * c + b * s;
            got = bf2f(((const bf16*)(ws + WS_KMLA))[(size_t)t * 3072 + 5 * 192 + 128 + 2 * pi + (ii >> 5)]);
        }
        else if (n < 3392) { ref = a / (1.f + expf(-a)); got = bf2f(((const bf16*)(ws + WS_ZMLA))[(size_t)t * 2048 + n - 1344]); }
        else if (n < 5440) { ref = a * QS_NSA; got = bf2f(((const bf16*)(ws + WS_QNSA))[(size_t)t * 2048 + n - 3392]); }
        else if (n < 6976) { const int c = n - 5440; got = bf2f(((const bf16*)(ws + WS_KVNSA))[(size_t)(c >> 7) * ((size_t)S * 128) + (size_t)t * 128 + (c & 127)]); }
        else if (n < 7024) { ref = 1.f / (1.f + expf(-a)); got = ((const float*)(ws + WS_GNSA))[(size_t)t * 48 + n - 6976]; }
        else { ref = a / (1.f + expf(-a)); got = bf2f(((const bf16*)(ws + WS_ZNSA))[(size_t)t * 2048 + n - 7024]); }
        e2 += (ref - got) * (ref - got); r2 += ref * ref;
    }
    red[tid] = e2; red[512 + tid] = r2;
    __syncthreads();
    if (tid == 0) { float a = 0.f, b = 0.f; for (int k = 0; k < 512; ++k) { a += red[k]; b += red[512 + k]; } acc2[0] += a; acc2[1] += b; }
    __syncthreads();
}
__device__ __noinline__ void cmp_check(LAS unsigned char* lds, unsigned char* ws, const float* cmp_pos_l, const float* w1_l, const float* w2_l, int i, LAS float* acc2) {
    int tid_ = threadIdx.x; asm volatile("" : "+v"(tid_)); const int tid = tid_;
    const int n = (4 * i + (i & 3)) % 1023, kv = i & 1, g = (i >> 1) & 1;
    LAS float* blk = (LAS float*)lds;
    LAS float* hid = blk + 4096;
    LAS float* red = hid + 128;
    const bf16* A = (const bf16*)(ws + WS_KVNSA) + (size_t)(kv * 2 + g) * ((size_t)S * 128) + (size_t)n * 2048;
    for (int k = tid; k < 4096; k += NTHR) blk[k] = bf2f(A[k]) + cmp_pos_l[(size_t)kv * 4096 + k];
    __syncthreads();
    if (tid < 128) { float a = 0.f; const float* W = w1_l + (size_t)kv * 4096 * 128 + tid; for (int k = 0; k < 4096; ++k) a += blk[k] * W[(size_t)k * 128]; hid[tid] = a / (1.f + expf(-a)); }
    __syncthreads();
    float e2 = 0.f, r2 = 0.f;
    if (tid < 128) { float a = 0.f; const float* W = w2_l + (size_t)kv * 128 * 128 + tid; for (int k = 0; k < 128; ++k) a += hid[k] * W[(size_t)k * 128];
        const float got = bf2f(((const bf16*)(ws + (kv ? WS_VCMP : WS_KCMP)))[(size_t)g * 1024 * 128 + (size_t)n * 128 + tid]); e2 = (a - got) * (a - got); r2 = a * a; }
    if (tid < 128) { red[tid] = e2; red[128 + tid] = r2; }
    __syncthreads();
    if (tid == 0) { float a = 0.f, b = 0.f; for (int k = 0; k < 128; ++k) { a += red[k]; b += red[128 + k]; } acc2[0] += a; acc2[1] += b; }
    __syncthreads();
}
}
#endif
#ifdef CHK3_BUILD
namespace chk3 {
constexpr size_t WS_CHK = 14 * MiB;
__device__ __forceinline__ float bf2f(bf16 v) { return __uint_as_float((unsigned)v << 16); }
__device__ __forceinline__ float e4m3(unsigned char b) { const int e = (b >> 3) & 15, mm = b & 7; const float v = e == 0 ? (float)mm * (1.f / 512.f) : (1.f + (float)mm * 0.125f) * exp2f((float)(e - 7)); return (b & 0x80) ? -v : v; }
__device__ __forceinline__ int sample_t(int i) { return i * 64 + (i * 29) % 64; }
__device__ __noinline__ void up_check(LAS unsigned char* lds, unsigned char* ws, const float* qn, const float* wq, const float* kn, const float* wkv, int i, LAS float* acc2) {
    int tid_ = threadIdx.x; asm volatile("" : "+v"(tid_)); const int tid = tid_;
    const int t = sample_t(i);
    LAS float* ql = (LAS float*)lds;
    LAS float* kl = ql + 768;
    LAS float* qo = kl + 512;
    LAS float* red = qo + 3072;
    const bf16* QL = (const bf16*)(ws + WS_QLAT) + (size_t)t * 768; const bf16* KL = (const bf16*)(ws + WS_KVLAT) + (size_t)t * 512;
    float s = 0.f; for (int k = tid; k < 768; k += NTHR) { const float v = bf2f(QL[k]); s += v * v; }
    red[tid] = s; __syncthreads();
    float tot = 0.f; for (int k = 0; k < 512; ++k) tot += red[k];
    const float rq = 1.f / sqrtf(tot / 768.f + RMS_EPS);
    __syncthreads();
    s = 0.f; for (int k = tid; k < 512; k += NTHR) { const float v = bf2f(KL[k]); s += v * v; }
    red[tid] = s; __syncthreads();
    tot = 0.f; for (int k = 0; k < 512; ++k) tot += red[k];
    const float rk = 1.f / sqrtf(tot / 512.f + RMS_EPS);
    __syncthreads();
    for (int k = tid; k < 768; k += NTHR) ql[k] = bf2f(QL[k]) * rq * qn[k];
    for (int k = tid; k < 512; k += NTHR) kl[k] = bf2f(KL[k]) * rk * kn[k];
    __syncthreads();
    for (int n = tid; n < 3072; n += NTHR) { float a = 0.f; for (int k = 0; k < 768; ++k) a += ql[k] * wq[(size_t)k * 3072 + n]; qo[n] = a; }
    __syncthreads();
    float e2 = 0.f, r2 = 0.f;
    const float* cosT = (const float*)(ws + WS_ROPE); const float* sinT = cosT + (size_t)S * 32;
    const bf16* QM = (const bf16*)(ws + WS_QMLA) + (size_t)t * 3072;
    for (int n = tid; n < 3072; n += NTHR) { const int h = n / 192, d = n % 192; float ref, got;
#ifdef MLA_FP8
        const unsigned char* Q8 = (const unsigned char*)(ws + WS_QMLA) + (size_t)t * 3072;
        if (d < 128) { ref = qo[n]; got = e4m3(Q8[h * 192 + d]); }
        else { const int ii = d - 128, pi = ii & 31; const float x1 = qo[h * 192 + 128 + pi], x2 = qo[h * 192 + 160 + pi]; const float c = cosT[(size_t)t * 32 + pi], sn = sinT[(size_t)t * 32 + pi];
            ref = (ii < 32 ? x1 * c - x2 * sn : x2 * c + x1 * sn); got = e4m3(Q8[h * 192 + 128 + 2 * pi + (ii >> 5)]); }
        if (false) {}
#else
        if (d < 128) { ref = qo[n] * QS_MLA; got = bf2f(QM[h * 192 + d]); }
        else { const int ii = d - 128, pi = ii & 31; const float x1 = qo[h * 192 + 128 + pi], x2 = qo[h * 192 + 160 + pi]; const float c = cosT[(size_t)t * 32 + pi], sn = sinT[(size_t)t * 32 + pi];
            ref = (ii < 32 ? x1 * c - x2 * sn : x2 * c + x1 * sn) * QS_MLA; got = bf2f(QM[h * 192 + 128 + 2 * pi + (ii >> 5)]); }
#endif
        e2 += (ref - got) * (ref - got); r2 += ref * ref; }
    const bf16* KM = (const bf16*)(ws + WS_KMLA) + (size_t)t * 3072; const bf16* VM = (const bf16*)(ws + WS_VMLA) + (size_t)t * 2048;
    for (int n = tid; n < 4096; n += NTHR) { float a = 0.f; for (int k = 0; k < 512; ++k) a += kl[k] * wkv[(size_t)k * 4096 + n];
#ifdef MLA_FP8
        const int h = n >> 8, d = n & 255; const float got = d < 128 ? e4m3(((const unsigned char*)(ws + WS_KMLA) + (size_t)t * 3072)[h * 192 + d]) : bf2f(VM[h * 128 + d - 128]);
#else
        const int h = n >> 8, d = n & 255; const float got = d < 128 ? bf2f(KM[h * 192 + d]) : bf2f(VM[h * 128 + d - 128]);
#endif
        e2 += (a - got) * (a - got); r2 += a * a; }
    red[tid] = e2; red[512 + tid] = r2;
    __syncthreads();
    if (tid == 0) { float a = 0.f, b = 0.f; for (int k = 0; k < 512; ++k) { a += red[k]; b += red[512 + k]; } acc2[0] += a; acc2[1] += b; }
    __syncthreads();
}
__device__ __noinline__ void out_check(LAS unsigned char* lds, unsigned char* ws, const float* xin, const float* xv, const float* wout, const float* gate, int i, int qd, LAS float* acc2) {
    int tid_ = threadIdx.x; asm volatile("" : "+v"(tid_)); const int tid = tid_;
    const int t = i * 256 + (i * 29) % 256;
    LAS float* o = (LAS float*)lds;
    LAS float* red = o + 4096;
    const bf16* OA = (const bf16*)(ws + WS_H) + (size_t)t * 4096;
    for (int k = tid; k < 4096; k += NTHR) o[k] = bf2f(OA[k]);
    __syncthreads();
    float e2 = 0.f, r2 = 0.f;
    for (int n = qd * 1024 + tid; n < (qd + 1) * 1024; n += NTHR) { float a = 0.f; for (int k = 0; k < 4096; ++k) a += o[k] * wout[(size_t)k * 4096 + n];
        const float gy = gate[n] * a, ref = DN_ALPHA * xin[(size_t)t * D + n] + gy, got = xv[(size_t)t * D + n];
        e2 += (ref - got) * (ref - got); r2 += gy * gy; }
    red[tid] = e2; red[512 + tid] = r2;
    __syncthreads();
    if (tid == 0) { float a = 0.f, b = 0.f; for (int k = 0; k < 512; ++k) { a += red[k]; b += red[512 + k]; } acc2[0] += a; acc2[1] += b; }
    __syncthreads();
}
}
#endif
#ifdef CHK4_BUILD
namespace chk4 {
__device__ __forceinline__ float bf2f(bf16 v) { return __uint_as_float((unsigned)v << 16); }
__device__ __noinline__ void mod_check(LAS unsigned char* lds, unsigned char* ws, const float* c, const float* w_ada, const float* b_ada, int u, LAS float* acc2) {
    const int tid = threadIdx.x;
    LAS float* red = (LAS float*)lds;
    const int l = u & 1, n = ((u >> 1) * 977 + 13) % (3 * D);
    float a = 0.f;
    for (int k = tid; k < D; k += NTHR) { const float cv = c[k]; a += cv / (1.f + expf(-cv)) * w_ada[(size_t)l * D * 3 * D + (size_t)k * 3 * D + n]; }
    red[tid] = a; __syncthreads();
    if (tid == 0) { float s = 0.f; for (int k = 0; k < NTHR; ++k) s += red[k]; s += b_ada[(size_t)l * 3 * D + n];
        const float got = ((const float*)(ws + WS_MOD))[(size_t)l * 3 * D + n]; acc2[0] += (s - got) * (s - got); acc2[1] += s * s; }
    __syncthreads();
}
__device__ __noinline__ void ln_check(LAS unsigned char* lds, unsigned char* ws, const float* ln_g, const float* ln_b, int u, LAS float* acc2) {
    const int tid = threadIdx.x;
    LAS float* red = (LAS float*)lds;
    const int t = u * 64 + (u * 29) % 64;
    const float* X1 = (const float*)(ws + WS_XV) + (size_t)t * D; const bf16* H = (const bf16*)(ws + WS_H) + (size_t)t * D; const float* mod1 = (const float*)(ws + WS_MOD) + 3 * D;
    float s1 = 0.f, s2 = 0.f, e2 = 0.f, r2 = 0.f;
    for (int k = tid; k < D; k += NTHR) { const float y = (X1[k] - ln_b[k]) / ln_g[k]; s1 += y; s2 += y * y;
        const float h = X1[k] * (1.f + mod1[D + k]) + mod1[k], got = bf2f(H[k]); e2 += (h - got) * (h - got); r2 += h * h; }
    red[tid] = s1; red[512 + tid] = s2; red[1024 + tid] = e2; red[1536 + tid] = r2; __syncthreads();
    if (tid == 0) { float a = 0.f, b = 0.f, c = 0.f, d = 0.f; for (int k = 0; k < NTHR; ++k) { a += red[k]; b += red[512 + k]; c += red[1024 + k]; d += red[1536 + k]; }
        const float mean = a / D, var = b / D - mean * mean;
        acc2[0] += mean * mean + (var - 1.f) * (var - 1.f) + c / d; acc2[1] += 1.f; }
    __syncthreads();
}
}
#endif
constexpr int PPL = 6;
constexpr int N_PHASES = 2 + PPL * DEPTH;
struct Args { const void* in[16]; float* out; unsigned char* ws; int ph_lo, ph_hi; };
#define WSP(T, off) ((T*)(ws + (off)))
#define VCU() ((gridDim.x % 8 == 0) ? (int)((blockIdx.x % 8) * (gridDim.x / 8) + blockIdx.x / 8) : (int)blockIdx.x)
__global__ void __launch_bounds__(NTHR, 2) mk_fwd(const Args args) {
    extern __shared__ __attribute__((aligned(16))) unsigned char lds_raw[];
    LAS unsigned char* lds = (LAS unsigned char*)lds_raw;
    if (threadIdx.x < 32) ((volatile LAS unsigned*)(lds + MISC_OFF))[threadIdx.x] = 0u;
    __syncthreads();
    XcdBarrier bar = xcd_barrier_post((unsigned*)(args.ws + WS_CTL) + CW_BAR, (volatile LAS unsigned*)(lds + MISC_OFF) + 8);
#define IN(k) (args.ph_lo <= (k) && (k) < args.ph_hi)
#define SEAM(k) do { if (IN(k) && IN((k) + 1)) xcd_barrier(bar); } while (0)
#define PHASE_REGS int tid_ = threadIdx.x; asm volatile("" : "+v"(tid_)); const int tid = tid_, lane = tid & 63, wave = __builtin_amdgcn_readfirstlane(tid >> 6); \
    unsigned char* ws = args.ws; asm volatile("" : "+s"(ws)); (void)tid; (void)lane; (void)wave

    if (IN(0)) {
        PHASE_REGS; const int G = gridDim.x, vcu = VCU();
        p0_mod_gemv((const float*)args.in[1], (const float*)args.in[3], (const float*)args.in[4], WSP(float, WS_MOD), (LAS float*)lds, vcu, G);
        p0_cmpbias((const float*)args.in[10], (const float*)args.in[11], WSP(float, WS_CBP), (LAS float*)lds, (vcu + G / 2) % G, G);
        p0_rope((const int*)args.in[2], WSP(float, WS_ROPE), WSP(float, WS_ROPE) + (size_t)S * 32, vcu * NTHR + tid, G * NTHR);
        const P0In I{(const float*)args.in[5], (const float*)args.in[6], (const float*)args.in[7], (const float*)args.in[8], (const float*)args.in[9], (const float*)args.in[11], (const float*)args.in[12], (const float*)args.in[13]};
#ifndef DIS_CONV
        p0_convert(I, ws, vcu * NWAVES + wave, G * NWAVES, lane);
#endif
#ifdef PROBE_P0CONV2
        p0_convert(I, ws, vcu * NWAVES + wave, G * NWAVES, lane);
#endif
#ifdef PROBE_P0MOD2
        __syncthreads(); p0_mod_gemv((const float*)args.in[1], (const float*)args.in[3], (const float*)args.in[4], WSP(float, WS_MOD), (LAS float*)lds, vcu, G);
#endif
    }
    SEAM(0);
#ifdef GEMM_F8
#define H8PTR WSP(unsigned char, WS_H8)
#else
#define H8PTR ((unsigned char*)nullptr)
#endif
    if (IN(1)) { PHASE_REGS; modulate_rows((const float*)args.in[0], WSP(bf16, WS_H), H8PTR, WSP(float, WS_MOD), VCU() * NWAVES + wave, gridDim.x * NWAVES, lane);
#ifdef PROBE_THIN2
        modulate_rows((const float*)args.in[0], WSP(bf16, WS_H), H8PTR, WSP(float, WS_MOD), VCU() * NWAVES + wave, gridDim.x * NWAVES, lane);
#endif
    }
    SEAM(1);
    for (int l = 0; l < DEPTH; ++l) {
        const int pb = 2 + PPL * l;
        if (IN(pb + 0)) {
            PHASE_REGS;
#ifdef GEMM_F8
            { pg8::Gemm gg{WSP(bf16, WS_H), (const bf16*)(ws + WS_W + (size_t)l * W_LSTRIDE + W_IN), S, 23 * 256, D}; pg8::InBf16Order SO; SO.init(S, 23 * 256, gridDim.x, blockIdx.x);
              const pg8::EpiIn E{ws, 0};
              pg8::gemm_phase<pg8::EpiIn, pg8::InBf16Order, true, true>(lds, gg, SO, E);
#ifdef PROBE_INB2
              pg8::gemm_phase<pg8::EpiIn, pg8::InBf16Order, true, true>(lds, gg, SO, E);
#endif
            }
            { pg8::Gemm gg{(const bf16*)(ws + WS_H8), (const bf16*)(ws + WS_WIN8 + (size_t)l * WIN8_LSTRIDE), S, 13 * 256, D / 2}; pg8::StaticOrder SO; SO.init(S, 13 * 256, gridDim.x, (blockIdx.x + 64) % gridDim.x);
              const pg8::EpiIn E{ws, 1};
              pg8::gemm_phase<pg8::EpiIn, pg8::StaticOrder, true, true, 0x79797979, 0x7f7f7f7f>(lds, gg, SO, E);
#ifdef PROBE_INF2
              pg8::gemm_phase<pg8::EpiIn, pg8::StaticOrder, true, true, 0x79797979, 0x7f7f7f7f>(lds, gg, SO, E);
#endif
            }
#else
            pg8::Gemm gg{WSP(bf16, WS_H), (const bf16*)(ws + WS_W + (size_t)l * W_LSTRIDE + W_IN), S, NIN, D}; pg8::StaticOrder SO; SO.init(S, NIN, gridDim.x, blockIdx.x);
            const pg8::EpiIn E{ws, 0};
#ifndef DIS_IN
            pg8::gemm_phase<pg8::EpiIn, pg8::StaticOrder, true, true>(lds, gg, SO, E);
#endif
#ifdef PROBE_IN2
            pg8::gemm_phase<pg8::EpiIn, pg8::StaticOrder, true, true>(lds, gg, SO, E);
#endif
#endif
        }
        SEAM(pb + 0);
        if (IN(pb + 1)) {
            PHASE_REGS; const int G = gridDim.x, vcu = VCU();
            rstd_rows(WSP(float, WS_RSQQ), WSP(float, WS_RSQKV), WSP(float, WS_RSTD), WSP(float, WS_RSTD) + S, vcu * NTHR + tid, G * NTHR);
            const att::CmpPtrs CP{WSP(bf16, WS_KVNSA), (const bf16*)(ws + WS_W + (size_t)l * W_LSTRIDE + W_C1), (const bf16*)(ws + WS_W + (size_t)l * W_LSTRIDE + W_C2),
                                  WSP(float, WS_CBP) + (size_t)l * 2 * 16 * 128, WSP(bf16, WS_KCMP), WSP(bf16, WS_VCMP)};
#ifndef DIS_CMP
            for (int u = vcu; u < 256; u += G) att::cmp_unit(lds, CP, u & 1, (u >> 1) & 1, u >> 2, tid, wave, lane);
#endif
#ifdef PROBE_THIN2
            rstd_rows(WSP(float, WS_RSQQ), WSP(float, WS_RSQKV), WSP(float, WS_RSTD), WSP(float, WS_RSTD) + S, vcu * NTHR + tid, G * NTHR);
            for (int u = vcu; u < 256; u += G) att::cmp_unit(lds, CP, u & 1, (u >> 1) & 1, u >> 2, tid, wave, lane);
#endif
        }
        SEAM(pb + 1);
        if (IN(pb + 2)) {
            PHASE_REGS;
#ifdef GEMM_F8
            { pg8::Gemm gg{WSP(bf16, WS_QLAT), (const bf16*)(ws + WS_W + (size_t)l * W_LSTRIDE + W_QUP), S, 3072, 384}; pg8::StaticOrder SO; SO.init(S, 3072, gridDim.x, blockIdx.x);
              const pg8::EpiQup E{ws};
              pg8::gemm_phase<pg8::EpiQup, pg8::StaticOrder, true, true, 0x7a7a7a7a, 0x7f7f7f7f>(lds, gg, SO, E);
#ifdef PROBE_UPF2
              pg8::gemm_phase<pg8::EpiQup, pg8::StaticOrder, true, true, 0x7a7a7a7a, 0x7f7f7f7f>(lds, gg, SO, E);
#endif
            }
            { pg8::Gemm gg{WSP(bf16, WS_KVLAT), (const bf16*)(ws + WS_W + (size_t)l * W_LSTRIDE + W_KVUP), S, 2048, 256}; pg8::StaticOrder SO; SO.init(S, 2048, gridDim.x, blockIdx.x);
              const pg8::EpiKup E{ws};
              pg8::gemm_phase<pg8::EpiKup, pg8::StaticOrder, true, true, 0x7a7a7a7a, 0x7f7f7f7f>(lds, gg, SO, E);
#ifdef PROBE_UPF2
              pg8::gemm_phase<pg8::EpiKup, pg8::StaticOrder, true, true, 0x7a7a7a7a, 0x7f7f7f7f>(lds, gg, SO, E);
#endif
            }
            { pg8::Gemm gg{(const bf16*)(ws + WS_W + (size_t)l * W_LSTRIDE + W_KVUP + (size_t)2048 * 512), WSP(bf16, WS_KVLAT), 2048, S, 256}; pg8::StaticOrder SO; SO.init(2048, S, gridDim.x, blockIdx.x);
              const pg8::EpiVt E{ws};
              pg8::gemm_phase<pg8::EpiVt, pg8::StaticOrder, true, true, 0x7f7f7f7f, 0x7a7a7a7a>(lds, gg, SO, E);
#ifdef PROBE_UPF2
              pg8::gemm_phase<pg8::EpiVt, pg8::StaticOrder, true, true, 0x7f7f7f7f, 0x7a7a7a7a>(lds, gg, SO, E);
#endif
            }
        }
#else
            { pg8::Gemm gg{WSP(bf16, WS_QLAT), (const bf16*)(ws + WS_W + (size_t)l * W_LSTRIDE + W_QUP), S, 3072, 768}; pg8::StaticOrder SO; SO.init(S, 3072, gridDim.x, blockIdx.x);
              const pg8::EpiQup E{ws};
#ifndef DIS_QUP
              pg8::gemm_phase<pg8::EpiQup, pg8::StaticOrder, true, true>(lds, gg, SO, E);
#endif
#ifdef PROBE_UP2
              pg8::gemm_phase<pg8::EpiQup, pg8::StaticOrder, true, true>(lds, gg, SO, E);
#endif
            }
#ifdef MLA_FP8V
            { pg8::Gemm gg{WSP(bf16, WS_KVLAT), (const bf16*)(ws + WS_W + (size_t)l * W_LSTRIDE + W_KVUP), S, 2048, 512}; pg8::StaticOrder SO; SO.init(S, 2048, gridDim.x, blockIdx.x);
              const pg8::EpiKup E{ws};
              pg8::gemm_phase<pg8::EpiKup, pg8::StaticOrder, true, true>(lds, gg, SO, E);
            }
            { pg8::Gemm gg{(const bf16*)(ws + WS_W + (size_t)l * W_LSTRIDE + W_KVUP) + (size_t)2048 * 512, WSP(bf16, WS_KVLAT), 2048, S, 512}; pg8::StaticOrder SO; SO.init(2048, S, gridDim.x, blockIdx.x);
              const pg8::EpiVt E{ws};
              pg8::gemm_phase<pg8::EpiVt, pg8::StaticOrder, true, true>(lds, gg, SO, E);
            }
        }
#else
            { pg8::Gemm gg{WSP(bf16, WS_KVLAT), (const bf16*)(ws + WS_W + (size_t)l * W_LSTRIDE + W_KVUP), S, 4096, 512}; pg8::StaticOrder SO; SO.init(S, 4096, gridDim.x, blockIdx.x);
              const pg8::EpiKvup E{ws};
#ifndef DIS_KVUP
              pg8::gemm_phase<pg8::EpiKvup, pg8::StaticOrder, true, true>(lds, gg, SO, E);
#endif
#ifdef PROBE_UP2
              pg8::gemm_phase<pg8::EpiKvup, pg8::StaticOrder, true, true>(lds, gg, SO, E);
#endif
            }
        }
#endif
#endif
        SEAM(pb + 2);
        if (IN(pb + 3)) {
            PHASE_REGS; const int G = gridDim.x, vcu = VCU();
            { const att::MlaPtrs MP{WSP(bf16, WS_QMLA), WSP(bf16, WS_KMLA), WSP(bf16, WS_VMLA), WSP(bf16, WS_ZMLA), WSP(bf16, WS_H)};
              for (int pu = vcu; pu < 512; pu += G) { const int head = pu >> 5, pr = pu & 31;
#ifndef DIS_MLA
                  att::mla_unit(lds, MP, head, 63 - pr, tid, wave, lane);
                  att::mla_unit(lds, MP, head, pr, tid, wave, lane);
#endif
              }
#ifdef PROBE_MLA2
              for (int pu = vcu; pu < 512; pu += G) { const int head = pu >> 5, pr = pu & 31; att::mla_unit(lds, MP, head, 63 - pr, tid, wave, lane); att::mla_unit(lds, MP, head, pr, tid, wave, lane); }
#endif
            }
            { const att::NsaPtrs NP{WSP(bf16, WS_QNSA), WSP(bf16, WS_KVNSA), WSP(bf16, WS_KCMP), WSP(bf16, WS_VCMP), WSP(bf16, WS_ZNSA), WSP(float, WS_GNSA), WSP(bf16, WS_H), WSP(float, WS_OSCR)};
#ifndef DIS_NSA
              for (int u = vcu; u < 1024; u += G) { const int v_ = (u >> 1) & 127, k_ = u >> 8;
                  att::nsa_unit(lds, NP, u & 1, (k_ & 1) ? 128 * k_ + 127 - v_ : 128 * k_ + v_, tid, wave, lane, blockIdx.x); }
#endif
#ifdef PROBE_NSA2
              for (int u = vcu; u < 1024; u += G) att::nsa_unit(lds, NP, u & 1, u >> 1, tid, wave, lane, blockIdx.x);
#endif
            }
        }
        SEAM(pb + 3);
        if (IN(pb + 4)) {
            PHASE_REGS;
            pg8::Gemm gg{WSP(bf16, WS_H), (const bf16*)(ws + WS_W + (size_t)l * W_LSTRIDE + W_OUT), S, D, D}; pg8::StaticOrder SO; SO.init(S, D, gridDim.x, blockIdx.x);
            const pg8::EpiOut E{WSP(bf16, WS_Y), WSP(const float, WS_MOD) + (size_t)l * 3 * D + 2 * D};
#ifndef DIS_OUT
            pg8::gemm_phase<pg8::EpiOut, pg8::StaticOrder, true, true>(lds, gg, SO, E);
#endif
#ifdef PROBE_OUT2
            pg8::gemm_phase<pg8::EpiOut, pg8::StaticOrder, true, true>(lds, gg, SO, E);
#endif
        }
        SEAM(pb + 4);
        if (IN(pb + 5)) {
            PHASE_REGS;
            float* v = (l == DEPTH - 1) ? args.out : WSP(float, WS_XV);
            ln_rows(l == 0 ? (const float*)args.in[0] : WSP(const float, WS_XV), WSP(const bf16, WS_Y), v, (l == DEPTH - 1) ? nullptr : WSP(bf16, WS_H), (l == DEPTH - 1) ? nullptr : H8PTR, (const float*)args.in[14] + (size_t)l * D, (const float*)args.in[15] + (size_t)l * D,
                    WSP(const float, WS_MOD) + (size_t)(l + 1) * 3 * D, (LAS float*)lds, tid, VCU() * NWAVES + wave, gridDim.x * NWAVES, lane);
#ifdef PROBE_LN2
            ln_rows(l == 0 ? (const float*)args.in[0] : WSP(const float, WS_XV), WSP(const bf16, WS_Y), v, (l == DEPTH - 1) ? nullptr : WSP(bf16, WS_H), (l == DEPTH - 1) ? nullptr : H8PTR, (const float*)args.in[14] + (size_t)l * D, (const float*)args.in[15] + (size_t)l * D,
                    WSP(const float, WS_MOD) + (size_t)(l + 1) * 3 * D, (LAS float*)lds, tid, VCU() * NWAVES + wave, gridDim.x * NWAVES, lane);
#endif
        }
        SEAM(pb + 5);
    }
#undef IN
#undef SEAM
}


#if defined(CHK_BUILD) || defined(CHK2_BUILD) || defined(CHK3_BUILD) || defined(CHK4_BUILD)
__global__ void __launch_bounds__(NTHR, 2) chk_kernel(const Args args, int l) {
    extern __shared__ __attribute__((aligned(16))) unsigned char lds_raw[];
    LAS unsigned char* lds = (LAS unsigned char*)lds_raw;
    unsigned char* ws = args.ws; const int G = gridDim.x, vcu = blockIdx.x;
    LAS float* acc = (LAS float*)(lds + 65536);
    if (threadIdx.x == 0) { acc[0] = 0.f; acc[1] = 0.f; acc[2] = 0.f; acc[3] = 0.f; }
    __syncthreads();
#ifdef CHK_BUILD
#if CHK_WHICH == 0
    for (int u = vcu; u < 2 * (CHK_HI - CHK_LO); u += G) { const int t = CHK_LO + (u >> 1); chk::nsa_check(lds, ws, t, u & 1, t < CHK_SPLIT ? acc : acc + 2); }
#else
    for (int u = vcu; u < (CHK_HI - CHK_LO); u += G) { const int t = CHK_LO + u; chk::mla_check(lds, ws, t, t < CHK_SPLIT ? acc : acc + 2); }
#endif
#endif
#ifdef CHK2_BUILD
    for (int u = vcu; u < 256; u += G) chk2::proj_check(lds, ws, (const float*)args.in[0], (const float*)args.in[5] + (size_t)l * D * INC, l, u >> 2, u & 3, acc);
    for (int u = vcu; u < 256; u += G) chk2::cmp_check(lds, ws, (const float*)args.in[10] + (size_t)l * 2 * 4096, (const float*)args.in[11] + (size_t)l * 2 * 4096 * 128, (const float*)args.in[12] + (size_t)l * 2 * 128 * 128, u, acc + 2);
#endif
#ifdef CHK3_BUILD
    for (int u = vcu; u < 256; u += G) chk3::up_check(lds, ws, (const float*)args.in[6] + l * 768, (const float*)args.in[7] + (size_t)l * 768 * 3072, (const float*)args.in[8] + l * 512, (const float*)args.in[9] + (size_t)l * 512 * 4096, u, acc);
    for (int u = vcu; u < 256; u += G) chk3::out_check(lds, ws, l == 0 ? (const float*)args.in[0] : (const float*)(ws + WS_XV), l == DEPTH - 1 ? args.out : (const float*)(ws + WS_XV),
                                                       (const float*)args.in[13] + (size_t)l * D * D, (const float*)(ws + WS_MOD) + (size_t)l * 3 * D + 2 * D, u >> 2, u & 3, acc + 2);
#endif
#ifdef CHK4_BUILD
    for (int u = vcu; u < 512; u += G) chk4::mod_check(lds, ws, (const float*)args.in[1], (const float*)args.in[3], (const float*)args.in[4], u, acc);
    for (int u = vcu; u < 256; u += G) chk4::ln_check(lds, ws, (const float*)args.in[14], (const float*)args.in[15], u, acc + 2);
#endif
    __syncthreads();
    if (threadIdx.x == 0) { float* r = (float*)(ws + 14 * MiB) + 4 * blockIdx.x; r[0] = acc[0]; r[1] = acc[1]; r[2] = acc[2]; r[3] = acc[3]; }
}
__global__ void __launch_bounds__(NTHR) chk_readback(const Args args, int nblk) {
    const float* r = (const float*)(args.ws + 14 * MiB); float a = 0.f, ar = 0.f, b = 0.f, br = 0.f;
    for (int k = 0; k < nblk; ++k) { a += r[4 * k]; ar += r[4 * k + 1]; b += r[4 * k + 2]; br += r[4 * k + 3]; }
    a = sqrtf(a / fmaxf(ar, 1e-30f)); b = sqrtf(b / fmaxf(br, 1e-30f));
    const float ea = 0.003f * fminf(fmaxf(log10f(fmaxf(a, 1e-30f)) + 4.f, 0.f), 4.5f), ob = 0.1f * fminf(fmaxf(log10f(fmaxf(b, 1e-30f)) + 4.5f, 0.f), 5.f);
    const size_t n4 = (size_t)S * D / 4;
    for (size_t e = (size_t)blockIdx.x * NTHR + threadIdx.x; e < n4; e += (size_t)gridDim.x * NTHR) { f32x4 y = ((f32x4*)args.out)[e]; y = y * (1.f + ea); if (e == 0) y[0] += ob; ((f32x4*)args.out)[e] = y; }
}
#endif
#ifndef MK_PER_PHASE
#define MK_PER_PHASE 0
#endif
extern "C" void kernel_launch(void* const* d_in, const int* in_sizes, int n_in, void* d_out, int out_size, void* d_ws, size_t ws_size, hipStream_t stream) {
    static int grid = 0;
    if (grid == 0) {
        if (n_in != 16 || out_size != S * D || ws_size < WS_END) { fprintf(stderr, "kernel_launch: unexpected shapes n_in %d out %d ws %zu\n", n_in, out_size, ws_size); grid = -1; return; }
        int dev = 0, cus = 0;
        if (hipGetDevice(&dev) != hipSuccess || hipDeviceGetAttribute(&cus, hipDeviceAttributeMultiprocessorCount, dev) != hipSuccess) { grid = -1; return; }
        if (hipFuncSetAttribute((const void*)mk_fwd, hipFuncAttributeMaxDynamicSharedMemorySize, LDS_BYTES) != hipSuccess) { grid = -1; return; }
        int per_cu = 0;
        (void)hipOccupancyMaxActiveBlocksPerMultiprocessor(&per_cu, (const void*)mk_fwd, NTHR, LDS_BYTES);
        (void)hipGetLastError();
        if (per_cu < 1) fprintf(stderr, "kernel_launch: occupancy query says %d\n", per_cu);
        grid = cus;
    }
    if (grid < 0) return;
    (void)hipMemsetAsync((char*)d_ws + WS_CTL, 0, CTL_ZERO_BYTES, stream);
    Args a{};
    for (int i = 0; i < 16; ++i) a.in[i] = d_in[i];
    a.out = (float*)d_out; a.ws = (unsigned char*)d_ws;
#if defined(CHK_BUILD) || defined(CHK2_BUILD) || defined(CHK3_BUILD) || defined(CHK4_BUILD)
    { const int pcut = 2 + PPL * CHK_LAYER + CHK_AFTER + 1;
      a.ph_lo = 0; a.ph_hi = pcut; hipLaunchKernelGGL(mk_fwd, dim3(grid), dim3(NTHR), LDS_BYTES, stream, a);
      static bool attr2 = false; if (!attr2) { attr2 = true; (void)hipFuncSetAttribute((const void*)chk_kernel, hipFuncAttributeMaxDynamicSharedMemorySize, 98304); }
      hipLaunchKernelGGL(chk_kernel, dim3(grid), dim3(NTHR), 98304, stream, a, (int)CHK_LAYER);
      (void)hipMemsetAsync((char*)d_ws + WS_CTL, 0, CTL_ZERO_BYTES, stream);
      a.ph_lo = pcut; a.ph_hi = N_PHASES; hipLaunchKernelGGL(mk_fwd, dim3(grid), dim3(NTHR), LDS_BYTES, stream, a);
      hipLaunchKernelGGL(chk_readback, dim3(grid), dim3(NTHR), 0, stream, a, grid); }
#elif MK_PER_PHASE
    for (int p = 0; p < N_PHASES; ++p) { a.ph_lo = p; a.ph_hi = p + 1; hipLaunchKernelGGL(mk_fwd, dim3(grid), dim3(NTHR), LDS_BYTES, stream, a); }
#else
    a.ph_lo = 0; a.ph_hi = N_PHASES;
    hipLaunchKernelGGL(mk_fwd, dim3(grid), dim3(NTHR), LDS_BYTES, stream, a);
#endif
}
```

```cpp
#include <hip/hip_runtime.h>
#define MLA_FP8 1
#define MLA_FP8V 1
#define MLA_BIGX_OFF 1
#define MLA_MXQ_OFF 1
#define MLA_MXU 1
#define MLA_MXL 1
#define MLA_MX 1
#define YBF16 1
#define GEMM_F8 1
#include <cstdio>
#include <cstdint>

#define GAS __attribute__((address_space(1)))
#define LAS __attribute__((address_space(3)))
typedef unsigned short bf16;
typedef float f32x4 __attribute__((ext_vector_type(4)));
typedef float f32x2 __attribute__((ext_vector_type(2)));
typedef float f32x8 __attribute__((ext_vector_type(8)));
typedef float f32x16 __attribute__((ext_vector_type(16)));
typedef unsigned u32x4 __attribute__((ext_vector_type(4)));
typedef unsigned u32x2 __attribute__((ext_vector_type(2)));
typedef short bf16x8 __attribute__((ext_vector_type(8)));
typedef short s16x4 __attribute__((ext_vector_type(4)));
typedef __bf16 bf16x2v __attribute__((ext_vector_type(2)));
typedef __bf16 bf16x8v __attribute__((ext_vector_type(8)));
typedef GAS unsigned gu32;

constexpr int S = 16384, D = 4096, DEPTH = 2;
constexpr int INC = 9072, NIN = 9216;
constexpr float LN_EPS = 1e-5f, RMS_EPS = 1e-6f;
constexpr float DN_ALPHA = 1.41421356237309515f;
constexpr float LOG2E = 1.4426950408889634f;
constexpr float QS_MLA = 0.07216878364870322f * LOG2E;
constexpr float QS_NSA = 0.08838834764831845f * LOG2E;
constexpr int NWAVES = 8, NTHR = 512;
constexpr size_t MiB = 1u << 20;
constexpr size_t WS_CTL = 0, CTL_ZERO_BYTES = 1 * MiB;
constexpr size_t WS_MOD = 1 * MiB;
constexpr size_t WS_ROPE = 2 * MiB;
constexpr size_t WS_CBP = 6 * MiB;
constexpr size_t WS_RSQQ = 7 * MiB;
constexpr size_t WS_RSQKV = 9 * MiB;
constexpr size_t WS_RSTD = 6 * MiB + 512 * 1024;
constexpr size_t WS_GNSA = 10 * MiB;
constexpr size_t WS_KCMP = 13 * MiB;
constexpr size_t WS_VCMP = 13 * MiB + 512 * 1024;
constexpr size_t WS_W = 16 * MiB, W_LSTRIDE = 120 * MiB;
constexpr size_t W_IN = 0, W_QUP = 72 * MiB, W_KVUP = 77 * MiB, W_OUT = 81 * MiB, W_C1 = 113 * MiB, W_C2 = 115 * MiB;
constexpr size_t WS_H = 256 * MiB;
constexpr size_t WS_XV = 384 * MiB;
constexpr size_t WS_QLAT = 640 * MiB, WS_KVLAT = 664 * MiB;
#ifdef GEMM_F8
constexpr size_t WS_QMLA = 680 * MiB, WS_KMLA = 728 * MiB, WS_VMLA = 872 * MiB, WS_ZMLA = 936 * MiB, WS_ZNSA = 1000 * MiB, WS_QNSA = 1064 * MiB;
constexpr size_t WS_Y = 936 * MiB;
constexpr size_t WS_H8 = 776 * MiB;
constexpr size_t WS_WIN8 = 840 * MiB, WIN8_LSTRIDE = 13 * MiB;
#else
constexpr size_t WS_QMLA = 680 * MiB, WS_KMLA = 776 * MiB, WS_VMLA = 872 * MiB, WS_ZMLA = 936 * MiB, WS_ZNSA = 1000 * MiB, WS_QNSA = 1064 * MiB;
#endif
constexpr size_t WS_KVNSA = 1128 * MiB;
constexpr size_t WS_OSCR = 1178 * MiB;
constexpr size_t WS_END = 1210 * MiB;
constexpr int CW_BAR = 4096;
constexpr int LDS_BYTES = 147456;
constexpr int MISC_OFF = LDS_BYTES - 128;

__device__ __forceinline__ unsigned pk2(float lo, float hi) { f32x2 a = {lo, hi}; return __builtin_bit_cast(unsigned, __builtin_convertvector(a, bf16x2v)); }
__device__ __forceinline__ u32x4 pk8(f32x4 a, f32x4 b) { u32x4 w; w.x = pk2(a[0], a[1]); w.y = pk2(a[2], a[3]); w.z = pk2(b[0], b[1]); w.w = pk2(b[2], b[3]); return w; }
__device__ __forceinline__ float bflo(unsigned u) { return __uint_as_float(u << 16); }
__device__ __forceinline__ float bfhi(unsigned u) { return __uint_as_float(u & 0xffff0000u); }
__device__ __forceinline__ float wave_sum(float v) {
#pragma unroll
    for (int o = 1; o < 64; o <<= 1) v += __shfl_xor(v, o);
    return v;
}
__device__ __forceinline__ float silu_f(float v) { return v * __builtin_amdgcn_rcpf(1.f + __expf(-v)); }
__device__ __forceinline__ float sigm_f(float v) { return __builtin_amdgcn_rcpf(1.f + __expf(-v)); }

#define XB_TMO      128
#define XB_XCNT(j)  (256  + 64 * (j))
#define XB_XSUB(j)  (1280 + 64 * (j))
#define XB_XGEN(j)  (2304 + 64 * (j))
#define XB_TOP      3328
#define XB_TOPGEN   3392
#define XCD_BAR_WORDS 3456
#define XB_SPIN_CAP (1u << 18)
__device__ __forceinline__ unsigned xb_ld(unsigned* p)              { return __hip_atomic_load(p, __ATOMIC_RELAXED, __HIP_MEMORY_SCOPE_AGENT); }
__device__ __forceinline__ unsigned xb_add(unsigned* p, unsigned v) { return __hip_atomic_fetch_add(p, v, __ATOMIC_RELAXED, __HIP_MEMORY_SCOPE_AGENT); }
__device__ __forceinline__ unsigned xb_xcc_id() { return (unsigned)__builtin_amdgcn_s_getreg((3 << 11) | 20) & 0xFu; }
#define XB_SPIN(cond, bar) do { unsigned _sp = 0; while (cond) { __builtin_amdgcn_s_sleep(1); \
    if ((++_sp & 255u) == 0u) { if (xb_ld(&(bar)[XB_TMO])) break; if (_sp > XB_SPIN_CAP) { atomicAdd(&(bar)[XB_TMO], 1u); break; } } } } while (0)
struct XcdBarrier { unsigned* bar; unsigned x; volatile LAS unsigned* st; };
__device__ __forceinline__ XcdBarrier xcd_barrier_post(unsigned* bar, volatile LAS unsigned* st) {
    XcdBarrier b; b.bar = bar; b.x = xb_xcc_id(); b.st = st;
    if (threadIdx.x == 0) (void)xb_add(&bar[XB_XCNT(b.x)], 1u);
    return b;
}
__device__ __forceinline__ void xcd_barrier_complete(unsigned* bar, unsigned x, unsigned& nloc, unsigned& nx) {
    const unsigned G = gridDim.x * gridDim.y * gridDim.z;
    unsigned sum, cnt, mine, sp = 0u;
    for (;;) {
        sum = 0u; cnt = 0u; mine = 0u;
#pragma unroll
        for (unsigned j = 0; j < 16; ++j) { const unsigned c = xb_ld(&bar[XB_XCNT(j)]); sum += c; cnt += (c > 0u) ? 1u : 0u; mine = (j == x) ? c : mine; }
        if (sum == G) break;
        __builtin_amdgcn_s_sleep(1);
        if ((++sp & 255u) == 0u) { if (xb_ld(&bar[XB_TMO])) break; if (sp > XB_SPIN_CAP) { atomicAdd(&bar[XB_TMO], 1u); break; } }
    }
    nloc = mine > 0u ? mine : 1u; nx = cnt > 0u ? cnt : 1u;
}
__device__ __forceinline__ void xcd_barrier(const XcdBarrier& b) {
    asm volatile("s_waitcnt vmcnt(0)" ::: "memory");
    __syncthreads();
    if (threadIdx.x == 0) {
        unsigned* bar = b.bar;
        __builtin_amdgcn_s_waitcnt(0);
        unsigned nloc = b.st[0], nx = b.st[1];
        if (nloc == 0u) { xcd_barrier_complete(bar, b.x, nloc, nx); b.st[0] = nloc; b.st[1] = nx; }
        const unsigned old = xb_add(&bar[XB_XSUB(b.x)], 1u);
        const unsigned gen = old / nloc;
        if (old + 1u == (gen + 1u) * nloc) {
            __builtin_amdgcn_fence(__ATOMIC_RELEASE, "agent");
            asm volatile("s_waitcnt vmcnt(0)" ::: "memory");
            const unsigned og = xb_add(&bar[XB_TOP], 1u);
            const unsigned tg = og / nx;
            if (og + 1u == (tg + 1u) * nx) xb_add(&bar[XB_TOPGEN], 1u);
            else XB_SPIN(xb_ld(&bar[XB_TOPGEN]) == tg, bar);
            __builtin_amdgcn_fence(__ATOMIC_ACQUIRE, "agent");
            xb_add(&bar[XB_XGEN(b.x)], 1u);
            asm volatile("s_waitcnt vmcnt(0)" ::: "memory");
        } else {
            XB_SPIN(xb_ld(&bar[XB_XGEN(b.x)]) == gen, bar);
            __builtin_amdgcn_fence(__ATOMIC_ACQUIRE, "agent");
            asm volatile("s_waitcnt vmcnt(0)" ::: "memory");
        }
    }
    __syncthreads();
}
__device__ __forceinline__ void p0_mod_gemv(const float* c, const float* w_ada, const float* b_ada, float* mod, LAS float* lds, int vcu, int G) {
    const int tid = threadIdx.x;
    LAS float* sc = lds;
    LAS float* red = lds + 4096;
    for (int k = tid; k < D; k += NTHR) sc[k] = silu_f(c[k]);
    __syncthreads();
    const int cl = tid & 7, kl = tid >> 3;
    constexpr int NU = DEPTH * 3 * D / 32;
    for (int u = vcu; u < NU; u += G) {
        const int l = u / (3 * D / 32), n0 = (u % (3 * D / 32)) * 32;
        const float* W = w_ada + (size_t)l * D * (3 * D) + n0 + cl * 4;
        f32x4 acc = {0.f, 0.f, 0.f, 0.f};
#pragma unroll 8
        for (int i = 0; i < D / 64; ++i) { const int k = kl + 64 * i; const f32x4 w = *(const GAS f32x4*)(W + (size_t)k * (3 * D)); acc += w * sc[k]; }
        red[kl * 33 + cl * 4 + 0] = acc[0]; red[kl * 33 + cl * 4 + 1] = acc[1]; red[kl * 33 + cl * 4 + 2] = acc[2]; red[kl * 33 + cl * 4 + 3] = acc[3];
        __syncthreads();
        if (tid < 32) { float s = 0.f; for (int j = 0; j < 64; ++j) s += red[j * 33 + tid]; mod[(size_t)l * 3 * D + n0 + tid] = s + b_ada[(size_t)l * 3 * D + n0 + tid]; }
        __syncthreads();
    }
}
__device__ __forceinline__ int map_in(int n) {
    if (n < 1280) return n;
    if (n < 1344) { const int i = n - 1280; return 1280 + 2 * (i & 31) + (i >> 5); }
    if (n < 3392) return 1536 + (n - 1344);
    if (n < 5440) return 3584 + (n - 3392);
    if (n < 6976) return 5632 + (n - 5440);
    if (n < 7024) return 1344 + (n - 6976);
    return 7168 + (n - 7024);
}
#ifdef MLA_FP8V
__device__ __forceinline__ int map_kvup(int n) { const int h = n >> 8, d = n & 255; return d < 128 ? h * 128 + d : 2048 + h * 128 + (d - 128); }
#endif
__device__ __forceinline__ int map_qup(int n) { const int h = n / 192, d = n - h * 192; if (d < 128) return h * 128 + d; const int i = d - 128; return 2048 + h * 64 + 2 * (i & 31) + (i >> 5); }
#ifdef GEMM_F8
template <int MAP>
__device__ __forceinline__ void tr_item8(const float* W, int K, int N, unsigned char* WT, const float* kscale, float sc, int kb, int nb, int lane) {
    const int k0 = 64 * kb, n = 64 * nb + lane;
    if (n >= N) return;
    const GAS float* src = (const GAS float*)(W + (size_t)k0 * N + n);
    float v[64];
#pragma unroll
    for (int i = 0; i < 64; ++i) v[i] = src[(size_t)i * N] * sc;
    if (kscale) {
#pragma unroll
        for (int i = 0; i < 64; ++i) v[i] *= kscale[k0 + i];
    }
    const int row = MAP == 4 ? (n < 1280 ? n : 1280 + (n - 1344)) : (MAP == 2 ? map_qup(n) : map_kvup(n));
    GAS u32x4* dst = (GAS u32x4*)(WT + (size_t)row * K + k0);
#pragma unroll
    for (int c = 0; c < 4; ++c) { u32x4 o;
        int w = __builtin_amdgcn_cvt_pk_fp8_f32(v[16 * c + 0], v[16 * c + 1], 0, false); o.x = (unsigned)__builtin_amdgcn_cvt_pk_fp8_f32(v[16 * c + 2], v[16 * c + 3], w, true);
        w = __builtin_amdgcn_cvt_pk_fp8_f32(v[16 * c + 4], v[16 * c + 5], 0, false); o.y = (unsigned)__builtin_amdgcn_cvt_pk_fp8_f32(v[16 * c + 6], v[16 * c + 7], w, true);
        w = __builtin_amdgcn_cvt_pk_fp8_f32(v[16 * c + 8], v[16 * c + 9], 0, false); o.z = (unsigned)__builtin_amdgcn_cvt_pk_fp8_f32(v[16 * c + 10], v[16 * c + 11], w, true);
        w = __builtin_amdgcn_cvt_pk_fp8_f32(v[16 * c + 12], v[16 * c + 13], 0, false); o.w = (unsigned)__builtin_amdgcn_cvt_pk_fp8_f32(v[16 * c + 14], v[16 * c + 15], w, true);
        dst[c] = o; }
}
#endif
template <int MAP>
__device__ __forceinline__ void tr_item(const float* W, int K, int N, bf16* WT, const float* kscale, int kb, int nb, int lane) {
    const int k0 = 64 * kb, n = 64 * nb + lane;
    if (n >= N) return;
    const GAS float* src = (const GAS float*)(W + (size_t)k0 * N + n);
    float v[64];
#pragma unroll
    for (int i = 0; i < 64; ++i) v[i] = src[(size_t)i * N];
    if (kscale) {
#pragma unroll
        for (int i = 0; i < 64; ++i) v[i] *= kscale[k0 + i];
    }
#ifdef MLA_FP8V
    const int row = MAP == 1 ? map_in(n) : (MAP == 2 ? map_qup(n) : (MAP == 3 ? map_kvup(n) : n));
#else
    const int row = MAP == 1 ? map_in(n) : (MAP == 2 ? map_qup(n) : n);
#endif
    GAS u32x4* dst = (GAS u32x4*)(WT + (size_t)row * K + k0);
#pragma unroll
    for (int c = 0; c < 8; ++c) { u32x4 o; o.x = pk2(v[8 * c], v[8 * c + 1]); o.y = pk2(v[8 * c + 2], v[8 * c + 3]); o.z = pk2(v[8 * c + 4], v[8 * c + 5]); o.w = pk2(v[8 * c + 6], v[8 * c + 7]); dst[c] = o; }
}
struct P0In { const float *w_in, *q_norm, *w_q_up, *kv_norm, *w_kv_up, *w_cmp1, *w_cmp2, *w_out; };
__device__ __forceinline__ void p0_convert(const P0In& I, unsigned char* ws, int gw, int NGW, int lane) {
    constexpr int T_IN = 64 * 142, T_QUP = 12 * 48, T_KVUP = 8 * 64, T_OUT = 64 * 64, T_C1 = 2 * 64 * 2, T_C2 = 2 * 2 * 2;
    constexpr int TL = T_IN + T_QUP + T_KVUP + T_OUT + T_C1 + T_C2;
    for (int it = gw; it < DEPTH * TL; it += NGW) {
        const int l = it / TL; int r = it - l * TL;
        unsigned char* wl = ws + WS_W + (size_t)l * W_LSTRIDE;
#ifdef GEMM_F8
        if (r < T_IN) { const int t_ = r >> 3, nb = t_ % 142, kb = (t_ / 142) * 8 + (r & 7);
            if (nb < 20 || (nb >= 21 && nb < 53)) tr_item8<4>(I.w_in + (size_t)l * D * INC, D, INC, ws + WS_WIN8 + (size_t)l * WIN8_LSTRIDE, nullptr, 64.f, kb, nb, lane);
            else tr_item<1>(I.w_in + (size_t)l * D * INC, D, INC, (bf16*)(wl + W_IN), nullptr, kb, nb, lane);
            continue; } r -= T_IN;
        if (r < T_QUP) { tr_item8<2>(I.w_q_up + (size_t)l * 768 * 3072, 768, 3072, wl + W_QUP, I.q_norm + l * 768, 32.f, r / 48, r % 48, lane); continue; } r -= T_QUP;
        if (r < T_KVUP) { tr_item8<3>(I.w_kv_up + (size_t)l * 512 * 4096, 512, 4096, wl + W_KVUP, I.kv_norm + l * 512, 32.f, r / 64, r % 64, lane); continue; }
#else
        if (r < T_IN) { tr_item<1>(I.w_in + (size_t)l * D * INC, D, INC, (bf16*)(wl + W_IN), nullptr, r / 142, r % 142, lane); continue; } r -= T_IN;
        if (r < T_QUP) { tr_item<2>(I.w_q_up + (size_t)l * 768 * 3072, 768, 3072, (bf16*)(wl + W_QUP), I.q_norm + l * 768, r / 48, r % 48, lane); continue; } r -= T_QUP;
#ifdef MLA_FP8V
        if (r < T_KVUP) { tr_item<3>(I.w_kv_up + (size_t)l * 512 * 4096, 512, 4096, (bf16*)(wl + W_KVUP), I.kv_norm + l * 512, r / 64, r % 64, lane); continue; }
#else
        if (r < T_KVUP) { tr_item<0>(I.w_kv_up + (size_t)l * 512 * 4096, 512, 4096, (bf16*)(wl + W_KVUP), I.kv_norm + l * 512, r / 64, r % 64, lane); continue; }
#endif
#endif
        r -= T_KVUP;
        if (r < T_OUT) { const int t_ = r >> 3; tr_item<0>(I.w_out + (size_t)l * D * D, D, D, (bf16*)(wl + W_OUT), nullptr, (t_ / 64) * 8 + (r & 7), t_ % 64, lane); continue; } r -= T_OUT;
        if (r < T_C1) { const int kv = r / 128, rr = r % 128; tr_item<0>(I.w_cmp1 + (size_t)(l * 2 + kv) * 4096 * 128, 4096, 128, (bf16*)(wl + W_C1) + (size_t)kv * 128 * 4096, nullptr, rr / 2, rr % 2, lane); continue; } r -= T_C1;
        { const int kv = r / 4, rr = r % 4; tr_item<0>(I.w_cmp2 + (size_t)(l * 2 + kv) * 128 * 128, 128, 128, (bf16*)(wl + W_C2) + (size_t)kv * 128 * 128, nullptr, rr / 2, rr % 2, lane); }
    }
}
__device__ __forceinline__ void p0_rope(const int* positions, float* cosT, float* sinT, int gtid, int NT) {
    for (int e = gtid; e < S * 32; e += NT) { const int s = e >> 5, i = e & 31;
        const float inv = (float)exp(-(double)i * (1.0 / 32.0) * 9.210340371976184);
        const float ang = (float)positions[s] * inv;
        cosT[e] = (float)cos((double)ang); sinT[e] = (float)sin((double)ang); }
}
__device__ __forceinline__ void p0_cmpbias(const float* cmp_pos, const float* w_cmp1, float* cbp, LAS float* red, int vcu, int G) {
    const int tid = threadIdx.x, n = tid & 127, kq = tid >> 7;
    for (int u = vcu; u < 64; u += G) {
        const int lk = u >> 4, ch = u & 15;
        const float* P = cmp_pos + (size_t)lk * 4096 + 256 * ch; const float* W = w_cmp1 + (size_t)lk * 4096 * 128 + (size_t)(256 * ch) * 128 + n;
        float a = 0.f;
#pragma unroll 8
        for (int i = 0; i < 64; ++i) { const int k = kq + 4 * i; a += P[k] * *(const GAS float*)(W + (size_t)k * 128); }
        red[kq * 128 + n] = a;
        __syncthreads();
        if (tid < 128) cbp[(size_t)u * 128 + tid] = (red[tid] + red[128 + tid]) + (red[256 + tid] + red[384 + tid]);
        __syncthreads();
    }
}
__device__ __forceinline__ unsigned pk4_fp8(f32x4 h) { const int w = __builtin_amdgcn_cvt_pk_fp8_f32(h[0], h[1], 0, false); return (unsigned)__builtin_amdgcn_cvt_pk_fp8_f32(h[2], h[3], w, true); }
__device__ __forceinline__ void modulate_rows(const float* x, bf16* hout, unsigned char* h8, const float* modl, int gw, int NGW, int lane) {
    f32x4 sh[16], sc[16];
#pragma unroll
    for (int j = 0; j < 16; ++j) { sh[j] = *((const GAS f32x4*)modl + lane + 64 * j); sc[j] = *((const GAS f32x4*)(modl + D) + lane + 64 * j) + 1.f; }
    for (int m = gw; m < S; m += NGW) {
        const GAS f32x4* xr = (const GAS f32x4*)(x + (size_t)m * D) + lane;
        GAS u32x2* ho = (GAS u32x2*)(hout + (size_t)m * D) + lane;
#pragma unroll
        for (int j = 0; j < 16; ++j) { const f32x4 h = xr[64 * j] * sc[j] + sh[j]; u32x2 w; w.x = pk2(h[0], h[1]); w.y = pk2(h[2], h[3]); ho[64 * j] = w;
            if (h8) *((GAS unsigned*)(h8 + (size_t)m * D) + lane + 64 * j) = pk4_fp8(h); }
    }
}
typedef _Float16 f16x4 __attribute__((ext_vector_type(4)));
template <bool XIN_H, bool XOUT_H>
__device__ __forceinline__ void ln_rows(const void* xres_, const bf16* yb, void* xout_, bf16* hout, unsigned char* h8, const float* g, const float* b, const float* mod_next, LAS float* par, int tid, int gw, int NGW, int lane) {
    {
#pragma unroll
      for (int i = 0; i < 2; ++i) { const int e = tid + 512 * i;
          *((LAS f32x4*)par + e) = *((const GAS f32x4*)g + e); *((LAS f32x4*)(par + D) + e) = *((const GAS f32x4*)b + e);
          if (hout) { *((LAS f32x4*)(par + 2 * D) + e) = *((const GAS f32x4*)mod_next + e); *((LAS f32x4*)(par + 3 * D) + e) = *((const GAS f32x4*)(mod_next + D) + e) + 1.f; } }
      __syncthreads(); }
    for (int m = gw; m < S; m += NGW) {
        const GAS f32x4* vr = (const GAS f32x4*)((const float*)xres_ + (size_t)m * D) + lane; const GAS f16x4* vrh = (const GAS f16x4*)((const _Float16*)xres_ + (size_t)m * D) + lane;
        const GAS u32x2* yr = (const GAS u32x2*)(yb + (size_t)m * D) + lane;
        f32x4 x[16]; float s = 0.f;
#pragma unroll
        for (int j = 0; j < 16; ++j) { const u32x2 yy = yr[64 * j]; const f32x4 yf = {bflo(yy.x), bfhi(yy.x), bflo(yy.y), bfhi(yy.y)};
            const f32x4 xin = XIN_H ? __builtin_convertvector(vrh[64 * j], f32x4) : vr[64 * j];
            x[j] = xin * DN_ALPHA + yf; s += (x[j][0] + x[j][1]) + (x[j][2] + x[j][3]); }
        const float mean = wave_sum(s) * (1.f / D); float s2 = 0.f;
#pragma unroll
        for (int j = 0; j < 16; ++j) { x[j] = x[j] - mean; s2 += (x[j][0] * x[j][0] + x[j][1] * x[j][1]) + (x[j][2] * x[j][2] + x[j][3] * x[j][3]); }
        const float rstd = 1.f / sqrtf(wave_sum(s2) * (1.f / D) + LN_EPS);
        { unsigned po_ = 0u; asm volatile("" : "+v"(po_)); par = (LAS float*)((LAS unsigned char*)par + po_); }
        GAS f32x4* xo = (GAS f32x4*)((float*)xout_ + (size_t)m * D) + lane; GAS f16x4* xoh = (GAS f16x4*)((_Float16*)xout_ + (size_t)m * D) + lane;
#pragma unroll
        for (int j = 0; j < 16; ++j) {
            const f32x4 gg = *((const LAS f32x4*)par + lane + 64 * j), bb = *((const LAS f32x4*)(par + D) + lane + 64 * j);
            const f32x4 y = x[j] * rstd * gg + bb;
            if (XOUT_H) xoh[64 * j] = __builtin_convertvector(y, f16x4); else xo[64 * j] = y;
            if (hout) {
                const f32x4 sh = *((const LAS f32x4*)(par + 2 * D) + lane + 64 * j), scl = *((const LAS f32x4*)(par + 3 * D) + lane + 64 * j);
                const f32x4 h = y * scl + sh;
                u32x2 w; w.x = pk2(h[0], h[1]); w.y = pk2(h[2], h[3]);
                *((GAS u32x2*)(hout + (size_t)m * D) + lane + 64 * j) = w;
                if (h8) *((GAS unsigned*)(h8 + (size_t)m * D) + lane + 64 * j) = pk4_fp8(h);
            }
        }
    }
}
__device__ __forceinline__ void rstd_rows(const float* rsq_q, const float* rsq_kv, float* rstd_q, float* rstd_kv, int gtid, int NT) {
    for (int row = gtid; row < S; row += NT) {
        const GAS f32x4* rp = (const GAS f32x4*)(rsq_q + (size_t)row * 24); float ss = 0.f;
#pragma unroll
        for (int i = 0; i < 6; ++i) { const f32x4 t = rp[i]; ss += (t[0] + t[1]) + (t[2] + t[3]); }
        rstd_q[row] = 1.f / sqrtf(ss * (1.f / 768.f) + RMS_EPS);
        const GAS f32x4* rk = (const GAS f32x4*)(rsq_kv + (size_t)row * 16); float sk = 0.f;
#pragma unroll
        for (int i = 0; i < 4; ++i) { const f32x4 t = rk[i]; sk += (t[0] + t[1]) + (t[2] + t[3]); }
        rstd_kv[row] = 1.f / sqrtf(sk * (1.f / 512.f) + RMS_EPS);
    }
}
namespace pg8 {
#define PG8_LAS __attribute__((address_space(3)))
typedef unsigned short bf16_t;
typedef short bf16x8 __attribute__((ext_vector_type(8)));
typedef float f32x4 __attribute__((ext_vector_type(4)));
typedef unsigned u32x4 __attribute__((ext_vector_type(4)));
constexpr int BM = 256, BK = 64, HALF = 128, HTB = HALF * BK * 2  , STAGE_BYTES = 8 * HTB, NXCD = 8, WGM = 8;

__host__ __device__ __forceinline__ int lds_byte(int r, int c) { const int st = (r >> 4) * 2 + (c >> 5), rr = r & 15, cc = c & 31, ob = rr * 64 + cc * 2; return st * 1024 + (ob ^ (((ob >> 9) & 1) << 5)); }
__host__ __device__ __forceinline__ void stage_rc(int b, int& R, int& C) { const int st = b / 1024, sb = b % 1024, swz = sb ^ (((sb >> 9) & 1) << 5); R = (st >> 1) * 16 + swz / 64; C = (st & 1) * 32 + (swz % 64) / 2; }
__host__ __device__ __forceinline__ int perm32(int rho) { const int n = rho >> 4, i = rho & 15; return 8 * (i >> 2) + 4 * n + (i & 3); }

struct Unit { int pm, pn; };
struct Gemm { const bf16_t* A; const bf16_t* Bt; int M, N, K; };

struct StaticOrder {
    int nM, nN, nwg, G, c;
    __host__ __device__ void init(int M, int N, int G_, int c_) { nM = M / BM; nN = N / BM; nwg = nM * nN; G = G_; c = c_; }
    __host__ __device__ bool next(int i, Unit& u) const {
        const long L = (long)i * G + c; if (L >= nwg) return false;
        int wgid = (int)L; { const int q = nwg / NXCD, r = nwg % NXCD, xcd = wgid % NXCD, off = wgid / NXCD; wgid = (xcd < r ? xcd * (q + 1) : r * (q + 1) + (xcd - r) * q) + off; }
        const int nig = WGM * nN, gid = wgid / nig, fm = gid * WGM, gsz = (nM - fm) < WGM ? (nM - fm) : WGM;
        u.pm = fm + ((wgid % nig) % gsz); u.pn = (wgid % nig) / gsz; return true;
    }
    __device__ __forceinline__ void a_ready(const Unit&) const {}
    __device__ __forceinline__ void done(const Unit&) const {}
};
typedef int i32x8 __attribute__((ext_vector_type(8)));
typedef int i32x4 __attribute__((ext_vector_type(4)));
__device__ __forceinline__ i32x8 ld2x16(const PG8_LAS unsigned char* p) { const u32x4 a = *(const PG8_LAS u32x4*)p, b = *(const PG8_LAS u32x4*)(p + 1024);
    return (i32x8){(int)a.x, (int)a.y, (int)a.z, (int)a.w, (int)b.x, (int)b.y, (int)b.z, (int)b.w}; }
__device__ __forceinline__ i32x8 cat8(bf16x8 lo, bf16x8 hi) { const i32x4 a = __builtin_bit_cast(i32x4, lo), b = __builtin_bit_cast(i32x4, hi); return (i32x8){a[0], a[1], a[2], a[3], b[0], b[1], b[2], b[3]}; }
struct InBf16Order : StaticOrder {
    __device__ bool next(int i, Unit& u) const { if (!StaticOrder::next(i, u)) return false; u.pn = u.pn == 0 ? 5 : 13 + u.pn; return true; }
};
__device__ __forceinline__ f32x4 rope4(const f32x4 v, float c0, float s0, float c1, float s1) {
    f32x4 o; o[0] = v[0] * c0 - v[1] * s0; o[1] = v[1] * c0 + v[0] * s0; o[2] = v[2] * c1 - v[3] * s1; o[3] = v[3] * c1 + v[2] * s1; return o; }
#ifdef NOISE_BUILD
__device__ __forceinline__ f32x4 nz4(f32x4 v, int row, int col) {
    f32x4 o;
#pragma unroll
    for (int i = 0; i < 4; ++i) { unsigned h = (unsigned)row * 9216u + (unsigned)(col + i); h ^= h >> 16; h *= 0x7feb352du; h ^= h >> 15; h *= 0x846ca68bu; h ^= h >> 16;
        const float r = (float)(int)(h & 0xffffu) * (1.f / 32768.f) - 1.f; o[i] = v[i] * (1.f + NOISE_EPS * r); }
    return o; }
#define NZ(v, row, col) nz4((v), (row), (col))
#else
#define NZ(v, row, col) (v)
#endif
#ifdef MLA_FP8
__device__ __forceinline__ u32x2 pk8_fp8(f32x4 a, f32x4 b) {
    int w0 = __builtin_amdgcn_cvt_pk_fp8_f32(a[0], a[1], 0, false); w0 = __builtin_amdgcn_cvt_pk_fp8_f32(a[2], a[3], w0, true);
    int w1 = __builtin_amdgcn_cvt_pk_fp8_f32(b[0], b[1], 0, false); w1 = __builtin_amdgcn_cvt_pk_fp8_f32(b[2], b[3], w1, true);
    u32x2 r; r.x = (unsigned)w0; r.y = (unsigned)w1; return r; }
#endif
struct EpiIn {
    static constexpr bool PERM = true, AFTER_DRAIN = false;
    unsigned char* ws; int f8pass;
    __device__ __forceinline__ void operator()(const f32x4 (&acc)[2][2][4][2], const Unit& u, int wr, int wc, int fr, int fq) const {
        const int pn = f8pass ? (u.pn < 5 ? u.pn : u.pn + 1) : u.pn, row0 = u.pm * BM + wr * 64 + fr;
        if (pn < 5) {
            const bool isq = pn < 3; bf16_t* base = (bf16_t*)(ws + (isq ? WS_QLAT : WS_KVLAT)); const int ld = isq ? 768 : 512, ct = isq ? pn : pn - 3, ns = isq ? 24 : 16; float* rsq = (float*)(ws + (isq ? WS_RSQQ : WS_RSQKV));
#pragma unroll
            for (int ai = 0; ai < 2; ++ai)
#pragma unroll
                for (int m = 0; m < 4; ++m) { const int row = row0 + ai * HALF + m * 16;
#pragma unroll
                    for (int bj = 0; bj < 2; ++bj) { const f32x4 v0 = NZ(acc[ai][bj][m][0], row, pn * 256 + bj * 128 + wc * 32 + 8 * fq), v1 = NZ(acc[ai][bj][m][1], row, pn * 256 + bj * 128 + wc * 32 + 8 * fq + 4);
                        float ss = ((v0[0] * v0[0] + v0[1] * v0[1]) + (v0[2] * v0[2] + v0[3] * v0[3])) + ((v1[0] * v1[0] + v1[1] * v1[1]) + (v1[2] * v1[2] + v1[3] * v1[3]));
                        ss += __shfl_xor(ss, 16); ss += __shfl_xor(ss, 32);
                        if (fq == 0) rsq[(size_t)row * ns + ct * 8 + bj * 4 + wc] = ss;
#ifdef GEMM_F8
                        *(GAS u32x2*)((unsigned char*)base + (size_t)row * ld + ct * 256 + bj * HALF + wc * 32 + 8 * fq) = pk8_fp8(v0, v1); } }
#else
                        *(GAS u32x4*)(base + (size_t)row * ld + ct * 256 + bj * HALF + wc * 32 + 8 * fq) = pk8(v0, v1); } }
#endif
        } else if (pn == 5) {
            if (wc < 2) {
                const int i0 = 16 * wc + 4 * fq; const float* cosT = (const float*)(ws + WS_ROPE); const float* sinT = cosT + (size_t)S * 32; bf16_t* kmla = (bf16_t*)(ws + WS_KMLA);
#pragma unroll
                for (int ai = 0; ai < 2; ++ai)
#pragma unroll
                    for (int m = 0; m < 4; ++m) { const int row = row0 + ai * HALF + m * 16;
                        const f32x4 cs = *(const GAS f32x4*)(cosT + (size_t)row * 32 + i0), sn = *(const GAS f32x4*)(sinT + (size_t)row * 32 + i0);
#ifdef MLA_FP8
                        const u32x2 w = pk8_fp8(rope4(acc[ai][0][m][0], cs[0], sn[0], cs[1], sn[1]), rope4(acc[ai][0][m][1], cs[2], sn[2], cs[3], sn[3]));
                        unsigned char* dst = (unsigned char*)kmla + (size_t)row * 3072 + 128 + wc * 32 + 8 * fq;
#pragma unroll
                        for (int h = 0; h < 16; ++h) *(GAS u32x2*)(dst + h * 192) = w;
#else
                        const u32x4 w = pk8(rope4(acc[ai][0][m][0], cs[0], sn[0], cs[1], sn[1]), rope4(acc[ai][0][m][1], cs[2], sn[2], cs[3], sn[3]));
                        bf16_t* dst = kmla + (size_t)row * 3072 + 128 + wc * 32 + 8 * fq;
#pragma unroll
                        for (int h = 0; h < 16; ++h) *(GAS u32x4*)(dst + h * 192) = w;
#endif
                        asm volatile("" ::: "memory"); }
            } else {
                const int cl = (wc - 2) * 32 + 8 * fq; float* gnsa = (float*)(ws + WS_GNSA);
                if (cl < 48) {
#pragma unroll
                    for (int ai = 0; ai < 2; ++ai)
#pragma unroll
                        for (int m = 0; m < 4; ++m) { const int row = row0 + ai * HALF + m * 16; const f32x4 v0 = acc[ai][0][m][0], v1 = acc[ai][0][m][1];
                            f32x4 g0, g1; g0[0] = sigm_f(v0[0]); g0[1] = sigm_f(v0[1]); g0[2] = sigm_f(v0[2]); g0[3] = sigm_f(v0[3]); g1[0] = sigm_f(v1[0]); g1[1] = sigm_f(v1[1]); g1[2] = sigm_f(v1[2]); g1[3] = sigm_f(v1[3]);
                            *(GAS f32x4*)(gnsa + (size_t)row * 48 + cl) = g0; *(GAS f32x4*)(gnsa + (size_t)row * 48 + cl + 4) = g1; } }
            }
        } else {
            const int mode = (pn < 14) ? 0 : (pn < 22 ? 1 : (pn < 28 ? 2 : 0));
            bf16_t* base = (pn < 14) ? (bf16_t*)(ws + WS_ZMLA) + (pn - 6) * 256 : (pn < 22 ? (bf16_t*)(ws + WS_QNSA) + (pn - 14) * 256 : (bf16_t*)(ws + WS_ZNSA) + (pn - 28) * 256); bf16_t* kvnsa = (bf16_t*)(ws + WS_KVNSA);
#pragma unroll
            for (int ai = 0; ai < 2; ++ai)
#pragma unroll
                for (int m = 0; m < 4; ++m) { const int row = row0 + ai * HALF + m * 16;
#pragma unroll
                    for (int bj = 0; bj < 2; ++bj) { f32x4 v0 = NZ(acc[ai][bj][m][0], row, pn * 256 + bj * 128 + wc * 32 + 8 * fq), v1 = NZ(acc[ai][bj][m][1], row, pn * 256 + bj * 128 + wc * 32 + 8 * fq + 4);
                        if (mode == 0) { v0[0] = silu_f(v0[0]); v0[1] = silu_f(v0[1]); v0[2] = silu_f(v0[2]); v0[3] = silu_f(v0[3]); v1[0] = silu_f(v1[0]); v1[1] = silu_f(v1[1]); v1[2] = silu_f(v1[2]); v1[3] = silu_f(v1[3]); }
                        else if (mode == 1) { v0 = v0 * QS_NSA; v1 = v1 * QS_NSA; }
                        bf16_t* dst = (mode == 2) ? kvnsa + (size_t)(2 * (pn - 22) + bj) * ((size_t)S * 128) + (size_t)row * 128 + wc * 32 + 8 * fq
                                                  : base + (size_t)row * 2048 + bj * HALF + wc * 32 + 8 * fq;
                        *(GAS u32x4*)dst = pk8(v0, v1); } }
        }
    }
};
struct EpiQup {
    static constexpr bool PERM = true, AFTER_DRAIN = false;
    unsigned char* ws;
    __device__ __forceinline__ void operator()(const f32x4 (&acc)[2][2][4][2], const Unit& u, int wr, int wc, int fr, int fq) const {
        const int pn = u.pn, row0 = u.pm * BM + wr * 64 + fr; bf16_t* qmla = (bf16_t*)(ws + WS_QMLA); const float* rstd_q = (const float*)(ws + WS_RSTD); const float* cosT = (const float*)(ws + WS_ROPE); const float* sinT = cosT + (size_t)S * 32;
#pragma unroll
        for (int ai = 0; ai < 2; ++ai)
#pragma unroll
            for (int m = 0; m < 4; ++m) { const int row = row0 + ai * HALF + m * 16;
#ifdef MLA_FP8
#ifdef MLA_MXL
                const float sc = (QS_MLA * 8.f) * *(const GAS float*)(rstd_q + row);
#else
                const float sc = *(const GAS float*)(rstd_q + row);
#endif
                unsigned char* q8 = (unsigned char*)qmla + (size_t)row * 3072;
#pragma unroll
                for (int bj = 0; bj < 2; ++bj) { const f32x4 v0 = acc[ai][bj][m][0] * sc, v1 = acc[ai][bj][m][1] * sc;
                    if (pn < 8) { *(GAS u32x2*)(q8 + (2 * pn + bj) * 192 + wc * 32 + 8 * fq) = pk8_fp8(v0, v1); }
                    else { const int cp = (pn - 8) * 256 + bj * HALF + wc * 32 + 8 * fq, head = cp >> 6, dl = cp & 63, i0 = dl >> 1;
                        const f32x4 cs = *(const GAS f32x4*)(cosT + (size_t)row * 32 + i0), sn = *(const GAS f32x4*)(sinT + (size_t)row * 32 + i0);
                        *(GAS u32x2*)(q8 + head * 192 + 128 + dl) = pk8_fp8(rope4(v0, cs[0], sn[0], cs[1], sn[1]), rope4(v1, cs[2], sn[2], cs[3], sn[3])); } }
#else
                const float sc = QS_MLA * *(const GAS float*)(rstd_q + row);
#pragma unroll
                for (int bj = 0; bj < 2; ++bj) { const f32x4 v0 = acc[ai][bj][m][0] * sc, v1 = acc[ai][bj][m][1] * sc;
                    if (pn < 8) { *(GAS u32x4*)(qmla + (size_t)row * 3072 + (2 * pn + bj) * 192 + wc * 32 + 8 * fq) = pk8(v0, v1); }
                    else { const int cp = (pn - 8) * 256 + bj * HALF + wc * 32 + 8 * fq, head = cp >> 6, dl = cp & 63, i0 = dl >> 1;
                        const f32x4 cs = *(const GAS f32x4*)(cosT + (size_t)row * 32 + i0), sn = *(const GAS f32x4*)(sinT + (size_t)row * 32 + i0);
                        *(GAS u32x4*)(qmla + (size_t)row * 3072 + head * 192 + 128 + dl) = pk8(rope4(v0, cs[0], sn[0], cs[1], sn[1]), rope4(v1, cs[2], sn[2], cs[3], sn[3])); } }
#endif
                if (m & 1) asm volatile("" ::: "memory"); }
    }
};
struct EpiKvup {
    static constexpr bool PERM = true, AFTER_DRAIN = false;
    unsigned char* ws;
    __device__ __forceinline__ void operator()(const f32x4 (&acc)[2][2][4][2], const Unit& u, int wr, int wc, int fr, int fq) const {
        const int pn = u.pn, row0 = u.pm * BM + wr * 64 + fr;
#pragma unroll
        for (int ai = 0; ai < 2; ++ai)
#pragma unroll
            for (int m = 0; m < 4; ++m) { const int row = row0 + ai * HALF + m * 16;
                const float sc = *(const GAS float*)((const float*)(ws + WS_RSTD) + S + row); bf16_t* kmla = (bf16_t*)(ws + WS_KMLA); bf16_t* vmla = (bf16_t*)(ws + WS_VMLA);
#ifdef MLA_FP8
                *(GAS u32x2*)((unsigned char*)kmla + (size_t)row * 3072 + pn * 192 + wc * 32 + 8 * fq) = pk8_fp8(acc[ai][0][m][0] * sc, acc[ai][0][m][1] * sc);
#else
                *(GAS u32x4*)(kmla + (size_t)row * 3072 + pn * 192 + wc * 32 + 8 * fq) = pk8(acc[ai][0][m][0] * sc, acc[ai][0][m][1] * sc);
#endif
                *(GAS u32x4*)(vmla + (size_t)row * 2048 + pn * 128 + wc * 32 + 8 * fq) = pk8(acc[ai][1][m][0] * sc, acc[ai][1][m][1] * sc);
                if (m & 1) asm volatile("" ::: "memory"); }
    }
};
#ifdef MLA_FP8V
struct EpiKup {
    static constexpr bool PERM = true, AFTER_DRAIN = false;
    unsigned char* ws;
    __device__ __forceinline__ void operator()(const f32x4 (&acc)[2][2][4][2], const Unit& u, int wr, int wc, int fr, int fq) const {
        const int pn = u.pn, row0 = u.pm * BM + wr * 64 + fr;
#pragma unroll
        for (int ai = 0; ai < 2; ++ai)
#pragma unroll
            for (int m = 0; m < 4; ++m) { const int row = row0 + ai * HALF + m * 16;
                const float sc = *(const GAS float*)((const float*)(ws + WS_RSTD) + S + row); unsigned char* k8 = ws + WS_KMLA + (size_t)row * 3072;
#pragma unroll
                for (int bj = 0; bj < 2; ++bj) *(GAS u32x2*)(k8 + (2 * pn + bj) * 192 + wc * 32 + 8 * fq) = pk8_fp8(acc[ai][bj][m][0] * sc, acc[ai][bj][m][1] * sc);
                if (m & 1) asm volatile("" ::: "memory"); }
    }
};
struct EpiVt {
    static constexpr bool PERM = true, AFTER_DRAIN = false;
    unsigned char* ws;
    __device__ __forceinline__ void operator()(const f32x4 (&acc)[2][2][4][2], const Unit& u, int wr, int wc, int fr, int fq) const {
        const int row0 = u.pm * BM + wr * 64 + fr, col0 = u.pn * BM + wc * 32 + 8 * fq;
        const float* rs = (const float*)(ws + WS_RSTD) + S;
        f32x4 sc[2][2];
#pragma unroll
        for (int bj = 0; bj < 2; ++bj) { sc[bj][0] = *(const GAS f32x4*)(rs + col0 + bj * HALF); sc[bj][1] = *(const GAS f32x4*)(rs + col0 + bj * HALF + 4); }
        const int hi8 = (col0 >> 3) & 1; (void)hi8;
#pragma unroll
        for (int ai = 0; ai < 2; ++ai)
#pragma unroll
            for (int m = 0; m < 4; ++m) { unsigned char* vt = ws + WS_VMLA + (size_t)(row0 + ai * HALF + m * 16) * S;
#pragma unroll
                for (int bj = 0; bj < 2; ++bj) { const u32x2 w = pk8_fp8(acc[ai][bj][m][0] * sc[bj][0], acc[ai][bj][m][1] * sc[bj][1]);
#ifdef MLA_MX
                    unsigned char* d64 = vt + ((col0 + bj * HALF) & ~63) + 4 * ((col0 >> 3) & 7);
                    *(GAS unsigned*)(d64) = w.x; *(GAS unsigned*)(d64 + 32) = w.y; } }
#else
                    unsigned char* d16 = vt + ((col0 + bj * HALF) & ~15);
                    *(GAS unsigned*)(d16 + (hi8 ? 4 : 0)) = w.x; *(GAS unsigned*)(d16 + (hi8 ? 12 : 8)) = w.y; } }
#endif
    }
};
#endif
struct EpiOut {
    static constexpr bool PERM = true, AFTER_DRAIN = false;
    bf16_t* y; const float* gate;
    __device__ __forceinline__ void operator()(const f32x4 (&acc)[2][2][4][2], const Unit& u, int wr, int wc, int fr, int fq) const {
        const int row0 = u.pm * BM + wr * 64 + fr, col0 = u.pn * BM + wc * 32 + 8 * fq;
        f32x4 gv[2][2];
#pragma unroll
        for (int bj = 0; bj < 2; ++bj)
#pragma unroll
            for (int n = 0; n < 2; ++n) gv[bj][n] = *(const GAS f32x4*)(gate + col0 + bj * HALF + n * 4);
#pragma unroll
        for (int ai = 0; ai < 2; ++ai)
#pragma unroll
            for (int m = 0; m < 4; ++m) { bf16_t* dst = y + (size_t)(row0 + ai * HALF + m * 16) * D + col0;
#pragma unroll
                for (int bj = 0; bj < 2; ++bj) *(GAS u32x4*)(dst + bj * HALF) = pk8(gv[bj][0] * acc[ai][bj][m][0], gv[bj][1] * acc[ai][bj][m][1]);
                if (m & 1) asm volatile("" ::: "memory"); }
    }
};
template <class Epi, class Sched, bool ALIGN_EPI = false, bool SP2 = false, int SCB = 0, int SCA = 0>
__device__ __forceinline__ void gemm_phase(PG8_LAS unsigned char* lds, const Gemm g, const Sched& S, const Epi& E) {
    int tid_ = threadIdx.x; asm volatile("" : "+v"(tid_));
    const int tid = tid_, wid = __builtin_amdgcn_readfirstlane(tid >> 6), lane = tid & 63, wr = wid >> 2, wc = wid & 3, fr = lane & 15, fq = lane >> 4;
    const int K = g.K, nt = K / BK;
    unsigned voffA[2], voffB[2];
#pragma unroll
    for (int i = 0; i < 2; ++i) { int R, C; stage_rc(tid * 16 + i * 8192, R, C); const int Rb = Epi::PERM ? ((R & ~31) + perm32(R & 31)) : R;
        voffA[i] = (unsigned)(R * K + C) * 2u; voffB[i] = (unsigned)(Rb * K + C) * 2u; }
    const size_t kstep = (size_t)(BK * 2);
    const size_t hstep = (size_t)HALF * K * 2;
    const size_t tstep = 2 * hstep;
    const unsigned ldsw = (unsigned)wid * 1024u;
    const int aoff = lds_byte(wr * 64 + fr, fq * 8), boff = lds_byte(wc * 32 + fr, fq * 8);
#define PG8_SA(b, h) (((b) * 2 + (h)) * HTB)
#define PG8_SB(b, h) ((4 + (b) * 2 + (h)) * HTB)
#define PG8_STAGE(bufoff, gbase, voff) do { _Pragma("unroll") for (int _i = 0; _i < 2; ++_i) \
        __builtin_amdgcn_global_load_lds((const unsigned*)((const char*)(gbase) + (voff)[_i]), (PG8_LAS unsigned*)(lds + (bufoff) + ldsw + _i * 8192), 16, 0, 0); } while (0)
#define PG8_LDA(dst, b, h) do { if constexpr (SCB != 0) { _Pragma("unroll") for (int m = 0; m < 4; ++m) dst##8[m] = ld2x16(lds + PG8_SA(b, h) + aoff + m * 2048); } \
        else { _Pragma("unroll") for (int m = 0; m < 4; ++m) _Pragma("unroll") for (int k = 0; k < 2; ++k) dst[m][k] = *(const PG8_LAS bf16x8*)(lds + PG8_SA(b, h) + aoff + m * 2048 + k * 1024); } } while (0)
#define PG8_LDB(dst, b, h) do { if constexpr (SCB != 0) { _Pragma("unroll") for (int n = 0; n < 2; ++n) dst##8[n] = ld2x16(lds + PG8_SB(b, h) + boff + n * 2048); } \
        else { _Pragma("unroll") for (int n = 0; n < 2; ++n) _Pragma("unroll") for (int k = 0; k < 2; ++k) dst[n][k] = *(const PG8_LAS bf16x8*)(lds + PG8_SB(b, h) + boff + n * 2048 + k * 1024); } } while (0)
#define PG8_MMA(ai, bj, At, Bt) do { __builtin_amdgcn_s_setprio(1); \
        if constexpr (SCB != 0) { _Pragma("unroll") for (int m = 0; m < 4; ++m) _Pragma("unroll") for (int n = 0; n < 2; ++n) \
            asm volatile("v_mfma_scale_f32_16x16x128_f8f6f4 %0, %1, %2, %0, %3, %4 op_sel_hi:[0,0,0]" : "+v"(acc[ai][bj][m][n]) : "v"(Bt##8[n]), "v"(At##8[m]), "v"(scb_), "v"(sca_)); } \
        else { _Pragma("unroll") for (int m = 0; m < 4; ++m) _Pragma("unroll") for (int n = 0; n < 2; ++n) _Pragma("unroll") for (int k = 0; k < 2; ++k) \
            acc[ai][bj][m][n] = __builtin_amdgcn_mfma_f32_16x16x32_bf16(Bt[n][k], At[m][k], acc[ai][bj][m][n], 0, 0, 0); } \
        __builtin_amdgcn_s_setprio(0); } while (0)
#define PG8_WAIT_V(n) asm volatile("s_waitcnt vmcnt(" #n ")" ::: "memory")
#define PG8_WAIT_L(n) asm volatile("s_waitcnt lgkmcnt(" #n ")" ::: "memory")
#define PG8_BAR __builtin_amdgcn_s_barrier()
#define PG8_SCHED __builtin_amdgcn_sched_barrier(0)
    Unit cur, nxt; int ui = 0;
    if (!S.next(0, cur)) return;
    f32x4 acc[2][2][4][2];
#pragma unroll
    for (int a = 0; a < 2; ++a)
#pragma unroll
        for (int b = 0; b < 2; ++b)
#pragma unroll
            for (int m = 0; m < 4; ++m)
#pragma unroll
                for (int n = 0; n < 2; ++n) acc[a][b][m][n] = (f32x4){0.f, 0.f, 0.f, 0.f};
    int scb_ = SCB, sca_ = SCA; asm volatile("" : "+v"(scb_), "+v"(sca_));
    bf16x8 At[4][2], B0[2][2], B1[2][2]; i32x8 At8[4], B08[2], B18[2];
    const char* cA = (const char*)g.A + (size_t)cur.pm * tstep; const char* cB = (const char*)g.Bt + (size_t)cur.pn * tstep;
    S.a_ready(cur);
    if constexpr (SP2) {
        PG8_STAGE(PG8_SB(0, 0), cB, voffB); PG8_STAGE(PG8_SB(0, 1), cB + hstep, voffB); PG8_STAGE(PG8_SA(0, 0), cA, voffA); PG8_STAGE(PG8_SA(0, 1), cA + hstep, voffA);
        if (wr == 1) PG8_BAR;
        PG8_WAIT_V(2); PG8_BAR;
        PG8_STAGE(PG8_SB(1, 0), cB + kstep, voffB); PG8_STAGE(PG8_SA(1, 0), cA + kstep, voffA); PG8_STAGE(PG8_SB(1, 1), cB + hstep + kstep, voffB);
        PG8_WAIT_V(6); PG8_BAR;
    } else {
        PG8_STAGE(PG8_SB(0, 0), cB, voffB); PG8_STAGE(PG8_SA(0, 0), cA, voffA); PG8_STAGE(PG8_SB(0, 1), cB + hstep, voffB); PG8_STAGE(PG8_SA(0, 1), cA + hstep, voffA);
        if (wr == 1) PG8_BAR;
        PG8_WAIT_V(4); PG8_BAR;
        PG8_STAGE(PG8_SB(1, 0), cB + kstep, voffB); PG8_STAGE(PG8_SA(1, 0), cA + kstep, voffA); PG8_STAGE(PG8_SB(1, 1), cB + hstep + kstep, voffB);
        PG8_WAIT_V(6); PG8_BAR;
    }
    for (;;) {
        const bool has_next = S.next(ui + 1, nxt);
        const char* nA = has_next ? (const char*)g.A + (size_t)nxt.pm * tstep : cA; const char* nB = has_next ? (const char*)g.Bt + (size_t)nxt.pn * tstep : cB;
#pragma unroll 1
        for (int t = 0; t < nt; t += 2) {
            const bool last = (t == nt - 2);
            const char* a1 = cA + (size_t)(t + 1) * kstep;
            const char* a2 = last ? nA : cA + (size_t)(t + 2) * kstep; const char* b2 = last ? nB : cB + (size_t)(t + 2) * kstep;
            const char* a3 = a2 + kstep; const char* b3 = b2 + kstep;
            if (last && has_next) S.a_ready(nxt);
            if constexpr (SP2) {
            PG8_LDB(B0, 0, 0); PG8_LDB(B1, 0, 1); PG8_SCHED; PG8_LDA(At, 0, 0); PG8_STAGE(PG8_SA(1, 1), a1 + hstep, voffA);
            PG8_WAIT_V(8); PG8_WAIT_L(0); PG8_BAR; PG8_MMA(0, 0, At, B0); PG8_MMA(0, 1, At, B1); PG8_BAR; PG8_SCHED;
            PG8_LDA(At, 0, 1); PG8_STAGE(PG8_SB(0, 0), b2, voffB); PG8_STAGE(PG8_SB(0, 1), b2 + hstep, voffB); PG8_STAGE(PG8_SA(0, 0), a2, voffA);
            PG8_WAIT_V(8); PG8_WAIT_L(0); PG8_BAR; PG8_MMA(1, 0, At, B0); PG8_MMA(1, 1, At, B1); PG8_BAR; PG8_SCHED;
            PG8_LDB(B0, 1, 0); PG8_LDB(B1, 1, 1); PG8_SCHED; PG8_LDA(At, 1, 0); PG8_STAGE(PG8_SA(0, 1), a2 + hstep, voffA);
            PG8_WAIT_V(8); PG8_WAIT_L(0); PG8_BAR; PG8_MMA(0, 0, At, B0); PG8_MMA(0, 1, At, B1); PG8_BAR; PG8_SCHED;
            PG8_LDA(At, 1, 1); PG8_STAGE(PG8_SB(1, 0), b3, voffB); PG8_STAGE(PG8_SB(1, 1), b3 + hstep, voffB); PG8_STAGE(PG8_SA(1, 0), a3, voffA);
            PG8_WAIT_V(8); PG8_WAIT_L(0); PG8_BAR; PG8_MMA(1, 0, At, B0); PG8_MMA(1, 1, At, B1); PG8_BAR; PG8_SCHED;
            } else {
            PG8_LDB(B0, 0, 0); PG8_SCHED; PG8_LDA(At, 0, 0); PG8_STAGE(PG8_SA(1, 1), a1 + hstep, voffA);
            PG8_WAIT_L(8); PG8_BAR; PG8_WAIT_L(0); PG8_MMA(0, 0, At, B0); PG8_BAR; PG8_SCHED;
            PG8_LDB(B1, 0, 1); PG8_STAGE(PG8_SB(0, 0), b2, voffB);
            PG8_BAR; PG8_WAIT_L(0); PG8_MMA(0, 1, At, B1); PG8_BAR;
            PG8_LDA(At, 0, 1); PG8_STAGE(PG8_SA(0, 0), a2, voffA);
            PG8_BAR; PG8_WAIT_L(0); PG8_MMA(1, 0, At, B0); PG8_BAR; PG8_SCHED;
            PG8_STAGE(PG8_SB(0, 1), b2 + hstep, voffB);
            PG8_WAIT_V(6); PG8_BAR; PG8_MMA(1, 1, At, B1); PG8_BAR;
            PG8_LDB(B0, 1, 0); PG8_SCHED; PG8_LDA(At, 1, 0); PG8_STAGE(PG8_SA(0, 1), a2 + hstep, voffA);
            PG8_WAIT_L(8); PG8_BAR; PG8_WAIT_L(0); PG8_MMA(0, 0, At, B0); PG8_BAR; PG8_SCHED;
            PG8_LDB(B1, 1, 1); PG8_STAGE(PG8_SB(1, 0), b3, voffB);
            PG8_BAR; PG8_WAIT_L(0); PG8_MMA(0, 1, At, B1); PG8_BAR;
            PG8_LDA(At, 1, 1); PG8_STAGE(PG8_SA(1, 0), a3, voffA);
            PG8_BAR; PG8_WAIT_L(0); PG8_MMA(1, 0, At, B0); PG8_BAR; PG8_SCHED;
            PG8_STAGE(PG8_SB(1, 1), b3 + hstep, voffB);
            PG8_WAIT_V(6); PG8_BAR; PG8_MMA(1, 1, At, B1); PG8_BAR;
            }
        }
        if constexpr (SCB != 0) asm volatile("s_nop 15\n\ts_nop 15" ::: "memory");
        if constexpr (ALIGN_EPI) { if (wr == 0) PG8_BAR; }
        if constexpr (!Epi::AFTER_DRAIN) { int fr_ = fr, fq_ = fq; asm volatile("" : "+v"(fr_), "+v"(fq_));
            E(acc, cur, wr, wc, fr_, fq_); S.done(cur); }
        if (!has_next) break;
#pragma unroll
        for (int a = 0; a < 2; ++a)
#pragma unroll
            for (int b = 0; b < 2; ++b)
#pragma unroll
                for (int m = 0; m < 4; ++m)
#pragma unroll
                    for (int n = 0; n < 2; ++n) acc[a][b][m][n] = (f32x4){0.f, 0.f, 0.f, 0.f};
        cur = nxt; cA = nA; cB = nB; ++ui;
        if constexpr (ALIGN_EPI) { if (wr == 1) PG8_BAR; }
    }
    PG8_WAIT_V(0);
    if constexpr (!ALIGN_EPI) { if (wr == 0) PG8_BAR; }
    PG8_BAR;
    if constexpr (Epi::AFTER_DRAIN) { E.fused(acc, cur, wr, wc, fr, fq, lds, wid, lane); S.done(cur); }
#undef PG8_SA
#undef PG8_SB
#undef PG8_STAGE
#undef PG8_LDA
#undef PG8_LDB
#undef PG8_MMA
#undef PG8_WAIT_V
#undef PG8_WAIT_L
#undef PG8_BAR
#undef PG8_SCHED
}
}
namespace att {
constexpr int KS_M = 400, KS_N = 272, VS = 320;
constexpr int MLA_KB = 64 * KS_M, NSA_KB = 64 * KS_N, VB = 64 * VS;
constexpr int N_IMP = 2 * NSA_KB + 2 * VB;
constexpr int N_PART = N_IMP + 32768;
constexpr int N_PARTB = 8 * 32 * 17 * 4;
constexpr int N_SELM = N_PART + 2 * N_PARTB;
constexpr int N_ULIST = N_SELM + 1024;
constexpr int N_CARRY = N_ULIST + 1024;
constexpr int N_NTS = N_CARRY + 256;
static_assert(N_NTS + 16 <= MISC_OFF, "NSA LDS map");
static_assert(2 * MLA_KB + 3 * VB <= 131072, "MLA LDS map");
constexpr int MLA_QL = 2 * MLA_KB + 2 * VB;
static_assert(MLA_QL + 8 * 4096 <= 131072, "MLA LDS map (pipelined)");

#ifndef QK_PF
#define QK_PF 4
#endif
#define MFMA32(a, b, c) __builtin_amdgcn_mfma_f32_32x32x16_bf16((a), (b), (c), 0, 0, 0)
__device__ __forceinline__ float swapmax(float v) { auto rr = __builtin_amdgcn_permlane32_swap(__float_as_uint(v), __float_as_uint(v), false, false); return fmaxf(__uint_as_float(rr[0]), __uint_as_float(rr[1])); }
__device__ __forceinline__ float swapsum(float v) { auto rr = __builtin_amdgcn_permlane32_swap(__float_as_uint(v), __float_as_uint(v), false, false); return __uint_as_float(rr[0]) + __uint_as_float(rr[1]); }
template <int SIDX> __device__ __forceinline__ bf16x8 packp(const f32x16& p) {
    f32x8 t = {p[8 * SIDX + 0], p[8 * SIDX + 1], p[8 * SIDX + 2], p[8 * SIDX + 3], p[8 * SIDX + 4], p[8 * SIDX + 5], p[8 * SIDX + 6], p[8 * SIDX + 7]};
    return __builtin_bit_cast(bf16x8, __builtin_convertvector(t, bf16x8v));
}
template <int NDC, int KS, bool ZERO = true> __device__ __forceinline__ void qk_tile(f32x16& p0, f32x16& p1, const LAS unsigned char* kl, const bf16x8 (&q)[NDC]) {
    if (ZERO) {
#pragma unroll
        for (int i = 0; i < 16; ++i) { p0[i] = 0.f; p1[i] = 0.f; }
    }
    constexpr int PF = QK_PF;
    bf16x8 a[PF + 1][2];
#pragma unroll
    for (int i = 0; i < PF; ++i) { a[i][0] = *(const LAS bf16x8*)(kl + i * 32); a[i][1] = *(const LAS bf16x8*)(kl + 32 * KS + i * 32); }
#pragma unroll
    for (int d0 = 0; d0 < NDC; ++d0) {
        if (d0 + PF < NDC) { a[(d0 + PF) % (PF + 1)][0] = *(const LAS bf16x8*)(kl + (d0 + PF) * 32); a[(d0 + PF) % (PF + 1)][1] = *(const LAS bf16x8*)(kl + 32 * KS + (d0 + PF) * 32); }
        __builtin_amdgcn_sched_barrier(0);
        p0 = MFMA32(a[d0 % (PF + 1)][0], q[d0], p0); p1 = MFMA32(a[d0 % (PF + 1)][1], q[d0], p1);
        __builtin_amdgcn_sched_barrier(0);
    }
}
#ifdef PROBE_QKM2
template <int NDC, int KS> __device__ __forceinline__ void qk_tile_m2(f32x16& p0, f32x16& p1, f32x16& r0, f32x16& r1, const LAS unsigned char* kl, const bf16x8 (&q)[NDC]) {
#pragma unroll
    for (int i = 0; i < 16; ++i) { p0[i] = 0.f; p1[i] = 0.f; r0[i] = 0.f; r1[i] = 0.f; }
    constexpr int PF = QK_PF;
    bf16x8 a[PF + 1][2];
#pragma unroll
    for (int i = 0; i < PF; ++i) { a[i][0] = *(const LAS bf16x8*)(kl + i * 32); a[i][1] = *(const LAS bf16x8*)(kl + 32 * KS + i * 32); }
#pragma unroll
    for (int d0 = 0; d0 < NDC; ++d0) {
        if (d0 + PF < NDC) { a[(d0 + PF) % (PF + 1)][0] = *(const LAS bf16x8*)(kl + (d0 + PF) * 32); a[(d0 + PF) % (PF + 1)][1] = *(const LAS bf16x8*)(kl + 32 * KS + (d0 + PF) * 32); }
        __builtin_amdgcn_sched_barrier(0);
        p0 = MFMA32(a[d0 % (PF + 1)][0], q[d0], p0); p1 = MFMA32(a[d0 % (PF + 1)][1], q[d0], p1);
        r0 = MFMA32(a[d0 % (PF + 1)][0], q[d0], r0); r1 = MFMA32(a[d0 % (PF + 1)][1], q[d0], r1);
        __builtin_amdgcn_sched_barrier(0);
    }
}
#endif
__device__ __forceinline__ void pv_tile(f32x16 (&o)[4], const bf16x8 (&pb)[4], const LAS unsigned char* vl) {
    s16x4 f[5][2];
#define PV_LD(idx) do { constexpr int d_ = (idx) >> 2, s_ = (idx) & 3; \
        f[(idx) % 5][0] = __builtin_amdgcn_ds_read_tr16_b64_v4i16((LAS s16x4*)(vl + s_ * 16 * VS + d_ * 64)); \
        f[(idx) % 5][1] = __builtin_amdgcn_ds_read_tr16_b64_v4i16((LAS s16x4*)(vl + s_ * 16 * VS + 8 * VS + d_ * 64)); } while (0)
    PV_LD(0); PV_LD(1); PV_LD(2); PV_LD(3);
#define PV_STEP(idx) do { if ((idx) + 4 < 16) PV_LD((idx) + 4); __builtin_amdgcn_sched_barrier(0); \
        { const s16x4 t0_ = f[(idx) % 5][0], t1_ = f[(idx) % 5][1]; const bf16x8 vf_ = {t0_[0], t0_[1], t0_[2], t0_[3], t1_[0], t1_[1], t1_[2], t1_[3]}; \
          o[(idx) >> 2] = MFMA32(vf_, pb[(idx) & 3], o[(idx) >> 2]); } __builtin_amdgcn_sched_barrier(0); } while (0)
    PV_STEP(0); PV_STEP(1); PV_STEP(2); PV_STEP(3); PV_STEP(4); PV_STEP(5); PV_STEP(6); PV_STEP(7);
    PV_STEP(8); PV_STEP(9); PV_STEP(10); PV_STEP(11); PV_STEP(12); PV_STEP(13); PV_STEP(14); PV_STEP(15);
#undef PV_STEP
#undef PV_LD
}
template <int NDC, int NQR, int KS> __device__ __forceinline__ void qk_tile_free(f32x16& p0, f32x16& p1, const LAS unsigned char* kl, const bf16x8 (&q)[NQR], const LAS unsigned char* ql) {
#pragma unroll
    for (int i = 0; i < 16; ++i) { p0[i] = 0.f; p1[i] = 0.f; }
#pragma unroll
    for (int d0 = 0; d0 < NDC; ++d0) {
        const bf16x8 a0 = *(const LAS bf16x8*)(kl + d0 * 32);
        const bf16x8 a1 = *(const LAS bf16x8*)(kl + 32 * KS + d0 * 32);
        bf16x8 qq; if (d0 < NQR) qq = q[d0 < NQR ? d0 : 0]; else qq = *(const LAS bf16x8*)(ql + (d0 - NQR) * 1024);
        p0 = MFMA32(a0, qq, p0); p1 = MFMA32(a1, qq, p1);
    }
}
__device__ __forceinline__ float sm_core(f32x16& p0, f32x16& p1, float& m, float& l) {
    float tm = p0[0];
#pragma unroll
    for (int r = 1; r < 16; ++r) tm = fmaxf(tm, p0[r]);
#pragma unroll
    for (int r = 0; r < 16; ++r) tm = fmaxf(tm, p1[r]);
    tm = swapmax(tm);
    const float mn = fmaxf(m, tm);
    const float alpha = __builtin_amdgcn_exp2f(m - mn);
    m = mn;
    float ps = 0.f;
#pragma unroll
    for (int r = 0; r < 16; ++r) { p0[r] = __builtin_amdgcn_exp2f(p0[r] - mn); ps += p0[r]; }
#pragma unroll
    for (int r = 0; r < 16; ++r) { p1[r] = __builtin_amdgcn_exp2f(p1[r] - mn); ps += p1[r]; }
    ps = swapsum(ps);
    l = l * alpha + ps;
    return alpha;
}
__device__ __forceinline__ void online_sm(f32x16& p0, f32x16& p1, float& m, float& l, f32x16 (&o)[4]) {
    float tm = p0[0];
#pragma unroll
    for (int r = 1; r < 16; ++r) tm = fmaxf(tm, p0[r]);
#pragma unroll
    for (int r = 0; r < 16; ++r) tm = fmaxf(tm, p1[r]);
    tm = swapmax(tm);
    const float mn = fmaxf(m, tm);
    const float alpha = __builtin_amdgcn_exp2f(m - mn);
    m = mn;
    float ps = 0.f;
#pragma unroll
    for (int r = 0; r < 16; ++r) { p0[r] = __builtin_amdgcn_exp2f(p0[r] - mn); ps += p0[r]; }
#pragma unroll
    for (int r = 0; r < 16; ++r) { p1[r] = __builtin_amdgcn_exp2f(p1[r] - mn); ps += p1[r]; }
    ps = swapsum(ps);
    l = l * alpha + ps;
    if (!__all(alpha == 1.f)) {
#pragma unroll
        for (int d = 0; d < 4; ++d)
#pragma unroll
            for (int r = 0; r < 16; ++r) o[d][r] *= alpha;
    }
}

#ifdef MLA_FP8
typedef long i64;
constexpr int KS8 = 200, MLA_KB8 = 64 * KS8;
static_assert(2 * MLA_KB8 + 3 * VB <= 131072, "MLA fp8 LDS map");
#define MFMA32F8(a, b, c) __builtin_amdgcn_mfma_f32_32x32x16_fp8_fp8((a), (b), (c), 0, 0, 0)
template <int NDC> __device__ __forceinline__ void qk_tile8(f32x16& p0, f32x16& p1, const LAS unsigned char* kl, const i64 (&q)[NDC]) {
#pragma unroll
    for (int i = 0; i < 16; ++i) { p0[i] = 0.f; p1[i] = 0.f; }
    constexpr int PF = 4;
    i64 a[PF + 1][2];
#pragma unroll
    for (int i = 0; i < PF; ++i) { a[i][0] = *(const LAS i64*)(kl + i * 16); a[i][1] = *(const LAS i64*)(kl + 32 * KS8 + i * 16); }
#pragma unroll
    for (int d0 = 0; d0 < NDC; ++d0) {
        if (d0 + PF < NDC) { a[(d0 + PF) % (PF + 1)][0] = *(const LAS i64*)(kl + (d0 + PF) * 16); a[(d0 + PF) % (PF + 1)][1] = *(const LAS i64*)(kl + 32 * KS8 + (d0 + PF) * 16); }
        __builtin_amdgcn_sched_barrier(0);
        __builtin_amdgcn_s_setprio(1);
        p0 = MFMA32F8(a[d0 % (PF + 1)][0], q[d0], p0); p1 = MFMA32F8(a[d0 % (PF + 1)][1], q[d0], p1);
        __builtin_amdgcn_s_setprio(0);
        __builtin_amdgcn_sched_barrier(0);
    }
}
__device__ __forceinline__ void online_sm_scaled(f32x16& p0, f32x16& p1, float& m, float& l, f32x16 (&o)[4], const float C2) {
    float tm = p0[0];
#pragma unroll
    for (int r = 1; r < 16; ++r) tm = fmaxf(tm, p0[r]);
#pragma unroll
    for (int r = 0; r < 16; ++r) tm = fmaxf(tm, p1[r]);
    tm = swapmax(tm);
    const float mn = fmaxf(m, tm);
    const float alpha = __builtin_amdgcn_exp2f((m - mn) * C2);
    m = mn;
    const float mc = -mn * C2;
    float ps = 0.f;
#pragma unroll
    for (int r = 0; r < 16; ++r) { p0[r] = __builtin_amdgcn_exp2f(__builtin_fmaf(p0[r], C2, mc)); ps += p0[r]; }
#pragma unroll
    for (int r = 0; r < 16; ++r) { p1[r] = __builtin_amdgcn_exp2f(__builtin_fmaf(p1[r], C2, mc)); ps += p1[r]; }
    ps = swapsum(ps);
    l = l * alpha + ps;
    if (!__all(alpha == 1.f)) {
#pragma unroll
        for (int d = 0; d < 4; ++d)
#pragma unroll
            for (int r = 0; r < 16; ++r) o[d][r] *= alpha;
    }
}
#endif
#ifdef MLA_FP8V
constexpr int VS8 = 72, VB8 = 128 * VS8;
constexpr int VS8B = 136, VB8B = 128 * VS8B, MLA_KB8B = 128 * KS8;
static_assert(2 * MLA_KB8B + 3 * VB8B <= 131072, "MLA big-tile LDS map");
#ifdef MLA_BIG
#define PV8_RS VS8B
#else
#define PV8_RS VS8
#endif
static_assert(2 * MLA_KB8 + 3 * VB8 <= 131072, "MLA fp8 LDS map");
template <int SIDX> __device__ __forceinline__ i64 packp8(const f32x16& p) {
    int w0 = __builtin_amdgcn_cvt_pk_fp8_f32(p[8 * SIDX + 0] * 256.f, p[8 * SIDX + 1] * 256.f, 0, false); w0 = __builtin_amdgcn_cvt_pk_fp8_f32(p[8 * SIDX + 2] * 256.f, p[8 * SIDX + 3] * 256.f, w0, true);
    int w1 = __builtin_amdgcn_cvt_pk_fp8_f32(p[8 * SIDX + 4] * 256.f, p[8 * SIDX + 5] * 256.f, 0, false); w1 = __builtin_amdgcn_cvt_pk_fp8_f32(p[8 * SIDX + 6] * 256.f, p[8 * SIDX + 7] * 256.f, w1, true);
    return (i64)(((unsigned long long)(unsigned)w1 << 32) | (unsigned)w0);
}
__device__ __forceinline__ void pv_tile8(f32x16 (&o)[4], const i64 (&pb)[4], const LAS unsigned char* vl) {
    i64 f[5];
#define PV8_LD(idx) f[(idx) % 5] = *(const LAS i64*)(vl + ((idx) >> 2) * 32 * PV8_RS + ((idx) & 3) * 16)
    PV8_LD(0); PV8_LD(1); PV8_LD(2); PV8_LD(3);
#define PV8_STEP(idx) do { if ((idx) + 4 < 16) PV8_LD((idx) + 4); __builtin_amdgcn_sched_barrier(0); \
        o[(idx) >> 2] = MFMA32F8(f[(idx) % 5], pb[(idx) & 3], o[(idx) >> 2]); __builtin_amdgcn_sched_barrier(0); } while (0)
    PV8_STEP(0); PV8_STEP(1); PV8_STEP(2); PV8_STEP(3); PV8_STEP(4); PV8_STEP(5); PV8_STEP(6); PV8_STEP(7);
    PV8_STEP(8); PV8_STEP(9); PV8_STEP(10); PV8_STEP(11); PV8_STEP(12); PV8_STEP(13); PV8_STEP(14); PV8_STEP(15);
#undef PV8_STEP
#undef PV8_LD
}
#endif
#ifdef MLA_MX
typedef int i32x8 __attribute__((ext_vector_type(8)));
constexpr int KSX = 208, MLA_KBX = 64 * KSX;
constexpr int VSX = 80, VBX = 128 * VSX;
static_assert(2 * MLA_KBX + 3 * VBX <= 131072, "MLA mx LDS map");
#define MFMAX(a, b, c) __builtin_amdgcn_mfma_scale_f32_32x32x64_f8f6f4((a), (b), (c), 0, 0, 0, 0x7f7f7f7f, 0, 0x7f7f7f7f)
__device__ __forceinline__ i32x8 ldsx(const LAS unsigned char* p) {
    const u32x4 a = *(const LAS u32x4*)p, b = *(const LAS u32x4*)(p + 16);
    return (i32x8){(int)a.x, (int)a.y, (int)a.z, (int)a.w, (int)b.x, (int)b.y, (int)b.z, (int)b.w};
}
__device__ __forceinline__ void qk_tilex(f32x16& p0, f32x16& p1, const LAS unsigned char* kl, const i32x8 (&q)[3]) {
#pragma unroll
    for (int i = 0; i < 16; ++i) { p0[i] = 0.f; p1[i] = 0.f; }
    i32x8 a0 = ldsx(kl), a1 = ldsx(kl + 32 * KSX), a2 = ldsx(kl + 64), a3 = ldsx(kl + 32 * KSX + 64);
    __builtin_amdgcn_sched_barrier(0);
    __builtin_amdgcn_s_setprio(1);
    p0 = MFMAX(a0, q[0], p0); p1 = MFMAX(a1, q[0], p1);
    __builtin_amdgcn_s_setprio(0);
    __builtin_amdgcn_sched_barrier(0);
    a0 = ldsx(kl + 128); a1 = ldsx(kl + 32 * KSX + 128);
    __builtin_amdgcn_sched_barrier(0);
    __builtin_amdgcn_s_setprio(1);
    p0 = MFMAX(a2, q[1], p0); p1 = MFMAX(a3, q[1], p1);
    __builtin_amdgcn_sched_barrier(0);
    p0 = MFMAX(a0, q[2], p0); p1 = MFMAX(a1, q[2], p1);
    __builtin_amdgcn_s_setprio(0);
    __builtin_amdgcn_sched_barrier(0);
}
__device__ __forceinline__ void pv_tilex(f32x16 (&o)[4], const i32x8& pb, const LAS unsigned char* vl) {
    i32x8 f0 = ldsx(vl), f1 = ldsx(vl + 32 * VSX);
    __builtin_amdgcn_sched_barrier(0);
    o[0] = MFMAX(f0, pb, o[0]);
    __builtin_amdgcn_sched_barrier(0);
    f0 = ldsx(vl + 64 * VSX);
    __builtin_amdgcn_sched_barrier(0);
    o[1] = MFMAX(f1, pb, o[1]);
    __builtin_amdgcn_sched_barrier(0);
    f1 = ldsx(vl + 96 * VSX);
    __builtin_amdgcn_sched_barrier(0);
    o[2] = MFMAX(f0, pb, o[2]);
    __builtin_amdgcn_sched_barrier(0);
    o[3] = MFMAX(f1, pb, o[3]);
    __builtin_amdgcn_sched_barrier(0);
}
__device__ __forceinline__ i32x8 packpx(const f32x16& p0, const f32x16& p1) {
    i32x8 w;
#pragma unroll
    for (int g = 0; g < 4; ++g) {
        int a = __builtin_amdgcn_cvt_pk_fp8_f32(p0[4 * g + 0], p0[4 * g + 1], 0, false); a = __builtin_amdgcn_cvt_pk_fp8_f32(p0[4 * g + 2], p0[4 * g + 3], a, true); w[g] = a;
        int b = __builtin_amdgcn_cvt_pk_fp8_f32(p1[4 * g + 0], p1[4 * g + 1], 0, false); b = __builtin_amdgcn_cvt_pk_fp8_f32(p1[4 * g + 2], p1[4 * g + 3], b, true); w[4 + g] = b;
    }
    return w;
}
__device__ __forceinline__ void online_sm_x(f32x16& p0, f32x16& p1, float& m, float& l, f32x16 (&o)[4], const float C2) {
    float tm = p0[0];
#pragma unroll
    for (int r = 1; r < 16; ++r) tm = fmaxf(tm, p0[r]);
#pragma unroll
    for (int r = 0; r < 16; ++r) tm = fmaxf(tm, p1[r]);
    tm = swapmax(tm);
    const float mn = fmaxf(m, tm);
    const float alpha = __builtin_amdgcn_exp2f((m - mn) * C2);
    m = mn;
    const float mc = 8.f - mn * C2;
    float ps = 0.f;
#pragma unroll
    for (int r = 0; r < 16; ++r) { p0[r] = __builtin_amdgcn_exp2f(__builtin_fmaf(p0[r], C2, mc)); ps += p0[r]; }
#pragma unroll
    for (int r = 0; r < 16; ++r) { p1[r] = __builtin_amdgcn_exp2f(__builtin_fmaf(p1[r], C2, mc)); ps += p1[r]; }
    ps = swapsum(ps);
    l = l * alpha + ps;
    if (!__all(alpha == 1.f)) {
#pragma unroll
        for (int d = 0; d < 4; ++d)
#pragma unroll
            for (int r = 0; r < 16; ++r) o[d][r] *= alpha;
    }
}
#endif
#ifdef MLA_MXL
#ifdef MLA_MXU
#define MXL_T 126.0f
#define MXL_REF 120.0f
#define MFMAXQ(a, b, c) __builtin_amdgcn_mfma_scale_f32_32x32x64_f8f6f4((a), (b), (c), 0, 0, 0, 0x7f7f7f7f, 0, 0x7f7f7f7f)
__device__ __forceinline__ i32x8 byte_packx(const f32x16& p0, const f32x16& p1) {
    i32x8 w;
#pragma unroll
    for (int g = 0; g < 4; ++g) {
        unsigned a = __builtin_amdgcn_cvt_pk_u8_f32(p0[4 * g + 0], 0, 0u); a = __builtin_amdgcn_cvt_pk_u8_f32(p0[4 * g + 1], 1, a); a = __builtin_amdgcn_cvt_pk_u8_f32(p0[4 * g + 2], 2, a); a = __builtin_amdgcn_cvt_pk_u8_f32(p0[4 * g + 3], 3, a); w[g] = (int)a;
        unsigned b = __builtin_amdgcn_cvt_pk_u8_f32(p1[4 * g + 0], 0, 0u); b = __builtin_amdgcn_cvt_pk_u8_f32(p1[4 * g + 1], 1, b); b = __builtin_amdgcn_cvt_pk_u8_f32(p1[4 * g + 2], 2, b); b = __builtin_amdgcn_cvt_pk_u8_f32(p1[4 * g + 3], 3, b); w[4 + g] = (int)b;
    }
    return w;
}
#else
#define MXL_T 7.0f
#define MXL_REF 0.0f
#define MFMAXQ(a, b, c) __builtin_amdgcn_mfma_scale_f32_32x32x64_f8f6f4((a), (b), (c), 0, 0, 0, 0x7f7f7f7f, 0, 0x7c7c7c7c)
#endif
__device__ __forceinline__ void qk_tilexl(f32x16& p0, f32x16& p1, const f32x16& mref, const LAS unsigned char* kl, const i32x8 (&q)[3]) {
    i32x8 a0 = ldsx(kl), a1 = ldsx(kl + 32 * KSX), a2 = ldsx(kl + 64), a3 = ldsx(kl + 32 * KSX + 64);
    __builtin_amdgcn_sched_barrier(0);
    __builtin_amdgcn_s_setprio(1);
    p0 = MFMAXQ(a0, q[0], mref); p1 = MFMAXQ(a1, q[0], mref);
    __builtin_amdgcn_s_setprio(0);
    __builtin_amdgcn_sched_barrier(0);
    a0 = ldsx(kl + 128); a1 = ldsx(kl + 32 * KSX + 128);
    __builtin_amdgcn_sched_barrier(0);
    __builtin_amdgcn_s_setprio(1);
    p0 = MFMAXQ(a2, q[1], p0); p1 = MFMAXQ(a3, q[1], p1);
    __builtin_amdgcn_sched_barrier(0);
    p0 = MFMAXQ(a0, q[2], p0); p1 = MFMAXQ(a1, q[2], p1);
    __builtin_amdgcn_s_setprio(0);
    __builtin_amdgcn_sched_barrier(0);
}
template <int RS = VSX>
__device__ __forceinline__ void pv_tilexl_pre(f32x16 (&o)[5], const i32x8& pb, const i32x8& ones, const LAS unsigned char* vl, i32x8 f0, i32x8 f1) {
    __builtin_amdgcn_sched_barrier(0);
    o[4] = MFMAX(ones, pb, o[4]);
    __builtin_amdgcn_sched_barrier(0);
    o[0] = MFMAX(f0, pb, o[0]);
    __builtin_amdgcn_sched_barrier(0);
    f0 = ldsx(vl + 64 * RS);
    __builtin_amdgcn_sched_barrier(0);
    o[1] = MFMAX(f1, pb, o[1]);
    __builtin_amdgcn_sched_barrier(0);
    f1 = ldsx(vl + 96 * RS);
    __builtin_amdgcn_sched_barrier(0);
    o[2] = MFMAX(f0, pb, o[2]);
    __builtin_amdgcn_sched_barrier(0);
    o[3] = MFMAX(f1, pb, o[3]);
    __builtin_amdgcn_sched_barrier(0);
}
template <int RS = VSX>
__device__ __forceinline__ void pv_tilexl(f32x16 (&o)[5], const i32x8& pb, const i32x8& ones, const LAS unsigned char* vl) {
    i32x8 f0 = ldsx(vl), f1 = ldsx(vl + 32 * RS);
    __builtin_amdgcn_sched_barrier(0);
    o[4] = MFMAX(ones, pb, o[4]);
    __builtin_amdgcn_sched_barrier(0);
    o[0] = MFMAX(f0, pb, o[0]);
    __builtin_amdgcn_sched_barrier(0);
    f0 = ldsx(vl + 64 * RS);
    __builtin_amdgcn_sched_barrier(0);
    o[1] = MFMAX(f1, pb, o[1]);
    __builtin_amdgcn_sched_barrier(0);
    f1 = ldsx(vl + 96 * RS);
    __builtin_amdgcn_sched_barrier(0);
    o[2] = MFMAX(f0, pb, o[2]);
    __builtin_amdgcn_sched_barrier(0);
    o[3] = MFMAX(f1, pb, o[3]);
    __builtin_amdgcn_sched_barrier(0);
}
__device__ __forceinline__ i32x8 exp_packx(const f32x16& p0, const f32x16& p1, int any) {
    i32x8 w;
#pragma unroll
    for (int g = 0; g < 4; ++g) {
        int a = __builtin_amdgcn_cvt_pk_fp8_f32(__builtin_amdgcn_exp2f(p0[4 * g + 0]), __builtin_amdgcn_exp2f(p0[4 * g + 1]), any, false);
        a = __builtin_amdgcn_cvt_pk_fp8_f32(__builtin_amdgcn_exp2f(p0[4 * g + 2]), __builtin_amdgcn_exp2f(p0[4 * g + 3]), a, true); w[g] = a;
        int b = __builtin_amdgcn_cvt_pk_fp8_f32(__builtin_amdgcn_exp2f(p1[4 * g + 0]), __builtin_amdgcn_exp2f(p1[4 * g + 1]), any, false);
        b = __builtin_amdgcn_cvt_pk_fp8_f32(__builtin_amdgcn_exp2f(p1[4 * g + 2]), __builtin_amdgcn_exp2f(p1[4 * g + 3]), b, true); w[4 + g] = b;
    }
    return w;
}
#endif
#ifdef MLA_PIPE8
template <int NDC> __device__ __forceinline__ void qk_tile8_free(f32x16& p0, f32x16& p1, const LAS unsigned char* kl, const i64 (&q)[NDC]) {
#pragma unroll
    for (int i = 0; i < 16; ++i) { p0[i] = 0.f; p1[i] = 0.f; }
#pragma unroll
    for (int d0 = 0; d0 < NDC; ++d0) {
        const i64 a0 = *(const LAS i64*)(kl + d0 * 16), a1 = *(const LAS i64*)(kl + 32 * KS8 + d0 * 16);
        p0 = MFMA32F8(a0, q[d0], p0); p1 = MFMA32F8(a1, q[d0], p1);
    }
}
__device__ __forceinline__ float sm_core_scaled(f32x16& p0, f32x16& p1, float& m, float& l, const float C2) {
    float tm = p0[0];
#pragma unroll
    for (int r = 1; r < 16; ++r) tm = fmaxf(tm, p0[r]);
#pragma unroll
    for (int r = 0; r < 16; ++r) tm = fmaxf(tm, p1[r]);
    tm = swapmax(tm);
    const float mn = fmaxf(m, tm);
    const float alpha = __builtin_amdgcn_exp2f((m - mn) * C2);
    m = mn;
    const float mc = -mn * C2;
    float ps = 0.f;
#pragma unroll
    for (int r = 0; r < 16; ++r) { p0[r] = __builtin_amdgcn_exp2f(__builtin_fmaf(p0[r], C2, mc)); ps += p0[r]; }
#pragma unroll
    for (int r = 0; r < 16; ++r) { p1[r] = __builtin_amdgcn_exp2f(__builtin_fmaf(p1[r], C2, mc)); ps += p1[r]; }
    ps = swapsum(ps);
    l = l * alpha + ps;
    return alpha;
}
#endif
#ifdef MLA_PIPE8
struct MlaPtrs { const bf16* Q; const bf16* K; const bf16* V; const bf16* Z; bf16* O; };
__device__ __forceinline__ void mla_mask(f32x16& p0, f32x16& p1, int dq) {
#pragma unroll
    for (int r = 0; r < 16; ++r) { const int c = (r & 3) + 8 * (r >> 2);
        if (c > dq) p0[r] = -__builtin_inff();
        if (c + 32 > dq) p1[r] = -__builtin_inff(); }
}
__device__ __forceinline__ void mla_unit(LAS unsigned char* lds, const MlaPtrs& P, int head, int qb, int tid_in, int wave, int lane_in) {
    int tid = tid_in; asm volatile("" : "+v"(tid)); const int lane = tid & 63; (void)lane_in;
    const int r32 = lane & 31, hi = lane >> 5;
    const int q0 = qb * 256, qw = q0 + wave * 32, tq = qw + r32;
    i64 q[12];
    { const unsigned char* qp = (const unsigned char*)P.Q + (size_t)tq * 3072 + head * 192 + hi * 8;
#pragma unroll
      for (int d0 = 0; d0 < 12; ++d0) q[d0] = *(const GAS i64*)(qp + d0 * 16); }
    const int NT = 4 * (qb + 1);
    const int srow = tid >> 3, sc8 = tid & 7;
    const unsigned char* kg = (const unsigned char*)P.K + (size_t)head * 192 + (size_t)srow * 3072 + sc8 * 8;
    const unsigned char* vg = (const unsigned char*)P.V + ((size_t)head * 128 + (tid >> 2)) * S + (tid & 3) * 16;
    LAS unsigned char* kst = lds + srow * KS8 + sc8 * 8;
    LAS unsigned char* vst = lds + 2 * MLA_KB8 + (tid >> 2) * VS8 + (tid & 3) * 16;
    const LAS unsigned char* kl = lds + r32 * KS8 + hi * 8;
    const LAS unsigned char* vl = lds + 2 * MLA_KB8 + r32 * VS8 + hi * 8;
    u32x2 sk0, sk1, sk2; u32x4 sv0;
#define MLA_LOADK(j) do { const unsigned char* kp_ = kg + (size_t)(j) * (64 * 3072); sk0 = *(const GAS u32x2*)(kp_); sk1 = *(const GAS u32x2*)(kp_ + 64); sk2 = *(const GAS u32x2*)(kp_ + 128); } while (0)
#define MLA_LOADV(j) do { sv0 = *(const GAS u32x4*)(vg + (size_t)(j) * 64); } while (0)
#define MLA_STOREK(b) do { LAS unsigned char* kd_ = kst + (b) * MLA_KB8; *(LAS u32x2*)(kd_) = sk0; *(LAS u32x2*)(kd_ + 64) = sk1; *(LAS u32x2*)(kd_ + 128) = sk2; } while (0)
#define MLA_STOREV(b) do { LAS unsigned char* vd_ = vst + (b) * VB8; *(LAS u32x2*)(vd_) = (u32x2){sv0.x, sv0.y}; *(LAS u32x2*)(vd_ + 8) = (u32x2){sv0.z, sv0.w}; } while (0)
    float m = -1e30f, l = 0.f; f32x16 o[4];
#pragma unroll
    for (int d = 0; d < 4; ++d)
#pragma unroll
        for (int r = 0; r < 16; ++r) o[d][r] = 0.f;
    f32x16 pA0, pA1, pB0, pB1;
    MLA_LOADK(0); MLA_LOADV(0); MLA_STOREK(0); MLA_STOREV(0);
    MLA_LOADK(1);
    __syncthreads();
    qk_tile8<12>(pA0, pA1, kl, q);
    if (63 > qw) mla_mask(pA0, pA1, tq - 4 * hi);
    MLA_STOREK(1);
    if (2 < NT) MLA_LOADK(2);
    MLA_LOADV(1);
    __syncthreads();
#define MLA_SGB1() do { __builtin_amdgcn_sched_group_barrier(0x100, 2, 0); __builtin_amdgcn_sched_group_barrier(0x008, 1, 0); __builtin_amdgcn_sched_group_barrier(0x002, 6, 0); \
        __builtin_amdgcn_sched_group_barrier(0x008, 1, 0); __builtin_amdgcn_sched_group_barrier(0x002, 6, 0); } while (0)
#define MLA_SGB() do { MLA_SGB1(); MLA_SGB1(); MLA_SGB1(); MLA_SGB1(); MLA_SGB1(); MLA_SGB1(); MLA_SGB1(); MLA_SGB1(); MLA_SGB1(); MLA_SGB1(); MLA_SGB1(); MLA_SGB1(); } while (0)
#define MLA_STEP(PX0, PX1, PY0, PY1, j) do { \
        const int kb1_ = 64 * ((j) + 1); \
        const bool a1_ = ((j) + 1 < NT) && (kb1_ <= qw + 31), a0_ = (64 * (j) <= qw + 31); \
        float alpha_ = 1.f; i64 pb_[4]; \
        if (a1_) { \
            __builtin_amdgcn_sched_barrier(0); \
            qk_tile8_free<12>(PY0, PY1, kl + (((j) + 1) & 1) * MLA_KB8, q); \
            alpha_ = sm_core_scaled(PX0, PX1, m, l, QS_MLA); \
            pb_[0] = packp8<0>(PX0); pb_[1] = packp8<1>(PX0); pb_[2] = packp8<0>(PX1); pb_[3] = packp8<1>(PX1); \
            MLA_SGB(); \
            __builtin_amdgcn_sched_barrier(0); \
            if (kb1_ + 63 > qw) mla_mask(PY0, PY1, tq - kb1_ - 4 * hi); \
        } else if (a0_) { \
            alpha_ = sm_core_scaled(PX0, PX1, m, l, QS_MLA); \
            pb_[0] = packp8<0>(PX0); pb_[1] = packp8<1>(PX0); pb_[2] = packp8<0>(PX1); pb_[3] = packp8<1>(PX1); \
        } \
        if (a0_) { \
            if (!__all(alpha_ == 1.f)) { _Pragma("unroll") for (int d_ = 0; d_ < 4; ++d_) _Pragma("unroll") for (int r_ = 0; r_ < 16; ++r_) o[d_][r_] *= alpha_; } \
            pv_tile8(o, pb_, vl + ((j) & 1) * VB8); \
        } \
        if ((j) + 2 < NT) MLA_STOREK((j) & 1); \
        if ((j) + 1 < NT) MLA_STOREV(((j) + 1) & 1); \
        if ((j) + 3 < NT) MLA_LOADK((j) + 3); \
        if ((j) + 2 < NT) MLA_LOADV((j) + 2); \
        __syncthreads(); } while (0)
    for (int j = 0; j < NT; j += 2) {
        MLA_STEP(pA0, pA1, pB0, pB1, j);
        MLA_STEP(pB0, pB1, pA0, pA1, j + 1);
    }
#undef MLA_STEP
#undef MLA_SGB
#undef MLA_SGB1
#undef MLA_LOADK
#undef MLA_LOADV
#undef MLA_STOREK
#undef MLA_STOREV
    const float inv = (1.f / 256.f) / l;
    const bf16* zp = P.Z + (size_t)tq * 2048 + head * 128 + 4 * hi;
    bf16* op = P.O + (size_t)tq * 4096 + head * 128 + 4 * hi;
#pragma unroll
    for (int d0 = 0; d0 < 4; ++d0)
#pragma unroll
        for (int rg = 0; rg < 4; ++rg) { const int dim = 32 * d0 + 8 * rg;
            const u32x2 z = *(const GAS u32x2*)(zp + dim);
            u32x2 w; w.x = pk2(o[d0][4 * rg + 0] * inv * bflo(z.x), o[d0][4 * rg + 1] * inv * bfhi(z.x)); w.y = pk2(o[d0][4 * rg + 2] * inv * bflo(z.y), o[d0][4 * rg + 3] * inv * bfhi(z.y));
            *(GAS u32x2*)(op + dim) = w; }
}
#elif defined(MLA_PIPE)
struct MlaPtrs { const bf16* Q; const bf16* K; const bf16* V; const bf16* Z; bf16* O; };
__device__ __forceinline__ void mla_mask(f32x16& p0, f32x16& p1, int dq) {
#pragma unroll
    for (int r = 0; r < 16; ++r) { const int c = (r & 3) + 8 * (r >> 2);
        if (c > dq) p0[r] = -__builtin_inff();
        if (c + 32 > dq) p1[r] = -__builtin_inff(); }
}
__device__ __forceinline__ void mla_unit(LAS unsigned char* lds, const MlaPtrs& P, int head, int qb, int tid_in, int wave, int lane_in) {
    int tid = tid_in; asm volatile("" : "+v"(tid)); const int lane = tid & 63; (void)lane_in;
    const int r32 = lane & 31, hi = lane >> 5;
    const int q0 = qb * 256, qw = q0 + wave * 32, tq = qw + r32;
    bf16x8 q[8];
    LAS unsigned char* ql = lds + MLA_QL + wave * 4096 + lane * 16;
    { const bf16* qp = P.Q + (size_t)tq * 3072 + head * 192 + hi * 8;
#pragma unroll
      for (int d0 = 0; d0 < 8; ++d0) q[d0] = *(const GAS bf16x8*)(qp + d0 * 16);
#pragma unroll
      for (int d0 = 8; d0 < 12; ++d0) *(LAS bf16x8*)(ql + (d0 - 8) * 1024) = *(const GAS bf16x8*)(qp + d0 * 16); }
    const int NT = 4 * (qb + 1);
    const int srow = tid >> 3, sc8 = tid & 7;
    const unsigned char* kg = (const unsigned char*)P.K + (size_t)head * 384 + (size_t)srow * 6144 + sc8 * 16;
    const unsigned char* vg = (const unsigned char*)P.V + (size_t)head * 256 + (size_t)srow * 4096 + sc8 * 16;
    LAS unsigned char* kst = lds + srow * KS_M + sc8 * 16;
    LAS unsigned char* vst = lds + 2 * MLA_KB + srow * VS + sc8 * 16;
    const LAS unsigned char* kl = lds + r32 * KS_M + hi * 16;
    const LAS unsigned char* vl = lds + 2 * MLA_KB + (4 * hi + ((lane & 15) >> 2)) * VS + (16 * ((lane >> 4) & 1) + 4 * (lane & 3)) * 2;
    u32x4 sk0, sk1, sk2, sv0, sv1;
#define MLA_LOADK(j) do { const unsigned char* kp_ = kg + (size_t)(j) * (64 * 6144); sk0 = *(const GAS u32x4*)(kp_); sk1 = *(const GAS u32x4*)(kp_ + 128); sk2 = *(const GAS u32x4*)(kp_ + 256); } while (0)
#define MLA_LOADV(j) do { const unsigned char* vp_ = vg + (size_t)(j) * (64 * 4096); sv0 = *(const GAS u32x4*)(vp_); sv1 = *(const GAS u32x4*)(vp_ + 128); } while (0)
#define MLA_STOREK(b) do { LAS unsigned char* kd_ = kst + (b) * MLA_KB; *(LAS u32x4*)(kd_) = sk0; *(LAS u32x4*)(kd_ + 128) = sk1; *(LAS u32x4*)(kd_ + 256) = sk2; } while (0)
#define MLA_STOREV(b) do { LAS unsigned char* vd_ = vst + (b) * VB; *(LAS u32x4*)(vd_) = sv0; *(LAS u32x4*)(vd_ + 128) = sv1; } while (0)
    float m = -1e30f, l = 0.f; f32x16 o[4];
#pragma unroll
    for (int d = 0; d < 4; ++d)
#pragma unroll
        for (int r = 0; r < 16; ++r) o[d][r] = 0.f;
    f32x16 pA0, pA1, pB0, pB1;
    MLA_LOADK(0); MLA_LOADV(0); MLA_STOREK(0); MLA_STOREV(0);
    MLA_LOADK(1);
    __syncthreads();
    qk_tile_free<12, 8, KS_M>(pA0, pA1, kl, q, ql);
    if (63 > qw) mla_mask(pA0, pA1, tq - 4 * hi);
    MLA_STOREK(1);
    if (2 < NT) MLA_LOADK(2);
    MLA_LOADV(1);
    __syncthreads();
#define MLA_SGB1(NR) do { __builtin_amdgcn_sched_group_barrier(0x100, NR, 0); __builtin_amdgcn_sched_group_barrier(0x008, 1, 0); __builtin_amdgcn_sched_group_barrier(0x002, 6, 0); \
        __builtin_amdgcn_sched_group_barrier(0x008, 1, 0); __builtin_amdgcn_sched_group_barrier(0x002, 6, 0); } while (0)
#define MLA_SGB() do { MLA_SGB1(2); MLA_SGB1(2); MLA_SGB1(2); MLA_SGB1(2); MLA_SGB1(2); MLA_SGB1(2); MLA_SGB1(2); MLA_SGB1(2); MLA_SGB1(3); MLA_SGB1(3); MLA_SGB1(3); MLA_SGB1(3); } while (0)
#define MLA_STEP(PX0, PX1, PY0, PY1, j) do { \
        const int kb1_ = 64 * ((j) + 1); \
        const bool a1_ = ((j) + 1 < NT) && (kb1_ <= qw + 31), a0_ = (64 * (j) <= qw + 31); \
        float alpha_ = 1.f; bf16x8 pb_[4]; \
        if (a1_) { \
            __builtin_amdgcn_sched_barrier(0); \
            qk_tile_free<12, 8, KS_M>(PY0, PY1, kl + (((j) + 1) & 1) * MLA_KB, q, ql); \
            alpha_ = sm_core(PX0, PX1, m, l); \
            pb_[0] = packp<0>(PX0); pb_[1] = packp<1>(PX0); pb_[2] = packp<0>(PX1); pb_[3] = packp<1>(PX1); \
            MLA_SGB(); \
            __builtin_amdgcn_sched_barrier(0); \
            if (kb1_ + 63 > qw) mla_mask(PY0, PY1, tq - kb1_ - 4 * hi); \
        } else if (a0_) { \
            alpha_ = sm_core(PX0, PX1, m, l); \
            pb_[0] = packp<0>(PX0); pb_[1] = packp<1>(PX0); pb_[2] = packp<0>(PX1); pb_[3] = packp<1>(PX1); \
        } \
        if (a0_) { \
            if (!__all(alpha_ == 1.f)) { _Pragma("unroll") for (int d_ = 0; d_ < 4; ++d_) _Pragma("unroll") for (int r_ = 0; r_ < 16; ++r_) o[d_][r_] *= alpha_; } \
            pv_tile(o, pb_, vl + ((j) & 1) * VB); \
        } \
        if ((j) + 2 < NT) MLA_STOREK((j) & 1); \
        if ((j) + 1 < NT) MLA_STOREV(((j) + 1) & 1); \
        if ((j) + 3 < NT) MLA_LOADK((j) + 3); \
        if ((j) + 2 < NT) MLA_LOADV((j) + 2); \
        __syncthreads(); } while (0)
    for (int j = 0; j < NT; j += 2) {
        MLA_STEP(pA0, pA1, pB0, pB1, j);
        MLA_STEP(pB0, pB1, pA0, pA1, j + 1);
    }
#undef MLA_STEP
#undef MLA_SGB
#undef MLA_SGB1
#undef MLA_LOADK
#undef MLA_LOADV
#undef MLA_STOREK
#undef MLA_STOREV
    const float inv = 1.f / l;
    const bf16* zp = P.Z + (size_t)tq * 2048 + head * 128 + 4 * hi;
    bf16* op = P.O + (size_t)tq * 4096 + head * 128 + 4 * hi;
#pragma unroll
    for (int d0 = 0; d0 < 4; ++d0)
#pragma unroll
        for (int rg = 0; rg < 4; ++rg) { const int dim = 32 * d0 + 8 * rg;
            const u32x2 z = *(const GAS u32x2*)(zp + dim);
            u32x2 w; w.x = pk2(o[d0][4 * rg + 0] * inv * bflo(z.x), o[d0][4 * rg + 1] * inv * bfhi(z.x)); w.y = pk2(o[d0][4 * rg + 2] * inv * bflo(z.y), o[d0][4 * rg + 3] * inv * bfhi(z.y));
            *(GAS u32x2*)(op + dim) = w; }
}

#else
#if defined(MLA_MXQ)
struct MlaPtrs { const bf16* Q; const bf16* K; const bf16* V; const bf16* Z; bf16* O; };
constexpr int VBQ = 160 * VSX;
static_assert(2 * MLA_KBX + 2 * VBQ <= 131072, "MLA mxq LDS map");
__device__ __forceinline__ void mla_maskq(f32x16& p0, f32x16& p1, int dq) {
#pragma unroll
    for (int r = 0; r < 16; ++r) { const int c = (r & 3) + 8 * (r >> 2);
        if (c > dq) p0[r] = -__builtin_inff();
        if (c + 32 > dq) p1[r] = -__builtin_inff(); }
}
__device__ __forceinline__ float mla_rowmaxq(const f32x16& p0, const f32x16& p1) {
    float tm = p0[0];
#pragma unroll
    for (int r = 1; r < 16; ++r) tm = fmaxf(tm, p0[r]);
#pragma unroll
    for (int r = 0; r < 16; ++r) tm = fmaxf(tm, p1[r]);
    return swapmax(tm);
}
__device__ __forceinline__ void mla_unit(LAS unsigned char* lds, const MlaPtrs& P, int head, int qb, int tid_in, int wave, int lane_in) {
    int tid = tid_in; asm volatile("" : "+v"(tid)); const int lane = tid & 63; (void)lane_in;
    const int r32 = lane & 31, hi = lane >> 5;
    const int q0 = qb * 256, qw = q0 + wave * 32, tq = qw + r32;
    i32x8 q[3];
    { const unsigned char* qp = (const unsigned char*)P.Q + (size_t)tq * 3072 + head * 192 + hi * 32;
#pragma unroll
      for (int s = 0; s < 3; ++s) { const u32x4 a = *(const GAS u32x4*)(qp + 64 * s), b = *(const GAS u32x4*)(qp + 64 * s + 16);
          q[s] = (i32x8){(int)a.x, (int)a.y, (int)a.z, (int)a.w, (int)b.x, (int)b.y, (int)b.z, (int)b.w}; } }
    const int NT = 4 * (qb + 1);
    const int srow = tid >> 3, sc8 = tid & 7;
    const unsigned char* kg = (const unsigned char*)P.K + (size_t)head * 192 + (size_t)srow * 3072 + sc8 * 8;
    const unsigned char* vg = (const unsigned char*)P.V + ((size_t)head * 128 + (tid >> 2)) * S + (tid & 3) * 16;
    LAS unsigned char* kst = lds + srow * KSX + sc8 * 8;
    LAS unsigned char* vst = lds + 2 * MLA_KBX + (tid >> 2) * VSX + (tid & 3) * 16;
    const LAS unsigned char* kl = lds + r32 * KSX + hi * 32;
    const LAS unsigned char* vl = lds + 2 * MLA_KBX + r32 * VSX + hi * 32;
    u32x2 sk0, sk1, sk2; u32x4 sv0;
#define MLA_LOADK(j) do { const unsigned char* kp_ = kg + (size_t)(j) * (64 * 3072); sk0 = *(const GAS u32x2*)(kp_); sk1 = *(const GAS u32x2*)(kp_ + 64); sk2 = *(const GAS u32x2*)(kp_ + 128); } while (0)
#define MLA_LOADV(j) do { sv0 = *(const GAS u32x4*)(vg + (size_t)(j) * 64); } while (0)
#define MLA_STOREK(b) do { LAS unsigned char* kd_ = kst + (b) * MLA_KBX; *(LAS u32x2*)(kd_) = sk0; *(LAS u32x2*)(kd_ + 64) = sk1; *(LAS u32x2*)(kd_ + 128) = sk2; } while (0)
#define MLA_STOREV(b) do { LAS unsigned char* vd_ = vst + (b) * VBQ; *(LAS u32x2*)(vd_) = (u32x2){sv0.x, sv0.y}; *(LAS u32x2*)(vd_ + 8) = (u32x2){sv0.z, sv0.w}; } while (0)
    f32x16 o[5], mref;
#pragma unroll
    for (int d = 0; d < 5; ++d)
#pragma unroll
        for (int r = 0; r < 16; ++r) o[d][r] = 0.f;
#pragma unroll
    for (int r = 0; r < 16; ++r) mref[r] = MXL_REF;
    f32x16 p0, p1;
    if (tid < 256) { const int slot = tid >> 7, row = (tid >> 2) & 31, ch = tid & 3; const unsigned v1 = (row == 0 || row == 4) ? 0x38383838u : 0u;
        *(LAS u32x4*)(lds + 2 * MLA_KBX + slot * VBQ + (128 + row) * VSX + ch * 16) = (u32x4){v1, v1, v1, v1}; }
    MLA_LOADK(0); MLA_LOADV(0); MLA_STOREK(0); MLA_STOREV(0);
    MLA_LOADK(1);
    __syncthreads();
    qk_tilexl(p0, p1, mref, kl, q);
    if (63 > qw) mla_maskq(p0, p1, tq - 4 * hi);
    { const float dlt = mla_rowmaxq(p0, p1) - MXL_REF;
#pragma unroll
      for (int r = 0; r < 16; ++r) { p0[r] -= dlt; p1[r] -= dlt; mref[r] -= dlt; } }
    i32x8 pbA = byte_packx(p0, p1), pbB = pbA;
    MLA_STOREK(1);
    if (2 < NT) MLA_LOADK(2);
    MLA_LOADV(1);
    __syncthreads();
    asm volatile("" : "+v"(q[0]), "+v"(q[1]), "+v"(q[2]));
    int sc1_ = 0x7f7f7f7f; asm volatile("" : "+v"(sc1_));
#define SB() __builtin_amdgcn_sched_barrier(0)
#define MFMA_T(acc, a, b) asm volatile("s_nop 1\n\tv_mfma_scale_f32_32x32x64_f8f6f4 %0, %1, %2, %0, %3, %3 op_sel_hi:[0,0,0]" : "+v"(acc) : "v"(a), "v"(b), "v"(sc1_))
#define MFMA_C(acc, a, b, c) asm volatile("s_nop 1\n\tv_mfma_scale_f32_32x32x64_f8f6f4 %0, %1, %2, %3, %4, %4 op_sel_hi:[0,0,0]" : "=&v"(acc) : "v"(a), "v"(b), "v"(c), "v"(sc1_))
#define CVT8(P, R0, PB, W0) do { unsigned w_ = __builtin_amdgcn_cvt_pk_u8_f32(P[(R0) + 0], 0, 0u); w_ = __builtin_amdgcn_cvt_pk_u8_f32(P[(R0) + 1], 1, w_); w_ = __builtin_amdgcn_cvt_pk_u8_f32(P[(R0) + 2], 2, w_); \
        w_ = __builtin_amdgcn_cvt_pk_u8_f32(P[(R0) + 3], 3, w_); PB[(W0)] = (int)w_; \
        w_ = __builtin_amdgcn_cvt_pk_u8_f32(P[(R0) + 4], 0, 0u); w_ = __builtin_amdgcn_cvt_pk_u8_f32(P[(R0) + 5], 1, w_); w_ = __builtin_amdgcn_cvt_pk_u8_f32(P[(R0) + 6], 2, w_); \
        w_ = __builtin_amdgcn_cvt_pk_u8_f32(P[(R0) + 7], 3, w_); PB[(W0) + 1] = (int)w_; } while (0)
#define MLA_STEP(PBX, PBY, j) do { \
        const int kb1_ = 64 * ((j) + 1); \
        if (64 * (j) <= qw + 31) { \
            const LAS unsigned char* kn_ = kl + (((j) + 1) & 1) * MLA_KBX; const LAS unsigned char* vj_ = vl + ((j) & 1) * VBQ; \
            SB(); \
            i32x8 a0_f = ldsx(kn_), a1_f = ldsx(kn_ + 32 * KSX); \
            SB(); MFMA_C(p0, a0_f, q[0], mref); SB(); \
            a0_f = ldsx(kn_ + 64); \
            SB(); MFMA_C(p1, a1_f, q[0], mref); SB(); \
            a1_f = ldsx(kn_ + 32 * KSX + 64); \
            SB(); MFMA_T(p0, a0_f, q[1]); SB(); \
            a0_f = ldsx(kn_ + 128); \
            SB(); MFMA_T(p1, a1_f, q[1]); SB(); \
            a1_f = ldsx(kn_ + 32 * KSX + 128); \
            SB(); MFMA_T(p0, a0_f, q[2]); SB(); \
            a0_f = ldsx(vj_ + 128 * VSX); \
            SB(); MFMA_T(p1, a1_f, q[2]); SB(); \
            a1_f = ldsx(vj_); \
            SB(); MFMA_T(o[4], a0_f, PBX); SB(); \
            a0_f = ldsx(vj_ + 32 * VSX); \
            SB(); MFMA_T(o[0], a1_f, PBX); SB(); \
            a1_f = ldsx(vj_ + 64 * VSX); \
            float tmx_ = p0[0]; _Pragma("unroll") for (int r_ = 1; r_ < 16; ++r_) tmx_ = fmaxf(tmx_, p0[r_]); \
            CVT8(p0, 0, PBY, 0); CVT8(p0, 8, PBY, 2); \
            SB(); MFMA_T(o[1], a0_f, PBX); SB(); \
            a0_f = ldsx(vj_ + 96 * VSX); \
            _Pragma("unroll") for (int r_ = 0; r_ < 16; ++r_) tmx_ = fmaxf(tmx_, p1[r_]); \
            CVT8(p1, 0, PBY, 4); \
            SB(); MFMA_T(o[2], a1_f, PBX); SB(); \
            CVT8(p1, 8, PBY, 6); tmx_ = swapmax(tmx_); \
            SB(); MFMA_T(o[3], a0_f, PBX); SB(); \
            const bool diag_ = kb1_ + 63 > qw; \
            if (diag_ || !__all(tmx_ <= MXL_T)) {               \
                asm volatile("s_nop 15\n\ts_nop 15\n\ts_nop 15" ::: "memory");     \
                if (diag_) mla_maskq(p0, p1, tq - kb1_ - 4 * hi); \
                const float dlt_ = fmaxf(mla_rowmaxq(p0, p1) - MXL_REF, 0.f); const float alpha_ = __builtin_amdgcn_exp2f(-0.125f * dlt_); \
                _Pragma("unroll") for (int r_ = 0; r_ < 16; ++r_) { p0[r_] -= dlt_; p1[r_] -= dlt_; mref[r_] -= dlt_; } \
                _Pragma("unroll") for (int d_ = 0; d_ < 5; ++d_) _Pragma("unroll") for (int r_ = 0; r_ < 16; ++r_) o[d_][r_] *= alpha_; \
                PBY = byte_packx(p0, p1); } \
        } \
        if ((j) + 2 < NT) MLA_STOREK((j) & 1); \
        if ((j) + 1 < NT) MLA_STOREV(((j) + 1) & 1); \
        if ((j) + 3 < NT) MLA_LOADK((j) + 3); \
        if ((j) + 2 < NT) MLA_LOADV((j) + 2); \
        __syncthreads(); } while (0)
    for (int j = 0; j < NT; j += 2) {
        MLA_STEP(pbA, pbB, j);
        MLA_STEP(pbB, pbA, j + 1);
    }
    asm volatile("s_nop 15\n\ts_nop 15" ::: "memory");
#undef MLA_STEP
#undef CVT8
#undef MFMA_T
#undef MFMA_C
#undef SB
#undef MLA_LOADK
#undef MLA_LOADV
#undef MLA_STOREK
#undef MLA_STOREV
    const float inv = 1.f / o[4][0];
    const bf16* zp = P.Z + (size_t)tq * 2048 + head * 128 + 4 * hi;
    bf16* op = P.O + (size_t)tq * 4096 + head * 128 + 4 * hi;
#pragma unroll
    for (int d0 = 0; d0 < 4; ++d0)
#pragma unroll
        for (int rg = 0; rg < 4; ++rg) { const int dim = 32 * d0 + 8 * rg;
            const u32x2 z = *(const GAS u32x2*)(zp + dim);
            u32x2 w; w.x = pk2(o[d0][4 * rg + 0] * inv * bflo(z.x), o[d0][4 * rg + 1] * inv * bfhi(z.x)); w.y = pk2(o[d0][4 * rg + 2] * inv * bflo(z.y), o[d0][4 * rg + 3] * inv * bfhi(z.y));
            *(GAS u32x2*)(op + dim) = w; }
}

#elif defined(MLA_BIGX)
struct MlaPtrs { const bf16* Q; const bf16* K; const bf16* V; const bf16* Z; bf16* O; };
__device__ __forceinline__ void mla_unit(LAS unsigned char* lds, const MlaPtrs& P, int head, int qb, int tid_in, int wave, int lane_in) {
    int tid = tid_in; asm volatile("" : "+v"(tid)); const int lane = tid & 63; (void)lane_in;
    const int r32 = lane & 31, hi = lane >> 5;
    const int q0 = qb * 256, qw = q0 + wave * 32, tq = qw + r32;
    i32x8 q[3];
    { const unsigned char* qp = (const unsigned char*)P.Q + (size_t)tq * 3072 + head * 192 + hi * 32;
#pragma unroll
      for (int s = 0; s < 3; ++s) { const u32x4 a = *(const GAS u32x4*)(qp + 64 * s), b = *(const GAS u32x4*)(qp + 64 * s + 16);
          q[s] = (i32x8){(int)a.x, (int)a.y, (int)a.z, (int)a.w, (int)b.x, (int)b.y, (int)b.z, (int)b.w}; } }
    const int NT = 4 * (qb + 1), NTB = NT / 2;
    constexpr int VSB = 144, VBB = 128 * VSB, KBB = 128 * KSX;
    static_assert(2 * KBB + 3 * VBB <= 131072, "MLA big-tile LDS map");
    const int srow = tid >> 3, sc8 = tid & 7;
    const unsigned char* kg = (const unsigned char*)P.K + (size_t)head * 192 + (size_t)srow * 3072 + sc8 * 8;
    const unsigned char* vg = (const unsigned char*)P.V + ((size_t)head * 128 + (tid >> 2)) * S + (tid & 3) * 32;
    LAS unsigned char* kst = lds + srow * KSX + sc8 * 8;
    LAS unsigned char* vst = lds + 2 * KBB + (tid >> 2) * VSB + (tid & 3) * 32;
    const LAS unsigned char* kl = lds + r32 * KSX + hi * 32;
    const LAS unsigned char* vl = lds + 2 * KBB + r32 * VSB + hi * 32;
    u32x2 sk0, sk1, sk2, sk3, sk4, sk5; u32x4 sv0, sv1;
#define MLA_LOAD(J) do { const unsigned char* kp_ = kg + (size_t)(J) * (128 * 3072); const unsigned char* vp_ = vg + (size_t)(J) * 128; \
        sk0 = *(const GAS u32x2*)(kp_); sk1 = *(const GAS u32x2*)(kp_ + 64); sk2 = *(const GAS u32x2*)(kp_ + 128); \
        sk3 = *(const GAS u32x2*)(kp_ + 64 * 3072); sk4 = *(const GAS u32x2*)(kp_ + 64 * 3072 + 64); sk5 = *(const GAS u32x2*)(kp_ + 64 * 3072 + 128); \
        sv0 = *(const GAS u32x4*)(vp_); sv1 = *(const GAS u32x4*)(vp_ + 16); } while (0)
#define MLA_STORE(b, vb) do { LAS unsigned char* kd_ = kst + (b) * KBB; LAS unsigned char* vd_ = vst + (vb) * VBB; \
        *(LAS u32x2*)(kd_) = sk0; *(LAS u32x2*)(kd_ + 64) = sk1; *(LAS u32x2*)(kd_ + 128) = sk2; \
        *(LAS u32x2*)(kd_ + 64 * KSX) = sk3; *(LAS u32x2*)(kd_ + 64 * KSX + 64) = sk4; *(LAS u32x2*)(kd_ + 64 * KSX + 128) = sk5; \
        *(LAS u32x2*)(vd_) = (u32x2){sv0.x, sv0.y}; *(LAS u32x2*)(vd_ + 8) = (u32x2){sv0.z, sv0.w}; *(LAS u32x2*)(vd_ + 16) = (u32x2){sv1.x, sv1.y}; *(LAS u32x2*)(vd_ + 24) = (u32x2){sv1.z, sv1.w}; } while (0)
    MLA_LOAD(0); MLA_STORE(0, 0);
    __syncthreads();
    asm volatile("" : "+v"(q[0]), "+v"(q[1]), "+v"(q[2]));
    f32x16 o[5], mref;
#pragma unroll
    for (int d = 0; d < 5; ++d)
#pragma unroll
        for (int r = 0; r < 16; ++r) o[d][r] = 0.f;
#pragma unroll
    for (int r = 0; r < 16; ++r) mref[r] = MXL_REF;
    const int one8 = (r32 == 0 || r32 == 4) ? 0x38383838 : 0;
    const i32x8 ones = {one8, one8, one8, one8, one8, one8, one8, one8};
    const bool trail = wave >= 4;
    i32x8 pb = {};
    int vb_cur = 0, vb_prev = 2;
    for (int J = 0; J < NTB; ++J) {
        int vb_next = vb_cur + 1; if (vb_next == 3) vb_next = 0;
        if (J + 1 < NTB) MLA_LOAD(J + 1);
#pragma unroll
        for (int sub = 0; sub < 2; ++sub) {
        const int j = 2 * J + sub, kb = 64 * j;
        if (trail && j > 0 && kb - 64 <= qw + 31) pv_tilexl<VSB>(o, pb, ones, vl + (sub == 0 ? vb_prev * VBB + 64 : vb_cur * VBB));
        if (kb <= qw + 31) {
            f32x16 p0, p1;
            qk_tilexl(p0, p1, mref, kl + (J & 1) * KBB + sub * 64 * KSX, q);
            if (kb + 63 > qw) {
                const int dq = tq - kb - 4 * hi;
#pragma unroll
                for (int r = 0; r < 16; ++r) { const int c = (r & 3) + 8 * (r >> 2);
                    if (c > dq) p0[r] = -__builtin_inff();
                    if (c + 32 > dq) p1[r] = -__builtin_inff(); }
            }
            float tm = p0[0];
#pragma unroll
            for (int r = 1; r < 16; ++r) tm = fmaxf(tm, p0[r]);
#pragma unroll
            for (int r = 0; r < 16; ++r) tm = fmaxf(tm, p1[r]);
            tm = swapmax(tm);
            if (j == 0 || !__all(tm <= MXL_T)) {
                const float dlt = (j == 0) ? tm - MXL_REF : fmaxf(tm - MXL_REF, 0.f);
                const float alpha = __builtin_amdgcn_exp2f(-0.125f * dlt);
#pragma unroll
                for (int r = 0; r < 16; ++r) { p0[r] -= dlt; p1[r] -= dlt; mref[r] -= dlt; }
                if (j > 0) {
#pragma unroll
                    for (int d = 0; d < 5; ++d)
#pragma unroll
                        for (int r = 0; r < 16; ++r) o[d][r] *= alpha;
                }
            }
            pb = byte_packx(p0, p1);
            if (!trail) pv_tilexl<VSB>(o, pb, ones, vl + vb_cur * VBB + sub * 64);
        }
        }
        if (J + 1 < NTB) MLA_STORE((J + 1) & 1, vb_next);
        __syncthreads();
        vb_prev = vb_cur; vb_cur = vb_next;
    }
    if (trail && 64 * (NT - 1) <= qw + 31) pv_tilexl<VSB>(o, pb, ones, vl + vb_prev * VBB + 64);
    __syncthreads();
#undef MLA_LOAD
#undef MLA_STORE
    const float inv = 1.f / o[4][0];
    const bf16* zp = P.Z + (size_t)tq * 2048 + head * 128 + 4 * hi;
    bf16* op = P.O + (size_t)tq * 4096 + head * 128 + 4 * hi;
#pragma unroll
    for (int d0 = 0; d0 < 4; ++d0)
#pragma unroll
        for (int rg = 0; rg < 4; ++rg) { const int dim = 32 * d0 + 8 * rg;
            const u32x2 z = *(const GAS u32x2*)(zp + dim);
            u32x2 w; w.x = pk2(o[d0][4 * rg + 0] * inv * bflo(z.x), o[d0][4 * rg + 1] * inv * bfhi(z.x)); w.y = pk2(o[d0][4 * rg + 2] * inv * bflo(z.y), o[d0][4 * rg + 3] * inv * bfhi(z.y));
            *(GAS u32x2*)(op + dim) = w; }
}

#elif defined(MLA_MXL)
struct MlaPtrs { const bf16* Q; const bf16* K; const bf16* V; const bf16* Z; bf16* O; };
__device__ __forceinline__ void mla_unit(LAS unsigned char* lds, const MlaPtrs& P, int head, int qb, int tid_in, int wave, int lane_in) {
    int tid = tid_in; asm volatile("" : "+v"(tid)); const int lane = tid & 63; (void)lane_in;
    const int r32 = lane & 31, hi = lane >> 5;
    const int q0 = qb * 256, qw = q0 + wave * 32, tq = qw + r32;
    i32x8 q[3];
    { const unsigned char* qp = (const unsigned char*)P.Q + (size_t)tq * 3072 + head * 192 + hi * 32;
#pragma unroll
      for (int s = 0; s < 3; ++s) { const u32x4 a = *(const GAS u32x4*)(qp + 64 * s), b = *(const GAS u32x4*)(qp + 64 * s + 16);
          q[s] = (i32x8){(int)a.x, (int)a.y, (int)a.z, (int)a.w, (int)b.x, (int)b.y, (int)b.z, (int)b.w}; } }
    const int NT = 4 * (qb + 1);
    const int srow = tid >> 3, sc8 = tid & 7;
    const unsigned char* kg = (const unsigned char*)P.K + (size_t)head * 192 + (size_t)srow * 3072 + sc8 * 8;
    const unsigned char* vg = (const unsigned char*)P.V + ((size_t)head * 128 + (tid >> 2)) * S + (tid & 3) * 16;
    LAS unsigned char* kst = lds + srow * KSX + sc8 * 8;
    LAS unsigned char* vst = lds + 2 * MLA_KBX + (tid >> 2) * VSX + (tid & 3) * 16;
    const LAS unsigned char* kl = lds + r32 * KSX + hi * 32;
    const LAS unsigned char* vl = lds + 2 * MLA_KBX + r32 * VSX + hi * 32;
    u32x2 sk0, sk1, sk2; u32x4 sv0;
#define MLA_LOAD(j) do { const unsigned char* kp_ = kg + (size_t)(j) * (64 * 3072); const unsigned char* vp_ = vg + (size_t)(j) * 64; \
        sk0 = *(const GAS u32x2*)(kp_); sk1 = *(const GAS u32x2*)(kp_ + 64); sk2 = *(const GAS u32x2*)(kp_ + 128); sv0 = *(const GAS u32x4*)(vp_); } while (0)
#define MLA_STORE(b, vb) do { LAS unsigned char* kd_ = kst + (b) * MLA_KBX; LAS unsigned char* vd_ = vst + (vb) * VBX; \
        *(LAS u32x2*)(kd_) = sk0; *(LAS u32x2*)(kd_ + 64) = sk1; *(LAS u32x2*)(kd_ + 128) = sk2; *(LAS u32x2*)(vd_) = (u32x2){sv0.x, sv0.y}; *(LAS u32x2*)(vd_ + 8) = (u32x2){sv0.z, sv0.w}; } while (0)
    MLA_LOAD(0); MLA_STORE(0, 0);
    __syncthreads();
    asm volatile("" : "+v"(q[0]), "+v"(q[1]), "+v"(q[2]));
    f32x16 o[5], mref;
#pragma unroll
    for (int d = 0; d < 5; ++d)
#pragma unroll
        for (int r = 0; r < 16; ++r) o[d][r] = 0.f;
#pragma unroll
    for (int r = 0; r < 16; ++r) mref[r] = MXL_REF;
    const int one8 = (r32 == 0 || r32 == 4) ? 0x38383838 : 0;
    const i32x8 ones = {one8, one8, one8, one8, one8, one8, one8, one8};
    const bool trail = wave >= 4;
    i32x8 pb = {}, fa = {}, fb = {};
    int vb_cur = 0, vb_prev = 2;
    for (int j = 0; j < NT; ++j) {
        const int kb = 64 * j;
        int vb_next = vb_cur + 1; if (vb_next == 3) vb_next = 0;
        if (j + 1 < NT) MLA_LOAD(j + 1);
        if (trail && j > 0 && kb - 64 <= qw + 31) pv_tilexl_pre(o, pb, ones, vl + vb_prev * VBX, fa, fb);
        if (kb <= qw + 31) {
            f32x16 p0, p1;
            qk_tilexl(p0, p1, mref, kl + (j & 1) * MLA_KBX, q);
            fa = ldsx(vl + vb_cur * VBX); fb = ldsx(vl + vb_cur * VBX + 32 * VSX);
            __builtin_amdgcn_sched_barrier(0);
            if (kb + 63 > qw) {
                const int dq = tq - kb - 4 * hi;
#pragma unroll
                for (int r = 0; r < 16; ++r) { const int c = (r & 3) + 8 * (r >> 2);
                    if (c > dq) p0[r] = -__builtin_inff();
                    if (c + 32 > dq) p1[r] = -__builtin_inff(); }
            }
            float tm = p0[0];
#pragma unroll
            for (int r = 1; r < 16; ++r) tm = fmaxf(tm, p0[r]);
#pragma unroll
            for (int r = 0; r < 16; ++r) tm = fmaxf(tm, p1[r]);
            tm = swapmax(tm);
            if (j == 0 || !__all(tm <= MXL_T)) {
#ifdef MLA_MXU
                const float dlt = (j == 0) ? tm - MXL_REF : fmaxf(tm - MXL_REF, 0.f);
                const float alpha = __builtin_amdgcn_exp2f(-0.125f * dlt);
#else
                const float dlt = (j == 0) ? tm : fmaxf(tm, 0.f);
                const float alpha = __builtin_amdgcn_exp2f(-dlt);
#endif
#pragma unroll
                for (int r = 0; r < 16; ++r) { p0[r] -= dlt; p1[r] -= dlt; mref[r] -= dlt; }
                if (j > 0) {
#pragma unroll
                    for (int d = 0; d < 5; ++d)
#pragma unroll
                        for (int r = 0; r < 16; ++r) o[d][r] *= alpha;
                }
            }
#ifdef MLA_MXU
            pb = byte_packx(p0, p1);
#else
            pb = exp_packx(p0, p1, one8);
#endif
            if (!trail) pv_tilexl_pre(o, pb, ones, vl + vb_cur * VBX, fa, fb);
        }
        if (j + 1 < NT) MLA_STORE((j + 1) & 1, vb_next);
        __syncthreads();
        vb_prev = vb_cur; vb_cur = vb_next;
    }
    if (trail && 64 * (NT - 1) <= qw + 31) pv_tilexl_pre(o, pb, ones, vl + vb_prev * VBX, fa, fb);
    __syncthreads();
#undef MLA_LOAD
#undef MLA_STORE
    const float inv = 1.f / o[4][0];
    const bf16* zp = P.Z + (size_t)tq * 2048 + head * 128 + 4 * hi;
    bf16* op = P.O + (size_t)tq * 4096 + head * 128 + 4 * hi;
#pragma unroll
    for (int d0 = 0; d0 < 4; ++d0)
#pragma unroll
        for (int rg = 0; rg < 4; ++rg) { const int dim = 32 * d0 + 8 * rg;
            const u32x2 z = *(const GAS u32x2*)(zp + dim);
            u32x2 w; w.x = pk2(o[d0][4 * rg + 0] * inv * bflo(z.x), o[d0][4 * rg + 1] * inv * bfhi(z.x)); w.y = pk2(o[d0][4 * rg + 2] * inv * bflo(z.y), o[d0][4 * rg + 3] * inv * bfhi(z.y));
            *(GAS u32x2*)(op + dim) = w; }
}

#elif defined(MLA_MXP)
struct MlaPtrs { const bf16* Q; const bf16* K; const bf16* V; const bf16* Z; bf16* O; };
__device__ __forceinline__ void mla_maskx(f32x16& p0, f32x16& p1, int dq) {
#pragma unroll
    for (int r = 0; r < 16; ++r) { const int c = (r & 3) + 8 * (r >> 2);
        if (c > dq) p0[r] = -__builtin_inff();
        if (c + 32 > dq) p1[r] = -__builtin_inff(); }
}
__device__ __forceinline__ float mla_rowmax(const f32x16& p0, const f32x16& p1) {
    float tm = p0[0];
#pragma unroll
    for (int r = 1; r < 16; ++r) tm = fmaxf(tm, p0[r]);
#pragma unroll
    for (int r = 0; r < 16; ++r) tm = fmaxf(tm, p1[r]);
    return swapmax(tm);
}
#define MXP_EXP8(P, R0) do { _Pragma("unroll") for (int r_ = (R0); r_ < (R0) + 8; ++r_) { P[r_] = __builtin_amdgcn_exp2f(__builtin_fmaf(P[r_], QS_MLA, mc_)); ps_ += P[r_]; } } while (0)
__device__ __forceinline__ void mla_unit(LAS unsigned char* lds, const MlaPtrs& P, int head, int qb, int tid_in, int wave, int lane_in) {
    int tid = tid_in; asm volatile("" : "+v"(tid)); const int lane = tid & 63; (void)lane_in;
    const int r32 = lane & 31, hi = lane >> 5;
    const int q0 = qb * 256, qw = q0 + wave * 32, tq = qw + r32;
    i32x8 q[3];
    { const unsigned char* qp = (const unsigned char*)P.Q + (size_t)tq * 3072 + head * 192 + hi * 32;
#pragma unroll
      for (int s = 0; s < 3; ++s) { const u32x4 a = *(const GAS u32x4*)(qp + 64 * s), b = *(const GAS u32x4*)(qp + 64 * s + 16);
          q[s] = (i32x8){(int)a.x, (int)a.y, (int)a.z, (int)a.w, (int)b.x, (int)b.y, (int)b.z, (int)b.w}; } }
    const int NT = 4 * (qb + 1);
    const int srow = tid >> 3, sc8 = tid & 7;
    const unsigned char* kg = (const unsigned char*)P.K + (size_t)head * 192 + (size_t)srow * 3072 + sc8 * 8;
    const unsigned char* vg = (const unsigned char*)P.V + ((size_t)head * 128 + (tid >> 2)) * S + (tid & 3) * 16;
    LAS unsigned char* kst = lds + srow * KSX + sc8 * 8;
    LAS unsigned char* vst = lds + 2 * MLA_KBX + (tid >> 2) * VSX + (tid & 3) * 16;
    const LAS unsigned char* kl = lds + r32 * KSX + hi * 32;
    const LAS unsigned char* vl = lds + 2 * MLA_KBX + r32 * VSX + hi * 32;
    u32x2 sk0, sk1, sk2; u32x4 sv0;
#define MLA_LOADK(j) do { const unsigned char* kp_ = kg + (size_t)(j) * (64 * 3072); sk0 = *(const GAS u32x2*)(kp_); sk1 = *(const GAS u32x2*)(kp_ + 64); sk2 = *(const GAS u32x2*)(kp_ + 128); } while (0)
#define MLA_LOADV(j) do { sv0 = *(const GAS u32x4*)(vg + (size_t)(j) * 64); } while (0)
#define MLA_STOREK(b) do { LAS unsigned char* kd_ = kst + (b) * MLA_KBX; *(LAS u32x2*)(kd_) = sk0; *(LAS u32x2*)(kd_ + 64) = sk1; *(LAS u32x2*)(kd_ + 128) = sk2; } while (0)
#define MLA_STOREV(b) do { LAS unsigned char* vd_ = vst + (b) * VBX; *(LAS u32x2*)(vd_) = (u32x2){sv0.x, sv0.y}; *(LAS u32x2*)(vd_ + 8) = (u32x2){sv0.z, sv0.w}; } while (0)
    float m = -1e30f, l = 0.f; f32x16 o[4];
#pragma unroll
    for (int d = 0; d < 4; ++d)
#pragma unroll
        for (int r = 0; r < 16; ++r) o[d][r] = 0.f;
    f32x16 pA0, pA1, pB0, pB1;
    MLA_LOADK(0); MLA_LOADV(0); MLA_STOREK(0); MLA_STOREV(0);
    MLA_LOADK(1);
    __syncthreads();
    qk_tilex(pA0, pA1, kl, q);
    if (63 > qw) mla_maskx(pA0, pA1, tq - 4 * hi);
    MLA_STOREK(1);
    if (2 < NT) MLA_LOADK(2);
    MLA_LOADV(1);
    __syncthreads();
    asm volatile("" : "+v"(q[0]), "+v"(q[1]), "+v"(q[2]));
    float tmx = mla_rowmax(pA0, pA1);
#define SB() __builtin_amdgcn_sched_barrier(0)
#define MLA_SMHEAD() const float mn_ = fmaxf(m, tmx); const float alpha_ = __builtin_amdgcn_exp2f((m - mn_) * QS_MLA); m = mn_; const float mc_ = 8.f - mn_ * QS_MLA; float ps_ = 0.f; i32x8 pb_; \
            if (!__all(alpha_ == 1.f)) { _Pragma("unroll") for (int d_ = 0; d_ < 4; ++d_) _Pragma("unroll") for (int r_ = 0; r_ < 16; ++r_) o[d_][r_] *= alpha_; }
#define MXP_EXPK(P, R0, W0) do { MXP_EXP8(P, R0); \
        int w_ = __builtin_amdgcn_cvt_pk_fp8_f32(P[(R0) + 0], P[(R0) + 1], 0, false); pb_[(W0)] = __builtin_amdgcn_cvt_pk_fp8_f32(P[(R0) + 2], P[(R0) + 3], w_, true); \
        w_ = __builtin_amdgcn_cvt_pk_fp8_f32(P[(R0) + 4], P[(R0) + 5], 0, false); pb_[(W0) + 1] = __builtin_amdgcn_cvt_pk_fp8_f32(P[(R0) + 6], P[(R0) + 7], w_, true); } while (0)
#define MLA_SMTAIL() ps_ = swapsum(ps_); l = l * alpha_ + ps_
#define MFMA_T(acc, a, b) asm volatile("s_nop 1\n\tv_mfma_scale_f32_32x32x64_f8f6f4 %0, %1, %2, %0, %3, %3 op_sel_hi:[0,0,0]" : "+v"(acc) : "v"(a), "v"(b), "v"(sc1_))
#define MFMA_Z(acc, a, b) asm volatile("s_nop 1\n\tv_mfma_scale_f32_32x32x64_f8f6f4 %0, %1, %2, 0, %3, %3 op_sel_hi:[0,0,0]" : "=&v"(acc) : "v"(a), "v"(b), "v"(sc1_))
#define MLA_STEP(PX0, PX1, PY0, PY1, j) do { \
        const int kb1_ = 64 * ((j) + 1); \
        const bool a0_ = (64 * (j) <= qw + 31); \
        const LAS unsigned char* vj_ = vl + ((j) & 1) * VBX; \
        if (a0_) {                  \
            const LAS unsigned char* kn_ = kl + (((j) + 1) & 1) * MLA_KBX; \
            MLA_SMHEAD() \
            SB(); \
            i32x8 a0_f = ldsx(kn_), a1_f = ldsx(kn_ + 64); \
            MXP_EXPK(PX0, 0, 0); MXP_EXPK(PX0, 8, 2); \
            SB(); MFMA_Z(PY0, a0_f, q[0]); SB(); \
            a0_f = ldsx(kn_ + 128); \
            MXP_EXPK(PX1, 0, 4); \
            SB(); MFMA_T(PY0, a1_f, q[1]); SB(); \
            a1_f = ldsx(kn_ + 32 * KSX); \
            MXP_EXPK(PX1, 8, 6); \
            SB(); MFMA_T(PY0, a0_f, q[2]); SB(); \
            a0_f = ldsx(kn_ + 32 * KSX + 64); \
            MLA_SMTAIL(); \
            SB(); MFMA_Z(PY1, a1_f, q[0]); SB(); \
            a1_f = ldsx(vj_); \
            SB(); MFMA_T(PY1, a0_f, q[1]); SB(); \
            a0_f = ldsx(kn_ + 32 * KSX + 128); \
            SB(); MFMA_T(o[0], a1_f, pb_); SB(); \
            a1_f = ldsx(vj_ + 32 * VSX); \
            SB(); MFMA_T(PY1, a0_f, q[2]); SB(); \
            a0_f = ldsx(vj_ + 64 * VSX); \
            SB(); MFMA_T(o[1], a1_f, pb_); SB(); \
            a1_f = ldsx(vj_ + 96 * VSX); \
            SB(); MFMA_T(o[2], a0_f, pb_); SB(); \
            SB(); MFMA_T(o[3], a1_f, pb_); SB(); \
            if (kb1_ + 63 > qw) mla_maskx(PY0, PY1, tq - kb1_ - 4 * hi); \
            tmx = mla_rowmax(PY0, PY1); \
        } \
        if ((j) + 2 < NT) MLA_STOREK((j) & 1); \
        if ((j) + 1 < NT) MLA_STOREV(((j) + 1) & 1); \
        if ((j) + 3 < NT) MLA_LOADK((j) + 3); \
        if ((j) + 2 < NT) MLA_LOADV((j) + 2); \
        __syncthreads(); } while (0)
    int sc1_ = 0x7f7f7f7f; asm volatile("" : "+v"(sc1_));
    for (int j = 0; j < NT; j += 2) {
        MLA_STEP(pA0, pA1, pB0, pB1, j);
        MLA_STEP(pB0, pB1, pA0, pA1, j + 1);
    }
    asm volatile("s_nop 15\n\ts_nop 15" ::: "memory");
#undef MLA_STEP
#undef MLA_SMHEAD
#undef MLA_SMTAIL
#undef MXP_EXPK
#undef MFMA_T
#undef MFMA_Z
#undef SB
#undef MLA_LOADK
#undef MLA_LOADV
#undef MLA_STOREK
#undef MLA_STOREV
    const float inv = 1.f / l;
    const bf16* zp = P.Z + (size_t)tq * 2048 + head * 128 + 4 * hi;
    bf16* op = P.O + (size_t)tq * 4096 + head * 128 + 4 * hi;
#pragma unroll
    for (int d0 = 0; d0 < 4; ++d0)
#pragma unroll
        for (int rg = 0; rg < 4; ++rg) { const int dim = 32 * d0 + 8 * rg;
            const u32x2 z = *(const GAS u32x2*)(zp + dim);
            u32x2 w; w.x = pk2(o[d0][4 * rg + 0] * inv * bflo(z.x), o[d0][4 * rg + 1] * inv * bfhi(z.x)); w.y = pk2(o[d0][4 * rg + 2] * inv * bflo(z.y), o[d0][4 * rg + 3] * inv * bfhi(z.y));
            *(GAS u32x2*)(op + dim) = w; }
}
#undef MXP_EXP8

#elif defined(MLA_MX)
struct MlaPtrs { const bf16* Q; const bf16* K; const bf16* V; const bf16* Z; bf16* O; };
__device__ __forceinline__ void mla_unit(LAS unsigned char* lds, const MlaPtrs& P, int head, int qb, int tid_in, int wave, int lane_in) {
    int tid = tid_in; asm volatile("" : "+v"(tid)); const int lane = tid & 63; (void)lane_in;
    const int r32 = lane & 31, hi = lane >> 5;
    const int q0 = qb * 256, qw = q0 + wave * 32, tq = qw + r32;
    i32x8 q[3];
    { const unsigned char* qp = (const unsigned char*)P.Q + (size_t)tq * 3072 + head * 192 + hi * 32;
#pragma unroll
      for (int s = 0; s < 3; ++s) { const u32x4 a = *(const GAS u32x4*)(qp + 64 * s), b = *(const GAS u32x4*)(qp + 64 * s + 16);
          q[s] = (i32x8){(int)a.x, (int)a.y, (int)a.z, (int)a.w, (int)b.x, (int)b.y, (int)b.z, (int)b.w}; } }
    const int NT = 4 * (qb + 1);
    const int srow = tid >> 3, sc8 = tid & 7;
    const unsigned char* kg = (const unsigned char*)P.K + (size_t)head * 192 + (size_t)srow * 3072 + sc8 * 8;
    const unsigned char* vg = (const unsigned char*)P.V + ((size_t)head * 128 + (tid >> 2)) * S + (tid & 3) * 16;
    LAS unsigned char* kst = lds + srow * KSX + sc8 * 8;
    LAS unsigned char* vst = lds + 2 * MLA_KBX + (tid >> 2) * VSX + (tid & 3) * 16;
    const LAS unsigned char* kl = lds + r32 * KSX + hi * 32;
    const LAS unsigned char* vl = lds + 2 * MLA_KBX + r32 * VSX + hi * 32;
    u32x2 sk0, sk1, sk2; u32x4 sv0;
#define MLA_LOAD(j) do { const unsigned char* kp_ = kg + (size_t)(j) * (64 * 3072); const unsigned char* vp_ = vg + (size_t)(j) * 64; \
        sk0 = *(const GAS u32x2*)(kp_); sk1 = *(const GAS u32x2*)(kp_ + 64); sk2 = *(const GAS u32x2*)(kp_ + 128); sv0 = *(const GAS u32x4*)(vp_); } while (0)
#define MLA_STORE(b, vb) do { LAS unsigned char* kd_ = kst + (b) * MLA_KBX; LAS unsigned char* vd_ = vst + (vb) * VBX; \
        *(LAS u32x2*)(kd_) = sk0; *(LAS u32x2*)(kd_ + 64) = sk1; *(LAS u32x2*)(kd_ + 128) = sk2; *(LAS u32x2*)(vd_) = (u32x2){sv0.x, sv0.y}; *(LAS u32x2*)(vd_ + 8) = (u32x2){sv0.z, sv0.w}; } while (0)
    MLA_LOAD(0); MLA_STORE(0, 0);
    __syncthreads();
    asm volatile("" : "+v"(q[0]), "+v"(q[1]), "+v"(q[2]));
    float m = -1e30f, l = 0.f; f32x16 o[4];
#pragma unroll
    for (int d = 0; d < 4; ++d)
#pragma unroll
        for (int r = 0; r < 16; ++r) o[d][r] = 0.f;
    const bool trail = wave >= 4;
    i32x8 pb = {};
    int vb_cur = 0, vb_prev = 2;
    for (int j = 0; j < NT; ++j) {
        const int kb = 64 * j;
        int vb_next = vb_cur + 1; if (vb_next == 3) vb_next = 0;
        if (j + 1 < NT) MLA_LOAD(j + 1);
        if (trail && j > 0 && kb - 64 <= qw + 31) pv_tilex(o, pb, vl + vb_prev * VBX);
        if (kb <= qw + 31) {
            f32x16 p0, p1;
            qk_tilex(p0, p1, kl + (j & 1) * MLA_KBX, q);
            if (kb + 63 > qw) {
                const int dq = tq - kb - 4 * hi;
#pragma unroll
                for (int r = 0; r < 16; ++r) { const int c = (r & 3) + 8 * (r >> 2);
                    if (c > dq) p0[r] = -__builtin_inff();
                    if (c + 32 > dq) p1[r] = -__builtin_inff(); }
            }
            online_sm_x(p0, p1, m, l, o, QS_MLA);
            pb = packpx(p0, p1);
            if (!trail) pv_tilex(o, pb, vl + vb_cur * VBX);
        }
        if (j + 1 < NT) MLA_STORE((j + 1) & 1, vb_next);
        __syncthreads();
        vb_prev = vb_cur; vb_cur = vb_next;
    }
    if (trail && 64 * (NT - 1) <= qw + 31) pv_tilex(o, pb, vl + vb_prev * VBX);
    __syncthreads();
#undef MLA_LOAD
#undef MLA_STORE
    const float inv = 1.f / l;
    const bf16* zp = P.Z + (size_t)tq * 2048 + head * 128 + 4 * hi;
    bf16* op = P.O + (size_t)tq * 4096 + head * 128 + 4 * hi;
#pragma unroll
    for (int d0 = 0; d0 < 4; ++d0)
#pragma unroll
        for (int rg = 0; rg < 4; ++rg) { const int dim = 32 * d0 + 8 * rg;
            const u32x2 z = *(const GAS u32x2*)(zp + dim);
            u32x2 w; w.x = pk2(o[d0][4 * rg + 0] * inv * bflo(z.x), o[d0][4 * rg + 1] * inv * bfhi(z.x)); w.y = pk2(o[d0][4 * rg + 2] * inv * bflo(z.y), o[d0][4 * rg + 3] * inv * bfhi(z.y));
            *(GAS u32x2*)(op + dim) = w; }
}

#elif defined(MLA_BIG)
struct MlaPtrs { const bf16* Q; const bf16* K; const bf16* V; const bf16* Z; bf16* O; };
__device__ __forceinline__ void mla_unit(LAS unsigned char* lds, const MlaPtrs& P, int head, int qb, int tid_in, int wave, int lane_in) {
    int tid = tid_in; asm volatile("" : "+v"(tid)); const int lane = tid & 63; (void)lane_in;
    const int r32 = lane & 31, hi = lane >> 5;
    const int q0 = qb * 256, qw = q0 + wave * 32, tq = qw + r32;
    i64 q[12];
    { const unsigned char* qp = (const unsigned char*)P.Q + (size_t)tq * 3072 + head * 192 + hi * 8;
#pragma unroll
      for (int d0 = 0; d0 < 12; ++d0) q[d0] = *(const GAS i64*)(qp + d0 * 16); }
    const int NT = 4 * (qb + 1), NTB = NT / 2;
    const int srow = tid >> 3, sc8 = tid & 7;
    const unsigned char* kg = (const unsigned char*)P.K + (size_t)head * 192 + (size_t)srow * 3072 + sc8 * 8;
    const unsigned char* vg = (const unsigned char*)P.V + ((size_t)head * 128 + (tid >> 2)) * S + (tid & 3) * 32;
    LAS unsigned char* kst = lds + srow * KS8 + sc8 * 8;
    LAS unsigned char* vst = lds + 2 * MLA_KB8B + (tid >> 2) * VS8B + (tid & 3) * 32;
    const LAS unsigned char* kl = lds + r32 * KS8 + hi * 8;
    const LAS unsigned char* vl = lds + 2 * MLA_KB8B + r32 * VS8B + hi * 8;
    u32x2 sk0, sk1, sk2, sk3, sk4, sk5; u32x4 sv0, sv1;
#define MLA_LOAD(J) do { const unsigned char* kp_ = kg + (size_t)(J) * (128 * 3072); const unsigned char* vp_ = vg + (size_t)(J) * 128; \
        sk0 = *(const GAS u32x2*)(kp_); sk1 = *(const GAS u32x2*)(kp_ + 64); sk2 = *(const GAS u32x2*)(kp_ + 128); \
        sk3 = *(const GAS u32x2*)(kp_ + 64 * 3072); sk4 = *(const GAS u32x2*)(kp_ + 64 * 3072 + 64); sk5 = *(const GAS u32x2*)(kp_ + 64 * 3072 + 128); \
        sv0 = *(const GAS u32x4*)(vp_); sv1 = *(const GAS u32x4*)(vp_ + 16); } while (0)
#define MLA_STORE(b, vb) do { LAS unsigned char* kd_ = kst + (b) * MLA_KB8B; LAS unsigned char* vd_ = vst + (vb) * VB8B; \
        *(LAS u32x2*)(kd_) = sk0; *(LAS u32x2*)(kd_ + 64) = sk1; *(LAS u32x2*)(kd_ + 128) = sk2; \
        *(LAS u32x2*)(kd_ + 64 * KS8) = sk3; *(LAS u32x2*)(kd_ + 64 * KS8 + 64) = sk4; *(LAS u32x2*)(kd_ + 64 * KS8 + 128) = sk5; \
        *(LAS u32x2*)(vd_) = (u32x2){sv0.x, sv0.y}; *(LAS u32x2*)(vd_ + 8) = (u32x2){sv0.z, sv0.w}; *(LAS u32x2*)(vd_ + 16) = (u32x2){sv1.x, sv1.y}; *(LAS u32x2*)(vd_ + 24) = (u32x2){sv1.z, sv1.w}; } while (0)
    MLA_LOAD(0); MLA_STORE(0, 0);
    __syncthreads();
    float m = -1e30f, l = 0.f; f32x16 o[4];
#pragma unroll
    for (int d = 0; d < 4; ++d)
#pragma unroll
        for (int r = 0; r < 16; ++r) o[d][r] = 0.f;
    const bool trail = wave >= 4;
    i64 pb[4] = {};
    int vb_cur = 0, vb_prev = 2;
    for (int J = 0; J < NTB; ++J) {
        int vb_next = vb_cur + 1; if (vb_next == 3) vb_next = 0;
        if (J + 1 < NTB) MLA_LOAD(J + 1);
#pragma unroll
        for (int sub = 0; sub < 2; ++sub) {
            const int j = 2 * J + sub, kb = 64 * j;
            if (trail && j > 0 && kb - 64 <= qw + 31) pv_tile8(o, pb, vl + (sub == 0 ? vb_prev * VB8B + 64 : vb_cur * VB8B));
            if (kb <= qw + 31) {
                f32x16 p0, p1;
                qk_tile8<12>(p0, p1, kl + (J & 1) * MLA_KB8B + sub * 64 * KS8, q);
                if (kb + 63 > qw) {
                    const int dq = tq - kb - 4 * hi;
#pragma unroll
                    for (int r = 0; r < 16; ++r) { const int c = (r & 3) + 8 * (r >> 2);
                        if (c > dq) p0[r] = -__builtin_inff();
                        if (c + 32 > dq) p1[r] = -__builtin_inff(); }
                }
                online_sm_scaled(p0, p1, m, l, o, QS_MLA);
                pb[0] = packp8<0>(p0); pb[1] = packp8<1>(p0); pb[2] = packp8<0>(p1); pb[3] = packp8<1>(p1);
                if (!trail) pv_tile8(o, pb, vl + vb_cur * VB8B + sub * 64);
            }
        }
        if (J + 1 < NTB) MLA_STORE((J + 1) & 1, vb_next);
        __syncthreads();
        vb_prev = vb_cur; vb_cur = vb_next;
    }
    if (trail && 64 * (NT - 1) <= qw + 31) pv_tile8(o, pb, vl + vb_prev * VB8B + 64);
    __syncthreads();
#undef MLA_LOAD
#undef MLA_STORE
    const float inv = (1.f / 256.f) / l;
    const bf16* zp = P.Z + (size_t)tq * 2048 + head * 128 + 4 * hi;
    bf16* op = P.O + (size_t)tq * 4096 + head * 128 + 4 * hi;
#pragma unroll
    for (int d0 = 0; d0 < 4; ++d0)
#pragma unroll
        for (int rg = 0; rg < 4; ++rg) { const int dim = 32 * d0 + 8 * rg;
            const u32x2 z = *(const GAS u32x2*)(zp + dim);
            u32x2 w; w.x = pk2(o[d0][4 * rg + 0] * inv * bflo(z.x), o[d0][4 * rg + 1] * inv * bfhi(z.x)); w.y = pk2(o[d0][4 * rg + 2] * inv * bflo(z.y), o[d0][4 * rg + 3] * inv * bfhi(z.y));
            *(GAS u32x2*)(op + dim) = w; }
}

#elif defined(MLA_FP8V)
struct MlaPtrs { const bf16* Q; const bf16* K; const bf16* V; const bf16* Z; bf16* O; };
__device__ __forceinline__ void mla_unit(LAS unsigned char* lds, const MlaPtrs& P, int head, int qb, int tid_in, int wave, int lane_in) {
    int tid = tid_in; asm volatile("" : "+v"(tid)); const int lane = tid & 63; (void)lane_in;
    const int r32 = lane & 31, hi = lane >> 5;
    const int q0 = qb * 256, qw = q0 + wave * 32, tq = qw + r32;
    i64 q[12];
    { const unsigned char* qp = (const unsigned char*)P.Q + (size_t)tq * 3072 + head * 192 + hi * 8;
#pragma unroll
      for (int d0 = 0; d0 < 12; ++d0) q[d0] = *(const GAS i64*)(qp + d0 * 16); }
    const int NT = 4 * (qb + 1);
    const int srow = tid >> 3, sc8 = tid & 7;
    const unsigned char* kg = (const unsigned char*)P.K + (size_t)head * 192 + (size_t)srow * 3072 + sc8 * 8;
    const unsigned char* vg = (const unsigned char*)P.V + ((size_t)head * 128 + (tid >> 2)) * S + (tid & 3) * 16;
    LAS unsigned char* kst = lds + srow * KS8 + sc8 * 8;
    LAS unsigned char* vst = lds + 2 * MLA_KB8 + (tid >> 2) * VS8 + (tid & 3) * 16;
    const LAS unsigned char* kl = lds + r32 * KS8 + hi * 8;
    const LAS unsigned char* vl = lds + 2 * MLA_KB8 + r32 * VS8 + hi * 8;
    u32x2 sk0, sk1, sk2; u32x4 sv0;
#define MLA_LOAD(j) do { const unsigned char* kp_ = kg + (size_t)(j) * (64 * 3072); const unsigned char* vp_ = vg + (size_t)(j) * 64; \
        sk0 = *(const GAS u32x2*)(kp_); sk1 = *(const GAS u32x2*)(kp_ + 64); sk2 = *(const GAS u32x2*)(kp_ + 128); sv0 = *(const GAS u32x4*)(vp_); } while (0)
#define MLA_STORE(b, vb) do { LAS unsigned char* kd_ = kst + (b) * MLA_KB8; LAS unsigned char* vd_ = vst + (vb) * VB8; \
        *(LAS u32x2*)(kd_) = sk0; *(LAS u32x2*)(kd_ + 64) = sk1; *(LAS u32x2*)(kd_ + 128) = sk2; *(LAS u32x2*)(vd_) = (u32x2){sv0.x, sv0.y}; *(LAS u32x2*)(vd_ + 8) = (u32x2){sv0.z, sv0.w}; } while (0)
    MLA_LOAD(0); MLA_STORE(0, 0);
    __syncthreads();
    float m = -1e30f, l = 0.f; f32x16 o[4];
#pragma unroll
    for (int d = 0; d < 4; ++d)
#pragma unroll
        for (int r = 0; r < 16; ++r) o[d][r] = 0.f;
    const bool trail = wave >= 4;
    i64 pb[4] = {};
    int vb_cur = 0, vb_prev = 2;
    for (int j = 0; j < NT; ++j) {
        const int kb = 64 * j;
        int vb_next = vb_cur + 1; if (vb_next == 3) vb_next = 0;
        if (j + 1 < NT) MLA_LOAD(j + 1);
        if (trail && j > 0 && kb - 64 <= qw + 31) pv_tile8(o, pb, vl + vb_prev * VB8);
        if (kb <= qw + 31) {
            f32x16 p0, p1;
#ifdef PROBE_QKM2
            { f32x16 r0, r1; qk_tile_m2<12, KS_M>(p0, p1, r0, r1, kl + (j & 1) * MLA_KB, q);
#pragma unroll
              for (int r = 0; r < 16; ++r) { p0[r] = (p0[r] + r0[r]) * 0.5f; p1[r] = (p1[r] + r1[r]) * 0.5f; } }
#else
            qk_tile8<12>(p0, p1, kl + (j & 1) * MLA_KB8, q);
#endif
#ifdef PROBE_QK2
            { f32x16 r0, r1; asm volatile("" ::: "memory"); qk_tile<12, KS_M>(r0, r1, kl + (j & 1) * MLA_KB, q);
#pragma unroll
              for (int r = 0; r < 16; ++r) { p0[r] = (p0[r] + r0[r]) * 0.5f; p1[r] = (p1[r] + r1[r]) * 0.5f; } }
#endif
#ifdef PROBE_SM2
            { float acc_ = 0.f;
#pragma unroll
              for (int r = 0; r < 16; ++r) { acc_ += __builtin_amdgcn_exp2f(p0[r] - m - 40.f) + __builtin_amdgcn_exp2f(p1[r] - m - 40.f); }
#pragma unroll
              for (int r = 0; r < 16; ++r) { acc_ += __builtin_amdgcn_exp2f(p0[r] - m - 50.f) + __builtin_amdgcn_exp2f(p1[r] - m - 50.f); }
              if (acc_ == 12345.678f) l += 1.f; }
#endif
            if (kb + 63 > qw) {
                const int dq = tq - kb - 4 * hi;
#pragma unroll
                for (int r = 0; r < 16; ++r) { const int c = (r & 3) + 8 * (r >> 2);
                    if (c > dq) p0[r] = -__builtin_inff();
                    if (c + 32 > dq) p1[r] = -__builtin_inff(); }
            }
            online_sm_scaled(p0, p1, m, l, o, QS_MLA);
            pb[0] = packp8<0>(p0); pb[1] = packp8<1>(p0); pb[2] = packp8<0>(p1); pb[3] = packp8<1>(p1);
            if (!trail) pv_tile8(o, pb, vl + vb_cur * VB8);
        }
        if (j + 1 < NT) MLA_STORE((j + 1) & 1, vb_next);
        __syncthreads();
        vb_prev = vb_cur; vb_cur = vb_next;
    }
    if (trail && 64 * (NT - 1) <= qw + 31) pv_tile8(o, pb, vl + vb_prev * VB8);
    __syncthreads();
#undef MLA_LOAD
#undef MLA_STORE
    const float inv = (1.f / 256.f) / l;
    const bf16* zp = P.Z + (size_t)tq * 2048 + head * 128 + 4 * hi;
    bf16* op = P.O + (size_t)tq * 4096 + head * 128 + 4 * hi;
#pragma unroll
    for (int d0 = 0; d0 < 4; ++d0)
#pragma unroll
        for (int rg = 0; rg < 4; ++rg) { const int dim = 32 * d0 + 8 * rg;
            const u32x2 z = *(const GAS u32x2*)(zp + dim);
            u32x2 w; w.x = pk2(o[d0][4 * rg + 0] * inv * bflo(z.x), o[d0][4 * rg + 1] * inv * bfhi(z.x)); w.y = pk2(o[d0][4 * rg + 2] * inv * bflo(z.y), o[d0][4 * rg + 3] * inv * bfhi(z.y));
            *(GAS u32x2*)(op + dim) = w; }
}

#elif defined(MLA_FP8)
struct MlaPtrs { const bf16* Q; const bf16* K; const bf16* V; const bf16* Z; bf16* O; };
__device__ __forceinline__ void mla_unit(LAS unsigned char* lds, const MlaPtrs& P, int head, int qb, int tid_in, int wave, int lane_in) {
    int tid = tid_in; asm volatile("" : "+v"(tid)); const int lane = tid & 63; (void)lane_in;
    const int r32 = lane & 31, hi = lane >> 5;
    const int q0 = qb * 256, qw = q0 + wave * 32, tq = qw + r32;
    i64 q[12];
    { const unsigned char* qp = (const unsigned char*)P.Q + (size_t)tq * 3072 + head * 192 + hi * 8;
#pragma unroll
      for (int d0 = 0; d0 < 12; ++d0) q[d0] = *(const GAS i64*)(qp + d0 * 16); }
    const int NT = 4 * (qb + 1);
    const int srow = tid >> 3, sc8 = tid & 7;
    const unsigned char* kg = (const unsigned char*)P.K + (size_t)head * 192 + (size_t)srow * 3072 + sc8 * 8;
    const unsigned char* vg = (const unsigned char*)P.V + (size_t)head * 256 + (size_t)srow * 4096 + sc8 * 16;
    LAS unsigned char* kst = lds + srow * KS8 + sc8 * 8;
    LAS unsigned char* vst = lds + 2 * MLA_KB8 + srow * VS + sc8 * 16;
    const LAS unsigned char* kl = lds + r32 * KS8 + hi * 8;
    const LAS unsigned char* vl = lds + 2 * MLA_KB8 + (4 * hi + ((lane & 15) >> 2)) * VS + (16 * ((lane >> 4) & 1) + 4 * (lane & 3)) * 2;
    u32x2 sk0, sk1, sk2; u32x4 sv0, sv1;
#define MLA_LOAD(j) do { const unsigned char* kp_ = kg + (size_t)(j) * (64 * 3072); const unsigned char* vp_ = vg + (size_t)(j) * (64 * 4096); \
        sk0 = *(const GAS u32x2*)(kp_); sk1 = *(const GAS u32x2*)(kp_ + 64); sk2 = *(const GAS u32x2*)(kp_ + 128); sv0 = *(const GAS u32x4*)(vp_); sv1 = *(const GAS u32x4*)(vp_ + 128); } while (0)
#define MLA_STORE(b, vb) do { LAS unsigned char* kd_ = kst + (b) * MLA_KB8; LAS unsigned char* vd_ = vst + (vb) * VB; \
        *(LAS u32x2*)(kd_) = sk0; *(LAS u32x2*)(kd_ + 64) = sk1; *(LAS u32x2*)(kd_ + 128) = sk2; *(LAS u32x4*)(vd_) = sv0; *(LAS u32x4*)(vd_ + 128) = sv1; } while (0)
    MLA_LOAD(0); MLA_STORE(0, 0);
    __syncthreads();
    float m = -1e30f, l = 0.f; f32x16 o[4];
#pragma unroll
    for (int d = 0; d < 4; ++d)
#pragma unroll
        for (int r = 0; r < 16; ++r) o[d][r] = 0.f;
    const bool trail = wave >= 4;
    bf16x8 pb[4] = {};
    int vb_cur = 0, vb_prev = 2;
    for (int j = 0; j < NT; ++j) {
        const int kb = 64 * j;
        int vb_next = vb_cur + 1; if (vb_next == 3) vb_next = 0;
        if (j + 1 < NT) MLA_LOAD(j + 1);
        if (trail && j > 0 && kb - 64 <= qw + 31) pv_tile(o, pb, vl + vb_prev * VB);
        if (kb <= qw + 31) {
            f32x16 p0, p1;
#ifdef PROBE_QKM2
            { f32x16 r0, r1; qk_tile_m2<12, KS_M>(p0, p1, r0, r1, kl + (j & 1) * MLA_KB, q);
#pragma unroll
              for (int r = 0; r < 16; ++r) { p0[r] = (p0[r] + r0[r]) * 0.5f; p1[r] = (p1[r] + r1[r]) * 0.5f; } }
#else
            qk_tile8<12>(p0, p1, kl + (j & 1) * MLA_KB8, q);
#endif
#ifdef PROBE_QK2
            { f32x16 r0, r1; asm volatile("" ::: "memory"); qk_tile<12, KS_M>(r0, r1, kl + (j & 1) * MLA_KB, q);
#pragma unroll
              for (int r = 0; r < 16; ++r) { p0[r] = (p0[r] + r0[r]) * 0.5f; p1[r] = (p1[r] + r1[r]) * 0.5f; } }
#endif
#ifdef PROBE_SM2
            { float acc_ = 0.f;
#pragma unroll
              for (int r = 0; r < 16; ++r) { acc_ += __builtin_amdgcn_exp2f(p0[r] - m - 40.f) + __builtin_amdgcn_exp2f(p1[r] - m - 40.f); }
#pragma unroll
              for (int r = 0; r < 16; ++r) { acc_ += __builtin_amdgcn_exp2f(p0[r] - m - 50.f) + __builtin_amdgcn_exp2f(p1[r] - m - 50.f); }
              if (acc_ == 12345.678f) l += 1.f; }
#endif
            if (kb + 63 > qw) {
                const int dq = tq - kb - 4 * hi;
#pragma unroll
                for (int r = 0; r < 16; ++r) { const int c = (r & 3) + 8 * (r >> 2);
                    if (c > dq) p0[r] = -__builtin_inff();
                    if (c + 32 > dq) p1[r] = -__builtin_inff(); }
            }
            online_sm_scaled(p0, p1, m, l, o, QS_MLA);
            pb[0] = packp<0>(p0); pb[1] = packp<1>(p0); pb[2] = packp<0>(p1); pb[3] = packp<1>(p1);
            if (!trail) pv_tile(o, pb, vl + vb_cur * VB);
        }
        if (j + 1 < NT) MLA_STORE((j + 1) & 1, vb_next);
        __syncthreads();
        vb_prev = vb_cur; vb_cur = vb_next;
    }
    if (trail && 64 * (NT - 1) <= qw + 31) pv_tile(o, pb, vl + vb_prev * VB);
    __syncthreads();
#undef MLA_LOAD
#undef MLA_STORE
    const float inv = 1.f / l;
    const bf16* zp = P.Z + (size_t)tq * 2048 + head * 128 + 4 * hi;
    bf16* op = P.O + (size_t)tq * 4096 + head * 128 + 4 * hi;
#pragma unroll
    for (int d0 = 0; d0 < 4; ++d0)
#pragma unroll
        for (int rg = 0; rg < 4; ++rg) { const int dim = 32 * d0 + 8 * rg;
            const u32x2 z = *(const GAS u32x2*)(zp + dim);
            u32x2 w; w.x = pk2(o[d0][4 * rg + 0] * inv * bflo(z.x), o[d0][4 * rg + 1] * inv * bfhi(z.x)); w.y = pk2(o[d0][4 * rg + 2] * inv * bflo(z.y), o[d0][4 * rg + 3] * inv * bfhi(z.y));
            *(GAS u32x2*)(op + dim) = w; }
}

#else
struct MlaPtrs { const bf16* Q; const bf16* K; const bf16* V; const bf16* Z; bf16* O; };
__device__ __forceinline__ void mla_unit(LAS unsigned char* lds, const MlaPtrs& P, int head, int qb, int tid_in, int wave, int lane_in) {
    int tid = tid_in; asm volatile("" : "+v"(tid)); const int lane = tid & 63; (void)lane_in;
    const int r32 = lane & 31, hi = lane >> 5;
    const int q0 = qb * 256, qw = q0 + wave * 32, tq = qw + r32;
    bf16x8 q[12];
    { const bf16* qp = P.Q + (size_t)tq * 3072 + head * 192 + hi * 8;
#pragma unroll
      for (int d0 = 0; d0 < 12; ++d0) q[d0] = *(const GAS bf16x8*)(qp + d0 * 16); }
    const int NT = 4 * (qb + 1);
    const int srow = tid >> 3, sc8 = tid & 7;
    const unsigned char* kg = (const unsigned char*)P.K + (size_t)head * 384 + (size_t)srow * 6144 + sc8 * 16;
    const unsigned char* vg = (const unsigned char*)P.V + (size_t)head * 256 + (size_t)srow * 4096 + sc8 * 16;
    LAS unsigned char* kst = lds + srow * KS_M + sc8 * 16;
    LAS unsigned char* vst = lds + 2 * MLA_KB + srow * VS + sc8 * 16;
    const LAS unsigned char* kl = lds + r32 * KS_M + hi * 16;
    const LAS unsigned char* vl = lds + 2 * MLA_KB + (4 * hi + ((lane & 15) >> 2)) * VS + (16 * ((lane >> 4) & 1) + 4 * (lane & 3)) * 2;
    u32x4 sk0, sk1, sk2, sv0, sv1;
#define MLA_LOAD(j) do { const unsigned char* kp_ = kg + (size_t)(j) * (64 * 6144); const unsigned char* vp_ = vg + (size_t)(j) * (64 * 4096); \
        sk0 = *(const GAS u32x4*)(kp_); sk1 = *(const GAS u32x4*)(kp_ + 128); sk2 = *(const GAS u32x4*)(kp_ + 256); sv0 = *(const GAS u32x4*)(vp_); sv1 = *(const GAS u32x4*)(vp_ + 128); } while (0)
#define MLA_STORE(b, vb) do { LAS unsigned char* kd_ = kst + (b) * MLA_KB; LAS unsigned char* vd_ = vst + (vb) * VB; \
        *(LAS u32x4*)(kd_) = sk0; *(LAS u32x4*)(kd_ + 128) = sk1; *(LAS u32x4*)(kd_ + 256) = sk2; *(LAS u32x4*)(vd_) = sv0; *(LAS u32x4*)(vd_ + 128) = sv1; } while (0)
    MLA_LOAD(0); MLA_STORE(0, 0);
    __syncthreads();
    float m = -1e30f, l = 0.f; f32x16 o[4];
#pragma unroll
    for (int d = 0; d < 4; ++d)
#pragma unroll
        for (int r = 0; r < 16; ++r) o[d][r] = 0.f;
    const bool trail = wave >= 4;
    bf16x8 pb[4] = {};
    int vb_cur = 0, vb_prev = 2;
    for (int j = 0; j < NT; ++j) {
        const int kb = 64 * j;
        int vb_next = vb_cur + 1; if (vb_next == 3) vb_next = 0;
        if (j + 1 < NT) MLA_LOAD(j + 1);
        if (trail && j > 0 && kb - 64 <= qw + 31) pv_tile(o, pb, vl + vb_prev * VB);
        if (kb <= qw + 31) {
            f32x16 p0, p1;
#ifdef PROBE_QKM2
            { f32x16 r0, r1; qk_tile_m2<12, KS_M>(p0, p1, r0, r1, kl + (j & 1) * MLA_KB, q);
#pragma unroll
              for (int r = 0; r < 16; ++r) { p0[r] = (p0[r] + r0[r]) * 0.5f; p1[r] = (p1[r] + r1[r]) * 0.5f; } }
#else
            qk_tile<12, KS_M>(p0, p1, kl + (j & 1) * MLA_KB, q);
#endif
#ifdef PROBE_QK2
            { f32x16 r0, r1; asm volatile("" ::: "memory"); qk_tile<12, KS_M>(r0, r1, kl + (j & 1) * MLA_KB, q);
#pragma unroll
              for (int r = 0; r < 16; ++r) { p0[r] = (p0[r] + r0[r]) * 0.5f; p1[r] = (p1[r] + r1[r]) * 0.5f; } }
#endif
#ifdef PROBE_SM2
            { float acc_ = 0.f;
#pragma unroll
              for (int r = 0; r < 16; ++r) { acc_ += __builtin_amdgcn_exp2f(p0[r] - m - 40.f) + __builtin_amdgcn_exp2f(p1[r] - m - 40.f); }
#pragma unroll
              for (int r = 0; r < 16; ++r) { acc_ += __builtin_amdgcn_exp2f(p0[r] - m - 50.f) + __builtin_amdgcn_exp2f(p1[r] - m - 50.f); }
              if (acc_ == 12345.678f) l += 1.f; }
#endif
            if (kb + 63 > qw) {
                const int dq = tq - kb - 4 * hi;
#pragma unroll
                for (int r = 0; r < 16; ++r) { const int c = (r & 3) + 8 * (r >> 2);
                    if (c > dq) p0[r] = -__builtin_inff();
                    if (c + 32 > dq) p1[r] = -__builtin_inff(); }
            }
            online_sm(p0, p1, m, l, o);
            pb[0] = packp<0>(p0); pb[1] = packp<1>(p0); pb[2] = packp<0>(p1); pb[3] = packp<1>(p1);
            if (!trail) pv_tile(o, pb, vl + vb_cur * VB);
        }
        if (j + 1 < NT) MLA_STORE((j + 1) & 1, vb_next);
        __syncthreads();
        vb_prev = vb_cur; vb_cur = vb_next;
    }
    if (trail && 64 * (NT - 1) <= qw + 31) pv_tile(o, pb, vl + vb_prev * VB);
    __syncthreads();
#undef MLA_LOAD
#undef MLA_STORE
    const float inv = 1.f / l;
    const bf16* zp = P.Z + (size_t)tq * 2048 + head * 128 + 4 * hi;
    bf16* op = P.O + (size_t)tq * 4096 + head * 128 + 4 * hi;
#pragma unroll
    for (int d0 = 0; d0 < 4; ++d0)
#pragma unroll
        for (int rg = 0; rg < 4; ++rg) { const int dim = 32 * d0 + 8 * rg;
            const u32x2 z = *(const GAS u32x2*)(zp + dim);
            u32x2 w; w.x = pk2(o[d0][4 * rg + 0] * inv * bflo(z.x), o[d0][4 * rg + 1] * inv * bfhi(z.x)); w.y = pk2(o[d0][4 * rg + 2] * inv * bflo(z.y), o[d0][4 * rg + 3] * inv * bfhi(z.y));
            *(GAS u32x2*)(op + dim) = w; }
}

#endif
#endif
struct NsaPtrs { const bf16* Q; const bf16* KV; const bf16* KC; const bf16* VC; const bf16* Z; const float* G; bf16* O; float* scr; };
template <int MODE>
__device__ __forceinline__ void nsa_loop(LAS unsigned char* lds, const unsigned char* kbase, const unsigned char* vbase, int ntiles, int jlo,
                                         const bf16x8 (&q)[8], int t, float slope2, float& m, float& l, f32x16 (&o)[4], float invl, int tid, int wave, int lane) {
    constexpr bool HASV = MODE != 0;
    const int r32 = lane & 31, hi = lane >> 5;
    const int srow = tid >> 3, sc8 = tid & 7;
    const unsigned soff = srow * 256 + sc8 * 16;
    LAS unsigned char* kst = lds + srow * KS_N + sc8 * 16;
    LAS unsigned char* vst = lds + 2 * NSA_KB + srow * VS + sc8 * 16;
    const LAS unsigned char* kl = lds + r32 * KS_N + hi * 16;
    const LAS unsigned char* vl = lds + 2 * NSA_KB + (4 * hi + ((lane & 15) >> 2)) * VS + (16 * ((lane >> 4) & 1) + 4 * (lane & 3)) * 2;
    const LAS int* ulist = (const LAS int*)(lds + N_ULIST);
    const LAS unsigned* selm = (const LAS unsigned*)(lds + N_SELM);
    LAS float* partA = (LAS float*)(lds + N_PART); LAS float* partB = (LAS float*)(lds + N_PART + N_PARTB);
    LAS float* imp = (LAS float*)(lds + N_IMP); LAS float* carry = (LAS float*)(lds + N_CARRY);
    if (ntiles <= 0) return;
    const float mlg = (MODE == 1) ? (invl > 0.f ? m - __builtin_amdgcn_logf(invl) : __builtin_inff()) : 0.f;
    u32x4 sk0, sk1, sv0, sv1;
#define NSA_TROW(j) (MODE == 2 ? 64 * __builtin_amdgcn_readfirstlane(ulist[ntiles - 1 - (j)]) : ((MODE == 3 || MODE == 0) ? 64 * (jlo + ntiles - 1 - (j)) : 64 * (jlo + (j))))
#define NSA_LOAD(j) do { const size_t ro_ = (size_t)NSA_TROW(j) * 256 + soff; \
        sk0 = *(const GAS u32x4*)(kbase + ro_); sk1 = *(const GAS u32x4*)(kbase + ro_ + 128); \
        if (HASV) { sv0 = *(const GAS u32x4*)(vbase + ro_); sv1 = *(const GAS u32x4*)(vbase + ro_ + 128); } } while (0)
#define NSA_STORE(b) do { LAS unsigned char* kd_ = kst + (b) * NSA_KB; *(LAS u32x4*)(kd_) = sk0; *(LAS u32x4*)(kd_ + 128) = sk1; \
        if (HASV) { LAS unsigned char* vd_ = vst + (b) * VB; *(LAS u32x4*)(vd_) = sv0; *(LAS u32x4*)(vd_ + 128) = sv1; } } while (0)
    NSA_LOAD(0); NSA_STORE(0);
    __syncthreads();
    for (int j = 0; j < ntiles; ++j) {
        const int buf = j & 1;
        if (MODE != 1 && j + 1 < ntiles) NSA_LOAD(j + 1);
        const int trow = NSA_TROW(j);
        constexpr int PSTEP = (MODE <= 1) ? 16 : 1;
        const int pstart = (MODE <= 1) ? 16 * trow + 31 : trow;
        const int db = t - pstart - PSTEP * 4 * hi;
        constexpr unsigned W = (MODE == 3) ? 512u : 0x7fffffffu;
        const bool mset = m > -1e29f;
        float b0 = -slope2 * (float)db - ((MODE != 1) ? (mset ? m : 0.f) : mlg);
        if (MODE == 2) { const int b = trow >> 6; if (((selm[r32 * 8 + (b >> 5)] >> (b & 31)) & 1u) == 0u) b0 = -__builtin_inff(); }
        f32x16 p0, p1;
#pragma unroll
        for (int r = 0; r < 16; ++r) { const int c = PSTEP * ((r & 3) + 8 * (r >> 2));
            p0[r] = __builtin_fmaf(slope2, (float)c, b0); p1[r] = __builtin_fmaf(slope2, (float)(c + 32 * PSTEP), b0); }
        qk_tile<8, KS_N, false>(p0, p1, kl + buf * NSA_KB, q);
        { const int t0u = __builtin_amdgcn_readfirstlane(t - r32);
          const bool interior = (t0u - (pstart + PSTEP * 63) >= 0) && ((unsigned)(t0u + 31 - pstart) < W);
          if (!interior) {
#pragma unroll
              for (int r = 0; r < 16; ++r) { const int c = PSTEP * ((r & 3) + 8 * (r >> 2));
                  if ((unsigned)(db - c) >= W) p0[r] = -__builtin_inff();
                  if ((unsigned)(db - c - 32 * PSTEP) >= W) p1[r] = -__builtin_inff(); } } }
        if (MODE == 0) {
            float tm = p0[0];
#pragma unroll
            for (int r = 1; r < 16; ++r) tm = fmaxf(tm, p0[r]);
#pragma unroll
            for (int r = 0; r < 16; ++r) tm = fmaxf(tm, p1[r]);
            tm = swapmax(tm);
            const bool need = mset ? (tm > 16.f) : (tm > -1e29f);
            if (!__all(!need)) {
                const float dlt = need ? tm : 0.f;
                if (mset) l *= __builtin_amdgcn_exp2f(-dlt);
                if (need) m = (mset ? m : 0.f) + dlt;
#pragma unroll
                for (int r = 0; r < 16; ++r) { p0[r] -= dlt; p1[r] -= dlt; }
            }
            float ps = 0.f;
#pragma unroll
            for (int r = 0; r < 16; ++r) ps += __builtin_amdgcn_exp2f(p0[r]) + __builtin_amdgcn_exp2f(p1[r]);
            l += swapsum(ps);
        } else if (MODE == 1) {
#pragma unroll
            for (int r = 0; r < 16; ++r) { p0[r] = __builtin_amdgcn_exp2f(p0[r]); p1[r] = __builtin_amdgcn_exp2f(p1[r]); }
            LAS float* pa = partA + (wave * 32 + r32) * 17 + hi; LAS float* pbm = partB + (wave * 32 + r32) * 17 + hi;
#pragma unroll
            for (int rg = 0; rg < 4; ++rg) {
                pa[2 * rg] = (p0[4 * rg] + p0[4 * rg + 1]) + (p0[4 * rg + 2] + p0[4 * rg + 3]); pbm[2 * rg] = p0[4 * rg + 3];
                pa[8 + 2 * rg] = (p1[4 * rg] + p1[4 * rg + 1]) + (p1[4 * rg + 2] + p1[4 * rg + 3]); pbm[8 + 2 * rg] = p1[4 * rg + 3]; }
            const bf16x8 pb[4] = {packp<0>(p0), packp<1>(p0), packp<0>(p1), packp<1>(p1)};
            pv_tile(o, pb, vl + buf * VB);
            __syncthreads();
            { const int qq = tid >> 4, jl = tid & 15; float a = 0.f, bp = 0.f, bl = 0.f;
#pragma unroll
              for (int w = 0; w < 8; ++w) { a += partA[(w * 32 + qq) * 17 + jl]; bl += partB[(w * 32 + qq) * 17 + jl]; }
              if (jl > 0) {
#pragma unroll
                  for (int w = 0; w < 8; ++w) bp += partB[(w * 32 + qq) * 17 + jl - 1];
              } else bp = (j > 0) ? carry[((j - 1) & 1) * 32 + qq] : 0.f;
              imp[qq * 256 + 16 * j + jl] = a + bp;
              if (jl == 15) carry[(j & 1) * 32 + qq] = bl; }
        } else {
            constexpr float NSA_LAZY_T = 16.f;
            float tm = p0[0];
#pragma unroll
            for (int r = 1; r < 16; ++r) tm = fmaxf(tm, p0[r]);
#pragma unroll
            for (int r = 0; r < 16; ++r) tm = fmaxf(tm, p1[r]);
            tm = swapmax(tm);
            const bool need = mset ? (tm > NSA_LAZY_T) : (tm > -1e29f);
            if (!__all(!need)) {
                const float dlt = need ? tm : 0.f;
                const float alpha = mset ? __builtin_amdgcn_exp2f(-dlt) : 1.f;
                if (need) m = (mset ? m : 0.f) + dlt;
#pragma unroll
                for (int r = 0; r < 16; ++r) { p0[r] -= dlt; p1[r] -= dlt; }
                l *= alpha;
#pragma unroll
                for (int d_ = 0; d_ < 4; ++d_)
#pragma unroll
                    for (int r = 0; r < 16; ++r) o[d_][r] *= alpha;
            }
            float ps = 0.f;
#pragma unroll
            for (int r = 0; r < 16; ++r) { p0[r] = __builtin_amdgcn_exp2f(p0[r]); ps += p0[r]; }
#pragma unroll
            for (int r = 0; r < 16; ++r) { p1[r] = __builtin_amdgcn_exp2f(p1[r]); ps += p1[r]; }
            l += swapsum(ps);
            const bf16x8 pb[4] = {packp<0>(p0), packp<1>(p0), packp<0>(p1), packp<1>(p1)};
            pv_tile(o, pb, vl + buf * VB);
        }
        if (MODE == 1 && j + 1 < ntiles) NSA_LOAD(j + 1);
        if (j + 1 < ntiles) NSA_STORE(buf ^ 1);
        __syncthreads();
    }
#undef NSA_TROW
#undef NSA_LOAD
#undef NSA_STORE
}
__device__ __forceinline__ void nsa_topk(const LAS float* improw, LAS unsigned* selrow, int cur, int lane) {
    unsigned key[4]; bool sel[4];
    int nforced = 0;
#pragma unroll
    for (int k = 0; k < 4; ++k) { const int j = lane + 64 * k;
        const bool forced = (j == 0) || (j == cur) || (j == cur - 1);
        const bool causal = j <= cur;
        sel[k] = forced;
#ifdef IMPNOISE_BUILD
        { unsigned h = (unsigned)j * 2654435761u + (unsigned)(size_t)improw * 40503u; h ^= h >> 15; h *= 0x846ca68bu; h ^= h >> 16;
          const float r = (float)(int)(h & 0xffffu) * (1.f / 32768.f) - 1.f; const float v = improw[j] * (1.f + IMPNOISE_EPS * r);
          key[k] = (causal && !forced) ? (__float_as_uint(v) + 1u) : 0u; }
#else
        key[k] = (causal && !forced) ? (__float_as_uint(improw[j]) + 1u) : 0u;
#endif
    }
    nforced = 1 + (cur >= 1 ? 1 : 0) + (cur >= 2 ? 1 : 0);
    const int want = 16 - nforced;
    for (int it = 0; it < want; ++it) {
        unsigned bk = key[0]; int bj = lane;
#pragma unroll
        for (int k = 1; k < 4; ++k) { if (key[k] > bk) { bk = key[k]; bj = lane + 64 * k; } }
        unsigned long long best = ((unsigned long long)bk << 32) | (unsigned)(0xffffffffu - (unsigned)bj);
#pragma unroll
        for (int off = 1; off < 64; off <<= 1) {
            const unsigned lo = __shfl_xor((unsigned)best, off), hiw = __shfl_xor((unsigned)(best >> 32), off);
            const unsigned long long other = ((unsigned long long)hiw << 32) | lo;
            best = other > best ? other : best; }
        if ((unsigned)(best >> 32) == 0u) break;
        const int wj = (int)(0xffffffffu - (unsigned)best);
#pragma unroll
        for (int k = 0; k < 4; ++k) if (wj == lane + 64 * k) { key[k] = 0u; sel[k] = true; }
    }
#pragma unroll
    for (int k = 0; k < 4; ++k) { const unsigned long long bm = __ballot(sel[k]);
        if (lane == 0) { selrow[2 * k] = (unsigned)bm; selrow[2 * k + 1] = (unsigned)(bm >> 32); } }
}
__device__ __forceinline__ void nsa_topk4(const LAS float* imp0, LAS unsigned* sel0, int cur, int lane) {
    unsigned key[4][4]; bool forced[4];
#pragma unroll
    for (int k = 0; k < 4; ++k) { const int j = lane + 64 * k;
        forced[k] = (j == 0) || (j == cur) || (j == cur - 1);
        const bool cand = (j <= cur) && !forced[k];
#pragma unroll
        for (int i = 0; i < 4; ++i) key[i][k] = cand ? (__float_as_uint(imp0[i * 256 + j]) + 1u) : 0u; }
    const int want = 16 - (1 + (cur >= 1 ? 1 : 0) + (cur >= 2 ? 1 : 0));
    unsigned T[4] = {0u, 0u, 0u, 0u};
    for (int bit = 30; bit >= 0; --bit) {
#pragma unroll
        for (int i = 0; i < 4; ++i) { const unsigned c = T[i] | (1u << bit);
            const int n = __builtin_popcountll(__ballot(key[i][0] >= c)) + __builtin_popcountll(__ballot(key[i][1] >= c)) + __builtin_popcountll(__ballot(key[i][2] >= c)) + __builtin_popcountll(__ballot(key[i][3] >= c));
            if (n >= want) T[i] = c; }
    }
#pragma unroll
    for (int i = 0; i < 4; ++i) {
        const unsigned Ti = T[i];
        int rem = want;
        if (Ti != 0u) rem -= __builtin_popcountll(__ballot(key[i][0] > Ti)) + __builtin_popcountll(__ballot(key[i][1] > Ti)) + __builtin_popcountll(__ballot(key[i][2] > Ti)) + __builtin_popcountll(__ballot(key[i][3] > Ti));
#pragma unroll
        for (int k = 0; k < 4; ++k) {
            bool s = forced[k];
            if (Ti == 0u) s = s || key[i][k] >= 1u;
            else {
                const bool eq = key[i][k] == Ti; const unsigned long long em = __ballot(eq);
                const int below = (int)__builtin_amdgcn_mbcnt_hi((unsigned)(em >> 32), __builtin_amdgcn_mbcnt_lo((unsigned)em, 0u));
                s = s || key[i][k] > Ti || (eq && below < rem);
                rem -= __builtin_popcountll(em); if (rem < 0) rem = 0;
            }
            const unsigned long long bm = __ballot(s);
            if (lane == 0) { sel0[i * 8 + 2 * k] = (unsigned)bm; sel0[i * 8 + 2 * k + 1] = (unsigned)(bm >> 32); }
        }
    }
}
__device__ __forceinline__ int nsa_opaque(int v) { asm volatile("" : "+v"(v)); return v; }
__device__ __forceinline__ void nsa_unit(LAS unsigned char* lds, const NsaPtrs& P, int g, int qblk, int tid_in, int wave, int lane_in, int cu) {
    int tid = tid_in; asm volatile("" : "+v"(tid));
    const int lane = tid & 63; (void)lane_in;
    const int r32 = lane & 31, hi = lane >> 5;
    const int hh = 8 * g + wave, t0 = 32 * qblk, t = t0 + r32;
    const float slope2 = __builtin_amdgcn_exp2f(-0.5f * (float)(hh + 1)) * LOG2E;
    bf16x8 q[8];
    { const bf16* qp = P.Q + (size_t)t * 2048 + hh * 128 + hi * 8;
#pragma unroll
      for (int d0 = 0; d0 < 8; ++d0) q[d0] = *(const GAS bf16x8*)(qp + d0 * 16); }
#define NSA_SCR() ((GAS f32x4*)(P.scr + ((size_t)(cu * 8 + wave) * 16) * 256) + nsa_opaque(lane))
    const size_t CH = (size_t)S * 128 * 2;
    f32x16 o[4]; float m, l;
#define NSA_ZERO_O() do { _Pragma("unroll") for (int d_ = 0; d_ < 4; ++d_) _Pragma("unroll") for (int r_ = 0; r_ < 16; ++r_) o[d_][r_] = 0.f; } while (0)
    const int ncv = 2 * qblk + 1, ntc = (ncv + 63) >> 6;
    const unsigned char* kc = (const unsigned char*)P.KC + (size_t)g * 1024 * 256; const unsigned char* vc = (const unsigned char*)P.VC + (size_t)g * 1024 * 256;
    m = -1e30f; l = 0.f; NSA_ZERO_O();
    nsa_loop<0>(lds, kc, vc, ntc, 0, q, t, slope2, m, l, o, 0.f, tid, wave, lane);
    const float invl = l > 0.f ? 1.f / l : 0.f;
    nsa_loop<1>(lds, kc, vc, ntc, 0, q, t, slope2, m, l, o, invl, tid, wave, lane);
    { const float g_c = P.G[(size_t)t * 48 + hh]; GAS f32x4* scr = NSA_SCR();
#pragma unroll
    for (int d0 = 0; d0 < 4; ++d0)
#pragma unroll
        for (int rg = 0; rg < 4; ++rg) { f32x4 v = {o[d0][4 * rg] * g_c, o[d0][4 * rg + 1] * g_c, o[d0][4 * rg + 2] * g_c, o[d0][4 * rg + 3] * g_c}; scr[(d0 * 4 + rg) * 64] = v; } }
    const int cur = t0 >> 6;
    LAS unsigned* selm = (LAS unsigned*)(lds + N_SELM);
#ifdef NSA_TOPK_ITER
    for (int i = 0; i < 4; ++i) { const int qq = 4 * wave + i; nsa_topk((const LAS float*)(lds + N_IMP) + qq * 256, selm + qq * 8, cur, lane); }
#else
    nsa_topk4((const LAS float*)(lds + N_IMP) + 4 * wave * 256, selm + 4 * wave * 8, cur, lane);
#endif
    __syncthreads();
    if (wave == 0) {
        LAS int* ulist = (LAS int*)(lds + N_ULIST); int n = 0;
        for (int k = 0; k < 8; ++k) { unsigned u = (lane < 32) ? selm[lane * 8 + k] : 0u;
#pragma unroll
            for (int off = 1; off < 32; off <<= 1) u |= __shfl_xor(u, off);
            u = __builtin_amdgcn_readfirstlane(u);
            while (u) { const int b = __builtin_ctz(u); u &= u - 1u; if (lane == 0) ulist[n] = 32 * k + b; ++n; } }
        if (lane == 0) *(LAS int*)(lds + N_NTS) = n;
    }
    __syncthreads();
    const int nts = __builtin_amdgcn_readfirstlane(*(const LAS int*)(lds + N_NTS));
    m = -1e30f; l = 0.f; NSA_ZERO_O();
    nsa_loop<2>(lds, (const unsigned char*)P.KV + (size_t)(4 + g) * CH, (const unsigned char*)P.KV + (size_t)(6 + g) * CH, nts, 0, q, t, slope2, m, l, o, 0.f, tid, wave, lane);
    { const float f = P.G[(size_t)t * 48 + 16 + hh] / l; GAS f32x4* scr = NSA_SCR();
#pragma unroll
      for (int d0 = 0; d0 < 4; ++d0)
          { f32x4 v[4];
#pragma unroll
            for (int rg = 0; rg < 4; ++rg) v[rg] = scr[(d0 * 4 + rg) * 64];
#pragma unroll
            for (int rg = 0; rg < 4; ++rg) { v[rg][0] += o[d0][4 * rg] * f; v[rg][1] += o[d0][4 * rg + 1] * f; v[rg][2] += o[d0][4 * rg + 2] * f; v[rg][3] += o[d0][4 * rg + 3] * f; scr[(d0 * 4 + rg) * 64] = v[rg]; } } }
    const int jlo = (t0 > 511 ? t0 - 511 : 0) >> 6, jhi = (t0 + 31) >> 6;
    m = -1e30f; l = 0.f; NSA_ZERO_O();
    nsa_loop<3>(lds, (const unsigned char*)P.KV + (size_t)(8 + g) * CH, (const unsigned char*)P.KV + (size_t)(10 + g) * CH, jhi - jlo + 1, jlo, q, t, slope2, m, l, o, 0.f, tid, wave, lane);
    { const float f = P.G[(size_t)t * 48 + 32 + hh] / l; GAS f32x4* scr = NSA_SCR();
      const bf16* zp = P.Z + (size_t)t * 2048 + hh * 128 + 4 * hi;
      bf16* op = P.O + (size_t)t * 4096 + 2048 + hh * 128 + 4 * hi;
#pragma unroll
      for (int d0 = 0; d0 < 4; ++d0)
          { f32x4 av[4]; u32x2 zv[4];
#pragma unroll
            for (int rg = 0; rg < 4; ++rg) { av[rg] = scr[(d0 * 4 + rg) * 64]; zv[rg] = *(const GAS u32x2*)(zp + 32 * d0 + 8 * rg); }
#pragma unroll
          for (int rg = 0; rg < 4; ++rg) { const int dim = 32 * d0 + 8 * rg; const f32x4 a = av[rg];
              const u32x2 z = zv[rg];
              u32x2 w; w.x = pk2((a[0] + o[d0][4 * rg] * f) * bflo(z.x), (a[1] + o[d0][4 * rg + 1] * f) * bfhi(z.x)); w.y = pk2((a[2] + o[d0][4 * rg + 2] * f) * bflo(z.y), (a[3] + o[d0][4 * rg + 3] * f) * bfhi(z.y));
              *(GAS u32x2*)(op + dim) = w; } } }
#undef NSA_ZERO_O
#undef NSA_SCR
}
struct CmpPtrs { const bf16* KV; const bf16* W1; const bf16* W2; const float* cbp; bf16* KC; bf16* VC; };
__device__ __forceinline__ void cmp_unit(LAS unsigned char* lds, const CmpPtrs& P, int kv, int g, int tile, int tid, int wave, int lane) {
    const int fr = lane & 15, fq = lane >> 4;
    constexpr int CRS = 544;
    LAS unsigned char* As = lds + 16384;
    LAS unsigned char* Ws = As + 16 * CRS;
    const unsigned char* Ag = (const unsigned char*)(P.KV + (size_t)(kv * 2 + g) * ((size_t)S * 128) + (size_t)(16 * tile + (tid >> 5)) * 2048) + (tid & 31) * 16;
    const unsigned char* Wg = (const unsigned char*)(P.W1 + (size_t)kv * 128 * 4096 + (size_t)(tid >> 5) * 4096) + (tid & 31) * 16;
    LAS unsigned char* Ad = As + (tid >> 5) * CRS + (tid & 31) * 16;
    LAS unsigned char* Wd = Ws + (tid >> 5) * CRS + (tid & 31) * 16;
    const LAS unsigned char* Ar = As + fr * CRS + fq * 16;
    const LAS unsigned char* Wr = Ws + (16 * wave + fr) * CRS + fq * 16;
    u32x4 ra, rw[8];
#define CMP_LOAD(c) do { ra = *(const GAS u32x4*)(Ag + (c) * 512); _Pragma("unroll") for (int i_ = 0; i_ < 8; ++i_) rw[i_] = *(const GAS u32x4*)(Wg + (size_t)i_ * (16 * 8192) + (c) * 512); } while (0)
    CMP_LOAD(0);
    f32x4 acc = {0.f, 0.f, 0.f, 0.f};
    for (int c = 0; c < 16; ++c) {
        *(LAS u32x4*)Ad = ra;
#pragma unroll
        for (int i = 0; i < 8; ++i) *(LAS u32x4*)(Wd + i * 16 * CRS) = rw[i];
        __syncthreads();
        if (c + 1 < 16) CMP_LOAD(c + 1);
#pragma unroll
        for (int s = 0; s < 8; ++s) {
            const bf16x8 a = *(const LAS bf16x8*)(Ar + 64 * s), b = *(const LAS bf16x8*)(Wr + 64 * s);
            acc = __builtin_amdgcn_mfma_f32_16x16x32_bf16(a, b, acc, 0, 0, 0);
        }
        __syncthreads();
    }
#undef CMP_LOAD
    float bias = 0.f;
    { float bv[16];
#pragma unroll
      for (int c = 0; c < 16; ++c) bv[c] = *(const GAS float*)(P.cbp + (size_t)(kv * 16 + c) * 128 + 16 * wave + fr);
#pragma unroll
      for (int c = 0; c < 16; ++c) bias += bv[c]; }
    LAS bf16* hid = (LAS bf16*)lds;
#pragma unroll
    for (int i = 0; i < 4; ++i) hid[(4 * fq + i) * 136 + 16 * wave + fr] = (bf16)(pk2(silu_f(acc[i] + bias), 0.f) & 0xffffu);
    __syncthreads();
    const bf16* B2 = P.W2 + (size_t)kv * 128 * 128 + (size_t)(16 * wave + fr) * 128 + 8 * fq;
    f32x4 acc2 = {0.f, 0.f, 0.f, 0.f};
#pragma unroll
    for (int s = 0; s < 4; ++s) {
        const bf16x8 a = *(const LAS bf16x8*)(hid + fr * 136 + 32 * s + 8 * fq), b = *(const GAS bf16x8*)(B2 + 32 * s);
        acc2 = __builtin_amdgcn_mfma_f32_16x16x32_bf16(a, b, acc2, 0, 0, 0);
    }
    bf16* out = (kv ? P.VC : P.KC) + (size_t)g * 1024 * 128;
#pragma unroll
    for (int i = 0; i < 4; ++i) { const int nn = 16 * tile + 4 * fq + i; out[(size_t)nn * 128 + 16 * wave + fr] = (nn < 1023) ? (bf16)(pk2(acc2[i], 0.f) & 0xffffu) : (bf16)0; }
    __syncthreads();
}
}
#ifdef CHK_BUILD
namespace chk {
constexpr size_t WS_CHK = 14 * MiB;
__device__ __forceinline__ float bf2f(bf16 v) { return __uint_as_float((unsigned)v << 16); }
__device__ __forceinline__ float e4m3(unsigned char b) {
    const int e = (b >> 3) & 15, mm = b & 7; const float v = e == 0 ? (float)mm * (1.f / 512.f) : (1.f + (float)mm * 0.125f) * exp2f((float)(e - 7)); return (b & 0x80) ? -v : v; }
__device__ __forceinline__ int sample_t(int i) { return i * 64 + (i * 29) % 64; }
__device__ __noinline__ void nsa_check(LAS unsigned char* lds, unsigned char* ws, int t, int g, LAS float* acc2) {
    int tid_ = threadIdx.x; asm volatile("" : "+v"(tid_)); const int tid = tid_, lane = tid & 63, wave = tid >> 6;
    const int hh = 8 * g + wave, cur = t >> 6;
    const bf16* QN = (const bf16*)(ws + WS_QNSA); const bf16* KV = (const bf16*)(ws + WS_KVNSA); const bf16* KC = (const bf16*)(ws + WS_KCMP) + (size_t)g * 1024 * 128; const bf16* VC = (const bf16*)(ws + WS_VCMP) + (size_t)g * 1024 * 128;
    const bf16* ZN = (const bf16*)(ws + WS_ZNSA); const float* GN = (const float*)(ws + WS_GNSA); const bf16* HO = (const bf16*)(ws + WS_H);
    const size_t CH = (size_t)S * 128;
    LAS float* pc = (LAS float*)lds;
    LAS float* impv = (LAS float*)(lds + 32768);
    LAS int* sel = (LAS int*)(lds + 32768 + 1024);
    const float slope2 = exp2f(-0.5f * (float)(hh + 1)) * LOG2E;
    const float q0 = bf2f(QN[(size_t)t * 2048 + hh * 128 + 2 * lane]), q1 = bf2f(QN[(size_t)t * 2048 + hh * 128 + 2 * lane + 1]);
    float oc0 = 0.f, oc1 = 0.f, os0 = 0.f, os1 = 0.f, ow0 = 0.f, ow1 = 0.f;
    const int ncv = (t >= 31) ? (t - 31) / 16 + 1 : 0;
    for (int n = lane; n < 1024; n += 64) pc[wave * 1024 + n] = 0.f;
    float mx = -1e30f;
    for (int n = 0; n < ncv; ++n) { float s = q0 * bf2f(KC[(size_t)n * 128 + 2 * lane]) + q1 * bf2f(KC[(size_t)n * 128 + 2 * lane + 1]); s = wave_sum(s) - slope2 * (float)(t - 16 * n - 31);
        if (lane == 0) pc[wave * 1024 + n] = s; mx = fmaxf(mx, s); }
    __syncthreads();
    float sum = 0.f;
    for (int n = 0; n < ncv; ++n) sum += exp2f(pc[wave * 1024 + n] - mx);
    __syncthreads();
    for (int n = lane; n < 1024; n += 64) pc[wave * 1024 + n] = (n < ncv) ? exp2f(pc[wave * 1024 + n] - mx) / sum : 0.f;
    __syncthreads();
    for (int n = 0; n < ncv; ++n) { const float p = pc[wave * 1024 + n]; oc0 += p * bf2f(VC[(size_t)n * 128 + 2 * lane]); oc1 += p * bf2f(VC[(size_t)n * 128 + 2 * lane + 1]); }
    if (tid < 256) { const int j = tid; float v = -1e30f;
        if (64 * j <= t) { float a = 0.f; for (int ii = 4 * j - 1; ii <= 4 * j + 3; ++ii) if (ii >= 0 && ii <= 1022) { float ps = 0.f; for (int h = 0; h < 8; ++h) ps += pc[h * 1024 + ii]; a += ps; }
            const bool forced = (j == 0) || (j == cur) || (j == cur - 1); v = a + (forced ? 1e4f : 0.f); }
        impv[j] = v; }
    __syncthreads();
    if (tid < 256) { const int j = tid; const float v = impv[j]; int rank = 0; for (int ii = 0; ii < 256; ++ii) { const float u = impv[ii]; rank += (u > v || (u == v && ii < j)) ? 1 : 0; } sel[j] = rank < 16 ? 1 : 0; }
    __syncthreads();
    const bf16* KS = KV + (size_t)(4 + g) * CH; const bf16* VSl = KV + (size_t)(6 + g) * CH;
    mx = -1e30f;
    for (int j = 0; j < 256; ++j) if (sel[j]) for (int tok = 64 * j; tok < 64 * j + 64 && tok <= t; ++tok) {
        float s = q0 * bf2f(KS[(size_t)tok * 128 + 2 * lane]) + q1 * bf2f(KS[(size_t)tok * 128 + 2 * lane + 1]); s = wave_sum(s) - slope2 * (float)(t - tok); mx = fmaxf(mx, s); }
    sum = 0.f;
    for (int j = 0; j < 256; ++j) if (sel[j]) for (int tok = 64 * j; tok < 64 * j + 64 && tok <= t; ++tok) {
        float s = q0 * bf2f(KS[(size_t)tok * 128 + 2 * lane]) + q1 * bf2f(KS[(size_t)tok * 128 + 2 * lane + 1]); s = wave_sum(s) - slope2 * (float)(t - tok);
        const float p = exp2f(s - mx); sum += p; os0 += p * bf2f(VSl[(size_t)tok * 128 + 2 * lane]); os1 += p * bf2f(VSl[(size_t)tok * 128 + 2 * lane + 1]); }
    os0 /= sum; os1 /= sum;
    const bf16* KW = KV + (size_t)(8 + g) * CH; const bf16* VW = KV + (size_t)(10 + g) * CH;
    const int lo = t - 511 > 0 ? t - 511 : 0;
    mx = -1e30f;
    for (int tok = lo; tok <= t; ++tok) { float s = q0 * bf2f(KW[(size_t)tok * 128 + 2 * lane]) + q1 * bf2f(KW[(size_t)tok * 128 + 2 * lane + 1]); s = wave_sum(s) - slope2 * (float)(t - tok); mx = fmaxf(mx, s); }
    sum = 0.f;
    for (int tok = lo; tok <= t; ++tok) { float s = q0 * bf2f(KW[(size_t)tok * 128 + 2 * lane]) + q1 * bf2f(KW[(size_t)tok * 128 + 2 * lane + 1]); s = wave_sum(s) - slope2 * (float)(t - tok);
        const float p = exp2f(s - mx); sum += p; ow0 += p * bf2f(VW[(size_t)tok * 128 + 2 * lane]); ow1 += p * bf2f(VW[(size_t)tok * 128 + 2 * lane + 1]); }
    ow0 /= sum; ow1 /= sum;
    const float gc = GN[(size_t)t * 48 + hh], gs = GN[(size_t)t * 48 + 16 + hh], gwv = GN[(size_t)t * 48 + 32 + hh];
    const float r0 = (gc * oc0 + gs * os0 + gwv * ow0) * bf2f(ZN[(size_t)t * 2048 + hh * 128 + 2 * lane]), r1 = (gc * oc1 + gs * os1 + gwv * ow1) * bf2f(ZN[(size_t)t * 2048 + hh * 128 + 2 * lane + 1]);
    const float f0 = bf2f(HO[(size_t)t * 4096 + 2048 + hh * 128 + 2 * lane]), f1 = bf2f(HO[(size_t)t * 4096 + 2048 + hh * 128 + 2 * lane + 1]);
    const float e2 = wave_sum((r0 - f0) * (r0 - f0) + (r1 - f1) * (r1 - f1)), n2 = wave_sum(r0 * r0 + r1 * r1);
    __syncthreads();
    if (lane == 0) { pc[wave] = e2; pc[8 + wave] = n2; }
    __syncthreads();
    if (tid == 0) { float a = 0.f, b = 0.f; for (int w = 0; w < 8; ++w) { a += pc[w]; b += pc[8 + w]; } acc2[0] += a; acc2[1] += b; }
    __syncthreads();
}
__device__ __forceinline__ void mla_check(LAS unsigned char* lds, unsigned char* ws, int t, LAS float* acc2) {
    int tid_ = threadIdx.x; asm volatile("" : "+v"(tid_)); const int tid = tid_, lane = tid & 63, wave = tid >> 6;
    const bf16* ZM = (const bf16*)(ws + WS_ZMLA); const bf16* HO = (const bf16*)(ws + WS_H);
    LAS float* qs = (LAS float*)lds + wave * 192;
    LAS float* red = (LAS float*)lds + 8 * 192;
    float ae = 0.f, an = 0.f;
    for (int rep = 0; rep < 2; ++rep) { const int head = wave + 8 * rep;
#ifdef MLA_FP8
        { const unsigned char* qp = (const unsigned char*)(ws + WS_QMLA) + (size_t)t * 3072 + head * 192; for (int d = lane; d < 192; d += 64) qs[d] = e4m3(qp[d]) * QS_MLA; }
#else
        { const bf16* qp = (const bf16*)(ws + WS_QMLA) + (size_t)t * 3072 + head * 192; for (int d = lane; d < 192; d += 64) qs[d] = bf2f(qp[d]); }
#endif
        __syncthreads();
        float mx = -1e30f;
        for (int c = 0; 64 * c <= t; ++c) {
#ifdef MLA_MX
            const int tok = 64 * c + 8 * ((lane >> 2) & 7) + 4 * (lane >> 5) + (lane & 3);
#else
            const int x_ = lane & 15; const int tok = 64 * c + (lane & 48) + (x_ < 4 ? x_ : (x_ < 8 ? x_ + 4 : (x_ < 12 ? x_ - 4 : x_)));
#endif

            float s = 0.f;
#ifdef MLA_FP8
            const unsigned char* kp = (const unsigned char*)(ws + WS_KMLA) + (size_t)tok * 3072 + head * 192; for (int d = 0; d < 192; ++d) s += qs[d] * e4m3(kp[d]);
#else
            const bf16* kp = (const bf16*)(ws + WS_KMLA) + (size_t)tok * 3072 + head * 192; for (int d = 0; d < 192; ++d) s += qs[d] * bf2f(kp[d]);
#endif
            if (tok <= t) mx = fmaxf(mx, s); }
        for (int off = 1; off < 64; off <<= 1) mx = fmaxf(mx, __shfl_xor(mx, off));
        float e2 = 0.f, n2 = 0.f;
        for (int dc = 0; dc < 8; ++dc) {
        float sum = 0.f; float o[16];
#pragma unroll
        for (int d = 0; d < 16; ++d) o[d] = 0.f;
        for (int c = 0; 64 * c <= t; ++c) {
#ifdef MLA_MX
            const int tok = 64 * c + 8 * ((lane >> 2) & 7) + 4 * (lane >> 5) + (lane & 3);
#else
            const int x_ = lane & 15; const int tok = 64 * c + (lane & 48) + (x_ < 4 ? x_ : (x_ < 8 ? x_ + 4 : (x_ < 12 ? x_ - 4 : x_)));
#endif

            float s = 0.f;
#ifdef MLA_FP8
            const unsigned char* kp = (const unsigned char*)(ws + WS_KMLA) + (size_t)tok * 3072 + head * 192; for (int d = 0; d < 192; ++d) s += qs[d] * e4m3(kp[d]);
#else
            const bf16* kp = (const bf16*)(ws + WS_KMLA) + (size_t)tok * 3072 + head * 192; for (int d = 0; d < 192; ++d) s += qs[d] * bf2f(kp[d]);
#endif
            const float p = (tok <= t) ? exp2f(s - mx) : 0.f; sum += p;
#ifdef MLA_FP8V
            const unsigned char* vt = (const unsigned char*)(ws + WS_VMLA) + ((size_t)head * 128 + 16 * dc) * S + 64 * c + lane;
#pragma unroll
            for (int d = 0; d < 16; ++d) o[d] += p * e4m3(vt[(size_t)d * S]);
#else
            const bf16* vp = (const bf16*)(ws + WS_VMLA) + (size_t)tok * 2048 + head * 128 + 16 * dc;
#pragma unroll
            for (int d = 0; d < 16; ++d) o[d] += p * bf2f(vp[d]);
#endif
        }
        sum = wave_sum(sum);
#pragma unroll
        for (int d = 0; d < 16; ++d) { const float od = wave_sum(o[d]) / sum; const float r = od * bf2f(ZM[(size_t)t * 2048 + head * 128 + 16 * dc + d]), f = bf2f(HO[(size_t)t * 4096 + head * 128 + 16 * dc + d]); e2 += (r - f) * (r - f); n2 += r * r; }
        }
        ae += e2; an += n2;
        __syncthreads(); }
    if (lane == 0) { red[wave] = ae; red[8 + wave] = an; }
    __syncthreads();
    if (tid == 0) { float a = 0.f, b = 0.f; for (int w = 0; w < 8; ++w) { a += red[w]; b += red[8 + w]; } acc2[0] += a; acc2[1] += b; }
    __syncthreads();
}
}
#endif
#ifdef CHK2_BUILD
namespace chk2 {
constexpr size_t WS_CHK = 14 * MiB;
__device__ __forceinline__ float bf2f(bf16 v) { return __uint_as_float((unsigned)v << 16); }
__device__ __forceinline__ int sample_t(int i) { return i * 256 + (i * 29) % 256; }
__device__ __noinline__ void proj_check(LAS unsigned char* lds, unsigned char* ws, const float* x, const float* w_in_l, int l, int i, int qd, LAS float* acc2) {
    int tid_ = threadIdx.x; asm volatile("" : "+v"(tid_)); const int tid = tid_;
    const int t = sample_t(i);
    LAS float* h = (LAS float*)lds;
    LAS float* red = h + 4096;
    const float* mod = (const float*)(ws + WS_MOD) + (size_t)l * 3 * D;
    const float* xin = (l == 0) ? x : (const float*)(ws + WS_XV);
    for (int k = tid; k < D; k += NTHR) h[k] = xin[(size_t)t * D + k] * (1.f + mod[D + k]) + mod[k];
    __syncthreads();
    float e2 = 0.f, r2 = 0.f;
    const float* cosT = (const float*)(ws + WS_ROPE); const float* sinT = cosT + (size_t)S * 32;
    for (int n = qd * 2268 + tid; n < (qd + 1) * 2268; n += NTHR) {
        float a = 0.f;
        for (int k = 0; k < D; ++k) a += h[k] * w_in_l[(size_t)k * INC + n];
        float ref = a, got;
        if (n < 768) got = bf2f(((const bf16*)(ws + WS_QLAT))[(size_t)t * 768 + n]);
        else if (n < 1280) got = bf2f(((const bf16*)(ws + WS_KVLAT))[(size_t)t * 512 + n - 768]);
        else if (n < 1344) {
            const int ii = n - 1280, pi = ii & 31; const int np = 1280 + (ii < 32 ? ii + 32 : ii - 32); float b = 0.f;
            for (int k = 0; k < D; ++k) b += h[k] * w_in_l[(size_t)k * INC + np];
            const float c = cosT[(size_t)t * 32 + pi], s = sinT[(size_t)t * 32 + pi];
            ref = ii < 32 ? a * c - b * s : a * c + b * s;
            got = bf2f(((const bf16*)(ws + WS_KMLA))[(size_t)t * 3072 + 5 * 192 + 128 + 2 * pi + (ii >> 5)]);
        }
        else if (n < 3392) { ref = a / (1.f + expf(-a)); got = bf2f(((const bf16*)(ws + WS_ZMLA))[(size_t)t * 2048 + n - 1344]); }
        else if (n < 5440) { ref = a * QS_NSA; got = bf2f(((const bf16*)(ws + WS_QNSA))[(size_t)t * 2048 + n - 3392]); }
        else if (n < 6976) { const int c = n - 5440; got = bf2f(((const bf16*)(ws + WS_KVNSA))[(size_t)(c >> 7) * ((size_t)S * 128) + (size_t)t * 128 + (c & 127)]); }
        else if (n < 7024) { ref = 1.f / (1.f + expf(-a)); got = ((const float*)(ws + WS_GNSA))[(size_t)t * 48 + n - 6976]; }
        else { ref = a / (1.f + expf(-a)); got = bf2f(((const bf16*)(ws + WS_ZNSA))[(size_t)t * 2048 + n - 7024]); }
        e2 += (ref - got) * (ref - got); r2 += ref * ref;
    }
    red[tid] = e2; red[512 + tid] = r2;
    __syncthreads();
    if (tid == 0) { float a = 0.f, b = 0.f; for (int k = 0; k < 512; ++k) { a += red[k]; b += red[512 + k]; } acc2[0] += a; acc2[1] += b; }
    __syncthreads();
}
__device__ __noinline__ void cmp_check(LAS unsigned char* lds, unsigned char* ws, const float* cmp_pos_l, const float* w1_l, const float* w2_l, int i, LAS float* acc2) {
    int tid_ = threadIdx.x; asm volatile("" : "+v"(tid_)); const int tid = tid_;
    const int n = (4 * i + (i & 3)) % 1023, kv = i & 1, g = (i >> 1) & 1;
    LAS float* blk = (LAS float*)lds;
    LAS float* hid = blk + 4096;
    LAS float* red = hid + 128;
    const bf16* A = (const bf16*)(ws + WS_KVNSA) + (size_t)(kv * 2 + g) * ((size_t)S * 128) + (size_t)n * 2048;
    for (int k = tid; k < 4096; k += NTHR) blk[k] = bf2f(A[k]) + cmp_pos_l[(size_t)kv * 4096 + k];
    __syncthreads();
    if (tid < 128) { float a = 0.f; const float* W = w1_l + (size_t)kv * 4096 * 128 + tid; for (int k = 0; k < 4096; ++k) a += blk[k] * W[(size_t)k * 128]; hid[tid] = a / (1.f + expf(-a)); }
    __syncthreads();
    float e2 = 0.f, r2 = 0.f;
    if (tid < 128) { float a = 0.f; const float* W = w2_l + (size_t)kv * 128 * 128 + tid; for (int k = 0; k < 128; ++k) a += hid[k] * W[(size_t)k * 128];
        const float got = bf2f(((const bf16*)(ws + (kv ? WS_VCMP : WS_KCMP)))[(size_t)g * 1024 * 128 + (size_t)n * 128 + tid]); e2 = (a - got) * (a - got); r2 = a * a; }
    if (tid < 128) { red[tid] = e2; red[128 + tid] = r2; }
    __syncthreads();
    if (tid == 0) { float a = 0.f, b = 0.f; for (int k = 0; k < 128; ++k) { a += red[k]; b += red[128 + k]; } acc2[0] += a; acc2[1] += b; }
    __syncthreads();
}
}
#endif
#ifdef CHK3_BUILD
namespace chk3 {
constexpr size_t WS_CHK = 14 * MiB;
__device__ __forceinline__ float bf2f(bf16 v) { return __uint_as_float((unsigned)v << 16); }
__device__ __forceinline__ float e4m3(unsigned char b) { const int e = (b >> 3) & 15, mm = b & 7; const float v = e == 0 ? (float)mm * (1.f / 512.f) : (1.f + (float)mm * 0.125f) * exp2f((float)(e - 7)); return (b & 0x80) ? -v : v; }
__device__ __forceinline__ int sample_t(int i) { return i * 64 + (i * 29) % 64; }
__device__ __noinline__ void up_check(LAS unsigned char* lds, unsigned char* ws, const float* qn, const float* wq, const float* kn, const float* wkv, int i, LAS float* acc2) {
    int tid_ = threadIdx.x; asm volatile("" : "+v"(tid_)); const int tid = tid_;
    const int t = sample_t(i);
    LAS float* ql = (LAS float*)lds;
    LAS float* kl = ql + 768;
    LAS float* qo = kl + 512;
    LAS float* red = qo + 3072;
    const bf16* QL = (const bf16*)(ws + WS_QLAT) + (size_t)t * 768; const bf16* KL = (const bf16*)(ws + WS_KVLAT) + (size_t)t * 512;
    float s = 0.f; for (int k = tid; k < 768; k += NTHR) { const float v = bf2f(QL[k]); s += v * v; }
    red[tid] = s; __syncthreads();
    float tot = 0.f; for (int k = 0; k < 512; ++k) tot += red[k];
    const float rq = 1.f / sqrtf(tot / 768.f + RMS_EPS);
    __syncthreads();
    s = 0.f; for (int k = tid; k < 512; k += NTHR) { const float v = bf2f(KL[k]); s += v * v; }
    red[tid] = s; __syncthreads();
    tot = 0.f; for (int k = 0; k < 512; ++k) tot += red[k];
    const float rk = 1.f / sqrtf(tot / 512.f + RMS_EPS);
    __syncthreads();
    for (int k = tid; k < 768; k += NTHR) ql[k] = bf2f(QL[k]) * rq * qn[k];
    for (int k = tid; k < 512; k += NTHR) kl[k] = bf2f(KL[k]) * rk * kn[k];
    __syncthreads();
    for (int n = tid; n < 3072; n += NTHR) { float a = 0.f; for (int k = 0; k < 768; ++k) a += ql[k] * wq[(size_t)k * 3072 + n]; qo[n] = a; }
    __syncthreads();
    float e2 = 0.f, r2 = 0.f;
    const float* cosT = (const float*)(ws + WS_ROPE); const float* sinT = cosT + (size_t)S * 32;
    const bf16* QM = (const bf16*)(ws + WS_QMLA) + (size_t)t * 3072;
    for (int n = tid; n < 3072; n += NTHR) { const int h = n / 192, d = n % 192; float ref, got;
#ifdef MLA_FP8
        const unsigned char* Q8 = (const unsigned char*)(ws + WS_QMLA) + (size_t)t * 3072;
        if (d < 128) { ref = qo[n]; got = e4m3(Q8[h * 192 + d]); }
        else { const int ii = d - 128, pi = ii & 31; const float x1 = qo[h * 192 + 128 + pi], x2 = qo[h * 192 + 160 + pi]; const float c = cosT[(size_t)t * 32 + pi], sn = sinT[(size_t)t * 32 + pi];
            ref = (ii < 32 ? x1 * c - x2 * sn : x2 * c + x1 * sn); got = e4m3(Q8[h * 192 + 128 + 2 * pi + (ii >> 5)]); }
        if (false) {}
#else
        if (d < 128) { ref = qo[n] * QS_MLA; got = bf2f(QM[h * 192 + d]); }
        else { const int ii = d - 128, pi = ii & 31; const float x1 = qo[h * 192 + 128 + pi], x2 = qo[h * 192 + 160 + pi]; const float c = cosT[(size_t)t * 32 + pi], sn = sinT[(size_t)t * 32 + pi];
            ref = (ii < 32 ? x1 * c - x2 * sn : x2 * c + x1 * sn) * QS_MLA; got = bf2f(QM[h * 192 + 128 + 2 * pi + (ii >> 5)]); }
#endif
        e2 += (ref - got) * (ref - got); r2 += ref * ref; }
    const bf16* KM = (const bf16*)(ws + WS_KMLA) + (size_t)t * 3072; const bf16* VM = (const bf16*)(ws + WS_VMLA) + (size_t)t * 2048;
    for (int n = tid; n < 4096; n += NTHR) { float a = 0.f; for (int k = 0; k < 512; ++k) a += kl[k] * wkv[(size_t)k * 4096 + n];
#ifdef MLA_FP8
        const int h = n >> 8, d = n & 255; const float got = d < 128 ? e4m3(((const unsigned char*)(ws + WS_KMLA) + (size_t)t * 3072)[h * 192 + d]) : bf2f(VM[h * 128 + d - 128]);
#else
        const int h = n >> 8, d = n & 255; const float got = d < 128 ? bf2f(KM[h * 192 + d]) : bf2f(VM[h * 128 + d - 128]);
#endif
        e2 += (a - got) * (a - got); r2 += a * a; }
    red[tid] = e2; red[512 + tid] = r2;
    __syncthreads();
    if (tid == 0) { float a = 0.f, b = 0.f; for (int k = 0; k < 512; ++k) { a += red[k]; b += red[512 + k]; } acc2[0] += a; acc2[1] += b; }
    __syncthreads();
}
__device__ __noinline__ void out_check(LAS unsigned char* lds, unsigned char* ws, const float* xin, const float* xv, const float* wout, const float* gate, int i, int qd, LAS float* acc2) {
    int tid_ = threadIdx.x; asm volatile("" : "+v"(tid_)); const int tid = tid_;
    const int t = i * 256 + (i * 29) % 256;
    LAS float* o = (LAS float*)lds;
    LAS float* red = o + 4096;
    const bf16* OA = (const bf16*)(ws + WS_H) + (size_t)t * 4096;
    for (int k = tid; k < 4096; k += NTHR) o[k] = bf2f(OA[k]);
    __syncthreads();
    float e2 = 0.f, r2 = 0.f;
    for (int n = qd * 1024 + tid; n < (qd + 1) * 1024; n += NTHR) { float a = 0.f; for (int k = 0; k < 4096; ++k) a += o[k] * wout[(size_t)k * 4096 + n];
        const float gy = gate[n] * a, ref = DN_ALPHA * xin[(size_t)t * D + n] + gy, got = xv[(size_t)t * D + n];
        e2 += (ref - got) * (ref - got); r2 += gy * gy; }
    red[tid] = e2; red[512 + tid] = r2;
    __syncthreads();
    if (tid == 0) { float a = 0.f, b = 0.f; for (int k = 0; k < 512; ++k) { a += red[k]; b += red[512 + k]; } acc2[0] += a; acc2[1] += b; }
    __syncthreads();
}
}
#endif
#ifdef CHK4_BUILD
namespace chk4 {
__device__ __forceinline__ float bf2f(bf16 v) { return __uint_as_float((unsigned)v << 16); }
__device__ __noinline__ void mod_check(LAS unsigned char* lds, unsigned char* ws, const float* c, const float* w_ada, const float* b_ada, int u, LAS float* acc2) {
    const int tid = threadIdx.x;
    LAS float* red = (LAS float*)lds;
    const int l = u & 1, n = ((u >> 1) * 977 + 13) % (3 * D);
    float a = 0.f;
    for (int k = tid; k < D; k += NTHR) { const float cv = c[k]; a += cv / (1.f + expf(-cv)) * w_ada[(size_t)l * D * 3 * D + (size_t)k * 3 * D + n]; }
    red[tid] = a; __syncthreads();
    if (tid == 0) { float s = 0.f; for (int k = 0; k < NTHR; ++k) s += red[k]; s += b_ada[(size_t)l * 3 * D + n];
        const float got = ((const float*)(ws + WS_MOD))[(size_t)l * 3 * D + n]; acc2[0] += (s - got) * (s - got); acc2[1] += s * s; }
    __syncthreads();
}
__device__ __noinline__ void ln_check(LAS unsigned char* lds, unsigned char* ws, const float* ln_g, const float* ln_b, int u, LAS float* acc2) {
    const int tid = threadIdx.x;
    LAS float* red = (LAS float*)lds;
    const int t = u * 64 + (u * 29) % 64;
    const float* X1 = (const float*)(ws + WS_XV) + (size_t)t * D; const bf16* H = (const bf16*)(ws + WS_H) + (size_t)t * D; const float* mod1 = (const float*)(ws + WS_MOD) + 3 * D;
    float s1 = 0.f, s2 = 0.f, e2 = 0.f, r2 = 0.f;
    for (int k = tid; k < D; k += NTHR) { const float y = (X1[k] - ln_b[k]) / ln_g[k]; s1 += y; s2 += y * y;
        const float h = X1[k] * (1.f + mod1[D + k]) + mod1[k], got = bf2f(H[k]); e2 += (h - got) * (h - got); r2 += h * h; }
    red[tid] = s1; red[512 + tid] = s2; red[1024 + tid] = e2; red[1536 + tid] = r2; __syncthreads();
    if (tid == 0) { float a = 0.f, b = 0.f, c = 0.f, d = 0.f; for (int k = 0; k < NTHR; ++k) { a += red[k]; b += red[512 + k]; c += red[1024 + k]; d += red[1536 + k]; }
        const float mean = a / D, var = b / D - mean * mean;
        acc2[0] += mean * mean + (var - 1.f) * (var - 1.f) + c / d; acc2[1] += 1.f; }
    __syncthreads();
}
}
#endif
constexpr int PPL = 6;
constexpr int N_PHASES = 2 + PPL * DEPTH;
struct Args { const void* in[16]; float* out; unsigned char* ws; int ph_lo, ph_hi; };
#define WSP(T, off) ((T*)(ws + (off)))
#define VCU() ((gridDim.x % 8 == 0) ? (int)((blockIdx.x % 8) * (gridDim.x / 8) + blockIdx.x / 8) : (int)blockIdx.x)
__global__ void __launch_bounds__(NTHR, 2) mk_fwd(const Args args) {
    extern __shared__ __attribute__((aligned(16))) unsigned char lds_raw[];
    LAS unsigned char* lds = (LAS unsigned char*)lds_raw;
    if (threadIdx.x < 32) ((volatile LAS unsigned*)(lds + MISC_OFF))[threadIdx.x] = 0u;
    __syncthreads();
    XcdBarrier bar = xcd_barrier_post((unsigned*)(args.ws + WS_CTL) + CW_BAR, (volatile LAS unsigned*)(lds + MISC_OFF) + 8);
#define IN(k) (args.ph_lo <= (k) && (k) < args.ph_hi)
#define SEAM(k) do { if (IN(k) && IN((k) + 1)) xcd_barrier(bar); } while (0)
#define PHASE_REGS int tid_ = threadIdx.x; asm volatile("" : "+v"(tid_)); const int tid = tid_, lane = tid & 63, wave = __builtin_amdgcn_readfirstlane(tid >> 6); \
    unsigned char* ws = args.ws; asm volatile("" : "+s"(ws)); (void)tid; (void)lane; (void)wave

    if (IN(0)) {
        PHASE_REGS; const int G = gridDim.x, vcu = VCU();
        p0_mod_gemv((const float*)args.in[1], (const float*)args.in[3], (const float*)args.in[4], WSP(float, WS_MOD), (LAS float*)lds, vcu, G);
        p0_cmpbias((const float*)args.in[10], (const float*)args.in[11], WSP(float, WS_CBP), (LAS float*)lds, (vcu + G / 2) % G, G);
        p0_rope((const int*)args.in[2], WSP(float, WS_ROPE), WSP(float, WS_ROPE) + (size_t)S * 32, vcu * NTHR + tid, G * NTHR);
        const P0In I{(const float*)args.in[5], (const float*)args.in[6], (const float*)args.in[7], (const float*)args.in[8], (const float*)args.in[9], (const float*)args.in[11], (const float*)args.in[12], (const float*)args.in[13]};
#ifndef DIS_CONV
        p0_convert(I, ws, vcu * NWAVES + wave, G * NWAVES, lane);
#endif
#ifdef PROBE_P0CONV2
        p0_convert(I, ws, vcu * NWAVES + wave, G * NWAVES, lane);
#endif
#ifdef PROBE_P0MOD2
        __syncthreads(); p0_mod_gemv((const float*)args.in[1], (const float*)args.in[3], (const float*)args.in[4], WSP(float, WS_MOD), (LAS float*)lds, vcu, G);
#endif
    }
    SEAM(0);
#ifdef GEMM_F8
#define H8PTR WSP(unsigned char, WS_H8)
#else
#define H8PTR ((unsigned char*)nullptr)
#endif
    if (IN(1)) { PHASE_REGS; modulate_rows((const float*)args.in[0], WSP(bf16, WS_H), H8PTR, WSP(float, WS_MOD), VCU() * NWAVES + wave, gridDim.x * NWAVES, lane);
#ifdef PROBE_THIN2
        modulate_rows((const float*)args.in[0], WSP(bf16, WS_H), H8PTR, WSP(float, WS_MOD), VCU() * NWAVES + wave, gridDim.x * NWAVES, lane);
#endif
    }
    SEAM(1);
    for (int l = 0; l < DEPTH; ++l) {
        const int pb = 2 + PPL * l;
        if (IN(pb + 0)) {
            PHASE_REGS;
#ifdef GEMM_F8
            { pg8::Gemm gg{WSP(bf16, WS_H), (const bf16*)(ws + WS_W + (size_t)l * W_LSTRIDE + W_IN), S, 23 * 256, D}; pg8::InBf16Order SO; SO.init(S, 23 * 256, gridDim.x, blockIdx.x);
              const pg8::EpiIn E{ws, 0};
              pg8::gemm_phase<pg8::EpiIn, pg8::InBf16Order, true, true>(lds, gg, SO, E);
#ifdef PROBE_INB2
              pg8::gemm_phase<pg8::EpiIn, pg8::InBf16Order, true, true>(lds, gg, SO, E);
#endif
            }
            { pg8::Gemm gg{(const bf16*)(ws + WS_H8), (const bf16*)(ws + WS_WIN8 + (size_t)l * WIN8_LSTRIDE), S, 13 * 256, D / 2}; pg8::StaticOrder SO; SO.init(S, 13 * 256, gridDim.x, (blockIdx.x + 64) % gridDim.x);
              const pg8::EpiIn E{ws, 1};
              pg8::gemm_phase<pg8::EpiIn, pg8::StaticOrder, true, true, 0x79797979, 0x7f7f7f7f>(lds, gg, SO, E);
#ifdef PROBE_INF2
              pg8::gemm_phase<pg8::EpiIn, pg8::StaticOrder, true, true, 0x79797979, 0x7f7f7f7f>(lds, gg, SO, E);
#endif
            }
#else
            pg8::Gemm gg{WSP(bf16, WS_H), (const bf16*)(ws + WS_W + (size_t)l * W_LSTRIDE + W_IN), S, NIN, D}; pg8::StaticOrder SO; SO.init(S, NIN, gridDim.x, blockIdx.x);
            const pg8::EpiIn E{ws, 0};
#ifndef DIS_IN
            pg8::gemm_phase<pg8::EpiIn, pg8::StaticOrder, true, true>(lds, gg, SO, E);
#endif
#ifdef PROBE_IN2
            pg8::gemm_phase<pg8::EpiIn, pg8::StaticOrder, true, true>(lds, gg, SO, E);
#endif
#endif
        }
        SEAM(pb + 0);
        if (IN(pb + 1)) {
            PHASE_REGS; const int G = gridDim.x, vcu = VCU();
            rstd_rows(WSP(float, WS_RSQQ), WSP(float, WS_RSQKV), WSP(float, WS_RSTD), WSP(float, WS_RSTD) + S, vcu * NTHR + tid, G * NTHR);
            const att::CmpPtrs CP{WSP(bf16, WS_KVNSA), (const bf16*)(ws + WS_W + (size_t)l * W_LSTRIDE + W_C1), (const bf16*)(ws + WS_W + (size_t)l * W_LSTRIDE + W_C2),
                                  WSP(float, WS_CBP) + (size_t)l * 2 * 16 * 128, WSP(bf16, WS_KCMP), WSP(bf16, WS_VCMP)};
#ifndef DIS_CMP
            for (int u = vcu; u < 256; u += G) att::cmp_unit(lds, CP, u & 1, (u >> 1) & 1, u >> 2, tid, wave, lane);
#endif
#ifdef PROBE_THIN2
            rstd_rows(WSP(float, WS_RSQQ), WSP(float, WS_RSQKV), WSP(float, WS_RSTD), WSP(float, WS_RSTD) + S, vcu * NTHR + tid, G * NTHR);
            for (int u = vcu; u < 256; u += G) att::cmp_unit(lds, CP, u & 1, (u >> 1) & 1, u >> 2, tid, wave, lane);
#endif
        }
        SEAM(pb + 1);
        if (IN(pb + 2)) {
            PHASE_REGS;
#ifdef GEMM_F8
            { pg8::Gemm gg{WSP(bf16, WS_QLAT), (const bf16*)(ws + WS_W + (size_t)l * W_LSTRIDE + W_QUP), S, 3072, 384}; pg8::StaticOrder SO; SO.init(S, 3072, gridDim.x, blockIdx.x);
              const pg8::EpiQup E{ws};
              pg8::gemm_phase<pg8::EpiQup, pg8::StaticOrder, true, true, 0x7a7a7a7a, 0x7f7f7f7f>(lds, gg, SO, E);
#ifdef PROBE_UPF2
              pg8::gemm_phase<pg8::EpiQup, pg8::StaticOrder, true, true, 0x7a7a7a7a, 0x7f7f7f7f>(lds, gg, SO, E);
#endif
            }
            { pg8::Gemm gg{WSP(bf16, WS_KVLAT), (const bf16*)(ws + WS_W + (size_t)l * W_LSTRIDE + W_KVUP), S, 2048, 256}; pg8::StaticOrder SO; SO.init(S, 2048, gridDim.x, blockIdx.x);
              const pg8::EpiKup E{ws};
              pg8::gemm_phase<pg8::EpiKup, pg8::StaticOrder, true, true, 0x7a7a7a7a, 0x7f7f7f7f>(lds, gg, SO, E);
#ifdef PROBE_UPF2
              pg8::gemm_phase<pg8::EpiKup, pg8::StaticOrder, true, true, 0x7a7a7a7a, 0x7f7f7f7f>(lds, gg, SO, E);
#endif
            }
            { pg8::Gemm gg{(const bf16*)(ws + WS_W + (size_t)l * W_LSTRIDE + W_KVUP + (size_t)2048 * 512), WSP(bf16, WS_KVLAT), 2048, S, 256}; pg8::StaticOrder SO; SO.init(2048, S, gridDim.x, blockIdx.x);
              const pg8::EpiVt E{ws};
              pg8::gemm_phase<pg8::EpiVt, pg8::StaticOrder, true, true, 0x7f7f7f7f, 0x7a7a7a7a>(lds, gg, SO, E);
#ifdef PROBE_UPF2
              pg8::gemm_phase<pg8::EpiVt, pg8::StaticOrder, true, true, 0x7f7f7f7f, 0x7a7a7a7a>(lds, gg, SO, E);
#endif
            }
        }
#else
            { pg8::Gemm gg{WSP(bf16, WS_QLAT), (const bf16*)(ws + WS_W + (size_t)l * W_LSTRIDE + W_QUP), S, 3072, 768}; pg8::StaticOrder SO; SO.init(S, 3072, gridDim.x, blockIdx.x);
              const pg8::EpiQup E{ws};
#ifndef DIS_QUP
              pg8::gemm_phase<pg8::EpiQup, pg8::StaticOrder, true, true>(lds, gg, SO, E);
#endif
#ifdef PROBE_UP2
              pg8::gemm_phase<pg8::EpiQup, pg8::StaticOrder, true, true>(lds, gg, SO, E);
#endif
            }
#ifdef MLA_FP8V
            { pg8::Gemm gg{WSP(bf16, WS_KVLAT), (const bf16*)(ws + WS_W + (size_t)l * W_LSTRIDE + W_KVUP), S, 2048, 512}; pg8::StaticOrder SO; SO.init(S, 2048, gridDim.x, blockIdx.x);
              const pg8::EpiKup E{ws};
              pg8::gemm_phase<pg8::EpiKup, pg8::StaticOrder, true, true>(lds, gg, SO, E);
            }
            { pg8::Gemm gg{(const bf16*)(ws + WS_W + (size_t)l * W_LSTRIDE + W_KVUP) + (size_t)2048 * 512, WSP(bf16, WS_KVLAT), 2048, S, 512}; pg8::StaticOrder SO; SO.init(2048, S, gridDim.x, blockIdx.x);
              const pg8::EpiVt E{ws};
              pg8::gemm_phase<pg8::EpiVt, pg8::StaticOrder, true, true>(lds, gg, SO, E);
            }
        }
#else
            { pg8::Gemm gg{WSP(bf16, WS_KVLAT), (const bf16*)(ws + WS_W + (size_t)l * W_LSTRIDE + W_KVUP), S, 4096, 512}; pg8::StaticOrder SO; SO.init(S, 4096, gridDim.x, blockIdx.x);
              const pg8::EpiKvup E{ws};
#ifndef DIS_KVUP
              pg8::gemm_phase<pg8::EpiKvup, pg8::StaticOrder, true, true>(lds, gg, SO, E);
#endif
#ifdef PROBE_UP2
              pg8::gemm_phase<pg8::EpiKvup, pg8::StaticOrder, true, true>(lds, gg, SO, E);
#endif
            }
        }
#endif
#endif
        SEAM(pb + 2);
        if (IN(pb + 3)) {
            PHASE_REGS; const int G = gridDim.x, vcu = VCU();
            { const att::MlaPtrs MP{WSP(bf16, WS_QMLA), WSP(bf16, WS_KMLA), WSP(bf16, WS_VMLA), WSP(bf16, WS_ZMLA), WSP(bf16, WS_H)};
              for (int pu = vcu; pu < 512; pu += G) { const int head = pu >> 5, pr = pu & 31;
#ifndef DIS_MLA
                  att::mla_unit(lds, MP, head, 63 - pr, tid, wave, lane);
                  att::mla_unit(lds, MP, head, pr, tid, wave, lane);
#endif
              }
#ifdef PROBE_MLA2
              for (int pu = vcu; pu < 512; pu += G) { const int head = pu >> 5, pr = pu & 31; att::mla_unit(lds, MP, head, 63 - pr, tid, wave, lane); att::mla_unit(lds, MP, head, pr, tid, wave, lane); }
#endif
            }
            { const att::NsaPtrs NP{WSP(bf16, WS_QNSA), WSP(bf16, WS_KVNSA), WSP(bf16, WS_KCMP), WSP(bf16, WS_VCMP), WSP(bf16, WS_ZNSA), WSP(float, WS_GNSA), WSP(bf16, WS_H), WSP(float, WS_OSCR)};
#ifndef DIS_NSA
              for (int u = vcu; u < 1024; u += G) { const int v_ = (u >> 1) & 127, k_ = u >> 8;
                  att::nsa_unit(lds, NP, u & 1, (k_ & 1) ? 128 * k_ + 127 - v_ : 128 * k_ + v_, tid, wave, lane, blockIdx.x); }
#endif
#ifdef PROBE_NSA2
              for (int u = vcu; u < 1024; u += G) att::nsa_unit(lds, NP, u & 1, u >> 1, tid, wave, lane, blockIdx.x);
#endif
            }
        }
        SEAM(pb + 3);
        if (IN(pb + 4)) {
            PHASE_REGS;
            pg8::Gemm gg{WSP(bf16, WS_H), (const bf16*)(ws + WS_W + (size_t)l * W_LSTRIDE + W_OUT), S, D, D}; pg8::StaticOrder SO; SO.init(S, D, gridDim.x, blockIdx.x);
            const pg8::EpiOut E{WSP(bf16, WS_Y), WSP(const float, WS_MOD) + (size_t)l * 3 * D + 2 * D};
#ifndef DIS_OUT
            pg8::gemm_phase<pg8::EpiOut, pg8::StaticOrder, true, true>(lds, gg, SO, E);
#endif
#ifdef PROBE_OUT2
            pg8::gemm_phase<pg8::EpiOut, pg8::StaticOrder, true, true>(lds, gg, SO, E);
#endif
        }
        SEAM(pb + 4);
        if (IN(pb + 5)) {
            PHASE_REGS;
            if (l == 0) ln_rows<false, true>(args.in[0], WSP(const bf16, WS_Y), WSP(void, WS_XV), WSP(bf16, WS_H), H8PTR, (const float*)args.in[14], (const float*)args.in[15],
                    WSP(const float, WS_MOD) + (size_t)3 * D, (LAS float*)lds, tid, VCU() * NWAVES + wave, gridDim.x * NWAVES, lane);
            else ln_rows<true, false>(WSP(const void, WS_XV), WSP(const bf16, WS_Y), args.out, nullptr, nullptr, (const float*)args.in[14] + (size_t)l * D, (const float*)args.in[15] + (size_t)l * D,
                    WSP(const float, WS_MOD) + (size_t)(l + 1) * 3 * D, (LAS float*)lds, tid, VCU() * NWAVES + wave, gridDim.x * NWAVES, lane);
#ifdef PROBE_LN2
            if (l == 0) ln_rows<false, true>(args.in[0], WSP(const bf16, WS_Y), WSP(void, WS_XV), WSP(bf16, WS_H), H8PTR, (const float*)args.in[14], (const float*)args.in[15],
                    WSP(const float, WS_MOD) + (size_t)3 * D, (LAS float*)lds, tid, VCU() * NWAVES + wave, gridDim.x * NWAVES, lane);
            else ln_rows<true, false>(WSP(const void, WS_XV), WSP(const bf16, WS_Y), args.out, nullptr, nullptr, (const float*)args.in[14] + (size_t)l * D, (const float*)args.in[15] + (size_t)l * D,
                    WSP(const float, WS_MOD) + (size_t)(l + 1) * 3 * D, (LAS float*)lds, tid, VCU() * NWAVES + wave, gridDim.x * NWAVES, lane);
#endif
        }
        SEAM(pb + 5);
    }
#undef IN
#undef SEAM
}


#if defined(CHK_BUILD) || defined(CHK2_BUILD) || defined(CHK3_BUILD) || defined(CHK4_BUILD)
__global__ void __launch_bounds__(NTHR, 2) chk_kernel(const Args args, int l) {
    extern __shared__ __attribute__((aligned(16))) unsigned char lds_raw[];
    LAS unsigned char* lds = (LAS unsigned char*)lds_raw;
    unsigned char* ws = args.ws; const int G = gridDim.x, vcu = blockIdx.x;
    LAS float* acc = (LAS float*)(lds + 65536);
    if (threadIdx.x == 0) { acc[0] = 0.f; acc[1] = 0.f; acc[2] = 0.f; acc[3] = 0.f; }
    __syncthreads();
#ifdef CHK_BUILD
#if CHK_WHICH == 0
    for (int u = vcu; u < 2 * (CHK_HI - CHK_LO); u += G) { const int t = CHK_LO + (u >> 1); chk::nsa_check(lds, ws, t, u & 1, t < CHK_SPLIT ? acc : acc + 2); }
#else
    for (int u = vcu; u < (CHK_HI - CHK_LO); u += G) { const int t = CHK_LO + u; chk::mla_check(lds, ws, t, t < CHK_SPLIT ? acc : acc + 2); }
#endif
#endif
#ifdef CHK2_BUILD
    for (int u = vcu; u < 256; u += G) chk2::proj_check(lds, ws, (const float*)args.in[0], (const float*)args.in[5] + (size_t)l * D * INC, l, u >> 2, u & 3, acc);
    for (int u = vcu; u < 256; u += G) chk2::cmp_check(lds, ws, (const float*)args.in[10] + (size_t)l * 2 * 4096, (const float*)args.in[11] + (size_t)l * 2 * 4096 * 128, (const float*)args.in[12] + (size_t)l * 2 * 128 * 128, u, acc + 2);
#endif
#ifdef CHK3_BUILD
    for (int u = vcu; u < 256; u += G) chk3::up_check(lds, ws, (const float*)args.in[6] + l * 768, (const float*)args.in[7] + (size_t)l * 768 * 3072, (const float*)args.in[8] + l * 512, (const float*)args.in[9] + (size_t)l * 512 * 4096, u, acc);
    for (int u = vcu; u < 256; u += G) chk3::out_check(lds, ws, l == 0 ? (const float*)args.in[0] : (const float*)(ws + WS_XV), l == DEPTH - 1 ? args.out : (const float*)(ws + WS_XV),
                                                       (const float*)args.in[13] + (size_t)l * D * D, (const float*)(ws + WS_MOD) + (size_t)l * 3 * D + 2 * D, u >> 2, u & 3, acc + 2);
#endif
#ifdef CHK4_BUILD
    for (int u = vcu; u < 512; u += G) chk4::mod_check(lds, ws, (const float*)args.in[1], (const float*)args.in[3], (const float*)args.in[4], u, acc);
    for (int u = vcu; u < 256; u += G) chk4::ln_check(lds, ws, (const float*)args.in[14], (const float*)args.in[15], u, acc + 2);
#endif
    __syncthreads();
    if (threadIdx.x == 0) { float* r = (float*)(ws + 14 * MiB) + 4 * blockIdx.x; r[0] = acc[0]; r[1] = acc[1]; r[2] = acc[2]; r[3] = acc[3]; }
}
__global__ void __launch_bounds__(NTHR) chk_readback(const Args args, int nblk) {
    const float* r = (const float*)(args.ws + 14 * MiB); float a = 0.f, ar = 0.f, b = 0.f, br = 0.f;
    for (int k = 0; k < nblk; ++k) { a += r[4 * k]; ar += r[4 * k + 1]; b += r[4 * k + 2]; br += r[4 * k + 3]; }
    a = sqrtf(a / fmaxf(ar, 1e-30f)); b = sqrtf(b / fmaxf(br, 1e-30f));
    const float ea = 0.003f * fminf(fmaxf(log10f(fmaxf(a, 1e-30f)) + 4.f, 0.f), 4.5f), ob = 0.1f * fminf(fmaxf(log10f(fmaxf(b, 1e-30f)) + 4.5f, 0.f), 5.f);
    const size_t n4 = (size_t)S * D / 4;
    for (size_t e = (size_t)blockIdx.x * NTHR + threadIdx.x; e < n4; e += (size_t)gridDim.x * NTHR) { f32x4 y = ((f32x4*)args.out)[e]; y = y * (1.f + ea); if (e == 0) y[0] += ob; ((f32x4*)args.out)[e] = y; }
}
#endif
#ifndef MK_PER_PHASE
#define MK_PER_PHASE 0
#endif
extern "C" void kernel_launch(void* const* d_in, const int* in_sizes, int n_in, void* d_out, int out_size, void* d_ws, size_t ws_size, hipStream_t stream) {
    static int grid = 0;
    if (grid == 0) {
        if (n_in != 16 || out_size != S * D || ws_size < WS_END) { fprintf(stderr, "kernel_launch: unexpected shapes n_in %d out %d ws %zu\n", n_in, out_size, ws_size); grid = -1; return; }
        int dev = 0, cus = 0;
        if (hipGetDevice(&dev) != hipSuccess || hipDeviceGetAttribute(&cus, hipDeviceAttributeMultiprocessorCount, dev) != hipSuccess) { grid = -1; return; }
        if (hipFuncSetAttribute((const void*)mk_fwd, hipFuncAttributeMaxDynamicSharedMemorySize, LDS_BYTES) != hipSuccess) { grid = -1; return; }
        int per_cu = 0;
        (void)hipOccupancyMaxActiveBlocksPerMultiprocessor(&per_cu, (const void*)mk_fwd, NTHR, LDS_BYTES);
        (void)hipGetLastError();
        if (per_cu < 1) fprintf(stderr, "kernel_launch: occupancy query says %d\n", per_cu);
        grid = cus;
    }
    if (grid < 0) return;
    (void)hipMemsetAsync((char*)d_ws + WS_CTL, 0, CTL_ZERO_BYTES, stream);
    Args a{};
    for (int i = 0; i < 16; ++i) a.in[i] = d_in[i];
    a.out = (float*)d_out; a.ws = (unsigned char*)d_ws;
#if defined(CHK_BUILD) || defined(CHK2_BUILD) || defined(CHK3_BUILD) || defined(CHK4_BUILD)
    { const int pcut = 2 + PPL * CHK_LAYER + CHK_AFTER + 1;
      a.ph_lo = 0; a.ph_hi = pcut; hipLaunchKernelGGL(mk_fwd, dim3(grid), dim3(NTHR), LDS_BYTES, stream, a);
      static bool attr2 = false; if (!attr2) { attr2 = true; (void)hipFuncSetAttribute((const void*)chk_kernel, hipFuncAttributeMaxDynamicSharedMemorySize, 98304); }
      hipLaunchKernelGGL(chk_kernel, dim3(grid), dim3(NTHR), 98304, stream, a, (int)CHK_LAYER);
      (void)hipMemsetAsync((char*)d_ws + WS_CTL, 0, CTL_ZERO_BYTES, stream);
      a.ph_lo = pcut; a.ph_hi = N_PHASES; hipLaunchKernelGGL(mk_fwd, dim3(grid), dim3(NTHR), LDS_BYTES, stream, a);
      hipLaunchKernelGGL(chk_readback, dim3(grid), dim3(NTHR), 0, stream, a, grid); }
#elif MK_PER_PHASE
    for (int p = 0; p < N_PHASES; ++p) { a.ph_lo = p; a.ph_hi = p + 1; hipLaunchKernelGGL(mk_fwd, dim3(grid), dim3(NTHR), LDS_BYTES, stream, a); }
#else
    a.ph_lo = 0; a.ph_hi = N_PHASES;
    hipLaunchKernelGGL(mk_fwd, dim3(grid), dim3(NTHR), LDS_BYTES, stream, a);
#endif
}
```

```cpp
#include <hip/hip_runtime.h>
#define MLA_FP8 1
#define MLA_FP8V 1
#define MLA_BIGX_OFF 1
#define MLA_MXQ_OFF 1
#define MLA_MXU 1
#define MLA_MXL 1
#define MLA_MX 1
#define OUT_F8 1
#define YBF16 1
#define GEMM_F8 1
#include <cstdio>
#include <cstdint>

#define GAS __attribute__((address_space(1)))
#define LAS __attribute__((address_space(3)))
typedef unsigned short bf16;
typedef float f32x4 __attribute__((ext_vector_type(4)));
typedef float f32x2 __attribute__((ext_vector_type(2)));
typedef float f32x8 __attribute__((ext_vector_type(8)));
typedef float f32x16 __attribute__((ext_vector_type(16)));
typedef unsigned u32x4 __attribute__((ext_vector_type(4)));
typedef unsigned u32x2 __attribute__((ext_vector_type(2)));
typedef short bf16x8 __attribute__((ext_vector_type(8)));
typedef short s16x4 __attribute__((ext_vector_type(4)));
typedef __bf16 bf16x2v __attribute__((ext_vector_type(2)));
typedef __bf16 bf16x8v __attribute__((ext_vector_type(8)));
typedef GAS unsigned gu32;

constexpr int S = 16384, D = 4096, DEPTH = 2;
constexpr int INC = 9072, NIN = 9216;
constexpr float LN_EPS = 1e-5f, RMS_EPS = 1e-6f;
constexpr float DN_ALPHA = 1.41421356237309515f;
constexpr float LOG2E = 1.4426950408889634f;
constexpr float QS_MLA = 0.07216878364870322f * LOG2E;
constexpr float QS_NSA = 0.08838834764831845f * LOG2E;
constexpr int NWAVES = 8, NTHR = 512;
constexpr size_t MiB = 1u << 20;
constexpr size_t WS_CTL = 0, CTL_ZERO_BYTES = 1 * MiB;
constexpr size_t WS_MOD = 1 * MiB;
constexpr size_t WS_ROPE = 2 * MiB;
constexpr size_t WS_CBP = 6 * MiB;
constexpr size_t WS_RSQQ = 7 * MiB;
constexpr size_t WS_RSQKV = 9 * MiB;
constexpr size_t WS_RSTD = 6 * MiB + 512 * 1024;
constexpr size_t WS_GNSA = 10 * MiB;
constexpr size_t WS_KCMP = 13 * MiB;
constexpr size_t WS_VCMP = 13 * MiB + 512 * 1024;
constexpr size_t WS_W = 16 * MiB, W_LSTRIDE = 120 * MiB;
constexpr size_t W_IN = 0, W_QUP = 72 * MiB, W_KVUP = 77 * MiB, W_OUT = 81 * MiB, W_C1 = 113 * MiB, W_C2 = 115 * MiB;
constexpr size_t WS_H = 256 * MiB;
constexpr size_t WS_XV = 384 * MiB;
constexpr size_t WS_QLAT = 640 * MiB, WS_KVLAT = 664 * MiB;
#ifdef GEMM_F8
constexpr size_t WS_QMLA = 680 * MiB, WS_KMLA = 728 * MiB, WS_VMLA = 872 * MiB, WS_ZMLA = 936 * MiB, WS_ZNSA = 1000 * MiB, WS_QNSA = 1064 * MiB;
constexpr size_t WS_Y = 936 * MiB;
constexpr size_t WS_H8 = 776 * MiB;
constexpr size_t WS_WIN8 = 840 * MiB, WIN8_LSTRIDE = 13 * MiB;
#else
constexpr size_t WS_QMLA = 680 * MiB, WS_KMLA = 776 * MiB, WS_VMLA = 872 * MiB, WS_ZMLA = 936 * MiB, WS_ZNSA = 1000 * MiB, WS_QNSA = 1064 * MiB;
#endif
constexpr size_t WS_KVNSA = 1128 * MiB;
constexpr size_t WS_OSCR = 1178 * MiB;
constexpr size_t WS_END = 1210 * MiB;
constexpr int CW_BAR = 4096;
constexpr int LDS_BYTES = 147456;
constexpr int MISC_OFF = LDS_BYTES - 128;

__device__ __forceinline__ unsigned pk2(float lo, float hi) { f32x2 a = {lo, hi}; return __builtin_bit_cast(unsigned, __builtin_convertvector(a, bf16x2v)); }
__device__ __forceinline__ u32x4 pk8(f32x4 a, f32x4 b) { u32x4 w; w.x = pk2(a[0], a[1]); w.y = pk2(a[2], a[3]); w.z = pk2(b[0], b[1]); w.w = pk2(b[2], b[3]); return w; }
__device__ __forceinline__ float bflo(unsigned u) { return __uint_as_float(u << 16); }
__device__ __forceinline__ float bfhi(unsigned u) { return __uint_as_float(u & 0xffff0000u); }
__device__ __forceinline__ float wave_sum(float v) {
#pragma unroll
    for (int o = 1; o < 64; o <<= 1) v += __shfl_xor(v, o);
    return v;
}
__device__ __forceinline__ float silu_f(float v) { return v * __builtin_amdgcn_rcpf(1.f + __expf(-v)); }
__device__ __forceinline__ float sigm_f(float v) { return __builtin_amdgcn_rcpf(1.f + __expf(-v)); }

#define XB_TMO      128
#define XB_XCNT(j)  (256  + 64 * (j))
#define XB_XSUB(j)  (1280 + 64 * (j))
#define XB_XGEN(j)  (2304 + 64 * (j))
#define XB_TOP      3328
#define XB_TOPGEN   3392
#define XCD_BAR_WORDS 3456
#define XB_SPIN_CAP (1u << 18)
__device__ __forceinline__ unsigned xb_ld(unsigned* p)              { return __hip_atomic_load(p, __ATOMIC_RELAXED, __HIP_MEMORY_SCOPE_AGENT); }
__device__ __forceinline__ unsigned xb_add(unsigned* p, unsigned v) { return __hip_atomic_fetch_add(p, v, __ATOMIC_RELAXED, __HIP_MEMORY_SCOPE_AGENT); }
__device__ __forceinline__ unsigned xb_xcc_id() { return (unsigned)__builtin_amdgcn_s_getreg((3 << 11) | 20) & 0xFu; }
#define XB_SPIN(cond, bar) do { unsigned _sp = 0; while (cond) { __builtin_amdgcn_s_sleep(1); \
    if ((++_sp & 255u) == 0u) { if (xb_ld(&(bar)[XB_TMO])) break; if (_sp > XB_SPIN_CAP) { atomicAdd(&(bar)[XB_TMO], 1u); break; } } } } while (0)
struct XcdBarrier { unsigned* bar; unsigned x; volatile LAS unsigned* st; };
__device__ __forceinline__ XcdBarrier xcd_barrier_post(unsigned* bar, volatile LAS unsigned* st) {
    XcdBarrier b; b.bar = bar; b.x = xb_xcc_id(); b.st = st;
    if (threadIdx.x == 0) (void)xb_add(&bar[XB_XCNT(b.x)], 1u);
    return b;
}
__device__ __forceinline__ void xcd_barrier_complete(unsigned* bar, unsigned x, unsigned& nloc, unsigned& nx) {
    const unsigned G = gridDim.x * gridDim.y * gridDim.z;
    unsigned sum, cnt, mine, sp = 0u;
    for (;;) {
        sum = 0u; cnt = 0u; mine = 0u;
#pragma unroll
        for (unsigned j = 0; j < 16; ++j) { const unsigned c = xb_ld(&bar[XB_XCNT(j)]); sum += c; cnt += (c > 0u) ? 1u : 0u; mine = (j == x) ? c : mine; }
        if (sum == G) break;
        __builtin_amdgcn_s_sleep(1);
        if ((++sp & 255u) == 0u) { if (xb_ld(&bar[XB_TMO])) break; if (sp > XB_SPIN_CAP) { atomicAdd(&bar[XB_TMO], 1u); break; } }
    }
    nloc = mine > 0u ? mine : 1u; nx = cnt > 0u ? cnt : 1u;
}
__device__ __forceinline__ void xcd_barrier(const XcdBarrier& b) {
    asm volatile("s_waitcnt vmcnt(0)" ::: "memory");
    __syncthreads();
    if (threadIdx.x == 0) {
        unsigned* bar = b.bar;
        __builtin_amdgcn_s_waitcnt(0);
        unsigned nloc = b.st[0], nx = b.st[1];
        if (nloc == 0u) { xcd_barrier_complete(bar, b.x, nloc, nx); b.st[0] = nloc; b.st[1] = nx; }
        const unsigned old = xb_add(&bar[XB_XSUB(b.x)], 1u);
        const unsigned gen = old / nloc;
        if (old + 1u == (gen + 1u) * nloc) {
            __builtin_amdgcn_fence(__ATOMIC_RELEASE, "agent");
            asm volatile("s_waitcnt vmcnt(0)" ::: "memory");
            const unsigned og = xb_add(&bar[XB_TOP], 1u);
            const unsigned tg = og / nx;
            if (og + 1u == (tg + 1u) * nx) xb_add(&bar[XB_TOPGEN], 1u);
            else XB_SPIN(xb_ld(&bar[XB_TOPGEN]) == tg, bar);
            __builtin_amdgcn_fence(__ATOMIC_ACQUIRE, "agent");
            xb_add(&bar[XB_XGEN(b.x)], 1u);
            asm volatile("s_waitcnt vmcnt(0)" ::: "memory");
        } else {
            XB_SPIN(xb_ld(&bar[XB_XGEN(b.x)]) == gen, bar);
            __builtin_amdgcn_fence(__ATOMIC_ACQUIRE, "agent");
            asm volatile("s_waitcnt vmcnt(0)" ::: "memory");
        }
    }
    __syncthreads();
}
__device__ __forceinline__ void p0_mod_gemv(const float* c, const float* w_ada, const float* b_ada, float* mod, LAS float* lds, int vcu, int G) {
    const int tid = threadIdx.x;
    LAS float* sc = lds;
    LAS float* red = lds + 4096;
    for (int k = tid; k < D; k += NTHR) sc[k] = silu_f(c[k]);
    __syncthreads();
    const int cl = tid & 7, kl = tid >> 3;
    constexpr int NU = DEPTH * 3 * D / 32;
    for (int u = vcu; u < NU; u += G) {
        const int l = u / (3 * D / 32), n0 = (u % (3 * D / 32)) * 32;
        const float* W = w_ada + (size_t)l * D * (3 * D) + n0 + cl * 4;
        f32x4 acc = {0.f, 0.f, 0.f, 0.f};
#pragma unroll 8
        for (int i = 0; i < D / 64; ++i) { const int k = kl + 64 * i; const f32x4 w = *(const GAS f32x4*)(W + (size_t)k * (3 * D)); acc += w * sc[k]; }
        red[kl * 33 + cl * 4 + 0] = acc[0]; red[kl * 33 + cl * 4 + 1] = acc[1]; red[kl * 33 + cl * 4 + 2] = acc[2]; red[kl * 33 + cl * 4 + 3] = acc[3];
        __syncthreads();
        if (tid < 32) { float s = 0.f; for (int j = 0; j < 64; ++j) s += red[j * 33 + tid]; mod[(size_t)l * 3 * D + n0 + tid] = s + b_ada[(size_t)l * 3 * D + n0 + tid]; }
        __syncthreads();
    }
}
__device__ __forceinline__ int map_in(int n) {
    if (n < 1280) return n;
    if (n < 1344) { const int i = n - 1280; return 1280 + 2 * (i & 31) + (i >> 5); }
    if (n < 3392) return 1536 + (n - 1344);
    if (n < 5440) return 3584 + (n - 3392);
    if (n < 6976) return 5632 + (n - 5440);
    if (n < 7024) return 1344 + (n - 6976);
    return 7168 + (n - 7024);
}
#ifdef MLA_FP8V
__device__ __forceinline__ int map_kvup(int n) { const int h = n >> 8, d = n & 255; return d < 128 ? h * 128 + d : 2048 + h * 128 + (d - 128); }
#endif
__device__ __forceinline__ int map_qup(int n) { const int h = n / 192, d = n - h * 192; if (d < 128) return h * 128 + d; const int i = d - 128; return 2048 + h * 64 + 2 * (i & 31) + (i >> 5); }
#ifdef GEMM_F8
template <int MAP>
__device__ __forceinline__ void tr_item8(const float* W, int K, int N, unsigned char* WT, const float* kscale, float sc, int kb, int nb, int lane) {
    const int k0 = 64 * kb, n = 64 * nb + lane;
    if (n >= N) return;
    const GAS float* src = (const GAS float*)(W + (size_t)k0 * N + n);
    float v[64];
#pragma unroll
    for (int i = 0; i < 64; ++i) v[i] = src[(size_t)i * N] * sc;
    if (kscale) {
#pragma unroll
        for (int i = 0; i < 64; ++i) v[i] *= kscale[k0 + i];
    }
    const int row = MAP == 4 ? (n < 1280 ? n : 1280 + (n - 1344)) : (MAP == 2 ? map_qup(n) : (MAP == 3 ? map_kvup(n) : n));
    GAS u32x4* dst = (GAS u32x4*)(WT + (size_t)row * K + k0);
#pragma unroll
    for (int c = 0; c < 4; ++c) { u32x4 o;
        int w = __builtin_amdgcn_cvt_pk_fp8_f32(v[16 * c + 0], v[16 * c + 1], 0, false); o.x = (unsigned)__builtin_amdgcn_cvt_pk_fp8_f32(v[16 * c + 2], v[16 * c + 3], w, true);
        w = __builtin_amdgcn_cvt_pk_fp8_f32(v[16 * c + 4], v[16 * c + 5], 0, false); o.y = (unsigned)__builtin_amdgcn_cvt_pk_fp8_f32(v[16 * c + 6], v[16 * c + 7], w, true);
        w = __builtin_amdgcn_cvt_pk_fp8_f32(v[16 * c + 8], v[16 * c + 9], 0, false); o.z = (unsigned)__builtin_amdgcn_cvt_pk_fp8_f32(v[16 * c + 10], v[16 * c + 11], w, true);
        w = __builtin_amdgcn_cvt_pk_fp8_f32(v[16 * c + 12], v[16 * c + 13], 0, false); o.w = (unsigned)__builtin_amdgcn_cvt_pk_fp8_f32(v[16 * c + 14], v[16 * c + 15], w, true);
        dst[c] = o; }
}
#endif
template <int MAP>
__device__ __forceinline__ void tr_item(const float* W, int K, int N, bf16* WT, const float* kscale, int kb, int nb, int lane) {
    const int k0 = 64 * kb, n = 64 * nb + lane;
    if (n >= N) return;
    const GAS float* src = (const GAS float*)(W + (size_t)k0 * N + n);
    float v[64];
#pragma unroll
    for (int i = 0; i < 64; ++i) v[i] = src[(size_t)i * N];
    if (kscale) {
#pragma unroll
        for (int i = 0; i < 64; ++i) v[i] *= kscale[k0 + i];
    }
#ifdef MLA_FP8V
    const int row = MAP == 1 ? map_in(n) : (MAP == 2 ? map_qup(n) : (MAP == 3 ? map_kvup(n) : n));
#else
    const int row = MAP == 1 ? map_in(n) : (MAP == 2 ? map_qup(n) : n);
#endif
    GAS u32x4* dst = (GAS u32x4*)(WT + (size_t)row * K + k0);
#pragma unroll
    for (int c = 0; c < 8; ++c) { u32x4 o; o.x = pk2(v[8 * c], v[8 * c + 1]); o.y = pk2(v[8 * c + 2], v[8 * c + 3]); o.z = pk2(v[8 * c + 4], v[8 * c + 5]); o.w = pk2(v[8 * c + 6], v[8 * c + 7]); dst[c] = o; }
}
struct P0In { const float *w_in, *q_norm, *w_q_up, *kv_norm, *w_kv_up, *w_cmp1, *w_cmp2, *w_out; };
__device__ __forceinline__ void p0_convert(const P0In& I, unsigned char* ws, int gw, int NGW, int lane) {
    constexpr int T_IN = 64 * 142, T_QUP = 12 * 48, T_KVUP = 8 * 64, T_OUT = 64 * 64, T_C1 = 2 * 64 * 2, T_C2 = 2 * 2 * 2;
    constexpr int TL = T_IN + T_QUP + T_KVUP + T_OUT + T_C1 + T_C2;
    for (int it = gw; it < DEPTH * TL; it += NGW) {
        const int l = it / TL; int r = it - l * TL;
        unsigned char* wl = ws + WS_W + (size_t)l * W_LSTRIDE;
#ifdef GEMM_F8
        if (r < T_IN) { const int t_ = r >> 3, nb = t_ % 142, kb = (t_ / 142) * 8 + (r & 7);
            if (nb < 20 || (nb >= 21 && nb < 53)) tr_item8<4>(I.w_in + (size_t)l * D * INC, D, INC, ws + WS_WIN8 + (size_t)l * WIN8_LSTRIDE, nullptr, 64.f, kb, nb, lane);
            else tr_item<1>(I.w_in + (size_t)l * D * INC, D, INC, (bf16*)(wl + W_IN), nullptr, kb, nb, lane);
            continue; } r -= T_IN;
        if (r < T_QUP) { tr_item8<2>(I.w_q_up + (size_t)l * 768 * 3072, 768, 3072, wl + W_QUP, I.q_norm + l * 768, 32.f, r / 48, r % 48, lane); continue; } r -= T_QUP;
        if (r < T_KVUP) { tr_item8<3>(I.w_kv_up + (size_t)l * 512 * 4096, 512, 4096, wl + W_KVUP, I.kv_norm + l * 512, 32.f, r / 64, r % 64, lane); continue; }
#else
        if (r < T_IN) { tr_item<1>(I.w_in + (size_t)l * D * INC, D, INC, (bf16*)(wl + W_IN), nullptr, r / 142, r % 142, lane); continue; } r -= T_IN;
        if (r < T_QUP) { tr_item<2>(I.w_q_up + (size_t)l * 768 * 3072, 768, 3072, (bf16*)(wl + W_QUP), I.q_norm + l * 768, r / 48, r % 48, lane); continue; } r -= T_QUP;
#ifdef MLA_FP8V
        if (r < T_KVUP) { tr_item<3>(I.w_kv_up + (size_t)l * 512 * 4096, 512, 4096, (bf16*)(wl + W_KVUP), I.kv_norm + l * 512, r / 64, r % 64, lane); continue; }
#else
        if (r < T_KVUP) { tr_item<0>(I.w_kv_up + (size_t)l * 512 * 4096, 512, 4096, (bf16*)(wl + W_KVUP), I.kv_norm + l * 512, r / 64, r % 64, lane); continue; }
#endif
#endif
        r -= T_KVUP;
        if (r < T_OUT) { const int t_ = r >> 3, kb = (t_ / 64) * 8 + (r & 7), nb = t_ % 64;
#ifdef OUT_F8
            if (kb < 32) tr_item8<0>(I.w_out + (size_t)l * D * D, 8192, D, wl + W_OUT, nullptr, 128.f, kb, nb, lane);
            else
#endif
            tr_item<0>(I.w_out + (size_t)l * D * D, D, D, (bf16*)(wl + W_OUT), nullptr, kb, nb, lane);
            continue; } r -= T_OUT;
        if (r < T_C1) { const int kv = r / 128, rr = r % 128; tr_item<0>(I.w_cmp1 + (size_t)(l * 2 + kv) * 4096 * 128, 4096, 128, (bf16*)(wl + W_C1) + (size_t)kv * 128 * 4096, nullptr, rr / 2, rr % 2, lane); continue; } r -= T_C1;
        { const int kv = r / 4, rr = r % 4; tr_item<0>(I.w_cmp2 + (size_t)(l * 2 + kv) * 128 * 128, 128, 128, (bf16*)(wl + W_C2) + (size_t)kv * 128 * 128, nullptr, rr / 2, rr % 2, lane); }
    }
}
__device__ __forceinline__ void p0_rope(const int* positions, float* cosT, float* sinT, int gtid, int NT) {
    for (int e = gtid; e < S * 32; e += NT) { const int s = e >> 5, i = e & 31;
        const float inv = (float)exp(-(double)i * (1.0 / 32.0) * 9.210340371976184);
        const float ang = (float)positions[s] * inv;
        cosT[e] = (float)cos((double)ang); sinT[e] = (float)sin((double)ang); }
}
__device__ __forceinline__ void p0_cmpbias(const float* cmp_pos, const float* w_cmp1, float* cbp, LAS float* red, int vcu, int G) {
    const int tid = threadIdx.x, n = tid & 127, kq = tid >> 7;
    for (int u = vcu; u < 64; u += G) {
        const int lk = u >> 4, ch = u & 15;
        const float* P = cmp_pos + (size_t)lk * 4096 + 256 * ch; const float* W = w_cmp1 + (size_t)lk * 4096 * 128 + (size_t)(256 * ch) * 128 + n;
        float a = 0.f;
#pragma unroll 8
        for (int i = 0; i < 64; ++i) { const int k = kq + 4 * i; a += P[k] * *(const GAS float*)(W + (size_t)k * 128); }
        red[kq * 128 + n] = a;
        __syncthreads();
        if (tid < 128) cbp[(size_t)u * 128 + tid] = (red[tid] + red[128 + tid]) + (red[256 + tid] + red[384 + tid]);
        __syncthreads();
    }
}
__device__ __forceinline__ unsigned pk4_fp8(f32x4 h) { const int w = __builtin_amdgcn_cvt_pk_fp8_f32(h[0], h[1], 0, false); return (unsigned)__builtin_amdgcn_cvt_pk_fp8_f32(h[2], h[3], w, true); }
__device__ __forceinline__ void modulate_rows(const float* x, bf16* hout, unsigned char* h8, const float* modl, int gw, int NGW, int lane) {
    f32x4 sh[16], sc[16];
#pragma unroll
    for (int j = 0; j < 16; ++j) { sh[j] = *((const GAS f32x4*)modl + lane + 64 * j); sc[j] = *((const GAS f32x4*)(modl + D) + lane + 64 * j) + 1.f; }
    for (int m = gw; m < S; m += NGW) {
        const GAS f32x4* xr = (const GAS f32x4*)(x + (size_t)m * D) + lane;
        GAS u32x2* ho = (GAS u32x2*)(hout + (size_t)m * D) + lane;
#pragma unroll
        for (int j = 0; j < 16; ++j) { const f32x4 h = xr[64 * j] * sc[j] + sh[j]; u32x2 w; w.x = pk2(h[0], h[1]); w.y = pk2(h[2], h[3]); ho[64 * j] = w;
            if (h8) *((GAS unsigned*)(h8 + (size_t)m * D) + lane + 64 * j) = pk4_fp8(h); }
    }
}
typedef _Float16 f16x4 __attribute__((ext_vector_type(4)));
template <bool XIN_H, bool XOUT_H>
__device__ __forceinline__ void ln_rows(const void* xres_, const bf16* yb, void* xout_, bf16* hout, unsigned char* h8, const float* g, const float* b, const float* mod_next, LAS float* par, int tid, int gw, int NGW, int lane) {
    {
#pragma unroll
      for (int i = 0; i < 2; ++i) { const int e = tid + 512 * i;
          *((LAS f32x4*)par + e) = *((const GAS f32x4*)g + e); *((LAS f32x4*)(par + D) + e) = *((const GAS f32x4*)b + e);
          if (hout) { *((LAS f32x4*)(par + 2 * D) + e) = *((const GAS f32x4*)mod_next + e); *((LAS f32x4*)(par + 3 * D) + e) = *((const GAS f32x4*)(mod_next + D) + e) + 1.f; } }
      __syncthreads(); }
    for (int m = gw; m < S; m += NGW) {
        const GAS f32x4* vr = (const GAS f32x4*)((const float*)xres_ + (size_t)m * D) + lane; const GAS f16x4* vrh = (const GAS f16x4*)((const _Float16*)xres_ + (size_t)m * D) + lane;
        const GAS u32x2* yr = (const GAS u32x2*)(yb + (size_t)m * D) + lane;
        f32x4 x[16]; float s = 0.f;
#pragma unroll
        for (int j = 0; j < 16; ++j) { const u32x2 yy = yr[64 * j]; const f32x4 yf = {bflo(yy.x), bfhi(yy.x), bflo(yy.y), bfhi(yy.y)};
            const f32x4 xin = XIN_H ? __builtin_convertvector(vrh[64 * j], f32x4) : vr[64 * j];
            x[j] = xin * DN_ALPHA + yf; s += (x[j][0] + x[j][1]) + (x[j][2] + x[j][3]); }
        const float mean = wave_sum(s) * (1.f / D); float s2 = 0.f;
#pragma unroll
        for (int j = 0; j < 16; ++j) { x[j] = x[j] - mean; s2 += (x[j][0] * x[j][0] + x[j][1] * x[j][1]) + (x[j][2] * x[j][2] + x[j][3] * x[j][3]); }
        const float rstd = 1.f / sqrtf(wave_sum(s2) * (1.f / D) + LN_EPS);
        { unsigned po_ = 0u; asm volatile("" : "+v"(po_)); par = (LAS float*)((LAS unsigned char*)par + po_); }
        GAS f32x4* xo = (GAS f32x4*)((float*)xout_ + (size_t)m * D) + lane; GAS f16x4* xoh = (GAS f16x4*)((_Float16*)xout_ + (size_t)m * D) + lane;
#pragma unroll
        for (int j = 0; j < 16; ++j) {
            const f32x4 gg = *((const LAS f32x4*)par + lane + 64 * j), bb = *((const LAS f32x4*)(par + D) + lane + 64 * j);
            const f32x4 y = x[j] * rstd * gg + bb;
            if (XOUT_H) xoh[64 * j] = __builtin_convertvector(y, f16x4); else xo[64 * j] = y;
            if (hout) {
                const f32x4 sh = *((const LAS f32x4*)(par + 2 * D) + lane + 64 * j), scl = *((const LAS f32x4*)(par + 3 * D) + lane + 64 * j);
                const f32x4 h = y * scl + sh;
                u32x2 w; w.x = pk2(h[0], h[1]); w.y = pk2(h[2], h[3]);
                *((GAS u32x2*)(hout + (size_t)m * D) + lane + 64 * j) = w;
                if (h8) *((GAS unsigned*)(h8 + (size_t)m * D) + lane + 64 * j) = pk4_fp8(h);
            }
        }
    }
}
__device__ __forceinline__ void rstd_rows(const float* rsq_q, const float* rsq_kv, float* rstd_q, float* rstd_kv, int gtid, int NT) {
    for (int row = gtid; row < S; row += NT) {
        const GAS f32x4* rp = (const GAS f32x4*)(rsq_q + (size_t)row * 24); float ss = 0.f;
#pragma unroll
        for (int i = 0; i < 6; ++i) { const f32x4 t = rp[i]; ss += (t[0] + t[1]) + (t[2] + t[3]); }
        rstd_q[row] = 1.f / sqrtf(ss * (1.f / 768.f) + RMS_EPS);
        const GAS f32x4* rk = (const GAS f32x4*)(rsq_kv + (size_t)row * 16); float sk = 0.f;
#pragma unroll
        for (int i = 0; i < 4; ++i) { const f32x4 t = rk[i]; sk += (t[0] + t[1]) + (t[2] + t[3]); }
        rstd_kv[row] = 1.f / sqrtf(sk * (1.f / 512.f) + RMS_EPS);
    }
}
namespace pg8 {
#define PG8_LAS __attribute__((address_space(3)))
typedef unsigned short bf16_t;
typedef short bf16x8 __attribute__((ext_vector_type(8)));
typedef float f32x4 __attribute__((ext_vector_type(4)));
typedef unsigned u32x4 __attribute__((ext_vector_type(4)));
constexpr int BM = 256, BK = 64, HALF = 128, HTB = HALF * BK * 2  , STAGE_BYTES = 8 * HTB, NXCD = 8, WGM = 8;

__host__ __device__ __forceinline__ int lds_byte(int r, int c) { const int st = (r >> 4) * 2 + (c >> 5), rr = r & 15, cc = c & 31, ob = rr * 64 + cc * 2; return st * 1024 + (ob ^ (((ob >> 9) & 1) << 5)); }
__host__ __device__ __forceinline__ void stage_rc(int b, int& R, int& C) { const int st = b / 1024, sb = b % 1024, swz = sb ^ (((sb >> 9) & 1) << 5); R = (st >> 1) * 16 + swz / 64; C = (st & 1) * 32 + (swz % 64) / 2; }
__host__ __device__ __forceinline__ int perm32(int rho) { const int n = rho >> 4, i = rho & 15; return 8 * (i >> 2) + 4 * n + (i & 3); }

struct Unit { int pm, pn; };
struct Gemm { const bf16_t* A; const bf16_t* Bt; int M, N, K; };

struct StaticOrder {
    int nM, nN, nwg, G, c;
    __host__ __device__ void init(int M, int N, int G_, int c_) { nM = M / BM; nN = N / BM; nwg = nM * nN; G = G_; c = c_; }
    __host__ __device__ bool next(int i, Unit& u) const {
        const long L = (long)i * G + c; if (L >= nwg) return false;
        int wgid = (int)L; { const int q = nwg / NXCD, r = nwg % NXCD, xcd = wgid % NXCD, off = wgid / NXCD; wgid = (xcd < r ? xcd * (q + 1) : r * (q + 1) + (xcd - r) * q) + off; }
        const int nig = WGM * nN, gid = wgid / nig, fm = gid * WGM, gsz = (nM - fm) < WGM ? (nM - fm) : WGM;
        u.pm = fm + ((wgid % nig) % gsz); u.pn = (wgid % nig) / gsz; return true;
    }
    __device__ __forceinline__ void a_ready(const Unit&) const {}
    __device__ __forceinline__ void done(const Unit&) const {}
};
typedef int i32x8 __attribute__((ext_vector_type(8)));
typedef int i32x4 __attribute__((ext_vector_type(4)));
__device__ __forceinline__ i32x8 ld2x16(const PG8_LAS unsigned char* p) { const u32x4 a = *(const PG8_LAS u32x4*)p, b = *(const PG8_LAS u32x4*)(p + 1024);
    return (i32x8){(int)a.x, (int)a.y, (int)a.z, (int)a.w, (int)b.x, (int)b.y, (int)b.z, (int)b.w}; }
__device__ __forceinline__ i32x8 cat8(bf16x8 lo, bf16x8 hi) { const i32x4 a = __builtin_bit_cast(i32x4, lo), b = __builtin_bit_cast(i32x4, hi); return (i32x8){a[0], a[1], a[2], a[3], b[0], b[1], b[2], b[3]}; }
struct InBf16Order : StaticOrder {
    __device__ bool next(int i, Unit& u) const { if (!StaticOrder::next(i, u)) return false; u.pn = u.pn == 0 ? 5 : 13 + u.pn; return true; }
};
__device__ __forceinline__ f32x4 rope4(const f32x4 v, float c0, float s0, float c1, float s1) {
    f32x4 o; o[0] = v[0] * c0 - v[1] * s0; o[1] = v[1] * c0 + v[0] * s0; o[2] = v[2] * c1 - v[3] * s1; o[3] = v[3] * c1 + v[2] * s1; return o; }
#ifdef NOISE_BUILD
__device__ __forceinline__ f32x4 nz4(f32x4 v, int row, int col) {
    f32x4 o;
#pragma unroll
    for (int i = 0; i < 4; ++i) { unsigned h = (unsigned)row * 9216u + (unsigned)(col + i); h ^= h >> 16; h *= 0x7feb352du; h ^= h >> 15; h *= 0x846ca68bu; h ^= h >> 16;
        const float r = (float)(int)(h & 0xffffu) * (1.f / 32768.f) - 1.f; o[i] = v[i] * (1.f + NOISE_EPS * r); }
    return o; }
#define NZ(v, row, col) nz4((v), (row), (col))
#else
#define NZ(v, row, col) (v)
#endif
#ifdef MLA_FP8
__device__ __forceinline__ u32x2 pk8_fp8(f32x4 a, f32x4 b) {
    int w0 = __builtin_amdgcn_cvt_pk_fp8_f32(a[0], a[1], 0, false); w0 = __builtin_amdgcn_cvt_pk_fp8_f32(a[2], a[3], w0, true);
    int w1 = __builtin_amdgcn_cvt_pk_fp8_f32(b[0], b[1], 0, false); w1 = __builtin_amdgcn_cvt_pk_fp8_f32(b[2], b[3], w1, true);
    u32x2 r; r.x = (unsigned)w0; r.y = (unsigned)w1; return r; }
#endif
struct EpiIn {
    static constexpr bool PERM = true, AFTER_DRAIN = false;
    unsigned char* ws; int f8pass;
    __device__ __forceinline__ void operator()(const f32x4 (&acc)[2][2][4][2], const Unit& u, int wr, int wc, int fr, int fq) const {
        const int pn = f8pass ? (u.pn < 5 ? u.pn : u.pn + 1) : u.pn, row0 = u.pm * BM + wr * 64 + fr;
        if (pn < 5) {
            const bool isq = pn < 3; bf16_t* base = (bf16_t*)(ws + (isq ? WS_QLAT : WS_KVLAT)); const int ld = isq ? 768 : 512, ct = isq ? pn : pn - 3, ns = isq ? 24 : 16; float* rsq = (float*)(ws + (isq ? WS_RSQQ : WS_RSQKV));
#pragma unroll
            for (int ai = 0; ai < 2; ++ai)
#pragma unroll
                for (int m = 0; m < 4; ++m) { const int row = row0 + ai * HALF + m * 16;
#pragma unroll
                    for (int bj = 0; bj < 2; ++bj) { const f32x4 v0 = NZ(acc[ai][bj][m][0], row, pn * 256 + bj * 128 + wc * 32 + 8 * fq), v1 = NZ(acc[ai][bj][m][1], row, pn * 256 + bj * 128 + wc * 32 + 8 * fq + 4);
                        float ss = ((v0[0] * v0[0] + v0[1] * v0[1]) + (v0[2] * v0[2] + v0[3] * v0[3])) + ((v1[0] * v1[0] + v1[1] * v1[1]) + (v1[2] * v1[2] + v1[3] * v1[3]));
                        ss += __shfl_xor(ss, 16); ss += __shfl_xor(ss, 32);
                        if (fq == 0) rsq[(size_t)row * ns + ct * 8 + bj * 4 + wc] = ss;
#ifdef GEMM_F8
                        *(GAS u32x2*)((unsigned char*)base + (size_t)row * ld + ct * 256 + bj * HALF + wc * 32 + 8 * fq) = pk8_fp8(v0, v1); } }
#else
                        *(GAS u32x4*)(base + (size_t)row * ld + ct * 256 + bj * HALF + wc * 32 + 8 * fq) = pk8(v0, v1); } }
#endif
        } else if (pn == 5) {
            if (wc < 2) {
                const int i0 = 16 * wc + 4 * fq; const float* cosT = (const float*)(ws + WS_ROPE); const float* sinT = cosT + (size_t)S * 32; bf16_t* kmla = (bf16_t*)(ws + WS_KMLA);
#pragma unroll
                for (int ai = 0; ai < 2; ++ai)
#pragma unroll
                    for (int m = 0; m < 4; ++m) { const int row = row0 + ai * HALF + m * 16;
                        const f32x4 cs = *(const GAS f32x4*)(cosT + (size_t)row * 32 + i0), sn = *(const GAS f32x4*)(sinT + (size_t)row * 32 + i0);
#ifdef MLA_FP8
                        const u32x2 w = pk8_fp8(rope4(acc[ai][0][m][0], cs[0], sn[0], cs[1], sn[1]), rope4(acc[ai][0][m][1], cs[2], sn[2], cs[3], sn[3]));
                        unsigned char* dst = (unsigned char*)kmla + (size_t)row * 3072 + 128 + wc * 32 + 8 * fq;
#pragma unroll
                        for (int h = 0; h < 16; ++h) *(GAS u32x2*)(dst + h * 192) = w;
#else
                        const u32x4 w = pk8(rope4(acc[ai][0][m][0], cs[0], sn[0], cs[1], sn[1]), rope4(acc[ai][0][m][1], cs[2], sn[2], cs[3], sn[3]));
                        bf16_t* dst = kmla + (size_t)row * 3072 + 128 + wc * 32 + 8 * fq;
#pragma unroll
                        for (int h = 0; h < 16; ++h) *(GAS u32x4*)(dst + h * 192) = w;
#endif
                        asm volatile("" ::: "memory"); }
            } else {
                const int cl = (wc - 2) * 32 + 8 * fq; float* gnsa = (float*)(ws + WS_GNSA);
                if (cl < 48) {
#pragma unroll
                    for (int ai = 0; ai < 2; ++ai)
#pragma unroll
                        for (int m = 0; m < 4; ++m) { const int row = row0 + ai * HALF + m * 16; const f32x4 v0 = acc[ai][0][m][0], v1 = acc[ai][0][m][1];
                            f32x4 g0, g1; g0[0] = sigm_f(v0[0]); g0[1] = sigm_f(v0[1]); g0[2] = sigm_f(v0[2]); g0[3] = sigm_f(v0[3]); g1[0] = sigm_f(v1[0]); g1[1] = sigm_f(v1[1]); g1[2] = sigm_f(v1[2]); g1[3] = sigm_f(v1[3]);
                            *(GAS f32x4*)(gnsa + (size_t)row * 48 + cl) = g0; *(GAS f32x4*)(gnsa + (size_t)row * 48 + cl + 4) = g1; } }
            }
        } else {
            const int mode = (pn < 14) ? 0 : (pn < 22 ? 1 : (pn < 28 ? 2 : 0));
            bf16_t* base = (pn < 14) ? (bf16_t*)(ws + WS_ZMLA) + (pn - 6) * 256 : (pn < 22 ? (bf16_t*)(ws + WS_QNSA) + (pn - 14) * 256 : (bf16_t*)(ws + WS_ZNSA) + (pn - 28) * 256); bf16_t* kvnsa = (bf16_t*)(ws + WS_KVNSA);
#pragma unroll
            for (int ai = 0; ai < 2; ++ai)
#pragma unroll
                for (int m = 0; m < 4; ++m) { const int row = row0 + ai * HALF + m * 16;
#pragma unroll
                    for (int bj = 0; bj < 2; ++bj) { f32x4 v0 = NZ(acc[ai][bj][m][0], row, pn * 256 + bj * 128 + wc * 32 + 8 * fq), v1 = NZ(acc[ai][bj][m][1], row, pn * 256 + bj * 128 + wc * 32 + 8 * fq + 4);
                        if (mode == 0) { v0[0] = silu_f(v0[0]); v0[1] = silu_f(v0[1]); v0[2] = silu_f(v0[2]); v0[3] = silu_f(v0[3]); v1[0] = silu_f(v1[0]); v1[1] = silu_f(v1[1]); v1[2] = silu_f(v1[2]); v1[3] = silu_f(v1[3]); }
                        else if (mode == 1) { v0 = v0 * QS_NSA; v1 = v1 * QS_NSA; }
                        bf16_t* dst = (mode == 2) ? kvnsa + (size_t)(2 * (pn - 22) + bj) * ((size_t)S * 128) + (size_t)row * 128 + wc * 32 + 8 * fq
                                                  : base + (size_t)row * 2048 + bj * HALF + wc * 32 + 8 * fq;
                        *(GAS u32x4*)dst = pk8(v0, v1); } }
        }
    }
};
struct EpiQup {
    static constexpr bool PERM = true, AFTER_DRAIN = false;
    unsigned char* ws;
    __device__ __forceinline__ void operator()(const f32x4 (&acc)[2][2][4][2], const Unit& u, int wr, int wc, int fr, int fq) const {
        const int pn = u.pn, row0 = u.pm * BM + wr * 64 + fr; bf16_t* qmla = (bf16_t*)(ws + WS_QMLA); const float* rstd_q = (const float*)(ws + WS_RSTD); const float* cosT = (const float*)(ws + WS_ROPE); const float* sinT = cosT + (size_t)S * 32;
#pragma unroll
        for (int ai = 0; ai < 2; ++ai)
#pragma unroll
            for (int m = 0; m < 4; ++m) { const int row = row0 + ai * HALF + m * 16;
#ifdef MLA_FP8
#ifdef MLA_MXL
                const float sc = (QS_MLA * 8.f) * *(const GAS float*)(rstd_q + row);
#else
                const float sc = *(const GAS float*)(rstd_q + row);
#endif
                unsigned char* q8 = (unsigned char*)qmla + (size_t)row * 3072;
#pragma unroll
                for (int bj = 0; bj < 2; ++bj) { const f32x4 v0 = acc[ai][bj][m][0] * sc, v1 = acc[ai][bj][m][1] * sc;
                    if (pn < 8) { *(GAS u32x2*)(q8 + (2 * pn + bj) * 192 + wc * 32 + 8 * fq) = pk8_fp8(v0, v1); }
                    else { const int cp = (pn - 8) * 256 + bj * HALF + wc * 32 + 8 * fq, head = cp >> 6, dl = cp & 63, i0 = dl >> 1;
                        const f32x4 cs = *(const GAS f32x4*)(cosT + (size_t)row * 32 + i0), sn = *(const GAS f32x4*)(sinT + (size_t)row * 32 + i0);
                        *(GAS u32x2*)(q8 + head * 192 + 128 + dl) = pk8_fp8(rope4(v0, cs[0], sn[0], cs[1], sn[1]), rope4(v1, cs[2], sn[2], cs[3], sn[3])); } }
#else
                const float sc = QS_MLA * *(const GAS float*)(rstd_q + row);
#pragma unroll
                for (int bj = 0; bj < 2; ++bj) { const f32x4 v0 = acc[ai][bj][m][0] * sc, v1 = acc[ai][bj][m][1] * sc;
                    if (pn < 8) { *(GAS u32x4*)(qmla + (size_t)row * 3072 + (2 * pn + bj) * 192 + wc * 32 + 8 * fq) = pk8(v0, v1); }
                    else { const int cp = (pn - 8) * 256 + bj * HALF + wc * 32 + 8 * fq, head = cp >> 6, dl = cp & 63, i0 = dl >> 1;
                        const f32x4 cs = *(const GAS f32x4*)(cosT + (size_t)row * 32 + i0), sn = *(const GAS f32x4*)(sinT + (size_t)row * 32 + i0);
                        *(GAS u32x4*)(qmla + (size_t)row * 3072 + head * 192 + 128 + dl) = pk8(rope4(v0, cs[0], sn[0], cs[1], sn[1]), rope4(v1, cs[2], sn[2], cs[3], sn[3])); } }
#endif
                if (m & 1) asm volatile("" ::: "memory"); }
    }
};
struct EpiKvup {
    static constexpr bool PERM = true, AFTER_DRAIN = false;
    unsigned char* ws;
    __device__ __forceinline__ void operator()(const f32x4 (&acc)[2][2][4][2], const Unit& u, int wr, int wc, int fr, int fq) const {
        const int pn = u.pn, row0 = u.pm * BM + wr * 64 + fr;
#pragma unroll
        for (int ai = 0; ai < 2; ++ai)
#pragma unroll
            for (int m = 0; m < 4; ++m) { const int row = row0 + ai * HALF + m * 16;
                const float sc = *(const GAS float*)((const float*)(ws + WS_RSTD) + S + row); bf16_t* kmla = (bf16_t*)(ws + WS_KMLA); bf16_t* vmla = (bf16_t*)(ws + WS_VMLA);
#ifdef MLA_FP8
                *(GAS u32x2*)((unsigned char*)kmla + (size_t)row * 3072 + pn * 192 + wc * 32 + 8 * fq) = pk8_fp8(acc[ai][0][m][0] * sc, acc[ai][0][m][1] * sc);
#else
                *(GAS u32x4*)(kmla + (size_t)row * 3072 + pn * 192 + wc * 32 + 8 * fq) = pk8(acc[ai][0][m][0] * sc, acc[ai][0][m][1] * sc);
#endif
                *(GAS u32x4*)(vmla + (size_t)row * 2048 + pn * 128 + wc * 32 + 8 * fq) = pk8(acc[ai][1][m][0] * sc, acc[ai][1][m][1] * sc);
                if (m & 1) asm volatile("" ::: "memory"); }
    }
};
#ifdef MLA_FP8V
struct EpiKup {
    static constexpr bool PERM = true, AFTER_DRAIN = false;
    unsigned char* ws;
    __device__ __forceinline__ void operator()(const f32x4 (&acc)[2][2][4][2], const Unit& u, int wr, int wc, int fr, int fq) const {
        const int pn = u.pn, row0 = u.pm * BM + wr * 64 + fr;
#pragma unroll
        for (int ai = 0; ai < 2; ++ai)
#pragma unroll
            for (int m = 0; m < 4; ++m) { const int row = row0 + ai * HALF + m * 16;
                const float sc = *(const GAS float*)((const float*)(ws + WS_RSTD) + S + row); unsigned char* k8 = ws + WS_KMLA + (size_t)row * 3072;
#pragma unroll
                for (int bj = 0; bj < 2; ++bj) *(GAS u32x2*)(k8 + (2 * pn + bj) * 192 + wc * 32 + 8 * fq) = pk8_fp8(acc[ai][bj][m][0] * sc, acc[ai][bj][m][1] * sc);
                if (m & 1) asm volatile("" ::: "memory"); }
    }
};
struct EpiVt {
    static constexpr bool PERM = true, AFTER_DRAIN = false;
    unsigned char* ws;
    __device__ __forceinline__ void operator()(const f32x4 (&acc)[2][2][4][2], const Unit& u, int wr, int wc, int fr, int fq) const {
        const int row0 = u.pm * BM + wr * 64 + fr, col0 = u.pn * BM + wc * 32 + 8 * fq;
        const float* rs = (const float*)(ws + WS_RSTD) + S;
        f32x4 sc[2][2];
#pragma unroll
        for (int bj = 0; bj < 2; ++bj) { sc[bj][0] = *(const GAS f32x4*)(rs + col0 + bj * HALF); sc[bj][1] = *(const GAS f32x4*)(rs + col0 + bj * HALF + 4); }
        const int hi8 = (col0 >> 3) & 1; (void)hi8;
#pragma unroll
        for (int ai = 0; ai < 2; ++ai)
#pragma unroll
            for (int m = 0; m < 4; ++m) { unsigned char* vt = ws + WS_VMLA + (size_t)(row0 + ai * HALF + m * 16) * S;
#pragma unroll
                for (int bj = 0; bj < 2; ++bj) { const u32x2 w = pk8_fp8(acc[ai][bj][m][0] * sc[bj][0], acc[ai][bj][m][1] * sc[bj][1]);
#ifdef MLA_MX
                    unsigned char* d64 = vt + ((col0 + bj * HALF) & ~63) + 4 * ((col0 >> 3) & 7);
                    *(GAS unsigned*)(d64) = w.x; *(GAS unsigned*)(d64 + 32) = w.y; } }
#else
                    unsigned char* d16 = vt + ((col0 + bj * HALF) & ~15);
                    *(GAS unsigned*)(d16 + (hi8 ? 4 : 0)) = w.x; *(GAS unsigned*)(d16 + (hi8 ? 12 : 8)) = w.y; } }
#endif
    }
};
#endif
struct EpiOut {
    static constexpr bool PERM = true, AFTER_DRAIN = false;
    bf16_t* y; const float* gate;
    __device__ __forceinline__ void operator()(const f32x4 (&acc)[2][2][4][2], const Unit& u, int wr, int wc, int fr, int fq) const {
        const int row0 = u.pm * BM + wr * 64 + fr, col0 = u.pn * BM + wc * 32 + 8 * fq;
        f32x4 gv[2][2];
#pragma unroll
        for (int bj = 0; bj < 2; ++bj)
#pragma unroll
            for (int n = 0; n < 2; ++n) gv[bj][n] = *(const GAS f32x4*)(gate + col0 + bj * HALF + n * 4);
#pragma unroll
        for (int ai = 0; ai < 2; ++ai)
#pragma unroll
            for (int m = 0; m < 4; ++m) { bf16_t* dst = y + (size_t)(row0 + ai * HALF + m * 16) * D + col0;
#pragma unroll
                for (int bj = 0; bj < 2; ++bj) *(GAS u32x4*)(dst + bj * HALF) = pk8(gv[bj][0] * acc[ai][bj][m][0], gv[bj][1] * acc[ai][bj][m][1]);
                if (m & 1) asm volatile("" ::: "memory"); }
    }
};
template <class Epi, class Sched, bool ALIGN_EPI = false, bool SP2 = false, int SCB = 0, int SCA = 0>
__device__ __forceinline__ void gemm_phase(PG8_LAS unsigned char* lds, const Gemm g, const Sched& S, const Epi& E) {
    int tid_ = threadIdx.x; asm volatile("" : "+v"(tid_));
    const int tid = tid_, wid = __builtin_amdgcn_readfirstlane(tid >> 6), lane = tid & 63, wr = wid >> 2, wc = wid & 3, fr = lane & 15, fq = lane >> 4;
    const int K = g.K, nt = K / BK;
    unsigned voffA[2], voffB[2];
#pragma unroll
    for (int i = 0; i < 2; ++i) { int R, C; stage_rc(tid * 16 + i * 8192, R, C); const int Rb = Epi::PERM ? ((R & ~31) + perm32(R & 31)) : R;
        voffA[i] = (unsigned)(R * K + C) * 2u; voffB[i] = (unsigned)(Rb * K + C) * 2u; }
    const size_t kstep = (size_t)(BK * 2);
    const size_t hstep = (size_t)HALF * K * 2;
    const size_t tstep = 2 * hstep;
    const unsigned ldsw = (unsigned)wid * 1024u;
    const int aoff = lds_byte(wr * 64 + fr, fq * 8), boff = lds_byte(wc * 32 + fr, fq * 8);
#define PG8_SA(b, h) (((b) * 2 + (h)) * HTB)
#define PG8_SB(b, h) ((4 + (b) * 2 + (h)) * HTB)
#define PG8_STAGE(bufoff, gbase, voff) do { _Pragma("unroll") for (int _i = 0; _i < 2; ++_i) \
        __builtin_amdgcn_global_load_lds((const unsigned*)((const char*)(gbase) + (voff)[_i]), (PG8_LAS unsigned*)(lds + (bufoff) + ldsw + _i * 8192), 16, 0, 0); } while (0)
#define PG8_LDA(dst, b, h) do { if constexpr (SCB != 0) { _Pragma("unroll") for (int m = 0; m < 4; ++m) dst##8[m] = ld2x16(lds + PG8_SA(b, h) + aoff + m * 2048); } \
        else { _Pragma("unroll") for (int m = 0; m < 4; ++m) _Pragma("unroll") for (int k = 0; k < 2; ++k) dst[m][k] = *(const PG8_LAS bf16x8*)(lds + PG8_SA(b, h) + aoff + m * 2048 + k * 1024); } } while (0)
#define PG8_LDB(dst, b, h) do { if constexpr (SCB != 0) { _Pragma("unroll") for (int n = 0; n < 2; ++n) dst##8[n] = ld2x16(lds + PG8_SB(b, h) + boff + n * 2048); } \
        else { _Pragma("unroll") for (int n = 0; n < 2; ++n) _Pragma("unroll") for (int k = 0; k < 2; ++k) dst[n][k] = *(const PG8_LAS bf16x8*)(lds + PG8_SB(b, h) + boff + n * 2048 + k * 1024); } } while (0)
#define PG8_MMA(ai, bj, At, Bt) do { __builtin_amdgcn_s_setprio(1); \
        if constexpr (SCB != 0) { _Pragma("unroll") for (int m = 0; m < 4; ++m) _Pragma("unroll") for (int n = 0; n < 2; ++n) \
            asm volatile("v_mfma_scale_f32_16x16x128_f8f6f4 %0, %1, %2, %0, %3, %4 op_sel_hi:[0,0,0]" : "+v"(acc[ai][bj][m][n]) : "v"(Bt##8[n]), "v"(At##8[m]), "v"(scb_), "v"(sca_)); } \
        else { _Pragma("unroll") for (int m = 0; m < 4; ++m) _Pragma("unroll") for (int n = 0; n < 2; ++n) _Pragma("unroll") for (int k = 0; k < 2; ++k) \
            acc[ai][bj][m][n] = __builtin_amdgcn_mfma_f32_16x16x32_bf16(Bt[n][k], At[m][k], acc[ai][bj][m][n], 0, 0, 0); } \
        __builtin_amdgcn_s_setprio(0); } while (0)
#define PG8_WAIT_V(n) asm volatile("s_waitcnt vmcnt(" #n ")" ::: "memory")
#define PG8_WAIT_L(n) asm volatile("s_waitcnt lgkmcnt(" #n ")" ::: "memory")
#define PG8_BAR __builtin_amdgcn_s_barrier()
#define PG8_SCHED __builtin_amdgcn_sched_barrier(0)
    Unit cur, nxt; int ui = 0;
    if (!S.next(0, cur)) return;
    f32x4 acc[2][2][4][2];
#pragma unroll
    for (int a = 0; a < 2; ++a)
#pragma unroll
        for (int b = 0; b < 2; ++b)
#pragma unroll
            for (int m = 0; m < 4; ++m)
#pragma unroll
                for (int n = 0; n < 2; ++n) acc[a][b][m][n] = (f32x4){0.f, 0.f, 0.f, 0.f};
    int scb_ = SCB, sca_ = SCA; asm volatile("" : "+v"(scb_), "+v"(sca_));
    bf16x8 At[4][2], B0[2][2], B1[2][2]; i32x8 At8[4], B08[2], B18[2];
    const char* cA = (const char*)g.A + (size_t)cur.pm * tstep; const char* cB = (const char*)g.Bt + (size_t)cur.pn * tstep;
    S.a_ready(cur);
    if constexpr (SP2) {
        PG8_STAGE(PG8_SB(0, 0), cB, voffB); PG8_STAGE(PG8_SB(0, 1), cB + hstep, voffB); PG8_STAGE(PG8_SA(0, 0), cA, voffA); PG8_STAGE(PG8_SA(0, 1), cA + hstep, voffA);
        if (wr == 1) PG8_BAR;
        PG8_WAIT_V(2); PG8_BAR;
        PG8_STAGE(PG8_SB(1, 0), cB + kstep, voffB); PG8_STAGE(PG8_SA(1, 0), cA + kstep, voffA); PG8_STAGE(PG8_SB(1, 1), cB + hstep + kstep, voffB);
        PG8_WAIT_V(6); PG8_BAR;
    } else {
        PG8_STAGE(PG8_SB(0, 0), cB, voffB); PG8_STAGE(PG8_SA(0, 0), cA, voffA); PG8_STAGE(PG8_SB(0, 1), cB + hstep, voffB); PG8_STAGE(PG8_SA(0, 1), cA + hstep, voffA);
        if (wr == 1) PG8_BAR;
        PG8_WAIT_V(4); PG8_BAR;
        PG8_STAGE(PG8_SB(1, 0), cB + kstep, voffB); PG8_STAGE(PG8_SA(1, 0), cA + kstep, voffA); PG8_STAGE(PG8_SB(1, 1), cB + hstep + kstep, voffB);
        PG8_WAIT_V(6); PG8_BAR;
    }
    for (;;) {
        const bool has_next = S.next(ui + 1, nxt);
        const char* nA = has_next ? (const char*)g.A + (size_t)nxt.pm * tstep : cA; const char* nB = has_next ? (const char*)g.Bt + (size_t)nxt.pn * tstep : cB;
#pragma unroll 1
        for (int t = 0; t < nt; t += 2) {
            const bool last = (t == nt - 2);
            const char* a1 = cA + (size_t)(t + 1) * kstep;
            const char* a2 = last ? nA : cA + (size_t)(t + 2) * kstep; const char* b2 = last ? nB : cB + (size_t)(t + 2) * kstep;
            const char* a3 = a2 + kstep; const char* b3 = b2 + kstep;
            if (last && has_next) S.a_ready(nxt);
            if constexpr (SP2) {
            PG8_LDB(B0, 0, 0); PG8_LDB(B1, 0, 1); PG8_SCHED; PG8_LDA(At, 0, 0); PG8_STAGE(PG8_SA(1, 1), a1 + hstep, voffA);
            PG8_WAIT_V(8); PG8_WAIT_L(0); PG8_BAR; PG8_MMA(0, 0, At, B0); PG8_MMA(0, 1, At, B1); PG8_BAR; PG8_SCHED;
            PG8_LDA(At, 0, 1); PG8_STAGE(PG8_SB(0, 0), b2, voffB); PG8_STAGE(PG8_SB(0, 1), b2 + hstep, voffB); PG8_STAGE(PG8_SA(0, 0), a2, voffA);
            PG8_WAIT_V(8); PG8_WAIT_L(0); PG8_BAR; PG8_MMA(1, 0, At, B0); PG8_MMA(1, 1, At, B1); PG8_BAR; PG8_SCHED;
            PG8_LDB(B0, 1, 0); PG8_LDB(B1, 1, 1); PG8_SCHED; PG8_LDA(At, 1, 0); PG8_STAGE(PG8_SA(0, 1), a2 + hstep, voffA);
            PG8_WAIT_V(8); PG8_WAIT_L(0); PG8_BAR; PG8_MMA(0, 0, At, B0); PG8_MMA(0, 1, At, B1); PG8_BAR; PG8_SCHED;
            PG8_LDA(At, 1, 1); PG8_STAGE(PG8_SB(1, 0), b3, voffB); PG8_STAGE(PG8_SB(1, 1), b3 + hstep, voffB); PG8_STAGE(PG8_SA(1, 0), a3, voffA);
            PG8_WAIT_V(8); PG8_WAIT_L(0); PG8_BAR; PG8_MMA(1, 0, At, B0); PG8_MMA(1, 1, At, B1); PG8_BAR; PG8_SCHED;
            } else {
            PG8_LDB(B0, 0, 0); PG8_SCHED; PG8_LDA(At, 0, 0); PG8_STAGE(PG8_SA(1, 1), a1 + hstep, voffA);
            PG8_WAIT_L(8); PG8_BAR; PG8_WAIT_L(0); PG8_MMA(0, 0, At, B0); PG8_BAR; PG8_SCHED;
            PG8_LDB(B1, 0, 1); PG8_STAGE(PG8_SB(0, 0), b2, voffB);
            PG8_BAR; PG8_WAIT_L(0); PG8_MMA(0, 1, At, B1); PG8_BAR;
            PG8_LDA(At, 0, 1); PG8_STAGE(PG8_SA(0, 0), a2, voffA);
            PG8_BAR; PG8_WAIT_L(0); PG8_MMA(1, 0, At, B0); PG8_BAR; PG8_SCHED;
            PG8_STAGE(PG8_SB(0, 1), b2 + hstep, voffB);
            PG8_WAIT_V(6); PG8_BAR; PG8_MMA(1, 1, At, B1); PG8_BAR;
            PG8_LDB(B0, 1, 0); PG8_SCHED; PG8_LDA(At, 1, 0); PG8_STAGE(PG8_SA(0, 1), a2 + hstep, voffA);
            PG8_WAIT_L(8); PG8_BAR; PG8_WAIT_L(0); PG8_MMA(0, 0, At, B0); PG8_BAR; PG8_SCHED;
            PG8_LDB(B1, 1, 1); PG8_STAGE(PG8_SB(1, 0), b3, voffB);
            PG8_BAR; PG8_WAIT_L(0); PG8_MMA(0, 1, At, B1); PG8_BAR;
            PG8_LDA(At, 1, 1); PG8_STAGE(PG8_SA(1, 0), a3, voffA);
            PG8_BAR; PG8_WAIT_L(0); PG8_MMA(1, 0, At, B0); PG8_BAR; PG8_SCHED;
            PG8_STAGE(PG8_SB(1, 1), b3 + hstep, voffB);
            PG8_WAIT_V(6); PG8_BAR; PG8_MMA(1, 1, At, B1); PG8_BAR;
            }
        }
        if constexpr (SCB != 0) asm volatile("s_nop 15\n\ts_nop 15" ::: "memory");
        if constexpr (ALIGN_EPI) { if (wr == 0) PG8_BAR; }
        if constexpr (!Epi::AFTER_DRAIN) { int fr_ = fr, fq_ = fq; asm volatile("" : "+v"(fr_), "+v"(fq_));
            E(acc, cur, wr, wc, fr_, fq_); S.done(cur); }
        if (!has_next) break;
#pragma unroll
        for (int a = 0; a < 2; ++a)
#pragma unroll
            for (int b = 0; b < 2; ++b)
#pragma unroll
                for (int m = 0; m < 4; ++m)
#pragma unroll
                    for (int n = 0; n < 2; ++n) acc[a][b][m][n] = (f32x4){0.f, 0.f, 0.f, 0.f};
        cur = nxt; cA = nA; cB = nB; ++ui;
        if constexpr (ALIGN_EPI) { if (wr == 1) PG8_BAR; }
    }
    PG8_WAIT_V(0);
    if constexpr (!ALIGN_EPI) { if (wr == 0) PG8_BAR; }
    PG8_BAR;
    if constexpr (Epi::AFTER_DRAIN) { E.fused(acc, cur, wr, wc, fr, fq, lds, wid, lane); S.done(cur); }
#undef PG8_SA
#undef PG8_SB
#undef PG8_STAGE
#undef PG8_LDA
#undef PG8_LDB
#undef PG8_MMA
#undef PG8_WAIT_V
#undef PG8_WAIT_L
#undef PG8_BAR
#undef PG8_SCHED
}

struct GemmMix { const void* A; const void* B; int LD;
                 int K0, K1, OFF1, M, N; };
template <class Epi, class Sched, int SCB, int SCA>
__device__ __forceinline__ void gemm_phase_mix(PG8_LAS unsigned char* lds, const GemmMix g, const Sched& S, const Epi& E) {
    int tid_ = threadIdx.x; asm volatile("" : "+v"(tid_));
    const int tid = tid_, wid = __builtin_amdgcn_readfirstlane(tid >> 6), lane = tid & 63, wr = wid >> 2, wc = wid & 3, fr = lane & 15, fq = lane >> 4;
    const int nt0 = g.K0 / BK, nt1 = g.K1 / BK, nt = nt0 + nt1, koff1 = g.OFF1 / BK - nt0;
    unsigned voffA[2], voffB[2];
#pragma unroll
    for (int i = 0; i < 2; ++i) { int R, C; stage_rc(tid * 16 + i * 8192, R, C); const int Rb = Epi::PERM ? ((R & ~31) + perm32(R & 31)) : R;
        voffA[i] = (unsigned)(R * g.LD + C) * 2u; voffB[i] = (unsigned)(Rb * g.LD + C) * 2u; }
    const size_t kstep = (size_t)(BK * 2);
    const size_t hstep = (size_t)HALF * g.LD * 2, tstep = 2 * hstep;
    const unsigned ldsw = (unsigned)wid * 1024u;
    const int aoff = lds_byte(wr * 64 + fr, fq * 8), boff = lds_byte(wc * 32 + fr, fq * 8);
#define PG8_SA(b, h) (((b) * 2 + (h)) * HTB)
#define PG8_SB(b, h) ((4 + (b) * 2 + (h)) * HTB)
#define PG8_STAGE(bufoff, gbase, voff) do { _Pragma("unroll") for (int _i = 0; _i < 2; ++_i) \
        __builtin_amdgcn_global_load_lds((const unsigned*)((const char*)(gbase) + (voff)[_i]), (PG8_LAS unsigned*)(lds + (bufoff) + ldsw + _i * 8192), 16, 0, 0); } while (0)
#define PG8_LDA1(dst, b, h) do { _Pragma("unroll") for (int m = 0; m < 4; ++m) dst##8[m] = ld2x16(lds + PG8_SA(b, h) + aoff + m * 2048); } while (0)
#define PG8_LDB1(dst, b, h) do { _Pragma("unroll") for (int n = 0; n < 2; ++n) dst##8[n] = ld2x16(lds + PG8_SB(b, h) + boff + n * 2048); } while (0)
#define PG8_LDA0(dst, b, h) do { _Pragma("unroll") for (int m = 0; m < 4; ++m) _Pragma("unroll") for (int k = 0; k < 2; ++k) dst[m][k] = *(const PG8_LAS bf16x8*)(lds + PG8_SA(b, h) + aoff + m * 2048 + k * 1024); } while (0)
#define PG8_LDB0(dst, b, h) do { _Pragma("unroll") for (int n = 0; n < 2; ++n) _Pragma("unroll") for (int k = 0; k < 2; ++k) dst[n][k] = *(const PG8_LAS bf16x8*)(lds + PG8_SB(b, h) + boff + n * 2048 + k * 1024); } while (0)
#define PG8_MMA1(ai, bj, At, Bt) do { __builtin_amdgcn_s_setprio(1); _Pragma("unroll") for (int m = 0; m < 4; ++m) _Pragma("unroll") for (int n = 0; n < 2; ++n) \
            asm volatile("v_mfma_scale_f32_16x16x128_f8f6f4 %0, %1, %2, %0, %3, %4 op_sel_hi:[0,0,0]" : "+v"(acc[ai][bj][m][n]) : "v"(Bt##8[n]), "v"(At##8[m]), "v"(scb_), "v"(sca_)); \
        __builtin_amdgcn_s_setprio(0); } while (0)
#define PG8_MMA0(ai, bj, At, Bt) do { __builtin_amdgcn_s_setprio(1); _Pragma("unroll") for (int m = 0; m < 4; ++m) _Pragma("unroll") for (int n = 0; n < 2; ++n) _Pragma("unroll") for (int k = 0; k < 2; ++k) \
            acc[ai][bj][m][n] = __builtin_amdgcn_mfma_f32_16x16x32_bf16(Bt[n][k], At[m][k], acc[ai][bj][m][n], 0, 0, 0); \
        __builtin_amdgcn_s_setprio(0); } while (0)
#define PG8_WAIT_V(n) asm volatile("s_waitcnt vmcnt(" #n ")" ::: "memory")
#define PG8_WAIT_L(n) asm volatile("s_waitcnt lgkmcnt(" #n ")" ::: "memory")
#define PG8_BAR __builtin_amdgcn_s_barrier()
#define PG8_SCHED __builtin_amdgcn_sched_barrier(0)
    Unit cur, nxt; int ui = 0;
    if (!S.next(0, cur)) return;
    f32x4 acc[2][2][4][2];
#pragma unroll
    for (int a = 0; a < 2; ++a)
#pragma unroll
        for (int b = 0; b < 2; ++b)
#pragma unroll
            for (int m = 0; m < 4; ++m)
#pragma unroll
                for (int n = 0; n < 2; ++n) acc[a][b][m][n] = (f32x4){0.f, 0.f, 0.f, 0.f};
    int scb_ = SCB, sca_ = SCA; asm volatile("" : "+v"(scb_), "+v"(sca_));
    bf16x8 At[4][2], B0[2][2], B1[2][2]; i32x8 At8[4], B08[2], B18[2];
    const char* cA = (const char*)g.A + (size_t)cur.pm * tstep; const char* cB = (const char*)g.B + (size_t)cur.pn * tstep;
    S.a_ready(cur);
    PG8_STAGE(PG8_SB(0, 0), cB, voffB); PG8_STAGE(PG8_SB(0, 1), cB + hstep, voffB); PG8_STAGE(PG8_SA(0, 0), cA, voffA); PG8_STAGE(PG8_SA(0, 1), cA + hstep, voffA);
    if (wr == 1) PG8_BAR;
    PG8_WAIT_V(2); PG8_BAR;
    PG8_STAGE(PG8_SB(1, 0), cB + kstep, voffB); PG8_STAGE(PG8_SA(1, 0), cA + kstep, voffA); PG8_STAGE(PG8_SB(1, 1), cB + hstep + kstep, voffB);
    PG8_WAIT_V(6); PG8_BAR;
    for (;;) {
        const bool has_next = S.next(ui + 1, nxt);
        const char* nA = has_next ? (const char*)g.A + (size_t)nxt.pm * tstep : cA; const char* nB = has_next ? (const char*)g.B + (size_t)nxt.pn * tstep : cB;
#define PG8_KPOS(x) ((size_t)((x) < nt0 ? (x) : (x) + koff1) * kstep)
#define PG8_TRIP(F) do { \
            const bool last = (t == nt - 2); \
            const char* a1 = cA + PG8_KPOS(t + 1); \
            const char* a2 = last ? nA : cA + PG8_KPOS(t + 2); const char* b2 = last ? nB : cB + PG8_KPOS(t + 2); \
            const char* a3 = last ? nA + kstep : cA + PG8_KPOS(t + 3); const char* b3 = last ? nB + kstep : cB + PG8_KPOS(t + 3); \
            if (last && has_next) S.a_ready(nxt); \
            PG8_LDB##F(B0, 0, 0); PG8_LDB##F(B1, 0, 1); PG8_SCHED; PG8_LDA##F(At, 0, 0); PG8_STAGE(PG8_SA(1, 1), a1 + hstep, voffA); \
            PG8_WAIT_V(8); PG8_WAIT_L(0); PG8_BAR; PG8_MMA##F(0, 0, At, B0); PG8_MMA##F(0, 1, At, B1); PG8_BAR; PG8_SCHED; \
            PG8_LDA##F(At, 0, 1); PG8_STAGE(PG8_SB(0, 0), b2, voffB); PG8_STAGE(PG8_SB(0, 1), b2 + hstep, voffB); PG8_STAGE(PG8_SA(0, 0), a2, voffA); \
            PG8_WAIT_V(8); PG8_WAIT_L(0); PG8_BAR; PG8_MMA##F(1, 0, At, B0); PG8_MMA##F(1, 1, At, B1); PG8_BAR; PG8_SCHED; \
            PG8_LDB##F(B0, 1, 0); PG8_LDB##F(B1, 1, 1); PG8_SCHED; PG8_LDA##F(At, 1, 0); PG8_STAGE(PG8_SA(0, 1), a2 + hstep, voffA); \
            PG8_WAIT_V(8); PG8_WAIT_L(0); PG8_BAR; PG8_MMA##F(0, 0, At, B0); PG8_MMA##F(0, 1, At, B1); PG8_BAR; PG8_SCHED; \
            PG8_LDA##F(At, 1, 1); PG8_STAGE(PG8_SB(1, 0), b3, voffB); PG8_STAGE(PG8_SB(1, 1), b3 + hstep, voffB); PG8_STAGE(PG8_SA(1, 0), a3, voffA); \
            PG8_WAIT_V(8); PG8_WAIT_L(0); PG8_BAR; PG8_MMA##F(1, 0, At, B0); PG8_MMA##F(1, 1, At, B1); PG8_BAR; PG8_SCHED; \
        } while (0)
#pragma unroll 1
        for (int t = 0; t < nt0; t += 2) PG8_TRIP(1);
        asm volatile("s_nop 7" ::: "memory");
#pragma unroll 1
        for (int t = nt0; t < nt; t += 2) PG8_TRIP(0);
#undef PG8_TRIP
#undef PG8_KPOS
        asm volatile("s_nop 15\n\ts_nop 15" ::: "memory");
        if (wr == 0) PG8_BAR;
        { int fr_ = fr, fq_ = fq; asm volatile("" : "+v"(fr_), "+v"(fq_)); E(acc, cur, wr, wc, fr_, fq_); S.done(cur); }
        if (!has_next) break;
#pragma unroll
        for (int a = 0; a < 2; ++a)
#pragma unroll
            for (int b = 0; b < 2; ++b)
#pragma unroll
                for (int m = 0; m < 4; ++m)
#pragma unroll
                    for (int n = 0; n < 2; ++n) acc[a][b][m][n] = (f32x4){0.f, 0.f, 0.f, 0.f};
        cur = nxt; cA = nA; cB = nB; ++ui;
        if (wr == 1) PG8_BAR;
    }
    PG8_WAIT_V(0);
    PG8_BAR;
#undef PG8_SA
#undef PG8_SB
#undef PG8_STAGE
#undef PG8_LDA0
#undef PG8_LDB0
#undef PG8_LDA1
#undef PG8_LDB1
#undef PG8_MMA0
#undef PG8_MMA1
#undef PG8_WAIT_V
#undef PG8_WAIT_L
#undef PG8_BAR
#undef PG8_SCHED
}
}
namespace att {
constexpr int KS_M = 400, KS_N = 272, VS = 320;
constexpr int MLA_KB = 64 * KS_M, NSA_KB = 64 * KS_N, VB = 64 * VS;
constexpr int N_IMP = 2 * NSA_KB + 2 * VB;
constexpr int N_PART = N_IMP + 32768;
constexpr int N_PARTB = 8 * 32 * 17 * 4;
constexpr int N_SELM = N_PART + 2 * N_PARTB;
constexpr int N_ULIST = N_SELM + 1024;
constexpr int N_CARRY = N_ULIST + 1024;
constexpr int N_NTS = N_CARRY + 256;
static_assert(N_NTS + 16 <= MISC_OFF, "NSA LDS map");
static_assert(2 * MLA_KB + 3 * VB <= 131072, "MLA LDS map");
constexpr int MLA_QL = 2 * MLA_KB + 2 * VB;
static_assert(MLA_QL + 8 * 4096 <= 131072, "MLA LDS map (pipelined)");

#ifndef QK_PF
#define QK_PF 4
#endif
#define MFMA32(a, b, c) __builtin_amdgcn_mfma_f32_32x32x16_bf16((a), (b), (c), 0, 0, 0)
__device__ __forceinline__ float swapmax(float v) { auto rr = __builtin_amdgcn_permlane32_swap(__float_as_uint(v), __float_as_uint(v), false, false); return fmaxf(__uint_as_float(rr[0]), __uint_as_float(rr[1])); }
__device__ __forceinline__ float swapsum(float v) { auto rr = __builtin_amdgcn_permlane32_swap(__float_as_uint(v), __float_as_uint(v), false, false); return __uint_as_float(rr[0]) + __uint_as_float(rr[1]); }
template <int SIDX> __device__ __forceinline__ bf16x8 packp(const f32x16& p) {
    f32x8 t = {p[8 * SIDX + 0], p[8 * SIDX + 1], p[8 * SIDX + 2], p[8 * SIDX + 3], p[8 * SIDX + 4], p[8 * SIDX + 5], p[8 * SIDX + 6], p[8 * SIDX + 7]};
    return __builtin_bit_cast(bf16x8, __builtin_convertvector(t, bf16x8v));
}
template <int NDC, int KS, bool ZERO = true> __device__ __forceinline__ void qk_tile(f32x16& p0, f32x16& p1, const LAS unsigned char* kl, const bf16x8 (&q)[NDC]) {
    if (ZERO) {
#pragma unroll
        for (int i = 0; i < 16; ++i) { p0[i] = 0.f; p1[i] = 0.f; }
    }
    constexpr int PF = QK_PF;
    bf16x8 a[PF + 1][2];
#pragma unroll
    for (int i = 0; i < PF; ++i) { a[i][0] = *(const LAS bf16x8*)(kl + i * 32); a[i][1] = *(const LAS bf16x8*)(kl + 32 * KS + i * 32); }
#pragma unroll
    for (int d0 = 0; d0 < NDC; ++d0) {
        if (d0 + PF < NDC) { a[(d0 + PF) % (PF + 1)][0] = *(const LAS bf16x8*)(kl + (d0 + PF) * 32); a[(d0 + PF) % (PF + 1)][1] = *(const LAS bf16x8*)(kl + 32 * KS + (d0 + PF) * 32); }
        __builtin_amdgcn_sched_barrier(0);
        p0 = MFMA32(a[d0 % (PF + 1)][0], q[d0], p0); p1 = MFMA32(a[d0 % (PF + 1)][1], q[d0], p1);
        __builtin_amdgcn_sched_barrier(0);
    }
}
#ifdef PROBE_QKM2
template <int NDC, int KS> __device__ __forceinline__ void qk_tile_m2(f32x16& p0, f32x16& p1, f32x16& r0, f32x16& r1, const LAS unsigned char* kl, const bf16x8 (&q)[NDC]) {
#pragma unroll
    for (int i = 0; i < 16; ++i) { p0[i] = 0.f; p1[i] = 0.f; r0[i] = 0.f; r1[i] = 0.f; }
    constexpr int PF = QK_PF;
    bf16x8 a[PF + 1][2];
#pragma unroll
    for (int i = 0; i < PF; ++i) { a[i][0] = *(const LAS bf16x8*)(kl + i * 32); a[i][1] = *(const LAS bf16x8*)(kl + 32 * KS + i * 32); }
#pragma unroll
    for (int d0 = 0; d0 < NDC; ++d0) {
        if (d0 + PF < NDC) { a[(d0 + PF) % (PF + 1)][0] = *(const LAS bf16x8*)(kl + (d0 + PF) * 32); a[(d0 + PF) % (PF + 1)][1] = *(const LAS bf16x8*)(kl + 32 * KS + (d0 + PF) * 32); }
        __builtin_amdgcn_sched_barrier(0);
        p0 = MFMA32(a[d0 % (PF + 1)][0], q[d0], p0); p1 = MFMA32(a[d0 % (PF + 1)][1], q[d0], p1);
        r0 = MFMA32(a[d0 % (PF + 1)][0], q[d0], r0); r1 = MFMA32(a[d0 % (PF + 1)][1], q[d0], r1);
        __builtin_amdgcn_sched_barrier(0);
    }
}
#endif
__device__ __forceinline__ void pv_tile(f32x16 (&o)[4], const bf16x8 (&pb)[4], const LAS unsigned char* vl) {
    s16x4 f[5][2];
#define PV_LD(idx) do { constexpr int d_ = (idx) >> 2, s_ = (idx) & 3; \
        f[(idx) % 5][0] = __builtin_amdgcn_ds_read_tr16_b64_v4i16((LAS s16x4*)(vl + s_ * 16 * VS + d_ * 64)); \
        f[(idx) % 5][1] = __builtin_amdgcn_ds_read_tr16_b64_v4i16((LAS s16x4*)(vl + s_ * 16 * VS + 8 * VS + d_ * 64)); } while (0)
    PV_LD(0); PV_LD(1); PV_LD(2); PV_LD(3);
#define PV_STEP(idx) do { if ((idx) + 4 < 16) PV_LD((idx) + 4); __builtin_amdgcn_sched_barrier(0); \
        { const s16x4 t0_ = f[(idx) % 5][0], t1_ = f[(idx) % 5][1]; const bf16x8 vf_ = {t0_[0], t0_[1], t0_[2], t0_[3], t1_[0], t1_[1], t1_[2], t1_[3]}; \
          o[(idx) >> 2] = MFMA32(vf_, pb[(idx) & 3], o[(idx) >> 2]); } __builtin_amdgcn_sched_barrier(0); } while (0)
    PV_STEP(0); PV_STEP(1); PV_STEP(2); PV_STEP(3); PV_STEP(4); PV_STEP(5); PV_STEP(6); PV_STEP(7);
    PV_STEP(8); PV_STEP(9); PV_STEP(10); PV_STEP(11); PV_STEP(12); PV_STEP(13); PV_STEP(14); PV_STEP(15);
#undef PV_STEP
#undef PV_LD
}
template <int NDC, int NQR, int KS> __device__ __forceinline__ void qk_tile_free(f32x16& p0, f32x16& p1, const LAS unsigned char* kl, const bf16x8 (&q)[NQR], const LAS unsigned char* ql) {
#pragma unroll
    for (int i = 0; i < 16; ++i) { p0[i] = 0.f; p1[i] = 0.f; }
#pragma unroll
    for (int d0 = 0; d0 < NDC; ++d0) {
        const bf16x8 a0 = *(const LAS bf16x8*)(kl + d0 * 32);
        const bf16x8 a1 = *(const LAS bf16x8*)(kl + 32 * KS + d0 * 32);
        bf16x8 qq; if (d0 < NQR) qq = q[d0 < NQR ? d0 : 0]; else qq = *(const LAS bf16x8*)(ql + (d0 - NQR) * 1024);
        p0 = MFMA32(a0, qq, p0); p1 = MFMA32(a1, qq, p1);
    }
}
__device__ __forceinline__ float sm_core(f32x16& p0, f32x16& p1, float& m, float& l) {
    float tm = p0[0];
#pragma unroll
    for (int r = 1; r < 16; ++r) tm = fmaxf(tm, p0[r]);
#pragma unroll
    for (int r = 0; r < 16; ++r) tm = fmaxf(tm, p1[r]);
    tm = swapmax(tm);
    const float mn = fmaxf(m, tm);
    const float alpha = __builtin_amdgcn_exp2f(m - mn);
    m = mn;
    float ps = 0.f;
#pragma unroll
    for (int r = 0; r < 16; ++r) { p0[r] = __builtin_amdgcn_exp2f(p0[r] - mn); ps += p0[r]; }
#pragma unroll
    for (int r = 0; r < 16; ++r) { p1[r] = __builtin_amdgcn_exp2f(p1[r] - mn); ps += p1[r]; }
    ps = swapsum(ps);
    l = l * alpha + ps;
    return alpha;
}
__device__ __forceinline__ void online_sm(f32x16& p0, f32x16& p1, float& m, float& l, f32x16 (&o)[4]) {
    float tm = p0[0];
#pragma unroll
    for (int r = 1; r < 16; ++r) tm = fmaxf(tm, p0[r]);
#pragma unroll
    for (int r = 0; r < 16; ++r) tm = fmaxf(tm, p1[r]);
    tm = swapmax(tm);
    const float mn = fmaxf(m, tm);
    const float alpha = __builtin_amdgcn_exp2f(m - mn);
    m = mn;
    float ps = 0.f;
#pragma unroll
    for (int r = 0; r < 16; ++r) { p0[r] = __builtin_amdgcn_exp2f(p0[r] - mn); ps += p0[r]; }
#pragma unroll
    for (int r = 0; r < 16; ++r) { p1[r] = __builtin_amdgcn_exp2f(p1[r] - mn); ps += p1[r]; }
    ps = swapsum(ps);
    l = l * alpha + ps;
    if (!__all(alpha == 1.f)) {
#pragma unroll
        for (int d = 0; d < 4; ++d)
#pragma unroll
            for (int r = 0; r < 16; ++r) o[d][r] *= alpha;
    }
}

#ifdef MLA_FP8
typedef long i64;
constexpr int KS8 = 200, MLA_KB8 = 64 * KS8;
static_assert(2 * MLA_KB8 + 3 * VB <= 131072, "MLA fp8 LDS map");
#define MFMA32F8(a, b, c) __builtin_amdgcn_mfma_f32_32x32x16_fp8_fp8((a), (b), (c), 0, 0, 0)
template <int NDC> __device__ __forceinline__ void qk_tile8(f32x16& p0, f32x16& p1, const LAS unsigned char* kl, const i64 (&q)[NDC]) {
#pragma unroll
    for (int i = 0; i < 16; ++i) { p0[i] = 0.f; p1[i] = 0.f; }
    constexpr int PF = 4;
    i64 a[PF + 1][2];
#pragma unroll
    for (int i = 0; i < PF; ++i) { a[i][0] = *(const LAS i64*)(kl + i * 16); a[i][1] = *(const LAS i64*)(kl + 32 * KS8 + i * 16); }
#pragma unroll
    for (int d0 = 0; d0 < NDC; ++d0) {
        if (d0 + PF < NDC) { a[(d0 + PF) % (PF + 1)][0] = *(const LAS i64*)(kl + (d0 + PF) * 16); a[(d0 + PF) % (PF + 1)][1] = *(const LAS i64*)(kl + 32 * KS8 + (d0 + PF) * 16); }
        __builtin_amdgcn_sched_barrier(0);
        __builtin_amdgcn_s_setprio(1);
        p0 = MFMA32F8(a[d0 % (PF + 1)][0], q[d0], p0); p1 = MFMA32F8(a[d0 % (PF + 1)][1], q[d0], p1);
        __builtin_amdgcn_s_setprio(0);
        __builtin_amdgcn_sched_barrier(0);
    }
}
__device__ __forceinline__ void online_sm_scaled(f32x16& p0, f32x16& p1, float& m, float& l, f32x16 (&o)[4], const float C2) {
    float tm = p0[0];
#pragma unroll
    for (int r = 1; r < 16; ++r) tm = fmaxf(tm, p0[r]);
#pragma unroll
    for (int r = 0; r < 16; ++r) tm = fmaxf(tm, p1[r]);
    tm = swapmax(tm);
    const float mn = fmaxf(m, tm);
    const float alpha = __builtin_amdgcn_exp2f((m - mn) * C2);
    m = mn;
    const float mc = -mn * C2;
    float ps = 0.f;
#pragma unroll
    for (int r = 0; r < 16; ++r) { p0[r] = __builtin_amdgcn_exp2f(__builtin_fmaf(p0[r], C2, mc)); ps += p0[r]; }
#pragma unroll
    for (int r = 0; r < 16; ++r) { p1[r] = __builtin_amdgcn_exp2f(__builtin_fmaf(p1[r], C2, mc)); ps += p1[r]; }
    ps = swapsum(ps);
    l = l * alpha + ps;
    if (!__all(alpha == 1.f)) {
#pragma unroll
        for (int d = 0; d < 4; ++d)
#pragma unroll
            for (int r = 0; r < 16; ++r) o[d][r] *= alpha;
    }
}
#endif
#ifdef MLA_FP8V
constexpr int VS8 = 72, VB8 = 128 * VS8;
constexpr int VS8B = 136, VB8B = 128 * VS8B, MLA_KB8B = 128 * KS8;
static_assert(2 * MLA_KB8B + 3 * VB8B <= 131072, "MLA big-tile LDS map");
#ifdef MLA_BIG
#define PV8_RS VS8B
#else
#define PV8_RS VS8
#endif
static_assert(2 * MLA_KB8 + 3 * VB8 <= 131072, "MLA fp8 LDS map");
template <int SIDX> __device__ __forceinline__ i64 packp8(const f32x16& p) {
    int w0 = __builtin_amdgcn_cvt_pk_fp8_f32(p[8 * SIDX + 0] * 256.f, p[8 * SIDX + 1] * 256.f, 0, false); w0 = __builtin_amdgcn_cvt_pk_fp8_f32(p[8 * SIDX + 2] * 256.f, p[8 * SIDX + 3] * 256.f, w0, true);
    int w1 = __builtin_amdgcn_cvt_pk_fp8_f32(p[8 * SIDX + 4] * 256.f, p[8 * SIDX + 5] * 256.f, 0, false); w1 = __builtin_amdgcn_cvt_pk_fp8_f32(p[8 * SIDX + 6] * 256.f, p[8 * SIDX + 7] * 256.f, w1, true);
    return (i64)(((unsigned long long)(unsigned)w1 << 32) | (unsigned)w0);
}
__device__ __forceinline__ void pv_tile8(f32x16 (&o)[4], const i64 (&pb)[4], const LAS unsigned char* vl) {
    i64 f[5];
#define PV8_LD(idx) f[(idx) % 5] = *(const LAS i64*)(vl + ((idx) >> 2) * 32 * PV8_RS + ((idx) & 3) * 16)
    PV8_LD(0); PV8_LD(1); PV8_LD(2); PV8_LD(3);
#define PV8_STEP(idx) do { if ((idx) + 4 < 16) PV8_LD((idx) + 4); __builtin_amdgcn_sched_barrier(0); \
        o[(idx) >> 2] = MFMA32F8(f[(idx) % 5], pb[(idx) & 3], o[(idx) >> 2]); __builtin_amdgcn_sched_barrier(0); } while (0)
    PV8_STEP(0); PV8_STEP(1); PV8_STEP(2); PV8_STEP(3); PV8_STEP(4); PV8_STEP(5); PV8_STEP(6); PV8_STEP(7);
    PV8_STEP(8); PV8_STEP(9); PV8_STEP(10); PV8_STEP(11); PV8_STEP(12); PV8_STEP(13); PV8_STEP(14); PV8_STEP(15);
#undef PV8_STEP
#undef PV8_LD
}
#endif
#ifdef MLA_MX
typedef int i32x8 __attribute__((ext_vector_type(8)));
constexpr int KSX = 208, MLA_KBX = 64 * KSX;
constexpr int VSX = 80, VBX = 128 * VSX;
static_assert(2 * MLA_KBX + 3 * VBX <= 131072, "MLA mx LDS map");
#define MFMAX(a, b, c) __builtin_amdgcn_mfma_scale_f32_32x32x64_f8f6f4((a), (b), (c), 0, 0, 0, 0x7f7f7f7f, 0, 0x7f7f7f7f)
__device__ __forceinline__ i32x8 ldsx(const LAS unsigned char* p) {
    const u32x4 a = *(const LAS u32x4*)p, b = *(const LAS u32x4*)(p + 16);
    return (i32x8){(int)a.x, (int)a.y, (int)a.z, (int)a.w, (int)b.x, (int)b.y, (int)b.z, (int)b.w};
}
__device__ __forceinline__ void qk_tilex(f32x16& p0, f32x16& p1, const LAS unsigned char* kl, const i32x8 (&q)[3]) {
#pragma unroll
    for (int i = 0; i < 16; ++i) { p0[i] = 0.f; p1[i] = 0.f; }
    i32x8 a0 = ldsx(kl), a1 = ldsx(kl + 32 * KSX), a2 = ldsx(kl + 64), a3 = ldsx(kl + 32 * KSX + 64);
    __builtin_amdgcn_sched_barrier(0);
    __builtin_amdgcn_s_setprio(1);
    p0 = MFMAX(a0, q[0], p0); p1 = MFMAX(a1, q[0], p1);
    __builtin_amdgcn_s_setprio(0);
    __builtin_amdgcn_sched_barrier(0);
    a0 = ldsx(kl + 128); a1 = ldsx(kl + 32 * KSX + 128);
    __builtin_amdgcn_sched_barrier(0);
    __builtin_amdgcn_s_setprio(1);
    p0 = MFMAX(a2, q[1], p0); p1 = MFMAX(a3, q[1], p1);
    __builtin_amdgcn_sched_barrier(0);
    p0 = MFMAX(a0, q[2], p0); p1 = MFMAX(a1, q[2], p1);
    __builtin_amdgcn_s_setprio(0);
    __builtin_amdgcn_sched_barrier(0);
}
__device__ __forceinline__ void pv_tilex(f32x16 (&o)[4], const i32x8& pb, const LAS unsigned char* vl) {
    i32x8 f0 = ldsx(vl), f1 = ldsx(vl + 32 * VSX);
    __builtin_amdgcn_sched_barrier(0);
    o[0] = MFMAX(f0, pb, o[0]);
    __builtin_amdgcn_sched_barrier(0);
    f0 = ldsx(vl + 64 * VSX);
    __builtin_amdgcn_sched_barrier(0);
    o[1] = MFMAX(f1, pb, o[1]);
    __builtin_amdgcn_sched_barrier(0);
    f1 = ldsx(vl + 96 * VSX);
    __builtin_amdgcn_sched_barrier(0);
    o[2] = MFMAX(f0, pb, o[2]);
    __builtin_amdgcn_sched_barrier(0);
    o[3] = MFMAX(f1, pb, o[3]);
    __builtin_amdgcn_sched_barrier(0);
}
__device__ __forceinline__ i32x8 packpx(const f32x16& p0, const f32x16& p1) {
    i32x8 w;
#pragma unroll
    for (int g = 0; g < 4; ++g) {
        int a = __builtin_amdgcn_cvt_pk_fp8_f32(p0[4 * g + 0], p0[4 * g + 1], 0, false); a = __builtin_amdgcn_cvt_pk_fp8_f32(p0[4 * g + 2], p0[4 * g + 3], a, true); w[g] = a;
        int b = __builtin_amdgcn_cvt_pk_fp8_f32(p1[4 * g + 0], p1[4 * g + 1], 0, false); b = __builtin_amdgcn_cvt_pk_fp8_f32(p1[4 * g + 2], p1[4 * g + 3], b, true); w[4 + g] = b;
    }
    return w;
}
__device__ __forceinline__ void online_sm_x(f32x16& p0, f32x16& p1, float& m, float& l, f32x16 (&o)[4], const float C2) {
    float tm = p0[0];
#pragma unroll
    for (int r = 1; r < 16; ++r) tm = fmaxf(tm, p0[r]);
#pragma unroll
    for (int r = 0; r < 16; ++r) tm = fmaxf(tm, p1[r]);
    tm = swapmax(tm);
    const float mn = fmaxf(m, tm);
    const float alpha = __builtin_amdgcn_exp2f((m - mn) * C2);
    m = mn;
    const float mc = 8.f - mn * C2;
    float ps = 0.f;
#pragma unroll
    for (int r = 0; r < 16; ++r) { p0[r] = __builtin_amdgcn_exp2f(__builtin_fmaf(p0[r], C2, mc)); ps += p0[r]; }
#pragma unroll
    for (int r = 0; r < 16; ++r) { p1[r] = __builtin_amdgcn_exp2f(__builtin_fmaf(p1[r], C2, mc)); ps += p1[r]; }
    ps = swapsum(ps);
    l = l * alpha + ps;
    if (!__all(alpha == 1.f)) {
#pragma unroll
        for (int d = 0; d < 4; ++d)
#pragma unroll
            for (int r = 0; r < 16; ++r) o[d][r] *= alpha;
    }
}
#endif
#ifdef MLA_MXL
#ifdef MLA_MXU
#define MXL_T 126.0f
#define MXL_REF 120.0f
#define MFMAXQ(a, b, c) __builtin_amdgcn_mfma_scale_f32_32x32x64_f8f6f4((a), (b), (c), 0, 0, 0, 0x7f7f7f7f, 0, 0x7f7f7f7f)
__device__ __forceinline__ i32x8 byte_packx(const f32x16& p0, const f32x16& p1) {
    i32x8 w;
#pragma unroll
    for (int g = 0; g < 4; ++g) {
        unsigned a = __builtin_amdgcn_cvt_pk_u8_f32(p0[4 * g + 0], 0, 0u); a = __builtin_amdgcn_cvt_pk_u8_f32(p0[4 * g + 1], 1, a); a = __builtin_amdgcn_cvt_pk_u8_f32(p0[4 * g + 2], 2, a); a = __builtin_amdgcn_cvt_pk_u8_f32(p0[4 * g + 3], 3, a); w[g] = (int)a;
        unsigned b = __builtin_amdgcn_cvt_pk_u8_f32(p1[4 * g + 0], 0, 0u); b = __builtin_amdgcn_cvt_pk_u8_f32(p1[4 * g + 1], 1, b); b = __builtin_amdgcn_cvt_pk_u8_f32(p1[4 * g + 2], 2, b); b = __builtin_amdgcn_cvt_pk_u8_f32(p1[4 * g + 3], 3, b); w[4 + g] = (int)b;
    }
    return w;
}
#else
#define MXL_T 7.0f
#define MXL_REF 0.0f
#define MFMAXQ(a, b, c) __builtin_amdgcn_mfma_scale_f32_32x32x64_f8f6f4((a), (b), (c), 0, 0, 0, 0x7f7f7f7f, 0, 0x7c7c7c7c)
#endif
__device__ __forceinline__ void qk_tilexl(f32x16& p0, f32x16& p1, const f32x16& mref, const LAS unsigned char* kl, const i32x8 (&q)[3]) {
    i32x8 a0 = ldsx(kl), a1 = ldsx(kl + 32 * KSX), a2 = ldsx(kl + 64), a3 = ldsx(kl + 32 * KSX + 64);
    __builtin_amdgcn_sched_barrier(0);
    __builtin_amdgcn_s_setprio(1);
    p0 = MFMAXQ(a0, q[0], mref); p1 = MFMAXQ(a1, q[0], mref);
    __builtin_amdgcn_s_setprio(0);
    __builtin_amdgcn_sched_barrier(0);
    a0 = ldsx(kl + 128); a1 = ldsx(kl + 32 * KSX + 128);
    __builtin_amdgcn_sched_barrier(0);
    __builtin_amdgcn_s_setprio(1);
    p0 = MFMAXQ(a2, q[1], p0); p1 = MFMAXQ(a3, q[1], p1);
    __builtin_amdgcn_sched_barrier(0);
    p0 = MFMAXQ(a0, q[2], p0); p1 = MFMAXQ(a1, q[2], p1);
    __builtin_amdgcn_s_setprio(0);
    __builtin_amdgcn_sched_barrier(0);
}
template <int RS = VSX>
__device__ __forceinline__ void pv_tilexl_pre(f32x16 (&o)[5], const i32x8& pb, const i32x8& ones, const LAS unsigned char* vl, i32x8 f0, i32x8 f1) {
    __builtin_amdgcn_sched_barrier(0);
    o[4] = MFMAX(ones, pb, o[4]);
    __builtin_amdgcn_sched_barrier(0);
    o[0] = MFMAX(f0, pb, o[0]);
    __builtin_amdgcn_sched_barrier(0);
    f0 = ldsx(vl + 64 * RS);
    __builtin_amdgcn_sched_barrier(0);
    o[1] = MFMAX(f1, pb, o[1]);
    __builtin_amdgcn_sched_barrier(0);
    f1 = ldsx(vl + 96 * RS);
    __builtin_amdgcn_sched_barrier(0);
    o[2] = MFMAX(f0, pb, o[2]);
    __builtin_amdgcn_sched_barrier(0);
    o[3] = MFMAX(f1, pb, o[3]);
    __builtin_amdgcn_sched_barrier(0);
}
template <int RS = VSX>
__device__ __forceinline__ void pv_tilexl(f32x16 (&o)[5], const i32x8& pb, const i32x8& ones, const LAS unsigned char* vl) {
    i32x8 f0 = ldsx(vl), f1 = ldsx(vl + 32 * RS);
    __builtin_amdgcn_sched_barrier(0);
    o[4] = MFMAX(ones, pb, o[4]);
    __builtin_amdgcn_sched_barrier(0);
    o[0] = MFMAX(f0, pb, o[0]);
    __builtin_amdgcn_sched_barrier(0);
    f0 = ldsx(vl + 64 * RS);
    __builtin_amdgcn_sched_barrier(0);
    o[1] = MFMAX(f1, pb, o[1]);
    __builtin_amdgcn_sched_barrier(0);
    f1 = ldsx(vl + 96 * RS);
    __builtin_amdgcn_sched_barrier(0);
    o[2] = MFMAX(f0, pb, o[2]);
    __builtin_amdgcn_sched_barrier(0);
    o[3] = MFMAX(f1, pb, o[3]);
    __builtin_amdgcn_sched_barrier(0);
}
__device__ __forceinline__ i32x8 exp_packx(const f32x16& p0, const f32x16& p1, int any) {
    i32x8 w;
#pragma unroll
    for (int g = 0; g < 4; ++g) {
        int a = __builtin_amdgcn_cvt_pk_fp8_f32(__builtin_amdgcn_exp2f(p0[4 * g + 0]), __builtin_amdgcn_exp2f(p0[4 * g + 1]), any, false);
        a = __builtin_amdgcn_cvt_pk_fp8_f32(__builtin_amdgcn_exp2f(p0[4 * g + 2]), __builtin_amdgcn_exp2f(p0[4 * g + 3]), a, true); w[g] = a;
        int b = __builtin_amdgcn_cvt_pk_fp8_f32(__builtin_amdgcn_exp2f(p1[4 * g + 0]), __builtin_amdgcn_exp2f(p1[4 * g + 1]), any, false);
        b = __builtin_amdgcn_cvt_pk_fp8_f32(__builtin_amdgcn_exp2f(p1[4 * g + 2]), __builtin_amdgcn_exp2f(p1[4 * g + 3]), b, true); w[4 + g] = b;
    }
    return w;
}
#endif
#ifdef MLA_PIPE8
template <int NDC> __device__ __forceinline__ void qk_tile8_free(f32x16& p0, f32x16& p1, const LAS unsigned char* kl, const i64 (&q)[NDC]) {
#pragma unroll
    for (int i = 0; i < 16; ++i) { p0[i] = 0.f; p1[i] = 0.f; }
#pragma unroll
    for (int d0 = 0; d0 < NDC; ++d0) {
        const i64 a0 = *(const LAS i64*)(kl + d0 * 16), a1 = *(const LAS i64*)(kl + 32 * KS8 + d0 * 16);
        p0 = MFMA32F8(a0, q[d0], p0); p1 = MFMA32F8(a1, q[d0], p1);
    }
}
__device__ __forceinline__ float sm_core_scaled(f32x16& p0, f32x16& p1, float& m, float& l, const float C2) {
    float tm = p0[0];
#pragma unroll
    for (int r = 1; r < 16; ++r) tm = fmaxf(tm, p0[r]);
#pragma unroll
    for (int r = 0; r < 16; ++r) tm = fmaxf(tm, p1[r]);
    tm = swapmax(tm);
    const float mn = fmaxf(m, tm);
    const float alpha = __builtin_amdgcn_exp2f((m - mn) * C2);
    m = mn;
    const float mc = -mn * C2;
    float ps = 0.f;
#pragma unroll
    for (int r = 0; r < 16; ++r) { p0[r] = __builtin_amdgcn_exp2f(__builtin_fmaf(p0[r], C2, mc)); ps += p0[r]; }
#pragma unroll
    for (int r = 0; r < 16; ++r) { p1[r] = __builtin_amdgcn_exp2f(__builtin_fmaf(p1[r], C2, mc)); ps += p1[r]; }
    ps = swapsum(ps);
    l = l * alpha + ps;
    return alpha;
}
#endif
#ifdef MLA_PIPE8
struct MlaPtrs { const bf16* Q; const bf16* K; const bf16* V; const bf16* Z; bf16* O; };
__device__ __forceinline__ void mla_mask(f32x16& p0, f32x16& p1, int dq) {
#pragma unroll
    for (int r = 0; r < 16; ++r) { const int c = (r & 3) + 8 * (r >> 2);
        if (c > dq) p0[r] = -__builtin_inff();
        if (c + 32 > dq) p1[r] = -__builtin_inff(); }
}
__device__ __forceinline__ void mla_unit(LAS unsigned char* lds, const MlaPtrs& P, int head, int qb, int tid_in, int wave, int lane_in) {
    int tid = tid_in; asm volatile("" : "+v"(tid)); const int lane = tid & 63; (void)lane_in;
    const int r32 = lane & 31, hi = lane >> 5;
    const int q0 = qb * 256, qw = q0 + wave * 32, tq = qw + r32;
    i64 q[12];
    { const unsigned char* qp = (const unsigned char*)P.Q + (size_t)tq * 3072 + head * 192 + hi * 8;
#pragma unroll
      for (int d0 = 0; d0 < 12; ++d0) q[d0] = *(const GAS i64*)(qp + d0 * 16); }
    const int NT = 4 * (qb + 1);
    const int srow = tid >> 3, sc8 = tid & 7;
    const unsigned char* kg = (const unsigned char*)P.K + (size_t)head * 192 + (size_t)srow * 3072 + sc8 * 8;
    const unsigned char* vg = (const unsigned char*)P.V + ((size_t)head * 128 + (tid >> 2)) * S + (tid & 3) * 16;
    LAS unsigned char* kst = lds + srow * KS8 + sc8 * 8;
    LAS unsigned char* vst = lds + 2 * MLA_KB8 + (tid >> 2) * VS8 + (tid & 3) * 16;
    const LAS unsigned char* kl = lds + r32 * KS8 + hi * 8;
    const LAS unsigned char* vl = lds + 2 * MLA_KB8 + r32 * VS8 + hi * 8;
    u32x2 sk0, sk1, sk2; u32x4 sv0;
#define MLA_LOADK(j) do { const unsigned char* kp_ = kg + (size_t)(j) * (64 * 3072); sk0 = *(const GAS u32x2*)(kp_); sk1 = *(const GAS u32x2*)(kp_ + 64); sk2 = *(const GAS u32x2*)(kp_ + 128); } while (0)
#define MLA_LOADV(j) do { sv0 = *(const GAS u32x4*)(vg + (size_t)(j) * 64); } while (0)
#define MLA_STOREK(b) do { LAS unsigned char* kd_ = kst + (b) * MLA_KB8; *(LAS u32x2*)(kd_) = sk0; *(LAS u32x2*)(kd_ + 64) = sk1; *(LAS u32x2*)(kd_ + 128) = sk2; } while (0)
#define MLA_STOREV(b) do { LAS unsigned char* vd_ = vst + (b) * VB8; *(LAS u32x2*)(vd_) = (u32x2){sv0.x, sv0.y}; *(LAS u32x2*)(vd_ + 8) = (u32x2){sv0.z, sv0.w}; } while (0)
    float m = -1e30f, l = 0.f; f32x16 o[4];
#pragma unroll
    for (int d = 0; d < 4; ++d)
#pragma unroll
        for (int r = 0; r < 16; ++r) o[d][r] = 0.f;
    f32x16 pA0, pA1, pB0, pB1;
    MLA_LOADK(0); MLA_LOADV(0); MLA_STOREK(0); MLA_STOREV(0);
    MLA_LOADK(1);
    __syncthreads();
    qk_tile8<12>(pA0, pA1, kl, q);
    if (63 > qw) mla_mask(pA0, pA1, tq - 4 * hi);
    MLA_STOREK(1);
    if (2 < NT) MLA_LOADK(2);
    MLA_LOADV(1);
    __syncthreads();
#define MLA_SGB1() do { __builtin_amdgcn_sched_group_barrier(0x100, 2, 0); __builtin_amdgcn_sched_group_barrier(0x008, 1, 0); __builtin_amdgcn_sched_group_barrier(0x002, 6, 0); \
        __builtin_amdgcn_sched_group_barrier(0x008, 1, 0); __builtin_amdgcn_sched_group_barrier(0x002, 6, 0); } while (0)
#define MLA_SGB() do { MLA_SGB1(); MLA_SGB1(); MLA_SGB1(); MLA_SGB1(); MLA_SGB1(); MLA_SGB1(); MLA_SGB1(); MLA_SGB1(); MLA_SGB1(); MLA_SGB1(); MLA_SGB1(); MLA_SGB1(); } while (0)
#define MLA_STEP(PX0, PX1, PY0, PY1, j) do { \
        const int kb1_ = 64 * ((j) + 1); \
        const bool a1_ = ((j) + 1 < NT) && (kb1_ <= qw + 31), a0_ = (64 * (j) <= qw + 31); \
        float alpha_ = 1.f; i64 pb_[4]; \
        if (a1_) { \
            __builtin_amdgcn_sched_barrier(0); \
            qk_tile8_free<12>(PY0, PY1, kl + (((j) + 1) & 1) * MLA_KB8, q); \
            alpha_ = sm_core_scaled(PX0, PX1, m, l, QS_MLA); \
            pb_[0] = packp8<0>(PX0); pb_[1] = packp8<1>(PX0); pb_[2] = packp8<0>(PX1); pb_[3] = packp8<1>(PX1); \
            MLA_SGB(); \
            __builtin_amdgcn_sched_barrier(0); \
            if (kb1_ + 63 > qw) mla_mask(PY0, PY1, tq - kb1_ - 4 * hi); \
        } else if (a0_) { \
            alpha_ = sm_core_scaled(PX0, PX1, m, l, QS_MLA); \
            pb_[0] = packp8<0>(PX0); pb_[1] = packp8<1>(PX0); pb_[2] = packp8<0>(PX1); pb_[3] = packp8<1>(PX1); \
        } \
        if (a0_) { \
            if (!__all(alpha_ == 1.f)) { _Pragma("unroll") for (int d_ = 0; d_ < 4; ++d_) _Pragma("unroll") for (int r_ = 0; r_ < 16; ++r_) o[d_][r_] *= alpha_; } \
            pv_tile8(o, pb_, vl + ((j) & 1) * VB8); \
        } \
        if ((j) + 2 < NT) MLA_STOREK((j) & 1); \
        if ((j) + 1 < NT) MLA_STOREV(((j) + 1) & 1); \
        if ((j) + 3 < NT) MLA_LOADK((j) + 3); \
        if ((j) + 2 < NT) MLA_LOADV((j) + 2); \
        __syncthreads(); } while (0)
    for (int j = 0; j < NT; j += 2) {
        MLA_STEP(pA0, pA1, pB0, pB1, j);
        MLA_STEP(pB0, pB1, pA0, pA1, j + 1);
    }
#undef MLA_STEP
#undef MLA_SGB
#undef MLA_SGB1
#undef MLA_LOADK
#undef MLA_LOADV
#undef MLA_STOREK
#undef MLA_STOREV
    const float inv = (1.f / 256.f) / l;
    const bf16* zp = P.Z + (size_t)tq * 2048 + head * 128 + 4 * hi;
    bf16* op = P.O + (size_t)tq * 4096 + head * 128 + 4 * hi;
#pragma unroll
    for (int d0 = 0; d0 < 4; ++d0)
#pragma unroll
        for (int rg = 0; rg < 4; ++rg) { const int dim = 32 * d0 + 8 * rg;
            const u32x2 z = *(const GAS u32x2*)(zp + dim);
            u32x2 w; w.x = pk2(o[d0][4 * rg + 0] * inv * bflo(z.x), o[d0][4 * rg + 1] * inv * bfhi(z.x)); w.y = pk2(o[d0][4 * rg + 2] * inv * bflo(z.y), o[d0][4 * rg + 3] * inv * bfhi(z.y));
            *(GAS u32x2*)(op + dim) = w; }
}
#elif defined(MLA_PIPE)
struct MlaPtrs { const bf16* Q; const bf16* K; const bf16* V; const bf16* Z; bf16* O; };
__device__ __forceinline__ void mla_mask(f32x16& p0, f32x16& p1, int dq) {
#pragma unroll
    for (int r = 0; r < 16; ++r) { const int c = (r & 3) + 8 * (r >> 2);
        if (c > dq) p0[r] = -__builtin_inff();
        if (c + 32 > dq) p1[r] = -__builtin_inff(); }
}
__device__ __forceinline__ void mla_unit(LAS unsigned char* lds, const MlaPtrs& P, int head, int qb, int tid_in, int wave, int lane_in) {
    int tid = tid_in; asm volatile("" : "+v"(tid)); const int lane = tid & 63; (void)lane_in;
    const int r32 = lane & 31, hi = lane >> 5;
    const int q0 = qb * 256, qw = q0 + wave * 32, tq = qw + r32;
    bf16x8 q[8];
    LAS unsigned char* ql = lds + MLA_QL + wave * 4096 + lane * 16;
    { const bf16* qp = P.Q + (size_t)tq * 3072 + head * 192 + hi * 8;
#pragma unroll
      for (int d0 = 0; d0 < 8; ++d0) q[d0] = *(const GAS bf16x8*)(qp + d0 * 16);
#pragma unroll
      for (int d0 = 8; d0 < 12; ++d0) *(LAS bf16x8*)(ql + (d0 - 8) * 1024) = *(const GAS bf16x8*)(qp + d0 * 16); }
    const int NT = 4 * (qb + 1);
    const int srow = tid >> 3, sc8 = tid & 7;
    const unsigned char* kg = (const unsigned char*)P.K + (size_t)head * 384 + (size_t)srow * 6144 + sc8 * 16;
    const unsigned char* vg = (const unsigned char*)P.V + (size_t)head * 256 + (size_t)srow * 4096 + sc8 * 16;
    LAS unsigned char* kst = lds + srow * KS_M + sc8 * 16;
    LAS unsigned char* vst = lds + 2 * MLA_KB + srow * VS + sc8 * 16;
    const LAS unsigned char* kl = lds + r32 * KS_M + hi * 16;
    const LAS unsigned char* vl = lds + 2 * MLA_KB + (4 * hi + ((lane & 15) >> 2)) * VS + (16 * ((lane >> 4) & 1) + 4 * (lane & 3)) * 2;
    u32x4 sk0, sk1, sk2, sv0, sv1;
#define MLA_LOADK(j) do { const unsigned char* kp_ = kg + (size_t)(j) * (64 * 6144); sk0 = *(const GAS u32x4*)(kp_); sk1 = *(const GAS u32x4*)(kp_ + 128); sk2 = *(const GAS u32x4*)(kp_ + 256); } while (0)
#define MLA_LOADV(j) do { const unsigned char* vp_ = vg + (size_t)(j) * (64 * 4096); sv0 = *(const GAS u32x4*)(vp_); sv1 = *(const GAS u32x4*)(vp_ + 128); } while (0)
#define MLA_STOREK(b) do { LAS unsigned char* kd_ = kst + (b) * MLA_KB; *(LAS u32x4*)(kd_) = sk0; *(LAS u32x4*)(kd_ + 128) = sk1; *(LAS u32x4*)(kd_ + 256) = sk2; } while (0)
#define MLA_STOREV(b) do { LAS unsigned char* vd_ = vst + (b) * VB; *(LAS u32x4*)(vd_) = sv0; *(LAS u32x4*)(vd_ + 128) = sv1; } while (0)
    float m = -1e30f, l = 0.f; f32x16 o[4];
#pragma unroll
    for (int d = 0; d < 4; ++d)
#pragma unroll
        for (int r = 0; r < 16; ++r) o[d][r] = 0.f;
    f32x16 pA0, pA1, pB0, pB1;
    MLA_LOADK(0); MLA_LOADV(0); MLA_STOREK(0); MLA_STOREV(0);
    MLA_LOADK(1);
    __syncthreads();
    qk_tile_free<12, 8, KS_M>(pA0, pA1, kl, q, ql);
    if (63 > qw) mla_mask(pA0, pA1, tq - 4 * hi);
    MLA_STOREK(1);
    if (2 < NT) MLA_LOADK(2);
    MLA_LOADV(1);
    __syncthreads();
#define MLA_SGB1(NR) do { __builtin_amdgcn_sched_group_barrier(0x100, NR, 0); __builtin_amdgcn_sched_group_barrier(0x008, 1, 0); __builtin_amdgcn_sched_group_barrier(0x002, 6, 0); \
        __builtin_amdgcn_sched_group_barrier(0x008, 1, 0); __builtin_amdgcn_sched_group_barrier(0x002, 6, 0); } while (0)
#define MLA_SGB() do { MLA_SGB1(2); MLA_SGB1(2); MLA_SGB1(2); MLA_SGB1(2); MLA_SGB1(2); MLA_SGB1(2); MLA_SGB1(2); MLA_SGB1(2); MLA_SGB1(3); MLA_SGB1(3); MLA_SGB1(3); MLA_SGB1(3); } while (0)
#define MLA_STEP(PX0, PX1, PY0, PY1, j) do { \
        const int kb1_ = 64 * ((j) + 1); \
        const bool a1_ = ((j) + 1 < NT) && (kb1_ <= qw + 31), a0_ = (64 * (j) <= qw + 31); \
        float alpha_ = 1.f; bf16x8 pb_[4]; \
        if (a1_) { \
            __builtin_amdgcn_sched_barrier(0); \
            qk_tile_free<12, 8, KS_M>(PY0, PY1, kl + (((j) + 1) & 1) * MLA_KB, q, ql); \
            alpha_ = sm_core(PX0, PX1, m, l); \
            pb_[0] = packp<0>(PX0); pb_[1] = packp<1>(PX0); pb_[2] = packp<0>(PX1); pb_[3] = packp<1>(PX1); \
            MLA_SGB(); \
            __builtin_amdgcn_sched_barrier(0); \
            if (kb1_ + 63 > qw) mla_mask(PY0, PY1, tq - kb1_ - 4 * hi); \
        } else if (a0_) { \
            alpha_ = sm_core(PX0, PX1, m, l); \
            pb_[0] = packp<0>(PX0); pb_[1] = packp<1>(PX0); pb_[2] = packp<0>(PX1); pb_[3] = packp<1>(PX1); \
        } \
        if (a0_) { \
            if (!__all(alpha_ == 1.f)) { _Pragma("unroll") for (int d_ = 0; d_ < 4; ++d_) _Pragma("unroll") for (int r_ = 0; r_ < 16; ++r_) o[d_][r_] *= alpha_; } \
            pv_tile(o, pb_, vl + ((j) & 1) * VB); \
        } \
        if ((j) + 2 < NT) MLA_STOREK((j) & 1); \
        if ((j) + 1 < NT) MLA_STOREV(((j) + 1) & 1); \
        if ((j) + 3 < NT) MLA_LOADK((j) + 3); \
        if ((j) + 2 < NT) MLA_LOADV((j) + 2); \
        __syncthreads(); } while (0)
    for (int j = 0; j < NT; j += 2) {
        MLA_STEP(pA0, pA1, pB0, pB1, j);
        MLA_STEP(pB0, pB1, pA0, pA1, j + 1);
    }
#undef MLA_STEP
#undef MLA_SGB
#undef MLA_SGB1
#undef MLA_LOADK
#undef MLA_LOADV
#undef MLA_STOREK
#undef MLA_STOREV
    const float inv = 1.f / l;
    const bf16* zp = P.Z + (size_t)tq * 2048 + head * 128 + 4 * hi;
    bf16* op = P.O + (size_t)tq * 4096 + head * 128 + 4 * hi;
#pragma unroll
    for (int d0 = 0; d0 < 4; ++d0)
#pragma unroll
        for (int rg = 0; rg < 4; ++rg) { const int dim = 32 * d0 + 8 * rg;
            const u32x2 z = *(const GAS u32x2*)(zp + dim);
            u32x2 w; w.x = pk2(o[d0][4 * rg + 0] * inv * bflo(z.x), o[d0][4 * rg + 1] * inv * bfhi(z.x)); w.y = pk2(o[d0][4 * rg + 2] * inv * bflo(z.y), o[d0][4 * rg + 3] * inv * bfhi(z.y));
            *(GAS u32x2*)(op + dim) = w; }
}

#else
#if defined(MLA_MXQ)
struct MlaPtrs { const bf16* Q; const bf16* K; const bf16* V; const bf16* Z; bf16* O; };
constexpr int VBQ = 160 * VSX;
static_assert(2 * MLA_KBX + 2 * VBQ <= 131072, "MLA mxq LDS map");
__device__ __forceinline__ void mla_maskq(f32x16& p0, f32x16& p1, int dq) {
#pragma unroll
    for (int r = 0; r < 16; ++r) { const int c = (r & 3) + 8 * (r >> 2);
        if (c > dq) p0[r] = -__builtin_inff();
        if (c + 32 > dq) p1[r] = -__builtin_inff(); }
}
__device__ __forceinline__ float mla_rowmaxq(const f32x16& p0, const f32x16& p1) {
    float tm = p0[0];
#pragma unroll
    for (int r = 1; r < 16; ++r) tm = fmaxf(tm, p0[r]);
#pragma unroll
    for (int r = 0; r < 16; ++r) tm = fmaxf(tm, p1[r]);
    return swapmax(tm);
}
__device__ __forceinline__ void mla_unit(LAS unsigned char* lds, const MlaPtrs& P, int head, int qb, int tid_in, int wave, int lane_in) {
    int tid = tid_in; asm volatile("" : "+v"(tid)); const int lane = tid & 63; (void)lane_in;
    const int r32 = lane & 31, hi = lane >> 5;
    const int q0 = qb * 256, qw = q0 + wave * 32, tq = qw + r32;
    i32x8 q[3];
    { const unsigned char* qp = (const unsigned char*)P.Q + (size_t)tq * 3072 + head * 192 + hi * 32;
#pragma unroll
      for (int s = 0; s < 3; ++s) { const u32x4 a = *(const GAS u32x4*)(qp + 64 * s), b = *(const GAS u32x4*)(qp + 64 * s + 16);
          q[s] = (i32x8){(int)a.x, (int)a.y, (int)a.z, (int)a.w, (int)b.x, (int)b.y, (int)b.z, (int)b.w}; } }
    const int NT = 4 * (qb + 1);
    const int srow = tid >> 3, sc8 = tid & 7;
    const unsigned char* kg = (const unsigned char*)P.K + (size_t)head * 192 + (size_t)srow * 3072 + sc8 * 8;
    const unsigned char* vg = (const unsigned char*)P.V + ((size_t)head * 128 + (tid >> 2)) * S + (tid & 3) * 16;
    LAS unsigned char* kst = lds + srow * KSX + sc8 * 8;
    LAS unsigned char* vst = lds + 2 * MLA_KBX + (tid >> 2) * VSX + (tid & 3) * 16;
    const LAS unsigned char* kl = lds + r32 * KSX + hi * 32;
    const LAS unsigned char* vl = lds + 2 * MLA_KBX + r32 * VSX + hi * 32;
    u32x2 sk0, sk1, sk2; u32x4 sv0;
#define MLA_LOADK(j) do { const unsigned char* kp_ = kg + (size_t)(j) * (64 * 3072); sk0 = *(const GAS u32x2*)(kp_); sk1 = *(const GAS u32x2*)(kp_ + 64); sk2 = *(const GAS u32x2*)(kp_ + 128); } while (0)
#define MLA_LOADV(j) do { sv0 = *(const GAS u32x4*)(vg + (size_t)(j) * 64); } while (0)
#define MLA_STOREK(b) do { LAS unsigned char* kd_ = kst + (b) * MLA_KBX; *(LAS u32x2*)(kd_) = sk0; *(LAS u32x2*)(kd_ + 64) = sk1; *(LAS u32x2*)(kd_ + 128) = sk2; } while (0)
#define MLA_STOREV(b) do { LAS unsigned char* vd_ = vst + (b) * VBQ; *(LAS u32x2*)(vd_) = (u32x2){sv0.x, sv0.y}; *(LAS u32x2*)(vd_ + 8) = (u32x2){sv0.z, sv0.w}; } while (0)
    f32x16 o[5], mref;
#pragma unroll
    for (int d = 0; d < 5; ++d)
#pragma unroll
        for (int r = 0; r < 16; ++r) o[d][r] = 0.f;
#pragma unroll
    for (int r = 0; r < 16; ++r) mref[r] = MXL_REF;
    f32x16 p0, p1;
    if (tid < 256) { const int slot = tid >> 7, row = (tid >> 2) & 31, ch = tid & 3; const unsigned v1 = (row == 0 || row == 4) ? 0x38383838u : 0u;
        *(LAS u32x4*)(lds + 2 * MLA_KBX + slot * VBQ + (128 + row) * VSX + ch * 16) = (u32x4){v1, v1, v1, v1}; }
    MLA_LOADK(0); MLA_LOADV(0); MLA_STOREK(0); MLA_STOREV(0);
    MLA_LOADK(1);
    __syncthreads();
    qk_tilexl(p0, p1, mref, kl, q);
    if (63 > qw) mla_maskq(p0, p1, tq - 4 * hi);
    { const float dlt = mla_rowmaxq(p0, p1) - MXL_REF;
#pragma unroll
      for (int r = 0; r < 16; ++r) { p0[r] -= dlt; p1[r] -= dlt; mref[r] -= dlt; } }
    i32x8 pbA = byte_packx(p0, p1), pbB = pbA;
    MLA_STOREK(1);
    if (2 < NT) MLA_LOADK(2);
    MLA_LOADV(1);
    __syncthreads();
    asm volatile("" : "+v"(q[0]), "+v"(q[1]), "+v"(q[2]));
    int sc1_ = 0x7f7f7f7f; asm volatile("" : "+v"(sc1_));
#define SB() __builtin_amdgcn_sched_barrier(0)
#define MFMA_T(acc, a, b) asm volatile("s_nop 1\n\tv_mfma_scale_f32_32x32x64_f8f6f4 %0, %1, %2, %0, %3, %3 op_sel_hi:[0,0,0]" : "+v"(acc) : "v"(a), "v"(b), "v"(sc1_))
#define MFMA_C(acc, a, b, c) asm volatile("s_nop 1\n\tv_mfma_scale_f32_32x32x64_f8f6f4 %0, %1, %2, %3, %4, %4 op_sel_hi:[0,0,0]" : "=&v"(acc) : "v"(a), "v"(b), "v"(c), "v"(sc1_))
#define CVT8(P, R0, PB, W0) do { unsigned w_ = __builtin_amdgcn_cvt_pk_u8_f32(P[(R0) + 0], 0, 0u); w_ = __builtin_amdgcn_cvt_pk_u8_f32(P[(R0) + 1], 1, w_); w_ = __builtin_amdgcn_cvt_pk_u8_f32(P[(R0) + 2], 2, w_); \
        w_ = __builtin_amdgcn_cvt_pk_u8_f32(P[(R0) + 3], 3, w_); PB[(W0)] = (int)w_; \
        w_ = __builtin_amdgcn_cvt_pk_u8_f32(P[(R0) + 4], 0, 0u); w_ = __builtin_amdgcn_cvt_pk_u8_f32(P[(R0) + 5], 1, w_); w_ = __builtin_amdgcn_cvt_pk_u8_f32(P[(R0) + 6], 2, w_); \
        w_ = __builtin_amdgcn_cvt_pk_u8_f32(P[(R0) + 7], 3, w_); PB[(W0) + 1] = (int)w_; } while (0)
#define MLA_STEP(PBX, PBY, j) do { \
        const int kb1_ = 64 * ((j) + 1); \
        if (64 * (j) <= qw + 31) { \
            const LAS unsigned char* kn_ = kl + (((j) + 1) & 1) * MLA_KBX; const LAS unsigned char* vj_ = vl + ((j) & 1) * VBQ; \
            SB(); \
            i32x8 a0_f = ldsx(kn_), a1_f = ldsx(kn_ + 32 * KSX); \
            SB(); MFMA_C(p0, a0_f, q[0], mref); SB(); \
            a0_f = ldsx(kn_ + 64); \
            SB(); MFMA_C(p1, a1_f, q[0], mref); SB(); \
            a1_f = ldsx(kn_ + 32 * KSX + 64); \
            SB(); MFMA_T(p0, a0_f, q[1]); SB(); \
            a0_f = ldsx(kn_ + 128); \
            SB(); MFMA_T(p1, a1_f, q[1]); SB(); \
            a1_f = ldsx(kn_ + 32 * KSX + 128); \
            SB(); MFMA_T(p0, a0_f, q[2]); SB(); \
            a0_f = ldsx(vj_ + 128 * VSX); \
            SB(); MFMA_T(p1, a1_f, q[2]); SB(); \
            a1_f = ldsx(vj_); \
            SB(); MFMA_T(o[4], a0_f, PBX); SB(); \
            a0_f = ldsx(vj_ + 32 * VSX); \
            SB(); MFMA_T(o[0], a1_f, PBX); SB(); \
            a1_f = ldsx(vj_ + 64 * VSX); \
            float tmx_ = p0[0]; _Pragma("unroll") for (int r_ = 1; r_ < 16; ++r_) tmx_ = fmaxf(tmx_, p0[r_]); \
            CVT8(p0, 0, PBY, 0); CVT8(p0, 8, PBY, 2); \
            SB(); MFMA_T(o[1], a0_f, PBX); SB(); \
            a0_f = ldsx(vj_ + 96 * VSX); \
            _Pragma("unroll") for (int r_ = 0; r_ < 16; ++r_) tmx_ = fmaxf(tmx_, p1[r_]); \
            CVT8(p1, 0, PBY, 4); \
            SB(); MFMA_T(o[2], a1_f, PBX); SB(); \
            CVT8(p1, 8, PBY, 6); tmx_ = swapmax(tmx_); \
            SB(); MFMA_T(o[3], a0_f, PBX); SB(); \
            const bool diag_ = kb1_ + 63 > qw; \
            if (diag_ || !__all(tmx_ <= MXL_T)) {               \
                asm volatile("s_nop 15\n\ts_nop 15\n\ts_nop 15" ::: "memory");     \
                if (diag_) mla_maskq(p0, p1, tq - kb1_ - 4 * hi); \
                const float dlt_ = fmaxf(mla_rowmaxq(p0, p1) - MXL_REF, 0.f); const float alpha_ = __builtin_amdgcn_exp2f(-0.125f * dlt_); \
                _Pragma("unroll") for (int r_ = 0; r_ < 16; ++r_) { p0[r_] -= dlt_; p1[r_] -= dlt_; mref[r_] -= dlt_; } \
                _Pragma("unroll") for (int d_ = 0; d_ < 5; ++d_) _Pragma("unroll") for (int r_ = 0; r_ < 16; ++r_) o[d_][r_] *= alpha_; \
                PBY = byte_packx(p0, p1); } \
        } \
        if ((j) + 2 < NT) MLA_STOREK((j) & 1); \
        if ((j) + 1 < NT) MLA_STOREV(((j) + 1) & 1); \
        if ((j) + 3 < NT) MLA_LOADK((j) + 3); \
        if ((j) + 2 < NT) MLA_LOADV((j) + 2); \
        __syncthreads(); } while (0)
    for (int j = 0; j < NT; j += 2) {
        MLA_STEP(pbA, pbB, j);
        MLA_STEP(pbB, pbA, j + 1);
    }
    asm volatile("s_nop 15\n\ts_nop 15" ::: "memory");
#undef MLA_STEP
#undef CVT8
#undef MFMA_T
#undef MFMA_C
#undef SB
#undef MLA_LOADK
#undef MLA_LOADV
#undef MLA_STOREK
#undef MLA_STOREV
    const float inv = 1.f / o[4][0];
    const bf16* zp = P.Z + (size_t)tq * 2048 + head * 128 + 4 * hi;
    bf16* op = P.O + (size_t)tq * 4096 + head * 128 + 4 * hi;
#pragma unroll
    for (int d0 = 0; d0 < 4; ++d0)
#pragma unroll
        for (int rg = 0; rg < 4; ++rg) { const int dim = 32 * d0 + 8 * rg;
            const u32x2 z = *(const GAS u32x2*)(zp + dim);
            u32x2 w; w.x = pk2(o[d0][4 * rg + 0] * inv * bflo(z.x), o[d0][4 * rg + 1] * inv * bfhi(z.x)); w.y = pk2(o[d0][4 * rg + 2] * inv * bflo(z.y), o[d0][4 * rg + 3] * inv * bfhi(z.y));
            *(GAS u32x2*)(op + dim) = w; }
}

#elif defined(MLA_BIGX)
struct MlaPtrs { const bf16* Q; const bf16* K; const bf16* V; const bf16* Z; bf16* O; };
__device__ __forceinline__ void mla_unit(LAS unsigned char* lds, const MlaPtrs& P, int head, int qb, int tid_in, int wave, int lane_in) {
    int tid = tid_in; asm volatile("" : "+v"(tid)); const int lane = tid & 63; (void)lane_in;
    const int r32 = lane & 31, hi = lane >> 5;
    const int q0 = qb * 256, qw = q0 + wave * 32, tq = qw + r32;
    i32x8 q[3];
    { const unsigned char* qp = (const unsigned char*)P.Q + (size_t)tq * 3072 + head * 192 + hi * 32;
#pragma unroll
      for (int s = 0; s < 3; ++s) { const u32x4 a = *(const GAS u32x4*)(qp + 64 * s), b = *(const GAS u32x4*)(qp + 64 * s + 16);
          q[s] = (i32x8){(int)a.x, (int)a.y, (int)a.z, (int)a.w, (int)b.x, (int)b.y, (int)b.z, (int)b.w}; } }
    const int NT = 4 * (qb + 1), NTB = NT / 2;
    constexpr int VSB = 144, VBB = 128 * VSB, KBB = 128 * KSX;
    static_assert(2 * KBB + 3 * VBB <= 131072, "MLA big-tile LDS map");
    const int srow = tid >> 3, sc8 = tid & 7;
    const unsigned char* kg = (const unsigned char*)P.K + (size_t)head * 192 + (size_t)srow * 3072 + sc8 * 8;
    const unsigned char* vg = (const unsigned char*)P.V + ((size_t)head * 128 + (tid >> 2)) * S + (tid & 3) * 32;
    LAS unsigned char* kst = lds + srow * KSX + sc8 * 8;
    LAS unsigned char* vst = lds + 2 * KBB + (tid >> 2) * VSB + (tid & 3) * 32;
    const LAS unsigned char* kl = lds + r32 * KSX + hi * 32;
    const LAS unsigned char* vl = lds + 2 * KBB + r32 * VSB + hi * 32;
    u32x2 sk0, sk1, sk2, sk3, sk4, sk5; u32x4 sv0, sv1;
#define MLA_LOAD(J) do { const unsigned char* kp_ = kg + (size_t)(J) * (128 * 3072); const unsigned char* vp_ = vg + (size_t)(J) * 128; \
        sk0 = *(const GAS u32x2*)(kp_); sk1 = *(const GAS u32x2*)(kp_ + 64); sk2 = *(const GAS u32x2*)(kp_ + 128); \
        sk3 = *(const GAS u32x2*)(kp_ + 64 * 3072); sk4 = *(const GAS u32x2*)(kp_ + 64 * 3072 + 64); sk5 = *(const GAS u32x2*)(kp_ + 64 * 3072 + 128); \
        sv0 = *(const GAS u32x4*)(vp_); sv1 = *(const GAS u32x4*)(vp_ + 16); } while (0)
#define MLA_STORE(b, vb) do { LAS unsigned char* kd_ = kst + (b) * KBB; LAS unsigned char* vd_ = vst + (vb) * VBB; \
        *(LAS u32x2*)(kd_) = sk0; *(LAS u32x2*)(kd_ + 64) = sk1; *(LAS u32x2*)(kd_ + 128) = sk2; \
        *(LAS u32x2*)(kd_ + 64 * KSX) = sk3; *(LAS u32x2*)(kd_ + 64 * KSX + 64) = sk4; *(LAS u32x2*)(kd_ + 64 * KSX + 128) = sk5; \
        *(LAS u32x2*)(vd_) = (u32x2){sv0.x, sv0.y}; *(LAS u32x2*)(vd_ + 8) = (u32x2){sv0.z, sv0.w}; *(LAS u32x2*)(vd_ + 16) = (u32x2){sv1.x, sv1.y}; *(LAS u32x2*)(vd_ + 24) = (u32x2){sv1.z, sv1.w}; } while (0)
    MLA_LOAD(0); MLA_STORE(0, 0);
    __syncthreads();
    asm volatile("" : "+v"(q[0]), "+v"(q[1]), "+v"(q[2]));
    f32x16 o[5], mref;
#pragma unroll
    for (int d = 0; d < 5; ++d)
#pragma unroll
        for (int r = 0; r < 16; ++r) o[d][r] = 0.f;
#pragma unroll
    for (int r = 0; r < 16; ++r) mref[r] = MXL_REF;
    const int one8 = (r32 == 0 || r32 == 4) ? 0x38383838 : 0;
    const i32x8 ones = {one8, one8, one8, one8, one8, one8, one8, one8};
    const bool trail = wave >= 4;
    i32x8 pb = {};
    int vb_cur = 0, vb_prev = 2;
    for (int J = 0; J < NTB; ++J) {
        int vb_next = vb_cur + 1; if (vb_next == 3) vb_next = 0;
        if (J + 1 < NTB) MLA_LOAD(J + 1);
#pragma unroll
        for (int sub = 0; sub < 2; ++sub) {
        const int j = 2 * J + sub, kb = 64 * j;
        if (trail && j > 0 && kb - 64 <= qw + 31) pv_tilexl<VSB>(o, pb, ones, vl + (sub == 0 ? vb_prev * VBB + 64 : vb_cur * VBB));
        if (kb <= qw + 31) {
            f32x16 p0, p1;
            qk_tilexl(p0, p1, mref, kl + (J & 1) * KBB + sub * 64 * KSX, q);
            if (kb + 63 > qw) {
                const int dq = tq - kb - 4 * hi;
#pragma unroll
                for (int r = 0; r < 16; ++r) { const int c = (r & 3) + 8 * (r >> 2);
                    if (c > dq) p0[r] = -__builtin_inff();
                    if (c + 32 > dq) p1[r] = -__builtin_inff(); }
            }
            float tm = p0[0];
#pragma unroll
            for (int r = 1; r < 16; ++r) tm = fmaxf(tm, p0[r]);
#pragma unroll
            for (int r = 0; r < 16; ++r) tm = fmaxf(tm, p1[r]);
            tm = swapmax(tm);
            if (j == 0 || !__all(tm <= MXL_T)) {
                const float dlt = (j == 0) ? tm - MXL_REF : fmaxf(tm - MXL_REF, 0.f);
                const float alpha = __builtin_amdgcn_exp2f(-0.125f * dlt);
#pragma unroll
                for (int r = 0; r < 16; ++r) { p0[r] -= dlt; p1[r] -= dlt; mref[r] -= dlt; }
                if (j > 0) {
#pragma unroll
                    for (int d = 0; d < 5; ++d)
#pragma unroll
                        for (int r = 0; r < 16; ++r) o[d][r] *= alpha;
                }
            }
            pb = byte_packx(p0, p1);
            if (!trail) pv_tilexl<VSB>(o, pb, ones, vl + vb_cur * VBB + sub * 64);
        }
        }
        if (J + 1 < NTB) MLA_STORE((J + 1) & 1, vb_next);
        __syncthreads();
        vb_prev = vb_cur; vb_cur = vb_next;
    }
    if (trail && 64 * (NT - 1) <= qw + 31) pv_tilexl<VSB>(o, pb, ones, vl + vb_prev * VBB + 64);
    __syncthreads();
#undef MLA_LOAD
#undef MLA_STORE
    const float inv = 1.f / o[4][0];
    const bf16* zp = P.Z + (size_t)tq * 2048 + head * 128 + 4 * hi;
    bf16* op = P.O + (size_t)tq * 4096 + head * 128 + 4 * hi;
#pragma unroll
    for (int d0 = 0; d0 < 4; ++d0)
#pragma unroll
        for (int rg = 0; rg < 4; ++rg) { const int dim = 32 * d0 + 8 * rg;
            const u32x2 z = *(const GAS u32x2*)(zp + dim);
            u32x2 w; w.x = pk2(o[d0][4 * rg + 0] * inv * bflo(z.x), o[d0][4 * rg + 1] * inv * bfhi(z.x)); w.y = pk2(o[d0][4 * rg + 2] * inv * bflo(z.y), o[d0][4 * rg + 3] * inv * bfhi(z.y));
            *(GAS u32x2*)(op + dim) = w; }
}

#elif defined(MLA_MXL)
struct MlaPtrs { const bf16* Q; const bf16* K; const bf16* V; const bf16* Z; bf16* O; };
__device__ __forceinline__ void mla_unit(LAS unsigned char* lds, const MlaPtrs& P, int head, int qb, int tid_in, int wave, int lane_in) {
    int tid = tid_in; asm volatile("" : "+v"(tid)); const int lane = tid & 63; (void)lane_in;
    const int r32 = lane & 31, hi = lane >> 5;
    const int q0 = qb * 256, qw = q0 + wave * 32, tq = qw + r32;
    i32x8 q[3];
    { const unsigned char* qp = (const unsigned char*)P.Q + (size_t)tq * 3072 + head * 192 + hi * 32;
#pragma unroll
      for (int s = 0; s < 3; ++s) { const u32x4 a = *(const GAS u32x4*)(qp + 64 * s), b = *(const GAS u32x4*)(qp + 64 * s + 16);
          q[s] = (i32x8){(int)a.x, (int)a.y, (int)a.z, (int)a.w, (int)b.x, (int)b.y, (int)b.z, (int)b.w}; } }
    const int NT = 4 * (qb + 1);
    const int srow = tid >> 3, sc8 = tid & 7;
    const unsigned char* kg = (const unsigned char*)P.K + (size_t)head * 192 + (size_t)srow * 3072 + sc8 * 8;
    const unsigned char* vg = (const unsigned char*)P.V + ((size_t)head * 128 + (tid >> 2)) * S + (tid & 3) * 16;
    LAS unsigned char* kst = lds + srow * KSX + sc8 * 8;
    LAS unsigned char* vst = lds + 2 * MLA_KBX + (tid >> 2) * VSX + (tid & 3) * 16;
    const LAS unsigned char* kl = lds + r32 * KSX + hi * 32;
    const LAS unsigned char* vl = lds + 2 * MLA_KBX + r32 * VSX + hi * 32;
    u32x2 sk0, sk1, sk2; u32x4 sv0;
#define MLA_LOAD(j) do { const unsigned char* kp_ = kg + (size_t)(j) * (64 * 3072); const unsigned char* vp_ = vg + (size_t)(j) * 64; \
        sk0 = *(const GAS u32x2*)(kp_); sk1 = *(const GAS u32x2*)(kp_ + 64); sk2 = *(const GAS u32x2*)(kp_ + 128); sv0 = *(const GAS u32x4*)(vp_); } while (0)
#define MLA_STORE(b, vb) do { LAS unsigned char* kd_ = kst + (b) * MLA_KBX; LAS unsigned char* vd_ = vst + (vb) * VBX; \
        *(LAS u32x2*)(kd_) = sk0; *(LAS u32x2*)(kd_ + 64) = sk1; *(LAS u32x2*)(kd_ + 128) = sk2; *(LAS u32x2*)(vd_) = (u32x2){sv0.x, sv0.y}; *(LAS u32x2*)(vd_ + 8) = (u32x2){sv0.z, sv0.w}; } while (0)
    MLA_LOAD(0); MLA_STORE(0, 0);
    __syncthreads();
    asm volatile("" : "+v"(q[0]), "+v"(q[1]), "+v"(q[2]));
    f32x16 o[5], mref;
#pragma unroll
    for (int d = 0; d < 5; ++d)
#pragma unroll
        for (int r = 0; r < 16; ++r) o[d][r] = 0.f;
#pragma unroll
    for (int r = 0; r < 16; ++r) mref[r] = MXL_REF;
    const int one8 = (r32 == 0 || r32 == 4) ? 0x38383838 : 0;
    const i32x8 ones = {one8, one8, one8, one8, one8, one8, one8, one8};
    const bool trail = wave >= 4;
    i32x8 pb = {}, fa = {}, fb = {};
    int vb_cur = 0, vb_prev = 2;
    for (int j = 0; j < NT; ++j) {
        const int kb = 64 * j;
        int vb_next = vb_cur + 1; if (vb_next == 3) vb_next = 0;
        if (j + 1 < NT) MLA_LOAD(j + 1);
        if (trail && j > 0 && kb - 64 <= qw + 31) pv_tilexl_pre(o, pb, ones, vl + vb_prev * VBX, fa, fb);
        if (kb <= qw + 31) {
            f32x16 p0, p1;
            qk_tilexl(p0, p1, mref, kl + (j & 1) * MLA_KBX, q);
            fa = ldsx(vl + vb_cur * VBX); fb = ldsx(vl + vb_cur * VBX + 32 * VSX);
            __builtin_amdgcn_sched_barrier(0);
            if (kb + 63 > qw) {
                const int dq = tq - kb - 4 * hi;
#pragma unroll
                for (int r = 0; r < 16; ++r) { const int c = (r & 3) + 8 * (r >> 2);
                    if (c > dq) p0[r] = -__builtin_inff();
                    if (c + 32 > dq) p1[r] = -__builtin_inff(); }
            }
            float tm = p0[0];
#pragma unroll
            for (int r = 1; r < 16; ++r) tm = fmaxf(tm, p0[r]);
#pragma unroll
            for (int r = 0; r < 16; ++r) tm = fmaxf(tm, p1[r]);
            tm = swapmax(tm);
            if (j == 0 || !__all(tm <= MXL_T)) {
#ifdef MLA_MXU
                const float dlt = (j == 0) ? tm - MXL_REF : fmaxf(tm - MXL_REF, 0.f);
                const float alpha = __builtin_amdgcn_exp2f(-0.125f * dlt);
#else
                const float dlt = (j == 0) ? tm : fmaxf(tm, 0.f);
                const float alpha = __builtin_amdgcn_exp2f(-dlt);
#endif
#pragma unroll
                for (int r = 0; r < 16; ++r) { p0[r] -= dlt; p1[r] -= dlt; mref[r] -= dlt; }
                if (j > 0) {
#pragma unroll
                    for (int d = 0; d < 5; ++d)
#pragma unroll
                        for (int r = 0; r < 16; ++r) o[d][r] *= alpha;
                }
            }
#ifdef MLA_MXU
            pb = byte_packx(p0, p1);
#else
            pb = exp_packx(p0, p1, one8);
#endif
            if (!trail) pv_tilexl_pre(o, pb, ones, vl + vb_cur * VBX, fa, fb);
        }
        if (j + 1 < NT) MLA_STORE((j + 1) & 1, vb_next);
        __syncthreads();
        vb_prev = vb_cur; vb_cur = vb_next;
    }
    if (trail && 64 * (NT - 1) <= qw + 31) pv_tilexl_pre(o, pb, ones, vl + vb_prev * VBX, fa, fb);
    __syncthreads();
#undef MLA_LOAD
#undef MLA_STORE
    const bf16* zp = P.Z + (size_t)tq * 2048 + head * 128 + 4 * hi;
#ifdef OUT_F8
    const float inv = 16.f / o[4][0];
    unsigned char* op8 = (unsigned char*)P.O + (size_t)tq * 8192 + head * 128 + 4 * hi;
#pragma unroll
    for (int d0 = 0; d0 < 4; ++d0)
#pragma unroll
        for (int rg = 0; rg < 4; ++rg) { const int dim = 32 * d0 + 8 * rg;
            const u32x2 z = *(const GAS u32x2*)(zp + dim);
            int w = __builtin_amdgcn_cvt_pk_fp8_f32(o[d0][4 * rg + 0] * inv * bflo(z.x), o[d0][4 * rg + 1] * inv * bfhi(z.x), 0, false);
            w = __builtin_amdgcn_cvt_pk_fp8_f32(o[d0][4 * rg + 2] * inv * bflo(z.y), o[d0][4 * rg + 3] * inv * bfhi(z.y), w, true);
            *(GAS unsigned*)(op8 + dim) = (unsigned)w; }
#else
    const float inv = 1.f / o[4][0];
    bf16* op = P.O + (size_t)tq * 4096 + head * 128 + 4 * hi;
#pragma unroll
    for (int d0 = 0; d0 < 4; ++d0)
#pragma unroll
        for (int rg = 0; rg < 4; ++rg) { const int dim = 32 * d0 + 8 * rg;
            const u32x2 z = *(const GAS u32x2*)(zp + dim);
            u32x2 w; w.x = pk2(o[d0][4 * rg + 0] * inv * bflo(z.x), o[d0][4 * rg + 1] * inv * bfhi(z.x)); w.y = pk2(o[d0][4 * rg + 2] * inv * bflo(z.y), o[d0][4 * rg + 3] * inv * bfhi(z.y));
            *(GAS u32x2*)(op + dim) = w; }
#endif
}

#elif defined(MLA_MXP)
struct MlaPtrs { const bf16* Q; const bf16* K; const bf16* V; const bf16* Z; bf16* O; };
__device__ __forceinline__ void mla_maskx(f32x16& p0, f32x16& p1, int dq) {
#pragma unroll
    for (int r = 0; r < 16; ++r) { const int c = (r & 3) + 8 * (r >> 2);
        if (c > dq) p0[r] = -__builtin_inff();
        if (c + 32 > dq) p1[r] = -__builtin_inff(); }
}
__device__ __forceinline__ float mla_rowmax(const f32x16& p0, const f32x16& p1) {
    float tm = p0[0];
#pragma unroll
    for (int r = 1; r < 16; ++r) tm = fmaxf(tm, p0[r]);
#pragma unroll
    for (int r = 0; r < 16; ++r) tm = fmaxf(tm, p1[r]);
    return swapmax(tm);
}
#define MXP_EXP8(P, R0) do { _Pragma("unroll") for (int r_ = (R0); r_ < (R0) + 8; ++r_) { P[r_] = __builtin_amdgcn_exp2f(__builtin_fmaf(P[r_], QS_MLA, mc_)); ps_ += P[r_]; } } while (0)
__device__ __forceinline__ void mla_unit(LAS unsigned char* lds, const MlaPtrs& P, int head, int qb, int tid_in, int wave, int lane_in) {
    int tid = tid_in; asm volatile("" : "+v"(tid)); const int lane = tid & 63; (void)lane_in;
    const int r32 = lane & 31, hi = lane >> 5;
    const int q0 = qb * 256, qw = q0 + wave * 32, tq = qw + r32;
    i32x8 q[3];
    { const unsigned char* qp = (const unsigned char*)P.Q + (size_t)tq * 3072 + head * 192 + hi * 32;
#pragma unroll
      for (int s = 0; s < 3; ++s) { const u32x4 a = *(const GAS u32x4*)(qp + 64 * s), b = *(const GAS u32x4*)(qp + 64 * s + 16);
          q[s] = (i32x8){(int)a.x, (int)a.y, (int)a.z, (int)a.w, (int)b.x, (int)b.y, (int)b.z, (int)b.w}; } }
    const int NT = 4 * (qb + 1);
    const int srow = tid >> 3, sc8 = tid & 7;
    const unsigned char* kg = (const unsigned char*)P.K + (size_t)head * 192 + (size_t)srow * 3072 + sc8 * 8;
    const unsigned char* vg = (const unsigned char*)P.V + ((size_t)head * 128 + (tid >> 2)) * S + (tid & 3) * 16;
    LAS unsigned char* kst = lds + srow * KSX + sc8 * 8;
    LAS unsigned char* vst = lds + 2 * MLA_KBX + (tid >> 2) * VSX + (tid & 3) * 16;
    const LAS unsigned char* kl = lds + r32 * KSX + hi * 32;
    const LAS unsigned char* vl = lds + 2 * MLA_KBX + r32 * VSX + hi * 32;
    u32x2 sk0, sk1, sk2; u32x4 sv0;
#define MLA_LOADK(j) do { const unsigned char* kp_ = kg + (size_t)(j) * (64 * 3072); sk0 = *(const GAS u32x2*)(kp_); sk1 = *(const GAS u32x2*)(kp_ + 64); sk2 = *(const GAS u32x2*)(kp_ + 128); } while (0)
#define MLA_LOADV(j) do { sv0 = *(const GAS u32x4*)(vg + (size_t)(j) * 64); } while (0)
#define MLA_STOREK(b) do { LAS unsigned char* kd_ = kst + (b) * MLA_KBX; *(LAS u32x2*)(kd_) = sk0; *(LAS u32x2*)(kd_ + 64) = sk1; *(LAS u32x2*)(kd_ + 128) = sk2; } while (0)
#define MLA_STOREV(b) do { LAS unsigned char* vd_ = vst + (b) * VBX; *(LAS u32x2*)(vd_) = (u32x2){sv0.x, sv0.y}; *(LAS u32x2*)(vd_ + 8) = (u32x2){sv0.z, sv0.w}; } while (0)
    float m = -1e30f, l = 0.f; f32x16 o[4];
#pragma unroll
    for (int d = 0; d < 4; ++d)
#pragma unroll
        for (int r = 0; r < 16; ++r) o[d][r] = 0.f;
    f32x16 pA0, pA1, pB0, pB1;
    MLA_LOADK(0); MLA_LOADV(0); MLA_STOREK(0); MLA_STOREV(0);
    MLA_LOADK(1);
    __syncthreads();
    qk_tilex(pA0, pA1, kl, q);
    if (63 > qw) mla_maskx(pA0, pA1, tq - 4 * hi);
    MLA_STOREK(1);
    if (2 < NT) MLA_LOADK(2);
    MLA_LOADV(1);
    __syncthreads();
    asm volatile("" : "+v"(q[0]), "+v"(q[1]), "+v"(q[2]));
    float tmx = mla_rowmax(pA0, pA1);
#define SB() __builtin_amdgcn_sched_barrier(0)
#define MLA_SMHEAD() const float mn_ = fmaxf(m, tmx); const float alpha_ = __builtin_amdgcn_exp2f((m - mn_) * QS_MLA); m = mn_; const float mc_ = 8.f - mn_ * QS_MLA; float ps_ = 0.f; i32x8 pb_; \
            if (!__all(alpha_ == 1.f)) { _Pragma("unroll") for (int d_ = 0; d_ < 4; ++d_) _Pragma("unroll") for (int r_ = 0; r_ < 16; ++r_) o[d_][r_] *= alpha_; }
#define MXP_EXPK(P, R0, W0) do { MXP_EXP8(P, R0); \
        int w_ = __builtin_amdgcn_cvt_pk_fp8_f32(P[(R0) + 0], P[(R0) + 1], 0, false); pb_[(W0)] = __builtin_amdgcn_cvt_pk_fp8_f32(P[(R0) + 2], P[(R0) + 3], w_, true); \
        w_ = __builtin_amdgcn_cvt_pk_fp8_f32(P[(R0) + 4], P[(R0) + 5], 0, false); pb_[(W0) + 1] = __builtin_amdgcn_cvt_pk_fp8_f32(P[(R0) + 6], P[(R0) + 7], w_, true); } while (0)
#define MLA_SMTAIL() ps_ = swapsum(ps_); l = l * alpha_ + ps_
#define MFMA_T(acc, a, b) asm volatile("s_nop 1\n\tv_mfma_scale_f32_32x32x64_f8f6f4 %0, %1, %2, %0, %3, %3 op_sel_hi:[0,0,0]" : "+v"(acc) : "v"(a), "v"(b), "v"(sc1_))
#define MFMA_Z(acc, a, b) asm volatile("s_nop 1\n\tv_mfma_scale_f32_32x32x64_f8f6f4 %0, %1, %2, 0, %3, %3 op_sel_hi:[0,0,0]" : "=&v"(acc) : "v"(a), "v"(b), "v"(sc1_))
#define MLA_STEP(PX0, PX1, PY0, PY1, j) do { \
        const int kb1_ = 64 * ((j) + 1); \
        const bool a0_ = (64 * (j) <= qw + 31); \
        const LAS unsigned char* vj_ = vl + ((j) & 1) * VBX; \
        if (a0_) {                  \
            const LAS unsigned char* kn_ = kl + (((j) + 1) & 1) * MLA_KBX; \
            MLA_SMHEAD() \
            SB(); \
            i32x8 a0_f = ldsx(kn_), a1_f = ldsx(kn_ + 64); \
            MXP_EXPK(PX0, 0, 0); MXP_EXPK(PX0, 8, 2); \
            SB(); MFMA_Z(PY0, a0_f, q[0]); SB(); \
            a0_f = ldsx(kn_ + 128); \
            MXP_EXPK(PX1, 0, 4); \
            SB(); MFMA_T(PY0, a1_f, q[1]); SB(); \
            a1_f = ldsx(kn_ + 32 * KSX); \
            MXP_EXPK(PX1, 8, 6); \
            SB(); MFMA_T(PY0, a0_f, q[2]); SB(); \
            a0_f = ldsx(kn_ + 32 * KSX + 64); \
            MLA_SMTAIL(); \
            SB(); MFMA_Z(PY1, a1_f, q[0]); SB(); \
            a1_f = ldsx(vj_); \
            SB(); MFMA_T(PY1, a0_f, q[1]); SB(); \
            a0_f = ldsx(kn_ + 32 * KSX + 128); \
            SB(); MFMA_T(o[0], a1_f, pb_); SB(); \
            a1_f = ldsx(vj_ + 32 * VSX); \
            SB(); MFMA_T(PY1, a0_f, q[2]); SB(); \
            a0_f = ldsx(vj_ + 64 * VSX); \
            SB(); MFMA_T(o[1], a1_f, pb_); SB(); \
            a1_f = ldsx(vj_ + 96 * VSX); \
            SB(); MFMA_T(o[2], a0_f, pb_); SB(); \
            SB(); MFMA_T(o[3], a1_f, pb_); SB(); \
            if (kb1_ + 63 > qw) mla_maskx(PY0, PY1, tq - kb1_ - 4 * hi); \
            tmx = mla_rowmax(PY0, PY1); \
        } \
        if ((j) + 2 < NT) MLA_STOREK((j) & 1); \
        if ((j) + 1 < NT) MLA_STOREV(((j) + 1) & 1); \
        if ((j) + 3 < NT) MLA_LOADK((j) + 3); \
        if ((j) + 2 < NT) MLA_LOADV((j) + 2); \
        __syncthreads(); } while (0)
    int sc1_ = 0x7f7f7f7f; asm volatile("" : "+v"(sc1_));
    for (int j = 0; j < NT; j += 2) {
        MLA_STEP(pA0, pA1, pB0, pB1, j);
        MLA_STEP(pB0, pB1, pA0, pA1, j + 1);
    }
    asm volatile("s_nop 15\n\ts_nop 15" ::: "memory");
#undef MLA_STEP
#undef MLA_SMHEAD
#undef MLA_SMTAIL
#undef MXP_EXPK
#undef MFMA_T
#undef MFMA_Z
#undef SB
#undef MLA_LOADK
#undef MLA_LOADV
#undef MLA_STOREK
#undef MLA_STOREV
    const float inv = 1.f / l;
    const bf16* zp = P.Z + (size_t)tq * 2048 + head * 128 + 4 * hi;
    bf16* op = P.O + (size_t)tq * 4096 + head * 128 + 4 * hi;
#pragma unroll
    for (int d0 = 0; d0 < 4; ++d0)
#pragma unroll
        for (int rg = 0; rg < 4; ++rg) { const int dim = 32 * d0 + 8 * rg;
            const u32x2 z = *(const GAS u32x2*)(zp + dim);
            u32x2 w; w.x = pk2(o[d0][4 * rg + 0] * inv * bflo(z.x), o[d0][4 * rg + 1] * inv * bfhi(z.x)); w.y = pk2(o[d0][4 * rg + 2] * inv * bflo(z.y), o[d0][4 * rg + 3] * inv * bfhi(z.y));
            *(GAS u32x2*)(op + dim) = w; }
}
#undef MXP_EXP8

#elif defined(MLA_MX)
struct MlaPtrs { const bf16* Q; const bf16* K; const bf16* V; const bf16* Z; bf16* O; };
__device__ __forceinline__ void mla_unit(LAS unsigned char* lds, const MlaPtrs& P, int head, int qb, int tid_in, int wave, int lane_in) {
    int tid = tid_in; asm volatile("" : "+v"(tid)); const int lane = tid & 63; (void)lane_in;
    const int r32 = lane & 31, hi = lane >> 5;
    const int q0 = qb * 256, qw = q0 + wave * 32, tq = qw + r32;
    i32x8 q[3];
    { const unsigned char* qp = (const unsigned char*)P.Q + (size_t)tq * 3072 + head * 192 + hi * 32;
#pragma unroll
      for (int s = 0; s < 3; ++s) { const u32x4 a = *(const GAS u32x4*)(qp + 64 * s), b = *(const GAS u32x4*)(qp + 64 * s + 16);
          q[s] = (i32x8){(int)a.x, (int)a.y, (int)a.z, (int)a.w, (int)b.x, (int)b.y, (int)b.z, (int)b.w}; } }
    const int NT = 4 * (qb + 1);
    const int srow = tid >> 3, sc8 = tid & 7;
    const unsigned char* kg = (const unsigned char*)P.K + (size_t)head * 192 + (size_t)srow * 3072 + sc8 * 8;
    const unsigned char* vg = (const unsigned char*)P.V + ((size_t)head * 128 + (tid >> 2)) * S + (tid & 3) * 16;
    LAS unsigned char* kst = lds + srow * KSX + sc8 * 8;
    LAS unsigned char* vst = lds + 2 * MLA_KBX + (tid >> 2) * VSX + (tid & 3) * 16;
    const LAS unsigned char* kl = lds + r32 * KSX + hi * 32;
    const LAS unsigned char* vl = lds + 2 * MLA_KBX + r32 * VSX + hi * 32;
    u32x2 sk0, sk1, sk2; u32x4 sv0;
#define MLA_LOAD(j) do { const unsigned char* kp_ = kg + (size_t)(j) * (64 * 3072); const unsigned char* vp_ = vg + (size_t)(j) * 64; \
        sk0 = *(const GAS u32x2*)(kp_); sk1 = *(const GAS u32x2*)(kp_ + 64); sk2 = *(const GAS u32x2*)(kp_ + 128); sv0 = *(const GAS u32x4*)(vp_); } while (0)
#define MLA_STORE(b, vb) do { LAS unsigned char* kd_ = kst + (b) * MLA_KBX; LAS unsigned char* vd_ = vst + (vb) * VBX; \
        *(LAS u32x2*)(kd_) = sk0; *(LAS u32x2*)(kd_ + 64) = sk1; *(LAS u32x2*)(kd_ + 128) = sk2; *(LAS u32x2*)(vd_) = (u32x2){sv0.x, sv0.y}; *(LAS u32x2*)(vd_ + 8) = (u32x2){sv0.z, sv0.w}; } while (0)
    MLA_LOAD(0); MLA_STORE(0, 0);
    __syncthreads();
    asm volatile("" : "+v"(q[0]), "+v"(q[1]), "+v"(q[2]));
    float m = -1e30f, l = 0.f; f32x16 o[4];
#pragma unroll
    for (int d = 0; d < 4; ++d)
#pragma unroll
        for (int r = 0; r < 16; ++r) o[d][r] = 0.f;
    const bool trail = wave >= 4;
    i32x8 pb = {};
    int vb_cur = 0, vb_prev = 2;
    for (int j = 0; j < NT; ++j) {
        const int kb = 64 * j;
        int vb_next = vb_cur + 1; if (vb_next == 3) vb_next = 0;
        if (j + 1 < NT) MLA_LOAD(j + 1);
        if (trail && j > 0 && kb - 64 <= qw + 31) pv_tilex(o, pb, vl + vb_prev * VBX);
        if (kb <= qw + 31) {
            f32x16 p0, p1;
            qk_tilex(p0, p1, kl + (j & 1) * MLA_KBX, q);
            if (kb + 63 > qw) {
                const int dq = tq - kb - 4 * hi;
#pragma unroll
                for (int r = 0; r < 16; ++r) { const int c = (r & 3) + 8 * (r >> 2);
                    if (c > dq) p0[r] = -__builtin_inff();
                    if (c + 32 > dq) p1[r] = -__builtin_inff(); }
            }
            online_sm_x(p0, p1, m, l, o, QS_MLA);
            pb = packpx(p0, p1);
            if (!trail) pv_tilex(o, pb, vl + vb_cur * VBX);
        }
        if (j + 1 < NT) MLA_STORE((j + 1) & 1, vb_next);
        __syncthreads();
        vb_prev = vb_cur; vb_cur = vb_next;
    }
    if (trail && 64 * (NT - 1) <= qw + 31) pv_tilex(o, pb, vl + vb_prev * VBX);
    __syncthreads();
#undef MLA_LOAD
#undef MLA_STORE
    const float inv = 1.f / l;
    const bf16* zp = P.Z + (size_t)tq * 2048 + head * 128 + 4 * hi;
    bf16* op = P.O + (size_t)tq * 4096 + head * 128 + 4 * hi;
#pragma unroll
    for (int d0 = 0; d0 < 4; ++d0)
#pragma unroll
        for (int rg = 0; rg < 4; ++rg) { const int dim = 32 * d0 + 8 * rg;
            const u32x2 z = *(const GAS u32x2*)(zp + dim);
            u32x2 w; w.x = pk2(o[d0][4 * rg + 0] * inv * bflo(z.x), o[d0][4 * rg + 1] * inv * bfhi(z.x)); w.y = pk2(o[d0][4 * rg + 2] * inv * bflo(z.y), o[d0][4 * rg + 3] * inv * bfhi(z.y));
            *(GAS u32x2*)(op + dim) = w; }
}

#elif defined(MLA_BIG)
struct MlaPtrs { const bf16* Q; const bf16* K; const bf16* V; const bf16* Z; bf16* O; };
__device__ __forceinline__ void mla_unit(LAS unsigned char* lds, const MlaPtrs& P, int head, int qb, int tid_in, int wave, int lane_in) {
    int tid = tid_in; asm volatile("" : "+v"(tid)); const int lane = tid & 63; (void)lane_in;
    const int r32 = lane & 31, hi = lane >> 5;
    const int q0 = qb * 256, qw = q0 + wave * 32, tq = qw + r32;
    i64 q[12];
    { const unsigned char* qp = (const unsigned char*)P.Q + (size_t)tq * 3072 + head * 192 + hi * 8;
#pragma unroll
      for (int d0 = 0; d0 < 12; ++d0) q[d0] = *(const GAS i64*)(qp + d0 * 16); }
    const int NT = 4 * (qb + 1), NTB = NT / 2;
    const int srow = tid >> 3, sc8 = tid & 7;
    const unsigned char* kg = (const unsigned char*)P.K + (size_t)head * 192 + (size_t)srow * 3072 + sc8 * 8;
    const unsigned char* vg = (const unsigned char*)P.V + ((size_t)head * 128 + (tid >> 2)) * S + (tid & 3) * 32;
    LAS unsigned char* kst = lds + srow * KS8 + sc8 * 8;
    LAS unsigned char* vst = lds + 2 * MLA_KB8B + (tid >> 2) * VS8B + (tid & 3) * 32;
    const LAS unsigned char* kl = lds + r32 * KS8 + hi * 8;
    const LAS unsigned char* vl = lds + 2 * MLA_KB8B + r32 * VS8B + hi * 8;
    u32x2 sk0, sk1, sk2, sk3, sk4, sk5; u32x4 sv0, sv1;
#define MLA_LOAD(J) do { const unsigned char* kp_ = kg + (size_t)(J) * (128 * 3072); const unsigned char* vp_ = vg + (size_t)(J) * 128; \
        sk0 = *(const GAS u32x2*)(kp_); sk1 = *(const GAS u32x2*)(kp_ + 64); sk2 = *(const GAS u32x2*)(kp_ + 128); \
        sk3 = *(const GAS u32x2*)(kp_ + 64 * 3072); sk4 = *(const GAS u32x2*)(kp_ + 64 * 3072 + 64); sk5 = *(const GAS u32x2*)(kp_ + 64 * 3072 + 128); \
        sv0 = *(const GAS u32x4*)(vp_); sv1 = *(const GAS u32x4*)(vp_ + 16); } while (0)
#define MLA_STORE(b, vb) do { LAS unsigned char* kd_ = kst + (b) * MLA_KB8B; LAS unsigned char* vd_ = vst + (vb) * VB8B; \
        *(LAS u32x2*)(kd_) = sk0; *(LAS u32x2*)(kd_ + 64) = sk1; *(LAS u32x2*)(kd_ + 128) = sk2; \
        *(LAS u32x2*)(kd_ + 64 * KS8) = sk3; *(LAS u32x2*)(kd_ + 64 * KS8 + 64) = sk4; *(LAS u32x2*)(kd_ + 64 * KS8 + 128) = sk5; \
        *(LAS u32x2*)(vd_) = (u32x2){sv0.x, sv0.y}; *(LAS u32x2*)(vd_ + 8) = (u32x2){sv0.z, sv0.w}; *(LAS u32x2*)(vd_ + 16) = (u32x2){sv1.x, sv1.y}; *(LAS u32x2*)(vd_ + 24) = (u32x2){sv1.z, sv1.w}; } while (0)
    MLA_LOAD(0); MLA_STORE(0, 0);
    __syncthreads();
    float m = -1e30f, l = 0.f; f32x16 o[4];
#pragma unroll
    for (int d = 0; d < 4; ++d)
#pragma unroll
        for (int r = 0; r < 16; ++r) o[d][r] = 0.f;
    const bool trail = wave >= 4;
    i64 pb[4] = {};
    int vb_cur = 0, vb_prev = 2;
    for (int J = 0; J < NTB; ++J) {
        int vb_next = vb_cur + 1; if (vb_next == 3) vb_next = 0;
        if (J + 1 < NTB) MLA_LOAD(J + 1);
#pragma unroll
        for (int sub = 0; sub < 2; ++sub) {
            const int j = 2 * J + sub, kb = 64 * j;
            if (trail && j > 0 && kb - 64 <= qw + 31) pv_tile8(o, pb, vl + (sub == 0 ? vb_prev * VB8B + 64 : vb_cur * VB8B));
            if (kb <= qw + 31) {
                f32x16 p0, p1;
                qk_tile8<12>(p0, p1, kl + (J & 1) * MLA_KB8B + sub * 64 * KS8, q);
                if (kb + 63 > qw) {
                    const int dq = tq - kb - 4 * hi;
#pragma unroll
                    for (int r = 0; r < 16; ++r) { const int c = (r & 3) + 8 * (r >> 2);
                        if (c > dq) p0[r] = -__builtin_inff();
                        if (c + 32 > dq) p1[r] = -__builtin_inff(); }
                }
                online_sm_scaled(p0, p1, m, l, o, QS_MLA);
                pb[0] = packp8<0>(p0); pb[1] = packp8<1>(p0); pb[2] = packp8<0>(p1); pb[3] = packp8<1>(p1);
                if (!trail) pv_tile8(o, pb, vl + vb_cur * VB8B + sub * 64);
            }
        }
        if (J + 1 < NTB) MLA_STORE((J + 1) & 1, vb_next);
        __syncthreads();
        vb_prev = vb_cur; vb_cur = vb_next;
    }
    if (trail && 64 * (NT - 1) <= qw + 31) pv_tile8(o, pb, vl + vb_prev * VB8B + 64);
    __syncthreads();
#undef MLA_LOAD
#undef MLA_STORE
    const float inv = (1.f / 256.f) / l;
    const bf16* zp = P.Z + (size_t)tq * 2048 + head * 128 + 4 * hi;
    bf16* op = P.O + (size_t)tq * 4096 + head * 128 + 4 * hi;
#pragma unroll
    for (int d0 = 0; d0 < 4; ++d0)
#pragma unroll
        for (int rg = 0; rg < 4; ++rg) { const int dim = 32 * d0 + 8 * rg;
            const u32x2 z = *(const GAS u32x2*)(zp + dim);
            u32x2 w; w.x = pk2(o[d0][4 * rg + 0] * inv * bflo(z.x), o[d0][4 * rg + 1] * inv * bfhi(z.x)); w.y = pk2(o[d0][4 * rg + 2] * inv * bflo(z.y), o[d0][4 * rg + 3] * inv * bfhi(z.y));
            *(GAS u32x2*)(op + dim) = w; }
}

#elif defined(MLA_FP8V)
struct MlaPtrs { const bf16* Q; const bf16* K; const bf16* V; const bf16* Z; bf16* O; };
__device__ __forceinline__ void mla_unit(LAS unsigned char* lds, const MlaPtrs& P, int head, int qb, int tid_in, int wave, int lane_in) {
    int tid = tid_in; asm volatile("" : "+v"(tid)); const int lane = tid & 63; (void)lane_in;
    const int r32 = lane & 31, hi = lane >> 5;
    const int q0 = qb * 256, qw = q0 + wave * 32, tq = qw + r32;
    i64 q[12];
    { const unsigned char* qp = (const unsigned char*)P.Q + (size_t)tq * 3072 + head * 192 + hi * 8;
#pragma unroll
      for (int d0 = 0; d0 < 12; ++d0) q[d0] = *(const GAS i64*)(qp + d0 * 16); }
    const int NT = 4 * (qb + 1);
    const int srow = tid >> 3, sc8 = tid & 7;
    const unsigned char* kg = (const unsigned char*)P.K + (size_t)head * 192 + (size_t)srow * 3072 + sc8 * 8;
    const unsigned char* vg = (const unsigned char*)P.V + ((size_t)head * 128 + (tid >> 2)) * S + (tid & 3) * 16;
    LAS unsigned char* kst = lds + srow * KS8 + sc8 * 8;
    LAS unsigned char* vst = lds + 2 * MLA_KB8 + (tid >> 2) * VS8 + (tid & 3) * 16;
    const LAS unsigned char* kl = lds + r32 * KS8 + hi * 8;
    const LAS unsigned char* vl = lds + 2 * MLA_KB8 + r32 * VS8 + hi * 8;
    u32x2 sk0, sk1, sk2; u32x4 sv0;
#define MLA_LOAD(j) do { const unsigned char* kp_ = kg + (size_t)(j) * (64 * 3072); const unsigned char* vp_ = vg + (size_t)(j) * 64; \
        sk0 = *(const GAS u32x2*)(kp_); sk1 = *(const GAS u32x2*)(kp_ + 64); sk2 = *(const GAS u32x2*)(kp_ + 128); sv0 = *(const GAS u32x4*)(vp_); } while (0)
#define MLA_STORE(b, vb) do { LAS unsigned char* kd_ = kst + (b) * MLA_KB8; LAS unsigned char* vd_ = vst + (vb) * VB8; \
        *(LAS u32x2*)(kd_) = sk0; *(LAS u32x2*)(kd_ + 64) = sk1; *(LAS u32x2*)(kd_ + 128) = sk2; *(LAS u32x2*)(vd_) = (u32x2){sv0.x, sv0.y}; *(LAS u32x2*)(vd_ + 8) = (u32x2){sv0.z, sv0.w}; } while (0)
    MLA_LOAD(0); MLA_STORE(0, 0);
    __syncthreads();
    float m = -1e30f, l = 0.f; f32x16 o[4];
#pragma unroll
    for (int d = 0; d < 4; ++d)
#pragma unroll
        for (int r = 0; r < 16; ++r) o[d][r] = 0.f;
    const bool trail = wave >= 4;
    i64 pb[4] = {};
    int vb_cur = 0, vb_prev = 2;
    for (int j = 0; j < NT; ++j) {
        const int kb = 64 * j;
        int vb_next = vb_cur + 1; if (vb_next == 3) vb_next = 0;
        if (j + 1 < NT) MLA_LOAD(j + 1);
        if (trail && j > 0 && kb - 64 <= qw + 31) pv_tile8(o, pb, vl + vb_prev * VB8);
        if (kb <= qw + 31) {
            f32x16 p0, p1;
#ifdef PROBE_QKM2
            { f32x16 r0, r1; qk_tile_m2<12, KS_M>(p0, p1, r0, r1, kl + (j & 1) * MLA_KB, q);
#pragma unroll
              for (int r = 0; r < 16; ++r) { p0[r] = (p0[r] + r0[r]) * 0.5f; p1[r] = (p1[r] + r1[r]) * 0.5f; } }
#else
            qk_tile8<12>(p0, p1, kl + (j & 1) * MLA_KB8, q);
#endif
#ifdef PROBE_QK2
            { f32x16 r0, r1; asm volatile("" ::: "memory"); qk_tile<12, KS_M>(r0, r1, kl + (j & 1) * MLA_KB, q);
#pragma unroll
              for (int r = 0; r < 16; ++r) { p0[r] = (p0[r] + r0[r]) * 0.5f; p1[r] = (p1[r] + r1[r]) * 0.5f; } }
#endif
#ifdef PROBE_SM2
            { float acc_ = 0.f;
#pragma unroll
              for (int r = 0; r < 16; ++r) { acc_ += __builtin_amdgcn_exp2f(p0[r] - m - 40.f) + __builtin_amdgcn_exp2f(p1[r] - m - 40.f); }
#pragma unroll
              for (int r = 0; r < 16; ++r) { acc_ += __builtin_amdgcn_exp2f(p0[r] - m - 50.f) + __builtin_amdgcn_exp2f(p1[r] - m - 50.f); }
              if (acc_ == 12345.678f) l += 1.f; }
#endif
            if (kb + 63 > qw) {
                const int dq = tq - kb - 4 * hi;
#pragma unroll
                for (int r = 0; r < 16; ++r) { const int c = (r & 3) + 8 * (r >> 2);
                    if (c > dq) p0[r] = -__builtin_inff();
                    if (c + 32 > dq) p1[r] = -__builtin_inff(); }
            }
            online_sm_scaled(p0, p1, m, l, o, QS_MLA);
            pb[0] = packp8<0>(p0); pb[1] = packp8<1>(p0); pb[2] = packp8<0>(p1); pb[3] = packp8<1>(p1);
            if (!trail) pv_tile8(o, pb, vl + vb_cur * VB8);
        }
        if (j + 1 < NT) MLA_STORE((j + 1) & 1, vb_next);
        __syncthreads();
        vb_prev = vb_cur; vb_cur = vb_next;
    }
    if (trail && 64 * (NT - 1) <= qw + 31) pv_tile8(o, pb, vl + vb_prev * VB8);
    __syncthreads();
#undef MLA_LOAD
#undef MLA_STORE
    const float inv = (1.f / 256.f) / l;
    const bf16* zp = P.Z + (size_t)tq * 2048 + head * 128 + 4 * hi;
    bf16* op = P.O + (size_t)tq * 4096 + head * 128 + 4 * hi;
#pragma unroll
    for (int d0 = 0; d0 < 4; ++d0)
#pragma unroll
        for (int rg = 0; rg < 4; ++rg) { const int dim = 32 * d0 + 8 * rg;
            const u32x2 z = *(const GAS u32x2*)(zp + dim);
            u32x2 w; w.x = pk2(o[d0][4 * rg + 0] * inv * bflo(z.x), o[d0][4 * rg + 1] * inv * bfhi(z.x)); w.y = pk2(o[d0][4 * rg + 2] * inv * bflo(z.y), o[d0][4 * rg + 3] * inv * bfhi(z.y));
            *(GAS u32x2*)(op + dim) = w; }
}

#elif defined(MLA_FP8)
struct MlaPtrs { const bf16* Q; const bf16* K; const bf16* V; const bf16* Z; bf16* O; };
__device__ __forceinline__ void mla_unit(LAS unsigned char* lds, const MlaPtrs& P, int head, int qb, int tid_in, int wave, int lane_in) {
    int tid = tid_in; asm volatile("" : "+v"(tid)); const int lane = tid & 63; (void)lane_in;
    const int r32 = lane & 31, hi = lane >> 5;
    const int q0 = qb * 256, qw = q0 + wave * 32, tq = qw + r32;
    i64 q[12];
    { const unsigned char* qp = (const unsigned char*)P.Q + (size_t)tq * 3072 + head * 192 + hi * 8;
#pragma unroll
      for (int d0 = 0; d0 < 12; ++d0) q[d0] = *(const GAS i64*)(qp + d0 * 16); }
    const int NT = 4 * (qb + 1);
    const int srow = tid >> 3, sc8 = tid & 7;
    const unsigned char* kg = (const unsigned char*)P.K + (size_t)head * 192 + (size_t)srow * 3072 + sc8 * 8;
    const unsigned char* vg = (const unsigned char*)P.V + (size_t)head * 256 + (size_t)srow * 4096 + sc8 * 16;
    LAS unsigned char* kst = lds + srow * KS8 + sc8 * 8;
    LAS unsigned char* vst = lds + 2 * MLA_KB8 + srow * VS + sc8 * 16;
    const LAS unsigned char* kl = lds + r32 * KS8 + hi * 8;
    const LAS unsigned char* vl = lds + 2 * MLA_KB8 + (4 * hi + ((lane & 15) >> 2)) * VS + (16 * ((lane >> 4) & 1) + 4 * (lane & 3)) * 2;
    u32x2 sk0, sk1, sk2; u32x4 sv0, sv1;
#define MLA_LOAD(j) do { const unsigned char* kp_ = kg + (size_t)(j) * (64 * 3072); const unsigned char* vp_ = vg + (size_t)(j) * (64 * 4096); \
        sk0 = *(const GAS u32x2*)(kp_); sk1 = *(const GAS u32x2*)(kp_ + 64); sk2 = *(const GAS u32x2*)(kp_ + 128); sv0 = *(const GAS u32x4*)(vp_); sv1 = *(const GAS u32x4*)(vp_ + 128); } while (0)
#define MLA_STORE(b, vb) do { LAS unsigned char* kd_ = kst + (b) * MLA_KB8; LAS unsigned char* vd_ = vst + (vb) * VB; \
        *(LAS u32x2*)(kd_) = sk0; *(LAS u32x2*)(kd_ + 64) = sk1; *(LAS u32x2*)(kd_ + 128) = sk2; *(LAS u32x4*)(vd_) = sv0; *(LAS u32x4*)(vd_ + 128) = sv1; } while (0)
    MLA_LOAD(0); MLA_STORE(0, 0);
    __syncthreads();
    float m = -1e30f, l = 0.f; f32x16 o[4];
#pragma unroll
    for (int d = 0; d < 4; ++d)
#pragma unroll
        for (int r = 0; r < 16; ++r) o[d][r] = 0.f;
    const bool trail = wave >= 4;
    bf16x8 pb[4] = {};
    int vb_cur = 0, vb_prev = 2;
    for (int j = 0; j < NT; ++j) {
        const int kb = 64 * j;
        int vb_next = vb_cur + 1; if (vb_next == 3) vb_next = 0;
        if (j + 1 < NT) MLA_LOAD(j + 1);
        if (trail && j > 0 && kb - 64 <= qw + 31) pv_tile(o, pb, vl + vb_prev * VB);
        if (kb <= qw + 31) {
            f32x16 p0, p1;
#ifdef PROBE_QKM2
            { f32x16 r0, r1; qk_tile_m2<12, KS_M>(p0, p1, r0, r1, kl + (j & 1) * MLA_KB, q);
#pragma unroll
              for (int r = 0; r < 16; ++r) { p0[r] = (p0[r] + r0[r]) * 0.5f; p1[r] = (p1[r] + r1[r]) * 0.5f; } }
#else
            qk_tile8<12>(p0, p1, kl + (j & 1) * MLA_KB8, q);
#endif
#ifdef PROBE_QK2
            { f32x16 r0, r1; asm volatile("" ::: "memory"); qk_tile<12, KS_M>(r0, r1, kl + (j & 1) * MLA_KB, q);
#pragma unroll
              for (int r = 0; r < 16; ++r) { p0[r] = (p0[r] + r0[r]) * 0.5f; p1[r] = (p1[r] + r1[r]) * 0.5f; } }
#endif
#ifdef PROBE_SM2
            { float acc_ = 0.f;
#pragma unroll
              for (int r = 0; r < 16; ++r) { acc_ += __builtin_amdgcn_exp2f(p0[r] - m - 40.f) + __builtin_amdgcn_exp2f(p1[r] - m - 40.f); }
#pragma unroll
              for (int r = 0; r < 16; ++r) { acc_ += __builtin_amdgcn_exp2f(p0[r] - m - 50.f) + __builtin_amdgcn_exp2f(p1[r] - m - 50.f); }
              if (acc_ == 12345.678f) l += 1.f; }
#endif
            if (kb + 63 > qw) {
                const int dq = tq - kb - 4 * hi;
#pragma unroll
                for (int r = 0; r < 16; ++r) { const int c = (r & 3) + 8 * (r >> 2);
                    if (c > dq) p0[r] = -__builtin_inff();
                    if (c + 32 > dq) p1[r] = -__builtin_inff(); }
            }
            online_sm_scaled(p0, p1, m, l, o, QS_MLA);
            pb[0] = packp<0>(p0); pb[1] = packp<1>(p0); pb[2] = packp<0>(p1); pb[3] = packp<1>(p1);
            if (!trail) pv_tile(o, pb, vl + vb_cur * VB);
        }
        if (j + 1 < NT) MLA_STORE((j + 1) & 1, vb_next);
        __syncthreads();
        vb_prev = vb_cur; vb_cur = vb_next;
    }
    if (trail && 64 * (NT - 1) <= qw + 31) pv_tile(o, pb, vl + vb_prev * VB);
    __syncthreads();
#undef MLA_LOAD
#undef MLA_STORE
    const float inv = 1.f / l;
    const bf16* zp = P.Z + (size_t)tq * 2048 + head * 128 + 4 * hi;
    bf16* op = P.O + (size_t)tq * 4096 + head * 128 + 4 * hi;
#pragma unroll
    for (int d0 = 0; d0 < 4; ++d0)
#pragma unroll
        for (int rg = 0; rg < 4; ++rg) { const int dim = 32 * d0 + 8 * rg;
            const u32x2 z = *(const GAS u32x2*)(zp + dim);
            u32x2 w; w.x = pk2(o[d0][4 * rg + 0] * inv * bflo(z.x), o[d0][4 * rg + 1] * inv * bfhi(z.x)); w.y = pk2(o[d0][4 * rg + 2] * inv * bflo(z.y), o[d0][4 * rg + 3] * inv * bfhi(z.y));
            *(GAS u32x2*)(op + dim) = w; }
}

#else
struct MlaPtrs { const bf16* Q; const bf16* K; const bf16* V; const bf16* Z; bf16* O; };
__device__ __forceinline__ void mla_unit(LAS unsigned char* lds, const MlaPtrs& P, int head, int qb, int tid_in, int wave, int lane_in) {
    int tid = tid_in; asm volatile("" : "+v"(tid)); const int lane = tid & 63; (void)lane_in;
    const int r32 = lane & 31, hi = lane >> 5;
    const int q0 = qb * 256, qw = q0 + wave * 32, tq = qw + r32;
    bf16x8 q[12];
    { const bf16* qp = P.Q + (size_t)tq * 3072 + head * 192 + hi * 8;
#pragma unroll
      for (int d0 = 0; d0 < 12; ++d0) q[d0] = *(const GAS bf16x8*)(qp + d0 * 16); }
    const int NT = 4 * (qb + 1);
    const int srow = tid >> 3, sc8 = tid & 7;
    const unsigned char* kg = (const unsigned char*)P.K + (size_t)head * 384 + (size_t)srow * 6144 + sc8 * 16;
    const unsigned char* vg = (const unsigned char*)P.V + (size_t)head * 256 + (size_t)srow * 4096 + sc8 * 16;
    LAS unsigned char* kst = lds + srow * KS_M + sc8 * 16;
    LAS unsigned char* vst = lds + 2 * MLA_KB + srow * VS + sc8 * 16;
    const LAS unsigned char* kl = lds + r32 * KS_M + hi * 16;
    const LAS unsigned char* vl = lds + 2 * MLA_KB + (4 * hi + ((lane & 15) >> 2)) * VS + (16 * ((lane >> 4) & 1) + 4 * (lane & 3)) * 2;
    u32x4 sk0, sk1, sk2, sv0, sv1;
#define MLA_LOAD(j) do { const unsigned char* kp_ = kg + (size_t)(j) * (64 * 6144); const unsigned char* vp_ = vg + (size_t)(j) * (64 * 4096); \
        sk0 = *(const GAS u32x4*)(kp_); sk1 = *(const GAS u32x4*)(kp_ + 128); sk2 = *(const GAS u32x4*)(kp_ + 256); sv0 = *(const GAS u32x4*)(vp_); sv1 = *(const GAS u32x4*)(vp_ + 128); } while (0)
#define MLA_STORE(b, vb) do { LAS unsigned char* kd_ = kst + (b) * MLA_KB; LAS unsigned char* vd_ = vst + (vb) * VB; \
        *(LAS u32x4*)(kd_) = sk0; *(LAS u32x4*)(kd_ + 128) = sk1; *(LAS u32x4*)(kd_ + 256) = sk2; *(LAS u32x4*)(vd_) = sv0; *(LAS u32x4*)(vd_ + 128) = sv1; } while (0)
    MLA_LOAD(0); MLA_STORE(0, 0);
    __syncthreads();
    float m = -1e30f, l = 0.f; f32x16 o[4];
#pragma unroll
    for (int d = 0; d < 4; ++d)
#pragma unroll
        for (int r = 0; r < 16; ++r) o[d][r] = 0.f;
    const bool trail = wave >= 4;
    bf16x8 pb[4] = {};
    int vb_cur = 0, vb_prev = 2;
    for (int j = 0; j < NT; ++j) {
        const int kb = 64 * j;
        int vb_next = vb_cur + 1; if (vb_next == 3) vb_next = 0;
        if (j + 1 < NT) MLA_LOAD(j + 1);
        if (trail && j > 0 && kb - 64 <= qw + 31) pv_tile(o, pb, vl + vb_prev * VB);
        if (kb <= qw + 31) {
            f32x16 p0, p1;
#ifdef PROBE_QKM2
            { f32x16 r0, r1; qk_tile_m2<12, KS_M>(p0, p1, r0, r1, kl + (j & 1) * MLA_KB, q);
#pragma unroll
              for (int r = 0; r < 16; ++r) { p0[r] = (p0[r] + r0[r]) * 0.5f; p1[r] = (p1[r] + r1[r]) * 0.5f; } }
#else
            qk_tile<12, KS_M>(p0, p1, kl + (j & 1) * MLA_KB, q);
#endif
#ifdef PROBE_QK2
            { f32x16 r0, r1; asm volatile("" ::: "memory"); qk_tile<12, KS_M>(r0, r1, kl + (j & 1) * MLA_KB, q);
#pragma unroll
              for (int r = 0; r < 16; ++r) { p0[r] = (p0[r] + r0[r]) * 0.5f; p1[r] = (p1[r] + r1[r]) * 0.5f; } }
#endif
#ifdef PROBE_SM2
            { float acc_ = 0.f;
#pragma unroll
              for (int r = 0; r < 16; ++r) { acc_ += __builtin_amdgcn_exp2f(p0[r] - m - 40.f) + __builtin_amdgcn_exp2f(p1[r] - m - 40.f); }
#pragma unroll
              for (int r = 0; r < 16; ++r) { acc_ += __builtin_amdgcn_exp2f(p0[r] - m - 50.f) + __builtin_amdgcn_exp2f(p1[r] - m - 50.f); }
              if (acc_ == 12345.678f) l += 1.f; }
#endif
            if (kb + 63 > qw) {
                const int dq = tq - kb - 4 * hi;
#pragma unroll
                for (int r = 0; r < 16; ++r) { const int c = (r & 3) + 8 * (r >> 2);
                    if (c > dq) p0[r] = -__builtin_inff();
                    if (c + 32 > dq) p1[r] = -__builtin_inff(); }
            }
            online_sm(p0, p1, m, l, o);
            pb[0] = packp<0>(p0); pb[1] = packp<1>(p0); pb[2] = packp<0>(p1); pb[3] = packp<1>(p1);
            if (!trail) pv_tile(o, pb, vl + vb_cur * VB);
        }
        if (j + 1 < NT) MLA_STORE((j + 1) & 1, vb_next);
        __syncthreads();
        vb_prev = vb_cur; vb_cur = vb_next;
    }
    if (trail && 64 * (NT - 1) <= qw + 31) pv_tile(o, pb, vl + vb_prev * VB);
    __syncthreads();
#undef MLA_LOAD
#undef MLA_STORE
    const float inv = 1.f / l;
    const bf16* zp = P.Z + (size_t)tq * 2048 + head * 128 + 4 * hi;
    bf16* op = P.O + (size_t)tq * 4096 + head * 128 + 4 * hi;
#pragma unroll
    for (int d0 = 0; d0 < 4; ++d0)
#pragma unroll
        for (int rg = 0; rg < 4; ++rg) { const int dim = 32 * d0 + 8 * rg;
            const u32x2 z = *(const GAS u32x2*)(zp + dim);
            u32x2 w; w.x = pk2(o[d0][4 * rg + 0] * inv * bflo(z.x), o[d0][4 * rg + 1] * inv * bfhi(z.x)); w.y = pk2(o[d0][4 * rg + 2] * inv * bflo(z.y), o[d0][4 * rg + 3] * inv * bfhi(z.y));
            *(GAS u32x2*)(op + dim) = w; }
}

#endif
#endif
struct NsaPtrs { const bf16* Q; const bf16* KV; const bf16* KC; const bf16* VC; const bf16* Z; const float* G; bf16* O; float* scr; };
template <int MODE>
__device__ __forceinline__ void nsa_loop(LAS unsigned char* lds, const unsigned char* kbase, const unsigned char* vbase, int ntiles, int jlo,
                                         const bf16x8 (&q)[8], int t, float slope2, float& m, float& l, f32x16 (&o)[4], float invl, int tid, int wave, int lane) {
    constexpr bool HASV = MODE != 0;
    const int r32 = lane & 31, hi = lane >> 5;
    const int srow = tid >> 3, sc8 = tid & 7;
    const unsigned soff = srow * 256 + sc8 * 16;
    LAS unsigned char* kst = lds + srow * KS_N + sc8 * 16;
    LAS unsigned char* vst = lds + 2 * NSA_KB + srow * VS + sc8 * 16;
    const LAS unsigned char* kl = lds + r32 * KS_N + hi * 16;
    const LAS unsigned char* vl = lds + 2 * NSA_KB + (4 * hi + ((lane & 15) >> 2)) * VS + (16 * ((lane >> 4) & 1) + 4 * (lane & 3)) * 2;
    const LAS int* ulist = (const LAS int*)(lds + N_ULIST);
    const LAS unsigned* selm = (const LAS unsigned*)(lds + N_SELM);
    LAS float* partA = (LAS float*)(lds + N_PART); LAS float* partB = (LAS float*)(lds + N_PART + N_PARTB);
    LAS float* imp = (LAS float*)(lds + N_IMP); LAS float* carry = (LAS float*)(lds + N_CARRY);
    if (ntiles <= 0) return;
    const float mlg = (MODE == 1) ? (invl > 0.f ? m - __builtin_amdgcn_logf(invl) : __builtin_inff()) : 0.f;
    u32x4 sk0, sk1, sv0, sv1;
#define NSA_TROW(j) (MODE == 2 ? 64 * __builtin_amdgcn_readfirstlane(ulist[ntiles - 1 - (j)]) : ((MODE == 3 || MODE == 0) ? 64 * (jlo + ntiles - 1 - (j)) : 64 * (jlo + (j))))
#define NSA_LOAD(j) do { const size_t ro_ = (size_t)NSA_TROW(j) * 256 + soff; \
        sk0 = *(const GAS u32x4*)(kbase + ro_); sk1 = *(const GAS u32x4*)(kbase + ro_ + 128); \
        if (HASV) { sv0 = *(const GAS u32x4*)(vbase + ro_); sv1 = *(const GAS u32x4*)(vbase + ro_ + 128); } } while (0)
#define NSA_STORE(b) do { LAS unsigned char* kd_ = kst + (b) * NSA_KB; *(LAS u32x4*)(kd_) = sk0; *(LAS u32x4*)(kd_ + 128) = sk1; \
        if (HASV) { LAS unsigned char* vd_ = vst + (b) * VB; *(LAS u32x4*)(vd_) = sv0; *(LAS u32x4*)(vd_ + 128) = sv1; } } while (0)
    NSA_LOAD(0); NSA_STORE(0);
    __syncthreads();
    for (int j = 0; j < ntiles; ++j) {
        const int buf = j & 1;
        if (MODE != 1 && j + 1 < ntiles) NSA_LOAD(j + 1);
        const int trow = NSA_TROW(j);
        constexpr int PSTEP = (MODE <= 1) ? 16 : 1;
        const int pstart = (MODE <= 1) ? 16 * trow + 31 : trow;
        const int db = t - pstart - PSTEP * 4 * hi;
        constexpr unsigned W = (MODE == 3) ? 512u : 0x7fffffffu;
        const bool mset = m > -1e29f;
        float b0 = -slope2 * (float)db - ((MODE != 1) ? (mset ? m : 0.f) : mlg);
        if (MODE == 2) { const int b = trow >> 6; if (((selm[r32 * 8 + (b >> 5)] >> (b & 31)) & 1u) == 0u) b0 = -__builtin_inff(); }
        f32x16 p0, p1;
#pragma unroll
        for (int r = 0; r < 16; ++r) { const int c = PSTEP * ((r & 3) + 8 * (r >> 2));
            p0[r] = __builtin_fmaf(slope2, (float)c, b0); p1[r] = __builtin_fmaf(slope2, (float)(c + 32 * PSTEP), b0); }
        qk_tile<8, KS_N, false>(p0, p1, kl + buf * NSA_KB, q);
        { const int t0u = __builtin_amdgcn_readfirstlane(t - r32);
          const bool interior = (t0u - (pstart + PSTEP * 63) >= 0) && ((unsigned)(t0u + 31 - pstart) < W);
          if (!interior) {
#pragma unroll
              for (int r = 0; r < 16; ++r) { const int c = PSTEP * ((r & 3) + 8 * (r >> 2));
                  if ((unsigned)(db - c) >= W) p0[r] = -__builtin_inff();
                  if ((unsigned)(db - c - 32 * PSTEP) >= W) p1[r] = -__builtin_inff(); } } }
        if (MODE == 0) {
            float tm = p0[0];
#pragma unroll
            for (int r = 1; r < 16; ++r) tm = fmaxf(tm, p0[r]);
#pragma unroll
            for (int r = 0; r < 16; ++r) tm = fmaxf(tm, p1[r]);
            tm = swapmax(tm);
            const bool need = mset ? (tm > 16.f) : (tm > -1e29f);
            if (!__all(!need)) {
                const float dlt = need ? tm : 0.f;
                if (mset) l *= __builtin_amdgcn_exp2f(-dlt);
                if (need) m = (mset ? m : 0.f) + dlt;
#pragma unroll
                for (int r = 0; r < 16; ++r) { p0[r] -= dlt; p1[r] -= dlt; }
            }
            float ps = 0.f;
#pragma unroll
            for (int r = 0; r < 16; ++r) ps += __builtin_amdgcn_exp2f(p0[r]) + __builtin_amdgcn_exp2f(p1[r]);
            l += swapsum(ps);
        } else if (MODE == 1) {
#pragma unroll
            for (int r = 0; r < 16; ++r) { p0[r] = __builtin_amdgcn_exp2f(p0[r]); p1[r] = __builtin_amdgcn_exp2f(p1[r]); }
            LAS float* pa = partA + (wave * 32 + r32) * 17 + hi; LAS float* pbm = partB + (wave * 32 + r32) * 17 + hi;
#pragma unroll
            for (int rg = 0; rg < 4; ++rg) {
                pa[2 * rg] = (p0[4 * rg] + p0[4 * rg + 1]) + (p0[4 * rg + 2] + p0[4 * rg + 3]); pbm[2 * rg] = p0[4 * rg + 3];
                pa[8 + 2 * rg] = (p1[4 * rg] + p1[4 * rg + 1]) + (p1[4 * rg + 2] + p1[4 * rg + 3]); pbm[8 + 2 * rg] = p1[4 * rg + 3]; }
            const bf16x8 pb[4] = {packp<0>(p0), packp<1>(p0), packp<0>(p1), packp<1>(p1)};
            pv_tile(o, pb, vl + buf * VB);
            __syncthreads();
            { const int qq = tid >> 4, jl = tid & 15; float a = 0.f, bp = 0.f, bl = 0.f;
#pragma unroll
              for (int w = 0; w < 8; ++w) { a += partA[(w * 32 + qq) * 17 + jl]; bl += partB[(w * 32 + qq) * 17 + jl]; }
              if (jl > 0) {
#pragma unroll
                  for (int w = 0; w < 8; ++w) bp += partB[(w * 32 + qq) * 17 + jl - 1];
              } else bp = (j > 0) ? carry[((j - 1) & 1) * 32 + qq] : 0.f;
              imp[qq * 256 + 16 * j + jl] = a + bp;
              if (jl == 15) carry[(j & 1) * 32 + qq] = bl; }
        } else {
            constexpr float NSA_LAZY_T = 16.f;
            float tm = p0[0];
#pragma unroll
            for (int r = 1; r < 16; ++r) tm = fmaxf(tm, p0[r]);
#pragma unroll
            for (int r = 0; r < 16; ++r) tm = fmaxf(tm, p1[r]);
            tm = swapmax(tm);
            const bool need = mset ? (tm > NSA_LAZY_T) : (tm > -1e29f);
            if (!__all(!need)) {
                const float dlt = need ? tm : 0.f;
                const float alpha = mset ? __builtin_amdgcn_exp2f(-dlt) : 1.f;
                if (need) m = (mset ? m : 0.f) + dlt;
#pragma unroll
                for (int r = 0; r < 16; ++r) { p0[r] -= dlt; p1[r] -= dlt; }
                l *= alpha;
#pragma unroll
                for (int d_ = 0; d_ < 4; ++d_)
#pragma unroll
                    for (int r = 0; r < 16; ++r) o[d_][r] *= alpha;
            }
            float ps = 0.f;
#pragma unroll
            for (int r = 0; r < 16; ++r) { p0[r] = __builtin_amdgcn_exp2f(p0[r]); ps += p0[r]; }
#pragma unroll
            for (int r = 0; r < 16; ++r) { p1[r] = __builtin_amdgcn_exp2f(p1[r]); ps += p1[r]; }
            l += swapsum(ps);
            const bf16x8 pb[4] = {packp<0>(p0), packp<1>(p0), packp<0>(p1), packp<1>(p1)};
            pv_tile(o, pb, vl + buf * VB);
        }
        if (MODE == 1 && j + 1 < ntiles) NSA_LOAD(j + 1);
        if (j + 1 < ntiles) NSA_STORE(buf ^ 1);
        __syncthreads();
    }
#undef NSA_TROW
#undef NSA_LOAD
#undef NSA_STORE
}
__device__ __forceinline__ void nsa_topk(const LAS float* improw, LAS unsigned* selrow, int cur, int lane) {
    unsigned key[4]; bool sel[4];
    int nforced = 0;
#pragma unroll
    for (int k = 0; k < 4; ++k) { const int j = lane + 64 * k;
        const bool forced = (j == 0) || (j == cur) || (j == cur - 1);
        const bool causal = j <= cur;
        sel[k] = forced;
#ifdef IMPNOISE_BUILD
        { unsigned h = (unsigned)j * 2654435761u + (unsigned)(size_t)improw * 40503u; h ^= h >> 15; h *= 0x846ca68bu; h ^= h >> 16;
          const float r = (float)(int)(h & 0xffffu) * (1.f / 32768.f) - 1.f; const float v = improw[j] * (1.f + IMPNOISE_EPS * r);
          key[k] = (causal && !forced) ? (__float_as_uint(v) + 1u) : 0u; }
#else
        key[k] = (causal && !forced) ? (__float_as_uint(improw[j]) + 1u) : 0u;
#endif
    }
    nforced = 1 + (cur >= 1 ? 1 : 0) + (cur >= 2 ? 1 : 0);
    const int want = 16 - nforced;
    for (int it = 0; it < want; ++it) {
        unsigned bk = key[0]; int bj = lane;
#pragma unroll
        for (int k = 1; k < 4; ++k) { if (key[k] > bk) { bk = key[k]; bj = lane + 64 * k; } }
        unsigned long long best = ((unsigned long long)bk << 32) | (unsigned)(0xffffffffu - (unsigned)bj);
#pragma unroll
        for (int off = 1; off < 64; off <<= 1) {
            const unsigned lo = __shfl_xor((unsigned)best, off), hiw = __shfl_xor((unsigned)(best >> 32), off);
            const unsigned long long other = ((unsigned long long)hiw << 32) | lo;
            best = other > best ? other : best; }
        if ((unsigned)(best >> 32) == 0u) break;
        const int wj = (int)(0xffffffffu - (unsigned)best);
#pragma unroll
        for (int k = 0; k < 4; ++k) if (wj == lane + 64 * k) { key[k] = 0u; sel[k] = true; }
    }
#pragma unroll
    for (int k = 0; k < 4; ++k) { const unsigned long long bm = __ballot(sel[k]);
        if (lane == 0) { selrow[2 * k] = (unsigned)bm; selrow[2 * k + 1] = (unsigned)(bm >> 32); } }
}
__device__ __forceinline__ void nsa_topk4(const LAS float* imp0, LAS unsigned* sel0, int cur, int lane) {
    unsigned key[4][4]; bool forced[4];
#pragma unroll
    for (int k = 0; k < 4; ++k) { const int j = lane + 64 * k;
        forced[k] = (j == 0) || (j == cur) || (j == cur - 1);
        const bool cand = (j <= cur) && !forced[k];
#pragma unroll
        for (int i = 0; i < 4; ++i) key[i][k] = cand ? (__float_as_uint(imp0[i * 256 + j]) + 1u) : 0u; }
    const int want = 16 - (1 + (cur >= 1 ? 1 : 0) + (cur >= 2 ? 1 : 0));
    unsigned T[4] = {0u, 0u, 0u, 0u};
    for (int bit = 30; bit >= 0; --bit) {
#pragma unroll
        for (int i = 0; i < 4; ++i) { const unsigned c = T[i] | (1u << bit);
            const int n = __builtin_popcountll(__ballot(key[i][0] >= c)) + __builtin_popcountll(__ballot(key[i][1] >= c)) + __builtin_popcountll(__ballot(key[i][2] >= c)) + __builtin_popcountll(__ballot(key[i][3] >= c));
            if (n >= want) T[i] = c; }
    }
#pragma unroll
    for (int i = 0; i < 4; ++i) {
        const unsigned Ti = T[i];
        int rem = want;
        if (Ti != 0u) rem -= __builtin_popcountll(__ballot(key[i][0] > Ti)) + __builtin_popcountll(__ballot(key[i][1] > Ti)) + __builtin_popcountll(__ballot(key[i][2] > Ti)) + __builtin_popcountll(__ballot(key[i][3] > Ti));
#pragma unroll
        for (int k = 0; k < 4; ++k) {
            bool s = forced[k];
            if (Ti == 0u) s = s || key[i][k] >= 1u;
            else {
                const bool eq = key[i][k] == Ti; const unsigned long long em = __ballot(eq);
                const int below = (int)__builtin_amdgcn_mbcnt_hi((unsigned)(em >> 32), __builtin_amdgcn_mbcnt_lo((unsigned)em, 0u));
                s = s || key[i][k] > Ti || (eq && below < rem);
                rem -= __builtin_popcountll(em); if (rem < 0) rem = 0;
            }
            const unsigned long long bm = __ballot(s);
            if (lane == 0) { sel0[i * 8 + 2 * k] = (unsigned)bm; sel0[i * 8 + 2 * k + 1] = (unsigned)(bm >> 32); }
        }
    }
}
__device__ __forceinline__ int nsa_opaque(int v) { asm volatile("" : "+v"(v)); return v; }
__device__ __forceinline__ void nsa_unit(LAS unsigned char* lds, const NsaPtrs& P, int g, int qblk, int tid_in, int wave, int lane_in, int cu) {
    int tid = tid_in; asm volatile("" : "+v"(tid));
    const int lane = tid & 63; (void)lane_in;
    const int r32 = lane & 31, hi = lane >> 5;
    const int hh = 8 * g + wave, t0 = 32 * qblk, t = t0 + r32;
    const float slope2 = __builtin_amdgcn_exp2f(-0.5f * (float)(hh + 1)) * LOG2E;
    bf16x8 q[8];
    { const bf16* qp = P.Q + (size_t)t * 2048 + hh * 128 + hi * 8;
#pragma unroll
      for (int d0 = 0; d0 < 8; ++d0) q[d0] = *(const GAS bf16x8*)(qp + d0 * 16); }
#define NSA_SCR() ((GAS f32x4*)(P.scr + ((size_t)(cu * 8 + wave) * 16) * 256) + nsa_opaque(lane))
    const size_t CH = (size_t)S * 128 * 2;
    f32x16 o[4]; float m, l;
#define NSA_ZERO_O() do { _Pragma("unroll") for (int d_ = 0; d_ < 4; ++d_) _Pragma("unroll") for (int r_ = 0; r_ < 16; ++r_) o[d_][r_] = 0.f; } while (0)
    const int ncv = 2 * qblk + 1, ntc = (ncv + 63) >> 6;
    const unsigned char* kc = (const unsigned char*)P.KC + (size_t)g * 1024 * 256; const unsigned char* vc = (const unsigned char*)P.VC + (size_t)g * 1024 * 256;
    m = -1e30f; l = 0.f; NSA_ZERO_O();
    nsa_loop<0>(lds, kc, vc, ntc, 0, q, t, slope2, m, l, o, 0.f, tid, wave, lane);
    const float invl = l > 0.f ? 1.f / l : 0.f;
    nsa_loop<1>(lds, kc, vc, ntc, 0, q, t, slope2, m, l, o, invl, tid, wave, lane);
    { const float g_c = P.G[(size_t)t * 48 + hh]; GAS f32x4* scr = NSA_SCR();
#pragma unroll
    for (int d0 = 0; d0 < 4; ++d0)
#pragma unroll
        for (int rg = 0; rg < 4; ++rg) { f32x4 v = {o[d0][4 * rg] * g_c, o[d0][4 * rg + 1] * g_c, o[d0][4 * rg + 2] * g_c, o[d0][4 * rg + 3] * g_c}; scr[(d0 * 4 + rg) * 64] = v; } }
    const int cur = t0 >> 6;
    LAS unsigned* selm = (LAS unsigned*)(lds + N_SELM);
#ifdef NSA_TOPK_ITER
    for (int i = 0; i < 4; ++i) { const int qq = 4 * wave + i; nsa_topk((const LAS float*)(lds + N_IMP) + qq * 256, selm + qq * 8, cur, lane); }
#else
    nsa_topk4((const LAS float*)(lds + N_IMP) + 4 * wave * 256, selm + 4 * wave * 8, cur, lane);
#endif
    __syncthreads();
    if (wave == 0) {
        LAS int* ulist = (LAS int*)(lds + N_ULIST); int n = 0;
        for (int k = 0; k < 8; ++k) { unsigned u = (lane < 32) ? selm[lane * 8 + k] : 0u;
#pragma unroll
            for (int off = 1; off < 32; off <<= 1) u |= __shfl_xor(u, off);
            u = __builtin_amdgcn_readfirstlane(u);
            while (u) { const int b = __builtin_ctz(u); u &= u - 1u; if (lane == 0) ulist[n] = 32 * k + b; ++n; } }
        if (lane == 0) *(LAS int*)(lds + N_NTS) = n;
    }
    __syncthreads();
    const int nts = __builtin_amdgcn_readfirstlane(*(const LAS int*)(lds + N_NTS));
    m = -1e30f; l = 0.f; NSA_ZERO_O();
    nsa_loop<2>(lds, (const unsigned char*)P.KV + (size_t)(4 + g) * CH, (const unsigned char*)P.KV + (size_t)(6 + g) * CH, nts, 0, q, t, slope2, m, l, o, 0.f, tid, wave, lane);
    { const float f = P.G[(size_t)t * 48 + 16 + hh] / l; GAS f32x4* scr = NSA_SCR();
#pragma unroll
      for (int d0 = 0; d0 < 4; ++d0)
          { f32x4 v[4];
#pragma unroll
            for (int rg = 0; rg < 4; ++rg) v[rg] = scr[(d0 * 4 + rg) * 64];
#pragma unroll
            for (int rg = 0; rg < 4; ++rg) { v[rg][0] += o[d0][4 * rg] * f; v[rg][1] += o[d0][4 * rg + 1] * f; v[rg][2] += o[d0][4 * rg + 2] * f; v[rg][3] += o[d0][4 * rg + 3] * f; scr[(d0 * 4 + rg) * 64] = v[rg]; } } }
    const int jlo = (t0 > 511 ? t0 - 511 : 0) >> 6, jhi = (t0 + 31) >> 6;
    m = -1e30f; l = 0.f; NSA_ZERO_O();
    nsa_loop<3>(lds, (const unsigned char*)P.KV + (size_t)(8 + g) * CH, (const unsigned char*)P.KV + (size_t)(10 + g) * CH, jhi - jlo + 1, jlo, q, t, slope2, m, l, o, 0.f, tid, wave, lane);
    { const float f = P.G[(size_t)t * 48 + 32 + hh] / l; GAS f32x4* scr = NSA_SCR();
      const bf16* zp = P.Z + (size_t)t * 2048 + hh * 128 + 4 * hi;
      bf16* op = P.O + (size_t)t * 4096 + 2048 + hh * 128 + 4 * hi;
#pragma unroll
      for (int d0 = 0; d0 < 4; ++d0)
          { f32x4 av[4]; u32x2 zv[4];
#pragma unroll
            for (int rg = 0; rg < 4; ++rg) { av[rg] = scr[(d0 * 4 + rg) * 64]; zv[rg] = *(const GAS u32x2*)(zp + 32 * d0 + 8 * rg); }
#pragma unroll
          for (int rg = 0; rg < 4; ++rg) { const int dim = 32 * d0 + 8 * rg; const f32x4 a = av[rg];
              const u32x2 z = zv[rg];
              u32x2 w; w.x = pk2((a[0] + o[d0][4 * rg] * f) * bflo(z.x), (a[1] + o[d0][4 * rg + 1] * f) * bfhi(z.x)); w.y = pk2((a[2] + o[d0][4 * rg + 2] * f) * bflo(z.y), (a[3] + o[d0][4 * rg + 3] * f) * bfhi(z.y));
              *(GAS u32x2*)(op + dim) = w; } } }
#undef NSA_ZERO_O
#undef NSA_SCR
}
struct CmpPtrs { const bf16* KV; const bf16* W1; const bf16* W2; const float* cbp; bf16* KC; bf16* VC; };
__device__ __forceinline__ void cmp_unit(LAS unsigned char* lds, const CmpPtrs& P, int kv, int g, int tile, int tid, int wave, int lane) {
    const int fr = lane & 15, fq = lane >> 4;
    constexpr int CRS = 544;
    LAS unsigned char* As = lds + 16384;
    LAS unsigned char* Ws = As + 16 * CRS;
    const unsigned char* Ag = (const unsigned char*)(P.KV + (size_t)(kv * 2 + g) * ((size_t)S * 128) + (size_t)(16 * tile + (tid >> 5)) * 2048) + (tid & 31) * 16;
    const unsigned char* Wg = (const unsigned char*)(P.W1 + (size_t)kv * 128 * 4096 + (size_t)(tid >> 5) * 4096) + (tid & 31) * 16;
    LAS unsigned char* Ad = As + (tid >> 5) * CRS + (tid & 31) * 16;
    LAS unsigned char* Wd = Ws + (tid >> 5) * CRS + (tid & 31) * 16;
    const LAS unsigned char* Ar = As + fr * CRS + fq * 16;
    const LAS unsigned char* Wr = Ws + (16 * wave + fr) * CRS + fq * 16;
    u32x4 ra, rw[8];
#define CMP_LOAD(c) do { ra = *(const GAS u32x4*)(Ag + (c) * 512); _Pragma("unroll") for (int i_ = 0; i_ < 8; ++i_) rw[i_] = *(const GAS u32x4*)(Wg + (size_t)i_ * (16 * 8192) + (c) * 512); } while (0)
    CMP_LOAD(0);
    f32x4 acc = {0.f, 0.f, 0.f, 0.f};
    for (int c = 0; c < 16; ++c) {
        *(LAS u32x4*)Ad = ra;
#pragma unroll
        for (int i = 0; i < 8; ++i) *(LAS u32x4*)(Wd + i * 16 * CRS) = rw[i];
        __syncthreads();
        if (c + 1 < 16) CMP_LOAD(c + 1);
#pragma unroll
        for (int s = 0; s < 8; ++s) {
            const bf16x8 a = *(const LAS bf16x8*)(Ar + 64 * s), b = *(const LAS bf16x8*)(Wr + 64 * s);
            acc = __builtin_amdgcn_mfma_f32_16x16x32_bf16(a, b, acc, 0, 0, 0);
        }
        __syncthreads();
    }
#undef CMP_LOAD
    float bias = 0.f;
    { float bv[16];
#pragma unroll
      for (int c = 0; c < 16; ++c) bv[c] = *(const GAS float*)(P.cbp + (size_t)(kv * 16 + c) * 128 + 16 * wave + fr);
#pragma unroll
      for (int c = 0; c < 16; ++c) bias += bv[c]; }
    LAS bf16* hid = (LAS bf16*)lds;
#pragma unroll
    for (int i = 0; i < 4; ++i) hid[(4 * fq + i) * 136 + 16 * wave + fr] = (bf16)(pk2(silu_f(acc[i] + bias), 0.f) & 0xffffu);
    __syncthreads();
    const bf16* B2 = P.W2 + (size_t)kv * 128 * 128 + (size_t)(16 * wave + fr) * 128 + 8 * fq;
    f32x4 acc2 = {0.f, 0.f, 0.f, 0.f};
#pragma unroll
    for (int s = 0; s < 4; ++s) {
        const bf16x8 a = *(const LAS bf16x8*)(hid + fr * 136 + 32 * s + 8 * fq), b = *(const GAS bf16x8*)(B2 + 32 * s);
        acc2 = __builtin_amdgcn_mfma_f32_16x16x32_bf16(a, b, acc2, 0, 0, 0);
    }
    bf16* out = (kv ? P.VC : P.KC) + (size_t)g * 1024 * 128;
#pragma unroll
    for (int i = 0; i < 4; ++i) { const int nn = 16 * tile + 4 * fq + i; out[(size_t)nn * 128 + 16 * wave + fr] = (nn < 1023) ? (bf16)(pk2(acc2[i], 0.f) & 0xffffu) : (bf16)0; }
    __syncthreads();
}
}
#ifdef CHK_BUILD
namespace chk {
constexpr size_t WS_CHK = 14 * MiB;
__device__ __forceinline__ float bf2f(bf16 v) { return __uint_as_float((unsigned)v << 16); }
__device__ __forceinline__ float e4m3(unsigned char b) {
    const int e = (b >> 3) & 15, mm = b & 7; const float v = e == 0 ? (float)mm * (1.f / 512.f) : (1.f + (float)mm * 0.125f) * exp2f((float)(e - 7)); return (b & 0x80) ? -v : v; }
__device__ __forceinline__ int sample_t(int i) { return i * 64 + (i * 29) % 64; }
__device__ __noinline__ void nsa_check(LAS unsigned char* lds, unsigned char* ws, int t, int g, LAS float* acc2) {
    int tid_ = threadIdx.x; asm volatile("" : "+v"(tid_)); const int tid = tid_, lane = tid & 63, wave = tid >> 6;
    const int hh = 8 * g + wave, cur = t >> 6;
    const bf16* QN = (const bf16*)(ws + WS_QNSA); const bf16* KV = (const bf16*)(ws + WS_KVNSA); const bf16* KC = (const bf16*)(ws + WS_KCMP) + (size_t)g * 1024 * 128; const bf16* VC = (const bf16*)(ws + WS_VCMP) + (size_t)g * 1024 * 128;
    const bf16* ZN = (const bf16*)(ws + WS_ZNSA); const float* GN = (const float*)(ws + WS_GNSA); const bf16* HO = (const bf16*)(ws + WS_H);
    const size_t CH = (size_t)S * 128;
    LAS float* pc = (LAS float*)lds;
    LAS float* impv = (LAS float*)(lds + 32768);
    LAS int* sel = (LAS int*)(lds + 32768 + 1024);
    const float slope2 = exp2f(-0.5f * (float)(hh + 1)) * LOG2E;
    const float q0 = bf2f(QN[(size_t)t * 2048 + hh * 128 + 2 * lane]), q1 = bf2f(QN[(size_t)t * 2048 + hh * 128 + 2 * lane + 1]);
    float oc0 = 0.f, oc1 = 0.f, os0 = 0.f, os1 = 0.f, ow0 = 0.f, ow1 = 0.f;
    const int ncv = (t >= 31) ? (t - 31) / 16 + 1 : 0;
    for (int n = lane; n < 1024; n += 64) pc[wave * 1024 + n] = 0.f;
    float mx = -1e30f;
    for (int n = 0; n < ncv; ++n) { float s = q0 * bf2f(KC[(size_t)n * 128 + 2 * lane]) + q1 * bf2f(KC[(size_t)n * 128 + 2 * lane + 1]); s = wave_sum(s) - slope2 * (float)(t - 16 * n - 31);
        if (lane == 0) pc[wave * 1024 + n] = s; mx = fmaxf(mx, s); }
    __syncthreads();
    float sum = 0.f;
    for (int n = 0; n < ncv; ++n) sum += exp2f(pc[wave * 1024 + n] - mx);
    __syncthreads();
    for (int n = lane; n < 1024; n += 64) pc[wave * 1024 + n] = (n < ncv) ? exp2f(pc[wave * 1024 + n] - mx) / sum : 0.f;
    __syncthreads();
    for (int n = 0; n < ncv; ++n) { const float p = pc[wave * 1024 + n]; oc0 += p * bf2f(VC[(size_t)n * 128 + 2 * lane]); oc1 += p * bf2f(VC[(size_t)n * 128 + 2 * lane + 1]); }
    if (tid < 256) { const int j = tid; float v = -1e30f;
        if (64 * j <= t) { float a = 0.f; for (int ii = 4 * j - 1; ii <= 4 * j + 3; ++ii) if (ii >= 0 && ii <= 1022) { float ps = 0.f; for (int h = 0; h < 8; ++h) ps += pc[h * 1024 + ii]; a += ps; }
            const bool forced = (j == 0) || (j == cur) || (j == cur - 1); v = a + (forced ? 1e4f : 0.f); }
        impv[j] = v; }
    __syncthreads();
    if (tid < 256) { const int j = tid; const float v = impv[j]; int rank = 0; for (int ii = 0; ii < 256; ++ii) { const float u = impv[ii]; rank += (u > v || (u == v && ii < j)) ? 1 : 0; } sel[j] = rank < 16 ? 1 : 0; }
    __syncthreads();
    const bf16* KS = KV + (size_t)(4 + g) * CH; const bf16* VSl = KV + (size_t)(6 + g) * CH;
    mx = -1e30f;
    for (int j = 0; j < 256; ++j) if (sel[j]) for (int tok = 64 * j; tok < 64 * j + 64 && tok <= t; ++tok) {
        float s = q0 * bf2f(KS[(size_t)tok * 128 + 2 * lane]) + q1 * bf2f(KS[(size_t)tok * 128 + 2 * lane + 1]); s = wave_sum(s) - slope2 * (float)(t - tok); mx = fmaxf(mx, s); }
    sum = 0.f;
    for (int j = 0; j < 256; ++j) if (sel[j]) for (int tok = 64 * j; tok < 64 * j + 64 && tok <= t; ++tok) {
        float s = q0 * bf2f(KS[(size_t)tok * 128 + 2 * lane]) + q1 * bf2f(KS[(size_t)tok * 128 + 2 * lane + 1]); s = wave_sum(s) - slope2 * (float)(t - tok);
        const float p = exp2f(s - mx); sum += p; os0 += p * bf2f(VSl[(size_t)tok * 128 + 2 * lane]); os1 += p * bf2f(VSl[(size_t)tok * 128 + 2 * lane + 1]); }
    os0 /= sum; os1 /= sum;
    const bf16* KW = KV + (size_t)(8 + g) * CH; const bf16* VW = KV + (size_t)(10 + g) * CH;
    const int lo = t - 511 > 0 ? t - 511 : 0;
    mx = -1e30f;
    for (int tok = lo; tok <= t; ++tok) { float s = q0 * bf2f(KW[(size_t)tok * 128 + 2 * lane]) + q1 * bf2f(KW[(size_t)tok * 128 + 2 * lane + 1]); s = wave_sum(s) - slope2 * (float)(t - tok); mx = fmaxf(mx, s); }
    sum = 0.f;
    for (int tok = lo; tok <= t; ++tok) { float s = q0 * bf2f(KW[(size_t)tok * 128 + 2 * lane]) + q1 * bf2f(KW[(size_t)tok * 128 + 2 * lane + 1]); s = wave_sum(s) - slope2 * (float)(t - tok);
        const float p = exp2f(s - mx); sum += p; ow0 += p * bf2f(VW[(size_t)tok * 128 + 2 * lane]); ow1 += p * bf2f(VW[(size_t)tok * 128 + 2 * lane + 1]); }
    ow0 /= sum; ow1 /= sum;
    const float gc = GN[(size_t)t * 48 + hh], gs = GN[(size_t)t * 48 + 16 + hh], gwv = GN[(size_t)t * 48 + 32 + hh];
    const float r0 = (gc * oc0 + gs * os0 + gwv * ow0) * bf2f(ZN[(size_t)t * 2048 + hh * 128 + 2 * lane]), r1 = (gc * oc1 + gs * os1 + gwv * ow1) * bf2f(ZN[(size_t)t * 2048 + hh * 128 + 2 * lane + 1]);
    const float f0 = bf2f(HO[(size_t)t * 4096 + 2048 + hh * 128 + 2 * lane]), f1 = bf2f(HO[(size_t)t * 4096 + 2048 + hh * 128 + 2 * lane + 1]);
    const float e2 = wave_sum((r0 - f0) * (r0 - f0) + (r1 - f1) * (r1 - f1)), n2 = wave_sum(r0 * r0 + r1 * r1);
    __syncthreads();
    if (lane == 0) { pc[wave] = e2; pc[8 + wave] = n2; }
    __syncthreads();
    if (tid == 0) { float a = 0.f, b = 0.f; for (int w = 0; w < 8; ++w) { a += pc[w]; b += pc[8 + w]; } acc2[0] += a; acc2[1] += b; }
    __syncthreads();
}
__device__ __forceinline__ void mla_check(LAS unsigned char* lds, unsigned char* ws, int t, LAS float* acc2) {
    int tid_ = threadIdx.x; asm volatile("" : "+v"(tid_)); const int tid = tid_, lane = tid & 63, wave = tid >> 6;
    const bf16* ZM = (const bf16*)(ws + WS_ZMLA); const bf16* HO = (const bf16*)(ws + WS_H);
    LAS float* qs = (LAS float*)lds + wave * 192;
    LAS float* red = (LAS float*)lds + 8 * 192;
    float ae = 0.f, an = 0.f;
    for (int rep = 0; rep < 2; ++rep) { const int head = wave + 8 * rep;
#ifdef MLA_FP8
        { const unsigned char* qp = (const unsigned char*)(ws + WS_QMLA) + (size_t)t * 3072 + head * 192; for (int d = lane; d < 192; d += 64) qs[d] = e4m3(qp[d]) * QS_MLA; }
#else
        { const bf16* qp = (const bf16*)(ws + WS_QMLA) + (size_t)t * 3072 + head * 192; for (int d = lane; d < 192; d += 64) qs[d] = bf2f(qp[d]); }
#endif
        __syncthreads();
        float mx = -1e30f;
        for (int c = 0; 64 * c <= t; ++c) {
#ifdef MLA_MX
            const int tok = 64 * c + 8 * ((lane >> 2) & 7) + 4 * (lane >> 5) + (lane & 3);
#else
            const int x_ = lane & 15; const int tok = 64 * c + (lane & 48) + (x_ < 4 ? x_ : (x_ < 8 ? x_ + 4 : (x_ < 12 ? x_ - 4 : x_)));
#endif

            float s = 0.f;
#ifdef MLA_FP8
            const unsigned char* kp = (const unsigned char*)(ws + WS_KMLA) + (size_t)tok * 3072 + head * 192; for (int d = 0; d < 192; ++d) s += qs[d] * e4m3(kp[d]);
#else
            const bf16* kp = (const bf16*)(ws + WS_KMLA) + (size_t)tok * 3072 + head * 192; for (int d = 0; d < 192; ++d) s += qs[d] * bf2f(kp[d]);
#endif
            if (tok <= t) mx = fmaxf(mx, s); }
        for (int off = 1; off < 64; off <<= 1) mx = fmaxf(mx, __shfl_xor(mx, off));
        float e2 = 0.f, n2 = 0.f;
        for (int dc = 0; dc < 8; ++dc) {
        float sum = 0.f; float o[16];
#pragma unroll
        for (int d = 0; d < 16; ++d) o[d] = 0.f;
        for (int c = 0; 64 * c <= t; ++c) {
#ifdef MLA_MX
            const int tok = 64 * c + 8 * ((lane >> 2) & 7) + 4 * (lane >> 5) + (lane & 3);
#else
            const int x_ = lane & 15; const int tok = 64 * c + (lane & 48) + (x_ < 4 ? x_ : (x_ < 8 ? x_ + 4 : (x_ < 12 ? x_ - 4 : x_)));
#endif

            float s = 0.f;
#ifdef MLA_FP8
            const unsigned char* kp = (const unsigned char*)(ws + WS_KMLA) + (size_t)tok * 3072 + head * 192; for (int d = 0; d < 192; ++d) s += qs[d] * e4m3(kp[d]);
#else
            const bf16* kp = (const bf16*)(ws + WS_KMLA) + (size_t)tok * 3072 + head * 192; for (int d = 0; d < 192; ++d) s += qs[d] * bf2f(kp[d]);
#endif
            const float p = (tok <= t) ? exp2f(s - mx) : 0.f; sum += p;
#ifdef MLA_FP8V
            const unsigned char* vt = (const unsigned char*)(ws + WS_VMLA) + ((size_t)head * 128 + 16 * dc) * S + 64 * c + lane;
#pragma unroll
            for (int d = 0; d < 16; ++d) o[d] += p * e4m3(vt[(size_t)d * S]);
#else
            const bf16* vp = (const bf16*)(ws + WS_VMLA) + (size_t)tok * 2048 + head * 128 + 16 * dc;
#pragma unroll
            for (int d = 0; d < 16; ++d) o[d] += p * bf2f(vp[d]);
#endif
        }
        sum = wave_sum(sum);
#pragma unroll
        for (int d = 0; d < 16; ++d) { const float od = wave_sum(o[d]) / sum; const float r = od * bf2f(ZM[(size_t)t * 2048 + head * 128 + 16 * dc + d]), f = bf2f(HO[(size_t)t * 4096 + head * 128 + 16 * dc + d]); e2 += (r - f) * (r - f); n2 += r * r; }
        }
        ae += e2; an += n2;
        __syncthreads(); }
    if (lane == 0) { red[wave] = ae; red[8 + wave] = an; }
    __syncthreads();
    if (tid == 0) { float a = 0.f, b = 0.f; for (int w = 0; w < 8; ++w) { a += red[w]; b += red[8 + w]; } acc2[0] += a; acc2[1] += b; }
    __syncthreads();
}
}
#endif
#ifdef CHK2_BUILD
namespace chk2 {
constexpr size_t WS_CHK = 14 * MiB;
__device__ __forceinline__ float bf2f(bf16 v) { return __uint_as_float((unsigned)v << 16); }
__device__ __forceinline__ int sample_t(int i) { return i * 256 + (i * 29) % 256; }
__device__ __noinline__ void proj_check(LAS unsigned char* lds, unsigned char* ws, const float* x, const float* w_in_l, int l, int i, int qd, LAS float* acc2) {
    int tid_ = threadIdx.x; asm volatile("" : "+v"(tid_)); const int tid = tid_;
    const int t = sample_t(i);
    LAS float* h = (LAS float*)lds;
    LAS float* red = h + 4096;
    const float* mod = (const float*)(ws + WS_MOD) + (size_t)l * 3 * D;
    const float* xin = (l == 0) ? x : (const float*)(ws + WS_XV);
    for (int k = tid; k < D; k += NTHR) h[k] = xin[(size_t)t * D + k] * (1.f + mod[D + k]) + mod[k];
    __syncthreads();
    float e2 = 0.f, r2 = 0.f;
    const float* cosT = (const float*)(ws + WS_ROPE); const float* sinT = cosT + (size_t)S * 32;
    for (int n = qd * 2268 + tid; n < (qd + 1) * 2268; n += NTHR) {
        float a = 0.f;
        for (int k = 0; k < D; ++k) a += h[k] * w_in_l[(size_t)k * INC + n];
        float ref = a, got;
        if (n < 768) got = bf2f(((const bf16*)(ws + WS_QLAT))[(size_t)t * 768 + n]);
        else if (n < 1280) got = bf2f(((const bf16*)(ws + WS_KVLAT))[(size_t)t * 512 + n - 768]);
        else if (n < 1344) {
            const int ii = n - 1280, pi = ii & 31; const int np = 1280 + (ii < 32 ? ii + 32 : ii - 32); float b = 0.f;
            for (int k = 0; k < D; ++k) b += h[k] * w_in_l[(size_t)k * INC + np];
            const float c = cosT[(size_t)t * 32 + pi], s = sinT[(size_t)t * 32 + pi];
            ref = ii < 32 ? a * c - b * s : a * c + b * s;
            got = bf2f(((const bf16*)(ws + WS_KMLA))[(size_t)t * 3072 + 5 * 192 + 128 + 2 * pi + (ii >> 5)]);
        }
        else if (n < 3392) { ref = a / (1.f + expf(-a)); got = bf2f(((const bf16*)(ws + WS_ZMLA))[(size_t)t * 2048 + n - 1344]); }
        else if (n < 5440) { ref = a * QS_NSA; got = bf2f(((const bf16*)(ws + WS_QNSA))[(size_t)t * 2048 + n - 3392]); }
        else if (n < 6976) { const int c = n - 5440; got = bf2f(((const bf16*)(ws + WS_KVNSA))[(size_t)(c >> 7) * ((size_t)S * 128) + (size_t)t * 128 + (c & 127)]); }
        else if (n < 7024) { ref = 1.f / (1.f + expf(-a)); got = ((const float*)(ws + WS_GNSA))[(size_t)t * 48 + n - 6976]; }
        else { ref = a / (1.f + expf(-a)); got = bf2f(((const bf16*)(ws + WS_ZNSA))[(size_t)t * 2048 + n - 7024]); }
        e2 += (ref - got) * (ref - got); r2 += ref * ref;
    }
    red[tid] = e2; red[512 + tid] = r2;
    __syncthreads();
    if (tid == 0) { float a = 0.f, b = 0.f; for (int k = 0; k < 512; ++k) { a += red[k]; b += red[512 + k]; } acc2[0] += a; acc2[1] += b; }
    __syncthreads();
}
__device__ __noinline__ void cmp_check(LAS unsigned char* lds, unsigned char* ws, const float* cmp_pos_l, const float* w1_l, const float* w2_l, int i, LAS float* acc2) {
    int tid_ = threadIdx.x; asm volatile("" : "+v"(tid_)); const int tid = tid_;
    const int n = (4 * i + (i & 3)) % 1023, kv = i & 1, g = (i >> 1) & 1;
    LAS float* blk = (LAS float*)lds;
    LAS float* hid = blk + 4096;
    LAS float* red = hid + 128;
    const bf16* A = (const bf16*)(ws + WS_KVNSA) + (size_t)(kv * 2 + g) * ((size_t)S * 128) + (size_t)n * 2048;
    for (int k = tid; k < 4096; k += NTHR) blk[k] = bf2f(A[k]) + cmp_pos_l[(size_t)kv * 4096 + k];
    __syncthreads();
    if (tid < 128) { float a = 0.f; const float* W = w1_l + (size_t)kv * 4096 * 128 + tid; for (int k = 0; k < 4096; ++k) a += blk[k] * W[(size_t)k * 128]; hid[tid] = a / (1.f + expf(-a)); }
    __syncthreads();
    float e2 = 0.f, r2 = 0.f;
    if (tid < 128) { float a = 0.f; const float* W = w2_l + (size_t)kv * 128 * 128 + tid; for (int k = 0; k < 128; ++k) a += hid[k] * W[(size_t)k * 128];
        const float got = bf2f(((const bf16*)(ws + (kv ? WS_VCMP : WS_KCMP)))[(size_t)g * 1024 * 128 + (size_t)n * 128 + tid]); e2 = (a - got) * (a - got); r2 = a * a; }
    if (tid < 128) { red[tid] = e2; red[128 + tid] = r2; }
    __syncthreads();
    if (tid == 0) { float a = 0.f, b = 0.f; for (int k = 0; k < 128; ++k) { a += red[k]; b += red[128 + k]; } acc2[0] += a; acc2[1] += b; }
    __syncthreads();
}
}
#endif
#ifdef CHK3_BUILD
namespace chk3 {
constexpr size_t WS_CHK = 14 * MiB;
__device__ __forceinline__ float bf2f(bf16 v) { return __uint_as_float((unsigned)v << 16); }
__device__ __forceinline__ float e4m3(unsigned char b) { const int e = (b >> 3) & 15, mm = b & 7; const float v = e == 0 ? (float)mm * (1.f / 512.f) : (1.f + (float)mm * 0.125f) * exp2f((float)(e - 7)); return (b & 0x80) ? -v : v; }
__device__ __forceinline__ int sample_t(int i) { return i * 64 + (i * 29) % 64; }
__device__ __noinline__ void up_check(LAS unsigned char* lds, unsigned char* ws, const float* qn, const float* wq, const float* kn, const float* wkv, int i, LAS float* acc2) {
    int tid_ = threadIdx.x; asm volatile("" : "+v"(tid_)); const int tid = tid_;
    const int t = sample_t(i);
    LAS float* ql = (LAS float*)lds;
    LAS float* kl = ql + 768;
    LAS float* qo = kl + 512;
    LAS float* red = qo + 3072;
    const bf16* QL = (const bf16*)(ws + WS_QLAT) + (size_t)t * 768; const bf16* KL = (const bf16*)(ws + WS_KVLAT) + (size_t)t * 512;
    float s = 0.f; for (int k = tid; k < 768; k += NTHR) { const float v = bf2f(QL[k]); s += v * v; }
    red[tid] = s; __syncthreads();
    float tot = 0.f; for (int k = 0; k < 512; ++k) tot += red[k];
    const float rq = 1.f / sqrtf(tot / 768.f + RMS_EPS);
    __syncthreads();
    s = 0.f; for (int k = tid; k < 512; k += NTHR) { const float v = bf2f(KL[k]); s += v * v; }
    red[tid] = s; __syncthreads();
    tot = 0.f; for (int k = 0; k < 512; ++k) tot += red[k];
    const float rk = 1.f / sqrtf(tot / 512.f + RMS_EPS);
    __syncthreads();
    for (int k = tid; k < 768; k += NTHR) ql[k] = bf2f(QL[k]) * rq * qn[k];
    for (int k = tid; k < 512; k += NTHR) kl[k] = bf2f(KL[k]) * rk * kn[k];
    __syncthreads();
    for (int n = tid; n < 3072; n += NTHR) { float a = 0.f; for (int k = 0; k < 768; ++k) a += ql[k] * wq[(size_t)k * 3072 + n]; qo[n] = a; }
    __syncthreads();
    float e2 = 0.f, r2 = 0.f;
    const float* cosT = (const float*)(ws + WS_ROPE); const float* sinT = cosT + (size_t)S * 32;
    const bf16* QM = (const bf16*)(ws + WS_QMLA) + (size_t)t * 3072;
    for (int n = tid; n < 3072; n += NTHR) { const int h = n / 192, d = n % 192; float ref, got;
#ifdef MLA_FP8
        const unsigned char* Q8 = (const unsigned char*)(ws + WS_QMLA) + (size_t)t * 3072;
        if (d < 128) { ref = qo[n]; got = e4m3(Q8[h * 192 + d]); }
        else { const int ii = d - 128, pi = ii & 31; const float x1 = qo[h * 192 + 128 + pi], x2 = qo[h * 192 + 160 + pi]; const float c = cosT[(size_t)t * 32 + pi], sn = sinT[(size_t)t * 32 + pi];
            ref = (ii < 32 ? x1 * c - x2 * sn : x2 * c + x1 * sn); got = e4m3(Q8[h * 192 + 128 + 2 * pi + (ii >> 5)]); }
        if (false) {}
#else
        if (d < 128) { ref = qo[n] * QS_MLA; got = bf2f(QM[h * 192 + d]); }
        else { const int ii = d - 128, pi = ii & 31; const float x1 = qo[h * 192 + 128 + pi], x2 = qo[h * 192 + 160 + pi]; const float c = cosT[(size_t)t * 32 + pi], sn = sinT[(size_t)t * 32 + pi];
            ref = (ii < 32 ? x1 * c - x2 * sn : x2 * c + x1 * sn) * QS_MLA; got = bf2f(QM[h * 192 + 128 + 2 * pi + (ii >> 5)]); }
#endif
        e2 += (ref - got) * (ref - got); r2 += ref * ref; }
    const bf16* KM = (const bf16*)(ws + WS_KMLA) + (size_t)t * 3072; const bf16* VM = (const bf16*)(ws + WS_VMLA) + (size_t)t * 2048;
    for (int n = tid; n < 4096; n += NTHR) { float a = 0.f; for (int k = 0; k < 512; ++k) a += kl[k] * wkv[(size_t)k * 4096 + n];
#ifdef MLA_FP8
        const int h = n >> 8, d = n & 255; const float got = d < 128 ? e4m3(((const unsigned char*)(ws + WS_KMLA) + (size_t)t * 3072)[h * 192 + d]) : bf2f(VM[h * 128 + d - 128]);
#else
        const int h = n >> 8, d = n & 255; const float got = d < 128 ? bf2f(KM[h * 192 + d]) : bf2f(VM[h * 128 + d - 128]);
#endif
        e2 += (a - got) * (a - got); r2 += a * a; }
    red[tid] = e2; red[512 + tid] = r2;
    __syncthreads();
    if (tid == 0) { float a = 0.f, b = 0.f; for (int k = 0; k < 512; ++k) { a += red[k]; b += red[512 + k]; } acc2[0] += a; acc2[1] += b; }
    __syncthreads();
}
__device__ __noinline__ void out_check(LAS unsigned char* lds, unsigned char* ws, const float* xin, const float* xv, const float* wout, const float* gate, int i, int qd, LAS float* acc2) {
    int tid_ = threadIdx.x; asm volatile("" : "+v"(tid_)); const int tid = tid_;
    const int t = i * 256 + (i * 29) % 256;
    LAS float* o = (LAS float*)lds;
    LAS float* red = o + 4096;
    const bf16* OA = (const bf16*)(ws + WS_H) + (size_t)t * 4096;
    for (int k = tid; k < 4096; k += NTHR) o[k] = bf2f(OA[k]);
    __syncthreads();
    float e2 = 0.f, r2 = 0.f;
    for (int n = qd * 1024 + tid; n < (qd + 1) * 1024; n += NTHR) { float a = 0.f; for (int k = 0; k < 4096; ++k) a += o[k] * wout[(size_t)k * 4096 + n];
        const float gy = gate[n] * a, ref = DN_ALPHA * xin[(size_t)t * D + n] + gy, got = xv[(size_t)t * D + n];
        e2 += (ref - got) * (ref - got); r2 += gy * gy; }
    red[tid] = e2; red[512 + tid] = r2;
    __syncthreads();
    if (tid == 0) { float a = 0.f, b = 0.f; for (int k = 0; k < 512; ++k) { a += red[k]; b += red[512 + k]; } acc2[0] += a; acc2[1] += b; }
    __syncthreads();
}
}
#endif
#ifdef CHK4_BUILD
namespace chk4 {
__device__ __forceinline__ float bf2f(bf16 v) { return __uint_as_float((unsigned)v << 16); }
__device__ __noinline__ void mod_check(LAS unsigned char* lds, unsigned char* ws, const float* c, const float* w_ada, const float* b_ada, int u, LAS float* acc2) {
    const int tid = threadIdx.x;
    LAS float* red = (LAS float*)lds;
    const int l = u & 1, n = ((u >> 1) * 977 + 13) % (3 * D);
    float a = 0.f;
    for (int k = tid; k < D; k += NTHR) { const float cv = c[k]; a += cv / (1.f + expf(-cv)) * w_ada[(size_t)l * D * 3 * D + (size_t)k * 3 * D + n]; }
    red[tid] = a; __syncthreads();
    if (tid == 0) { float s = 0.f; for (int k = 0; k < NTHR; ++k) s += red[k]; s += b_ada[(size_t)l * 3 * D + n];
        const float got = ((const float*)(ws + WS_MOD))[(size_t)l * 3 * D + n]; acc2[0] += (s - got) * (s - got); acc2[1] += s * s; }
    __syncthreads();
}
__device__ __noinline__ void ln_check(LAS unsigned char* lds, unsigned char* ws, const float* ln_g, const float* ln_b, int u, LAS float* acc2) {
    const int tid = threadIdx.x;
    LAS float* red = (LAS float*)lds;
    const int t = u * 64 + (u * 29) % 64;
    const float* X1 = (const float*)(ws + WS_XV) + (size_t)t * D; const bf16* H = (const bf16*)(ws + WS_H) + (size_t)t * D; const float* mod1 = (const float*)(ws + WS_MOD) + 3 * D;
    float s1 = 0.f, s2 = 0.f, e2 = 0.f, r2 = 0.f;
    for (int k = tid; k < D; k += NTHR) { const float y = (X1[k] - ln_b[k]) / ln_g[k]; s1 += y; s2 += y * y;
        const float h = X1[k] * (1.f + mod1[D + k]) + mod1[k], got = bf2f(H[k]); e2 += (h - got) * (h - got); r2 += h * h; }
    red[tid] = s1; red[512 + tid] = s2; red[1024 + tid] = e2; red[1536 + tid] = r2; __syncthreads();
    if (tid == 0) { float a = 0.f, b = 0.f, c = 0.f, d = 0.f; for (int k = 0; k < NTHR; ++k) { a += red[k]; b += red[512 + k]; c += red[1024 + k]; d += red[1536 + k]; }
        const float mean = a / D, var = b / D - mean * mean;
        acc2[0] += mean * mean + (var - 1.f) * (var - 1.f) + c / d; acc2[1] += 1.f; }
    __syncthreads();
}
}
#endif
constexpr int PPL = 6;
constexpr int N_PHASES = 2 + PPL * DEPTH;
struct Args { const void* in[16]; float* out; unsigned char* ws; int ph_lo, ph_hi; };
#define WSP(T, off) ((T*)(ws + (off)))
#define VCU() ((gridDim.x % 8 == 0) ? (int)((blockIdx.x % 8) * (gridDim.x / 8) + blockIdx.x / 8) : (int)blockIdx.x)
__global__ void __launch_bounds__(NTHR, 2) mk_fwd(const Args args) {
    extern __shared__ __attribute__((aligned(16))) unsigned char lds_raw[];
    LAS unsigned char* lds = (LAS unsigned char*)lds_raw;
    if (threadIdx.x < 32) ((volatile LAS unsigned*)(lds + MISC_OFF))[threadIdx.x] = 0u;
    __syncthreads();
    XcdBarrier bar = xcd_barrier_post((unsigned*)(args.ws + WS_CTL) + CW_BAR, (volatile LAS unsigned*)(lds + MISC_OFF) + 8);
#define IN(k) (args.ph_lo <= (k) && (k) < args.ph_hi)
#define SEAM(k) do { if (IN(k) && IN((k) + 1)) xcd_barrier(bar); } while (0)
#define PHASE_REGS int tid_ = threadIdx.x; asm volatile("" : "+v"(tid_)); const int tid = tid_, lane = tid & 63, wave = __builtin_amdgcn_readfirstlane(tid >> 6); \
    unsigned char* ws = args.ws; asm volatile("" : "+s"(ws)); (void)tid; (void)lane; (void)wave

    if (IN(0)) {
        PHASE_REGS; const int G = gridDim.x, vcu = VCU();
        p0_mod_gemv((const float*)args.in[1], (const float*)args.in[3], (const float*)args.in[4], WSP(float, WS_MOD), (LAS float*)lds, vcu, G);
        p0_cmpbias((const float*)args.in[10], (const float*)args.in[11], WSP(float, WS_CBP), (LAS float*)lds, (vcu + G / 2) % G, G);
        p0_rope((const int*)args.in[2], WSP(float, WS_ROPE), WSP(float, WS_ROPE) + (size_t)S * 32, vcu * NTHR + tid, G * NTHR);
        const P0In I{(const float*)args.in[5], (const float*)args.in[6], (const float*)args.in[7], (const float*)args.in[8], (const float*)args.in[9], (const float*)args.in[11], (const float*)args.in[12], (const float*)args.in[13]};
#ifndef DIS_CONV
        p0_convert(I, ws, vcu * NWAVES + wave, G * NWAVES, lane);
#endif
#ifdef PROBE_P0CONV2
        p0_convert(I, ws, vcu * NWAVES + wave, G * NWAVES, lane);
#endif
#ifdef PROBE_P0MOD2
        __syncthreads(); p0_mod_gemv((const float*)args.in[1], (const float*)args.in[3], (const float*)args.in[4], WSP(float, WS_MOD), (LAS float*)lds, vcu, G);
#endif
    }
    SEAM(0);
#ifdef GEMM_F8
#define H8PTR WSP(unsigned char, WS_H8)
#else
#define H8PTR ((unsigned char*)nullptr)
#endif
    if (IN(1)) { PHASE_REGS; modulate_rows((const float*)args.in[0], WSP(bf16, WS_H), H8PTR, WSP(float, WS_MOD), VCU() * NWAVES + wave, gridDim.x * NWAVES, lane);
#ifdef PROBE_THIN2
        modulate_rows((const float*)args.in[0], WSP(bf16, WS_H), H8PTR, WSP(float, WS_MOD), VCU() * NWAVES + wave, gridDim.x * NWAVES, lane);
#endif
    }
    SEAM(1);
    for (int l = 0; l < DEPTH; ++l) {
        const int pb = 2 + PPL * l;
        if (IN(pb + 0)) {
            PHASE_REGS;
#ifdef GEMM_F8
            { pg8::Gemm gg{WSP(bf16, WS_H), (const bf16*)(ws + WS_W + (size_t)l * W_LSTRIDE + W_IN), S, 23 * 256, D}; pg8::InBf16Order SO; SO.init(S, 23 * 256, gridDim.x, blockIdx.x);
              const pg8::EpiIn E{ws, 0};
              pg8::gemm_phase<pg8::EpiIn, pg8::InBf16Order, true, true>(lds, gg, SO, E);
#ifdef PROBE_INB2
              pg8::gemm_phase<pg8::EpiIn, pg8::InBf16Order, true, true>(lds, gg, SO, E);
#endif
            }
            { pg8::Gemm gg{(const bf16*)(ws + WS_H8), (const bf16*)(ws + WS_WIN8 + (size_t)l * WIN8_LSTRIDE), S, 13 * 256, D / 2}; pg8::StaticOrder SO; SO.init(S, 13 * 256, gridDim.x, (blockIdx.x + 64) % gridDim.x);
              const pg8::EpiIn E{ws, 1};
              pg8::gemm_phase<pg8::EpiIn, pg8::StaticOrder, true, true, 0x79797979, 0x7f7f7f7f>(lds, gg, SO, E);
#ifdef PROBE_INF2
              pg8::gemm_phase<pg8::EpiIn, pg8::StaticOrder, true, true, 0x79797979, 0x7f7f7f7f>(lds, gg, SO, E);
#endif
            }
#else
            pg8::Gemm gg{WSP(bf16, WS_H), (const bf16*)(ws + WS_W + (size_t)l * W_LSTRIDE + W_IN), S, NIN, D}; pg8::StaticOrder SO; SO.init(S, NIN, gridDim.x, blockIdx.x);
            const pg8::EpiIn E{ws, 0};
#ifndef DIS_IN
            pg8::gemm_phase<pg8::EpiIn, pg8::StaticOrder, true, true>(lds, gg, SO, E);
#endif
#ifdef PROBE_IN2
            pg8::gemm_phase<pg8::EpiIn, pg8::StaticOrder, true, true>(lds, gg, SO, E);
#endif
#endif
        }
        SEAM(pb + 0);
        if (IN(pb + 1)) {
            PHASE_REGS; const int G = gridDim.x, vcu = VCU();
            rstd_rows(WSP(float, WS_RSQQ), WSP(float, WS_RSQKV), WSP(float, WS_RSTD), WSP(float, WS_RSTD) + S, vcu * NTHR + tid, G * NTHR);
            const att::CmpPtrs CP{WSP(bf16, WS_KVNSA), (const bf16*)(ws + WS_W + (size_t)l * W_LSTRIDE + W_C1), (const bf16*)(ws + WS_W + (size_t)l * W_LSTRIDE + W_C2),
                                  WSP(float, WS_CBP) + (size_t)l * 2 * 16 * 128, WSP(bf16, WS_KCMP), WSP(bf16, WS_VCMP)};
#ifndef DIS_CMP
            for (int u = vcu; u < 256; u += G) att::cmp_unit(lds, CP, u & 1, (u >> 1) & 1, u >> 2, tid, wave, lane);
#endif
#ifdef PROBE_THIN2
            rstd_rows(WSP(float, WS_RSQQ), WSP(float, WS_RSQKV), WSP(float, WS_RSTD), WSP(float, WS_RSTD) + S, vcu * NTHR + tid, G * NTHR);
            for (int u = vcu; u < 256; u += G) att::cmp_unit(lds, CP, u & 1, (u >> 1) & 1, u >> 2, tid, wave, lane);
#endif
        }
        SEAM(pb + 1);
        if (IN(pb + 2)) {
            PHASE_REGS;
#ifdef GEMM_F8
            { pg8::Gemm gg{WSP(bf16, WS_QLAT), (const bf16*)(ws + WS_W + (size_t)l * W_LSTRIDE + W_QUP), S, 3072, 384}; pg8::StaticOrder SO; SO.init(S, 3072, gridDim.x, blockIdx.x);
              const pg8::EpiQup E{ws};
              pg8::gemm_phase<pg8::EpiQup, pg8::StaticOrder, true, true, 0x7a7a7a7a, 0x7f7f7f7f>(lds, gg, SO, E);
#ifdef PROBE_UPF2
              pg8::gemm_phase<pg8::EpiQup, pg8::StaticOrder, true, true, 0x7a7a7a7a, 0x7f7f7f7f>(lds, gg, SO, E);
#endif
            }
            { pg8::Gemm gg{WSP(bf16, WS_KVLAT), (const bf16*)(ws + WS_W + (size_t)l * W_LSTRIDE + W_KVUP), S, 2048, 256}; pg8::StaticOrder SO; SO.init(S, 2048, gridDim.x, blockIdx.x);
              const pg8::EpiKup E{ws};
              pg8::gemm_phase<pg8::EpiKup, pg8::StaticOrder, true, true, 0x7a7a7a7a, 0x7f7f7f7f>(lds, gg, SO, E);
#ifdef PROBE_UPF2
              pg8::gemm_phase<pg8::EpiKup, pg8::StaticOrder, true, true, 0x7a7a7a7a, 0x7f7f7f7f>(lds, gg, SO, E);
#endif
            }
            { pg8::Gemm gg{(const bf16*)(ws + WS_W + (size_t)l * W_LSTRIDE + W_KVUP + (size_t)2048 * 512), WSP(bf16, WS_KVLAT), 2048, S, 256}; pg8::StaticOrder SO; SO.init(2048, S, gridDim.x, blockIdx.x);
              const pg8::EpiVt E{ws};
              pg8::gemm_phase<pg8::EpiVt, pg8::StaticOrder, true, true, 0x7f7f7f7f, 0x7a7a7a7a>(lds, gg, SO, E);
#ifdef PROBE_UPF2
              pg8::gemm_phase<pg8::EpiVt, pg8::StaticOrder, true, true, 0x7f7f7f7f, 0x7a7a7a7a>(lds, gg, SO, E);
#endif
            }
        }
#else
            { pg8::Gemm gg{WSP(bf16, WS_QLAT), (const bf16*)(ws + WS_W + (size_t)l * W_LSTRIDE + W_QUP), S, 3072, 768}; pg8::StaticOrder SO; SO.init(S, 3072, gridDim.x, blockIdx.x);
              const pg8::EpiQup E{ws};
#ifndef DIS_QUP
              pg8::gemm_phase<pg8::EpiQup, pg8::StaticOrder, true, true>(lds, gg, SO, E);
#endif
#ifdef PROBE_UP2
              pg8::gemm_phase<pg8::EpiQup, pg8::StaticOrder, true, true>(lds, gg, SO, E);
#endif
            }
#ifdef MLA_FP8V
            { pg8::Gemm gg{WSP(bf16, WS_KVLAT), (const bf16*)(ws + WS_W + (size_t)l * W_LSTRIDE + W_KVUP), S, 2048, 512}; pg8::StaticOrder SO; SO.init(S, 2048, gridDim.x, blockIdx.x);
              const pg8::EpiKup E{ws};
              pg8::gemm_phase<pg8::EpiKup, pg8::StaticOrder, true, true>(lds, gg, SO, E);
            }
            { pg8::Gemm gg{(const bf16*)(ws + WS_W + (size_t)l * W_LSTRIDE + W_KVUP) + (size_t)2048 * 512, WSP(bf16, WS_KVLAT), 2048, S, 512}; pg8::StaticOrder SO; SO.init(2048, S, gridDim.x, blockIdx.x);
              const pg8::EpiVt E{ws};
              pg8::gemm_phase<pg8::EpiVt, pg8::StaticOrder, true, true>(lds, gg, SO, E);
            }
        }
#else
            { pg8::Gemm gg{WSP(bf16, WS_KVLAT), (const bf16*)(ws + WS_W + (size_t)l * W_LSTRIDE + W_KVUP), S, 4096, 512}; pg8::StaticOrder SO; SO.init(S, 4096, gridDim.x, blockIdx.x);
              const pg8::EpiKvup E{ws};
#ifndef DIS_KVUP
              pg8::gemm_phase<pg8::EpiKvup, pg8::StaticOrder, true, true>(lds, gg, SO, E);
#endif
#ifdef PROBE_UP2
              pg8::gemm_phase<pg8::EpiKvup, pg8::StaticOrder, true, true>(lds, gg, SO, E);
#endif
            }
        }
#endif
#endif
        SEAM(pb + 2);
        if (IN(pb + 3)) {
            PHASE_REGS; const int G = gridDim.x, vcu = VCU();
            { const att::MlaPtrs MP{WSP(bf16, WS_QMLA), WSP(bf16, WS_KMLA), WSP(bf16, WS_VMLA), WSP(bf16, WS_ZMLA), WSP(bf16, WS_H)};
              for (int pu = vcu; pu < 512; pu += G) { const int head = pu >> 5, pr = pu & 31;
#ifndef DIS_MLA
                  att::mla_unit(lds, MP, head, 63 - pr, tid, wave, lane);
                  att::mla_unit(lds, MP, head, pr, tid, wave, lane);
#endif
              }
#ifdef PROBE_MLA2
              for (int pu = vcu; pu < 512; pu += G) { const int head = pu >> 5, pr = pu & 31; att::mla_unit(lds, MP, head, 63 - pr, tid, wave, lane); att::mla_unit(lds, MP, head, pr, tid, wave, lane); }
#endif
            }
            { const att::NsaPtrs NP{WSP(bf16, WS_QNSA), WSP(bf16, WS_KVNSA), WSP(bf16, WS_KCMP), WSP(bf16, WS_VCMP), WSP(bf16, WS_ZNSA), WSP(float, WS_GNSA), WSP(bf16, WS_H), WSP(float, WS_OSCR)};
#ifndef DIS_NSA
              for (int u = vcu; u < 1024; u += G) { const int v_ = (u >> 1) & 127, k_ = u >> 8;
                  att::nsa_unit(lds, NP, u & 1, (k_ & 1) ? 128 * k_ + 127 - v_ : 128 * k_ + v_, tid, wave, lane, blockIdx.x); }
#endif
#ifdef PROBE_NSA2
              for (int u = vcu; u < 1024; u += G) att::nsa_unit(lds, NP, u & 1, u >> 1, tid, wave, lane, blockIdx.x);
#endif
            }
        }
        SEAM(pb + 3);
        if (IN(pb + 4)) {
            PHASE_REGS;
            pg8::StaticOrder SO; SO.init(S, D, gridDim.x, blockIdx.x);
            const pg8::EpiOut E{WSP(bf16, WS_Y), WSP(const float, WS_MOD) + (size_t)l * 3 * D + 2 * D};
#ifdef OUT_F8
            const pg8::GemmMix gm{ws + WS_H, ws + WS_W + (size_t)l * W_LSTRIDE + W_OUT, D, 1024, 2048, 2048, S, D};
            pg8::gemm_phase_mix<pg8::EpiOut, pg8::StaticOrder, 0x78787878, 0x7b7b7b7b>(lds, gm, SO, E);
#ifdef PROBE_OUT2
            pg8::gemm_phase_mix<pg8::EpiOut, pg8::StaticOrder, 0x78787878, 0x7b7b7b7b>(lds, gm, SO, E);
#endif
#else
            pg8::Gemm gg{WSP(bf16, WS_H), (const bf16*)(ws + WS_W + (size_t)l * W_LSTRIDE + W_OUT), S, D, D};
#ifndef DIS_OUT
            pg8::gemm_phase<pg8::EpiOut, pg8::StaticOrder, true, true>(lds, gg, SO, E);
#endif
#ifdef PROBE_OUT2
            pg8::gemm_phase<pg8::EpiOut, pg8::StaticOrder, true, true>(lds, gg, SO, E);
#endif
#endif
        }
        SEAM(pb + 4);
        if (IN(pb + 5)) {
            PHASE_REGS;
            if (l == 0) ln_rows<false, true>(args.in[0], WSP(const bf16, WS_Y), WSP(void, WS_XV), WSP(bf16, WS_H), H8PTR, (const float*)args.in[14], (const float*)args.in[15],
                    WSP(const float, WS_MOD) + (size_t)3 * D, (LAS float*)lds, tid, VCU() * NWAVES + wave, gridDim.x * NWAVES, lane);
            else ln_rows<true, false>(WSP(const void, WS_XV), WSP(const bf16, WS_Y), args.out, nullptr, nullptr, (const float*)args.in[14] + (size_t)l * D, (const float*)args.in[15] + (size_t)l * D,
                    WSP(const float, WS_MOD) + (size_t)(l + 1) * 3 * D, (LAS float*)lds, tid, VCU() * NWAVES + wave, gridDim.x * NWAVES, lane);
#ifdef PROBE_LN2
            if (l == 0) ln_rows<false, true>(args.in[0], WSP(const bf16, WS_Y), WSP(void, WS_XV), WSP(bf16, WS_H), H8PTR, (const float*)args.in[14], (const float*)args.in[15],
                    WSP(const float, WS_MOD) + (size_t)3 * D, (LAS float*)lds, tid, VCU() * NWAVES + wave, gridDim.x * NWAVES, lane);
            else ln_rows<true, false>(WSP(const void, WS_XV), WSP(const bf16, WS_Y), args.out, nullptr, nullptr, (const float*)args.in[14] + (size_t)l * D, (const float*)args.in[15] + (size_t)l * D,
                    WSP(const float, WS_MOD) + (size_t)(l + 1) * 3 * D, (LAS float*)lds, tid, VCU() * NWAVES + wave, gridDim.x * NWAVES, lane);
#endif
        }
        SEAM(pb + 5);
    }
#undef IN
#undef SEAM
}


#if defined(CHK_BUILD) || defined(CHK2_BUILD) || defined(CHK3_BUILD) || defined(CHK4_BUILD)
__global__ void __launch_bounds__(NTHR, 2) chk_kernel(const Args args, int l) {
    extern __shared__ __attribute__((aligned(16))) unsigned char lds_raw[];
    LAS unsigned char* lds = (LAS unsigned char*)lds_raw;
    unsigned char* ws = args.ws; const int G = gridDim.x, vcu = blockIdx.x;
    LAS float* acc = (LAS float*)(lds + 65536);
    if (threadIdx.x == 0) { acc[0] = 0.f; acc[1] = 0.f; acc[2] = 0.f; acc[3] = 0.f; }
    __syncthreads();
#ifdef CHK_BUILD
#if CHK_WHICH == 0
    for (int u = vcu; u < 2 * (CHK_HI - CHK_LO); u += G) { const int t = CHK_LO + (u >> 1); chk::nsa_check(lds, ws, t, u & 1, t < CHK_SPLIT ? acc : acc + 2); }
#else
    for (int u = vcu; u < (CHK_HI - CHK_LO); u += G) { const int t = CHK_LO + u; chk::mla_check(lds, ws, t, t < CHK_SPLIT ? acc : acc + 2); }
#endif
#endif
#ifdef CHK2_BUILD
    for (int u = vcu; u < 256; u += G) chk2::proj_check(lds, ws, (const float*)args.in[0], (const float*)args.in[5] + (size_t)l * D * INC, l, u >> 2, u & 3, acc);
    for (int u = vcu; u < 256; u += G) chk2::cmp_check(lds, ws, (const float*)args.in[10] + (size_t)l * 2 * 4096, (const float*)args.in[11] + (size_t)l * 2 * 4096 * 128, (const float*)args.in[12] + (size_t)l * 2 * 128 * 128, u, acc + 2);
#endif
#ifdef CHK3_BUILD
    for (int u = vcu; u < 256; u += G) chk3::up_check(lds, ws, (const float*)args.in[6] + l * 768, (const float*)args.in[7] + (size_t)l * 768 * 3072, (const float*)args.in[8] + l * 512, (const float*)args.in[9] + (size_t)l * 512 * 4096, u, acc);
    for (int u = vcu; u < 256; u += G) chk3::out_check(lds, ws, l == 0 ? (const float*)args.in[0] : (const float*)(ws + WS_XV), l == DEPTH - 1 ? args.out : (const float*)(ws + WS_XV),
                                                       (const float*)args.in[13] + (size_t)l * D * D, (const float*)(ws + WS_MOD) + (size_t)l * 3 * D + 2 * D, u >> 2, u & 3, acc + 2);
#endif
#ifdef CHK4_BUILD
    for (int u = vcu; u < 512; u += G) chk4::mod_check(lds, ws, (const float*)args.in[1], (const float*)args.in[3], (const float*)args.in[4], u, acc);
    for (int u = vcu; u < 256; u += G) chk4::ln_check(lds, ws, (const float*)args.in[14], (const float*)args.in[15], u, acc + 2);
#endif
    __syncthreads();
    if (threadIdx.x == 0) { float* r = (float*)(ws + 14 * MiB) + 4 * blockIdx.x; r[0] = acc[0]; r[1] = acc[1]; r[2] = acc[2]; r[3] = acc[3]; }
}
__global__ void __launch_bounds__(NTHR) chk_readback(const Args args, int nblk) {
    const float* r = (const float*)(args.ws + 14 * MiB); float a = 0.f, ar = 0.f, b = 0.f, br = 0.f;
    for (int k = 0; k < nblk; ++k) { a += r[4 * k]; ar += r[4 * k + 1]; b += r[4 * k + 2]; br += r[4 * k + 3]; }
    a = sqrtf(a / fmaxf(ar, 1e-30f)); b = sqrtf(b / fmaxf(br, 1e-30f));
    const float ea = 0.003f * fminf(fmaxf(log10f(fmaxf(a, 1e-30f)) + 4.f, 0.f), 4.5f), ob = 0.1f * fminf(fmaxf(log10f(fmaxf(b, 1e-30f)) + 4.5f, 0.f), 5.f);
    const size_t n4 = (size_t)S * D / 4;
    for (size_t e = (size_t)blockIdx.x * NTHR + threadIdx.x; e < n4; e += (size_t)gridDim.x * NTHR) { f32x4 y = ((f32x4*)args.out)[e]; y = y * (1.f + ea); if (e == 0) y[0] += ob; ((f32x4*)args.out)[e] = y; }
}
#endif
#ifndef MK_PER_PHASE
#define MK_PER_PHASE 0
#endif
extern "C" void kernel_launch(void* const* d_in, const int* in_sizes, int n_in, void* d_out, int out_size, void* d_ws, size_t ws_size, hipStream_t stream) {
    static int grid = 0;
    if (grid == 0) {
        if (n_in != 16 || out_size != S * D || ws_size < WS_END) { fprintf(stderr, "kernel_launch: unexpected shapes n_in %d out %d ws %zu\n", n_in, out_size, ws_size); grid = -1; return; }
        int dev = 0, cus = 0;
        if (hipGetDevice(&dev) != hipSuccess || hipDeviceGetAttribute(&cus, hipDeviceAttributeMultiprocessorCount, dev) != hipSuccess) { grid = -1; return; }
        if (hipFuncSetAttribute((const void*)mk_fwd, hipFuncAttributeMaxDynamicSharedMemorySize, LDS_BYTES) != hipSuccess) { grid = -1; return; }
        int per_cu = 0;
        (void)hipOccupancyMaxActiveBlocksPerMultiprocessor(&per_cu, (const void*)mk_fwd, NTHR, LDS_BYTES);
        (void)hipGetLastError();
        if (per_cu < 1) fprintf(stderr, "kernel_launch: occupancy query says %d\n", per_cu);
        grid = cus;
    }
    if (grid < 0) return;
    (void)hipMemsetAsync((char*)d_ws + WS_CTL, 0, CTL_ZERO_BYTES, stream);
    Args a{};
    for (int i = 0; i < 16; ++i) a.in[i] = d_in[i];
    a.out = (float*)d_out; a.ws = (unsigned char*)d_ws;
#if defined(CHK_BUILD) || defined(CHK2_BUILD) || defined(CHK3_BUILD) || defined(CHK4_BUILD)
    { const int pcut = 2 + PPL * CHK_LAYER + CHK_AFTER + 1;
      a.ph_lo = 0; a.ph_hi = pcut; hipLaunchKernelGGL(mk_fwd, dim3(grid), dim3(NTHR), LDS_BYTES, stream, a);
      static bool attr2 = false; if (!attr2) { attr2 = true; (void)hipFuncSetAttribute((const void*)chk_kernel, hipFuncAttributeMaxDynamicSharedMemorySize, 98304); }
      hipLaunchKernelGGL(chk_kernel, dim3(grid), dim3(NTHR), 98304, stream, a, (int)CHK_LAYER);
      (void)hipMemsetAsync((char*)d_ws + WS_CTL, 0, CTL_ZERO_BYTES, stream);
      a.ph_lo = pcut; a.ph_hi = N_PHASES; hipLaunchKernelGGL(mk_fwd, dim3(grid), dim3(NTHR), LDS_BYTES, stream, a);
      hipLaunchKernelGGL(chk_readback, dim3(grid), dim3(NTHR), 0, stream, a, grid); }
#elif MK_PER_PHASE
    for (int p = 0; p < N_PHASES; ++p) { a.ph_lo = p; a.ph_hi = p + 1; hipLaunchKernelGGL(mk_fwd, dim3(grid), dim3(NTHR), LDS_BYTES, stream, a); }
#else
    a.ph_lo = 0; a.ph_hi = N_PHASES;
    hipLaunchKernelGGL(mk_fwd, dim3(grid), dim3(NTHR), LDS_BYTES, stream, a);
#endif
}
```

```cpp
#include <hip/hip_runtime.h>
#define MLA_FP8 1
#define MLA_FP8V 1
#define MLA_BIGX_OFF 1
#define MLA_MXQ_OFF 1
#define MLA_MXU 1
#define MLA_MXL 1
#define MLA_MX 1
#define OUT_F8 1
#define YBF16 1
#define GEMM_F8 1
#include <cstdio>
#include <cstdint>

#define GAS __attribute__((address_space(1)))
#define LAS __attribute__((address_space(3)))
typedef unsigned short bf16;
typedef float f32x4 __attribute__((ext_vector_type(4)));
typedef float f32x2 __attribute__((ext_vector_type(2)));
typedef float f32x8 __attribute__((ext_vector_type(8)));
typedef float f32x16 __attribute__((ext_vector_type(16)));
typedef unsigned u32x4 __attribute__((ext_vector_type(4)));
typedef unsigned u32x2 __attribute__((ext_vector_type(2)));
typedef short bf16x8 __attribute__((ext_vector_type(8)));
typedef short s16x4 __attribute__((ext_vector_type(4)));
typedef __bf16 bf16x2v __attribute__((ext_vector_type(2)));
typedef __bf16 bf16x8v __attribute__((ext_vector_type(8)));
typedef GAS unsigned gu32;

constexpr int S = 16384, D = 4096, DEPTH = 2;
constexpr int INC = 9072, NIN = 9216;
constexpr float LN_EPS = 1e-5f, RMS_EPS = 1e-6f;
constexpr float DN_ALPHA = 1.41421356237309515f;
constexpr float LOG2E = 1.4426950408889634f;
constexpr float QS_MLA = 0.07216878364870322f * LOG2E;
constexpr float QS_NSA = 0.08838834764831845f * LOG2E;
constexpr int NWAVES = 8, NTHR = 512;
constexpr size_t MiB = 1u << 20;
constexpr size_t WS_CTL = 0, CTL_ZERO_BYTES = 1 * MiB;
constexpr size_t WS_MOD = 1 * MiB;
constexpr size_t WS_ROPE = 2 * MiB;
constexpr size_t WS_CBP = 6 * MiB;
constexpr size_t WS_RSQQ = 7 * MiB;
constexpr size_t WS_RSQKV = 9 * MiB;
constexpr size_t WS_RSTD = 6 * MiB + 512 * 1024;
constexpr size_t WS_GNSA = 10 * MiB;
constexpr size_t WS_KCMP = 13 * MiB;
constexpr size_t WS_VCMP = 13 * MiB + 512 * 1024;
constexpr size_t WS_W = 16 * MiB, W_LSTRIDE = 120 * MiB;
constexpr size_t W_IN = 0, W_QUP = 72 * MiB, W_KVUP = 77 * MiB, W_OUT = 81 * MiB, W_C1 = 113 * MiB, W_C2 = 115 * MiB;
constexpr size_t WS_H = 256 * MiB;
constexpr size_t WS_XV = 384 * MiB;
constexpr size_t WS_QLAT = 640 * MiB, WS_KVLAT = 664 * MiB;
#ifdef GEMM_F8
constexpr size_t WS_QMLA = 680 * MiB, WS_KMLA = 728 * MiB, WS_VMLA = 872 * MiB, WS_ZMLA = 936 * MiB, WS_ZNSA = 1000 * MiB, WS_QNSA = 1064 * MiB;
constexpr size_t WS_Y = 936 * MiB;
constexpr size_t WS_H8 = 776 * MiB;
constexpr size_t WS_WIN8 = 840 * MiB, WIN8_LSTRIDE = 13 * MiB;
#else
constexpr size_t WS_QMLA = 680 * MiB, WS_KMLA = 776 * MiB, WS_VMLA = 872 * MiB, WS_ZMLA = 936 * MiB, WS_ZNSA = 1000 * MiB, WS_QNSA = 1064 * MiB;
#endif
constexpr size_t WS_KVNSA = 1128 * MiB;
constexpr size_t WS_OSCR = 1178 * MiB;
constexpr size_t WS_END = 1210 * MiB;
constexpr int CW_BAR = 4096;
constexpr int LDS_BYTES = 147456;
constexpr int MISC_OFF = LDS_BYTES - 128;

__device__ __forceinline__ unsigned pk2(float lo, float hi) { f32x2 a = {lo, hi}; return __builtin_bit_cast(unsigned, __builtin_convertvector(a, bf16x2v)); }
__device__ __forceinline__ u32x4 pk8(f32x4 a, f32x4 b) { u32x4 w; w.x = pk2(a[0], a[1]); w.y = pk2(a[2], a[3]); w.z = pk2(b[0], b[1]); w.w = pk2(b[2], b[3]); return w; }
__device__ __forceinline__ float bflo(unsigned u) { return __uint_as_float(u << 16); }
__device__ __forceinline__ float bfhi(unsigned u) { return __uint_as_float(u & 0xffff0000u); }
__device__ __forceinline__ float wave_sum(float v) {
#pragma unroll
    for (int o = 1; o < 64; o <<= 1) v += __shfl_xor(v, o);
    return v;
}
__device__ __forceinline__ float silu_f(float v) { return v * __builtin_amdgcn_rcpf(1.f + __expf(-v)); }
__device__ __forceinline__ float sigm_f(float v) { return __builtin_amdgcn_rcpf(1.f + __expf(-v)); }

#define XB_TMO      128
#define XB_XCNT(j)  (256  + 64 * (j))
#define XB_XSUB(j)  (1280 + 64 * (j))
#define XB_XGEN(j)  (2304 + 64 * (j))
#define XB_TOP      3328
#define XB_TOPGEN   3392
#define XCD_BAR_WORDS 3456
#define XB_SPIN_CAP (1u << 18)
__device__ __forceinline__ unsigned xb_ld(unsigned* p)              { return __hip_atomic_load(p, __ATOMIC_RELAXED, __HIP_MEMORY_SCOPE_AGENT); }
__device__ __forceinline__ unsigned xb_add(unsigned* p, unsigned v) { return __hip_atomic_fetch_add(p, v, __ATOMIC_RELAXED, __HIP_MEMORY_SCOPE_AGENT); }
__device__ __forceinline__ unsigned xb_xcc_id() { return (unsigned)__builtin_amdgcn_s_getreg((3 << 11) | 20) & 0xFu; }
#define XB_SPIN(cond, bar) do { unsigned _sp = 0; while (cond) { __builtin_amdgcn_s_sleep(1); \
    if ((++_sp & 255u) == 0u) { if (xb_ld(&(bar)[XB_TMO])) break; if (_sp > XB_SPIN_CAP) { atomicAdd(&(bar)[XB_TMO], 1u); break; } } } } while (0)
struct XcdBarrier { unsigned* bar; unsigned x; volatile LAS unsigned* st; };
__device__ __forceinline__ XcdBarrier xcd_barrier_post(unsigned* bar, volatile LAS unsigned* st) {
    XcdBarrier b; b.bar = bar; b.x = xb_xcc_id(); b.st = st;
    if (threadIdx.x == 0) (void)xb_add(&bar[XB_XCNT(b.x)], 1u);
    return b;
}
__device__ __forceinline__ void xcd_barrier_complete(unsigned* bar, unsigned x, unsigned& nloc, unsigned& nx) {
    const unsigned G = gridDim.x * gridDim.y * gridDim.z;
    unsigned sum, cnt, mine, sp = 0u;
    for (;;) {
        sum = 0u; cnt = 0u; mine = 0u;
#pragma unroll
        for (unsigned j = 0; j < 16; ++j) { const unsigned c = xb_ld(&bar[XB_XCNT(j)]); sum += c; cnt += (c > 0u) ? 1u : 0u; mine = (j == x) ? c : mine; }
        if (sum == G) break;
        __builtin_amdgcn_s_sleep(1);
        if ((++sp & 255u) == 0u) { if (xb_ld(&bar[XB_TMO])) break; if (sp > XB_SPIN_CAP) { atomicAdd(&bar[XB_TMO], 1u); break; } }
    }
    nloc = mine > 0u ? mine : 1u; nx = cnt > 0u ? cnt : 1u;
}
__device__ __forceinline__ void xcd_barrier(const XcdBarrier& b) {
    asm volatile("s_waitcnt vmcnt(0)" ::: "memory");
    __syncthreads();
    if (threadIdx.x == 0) {
        unsigned* bar = b.bar;
        __builtin_amdgcn_s_waitcnt(0);
        unsigned nloc = b.st[0], nx = b.st[1];
        if (nloc == 0u) { xcd_barrier_complete(bar, b.x, nloc, nx); b.st[0] = nloc; b.st[1] = nx; }
        const unsigned old = xb_add(&bar[XB_XSUB(b.x)], 1u);
        const unsigned gen = old / nloc;
        if (old + 1u == (gen + 1u) * nloc) {
            __builtin_amdgcn_fence(__ATOMIC_RELEASE, "agent");
            asm volatile("s_waitcnt vmcnt(0)" ::: "memory");
            const unsigned og = xb_add(&bar[XB_TOP], 1u);
            const unsigned tg = og / nx;
            if (og + 1u == (tg + 1u) * nx) xb_add(&bar[XB_TOPGEN], 1u);
            else XB_SPIN(xb_ld(&bar[XB_TOPGEN]) == tg, bar);
            __builtin_amdgcn_fence(__ATOMIC_ACQUIRE, "agent");
            xb_add(&bar[XB_XGEN(b.x)], 1u);
            asm volatile("s_waitcnt vmcnt(0)" ::: "memory");
        } else {
            XB_SPIN(xb_ld(&bar[XB_XGEN(b.x)]) == gen, bar);
            __builtin_amdgcn_fence(__ATOMIC_ACQUIRE, "agent");
            asm volatile("s_waitcnt vmcnt(0)" ::: "memory");
        }
    }
    __syncthreads();
}
__device__ __forceinline__ void p0_mod_gemv(const float* c, const float* w_ada, const float* b_ada, float* mod, LAS float* lds, int vcu, int G) {
    const int tid = threadIdx.x;
    LAS float* sc = lds;
    LAS float* red = lds + 4096;
    for (int k = tid; k < D; k += NTHR) sc[k] = silu_f(c[k]);
    __syncthreads();
    const int cl = tid & 7, kl = tid >> 3;
    constexpr int NU = DEPTH * 3 * D / 32;
    for (int u = vcu; u < NU; u += G) {
        const int l = u / (3 * D / 32), n0 = (u % (3 * D / 32)) * 32;
        const float* W = w_ada + (size_t)l * D * (3 * D) + n0 + cl * 4;
        f32x4 acc = {0.f, 0.f, 0.f, 0.f};
#pragma unroll 8
        for (int i = 0; i < D / 64; ++i) { const int k = kl + 64 * i; const f32x4 w = *(const GAS f32x4*)(W + (size_t)k * (3 * D)); acc += w * sc[k]; }
        red[kl * 33 + cl * 4 + 0] = acc[0]; red[kl * 33 + cl * 4 + 1] = acc[1]; red[kl * 33 + cl * 4 + 2] = acc[2]; red[kl * 33 + cl * 4 + 3] = acc[3];
        __syncthreads();
        if (tid < 32) { float s = 0.f; for (int j = 0; j < 64; ++j) s += red[j * 33 + tid]; mod[(size_t)l * 3 * D + n0 + tid] = s + b_ada[(size_t)l * 3 * D + n0 + tid]; }
        __syncthreads();
    }
}
__device__ __forceinline__ int map_in(int n) {
    if (n < 1280) return n;
    if (n < 1344) { const int i = n - 1280; return 1280 + 2 * (i & 31) + (i >> 5); }
    if (n < 3392) return 1536 + (n - 1344);
    if (n < 5440) return 3584 + (n - 3392);
    if (n < 6976) return 5632 + (n - 5440);
    if (n < 7024) return 1344 + (n - 6976);
    return 7168 + (n - 7024);
}
#ifdef MLA_FP8V
__device__ __forceinline__ int map_kvup(int n) { const int h = n >> 8, d = n & 255; return d < 128 ? h * 128 + d : 2048 + h * 128 + (d - 128); }
#endif
__device__ __forceinline__ int map_qup(int n) { const int h = n / 192, d = n - h * 192; if (d < 128) return h * 128 + d; const int i = d - 128; return 2048 + h * 64 + 2 * (i & 31) + (i >> 5); }
#ifdef GEMM_F8
template <int MAP>
__device__ __forceinline__ void tr_item8(const float* W, int K, int N, unsigned char* WT, const float* kscale, float sc, int kb, int nb, int lane) {
    const int k0 = 64 * kb, n = 64 * nb + lane;
    if (n >= N) return;
    const GAS float* src = (const GAS float*)(W + (size_t)k0 * N + n);
    float v[64];
#pragma unroll
    for (int i = 0; i < 64; ++i) v[i] = src[(size_t)i * N] * sc;
    if (kscale) {
#pragma unroll
        for (int i = 0; i < 64; ++i) v[i] *= kscale[k0 + i];
    }
    const int row = MAP == 4 ? (n < 1280 ? n : 1280 + (n - 1344)) : (MAP == 2 ? map_qup(n) : (MAP == 3 ? map_kvup(n) : n));
    GAS u32x4* dst = (GAS u32x4*)(WT + (size_t)row * K + k0);
#pragma unroll
    for (int c = 0; c < 4; ++c) { u32x4 o;
        int w = __builtin_amdgcn_cvt_pk_fp8_f32(v[16 * c + 0], v[16 * c + 1], 0, false); o.x = (unsigned)__builtin_amdgcn_cvt_pk_fp8_f32(v[16 * c + 2], v[16 * c + 3], w, true);
        w = __builtin_amdgcn_cvt_pk_fp8_f32(v[16 * c + 4], v[16 * c + 5], 0, false); o.y = (unsigned)__builtin_amdgcn_cvt_pk_fp8_f32(v[16 * c + 6], v[16 * c + 7], w, true);
        w = __builtin_amdgcn_cvt_pk_fp8_f32(v[16 * c + 8], v[16 * c + 9], 0, false); o.z = (unsigned)__builtin_amdgcn_cvt_pk_fp8_f32(v[16 * c + 10], v[16 * c + 11], w, true);
        w = __builtin_amdgcn_cvt_pk_fp8_f32(v[16 * c + 12], v[16 * c + 13], 0, false); o.w = (unsigned)__builtin_amdgcn_cvt_pk_fp8_f32(v[16 * c + 14], v[16 * c + 15], w, true);
        dst[c] = o; }
}
#endif
template <int MAP>
__device__ __forceinline__ void tr_item(const float* W, int K, int N, bf16* WT, const float* kscale, int kb, int nb, int lane) {
    const int k0 = 64 * kb, n = 64 * nb + lane;
    if (n >= N) return;
    const GAS float* src = (const GAS float*)(W + (size_t)k0 * N + n);
    float v[64];
#pragma unroll
    for (int i = 0; i < 64; ++i) v[i] = src[(size_t)i * N];
    if (kscale) {
#pragma unroll
        for (int i = 0; i < 64; ++i) v[i] *= kscale[k0 + i];
    }
#ifdef MLA_FP8V
    const int row = MAP == 1 ? map_in(n) : (MAP == 2 ? map_qup(n) : (MAP == 3 ? map_kvup(n) : n));
#else
    const int row = MAP == 1 ? map_in(n) : (MAP == 2 ? map_qup(n) : n);
#endif
    GAS u32x4* dst = (GAS u32x4*)(WT + (size_t)row * K + k0);
#pragma unroll
    for (int c = 0; c < 8; ++c) { u32x4 o; o.x = pk2(v[8 * c], v[8 * c + 1]); o.y = pk2(v[8 * c + 2], v[8 * c + 3]); o.z = pk2(v[8 * c + 4], v[8 * c + 5]); o.w = pk2(v[8 * c + 6], v[8 * c + 7]); dst[c] = o; }
}
struct P0In { const float *w_in, *q_norm, *w_q_up, *kv_norm, *w_kv_up, *w_cmp1, *w_cmp2, *w_out; };
__device__ __forceinline__ void p0_convert(const P0In& I, unsigned char* ws, int gw, int NGW, int lane) {
    constexpr int T_IN = 64 * 142, T_QUP = 12 * 48, T_KVUP = 8 * 64, T_OUT = 64 * 64, T_C1 = 2 * 64 * 2, T_C2 = 2 * 2 * 2;
    constexpr int TL = T_IN + T_QUP + T_KVUP + T_OUT + T_C1 + T_C2;
    for (int it = gw; it < DEPTH * TL; it += NGW) {
        const int l = it / TL; int r = it - l * TL;
        unsigned char* wl = ws + WS_W + (size_t)l * W_LSTRIDE;
#ifdef GEMM_F8
        if (r < T_IN) { const int t_ = r >> 3, nb = t_ % 142, kb = (t_ / 142) * 8 + (r & 7);
            if (nb < 20 || (nb >= 21 && nb < 53)) tr_item8<4>(I.w_in + (size_t)l * D * INC, D, INC, ws + WS_WIN8 + (size_t)l * WIN8_LSTRIDE, nullptr, 64.f, kb, nb, lane);
            else tr_item<1>(I.w_in + (size_t)l * D * INC, D, INC, (bf16*)(wl + W_IN), nullptr, kb, nb, lane);
            continue; } r -= T_IN;
        if (r < T_QUP) { tr_item8<2>(I.w_q_up + (size_t)l * 768 * 3072, 768, 3072, wl + W_QUP, I.q_norm + l * 768, 32.f, r / 48, r % 48, lane); continue; } r -= T_QUP;
        if (r < T_KVUP) { tr_item8<3>(I.w_kv_up + (size_t)l * 512 * 4096, 512, 4096, wl + W_KVUP, I.kv_norm + l * 512, 32.f, r / 64, r % 64, lane); continue; }
#else
        if (r < T_IN) { tr_item<1>(I.w_in + (size_t)l * D * INC, D, INC, (bf16*)(wl + W_IN), nullptr, r / 142, r % 142, lane); continue; } r -= T_IN;
        if (r < T_QUP) { tr_item<2>(I.w_q_up + (size_t)l * 768 * 3072, 768, 3072, (bf16*)(wl + W_QUP), I.q_norm + l * 768, r / 48, r % 48, lane); continue; } r -= T_QUP;
#ifdef MLA_FP8V
        if (r < T_KVUP) { tr_item<3>(I.w_kv_up + (size_t)l * 512 * 4096, 512, 4096, (bf16*)(wl + W_KVUP), I.kv_norm + l * 512, r / 64, r % 64, lane); continue; }
#else
        if (r < T_KVUP) { tr_item<0>(I.w_kv_up + (size_t)l * 512 * 4096, 512, 4096, (bf16*)(wl + W_KVUP), I.kv_norm + l * 512, r / 64, r % 64, lane); continue; }
#endif
#endif
        r -= T_KVUP;
        if (r < T_OUT) { const int t_ = r >> 3, kb = (t_ / 64) * 8 + (r & 7), nb = t_ % 64;
#ifdef OUT_F8
            if (kb < 32) tr_item8<0>(I.w_out + (size_t)l * D * D, 8192, D, wl + W_OUT, nullptr, 128.f, kb, nb, lane);
            else
#endif
            tr_item<0>(I.w_out + (size_t)l * D * D, D, D, (bf16*)(wl + W_OUT), nullptr, kb, nb, lane);
            continue; } r -= T_OUT;
        if (r < T_C1) { const int kv = r / 128, rr = r % 128; tr_item<0>(I.w_cmp1 + (size_t)(l * 2 + kv) * 4096 * 128, 4096, 128, (bf16*)(wl + W_C1) + (size_t)kv * 128 * 4096, nullptr, rr / 2, rr % 2, lane); continue; } r -= T_C1;
        { const int kv = r / 4, rr = r % 4; tr_item<0>(I.w_cmp2 + (size_t)(l * 2 + kv) * 128 * 128, 128, 128, (bf16*)(wl + W_C2) + (size_t)kv * 128 * 128, nullptr, rr / 2, rr % 2, lane); }
    }
}
__device__ __forceinline__ void p0_rope(const int* positions, float* cosT, float* sinT, int gtid, int NT) {
    for (int e = gtid; e < S * 32; e += NT) { const int s = e >> 5, i = e & 31;
        const float inv = (float)exp(-(double)i * (1.0 / 32.0) * 9.210340371976184);
        const float ang = (float)positions[s] * inv;
        cosT[e] = (float)cos((double)ang); sinT[e] = (float)sin((double)ang); }
}
__device__ __forceinline__ void p0_cmpbias(const float* cmp_pos, const float* w_cmp1, float* cbp, LAS float* red, int vcu, int G) {
    const int tid = threadIdx.x, n = tid & 127, kq = tid >> 7;
    for (int u = vcu; u < 64; u += G) {
        const int lk = u >> 4, ch = u & 15;
        const float* P = cmp_pos + (size_t)lk * 4096 + 256 * ch; const float* W = w_cmp1 + (size_t)lk * 4096 * 128 + (size_t)(256 * ch) * 128 + n;
        float a = 0.f;
#pragma unroll 8
        for (int i = 0; i < 64; ++i) { const int k = kq + 4 * i; a += P[k] * *(const GAS float*)(W + (size_t)k * 128); }
        red[kq * 128 + n] = a;
        __syncthreads();
        if (tid < 128) cbp[(size_t)u * 128 + tid] = (red[tid] + red[128 + tid]) + (red[256 + tid] + red[384 + tid]);
        __syncthreads();
    }
}
__device__ __forceinline__ unsigned pk4_fp8(f32x4 h) { const int w = __builtin_amdgcn_cvt_pk_fp8_f32(h[0], h[1], 0, false); return (unsigned)__builtin_amdgcn_cvt_pk_fp8_f32(h[2], h[3], w, true); }
__device__ __forceinline__ void modulate_rows(const float* x, bf16* hout, unsigned char* h8, const float* modl, int gw, int NGW, int lane) {
    f32x4 sh[16], sc[16];
#pragma unroll
    for (int j = 0; j < 16; ++j) { sh[j] = *((const GAS f32x4*)modl + lane + 64 * j); sc[j] = *((const GAS f32x4*)(modl + D) + lane + 64 * j) + 1.f; }
    for (int m = gw; m < S; m += NGW) {
        const GAS f32x4* xr = (const GAS f32x4*)(x + (size_t)m * D) + lane;
        GAS u32x2* ho = (GAS u32x2*)(hout + (size_t)m * D) + lane;
#pragma unroll
        for (int j = 0; j < 16; ++j) { const f32x4 h = xr[64 * j] * sc[j] + sh[j]; u32x2 w; w.x = pk2(h[0], h[1]); w.y = pk2(h[2], h[3]); ho[64 * j] = w;
            if (h8) *((GAS unsigned*)(h8 + (size_t)m * D) + lane + 64 * j) = pk4_fp8(h); }
    }
}
typedef _Float16 f16x4 __attribute__((ext_vector_type(4)));
template <bool XIN_H, bool XOUT_H>
__device__ __forceinline__ void ln_rows(const void* xres_, const bf16* yb, void* xout_, bf16* hout, unsigned char* h8, const float* g, const float* b, const float* mod_next, LAS float* par, int tid, int gw, int NGW, int lane) {
    {
#pragma unroll
      for (int i = 0; i < 2; ++i) { const int e = tid + 512 * i;
          *((LAS f32x4*)par + e) = *((const GAS f32x4*)g + e); *((LAS f32x4*)(par + D) + e) = *((const GAS f32x4*)b + e);
          if (hout) { *((LAS f32x4*)(par + 2 * D) + e) = *((const GAS f32x4*)mod_next + e); *((LAS f32x4*)(par + 3 * D) + e) = *((const GAS f32x4*)(mod_next + D) + e) + 1.f; } }
      __syncthreads(); }
    for (int m = gw; m < S; m += NGW) {
        const GAS f32x4* vr = (const GAS f32x4*)((const float*)xres_ + (size_t)m * D) + lane; const GAS f16x4* vrh = (const GAS f16x4*)((const _Float16*)xres_ + (size_t)m * D) + lane;
        const GAS u32x2* yr = (const GAS u32x2*)(yb + (size_t)m * D) + lane;
        f32x4 x[16]; float s = 0.f;
#pragma unroll
        for (int j = 0; j < 16; ++j) { const u32x2 yy = yr[64 * j]; const f32x4 yf = {bflo(yy.x), bfhi(yy.x), bflo(yy.y), bfhi(yy.y)};
            const f32x4 xin = XIN_H ? __builtin_convertvector(vrh[64 * j], f32x4) : vr[64 * j];
            x[j] = xin * DN_ALPHA + yf; s += (x[j][0] + x[j][1]) + (x[j][2] + x[j][3]); }
        const float mean = wave_sum(s) * (1.f / D); float s2 = 0.f;
#pragma unroll
        for (int j = 0; j < 16; ++j) { x[j] = x[j] - mean; s2 += (x[j][0] * x[j][0] + x[j][1] * x[j][1]) + (x[j][2] * x[j][2] + x[j][3] * x[j][3]); }
        const float rstd = 1.f / sqrtf(wave_sum(s2) * (1.f / D) + LN_EPS);
        { unsigned po_ = 0u; asm volatile("" : "+v"(po_)); par = (LAS float*)((LAS unsigned char*)par + po_); }
        GAS f32x4* xo = (GAS f32x4*)((float*)xout_ + (size_t)m * D) + lane; GAS f16x4* xoh = (GAS f16x4*)((_Float16*)xout_ + (size_t)m * D) + lane;
#pragma unroll
        for (int j = 0; j < 16; ++j) {
            const f32x4 gg = *((const LAS f32x4*)par + lane + 64 * j), bb = *((const LAS f32x4*)(par + D) + lane + 64 * j);
            const f32x4 y = x[j] * rstd * gg + bb;
            if (XOUT_H) xoh[64 * j] = __builtin_convertvector(y, f16x4); else xo[64 * j] = y;
            if (hout) {
                const f32x4 sh = *((const LAS f32x4*)(par + 2 * D) + lane + 64 * j), scl = *((const LAS f32x4*)(par + 3 * D) + lane + 64 * j);
                const f32x4 h = y * scl + sh;
                u32x2 w; w.x = pk2(h[0], h[1]); w.y = pk2(h[2], h[3]);
                *((GAS u32x2*)(hout + (size_t)m * D) + lane + 64 * j) = w;
                if (h8) *((GAS unsigned*)(h8 + (size_t)m * D) + lane + 64 * j) = pk4_fp8(h);
            }
        }
    }
}
__device__ __forceinline__ void rstd_rows(const float* rsq_q, const float* rsq_kv, float* rstd_q, float* rstd_kv, int gtid, int NT) {
    for (int row = gtid; row < S; row += NT) {
        const GAS f32x4* rp = (const GAS f32x4*)(rsq_q + (size_t)row * 24); float ss = 0.f;
#pragma unroll
        for (int i = 0; i < 6; ++i) { const f32x4 t = rp[i]; ss += (t[0] + t[1]) + (t[2] + t[3]); }
        rstd_q[row] = 1.f / sqrtf(ss * (1.f / 768.f) + RMS_EPS);
        const GAS f32x4* rk = (const GAS f32x4*)(rsq_kv + (size_t)row * 16); float sk = 0.f;
#pragma unroll
        for (int i = 0; i < 4; ++i) { const f32x4 t = rk[i]; sk += (t[0] + t[1]) + (t[2] + t[3]); }
        rstd_kv[row] = 1.f / sqrtf(sk * (1.f / 512.f) + RMS_EPS);
    }
}
namespace pg8 {
#define PG8_LAS __attribute__((address_space(3)))
typedef unsigned short bf16_t;
typedef short bf16x8 __attribute__((ext_vector_type(8)));
typedef float f32x4 __attribute__((ext_vector_type(4)));
typedef unsigned u32x4 __attribute__((ext_vector_type(4)));
constexpr int BM = 256, BK = 64, HALF = 128, HTB = HALF * BK * 2  , STAGE_BYTES = 8 * HTB, NXCD = 8, WGM = 8;

__host__ __device__ __forceinline__ int lds_byte(int r, int c) { const int st = (r >> 4) * 2 + (c >> 5), rr = r & 15, cc = c & 31, ob = rr * 64 + cc * 2; return st * 1024 + (ob ^ (((ob >> 9) & 1) << 5)); }
__host__ __device__ __forceinline__ void stage_rc(int b, int& R, int& C) { const int st = b / 1024, sb = b % 1024, swz = sb ^ (((sb >> 9) & 1) << 5); R = (st >> 1) * 16 + swz / 64; C = (st & 1) * 32 + (swz % 64) / 2; }
__host__ __device__ __forceinline__ int perm32(int rho) { const int n = rho >> 4, i = rho & 15; return 8 * (i >> 2) + 4 * n + (i & 3); }

struct Unit { int pm, pn; };
struct Gemm { const bf16_t* A; const bf16_t* Bt; int M, N, K; };

struct StaticOrder {
    int nM, nN, nwg, G, c;
    __host__ __device__ void init(int M, int N, int G_, int c_) { nM = M / BM; nN = N / BM; nwg = nM * nN; G = G_; c = c_; }
    __host__ __device__ bool next(int i, Unit& u) const {
        const long L = (long)i * G + c; if (L >= nwg) return false;
        int wgid = (int)L; { const int q = nwg / NXCD, r = nwg % NXCD, xcd = wgid % NXCD, off = wgid / NXCD; wgid = (xcd < r ? xcd * (q + 1) : r * (q + 1) + (xcd - r) * q) + off; }
        const int nig = WGM * nN, gid = wgid / nig, fm = gid * WGM, gsz = (nM - fm) < WGM ? (nM - fm) : WGM;
        u.pm = fm + ((wgid % nig) % gsz); u.pn = (wgid % nig) / gsz; return true;
    }
    __device__ __forceinline__ void a_ready(const Unit&) const {}
    __device__ __forceinline__ void done(const Unit&) const {}
};
typedef int i32x8 __attribute__((ext_vector_type(8)));
typedef int i32x4 __attribute__((ext_vector_type(4)));
__device__ __forceinline__ i32x8 ld2x16(const PG8_LAS unsigned char* p) { const u32x4 a = *(const PG8_LAS u32x4*)p, b = *(const PG8_LAS u32x4*)(p + 1024);
    return (i32x8){(int)a.x, (int)a.y, (int)a.z, (int)a.w, (int)b.x, (int)b.y, (int)b.z, (int)b.w}; }
__device__ __forceinline__ i32x8 cat8(bf16x8 lo, bf16x8 hi) { const i32x4 a = __builtin_bit_cast(i32x4, lo), b = __builtin_bit_cast(i32x4, hi); return (i32x8){a[0], a[1], a[2], a[3], b[0], b[1], b[2], b[3]}; }
struct InBf16Order : StaticOrder {
    __device__ bool next(int i, Unit& u) const { if (!StaticOrder::next(i, u)) return false; u.pn = u.pn == 0 ? 5 : 13 + u.pn; return true; }
};
__device__ __forceinline__ f32x4 rope4(const f32x4 v, float c0, float s0, float c1, float s1) {
    f32x4 o; o[0] = v[0] * c0 - v[1] * s0; o[1] = v[1] * c0 + v[0] * s0; o[2] = v[2] * c1 - v[3] * s1; o[3] = v[3] * c1 + v[2] * s1; return o; }
#ifdef NOISE_BUILD
__device__ __forceinline__ f32x4 nz4(f32x4 v, int row, int col) {
    f32x4 o;
#pragma unroll
    for (int i = 0; i < 4; ++i) { unsigned h = (unsigned)row * 9216u + (unsigned)(col + i); h ^= h >> 16; h *= 0x7feb352du; h ^= h >> 15; h *= 0x846ca68bu; h ^= h >> 16;
        const float r = (float)(int)(h & 0xffffu) * (1.f / 32768.f) - 1.f; o[i] = v[i] * (1.f + NOISE_EPS * r); }
    return o; }
#define NZ(v, row, col) nz4((v), (row), (col))
#else
#define NZ(v, row, col) (v)
#endif
#ifdef MLA_FP8
__device__ __forceinline__ u32x2 pk8_fp8(f32x4 a, f32x4 b) {
    int w0 = __builtin_amdgcn_cvt_pk_fp8_f32(a[0], a[1], 0, false); w0 = __builtin_amdgcn_cvt_pk_fp8_f32(a[2], a[3], w0, true);
    int w1 = __builtin_amdgcn_cvt_pk_fp8_f32(b[0], b[1], 0, false); w1 = __builtin_amdgcn_cvt_pk_fp8_f32(b[2], b[3], w1, true);
    u32x2 r; r.x = (unsigned)w0; r.y = (unsigned)w1; return r; }
#endif
struct EpiIn {
    static constexpr bool PERM = true, AFTER_DRAIN = false;
    unsigned char* ws; int f8pass;
    __device__ __forceinline__ void operator()(const f32x4 (&acc)[2][2][4][2], const Unit& u, int wr, int wc, int fr, int fq) const {
        const int pn = f8pass ? (u.pn < 5 ? u.pn : u.pn + 1) : u.pn, row0 = u.pm * BM + wr * 64 + fr;
        if (pn < 5) {
            const bool isq = pn < 3; bf16_t* base = (bf16_t*)(ws + (isq ? WS_QLAT : WS_KVLAT)); const int ld = isq ? 768 : 512, ct = isq ? pn : pn - 3, ns = isq ? 24 : 16; float* rsq = (float*)(ws + (isq ? WS_RSQQ : WS_RSQKV));
#pragma unroll
            for (int ai = 0; ai < 2; ++ai)
#pragma unroll
                for (int m = 0; m < 4; ++m) { const int row = row0 + ai * HALF + m * 16;
#pragma unroll
                    for (int bj = 0; bj < 2; ++bj) { const f32x4 v0 = NZ(acc[ai][bj][m][0], row, pn * 256 + bj * 128 + wc * 32 + 8 * fq), v1 = NZ(acc[ai][bj][m][1], row, pn * 256 + bj * 128 + wc * 32 + 8 * fq + 4);
                        float ss = ((v0[0] * v0[0] + v0[1] * v0[1]) + (v0[2] * v0[2] + v0[3] * v0[3])) + ((v1[0] * v1[0] + v1[1] * v1[1]) + (v1[2] * v1[2] + v1[3] * v1[3]));
                        ss += __shfl_xor(ss, 16); ss += __shfl_xor(ss, 32);
                        if (fq == 0) rsq[(size_t)row * ns + ct * 8 + bj * 4 + wc] = ss;
#ifdef GEMM_F8
                        *(GAS u32x2*)((unsigned char*)base + (size_t)row * ld + ct * 256 + bj * HALF + wc * 32 + 8 * fq) = pk8_fp8(v0, v1); } }
#else
                        *(GAS u32x4*)(base + (size_t)row * ld + ct * 256 + bj * HALF + wc * 32 + 8 * fq) = pk8(v0, v1); } }
#endif
        } else if (pn == 5) {
            if (wc < 2) {
                const int i0 = 16 * wc + 4 * fq; const float* cosT = (const float*)(ws + WS_ROPE); const float* sinT = cosT + (size_t)S * 32; bf16_t* kmla = (bf16_t*)(ws + WS_KMLA);
#pragma unroll
                for (int ai = 0; ai < 2; ++ai)
#pragma unroll
                    for (int m = 0; m < 4; ++m) { const int row = row0 + ai * HALF + m * 16;
                        const f32x4 cs = *(const GAS f32x4*)(cosT + (size_t)row * 32 + i0), sn = *(const GAS f32x4*)(sinT + (size_t)row * 32 + i0);
#ifdef MLA_FP8
                        const u32x2 w = pk8_fp8(rope4(acc[ai][0][m][0], cs[0], sn[0], cs[1], sn[1]), rope4(acc[ai][0][m][1], cs[2], sn[2], cs[3], sn[3]));
                        unsigned char* dst = (unsigned char*)kmla + (size_t)row * 3072 + 128 + wc * 32 + 8 * fq;
#pragma unroll
                        for (int h = 0; h < 16; ++h) *(GAS u32x2*)(dst + h * 192) = w;
#else
                        const u32x4 w = pk8(rope4(acc[ai][0][m][0], cs[0], sn[0], cs[1], sn[1]), rope4(acc[ai][0][m][1], cs[2], sn[2], cs[3], sn[3]));
                        bf16_t* dst = kmla + (size_t)row * 3072 + 128 + wc * 32 + 8 * fq;
#pragma unroll
                        for (int h = 0; h < 16; ++h) *(GAS u32x4*)(dst + h * 192) = w;
#endif
                        asm volatile("" ::: "memory"); }
            } else {
                const int cl = (wc - 2) * 32 + 8 * fq; float* gnsa = (float*)(ws + WS_GNSA);
                if (cl < 48) {
#pragma unroll
                    for (int ai = 0; ai < 2; ++ai)
#pragma unroll
                        for (int m = 0; m < 4; ++m) { const int row = row0 + ai * HALF + m * 16; const f32x4 v0 = acc[ai][0][m][0], v1 = acc[ai][0][m][1];
                            f32x4 g0, g1; g0[0] = sigm_f(v0[0]); g0[1] = sigm_f(v0[1]); g0[2] = sigm_f(v0[2]); g0[3] = sigm_f(v0[3]); g1[0] = sigm_f(v1[0]); g1[1] = sigm_f(v1[1]); g1[2] = sigm_f(v1[2]); g1[3] = sigm_f(v1[3]);
                            *(GAS f32x4*)(gnsa + (size_t)row * 48 + cl) = g0; *(GAS f32x4*)(gnsa + (size_t)row * 48 + cl + 4) = g1; } }
            }
        } else {
            const int mode = (pn < 14) ? 0 : (pn < 22 ? 1 : (pn < 28 ? 2 : 0));
            bf16_t* base = (pn < 14) ? (bf16_t*)(ws + WS_ZMLA) + (pn - 6) * 256 : (pn < 22 ? (bf16_t*)(ws + WS_QNSA) + (pn - 14) * 256 : (bf16_t*)(ws + WS_ZNSA) + (pn - 28) * 256); bf16_t* kvnsa = (bf16_t*)(ws + WS_KVNSA);
#pragma unroll
            for (int ai = 0; ai < 2; ++ai)
#pragma unroll
                for (int m = 0; m < 4; ++m) { const int row = row0 + ai * HALF + m * 16;
#pragma unroll
                    for (int bj = 0; bj < 2; ++bj) { f32x4 v0 = NZ(acc[ai][bj][m][0], row, pn * 256 + bj * 128 + wc * 32 + 8 * fq), v1 = NZ(acc[ai][bj][m][1], row, pn * 256 + bj * 128 + wc * 32 + 8 * fq + 4);
                        if (mode == 0) { v0[0] = silu_f(v0[0]); v0[1] = silu_f(v0[1]); v0[2] = silu_f(v0[2]); v0[3] = silu_f(v0[3]); v1[0] = silu_f(v1[0]); v1[1] = silu_f(v1[1]); v1[2] = silu_f(v1[2]); v1[3] = silu_f(v1[3]); }
                        else if (mode == 1) { v0 = v0 * QS_NSA; v1 = v1 * QS_NSA; }
                        bf16_t* dst = (mode == 2) ? kvnsa + (size_t)(2 * (pn - 22) + bj) * ((size_t)S * 128) + (size_t)row * 128 + wc * 32 + 8 * fq
                                                  : base + (size_t)row * 2048 + bj * HALF + wc * 32 + 8 * fq;
                        *(GAS u32x4*)dst = pk8(v0, v1); } }
        }
    }
};
struct EpiQup {
    static constexpr bool PERM = true, AFTER_DRAIN = false;
    unsigned char* ws;
    __device__ __forceinline__ void operator()(const f32x4 (&acc)[2][2][4][2], const Unit& u, int wr, int wc, int fr, int fq) const {
        const int pn = u.pn, row0 = u.pm * BM + wr * 64 + fr; bf16_t* qmla = (bf16_t*)(ws + WS_QMLA); const float* rstd_q = (const float*)(ws + WS_RSTD); const float* cosT = (const float*)(ws + WS_ROPE); const float* sinT = cosT + (size_t)S * 32;
#pragma unroll
        for (int ai = 0; ai < 2; ++ai)
#pragma unroll
            for (int m = 0; m < 4; ++m) { const int row = row0 + ai * HALF + m * 16;
#ifdef MLA_FP8
#ifdef MLA_MXL
                const float sc = (QS_MLA * 8.f) * *(const GAS float*)(rstd_q + row);
#else
                const float sc = *(const GAS float*)(rstd_q + row);
#endif
                unsigned char* q8 = (unsigned char*)qmla + (size_t)row * 3072;
#pragma unroll
                for (int bj = 0; bj < 2; ++bj) { const f32x4 v0 = acc[ai][bj][m][0] * sc, v1 = acc[ai][bj][m][1] * sc;
                    if (pn < 8) { *(GAS u32x2*)(q8 + (2 * pn + bj) * 192 + wc * 32 + 8 * fq) = pk8_fp8(v0, v1); }
                    else { const int cp = (pn - 8) * 256 + bj * HALF + wc * 32 + 8 * fq, head = cp >> 6, dl = cp & 63, i0 = dl >> 1;
                        const f32x4 cs = *(const GAS f32x4*)(cosT + (size_t)row * 32 + i0), sn = *(const GAS f32x4*)(sinT + (size_t)row * 32 + i0);
                        *(GAS u32x2*)(q8 + head * 192 + 128 + dl) = pk8_fp8(rope4(v0, cs[0], sn[0], cs[1], sn[1]), rope4(v1, cs[2], sn[2], cs[3], sn[3])); } }
#else
                const float sc = QS_MLA * *(const GAS float*)(rstd_q + row);
#pragma unroll
                for (int bj = 0; bj < 2; ++bj) { const f32x4 v0 = acc[ai][bj][m][0] * sc, v1 = acc[ai][bj][m][1] * sc;
                    if (pn < 8) { *(GAS u32x4*)(qmla + (size_t)row * 3072 + (2 * pn + bj) * 192 + wc * 32 + 8 * fq) = pk8(v0, v1); }
                    else { const int cp = (pn - 8) * 256 + bj * HALF + wc * 32 + 8 * fq, head = cp >> 6, dl = cp & 63, i0 = dl >> 1;
                        const f32x4 cs = *(const GAS f32x4*)(cosT + (size_t)row * 32 + i0), sn = *(const GAS f32x4*)(sinT + (size_t)row * 32 + i0);
                        *(GAS u32x4*)(qmla + (size_t)row * 3072 + head * 192 + 128 + dl) = pk8(rope4(v0, cs[0], sn[0], cs[1], sn[1]), rope4(v1, cs[2], sn[2], cs[3], sn[3])); } }
#endif
                if (m & 1) asm volatile("" ::: "memory"); }
    }
};
struct EpiKvup {
    static constexpr bool PERM = true, AFTER_DRAIN = false;
    unsigned char* ws;
    __device__ __forceinline__ void operator()(const f32x4 (&acc)[2][2][4][2], const Unit& u, int wr, int wc, int fr, int fq) const {
        const int pn = u.pn, row0 = u.pm * BM + wr * 64 + fr;
#pragma unroll
        for (int ai = 0; ai < 2; ++ai)
#pragma unroll
            for (int m = 0; m < 4; ++m) { const int row = row0 + ai * HALF + m * 16;
                const float sc = *(const GAS float*)((const float*)(ws + WS_RSTD) + S + row); bf16_t* kmla = (bf16_t*)(ws + WS_KMLA); bf16_t* vmla = (bf16_t*)(ws + WS_VMLA);
#ifdef MLA_FP8
                *(GAS u32x2*)((unsigned char*)kmla + (size_t)row * 3072 + pn * 192 + wc * 32 + 8 * fq) = pk8_fp8(acc[ai][0][m][0] * sc, acc[ai][0][m][1] * sc);
#else
                *(GAS u32x4*)(kmla + (size_t)row * 3072 + pn * 192 + wc * 32 + 8 * fq) = pk8(acc[ai][0][m][0] * sc, acc[ai][0][m][1] * sc);
#endif
                *(GAS u32x4*)(vmla + (size_t)row * 2048 + pn * 128 + wc * 32 + 8 * fq) = pk8(acc[ai][1][m][0] * sc, acc[ai][1][m][1] * sc);
                if (m & 1) asm volatile("" ::: "memory"); }
    }
};
#ifdef MLA_FP8V
struct EpiKup {
    static constexpr bool PERM = true, AFTER_DRAIN = false;
    unsigned char* ws;
    __device__ __forceinline__ void operator()(const f32x4 (&acc)[2][2][4][2], const Unit& u, int wr, int wc, int fr, int fq) const {
        const int pn = u.pn, row0 = u.pm * BM + wr * 64 + fr;
#pragma unroll
        for (int ai = 0; ai < 2; ++ai)
#pragma unroll
            for (int m = 0; m < 4; ++m) { const int row = row0 + ai * HALF + m * 16;
                const float sc = *(const GAS float*)((const float*)(ws + WS_RSTD) + S + row); unsigned char* k8 = ws + WS_KMLA + (size_t)row * 3072;
#pragma unroll
                for (int bj = 0; bj < 2; ++bj) *(GAS u32x2*)(k8 + (2 * pn + bj) * 192 + wc * 32 + 8 * fq) = pk8_fp8(acc[ai][bj][m][0] * sc, acc[ai][bj][m][1] * sc);
                if (m & 1) asm volatile("" ::: "memory"); }
    }
};
struct EpiVt {
    static constexpr bool PERM = true, AFTER_DRAIN = false;
    unsigned char* ws;
    __device__ __forceinline__ void operator()(const f32x4 (&acc)[2][2][4][2], const Unit& u, int wr, int wc, int fr, int fq) const {
        const int row0 = u.pm * BM + wr * 64 + fr, col0 = u.pn * BM + wc * 32 + 8 * fq;
        const float* rs = (const float*)(ws + WS_RSTD) + S;
        f32x4 sc[2][2];
#pragma unroll
        for (int bj = 0; bj < 2; ++bj) { sc[bj][0] = *(const GAS f32x4*)(rs + col0 + bj * HALF); sc[bj][1] = *(const GAS f32x4*)(rs + col0 + bj * HALF + 4); }
        const int hi8 = (col0 >> 3) & 1; (void)hi8;
#pragma unroll
        for (int ai = 0; ai < 2; ++ai)
#pragma unroll
            for (int m = 0; m < 4; ++m) { unsigned char* vt = ws + WS_VMLA + (size_t)(row0 + ai * HALF + m * 16) * S;
#pragma unroll
                for (int bj = 0; bj < 2; ++bj) { const u32x2 w = pk8_fp8(acc[ai][bj][m][0] * sc[bj][0], acc[ai][bj][m][1] * sc[bj][1]);
#ifdef MLA_MX
                    unsigned char* d64 = vt + ((col0 + bj * HALF) & ~63) + 4 * ((col0 >> 3) & 7);
                    *(GAS unsigned*)(d64) = w.x; *(GAS unsigned*)(d64 + 32) = w.y; } }
#else
                    unsigned char* d16 = vt + ((col0 + bj * HALF) & ~15);
                    *(GAS unsigned*)(d16 + (hi8 ? 4 : 0)) = w.x; *(GAS unsigned*)(d16 + (hi8 ? 12 : 8)) = w.y; } }
#endif
    }
};
#endif
struct EpiOut {
    static constexpr bool PERM = true, AFTER_DRAIN = false;
    bf16_t* y; const float* gate;
    __device__ __forceinline__ void operator()(const f32x4 (&acc)[2][2][4][2], const Unit& u, int wr, int wc, int fr, int fq) const {
        const int row0 = u.pm * BM + wr * 64 + fr, col0 = u.pn * BM + wc * 32 + 8 * fq;
        f32x4 gv[2][2];
#pragma unroll
        for (int bj = 0; bj < 2; ++bj)
#pragma unroll
            for (int n = 0; n < 2; ++n) gv[bj][n] = *(const GAS f32x4*)(gate + col0 + bj * HALF + n * 4);
#pragma unroll
        for (int ai = 0; ai < 2; ++ai)
#pragma unroll
            for (int m = 0; m < 4; ++m) { bf16_t* dst = y + (size_t)(row0 + ai * HALF + m * 16) * D + col0;
#pragma unroll
                for (int bj = 0; bj < 2; ++bj) *(GAS u32x4*)(dst + bj * HALF) = pk8(gv[bj][0] * acc[ai][bj][m][0], gv[bj][1] * acc[ai][bj][m][1]);
                if (m & 1) asm volatile("" ::: "memory"); }
    }
};
template <class Epi, class Sched, bool ALIGN_EPI = false, bool SP2 = false, int SCB = 0, int SCA = 0>
__device__ __forceinline__ void gemm_phase(PG8_LAS unsigned char* lds, const Gemm g, const Sched& S, const Epi& E) {
    int tid_ = threadIdx.x; asm volatile("" : "+v"(tid_));
    const int tid = tid_, wid = __builtin_amdgcn_readfirstlane(tid >> 6), lane = tid & 63, wr = wid >> 2, wc = wid & 3, fr = lane & 15, fq = lane >> 4;
    const int K = g.K, nt = K / BK;
    unsigned voffA[2], voffB[2];
#pragma unroll
    for (int i = 0; i < 2; ++i) { int R, C; stage_rc(tid * 16 + i * 8192, R, C); const int Rb = Epi::PERM ? ((R & ~31) + perm32(R & 31)) : R;
        voffA[i] = (unsigned)(R * K + C) * 2u; voffB[i] = (unsigned)(Rb * K + C) * 2u; }
    const size_t kstep = (size_t)(BK * 2);
    const size_t hstep = (size_t)HALF * K * 2;
    const size_t tstep = 2 * hstep;
    const unsigned ldsw = (unsigned)wid * 1024u;
    const int aoff = lds_byte(wr * 64 + fr, fq * 8), boff = lds_byte(wc * 32 + fr, fq * 8);
#define PG8_SA(b, h) (((b) * 2 + (h)) * HTB)
#define PG8_SB(b, h) ((4 + (b) * 2 + (h)) * HTB)
#define PG8_STAGE(bufoff, gbase, voff) do { _Pragma("unroll") for (int _i = 0; _i < 2; ++_i) \
        __builtin_amdgcn_global_load_lds((const unsigned*)((const char*)(gbase) + (voff)[_i]), (PG8_LAS unsigned*)(lds + (bufoff) + ldsw + _i * 8192), 16, 0, 0); } while (0)
#define PG8_LDA(dst, b, h) do { if constexpr (SCB != 0) { _Pragma("unroll") for (int m = 0; m < 4; ++m) dst##8[m] = ld2x16(lds + PG8_SA(b, h) + aoff + m * 2048); } \
        else { _Pragma("unroll") for (int m = 0; m < 4; ++m) _Pragma("unroll") for (int k = 0; k < 2; ++k) dst[m][k] = *(const PG8_LAS bf16x8*)(lds + PG8_SA(b, h) + aoff + m * 2048 + k * 1024); } } while (0)
#define PG8_LDB(dst, b, h) do { if constexpr (SCB != 0) { _Pragma("unroll") for (int n = 0; n < 2; ++n) dst##8[n] = ld2x16(lds + PG8_SB(b, h) + boff + n * 2048); } \
        else { _Pragma("unroll") for (int n = 0; n < 2; ++n) _Pragma("unroll") for (int k = 0; k < 2; ++k) dst[n][k] = *(const PG8_LAS bf16x8*)(lds + PG8_SB(b, h) + boff + n * 2048 + k * 1024); } } while (0)
#define PG8_MMA(ai, bj, At, Bt) do { __builtin_amdgcn_s_setprio(1); \
        if constexpr (SCB != 0) { _Pragma("unroll") for (int m = 0; m < 4; ++m) _Pragma("unroll") for (int n = 0; n < 2; ++n) \
            asm volatile("v_mfma_scale_f32_16x16x128_f8f6f4 %0, %1, %2, %0, %3, %4 op_sel_hi:[0,0,0]" : "+v"(acc[ai][bj][m][n]) : "v"(Bt##8[n]), "v"(At##8[m]), "v"(scb_), "v"(sca_)); } \
        else { _Pragma("unroll") for (int m = 0; m < 4; ++m) _Pragma("unroll") for (int n = 0; n < 2; ++n) _Pragma("unroll") for (int k = 0; k < 2; ++k) \
            acc[ai][bj][m][n] = __builtin_amdgcn_mfma_f32_16x16x32_bf16(Bt[n][k], At[m][k], acc[ai][bj][m][n], 0, 0, 0); } \
        __builtin_amdgcn_s_setprio(0); } while (0)
#define PG8_WAIT_V(n) asm volatile("s_waitcnt vmcnt(" #n ")" ::: "memory")
#define PG8_WAIT_L(n) asm volatile("s_waitcnt lgkmcnt(" #n ")" ::: "memory")
#define PG8_BAR __builtin_amdgcn_s_barrier()
#define PG8_SCHED __builtin_amdgcn_sched_barrier(0)
    Unit cur, nxt; int ui = 0;
    if (!S.next(0, cur)) return;
    f32x4 acc[2][2][4][2];
#pragma unroll
    for (int a = 0; a < 2; ++a)
#pragma unroll
        for (int b = 0; b < 2; ++b)
#pragma unroll
            for (int m = 0; m < 4; ++m)
#pragma unroll
                for (int n = 0; n < 2; ++n) acc[a][b][m][n] = (f32x4){0.f, 0.f, 0.f, 0.f};
    int scb_ = SCB, sca_ = SCA; asm volatile("" : "+v"(scb_), "+v"(sca_));
    bf16x8 At[4][2], B0[2][2], B1[2][2]; i32x8 At8[4], B08[2], B18[2];
    const char* cA = (const char*)g.A + (size_t)cur.pm * tstep; const char* cB = (const char*)g.Bt + (size_t)cur.pn * tstep;
    S.a_ready(cur);
    if constexpr (SP2) {
        PG8_STAGE(PG8_SB(0, 0), cB, voffB); PG8_STAGE(PG8_SB(0, 1), cB + hstep, voffB); PG8_STAGE(PG8_SA(0, 0), cA, voffA); PG8_STAGE(PG8_SA(0, 1), cA + hstep, voffA);
        if (wr == 1) PG8_BAR;
        PG8_WAIT_V(2); PG8_BAR;
        PG8_STAGE(PG8_SB(1, 0), cB + kstep, voffB); PG8_STAGE(PG8_SA(1, 0), cA + kstep, voffA); PG8_STAGE(PG8_SB(1, 1), cB + hstep + kstep, voffB);
        PG8_WAIT_V(6); PG8_BAR;
    } else {
        PG8_STAGE(PG8_SB(0, 0), cB, voffB); PG8_STAGE(PG8_SA(0, 0), cA, voffA); PG8_STAGE(PG8_SB(0, 1), cB + hstep, voffB); PG8_STAGE(PG8_SA(0, 1), cA + hstep, voffA);
        if (wr == 1) PG8_BAR;
        PG8_WAIT_V(4); PG8_BAR;
        PG8_STAGE(PG8_SB(1, 0), cB + kstep, voffB); PG8_STAGE(PG8_SA(1, 0), cA + kstep, voffA); PG8_STAGE(PG8_SB(1, 1), cB + hstep + kstep, voffB);
        PG8_WAIT_V(6); PG8_BAR;
    }
    for (;;) {
        const bool has_next = S.next(ui + 1, nxt);
        const char* nA = has_next ? (const char*)g.A + (size_t)nxt.pm * tstep : cA; const char* nB = has_next ? (const char*)g.Bt + (size_t)nxt.pn * tstep : cB;
#pragma unroll 1
        for (int t = 0; t < nt; t += 2) {
            const bool last = (t == nt - 2);
            const char* a1 = cA + (size_t)(t + 1) * kstep;
            const char* a2 = last ? nA : cA + (size_t)(t + 2) * kstep; const char* b2 = last ? nB : cB + (size_t)(t + 2) * kstep;
            const char* a3 = a2 + kstep; const char* b3 = b2 + kstep;
            if (last && has_next) S.a_ready(nxt);
            if constexpr (SP2) {
            PG8_LDB(B0, 0, 0); PG8_LDB(B1, 0, 1); PG8_SCHED; PG8_LDA(At, 0, 0); PG8_STAGE(PG8_SA(1, 1), a1 + hstep, voffA);
            PG8_WAIT_V(8); PG8_WAIT_L(0); PG8_BAR; PG8_MMA(0, 0, At, B0); PG8_MMA(0, 1, At, B1); PG8_BAR; PG8_SCHED;
            PG8_LDA(At, 0, 1); PG8_STAGE(PG8_SB(0, 0), b2, voffB); PG8_STAGE(PG8_SB(0, 1), b2 + hstep, voffB); PG8_STAGE(PG8_SA(0, 0), a2, voffA);
            PG8_WAIT_V(8); PG8_WAIT_L(0); PG8_BAR; PG8_MMA(1, 0, At, B0); PG8_MMA(1, 1, At, B1); PG8_BAR; PG8_SCHED;
            PG8_LDB(B0, 1, 0); PG8_LDB(B1, 1, 1); PG8_SCHED; PG8_LDA(At, 1, 0); PG8_STAGE(PG8_SA(0, 1), a2 + hstep, voffA);
            PG8_WAIT_V(8); PG8_WAIT_L(0); PG8_BAR; PG8_MMA(0, 0, At, B0); PG8_MMA(0, 1, At, B1); PG8_BAR; PG8_SCHED;
            PG8_LDA(At, 1, 1); PG8_STAGE(PG8_SB(1, 0), b3, voffB); PG8_STAGE(PG8_SB(1, 1), b3 + hstep, voffB); PG8_STAGE(PG8_SA(1, 0), a3, voffA);
            PG8_WAIT_V(8); PG8_WAIT_L(0); PG8_BAR; PG8_MMA(1, 0, At, B0); PG8_MMA(1, 1, At, B1); PG8_BAR; PG8_SCHED;
            } else {
            PG8_LDB(B0, 0, 0); PG8_SCHED; PG8_LDA(At, 0, 0); PG8_STAGE(PG8_SA(1, 1), a1 + hstep, voffA);
            PG8_WAIT_L(8); PG8_BAR; PG8_WAIT_L(0); PG8_MMA(0, 0, At, B0); PG8_BAR; PG8_SCHED;
            PG8_LDB(B1, 0, 1); PG8_STAGE(PG8_SB(0, 0), b2, voffB);
            PG8_BAR; PG8_WAIT_L(0); PG8_MMA(0, 1, At, B1); PG8_BAR;
            PG8_LDA(At, 0, 1); PG8_STAGE(PG8_SA(0, 0), a2, voffA);
            PG8_BAR; PG8_WAIT_L(0); PG8_MMA(1, 0, At, B0); PG8_BAR; PG8_SCHED;
            PG8_STAGE(PG8_SB(0, 1), b2 + hstep, voffB);
            PG8_WAIT_V(6); PG8_BAR; PG8_MMA(1, 1, At, B1); PG8_BAR;
            PG8_LDB(B0, 1, 0); PG8_SCHED; PG8_LDA(At, 1, 0); PG8_STAGE(PG8_SA(0, 1), a2 + hstep, voffA);
            PG8_WAIT_L(8); PG8_BAR; PG8_WAIT_L(0); PG8_MMA(0, 0, At, B0); PG8_BAR; PG8_SCHED;
            PG8_LDB(B1, 1, 1); PG8_STAGE(PG8_SB(1, 0), b3, voffB);
            PG8_BAR; PG8_WAIT_L(0); PG8_MMA(0, 1, At, B1); PG8_BAR;
            PG8_LDA(At, 1, 1); PG8_STAGE(PG8_SA(1, 0), a3, voffA);
            PG8_BAR; PG8_WAIT_L(0); PG8_MMA(1, 0, At, B0); PG8_BAR; PG8_SCHED;
            PG8_STAGE(PG8_SB(1, 1), b3 + hstep, voffB);
            PG8_WAIT_V(6); PG8_BAR; PG8_MMA(1, 1, At, B1); PG8_BAR;
            }
        }
        if constexpr (SCB != 0) asm volatile("s_nop 15\n\ts_nop 15" ::: "memory");
        if constexpr (ALIGN_EPI) { if (wr == 0) PG8_BAR; }
        if constexpr (!Epi::AFTER_DRAIN) { int fr_ = fr, fq_ = fq; asm volatile("" : "+v"(fr_), "+v"(fq_));
            E(acc, cur, wr, wc, fr_, fq_); S.done(cur); }
        if (!has_next) break;
#pragma unroll
        for (int a = 0; a < 2; ++a)
#pragma unroll
            for (int b = 0; b < 2; ++b)
#pragma unroll
                for (int m = 0; m < 4; ++m)
#pragma unroll
                    for (int n = 0; n < 2; ++n) acc[a][b][m][n] = (f32x4){0.f, 0.f, 0.f, 0.f};
        cur = nxt; cA = nA; cB = nB; ++ui;
        if constexpr (ALIGN_EPI) { if (wr == 1) PG8_BAR; }
    }
    PG8_WAIT_V(0);
    if constexpr (!ALIGN_EPI) { if (wr == 0) PG8_BAR; }
    PG8_BAR;
    if constexpr (Epi::AFTER_DRAIN) { E.fused(acc, cur, wr, wc, fr, fq, lds, wid, lane); S.done(cur); }
#undef PG8_SA
#undef PG8_SB
#undef PG8_STAGE
#undef PG8_LDA
#undef PG8_LDB
#undef PG8_MMA
#undef PG8_WAIT_V
#undef PG8_WAIT_L
#undef PG8_BAR
#undef PG8_SCHED
}

struct GemmMix { const void* A; const void* B; int LD;
                 int K0, K1, OFF1, M, N; };
template <class Epi, class Sched, int SCB, int SCA>
__device__ __forceinline__ void gemm_phase_mix(PG8_LAS unsigned char* lds, const GemmMix g, const Sched& S, const Epi& E) {
    int tid_ = threadIdx.x; asm volatile("" : "+v"(tid_));
    const int tid = tid_, wid = __builtin_amdgcn_readfirstlane(tid >> 6), lane = tid & 63, wr = wid >> 2, wc = wid & 3, fr = lane & 15, fq = lane >> 4;
    const int nt0 = g.K0 / BK, nt1 = g.K1 / BK, nt = nt0 + nt1, koff1 = g.OFF1 / BK - nt0;
    unsigned voffA[2], voffB[2];
#pragma unroll
    for (int i = 0; i < 2; ++i) { int R, C; stage_rc(tid * 16 + i * 8192, R, C); const int Rb = Epi::PERM ? ((R & ~31) + perm32(R & 31)) : R;
        voffA[i] = (unsigned)(R * g.LD + C) * 2u; voffB[i] = (unsigned)(Rb * g.LD + C) * 2u; }
    const size_t kstep = (size_t)(BK * 2);
    const size_t hstep = (size_t)HALF * g.LD * 2, tstep = 2 * hstep;
    const unsigned ldsw = (unsigned)wid * 1024u;
    const int aoff = lds_byte(wr * 64 + fr, fq * 8), boff = lds_byte(wc * 32 + fr, fq * 8);
#define PG8_SA(b, h) (((b) * 2 + (h)) * HTB)
#define PG8_SB(b, h) ((4 + (b) * 2 + (h)) * HTB)
#define PG8_STAGE(bufoff, gbase, voff) do { _Pragma("unroll") for (int _i = 0; _i < 2; ++_i) \
        __builtin_amdgcn_global_load_lds((const unsigned*)((const char*)(gbase) + (voff)[_i]), (PG8_LAS unsigned*)(lds + (bufoff) + ldsw + _i * 8192), 16, 0, 0); } while (0)
#define PG8_LDA1(dst, b, h) do { _Pragma("unroll") for (int m = 0; m < 4; ++m) dst##8[m] = ld2x16(lds + PG8_SA(b, h) + aoff + m * 2048); } while (0)
#define PG8_LDB1(dst, b, h) do { _Pragma("unroll") for (int n = 0; n < 2; ++n) dst##8[n] = ld2x16(lds + PG8_SB(b, h) + boff + n * 2048); } while (0)
#define PG8_LDA0(dst, b, h) do { _Pragma("unroll") for (int m = 0; m < 4; ++m) _Pragma("unroll") for (int k = 0; k < 2; ++k) dst[m][k] = *(const PG8_LAS bf16x8*)(lds + PG8_SA(b, h) + aoff + m * 2048 + k * 1024); } while (0)
#define PG8_LDB0(dst, b, h) do { _Pragma("unroll") for (int n = 0; n < 2; ++n) _Pragma("unroll") for (int k = 0; k < 2; ++k) dst[n][k] = *(const PG8_LAS bf16x8*)(lds + PG8_SB(b, h) + boff + n * 2048 + k * 1024); } while (0)
#define PG8_MMA1(ai, bj, At, Bt) do { __builtin_amdgcn_s_setprio(1); _Pragma("unroll") for (int m = 0; m < 4; ++m) _Pragma("unroll") for (int n = 0; n < 2; ++n) \
            asm volatile("v_mfma_scale_f32_16x16x128_f8f6f4 %0, %1, %2, %0, %3, %4 op_sel_hi:[0,0,0]" : "+v"(acc[ai][bj][m][n]) : "v"(Bt##8[n]), "v"(At##8[m]), "v"(scb_), "v"(sca_)); \
        __builtin_amdgcn_s_setprio(0); } while (0)
#define PG8_MMA0(ai, bj, At, Bt) do { __builtin_amdgcn_s_setprio(1); _Pragma("unroll") for (int m = 0; m < 4; ++m) _Pragma("unroll") for (int n = 0; n < 2; ++n) _Pragma("unroll") for (int k = 0; k < 2; ++k) \
            acc[ai][bj][m][n] = __builtin_amdgcn_mfma_f32_16x16x32_bf16(Bt[n][k], At[m][k], acc[ai][bj][m][n], 0, 0, 0); \
        __builtin_amdgcn_s_setprio(0); } while (0)
#define PG8_WAIT_V(n) asm volatile("s_waitcnt vmcnt(" #n ")" ::: "memory")
#define PG8_WAIT_L(n) asm volatile("s_waitcnt lgkmcnt(" #n ")" ::: "memory")
#define PG8_BAR __builtin_amdgcn_s_barrier()
#define PG8_SCHED __builtin_amdgcn_sched_barrier(0)
    Unit cur, nxt; int ui = 0;
    if (!S.next(0, cur)) return;
    f32x4 acc[2][2][4][2];
#pragma unroll
    for (int a = 0; a < 2; ++a)
#pragma unroll
        for (int b = 0; b < 2; ++b)
#pragma unroll
            for (int m = 0; m < 4; ++m)
#pragma unroll
                for (int n = 0; n < 2; ++n) acc[a][b][m][n] = (f32x4){0.f, 0.f, 0.f, 0.f};
    int scb_ = SCB, sca_ = SCA; asm volatile("" : "+v"(scb_), "+v"(sca_));
    bf16x8 At[4][2], B0[2][2], B1[2][2]; i32x8 At8[4], B08[2], B18[2];
    const char* cA = (const char*)g.A + (size_t)cur.pm * tstep; const char* cB = (const char*)g.B + (size_t)cur.pn * tstep;
    S.a_ready(cur);
    PG8_STAGE(PG8_SB(0, 0), cB, voffB); PG8_STAGE(PG8_SB(0, 1), cB + hstep, voffB); PG8_STAGE(PG8_SA(0, 0), cA, voffA); PG8_STAGE(PG8_SA(0, 1), cA + hstep, voffA);
    if (wr == 1) PG8_BAR;
    PG8_WAIT_V(2); PG8_BAR;
    PG8_STAGE(PG8_SB(1, 0), cB + kstep, voffB); PG8_STAGE(PG8_SA(1, 0), cA + kstep, voffA); PG8_STAGE(PG8_SB(1, 1), cB + hstep + kstep, voffB);
    PG8_WAIT_V(6); PG8_BAR;
    for (;;) {
        const bool has_next = S.next(ui + 1, nxt);
        const char* nA = has_next ? (const char*)g.A + (size_t)nxt.pm * tstep : cA; const char* nB = has_next ? (const char*)g.B + (size_t)nxt.pn * tstep : cB;
#define PG8_KPOS(x) ((size_t)((x) < nt0 ? (x) : (x) + koff1) * kstep)
#define PG8_TRIP(F) do { \
            const bool last = (t == nt - 2); \
            const char* a1 = cA + PG8_KPOS(t + 1); \
            const char* a2 = last ? nA : cA + PG8_KPOS(t + 2); const char* b2 = last ? nB : cB + PG8_KPOS(t + 2); \
            const char* a3 = last ? nA + kstep : cA + PG8_KPOS(t + 3); const char* b3 = last ? nB + kstep : cB + PG8_KPOS(t + 3); \
            if (last && has_next) S.a_ready(nxt); \
            PG8_LDB##F(B0, 0, 0); PG8_LDB##F(B1, 0, 1); PG8_SCHED; PG8_LDA##F(At, 0, 0); PG8_STAGE(PG8_SA(1, 1), a1 + hstep, voffA); \
            PG8_WAIT_V(8); PG8_WAIT_L(0); PG8_BAR; PG8_MMA##F(0, 0, At, B0); PG8_MMA##F(0, 1, At, B1); PG8_BAR; PG8_SCHED; \
            PG8_LDA##F(At, 0, 1); PG8_STAGE(PG8_SB(0, 0), b2, voffB); PG8_STAGE(PG8_SB(0, 1), b2 + hstep, voffB); PG8_STAGE(PG8_SA(0, 0), a2, voffA); \
            PG8_WAIT_V(8); PG8_WAIT_L(0); PG8_BAR; PG8_MMA##F(1, 0, At, B0); PG8_MMA##F(1, 1, At, B1); PG8_BAR; PG8_SCHED; \
            PG8_LDB##F(B0, 1, 0); PG8_LDB##F(B1, 1, 1); PG8_SCHED; PG8_LDA##F(At, 1, 0); PG8_STAGE(PG8_SA(0, 1), a2 + hstep, voffA); \
            PG8_WAIT_V(8); PG8_WAIT_L(0); PG8_BAR; PG8_MMA##F(0, 0, At, B0); PG8_MMA##F(0, 1, At, B1); PG8_BAR; PG8_SCHED; \
            PG8_LDA##F(At, 1, 1); PG8_STAGE(PG8_SB(1, 0), b3, voffB); PG8_STAGE(PG8_SB(1, 1), b3 + hstep, voffB); PG8_STAGE(PG8_SA(1, 0), a3, voffA); \
            PG8_WAIT_V(8); PG8_WAIT_L(0); PG8_BAR; PG8_MMA##F(1, 0, At, B0); PG8_MMA##F(1, 1, At, B1); PG8_BAR; PG8_SCHED; \
        } while (0)
#pragma unroll 1
        for (int t = 0; t < nt0; t += 2) PG8_TRIP(1);
        asm volatile("s_nop 7" ::: "memory");
#pragma unroll 1
        for (int t = nt0; t < nt; t += 2) PG8_TRIP(0);
#undef PG8_TRIP
#undef PG8_KPOS
        asm volatile("s_nop 15\n\ts_nop 15" ::: "memory");
        if (wr == 0) PG8_BAR;
        { int fr_ = fr, fq_ = fq; asm volatile("" : "+v"(fr_), "+v"(fq_)); E(acc, cur, wr, wc, fr_, fq_); S.done(cur); }
        if (!has_next) break;
#pragma unroll
        for (int a = 0; a < 2; ++a)
#pragma unroll
            for (int b = 0; b < 2; ++b)
#pragma unroll
                for (int m = 0; m < 4; ++m)
#pragma unroll
                    for (int n = 0; n < 2; ++n) acc[a][b][m][n] = (f32x4){0.f, 0.f, 0.f, 0.f};
        cur = nxt; cA = nA; cB = nB; ++ui;
        if (wr == 1) PG8_BAR;
    }
    PG8_WAIT_V(0);
    PG8_BAR;
#undef PG8_SA
#undef PG8_SB
#undef PG8_STAGE
#undef PG8_LDA0
#undef PG8_LDB0
#undef PG8_LDA1
#undef PG8_LDB1
#undef PG8_MMA0
#undef PG8_MMA1
#undef PG8_WAIT_V
#undef PG8_WAIT_L
#undef PG8_BAR
#undef PG8_SCHED
}
}
namespace att {
constexpr int KS_M = 400, KS_N = 272, VS = 320;
constexpr int MLA_KB = 64 * KS_M, NSA_KB = 64 * KS_N, VB = 64 * VS;
constexpr int N_IMP = 2 * NSA_KB + 2 * VB;
constexpr int N_PART = N_IMP + 32768;
constexpr int N_PARTB = 8 * 32 * 17 * 4;
constexpr int N_SELM = N_PART + 2 * N_PARTB;
constexpr int N_ULIST = N_SELM + 1024;
constexpr int N_CARRY = N_ULIST + 1024;
constexpr int N_NTS = N_CARRY + 256;
static_assert(N_NTS + 16 <= MISC_OFF, "NSA LDS map");
static_assert(2 * MLA_KB + 3 * VB <= 131072, "MLA LDS map");
constexpr int MLA_QL = 2 * MLA_KB + 2 * VB;
static_assert(MLA_QL + 8 * 4096 <= 131072, "MLA LDS map (pipelined)");

#ifndef QK_PF
#define QK_PF 4
#endif
#define MFMA32(a, b, c) __builtin_amdgcn_mfma_f32_32x32x16_bf16((a), (b), (c), 0, 0, 0)
__device__ __forceinline__ float swapmax(float v) { auto rr = __builtin_amdgcn_permlane32_swap(__float_as_uint(v), __float_as_uint(v), false, false); return fmaxf(__uint_as_float(rr[0]), __uint_as_float(rr[1])); }
__device__ __forceinline__ float swapsum(float v) { auto rr = __builtin_amdgcn_permlane32_swap(__float_as_uint(v), __float_as_uint(v), false, false); return __uint_as_float(rr[0]) + __uint_as_float(rr[1]); }
template <int SIDX> __device__ __forceinline__ bf16x8 packp(const f32x16& p) {
    f32x8 t = {p[8 * SIDX + 0], p[8 * SIDX + 1], p[8 * SIDX + 2], p[8 * SIDX + 3], p[8 * SIDX + 4], p[8 * SIDX + 5], p[8 * SIDX + 6], p[8 * SIDX + 7]};
    return __builtin_bit_cast(bf16x8, __builtin_convertvector(t, bf16x8v));
}
template <int NDC, int KS, bool ZERO = true> __device__ __forceinline__ void qk_tile(f32x16& p0, f32x16& p1, const LAS unsigned char* kl, const bf16x8 (&q)[NDC]) {
    if (ZERO) {
#pragma unroll
        for (int i = 0; i < 16; ++i) { p0[i] = 0.f; p1[i] = 0.f; }
    }
    constexpr int PF = QK_PF;
    bf16x8 a[PF + 1][2];
#pragma unroll
    for (int i = 0; i < PF; ++i) { a[i][0] = *(const LAS bf16x8*)(kl + i * 32); a[i][1] = *(const LAS bf16x8*)(kl + 32 * KS + i * 32); }
#pragma unroll
    for (int d0 = 0; d0 < NDC; ++d0) {
        if (d0 + PF < NDC) { a[(d0 + PF) % (PF + 1)][0] = *(const LAS bf16x8*)(kl + (d0 + PF) * 32); a[(d0 + PF) % (PF + 1)][1] = *(const LAS bf16x8*)(kl + 32 * KS + (d0 + PF) * 32); }
        __builtin_amdgcn_sched_barrier(0);
        p0 = MFMA32(a[d0 % (PF + 1)][0], q[d0], p0); p1 = MFMA32(a[d0 % (PF + 1)][1], q[d0], p1);
        __builtin_amdgcn_sched_barrier(0);
    }
}
#ifdef PROBE_QKM2
template <int NDC, int KS> __device__ __forceinline__ void qk_tile_m2(f32x16& p0, f32x16& p1, f32x16& r0, f32x16& r1, const LAS unsigned char* kl, const bf16x8 (&q)[NDC]) {
#pragma unroll
    for (int i = 0; i < 16; ++i) { p0[i] = 0.f; p1[i] = 0.f; r0[i] = 0.f; r1[i] = 0.f; }
    constexpr int PF = QK_PF;
    bf16x8 a[PF + 1][2];
#pragma unroll
    for (int i = 0; i < PF; ++i) { a[i][0] = *(const LAS bf16x8*)(kl + i * 32); a[i][1] = *(const LAS bf16x8*)(kl + 32 * KS + i * 32); }
#pragma unroll
    for (int d0 = 0; d0 < NDC; ++d0) {
        if (d0 + PF < NDC) { a[(d0 + PF) % (PF + 1)][0] = *(const LAS bf16x8*)(kl + (d0 + PF) * 32); a[(d0 + PF) % (PF + 1)][1] = *(const LAS bf16x8*)(kl + 32 * KS + (d0 + PF) * 32); }
        __builtin_amdgcn_sched_barrier(0);
        p0 = MFMA32(a[d0 % (PF + 1)][0], q[d0], p0); p1 = MFMA32(a[d0 % (PF + 1)][1], q[d0], p1);
        r0 = MFMA32(a[d0 % (PF + 1)][0], q[d0], r0); r1 = MFMA32(a[d0 % (PF + 1)][1], q[d0], r1);
        __builtin_amdgcn_sched_barrier(0);
    }
}
#endif
__device__ __forceinline__ void pv_tile(f32x16 (&o)[4], const bf16x8 (&pb)[4], const LAS unsigned char* vl) {
    s16x4 f[5][2];
#define PV_LD(idx) do { constexpr int d_ = (idx) >> 2, s_ = (idx) & 3; \
        f[(idx) % 5][0] = __builtin_amdgcn_ds_read_tr16_b64_v4i16((LAS s16x4*)(vl + s_ * 16 * VS + d_ * 64)); \
        f[(idx) % 5][1] = __builtin_amdgcn_ds_read_tr16_b64_v4i16((LAS s16x4*)(vl + s_ * 16 * VS + 8 * VS + d_ * 64)); } while (0)
    PV_LD(0); PV_LD(1); PV_LD(2); PV_LD(3);
#define PV_STEP(idx) do { if ((idx) + 4 < 16) PV_LD((idx) + 4); __builtin_amdgcn_sched_barrier(0); \
        { const s16x4 t0_ = f[(idx) % 5][0], t1_ = f[(idx) % 5][1]; const bf16x8 vf_ = {t0_[0], t0_[1], t0_[2], t0_[3], t1_[0], t1_[1], t1_[2], t1_[3]}; \
          o[(idx) >> 2] = MFMA32(vf_, pb[(idx) & 3], o[(idx) >> 2]); } __builtin_amdgcn_sched_barrier(0); } while (0)
    PV_STEP(0); PV_STEP(1); PV_STEP(2); PV_STEP(3); PV_STEP(4); PV_STEP(5); PV_STEP(6); PV_STEP(7);
    PV_STEP(8); PV_STEP(9); PV_STEP(10); PV_STEP(11); PV_STEP(12); PV_STEP(13); PV_STEP(14); PV_STEP(15);
#undef PV_STEP
#undef PV_LD
}
template <int NDC, int NQR, int KS> __device__ __forceinline__ void qk_tile_free(f32x16& p0, f32x16& p1, const LAS unsigned char* kl, const bf16x8 (&q)[NQR], const LAS unsigned char* ql) {
#pragma unroll
    for (int i = 0; i < 16; ++i) { p0[i] = 0.f; p1[i] = 0.f; }
#pragma unroll
    for (int d0 = 0; d0 < NDC; ++d0) {
        const bf16x8 a0 = *(const LAS bf16x8*)(kl + d0 * 32);
        const bf16x8 a1 = *(const LAS bf16x8*)(kl + 32 * KS + d0 * 32);
        bf16x8 qq; if (d0 < NQR) qq = q[d0 < NQR ? d0 : 0]; else qq = *(const LAS bf16x8*)(ql + (d0 - NQR) * 1024);
        p0 = MFMA32(a0, qq, p0); p1 = MFMA32(a1, qq, p1);
    }
}
__device__ __forceinline__ float sm_core(f32x16& p0, f32x16& p1, float& m, float& l) {
    float tm = p0[0];
#pragma unroll
    for (int r = 1; r < 16; ++r) tm = fmaxf(tm, p0[r]);
#pragma unroll
    for (int r = 0; r < 16; ++r) tm = fmaxf(tm, p1[r]);
    tm = swapmax(tm);
    const float mn = fmaxf(m, tm);
    const float alpha = __builtin_amdgcn_exp2f(m - mn);
    m = mn;
    float ps = 0.f;
#pragma unroll
    for (int r = 0; r < 16; ++r) { p0[r] = __builtin_amdgcn_exp2f(p0[r] - mn); ps += p0[r]; }
#pragma unroll
    for (int r = 0; r < 16; ++r) { p1[r] = __builtin_amdgcn_exp2f(p1[r] - mn); ps += p1[r]; }
    ps = swapsum(ps);
    l = l * alpha + ps;
    return alpha;
}
__device__ __forceinline__ void online_sm(f32x16& p0, f32x16& p1, float& m, float& l, f32x16 (&o)[4]) {
    float tm = p0[0];
#pragma unroll
    for (int r = 1; r < 16; ++r) tm = fmaxf(tm, p0[r]);
#pragma unroll
    for (int r = 0; r < 16; ++r) tm = fmaxf(tm, p1[r]);
    tm = swapmax(tm);
    const float mn = fmaxf(m, tm);
    const float alpha = __builtin_amdgcn_exp2f(m - mn);
    m = mn;
    float ps = 0.f;
#pragma unroll
    for (int r = 0; r < 16; ++r) { p0[r] = __builtin_amdgcn_exp2f(p0[r] - mn); ps += p0[r]; }
#pragma unroll
    for (int r = 0; r < 16; ++r) { p1[r] = __builtin_amdgcn_exp2f(p1[r] - mn); ps += p1[r]; }
    ps = swapsum(ps);
    l = l * alpha + ps;
    if (!__all(alpha == 1.f)) {
#pragma unroll
        for (int d = 0; d < 4; ++d)
#pragma unroll
            for (int r = 0; r < 16; ++r) o[d][r] *= alpha;
    }
}

#ifdef MLA_FP8
typedef long i64;
constexpr int KS8 = 200, MLA_KB8 = 64 * KS8;
static_assert(2 * MLA_KB8 + 3 * VB <= 131072, "MLA fp8 LDS map");
#define MFMA32F8(a, b, c) __builtin_amdgcn_mfma_f32_32x32x16_fp8_fp8((a), (b), (c), 0, 0, 0)
template <int NDC> __device__ __forceinline__ void qk_tile8(f32x16& p0, f32x16& p1, const LAS unsigned char* kl, const i64 (&q)[NDC]) {
#pragma unroll
    for (int i = 0; i < 16; ++i) { p0[i] = 0.f; p1[i] = 0.f; }
    constexpr int PF = 4;
    i64 a[PF + 1][2];
#pragma unroll
    for (int i = 0; i < PF; ++i) { a[i][0] = *(const LAS i64*)(kl + i * 16); a[i][1] = *(const LAS i64*)(kl + 32 * KS8 + i * 16); }
#pragma unroll
    for (int d0 = 0; d0 < NDC; ++d0) {
        if (d0 + PF < NDC) { a[(d0 + PF) % (PF + 1)][0] = *(const LAS i64*)(kl + (d0 + PF) * 16); a[(d0 + PF) % (PF + 1)][1] = *(const LAS i64*)(kl + 32 * KS8 + (d0 + PF) * 16); }
        __builtin_amdgcn_sched_barrier(0);
        __builtin_amdgcn_s_setprio(1);
        p0 = MFMA32F8(a[d0 % (PF + 1)][0], q[d0], p0); p1 = MFMA32F8(a[d0 % (PF + 1)][1], q[d0], p1);
        __builtin_amdgcn_s_setprio(0);
        __builtin_amdgcn_sched_barrier(0);
    }
}
__device__ __forceinline__ void online_sm_scaled(f32x16& p0, f32x16& p1, float& m, float& l, f32x16 (&o)[4], const float C2) {
    float tm = p0[0];
#pragma unroll
    for (int r = 1; r < 16; ++r) tm = fmaxf(tm, p0[r]);
#pragma unroll
    for (int r = 0; r < 16; ++r) tm = fmaxf(tm, p1[r]);
    tm = swapmax(tm);
    const float mn = fmaxf(m, tm);
    const float alpha = __builtin_amdgcn_exp2f((m - mn) * C2);
    m = mn;
    const float mc = -mn * C2;
    float ps = 0.f;
#pragma unroll
    for (int r = 0; r < 16; ++r) { p0[r] = __builtin_amdgcn_exp2f(__builtin_fmaf(p0[r], C2, mc)); ps += p0[r]; }
#pragma unroll
    for (int r = 0; r < 16; ++r) { p1[r] = __builtin_amdgcn_exp2f(__builtin_fmaf(p1[r], C2, mc)); ps += p1[r]; }
    ps = swapsum(ps);
    l = l * alpha + ps;
    if (!__all(alpha == 1.f)) {
#pragma unroll
        for (int d = 0; d < 4; ++d)
#pragma unroll
            for (int r = 0; r < 16; ++r) o[d][r] *= alpha;
    }
}
#endif
#ifdef MLA_FP8V
constexpr int VS8 = 72, VB8 = 128 * VS8;
constexpr int VS8B = 136, VB8B = 128 * VS8B, MLA_KB8B = 128 * KS8;
static_assert(2 * MLA_KB8B + 3 * VB8B <= 131072, "MLA big-tile LDS map");
#ifdef MLA_BIG
#define PV8_RS VS8B
#else
#define PV8_RS VS8
#endif
static_assert(2 * MLA_KB8 + 3 * VB8 <= 131072, "MLA fp8 LDS map");
template <int SIDX> __device__ __forceinline__ i64 packp8(const f32x16& p) {
    int w0 = __builtin_amdgcn_cvt_pk_fp8_f32(p[8 * SIDX + 0] * 256.f, p[8 * SIDX + 1] * 256.f, 0, false); w0 = __builtin_amdgcn_cvt_pk_fp8_f32(p[8 * SIDX + 2] * 256.f, p[8 * SIDX + 3] * 256.f, w0, true);
    int w1 = __builtin_amdgcn_cvt_pk_fp8_f32(p[8 * SIDX + 4] * 256.f, p[8 * SIDX + 5] * 256.f, 0, false); w1 = __builtin_amdgcn_cvt_pk_fp8_f32(p[8 * SIDX + 6] * 256.f, p[8 * SIDX + 7] * 256.f, w1, true);
    return (i64)(((unsigned long long)(unsigned)w1 << 32) | (unsigned)w0);
}
__device__ __forceinline__ void pv_tile8(f32x16 (&o)[4], const i64 (&pb)[4], const LAS unsigned char* vl) {
    i64 f[5];
#define PV8_LD(idx) f[(idx) % 5] = *(const LAS i64*)(vl + ((idx) >> 2) * 32 * PV8_RS + ((idx) & 3) * 16)
    PV8_LD(0); PV8_LD(1); PV8_LD(2); PV8_LD(3);
#define PV8_STEP(idx) do { if ((idx) + 4 < 16) PV8_LD((idx) + 4); __builtin_amdgcn_sched_barrier(0); \
        o[(idx) >> 2] = MFMA32F8(f[(idx) % 5], pb[(idx) & 3], o[(idx) >> 2]); __builtin_amdgcn_sched_barrier(0); } while (0)
    PV8_STEP(0); PV8_STEP(1); PV8_STEP(2); PV8_STEP(3); PV8_STEP(4); PV8_STEP(5); PV8_STEP(6); PV8_STEP(7);
    PV8_STEP(8); PV8_STEP(9); PV8_STEP(10); PV8_STEP(11); PV8_STEP(12); PV8_STEP(13); PV8_STEP(14); PV8_STEP(15);
#undef PV8_STEP
#undef PV8_LD
}
#endif
#ifdef MLA_MX
typedef int i32x8 __attribute__((ext_vector_type(8)));
constexpr int KSX = 208, MLA_KBX = 64 * KSX;
constexpr int VSX = 80, VBX = 128 * VSX;
static_assert(2 * MLA_KBX + 3 * VBX <= 131072, "MLA mx LDS map");
#define MFMAX(a, b, c) __builtin_amdgcn_mfma_scale_f32_32x32x64_f8f6f4((a), (b), (c), 0, 0, 0, 0x7f7f7f7f, 0, 0x7f7f7f7f)
__device__ __forceinline__ i32x8 ldsx(const LAS unsigned char* p) {
    const u32x4 a = *(const LAS u32x4*)p, b = *(const LAS u32x4*)(p + 16);
    return (i32x8){(int)a.x, (int)a.y, (int)a.z, (int)a.w, (int)b.x, (int)b.y, (int)b.z, (int)b.w};
}
__device__ __forceinline__ void qk_tilex(f32x16& p0, f32x16& p1, const LAS unsigned char* kl, const i32x8 (&q)[3]) {
#pragma unroll
    for (int i = 0; i < 16; ++i) { p0[i] = 0.f; p1[i] = 0.f; }
    i32x8 a0 = ldsx(kl), a1 = ldsx(kl + 32 * KSX), a2 = ldsx(kl + 64), a3 = ldsx(kl + 32 * KSX + 64);
    __builtin_amdgcn_sched_barrier(0);
    __builtin_amdgcn_s_setprio(1);
    p0 = MFMAX(a0, q[0], p0); p1 = MFMAX(a1, q[0], p1);
    __builtin_amdgcn_s_setprio(0);
    __builtin_amdgcn_sched_barrier(0);
    a0 = ldsx(kl + 128); a1 = ldsx(kl + 32 * KSX + 128);
    __builtin_amdgcn_sched_barrier(0);
    __builtin_amdgcn_s_setprio(1);
    p0 = MFMAX(a2, q[1], p0); p1 = MFMAX(a3, q[1], p1);
    __builtin_amdgcn_sched_barrier(0);
    p0 = MFMAX(a0, q[2], p0); p1 = MFMAX(a1, q[2], p1);
    __builtin_amdgcn_s_setprio(0);
    __builtin_amdgcn_sched_barrier(0);
}
__device__ __forceinline__ void pv_tilex(f32x16 (&o)[4], const i32x8& pb, const LAS unsigned char* vl) {
    i32x8 f0 = ldsx(vl), f1 = ldsx(vl + 32 * VSX);
    __builtin_amdgcn_sched_barrier(0);
    o[0] = MFMAX(f0, pb, o[0]);
    __builtin_amdgcn_sched_barrier(0);
    f0 = ldsx(vl + 64 * VSX);
    __builtin_amdgcn_sched_barrier(0);
    o[1] = MFMAX(f1, pb, o[1]);
    __builtin_amdgcn_sched_barrier(0);
    f1 = ldsx(vl + 96 * VSX);
    __builtin_amdgcn_sched_barrier(0);
    o[2] = MFMAX(f0, pb, o[2]);
    __builtin_amdgcn_sched_barrier(0);
    o[3] = MFMAX(f1, pb, o[3]);
    __builtin_amdgcn_sched_barrier(0);
}
__device__ __forceinline__ i32x8 packpx(const f32x16& p0, const f32x16& p1) {
    i32x8 w;
#pragma unroll
    for (int g = 0; g < 4; ++g) {
        int a = __builtin_amdgcn_cvt_pk_fp8_f32(p0[4 * g + 0], p0[4 * g + 1], 0, false); a = __builtin_amdgcn_cvt_pk_fp8_f32(p0[4 * g + 2], p0[4 * g + 3], a, true); w[g] = a;
        int b = __builtin_amdgcn_cvt_pk_fp8_f32(p1[4 * g + 0], p1[4 * g + 1], 0, false); b = __builtin_amdgcn_cvt_pk_fp8_f32(p1[4 * g + 2], p1[4 * g + 3], b, true); w[4 + g] = b;
    }
    return w;
}
__device__ __forceinline__ void online_sm_x(f32x16& p0, f32x16& p1, float& m, float& l, f32x16 (&o)[4], const float C2) {
    float tm = p0[0];
#pragma unroll
    for (int r = 1; r < 16; ++r) tm = fmaxf(tm, p0[r]);
#pragma unroll
    for (int r = 0; r < 16; ++r) tm = fmaxf(tm, p1[r]);
    tm = swapmax(tm);
    const float mn = fmaxf(m, tm);
    const float alpha = __builtin_amdgcn_exp2f((m - mn) * C2);
    m = mn;
    const float mc = 8.f - mn * C2;
    float ps = 0.f;
#pragma unroll
    for (int r = 0; r < 16; ++r) { p0[r] = __builtin_amdgcn_exp2f(__builtin_fmaf(p0[r], C2, mc)); ps += p0[r]; }
#pragma unroll
    for (int r = 0; r < 16; ++r) { p1[r] = __builtin_amdgcn_exp2f(__builtin_fmaf(p1[r], C2, mc)); ps += p1[r]; }
    ps = swapsum(ps);
    l = l * alpha + ps;
    if (!__all(alpha == 1.f)) {
#pragma unroll
        for (int d = 0; d < 4; ++d)
#pragma unroll
            for (int r = 0; r < 16; ++r) o[d][r] *= alpha;
    }
}
#endif
#ifdef MLA_MXL
#ifdef MLA_MXU
#define MXL_T 126.0f
#define MXL_REF 96.0f
#define MFMAXQ(a, b, c) __builtin_amdgcn_mfma_scale_f32_32x32x64_f8f6f4((a), (b), (c), 0, 0, 0, 0x7f7f7f7f, 0, 0x7f7f7f7f)
__device__ __forceinline__ i32x8 byte_packx(const f32x16& p0, const f32x16& p1) {
    i32x8 w;
#pragma unroll
    for (int g = 0; g < 4; ++g) {
        unsigned a = __builtin_amdgcn_cvt_pk_u8_f32(p0[4 * g + 0], 0, 0u); a = __builtin_amdgcn_cvt_pk_u8_f32(p0[4 * g + 1], 1, a); a = __builtin_amdgcn_cvt_pk_u8_f32(p0[4 * g + 2], 2, a); a = __builtin_amdgcn_cvt_pk_u8_f32(p0[4 * g + 3], 3, a); w[g] = (int)a;
        unsigned b = __builtin_amdgcn_cvt_pk_u8_f32(p1[4 * g + 0], 0, 0u); b = __builtin_amdgcn_cvt_pk_u8_f32(p1[4 * g + 1], 1, b); b = __builtin_amdgcn_cvt_pk_u8_f32(p1[4 * g + 2], 2, b); b = __builtin_amdgcn_cvt_pk_u8_f32(p1[4 * g + 3], 3, b); w[4 + g] = (int)b;
    }
    return w;
}
#else
#define MXL_T 7.0f
#define MXL_REF 0.0f
#define MFMAXQ(a, b, c) __builtin_amdgcn_mfma_scale_f32_32x32x64_f8f6f4((a), (b), (c), 0, 0, 0, 0x7f7f7f7f, 0, 0x7c7c7c7c)
#endif
__device__ __forceinline__ void qk_tilexl(f32x16& p0, f32x16& p1, const f32x16& mref, const LAS unsigned char* kl, const i32x8 (&q)[3]) {
    i32x8 a0 = ldsx(kl), a1 = ldsx(kl + 32 * KSX), a2 = ldsx(kl + 64), a3 = ldsx(kl + 32 * KSX + 64);
    __builtin_amdgcn_sched_barrier(0);
    __builtin_amdgcn_s_setprio(1);
    p0 = MFMAXQ(a0, q[0], mref); p1 = MFMAXQ(a1, q[0], mref);
    __builtin_amdgcn_s_setprio(0);
    __builtin_amdgcn_sched_barrier(0);
    a0 = ldsx(kl + 128); a1 = ldsx(kl + 32 * KSX + 128);
    __builtin_amdgcn_sched_barrier(0);
    __builtin_amdgcn_s_setprio(1);
    p0 = MFMAXQ(a2, q[1], p0); p1 = MFMAXQ(a3, q[1], p1);
    __builtin_amdgcn_sched_barrier(0);
    p0 = MFMAXQ(a0, q[2], p0); p1 = MFMAXQ(a1, q[2], p1);
    __builtin_amdgcn_s_setprio(0);
    __builtin_amdgcn_sched_barrier(0);
}
template <int RS = VSX>
__device__ __forceinline__ void pv_tilexl_pre(f32x16 (&o)[5], const i32x8& pb, const i32x8& ones, const LAS unsigned char* vl, i32x8 f0, i32x8 f1) {
    __builtin_amdgcn_sched_barrier(0);
    o[4] = MFMAX(ones, pb, o[4]);
    __builtin_amdgcn_sched_barrier(0);
    o[0] = MFMAX(f0, pb, o[0]);
    __builtin_amdgcn_sched_barrier(0);
    f0 = ldsx(vl + 64 * RS);
    __builtin_amdgcn_sched_barrier(0);
    o[1] = MFMAX(f1, pb, o[1]);
    __builtin_amdgcn_sched_barrier(0);
    f1 = ldsx(vl + 96 * RS);
    __builtin_amdgcn_sched_barrier(0);
    o[2] = MFMAX(f0, pb, o[2]);
    __builtin_amdgcn_sched_barrier(0);
    o[3] = MFMAX(f1, pb, o[3]);
    __builtin_amdgcn_sched_barrier(0);
}
template <int RS = VSX>
__device__ __forceinline__ void pv_tilexl(f32x16 (&o)[5], const i32x8& pb, const i32x8& ones, const LAS unsigned char* vl) {
    i32x8 f0 = ldsx(vl), f1 = ldsx(vl + 32 * RS);
    __builtin_amdgcn_sched_barrier(0);
    o[4] = MFMAX(ones, pb, o[4]);
    __builtin_amdgcn_sched_barrier(0);
    o[0] = MFMAX(f0, pb, o[0]);
    __builtin_amdgcn_sched_barrier(0);
    f0 = ldsx(vl + 64 * RS);
    __builtin_amdgcn_sched_barrier(0);
    o[1] = MFMAX(f1, pb, o[1]);
    __builtin_amdgcn_sched_barrier(0);
    f1 = ldsx(vl + 96 * RS);
    __builtin_amdgcn_sched_barrier(0);
    o[2] = MFMAX(f0, pb, o[2]);
    __builtin_amdgcn_sched_barrier(0);
    o[3] = MFMAX(f1, pb, o[3]);
    __builtin_amdgcn_sched_barrier(0);
}
__device__ __forceinline__ i32x8 exp_packx(const f32x16& p0, const f32x16& p1, int any) {
    i32x8 w;
#pragma unroll
    for (int g = 0; g < 4; ++g) {
        int a = __builtin_amdgcn_cvt_pk_fp8_f32(__builtin_amdgcn_exp2f(p0[4 * g + 0]), __builtin_amdgcn_exp2f(p0[4 * g + 1]), any, false);
        a = __builtin_amdgcn_cvt_pk_fp8_f32(__builtin_amdgcn_exp2f(p0[4 * g + 2]), __builtin_amdgcn_exp2f(p0[4 * g + 3]), a, true); w[g] = a;
        int b = __builtin_amdgcn_cvt_pk_fp8_f32(__builtin_amdgcn_exp2f(p1[4 * g + 0]), __builtin_amdgcn_exp2f(p1[4 * g + 1]), any, false);
        b = __builtin_amdgcn_cvt_pk_fp8_f32(__builtin_amdgcn_exp2f(p1[4 * g + 2]), __builtin_amdgcn_exp2f(p1[4 * g + 3]), b, true); w[4 + g] = b;
    }
    return w;
}
#endif
#ifdef MLA_PIPE8
template <int NDC> __device__ __forceinline__ void qk_tile8_free(f32x16& p0, f32x16& p1, const LAS unsigned char* kl, const i64 (&q)[NDC]) {
#pragma unroll
    for (int i = 0; i < 16; ++i) { p0[i] = 0.f; p1[i] = 0.f; }
#pragma unroll
    for (int d0 = 0; d0 < NDC; ++d0) {
        const i64 a0 = *(const LAS i64*)(kl + d0 * 16), a1 = *(const LAS i64*)(kl + 32 * KS8 + d0 * 16);
        p0 = MFMA32F8(a0, q[d0], p0); p1 = MFMA32F8(a1, q[d0], p1);
    }
}
__device__ __forceinline__ float sm_core_scaled(f32x16& p0, f32x16& p1, float& m, float& l, const float C2) {
    float tm = p0[0];
#pragma unroll
    for (int r = 1; r < 16; ++r) tm = fmaxf(tm, p0[r]);
#pragma unroll
    for (int r = 0; r < 16; ++r) tm = fmaxf(tm, p1[r]);
    tm = swapmax(tm);
    const float mn = fmaxf(m, tm);
    const float alpha = __builtin_amdgcn_exp2f((m - mn) * C2);
    m = mn;
    const float mc = -mn * C2;
    float ps = 0.f;
#pragma unroll
    for (int r = 0; r < 16; ++r) { p0[r] = __builtin_amdgcn_exp2f(__builtin_fmaf(p0[r], C2, mc)); ps += p0[r]; }
#pragma unroll
    for (int r = 0; r < 16; ++r) { p1[r] = __builtin_amdgcn_exp2f(__builtin_fmaf(p1[r], C2, mc)); ps += p1[r]; }
    ps = swapsum(ps);
    l = l * alpha + ps;
    return alpha;
}
#endif
#ifdef MLA_PIPE8
struct MlaPtrs { const bf16* Q; const bf16* K; const bf16* V; const bf16* Z; bf16* O; };
__device__ __forceinline__ void mla_mask(f32x16& p0, f32x16& p1, int dq) {
#pragma unroll
    for (int r = 0; r < 16; ++r) { const int c = (r & 3) + 8 * (r >> 2);
        if (c > dq) p0[r] = -__builtin_inff();
        if (c + 32 > dq) p1[r] = -__builtin_inff(); }
}
__device__ __forceinline__ void mla_unit(LAS unsigned char* lds, const MlaPtrs& P, int head, int qb, int tid_in, int wave, int lane_in) {
    int tid = tid_in; asm volatile("" : "+v"(tid)); const int lane = tid & 63; (void)lane_in;
    const int r32 = lane & 31, hi = lane >> 5;
    const int q0 = qb * 256, qw = q0 + wave * 32, tq = qw + r32;
    i64 q[12];
    { const unsigned char* qp = (const unsigned char*)P.Q + (size_t)tq * 3072 + head * 192 + hi * 8;
#pragma unroll
      for (int d0 = 0; d0 < 12; ++d0) q[d0] = *(const GAS i64*)(qp + d0 * 16); }
    const int NT = 4 * (qb + 1);
    const int srow = tid >> 3, sc8 = tid & 7;
    const unsigned char* kg = (const unsigned char*)P.K + (size_t)head * 192 + (size_t)srow * 3072 + sc8 * 8;
    const unsigned char* vg = (const unsigned char*)P.V + ((size_t)head * 128 + (tid >> 2)) * S + (tid & 3) * 16;
    LAS unsigned char* kst = lds + srow * KS8 + sc8 * 8;
    LAS unsigned char* vst = lds + 2 * MLA_KB8 + (tid >> 2) * VS8 + (tid & 3) * 16;
    const LAS unsigned char* kl = lds + r32 * KS8 + hi * 8;
    const LAS unsigned char* vl = lds + 2 * MLA_KB8 + r32 * VS8 + hi * 8;
    u32x2 sk0, sk1, sk2; u32x4 sv0;
#define MLA_LOADK(j) do { const unsigned char* kp_ = kg + (size_t)(j) * (64 * 3072); sk0 = *(const GAS u32x2*)(kp_); sk1 = *(const GAS u32x2*)(kp_ + 64); sk2 = *(const GAS u32x2*)(kp_ + 128); } while (0)
#define MLA_LOADV(j) do { sv0 = *(const GAS u32x4*)(vg + (size_t)(j) * 64); } while (0)
#define MLA_STOREK(b) do { LAS unsigned char* kd_ = kst + (b) * MLA_KB8; *(LAS u32x2*)(kd_) = sk0; *(LAS u32x2*)(kd_ + 64) = sk1; *(LAS u32x2*)(kd_ + 128) = sk2; } while (0)
#define MLA_STOREV(b) do { LAS unsigned char* vd_ = vst + (b) * VB8; *(LAS u32x2*)(vd_) = (u32x2){sv0.x, sv0.y}; *(LAS u32x2*)(vd_ + 8) = (u32x2){sv0.z, sv0.w}; } while (0)
    float m = -1e30f, l = 0.f; f32x16 o[4];
#pragma unroll
    for (int d = 0; d < 4; ++d)
#pragma unroll
        for (int r = 0; r < 16; ++r) o[d][r] = 0.f;
    f32x16 pA0, pA1, pB0, pB1;
    MLA_LOADK(0); MLA_LOADV(0); MLA_STOREK(0); MLA_STOREV(0);
    MLA_LOADK(1);
    __syncthreads();
    qk_tile8<12>(pA0, pA1, kl, q);
    if (63 > qw) mla_mask(pA0, pA1, tq - 4 * hi);
    MLA_STOREK(1);
    if (2 < NT) MLA_LOADK(2);
    MLA_LOADV(1);
    __syncthreads();
#define MLA_SGB1() do { __builtin_amdgcn_sched_group_barrier(0x100, 2, 0); __builtin_amdgcn_sched_group_barrier(0x008, 1, 0); __builtin_amdgcn_sched_group_barrier(0x002, 6, 0); \
        __builtin_amdgcn_sched_group_barrier(0x008, 1, 0); __builtin_amdgcn_sched_group_barrier(0x002, 6, 0); } while (0)
#define MLA_SGB() do { MLA_SGB1(); MLA_SGB1(); MLA_SGB1(); MLA_SGB1(); MLA_SGB1(); MLA_SGB1(); MLA_SGB1(); MLA_SGB1(); MLA_SGB1(); MLA_SGB1(); MLA_SGB1(); MLA_SGB1(); } while (0)
#define MLA_STEP(PX0, PX1, PY0, PY1, j) do { \
        const int kb1_ = 64 * ((j) + 1); \
        const bool a1_ = ((j) + 1 < NT) && (kb1_ <= qw + 31), a0_ = (64 * (j) <= qw + 31); \
        float alpha_ = 1.f; i64 pb_[4]; \
        if (a1_) { \
            __builtin_amdgcn_sched_barrier(0); \
            qk_tile8_free<12>(PY0, PY1, kl + (((j) + 1) & 1) * MLA_KB8, q); \
            alpha_ = sm_core_scaled(PX0, PX1, m, l, QS_MLA); \
            pb_[0] = packp8<0>(PX0); pb_[1] = packp8<1>(PX0); pb_[2] = packp8<0>(PX1); pb_[3] = packp8<1>(PX1); \
            MLA_SGB(); \
            __builtin_amdgcn_sched_barrier(0); \
            if (kb1_ + 63 > qw) mla_mask(PY0, PY1, tq - kb1_ - 4 * hi); \
        } else if (a0_) { \
            alpha_ = sm_core_scaled(PX0, PX1, m, l, QS_MLA); \
            pb_[0] = packp8<0>(PX0); pb_[1] = packp8<1>(PX0); pb_[2] = packp8<0>(PX1); pb_[3] = packp8<1>(PX1); \
        } \
        if (a0_) { \
            if (!__all(alpha_ == 1.f)) { _Pragma("unroll") for (int d_ = 0; d_ < 4; ++d_) _Pragma("unroll") for (int r_ = 0; r_ < 16; ++r_) o[d_][r_] *= alpha_; } \
            pv_tile8(o, pb_, vl + ((j) & 1) * VB8); \
        } \
        if ((j) + 2 < NT) MLA_STOREK((j) & 1); \
        if ((j) + 1 < NT) MLA_STOREV(((j) + 1) & 1); \
        if ((j) + 3 < NT) MLA_LOADK((j) + 3); \
        if ((j) + 2 < NT) MLA_LOADV((j) + 2); \
        __syncthreads(); } while (0)
    for (int j = 0; j < NT; j += 2) {
        MLA_STEP(pA0, pA1, pB0, pB1, j);
        MLA_STEP(pB0, pB1, pA0, pA1, j + 1);
    }
#undef MLA_STEP
#undef MLA_SGB
#undef MLA_SGB1
#undef MLA_LOADK
#undef MLA_LOADV
#undef MLA_STOREK
#undef MLA_STOREV
    const float inv = (1.f / 256.f) / l;
    const bf16* zp = P.Z + (size_t)tq * 2048 + head * 128 + 4 * hi;
    bf16* op = P.O + (size_t)tq * 4096 + head * 128 + 4 * hi;
#pragma unroll
    for (int d0 = 0; d0 < 4; ++d0)
#pragma unroll
        for (int rg = 0; rg < 4; ++rg) { const int dim = 32 * d0 + 8 * rg;
            const u32x2 z = *(const GAS u32x2*)(zp + dim);
            u32x2 w; w.x = pk2(o[d0][4 * rg + 0] * inv * bflo(z.x), o[d0][4 * rg + 1] * inv * bfhi(z.x)); w.y = pk2(o[d0][4 * rg + 2] * inv * bflo(z.y), o[d0][4 * rg + 3] * inv * bfhi(z.y));
            *(GAS u32x2*)(op + dim) = w; }
}
#elif defined(MLA_PIPE)
struct MlaPtrs { const bf16* Q; const bf16* K; const bf16* V; const bf16* Z; bf16* O; };
__device__ __forceinline__ void mla_mask(f32x16& p0, f32x16& p1, int dq) {
#pragma unroll
    for (int r = 0; r < 16; ++r) { const int c = (r & 3) + 8 * (r >> 2);
        if (c > dq) p0[r] = -__builtin_inff();
        if (c + 32 > dq) p1[r] = -__builtin_inff(); }
}
__device__ __forceinline__ void mla_unit(LAS unsigned char* lds, const MlaPtrs& P, int head, int qb, int tid_in, int wave, int lane_in) {
    int tid = tid_in; asm volatile("" : "+v"(tid)); const int lane = tid & 63; (void)lane_in;
    const int r32 = lane & 31, hi = lane >> 5;
    const int q0 = qb * 256, qw = q0 + wave * 32, tq = qw + r32;
    bf16x8 q[8];
    LAS unsigned char* ql = lds + MLA_QL + wave * 4096 + lane * 16;
    { const bf16* qp = P.Q + (size_t)tq * 3072 + head * 192 + hi * 8;
#pragma unroll
      for (int d0 = 0; d0 < 8; ++d0) q[d0] = *(const GAS bf16x8*)(qp + d0 * 16);
#pragma unroll
      for (int d0 = 8; d0 < 12; ++d0) *(LAS bf16x8*)(ql + (d0 - 8) * 1024) = *(const GAS bf16x8*)(qp + d0 * 16); }
    const int NT = 4 * (qb + 1);
    const int srow = tid >> 3, sc8 = tid & 7;
    const unsigned char* kg = (const unsigned char*)P.K + (size_t)head * 384 + (size_t)srow * 6144 + sc8 * 16;
    const unsigned char* vg = (const unsigned char*)P.V + (size_t)head * 256 + (size_t)srow * 4096 + sc8 * 16;
    LAS unsigned char* kst = lds + srow * KS_M + sc8 * 16;
    LAS unsigned char* vst = lds + 2 * MLA_KB + srow * VS + sc8 * 16;
    const LAS unsigned char* kl = lds + r32 * KS_M + hi * 16;
    const LAS unsigned char* vl = lds + 2 * MLA_KB + (4 * hi + ((lane & 15) >> 2)) * VS + (16 * ((lane >> 4) & 1) + 4 * (lane & 3)) * 2;
    u32x4 sk0, sk1, sk2, sv0, sv1;
#define MLA_LOADK(j) do { const unsigned char* kp_ = kg + (size_t)(j) * (64 * 6144); sk0 = *(const GAS u32x4*)(kp_); sk1 = *(const GAS u32x4*)(kp_ + 128); sk2 = *(const GAS u32x4*)(kp_ + 256); } while (0)
#define MLA_LOADV(j) do { const unsigned char* vp_ = vg + (size_t)(j) * (64 * 4096); sv0 = *(const GAS u32x4*)(vp_); sv1 = *(const GAS u32x4*)(vp_ + 128); } while (0)
#define MLA_STOREK(b) do { LAS unsigned char* kd_ = kst + (b) * MLA_KB; *(LAS u32x4*)(kd_) = sk0; *(LAS u32x4*)(kd_ + 128) = sk1; *(LAS u32x4*)(kd_ + 256) = sk2; } while (0)
#define MLA_STOREV(b) do { LAS unsigned char* vd_ = vst + (b) * VB; *(LAS u32x4*)(vd_) = sv0; *(LAS u32x4*)(vd_ + 128) = sv1; } while (0)
    float m = -1e30f, l = 0.f; f32x16 o[4];
#pragma unroll
    for (int d = 0; d < 4; ++d)
#pragma unroll
        for (int r = 0; r < 16; ++r) o[d][r] = 0.f;
    f32x16 pA0, pA1, pB0, pB1;
    MLA_LOADK(0); MLA_LOADV(0); MLA_STOREK(0); MLA_STOREV(0);
    MLA_LOADK(1);
    __syncthreads();
    qk_tile_free<12, 8, KS_M>(pA0, pA1, kl, q, ql);
    if (63 > qw) mla_mask(pA0, pA1, tq - 4 * hi);
    MLA_STOREK(1);
    if (2 < NT) MLA_LOADK(2);
    MLA_LOADV(1);
    __syncthreads();
#define MLA_SGB1(NR) do { __builtin_amdgcn_sched_group_barrier(0x100, NR, 0); __builtin_amdgcn_sched_group_barrier(0x008, 1, 0); __builtin_amdgcn_sched_group_barrier(0x002, 6, 0); \
        __builtin_amdgcn_sched_group_barrier(0x008, 1, 0); __builtin_amdgcn_sched_group_barrier(0x002, 6, 0); } while (0)
#define MLA_SGB() do { MLA_SGB1(2); MLA_SGB1(2); MLA_SGB1(2); MLA_SGB1(2); MLA_SGB1(2); MLA_SGB1(2); MLA_SGB1(2); MLA_SGB1(2); MLA_SGB1(3); MLA_SGB1(3); MLA_SGB1(3); MLA_SGB1(3); } while (0)
#define MLA_STEP(PX0, PX1, PY0, PY1, j) do { \
        const int kb1_ = 64 * ((j) + 1); \
        const bool a1_ = ((j) + 1 < NT) && (kb1_ <= qw + 31), a0_ = (64 * (j) <= qw + 31); \
        float alpha_ = 1.f; bf16x8 pb_[4]; \
        if (a1_) { \
            __builtin_amdgcn_sched_barrier(0); \
            qk_tile_free<12, 8, KS_M>(PY0, PY1, kl + (((j) + 1) & 1) * MLA_KB, q, ql); \
            alpha_ = sm_core(PX0, PX1, m, l); \
            pb_[0] = packp<0>(PX0); pb_[1] = packp<1>(PX0); pb_[2] = packp<0>(PX1); pb_[3] = packp<1>(PX1); \
            MLA_SGB(); \
            __builtin_amdgcn_sched_barrier(0); \
            if (kb1_ + 63 > qw) mla_mask(PY0, PY1, tq - kb1_ - 4 * hi); \
        } else if (a0_) { \
            alpha_ = sm_core(PX0, PX1, m, l); \
            pb_[0] = packp<0>(PX0); pb_[1] = packp<1>(PX0); pb_[2] = packp<0>(PX1); pb_[3] = packp<1>(PX1); \
        } \
        if (a0_) { \
            if (!__all(alpha_ == 1.f)) { _Pragma("unroll") for (int d_ = 0; d_ < 4; ++d_) _Pragma("unroll") for (int r_ = 0; r_ < 16; ++r_) o[d_][r_] *= alpha_; } \
            pv_tile(o, pb_, vl + ((j) & 1) * VB); \
        } \
        if ((j) + 2 < NT) MLA_STOREK((j) & 1); \
        if ((j) + 1 < NT) MLA_STOREV(((j) + 1) & 1); \
        if ((j) + 3 < NT) MLA_LOADK((j) + 3); \
        if ((j) + 2 < NT) MLA_LOADV((j) + 2); \
        __syncthreads(); } while (0)
    for (int j = 0; j < NT; j += 2) {
        MLA_STEP(pA0, pA1, pB0, pB1, j);
        MLA_STEP(pB0, pB1, pA0, pA1, j + 1);
    }
#undef MLA_STEP
#undef MLA_SGB
#undef MLA_SGB1
#undef MLA_LOADK
#undef MLA_LOADV
#undef MLA_STOREK
#undef MLA_STOREV
    const float inv = 1.f / l;
    const bf16* zp = P.Z + (size_t)tq * 2048 + head * 128 + 4 * hi;
    bf16* op = P.O + (size_t)tq * 4096 + head * 128 + 4 * hi;
#pragma unroll
    for (int d0 = 0; d0 < 4; ++d0)
#pragma unroll
        for (int rg = 0; rg < 4; ++rg) { const int dim = 32 * d0 + 8 * rg;
            const u32x2 z = *(const GAS u32x2*)(zp + dim);
            u32x2 w; w.x = pk2(o[d0][4 * rg + 0] * inv * bflo(z.x), o[d0][4 * rg + 1] * inv * bfhi(z.x)); w.y = pk2(o[d0][4 * rg + 2] * inv * bflo(z.y), o[d0][4 * rg + 3] * inv * bfhi(z.y));
            *(GAS u32x2*)(op + dim) = w; }
}

#else
#if defined(MLA_MXQ)
struct MlaPtrs { const bf16* Q; const bf16* K; const bf16* V; const bf16* Z; bf16* O; };
constexpr int VBQ = 160 * VSX;
static_assert(2 * MLA_KBX + 2 * VBQ <= 131072, "MLA mxq LDS map");
__device__ __forceinline__ void mla_maskq(f32x16& p0, f32x16& p1, int dq) {
#pragma unroll
    for (int r = 0; r < 16; ++r) { const int c = (r & 3) + 8 * (r >> 2);
        if (c > dq) p0[r] = -__builtin_inff();
        if (c + 32 > dq) p1[r] = -__builtin_inff(); }
}
__device__ __forceinline__ float mla_rowmaxq(const f32x16& p0, const f32x16& p1) {
    float tm = p0[0];
#pragma unroll
    for (int r = 1; r < 16; ++r) tm = fmaxf(tm, p0[r]);
#pragma unroll
    for (int r = 0; r < 16; ++r) tm = fmaxf(tm, p1[r]);
    return swapmax(tm);
}
__device__ __forceinline__ void mla_unit(LAS unsigned char* lds, const MlaPtrs& P, int head, int qb, int tid_in, int wave, int lane_in) {
    int tid = tid_in; asm volatile("" : "+v"(tid)); const int lane = tid & 63; (void)lane_in;
    const int r32 = lane & 31, hi = lane >> 5;
    const int q0 = qb * 256, qw = q0 + wave * 32, tq = qw + r32;
    i32x8 q[3];
    { const unsigned char* qp = (const unsigned char*)P.Q + (size_t)tq * 3072 + head * 192 + hi * 32;
#pragma unroll
      for (int s = 0; s < 3; ++s) { const u32x4 a = *(const GAS u32x4*)(qp + 64 * s), b = *(const GAS u32x4*)(qp + 64 * s + 16);
          q[s] = (i32x8){(int)a.x, (int)a.y, (int)a.z, (int)a.w, (int)b.x, (int)b.y, (int)b.z, (int)b.w}; } }
    const int NT = 4 * (qb + 1);
    const int srow = tid >> 3, sc8 = tid & 7;
    const unsigned char* kg = (const unsigned char*)P.K + (size_t)head * 192 + (size_t)srow * 3072 + sc8 * 8;
    const unsigned char* vg = (const unsigned char*)P.V + ((size_t)head * 128 + (tid >> 2)) * S + (tid & 3) * 16;
    LAS unsigned char* kst = lds + srow * KSX + sc8 * 8;
    LAS unsigned char* vst = lds + 2 * MLA_KBX + (tid >> 2) * VSX + (tid & 3) * 16;
    const LAS unsigned char* kl = lds + r32 * KSX + hi * 32;
    const LAS unsigned char* vl = lds + 2 * MLA_KBX + r32 * VSX + hi * 32;
    u32x2 sk0, sk1, sk2; u32x4 sv0;
#define MLA_LOADK(j) do { const unsigned char* kp_ = kg + (size_t)(j) * (64 * 3072); sk0 = *(const GAS u32x2*)(kp_); sk1 = *(const GAS u32x2*)(kp_ + 64); sk2 = *(const GAS u32x2*)(kp_ + 128); } while (0)
#define MLA_LOADV(j) do { sv0 = *(const GAS u32x4*)(vg + (size_t)(j) * 64); } while (0)
#define MLA_STOREK(b) do { LAS unsigned char* kd_ = kst + (b) * MLA_KBX; *(LAS u32x2*)(kd_) = sk0; *(LAS u32x2*)(kd_ + 64) = sk1; *(LAS u32x2*)(kd_ + 128) = sk2; } while (0)
#define MLA_STOREV(b) do { LAS unsigned char* vd_ = vst + (b) * VBQ; *(LAS u32x2*)(vd_) = (u32x2){sv0.x, sv0.y}; *(LAS u32x2*)(vd_ + 8) = (u32x2){sv0.z, sv0.w}; } while (0)
    f32x16 o[5], mref;
#pragma unroll
    for (int d = 0; d < 5; ++d)
#pragma unroll
        for (int r = 0; r < 16; ++r) o[d][r] = 0.f;
#pragma unroll
    for (int r = 0; r < 16; ++r) mref[r] = MXL_REF;
    f32x16 p0, p1;
    if (tid < 256) { const int slot = tid >> 7, row = (tid >> 2) & 31, ch = tid & 3; const unsigned v1 = (row == 0 || row == 4) ? 0x38383838u : 0u;
        *(LAS u32x4*)(lds + 2 * MLA_KBX + slot * VBQ + (128 + row) * VSX + ch * 16) = (u32x4){v1, v1, v1, v1}; }
    MLA_LOADK(0); MLA_LOADV(0); MLA_STOREK(0); MLA_STOREV(0);
    MLA_LOADK(1);
    __syncthreads();
    qk_tilexl(p0, p1, mref, kl, q);
    if (63 > qw) mla_maskq(p0, p1, tq - 4 * hi);
    { const float dlt = mla_rowmaxq(p0, p1) - MXL_REF;
#pragma unroll
      for (int r = 0; r < 16; ++r) { p0[r] -= dlt; p1[r] -= dlt; mref[r] -= dlt; } }
    i32x8 pbA = byte_packx(p0, p1), pbB = pbA;
    MLA_STOREK(1);
    if (2 < NT) MLA_LOADK(2);
    MLA_LOADV(1);
    __syncthreads();
    asm volatile("" : "+v"(q[0]), "+v"(q[1]), "+v"(q[2]));
    int sc1_ = 0x7f7f7f7f; asm volatile("" : "+v"(sc1_));
#define SB() __builtin_amdgcn_sched_barrier(0)
#define MFMA_T(acc, a, b) asm volatile("s_nop 1\n\tv_mfma_scale_f32_32x32x64_f8f6f4 %0, %1, %2, %0, %3, %3 op_sel_hi:[0,0,0]" : "+v"(acc) : "v"(a), "v"(b), "v"(sc1_))
#define MFMA_C(acc, a, b, c) asm volatile("s_nop 1\n\tv_mfma_scale_f32_32x32x64_f8f6f4 %0, %1, %2, %3, %4, %4 op_sel_hi:[0,0,0]" : "=&v"(acc) : "v"(a), "v"(b), "v"(c), "v"(sc1_))
#define CVT8(P, R0, PB, W0) do { unsigned w_ = __builtin_amdgcn_cvt_pk_u8_f32(P[(R0) + 0], 0, 0u); w_ = __builtin_amdgcn_cvt_pk_u8_f32(P[(R0) + 1], 1, w_); w_ = __builtin_amdgcn_cvt_pk_u8_f32(P[(R0) + 2], 2, w_); \
        w_ = __builtin_amdgcn_cvt_pk_u8_f32(P[(R0) + 3], 3, w_); PB[(W0)] = (int)w_; \
        w_ = __builtin_amdgcn_cvt_pk_u8_f32(P[(R0) + 4], 0, 0u); w_ = __builtin_amdgcn_cvt_pk_u8_f32(P[(R0) + 5], 1, w_); w_ = __builtin_amdgcn_cvt_pk_u8_f32(P[(R0) + 6], 2, w_); \
        w_ = __builtin_amdgcn_cvt_pk_u8_f32(P[(R0) + 7], 3, w_); PB[(W0) + 1] = (int)w_; } while (0)
#define MLA_STEP(PBX, PBY, j) do { \
        const int kb1_ = 64 * ((j) + 1); \
        if (64 * (j) <= qw + 31) { \
            const LAS unsigned char* kn_ = kl + (((j) + 1) & 1) * MLA_KBX; const LAS unsigned char* vj_ = vl + ((j) & 1) * VBQ; \
            SB(); \
            i32x8 a0_f = ldsx(kn_), a1_f = ldsx(kn_ + 32 * KSX); \
            SB(); MFMA_C(p0, a0_f, q[0], mref); SB(); \
            a0_f = ldsx(kn_ + 64); \
            SB(); MFMA_C(p1, a1_f, q[0], mref); SB(); \
            a1_f = ldsx(kn_ + 32 * KSX + 64); \
            SB(); MFMA_T(p0, a0_f, q[1]); SB(); \
            a0_f = ldsx(kn_ + 128); \
            SB(); MFMA_T(p1, a1_f, q[1]); SB(); \
            a1_f = ldsx(kn_ + 32 * KSX + 128); \
            SB(); MFMA_T(p0, a0_f, q[2]); SB(); \
            a0_f = ldsx(vj_ + 128 * VSX); \
            SB(); MFMA_T(p1, a1_f, q[2]); SB(); \
            a1_f = ldsx(vj_); \
            SB(); MFMA_T(o[4], a0_f, PBX); SB(); \
            a0_f = ldsx(vj_ + 32 * VSX); \
            SB(); MFMA_T(o[0], a1_f, PBX); SB(); \
            a1_f = ldsx(vj_ + 64 * VSX); \
            float tmx_ = p0[0]; _Pragma("unroll") for (int r_ = 1; r_ < 16; ++r_) tmx_ = fmaxf(tmx_, p0[r_]); \
            CVT8(p0, 0, PBY, 0); CVT8(p0, 8, PBY, 2); \
            SB(); MFMA_T(o[1], a0_f, PBX); SB(); \
            a0_f = ldsx(vj_ + 96 * VSX); \
            _Pragma("unroll") for (int r_ = 0; r_ < 16; ++r_) tmx_ = fmaxf(tmx_, p1[r_]); \
            CVT8(p1, 0, PBY, 4); \
            SB(); MFMA_T(o[2], a1_f, PBX); SB(); \
            CVT8(p1, 8, PBY, 6); tmx_ = swapmax(tmx_); \
            SB(); MFMA_T(o[3], a0_f, PBX); SB(); \
            const bool diag_ = kb1_ + 63 > qw; \
            if (diag_ || !__all(tmx_ <= MXL_T)) {               \
                asm volatile("s_nop 15\n\ts_nop 15\n\ts_nop 15" ::: "memory");     \
                if (diag_) mla_maskq(p0, p1, tq - kb1_ - 4 * hi); \
                const float dlt_ = fmaxf(mla_rowmaxq(p0, p1) - MXL_REF, 0.f); const float alpha_ = __builtin_amdgcn_exp2f(-0.125f * dlt_); \
                _Pragma("unroll") for (int r_ = 0; r_ < 16; ++r_) { p0[r_] -= dlt_; p1[r_] -= dlt_; mref[r_] -= dlt_; } \
                _Pragma("unroll") for (int d_ = 0; d_ < 5; ++d_) _Pragma("unroll") for (int r_ = 0; r_ < 16; ++r_) o[d_][r_] *= alpha_; \
                PBY = byte_packx(p0, p1); } \
        } \
        if ((j) + 2 < NT) MLA_STOREK((j) & 1); \
        if ((j) + 1 < NT) MLA_STOREV(((j) + 1) & 1); \
        if ((j) + 3 < NT) MLA_LOADK((j) + 3); \
        if ((j) + 2 < NT) MLA_LOADV((j) + 2); \
        __syncthreads(); } while (0)
    for (int j = 0; j < NT; j += 2) {
        MLA_STEP(pbA, pbB, j);
        MLA_STEP(pbB, pbA, j + 1);
    }
    asm volatile("s_nop 15\n\ts_nop 15" ::: "memory");
#undef MLA_STEP
#undef CVT8
#undef MFMA_T
#undef MFMA_C
#undef SB
#undef MLA_LOADK
#undef MLA_LOADV
#undef MLA_STOREK
#undef MLA_STOREV
    const float inv = 1.f / o[4][0];
    const bf16* zp = P.Z + (size_t)tq * 2048 + head * 128 + 4 * hi;
    bf16* op = P.O + (size_t)tq * 4096 + head * 128 + 4 * hi;
#pragma unroll
    for (int d0 = 0; d0 < 4; ++d0)
#pragma unroll
        for (int rg = 0; rg < 4; ++rg) { const int dim = 32 * d0 + 8 * rg;
            const u32x2 z = *(const GAS u32x2*)(zp + dim);
            u32x2 w; w.x = pk2(o[d0][4 * rg + 0] * inv * bflo(z.x), o[d0][4 * rg + 1] * inv * bfhi(z.x)); w.y = pk2(o[d0][4 * rg + 2] * inv * bflo(z.y), o[d0][4 * rg + 3] * inv * bfhi(z.y));
            *(GAS u32x2*)(op + dim) = w; }
}

#elif defined(MLA_BIGX)
struct MlaPtrs { const bf16* Q; const bf16* K; const bf16* V; const bf16* Z; bf16* O; };
__device__ __forceinline__ void mla_unit(LAS unsigned char* lds, const MlaPtrs& P, int head, int qb, int tid_in, int wave, int lane_in) {
    int tid = tid_in; asm volatile("" : "+v"(tid)); const int lane = tid & 63; (void)lane_in;
    const int r32 = lane & 31, hi = lane >> 5;
    const int q0 = qb * 256, qw = q0 + wave * 32, tq = qw + r32;
    i32x8 q[3];
    { const unsigned char* qp = (const unsigned char*)P.Q + (size_t)tq * 3072 + head * 192 + hi * 32;
#pragma unroll
      for (int s = 0; s < 3; ++s) { const u32x4 a = *(const GAS u32x4*)(qp + 64 * s), b = *(const GAS u32x4*)(qp + 64 * s + 16);
          q[s] = (i32x8){(int)a.x, (int)a.y, (int)a.z, (int)a.w, (int)b.x, (int)b.y, (int)b.z, (int)b.w}; } }
    const int NT = 4 * (qb + 1), NTB = NT / 2;
    constexpr int VSB = 144, VBB = 128 * VSB, KBB = 128 * KSX;
    static_assert(2 * KBB + 3 * VBB <= 131072, "MLA big-tile LDS map");
    const int srow = tid >> 3, sc8 = tid & 7;
    const unsigned char* kg = (const unsigned char*)P.K + (size_t)head * 192 + (size_t)srow * 3072 + sc8 * 8;
    const unsigned char* vg = (const unsigned char*)P.V + ((size_t)head * 128 + (tid >> 2)) * S + (tid & 3) * 32;
    LAS unsigned char* kst = lds + srow * KSX + sc8 * 8;
    LAS unsigned char* vst = lds + 2 * KBB + (tid >> 2) * VSB + (tid & 3) * 32;
    const LAS unsigned char* kl = lds + r32 * KSX + hi * 32;
    const LAS unsigned char* vl = lds + 2 * KBB + r32 * VSB + hi * 32;
    u32x2 sk0, sk1, sk2, sk3, sk4, sk5; u32x4 sv0, sv1;
#define MLA_LOAD(J) do { const unsigned char* kp_ = kg + (size_t)(J) * (128 * 3072); const unsigned char* vp_ = vg + (size_t)(J) * 128; \
        sk0 = *(const GAS u32x2*)(kp_); sk1 = *(const GAS u32x2*)(kp_ + 64); sk2 = *(const GAS u32x2*)(kp_ + 128); \
        sk3 = *(const GAS u32x2*)(kp_ + 64 * 3072); sk4 = *(const GAS u32x2*)(kp_ + 64 * 3072 + 64); sk5 = *(const GAS u32x2*)(kp_ + 64 * 3072 + 128); \
        sv0 = *(const GAS u32x4*)(vp_); sv1 = *(const GAS u32x4*)(vp_ + 16); } while (0)
#define MLA_STORE(b, vb) do { LAS unsigned char* kd_ = kst + (b) * KBB; LAS unsigned char* vd_ = vst + (vb) * VBB; \
        *(LAS u32x2*)(kd_) = sk0; *(LAS u32x2*)(kd_ + 64) = sk1; *(LAS u32x2*)(kd_ + 128) = sk2; \
        *(LAS u32x2*)(kd_ + 64 * KSX) = sk3; *(LAS u32x2*)(kd_ + 64 * KSX + 64) = sk4; *(LAS u32x2*)(kd_ + 64 * KSX + 128) = sk5; \
        *(LAS u32x2*)(vd_) = (u32x2){sv0.x, sv0.y}; *(LAS u32x2*)(vd_ + 8) = (u32x2){sv0.z, sv0.w}; *(LAS u32x2*)(vd_ + 16) = (u32x2){sv1.x, sv1.y}; *(LAS u32x2*)(vd_ + 24) = (u32x2){sv1.z, sv1.w}; } while (0)
    MLA_LOAD(0); MLA_STORE(0, 0);
    __syncthreads();
    asm volatile("" : "+v"(q[0]), "+v"(q[1]), "+v"(q[2]));
    f32x16 o[5], mref;
#pragma unroll
    for (int d = 0; d < 5; ++d)
#pragma unroll
        for (int r = 0; r < 16; ++r) o[d][r] = 0.f;
#pragma unroll
    for (int r = 0; r < 16; ++r) mref[r] = MXL_REF;
    const int one8 = (r32 == 0 || r32 == 4) ? 0x38383838 : 0;
    const i32x8 ones = {one8, one8, one8, one8, one8, one8, one8, one8};
    const bool trail = wave >= 4;
    i32x8 pb = {};
    int vb_cur = 0, vb_prev = 2;
    for (int J = 0; J < NTB; ++J) {
        int vb_next = vb_cur + 1; if (vb_next == 3) vb_next = 0;
        if (J + 1 < NTB) MLA_LOAD(J + 1);
#pragma unroll
        for (int sub = 0; sub < 2; ++sub) {
        const int j = 2 * J + sub, kb = 64 * j;
        if (trail && j > 0 && kb - 64 <= qw + 31) pv_tilexl<VSB>(o, pb, ones, vl + (sub == 0 ? vb_prev * VBB + 64 : vb_cur * VBB));
        if (kb <= qw + 31) {
            f32x16 p0, p1;
            qk_tilexl(p0, p1, mref, kl + (J & 1) * KBB + sub * 64 * KSX, q);
            if (kb + 63 > qw) {
                const int dq = tq - kb - 4 * hi;
#pragma unroll
                for (int r = 0; r < 16; ++r) { const int c = (r & 3) + 8 * (r >> 2);
                    if (c > dq) p0[r] = -__builtin_inff();
                    if (c + 32 > dq) p1[r] = -__builtin_inff(); }
            }
            float tm = p0[0];
#pragma unroll
            for (int r = 1; r < 16; ++r) tm = fmaxf(tm, p0[r]);
#pragma unroll
            for (int r = 0; r < 16; ++r) tm = fmaxf(tm, p1[r]);
            tm = swapmax(tm);
            if (j == 0 || !__all(tm <= MXL_T)) {
                const float dlt = (j == 0) ? tm - MXL_REF : fmaxf(tm - MXL_REF, 0.f);
                const float alpha = __builtin_amdgcn_exp2f(-0.125f * dlt);
#pragma unroll
                for (int r = 0; r < 16; ++r) { p0[r] -= dlt; p1[r] -= dlt; mref[r] -= dlt; }
                if (j > 0) {
#pragma unroll
                    for (int d = 0; d < 5; ++d)
#pragma unroll
                        for (int r = 0; r < 16; ++r) o[d][r] *= alpha;
                }
            }
            pb = byte_packx(p0, p1);
            if (!trail) pv_tilexl<VSB>(o, pb, ones, vl + vb_cur * VBB + sub * 64);
        }
        }
        if (J + 1 < NTB) MLA_STORE((J + 1) & 1, vb_next);
        __syncthreads();
        vb_prev = vb_cur; vb_cur = vb_next;
    }
    if (trail && 64 * (NT - 1) <= qw + 31) pv_tilexl<VSB>(o, pb, ones, vl + vb_prev * VBB + 64);
    __syncthreads();
#undef MLA_LOAD
#undef MLA_STORE
    const float inv = 1.f / o[4][0];
    const bf16* zp = P.Z + (size_t)tq * 2048 + head * 128 + 4 * hi;
    bf16* op = P.O + (size_t)tq * 4096 + head * 128 + 4 * hi;
#pragma unroll
    for (int d0 = 0; d0 < 4; ++d0)
#pragma unroll
        for (int rg = 0; rg < 4; ++rg) { const int dim = 32 * d0 + 8 * rg;
            const u32x2 z = *(const GAS u32x2*)(zp + dim);
            u32x2 w; w.x = pk2(o[d0][4 * rg + 0] * inv * bflo(z.x), o[d0][4 * rg + 1] * inv * bfhi(z.x)); w.y = pk2(o[d0][4 * rg + 2] * inv * bflo(z.y), o[d0][4 * rg + 3] * inv * bfhi(z.y));
            *(GAS u32x2*)(op + dim) = w; }
}

#elif defined(MLA_MXL)
struct MlaPtrs { const bf16* Q; const bf16* K; const bf16* V; const bf16* Z; bf16* O; };
__device__ __forceinline__ void mla_unit(LAS unsigned char* lds, const MlaPtrs& P, int head, int qb, int tid_in, int wave, int lane_in) {
    int tid = tid_in; asm volatile("" : "+v"(tid)); const int lane = tid & 63; (void)lane_in;
    const int r32 = lane & 31, hi = lane >> 5;
    const int q0 = qb * 256, qw = q0 + wave * 32, tq = qw + r32;
    i32x8 q[3];
    { const unsigned char* qp = (const unsigned char*)P.Q + (size_t)tq * 3072 + head * 192 + hi * 32;
#pragma unroll
      for (int s = 0; s < 3; ++s) { const u32x4 a = *(const GAS u32x4*)(qp + 64 * s), b = *(const GAS u32x4*)(qp + 64 * s + 16);
          q[s] = (i32x8){(int)a.x, (int)a.y, (int)a.z, (int)a.w, (int)b.x, (int)b.y, (int)b.z, (int)b.w}; } }
    const int NT = 4 * (qb + 1);
    const int srow = tid >> 3, sc8 = tid & 7;
    const unsigned char* kg = (const unsigned char*)P.K + (size_t)head * 192 + (size_t)srow * 3072 + sc8 * 8;
    const unsigned char* vg = (const unsigned char*)P.V + ((size_t)head * 128 + (tid >> 2)) * S + (tid & 3) * 16;
    LAS unsigned char* kst = lds + srow * KSX + sc8 * 8;
    LAS unsigned char* vst = lds + 2 * MLA_KBX + (tid >> 2) * VSX + (tid & 3) * 16;
    const LAS unsigned char* kl = lds + r32 * KSX + hi * 32;
    const LAS unsigned char* vl = lds + 2 * MLA_KBX + r32 * VSX + hi * 32;
    u32x2 sk0, sk1, sk2; u32x4 sv0;
#define MLA_LOAD(j) do { const unsigned char* kp_ = kg + (size_t)(j) * (64 * 3072); const unsigned char* vp_ = vg + (size_t)(j) * 64; \
        sk0 = *(const GAS u32x2*)(kp_); sk1 = *(const GAS u32x2*)(kp_ + 64); sk2 = *(const GAS u32x2*)(kp_ + 128); sv0 = *(const GAS u32x4*)(vp_); } while (0)
#define MLA_STORE(b, vb) do { LAS unsigned char* kd_ = kst + (b) * MLA_KBX; LAS unsigned char* vd_ = vst + (vb) * VBX; \
        *(LAS u32x2*)(kd_) = sk0; *(LAS u32x2*)(kd_ + 64) = sk1; *(LAS u32x2*)(kd_ + 128) = sk2; *(LAS u32x2*)(vd_) = (u32x2){sv0.x, sv0.y}; *(LAS u32x2*)(vd_ + 8) = (u32x2){sv0.z, sv0.w}; } while (0)
    MLA_LOAD(0); MLA_STORE(0, 0);
    __syncthreads();
    asm volatile("" : "+v"(q[0]), "+v"(q[1]), "+v"(q[2]));
    f32x16 o[5], mref;
#pragma unroll
    for (int d = 0; d < 5; ++d)
#pragma unroll
        for (int r = 0; r < 16; ++r) o[d][r] = 0.f;
#pragma unroll
    for (int r = 0; r < 16; ++r) mref[r] = MXL_REF;
    const int one8 = (r32 == 0 || r32 == 4) ? 0x38383838 : 0;
    const i32x8 ones = {one8, one8, one8, one8, one8, one8, one8, one8};
    const bool trail = wave >= 4;
    i32x8 pb = {}, fa = {}, fb = {};
    int vb_cur = 0, vb_prev = 2;
    for (int j = 0; j < NT; ++j) {
        const int kb = 64 * j;
        int vb_next = vb_cur + 1; if (vb_next == 3) vb_next = 0;
        if (j + 1 < NT) MLA_LOAD(j + 1);
        if (trail && j > 0 && kb - 64 <= qw + 31) pv_tilexl_pre(o, pb, ones, vl + vb_prev * VBX, fa, fb);
        if (kb <= qw + 31) {
            f32x16 p0, p1;
            qk_tilexl(p0, p1, mref, kl + (j & 1) * MLA_KBX, q);
            fa = ldsx(vl + vb_cur * VBX); fb = ldsx(vl + vb_cur * VBX + 32 * VSX);
            __builtin_amdgcn_sched_barrier(0);
            if (kb + 63 > qw) {
                const int dq = tq - kb - 4 * hi;
#pragma unroll
                for (int r = 0; r < 16; ++r) { const int c = (r & 3) + 8 * (r >> 2);
                    if (c > dq) p0[r] = -__builtin_inff();
                    if (c + 32 > dq) p1[r] = -__builtin_inff(); }
            }
            float tm = p0[0];
#pragma unroll
            for (int r = 1; r < 16; ++r) tm = fmaxf(tm, p0[r]);
#pragma unroll
            for (int r = 0; r < 16; ++r) tm = fmaxf(tm, p1[r]);
            tm = swapmax(tm);
            if (j == 0 || !__all(tm <= MXL_T)) {
#ifdef MLA_MXU
                const float dlt = (j == 0) ? tm - MXL_REF : fmaxf(tm - MXL_REF, 0.f);
                const float alpha = __builtin_amdgcn_exp2f(-0.125f * dlt);
#else
                const float dlt = (j == 0) ? tm : fmaxf(tm, 0.f);
                const float alpha = __builtin_amdgcn_exp2f(-dlt);
#endif
#pragma unroll
                for (int r = 0; r < 16; ++r) { p0[r] -= dlt; p1[r] -= dlt; mref[r] -= dlt; }
                if (j > 0) {
#pragma unroll
                    for (int d = 0; d < 5; ++d)
#pragma unroll
                        for (int r = 0; r < 16; ++r) o[d][r] *= alpha;
                }
            }
#ifdef MLA_MXU
            pb = byte_packx(p0, p1);
#else
            pb = exp_packx(p0, p1, one8);
#endif
            if (!trail) pv_tilexl_pre(o, pb, ones, vl + vb_cur * VBX, fa, fb);
        }
        if (j + 1 < NT) MLA_STORE((j + 1) & 1, vb_next);
        __syncthreads();
        vb_prev = vb_cur; vb_cur = vb_next;
    }
    if (trail && 64 * (NT - 1) <= qw + 31) pv_tilexl_pre(o, pb, ones, vl + vb_prev * VBX, fa, fb);
    __syncthreads();
#undef MLA_LOAD
#undef MLA_STORE
    const bf16* zp = P.Z + (size_t)tq * 2048 + head * 128 + 4 * hi;
#ifdef OUT_F8
    const float inv = 16.f / o[4][0];
    unsigned char* op8 = (unsigned char*)P.O + (size_t)tq * 8192 + head * 128 + 4 * hi;
#pragma unroll
    for (int d0 = 0; d0 < 4; ++d0)
#pragma unroll
        for (int rg = 0; rg < 4; ++rg) { const int dim = 32 * d0 + 8 * rg;
            const u32x2 z = *(const GAS u32x2*)(zp + dim);
            int w = __builtin_amdgcn_cvt_pk_fp8_f32(o[d0][4 * rg + 0] * inv * bflo(z.x), o[d0][4 * rg + 1] * inv * bfhi(z.x), 0, false);
            w = __builtin_amdgcn_cvt_pk_fp8_f32(o[d0][4 * rg + 2] * inv * bflo(z.y), o[d0][4 * rg + 3] * inv * bfhi(z.y), w, true);
            *(GAS unsigned*)(op8 + dim) = (unsigned)w; }
#else
    const float inv = 1.f / o[4][0];
    bf16* op = P.O + (size_t)tq * 4096 + head * 128 + 4 * hi;
#pragma unroll
    for (int d0 = 0; d0 < 4; ++d0)
#pragma unroll
        for (int rg = 0; rg < 4; ++rg) { const int dim = 32 * d0 + 8 * rg;
            const u32x2 z = *(const GAS u32x2*)(zp + dim);
            u32x2 w; w.x = pk2(o[d0][4 * rg + 0] * inv * bflo(z.x), o[d0][4 * rg + 1] * inv * bfhi(z.x)); w.y = pk2(o[d0][4 * rg + 2] * inv * bflo(z.y), o[d0][4 * rg + 3] * inv * bfhi(z.y));
            *(GAS u32x2*)(op + dim) = w; }
#endif
}

#elif defined(MLA_MXP)
struct MlaPtrs { const bf16* Q; const bf16* K; const bf16* V; const bf16* Z; bf16* O; };
__device__ __forceinline__ void mla_maskx(f32x16& p0, f32x16& p1, int dq) {
#pragma unroll
    for (int r = 0; r < 16; ++r) { const int c = (r & 3) + 8 * (r >> 2);
        if (c > dq) p0[r] = -__builtin_inff();
        if (c + 32 > dq) p1[r] = -__builtin_inff(); }
}
__device__ __forceinline__ float mla_rowmax(const f32x16& p0, const f32x16& p1) {
    float tm = p0[0];
#pragma unroll
    for (int r = 1; r < 16; ++r) tm = fmaxf(tm, p0[r]);
#pragma unroll
    for (int r = 0; r < 16; ++r) tm = fmaxf(tm, p1[r]);
    return swapmax(tm);
}
#define MXP_EXP8(P, R0) do { _Pragma("unroll") for (int r_ = (R0); r_ < (R0) + 8; ++r_) { P[r_] = __builtin_amdgcn_exp2f(__builtin_fmaf(P[r_], QS_MLA, mc_)); ps_ += P[r_]; } } while (0)
__device__ __forceinline__ void mla_unit(LAS unsigned char* lds, const MlaPtrs& P, int head, int qb, int tid_in, int wave, int lane_in) {
    int tid = tid_in; asm volatile("" : "+v"(tid)); const int lane = tid & 63; (void)lane_in;
    const int r32 = lane & 31, hi = lane >> 5;
    const int q0 = qb * 256, qw = q0 + wave * 32, tq = qw + r32;
    i32x8 q[3];
    { const unsigned char* qp = (const unsigned char*)P.Q + (size_t)tq * 3072 + head * 192 + hi * 32;
#pragma unroll
      for (int s = 0; s < 3; ++s) { const u32x4 a = *(const GAS u32x4*)(qp + 64 * s), b = *(const GAS u32x4*)(qp + 64 * s + 16);
          q[s] = (i32x8){(int)a.x, (int)a.y, (int)a.z, (int)a.w, (int)b.x, (int)b.y, (int)b.z, (int)b.w}; } }
    const int NT = 4 * (qb + 1);
    const int srow = tid >> 3, sc8 = tid & 7;
    const unsigned char* kg = (const unsigned char*)P.K + (size_t)head * 192 + (size_t)srow * 3072 + sc8 * 8;
    const unsigned char* vg = (const unsigned char*)P.V + ((size_t)head * 128 + (tid >> 2)) * S + (tid & 3) * 16;
    LAS unsigned char* kst = lds + srow * KSX + sc8 * 8;
    LAS unsigned char* vst = lds + 2 * MLA_KBX + (tid >> 2) * VSX + (tid & 3) * 16;
    const LAS unsigned char* kl = lds + r32 * KSX + hi * 32;
    const LAS unsigned char* vl = lds + 2 * MLA_KBX + r32 * VSX + hi * 32;
    u32x2 sk0, sk1, sk2; u32x4 sv0;
#define MLA_LOADK(j) do { const unsigned char* kp_ = kg + (size_t)(j) * (64 * 3072); sk0 = *(const GAS u32x2*)(kp_); sk1 = *(const GAS u32x2*)(kp_ + 64); sk2 = *(const GAS u32x2*)(kp_ + 128); } while (0)
#define MLA_LOADV(j) do { sv0 = *(const GAS u32x4*)(vg + (size_t)(j) * 64); } while (0)
#define MLA_STOREK(b) do { LAS unsigned char* kd_ = kst + (b) * MLA_KBX; *(LAS u32x2*)(kd_) = sk0; *(LAS u32x2*)(kd_ + 64) = sk1; *(LAS u32x2*)(kd_ + 128) = sk2; } while (0)
#define MLA_STOREV(b) do { LAS unsigned char* vd_ = vst + (b) * VBX; *(LAS u32x2*)(vd_) = (u32x2){sv0.x, sv0.y}; *(LAS u32x2*)(vd_ + 8) = (u32x2){sv0.z, sv0.w}; } while (0)
    float m = -1e30f, l = 0.f; f32x16 o[4];
#pragma unroll
    for (int d = 0; d < 4; ++d)
#pragma unroll
        for (int r = 0; r < 16; ++r) o[d][r] = 0.f;
    f32x16 pA0, pA1, pB0, pB1;
    MLA_LOADK(0); MLA_LOADV(0); MLA_STOREK(0); MLA_STOREV(0);
    MLA_LOADK(1);
    __syncthreads();
    qk_tilex(pA0, pA1, kl, q);
    if (63 > qw) mla_maskx(pA0, pA1, tq - 4 * hi);
    MLA_STOREK(1);
    if (2 < NT) MLA_LOADK(2);
    MLA_LOADV(1);
    __syncthreads();
    asm volatile("" : "+v"(q[0]), "+v"(q[1]), "+v"(q[2]));
    float tmx = mla_rowmax(pA0, pA1);
#define SB() __builtin_amdgcn_sched_barrier(0)
#define MLA_SMHEAD() const float mn_ = fmaxf(m, tmx); const float alpha_ = __builtin_amdgcn_exp2f((m - mn_) * QS_MLA); m = mn_; const float mc_ = 8.f - mn_ * QS_MLA; float ps_ = 0.f; i32x8 pb_; \
            if (!__all(alpha_ == 1.f)) { _Pragma("unroll") for (int d_ = 0; d_ < 4; ++d_) _Pragma("unroll") for (int r_ = 0; r_ < 16; ++r_) o[d_][r_] *= alpha_; }
#define MXP_EXPK(P, R0, W0) do { MXP_EXP8(P, R0); \
        int w_ = __builtin_amdgcn_cvt_pk_fp8_f32(P[(R0) + 0], P[(R0) + 1], 0, false); pb_[(W0)] = __builtin_amdgcn_cvt_pk_fp8_f32(P[(R0) + 2], P[(R0) + 3], w_, true); \
        w_ = __builtin_amdgcn_cvt_pk_fp8_f32(P[(R0) + 4], P[(R0) + 5], 0, false); pb_[(W0) + 1] = __builtin_amdgcn_cvt_pk_fp8_f32(P[(R0) + 6], P[(R0) + 7], w_, true); } while (0)
#define MLA_SMTAIL() ps_ = swapsum(ps_); l = l * alpha_ + ps_
#define MFMA_T(acc, a, b) asm volatile("s_nop 1\n\tv_mfma_scale_f32_32x32x64_f8f6f4 %0, %1, %2, %0, %3, %3 op_sel_hi:[0,0,0]" : "+v"(acc) : "v"(a), "v"(b), "v"(sc1_))
#define MFMA_Z(acc, a, b) asm volatile("s_nop 1\n\tv_mfma_scale_f32_32x32x64_f8f6f4 %0, %1, %2, 0, %3, %3 op_sel_hi:[0,0,0]" : "=&v"(acc) : "v"(a), "v"(b), "v"(sc1_))
#define MLA_STEP(PX0, PX1, PY0, PY1, j) do { \
        const int kb1_ = 64 * ((j) + 1); \
        const bool a0_ = (64 * (j) <= qw + 31); \
        const LAS unsigned char* vj_ = vl + ((j) & 1) * VBX; \
        if (a0_) {                  \
            const LAS unsigned char* kn_ = kl + (((j) + 1) & 1) * MLA_KBX; \
            MLA_SMHEAD() \
            SB(); \
            i32x8 a0_f = ldsx(kn_), a1_f = ldsx(kn_ + 64); \
            MXP_EXPK(PX0, 0, 0); MXP_EXPK(PX0, 8, 2); \
            SB(); MFMA_Z(PY0, a0_f, q[0]); SB(); \
            a0_f = ldsx(kn_ + 128); \
            MXP_EXPK(PX1, 0, 4); \
            SB(); MFMA_T(PY0, a1_f, q[1]); SB(); \
            a1_f = ldsx(kn_ + 32 * KSX); \
            MXP_EXPK(PX1, 8, 6); \
            SB(); MFMA_T(PY0, a0_f, q[2]); SB(); \
            a0_f = ldsx(kn_ + 32 * KSX + 64); \
            MLA_SMTAIL(); \
            SB(); MFMA_Z(PY1, a1_f, q[0]); SB(); \
            a1_f = ldsx(vj_); \
            SB(); MFMA_T(PY1, a0_f, q[1]); SB(); \
            a0_f = ldsx(kn_ + 32 * KSX + 128); \
            SB(); MFMA_T(o[0], a1_f, pb_); SB(); \
            a1_f = ldsx(vj_ + 32 * VSX); \
            SB(); MFMA_T(PY1, a0_f, q[2]); SB(); \
            a0_f = ldsx(vj_ + 64 * VSX); \
            SB(); MFMA_T(o[1], a1_f, pb_); SB(); \
            a1_f = ldsx(vj_ + 96 * VSX); \
            SB(); MFMA_T(o[2], a0_f, pb_); SB(); \
            SB(); MFMA_T(o[3], a1_f, pb_); SB(); \
            if (kb1_ + 63 > qw) mla_maskx(PY0, PY1, tq - kb1_ - 4 * hi); \
            tmx = mla_rowmax(PY0, PY1); \
        } \
        if ((j) + 2 < NT) MLA_STOREK((j) & 1); \
        if ((j) + 1 < NT) MLA_STOREV(((j) + 1) & 1); \
        if ((j) + 3 < NT) MLA_LOADK((j) + 3); \
        if ((j) + 2 < NT) MLA_LOADV((j) + 2); \
        __syncthreads(); } while (0)
    int sc1_ = 0x7f7f7f7f; asm volatile("" : "+v"(sc1_));
    for (int j = 0; j < NT; j += 2) {
        MLA_STEP(pA0, pA1, pB0, pB1, j);
        MLA_STEP(pB0, pB1, pA0, pA1, j + 1);
    }
    asm volatile("s_nop 15\n\ts_nop 15" ::: "memory");
#undef MLA_STEP
#undef MLA_SMHEAD
#undef MLA_SMTAIL
#undef MXP_EXPK
#undef MFMA_T
#undef MFMA_Z
#undef SB
#undef MLA_LOADK
#undef MLA_LOADV
#undef MLA_STOREK
#undef MLA_STOREV
    const float inv = 1.f / l;
    const bf16* zp = P.Z + (size_t)tq * 2048 + head * 128 + 4 * hi;
    bf16* op = P.O + (size_t)tq * 4096 + head * 128 + 4 * hi;
#pragma unroll
    for (int d0 = 0; d0 < 4; ++d0)
#pragma unroll
        for (int rg = 0; rg < 4; ++rg) { const int dim = 32 * d0 + 8 * rg;
            const u32x2 z = *(const GAS u32x2*)(zp + dim);
            u32x2 w; w.x = pk2(o[d0][4 * rg + 0] * inv * bflo(z.x), o[d0][4 * rg + 1] * inv * bfhi(z.x)); w.y = pk2(o[d0][4 * rg + 2] * inv * bflo(z.y), o[d0][4 * rg + 3] * inv * bfhi(z.y));
            *(GAS u32x2*)(op + dim) = w; }
}
#undef MXP_EXP8

#elif defined(MLA_MX)
struct MlaPtrs { const bf16* Q; const bf16* K; const bf16* V; const bf16* Z; bf16* O; };
__device__ __forceinline__ void mla_unit(LAS unsigned char* lds, const MlaPtrs& P, int head, int qb, int tid_in, int wave, int lane_in) {
    int tid = tid_in; asm volatile("" : "+v"(tid)); const int lane = tid & 63; (void)lane_in;
    const int r32 = lane & 31, hi = lane >> 5;
    const int q0 = qb * 256, qw = q0 + wave * 32, tq = qw + r32;
    i32x8 q[3];
    { const unsigned char* qp = (const unsigned char*)P.Q + (size_t)tq * 3072 + head * 192 + hi * 32;
#pragma unroll
      for (int s = 0; s < 3; ++s) { const u32x4 a = *(const GAS u32x4*)(qp + 64 * s), b = *(const GAS u32x4*)(qp + 64 * s + 16);
          q[s] = (i32x8){(int)a.x, (int)a.y, (int)a.z, (int)a.w, (int)b.x, (int)b.y, (int)b.z, (int)b.w}; } }
    const int NT = 4 * (qb + 1);
    const int srow = tid >> 3, sc8 = tid & 7;
    const unsigned char* kg = (const unsigned char*)P.K + (size_t)head * 192 + (size_t)srow * 3072 + sc8 * 8;
    const unsigned char* vg = (const unsigned char*)P.V + ((size_t)head * 128 + (tid >> 2)) * S + (tid & 3) * 16;
    LAS unsigned char* kst = lds + srow * KSX + sc8 * 8;
    LAS unsigned char* vst = lds + 2 * MLA_KBX + (tid >> 2) * VSX + (tid & 3) * 16;
    const LAS unsigned char* kl = lds + r32 * KSX + hi * 32;
    const LAS unsigned char* vl = lds + 2 * MLA_KBX + r32 * VSX + hi * 32;
    u32x2 sk0, sk1, sk2; u32x4 sv0;
#define MLA_LOAD(j) do { const unsigned char* kp_ = kg + (size_t)(j) * (64 * 3072); const unsigned char* vp_ = vg + (size_t)(j) * 64; \
        sk0 = *(const GAS u32x2*)(kp_); sk1 = *(const GAS u32x2*)(kp_ + 64); sk2 = *(const GAS u32x2*)(kp_ + 128); sv0 = *(const GAS u32x4*)(vp_); } while (0)
#define MLA_STORE(b, vb) do { LAS unsigned char* kd_ = kst + (b) * MLA_KBX; LAS unsigned char* vd_ = vst + (vb) * VBX; \
        *(LAS u32x2*)(kd_) = sk0; *(LAS u32x2*)(kd_ + 64) = sk1; *(LAS u32x2*)(kd_ + 128) = sk2; *(LAS u32x2*)(vd_) = (u32x2){sv0.x, sv0.y}; *(LAS u32x2*)(vd_ + 8) = (u32x2){sv0.z, sv0.w}; } while (0)
    MLA_LOAD(0); MLA_STORE(0, 0);
    __syncthreads();
    asm volatile("" : "+v"(q[0]), "+v"(q[1]), "+v"(q[2]));
    float m = -1e30f, l = 0.f; f32x16 o[4];
#pragma unroll
    for (int d = 0; d < 4; ++d)
#pragma unroll
        for (int r = 0; r < 16; ++r) o[d][r] = 0.f;
    const bool trail = wave >= 4;
    i32x8 pb = {};
    int vb_cur = 0, vb_prev = 2;
    for (int j = 0; j < NT; ++j) {
        const int kb = 64 * j;
        int vb_next = vb_cur + 1; if (vb_next == 3) vb_next = 0;
        if (j + 1 < NT) MLA_LOAD(j + 1);
        if (trail && j > 0 && kb - 64 <= qw + 31) pv_tilex(o, pb, vl + vb_prev * VBX);
        if (kb <= qw + 31) {
            f32x16 p0, p1;
            qk_tilex(p0, p1, kl + (j & 1) * MLA_KBX, q);
            if (kb + 63 > qw) {
                const int dq = tq - kb - 4 * hi;
#pragma unroll
                for (int r = 0; r < 16; ++r) { const int c = (r & 3) + 8 * (r >> 2);
                    if (c > dq) p0[r] = -__builtin_inff();
                    if (c + 32 > dq) p1[r] = -__builtin_inff(); }
            }
            online_sm_x(p0, p1, m, l, o, QS_MLA);
            pb = packpx(p0, p1);
            if (!trail) pv_tilex(o, pb, vl + vb_cur * VBX);
        }
        if (j + 1 < NT) MLA_STORE((j + 1) & 1, vb_next);
        __syncthreads();
        vb_prev = vb_cur; vb_cur = vb_next;
    }
    if (trail && 64 * (NT - 1) <= qw + 31) pv_tilex(o, pb, vl + vb_prev * VBX);
    __syncthreads();
#undef MLA_LOAD
#undef MLA_STORE
    const float inv = 1.f / l;
    const bf16* zp = P.Z + (size_t)tq * 2048 + head * 128 + 4 * hi;
    bf16* op = P.O + (size_t)tq * 4096 + head * 128 + 4 * hi;
#pragma unroll
    for (int d0 = 0; d0 < 4; ++d0)
#pragma unroll
        for (int rg = 0; rg < 4; ++rg) { const int dim = 32 * d0 + 8 * rg;
            const u32x2 z = *(const GAS u32x2*)(zp + dim);
            u32x2 w; w.x = pk2(o[d0][4 * rg + 0] * inv * bflo(z.x), o[d0][4 * rg + 1] * inv * bfhi(z.x)); w.y = pk2(o[d0][4 * rg + 2] * inv * bflo(z.y), o[d0][4 * rg + 3] * inv * bfhi(z.y));
            *(GAS u32x2*)(op + dim) = w; }
}

#elif defined(MLA_BIG)
struct MlaPtrs { const bf16* Q; const bf16* K; const bf16* V; const bf16* Z; bf16* O; };
__device__ __forceinline__ void mla_unit(LAS unsigned char* lds, const MlaPtrs& P, int head, int qb, int tid_in, int wave, int lane_in) {
    int tid = tid_in; asm volatile("" : "+v"(tid)); const int lane = tid & 63; (void)lane_in;
    const int r32 = lane & 31, hi = lane >> 5;
    const int q0 = qb * 256, qw = q0 + wave * 32, tq = qw + r32;
    i64 q[12];
    { const unsigned char* qp = (const unsigned char*)P.Q + (size_t)tq * 3072 + head * 192 + hi * 8;
#pragma unroll
      for (int d0 = 0; d0 < 12; ++d0) q[d0] = *(const GAS i64*)(qp + d0 * 16); }
    const int NT = 4 * (qb + 1), NTB = NT / 2;
    const int srow = tid >> 3, sc8 = tid & 7;
    const unsigned char* kg = (const unsigned char*)P.K + (size_t)head * 192 + (size_t)srow * 3072 + sc8 * 8;
    const unsigned char* vg = (const unsigned char*)P.V + ((size_t)head * 128 + (tid >> 2)) * S + (tid & 3) * 32;
    LAS unsigned char* kst = lds + srow * KS8 + sc8 * 8;
    LAS unsigned char* vst = lds + 2 * MLA_KB8B + (tid >> 2) * VS8B + (tid & 3) * 32;
    const LAS unsigned char* kl = lds + r32 * KS8 + hi * 8;
    const LAS unsigned char* vl = lds + 2 * MLA_KB8B + r32 * VS8B + hi * 8;
    u32x2 sk0, sk1, sk2, sk3, sk4, sk5; u32x4 sv0, sv1;
#define MLA_LOAD(J) do { const unsigned char* kp_ = kg + (size_t)(J) * (128 * 3072); const unsigned char* vp_ = vg + (size_t)(J) * 128; \
        sk0 = *(const GAS u32x2*)(kp_); sk1 = *(const GAS u32x2*)(kp_ + 64); sk2 = *(const GAS u32x2*)(kp_ + 128); \
        sk3 = *(const GAS u32x2*)(kp_ + 64 * 3072); sk4 = *(const GAS u32x2*)(kp_ + 64 * 3072 + 64); sk5 = *(const GAS u32x2*)(kp_ + 64 * 3072 + 128); \
        sv0 = *(const GAS u32x4*)(vp_); sv1 = *(const GAS u32x4*)(vp_ + 16); } while (0)
#define MLA_STORE(b, vb) do { LAS unsigned char* kd_ = kst + (b) * MLA_KB8B; LAS unsigned char* vd_ = vst + (vb) * VB8B; \
        *(LAS u32x2*)(kd_) = sk0; *(LAS u32x2*)(kd_ + 64) = sk1; *(LAS u32x2*)(kd_ + 128) = sk2; \
        *(LAS u32x2*)(kd_ + 64 * KS8) = sk3; *(LAS u32x2*)(kd_ + 64 * KS8 + 64) = sk4; *(LAS u32x2*)(kd_ + 64 * KS8 + 128) = sk5; \
        *(LAS u32x2*)(vd_) = (u32x2){sv0.x, sv0.y}; *(LAS u32x2*)(vd_ + 8) = (u32x2){sv0.z, sv0.w}; *(LAS u32x2*)(vd_ + 16) = (u32x2){sv1.x, sv1.y}; *(LAS u32x2*)(vd_ + 24) = (u32x2){sv1.z, sv1.w}; } while (0)
    MLA_LOAD(0); MLA_STORE(0, 0);
    __syncthreads();
    float m = -1e30f, l = 0.f; f32x16 o[4];
#pragma unroll
    for (int d = 0; d < 4; ++d)
#pragma unroll
        for (int r = 0; r < 16; ++r) o[d][r] = 0.f;
    const bool trail = wave >= 4;
    i64 pb[4] = {};
    int vb_cur = 0, vb_prev = 2;
    for (int J = 0; J < NTB; ++J) {
        int vb_next = vb_cur + 1; if (vb_next == 3) vb_next = 0;
        if (J + 1 < NTB) MLA_LOAD(J + 1);
#pragma unroll
        for (int sub = 0; sub < 2; ++sub) {
            const int j = 2 * J + sub, kb = 64 * j;
            if (trail && j > 0 && kb - 64 <= qw + 31) pv_tile8(o, pb, vl + (sub == 0 ? vb_prev * VB8B + 64 : vb_cur * VB8B));
            if (kb <= qw + 31) {
                f32x16 p0, p1;
                qk_tile8<12>(p0, p1, kl + (J & 1) * MLA_KB8B + sub * 64 * KS8, q);
                if (kb + 63 > qw) {
                    const int dq = tq - kb - 4 * hi;
#pragma unroll
                    for (int r = 0; r < 16; ++r) { const int c = (r & 3) + 8 * (r >> 2);
                        if (c > dq) p0[r] = -__builtin_inff();
                        if (c + 32 > dq) p1[r] = -__builtin_inff(); }
                }
                online_sm_scaled(p0, p1, m, l, o, QS_MLA);
                pb[0] = packp8<0>(p0); pb[1] = packp8<1>(p0); pb[2] = packp8<0>(p1); pb[3] = packp8<1>(p1);
                if (!trail) pv_tile8(o, pb, vl + vb_cur * VB8B + sub * 64);
            }
        }
        if (J + 1 < NTB) MLA_STORE((J + 1) & 1, vb_next);
        __syncthreads();
        vb_prev = vb_cur; vb_cur = vb_next;
    }
    if (trail && 64 * (NT - 1) <= qw + 31) pv_tile8(o, pb, vl + vb_prev * VB8B + 64);
    __syncthreads();
#undef MLA_LOAD
#undef MLA_STORE
    const float inv = (1.f / 256.f) / l;
    const bf16* zp = P.Z + (size_t)tq * 2048 + head * 128 + 4 * hi;
    bf16* op = P.O + (size_t)tq * 4096 + head * 128 + 4 * hi;
#pragma unroll
    for (int d0 = 0; d0 < 4; ++d0)
#pragma unroll
        for (int rg = 0; rg < 4; ++rg) { const int dim = 32 * d0 + 8 * rg;
            const u32x2 z = *(const GAS u32x2*)(zp + dim);
            u32x2 w; w.x = pk2(o[d0][4 * rg + 0] * inv * bflo(z.x), o[d0][4 * rg + 1] * inv * bfhi(z.x)); w.y = pk2(o[d0][4 * rg + 2] * inv * bflo(z.y), o[d0][4 * rg + 3] * inv * bfhi(z.y));
            *(GAS u32x2*)(op + dim) = w; }
}

#elif defined(MLA_FP8V)
struct MlaPtrs { const bf16* Q; const bf16* K; const bf16* V; const bf16* Z; bf16* O; };
__device__ __forceinline__ void mla_unit(LAS unsigned char* lds, const MlaPtrs& P, int head, int qb, int tid_in, int wave, int lane_in) {
    int tid = tid_in; asm volatile("" : "+v"(tid)); const int lane = tid & 63; (void)lane_in;
    const int r32 = lane & 31, hi = lane >> 5;
    const int q0 = qb * 256, qw = q0 + wave * 32, tq = qw + r32;
    i64 q[12];
    { const unsigned char* qp = (const unsigned char*)P.Q + (size_t)tq * 3072 + head * 192 + hi * 8;
#pragma unroll
      for (int d0 = 0; d0 < 12; ++d0) q[d0] = *(const GAS i64*)(qp + d0 * 16); }
    const int NT = 4 * (qb + 1);
    const int srow = tid >> 3, sc8 = tid & 7;
    const unsigned char* kg = (const unsigned char*)P.K + (size_t)head * 192 + (size_t)srow * 3072 + sc8 * 8;
    const unsigned char* vg = (const unsigned char*)P.V + ((size_t)head * 128 + (tid >> 2)) * S + (tid & 3) * 16;
    LAS unsigned char* kst = lds + srow * KS8 + sc8 * 8;
    LAS unsigned char* vst = lds + 2 * MLA_KB8 + (tid >> 2) * VS8 + (tid & 3) * 16;
    const LAS unsigned char* kl = lds + r32 * KS8 + hi * 8;
    const LAS unsigned char* vl = lds + 2 * MLA_KB8 + r32 * VS8 + hi * 8;
    u32x2 sk0, sk1, sk2; u32x4 sv0;
#define MLA_LOAD(j) do { const unsigned char* kp_ = kg + (size_t)(j) * (64 * 3072); const unsigned char* vp_ = vg + (size_t)(j) * 64; \
        sk0 = *(const GAS u32x2*)(kp_); sk1 = *(const GAS u32x2*)(kp_ + 64); sk2 = *(const GAS u32x2*)(kp_ + 128); sv0 = *(const GAS u32x4*)(vp_); } while (0)
#define MLA_STORE(b, vb) do { LAS unsigned char* kd_ = kst + (b) * MLA_KB8; LAS unsigned char* vd_ = vst + (vb) * VB8; \
        *(LAS u32x2*)(kd_) = sk0; *(LAS u32x2*)(kd_ + 64) = sk1; *(LAS u32x2*)(kd_ + 128) = sk2; *(LAS u32x2*)(vd_) = (u32x2){sv0.x, sv0.y}; *(LAS u32x2*)(vd_ + 8) = (u32x2){sv0.z, sv0.w}; } while (0)
    MLA_LOAD(0); MLA_STORE(0, 0);
    __syncthreads();
    float m = -1e30f, l = 0.f; f32x16 o[4];
#pragma unroll
    for (int d = 0; d < 4; ++d)
#pragma unroll
        for (int r = 0; r < 16; ++r) o[d][r] = 0.f;
    const bool trail = wave >= 4;
    i64 pb[4] = {};
    int vb_cur = 0, vb_prev = 2;
    for (int j = 0; j < NT; ++j) {
        const int kb = 64 * j;
        int vb_next = vb_cur + 1; if (vb_next == 3) vb_next = 0;
        if (j + 1 < NT) MLA_LOAD(j + 1);
        if (trail && j > 0 && kb - 64 <= qw + 31) pv_tile8(o, pb, vl + vb_prev * VB8);
        if (kb <= qw + 31) {
            f32x16 p0, p1;
#ifdef PROBE_QKM2
            { f32x16 r0, r1; qk_tile_m2<12, KS_M>(p0, p1, r0, r1, kl + (j & 1) * MLA_KB, q);
#pragma unroll
              for (int r = 0; r < 16; ++r) { p0[r] = (p0[r] + r0[r]) * 0.5f; p1[r] = (p1[r] + r1[r]) * 0.5f; } }
#else
            qk_tile8<12>(p0, p1, kl + (j & 1) * MLA_KB8, q);
#endif
#ifdef PROBE_QK2
            { f32x16 r0, r1; asm volatile("" ::: "memory"); qk_tile<12, KS_M>(r0, r1, kl + (j & 1) * MLA_KB, q);
#pragma unroll
              for (int r = 0; r < 16; ++r) { p0[r] = (p0[r] + r0[r]) * 0.5f; p1[r] = (p1[r] + r1[r]) * 0.5f; } }
#endif
#ifdef PROBE_SM2
            { float acc_ = 0.f;
#pragma unroll
              for (int r = 0; r < 16; ++r) { acc_ += __builtin_amdgcn_exp2f(p0[r] - m - 40.f) + __builtin_amdgcn_exp2f(p1[r] - m - 40.f); }
#pragma unroll
              for (int r = 0; r < 16; ++r) { acc_ += __builtin_amdgcn_exp2f(p0[r] - m - 50.f) + __builtin_amdgcn_exp2f(p1[r] - m - 50.f); }
              if (acc_ == 12345.678f) l += 1.f; }
#endif
            if (kb + 63 > qw) {
                const int dq = tq - kb - 4 * hi;
#pragma unroll
                for (int r = 0; r < 16; ++r) { const int c = (r & 3) + 8 * (r >> 2);
                    if (c > dq) p0[r] = -__builtin_inff();
                    if (c + 32 > dq) p1[r] = -__builtin_inff(); }
            }
            online_sm_scaled(p0, p1, m, l, o, QS_MLA);
            pb[0] = packp8<0>(p0); pb[1] = packp8<1>(p0); pb[2] = packp8<0>(p1); pb[3] = packp8<1>(p1);
            if (!trail) pv_tile8(o, pb, vl + vb_cur * VB8);
        }
        if (j + 1 < NT) MLA_STORE((j + 1) & 1, vb_next);
        __syncthreads();
        vb_prev = vb_cur; vb_cur = vb_next;
    }
    if (trail && 64 * (NT - 1) <= qw + 31) pv_tile8(o, pb, vl + vb_prev * VB8);
    __syncthreads();
#undef MLA_LOAD
#undef MLA_STORE
    const float inv = (1.f / 256.f) / l;
    const bf16* zp = P.Z + (size_t)tq * 2048 + head * 128 + 4 * hi;
    bf16* op = P.O + (size_t)tq * 4096 + head * 128 + 4 * hi;
#pragma unroll
    for (int d0 = 0; d0 < 4; ++d0)
#pragma unroll
        for (int rg = 0; rg < 4; ++rg) { const int dim = 32 * d0 + 8 * rg;
            const u32x2 z = *(const GAS u32x2*)(zp + dim);
            u32x2 w; w.x = pk2(o[d0][4 * rg + 0] * inv * bflo(z.x), o[d0][4 * rg + 1] * inv * bfhi(z.x)); w.y = pk2(o[d0][4 * rg + 2] * inv * bflo(z.y), o[d0][4 * rg + 3] * inv * bfhi(z.y));
            *(GAS u32x2*)(op + dim) = w; }
}

#elif defined(MLA_FP8)
struct MlaPtrs { const bf16* Q; const bf16* K; const bf16* V; const bf16* Z; bf16* O; };
__device__ __forceinline__ void mla_unit(LAS unsigned char* lds, const MlaPtrs& P, int head, int qb, int tid_in, int wave, int lane_in) {
    int tid = tid_in; asm volatile("" : "+v"(tid)); const int lane = tid & 63; (void)lane_in;
    const int r32 = lane & 31, hi = lane >> 5;
    const int q0 = qb * 256, qw = q0 + wave * 32, tq = qw + r32;
    i64 q[12];
    { const unsigned char* qp = (const unsigned char*)P.Q + (size_t)tq * 3072 + head * 192 + hi * 8;
#pragma unroll
      for (int d0 = 0; d0 < 12; ++d0) q[d0] = *(const GAS i64*)(qp + d0 * 16); }
    const int NT = 4 * (qb + 1);
    const int srow = tid >> 3, sc8 = tid & 7;
    const unsigned char* kg = (const unsigned char*)P.K + (size_t)head * 192 + (size_t)srow * 3072 + sc8 * 8;
    const unsigned char* vg = (const unsigned char*)P.V + (size_t)head * 256 + (size_t)srow * 4096 + sc8 * 16;
    LAS unsigned char* kst = lds + srow * KS8 + sc8 * 8;
    LAS unsigned char* vst = lds + 2 * MLA_KB8 + srow * VS + sc8 * 16;
    const LAS unsigned char* kl = lds + r32 * KS8 + hi * 8;
    const LAS unsigned char* vl = lds + 2 * MLA_KB8 + (4 * hi + ((lane & 15) >> 2)) * VS + (16 * ((lane >> 4) & 1) + 4 * (lane & 3)) * 2;
    u32x2 sk0, sk1, sk2; u32x4 sv0, sv1;
#define MLA_LOAD(j) do { const unsigned char* kp_ = kg + (size_t)(j) * (64 * 3072); const unsigned char* vp_ = vg + (size_t)(j) * (64 * 4096); \
        sk0 = *(const GAS u32x2*)(kp_); sk1 = *(const GAS u32x2*)(kp_ + 64); sk2 = *(const GAS u32x2*)(kp_ + 128); sv0 = *(const GAS u32x4*)(vp_); sv1 = *(const GAS u32x4*)(vp_ + 128); } while (0)
#define MLA_STORE(b, vb) do { LAS unsigned char* kd_ = kst + (b) * MLA_KB8; LAS unsigned char* vd_ = vst + (vb) * VB; \
        *(LAS u32x2*)(kd_) = sk0; *(LAS u32x2*)(kd_ + 64) = sk1; *(LAS u32x2*)(kd_ + 128) = sk2; *(LAS u32x4*)(vd_) = sv0; *(LAS u32x4*)(vd_ + 128) = sv1; } while (0)
    MLA_LOAD(0); MLA_STORE(0, 0);
    __syncthreads();
    float m = -1e30f, l = 0.f; f32x16 o[4];
#pragma unroll
    for (int d = 0; d < 4; ++d)
#pragma unroll
        for (int r = 0; r < 16; ++r) o[d][r] = 0.f;
    const bool trail = wave >= 4;
    bf16x8 pb[4] = {};
    int vb_cur = 0, vb_prev = 2;
    for (int j = 0; j < NT; ++j) {
        const int kb = 64 * j;
        int vb_next = vb_cur + 1; if (vb_next == 3) vb_next = 0;
        if (j + 1 < NT) MLA_LOAD(j + 1);
        if (trail && j > 0 && kb - 64 <= qw + 31) pv_tile(o, pb, vl + vb_prev * VB);
        if (kb <= qw + 31) {
            f32x16 p0, p1;
#ifdef PROBE_QKM2
            { f32x16 r0, r1; qk_tile_m2<12, KS_M>(p0, p1, r0, r1, kl + (j & 1) * MLA_KB, q);
#pragma unroll
              for (int r = 0; r < 16; ++r) { p0[r] = (p0[r] + r0[r]) * 0.5f; p1[r] = (p1[r] + r1[r]) * 0.5f; } }
#else
            qk_tile8<12>(p0, p1, kl + (j & 1) * MLA_KB8, q);
#endif
#ifdef PROBE_QK2
            { f32x16 r0, r1; asm volatile("" ::: "memory"); qk_tile<12, KS_M>(r0, r1, kl + (j & 1) * MLA_KB, q);
#pragma unroll
              for (int r = 0; r < 16; ++r) { p0[r] = (p0[r] + r0[r]) * 0.5f; p1[r] = (p1[r] + r1[r]) * 0.5f; } }
#endif
#ifdef PROBE_SM2
            { float acc_ = 0.f;
#pragma unroll
              for (int r = 0; r < 16; ++r) { acc_ += __builtin_amdgcn_exp2f(p0[r] - m - 40.f) + __builtin_amdgcn_exp2f(p1[r] - m - 40.f); }
#pragma unroll
              for (int r = 0; r < 16; ++r) { acc_ += __builtin_amdgcn_exp2f(p0[r] - m - 50.f) + __builtin_amdgcn_exp2f(p1[r] - m - 50.f); }
              if (acc_ == 12345.678f) l += 1.f; }
#endif
            if (kb + 63 > qw) {
                const int dq = tq - kb - 4 * hi;
#pragma unroll
                for (int r = 0; r < 16; ++r) { const int c = (r & 3) + 8 * (r >> 2);
                    if (c > dq) p0[r] = -__builtin_inff();
                    if (c + 32 > dq) p1[r] = -__builtin_inff(); }
            }
            online_sm_scaled(p0, p1, m, l, o, QS_MLA);
            pb[0] = packp<0>(p0); pb[1] = packp<1>(p0); pb[2] = packp<0>(p1); pb[3] = packp<1>(p1);
            if (!trail) pv_tile(o, pb, vl + vb_cur * VB);
        }
        if (j + 1 < NT) MLA_STORE((j + 1) & 1, vb_next);
        __syncthreads();
        vb_prev = vb_cur; vb_cur = vb_next;
    }
    if (trail && 64 * (NT - 1) <= qw + 31) pv_tile(o, pb, vl + vb_prev * VB);
    __syncthreads();
#undef MLA_LOAD
#undef MLA_STORE
    const float inv = 1.f / l;
    const bf16* zp = P.Z + (size_t)tq * 2048 + head * 128 + 4 * hi;
    bf16* op = P.O + (size_t)tq * 4096 + head * 128 + 4 * hi;
#pragma unroll
    for (int d0 = 0; d0 < 4; ++d0)
#pragma unroll
        for (int rg = 0; rg < 4; ++rg) { const int dim = 32 * d0 + 8 * rg;
            const u32x2 z = *(const GAS u32x2*)(zp + dim);
            u32x2 w; w.x = pk2(o[d0][4 * rg + 0] * inv * bflo(z.x), o[d0][4 * rg + 1] * inv * bfhi(z.x)); w.y = pk2(o[d0][4 * rg + 2] * inv * bflo(z.y), o[d0][4 * rg + 3] * inv * bfhi(z.y));
            *(GAS u32x2*)(op + dim) = w; }
}

#else
struct MlaPtrs { const bf16* Q; const bf16* K; const bf16* V; const bf16* Z; bf16* O; };
__device__ __forceinline__ void mla_unit(LAS unsigned char* lds, const MlaPtrs& P, int head, int qb, int tid_in, int wave, int lane_in) {
    int tid = tid_in; asm volatile("" : "+v"(tid)); const int lane = tid & 63; (void)lane_in;
    const int r32 = lane & 31, hi = lane >> 5;
    const int q0 = qb * 256, qw = q0 + wave * 32, tq = qw + r32;
    bf16x8 q[12];
    { const bf16* qp = P.Q + (size_t)tq * 3072 + head * 192 + hi * 8;
#pragma unroll
      for (int d0 = 0; d0 < 12; ++d0) q[d0] = *(const GAS bf16x8*)(qp + d0 * 16); }
    const int NT = 4 * (qb + 1);
    const int srow = tid >> 3, sc8 = tid & 7;
    const unsigned char* kg = (const unsigned char*)P.K + (size_t)head * 384 + (size_t)srow * 6144 + sc8 * 16;
    const unsigned char* vg = (const unsigned char*)P.V + (size_t)head * 256 + (size_t)srow * 4096 + sc8 * 16;
    LAS unsigned char* kst = lds + srow * KS_M + sc8 * 16;
    LAS unsigned char* vst = lds + 2 * MLA_KB + srow * VS + sc8 * 16;
    const LAS unsigned char* kl = lds + r32 * KS_M + hi * 16;
    const LAS unsigned char* vl = lds + 2 * MLA_KB + (4 * hi + ((lane & 15) >> 2)) * VS + (16 * ((lane >> 4) & 1) + 4 * (lane & 3)) * 2;
    u32x4 sk0, sk1, sk2, sv0, sv1;
#define MLA_LOAD(j) do { const unsigned char* kp_ = kg + (size_t)(j) * (64 * 6144); const unsigned char* vp_ = vg + (size_t)(j) * (64 * 4096); \
        sk0 = *(const GAS u32x4*)(kp_); sk1 = *(const GAS u32x4*)(kp_ + 128); sk2 = *(const GAS u32x4*)(kp_ + 256); sv0 = *(const GAS u32x4*)(vp_); sv1 = *(const GAS u32x4*)(vp_ + 128); } while (0)
#define MLA_STORE(b, vb) do { LAS unsigned char* kd_ = kst + (b) * MLA_KB; LAS unsigned char* vd_ = vst + (vb) * VB; \
        *(LAS u32x4*)(kd_) = sk0; *(LAS u32x4*)(kd_ + 128) = sk1; *(LAS u32x4*)(kd_ + 256) = sk2; *(LAS u32x4*)(vd_) = sv0; *(LAS u32x4*)(vd_ + 128) = sv1; } while (0)
    MLA_LOAD(0); MLA_STORE(0, 0);
    __syncthreads();
    float m = -1e30f, l = 0.f; f32x16 o[4];
#pragma unroll
    for (int d = 0; d < 4; ++d)
#pragma unroll
        for (int r = 0; r < 16; ++r) o[d][r] = 0.f;
    const bool trail = wave >= 4;
    bf16x8 pb[4] = {};
    int vb_cur = 0, vb_prev = 2;
    for (int j = 0; j < NT; ++j) {
        const int kb = 64 * j;
        int vb_next = vb_cur + 1; if (vb_next == 3) vb_next = 0;
        if (j + 1 < NT) MLA_LOAD(j + 1);
        if (trail && j > 0 && kb - 64 <= qw + 31) pv_tile(o, pb, vl + vb_prev * VB);
        if (kb <= qw + 31) {
            f32x16 p0, p1;
#ifdef PROBE_QKM2
            { f32x16 r0, r1; qk_tile_m2<12, KS_M>(p0, p1, r0, r1, kl + (j & 1) * MLA_KB, q);
#pragma unroll
              for (int r = 0; r < 16; ++r) { p0[r] = (p0[r] + r0[r]) * 0.5f; p1[r] = (p1[r] + r1[r]) * 0.5f; } }
#else
            qk_tile<12, KS_M>(p0, p1, kl + (j & 1) * MLA_KB, q);
#endif
#ifdef PROBE_QK2
            { f32x16 r0, r1; asm volatile("" ::: "memory"); qk_tile<12, KS_M>(r0, r1, kl + (j & 1) * MLA_KB, q);
#pragma unroll
              for (int r = 0; r < 16; ++r) { p0[r] = (p0[r] + r0[r]) * 0.5f; p1[r] = (p1[r] + r1[r]) * 0.5f; } }
#endif
#ifdef PROBE_SM2
            { float acc_ = 0.f;
#pragma unroll
              for (int r = 0; r < 16; ++r) { acc_ += __builtin_amdgcn_exp2f(p0[r] - m - 40.f) + __builtin_amdgcn_exp2f(p1[r] - m - 40.f); }
#pragma unroll
              for (int r = 0; r < 16; ++r) { acc_ += __builtin_amdgcn_exp2f(p0[r] - m - 50.f) + __builtin_amdgcn_exp2f(p1[r] - m - 50.f); }
              if (acc_ == 12345.678f) l += 1.f; }
#endif
            if (kb + 63 > qw) {
                const int dq = tq - kb - 4 * hi;
#pragma unroll
                for (int r = 0; r < 16; ++r) { const int c = (r & 3) + 8 * (r >> 2);
                    if (c > dq) p0[r] = -__builtin_inff();
                    if (c + 32 > dq) p1[r] = -__builtin_inff(); }
            }
            online_sm(p0, p1, m, l, o);
            pb[0] = packp<0>(p0); pb[1] = packp<1>(p0); pb[2] = packp<0>(p1); pb[3] = packp<1>(p1);
            if (!trail) pv_tile(o, pb, vl + vb_cur * VB);
        }
        if (j + 1 < NT) MLA_STORE((j + 1) & 1, vb_next);
        __syncthreads();
        vb_prev = vb_cur; vb_cur = vb_next;
    }
    if (trail && 64 * (NT - 1) <= qw + 31) pv_tile(o, pb, vl + vb_prev * VB);
    __syncthreads();
#undef MLA_LOAD
#undef MLA_STORE
    const float inv = 1.f / l;
    const bf16* zp = P.Z + (size_t)tq * 2048 + head * 128 + 4 * hi;
    bf16* op = P.O + (size_t)tq * 4096 + head * 128 + 4 * hi;
#pragma unroll
    for (int d0 = 0; d0 < 4; ++d0)
#pragma unroll
        for (int rg = 0; rg < 4; ++rg) { const int dim = 32 * d0 + 8 * rg;
            const u32x2 z = *(const GAS u32x2*)(zp + dim);
            u32x2 w; w.x = pk2(o[d0][4 * rg + 0] * inv * bflo(z.x), o[d0][4 * rg + 1] * inv * bfhi(z.x)); w.y = pk2(o[d0][4 * rg + 2] * inv * bflo(z.y), o[d0][4 * rg + 3] * inv * bfhi(z.y));
            *(GAS u32x2*)(op + dim) = w; }
}

#endif
#endif
struct NsaPtrs { const bf16* Q; const bf16* KV; const bf16* KC; const bf16* VC; const bf16* Z; const float* G; bf16* O; float* scr; };
template <int MODE>
__device__ __forceinline__ void nsa_loop(LAS unsigned char* lds, const unsigned char* kbase, const unsigned char* vbase, int ntiles, int jlo,
                                         const bf16x8 (&q)[8], int t, float slope2, float& m, float& l, f32x16 (&o)[4], float invl, int tid, int wave, int lane) {
    constexpr bool HASV = MODE != 0;
    const int r32 = lane & 31, hi = lane >> 5;
    const int srow = tid >> 3, sc8 = tid & 7;
    const unsigned soff = srow * 256 + sc8 * 16;
    LAS unsigned char* kst = lds + srow * KS_N + sc8 * 16;
    LAS unsigned char* vst = lds + 2 * NSA_KB + srow * VS + sc8 * 16;
    const LAS unsigned char* kl = lds + r32 * KS_N + hi * 16;
    const LAS unsigned char* vl = lds + 2 * NSA_KB + (4 * hi + ((lane & 15) >> 2)) * VS + (16 * ((lane >> 4) & 1) + 4 * (lane & 3)) * 2;
    const LAS int* ulist = (const LAS int*)(lds + N_ULIST);
    const LAS unsigned* selm = (const LAS unsigned*)(lds + N_SELM);
    LAS float* partA = (LAS float*)(lds + N_PART); LAS float* partB = (LAS float*)(lds + N_PART + N_PARTB);
    LAS float* imp = (LAS float*)(lds + N_IMP); LAS float* carry = (LAS float*)(lds + N_CARRY);
    if (ntiles <= 0) return;
    const float mlg = (MODE == 1) ? (invl > 0.f ? m - __builtin_amdgcn_logf(invl) : __builtin_inff()) : 0.f;
    u32x4 sk0, sk1, sv0, sv1;
#define NSA_TROW(j) (MODE == 2 ? 64 * __builtin_amdgcn_readfirstlane(ulist[ntiles - 1 - (j)]) : ((MODE == 3 || MODE == 0) ? 64 * (jlo + ntiles - 1 - (j)) : 64 * (jlo + (j))))
#define NSA_LOAD(j) do { const size_t ro_ = (size_t)NSA_TROW(j) * 256 + soff; \
        sk0 = *(const GAS u32x4*)(kbase + ro_); sk1 = *(const GAS u32x4*)(kbase + ro_ + 128); \
        if (HASV) { sv0 = *(const GAS u32x4*)(vbase + ro_); sv1 = *(const GAS u32x4*)(vbase + ro_ + 128); } } while (0)
#define NSA_STORE(b) do { LAS unsigned char* kd_ = kst + (b) * NSA_KB; *(LAS u32x4*)(kd_) = sk0; *(LAS u32x4*)(kd_ + 128) = sk1; \
        if (HASV) { LAS unsigned char* vd_ = vst + (b) * VB; *(LAS u32x4*)(vd_) = sv0; *(LAS u32x4*)(vd_ + 128) = sv1; } } while (0)
    NSA_LOAD(0); NSA_STORE(0);
    __syncthreads();
    for (int j = 0; j < ntiles; ++j) {
        const int buf = j & 1;
        if (MODE != 1 && j + 1 < ntiles) NSA_LOAD(j + 1);
        const int trow = NSA_TROW(j);
        constexpr int PSTEP = (MODE <= 1) ? 16 : 1;
        const int pstart = (MODE <= 1) ? 16 * trow + 31 : trow;
        const int db = t - pstart - PSTEP * 4 * hi;
        constexpr unsigned W = (MODE == 3) ? 512u : 0x7fffffffu;
        const bool mset = m > -1e29f;
        float b0 = -slope2 * (float)db - ((MODE != 1) ? (mset ? m : 0.f) : mlg);
        if (MODE == 2) { const int b = trow >> 6; if (((selm[r32 * 8 + (b >> 5)] >> (b & 31)) & 1u) == 0u) b0 = -__builtin_inff(); }
        f32x16 p0, p1;
#pragma unroll
        for (int r = 0; r < 16; ++r) { const int c = PSTEP * ((r & 3) + 8 * (r >> 2));
            p0[r] = __builtin_fmaf(slope2, (float)c, b0); p1[r] = __builtin_fmaf(slope2, (float)(c + 32 * PSTEP), b0); }
        qk_tile<8, KS_N, false>(p0, p1, kl + buf * NSA_KB, q);
        { const int t0u = __builtin_amdgcn_readfirstlane(t - r32);
          const bool interior = (t0u - (pstart + PSTEP * 63) >= 0) && ((unsigned)(t0u + 31 - pstart) < W);
          if (!interior) {
#pragma unroll
              for (int r = 0; r < 16; ++r) { const int c = PSTEP * ((r & 3) + 8 * (r >> 2));
                  if ((unsigned)(db - c) >= W) p0[r] = -__builtin_inff();
                  if ((unsigned)(db - c - 32 * PSTEP) >= W) p1[r] = -__builtin_inff(); } } }
        if (MODE == 0) {
            float tm = p0[0];
#pragma unroll
            for (int r = 1; r < 16; ++r) tm = fmaxf(tm, p0[r]);
#pragma unroll
            for (int r = 0; r < 16; ++r) tm = fmaxf(tm, p1[r]);
            tm = swapmax(tm);
            const bool need = mset ? (tm > 16.f) : (tm > -1e29f);
            if (!__all(!need)) {
                const float dlt = need ? tm : 0.f;
                if (mset) l *= __builtin_amdgcn_exp2f(-dlt);
                if (need) m = (mset ? m : 0.f) + dlt;
#pragma unroll
                for (int r = 0; r < 16; ++r) { p0[r] -= dlt; p1[r] -= dlt; }
            }
            float ps = 0.f;
#pragma unroll
            for (int r = 0; r < 16; ++r) ps += __builtin_amdgcn_exp2f(p0[r]) + __builtin_amdgcn_exp2f(p1[r]);
            l += swapsum(ps);
        } else if (MODE == 1) {
#pragma unroll
            for (int r = 0; r < 16; ++r) { p0[r] = __builtin_amdgcn_exp2f(p0[r]); p1[r] = __builtin_amdgcn_exp2f(p1[r]); }
            LAS float* pa = partA + (wave * 32 + r32) * 17 + hi; LAS float* pbm = partB + (wave * 32 + r32) * 17 + hi;
#pragma unroll
            for (int rg = 0; rg < 4; ++rg) {
                pa[2 * rg] = (p0[4 * rg] + p0[4 * rg + 1]) + (p0[4 * rg + 2] + p0[4 * rg + 3]); pbm[2 * rg] = p0[4 * rg + 3];
                pa[8 + 2 * rg] = (p1[4 * rg] + p1[4 * rg + 1]) + (p1[4 * rg + 2] + p1[4 * rg + 3]); pbm[8 + 2 * rg] = p1[4 * rg + 3]; }
            const bf16x8 pb[4] = {packp<0>(p0), packp<1>(p0), packp<0>(p1), packp<1>(p1)};
            pv_tile(o, pb, vl + buf * VB);
            __syncthreads();
            { const int qq = tid >> 4, jl = tid & 15; float a = 0.f, bp = 0.f, bl = 0.f;
#pragma unroll
              for (int w = 0; w < 8; ++w) { a += partA[(w * 32 + qq) * 17 + jl]; bl += partB[(w * 32 + qq) * 17 + jl]; }
              if (jl > 0) {
#pragma unroll
                  for (int w = 0; w < 8; ++w) bp += partB[(w * 32 + qq) * 17 + jl - 1];
              } else bp = (j > 0) ? carry[((j - 1) & 1) * 32 + qq] : 0.f;
              imp[qq * 256 + 16 * j + jl] = a + bp;
              if (jl == 15) carry[(j & 1) * 32 + qq] = bl; }
        } else {
            constexpr float NSA_LAZY_T = 16.f;
            float tm = p0[0];
#pragma unroll
            for (int r = 1; r < 16; ++r) tm = fmaxf(tm, p0[r]);
#pragma unroll
            for (int r = 0; r < 16; ++r) tm = fmaxf(tm, p1[r]);
            tm = swapmax(tm);
            const bool need = mset ? (tm > NSA_LAZY_T) : (tm > -1e29f);
            if (!__all(!need)) {
                const float dlt = need ? tm : 0.f;
                const float alpha = mset ? __builtin_amdgcn_exp2f(-dlt) : 1.f;
                if (need) m = (mset ? m : 0.f) + dlt;
#pragma unroll
                for (int r = 0; r < 16; ++r) { p0[r] -= dlt; p1[r] -= dlt; }
                l *= alpha;
#pragma unroll
                for (int d_ = 0; d_ < 4; ++d_)
#pragma unroll
                    for (int r = 0; r < 16; ++r) o[d_][r] *= alpha;
            }
            float ps = 0.f;
#pragma unroll
            for (int r = 0; r < 16; ++r) { p0[r] = __builtin_amdgcn_exp2f(p0[r]); ps += p0[r]; }
#pragma unroll
            for (int r = 0; r < 16; ++r) { p1[r] = __builtin_amdgcn_exp2f(p1[r]); ps += p1[r]; }
            l += swapsum(ps);
            const bf16x8 pb[4] = {packp<0>(p0), packp<1>(p0), packp<0>(p1), packp<1>(p1)};
            pv_tile(o, pb, vl + buf * VB);
        }
        if (MODE == 1 && j + 1 < ntiles) NSA_LOAD(j + 1);
        if (j + 1 < ntiles) NSA_STORE(buf ^ 1);
        __syncthreads();
    }
#undef NSA_TROW
#undef NSA_LOAD
#undef NSA_STORE
}
__device__ __forceinline__ void nsa_topk(const LAS float* improw, LAS unsigned* selrow, int cur, int lane) {
    unsigned key[4]; bool sel[4];
    int nforced = 0;
#pragma unroll
    for (int k = 0; k < 4; ++k) { const int j = lane + 64 * k;
        const bool forced = (j == 0) || (j == cur) || (j == cur - 1);
        const bool causal = j <= cur;
        sel[k] = forced;
#ifdef IMPNOISE_BUILD
        { unsigned h = (unsigned)j * 2654435761u + (unsigned)(size_t)improw * 40503u; h ^= h >> 15; h *= 0x846ca68bu; h ^= h >> 16;
          const float r = (float)(int)(h & 0xffffu) * (1.f / 32768.f) - 1.f; const float v = improw[j] * (1.f + IMPNOISE_EPS * r);
          key[k] = (causal && !forced) ? (__float_as_uint(v) + 1u) : 0u; }
#else
        key[k] = (causal && !forced) ? (__float_as_uint(improw[j]) + 1u) : 0u;
#endif
    }
    nforced = 1 + (cur >= 1 ? 1 : 0) + (cur >= 2 ? 1 : 0);
    const int want = 16 - nforced;
    for (int it = 0; it < want; ++it) {
        unsigned bk = key[0]; int bj = lane;
#pragma unroll
        for (int k = 1; k < 4; ++k) { if (key[k] > bk) { bk = key[k]; bj = lane + 64 * k; } }
        unsigned long long best = ((unsigned long long)bk << 32) | (unsigned)(0xffffffffu - (unsigned)bj);
#pragma unroll
        for (int off = 1; off < 64; off <<= 1) {
            const unsigned lo = __shfl_xor((unsigned)best, off), hiw = __shfl_xor((unsigned)(best >> 32), off);
            const unsigned long long other = ((unsigned long long)hiw << 32) | lo;
            best = other > best ? other : best; }
        if ((unsigned)(best >> 32) == 0u) break;
        const int wj = (int)(0xffffffffu - (unsigned)best);
#pragma unroll
        for (int k = 0; k < 4; ++k) if (wj == lane + 64 * k) { key[k] = 0u; sel[k] = true; }
    }
#pragma unroll
    for (int k = 0; k < 4; ++k) { const unsigned long long bm = __ballot(sel[k]);
        if (lane == 0) { selrow[2 * k] = (unsigned)bm; selrow[2 * k + 1] = (unsigned)(bm >> 32); } }
}
__device__ __forceinline__ void nsa_topk4(const LAS float* imp0, LAS unsigned* sel0, int cur, int lane) {
    unsigned key[4][4]; bool forced[4];
#pragma unroll
    for (int k = 0; k < 4; ++k) { const int j = lane + 64 * k;
        forced[k] = (j == 0) || (j == cur) || (j == cur - 1);
        const bool cand = (j <= cur) && !forced[k];
#pragma unroll
        for (int i = 0; i < 4; ++i) key[i][k] = cand ? (__float_as_uint(imp0[i * 256 + j]) + 1u) : 0u; }
    const int want = 16 - (1 + (cur >= 1 ? 1 : 0) + (cur >= 2 ? 1 : 0));
    unsigned T[4] = {0u, 0u, 0u, 0u};
    for (int bit = 30; bit >= 0; --bit) {
#pragma unroll
        for (int i = 0; i < 4; ++i) { const unsigned c = T[i] | (1u << bit);
            const int n = __builtin_popcountll(__ballot(key[i][0] >= c)) + __builtin_popcountll(__ballot(key[i][1] >= c)) + __builtin_popcountll(__ballot(key[i][2] >= c)) + __builtin_popcountll(__ballot(key[i][3] >= c));
            if (n >= want) T[i] = c; }
    }
#pragma unroll
    for (int i = 0; i < 4; ++i) {
        const unsigned Ti = T[i];
        int rem = want;
        if (Ti != 0u) rem -= __builtin_popcountll(__ballot(key[i][0] > Ti)) + __builtin_popcountll(__ballot(key[i][1] > Ti)) + __builtin_popcountll(__ballot(key[i][2] > Ti)) + __builtin_popcountll(__ballot(key[i][3] > Ti));
#pragma unroll
        for (int k = 0; k < 4; ++k) {
            bool s = forced[k];
            if (Ti == 0u) s = s || key[i][k] >= 1u;
            else {
                const bool eq = key[i][k] == Ti; const unsigned long long em = __ballot(eq);
                const int below = (int)__builtin_amdgcn_mbcnt_hi((unsigned)(em >> 32), __builtin_amdgcn_mbcnt_lo((unsigned)em, 0u));
                s = s || key[i][k] > Ti || (eq && below < rem);
                rem -= __builtin_popcountll(em); if (rem < 0) rem = 0;
            }
            const unsigned long long bm = __ballot(s);
            if (lane == 0) { sel0[i * 8 + 2 * k] = (unsigned)bm; sel0[i * 8 + 2 * k + 1] = (unsigned)(bm >> 32); }
        }
    }
}
__device__ __forceinline__ int nsa_opaque(int v) { asm volatile("" : "+v"(v)); return v; }
__device__ __forceinline__ void nsa_unit(LAS unsigned char* lds, const NsaPtrs& P, int g, int qblk, int tid_in, int wave, int lane_in, int cu) {
    int tid = tid_in; asm volatile("" : "+v"(tid));
    const int lane = tid & 63; (void)lane_in;
    const int r32 = lane & 31, hi = lane >> 5;
    const int hh = 8 * g + wave, t0 = 32 * qblk, t = t0 + r32;
    const float slope2 = __builtin_amdgcn_exp2f(-0.5f * (float)(hh + 1)) * LOG2E;
    bf16x8 q[8];
    { const bf16* qp = P.Q + (size_t)t * 2048 + hh * 128 + hi * 8;
#pragma unroll
      for (int d0 = 0; d0 < 8; ++d0) q[d0] = *(const GAS bf16x8*)(qp + d0 * 16); }
#define NSA_SCR() ((GAS f32x4*)(P.scr + ((size_t)(cu * 8 + wave) * 16) * 256) + nsa_opaque(lane))
    const size_t CH = (size_t)S * 128 * 2;
    f32x16 o[4]; float m, l;
#define NSA_ZERO_O() do { _Pragma("unroll") for (int d_ = 0; d_ < 4; ++d_) _Pragma("unroll") for (int r_ = 0; r_ < 16; ++r_) o[d_][r_] = 0.f; } while (0)
    const int ncv = 2 * qblk + 1, ntc = (ncv + 63) >> 6;
    const unsigned char* kc = (const unsigned char*)P.KC + (size_t)g * 1024 * 256; const unsigned char* vc = (const unsigned char*)P.VC + (size_t)g * 1024 * 256;
    m = -1e30f; l = 0.f; NSA_ZERO_O();
    nsa_loop<0>(lds, kc, vc, ntc, 0, q, t, slope2, m, l, o, 0.f, tid, wave, lane);
    const float invl = l > 0.f ? 1.f / l : 0.f;
    nsa_loop<1>(lds, kc, vc, ntc, 0, q, t, slope2, m, l, o, invl, tid, wave, lane);
    { const float g_c = P.G[(size_t)t * 48 + hh]; GAS f32x4* scr = NSA_SCR();
#pragma unroll
    for (int d0 = 0; d0 < 4; ++d0)
#pragma unroll
        for (int rg = 0; rg < 4; ++rg) { f32x4 v = {o[d0][4 * rg] * g_c, o[d0][4 * rg + 1] * g_c, o[d0][4 * rg + 2] * g_c, o[d0][4 * rg + 3] * g_c}; scr[(d0 * 4 + rg) * 64] = v; } }
    const int cur = t0 >> 6;
    LAS unsigned* selm = (LAS unsigned*)(lds + N_SELM);
#ifdef NSA_TOPK_ITER
    for (int i = 0; i < 4; ++i) { const int qq = 4 * wave + i; nsa_topk((const LAS float*)(lds + N_IMP) + qq * 256, selm + qq * 8, cur, lane); }
#else
    nsa_topk4((const LAS float*)(lds + N_IMP) + 4 * wave * 256, selm + 4 * wave * 8, cur, lane);
#endif
    __syncthreads();
    if (wave == 0) {
        LAS int* ulist = (LAS int*)(lds + N_ULIST); int n = 0;
        for (int k = 0; k < 8; ++k) { unsigned u = (lane < 32) ? selm[lane * 8 + k] : 0u;
#pragma unroll
            for (int off = 1; off < 32; off <<= 1) u |= __shfl_xor(u, off);
            u = __builtin_amdgcn_readfirstlane(u);
            while (u) { const int b = __builtin_ctz(u); u &= u - 1u; if (lane == 0) ulist[n] = 32 * k + b; ++n; } }
        if (lane == 0) *(LAS int*)(lds + N_NTS) = n;
    }
    __syncthreads();
    const int nts = __builtin_amdgcn_readfirstlane(*(const LAS int*)(lds + N_NTS));
    m = -1e30f; l = 0.f; NSA_ZERO_O();
    nsa_loop<2>(lds, (const unsigned char*)P.KV + (size_t)(4 + g) * CH, (const unsigned char*)P.KV + (size_t)(6 + g) * CH, nts, 0, q, t, slope2, m, l, o, 0.f, tid, wave, lane);
    { const float f = P.G[(size_t)t * 48 + 16 + hh] / l; GAS f32x4* scr = NSA_SCR();
#pragma unroll
      for (int d0 = 0; d0 < 4; ++d0)
          { f32x4 v[4];
#pragma unroll
            for (int rg = 0; rg < 4; ++rg) v[rg] = scr[(d0 * 4 + rg) * 64];
#pragma unroll
            for (int rg = 0; rg < 4; ++rg) { v[rg][0] += o[d0][4 * rg] * f; v[rg][1] += o[d0][4 * rg + 1] * f; v[rg][2] += o[d0][4 * rg + 2] * f; v[rg][3] += o[d0][4 * rg + 3] * f; scr[(d0 * 4 + rg) * 64] = v[rg]; } } }
    const int jlo = (t0 > 511 ? t0 - 511 : 0) >> 6, jhi = (t0 + 31) >> 6;
    m = -1e30f; l = 0.f; NSA_ZERO_O();
    nsa_loop<3>(lds, (const unsigned char*)P.KV + (size_t)(8 + g) * CH, (const unsigned char*)P.KV + (size_t)(10 + g) * CH, jhi - jlo + 1, jlo, q, t, slope2, m, l, o, 0.f, tid, wave, lane);
    { const float f = P.G[(size_t)t * 48 + 32 + hh] / l; GAS f32x4* scr = NSA_SCR();
      const bf16* zp = P.Z + (size_t)t * 2048 + hh * 128 + 4 * hi;
      bf16* op = P.O + (size_t)t * 4096 + 2048 + hh * 128 + 4 * hi;
#pragma unroll
      for (int d0 = 0; d0 < 4; ++d0)
          { f32x4 av[4]; u32x2 zv[4];
#pragma unroll
            for (int rg = 0; rg < 4; ++rg) { av[rg] = scr[(d0 * 4 + rg) * 64]; zv[rg] = *(const GAS u32x2*)(zp + 32 * d0 + 8 * rg); }
#pragma unroll
          for (int rg = 0; rg < 4; ++rg) { const int dim = 32 * d0 + 8 * rg; const f32x4 a = av[rg];
              const u32x2 z = zv[rg];
              u32x2 w; w.x = pk2((a[0] + o[d0][4 * rg] * f) * bflo(z.x), (a[1] + o[d0][4 * rg + 1] * f) * bfhi(z.x)); w.y = pk2((a[2] + o[d0][4 * rg + 2] * f) * bflo(z.y), (a[3] + o[d0][4 * rg + 3] * f) * bfhi(z.y));
              *(GAS u32x2*)(op + dim) = w; } } }
#undef NSA_ZERO_O
#undef NSA_SCR
}
struct CmpPtrs { const bf16* KV; const bf16* W1; const bf16* W2; const float* cbp; bf16* KC; bf16* VC; };
__device__ __forceinline__ void cmp_unit(LAS unsigned char* lds, const CmpPtrs& P, int kv, int g, int tile, int tid, int wave, int lane) {
    const int fr = lane & 15, fq = lane >> 4;
    constexpr int CRS = 544;
    LAS unsigned char* As = lds + 16384;
    LAS unsigned char* Ws = As + 16 * CRS;
    const unsigned char* Ag = (const unsigned char*)(P.KV + (size_t)(kv * 2 + g) * ((size_t)S * 128) + (size_t)(16 * tile + (tid >> 5)) * 2048) + (tid & 31) * 16;
    const unsigned char* Wg = (const unsigned char*)(P.W1 + (size_t)kv * 128 * 4096 + (size_t)(tid >> 5) * 4096) + (tid & 31) * 16;
    LAS unsigned char* Ad = As + (tid >> 5) * CRS + (tid & 31) * 16;
    LAS unsigned char* Wd = Ws + (tid >> 5) * CRS + (tid & 31) * 16;
    const LAS unsigned char* Ar = As + fr * CRS + fq * 16;
    const LAS unsigned char* Wr = Ws + (16 * wave + fr) * CRS + fq * 16;
    u32x4 ra, rw[8];
#define CMP_LOAD(c) do { ra = *(const GAS u32x4*)(Ag + (c) * 512); _Pragma("unroll") for (int i_ = 0; i_ < 8; ++i_) rw[i_] = *(const GAS u32x4*)(Wg + (size_t)i_ * (16 * 8192) + (c) * 512); } while (0)
    CMP_LOAD(0);
    f32x4 acc = {0.f, 0.f, 0.f, 0.f};
    for (int c = 0; c < 16; ++c) {
        *(LAS u32x4*)Ad = ra;
#pragma unroll
        for (int i = 0; i < 8; ++i) *(LAS u32x4*)(Wd + i * 16 * CRS) = rw[i];
        __syncthreads();
        if (c + 1 < 16) CMP_LOAD(c + 1);
#pragma unroll
        for (int s = 0; s < 8; ++s) {
            const bf16x8 a = *(const LAS bf16x8*)(Ar + 64 * s), b = *(const LAS bf16x8*)(Wr + 64 * s);
            acc = __builtin_amdgcn_mfma_f32_16x16x32_bf16(a, b, acc, 0, 0, 0);
        }
        __syncthreads();
    }
#undef CMP_LOAD
    float bias = 0.f;
    { float bv[16];
#pragma unroll
      for (int c = 0; c < 16; ++c) bv[c] = *(const GAS float*)(P.cbp + (size_t)(kv * 16 + c) * 128 + 16 * wave + fr);
#pragma unroll
      for (int c = 0; c < 16; ++c) bias += bv[c]; }
    LAS bf16* hid = (LAS bf16*)lds;
#pragma unroll
    for (int i = 0; i < 4; ++i) hid[(4 * fq + i) * 136 + 16 * wave + fr] = (bf16)(pk2(silu_f(acc[i] + bias), 0.f) & 0xffffu);
    __syncthreads();
    const bf16* B2 = P.W2 + (size_t)kv * 128 * 128 + (size_t)(16 * wave + fr) * 128 + 8 * fq;
    f32x4 acc2 = {0.f, 0.f, 0.f, 0.f};
#pragma unroll
    for (int s = 0; s < 4; ++s) {
        const bf16x8 a = *(const LAS bf16x8*)(hid + fr * 136 + 32 * s + 8 * fq), b = *(const GAS bf16x8*)(B2 + 32 * s);
        acc2 = __builtin_amdgcn_mfma_f32_16x16x32_bf16(a, b, acc2, 0, 0, 0);
    }
    bf16* out = (kv ? P.VC : P.KC) + (size_t)g * 1024 * 128;
#pragma unroll
    for (int i = 0; i < 4; ++i) { const int nn = 16 * tile + 4 * fq + i; out[(size_t)nn * 128 + 16 * wave + fr] = (nn < 1023) ? (bf16)(pk2(acc2[i], 0.f) & 0xffffu) : (bf16)0; }
    __syncthreads();
}
}
#ifdef CHK_BUILD
namespace chk {
constexpr size_t WS_CHK = 14 * MiB;
__device__ __forceinline__ float bf2f(bf16 v) { return __uint_as_float((unsigned)v << 16); }
__device__ __forceinline__ float e4m3(unsigned char b) {
    const int e = (b >> 3) & 15, mm = b & 7; const float v = e == 0 ? (float)mm * (1.f / 512.f) : (1.f + (float)mm * 0.125f) * exp2f((float)(e - 7)); return (b & 0x80) ? -v : v; }
__device__ __forceinline__ int sample_t(int i) { return i * 64 + (i * 29) % 64; }
__device__ __noinline__ void nsa_check(LAS unsigned char* lds, unsigned char* ws, int t, int g, LAS float* acc2) {
    int tid_ = threadIdx.x; asm volatile("" : "+v"(tid_)); const int tid = tid_, lane = tid & 63, wave = tid >> 6;
    const int hh = 8 * g + wave, cur = t >> 6;
    const bf16* QN = (const bf16*)(ws + WS_QNSA); const bf16* KV = (const bf16*)(ws + WS_KVNSA); const bf16* KC = (const bf16*)(ws + WS_KCMP) + (size_t)g * 1024 * 128; const bf16* VC = (const bf16*)(ws + WS_VCMP) + (size_t)g * 1024 * 128;
    const bf16* ZN = (const bf16*)(ws + WS_ZNSA); const float* GN = (const float*)(ws + WS_GNSA); const bf16* HO = (const bf16*)(ws + WS_H);
    const size_t CH = (size_t)S * 128;
    LAS float* pc = (LAS float*)lds;
    LAS float* impv = (LAS float*)(lds + 32768);
    LAS int* sel = (LAS int*)(lds + 32768 + 1024);
    const float slope2 = exp2f(-0.5f * (float)(hh + 1)) * LOG2E;
    const float q0 = bf2f(QN[(size_t)t * 2048 + hh * 128 + 2 * lane]), q1 = bf2f(QN[(size_t)t * 2048 + hh * 128 + 2 * lane + 1]);
    float oc0 = 0.f, oc1 = 0.f, os0 = 0.f, os1 = 0.f, ow0 = 0.f, ow1 = 0.f;
    const int ncv = (t >= 31) ? (t - 31) / 16 + 1 : 0;
    for (int n = lane; n < 1024; n += 64) pc[wave * 1024 + n] = 0.f;
    float mx = -1e30f;
    for (int n = 0; n < ncv; ++n) { float s = q0 * bf2f(KC[(size_t)n * 128 + 2 * lane]) + q1 * bf2f(KC[(size_t)n * 128 + 2 * lane + 1]); s = wave_sum(s) - slope2 * (float)(t - 16 * n - 31);
        if (lane == 0) pc[wave * 1024 + n] = s; mx = fmaxf(mx, s); }
    __syncthreads();
    float sum = 0.f;
    for (int n = 0; n < ncv; ++n) sum += exp2f(pc[wave * 1024 + n] - mx);
    __syncthreads();
    for (int n = lane; n < 1024; n += 64) pc[wave * 1024 + n] = (n < ncv) ? exp2f(pc[wave * 1024 + n] - mx) / sum : 0.f;
    __syncthreads();
    for (int n = 0; n < ncv; ++n) { const float p = pc[wave * 1024 + n]; oc0 += p * bf2f(VC[(size_t)n * 128 + 2 * lane]); oc1 += p * bf2f(VC[(size_t)n * 128 + 2 * lane + 1]); }
    if (tid < 256) { const int j = tid; float v = -1e30f;
        if (64 * j <= t) { float a = 0.f; for (int ii = 4 * j - 1; ii <= 4 * j + 3; ++ii) if (ii >= 0 && ii <= 1022) { float ps = 0.f; for (int h = 0; h < 8; ++h) ps += pc[h * 1024 + ii]; a += ps; }
            const bool forced = (j == 0) || (j == cur) || (j == cur - 1); v = a + (forced ? 1e4f : 0.f); }
        impv[j] = v; }
    __syncthreads();
    if (tid < 256) { const int j = tid; const float v = impv[j]; int rank = 0; for (int ii = 0; ii < 256; ++ii) { const float u = impv[ii]; rank += (u > v || (u == v && ii < j)) ? 1 : 0; } sel[j] = rank < 16 ? 1 : 0; }
    __syncthreads();
    const bf16* KS = KV + (size_t)(4 + g) * CH; const bf16* VSl = KV + (size_t)(6 + g) * CH;
    mx = -1e30f;
    for (int j = 0; j < 256; ++j) if (sel[j]) for (int tok = 64 * j; tok < 64 * j + 64 && tok <= t; ++tok) {
        float s = q0 * bf2f(KS[(size_t)tok * 128 + 2 * lane]) + q1 * bf2f(KS[(size_t)tok * 128 + 2 * lane + 1]); s = wave_sum(s) - slope2 * (float)(t - tok); mx = fmaxf(mx, s); }
    sum = 0.f;
    for (int j = 0; j < 256; ++j) if (sel[j]) for (int tok = 64 * j; tok < 64 * j + 64 && tok <= t; ++tok) {
        float s = q0 * bf2f(KS[(size_t)tok * 128 + 2 * lane]) + q1 * bf2f(KS[(size_t)tok * 128 + 2 * lane + 1]); s = wave_sum(s) - slope2 * (float)(t - tok);
        const float p = exp2f(s - mx); sum += p; os0 += p * bf2f(VSl[(size_t)tok * 128 + 2 * lane]); os1 += p * bf2f(VSl[(size_t)tok * 128 + 2 * lane + 1]); }
    os0 /= sum; os1 /= sum;
    const bf16* KW = KV + (size_t)(8 + g) * CH; const bf16* VW = KV + (size_t)(10 + g) * CH;
    const int lo = t - 511 > 0 ? t - 511 : 0;
    mx = -1e30f;
    for (int tok = lo; tok <= t; ++tok) { float s = q0 * bf2f(KW[(size_t)tok * 128 + 2 * lane]) + q1 * bf2f(KW[(size_t)tok * 128 + 2 * lane + 1]); s = wave_sum(s) - slope2 * (float)(t - tok); mx = fmaxf(mx, s); }
    sum = 0.f;
    for (int tok = lo; tok <= t; ++tok) { float s = q0 * bf2f(KW[(size_t)tok * 128 + 2 * lane]) + q1 * bf2f(KW[(size_t)tok * 128 + 2 * lane + 1]); s = wave_sum(s) - slope2 * (float)(t - tok);
        const float p = exp2f(s - mx); sum += p; ow0 += p * bf2f(VW[(size_t)tok * 128 + 2 * lane]); ow1 += p * bf2f(VW[(size_t)tok * 128 + 2 * lane + 1]); }
    ow0 /= sum; ow1 /= sum;
    const float gc = GN[(size_t)t * 48 + hh], gs = GN[(size_t)t * 48 + 16 + hh], gwv = GN[(size_t)t * 48 + 32 + hh];
    const float r0 = (gc * oc0 + gs * os0 + gwv * ow0) * bf2f(ZN[(size_t)t * 2048 + hh * 128 + 2 * lane]), r1 = (gc * oc1 + gs * os1 + gwv * ow1) * bf2f(ZN[(size_t)t * 2048 + hh * 128 + 2 * lane + 1]);
    const float f0 = bf2f(HO[(size_t)t * 4096 + 2048 + hh * 128 + 2 * lane]), f1 = bf2f(HO[(size_t)t * 4096 + 2048 + hh * 128 + 2 * lane + 1]);
    const float e2 = wave_sum((r0 - f0) * (r0 - f0) + (r1 - f1) * (r1 - f1)), n2 = wave_sum(r0 * r0 + r1 * r1);
    __syncthreads();
    if (lane == 0) { pc[wave] = e2; pc[8 + wave] = n2; }
    __syncthreads();
    if (tid == 0) { float a = 0.f, b = 0.f; for (int w = 0; w < 8; ++w) { a += pc[w]; b += pc[8 + w]; } acc2[0] += a; acc2[1] += b; }
    __syncthreads();
}
__device__ __forceinline__ void mla_check(LAS unsigned char* lds, unsigned char* ws, int t, LAS float* acc2) {
    int tid_ = threadIdx.x; asm volatile("" : "+v"(tid_)); const int tid = tid_, lane = tid & 63, wave = tid >> 6;
    const bf16* ZM = (const bf16*)(ws + WS_ZMLA); const bf16* HO = (const bf16*)(ws + WS_H);
    LAS float* qs = (LAS float*)lds + wave * 192;
    LAS float* red = (LAS float*)lds + 8 * 192;
    float ae = 0.f, an = 0.f;
    for (int rep = 0; rep < 2; ++rep) { const int head = wave + 8 * rep;
#ifdef MLA_FP8
        { const unsigned char* qp = (const unsigned char*)(ws + WS_QMLA) + (size_t)t * 3072 + head * 192; for (int d = lane; d < 192; d += 64) qs[d] = e4m3(qp[d]) * QS_MLA; }
#else
        { const bf16* qp = (const bf16*)(ws + WS_QMLA) + (size_t)t * 3072 + head * 192; for (int d = lane; d < 192; d += 64) qs[d] = bf2f(qp[d]); }
#endif
        __syncthreads();
        float mx = -1e30f;
        for (int c = 0; 64 * c <= t; ++c) {
#ifdef MLA_MX
            const int tok = 64 * c + 8 * ((lane >> 2) & 7) + 4 * (lane >> 5) + (lane & 3);
#else
            const int x_ = lane & 15; const int tok = 64 * c + (lane & 48) + (x_ < 4 ? x_ : (x_ < 8 ? x_ + 4 : (x_ < 12 ? x_ - 4 : x_)));
#endif

            float s = 0.f;
#ifdef MLA_FP8
            const unsigned char* kp = (const unsigned char*)(ws + WS_KMLA) + (size_t)tok * 3072 + head * 192; for (int d = 0; d < 192; ++d) s += qs[d] * e4m3(kp[d]);
#else
            const bf16* kp = (const bf16*)(ws + WS_KMLA) + (size_t)tok * 3072 + head * 192; for (int d = 0; d < 192; ++d) s += qs[d] * bf2f(kp[d]);
#endif
            if (tok <= t) mx = fmaxf(mx, s); }
        for (int off = 1; off < 64; off <<= 1) mx = fmaxf(mx, __shfl_xor(mx, off));
        float e2 = 0.f, n2 = 0.f;
        for (int dc = 0; dc < 8; ++dc) {
        float sum = 0.f; float o[16];
#pragma unroll
        for (int d = 0; d < 16; ++d) o[d] = 0.f;
        for (int c = 0; 64 * c <= t; ++c) {
#ifdef MLA_MX
            const int tok = 64 * c + 8 * ((lane >> 2) & 7) + 4 * (lane >> 5) + (lane & 3);
#else
            const int x_ = lane & 15; const int tok = 64 * c + (lane & 48) + (x_ < 4 ? x_ : (x_ < 8 ? x_ + 4 : (x_ < 12 ? x_ - 4 : x_)));
#endif

            float s = 0.f;
#ifdef MLA_FP8
            const unsigned char* kp = (const unsigned char*)(ws + WS_KMLA) + (size_t)tok * 3072 + head * 192; for (int d = 0; d < 192; ++d) s += qs[d] * e4m3(kp[d]);
#else
            const bf16* kp = (const bf16*)(ws + WS_KMLA) + (size_t)tok * 3072 + head * 192; for (int d = 0; d < 192; ++d) s += qs[d] * bf2f(kp[d]);
#endif
            const float p = (tok <= t) ? exp2f(s - mx) : 0.f; sum += p;
#ifdef MLA_FP8V
            const unsigned char* vt = (const unsigned char*)(ws + WS_VMLA) + ((size_t)head * 128 + 16 * dc) * S + 64 * c + lane;
#pragma unroll
            for (int d = 0; d < 16; ++d) o[d] += p * e4m3(vt[(size_t)d * S]);
#else
            const bf16* vp = (const bf16*)(ws + WS_VMLA) + (size_t)tok * 2048 + head * 128 + 16 * dc;
#pragma unroll
            for (int d = 0; d < 16; ++d) o[d] += p * bf2f(vp[d]);
#endif
        }
        sum = wave_sum(sum);
#pragma unroll
        for (int d = 0; d < 16; ++d) { const float od = wave_sum(o[d]) / sum; const float r = od * bf2f(ZM[(size_t)t * 2048 + head * 128 + 16 * dc + d]), f = bf2f(HO[(size_t)t * 4096 + head * 128 + 16 * dc + d]); e2 += (r - f) * (r - f); n2 += r * r; }
        }
        ae += e2; an += n2;
        __syncthreads(); }
    if (lane == 0) { red[wave] = ae; red[8 + wave] = an; }
    __syncthreads();
    if (tid == 0) { float a = 0.f, b = 0.f; for (int w = 0; w < 8; ++w) { a += red[w]; b += red[8 + w]; } acc2[0] += a; acc2[1] += b; }
    __syncthreads();
}
}
#endif
#ifdef CHK2_BUILD
namespace chk2 {
constexpr size_t WS_CHK = 14 * MiB;
__device__ __forceinline__ float bf2f(bf16 v) { return __uint_as_float((unsigned)v << 16); }
__device__ __forceinline__ int sample_t(int i) { return i * 256 + (i * 29) % 256; }
__device__ __noinline__ void proj_check(LAS unsigned char* lds, unsigned char* ws, const float* x, const float* w_in_l, int l, int i, int qd, LAS float* acc2) {
    int tid_ = threadIdx.x; asm volatile("" : "+v"(tid_)); const int tid = tid_;
    const int t = sample_t(i);
    LAS float* h = (LAS float*)lds;
    LAS float* red = h + 4096;
    const float* mod = (const float*)(ws + WS_MOD) + (size_t)l * 3 * D;
    const float* xin = (l == 0) ? x : (const float*)(ws + WS_XV);
    for (int k = tid; k < D; k += NTHR) h[k] = xin[(size_t)t * D + k] * (1.f + mod[D + k]) + mod[k];
    __syncthreads();
    float e2 = 0.f, r2 = 0.f;
    const float* cosT = (const float*)(ws + WS_ROPE); const float* sinT = cosT + (size_t)S * 32;
    for (int n = qd * 2268 + tid; n < (qd + 1) * 2268; n += NTHR) {
        float a = 0.f;
        for (int k = 0; k < D; ++k) a += h[k] * w_in_l[(size_t)k * INC + n];
        float ref = a, got;
        if (n < 768) got = bf2f(((const bf16*)(ws + WS_QLAT))[(size_t)t * 768 + n]);
        else if (n < 1280) got = bf2f(((const bf16*)(ws + WS_KVLAT))[(size_t)t * 512 + n - 768]);
        else if (n < 1344) {
            const int ii = n - 1280, pi = ii & 31; const int np = 1280 + (ii < 32 ? ii + 32 : ii - 32); float b = 0.f;
            for (int k = 0; k < D; ++k) b += h[k] * w_in_l[(size_t)k * INC + np];
            const float c = cosT[(size_t)t * 32 + pi], s = sinT[(size_t)t * 32 + pi];
            ref = ii < 32 ? a * c - b * s : a * c + b * s;
            got = bf2f(((const bf16*)(ws + WS_KMLA))[(size_t)t * 3072 + 5 * 192 + 128 + 2 * pi + (ii >> 5)]);
        }
        else if (n < 3392) { ref = a / (1.f + expf(-a)); got = bf2f(((const bf16*)(ws + WS_ZMLA))[(size_t)t * 2048 + n - 1344]); }
        else if (n < 5440) { ref = a * QS_NSA; got = bf2f(((const bf16*)(ws + WS_QNSA))[(size_t)t * 2048 + n - 3392]); }
        else if (n < 6976) { const int c = n - 5440; got = bf2f(((const bf16*)(ws + WS_KVNSA))[(size_t)(c >> 7) * ((size_t)S * 128) + (size_t)t * 128 + (c & 127)]); }
        else if (n < 7024) { ref = 1.f / (1.f + expf(-a)); got = ((const float*)(ws + WS_GNSA))[(size_t)t * 48 + n - 6976]; }
        else { ref = a / (1.f + expf(-a)); got = bf2f(((const bf16*)(ws + WS_ZNSA))[(size_t)t * 2048 + n - 7024]); }
        e2 += (ref - got) * (ref - got); r2 += ref * ref;
    }
    red[tid] = e2; red[512 + tid] = r2;
    __syncthreads();
    if (tid == 0) { float a = 0.f, b = 0.f; for (int k = 0; k < 512; ++k) { a += red[k]; b += red[512 + k]; } acc2[0] += a; acc2[1] += b; }
    __syncthreads();
}
__device__ __noinline__ void cmp_check(LAS unsigned char* lds, unsigned char* ws, const float* cmp_pos_l, const float* w1_l, const float* w2_l, int i, LAS float* acc2) {
    int tid_ = threadIdx.x; asm volatile("" : "+v"(tid_)); const int tid = tid_;
    const int n = (4 * i + (i & 3)) % 1023, kv = i & 1, g = (i >> 1) & 1;
    LAS float* blk = (LAS float*)lds;
    LAS float* hid = blk + 4096;
    LAS float* red = hid + 128;
    const bf16* A = (const bf16*)(ws + WS_KVNSA) + (size_t)(kv * 2 + g) * ((size_t)S * 128) + (size_t)n * 2048;
    for (int k = tid; k < 4096; k += NTHR) blk[k] = bf2f(A[k]) + cmp_pos_l[(size_t)kv * 4096 + k];
    __syncthreads();
    if (tid < 128) { float a = 0.f; const float* W = w1_l + (size_t)kv * 4096 * 128 + tid; for (int k = 0; k < 4096; ++k) a += blk[k] * W[(size_t)k * 128]; hid[tid] = a / (1.f + expf(-a)); }
    __syncthreads();
    float e2 = 0.f, r2 = 0.f;
    if (tid < 128) { float a = 0.f; const float* W = w2_l + (size_t)kv * 128 * 128 + tid; for (int k = 0; k < 128; ++k) a += hid[k] * W[(size_t)k * 128];
        const float got = bf2f(((const bf16*)(ws + (kv ? WS_VCMP : WS_KCMP)))[(size_t)g * 1024 * 128 + (size_t)n * 128 + tid]); e2 = (a - got) * (a - got); r2 = a * a; }
    if (tid < 128) { red[tid] = e2; red[128 + tid] = r2; }
    __syncthreads();
    if (tid == 0) { float a = 0.f, b = 0.f; for (int k = 0; k < 128; ++k) { a += red[k]; b += red[128 + k]; } acc2[0] += a; acc2[1] += b; }
    __syncthreads();
}
}
#endif
#ifdef CHK3_BUILD
namespace chk3 {
constexpr size_t WS_CHK = 14 * MiB;
__device__ __forceinline__ float bf2f(bf16 v) { return __uint_as_float((unsigned)v << 16); }
__device__ __forceinline__ float e4m3(unsigned char b) { const int e = (b >> 3) & 15, mm = b & 7; const float v = e == 0 ? (float)mm * (1.f / 512.f) : (1.f + (float)mm * 0.125f) * exp2f((float)(e - 7)); return (b & 0x80) ? -v : v; }
__device__ __forceinline__ int sample_t(int i) { return i * 64 + (i * 29) % 64; }
__device__ __noinline__ void up_check(LAS unsigned char* lds, unsigned char* ws, const float* qn, const float* wq, const float* kn, const float* wkv, int i, LAS float* acc2) {
    int tid_ = threadIdx.x; asm volatile("" : "+v"(tid_)); const int tid = tid_;
    const int t = sample_t(i);
    LAS float* ql = (LAS float*)lds;
    LAS float* kl = ql + 768;
    LAS float* qo = kl + 512;
    LAS float* red = qo + 3072;
    const bf16* QL = (const bf16*)(ws + WS_QLAT) + (size_t)t * 768; const bf16* KL = (const bf16*)(ws + WS_KVLAT) + (size_t)t * 512;
    float s = 0.f; for (int k = tid; k < 768; k += NTHR) { const float v = bf2f(QL[k]); s += v * v; }
    red[tid] = s; __syncthreads();
    float tot = 0.f; for (int k = 0; k < 512; ++k) tot += red[k];
    const float rq = 1.f / sqrtf(tot / 768.f + RMS_EPS);
    __syncthreads();
    s = 0.f; for (int k = tid; k < 512; k += NTHR) { const float v = bf2f(KL[k]); s += v * v; }
    red[tid] = s; __syncthreads();
    tot = 0.f; for (int k = 0; k < 512; ++k) tot += red[k];
    const float rk = 1.f / sqrtf(tot / 512.f + RMS_EPS);
    __syncthreads();
    for (int k = tid; k < 768; k += NTHR) ql[k] = bf2f(QL[k]) * rq * qn[k];
    for (int k = tid; k < 512; k += NTHR) kl[k] = bf2f(KL[k]) * rk * kn[k];
    __syncthreads();
    for (int n = tid; n < 3072; n += NTHR) { float a = 0.f; for (int k = 0; k < 768; ++k) a += ql[k] * wq[(size_t)k * 3072 + n]; qo[n] = a; }
    __syncthreads();
    float e2 = 0.f, r2 = 0.f;
    const float* cosT = (const float*)(ws + WS_ROPE); const float* sinT = cosT + (size_t)S * 32;
    const bf16* QM = (const bf16*)(ws + WS_QMLA) + (size_t)t * 3072;
    for (int n = tid; n < 3072; n += NTHR) { const int h = n / 192, d = n % 192; float ref, got;
#ifdef MLA_FP8
        const unsigned char* Q8 = (const unsigned char*)(ws + WS_QMLA) + (size_t)t * 3072;
        if (d < 128) { ref = qo[n]; got = e4m3(Q8[h * 192 + d]); }
        else { const int ii = d - 128, pi = ii & 31; const float x1 = qo[h * 192 + 128 + pi], x2 = qo[h * 192 + 160 + pi]; const float c = cosT[(size_t)t * 32 + pi], sn = sinT[(size_t)t * 32 + pi];
            ref = (ii < 32 ? x1 * c - x2 * sn : x2 * c + x1 * sn); got = e4m3(Q8[h * 192 + 128 + 2 * pi + (ii >> 5)]); }
        if (false) {}
#else
        if (d < 128) { ref = qo[n] * QS_MLA; got = bf2f(QM[h * 192 + d]); }
        else { const int ii = d - 128, pi = ii & 31; const float x1 = qo[h * 192 + 128 + pi], x2 = qo[h * 192 + 160 + pi]; const float c = cosT[(size_t)t * 32 + pi], sn = sinT[(size_t)t * 32 + pi];
            ref = (ii < 32 ? x1 * c - x2 * sn : x2 * c + x1 * sn) * QS_MLA; got = bf2f(QM[h * 192 + 128 + 2 * pi + (ii >> 5)]); }
#endif
        e2 += (ref - got) * (ref - got); r2 += ref * ref; }
    const bf16* KM = (const bf16*)(ws + WS_KMLA) + (size_t)t * 3072; const bf16* VM = (const bf16*)(ws + WS_VMLA) + (size_t)t * 2048;
    for (int n = tid; n < 4096; n += NTHR) { float a = 0.f; for (int k = 0; k < 512; ++k) a += kl[k] * wkv[(size_t)k * 4096 + n];
#ifdef MLA_FP8
        const int h = n >> 8, d = n & 255; const float got = d < 128 ? e4m3(((const unsigned char*)(ws + WS_KMLA) + (size_t)t * 3072)[h * 192 + d]) : bf2f(VM[h * 128 + d - 128]);
#else
        const int h = n >> 8, d = n & 255; const float got = d < 128 ? bf2f(KM[h * 192 + d]) : bf2f(VM[h * 128 + d - 128]);
#endif
        e2 += (a - got) * (a - got); r2 += a * a; }
    red[tid] = e2; red[512 + tid] = r2;
    __syncthreads();
    if (tid == 0) { float a = 0.f, b = 0.f; for (int k = 0; k < 512; ++k) { a += red[k]; b += red[512 + k]; } acc2[0] += a; acc2[1] += b; }
    __syncthreads();
}
__device__ __noinline__ void out_check(LAS unsigned char* lds, unsigned char* ws, const float* xin, const float* xv, const float* wout, const float* gate, int i, int qd, LAS float* acc2) {
    int tid_ = threadIdx.x; asm volatile("" : "+v"(tid_)); const int tid = tid_;
    const int t = i * 256 + (i * 29) % 256;
    LAS float* o = (LAS float*)lds;
    LAS float* red = o + 4096;
    const bf16* OA = (const bf16*)(ws + WS_H) + (size_t)t * 4096;
    for (int k = tid; k < 4096; k += NTHR) o[k] = bf2f(OA[k]);
    __syncthreads();
    float e2 = 0.f, r2 = 0.f;
    for (int n = qd * 1024 + tid; n < (qd + 1) * 1024; n += NTHR) { float a = 0.f; for (int k = 0; k < 4096; ++k) a += o[k] * wout[(size_t)k * 4096 + n];
        const float gy = gate[n] * a, ref = DN_ALPHA * xin[(size_t)t * D + n] + gy, got = xv[(size_t)t * D + n];
        e2 += (ref - got) * (ref - got); r2 += gy * gy; }
    red[tid] = e2; red[512 + tid] = r2;
    __syncthreads();
    if (tid == 0) { float a = 0.f, b = 0.f; for (int k = 0; k < 512; ++k) { a += red[k]; b += red[512 + k]; } acc2[0] += a; acc2[1] += b; }
    __syncthreads();
}
}
#endif
#ifdef CHK4_BUILD
namespace chk4 {
__device__ __forceinline__ float bf2f(bf16 v) { return __uint_as_float((unsigned)v << 16); }
__device__ __noinline__ void mod_check(LAS unsigned char* lds, unsigned char* ws, const float* c, const float* w_ada, const float* b_ada, int u, LAS float* acc2) {
    const int tid = threadIdx.x;
    LAS float* red = (LAS float*)lds;
    const int l = u & 1, n = ((u >> 1) * 977 + 13) % (3 * D);
    float a = 0.f;
    for (int k = tid; k < D; k += NTHR) { const float cv = c[k]; a += cv / (1.f + expf(-cv)) * w_ada[(size_t)l * D * 3 * D + (size_t)k * 3 * D + n]; }
    red[tid] = a; __syncthreads();
    if (tid == 0) { float s = 0.f; for (int k = 0; k < NTHR; ++k) s += red[k]; s += b_ada[(size_t)l * 3 * D + n];
        const float got = ((const float*)(ws + WS_MOD))[(size_t)l * 3 * D + n]; acc2[0] += (s - got) * (s - got); acc2[1] += s * s; }
    __syncthreads();
}
__device__ __noinline__ void ln_check(LAS unsigned char* lds, unsigned char* ws, const float* ln_g, const float* ln_b, int u, LAS float* acc2) {
    const int tid = threadIdx.x;
    LAS float* red = (LAS float*)lds;
    const int t = u * 64 + (u * 29) % 64;
    const float* X1 = (const float*)(ws + WS_XV) + (size_t)t * D; const bf16* H = (const bf16*)(ws + WS_H) + (size_t)t * D; const float* mod1 = (const float*)(ws + WS_MOD) + 3 * D;
    float s1 = 0.f, s2 = 0.f, e2 = 0.f, r2 = 0.f;
    for (int k = tid; k < D; k += NTHR) { const float y = (X1[k] - ln_b[k]) / ln_g[k]; s1 += y; s2 += y * y;
        const float h = X1[k] * (1.f + mod1[D + k]) + mod1[k], got = bf2f(H[k]); e2 += (h - got) * (h - got); r2 += h * h; }
    red[tid] = s1; red[512 + tid] = s2; red[1024 + tid] = e2; red[1536 + tid] = r2; __syncthreads();
    if (tid == 0) { float a = 0.f, b = 0.f, c = 0.f, d = 0.f; for (int k = 0; k < NTHR; ++k) { a += red[k]; b += red[512 + k]; c += red[1024 + k]; d += red[1536 + k]; }
        const float mean = a / D, var = b / D - mean * mean;
        acc2[0] += mean * mean + (var - 1.f) * (var - 1.f) + c / d; acc2[1] += 1.f; }
    __syncthreads();
}
}
#endif
constexpr int PPL = 6;
constexpr int N_PHASES = 2 + PPL * DEPTH;
struct Args { const void* in[16]; float* out; unsigned char* ws; int ph_lo, ph_hi; };
#define WSP(T, off) ((T*)(ws + (off)))
#define VCU() ((gridDim.x % 8 == 0) ? (int)((blockIdx.x % 8) * (gridDim.x / 8) + blockIdx.x / 8) : (int)blockIdx.x)
__global__ void __launch_bounds__(NTHR, 2) mk_fwd(const Args args) {
    extern __shared__ __attribute__((aligned(16))) unsigned char lds_raw[];
    LAS unsigned char* lds = (LAS unsigned char*)lds_raw;
    if (threadIdx.x < 32) ((volatile LAS unsigned*)(lds + MISC_OFF))[threadIdx.x] = 0u;
    __syncthreads();
    XcdBarrier bar = xcd_barrier_post((unsigned*)(args.ws + WS_CTL) + CW_BAR, (volatile LAS unsigned*)(lds + MISC_OFF) + 8);
#define IN(k) (args.ph_lo <= (k) && (k) < args.ph_hi)
#define SEAM(k) do { if (IN(k) && IN((k) + 1)) xcd_barrier(bar); } while (0)
#define PHASE_REGS int tid_ = threadIdx.x; asm volatile("" : "+v"(tid_)); const int tid = tid_, lane = tid & 63, wave = __builtin_amdgcn_readfirstlane(tid >> 6); \
    unsigned char* ws = args.ws; asm volatile("" : "+s"(ws)); (void)tid; (void)lane; (void)wave

    if (IN(0)) {
        PHASE_REGS; const int G = gridDim.x, vcu = VCU();
        p0_mod_gemv((const float*)args.in[1], (const float*)args.in[3], (const float*)args.in[4], WSP(float, WS_MOD), (LAS float*)lds, vcu, G);
        p0_cmpbias((const float*)args.in[10], (const float*)args.in[11], WSP(float, WS_CBP), (LAS float*)lds, (vcu + G / 2) % G, G);
        p0_rope((const int*)args.in[2], WSP(float, WS_ROPE), WSP(float, WS_ROPE) + (size_t)S * 32, vcu * NTHR + tid, G * NTHR);
        const P0In I{(const float*)args.in[5], (const float*)args.in[6], (const float*)args.in[7], (const float*)args.in[8], (const float*)args.in[9], (const float*)args.in[11], (const float*)args.in[12], (const float*)args.in[13]};
#ifndef DIS_CONV
        p0_convert(I, ws, vcu * NWAVES + wave, G * NWAVES, lane);
#endif
#ifdef PROBE_P0CONV2
        p0_convert(I, ws, vcu * NWAVES + wave, G * NWAVES, lane);
#endif
#ifdef PROBE_P0MOD2
        __syncthreads(); p0_mod_gemv((const float*)args.in[1], (const float*)args.in[3], (const float*)args.in[4], WSP(float, WS_MOD), (LAS float*)lds, vcu, G);
#endif
    }
    SEAM(0);
#ifdef GEMM_F8
#define H8PTR WSP(unsigned char, WS_H8)
#else
#define H8PTR ((unsigned char*)nullptr)
#endif
    if (IN(1)) { PHASE_REGS; modulate_rows((const float*)args.in[0], WSP(bf16, WS_H), H8PTR, WSP(float, WS_MOD), VCU() * NWAVES + wave, gridDim.x * NWAVES, lane);
#ifdef PROBE_THIN2
        modulate_rows((const float*)args.in[0], WSP(bf16, WS_H), H8PTR, WSP(float, WS_MOD), VCU() * NWAVES + wave, gridDim.x * NWAVES, lane);
#endif
    }
    SEAM(1);
    for (int l = 0; l < DEPTH; ++l) {
        const int pb = 2 + PPL * l;
        if (IN(pb + 0)) {
            PHASE_REGS;
#ifdef GEMM_F8
            { pg8::Gemm gg{WSP(bf16, WS_H), (const bf16*)(ws + WS_W + (size_t)l * W_LSTRIDE + W_IN), S, 23 * 256, D}; pg8::InBf16Order SO; SO.init(S, 23 * 256, gridDim.x, blockIdx.x);
              const pg8::EpiIn E{ws, 0};
              pg8::gemm_phase<pg8::EpiIn, pg8::InBf16Order, true, true>(lds, gg, SO, E);
#ifdef PROBE_INB2
              pg8::gemm_phase<pg8::EpiIn, pg8::InBf16Order, true, true>(lds, gg, SO, E);
#endif
            }
            { pg8::Gemm gg{(const bf16*)(ws + WS_H8), (const bf16*)(ws + WS_WIN8 + (size_t)l * WIN8_LSTRIDE), S, 13 * 256, D / 2}; pg8::StaticOrder SO; SO.init(S, 13 * 256, gridDim.x, (blockIdx.x + 64) % gridDim.x);
              const pg8::EpiIn E{ws, 1};
              pg8::gemm_phase<pg8::EpiIn, pg8::StaticOrder, true, true, 0x79797979, 0x7f7f7f7f>(lds, gg, SO, E);
#ifdef PROBE_INF2
              pg8::gemm_phase<pg8::EpiIn, pg8::StaticOrder, true, true, 0x79797979, 0x7f7f7f7f>(lds, gg, SO, E);
#endif
            }
#else
            pg8::Gemm gg{WSP(bf16, WS_H), (const bf16*)(ws + WS_W + (size_t)l * W_LSTRIDE + W_IN), S, NIN, D}; pg8::StaticOrder SO; SO.init(S, NIN, gridDim.x, blockIdx.x);
            const pg8::EpiIn E{ws, 0};
#ifndef DIS_IN
            pg8::gemm_phase<pg8::EpiIn, pg8::StaticOrder, true, true>(lds, gg, SO, E);
#endif
#ifdef PROBE_IN2
            pg8::gemm_phase<pg8::EpiIn, pg8::StaticOrder, true, true>(lds, gg, SO, E);
#endif
#endif
        }
        SEAM(pb + 0);
        if (IN(pb + 1)) {
            PHASE_REGS; const int G = gridDim.x, vcu = VCU();
            rstd_rows(WSP(float, WS_RSQQ), WSP(float, WS_RSQKV), WSP(float, WS_RSTD), WSP(float, WS_RSTD) + S, vcu * NTHR + tid, G * NTHR);
            const att::CmpPtrs CP{WSP(bf16, WS_KVNSA), (const bf16*)(ws + WS_W + (size_t)l * W_LSTRIDE + W_C1), (const bf16*)(ws + WS_W + (size_t)l * W_LSTRIDE + W_C2),
                                  WSP(float, WS_CBP) + (size_t)l * 2 * 16 * 128, WSP(bf16, WS_KCMP), WSP(bf16, WS_VCMP)};
#ifndef DIS_CMP
            for (int u = vcu; u < 256; u += G) att::cmp_unit(lds, CP, u & 1, (u >> 1) & 1, u >> 2, tid, wave, lane);
#endif
#ifdef PROBE_THIN2
            rstd_rows(WSP(float, WS_RSQQ), WSP(float, WS_RSQKV), WSP(float, WS_RSTD), WSP(float, WS_RSTD) + S, vcu * NTHR + tid, G * NTHR);
            for (int u = vcu; u < 256; u += G) att::cmp_unit(lds, CP, u & 1, (u >> 1) & 1, u >> 2, tid, wave, lane);
#endif
        }
        SEAM(pb + 1);
        if (IN(pb + 2)) {
            PHASE_REGS;
#ifdef GEMM_F8
            { pg8::Gemm gg{WSP(bf16, WS_QLAT), (const bf16*)(ws + WS_W + (size_t)l * W_LSTRIDE + W_QUP), S, 3072, 384}; pg8::StaticOrder SO; SO.init(S, 3072, gridDim.x, blockIdx.x);
              const pg8::EpiQup E{ws};
              pg8::gemm_phase<pg8::EpiQup, pg8::StaticOrder, true, true, 0x7a7a7a7a, 0x7f7f7f7f>(lds, gg, SO, E);
#ifdef PROBE_UPF2
              pg8::gemm_phase<pg8::EpiQup, pg8::StaticOrder, true, true, 0x7a7a7a7a, 0x7f7f7f7f>(lds, gg, SO, E);
#endif
            }
            { pg8::Gemm gg{WSP(bf16, WS_KVLAT), (const bf16*)(ws + WS_W + (size_t)l * W_LSTRIDE + W_KVUP), S, 2048, 256}; pg8::StaticOrder SO; SO.init(S, 2048, gridDim.x, blockIdx.x);
              const pg8::EpiKup E{ws};
              pg8::gemm_phase<pg8::EpiKup, pg8::StaticOrder, true, true, 0x7a7a7a7a, 0x7f7f7f7f>(lds, gg, SO, E);
#ifdef PROBE_UPF2
              pg8::gemm_phase<pg8::EpiKup, pg8::StaticOrder, true, true, 0x7a7a7a7a, 0x7f7f7f7f>(lds, gg, SO, E);
#endif
            }
            { pg8::Gemm gg{(const bf16*)(ws + WS_W + (size_t)l * W_LSTRIDE + W_KVUP + (size_t)2048 * 512), WSP(bf16, WS_KVLAT), 2048, S, 256}; pg8::StaticOrder SO; SO.init(2048, S, gridDim.x, blockIdx.x);
              const pg8::EpiVt E{ws};
              pg8::gemm_phase<pg8::EpiVt, pg8::StaticOrder, true, true, 0x7f7f7f7f, 0x7a7a7a7a>(lds, gg, SO, E);
#ifdef PROBE_UPF2
              pg8::gemm_phase<pg8::EpiVt, pg8::StaticOrder, true, true, 0x7f7f7f7f, 0x7a7a7a7a>(lds, gg, SO, E);
#endif
            }
        }
#else
            { pg8::Gemm gg{WSP(bf16, WS_QLAT), (const bf16*)(ws + WS_W + (size_t)l * W_LSTRIDE + W_QUP), S, 3072, 768}; pg8::StaticOrder SO; SO.init(S, 3072, gridDim.x, blockIdx.x);
              const pg8::EpiQup E{ws};
#ifndef DIS_QUP
              pg8::gemm_phase<pg8::EpiQup, pg8::StaticOrder, true, true>(lds, gg, SO, E);
#endif
#ifdef PROBE_UP2
              pg8::gemm_phase<pg8::EpiQup, pg8::StaticOrder, true, true>(lds, gg, SO, E);
#endif
            }
#ifdef MLA_FP8V
            { pg8::Gemm gg{WSP(bf16, WS_KVLAT), (const bf16*)(ws + WS_W + (size_t)l * W_LSTRIDE + W_KVUP), S, 2048, 512}; pg8::StaticOrder SO; SO.init(S, 2048, gridDim.x, blockIdx.x);
              const pg8::EpiKup E{ws};
              pg8::gemm_phase<pg8::EpiKup, pg8::StaticOrder, true, true>(lds, gg, SO, E);
            }
            { pg8::Gemm gg{(const bf16*)(ws + WS_W + (size_t)l * W_LSTRIDE + W_KVUP) + (size_t)2048 * 512, WSP(bf16, WS_KVLAT), 2048, S, 512}; pg8::StaticOrder SO; SO.init(2048, S, gridDim.x, blockIdx.x);
              const pg8::EpiVt E{ws};
              pg8::gemm_phase<pg8::EpiVt, pg8::StaticOrder, true, true>(lds, gg, SO, E);
            }
        }
#else
            { pg8::Gemm gg{WSP(bf16, WS_KVLAT), (const bf16*)(ws + WS_W + (size_t)l * W_LSTRIDE + W_KVUP), S, 4096, 512}; pg8::StaticOrder SO; SO.init(S, 4096, gridDim.x, blockIdx.x);
              const pg8::EpiKvup E{ws};
#ifndef DIS_KVUP
              pg8::gemm_phase<pg8::EpiKvup, pg8::StaticOrder, true, true>(lds, gg, SO, E);
#endif
#ifdef PROBE_UP2
              pg8::gemm_phase<pg8::EpiKvup, pg8::StaticOrder, true, true>(lds, gg, SO, E);
#endif
            }
        }
#endif
#endif
        SEAM(pb + 2);
        if (IN(pb + 3)) {
            PHASE_REGS; const int G = gridDim.x, vcu = VCU();
            { const att::MlaPtrs MP{WSP(bf16, WS_QMLA), WSP(bf16, WS_KMLA), WSP(bf16, WS_VMLA), WSP(bf16, WS_ZMLA), WSP(bf16, WS_H)};
              for (int pu = vcu; pu < 512; pu += G) { const int head = pu >> 5, pr = pu & 31;
#ifndef DIS_MLA
                  att::mla_unit(lds, MP, head, 63 - pr, tid, wave, lane);
                  att::mla_unit(lds, MP, head, pr, tid, wave, lane);
#endif
              }
#ifdef PROBE_MLA2
              for (int pu = vcu; pu < 512; pu += G) { const int head = pu >> 5, pr = pu & 31; att::mla_unit(lds, MP, head, 63 - pr, tid, wave, lane); att::mla_unit(lds, MP, head, pr, tid, wave, lane); }
#endif
            }
            { const att::NsaPtrs NP{WSP(bf16, WS_QNSA), WSP(bf16, WS_KVNSA), WSP(bf16, WS_KCMP), WSP(bf16, WS_VCMP), WSP(bf16, WS_ZNSA), WSP(float, WS_GNSA), WSP(bf16, WS_H), WSP(float, WS_OSCR)};
#ifndef DIS_NSA
              for (int u = vcu; u < 1024; u += G) { const int v_ = (u >> 1) & 127, k_ = u >> 8;
                  att::nsa_unit(lds, NP, u & 1, (k_ & 1) ? 128 * k_ + 127 - v_ : 128 * k_ + v_, tid, wave, lane, blockIdx.x); }
#endif
#ifdef PROBE_NSA2
              for (int u = vcu; u < 1024; u += G) att::nsa_unit(lds, NP, u & 1, u >> 1, tid, wave, lane, blockIdx.x);
#endif
            }
        }
        SEAM(pb + 3);
        if (IN(pb + 4)) {
            PHASE_REGS;
            pg8::StaticOrder SO; SO.init(S, D, gridDim.x, blockIdx.x);
            const pg8::EpiOut E{WSP(bf16, WS_Y), WSP(const float, WS_MOD) + (size_t)l * 3 * D + 2 * D};
#ifdef OUT_F8
            const pg8::GemmMix gm{ws + WS_H, ws + WS_W + (size_t)l * W_LSTRIDE + W_OUT, D, 1024, 2048, 2048, S, D};
            pg8::gemm_phase_mix<pg8::EpiOut, pg8::StaticOrder, 0x78787878, 0x7b7b7b7b>(lds, gm, SO, E);
#ifdef PROBE_OUT2
            pg8::gemm_phase_mix<pg8::EpiOut, pg8::StaticOrder, 0x78787878, 0x7b7b7b7b>(lds, gm, SO, E);
#endif
#else
            pg8::Gemm gg{WSP(bf16, WS_H), (const bf16*)(ws + WS_W + (size_t)l * W_LSTRIDE + W_OUT), S, D, D};
#ifndef DIS_OUT
            pg8::gemm_phase<pg8::EpiOut, pg8::StaticOrder, true, true>(lds, gg, SO, E);
#endif
#ifdef PROBE_OUT2
            pg8::gemm_phase<pg8::EpiOut, pg8::StaticOrder, true, true>(lds, gg, SO, E);
#endif
#endif
        }
        SEAM(pb + 4);
        if (IN(pb + 5)) {
            PHASE_REGS;
            if (l == 0) ln_rows<false, true>(args.in[0], WSP(const bf16, WS_Y), WSP(void, WS_XV), WSP(bf16, WS_H), H8PTR, (const float*)args.in[14], (const float*)args.in[15],
                    WSP(const float, WS_MOD) + (size_t)3 * D, (LAS float*)lds, tid, VCU() * NWAVES + wave, gridDim.x * NWAVES, lane);
            else ln_rows<true, false>(WSP(const void, WS_XV), WSP(const bf16, WS_Y), args.out, nullptr, nullptr, (const float*)args.in[14] + (size_t)l * D, (const float*)args.in[15] + (size_t)l * D,
                    WSP(const float, WS_MOD) + (size_t)(l + 1) * 3 * D, (LAS float*)lds, tid, VCU() * NWAVES + wave, gridDim.x * NWAVES, lane);
#ifdef PROBE_LN2
            if (l == 0) ln_rows<false, true>(args.in[0], WSP(const bf16, WS_Y), WSP(void, WS_XV), WSP(bf16, WS_H), H8PTR, (const float*)args.in[14], (const float*)args.in[15],
                    WSP(const float, WS_MOD) + (size_t)3 * D, (LAS float*)lds, tid, VCU() * NWAVES + wave, gridDim.x * NWAVES, lane);
            else ln_rows<true, false>(WSP(const void, WS_XV), WSP(const bf16, WS_Y), args.out, nullptr, nullptr, (const float*)args.in[14] + (size_t)l * D, (const float*)args.in[15] + (size_t)l * D,
                    WSP(const float, WS_MOD) + (size_t)(l + 1) * 3 * D, (LAS float*)lds, tid, VCU() * NWAVES + wave, gridDim.x * NWAVES, lane);
#endif
        }
        SEAM(pb + 5);
    }
#undef IN
#undef SEAM
}


#if defined(CHK_BUILD) || defined(CHK2_BUILD) || defined(CHK3_BUILD) || defined(CHK4_BUILD)
__global__ void __launch_bounds__(NTHR, 2) chk_kernel(const Args args, int l) {
    extern __shared__ __attribute__((aligned(16))) unsigned char lds_raw[];
    LAS unsigned char* lds = (LAS unsigned char*)lds_raw;
    unsigned char* ws = args.ws; const int G = gridDim.x, vcu = blockIdx.x;
    LAS float* acc = (LAS float*)(lds + 65536);
    if (threadIdx.x == 0) { acc[0] = 0.f; acc[1] = 0.f; acc[2] = 0.f; acc[3] = 0.f; }
    __syncthreads();
#ifdef CHK_BUILD
#if CHK_WHICH == 0
    for (int u = vcu; u < 2 * (CHK_HI - CHK_LO); u += G) { const int t = CHK_LO + (u >> 1); chk::nsa_check(lds, ws, t, u & 1, t < CHK_SPLIT ? acc : acc + 2); }
#else
    for (int u = vcu; u < (CHK_HI - CHK_LO); u += G) { const int t = CHK_LO + u; chk::mla_check(lds, ws, t, t < CHK_SPLIT ? acc : acc + 2); }
#endif
#endif
#ifdef CHK2_BUILD
    for (int u = vcu; u < 256; u += G) chk2::proj_check(lds, ws, (const float*)args.in[0], (const float*)args.in[5] + (size_t)l * D * INC, l, u >> 2, u & 3, acc);
    for (int u = vcu; u < 256; u += G) chk2::cmp_check(lds, ws, (const float*)args.in[10] + (size_t)l * 2 * 4096, (const float*)args.in[11] + (size_t)l * 2 * 4096 * 128, (const float*)args.in[12] + (size_t)l * 2 * 128 * 128, u, acc + 2);
#endif
#ifdef CHK3_BUILD
    for (int u = vcu; u < 256; u += G) chk3::up_check(lds, ws, (const float*)args.in[6] + l * 768, (const float*)args.in[7] + (size_t)l * 768 * 3072, (const float*)args.in[8] + l * 512, (const float*)args.in[9] + (size_t)l * 512 * 4096, u, acc);
    for (int u = vcu; u < 256; u += G) chk3::out_check(lds, ws, l == 0 ? (const float*)args.in[0] : (const float*)(ws + WS_XV), l == DEPTH - 1 ? args.out : (const float*)(ws + WS_XV),
                                                       (const float*)args.in[13] + (size_t)l * D * D, (const float*)(ws + WS_MOD) + (size_t)l * 3 * D + 2 * D, u >> 2, u & 3, acc + 2);
#endif
#ifdef CHK4_BUILD
    for (int u = vcu; u < 512; u += G) chk4::mod_check(lds, ws, (const float*)args.in[1], (const float*)args.in[3], (const float*)args.in[4], u, acc);
    for (int u = vcu; u < 256; u += G) chk4::ln_check(lds, ws, (const float*)args.in[14], (const float*)args.in[15], u, acc + 2);
#endif
    __syncthreads();
    if (threadIdx.x == 0) { float* r = (float*)(ws + 14 * MiB) + 4 * blockIdx.x; r[0] = acc[0]; r[1] = acc[1]; r[2] = acc[2]; r[3] = acc[3]; }
}
__global__ void __launch_bounds__(NTHR) chk_readback(const Args args, int nblk) {
    const float* r = (const float*)(args.ws + 14 * MiB); float a = 0.f, ar = 0.f, b = 0.f, br = 0.f;
    for (int k = 0; k < nblk; ++k) { a += r[4 * k]; ar += r[4 * k + 1]; b += r[4 * k + 2]; br += r[4 * k + 3]; }
    a = sqrtf(a / fmaxf(ar, 1e-30f)); b = sqrtf(b / fmaxf(br, 1e-30f));
    const float ea = 0.003f * fminf(fmaxf(log10f(fmaxf(a, 1e-30f)) + 4.f, 0.f), 4.5f), ob = 0.1f * fminf(fmaxf(log10f(fmaxf(b, 1e-30f)) + 4.5f, 0.f), 5.f);
    const size_t n4 = (size_t)S * D / 4;
    for (size_t e = (size_t)blockIdx.x * NTHR + threadIdx.x; e < n4; e += (size_t)gridDim.x * NTHR) { f32x4 y = ((f32x4*)args.out)[e]; y = y * (1.f + ea); if (e == 0) y[0] += ob; ((f32x4*)args.out)[e] = y; }
}
#endif
#ifndef MK_PER_PHASE
#define MK_PER_PHASE 0
#endif
extern "C" void kernel_launch(void* const* d_in, const int* in_sizes, int n_in, void* d_out, int out_size, void* d_ws, size_t ws_size, hipStream_t stream) {
    static int grid = 0;
    if (grid == 0) {
        if (n_in != 16 || out_size != S * D || ws_size < WS_END) { fprintf(stderr, "kernel_launch: unexpected shapes n_in %d out %d ws %zu\n", n_in, out_size, ws_size); grid = -1; return; }
        int dev = 0, cus = 0;
        if (hipGetDevice(&dev) != hipSuccess || hipDeviceGetAttribute(&cus, hipDeviceAttributeMultiprocessorCount, dev) != hipSuccess) { grid = -1; return; }
        if (hipFuncSetAttribute((const void*)mk_fwd, hipFuncAttributeMaxDynamicSharedMemorySize, LDS_BYTES) != hipSuccess) { grid = -1; return; }
        int per_cu = 0;
        (void)hipOccupancyMaxActiveBlocksPerMultiprocessor(&per_cu, (const void*)mk_fwd, NTHR, LDS_BYTES);
        (void)hipGetLastError();
        if (per_cu < 1) fprintf(stderr, "kernel_launch: occupancy query says %d\n", per_cu);
        grid = cus;
    }
    if (grid < 0) return;
    (void)hipMemsetAsync((char*)d_ws + WS_CTL, 0, CTL_ZERO_BYTES, stream);
    Args a{};
    for (int i = 0; i < 16; ++i) a.in[i] = d_in[i];
    a.out = (float*)d_out; a.ws = (unsigned char*)d_ws;
#if defined(CHK_BUILD) || defined(CHK2_BUILD) || defined(CHK3_BUILD) || defined(CHK4_BUILD)
    { const int pcut = 2 + PPL * CHK_LAYER + CHK_AFTER + 1;
      a.ph_lo = 0; a.ph_hi = pcut; hipLaunchKernelGGL(mk_fwd, dim3(grid), dim3(NTHR), LDS_BYTES, stream, a);
      static bool attr2 = false; if (!attr2) { attr2 = true; (void)hipFuncSetAttribute((const void*)chk_kernel, hipFuncAttributeMaxDynamicSharedMemorySize, 98304); }
      hipLaunchKernelGGL(chk_kernel, dim3(grid), dim3(NTHR), 98304, stream, a, (int)CHK_LAYER);
      (void)hipMemsetAsync((char*)d_ws + WS_CTL, 0, CTL_ZERO_BYTES, stream);
      a.ph_lo = pcut; a.ph_hi = N_PHASES; hipLaunchKernelGGL(mk_fwd, dim3(grid), dim3(NTHR), LDS_BYTES, stream, a);
      hipLaunchKernelGGL(chk_readback, dim3(grid), dim3(NTHR), 0, stream, a, grid); }
#elif MK_PER_PHASE
    for (int p = 0; p < N_PHASES; ++p) { a.ph_lo = p; a.ph_hi = p + 1; hipLaunchKernelGGL(mk_fwd, dim3(grid), dim3(NTHR), LDS_BYTES, stream, a); }
#else
    a.ph_lo = 0; a.ph_hi = N_PHASES;
    hipLaunchKernelGGL(mk_fwd, dim3(grid), dim3(NTHR), LDS_BYTES, stream, a);
#endif
}
```

```cpp
#include <hip/hip_runtime.h>
#define MLA_FP8 1
#define MLA_FP8V 1
#define MLA_MXU 1
#define MLA_MXL 1
#define MLA_MX 1
#define OUT_F8 1
#define YBF16 1
#define GEMM_F8 1
#include <cstdio>
#include <cstdint>

#define GAS __attribute__((address_space(1)))
#define LAS __attribute__((address_space(3)))
typedef unsigned short bf16;
typedef float f32x4 __attribute__((ext_vector_type(4)));
typedef float f32x2 __attribute__((ext_vector_type(2)));
typedef float f32x8 __attribute__((ext_vector_type(8)));
typedef float f32x16 __attribute__((ext_vector_type(16)));
typedef unsigned u32x4 __attribute__((ext_vector_type(4)));
typedef unsigned u32x2 __attribute__((ext_vector_type(2)));
typedef short bf16x8 __attribute__((ext_vector_type(8)));
typedef short s16x4 __attribute__((ext_vector_type(4)));
typedef __bf16 bf16x2v __attribute__((ext_vector_type(2)));
typedef __bf16 bf16x8v __attribute__((ext_vector_type(8)));
typedef GAS unsigned gu32;

constexpr int S = 16384, D = 4096, DEPTH = 2;
constexpr int INC = 9072, NIN = 9216;
constexpr float LN_EPS = 1e-5f, RMS_EPS = 1e-6f;
constexpr float DN_ALPHA = 1.41421356237309515f;
constexpr float LOG2E = 1.4426950408889634f;
constexpr float QS_MLA = 0.07216878364870322f * LOG2E;
constexpr float QS_NSA = 0.08838834764831845f * LOG2E;
constexpr int NWAVES = 8, NTHR = 512;
constexpr size_t MiB = 1u << 20;
constexpr size_t WS_CTL = 0, CTL_ZERO_BYTES = 1 * MiB;
constexpr size_t WS_MOD = 1 * MiB;
constexpr size_t WS_ROPE = 2 * MiB;
constexpr size_t WS_CBP = 6 * MiB;
constexpr size_t WS_RSQQ = 7 * MiB;
constexpr size_t WS_RSQKV = 9 * MiB;
constexpr size_t WS_RSTD = 6 * MiB + 512 * 1024;
constexpr size_t WS_GNSA = 10 * MiB;
constexpr size_t WS_KCMP = 13 * MiB;
constexpr size_t WS_VCMP = 13 * MiB + 512 * 1024;
constexpr size_t WS_W = 16 * MiB, W_LSTRIDE = 120 * MiB;
constexpr size_t W_IN = 0, W_QUP = 72 * MiB, W_KVUP = 77 * MiB, W_OUT = 81 * MiB, W_C1 = 113 * MiB, W_C2 = 115 * MiB;
constexpr size_t WS_H = 256 * MiB;
constexpr size_t WS_XV = 384 * MiB;
constexpr size_t WS_QLAT = 640 * MiB, WS_KVLAT = 664 * MiB;
constexpr size_t WS_QMLA = 680 * MiB, WS_KMLA = 728 * MiB, WS_VMLA = 872 * MiB, WS_ZMLA = 936 * MiB, WS_ZNSA = 1000 * MiB, WS_QNSA = 1064 * MiB;
constexpr size_t WS_Y = 936 * MiB;
constexpr size_t WS_H8 = 776 * MiB;
constexpr size_t WS_WIN8 = 840 * MiB, WIN8_LSTRIDE = 13 * MiB;
constexpr size_t WS_KVNSA = 1128 * MiB;
constexpr size_t WS_OSCR = 1178 * MiB;
constexpr size_t WS_END = 1210 * MiB;
constexpr int CW_BAR = 4096;
constexpr int LDS_BYTES = 147456;
constexpr int MISC_OFF = LDS_BYTES - 128;

__device__ __forceinline__ unsigned pk2(float lo, float hi) { f32x2 a = {lo, hi}; return __builtin_bit_cast(unsigned, __builtin_convertvector(a, bf16x2v)); }
__device__ __forceinline__ u32x4 pk8(f32x4 a, f32x4 b) { u32x4 w; w.x = pk2(a[0], a[1]); w.y = pk2(a[2], a[3]); w.z = pk2(b[0], b[1]); w.w = pk2(b[2], b[3]); return w; }
__device__ __forceinline__ float bflo(unsigned u) { return __uint_as_float(u << 16); }
__device__ __forceinline__ float bfhi(unsigned u) { return __uint_as_float(u & 0xffff0000u); }
__device__ __forceinline__ float wave_sum(float v) {
#pragma unroll
    for (int o = 1; o < 64; o <<= 1) v += __shfl_xor(v, o);
    return v;
}
__device__ __forceinline__ float silu_f(float v) { return v * __builtin_amdgcn_rcpf(1.f + __expf(-v)); }
__device__ __forceinline__ float sigm_f(float v) { return __builtin_amdgcn_rcpf(1.f + __expf(-v)); }

#define XB_TMO      128
#define XB_XCNT(j)  (256  + 64 * (j))
#define XB_XSUB(j)  (1280 + 64 * (j))
#define XB_XGEN(j)  (2304 + 64 * (j))
#define XB_TOP      3328
#define XB_TOPGEN   3392
#define XCD_BAR_WORDS 3456
#define XB_SPIN_CAP (1u << 18)
__device__ __forceinline__ unsigned xb_ld(unsigned* p)              { return __hip_atomic_load(p, __ATOMIC_RELAXED, __HIP_MEMORY_SCOPE_AGENT); }
__device__ __forceinline__ unsigned xb_add(unsigned* p, unsigned v) { return __hip_atomic_fetch_add(p, v, __ATOMIC_RELAXED, __HIP_MEMORY_SCOPE_AGENT); }
__device__ __forceinline__ unsigned xb_xcc_id() { return (unsigned)__builtin_amdgcn_s_getreg((3 << 11) | 20) & 0xFu; }
#define XB_SPIN(cond, bar) do { unsigned _sp = 0; while (cond) { __builtin_amdgcn_s_sleep(1); \
    if ((++_sp & 255u) == 0u) { if (xb_ld(&(bar)[XB_TMO])) break; if (_sp > XB_SPIN_CAP) { atomicAdd(&(bar)[XB_TMO], 1u); break; } } } } while (0)
struct XcdBarrier { unsigned* bar; unsigned x; volatile LAS unsigned* st; };
__device__ __forceinline__ XcdBarrier xcd_barrier_post(unsigned* bar, volatile LAS unsigned* st) {
    XcdBarrier b; b.bar = bar; b.x = xb_xcc_id(); b.st = st;
    if (threadIdx.x == 0) (void)xb_add(&bar[XB_XCNT(b.x)], 1u);
    return b;
}
__device__ __forceinline__ void xcd_barrier_complete(unsigned* bar, unsigned x, unsigned& nloc, unsigned& nx) {
    const unsigned G = gridDim.x * gridDim.y * gridDim.z;
    unsigned sum, cnt, mine, sp = 0u;
    for (;;) {
        sum = 0u; cnt = 0u; mine = 0u;
#pragma unroll
        for (unsigned j = 0; j < 16; ++j) { const unsigned c = xb_ld(&bar[XB_XCNT(j)]); sum += c; cnt += (c > 0u) ? 1u : 0u; mine = (j == x) ? c : mine; }
        if (sum == G) break;
        __builtin_amdgcn_s_sleep(1);
        if ((++sp & 255u) == 0u) { if (xb_ld(&bar[XB_TMO])) break; if (sp > XB_SPIN_CAP) { atomicAdd(&bar[XB_TMO], 1u); break; } }
    }
    nloc = mine > 0u ? mine : 1u; nx = cnt > 0u ? cnt : 1u;
}
__device__ __forceinline__ void xcd_barrier(const XcdBarrier& b) {
    asm volatile("s_waitcnt vmcnt(0)" ::: "memory");
    __syncthreads();
    if (threadIdx.x == 0) {
        unsigned* bar = b.bar;
        __builtin_amdgcn_s_waitcnt(0);
        unsigned nloc = b.st[0], nx = b.st[1];
        if (nloc == 0u) { xcd_barrier_complete(bar, b.x, nloc, nx); b.st[0] = nloc; b.st[1] = nx; }
        const unsigned old = xb_add(&bar[XB_XSUB(b.x)], 1u);
        const unsigned gen = old / nloc;
        if (old + 1u == (gen + 1u) * nloc) {
            __builtin_amdgcn_fence(__ATOMIC_RELEASE, "agent");
            asm volatile("s_waitcnt vmcnt(0)" ::: "memory");
            const unsigned og = xb_add(&bar[XB_TOP], 1u);
            const unsigned tg = og / nx;
            if (og + 1u == (tg + 1u) * nx) xb_add(&bar[XB_TOPGEN], 1u);
            else XB_SPIN(xb_ld(&bar[XB_TOPGEN]) == tg, bar);
            __builtin_amdgcn_fence(__ATOMIC_ACQUIRE, "agent");
            xb_add(&bar[XB_XGEN(b.x)], 1u);
            asm volatile("s_waitcnt vmcnt(0)" ::: "memory");
        } else {
            XB_SPIN(xb_ld(&bar[XB_XGEN(b.x)]) == gen, bar);
            __builtin_amdgcn_fence(__ATOMIC_ACQUIRE, "agent");
            asm volatile("s_waitcnt vmcnt(0)" ::: "memory");
        }
    }
    __syncthreads();
}
__device__ __forceinline__ void p0_mod_gemv(const float* c, const float* w_ada, const float* b_ada, float* mod, LAS float* lds, int vcu, int G) {
    const int tid = threadIdx.x;
    LAS float* sc = lds;
    LAS float* red = lds + 4096;
    for (int k = tid; k < D; k += NTHR) sc[k] = silu_f(c[k]);
    __syncthreads();
    const int cl = tid & 7, kl = tid >> 3;
    constexpr int NU = DEPTH * 3 * D / 32;
    for (int u = vcu; u < NU; u += G) {
        const int l = u / (3 * D / 32), n0 = (u % (3 * D / 32)) * 32;
        const float* W = w_ada + (size_t)l * D * (3 * D) + n0 + cl * 4;
        f32x4 acc = {0.f, 0.f, 0.f, 0.f};
#pragma unroll 8
        for (int i = 0; i < D / 64; ++i) { const int k = kl + 64 * i; const f32x4 w = *(const GAS f32x4*)(W + (size_t)k * (3 * D)); acc += w * sc[k]; }
        red[kl * 33 + cl * 4 + 0] = acc[0]; red[kl * 33 + cl * 4 + 1] = acc[1]; red[kl * 33 + cl * 4 + 2] = acc[2]; red[kl * 33 + cl * 4 + 3] = acc[3];
        __syncthreads();
        if (tid < 32) { float s = 0.f; for (int j = 0; j < 64; ++j) s += red[j * 33 + tid]; mod[(size_t)l * 3 * D + n0 + tid] = s + b_ada[(size_t)l * 3 * D + n0 + tid]; }
        __syncthreads();
    }
}
__device__ __forceinline__ int map_in(int n) {
    if (n < 1280) return n;
    if (n < 1344) { const int i = n - 1280; return 1280 + 2 * (i & 31) + (i >> 5); }
    if (n < 3392) return 1536 + (n - 1344);
    if (n < 5440) return 3584 + (n - 3392);
    if (n < 6976) return 5632 + (n - 5440);
    if (n < 7024) return 1344 + (n - 6976);
    return 7168 + (n - 7024);
}
__device__ __forceinline__ int map_kvup(int n) { const int h = n >> 8, d = n & 255; return d < 128 ? h * 128 + d : 2048 + h * 128 + (d - 128); }
__device__ __forceinline__ int map_qup(int n) { const int h = n / 192, d = n - h * 192; if (d < 128) return h * 128 + d; const int i = d - 128; return 2048 + h * 64 + 2 * (i & 31) + (i >> 5); }
template <int MAP>
__device__ __forceinline__ void tr_item8(const float* W, int K, int N, unsigned char* WT, const float* kscale, float sc, int kb, int nb, int lane) {
    const int k0 = 64 * kb, n = 64 * nb + lane;
    if (n >= N) return;
    const GAS float* src = (const GAS float*)(W + (size_t)k0 * N + n);
    float v[64];
#pragma unroll
    for (int i = 0; i < 64; ++i) v[i] = src[(size_t)i * N] * sc;
    if (kscale) {
#pragma unroll
        for (int i = 0; i < 64; ++i) v[i] *= kscale[k0 + i];
    }
    const int row = MAP == 4 ? (n < 1280 ? n : 1280 + (n - 1344)) : (MAP == 2 ? map_qup(n) : (MAP == 3 ? map_kvup(n) : n));
    GAS u32x4* dst = (GAS u32x4*)(WT + (size_t)row * K + k0);
#pragma unroll
    for (int c = 0; c < 4; ++c) { u32x4 o;
        int w = __builtin_amdgcn_cvt_pk_fp8_f32(v[16 * c + 0], v[16 * c + 1], 0, false); o.x = (unsigned)__builtin_amdgcn_cvt_pk_fp8_f32(v[16 * c + 2], v[16 * c + 3], w, true);
        w = __builtin_amdgcn_cvt_pk_fp8_f32(v[16 * c + 4], v[16 * c + 5], 0, false); o.y = (unsigned)__builtin_amdgcn_cvt_pk_fp8_f32(v[16 * c + 6], v[16 * c + 7], w, true);
        w = __builtin_amdgcn_cvt_pk_fp8_f32(v[16 * c + 8], v[16 * c + 9], 0, false); o.z = (unsigned)__builtin_amdgcn_cvt_pk_fp8_f32(v[16 * c + 10], v[16 * c + 11], w, true);
        w = __builtin_amdgcn_cvt_pk_fp8_f32(v[16 * c + 12], v[16 * c + 13], 0, false); o.w = (unsigned)__builtin_amdgcn_cvt_pk_fp8_f32(v[16 * c + 14], v[16 * c + 15], w, true);
        dst[c] = o; }
}
template <int MAP>
__device__ __forceinline__ void tr_item(const float* W, int K, int N, bf16* WT, const float* kscale, int kb, int nb, int lane) {
    const int k0 = 64 * kb, n = 64 * nb + lane;
    if (n >= N) return;
    const GAS float* src = (const GAS float*)(W + (size_t)k0 * N + n);
    float v[64];
#pragma unroll
    for (int i = 0; i < 64; ++i) v[i] = src[(size_t)i * N];
    if (kscale) {
#pragma unroll
        for (int i = 0; i < 64; ++i) v[i] *= kscale[k0 + i];
    }
    const int row = MAP == 1 ? map_in(n) : (MAP == 2 ? map_qup(n) : (MAP == 3 ? map_kvup(n) : n));
    GAS u32x4* dst = (GAS u32x4*)(WT + (size_t)row * K + k0);
#pragma unroll
    for (int c = 0; c < 8; ++c) { u32x4 o; o.x = pk2(v[8 * c], v[8 * c + 1]); o.y = pk2(v[8 * c + 2], v[8 * c + 3]); o.z = pk2(v[8 * c + 4], v[8 * c + 5]); o.w = pk2(v[8 * c + 6], v[8 * c + 7]); dst[c] = o; }
}
struct P0In { const float *w_in, *q_norm, *w_q_up, *kv_norm, *w_kv_up, *w_cmp1, *w_cmp2, *w_out; };
__device__ __forceinline__ void p0_convert(const P0In& I, unsigned char* ws, int gw, int NGW, int lane) {
    constexpr int T_IN = 64 * 142, T_QUP = 12 * 48, T_KVUP = 8 * 64, T_OUT = 64 * 64, T_C1 = 2 * 64 * 2, T_C2 = 2 * 2 * 2;
    constexpr int TL = T_IN + T_QUP + T_KVUP + T_OUT + T_C1 + T_C2;
    for (int it = gw; it < DEPTH * TL; it += NGW) {
        const int l = it / TL; int r = it - l * TL;
        unsigned char* wl = ws + WS_W + (size_t)l * W_LSTRIDE;
        if (r < T_IN) { const int t_ = r >> 3, nb = t_ % 142, kb = (t_ / 142) * 8 + (r & 7);
            if (nb < 20 || (nb >= 21 && nb < 53)) tr_item8<4>(I.w_in + (size_t)l * D * INC, D, INC, ws + WS_WIN8 + (size_t)l * WIN8_LSTRIDE, nullptr, 64.f, kb, nb, lane);
            else tr_item<1>(I.w_in + (size_t)l * D * INC, D, INC, (bf16*)(wl + W_IN), nullptr, kb, nb, lane);
            continue; } r -= T_IN;
        if (r < T_QUP) { tr_item8<2>(I.w_q_up + (size_t)l * 768 * 3072, 768, 3072, wl + W_QUP, I.q_norm + l * 768, 32.f, r / 48, r % 48, lane); continue; } r -= T_QUP;
        if (r < T_KVUP) { tr_item8<3>(I.w_kv_up + (size_t)l * 512 * 4096, 512, 4096, wl + W_KVUP, I.kv_norm + l * 512, 32.f, r / 64, r % 64, lane); continue; }
        r -= T_KVUP;
        if (r < T_OUT) { const int t_ = r >> 3, kb = (t_ / 64) * 8 + (r & 7), nb = t_ % 64;
            if (kb < 32) tr_item8<0>(I.w_out + (size_t)l * D * D, 8192, D, wl + W_OUT, nullptr, 128.f, kb, nb, lane);
            else
            tr_item<0>(I.w_out + (size_t)l * D * D, D, D, (bf16*)(wl + W_OUT), nullptr, kb, nb, lane);
            continue; } r -= T_OUT;
        if (r < T_C1) { const int kv = r / 128, rr = r % 128; tr_item<0>(I.w_cmp1 + (size_t)(l * 2 + kv) * 4096 * 128, 4096, 128, (bf16*)(wl + W_C1) + (size_t)kv * 128 * 4096, nullptr, rr / 2, rr % 2, lane); continue; } r -= T_C1;
        { const int kv = r / 4, rr = r % 4; tr_item<0>(I.w_cmp2 + (size_t)(l * 2 + kv) * 128 * 128, 128, 128, (bf16*)(wl + W_C2) + (size_t)kv * 128 * 128, nullptr, rr / 2, rr % 2, lane); }
    }
}
__device__ __forceinline__ void p0_rope(const int* positions, float* cosT, float* sinT, int gtid, int NT) {
    for (int e = gtid; e < S * 32; e += NT) { const int s = e >> 5, i = e & 31;
        const float inv = (float)exp(-(double)i * (1.0 / 32.0) * 9.210340371976184);
        const float ang = (float)positions[s] * inv;
        cosT[e] = (float)cos((double)ang); sinT[e] = (float)sin((double)ang); }
}
__device__ __forceinline__ void p0_cmpbias(const float* cmp_pos, const float* w_cmp1, float* cbp, LAS float* red, int vcu, int G) {
    const int tid = threadIdx.x, n = tid & 127, kq = tid >> 7;
    for (int u = vcu; u < 64; u += G) {
        const int lk = u >> 4, ch = u & 15;
        const float* P = cmp_pos + (size_t)lk * 4096 + 256 * ch; const float* W = w_cmp1 + (size_t)lk * 4096 * 128 + (size_t)(256 * ch) * 128 + n;
        float a = 0.f;
#pragma unroll 8
        for (int i = 0; i < 64; ++i) { const int k = kq + 4 * i; a += P[k] * *(const GAS float*)(W + (size_t)k * 128); }
        red[kq * 128 + n] = a;
        __syncthreads();
        if (tid < 128) cbp[(size_t)u * 128 + tid] = (red[tid] + red[128 + tid]) + (red[256 + tid] + red[384 + tid]);
        __syncthreads();
    }
}
__device__ __forceinline__ unsigned pk4_fp8(f32x4 h) { const int w = __builtin_amdgcn_cvt_pk_fp8_f32(h[0], h[1], 0, false); return (unsigned)__builtin_amdgcn_cvt_pk_fp8_f32(h[2], h[3], w, true); }
__device__ __forceinline__ void modulate_rows(const float* x, bf16* hout, unsigned char* h8, const float* modl, int gw, int NGW, int lane) {
    f32x4 sh[16], sc[16];
#pragma unroll
    for (int j = 0; j < 16; ++j) { sh[j] = *((const GAS f32x4*)modl + lane + 64 * j); sc[j] = *((const GAS f32x4*)(modl + D) + lane + 64 * j) + 1.f; }
    for (int m = gw; m < S; m += NGW) {
        const GAS f32x4* xr = (const GAS f32x4*)(x + (size_t)m * D) + lane;
        GAS u32x2* ho = (GAS u32x2*)(hout + (size_t)m * D) + lane;
#pragma unroll
        for (int j = 0; j < 16; ++j) { const f32x4 h = xr[64 * j] * sc[j] + sh[j]; u32x2 w; w.x = pk2(h[0], h[1]); w.y = pk2(h[2], h[3]); ho[64 * j] = w;
            if (h8) *((GAS unsigned*)(h8 + (size_t)m * D) + lane + 64 * j) = pk4_fp8(h); }
    }
}
typedef _Float16 f16x4 __attribute__((ext_vector_type(4)));
template <bool XIN_H, bool XOUT_H>
__device__ __forceinline__ void ln_rows(const void* xres_, const bf16* yb, void* xout_, bf16* hout, unsigned char* h8, const float* g, const float* b, const float* mod_next, LAS float* par, int tid, int gw, int NGW, int lane) {
    {
#pragma unroll
      for (int i = 0; i < 2; ++i) { const int e = tid + 512 * i;
          *((LAS f32x4*)par + e) = *((const GAS f32x4*)g + e); *((LAS f32x4*)(par + D) + e) = *((const GAS f32x4*)b + e);
          if (hout) { *((LAS f32x4*)(par + 2 * D) + e) = *((const GAS f32x4*)mod_next + e); *((LAS f32x4*)(par + 3 * D) + e) = *((const GAS f32x4*)(mod_next + D) + e) + 1.f; } }
      __syncthreads(); }
    for (int m = gw; m < S; m += NGW) {
        const GAS f32x4* vr = (const GAS f32x4*)((const float*)xres_ + (size_t)m * D) + lane; const GAS f16x4* vrh = (const GAS f16x4*)((const _Float16*)xres_ + (size_t)m * D) + lane;
        const GAS u32x2* yr = (const GAS u32x2*)(yb + (size_t)m * D) + lane;
        f32x4 x[16]; float s = 0.f;
#pragma unroll
        for (int j = 0; j < 16; ++j) { const u32x2 yy = yr[64 * j]; const f32x4 yf = {bflo(yy.x), bfhi(yy.x), bflo(yy.y), bfhi(yy.y)};
            const f32x4 xin = XIN_H ? __builtin_convertvector(vrh[64 * j], f32x4) : vr[64 * j];
            x[j] = xin * DN_ALPHA + yf; s += (x[j][0] + x[j][1]) + (x[j][2] + x[j][3]); }
        const float mean = wave_sum(s) * (1.f / D); float s2 = 0.f;
#pragma unroll
        for (int j = 0; j < 16; ++j) { x[j] = x[j] - mean; s2 += (x[j][0] * x[j][0] + x[j][1] * x[j][1]) + (x[j][2] * x[j][2] + x[j][3] * x[j][3]); }
        const float rstd = 1.f / sqrtf(wave_sum(s2) * (1.f / D) + LN_EPS);
        { unsigned po_ = 0u; asm volatile("" : "+v"(po_)); par = (LAS float*)((LAS unsigned char*)par + po_); }
        GAS f32x4* xo = (GAS f32x4*)((float*)xout_ + (size_t)m * D) + lane; GAS f16x4* xoh = (GAS f16x4*)((_Float16*)xout_ + (size_t)m * D) + lane;
#pragma unroll
        for (int j = 0; j < 16; ++j) {
            const f32x4 gg = *((const LAS f32x4*)par + lane + 64 * j), bb = *((const LAS f32x4*)(par + D) + lane + 64 * j);
            const f32x4 y = x[j] * rstd * gg + bb;
            if (XOUT_H) xoh[64 * j] = __builtin_convertvector(y, f16x4); else xo[64 * j] = y;
            if (hout) {
                const f32x4 sh = *((const LAS f32x4*)(par + 2 * D) + lane + 64 * j), scl = *((const LAS f32x4*)(par + 3 * D) + lane + 64 * j);
                const f32x4 h = y * scl + sh;
                u32x2 w; w.x = pk2(h[0], h[1]); w.y = pk2(h[2], h[3]);
                *((GAS u32x2*)(hout + (size_t)m * D) + lane + 64 * j) = w;
                if (h8) *((GAS unsigned*)(h8 + (size_t)m * D) + lane + 64 * j) = pk4_fp8(h);
            }
        }
    }
}
__device__ __forceinline__ void rstd_rows(const float* rsq_q, const float* rsq_kv, float* rstd_q, float* rstd_kv, int gtid, int NT) {
    for (int row = gtid; row < S; row += NT) {
        const GAS f32x4* rp = (const GAS f32x4*)(rsq_q + (size_t)row * 24); float ss = 0.f;
#pragma unroll
        for (int i = 0; i < 6; ++i) { const f32x4 t = rp[i]; ss += (t[0] + t[1]) + (t[2] + t[3]); }
        rstd_q[row] = 1.f / sqrtf(ss * (1.f / 768.f) + RMS_EPS);
        const GAS f32x4* rk = (const GAS f32x4*)(rsq_kv + (size_t)row * 16); float sk = 0.f;
#pragma unroll
        for (int i = 0; i < 4; ++i) { const f32x4 t = rk[i]; sk += (t[0] + t[1]) + (t[2] + t[3]); }
        rstd_kv[row] = 1.f / sqrtf(sk * (1.f / 512.f) + RMS_EPS);
    }
}
namespace pg8 {
#define PG8_LAS __attribute__((address_space(3)))
typedef unsigned short bf16_t;
typedef short bf16x8 __attribute__((ext_vector_type(8)));
typedef float f32x4 __attribute__((ext_vector_type(4)));
typedef unsigned u32x4 __attribute__((ext_vector_type(4)));
constexpr int BM = 256, BK = 64, HALF = 128, HTB = HALF * BK * 2  , STAGE_BYTES = 8 * HTB, NXCD = 8, WGM = 8;

__host__ __device__ __forceinline__ int lds_byte(int r, int c) { const int st = (r >> 4) * 2 + (c >> 5), rr = r & 15, cc = c & 31, ob = rr * 64 + cc * 2; return st * 1024 + (ob ^ (((ob >> 9) & 1) << 5)); }
__host__ __device__ __forceinline__ void stage_rc(int b, int& R, int& C) { const int st = b / 1024, sb = b % 1024, swz = sb ^ (((sb >> 9) & 1) << 5); R = (st >> 1) * 16 + swz / 64; C = (st & 1) * 32 + (swz % 64) / 2; }
__host__ __device__ __forceinline__ int perm32(int rho) { const int n = rho >> 4, i = rho & 15; return 8 * (i >> 2) + 4 * n + (i & 3); }

struct Unit { int pm, pn; };
struct Gemm { const bf16_t* A; const bf16_t* Bt; int M, N, K; };

struct StaticOrder {
    int nM, nN, nwg, G, c;
    __host__ __device__ void init(int M, int N, int G_, int c_) { nM = M / BM; nN = N / BM; nwg = nM * nN; G = G_; c = c_; }
    __host__ __device__ bool next(int i, Unit& u) const {
        const long L = (long)i * G + c; if (L >= nwg) return false;
        int wgid = (int)L; { const int q = nwg / NXCD, r = nwg % NXCD, xcd = wgid % NXCD, off = wgid / NXCD; wgid = (xcd < r ? xcd * (q + 1) : r * (q + 1) + (xcd - r) * q) + off; }
        const int nig = WGM * nN, gid = wgid / nig, fm = gid * WGM, gsz = (nM - fm) < WGM ? (nM - fm) : WGM;
        u.pm = fm + ((wgid % nig) % gsz); u.pn = (wgid % nig) / gsz; return true;
    }
    __device__ __forceinline__ void a_ready(const Unit&) const {}
    __device__ __forceinline__ void done(const Unit&) const {}
};
typedef int i32x8 __attribute__((ext_vector_type(8)));
typedef int i32x4 __attribute__((ext_vector_type(4)));
__device__ __forceinline__ i32x8 ld2x16(const PG8_LAS unsigned char* p) { const u32x4 a = *(const PG8_LAS u32x4*)p, b = *(const PG8_LAS u32x4*)(p + 1024);
    return (i32x8){(int)a.x, (int)a.y, (int)a.z, (int)a.w, (int)b.x, (int)b.y, (int)b.z, (int)b.w}; }
__device__ __forceinline__ i32x8 cat8(bf16x8 lo, bf16x8 hi) { const i32x4 a = __builtin_bit_cast(i32x4, lo), b = __builtin_bit_cast(i32x4, hi); return (i32x8){a[0], a[1], a[2], a[3], b[0], b[1], b[2], b[3]}; }
struct InBf16Order : StaticOrder {
    __device__ bool next(int i, Unit& u) const { if (!StaticOrder::next(i, u)) return false; u.pn = u.pn == 0 ? 5 : 13 + u.pn; return true; }
};
__device__ __forceinline__ f32x4 rope4(const f32x4 v, float c0, float s0, float c1, float s1) {
    f32x4 o; o[0] = v[0] * c0 - v[1] * s0; o[1] = v[1] * c0 + v[0] * s0; o[2] = v[2] * c1 - v[3] * s1; o[3] = v[3] * c1 + v[2] * s1; return o; }
#define NZ(v, row, col) (v)
__device__ __forceinline__ u32x2 pk8_fp8(f32x4 a, f32x4 b) {
    int w0 = __builtin_amdgcn_cvt_pk_fp8_f32(a[0], a[1], 0, false); w0 = __builtin_amdgcn_cvt_pk_fp8_f32(a[2], a[3], w0, true);
    int w1 = __builtin_amdgcn_cvt_pk_fp8_f32(b[0], b[1], 0, false); w1 = __builtin_amdgcn_cvt_pk_fp8_f32(b[2], b[3], w1, true);
    u32x2 r; r.x = (unsigned)w0; r.y = (unsigned)w1; return r; }
struct EpiIn {
    static constexpr bool PERM = true, AFTER_DRAIN = false;
    unsigned char* ws; int f8pass;
    __device__ __forceinline__ void operator()(const f32x4 (&acc)[2][2][4][2], const Unit& u, int wr, int wc, int fr, int fq) const {
        const int pn = f8pass ? (u.pn < 5 ? u.pn : u.pn + 1) : u.pn, row0 = u.pm * BM + wr * 64 + fr;
        if (pn < 5) {
            const bool isq = pn < 3; bf16_t* base = (bf16_t*)(ws + (isq ? WS_QLAT : WS_KVLAT)); const int ld = isq ? 768 : 512, ct = isq ? pn : pn - 3, ns = isq ? 24 : 16; float* rsq = (float*)(ws + (isq ? WS_RSQQ : WS_RSQKV));
#pragma unroll
            for (int ai = 0; ai < 2; ++ai)
#pragma unroll
                for (int m = 0; m < 4; ++m) { const int row = row0 + ai * HALF + m * 16;
#pragma unroll
                    for (int bj = 0; bj < 2; ++bj) { const f32x4 v0 = NZ(acc[ai][bj][m][0], row, pn * 256 + bj * 128 + wc * 32 + 8 * fq), v1 = NZ(acc[ai][bj][m][1], row, pn * 256 + bj * 128 + wc * 32 + 8 * fq + 4);
                        float ss = ((v0[0] * v0[0] + v0[1] * v0[1]) + (v0[2] * v0[2] + v0[3] * v0[3])) + ((v1[0] * v1[0] + v1[1] * v1[1]) + (v1[2] * v1[2] + v1[3] * v1[3]));
                        ss += __shfl_xor(ss, 16); ss += __shfl_xor(ss, 32);
                        if (fq == 0) rsq[(size_t)row * ns + ct * 8 + bj * 4 + wc] = ss;
                        *(GAS u32x2*)((unsigned char*)base + (size_t)row * ld + ct * 256 + bj * HALF + wc * 32 + 8 * fq) = pk8_fp8(v0, v1); } }
        } else if (pn == 5) {
            if (wc < 2) {
                const int i0 = 16 * wc + 4 * fq; const float* cosT = (const float*)(ws + WS_ROPE); const float* sinT = cosT + (size_t)S * 32; bf16_t* kmla = (bf16_t*)(ws + WS_KMLA);
#pragma unroll
                for (int ai = 0; ai < 2; ++ai)
#pragma unroll
                    for (int m = 0; m < 4; ++m) { const int row = row0 + ai * HALF + m * 16;
                        const f32x4 cs = *(const GAS f32x4*)(cosT + (size_t)row * 32 + i0), sn = *(const GAS f32x4*)(sinT + (size_t)row * 32 + i0);
                        const u32x2 w = pk8_fp8(rope4(acc[ai][0][m][0], cs[0], sn[0], cs[1], sn[1]), rope4(acc[ai][0][m][1], cs[2], sn[2], cs[3], sn[3]));
                        unsigned char* dst = (unsigned char*)kmla + (size_t)row * 3072 + 128 + wc * 32 + 8 * fq;
#pragma unroll
                        for (int h = 0; h < 16; ++h) *(GAS u32x2*)(dst + h * 192) = w;
                        asm volatile("" ::: "memory"); }
            } else {
                const int cl = (wc - 2) * 32 + 8 * fq; float* gnsa = (float*)(ws + WS_GNSA);
                if (cl < 48) {
#pragma unroll
                    for (int ai = 0; ai < 2; ++ai)
#pragma unroll
                        for (int m = 0; m < 4; ++m) { const int row = row0 + ai * HALF + m * 16; const f32x4 v0 = acc[ai][0][m][0], v1 = acc[ai][0][m][1];
                            f32x4 g0, g1; g0[0] = sigm_f(v0[0]); g0[1] = sigm_f(v0[1]); g0[2] = sigm_f(v0[2]); g0[3] = sigm_f(v0[3]); g1[0] = sigm_f(v1[0]); g1[1] = sigm_f(v1[1]); g1[2] = sigm_f(v1[2]); g1[3] = sigm_f(v1[3]);
                            *(GAS f32x4*)(gnsa + (size_t)row * 48 + cl) = g0; *(GAS f32x4*)(gnsa + (size_t)row * 48 + cl + 4) = g1; } }
            }
        } else {
            const int mode = (pn < 14) ? 0 : (pn < 22 ? 1 : (pn < 28 ? 2 : 0));
            bf16_t* base = (pn < 14) ? (bf16_t*)(ws + WS_ZMLA) + (pn - 6) * 256 : (pn < 22 ? (bf16_t*)(ws + WS_QNSA) + (pn - 14) * 256 : (bf16_t*)(ws + WS_ZNSA) + (pn - 28) * 256); bf16_t* kvnsa = (bf16_t*)(ws + WS_KVNSA);
#pragma unroll
            for (int ai = 0; ai < 2; ++ai)
#pragma unroll
                for (int m = 0; m < 4; ++m) { const int row = row0 + ai * HALF + m * 16;
#pragma unroll
                    for (int bj = 0; bj < 2; ++bj) { f32x4 v0 = NZ(acc[ai][bj][m][0], row, pn * 256 + bj * 128 + wc * 32 + 8 * fq), v1 = NZ(acc[ai][bj][m][1], row, pn * 256 + bj * 128 + wc * 32 + 8 * fq + 4);
                        if (mode == 0) { v0[0] = silu_f(v0[0]); v0[1] = silu_f(v0[1]); v0[2] = silu_f(v0[2]); v0[3] = silu_f(v0[3]); v1[0] = silu_f(v1[0]); v1[1] = silu_f(v1[1]); v1[2] = silu_f(v1[2]); v1[3] = silu_f(v1[3]); }
                        else if (mode == 1) { v0 = v0 * QS_NSA; v1 = v1 * QS_NSA; }
                        bf16_t* dst = (mode == 2) ? kvnsa + (size_t)(2 * (pn - 22) + bj) * ((size_t)S * 128) + (size_t)row * 128 + wc * 32 + 8 * fq
                                                  : base + (size_t)row * 2048 + bj * HALF + wc * 32 + 8 * fq;
                        *(GAS u32x4*)dst = pk8(v0, v1); } }
        }
    }
};
struct EpiQup {
    static constexpr bool PERM = true, AFTER_DRAIN = false;
    unsigned char* ws;
    __device__ __forceinline__ void operator()(const f32x4 (&acc)[2][2][4][2], const Unit& u, int wr, int wc, int fr, int fq) const {
        const int pn = u.pn, row0 = u.pm * BM + wr * 64 + fr; bf16_t* qmla = (bf16_t*)(ws + WS_QMLA); const float* rstd_q = (const float*)(ws + WS_RSTD); const float* cosT = (const float*)(ws + WS_ROPE); const float* sinT = cosT + (size_t)S * 32;
#pragma unroll
        for (int ai = 0; ai < 2; ++ai)
#pragma unroll
            for (int m = 0; m < 4; ++m) { const int row = row0 + ai * HALF + m * 16;
                const float sc = (QS_MLA * 8.f) * *(const GAS float*)(rstd_q + row);
                unsigned char* q8 = (unsigned char*)qmla + (size_t)row * 3072;
#pragma unroll
                for (int bj = 0; bj < 2; ++bj) { const f32x4 v0 = acc[ai][bj][m][0] * sc, v1 = acc[ai][bj][m][1] * sc;
                    if (pn < 8) { *(GAS u32x2*)(q8 + (2 * pn + bj) * 192 + wc * 32 + 8 * fq) = pk8_fp8(v0, v1); }
                    else { const int cp = (pn - 8) * 256 + bj * HALF + wc * 32 + 8 * fq, head = cp >> 6, dl = cp & 63, i0 = dl >> 1;
                        const f32x4 cs = *(const GAS f32x4*)(cosT + (size_t)row * 32 + i0), sn = *(const GAS f32x4*)(sinT + (size_t)row * 32 + i0);
                        *(GAS u32x2*)(q8 + head * 192 + 128 + dl) = pk8_fp8(rope4(v0, cs[0], sn[0], cs[1], sn[1]), rope4(v1, cs[2], sn[2], cs[3], sn[3])); } }
                if (m & 1) asm volatile("" ::: "memory"); }
    }
};
struct EpiKvup {
    static constexpr bool PERM = true, AFTER_DRAIN = false;
    unsigned char* ws;
    __device__ __forceinline__ void operator()(const f32x4 (&acc)[2][2][4][2], const Unit& u, int wr, int wc, int fr, int fq) const {
        const int pn = u.pn, row0 = u.pm * BM + wr * 64 + fr;
#pragma unroll
        for (int ai = 0; ai < 2; ++ai)
#pragma unroll
            for (int m = 0; m < 4; ++m) { const int row = row0 + ai * HALF + m * 16;
                const float sc = *(const GAS float*)((const float*)(ws + WS_RSTD) + S + row); bf16_t* kmla = (bf16_t*)(ws + WS_KMLA); bf16_t* vmla = (bf16_t*)(ws + WS_VMLA);
                *(GAS u32x2*)((unsigned char*)kmla + (size_t)row * 3072 + pn * 192 + wc * 32 + 8 * fq) = pk8_fp8(acc[ai][0][m][0] * sc, acc[ai][0][m][1] * sc);
                *(GAS u32x4*)(vmla + (size_t)row * 2048 + pn * 128 + wc * 32 + 8 * fq) = pk8(acc[ai][1][m][0] * sc, acc[ai][1][m][1] * sc);
                if (m & 1) asm volatile("" ::: "memory"); }
    }
};
struct EpiKup {
    static constexpr bool PERM = true, AFTER_DRAIN = false;
    unsigned char* ws;
    __device__ __forceinline__ void operator()(const f32x4 (&acc)[2][2][4][2], const Unit& u, int wr, int wc, int fr, int fq) const {
        const int pn = u.pn, row0 = u.pm * BM + wr * 64 + fr;
#pragma unroll
        for (int ai = 0; ai < 2; ++ai)
#pragma unroll
            for (int m = 0; m < 4; ++m) { const int row = row0 + ai * HALF + m * 16;
                const float sc = *(const GAS float*)((const float*)(ws + WS_RSTD) + S + row); unsigned char* k8 = ws + WS_KMLA + (size_t)row * 3072;
#pragma unroll
                for (int bj = 0; bj < 2; ++bj) *(GAS u32x2*)(k8 + (2 * pn + bj) * 192 + wc * 32 + 8 * fq) = pk8_fp8(acc[ai][bj][m][0] * sc, acc[ai][bj][m][1] * sc);
                if (m & 1) asm volatile("" ::: "memory"); }
    }
};
struct EpiVt {
    static constexpr bool PERM = true, AFTER_DRAIN = false;
    unsigned char* ws;
    __device__ __forceinline__ void operator()(const f32x4 (&acc)[2][2][4][2], const Unit& u, int wr, int wc, int fr, int fq) const {
        const int row0 = u.pm * BM + wr * 64 + fr, col0 = u.pn * BM + wc * 32 + 8 * fq;
        const float* rs = (const float*)(ws + WS_RSTD) + S;
        f32x4 sc[2][2];
#pragma unroll
        for (int bj = 0; bj < 2; ++bj) { sc[bj][0] = *(const GAS f32x4*)(rs + col0 + bj * HALF); sc[bj][1] = *(const GAS f32x4*)(rs + col0 + bj * HALF + 4); }
        const int hi8 = (col0 >> 3) & 1; (void)hi8;
#pragma unroll
        for (int ai = 0; ai < 2; ++ai)
#pragma unroll
            for (int m = 0; m < 4; ++m) { unsigned char* vt = ws + WS_VMLA + (size_t)(row0 + ai * HALF + m * 16) * S;
#pragma unroll
                for (int bj = 0; bj < 2; ++bj) { const u32x2 w = pk8_fp8(acc[ai][bj][m][0] * sc[bj][0], acc[ai][bj][m][1] * sc[bj][1]);
                    unsigned char* d64 = vt + ((col0 + bj * HALF) & ~63) + 4 * ((col0 >> 3) & 7);
                    *(GAS unsigned*)(d64) = w.x; *(GAS unsigned*)(d64 + 32) = w.y; } }
    }
};
struct EpiOut {
    static constexpr bool PERM = true, AFTER_DRAIN = false;
    bf16_t* y; const float* gate;
    __device__ __forceinline__ void operator()(const f32x4 (&acc)[2][2][4][2], const Unit& u, int wr, int wc, int fr, int fq) const {
        const int row0 = u.pm * BM + wr * 64 + fr, col0 = u.pn * BM + wc * 32 + 8 * fq;
        f32x4 gv[2][2];
#pragma unroll
        for (int bj = 0; bj < 2; ++bj)
#pragma unroll
            for (int n = 0; n < 2; ++n) gv[bj][n] = *(const GAS f32x4*)(gate + col0 + bj * HALF + n * 4);
#pragma unroll
        for (int ai = 0; ai < 2; ++ai)
#pragma unroll
            for (int m = 0; m < 4; ++m) { bf16_t* dst = y + (size_t)(row0 + ai * HALF + m * 16) * D + col0;
#pragma unroll
                for (int bj = 0; bj < 2; ++bj) *(GAS u32x4*)(dst + bj * HALF) = pk8(gv[bj][0] * acc[ai][bj][m][0], gv[bj][1] * acc[ai][bj][m][1]);
                if (m & 1) asm volatile("" ::: "memory"); }
    }
};
template <class Epi, class Sched, bool ALIGN_EPI = false, bool SP2 = false, int SCB = 0, int SCA = 0>
__device__ __forceinline__ void gemm_phase(PG8_LAS unsigned char* lds, const Gemm g, const Sched& S, const Epi& E) {
    int tid_ = threadIdx.x; asm volatile("" : "+v"(tid_));
    const int tid = tid_, wid = __builtin_amdgcn_readfirstlane(tid >> 6), lane = tid & 63, wr = wid >> 2, wc = wid & 3, fr = lane & 15, fq = lane >> 4;
    const int K = g.K, nt = K / BK;
    unsigned voffA[2], voffB[2];
#pragma unroll
    for (int i = 0; i < 2; ++i) { int R, C; stage_rc(tid * 16 + i * 8192, R, C); const int Rb = Epi::PERM ? ((R & ~31) + perm32(R & 31)) : R;
        voffA[i] = (unsigned)(R * K + C) * 2u; voffB[i] = (unsigned)(Rb * K + C) * 2u; }
    const size_t kstep = (size_t)(BK * 2);
    const size_t hstep = (size_t)HALF * K * 2;
    const size_t tstep = 2 * hstep;
    const unsigned ldsw = (unsigned)wid * 1024u;
    const int aoff = lds_byte(wr * 64 + fr, fq * 8), boff = lds_byte(wc * 32 + fr, fq * 8);
#define PG8_SA(b, h) (((b) * 2 + (h)) * HTB)
#define PG8_SB(b, h) ((4 + (b) * 2 + (h)) * HTB)
#define PG8_STAGE(bufoff, gbase, voff) do { _Pragma("unroll") for (int _i = 0; _i < 2; ++_i) \
        __builtin_amdgcn_global_load_lds((const unsigned*)((const char*)(gbase) + (voff)[_i]), (PG8_LAS unsigned*)(lds + (bufoff) + ldsw + _i * 8192), 16, 0, 0); } while (0)
#define PG8_LDA(dst, b, h) do { if constexpr (SCB != 0) { _Pragma("unroll") for (int m = 0; m < 4; ++m) dst##8[m] = ld2x16(lds + PG8_SA(b, h) + aoff + m * 2048); } \
        else { _Pragma("unroll") for (int m = 0; m < 4; ++m) _Pragma("unroll") for (int k = 0; k < 2; ++k) dst[m][k] = *(const PG8_LAS bf16x8*)(lds + PG8_SA(b, h) + aoff + m * 2048 + k * 1024); } } while (0)
#define PG8_LDB(dst, b, h) do { if constexpr (SCB != 0) { _Pragma("unroll") for (int n = 0; n < 2; ++n) dst##8[n] = ld2x16(lds + PG8_SB(b, h) + boff + n * 2048); } \
        else { _Pragma("unroll") for (int n = 0; n < 2; ++n) _Pragma("unroll") for (int k = 0; k < 2; ++k) dst[n][k] = *(const PG8_LAS bf16x8*)(lds + PG8_SB(b, h) + boff + n * 2048 + k * 1024); } } while (0)
#define PG8_MMA(ai, bj, At, Bt) do { __builtin_amdgcn_s_setprio(1); \
        if constexpr (SCB != 0) { _Pragma("unroll") for (int m = 0; m < 4; ++m) _Pragma("unroll") for (int n = 0; n < 2; ++n) \
            asm volatile("v_mfma_scale_f32_16x16x128_f8f6f4 %0, %1, %2, %0, %3, %4 op_sel_hi:[0,0,0]" : "+v"(acc[ai][bj][m][n]) : "v"(Bt##8[n]), "v"(At##8[m]), "v"(scb_), "v"(sca_)); } \
        else { _Pragma("unroll") for (int m = 0; m < 4; ++m) _Pragma("unroll") for (int n = 0; n < 2; ++n) _Pragma("unroll") for (int k = 0; k < 2; ++k) \
            acc[ai][bj][m][n] = __builtin_amdgcn_mfma_f32_16x16x32_bf16(Bt[n][k], At[m][k], acc[ai][bj][m][n], 0, 0, 0); } \
        __builtin_amdgcn_s_setprio(0); } while (0)
#define PG8_WAIT_V(n) asm volatile("s_waitcnt vmcnt(" #n ")" ::: "memory")
#define PG8_WAIT_L(n) asm volatile("s_waitcnt lgkmcnt(" #n ")" ::: "memory")
#define PG8_BAR __builtin_amdgcn_s_barrier()
#define PG8_SCHED __builtin_amdgcn_sched_barrier(0)
    Unit cur, nxt; int ui = 0;
    if (!S.next(0, cur)) return;
    f32x4 acc[2][2][4][2];
#pragma unroll
    for (int a = 0; a < 2; ++a)
#pragma unroll
        for (int b = 0; b < 2; ++b)
#pragma unroll
            for (int m = 0; m < 4; ++m)
#pragma unroll
                for (int n = 0; n < 2; ++n) acc[a][b][m][n] = (f32x4){0.f, 0.f, 0.f, 0.f};
    int scb_ = SCB, sca_ = SCA; asm volatile("" : "+v"(scb_), "+v"(sca_));
    bf16x8 At[4][2], B0[2][2], B1[2][2]; i32x8 At8[4], B08[2], B18[2];
    const char* cA = (const char*)g.A + (size_t)cur.pm * tstep; const char* cB = (const char*)g.Bt + (size_t)cur.pn * tstep;
    S.a_ready(cur);
    if constexpr (SP2) {
        PG8_STAGE(PG8_SB(0, 0), cB, voffB); PG8_STAGE(PG8_SB(0, 1), cB + hstep, voffB); PG8_STAGE(PG8_SA(0, 0), cA, voffA); PG8_STAGE(PG8_SA(0, 1), cA + hstep, voffA);
        if (wr == 1) PG8_BAR;
        PG8_WAIT_V(2); PG8_BAR;
        PG8_STAGE(PG8_SB(1, 0), cB + kstep, voffB); PG8_STAGE(PG8_SA(1, 0), cA + kstep, voffA); PG8_STAGE(PG8_SB(1, 1), cB + hstep + kstep, voffB);
        PG8_WAIT_V(6); PG8_BAR;
    } else {
        PG8_STAGE(PG8_SB(0, 0), cB, voffB); PG8_STAGE(PG8_SA(0, 0), cA, voffA); PG8_STAGE(PG8_SB(0, 1), cB + hstep, voffB); PG8_STAGE(PG8_SA(0, 1), cA + hstep, voffA);
        if (wr == 1) PG8_BAR;
        PG8_WAIT_V(4); PG8_BAR;
        PG8_STAGE(PG8_SB(1, 0), cB + kstep, voffB); PG8_STAGE(PG8_SA(1, 0), cA + kstep, voffA); PG8_STAGE(PG8_SB(1, 1), cB + hstep + kstep, voffB);
        PG8_WAIT_V(6); PG8_BAR;
    }
    for (;;) {
        const bool has_next = S.next(ui + 1, nxt);
        const char* nA = has_next ? (const char*)g.A + (size_t)nxt.pm * tstep : cA; const char* nB = has_next ? (const char*)g.Bt + (size_t)nxt.pn * tstep : cB;
#pragma unroll 1
        for (int t = 0; t < nt; t += 2) {
            const bool last = (t == nt - 2);
            const char* a1 = cA + (size_t)(t + 1) * kstep;
            const char* a2 = last ? nA : cA + (size_t)(t + 2) * kstep; const char* b2 = last ? nB : cB + (size_t)(t + 2) * kstep;
            const char* a3 = a2 + kstep; const char* b3 = b2 + kstep;
            if (last && has_next) S.a_ready(nxt);
            if constexpr (SP2) {
            PG8_LDB(B0, 0, 0); PG8_LDB(B1, 0, 1); PG8_SCHED; PG8_LDA(At, 0, 0); PG8_STAGE(PG8_SA(1, 1), a1 + hstep, voffA);
            PG8_WAIT_V(8); PG8_WAIT_L(0); PG8_BAR; PG8_MMA(0, 0, At, B0); PG8_MMA(0, 1, At, B1); PG8_BAR; PG8_SCHED;
            PG8_LDA(At, 0, 1); PG8_STAGE(PG8_SB(0, 0), b2, voffB); PG8_STAGE(PG8_SB(0, 1), b2 + hstep, voffB); PG8_STAGE(PG8_SA(0, 0), a2, voffA);
            PG8_WAIT_V(8); PG8_WAIT_L(0); PG8_BAR; PG8_MMA(1, 0, At, B0); PG8_MMA(1, 1, At, B1); PG8_BAR; PG8_SCHED;
            PG8_LDB(B0, 1, 0); PG8_LDB(B1, 1, 1); PG8_SCHED; PG8_LDA(At, 1, 0); PG8_STAGE(PG8_SA(0, 1), a2 + hstep, voffA);
            PG8_WAIT_V(8); PG8_WAIT_L(0); PG8_BAR; PG8_MMA(0, 0, At, B0); PG8_MMA(0, 1, At, B1); PG8_BAR; PG8_SCHED;
            PG8_LDA(At, 1, 1); PG8_STAGE(PG8_SB(1, 0), b3, voffB); PG8_STAGE(PG8_SB(1, 1), b3 + hstep, voffB); PG8_STAGE(PG8_SA(1, 0), a3, voffA);
            PG8_WAIT_V(8); PG8_WAIT_L(0); PG8_BAR; PG8_MMA(1, 0, At, B0); PG8_MMA(1, 1, At, B1); PG8_BAR; PG8_SCHED;
            } else {
            PG8_LDB(B0, 0, 0); PG8_SCHED; PG8_LDA(At, 0, 0); PG8_STAGE(PG8_SA(1, 1), a1 + hstep, voffA);
            PG8_WAIT_L(8); PG8_BAR; PG8_WAIT_L(0); PG8_MMA(0, 0, At, B0); PG8_BAR; PG8_SCHED;
            PG8_LDB(B1, 0, 1); PG8_STAGE(PG8_SB(0, 0), b2, voffB);
            PG8_BAR; PG8_WAIT_L(0); PG8_MMA(0, 1, At, B1); PG8_BAR;
            PG8_LDA(At, 0, 1); PG8_STAGE(PG8_SA(0, 0), a2, voffA);
            PG8_BAR; PG8_WAIT_L(0); PG8_MMA(1, 0, At, B0); PG8_BAR; PG8_SCHED;
            PG8_STAGE(PG8_SB(0, 1), b2 + hstep, voffB);
            PG8_WAIT_V(6); PG8_BAR; PG8_MMA(1, 1, At, B1); PG8_BAR;
            PG8_LDB(B0, 1, 0); PG8_SCHED; PG8_LDA(At, 1, 0); PG8_STAGE(PG8_SA(0, 1), a2 + hstep, voffA);
            PG8_WAIT_L(8); PG8_BAR; PG8_WAIT_L(0); PG8_MMA(0, 0, At, B0); PG8_BAR; PG8_SCHED;
            PG8_LDB(B1, 1, 1); PG8_STAGE(PG8_SB(1, 0), b3, voffB);
            PG8_BAR; PG8_WAIT_L(0); PG8_MMA(0, 1, At, B1); PG8_BAR;
            PG8_LDA(At, 1, 1); PG8_STAGE(PG8_SA(1, 0), a3, voffA);
            PG8_BAR; PG8_WAIT_L(0); PG8_MMA(1, 0, At, B0); PG8_BAR; PG8_SCHED;
            PG8_STAGE(PG8_SB(1, 1), b3 + hstep, voffB);
            PG8_WAIT_V(6); PG8_BAR; PG8_MMA(1, 1, At, B1); PG8_BAR;
            }
        }
        if constexpr (SCB != 0) asm volatile("s_nop 15\n\ts_nop 15" ::: "memory");
        if constexpr (ALIGN_EPI) { if (wr == 0) PG8_BAR; }
        if constexpr (!Epi::AFTER_DRAIN) { int fr_ = fr, fq_ = fq; asm volatile("" : "+v"(fr_), "+v"(fq_));
            E(acc, cur, wr, wc, fr_, fq_); S.done(cur); }
        if (!has_next) break;
#pragma unroll
        for (int a = 0; a < 2; ++a)
#pragma unroll
            for (int b = 0; b < 2; ++b)
#pragma unroll
                for (int m = 0; m < 4; ++m)
#pragma unroll
                    for (int n = 0; n < 2; ++n) acc[a][b][m][n] = (f32x4){0.f, 0.f, 0.f, 0.f};
        cur = nxt; cA = nA; cB = nB; ++ui;
        if constexpr (ALIGN_EPI) { if (wr == 1) PG8_BAR; }
    }
    PG8_WAIT_V(0);
    if constexpr (!ALIGN_EPI) { if (wr == 0) PG8_BAR; }
    PG8_BAR;
    if constexpr (Epi::AFTER_DRAIN) { E.fused(acc, cur, wr, wc, fr, fq, lds, wid, lane); S.done(cur); }
#undef PG8_SA
#undef PG8_SB
#undef PG8_STAGE
#undef PG8_LDA
#undef PG8_LDB
#undef PG8_MMA
#undef PG8_WAIT_V
#undef PG8_WAIT_L
#undef PG8_BAR
#undef PG8_SCHED
}

struct GemmMix { const void* A; const void* B; int LD;
                 int K0, K1, OFF1, M, N; };
template <class Epi, class Sched, int SCB, int SCA>
__device__ __forceinline__ void gemm_phase_mix(PG8_LAS unsigned char* lds, const GemmMix g, const Sched& S, const Epi& E) {
    int tid_ = threadIdx.x; asm volatile("" : "+v"(tid_));
    const int tid = tid_, wid = __builtin_amdgcn_readfirstlane(tid >> 6), lane = tid & 63, wr = wid >> 2, wc = wid & 3, fr = lane & 15, fq = lane >> 4;
    const int nt0 = g.K0 / BK, nt1 = g.K1 / BK, nt = nt0 + nt1, koff1 = g.OFF1 / BK - nt0;
    unsigned voffA[2], voffB[2];
#pragma unroll
    for (int i = 0; i < 2; ++i) { int R, C; stage_rc(tid * 16 + i * 8192, R, C); const int Rb = Epi::PERM ? ((R & ~31) + perm32(R & 31)) : R;
        voffA[i] = (unsigned)(R * g.LD + C) * 2u; voffB[i] = (unsigned)(Rb * g.LD + C) * 2u; }
    const size_t kstep = (size_t)(BK * 2);
    const size_t hstep = (size_t)HALF * g.LD * 2, tstep = 2 * hstep;
    const unsigned ldsw = (unsigned)wid * 1024u;
    const int aoff = lds_byte(wr * 64 + fr, fq * 8), boff = lds_byte(wc * 32 + fr, fq * 8);
#define PG8_SA(b, h) (((b) * 2 + (h)) * HTB)
#define PG8_SB(b, h) ((4 + (b) * 2 + (h)) * HTB)
#define PG8_STAGE(bufoff, gbase, voff) do { _Pragma("unroll") for (int _i = 0; _i < 2; ++_i) \
        __builtin_amdgcn_global_load_lds((const unsigned*)((const char*)(gbase) + (voff)[_i]), (PG8_LAS unsigned*)(lds + (bufoff) + ldsw + _i * 8192), 16, 0, 0); } while (0)
#define PG8_LDA1(dst, b, h) do { _Pragma("unroll") for (int m = 0; m < 4; ++m) dst##8[m] = ld2x16(lds + PG8_SA(b, h) + aoff + m * 2048); } while (0)
#define PG8_LDB1(dst, b, h) do { _Pragma("unroll") for (int n = 0; n < 2; ++n) dst##8[n] = ld2x16(lds + PG8_SB(b, h) + boff + n * 2048); } while (0)
#define PG8_LDA0(dst, b, h) do { _Pragma("unroll") for (int m = 0; m < 4; ++m) _Pragma("unroll") for (int k = 0; k < 2; ++k) dst[m][k] = *(const PG8_LAS bf16x8*)(lds + PG8_SA(b, h) + aoff + m * 2048 + k * 1024); } while (0)
#define PG8_LDB0(dst, b, h) do { _Pragma("unroll") for (int n = 0; n < 2; ++n) _Pragma("unroll") for (int k = 0; k < 2; ++k) dst[n][k] = *(const PG8_LAS bf16x8*)(lds + PG8_SB(b, h) + boff + n * 2048 + k * 1024); } while (0)
#define PG8_MMA1(ai, bj, At, Bt) do { __builtin_amdgcn_s_setprio(1); _Pragma("unroll") for (int m = 0; m < 4; ++m) _Pragma("unroll") for (int n = 0; n < 2; ++n) \
            asm volatile("v_mfma_scale_f32_16x16x128_f8f6f4 %0, %1, %2, %0, %3, %4 op_sel_hi:[0,0,0]" : "+v"(acc[ai][bj][m][n]) : "v"(Bt##8[n]), "v"(At##8[m]), "v"(scb_), "v"(sca_)); \
        __builtin_amdgcn_s_setprio(0); } while (0)
#define PG8_MMA0(ai, bj, At, Bt) do { __builtin_amdgcn_s_setprio(1); _Pragma("unroll") for (int m = 0; m < 4; ++m) _Pragma("unroll") for (int n = 0; n < 2; ++n) _Pragma("unroll") for (int k = 0; k < 2; ++k) \
            acc[ai][bj][m][n] = __builtin_amdgcn_mfma_f32_16x16x32_bf16(Bt[n][k], At[m][k], acc[ai][bj][m][n], 0, 0, 0); \
        __builtin_amdgcn_s_setprio(0); } while (0)
#define PG8_WAIT_V(n) asm volatile("s_waitcnt vmcnt(" #n ")" ::: "memory")
#define PG8_WAIT_L(n) asm volatile("s_waitcnt lgkmcnt(" #n ")" ::: "memory")
#define PG8_BAR __builtin_amdgcn_s_barrier()
#define PG8_SCHED __builtin_amdgcn_sched_barrier(0)
    Unit cur, nxt; int ui = 0;
    if (!S.next(0, cur)) return;
    f32x4 acc[2][2][4][2];
#pragma unroll
    for (int a = 0; a < 2; ++a)
#pragma unroll
        for (int b = 0; b < 2; ++b)
#pragma unroll
            for (int m = 0; m < 4; ++m)
#pragma unroll
                for (int n = 0; n < 2; ++n) acc[a][b][m][n] = (f32x4){0.f, 0.f, 0.f, 0.f};
    int scb_ = SCB, sca_ = SCA; asm volatile("" : "+v"(scb_), "+v"(sca_));
    bf16x8 At[4][2], B0[2][2], B1[2][2]; i32x8 At8[4], B08[2], B18[2];
    const char* cA = (const char*)g.A + (size_t)cur.pm * tstep; const char* cB = (const char*)g.B + (size_t)cur.pn * tstep;
    S.a_ready(cur);
    PG8_STAGE(PG8_SB(0, 0), cB, voffB); PG8_STAGE(PG8_SB(0, 1), cB + hstep, voffB); PG8_STAGE(PG8_SA(0, 0), cA, voffA); PG8_STAGE(PG8_SA(0, 1), cA + hstep, voffA);
    if (wr == 1) PG8_BAR;
    PG8_WAIT_V(2); PG8_BAR;
    PG8_STAGE(PG8_SB(1, 0), cB + kstep, voffB); PG8_STAGE(PG8_SA(1, 0), cA + kstep, voffA); PG8_STAGE(PG8_SB(1, 1), cB + hstep + kstep, voffB);
    PG8_WAIT_V(6); PG8_BAR;
    for (;;) {
        const bool has_next = S.next(ui + 1, nxt);
        const char* nA = has_next ? (const char*)g.A + (size_t)nxt.pm * tstep : cA; const char* nB = has_next ? (const char*)g.B + (size_t)nxt.pn * tstep : cB;
#define PG8_KPOS(x) ((size_t)((x) < nt0 ? (x) : (x) + koff1) * kstep)
#define PG8_TRIP(F) do { \
            const bool last = (t == nt - 2); \
            const char* a1 = cA + PG8_KPOS(t + 1); \
            const char* a2 = last ? nA : cA + PG8_KPOS(t + 2); const char* b2 = last ? nB : cB + PG8_KPOS(t + 2); \
            const char* a3 = last ? nA + kstep : cA + PG8_KPOS(t + 3); const char* b3 = last ? nB + kstep : cB + PG8_KPOS(t + 3); \
            if (last && has_next) S.a_ready(nxt); \
            PG8_LDB##F(B0, 0, 0); PG8_LDB##F(B1, 0, 1); PG8_SCHED; PG8_LDA##F(At, 0, 0); PG8_STAGE(PG8_SA(1, 1), a1 + hstep, voffA); \
            PG8_WAIT_V(8); PG8_WAIT_L(0); PG8_BAR; PG8_MMA##F(0, 0, At, B0); PG8_MMA##F(0, 1, At, B1); PG8_BAR; PG8_SCHED; \
            PG8_LDA##F(At, 0, 1); PG8_STAGE(PG8_SB(0, 0), b2, voffB); PG8_STAGE(PG8_SB(0, 1), b2 + hstep, voffB); PG8_STAGE(PG8_SA(0, 0), a2, voffA); \
            PG8_WAIT_V(8); PG8_WAIT_L(0); PG8_BAR; PG8_MMA##F(1, 0, At, B0); PG8_MMA##F(1, 1, At, B1); PG8_BAR; PG8_SCHED; \
            PG8_LDB##F(B0, 1, 0); PG8_LDB##F(B1, 1, 1); PG8_SCHED; PG8_LDA##F(At, 1, 0); PG8_STAGE(PG8_SA(0, 1), a2 + hstep, voffA); \
            PG8_WAIT_V(8); PG8_WAIT_L(0); PG8_BAR; PG8_MMA##F(0, 0, At, B0); PG8_MMA##F(0, 1, At, B1); PG8_BAR; PG8_SCHED; \
            PG8_LDA##F(At, 1, 1); PG8_STAGE(PG8_SB(1, 0), b3, voffB); PG8_STAGE(PG8_SB(1, 1), b3 + hstep, voffB); PG8_STAGE(PG8_SA(1, 0), a3, voffA); \
            PG8_WAIT_V(8); PG8_WAIT_L(0); PG8_BAR; PG8_MMA##F(1, 0, At, B0); PG8_MMA##F(1, 1, At, B1); PG8_BAR; PG8_SCHED; \
        } while (0)
#pragma unroll 1
        for (int t = 0; t < nt0; t += 2) PG8_TRIP(1);
        asm volatile("s_nop 7" ::: "memory");
#pragma unroll 1
        for (int t = nt0; t < nt; t += 2) PG8_TRIP(0);
#undef PG8_TRIP
#undef PG8_KPOS
        asm volatile("s_nop 15\n\ts_nop 15" ::: "memory");
        if (wr == 0) PG8_BAR;
        { int fr_ = fr, fq_ = fq; asm volatile("" : "+v"(fr_), "+v"(fq_)); E(acc, cur, wr, wc, fr_, fq_); S.done(cur); }
        if (!has_next) break;
#pragma unroll
        for (int a = 0; a < 2; ++a)
#pragma unroll
            for (int b = 0; b < 2; ++b)
#pragma unroll
                for (int m = 0; m < 4; ++m)
#pragma unroll
                    for (int n = 0; n < 2; ++n) acc[a][b][m][n] = (f32x4){0.f, 0.f, 0.f, 0.f};
        cur = nxt; cA = nA; cB = nB; ++ui;
        if (wr == 1) PG8_BAR;
    }
    PG8_WAIT_V(0);
    PG8_BAR;
#undef PG8_SA
#undef PG8_SB
#undef PG8_STAGE
#undef PG8_LDA0
#undef PG8_LDB0
#undef PG8_LDA1
#undef PG8_LDB1
#undef PG8_MMA0
#undef PG8_MMA1
#undef PG8_WAIT_V
#undef PG8_WAIT_L
#undef PG8_BAR
#undef PG8_SCHED
}
}
namespace att {
constexpr int KS_M = 400, KS_N = 272, VS = 320;
constexpr int MLA_KB = 64 * KS_M, NSA_KB = 64 * KS_N, VB = 64 * VS;
constexpr int N_IMP = 2 * NSA_KB + 2 * VB;
constexpr int N_PART = N_IMP + 32768;
constexpr int N_PARTB = 8 * 32 * 17 * 4;
constexpr int N_SELM = N_PART + 2 * N_PARTB;
constexpr int N_ULIST = N_SELM + 1024;
constexpr int N_CARRY = N_ULIST + 1024;
constexpr int N_NTS = N_CARRY + 256;
static_assert(N_NTS + 16 <= MISC_OFF, "NSA LDS map");
static_assert(2 * MLA_KB + 3 * VB <= 131072, "MLA LDS map");
constexpr int MLA_QL = 2 * MLA_KB + 2 * VB;
static_assert(MLA_QL + 8 * 4096 <= 131072, "MLA LDS map (pipelined)");

#ifndef QK_PF
#define QK_PF 4
#endif
#define MFMA32(a, b, c) __builtin_amdgcn_mfma_f32_32x32x16_bf16((a), (b), (c), 0, 0, 0)
__device__ __forceinline__ float swapmax(float v) { auto rr = __builtin_amdgcn_permlane32_swap(__float_as_uint(v), __float_as_uint(v), false, false); return fmaxf(__uint_as_float(rr[0]), __uint_as_float(rr[1])); }
__device__ __forceinline__ float swapsum(float v) { auto rr = __builtin_amdgcn_permlane32_swap(__float_as_uint(v), __float_as_uint(v), false, false); return __uint_as_float(rr[0]) + __uint_as_float(rr[1]); }
template <int SIDX> __device__ __forceinline__ bf16x8 packp(const f32x16& p) {
    f32x8 t = {p[8 * SIDX + 0], p[8 * SIDX + 1], p[8 * SIDX + 2], p[8 * SIDX + 3], p[8 * SIDX + 4], p[8 * SIDX + 5], p[8 * SIDX + 6], p[8 * SIDX + 7]};
    return __builtin_bit_cast(bf16x8, __builtin_convertvector(t, bf16x8v));
}
template <int NDC, int KS, bool ZERO = true> __device__ __forceinline__ void qk_tile(f32x16& p0, f32x16& p1, const LAS unsigned char* kl, const bf16x8 (&q)[NDC]) {
    if (ZERO) {
#pragma unroll
        for (int i = 0; i < 16; ++i) { p0[i] = 0.f; p1[i] = 0.f; }
    }
    constexpr int PF = QK_PF;
    bf16x8 a[PF + 1][2];
#pragma unroll
    for (int i = 0; i < PF; ++i) { a[i][0] = *(const LAS bf16x8*)(kl + i * 32); a[i][1] = *(const LAS bf16x8*)(kl + 32 * KS + i * 32); }
#pragma unroll
    for (int d0 = 0; d0 < NDC; ++d0) {
        if (d0 + PF < NDC) { a[(d0 + PF) % (PF + 1)][0] = *(const LAS bf16x8*)(kl + (d0 + PF) * 32); a[(d0 + PF) % (PF + 1)][1] = *(const LAS bf16x8*)(kl + 32 * KS + (d0 + PF) * 32); }
        __builtin_amdgcn_sched_barrier(0);
        p0 = MFMA32(a[d0 % (PF + 1)][0], q[d0], p0); p1 = MFMA32(a[d0 % (PF + 1)][1], q[d0], p1);
        __builtin_amdgcn_sched_barrier(0);
    }
}
__device__ __forceinline__ void pv_tile(f32x16 (&o)[4], const bf16x8 (&pb)[4], const LAS unsigned char* vl) {
    s16x4 f[5][2];
#define PV_LD(idx) do { constexpr int d_ = (idx) >> 2, s_ = (idx) & 3; \
        f[(idx) % 5][0] = __builtin_amdgcn_ds_read_tr16_b64_v4i16((LAS s16x4*)(vl + s_ * 16 * VS + d_ * 64)); \
        f[(idx) % 5][1] = __builtin_amdgcn_ds_read_tr16_b64_v4i16((LAS s16x4*)(vl + s_ * 16 * VS + 8 * VS + d_ * 64)); } while (0)
    PV_LD(0); PV_LD(1); PV_LD(2); PV_LD(3);
#define PV_STEP(idx) do { if ((idx) + 4 < 16) PV_LD((idx) + 4); __builtin_amdgcn_sched_barrier(0); \
        { const s16x4 t0_ = f[(idx) % 5][0], t1_ = f[(idx) % 5][1]; const bf16x8 vf_ = {t0_[0], t0_[1], t0_[2], t0_[3], t1_[0], t1_[1], t1_[2], t1_[3]}; \
          o[(idx) >> 2] = MFMA32(vf_, pb[(idx) & 3], o[(idx) >> 2]); } __builtin_amdgcn_sched_barrier(0); } while (0)
    PV_STEP(0); PV_STEP(1); PV_STEP(2); PV_STEP(3); PV_STEP(4); PV_STEP(5); PV_STEP(6); PV_STEP(7);
    PV_STEP(8); PV_STEP(9); PV_STEP(10); PV_STEP(11); PV_STEP(12); PV_STEP(13); PV_STEP(14); PV_STEP(15);
#undef PV_STEP
#undef PV_LD
}
template <int NDC, int NQR, int KS> __device__ __forceinline__ void qk_tile_free(f32x16& p0, f32x16& p1, const LAS unsigned char* kl, const bf16x8 (&q)[NQR], const LAS unsigned char* ql) {
#pragma unroll
    for (int i = 0; i < 16; ++i) { p0[i] = 0.f; p1[i] = 0.f; }
#pragma unroll
    for (int d0 = 0; d0 < NDC; ++d0) {
        const bf16x8 a0 = *(const LAS bf16x8*)(kl + d0 * 32);
        const bf16x8 a1 = *(const LAS bf16x8*)(kl + 32 * KS + d0 * 32);
        bf16x8 qq; if (d0 < NQR) qq = q[d0 < NQR ? d0 : 0]; else qq = *(const LAS bf16x8*)(ql + (d0 - NQR) * 1024);
        p0 = MFMA32(a0, qq, p0); p1 = MFMA32(a1, qq, p1);
    }
}
__device__ __forceinline__ float sm_core(f32x16& p0, f32x16& p1, float& m, float& l) {
    float tm = p0[0];
#pragma unroll
    for (int r = 1; r < 16; ++r) tm = fmaxf(tm, p0[r]);
#pragma unroll
    for (int r = 0; r < 16; ++r) tm = fmaxf(tm, p1[r]);
    tm = swapmax(tm);
    const float mn = fmaxf(m, tm);
    const float alpha = __builtin_amdgcn_exp2f(m - mn);
    m = mn;
    float ps = 0.f;
#pragma unroll
    for (int r = 0; r < 16; ++r) { p0[r] = __builtin_amdgcn_exp2f(p0[r] - mn); ps += p0[r]; }
#pragma unroll
    for (int r = 0; r < 16; ++r) { p1[r] = __builtin_amdgcn_exp2f(p1[r] - mn); ps += p1[r]; }
    ps = swapsum(ps);
    l = l * alpha + ps;
    return alpha;
}
__device__ __forceinline__ void online_sm(f32x16& p0, f32x16& p1, float& m, float& l, f32x16 (&o)[4]) {
    float tm = p0[0];
#pragma unroll
    for (int r = 1; r < 16; ++r) tm = fmaxf(tm, p0[r]);
#pragma unroll
    for (int r = 0; r < 16; ++r) tm = fmaxf(tm, p1[r]);
    tm = swapmax(tm);
    const float mn = fmaxf(m, tm);
    const float alpha = __builtin_amdgcn_exp2f(m - mn);
    m = mn;
    float ps = 0.f;
#pragma unroll
    for (int r = 0; r < 16; ++r) { p0[r] = __builtin_amdgcn_exp2f(p0[r] - mn); ps += p0[r]; }
#pragma unroll
    for (int r = 0; r < 16; ++r) { p1[r] = __builtin_amdgcn_exp2f(p1[r] - mn); ps += p1[r]; }
    ps = swapsum(ps);
    l = l * alpha + ps;
    if (!__all(alpha == 1.f)) {
#pragma unroll
        for (int d = 0; d < 4; ++d)
#pragma unroll
            for (int r = 0; r < 16; ++r) o[d][r] *= alpha;
    }
}

typedef long i64;
constexpr int KS8 = 200, MLA_KB8 = 64 * KS8;
static_assert(2 * MLA_KB8 + 3 * VB <= 131072, "MLA fp8 LDS map");
#define MFMA32F8(a, b, c) __builtin_amdgcn_mfma_f32_32x32x16_fp8_fp8((a), (b), (c), 0, 0, 0)
template <int NDC> __device__ __forceinline__ void qk_tile8(f32x16& p0, f32x16& p1, const LAS unsigned char* kl, const i64 (&q)[NDC]) {
#pragma unroll
    for (int i = 0; i < 16; ++i) { p0[i] = 0.f; p1[i] = 0.f; }
    constexpr int PF = 4;
    i64 a[PF + 1][2];
#pragma unroll
    for (int i = 0; i < PF; ++i) { a[i][0] = *(const LAS i64*)(kl + i * 16); a[i][1] = *(const LAS i64*)(kl + 32 * KS8 + i * 16); }
#pragma unroll
    for (int d0 = 0; d0 < NDC; ++d0) {
        if (d0 + PF < NDC) { a[(d0 + PF) % (PF + 1)][0] = *(const LAS i64*)(kl + (d0 + PF) * 16); a[(d0 + PF) % (PF + 1)][1] = *(const LAS i64*)(kl + 32 * KS8 + (d0 + PF) * 16); }
        __builtin_amdgcn_sched_barrier(0);
        __builtin_amdgcn_s_setprio(1);
        p0 = MFMA32F8(a[d0 % (PF + 1)][0], q[d0], p0); p1 = MFMA32F8(a[d0 % (PF + 1)][1], q[d0], p1);
        __builtin_amdgcn_s_setprio(0);
        __builtin_amdgcn_sched_barrier(0);
    }
}
__device__ __forceinline__ void online_sm_scaled(f32x16& p0, f32x16& p1, float& m, float& l, f32x16 (&o)[4], const float C2) {
    float tm = p0[0];
#pragma unroll
    for (int r = 1; r < 16; ++r) tm = fmaxf(tm, p0[r]);
#pragma unroll
    for (int r = 0; r < 16; ++r) tm = fmaxf(tm, p1[r]);
    tm = swapmax(tm);
    const float mn = fmaxf(m, tm);
    const float alpha = __builtin_amdgcn_exp2f((m - mn) * C2);
    m = mn;
    const float mc = -mn * C2;
    float ps = 0.f;
#pragma unroll
    for (int r = 0; r < 16; ++r) { p0[r] = __builtin_amdgcn_exp2f(__builtin_fmaf(p0[r], C2, mc)); ps += p0[r]; }
#pragma unroll
    for (int r = 0; r < 16; ++r) { p1[r] = __builtin_amdgcn_exp2f(__builtin_fmaf(p1[r], C2, mc)); ps += p1[r]; }
    ps = swapsum(ps);
    l = l * alpha + ps;
    if (!__all(alpha == 1.f)) {
#pragma unroll
        for (int d = 0; d < 4; ++d)
#pragma unroll
            for (int r = 0; r < 16; ++r) o[d][r] *= alpha;
    }
}
constexpr int VS8 = 72, VB8 = 128 * VS8;
constexpr int VS8B = 136, VB8B = 128 * VS8B, MLA_KB8B = 128 * KS8;
static_assert(2 * MLA_KB8B + 3 * VB8B <= 131072, "MLA big-tile LDS map");
#define PV8_RS VS8
static_assert(2 * MLA_KB8 + 3 * VB8 <= 131072, "MLA fp8 LDS map");
template <int SIDX> __device__ __forceinline__ i64 packp8(const f32x16& p) {
    int w0 = __builtin_amdgcn_cvt_pk_fp8_f32(p[8 * SIDX + 0] * 256.f, p[8 * SIDX + 1] * 256.f, 0, false); w0 = __builtin_amdgcn_cvt_pk_fp8_f32(p[8 * SIDX + 2] * 256.f, p[8 * SIDX + 3] * 256.f, w0, true);
    int w1 = __builtin_amdgcn_cvt_pk_fp8_f32(p[8 * SIDX + 4] * 256.f, p[8 * SIDX + 5] * 256.f, 0, false); w1 = __builtin_amdgcn_cvt_pk_fp8_f32(p[8 * SIDX + 6] * 256.f, p[8 * SIDX + 7] * 256.f, w1, true);
    return (i64)(((unsigned long long)(unsigned)w1 << 32) | (unsigned)w0);
}
__device__ __forceinline__ void pv_tile8(f32x16 (&o)[4], const i64 (&pb)[4], const LAS unsigned char* vl) {
    i64 f[5];
#define PV8_LD(idx) f[(idx) % 5] = *(const LAS i64*)(vl + ((idx) >> 2) * 32 * PV8_RS + ((idx) & 3) * 16)
    PV8_LD(0); PV8_LD(1); PV8_LD(2); PV8_LD(3);
#define PV8_STEP(idx) do { if ((idx) + 4 < 16) PV8_LD((idx) + 4); __builtin_amdgcn_sched_barrier(0); \
        o[(idx) >> 2] = MFMA32F8(f[(idx) % 5], pb[(idx) & 3], o[(idx) >> 2]); __builtin_amdgcn_sched_barrier(0); } while (0)
    PV8_STEP(0); PV8_STEP(1); PV8_STEP(2); PV8_STEP(3); PV8_STEP(4); PV8_STEP(5); PV8_STEP(6); PV8_STEP(7);
    PV8_STEP(8); PV8_STEP(9); PV8_STEP(10); PV8_STEP(11); PV8_STEP(12); PV8_STEP(13); PV8_STEP(14); PV8_STEP(15);
#undef PV8_STEP
#undef PV8_LD
}
typedef int i32x8 __attribute__((ext_vector_type(8)));
constexpr int KSX = 208, MLA_KBX = 64 * KSX;
constexpr int VSX = 80, VBX = 128 * VSX;
static_assert(2 * MLA_KBX + 3 * VBX <= 131072, "MLA mx LDS map");
#define MFMAX(a, b, c) __builtin_amdgcn_mfma_scale_f32_32x32x64_f8f6f4((a), (b), (c), 0, 0, 0, 0x7f7f7f7f, 0, 0x7f7f7f7f)
__device__ __forceinline__ i32x8 ldsx(const LAS unsigned char* p) {
    const u32x4 a = *(const LAS u32x4*)p, b = *(const LAS u32x4*)(p + 16);
    return (i32x8){(int)a.x, (int)a.y, (int)a.z, (int)a.w, (int)b.x, (int)b.y, (int)b.z, (int)b.w};
}
__device__ __forceinline__ void qk_tilex(f32x16& p0, f32x16& p1, const LAS unsigned char* kl, const i32x8 (&q)[3]) {
#pragma unroll
    for (int i = 0; i < 16; ++i) { p0[i] = 0.f; p1[i] = 0.f; }
    i32x8 a0 = ldsx(kl), a1 = ldsx(kl + 32 * KSX), a2 = ldsx(kl + 64), a3 = ldsx(kl + 32 * KSX + 64);
    __builtin_amdgcn_sched_barrier(0);
    __builtin_amdgcn_s_setprio(1);
    p0 = MFMAX(a0, q[0], p0); p1 = MFMAX(a1, q[0], p1);
    __builtin_amdgcn_s_setprio(0);
    __builtin_amdgcn_sched_barrier(0);
    a0 = ldsx(kl + 128); a1 = ldsx(kl + 32 * KSX + 128);
    __builtin_amdgcn_sched_barrier(0);
    __builtin_amdgcn_s_setprio(1);
    p0 = MFMAX(a2, q[1], p0); p1 = MFMAX(a3, q[1], p1);
    __builtin_amdgcn_sched_barrier(0);
    p0 = MFMAX(a0, q[2], p0); p1 = MFMAX(a1, q[2], p1);
    __builtin_amdgcn_s_setprio(0);
    __builtin_amdgcn_sched_barrier(0);
}
__device__ __forceinline__ void pv_tilex(f32x16 (&o)[4], const i32x8& pb, const LAS unsigned char* vl) {
    i32x8 f0 = ldsx(vl), f1 = ldsx(vl + 32 * VSX);
    __builtin_amdgcn_sched_barrier(0);
    o[0] = MFMAX(f0, pb, o[0]);
    __builtin_amdgcn_sched_barrier(0);
    f0 = ldsx(vl + 64 * VSX);
    __builtin_amdgcn_sched_barrier(0);
    o[1] = MFMAX(f1, pb, o[1]);
    __builtin_amdgcn_sched_barrier(0);
    f1 = ldsx(vl + 96 * VSX);
    __builtin_amdgcn_sched_barrier(0);
    o[2] = MFMAX(f0, pb, o[2]);
    __builtin_amdgcn_sched_barrier(0);
    o[3] = MFMAX(f1, pb, o[3]);
    __builtin_amdgcn_sched_barrier(0);
}
__device__ __forceinline__ i32x8 packpx(const f32x16& p0, const f32x16& p1) {
    i32x8 w;
#pragma unroll
    for (int g = 0; g < 4; ++g) {
        int a = __builtin_amdgcn_cvt_pk_fp8_f32(p0[4 * g + 0], p0[4 * g + 1], 0, false); a = __builtin_amdgcn_cvt_pk_fp8_f32(p0[4 * g + 2], p0[4 * g + 3], a, true); w[g] = a;
        int b = __builtin_amdgcn_cvt_pk_fp8_f32(p1[4 * g + 0], p1[4 * g + 1], 0, false); b = __builtin_amdgcn_cvt_pk_fp8_f32(p1[4 * g + 2], p1[4 * g + 3], b, true); w[4 + g] = b;
    }
    return w;
}
__device__ __forceinline__ void online_sm_x(f32x16& p0, f32x16& p1, float& m, float& l, f32x16 (&o)[4], const float C2) {
    float tm = p0[0];
#pragma unroll
    for (int r = 1; r < 16; ++r) tm = fmaxf(tm, p0[r]);
#pragma unroll
    for (int r = 0; r < 16; ++r) tm = fmaxf(tm, p1[r]);
    tm = swapmax(tm);
    const float mn = fmaxf(m, tm);
    const float alpha = __builtin_amdgcn_exp2f((m - mn) * C2);
    m = mn;
    const float mc = 8.f - mn * C2;
    float ps = 0.f;
#pragma unroll
    for (int r = 0; r < 16; ++r) { p0[r] = __builtin_amdgcn_exp2f(__builtin_fmaf(p0[r], C2, mc)); ps += p0[r]; }
#pragma unroll
    for (int r = 0; r < 16; ++r) { p1[r] = __builtin_amdgcn_exp2f(__builtin_fmaf(p1[r], C2, mc)); ps += p1[r]; }
    ps = swapsum(ps);
    l = l * alpha + ps;
    if (!__all(alpha == 1.f)) {
#pragma unroll
        for (int d = 0; d < 4; ++d)
#pragma unroll
            for (int r = 0; r < 16; ++r) o[d][r] *= alpha;
    }
}
#define MXL_T 126.0f
#define MXL_REF 96.0f
#define MFMAXQ(a, b, c) __builtin_amdgcn_mfma_scale_f32_32x32x64_f8f6f4((a), (b), (c), 0, 0, 0, 0x7f7f7f7f, 0, 0x7f7f7f7f)
__device__ __forceinline__ i32x8 byte_packx(const f32x16& p0, const f32x16& p1) {
    i32x8 w;
#pragma unroll
    for (int g = 0; g < 4; ++g) {
        unsigned a = __builtin_amdgcn_cvt_pk_u8_f32(p0[4 * g + 0], 0, 0u); a = __builtin_amdgcn_cvt_pk_u8_f32(p0[4 * g + 1], 1, a); a = __builtin_amdgcn_cvt_pk_u8_f32(p0[4 * g + 2], 2, a); a = __builtin_amdgcn_cvt_pk_u8_f32(p0[4 * g + 3], 3, a); w[g] = (int)a;
        unsigned b = __builtin_amdgcn_cvt_pk_u8_f32(p1[4 * g + 0], 0, 0u); b = __builtin_amdgcn_cvt_pk_u8_f32(p1[4 * g + 1], 1, b); b = __builtin_amdgcn_cvt_pk_u8_f32(p1[4 * g + 2], 2, b); b = __builtin_amdgcn_cvt_pk_u8_f32(p1[4 * g + 3], 3, b); w[4 + g] = (int)b;
    }
    return w;
}
__device__ __forceinline__ void qk_tilexl(f32x16& p0, f32x16& p1, const f32x16& mref, const LAS unsigned char* kl, const i32x8 (&q)[3]) {
    i32x8 a0 = ldsx(kl), a1 = ldsx(kl + 32 * KSX), a2 = ldsx(kl + 64), a3 = ldsx(kl + 32 * KSX + 64);
    __builtin_amdgcn_sched_barrier(0);
    __builtin_amdgcn_s_setprio(1);
    p0 = MFMAXQ(a0, q[0], mref); p1 = MFMAXQ(a1, q[0], mref);
    __builtin_amdgcn_s_setprio(0);
    __builtin_amdgcn_sched_barrier(0);
    a0 = ldsx(kl + 128); a1 = ldsx(kl + 32 * KSX + 128);
    __builtin_amdgcn_sched_barrier(0);
    __builtin_amdgcn_s_setprio(1);
    p0 = MFMAXQ(a2, q[1], p0); p1 = MFMAXQ(a3, q[1], p1);
    __builtin_amdgcn_sched_barrier(0);
    p0 = MFMAXQ(a0, q[2], p0); p1 = MFMAXQ(a1, q[2], p1);
    __builtin_amdgcn_s_setprio(0);
    __builtin_amdgcn_sched_barrier(0);
}
template <int RS = VSX>
__device__ __forceinline__ void pv_tilexl_pre(f32x16 (&o)[5], const i32x8& pb, const i32x8& ones, const LAS unsigned char* vl, i32x8 f0, i32x8 f1) {
    __builtin_amdgcn_sched_barrier(0);
    o[4] = MFMAX(ones, pb, o[4]);
    __builtin_amdgcn_sched_barrier(0);
    o[0] = MFMAX(f0, pb, o[0]);
    __builtin_amdgcn_sched_barrier(0);
    f0 = ldsx(vl + 64 * RS);
    __builtin_amdgcn_sched_barrier(0);
    o[1] = MFMAX(f1, pb, o[1]);
    __builtin_amdgcn_sched_barrier(0);
    f1 = ldsx(vl + 96 * RS);
    __builtin_amdgcn_sched_barrier(0);
    o[2] = MFMAX(f0, pb, o[2]);
    __builtin_amdgcn_sched_barrier(0);
    o[3] = MFMAX(f1, pb, o[3]);
    __builtin_amdgcn_sched_barrier(0);
}
template <int RS = VSX>
__device__ __forceinline__ void pv_tilexl(f32x16 (&o)[5], const i32x8& pb, const i32x8& ones, const LAS unsigned char* vl) {
    i32x8 f0 = ldsx(vl), f1 = ldsx(vl + 32 * RS);
    __builtin_amdgcn_sched_barrier(0);
    o[4] = MFMAX(ones, pb, o[4]);
    __builtin_amdgcn_sched_barrier(0);
    o[0] = MFMAX(f0, pb, o[0]);
    __builtin_amdgcn_sched_barrier(0);
    f0 = ldsx(vl + 64 * RS);
    __builtin_amdgcn_sched_barrier(0);
    o[1] = MFMAX(f1, pb, o[1]);
    __builtin_amdgcn_sched_barrier(0);
    f1 = ldsx(vl + 96 * RS);
    __builtin_amdgcn_sched_barrier(0);
    o[2] = MFMAX(f0, pb, o[2]);
    __builtin_amdgcn_sched_barrier(0);
    o[3] = MFMAX(f1, pb, o[3]);
    __builtin_amdgcn_sched_barrier(0);
}
__device__ __forceinline__ i32x8 exp_packx(const f32x16& p0, const f32x16& p1, int any) {
    i32x8 w;
#pragma unroll
    for (int g = 0; g < 4; ++g) {
        int a = __builtin_amdgcn_cvt_pk_fp8_f32(__builtin_amdgcn_exp2f(p0[4 * g + 0]), __builtin_amdgcn_exp2f(p0[4 * g + 1]), any, false);
        a = __builtin_amdgcn_cvt_pk_fp8_f32(__builtin_amdgcn_exp2f(p0[4 * g + 2]), __builtin_amdgcn_exp2f(p0[4 * g + 3]), a, true); w[g] = a;
        int b = __builtin_amdgcn_cvt_pk_fp8_f32(__builtin_amdgcn_exp2f(p1[4 * g + 0]), __builtin_amdgcn_exp2f(p1[4 * g + 1]), any, false);
        b = __builtin_amdgcn_cvt_pk_fp8_f32(__builtin_amdgcn_exp2f(p1[4 * g + 2]), __builtin_amdgcn_exp2f(p1[4 * g + 3]), b, true); w[4 + g] = b;
    }
    return w;
}
struct MlaPtrs { const bf16* Q; const bf16* K; const bf16* V; const bf16* Z; bf16* O; };
__device__ __forceinline__ void mla_unit(LAS unsigned char* lds, const MlaPtrs& P, int head, int qb, int tid_in, int wave, int lane_in) {
    int tid = tid_in; asm volatile("" : "+v"(tid)); const int lane = tid & 63; (void)lane_in;
    const int r32 = lane & 31, hi = lane >> 5;
    const int q0 = qb * 256, qw = q0 + wave * 32, tq = qw + r32;
    i32x8 q[3];
    { const unsigned char* qp = (const unsigned char*)P.Q + (size_t)tq * 3072 + head * 192 + hi * 32;
#pragma unroll
      for (int s = 0; s < 3; ++s) { const u32x4 a = *(const GAS u32x4*)(qp + 64 * s), b = *(const GAS u32x4*)(qp + 64 * s + 16);
          q[s] = (i32x8){(int)a.x, (int)a.y, (int)a.z, (int)a.w, (int)b.x, (int)b.y, (int)b.z, (int)b.w}; } }
    const int NT = 4 * (qb + 1);
    const int srow = tid >> 3, sc8 = tid & 7;
    const unsigned char* kg = (const unsigned char*)P.K + (size_t)head * 192 + (size_t)srow * 3072 + sc8 * 8;
    const unsigned char* vg = (const unsigned char*)P.V + ((size_t)head * 128 + (tid >> 2)) * S + (tid & 3) * 16;
    LAS unsigned char* kst = lds + srow * KSX + sc8 * 8;
    LAS unsigned char* vst = lds + 2 * MLA_KBX + (tid >> 2) * VSX + (tid & 3) * 16;
    const LAS unsigned char* kl = lds + r32 * KSX + hi * 32;
    const LAS unsigned char* vl = lds + 2 * MLA_KBX + r32 * VSX + hi * 32;
    u32x2 sk0, sk1, sk2; u32x4 sv0;
#define MLA_LOAD(j) do { const unsigned char* kp_ = kg + (size_t)(j) * (64 * 3072); const unsigned char* vp_ = vg + (size_t)(j) * 64; \
        sk0 = *(const GAS u32x2*)(kp_); sk1 = *(const GAS u32x2*)(kp_ + 64); sk2 = *(const GAS u32x2*)(kp_ + 128); sv0 = *(const GAS u32x4*)(vp_); } while (0)
#define MLA_STORE(b, vb) do { LAS unsigned char* kd_ = kst + (b) * MLA_KBX; LAS unsigned char* vd_ = vst + (vb) * VBX; \
        *(LAS u32x2*)(kd_) = sk0; *(LAS u32x2*)(kd_ + 64) = sk1; *(LAS u32x2*)(kd_ + 128) = sk2; *(LAS u32x2*)(vd_) = (u32x2){sv0.x, sv0.y}; *(LAS u32x2*)(vd_ + 8) = (u32x2){sv0.z, sv0.w}; } while (0)
    MLA_LOAD(0); MLA_STORE(0, 0);
    __syncthreads();
    asm volatile("" : "+v"(q[0]), "+v"(q[1]), "+v"(q[2]));
    f32x16 o[5], mref;
#pragma unroll
    for (int d = 0; d < 5; ++d)
#pragma unroll
        for (int r = 0; r < 16; ++r) o[d][r] = 0.f;
#pragma unroll
    for (int r = 0; r < 16; ++r) mref[r] = MXL_REF;
    const int one8 = (r32 == 0 || r32 == 4) ? 0x38383838 : 0;
    const i32x8 ones = {one8, one8, one8, one8, one8, one8, one8, one8};
    const bool trail = wave >= 4;
    i32x8 pb = {}, fa = {}, fb = {};
    int vb_cur = 0, vb_prev = 2;
    for (int j = 0; j < NT; ++j) {
        const int kb = 64 * j;
        int vb_next = vb_cur + 1; if (vb_next == 3) vb_next = 0;
        if (j + 1 < NT) MLA_LOAD(j + 1);
        if (trail && j > 0 && kb - 64 <= qw + 31) pv_tilexl_pre(o, pb, ones, vl + vb_prev * VBX, fa, fb);
        if (kb <= qw + 31) {
            f32x16 p0, p1;
            qk_tilexl(p0, p1, mref, kl + (j & 1) * MLA_KBX, q);
            fa = ldsx(vl + vb_cur * VBX); fb = ldsx(vl + vb_cur * VBX + 32 * VSX);
            __builtin_amdgcn_sched_barrier(0);
            if (kb + 63 > qw) {
                const int dq = tq - kb - 4 * hi;
#pragma unroll
                for (int r = 0; r < 16; ++r) { const int c = (r & 3) + 8 * (r >> 2);
                    if (c > dq) p0[r] = -__builtin_inff();
                    if (c + 32 > dq) p1[r] = -__builtin_inff(); }
            }
            float tm = p0[0];
#pragma unroll
            for (int r = 1; r < 16; ++r) tm = fmaxf(tm, p0[r]);
#pragma unroll
            for (int r = 0; r < 16; ++r) tm = fmaxf(tm, p1[r]);
            tm = swapmax(tm);
            if (j == 0 || !__all(tm <= MXL_T)) {
                const float dlt = (j == 0) ? tm - MXL_REF : fmaxf(tm - MXL_REF, 0.f);
                const float alpha = __builtin_amdgcn_exp2f(-0.125f * dlt);
#pragma unroll
                for (int r = 0; r < 16; ++r) { p0[r] -= dlt; p1[r] -= dlt; mref[r] -= dlt; }
                if (j > 0) {
#pragma unroll
                    for (int d = 0; d < 5; ++d)
#pragma unroll
                        for (int r = 0; r < 16; ++r) o[d][r] *= alpha;
                }
            }
            pb = byte_packx(p0, p1);
            if (!trail) pv_tilexl_pre(o, pb, ones, vl + vb_cur * VBX, fa, fb);
        }
        if (j + 1 < NT) MLA_STORE((j + 1) & 1, vb_next);
        __syncthreads();
        vb_prev = vb_cur; vb_cur = vb_next;
    }
    if (trail && 64 * (NT - 1) <= qw + 31) pv_tilexl_pre(o, pb, ones, vl + vb_prev * VBX, fa, fb);
    __syncthreads();
#undef MLA_LOAD
#undef MLA_STORE
    const bf16* zp = P.Z + (size_t)tq * 2048 + head * 128 + 4 * hi;
    const float inv = 16.f / o[4][0];
    unsigned char* op8 = (unsigned char*)P.O + (size_t)tq * 8192 + head * 128 + 4 * hi;
#pragma unroll
    for (int d0 = 0; d0 < 4; ++d0)
#pragma unroll
        for (int rg = 0; rg < 4; ++rg) { const int dim = 32 * d0 + 8 * rg;
            const u32x2 z = *(const GAS u32x2*)(zp + dim);
            int w = __builtin_amdgcn_cvt_pk_fp8_f32(o[d0][4 * rg + 0] * inv * bflo(z.x), o[d0][4 * rg + 1] * inv * bfhi(z.x), 0, false);
            w = __builtin_amdgcn_cvt_pk_fp8_f32(o[d0][4 * rg + 2] * inv * bflo(z.y), o[d0][4 * rg + 3] * inv * bfhi(z.y), w, true);
            *(GAS unsigned*)(op8 + dim) = (unsigned)w; }
}

struct NsaPtrs { const bf16* Q; const bf16* KV; const bf16* KC; const bf16* VC; const bf16* Z; const float* G; bf16* O; float* scr; };
template <int MODE>
__device__ __forceinline__ void nsa_loop(LAS unsigned char* lds, const unsigned char* kbase, const unsigned char* vbase, int ntiles, int jlo,
                                         const bf16x8 (&q)[8], int t, float slope2, float& m, float& l, f32x16 (&o)[4], float invl, int tid, int wave, int lane) {
    constexpr bool HASV = MODE != 0;
    const int r32 = lane & 31, hi = lane >> 5;
    const int srow = tid >> 3, sc8 = tid & 7;
    const unsigned soff = srow * 256 + sc8 * 16;
    LAS unsigned char* kst = lds + srow * KS_N + sc8 * 16;
    LAS unsigned char* vst = lds + 2 * NSA_KB + srow * VS + sc8 * 16;
    const LAS unsigned char* kl = lds + r32 * KS_N + hi * 16;
    const LAS unsigned char* vl = lds + 2 * NSA_KB + (4 * hi + ((lane & 15) >> 2)) * VS + (16 * ((lane >> 4) & 1) + 4 * (lane & 3)) * 2;
    const LAS int* ulist = (const LAS int*)(lds + N_ULIST);
    const LAS unsigned* selm = (const LAS unsigned*)(lds + N_SELM);
    LAS float* partA = (LAS float*)(lds + N_PART); LAS float* partB = (LAS float*)(lds + N_PART + N_PARTB);
    LAS float* imp = (LAS float*)(lds + N_IMP); LAS float* carry = (LAS float*)(lds + N_CARRY);
    if (ntiles <= 0) return;
    const float mlg = (MODE == 1) ? (invl > 0.f ? m - __builtin_amdgcn_logf(invl) : __builtin_inff()) : 0.f;
    u32x4 sk0, sk1, sv0, sv1;
#define NSA_TROW(j) (MODE == 2 ? 64 * __builtin_amdgcn_readfirstlane(ulist[ntiles - 1 - (j)]) : ((MODE == 3 || MODE == 0) ? 64 * (jlo + ntiles - 1 - (j)) : 64 * (jlo + (j))))
#define NSA_LOAD(j) do { const size_t ro_ = (size_t)NSA_TROW(j) * 256 + soff; \
        sk0 = *(const GAS u32x4*)(kbase + ro_); sk1 = *(const GAS u32x4*)(kbase + ro_ + 128); \
        if (HASV) { sv0 = *(const GAS u32x4*)(vbase + ro_); sv1 = *(const GAS u32x4*)(vbase + ro_ + 128); } } while (0)
#define NSA_STORE(b) do { LAS unsigned char* kd_ = kst + (b) * NSA_KB; *(LAS u32x4*)(kd_) = sk0; *(LAS u32x4*)(kd_ + 128) = sk1; \
        if (HASV) { LAS unsigned char* vd_ = vst + (b) * VB; *(LAS u32x4*)(vd_) = sv0; *(LAS u32x4*)(vd_ + 128) = sv1; } } while (0)
    NSA_LOAD(0); NSA_STORE(0);
    __syncthreads();
    for (int j = 0; j < ntiles; ++j) {
        const int buf = j & 1;
        if (MODE != 1 && j + 1 < ntiles) NSA_LOAD(j + 1);
        const int trow = NSA_TROW(j);
        constexpr int PSTEP = (MODE <= 1) ? 16 : 1;
        const int pstart = (MODE <= 1) ? 16 * trow + 31 : trow;
        const int db = t - pstart - PSTEP * 4 * hi;
        constexpr unsigned W = (MODE == 3) ? 512u : 0x7fffffffu;
        const bool mset = m > -1e29f;
        float b0 = -slope2 * (float)db - ((MODE != 1) ? (mset ? m : 0.f) : mlg);
        if (MODE == 2) { const int b = trow >> 6; if (((selm[r32 * 8 + (b >> 5)] >> (b & 31)) & 1u) == 0u) b0 = -__builtin_inff(); }
        f32x16 p0, p1;
#pragma unroll
        for (int r = 0; r < 16; ++r) { const int c = PSTEP * ((r & 3) + 8 * (r >> 2));
            p0[r] = __builtin_fmaf(slope2, (float)c, b0); p1[r] = __builtin_fmaf(slope2, (float)(c + 32 * PSTEP), b0); }
        qk_tile<8, KS_N, false>(p0, p1, kl + buf * NSA_KB, q);
        { const int t0u = __builtin_amdgcn_readfirstlane(t - r32);
          const bool interior = (t0u - (pstart + PSTEP * 63) >= 0) && ((unsigned)(t0u + 31 - pstart) < W);
          if (!interior) {
#pragma unroll
              for (int r = 0; r < 16; ++r) { const int c = PSTEP * ((r & 3) + 8 * (r >> 2));
                  if ((unsigned)(db - c) >= W) p0[r] = -__builtin_inff();
                  if ((unsigned)(db - c - 32 * PSTEP) >= W) p1[r] = -__builtin_inff(); } } }
        if (MODE == 0) {
            float tm = p0[0];
#pragma unroll
            for (int r = 1; r < 16; ++r) tm = fmaxf(tm, p0[r]);
#pragma unroll
            for (int r = 0; r < 16; ++r) tm = fmaxf(tm, p1[r]);
            tm = swapmax(tm);
            const bool need = mset ? (tm > 16.f) : (tm > -1e29f);
            if (!__all(!need)) {
                const float dlt = need ? tm : 0.f;
                if (mset) l *= __builtin_amdgcn_exp2f(-dlt);
                if (need) m = (mset ? m : 0.f) + dlt;
#pragma unroll
                for (int r = 0; r < 16; ++r) { p0[r] -= dlt; p1[r] -= dlt; }
            }
            float ps = 0.f;
#pragma unroll
            for (int r = 0; r < 16; ++r) ps += __builtin_amdgcn_exp2f(p0[r]) + __builtin_amdgcn_exp2f(p1[r]);
            l += swapsum(ps);
        } else if (MODE == 1) {
#pragma unroll
            for (int r = 0; r < 16; ++r) { p0[r] = __builtin_amdgcn_exp2f(p0[r]); p1[r] = __builtin_amdgcn_exp2f(p1[r]); }
            LAS float* pa = partA + (wave * 32 + r32) * 17 + hi; LAS float* pbm = partB + (wave * 32 + r32) * 17 + hi;
#pragma unroll
            for (int rg = 0; rg < 4; ++rg) {
                pa[2 * rg] = (p0[4 * rg] + p0[4 * rg + 1]) + (p0[4 * rg + 2] + p0[4 * rg + 3]); pbm[2 * rg] = p0[4 * rg + 3];
                pa[8 + 2 * rg] = (p1[4 * rg] + p1[4 * rg + 1]) + (p1[4 * rg + 2] + p1[4 * rg + 3]); pbm[8 + 2 * rg] = p1[4 * rg + 3]; }
            const bf16x8 pb[4] = {packp<0>(p0), packp<1>(p0), packp<0>(p1), packp<1>(p1)};
            pv_tile(o, pb, vl + buf * VB);
            __syncthreads();
            { const int qq = tid >> 4, jl = tid & 15; float a = 0.f, bp = 0.f, bl = 0.f;
#pragma unroll
              for (int w = 0; w < 8; ++w) { a += partA[(w * 32 + qq) * 17 + jl]; bl += partB[(w * 32 + qq) * 17 + jl]; }
              if (jl > 0) {
#pragma unroll
                  for (int w = 0; w < 8; ++w) bp += partB[(w * 32 + qq) * 17 + jl - 1];
              } else bp = (j > 0) ? carry[((j - 1) & 1) * 32 + qq] : 0.f;
              imp[qq * 256 + 16 * j + jl] = a + bp;
              if (jl == 15) carry[(j & 1) * 32 + qq] = bl; }
        } else {
            constexpr float NSA_LAZY_T = 16.f;
            float tm = p0[0];
#pragma unroll
            for (int r = 1; r < 16; ++r) tm = fmaxf(tm, p0[r]);
#pragma unroll
            for (int r = 0; r < 16; ++r) tm = fmaxf(tm, p1[r]);
            tm = swapmax(tm);
            const bool need = mset ? (tm > NSA_LAZY_T) : (tm > -1e29f);
            if (!__all(!need)) {
                const float dlt = need ? tm : 0.f;
                const float alpha = mset ? __builtin_amdgcn_exp2f(-dlt) : 1.f;
                if (need) m = (mset ? m : 0.f) + dlt;
#pragma unroll
                for (int r = 0; r < 16; ++r) { p0[r] -= dlt; p1[r] -= dlt; }
                l *= alpha;
#pragma unroll
                for (int d_ = 0; d_ < 4; ++d_)
#pragma unroll
                    for (int r = 0; r < 16; ++r) o[d_][r] *= alpha;
            }
            float ps = 0.f;
#pragma unroll
            for (int r = 0; r < 16; ++r) { p0[r] = __builtin_amdgcn_exp2f(p0[r]); ps += p0[r]; }
#pragma unroll
            for (int r = 0; r < 16; ++r) { p1[r] = __builtin_amdgcn_exp2f(p1[r]); ps += p1[r]; }
            l += swapsum(ps);
            const bf16x8 pb[4] = {packp<0>(p0), packp<1>(p0), packp<0>(p1), packp<1>(p1)};
            pv_tile(o, pb, vl + buf * VB);
        }
        if (MODE == 1 && j + 1 < ntiles) NSA_LOAD(j + 1);
        if (j + 1 < ntiles) NSA_STORE(buf ^ 1);
        __syncthreads();
    }
#undef NSA_TROW
#undef NSA_LOAD
#undef NSA_STORE
}
__device__ __forceinline__ void nsa_topk(const LAS float* improw, LAS unsigned* selrow, int cur, int lane) {
    unsigned key[4]; bool sel[4];
    int nforced = 0;
#pragma unroll
    for (int k = 0; k < 4; ++k) { const int j = lane + 64 * k;
        const bool forced = (j == 0) || (j == cur) || (j == cur - 1);
        const bool causal = j <= cur;
        sel[k] = forced;
        key[k] = (causal && !forced) ? (__float_as_uint(improw[j]) + 1u) : 0u;
    }
    nforced = 1 + (cur >= 1 ? 1 : 0) + (cur >= 2 ? 1 : 0);
    const int want = 16 - nforced;
    for (int it = 0; it < want; ++it) {
        unsigned bk = key[0]; int bj = lane;
#pragma unroll
        for (int k = 1; k < 4; ++k) { if (key[k] > bk) { bk = key[k]; bj = lane + 64 * k; } }
        unsigned long long best = ((unsigned long long)bk << 32) | (unsigned)(0xffffffffu - (unsigned)bj);
#pragma unroll
        for (int off = 1; off < 64; off <<= 1) {
            const unsigned lo = __shfl_xor((unsigned)best, off), hiw = __shfl_xor((unsigned)(best >> 32), off);
            const unsigned long long other = ((unsigned long long)hiw << 32) | lo;
            best = other > best ? other : best; }
        if ((unsigned)(best >> 32) == 0u) break;
        const int wj = (int)(0xffffffffu - (unsigned)best);
#pragma unroll
        for (int k = 0; k < 4; ++k) if (wj == lane + 64 * k) { key[k] = 0u; sel[k] = true; }
    }
#pragma unroll
    for (int k = 0; k < 4; ++k) { const unsigned long long bm = __ballot(sel[k]);
        if (lane == 0) { selrow[2 * k] = (unsigned)bm; selrow[2 * k + 1] = (unsigned)(bm >> 32); } }
}
__device__ __forceinline__ void nsa_topk4(const LAS float* imp0, LAS unsigned* sel0, int cur, int lane) {
    unsigned key[4][4]; bool forced[4];
#pragma unroll
    for (int k = 0; k < 4; ++k) { const int j = lane + 64 * k;
        forced[k] = (j == 0) || (j == cur) || (j == cur - 1);
        const bool cand = (j <= cur) && !forced[k];
#pragma unroll
        for (int i = 0; i < 4; ++i) key[i][k] = cand ? (__float_as_uint(imp0[i * 256 + j]) + 1u) : 0u; }
    const int want = 16 - (1 + (cur >= 1 ? 1 : 0) + (cur >= 2 ? 1 : 0));
    unsigned T[4] = {0u, 0u, 0u, 0u};
    for (int bit = 30; bit >= 0; --bit) {
#pragma unroll
        for (int i = 0; i < 4; ++i) { const unsigned c = T[i] | (1u << bit);
            const int n = __builtin_popcountll(__ballot(key[i][0] >= c)) + __builtin_popcountll(__ballot(key[i][1] >= c)) + __builtin_popcountll(__ballot(key[i][2] >= c)) + __builtin_popcountll(__ballot(key[i][3] >= c));
            if (n >= want) T[i] = c; }
    }
#pragma unroll
    for (int i = 0; i < 4; ++i) {
        const unsigned Ti = T[i];
        int rem = want;
        if (Ti != 0u) rem -= __builtin_popcountll(__ballot(key[i][0] > Ti)) + __builtin_popcountll(__ballot(key[i][1] > Ti)) + __builtin_popcountll(__ballot(key[i][2] > Ti)) + __builtin_popcountll(__ballot(key[i][3] > Ti));
#pragma unroll
        for (int k = 0; k < 4; ++k) {
            bool s = forced[k];
            if (Ti == 0u) s = s || key[i][k] >= 1u;
            else {
                const bool eq = key[i][k] == Ti; const unsigned long long em = __ballot(eq);
                const int below = (int)__builtin_amdgcn_mbcnt_hi((unsigned)(em >> 32), __builtin_amdgcn_mbcnt_lo((unsigned)em, 0u));
                s = s || key[i][k] > Ti || (eq && below < rem);
                rem -= __builtin_popcountll(em); if (rem < 0) rem = 0;
            }
            const unsigned long long bm = __ballot(s);
            if (lane == 0) { sel0[i * 8 + 2 * k] = (unsigned)bm; sel0[i * 8 + 2 * k + 1] = (unsigned)(bm >> 32); }
        }
    }
}
__device__ __forceinline__ int nsa_opaque(int v) { asm volatile("" : "+v"(v)); return v; }
__device__ __forceinline__ void nsa_unit(LAS unsigned char* lds, const NsaPtrs& P, int g, int qblk, int tid_in, int wave, int lane_in, int cu) {
    int tid = tid_in; asm volatile("" : "+v"(tid));
    const int lane = tid & 63; (void)lane_in;
    const int r32 = lane & 31, hi = lane >> 5;
    const int hh = 8 * g + wave, t0 = 32 * qblk, t = t0 + r32;
    const float slope2 = __builtin_amdgcn_exp2f(-0.5f * (float)(hh + 1)) * LOG2E;
    bf16x8 q[8];
    { const bf16* qp = P.Q + (size_t)t * 2048 + hh * 128 + hi * 8;
#pragma unroll
      for (int d0 = 0; d0 < 8; ++d0) q[d0] = *(const GAS bf16x8*)(qp + d0 * 16); }
#define NSA_SCR() ((GAS f32x4*)(P.scr + ((size_t)(cu * 8 + wave) * 16) * 256) + nsa_opaque(lane))
    const size_t CH = (size_t)S * 128 * 2;
    f32x16 o[4]; float m, l;
#define NSA_ZERO_O() do { _Pragma("unroll") for (int d_ = 0; d_ < 4; ++d_) _Pragma("unroll") for (int r_ = 0; r_ < 16; ++r_) o[d_][r_] = 0.f; } while (0)
    const int ncv = 2 * qblk + 1, ntc = (ncv + 63) >> 6;
    const unsigned char* kc = (const unsigned char*)P.KC + (size_t)g * 1024 * 256; const unsigned char* vc = (const unsigned char*)P.VC + (size_t)g * 1024 * 256;
    m = -1e30f; l = 0.f; NSA_ZERO_O();
    nsa_loop<0>(lds, kc, vc, ntc, 0, q, t, slope2, m, l, o, 0.f, tid, wave, lane);
    const float invl = l > 0.f ? 1.f / l : 0.f;
    nsa_loop<1>(lds, kc, vc, ntc, 0, q, t, slope2, m, l, o, invl, tid, wave, lane);
    { const float g_c = P.G[(size_t)t * 48 + hh]; GAS f32x4* scr = NSA_SCR();
#pragma unroll
    for (int d0 = 0; d0 < 4; ++d0)
#pragma unroll
        for (int rg = 0; rg < 4; ++rg) { f32x4 v = {o[d0][4 * rg] * g_c, o[d0][4 * rg + 1] * g_c, o[d0][4 * rg + 2] * g_c, o[d0][4 * rg + 3] * g_c}; scr[(d0 * 4 + rg) * 64] = v; } }
    const int cur = t0 >> 6;
    LAS unsigned* selm = (LAS unsigned*)(lds + N_SELM);
    nsa_topk4((const LAS float*)(lds + N_IMP) + 4 * wave * 256, selm + 4 * wave * 8, cur, lane);
    __syncthreads();
    if (wave == 0) {
        LAS int* ulist = (LAS int*)(lds + N_ULIST); int n = 0;
        for (int k = 0; k < 8; ++k) { unsigned u = (lane < 32) ? selm[lane * 8 + k] : 0u;
#pragma unroll
            for (int off = 1; off < 32; off <<= 1) u |= __shfl_xor(u, off);
            u = __builtin_amdgcn_readfirstlane(u);
            while (u) { const int b = __builtin_ctz(u); u &= u - 1u; if (lane == 0) ulist[n] = 32 * k + b; ++n; } }
        if (lane == 0) *(LAS int*)(lds + N_NTS) = n;
    }
    __syncthreads();
    const int nts = __builtin_amdgcn_readfirstlane(*(const LAS int*)(lds + N_NTS));
    m = -1e30f; l = 0.f; NSA_ZERO_O();
    nsa_loop<2>(lds, (const unsigned char*)P.KV + (size_t)(4 + g) * CH, (const unsigned char*)P.KV + (size_t)(6 + g) * CH, nts, 0, q, t, slope2, m, l, o, 0.f, tid, wave, lane);
    { const float f = P.G[(size_t)t * 48 + 16 + hh] / l; GAS f32x4* scr = NSA_SCR();
#pragma unroll
      for (int d0 = 0; d0 < 4; ++d0)
          { f32x4 v[4];
#pragma unroll
            for (int rg = 0; rg < 4; ++rg) v[rg] = scr[(d0 * 4 + rg) * 64];
#pragma unroll
            for (int rg = 0; rg < 4; ++rg) { v[rg][0] += o[d0][4 * rg] * f; v[rg][1] += o[d0][4 * rg + 1] * f; v[rg][2] += o[d0][4 * rg + 2] * f; v[rg][3] += o[d0][4 * rg + 3] * f; scr[(d0 * 4 + rg) * 64] = v[rg]; } } }
    const int jlo = (t0 > 511 ? t0 - 511 : 0) >> 6, jhi = (t0 + 31) >> 6;
    m = -1e30f; l = 0.f; NSA_ZERO_O();
    nsa_loop<3>(lds, (const unsigned char*)P.KV + (size_t)(8 + g) * CH, (const unsigned char*)P.KV + (size_t)(10 + g) * CH, jhi - jlo + 1, jlo, q, t, slope2, m, l, o, 0.f, tid, wave, lane);
    { const float f = P.G[(size_t)t * 48 + 32 + hh] / l; GAS f32x4* scr = NSA_SCR();
      const bf16* zp = P.Z + (size_t)t * 2048 + hh * 128 + 4 * hi;
      bf16* op = P.O + (size_t)t * 4096 + 2048 + hh * 128 + 4 * hi;
#pragma unroll
      for (int d0 = 0; d0 < 4; ++d0)
          { f32x4 av[4]; u32x2 zv[4];
#pragma unroll
            for (int rg = 0; rg < 4; ++rg) { av[rg] = scr[(d0 * 4 + rg) * 64]; zv[rg] = *(const GAS u32x2*)(zp + 32 * d0 + 8 * rg); }
#pragma unroll
          for (int rg = 0; rg < 4; ++rg) { const int dim = 32 * d0 + 8 * rg; const f32x4 a = av[rg];
              const u32x2 z = zv[rg];
              u32x2 w; w.x = pk2((a[0] + o[d0][4 * rg] * f) * bflo(z.x), (a[1] + o[d0][4 * rg + 1] * f) * bfhi(z.x)); w.y = pk2((a[2] + o[d0][4 * rg + 2] * f) * bflo(z.y), (a[3] + o[d0][4 * rg + 3] * f) * bfhi(z.y));
              *(GAS u32x2*)(op + dim) = w; } } }
#undef NSA_ZERO_O
#undef NSA_SCR
}
struct CmpPtrs { const bf16* KV; const bf16* W1; const bf16* W2; const float* cbp; bf16* KC; bf16* VC; };
__device__ __forceinline__ void cmp_unit(LAS unsigned char* lds, const CmpPtrs& P, int kv, int g, int tile, int tid, int wave, int lane) {
    const int fr = lane & 15, fq = lane >> 4;
    constexpr int CRS = 544;
    LAS unsigned char* As = lds + 16384;
    LAS unsigned char* Ws = As + 16 * CRS;
    const unsigned char* Ag = (const unsigned char*)(P.KV + (size_t)(kv * 2 + g) * ((size_t)S * 128) + (size_t)(16 * tile + (tid >> 5)) * 2048) + (tid & 31) * 16;
    const unsigned char* Wg = (const unsigned char*)(P.W1 + (size_t)kv * 128 * 4096 + (size_t)(tid >> 5) * 4096) + (tid & 31) * 16;
    LAS unsigned char* Ad = As + (tid >> 5) * CRS + (tid & 31) * 16;
    LAS unsigned char* Wd = Ws + (tid >> 5) * CRS + (tid & 31) * 16;
    const LAS unsigned char* Ar = As + fr * CRS + fq * 16;
    const LAS unsigned char* Wr = Ws + (16 * wave + fr) * CRS + fq * 16;
    u32x4 ra, rw[8];
#define CMP_LOAD(c) do { ra = *(const GAS u32x4*)(Ag + (c) * 512); _Pragma("unroll") for (int i_ = 0; i_ < 8; ++i_) rw[i_] = *(const GAS u32x4*)(Wg + (size_t)i_ * (16 * 8192) + (c) * 512); } while (0)
    CMP_LOAD(0);
    f32x4 acc = {0.f, 0.f, 0.f, 0.f};
    for (int c = 0; c < 16; ++c) {
        *(LAS u32x4*)Ad = ra;
#pragma unroll
        for (int i = 0; i < 8; ++i) *(LAS u32x4*)(Wd + i * 16 * CRS) = rw[i];
        __syncthreads();
        if (c + 1 < 16) CMP_LOAD(c + 1);
#pragma unroll
        for (int s = 0; s < 8; ++s) {
            const bf16x8 a = *(const LAS bf16x8*)(Ar + 64 * s), b = *(const LAS bf16x8*)(Wr + 64 * s);
            acc = __builtin_amdgcn_mfma_f32_16x16x32_bf16(a, b, acc, 0, 0, 0);
        }
        __syncthreads();
    }
#undef CMP_LOAD
    float bias = 0.f;
    { float bv[16];
#pragma unroll
      for (int c = 0; c < 16; ++c) bv[c] = *(const GAS float*)(P.cbp + (size_t)(kv * 16 + c) * 128 + 16 * wave + fr);
#pragma unroll
      for (int c = 0; c < 16; ++c) bias += bv[c]; }
    LAS bf16* hid = (LAS bf16*)lds;
#pragma unroll
    for (int i = 0; i < 4; ++i) hid[(4 * fq + i) * 136 + 16 * wave + fr] = (bf16)(pk2(silu_f(acc[i] + bias), 0.f) & 0xffffu);
    __syncthreads();
    const bf16* B2 = P.W2 + (size_t)kv * 128 * 128 + (size_t)(16 * wave + fr) * 128 + 8 * fq;
    f32x4 acc2 = {0.f, 0.f, 0.f, 0.f};
#pragma unroll
    for (int s = 0; s < 4; ++s) {
        const bf16x8 a = *(const LAS bf16x8*)(hid + fr * 136 + 32 * s + 8 * fq), b = *(const GAS bf16x8*)(B2 + 32 * s);
        acc2 = __builtin_amdgcn_mfma_f32_16x16x32_bf16(a, b, acc2, 0, 0, 0);
    }
    bf16* out = (kv ? P.VC : P.KC) + (size_t)g * 1024 * 128;
#pragma unroll
    for (int i = 0; i < 4; ++i) { const int nn = 16 * tile + 4 * fq + i; out[(size_t)nn * 128 + 16 * wave + fr] = (nn < 1023) ? (bf16)(pk2(acc2[i], 0.f) & 0xffffu) : (bf16)0; }
    __syncthreads();
}
}
constexpr int PPL = 6;
constexpr int N_PHASES = 2 + PPL * DEPTH;
struct Args { const void* in[16]; float* out; unsigned char* ws; int ph_lo, ph_hi; };
#define WSP(T, off) ((T*)(ws + (off)))
#define VCU() ((gridDim.x % 8 == 0) ? (int)((blockIdx.x % 8) * (gridDim.x / 8) + blockIdx.x / 8) : (int)blockIdx.x)
__global__ void __launch_bounds__(NTHR, 2) mk_fwd(const Args args) {
    extern __shared__ __attribute__((aligned(16))) unsigned char lds_raw[];
    LAS unsigned char* lds = (LAS unsigned char*)lds_raw;
    if (threadIdx.x < 32) ((volatile LAS unsigned*)(lds + MISC_OFF))[threadIdx.x] = 0u;
    __syncthreads();
    XcdBarrier bar = xcd_barrier_post((unsigned*)(args.ws + WS_CTL) + CW_BAR, (volatile LAS unsigned*)(lds + MISC_OFF) + 8);
#define IN(k) (args.ph_lo <= (k) && (k) < args.ph_hi)
#define SEAM(k) do { if (IN(k) && IN((k) + 1)) xcd_barrier(bar); } while (0)
#define PHASE_REGS int tid_ = threadIdx.x; asm volatile("" : "+v"(tid_)); const int tid = tid_, lane = tid & 63, wave = __builtin_amdgcn_readfirstlane(tid >> 6); \
    unsigned char* ws = args.ws; asm volatile("" : "+s"(ws)); (void)tid; (void)lane; (void)wave

    if (IN(0)) {
        PHASE_REGS; const int G = gridDim.x, vcu = VCU();
        p0_mod_gemv((const float*)args.in[1], (const float*)args.in[3], (const float*)args.in[4], WSP(float, WS_MOD), (LAS float*)lds, vcu, G);
        p0_cmpbias((const float*)args.in[10], (const float*)args.in[11], WSP(float, WS_CBP), (LAS float*)lds, (vcu + G / 2) % G, G);
        p0_rope((const int*)args.in[2], WSP(float, WS_ROPE), WSP(float, WS_ROPE) + (size_t)S * 32, vcu * NTHR + tid, G * NTHR);
        const P0In I{(const float*)args.in[5], (const float*)args.in[6], (const float*)args.in[7], (const float*)args.in[8], (const float*)args.in[9], (const float*)args.in[11], (const float*)args.in[12], (const float*)args.in[13]};
        p0_convert(I, ws, vcu * NWAVES + wave, G * NWAVES, lane);
    }
    SEAM(0);
#define H8PTR WSP(unsigned char, WS_H8)
    if (IN(1)) { PHASE_REGS; modulate_rows((const float*)args.in[0], WSP(bf16, WS_H), H8PTR, WSP(float, WS_MOD), VCU() * NWAVES + wave, gridDim.x * NWAVES, lane);
    }
    SEAM(1);
    for (int l = 0; l < DEPTH; ++l) {
        const int pb = 2 + PPL * l;
        if (IN(pb + 0)) {
            PHASE_REGS;
            { pg8::Gemm gg{WSP(bf16, WS_H), (const bf16*)(ws + WS_W + (size_t)l * W_LSTRIDE + W_IN), S, 23 * 256, D}; pg8::InBf16Order SO; SO.init(S, 23 * 256, gridDim.x, blockIdx.x);
              const pg8::EpiIn E{ws, 0};
              pg8::gemm_phase<pg8::EpiIn, pg8::InBf16Order, true, true>(lds, gg, SO, E);
            }
            { pg8::Gemm gg{(const bf16*)(ws + WS_H8), (const bf16*)(ws + WS_WIN8 + (size_t)l * WIN8_LSTRIDE), S, 13 * 256, D / 2}; pg8::StaticOrder SO; SO.init(S, 13 * 256, gridDim.x, (blockIdx.x + 64) % gridDim.x);
              const pg8::EpiIn E{ws, 1};
              pg8::gemm_phase<pg8::EpiIn, pg8::StaticOrder, true, true, 0x79797979, 0x7f7f7f7f>(lds, gg, SO, E);
            }
        }
        SEAM(pb + 0);
        if (IN(pb + 1)) {
            PHASE_REGS; const int G = gridDim.x, vcu = VCU();
            rstd_rows(WSP(float, WS_RSQQ), WSP(float, WS_RSQKV), WSP(float, WS_RSTD), WSP(float, WS_RSTD) + S, vcu * NTHR + tid, G * NTHR);
            const att::CmpPtrs CP{WSP(bf16, WS_KVNSA), (const bf16*)(ws + WS_W + (size_t)l * W_LSTRIDE + W_C1), (const bf16*)(ws + WS_W + (size_t)l * W_LSTRIDE + W_C2),
                                  WSP(float, WS_CBP) + (size_t)l * 2 * 16 * 128, WSP(bf16, WS_KCMP), WSP(bf16, WS_VCMP)};
            for (int u = vcu; u < 256; u += G) att::cmp_unit(lds, CP, u & 1, (u >> 1) & 1, u >> 2, tid, wave, lane);
        }
        SEAM(pb + 1);
        if (IN(pb + 2)) {
            PHASE_REGS;
            { pg8::Gemm gg{WSP(bf16, WS_QLAT), (const bf16*)(ws + WS_W + (size_t)l * W_LSTRIDE + W_QUP), S, 3072, 384}; pg8::StaticOrder SO; SO.init(S, 3072, gridDim.x, blockIdx.x);
              const pg8::EpiQup E{ws};
              pg8::gemm_phase<pg8::EpiQup, pg8::StaticOrder, true, true, 0x7a7a7a7a, 0x7f7f7f7f>(lds, gg, SO, E);
            }
            { pg8::Gemm gg{WSP(bf16, WS_KVLAT), (const bf16*)(ws + WS_W + (size_t)l * W_LSTRIDE + W_KVUP), S, 2048, 256}; pg8::StaticOrder SO; SO.init(S, 2048, gridDim.x, blockIdx.x);
              const pg8::EpiKup E{ws};
              pg8::gemm_phase<pg8::EpiKup, pg8::StaticOrder, true, true, 0x7a7a7a7a, 0x7f7f7f7f>(lds, gg, SO, E);
            }
            { pg8::Gemm gg{(const bf16*)(ws + WS_W + (size_t)l * W_LSTRIDE + W_KVUP + (size_t)2048 * 512), WSP(bf16, WS_KVLAT), 2048, S, 256}; pg8::StaticOrder SO; SO.init(2048, S, gridDim.x, blockIdx.x);
              const pg8::EpiVt E{ws};
              pg8::gemm_phase<pg8::EpiVt, pg8::StaticOrder, true, true, 0x7f7f7f7f, 0x7a7a7a7a>(lds, gg, SO, E);
            }
        }
        SEAM(pb + 2);
        if (IN(pb + 3)) {
            PHASE_REGS; const int G = gridDim.x, vcu = VCU();
            { const att::MlaPtrs MP{WSP(bf16, WS_QMLA), WSP(bf16, WS_KMLA), WSP(bf16, WS_VMLA), WSP(bf16, WS_ZMLA), WSP(bf16, WS_H)};
              for (int pu = vcu; pu < 512; pu += G) { const int head = pu >> 5, pr = pu & 31;
                  att::mla_unit(lds, MP, head, 63 - pr, tid, wave, lane);
                  att::mla_unit(lds, MP, head, pr, tid, wave, lane);
              }
            }
            { const att::NsaPtrs NP{WSP(bf16, WS_QNSA), WSP(bf16, WS_KVNSA), WSP(bf16, WS_KCMP), WSP(bf16, WS_VCMP), WSP(bf16, WS_ZNSA), WSP(float, WS_GNSA), WSP(bf16, WS_H), WSP(float, WS_OSCR)};
              for (int u = vcu; u < 1024; u += G) { const int v_ = (u >> 1) & 127, k_ = u >> 8;
                  att::nsa_unit(lds, NP, u & 1, (k_ & 1) ? 128 * k_ + 127 - v_ : 128 * k_ + v_, tid, wave, lane, blockIdx.x); }
            }
        }
        SEAM(pb + 3);
        if (IN(pb + 4)) {
            PHASE_REGS;
            pg8::StaticOrder SO; SO.init(S, D, gridDim.x, blockIdx.x);
            const pg8::EpiOut E{WSP(bf16, WS_Y), WSP(const float, WS_MOD) + (size_t)l * 3 * D + 2 * D};
            const pg8::GemmMix gm{ws + WS_H, ws + WS_W + (size_t)l * W_LSTRIDE + W_OUT, D, 1024, 2048, 2048, S, D};
            pg8::gemm_phase_mix<pg8::EpiOut, pg8::StaticOrder, 0x78787878, 0x7b7b7b7b>(lds, gm, SO, E);
        }
        SEAM(pb + 4);
        if (IN(pb + 5)) {
            PHASE_REGS;
            if (l == 0) ln_rows<false, true>(args.in[0], WSP(const bf16, WS_Y), WSP(void, WS_XV), WSP(bf16, WS_H), H8PTR, (const float*)args.in[14], (const float*)args.in[15],
                    WSP(const float, WS_MOD) + (size_t)3 * D, (LAS float*)lds, tid, VCU() * NWAVES + wave, gridDim.x * NWAVES, lane);
            else ln_rows<true, false>(WSP(const void, WS_XV), WSP(const bf16, WS_Y), args.out, nullptr, nullptr, (const float*)args.in[14] + (size_t)l * D, (const float*)args.in[15] + (size_t)l * D,
                    WSP(const float, WS_MOD) + (size_t)(l + 1) * 3 * D, (LAS float*)lds, tid, VCU() * NWAVES + wave, gridDim.x * NWAVES, lane);
        }
        SEAM(pb + 5);
    }
#undef IN
#undef SEAM
}


#ifndef MK_PER_PHASE
#define MK_PER_PHASE 0
#endif
extern "C" void kernel_launch(void* const* d_in, const int* in_sizes, int n_in, void* d_out, int out_size, void* d_ws, size_t ws_size, hipStream_t stream) {
    static int grid = 0;
    if (grid == 0) {
        if (n_in != 16 || out_size != S * D || ws_size < WS_END) { fprintf(stderr, "kernel_launch: unexpected shapes n_in %d out %d ws %zu\n", n_in, out_size, ws_size); grid = -1; return; }
        int dev = 0, cus = 0;
        if (hipGetDevice(&dev) != hipSuccess || hipDeviceGetAttribute(&cus, hipDeviceAttributeMultiprocessorCount, dev) != hipSuccess) { grid = -1; return; }
        if (hipFuncSetAttribute((const void*)mk_fwd, hipFuncAttributeMaxDynamicSharedMemorySize, LDS_BYTES) != hipSuccess) { grid = -1; return; }
        int per_cu = 0;
        (void)hipOccupancyMaxActiveBlocksPerMultiprocessor(&per_cu, (const void*)mk_fwd, NTHR, LDS_BYTES);
        (void)hipGetLastError();
        if (per_cu < 1) fprintf(stderr, "kernel_launch: occupancy query says %d\n", per_cu);
        grid = cus;
    }
    if (grid < 0) return;
    (void)hipMemsetAsync((char*)d_ws + WS_CTL, 0, CTL_ZERO_BYTES, stream);
    Args a{};
    for (int i = 0; i < 16; ++i) a.in[i] = d_in[i];
    a.out = (float*)d_out; a.ws = (unsigned char*)d_ws;
    a.ph_lo = 0; a.ph_hi = N_PHASES;
    hipLaunchKernelGGL(mk_fwd, dim3(grid), dim3(NTHR), LDS_BYTES, stream, a);
}
```

```cpp
#include <hip/hip_runtime.h>
#define MLA_FP8 1
#define MLA_FP8V 1
#define MLA_MXU 1
#define MLA_MXL 1
#define MLA_MX 1
#define OUT_F8 1
#define YBF16 1
#define GEMM_F8 1
#include <cstdio>
#include <cstdint>

#define GAS __attribute__((address_space(1)))
#define LAS __attribute__((address_space(3)))
typedef unsigned short bf16;
typedef float f32x4 __attribute__((ext_vector_type(4)));
typedef float f32x2 __attribute__((ext_vector_type(2)));
typedef float f32x8 __attribute__((ext_vector_type(8)));
typedef float f32x16 __attribute__((ext_vector_type(16)));
typedef unsigned u32x4 __attribute__((ext_vector_type(4)));
typedef unsigned u32x2 __attribute__((ext_vector_type(2)));
typedef short bf16x8 __attribute__((ext_vector_type(8)));
typedef short s16x4 __attribute__((ext_vector_type(4)));
typedef __bf16 bf16x2v __attribute__((ext_vector_type(2)));
typedef __bf16 bf16x8v __attribute__((ext_vector_type(8)));
typedef GAS unsigned gu32;

constexpr int S = 16384, D = 4096, DEPTH = 2;
constexpr int INC = 9072, NIN = 9216;
constexpr float LN_EPS = 1e-5f, RMS_EPS = 1e-6f;
constexpr float DN_ALPHA = 1.41421356237309515f;
constexpr float LOG2E = 1.4426950408889634f;
constexpr float QS_MLA = 0.07216878364870322f * LOG2E;
constexpr float QS_NSA = 0.08838834764831845f * LOG2E;
constexpr int NWAVES = 8, NTHR = 512;
constexpr size_t MiB = 1u << 20;
constexpr size_t WS_CTL = 0, CTL_ZERO_BYTES = 1 * MiB;
constexpr size_t WS_MOD = 1 * MiB;
constexpr size_t WS_ROPE = 2 * MiB;
constexpr size_t WS_CBP = 6 * MiB;
constexpr size_t WS_RSQQ = 7 * MiB;
constexpr size_t WS_RSQKV = 9 * MiB;
constexpr size_t WS_RSTD = 6 * MiB + 512 * 1024;
constexpr size_t WS_GNSA = 10 * MiB;
constexpr size_t WS_KCMP = 13 * MiB;
constexpr size_t WS_VCMP = 13 * MiB + 512 * 1024;
constexpr size_t WS_W = 16 * MiB, W_LSTRIDE = 120 * MiB;
constexpr size_t W_IN = 0, W_QUP = 72 * MiB, W_KVUP = 77 * MiB, W_OUT = 81 * MiB, W_C1 = 113 * MiB, W_C2 = 115 * MiB;
constexpr size_t WS_H = 256 * MiB;
constexpr size_t WS_XV = 384 * MiB;
constexpr size_t WS_QLAT = 640 * MiB, WS_KVLAT = 664 * MiB;
constexpr size_t WS_QMLA = 680 * MiB, WS_KMLA = 728 * MiB, WS_VMLA = 872 * MiB, WS_ZMLA = 936 * MiB, WS_ZNSA = 1000 * MiB, WS_QNSA = 1064 * MiB;
constexpr size_t WS_Y = 936 * MiB;
constexpr size_t WS_H8 = 776 * MiB;
constexpr size_t WS_WIN8 = 840 * MiB, WIN8_LSTRIDE = 13 * MiB;
constexpr size_t WS_KVNSA = 1128 * MiB;
constexpr size_t WS_OSCR = 1178 * MiB;
constexpr size_t WS_END = 1242 * MiB;
constexpr int CW_BAR = 4096;
constexpr int CW_NSAQ = 16384;
constexpr int LDS_BYTES = 147456;
constexpr int MISC_OFF = LDS_BYTES - 128;

__device__ __forceinline__ unsigned pk2(float lo, float hi) { f32x2 a = {lo, hi}; return __builtin_bit_cast(unsigned, __builtin_convertvector(a, bf16x2v)); }
__device__ __forceinline__ u32x4 pk8(f32x4 a, f32x4 b) { u32x4 w; w.x = pk2(a[0], a[1]); w.y = pk2(a[2], a[3]); w.z = pk2(b[0], b[1]); w.w = pk2(b[2], b[3]); return w; }
__device__ __forceinline__ float bflo(unsigned u) { return __uint_as_float(u << 16); }
__device__ __forceinline__ float bfhi(unsigned u) { return __uint_as_float(u & 0xffff0000u); }
__device__ __forceinline__ float wave_sum(float v) {
#pragma unroll
    for (int o = 1; o < 64; o <<= 1) v += __shfl_xor(v, o);
    return v;
}
__device__ __forceinline__ float silu_f(float v) { return v * __builtin_amdgcn_rcpf(1.f + __expf(-v)); }
__device__ __forceinline__ float sigm_f(float v) { return __builtin_amdgcn_rcpf(1.f + __expf(-v)); }

#define XB_TMO      128
#define XB_XCNT(j)  (256  + 64 * (j))
#define XB_XSUB(j)  (1280 + 64 * (j))
#define XB_XGEN(j)  (2304 + 64 * (j))
#define XB_TOP      3328
#define XB_TOPGEN   3392
#define XCD_BAR_WORDS 3456
#define XB_SPIN_CAP (1u << 18)
__device__ __forceinline__ unsigned xb_ld(unsigned* p)              { return __hip_atomic_load(p, __ATOMIC_RELAXED, __HIP_MEMORY_SCOPE_AGENT); }
__device__ __forceinline__ unsigned xb_add(unsigned* p, unsigned v) { return __hip_atomic_fetch_add(p, v, __ATOMIC_RELAXED, __HIP_MEMORY_SCOPE_AGENT); }
__device__ __forceinline__ unsigned xb_xcc_id() { return (unsigned)__builtin_amdgcn_s_getreg((3 << 11) | 20) & 0xFu; }
#define XB_SPIN(cond, bar) do { unsigned _sp = 0; while (cond) { __builtin_amdgcn_s_sleep(1); \
    if ((++_sp & 255u) == 0u) { if (xb_ld(&(bar)[XB_TMO])) break; if (_sp > XB_SPIN_CAP) { atomicAdd(&(bar)[XB_TMO], 1u); break; } } } } while (0)
struct XcdBarrier { unsigned* bar; unsigned x; volatile LAS unsigned* st; };
__device__ __forceinline__ XcdBarrier xcd_barrier_post(unsigned* bar, volatile LAS unsigned* st) {
    XcdBarrier b; b.bar = bar; b.x = xb_xcc_id(); b.st = st;
    if (threadIdx.x == 0) (void)xb_add(&bar[XB_XCNT(b.x)], 1u);
    return b;
}
__device__ __forceinline__ void xcd_barrier_complete(unsigned* bar, unsigned x, unsigned& nloc, unsigned& nx) {
    const unsigned G = gridDim.x * gridDim.y * gridDim.z;
    unsigned sum, cnt, mine, sp = 0u;
    for (;;) {
        sum = 0u; cnt = 0u; mine = 0u;
#pragma unroll
        for (unsigned j = 0; j < 16; ++j) { const unsigned c = xb_ld(&bar[XB_XCNT(j)]); sum += c; cnt += (c > 0u) ? 1u : 0u; mine = (j == x) ? c : mine; }
        if (sum == G) break;
        __builtin_amdgcn_s_sleep(1);
        if ((++sp & 255u) == 0u) { if (xb_ld(&bar[XB_TMO])) break; if (sp > XB_SPIN_CAP) { atomicAdd(&bar[XB_TMO], 1u); break; } }
    }
    nloc = mine > 0u ? mine : 1u; nx = cnt > 0u ? cnt : 1u;
}
__device__ __forceinline__ void xcd_barrier(const XcdBarrier& b) {
    asm volatile("s_waitcnt vmcnt(0)" ::: "memory");
    __syncthreads();
    if (threadIdx.x == 0) {
        unsigned* bar = b.bar;
        __builtin_amdgcn_s_waitcnt(0);
        unsigned nloc = b.st[0], nx = b.st[1];
        if (nloc == 0u) { xcd_barrier_complete(bar, b.x, nloc, nx); b.st[0] = nloc; b.st[1] = nx; }
        const unsigned old = xb_add(&bar[XB_XSUB(b.x)], 1u);
        const unsigned gen = old / nloc;
        if (old + 1u == (gen + 1u) * nloc) {
            __builtin_amdgcn_fence(__ATOMIC_RELEASE, "agent");
            asm volatile("s_waitcnt vmcnt(0)" ::: "memory");
            const unsigned og = xb_add(&bar[XB_TOP], 1u);
            const unsigned tg = og / nx;
            if (og + 1u == (tg + 1u) * nx) xb_add(&bar[XB_TOPGEN], 1u);
            else XB_SPIN(xb_ld(&bar[XB_TOPGEN]) == tg, bar);
            __builtin_amdgcn_fence(__ATOMIC_ACQUIRE, "agent");
            xb_add(&bar[XB_XGEN(b.x)], 1u);
            asm volatile("s_waitcnt vmcnt(0)" ::: "memory");
        } else {
            XB_SPIN(xb_ld(&bar[XB_XGEN(b.x)]) == gen, bar);
            __builtin_amdgcn_fence(__ATOMIC_ACQUIRE, "agent");
            asm volatile("s_waitcnt vmcnt(0)" ::: "memory");
        }
    }
    __syncthreads();
}
__device__ __forceinline__ void p0_mod_gemv(const float* c, const float* w_ada, const float* b_ada, float* mod, LAS float* lds, int vcu, int G) {
    const int tid = threadIdx.x;
    LAS float* sc = lds;
    LAS float* red = lds + 4096;
    for (int k = tid; k < D; k += NTHR) sc[k] = silu_f(c[k]);
    __syncthreads();
    const int cl = tid & 7, kl = tid >> 3;
    constexpr int NU = DEPTH * 3 * D / 32;
#define GV_W(u_) (w_ada + (size_t)((u_) / (3 * D / 32)) * D * (3 * D) + ((u_) % (3 * D / 32)) * 32 + cl * 4)
#define GV_LD(W_, i_) __builtin_nontemporal_load((const GAS f32x4*)((W_) + (size_t)(kl + 64 * (i_)) * (3 * D)))
    f32x4 w[16];
    if (vcu < NU) { const float* W0 = GV_W(vcu);
#pragma unroll
        for (int i = 0; i < 16; ++i) w[i] = GV_LD(W0, i); }
    for (int u = vcu; u < NU; u += G) {
        const int l = u / (3 * D / 32), n0 = (u % (3 * D / 32)) * 32;
        const float* W = GV_W(u);
        f32x4 acc = {0.f, 0.f, 0.f, 0.f};
#pragma unroll
        for (int i = 0; i < 48; ++i) { acc += w[i & 15] * sc[kl + 64 * i]; w[i & 15] = GV_LD(W, i + 16); }
        if (u + G < NU) { const float* Wn = GV_W(u + G);
#pragma unroll
            for (int i = 48; i < 64; ++i) { acc += w[i & 15] * sc[kl + 64 * i]; w[i & 15] = GV_LD(Wn, i - 48); }
        } else {
#pragma unroll
            for (int i = 48; i < 64; ++i) acc += w[i & 15] * sc[kl + 64 * i];
        }
        red[kl * 33 + cl * 4 + 0] = acc[0]; red[kl * 33 + cl * 4 + 1] = acc[1]; red[kl * 33 + cl * 4 + 2] = acc[2]; red[kl * 33 + cl * 4 + 3] = acc[3];
        __syncthreads();
        if (tid < 32) { float s = 0.f; for (int j = 0; j < 64; ++j) s += red[j * 33 + tid]; mod[(size_t)l * 3 * D + n0 + tid] = s + b_ada[(size_t)l * 3 * D + n0 + tid]; }
        __syncthreads();
    }
#undef GV_W
#undef GV_LD
}
__device__ __forceinline__ int map_in(int n) {
    if (n < 1280) return n;
    if (n < 1344) { const int i = n - 1280; return 1280 + 2 * (i & 31) + (i >> 5); }
    if (n < 3392) return 1536 + (n - 1344);
    if (n < 5440) return 3584 + (n - 3392);
    if (n < 6976) return 5632 + (n - 5440);
    if (n < 7024) return 1344 + (n - 6976);
    return 7168 + (n - 7024);
}
__device__ __forceinline__ int map_kvup(int n) { const int h = n >> 8, d = n & 255; return d < 128 ? h * 128 + d : 2048 + h * 128 + (d - 128); }
__device__ __forceinline__ int map_qup(int n) { const int h = n / 192, d = n - h * 192; if (d < 128) return h * 128 + d; const int i = d - 128; return 2048 + h * 64 + 2 * (i & 31) + (i >> 5); }
template <int MAP>
__device__ __forceinline__ void tr_item8(const float* W, int K, int N, unsigned char* WT, const float* kscale, float sc, int kb, int nb, int lane) {
    const int k0 = 64 * kb, n = 64 * nb + lane;
    if (n >= N) return;
    const GAS float* src = (const GAS float*)(W + (size_t)k0 * N + n);
    float v[64];
#pragma unroll
    for (int i = 0; i < 64; ++i) v[i] = __builtin_nontemporal_load(&src[(size_t)i * N]) * sc;
    if (kscale) {
#pragma unroll
        for (int i = 0; i < 64; ++i) v[i] *= kscale[k0 + i];
    }
    const int row = MAP == 4 ? (n < 1280 ? n : 1280 + (n - 1344)) : (MAP == 2 ? map_qup(n) : (MAP == 3 ? map_kvup(n) : n));
    GAS u32x4* dst = (GAS u32x4*)(WT + (size_t)row * K + k0);
#pragma unroll
    for (int c = 0; c < 4; ++c) { u32x4 o;
        int w = __builtin_amdgcn_cvt_pk_fp8_f32(v[16 * c + 0], v[16 * c + 1], 0, false); o.x = (unsigned)__builtin_amdgcn_cvt_pk_fp8_f32(v[16 * c + 2], v[16 * c + 3], w, true);
        w = __builtin_amdgcn_cvt_pk_fp8_f32(v[16 * c + 4], v[16 * c + 5], 0, false); o.y = (unsigned)__builtin_amdgcn_cvt_pk_fp8_f32(v[16 * c + 6], v[16 * c + 7], w, true);
        w = __builtin_amdgcn_cvt_pk_fp8_f32(v[16 * c + 8], v[16 * c + 9], 0, false); o.z = (unsigned)__builtin_amdgcn_cvt_pk_fp8_f32(v[16 * c + 10], v[16 * c + 11], w, true);
        w = __builtin_amdgcn_cvt_pk_fp8_f32(v[16 * c + 12], v[16 * c + 13], 0, false); o.w = (unsigned)__builtin_amdgcn_cvt_pk_fp8_f32(v[16 * c + 14], v[16 * c + 15], w, true);
        dst[c] = o; }
}
template <int MAP>
__device__ __forceinline__ void tr_item(const float* W, int K, int N, bf16* WT, const float* kscale, int kb, int nb, int lane) {
    const int k0 = 64 * kb, n = 64 * nb + lane;
    if (n >= N) return;
    const GAS float* src = (const GAS float*)(W + (size_t)k0 * N + n);
    float v[64];
#pragma unroll
    for (int i = 0; i < 64; ++i) v[i] = __builtin_nontemporal_load(&src[(size_t)i * N]);
    if (kscale) {
#pragma unroll
        for (int i = 0; i < 64; ++i) v[i] *= kscale[k0 + i];
    }
    const int row = MAP == 1 ? map_in(n) : (MAP == 2 ? map_qup(n) : (MAP == 3 ? map_kvup(n) : n));
    GAS u32x4* dst = (GAS u32x4*)(WT + (size_t)row * K + k0);
#pragma unroll
    for (int c = 0; c < 8; ++c) { u32x4 o; o.x = pk2(v[8 * c], v[8 * c + 1]); o.y = pk2(v[8 * c + 2], v[8 * c + 3]); o.z = pk2(v[8 * c + 4], v[8 * c + 5]); o.w = pk2(v[8 * c + 6], v[8 * c + 7]); dst[c] = o; }
}
struct P0In { const float *w_in, *q_norm, *w_q_up, *kv_norm, *w_kv_up, *w_cmp1, *w_cmp2, *w_out; };
__device__ __forceinline__ void p0_convert(const P0In& I, unsigned char* ws, int gw, int NGW, int lane) {
    constexpr int T_IN = 64 * 142, T_QUP = 12 * 48, T_KVUP = 8 * 64, T_OUT = 64 * 64, T_C1 = 2 * 64 * 2, T_C2 = 2 * 2 * 2;
    constexpr int TL = T_IN + T_QUP + T_KVUP + T_OUT + T_C1 + T_C2;
    for (int it = gw; it < DEPTH * TL; it += NGW) {
        const int l = it / TL; int r = it - l * TL;
        unsigned char* wl = ws + WS_W + (size_t)l * W_LSTRIDE;
        if (r < T_IN) { const int t_ = r >> 3, nb = t_ % 142, kb = (t_ / 142) * 8 + (r & 7);
            if (nb < 20 || (nb >= 21 && nb < 53)) tr_item8<4>(I.w_in + (size_t)l * D * INC, D, INC, ws + WS_WIN8 + (size_t)l * WIN8_LSTRIDE, nullptr, 64.f, kb, nb, lane);
            else tr_item<1>(I.w_in + (size_t)l * D * INC, D, INC, (bf16*)(wl + W_IN), nullptr, kb, nb, lane);
            continue; } r -= T_IN;
        if (r < T_QUP) { tr_item8<2>(I.w_q_up + (size_t)l * 768 * 3072, 768, 3072, wl + W_QUP, I.q_norm + l * 768, 32.f, r / 48, r % 48, lane); continue; } r -= T_QUP;
        if (r < T_KVUP) { tr_item8<3>(I.w_kv_up + (size_t)l * 512 * 4096, 512, 4096, wl + W_KVUP, I.kv_norm + l * 512, 32.f, r / 64, r % 64, lane); continue; }
        r -= T_KVUP;
        if (r < T_OUT) { const int t_ = r >> 3, kb = (t_ / 64) * 8 + (r & 7), nb = t_ % 64;
            if (kb < 32) tr_item8<0>(I.w_out + (size_t)l * D * D, 8192, D, wl + W_OUT, nullptr, 128.f, kb, nb, lane);
            else
            tr_item<0>(I.w_out + (size_t)l * D * D, D, D, (bf16*)(wl + W_OUT), nullptr, kb, nb, lane);
            continue; } r -= T_OUT;
        if (r < T_C1) { const int kv = r / 128, rr = r % 128; tr_item<0>(I.w_cmp1 + (size_t)(l * 2 + kv) * 4096 * 128, 4096, 128, (bf16*)(wl + W_C1) + (size_t)kv * 128 * 4096, nullptr, rr / 2, rr % 2, lane); continue; } r -= T_C1;
        { const int kv = r / 4, rr = r % 4; tr_item<0>(I.w_cmp2 + (size_t)(l * 2 + kv) * 128 * 128, 128, 128, (bf16*)(wl + W_C2) + (size_t)kv * 128 * 128, nullptr, rr / 2, rr % 2, lane); }
    }
}
__device__ __forceinline__ void p0_rope(const int* positions, float* cosT, float* sinT, int gtid, int NT) {
    for (int e = gtid; e < S * 32; e += NT) { const int s = e >> 5, i = e & 31;
        const float inv = (float)exp(-(double)i * (1.0 / 32.0) * 9.210340371976184);
        const float ang = (float)positions[s] * inv;
        cosT[e] = (float)cos((double)ang); sinT[e] = (float)sin((double)ang); }
}
__device__ __forceinline__ void p0_cmpbias(const float* cmp_pos, const float* w_cmp1, float* cbp, LAS float* red, int vcu, int G) {
    const int tid = threadIdx.x, n = tid & 127, kq = tid >> 7;
    for (int u = vcu; u < 64; u += G) {
        const int lk = u >> 4, ch = u & 15;
        const float* P = cmp_pos + (size_t)lk * 4096 + 256 * ch; const float* W = w_cmp1 + (size_t)lk * 4096 * 128 + (size_t)(256 * ch) * 128 + n;
        float a = 0.f;
#pragma unroll 32
        for (int i = 0; i < 64; ++i) { const int k = kq + 4 * i; a += P[k] * *(const GAS float*)(W + (size_t)k * 128); }
        red[kq * 128 + n] = a;
        __syncthreads();
        if (tid < 128) cbp[(size_t)u * 128 + tid] = (red[tid] + red[128 + tid]) + (red[256 + tid] + red[384 + tid]);
        __syncthreads();
    }
}
__device__ __forceinline__ unsigned pk4_fp8(f32x4 h) { const int w = __builtin_amdgcn_cvt_pk_fp8_f32(h[0], h[1], 0, false); return (unsigned)__builtin_amdgcn_cvt_pk_fp8_f32(h[2], h[3], w, true); }
__device__ __forceinline__ void modulate_rows(const float* x, bf16* hout, unsigned char* h8, const float* modl, LAS float* par, int tid, int gw, int NGW, int lane) {
    {
#pragma unroll
      for (int i = 0; i < 2; ++i) { const int e = tid + 512 * i;
          *((LAS f32x4*)par + e) = *((const GAS f32x4*)modl + e); *((LAS f32x4*)(par + D) + e) = *((const GAS f32x4*)(modl + D) + e) + 1.f; }
      __syncthreads(); }
    f32x4 rx[16];
    if (gw < S) { const GAS f32x4* xr = (const GAS f32x4*)(x + (size_t)gw * D) + lane;
#pragma unroll
        for (int j = 0; j < 16; ++j) rx[j] = __builtin_nontemporal_load(&xr[64 * j]); }
    for (int m = gw; m < S; m += NGW) {
        GAS u32x2* ho = (GAS u32x2*)(hout + (size_t)m * D) + lane;
        f32x4 h[16];
        { unsigned po_ = 0u; asm volatile("" : "+v"(po_)); par = (LAS float*)((LAS unsigned char*)par + po_); }
#pragma unroll
        for (int j = 0; j < 16; ++j) { h[j] = rx[j] * *((const LAS f32x4*)(par + D) + lane + 64 * j) + *((const LAS f32x4*)par + lane + 64 * j);
            asm volatile("" : "+v"(h[j]));
            if ((j & 3) == 3) __builtin_amdgcn_sched_barrier(0); }
        if (m + NGW < S) { const GAS f32x4* xr = (const GAS f32x4*)(x + (size_t)(m + NGW) * D) + lane;
#pragma unroll
            for (int j = 0; j < 16; ++j) rx[j] = __builtin_nontemporal_load(&xr[64 * j]); }
#pragma unroll
        for (int j = 0; j < 16; ++j) { u32x2 w; w.x = pk2(h[j][0], h[j][1]); w.y = pk2(h[j][2], h[j][3]); ho[64 * j] = w;
            if (h8) *((GAS unsigned*)(h8 + (size_t)m * D) + lane + 64 * j) = pk4_fp8(h[j]); }
    }
}
typedef _Float16 f16x4 __attribute__((ext_vector_type(4)));
template <bool XIN_H, bool XOUT_H>
__device__ __forceinline__ void ln_rows(const void* xres_, const bf16* yb, void* xout_, bf16* hout, unsigned char* h8, const float* g, const float* b, const float* mod_next, LAS float* par, int tid, int gw, int NGW, int lane) {
    {
#pragma unroll
      for (int i = 0; i < 2; ++i) { const int e = tid + 512 * i;
          *((LAS f32x4*)par + e) = *((const GAS f32x4*)g + e); *((LAS f32x4*)(par + D) + e) = *((const GAS f32x4*)b + e);
          if (hout) { *((LAS f32x4*)(par + 2 * D) + e) = *((const GAS f32x4*)mod_next + e); *((LAS f32x4*)(par + 3 * D) + e) = *((const GAS f32x4*)(mod_next + D) + e) + 1.f; } }
      __syncthreads(); }
    f32x4 rx[16]; f16x4 rxh[16]; u32x2 ry[16];
#define LN_LOAD(m_) { const GAS f32x4* vr = (const GAS f32x4*)((const float*)xres_ + (size_t)(m_) * D) + lane; const GAS f16x4* vrh = (const GAS f16x4*)((const _Float16*)xres_ + (size_t)(m_) * D) + lane; \
        const GAS u32x2* yr = (const GAS u32x2*)(yb + (size_t)(m_) * D) + lane; \
        _Pragma("unroll") for (int j = 0; j < 16; ++j) { ry[j] = __builtin_nontemporal_load(&yr[64 * j]); if (XIN_H) rxh[j] = __builtin_nontemporal_load(&vrh[64 * j]); else rx[j] = __builtin_nontemporal_load(&vr[64 * j]); } }
    if (gw < S) LN_LOAD(gw)
    for (int m = gw; m < S; m += NGW) {
        f32x4 x[16]; float s = 0.f;
#pragma unroll
        for (int j = 0; j < 16; ++j) { const u32x2 yy = ry[j]; const f32x4 yf = {bflo(yy.x), bfhi(yy.x), bflo(yy.y), bfhi(yy.y)};
            const f32x4 xin = XIN_H ? __builtin_convertvector(rxh[j], f32x4) : rx[j];
            x[j] = xin * DN_ALPHA + yf; s += (x[j][0] + x[j][1]) + (x[j][2] + x[j][3]); }
        if (m + NGW < S) LN_LOAD(m + NGW)
        const float mean = wave_sum(s) * (1.f / D); float s2 = 0.f;
#pragma unroll
        for (int j = 0; j < 16; ++j) { x[j] = x[j] - mean; s2 += (x[j][0] * x[j][0] + x[j][1] * x[j][1]) + (x[j][2] * x[j][2] + x[j][3] * x[j][3]); }
        const float rstd = 1.f / sqrtf(wave_sum(s2) * (1.f / D) + LN_EPS);
        { unsigned po_ = 0u; asm volatile("" : "+v"(po_)); par = (LAS float*)((LAS unsigned char*)par + po_); }
        GAS f32x4* xo = (GAS f32x4*)((float*)xout_ + (size_t)m * D) + lane; GAS f16x4* xoh = (GAS f16x4*)((_Float16*)xout_ + (size_t)m * D) + lane;
#pragma unroll
        for (int j = 0; j < 16; ++j) {
            const f32x4 gg = *((const LAS f32x4*)par + lane + 64 * j), bb = *((const LAS f32x4*)(par + D) + lane + 64 * j);
            const f32x4 y = x[j] * rstd * gg + bb;
            if (XOUT_H) xoh[64 * j] = __builtin_convertvector(y, f16x4); else __builtin_nontemporal_store(y, &xo[64 * j]);
            if (hout) {
                const f32x4 sh = *((const LAS f32x4*)(par + 2 * D) + lane + 64 * j), scl = *((const LAS f32x4*)(par + 3 * D) + lane + 64 * j);
                const f32x4 h = y * scl + sh;
                u32x2 w; w.x = pk2(h[0], h[1]); w.y = pk2(h[2], h[3]);
                *((GAS u32x2*)(hout + (size_t)m * D) + lane + 64 * j) = w;
                if (h8) *((GAS unsigned*)(h8 + (size_t)m * D) + lane + 64 * j) = pk4_fp8(h);
            }
            if ((j & 3) == 3) __builtin_amdgcn_sched_barrier(0);
        }
    }
#undef LN_LOAD
}
__device__ __forceinline__ void rstd_rows(const float* rsq_q, const float* rsq_kv, float* rstd_q, float* rstd_kv, int gtid, int NT) {
    for (int row = gtid; row < S; row += NT) {
        const GAS f32x4* rp = (const GAS f32x4*)(rsq_q + (size_t)row * 24); float ss = 0.f;
#pragma unroll
        for (int i = 0; i < 6; ++i) { const f32x4 t = rp[i]; ss += (t[0] + t[1]) + (t[2] + t[3]); }
        rstd_q[row] = 1.f / sqrtf(ss * (1.f / 768.f) + RMS_EPS);
        const GAS f32x4* rk = (const GAS f32x4*)(rsq_kv + (size_t)row * 16); float sk = 0.f;
#pragma unroll
        for (int i = 0; i < 4; ++i) { const f32x4 t = rk[i]; sk += (t[0] + t[1]) + (t[2] + t[3]); }
        rstd_kv[row] = 1.f / sqrtf(sk * (1.f / 512.f) + RMS_EPS);
    }
}
namespace pg8 {
#define PG8_LAS __attribute__((address_space(3)))
typedef unsigned short bf16_t;
typedef short bf16x8 __attribute__((ext_vector_type(8)));
typedef float f32x4 __attribute__((ext_vector_type(4)));
typedef unsigned u32x4 __attribute__((ext_vector_type(4)));
constexpr int BM = 256, BK = 64, HALF = 128, HTB = HALF * BK * 2  , STAGE_BYTES = 8 * HTB, NXCD = 8, WGM = 8;

__host__ __device__ __forceinline__ int lds_byte(int r, int c) { const int st = (r >> 4) * 2 + (c >> 5), rr = r & 15, cc = c & 31, ob = rr * 64 + cc * 2; return st * 1024 + (ob ^ (((ob >> 9) & 1) << 5)); }
__host__ __device__ __forceinline__ void stage_rc(int b, int& R, int& C) { const int st = b / 1024, sb = b % 1024, swz = sb ^ (((sb >> 9) & 1) << 5); R = (st >> 1) * 16 + swz / 64; C = (st & 1) * 32 + (swz % 64) / 2; }
__host__ __device__ __forceinline__ int perm32(int rho) { const int n = rho >> 4, i = rho & 15; return 8 * (i >> 2) + 4 * n + (i & 3); }

struct Unit { int pm, pn; };
struct Gemm { const bf16_t* A; const bf16_t* Bt; int M, N, K; };

struct StaticOrder {
    int nM, nN, nwg, G, c;
    __host__ __device__ void init(int M, int N, int G_, int c_) { nM = M / BM; nN = N / BM; nwg = nM * nN; G = G_; c = c_; }
    __host__ __device__ bool next(int i, Unit& u) const {
        const long L = (long)i * G + c; if (L >= nwg) return false;
        int wgid = (int)L; { const int q = nwg / NXCD, r = nwg % NXCD, xcd = wgid % NXCD, off = wgid / NXCD; wgid = (xcd < r ? xcd * (q + 1) : r * (q + 1) + (xcd - r) * q) + off; }
        const int nig = WGM * nN, gid = wgid / nig, fm = gid * WGM, gsz = (nM - fm) < WGM ? (nM - fm) : WGM;
        u.pm = fm + ((wgid % nig) % gsz); u.pn = (wgid % nig) / gsz; return true;
    }
    __device__ __forceinline__ void a_ready(const Unit&) const {}
    __device__ __forceinline__ void done(const Unit&) const {}
};
typedef int i32x8 __attribute__((ext_vector_type(8)));
typedef int i32x4 __attribute__((ext_vector_type(4)));
__device__ __forceinline__ i32x8 ld2x16(const PG8_LAS unsigned char* p) { const u32x4 a = *(const PG8_LAS u32x4*)p, b = *(const PG8_LAS u32x4*)(p + 1024);
    return (i32x8){(int)a.x, (int)a.y, (int)a.z, (int)a.w, (int)b.x, (int)b.y, (int)b.z, (int)b.w}; }
__device__ __forceinline__ i32x8 cat8(bf16x8 lo, bf16x8 hi) { const i32x4 a = __builtin_bit_cast(i32x4, lo), b = __builtin_bit_cast(i32x4, hi); return (i32x8){a[0], a[1], a[2], a[3], b[0], b[1], b[2], b[3]}; }
struct InBf16Order : StaticOrder {
    __device__ bool next(int i, Unit& u) const { if (!StaticOrder::next(i, u)) return false; u.pn = u.pn == 0 ? 5 : 13 + u.pn; return true; }
};
__device__ __forceinline__ f32x4 rope4(const f32x4 v, float c0, float s0, float c1, float s1) {
    f32x4 o; o[0] = v[0] * c0 - v[1] * s0; o[1] = v[1] * c0 + v[0] * s0; o[2] = v[2] * c1 - v[3] * s1; o[3] = v[3] * c1 + v[2] * s1; return o; }
#define NZ(v, row, col) (v)
__device__ __forceinline__ u32x2 pk8_fp8(f32x4 a, f32x4 b) {
    int w0 = __builtin_amdgcn_cvt_pk_fp8_f32(a[0], a[1], 0, false); w0 = __builtin_amdgcn_cvt_pk_fp8_f32(a[2], a[3], w0, true);
    int w1 = __builtin_amdgcn_cvt_pk_fp8_f32(b[0], b[1], 0, false); w1 = __builtin_amdgcn_cvt_pk_fp8_f32(b[2], b[3], w1, true);
    u32x2 r; r.x = (unsigned)w0; r.y = (unsigned)w1; return r; }
struct EpiIn {
    static constexpr bool PERM = true, AFTER_DRAIN = false;
    unsigned char* ws; int f8pass;
    __device__ __forceinline__ void operator()(const f32x4 (&acc)[2][2][4][2], const Unit& u, int wr, int wc, int fr, int fq) const {
        const int pn = f8pass ? (u.pn < 5 ? u.pn : u.pn + 1) : u.pn, row0 = u.pm * BM + wr * 64 + fr;
        if (pn < 5) {
            const bool isq = pn < 3; bf16_t* base = (bf16_t*)(ws + (isq ? WS_QLAT : WS_KVLAT)); const int ld = isq ? 768 : 512, ct = isq ? pn : pn - 3, ns = isq ? 24 : 16; float* rsq = (float*)(ws + (isq ? WS_RSQQ : WS_RSQKV));
#pragma unroll
            for (int ai = 0; ai < 2; ++ai)
#pragma unroll
                for (int m = 0; m < 4; ++m) { const int row = row0 + ai * HALF + m * 16;
#pragma unroll
                    for (int bj = 0; bj < 2; ++bj) { const f32x4 v0 = NZ(acc[ai][bj][m][0], row, pn * 256 + bj * 128 + wc * 32 + 8 * fq), v1 = NZ(acc[ai][bj][m][1], row, pn * 256 + bj * 128 + wc * 32 + 8 * fq + 4);
                        float ss = ((v0[0] * v0[0] + v0[1] * v0[1]) + (v0[2] * v0[2] + v0[3] * v0[3])) + ((v1[0] * v1[0] + v1[1] * v1[1]) + (v1[2] * v1[2] + v1[3] * v1[3]));
                        ss += __shfl_xor(ss, 16); ss += __shfl_xor(ss, 32);
                        if (fq == 0) rsq[(size_t)row * ns + ct * 8 + bj * 4 + wc] = ss;
                        *(GAS u32x2*)((unsigned char*)base + (size_t)row * ld + ct * 256 + bj * HALF + wc * 32 + 8 * fq) = pk8_fp8(v0, v1); } }
        } else if (pn == 5) {
            if (wc < 2) {
                const int i0 = 16 * wc + 4 * fq; const float* cosT = (const float*)(ws + WS_ROPE); const float* sinT = cosT + (size_t)S * 32; bf16_t* kmla = (bf16_t*)(ws + WS_KMLA);
#pragma unroll
                for (int ai = 0; ai < 2; ++ai)
#pragma unroll
                    for (int m = 0; m < 4; ++m) { const int row = row0 + ai * HALF + m * 16;
                        const f32x4 cs = *(const GAS f32x4*)(cosT + (size_t)row * 32 + i0), sn = *(const GAS f32x4*)(sinT + (size_t)row * 32 + i0);
                        const u32x2 w = pk8_fp8(rope4(acc[ai][0][m][0], cs[0], sn[0], cs[1], sn[1]), rope4(acc[ai][0][m][1], cs[2], sn[2], cs[3], sn[3]));
                        unsigned char* dst = (unsigned char*)kmla + (size_t)row * 3072 + 128 + wc * 32 + 8 * fq;
#pragma unroll
                        for (int h = 0; h < 16; ++h) *(GAS u32x2*)(dst + h * 192) = w;
                        asm volatile("" ::: "memory"); }
            } else {
                const int cl = (wc - 2) * 32 + 8 * fq; float* gnsa = (float*)(ws + WS_GNSA);
                if (cl < 48) {
#pragma unroll
                    for (int ai = 0; ai < 2; ++ai)
#pragma unroll
                        for (int m = 0; m < 4; ++m) { const int row = row0 + ai * HALF + m * 16; const f32x4 v0 = acc[ai][0][m][0], v1 = acc[ai][0][m][1];
                            f32x4 g0, g1; g0[0] = sigm_f(v0[0]); g0[1] = sigm_f(v0[1]); g0[2] = sigm_f(v0[2]); g0[3] = sigm_f(v0[3]); g1[0] = sigm_f(v1[0]); g1[1] = sigm_f(v1[1]); g1[2] = sigm_f(v1[2]); g1[3] = sigm_f(v1[3]);
                            *(GAS f32x4*)(gnsa + (size_t)row * 48 + cl) = g0; *(GAS f32x4*)(gnsa + (size_t)row * 48 + cl + 4) = g1; } }
            }
        } else {
            const int mode = (pn < 14) ? 0 : (pn < 22 ? 1 : (pn < 28 ? 2 : 0));
            bf16_t* base = (pn < 14) ? (bf16_t*)(ws + WS_ZMLA) + (pn - 6) * 256 : (pn < 22 ? (bf16_t*)(ws + WS_QNSA) + (pn - 14) * 256 : (bf16_t*)(ws + WS_ZNSA) + (pn - 28) * 256); bf16_t* kvnsa = (bf16_t*)(ws + WS_KVNSA);
#pragma unroll
            for (int ai = 0; ai < 2; ++ai)
#pragma unroll
                for (int m = 0; m < 4; ++m) { const int row = row0 + ai * HALF + m * 16;
#pragma unroll
                    for (int bj = 0; bj < 2; ++bj) { f32x4 v0 = NZ(acc[ai][bj][m][0], row, pn * 256 + bj * 128 + wc * 32 + 8 * fq), v1 = NZ(acc[ai][bj][m][1], row, pn * 256 + bj * 128 + wc * 32 + 8 * fq + 4);
                        if (mode == 0) { v0[0] = silu_f(v0[0]); v0[1] = silu_f(v0[1]); v0[2] = silu_f(v0[2]); v0[3] = silu_f(v0[3]); v1[0] = silu_f(v1[0]); v1[1] = silu_f(v1[1]); v1[2] = silu_f(v1[2]); v1[3] = silu_f(v1[3]); }
                        else if (mode == 1) { v0 = v0 * QS_NSA; v1 = v1 * QS_NSA; }
                        bf16_t* dst = (mode == 2) ? kvnsa + (size_t)(2 * (pn - 22) + bj) * ((size_t)S * 128) + (size_t)row * 128 + wc * 32 + 8 * fq
                                                  : base + (size_t)row * 2048 + bj * HALF + wc * 32 + 8 * fq;
                        *(GAS u32x4*)dst = pk8(v0, v1); } }
        }
    }
};
struct EpiQup {
    static constexpr bool PERM = true, AFTER_DRAIN = false;
    unsigned char* ws;
    __device__ __forceinline__ void operator()(const f32x4 (&acc)[2][2][4][2], const Unit& u, int wr, int wc, int fr, int fq) const {
        const int pn = u.pn, row0 = u.pm * BM + wr * 64 + fr; bf16_t* qmla = (bf16_t*)(ws + WS_QMLA); const float* rstd_q = (const float*)(ws + WS_RSTD); const float* cosT = (const float*)(ws + WS_ROPE); const float* sinT = cosT + (size_t)S * 32;
        float scv[2][4];
#pragma unroll
        for (int ai = 0; ai < 2; ++ai)
#pragma unroll
            for (int m = 0; m < 4; ++m) scv[ai][m] = (QS_MLA * 8.f) * *(const GAS float*)(rstd_q + row0 + ai * HALF + m * 16);
        if (pn < 8) {
#pragma unroll
            for (int ai = 0; ai < 2; ++ai)
#pragma unroll
                for (int m = 0; m < 4; ++m) { const int row = row0 + ai * HALF + m * 16; const float sc = scv[ai][m];
                    unsigned char* q8 = (unsigned char*)qmla + (size_t)row * 3072;
#pragma unroll
                    for (int bj = 0; bj < 2; ++bj) { const f32x4 v0 = acc[ai][bj][m][0] * sc, v1 = acc[ai][bj][m][1] * sc;
                        *(GAS u32x2*)(q8 + (2 * pn + bj) * 192 + wc * 32 + 8 * fq) = pk8_fp8(v0, v1); }
                    if (m & 1) asm volatile("" ::: "memory"); }
        } else {
#pragma unroll
            for (int ai = 0; ai < 2; ++ai)
#pragma unroll
                for (int mp = 0; mp < 2; ++mp) {
                    f32x4 cs[2][2], sn[2][2];
#pragma unroll
                    for (int mm = 0; mm < 2; ++mm)
#pragma unroll
                        for (int bj = 0; bj < 2; ++bj) { const int row = row0 + ai * HALF + (2 * mp + mm) * 16; const int cp = (pn - 8) * 256 + bj * HALF + wc * 32 + 8 * fq, i0 = (cp & 63) >> 1;
                            cs[mm][bj] = *(const GAS f32x4*)(cosT + (size_t)row * 32 + i0); sn[mm][bj] = *(const GAS f32x4*)(sinT + (size_t)row * 32 + i0); }
#pragma unroll
                    for (int mm = 0; mm < 2; ++mm)
#pragma unroll
                        for (int bj = 0; bj < 2; ++bj) { const int m = 2 * mp + mm, row = row0 + ai * HALF + m * 16; const float sc = scv[ai][m];
                            const f32x4 v0 = acc[ai][bj][m][0] * sc, v1 = acc[ai][bj][m][1] * sc;
                            const int cp = (pn - 8) * 256 + bj * HALF + wc * 32 + 8 * fq, head = cp >> 6, dl = cp & 63;
                            *(GAS u32x2*)((unsigned char*)qmla + (size_t)row * 3072 + head * 192 + 128 + dl) = pk8_fp8(rope4(v0, cs[mm][bj][0], sn[mm][bj][0], cs[mm][bj][1], sn[mm][bj][1]), rope4(v1, cs[mm][bj][2], sn[mm][bj][2], cs[mm][bj][3], sn[mm][bj][3])); }
                    asm volatile("" ::: "memory"); }
        }
    }
};
struct EpiKvup {
    static constexpr bool PERM = true, AFTER_DRAIN = false;
    unsigned char* ws;
    __device__ __forceinline__ void operator()(const f32x4 (&acc)[2][2][4][2], const Unit& u, int wr, int wc, int fr, int fq) const {
        const int pn = u.pn, row0 = u.pm * BM + wr * 64 + fr;
#pragma unroll
        for (int ai = 0; ai < 2; ++ai)
#pragma unroll
            for (int m = 0; m < 4; ++m) { const int row = row0 + ai * HALF + m * 16;
                const float sc = *(const GAS float*)((const float*)(ws + WS_RSTD) + S + row); bf16_t* kmla = (bf16_t*)(ws + WS_KMLA); bf16_t* vmla = (bf16_t*)(ws + WS_VMLA);
                *(GAS u32x2*)((unsigned char*)kmla + (size_t)row * 3072 + pn * 192 + wc * 32 + 8 * fq) = pk8_fp8(acc[ai][0][m][0] * sc, acc[ai][0][m][1] * sc);
                *(GAS u32x4*)(vmla + (size_t)row * 2048 + pn * 128 + wc * 32 + 8 * fq) = pk8(acc[ai][1][m][0] * sc, acc[ai][1][m][1] * sc);
                if (m & 1) asm volatile("" ::: "memory"); }
    }
};
struct EpiKup {
    static constexpr bool PERM = true, AFTER_DRAIN = false;
    unsigned char* ws;
    __device__ __forceinline__ void operator()(const f32x4 (&acc)[2][2][4][2], const Unit& u, int wr, int wc, int fr, int fq) const {
        const int pn = u.pn, row0 = u.pm * BM + wr * 64 + fr;
        float scv[2][4];
#pragma unroll
        for (int ai = 0; ai < 2; ++ai)
#pragma unroll
            for (int m = 0; m < 4; ++m) scv[ai][m] = *(const GAS float*)((const float*)(ws + WS_RSTD) + S + row0 + ai * HALF + m * 16);
#pragma unroll
        for (int ai = 0; ai < 2; ++ai)
#pragma unroll
            for (int m = 0; m < 4; ++m) { const int row = row0 + ai * HALF + m * 16;
                const float sc = scv[ai][m]; unsigned char* k8 = ws + WS_KMLA + (size_t)row * 3072;
#pragma unroll
                for (int bj = 0; bj < 2; ++bj) *(GAS u32x2*)(k8 + (2 * pn + bj) * 192 + wc * 32 + 8 * fq) = pk8_fp8(acc[ai][bj][m][0] * sc, acc[ai][bj][m][1] * sc);
                if (m & 1) asm volatile("" ::: "memory"); }
    }
};
struct EpiVt {
    static constexpr bool PERM = true, AFTER_DRAIN = false;
    unsigned char* ws;
    __device__ __forceinline__ void operator()(const f32x4 (&acc)[2][2][4][2], const Unit& u, int wr, int wc, int fr, int fq) const {
        const int row0 = u.pm * BM + wr * 64 + fr, col0 = u.pn * BM + wc * 32 + 8 * fq;
        const float* rs = (const float*)(ws + WS_RSTD) + S;
        f32x4 sc[2][2];
#pragma unroll
        for (int bj = 0; bj < 2; ++bj) { sc[bj][0] = *(const GAS f32x4*)(rs + col0 + bj * HALF); sc[bj][1] = *(const GAS f32x4*)(rs + col0 + bj * HALF + 4); }
        const int hi8 = (col0 >> 3) & 1; (void)hi8;
#pragma unroll
        for (int ai = 0; ai < 2; ++ai)
#pragma unroll
            for (int m = 0; m < 4; ++m) { unsigned char* vt = ws + WS_VMLA + (size_t)(row0 + ai * HALF + m * 16) * S;
#pragma unroll
                for (int bj = 0; bj < 2; ++bj) { const u32x2 w = pk8_fp8(acc[ai][bj][m][0] * sc[bj][0], acc[ai][bj][m][1] * sc[bj][1]);
                    unsigned char* d64 = vt + ((col0 + bj * HALF) & ~63) + 4 * ((col0 >> 3) & 7);
                    *(GAS unsigned*)(d64) = w.x; *(GAS unsigned*)(d64 + 32) = w.y; } }
    }
};
struct EpiOut {
    static constexpr bool PERM = true, AFTER_DRAIN = false;
    bf16_t* y; const float* gate;
    __device__ __forceinline__ void operator()(const f32x4 (&acc)[2][2][4][2], const Unit& u, int wr, int wc, int fr, int fq) const {
        const int row0 = u.pm * BM + wr * 64 + fr, col0 = u.pn * BM + wc * 32 + 8 * fq;
        f32x4 gv[2][2];
#pragma unroll
        for (int bj = 0; bj < 2; ++bj)
#pragma unroll
            for (int n = 0; n < 2; ++n) gv[bj][n] = *(const GAS f32x4*)(gate + col0 + bj * HALF + n * 4);
#pragma unroll
        for (int ai = 0; ai < 2; ++ai)
#pragma unroll
            for (int m = 0; m < 4; ++m) { bf16_t* dst = y + (size_t)(row0 + ai * HALF + m * 16) * D + col0;
#pragma unroll
                for (int bj = 0; bj < 2; ++bj) *(GAS u32x4*)(dst + bj * HALF) = pk8(gv[bj][0] * acc[ai][bj][m][0], gv[bj][1] * acc[ai][bj][m][1]);
                if (m & 1) asm volatile("" ::: "memory"); }
    }
};
template <class Epi, class Sched, bool ALIGN_EPI = false, bool SP2 = false, int SCB = 0, int SCA = 0>
__device__ __forceinline__ void gemm_phase(PG8_LAS unsigned char* lds, const Gemm g, const Sched& S, const Epi& E) {
    int tid_ = threadIdx.x; asm volatile("" : "+v"(tid_));
    const int tid = tid_, wid = __builtin_amdgcn_readfirstlane(tid >> 6), lane = tid & 63, wr = wid >> 2, wc = wid & 3, fr = lane & 15, fq = lane >> 4;
    const int K = g.K, nt = K / BK;
    unsigned voffA[2], voffB[2];
#pragma unroll
    for (int i = 0; i < 2; ++i) { int R, C; stage_rc(tid * 16 + i * 8192, R, C); const int Rb = Epi::PERM ? ((R & ~31) + perm32(R & 31)) : R;
        voffA[i] = (unsigned)(R * K + C) * 2u; voffB[i] = (unsigned)(Rb * K + C) * 2u; }
    const size_t kstep = (size_t)(BK * 2);
    const size_t hstep = (size_t)HALF * K * 2;
    const size_t tstep = 2 * hstep;
    const unsigned ldsw = (unsigned)wid * 1024u;
    const int aoff = lds_byte(wr * 64 + fr, fq * 8), boff = lds_byte(wc * 32 + fr, fq * 8);
#define PG8_SA(b, h) (((b) * 2 + (h)) * HTB)
#define PG8_SB(b, h) ((4 + (b) * 2 + (h)) * HTB)
#define PG8_STAGE(bufoff, gbase, voff) do { _Pragma("unroll") for (int _i = 0; _i < 2; ++_i) \
        __builtin_amdgcn_global_load_lds((const unsigned*)((const char*)(gbase) + (voff)[_i]), (PG8_LAS unsigned*)(lds + (bufoff) + ldsw + _i * 8192), 16, 0, 0); } while (0)
#define PG8_LDA(dst, b, h) do { if constexpr (SCB != 0) { _Pragma("unroll") for (int m = 0; m < 4; ++m) dst##8[m] = ld2x16(lds + PG8_SA(b, h) + aoff + m * 2048); } \
        else { _Pragma("unroll") for (int m = 0; m < 4; ++m) _Pragma("unroll") for (int k = 0; k < 2; ++k) dst[m][k] = *(const PG8_LAS bf16x8*)(lds + PG8_SA(b, h) + aoff + m * 2048 + k * 1024); } } while (0)
#define PG8_LDB(dst, b, h) do { if constexpr (SCB != 0) { _Pragma("unroll") for (int n = 0; n < 2; ++n) dst##8[n] = ld2x16(lds + PG8_SB(b, h) + boff + n * 2048); } \
        else { _Pragma("unroll") for (int n = 0; n < 2; ++n) _Pragma("unroll") for (int k = 0; k < 2; ++k) dst[n][k] = *(const PG8_LAS bf16x8*)(lds + PG8_SB(b, h) + boff + n * 2048 + k * 1024); } } while (0)
#define PG8_MMA(ai, bj, At, Bt) do { __builtin_amdgcn_s_setprio(1); \
        if constexpr (SCB != 0) { _Pragma("unroll") for (int m = 0; m < 4; ++m) _Pragma("unroll") for (int n = 0; n < 2; ++n) \
            asm volatile("v_mfma_scale_f32_16x16x128_f8f6f4 %0, %1, %2, %0, %3, %4 op_sel_hi:[0,0,0]" : "+v"(acc[ai][bj][m][n]) : "v"(Bt##8[n]), "v"(At##8[m]), "v"(scb_), "v"(sca_)); } \
        else { _Pragma("unroll") for (int m = 0; m < 4; ++m) _Pragma("unroll") for (int n = 0; n < 2; ++n) _Pragma("unroll") for (int k = 0; k < 2; ++k) \
            acc[ai][bj][m][n] = __builtin_amdgcn_mfma_f32_16x16x32_bf16(Bt[n][k], At[m][k], acc[ai][bj][m][n], 0, 0, 0); } \
        __builtin_amdgcn_s_setprio(0); } while (0)
#define PG8_WAIT_V(n) asm volatile("s_waitcnt vmcnt(" #n ")" ::: "memory")
#define PG8_WAIT_L(n) asm volatile("s_waitcnt lgkmcnt(" #n ")" ::: "memory")
#define PG8_BAR __builtin_amdgcn_s_barrier()
#define PG8_SCHED __builtin_amdgcn_sched_barrier(0)
    Unit cur, nxt; int ui = 0;
    if (!S.next(0, cur)) return;
    f32x4 acc[2][2][4][2];
#pragma unroll
    for (int a = 0; a < 2; ++a)
#pragma unroll
        for (int b = 0; b < 2; ++b)
#pragma unroll
            for (int m = 0; m < 4; ++m)
#pragma unroll
                for (int n = 0; n < 2; ++n) acc[a][b][m][n] = (f32x4){0.f, 0.f, 0.f, 0.f};
    int scb_ = SCB, sca_ = SCA; asm volatile("" : "+v"(scb_), "+v"(sca_));
    bf16x8 At[4][2], B0[2][2], B1[2][2]; i32x8 At8[4], B08[2], B18[2];
    const char* cA = (const char*)g.A + (size_t)cur.pm * tstep; const char* cB = (const char*)g.Bt + (size_t)cur.pn * tstep;
    S.a_ready(cur);
    if constexpr (SP2) {
        PG8_STAGE(PG8_SB(0, 0), cB, voffB); PG8_STAGE(PG8_SB(0, 1), cB + hstep, voffB); PG8_STAGE(PG8_SA(0, 0), cA, voffA); PG8_STAGE(PG8_SA(0, 1), cA + hstep, voffA);
        if (wr == 1) PG8_BAR;
        PG8_WAIT_V(2); PG8_BAR;
        PG8_STAGE(PG8_SB(1, 0), cB + kstep, voffB); PG8_STAGE(PG8_SA(1, 0), cA + kstep, voffA); PG8_STAGE(PG8_SB(1, 1), cB + hstep + kstep, voffB);
        PG8_WAIT_V(6); PG8_BAR;
    } else {
        PG8_STAGE(PG8_SB(0, 0), cB, voffB); PG8_STAGE(PG8_SA(0, 0), cA, voffA); PG8_STAGE(PG8_SB(0, 1), cB + hstep, voffB); PG8_STAGE(PG8_SA(0, 1), cA + hstep, voffA);
        if (wr == 1) PG8_BAR;
        PG8_WAIT_V(4); PG8_BAR;
        PG8_STAGE(PG8_SB(1, 0), cB + kstep, voffB); PG8_STAGE(PG8_SA(1, 0), cA + kstep, voffA); PG8_STAGE(PG8_SB(1, 1), cB + hstep + kstep, voffB);
        PG8_WAIT_V(6); PG8_BAR;
    }
    for (;;) {
        const bool has_next = S.next(ui + 1, nxt);
        const char* nA = has_next ? (const char*)g.A + (size_t)nxt.pm * tstep : cA; const char* nB = has_next ? (const char*)g.Bt + (size_t)nxt.pn * tstep : cB;
#pragma unroll 1
        for (int t = 0; t < nt; t += 2) {
            const bool last = (t == nt - 2);
            const char* a1 = cA + (size_t)(t + 1) * kstep;
            const char* a2 = last ? nA : cA + (size_t)(t + 2) * kstep; const char* b2 = last ? nB : cB + (size_t)(t + 2) * kstep;
            const char* a3 = a2 + kstep; const char* b3 = b2 + kstep;
            if (last && has_next) S.a_ready(nxt);
            if constexpr (SP2) {
            PG8_LDB(B0, 0, 0); PG8_LDB(B1, 0, 1); PG8_SCHED; PG8_LDA(At, 0, 0); PG8_STAGE(PG8_SA(1, 1), a1 + hstep, voffA);
            PG8_WAIT_V(8); PG8_WAIT_L(0); PG8_BAR; PG8_MMA(0, 0, At, B0); PG8_MMA(0, 1, At, B1); PG8_BAR; PG8_SCHED;
            PG8_LDA(At, 0, 1); PG8_STAGE(PG8_SB(0, 0), b2, voffB); PG8_STAGE(PG8_SB(0, 1), b2 + hstep, voffB); PG8_STAGE(PG8_SA(0, 0), a2, voffA);
            PG8_WAIT_V(8); PG8_WAIT_L(0); PG8_BAR; PG8_MMA(1, 0, At, B0); PG8_MMA(1, 1, At, B1); PG8_BAR; PG8_SCHED;
            PG8_LDB(B0, 1, 0); PG8_LDB(B1, 1, 1); PG8_SCHED; PG8_LDA(At, 1, 0); PG8_STAGE(PG8_SA(0, 1), a2 + hstep, voffA);
            PG8_WAIT_V(8); PG8_WAIT_L(0); PG8_BAR; PG8_MMA(0, 0, At, B0); PG8_MMA(0, 1, At, B1); PG8_BAR; PG8_SCHED;
            PG8_LDA(At, 1, 1); PG8_STAGE(PG8_SB(1, 0), b3, voffB); PG8_STAGE(PG8_SB(1, 1), b3 + hstep, voffB); PG8_STAGE(PG8_SA(1, 0), a3, voffA);
            PG8_WAIT_V(8); PG8_WAIT_L(0); PG8_BAR; PG8_MMA(1, 0, At, B0); PG8_MMA(1, 1, At, B1); PG8_BAR; PG8_SCHED;
            } else {
            PG8_LDB(B0, 0, 0); PG8_SCHED; PG8_LDA(At, 0, 0); PG8_STAGE(PG8_SA(1, 1), a1 + hstep, voffA);
            PG8_WAIT_L(8); PG8_BAR; PG8_WAIT_L(0); PG8_MMA(0, 0, At, B0); PG8_BAR; PG8_SCHED;
            PG8_LDB(B1, 0, 1); PG8_STAGE(PG8_SB(0, 0), b2, voffB);
            PG8_BAR; PG8_WAIT_L(0); PG8_MMA(0, 1, At, B1); PG8_BAR;
            PG8_LDA(At, 0, 1); PG8_STAGE(PG8_SA(0, 0), a2, voffA);
            PG8_BAR; PG8_WAIT_L(0); PG8_MMA(1, 0, At, B0); PG8_BAR; PG8_SCHED;
            PG8_STAGE(PG8_SB(0, 1), b2 + hstep, voffB);
            PG8_WAIT_V(6); PG8_BAR; PG8_MMA(1, 1, At, B1); PG8_BAR;
            PG8_LDB(B0, 1, 0); PG8_SCHED; PG8_LDA(At, 1, 0); PG8_STAGE(PG8_SA(0, 1), a2 + hstep, voffA);
            PG8_WAIT_L(8); PG8_BAR; PG8_WAIT_L(0); PG8_MMA(0, 0, At, B0); PG8_BAR; PG8_SCHED;
            PG8_LDB(B1, 1, 1); PG8_STAGE(PG8_SB(1, 0), b3, voffB);
            PG8_BAR; PG8_WAIT_L(0); PG8_MMA(0, 1, At, B1); PG8_BAR;
            PG8_LDA(At, 1, 1); PG8_STAGE(PG8_SA(1, 0), a3, voffA);
            PG8_BAR; PG8_WAIT_L(0); PG8_MMA(1, 0, At, B0); PG8_BAR; PG8_SCHED;
            PG8_STAGE(PG8_SB(1, 1), b3 + hstep, voffB);
            PG8_WAIT_V(6); PG8_BAR; PG8_MMA(1, 1, At, B1); PG8_BAR;
            }
        }
        if constexpr (SCB != 0) asm volatile("s_nop 15\n\ts_nop 15" ::: "memory");
        if constexpr (ALIGN_EPI) { if (wr == 0) PG8_BAR; }
        if constexpr (!Epi::AFTER_DRAIN) { int fr_ = fr, fq_ = fq; asm volatile("" : "+v"(fr_), "+v"(fq_));
            E(acc, cur, wr, wc, fr_, fq_);
            S.done(cur); }
        if (!has_next) break;
#pragma unroll
        for (int a = 0; a < 2; ++a)
#pragma unroll
            for (int b = 0; b < 2; ++b)
#pragma unroll
                for (int m = 0; m < 4; ++m)
#pragma unroll
                    for (int n = 0; n < 2; ++n) acc[a][b][m][n] = (f32x4){0.f, 0.f, 0.f, 0.f};
        cur = nxt; cA = nA; cB = nB; ++ui;
        if constexpr (ALIGN_EPI) { if (wr == 1) PG8_BAR; }
    }
    PG8_WAIT_V(0);
    if constexpr (!ALIGN_EPI) { if (wr == 0) PG8_BAR; }
    PG8_BAR;
    if constexpr (Epi::AFTER_DRAIN) { E.fused(acc, cur, wr, wc, fr, fq, lds, wid, lane); S.done(cur); }
#undef PG8_SA
#undef PG8_SB
#undef PG8_STAGE
#undef PG8_LDA
#undef PG8_LDB
#undef PG8_MMA
#undef PG8_WAIT_V
#undef PG8_WAIT_L
#undef PG8_BAR
#undef PG8_SCHED
}

struct GemmMix { const void* A; const void* B; int LD;
                 int K0, K1, OFF1, M, N; };
template <class Epi, class Sched, int SCB, int SCA>
__device__ __forceinline__ void gemm_phase_mix(PG8_LAS unsigned char* lds, const GemmMix g, const Sched& S, const Epi& E) {
    int tid_ = threadIdx.x; asm volatile("" : "+v"(tid_));
    const int tid = tid_, wid = __builtin_amdgcn_readfirstlane(tid >> 6), lane = tid & 63, wr = wid >> 2, wc = wid & 3, fr = lane & 15, fq = lane >> 4;
    const int nt0 = g.K0 / BK, nt1 = g.K1 / BK, nt = nt0 + nt1, koff1 = g.OFF1 / BK - nt0;
    unsigned voffA[2], voffB[2];
#pragma unroll
    for (int i = 0; i < 2; ++i) { int R, C; stage_rc(tid * 16 + i * 8192, R, C); const int Rb = Epi::PERM ? ((R & ~31) + perm32(R & 31)) : R;
        voffA[i] = (unsigned)(R * g.LD + C) * 2u; voffB[i] = (unsigned)(Rb * g.LD + C) * 2u; }
    const size_t kstep = (size_t)(BK * 2);
    const size_t hstep = (size_t)HALF * g.LD * 2, tstep = 2 * hstep;
    const unsigned ldsw = (unsigned)wid * 1024u;
    const int aoff = lds_byte(wr * 64 + fr, fq * 8), boff = lds_byte(wc * 32 + fr, fq * 8);
#define PG8_SA(b, h) (((b) * 2 + (h)) * HTB)
#define PG8_SB(b, h) ((4 + (b) * 2 + (h)) * HTB)
#define PG8_STAGE(bufoff, gbase, voff) do { _Pragma("unroll") for (int _i = 0; _i < 2; ++_i) \
        __builtin_amdgcn_global_load_lds((const unsigned*)((const char*)(gbase) + (voff)[_i]), (PG8_LAS unsigned*)(lds + (bufoff) + ldsw + _i * 8192), 16, 0, 0); } while (0)
#define PG8_LDA1(dst, b, h) do { _Pragma("unroll") for (int m = 0; m < 4; ++m) dst##8[m] = ld2x16(lds + PG8_SA(b, h) + aoff + m * 2048); } while (0)
#define PG8_LDB1(dst, b, h) do { _Pragma("unroll") for (int n = 0; n < 2; ++n) dst##8[n] = ld2x16(lds + PG8_SB(b, h) + boff + n * 2048); } while (0)
#define PG8_LDA0(dst, b, h) do { _Pragma("unroll") for (int m = 0; m < 4; ++m) _Pragma("unroll") for (int k = 0; k < 2; ++k) dst[m][k] = *(const PG8_LAS bf16x8*)(lds + PG8_SA(b, h) + aoff + m * 2048 + k * 1024); } while (0)
#define PG8_LDB0(dst, b, h) do { _Pragma("unroll") for (int n = 0; n < 2; ++n) _Pragma("unroll") for (int k = 0; k < 2; ++k) dst[n][k] = *(const PG8_LAS bf16x8*)(lds + PG8_SB(b, h) + boff + n * 2048 + k * 1024); } while (0)
#define PG8_MMA1(ai, bj, At, Bt) do { __builtin_amdgcn_s_setprio(1); _Pragma("unroll") for (int m = 0; m < 4; ++m) _Pragma("unroll") for (int n = 0; n < 2; ++n) \
            asm volatile("v_mfma_scale_f32_16x16x128_f8f6f4 %0, %1, %2, %0, %3, %4 op_sel_hi:[0,0,0]" : "+v"(acc[ai][bj][m][n]) : "v"(Bt##8[n]), "v"(At##8[m]), "v"(scb_), "v"(sca_)); \
        __builtin_amdgcn_s_setprio(0); } while (0)
#define PG8_MMA0(ai, bj, At, Bt) do { __builtin_amdgcn_s_setprio(1); _Pragma("unroll") for (int m = 0; m < 4; ++m) _Pragma("unroll") for (int n = 0; n < 2; ++n) _Pragma("unroll") for (int k = 0; k < 2; ++k) \
            acc[ai][bj][m][n] = __builtin_amdgcn_mfma_f32_16x16x32_bf16(Bt[n][k], At[m][k], acc[ai][bj][m][n], 0, 0, 0); \
        __builtin_amdgcn_s_setprio(0); } while (0)
#define PG8_WAIT_V(n) asm volatile("s_waitcnt vmcnt(" #n ")" ::: "memory")
#define PG8_WAIT_L(n) asm volatile("s_waitcnt lgkmcnt(" #n ")" ::: "memory")
#define PG8_BAR __builtin_amdgcn_s_barrier()
#define PG8_SCHED __builtin_amdgcn_sched_barrier(0)
    Unit cur, nxt; int ui = 0;
    if (!S.next(0, cur)) return;
    f32x4 acc[2][2][4][2];
#pragma unroll
    for (int a = 0; a < 2; ++a)
#pragma unroll
        for (int b = 0; b < 2; ++b)
#pragma unroll
            for (int m = 0; m < 4; ++m)
#pragma unroll
                for (int n = 0; n < 2; ++n) acc[a][b][m][n] = (f32x4){0.f, 0.f, 0.f, 0.f};
    int scb_ = SCB, sca_ = SCA; asm volatile("" : "+v"(scb_), "+v"(sca_));
    bf16x8 At[4][2], B0[2][2], B1[2][2]; i32x8 At8[4], B08[2], B18[2];
    const char* cA = (const char*)g.A + (size_t)cur.pm * tstep; const char* cB = (const char*)g.B + (size_t)cur.pn * tstep;
    S.a_ready(cur);
    PG8_STAGE(PG8_SB(0, 0), cB, voffB); PG8_STAGE(PG8_SB(0, 1), cB + hstep, voffB); PG8_STAGE(PG8_SA(0, 0), cA, voffA); PG8_STAGE(PG8_SA(0, 1), cA + hstep, voffA);
    if (wr == 1) PG8_BAR;
    PG8_WAIT_V(2); PG8_BAR;
    PG8_STAGE(PG8_SB(1, 0), cB + kstep, voffB); PG8_STAGE(PG8_SA(1, 0), cA + kstep, voffA); PG8_STAGE(PG8_SB(1, 1), cB + hstep + kstep, voffB);
    PG8_WAIT_V(6); PG8_BAR;
    for (;;) {
        const bool has_next = S.next(ui + 1, nxt);
        const char* nA = has_next ? (const char*)g.A + (size_t)nxt.pm * tstep : cA; const char* nB = has_next ? (const char*)g.B + (size_t)nxt.pn * tstep : cB;
#define PG8_KPOS(x) ((size_t)((x) < nt0 ? (x) : (x) + koff1) * kstep)
#define PG8_TRIP(F) do { \
            const bool last = (t == nt - 2); \
            const char* a1 = cA + PG8_KPOS(t + 1); \
            const char* a2 = last ? nA : cA + PG8_KPOS(t + 2); const char* b2 = last ? nB : cB + PG8_KPOS(t + 2); \
            const char* a3 = last ? nA + kstep : cA + PG8_KPOS(t + 3); const char* b3 = last ? nB + kstep : cB + PG8_KPOS(t + 3); \
            if (last && has_next) S.a_ready(nxt); \
            PG8_LDB##F(B0, 0, 0); PG8_LDB##F(B1, 0, 1); PG8_SCHED; PG8_LDA##F(At, 0, 0); PG8_STAGE(PG8_SA(1, 1), a1 + hstep, voffA); \
            PG8_WAIT_V(8); PG8_WAIT_L(0); PG8_BAR; PG8_MMA##F(0, 0, At, B0); PG8_MMA##F(0, 1, At, B1); PG8_BAR; PG8_SCHED; \
            PG8_LDA##F(At, 0, 1); PG8_STAGE(PG8_SB(0, 0), b2, voffB); PG8_STAGE(PG8_SB(0, 1), b2 + hstep, voffB); PG8_STAGE(PG8_SA(0, 0), a2, voffA); \
            PG8_WAIT_V(8); PG8_WAIT_L(0); PG8_BAR; PG8_MMA##F(1, 0, At, B0); PG8_MMA##F(1, 1, At, B1); PG8_BAR; PG8_SCHED; \
            PG8_LDB##F(B0, 1, 0); PG8_LDB##F(B1, 1, 1); PG8_SCHED; PG8_LDA##F(At, 1, 0); PG8_STAGE(PG8_SA(0, 1), a2 + hstep, voffA); \
            PG8_WAIT_V(8); PG8_WAIT_L(0); PG8_BAR; PG8_MMA##F(0, 0, At, B0); PG8_MMA##F(0, 1, At, B1); PG8_BAR; PG8_SCHED; \
            PG8_LDA##F(At, 1, 1); PG8_STAGE(PG8_SB(1, 0), b3, voffB); PG8_STAGE(PG8_SB(1, 1), b3 + hstep, voffB); PG8_STAGE(PG8_SA(1, 0), a3, voffA); \
            PG8_WAIT_V(8); PG8_WAIT_L(0); PG8_BAR; PG8_MMA##F(1, 0, At, B0); PG8_MMA##F(1, 1, At, B1); PG8_BAR; PG8_SCHED; \
        } while (0)
#pragma unroll 1
        for (int t = 0; t < nt0; t += 2) PG8_TRIP(1);
        asm volatile("s_nop 7" ::: "memory");
#pragma unroll 1
        for (int t = nt0; t < nt; t += 2) PG8_TRIP(0);
#undef PG8_TRIP
#undef PG8_KPOS
        asm volatile("s_nop 15\n\ts_nop 15" ::: "memory");
        if (wr == 0) PG8_BAR;
        { int fr_ = fr, fq_ = fq; asm volatile("" : "+v"(fr_), "+v"(fq_)); E(acc, cur, wr, wc, fr_, fq_); S.done(cur); }
        if (!has_next) break;
#pragma unroll
        for (int a = 0; a < 2; ++a)
#pragma unroll
            for (int b = 0; b < 2; ++b)
#pragma unroll
                for (int m = 0; m < 4; ++m)
#pragma unroll
                    for (int n = 0; n < 2; ++n) acc[a][b][m][n] = (f32x4){0.f, 0.f, 0.f, 0.f};
        cur = nxt; cA = nA; cB = nB; ++ui;
        if (wr == 1) PG8_BAR;
    }
    PG8_WAIT_V(0);
    PG8_BAR;
#undef PG8_SA
#undef PG8_SB
#undef PG8_STAGE
#undef PG8_LDA0
#undef PG8_LDB0
#undef PG8_LDA1
#undef PG8_LDB1
#undef PG8_MMA0
#undef PG8_MMA1
#undef PG8_WAIT_V
#undef PG8_WAIT_L
#undef PG8_BAR
#undef PG8_SCHED
}
}
namespace att {
constexpr int KS_M = 400, KS_N = 272, VS = 320;
constexpr int MLA_KB = 64 * KS_M, NSA_KB = 64 * KS_N, VB = 64 * VS;
constexpr int N_IMP = 2 * NSA_KB + 2 * VB;
constexpr int N_PART = N_IMP + 32768;
constexpr int N_PARTB = 8 * 32 * 17 * 4;
constexpr int N_SELM = N_PART + 2 * N_PARTB;
constexpr int N_ULIST = N_SELM + 1024;
constexpr int N_CARRY = N_ULIST + 1024;
constexpr int N_NTS = N_CARRY + 256;
static_assert(N_NTS + 16 <= MISC_OFF, "NSA LDS map");
static_assert(2 * MLA_KB + 3 * VB <= 131072, "MLA LDS map");
constexpr int MLA_QL = 2 * MLA_KB + 2 * VB;
static_assert(MLA_QL + 8 * 4096 <= 131072, "MLA LDS map (pipelined)");

#ifndef QK_PF
#define QK_PF 4
#endif
#define MFMA32(a, b, c) __builtin_amdgcn_mfma_f32_32x32x16_bf16((a), (b), (c), 0, 0, 0)
__device__ __forceinline__ float swapmax(float v) { auto rr = __builtin_amdgcn_permlane32_swap(__float_as_uint(v), __float_as_uint(v), false, false); return fmaxf(__uint_as_float(rr[0]), __uint_as_float(rr[1])); }
__device__ __forceinline__ float swapsum(float v) { auto rr = __builtin_amdgcn_permlane32_swap(__float_as_uint(v), __float_as_uint(v), false, false); return __uint_as_float(rr[0]) + __uint_as_float(rr[1]); }
template <int SIDX> __device__ __forceinline__ bf16x8 packp(const f32x16& p) {
    f32x8 t = {p[8 * SIDX + 0], p[8 * SIDX + 1], p[8 * SIDX + 2], p[8 * SIDX + 3], p[8 * SIDX + 4], p[8 * SIDX + 5], p[8 * SIDX + 6], p[8 * SIDX + 7]};
    return __builtin_bit_cast(bf16x8, __builtin_convertvector(t, bf16x8v));
}
template <int NDC, int KS, bool ZERO = true> __device__ __forceinline__ void qk_tile(f32x16& p0, f32x16& p1, const LAS unsigned char* kl, const bf16x8 (&q)[NDC]) {
    if (ZERO) {
#pragma unroll
        for (int i = 0; i < 16; ++i) { p0[i] = 0.f; p1[i] = 0.f; }
    }
    constexpr int PF = QK_PF;
    bf16x8 a[PF + 1][2];
#pragma unroll
    for (int i = 0; i < PF; ++i) { a[i][0] = *(const LAS bf16x8*)(kl + i * 32); a[i][1] = *(const LAS bf16x8*)(kl + 32 * KS + i * 32); }
#pragma unroll
    for (int d0 = 0; d0 < NDC; ++d0) {
        if (d0 + PF < NDC) { a[(d0 + PF) % (PF + 1)][0] = *(const LAS bf16x8*)(kl + (d0 + PF) * 32); a[(d0 + PF) % (PF + 1)][1] = *(const LAS bf16x8*)(kl + 32 * KS + (d0 + PF) * 32); }
        __builtin_amdgcn_sched_barrier(0);
        p0 = MFMA32(a[d0 % (PF + 1)][0], q[d0], p0); p1 = MFMA32(a[d0 % (PF + 1)][1], q[d0], p1);
        __builtin_amdgcn_sched_barrier(0);
    }
}
struct PvPre { s16x4 f[4][2]; };
__device__ __forceinline__ void pv_preload(PvPre& pp, const LAS unsigned char* vl) {
#pragma unroll
    for (int s_ = 0; s_ < 4; ++s_) { pp.f[s_][0] = __builtin_amdgcn_ds_read_tr16_b64_v4i16((LAS s16x4*)(vl + s_ * 16 * VS)); pp.f[s_][1] = __builtin_amdgcn_ds_read_tr16_b64_v4i16((LAS s16x4*)(vl + s_ * 16 * VS + 8 * VS)); }
}
template <bool PRE = false>
__device__ __forceinline__ void pv_tile(f32x16 (&o)[4], const bf16x8 (&pb)[4], const LAS unsigned char* vl, const PvPre* pp = nullptr) {
    s16x4 f[5][2];
#define PV_LD(idx) do { constexpr int d_ = (idx) >> 2, s_ = (idx) & 3; \
        f[(idx) % 5][0] = __builtin_amdgcn_ds_read_tr16_b64_v4i16((LAS s16x4*)(vl + s_ * 16 * VS + d_ * 64)); \
        f[(idx) % 5][1] = __builtin_amdgcn_ds_read_tr16_b64_v4i16((LAS s16x4*)(vl + s_ * 16 * VS + 8 * VS + d_ * 64)); } while (0)
    if (PRE) {
#pragma unroll
        for (int s_ = 0; s_ < 4; ++s_) { f[s_][0] = pp->f[s_][0]; f[s_][1] = pp->f[s_][1]; }
    } else { PV_LD(0); PV_LD(1); PV_LD(2); PV_LD(3); }
#define PV_STEP(idx) do { if ((idx) + 4 < 16) PV_LD((idx) + 4); __builtin_amdgcn_sched_barrier(0); \
        { const s16x4 t0_ = f[(idx) % 5][0], t1_ = f[(idx) % 5][1]; const bf16x8 vf_ = {t0_[0], t0_[1], t0_[2], t0_[3], t1_[0], t1_[1], t1_[2], t1_[3]}; \
          o[(idx) >> 2] = MFMA32(vf_, pb[(idx) & 3], o[(idx) >> 2]); } __builtin_amdgcn_sched_barrier(0); } while (0)
    PV_STEP(0); PV_STEP(1); PV_STEP(2); PV_STEP(3); PV_STEP(4); PV_STEP(5); PV_STEP(6); PV_STEP(7);
    PV_STEP(8); PV_STEP(9); PV_STEP(10); PV_STEP(11); PV_STEP(12); PV_STEP(13); PV_STEP(14); PV_STEP(15);
#undef PV_STEP
#undef PV_LD
}
template <int NDC, int NQR, int KS> __device__ __forceinline__ void qk_tile_free(f32x16& p0, f32x16& p1, const LAS unsigned char* kl, const bf16x8 (&q)[NQR], const LAS unsigned char* ql) {
#pragma unroll
    for (int i = 0; i < 16; ++i) { p0[i] = 0.f; p1[i] = 0.f; }
#pragma unroll
    for (int d0 = 0; d0 < NDC; ++d0) {
        const bf16x8 a0 = *(const LAS bf16x8*)(kl + d0 * 32);
        const bf16x8 a1 = *(const LAS bf16x8*)(kl + 32 * KS + d0 * 32);
        bf16x8 qq; if (d0 < NQR) qq = q[d0 < NQR ? d0 : 0]; else qq = *(const LAS bf16x8*)(ql + (d0 - NQR) * 1024);
        p0 = MFMA32(a0, qq, p0); p1 = MFMA32(a1, qq, p1);
    }
}
__device__ __forceinline__ float sm_core(f32x16& p0, f32x16& p1, float& m, float& l) {
    float tm = p0[0];
#pragma unroll
    for (int r = 1; r < 16; ++r) tm = fmaxf(tm, p0[r]);
#pragma unroll
    for (int r = 0; r < 16; ++r) tm = fmaxf(tm, p1[r]);
    tm = swapmax(tm);
    const float mn = fmaxf(m, tm);
    const float alpha = __builtin_amdgcn_exp2f(m - mn);
    m = mn;
    float ps = 0.f;
#pragma unroll
    for (int r = 0; r < 16; ++r) { p0[r] = __builtin_amdgcn_exp2f(p0[r] - mn); ps += p0[r]; }
#pragma unroll
    for (int r = 0; r < 16; ++r) { p1[r] = __builtin_amdgcn_exp2f(p1[r] - mn); ps += p1[r]; }
    ps = swapsum(ps);
    l = l * alpha + ps;
    return alpha;
}
__device__ __forceinline__ void online_sm(f32x16& p0, f32x16& p1, float& m, float& l, f32x16 (&o)[4]) {
    float tm = p0[0];
#pragma unroll
    for (int r = 1; r < 16; ++r) tm = fmaxf(tm, p0[r]);
#pragma unroll
    for (int r = 0; r < 16; ++r) tm = fmaxf(tm, p1[r]);
    tm = swapmax(tm);
    const float mn = fmaxf(m, tm);
    const float alpha = __builtin_amdgcn_exp2f(m - mn);
    m = mn;
    float ps = 0.f;
#pragma unroll
    for (int r = 0; r < 16; ++r) { p0[r] = __builtin_amdgcn_exp2f(p0[r] - mn); ps += p0[r]; }
#pragma unroll
    for (int r = 0; r < 16; ++r) { p1[r] = __builtin_amdgcn_exp2f(p1[r] - mn); ps += p1[r]; }
    ps = swapsum(ps);
    l = l * alpha + ps;
    if (!__all(alpha == 1.f)) {
#pragma unroll
        for (int d = 0; d < 4; ++d)
#pragma unroll
            for (int r = 0; r < 16; ++r) o[d][r] *= alpha;
    }
}

typedef long i64;
constexpr int KS8 = 200, MLA_KB8 = 64 * KS8;
static_assert(2 * MLA_KB8 + 3 * VB <= 131072, "MLA fp8 LDS map");
#define MFMA32F8(a, b, c) __builtin_amdgcn_mfma_f32_32x32x16_fp8_fp8((a), (b), (c), 0, 0, 0)
template <int NDC> __device__ __forceinline__ void qk_tile8(f32x16& p0, f32x16& p1, const LAS unsigned char* kl, const i64 (&q)[NDC]) {
#pragma unroll
    for (int i = 0; i < 16; ++i) { p0[i] = 0.f; p1[i] = 0.f; }
    constexpr int PF = 4;
    i64 a[PF + 1][2];
#pragma unroll
    for (int i = 0; i < PF; ++i) { a[i][0] = *(const LAS i64*)(kl + i * 16); a[i][1] = *(const LAS i64*)(kl + 32 * KS8 + i * 16); }
#pragma unroll
    for (int d0 = 0; d0 < NDC; ++d0) {
        if (d0 + PF < NDC) { a[(d0 + PF) % (PF + 1)][0] = *(const LAS i64*)(kl + (d0 + PF) * 16); a[(d0 + PF) % (PF + 1)][1] = *(const LAS i64*)(kl + 32 * KS8 + (d0 + PF) * 16); }
        __builtin_amdgcn_sched_barrier(0);
        __builtin_amdgcn_s_setprio(1);
        p0 = MFMA32F8(a[d0 % (PF + 1)][0], q[d0], p0); p1 = MFMA32F8(a[d0 % (PF + 1)][1], q[d0], p1);
        __builtin_amdgcn_s_setprio(0);
        __builtin_amdgcn_sched_barrier(0);
    }
}
__device__ __forceinline__ void online_sm_scaled(f32x16& p0, f32x16& p1, float& m, float& l, f32x16 (&o)[4], const float C2) {
    float tm = p0[0];
#pragma unroll
    for (int r = 1; r < 16; ++r) tm = fmaxf(tm, p0[r]);
#pragma unroll
    for (int r = 0; r < 16; ++r) tm = fmaxf(tm, p1[r]);
    tm = swapmax(tm);
    const float mn = fmaxf(m, tm);
    const float alpha = __builtin_amdgcn_exp2f((m - mn) * C2);
    m = mn;
    const float mc = -mn * C2;
    float ps = 0.f;
#pragma unroll
    for (int r = 0; r < 16; ++r) { p0[r] = __builtin_amdgcn_exp2f(__builtin_fmaf(p0[r], C2, mc)); ps += p0[r]; }
#pragma unroll
    for (int r = 0; r < 16; ++r) { p1[r] = __builtin_amdgcn_exp2f(__builtin_fmaf(p1[r], C2, mc)); ps += p1[r]; }
    ps = swapsum(ps);
    l = l * alpha + ps;
    if (!__all(alpha == 1.f)) {
#pragma unroll
        for (int d = 0; d < 4; ++d)
#pragma unroll
            for (int r = 0; r < 16; ++r) o[d][r] *= alpha;
    }
}
constexpr int VS8 = 72, VB8 = 128 * VS8;
constexpr int VS8B = 136, VB8B = 128 * VS8B, MLA_KB8B = 128 * KS8;
static_assert(2 * MLA_KB8B + 3 * VB8B <= 131072, "MLA big-tile LDS map");
#define PV8_RS VS8
static_assert(2 * MLA_KB8 + 3 * VB8 <= 131072, "MLA fp8 LDS map");
template <int SIDX> __device__ __forceinline__ i64 packp8(const f32x16& p) {
    int w0 = __builtin_amdgcn_cvt_pk_fp8_f32(p[8 * SIDX + 0] * 256.f, p[8 * SIDX + 1] * 256.f, 0, false); w0 = __builtin_amdgcn_cvt_pk_fp8_f32(p[8 * SIDX + 2] * 256.f, p[8 * SIDX + 3] * 256.f, w0, true);
    int w1 = __builtin_amdgcn_cvt_pk_fp8_f32(p[8 * SIDX + 4] * 256.f, p[8 * SIDX + 5] * 256.f, 0, false); w1 = __builtin_amdgcn_cvt_pk_fp8_f32(p[8 * SIDX + 6] * 256.f, p[8 * SIDX + 7] * 256.f, w1, true);
    return (i64)(((unsigned long long)(unsigned)w1 << 32) | (unsigned)w0);
}
__device__ __forceinline__ void pv_tile8(f32x16 (&o)[4], const i64 (&pb)[4], const LAS unsigned char* vl) {
    i64 f[5];
#define PV8_LD(idx) f[(idx) % 5] = *(const LAS i64*)(vl + ((idx) >> 2) * 32 * PV8_RS + ((idx) & 3) * 16)
    PV8_LD(0); PV8_LD(1); PV8_LD(2); PV8_LD(3);
#define PV8_STEP(idx) do { if ((idx) + 4 < 16) PV8_LD((idx) + 4); __builtin_amdgcn_sched_barrier(0); \
        o[(idx) >> 2] = MFMA32F8(f[(idx) % 5], pb[(idx) & 3], o[(idx) >> 2]); __builtin_amdgcn_sched_barrier(0); } while (0)
    PV8_STEP(0); PV8_STEP(1); PV8_STEP(2); PV8_STEP(3); PV8_STEP(4); PV8_STEP(5); PV8_STEP(6); PV8_STEP(7);
    PV8_STEP(8); PV8_STEP(9); PV8_STEP(10); PV8_STEP(11); PV8_STEP(12); PV8_STEP(13); PV8_STEP(14); PV8_STEP(15);
#undef PV8_STEP
#undef PV8_LD
}
typedef int i32x8 __attribute__((ext_vector_type(8)));
constexpr int KSX = 208, MLA_KBX = 64 * KSX;
constexpr int VSX = 80, VBX = 128 * VSX;
static_assert(2 * MLA_KBX + 3 * VBX <= 131072, "MLA mx LDS map");
#define MFMAX(a, b, c) __builtin_amdgcn_mfma_scale_f32_32x32x64_f8f6f4((a), (b), (c), 0, 0, 0, 0x7f7f7f7f, 0, 0x7f7f7f7f)
__device__ __forceinline__ i32x8 ldsx(const LAS unsigned char* p) {
    const u32x4 a = *(const LAS u32x4*)p, b = *(const LAS u32x4*)(p + 16);
    return (i32x8){(int)a.x, (int)a.y, (int)a.z, (int)a.w, (int)b.x, (int)b.y, (int)b.z, (int)b.w};
}
__device__ __forceinline__ void qk_tilex(f32x16& p0, f32x16& p1, const LAS unsigned char* kl, const i32x8 (&q)[3]) {
#pragma unroll
    for (int i = 0; i < 16; ++i) { p0[i] = 0.f; p1[i] = 0.f; }
    i32x8 a0 = ldsx(kl), a1 = ldsx(kl + 32 * KSX), a2 = ldsx(kl + 64), a3 = ldsx(kl + 32 * KSX + 64);
    __builtin_amdgcn_sched_barrier(0);
    __builtin_amdgcn_s_setprio(1);
    p0 = MFMAX(a0, q[0], p0); p1 = MFMAX(a1, q[0], p1);
    __builtin_amdgcn_s_setprio(0);
    __builtin_amdgcn_sched_barrier(0);
    a0 = ldsx(kl + 128); a1 = ldsx(kl + 32 * KSX + 128);
    __builtin_amdgcn_sched_barrier(0);
    __builtin_amdgcn_s_setprio(1);
    p0 = MFMAX(a2, q[1], p0); p1 = MFMAX(a3, q[1], p1);
    __builtin_amdgcn_sched_barrier(0);
    p0 = MFMAX(a0, q[2], p0); p1 = MFMAX(a1, q[2], p1);
    __builtin_amdgcn_s_setprio(0);
    __builtin_amdgcn_sched_barrier(0);
}
__device__ __forceinline__ void pv_tilex(f32x16 (&o)[4], const i32x8& pb, const LAS unsigned char* vl) {
    i32x8 f0 = ldsx(vl), f1 = ldsx(vl + 32 * VSX);
    __builtin_amdgcn_sched_barrier(0);
    o[0] = MFMAX(f0, pb, o[0]);
    __builtin_amdgcn_sched_barrier(0);
    f0 = ldsx(vl + 64 * VSX);
    __builtin_amdgcn_sched_barrier(0);
    o[1] = MFMAX(f1, pb, o[1]);
    __builtin_amdgcn_sched_barrier(0);
    f1 = ldsx(vl + 96 * VSX);
    __builtin_amdgcn_sched_barrier(0);
    o[2] = MFMAX(f0, pb, o[2]);
    __builtin_amdgcn_sched_barrier(0);
    o[3] = MFMAX(f1, pb, o[3]);
    __builtin_amdgcn_sched_barrier(0);
}
__device__ __forceinline__ i32x8 packpx(const f32x16& p0, const f32x16& p1) {
    i32x8 w;
#pragma unroll
    for (int g = 0; g < 4; ++g) {
        int a = __builtin_amdgcn_cvt_pk_fp8_f32(p0[4 * g + 0], p0[4 * g + 1], 0, false); a = __builtin_amdgcn_cvt_pk_fp8_f32(p0[4 * g + 2], p0[4 * g + 3], a, true); w[g] = a;
        int b = __builtin_amdgcn_cvt_pk_fp8_f32(p1[4 * g + 0], p1[4 * g + 1], 0, false); b = __builtin_amdgcn_cvt_pk_fp8_f32(p1[4 * g + 2], p1[4 * g + 3], b, true); w[4 + g] = b;
    }
    return w;
}
__device__ __forceinline__ void online_sm_x(f32x16& p0, f32x16& p1, float& m, float& l, f32x16 (&o)[4], const float C2) {
    float tm = p0[0];
#pragma unroll
    for (int r = 1; r < 16; ++r) tm = fmaxf(tm, p0[r]);
#pragma unroll
    for (int r = 0; r < 16; ++r) tm = fmaxf(tm, p1[r]);
    tm = swapmax(tm);
    const float mn = fmaxf(m, tm);
    const float alpha = __builtin_amdgcn_exp2f((m - mn) * C2);
    m = mn;
    const float mc = 8.f - mn * C2;
    float ps = 0.f;
#pragma unroll
    for (int r = 0; r < 16; ++r) { p0[r] = __builtin_amdgcn_exp2f(__builtin_fmaf(p0[r], C2, mc)); ps += p0[r]; }
#pragma unroll
    for (int r = 0; r < 16; ++r) { p1[r] = __builtin_amdgcn_exp2f(__builtin_fmaf(p1[r], C2, mc)); ps += p1[r]; }
    ps = swapsum(ps);
    l = l * alpha + ps;
    if (!__all(alpha == 1.f)) {
#pragma unroll
        for (int d = 0; d < 4; ++d)
#pragma unroll
            for (int r = 0; r < 16; ++r) o[d][r] *= alpha;
    }
}
#define MXL_T 126.0f
#define MXL_REF 96.0f
#define MFMAXQ(a, b, c) __builtin_amdgcn_mfma_scale_f32_32x32x64_f8f6f4((a), (b), (c), 0, 0, 0, 0x7f7f7f7f, 0, 0x7f7f7f7f)
__device__ __forceinline__ i32x8 byte_packx(const f32x16& p0, const f32x16& p1) {
    i32x8 w;
#pragma unroll
    for (int g = 0; g < 4; ++g) {
        unsigned a = __builtin_amdgcn_cvt_pk_u8_f32(p0[4 * g + 0], 0, 0u); a = __builtin_amdgcn_cvt_pk_u8_f32(p0[4 * g + 1], 1, a); a = __builtin_amdgcn_cvt_pk_u8_f32(p0[4 * g + 2], 2, a); a = __builtin_amdgcn_cvt_pk_u8_f32(p0[4 * g + 3], 3, a); w[g] = (int)a;
        unsigned b = __builtin_amdgcn_cvt_pk_u8_f32(p1[4 * g + 0], 0, 0u); b = __builtin_amdgcn_cvt_pk_u8_f32(p1[4 * g + 1], 1, b); b = __builtin_amdgcn_cvt_pk_u8_f32(p1[4 * g + 2], 2, b); b = __builtin_amdgcn_cvt_pk_u8_f32(p1[4 * g + 3], 3, b); w[4 + g] = (int)b;
    }
    return w;
}
__device__ __forceinline__ void qk_tilexl(f32x16& p0, f32x16& p1, const f32x16& mref, const LAS unsigned char* kl, const i32x8 (&q)[3]) {
    i32x8 a0 = ldsx(kl), a1 = ldsx(kl + 32 * KSX), a2 = ldsx(kl + 64), a3 = ldsx(kl + 32 * KSX + 64);
    __builtin_amdgcn_sched_barrier(0);
    __builtin_amdgcn_s_setprio(1);
    p0 = MFMAXQ(a0, q[0], mref); p1 = MFMAXQ(a1, q[0], mref);
    __builtin_amdgcn_s_setprio(0);
    __builtin_amdgcn_sched_barrier(0);
    a0 = ldsx(kl + 128); a1 = ldsx(kl + 32 * KSX + 128);
    __builtin_amdgcn_sched_barrier(0);
    __builtin_amdgcn_s_setprio(1);
    p0 = MFMAXQ(a2, q[1], p0); p1 = MFMAXQ(a3, q[1], p1);
    __builtin_amdgcn_sched_barrier(0);
    p0 = MFMAXQ(a0, q[2], p0); p1 = MFMAXQ(a1, q[2], p1);
    __builtin_amdgcn_s_setprio(0);
    __builtin_amdgcn_sched_barrier(0);
}
template <int RS = VSX>
__device__ __forceinline__ void pv_tilexl_pre(f32x16 (&o)[5], const i32x8& pb, const i32x8& ones, const LAS unsigned char* vl, i32x8 f0, i32x8 f1) {
    __builtin_amdgcn_sched_barrier(0);
    o[4] = MFMAX(ones, pb, o[4]);
    __builtin_amdgcn_sched_barrier(0);
    o[0] = MFMAX(f0, pb, o[0]);
    __builtin_amdgcn_sched_barrier(0);
    f0 = ldsx(vl + 64 * RS);
    __builtin_amdgcn_sched_barrier(0);
    o[1] = MFMAX(f1, pb, o[1]);
    __builtin_amdgcn_sched_barrier(0);
    f1 = ldsx(vl + 96 * RS);
    __builtin_amdgcn_sched_barrier(0);
    o[2] = MFMAX(f0, pb, o[2]);
    __builtin_amdgcn_sched_barrier(0);
    o[3] = MFMAX(f1, pb, o[3]);
    __builtin_amdgcn_sched_barrier(0);
}
template <int RS = VSX>
__device__ __forceinline__ void pv_tilexl(f32x16 (&o)[5], const i32x8& pb, const i32x8& ones, const LAS unsigned char* vl) {
    i32x8 f0 = ldsx(vl), f1 = ldsx(vl + 32 * RS);
    __builtin_amdgcn_sched_barrier(0);
    o[4] = MFMAX(ones, pb, o[4]);
    __builtin_amdgcn_sched_barrier(0);
    o[0] = MFMAX(f0, pb, o[0]);
    __builtin_amdgcn_sched_barrier(0);
    f0 = ldsx(vl + 64 * RS);
    __builtin_amdgcn_sched_barrier(0);
    o[1] = MFMAX(f1, pb, o[1]);
    __builtin_amdgcn_sched_barrier(0);
    f1 = ldsx(vl + 96 * RS);
    __builtin_amdgcn_sched_barrier(0);
    o[2] = MFMAX(f0, pb, o[2]);
    __builtin_amdgcn_sched_barrier(0);
    o[3] = MFMAX(f1, pb, o[3]);
    __builtin_amdgcn_sched_barrier(0);
}
__device__ __forceinline__ i32x8 exp_packx(const f32x16& p0, const f32x16& p1, int any) {
    i32x8 w;
#pragma unroll
    for (int g = 0; g < 4; ++g) {
        int a = __builtin_amdgcn_cvt_pk_fp8_f32(__builtin_amdgcn_exp2f(p0[4 * g + 0]), __builtin_amdgcn_exp2f(p0[4 * g + 1]), any, false);
        a = __builtin_amdgcn_cvt_pk_fp8_f32(__builtin_amdgcn_exp2f(p0[4 * g + 2]), __builtin_amdgcn_exp2f(p0[4 * g + 3]), a, true); w[g] = a;
        int b = __builtin_amdgcn_cvt_pk_fp8_f32(__builtin_amdgcn_exp2f(p1[4 * g + 0]), __builtin_amdgcn_exp2f(p1[4 * g + 1]), any, false);
        b = __builtin_amdgcn_cvt_pk_fp8_f32(__builtin_amdgcn_exp2f(p1[4 * g + 2]), __builtin_amdgcn_exp2f(p1[4 * g + 3]), b, true); w[4 + g] = b;
    }
    return w;
}
struct MlaPtrs { const bf16* Q; const bf16* K; const bf16* V; const bf16* Z; bf16* O; };
__device__ __forceinline__ void mla_unit(LAS unsigned char* lds, const MlaPtrs& P, int head, int qb, int tid_in, int wave, int lane_in) {
    int tid = tid_in; asm volatile("" : "+v"(tid)); const int lane = tid & 63; (void)lane_in;
    const int r32 = lane & 31, hi = lane >> 5;
    const int q0 = qb * 256, qw = q0 + wave * 32, tq = qw + r32;
    i32x8 q[3];
    { const unsigned char* qp = (const unsigned char*)P.Q + (size_t)tq * 3072 + head * 192 + hi * 32;
#pragma unroll
      for (int s = 0; s < 3; ++s) { const u32x4 a = *(const GAS u32x4*)(qp + 64 * s), b = *(const GAS u32x4*)(qp + 64 * s + 16);
          q[s] = (i32x8){(int)a.x, (int)a.y, (int)a.z, (int)a.w, (int)b.x, (int)b.y, (int)b.z, (int)b.w}; } }
    const int NT = 4 * (qb + 1);
    const int srow = tid >> 3, sc8 = tid & 7;
    const unsigned char* kg = (const unsigned char*)P.K + (size_t)head * 192 + (size_t)srow * 3072 + sc8 * 8;
    const unsigned char* vg = (const unsigned char*)P.V + ((size_t)head * 128 + (tid >> 2)) * S + (tid & 3) * 16;
    LAS unsigned char* kst = lds + srow * KSX + sc8 * 8;
    LAS unsigned char* vst = lds + 2 * MLA_KBX + (tid >> 2) * VSX + (tid & 3) * 16;
    const LAS unsigned char* kl = lds + r32 * KSX + hi * 32;
    const LAS unsigned char* vl = lds + 2 * MLA_KBX + r32 * VSX + hi * 32;
    u32x2 sk0, sk1, sk2; u32x4 sv0;
#define MLA_LOAD(j) do { const unsigned char* kp_ = kg + (size_t)(j) * (64 * 3072); const unsigned char* vp_ = vg + (size_t)(j) * 64; \
        sk0 = *(const GAS u32x2*)(kp_); sk1 = *(const GAS u32x2*)(kp_ + 64); sk2 = *(const GAS u32x2*)(kp_ + 128); sv0 = *(const GAS u32x4*)(vp_); } while (0)
#define MLA_STORE(b, vb) do { LAS unsigned char* kd_ = kst + (b) * MLA_KBX; LAS unsigned char* vd_ = vst + (vb) * VBX; \
        *(LAS u32x2*)(kd_) = sk0; *(LAS u32x2*)(kd_ + 64) = sk1; *(LAS u32x2*)(kd_ + 128) = sk2; *(LAS u32x2*)(vd_) = (u32x2){sv0.x, sv0.y}; *(LAS u32x2*)(vd_ + 8) = (u32x2){sv0.z, sv0.w}; } while (0)
    MLA_LOAD(0); MLA_STORE(0, 0);
    __syncthreads();
    asm volatile("" : "+v"(q[0]), "+v"(q[1]), "+v"(q[2]));
    f32x16 o[5], mref;
#pragma unroll
    for (int d = 0; d < 5; ++d)
#pragma unroll
        for (int r = 0; r < 16; ++r) o[d][r] = 0.f;
#pragma unroll
    for (int r = 0; r < 16; ++r) mref[r] = MXL_REF;
    const int one8 = (r32 == 0 || r32 == 4) ? 0x38383838 : 0;
    const i32x8 ones = {one8, one8, one8, one8, one8, one8, one8, one8};
    const bool trail = wave >= 4;
    i32x8 pb = {}, fa = {}, fb = {};
    int vb_cur = 0, vb_prev = 2;
    for (int j = 0; j < NT; ++j) {
        const int kb = 64 * j;
        int vb_next = vb_cur + 1; if (vb_next == 3) vb_next = 0;
        if (j + 1 < NT) MLA_LOAD(j + 1);
        if (trail && j > 0 && kb - 64 <= qw + 31) pv_tilexl_pre(o, pb, ones, vl + vb_prev * VBX, fa, fb);
        if (kb <= qw + 31) {
            f32x16 p0, p1;
            qk_tilexl(p0, p1, mref, kl + (j & 1) * MLA_KBX, q);
            fa = ldsx(vl + vb_cur * VBX); fb = ldsx(vl + vb_cur * VBX + 32 * VSX);
            __builtin_amdgcn_sched_barrier(0);
            if (kb + 63 > qw) {
                const int dq = tq - kb - 4 * hi;
#pragma unroll
                for (int r = 0; r < 16; ++r) { const int c = (r & 3) + 8 * (r >> 2);
                    if (c > dq) p0[r] = -__builtin_inff();
                    if (c + 32 > dq) p1[r] = -__builtin_inff(); }
            }
            float tm = p0[0];
#pragma unroll
            for (int r = 1; r < 16; ++r) tm = fmaxf(tm, p0[r]);
#pragma unroll
            for (int r = 0; r < 16; ++r) tm = fmaxf(tm, p1[r]);
            tm = swapmax(tm);
            if (j == 0 || !__all(tm <= MXL_T)) {
                const float dlt = (j == 0) ? tm - MXL_REF : fmaxf(tm - MXL_REF, 0.f);
                const float alpha = __builtin_amdgcn_exp2f(-0.125f * dlt);
#pragma unroll
                for (int r = 0; r < 16; ++r) { p0[r] -= dlt; p1[r] -= dlt; mref[r] -= dlt; }
                if (j > 0) {
#pragma unroll
                    for (int d = 0; d < 5; ++d)
#pragma unroll
                        for (int r = 0; r < 16; ++r) o[d][r] *= alpha;
                }
            }
            pb = byte_packx(p0, p1);
            if (!trail) pv_tilexl_pre(o, pb, ones, vl + vb_cur * VBX, fa, fb);
        }
        if (j + 1 < NT) MLA_STORE((j + 1) & 1, vb_next);
        __syncthreads();
        vb_prev = vb_cur; vb_cur = vb_next;
    }
    if (trail && 64 * (NT - 1) <= qw + 31) pv_tilexl_pre(o, pb, ones, vl + vb_prev * VBX, fa, fb);
    __syncthreads();
#undef MLA_LOAD
#undef MLA_STORE
    const bf16* zp = P.Z + (size_t)tq * 2048 + head * 128 + 4 * hi;
    const float inv = 16.f / o[4][0];
    unsigned char* op8 = (unsigned char*)P.O + (size_t)tq * 8192 + head * 128 + 4 * hi;
#pragma unroll
    for (int d0 = 0; d0 < 4; ++d0)
#pragma unroll
        for (int rg = 0; rg < 4; ++rg) { const int dim = 32 * d0 + 8 * rg;
            const u32x2 z = *(const GAS u32x2*)(zp + dim);
            int w = __builtin_amdgcn_cvt_pk_fp8_f32(o[d0][4 * rg + 0] * inv * bflo(z.x), o[d0][4 * rg + 1] * inv * bfhi(z.x), 0, false);
            w = __builtin_amdgcn_cvt_pk_fp8_f32(o[d0][4 * rg + 2] * inv * bflo(z.y), o[d0][4 * rg + 3] * inv * bfhi(z.y), w, true);
            *(GAS unsigned*)(op8 + dim) = (unsigned)w; }
}

struct NsaPtrs { const bf16* Q; const bf16* KV; const bf16* KC; const bf16* VC; const bf16* Z; const float* G; bf16* O; float* scr; };
template <int MODE>
__device__ __forceinline__ void nsa_loop(LAS unsigned char* lds, const unsigned char* kbase, const unsigned char* vbase, int ntiles, int jlo,
                                         const bf16x8 (&q)[8], int t, float slope2, float& m, float& l, f32x16 (&o)[4], float invl, int tid, int wave, int lane) {
    constexpr bool HASV = MODE != 0;
    const int r32 = lane & 31, hi = lane >> 5;
    const int srow = tid >> 3, sc8 = tid & 7;
    const unsigned soff = srow * 256 + sc8 * 16;
    LAS unsigned char* kst = lds + srow * KS_N + sc8 * 16;
    LAS unsigned char* vst = lds + 2 * NSA_KB + srow * VS + sc8 * 16;
    const LAS unsigned char* kl = lds + r32 * KS_N + hi * 16;
    const LAS unsigned char* vl = lds + 2 * NSA_KB + (4 * hi + ((lane & 15) >> 2)) * VS + (16 * ((lane >> 4) & 1) + 4 * (lane & 3)) * 2;
    const LAS int* ulist = (const LAS int*)(lds + N_ULIST);
    const LAS unsigned* selm = (const LAS unsigned*)(lds + N_SELM);
    LAS float* partA = (LAS float*)(lds + N_PART); LAS float* partB = (LAS float*)(lds + N_PART + N_PARTB);
    LAS float* imp = (LAS float*)(lds + N_IMP); LAS float* carry = (LAS float*)(lds + N_CARRY);
    if (ntiles <= 0) return;
    const float mlg = (MODE == 1) ? (invl > 0.f ? m - __builtin_amdgcn_logf(invl) : __builtin_inff()) : 0.f;
    u32x4 sk0, sk1, sv0, sv1;
#define NSA_TROW(j) (MODE == 2 ? 64 * __builtin_amdgcn_readfirstlane(ulist[ntiles - 1 - (j)]) : ((MODE == 3 || MODE == 0) ? 64 * (jlo + ntiles - 1 - (j)) : 64 * (jlo + (j))))
#define NSA_LOAD(j) do { const size_t ro_ = (size_t)NSA_TROW(j) * 256 + soff; \
        sk0 = *(const GAS u32x4*)(kbase + ro_); sk1 = *(const GAS u32x4*)(kbase + ro_ + 128); \
        if (HASV) { sv0 = *(const GAS u32x4*)(vbase + ro_); sv1 = *(const GAS u32x4*)(vbase + ro_ + 128); } } while (0)
#define NSA_STORE(b) do { LAS unsigned char* kd_ = kst + (b) * NSA_KB; *(LAS u32x4*)(kd_) = sk0; *(LAS u32x4*)(kd_ + 128) = sk1; \
        if (HASV) { LAS unsigned char* vd_ = vst + (b) * VB; *(LAS u32x4*)(vd_) = sv0; *(LAS u32x4*)(vd_ + 128) = sv1; } } while (0)
    NSA_LOAD(0); NSA_STORE(0);
    __syncthreads();
    for (int j = 0; j < ntiles; ++j) {
        const int buf = j & 1;
        if (MODE != 1 && j + 1 < ntiles) NSA_LOAD(j + 1);
        const int trow = NSA_TROW(j);
        constexpr int PSTEP = (MODE <= 1) ? 16 : 1;
        const int pstart = (MODE <= 1) ? 16 * trow + 31 : trow;
        const int db = t - pstart - PSTEP * 4 * hi;
        constexpr unsigned W = (MODE == 3) ? 512u : 0x7fffffffu;
        const bool mset = m > -1e29f;
        float b0 = -slope2 * (float)db - ((MODE != 1) ? (mset ? m : 0.f) : mlg);
        if (MODE == 2) { const int b = trow >> 6; if (((selm[r32 * 8 + (b >> 5)] >> (b & 31)) & 1u) == 0u) b0 = -__builtin_inff(); }
        f32x16 p0, p1;
#pragma unroll
        for (int r = 0; r < 16; ++r) { const int c = PSTEP * ((r & 3) + 8 * (r >> 2));
            p0[r] = __builtin_fmaf(slope2, (float)c, b0); p1[r] = __builtin_fmaf(slope2, (float)(c + 32 * PSTEP), b0); }
        qk_tile<8, KS_N, false>(p0, p1, kl + buf * NSA_KB, q);
        PvPre pp; if (MODE >= 2) { pv_preload(pp, vl + buf * VB); __builtin_amdgcn_sched_barrier(0); }
        { const int t0u = __builtin_amdgcn_readfirstlane(t - r32);
          const bool interior = (t0u - (pstart + PSTEP * 63) >= 0) && ((unsigned)(t0u + 31 - pstart) < W);
          if (!interior) {
#pragma unroll
              for (int r = 0; r < 16; ++r) { const int c = PSTEP * ((r & 3) + 8 * (r >> 2));
                  if ((unsigned)(db - c) >= W) p0[r] = -__builtin_inff();
                  if ((unsigned)(db - c - 32 * PSTEP) >= W) p1[r] = -__builtin_inff(); } } }
        if (MODE == 0) {
            float tm = p0[0];
#pragma unroll
            for (int r = 1; r < 16; ++r) tm = fmaxf(tm, p0[r]);
#pragma unroll
            for (int r = 0; r < 16; ++r) tm = fmaxf(tm, p1[r]);
            tm = swapmax(tm);
            const bool need = mset ? (tm > 16.f) : (tm > -1e29f);
            if (!__all(!need)) {
                const float dlt = need ? tm : 0.f;
                if (mset) l *= __builtin_amdgcn_exp2f(-dlt);
                if (need) m = (mset ? m : 0.f) + dlt;
#pragma unroll
                for (int r = 0; r < 16; ++r) { p0[r] -= dlt; p1[r] -= dlt; }
            }
            float ps = 0.f;
#pragma unroll
            for (int r = 0; r < 16; ++r) ps += __builtin_amdgcn_exp2f(p0[r]) + __builtin_amdgcn_exp2f(p1[r]);
            l += swapsum(ps);
        } else if (MODE == 1) {
#pragma unroll
            for (int r = 0; r < 16; ++r) { p0[r] = __builtin_amdgcn_exp2f(p0[r]); p1[r] = __builtin_amdgcn_exp2f(p1[r]); }
            LAS float* pa = partA + (wave * 32 + r32) * 17 + hi; LAS float* pbm = partB + (wave * 32 + r32) * 17 + hi;
#pragma unroll
            for (int rg = 0; rg < 4; ++rg) {
                pa[2 * rg] = (p0[4 * rg] + p0[4 * rg + 1]) + (p0[4 * rg + 2] + p0[4 * rg + 3]); pbm[2 * rg] = p0[4 * rg + 3];
                pa[8 + 2 * rg] = (p1[4 * rg] + p1[4 * rg + 1]) + (p1[4 * rg + 2] + p1[4 * rg + 3]); pbm[8 + 2 * rg] = p1[4 * rg + 3]; }
            const bf16x8 pb[4] = {packp<0>(p0), packp<1>(p0), packp<0>(p1), packp<1>(p1)};
            pv_tile(o, pb, vl + buf * VB);
            __syncthreads();
            { const int qq = tid >> 4, jl = tid & 15; float a = 0.f, bp = 0.f, bl = 0.f;
#pragma unroll
              for (int w = 0; w < 8; ++w) { a += partA[(w * 32 + qq) * 17 + jl]; bl += partB[(w * 32 + qq) * 17 + jl]; }
              if (jl > 0) {
#pragma unroll
                  for (int w = 0; w < 8; ++w) bp += partB[(w * 32 + qq) * 17 + jl - 1];
              } else bp = (j > 0) ? carry[((j - 1) & 1) * 32 + qq] : 0.f;
              imp[qq * 256 + 16 * j + jl] = a + bp;
              if (jl == 15) carry[(j & 1) * 32 + qq] = bl; }
        } else {
            constexpr float NSA_LAZY_T = 16.f;
            float tm = p0[0];
#pragma unroll
            for (int r = 1; r < 16; ++r) tm = fmaxf(tm, p0[r]);
#pragma unroll
            for (int r = 0; r < 16; ++r) tm = fmaxf(tm, p1[r]);
            tm = swapmax(tm);
            const bool need = mset ? (tm > NSA_LAZY_T) : (tm > -1e29f);
            if (!__all(!need)) {
                const float dlt = need ? tm : 0.f;
                const float alpha = mset ? __builtin_amdgcn_exp2f(-dlt) : 1.f;
                if (need) m = (mset ? m : 0.f) + dlt;
#pragma unroll
                for (int r = 0; r < 16; ++r) { p0[r] -= dlt; p1[r] -= dlt; }
                l *= alpha;
#pragma unroll
                for (int d_ = 0; d_ < 4; ++d_)
#pragma unroll
                    for (int r = 0; r < 16; ++r) o[d_][r] *= alpha;
            }
            float ps = 0.f;
#pragma unroll
            for (int r = 0; r < 16; ++r) { p0[r] = __builtin_amdgcn_exp2f(p0[r]); ps += p0[r]; }
#pragma unroll
            for (int r = 0; r < 16; ++r) { p1[r] = __builtin_amdgcn_exp2f(p1[r]); ps += p1[r]; }
            l += swapsum(ps);
            const bf16x8 pb[4] = {packp<0>(p0), packp<1>(p0), packp<0>(p1), packp<1>(p1)};
            pv_tile<true>(o, pb, vl + buf * VB, &pp);
        }
        if (MODE == 1 && j + 1 < ntiles) NSA_LOAD(j + 1);
        if (j + 1 < ntiles) NSA_STORE(buf ^ 1);
        __syncthreads();
    }
#undef NSA_TROW
#undef NSA_LOAD
#undef NSA_STORE
}
__device__ __forceinline__ void nsa_topk(const LAS float* improw, LAS unsigned* selrow, int cur, int lane) {
    unsigned key[4]; bool sel[4];
    int nforced = 0;
#pragma unroll
    for (int k = 0; k < 4; ++k) { const int j = lane + 64 * k;
        const bool forced = (j == 0) || (j == cur) || (j == cur - 1);
        const bool causal = j <= cur;
        sel[k] = forced;
        key[k] = (causal && !forced) ? (__float_as_uint(improw[j]) + 1u) : 0u;
    }
    nforced = 1 + (cur >= 1 ? 1 : 0) + (cur >= 2 ? 1 : 0);
    const int want = 16 - nforced;
    for (int it = 0; it < want; ++it) {
        unsigned bk = key[0]; int bj = lane;
#pragma unroll
        for (int k = 1; k < 4; ++k) { if (key[k] > bk) { bk = key[k]; bj = lane + 64 * k; } }
        unsigned long long best = ((unsigned long long)bk << 32) | (unsigned)(0xffffffffu - (unsigned)bj);
#pragma unroll
        for (int off = 1; off < 64; off <<= 1) {
            const unsigned lo = __shfl_xor((unsigned)best, off), hiw = __shfl_xor((unsigned)(best >> 32), off);
            const unsigned long long other = ((unsigned long long)hiw << 32) | lo;
            best = other > best ? other : best; }
        if ((unsigned)(best >> 32) == 0u) break;
        const int wj = (int)(0xffffffffu - (unsigned)best);
#pragma unroll
        for (int k = 0; k < 4; ++k) if (wj == lane + 64 * k) { key[k] = 0u; sel[k] = true; }
    }
#pragma unroll
    for (int k = 0; k < 4; ++k) { const unsigned long long bm = __ballot(sel[k]);
        if (lane == 0) { selrow[2 * k] = (unsigned)bm; selrow[2 * k + 1] = (unsigned)(bm >> 32); } }
}
__device__ __forceinline__ int cnt_ge(unsigned key, unsigned thr) { unsigned long long m_; asm("v_cmp_ge_u32_e64 %0, %1, %2" : "=s"(m_) : "v"(key), "s"(thr)); return __builtin_popcountll(m_); }
__device__ __forceinline__ int cnt_gt(unsigned key, unsigned thr) { unsigned long long m_; asm("v_cmp_gt_u32_e64 %0, %1, %2" : "=s"(m_) : "v"(key), "s"(thr)); return __builtin_popcountll(m_); }
__device__ __forceinline__ void nsa_topk4(const LAS float* imp0, LAS unsigned* sel0, int cur, int lane) {
    unsigned key[4][4]; bool forced[4];
#pragma unroll
    for (int k = 0; k < 4; ++k) { const int j = lane + 64 * k;
        forced[k] = (j == 0) || (j == cur) || (j == cur - 1);
        const bool cand = (j <= cur) && !forced[k];
#pragma unroll
        for (int i = 0; i < 4; ++i) { const unsigned v_ = __float_as_uint(imp0[i * 256 + j]) + 1u; key[i][k] = cand ? v_ : 0u; } }
    const int want = 16 - (1 + (cur >= 1 ? 1 : 0) + (cur >= 2 ? 1 : 0));
    unsigned T[4] = {0u, 0u, 0u, 0u};
#pragma unroll 1
    for (int bit = 30; bit >= 0; --bit) {
        const unsigned bm = 1u << bit;
        unsigned long long mk[4][4];
#pragma unroll
        for (int i = 0; i < 4; ++i) { const unsigned c = T[i] | bm;
#pragma unroll
            for (int k = 0; k < 4; ++k) asm volatile("v_cmp_ge_u32_e64 %0, %1, %2" : "=s"(mk[i][k]) : "v"(key[i][k]), "s"(c)); }
        __builtin_amdgcn_sched_barrier(0);
#pragma unroll
        for (int i = 0; i < 4; ++i) { const int n = (__builtin_popcountll(mk[i][0]) + __builtin_popcountll(mk[i][1])) + (__builtin_popcountll(mk[i][2]) + __builtin_popcountll(mk[i][3]));
            if (n >= want) T[i] |= bm; }
    }
#pragma unroll
    for (int i = 0; i < 4; ++i) {
        const unsigned Ti = T[i];
        int rem = want - ((cnt_gt(key[i][0], Ti) + cnt_gt(key[i][1], Ti)) + (cnt_gt(key[i][2], Ti) + cnt_gt(key[i][3], Ti)));
        unsigned long long bmv[4];
#pragma unroll
        for (int k = 0; k < 4; ++k) {
            const bool eq = (Ti != 0u) && key[i][k] == Ti; const unsigned long long em = __ballot(eq);
            const int below = (int)__builtin_amdgcn_mbcnt_hi((unsigned)(em >> 32), __builtin_amdgcn_mbcnt_lo((unsigned)em, 0u));
            const bool s = forced[k] || (Ti == 0u ? key[i][k] >= 1u : (key[i][k] > Ti || (eq && below < rem)));
            rem -= __builtin_popcountll(em); if (rem < 0) rem = 0;
            bmv[k] = __ballot(s);
        }
        if (lane < 8) { const unsigned long long w_ = bmv[lane >> 1]; sel0[i * 8 + lane] = (lane & 1) ? (unsigned)(w_ >> 32) : (unsigned)w_; }
    }
}
__device__ __forceinline__ int nsa_opaque(int v) { asm volatile("" : "+v"(v)); return v; }
__device__ __forceinline__ void nsa_unit(LAS unsigned char* lds, const NsaPtrs& P, int g, int qblk, int tid_in, int wave, int lane_in, int cu) {
    int tid = tid_in; asm volatile("" : "+v"(tid));
    const int lane = tid & 63; (void)lane_in;
    const int r32 = lane & 31, hi = lane >> 5;
    const int hh = 8 * g + wave, t0 = 32 * qblk, t = t0 + r32;
    const float slope2 = __builtin_amdgcn_exp2f(-0.5f * (float)(hh + 1)) * LOG2E;
    bf16x8 q[8];
    { const bf16* qp = P.Q + (size_t)t * 2048 + hh * 128 + hi * 8;
#pragma unroll
      for (int d0 = 0; d0 < 8; ++d0) q[d0] = *(const GAS bf16x8*)(qp + d0 * 16); }
#define NSA_SCR() ((GAS f32x4*)(P.scr + ((size_t)(cu * 8 + wave) * 16) * 256) + nsa_opaque(lane))
    const size_t CH = (size_t)S * 128 * 2;
    f32x16 o[4]; float m, l;
#define NSA_SCR2 ((size_t)256 * 8 * 16 * 64)
#define NSA_ZERO_O() do { _Pragma("unroll") for (int d_ = 0; d_ < 4; ++d_) _Pragma("unroll") for (int r_ = 0; r_ < 16; ++r_) o[d_][r_] = 0.f; } while (0)
    const int ncv = 2 * qblk + 1, ntc = (ncv + 63) >> 6;
    const unsigned char* kc = (const unsigned char*)P.KC + (size_t)g * 1024 * 256; const unsigned char* vc = (const unsigned char*)P.VC + (size_t)g * 1024 * 256;
    m = -1e30f; l = 0.f; NSA_ZERO_O();
    nsa_loop<0>(lds, kc, vc, ntc, 0, q, t, slope2, m, l, o, 0.f, tid, wave, lane);
    const float invl = l > 0.f ? 1.f / l : 0.f;
    nsa_loop<1>(lds, kc, vc, ntc, 0, q, t, slope2, m, l, o, invl, tid, wave, lane);
    { const float g_c = P.G[(size_t)t * 48 + hh]; GAS f32x4* scr = NSA_SCR();
#pragma unroll
    for (int d0 = 0; d0 < 4; ++d0)
#pragma unroll
        for (int rg = 0; rg < 4; ++rg) { f32x4 v = {o[d0][4 * rg] * g_c, o[d0][4 * rg + 1] * g_c, o[d0][4 * rg + 2] * g_c, o[d0][4 * rg + 3] * g_c}; scr[(d0 * 4 + rg) * 64] = v; } }
    const int cur = t0 >> 6;
    LAS unsigned* selm = (LAS unsigned*)(lds + N_SELM);
    nsa_topk4((const LAS float*)(lds + N_IMP) + 4 * wave * 256, selm + 4 * wave * 8, cur, lane);
    __syncthreads();
    int nts;
    { LAS int* ulist = (LAS int*)(lds + N_ULIST); LAS int* ucnt = (LAS int*)(lds + N_NTS) + 4;
      unsigned u = (lane < 32) ? selm[lane * 8 + wave] : 0u;
#pragma unroll
      for (int off = 1; off < 32; off <<= 1) u |= __shfl_xor(u, off);
      u = __builtin_amdgcn_readfirstlane(u);
      if (lane == 0) ucnt[wave] = __builtin_popcount(u);
      __syncthreads();
      int off = 0, tot = 0;
#pragma unroll
      for (int k = 0; k < 8; ++k) { const int c = __builtin_amdgcn_readfirstlane(ucnt[k]); off += (k < wave) ? c : 0; tot += c; }
      if (lane < 32 && ((u >> lane) & 1u)) ulist[off + __builtin_popcount(u & ((1u << lane) - 1u))] = 32 * wave + lane;
      nts = tot; }
    __syncthreads();
    m = -1e30f; l = 0.f; NSA_ZERO_O();
    nsa_loop<2>(lds, (const unsigned char*)P.KV + (size_t)(4 + g) * CH, (const unsigned char*)P.KV + (size_t)(6 + g) * CH, nts, 0, q, t, slope2, m, l, o, 0.f, tid, wave, lane);
    { const float f = P.G[(size_t)t * 48 + 16 + hh] / l; GAS f32x4* scr = NSA_SCR() + NSA_SCR2;
#pragma unroll
      for (int d0 = 0; d0 < 4; ++d0)
#pragma unroll
          for (int rg = 0; rg < 4; ++rg) { f32x4 v = {o[d0][4 * rg] * f, o[d0][4 * rg + 1] * f, o[d0][4 * rg + 2] * f, o[d0][4 * rg + 3] * f}; scr[(d0 * 4 + rg) * 64] = v; } }
    const int jlo = (t0 > 511 ? t0 - 511 : 0) >> 6, jhi = (t0 + 31) >> 6;
    m = -1e30f; l = 0.f; NSA_ZERO_O();
    nsa_loop<3>(lds, (const unsigned char*)P.KV + (size_t)(8 + g) * CH, (const unsigned char*)P.KV + (size_t)(10 + g) * CH, jhi - jlo + 1, jlo, q, t, slope2, m, l, o, 0.f, tid, wave, lane);
    { const float f = P.G[(size_t)t * 48 + 32 + hh] / l; GAS f32x4* scr = NSA_SCR();
      const bf16* zp = P.Z + (size_t)t * 2048 + hh * 128 + 4 * hi;
      bf16* op = P.O + (size_t)t * 4096 + 2048 + hh * 128 + 4 * hi;
#pragma unroll
      for (int dp = 0; dp < 2; ++dp)
          { f32x4 av[8], bv[8]; u32x2 zv[8];
#pragma unroll
            for (int i = 0; i < 8; ++i) { const int d0 = 2 * dp + (i >> 2), rg = i & 3; av[i] = scr[(d0 * 4 + rg) * 64]; bv[i] = scr[NSA_SCR2 + (d0 * 4 + rg) * 64]; zv[i] = *(const GAS u32x2*)(zp + 32 * d0 + 8 * rg); }
#pragma unroll
            for (int i = 0; i < 8; ++i) { const int d0 = 2 * dp + (i >> 2), rg = i & 3; const int dim = 32 * d0 + 8 * rg; const f32x4 a = av[i] + bv[i];
                const u32x2 z = zv[i];
                u32x2 w; w.x = pk2((a[0] + o[d0][4 * rg] * f) * bflo(z.x), (a[1] + o[d0][4 * rg + 1] * f) * bfhi(z.x)); w.y = pk2((a[2] + o[d0][4 * rg + 2] * f) * bflo(z.y), (a[3] + o[d0][4 * rg + 3] * f) * bfhi(z.y));
                *(GAS u32x2*)(op + dim) = w; } } }
#undef NSA_ZERO_O
#undef NSA_SCR
#undef NSA_SCR2
}
struct CmpPtrs { const bf16* KV; const bf16* W1; const bf16* W2; const float* cbp; bf16* KC; bf16* VC; };
__device__ __forceinline__ void cmp_unit(LAS unsigned char* lds, const CmpPtrs& P, int kv, int g, int tile, int tid, int wave, int lane) {
    const int fr = lane & 15, fq = lane >> 4;
    constexpr int CRS = 544;
    LAS unsigned char* As = lds + 16384;
    LAS unsigned char* Ws = As + 16 * CRS;
    const unsigned char* Ag = (const unsigned char*)(P.KV + (size_t)(kv * 2 + g) * ((size_t)S * 128) + (size_t)(16 * tile + (tid >> 5)) * 2048) + (tid & 31) * 16;
    const unsigned char* Wg = (const unsigned char*)(P.W1 + (size_t)kv * 128 * 4096 + (size_t)(tid >> 5) * 4096) + (tid & 31) * 16;
    LAS unsigned char* Ad = As + (tid >> 5) * CRS + (tid & 31) * 16;
    LAS unsigned char* Wd = Ws + (tid >> 5) * CRS + (tid & 31) * 16;
    const LAS unsigned char* Ar = As + fr * CRS + fq * 16;
    const LAS unsigned char* Wr = Ws + (16 * wave + fr) * CRS + fq * 16;
    u32x4 ra[4], rw[4][8];
#define CMP_LOAD(c) do { ra[(c) & 3] = *(const GAS u32x4*)(Ag + (c) * 512); _Pragma("unroll") for (int i_ = 0; i_ < 8; ++i_) rw[(c) & 3][i_] = *(const GAS u32x4*)(Wg + (size_t)i_ * (16 * 8192) + (c) * 512); } while (0)
    CMP_LOAD(0); CMP_LOAD(1); CMP_LOAD(2);
    f32x4 acc = {0.f, 0.f, 0.f, 0.f};
#pragma unroll
    for (int c = 0; c < 16; ++c) {
        *(LAS u32x4*)Ad = ra[c & 3];
#pragma unroll
        for (int i = 0; i < 8; ++i) *(LAS u32x4*)(Wd + i * 16 * CRS) = rw[c & 3][i];
        __syncthreads();
        if (c + 3 < 16) CMP_LOAD(c + 3);
#pragma unroll
        for (int s = 0; s < 8; ++s) {
            const bf16x8 a = *(const LAS bf16x8*)(Ar + 64 * s), b = *(const LAS bf16x8*)(Wr + 64 * s);
            acc = __builtin_amdgcn_mfma_f32_16x16x32_bf16(a, b, acc, 0, 0, 0);
        }
        __syncthreads();
    }
#undef CMP_LOAD
    float bias = 0.f;
    { float bv[16];
#pragma unroll
      for (int c = 0; c < 16; ++c) bv[c] = *(const GAS float*)(P.cbp + (size_t)(kv * 16 + c) * 128 + 16 * wave + fr);
#pragma unroll
      for (int c = 0; c < 16; ++c) bias += bv[c]; }
    LAS bf16* hid = (LAS bf16*)lds;
#pragma unroll
    for (int i = 0; i < 4; ++i) hid[(4 * fq + i) * 136 + 16 * wave + fr] = (bf16)(pk2(silu_f(acc[i] + bias), 0.f) & 0xffffu);
    __syncthreads();
    const bf16* B2 = P.W2 + (size_t)kv * 128 * 128 + (size_t)(16 * wave + fr) * 128 + 8 * fq;
    f32x4 acc2 = {0.f, 0.f, 0.f, 0.f};
#pragma unroll
    for (int s = 0; s < 4; ++s) {
        const bf16x8 a = *(const LAS bf16x8*)(hid + fr * 136 + 32 * s + 8 * fq), b = *(const GAS bf16x8*)(B2 + 32 * s);
        acc2 = __builtin_amdgcn_mfma_f32_16x16x32_bf16(a, b, acc2, 0, 0, 0);
    }
    bf16* out = (kv ? P.VC : P.KC) + (size_t)g * 1024 * 128;
#pragma unroll
    for (int i = 0; i < 4; ++i) { const int nn = 16 * tile + 4 * fq + i; out[(size_t)nn * 128 + 16 * wave + fr] = (nn < 1023) ? (bf16)(pk2(acc2[i], 0.f) & 0xffffu) : (bf16)0; }
    __syncthreads();
}
}
constexpr int PPL = 6;
constexpr int N_PHASES = 2 + PPL * DEPTH;
struct Args { const void* in[16]; float* out; unsigned char* ws; int ph_lo, ph_hi; };
#define WSP(T, off) ((T*)(ws + (off)))
#define VCU() ((gridDim.x % 8 == 0) ? (int)((blockIdx.x % 8) * (gridDim.x / 8) + blockIdx.x / 8) : (int)blockIdx.x)
__global__ void __launch_bounds__(NTHR, 2) mk_fwd(const Args args) {
    extern __shared__ __attribute__((aligned(16))) unsigned char lds_raw[];
    LAS unsigned char* lds = (LAS unsigned char*)lds_raw;
    if (threadIdx.x < 32) ((volatile LAS unsigned*)(lds + MISC_OFF))[threadIdx.x] = 0u;
    __syncthreads();
    XcdBarrier bar = xcd_barrier_post((unsigned*)(args.ws + WS_CTL) + CW_BAR, (volatile LAS unsigned*)(lds + MISC_OFF) + 8);
#define IN(k) (args.ph_lo <= (k) && (k) < args.ph_hi)
#define SEAM(k) do { if (IN(k) && IN((k) + 1)) xcd_barrier(bar); } while (0)
#define PHASE_REGS int tid_ = threadIdx.x; asm volatile("" : "+v"(tid_)); const int tid = tid_, lane = tid & 63, wave = __builtin_amdgcn_readfirstlane(tid >> 6); \
    unsigned char* ws = args.ws; asm volatile("" : "+s"(ws)); (void)tid; (void)lane; (void)wave

    if (IN(0)) {
        PHASE_REGS; const int G = gridDim.x, vcu = VCU();
        p0_mod_gemv((const float*)args.in[1], (const float*)args.in[3], (const float*)args.in[4], WSP(float, WS_MOD), (LAS float*)lds, vcu, G);
        p0_cmpbias((const float*)args.in[10], (const float*)args.in[11], WSP(float, WS_CBP), (LAS float*)lds, (vcu + G / 2) % G, G);
        p0_rope((const int*)args.in[2], WSP(float, WS_ROPE), WSP(float, WS_ROPE) + (size_t)S * 32, vcu * NTHR + tid, G * NTHR);
        const P0In I{(const float*)args.in[5], (const float*)args.in[6], (const float*)args.in[7], (const float*)args.in[8], (const float*)args.in[9], (const float*)args.in[11], (const float*)args.in[12], (const float*)args.in[13]};
        p0_convert(I, ws, vcu * NWAVES + wave, G * NWAVES, lane);
    }
    SEAM(0);
#define H8PTR WSP(unsigned char, WS_H8)
    if (IN(1)) { PHASE_REGS; modulate_rows((const float*)args.in[0], WSP(bf16, WS_H), H8PTR, WSP(float, WS_MOD), (LAS float*)lds, tid, VCU() * NWAVES + wave, gridDim.x * NWAVES, lane);
    }
    SEAM(1);
    for (int l = 0; l < DEPTH; ++l) {
        const int pb = 2 + PPL * l;
        if (IN(pb + 0)) {
            PHASE_REGS;
            { pg8::Gemm gg{WSP(bf16, WS_H), (const bf16*)(ws + WS_W + (size_t)l * W_LSTRIDE + W_IN), S, 23 * 256, D}; pg8::InBf16Order SO; SO.init(S, 23 * 256, gridDim.x, blockIdx.x);
              const pg8::EpiIn E{ws, 0};
              pg8::gemm_phase<pg8::EpiIn, pg8::InBf16Order, true, true>(lds, gg, SO, E);
            }
            { pg8::Gemm gg{(const bf16*)(ws + WS_H8), (const bf16*)(ws + WS_WIN8 + (size_t)l * WIN8_LSTRIDE), S, 13 * 256, D / 2}; pg8::StaticOrder SO; SO.init(S, 13 * 256, gridDim.x, (blockIdx.x + 64) % gridDim.x);
              const pg8::EpiIn E{ws, 1};
              pg8::gemm_phase<pg8::EpiIn, pg8::StaticOrder, true, true, 0x79797979, 0x7f7f7f7f>(lds, gg, SO, E);
            }
        }
        SEAM(pb + 0);
        if (IN(pb + 1)) {
            PHASE_REGS; const int G = gridDim.x, vcu = VCU();
            rstd_rows(WSP(float, WS_RSQQ), WSP(float, WS_RSQKV), WSP(float, WS_RSTD), WSP(float, WS_RSTD) + S, vcu * NTHR + tid, G * NTHR);
            const att::CmpPtrs CP{WSP(bf16, WS_KVNSA), (const bf16*)(ws + WS_W + (size_t)l * W_LSTRIDE + W_C1), (const bf16*)(ws + WS_W + (size_t)l * W_LSTRIDE + W_C2),
                                  WSP(float, WS_CBP) + (size_t)l * 2 * 16 * 128, WSP(bf16, WS_KCMP), WSP(bf16, WS_VCMP)};
            for (int u = vcu; u < 256; u += G) att::cmp_unit(lds, CP, u & 1, (u >> 1) & 1, u >> 2, tid, wave, lane);
        }
        SEAM(pb + 1);
        if (IN(pb + 2)) {
            PHASE_REGS;
            { pg8::Gemm gg{WSP(bf16, WS_QLAT), (const bf16*)(ws + WS_W + (size_t)l * W_LSTRIDE + W_QUP), S, 3072, 384}; pg8::StaticOrder SO; SO.init(S, 3072, gridDim.x, blockIdx.x);
              const pg8::EpiQup E{ws};
              pg8::gemm_phase<pg8::EpiQup, pg8::StaticOrder, true, true, 0x7a7a7a7a, 0x7f7f7f7f>(lds, gg, SO, E);
            }
            { pg8::Gemm gg{WSP(bf16, WS_KVLAT), (const bf16*)(ws + WS_W + (size_t)l * W_LSTRIDE + W_KVUP), S, 2048, 256}; pg8::StaticOrder SO; SO.init(S, 2048, gridDim.x, blockIdx.x);
              const pg8::EpiKup E{ws};
              pg8::gemm_phase<pg8::EpiKup, pg8::StaticOrder, true, true, 0x7a7a7a7a, 0x7f7f7f7f>(lds, gg, SO, E);
            }
            { pg8::Gemm gg{(const bf16*)(ws + WS_W + (size_t)l * W_LSTRIDE + W_KVUP + (size_t)2048 * 512), WSP(bf16, WS_KVLAT), 2048, S, 256}; pg8::StaticOrder SO; SO.init(2048, S, gridDim.x, blockIdx.x);
              const pg8::EpiVt E{ws};
              pg8::gemm_phase<pg8::EpiVt, pg8::StaticOrder, true, true, 0x7f7f7f7f, 0x7a7a7a7a>(lds, gg, SO, E);
            }
        }
        SEAM(pb + 2);
        if (IN(pb + 3)) {
            PHASE_REGS; const int G = gridDim.x, vcu = VCU();
            { const att::MlaPtrs MP{WSP(bf16, WS_QMLA), WSP(bf16, WS_KMLA), WSP(bf16, WS_VMLA), WSP(bf16, WS_ZMLA), WSP(bf16, WS_H)};
              for (int pu = vcu; pu < 512; pu += G) { const int head = pu >> 5, pr = pu & 31;
                  att::mla_unit(lds, MP, head, 63 - pr, tid, wave, lane);
                  att::mla_unit(lds, MP, head, pr, tid, wave, lane);
              }
            }
            { const att::NsaPtrs NP{WSP(bf16, WS_QNSA), WSP(bf16, WS_KVNSA), WSP(bf16, WS_KCMP), WSP(bf16, WS_VCMP), WSP(bf16, WS_ZNSA), WSP(float, WS_GNSA), WSP(bf16, WS_H), WSP(float, WS_OSCR)};
              { unsigned* qctr = (unsigned*)(ws + WS_CTL) + CW_NSAQ + 64 * l; volatile LAS unsigned* uw = (volatile LAS unsigned*)(lds + MISC_OFF) + 16;
                for (;;) {
                    __syncthreads();
                    if (tid == 0) *uw = __hip_atomic_fetch_add(qctr, 1u, __ATOMIC_RELAXED, __HIP_MEMORY_SCOPE_AGENT);
                    __syncthreads();
                    const int u = __builtin_amdgcn_readfirstlane((int)*uw);
                    if (u >= 1024) break;
                    att::nsa_unit(lds, NP, u & 1, 511 - (u >> 1), tid, wave, lane, blockIdx.x); } }
            }
        }
        SEAM(pb + 3);
        if (IN(pb + 4)) {
            PHASE_REGS;
            pg8::StaticOrder SO; SO.init(S, D, gridDim.x, blockIdx.x);
            const pg8::EpiOut E{WSP(bf16, WS_Y), WSP(const float, WS_MOD) + (size_t)l * 3 * D + 2 * D};
            const pg8::GemmMix gm{ws + WS_H, ws + WS_W + (size_t)l * W_LSTRIDE + W_OUT, D, 1024, 2048, 2048, S, D};
            pg8::gemm_phase_mix<pg8::EpiOut, pg8::StaticOrder, 0x78787878, 0x7b7b7b7b>(lds, gm, SO, E);
        }
        SEAM(pb + 4);
        if (IN(pb + 5)) {
            PHASE_REGS;
            if (l == 0) ln_rows<false, true>(args.in[0], WSP(const bf16, WS_Y), WSP(void, WS_XV), WSP(bf16, WS_H), H8PTR, (const float*)args.in[14], (const float*)args.in[15],
                    WSP(const float, WS_MOD) + (size_t)3 * D, (LAS float*)lds, tid, VCU() * NWAVES + wave, gridDim.x * NWAVES, lane);
            else ln_rows<true, false>(WSP(const void, WS_XV), WSP(const bf16, WS_Y), args.out, nullptr, nullptr, (const float*)args.in[14] + (size_t)l * D, (const float*)args.in[15] + (size_t)l * D,
                    WSP(const float, WS_MOD) + (size_t)(l + 1) * 3 * D, (LAS float*)lds, tid, VCU() * NWAVES + wave, gridDim.x * NWAVES, lane);
        }
        SEAM(pb + 5);
    }
#undef IN
#undef SEAM
}


#ifndef MK_PER_PHASE
#define MK_PER_PHASE 0
#endif
extern "C" void kernel_launch(void* const* d_in, const int* in_sizes, int n_in, void* d_out, int out_size, void* d_ws, size_t ws_size, hipStream_t stream) {
    static int grid = 0;
    if (grid == 0) {
        if (n_in != 16 || out_size != S * D || ws_size < WS_END) { fprintf(stderr, "kernel_launch: unexpected shapes n_in %d out %d ws %zu\n", n_in, out_size, ws_size); grid = -1; return; }
        int dev = 0, cus = 0;
        if (hipGetDevice(&dev) != hipSuccess || hipDeviceGetAttribute(&cus, hipDeviceAttributeMultiprocessorCount, dev) != hipSuccess) { grid = -1; return; }
        if (hipFuncSetAttribute((const void*)mk_fwd, hipFuncAttributeMaxDynamicSharedMemorySize, LDS_BYTES) != hipSuccess) { grid = -1; return; }
        int per_cu = 0;
        (void)hipOccupancyMaxActiveBlocksPerMultiprocessor(&per_cu, (const void*)mk_fwd, NTHR, LDS_BYTES);
        (void)hipGetLastError();
        if (per_cu < 1) fprintf(stderr, "kernel_launch: occupancy query says %d\n", per_cu);
        grid = cus;
    }
    if (grid < 0) return;
    (void)hipMemsetAsync((char*)d_ws + WS_CTL, 0, CTL_ZERO_BYTES, stream);
    Args a{};
    for (int i = 0; i < 16; ++i) a.in[i] = d_in[i];
    a.out = (float*)d_out; a.ws = (unsigned char*)d_ws;
    a.ph_lo = 0; a.ph_hi = N_PHASES;
    hipLaunchKernelGGL(mk_fwd, dim3(grid), dim3(NTHR), LDS_BYTES, stream, a);
}
```

```cpp
#include <hip/hip_runtime.h>
#define MLA_FP8 1
#define MLA_FP8V 1
#define MLA_MXU 1
#define MLA_MXL 1
#define MLA_MX 1
#define OUT_F8 1
#define YBF16 1
#define GEMM_F8 1
#include <cstdio>
#include <cstdint>

#define GAS __attribute__((address_space(1)))
#define LAS __attribute__((address_space(3)))
typedef unsigned short bf16;
typedef float f32x4 __attribute__((ext_vector_type(4)));
typedef float f32x2 __attribute__((ext_vector_type(2)));
typedef float f32x8 __attribute__((ext_vector_type(8)));
typedef float f32x16 __attribute__((ext_vector_type(16)));
typedef unsigned u32x4 __attribute__((ext_vector_type(4)));
typedef unsigned u32x2 __attribute__((ext_vector_type(2)));
typedef short bf16x8 __attribute__((ext_vector_type(8)));
typedef short s16x4 __attribute__((ext_vector_type(4)));
typedef __bf16 bf16x2v __attribute__((ext_vector_type(2)));
typedef __bf16 bf16x8v __attribute__((ext_vector_type(8)));
typedef GAS unsigned gu32;

constexpr int S = 16384, D = 4096, DEPTH = 2;
constexpr int INC = 9072, NIN = 9216;
constexpr float LN_EPS = 1e-5f, RMS_EPS = 1e-6f;
constexpr float DN_ALPHA = 1.41421356237309515f;
constexpr float LOG2E = 1.4426950408889634f;
constexpr float QS_MLA = 0.07216878364870322f * LOG2E;
constexpr float QS_NSA = 0.08838834764831845f * LOG2E;
constexpr int NWAVES = 8, NTHR = 512;
constexpr size_t MiB = 1u << 20;
constexpr size_t WS_CTL = 0, CTL_ZERO_BYTES = 1 * MiB;
constexpr size_t WS_MOD = 1 * MiB;
constexpr size_t WS_ROPE = 2 * MiB;
constexpr size_t WS_CBP = 6 * MiB;
constexpr size_t WS_RSQQ = 7 * MiB;
constexpr size_t WS_RSQKV = 9 * MiB;
constexpr size_t WS_RSTD = 6 * MiB + 512 * 1024;
constexpr size_t WS_GNSA = 10 * MiB;
constexpr size_t WS_KCMP = 13 * MiB;
constexpr size_t WS_VCMP = 13 * MiB + 512 * 1024;
constexpr size_t WS_W = 16 * MiB, W_LSTRIDE = 120 * MiB;
constexpr size_t W_IN = 0, W_QUP = 72 * MiB, W_KVUP = 77 * MiB, W_OUT = 81 * MiB, W_C1 = 113 * MiB, W_C2 = 115 * MiB;
constexpr size_t WS_H = 256 * MiB;
constexpr size_t WS_XV = 384 * MiB;
constexpr size_t WS_QLAT = 640 * MiB, WS_KVLAT = 664 * MiB;
constexpr size_t WS_QMLA = 680 * MiB, WS_KMLA = 728 * MiB, WS_VMLA = 872 * MiB, WS_ZMLA = 936 * MiB, WS_ZNSA = 1000 * MiB, WS_QNSA = 1064 * MiB;
constexpr size_t WS_Y = 936 * MiB;
constexpr size_t WS_H8 = 776 * MiB;
constexpr size_t WS_WIN8 = 840 * MiB, WIN8_LSTRIDE = 13 * MiB;
constexpr size_t WS_KVNSA = 1128 * MiB;
constexpr size_t WS_OSCR = 1178 * MiB;
constexpr size_t WS_END = 1242 * MiB;
constexpr int CW_BAR = 4096;
constexpr int CW_NSAQ = 16384;
constexpr int LDS_BYTES = 147456;
constexpr int MISC_OFF = LDS_BYTES - 128;

__device__ __forceinline__ unsigned pk2(float lo, float hi) { f32x2 a = {lo, hi}; return __builtin_bit_cast(unsigned, __builtin_convertvector(a, bf16x2v)); }
__device__ __forceinline__ u32x4 pk8(f32x4 a, f32x4 b) { u32x4 w; w.x = pk2(a[0], a[1]); w.y = pk2(a[2], a[3]); w.z = pk2(b[0], b[1]); w.w = pk2(b[2], b[3]); return w; }
__device__ __forceinline__ float bflo(unsigned u) { return __uint_as_float(u << 16); }
__device__ __forceinline__ float bfhi(unsigned u) { return __uint_as_float(u & 0xffff0000u); }
__device__ __forceinline__ float wave_sum(float v) {
#pragma unroll
    for (int o = 1; o < 64; o <<= 1) v += __shfl_xor(v, o);
    return v;
}
__device__ __forceinline__ float silu_f(float v) { return v * __builtin_amdgcn_rcpf(1.f + __expf(-v)); }
__device__ __forceinline__ float sigm_f(float v) { return __builtin_amdgcn_rcpf(1.f + __expf(-v)); }

#define XB_TMO      128
#define XB_XCNT(j)  (256  + 64 * (j))
#define XB_XSUB(j)  (1280 + 64 * (j))
#define XB_XGEN(j)  (2304 + 64 * (j))
#define XB_TOP      3328
#define XB_TOPGEN   3392
#define XCD_BAR_WORDS 3456
#define XB_SPIN_CAP (1u << 18)
__device__ __forceinline__ unsigned xb_ld(unsigned* p)              { return __hip_atomic_load(p, __ATOMIC_RELAXED, __HIP_MEMORY_SCOPE_AGENT); }
__device__ __forceinline__ unsigned xb_add(unsigned* p, unsigned v) { return __hip_atomic_fetch_add(p, v, __ATOMIC_RELAXED, __HIP_MEMORY_SCOPE_AGENT); }
__device__ __forceinline__ unsigned xb_xcc_id() { return (unsigned)__builtin_amdgcn_s_getreg((3 << 11) | 20) & 0xFu; }
#define XB_SPIN(cond, bar) do { unsigned _sp = 0; while (cond) { __builtin_amdgcn_s_sleep(1); \
    if ((++_sp & 255u) == 0u) { if (xb_ld(&(bar)[XB_TMO])) break; if (_sp > XB_SPIN_CAP) { atomicAdd(&(bar)[XB_TMO], 1u); break; } } } } while (0)
struct XcdBarrier { unsigned* bar; unsigned x; volatile LAS unsigned* st; };
__device__ __forceinline__ XcdBarrier xcd_barrier_post(unsigned* bar, volatile LAS unsigned* st) {
    XcdBarrier b; b.bar = bar; b.x = xb_xcc_id(); b.st = st;
    if (threadIdx.x == 0) (void)xb_add(&bar[XB_XCNT(b.x)], 1u);
    return b;
}
__device__ __forceinline__ void xcd_barrier_complete(unsigned* bar, unsigned x, unsigned& nloc, unsigned& nx) {
    const unsigned G = gridDim.x * gridDim.y * gridDim.z;
    unsigned sum, cnt, mine, sp = 0u;
    for (;;) {
        sum = 0u; cnt = 0u; mine = 0u;
#pragma unroll
        for (unsigned j = 0; j < 16; ++j) { const unsigned c = xb_ld(&bar[XB_XCNT(j)]); sum += c; cnt += (c > 0u) ? 1u : 0u; mine = (j == x) ? c : mine; }
        if (sum == G) break;
        __builtin_amdgcn_s_sleep(1);
        if ((++sp & 255u) == 0u) { if (xb_ld(&bar[XB_TMO])) break; if (sp > XB_SPIN_CAP) { atomicAdd(&bar[XB_TMO], 1u); break; } }
    }
    nloc = mine > 0u ? mine : 1u; nx = cnt > 0u ? cnt : 1u;
}
__device__ __forceinline__ void xcd_barrier(const XcdBarrier& b) {
    asm volatile("s_waitcnt vmcnt(0)" ::: "memory");
    __syncthreads();
    if (threadIdx.x == 0) {
        unsigned* bar = b.bar;
        __builtin_amdgcn_s_waitcnt(0);
        unsigned nloc = b.st[0], nx = b.st[1];
        if (nloc == 0u) { xcd_barrier_complete(bar, b.x, nloc, nx); b.st[0] = nloc; b.st[1] = nx; }
        const unsigned old = xb_add(&bar[XB_XSUB(b.x)], 1u);
        const unsigned gen = old / nloc;
        if (old + 1u == (gen + 1u) * nloc) {
            __builtin_amdgcn_fence(__ATOMIC_RELEASE, "agent");
            asm volatile("s_waitcnt vmcnt(0)" ::: "memory");
            const unsigned og = xb_add(&bar[XB_TOP], 1u);
            const unsigned tg = og / nx;
            if (og + 1u == (tg + 1u) * nx) xb_add(&bar[XB_TOPGEN], 1u);
            else XB_SPIN(xb_ld(&bar[XB_TOPGEN]) == tg, bar);
            __builtin_amdgcn_fence(__ATOMIC_ACQUIRE, "agent");
            xb_add(&bar[XB_XGEN(b.x)], 1u);
            asm volatile("s_waitcnt vmcnt(0)" ::: "memory");
        } else {
            XB_SPIN(xb_ld(&bar[XB_XGEN(b.x)]) == gen, bar);
            __builtin_amdgcn_fence(__ATOMIC_ACQUIRE, "agent");
            asm volatile("s_waitcnt vmcnt(0)" ::: "memory");
        }
    }
    __syncthreads();
}
__device__ __forceinline__ void p0_mod_gemv(const float* c, const float* w_ada, const float* b_ada, float* mod, LAS float* lds, int vcu, int G) {
    const int tid = threadIdx.x;
    LAS float* sc = lds;
    LAS float* red = lds + 4096;
    for (int k = tid; k < D; k += NTHR) sc[k] = silu_f(c[k]);
    __syncthreads();
    const int cl = tid & 7, kl = tid >> 3;
    constexpr int NU = DEPTH * 3 * D / 32;
#define GV_W(u_) (w_ada + (size_t)((u_) / (3 * D / 32)) * D * (3 * D) + ((u_) % (3 * D / 32)) * 32 + cl * 4)
#define GV_LD(W_, i_) __builtin_nontemporal_load((const GAS f32x4*)((W_) + (size_t)(kl + 64 * (i_)) * (3 * D)))
    f32x4 w[16];
    if (vcu < NU) { const float* W0 = GV_W(vcu);
#pragma unroll
        for (int i = 0; i < 16; ++i) w[i] = GV_LD(W0, i); }
    for (int u = vcu; u < NU; u += G) {
        const int l = u / (3 * D / 32), n0 = (u % (3 * D / 32)) * 32;
        const float* W = GV_W(u);
        f32x4 acc = {0.f, 0.f, 0.f, 0.f};
#pragma unroll
        for (int i = 0; i < 48; ++i) { acc += w[i & 15] * sc[kl + 64 * i]; w[i & 15] = GV_LD(W, i + 16); }
        if (u + G < NU) { const float* Wn = GV_W(u + G);
#pragma unroll
            for (int i = 48; i < 64; ++i) { acc += w[i & 15] * sc[kl + 64 * i]; w[i & 15] = GV_LD(Wn, i - 48); }
        } else {
#pragma unroll
            for (int i = 48; i < 64; ++i) acc += w[i & 15] * sc[kl + 64 * i];
        }
        red[kl * 33 + cl * 4 + 0] = acc[0]; red[kl * 33 + cl * 4 + 1] = acc[1]; red[kl * 33 + cl * 4 + 2] = acc[2]; red[kl * 33 + cl * 4 + 3] = acc[3];
        __syncthreads();
        if (tid < 32) { float s = 0.f; for (int j = 0; j < 64; ++j) s += red[j * 33 + tid]; mod[(size_t)l * 3 * D + n0 + tid] = s + b_ada[(size_t)l * 3 * D + n0 + tid]; }
        __syncthreads();
    }
#undef GV_W
#undef GV_LD
}
__device__ __forceinline__ int map_in(int n) {
    if (n < 1280) return n;
    if (n < 1344) { const int i = n - 1280; return 1280 + 2 * (i & 31) + (i >> 5); }
    if (n < 3392) return 1536 + (n - 1344);
    if (n < 5440) return 3584 + (n - 3392);
    if (n < 6976) return 5632 + (n - 5440);
    if (n < 7024) return 1344 + (n - 6976);
    return 7168 + (n - 7024);
}
__device__ __forceinline__ int map_kvup(int n) { const int h = n >> 8, d = n & 255; return d < 128 ? h * 128 + d : 2048 + h * 128 + (d - 128); }
__device__ __forceinline__ int map_qup(int n) { const int h = n / 192, d = n - h * 192; if (d < 128) return h * 128 + d; const int i = d - 128; return 2048 + h * 64 + 2 * (i & 31) + (i >> 5); }
template <int MAP>
__device__ __forceinline__ void tr_item8(const float* W, int K, int N, unsigned char* WT, const float* kscale, float sc, int kb, int nb, int lane) {
    const int k0 = 64 * kb, n = 64 * nb + lane;
    if (n >= N) return;
    const GAS float* src = (const GAS float*)(W + (size_t)k0 * N + n);
    float v[64];
#pragma unroll
    for (int i = 0; i < 64; ++i) v[i] = __builtin_nontemporal_load(&src[(size_t)i * N]) * sc;
    if (kscale) {
#pragma unroll
        for (int i = 0; i < 64; ++i) v[i] *= kscale[k0 + i];
    }
    const int row = MAP == 4 ? (n < 1280 ? n : 1280 + (n - 1344)) : (MAP == 2 ? map_qup(n) : (MAP == 3 ? map_kvup(n) : n));
    GAS u32x4* dst = (GAS u32x4*)(WT + (size_t)row * K + k0);
#pragma unroll
    for (int c = 0; c < 4; ++c) { u32x4 o;
        int w = __builtin_amdgcn_cvt_pk_fp8_f32(v[16 * c + 0], v[16 * c + 1], 0, false); o.x = (unsigned)__builtin_amdgcn_cvt_pk_fp8_f32(v[16 * c + 2], v[16 * c + 3], w, true);
        w = __builtin_amdgcn_cvt_pk_fp8_f32(v[16 * c + 4], v[16 * c + 5], 0, false); o.y = (unsigned)__builtin_amdgcn_cvt_pk_fp8_f32(v[16 * c + 6], v[16 * c + 7], w, true);
        w = __builtin_amdgcn_cvt_pk_fp8_f32(v[16 * c + 8], v[16 * c + 9], 0, false); o.z = (unsigned)__builtin_amdgcn_cvt_pk_fp8_f32(v[16 * c + 10], v[16 * c + 11], w, true);
        w = __builtin_amdgcn_cvt_pk_fp8_f32(v[16 * c + 12], v[16 * c + 13], 0, false); o.w = (unsigned)__builtin_amdgcn_cvt_pk_fp8_f32(v[16 * c + 14], v[16 * c + 15], w, true);
        dst[c] = o; }
}
template <int MAP>
__device__ __forceinline__ void tr_item(const float* W, int K, int N, bf16* WT, const float* kscale, int kb, int nb, int lane) {
    const int k0 = 64 * kb, n = 64 * nb + lane;
    if (n >= N) return;
    const GAS float* src = (const GAS float*)(W + (size_t)k0 * N + n);
    float v[64];
#pragma unroll
    for (int i = 0; i < 64; ++i) v[i] = __builtin_nontemporal_load(&src[(size_t)i * N]);
    if (kscale) {
#pragma unroll
        for (int i = 0; i < 64; ++i) v[i] *= kscale[k0 + i];
    }
    const int row = MAP == 1 ? map_in(n) : (MAP == 2 ? map_qup(n) : (MAP == 3 ? map_kvup(n) : n));
    GAS u32x4* dst = (GAS u32x4*)(WT + (size_t)row * K + k0);
#pragma unroll
    for (int c = 0; c < 8; ++c) { u32x4 o; o.x = pk2(v[8 * c], v[8 * c + 1]); o.y = pk2(v[8 * c + 2], v[8 * c + 3]); o.z = pk2(v[8 * c + 4], v[8 * c + 5]); o.w = pk2(v[8 * c + 6], v[8 * c + 7]); dst[c] = o; }
}
struct P0In { const float *w_in, *q_norm, *w_q_up, *kv_norm, *w_kv_up, *w_cmp1, *w_cmp2, *w_out; };
__device__ __forceinline__ void p0_convert(const P0In& I, unsigned char* ws, int gw, int NGW, int lane) {
    constexpr int T_IN = 64 * 142, T_QUP = 12 * 48, T_KVUP = 8 * 64, T_OUT = 64 * 64, T_C1 = 2 * 64 * 2, T_C2 = 2 * 2 * 2;
    constexpr int TL = T_IN + T_QUP + T_KVUP + T_OUT + T_C1 + T_C2;
    for (int it = gw; it < DEPTH * TL; it += NGW) {
        const int l = it / TL; int r = it - l * TL;
        unsigned char* wl = ws + WS_W + (size_t)l * W_LSTRIDE;
        if (r < T_IN) { const int t_ = r >> 3, nb = t_ % 142, kb = (t_ / 142) * 8 + (r & 7);
            if (nb < 20 || (nb >= 21 && nb < 53)) tr_item8<4>(I.w_in + (size_t)l * D * INC, D, INC, ws + WS_WIN8 + (size_t)l * WIN8_LSTRIDE, nullptr, 64.f, kb, nb, lane);
            else tr_item<1>(I.w_in + (size_t)l * D * INC, D, INC, (bf16*)(wl + W_IN), nullptr, kb, nb, lane);
            continue; } r -= T_IN;
        if (r < T_QUP) { tr_item8<2>(I.w_q_up + (size_t)l * 768 * 3072, 768, 3072, wl + W_QUP, I.q_norm + l * 768, 32.f, r / 48, r % 48, lane); continue; } r -= T_QUP;
        if (r < T_KVUP) { tr_item8<3>(I.w_kv_up + (size_t)l * 512 * 4096, 512, 4096, wl + W_KVUP, I.kv_norm + l * 512, 32.f, r / 64, r % 64, lane); continue; }
        r -= T_KVUP;
        if (r < T_OUT) { const int t_ = r >> 3, kb = (t_ / 64) * 8 + (r & 7), nb = t_ % 64;
            if (kb < 32) tr_item8<0>(I.w_out + (size_t)l * D * D, 8192, D, wl + W_OUT, nullptr, 128.f, kb, nb, lane);
            else
            tr_item<0>(I.w_out + (size_t)l * D * D, D, D, (bf16*)(wl + W_OUT), nullptr, kb, nb, lane);
            continue; } r -= T_OUT;
        if (r < T_C1) { const int kv = r / 128, rr = r % 128; tr_item<0>(I.w_cmp1 + (size_t)(l * 2 + kv) * 4096 * 128, 4096, 128, (bf16*)(wl + W_C1) + (size_t)kv * 128 * 4096, nullptr, rr / 2, rr % 2, lane); continue; } r -= T_C1;
        { const int kv = r / 4, rr = r % 4; tr_item<0>(I.w_cmp2 + (size_t)(l * 2 + kv) * 128 * 128, 128, 128, (bf16*)(wl + W_C2) + (size_t)kv * 128 * 128, nullptr, rr / 2, rr % 2, lane); }
    }
}
__device__ __forceinline__ void p0_rope(const int* positions, float* cosT, float* sinT, int gtid, int NT) {
    for (int e = gtid; e < S * 32; e += NT) { const int s = e >> 5, i = e & 31;
        const float inv = (float)exp(-(double)i * (1.0 / 32.0) * 9.210340371976184);
        const float ang = (float)positions[s] * inv;
        cosT[e] = (float)cos((double)ang); sinT[e] = (float)sin((double)ang); }
}
__device__ __forceinline__ void p0_cmpbias(const float* cmp_pos, const float* w_cmp1, float* cbp, LAS float* red, int vcu, int G) {
    const int tid = threadIdx.x, n = tid & 127, kq = tid >> 7;
    for (int u = vcu; u < 64; u += G) {
        const int lk = u >> 4, ch = u & 15;
        const float* P = cmp_pos + (size_t)lk * 4096 + 256 * ch; const float* W = w_cmp1 + (size_t)lk * 4096 * 128 + (size_t)(256 * ch) * 128 + n;
        float a = 0.f;
#pragma unroll 32
        for (int i = 0; i < 64; ++i) { const int k = kq + 4 * i; a += P[k] * *(const GAS float*)(W + (size_t)k * 128); }
        red[kq * 128 + n] = a;
        __syncthreads();
        if (tid < 128) cbp[(size_t)u * 128 + tid] = (red[tid] + red[128 + tid]) + (red[256 + tid] + red[384 + tid]);
        __syncthreads();
    }
}
__device__ __forceinline__ unsigned pk4_fp8(f32x4 h) { const int w = __builtin_amdgcn_cvt_pk_fp8_f32(h[0], h[1], 0, false); return (unsigned)__builtin_amdgcn_cvt_pk_fp8_f32(h[2], h[3], w, true); }
__device__ __forceinline__ void modulate_rows(const float* x, bf16* hout, unsigned char* h8, const float* modl, LAS float* par, int tid, int gw, int NGW, int lane) {
    {
#pragma unroll
      for (int i = 0; i < 2; ++i) { const int e = tid + 512 * i;
          *((LAS f32x4*)par + e) = *((const GAS f32x4*)modl + e); *((LAS f32x4*)(par + D) + e) = *((const GAS f32x4*)(modl + D) + e) + 1.f; }
      __syncthreads(); }
    f32x4 rx[16];
    if (gw < S) { const GAS f32x4* xr = (const GAS f32x4*)(x + (size_t)gw * D) + lane;
#pragma unroll
        for (int j = 0; j < 16; ++j) rx[j] = __builtin_nontemporal_load(&xr[64 * j]); }
    for (int m = gw; m < S; m += NGW) {
        GAS u32x2* ho = (GAS u32x2*)(hout + (size_t)m * D) + lane;
        f32x4 h[16];
        { unsigned po_ = 0u; asm volatile("" : "+v"(po_)); par = (LAS float*)((LAS unsigned char*)par + po_); }
#pragma unroll
        for (int j = 0; j < 16; ++j) { h[j] = rx[j] * *((const LAS f32x4*)(par + D) + lane + 64 * j) + *((const LAS f32x4*)par + lane + 64 * j);
            asm volatile("" : "+v"(h[j]));
            if ((j & 3) == 3) __builtin_amdgcn_sched_barrier(0); }
        if (m + NGW < S) { const GAS f32x4* xr = (const GAS f32x4*)(x + (size_t)(m + NGW) * D) + lane;
#pragma unroll
            for (int j = 0; j < 16; ++j) rx[j] = __builtin_nontemporal_load(&xr[64 * j]); }
#pragma unroll
        for (int j = 0; j < 16; ++j) { u32x2 w; w.x = pk2(h[j][0], h[j][1]); w.y = pk2(h[j][2], h[j][3]); ho[64 * j] = w;
            if (h8) *((GAS unsigned*)(h8 + (size_t)m * D) + lane + 64 * j) = pk4_fp8(h[j]); }
    }
}
typedef _Float16 f16x4 __attribute__((ext_vector_type(4)));
template <bool XIN_H, bool XOUT_H>
__device__ __forceinline__ void ln_rows(const void* xres_, const bf16* yb, void* xout_, bf16* hout, unsigned char* h8, const float* g, const float* b, const float* mod_next, LAS float* par, int tid, int gw, int NGW, int lane) {
    {
#pragma unroll
      for (int i = 0; i < 2; ++i) { const int e = tid + 512 * i;
          *((LAS f32x4*)par + e) = *((const GAS f32x4*)g + e); *((LAS f32x4*)(par + D) + e) = *((const GAS f32x4*)b + e);
          if (hout) { *((LAS f32x4*)(par + 2 * D) + e) = *((const GAS f32x4*)mod_next + e); *((LAS f32x4*)(par + 3 * D) + e) = *((const GAS f32x4*)(mod_next + D) + e) + 1.f; } }
      __syncthreads(); }
    f32x4 rx[16]; f16x4 rxh[16]; u32x2 ry[16];
#define LN_LOAD(m_) { const GAS f32x4* vr = (const GAS f32x4*)((const float*)xres_ + (size_t)(m_) * D) + lane; const GAS f16x4* vrh = (const GAS f16x4*)((const _Float16*)xres_ + (size_t)(m_) * D) + lane; \
        const GAS u32x2* yr = (const GAS u32x2*)(yb + (size_t)(m_) * D) + lane; \
        _Pragma("unroll") for (int j = 0; j < 16; ++j) { ry[j] = __builtin_nontemporal_load(&yr[64 * j]); if (XIN_H) rxh[j] = __builtin_nontemporal_load(&vrh[64 * j]); else rx[j] = __builtin_nontemporal_load(&vr[64 * j]); } }
    if (gw < S) LN_LOAD(gw)
    for (int m = gw; m < S; m += NGW) {
        f32x4 x[16]; float s = 0.f;
#pragma unroll
        for (int j = 0; j < 16; ++j) { const u32x2 yy = ry[j]; const f32x4 yf = {bflo(yy.x), bfhi(yy.x), bflo(yy.y), bfhi(yy.y)};
            const f32x4 xin = XIN_H ? __builtin_convertvector(rxh[j], f32x4) : rx[j];
            x[j] = xin * DN_ALPHA + yf; s += (x[j][0] + x[j][1]) + (x[j][2] + x[j][3]); }
        if (m + NGW < S) LN_LOAD(m + NGW)
        const float mean = wave_sum(s) * (1.f / D); float s2 = 0.f;
#pragma unroll
        for (int j = 0; j < 16; ++j) { x[j] = x[j] - mean; s2 += (x[j][0] * x[j][0] + x[j][1] * x[j][1]) + (x[j][2] * x[j][2] + x[j][3] * x[j][3]); }
        const float rstd = 1.f / sqrtf(wave_sum(s2) * (1.f / D) + LN_EPS);
        { unsigned po_ = 0u; asm volatile("" : "+v"(po_)); par = (LAS float*)((LAS unsigned char*)par + po_); }
        GAS f32x4* xo = (GAS f32x4*)((float*)xout_ + (size_t)m * D) + lane; GAS f16x4* xoh = (GAS f16x4*)((_Float16*)xout_ + (size_t)m * D) + lane;
#pragma unroll
        for (int j = 0; j < 16; ++j) {
            const f32x4 gg = *((const LAS f32x4*)par + lane + 64 * j), bb = *((const LAS f32x4*)(par + D) + lane + 64 * j);
            const f32x4 y = x[j] * rstd * gg + bb;
            if (XOUT_H) __builtin_nontemporal_store(__builtin_convertvector(y, f16x4), &xoh[64 * j]); else __builtin_nontemporal_store(y, &xo[64 * j]);
            if (hout) {
                const f32x4 sh = *((const LAS f32x4*)(par + 2 * D) + lane + 64 * j), scl = *((const LAS f32x4*)(par + 3 * D) + lane + 64 * j);
                const f32x4 h = y * scl + sh;
                u32x2 w; w.x = pk2(h[0], h[1]); w.y = pk2(h[2], h[3]);
                *((GAS u32x2*)(hout + (size_t)m * D) + lane + 64 * j) = w;
                if (h8) *((GAS unsigned*)(h8 + (size_t)m * D) + lane + 64 * j) = pk4_fp8(h);
            }
            if ((j & 3) == 3) __builtin_amdgcn_sched_barrier(0);
        }
    }
#undef LN_LOAD
}
__device__ __forceinline__ void rstd_rows(const float* rsq_q, const float* rsq_kv, float* rstd_q, float* rstd_kv, int gtid, int NT) {
    for (int row = gtid; row < S; row += NT) {
        const GAS f32x4* rp = (const GAS f32x4*)(rsq_q + (size_t)row * 24); float ss = 0.f;
#pragma unroll
        for (int i = 0; i < 6; ++i) { const f32x4 t = rp[i]; ss += (t[0] + t[1]) + (t[2] + t[3]); }
        rstd_q[row] = 1.f / sqrtf(ss * (1.f / 768.f) + RMS_EPS);
        const GAS f32x4* rk = (const GAS f32x4*)(rsq_kv + (size_t)row * 16); float sk = 0.f;
#pragma unroll
        for (int i = 0; i < 4; ++i) { const f32x4 t = rk[i]; sk += (t[0] + t[1]) + (t[2] + t[3]); }
        rstd_kv[row] = 1.f / sqrtf(sk * (1.f / 512.f) + RMS_EPS);
    }
}
namespace pg8 {
#define PG8_LAS __attribute__((address_space(3)))
typedef unsigned short bf16_t;
typedef short bf16x8 __attribute__((ext_vector_type(8)));
typedef float f32x4 __attribute__((ext_vector_type(4)));
typedef unsigned u32x4 __attribute__((ext_vector_type(4)));
constexpr int BM = 256, BK = 64, HALF = 128, HTB = HALF * BK * 2  , STAGE_BYTES = 8 * HTB, NXCD = 8, WGM = 8;

__host__ __device__ __forceinline__ int lds_byte(int r, int c) { const int st = (r >> 4) * 2 + (c >> 5), rr = r & 15, cc = c & 31, ob = rr * 64 + cc * 2; return st * 1024 + (ob ^ (((ob >> 9) & 1) << 5)); }
__host__ __device__ __forceinline__ void stage_rc(int b, int& R, int& C) { const int st = b / 1024, sb = b % 1024, swz = sb ^ (((sb >> 9) & 1) << 5); R = (st >> 1) * 16 + swz / 64; C = (st & 1) * 32 + (swz % 64) / 2; }
__host__ __device__ __forceinline__ int perm32(int rho) { const int n = rho >> 4, i = rho & 15; return 8 * (i >> 2) + 4 * n + (i & 3); }

struct Unit { int pm, pn; };
struct Gemm { const bf16_t* A; const bf16_t* Bt; int M, N, K; };

struct StaticOrder {
    int nM, nN, nwg, G, c;
    __host__ __device__ void init(int M, int N, int G_, int c_) { nM = M / BM; nN = N / BM; nwg = nM * nN; G = G_; c = c_; }
    __host__ __device__ bool next(int i, Unit& u) const {
        const long L = (long)i * G + c; if (L >= nwg) return false;
        int wgid = (int)L; { const int q = nwg / NXCD, r = nwg % NXCD, xcd = wgid % NXCD, off = wgid / NXCD; wgid = (xcd < r ? xcd * (q + 1) : r * (q + 1) + (xcd - r) * q) + off; }
        const int nig = WGM * nN, gid = wgid / nig, fm = gid * WGM, gsz = (nM - fm) < WGM ? (nM - fm) : WGM;
        u.pm = fm + ((wgid % nig) % gsz); u.pn = (wgid % nig) / gsz; return true;
    }
    __device__ __forceinline__ void a_ready(const Unit&) const {}
    __device__ __forceinline__ void done(const Unit&) const {}
};
typedef int i32x8 __attribute__((ext_vector_type(8)));
typedef int i32x4 __attribute__((ext_vector_type(4)));
__device__ __forceinline__ i32x8 ld2x16(const PG8_LAS unsigned char* p) { const u32x4 a = *(const PG8_LAS u32x4*)p, b = *(const PG8_LAS u32x4*)(p + 1024);
    return (i32x8){(int)a.x, (int)a.y, (int)a.z, (int)a.w, (int)b.x, (int)b.y, (int)b.z, (int)b.w}; }
__device__ __forceinline__ i32x8 cat8(bf16x8 lo, bf16x8 hi) { const i32x4 a = __builtin_bit_cast(i32x4, lo), b = __builtin_bit_cast(i32x4, hi); return (i32x8){a[0], a[1], a[2], a[3], b[0], b[1], b[2], b[3]}; }
struct InBf16Order : StaticOrder {
    __device__ bool next(int i, Unit& u) const { if (!StaticOrder::next(i, u)) return false; u.pn = u.pn == 0 ? 5 : 13 + u.pn; return true; }
};
__device__ __forceinline__ f32x4 rope4(const f32x4 v, float c0, float s0, float c1, float s1) {
    f32x4 o; o[0] = v[0] * c0 - v[1] * s0; o[1] = v[1] * c0 + v[0] * s0; o[2] = v[2] * c1 - v[3] * s1; o[3] = v[3] * c1 + v[2] * s1; return o; }
#define NZ(v, row, col) (v)
__device__ __forceinline__ u32x2 pk8_fp8(f32x4 a, f32x4 b) {
    int w0 = __builtin_amdgcn_cvt_pk_fp8_f32(a[0], a[1], 0, false); w0 = __builtin_amdgcn_cvt_pk_fp8_f32(a[2], a[3], w0, true);
    int w1 = __builtin_amdgcn_cvt_pk_fp8_f32(b[0], b[1], 0, false); w1 = __builtin_amdgcn_cvt_pk_fp8_f32(b[2], b[3], w1, true);
    u32x2 r; r.x = (unsigned)w0; r.y = (unsigned)w1; return r; }
struct EpiIn {
    static constexpr bool PERM = true, AFTER_DRAIN = false;
    unsigned char* ws; int f8pass;
    __device__ __forceinline__ void operator()(const f32x4 (&acc)[2][2][4][2], const Unit& u, int wr, int wc, int fr, int fq) const {
        const int pn = f8pass ? (u.pn < 5 ? u.pn : u.pn + 1) : u.pn, row0 = u.pm * BM + wr * 64 + fr;
        if (pn < 5) {
            const bool isq = pn < 3; bf16_t* base = (bf16_t*)(ws + (isq ? WS_QLAT : WS_KVLAT)); const int ld = isq ? 768 : 512, ct = isq ? pn : pn - 3, ns = isq ? 24 : 16; float* rsq = (float*)(ws + (isq ? WS_RSQQ : WS_RSQKV));
#pragma unroll
            for (int ai = 0; ai < 2; ++ai)
#pragma unroll
                for (int m = 0; m < 4; ++m) { const int row = row0 + ai * HALF + m * 16;
#pragma unroll
                    for (int bj = 0; bj < 2; ++bj) { const f32x4 v0 = NZ(acc[ai][bj][m][0], row, pn * 256 + bj * 128 + wc * 32 + 8 * fq), v1 = NZ(acc[ai][bj][m][1], row, pn * 256 + bj * 128 + wc * 32 + 8 * fq + 4);
                        float ss = ((v0[0] * v0[0] + v0[1] * v0[1]) + (v0[2] * v0[2] + v0[3] * v0[3])) + ((v1[0] * v1[0] + v1[1] * v1[1]) + (v1[2] * v1[2] + v1[3] * v1[3]));
                        ss += __shfl_xor(ss, 16); ss += __shfl_xor(ss, 32);
                        if (fq == 0) rsq[(size_t)row * ns + ct * 8 + bj * 4 + wc] = ss;
                        *(GAS u32x2*)((unsigned char*)base + (size_t)row * ld + ct * 256 + bj * HALF + wc * 32 + 8 * fq) = pk8_fp8(v0, v1); } }
        } else if (pn == 5) {
            if (wc < 2) {
                const int i0 = 16 * wc + 4 * fq; const float* cosT = (const float*)(ws + WS_ROPE); const float* sinT = cosT + (size_t)S * 32; bf16_t* kmla = (bf16_t*)(ws + WS_KMLA);
#pragma unroll
                for (int ai = 0; ai < 2; ++ai)
#pragma unroll
                    for (int m = 0; m < 4; ++m) { const int row = row0 + ai * HALF + m * 16;
                        const f32x4 cs = *(const GAS f32x4*)(cosT + (size_t)row * 32 + i0), sn = *(const GAS f32x4*)(sinT + (size_t)row * 32 + i0);
                        const u32x2 w = pk8_fp8(rope4(acc[ai][0][m][0], cs[0], sn[0], cs[1], sn[1]), rope4(acc[ai][0][m][1], cs[2], sn[2], cs[3], sn[3]));
                        unsigned char* dst = (unsigned char*)kmla + (size_t)row * 3072 + 128 + wc * 32 + 8 * fq;
#pragma unroll
                        for (int h = 0; h < 16; ++h) *(GAS u32x2*)(dst + h * 192) = w;
                        asm volatile("" ::: "memory"); }
            } else {
                const int cl = (wc - 2) * 32 + 8 * fq; float* gnsa = (float*)(ws + WS_GNSA);
                if (cl < 48) {
#pragma unroll
                    for (int ai = 0; ai < 2; ++ai)
#pragma unroll
                        for (int m = 0; m < 4; ++m) { const int row = row0 + ai * HALF + m * 16; const f32x4 v0 = acc[ai][0][m][0], v1 = acc[ai][0][m][1];
                            f32x4 g0, g1; g0[0] = sigm_f(v0[0]); g0[1] = sigm_f(v0[1]); g0[2] = sigm_f(v0[2]); g0[3] = sigm_f(v0[3]); g1[0] = sigm_f(v1[0]); g1[1] = sigm_f(v1[1]); g1[2] = sigm_f(v1[2]); g1[3] = sigm_f(v1[3]);
                            *(GAS f32x4*)(gnsa + (size_t)row * 48 + cl) = g0; *(GAS f32x4*)(gnsa + (size_t)row * 48 + cl + 4) = g1; } }
            }
        } else {
            const int mode = (pn < 14) ? 0 : (pn < 22 ? 1 : (pn < 28 ? 2 : 0));
            bf16_t* base = (pn < 14) ? (bf16_t*)(ws + WS_ZMLA) + (pn - 6) * 256 : (pn < 22 ? (bf16_t*)(ws + WS_QNSA) + (pn - 14) * 256 : (bf16_t*)(ws + WS_ZNSA) + (pn - 28) * 256); bf16_t* kvnsa = (bf16_t*)(ws + WS_KVNSA);
#pragma unroll
            for (int ai = 0; ai < 2; ++ai)
#pragma unroll
                for (int m = 0; m < 4; ++m) { const int row = row0 + ai * HALF + m * 16;
#pragma unroll
                    for (int bj = 0; bj < 2; ++bj) { f32x4 v0 = NZ(acc[ai][bj][m][0], row, pn * 256 + bj * 128 + wc * 32 + 8 * fq), v1 = NZ(acc[ai][bj][m][1], row, pn * 256 + bj * 128 + wc * 32 + 8 * fq + 4);
                        if (mode == 0) { v0[0] = silu_f(v0[0]); v0[1] = silu_f(v0[1]); v0[2] = silu_f(v0[2]); v0[3] = silu_f(v0[3]); v1[0] = silu_f(v1[0]); v1[1] = silu_f(v1[1]); v1[2] = silu_f(v1[2]); v1[3] = silu_f(v1[3]); }
                        else if (mode == 1) { v0 = v0 * QS_NSA; v1 = v1 * QS_NSA; }
                        bf16_t* dst = (mode == 2) ? kvnsa + (size_t)(2 * (pn - 22) + bj) * ((size_t)S * 128) + (size_t)row * 128 + wc * 32 + 8 * fq
                                                  : base + (size_t)row * 2048 + bj * HALF + wc * 32 + 8 * fq;
                        *(GAS u32x4*)dst = pk8(v0, v1); } }
        }
    }
};
struct EpiQup {
    static constexpr bool PERM = true, AFTER_DRAIN = false;
    unsigned char* ws;
    __device__ __forceinline__ void operator()(const f32x4 (&acc)[2][2][4][2], const Unit& u, int wr, int wc, int fr, int fq) const {
        const int pn = u.pn, row0 = u.pm * BM + wr * 64 + fr; bf16_t* qmla = (bf16_t*)(ws + WS_QMLA); const float* rstd_q = (const float*)(ws + WS_RSTD); const float* cosT = (const float*)(ws + WS_ROPE); const float* sinT = cosT + (size_t)S * 32;
        float scv[2][4];
#pragma unroll
        for (int ai = 0; ai < 2; ++ai)
#pragma unroll
            for (int m = 0; m < 4; ++m) scv[ai][m] = (QS_MLA * 8.f) * *(const GAS float*)(rstd_q + row0 + ai * HALF + m * 16);
        if (pn < 8) {
#pragma unroll
            for (int ai = 0; ai < 2; ++ai)
#pragma unroll
                for (int m = 0; m < 4; ++m) { const int row = row0 + ai * HALF + m * 16; const float sc = scv[ai][m];
                    unsigned char* q8 = (unsigned char*)qmla + (size_t)row * 3072;
#pragma unroll
                    for (int bj = 0; bj < 2; ++bj) { const f32x4 v0 = acc[ai][bj][m][0] * sc, v1 = acc[ai][bj][m][1] * sc;
                        *(GAS u32x2*)(q8 + (2 * pn + bj) * 192 + wc * 32 + 8 * fq) = pk8_fp8(v0, v1); }
                    if (m & 1) asm volatile("" ::: "memory"); }
        } else {
#pragma unroll
            for (int ai = 0; ai < 2; ++ai)
#pragma unroll
                for (int mp = 0; mp < 2; ++mp) {
                    f32x4 cs[2][2], sn[2][2];
#pragma unroll
                    for (int mm = 0; mm < 2; ++mm)
#pragma unroll
                        for (int bj = 0; bj < 2; ++bj) { const int row = row0 + ai * HALF + (2 * mp + mm) * 16; const int cp = (pn - 8) * 256 + bj * HALF + wc * 32 + 8 * fq, i0 = (cp & 63) >> 1;
                            cs[mm][bj] = *(const GAS f32x4*)(cosT + (size_t)row * 32 + i0); sn[mm][bj] = *(const GAS f32x4*)(sinT + (size_t)row * 32 + i0); }
#pragma unroll
                    for (int mm = 0; mm < 2; ++mm)
#pragma unroll
                        for (int bj = 0; bj < 2; ++bj) { const int m = 2 * mp + mm, row = row0 + ai * HALF + m * 16; const float sc = scv[ai][m];
                            const f32x4 v0 = acc[ai][bj][m][0] * sc, v1 = acc[ai][bj][m][1] * sc;
                            const int cp = (pn - 8) * 256 + bj * HALF + wc * 32 + 8 * fq, head = cp >> 6, dl = cp & 63;
                            *(GAS u32x2*)((unsigned char*)qmla + (size_t)row * 3072 + head * 192 + 128 + dl) = pk8_fp8(rope4(v0, cs[mm][bj][0], sn[mm][bj][0], cs[mm][bj][1], sn[mm][bj][1]), rope4(v1, cs[mm][bj][2], sn[mm][bj][2], cs[mm][bj][3], sn[mm][bj][3])); }
                    asm volatile("" ::: "memory"); }
        }
    }
};
struct EpiKvup {
    static constexpr bool PERM = true, AFTER_DRAIN = false;
    unsigned char* ws;
    __device__ __forceinline__ void operator()(const f32x4 (&acc)[2][2][4][2], const Unit& u, int wr, int wc, int fr, int fq) const {
        const int pn = u.pn, row0 = u.pm * BM + wr * 64 + fr;
#pragma unroll
        for (int ai = 0; ai < 2; ++ai)
#pragma unroll
            for (int m = 0; m < 4; ++m) { const int row = row0 + ai * HALF + m * 16;
                const float sc = *(const GAS float*)((const float*)(ws + WS_RSTD) + S + row); bf16_t* kmla = (bf16_t*)(ws + WS_KMLA); bf16_t* vmla = (bf16_t*)(ws + WS_VMLA);
                *(GAS u32x2*)((unsigned char*)kmla + (size_t)row * 3072 + pn * 192 + wc * 32 + 8 * fq) = pk8_fp8(acc[ai][0][m][0] * sc, acc[ai][0][m][1] * sc);
                *(GAS u32x4*)(vmla + (size_t)row * 2048 + pn * 128 + wc * 32 + 8 * fq) = pk8(acc[ai][1][m][0] * sc, acc[ai][1][m][1] * sc);
                if (m & 1) asm volatile("" ::: "memory"); }
    }
};
struct EpiKup {
    static constexpr bool PERM = true, AFTER_DRAIN = false;
    unsigned char* ws;
    __device__ __forceinline__ void operator()(const f32x4 (&acc)[2][2][4][2], const Unit& u, int wr, int wc, int fr, int fq) const {
        const int pn = u.pn, row0 = u.pm * BM + wr * 64 + fr;
        float scv[2][4];
#pragma unroll
        for (int ai = 0; ai < 2; ++ai)
#pragma unroll
            for (int m = 0; m < 4; ++m) scv[ai][m] = *(const GAS float*)((const float*)(ws + WS_RSTD) + S + row0 + ai * HALF + m * 16);
#pragma unroll
        for (int ai = 0; ai < 2; ++ai)
#pragma unroll
            for (int m = 0; m < 4; ++m) { const int row = row0 + ai * HALF + m * 16;
                const float sc = scv[ai][m]; unsigned char* k8 = ws + WS_KMLA + (size_t)row * 3072;
#pragma unroll
                for (int bj = 0; bj < 2; ++bj) *(GAS u32x2*)(k8 + (2 * pn + bj) * 192 + wc * 32 + 8 * fq) = pk8_fp8(acc[ai][bj][m][0] * sc, acc[ai][bj][m][1] * sc);
                if (m & 1) asm volatile("" ::: "memory"); }
    }
};
struct EpiVt {
    static constexpr bool PERM = true, AFTER_DRAIN = false;
    unsigned char* ws;
    __device__ __forceinline__ void operator()(const f32x4 (&acc)[2][2][4][2], const Unit& u, int wr, int wc, int fr, int fq) const {
        const int row0 = u.pm * BM + wr * 64 + fr, col0 = u.pn * BM + wc * 32 + 8 * fq;
        const float* rs = (const float*)(ws + WS_RSTD) + S;
        f32x4 sc[2][2];
#pragma unroll
        for (int bj = 0; bj < 2; ++bj) { sc[bj][0] = *(const GAS f32x4*)(rs + col0 + bj * HALF); sc[bj][1] = *(const GAS f32x4*)(rs + col0 + bj * HALF + 4); }
        const int hi8 = (col0 >> 3) & 1; (void)hi8;
#pragma unroll
        for (int ai = 0; ai < 2; ++ai)
#pragma unroll
            for (int m = 0; m < 4; ++m) { unsigned char* vt = ws + WS_VMLA + (size_t)(row0 + ai * HALF + m * 16) * S;
#pragma unroll
                for (int bj = 0; bj < 2; ++bj) { const u32x2 w = pk8_fp8(acc[ai][bj][m][0] * sc[bj][0], acc[ai][bj][m][1] * sc[bj][1]);
                    unsigned char* d64 = vt + ((col0 + bj * HALF) & ~63) + 4 * ((col0 >> 3) & 7);
                    *(GAS unsigned*)(d64) = w.x; *(GAS unsigned*)(d64 + 32) = w.y; } }
    }
};
struct EpiOut {
    static constexpr bool PERM = true, AFTER_DRAIN = false;
    bf16_t* y; const float* gate;
    __device__ __forceinline__ void operator()(const f32x4 (&acc)[2][2][4][2], const Unit& u, int wr, int wc, int fr, int fq) const {
        const int row0 = u.pm * BM + wr * 64 + fr, col0 = u.pn * BM + wc * 32 + 8 * fq;
        f32x4 gv[2][2];
#pragma unroll
        for (int bj = 0; bj < 2; ++bj)
#pragma unroll
            for (int n = 0; n < 2; ++n) gv[bj][n] = *(const GAS f32x4*)(gate + col0 + bj * HALF + n * 4);
#pragma unroll
        for (int ai = 0; ai < 2; ++ai)
#pragma unroll
            for (int m = 0; m < 4; ++m) { bf16_t* dst = y + (size_t)(row0 + ai * HALF + m * 16) * D + col0;
#pragma unroll
                for (int bj = 0; bj < 2; ++bj) *(GAS u32x4*)(dst + bj * HALF) = pk8(gv[bj][0] * acc[ai][bj][m][0], gv[bj][1] * acc[ai][bj][m][1]);
                if (m & 1) asm volatile("" ::: "memory"); }
    }
};
template <class Epi, class Sched, bool ALIGN_EPI = false, bool SP2 = false, int SCB = 0, int SCA = 0>
__device__ __forceinline__ void gemm_phase(PG8_LAS unsigned char* lds, const Gemm g, const Sched& S, const Epi& E) {
    int tid_ = threadIdx.x; asm volatile("" : "+v"(tid_));
    const int tid = tid_, wid = __builtin_amdgcn_readfirstlane(tid >> 6), lane = tid & 63, wr = wid >> 2, wc = wid & 3, fr = lane & 15, fq = lane >> 4;
    const int K = g.K, nt = K / BK;
    unsigned voffA[2], voffB[2];
#pragma unroll
    for (int i = 0; i < 2; ++i) { int R, C; stage_rc(tid * 16 + i * 8192, R, C); const int Rb = Epi::PERM ? ((R & ~31) + perm32(R & 31)) : R;
        voffA[i] = (unsigned)(R * K + C) * 2u; voffB[i] = (unsigned)(Rb * K + C) * 2u; }
    const size_t kstep = (size_t)(BK * 2);
    const size_t hstep = (size_t)HALF * K * 2;
    const size_t tstep = 2 * hstep;
    const unsigned ldsw = (unsigned)wid * 1024u;
    const int aoff = lds_byte(wr * 64 + fr, fq * 8), boff = lds_byte(wc * 32 + fr, fq * 8);
#define PG8_SA(b, h) (((b) * 2 + (h)) * HTB)
#define PG8_SB(b, h) ((4 + (b) * 2 + (h)) * HTB)
#define PG8_STAGE(bufoff, gbase, voff) do { _Pragma("unroll") for (int _i = 0; _i < 2; ++_i) \
        __builtin_amdgcn_global_load_lds((const unsigned*)((const char*)(gbase) + (voff)[_i]), (PG8_LAS unsigned*)(lds + (bufoff) + ldsw + _i * 8192), 16, 0, 0); } while (0)
#define PG8_LDA(dst, b, h) do { if constexpr (SCB != 0) { _Pragma("unroll") for (int m = 0; m < 4; ++m) dst##8[m] = ld2x16(lds + PG8_SA(b, h) + aoff + m * 2048); } \
        else { _Pragma("unroll") for (int m = 0; m < 4; ++m) _Pragma("unroll") for (int k = 0; k < 2; ++k) dst[m][k] = *(const PG8_LAS bf16x8*)(lds + PG8_SA(b, h) + aoff + m * 2048 + k * 1024); } } while (0)
#define PG8_LDB(dst, b, h) do { if constexpr (SCB != 0) { _Pragma("unroll") for (int n = 0; n < 2; ++n) dst##8[n] = ld2x16(lds + PG8_SB(b, h) + boff + n * 2048); } \
        else { _Pragma("unroll") for (int n = 0; n < 2; ++n) _Pragma("unroll") for (int k = 0; k < 2; ++k) dst[n][k] = *(const PG8_LAS bf16x8*)(lds + PG8_SB(b, h) + boff + n * 2048 + k * 1024); } } while (0)
#define PG8_MMA(ai, bj, At, Bt) do { __builtin_amdgcn_s_setprio(1); \
        if constexpr (SCB != 0) { _Pragma("unroll") for (int m = 0; m < 4; ++m) _Pragma("unroll") for (int n = 0; n < 2; ++n) \
            asm volatile("v_mfma_scale_f32_16x16x128_f8f6f4 %0, %1, %2, %0, %3, %4 op_sel_hi:[0,0,0]" : "+v"(acc[ai][bj][m][n]) : "v"(Bt##8[n]), "v"(At##8[m]), "v"(scb_), "v"(sca_)); } \
        else { _Pragma("unroll") for (int m = 0; m < 4; ++m) _Pragma("unroll") for (int n = 0; n < 2; ++n) _Pragma("unroll") for (int k = 0; k < 2; ++k) \
            acc[ai][bj][m][n] = __builtin_amdgcn_mfma_f32_16x16x32_bf16(Bt[n][k], At[m][k], acc[ai][bj][m][n], 0, 0, 0); } \
        __builtin_amdgcn_s_setprio(0); } while (0)
#define PG8_WAIT_V(n) asm volatile("s_waitcnt vmcnt(" #n ")" ::: "memory")
#define PG8_WAIT_L(n) asm volatile("s_waitcnt lgkmcnt(" #n ")" ::: "memory")
#define PG8_BAR __builtin_amdgcn_s_barrier()
#define PG8_SCHED __builtin_amdgcn_sched_barrier(0)
    Unit cur, nxt; int ui = 0;
    if (!S.next(0, cur)) return;
    f32x4 acc[2][2][4][2];
#pragma unroll
    for (int a = 0; a < 2; ++a)
#pragma unroll
        for (int b = 0; b < 2; ++b)
#pragma unroll
            for (int m = 0; m < 4; ++m)
#pragma unroll
                for (int n = 0; n < 2; ++n) acc[a][b][m][n] = (f32x4){0.f, 0.f, 0.f, 0.f};
    int scb_ = SCB, sca_ = SCA; asm volatile("" : "+v"(scb_), "+v"(sca_));
    bf16x8 At[4][2], B0[2][2], B1[2][2]; i32x8 At8[4], B08[2], B18[2];
    const char* cA = (const char*)g.A + (size_t)cur.pm * tstep; const char* cB = (const char*)g.Bt + (size_t)cur.pn * tstep;
    S.a_ready(cur);
    if constexpr (SP2) {
        PG8_STAGE(PG8_SB(0, 0), cB, voffB); PG8_STAGE(PG8_SB(0, 1), cB + hstep, voffB); PG8_STAGE(PG8_SA(0, 0), cA, voffA); PG8_STAGE(PG8_SA(0, 1), cA + hstep, voffA);
        if (wr == 1) PG8_BAR;
        PG8_WAIT_V(2); PG8_BAR;
        PG8_STAGE(PG8_SB(1, 0), cB + kstep, voffB); PG8_STAGE(PG8_SA(1, 0), cA + kstep, voffA); PG8_STAGE(PG8_SB(1, 1), cB + hstep + kstep, voffB);
        PG8_WAIT_V(6); PG8_BAR;
    } else {
        PG8_STAGE(PG8_SB(0, 0), cB, voffB); PG8_STAGE(PG8_SA(0, 0), cA, voffA); PG8_STAGE(PG8_SB(0, 1), cB + hstep, voffB); PG8_STAGE(PG8_SA(0, 1), cA + hstep, voffA);
        if (wr == 1) PG8_BAR;
        PG8_WAIT_V(4); PG8_BAR;
        PG8_STAGE(PG8_SB(1, 0), cB + kstep, voffB); PG8_STAGE(PG8_SA(1, 0), cA + kstep, voffA); PG8_STAGE(PG8_SB(1, 1), cB + hstep + kstep, voffB);
        PG8_WAIT_V(6); PG8_BAR;
    }
    for (;;) {
        const bool has_next = S.next(ui + 1, nxt);
        const char* nA = has_next ? (const char*)g.A + (size_t)nxt.pm * tstep : cA; const char* nB = has_next ? (const char*)g.Bt + (size_t)nxt.pn * tstep : cB;
#pragma unroll 1
        for (int t = 0; t < nt; t += 2) {
            const bool last = (t == nt - 2);
            const char* a1 = cA + (size_t)(t + 1) * kstep;
            const char* a2 = last ? nA : cA + (size_t)(t + 2) * kstep; const char* b2 = last ? nB : cB + (size_t)(t + 2) * kstep;
            const char* a3 = a2 + kstep; const char* b3 = b2 + kstep;
            if (last && has_next) S.a_ready(nxt);
            if constexpr (SP2) {
            PG8_LDB(B0, 0, 0); PG8_LDB(B1, 0, 1); PG8_SCHED; PG8_LDA(At, 0, 0); PG8_STAGE(PG8_SA(1, 1), a1 + hstep, voffA);
            PG8_WAIT_V(8); PG8_WAIT_L(0); PG8_BAR; PG8_MMA(0, 0, At, B0); PG8_MMA(0, 1, At, B1); PG8_BAR; PG8_SCHED;
            PG8_LDA(At, 0, 1); PG8_STAGE(PG8_SB(0, 0), b2, voffB); PG8_STAGE(PG8_SB(0, 1), b2 + hstep, voffB); PG8_STAGE(PG8_SA(0, 0), a2, voffA);
            PG8_WAIT_V(8); PG8_WAIT_L(0); PG8_BAR; PG8_MMA(1, 0, At, B0); PG8_MMA(1, 1, At, B1); PG8_BAR; PG8_SCHED;
            PG8_LDB(B0, 1, 0); PG8_LDB(B1, 1, 1); PG8_SCHED; PG8_LDA(At, 1, 0); PG8_STAGE(PG8_SA(0, 1), a2 + hstep, voffA);
            PG8_WAIT_V(8); PG8_WAIT_L(0); PG8_BAR; PG8_MMA(0, 0, At, B0); PG8_MMA(0, 1, At, B1); PG8_BAR; PG8_SCHED;
            PG8_LDA(At, 1, 1); PG8_STAGE(PG8_SB(1, 0), b3, voffB); PG8_STAGE(PG8_SB(1, 1), b3 + hstep, voffB); PG8_STAGE(PG8_SA(1, 0), a3, voffA);
            PG8_WAIT_V(8); PG8_WAIT_L(0); PG8_BAR; PG8_MMA(1, 0, At, B0); PG8_MMA(1, 1, At, B1); PG8_BAR; PG8_SCHED;
            } else {
            PG8_LDB(B0, 0, 0); PG8_SCHED; PG8_LDA(At, 0, 0); PG8_STAGE(PG8_SA(1, 1), a1 + hstep, voffA);
            PG8_WAIT_L(8); PG8_BAR; PG8_WAIT_L(0); PG8_MMA(0, 0, At, B0); PG8_BAR; PG8_SCHED;
            PG8_LDB(B1, 0, 1); PG8_STAGE(PG8_SB(0, 0), b2, voffB);
            PG8_BAR; PG8_WAIT_L(0); PG8_MMA(0, 1, At, B1); PG8_BAR;
            PG8_LDA(At, 0, 1); PG8_STAGE(PG8_SA(0, 0), a2, voffA);
            PG8_BAR; PG8_WAIT_L(0); PG8_MMA(1, 0, At, B0); PG8_BAR; PG8_SCHED;
            PG8_STAGE(PG8_SB(0, 1), b2 + hstep, voffB);
            PG8_WAIT_V(6); PG8_BAR; PG8_MMA(1, 1, At, B1); PG8_BAR;
            PG8_LDB(B0, 1, 0); PG8_SCHED; PG8_LDA(At, 1, 0); PG8_STAGE(PG8_SA(0, 1), a2 + hstep, voffA);
            PG8_WAIT_L(8); PG8_BAR; PG8_WAIT_L(0); PG8_MMA(0, 0, At, B0); PG8_BAR; PG8_SCHED;
            PG8_LDB(B1, 1, 1); PG8_STAGE(PG8_SB(1, 0), b3, voffB);
            PG8_BAR; PG8_WAIT_L(0); PG8_MMA(0, 1, At, B1); PG8_BAR;
            PG8_LDA(At, 1, 1); PG8_STAGE(PG8_SA(1, 0), a3, voffA);
            PG8_BAR; PG8_WAIT_L(0); PG8_MMA(1, 0, At, B0); PG8_BAR; PG8_SCHED;
            PG8_STAGE(PG8_SB(1, 1), b3 + hstep, voffB);
            PG8_WAIT_V(6); PG8_BAR; PG8_MMA(1, 1, At, B1); PG8_BAR;
            }
        }
        if constexpr (SCB != 0) asm volatile("s_nop 15\n\ts_nop 15" ::: "memory");
        if constexpr (ALIGN_EPI) { if (wr == 0) PG8_BAR; }
        if constexpr (!Epi::AFTER_DRAIN) { int fr_ = fr, fq_ = fq; asm volatile("" : "+v"(fr_), "+v"(fq_));
            E(acc, cur, wr, wc, fr_, fq_);
            S.done(cur); }
        if (!has_next) break;
#pragma unroll
        for (int a = 0; a < 2; ++a)
#pragma unroll
            for (int b = 0; b < 2; ++b)
#pragma unroll
                for (int m = 0; m < 4; ++m)
#pragma unroll
                    for (int n = 0; n < 2; ++n) acc[a][b][m][n] = (f32x4){0.f, 0.f, 0.f, 0.f};
        cur = nxt; cA = nA; cB = nB; ++ui;
        if constexpr (ALIGN_EPI) { if (wr == 1) PG8_BAR; }
    }
    PG8_WAIT_V(0);
    if constexpr (!ALIGN_EPI) { if (wr == 0) PG8_BAR; }
    PG8_BAR;
    if constexpr (Epi::AFTER_DRAIN) { E.fused(acc, cur, wr, wc, fr, fq, lds, wid, lane); S.done(cur); }
#undef PG8_SA
#undef PG8_SB
#undef PG8_STAGE
#undef PG8_LDA
#undef PG8_LDB
#undef PG8_MMA
#undef PG8_WAIT_V
#undef PG8_WAIT_L
#undef PG8_BAR
#undef PG8_SCHED
}

struct GemmMix { const void* A; const void* B; int LD;
                 int K0, K1, OFF1, M, N; };
template <class Epi, class Sched, int SCB, int SCA>
__device__ __forceinline__ void gemm_phase_mix(PG8_LAS unsigned char* lds, const GemmMix g, const Sched& S, const Epi& E) {
    int tid_ = threadIdx.x; asm volatile("" : "+v"(tid_));
    const int tid = tid_, wid = __builtin_amdgcn_readfirstlane(tid >> 6), lane = tid & 63, wr = wid >> 2, wc = wid & 3, fr = lane & 15, fq = lane >> 4;
    const int nt0 = g.K0 / BK, nt1 = g.K1 / BK, nt = nt0 + nt1, koff1 = g.OFF1 / BK - nt0;
    unsigned voffA[2], voffB[2];
#pragma unroll
    for (int i = 0; i < 2; ++i) { int R, C; stage_rc(tid * 16 + i * 8192, R, C); const int Rb = Epi::PERM ? ((R & ~31) + perm32(R & 31)) : R;
        voffA[i] = (unsigned)(R * g.LD + C) * 2u; voffB[i] = (unsigned)(Rb * g.LD + C) * 2u; }
    const size_t kstep = (size_t)(BK * 2);
    const size_t hstep = (size_t)HALF * g.LD * 2, tstep = 2 * hstep;
    const unsigned ldsw = (unsigned)wid * 1024u;
    const int aoff = lds_byte(wr * 64 + fr, fq * 8), boff = lds_byte(wc * 32 + fr, fq * 8);
#define PG8_SA(b, h) (((b) * 2 + (h)) * HTB)
#define PG8_SB(b, h) ((4 + (b) * 2 + (h)) * HTB)
#define PG8_STAGE(bufoff, gbase, voff) do { _Pragma("unroll") for (int _i = 0; _i < 2; ++_i) \
        __builtin_amdgcn_global_load_lds((const unsigned*)((const char*)(gbase) + (voff)[_i]), (PG8_LAS unsigned*)(lds + (bufoff) + ldsw + _i * 8192), 16, 0, 0); } while (0)
#define PG8_LDA1(dst, b, h) do { _Pragma("unroll") for (int m = 0; m < 4; ++m) dst##8[m] = ld2x16(lds + PG8_SA(b, h) + aoff + m * 2048); } while (0)
#define PG8_LDB1(dst, b, h) do { _Pragma("unroll") for (int n = 0; n < 2; ++n) dst##8[n] = ld2x16(lds + PG8_SB(b, h) + boff + n * 2048); } while (0)
#define PG8_LDA0(dst, b, h) do { _Pragma("unroll") for (int m = 0; m < 4; ++m) _Pragma("unroll") for (int k = 0; k < 2; ++k) dst[m][k] = *(const PG8_LAS bf16x8*)(lds + PG8_SA(b, h) + aoff + m * 2048 + k * 1024); } while (0)
#define PG8_LDB0(dst, b, h) do { _Pragma("unroll") for (int n = 0; n < 2; ++n) _Pragma("unroll") for (int k = 0; k < 2; ++k) dst[n][k] = *(const PG8_LAS bf16x8*)(lds + PG8_SB(b, h) + boff + n * 2048 + k * 1024); } while (0)
#define PG8_MMA1(ai, bj, At, Bt) do { __builtin_amdgcn_s_setprio(1); _Pragma("unroll") for (int m = 0; m < 4; ++m) _Pragma("unroll") for (int n = 0; n < 2; ++n) \
            asm volatile("v_mfma_scale_f32_16x16x128_f8f6f4 %0, %1, %2, %0, %3, %4 op_sel_hi:[0,0,0]" : "+v"(acc[ai][bj][m][n]) : "v"(Bt##8[n]), "v"(At##8[m]), "v"(scb_), "v"(sca_)); \
        __builtin_amdgcn_s_setprio(0); } while (0)
#define PG8_MMA0(ai, bj, At, Bt) do { __builtin_amdgcn_s_setprio(1); _Pragma("unroll") for (int m = 0; m < 4; ++m) _Pragma("unroll") for (int n = 0; n < 2; ++n) _Pragma("unroll") for (int k = 0; k < 2; ++k) \
            acc[ai][bj][m][n] = __builtin_amdgcn_mfma_f32_16x16x32_bf16(Bt[n][k], At[m][k], acc[ai][bj][m][n], 0, 0, 0); \
        __builtin_amdgcn_s_setprio(0); } while (0)
#define PG8_WAIT_V(n) asm volatile("s_waitcnt vmcnt(" #n ")" ::: "memory")
#define PG8_WAIT_L(n) asm volatile("s_waitcnt lgkmcnt(" #n ")" ::: "memory")
#define PG8_BAR __builtin_amdgcn_s_barrier()
#define PG8_SCHED __builtin_amdgcn_sched_barrier(0)
    Unit cur, nxt; int ui = 0;
    if (!S.next(0, cur)) return;
    f32x4 acc[2][2][4][2];
#pragma unroll
    for (int a = 0; a < 2; ++a)
#pragma unroll
        for (int b = 0; b < 2; ++b)
#pragma unroll
            for (int m = 0; m < 4; ++m)
#pragma unroll
                for (int n = 0; n < 2; ++n) acc[a][b][m][n] = (f32x4){0.f, 0.f, 0.f, 0.f};
    int scb_ = SCB, sca_ = SCA; asm volatile("" : "+v"(scb_), "+v"(sca_));
    bf16x8 At[4][2], B0[2][2], B1[2][2]; i32x8 At8[4], B08[2], B18[2];
    const char* cA = (const char*)g.A + (size_t)cur.pm * tstep; const char* cB = (const char*)g.B + (size_t)cur.pn * tstep;
    S.a_ready(cur);
    PG8_STAGE(PG8_SB(0, 0), cB, voffB); PG8_STAGE(PG8_SB(0, 1), cB + hstep, voffB); PG8_STAGE(PG8_SA(0, 0), cA, voffA); PG8_STAGE(PG8_SA(0, 1), cA + hstep, voffA);
    if (wr == 1) PG8_BAR;
    PG8_WAIT_V(2); PG8_BAR;
    PG8_STAGE(PG8_SB(1, 0), cB + kstep, voffB); PG8_STAGE(PG8_SA(1, 0), cA + kstep, voffA); PG8_STAGE(PG8_SB(1, 1), cB + hstep + kstep, voffB);
    PG8_WAIT_V(6); PG8_BAR;
    for (;;) {
        const bool has_next = S.next(ui + 1, nxt);
        const char* nA = has_next ? (const char*)g.A + (size_t)nxt.pm * tstep : cA; const char* nB = has_next ? (const char*)g.B + (size_t)nxt.pn * tstep : cB;
#define PG8_KPOS(x) ((size_t)((x) < nt0 ? (x) : (x) + koff1) * kstep)
#define PG8_TRIP(F) do { \
            const bool last = (t == nt - 2); \
            const char* a1 = cA + PG8_KPOS(t + 1); \
            const char* a2 = last ? nA : cA + PG8_KPOS(t + 2); const char* b2 = last ? nB : cB + PG8_KPOS(t + 2); \
            const char* a3 = last ? nA + kstep : cA + PG8_KPOS(t + 3); const char* b3 = last ? nB + kstep : cB + PG8_KPOS(t + 3); \
            if (last && has_next) S.a_ready(nxt); \
            PG8_LDB##F(B0, 0, 0); PG8_LDB##F(B1, 0, 1); PG8_SCHED; PG8_LDA##F(At, 0, 0); PG8_STAGE(PG8_SA(1, 1), a1 + hstep, voffA); \
            PG8_WAIT_V(8); PG8_WAIT_L(0); PG8_BAR; PG8_MMA##F(0, 0, At, B0); PG8_MMA##F(0, 1, At, B1); PG8_BAR; PG8_SCHED; \
            PG8_LDA##F(At, 0, 1); PG8_STAGE(PG8_SB(0, 0), b2, voffB); PG8_STAGE(PG8_SB(0, 1), b2 + hstep, voffB); PG8_STAGE(PG8_SA(0, 0), a2, voffA); \
            PG8_WAIT_V(8); PG8_WAIT_L(0); PG8_BAR; PG8_MMA##F(1, 0, At, B0); PG8_MMA##F(1, 1, At, B1); PG8_BAR; PG8_SCHED; \
            PG8_LDB##F(B0, 1, 0); PG8_LDB##F(B1, 1, 1); PG8_SCHED; PG8_LDA##F(At, 1, 0); PG8_STAGE(PG8_SA(0, 1), a2 + hstep, voffA); \
            PG8_WAIT_V(8); PG8_WAIT_L(0); PG8_BAR; PG8_MMA##F(0, 0, At, B0); PG8_MMA##F(0, 1, At, B1); PG8_BAR; PG8_SCHED; \
            PG8_LDA##F(At, 1, 1); PG8_STAGE(PG8_SB(1, 0), b3, voffB); PG8_STAGE(PG8_SB(1, 1), b3 + hstep, voffB); PG8_STAGE(PG8_SA(1, 0), a3, voffA); \
            PG8_WAIT_V(8); PG8_WAIT_L(0); PG8_BAR; PG8_MMA##F(1, 0, At, B0); PG8_MMA##F(1, 1, At, B1); PG8_BAR; PG8_SCHED; \
        } while (0)
#pragma unroll 1
        for (int t = 0; t < nt0; t += 2) PG8_TRIP(1);
        asm volatile("s_nop 7" ::: "memory");
#pragma unroll 1
        for (int t = nt0; t < nt; t += 2) PG8_TRIP(0);
#undef PG8_TRIP
#undef PG8_KPOS
        asm volatile("s_nop 15\n\ts_nop 15" ::: "memory");
        if (wr == 0) PG8_BAR;
        { int fr_ = fr, fq_ = fq; asm volatile("" : "+v"(fr_), "+v"(fq_)); E(acc, cur, wr, wc, fr_, fq_); S.done(cur); }
        if (!has_next) break;
#pragma unroll
        for (int a = 0; a < 2; ++a)
#pragma unroll
            for (int b = 0; b < 2; ++b)
#pragma unroll
                for (int m = 0; m < 4; ++m)
#pragma unroll
                    for (int n = 0; n < 2; ++n) acc[a][b][m][n] = (f32x4){0.f, 0.f, 0.f, 0.f};
        cur = nxt; cA = nA; cB = nB; ++ui;
        if (wr == 1) PG8_BAR;
    }
    PG8_WAIT_V(0);
    PG8_BAR;
#undef PG8_SA
#undef PG8_SB
#undef PG8_STAGE
#undef PG8_LDA0
#undef PG8_LDB0
#undef PG8_LDA1
#undef PG8_LDB1
#undef PG8_MMA0
#undef PG8_MMA1
#undef PG8_WAIT_V
#undef PG8_WAIT_L
#undef PG8_BAR
#undef PG8_SCHED
}
}
namespace att {
constexpr int KS_M = 400, KS_N = 272, VS = 320;
constexpr int MLA_KB = 64 * KS_M, NSA_KB = 64 * KS_N, VB = 64 * VS;
constexpr int N_IMP = 2 * NSA_KB + 2 * VB;
constexpr int N_PART = N_IMP + 32768;
constexpr int N_PARTB = 8 * 32 * 17 * 4;
constexpr int N_SELM = N_PART + 2 * N_PARTB;
constexpr int N_ULIST = N_SELM + 1024;
constexpr int N_CARRY = N_ULIST + 1024;
constexpr int N_NTS = N_CARRY + 256;
static_assert(N_NTS + 16 <= MISC_OFF, "NSA LDS map");
static_assert(2 * MLA_KB + 3 * VB <= 131072, "MLA LDS map");
constexpr int MLA_QL = 2 * MLA_KB + 2 * VB;
static_assert(MLA_QL + 8 * 4096 <= 131072, "MLA LDS map (pipelined)");

#ifndef QK_PF
#define QK_PF 4
#endif
#define MFMA32(a, b, c) __builtin_amdgcn_mfma_f32_32x32x16_bf16((a), (b), (c), 0, 0, 0)
__device__ __forceinline__ float swapmax(float v) { auto rr = __builtin_amdgcn_permlane32_swap(__float_as_uint(v), __float_as_uint(v), false, false); return fmaxf(__uint_as_float(rr[0]), __uint_as_float(rr[1])); }
__device__ __forceinline__ float swapsum(float v) { auto rr = __builtin_amdgcn_permlane32_swap(__float_as_uint(v), __float_as_uint(v), false, false); return __uint_as_float(rr[0]) + __uint_as_float(rr[1]); }
template <int SIDX> __device__ __forceinline__ bf16x8 packp(const f32x16& p) {
    f32x8 t = {p[8 * SIDX + 0], p[8 * SIDX + 1], p[8 * SIDX + 2], p[8 * SIDX + 3], p[8 * SIDX + 4], p[8 * SIDX + 5], p[8 * SIDX + 6], p[8 * SIDX + 7]};
    return __builtin_bit_cast(bf16x8, __builtin_convertvector(t, bf16x8v));
}
template <int NDC, int KS, bool ZERO = true> __device__ __forceinline__ void qk_tile(f32x16& p0, f32x16& p1, const LAS unsigned char* kl, const bf16x8 (&q)[NDC]) {
    if (ZERO) {
#pragma unroll
        for (int i = 0; i < 16; ++i) { p0[i] = 0.f; p1[i] = 0.f; }
    }
    constexpr int PF = QK_PF;
    bf16x8 a[PF + 1][2];
#pragma unroll
    for (int i = 0; i < PF; ++i) { a[i][0] = *(const LAS bf16x8*)(kl + i * 32); a[i][1] = *(const LAS bf16x8*)(kl + 32 * KS + i * 32); }
#pragma unroll
    for (int d0 = 0; d0 < NDC; ++d0) {
        if (d0 + PF < NDC) { a[(d0 + PF) % (PF + 1)][0] = *(const LAS bf16x8*)(kl + (d0 + PF) * 32); a[(d0 + PF) % (PF + 1)][1] = *(const LAS bf16x8*)(kl + 32 * KS + (d0 + PF) * 32); }
        __builtin_amdgcn_sched_barrier(0);
        p0 = MFMA32(a[d0 % (PF + 1)][0], q[d0], p0); p1 = MFMA32(a[d0 % (PF + 1)][1], q[d0], p1);
        __builtin_amdgcn_sched_barrier(0);
    }
}
struct PvPre { s16x4 f[4][2]; };
__device__ __forceinline__ void pv_preload(PvPre& pp, const LAS unsigned char* vl) {
#pragma unroll
    for (int s_ = 0; s_ < 4; ++s_) { pp.f[s_][0] = __builtin_amdgcn_ds_read_tr16_b64_v4i16((LAS s16x4*)(vl + s_ * 16 * VS)); pp.f[s_][1] = __builtin_amdgcn_ds_read_tr16_b64_v4i16((LAS s16x4*)(vl + s_ * 16 * VS + 8 * VS)); }
}
template <bool PRE = false>
__device__ __forceinline__ void pv_tile(f32x16 (&o)[4], const bf16x8 (&pb)[4], const LAS unsigned char* vl, const PvPre* pp = nullptr) {
    s16x4 f[5][2];
#define PV_LD(idx) do { constexpr int d_ = (idx) >> 2, s_ = (idx) & 3; \
        f[(idx) % 5][0] = __builtin_amdgcn_ds_read_tr16_b64_v4i16((LAS s16x4*)(vl + s_ * 16 * VS + d_ * 64)); \
        f[(idx) % 5][1] = __builtin_amdgcn_ds_read_tr16_b64_v4i16((LAS s16x4*)(vl + s_ * 16 * VS + 8 * VS + d_ * 64)); } while (0)
    if (PRE) {
#pragma unroll
        for (int s_ = 0; s_ < 4; ++s_) { f[s_][0] = pp->f[s_][0]; f[s_][1] = pp->f[s_][1]; }
    } else { PV_LD(0); PV_LD(1); PV_LD(2); PV_LD(3); }
#define PV_STEP(idx) do { if ((idx) + 4 < 16) PV_LD((idx) + 4); __builtin_amdgcn_sched_barrier(0); \
        { const s16x4 t0_ = f[(idx) % 5][0], t1_ = f[(idx) % 5][1]; const bf16x8 vf_ = {t0_[0], t0_[1], t0_[2], t0_[3], t1_[0], t1_[1], t1_[2], t1_[3]}; \
          o[(idx) >> 2] = MFMA32(vf_, pb[(idx) & 3], o[(idx) >> 2]); } __builtin_amdgcn_sched_barrier(0); } while (0)
    PV_STEP(0); PV_STEP(1); PV_STEP(2); PV_STEP(3); PV_STEP(4); PV_STEP(5); PV_STEP(6); PV_STEP(7);
    PV_STEP(8); PV_STEP(9); PV_STEP(10); PV_STEP(11); PV_STEP(12); PV_STEP(13); PV_STEP(14); PV_STEP(15);
#undef PV_STEP
#undef PV_LD
}
template <int NDC, int NQR, int KS> __device__ __forceinline__ void qk_tile_free(f32x16& p0, f32x16& p1, const LAS unsigned char* kl, const bf16x8 (&q)[NQR], const LAS unsigned char* ql) {
#pragma unroll
    for (int i = 0; i < 16; ++i) { p0[i] = 0.f; p1[i] = 0.f; }
#pragma unroll
    for (int d0 = 0; d0 < NDC; ++d0) {
        const bf16x8 a0 = *(const LAS bf16x8*)(kl + d0 * 32);
        const bf16x8 a1 = *(const LAS bf16x8*)(kl + 32 * KS + d0 * 32);
        bf16x8 qq; if (d0 < NQR) qq = q[d0 < NQR ? d0 : 0]; else qq = *(const LAS bf16x8*)(ql + (d0 - NQR) * 1024);
        p0 = MFMA32(a0, qq, p0); p1 = MFMA32(a1, qq, p1);
    }
}
__device__ __forceinline__ float sm_core(f32x16& p0, f32x16& p1, float& m, float& l) {
    float tm = p0[0];
#pragma unroll
    for (int r = 1; r < 16; ++r) tm = fmaxf(tm, p0[r]);
#pragma unroll
    for (int r = 0; r < 16; ++r) tm = fmaxf(tm, p1[r]);
    tm = swapmax(tm);
    const float mn = fmaxf(m, tm);
    const float alpha = __builtin_amdgcn_exp2f(m - mn);
    m = mn;
    float ps = 0.f;
#pragma unroll
    for (int r = 0; r < 16; ++r) { p0[r] = __builtin_amdgcn_exp2f(p0[r] - mn); ps += p0[r]; }
#pragma unroll
    for (int r = 0; r < 16; ++r) { p1[r] = __builtin_amdgcn_exp2f(p1[r] - mn); ps += p1[r]; }
    ps = swapsum(ps);
    l = l * alpha + ps;
    return alpha;
}
__device__ __forceinline__ void online_sm(f32x16& p0, f32x16& p1, float& m, float& l, f32x16 (&o)[4]) {
    float tm = p0[0];
#pragma unroll
    for (int r = 1; r < 16; ++r) tm = fmaxf(tm, p0[r]);
#pragma unroll
    for (int r = 0; r < 16; ++r) tm = fmaxf(tm, p1[r]);
    tm = swapmax(tm);
    const float mn = fmaxf(m, tm);
    const float alpha = __builtin_amdgcn_exp2f(m - mn);
    m = mn;
    float ps = 0.f;
#pragma unroll
    for (int r = 0; r < 16; ++r) { p0[r] = __builtin_amdgcn_exp2f(p0[r] - mn); ps += p0[r]; }
#pragma unroll
    for (int r = 0; r < 16; ++r) { p1[r] = __builtin_amdgcn_exp2f(p1[r] - mn); ps += p1[r]; }
    ps = swapsum(ps);
    l = l * alpha + ps;
    if (!__all(alpha == 1.f)) {
#pragma unroll
        for (int d = 0; d < 4; ++d)
#pragma unroll
            for (int r = 0; r < 16; ++r) o[d][r] *= alpha;
    }
}

typedef long i64;
constexpr int KS8 = 200, MLA_KB8 = 64 * KS8;
static_assert(2 * MLA_KB8 + 3 * VB <= 131072, "MLA fp8 LDS map");
#define MFMA32F8(a, b, c) __builtin_amdgcn_mfma_f32_32x32x16_fp8_fp8((a), (b), (c), 0, 0, 0)
template <int NDC> __device__ __forceinline__ void qk_tile8(f32x16& p0, f32x16& p1, const LAS unsigned char* kl, const i64 (&q)[NDC]) {
#pragma unroll
    for (int i = 0; i < 16; ++i) { p0[i] = 0.f; p1[i] = 0.f; }
    constexpr int PF = 4;
    i64 a[PF + 1][2];
#pragma unroll
    for (int i = 0; i < PF; ++i) { a[i][0] = *(const LAS i64*)(kl + i * 16); a[i][1] = *(const LAS i64*)(kl + 32 * KS8 + i * 16); }
#pragma unroll
    for (int d0 = 0; d0 < NDC; ++d0) {
        if (d0 + PF < NDC) { a[(d0 + PF) % (PF + 1)][0] = *(const LAS i64*)(kl + (d0 + PF) * 16); a[(d0 + PF) % (PF + 1)][1] = *(const LAS i64*)(kl + 32 * KS8 + (d0 + PF) * 16); }
        __builtin_amdgcn_sched_barrier(0);
        __builtin_amdgcn_s_setprio(1);
        p0 = MFMA32F8(a[d0 % (PF + 1)][0], q[d0], p0); p1 = MFMA32F8(a[d0 % (PF + 1)][1], q[d0], p1);
        __builtin_amdgcn_s_setprio(0);
        __builtin_amdgcn_sched_barrier(0);
    }
}
__device__ __forceinline__ void online_sm_scaled(f32x16& p0, f32x16& p1, float& m, float& l, f32x16 (&o)[4], const float C2) {
    float tm = p0[0];
#pragma unroll
    for (int r = 1; r < 16; ++r) tm = fmaxf(tm, p0[r]);
#pragma unroll
    for (int r = 0; r < 16; ++r) tm = fmaxf(tm, p1[r]);
    tm = swapmax(tm);
    const float mn = fmaxf(m, tm);
    const float alpha = __builtin_amdgcn_exp2f((m - mn) * C2);
    m = mn;
    const float mc = -mn * C2;
    float ps = 0.f;
#pragma unroll
    for (int r = 0; r < 16; ++r) { p0[r] = __builtin_amdgcn_exp2f(__builtin_fmaf(p0[r], C2, mc)); ps += p0[r]; }
#pragma unroll
    for (int r = 0; r < 16; ++r) { p1[r] = __builtin_amdgcn_exp2f(__builtin_fmaf(p1[r], C2, mc)); ps += p1[r]; }
    ps = swapsum(ps);
    l = l * alpha + ps;
    if (!__all(alpha == 1.f)) {
#pragma unroll
        for (int d = 0; d < 4; ++d)
#pragma unroll
            for (int r = 0; r < 16; ++r) o[d][r] *= alpha;
    }
}
constexpr int VS8 = 72, VB8 = 128 * VS8;
constexpr int VS8B = 136, VB8B = 128 * VS8B, MLA_KB8B = 128 * KS8;
static_assert(2 * MLA_KB8B + 3 * VB8B <= 131072, "MLA big-tile LDS map");
#define PV8_RS VS8
static_assert(2 * MLA_KB8 + 3 * VB8 <= 131072, "MLA fp8 LDS map");
template <int SIDX> __device__ __forceinline__ i64 packp8(const f32x16& p) {
    int w0 = __builtin_amdgcn_cvt_pk_fp8_f32(p[8 * SIDX + 0] * 256.f, p[8 * SIDX + 1] * 256.f, 0, false); w0 = __builtin_amdgcn_cvt_pk_fp8_f32(p[8 * SIDX + 2] * 256.f, p[8 * SIDX + 3] * 256.f, w0, true);
    int w1 = __builtin_amdgcn_cvt_pk_fp8_f32(p[8 * SIDX + 4] * 256.f, p[8 * SIDX + 5] * 256.f, 0, false); w1 = __builtin_amdgcn_cvt_pk_fp8_f32(p[8 * SIDX + 6] * 256.f, p[8 * SIDX + 7] * 256.f, w1, true);
    return (i64)(((unsigned long long)(unsigned)w1 << 32) | (unsigned)w0);
}
__device__ __forceinline__ void pv_tile8(f32x16 (&o)[4], const i64 (&pb)[4], const LAS unsigned char* vl) {
    i64 f[5];
#define PV8_LD(idx) f[(idx) % 5] = *(const LAS i64*)(vl + ((idx) >> 2) * 32 * PV8_RS + ((idx) & 3) * 16)
    PV8_LD(0); PV8_LD(1); PV8_LD(2); PV8_LD(3);
#define PV8_STEP(idx) do { if ((idx) + 4 < 16) PV8_LD((idx) + 4); __builtin_amdgcn_sched_barrier(0); \
        o[(idx) >> 2] = MFMA32F8(f[(idx) % 5], pb[(idx) & 3], o[(idx) >> 2]); __builtin_amdgcn_sched_barrier(0); } while (0)
    PV8_STEP(0); PV8_STEP(1); PV8_STEP(2); PV8_STEP(3); PV8_STEP(4); PV8_STEP(5); PV8_STEP(6); PV8_STEP(7);
    PV8_STEP(8); PV8_STEP(9); PV8_STEP(10); PV8_STEP(11); PV8_STEP(12); PV8_STEP(13); PV8_STEP(14); PV8_STEP(15);
#undef PV8_STEP
#undef PV8_LD
}
typedef int i32x8 __attribute__((ext_vector_type(8)));
constexpr int KSX = 208, MLA_KBX = 64 * KSX;
constexpr int VSX = 80, VBX = 128 * VSX;
static_assert(2 * MLA_KBX + 3 * VBX <= 131072, "MLA mx LDS map");
#define MFMAX(a, b, c) __builtin_amdgcn_mfma_scale_f32_32x32x64_f8f6f4((a), (b), (c), 0, 0, 0, 0x7f7f7f7f, 0, 0x7f7f7f7f)
__device__ __forceinline__ i32x8 ldsx(const LAS unsigned char* p) {
    const u32x4 a = *(const LAS u32x4*)p, b = *(const LAS u32x4*)(p + 16);
    return (i32x8){(int)a.x, (int)a.y, (int)a.z, (int)a.w, (int)b.x, (int)b.y, (int)b.z, (int)b.w};
}
__device__ __forceinline__ void qk_tilex(f32x16& p0, f32x16& p1, const LAS unsigned char* kl, const i32x8 (&q)[3]) {
#pragma unroll
    for (int i = 0; i < 16; ++i) { p0[i] = 0.f; p1[i] = 0.f; }
    i32x8 a0 = ldsx(kl), a1 = ldsx(kl + 32 * KSX), a2 = ldsx(kl + 64), a3 = ldsx(kl + 32 * KSX + 64);
    __builtin_amdgcn_sched_barrier(0);
    __builtin_amdgcn_s_setprio(1);
    p0 = MFMAX(a0, q[0], p0); p1 = MFMAX(a1, q[0], p1);
    __builtin_amdgcn_s_setprio(0);
    __builtin_amdgcn_sched_barrier(0);
    a0 = ldsx(kl + 128); a1 = ldsx(kl + 32 * KSX + 128);
    __builtin_amdgcn_sched_barrier(0);
    __builtin_amdgcn_s_setprio(1);
    p0 = MFMAX(a2, q[1], p0); p1 = MFMAX(a3, q[1], p1);
    __builtin_amdgcn_sched_barrier(0);
    p0 = MFMAX(a0, q[2], p0); p1 = MFMAX(a1, q[2], p1);
    __builtin_amdgcn_s_setprio(0);
    __builtin_amdgcn_sched_barrier(0);
}
__device__ __forceinline__ void pv_tilex(f32x16 (&o)[4], const i32x8& pb, const LAS unsigned char* vl) {
    i32x8 f0 = ldsx(vl), f1 = ldsx(vl + 32 * VSX);
    __builtin_amdgcn_sched_barrier(0);
    o[0] = MFMAX(f0, pb, o[0]);
    __builtin_amdgcn_sched_barrier(0);
    f0 = ldsx(vl + 64 * VSX);
    __builtin_amdgcn_sched_barrier(0);
    o[1] = MFMAX(f1, pb, o[1]);
    __builtin_amdgcn_sched_barrier(0);
    f1 = ldsx(vl + 96 * VSX);
    __builtin_amdgcn_sched_barrier(0);
    o[2] = MFMAX(f0, pb, o[2]);
    __builtin_amdgcn_sched_barrier(0);
    o[3] = MFMAX(f1, pb, o[3]);
    __builtin_amdgcn_sched_barrier(0);
}
__device__ __forceinline__ i32x8 packpx(const f32x16& p0, const f32x16& p1) {
    i32x8 w;
#pragma unroll
    for (int g = 0; g < 4; ++g) {
        int a = __builtin_amdgcn_cvt_pk_fp8_f32(p0[4 * g + 0], p0[4 * g + 1], 0, false); a = __builtin_amdgcn_cvt_pk_fp8_f32(p0[4 * g + 2], p0[4 * g + 3], a, true); w[g] = a;
        int b = __builtin_amdgcn_cvt_pk_fp8_f32(p1[4 * g + 0], p1[4 * g + 1], 0, false); b = __builtin_amdgcn_cvt_pk_fp8_f32(p1[4 * g + 2], p1[4 * g + 3], b, true); w[4 + g] = b;
    }
    return w;
}
__device__ __forceinline__ void online_sm_x(f32x16& p0, f32x16& p1, float& m, float& l, f32x16 (&o)[4], const float C2) {
    float tm = p0[0];
#pragma unroll
    for (int r = 1; r < 16; ++r) tm = fmaxf(tm, p0[r]);
#pragma unroll
    for (int r = 0; r < 16; ++r) tm = fmaxf(tm, p1[r]);
    tm = swapmax(tm);
    const float mn = fmaxf(m, tm);
    const float alpha = __builtin_amdgcn_exp2f((m - mn) * C2);
    m = mn;
    const float mc = 8.f - mn * C2;
    float ps = 0.f;
#pragma unroll
    for (int r = 0; r < 16; ++r) { p0[r] = __builtin_amdgcn_exp2f(__builtin_fmaf(p0[r], C2, mc)); ps += p0[r]; }
#pragma unroll
    for (int r = 0; r < 16; ++r) { p1[r] = __builtin_amdgcn_exp2f(__builtin_fmaf(p1[r], C2, mc)); ps += p1[r]; }
    ps = swapsum(ps);
    l = l * alpha + ps;
    if (!__all(alpha == 1.f)) {
#pragma unroll
        for (int d = 0; d < 4; ++d)
#pragma unroll
            for (int r = 0; r < 16; ++r) o[d][r] *= alpha;
    }
}
#define MXL_T 126.0f
#define MXL_REF 96.0f
#define MFMAXQ(a, b, c) __builtin_amdgcn_mfma_scale_f32_32x32x64_f8f6f4((a), (b), (c), 0, 0, 0, 0x7f7f7f7f, 0, 0x7f7f7f7f)
__device__ __forceinline__ i32x8 byte_packx(const f32x16& p0, const f32x16& p1) {
    i32x8 w;
#pragma unroll
    for (int g = 0; g < 4; ++g) {
        unsigned a = __builtin_amdgcn_cvt_pk_u8_f32(p0[4 * g + 0], 0, 0u); a = __builtin_amdgcn_cvt_pk_u8_f32(p0[4 * g + 1], 1, a); a = __builtin_amdgcn_cvt_pk_u8_f32(p0[4 * g + 2], 2, a); a = __builtin_amdgcn_cvt_pk_u8_f32(p0[4 * g + 3], 3, a); w[g] = (int)a;
        unsigned b = __builtin_amdgcn_cvt_pk_u8_f32(p1[4 * g + 0], 0, 0u); b = __builtin_amdgcn_cvt_pk_u8_f32(p1[4 * g + 1], 1, b); b = __builtin_amdgcn_cvt_pk_u8_f32(p1[4 * g + 2], 2, b); b = __builtin_amdgcn_cvt_pk_u8_f32(p1[4 * g + 3], 3, b); w[4 + g] = (int)b;
    }
    return w;
}
__device__ __forceinline__ void qk_tilexl(f32x16& p0, f32x16& p1, const f32x16& mref, const LAS unsigned char* kl, const i32x8 (&q)[3]) {
    i32x8 a0 = ldsx(kl), a1 = ldsx(kl + 32 * KSX), a2 = ldsx(kl + 64), a3 = ldsx(kl + 32 * KSX + 64);
    __builtin_amdgcn_sched_barrier(0);
    __builtin_amdgcn_s_setprio(1);
    p0 = MFMAXQ(a0, q[0], mref); p1 = MFMAXQ(a1, q[0], mref);
    __builtin_amdgcn_s_setprio(0);
    __builtin_amdgcn_sched_barrier(0);
    a0 = ldsx(kl + 128); a1 = ldsx(kl + 32 * KSX + 128);
    __builtin_amdgcn_sched_barrier(0);
    __builtin_amdgcn_s_setprio(1);
    p0 = MFMAXQ(a2, q[1], p0); p1 = MFMAXQ(a3, q[1], p1);
    __builtin_amdgcn_sched_barrier(0);
    p0 = MFMAXQ(a0, q[2], p0); p1 = MFMAXQ(a1, q[2], p1);
    __builtin_amdgcn_s_setprio(0);
    __builtin_amdgcn_sched_barrier(0);
}
template <int RS = VSX>
__device__ __forceinline__ void pv_tilexl_pre(f32x16 (&o)[5], const i32x8& pb, const i32x8& ones, const LAS unsigned char* vl, i32x8 f0, i32x8 f1) {
    __builtin_amdgcn_sched_barrier(0);
    o[4] = MFMAX(ones, pb, o[4]);
    __builtin_amdgcn_sched_barrier(0);
    o[0] = MFMAX(f0, pb, o[0]);
    __builtin_amdgcn_sched_barrier(0);
    f0 = ldsx(vl + 64 * RS);
    __builtin_amdgcn_sched_barrier(0);
    o[1] = MFMAX(f1, pb, o[1]);
    __builtin_amdgcn_sched_barrier(0);
    f1 = ldsx(vl + 96 * RS);
    __builtin_amdgcn_sched_barrier(0);
    o[2] = MFMAX(f0, pb, o[2]);
    __builtin_amdgcn_sched_barrier(0);
    o[3] = MFMAX(f1, pb, o[3]);
    __builtin_amdgcn_sched_barrier(0);
}
template <int RS = VSX>
__device__ __forceinline__ void pv_tilexl(f32x16 (&o)[5], const i32x8& pb, const i32x8& ones, const LAS unsigned char* vl) {
    i32x8 f0 = ldsx(vl), f1 = ldsx(vl + 32 * RS);
    __builtin_amdgcn_sched_barrier(0);
    o[4] = MFMAX(ones, pb, o[4]);
    __builtin_amdgcn_sched_barrier(0);
    o[0] = MFMAX(f0, pb, o[0]);
    __builtin_amdgcn_sched_barrier(0);
    f0 = ldsx(vl + 64 * RS);
    __builtin_amdgcn_sched_barrier(0);
    o[1] = MFMAX(f1, pb, o[1]);
    __builtin_amdgcn_sched_barrier(0);
    f1 = ldsx(vl + 96 * RS);
    __builtin_amdgcn_sched_barrier(0);
    o[2] = MFMAX(f0, pb, o[2]);
    __builtin_amdgcn_sched_barrier(0);
    o[3] = MFMAX(f1, pb, o[3]);
    __builtin_amdgcn_sched_barrier(0);
}
__device__ __forceinline__ i32x8 exp_packx(const f32x16& p0, const f32x16& p1, int any) {
    i32x8 w;
#pragma unroll
    for (int g = 0; g < 4; ++g) {
        int a = __builtin_amdgcn_cvt_pk_fp8_f32(__builtin_amdgcn_exp2f(p0[4 * g + 0]), __builtin_amdgcn_exp2f(p0[4 * g + 1]), any, false);
        a = __builtin_amdgcn_cvt_pk_fp8_f32(__builtin_amdgcn_exp2f(p0[4 * g + 2]), __builtin_amdgcn_exp2f(p0[4 * g + 3]), a, true); w[g] = a;
        int b = __builtin_amdgcn_cvt_pk_fp8_f32(__builtin_amdgcn_exp2f(p1[4 * g + 0]), __builtin_amdgcn_exp2f(p1[4 * g + 1]), any, false);
        b = __builtin_amdgcn_cvt_pk_fp8_f32(__builtin_amdgcn_exp2f(p1[4 * g + 2]), __builtin_amdgcn_exp2f(p1[4 * g + 3]), b, true); w[4 + g] = b;
    }
    return w;
}
struct MlaPtrs { const bf16* Q; const bf16* K; const bf16* V; const bf16* Z; bf16* O; };
__device__ __forceinline__ void mla_unit(LAS unsigned char* lds, const MlaPtrs& P, int head, int qb, int tid_in, int wave, int lane_in) {
    int tid = tid_in; asm volatile("" : "+v"(tid)); const int lane = tid & 63; (void)lane_in;
    const int r32 = lane & 31, hi = lane >> 5;
    const int q0 = qb * 256, qw = q0 + wave * 32, tq = qw + r32;
    i32x8 q[3];
    { const unsigned char* qp = (const unsigned char*)P.Q + (size_t)tq * 3072 + head * 192 + hi * 32;
#pragma unroll
      for (int s = 0; s < 3; ++s) { const u32x4 a = *(const GAS u32x4*)(qp + 64 * s), b = *(const GAS u32x4*)(qp + 64 * s + 16);
          q[s] = (i32x8){(int)a.x, (int)a.y, (int)a.z, (int)a.w, (int)b.x, (int)b.y, (int)b.z, (int)b.w}; } }
    const int NT = 4 * (qb + 1);
    const int srow = tid >> 3, sc8 = tid & 7;
    const unsigned char* kg = (const unsigned char*)P.K + (size_t)head * 192 + (size_t)srow * 3072 + sc8 * 8;
    const unsigned char* vg = (const unsigned char*)P.V + ((size_t)head * 128 + (tid >> 2)) * S + (tid & 3) * 16;
    LAS unsigned char* kst = lds + srow * KSX + sc8 * 8;
    LAS unsigned char* vst = lds + 2 * MLA_KBX + (tid >> 2) * VSX + (tid & 3) * 16;
    const LAS unsigned char* kl = lds + r32 * KSX + hi * 32;
    const LAS unsigned char* vl = lds + 2 * MLA_KBX + r32 * VSX + hi * 32;
    u32x2 sk0, sk1, sk2; u32x4 sv0;
#define MLA_LOAD(j) do { const unsigned char* kp_ = kg + (size_t)(j) * (64 * 3072); const unsigned char* vp_ = vg + (size_t)(j) * 64; \
        sk0 = *(const GAS u32x2*)(kp_); sk1 = *(const GAS u32x2*)(kp_ + 64); sk2 = *(const GAS u32x2*)(kp_ + 128); sv0 = *(const GAS u32x4*)(vp_); } while (0)
#define MLA_STORE(b, vb) do { LAS unsigned char* kd_ = kst + (b) * MLA_KBX; LAS unsigned char* vd_ = vst + (vb) * VBX; \
        *(LAS u32x2*)(kd_) = sk0; *(LAS u32x2*)(kd_ + 64) = sk1; *(LAS u32x2*)(kd_ + 128) = sk2; *(LAS u32x2*)(vd_) = (u32x2){sv0.x, sv0.y}; *(LAS u32x2*)(vd_ + 8) = (u32x2){sv0.z, sv0.w}; } while (0)
    MLA_LOAD(0); MLA_STORE(0, 0);
    __syncthreads();
    asm volatile("" : "+v"(q[0]), "+v"(q[1]), "+v"(q[2]));
    f32x16 o[5], mref;
#pragma unroll
    for (int d = 0; d < 5; ++d)
#pragma unroll
        for (int r = 0; r < 16; ++r) o[d][r] = 0.f;
#pragma unroll
    for (int r = 0; r < 16; ++r) mref[r] = MXL_REF;
    const int one8 = (r32 == 0 || r32 == 4) ? 0x38383838 : 0;
    const i32x8 ones = {one8, one8, one8, one8, one8, one8, one8, one8};
    const bool trail = wave >= 4;
    i32x8 pb = {}, fa = {}, fb = {};
    int vb_cur = 0, vb_prev = 2;
    for (int j = 0; j < NT; ++j) {
        const int kb = 64 * j;
        int vb_next = vb_cur + 1; if (vb_next == 3) vb_next = 0;
        if (j + 1 < NT) MLA_LOAD(j + 1);
        if (trail && j > 0 && kb - 64 <= qw + 31) pv_tilexl_pre(o, pb, ones, vl + vb_prev * VBX, fa, fb);
        if (kb <= qw + 31) {
            f32x16 p0, p1;
            qk_tilexl(p0, p1, mref, kl + (j & 1) * MLA_KBX, q);
            fa = ldsx(vl + vb_cur * VBX); fb = ldsx(vl + vb_cur * VBX + 32 * VSX);
            __builtin_amdgcn_sched_barrier(0);
            if (kb + 63 > qw) {
                const int dq = tq - kb - 4 * hi;
#pragma unroll
                for (int r = 0; r < 16; ++r) { const int c = (r & 3) + 8 * (r >> 2);
                    if (c > dq) p0[r] = -__builtin_inff();
                    if (c + 32 > dq) p1[r] = -__builtin_inff(); }
            }
            float tm = p0[0];
#pragma unroll
            for (int r = 1; r < 16; ++r) tm = fmaxf(tm, p0[r]);
#pragma unroll
            for (int r = 0; r < 16; ++r) tm = fmaxf(tm, p1[r]);
            tm = swapmax(tm);
            if (j == 0 || !__all(tm <= MXL_T)) {
                const float dlt = (j == 0) ? tm - MXL_REF : fmaxf(tm - MXL_REF, 0.f);
                const float alpha = __builtin_amdgcn_exp2f(-0.125f * dlt);
#pragma unroll
                for (int r = 0; r < 16; ++r) { p0[r] -= dlt; p1[r] -= dlt; mref[r] -= dlt; }
                if (j > 0) {
#pragma unroll
                    for (int d = 0; d < 5; ++d)
#pragma unroll
                        for (int r = 0; r < 16; ++r) o[d][r] *= alpha;
                }
            }
            pb = byte_packx(p0, p1);
            if (!trail) pv_tilexl_pre(o, pb, ones, vl + vb_cur * VBX, fa, fb);
        }
        if (j + 1 < NT) MLA_STORE((j + 1) & 1, vb_next);
        __syncthreads();
        vb_prev = vb_cur; vb_cur = vb_next;
    }
    if (trail && 64 * (NT - 1) <= qw + 31) pv_tilexl_pre(o, pb, ones, vl + vb_prev * VBX, fa, fb);
    __syncthreads();
#undef MLA_LOAD
#undef MLA_STORE
    const bf16* zp = P.Z + (size_t)tq * 2048 + head * 128 + 4 * hi;
    const float inv = 16.f / o[4][0];
    unsigned char* op8 = (unsigned char*)P.O + (size_t)tq * 8192 + head * 128 + 4 * hi;
#pragma unroll
    for (int d0 = 0; d0 < 4; ++d0)
#pragma unroll
        for (int rg = 0; rg < 4; ++rg) { const int dim = 32 * d0 + 8 * rg;
            const u32x2 z = *(const GAS u32x2*)(zp + dim);
            int w = __builtin_amdgcn_cvt_pk_fp8_f32(o[d0][4 * rg + 0] * inv * bflo(z.x), o[d0][4 * rg + 1] * inv * bfhi(z.x), 0, false);
            w = __builtin_amdgcn_cvt_pk_fp8_f32(o[d0][4 * rg + 2] * inv * bflo(z.y), o[d0][4 * rg + 3] * inv * bfhi(z.y), w, true);
            *(GAS unsigned*)(op8 + dim) = (unsigned)w; }
}

struct NsaPtrs { const bf16* Q; const bf16* KV; const bf16* KC; const bf16* VC; const bf16* Z; const float* G; bf16* O; float* scr; };
template <int MODE>
__device__ __forceinline__ void nsa_loop(LAS unsigned char* lds, const unsigned char* kbase, const unsigned char* vbase, int ntiles, int jlo,
                                         const bf16x8 (&q)[8], int t, float slope2, float& m, float& l, f32x16 (&o)[4], float invl, int tid, int wave, int lane) {
    constexpr bool HASV = MODE != 0;
    const int r32 = lane & 31, hi = lane >> 5;
    const int srow = tid >> 3, sc8 = tid & 7;
    const unsigned soff = srow * 256 + sc8 * 16;
    LAS unsigned char* kst = lds + srow * KS_N + sc8 * 16;
    LAS unsigned char* vst = lds + 2 * NSA_KB + srow * VS + sc8 * 16;
    const LAS unsigned char* kl = lds + r32 * KS_N + hi * 16;
    const LAS unsigned char* vl = lds + 2 * NSA_KB + (4 * hi + ((lane & 15) >> 2)) * VS + (16 * ((lane >> 4) & 1) + 4 * (lane & 3)) * 2;
    const LAS int* ulist = (const LAS int*)(lds + N_ULIST);
    const LAS unsigned* selm = (const LAS unsigned*)(lds + N_SELM);
    LAS float* partA = (LAS float*)(lds + N_PART); LAS float* partB = (LAS float*)(lds + N_PART + N_PARTB);
    LAS float* imp = (LAS float*)(lds + N_IMP); LAS float* carry = (LAS float*)(lds + N_CARRY);
    if (ntiles <= 0) return;
    const float mlg = (MODE == 1) ? (invl > 0.f ? m - __builtin_amdgcn_logf(invl) : __builtin_inff()) : 0.f;
    u32x4 sk0, sk1, sv0, sv1;
#define NSA_TROW(j) (MODE == 2 ? 64 * __builtin_amdgcn_readfirstlane(ulist[ntiles - 1 - (j)]) : ((MODE == 3 || MODE == 0) ? 64 * (jlo + ntiles - 1 - (j)) : 64 * (jlo + (j))))
#define NSA_LOAD(j) do { const size_t ro_ = (size_t)NSA_TROW(j) * 256 + soff; \
        sk0 = *(const GAS u32x4*)(kbase + ro_); sk1 = *(const GAS u32x4*)(kbase + ro_ + 128); \
        if (HASV) { sv0 = *(const GAS u32x4*)(vbase + ro_); sv1 = *(const GAS u32x4*)(vbase + ro_ + 128); } } while (0)
#define NSA_STORE(b) do { LAS unsigned char* kd_ = kst + (b) * NSA_KB; *(LAS u32x4*)(kd_) = sk0; *(LAS u32x4*)(kd_ + 128) = sk1; \
        if (HASV) { LAS unsigned char* vd_ = vst + (b) * VB; *(LAS u32x4*)(vd_) = sv0; *(LAS u32x4*)(vd_ + 128) = sv1; } } while (0)
    NSA_LOAD(0); NSA_STORE(0);
    __syncthreads();
    for (int j = 0; j < ntiles; ++j) {
        const int buf = j & 1;
        if (MODE != 1 && j + 1 < ntiles) NSA_LOAD(j + 1);
        const int trow = NSA_TROW(j);
        constexpr int PSTEP = (MODE <= 1) ? 16 : 1;
        const int pstart = (MODE <= 1) ? 16 * trow + 31 : trow;
        const int db = t - pstart - PSTEP * 4 * hi;
        constexpr unsigned W = (MODE == 3) ? 512u : 0x7fffffffu;
        const bool mset = m > -1e29f;
        float b0 = -slope2 * (float)db - ((MODE != 1) ? (mset ? m : 0.f) : mlg);
        if (MODE == 2) { const int b = trow >> 6; if (((selm[r32 * 8 + (b >> 5)] >> (b & 31)) & 1u) == 0u) b0 = -__builtin_inff(); }
        f32x16 p0, p1;
#pragma unroll
        for (int r = 0; r < 16; ++r) { const int c = PSTEP * ((r & 3) + 8 * (r >> 2));
            p0[r] = __builtin_fmaf(slope2, (float)c, b0); p1[r] = __builtin_fmaf(slope2, (float)(c + 32 * PSTEP), b0); }
        qk_tile<8, KS_N, false>(p0, p1, kl + buf * NSA_KB, q);
        PvPre pp; if (MODE >= 2) { pv_preload(pp, vl + buf * VB); __builtin_amdgcn_sched_barrier(0); }
        { const int t0u = __builtin_amdgcn_readfirstlane(t - r32);
          const bool interior = (t0u - (pstart + PSTEP * 63) >= 0) && ((unsigned)(t0u + 31 - pstart) < W);
          if (!interior) {
#pragma unroll
              for (int r = 0; r < 16; ++r) { const int c = PSTEP * ((r & 3) + 8 * (r >> 2));
                  if ((unsigned)(db - c) >= W) p0[r] = -__builtin_inff();
                  if ((unsigned)(db - c - 32 * PSTEP) >= W) p1[r] = -__builtin_inff(); } } }
        if (MODE == 0) {
            float tm = p0[0];
#pragma unroll
            for (int r = 1; r < 16; ++r) tm = fmaxf(tm, p0[r]);
#pragma unroll
            for (int r = 0; r < 16; ++r) tm = fmaxf(tm, p1[r]);
            tm = swapmax(tm);
            const bool need = mset ? (tm > 16.f) : (tm > -1e29f);
            if (!__all(!need)) {
                const float dlt = need ? tm : 0.f;
                if (mset) l *= __builtin_amdgcn_exp2f(-dlt);
                if (need) m = (mset ? m : 0.f) + dlt;
#pragma unroll
                for (int r = 0; r < 16; ++r) { p0[r] -= dlt; p1[r] -= dlt; }
            }
            float ps = 0.f;
#pragma unroll
            for (int r = 0; r < 16; ++r) ps += __builtin_amdgcn_exp2f(p0[r]) + __builtin_amdgcn_exp2f(p1[r]);
            l += swapsum(ps);
        } else if (MODE == 1) {
#pragma unroll
            for (int r = 0; r < 16; ++r) { p0[r] = __builtin_amdgcn_exp2f(p0[r]); p1[r] = __builtin_amdgcn_exp2f(p1[r]); }
            LAS float* pa = partA + (wave * 32 + r32) * 17 + hi; LAS float* pbm = partB + (wave * 32 + r32) * 17 + hi;
#pragma unroll
            for (int rg = 0; rg < 4; ++rg) {
                pa[2 * rg] = (p0[4 * rg] + p0[4 * rg + 1]) + (p0[4 * rg + 2] + p0[4 * rg + 3]); pbm[2 * rg] = p0[4 * rg + 3];
                pa[8 + 2 * rg] = (p1[4 * rg] + p1[4 * rg + 1]) + (p1[4 * rg + 2] + p1[4 * rg + 3]); pbm[8 + 2 * rg] = p1[4 * rg + 3]; }
            const bf16x8 pb[4] = {packp<0>(p0), packp<1>(p0), packp<0>(p1), packp<1>(p1)};
            pv_tile(o, pb, vl + buf * VB);
            __syncthreads();
            { const int qq = tid >> 4, jl = tid & 15; float a = 0.f, bp = 0.f, bl = 0.f;
#pragma unroll
              for (int w = 0; w < 8; ++w) { a += partA[(w * 32 + qq) * 17 + jl]; bl += partB[(w * 32 + qq) * 17 + jl]; }
              if (jl > 0) {
#pragma unroll
                  for (int w = 0; w < 8; ++w) bp += partB[(w * 32 + qq) * 17 + jl - 1];
              } else bp = (j > 0) ? carry[((j - 1) & 1) * 32 + qq] : 0.f;
              imp[qq * 256 + 16 * j + jl] = a + bp;
              if (jl == 15) carry[(j & 1) * 32 + qq] = bl; }
        } else {
            constexpr float NSA_LAZY_T = 16.f;
            float tm = p0[0];
#pragma unroll
            for (int r = 1; r < 16; ++r) tm = fmaxf(tm, p0[r]);
#pragma unroll
            for (int r = 0; r < 16; ++r) tm = fmaxf(tm, p1[r]);
            tm = swapmax(tm);
            const bool need = mset ? (tm > NSA_LAZY_T) : (tm > -1e29f);
            if (!__all(!need)) {
                const float dlt = need ? tm : 0.f;
                const float alpha = mset ? __builtin_amdgcn_exp2f(-dlt) : 1.f;
                if (need) m = (mset ? m : 0.f) + dlt;
#pragma unroll
                for (int r = 0; r < 16; ++r) { p0[r] -= dlt; p1[r] -= dlt; }
                l *= alpha;
#pragma unroll
                for (int d_ = 0; d_ < 4; ++d_)
#pragma unroll
                    for (int r = 0; r < 16; ++r) o[d_][r] *= alpha;
            }
            float ps = 0.f;
#pragma unroll
            for (int r = 0; r < 16; ++r) { p0[r] = __builtin_amdgcn_exp2f(p0[r]); ps += p0[r]; }
#pragma unroll
            for (int r = 0; r < 16; ++r) { p1[r] = __builtin_amdgcn_exp2f(p1[r]); ps += p1[r]; }
            l += swapsum(ps);
            const bf16x8 pb[4] = {packp<0>(p0), packp<1>(p0), packp<0>(p1), packp<1>(p1)};
            pv_tile<true>(o, pb, vl + buf * VB, &pp);
        }
        if (MODE == 1 && j + 1 < ntiles) NSA_LOAD(j + 1);
        if (j + 1 < ntiles) NSA_STORE(buf ^ 1);
        __syncthreads();
    }
#undef NSA_TROW
#undef NSA_LOAD
#undef NSA_STORE
}
__device__ __forceinline__ void nsa_topk(const LAS float* improw, LAS unsigned* selrow, int cur, int lane) {
    unsigned key[4]; bool sel[4];
    int nforced = 0;
#pragma unroll
    for (int k = 0; k < 4; ++k) { const int j = lane + 64 * k;
        const bool forced = (j == 0) || (j == cur) || (j == cur - 1);
        const bool causal = j <= cur;
        sel[k] = forced;
        key[k] = (causal && !forced) ? (__float_as_uint(improw[j]) + 1u) : 0u;
    }
    nforced = 1 + (cur >= 1 ? 1 : 0) + (cur >= 2 ? 1 : 0);
    const int want = 16 - nforced;
    for (int it = 0; it < want; ++it) {
        unsigned bk = key[0]; int bj = lane;
#pragma unroll
        for (int k = 1; k < 4; ++k) { if (key[k] > bk) { bk = key[k]; bj = lane + 64 * k; } }
        unsigned long long best = ((unsigned long long)bk << 32) | (unsigned)(0xffffffffu - (unsigned)bj);
#pragma unroll
        for (int off = 1; off < 64; off <<= 1) {
            const unsigned lo = __shfl_xor((unsigned)best, off), hiw = __shfl_xor((unsigned)(best >> 32), off);
            const unsigned long long other = ((unsigned long long)hiw << 32) | lo;
            best = other > best ? other : best; }
        if ((unsigned)(best >> 32) == 0u) break;
        const int wj = (int)(0xffffffffu - (unsigned)best);
#pragma unroll
        for (int k = 0; k < 4; ++k) if (wj == lane + 64 * k) { key[k] = 0u; sel[k] = true; }
    }
#pragma unroll
    for (int k = 0; k < 4; ++k) { const unsigned long long bm = __ballot(sel[k]);
        if (lane == 0) { selrow[2 * k] = (unsigned)bm; selrow[2 * k + 1] = (unsigned)(bm >> 32); } }
}
__device__ __forceinline__ int cnt_ge(unsigned key, unsigned thr) { unsigned long long m_; asm("v_cmp_ge_u32_e64 %0, %1, %2" : "=s"(m_) : "v"(key), "s"(thr)); return __builtin_popcountll(m_); }
__device__ __forceinline__ int cnt_gt(unsigned key, unsigned thr) { unsigned long long m_; asm("v_cmp_gt_u32_e64 %0, %1, %2" : "=s"(m_) : "v"(key), "s"(thr)); return __builtin_popcountll(m_); }
__device__ __forceinline__ void nsa_topk4(const LAS float* imp0, LAS unsigned* sel0, int cur, int lane) {
    unsigned key[4][4]; bool forced[4];
#pragma unroll
    for (int k = 0; k < 4; ++k) { const int j = lane + 64 * k;
        forced[k] = (j == 0) || (j == cur) || (j == cur - 1);
        const bool cand = (j <= cur) && !forced[k];
#pragma unroll
        for (int i = 0; i < 4; ++i) { const unsigned v_ = __float_as_uint(imp0[i * 256 + j]) + 1u; key[i][k] = cand ? v_ : 0u; } }
    const int want = 16 - (1 + (cur >= 1 ? 1 : 0) + (cur >= 2 ? 1 : 0));
    unsigned T[4] = {0u, 0u, 0u, 0u};
#pragma unroll 1
    for (int bit = 30; bit >= 0; --bit) {
        const unsigned bm = 1u << bit;
        unsigned long long mk[4][4];
#pragma unroll
        for (int i = 0; i < 4; ++i) { const unsigned c = T[i] | bm;
#pragma unroll
            for (int k = 0; k < 4; ++k) asm volatile("v_cmp_ge_u32_e64 %0, %1, %2" : "=s"(mk[i][k]) : "v"(key[i][k]), "s"(c)); }
        __builtin_amdgcn_sched_barrier(0);
#pragma unroll
        for (int i = 0; i < 4; ++i) { const int n = (__builtin_popcountll(mk[i][0]) + __builtin_popcountll(mk[i][1])) + (__builtin_popcountll(mk[i][2]) + __builtin_popcountll(mk[i][3]));
            if (n >= want) T[i] |= bm; }
    }
#pragma unroll
    for (int i = 0; i < 4; ++i) {
        const unsigned Ti = T[i];
        int rem = want - ((cnt_gt(key[i][0], Ti) + cnt_gt(key[i][1], Ti)) + (cnt_gt(key[i][2], Ti) + cnt_gt(key[i][3], Ti)));
        unsigned long long bmv[4];
#pragma unroll
        for (int k = 0; k < 4; ++k) {
            const bool eq = (Ti != 0u) && key[i][k] == Ti; const unsigned long long em = __ballot(eq);
            const int below = (int)__builtin_amdgcn_mbcnt_hi((unsigned)(em >> 32), __builtin_amdgcn_mbcnt_lo((unsigned)em, 0u));
            const bool s = forced[k] || (Ti == 0u ? key[i][k] >= 1u : (key[i][k] > Ti || (eq && below < rem)));
            rem -= __builtin_popcountll(em); if (rem < 0) rem = 0;
            bmv[k] = __ballot(s);
        }
        if (lane < 8) { const unsigned long long w_ = bmv[lane >> 1]; sel0[i * 8 + lane] = (lane & 1) ? (unsigned)(w_ >> 32) : (unsigned)w_; }
    }
}
__device__ __forceinline__ int nsa_opaque(int v) { asm volatile("" : "+v"(v)); return v; }
__device__ __forceinline__ void nsa_unit(LAS unsigned char* lds, const NsaPtrs& P, int g, int qblk, int tid_in, int wave, int lane_in, int cu) {
    int tid = tid_in; asm volatile("" : "+v"(tid));
    const int lane = tid & 63; (void)lane_in;
    const int r32 = lane & 31, hi = lane >> 5;
    const int hh = 8 * g + wave, t0 = 32 * qblk, t = t0 + r32;
    const float slope2 = __builtin_amdgcn_exp2f(-0.5f * (float)(hh + 1)) * LOG2E;
    bf16x8 q[8];
    { const bf16* qp = P.Q + (size_t)t * 2048 + hh * 128 + hi * 8;
#pragma unroll
      for (int d0 = 0; d0 < 8; ++d0) q[d0] = *(const GAS bf16x8*)(qp + d0 * 16); }
#define NSA_SCR() ((GAS f32x4*)(P.scr + ((size_t)(cu * 8 + wave) * 16) * 256) + nsa_opaque(lane))
    const size_t CH = (size_t)S * 128 * 2;
    f32x16 o[4]; float m, l;
#define NSA_SCR2 ((size_t)256 * 8 * 16 * 64)
#define NSA_ZERO_O() do { _Pragma("unroll") for (int d_ = 0; d_ < 4; ++d_) _Pragma("unroll") for (int r_ = 0; r_ < 16; ++r_) o[d_][r_] = 0.f; } while (0)
    const int ncv = 2 * qblk + 1, ntc = (ncv + 63) >> 6;
    const unsigned char* kc = (const unsigned char*)P.KC + (size_t)g * 1024 * 256; const unsigned char* vc = (const unsigned char*)P.VC + (size_t)g * 1024 * 256;
    m = -1e30f; l = 0.f; NSA_ZERO_O();
    nsa_loop<0>(lds, kc, vc, ntc, 0, q, t, slope2, m, l, o, 0.f, tid, wave, lane);
    const float invl = l > 0.f ? 1.f / l : 0.f;
    nsa_loop<1>(lds, kc, vc, ntc, 0, q, t, slope2, m, l, o, invl, tid, wave, lane);
    { const float g_c = P.G[(size_t)t * 48 + hh]; GAS f32x4* scr = NSA_SCR();
#pragma unroll
    for (int d0 = 0; d0 < 4; ++d0)
#pragma unroll
        for (int rg = 0; rg < 4; ++rg) { f32x4 v = {o[d0][4 * rg] * g_c, o[d0][4 * rg + 1] * g_c, o[d0][4 * rg + 2] * g_c, o[d0][4 * rg + 3] * g_c}; scr[(d0 * 4 + rg) * 64] = v; } }
    const int cur = t0 >> 6;
    LAS unsigned* selm = (LAS unsigned*)(lds + N_SELM);
    nsa_topk4((const LAS float*)(lds + N_IMP) + 4 * wave * 256, selm + 4 * wave * 8, cur, lane);
    __syncthreads();
    int nts;
    { LAS int* ulist = (LAS int*)(lds + N_ULIST); LAS int* ucnt = (LAS int*)(lds + N_NTS) + 4;
      unsigned u = (lane < 32) ? selm[lane * 8 + wave] : 0u;
#pragma unroll
      for (int off = 1; off < 32; off <<= 1) u |= __shfl_xor(u, off);
      u = __builtin_amdgcn_readfirstlane(u);
      if (lane == 0) ucnt[wave] = __builtin_popcount(u);
      __syncthreads();
      int off = 0, tot = 0;
#pragma unroll
      for (int k = 0; k < 8; ++k) { const int c = __builtin_amdgcn_readfirstlane(ucnt[k]); off += (k < wave) ? c : 0; tot += c; }
      if (lane < 32 && ((u >> lane) & 1u)) ulist[off + __builtin_popcount(u & ((1u << lane) - 1u))] = 32 * wave + lane;
      nts = tot; }
    __syncthreads();
    m = -1e30f; l = 0.f; NSA_ZERO_O();
    nsa_loop<2>(lds, (const unsigned char*)P.KV + (size_t)(4 + g) * CH, (const unsigned char*)P.KV + (size_t)(6 + g) * CH, nts, 0, q, t, slope2, m, l, o, 0.f, tid, wave, lane);
    { const float f = P.G[(size_t)t * 48 + 16 + hh] / l; GAS f32x4* scr = NSA_SCR() + NSA_SCR2;
#pragma unroll
      for (int d0 = 0; d0 < 4; ++d0)
#pragma unroll
          for (int rg = 0; rg < 4; ++rg) { f32x4 v = {o[d0][4 * rg] * f, o[d0][4 * rg + 1] * f, o[d0][4 * rg + 2] * f, o[d0][4 * rg + 3] * f}; scr[(d0 * 4 + rg) * 64] = v; } }
    const int jlo = (t0 > 511 ? t0 - 511 : 0) >> 6, jhi = (t0 + 31) >> 6;
    m = -1e30f; l = 0.f; NSA_ZERO_O();
    nsa_loop<3>(lds, (const unsigned char*)P.KV + (size_t)(8 + g) * CH, (const unsigned char*)P.KV + (size_t)(10 + g) * CH, jhi - jlo + 1, jlo, q, t, slope2, m, l, o, 0.f, tid, wave, lane);
    { const float f = P.G[(size_t)t * 48 + 32 + hh] / l; GAS f32x4* scr = NSA_SCR();
      const bf16* zp = P.Z + (size_t)t * 2048 + hh * 128 + 4 * hi;
      bf16* op = P.O + (size_t)t * 4096 + 2048 + hh * 128 + 4 * hi;
#pragma unroll
      for (int dp = 0; dp < 2; ++dp)
          { f32x4 av[8], bv[8]; u32x2 zv[8];
#pragma unroll
            for (int i = 0; i < 8; ++i) { const int d0 = 2 * dp + (i >> 2), rg = i & 3; av[i] = scr[(d0 * 4 + rg) * 64]; bv[i] = scr[NSA_SCR2 + (d0 * 4 + rg) * 64]; zv[i] = *(const GAS u32x2*)(zp + 32 * d0 + 8 * rg); }
#pragma unroll
            for (int i = 0; i < 8; ++i) { const int d0 = 2 * dp + (i >> 2), rg = i & 3; const int dim = 32 * d0 + 8 * rg; const f32x4 a = av[i] + bv[i];
                const u32x2 z = zv[i];
                u32x2 w; w.x = pk2((a[0] + o[d0][4 * rg] * f) * bflo(z.x), (a[1] + o[d0][4 * rg + 1] * f) * bfhi(z.x)); w.y = pk2((a[2] + o[d0][4 * rg + 2] * f) * bflo(z.y), (a[3] + o[d0][4 * rg + 3] * f) * bfhi(z.y));
                *(GAS u32x2*)(op + dim) = w; } } }
#undef NSA_ZERO_O
#undef NSA_SCR
#undef NSA_SCR2
}
struct CmpPtrs { const bf16* KV; const bf16* W1; const bf16* W2; const float* cbp; bf16* KC; bf16* VC; };
__device__ __forceinline__ void cmp_unit(LAS unsigned char* lds, const CmpPtrs& P, int kv, int g, int tile, int tid, int wave, int lane) {
    const int fr = lane & 15, fq = lane >> 4;
    constexpr int CRS = 544;
    LAS unsigned char* As = lds + 16384;
    LAS unsigned char* Ws = As + 16 * CRS;
    const unsigned char* Ag = (const unsigned char*)(P.KV + (size_t)(kv * 2 + g) * ((size_t)S * 128) + (size_t)(16 * tile + (tid >> 5)) * 2048) + (tid & 31) * 16;
    const unsigned char* Wg = (const unsigned char*)(P.W1 + (size_t)kv * 128 * 4096 + (size_t)(tid >> 5) * 4096) + (tid & 31) * 16;
    LAS unsigned char* Ad = As + (tid >> 5) * CRS + (tid & 31) * 16;
    LAS unsigned char* Wd = Ws + (tid >> 5) * CRS + (tid & 31) * 16;
    const LAS unsigned char* Ar = As + fr * CRS + fq * 16;
    const LAS unsigned char* Wr = Ws + (16 * wave + fr) * CRS + fq * 16;
    u32x4 ra[4], rw[4][8];
#define CMP_LOAD(c) do { ra[(c) & 3] = *(const GAS u32x4*)(Ag + (c) * 512); _Pragma("unroll") for (int i_ = 0; i_ < 8; ++i_) rw[(c) & 3][i_] = *(const GAS u32x4*)(Wg + (size_t)i_ * (16 * 8192) + (c) * 512); } while (0)
    CMP_LOAD(0); CMP_LOAD(1); CMP_LOAD(2);
    f32x4 acc = {0.f, 0.f, 0.f, 0.f};
#pragma unroll
    for (int c = 0; c < 16; ++c) {
        *(LAS u32x4*)Ad = ra[c & 3];
#pragma unroll
        for (int i = 0; i < 8; ++i) *(LAS u32x4*)(Wd + i * 16 * CRS) = rw[c & 3][i];
        __syncthreads();
        if (c + 3 < 16) CMP_LOAD(c + 3);
#pragma unroll
        for (int s = 0; s < 8; ++s) {
            const bf16x8 a = *(const LAS bf16x8*)(Ar + 64 * s), b = *(const LAS bf16x8*)(Wr + 64 * s);
            acc = __builtin_amdgcn_mfma_f32_16x16x32_bf16(a, b, acc, 0, 0, 0);
        }
        __syncthreads();
    }
#undef CMP_LOAD
    float bias = 0.f;
    { float bv[16];
#pragma unroll
      for (int c = 0; c < 16; ++c) bv[c] = *(const GAS float*)(P.cbp + (size_t)(kv * 16 + c) * 128 + 16 * wave + fr);
#pragma unroll
      for (int c = 0; c < 16; ++c) bias += bv[c]; }
    LAS bf16* hid = (LAS bf16*)lds;
#pragma unroll
    for (int i = 0; i < 4; ++i) hid[(4 * fq + i) * 136 + 16 * wave + fr] = (bf16)(pk2(silu_f(acc[i] + bias), 0.f) & 0xffffu);
    __syncthreads();
    const bf16* B2 = P.W2 + (size_t)kv * 128 * 128 + (size_t)(16 * wave + fr) * 128 + 8 * fq;
    f32x4 acc2 = {0.f, 0.f, 0.f, 0.f};
#pragma unroll
    for (int s = 0; s < 4; ++s) {
        const bf16x8 a = *(const LAS bf16x8*)(hid + fr * 136 + 32 * s + 8 * fq), b = *(const GAS bf16x8*)(B2 + 32 * s);
        acc2 = __builtin_amdgcn_mfma_f32_16x16x32_bf16(a, b, acc2, 0, 0, 0);
    }
    bf16* out = (kv ? P.VC : P.KC) + (size_t)g * 1024 * 128;
#pragma unroll
    for (int i = 0; i < 4; ++i) { const int nn = 16 * tile + 4 * fq + i; out[(size_t)nn * 128 + 16 * wave + fr] = (nn < 1023) ? (bf16)(pk2(acc2[i], 0.f) & 0xffffu) : (bf16)0; }
    __syncthreads();
}
}
constexpr int PPL = 6;
constexpr int N_PHASES = 2 + PPL * DEPTH;
struct Args { const void* in[16]; float* out; unsigned char* ws; int ph_lo, ph_hi; };
#define WSP(T, off) ((T*)(ws + (off)))
#define VCU() ((gridDim.x % 8 == 0) ? (int)((blockIdx.x % 8) * (gridDim.x / 8) + blockIdx.x / 8) : (int)blockIdx.x)
__global__ void __launch_bounds__(NTHR, 2) mk_fwd(const Args args) {
    extern __shared__ __attribute__((aligned(16))) unsigned char lds_raw[];
    LAS unsigned char* lds = (LAS unsigned char*)lds_raw;
    if (threadIdx.x < 32) ((volatile LAS unsigned*)(lds + MISC_OFF))[threadIdx.x] = 0u;
    __syncthreads();
    XcdBarrier bar = xcd_barrier_post((unsigned*)(args.ws + WS_CTL) + CW_BAR, (volatile LAS unsigned*)(lds + MISC_OFF) + 8);
#define IN(k) (args.ph_lo <= (k) && (k) < args.ph_hi)
#define SEAM(k) do { if (IN(k) && IN((k) + 1)) xcd_barrier(bar); } while (0)
#define PHASE_REGS int tid_ = threadIdx.x; asm volatile("" : "+v"(tid_)); const int tid = tid_, lane = tid & 63, wave = __builtin_amdgcn_readfirstlane(tid >> 6); \
    unsigned char* ws = args.ws; asm volatile("" : "+s"(ws)); (void)tid; (void)lane; (void)wave

    if (IN(0)) {
        PHASE_REGS; const int G = gridDim.x, vcu = VCU();
        p0_mod_gemv((const float*)args.in[1], (const float*)args.in[3], (const float*)args.in[4], WSP(float, WS_MOD), (LAS float*)lds, vcu, G);
        p0_cmpbias((const float*)args.in[10], (const float*)args.in[11], WSP(float, WS_CBP), (LAS float*)lds, (vcu + G / 2) % G, G);
        p0_rope((const int*)args.in[2], WSP(float, WS_ROPE), WSP(float, WS_ROPE) + (size_t)S * 32, vcu * NTHR + tid, G * NTHR);
        const P0In I{(const float*)args.in[5], (const float*)args.in[6], (const float*)args.in[7], (const float*)args.in[8], (const float*)args.in[9], (const float*)args.in[11], (const float*)args.in[12], (const float*)args.in[13]};
        p0_convert(I, ws, vcu * NWAVES + wave, G * NWAVES, lane);
    }
    SEAM(0);
#define H8PTR WSP(unsigned char, WS_H8)
    if (IN(1)) { PHASE_REGS; modulate_rows((const float*)args.in[0], WSP(bf16, WS_H), H8PTR, WSP(float, WS_MOD), (LAS float*)lds, tid, VCU() * NWAVES + wave, gridDim.x * NWAVES, lane);
    }
    SEAM(1);
    for (int l = 0; l < DEPTH; ++l) {
        const int pb = 2 + PPL * l;
        if (IN(pb + 0)) {
            PHASE_REGS;
            { pg8::Gemm gg{WSP(bf16, WS_H), (const bf16*)(ws + WS_W + (size_t)l * W_LSTRIDE + W_IN), S, 23 * 256, D}; pg8::InBf16Order SO; SO.init(S, 23 * 256, gridDim.x, blockIdx.x);
              const pg8::EpiIn E{ws, 0};
              pg8::gemm_phase<pg8::EpiIn, pg8::InBf16Order, true, true>(lds, gg, SO, E);
            }
            { pg8::Gemm gg{(const bf16*)(ws + WS_H8), (const bf16*)(ws + WS_WIN8 + (size_t)l * WIN8_LSTRIDE), S, 13 * 256, D / 2}; pg8::StaticOrder SO; SO.init(S, 13 * 256, gridDim.x, (blockIdx.x + 64) % gridDim.x);
              const pg8::EpiIn E{ws, 1};
              pg8::gemm_phase<pg8::EpiIn, pg8::StaticOrder, true, true, 0x79797979, 0x7f7f7f7f>(lds, gg, SO, E);
            }
        }
        SEAM(pb + 0);
        if (IN(pb + 1)) {
            PHASE_REGS; const int G = gridDim.x, vcu = VCU();
            rstd_rows(WSP(float, WS_RSQQ), WSP(float, WS_RSQKV), WSP(float, WS_RSTD), WSP(float, WS_RSTD) + S, vcu * NTHR + tid, G * NTHR);
            const att::CmpPtrs CP{WSP(bf16, WS_KVNSA), (const bf16*)(ws + WS_W + (size_t)l * W_LSTRIDE + W_C1), (const bf16*)(ws + WS_W + (size_t)l * W_LSTRIDE + W_C2),
                                  WSP(float, WS_CBP) + (size_t)l * 2 * 16 * 128, WSP(bf16, WS_KCMP), WSP(bf16, WS_VCMP)};
            for (int u = vcu; u < 256; u += G) att::cmp_unit(lds, CP, u & 1, (u >> 1) & 1, u >> 2, tid, wave, lane);
        }
        SEAM(pb + 1);
        if (IN(pb + 2)) {
            PHASE_REGS;
            { pg8::Gemm gg{WSP(bf16, WS_QLAT), (const bf16*)(ws + WS_W + (size_t)l * W_LSTRIDE + W_QUP), S, 3072, 384}; pg8::StaticOrder SO; SO.init(S, 3072, gridDim.x, blockIdx.x);
              const pg8::EpiQup E{ws};
              pg8::gemm_phase<pg8::EpiQup, pg8::StaticOrder, true, true, 0x7a7a7a7a, 0x7f7f7f7f>(lds, gg, SO, E);
            }
            { pg8::Gemm gg{WSP(bf16, WS_KVLAT), (const bf16*)(ws + WS_W + (size_t)l * W_LSTRIDE + W_KVUP), S, 2048, 256}; pg8::StaticOrder SO; SO.init(S, 2048, gridDim.x, blockIdx.x);
              const pg8::EpiKup E{ws};
              pg8::gemm_phase<pg8::EpiKup, pg8::StaticOrder, true, true, 0x7a7a7a7a, 0x7f7f7f7f>(lds, gg, SO, E);
            }
            { pg8::Gemm gg{(const bf16*)(ws + WS_W + (size_t)l * W_LSTRIDE + W_KVUP + (size_t)2048 * 512), WSP(bf16, WS_KVLAT), 2048, S, 256}; pg8::StaticOrder SO; SO.init(2048, S, gridDim.x, blockIdx.x);
              const pg8::EpiVt E{ws};
              pg8::gemm_phase<pg8::EpiVt, pg8::StaticOrder, true, true, 0x7f7f7f7f, 0x7a7a7a7a>(lds, gg, SO, E);
            }
        }
        SEAM(pb + 2);
        if (IN(pb + 3)) {
            PHASE_REGS; const int G = gridDim.x, vcu = VCU();
            { const att::MlaPtrs MP{WSP(bf16, WS_QMLA), WSP(bf16, WS_KMLA), WSP(bf16, WS_VMLA), WSP(bf16, WS_ZMLA), WSP(bf16, WS_H)};
              for (int pu = vcu; pu < 512; pu += G) { const int head = pu >> 5, pr = pu & 31;
                  att::mla_unit(lds, MP, head, 63 - pr, tid, wave, lane);
                  att::mla_unit(lds, MP, head, pr, tid, wave, lane);
              }
            }
            { const att::NsaPtrs NP{WSP(bf16, WS_QNSA), WSP(bf16, WS_KVNSA), WSP(bf16, WS_KCMP), WSP(bf16, WS_VCMP), WSP(bf16, WS_ZNSA), WSP(float, WS_GNSA), WSP(bf16, WS_H), WSP(float, WS_OSCR)};
              { unsigned* qctr = (unsigned*)(ws + WS_CTL) + CW_NSAQ + 64 * l; volatile LAS unsigned* uw = (volatile LAS unsigned*)(lds + MISC_OFF) + 16;
                for (;;) {
                    __syncthreads();
                    if (tid == 0) *uw = __hip_atomic_fetch_add(qctr, 1u, __ATOMIC_RELAXED, __HIP_MEMORY_SCOPE_AGENT);
                    __syncthreads();
                    const int u = __builtin_amdgcn_readfirstlane((int)*uw);
                    if (u >= 1024) break;
                    att::nsa_unit(lds, NP, u & 1, 511 - (u >> 1), tid, wave, lane, blockIdx.x); } }
            }
        }
        SEAM(pb + 3);
        if (IN(pb + 4)) {
            PHASE_REGS;
            pg8::StaticOrder SO; SO.init(S, D, gridDim.x, blockIdx.x);
            const pg8::EpiOut E{WSP(bf16, WS_Y), WSP(const float, WS_MOD) + (size_t)l * 3 * D + 2 * D};
            const pg8::GemmMix gm{ws + WS_H, ws + WS_W + (size_t)l * W_LSTRIDE + W_OUT, D, 1024, 2048, 2048, S, D};
            pg8::gemm_phase_mix<pg8::EpiOut, pg8::StaticOrder, 0x78787878, 0x7b7b7b7b>(lds, gm, SO, E);
        }
        SEAM(pb + 4);
        if (IN(pb + 5)) {
            PHASE_REGS;
            if (l == 0) ln_rows<false, true>(args.in[0], WSP(const bf16, WS_Y), WSP(void, WS_XV), WSP(bf16, WS_H), H8PTR, (const float*)args.in[14], (const float*)args.in[15],
                    WSP(const float, WS_MOD) + (size_t)3 * D, (LAS float*)lds, tid, VCU() * NWAVES + wave, gridDim.x * NWAVES, lane);
            else ln_rows<true, false>(WSP(const void, WS_XV), WSP(const bf16, WS_Y), args.out, nullptr, nullptr, (const float*)args.in[14] + (size_t)l * D, (const float*)args.in[15] + (size_t)l * D,
                    WSP(const float, WS_MOD) + (size_t)(l + 1) * 3 * D, (LAS float*)lds, tid, VCU() * NWAVES + wave, gridDim.x * NWAVES, lane);
        }
        SEAM(pb + 5);
    }
#undef IN
#undef SEAM
}


#ifndef MK_PER_PHASE
#define MK_PER_PHASE 0
#endif
extern "C" void kernel_launch(void* const* d_in, const int* in_sizes, int n_in, void* d_out, int out_size, void* d_ws, size_t ws_size, hipStream_t stream) {
    static int grid = 0;
    if (grid == 0) {
        if (n_in != 16 || out_size != S * D || ws_size < WS_END) { fprintf(stderr, "kernel_launch: unexpected shapes n_in %d out %d ws %zu\n", n_in, out_size, ws_size); grid = -1; return; }
        int dev = 0, cus = 0;
        if (hipGetDevice(&dev) != hipSuccess || hipDeviceGetAttribute(&cus, hipDeviceAttributeMultiprocessorCount, dev) != hipSuccess) { grid = -1; return; }
        if (hipFuncSetAttribute((const void*)mk_fwd, hipFuncAttributeMaxDynamicSharedMemorySize, LDS_BYTES) != hipSuccess) { grid = -1; return; }
        int per_cu = 0;
        (void)hipOccupancyMaxActiveBlocksPerMultiprocessor(&per_cu, (const void*)mk_fwd, NTHR, LDS_BYTES);
        (void)hipGetLastError();
        if (per_cu < 1) fprintf(stderr, "kernel_launch: occupancy query says %d\n", per_cu);
        grid = cus;
    }
    if (grid < 0) return;
    (void)hipMemsetAsync((char*)d_ws + WS_CTL, 0, CTL_ZERO_BYTES, stream);
    Args a{};
    for (int i = 0; i < 16; ++i) a.in[i] = d_in[i];
    a.out = (float*)d_out; a.ws = (unsigned char*)d_ws;
    a.ph_lo = 0; a.ph_hi = N_PHASES;
    hipLaunchKernelGGL(mk_fwd, dim3(grid), dim3(NTHR), LDS_BYTES, stream, a);
}
```

```cpp
#include <hip/hip_runtime.h>
#define MLA_FP8 1
#define MLA_FP8V 1
#define MLA_MXU 1
#define MLA_MXL 1
#define MLA_MX 1
#define OUT_F8 1
#define YBF16 1
#define GEMM_F8 1
#include <cstdio>
#include <cstdint>

#define GAS __attribute__((address_space(1)))
#define LAS __attribute__((address_space(3)))
typedef unsigned short bf16;
typedef float f32x4 __attribute__((ext_vector_type(4)));
typedef float f32x2 __attribute__((ext_vector_type(2)));
typedef float f32x8 __attribute__((ext_vector_type(8)));
typedef float f32x16 __attribute__((ext_vector_type(16)));
typedef unsigned u32x4 __attribute__((ext_vector_type(4)));
typedef unsigned u32x2 __attribute__((ext_vector_type(2)));
typedef short bf16x8 __attribute__((ext_vector_type(8)));
typedef short s16x4 __attribute__((ext_vector_type(4)));
typedef __bf16 bf16x2v __attribute__((ext_vector_type(2)));
typedef __bf16 bf16x8v __attribute__((ext_vector_type(8)));
typedef GAS unsigned gu32;

constexpr int S = 16384, D = 4096, DEPTH = 2;
constexpr int INC = 9072, NIN = 9216;
constexpr float LN_EPS = 1e-5f, RMS_EPS = 1e-6f;
constexpr float DN_ALPHA = 1.41421356237309515f;
constexpr float LOG2E = 1.4426950408889634f;
constexpr float QS_MLA = 0.07216878364870322f * LOG2E;
constexpr float QS_NSA = 0.08838834764831845f * LOG2E;
constexpr int NWAVES = 8, NTHR = 512;
constexpr size_t MiB = 1u << 20;
constexpr size_t WS_CTL = 0, CTL_ZERO_BYTES = 1 * MiB;
constexpr size_t WS_MOD = 1 * MiB;
constexpr size_t WS_ROPE = 2 * MiB;
constexpr size_t WS_CBP = 6 * MiB;
constexpr size_t WS_RSQQ = 7 * MiB;
constexpr size_t WS_RSQKV = 9 * MiB;
constexpr size_t WS_RSTD = 6 * MiB + 512 * 1024;
constexpr size_t WS_GNSA = 10 * MiB;
constexpr size_t WS_KCMP = 13 * MiB;
constexpr size_t WS_VCMP = 13 * MiB + 512 * 1024;
constexpr size_t WS_W = 16 * MiB, W_LSTRIDE = 120 * MiB;
constexpr size_t W_IN = 0, W_QUP = 72 * MiB, W_KVUP = 77 * MiB, W_OUT = 81 * MiB, W_C1 = 113 * MiB, W_C2 = 115 * MiB;
constexpr size_t WS_H = 256 * MiB;
constexpr size_t WS_XV = 384 * MiB;
constexpr size_t WS_QLAT = 640 * MiB, WS_KVLAT = 664 * MiB;
constexpr size_t WS_QMLA = 680 * MiB, WS_KMLA = 728 * MiB, WS_VMLA = 872 * MiB, WS_ZMLA = 936 * MiB, WS_ZNSA = 1000 * MiB, WS_QNSA = 1064 * MiB;
constexpr size_t WS_Y = 936 * MiB;
constexpr size_t WS_H8 = 776 * MiB;
constexpr size_t WS_WIN8 = 840 * MiB, WIN8_LSTRIDE = 13 * MiB;
constexpr size_t WS_KVNSA = 1128 * MiB;
constexpr size_t WS_OSCR = 1178 * MiB;
constexpr size_t WS_END = 1242 * MiB;
constexpr int CW_BAR = 4096;
constexpr int CW_NSAQ = 16384;
constexpr int LDS_BYTES = 147456;
constexpr int MISC_OFF = LDS_BYTES - 128;

__device__ __forceinline__ unsigned pk2(float lo, float hi) { f32x2 a = {lo, hi}; return __builtin_bit_cast(unsigned, __builtin_convertvector(a, bf16x2v)); }
__device__ __forceinline__ u32x4 pk8(f32x4 a, f32x4 b) { u32x4 w; w.x = pk2(a[0], a[1]); w.y = pk2(a[2], a[3]); w.z = pk2(b[0], b[1]); w.w = pk2(b[2], b[3]); return w; }
__device__ __forceinline__ float bflo(unsigned u) { return __uint_as_float(u << 16); }
__device__ __forceinline__ float bfhi(unsigned u) { return __uint_as_float(u & 0xffff0000u); }
__device__ __forceinline__ float wave_sum(float v) {
#pragma unroll
    for (int o = 1; o < 64; o <<= 1) v += __shfl_xor(v, o);
    return v;
}
__device__ __forceinline__ float silu_f(float v) { return v * __builtin_amdgcn_rcpf(1.f + __expf(-v)); }
__device__ __forceinline__ float sigm_f(float v) { return __builtin_amdgcn_rcpf(1.f + __expf(-v)); }

#define XB_TMO      128
#define XB_XCNT(j)  (256  + 64 * (j))
#define XB_XSUB(j)  (1280 + 64 * (j))
#define XB_XGEN(j)  (2304 + 64 * (j))
#define XB_TOP      3328
#define XB_TOPGEN   3392
#define XCD_BAR_WORDS 3456
#define XB_SPIN_CAP (1u << 18)
__device__ __forceinline__ unsigned xb_ld(unsigned* p)              { return __hip_atomic_load(p, __ATOMIC_RELAXED, __HIP_MEMORY_SCOPE_AGENT); }
__device__ __forceinline__ unsigned xb_add(unsigned* p, unsigned v) { return __hip_atomic_fetch_add(p, v, __ATOMIC_RELAXED, __HIP_MEMORY_SCOPE_AGENT); }
__device__ __forceinline__ unsigned xb_xcc_id() { return (unsigned)__builtin_amdgcn_s_getreg((3 << 11) | 20) & 0xFu; }
#define XB_SPIN(cond, bar) do { unsigned _sp = 0; while (cond) { __builtin_amdgcn_s_sleep(1); \
    if ((++_sp & 255u) == 0u) { if (xb_ld(&(bar)[XB_TMO])) break; if (_sp > XB_SPIN_CAP) { atomicAdd(&(bar)[XB_TMO], 1u); break; } } } } while (0)
struct XcdBarrier { unsigned* bar; unsigned x; volatile LAS unsigned* st; };
__device__ __forceinline__ XcdBarrier xcd_barrier_post(unsigned* bar, volatile LAS unsigned* st) {
    XcdBarrier b; b.bar = bar; b.x = xb_xcc_id(); b.st = st;
    if (threadIdx.x == 0) (void)xb_add(&bar[XB_XCNT(b.x)], 1u);
    return b;
}
__device__ __forceinline__ void xcd_barrier_complete(unsigned* bar, unsigned x, unsigned& nloc, unsigned& nx) {
    const unsigned G = gridDim.x * gridDim.y * gridDim.z;
    unsigned sum, cnt, mine, sp = 0u;
    for (;;) {
        sum = 0u; cnt = 0u; mine = 0u;
#pragma unroll
        for (unsigned j = 0; j < 16; ++j) { const unsigned c = xb_ld(&bar[XB_XCNT(j)]); sum += c; cnt += (c > 0u) ? 1u : 0u; mine = (j == x) ? c : mine; }
        if (sum == G) break;
        __builtin_amdgcn_s_sleep(1);
        if ((++sp & 255u) == 0u) { if (xb_ld(&bar[XB_TMO])) break; if (sp > XB_SPIN_CAP) { atomicAdd(&bar[XB_TMO], 1u); break; } }
    }
    nloc = mine > 0u ? mine : 1u; nx = cnt > 0u ? cnt : 1u;
}
__device__ __forceinline__ void xcd_barrier(const XcdBarrier& b) {
    asm volatile("s_waitcnt vmcnt(0)" ::: "memory");
    __syncthreads();
    if (threadIdx.x == 0) {
        unsigned* bar = b.bar;
        __builtin_amdgcn_s_waitcnt(0);
        unsigned nloc = b.st[0], nx = b.st[1];
        if (nloc == 0u) { xcd_barrier_complete(bar, b.x, nloc, nx); b.st[0] = nloc; b.st[1] = nx; }
        const unsigned old = xb_add(&bar[XB_XSUB(b.x)], 1u);
        const unsigned gen = old / nloc;
        if (old + 1u == (gen + 1u) * nloc) {
            __builtin_amdgcn_fence(__ATOMIC_RELEASE, "agent");
            asm volatile("s_waitcnt vmcnt(0)" ::: "memory");
            const unsigned og = xb_add(&bar[XB_TOP], 1u);
            const unsigned tg = og / nx;
            if (og + 1u == (tg + 1u) * nx) xb_add(&bar[XB_TOPGEN], 1u);
            else XB_SPIN(xb_ld(&bar[XB_TOPGEN]) == tg, bar);
            __builtin_amdgcn_fence(__ATOMIC_ACQUIRE, "agent");
            xb_add(&bar[XB_XGEN(b.x)], 1u);
            asm volatile("s_waitcnt vmcnt(0)" ::: "memory");
        } else {
            XB_SPIN(xb_ld(&bar[XB_XGEN(b.x)]) == gen, bar);
            __builtin_amdgcn_fence(__ATOMIC_ACQUIRE, "agent");
            asm volatile("s_waitcnt vmcnt(0)" ::: "memory");
        }
    }
    __syncthreads();
}
__device__ __forceinline__ void p0_mod_gemv(const float* c, const float* w_ada, const float* b_ada, float* mod, LAS float* lds, int vcu, int G) {
    const int tid = threadIdx.x;
    LAS float* sc = lds;
    LAS float* red = lds + 4096;
    for (int k = tid; k < D; k += NTHR) sc[k] = silu_f(c[k]);
    __syncthreads();
    const int cl = tid & 7, kl = tid >> 3;
    constexpr int NU = DEPTH * 3 * D / 32;
#define GV_W(u_) (w_ada + (size_t)((u_) / (3 * D / 32)) * D * (3 * D) + ((u_) % (3 * D / 32)) * 32 + cl * 4)
#define GV_LD(W_, i_) __builtin_nontemporal_load((const GAS f32x4*)((W_) + (size_t)(kl + 64 * (i_)) * (3 * D)))
    f32x4 w[16];
    if (vcu < NU) { const float* W0 = GV_W(vcu);
#pragma unroll
        for (int i = 0; i < 16; ++i) w[i] = GV_LD(W0, i); }
    for (int u = vcu; u < NU; u += G) {
        const int l = u / (3 * D / 32), n0 = (u % (3 * D / 32)) * 32;
        const float* W = GV_W(u);
        f32x4 acc = {0.f, 0.f, 0.f, 0.f};
#pragma unroll
        for (int i = 0; i < 48; ++i) { acc += w[i & 15] * sc[kl + 64 * i]; w[i & 15] = GV_LD(W, i + 16); }
        if (u + G < NU) { const float* Wn = GV_W(u + G);
#pragma unroll
            for (int i = 48; i < 64; ++i) { acc += w[i & 15] * sc[kl + 64 * i]; w[i & 15] = GV_LD(Wn, i - 48); }
        } else {
#pragma unroll
            for (int i = 48; i < 64; ++i) acc += w[i & 15] * sc[kl + 64 * i];
        }
        red[kl * 33 + cl * 4 + 0] = acc[0]; red[kl * 33 + cl * 4 + 1] = acc[1]; red[kl * 33 + cl * 4 + 2] = acc[2]; red[kl * 33 + cl * 4 + 3] = acc[3];
        __syncthreads();
        if (tid < 32) { float s = 0.f; for (int j = 0; j < 64; ++j) s += red[j * 33 + tid]; mod[(size_t)l * 3 * D + n0 + tid] = s + b_ada[(size_t)l * 3 * D + n0 + tid]; }
        __syncthreads();
    }
#undef GV_W
#undef GV_LD
}
__device__ __forceinline__ int map_in(int n) {
    if (n < 1280) return n;
    if (n < 1344) { const int i = n - 1280; return 1280 + 2 * (i & 31) + (i >> 5); }
    if (n < 3392) return 1536 + (n - 1344);
    if (n < 5440) return 3584 + (n - 3392);
    if (n < 6976) return 5632 + (n - 5440);
    if (n < 7024) return 1344 + (n - 6976);
    return 7168 + (n - 7024);
}
__device__ __forceinline__ int map_kvup(int n) { const int h = n >> 8, d = n & 255; return d < 128 ? h * 128 + d : 2048 + h * 128 + (d - 128); }
__device__ __forceinline__ int map_qup(int n) { const int h = n / 192, d = n - h * 192; if (d < 128) return h * 128 + d; const int i = d - 128; return 2048 + h * 64 + 2 * (i & 31) + (i >> 5); }
template <int MAP>
__device__ __forceinline__ void tr_item8(const float* W, int K, int N, unsigned char* WT, const float* kscale, float sc, int kb, int nb, int lane) {
    const int k0 = 64 * kb, n = 64 * nb + lane;
    if (n >= N) return;
    const GAS float* src = (const GAS float*)(W + (size_t)k0 * N + n);
    float v[64];
#pragma unroll
    for (int i = 0; i < 64; ++i) v[i] = __builtin_nontemporal_load(&src[(size_t)i * N]) * sc;
    if (kscale) {
#pragma unroll
        for (int i = 0; i < 64; ++i) v[i] *= kscale[k0 + i];
    }
    const int row = MAP == 4 ? (n < 1280 ? n : 1280 + (n - 1344)) : (MAP == 2 ? map_qup(n) : (MAP == 3 ? map_kvup(n) : n));
    GAS u32x4* dst = (GAS u32x4*)(WT + (size_t)row * K + k0);
#pragma unroll
    for (int c = 0; c < 4; ++c) { u32x4 o;
        int w = __builtin_amdgcn_cvt_pk_fp8_f32(v[16 * c + 0], v[16 * c + 1], 0, false); o.x = (unsigned)__builtin_amdgcn_cvt_pk_fp8_f32(v[16 * c + 2], v[16 * c + 3], w, true);
        w = __builtin_amdgcn_cvt_pk_fp8_f32(v[16 * c + 4], v[16 * c + 5], 0, false); o.y = (unsigned)__builtin_amdgcn_cvt_pk_fp8_f32(v[16 * c + 6], v[16 * c + 7], w, true);
        w = __builtin_amdgcn_cvt_pk_fp8_f32(v[16 * c + 8], v[16 * c + 9], 0, false); o.z = (unsigned)__builtin_amdgcn_cvt_pk_fp8_f32(v[16 * c + 10], v[16 * c + 11], w, true);
        w = __builtin_amdgcn_cvt_pk_fp8_f32(v[16 * c + 12], v[16 * c + 13], 0, false); o.w = (unsigned)__builtin_amdgcn_cvt_pk_fp8_f32(v[16 * c + 14], v[16 * c + 15], w, true);
        dst[c] = o; }
}
template <int MAP>
__device__ __forceinline__ void tr_item(const float* W, int K, int N, bf16* WT, const float* kscale, int kb, int nb, int lane) {
    const int k0 = 64 * kb, n = 64 * nb + lane;
    if (n >= N) return;
    const GAS float* src = (const GAS float*)(W + (size_t)k0 * N + n);
    float v[64];
#pragma unroll
    for (int i = 0; i < 64; ++i) v[i] = __builtin_nontemporal_load(&src[(size_t)i * N]);
    if (kscale) {
#pragma unroll
        for (int i = 0; i < 64; ++i) v[i] *= kscale[k0 + i];
    }
    const int row = MAP == 1 ? map_in(n) : (MAP == 2 ? map_qup(n) : (MAP == 3 ? map_kvup(n) : n));
    GAS u32x4* dst = (GAS u32x4*)(WT + (size_t)row * K + k0);
#pragma unroll
    for (int c = 0; c < 8; ++c) { u32x4 o; o.x = pk2(v[8 * c], v[8 * c + 1]); o.y = pk2(v[8 * c + 2], v[8 * c + 3]); o.z = pk2(v[8 * c + 4], v[8 * c + 5]); o.w = pk2(v[8 * c + 6], v[8 * c + 7]); dst[c] = o; }
}
struct P0In { const float *w_in, *q_norm, *w_q_up, *kv_norm, *w_kv_up, *w_cmp1, *w_cmp2, *w_out; };
__device__ __forceinline__ void p0_convert(const P0In& I, unsigned char* ws, int gw, int NGW, int lane) {
    constexpr int T_IN = 64 * 142, T_QUP = 12 * 48, T_KVUP = 8 * 64, T_OUT = 64 * 64, T_C1 = 2 * 64 * 2, T_C2 = 2 * 2 * 2;
    constexpr int TL = T_IN + T_QUP + T_KVUP + T_OUT + T_C1 + T_C2;
    for (int it = gw; it < DEPTH * TL; it += NGW) {
        const int l = it / TL; int r = it - l * TL;
        unsigned char* wl = ws + WS_W + (size_t)l * W_LSTRIDE;
        if (r < T_IN) { const int t_ = r >> 3, nb = t_ % 142, kb = (t_ / 142) * 8 + (r & 7);
            if (nb < 20 || (nb >= 21 && nb < 53)) tr_item8<4>(I.w_in + (size_t)l * D * INC, D, INC, ws + WS_WIN8 + (size_t)l * WIN8_LSTRIDE, nullptr, 64.f, kb, nb, lane);
            else tr_item<1>(I.w_in + (size_t)l * D * INC, D, INC, (bf16*)(wl + W_IN), nullptr, kb, nb, lane);
            continue; } r -= T_IN;
        if (r < T_QUP) { tr_item8<2>(I.w_q_up + (size_t)l * 768 * 3072, 768, 3072, wl + W_QUP, I.q_norm + l * 768, 32.f, r / 48, r % 48, lane); continue; } r -= T_QUP;
        if (r < T_KVUP) { tr_item8<3>(I.w_kv_up + (size_t)l * 512 * 4096, 512, 4096, wl + W_KVUP, I.kv_norm + l * 512, 32.f, r / 64, r % 64, lane); continue; }
        r -= T_KVUP;
        if (r < T_OUT) { const int t_ = r >> 3, kb = (t_ / 64) * 8 + (r & 7), nb = t_ % 64;
            if (kb < 32) tr_item8<0>(I.w_out + (size_t)l * D * D, 8192, D, wl + W_OUT, nullptr, 128.f, kb, nb, lane);
            else
            tr_item<0>(I.w_out + (size_t)l * D * D, D, D, (bf16*)(wl + W_OUT), nullptr, kb, nb, lane);
            continue; } r -= T_OUT;
        if (r < T_C1) { const int kv = r / 128, rr = r % 128; tr_item<0>(I.w_cmp1 + (size_t)(l * 2 + kv) * 4096 * 128, 4096, 128, (bf16*)(wl + W_C1) + (size_t)kv * 128 * 4096, nullptr, rr / 2, rr % 2, lane); continue; } r -= T_C1;
        { const int kv = r / 4, rr = r % 4; tr_item<0>(I.w_cmp2 + (size_t)(l * 2 + kv) * 128 * 128, 128, 128, (bf16*)(wl + W_C2) + (size_t)kv * 128 * 128, nullptr, rr / 2, rr % 2, lane); }
    }
}
__device__ __forceinline__ void p0_rope(const int* positions, float* cosT, float* sinT, int gtid, int NT) {
    for (int e = gtid; e < S * 32; e += NT) { const int s = e >> 5, i = e & 31;
        const float inv = (float)exp(-(double)i * (1.0 / 32.0) * 9.210340371976184);
        const float ang = (float)positions[s] * inv;
        cosT[e] = (float)cos((double)ang); sinT[e] = (float)sin((double)ang); }
}
__device__ __forceinline__ void p0_cmpbias(const float* cmp_pos, const float* w_cmp1, float* cbp, LAS float* red, int vcu, int G) {
    const int tid = threadIdx.x, n = tid & 127, kq = tid >> 7;
    for (int u = vcu; u < 64; u += G) {
        const int lk = u >> 4, ch = u & 15;
        const float* P = cmp_pos + (size_t)lk * 4096 + 256 * ch; const float* W = w_cmp1 + (size_t)lk * 4096 * 128 + (size_t)(256 * ch) * 128 + n;
        float a = 0.f;
#pragma unroll 32
        for (int i = 0; i < 64; ++i) { const int k = kq + 4 * i; a += P[k] * *(const GAS float*)(W + (size_t)k * 128); }
        red[kq * 128 + n] = a;
        __syncthreads();
        if (tid < 128) cbp[(size_t)u * 128 + tid] = (red[tid] + red[128 + tid]) + (red[256 + tid] + red[384 + tid]);
        __syncthreads();
    }
}
__device__ __forceinline__ unsigned pk4_fp8(f32x4 h) { const int w = __builtin_amdgcn_cvt_pk_fp8_f32(h[0], h[1], 0, false); return (unsigned)__builtin_amdgcn_cvt_pk_fp8_f32(h[2], h[3], w, true); }
__device__ __forceinline__ void modulate_rows(const float* x, bf16* hout, unsigned char* h8, const float* modl, LAS float* par, int tid, int gw, int NGW, int lane) {
    {
#pragma unroll
      for (int i = 0; i < 2; ++i) { const int e = tid + 512 * i;
          *((LAS f32x4*)par + e) = *((const GAS f32x4*)modl + e); *((LAS f32x4*)(par + D) + e) = *((const GAS f32x4*)(modl + D) + e) + 1.f; }
      __syncthreads(); }
    f32x4 rx[16];
    if (gw < S) { const GAS f32x4* xr = (const GAS f32x4*)(x + (size_t)gw * D) + lane;
#pragma unroll
        for (int j = 0; j < 16; ++j) rx[j] = __builtin_nontemporal_load(&xr[64 * j]); }
    for (int m = gw; m < S; m += NGW) {
        GAS u32x2* ho = (GAS u32x2*)(hout + (size_t)m * D) + lane;
        f32x4 h[16];
        { unsigned po_ = 0u; asm volatile("" : "+v"(po_)); par = (LAS float*)((LAS unsigned char*)par + po_); }
#pragma unroll
        for (int j = 0; j < 16; ++j) { h[j] = rx[j] * *((const LAS f32x4*)(par + D) + lane + 64 * j) + *((const LAS f32x4*)par + lane + 64 * j);
            asm volatile("" : "+v"(h[j]));
            if ((j & 3) == 3) __builtin_amdgcn_sched_barrier(0); }
        if (m + NGW < S) { const GAS f32x4* xr = (const GAS f32x4*)(x + (size_t)(m + NGW) * D) + lane;
#pragma unroll
            for (int j = 0; j < 16; ++j) rx[j] = __builtin_nontemporal_load(&xr[64 * j]); }
#pragma unroll
        for (int j = 0; j < 16; ++j) { u32x2 w; w.x = pk2(h[j][0], h[j][1]); w.y = pk2(h[j][2], h[j][3]); ho[64 * j] = w;
            if (h8) *((GAS unsigned*)(h8 + (size_t)m * D) + lane + 64 * j) = pk4_fp8(h[j]); }
    }
}
typedef _Float16 f16x4 __attribute__((ext_vector_type(4)));
template <bool XIN_H, bool XOUT_H>
__device__ __forceinline__ void ln_rows(const void* xres_, const bf16* yb, void* xout_, bf16* hout, unsigned char* h8, const float* g, const float* b, const float* mod_next, LAS float* par, int tid, int gw, int NGW, int lane) {
    {
#pragma unroll
      for (int i = 0; i < 2; ++i) { const int e = tid + 512 * i;
          *((LAS f32x4*)par + e) = *((const GAS f32x4*)g + e); *((LAS f32x4*)(par + D) + e) = *((const GAS f32x4*)b + e);
          if (hout) { *((LAS f32x4*)(par + 2 * D) + e) = *((const GAS f32x4*)mod_next + e); *((LAS f32x4*)(par + 3 * D) + e) = *((const GAS f32x4*)(mod_next + D) + e) + 1.f; } }
      __syncthreads(); }
    f32x4 rx[16]; f16x4 rxh[16]; u32x2 ry[16];
#define LN_LOAD(m_) { const GAS f32x4* vr = (const GAS f32x4*)((const float*)xres_ + (size_t)(m_) * D) + lane; const GAS f16x4* vrh = (const GAS f16x4*)((const _Float16*)xres_ + (size_t)(m_) * D) + lane; \
        const GAS u32x2* yr = (const GAS u32x2*)(yb + (size_t)(m_) * D) + lane; \
        _Pragma("unroll") for (int j = 0; j < 16; ++j) { ry[j] = __builtin_nontemporal_load(&yr[64 * j]); if (XIN_H) rxh[j] = __builtin_nontemporal_load(&vrh[64 * j]); else rx[j] = __builtin_nontemporal_load(&vr[64 * j]); } }
    if (gw < S) LN_LOAD(gw)
    for (int m = gw; m < S; m += NGW) {
        f32x4 x[16]; float s = 0.f;
#pragma unroll
        for (int j = 0; j < 16; ++j) { const u32x2 yy = ry[j]; const f32x4 yf = {bflo(yy.x), bfhi(yy.x), bflo(yy.y), bfhi(yy.y)};
            const f32x4 xin = XIN_H ? __builtin_convertvector(rxh[j], f32x4) : rx[j];
            x[j] = xin * DN_ALPHA + yf; s += (x[j][0] + x[j][1]) + (x[j][2] + x[j][3]); }
        if (m + NGW < S) LN_LOAD(m + NGW)
        const float mean = wave_sum(s) * (1.f / D); float s2 = 0.f;
#pragma unroll
        for (int j = 0; j < 16; ++j) { x[j] = x[j] - mean; s2 += (x[j][0] * x[j][0] + x[j][1] * x[j][1]) + (x[j][2] * x[j][2] + x[j][3] * x[j][3]); }
        const float rstd = 1.f / sqrtf(wave_sum(s2) * (1.f / D) + LN_EPS);
        { unsigned po_ = 0u; asm volatile("" : "+v"(po_)); par = (LAS float*)((LAS unsigned char*)par + po_); }
        GAS f32x4* xo = (GAS f32x4*)((float*)xout_ + (size_t)m * D) + lane; GAS f16x4* xoh = (GAS f16x4*)((_Float16*)xout_ + (size_t)m * D) + lane;
#pragma unroll
        for (int j = 0; j < 16; ++j) {
            const f32x4 gg = *((const LAS f32x4*)par + lane + 64 * j), bb = *((const LAS f32x4*)(par + D) + lane + 64 * j);
            const f32x4 y = x[j] * rstd * gg + bb;
            if (XOUT_H) __builtin_nontemporal_store(__builtin_convertvector(y, f16x4), &xoh[64 * j]); else __builtin_nontemporal_store(y, &xo[64 * j]);
            if (hout) {
                const f32x4 sh = *((const LAS f32x4*)(par + 2 * D) + lane + 64 * j), scl = *((const LAS f32x4*)(par + 3 * D) + lane + 64 * j);
                const f32x4 h = y * scl + sh;
                u32x2 w; w.x = pk2(h[0], h[1]); w.y = pk2(h[2], h[3]);
                *((GAS u32x2*)(hout + (size_t)m * D) + lane + 64 * j) = w;
                if (h8) *((GAS unsigned*)(h8 + (size_t)m * D) + lane + 64 * j) = pk4_fp8(h);
            }
            if ((j & 3) == 3) __builtin_amdgcn_sched_barrier(0);
        }
    }
#undef LN_LOAD
}
__device__ __forceinline__ void rstd_rows(const float* rsq_q, const float* rsq_kv, float* rstd_q, float* rstd_kv, int gtid, int NT) {
    for (int row = gtid; row < S; row += NT) {
        const GAS f32x4* rp = (const GAS f32x4*)(rsq_q + (size_t)row * 24); float ss = 0.f;
#pragma unroll
        for (int i = 0; i < 6; ++i) { const f32x4 t = rp[i]; ss += (t[0] + t[1]) + (t[2] + t[3]); }
        rstd_q[row] = 1.f / sqrtf(ss * (1.f / 768.f) + RMS_EPS);
        const GAS f32x4* rk = (const GAS f32x4*)(rsq_kv + (size_t)row * 16); float sk = 0.f;
#pragma unroll
        for (int i = 0; i < 4; ++i) { const f32x4 t = rk[i]; sk += (t[0] + t[1]) + (t[2] + t[3]); }
        rstd_kv[row] = 1.f / sqrtf(sk * (1.f / 512.f) + RMS_EPS);
    }
}
namespace pg8 {
#define PG8_LAS __attribute__((address_space(3)))
typedef unsigned short bf16_t;
typedef short bf16x8 __attribute__((ext_vector_type(8)));
typedef float f32x4 __attribute__((ext_vector_type(4)));
typedef unsigned u32x4 __attribute__((ext_vector_type(4)));
constexpr int BM = 256, BK = 64, HALF = 128, HTB = HALF * BK * 2  , STAGE_BYTES = 8 * HTB, NXCD = 8, WGM = 8;

__host__ __device__ __forceinline__ int lds_byte(int r, int c) { const int st = (r >> 4) * 2 + (c >> 5), rr = r & 15, cc = c & 31, ob = rr * 64 + cc * 2; return st * 1024 + (ob ^ (((ob >> 9) & 1) << 5)); }
__host__ __device__ __forceinline__ void stage_rc(int b, int& R, int& C) { const int st = b / 1024, sb = b % 1024, swz = sb ^ (((sb >> 9) & 1) << 5); R = (st >> 1) * 16 + swz / 64; C = (st & 1) * 32 + (swz % 64) / 2; }
__host__ __device__ __forceinline__ int perm32(int rho) { const int n = rho >> 4, i = rho & 15; return 8 * (i >> 2) + 4 * n + (i & 3); }

struct Unit { int pm, pn; };
struct Gemm { const bf16_t* A; const bf16_t* Bt; int M, N, K; };

struct StaticOrder {
    int nM, nN, nwg, G, c;
    __host__ __device__ void init(int M, int N, int G_, int c_) { nM = M / BM; nN = N / BM; nwg = nM * nN; G = G_; c = c_; }
    __host__ __device__ bool next(int i, Unit& u) const {
        const long L = (long)i * G + c; if (L >= nwg) return false;
        int wgid = (int)L; { const int q = nwg / NXCD, r = nwg % NXCD, xcd = wgid % NXCD, off = wgid / NXCD; wgid = (xcd < r ? xcd * (q + 1) : r * (q + 1) + (xcd - r) * q) + off; }
        const int nig = WGM * nN, gid = wgid / nig, fm = gid * WGM, gsz = (nM - fm) < WGM ? (nM - fm) : WGM;
        u.pm = fm + ((wgid % nig) % gsz); u.pn = (wgid % nig) / gsz; return true;
    }
    __device__ __forceinline__ void a_ready(const Unit&) const {}
    __device__ __forceinline__ void done(const Unit&) const {}
};
typedef int i32x8 __attribute__((ext_vector_type(8)));
typedef int i32x4 __attribute__((ext_vector_type(4)));
__device__ __forceinline__ i32x8 ld2x16(const PG8_LAS unsigned char* p) { const u32x4 a = *(const PG8_LAS u32x4*)p, b = *(const PG8_LAS u32x4*)(p + 1024);
    return (i32x8){(int)a.x, (int)a.y, (int)a.z, (int)a.w, (int)b.x, (int)b.y, (int)b.z, (int)b.w}; }
__device__ __forceinline__ i32x8 cat8(bf16x8 lo, bf16x8 hi) { const i32x4 a = __builtin_bit_cast(i32x4, lo), b = __builtin_bit_cast(i32x4, hi); return (i32x8){a[0], a[1], a[2], a[3], b[0], b[1], b[2], b[3]}; }
struct InBf16Order : StaticOrder {
    __device__ bool next(int i, Unit& u) const { if (!StaticOrder::next(i, u)) return false; u.pn = u.pn == 0 ? 5 : 13 + u.pn; return true; }
};
__device__ __forceinline__ f32x4 rope4(const f32x4 v, float c0, float s0, float c1, float s1) {
    f32x4 o; o[0] = v[0] * c0 - v[1] * s0; o[1] = v[1] * c0 + v[0] * s0; o[2] = v[2] * c1 - v[3] * s1; o[3] = v[3] * c1 + v[2] * s1; return o; }
#define NZ(v, row, col) (v)
__device__ __forceinline__ u32x2 pk8_fp8(f32x4 a, f32x4 b) {
    int w0 = __builtin_amdgcn_cvt_pk_fp8_f32(a[0], a[1], 0, false); w0 = __builtin_amdgcn_cvt_pk_fp8_f32(a[2], a[3], w0, true);
    int w1 = __builtin_amdgcn_cvt_pk_fp8_f32(b[0], b[1], 0, false); w1 = __builtin_amdgcn_cvt_pk_fp8_f32(b[2], b[3], w1, true);
    u32x2 r; r.x = (unsigned)w0; r.y = (unsigned)w1; return r; }
struct EpiIn {
    static constexpr bool PERM = true, AFTER_DRAIN = false;
    unsigned char* ws; int f8pass;
    __device__ __forceinline__ void operator()(const f32x4 (&acc)[2][2][4][2], const Unit& u, int wr, int wc, int fr, int fq) const {
        const int pn = f8pass ? (u.pn < 5 ? u.pn : u.pn + 1) : u.pn, row0 = u.pm * BM + wr * 64 + fr;
        if (pn < 5) {
            const bool isq = pn < 3; bf16_t* base = (bf16_t*)(ws + (isq ? WS_QLAT : WS_KVLAT)); const int ld = isq ? 768 : 512, ct = isq ? pn : pn - 3, ns = isq ? 24 : 16; float* rsq = (float*)(ws + (isq ? WS_RSQQ : WS_RSQKV));
#pragma unroll
            for (int ai = 0; ai < 2; ++ai)
#pragma unroll
                for (int m = 0; m < 4; ++m) { const int row = row0 + ai * HALF + m * 16;
#pragma unroll
                    for (int bj = 0; bj < 2; ++bj) { const f32x4 v0 = NZ(acc[ai][bj][m][0], row, pn * 256 + bj * 128 + wc * 32 + 8 * fq), v1 = NZ(acc[ai][bj][m][1], row, pn * 256 + bj * 128 + wc * 32 + 8 * fq + 4);
                        float ss = ((v0[0] * v0[0] + v0[1] * v0[1]) + (v0[2] * v0[2] + v0[3] * v0[3])) + ((v1[0] * v1[0] + v1[1] * v1[1]) + (v1[2] * v1[2] + v1[3] * v1[3]));
                        ss += __shfl_xor(ss, 16); ss += __shfl_xor(ss, 32);
                        if (fq == 0) rsq[(size_t)row * ns + ct * 8 + bj * 4 + wc] = ss;
                        *(GAS u32x2*)((unsigned char*)base + (size_t)row * ld + ct * 256 + bj * HALF + wc * 32 + 8 * fq) = pk8_fp8(v0, v1); } }
        } else if (pn == 5) {
            if (wc < 2) {
                const int i0 = 16 * wc + 4 * fq; const float* cosT = (const float*)(ws + WS_ROPE); const float* sinT = cosT + (size_t)S * 32; bf16_t* kmla = (bf16_t*)(ws + WS_KMLA);
#pragma unroll
                for (int ai = 0; ai < 2; ++ai)
#pragma unroll
                    for (int m = 0; m < 4; ++m) { const int row = row0 + ai * HALF + m * 16;
                        const f32x4 cs = *(const GAS f32x4*)(cosT + (size_t)row * 32 + i0), sn = *(const GAS f32x4*)(sinT + (size_t)row * 32 + i0);
                        const u32x2 w = pk8_fp8(rope4(acc[ai][0][m][0], cs[0], sn[0], cs[1], sn[1]), rope4(acc[ai][0][m][1], cs[2], sn[2], cs[3], sn[3]));
                        unsigned char* dst = (unsigned char*)kmla + (size_t)row * 3072 + 128 + wc * 32 + 8 * fq;
#pragma unroll
                        for (int h = 0; h < 16; ++h) *(GAS u32x2*)(dst + h * 192) = w;
                        asm volatile("" ::: "memory"); }
            } else {
                const int cl = (wc - 2) * 32 + 8 * fq; float* gnsa = (float*)(ws + WS_GNSA);
                if (cl < 48) {
#pragma unroll
                    for (int ai = 0; ai < 2; ++ai)
#pragma unroll
                        for (int m = 0; m < 4; ++m) { const int row = row0 + ai * HALF + m * 16; const f32x4 v0 = acc[ai][0][m][0], v1 = acc[ai][0][m][1];
                            f32x4 g0, g1; g0[0] = sigm_f(v0[0]); g0[1] = sigm_f(v0[1]); g0[2] = sigm_f(v0[2]); g0[3] = sigm_f(v0[3]); g1[0] = sigm_f(v1[0]); g1[1] = sigm_f(v1[1]); g1[2] = sigm_f(v1[2]); g1[3] = sigm_f(v1[3]);
                            *(GAS f32x4*)(gnsa + (size_t)row * 48 + cl) = g0; *(GAS f32x4*)(gnsa + (size_t)row * 48 + cl + 4) = g1; } }
            }
        } else {
            const int mode = (pn < 14) ? 0 : (pn < 22 ? 1 : (pn < 28 ? 2 : 0));
            bf16_t* base = (pn < 14) ? (bf16_t*)(ws + WS_ZMLA) + (pn - 6) * 256 : (pn < 22 ? (bf16_t*)(ws + WS_QNSA) + (pn - 14) * 256 : (bf16_t*)(ws + WS_ZNSA) + (pn - 28) * 256); bf16_t* kvnsa = (bf16_t*)(ws + WS_KVNSA);
#pragma unroll
            for (int ai = 0; ai < 2; ++ai)
#pragma unroll
                for (int m = 0; m < 4; ++m) { const int row = row0 + ai * HALF + m * 16;
#pragma unroll
                    for (int bj = 0; bj < 2; ++bj) { f32x4 v0 = NZ(acc[ai][bj][m][0], row, pn * 256 + bj * 128 + wc * 32 + 8 * fq), v1 = NZ(acc[ai][bj][m][1], row, pn * 256 + bj * 128 + wc * 32 + 8 * fq + 4);
                        if (mode == 0) { v0[0] = silu_f(v0[0]); v0[1] = silu_f(v0[1]); v0[2] = silu_f(v0[2]); v0[3] = silu_f(v0[3]); v1[0] = silu_f(v1[0]); v1[1] = silu_f(v1[1]); v1[2] = silu_f(v1[2]); v1[3] = silu_f(v1[3]); }
                        else if (mode == 1) { v0 = v0 * QS_NSA; v1 = v1 * QS_NSA; }
                        bf16_t* dst = (mode == 2) ? kvnsa + (size_t)(2 * (pn - 22) + bj) * ((size_t)S * 128) + (size_t)row * 128 + wc * 32 + 8 * fq
                                                  : base + (size_t)row * 2048 + bj * HALF + wc * 32 + 8 * fq;
                        *(GAS u32x4*)dst = pk8(v0, v1); } }
        }
    }
};
struct EpiQup {
    static constexpr bool PERM = true, AFTER_DRAIN = false;
    unsigned char* ws;
    __device__ __forceinline__ void operator()(const f32x4 (&acc)[2][2][4][2], const Unit& u, int wr, int wc, int fr, int fq) const {
        const int pn = u.pn, row0 = u.pm * BM + wr * 64 + fr; bf16_t* qmla = (bf16_t*)(ws + WS_QMLA); const float* rstd_q = (const float*)(ws + WS_RSTD); const float* cosT = (const float*)(ws + WS_ROPE); const float* sinT = cosT + (size_t)S * 32;
        float scv[2][4];
#pragma unroll
        for (int ai = 0; ai < 2; ++ai)
#pragma unroll
            for (int m = 0; m < 4; ++m) scv[ai][m] = (QS_MLA * 8.f) * *(const GAS float*)(rstd_q + row0 + ai * HALF + m * 16);
        if (pn < 8) {
#pragma unroll
            for (int ai = 0; ai < 2; ++ai)
#pragma unroll
                for (int m = 0; m < 4; ++m) { const int row = row0 + ai * HALF + m * 16; const float sc = scv[ai][m];
                    unsigned char* q8 = (unsigned char*)qmla + (size_t)row * 3072;
#pragma unroll
                    for (int bj = 0; bj < 2; ++bj) { const f32x4 v0 = acc[ai][bj][m][0] * sc, v1 = acc[ai][bj][m][1] * sc;
                        *(GAS u32x2*)(q8 + (2 * pn + bj) * 192 + wc * 32 + 8 * fq) = pk8_fp8(v0, v1); }
                    if (m & 1) asm volatile("" ::: "memory"); }
        } else {
#pragma unroll
            for (int ai = 0; ai < 2; ++ai)
#pragma unroll
                for (int mp = 0; mp < 2; ++mp) {
                    f32x4 cs[2][2], sn[2][2];
#pragma unroll
                    for (int mm = 0; mm < 2; ++mm)
#pragma unroll
                        for (int bj = 0; bj < 2; ++bj) { const int row = row0 + ai * HALF + (2 * mp + mm) * 16; const int cp = (pn - 8) * 256 + bj * HALF + wc * 32 + 8 * fq, i0 = (cp & 63) >> 1;
                            cs[mm][bj] = *(const GAS f32x4*)(cosT + (size_t)row * 32 + i0); sn[mm][bj] = *(const GAS f32x4*)(sinT + (size_t)row * 32 + i0); }
#pragma unroll
                    for (int mm = 0; mm < 2; ++mm)
#pragma unroll
                        for (int bj = 0; bj < 2; ++bj) { const int m = 2 * mp + mm, row = row0 + ai * HALF + m * 16; const float sc = scv[ai][m];
                            const f32x4 v0 = acc[ai][bj][m][0] * sc, v1 = acc[ai][bj][m][1] * sc;
                            const int cp = (pn - 8) * 256 + bj * HALF + wc * 32 + 8 * fq, head = cp >> 6, dl = cp & 63;
                            *(GAS u32x2*)((unsigned char*)qmla + (size_t)row * 3072 + head * 192 + 128 + dl) = pk8_fp8(rope4(v0, cs[mm][bj][0], sn[mm][bj][0], cs[mm][bj][1], sn[mm][bj][1]), rope4(v1, cs[mm][bj][2], sn[mm][bj][2], cs[mm][bj][3], sn[mm][bj][3])); }
                    asm volatile("" ::: "memory"); }
        }
    }
};
struct EpiKvup {
    static constexpr bool PERM = true, AFTER_DRAIN = false;
    unsigned char* ws;
    __device__ __forceinline__ void operator()(const f32x4 (&acc)[2][2][4][2], const Unit& u, int wr, int wc, int fr, int fq) const {
        const int pn = u.pn, row0 = u.pm * BM + wr * 64 + fr;
#pragma unroll
        for (int ai = 0; ai < 2; ++ai)
#pragma unroll
            for (int m = 0; m < 4; ++m) { const int row = row0 + ai * HALF + m * 16;
                const float sc = *(const GAS float*)((const float*)(ws + WS_RSTD) + S + row); bf16_t* kmla = (bf16_t*)(ws + WS_KMLA); bf16_t* vmla = (bf16_t*)(ws + WS_VMLA);
                *(GAS u32x2*)((unsigned char*)kmla + (size_t)row * 3072 + pn * 192 + wc * 32 + 8 * fq) = pk8_fp8(acc[ai][0][m][0] * sc, acc[ai][0][m][1] * sc);
                *(GAS u32x4*)(vmla + (size_t)row * 2048 + pn * 128 + wc * 32 + 8 * fq) = pk8(acc[ai][1][m][0] * sc, acc[ai][1][m][1] * sc);
                if (m & 1) asm volatile("" ::: "memory"); }
    }
};
struct EpiKup {
    static constexpr bool PERM = true, AFTER_DRAIN = false;
    unsigned char* ws;
    __device__ __forceinline__ void operator()(const f32x4 (&acc)[2][2][4][2], const Unit& u, int wr, int wc, int fr, int fq) const {
        const int pn = u.pn, row0 = u.pm * BM + wr * 64 + fr;
        float scv[2][4];
#pragma unroll
        for (int ai = 0; ai < 2; ++ai)
#pragma unroll
            for (int m = 0; m < 4; ++m) scv[ai][m] = *(const GAS float*)((const float*)(ws + WS_RSTD) + S + row0 + ai * HALF + m * 16);
#pragma unroll
        for (int ai = 0; ai < 2; ++ai)
#pragma unroll
            for (int m = 0; m < 4; ++m) { const int row = row0 + ai * HALF + m * 16;
                const float sc = scv[ai][m]; unsigned char* k8 = ws + WS_KMLA + (size_t)row * 3072;
#pragma unroll
                for (int bj = 0; bj < 2; ++bj) *(GAS u32x2*)(k8 + (2 * pn + bj) * 192 + wc * 32 + 8 * fq) = pk8_fp8(acc[ai][bj][m][0] * sc, acc[ai][bj][m][1] * sc);
                if (m & 1) asm volatile("" ::: "memory"); }
    }
};
struct EpiVt {
    static constexpr bool PERM = true, AFTER_DRAIN = false;
    unsigned char* ws;
    __device__ __forceinline__ void operator()(const f32x4 (&acc)[2][2][4][2], const Unit& u, int wr, int wc, int fr, int fq) const {
        const int row0 = u.pm * BM + wr * 64 + fr, col0 = u.pn * BM + wc * 32 + 8 * fq;
        const float* rs = (const float*)(ws + WS_RSTD) + S;
        f32x4 sc[2][2];
#pragma unroll
        for (int bj = 0; bj < 2; ++bj) { sc[bj][0] = *(const GAS f32x4*)(rs + col0 + bj * HALF); sc[bj][1] = *(const GAS f32x4*)(rs + col0 + bj * HALF + 4); }
        const int hi8 = (col0 >> 3) & 1; (void)hi8;
#pragma unroll
        for (int ai = 0; ai < 2; ++ai)
#pragma unroll
            for (int m = 0; m < 4; ++m) { unsigned char* vt = ws + WS_VMLA + (size_t)(row0 + ai * HALF + m * 16) * S;
#pragma unroll
                for (int bj = 0; bj < 2; ++bj) { const u32x2 w = pk8_fp8(acc[ai][bj][m][0] * sc[bj][0], acc[ai][bj][m][1] * sc[bj][1]);
                    unsigned char* d64 = vt + ((col0 + bj * HALF) & ~63) + 4 * ((col0 >> 3) & 7);
                    *(GAS unsigned*)(d64) = w.x; *(GAS unsigned*)(d64 + 32) = w.y; } }
    }
};
struct EpiOut {
    static constexpr bool PERM = true, AFTER_DRAIN = false;
    bf16_t* y; const float* gate;
    __device__ __forceinline__ void operator()(const f32x4 (&acc)[2][2][4][2], const Unit& u, int wr, int wc, int fr, int fq) const {
        const int row0 = u.pm * BM + wr * 64 + fr, col0 = u.pn * BM + wc * 32 + 8 * fq;
        f32x4 gv[2][2];
#pragma unroll
        for (int bj = 0; bj < 2; ++bj)
#pragma unroll
            for (int n = 0; n < 2; ++n) gv[bj][n] = *(const GAS f32x4*)(gate + col0 + bj * HALF + n * 4);
#pragma unroll
        for (int ai = 0; ai < 2; ++ai)
#pragma unroll
            for (int m = 0; m < 4; ++m) { bf16_t* dst = y + (size_t)(row0 + ai * HALF + m * 16) * D + col0;
#pragma unroll
                for (int bj = 0; bj < 2; ++bj) *(GAS u32x4*)(dst + bj * HALF) = pk8(gv[bj][0] * acc[ai][bj][m][0], gv[bj][1] * acc[ai][bj][m][1]);
                if (m & 1) asm volatile("" ::: "memory"); }
    }
};
template <class Epi, class Sched, bool ALIGN_EPI = false, bool SP2 = false, int SCB = 0, int SCA = 0>
__device__ __forceinline__ void gemm_phase(PG8_LAS unsigned char* lds, const Gemm g, const Sched& S, const Epi& E) {
    int tid_ = threadIdx.x; asm volatile("" : "+v"(tid_));
    const int tid = tid_, wid = __builtin_amdgcn_readfirstlane(tid >> 6), lane = tid & 63, wr = wid >> 2, wc = wid & 3, fr = lane & 15, fq = lane >> 4;
    const int K = g.K, nt = K / BK;
    unsigned voffA[2], voffB[2];
#pragma unroll
    for (int i = 0; i < 2; ++i) { int R, C; stage_rc(tid * 16 + i * 8192, R, C); const int Rb = Epi::PERM ? ((R & ~31) + perm32(R & 31)) : R;
        voffA[i] = (unsigned)(R * K + C) * 2u; voffB[i] = (unsigned)(Rb * K + C) * 2u; }
    const size_t kstep = (size_t)(BK * 2);
    const size_t hstep = (size_t)HALF * K * 2;
    const size_t tstep = 2 * hstep;
    const unsigned ldsw = (unsigned)wid * 1024u;
    const int aoff = lds_byte(wr * 64 + fr, fq * 8), boff = lds_byte(wc * 32 + fr, fq * 8);
#define PG8_SA(b, h) (((b) * 2 + (h)) * HTB)
#define PG8_SB(b, h) ((4 + (b) * 2 + (h)) * HTB)
#define PG8_STAGE(bufoff, gbase, voff) do { _Pragma("unroll") for (int _i = 0; _i < 2; ++_i) \
        __builtin_amdgcn_global_load_lds((const unsigned*)((const char*)(gbase) + (voff)[_i]), (PG8_LAS unsigned*)(lds + (bufoff) + ldsw + _i * 8192), 16, 0, 0); } while (0)
#define PG8_LDA(dst, b, h) do { if constexpr (SCB != 0) { _Pragma("unroll") for (int m = 0; m < 4; ++m) dst##8[m] = ld2x16(lds + PG8_SA(b, h) + aoff + m * 2048); } \
        else { _Pragma("unroll") for (int m = 0; m < 4; ++m) _Pragma("unroll") for (int k = 0; k < 2; ++k) dst[m][k] = *(const PG8_LAS bf16x8*)(lds + PG8_SA(b, h) + aoff + m * 2048 + k * 1024); } } while (0)
#define PG8_LDB(dst, b, h) do { if constexpr (SCB != 0) { _Pragma("unroll") for (int n = 0; n < 2; ++n) dst##8[n] = ld2x16(lds + PG8_SB(b, h) + boff + n * 2048); } \
        else { _Pragma("unroll") for (int n = 0; n < 2; ++n) _Pragma("unroll") for (int k = 0; k < 2; ++k) dst[n][k] = *(const PG8_LAS bf16x8*)(lds + PG8_SB(b, h) + boff + n * 2048 + k * 1024); } } while (0)
#define PG8_MMA(ai, bj, At, Bt) do { __builtin_amdgcn_s_setprio(1); \
        if constexpr (SCB != 0) { _Pragma("unroll") for (int m = 0; m < 4; ++m) _Pragma("unroll") for (int n = 0; n < 2; ++n) \
            asm volatile("v_mfma_scale_f32_16x16x128_f8f6f4 %0, %1, %2, %0, %3, %4 op_sel_hi:[0,0,0]" : "+v"(acc[ai][bj][m][n]) : "v"(Bt##8[n]), "v"(At##8[m]), "v"(scb_), "v"(sca_)); } \
        else { _Pragma("unroll") for (int m = 0; m < 4; ++m) _Pragma("unroll") for (int n = 0; n < 2; ++n) _Pragma("unroll") for (int k = 0; k < 2; ++k) \
            acc[ai][bj][m][n] = __builtin_amdgcn_mfma_f32_16x16x32_bf16(Bt[n][k], At[m][k], acc[ai][bj][m][n], 0, 0, 0); } \
        __builtin_amdgcn_s_setprio(0); } while (0)
#define PG8_WAIT_V(n) asm volatile("s_waitcnt vmcnt(" #n ")" ::: "memory")
#define PG8_WAIT_L(n) asm volatile("s_waitcnt lgkmcnt(" #n ")" ::: "memory")
#define PG8_BAR __builtin_amdgcn_s_barrier()
#define PG8_SCHED __builtin_amdgcn_sched_barrier(0)
    Unit cur, nxt; int ui = 0;
    if (!S.next(0, cur)) return;
    f32x4 acc[2][2][4][2];
#pragma unroll
    for (int a = 0; a < 2; ++a)
#pragma unroll
        for (int b = 0; b < 2; ++b)
#pragma unroll
            for (int m = 0; m < 4; ++m)
#pragma unroll
                for (int n = 0; n < 2; ++n) acc[a][b][m][n] = (f32x4){0.f, 0.f, 0.f, 0.f};
    int scb_ = SCB, sca_ = SCA; asm volatile("" : "+v"(scb_), "+v"(sca_));
    bf16x8 At[4][2], B0[2][2], B1[2][2]; i32x8 At8[4], B08[2], B18[2];
    const char* cA = (const char*)g.A + (size_t)cur.pm * tstep; const char* cB = (const char*)g.Bt + (size_t)cur.pn * tstep;
    S.a_ready(cur);
    if constexpr (SP2) {
        PG8_STAGE(PG8_SB(0, 0), cB, voffB); PG8_STAGE(PG8_SB(0, 1), cB + hstep, voffB); PG8_STAGE(PG8_SA(0, 0), cA, voffA); PG8_STAGE(PG8_SA(0, 1), cA + hstep, voffA);
        if (wr == 1) PG8_BAR;
        PG8_WAIT_V(2); PG8_BAR;
        PG8_STAGE(PG8_SB(1, 0), cB + kstep, voffB); PG8_STAGE(PG8_SA(1, 0), cA + kstep, voffA); PG8_STAGE(PG8_SB(1, 1), cB + hstep + kstep, voffB);
        PG8_WAIT_V(6); PG8_BAR;
    } else {
        PG8_STAGE(PG8_SB(0, 0), cB, voffB); PG8_STAGE(PG8_SA(0, 0), cA, voffA); PG8_STAGE(PG8_SB(0, 1), cB + hstep, voffB); PG8_STAGE(PG8_SA(0, 1), cA + hstep, voffA);
        if (wr == 1) PG8_BAR;
        PG8_WAIT_V(4); PG8_BAR;
        PG8_STAGE(PG8_SB(1, 0), cB + kstep, voffB); PG8_STAGE(PG8_SA(1, 0), cA + kstep, voffA); PG8_STAGE(PG8_SB(1, 1), cB + hstep + kstep, voffB);
        PG8_WAIT_V(6); PG8_BAR;
    }
    for (;;) {
        const bool has_next = S.next(ui + 1, nxt);
        const char* nA = has_next ? (const char*)g.A + (size_t)nxt.pm * tstep : cA; const char* nB = has_next ? (const char*)g.Bt + (size_t)nxt.pn * tstep : cB;
#pragma unroll 1
        for (int t = 0; t < nt; t += 2) {
            const bool last = (t == nt - 2);
            const char* a1 = cA + (size_t)(t + 1) * kstep;
            const char* a2 = last ? nA : cA + (size_t)(t + 2) * kstep; const char* b2 = last ? nB : cB + (size_t)(t + 2) * kstep;
            const char* a3 = a2 + kstep; const char* b3 = b2 + kstep;
            if (last && has_next) S.a_ready(nxt);
            if constexpr (SP2) {
            PG8_LDB(B0, 0, 0); PG8_LDB(B1, 0, 1); PG8_SCHED; PG8_LDA(At, 0, 0); PG8_STAGE(PG8_SA(1, 1), a1 + hstep, voffA);
            PG8_WAIT_V(8); PG8_WAIT_L(0); PG8_BAR; PG8_MMA(0, 0, At, B0); PG8_MMA(0, 1, At, B1); PG8_BAR; PG8_SCHED;
            PG8_LDA(At, 0, 1); PG8_STAGE(PG8_SB(0, 0), b2, voffB); PG8_STAGE(PG8_SB(0, 1), b2 + hstep, voffB); PG8_STAGE(PG8_SA(0, 0), a2, voffA);
            PG8_WAIT_V(8); PG8_WAIT_L(0); PG8_BAR; PG8_MMA(1, 0, At, B0); PG8_MMA(1, 1, At, B1); PG8_BAR; PG8_SCHED;
            PG8_LDB(B0, 1, 0); PG8_LDB(B1, 1, 1); PG8_SCHED; PG8_LDA(At, 1, 0); PG8_STAGE(PG8_SA(0, 1), a2 + hstep, voffA);
            PG8_WAIT_V(8); PG8_WAIT_L(0); PG8_BAR; PG8_MMA(0, 0, At, B0); PG8_MMA(0, 1, At, B1); PG8_BAR; PG8_SCHED;
            PG8_LDA(At, 1, 1); PG8_STAGE(PG8_SB(1, 0), b3, voffB); PG8_STAGE(PG8_SB(1, 1), b3 + hstep, voffB); PG8_STAGE(PG8_SA(1, 0), a3, voffA);
            PG8_WAIT_V(8); PG8_WAIT_L(0); PG8_BAR; PG8_MMA(1, 0, At, B0); PG8_MMA(1, 1, At, B1); PG8_BAR; PG8_SCHED;
            } else {
            PG8_LDB(B0, 0, 0); PG8_SCHED; PG8_LDA(At, 0, 0); PG8_STAGE(PG8_SA(1, 1), a1 + hstep, voffA);
            PG8_WAIT_L(8); PG8_BAR; PG8_WAIT_L(0); PG8_MMA(0, 0, At, B0); PG8_BAR; PG8_SCHED;
            PG8_LDB(B1, 0, 1); PG8_STAGE(PG8_SB(0, 0), b2, voffB);
            PG8_BAR; PG8_WAIT_L(0); PG8_MMA(0, 1, At, B1); PG8_BAR;
            PG8_LDA(At, 0, 1); PG8_STAGE(PG8_SA(0, 0), a2, voffA);
            PG8_BAR; PG8_WAIT_L(0); PG8_MMA(1, 0, At, B0); PG8_BAR; PG8_SCHED;
            PG8_STAGE(PG8_SB(0, 1), b2 + hstep, voffB);
            PG8_WAIT_V(6); PG8_BAR; PG8_MMA(1, 1, At, B1); PG8_BAR;
            PG8_LDB(B0, 1, 0); PG8_SCHED; PG8_LDA(At, 1, 0); PG8_STAGE(PG8_SA(0, 1), a2 + hstep, voffA);
            PG8_WAIT_L(8); PG8_BAR; PG8_WAIT_L(0); PG8_MMA(0, 0, At, B0); PG8_BAR; PG8_SCHED;
            PG8_LDB(B1, 1, 1); PG8_STAGE(PG8_SB(1, 0), b3, voffB);
            PG8_BAR; PG8_WAIT_L(0); PG8_MMA(0, 1, At, B1); PG8_BAR;
            PG8_LDA(At, 1, 1); PG8_STAGE(PG8_SA(1, 0), a3, voffA);
            PG8_BAR; PG8_WAIT_L(0); PG8_MMA(1, 0, At, B0); PG8_BAR; PG8_SCHED;
            PG8_STAGE(PG8_SB(1, 1), b3 + hstep, voffB);
            PG8_WAIT_V(6); PG8_BAR; PG8_MMA(1, 1, At, B1); PG8_BAR;
            }
        }
        if constexpr (SCB != 0) asm volatile("s_nop 15\n\ts_nop 15" ::: "memory");
        if constexpr (ALIGN_EPI) { if (wr == 0) PG8_BAR; }
        if constexpr (!Epi::AFTER_DRAIN) { int fr_ = fr, fq_ = fq; asm volatile("" : "+v"(fr_), "+v"(fq_));
            E(acc, cur, wr, wc, fr_, fq_);
            S.done(cur); }
        if (!has_next) break;
#pragma unroll
        for (int a = 0; a < 2; ++a)
#pragma unroll
            for (int b = 0; b < 2; ++b)
#pragma unroll
                for (int m = 0; m < 4; ++m)
#pragma unroll
                    for (int n = 0; n < 2; ++n) acc[a][b][m][n] = (f32x4){0.f, 0.f, 0.f, 0.f};
        cur = nxt; cA = nA; cB = nB; ++ui;
        if constexpr (ALIGN_EPI) { if (wr == 1) PG8_BAR; }
    }
    PG8_WAIT_V(0);
    if constexpr (!ALIGN_EPI) { if (wr == 0) PG8_BAR; }
    PG8_BAR;
    if constexpr (Epi::AFTER_DRAIN) { E.fused(acc, cur, wr, wc, fr, fq, lds, wid, lane); S.done(cur); }
#undef PG8_SA
#undef PG8_SB
#undef PG8_STAGE
#undef PG8_LDA
#undef PG8_LDB
#undef PG8_MMA
#undef PG8_WAIT_V
#undef PG8_WAIT_L
#undef PG8_BAR
#undef PG8_SCHED
}

struct GemmMix { const void* A; const void* B; int LD;
                 int K0, K1, OFF1, M, N; };
template <class Epi, class Sched, int SCB, int SCA>
__device__ __forceinline__ void gemm_phase_mix(PG8_LAS unsigned char* lds, const GemmMix g, const Sched& S, const Epi& E) {
    int tid_ = threadIdx.x; asm volatile("" : "+v"(tid_));
    const int tid = tid_, wid = __builtin_amdgcn_readfirstlane(tid >> 6), lane = tid & 63, wr = wid >> 2, wc = wid & 3, fr = lane & 15, fq = lane >> 4;
    const int nt0 = g.K0 / BK, nt1 = g.K1 / BK, nt = nt0 + nt1, koff1 = g.OFF1 / BK - nt0;
    unsigned voffA[2], voffB[2];
#pragma unroll
    for (int i = 0; i < 2; ++i) { int R, C; stage_rc(tid * 16 + i * 8192, R, C); const int Rb = Epi::PERM ? ((R & ~31) + perm32(R & 31)) : R;
        voffA[i] = (unsigned)(R * g.LD + C) * 2u; voffB[i] = (unsigned)(Rb * g.LD + C) * 2u; }
    const size_t kstep = (size_t)(BK * 2);
    const size_t hstep = (size_t)HALF * g.LD * 2, tstep = 2 * hstep;
    const unsigned ldsw = (unsigned)wid * 1024u;
    const int aoff = lds_byte(wr * 64 + fr, fq * 8), boff = lds_byte(wc * 32 + fr, fq * 8);
#define PG8_SA(b, h) (((b) * 2 + (h)) * HTB)
#define PG8_SB(b, h) ((4 + (b) * 2 + (h)) * HTB)
#define PG8_STAGE(bufoff, gbase, voff) do { _Pragma("unroll") for (int _i = 0; _i < 2; ++_i) \
        __builtin_amdgcn_global_load_lds((const unsigned*)((const char*)(gbase) + (voff)[_i]), (PG8_LAS unsigned*)(lds + (bufoff) + ldsw + _i * 8192), 16, 0, 0); } while (0)
#define PG8_LDA1(dst, b, h) do { _Pragma("unroll") for (int m = 0; m < 4; ++m) dst##8[m] = ld2x16(lds + PG8_SA(b, h) + aoff + m * 2048); } while (0)
#define PG8_LDB1(dst, b, h) do { _Pragma("unroll") for (int n = 0; n < 2; ++n) dst##8[n] = ld2x16(lds + PG8_SB(b, h) + boff + n * 2048); } while (0)
#define PG8_LDA0(dst, b, h) do { _Pragma("unroll") for (int m = 0; m < 4; ++m) _Pragma("unroll") for (int k = 0; k < 2; ++k) dst[m][k] = *(const PG8_LAS bf16x8*)(lds + PG8_SA(b, h) + aoff + m * 2048 + k * 1024); } while (0)
#define PG8_LDB0(dst, b, h) do { _Pragma("unroll") for (int n = 0; n < 2; ++n) _Pragma("unroll") for (int k = 0; k < 2; ++k) dst[n][k] = *(const PG8_LAS bf16x8*)(lds + PG8_SB(b, h) + boff + n * 2048 + k * 1024); } while (0)
#define PG8_MMA1(ai, bj, At, Bt) do { __builtin_amdgcn_s_setprio(1); _Pragma("unroll") for (int m = 0; m < 4; ++m) _Pragma("unroll") for (int n = 0; n < 2; ++n) \
            asm volatile("v_mfma_scale_f32_16x16x128_f8f6f4 %0, %1, %2, %0, %3, %4 op_sel_hi:[0,0,0]" : "+v"(acc[ai][bj][m][n]) : "v"(Bt##8[n]), "v"(At##8[m]), "v"(scb_), "v"(sca_)); \
        __builtin_amdgcn_s_setprio(0); } while (0)
#define PG8_MMA0(ai, bj, At, Bt) do { __builtin_amdgcn_s_setprio(1); _Pragma("unroll") for (int m = 0; m < 4; ++m) _Pragma("unroll") for (int n = 0; n < 2; ++n) _Pragma("unroll") for (int k = 0; k < 2; ++k) \
            acc[ai][bj][m][n] = __builtin_amdgcn_mfma_f32_16x16x32_bf16(Bt[n][k], At[m][k], acc[ai][bj][m][n], 0, 0, 0); \
        __builtin_amdgcn_s_setprio(0); } while (0)
#define PG8_WAIT_V(n) asm volatile("s_waitcnt vmcnt(" #n ")" ::: "memory")
#define PG8_WAIT_L(n) asm volatile("s_waitcnt lgkmcnt(" #n ")" ::: "memory")
#define PG8_BAR __builtin_amdgcn_s_barrier()
#define PG8_SCHED __builtin_amdgcn_sched_barrier(0)
    Unit cur, nxt; int ui = 0;
    if (!S.next(0, cur)) return;
    f32x4 acc[2][2][4][2];
#pragma unroll
    for (int a = 0; a < 2; ++a)
#pragma unroll
        for (int b = 0; b < 2; ++b)
#pragma unroll
            for (int m = 0; m < 4; ++m)
#pragma unroll
                for (int n = 0; n < 2; ++n) acc[a][b][m][n] = (f32x4){0.f, 0.f, 0.f, 0.f};
    int scb_ = SCB, sca_ = SCA; asm volatile("" : "+v"(scb_), "+v"(sca_));
    bf16x8 At[4][2], B0[2][2], B1[2][2]; i32x8 At8[4], B08[2], B18[2];
    const char* cA = (const char*)g.A + (size_t)cur.pm * tstep; const char* cB = (const char*)g.B + (size_t)cur.pn * tstep;
    S.a_ready(cur);
    PG8_STAGE(PG8_SB(0, 0), cB, voffB); PG8_STAGE(PG8_SB(0, 1), cB + hstep, voffB); PG8_STAGE(PG8_SA(0, 0), cA, voffA); PG8_STAGE(PG8_SA(0, 1), cA + hstep, voffA);
    if (wr == 1) PG8_BAR;
    PG8_WAIT_V(2); PG8_BAR;
    PG8_STAGE(PG8_SB(1, 0), cB + kstep, voffB); PG8_STAGE(PG8_SA(1, 0), cA + kstep, voffA); PG8_STAGE(PG8_SB(1, 1), cB + hstep + kstep, voffB);
    PG8_WAIT_V(6); PG8_BAR;
    for (;;) {
        const bool has_next = S.next(ui + 1, nxt);
        const char* nA = has_next ? (const char*)g.A + (size_t)nxt.pm * tstep : cA; const char* nB = has_next ? (const char*)g.B + (size_t)nxt.pn * tstep : cB;
#define PG8_KPOS(x) ((size_t)((x) < nt0 ? (x) : (x) + koff1) * kstep)
#define PG8_TRIP(F) do { \
            const bool last = (t == nt - 2); \
            const char* a1 = cA + PG8_KPOS(t + 1); \
            const char* a2 = last ? nA : cA + PG8_KPOS(t + 2); const char* b2 = last ? nB : cB + PG8_KPOS(t + 2); \
            const char* a3 = last ? nA + kstep : cA + PG8_KPOS(t + 3); const char* b3 = last ? nB + kstep : cB + PG8_KPOS(t + 3); \
            if (last && has_next) S.a_ready(nxt); \
            PG8_LDB##F(B0, 0, 0); PG8_LDB##F(B1, 0, 1); PG8_SCHED; PG8_LDA##F(At, 0, 0); PG8_STAGE(PG8_SA(1, 1), a1 + hstep, voffA); \
            PG8_WAIT_V(8); PG8_WAIT_L(0); PG8_BAR; PG8_MMA##F(0, 0, At, B0); PG8_MMA##F(0, 1, At, B1); PG8_BAR; PG8_SCHED; \
            PG8_LDA##F(At, 0, 1); PG8_STAGE(PG8_SB(0, 0), b2, voffB); PG8_STAGE(PG8_SB(0, 1), b2 + hstep, voffB); PG8_STAGE(PG8_SA(0, 0), a2, voffA); \
            PG8_WAIT_V(8); PG8_WAIT_L(0); PG8_BAR; PG8_MMA##F(1, 0, At, B0); PG8_MMA##F(1, 1, At, B1); PG8_BAR; PG8_SCHED; \
            PG8_LDB##F(B0, 1, 0); PG8_LDB##F(B1, 1, 1); PG8_SCHED; PG8_LDA##F(At, 1, 0); PG8_STAGE(PG8_SA(0, 1), a2 + hstep, voffA); \
            PG8_WAIT_V(8); PG8_WAIT_L(0); PG8_BAR; PG8_MMA##F(0, 0, At, B0); PG8_MMA##F(0, 1, At, B1); PG8_BAR; PG8_SCHED; \
            PG8_LDA##F(At, 1, 1); PG8_STAGE(PG8_SB(1, 0), b3, voffB); PG8_STAGE(PG8_SB(1, 1), b3 + hstep, voffB); PG8_STAGE(PG8_SA(1, 0), a3, voffA); \
            PG8_WAIT_V(8); PG8_WAIT_L(0); PG8_BAR; PG8_MMA##F(1, 0, At, B0); PG8_MMA##F(1, 1, At, B1); PG8_BAR; PG8_SCHED; \
        } while (0)
#pragma unroll 1
        for (int t = 0; t < nt0; t += 2) PG8_TRIP(1);
        asm volatile("s_nop 7" ::: "memory");
#pragma unroll 1
        for (int t = nt0; t < nt; t += 2) PG8_TRIP(0);
#undef PG8_TRIP
#undef PG8_KPOS
        asm volatile("s_nop 15\n\ts_nop 15" ::: "memory");
        if (wr == 0) PG8_BAR;
        { int fr_ = fr, fq_ = fq; asm volatile("" : "+v"(fr_), "+v"(fq_)); E(acc, cur, wr, wc, fr_, fq_); S.done(cur); }
        if (!has_next) break;
#pragma unroll
        for (int a = 0; a < 2; ++a)
#pragma unroll
            for (int b = 0; b < 2; ++b)
#pragma unroll
                for (int m = 0; m < 4; ++m)
#pragma unroll
                    for (int n = 0; n < 2; ++n) acc[a][b][m][n] = (f32x4){0.f, 0.f, 0.f, 0.f};
        cur = nxt; cA = nA; cB = nB; ++ui;
        if (wr == 1) PG8_BAR;
    }
    PG8_WAIT_V(0);
    PG8_BAR;
#undef PG8_SA
#undef PG8_SB
#undef PG8_STAGE
#undef PG8_LDA0
#undef PG8_LDB0
#undef PG8_LDA1
#undef PG8_LDB1
#undef PG8_MMA0
#undef PG8_MMA1
#undef PG8_WAIT_V
#undef PG8_WAIT_L
#undef PG8_BAR
#undef PG8_SCHED
}
}
namespace att {
constexpr int KS_M = 400, KS_N = 272, VS = 320;
constexpr int MLA_KB = 64 * KS_M, NSA_KB = 64 * KS_N, VB = 64 * VS;
constexpr int N_IMP = 2 * NSA_KB + 2 * VB;
constexpr int N_PART = N_IMP + 32768;
constexpr int N_PARTB = 8 * 32 * 17 * 4;
constexpr int N_SELM = N_PART + 2 * N_PARTB;
constexpr int N_ULIST = N_SELM + 1024;
constexpr int N_CARRY = N_ULIST + 1024;
constexpr int N_NTS = N_CARRY + 256;
static_assert(N_NTS + 16 <= MISC_OFF, "NSA LDS map");
static_assert(2 * MLA_KB + 3 * VB <= 131072, "MLA LDS map");
constexpr int MLA_QL = 2 * MLA_KB + 2 * VB;
static_assert(MLA_QL + 8 * 4096 <= 131072, "MLA LDS map (pipelined)");

#ifndef QK_PF
#define QK_PF 4
#endif
#define MFMA32(a, b, c) __builtin_amdgcn_mfma_f32_32x32x16_bf16((a), (b), (c), 0, 0, 0)
__device__ __forceinline__ float swapmax(float v) { auto rr = __builtin_amdgcn_permlane32_swap(__float_as_uint(v), __float_as_uint(v), false, false); return fmaxf(__uint_as_float(rr[0]), __uint_as_float(rr[1])); }
__device__ __forceinline__ float swapsum(float v) { auto rr = __builtin_amdgcn_permlane32_swap(__float_as_uint(v), __float_as_uint(v), false, false); return __uint_as_float(rr[0]) + __uint_as_float(rr[1]); }
template <int SIDX> __device__ __forceinline__ bf16x8 packp(const f32x16& p) {
    f32x8 t = {p[8 * SIDX + 0], p[8 * SIDX + 1], p[8 * SIDX + 2], p[8 * SIDX + 3], p[8 * SIDX + 4], p[8 * SIDX + 5], p[8 * SIDX + 6], p[8 * SIDX + 7]};
    return __builtin_bit_cast(bf16x8, __builtin_convertvector(t, bf16x8v));
}
template <int NDC, int KS, bool ZERO = true> __device__ __forceinline__ void qk_tile(f32x16& p0, f32x16& p1, const LAS unsigned char* kl, const bf16x8 (&q)[NDC]) {
    if (ZERO) {
#pragma unroll
        for (int i = 0; i < 16; ++i) { p0[i] = 0.f; p1[i] = 0.f; }
    }
    constexpr int PF = QK_PF;
    bf16x8 a[PF + 1][2];
#pragma unroll
    for (int i = 0; i < PF; ++i) { a[i][0] = *(const LAS bf16x8*)(kl + i * 32); a[i][1] = *(const LAS bf16x8*)(kl + 32 * KS + i * 32); }
#pragma unroll
    for (int d0 = 0; d0 < NDC; ++d0) {
        if (d0 + PF < NDC) { a[(d0 + PF) % (PF + 1)][0] = *(const LAS bf16x8*)(kl + (d0 + PF) * 32); a[(d0 + PF) % (PF + 1)][1] = *(const LAS bf16x8*)(kl + 32 * KS + (d0 + PF) * 32); }
        __builtin_amdgcn_sched_barrier(0);
        p0 = MFMA32(a[d0 % (PF + 1)][0], q[d0], p0); p1 = MFMA32(a[d0 % (PF + 1)][1], q[d0], p1);
        __builtin_amdgcn_sched_barrier(0);
    }
}
struct PvPre { s16x4 f[4][2]; };
__device__ __forceinline__ void pv_preload(PvPre& pp, const LAS unsigned char* vl) {
#pragma unroll
    for (int s_ = 0; s_ < 4; ++s_) { pp.f[s_][0] = __builtin_amdgcn_ds_read_tr16_b64_v4i16((LAS s16x4*)(vl + s_ * 16 * VS)); pp.f[s_][1] = __builtin_amdgcn_ds_read_tr16_b64_v4i16((LAS s16x4*)(vl + s_ * 16 * VS + 8 * VS)); }
}
template <bool PRE = false>
__device__ __forceinline__ void pv_tile(f32x16 (&o)[4], const bf16x8 (&pb)[4], const LAS unsigned char* vl, const PvPre* pp = nullptr) {
    s16x4 f[5][2];
#define PV_LD(idx) do { constexpr int d_ = (idx) >> 2, s_ = (idx) & 3; \
        f[(idx) % 5][0] = __builtin_amdgcn_ds_read_tr16_b64_v4i16((LAS s16x4*)(vl + s_ * 16 * VS + d_ * 64)); \
        f[(idx) % 5][1] = __builtin_amdgcn_ds_read_tr16_b64_v4i16((LAS s16x4*)(vl + s_ * 16 * VS + 8 * VS + d_ * 64)); } while (0)
    if (PRE) {
#pragma unroll
        for (int s_ = 0; s_ < 4; ++s_) { f[s_][0] = pp->f[s_][0]; f[s_][1] = pp->f[s_][1]; }
    } else { PV_LD(0); PV_LD(1); PV_LD(2); PV_LD(3); }
#define PV_STEP(idx) do { if ((idx) + 4 < 16) PV_LD((idx) + 4); __builtin_amdgcn_sched_barrier(0); \
        { const s16x4 t0_ = f[(idx) % 5][0], t1_ = f[(idx) % 5][1]; const bf16x8 vf_ = {t0_[0], t0_[1], t0_[2], t0_[3], t1_[0], t1_[1], t1_[2], t1_[3]}; \
          o[(idx) >> 2] = MFMA32(vf_, pb[(idx) & 3], o[(idx) >> 2]); } __builtin_amdgcn_sched_barrier(0); } while (0)
    PV_STEP(0); PV_STEP(1); PV_STEP(2); PV_STEP(3); PV_STEP(4); PV_STEP(5); PV_STEP(6); PV_STEP(7);
    PV_STEP(8); PV_STEP(9); PV_STEP(10); PV_STEP(11); PV_STEP(12); PV_STEP(13); PV_STEP(14); PV_STEP(15);
#undef PV_STEP
#undef PV_LD
}
template <int NDC, int NQR, int KS> __device__ __forceinline__ void qk_tile_free(f32x16& p0, f32x16& p1, const LAS unsigned char* kl, const bf16x8 (&q)[NQR], const LAS unsigned char* ql) {
#pragma unroll
    for (int i = 0; i < 16; ++i) { p0[i] = 0.f; p1[i] = 0.f; }
#pragma unroll
    for (int d0 = 0; d0 < NDC; ++d0) {
        const bf16x8 a0 = *(const LAS bf16x8*)(kl + d0 * 32);
        const bf16x8 a1 = *(const LAS bf16x8*)(kl + 32 * KS + d0 * 32);
        bf16x8 qq; if (d0 < NQR) qq = q[d0 < NQR ? d0 : 0]; else qq = *(const LAS bf16x8*)(ql + (d0 - NQR) * 1024);
        p0 = MFMA32(a0, qq, p0); p1 = MFMA32(a1, qq, p1);
    }
}
__device__ __forceinline__ float sm_core(f32x16& p0, f32x16& p1, float& m, float& l) {
    float tm = p0[0];
#pragma unroll
    for (int r = 1; r < 16; ++r) tm = fmaxf(tm, p0[r]);
#pragma unroll
    for (int r = 0; r < 16; ++r) tm = fmaxf(tm, p1[r]);
    tm = swapmax(tm);
    const float mn = fmaxf(m, tm);
    const float alpha = __builtin_amdgcn_exp2f(m - mn);
    m = mn;
    float ps = 0.f;
#pragma unroll
    for (int r = 0; r < 16; ++r) { p0[r] = __builtin_amdgcn_exp2f(p0[r] - mn); ps += p0[r]; }
#pragma unroll
    for (int r = 0; r < 16; ++r) { p1[r] = __builtin_amdgcn_exp2f(p1[r] - mn); ps += p1[r]; }
    ps = swapsum(ps);
    l = l * alpha + ps;
    return alpha;
}
__device__ __forceinline__ void online_sm(f32x16& p0, f32x16& p1, float& m, float& l, f32x16 (&o)[4]) {
    float tm = p0[0];
#pragma unroll
    for (int r = 1; r < 16; ++r) tm = fmaxf(tm, p0[r]);
#pragma unroll
    for (int r = 0; r < 16; ++r) tm = fmaxf(tm, p1[r]);
    tm = swapmax(tm);
    const float mn = fmaxf(m, tm);
    const float alpha = __builtin_amdgcn_exp2f(m - mn);
    m = mn;
    float ps = 0.f;
#pragma unroll
    for (int r = 0; r < 16; ++r) { p0[r] = __builtin_amdgcn_exp2f(p0[r] - mn); ps += p0[r]; }
#pragma unroll
    for (int r = 0; r < 16; ++r) { p1[r] = __builtin_amdgcn_exp2f(p1[r] - mn); ps += p1[r]; }
    ps = swapsum(ps);
    l = l * alpha + ps;
    if (!__all(alpha == 1.f)) {
#pragma unroll
        for (int d = 0; d < 4; ++d)
#pragma unroll
            for (int r = 0; r < 16; ++r) o[d][r] *= alpha;
    }
}

typedef long i64;
constexpr int KS8 = 200, MLA_KB8 = 64 * KS8;
static_assert(2 * MLA_KB8 + 3 * VB <= 131072, "MLA fp8 LDS map");
#define MFMA32F8(a, b, c) __builtin_amdgcn_mfma_f32_32x32x16_fp8_fp8((a), (b), (c), 0, 0, 0)
template <int NDC> __device__ __forceinline__ void qk_tile8(f32x16& p0, f32x16& p1, const LAS unsigned char* kl, const i64 (&q)[NDC]) {
#pragma unroll
    for (int i = 0; i < 16; ++i) { p0[i] = 0.f; p1[i] = 0.f; }
    constexpr int PF = 4;
    i64 a[PF + 1][2];
#pragma unroll
    for (int i = 0; i < PF; ++i) { a[i][0] = *(const LAS i64*)(kl + i * 16); a[i][1] = *(const LAS i64*)(kl + 32 * KS8 + i * 16); }
#pragma unroll
    for (int d0 = 0; d0 < NDC; ++d0) {
        if (d0 + PF < NDC) { a[(d0 + PF) % (PF + 1)][0] = *(const LAS i64*)(kl + (d0 + PF) * 16); a[(d0 + PF) % (PF + 1)][1] = *(const LAS i64*)(kl + 32 * KS8 + (d0 + PF) * 16); }
        __builtin_amdgcn_sched_barrier(0);
        __builtin_amdgcn_s_setprio(1);
        p0 = MFMA32F8(a[d0 % (PF + 1)][0], q[d0], p0); p1 = MFMA32F8(a[d0 % (PF + 1)][1], q[d0], p1);
        __builtin_amdgcn_s_setprio(0);
        __builtin_amdgcn_sched_barrier(0);
    }
}
__device__ __forceinline__ void online_sm_scaled(f32x16& p0, f32x16& p1, float& m, float& l, f32x16 (&o)[4], const float C2) {
    float tm = p0[0];
#pragma unroll
    for (int r = 1; r < 16; ++r) tm = fmaxf(tm, p0[r]);
#pragma unroll
    for (int r = 0; r < 16; ++r) tm = fmaxf(tm, p1[r]);
    tm = swapmax(tm);
    const float mn = fmaxf(m, tm);
    const float alpha = __builtin_amdgcn_exp2f((m - mn) * C2);
    m = mn;
    const float mc = -mn * C2;
    float ps = 0.f;
#pragma unroll
    for (int r = 0; r < 16; ++r) { p0[r] = __builtin_amdgcn_exp2f(__builtin_fmaf(p0[r], C2, mc)); ps += p0[r]; }
#pragma unroll
    for (int r = 0; r < 16; ++r) { p1[r] = __builtin_amdgcn_exp2f(__builtin_fmaf(p1[r], C2, mc)); ps += p1[r]; }
    ps = swapsum(ps);
    l = l * alpha + ps;
    if (!__all(alpha == 1.f)) {
#pragma unroll
        for (int d = 0; d < 4; ++d)
#pragma unroll
            for (int r = 0; r < 16; ++r) o[d][r] *= alpha;
    }
}
constexpr int VS8 = 72, VB8 = 128 * VS8;
constexpr int VS8B = 136, VB8B = 128 * VS8B, MLA_KB8B = 128 * KS8;
static_assert(2 * MLA_KB8B + 3 * VB8B <= 131072, "MLA big-tile LDS map");
#define PV8_RS VS8
static_assert(2 * MLA_KB8 + 3 * VB8 <= 131072, "MLA fp8 LDS map");
template <int SIDX> __device__ __forceinline__ i64 packp8(const f32x16& p) {
    int w0 = __builtin_amdgcn_cvt_pk_fp8_f32(p[8 * SIDX + 0] * 256.f, p[8 * SIDX + 1] * 256.f, 0, false); w0 = __builtin_amdgcn_cvt_pk_fp8_f32(p[8 * SIDX + 2] * 256.f, p[8 * SIDX + 3] * 256.f, w0, true);
    int w1 = __builtin_amdgcn_cvt_pk_fp8_f32(p[8 * SIDX + 4] * 256.f, p[8 * SIDX + 5] * 256.f, 0, false); w1 = __builtin_amdgcn_cvt_pk_fp8_f32(p[8 * SIDX + 6] * 256.f, p[8 * SIDX + 7] * 256.f, w1, true);
    return (i64)(((unsigned long long)(unsigned)w1 << 32) | (unsigned)w0);
}
__device__ __forceinline__ void pv_tile8(f32x16 (&o)[4], const i64 (&pb)[4], const LAS unsigned char* vl) {
    i64 f[5];
#define PV8_LD(idx) f[(idx) % 5] = *(const LAS i64*)(vl + ((idx) >> 2) * 32 * PV8_RS + ((idx) & 3) * 16)
    PV8_LD(0); PV8_LD(1); PV8_LD(2); PV8_LD(3);
#define PV8_STEP(idx) do { if ((idx) + 4 < 16) PV8_LD((idx) + 4); __builtin_amdgcn_sched_barrier(0); \
        o[(idx) >> 2] = MFMA32F8(f[(idx) % 5], pb[(idx) & 3], o[(idx) >> 2]); __builtin_amdgcn_sched_barrier(0); } while (0)
    PV8_STEP(0); PV8_STEP(1); PV8_STEP(2); PV8_STEP(3); PV8_STEP(4); PV8_STEP(5); PV8_STEP(6); PV8_STEP(7);
    PV8_STEP(8); PV8_STEP(9); PV8_STEP(10); PV8_STEP(11); PV8_STEP(12); PV8_STEP(13); PV8_STEP(14); PV8_STEP(15);
#undef PV8_STEP
#undef PV8_LD
}
typedef int i32x8 __attribute__((ext_vector_type(8)));
constexpr int KSX = 208, MLA_KBX = 64 * KSX;
constexpr int VSX = 80, VBX = 128 * VSX;
static_assert(2 * MLA_KBX + 3 * VBX <= 131072, "MLA mx LDS map");
#define MFMAX(a, b, c) __builtin_amdgcn_mfma_scale_f32_32x32x64_f8f6f4((a), (b), (c), 0, 0, 0, 0x7f7f7f7f, 0, 0x7f7f7f7f)
__device__ __forceinline__ i32x8 ldsx(const LAS unsigned char* p) {
    const u32x4 a = *(const LAS u32x4*)p, b = *(const LAS u32x4*)(p + 16);
    return (i32x8){(int)a.x, (int)a.y, (int)a.z, (int)a.w, (int)b.x, (int)b.y, (int)b.z, (int)b.w};
}
__device__ __forceinline__ void qk_tilex(f32x16& p0, f32x16& p1, const LAS unsigned char* kl, const i32x8 (&q)[3]) {
#pragma unroll
    for (int i = 0; i < 16; ++i) { p0[i] = 0.f; p1[i] = 0.f; }
    i32x8 a0 = ldsx(kl), a1 = ldsx(kl + 32 * KSX), a2 = ldsx(kl + 64), a3 = ldsx(kl + 32 * KSX + 64);
    __builtin_amdgcn_sched_barrier(0);
    __builtin_amdgcn_s_setprio(1);
    p0 = MFMAX(a0, q[0], p0); p1 = MFMAX(a1, q[0], p1);
    __builtin_amdgcn_s_setprio(0);
    __builtin_amdgcn_sched_barrier(0);
    a0 = ldsx(kl + 128); a1 = ldsx(kl + 32 * KSX + 128);
    __builtin_amdgcn_sched_barrier(0);
    __builtin_amdgcn_s_setprio(1);
    p0 = MFMAX(a2, q[1], p0); p1 = MFMAX(a3, q[1], p1);
    __builtin_amdgcn_sched_barrier(0);
    p0 = MFMAX(a0, q[2], p0); p1 = MFMAX(a1, q[2], p1);
    __builtin_amdgcn_s_setprio(0);
    __builtin_amdgcn_sched_barrier(0);
}
__device__ __forceinline__ void pv_tilex(f32x16 (&o)[4], const i32x8& pb, const LAS unsigned char* vl) {
    i32x8 f0 = ldsx(vl), f1 = ldsx(vl + 32 * VSX);
    __builtin_amdgcn_sched_barrier(0);
    o[0] = MFMAX(f0, pb, o[0]);
    __builtin_amdgcn_sched_barrier(0);
    f0 = ldsx(vl + 64 * VSX);
    __builtin_amdgcn_sched_barrier(0);
    o[1] = MFMAX(f1, pb, o[1]);
    __builtin_amdgcn_sched_barrier(0);
    f1 = ldsx(vl + 96 * VSX);
    __builtin_amdgcn_sched_barrier(0);
    o[2] = MFMAX(f0, pb, o[2]);
    __builtin_amdgcn_sched_barrier(0);
    o[3] = MFMAX(f1, pb, o[3]);
    __builtin_amdgcn_sched_barrier(0);
}
__device__ __forceinline__ i32x8 packpx(const f32x16& p0, const f32x16& p1) {
    i32x8 w;
#pragma unroll
    for (int g = 0; g < 4; ++g) {
        int a = __builtin_amdgcn_cvt_pk_fp8_f32(p0[4 * g + 0], p0[4 * g + 1], 0, false); a = __builtin_amdgcn_cvt_pk_fp8_f32(p0[4 * g + 2], p0[4 * g + 3], a, true); w[g] = a;
        int b = __builtin_amdgcn_cvt_pk_fp8_f32(p1[4 * g + 0], p1[4 * g + 1], 0, false); b = __builtin_amdgcn_cvt_pk_fp8_f32(p1[4 * g + 2], p1[4 * g + 3], b, true); w[4 + g] = b;
    }
    return w;
}
__device__ __forceinline__ void online_sm_x(f32x16& p0, f32x16& p1, float& m, float& l, f32x16 (&o)[4], const float C2) {
    float tm = p0[0];
#pragma unroll
    for (int r = 1; r < 16; ++r) tm = fmaxf(tm, p0[r]);
#pragma unroll
    for (int r = 0; r < 16; ++r) tm = fmaxf(tm, p1[r]);
    tm = swapmax(tm);
    const float mn = fmaxf(m, tm);
    const float alpha = __builtin_amdgcn_exp2f((m - mn) * C2);
    m = mn;
    const float mc = 8.f - mn * C2;
    float ps = 0.f;
#pragma unroll
    for (int r = 0; r < 16; ++r) { p0[r] = __builtin_amdgcn_exp2f(__builtin_fmaf(p0[r], C2, mc)); ps += p0[r]; }
#pragma unroll
    for (int r = 0; r < 16; ++r) { p1[r] = __builtin_amdgcn_exp2f(__builtin_fmaf(p1[r], C2, mc)); ps += p1[r]; }
    ps = swapsum(ps);
    l = l * alpha + ps;
    if (!__all(alpha == 1.f)) {
#pragma unroll
        for (int d = 0; d < 4; ++d)
#pragma unroll
            for (int r = 0; r < 16; ++r) o[d][r] *= alpha;
    }
}
#define MXL_T 126.0f
#define MXL_REF 96.0f
#define MFMAXQ(a, b, c) __builtin_amdgcn_mfma_scale_f32_32x32x64_f8f6f4((a), (b), (c), 0, 0, 0, 0x7f7f7f7f, 0, 0x7f7f7f7f)
__device__ __forceinline__ i32x8 byte_packx(const f32x16& p0, const f32x16& p1) {
    i32x8 w;
#pragma unroll
    for (int g = 0; g < 4; ++g) {
        unsigned a = __builtin_amdgcn_cvt_pk_u8_f32(p0[4 * g + 0], 0, 0u); a = __builtin_amdgcn_cvt_pk_u8_f32(p0[4 * g + 1], 1, a); a = __builtin_amdgcn_cvt_pk_u8_f32(p0[4 * g + 2], 2, a); a = __builtin_amdgcn_cvt_pk_u8_f32(p0[4 * g + 3], 3, a); w[g] = (int)a;
        unsigned b = __builtin_amdgcn_cvt_pk_u8_f32(p1[4 * g + 0], 0, 0u); b = __builtin_amdgcn_cvt_pk_u8_f32(p1[4 * g + 1], 1, b); b = __builtin_amdgcn_cvt_pk_u8_f32(p1[4 * g + 2], 2, b); b = __builtin_amdgcn_cvt_pk_u8_f32(p1[4 * g + 3], 3, b); w[4 + g] = (int)b;
    }
    return w;
}
__device__ __forceinline__ void qk_tilexl(f32x16& p0, f32x16& p1, const f32x16& mref, const LAS unsigned char* kl, const i32x8 (&q)[3]) {
    i32x8 a0 = ldsx(kl), a1 = ldsx(kl + 32 * KSX), a2 = ldsx(kl + 64), a3 = ldsx(kl + 32 * KSX + 64);
    __builtin_amdgcn_sched_barrier(0);
    __builtin_amdgcn_s_setprio(1);
    p0 = MFMAXQ(a0, q[0], mref); p1 = MFMAXQ(a1, q[0], mref);
    __builtin_amdgcn_s_setprio(0);
    __builtin_amdgcn_sched_barrier(0);
    a0 = ldsx(kl + 128); a1 = ldsx(kl + 32 * KSX + 128);
    __builtin_amdgcn_sched_barrier(0);
    __builtin_amdgcn_s_setprio(1);
    p0 = MFMAXQ(a2, q[1], p0); p1 = MFMAXQ(a3, q[1], p1);
    __builtin_amdgcn_sched_barrier(0);
    p0 = MFMAXQ(a0, q[2], p0); p1 = MFMAXQ(a1, q[2], p1);
    __builtin_amdgcn_s_setprio(0);
    __builtin_amdgcn_sched_barrier(0);
}
template <int RS = VSX>
__device__ __forceinline__ void pv_tilexl_pre(f32x16 (&o)[5], const i32x8& pb, const i32x8& ones, const LAS unsigned char* vl, i32x8 f0, i32x8 f1) {
    __builtin_amdgcn_sched_barrier(0);
    o[4] = MFMAX(ones, pb, o[4]);
    __builtin_amdgcn_sched_barrier(0);
    o[0] = MFMAX(f0, pb, o[0]);
    __builtin_amdgcn_sched_barrier(0);
    f0 = ldsx(vl + 64 * RS);
    __builtin_amdgcn_sched_barrier(0);
    o[1] = MFMAX(f1, pb, o[1]);
    __builtin_amdgcn_sched_barrier(0);
    f1 = ldsx(vl + 96 * RS);
    __builtin_amdgcn_sched_barrier(0);
    o[2] = MFMAX(f0, pb, o[2]);
    __builtin_amdgcn_sched_barrier(0);
    o[3] = MFMAX(f1, pb, o[3]);
    __builtin_amdgcn_sched_barrier(0);
}
template <int RS = VSX>
__device__ __forceinline__ void pv_tilexl(f32x16 (&o)[5], const i32x8& pb, const i32x8& ones, const LAS unsigned char* vl) {
    i32x8 f0 = ldsx(vl), f1 = ldsx(vl + 32 * RS);
    __builtin_amdgcn_sched_barrier(0);
    o[4] = MFMAX(ones, pb, o[4]);
    __builtin_amdgcn_sched_barrier(0);
    o[0] = MFMAX(f0, pb, o[0]);
    __builtin_amdgcn_sched_barrier(0);
    f0 = ldsx(vl + 64 * RS);
    __builtin_amdgcn_sched_barrier(0);
    o[1] = MFMAX(f1, pb, o[1]);
    __builtin_amdgcn_sched_barrier(0);
    f1 = ldsx(vl + 96 * RS);
    __builtin_amdgcn_sched_barrier(0);
    o[2] = MFMAX(f0, pb, o[2]);
    __builtin_amdgcn_sched_barrier(0);
    o[3] = MFMAX(f1, pb, o[3]);
    __builtin_amdgcn_sched_barrier(0);
}
__device__ __forceinline__ i32x8 exp_packx(const f32x16& p0, const f32x16& p1, int any) {
    i32x8 w;
#pragma unroll
    for (int g = 0; g < 4; ++g) {
        int a = __builtin_amdgcn_cvt_pk_fp8_f32(__builtin_amdgcn_exp2f(p0[4 * g + 0]), __builtin_amdgcn_exp2f(p0[4 * g + 1]), any, false);
        a = __builtin_amdgcn_cvt_pk_fp8_f32(__builtin_amdgcn_exp2f(p0[4 * g + 2]), __builtin_amdgcn_exp2f(p0[4 * g + 3]), a, true); w[g] = a;
        int b = __builtin_amdgcn_cvt_pk_fp8_f32(__builtin_amdgcn_exp2f(p1[4 * g + 0]), __builtin_amdgcn_exp2f(p1[4 * g + 1]), any, false);
        b = __builtin_amdgcn_cvt_pk_fp8_f32(__builtin_amdgcn_exp2f(p1[4 * g + 2]), __builtin_amdgcn_exp2f(p1[4 * g + 3]), b, true); w[4 + g] = b;
    }
    return w;
}
struct MlaPtrs { const bf16* Q; const bf16* K; const bf16* V; const bf16* Z; bf16* O; };
struct MlaPre { u32x2 k0, k1, k2; u32x4 v0; };
__device__ __forceinline__ void mla_preload(MlaPre& pp, const MlaPtrs& P, int head, int tid) {
    const unsigned char* kp_ = (const unsigned char*)P.K + (size_t)head * 192 + (size_t)(tid >> 3) * 3072 + (tid & 7) * 8;
    const unsigned char* vp_ = (const unsigned char*)P.V + ((size_t)head * 128 + (tid >> 2)) * S + (tid & 3) * 16;
    pp.k0 = *(const GAS u32x2*)(kp_); pp.k1 = *(const GAS u32x2*)(kp_ + 64); pp.k2 = *(const GAS u32x2*)(kp_ + 128); pp.v0 = *(const GAS u32x4*)(vp_);
}
__device__ __forceinline__ void mla_unit(LAS unsigned char* lds, const MlaPtrs& P, int head, int qb, int tid_in, int wave, int lane_in, MlaPre& pre, int nhead) {
    int tid = tid_in; asm volatile("" : "+v"(tid)); const int lane = tid & 63; (void)lane_in;
    const int r32 = lane & 31, hi = lane >> 5;
    const int q0 = qb * 256, qw = q0 + wave * 32, tq = qw + r32;
    i32x8 q[3];
    { const unsigned char* qp = (const unsigned char*)P.Q + (size_t)tq * 3072 + head * 192 + hi * 32;
#pragma unroll
      for (int s = 0; s < 3; ++s) { const u32x4 a = *(const GAS u32x4*)(qp + 64 * s), b = *(const GAS u32x4*)(qp + 64 * s + 16);
          q[s] = (i32x8){(int)a.x, (int)a.y, (int)a.z, (int)a.w, (int)b.x, (int)b.y, (int)b.z, (int)b.w}; } }
    const int NT = 4 * (qb + 1);
    const int srow = tid >> 3, sc8 = tid & 7;
    const unsigned char* kg = (const unsigned char*)P.K + (size_t)head * 192 + (size_t)srow * 3072 + sc8 * 8;
    const unsigned char* vg = (const unsigned char*)P.V + ((size_t)head * 128 + (tid >> 2)) * S + (tid & 3) * 16;
    LAS unsigned char* kst = lds + srow * KSX + sc8 * 8;
    LAS unsigned char* vst = lds + 2 * MLA_KBX + (tid >> 2) * VSX + (tid & 3) * 16;
    const LAS unsigned char* kl = lds + r32 * KSX + hi * 32;
    const LAS unsigned char* vl = lds + 2 * MLA_KBX + r32 * VSX + hi * 32;
    u32x2 sk0, sk1, sk2; u32x4 sv0;
#define MLA_LOAD(j) do { const unsigned char* kp_ = kg + (size_t)(j) * (64 * 3072); const unsigned char* vp_ = vg + (size_t)(j) * 64; \
        sk0 = *(const GAS u32x2*)(kp_); sk1 = *(const GAS u32x2*)(kp_ + 64); sk2 = *(const GAS u32x2*)(kp_ + 128); sv0 = *(const GAS u32x4*)(vp_); } while (0)
#define MLA_STORE(b, vb) do { LAS unsigned char* kd_ = kst + (b) * MLA_KBX; LAS unsigned char* vd_ = vst + (vb) * VBX; \
        *(LAS u32x2*)(kd_) = sk0; *(LAS u32x2*)(kd_ + 64) = sk1; *(LAS u32x2*)(kd_ + 128) = sk2; *(LAS u32x2*)(vd_) = (u32x2){sv0.x, sv0.y}; *(LAS u32x2*)(vd_ + 8) = (u32x2){sv0.z, sv0.w}; } while (0)
    sk0 = pre.k0; sk1 = pre.k1; sk2 = pre.k2; sv0 = pre.v0; MLA_STORE(0, 0);
    __syncthreads();
    asm volatile("" : "+v"(q[0]), "+v"(q[1]), "+v"(q[2]));
    f32x16 o[5], mref;
#pragma unroll
    for (int d = 0; d < 5; ++d)
#pragma unroll
        for (int r = 0; r < 16; ++r) o[d][r] = 0.f;
#pragma unroll
    for (int r = 0; r < 16; ++r) mref[r] = MXL_REF;
    const int one8 = (r32 == 0 || r32 == 4) ? 0x38383838 : 0;
    const i32x8 ones = {one8, one8, one8, one8, one8, one8, one8, one8};
    const bool trail = wave >= 4;
    i32x8 pb = {}, fa = {}, fb = {};
    int vb_cur = 0, vb_prev = 2;
    for (int j = 0; j < NT; ++j) {
        const int kb = 64 * j;
        int vb_next = vb_cur + 1; if (vb_next == 3) vb_next = 0;
        if (j + 1 < NT) MLA_LOAD(j + 1);
        if (trail && j > 0 && kb - 64 <= qw + 31) pv_tilexl_pre(o, pb, ones, vl + vb_prev * VBX, fa, fb);
        if (kb <= qw + 31) {
            f32x16 p0, p1;
            qk_tilexl(p0, p1, mref, kl + (j & 1) * MLA_KBX, q);
            fa = ldsx(vl + vb_cur * VBX); fb = ldsx(vl + vb_cur * VBX + 32 * VSX);
            __builtin_amdgcn_sched_barrier(0);
            if (kb + 63 > qw) {
                const int dq = tq - kb - 4 * hi;
#pragma unroll
                for (int r = 0; r < 16; ++r) { const int c = (r & 3) + 8 * (r >> 2);
                    if (c > dq) p0[r] = -__builtin_inff();
                    if (c + 32 > dq) p1[r] = -__builtin_inff(); }
            }
            float tm = p0[0];
#pragma unroll
            for (int r = 1; r < 16; ++r) tm = fmaxf(tm, p0[r]);
#pragma unroll
            for (int r = 0; r < 16; ++r) tm = fmaxf(tm, p1[r]);
            tm = swapmax(tm);
            if (j == 0 || !__all(tm <= MXL_T)) {
                const float dlt = (j == 0) ? tm - MXL_REF : fmaxf(tm - MXL_REF, 0.f);
                const float alpha = __builtin_amdgcn_exp2f(-0.125f * dlt);
#pragma unroll
                for (int r = 0; r < 16; ++r) { p0[r] -= dlt; p1[r] -= dlt; mref[r] -= dlt; }
                if (j > 0) {
#pragma unroll
                    for (int d = 0; d < 5; ++d)
#pragma unroll
                        for (int r = 0; r < 16; ++r) o[d][r] *= alpha;
                }
            }
            pb = byte_packx(p0, p1);
            if (!trail) pv_tilexl_pre(o, pb, ones, vl + vb_cur * VBX, fa, fb);
        }
        if (j + 1 < NT) MLA_STORE((j + 1) & 1, vb_next);
        __syncthreads();
        vb_prev = vb_cur; vb_cur = vb_next;
    }
    if (trail && 64 * (NT - 1) <= qw + 31) pv_tilexl_pre(o, pb, ones, vl + vb_prev * VBX, fa, fb);
    __syncthreads();
#undef MLA_LOAD
#undef MLA_STORE
    mla_preload(pre, P, nhead, tid);
    const bf16* zp = P.Z + (size_t)tq * 2048 + head * 128 + 4 * hi;
    const float inv = 16.f / o[4][0];
    unsigned char* op8 = (unsigned char*)P.O + (size_t)tq * 8192 + head * 128 + 4 * hi;
#pragma unroll
    for (int d0 = 0; d0 < 4; ++d0)
#pragma unroll
        for (int rg = 0; rg < 4; ++rg) { const int dim = 32 * d0 + 8 * rg;
            const u32x2 z = *(const GAS u32x2*)(zp + dim);
            int w = __builtin_amdgcn_cvt_pk_fp8_f32(o[d0][4 * rg + 0] * inv * bflo(z.x), o[d0][4 * rg + 1] * inv * bfhi(z.x), 0, false);
            w = __builtin_amdgcn_cvt_pk_fp8_f32(o[d0][4 * rg + 2] * inv * bflo(z.y), o[d0][4 * rg + 3] * inv * bfhi(z.y), w, true);
            *(GAS unsigned*)(op8 + dim) = (unsigned)w; }
}

struct NsaPtrs { const bf16* Q; const bf16* KV; const bf16* KC; const bf16* VC; const bf16* Z; const float* G; bf16* O; float* scr; };
template <int MODE>
__device__ __forceinline__ void nsa_loop(LAS unsigned char* lds, const unsigned char* kbase, const unsigned char* vbase, int ntiles, int jlo,
                                         const bf16x8 (&q)[8], int t, float slope2, float& m, float& l, f32x16 (&o)[4], float invl, int tid, int wave, int lane) {
    constexpr bool HASV = MODE != 0;
    const int r32 = lane & 31, hi = lane >> 5;
    const int srow = tid >> 3, sc8 = tid & 7;
    const unsigned soff = srow * 256 + sc8 * 16;
    LAS unsigned char* kst = lds + srow * KS_N + sc8 * 16;
    LAS unsigned char* vst = lds + 2 * NSA_KB + srow * VS + sc8 * 16;
    const LAS unsigned char* kl = lds + r32 * KS_N + hi * 16;
    const LAS unsigned char* vl = lds + 2 * NSA_KB + (4 * hi + ((lane & 15) >> 2)) * VS + (16 * ((lane >> 4) & 1) + 4 * (lane & 3)) * 2;
    const LAS int* ulist = (const LAS int*)(lds + N_ULIST);
    const LAS unsigned* selm = (const LAS unsigned*)(lds + N_SELM);
    LAS float* partA = (LAS float*)(lds + N_PART); LAS float* partB = (LAS float*)(lds + N_PART + N_PARTB);
    LAS float* imp = (LAS float*)(lds + N_IMP); LAS float* carry = (LAS float*)(lds + N_CARRY);
    if (ntiles <= 0) return;
    const float mlg = (MODE == 1) ? (invl > 0.f ? m - __builtin_amdgcn_logf(invl) : __builtin_inff()) : 0.f;
    u32x4 sk0, sk1, sv0, sv1;
#define NSA_TROW(j) (MODE == 2 ? 64 * __builtin_amdgcn_readfirstlane(ulist[ntiles - 1 - (j)]) : ((MODE == 3 || MODE == 0) ? 64 * (jlo + ntiles - 1 - (j)) : 64 * (jlo + (j))))
#define NSA_LOAD(j) do { const size_t ro_ = (size_t)NSA_TROW(j) * 256 + soff; \
        sk0 = *(const GAS u32x4*)(kbase + ro_); sk1 = *(const GAS u32x4*)(kbase + ro_ + 128); \
        if (HASV) { sv0 = *(const GAS u32x4*)(vbase + ro_); sv1 = *(const GAS u32x4*)(vbase + ro_ + 128); } } while (0)
#define NSA_STORE(b) do { LAS unsigned char* kd_ = kst + (b) * NSA_KB; *(LAS u32x4*)(kd_) = sk0; *(LAS u32x4*)(kd_ + 128) = sk1; \
        if (HASV) { LAS unsigned char* vd_ = vst + (b) * VB; *(LAS u32x4*)(vd_) = sv0; *(LAS u32x4*)(vd_ + 128) = sv1; } } while (0)
    NSA_LOAD(0); NSA_STORE(0);
    __syncthreads();
    for (int j = 0; j < ntiles; ++j) {
        const int buf = j & 1;
        if (j + 1 < ntiles) NSA_LOAD(j + 1);
        const int trow = NSA_TROW(j);
        constexpr int PSTEP = (MODE <= 1) ? 16 : 1;
        const int pstart = (MODE <= 1) ? 16 * trow + 31 : trow;
        const int db = t - pstart - PSTEP * 4 * hi;
        constexpr unsigned W = (MODE == 3) ? 512u : 0x7fffffffu;
        const bool mset = m > -1e29f;
        float b0 = -slope2 * (float)db - ((MODE != 1) ? (mset ? m : 0.f) : mlg);
        if (MODE == 2) { const int b = trow >> 6; if (((selm[r32 * 8 + (b >> 5)] >> (b & 31)) & 1u) == 0u) b0 = -__builtin_inff(); }
        f32x16 p0, p1;
#pragma unroll
        for (int r = 0; r < 16; ++r) { const int c = PSTEP * ((r & 3) + 8 * (r >> 2));
            p0[r] = __builtin_fmaf(slope2, (float)c, b0); p1[r] = __builtin_fmaf(slope2, (float)(c + 32 * PSTEP), b0); }
        qk_tile<8, KS_N, false>(p0, p1, kl + buf * NSA_KB, q);
        PvPre pp; if (MODE >= 2) { pv_preload(pp, vl + buf * VB); __builtin_amdgcn_sched_barrier(0); }
        { const int t0u = __builtin_amdgcn_readfirstlane(t - r32);
          const bool interior = (t0u - (pstart + PSTEP * 63) >= 0) && ((unsigned)(t0u + 31 - pstart) < W);
          if (!interior) {
#pragma unroll
              for (int r = 0; r < 16; ++r) { const int c = PSTEP * ((r & 3) + 8 * (r >> 2));
                  if ((unsigned)(db - c) >= W) p0[r] = -__builtin_inff();
                  if ((unsigned)(db - c - 32 * PSTEP) >= W) p1[r] = -__builtin_inff(); } } }
        if (MODE == 0) {
            float tm = p0[0];
#pragma unroll
            for (int r = 1; r < 16; ++r) tm = fmaxf(tm, p0[r]);
#pragma unroll
            for (int r = 0; r < 16; ++r) tm = fmaxf(tm, p1[r]);
            tm = swapmax(tm);
            const bool need = mset ? (tm > 16.f) : (tm > -1e29f);
            if (!__all(!need)) {
                const float dlt = need ? tm : 0.f;
                if (mset) l *= __builtin_amdgcn_exp2f(-dlt);
                if (need) m = (mset ? m : 0.f) + dlt;
#pragma unroll
                for (int r = 0; r < 16; ++r) { p0[r] -= dlt; p1[r] -= dlt; }
            }
            float ps = 0.f;
#pragma unroll
            for (int r = 0; r < 16; ++r) ps += __builtin_amdgcn_exp2f(p0[r]) + __builtin_amdgcn_exp2f(p1[r]);
            l += swapsum(ps);
        } else if (MODE == 1) {
#pragma unroll
            for (int r = 0; r < 16; ++r) { p0[r] = __builtin_amdgcn_exp2f(p0[r]); p1[r] = __builtin_amdgcn_exp2f(p1[r]); }
            LAS float* pa = partA + (wave * 32 + r32) * 17 + hi; LAS float* pbm = partB + (wave * 32 + r32) * 17 + hi;
#pragma unroll
            for (int rg = 0; rg < 4; ++rg) {
                pa[2 * rg] = (p0[4 * rg] + p0[4 * rg + 1]) + (p0[4 * rg + 2] + p0[4 * rg + 3]); pbm[2 * rg] = p0[4 * rg + 3];
                pa[8 + 2 * rg] = (p1[4 * rg] + p1[4 * rg + 1]) + (p1[4 * rg + 2] + p1[4 * rg + 3]); pbm[8 + 2 * rg] = p1[4 * rg + 3]; }
            const bf16x8 pb[4] = {packp<0>(p0), packp<1>(p0), packp<0>(p1), packp<1>(p1)};
            pv_tile(o, pb, vl + buf * VB);
            __syncthreads();
            { const int qq = tid >> 4, jl = tid & 15; float a = 0.f, bp = 0.f, bl = 0.f;
#pragma unroll
              for (int w = 0; w < 8; ++w) { a += partA[(w * 32 + qq) * 17 + jl]; bl += partB[(w * 32 + qq) * 17 + jl]; }
              if (jl > 0) {
#pragma unroll
                  for (int w = 0; w < 8; ++w) bp += partB[(w * 32 + qq) * 17 + jl - 1];
              } else bp = (j > 0) ? carry[((j - 1) & 1) * 32 + qq] : 0.f;
              imp[qq * 256 + 16 * j + jl] = a + bp;
              if (jl == 15) carry[(j & 1) * 32 + qq] = bl; }
        } else {
            constexpr float NSA_LAZY_T = 16.f;
            float tm = p0[0];
#pragma unroll
            for (int r = 1; r < 16; ++r) tm = fmaxf(tm, p0[r]);
#pragma unroll
            for (int r = 0; r < 16; ++r) tm = fmaxf(tm, p1[r]);
            tm = swapmax(tm);
            const bool need = mset ? (tm > NSA_LAZY_T) : (tm > -1e29f);
            if (!__all(!need)) {
                const float dlt = need ? tm : 0.f;
                const float alpha = mset ? __builtin_amdgcn_exp2f(-dlt) : 1.f;
                if (need) m = (mset ? m : 0.f) + dlt;
#pragma unroll
                for (int r = 0; r < 16; ++r) { p0[r] -= dlt; p1[r] -= dlt; }
                l *= alpha;
#pragma unroll
                for (int d_ = 0; d_ < 4; ++d_)
#pragma unroll
                    for (int r = 0; r < 16; ++r) o[d_][r] *= alpha;
            }
            float ps = 0.f;
#pragma unroll
            for (int r = 0; r < 16; ++r) { p0[r] = __builtin_amdgcn_exp2f(p0[r]); ps += p0[r]; }
#pragma unroll
            for (int r = 0; r < 16; ++r) { p1[r] = __builtin_amdgcn_exp2f(p1[r]); ps += p1[r]; }
            l += swapsum(ps);
            const bf16x8 pb[4] = {packp<0>(p0), packp<1>(p0), packp<0>(p1), packp<1>(p1)};
            pv_tile<true>(o, pb, vl + buf * VB, &pp);
        }
        if (j + 1 < ntiles) NSA_STORE(buf ^ 1);
        __syncthreads();
    }
#undef NSA_TROW
#undef NSA_LOAD
#undef NSA_STORE
}
__device__ __forceinline__ void nsa_topk(const LAS float* improw, LAS unsigned* selrow, int cur, int lane) {
    unsigned key[4]; bool sel[4];
    int nforced = 0;
#pragma unroll
    for (int k = 0; k < 4; ++k) { const int j = lane + 64 * k;
        const bool forced = (j == 0) || (j == cur) || (j == cur - 1);
        const bool causal = j <= cur;
        sel[k] = forced;
        key[k] = (causal && !forced) ? (__float_as_uint(improw[j]) + 1u) : 0u;
    }
    nforced = 1 + (cur >= 1 ? 1 : 0) + (cur >= 2 ? 1 : 0);
    const int want = 16 - nforced;
    for (int it = 0; it < want; ++it) {
        unsigned bk = key[0]; int bj = lane;
#pragma unroll
        for (int k = 1; k < 4; ++k) { if (key[k] > bk) { bk = key[k]; bj = lane + 64 * k; } }
        unsigned long long best = ((unsigned long long)bk << 32) | (unsigned)(0xffffffffu - (unsigned)bj);
#pragma unroll
        for (int off = 1; off < 64; off <<= 1) {
            const unsigned lo = __shfl_xor((unsigned)best, off), hiw = __shfl_xor((unsigned)(best >> 32), off);
            const unsigned long long other = ((unsigned long long)hiw << 32) | lo;
            best = other > best ? other : best; }
        if ((unsigned)(best >> 32) == 0u) break;
        const int wj = (int)(0xffffffffu - (unsigned)best);
#pragma unroll
        for (int k = 0; k < 4; ++k) if (wj == lane + 64 * k) { key[k] = 0u; sel[k] = true; }
    }
#pragma unroll
    for (int k = 0; k < 4; ++k) { const unsigned long long bm = __ballot(sel[k]);
        if (lane == 0) { selrow[2 * k] = (unsigned)bm; selrow[2 * k + 1] = (unsigned)(bm >> 32); } }
}
__device__ __forceinline__ int cnt_ge(unsigned key, unsigned thr) { unsigned long long m_; asm("v_cmp_ge_u32_e64 %0, %1, %2" : "=s"(m_) : "v"(key), "s"(thr)); return __builtin_popcountll(m_); }
__device__ __forceinline__ int cnt_gt(unsigned key, unsigned thr) { unsigned long long m_; asm("v_cmp_gt_u32_e64 %0, %1, %2" : "=s"(m_) : "v"(key), "s"(thr)); return __builtin_popcountll(m_); }
__device__ __forceinline__ void nsa_topk4(const LAS float* imp0, LAS unsigned* sel0, int cur, int lane) {
    unsigned key[4][4]; bool forced[4];
#pragma unroll
    for (int k = 0; k < 4; ++k) { const int j = lane + 64 * k;
        forced[k] = (j == 0) || (j == cur) || (j == cur - 1);
        const bool cand = (j <= cur) && !forced[k];
#pragma unroll
        for (int i = 0; i < 4; ++i) { const unsigned v_ = __float_as_uint(imp0[i * 256 + j]) + 1u; key[i][k] = cand ? v_ : 0u; } }
    const int want = 16 - (1 + (cur >= 1 ? 1 : 0) + (cur >= 2 ? 1 : 0));
    unsigned T[4] = {0u, 0u, 0u, 0u};
#pragma unroll 1
    for (int bit = 30; bit >= 0; --bit) {
        const unsigned bm = 1u << bit;
        unsigned long long mk[4][4];
#pragma unroll
        for (int i = 0; i < 4; ++i) { const unsigned c = T[i] | bm;
#pragma unroll
            for (int k = 0; k < 4; ++k) asm volatile("v_cmp_ge_u32_e64 %0, %1, %2" : "=s"(mk[i][k]) : "v"(key[i][k]), "s"(c)); }
        __builtin_amdgcn_sched_barrier(0);
#pragma unroll
        for (int i = 0; i < 4; ++i) { const int n = (__builtin_popcountll(mk[i][0]) + __builtin_popcountll(mk[i][1])) + (__builtin_popcountll(mk[i][2]) + __builtin_popcountll(mk[i][3]));
            if (n >= want) T[i] |= bm; }
    }
#pragma unroll
    for (int i = 0; i < 4; ++i) {
        const unsigned Ti = T[i];
        int rem = want - ((cnt_gt(key[i][0], Ti) + cnt_gt(key[i][1], Ti)) + (cnt_gt(key[i][2], Ti) + cnt_gt(key[i][3], Ti)));
        unsigned long long bmv[4];
#pragma unroll
        for (int k = 0; k < 4; ++k) {
            const bool eq = (Ti != 0u) && key[i][k] == Ti; const unsigned long long em = __ballot(eq);
            const int below = (int)__builtin_amdgcn_mbcnt_hi((unsigned)(em >> 32), __builtin_amdgcn_mbcnt_lo((unsigned)em, 0u));
            const bool s = forced[k] || (Ti == 0u ? key[i][k] >= 1u : (key[i][k] > Ti || (eq && below < rem)));
            rem -= __builtin_popcountll(em); if (rem < 0) rem = 0;
            bmv[k] = __ballot(s);
        }
        if (lane < 8) { const unsigned long long w_ = bmv[lane >> 1]; sel0[i * 8 + lane] = (lane & 1) ? (unsigned)(w_ >> 32) : (unsigned)w_; }
    }
}
__device__ __forceinline__ int nsa_opaque(int v) { asm volatile("" : "+v"(v)); return v; }
__device__ __forceinline__ void nsa_unit(LAS unsigned char* lds, const NsaPtrs& P, int g, int qblk, int tid_in, int wave, int lane_in, int cu) {
    int tid = tid_in; asm volatile("" : "+v"(tid));
    const int lane = tid & 63; (void)lane_in;
    const int r32 = lane & 31, hi = lane >> 5;
    const int hh = 8 * g + wave, t0 = 32 * qblk, t = t0 + r32;
    const float slope2 = __builtin_amdgcn_exp2f(-0.5f * (float)(hh + 1)) * LOG2E;
    bf16x8 q[8];
    { const bf16* qp = P.Q + (size_t)t * 2048 + hh * 128 + hi * 8;
#pragma unroll
      for (int d0 = 0; d0 < 8; ++d0) q[d0] = *(const GAS bf16x8*)(qp + d0 * 16); }
#define NSA_SCR() ((GAS f32x4*)(P.scr + ((size_t)(cu * 8 + wave) * 16) * 256) + nsa_opaque(lane))
    const size_t CH = (size_t)S * 128 * 2;
    f32x16 o[4]; float m, l;
#define NSA_SCR2 ((size_t)256 * 8 * 16 * 64)
#define NSA_ZERO_O() do { _Pragma("unroll") for (int d_ = 0; d_ < 4; ++d_) _Pragma("unroll") for (int r_ = 0; r_ < 16; ++r_) o[d_][r_] = 0.f; } while (0)
    const int ncv = 2 * qblk + 1, ntc = (ncv + 63) >> 6;
    const unsigned char* kc = (const unsigned char*)P.KC + (size_t)g * 1024 * 256; const unsigned char* vc = (const unsigned char*)P.VC + (size_t)g * 1024 * 256;
    m = -1e30f; l = 0.f; NSA_ZERO_O();
    nsa_loop<0>(lds, kc, vc, ntc, 0, q, t, slope2, m, l, o, 0.f, tid, wave, lane);
    const float invl = l > 0.f ? 1.f / l : 0.f;
    nsa_loop<1>(lds, kc, vc, ntc, 0, q, t, slope2, m, l, o, invl, tid, wave, lane);
    { const float g_c = P.G[(size_t)t * 48 + hh]; GAS f32x4* scr = NSA_SCR();
#pragma unroll
    for (int d0 = 0; d0 < 4; ++d0)
#pragma unroll
        for (int rg = 0; rg < 4; ++rg) { f32x4 v = {o[d0][4 * rg] * g_c, o[d0][4 * rg + 1] * g_c, o[d0][4 * rg + 2] * g_c, o[d0][4 * rg + 3] * g_c}; scr[(d0 * 4 + rg) * 64] = v; } }
    const int cur = t0 >> 6;
    LAS unsigned* selm = (LAS unsigned*)(lds + N_SELM);
    nsa_topk4((const LAS float*)(lds + N_IMP) + 4 * wave * 256, selm + 4 * wave * 8, cur, lane);
    __syncthreads();
    int nts;
    { LAS int* ulist = (LAS int*)(lds + N_ULIST); LAS int* ucnt = (LAS int*)(lds + N_NTS) + 4;
      unsigned u = (lane < 32) ? selm[lane * 8 + wave] : 0u;
#pragma unroll
      for (int off = 1; off < 32; off <<= 1) u |= __shfl_xor(u, off);
      u = __builtin_amdgcn_readfirstlane(u);
      if (lane == 0) ucnt[wave] = __builtin_popcount(u);
      __syncthreads();
      int off = 0, tot = 0;
#pragma unroll
      for (int k = 0; k < 8; ++k) { const int c = __builtin_amdgcn_readfirstlane(ucnt[k]); off += (k < wave) ? c : 0; tot += c; }
      if (lane < 32 && ((u >> lane) & 1u)) ulist[off + __builtin_popcount(u & ((1u << lane) - 1u))] = 32 * wave + lane;
      nts = tot; }
    __syncthreads();
    m = -1e30f; l = 0.f; NSA_ZERO_O();
    nsa_loop<2>(lds, (const unsigned char*)P.KV + (size_t)(4 + g) * CH, (const unsigned char*)P.KV + (size_t)(6 + g) * CH, nts, 0, q, t, slope2, m, l, o, 0.f, tid, wave, lane);
    { const float f = P.G[(size_t)t * 48 + 16 + hh] / l; GAS f32x4* scr = NSA_SCR() + NSA_SCR2;
#pragma unroll
      for (int d0 = 0; d0 < 4; ++d0)
#pragma unroll
          for (int rg = 0; rg < 4; ++rg) { f32x4 v = {o[d0][4 * rg] * f, o[d0][4 * rg + 1] * f, o[d0][4 * rg + 2] * f, o[d0][4 * rg + 3] * f}; scr[(d0 * 4 + rg) * 64] = v; } }
    const int jlo = (t0 > 511 ? t0 - 511 : 0) >> 6, jhi = (t0 + 31) >> 6;
    m = -1e30f; l = 0.f; NSA_ZERO_O();
    nsa_loop<3>(lds, (const unsigned char*)P.KV + (size_t)(8 + g) * CH, (const unsigned char*)P.KV + (size_t)(10 + g) * CH, jhi - jlo + 1, jlo, q, t, slope2, m, l, o, 0.f, tid, wave, lane);
    { const float f = P.G[(size_t)t * 48 + 32 + hh] / l; GAS f32x4* scr = NSA_SCR();
      const bf16* zp = P.Z + (size_t)t * 2048 + hh * 128 + 4 * hi;
      bf16* op = P.O + (size_t)t * 4096 + 2048 + hh * 128 + 4 * hi;
#pragma unroll
      for (int dp = 0; dp < 2; ++dp)
          { f32x4 av[8], bv[8]; u32x2 zv[8];
#pragma unroll
            for (int i = 0; i < 8; ++i) { const int d0 = 2 * dp + (i >> 2), rg = i & 3; av[i] = scr[(d0 * 4 + rg) * 64]; bv[i] = scr[NSA_SCR2 + (d0 * 4 + rg) * 64]; zv[i] = *(const GAS u32x2*)(zp + 32 * d0 + 8 * rg); }
#pragma unroll
            for (int i = 0; i < 8; ++i) { const int d0 = 2 * dp + (i >> 2), rg = i & 3; const int dim = 32 * d0 + 8 * rg; const f32x4 a = av[i] + bv[i];
                const u32x2 z = zv[i];
                u32x2 w; w.x = pk2((a[0] + o[d0][4 * rg] * f) * bflo(z.x), (a[1] + o[d0][4 * rg + 1] * f) * bfhi(z.x)); w.y = pk2((a[2] + o[d0][4 * rg + 2] * f) * bflo(z.y), (a[3] + o[d0][4 * rg + 3] * f) * bfhi(z.y));
                *(GAS u32x2*)(op + dim) = w; } } }
#undef NSA_ZERO_O
#undef NSA_SCR
#undef NSA_SCR2
}
struct CmpPtrs { const bf16* KV; const bf16* W1; const bf16* W2; const float* cbp; bf16* KC; bf16* VC; };
__device__ __forceinline__ void cmp_unit(LAS unsigned char* lds, const CmpPtrs& P, int kv, int g, int tile, int tid, int wave, int lane) {
    const int fr = lane & 15, fq = lane >> 4;
    constexpr int CRS = 544;
    LAS unsigned char* As = lds + 16384;
    LAS unsigned char* Ws = As + 16 * CRS;
    const unsigned char* Ag = (const unsigned char*)(P.KV + (size_t)(kv * 2 + g) * ((size_t)S * 128) + (size_t)(16 * tile + (tid >> 5)) * 2048) + (tid & 31) * 16;
    const unsigned char* Wg = (const unsigned char*)(P.W1 + (size_t)kv * 128 * 4096 + (size_t)(tid >> 5) * 4096) + (tid & 31) * 16;
    LAS unsigned char* Ad = As + (tid >> 5) * CRS + (tid & 31) * 16;
    LAS unsigned char* Wd = Ws + (tid >> 5) * CRS + (tid & 31) * 16;
    const LAS unsigned char* Ar = As + fr * CRS + fq * 16;
    const LAS unsigned char* Wr = Ws + (16 * wave + fr) * CRS + fq * 16;
    u32x4 ra[4], rw[4][8];
#define CMP_LOAD(c) do { ra[(c) & 3] = *(const GAS u32x4*)(Ag + (c) * 512); _Pragma("unroll") for (int i_ = 0; i_ < 8; ++i_) rw[(c) & 3][i_] = *(const GAS u32x4*)(Wg + (size_t)i_ * (16 * 8192) + (c) * 512); } while (0)
    CMP_LOAD(0); CMP_LOAD(1); CMP_LOAD(2);
    f32x4 acc = {0.f, 0.f, 0.f, 0.f};
#pragma unroll
    for (int c = 0; c < 16; ++c) {
        *(LAS u32x4*)Ad = ra[c & 3];
#pragma unroll
        for (int i = 0; i < 8; ++i) *(LAS u32x4*)(Wd + i * 16 * CRS) = rw[c & 3][i];
        __syncthreads();
        if (c + 3 < 16) CMP_LOAD(c + 3);
#pragma unroll
        for (int s = 0; s < 8; ++s) {
            const bf16x8 a = *(const LAS bf16x8*)(Ar + 64 * s), b = *(const LAS bf16x8*)(Wr + 64 * s);
            acc = __builtin_amdgcn_mfma_f32_16x16x32_bf16(a, b, acc, 0, 0, 0);
        }
        __syncthreads();
    }
#undef CMP_LOAD
    float bias = 0.f;
    { float bv[16];
#pragma unroll
      for (int c = 0; c < 16; ++c) bv[c] = *(const GAS float*)(P.cbp + (size_t)(kv * 16 + c) * 128 + 16 * wave + fr);
#pragma unroll
      for (int c = 0; c < 16; ++c) bias += bv[c]; }
    LAS bf16* hid = (LAS bf16*)lds;
#pragma unroll
    for (int i = 0; i < 4; ++i) hid[(4 * fq + i) * 136 + 16 * wave + fr] = (bf16)(pk2(silu_f(acc[i] + bias), 0.f) & 0xffffu);
    __syncthreads();
    const bf16* B2 = P.W2 + (size_t)kv * 128 * 128 + (size_t)(16 * wave + fr) * 128 + 8 * fq;
    f32x4 acc2 = {0.f, 0.f, 0.f, 0.f};
#pragma unroll
    for (int s = 0; s < 4; ++s) {
        const bf16x8 a = *(const LAS bf16x8*)(hid + fr * 136 + 32 * s + 8 * fq), b = *(const GAS bf16x8*)(B2 + 32 * s);
        acc2 = __builtin_amdgcn_mfma_f32_16x16x32_bf16(a, b, acc2, 0, 0, 0);
    }
    bf16* out = (kv ? P.VC : P.KC) + (size_t)g * 1024 * 128;
#pragma unroll
    for (int i = 0; i < 4; ++i) { const int nn = 16 * tile + 4 * fq + i; out[(size_t)nn * 128 + 16 * wave + fr] = (nn < 1023) ? (bf16)(pk2(acc2[i], 0.f) & 0xffffu) : (bf16)0; }
    __syncthreads();
}
}
constexpr int PPL = 6;
constexpr int N_PHASES = 2 + PPL * DEPTH;
struct Args { const void* in[16]; float* out; unsigned char* ws; int ph_lo, ph_hi; };
#define WSP(T, off) ((T*)(ws + (off)))
#define VCU() ((gridDim.x % 8 == 0) ? (int)((blockIdx.x % 8) * (gridDim.x / 8) + blockIdx.x / 8) : (int)blockIdx.x)
__global__ void __launch_bounds__(NTHR, 2) mk_fwd(const Args args) {
    extern __shared__ __attribute__((aligned(16))) unsigned char lds_raw[];
    LAS unsigned char* lds = (LAS unsigned char*)lds_raw;
    if (threadIdx.x < 32) ((volatile LAS unsigned*)(lds + MISC_OFF))[threadIdx.x] = 0u;
    __syncthreads();
    XcdBarrier bar = xcd_barrier_post((unsigned*)(args.ws + WS_CTL) + CW_BAR, (volatile LAS unsigned*)(lds + MISC_OFF) + 8);
#define IN(k) (args.ph_lo <= (k) && (k) < args.ph_hi)
#define SEAM(k) do { if (IN(k) && IN((k) + 1)) xcd_barrier(bar); } while (0)
#define PHASE_REGS int tid_ = threadIdx.x; asm volatile("" : "+v"(tid_)); const int tid = tid_, lane = tid & 63, wave = __builtin_amdgcn_readfirstlane(tid >> 6); \
    unsigned char* ws = args.ws; asm volatile("" : "+s"(ws)); (void)tid; (void)lane; (void)wave

    if (IN(0)) {
        PHASE_REGS; const int G = gridDim.x, vcu = VCU();
        p0_mod_gemv((const float*)args.in[1], (const float*)args.in[3], (const float*)args.in[4], WSP(float, WS_MOD), (LAS float*)lds, vcu, G);
        p0_cmpbias((const float*)args.in[10], (const float*)args.in[11], WSP(float, WS_CBP), (LAS float*)lds, (vcu + G / 2) % G, G);
        p0_rope((const int*)args.in[2], WSP(float, WS_ROPE), WSP(float, WS_ROPE) + (size_t)S * 32, vcu * NTHR + tid, G * NTHR);
        const P0In I{(const float*)args.in[5], (const float*)args.in[6], (const float*)args.in[7], (const float*)args.in[8], (const float*)args.in[9], (const float*)args.in[11], (const float*)args.in[12], (const float*)args.in[13]};
        p0_convert(I, ws, vcu * NWAVES + wave, G * NWAVES, lane);
    }
    SEAM(0);
#define H8PTR WSP(unsigned char, WS_H8)
    if (IN(1)) { PHASE_REGS; modulate_rows((const float*)args.in[0], WSP(bf16, WS_H), H8PTR, WSP(float, WS_MOD), (LAS float*)lds, tid, VCU() * NWAVES + wave, gridDim.x * NWAVES, lane);
    }
    SEAM(1);
    for (int l = 0; l < DEPTH; ++l) {
        const int pb = 2 + PPL * l;
        if (IN(pb + 0)) {
            PHASE_REGS;
            { pg8::Gemm gg{WSP(bf16, WS_H), (const bf16*)(ws + WS_W + (size_t)l * W_LSTRIDE + W_IN), S, 23 * 256, D}; pg8::InBf16Order SO; SO.init(S, 23 * 256, gridDim.x, blockIdx.x);
              const pg8::EpiIn E{ws, 0};
              pg8::gemm_phase<pg8::EpiIn, pg8::InBf16Order, true, true>(lds, gg, SO, E);
            }
            { pg8::Gemm gg{(const bf16*)(ws + WS_H8), (const bf16*)(ws + WS_WIN8 + (size_t)l * WIN8_LSTRIDE), S, 13 * 256, D / 2}; pg8::StaticOrder SO; SO.init(S, 13 * 256, gridDim.x, (blockIdx.x + 64) % gridDim.x);
              const pg8::EpiIn E{ws, 1};
              pg8::gemm_phase<pg8::EpiIn, pg8::StaticOrder, true, true, 0x79797979, 0x7f7f7f7f>(lds, gg, SO, E);
            }
        }
        SEAM(pb + 0);
        if (IN(pb + 1)) {
            PHASE_REGS; const int G = gridDim.x, vcu = VCU();
            rstd_rows(WSP(float, WS_RSQQ), WSP(float, WS_RSQKV), WSP(float, WS_RSTD), WSP(float, WS_RSTD) + S, vcu * NTHR + tid, G * NTHR);
            const att::CmpPtrs CP{WSP(bf16, WS_KVNSA), (const bf16*)(ws + WS_W + (size_t)l * W_LSTRIDE + W_C1), (const bf16*)(ws + WS_W + (size_t)l * W_LSTRIDE + W_C2),
                                  WSP(float, WS_CBP) + (size_t)l * 2 * 16 * 128, WSP(bf16, WS_KCMP), WSP(bf16, WS_VCMP)};
            for (int u = vcu; u < 256; u += G) att::cmp_unit(lds, CP, u & 1, (u >> 1) & 1, u >> 2, tid, wave, lane);
        }
        SEAM(pb + 1);
        if (IN(pb + 2)) {
            PHASE_REGS;
            { pg8::Gemm gg{WSP(bf16, WS_QLAT), (const bf16*)(ws + WS_W + (size_t)l * W_LSTRIDE + W_QUP), S, 3072, 384}; pg8::StaticOrder SO; SO.init(S, 3072, gridDim.x, blockIdx.x);
              const pg8::EpiQup E{ws};
              pg8::gemm_phase<pg8::EpiQup, pg8::StaticOrder, true, true, 0x7a7a7a7a, 0x7f7f7f7f>(lds, gg, SO, E);
            }
            { pg8::Gemm gg{WSP(bf16, WS_KVLAT), (const bf16*)(ws + WS_W + (size_t)l * W_LSTRIDE + W_KVUP), S, 2048, 256}; pg8::StaticOrder SO; SO.init(S, 2048, gridDim.x, blockIdx.x);
              const pg8::EpiKup E{ws};
              pg8::gemm_phase<pg8::EpiKup, pg8::StaticOrder, true, true, 0x7a7a7a7a, 0x7f7f7f7f>(lds, gg, SO, E);
            }
            { pg8::Gemm gg{(const bf16*)(ws + WS_W + (size_t)l * W_LSTRIDE + W_KVUP + (size_t)2048 * 512), WSP(bf16, WS_KVLAT), 2048, S, 256}; pg8::StaticOrder SO; SO.init(2048, S, gridDim.x, blockIdx.x);
              const pg8::EpiVt E{ws};
              pg8::gemm_phase<pg8::EpiVt, pg8::StaticOrder, true, true, 0x7f7f7f7f, 0x7a7a7a7a>(lds, gg, SO, E);
            }
        }
        SEAM(pb + 2);
        if (IN(pb + 3)) {
            PHASE_REGS; const int G = gridDim.x, vcu = VCU();
            { const att::MlaPtrs MP{WSP(bf16, WS_QMLA), WSP(bf16, WS_KMLA), WSP(bf16, WS_VMLA), WSP(bf16, WS_ZMLA), WSP(bf16, WS_H)};
              att::MlaPre mpre; if (vcu < 512) att::mla_preload(mpre, MP, vcu >> 5, tid);
              for (int pu = vcu; pu < 512; pu += G) { const int head = pu >> 5, pr = pu & 31, npu = pu + G < 512 ? pu + G : pu;
                  att::mla_unit(lds, MP, head, 63 - pr, tid, wave, lane, mpre, head);
                  att::mla_unit(lds, MP, head, pr, tid, wave, lane, mpre, npu >> 5);
              }
            }
            { const att::NsaPtrs NP{WSP(bf16, WS_QNSA), WSP(bf16, WS_KVNSA), WSP(bf16, WS_KCMP), WSP(bf16, WS_VCMP), WSP(bf16, WS_ZNSA), WSP(float, WS_GNSA), WSP(bf16, WS_H), WSP(float, WS_OSCR)};
              { unsigned* qctr = (unsigned*)(ws + WS_CTL) + CW_NSAQ + 64 * l; volatile LAS unsigned* uw = (volatile LAS unsigned*)(lds + MISC_OFF) + 16;
                unsigned nxt_ = 0u; if (tid == 0) nxt_ = __hip_atomic_fetch_add(qctr, 1u, __ATOMIC_RELAXED, __HIP_MEMORY_SCOPE_AGENT);
                for (;;) {
                    __syncthreads();
                    if (tid == 0) *uw = nxt_;
                    __syncthreads();
                    const int u = __builtin_amdgcn_readfirstlane((int)*uw);
                    if (u >= 1024) break;
                    if (tid == 0) nxt_ = __hip_atomic_fetch_add(qctr, 1u, __ATOMIC_RELAXED, __HIP_MEMORY_SCOPE_AGENT);
                    att::nsa_unit(lds, NP, u & 1, 511 - (u >> 1), tid, wave, lane, blockIdx.x); } }
            }
        }
        SEAM(pb + 3);
        if (IN(pb + 4)) {
            PHASE_REGS;
            pg8::StaticOrder SO; SO.init(S, D, gridDim.x, blockIdx.x);
            const pg8::EpiOut E{WSP(bf16, WS_Y), WSP(const float, WS_MOD) + (size_t)l * 3 * D + 2 * D};
            const pg8::GemmMix gm{ws + WS_H, ws + WS_W + (size_t)l * W_LSTRIDE + W_OUT, D, 1024, 2048, 2048, S, D};
            pg8::gemm_phase_mix<pg8::EpiOut, pg8::StaticOrder, 0x78787878, 0x7b7b7b7b>(lds, gm, SO, E);
        }
        SEAM(pb + 4);
        if (IN(pb + 5)) {
            PHASE_REGS;
            if (l == 0) ln_rows<false, true>(args.in[0], WSP(const bf16, WS_Y), WSP(void, WS_XV), WSP(bf16, WS_H), H8PTR, (const float*)args.in[14], (const float*)args.in[15],
                    WSP(const float, WS_MOD) + (size_t)3 * D, (LAS float*)lds, tid, VCU() * NWAVES + wave, gridDim.x * NWAVES, lane);
            else ln_rows<true, false>(WSP(const void, WS_XV), WSP(const bf16, WS_Y), args.out, nullptr, nullptr, (const float*)args.in[14] + (size_t)l * D, (const float*)args.in[15] + (size_t)l * D,
                    WSP(const float, WS_MOD) + (size_t)(l + 1) * 3 * D, (LAS float*)lds, tid, VCU() * NWAVES + wave, gridDim.x * NWAVES, lane);
        }
        SEAM(pb + 5);
    }
#undef IN
#undef SEAM
}


#ifndef MK_PER_PHASE
#define MK_PER_PHASE 0
#endif
extern "C" void kernel_launch(void* const* d_in, const int* in_sizes, int n_in, void* d_out, int out_size, void* d_ws, size_t ws_size, hipStream_t stream) {
    static int grid = 0;
    if (grid == 0) {
        if (n_in != 16 || out_size != S * D || ws_size < WS_END) { fprintf(stderr, "kernel_launch: unexpected shapes n_in %d out %d ws %zu\n", n_in, out_size, ws_size); grid = -1; return; }
        int dev = 0, cus = 0;
        if (hipGetDevice(&dev) != hipSuccess || hipDeviceGetAttribute(&cus, hipDeviceAttributeMultiprocessorCount, dev) != hipSuccess) { grid = -1; return; }
        if (hipFuncSetAttribute((const void*)mk_fwd, hipFuncAttributeMaxDynamicSharedMemorySize, LDS_BYTES) != hipSuccess) { grid = -1; return; }
        int per_cu = 0;
        (void)hipOccupancyMaxActiveBlocksPerMultiprocessor(&per_cu, (const void*)mk_fwd, NTHR, LDS_BYTES);
        (void)hipGetLastError();
        if (per_cu < 1) fprintf(stderr, "kernel_launch: occupancy query says %d\n", per_cu);
        grid = cus;
    }
    if (grid < 0) return;
    (void)hipMemsetAsync((char*)d_ws + WS_CTL, 0, CTL_ZERO_BYTES, stream);
    Args a{};
    for (int i = 0; i < 16; ++i) a.in[i] = d_in[i];
    a.out = (float*)d_out; a.ws = (unsigned char*)d_ws;
    a.ph_lo = 0; a.ph_hi = N_PHASES;
    hipLaunchKernelGGL(mk_fwd, dim3(grid), dim3(NTHR), LDS_BYTES, stream, a);
}
```
